# Optimizing an MI355X kernel written in HIP

```python
import math
import jax, jax.numpy as jnp
from jax import lax
import numpy as np

D_MODEL = 1024
BATCH = 2
SEQ = 8192
DEPTH = 4

NSA_HEADS = 8
NSA_KV_GROUPS = 2
NSA_HPG = NSA_HEADS // NSA_KV_GROUPS
NSA_HEAD_DIM = 64
CMP_LEN = 32
CMP_STRIDE = 16
SLC_BLOCK = 64
N_SELECT = 16
WINDOW = 512
Q_BLOCK = 128
FORCE_SCORE = 1.0e4
RET_HEADS = 8
RET_QK_DIM = 64
RET_V_DIM = 128
RET_CHUNK = 128
ROPE_BASE = 10000.0
REL_BUCKETS = 32
REL_MAX_EXACT = 16
REL_MAX_DIST = 2048
N_EXPERTS = 16
N_GROUPS = 4
EXPERTS_PER_GROUP = N_EXPERTS // N_GROUPS
TOP_K = 2
D_EXPERT = 512
MOE_BLOCK = 128
DN_ALPHA = (2 * DEPTH) ** 0.25
DN_BETA = (8 * DEPTH) ** -0.25
LN_EPS = 1e-5
GN_EPS = 1e-5
NEG_INF = -1e30

W_NSA_Q = NSA_HEADS * NSA_HEAD_DIM
W_NSA_KV = NSA_KV_GROUPS * NSA_HEAD_DIM
W_NSA_GATE = NSA_HEADS * 3
W_RET_QK = RET_HEADS * RET_QK_DIM
W_RET_V = RET_HEADS * RET_V_DIM
IN_WIDTHS = (W_NSA_Q, W_NSA_KV, W_NSA_KV, W_NSA_KV, W_NSA_KV, W_NSA_KV, W_NSA_KV, W_NSA_GATE,
             W_RET_QK, W_RET_QK, W_RET_V, W_RET_V, D_MODEL, D_MODEL)
D_IN = sum(IN_WIDTHS)

kernel_name = 'nsa_retention_gated_moe_deepnorm'


def layer_norm(x, g, b):
    xf = x.astype(jnp.float32)
    mu = jnp.mean(xf, axis=-1, keepdims=True)
    var = jnp.mean(jnp.square(xf - mu), axis=-1, keepdims=True)
    return ((xf - mu) * lax.rsqrt(var + LN_EPS) * g + b).astype(x.dtype)


def t5_bucket(rel):
    n = jnp.maximum(rel, 0)
    nf = jnp.maximum(n, 1).astype(jnp.float32)
    large = REL_MAX_EXACT + (jnp.log(nf / REL_MAX_EXACT) / math.log(REL_MAX_DIST / REL_MAX_EXACT)
                             * (REL_BUCKETS - REL_MAX_EXACT)).astype(jnp.int32)
    large = jnp.minimum(large, REL_BUCKETS - 1)
    return jnp.where(n < REL_MAX_EXACT, n, large)


def masked_softmax(s, mask):
    s = jnp.where(mask, s, NEG_INF)
    s = s - jnp.max(s, axis=-1, keepdims=True)
    p = jnp.exp(s) * mask
    return p / jnp.maximum(jnp.sum(p, axis=-1, keepdims=True), 1e-30)


def nsa_compress(kv, pos, w1, w2):
    b, s, g, d = kv.shape
    nc = (s - CMP_LEN) // CMP_STRIDE + 1
    idx = (jnp.arange(nc) * CMP_STRIDE)[:, None] + jnp.arange(CMP_LEN)[None, :]
    blocks = kv[:, idx] + pos[None, None, :, None, :]
    flat = blocks.transpose(0, 3, 1, 2, 4).reshape(b, g, nc, CMP_LEN * d)
    return jax.nn.gelu(flat @ w1) @ w2


def nsa_attention(q, k_cmp, v_cmp, k_slc, v_slc, k_win, v_win, gate_logits,
                  cmp_pos, cmp_w1, cmp_w2, rel_bias):
    b, s, h, d = q.shape
    g, r = NSA_KV_GROUPS, NSA_HPG
    scale = d ** -0.5
    qg = q.reshape(b, s, g, r, d).transpose(0, 2, 3, 1, 4)
    gates = jax.nn.sigmoid(gate_logits.astype(jnp.float32)).reshape(b, s, g, r, 3).transpose(0, 2, 3, 1, 4)
    kc = nsa_compress(k_cmp, cmp_pos[0], cmp_w1[0], cmp_w2[0])
    vc = nsa_compress(v_cmp, cmp_pos[1], cmp_w1[1], cmp_w2[1])
    nc = kc.shape[2]
    c_start = jnp.arange(nc) * CMP_STRIDE
    cmp_end = c_start + CMP_LEN - 1
    ns = s // SLC_BLOCK
    n_sel = min(N_SELECT, ns)
    ks_blk = k_slc.transpose(0, 2, 1, 3).reshape(b, g, ns, SLC_BLOCK, d)
    vs_blk = v_slc.transpose(0, 2, 1, 3).reshape(b, g, ns, SLC_BLOCK, d)
    s_start = jnp.arange(ns) * SLC_BLOCK
    cover = jnp.maximum(jnp.minimum(c_start[:, None] + CMP_LEN, s_start[None, :] + SLC_BLOCK)
                        - jnp.maximum(c_start[:, None], s_start[None, :]), 0).astype(jnp.float32) / CMP_LEN
    kw = jnp.pad(k_win.transpose(0, 2, 1, 3), ((0, 0), (0, 0), (WINDOW, 0), (0, 0)))
    vw = jnp.pad(v_win.transpose(0, 2, 1, 3), ((0, 0), (0, 0), (WINDOW, 0), (0, 0)))
    bias_g = rel_bias.reshape(REL_BUCKETS, g, r)
    b_ix = jnp.arange(b)[:, None, None, None]
    g_ix = jnp.arange(g)[None, :, None, None]
    blk_ids = jnp.arange(ns)

    def head_bias(bucket):
        return rel_bias[bucket].transpose(2, 0, 1).reshape(g, r, *bucket.shape)

    def query_block(qi):
        q0 = qi * Q_BLOCK
        t = q0 + jnp.arange(Q_BLOCK)
        qb = lax.dynamic_slice_in_dim(qg, q0, Q_BLOCK, axis=3)
        gb = lax.dynamic_slice_in_dim(gates, q0, Q_BLOCK, axis=3)
        s_c = jnp.einsum('bgrqd,bgkd->bgrqk', qb, kc).astype(jnp.float32) * scale \
            + head_bias(t5_bucket(t[:, None] - cmp_end[None, :]))
        p_c = masked_softmax(s_c, cmp_end[None, :] <= t[:, None])
        o_c = jnp.einsum('bgrqk,bgkd->bgrqd', p_c.astype(vc.dtype), vc)
        imp = jnp.einsum('bgrqk,kj->bgqj', p_c, cover)
        cur = (t // SLC_BLOCK)[:, None]
        eligible = blk_ids[None, :] <= cur
        forced = (blk_ids[None, :] == 0) | (blk_ids[None, :] == cur) | (blk_ids[None, :] == cur - 1)
        score = jnp.where(eligible, imp + jnp.where(forced, FORCE_SCORE, 0.0), -1.0)
        top_s, sel = lax.top_k(score, n_sel)
        ks = ks_blk[b_ix, g_ix, sel].reshape(b, g, Q_BLOCK, n_sel * SLC_BLOCK, d)
        vs = vs_blk[b_ix, g_ix, sel].reshape(b, g, Q_BLOCK, n_sel * SLC_BLOCK, d)
        kpos = (sel[..., None] * SLC_BLOCK + jnp.arange(SLC_BLOCK)).reshape(b, g, Q_BLOCK, n_sel * SLC_BLOCK)
        valid = jnp.broadcast_to((top_s >= 0.0)[..., None], sel.shape + (SLC_BLOCK,)).reshape(kpos.shape)
        rel_s = t[None, None, :, None] - kpos
        mask_s = valid & (rel_s >= 0)
        bias_s = jnp.moveaxis(bias_g[t5_bucket(rel_s), g_ix], -1, 2)
        s_s = jnp.einsum('bgrqd,bgqkd->bgrqk', qb, ks).astype(jnp.float32) * scale + bias_s
        p_s = masked_softmax(s_s, mask_s[:, :, None])
        o_s = jnp.einsum('bgrqk,bgqkd->bgrqd', p_s.astype(vs.dtype), vs)
        kwb = lax.dynamic_slice_in_dim(kw, q0, Q_BLOCK + WINDOW, axis=2)
        vwb = lax.dynamic_slice_in_dim(vw, q0, Q_BLOCK + WINDOW, axis=2)
        kpos_w = q0 - WINDOW + jnp.arange(Q_BLOCK + WINDOW)
        rel_w = t[:, None] - kpos_w[None, :]
        mask_w = (kpos_w[None, :] >= 0) & (rel_w >= 0) & (rel_w < WINDOW)
        s_w = jnp.einsum('bgrqd,bgkd->bgrqk', qb, kwb).astype(jnp.float32) * scale + head_bias(t5_bucket(rel_w))
        p_w = masked_softmax(s_w, mask_w)
        o_w = jnp.einsum('bgrqk,bgkd->bgrqd', p_w.astype(vwb.dtype), vwb)
        o = gb[..., 0:1] * o_c + gb[..., 1:2] * o_s + gb[..., 2:3] * o_w
        return o.astype(q.dtype).transpose(0, 3, 1, 2, 4).reshape(b, Q_BLOCK, h * d)

    out = lax.map(query_block, jnp.arange(s // Q_BLOCK))
    return out.transpose(1, 0, 2, 3).reshape(b, s, h * d)


def rotary(x):
    s, dk = x.shape[1], x.shape[-1]
    half = dk // 2
    inv = ROPE_BASE ** (-jnp.arange(half, dtype=jnp.float32) * 2.0 / dk)
    ang = jnp.arange(s, dtype=jnp.float32)[:, None] * inv[None, :]
    cos = jnp.cos(ang)[None, :, None, :]
    sin = jnp.sin(ang)[None, :, None, :]
    x1, x2 = x[..., :half], x[..., half:]
    return jnp.concatenate([x1 * cos - x2 * sin, x1 * sin + x2 * cos], axis=-1)


def retention(q, k, v, gate):
    b, s, h, dk = q.shape
    dv = v.shape[-1]
    c = RET_CHUNK
    n = s // c

    def chunks(a):
        return a.reshape(b, n, c, h, -1).transpose(0, 3, 1, 2, 4)

    qc = chunks(rotary(q.astype(jnp.float32)))
    kc = chunks(rotary(k.astype(jnp.float32)) * dk ** -0.5)
    vc = chunks(v.astype(jnp.float32))
    lg = jnp.log(1.0 - 2.0 ** (-5.0 - jnp.arange(h, dtype=jnp.float32)))
    i = jnp.arange(c, dtype=jnp.float32)
    diff = i[:, None] - i[None, :]
    dmat = jnp.where(diff >= 0, jnp.exp(jnp.maximum(diff, 0.0)[None] * lg[:, None, None]), 0.0)
    intra = jnp.einsum('bhncj,bhnje->bhnce',
                       jnp.einsum('bhncd,bhnjd->bhncj', qc, kc) * dmat[None, :, None], vc)
    k_dec = kc * jnp.exp((c - 1.0 - i)[None, :] * lg[:, None])[None, :, None, :, None]
    kv = jnp.einsum('bhncd,bhnce->bhnde', k_dec, vc)
    chunk_decay = jnp.exp(c * lg)[None, :, None, None]

    def step(state, kv_n):
        return chunk_decay * state + kv_n, state

    _, s_prev = lax.scan(step, jnp.zeros((b, h, dk, dv), jnp.float32), jnp.moveaxis(kv, 2, 0))
    s_prev = jnp.moveaxis(s_prev, 0, 2)
    q_dec = qc * jnp.exp((i + 1.0)[None, :] * lg[:, None])[None, :, None, :, None]
    y = intra + jnp.einsum('bhncd,bhnde->bhnce', q_dec, s_prev)
    y = y.transpose(0, 2, 3, 1, 4).reshape(b, s, h, dv)
    mu = jnp.mean(y, axis=-1, keepdims=True)
    var = jnp.mean(jnp.square(y - mu), axis=-1, keepdims=True)
    y = ((y - mu) * lax.rsqrt(var + GN_EPS)).reshape(b, s, h * dv)
    return (jax.nn.silu(gate.astype(jnp.float32)) * y).astype(v.dtype)


def moe_ffn(h, w_router, router_bias, w_gate, w_up, w_down):
    b, s, d = h.shape
    t = b * s
    hf = h.reshape(t, d)
    probs = jax.nn.softmax((hf @ w_router).astype(jnp.float32), axis=-1)
    sel = (probs + router_bias.astype(jnp.float32)).reshape(t, N_GROUPS, EXPERTS_PER_GROUP)
    group_score = jnp.sum(lax.top_k(sel, TOP_K)[0], axis=-1)
    best = jnp.argmax(group_score, axis=-1)
    in_group = sel[jnp.arange(t), best]
    _, local = lax.top_k(in_group, TOP_K)
    eidx = best[:, None] * EXPERTS_PER_GROUP + local
    wts = jnp.take_along_axis(probs, eidx, axis=1)
    wts = wts / jnp.sum(wts, axis=-1, keepdims=True)
    tk = t * TOP_K
    flat_e = eidx.reshape(tk)
    flat_tok = jnp.arange(tk) // TOP_K
    flat_w = wts.reshape(tk)
    order = jnp.argsort(flat_e)
    se = flat_e[order]
    counts = jnp.bincount(flat_e, length=N_EXPERTS)
    padded = ((counts + MOE_BLOCK - 1) // MOE_BLOCK) * MOE_BLOCK
    pad_end = jnp.cumsum(padded)
    pad_start = pad_end - padded
    start = jnp.cumsum(counts) - counts
    dest = pad_start[se] + jnp.arange(tk) - start[se]
    n_blk = -(-(tk + N_EXPERTS * MOE_BLOCK) // MOE_BLOCK)
    rows = n_blk * MOE_BLOCK
    row_tok = jnp.zeros((rows,), jnp.int32).at[dest].set(flat_tok[order])
    row_w = jnp.zeros((rows,), jnp.float32).at[dest].set(flat_w[order])
    blk_e = jnp.minimum(jnp.searchsorted(pad_end, jnp.arange(n_blk) * MOE_BLOCK, side='right'), N_EXPERTS - 1)
    xs = hf[row_tok].reshape(n_blk, MOE_BLOCK, d)

    def expert_block(args):
        xb, e = args
        return (jax.nn.silu(xb @ w_gate[e]) * (xb @ w_up[e])) @ w_down[e]

    ys = lax.map(expert_block, (xs, blk_e)).reshape(rows, d)
    out = jax.ops.segment_sum(ys * row_w[:, None].astype(ys.dtype), row_tok, num_segments=t)
    return out.reshape(b, s, d)


def setup_inputs(seed: int = 0) -> dict:
    key = jax.random.key(seed)
    ks = jax.random.split(key, 18)

    def nrm(k, shape, scale):
        return jax.random.normal(k, shape, jnp.float32) * scale

    return {
        'x': nrm(ks[0], (BATCH, SEQ, D_MODEL), 1.0),
        'w_in': nrm(ks[1], (DEPTH, D_MODEL, D_IN), D_MODEL ** -0.5),
        'cmp_pos': nrm(ks[2], (DEPTH, 2, CMP_LEN, NSA_HEAD_DIM), 0.1),
        'cmp_w1': nrm(ks[3], (DEPTH, 2, CMP_LEN * NSA_HEAD_DIM, NSA_HEAD_DIM), (CMP_LEN * NSA_HEAD_DIM) ** -0.5),
        'cmp_w2': nrm(ks[4], (DEPTH, 2, NSA_HEAD_DIM, NSA_HEAD_DIM), NSA_HEAD_DIM ** -0.5),
        'w_br_a': nrm(ks[5], (DEPTH, W_NSA_Q, D_MODEL), W_NSA_Q ** -0.5),
        'w_br_b': nrm(ks[6], (DEPTH, W_RET_V, D_MODEL), W_RET_V ** -0.5),
        'w_o': nrm(ks[7], (DEPTH, D_MODEL, D_MODEL), D_MODEL ** -0.5 * DN_BETA),
        'ln1_g': 1.0 + nrm(ks[8], (DEPTH, D_MODEL), 0.02),
        'ln1_b': nrm(ks[9], (DEPTH, D_MODEL), 0.02),
        'w_router': nrm(ks[10], (D_MODEL, N_EXPERTS), D_MODEL ** -0.5),
        'router_bias': nrm(ks[11], (N_EXPERTS,), 0.01),
        'moe_w_gate': nrm(ks[12], (DEPTH, N_EXPERTS, D_MODEL, D_EXPERT), D_MODEL ** -0.5),
        'moe_w_up': nrm(ks[13], (DEPTH, N_EXPERTS, D_MODEL, D_EXPERT), D_MODEL ** -0.5),
        'moe_w_down': nrm(ks[14], (DEPTH, N_EXPERTS, D_EXPERT, D_MODEL), D_EXPERT ** -0.5 * DN_BETA),
        'ln2_g': 1.0 + nrm(ks[15], (DEPTH, D_MODEL), 0.02),
        'ln2_b': nrm(ks[16], (DEPTH, D_MODEL), 0.02),
        'rel_bias': nrm(ks[17], (REL_BUCKETS, NSA_HEADS), 0.2),
    }


def reference(x, w_in, cmp_pos, cmp_w1, cmp_w2, w_br_a, w_br_b, w_o, ln1_g, ln1_b,
              w_router, router_bias, moe_w_gate, moe_w_up, moe_w_down, ln2_g, ln2_b, rel_bias):
    b, s, _ = x.shape
    offsets = [int(o) for o in np.cumsum(IN_WIDTHS)[:-1]]
    for l in range(DEPTH):
        proj = x @ w_in[l]
        (q_a, k_c, v_c, k_s, v_s, k_w, v_w, g_a,
         q_r, k_r, v_r, g_r, m_a, m_b) = jnp.split(proj, offsets, axis=-1)
        y_a = nsa_attention(q_a.reshape(b, s, NSA_HEADS, NSA_HEAD_DIM),
                            k_c.reshape(b, s, NSA_KV_GROUPS, NSA_HEAD_DIM),
                            v_c.reshape(b, s, NSA_KV_GROUPS, NSA_HEAD_DIM),
                            k_s.reshape(b, s, NSA_KV_GROUPS, NSA_HEAD_DIM),
                            v_s.reshape(b, s, NSA_KV_GROUPS, NSA_HEAD_DIM),
                            k_w.reshape(b, s, NSA_KV_GROUPS, NSA_HEAD_DIM),
                            v_w.reshape(b, s, NSA_KV_GROUPS, NSA_HEAD_DIM),
                            g_a.reshape(b, s, NSA_HEADS, 3),
                            cmp_pos[l], cmp_w1[l], cmp_w2[l], rel_bias)
        y_b = retention(q_r.reshape(b, s, RET_HEADS, RET_QK_DIM),
                        k_r.reshape(b, s, RET_HEADS, RET_QK_DIM),
                        v_r.reshape(b, s, RET_HEADS, RET_V_DIM), g_r)
        merged = jax.nn.sigmoid(m_a) * (y_a @ w_br_a[l]) + jax.nn.sigmoid(m_b) * (y_b @ w_br_b[l])
        x = layer_norm(DN_ALPHA * x + merged @ w_o[l], ln1_g[l], ln1_b[l])
        x = layer_norm(DN_ALPHA * x + moe_ffn(x, w_router, router_bias, moe_w_gate[l], moe_w_up[l], moe_w_down[l]),
                       ln2_g[l], ln2_b[l])
    return x
```

```cpp
#include <hip/hip_runtime.h>
#include <hip/hip_cooperative_groups.h>
#include <cstdio>
#include <cstdint>
namespace cg = cooperative_groups;

#ifndef SINGLE_LAUNCH
#define SINGLE_LAUNCH 1
#endif

typedef unsigned short bf16_t;
typedef short bf16x8 __attribute__((ext_vector_type(8)));
typedef float f32x4 __attribute__((ext_vector_type(4)));
typedef unsigned u32x2 __attribute__((ext_vector_type(2)));
typedef unsigned u32x4 __attribute__((ext_vector_type(4)));

constexpr int B_ = 2, S_ = 8192, D_ = 1024, T_ = B_ * S_, NLAYER = 4;
constexpr int DIN = 6424;
constexpr int LD = 6528;
constexpr int C_QA = 0, C_KC = 512, C_VC = 640, C_KS = 768, C_VS = 896, C_KW = 1024, C_VW = 1152, C_QR = 1280, C_KR = 1792,
              C_VR = 2304, C_GR = 3328, C_MA = 4352, C_MB = 5376, C_GA = 6400;
constexpr float DN_ALPHA = 1.681792830507429f;
constexpr int NE = 16;

constexpr size_t al256(size_t x) { return (x + 255) & ~(size_t)255; }
constexpr size_t WS_CTL = 0;
constexpr size_t WS_BUCKET = 65536;
constexpr size_t WS_ROPE = WS_BUCKET + 8192;
constexpr size_t WS_WIN = WS_ROPE + (size_t)8192 * 32 * 8;
constexpr size_t WS_WA = WS_WIN + (size_t)LD * 1024 * 2;
constexpr size_t WS_WB = WS_WA + (size_t)1024 * 512 * 2;
constexpr size_t WS_WO = WS_WB + (size_t)1024 * 1024 * 2;
constexpr size_t WS_WG = WS_WO + (size_t)1024 * 1024 * 2;
constexpr size_t WS_WU = WS_WG + (size_t)16 * 512 * 1024 * 2;
constexpr size_t WS_WD = WS_WU + (size_t)16 * 512 * 1024 * 2;
constexpr size_t WS_XB = WS_WD + (size_t)16 * 512 * 1024 * 2;
constexpr size_t WS_X = WS_XB + (size_t)T_ * 1024 * 2;
constexpr size_t WS_MG = WS_X + (size_t)T_ * 1024 * 4;
constexpr size_t WS_KCC = WS_MG + (size_t)T_ * 1024 * 2;
constexpr size_t WS_VCCT = WS_KCC + (size_t)4 * 512 * 64 * 2;
constexpr size_t WS_R = WS_VCCT + (size_t)4 * 512 * 64 * 2;
constexpr size_t WS_P = WS_R;
constexpr size_t WS_VST = WS_P + (size_t)T_ * LD * 2;
constexpr size_t WS_VWT = WS_VST + (size_t)4 * 64 * S_ * 2;
constexpr size_t WS_VRT = WS_VWT + (size_t)4 * 64 * S_ * 2;
constexpr size_t WS_KVT = WS_VRT + (size_t)16 * 128 * S_ * 2;
constexpr size_t WS_SPT = WS_KVT + (size_t)16 * 64 * 8192 * 4;
constexpr size_t WS_YA32 = WS_SPT + (size_t)16 * 64 * 8192 * 2;
constexpr size_t WS_YA = WS_YA32 + (size_t)T_ * 512 * 4;
constexpr size_t WS_YB = WS_YA + (size_t)T_ * 512 * 2;
constexpr size_t WS_ENDA = WS_YB + (size_t)T_ * 1024 * 2;
constexpr size_t WS_H1 = WS_R;
constexpr size_t WS_X1 = WS_H1 + (size_t)T_ * 1024 * 4;
constexpr size_t WS_X1B = WS_X1 + (size_t)T_ * 1024 * 4;
constexpr size_t WS_HB = WS_X1B + (size_t)T_ * 1024 * 2;
constexpr size_t WS_CT = WS_P + (size_t)T_ * LD * 2;
constexpr size_t WS_LIST = WS_CT + (size_t)2 * T_ * 1024 * 2;
constexpr size_t WS_WTS = WS_LIST + (size_t)16 * T_ * 4;
constexpr size_t WS_ENDB = WS_WTS + (size_t)2 * T_ * 4;
static_assert(WS_HB + (size_t)2 * T_ * 512 * 2 <= WS_CT, "view B overlap");
constexpr size_t WS_END = WS_ENDA > WS_ENDB ? WS_ENDA : WS_ENDB;

constexpr int CW_CNT = 4096;
constexpr int CW_BAR = 8192;

constexpr int LDS_BYTES = 75776;
constexpr int NTHREADS = 256;

struct Params {
    const float* x; const float* w_in; const float* cmp_pos; const float* cmp_w1; const float* cmp_w2;
    const float* w_br_a; const float* w_br_b; const float* w_o; const float* ln1_g; const float* ln1_b;
    const float* w_router; const float* router_bias; const float* w_gate; const float* w_up; const float* w_down;
    const float* ln2_g; const float* ln2_b; const float* rel_bias;
    float* out; unsigned char* ws;
    int ph_lo, ph_hi;
};

__device__ __forceinline__ bf16_t f2bf(float f) { unsigned u = __float_as_uint(f); u += 0x7fffu + ((u >> 16) & 1u); return (bf16_t)(u >> 16); }
__device__ __forceinline__ float bf2f(unsigned h) { return __uint_as_float(h << 16); }
__device__ __forceinline__ unsigned pack2(float lo, float hi) { return (unsigned)f2bf(lo) | ((unsigned)f2bf(hi) << 16); }
__device__ __forceinline__ u32x2 pack4(f32x4 v) { u32x2 r; r.x = pack2(v[0], v[1]); r.y = pack2(v[2], v[3]); return r; }
__device__ __forceinline__ f32x4 unpack4(u32x2 u) { f32x4 r; r[0] = bf2f(u.x & 0xffffu); r[1] = bf2f(u.x >> 16); r[2] = bf2f(u.y & 0xffffu); r[3] = bf2f(u.y >> 16); return r; }
__device__ __forceinline__ float sigmoidf_(float x) { return 1.f / (1.f + __expf(-x)); }
__device__ __forceinline__ int vzero() { int z; asm volatile("v_mov_b32 %0, 0" : "=v"(z)); return z; }
__device__ __forceinline__ unsigned char* launder(unsigned char* q) { asm volatile("" : "+s"(q)); return q; }
__device__ __forceinline__ void wait_vm0() { asm volatile("s_waitcnt vmcnt(0)" ::: "memory"); }

__device__ __forceinline__ void glds16(const void* g, void* l) {
    __builtin_amdgcn_global_load_lds((const __attribute__((address_space(1))) unsigned*)g,
                                     (__attribute__((address_space(3))) unsigned*)l, 16, 0, 0);
}
__device__ __forceinline__ f32x4 mfma16(bf16x8 a, bf16x8 b, f32x4 c) { return __builtin_amdgcn_mfma_f32_16x16x32_bf16(a, b, c, 0, 0, 0); }

__device__ __forceinline__ void gemm_stage(const bf16_t* const (&mp)[4], const bf16_t* const (&np)[4], int kt, unsigned char* st, int wid) {
#pragma unroll
    for (int i = 0; i < 4; ++i) {
        glds16(mp[i] + kt * 64, st + (4 * i + wid) * 1024);
        glds16(np[i] + kt * 64, st + 16384 + (4 * i + wid) * 1024);
    }
}
__device__ __forceinline__ void gemm_compute(const unsigned char* st, f32x4 (&acc)[4][4], int wr, int wc, int fr, int fq) {
#pragma unroll
    for (int ks = 0; ks < 2; ++ks) {
        bf16x8 a[4], b[4];
        const int sw = ((4 * ks + fq) ^ (fr & 7)) << 4;
#pragma unroll
        for (int i = 0; i < 4; ++i) {
            a[i] = *(const bf16x8*)(st + (64 * wr + 16 * i + fr) * 128 + sw);
            b[i] = *(const bf16x8*)(st + 16384 + (64 * wc + 16 * i + fr) * 128 + sw);
        }
#pragma unroll
        for (int i = 0; i < 4; ++i)
#pragma unroll
            for (int j = 0; j < 4; ++j) acc[i][j] = mfma16(a[i], b[j], acc[i][j]);
    }
}
__device__ __forceinline__ void gemm_kloop(const bf16_t* const (&mp)[4], const bf16_t* const (&np)[4], int nk, unsigned char* lds, f32x4 (&acc)[4][4]) {
    const int tid = threadIdx.x + vzero(), lane = tid & 63, wid = tid >> 6, wr = wid >> 1, wc = wid & 1, fr = lane & 15, fq = lane >> 4;
    gemm_stage(mp, np, 0, lds, wid);
    wait_vm0(); __syncthreads();
    for (int kt = 0; kt < nk; ++kt) {
        unsigned char* cur = lds + (kt & 1) * 32768;
        if (kt + 1 < nk) gemm_stage(mp, np, kt + 1, lds + ((kt + 1) & 1) * 32768, wid);
        gemm_compute(cur, acc, wr, wc, fr, fq);
        wait_vm0(); __syncthreads();
    }
}
__device__ __forceinline__ void zero_acc(f32x4 (&acc)[4][4]) {
#pragma unroll
    for (int i = 0; i < 4; ++i)
#pragma unroll
        for (int j = 0; j < 4; ++j) acc[i][j] = (f32x4){0.f, 0.f, 0.f, 0.f};
}

__device__ void tcvt_tile(const float* src, int ld_src, int k0, int n0, int mode, bf16_t* dst, int kdst, unsigned char* lds) {
    float* tile = (float*)lds;
    const int tid = threadIdx.x + vzero();
#pragma unroll
    for (int i = 0; i < 4; ++i) {
        const int kk = (tid >> 4) + 16 * i, c4 = (tid & 15) * 4, cd = n0 + c4;
        int orig = cd; bool ok = true;
        if (mode == 1) { if (cd < 1280) orig = cd; else if (cd < 6400) orig = cd + 24; else if (cd < 6424) orig = cd - 6400 + 1280; else ok = false; }
        float4 v = make_float4(0.f, 0.f, 0.f, 0.f);
        if (ok) v = *(const float4*)(src + (size_t)(k0 + kk) * ld_src + orig);
        tile[kk * 65 + c4 + 0] = v.x; tile[kk * 65 + c4 + 1] = v.y; tile[kk * 65 + c4 + 2] = v.z; tile[kk * 65 + c4 + 3] = v.w;
    }
    __syncthreads();
#pragma unroll
    for (int i = 0; i < 2; ++i) {
        const int q = tid + 256 * i, n = q >> 3, kc = q & 7;
        float v[8];
#pragma unroll
        for (int j = 0; j < 8; ++j) v[j] = tile[(kc * 8 + j) * 65 + n];
        u32x4 w; w.x = pack2(v[0], v[1]); w.y = pack2(v[2], v[3]); w.z = pack2(v[4], v[5]); w.w = pack2(v[6], v[7]);
        *(u32x4*)(dst + (size_t)(n0 + n) * kdst + k0 + kc * 8) = w;
    }
    __syncthreads();
}

__device__ void phase_pw(const Params& p, int layer, unsigned char* lds) {
    const int bid = blockIdx.x, nblk = gridDim.x, tid = threadIdx.x + vzero();
    unsigned char* ws = launder(p.ws);
    constexpr int J0 = 16 * 102, J1 = 8 * 16, J2 = 256, J3 = 256, J4 = 2048, J5 = 2048, J6 = 2048, JT = J0 + J1 + J2 + J3 + J4 + J5 + J6;
    for (int t = bid; t < JT; t += nblk) {
        int u = t;
        if (u < J0) { tcvt_tile(p.w_in + (size_t)layer * 1024 * DIN, DIN, (u % 16) * 64, (u / 16) * 64, 1, (bf16_t*)(ws + WS_WIN), 1024, lds); continue; }
        u -= J0;
        if (u < J1) { tcvt_tile(p.w_br_a + (size_t)layer * 512 * 1024, 1024, (u % 8) * 64, (u / 8) * 64, 0, (bf16_t*)(ws + WS_WA), 512, lds); continue; }
        u -= J1;
        if (u < J2) { tcvt_tile(p.w_br_b + (size_t)layer * 1024 * 1024, 1024, (u % 16) * 64, (u / 16) * 64, 0, (bf16_t*)(ws + WS_WB), 1024, lds); continue; }
        u -= J2;
        if (u < J3) { tcvt_tile(p.w_o + (size_t)layer * 1024 * 1024, 1024, (u % 16) * 64, (u / 16) * 64, 0, (bf16_t*)(ws + WS_WO), 1024, lds); continue; }
        u -= J3;
        if (u < J4 + J5) {
            const bool up = u >= J4; if (up) u -= J4;
            const int e = u / 128, v = u % 128;
            const float* src = (up ? p.w_up : p.w_gate) + ((size_t)layer * NE + e) * 1024 * 512;
            tcvt_tile(src, 512, (v % 16) * 64, (v / 16) * 64, 0, (bf16_t*)(ws + (up ? WS_WU : WS_WG)) + (size_t)e * 512 * 1024, 1024, lds); continue;
        }
        u -= J4 + J5;
        { const int e = u / 128, v = u % 128;
          const float* src = p.w_down + ((size_t)layer * NE + e) * 512 * 1024;
          tcvt_tile(src, 1024, (v % 8) * 64, (v / 8) * 64, 0, (bf16_t*)(ws + WS_WD) + (size_t)e * 1024 * 512, 512, lds); }
    }
    if (layer == 0) {
        const float4* xs = (const float4*)p.x; u32x2* xb = (u32x2*)(ws + WS_XB);
        for (size_t i = (size_t)bid * NTHREADS + tid; i < (size_t)T_ * 1024 / 4; i += (size_t)nblk * NTHREADS) {
            float4 v = xs[i]; u32x2 w; w.x = pack2(v.x, v.y); w.y = pack2(v.z, v.w); xb[i] = w;
        }
        for (int n = bid * NTHREADS + tid; n < 8192; n += nblk * NTHREADS) {
            int bk;
            if (n < 16) bk = n;
            else { const int th[15] = {22, 30, 40, 54, 73, 99, 134, 182, 246, 332, 450, 609, 825, 1117, 1513}; bk = 16;
#pragma unroll
                for (int k = 0; k < 15; ++k) bk += (n >= th[k]) ? 1 : 0; }
            (ws + WS_BUCKET)[n] = (unsigned char)bk;
        }
        for (int i = bid * NTHREADS + tid; i < 8192 * 32; i += nblk * NTHREADS) {
            const int pos = i >> 5, d = i & 31;
            const float inv = powf(10000.f, -(float)d * 2.0f / 64.f);
            const float ang = (float)pos * inv;
            float sn, cs; sincosf(ang, &sn, &cs);
            ((float2*)(ws + WS_ROPE))[i] = make_float2(cs, sn);
        }
        if (bid == 0 && tid < 64) ((unsigned*)(ws + WS_CTL))[CW_CNT + tid] = 0u;
    }
}

__device__ void phase_g1(const Params& p, int layer, unsigned char* lds) {
    unsigned char* ws = launder(p.ws);
    const bf16_t* XB = (const bf16_t*)(ws + WS_XB);
    const bf16_t* WT = (const bf16_t*)(ws + WS_WIN);
    bf16_t* P = (bf16_t*)(ws + WS_P);
    const int tid = threadIdx.x + vzero(), lane = tid & 63, wid = tid >> 6, wr = wid >> 1, wc = wid & 1, fr = lane & 15, fq = lane >> 4;
    const int ldrow = 8 * wid + (lane >> 3), ldc = ((lane & 7) ^ (lane >> 3)) * 8;
    const float2* rope = (const float2*)(ws + WS_ROPE);
    for (int t = blockIdx.x; t < 128 * 51; t += gridDim.x) {
        const int mt = t / 51, nt = t % 51, m0 = mt * 128, n0 = nt * 128;
        const bool transposed = (nt == 7) || (nt == 9) || (nt >= 18 && nt <= 25);
        const bf16_t* mp[4]; const bf16_t* np[4];
#pragma unroll
        for (int i = 0; i < 4; ++i) {
            const bf16_t* wrow = WT + (size_t)(n0 + 32 * i + ldrow) * 1024 + ldc;
            const bf16_t* xrow = XB + (size_t)(m0 + 32 * i + ldrow) * 1024 + ldc;
            mp[i] = transposed ? xrow : wrow; np[i] = transposed ? wrow : xrow;
        }
        f32x4 acc[4][4]; zero_acc(acc);
        gemm_kloop(mp, np, 16, lds, acc);
        if (!transposed) {
            const int kind = (nt >= 10 && nt <= 13) ? 1 : (nt >= 14 && nt <= 17) ? 2 : (nt >= 26 && nt <= 33) ? 3 : (nt >= 34) ? 4 : 0;
            if (kind == 1 || kind == 2) {
                const float sc = (kind == 2) ? 0.125f : 1.0f;
#pragma unroll
                for (int ni = 0; ni < 4; ++ni) {
                    const int tok = m0 + 64 * wc + 16 * ni + fr, pos = tok & (S_ - 1);
#pragma unroll
                    for (int mi = 0; mi < 2; ++mi) {
                        const int d = 16 * mi + 4 * fq;
                        const float4 cs01 = *(const float4*)(rope + pos * 32 + d), cs23 = *(const float4*)(rope + pos * 32 + d + 2);
                        const float c[4] = {cs01.x, cs01.z, cs23.x, cs23.z}, s[4] = {cs01.y, cs01.w, cs23.y, cs23.w};
                        f32x4 x1 = acc[mi][ni], x2 = acc[mi + 2][ni], y1, y2;
#pragma unroll
                        for (int r = 0; r < 4; ++r) { y1[r] = (x1[r] * c[r] - x2[r] * s[r]) * sc; y2[r] = (x1[r] * s[r] + x2[r] * c[r]) * sc; }
                        acc[mi][ni] = y1; acc[mi + 2][ni] = y2;
                    }
                }
            }
#pragma unroll
            for (int mi = 0; mi < 4; ++mi)
#pragma unroll
                for (int ni = 0; ni < 4; ++ni) {
                    const int n = n0 + 64 * wr + 16 * mi + 4 * fq, tok = m0 + 64 * wc + 16 * ni + fr;
                    f32x4 v = acc[mi][ni];
                    if (kind == 3) {
#pragma unroll
                        for (int r = 0; r < 4; ++r) v[r] = v[r] * sigmoidf_(v[r]);
                    } else if (kind == 4) {
#pragma unroll
                        for (int r = 0; r < 4; ++r) v[r] = sigmoidf_(v[r]);
                    }
                    *(u32x2*)(P + (size_t)tok * LD + n) = pack4(v);
                }
        } else {
#pragma unroll
            for (int mi = 0; mi < 4; ++mi)
#pragma unroll
                for (int ni = 0; ni < 4; ++ni) {
                    const int tok = m0 + 64 * wr + 16 * mi + 4 * fq, n = n0 + 64 * wc + 16 * ni + fr;
                    const int b = tok >> 13, s = tok & (S_ - 1);
                    bf16_t* dst;
                    if (nt == 7) { const int c = n - C_VS; dst = (bf16_t*)(ws + WS_VST) + ((size_t)(b * 2 + (c >> 6)) * 64 + (c & 63)) * S_ + s; }
                    else if (nt == 9) { const int c = n - C_VW; dst = (bf16_t*)(ws + WS_VWT) + ((size_t)(b * 2 + (c >> 6)) * 64 + (c & 63)) * S_ + s; }
                    else { const int c = n - C_VR; dst = (bf16_t*)(ws + WS_VRT) + ((size_t)(b * 8 + (c >> 7)) * 128 + (c & 127)) * S_ + s; }
                    *(u32x2*)dst = pack4(acc[mi][ni]);
                }
        }
    }
}

__device__ __forceinline__ void load_tile64(const bf16_t* base, size_t rowStride, unsigned char* dst, int wid, int lane) {
    const int c = ((lane & 7) ^ (lane >> 3)) * 8;
#pragma unroll
    for (int i = 0; i < 2; ++i) { const int j = wid + 4 * i, row = 8 * j + (lane >> 3); glds16(base + (size_t)row * rowStride + c, dst + j * 1024); }
}
__device__ __forceinline__ void load_tile128(const bf16_t* base, size_t rowStride, unsigned char* dst, int wid, int lane) {
    const int c = ((lane & 7) ^ (lane >> 3)) * 8;
#pragma unroll
    for (int i = 0; i < 4; ++i) { const int j = wid + 4 * i, row = 8 * j + (lane >> 3); glds16(base + (size_t)row * rowStride + c, dst + j * 1024); }
}
__device__ __forceinline__ void load_tile128w(const bf16_t* base, size_t rowStride, unsigned char* dst, int wid, int lane) {
    const int c = ((lane & 15) ^ ((4 * wid + (lane >> 4)) & 15)) * 8;
#pragma unroll
    for (int i = 0; i < 8; ++i) { const int j = wid + 4 * i, row = 4 * j + (lane >> 4); glds16(base + (size_t)row * rowStride + c, dst + j * 1024); }
}
__device__ __forceinline__ bf16x8 lds_frag128(const unsigned char* tile, int row, int chunk) {
    return *(const bf16x8*)(tile + row * 128 + ((chunk ^ (row & 7)) << 4));
}
__device__ __forceinline__ bf16x8 lds_frag256(const unsigned char* tile, int row, int chunk) {
    return *(const bf16x8*)(tile + row * 256 + ((chunk ^ (row & 15)) << 4));
}
__device__ __forceinline__ bf16x8 lds_vfrag128(const unsigned char* tile, int row, int kbase, int fq) {
    const int ca = (kbase >> 3) + (fq >> 1), hb = (fq & 1) * 8;
    const u32x2 a = *(const u32x2*)(tile + row * 128 + ((ca ^ (row & 7)) << 4) + hb);
    const u32x2 b = *(const u32x2*)(tile + row * 128 + (((ca + 2) ^ (row & 7)) << 4) + hb);
    u32x4 w; w.x = a.x; w.y = a.y; w.z = b.x; w.w = b.y;
    return __builtin_bit_cast(bf16x8, w);
}
__device__ __forceinline__ bf16x8 lds_vfrag256(const unsigned char* tile, int row, int kbase, int fq) {
    const int ca = (kbase >> 3) + (fq >> 1), hb = (fq & 1) * 8;
    const u32x2 a = *(const u32x2*)(tile + row * 256 + ((ca ^ (row & 15)) << 4) + hb);
    const u32x2 b = *(const u32x2*)(tile + row * 256 + (((ca + 2) ^ (row & 15)) << 4) + hb);
    u32x4 w; w.x = a.x; w.y = a.y; w.z = b.x; w.w = b.y;
    return __builtin_bit_cast(bf16x8, w);
}
__device__ __forceinline__ bf16x8 pack8(f32x4 a, f32x4 b) {
    u32x4 w; w.x = pack2(a[0], a[1]); w.y = pack2(a[2], a[3]); w.z = pack2(b[0], b[1]); w.w = pack2(b[2], b[3]);
    return __builtin_bit_cast(bf16x8, w);
}

__device__ __forceinline__ float gelu_tanh(float x) {
    const float u = 0.7978845608028654f * (x + 0.044715f * x * x * x);
    return 0.5f * x * (1.f + tanhf(u));
}
__device__ void compress_item(const Params& p, int layer, int item, unsigned char* lds) {
    unsigned char* ws = launder(p.ws);
    const int tid = threadIdx.x + vzero(), lane = tid & 63, wid = tid >> 6;
    const int task = item * 4 + wid;
    const int grp = task & 63, combo = task >> 6;
    const int kv = combo >> 2, b = (combo >> 1) & 1, g = combo & 1;
    const float* pos = p.cmp_pos + ((size_t)layer * 2 + kv) * 32 * 64;
    const float* w1 = p.cmp_w1 + ((size_t)layer * 2 + kv) * 2048 * 64;
    const float* w2 = p.cmp_w2 + ((size_t)layer * 2 + kv) * 64 * 64;
    const bf16_t* P = (const bf16_t*)(ws + WS_P) + vzero();
    const int col = (kv ? C_VC : C_KC) + g * 64;
    float acc[8];
#pragma unroll
    for (int j = 0; j < 8; ++j) acc[j] = 0.f;
    const int i0 = grp * 8;
    for (int l = 0; l < 32; ++l) {
        for (int d = 0; d < 64; ++d) {
            const float w = w1[(size_t)(l * 64 + d) * 64 + lane];
            const float ps = pos[l * 64 + d];
#pragma unroll
            for (int j = 0; j < 8; ++j) {
                int tk = 16 * (i0 + j) + l; tk = tk < S_ ? tk : S_ - 1;
                const float v = bf2f(P[((size_t)b * S_ + tk) * LD + col + d]) + ps;
                acc[j] += v * w;
            }
        }
    }
    float* hid = (float*)lds + wid * 512;
#pragma unroll
    for (int j = 0; j < 8; ++j) hid[j * 64 + lane] = gelu_tanh(acc[j]);
    __syncthreads();
    float o[8];
#pragma unroll
    for (int j = 0; j < 8; ++j) o[j] = 0.f;
    for (int n = 0; n < 64; ++n) {
        const float w = w2[n * 64 + lane];
#pragma unroll
        for (int j = 0; j < 8; ++j) o[j] += hid[j * 64 + n] * w;
    }
#pragma unroll
    for (int j = 0; j < 8; ++j) {
        const int ci = i0 + j;
        const float v = ci < 511 ? o[j] : 0.f;
        if (kv == 0) ((bf16_t*)(ws + WS_KCC))[((size_t)(b * 2 + g) * 512 + ci) * 64 + lane] = f2bf(v);
        else ((bf16_t*)(ws + WS_VCCT))[((size_t)(b * 2 + g) * 64 + lane) * 512 + ci] = f2bf(v);
    }
    __syncthreads();
}

__device__ __forceinline__ float ret_lg2(int h) { const float gam = 1.f - exp2f(-5.f - (float)h); return log2f(gam); }

__device__ void retkv_item(const Params& p, int item, unsigned char* lds) {
    unsigned char* ws = launder(p.ws);
    const int tid = threadIdx.x + vzero(), lane = tid & 63, wid = tid >> 6, fr = lane & 15, fq = lane >> 4;
    const int n = item & 63, h = (item >> 6) & 7, b = item >> 9;
    const size_t tok0 = (size_t)b * S_ + 128 * n;
    unsigned char* vL = lds; unsigned char* kL = lds + 32768;
    load_tile128w((const bf16_t*)(ws + WS_VRT) + ((size_t)(b * 8 + h) * 128) * S_ + 128 * n, S_, vL, wid, lane);
    load_tile128((const bf16_t*)(ws + WS_P) + tok0 * LD + C_KR + h * 64, LD, kL, wid, lane);
    wait_vm0(); __syncthreads();
    const float lg2 = ret_lg2(h);
    f32x4 acc[2][4];
#pragma unroll
    for (int m = 0; m < 2; ++m)
#pragma unroll
        for (int nt = 0; nt < 4; ++nt) acc[m][nt] = (f32x4){0.f, 0.f, 0.f, 0.f};
#pragma unroll
    for (int ks = 0; ks < 4; ++ks) {
        bf16x8 a[2], bb[4];
#pragma unroll
        for (int m = 0; m < 2; ++m) a[m] = lds_frag256(vL, 32 * wid + 16 * m + fr, 4 * ks + fq);
        float dec[8];
#pragma unroll
        for (int j = 0; j < 8; ++j) dec[j] = exp2f((float)(127 - (32 * ks + 8 * fq + j)) * lg2);
#pragma unroll
        for (int nt = 0; nt < 4; ++nt) {
            const int d = 16 * nt + fr;
            float v[8];
#pragma unroll
            for (int j = 0; j < 8; ++j) {
                const int tk = 32 * ks + 8 * fq + j;
                const bf16_t kvv = *(const bf16_t*)(kL + tk * 128 + (((d >> 3) ^ (tk & 7)) << 4) + (d & 7) * 2);
                v[j] = bf2f(kvv) * dec[j];
            }
            u32x4 w; w.x = pack2(v[0], v[1]); w.y = pack2(v[2], v[3]); w.z = pack2(v[4], v[5]); w.w = pack2(v[6], v[7]);
            bb[nt] = __builtin_bit_cast(bf16x8, w);
        }
#pragma unroll
        for (int m = 0; m < 2; ++m)
#pragma unroll
            for (int nt = 0; nt < 4; ++nt) acc[m][nt] = mfma16(a[m], bb[nt], acc[m][nt]);
    }
    float* KVT = (float*)(ws + WS_KVT) + ((size_t)(b * 8 + h) * 64 + n) * 8192;
#pragma unroll
    for (int m = 0; m < 2; ++m)
#pragma unroll
        for (int nt = 0; nt < 4; ++nt)
#pragma unroll
            for (int r = 0; r < 4; ++r) KVT[(32 * wid + 16 * m + 4 * fq + r) * 64 + 16 * nt + fr] = acc[m][nt][r];
    __syncthreads();
}

__device__ void phase_p2(const Params& p, int layer, unsigned char* lds) {
    for (int it = blockIdx.x; it < 1024 + 128; it += gridDim.x) {
        if (it < 1024) retkv_item(p, it, lds); else compress_item(p, layer, it - 1024, lds);
    }
}

constexpr int NSA_IMP = 32768, NSA_BUCKET = 65792, NSA_BIAS = 73984;

struct NsaLane { int t; int fr, fq, wid, lane; };

template <int BR, int PASS>
__device__ __forceinline__ void nsa_half(const unsigned char* kL, const unsigned char* vL, const unsigned char* lds, const bf16_t* qptr,
                                         f32x4 (&O)[4][4], float (&m)[4], float (&l)[4], int tile, int hf, bool selbit, const NsaLane& L, int qrow) {
    const int fr = L.fr, fq = L.fq;
    bf16x8 Kf[2][2];
#pragma unroll
    for (int i = 0; i < 2; ++i)
#pragma unroll
        for (int ks = 0; ks < 2; ++ks) Kf[i][ks] = lds_frag128(kL, 32 * hf + 16 * i + fr, 4 * ks + fq);
    unsigned vmask = 0; unsigned bk[2];
    const unsigned char* bucketL = lds + NSA_BUCKET;
#pragma unroll
    for (int i = 0; i < 2; ++i) {
        unsigned pk = 0;
#pragma unroll
        for (int r = 0; r < 4; ++r) {
            const int kk = 32 * hf + 16 * i + 4 * fq + r;
            int rel; bool ok;
            if (BR == 0) { rel = L.t - (16 * (64 * tile + kk) + 31); ok = rel >= 0; }
            else if (BR == 1) { rel = L.t - (64 * tile + kk); ok = selbit && rel >= 0; }
            else { rel = L.t - (64 * tile + kk); ok = rel >= 0 && rel < 512; }
            int rc = rel < 0 ? 0 : rel; rc = rc > 8191 ? 8191 : rc;
            pk |= (unsigned)bucketL[rc] << (8 * r);
            vmask |= (ok ? 1u : 0u) << (4 * i + r);
        }
        bk[i] = pk;
    }
    const float* biasL = (const float*)(lds + NSA_BIAS);
    float ia[2] = {0.f, 0.f}, ic[2] = {0.f, 0.f};
#pragma unroll
    for (int nt = 0; nt < 4; ++nt) {
        asm volatile("" ::: "memory");
        f32x4 S[2];
        const bf16x8 q0 = *(const bf16x8*)(qptr + nt * 64), q1 = *(const bf16x8*)(qptr + nt * 64 + 32);
#pragma unroll
        for (int i = 0; i < 2; ++i) {
            S[i] = (f32x4){0.f, 0.f, 0.f, 0.f};
            S[i] = mfma16(Kf[i][0], q0, S[i]); S[i] = mfma16(Kf[i][1], q1, S[i]);
        }
        float tmax = -1e30f;
#pragma unroll
        for (int i = 0; i < 2; ++i)
#pragma unroll
            for (int r = 0; r < 4; ++r) {
                const float bias = biasL[nt * 32 + ((bk[i] >> (8 * r)) & 0xffu)];
                const bool ok = (vmask >> (4 * i + r)) & 1u;
                const float sv = ok ? S[i][r] * 0.125f + bias : -1e30f;
                S[i][r] = sv; tmax = fmaxf(tmax, sv);
            }
        if (PASS != 1) {
            tmax = fmaxf(tmax, __shfl_xor(tmax, 16)); tmax = fmaxf(tmax, __shfl_xor(tmax, 32));
            const float mnew = fmaxf(m[nt], tmax), alpha = __expf(m[nt] - mnew);
            float psum = 0.f;
#pragma unroll
            for (int i = 0; i < 2; ++i)
#pragma unroll
                for (int r = 0; r < 4; ++r) {
                    const bool ok = (vmask >> (4 * i + r)) & 1u;
                    const float pv = ok ? __expf(S[i][r] - mnew) : 0.f;
                    S[i][r] = pv; psum += pv;
                }
            psum += __shfl_xor(psum, 16); psum += __shfl_xor(psum, 32);
            l[nt] = l[nt] * alpha + psum; m[nt] = mnew;
            if (PASS == 2) {
#pragma unroll
                for (int mt = 0; mt < 4; ++mt) O[mt][nt] = O[mt][nt] * alpha;
            }
        } else {
#pragma unroll
            for (int i = 0; i < 2; ++i) {
#pragma unroll
                for (int r = 0; r < 4; ++r) {
                    const bool ok = (vmask >> (4 * i + r)) & 1u;
                    S[i][r] = ok ? __expf(S[i][r] - m[nt]) * l[nt] : 0.f;
                }
                ia[i] += S[i][0] + S[i][1] + S[i][2] + 0.5f * S[i][3];
                ic[i] += 0.5f * S[i][3];
            }
        }
        if (PASS != 0) {
            const bf16x8 Pb = pack8(S[0], S[1]);
#pragma unroll
            for (int mt = 0; mt < 4; ++mt) O[mt][nt] = mfma16(lds_vfrag128(vL, 16 * mt + fr, 32 * hf, fq), Pb, O[mt][nt]);
        }
    }
    if (PASS == 1) {
        float* imp = (float*)(lds + NSA_IMP) + qrow * 129;
        asm volatile("" ::: "memory"); __builtin_amdgcn_wave_barrier();
#pragma unroll
        for (int i = 0; i < 2; ++i) { const int j = 16 * tile + 8 * hf + 4 * i + fq; imp[j] += ia[i]; }
        asm volatile("s_waitcnt lgkmcnt(0)" ::: "memory"); __builtin_amdgcn_wave_barrier();
#pragma unroll
        for (int i = 0; i < 2; ++i) { const int j = 16 * tile + 8 * hf + 4 * i + fq + 1; if (j < 128) imp[j] += ic[i]; }
        asm volatile("s_waitcnt lgkmcnt(0)" ::: "memory"); __builtin_amdgcn_wave_barrier();
    }
}
template <int BR, int PASS>
__device__ __forceinline__ void nsa_tile(const unsigned char* kL, const unsigned char* vL, const unsigned char* lds, const bf16_t* qptr,
                                         f32x4 (&O)[4][4], float (&m)[4], float (&l)[4], int tile, bool selbit, const NsaLane& L, int qrow) {
#pragma unroll 1
    for (int hf = 0; hf < 2; ++hf) nsa_half<BR, PASS>(kL, vL, lds, qptr, O, m, l, tile, hf, selbit, L, qrow);
}

__device__ void nsa_item(const Params& p, int item, unsigned char* lds) {
    unsigned char* ws = launder(p.ws);
    const int tid = threadIdx.x + vzero(), lane = tid & 63, wid = tid >> 6, fr = lane & 15, fq = lane >> 4;
    const int combo = item & 3, qt = 127 - (item >> 2), b = combo >> 1, g = combo & 1;
    const int q0 = qt * 64, qrow = 16 * wid + fr;
    NsaLane L; L.t = q0 + qrow; L.fr = fr; L.fq = fq; L.wid = wid; L.lane = lane;
    const size_t tok = (size_t)b * S_ + L.t;
    const bf16_t* P = (const bf16_t*)(ws + WS_P);
    __syncthreads();
    if (tid < 128) ((float*)(lds + NSA_BIAS))[tid] = p.rel_bias[(tid & 31) * 8 + 4 * g + (tid >> 5)];
    for (int i = tid; i < 64 * 129; i += NTHREADS) ((float*)(lds + NSA_IMP))[i] = 0.f;
    const bf16_t* Qf = P + tok * LD + C_QA + (4 * g) * 64 + 8 * fq;
    __syncthreads();
    f32x4 O[4][4]; float m[4], l[4];
    float* YA32 = (float*)(ws + WS_YA32) + tok * 512 + (4 * g) * 64;
    const bf16_t* gates = P + tok * LD + C_GA + (4 * g) * 3;

    const bf16_t* kc = (const bf16_t*)(ws + WS_KCC) + (size_t)(b * 2 + g) * 512 * 64;
    const bf16_t* vc = (const bf16_t*)(ws + WS_VCCT) + (size_t)(b * 2 + g) * 64 * 512;
    const int ntc = ((q0 + 32) >> 4) / 64 + 1;
#pragma unroll
    for (int nt = 0; nt < 4; ++nt) { m[nt] = -1e30f; l[nt] = 0.f; }
    load_tile64(kc, 64, lds, wid, lane);
    wait_vm0(); __syncthreads();
    for (int it = 0; it < ntc; ++it) {
        unsigned char* cur = lds + (it & 1) * 16384;
        if (it + 1 < ntc) load_tile64(kc + (size_t)(it + 1) * 64 * 64, 64, lds + ((it + 1) & 1) * 16384, wid, lane);
        nsa_tile<0, 0>(cur, cur + 8192, lds, Qf, O, m, l, it, true, L, qrow);
        wait_vm0(); __syncthreads();
    }
#pragma unroll
    for (int nt = 0; nt < 4; ++nt) l[nt] = l[nt] > 0.f ? 1.f / l[nt] : 0.f;
#pragma unroll
    for (int mt = 0; mt < 4; ++mt)
#pragma unroll
        for (int nt = 0; nt < 4; ++nt) O[mt][nt] = (f32x4){0.f, 0.f, 0.f, 0.f};
    load_tile64(kc, 64, lds, wid, lane); load_tile64(vc, 512, lds + 8192, wid, lane);
    wait_vm0(); __syncthreads();
    for (int it = 0; it < ntc; ++it) {
        unsigned char* cur = lds + (it & 1) * 16384;
        if (it + 1 < ntc) { unsigned char* nx = lds + ((it + 1) & 1) * 16384;
            load_tile64(kc + (size_t)(it + 1) * 64 * 64, 64, nx, wid, lane); load_tile64(vc + (it + 1) * 64, 512, nx + 8192, wid, lane); }
        nsa_tile<0, 1>(cur, cur + 8192, lds, Qf, O, m, l, it, true, L, qrow);
        wait_vm0(); __syncthreads();
    }
#pragma unroll
    for (int nt = 0; nt < 4; ++nt) {
        const float gt = bf2f(gates[nt * 3 + 0]);
#pragma unroll
        for (int mt = 0; mt < 4; ++mt) *(f32x4*)(YA32 + nt * 64 + 16 * mt + 4 * fq) = O[mt][nt] * gt;
    }
    const int cur = qt;
    unsigned selw[4];
    {
        float* imp = (float*)(lds + NSA_IMP) + qrow * 129 + 32 * fq;
        asm volatile("s_waitcnt lgkmcnt(0)" ::: "memory"); __builtin_amdgcn_wave_barrier();
#pragma unroll
        for (int i = 0; i < 32; ++i) {
            const int j = 32 * fq + i;
            const float v = imp[i];
            imp[i] = j > cur ? -1.f : v + ((j == 0 || j == cur || j == cur - 1) ? 1.0e4f : 0.f);
        }
        unsigned word = 0;
#pragma unroll 1
        for (int round = 0; round < 16; ++round) {
            float bv = imp[0]; int bi = 0;
#pragma unroll
            for (int i = 1; i < 32; ++i) { const float v = imp[i]; if (v > bv) { bv = v; bi = i; } }
            int gi = 32 * fq + bi;
#pragma unroll
            for (int off = 16; off <= 32; off <<= 1) {
                const float ov = __shfl_xor(bv, off); const int oi = __shfl_xor(gi, off);
                if (ov > bv || (ov == bv && oi < gi)) { bv = ov; gi = oi; }
            }
            if (bv >= 0.f && (gi >> 5) == fq) { word |= 1u << (gi & 31); imp[gi & 31] = -2.f; }
        }
#pragma unroll
        for (int pp = 0; pp < 4; ++pp) selw[pp] = (unsigned)__shfl((int)word, fr + 16 * pp);
    }
#pragma unroll
    for (int nt = 0; nt < 4; ++nt) { m[nt] = -1e30f; l[nt] = 0.f; }
#pragma unroll
    for (int mt = 0; mt < 4; ++mt)
#pragma unroll
        for (int nt = 0; nt < 4; ++nt) O[mt][nt] = (f32x4){0.f, 0.f, 0.f, 0.f};
    {
        const bf16_t* kb = P + ((size_t)b * S_) * LD + C_KS + g * 64;
        const bf16_t* vb = (const bf16_t*)(ws + WS_VST) + (size_t)(b * 2 + g) * 64 * S_;
        const int nts = cur + 1;
        load_tile64(kb, LD, lds, wid, lane); load_tile64(vb, S_, lds + 8192, wid, lane);
        wait_vm0(); __syncthreads();
        for (int it = 0; it < nts; ++it) {
            unsigned char* cu = lds + (it & 1) * 16384;
            if (it + 1 < nts) { unsigned char* nx = lds + ((it + 1) & 1) * 16384;
                load_tile64(kb + (size_t)(it + 1) * 64 * LD, LD, nx, wid, lane); load_tile64(vb + (it + 1) * 64, S_, nx + 8192, wid, lane); }
            const unsigned w = it < 32 ? selw[0] : it < 64 ? selw[1] : it < 96 ? selw[2] : selw[3];
            const bool sb = (w >> (it & 31)) & 1u;
            if (__ballot(sb) != 0ull) nsa_tile<1, 2>(cu, cu + 8192, lds, Qf, O, m, l, it, sb, L, qrow);
            wait_vm0(); __syncthreads();
        }
    }
#pragma unroll
    for (int nt = 0; nt < 4; ++nt) {
        const float gt = bf2f(gates[nt * 3 + 1]) * (l[nt] > 0.f ? 1.f / l[nt] : 0.f);
#pragma unroll
        for (int mt = 0; mt < 4; ++mt) { f32x4* q = (f32x4*)(YA32 + nt * 64 + 16 * mt + 4 * fq); *q = *q + O[mt][nt] * gt; }
    }
#pragma unroll
    for (int nt = 0; nt < 4; ++nt) { m[nt] = -1e30f; l[nt] = 0.f; }
#pragma unroll
    for (int mt = 0; mt < 4; ++mt)
#pragma unroll
        for (int nt = 0; nt < 4; ++nt) O[mt][nt] = (f32x4){0.f, 0.f, 0.f, 0.f};
    {
        const bf16_t* kb = P + ((size_t)b * S_) * LD + C_KW + g * 64;
        const bf16_t* vb = (const bf16_t*)(ws + WS_VWT) + (size_t)(b * 2 + g) * 64 * S_;
        const int k_lo = qt - 8 > 0 ? qt - 8 : 0, ntw = qt - k_lo + 1;
        load_tile64(kb + (size_t)k_lo * 64 * LD, LD, lds, wid, lane); load_tile64(vb + k_lo * 64, S_, lds + 8192, wid, lane);
        wait_vm0(); __syncthreads();
        for (int it = 0; it < ntw; ++it) {
            unsigned char* cu = lds + (it & 1) * 16384;
            if (it + 1 < ntw) { unsigned char* nx = lds + ((it + 1) & 1) * 16384;
                load_tile64(kb + (size_t)(k_lo + it + 1) * 64 * LD, LD, nx, wid, lane); load_tile64(vb + (k_lo + it + 1) * 64, S_, nx + 8192, wid, lane); }
            nsa_tile<2, 2>(cu, cu + 8192, lds, Qf, O, m, l, k_lo + it, true, L, qrow);
            wait_vm0(); __syncthreads();
        }
    }
    bf16_t* YA = (bf16_t*)(ws + WS_YA) + tok * 512 + (4 * g) * 64;
#pragma unroll
    for (int nt = 0; nt < 4; ++nt) {
        const float gt = bf2f(gates[nt * 3 + 2]) * (l[nt] > 0.f ? 1.f / l[nt] : 0.f);
#pragma unroll
        for (int mt = 0; mt < 4; ++mt) {
            const f32x4 v = *(const f32x4*)(YA32 + nt * 64 + 16 * mt + 4 * fq) + O[mt][nt] * gt;
            *(u32x2*)(YA + nt * 64 + 16 * mt + 4 * fq) = pack4(v);
        }
    }
}

__device__ void scan_item(const Params& p, int item) {
    unsigned char* ws = launder(p.ws);
    const int idx = item * NTHREADS + threadIdx.x;
    const int bh = idx >> 13, ed = idx & 8191, h = bh & 7;
    const float dec = exp2f(128.f * ret_lg2(h));
    const float* KVT = (const float*)(ws + WS_KVT) + (size_t)bh * 64 * 8192 + ed;
    bf16_t* SPT = (bf16_t*)(ws + WS_SPT) + (size_t)bh * 64 * 8192 + ed;
    float s = 0.f;
    for (int n = 0; n < 64; ++n) { SPT[(size_t)n * 8192] = f2bf(s); s = s * dec + KVT[(size_t)n * 8192]; }
}

__device__ void phase_p3(const Params& p, unsigned char* lds) {
    for (int i = threadIdx.x; i < 8192 / 16; i += NTHREADS) ((u32x4*)(lds + NSA_BUCKET))[i] = ((const u32x4*)(p.ws + WS_BUCKET))[i];
    __syncthreads();
    for (int it = blockIdx.x; it < 512 + 512; it += gridDim.x) {
        if (it < 512) nsa_item(p, it, lds); else scan_item(p, it - 512);
    }
}

__device__ void retout_item(const Params& p, int item, unsigned char* lds) {
    unsigned char* ws = launder(p.ws);
    const int tid = threadIdx.x + vzero(), lane = tid & 63, wid = tid >> 6, fr = lane & 15, fq = lane >> 4;
    const int n = item & 63, h = (item >> 6) & 7, b = item >> 9;
    const size_t tok0 = (size_t)b * S_ + 128 * n;
    const bf16_t* P = (const bf16_t*)(ws + WS_P);
    unsigned char* vL = lds; unsigned char* kL = lds + 32768; unsigned char* sL = lds + 49152;
    __syncthreads();
    load_tile128w((const bf16_t*)(ws + WS_VRT) + ((size_t)(b * 8 + h) * 128) * S_ + 128 * n, S_, vL, wid, lane);
    load_tile128(P + tok0 * LD + C_KR + h * 64, LD, kL, wid, lane);
    load_tile128((const bf16_t*)(ws + WS_SPT) + ((size_t)(b * 8 + h) * 64 + n) * 8192, 64, sL, wid, lane);
    bf16x8 Qf[2][2];
#pragma unroll
    for (int nt = 0; nt < 2; ++nt)
#pragma unroll
        for (int ks = 0; ks < 2; ++ks) Qf[nt][ks] = *(const bf16x8*)(P + (tok0 + 32 * wid + 16 * nt + fr) * LD + C_QR + h * 64 + 32 * ks + 8 * fq);
    wait_vm0(); __syncthreads();
    const float lg2 = ret_lg2(h);
    f32x4 Y[8][2];
#pragma unroll
    for (int m = 0; m < 8; ++m)
#pragma unroll
        for (int nt = 0; nt < 2; ++nt) Y[m][nt] = (f32x4){0.f, 0.f, 0.f, 0.f};
#pragma unroll
    for (int m = 0; m < 8; ++m)
#pragma unroll
        for (int ks = 0; ks < 2; ++ks) {
            const bf16x8 a = lds_frag128(sL, 16 * m + fr, 4 * ks + fq);
#pragma unroll
            for (int nt = 0; nt < 2; ++nt) Y[m][nt] = mfma16(a, Qf[nt][ks], Y[m][nt]);
        }
#pragma unroll
    for (int nt = 0; nt < 2; ++nt) {
        const float sc = exp2f((float)(32 * wid + 16 * nt + fr + 1) * lg2);
#pragma unroll
        for (int m = 0; m < 8; ++m) Y[m][nt] = Y[m][nt] * sc;
    }
#pragma unroll 1
    for (int s = 0; s < 4; ++s) {
        f32x4 St[2][2];
#pragma unroll
        for (int hh = 0; hh < 2; ++hh) {
            const int mt = 2 * s + hh;
#pragma unroll
            for (int nt = 0; nt < 2; ++nt) St[hh][nt] = (f32x4){0.f, 0.f, 0.f, 0.f};
#pragma unroll
            for (int ks = 0; ks < 2; ++ks) {
                const bf16x8 a = lds_frag128(kL, 16 * mt + fr, 4 * ks + fq);
#pragma unroll
                for (int nt = 0; nt < 2; ++nt) St[hh][nt] = mfma16(a, Qf[nt][ks], St[hh][nt]);
            }
#pragma unroll
            for (int nt = 0; nt < 2; ++nt) {
                const int qi = 32 * wid + 16 * nt + fr;
#pragma unroll
                for (int r = 0; r < 4; ++r) {
                    const int kj = 16 * mt + 4 * fq + r;
                    const float dm = qi >= kj ? exp2f((float)(qi - kj) * lg2) : 0.f;
                    St[hh][nt][r] *= dm;
                }
            }
        }
        bf16x8 Pb[2];
#pragma unroll
        for (int nt = 0; nt < 2; ++nt) Pb[nt] = pack8(St[0][nt], St[1][nt]);
#pragma unroll
        for (int m = 0; m < 8; ++m) {
            const bf16x8 a = lds_vfrag256(vL, 16 * m + fr, 32 * s, fq);
#pragma unroll
            for (int nt = 0; nt < 2; ++nt) Y[m][nt] = mfma16(a, Pb[nt], Y[m][nt]);
        }
    }
    bf16_t* YB = (bf16_t*)(ws + WS_YB);
#pragma unroll
    for (int nt = 0; nt < 2; ++nt) {
        float sum = 0.f;
#pragma unroll
        for (int m = 0; m < 8; ++m) sum += Y[m][nt][0] + Y[m][nt][1] + Y[m][nt][2] + Y[m][nt][3];
        sum += __shfl_xor(sum, 16); sum += __shfl_xor(sum, 32);
        const float mu = sum * (1.f / 128.f);
        float vs = 0.f;
#pragma unroll
        for (int m = 0; m < 8; ++m)
#pragma unroll
            for (int r = 0; r < 4; ++r) { const float dlt = Y[m][nt][r] - mu; vs += dlt * dlt; }
        vs += __shfl_xor(vs, 16); vs += __shfl_xor(vs, 32);
        const float rstd = rsqrtf(vs * (1.f / 128.f) + 1e-5f);
        const size_t tk = tok0 + 32 * wid + 16 * nt + fr;
#pragma unroll
        for (int m = 0; m < 8; ++m) {
            const f32x4 gt = unpack4(*(const u32x2*)(P + tk * LD + C_GR + h * 128 + 16 * m + 4 * fq));
            f32x4 v;
#pragma unroll
            for (int r = 0; r < 4; ++r) v[r] = (Y[m][nt][r] - mu) * rstd * gt[r];
            *(u32x2*)(YB + tk * 1024 + h * 128 + 16 * m + 4 * fq) = pack4(v);
        }
    }
}
__device__ void phase_p4(const Params& p, unsigned char* lds) {
    for (int it = blockIdx.x; it < 1024; it += gridDim.x) retout_item(p, it, lds);
}

__device__ void phase_g2(const Params& p, unsigned char* lds) {
    unsigned char* ws = launder(p.ws);
    const bf16_t* P = (const bf16_t*)(ws + WS_P);
    for (int t = blockIdx.x; t < 128 * 8; t += gridDim.x) {
        const int mt = t >> 3, nt = t & 7, m0 = mt * 128, n0 = nt * 128;
        const int tid = threadIdx.x + vzero(), lane = tid & 63, wid = tid >> 6, wr = wid >> 1, wc = wid & 1, fr = lane & 15, fq = lane >> 4;
        const int ldrow = 8 * wid + (lane >> 3), ldc = ((lane & 7) ^ (lane >> 3)) * 8;
        const bf16_t* mp[4]; const bf16_t* np[4];
        bf16_t* MG = (bf16_t*)(ws + WS_MG);
        { f32x4 acc1[4][4]; zero_acc(acc1);
#pragma unroll
        for (int i = 0; i < 4; ++i) { mp[i] = (const bf16_t*)(ws + WS_WA) + (size_t)(n0 + 32 * i + ldrow) * 512 + ldc; np[i] = (const bf16_t*)(ws + WS_YA) + (size_t)(m0 + 32 * i + ldrow) * 512 + ldc; }
        gemm_kloop(mp, np, 8, lds, acc1);
#pragma unroll
        for (int mi = 0; mi < 4; ++mi)
#pragma unroll
            for (int ni = 0; ni < 4; ++ni) {
                const int n = n0 + 64 * wr + 16 * mi + 4 * fq; const size_t tok = m0 + 64 * wc + 16 * ni + fr;
                const f32x4 ga = unpack4(*(const u32x2*)(P + tok * LD + C_MA + n));
                *(u32x2*)(MG + tok * 1024 + n) = pack4(ga * acc1[mi][ni]);
            } }
        { f32x4 acc2[4][4]; zero_acc(acc2);
#pragma unroll
        for (int i = 0; i < 4; ++i) { mp[i] = (const bf16_t*)(ws + WS_WB) + (size_t)(n0 + 32 * i + ldrow) * 1024 + ldc; np[i] = (const bf16_t*)(ws + WS_YB) + (size_t)(m0 + 32 * i + ldrow) * 1024 + ldc; }
        gemm_kloop(mp, np, 16, lds, acc2);
#pragma unroll
        for (int mi = 0; mi < 4; ++mi)
#pragma unroll
            for (int ni = 0; ni < 4; ++ni) {
                const int n = n0 + 64 * wr + 16 * mi + 4 * fq; const size_t tok = m0 + 64 * wc + 16 * ni + fr;
                const f32x4 gb = unpack4(*(const u32x2*)(P + tok * LD + C_MB + n));
                const f32x4 v = unpack4(*(const u32x2*)(MG + tok * 1024 + n)) + gb * acc2[mi][ni];
                *(u32x2*)(MG + tok * 1024 + n) = pack4(v);
            } }
    }
}

__device__ void phase_g3(const Params& p, int layer, unsigned char* lds) {
    unsigned char* ws = launder(p.ws);
    const int tid = threadIdx.x + vzero(), lane = tid & 63, wid = tid >> 6, wr = wid >> 1, wc = wid & 1, fr = lane & 15, fq = lane >> 4;
    const int ldrow = 8 * wid + (lane >> 3), ldc = ((lane & 7) ^ (lane >> 3)) * 8;
    const float* X = layer == 0 ? p.x : (const float*)(ws + WS_X);
    float* H1 = (float*)(ws + WS_H1);
    for (int t = blockIdx.x; t < 128 * 8; t += gridDim.x) {
        const int mt = t >> 3, nt = t & 7, m0 = mt * 128, n0 = nt * 128;
        const bf16_t* mp[4]; const bf16_t* np[4];
        f32x4 acc[4][4]; zero_acc(acc);
#pragma unroll
        for (int i = 0; i < 4; ++i) { mp[i] = (const bf16_t*)(ws + WS_WO) + (size_t)(n0 + 32 * i + ldrow) * 1024 + ldc; np[i] = (const bf16_t*)(ws + WS_MG) + (size_t)(m0 + 32 * i + ldrow) * 1024 + ldc; }
        gemm_kloop(mp, np, 16, lds, acc);
#pragma unroll
        for (int mi = 0; mi < 4; ++mi)
#pragma unroll
            for (int ni = 0; ni < 4; ++ni) {
                const int n = n0 + 64 * wr + 16 * mi + 4 * fq; const size_t tok = m0 + 64 * wc + 16 * ni + fr;
                const f32x4 xv = *(const f32x4*)(X + tok * 1024 + n);
                *(f32x4*)(H1 + tok * 1024 + n) = xv * DN_ALPHA + acc[mi][ni];
            }
    }
}

__device__ void phase_ln1(const Params& p, int layer, unsigned char* lds) {
    unsigned char* ws = launder(p.ws);
    const int tid = threadIdx.x + vzero(), lane = tid & 63, wid = tid >> 6;
    float* wrL = (float*)lds;
    for (int i = tid; i < 1024 * 16 / 4; i += NTHREADS) ((float4*)wrL)[i] = ((const float4*)p.w_router)[i];
    __syncthreads();
    const float* H1 = (const float*)(ws + WS_H1);
    float* X1 = (float*)(ws + WS_X1); bf16_t* X1B = (bf16_t*)(ws + WS_X1B);
    const float* gam = p.ln1_g + layer * 1024; const float* bet = p.ln1_b + layer * 1024;
    unsigned* cnt = (unsigned*)(ws + WS_CTL) + CW_CNT + layer * 16;
    int* LIST = (int*)(ws + WS_LIST); float* WTS = (float*)(ws + WS_WTS);
    for (int tok = blockIdx.x * 4 + wid; tok < T_; tok += gridDim.x * 4) {
        float4 v[4];
#pragma unroll
        for (int j = 0; j < 4; ++j) v[j] = *(const float4*)(H1 + (size_t)tok * 1024 + 256 * j + 4 * lane);
        float s = 0.f;
#pragma unroll
        for (int j = 0; j < 4; ++j) s += v[j].x + v[j].y + v[j].z + v[j].w;
#pragma unroll
        for (int o = 1; o < 64; o <<= 1) s += __shfl_xor(s, o);
        const float mu = s * (1.f / 1024.f);
        float q = 0.f;
#pragma unroll
        for (int j = 0; j < 4; ++j) { const float a = v[j].x - mu, b2 = v[j].y - mu, c = v[j].z - mu, d = v[j].w - mu; q += a * a + b2 * b2 + c * c + d * d; }
#pragma unroll
        for (int o = 1; o < 64; o <<= 1) q += __shfl_xor(q, o);
        const float rstd = rsqrtf(q * (1.f / 1024.f) + 1e-5f);
        float lg[16];
#pragma unroll
        for (int e = 0; e < 16; ++e) lg[e] = 0.f;
#pragma unroll
        for (int j = 0; j < 4; ++j) {
            const int d0 = 256 * j + 4 * lane;
            const float4 gg = *(const float4*)(gam + d0), bb = *(const float4*)(bet + d0);
            float4 y; y.x = (v[j].x - mu) * rstd * gg.x + bb.x; y.y = (v[j].y - mu) * rstd * gg.y + bb.y; y.z = (v[j].z - mu) * rstd * gg.z + bb.z; y.w = (v[j].w - mu) * rstd * gg.w + bb.w;
            *(float4*)(X1 + (size_t)tok * 1024 + d0) = y;
            u32x2 w; w.x = pack2(y.x, y.y); w.y = pack2(y.z, y.w);
            *(u32x2*)(X1B + (size_t)tok * 1024 + d0) = w;
            const float yy[4] = {y.x, y.y, y.z, y.w};
#pragma unroll
            for (int c = 0; c < 4; ++c) {
                const float4* wp = (const float4*)(wrL + (d0 + c) * 16);
#pragma unroll
                for (int e4 = 0; e4 < 4; ++e4) { const float4 w4 = wp[e4]; lg[4 * e4 + 0] += yy[c] * w4.x; lg[4 * e4 + 1] += yy[c] * w4.y; lg[4 * e4 + 2] += yy[c] * w4.z; lg[4 * e4 + 3] += yy[c] * w4.w; }
                asm volatile("" ::: "memory");
            }
        }
#pragma unroll
        for (int e = 0; e < 16; ++e) {
#pragma unroll
            for (int o = 1; o < 64; o <<= 1) lg[e] += __shfl_xor(lg[e], o);
        }
        float mx = lg[0];
#pragma unroll
        for (int e = 1; e < 16; ++e) mx = fmaxf(mx, lg[e]);
        float pr[16], ps = 0.f;
#pragma unroll
        for (int e = 0; e < 16; ++e) { pr[e] = expf(lg[e] - mx); ps += pr[e]; }
        const float ips = 1.f / ps;
        float sel[16];
#pragma unroll
        for (int e = 0; e < 16; ++e) { pr[e] *= ips; sel[e] = pr[e] + p.router_bias[e]; }
        int best = 0; float bestv = -1e30f;
#pragma unroll
        for (int gI = 0; gI < 4; ++gI) {
            float a = -1e30f, b2 = -1e30f;
#pragma unroll
            for (int k = 0; k < 4; ++k) { const float x = sel[4 * gI + k]; if (x > a) { b2 = a; a = x; } else if (x > b2) b2 = x; }
            const float gs = a + b2;
            if (gs > bestv) { bestv = gs; best = gI; }
        }
        float s4[4], p4[4];
#pragma unroll
        for (int k = 0; k < 4; ++k) { s4[k] = 0.f; p4[k] = 0.f; }
#pragma unroll
        for (int gI = 0; gI < 4; ++gI) if (gI == best) {
#pragma unroll
            for (int k = 0; k < 4; ++k) { s4[k] = sel[4 * gI + k]; p4[k] = pr[4 * gI + k]; }
        }
        int i0 = 0; float a0 = s4[0];
#pragma unroll
        for (int k = 1; k < 4; ++k) if (s4[k] > a0) { a0 = s4[k]; i0 = k; }
        int i1 = -1; float a1 = -1e30f;
#pragma unroll
        for (int k = 0; k < 4; ++k) if (k != i0 && s4[k] > a1) { a1 = s4[k]; i1 = k; }
        float w0 = 0.f, w1 = 0.f;
#pragma unroll
        for (int k = 0; k < 4; ++k) { if (k == i0) w0 = p4[k]; if (k == i1) w1 = p4[k]; }
        const float iw = 1.f / (w0 + w1);
        if (lane == 0) {
            const int e0 = best * 4 + i0, e1 = best * 4 + i1;
            const unsigned p0 = atomicAdd(&cnt[e0], 1u); LIST[(size_t)e0 * T_ + p0] = tok * 2;
            const unsigned p1 = atomicAdd(&cnt[e1], 1u); LIST[(size_t)e1 * T_ + p1] = tok * 2 + 1;
            WTS[tok * 2] = w0 * iw; WTS[tok * 2 + 1] = w1 * iw;
        }
    }
}

__device__ __forceinline__ bool moe_find(const unsigned* cnt, int t, int colTiles, int& e, int& rt, int& ct, int& cnte, int& off) {
    int base = 0; off = 0;
    for (int k = 0; k < NE; ++k) {
        const int c = __builtin_amdgcn_readfirstlane((int)cnt[k]), nt = ((c + 127) >> 7) * colTiles;
        if (t < base + nt) { e = k; cnte = c; const int u = t - base; rt = u / colTiles; ct = u % colTiles;
            e = __builtin_amdgcn_readfirstlane(e); cnte = __builtin_amdgcn_readfirstlane(cnte); rt = __builtin_amdgcn_readfirstlane(rt);
            ct = __builtin_amdgcn_readfirstlane(ct); off = __builtin_amdgcn_readfirstlane(off); return true; }
        base += nt; off += c;
    }
    return false;
}
__device__ void phase_m2(const Params& p, int layer, unsigned char* lds) {
    unsigned char* ws = launder(p.ws);
    const int tid = threadIdx.x + vzero(), lane = tid & 63, wid = tid >> 6, wr = wid >> 1, wc = wid & 1, fr = lane & 15, fq = lane >> 4;
    const int ldrow = 8 * wid + (lane >> 3), ldc = ((lane & 7) ^ (lane >> 3)) * 8;
    const unsigned* cnt = (const unsigned*)(ws + WS_CTL) + CW_CNT + layer * 16 + vzero();
    const int* LIST = (const int*)(ws + WS_LIST);
    const bf16_t* X1B = (const bf16_t*)(ws + WS_X1B);
    bf16_t* HB = (bf16_t*)(ws + WS_HB);
    for (int t = blockIdx.x;; t += gridDim.x) {
        int e, rt, ct, cnte, off;
        if (!moe_find(cnt, t, 8, e, rt, ct, cnte, off)) break;
        const bf16_t* mp[4]; const bf16_t* np[4];
#pragma unroll
        for (int i = 0; i < 4; ++i) {
            const int rho = 32 * i + ldrow, blk = rho >> 4, nn = ct * 64 + (blk >> 1) * 16 + (rho & 15);
            mp[i] = (const bf16_t*)(ws + ((blk & 1) ? WS_WU : WS_WG)) + ((size_t)e * 512 + nn) * 1024 + ldc;
            int idx = rt * 128 + rho; idx = idx < cnte ? idx : cnte - 1;
            const int a = LIST[(size_t)e * T_ + idx];
            np[i] = X1B + (size_t)(a >> 1) * 1024 + ldc;
        }
        f32x4 acc[4][4]; zero_acc(acc);
        gemm_kloop(mp, np, 16, lds, acc);
#pragma unroll
        for (int mp2 = 0; mp2 < 2; ++mp2)
#pragma unroll
            for (int ni = 0; ni < 4; ++ni) {
                const int idx = rt * 128 + 64 * wc + 16 * ni + fr;
                if (idx < cnte) {
                    const int n = ct * 64 + (2 * wr + mp2) * 16 + 4 * fq;
                    const f32x4 gv = acc[2 * mp2][ni], uv = acc[2 * mp2 + 1][ni];
                    f32x4 hv;
#pragma unroll
                    for (int r = 0; r < 4; ++r) hv[r] = gv[r] * sigmoidf_(gv[r]) * uv[r];
                    *(u32x2*)(HB + (size_t)(off + idx) * 512 + n) = pack4(hv);
                }
            }
    }
}
__device__ void phase_m3(const Params& p, int layer, unsigned char* lds) {
    unsigned char* ws = launder(p.ws);
    const int tid = threadIdx.x + vzero(), lane = tid & 63, wid = tid >> 6, wr = wid >> 1, wc = wid & 1, fr = lane & 15, fq = lane >> 4;
    const int ldrow = 8 * wid + (lane >> 3), ldc = ((lane & 7) ^ (lane >> 3)) * 8;
    const unsigned* cnt = (const unsigned*)(ws + WS_CTL) + CW_CNT + layer * 16 + vzero();
    const int* LIST = (const int*)(ws + WS_LIST);
    const bf16_t* HB = (const bf16_t*)(ws + WS_HB);
    bf16_t* CT = (bf16_t*)(ws + WS_CT);
    for (int t = blockIdx.x;; t += gridDim.x) {
        int e, rt, ct, cnte, off;
        if (!moe_find(cnt, t, 8, e, rt, ct, cnte, off)) break;
        const bf16_t* mp[4]; const bf16_t* np[4];
#pragma unroll
        for (int i = 0; i < 4; ++i) {
            const int rho = 32 * i + ldrow;
            mp[i] = (const bf16_t*)(ws + WS_WD) + ((size_t)e * 1024 + ct * 128 + rho) * 512 + ldc;
            int idx = rt * 128 + rho; idx = idx < cnte ? idx : cnte - 1;
            np[i] = HB + (size_t)(off + idx) * 512 + ldc;
        }
        f32x4 acc[4][4]; zero_acc(acc);
        gemm_kloop(mp, np, 8, lds, acc);
#pragma unroll
        for (int ni = 0; ni < 4; ++ni) {
            const int idx = rt * 128 + 64 * wc + 16 * ni + fr;
            if (idx < cnte) {
                const int a = LIST[(size_t)e * T_ + idx];
#pragma unroll
                for (int mi = 0; mi < 4; ++mi) {
                    const int n = ct * 128 + 64 * wr + 16 * mi + 4 * fq;
                    *(u32x2*)(CT + (size_t)a * 1024 + n) = pack4(acc[mi][ni]);
                }
            }
        }
    }
}

__device__ void phase_ln2(const Params& p, int layer) {
    unsigned char* ws = launder(p.ws);
    const int tid = threadIdx.x + vzero(), lane = tid & 63, wid = tid >> 6;
    const float* X1 = (const float*)(ws + WS_X1); const bf16_t* CT = (const bf16_t*)(ws + WS_CT); const float* WTS = (const float*)(ws + WS_WTS);
    float* XO = layer == NLAYER - 1 ? p.out : (float*)(ws + WS_X); bf16_t* XB = (bf16_t*)(ws + WS_XB);
    const float* gam = p.ln2_g + layer * 1024; const float* bet = p.ln2_b + layer * 1024;
    for (int tok = blockIdx.x * 4 + wid; tok < T_; tok += gridDim.x * 4) {
        const float w0 = WTS[tok * 2 + vzero()], w1 = WTS[tok * 2 + 1 + vzero()];
        float4 v[4];
#pragma unroll
        for (int j = 0; j < 4; ++j) {
            const int d0 = 256 * j + 4 * lane;
            const float4 xv = *(const float4*)(X1 + (size_t)tok * 1024 + d0);
            const f32x4 c0 = unpack4(*(const u32x2*)(CT + (size_t)(tok * 2) * 1024 + d0)), c1 = unpack4(*(const u32x2*)(CT + (size_t)(tok * 2 + 1) * 1024 + d0));
            v[j].x = xv.x * DN_ALPHA + w0 * c0[0] + w1 * c1[0]; v[j].y = xv.y * DN_ALPHA + w0 * c0[1] + w1 * c1[1];
            v[j].z = xv.z * DN_ALPHA + w0 * c0[2] + w1 * c1[2]; v[j].w = xv.w * DN_ALPHA + w0 * c0[3] + w1 * c1[3];
        }
        float s = 0.f;
#pragma unroll
        for (int j = 0; j < 4; ++j) s += v[j].x + v[j].y + v[j].z + v[j].w;
#pragma unroll
        for (int o = 1; o < 64; o <<= 1) s += __shfl_xor(s, o);
        const float mu = s * (1.f / 1024.f);
        float q = 0.f;
#pragma unroll
        for (int j = 0; j < 4; ++j) { const float a = v[j].x - mu, b2 = v[j].y - mu, c = v[j].z - mu, d = v[j].w - mu; q += a * a + b2 * b2 + c * c + d * d; }
#pragma unroll
        for (int o = 1; o < 64; o <<= 1) q += __shfl_xor(q, o);
        const float rstd = rsqrtf(q * (1.f / 1024.f) + 1e-5f);
#pragma unroll
        for (int j = 0; j < 4; ++j) {
            const int d0 = 256 * j + 4 * lane;
            const float4 gg = *(const float4*)(gam + d0), bb = *(const float4*)(bet + d0);
            float4 y; y.x = (v[j].x - mu) * rstd * gg.x + bb.x; y.y = (v[j].y - mu) * rstd * gg.y + bb.y; y.z = (v[j].z - mu) * rstd * gg.z + bb.z; y.w = (v[j].w - mu) * rstd * gg.w + bb.w;
            *(float4*)(XO + (size_t)tok * 1024 + d0) = y;
            u32x2 w; w.x = pack2(y.x, y.y); w.y = pack2(y.z, y.w);
            *(u32x2*)(XB + (size_t)tok * 1024 + d0) = w;
        }
    }
}

constexpr int PH_PER_LAYER = 11, N_PHASES = PH_PER_LAYER * NLAYER;
__global__ void __launch_bounds__(NTHREADS, 2) mega(Params p) {
    extern __shared__ __attribute__((aligned(16))) unsigned char lds[];
    for (int ph = p.ph_lo; ph < p.ph_hi; ++ph) {
        const int layer = ph / PH_PER_LAYER, k = ph % PH_PER_LAYER;
#ifdef ONLY_PHASE
        if (k != ONLY_PHASE) continue;
#endif
        switch (k) {
            case 0: phase_pw(p, layer, lds); break;
            case 1: phase_g1(p, layer, lds); break;
            case 2: phase_p2(p, layer, lds); break;
            case 3: phase_p3(p, lds); break;
            case 4: phase_p4(p, lds); break;
            case 5: phase_g2(p, lds); break;
            case 6: phase_g3(p, layer, lds); break;
            case 7: phase_ln1(p, layer, lds); break;
            case 8: phase_m2(p, layer, lds); break;
            case 9: phase_m3(p, layer, lds); break;
            case 10: phase_ln2(p, layer); break;
        }
#if SINGLE_LAUNCH
        if (ph + 1 < p.ph_hi) { cg::this_grid().sync(); }
#endif
    }
}

extern "C" void kernel_launch(void* const* d_in, const int* in_sizes, int n_in, void* d_out, int out_size, void* d_ws, size_t ws_size, hipStream_t stream) {
    static int grid = 0;
    if (grid == 0) {
        if (n_in != 18 || ws_size < WS_END) { fprintf(stderr, "kernel_launch: unexpected n_in %d or ws_size %zu < %zu\n", n_in, ws_size, (size_t)WS_END); grid = -1; return; }
        int dev = 0, cus = 0, per_cu = 0;
        hipGetDevice(&dev); hipDeviceGetAttribute(&cus, hipDeviceAttributeMultiprocessorCount, dev);
        hipFuncSetAttribute((const void*)mega, hipFuncAttributeMaxDynamicSharedMemorySize, LDS_BYTES);
        hipOccupancyMaxActiveBlocksPerMultiprocessor(&per_cu, (const void*)mega, NTHREADS, LDS_BYTES);
        if (per_cu < 1) per_cu = 1;
        if (per_cu > 2) per_cu = 2;
        grid = cus * per_cu;
        (void)hipGetLastError();
    }
    if (grid < 0) return;
    Params p{};
    p.x = (const float*)d_in[0]; p.w_in = (const float*)d_in[1]; p.cmp_pos = (const float*)d_in[2]; p.cmp_w1 = (const float*)d_in[3]; p.cmp_w2 = (const float*)d_in[4];
    p.w_br_a = (const float*)d_in[5]; p.w_br_b = (const float*)d_in[6]; p.w_o = (const float*)d_in[7]; p.ln1_g = (const float*)d_in[8]; p.ln1_b = (const float*)d_in[9];
    p.w_router = (const float*)d_in[10]; p.router_bias = (const float*)d_in[11]; p.w_gate = (const float*)d_in[12]; p.w_up = (const float*)d_in[13]; p.w_down = (const float*)d_in[14];
    p.ln2_g = (const float*)d_in[15]; p.ln2_b = (const float*)d_in[16]; p.rel_bias = (const float*)d_in[17];
    p.out = (float*)d_out; p.ws = (unsigned char*)d_ws;
#if SINGLE_LAUNCH
    p.ph_lo = 0; p.ph_hi = N_PHASES;
    void* args[] = {&p};
    hipError_t e = hipLaunchCooperativeKernel((const void*)mega, dim3(grid), dim3(NTHREADS), args, LDS_BYTES, stream);
    if (e != hipSuccess) fprintf(stderr, "cooperative launch failed: %s (grid %d)\n", hipGetErrorString(e), grid);
#else
    for (int ph = 0; ph < N_PHASES; ++ph) {
        p.ph_lo = ph; p.ph_hi = ph + 1;
        hipLaunchKernelGGL(mega, dim3(grid), dim3(NTHREADS), LDS_BYTES, stream, p);
    }
#endif
}
```

```cpp
#include <hip/hip_runtime.h>
#include <hip/hip_cooperative_groups.h>
#include <cstdio>
#include <cstdint>
namespace cg = cooperative_groups;

#ifndef SINGLE_LAUNCH
#define SINGLE_LAUNCH 1
#endif

typedef unsigned short bf16_t;
typedef short bf16x8 __attribute__((ext_vector_type(8)));
typedef float f32x4 __attribute__((ext_vector_type(4)));
typedef unsigned u32x2 __attribute__((ext_vector_type(2)));
typedef unsigned u32x4 __attribute__((ext_vector_type(4)));

constexpr int B_ = 2, S_ = 8192, D_ = 1024, T_ = B_ * S_, NLAYER = 4;
constexpr int DIN = 6424;
constexpr int LD = 6528;
constexpr int C_QA = 0, C_KC = 512, C_VC = 640, C_KS = 768, C_VS = 896, C_KW = 1024, C_VW = 1152, C_QR = 1280, C_KR = 1792,
              C_VR = 2304, C_GR = 3328, C_MA = 4352, C_MB = 5376, C_GA = 6400;
constexpr float DN_ALPHA = 1.681792830507429f;
constexpr int NE = 16;

constexpr size_t al256(size_t x) { return (x + 255) & ~(size_t)255; }
constexpr size_t WS_CTL = 0;
constexpr size_t WS_BUCKET = 65536;
constexpr size_t WS_ROPE = WS_BUCKET + 8192;
constexpr size_t WS_WIN = WS_ROPE + (size_t)8192 * 32 * 8;
constexpr size_t WS_WA = WS_WIN + (size_t)LD * 1024 * 2;
constexpr size_t WS_WB = WS_WA + (size_t)1024 * 512 * 2;
constexpr size_t WS_WO = WS_WB + (size_t)1024 * 1024 * 2;
constexpr size_t WS_WG = WS_WO + (size_t)1024 * 1024 * 2;
constexpr size_t WS_WU = WS_WG + (size_t)16 * 512 * 1024 * 2;
constexpr size_t WS_WD = WS_WU + (size_t)16 * 512 * 1024 * 2;
constexpr size_t WS_XB = WS_WD + (size_t)16 * 512 * 1024 * 2;
constexpr size_t WS_X = WS_XB + (size_t)T_ * 1024 * 2;
constexpr size_t WS_MG = WS_X + (size_t)T_ * 1024 * 4;
constexpr size_t WS_KCC = WS_MG + (size_t)T_ * 1024 * 2;
constexpr size_t WS_VCCT = WS_KCC + (size_t)4 * 512 * 64 * 2;
constexpr size_t WS_R = WS_VCCT + (size_t)4 * 512 * 64 * 2;
constexpr size_t WS_P = WS_R;
constexpr size_t WS_VST = WS_P + (size_t)T_ * LD * 2;
constexpr size_t WS_VWT = WS_VST + (size_t)4 * 64 * S_ * 2;
constexpr size_t WS_VRT = WS_VWT + (size_t)4 * 64 * S_ * 2;
constexpr size_t WS_KVT = WS_VRT + (size_t)16 * 128 * S_ * 2;
constexpr size_t WS_SPT = WS_KVT + (size_t)16 * 64 * 8192 * 4;
constexpr size_t WS_YA32 = WS_SPT + (size_t)16 * 64 * 8192 * 2;
constexpr size_t WS_YA = WS_YA32 + (size_t)T_ * 512 * 4;
constexpr size_t WS_YB = WS_YA + (size_t)T_ * 512 * 2;
constexpr size_t WS_ENDA = WS_YB + (size_t)T_ * 1024 * 2;
constexpr size_t WS_H1 = WS_R;
constexpr size_t WS_X1 = WS_H1 + (size_t)T_ * 1024 * 4;
constexpr size_t WS_X1B = WS_X1 + (size_t)T_ * 1024 * 4;
constexpr size_t WS_HB = WS_X1B + (size_t)T_ * 1024 * 2;
constexpr size_t WS_CT = WS_P + (size_t)T_ * LD * 2;
constexpr size_t WS_LIST = WS_CT + (size_t)2 * T_ * 1024 * 2;
constexpr size_t WS_WTS = WS_LIST + (size_t)16 * T_ * 4;
constexpr size_t WS_ENDB = WS_WTS + (size_t)2 * T_ * 4;
static_assert(WS_HB + (size_t)2 * T_ * 512 * 2 <= WS_CT, "view B overlap");
constexpr size_t WS_END = WS_ENDA > WS_ENDB ? WS_ENDA : WS_ENDB;

constexpr int CW_CNT = 4096;
constexpr int CW_BAR = 8192;

constexpr int LDS_BYTES = 75776;
constexpr int NTHREADS = 256;

struct Params {
    const float* x; const float* w_in; const float* cmp_pos; const float* cmp_w1; const float* cmp_w2;
    const float* w_br_a; const float* w_br_b; const float* w_o; const float* ln1_g; const float* ln1_b;
    const float* w_router; const float* router_bias; const float* w_gate; const float* w_up; const float* w_down;
    const float* ln2_g; const float* ln2_b; const float* rel_bias;
    float* out; unsigned char* ws;
    int ph_lo, ph_hi;
};

__device__ __forceinline__ bf16_t f2bf(float f) { unsigned u = __float_as_uint(f); u += 0x7fffu + ((u >> 16) & 1u); return (bf16_t)(u >> 16); }
__device__ __forceinline__ float bf2f(unsigned h) { return __uint_as_float(h << 16); }
__device__ __forceinline__ unsigned pack2(float lo, float hi) { return (unsigned)f2bf(lo) | ((unsigned)f2bf(hi) << 16); }
__device__ __forceinline__ u32x2 pack4(f32x4 v) { u32x2 r; r.x = pack2(v[0], v[1]); r.y = pack2(v[2], v[3]); return r; }
__device__ __forceinline__ f32x4 unpack4(u32x2 u) { f32x4 r; r[0] = bf2f(u.x & 0xffffu); r[1] = bf2f(u.x >> 16); r[2] = bf2f(u.y & 0xffffu); r[3] = bf2f(u.y >> 16); return r; }
__device__ __forceinline__ float sigmoidf_(float x) { return 1.f / (1.f + __expf(-x)); }
__device__ __forceinline__ int vzero() { int z; asm volatile("v_mov_b32 %0, 0" : "=v"(z)); return z; }
__device__ __forceinline__ unsigned char* launder(unsigned char* q) { asm volatile("" : "+s"(q)); return q; }
__device__ __forceinline__ void wait_vm0() { asm volatile("s_waitcnt vmcnt(0)" ::: "memory"); }

__device__ __forceinline__ void glds16(const void* g, void* l) {
    __builtin_amdgcn_global_load_lds((const __attribute__((address_space(1))) unsigned*)g,
                                     (__attribute__((address_space(3))) unsigned*)l, 16, 0, 0);
}
__device__ __forceinline__ f32x4 mfma16(bf16x8 a, bf16x8 b, f32x4 c) { return __builtin_amdgcn_mfma_f32_16x16x32_bf16(a, b, c, 0, 0, 0); }

__device__ __forceinline__ void gemm_stage(const bf16_t* const (&mp)[4], const bf16_t* const (&np)[4], int kt, unsigned char* st, int wid) {
#pragma unroll
    for (int i = 0; i < 4; ++i) {
        glds16(mp[i] + kt * 64, st + (4 * i + wid) * 1024);
        glds16(np[i] + kt * 64, st + 16384 + (4 * i + wid) * 1024);
    }
}
__device__ __forceinline__ void gemm_compute(const unsigned char* st, f32x4 (&acc)[4][4], int wr, int wc, int fr, int fq) {
#pragma unroll
    for (int ks = 0; ks < 2; ++ks) {
        bf16x8 a[4], b[4];
        const int sw = ((4 * ks + fq) ^ (fr & 7)) << 4;
#pragma unroll
        for (int i = 0; i < 4; ++i) {
            a[i] = *(const bf16x8*)(st + (64 * wr + 16 * i + fr) * 128 + sw);
            b[i] = *(const bf16x8*)(st + 16384 + (64 * wc + 16 * i + fr) * 128 + sw);
        }
#pragma unroll
        for (int i = 0; i < 4; ++i)
#pragma unroll
            for (int j = 0; j < 4; ++j) acc[i][j] = mfma16(a[i], b[j], acc[i][j]);
    }
}
__device__ __forceinline__ void gemm_kloop(const bf16_t* const (&mp)[4], const bf16_t* const (&np)[4], int nk, unsigned char* lds, f32x4 (&acc)[4][4]) {
    const int tid = threadIdx.x + vzero(), lane = tid & 63, wid = tid >> 6, wr = wid >> 1, wc = wid & 1, fr = lane & 15, fq = lane >> 4;
    gemm_stage(mp, np, 0, lds, wid);
    wait_vm0(); __syncthreads();
    for (int kt = 0; kt < nk; ++kt) {
        unsigned char* cur = lds + (kt & 1) * 32768;
        if (kt + 1 < nk) gemm_stage(mp, np, kt + 1, lds + ((kt + 1) & 1) * 32768, wid);
        gemm_compute(cur, acc, wr, wc, fr, fq);
        wait_vm0(); __syncthreads();
    }
}
__device__ __forceinline__ void zero_acc(f32x4 (&acc)[4][4]) {
#pragma unroll
    for (int i = 0; i < 4; ++i)
#pragma unroll
        for (int j = 0; j < 4; ++j) acc[i][j] = (f32x4){0.f, 0.f, 0.f, 0.f};
}

__device__ void tcvt_tile(const float* src, int ld_src, int k0, int n0, int mode, bf16_t* dst, int kdst, unsigned char* lds) {
    float* tile = (float*)lds;
    const int tid = threadIdx.x + vzero();
#pragma unroll
    for (int i = 0; i < 4; ++i) {
        const int kk = (tid >> 4) + 16 * i, c4 = (tid & 15) * 4, cd = n0 + c4;
        int orig = cd; bool ok = true;
        if (mode == 1) { if (cd < 1280) orig = cd; else if (cd < 6400) orig = cd + 24; else if (cd < 6424) orig = cd - 6400 + 1280; else ok = false; }
        float4 v = make_float4(0.f, 0.f, 0.f, 0.f);
        if (ok) v = *(const float4*)(src + (size_t)(k0 + kk) * ld_src + orig);
        tile[kk * 65 + c4 + 0] = v.x; tile[kk * 65 + c4 + 1] = v.y; tile[kk * 65 + c4 + 2] = v.z; tile[kk * 65 + c4 + 3] = v.w;
    }
    __syncthreads();
#pragma unroll
    for (int i = 0; i < 2; ++i) {
        const int q = tid + 256 * i, n = q >> 3, kc = q & 7;
        float v[8];
#pragma unroll
        for (int j = 0; j < 8; ++j) v[j] = tile[(kc * 8 + j) * 65 + n];
        u32x4 w; w.x = pack2(v[0], v[1]); w.y = pack2(v[2], v[3]); w.z = pack2(v[4], v[5]); w.w = pack2(v[6], v[7]);
        *(u32x4*)(dst + (size_t)(n0 + n) * kdst + k0 + kc * 8) = w;
    }
    __syncthreads();
}

__device__ void phase_pw(const Params& p, int layer, unsigned char* lds) {
    const int bid = blockIdx.x, nblk = gridDim.x, tid = threadIdx.x + vzero();
    unsigned char* ws = launder(p.ws);
    constexpr int J0 = 16 * 102, J1 = 8 * 16, J2 = 256, J3 = 256, J4 = 2048, J5 = 2048, J6 = 2048, JT = J0 + J1 + J2 + J3 + J4 + J5 + J6;
    for (int t = bid; t < JT; t += nblk) {
        int u = t;
        if (u < J0) { tcvt_tile(p.w_in + (size_t)layer * 1024 * DIN, DIN, (u % 16) * 64, (u / 16) * 64, 1, (bf16_t*)(ws + WS_WIN), 1024, lds); continue; }
        u -= J0;
        if (u < J1) { tcvt_tile(p.w_br_a + (size_t)layer * 512 * 1024, 1024, (u % 8) * 64, (u / 8) * 64, 0, (bf16_t*)(ws + WS_WA), 512, lds); continue; }
        u -= J1;
        if (u < J2) { tcvt_tile(p.w_br_b + (size_t)layer * 1024 * 1024, 1024, (u % 16) * 64, (u / 16) * 64, 0, (bf16_t*)(ws + WS_WB), 1024, lds); continue; }
        u -= J2;
        if (u < J3) { tcvt_tile(p.w_o + (size_t)layer * 1024 * 1024, 1024, (u % 16) * 64, (u / 16) * 64, 0, (bf16_t*)(ws + WS_WO), 1024, lds); continue; }
        u -= J3;
        if (u < J4 + J5) {
            const bool up = u >= J4; if (up) u -= J4;
            const int e = u / 128, v = u % 128;
            const float* src = (up ? p.w_up : p.w_gate) + ((size_t)layer * NE + e) * 1024 * 512;
            tcvt_tile(src, 512, (v % 16) * 64, (v / 16) * 64, 0, (bf16_t*)(ws + (up ? WS_WU : WS_WG)) + (size_t)e * 512 * 1024, 1024, lds); continue;
        }
        u -= J4 + J5;
        { const int e = u / 128, v = u % 128;
          const float* src = p.w_down + ((size_t)layer * NE + e) * 512 * 1024;
          tcvt_tile(src, 1024, (v % 8) * 64, (v / 8) * 64, 0, (bf16_t*)(ws + WS_WD) + (size_t)e * 1024 * 512, 512, lds); }
    }
    if (layer == 0) {
        const float4* xs = (const float4*)p.x; u32x2* xb = (u32x2*)(ws + WS_XB);
        for (size_t i = (size_t)bid * NTHREADS + tid; i < (size_t)T_ * 1024 / 4; i += (size_t)nblk * NTHREADS) {
            float4 v = xs[i]; u32x2 w; w.x = pack2(v.x, v.y); w.y = pack2(v.z, v.w); xb[i] = w;
        }
        for (int n = bid * NTHREADS + tid; n < 8192; n += nblk * NTHREADS) {
            int bk;
            if (n < 16) bk = n;
            else { const int th[15] = {22, 30, 40, 54, 73, 99, 134, 182, 246, 332, 450, 609, 825, 1117, 1513}; bk = 16;
#pragma unroll
                for (int k = 0; k < 15; ++k) bk += (n >= th[k]) ? 1 : 0; }
            (ws + WS_BUCKET)[n] = (unsigned char)bk;
        }
        for (int i = bid * NTHREADS + tid; i < 8192 * 32; i += nblk * NTHREADS) {
            const int pos = i >> 5, d = i & 31;
            const float inv = powf(10000.f, -(float)d * 2.0f / 64.f);
            const float ang = (float)pos * inv;
            float sn, cs; sincosf(ang, &sn, &cs);
            ((float2*)(ws + WS_ROPE))[i] = make_float2(cs, sn);
        }
        if (bid == 0 && tid < 64) ((unsigned*)(ws + WS_CTL))[CW_CNT + tid] = 0u;
    }
}

__device__ void phase_g1(const Params& p, int layer, unsigned char* lds) {
    unsigned char* ws = launder(p.ws);
    const bf16_t* XB = (const bf16_t*)(ws + WS_XB);
    const bf16_t* WT = (const bf16_t*)(ws + WS_WIN);
    bf16_t* P = (bf16_t*)(ws + WS_P);
    const int tid = threadIdx.x + vzero(), lane = tid & 63, wid = tid >> 6, wr = wid >> 1, wc = wid & 1, fr = lane & 15, fq = lane >> 4;
    const int ldrow = 8 * wid + (lane >> 3), ldc = ((lane & 7) ^ (lane >> 3)) * 8;
    const float2* rope = (const float2*)(ws + WS_ROPE);
    for (int t = blockIdx.x; t < 128 * 51; t += gridDim.x) {
        const int mt = t / 51, nt = t % 51, m0 = mt * 128, n0 = nt * 128;
        const bool transposed = (nt == 7) || (nt == 9) || (nt >= 18 && nt <= 25);
        const bf16_t* mp[4]; const bf16_t* np[4];
#pragma unroll
        for (int i = 0; i < 4; ++i) {
            const bf16_t* wrow = WT + (size_t)(n0 + 32 * i + ldrow) * 1024 + ldc;
            const bf16_t* xrow = XB + (size_t)(m0 + 32 * i + ldrow) * 1024 + ldc;
            mp[i] = transposed ? xrow : wrow; np[i] = transposed ? wrow : xrow;
        }
        f32x4 acc[4][4]; zero_acc(acc);
        gemm_kloop(mp, np, 16, lds, acc);
        if (!transposed) {
            const int kind = (nt >= 10 && nt <= 13) ? 1 : (nt >= 14 && nt <= 17) ? 2 : (nt >= 26 && nt <= 33) ? 3 : (nt >= 34) ? 4 : 0;
            if (kind == 1 || kind == 2) {
                const float sc = (kind == 2) ? 0.125f : 1.0f;
#pragma unroll
                for (int ni = 0; ni < 4; ++ni) {
                    const int tok = m0 + 64 * wc + 16 * ni + fr, pos = tok & (S_ - 1);
#pragma unroll
                    for (int mi = 0; mi < 2; ++mi) {
                        const int d = 16 * mi + 4 * fq;
                        const float4 cs01 = *(const float4*)(rope + pos * 32 + d), cs23 = *(const float4*)(rope + pos * 32 + d + 2);
                        const float c[4] = {cs01.x, cs01.z, cs23.x, cs23.z}, s[4] = {cs01.y, cs01.w, cs23.y, cs23.w};
                        f32x4 x1 = acc[mi][ni], x2 = acc[mi + 2][ni], y1, y2;
#pragma unroll
                        for (int r = 0; r < 4; ++r) { y1[r] = (x1[r] * c[r] - x2[r] * s[r]) * sc; y2[r] = (x1[r] * s[r] + x2[r] * c[r]) * sc; }
                        acc[mi][ni] = y1; acc[mi + 2][ni] = y2;
                    }
                }
            }
#pragma unroll
            for (int mi = 0; mi < 4; ++mi)
#pragma unroll
                for (int ni = 0; ni < 4; ++ni) {
                    const int n = n0 + 64 * wr + 16 * mi + 4 * fq, tok = m0 + 64 * wc + 16 * ni + fr;
                    f32x4 v = acc[mi][ni];
                    if (kind == 3) {
#pragma unroll
                        for (int r = 0; r < 4; ++r) v[r] = v[r] * sigmoidf_(v[r]);
                    } else if (kind == 4) {
#pragma unroll
                        for (int r = 0; r < 4; ++r) v[r] = sigmoidf_(v[r]);
                    }
                    *(u32x2*)(P + (size_t)tok * LD + n) = pack4(v);
                }
        } else {
#pragma unroll
            for (int mi = 0; mi < 4; ++mi)
#pragma unroll
                for (int ni = 0; ni < 4; ++ni) {
                    const int tok = m0 + 64 * wr + 16 * mi + 4 * fq, n = n0 + 64 * wc + 16 * ni + fr;
                    const int b = tok >> 13, s = tok & (S_ - 1);
                    bf16_t* dst;
                    if (nt == 7) { const int c = n - C_VS; dst = (bf16_t*)(ws + WS_VST) + ((size_t)(b * 2 + (c >> 6)) * 64 + (c & 63)) * S_ + s; }
                    else if (nt == 9) { const int c = n - C_VW; dst = (bf16_t*)(ws + WS_VWT) + ((size_t)(b * 2 + (c >> 6)) * 64 + (c & 63)) * S_ + s; }
                    else { const int c = n - C_VR; dst = (bf16_t*)(ws + WS_VRT) + ((size_t)(b * 8 + (c >> 7)) * 128 + (c & 127)) * S_ + s; }
                    *(u32x2*)dst = pack4(acc[mi][ni]);
                }
        }
    }
}

__device__ __forceinline__ void load_tile64(const bf16_t* base, size_t rowStride, unsigned char* dst, int wid, int lane) {
    const int c = ((lane & 7) ^ (lane >> 3)) * 8;
#pragma unroll
    for (int i = 0; i < 2; ++i) { const int j = wid + 4 * i, row = 8 * j + (lane >> 3); glds16(base + (size_t)row * rowStride + c, dst + j * 1024); }
}
__device__ __forceinline__ void load_tile128(const bf16_t* base, size_t rowStride, unsigned char* dst, int wid, int lane) {
    const int c = ((lane & 7) ^ (lane >> 3)) * 8;
#pragma unroll
    for (int i = 0; i < 4; ++i) { const int j = wid + 4 * i, row = 8 * j + (lane >> 3); glds16(base + (size_t)row * rowStride + c, dst + j * 1024); }
}
__device__ __forceinline__ void load_tile128w(const bf16_t* base, size_t rowStride, unsigned char* dst, int wid, int lane) {
    const int c = ((lane & 15) ^ ((4 * wid + (lane >> 4)) & 15)) * 8;
#pragma unroll
    for (int i = 0; i < 8; ++i) { const int j = wid + 4 * i, row = 4 * j + (lane >> 4); glds16(base + (size_t)row * rowStride + c, dst + j * 1024); }
}
__device__ __forceinline__ bf16x8 lds_frag128(const unsigned char* tile, int row, int chunk) {
    return *(const bf16x8*)(tile + row * 128 + ((chunk ^ (row & 7)) << 4));
}
__device__ __forceinline__ bf16x8 lds_frag256(const unsigned char* tile, int row, int chunk) {
    return *(const bf16x8*)(tile + row * 256 + ((chunk ^ (row & 15)) << 4));
}
__device__ __forceinline__ bf16x8 lds_vfrag128(const unsigned char* tile, int row, int kbase, int fq) {
    const int ca = (kbase >> 3) + (fq >> 1), hb = (fq & 1) * 8;
    const u32x2 a = *(const u32x2*)(tile + row * 128 + ((ca ^ (row & 7)) << 4) + hb);
    const u32x2 b = *(const u32x2*)(tile + row * 128 + (((ca + 2) ^ (row & 7)) << 4) + hb);
    u32x4 w; w.x = a.x; w.y = a.y; w.z = b.x; w.w = b.y;
    return __builtin_bit_cast(bf16x8, w);
}
__device__ __forceinline__ bf16x8 lds_vfrag256(const unsigned char* tile, int row, int kbase, int fq) {
    const int ca = (kbase >> 3) + (fq >> 1), hb = (fq & 1) * 8;
    const u32x2 a = *(const u32x2*)(tile + row * 256 + ((ca ^ (row & 15)) << 4) + hb);
    const u32x2 b = *(const u32x2*)(tile + row * 256 + (((ca + 2) ^ (row & 15)) << 4) + hb);
    u32x4 w; w.x = a.x; w.y = a.y; w.z = b.x; w.w = b.y;
    return __builtin_bit_cast(bf16x8, w);
}
__device__ __forceinline__ bf16x8 pack8(f32x4 a, f32x4 b) {
    u32x4 w; w.x = pack2(a[0], a[1]); w.y = pack2(a[2], a[3]); w.z = pack2(b[0], b[1]); w.w = pack2(b[2], b[3]);
    return __builtin_bit_cast(bf16x8, w);
}

__device__ __forceinline__ float gelu_tanh(float x) {
    const float u = 0.7978845608028654f * (x + 0.044715f * x * x * x);
    return 0.5f * x * (1.f + tanhf(u));
}
__device__ void compress_item(const Params& p, int layer, int item, unsigned char* lds) {
    unsigned char* ws = launder(p.ws);
    const int tid = threadIdx.x + vzero(), lane = tid & 63, wid = tid >> 6;
    const int task = item * 4 + wid;
    const int grp = task & 63, combo = task >> 6;
    const int kv = combo >> 2, b = (combo >> 1) & 1, g = combo & 1;
    const float* pos = p.cmp_pos + ((size_t)layer * 2 + kv) * 32 * 64;
    const float* w1 = p.cmp_w1 + ((size_t)layer * 2 + kv) * 2048 * 64;
    const float* w2 = p.cmp_w2 + ((size_t)layer * 2 + kv) * 64 * 64;
    const bf16_t* P = (const bf16_t*)(ws + WS_P) + vzero();
    const int col = (kv ? C_VC : C_KC) + g * 64;
    float acc[8];
#pragma unroll
    for (int j = 0; j < 8; ++j) acc[j] = 0.f;
    const int i0 = grp * 8;
    for (int l = 0; l < 32; ++l) {
        for (int d = 0; d < 64; ++d) {
            const float w = w1[(size_t)(l * 64 + d) * 64 + lane];
            const float ps = pos[l * 64 + d];
#pragma unroll
            for (int j = 0; j < 8; ++j) {
                int tk = 16 * (i0 + j) + l; tk = tk < S_ ? tk : S_ - 1;
                const float v = bf2f(P[((size_t)b * S_ + tk) * LD + col + d]) + ps;
                acc[j] += v * w;
            }
        }
    }
    float* hid = (float*)lds + wid * 512;
#pragma unroll
    for (int j = 0; j < 8; ++j) hid[j * 64 + lane] = gelu_tanh(acc[j]);
    __syncthreads();
    float o[8];
#pragma unroll
    for (int j = 0; j < 8; ++j) o[j] = 0.f;
    for (int n = 0; n < 64; ++n) {
        const float w = w2[n * 64 + lane];
#pragma unroll
        for (int j = 0; j < 8; ++j) o[j] += hid[j * 64 + n] * w;
    }
#pragma unroll
    for (int j = 0; j < 8; ++j) {
        const int ci = i0 + j;
        const float v = ci < 511 ? o[j] : 0.f;
        if (kv == 0) ((bf16_t*)(ws + WS_KCC))[((size_t)(b * 2 + g) * 512 + ci) * 64 + lane] = f2bf(v);
        else ((bf16_t*)(ws + WS_VCCT))[((size_t)(b * 2 + g) * 64 + lane) * 512 + ci] = f2bf(v);
    }
    __syncthreads();
}

__device__ __forceinline__ float ret_lg2(int h) { const float gam = 1.f - exp2f(-5.f - (float)h); return log2f(gam); }

__device__ void retkv_item(const Params& p, int item, unsigned char* lds) {
    unsigned char* ws = launder(p.ws);
    const int tid = threadIdx.x + vzero(), lane = tid & 63, wid = tid >> 6, fr = lane & 15, fq = lane >> 4;
    const int n = item & 63, h = (item >> 6) & 7, b = item >> 9;
    const size_t tok0 = (size_t)b * S_ + 128 * n;
    unsigned char* vL = lds; unsigned char* kL = lds + 32768;
    load_tile128w((const bf16_t*)(ws + WS_VRT) + ((size_t)(b * 8 + h) * 128) * S_ + 128 * n, S_, vL, wid, lane);
    load_tile128((const bf16_t*)(ws + WS_P) + tok0 * LD + C_KR + h * 64, LD, kL, wid, lane);
    wait_vm0(); __syncthreads();
    const float lg2 = ret_lg2(h);
    f32x4 acc[2][4];
#pragma unroll
    for (int m = 0; m < 2; ++m)
#pragma unroll
        for (int nt = 0; nt < 4; ++nt) acc[m][nt] = (f32x4){0.f, 0.f, 0.f, 0.f};
#pragma unroll
    for (int ks = 0; ks < 4; ++ks) {
        bf16x8 a[2], bb[4];
#pragma unroll
        for (int m = 0; m < 2; ++m) a[m] = lds_frag256(vL, 32 * wid + 16 * m + fr, 4 * ks + fq);
        float dec[8];
#pragma unroll
        for (int j = 0; j < 8; ++j) dec[j] = exp2f((float)(127 - (32 * ks + 8 * fq + j)) * lg2);
#pragma unroll
        for (int nt = 0; nt < 4; ++nt) {
            const int d = 16 * nt + fr;
            float v[8];
#pragma unroll
            for (int j = 0; j < 8; ++j) {
                const int tk = 32 * ks + 8 * fq + j;
                const bf16_t kvv = *(const bf16_t*)(kL + tk * 128 + (((d >> 3) ^ (tk & 7)) << 4) + (d & 7) * 2);
                v[j] = bf2f(kvv) * dec[j];
            }
            u32x4 w; w.x = pack2(v[0], v[1]); w.y = pack2(v[2], v[3]); w.z = pack2(v[4], v[5]); w.w = pack2(v[6], v[7]);
            bb[nt] = __builtin_bit_cast(bf16x8, w);
        }
#pragma unroll
        for (int m = 0; m < 2; ++m)
#pragma unroll
            for (int nt = 0; nt < 4; ++nt) acc[m][nt] = mfma16(a[m], bb[nt], acc[m][nt]);
    }
    float* KVT = (float*)(ws + WS_KVT) + ((size_t)(b * 8 + h) * 64 + n) * 8192;
#pragma unroll
    for (int m = 0; m < 2; ++m)
#pragma unroll
        for (int nt = 0; nt < 4; ++nt)
#pragma unroll
            for (int r = 0; r < 4; ++r) KVT[(32 * wid + 16 * m + 4 * fq + r) * 64 + 16 * nt + fr] = acc[m][nt][r];
    __syncthreads();
}

__device__ void phase_p2(const Params& p, int layer, unsigned char* lds) {
    for (int it = blockIdx.x; it < 1024 + 128; it += gridDim.x) {
        if (it < 1024) retkv_item(p, it, lds); else compress_item(p, layer, it - 1024, lds);
    }
}

constexpr int NSA_IMP = 32768, NSA_BUCKET = 65792, NSA_BIAS = 73984;

struct NsaLane { int t; int fr, fq, wid, lane; };

template <int BR, int PASS>
__device__ __forceinline__ void nsa_half(const unsigned char* kL, const unsigned char* vL, const unsigned char* lds, const bf16_t* qptr,
                                         f32x4 (&O)[4][4], float (&m)[4], float (&l)[4], int tile, int hf, bool selbit, const NsaLane& L, int qrow) {
    const int fr = L.fr, fq = L.fq;
    bf16x8 Kf[2][2];
#pragma unroll
    for (int i = 0; i < 2; ++i)
#pragma unroll
        for (int ks = 0; ks < 2; ++ks) Kf[i][ks] = lds_frag128(kL, 32 * hf + 16 * i + fr, 4 * ks + fq);
    unsigned vmask = 0; unsigned bk[2];
    const unsigned char* bucketL = lds + NSA_BUCKET;
#pragma unroll
    for (int i = 0; i < 2; ++i) {
        unsigned pk = 0;
#pragma unroll
        for (int r = 0; r < 4; ++r) {
            const int kk = 32 * hf + 16 * i + 4 * fq + r;
            int rel; bool ok;
            if (BR == 0) { rel = L.t - (16 * (64 * tile + kk) + 31); ok = rel >= 0; }
            else if (BR == 1) { rel = L.t - (64 * tile + kk); ok = selbit && rel >= 0; }
            else { rel = L.t - (64 * tile + kk); ok = rel >= 0 && rel < 512; }
            int rc = rel < 0 ? 0 : rel; rc = rc > 8191 ? 8191 : rc;
            pk |= (unsigned)bucketL[rc] << (8 * r);
            vmask |= (ok ? 1u : 0u) << (4 * i + r);
        }
        bk[i] = pk;
    }
    const float* biasL = (const float*)(lds + NSA_BIAS);
    float ia[2] = {0.f, 0.f}, ic[2] = {0.f, 0.f};
#pragma unroll
    for (int nt = 0; nt < 4; ++nt) {
        asm volatile("" ::: "memory");
        f32x4 S[2];
        const bf16x8 q0 = *(const bf16x8*)(qptr + nt * 64), q1 = *(const bf16x8*)(qptr + nt * 64 + 32);
#pragma unroll
        for (int i = 0; i < 2; ++i) {
            S[i] = (f32x4){0.f, 0.f, 0.f, 0.f};
            S[i] = mfma16(Kf[i][0], q0, S[i]); S[i] = mfma16(Kf[i][1], q1, S[i]);
        }
        float tmax = -1e30f;
#pragma unroll
        for (int i = 0; i < 2; ++i)
#pragma unroll
            for (int r = 0; r < 4; ++r) {
                const float bias = biasL[nt * 32 + ((bk[i] >> (8 * r)) & 0xffu)];
                const bool ok = (vmask >> (4 * i + r)) & 1u;
                const float sv = ok ? S[i][r] * 0.125f + bias : -1e30f;
                S[i][r] = sv; tmax = fmaxf(tmax, sv);
            }
        if (PASS != 1) {
            tmax = fmaxf(tmax, __shfl_xor(tmax, 16)); tmax = fmaxf(tmax, __shfl_xor(tmax, 32));
            const float mnew = fmaxf(m[nt], tmax), alpha = __expf(m[nt] - mnew);
            float psum = 0.f;
#pragma unroll
            for (int i = 0; i < 2; ++i)
#pragma unroll
                for (int r = 0; r < 4; ++r) {
                    const bool ok = (vmask >> (4 * i + r)) & 1u;
                    const float pv = ok ? __expf(S[i][r] - mnew) : 0.f;
                    S[i][r] = pv; psum += pv;
                }
            psum += __shfl_xor(psum, 16); psum += __shfl_xor(psum, 32);
            l[nt] = l[nt] * alpha + psum; m[nt] = mnew;
            if (PASS == 2) {
#pragma unroll
                for (int mt = 0; mt < 4; ++mt) O[mt][nt] = O[mt][nt] * alpha;
            }
        } else {
#pragma unroll
            for (int i = 0; i < 2; ++i) {
#pragma unroll
                for (int r = 0; r < 4; ++r) {
                    const bool ok = (vmask >> (4 * i + r)) & 1u;
                    S[i][r] = ok ? __expf(S[i][r] - m[nt]) * l[nt] : 0.f;
                }
                ia[i] += S[i][0] + S[i][1] + S[i][2] + 0.5f * S[i][3];
                ic[i] += 0.5f * S[i][3];
            }
        }
        if (PASS != 0) {
            const bf16x8 Pb = pack8(S[0], S[1]);
#pragma unroll
            for (int mt = 0; mt < 4; ++mt) O[mt][nt] = mfma16(lds_vfrag128(vL, 16 * mt + fr, 32 * hf, fq), Pb, O[mt][nt]);
        }
    }
    if (PASS == 1) {
        float* imp = (float*)(lds + NSA_IMP) + qrow * 129;
        asm volatile("" ::: "memory"); __builtin_amdgcn_wave_barrier();
#pragma unroll
        for (int i = 0; i < 2; ++i) { const int j = 16 * tile + 8 * hf + 4 * i + fq; imp[j] += ia[i]; }
        asm volatile("s_waitcnt lgkmcnt(0)" ::: "memory"); __builtin_amdgcn_wave_barrier();
#pragma unroll
        for (int i = 0; i < 2; ++i) { const int j = 16 * tile + 8 * hf + 4 * i + fq + 1; if (j < 128) imp[j] += ic[i]; }
        asm volatile("s_waitcnt lgkmcnt(0)" ::: "memory"); __builtin_amdgcn_wave_barrier();
    }
}
template <int BR, int PASS>
__device__ __forceinline__ void nsa_tile(const unsigned char* kL, const unsigned char* vL, const unsigned char* lds, const bf16_t* qptr,
                                         f32x4 (&O)[4][4], float (&m)[4], float (&l)[4], int tile, bool selbit, const NsaLane& L, int qrow) {
#pragma unroll 1
    for (int hf = 0; hf < 2; ++hf) nsa_half<BR, PASS>(kL, vL, lds, qptr, O, m, l, tile, hf, selbit, L, qrow);
}

__device__ void nsa_item(const Params& p, int item, unsigned char* lds) {
    unsigned char* ws = launder(p.ws);
    const int tid = threadIdx.x + vzero(), lane = tid & 63, wid = tid >> 6, fr = lane & 15, fq = lane >> 4;
    const int combo = item & 3, qt = 127 - (item >> 2), b = combo >> 1, g = combo & 1;
    const int q0 = qt * 64, qrow = 16 * wid + fr;
    NsaLane L; L.t = q0 + qrow; L.fr = fr; L.fq = fq; L.wid = wid; L.lane = lane;
    const size_t tok = (size_t)b * S_ + L.t;
    const bf16_t* P = (const bf16_t*)(ws + WS_P);
    __syncthreads();
    if (tid < 128) ((float*)(lds + NSA_BIAS))[tid] = p.rel_bias[(tid & 31) * 8 + 4 * g + (tid >> 5)];
    for (int i = tid; i < 64 * 129; i += NTHREADS) ((float*)(lds + NSA_IMP))[i] = 0.f;
    const bf16_t* Qf = P + tok * LD + C_QA + (4 * g) * 64 + 8 * fq;
    __syncthreads();
    f32x4 O[4][4]; float m[4], l[4];
    float* YA32 = (float*)(ws + WS_YA32) + tok * 512 + (4 * g) * 64;
    const bf16_t* gates = P + tok * LD + C_GA + (4 * g) * 3;

    const bf16_t* kc = (const bf16_t*)(ws + WS_KCC) + (size_t)(b * 2 + g) * 512 * 64;
    const bf16_t* vc = (const bf16_t*)(ws + WS_VCCT) + (size_t)(b * 2 + g) * 64 * 512;
    const int ntc = ((q0 + 32) >> 4) / 64 + 1;
#pragma unroll
    for (int nt = 0; nt < 4; ++nt) { m[nt] = -1e30f; l[nt] = 0.f; }
    load_tile64(kc, 64, lds, wid, lane);
    wait_vm0(); __syncthreads();
    for (int it = 0; it < ntc; ++it) {
        unsigned char* cur = lds + (it & 1) * 16384;
        if (it + 1 < ntc) load_tile64(kc + (size_t)(it + 1) * 64 * 64, 64, lds + ((it + 1) & 1) * 16384, wid, lane);
        nsa_tile<0, 0>(cur, cur + 8192, lds, Qf, O, m, l, it, true, L, qrow);
        wait_vm0(); __syncthreads();
    }
#pragma unroll
    for (int nt = 0; nt < 4; ++nt) l[nt] = l[nt] > 0.f ? 1.f / l[nt] : 0.f;
#pragma unroll
    for (int mt = 0; mt < 4; ++mt)
#pragma unroll
        for (int nt = 0; nt < 4; ++nt) O[mt][nt] = (f32x4){0.f, 0.f, 0.f, 0.f};
    load_tile64(kc, 64, lds, wid, lane); load_tile64(vc, 512, lds + 8192, wid, lane);
    wait_vm0(); __syncthreads();
    for (int it = 0; it < ntc; ++it) {
        unsigned char* cur = lds + (it & 1) * 16384;
        if (it + 1 < ntc) { unsigned char* nx = lds + ((it + 1) & 1) * 16384;
            load_tile64(kc + (size_t)(it + 1) * 64 * 64, 64, nx, wid, lane); load_tile64(vc + (it + 1) * 64, 512, nx + 8192, wid, lane); }
        nsa_tile<0, 1>(cur, cur + 8192, lds, Qf, O, m, l, it, true, L, qrow);
        wait_vm0(); __syncthreads();
    }
#pragma unroll
    for (int nt = 0; nt < 4; ++nt) {
        const float gt = bf2f(gates[nt * 3 + 0]);
#pragma unroll
        for (int mt = 0; mt < 4; ++mt) *(f32x4*)(YA32 + nt * 64 + 16 * mt + 4 * fq) = O[mt][nt] * gt;
    }
    const int cur = qt;
    unsigned selw[4];
    {
        float* imp = (float*)(lds + NSA_IMP) + qrow * 129 + 32 * fq;
        asm volatile("s_waitcnt lgkmcnt(0)" ::: "memory"); __builtin_amdgcn_wave_barrier();
#pragma unroll
        for (int i = 0; i < 32; ++i) {
            const int j = 32 * fq + i;
            const float v = imp[i];
            imp[i] = j > cur ? -1.f : v + ((j == 0 || j == cur || j == cur - 1) ? 1.0e4f : 0.f);
        }
        unsigned word = 0;
#pragma unroll 1
        for (int round = 0; round < 16; ++round) {
            float bv = imp[0]; int bi = 0;
#pragma unroll
            for (int i = 1; i < 32; ++i) { const float v = imp[i]; if (v > bv) { bv = v; bi = i; } }
            int gi = 32 * fq + bi;
#pragma unroll
            for (int off = 16; off <= 32; off <<= 1) {
                const float ov = __shfl_xor(bv, off); const int oi = __shfl_xor(gi, off);
                if (ov > bv || (ov == bv && oi < gi)) { bv = ov; gi = oi; }
            }
            if (bv >= 0.f && (gi >> 5) == fq) { word |= 1u << (gi & 31); imp[gi & 31] = -2.f; }
        }
#pragma unroll
        for (int pp = 0; pp < 4; ++pp) selw[pp] = (unsigned)__shfl((int)word, fr + 16 * pp);
    }
#pragma unroll
    for (int nt = 0; nt < 4; ++nt) { m[nt] = -1e30f; l[nt] = 0.f; }
#pragma unroll
    for (int mt = 0; mt < 4; ++mt)
#pragma unroll
        for (int nt = 0; nt < 4; ++nt) O[mt][nt] = (f32x4){0.f, 0.f, 0.f, 0.f};
    {
        const bf16_t* kb = P + ((size_t)b * S_) * LD + C_KS + g * 64;
        const bf16_t* vb = (const bf16_t*)(ws + WS_VST) + (size_t)(b * 2 + g) * 64 * S_;
        const int nts = cur + 1;
        load_tile64(kb, LD, lds, wid, lane); load_tile64(vb, S_, lds + 8192, wid, lane);
        wait_vm0(); __syncthreads();
        for (int it = 0; it < nts; ++it) {
            unsigned char* cu = lds + (it & 1) * 16384;
            if (it + 1 < nts) { unsigned char* nx = lds + ((it + 1) & 1) * 16384;
                load_tile64(kb + (size_t)(it + 1) * 64 * LD, LD, nx, wid, lane); load_tile64(vb + (it + 1) * 64, S_, nx + 8192, wid, lane); }
            const unsigned w = it < 32 ? selw[0] : it < 64 ? selw[1] : it < 96 ? selw[2] : selw[3];
            const bool sb = (w >> (it & 31)) & 1u;
            if (__ballot(sb) != 0ull) nsa_tile<1, 2>(cu, cu + 8192, lds, Qf, O, m, l, it, sb, L, qrow);
            wait_vm0(); __syncthreads();
        }
    }
#pragma unroll
    for (int nt = 0; nt < 4; ++nt) {
        const float gt = bf2f(gates[nt * 3 + 1]) * (l[nt] > 0.f ? 1.f / l[nt] : 0.f);
#pragma unroll
        for (int mt = 0; mt < 4; ++mt) { f32x4* q = (f32x4*)(YA32 + nt * 64 + 16 * mt + 4 * fq); *q = *q + O[mt][nt] * gt; }
    }
#pragma unroll
    for (int nt = 0; nt < 4; ++nt) { m[nt] = -1e30f; l[nt] = 0.f; }
#pragma unroll
    for (int mt = 0; mt < 4; ++mt)
#pragma unroll
        for (int nt = 0; nt < 4; ++nt) O[mt][nt] = (f32x4){0.f, 0.f, 0.f, 0.f};
    {
        const bf16_t* kb = P + ((size_t)b * S_) * LD + C_KW + g * 64;
        const bf16_t* vb = (const bf16_t*)(ws + WS_VWT) + (size_t)(b * 2 + g) * 64 * S_;
        const int k_lo = qt - 8 > 0 ? qt - 8 : 0, ntw = qt - k_lo + 1;
        load_tile64(kb + (size_t)k_lo * 64 * LD, LD, lds, wid, lane); load_tile64(vb + k_lo * 64, S_, lds + 8192, wid, lane);
        wait_vm0(); __syncthreads();
        for (int it = 0; it < ntw; ++it) {
            unsigned char* cu = lds + (it & 1) * 16384;
            if (it + 1 < ntw) { unsigned char* nx = lds + ((it + 1) & 1) * 16384;
                load_tile64(kb + (size_t)(k_lo + it + 1) * 64 * LD, LD, nx, wid, lane); load_tile64(vb + (k_lo + it + 1) * 64, S_, nx + 8192, wid, lane); }
            nsa_tile<2, 2>(cu, cu + 8192, lds, Qf, O, m, l, k_lo + it, true, L, qrow);
            wait_vm0(); __syncthreads();
        }
    }
    bf16_t* YA = (bf16_t*)(ws + WS_YA) + tok * 512 + (4 * g) * 64;
#pragma unroll
    for (int nt = 0; nt < 4; ++nt) {
        const float gt = bf2f(gates[nt * 3 + 2]) * (l[nt] > 0.f ? 1.f / l[nt] : 0.f);
#pragma unroll
        for (int mt = 0; mt < 4; ++mt) {
            const f32x4 v = *(const f32x4*)(YA32 + nt * 64 + 16 * mt + 4 * fq) + O[mt][nt] * gt;
            *(u32x2*)(YA + nt * 64 + 16 * mt + 4 * fq) = pack4(v);
        }
    }
}

__device__ void scan_item(const Params& p, int item) {
    unsigned char* ws = launder(p.ws);
    const int idx = item * NTHREADS + threadIdx.x;
    const int bh = idx >> 13, ed = idx & 8191, h = bh & 7;
    const float dec = exp2f(128.f * ret_lg2(h));
    const float* KVT = (const float*)(ws + WS_KVT) + (size_t)bh * 64 * 8192 + ed;
    bf16_t* SPT = (bf16_t*)(ws + WS_SPT) + (size_t)bh * 64 * 8192 + ed;
    float s = 0.f;
    for (int n = 0; n < 64; ++n) { SPT[(size_t)n * 8192] = f2bf(s); s = s * dec + KVT[(size_t)n * 8192]; }
}

__device__ void phase_p3(const Params& p, unsigned char* lds) {
    for (int i = threadIdx.x; i < 8192 / 16; i += NTHREADS) ((u32x4*)(lds + NSA_BUCKET))[i] = ((const u32x4*)(p.ws + WS_BUCKET))[i];
    __syncthreads();
    for (int it = blockIdx.x; it < 512 + 512; it += gridDim.x) {
        if (it < 512) nsa_item(p, it, lds); else scan_item(p, it - 512);
    }
}

__device__ void retout_item(const Params& p, int item, unsigned char* lds) {
    unsigned char* ws = launder(p.ws);
    const int tid = threadIdx.x + vzero(), lane = tid & 63, wid = tid >> 6, fr = lane & 15, fq = lane >> 4;
    const int n = item & 63, h = (item >> 6) & 7, b = item >> 9;
    const size_t tok0 = (size_t)b * S_ + 128 * n;
    const bf16_t* P = (const bf16_t*)(ws + WS_P);
    unsigned char* vL = lds; unsigned char* kL = lds + 32768; unsigned char* sL = lds + 49152;
    __syncthreads();
    load_tile128w((const bf16_t*)(ws + WS_VRT) + ((size_t)(b * 8 + h) * 128) * S_ + 128 * n, S_, vL, wid, lane);
    load_tile128(P + tok0 * LD + C_KR + h * 64, LD, kL, wid, lane);
    load_tile128((const bf16_t*)(ws + WS_SPT) + ((size_t)(b * 8 + h) * 64 + n) * 8192, 64, sL, wid, lane);
    bf16x8 Qf[2][2];
#pragma unroll
    for (int nt = 0; nt < 2; ++nt)
#pragma unroll
        for (int ks = 0; ks < 2; ++ks) Qf[nt][ks] = *(const bf16x8*)(P + (tok0 + 32 * wid + 16 * nt + fr) * LD + C_QR + h * 64 + 32 * ks + 8 * fq);
    wait_vm0(); __syncthreads();
    const float lg2 = ret_lg2(h);
    f32x4 Y[8][2];
#pragma unroll
    for (int m = 0; m < 8; ++m)
#pragma unroll
        for (int nt = 0; nt < 2; ++nt) Y[m][nt] = (f32x4){0.f, 0.f, 0.f, 0.f};
#pragma unroll
    for (int m = 0; m < 8; ++m)
#pragma unroll
        for (int ks = 0; ks < 2; ++ks) {
            const bf16x8 a = lds_frag128(sL, 16 * m + fr, 4 * ks + fq);
#pragma unroll
            for (int nt = 0; nt < 2; ++nt) Y[m][nt] = mfma16(a, Qf[nt][ks], Y[m][nt]);
        }
#pragma unroll
    for (int nt = 0; nt < 2; ++nt) {
        const float sc = exp2f((float)(32 * wid + 16 * nt + fr + 1) * lg2);
#pragma unroll
        for (int m = 0; m < 8; ++m) Y[m][nt] = Y[m][nt] * sc;
    }
#pragma unroll 1
    for (int s = 0; s < 4; ++s) {
        f32x4 St[2][2];
#pragma unroll
        for (int hh = 0; hh < 2; ++hh) {
            const int mt = 2 * s + hh;
#pragma unroll
            for (int nt = 0; nt < 2; ++nt) St[hh][nt] = (f32x4){0.f, 0.f, 0.f, 0.f};
#pragma unroll
            for (int ks = 0; ks < 2; ++ks) {
                const bf16x8 a = lds_frag128(kL, 16 * mt + fr, 4 * ks + fq);
#pragma unroll
                for (int nt = 0; nt < 2; ++nt) St[hh][nt] = mfma16(a, Qf[nt][ks], St[hh][nt]);
            }
#pragma unroll
            for (int nt = 0; nt < 2; ++nt) {
                const int qi = 32 * wid + 16 * nt + fr;
#pragma unroll
                for (int r = 0; r < 4; ++r) {
                    const int kj = 16 * mt + 4 * fq + r;
                    const float dm = qi >= kj ? exp2f((float)(qi - kj) * lg2) : 0.f;
                    St[hh][nt][r] *= dm;
                }
            }
        }
        bf16x8 Pb[2];
#pragma unroll
        for (int nt = 0; nt < 2; ++nt) Pb[nt] = pack8(St[0][nt], St[1][nt]);
#pragma unroll
        for (int m = 0; m < 8; ++m) {
            const bf16x8 a = lds_vfrag256(vL, 16 * m + fr, 32 * s, fq);
#pragma unroll
            for (int nt = 0; nt < 2; ++nt) Y[m][nt] = mfma16(a, Pb[nt], Y[m][nt]);
        }
    }
    bf16_t* YB = (bf16_t*)(ws + WS_YB);
#pragma unroll
    for (int nt = 0; nt < 2; ++nt) {
        float sum = 0.f;
#pragma unroll
        for (int m = 0; m < 8; ++m) sum += Y[m][nt][0] + Y[m][nt][1] + Y[m][nt][2] + Y[m][nt][3];
        sum += __shfl_xor(sum, 16); sum += __shfl_xor(sum, 32);
        const float mu = sum * (1.f / 128.f);
        float vs = 0.f;
#pragma unroll
        for (int m = 0; m < 8; ++m)
#pragma unroll
            for (int r = 0; r < 4; ++r) { const float dlt = Y[m][nt][r] - mu; vs += dlt * dlt; }
        vs += __shfl_xor(vs, 16); vs += __shfl_xor(vs, 32);
        const float rstd = rsqrtf(vs * (1.f / 128.f) + 1e-5f);
        const size_t tk = tok0 + 32 * wid + 16 * nt + fr;
#pragma unroll
        for (int m = 0; m < 8; ++m) {
            const f32x4 gt = unpack4(*(const u32x2*)(P + tk * LD + C_GR + h * 128 + 16 * m + 4 * fq));
            f32x4 v;
#pragma unroll
            for (int r = 0; r < 4; ++r) v[r] = (Y[m][nt][r] - mu) * rstd * gt[r];
            *(u32x2*)(YB + tk * 1024 + h * 128 + 16 * m + 4 * fq) = pack4(v);
        }
    }
}
__device__ void phase_p4(const Params& p, unsigned char* lds) {
    for (int it = blockIdx.x; it < 1024; it += gridDim.x) retout_item(p, it, lds);
}

__device__ void phase_g2(const Params& p, unsigned char* lds) {
    unsigned char* ws = launder(p.ws);
    const bf16_t* P = (const bf16_t*)(ws + WS_P);
    for (int t = blockIdx.x; t < 128 * 8; t += gridDim.x) {
        const int mt = t >> 3, nt = t & 7, m0 = mt * 128, n0 = nt * 128;
        const int tid = threadIdx.x + vzero(), lane = tid & 63, wid = tid >> 6, wr = wid >> 1, wc = wid & 1, fr = lane & 15, fq = lane >> 4;
        const int ldrow = 8 * wid + (lane >> 3), ldc = ((lane & 7) ^ (lane >> 3)) * 8;
        const bf16_t* mp[4]; const bf16_t* np[4];
        bf16_t* MG = (bf16_t*)(ws + WS_MG);
        { f32x4 acc1[4][4]; zero_acc(acc1);
#pragma unroll
        for (int i = 0; i < 4; ++i) { mp[i] = (const bf16_t*)(ws + WS_WA) + (size_t)(n0 + 32 * i + ldrow) * 512 + ldc; np[i] = (const bf16_t*)(ws + WS_YA) + (size_t)(m0 + 32 * i + ldrow) * 512 + ldc; }
        gemm_kloop(mp, np, 8, lds, acc1);
#pragma unroll
        for (int mi = 0; mi < 4; ++mi)
#pragma unroll
            for (int ni = 0; ni < 4; ++ni) {
                const int n = n0 + 64 * wr + 16 * mi + 4 * fq; const size_t tok = m0 + 64 * wc + 16 * ni + fr;
                const f32x4 ga = unpack4(*(const u32x2*)(P + tok * LD + C_MA + n));
                *(u32x2*)(MG + tok * 1024 + n) = pack4(ga * acc1[mi][ni]);
            } }
        { f32x4 acc2[4][4]; zero_acc(acc2);
#pragma unroll
        for (int i = 0; i < 4; ++i) { mp[i] = (const bf16_t*)(ws + WS_WB) + (size_t)(n0 + 32 * i + ldrow) * 1024 + ldc; np[i] = (const bf16_t*)(ws + WS_YB) + (size_t)(m0 + 32 * i + ldrow) * 1024 + ldc; }
        gemm_kloop(mp, np, 16, lds, acc2);
#pragma unroll
        for (int mi = 0; mi < 4; ++mi)
#pragma unroll
            for (int ni = 0; ni < 4; ++ni) {
                const int n = n0 + 64 * wr + 16 * mi + 4 * fq; const size_t tok = m0 + 64 * wc + 16 * ni + fr;
                const f32x4 gb = unpack4(*(const u32x2*)(P + tok * LD + C_MB + n));
                const f32x4 v = unpack4(*(const u32x2*)(MG + tok * 1024 + n)) + gb * acc2[mi][ni];
                *(u32x2*)(MG + tok * 1024 + n) = pack4(v);
            } }
    }
}

__device__ void phase_g3(const Params& p, int layer, unsigned char* lds) {
    unsigned char* ws = launder(p.ws);
    const int tid = threadIdx.x + vzero(), lane = tid & 63, wid = tid >> 6, wr = wid >> 1, wc = wid & 1, fr = lane & 15, fq = lane >> 4;
    const int ldrow = 8 * wid + (lane >> 3), ldc = ((lane & 7) ^ (lane >> 3)) * 8;
    const float* X = layer == 0 ? p.x : (const float*)(ws + WS_X);
    float* H1 = (float*)(ws + WS_H1);
    for (int t = blockIdx.x; t < 128 * 8; t += gridDim.x) {
        const int mt = t >> 3, nt = t & 7, m0 = mt * 128, n0 = nt * 128;
        const bf16_t* mp[4]; const bf16_t* np[4];
        f32x4 acc[4][4]; zero_acc(acc);
#pragma unroll
        for (int i = 0; i < 4; ++i) { mp[i] = (const bf16_t*)(ws + WS_WO) + (size_t)(n0 + 32 * i + ldrow) * 1024 + ldc; np[i] = (const bf16_t*)(ws + WS_MG) + (size_t)(m0 + 32 * i + ldrow) * 1024 + ldc; }
        gemm_kloop(mp, np, 16, lds, acc);
#pragma unroll
        for (int mi = 0; mi < 4; ++mi)
#pragma unroll
            for (int ni = 0; ni < 4; ++ni) {
                const int n = n0 + 64 * wr + 16 * mi + 4 * fq; const size_t tok = m0 + 64 * wc + 16 * ni + fr;
                const f32x4 xv = *(const f32x4*)(X + tok * 1024 + n);
                *(f32x4*)(H1 + tok * 1024 + n) = xv * DN_ALPHA + acc[mi][ni];
            }
    }
}

__device__ void phase_ln1(const Params& p, int layer, unsigned char* lds) {
    unsigned char* ws = launder(p.ws);
    const int tid = threadIdx.x + vzero(), lane = tid & 63, wid = tid >> 6;
    float* wrL = (float*)lds;
    for (int i = tid; i < 1024 * 16 / 4; i += NTHREADS) ((float4*)wrL)[i] = ((const float4*)p.w_router)[i];
    __syncthreads();
    const float* H1 = (const float*)(ws + WS_H1);
    float* X1 = (float*)(ws + WS_X1); bf16_t* X1B = (bf16_t*)(ws + WS_X1B);
    const float* gam = p.ln1_g + layer * 1024; const float* bet = p.ln1_b + layer * 1024;
    unsigned* cnt = (unsigned*)(ws + WS_CTL) + CW_CNT + layer * 16;
    int* LIST = (int*)(ws + WS_LIST); float* WTS = (float*)(ws + WS_WTS);
    for (int tok = blockIdx.x * 4 + wid; tok < T_; tok += gridDim.x * 4) {
        float4 v[4];
#pragma unroll
        for (int j = 0; j < 4; ++j) v[j] = *(const float4*)(H1 + (size_t)tok * 1024 + 256 * j + 4 * lane);
        float s = 0.f;
#pragma unroll
        for (int j = 0; j < 4; ++j) s += v[j].x + v[j].y + v[j].z + v[j].w;
#pragma unroll
        for (int o = 1; o < 64; o <<= 1) s += __shfl_xor(s, o);
        const float mu = s * (1.f / 1024.f);
        float q = 0.f;
#pragma unroll
        for (int j = 0; j < 4; ++j) { const float a = v[j].x - mu, b2 = v[j].y - mu, c = v[j].z - mu, d = v[j].w - mu; q += a * a + b2 * b2 + c * c + d * d; }
#pragma unroll
        for (int o = 1; o < 64; o <<= 1) q += __shfl_xor(q, o);
        const float rstd = rsqrtf(q * (1.f / 1024.f) + 1e-5f);
        float lg[16];
#pragma unroll
        for (int e = 0; e < 16; ++e) lg[e] = 0.f;
#pragma unroll
        for (int j = 0; j < 4; ++j) {
            const int d0 = 256 * j + 4 * lane;
            const float4 gg = *(const float4*)(gam + d0), bb = *(const float4*)(bet + d0);
            float4 y; y.x = (v[j].x - mu) * rstd * gg.x + bb.x; y.y = (v[j].y - mu) * rstd * gg.y + bb.y; y.z = (v[j].z - mu) * rstd * gg.z + bb.z; y.w = (v[j].w - mu) * rstd * gg.w + bb.w;
            *(float4*)(X1 + (size_t)tok * 1024 + d0) = y;
            u32x2 w; w.x = pack2(y.x, y.y); w.y = pack2(y.z, y.w);
            *(u32x2*)(X1B + (size_t)tok * 1024 + d0) = w;
            const float yy[4] = {y.x, y.y, y.z, y.w};
#pragma unroll
            for (int c = 0; c < 4; ++c) {
                const float4* wp = (const float4*)(wrL + (d0 + c) * 16);
#pragma unroll
                for (int e4 = 0; e4 < 4; ++e4) { const float4 w4 = wp[e4]; lg[4 * e4 + 0] += yy[c] * w4.x; lg[4 * e4 + 1] += yy[c] * w4.y; lg[4 * e4 + 2] += yy[c] * w4.z; lg[4 * e4 + 3] += yy[c] * w4.w; }
                asm volatile("" ::: "memory");
            }
        }
#pragma unroll
        for (int e = 0; e < 16; ++e) {
#pragma unroll
            for (int o = 1; o < 64; o <<= 1) lg[e] += __shfl_xor(lg[e], o);
        }
        float mx = lg[0];
#pragma unroll
        for (int e = 1; e < 16; ++e) mx = fmaxf(mx, lg[e]);
        float pr[16], ps = 0.f;
#pragma unroll
        for (int e = 0; e < 16; ++e) { pr[e] = expf(lg[e] - mx); ps += pr[e]; }
        const float ips = 1.f / ps;
        float sel[16];
#pragma unroll
        for (int e = 0; e < 16; ++e) { pr[e] *= ips; sel[e] = pr[e] + p.router_bias[e]; }
        int best = 0; float bestv = -1e30f;
#pragma unroll
        for (int gI = 0; gI < 4; ++gI) {
            float a = -1e30f, b2 = -1e30f;
#pragma unroll
            for (int k = 0; k < 4; ++k) { const float x = sel[4 * gI + k]; if (x > a) { b2 = a; a = x; } else if (x > b2) b2 = x; }
            const float gs = a + b2;
            if (gs > bestv) { bestv = gs; best = gI; }
        }
        float s4[4], p4[4];
#pragma unroll
        for (int k = 0; k < 4; ++k) { s4[k] = 0.f; p4[k] = 0.f; }
#pragma unroll
        for (int gI = 0; gI < 4; ++gI) if (gI == best) {
#pragma unroll
            for (int k = 0; k < 4; ++k) { s4[k] = sel[4 * gI + k]; p4[k] = pr[4 * gI + k]; }
        }
        int i0 = 0; float a0 = s4[0];
#pragma unroll
        for (int k = 1; k < 4; ++k) if (s4[k] > a0) { a0 = s4[k]; i0 = k; }
        int i1 = -1; float a1 = -1e30f;
#pragma unroll
        for (int k = 0; k < 4; ++k) if (k != i0 && s4[k] > a1) { a1 = s4[k]; i1 = k; }
        float w0 = 0.f, w1 = 0.f;
#pragma unroll
        for (int k = 0; k < 4; ++k) { if (k == i0) w0 = p4[k]; if (k == i1) w1 = p4[k]; }
        const float iw = 1.f / (w0 + w1);
        if (lane == 0) {
            const int e0 = best * 4 + i0, e1 = best * 4 + i1;
            const unsigned p0 = atomicAdd(&cnt[e0], 1u); LIST[(size_t)e0 * T_ + p0] = tok * 2;
            const unsigned p1 = atomicAdd(&cnt[e1], 1u); LIST[(size_t)e1 * T_ + p1] = tok * 2 + 1;
            WTS[tok * 2] = w0 * iw; WTS[tok * 2 + 1] = w1 * iw;
        }
    }
}

__device__ __forceinline__ bool moe_find(const unsigned* cnt, int t, int colTiles, int& e, int& rt, int& ct, int& cnte, int& off) {
    int base = 0; off = 0;
    for (int k = 0; k < NE; ++k) {
        const int c = __builtin_amdgcn_readfirstlane((int)cnt[k]), nt = ((c + 127) >> 7) * colTiles;
        if (t < base + nt) { e = k; cnte = c; const int u = t - base; rt = u / colTiles; ct = u % colTiles;
            e = __builtin_amdgcn_readfirstlane(e); cnte = __builtin_amdgcn_readfirstlane(cnte); rt = __builtin_amdgcn_readfirstlane(rt);
            ct = __builtin_amdgcn_readfirstlane(ct); off = __builtin_amdgcn_readfirstlane(off); return true; }
        base += nt; off += c;
    }
    return false;
}
__device__ void phase_m2(const Params& p, int layer, unsigned char* lds) {
    unsigned char* ws = launder(p.ws);
    const int tid = threadIdx.x + vzero(), lane = tid & 63, wid = tid >> 6, wr = wid >> 1, wc = wid & 1, fr = lane & 15, fq = lane >> 4;
    const int ldrow = 8 * wid + (lane >> 3), ldc = ((lane & 7) ^ (lane >> 3)) * 8;
    const unsigned* cnt = (const unsigned*)(ws + WS_CTL) + CW_CNT + layer * 16 + vzero();
    const int* LIST = (const int*)(ws + WS_LIST);
    const bf16_t* X1B = (const bf16_t*)(ws + WS_X1B);
    bf16_t* HB = (bf16_t*)(ws + WS_HB);
    for (int t = blockIdx.x;; t += gridDim.x) {
        int e, rt, ct, cnte, off;
        if (!moe_find(cnt, t, 8, e, rt, ct, cnte, off)) break;
        const bf16_t* mp[4]; const bf16_t* np[4];
#pragma unroll
        for (int i = 0; i < 4; ++i) {
            const int rho = 32 * i + ldrow, blk = rho >> 4, nn = ct * 64 + (blk >> 1) * 16 + (rho & 15);
            mp[i] = (const bf16_t*)(ws + ((blk & 1) ? WS_WU : WS_WG)) + ((size_t)e * 512 + nn) * 1024 + ldc;
            int idx = rt * 128 + rho; idx = idx < cnte ? idx : cnte - 1;
            const int a = LIST[(size_t)e * T_ + idx];
            np[i] = X1B + (size_t)(a >> 1) * 1024 + ldc;
        }
        f32x4 acc[4][4]; zero_acc(acc);
        gemm_kloop(mp, np, 16, lds, acc);
#pragma unroll
        for (int mp2 = 0; mp2 < 2; ++mp2)
#pragma unroll
            for (int ni = 0; ni < 4; ++ni) {
                const int idx = rt * 128 + 64 * wc + 16 * ni + fr;
                if (idx < cnte) {
                    const int n = ct * 64 + (2 * wr + mp2) * 16 + 4 * fq;
                    const f32x4 gv = acc[2 * mp2][ni], uv = acc[2 * mp2 + 1][ni];
                    f32x4 hv;
#pragma unroll
                    for (int r = 0; r < 4; ++r) hv[r] = gv[r] * sigmoidf_(gv[r]) * uv[r];
                    *(u32x2*)(HB + (size_t)(off + idx) * 512 + n) = pack4(hv);
                }
            }
    }
}
__device__ void phase_m3(const Params& p, int layer, unsigned char* lds) {
    unsigned char* ws = launder(p.ws);
    const int tid = threadIdx.x + vzero(), lane = tid & 63, wid = tid >> 6, wr = wid >> 1, wc = wid & 1, fr = lane & 15, fq = lane >> 4;
    const int ldrow = 8 * wid + (lane >> 3), ldc = ((lane & 7) ^ (lane >> 3)) * 8;
    const unsigned* cnt = (const unsigned*)(ws + WS_CTL) + CW_CNT + layer * 16 + vzero();
    const int* LIST = (const int*)(ws + WS_LIST);
    const bf16_t* HB = (const bf16_t*)(ws + WS_HB);
    bf16_t* CT = (bf16_t*)(ws + WS_CT);
    for (int t = blockIdx.x;; t += gridDim.x) {
        int e, rt, ct, cnte, off;
        if (!moe_find(cnt, t, 8, e, rt, ct, cnte, off)) break;
        const bf16_t* mp[4]; const bf16_t* np[4];
#pragma unroll
        for (int i = 0; i < 4; ++i) {
            const int rho = 32 * i + ldrow;
            mp[i] = (const bf16_t*)(ws + WS_WD) + ((size_t)e * 1024 + ct * 128 + rho) * 512 + ldc;
            int idx = rt * 128 + rho; idx = idx < cnte ? idx : cnte - 1;
            np[i] = HB + (size_t)(off + idx) * 512 + ldc;
        }
        f32x4 acc[4][4]; zero_acc(acc);
        gemm_kloop(mp, np, 8, lds, acc);
#pragma unroll
        for (int ni = 0; ni < 4; ++ni) {
            const int idx = rt * 128 + 64 * wc + 16 * ni + fr;
            if (idx < cnte) {
                const int a = LIST[(size_t)e * T_ + idx];
#pragma unroll
                for (int mi = 0; mi < 4; ++mi) {
                    const int n = ct * 128 + 64 * wr + 16 * mi + 4 * fq;
                    *(u32x2*)(CT + (size_t)a * 1024 + n) = pack4(acc[mi][ni]);
                }
            }
        }
    }
}

__device__ void phase_ln2(const Params& p, int layer) {
    unsigned char* ws = launder(p.ws);
    const int tid = threadIdx.x + vzero(), lane = tid & 63, wid = tid >> 6;
    const float* X1 = (const float*)(ws + WS_X1); const bf16_t* CT = (const bf16_t*)(ws + WS_CT); const float* WTS = (const float*)(ws + WS_WTS);
    float* XO = layer == NLAYER - 1 ? p.out : (float*)(ws + WS_X); bf16_t* XB = (bf16_t*)(ws + WS_XB);
    const float* gam = p.ln2_g + layer * 1024; const float* bet = p.ln2_b + layer * 1024;
    for (int tok = blockIdx.x * 4 + wid; tok < T_; tok += gridDim.x * 4) {
        const float w0 = WTS[tok * 2 + vzero()], w1 = WTS[tok * 2 + 1 + vzero()];
        float4 v[4];
#pragma unroll
        for (int j = 0; j < 4; ++j) {
            const int d0 = 256 * j + 4 * lane;
            const float4 xv = *(const float4*)(X1 + (size_t)tok * 1024 + d0);
            const f32x4 c0 = unpack4(*(const u32x2*)(CT + (size_t)(tok * 2) * 1024 + d0)), c1 = unpack4(*(const u32x2*)(CT + (size_t)(tok * 2 + 1) * 1024 + d0));
            v[j].x = xv.x * DN_ALPHA + w0 * c0[0] + w1 * c1[0]; v[j].y = xv.y * DN_ALPHA + w0 * c0[1] + w1 * c1[1];
            v[j].z = xv.z * DN_ALPHA + w0 * c0[2] + w1 * c1[2]; v[j].w = xv.w * DN_ALPHA + w0 * c0[3] + w1 * c1[3];
        }
        float s = 0.f;
#pragma unroll
        for (int j = 0; j < 4; ++j) s += v[j].x + v[j].y + v[j].z + v[j].w;
#pragma unroll
        for (int o = 1; o < 64; o <<= 1) s += __shfl_xor(s, o);
        const float mu = s * (1.f / 1024.f);
        float q = 0.f;
#pragma unroll
        for (int j = 0; j < 4; ++j) { const float a = v[j].x - mu, b2 = v[j].y - mu, c = v[j].z - mu, d = v[j].w - mu; q += a * a + b2 * b2 + c * c + d * d; }
#pragma unroll
        for (int o = 1; o < 64; o <<= 1) q += __shfl_xor(q, o);
        const float rstd = rsqrtf(q * (1.f / 1024.f) + 1e-5f);
#pragma unroll
        for (int j = 0; j < 4; ++j) {
            const int d0 = 256 * j + 4 * lane;
            const float4 gg = *(const float4*)(gam + d0), bb = *(const float4*)(bet + d0);
            float4 y; y.x = (v[j].x - mu) * rstd * gg.x + bb.x; y.y = (v[j].y - mu) * rstd * gg.y + bb.y; y.z = (v[j].z - mu) * rstd * gg.z + bb.z; y.w = (v[j].w - mu) * rstd * gg.w + bb.w;
            *(float4*)(XO + (size_t)tok * 1024 + d0) = y;
            u32x2 w; w.x = pack2(y.x, y.y); w.y = pack2(y.z, y.w);
            *(u32x2*)(XB + (size_t)tok * 1024 + d0) = w;
        }
    }
}

#define XB_TMO      128
#define XB_XCNT(j)  (256  + 64 * (j))
#define XB_XSUB(j)  (1280 + 64 * (j))
#define XB_XGEN(j)  (2304 + 64 * (j))
#define XB_TOP      3328
#define XB_TOPGEN   3392
#define XCD_BAR_WORDS 3456
#define XB_SPIN_CAP (1u << 22)
#define LAS __attribute__((address_space(3)))
__device__ __forceinline__ unsigned xb_ld(unsigned* p)              { return __hip_atomic_load(p, __ATOMIC_RELAXED, __HIP_MEMORY_SCOPE_AGENT); }
__device__ __forceinline__ unsigned xb_add(unsigned* p, unsigned v) { return __hip_atomic_fetch_add(p, v, __ATOMIC_RELAXED, __HIP_MEMORY_SCOPE_AGENT); }
__device__ __forceinline__ unsigned xb_xcc_id() { return (unsigned)__builtin_amdgcn_s_getreg((3 << 11) | 20) & 0xFu; }
#define XB_SPIN(cond, bar) do { unsigned _sp = 0; while (cond) { __builtin_amdgcn_s_sleep(1); \
    if ((++_sp & 255u) == 0u) { if (xb_ld(&(bar)[XB_TMO])) break; if (_sp > XB_SPIN_CAP) { atomicAdd(&(bar)[XB_TMO], 1u); break; } } } } while (0)
struct XcdBarrier { unsigned* bar; unsigned x; volatile LAS unsigned* st; };
__device__ __forceinline__ XcdBarrier xcd_barrier_post(unsigned* bar, volatile LAS unsigned* st) {
    XcdBarrier b; b.bar = bar; b.x = xb_xcc_id(); b.st = st;
    if (threadIdx.x == 0) (void)xb_add(&bar[XB_XCNT(b.x)], 1u);
    return b;
}
__device__ __forceinline__ void xcd_barrier_complete(unsigned* bar, unsigned x, unsigned& nloc, unsigned& nx) {
    const unsigned G = gridDim.x * gridDim.y * gridDim.z;
    unsigned sum, cnt, mine, sp = 0u;
    for (;;) {
        sum = 0u; cnt = 0u; mine = 0u;
#pragma unroll
        for (unsigned j = 0; j < 16; ++j) { const unsigned c = xb_ld(&bar[XB_XCNT(j)]); sum += c; cnt += (c > 0u) ? 1u : 0u; mine = (j == x) ? c : mine; }
        if (sum == G) break;
        __builtin_amdgcn_s_sleep(1);
        if ((++sp & 255u) == 0u) { if (xb_ld(&bar[XB_TMO])) break; if (sp > XB_SPIN_CAP) { atomicAdd(&bar[XB_TMO], 1u); break; } }
    }
    nloc = mine > 0u ? mine : 1u; nx = cnt > 0u ? cnt : 1u;
}
__device__ __forceinline__ void xcd_barrier(const XcdBarrier& b) {
    asm volatile("s_waitcnt vmcnt(0)" ::: "memory");
    __syncthreads();
    if (threadIdx.x == 0) {
        unsigned* bar = b.bar;
        __builtin_amdgcn_s_waitcnt(0);
        unsigned nloc = b.st[0], nx = b.st[1];
        if (nloc == 0u) { xcd_barrier_complete(bar, b.x, nloc, nx); b.st[0] = nloc; b.st[1] = nx; }
        const unsigned old = xb_add(&bar[XB_XSUB(b.x)], 1u);
        const unsigned gen = old / nloc;
        if (old + 1u == (gen + 1u) * nloc) {
            __builtin_amdgcn_fence(__ATOMIC_RELEASE, "agent");
            asm volatile("s_waitcnt vmcnt(0)" ::: "memory");
            const unsigned og = xb_add(&bar[XB_TOP], 1u);
            const unsigned tg = og / nx;
            if (og + 1u == (tg + 1u) * nx) xb_add(&bar[XB_TOPGEN], 1u);
            else XB_SPIN(xb_ld(&bar[XB_TOPGEN]) == tg, bar);
            __builtin_amdgcn_fence(__ATOMIC_ACQUIRE, "agent");
            xb_add(&bar[XB_XGEN(b.x)], 1u);
            asm volatile("s_waitcnt vmcnt(0)" ::: "memory");
        } else {
            XB_SPIN(xb_ld(&bar[XB_XGEN(b.x)]) == gen, bar);
            __builtin_amdgcn_fence(__ATOMIC_ACQUIRE, "agent");
            asm volatile("s_waitcnt vmcnt(0)" ::: "memory");
        }
    }
    __syncthreads();
}

constexpr int PH_PER_LAYER = 11, N_PHASES = PH_PER_LAYER * NLAYER;
__global__ void __launch_bounds__(NTHREADS, 2) mega(Params p) {
    extern __shared__ __attribute__((aligned(16))) unsigned char lds[];
#if SINGLE_LAUNCH
    volatile LAS unsigned* xbw = (volatile LAS unsigned*)(lds + LDS_BYTES - 16);
    if (threadIdx.x < 4) xbw[threadIdx.x] = 0u;
    __syncthreads();
    XcdBarrier xbar = xcd_barrier_post((unsigned*)(p.ws + WS_CTL) + CW_BAR, xbw);
#endif
    for (int ph = p.ph_lo; ph < p.ph_hi; ++ph) {
        const int layer = ph / PH_PER_LAYER, k = ph % PH_PER_LAYER;
#ifdef ONLY_PHASE
        if (k != ONLY_PHASE) continue;
#endif
#ifdef REPEAT_MASK
        for (int rep = 0; rep < (((REPEAT_MASK) >> k) & 1) + 1; ++rep) {
        if (rep) __syncthreads();
#endif
        switch (k) {
            case 0: phase_pw(p, layer, lds); break;
            case 1: phase_g1(p, layer, lds); break;
            case 2: phase_p2(p, layer, lds); break;
            case 3: phase_p3(p, lds); break;
            case 4: phase_p4(p, lds); break;
            case 5: phase_g2(p, lds); break;
            case 6: phase_g3(p, layer, lds); break;
            case 7: phase_ln1(p, layer, lds); break;
            case 8: phase_m2(p, layer, lds); break;
            case 9: phase_m3(p, layer, lds); break;
            case 10: phase_ln2(p, layer); break;
        }
#ifdef REPEAT_MASK
        }
#endif
#if SINGLE_LAUNCH
        if (ph + 1 < p.ph_hi) { if (ph == p.ph_lo) cg::this_grid().sync(); else xcd_barrier(xbar); }
#endif
    }
}

extern "C" void kernel_launch(void* const* d_in, const int* in_sizes, int n_in, void* d_out, int out_size, void* d_ws, size_t ws_size, hipStream_t stream) {
    static int grid = 0;
    if (grid == 0) {
        if (n_in != 18 || ws_size < WS_END) { fprintf(stderr, "kernel_launch: unexpected n_in %d or ws_size %zu < %zu\n", n_in, ws_size, (size_t)WS_END); grid = -1; return; }
        int dev = 0, cus = 0, per_cu = 0;
        hipGetDevice(&dev); hipDeviceGetAttribute(&cus, hipDeviceAttributeMultiprocessorCount, dev);
        hipFuncSetAttribute((const void*)mega, hipFuncAttributeMaxDynamicSharedMemorySize, LDS_BYTES);
        hipOccupancyMaxActiveBlocksPerMultiprocessor(&per_cu, (const void*)mega, NTHREADS, LDS_BYTES);
        if (per_cu < 1) per_cu = 1;
        if (per_cu > 2) per_cu = 2;
        grid = cus * per_cu;
        (void)hipGetLastError();
    }
    if (grid < 0) return;
    Params p{};
    p.x = (const float*)d_in[0]; p.w_in = (const float*)d_in[1]; p.cmp_pos = (const float*)d_in[2]; p.cmp_w1 = (const float*)d_in[3]; p.cmp_w2 = (const float*)d_in[4];
    p.w_br_a = (const float*)d_in[5]; p.w_br_b = (const float*)d_in[6]; p.w_o = (const float*)d_in[7]; p.ln1_g = (const float*)d_in[8]; p.ln1_b = (const float*)d_in[9];
    p.w_router = (const float*)d_in[10]; p.router_bias = (const float*)d_in[11]; p.w_gate = (const float*)d_in[12]; p.w_up = (const float*)d_in[13]; p.w_down = (const float*)d_in[14];
    p.ln2_g = (const float*)d_in[15]; p.ln2_b = (const float*)d_in[16]; p.rel_bias = (const float*)d_in[17];
    p.out = (float*)d_out; p.ws = (unsigned char*)d_ws;
#if SINGLE_LAUNCH
    hipMemsetAsync((unsigned char*)d_ws + WS_CTL + (size_t)CW_BAR * 4, 0, XCD_BAR_WORDS * 4, stream);
    p.ph_lo = 0; p.ph_hi = N_PHASES;
    void* args[] = {&p};
    hipError_t e = hipLaunchCooperativeKernel((const void*)mega, dim3(grid), dim3(NTHREADS), args, LDS_BYTES, stream);
    if (e != hipSuccess) fprintf(stderr, "cooperative launch failed: %s (grid %d)\n", hipGetErrorString(e), grid);
#else
    for (int ph = 0; ph < N_PHASES; ++ph) {
        p.ph_lo = ph; p.ph_hi = ph + 1;
        hipLaunchKernelGGL(mega, dim3(grid), dim3(NTHREADS), LDS_BYTES, stream, p);
    }
#endif
}
```

```cpp
#include <hip/hip_runtime.h>
#include <hip/hip_cooperative_groups.h>
#include <cstdio>
#include <cstdint>
namespace cg = cooperative_groups;

#ifndef SINGLE_LAUNCH
#define SINGLE_LAUNCH 1
#endif

typedef unsigned short bf16_t;
typedef short bf16x8 __attribute__((ext_vector_type(8)));
typedef float f32x4 __attribute__((ext_vector_type(4)));
typedef unsigned u32x2 __attribute__((ext_vector_type(2)));
typedef unsigned u32x4 __attribute__((ext_vector_type(4)));

constexpr int B_ = 2, S_ = 8192, D_ = 1024, T_ = B_ * S_, NLAYER = 4;
constexpr int DIN = 6424;
constexpr int LD = 6528;
constexpr int C_QA = 0, C_KC = 512, C_VC = 640, C_KS = 768, C_VS = 896, C_KW = 1024, C_VW = 1152, C_QR = 1280, C_KR = 1792,
              C_VR = 2304, C_GR = 3328, C_MA = 4352, C_MB = 5376, C_GA = 6400;
constexpr float DN_ALPHA = 1.681792830507429f;
constexpr int NE = 16;

constexpr size_t al256(size_t x) { return (x + 255) & ~(size_t)255; }
constexpr size_t WS_CTL = 0;
constexpr size_t WS_BUCKET = 65536;
constexpr size_t WS_ROPE = WS_BUCKET + 8192;
constexpr size_t WS_WIN = WS_ROPE + (size_t)8192 * 32 * 8;
constexpr size_t WS_WA = WS_WIN + (size_t)LD * 1024 * 2;
constexpr size_t WS_WB = WS_WA + (size_t)1024 * 512 * 2;
constexpr size_t WS_WO = WS_WB + (size_t)1024 * 1024 * 2;
constexpr size_t WS_WG = WS_WO + (size_t)1024 * 1024 * 2;
constexpr size_t WS_WU = WS_WG + (size_t)16 * 512 * 1024 * 2;
constexpr size_t WS_WD = WS_WU + (size_t)16 * 512 * 1024 * 2;
constexpr size_t WS_XB = WS_WD + (size_t)16 * 512 * 1024 * 2;
constexpr size_t WS_X = WS_XB + (size_t)T_ * 1024 * 2;
constexpr size_t WS_MG = WS_X + (size_t)T_ * 1024 * 4;
constexpr size_t WS_KCC = WS_MG + (size_t)T_ * 1024 * 2;
constexpr size_t WS_VCCT = WS_KCC + (size_t)4 * 512 * 64 * 2;
constexpr size_t WS_W1T = WS_VCCT + (size_t)4 * 512 * 64 * 2;
constexpr size_t WS_B1 = WS_W1T + (size_t)2 * 64 * 2048 * 2;
constexpr size_t WS_R = WS_B1 + 1024;
constexpr size_t WS_P = WS_R;
constexpr size_t WS_VST = WS_P + (size_t)T_ * LD * 2;
constexpr size_t WS_VWT = WS_VST + (size_t)4 * 64 * S_ * 2;
constexpr size_t WS_VRT = WS_VWT + (size_t)4 * 64 * S_ * 2;
constexpr size_t WS_KVT = WS_VRT + (size_t)16 * 128 * S_ * 2;
constexpr size_t WS_SPT = WS_KVT + (size_t)16 * 64 * 8192 * 4;
constexpr size_t WS_YA32 = WS_SPT + (size_t)16 * 64 * 8192 * 2;
constexpr size_t WS_YA = WS_YA32 + (size_t)T_ * 512 * 4;
constexpr size_t WS_YB = WS_YA + (size_t)T_ * 512 * 2;
constexpr size_t WS_ENDA = WS_YB + (size_t)T_ * 1024 * 2;
constexpr size_t WS_H1 = WS_R;
constexpr size_t WS_X1 = WS_H1 + (size_t)T_ * 1024 * 4;
constexpr size_t WS_X1B = WS_X1 + (size_t)T_ * 1024 * 4;
constexpr size_t WS_HB = WS_X1B + (size_t)T_ * 1024 * 2;
constexpr size_t WS_CT = WS_P + (size_t)T_ * LD * 2;
constexpr size_t WS_LIST = WS_CT + (size_t)2 * T_ * 1024 * 2;
constexpr size_t WS_WTS = WS_LIST + (size_t)16 * T_ * 4;
constexpr size_t WS_ENDB = WS_WTS + (size_t)2 * T_ * 4;
static_assert(WS_HB + (size_t)2 * T_ * 512 * 2 <= WS_CT, "view B overlap");
constexpr size_t WS_END = WS_ENDA > WS_ENDB ? WS_ENDA : WS_ENDB;

constexpr int CW_CNT = 4096;
constexpr int CW_BAR = 8192;

constexpr int LDS_BYTES = 75776;
constexpr int NTHREADS = 256;

struct Params {
    const float* x; const float* w_in; const float* cmp_pos; const float* cmp_w1; const float* cmp_w2;
    const float* w_br_a; const float* w_br_b; const float* w_o; const float* ln1_g; const float* ln1_b;
    const float* w_router; const float* router_bias; const float* w_gate; const float* w_up; const float* w_down;
    const float* ln2_g; const float* ln2_b; const float* rel_bias;
    float* out; unsigned char* ws;
    int ph_lo, ph_hi;
};

__device__ __forceinline__ bf16_t f2bf(float f) { unsigned u = __float_as_uint(f); u += 0x7fffu + ((u >> 16) & 1u); return (bf16_t)(u >> 16); }
__device__ __forceinline__ float bf2f(unsigned h) { return __uint_as_float(h << 16); }
__device__ __forceinline__ unsigned pack2(float lo, float hi) { return (unsigned)f2bf(lo) | ((unsigned)f2bf(hi) << 16); }
__device__ __forceinline__ u32x2 pack4(f32x4 v) { u32x2 r; r.x = pack2(v[0], v[1]); r.y = pack2(v[2], v[3]); return r; }
__device__ __forceinline__ f32x4 unpack4(u32x2 u) { f32x4 r; r[0] = bf2f(u.x & 0xffffu); r[1] = bf2f(u.x >> 16); r[2] = bf2f(u.y & 0xffffu); r[3] = bf2f(u.y >> 16); return r; }
__device__ __forceinline__ float sigmoidf_(float x) { return 1.f / (1.f + __expf(-x)); }
__device__ __forceinline__ int vzero() { int z; asm volatile("v_mov_b32 %0, 0" : "=v"(z)); return z; }
__device__ __forceinline__ unsigned char* launder(unsigned char* q) { asm volatile("" : "+s"(q)); return q; }
__device__ __forceinline__ void wait_vm0() { asm volatile("s_waitcnt vmcnt(0)" ::: "memory"); }

__device__ __forceinline__ void glds16(const void* g, void* l) {
    __builtin_amdgcn_global_load_lds((const __attribute__((address_space(1))) unsigned*)g,
                                     (__attribute__((address_space(3))) unsigned*)l, 16, 0, 0);
}
__device__ __forceinline__ f32x4 mfma16(bf16x8 a, bf16x8 b, f32x4 c) { return __builtin_amdgcn_mfma_f32_16x16x32_bf16(a, b, c, 0, 0, 0); }

__device__ __forceinline__ void gemm_stage(const bf16_t* const (&mp)[4], const bf16_t* const (&np)[4], int kt, unsigned char* st, int wid) {
#pragma unroll
    for (int i = 0; i < 4; ++i) {
        glds16(mp[i] + kt * 64, st + (4 * i + wid) * 1024);
        glds16(np[i] + kt * 64, st + 16384 + (4 * i + wid) * 1024);
    }
}
__device__ __forceinline__ void gemm_compute(const unsigned char* st, f32x4 (&acc)[4][4], int wr, int wc, int fr, int fq) {
#pragma unroll
    for (int ks = 0; ks < 2; ++ks) {
        bf16x8 a[4], b[4];
        const int sw = ((4 * ks + fq) ^ (fr & 7)) << 4;
#pragma unroll
        for (int i = 0; i < 4; ++i) {
            a[i] = *(const bf16x8*)(st + (64 * wr + 16 * i + fr) * 128 + sw);
            b[i] = *(const bf16x8*)(st + 16384 + (64 * wc + 16 * i + fr) * 128 + sw);
        }
#pragma unroll
        for (int i = 0; i < 4; ++i)
#pragma unroll
            for (int j = 0; j < 4; ++j) acc[i][j] = mfma16(a[i], b[j], acc[i][j]);
    }
}
__device__ __forceinline__ void gemm_kloop(const bf16_t* const (&mp)[4], const bf16_t* const (&np)[4], int nk, unsigned char* lds, f32x4 (&acc)[4][4]) {
    const int tid = threadIdx.x + vzero(), lane = tid & 63, wid = tid >> 6, wr = wid >> 1, wc = wid & 1, fr = lane & 15, fq = lane >> 4;
    gemm_stage(mp, np, 0, lds, wid);
    wait_vm0(); __syncthreads();
    for (int kt = 0; kt < nk; ++kt) {
        unsigned char* cur = lds + (kt & 1) * 32768;
        if (kt + 1 < nk) gemm_stage(mp, np, kt + 1, lds + ((kt + 1) & 1) * 32768, wid);
        gemm_compute(cur, acc, wr, wc, fr, fq);
        wait_vm0(); __syncthreads();
    }
}
__device__ __forceinline__ void zero_acc(f32x4 (&acc)[4][4]) {
#pragma unroll
    for (int i = 0; i < 4; ++i)
#pragma unroll
        for (int j = 0; j < 4; ++j) acc[i][j] = (f32x4){0.f, 0.f, 0.f, 0.f};
}

__device__ void tcvt_tile(const float* src, int ld_src, int k0, int n0, int mode, bf16_t* dst, int kdst, unsigned char* lds) {
    float* tile = (float*)lds;
    const int tid = threadIdx.x + vzero();
#pragma unroll
    for (int i = 0; i < 4; ++i) {
        const int kk = (tid >> 4) + 16 * i, c4 = (tid & 15) * 4, cd = n0 + c4;
        int orig = cd; bool ok = true;
        if (mode == 1) { if (cd < 1280) orig = cd; else if (cd < 6400) orig = cd + 24; else if (cd < 6424) orig = cd - 6400 + 1280; else ok = false; }
        float4 v = make_float4(0.f, 0.f, 0.f, 0.f);
        if (ok) v = *(const float4*)(src + (size_t)(k0 + kk) * ld_src + orig);
        tile[kk * 65 + c4 + 0] = v.x; tile[kk * 65 + c4 + 1] = v.y; tile[kk * 65 + c4 + 2] = v.z; tile[kk * 65 + c4 + 3] = v.w;
    }
    __syncthreads();
#pragma unroll
    for (int i = 0; i < 2; ++i) {
        const int q = tid + 256 * i, n = q >> 3, kc = q & 7;
        float v[8];
#pragma unroll
        for (int j = 0; j < 8; ++j) v[j] = tile[(kc * 8 + j) * 65 + n];
        u32x4 w; w.x = pack2(v[0], v[1]); w.y = pack2(v[2], v[3]); w.z = pack2(v[4], v[5]); w.w = pack2(v[6], v[7]);
        *(u32x4*)(dst + (size_t)(n0 + n) * kdst + k0 + kc * 8) = w;
    }
    __syncthreads();
}

__device__ void phase_pw(const Params& p, int layer, unsigned char* lds) {
    const int bid = blockIdx.x, nblk = gridDim.x, tid = threadIdx.x + vzero();
    unsigned char* ws = launder(p.ws);
    constexpr int J0 = 16 * 102, J1 = 8 * 16, J2 = 256, J3 = 256, J4 = 2048, J5 = 2048, J6 = 2048, JT = J0 + J1 + J2 + J3 + J4 + J5 + J6;
    for (int t = bid; t < JT; t += nblk) {
        int u = t;
        if (u < J0) { tcvt_tile(p.w_in + (size_t)layer * 1024 * DIN, DIN, (u % 16) * 64, (u / 16) * 64, 1, (bf16_t*)(ws + WS_WIN), 1024, lds); continue; }
        u -= J0;
        if (u < J1) { tcvt_tile(p.w_br_a + (size_t)layer * 512 * 1024, 1024, (u % 8) * 64, (u / 8) * 64, 0, (bf16_t*)(ws + WS_WA), 512, lds); continue; }
        u -= J1;
        if (u < J2) { tcvt_tile(p.w_br_b + (size_t)layer * 1024 * 1024, 1024, (u % 16) * 64, (u / 16) * 64, 0, (bf16_t*)(ws + WS_WB), 1024, lds); continue; }
        u -= J2;
        if (u < J3) { tcvt_tile(p.w_o + (size_t)layer * 1024 * 1024, 1024, (u % 16) * 64, (u / 16) * 64, 0, (bf16_t*)(ws + WS_WO), 1024, lds); continue; }
        u -= J3;
        if (u < J4 + J5) {
            const bool up = u >= J4; if (up) u -= J4;
            const int e = u / 128, v = u % 128;
            const float* src = (up ? p.w_up : p.w_gate) + ((size_t)layer * NE + e) * 1024 * 512;
            tcvt_tile(src, 512, (v % 16) * 64, (v / 16) * 64, 0, (bf16_t*)(ws + (up ? WS_WU : WS_WG)) + (size_t)e * 512 * 1024, 1024, lds); continue;
        }
        u -= J4 + J5;
        { const int e = u / 128, v = u % 128;
          const float* src = p.w_down + ((size_t)layer * NE + e) * 512 * 1024;
          tcvt_tile(src, 1024, (v % 8) * 64, (v / 8) * 64, 0, (bf16_t*)(ws + WS_WD) + (size_t)e * 1024 * 512, 512, lds); }
    }
    for (int t = bid; t < 64; t += nblk) {
        const int kv = t >> 5, kt = t & 31;
        tcvt_tile(p.cmp_w1 + ((size_t)layer * 2 + kv) * 2048 * 64, 64, kt * 64, 0, 0, (bf16_t*)(ws + WS_W1T) + (size_t)kv * 64 * 2048, 2048, lds);
    }
    if (bid >= nblk - 2) {
        const int kv = nblk - 1 - bid, n = tid & 63, part = tid >> 6;
        const float* w1 = p.cmp_w1 + ((size_t)layer * 2 + kv) * 2048 * 64; const float* pos = p.cmp_pos + ((size_t)layer * 2 + kv) * 2048;
        float a = 0.f;
        for (int k = part * 512; k < part * 512 + 512; ++k) a += pos[k] * w1[(size_t)k * 64 + n];
        float* red = (float*)lds;
        __syncthreads(); red[tid] = a; __syncthreads();
        if (tid < 64) ((float*)(ws + WS_B1))[kv * 64 + tid] = red[tid] + red[tid + 64] + red[tid + 128] + red[tid + 192];
        __syncthreads();
    }
    if (layer == 0) {
        const float4* xs = (const float4*)p.x; u32x2* xb = (u32x2*)(ws + WS_XB);
        for (size_t i = (size_t)bid * NTHREADS + tid; i < (size_t)T_ * 1024 / 4; i += (size_t)nblk * NTHREADS) {
            float4 v = xs[i]; u32x2 w; w.x = pack2(v.x, v.y); w.y = pack2(v.z, v.w); xb[i] = w;
        }
        for (int n = bid * NTHREADS + tid; n < 8192; n += nblk * NTHREADS) {
            int bk;
            if (n < 16) bk = n;
            else { const int th[15] = {22, 30, 40, 54, 73, 99, 134, 182, 246, 332, 450, 609, 825, 1117, 1513}; bk = 16;
#pragma unroll
                for (int k = 0; k < 15; ++k) bk += (n >= th[k]) ? 1 : 0; }
            (ws + WS_BUCKET)[n] = (unsigned char)bk;
        }
        for (int i = bid * NTHREADS + tid; i < 8192 * 32; i += nblk * NTHREADS) {
            const int pos = i >> 5, d = i & 31;
            const float inv = powf(10000.f, -(float)d * 2.0f / 64.f);
            const float ang = (float)pos * inv;
            float sn, cs; sincosf(ang, &sn, &cs);
            ((float2*)(ws + WS_ROPE))[i] = make_float2(cs, sn);
        }
        if (bid == 0 && tid < 64) ((unsigned*)(ws + WS_CTL))[CW_CNT + tid] = 0u;
    }
}

__device__ void phase_g1(const Params& p, int layer, unsigned char* lds) {
    unsigned char* ws = launder(p.ws);
    const bf16_t* XB = (const bf16_t*)(ws + WS_XB);
    const bf16_t* WT = (const bf16_t*)(ws + WS_WIN);
    bf16_t* P = (bf16_t*)(ws + WS_P);
    const int tid = threadIdx.x + vzero(), lane = tid & 63, wid = tid >> 6, wr = wid >> 1, wc = wid & 1, fr = lane & 15, fq = lane >> 4;
    const int ldrow = 8 * wid + (lane >> 3), ldc = ((lane & 7) ^ (lane >> 3)) * 8;
    const float2* rope = (const float2*)(ws + WS_ROPE);
    for (int t = blockIdx.x; t < 128 * 51; t += gridDim.x) {
        const int mt = t / 51, nt = t % 51, m0 = mt * 128, n0 = nt * 128;
        const bool transposed = (nt == 7) || (nt == 9) || (nt >= 18 && nt <= 25);
        const bf16_t* mp[4]; const bf16_t* np[4];
#pragma unroll
        for (int i = 0; i < 4; ++i) {
            const bf16_t* wrow = WT + (size_t)(n0 + 32 * i + ldrow) * 1024 + ldc;
            const bf16_t* xrow = XB + (size_t)(m0 + 32 * i + ldrow) * 1024 + ldc;
            mp[i] = transposed ? xrow : wrow; np[i] = transposed ? wrow : xrow;
        }
        f32x4 acc[4][4]; zero_acc(acc);
        gemm_kloop(mp, np, 16, lds, acc);
        if (!transposed) {
            const int kind = (nt >= 10 && nt <= 13) ? 1 : (nt >= 14 && nt <= 17) ? 2 : (nt >= 26 && nt <= 33) ? 3 : (nt >= 34) ? 4 : 0;
            if (kind == 1 || kind == 2) {
                const float sc = (kind == 2) ? 0.125f : 1.0f;
#pragma unroll
                for (int ni = 0; ni < 4; ++ni) {
                    const int tok = m0 + 64 * wc + 16 * ni + fr, pos = tok & (S_ - 1);
#pragma unroll
                    for (int mi = 0; mi < 2; ++mi) {
                        const int d = 16 * mi + 4 * fq;
                        const float4 cs01 = *(const float4*)(rope + pos * 32 + d), cs23 = *(const float4*)(rope + pos * 32 + d + 2);
                        const float c[4] = {cs01.x, cs01.z, cs23.x, cs23.z}, s[4] = {cs01.y, cs01.w, cs23.y, cs23.w};
                        f32x4 x1 = acc[mi][ni], x2 = acc[mi + 2][ni], y1, y2;
#pragma unroll
                        for (int r = 0; r < 4; ++r) { y1[r] = (x1[r] * c[r] - x2[r] * s[r]) * sc; y2[r] = (x1[r] * s[r] + x2[r] * c[r]) * sc; }
                        acc[mi][ni] = y1; acc[mi + 2][ni] = y2;
                    }
                }
            }
#pragma unroll
            for (int mi = 0; mi < 4; ++mi)
#pragma unroll
                for (int ni = 0; ni < 4; ++ni) {
                    const int n = n0 + 64 * wr + 16 * mi + 4 * fq, tok = m0 + 64 * wc + 16 * ni + fr;
                    f32x4 v = acc[mi][ni];
                    if (kind == 3) {
#pragma unroll
                        for (int r = 0; r < 4; ++r) v[r] = v[r] * sigmoidf_(v[r]);
                    } else if (kind == 4) {
#pragma unroll
                        for (int r = 0; r < 4; ++r) v[r] = sigmoidf_(v[r]);
                    }
                    *(u32x2*)(P + (size_t)tok * LD + n) = pack4(v);
                }
        } else {
#pragma unroll
            for (int mi = 0; mi < 4; ++mi)
#pragma unroll
                for (int ni = 0; ni < 4; ++ni) {
                    const int tok = m0 + 64 * wr + 16 * mi + 4 * fq, n = n0 + 64 * wc + 16 * ni + fr;
                    const int b = tok >> 13, s = tok & (S_ - 1);
                    bf16_t* dst;
                    if (nt == 7) { const int c = n - C_VS; dst = (bf16_t*)(ws + WS_VST) + ((size_t)(b * 2 + (c >> 6)) * 64 + (c & 63)) * S_ + s; }
                    else if (nt == 9) { const int c = n - C_VW; dst = (bf16_t*)(ws + WS_VWT) + ((size_t)(b * 2 + (c >> 6)) * 64 + (c & 63)) * S_ + s; }
                    else { const int c = n - C_VR; dst = (bf16_t*)(ws + WS_VRT) + ((size_t)(b * 8 + (c >> 7)) * 128 + (c & 127)) * S_ + s; }
                    *(u32x2*)dst = pack4(acc[mi][ni]);
                }
        }
    }
}

__device__ __forceinline__ void load_tile64(const bf16_t* base, size_t rowStride, unsigned char* dst, int wid, int lane) {
    const int c = ((lane & 7) ^ (lane >> 3)) * 8;
#pragma unroll
    for (int i = 0; i < 2; ++i) { const int j = wid + 4 * i, row = 8 * j + (lane >> 3); glds16(base + (size_t)row * rowStride + c, dst + j * 1024); }
}
__device__ __forceinline__ void load_tile128(const bf16_t* base, size_t rowStride, unsigned char* dst, int wid, int lane) {
    const int c = ((lane & 7) ^ (lane >> 3)) * 8;
#pragma unroll
    for (int i = 0; i < 4; ++i) { const int j = wid + 4 * i, row = 8 * j + (lane >> 3); glds16(base + (size_t)row * rowStride + c, dst + j * 1024); }
}
__device__ __forceinline__ void load_tile128w(const bf16_t* base, size_t rowStride, unsigned char* dst, int wid, int lane) {
    const int c = ((lane & 15) ^ ((4 * wid + (lane >> 4)) & 15)) * 8;
#pragma unroll
    for (int i = 0; i < 8; ++i) { const int j = wid + 4 * i, row = 4 * j + (lane >> 4); glds16(base + (size_t)row * rowStride + c, dst + j * 1024); }
}
__device__ __forceinline__ bf16x8 lds_frag128(const unsigned char* tile, int row, int chunk) {
    return *(const bf16x8*)(tile + row * 128 + ((chunk ^ (row & 7)) << 4));
}
__device__ __forceinline__ bf16x8 lds_frag256(const unsigned char* tile, int row, int chunk) {
    return *(const bf16x8*)(tile + row * 256 + ((chunk ^ (row & 15)) << 4));
}
__device__ __forceinline__ bf16x8 lds_vfrag128(const unsigned char* tile, int row, int kbase, int fq) {
    const int ca = (kbase >> 3) + (fq >> 1), hb = (fq & 1) * 8;
    const u32x2 a = *(const u32x2*)(tile + row * 128 + ((ca ^ (row & 7)) << 4) + hb);
    const u32x2 b = *(const u32x2*)(tile + row * 128 + (((ca + 2) ^ (row & 7)) << 4) + hb);
    u32x4 w; w.x = a.x; w.y = a.y; w.z = b.x; w.w = b.y;
    return __builtin_bit_cast(bf16x8, w);
}
__device__ __forceinline__ bf16x8 lds_vfrag256(const unsigned char* tile, int row, int kbase, int fq) {
    const int ca = (kbase >> 3) + (fq >> 1), hb = (fq & 1) * 8;
    const u32x2 a = *(const u32x2*)(tile + row * 256 + ((ca ^ (row & 15)) << 4) + hb);
    const u32x2 b = *(const u32x2*)(tile + row * 256 + (((ca + 2) ^ (row & 15)) << 4) + hb);
    u32x4 w; w.x = a.x; w.y = a.y; w.z = b.x; w.w = b.y;
    return __builtin_bit_cast(bf16x8, w);
}
__device__ __forceinline__ bf16x8 pack8(f32x4 a, f32x4 b) {
    u32x4 w; w.x = pack2(a[0], a[1]); w.y = pack2(a[2], a[3]); w.z = pack2(b[0], b[1]); w.w = pack2(b[2], b[3]);
    return __builtin_bit_cast(bf16x8, w);
}

__device__ __forceinline__ float gelu_tanh(float x) {
    const float u = 0.7978845608028654f * (x + 0.044715f * x * x * x);
    return 0.5f * x * (1.f + tanhf(u));
}
__device__ void compress_item(const Params& p, int layer, int item, unsigned char* lds) {
    unsigned char* ws = launder(p.ws);
    const int tid = threadIdx.x + vzero(), lane = tid & 63, wid = tid >> 6, wr = wid >> 1, wc = wid & 1, fr = lane & 15, fq = lane >> 4;
    const int mtile = item & 3, g = (item >> 2) & 1, b = (item >> 3) & 1, kv = item >> 4;
    const int i0 = mtile * 128;
    const bf16_t* P = (const bf16_t*)(ws + WS_P);
    const bf16_t* W1T = (const bf16_t*)(ws + WS_W1T) + (size_t)kv * 64 * 2048;
    const int col = (kv ? C_VC : C_KC) + g * 64;
    const int ldc = ((lane & 7) ^ (lane >> 3)) * 8;
    const bf16_t* ap[4];
#pragma unroll
    for (int i = 0; i < 4; ++i) ap[i] = P + ((size_t)b * S_ + 16 * (i0 + 32 * i + 8 * wid + (lane >> 3))) * LD + col + ldc;
    const bf16_t* bp[2];
#pragma unroll
    for (int i = 0; i < 2; ++i) bp[i] = W1T + (size_t)(8 * (wid + 4 * i) + (lane >> 3)) * 2048 + ldc;
    f32x4 acc[4][2];
#pragma unroll
    for (int i = 0; i < 4; ++i)
#pragma unroll
        for (int j = 0; j < 2; ++j) acc[i][j] = (f32x4){0.f, 0.f, 0.f, 0.f};
    __syncthreads();
#define CSTAGE(buf, l) do { unsigned char* st_ = lds + (buf) * 24576; \
        _Pragma("unroll") for (int i = 0; i < 4; ++i) glds16(ap[i] + (size_t)(l) * LD, st_ + (4 * i + wid) * 1024); \
        _Pragma("unroll") for (int i = 0; i < 2; ++i) glds16(bp[i] + (l) * 64, st_ + 16384 + (wid + 4 * i) * 1024); } while (0)
    CSTAGE(0, 0); wait_vm0(); __syncthreads();
    for (int l = 0; l < 32; ++l) {
        const unsigned char* st = lds + (l & 1) * 24576;
        if (l + 1 < 32) CSTAGE((l + 1) & 1, l + 1);
#pragma unroll
        for (int ks = 0; ks < 2; ++ks) {
            bf16x8 a[4], bb[2];
#pragma unroll
            for (int i = 0; i < 4; ++i) a[i] = lds_frag128(st, 64 * wr + 16 * i + fr, 4 * ks + fq);
#pragma unroll
            for (int j = 0; j < 2; ++j) bb[j] = lds_frag128(st + 16384, 32 * wc + 16 * j + fr, 4 * ks + fq);
#pragma unroll
            for (int i = 0; i < 4; ++i)
#pragma unroll
                for (int j = 0; j < 2; ++j) acc[i][j] = mfma16(a[i], bb[j], acc[i][j]);
        }
        wait_vm0(); __syncthreads();
    }
#undef CSTAGE
    float* hid = (float*)lds;
    const float* b1 = (const float*)(ws + WS_B1) + kv * 64;
#pragma unroll
    for (int j = 0; j < 2; ++j) {
        const int n = 32 * wc + 16 * j + fr; const float bias = b1[n + vzero()];
#pragma unroll
        for (int i = 0; i < 4; ++i)
#pragma unroll
            for (int r = 0; r < 4; ++r) hid[(64 * wr + 16 * i + 4 * fq + r) * 65 + n] = gelu_tanh(acc[i][j][r] + bias);
    }
    __syncthreads();
    {
        const int row = tid >> 1, nb = (tid & 1) * 32, ci = i0 + row;
        const float* w2 = p.cmp_w2 + ((size_t)layer * 2 + kv) * 64 * 64;
        float o[32];
#pragma unroll
        for (int q = 0; q < 32; ++q) o[q] = 0.f;
        for (int n = 0; n < 64; ++n) {
            const float h = hid[row * 65 + n];
#pragma unroll
            for (int q4 = 0; q4 < 8; ++q4) { const float4 w = *(const float4*)(w2 + n * 64 + nb + 4 * q4); o[4 * q4] += h * w.x; o[4 * q4 + 1] += h * w.y; o[4 * q4 + 2] += h * w.z; o[4 * q4 + 3] += h * w.w; }
        }
        if (kv == 0) {
            bf16_t* dst = (bf16_t*)(ws + WS_KCC) + ((size_t)(b * 2 + g) * 512 + ci) * 64 + nb;
#pragma unroll
            for (int q = 0; q < 32; q += 4) { f32x4 v = {o[q], o[q + 1], o[q + 2], o[q + 3]}; if (ci >= 511) v = (f32x4){0.f, 0.f, 0.f, 0.f}; *(u32x2*)(dst + q) = pack4(v); }
        } else {
            bf16_t* dst = (bf16_t*)(ws + WS_VCCT) + ((size_t)(b * 2 + g) * 64 + nb) * 512 + ci;
#pragma unroll
            for (int q = 0; q < 32; ++q) dst[(size_t)q * 512] = f2bf(ci >= 511 ? 0.f : o[q]);
        }
    }
    __syncthreads();
}

__device__ __forceinline__ float ret_lg2(int h) { const float gam = 1.f - exp2f(-5.f - (float)h); return log2f(gam); }

__device__ void retkv_item(const Params& p, int item, unsigned char* lds) {
    unsigned char* ws = launder(p.ws);
    const int tid = threadIdx.x + vzero(), lane = tid & 63, wid = tid >> 6, fr = lane & 15, fq = lane >> 4;
    const int n = item & 63, h = (item >> 6) & 7, b = item >> 9;
    const size_t tok0 = (size_t)b * S_ + 128 * n;
    unsigned char* vL = lds; unsigned char* kL = lds + 32768;
    load_tile128w((const bf16_t*)(ws + WS_VRT) + ((size_t)(b * 8 + h) * 128) * S_ + 128 * n, S_, vL, wid, lane);
    load_tile128((const bf16_t*)(ws + WS_P) + tok0 * LD + C_KR + h * 64, LD, kL, wid, lane);
    wait_vm0(); __syncthreads();
    const float lg2 = ret_lg2(h);
    f32x4 acc[2][4];
#pragma unroll
    for (int m = 0; m < 2; ++m)
#pragma unroll
        for (int nt = 0; nt < 4; ++nt) acc[m][nt] = (f32x4){0.f, 0.f, 0.f, 0.f};
#pragma unroll
    for (int ks = 0; ks < 4; ++ks) {
        bf16x8 a[2], bb[4];
#pragma unroll
        for (int m = 0; m < 2; ++m) a[m] = lds_frag256(vL, 32 * wid + 16 * m + fr, 4 * ks + fq);
        float dec[8];
#pragma unroll
        for (int j = 0; j < 8; ++j) dec[j] = exp2f((float)(127 - (32 * ks + 8 * fq + j)) * lg2);
#pragma unroll
        for (int nt = 0; nt < 4; ++nt) {
            const int d = 16 * nt + fr;
            float v[8];
#pragma unroll
            for (int j = 0; j < 8; ++j) {
                const int tk = 32 * ks + 8 * fq + j;
                const bf16_t kvv = *(const bf16_t*)(kL + tk * 128 + (((d >> 3) ^ (tk & 7)) << 4) + (d & 7) * 2);
                v[j] = bf2f(kvv) * dec[j];
            }
            u32x4 w; w.x = pack2(v[0], v[1]); w.y = pack2(v[2], v[3]); w.z = pack2(v[4], v[5]); w.w = pack2(v[6], v[7]);
            bb[nt] = __builtin_bit_cast(bf16x8, w);
        }
#pragma unroll
        for (int m = 0; m < 2; ++m)
#pragma unroll
            for (int nt = 0; nt < 4; ++nt) acc[m][nt] = mfma16(a[m], bb[nt], acc[m][nt]);
    }
    float* KVT = (float*)(ws + WS_KVT) + ((size_t)(b * 8 + h) * 64 + n) * 8192;
#pragma unroll
    for (int m = 0; m < 2; ++m)
#pragma unroll
        for (int nt = 0; nt < 4; ++nt)
#pragma unroll
            for (int r = 0; r < 4; ++r) KVT[(32 * wid + 16 * m + 4 * fq + r) * 64 + 16 * nt + fr] = acc[m][nt][r];
    __syncthreads();
}

__device__ void phase_p2(const Params& p, int layer, unsigned char* lds) {
    for (int it = blockIdx.x; it < 1024 + 32; it += gridDim.x) {
        if (it < 32) compress_item(p, layer, it, lds); else retkv_item(p, it - 32, lds);
    }
}

constexpr int NSA_IMP = 32768, NSA_BUCKET = 65792, NSA_BIAS = 73984;

struct NsaLane { int t; int fr, fq, wid, lane; };

template <int BR, int PASS>
__device__ __forceinline__ void nsa_half(const unsigned char* kL, const unsigned char* vL, const unsigned char* lds, const bf16_t* qptr,
                                         f32x4 (&O)[4][4], float (&m)[4], float (&l)[4], int tile, int hf, bool selbit, const NsaLane& L, int qrow) {
    const int fr = L.fr, fq = L.fq;
    bf16x8 Kf[2][2];
#pragma unroll
    for (int i = 0; i < 2; ++i)
#pragma unroll
        for (int ks = 0; ks < 2; ++ks) Kf[i][ks] = lds_frag128(kL, 32 * hf + 16 * i + fr, 4 * ks + fq);
    unsigned vmask = 0; unsigned bk[2];
    const unsigned char* bucketL = lds + NSA_BUCKET;
#pragma unroll
    for (int i = 0; i < 2; ++i) {
        unsigned pk = 0;
#pragma unroll
        for (int r = 0; r < 4; ++r) {
            const int kk = 32 * hf + 16 * i + 4 * fq + r;
            int rel; bool ok;
            if (BR == 0) { rel = L.t - (16 * (64 * tile + kk) + 31); ok = rel >= 0; }
            else if (BR == 1) { rel = L.t - (64 * tile + kk); ok = selbit && rel >= 0; }
            else { rel = L.t - (64 * tile + kk); ok = rel >= 0 && rel < 512; }
            int rc = rel < 0 ? 0 : rel; rc = rc > 8191 ? 8191 : rc;
            pk |= (unsigned)bucketL[rc] << (8 * r);
            vmask |= (ok ? 1u : 0u) << (4 * i + r);
        }
        bk[i] = pk;
    }
    const float* biasL = (const float*)(lds + NSA_BIAS);
    float ia[2] = {0.f, 0.f}, ic[2] = {0.f, 0.f};
#pragma unroll
    for (int nt = 0; nt < 4; ++nt) {
        asm volatile("" ::: "memory");
        f32x4 S[2];
        const bf16x8 q0 = *(const bf16x8*)(qptr + nt * 64), q1 = *(const bf16x8*)(qptr + nt * 64 + 32);
#pragma unroll
        for (int i = 0; i < 2; ++i) {
            S[i] = (f32x4){0.f, 0.f, 0.f, 0.f};
            S[i] = mfma16(Kf[i][0], q0, S[i]); S[i] = mfma16(Kf[i][1], q1, S[i]);
        }
        float tmax = -1e30f;
#pragma unroll
        for (int i = 0; i < 2; ++i)
#pragma unroll
            for (int r = 0; r < 4; ++r) {
                const float bias = biasL[nt * 32 + ((bk[i] >> (8 * r)) & 0xffu)];
                const bool ok = (vmask >> (4 * i + r)) & 1u;
                const float sv = ok ? S[i][r] * 0.125f + bias : -1e30f;
                S[i][r] = sv; tmax = fmaxf(tmax, sv);
            }
        if (PASS != 1) {
            tmax = fmaxf(tmax, __shfl_xor(tmax, 16)); tmax = fmaxf(tmax, __shfl_xor(tmax, 32));
            const float mnew = fmaxf(m[nt], tmax), alpha = __expf(m[nt] - mnew);
            float psum = 0.f;
#pragma unroll
            for (int i = 0; i < 2; ++i)
#pragma unroll
                for (int r = 0; r < 4; ++r) {
                    const bool ok = (vmask >> (4 * i + r)) & 1u;
                    const float pv = ok ? __expf(S[i][r] - mnew) : 0.f;
                    S[i][r] = pv; psum += pv;
                }
            psum += __shfl_xor(psum, 16); psum += __shfl_xor(psum, 32);
            l[nt] = l[nt] * alpha + psum; m[nt] = mnew;
            if (PASS == 2) {
#pragma unroll
                for (int mt = 0; mt < 4; ++mt) O[mt][nt] = O[mt][nt] * alpha;
            }
        } else {
#pragma unroll
            for (int i = 0; i < 2; ++i) {
#pragma unroll
                for (int r = 0; r < 4; ++r) {
                    const bool ok = (vmask >> (4 * i + r)) & 1u;
                    S[i][r] = ok ? __expf(S[i][r] - m[nt]) * l[nt] : 0.f;
                }
                ia[i] += S[i][0] + S[i][1] + S[i][2] + 0.5f * S[i][3];
                ic[i] += 0.5f * S[i][3];
            }
        }
        if (PASS != 0) {
            const bf16x8 Pb = pack8(S[0], S[1]);
#pragma unroll
            for (int mt = 0; mt < 4; ++mt) O[mt][nt] = mfma16(lds_vfrag128(vL, 16 * mt + fr, 32 * hf, fq), Pb, O[mt][nt]);
        }
    }
    if (PASS == 1) {
        float* imp = (float*)(lds + NSA_IMP) + qrow * 129;
        asm volatile("" ::: "memory"); __builtin_amdgcn_wave_barrier();
#pragma unroll
        for (int i = 0; i < 2; ++i) { const int j = 16 * tile + 8 * hf + 4 * i + fq; imp[j] += ia[i]; }
        asm volatile("s_waitcnt lgkmcnt(0)" ::: "memory"); __builtin_amdgcn_wave_barrier();
#pragma unroll
        for (int i = 0; i < 2; ++i) { const int j = 16 * tile + 8 * hf + 4 * i + fq + 1; if (j < 128) imp[j] += ic[i]; }
        asm volatile("s_waitcnt lgkmcnt(0)" ::: "memory"); __builtin_amdgcn_wave_barrier();
    }
}
template <int BR, int PASS>
__device__ __forceinline__ void nsa_tile(const unsigned char* kL, const unsigned char* vL, const unsigned char* lds, const bf16_t* qptr,
                                         f32x4 (&O)[4][4], float (&m)[4], float (&l)[4], int tile, bool selbit, const NsaLane& L, int qrow) {
#pragma unroll 1
    for (int hf = 0; hf < 2; ++hf) nsa_half<BR, PASS>(kL, vL, lds, qptr, O, m, l, tile, hf, selbit, L, qrow);
}

__device__ void nsa_item(const Params& p, int item, unsigned char* lds) {
    unsigned char* ws = launder(p.ws);
    const int tid = threadIdx.x + vzero(), lane = tid & 63, wid = tid >> 6, fr = lane & 15, fq = lane >> 4;
    const int combo = item & 3, qt = 127 - (item >> 2), b = combo >> 1, g = combo & 1;
    const int q0 = qt * 64, qrow = 16 * wid + fr;
    NsaLane L; L.t = q0 + qrow; L.fr = fr; L.fq = fq; L.wid = wid; L.lane = lane;
    const size_t tok = (size_t)b * S_ + L.t;
    const bf16_t* P = (const bf16_t*)(ws + WS_P);
    __syncthreads();
    if (tid < 128) ((float*)(lds + NSA_BIAS))[tid] = p.rel_bias[(tid & 31) * 8 + 4 * g + (tid >> 5)];
    for (int i = tid; i < 64 * 129; i += NTHREADS) ((float*)(lds + NSA_IMP))[i] = 0.f;
    const bf16_t* Qf = P + tok * LD + C_QA + (4 * g) * 64 + 8 * fq;
    __syncthreads();
    f32x4 O[4][4]; float m[4], l[4];
    float* YA32 = (float*)(ws + WS_YA32) + tok * 512 + (4 * g) * 64;
    const bf16_t* gates = P + tok * LD + C_GA + (4 * g) * 3;

    const bf16_t* kc = (const bf16_t*)(ws + WS_KCC) + (size_t)(b * 2 + g) * 512 * 64;
    const bf16_t* vc = (const bf16_t*)(ws + WS_VCCT) + (size_t)(b * 2 + g) * 64 * 512;
    const int ntc = ((q0 + 32) >> 4) / 64 + 1;
#pragma unroll
    for (int nt = 0; nt < 4; ++nt) { m[nt] = -1e30f; l[nt] = 0.f; }
    load_tile64(kc, 64, lds, wid, lane);
    wait_vm0(); __syncthreads();
    for (int it = 0; it < ntc; ++it) {
        unsigned char* cur = lds + (it & 1) * 16384;
        if (it + 1 < ntc) load_tile64(kc + (size_t)(it + 1) * 64 * 64, 64, lds + ((it + 1) & 1) * 16384, wid, lane);
        nsa_tile<0, 0>(cur, cur + 8192, lds, Qf, O, m, l, it, true, L, qrow);
        wait_vm0(); __syncthreads();
    }
#pragma unroll
    for (int nt = 0; nt < 4; ++nt) l[nt] = l[nt] > 0.f ? 1.f / l[nt] : 0.f;
#pragma unroll
    for (int mt = 0; mt < 4; ++mt)
#pragma unroll
        for (int nt = 0; nt < 4; ++nt) O[mt][nt] = (f32x4){0.f, 0.f, 0.f, 0.f};
    load_tile64(kc, 64, lds, wid, lane); load_tile64(vc, 512, lds + 8192, wid, lane);
    wait_vm0(); __syncthreads();
    for (int it = 0; it < ntc; ++it) {
        unsigned char* cur = lds + (it & 1) * 16384;
        if (it + 1 < ntc) { unsigned char* nx = lds + ((it + 1) & 1) * 16384;
            load_tile64(kc + (size_t)(it + 1) * 64 * 64, 64, nx, wid, lane); load_tile64(vc + (it + 1) * 64, 512, nx + 8192, wid, lane); }
        nsa_tile<0, 1>(cur, cur + 8192, lds, Qf, O, m, l, it, true, L, qrow);
        wait_vm0(); __syncthreads();
    }
#pragma unroll
    for (int nt = 0; nt < 4; ++nt) {
        const float gt = bf2f(gates[nt * 3 + 0]);
#pragma unroll
        for (int mt = 0; mt < 4; ++mt) *(f32x4*)(YA32 + nt * 64 + 16 * mt + 4 * fq) = O[mt][nt] * gt;
    }
    const int cur = qt;
    unsigned selw[4];
    {
        float* imp = (float*)(lds + NSA_IMP) + qrow * 129 + 32 * fq;
        asm volatile("s_waitcnt lgkmcnt(0)" ::: "memory"); __builtin_amdgcn_wave_barrier();
#pragma unroll
        for (int i = 0; i < 32; ++i) {
            const int j = 32 * fq + i;
            const float v = imp[i];
            imp[i] = j > cur ? -1.f : v + ((j == 0 || j == cur || j == cur - 1) ? 1.0e4f : 0.f);
        }
        unsigned word = 0;
#pragma unroll 1
        for (int round = 0; round < 16; ++round) {
            float bv = imp[0]; int bi = 0;
#pragma unroll
            for (int i = 1; i < 32; ++i) { const float v = imp[i]; if (v > bv) { bv = v; bi = i; } }
            int gi = 32 * fq + bi;
#pragma unroll
            for (int off = 16; off <= 32; off <<= 1) {
                const float ov = __shfl_xor(bv, off); const int oi = __shfl_xor(gi, off);
                if (ov > bv || (ov == bv && oi < gi)) { bv = ov; gi = oi; }
            }
            if (bv >= 0.f && (gi >> 5) == fq) { word |= 1u << (gi & 31); imp[gi & 31] = -2.f; }
        }
#pragma unroll
        for (int pp = 0; pp < 4; ++pp) selw[pp] = (unsigned)__shfl((int)word, fr + 16 * pp);
    }
#pragma unroll
    for (int nt = 0; nt < 4; ++nt) { m[nt] = -1e30f; l[nt] = 0.f; }
#pragma unroll
    for (int mt = 0; mt < 4; ++mt)
#pragma unroll
        for (int nt = 0; nt < 4; ++nt) O[mt][nt] = (f32x4){0.f, 0.f, 0.f, 0.f};
    {
        const bf16_t* kb = P + ((size_t)b * S_) * LD + C_KS + g * 64;
        const bf16_t* vb = (const bf16_t*)(ws + WS_VST) + (size_t)(b * 2 + g) * 64 * S_;
        const int nts = cur + 1;
        load_tile64(kb, LD, lds, wid, lane); load_tile64(vb, S_, lds + 8192, wid, lane);
        wait_vm0(); __syncthreads();
        for (int it = 0; it < nts; ++it) {
            unsigned char* cu = lds + (it & 1) * 16384;
            if (it + 1 < nts) { unsigned char* nx = lds + ((it + 1) & 1) * 16384;
                load_tile64(kb + (size_t)(it + 1) * 64 * LD, LD, nx, wid, lane); load_tile64(vb + (it + 1) * 64, S_, nx + 8192, wid, lane); }
            const unsigned w = it < 32 ? selw[0] : it < 64 ? selw[1] : it < 96 ? selw[2] : selw[3];
            const bool sb = (w >> (it & 31)) & 1u;
            if (__ballot(sb) != 0ull) nsa_tile<1, 2>(cu, cu + 8192, lds, Qf, O, m, l, it, sb, L, qrow);
            wait_vm0(); __syncthreads();
        }
    }
#pragma unroll
    for (int nt = 0; nt < 4; ++nt) {
        const float gt = bf2f(gates[nt * 3 + 1]) * (l[nt] > 0.f ? 1.f / l[nt] : 0.f);
#pragma unroll
        for (int mt = 0; mt < 4; ++mt) { f32x4* q = (f32x4*)(YA32 + nt * 64 + 16 * mt + 4 * fq); *q = *q + O[mt][nt] * gt; }
    }
#pragma unroll
    for (int nt = 0; nt < 4; ++nt) { m[nt] = -1e30f; l[nt] = 0.f; }
#pragma unroll
    for (int mt = 0; mt < 4; ++mt)
#pragma unroll
        for (int nt = 0; nt < 4; ++nt) O[mt][nt] = (f32x4){0.f, 0.f, 0.f, 0.f};
    {
        const bf16_t* kb = P + ((size_t)b * S_) * LD + C_KW + g * 64;
        const bf16_t* vb = (const bf16_t*)(ws + WS_VWT) + (size_t)(b * 2 + g) * 64 * S_;
        const int k_lo = qt - 8 > 0 ? qt - 8 : 0, ntw = qt - k_lo + 1;
        load_tile64(kb + (size_t)k_lo * 64 * LD, LD, lds, wid, lane); load_tile64(vb + k_lo * 64, S_, lds + 8192, wid, lane);
        wait_vm0(); __syncthreads();
        for (int it = 0; it < ntw; ++it) {
            unsigned char* cu = lds + (it & 1) * 16384;
            if (it + 1 < ntw) { unsigned char* nx = lds + ((it + 1) & 1) * 16384;
                load_tile64(kb + (size_t)(k_lo + it + 1) * 64 * LD, LD, nx, wid, lane); load_tile64(vb + (k_lo + it + 1) * 64, S_, nx + 8192, wid, lane); }
            nsa_tile<2, 2>(cu, cu + 8192, lds, Qf, O, m, l, k_lo + it, true, L, qrow);
            wait_vm0(); __syncthreads();
        }
    }
    bf16_t* YA = (bf16_t*)(ws + WS_YA) + tok * 512 + (4 * g) * 64;
#pragma unroll
    for (int nt = 0; nt < 4; ++nt) {
        const float gt = bf2f(gates[nt * 3 + 2]) * (l[nt] > 0.f ? 1.f / l[nt] : 0.f);
#pragma unroll
        for (int mt = 0; mt < 4; ++mt) {
            const f32x4 v = *(const f32x4*)(YA32 + nt * 64 + 16 * mt + 4 * fq) + O[mt][nt] * gt;
            *(u32x2*)(YA + nt * 64 + 16 * mt + 4 * fq) = pack4(v);
        }
    }
}

__device__ void scan_item(const Params& p, int item) {
    unsigned char* ws = launder(p.ws);
    const int idx = item * NTHREADS + threadIdx.x;
    const int bh = idx >> 13, ed = idx & 8191, h = bh & 7;
    const float dec = exp2f(128.f * ret_lg2(h));
    const float* KVT = (const float*)(ws + WS_KVT) + (size_t)bh * 64 * 8192 + ed;
    bf16_t* SPT = (bf16_t*)(ws + WS_SPT) + (size_t)bh * 64 * 8192 + ed;
    float s = 0.f;
    for (int n = 0; n < 64; ++n) { SPT[(size_t)n * 8192] = f2bf(s); s = s * dec + KVT[(size_t)n * 8192]; }
}

__device__ void phase_p3(const Params& p, unsigned char* lds) {
    for (int i = threadIdx.x; i < 8192 / 16; i += NTHREADS) ((u32x4*)(lds + NSA_BUCKET))[i] = ((const u32x4*)(p.ws + WS_BUCKET))[i];
    __syncthreads();
    for (int it = blockIdx.x; it < 512 + 512; it += gridDim.x) {
        if (it < 512) nsa_item(p, it, lds); else scan_item(p, it - 512);
    }
}

__device__ void retout_item(const Params& p, int item, unsigned char* lds) {
    unsigned char* ws = launder(p.ws);
    const int tid = threadIdx.x + vzero(), lane = tid & 63, wid = tid >> 6, fr = lane & 15, fq = lane >> 4;
    const int n = item & 63, h = (item >> 6) & 7, b = item >> 9;
    const size_t tok0 = (size_t)b * S_ + 128 * n;
    const bf16_t* P = (const bf16_t*)(ws + WS_P);
    unsigned char* vL = lds; unsigned char* kL = lds + 32768; unsigned char* sL = lds + 49152;
    __syncthreads();
    load_tile128w((const bf16_t*)(ws + WS_VRT) + ((size_t)(b * 8 + h) * 128) * S_ + 128 * n, S_, vL, wid, lane);
    load_tile128(P + tok0 * LD + C_KR + h * 64, LD, kL, wid, lane);
    load_tile128((const bf16_t*)(ws + WS_SPT) + ((size_t)(b * 8 + h) * 64 + n) * 8192, 64, sL, wid, lane);
    bf16x8 Qf[2][2];
#pragma unroll
    for (int nt = 0; nt < 2; ++nt)
#pragma unroll
        for (int ks = 0; ks < 2; ++ks) Qf[nt][ks] = *(const bf16x8*)(P + (tok0 + 32 * wid + 16 * nt + fr) * LD + C_QR + h * 64 + 32 * ks + 8 * fq);
    wait_vm0(); __syncthreads();
    const float lg2 = ret_lg2(h);
    f32x4 Y[8][2];
#pragma unroll
    for (int m = 0; m < 8; ++m)
#pragma unroll
        for (int nt = 0; nt < 2; ++nt) Y[m][nt] = (f32x4){0.f, 0.f, 0.f, 0.f};
#pragma unroll
    for (int m = 0; m < 8; ++m)
#pragma unroll
        for (int ks = 0; ks < 2; ++ks) {
            const bf16x8 a = lds_frag128(sL, 16 * m + fr, 4 * ks + fq);
#pragma unroll
            for (int nt = 0; nt < 2; ++nt) Y[m][nt] = mfma16(a, Qf[nt][ks], Y[m][nt]);
        }
#pragma unroll
    for (int nt = 0; nt < 2; ++nt) {
        const float sc = exp2f((float)(32 * wid + 16 * nt + fr + 1) * lg2);
#pragma unroll
        for (int m = 0; m < 8; ++m) Y[m][nt] = Y[m][nt] * sc;
    }
#pragma unroll 1
    for (int s = 0; s < 4; ++s) {
        f32x4 St[2][2];
#pragma unroll
        for (int hh = 0; hh < 2; ++hh) {
            const int mt = 2 * s + hh;
#pragma unroll
            for (int nt = 0; nt < 2; ++nt) St[hh][nt] = (f32x4){0.f, 0.f, 0.f, 0.f};
#pragma unroll
            for (int ks = 0; ks < 2; ++ks) {
                const bf16x8 a = lds_frag128(kL, 16 * mt + fr, 4 * ks + fq);
#pragma unroll
                for (int nt = 0; nt < 2; ++nt) St[hh][nt] = mfma16(a, Qf[nt][ks], St[hh][nt]);
            }
#pragma unroll
            for (int nt = 0; nt < 2; ++nt) {
                const int qi = 32 * wid + 16 * nt + fr;
#pragma unroll
                for (int r = 0; r < 4; ++r) {
                    const int kj = 16 * mt + 4 * fq + r;
                    const float dm = qi >= kj ? exp2f((float)(qi - kj) * lg2) : 0.f;
                    St[hh][nt][r] *= dm;
                }
            }
        }
        bf16x8 Pb[2];
#pragma unroll
        for (int nt = 0; nt < 2; ++nt) Pb[nt] = pack8(St[0][nt], St[1][nt]);
#pragma unroll
        for (int m = 0; m < 8; ++m) {
            const bf16x8 a = lds_vfrag256(vL, 16 * m + fr, 32 * s, fq);
#pragma unroll
            for (int nt = 0; nt < 2; ++nt) Y[m][nt] = mfma16(a, Pb[nt], Y[m][nt]);
        }
    }
    bf16_t* YB = (bf16_t*)(ws + WS_YB);
#pragma unroll
    for (int nt = 0; nt < 2; ++nt) {
        float sum = 0.f;
#pragma unroll
        for (int m = 0; m < 8; ++m) sum += Y[m][nt][0] + Y[m][nt][1] + Y[m][nt][2] + Y[m][nt][3];
        sum += __shfl_xor(sum, 16); sum += __shfl_xor(sum, 32);
        const float mu = sum * (1.f / 128.f);
        float vs = 0.f;
#pragma unroll
        for (int m = 0; m < 8; ++m)
#pragma unroll
            for (int r = 0; r < 4; ++r) { const float dlt = Y[m][nt][r] - mu; vs += dlt * dlt; }
        vs += __shfl_xor(vs, 16); vs += __shfl_xor(vs, 32);
        const float rstd = rsqrtf(vs * (1.f / 128.f) + 1e-5f);
        const size_t tk = tok0 + 32 * wid + 16 * nt + fr;
#pragma unroll
        for (int m = 0; m < 8; ++m) {
            const f32x4 gt = unpack4(*(const u32x2*)(P + tk * LD + C_GR + h * 128 + 16 * m + 4 * fq));
            f32x4 v;
#pragma unroll
            for (int r = 0; r < 4; ++r) v[r] = (Y[m][nt][r] - mu) * rstd * gt[r];
            *(u32x2*)(YB + tk * 1024 + h * 128 + 16 * m + 4 * fq) = pack4(v);
        }
    }
}
__device__ void phase_p4(const Params& p, unsigned char* lds) {
    for (int it = blockIdx.x; it < 1024; it += gridDim.x) retout_item(p, it, lds);
}

__device__ void phase_g2(const Params& p, unsigned char* lds) {
    unsigned char* ws = launder(p.ws);
    const bf16_t* P = (const bf16_t*)(ws + WS_P);
    for (int t = blockIdx.x; t < 128 * 8; t += gridDim.x) {
        const int mt = t >> 3, nt = t & 7, m0 = mt * 128, n0 = nt * 128;
        const int tid = threadIdx.x + vzero(), lane = tid & 63, wid = tid >> 6, wr = wid >> 1, wc = wid & 1, fr = lane & 15, fq = lane >> 4;
        const int ldrow = 8 * wid + (lane >> 3), ldc = ((lane & 7) ^ (lane >> 3)) * 8;
        const bf16_t* mp[4]; const bf16_t* np[4];
        bf16_t* MG = (bf16_t*)(ws + WS_MG);
        { f32x4 acc1[4][4]; zero_acc(acc1);
#pragma unroll
        for (int i = 0; i < 4; ++i) { mp[i] = (const bf16_t*)(ws + WS_WA) + (size_t)(n0 + 32 * i + ldrow) * 512 + ldc; np[i] = (const bf16_t*)(ws + WS_YA) + (size_t)(m0 + 32 * i + ldrow) * 512 + ldc; }
        gemm_kloop(mp, np, 8, lds, acc1);
#pragma unroll
        for (int mi = 0; mi < 4; ++mi)
#pragma unroll
            for (int ni = 0; ni < 4; ++ni) {
                const int n = n0 + 64 * wr + 16 * mi + 4 * fq; const size_t tok = m0 + 64 * wc + 16 * ni + fr;
                const f32x4 ga = unpack4(*(const u32x2*)(P + tok * LD + C_MA + n));
                *(u32x2*)(MG + tok * 1024 + n) = pack4(ga * acc1[mi][ni]);
            } }
        { f32x4 acc2[4][4]; zero_acc(acc2);
#pragma unroll
        for (int i = 0; i < 4; ++i) { mp[i] = (const bf16_t*)(ws + WS_WB) + (size_t)(n0 + 32 * i + ldrow) * 1024 + ldc; np[i] = (const bf16_t*)(ws + WS_YB) + (size_t)(m0 + 32 * i + ldrow) * 1024 + ldc; }
        gemm_kloop(mp, np, 16, lds, acc2);
#pragma unroll
        for (int mi = 0; mi < 4; ++mi)
#pragma unroll
            for (int ni = 0; ni < 4; ++ni) {
                const int n = n0 + 64 * wr + 16 * mi + 4 * fq; const size_t tok = m0 + 64 * wc + 16 * ni + fr;
                const f32x4 gb = unpack4(*(const u32x2*)(P + tok * LD + C_MB + n));
                const f32x4 v = unpack4(*(const u32x2*)(MG + tok * 1024 + n)) + gb * acc2[mi][ni];
                *(u32x2*)(MG + tok * 1024 + n) = pack4(v);
            } }
    }
}

__device__ void phase_g3(const Params& p, int layer, unsigned char* lds) {
    unsigned char* ws = launder(p.ws);
    const int tid = threadIdx.x + vzero(), lane = tid & 63, wid = tid >> 6, wr = wid >> 1, wc = wid & 1, fr = lane & 15, fq = lane >> 4;
    const int ldrow = 8 * wid + (lane >> 3), ldc = ((lane & 7) ^ (lane >> 3)) * 8;
    const float* X = layer == 0 ? p.x : (const float*)(ws + WS_X);
    float* H1 = (float*)(ws + WS_H1);
    for (int t = blockIdx.x; t < 128 * 8; t += gridDim.x) {
        const int mt = t >> 3, nt = t & 7, m0 = mt * 128, n0 = nt * 128;
        const bf16_t* mp[4]; const bf16_t* np[4];
        f32x4 acc[4][4]; zero_acc(acc);
#pragma unroll
        for (int i = 0; i < 4; ++i) { mp[i] = (const bf16_t*)(ws + WS_WO) + (size_t)(n0 + 32 * i + ldrow) * 1024 + ldc; np[i] = (const bf16_t*)(ws + WS_MG) + (size_t)(m0 + 32 * i + ldrow) * 1024 + ldc; }
        gemm_kloop(mp, np, 16, lds, acc);
#pragma unroll
        for (int mi = 0; mi < 4; ++mi)
#pragma unroll
            for (int ni = 0; ni < 4; ++ni) {
                const int n = n0 + 64 * wr + 16 * mi + 4 * fq; const size_t tok = m0 + 64 * wc + 16 * ni + fr;
                const f32x4 xv = *(const f32x4*)(X + tok * 1024 + n);
                *(f32x4*)(H1 + tok * 1024 + n) = xv * DN_ALPHA + acc[mi][ni];
            }
    }
}

__device__ void phase_ln1(const Params& p, int layer, unsigned char* lds) {
    unsigned char* ws = launder(p.ws);
    const int tid = threadIdx.x + vzero(), lane = tid & 63, wid = tid >> 6;
    float* wrL = (float*)lds;
    for (int i = tid; i < 1024 * 16; i += NTHREADS) wrL[(i & 15) * 1024 + (i >> 4)] = p.w_router[i];
    __syncthreads();
    const float* H1 = (const float*)(ws + WS_H1);
    float* X1 = (float*)(ws + WS_X1); bf16_t* X1B = (bf16_t*)(ws + WS_X1B);
    const float* gam = p.ln1_g + layer * 1024; const float* bet = p.ln1_b + layer * 1024;
    unsigned* cnt = (unsigned*)(ws + WS_CTL) + CW_CNT + layer * 16;
    int* LIST = (int*)(ws + WS_LIST); float* WTS = (float*)(ws + WS_WTS);
    for (int tok = blockIdx.x * 4 + wid; tok < T_; tok += gridDim.x * 4) {
        float4 v[4];
#pragma unroll
        for (int j = 0; j < 4; ++j) v[j] = *(const float4*)(H1 + (size_t)tok * 1024 + 256 * j + 4 * lane);
        float s = 0.f;
#pragma unroll
        for (int j = 0; j < 4; ++j) s += v[j].x + v[j].y + v[j].z + v[j].w;
#pragma unroll
        for (int o = 1; o < 64; o <<= 1) s += __shfl_xor(s, o);
        const float mu = s * (1.f / 1024.f);
        float q = 0.f;
#pragma unroll
        for (int j = 0; j < 4; ++j) { const float a = v[j].x - mu, b2 = v[j].y - mu, c = v[j].z - mu, d = v[j].w - mu; q += a * a + b2 * b2 + c * c + d * d; }
#pragma unroll
        for (int o = 1; o < 64; o <<= 1) q += __shfl_xor(q, o);
        const float rstd = rsqrtf(q * (1.f / 1024.f) + 1e-5f);
        float4 y[4];
#pragma unroll
        for (int j = 0; j < 4; ++j) {
            const int d0 = 256 * j + 4 * lane;
            const float4 gg = *(const float4*)(gam + d0), bb = *(const float4*)(bet + d0);
            y[j].x = (v[j].x - mu) * rstd * gg.x + bb.x; y[j].y = (v[j].y - mu) * rstd * gg.y + bb.y; y[j].z = (v[j].z - mu) * rstd * gg.z + bb.z; y[j].w = (v[j].w - mu) * rstd * gg.w + bb.w;
            *(float4*)(X1 + (size_t)tok * 1024 + d0) = y[j];
            u32x2 w; w.x = pack2(y[j].x, y[j].y); w.y = pack2(y[j].z, y[j].w);
            *(u32x2*)(X1B + (size_t)tok * 1024 + d0) = w;
        }
        float lg[16];
#pragma unroll
        for (int e = 0; e < 16; ++e) {
            float a = 0.f;
#pragma unroll
            for (int j = 0; j < 4; ++j) { const float4 w4 = *(const float4*)(wrL + e * 1024 + 256 * j + 4 * lane); a += y[j].x * w4.x + y[j].y * w4.y + y[j].z * w4.z + y[j].w * w4.w; }
            lg[e] = a;
        }
#pragma unroll
        for (int e = 0; e < 16; ++e) {
#pragma unroll
            for (int o = 1; o < 64; o <<= 1) lg[e] += __shfl_xor(lg[e], o);
        }
        float mx = lg[0];
#pragma unroll
        for (int e = 1; e < 16; ++e) mx = fmaxf(mx, lg[e]);
        float pr[16], ps = 0.f;
#pragma unroll
        for (int e = 0; e < 16; ++e) { pr[e] = expf(lg[e] - mx); ps += pr[e]; }
        const float ips = 1.f / ps;
        float sel[16];
#pragma unroll
        for (int e = 0; e < 16; ++e) { pr[e] *= ips; sel[e] = pr[e] + p.router_bias[e]; }
        int best = 0; float bestv = -1e30f;
#pragma unroll
        for (int gI = 0; gI < 4; ++gI) {
            float a = -1e30f, b2 = -1e30f;
#pragma unroll
            for (int k = 0; k < 4; ++k) { const float x = sel[4 * gI + k]; if (x > a) { b2 = a; a = x; } else if (x > b2) b2 = x; }
            const float gs = a + b2;
            if (gs > bestv) { bestv = gs; best = gI; }
        }
        float s4[4], p4[4];
#pragma unroll
        for (int k = 0; k < 4; ++k) { s4[k] = 0.f; p4[k] = 0.f; }
#pragma unroll
        for (int gI = 0; gI < 4; ++gI) if (gI == best) {
#pragma unroll
            for (int k = 0; k < 4; ++k) { s4[k] = sel[4 * gI + k]; p4[k] = pr[4 * gI + k]; }
        }
        int i0 = 0; float a0 = s4[0];
#pragma unroll
        for (int k = 1; k < 4; ++k) if (s4[k] > a0) { a0 = s4[k]; i0 = k; }
        int i1 = -1; float a1 = -1e30f;
#pragma unroll
        for (int k = 0; k < 4; ++k) if (k != i0 && s4[k] > a1) { a1 = s4[k]; i1 = k; }
        float w0 = 0.f, w1 = 0.f;
#pragma unroll
        for (int k = 0; k < 4; ++k) { if (k == i0) w0 = p4[k]; if (k == i1) w1 = p4[k]; }
        const float iw = 1.f / (w0 + w1);
        if (lane == 0) {
            const int e0 = best * 4 + i0, e1 = best * 4 + i1;
            const unsigned p0 = atomicAdd(&cnt[e0], 1u); LIST[(size_t)e0 * T_ + p0] = tok * 2;
            const unsigned p1 = atomicAdd(&cnt[e1], 1u); LIST[(size_t)e1 * T_ + p1] = tok * 2 + 1;
            WTS[tok * 2] = w0 * iw; WTS[tok * 2 + 1] = w1 * iw;
        }
    }
}

__device__ __forceinline__ bool moe_find(const unsigned* cnt, int t, int colTiles, int& e, int& rt, int& ct, int& cnte, int& off) {
    int base = 0; off = 0;
    for (int k = 0; k < NE; ++k) {
        const int c = __builtin_amdgcn_readfirstlane((int)cnt[k]), nt = ((c + 127) >> 7) * colTiles;
        if (t < base + nt) { e = k; cnte = c; const int u = t - base; rt = u / colTiles; ct = u % colTiles;
            e = __builtin_amdgcn_readfirstlane(e); cnte = __builtin_amdgcn_readfirstlane(cnte); rt = __builtin_amdgcn_readfirstlane(rt);
            ct = __builtin_amdgcn_readfirstlane(ct); off = __builtin_amdgcn_readfirstlane(off); return true; }
        base += nt; off += c;
    }
    return false;
}
__device__ void phase_m2(const Params& p, int layer, unsigned char* lds) {
    unsigned char* ws = launder(p.ws);
    const int tid = threadIdx.x + vzero(), lane = tid & 63, wid = tid >> 6, wr = wid >> 1, wc = wid & 1, fr = lane & 15, fq = lane >> 4;
    const int ldrow = 8 * wid + (lane >> 3), ldc = ((lane & 7) ^ (lane >> 3)) * 8;
    const unsigned* cnt = (const unsigned*)(ws + WS_CTL) + CW_CNT + layer * 16 + vzero();
    const int* LIST = (const int*)(ws + WS_LIST);
    const bf16_t* X1B = (const bf16_t*)(ws + WS_X1B);
    bf16_t* HB = (bf16_t*)(ws + WS_HB);
    for (int t = blockIdx.x;; t += gridDim.x) {
        int e, rt, ct, cnte, off;
        if (!moe_find(cnt, t, 8, e, rt, ct, cnte, off)) break;
        const bf16_t* mp[4]; const bf16_t* np[4];
#pragma unroll
        for (int i = 0; i < 4; ++i) {
            const int rho = 32 * i + ldrow, blk = rho >> 4, nn = ct * 64 + (blk >> 1) * 16 + (rho & 15);
            mp[i] = (const bf16_t*)(ws + ((blk & 1) ? WS_WU : WS_WG)) + ((size_t)e * 512 + nn) * 1024 + ldc;
            int idx = rt * 128 + rho; idx = idx < cnte ? idx : cnte - 1;
            const int a = LIST[(size_t)e * T_ + idx];
            np[i] = X1B + (size_t)(a >> 1) * 1024 + ldc;
        }
        f32x4 acc[4][4]; zero_acc(acc);
        gemm_kloop(mp, np, 16, lds, acc);
#pragma unroll
        for (int mp2 = 0; mp2 < 2; ++mp2)
#pragma unroll
            for (int ni = 0; ni < 4; ++ni) {
                const int idx = rt * 128 + 64 * wc + 16 * ni + fr;
                if (idx < cnte) {
                    const int n = ct * 64 + (2 * wr + mp2) * 16 + 4 * fq;
                    const f32x4 gv = acc[2 * mp2][ni], uv = acc[2 * mp2 + 1][ni];
                    f32x4 hv;
#pragma unroll
                    for (int r = 0; r < 4; ++r) hv[r] = gv[r] * sigmoidf_(gv[r]) * uv[r];
                    *(u32x2*)(HB + (size_t)(off + idx) * 512 + n) = pack4(hv);
                }
            }
    }
}
__device__ void phase_m3(const Params& p, int layer, unsigned char* lds) {
    unsigned char* ws = launder(p.ws);
    const int tid = threadIdx.x + vzero(), lane = tid & 63, wid = tid >> 6, wr = wid >> 1, wc = wid & 1, fr = lane & 15, fq = lane >> 4;
    const int ldrow = 8 * wid + (lane >> 3), ldc = ((lane & 7) ^ (lane >> 3)) * 8;
    const unsigned* cnt = (const unsigned*)(ws + WS_CTL) + CW_CNT + layer * 16 + vzero();
    const int* LIST = (const int*)(ws + WS_LIST);
    const bf16_t* HB = (const bf16_t*)(ws + WS_HB);
    bf16_t* CT = (bf16_t*)(ws + WS_CT);
    for (int t = blockIdx.x;; t += gridDim.x) {
        int e, rt, ct, cnte, off;
        if (!moe_find(cnt, t, 8, e, rt, ct, cnte, off)) break;
        const bf16_t* mp[4]; const bf16_t* np[4];
#pragma unroll
        for (int i = 0; i < 4; ++i) {
            const int rho = 32 * i + ldrow;
            mp[i] = (const bf16_t*)(ws + WS_WD) + ((size_t)e * 1024 + ct * 128 + rho) * 512 + ldc;
            int idx = rt * 128 + rho; idx = idx < cnte ? idx : cnte - 1;
            np[i] = HB + (size_t)(off + idx) * 512 + ldc;
        }
        f32x4 acc[4][4]; zero_acc(acc);
        gemm_kloop(mp, np, 8, lds, acc);
#pragma unroll
        for (int ni = 0; ni < 4; ++ni) {
            const int idx = rt * 128 + 64 * wc + 16 * ni + fr;
            if (idx < cnte) {
                const int a = LIST[(size_t)e * T_ + idx];
#pragma unroll
                for (int mi = 0; mi < 4; ++mi) {
                    const int n = ct * 128 + 64 * wr + 16 * mi + 4 * fq;
                    *(u32x2*)(CT + (size_t)a * 1024 + n) = pack4(acc[mi][ni]);
                }
            }
        }
    }
}

__device__ void phase_ln2(const Params& p, int layer) {
    unsigned char* ws = launder(p.ws);
    const int tid = threadIdx.x + vzero(), lane = tid & 63, wid = tid >> 6;
    const float* X1 = (const float*)(ws + WS_X1); const bf16_t* CT = (const bf16_t*)(ws + WS_CT); const float* WTS = (const float*)(ws + WS_WTS);
    float* XO = layer == NLAYER - 1 ? p.out : (float*)(ws + WS_X); bf16_t* XB = (bf16_t*)(ws + WS_XB);
    const float* gam = p.ln2_g + layer * 1024; const float* bet = p.ln2_b + layer * 1024;
    for (int tok = blockIdx.x * 4 + wid; tok < T_; tok += gridDim.x * 4) {
        const float w0 = WTS[tok * 2 + vzero()], w1 = WTS[tok * 2 + 1 + vzero()];
        float4 v[4];
#pragma unroll
        for (int j = 0; j < 4; ++j) {
            const int d0 = 256 * j + 4 * lane;
            const float4 xv = *(const float4*)(X1 + (size_t)tok * 1024 + d0);
            const f32x4 c0 = unpack4(*(const u32x2*)(CT + (size_t)(tok * 2) * 1024 + d0)), c1 = unpack4(*(const u32x2*)(CT + (size_t)(tok * 2 + 1) * 1024 + d0));
            v[j].x = xv.x * DN_ALPHA + w0 * c0[0] + w1 * c1[0]; v[j].y = xv.y * DN_ALPHA + w0 * c0[1] + w1 * c1[1];
            v[j].z = xv.z * DN_ALPHA + w0 * c0[2] + w1 * c1[2]; v[j].w = xv.w * DN_ALPHA + w0 * c0[3] + w1 * c1[3];
        }
        float s = 0.f;
#pragma unroll
        for (int j = 0; j < 4; ++j) s += v[j].x + v[j].y + v[j].z + v[j].w;
#pragma unroll
        for (int o = 1; o < 64; o <<= 1) s += __shfl_xor(s, o);
        const float mu = s * (1.f / 1024.f);
        float q = 0.f;
#pragma unroll
        for (int j = 0; j < 4; ++j) { const float a = v[j].x - mu, b2 = v[j].y - mu, c = v[j].z - mu, d = v[j].w - mu; q += a * a + b2 * b2 + c * c + d * d; }
#pragma unroll
        for (int o = 1; o < 64; o <<= 1) q += __shfl_xor(q, o);
        const float rstd = rsqrtf(q * (1.f / 1024.f) + 1e-5f);
#pragma unroll
        for (int j = 0; j < 4; ++j) {
            const int d0 = 256 * j + 4 * lane;
            const float4 gg = *(const float4*)(gam + d0), bb = *(const float4*)(bet + d0);
            float4 y; y.x = (v[j].x - mu) * rstd * gg.x + bb.x; y.y = (v[j].y - mu) * rstd * gg.y + bb.y; y.z = (v[j].z - mu) * rstd * gg.z + bb.z; y.w = (v[j].w - mu) * rstd * gg.w + bb.w;
            *(float4*)(XO + (size_t)tok * 1024 + d0) = y;
            u32x2 w; w.x = pack2(y.x, y.y); w.y = pack2(y.z, y.w);
            *(u32x2*)(XB + (size_t)tok * 1024 + d0) = w;
        }
    }
}

#define XB_TMO      128
#define XB_XCNT(j)  (256  + 64 * (j))
#define XB_XSUB(j)  (1280 + 64 * (j))
#define XB_XGEN(j)  (2304 + 64 * (j))
#define XB_TOP      3328
#define XB_TOPGEN   3392
#define XCD_BAR_WORDS 3456
#define XB_SPIN_CAP (1u << 22)
#define LAS __attribute__((address_space(3)))
__device__ __forceinline__ unsigned xb_ld(unsigned* p)              { return __hip_atomic_load(p, __ATOMIC_RELAXED, __HIP_MEMORY_SCOPE_AGENT); }
__device__ __forceinline__ unsigned xb_add(unsigned* p, unsigned v) { return __hip_atomic_fetch_add(p, v, __ATOMIC_RELAXED, __HIP_MEMORY_SCOPE_AGENT); }
__device__ __forceinline__ unsigned xb_xcc_id() { return (unsigned)__builtin_amdgcn_s_getreg((3 << 11) | 20) & 0xFu; }
#define XB_SPIN(cond, bar) do { unsigned _sp = 0; while (cond) { __builtin_amdgcn_s_sleep(1); \
    if ((++_sp & 255u) == 0u) { if (xb_ld(&(bar)[XB_TMO])) break; if (_sp > XB_SPIN_CAP) { atomicAdd(&(bar)[XB_TMO], 1u); break; } } } } while (0)
struct XcdBarrier { unsigned* bar; unsigned x; volatile LAS unsigned* st; };
__device__ __forceinline__ XcdBarrier xcd_barrier_post(unsigned* bar, volatile LAS unsigned* st) {
    XcdBarrier b; b.bar = bar; b.x = xb_xcc_id(); b.st = st;
    if (threadIdx.x == 0) (void)xb_add(&bar[XB_XCNT(b.x)], 1u);
    return b;
}
__device__ __forceinline__ void xcd_barrier_complete(unsigned* bar, unsigned x, unsigned& nloc, unsigned& nx) {
    const unsigned G = gridDim.x * gridDim.y * gridDim.z;
    unsigned sum, cnt, mine, sp = 0u;
    for (;;) {
        sum = 0u; cnt = 0u; mine = 0u;
#pragma unroll
        for (unsigned j = 0; j < 16; ++j) { const unsigned c = xb_ld(&bar[XB_XCNT(j)]); sum += c; cnt += (c > 0u) ? 1u : 0u; mine = (j == x) ? c : mine; }
        if (sum == G) break;
        __builtin_amdgcn_s_sleep(1);
        if ((++sp & 255u) == 0u) { if (xb_ld(&bar[XB_TMO])) break; if (sp > XB_SPIN_CAP) { atomicAdd(&bar[XB_TMO], 1u); break; } }
    }
    nloc = mine > 0u ? mine : 1u; nx = cnt > 0u ? cnt : 1u;
}
__device__ __forceinline__ void xcd_barrier(const XcdBarrier& b) {
    asm volatile("s_waitcnt vmcnt(0)" ::: "memory");
    __syncthreads();
    if (threadIdx.x == 0) {
        unsigned* bar = b.bar;
        __builtin_amdgcn_s_waitcnt(0);
        unsigned nloc = b.st[0], nx = b.st[1];
        if (nloc == 0u) { xcd_barrier_complete(bar, b.x, nloc, nx); b.st[0] = nloc; b.st[1] = nx; }
        const unsigned old = xb_add(&bar[XB_XSUB(b.x)], 1u);
        const unsigned gen = old / nloc;
        if (old + 1u == (gen + 1u) * nloc) {
            __builtin_amdgcn_fence(__ATOMIC_RELEASE, "agent");
            asm volatile("s_waitcnt vmcnt(0)" ::: "memory");
            const unsigned og = xb_add(&bar[XB_TOP], 1u);
            const unsigned tg = og / nx;
            if (og + 1u == (tg + 1u) * nx) xb_add(&bar[XB_TOPGEN], 1u);
            else XB_SPIN(xb_ld(&bar[XB_TOPGEN]) == tg, bar);
            __builtin_amdgcn_fence(__ATOMIC_ACQUIRE, "agent");
            xb_add(&bar[XB_XGEN(b.x)], 1u);
            asm volatile("s_waitcnt vmcnt(0)" ::: "memory");
        } else {
            XB_SPIN(xb_ld(&bar[XB_XGEN(b.x)]) == gen, bar);
            __builtin_amdgcn_fence(__ATOMIC_ACQUIRE, "agent");
            asm volatile("s_waitcnt vmcnt(0)" ::: "memory");
        }
    }
    __syncthreads();
}

constexpr int PH_PER_LAYER = 11, N_PHASES = PH_PER_LAYER * NLAYER;
__global__ void __launch_bounds__(NTHREADS, 2) mega(Params p) {
    extern __shared__ __attribute__((aligned(16))) unsigned char lds[];
#if SINGLE_LAUNCH
    volatile LAS unsigned* xbw = (volatile LAS unsigned*)(lds + LDS_BYTES - 16);
    if (threadIdx.x < 4) xbw[threadIdx.x] = 0u;
    __syncthreads();
    XcdBarrier xbar = xcd_barrier_post((unsigned*)(p.ws + WS_CTL) + CW_BAR, xbw);
#endif
    for (int ph = p.ph_lo; ph < p.ph_hi; ++ph) {
        const int layer = ph / PH_PER_LAYER, k = ph % PH_PER_LAYER;
#ifdef ONLY_PHASE
        if (k != ONLY_PHASE) continue;
#endif
#ifdef REPEAT_MASK
        for (int rep = 0; rep < (((REPEAT_MASK) >> k) & 1) + 1; ++rep) {
        if (rep) __syncthreads();
#endif
        switch (k) {
            case 0: phase_pw(p, layer, lds); break;
            case 1: phase_g1(p, layer, lds); break;
            case 2: phase_p2(p, layer, lds); break;
            case 3: phase_p3(p, lds); break;
            case 4: phase_p4(p, lds); break;
            case 5: phase_g2(p, lds); break;
            case 6: phase_g3(p, layer, lds); break;
            case 7: phase_ln1(p, layer, lds); break;
            case 8: phase_m2(p, layer, lds); break;
            case 9: phase_m3(p, layer, lds); break;
            case 10: phase_ln2(p, layer); break;
        }
#ifdef REPEAT_MASK
        }
#endif
#if SINGLE_LAUNCH
        if (ph + 1 < p.ph_hi) { if (ph == p.ph_lo) cg::this_grid().sync(); else xcd_barrier(xbar); }
#endif
    }
}

extern "C" void kernel_launch(void* const* d_in, const int* in_sizes, int n_in, void* d_out, int out_size, void* d_ws, size_t ws_size, hipStream_t stream) {
    static int grid = 0;
    if (grid == 0) {
        if (n_in != 18 || ws_size < WS_END) { fprintf(stderr, "kernel_launch: unexpected n_in %d or ws_size %zu < %zu\n", n_in, ws_size, (size_t)WS_END); grid = -1; return; }
        int dev = 0, cus = 0, per_cu = 0;
        hipGetDevice(&dev); hipDeviceGetAttribute(&cus, hipDeviceAttributeMultiprocessorCount, dev);
        hipFuncSetAttribute((const void*)mega, hipFuncAttributeMaxDynamicSharedMemorySize, LDS_BYTES);
        hipOccupancyMaxActiveBlocksPerMultiprocessor(&per_cu, (const void*)mega, NTHREADS, LDS_BYTES);
        if (per_cu < 1) per_cu = 1;
        if (per_cu > 2) per_cu = 2;
        grid = cus * per_cu;
        (void)hipGetLastError();
    }
    if (grid < 0) return;
    Params p{};
    p.x = (const float*)d_in[0]; p.w_in = (const float*)d_in[1]; p.cmp_pos = (const float*)d_in[2]; p.cmp_w1 = (const float*)d_in[3]; p.cmp_w2 = (const float*)d_in[4];
    p.w_br_a = (const float*)d_in[5]; p.w_br_b = (const float*)d_in[6]; p.w_o = (const float*)d_in[7]; p.ln1_g = (const float*)d_in[8]; p.ln1_b = (const float*)d_in[9];
    p.w_router = (const float*)d_in[10]; p.router_bias = (const float*)d_in[11]; p.w_gate = (const float*)d_in[12]; p.w_up = (const float*)d_in[13]; p.w_down = (const float*)d_in[14];
    p.ln2_g = (const float*)d_in[15]; p.ln2_b = (const float*)d_in[16]; p.rel_bias = (const float*)d_in[17];
    p.out = (float*)d_out; p.ws = (unsigned char*)d_ws;
#if SINGLE_LAUNCH
    hipMemsetAsync((unsigned char*)d_ws + WS_CTL + (size_t)CW_BAR * 4, 0, XCD_BAR_WORDS * 4, stream);
    p.ph_lo = 0; p.ph_hi = N_PHASES;
    void* args[] = {&p};
    hipError_t e = hipLaunchCooperativeKernel((const void*)mega, dim3(grid), dim3(NTHREADS), args, LDS_BYTES, stream);
    if (e != hipSuccess) fprintf(stderr, "cooperative launch failed: %s (grid %d)\n", hipGetErrorString(e), grid);
#else
    for (int ph = 0; ph < N_PHASES; ++ph) {
        p.ph_lo = ph; p.ph_hi = ph + 1;
        hipLaunchKernelGGL(mega, dim3(grid), dim3(NTHREADS), LDS_BYTES, stream, p);
    }
#endif
}
```

```cpp
#include <hip/hip_runtime.h>
#include <hip/hip_cooperative_groups.h>
#include <cstdio>
#include <cstdint>
namespace cg = cooperative_groups;

#ifndef SINGLE_LAUNCH
#define SINGLE_LAUNCH 1
#endif

typedef unsigned short bf16_t;
typedef short bf16x8 __attribute__((ext_vector_type(8)));
typedef float f32x4 __attribute__((ext_vector_type(4)));
typedef unsigned u32x2 __attribute__((ext_vector_type(2)));
typedef unsigned u32x4 __attribute__((ext_vector_type(4)));

constexpr int B_ = 2, S_ = 8192, D_ = 1024, T_ = B_ * S_, NLAYER = 4;
constexpr int DIN = 6424;
constexpr int LD = 6528;
constexpr int C_QA = 0, C_KC = 512, C_VC = 640, C_KS = 768, C_VS = 896, C_KW = 1024, C_VW = 1152, C_QR = 1280, C_KR = 1792,
              C_VR = 2304, C_GR = 3328, C_MA = 4352, C_MB = 5376, C_GA = 6400;
constexpr float DN_ALPHA = 1.681792830507429f;
constexpr int NE = 16;

constexpr size_t al256(size_t x) { return (x + 255) & ~(size_t)255; }
constexpr size_t WS_CTL = 0;
constexpr size_t WS_BUCKET = 65536;
constexpr size_t WS_ROPE = WS_BUCKET + 8192;
constexpr size_t WS_WIN = WS_ROPE + (size_t)8192 * 32 * 8;
constexpr size_t WS_WA = WS_WIN + (size_t)LD * 1024 * 2;
constexpr size_t WS_WB = WS_WA + (size_t)1024 * 512 * 2;
constexpr size_t WS_WO = WS_WB + (size_t)1024 * 1024 * 2;
constexpr size_t WS_WG = WS_WO + (size_t)1024 * 1024 * 2;
constexpr size_t WS_WU = WS_WG + (size_t)16 * 512 * 1024 * 2;
constexpr size_t WS_WD = WS_WU + (size_t)16 * 512 * 1024 * 2;
constexpr size_t WS_XB = WS_WD + (size_t)16 * 512 * 1024 * 2;
constexpr size_t WS_X = WS_XB + (size_t)T_ * 1024 * 2;
constexpr size_t WS_MG = WS_X + (size_t)T_ * 1024 * 4;
constexpr size_t WS_KCC = WS_MG + (size_t)T_ * 1024 * 2;
constexpr size_t WS_VCCT = WS_KCC + (size_t)4 * 512 * 64 * 2;
constexpr size_t WS_W1T = WS_VCCT + (size_t)4 * 512 * 64 * 2;
constexpr size_t WS_B1 = WS_W1T + (size_t)2 * 64 * 2048 * 2;
constexpr size_t WS_R = WS_B1 + 1024;
constexpr size_t WS_P = WS_R;
constexpr size_t WS_VST = WS_P + (size_t)T_ * LD * 2;
constexpr size_t WS_VWT = WS_VST + (size_t)4 * 64 * S_ * 2;
constexpr size_t WS_VRT = WS_VWT + (size_t)4 * 64 * S_ * 2;
constexpr size_t WS_KVT = WS_VRT + (size_t)16 * 128 * S_ * 2;
constexpr size_t WS_SPT = WS_KVT + (size_t)16 * 64 * 8192 * 4;
constexpr size_t WS_YC = WS_SPT + (size_t)16 * 64 * 8192 * 2;
constexpr size_t WS_YW = WS_YC + (size_t)T_ * 512 * 2;
constexpr size_t WS_YA = WS_YW + (size_t)T_ * 512 * 2;
constexpr size_t WS_YB = WS_YA + (size_t)T_ * 512 * 2;
constexpr size_t WS_SELW = WS_YB + (size_t)T_ * 1024 * 2;
constexpr size_t WS_ENDA = WS_SELW + (size_t)T_ * 2 * 4 * 4;
constexpr size_t WS_H1 = WS_R;
constexpr size_t WS_X1 = WS_H1 + (size_t)T_ * 1024 * 4;
constexpr size_t WS_X1B = WS_X1 + (size_t)T_ * 1024 * 4;
constexpr size_t WS_HB = WS_X1B + (size_t)T_ * 1024 * 2;
constexpr size_t WS_CT = WS_P + (size_t)T_ * LD * 2;
constexpr size_t WS_LIST = WS_CT + (size_t)2 * T_ * 1024 * 2;
constexpr size_t WS_WTS = WS_LIST + (size_t)16 * T_ * 4;
constexpr size_t WS_ENDB = WS_WTS + (size_t)2 * T_ * 4;
static_assert(WS_HB + (size_t)2 * T_ * 512 * 2 <= WS_CT, "view B overlap");
constexpr size_t WS_END = WS_ENDA > WS_ENDB ? WS_ENDA : WS_ENDB;

constexpr int CW_CNT = 4096;
constexpr int CW_BAR = 8192;

constexpr int LDS_BYTES = 75776;
constexpr int NTHREADS = 256;

struct Params {
    const float* x; const float* w_in; const float* cmp_pos; const float* cmp_w1; const float* cmp_w2;
    const float* w_br_a; const float* w_br_b; const float* w_o; const float* ln1_g; const float* ln1_b;
    const float* w_router; const float* router_bias; const float* w_gate; const float* w_up; const float* w_down;
    const float* ln2_g; const float* ln2_b; const float* rel_bias;
    float* out; unsigned char* ws;
    int ph_lo, ph_hi;
};

__device__ __forceinline__ bf16_t f2bf(float f) { unsigned u = __float_as_uint(f); u += 0x7fffu + ((u >> 16) & 1u); return (bf16_t)(u >> 16); }
__device__ __forceinline__ float bf2f(unsigned h) { return __uint_as_float(h << 16); }
__device__ __forceinline__ unsigned pack2(float lo, float hi) { return (unsigned)f2bf(lo) | ((unsigned)f2bf(hi) << 16); }
__device__ __forceinline__ u32x2 pack4(f32x4 v) { u32x2 r; r.x = pack2(v[0], v[1]); r.y = pack2(v[2], v[3]); return r; }
__device__ __forceinline__ f32x4 unpack4(u32x2 u) { f32x4 r; r[0] = bf2f(u.x & 0xffffu); r[1] = bf2f(u.x >> 16); r[2] = bf2f(u.y & 0xffffu); r[3] = bf2f(u.y >> 16); return r; }
__device__ __forceinline__ float sigmoidf_(float x) { return 1.f / (1.f + __expf(-x)); }
__device__ __forceinline__ int vzero() { int z; asm volatile("v_mov_b32 %0, 0" : "=v"(z)); return z; }
__device__ __forceinline__ unsigned char* launder(unsigned char* q) { asm volatile("" : "+s"(q)); return q; }
__device__ __forceinline__ void wait_vm0() { asm volatile("s_waitcnt vmcnt(0)" ::: "memory"); }

__device__ __forceinline__ void glds16(const void* g, void* l) {
    __builtin_amdgcn_global_load_lds((const __attribute__((address_space(1))) unsigned*)g,
                                     (__attribute__((address_space(3))) unsigned*)l, 16, 0, 0);
}
__device__ __forceinline__ f32x4 mfma16(bf16x8 a, bf16x8 b, f32x4 c) { return __builtin_amdgcn_mfma_f32_16x16x32_bf16(a, b, c, 0, 0, 0); }

__device__ __forceinline__ void gemm_stage(const bf16_t* const (&mp)[4], const bf16_t* const (&np)[4], int kt, unsigned char* st, int wid) {
#pragma unroll
    for (int i = 0; i < 4; ++i) {
        glds16(mp[i] + kt * 64, st + (4 * i + wid) * 1024);
        glds16(np[i] + kt * 64, st + 16384 + (4 * i + wid) * 1024);
    }
}
__device__ __forceinline__ void gemm_compute(const unsigned char* st, f32x4 (&acc)[4][4], int wr, int wc, int fr, int fq) {
#pragma unroll
    for (int ks = 0; ks < 2; ++ks) {
        bf16x8 a[4], b[4];
        const int sw = ((4 * ks + fq) ^ (fr & 7)) << 4;
#pragma unroll
        for (int i = 0; i < 4; ++i) {
            a[i] = *(const bf16x8*)(st + (64 * wr + 16 * i + fr) * 128 + sw);
            b[i] = *(const bf16x8*)(st + 16384 + (64 * wc + 16 * i + fr) * 128 + sw);
        }
#pragma unroll
        for (int i = 0; i < 4; ++i)
#pragma unroll
            for (int j = 0; j < 4; ++j) acc[i][j] = mfma16(a[i], b[j], acc[i][j]);
    }
}
__device__ __forceinline__ void gemm_kloop(const bf16_t* const (&mp)[4], const bf16_t* const (&np)[4], int nk, unsigned char* lds, f32x4 (&acc)[4][4]) {
    const int tid = threadIdx.x + vzero(), lane = tid & 63, wid = tid >> 6, wr = wid >> 1, wc = wid & 1, fr = lane & 15, fq = lane >> 4;
    gemm_stage(mp, np, 0, lds, wid);
    wait_vm0(); __syncthreads();
    for (int kt = 0; kt < nk; ++kt) {
        unsigned char* cur = lds + (kt & 1) * 32768;
        if (kt + 1 < nk) gemm_stage(mp, np, kt + 1, lds + ((kt + 1) & 1) * 32768, wid);
        gemm_compute(cur, acc, wr, wc, fr, fq);
        wait_vm0(); __syncthreads();
    }
}
__device__ __forceinline__ void zero_acc(f32x4 (&acc)[4][4]) {
#pragma unroll
    for (int i = 0; i < 4; ++i)
#pragma unroll
        for (int j = 0; j < 4; ++j) acc[i][j] = (f32x4){0.f, 0.f, 0.f, 0.f};
}

__device__ void tcvt_tile(const float* src, int ld_src, int k0, int n0, int mode, bf16_t* dst, int kdst, unsigned char* lds) {
    float* tile = (float*)lds;
    const int tid = threadIdx.x + vzero();
#pragma unroll
    for (int i = 0; i < 4; ++i) {
        const int kk = (tid >> 4) + 16 * i, c4 = (tid & 15) * 4, cd = n0 + c4;
        int orig = cd; bool ok = true;
        if (mode == 1) { if (cd < 1280) orig = cd; else if (cd < 6400) orig = cd + 24; else if (cd < 6424) orig = cd - 6400 + 1280; else ok = false; }
        float4 v = make_float4(0.f, 0.f, 0.f, 0.f);
        if (ok) v = *(const float4*)(src + (size_t)(k0 + kk) * ld_src + orig);
        tile[kk * 65 + c4 + 0] = v.x; tile[kk * 65 + c4 + 1] = v.y; tile[kk * 65 + c4 + 2] = v.z; tile[kk * 65 + c4 + 3] = v.w;
    }
    __syncthreads();
#pragma unroll
    for (int i = 0; i < 2; ++i) {
        const int q = tid + 256 * i, n = q >> 3, kc = q & 7;
        float v[8];
#pragma unroll
        for (int j = 0; j < 8; ++j) v[j] = tile[(kc * 8 + j) * 65 + n];
        u32x4 w; w.x = pack2(v[0], v[1]); w.y = pack2(v[2], v[3]); w.z = pack2(v[4], v[5]); w.w = pack2(v[6], v[7]);
        *(u32x4*)(dst + (size_t)(n0 + n) * kdst + k0 + kc * 8) = w;
    }
    __syncthreads();
}

__device__ void phase_pw(const Params& p, int layer, unsigned char* lds) {
    const int bid = blockIdx.x, nblk = gridDim.x, tid = threadIdx.x + vzero();
    unsigned char* ws = launder(p.ws);
    constexpr int J0 = 16 * 102, J1 = 8 * 16, J2 = 256, J3 = 256, J4 = 2048, J5 = 2048, J6 = 2048, JT = J0 + J1 + J2 + J3 + J4 + J5 + J6;
    for (int t = bid; t < JT; t += nblk) {
        int u = t;
        if (u < J0) { tcvt_tile(p.w_in + (size_t)layer * 1024 * DIN, DIN, (u % 16) * 64, (u / 16) * 64, 1, (bf16_t*)(ws + WS_WIN), 1024, lds); continue; }
        u -= J0;
        if (u < J1) { tcvt_tile(p.w_br_a + (size_t)layer * 512 * 1024, 1024, (u % 8) * 64, (u / 8) * 64, 0, (bf16_t*)(ws + WS_WA), 512, lds); continue; }
        u -= J1;
        if (u < J2) { tcvt_tile(p.w_br_b + (size_t)layer * 1024 * 1024, 1024, (u % 16) * 64, (u / 16) * 64, 0, (bf16_t*)(ws + WS_WB), 1024, lds); continue; }
        u -= J2;
        if (u < J3) { tcvt_tile(p.w_o + (size_t)layer * 1024 * 1024, 1024, (u % 16) * 64, (u / 16) * 64, 0, (bf16_t*)(ws + WS_WO), 1024, lds); continue; }
        u -= J3;
        if (u < J4 + J5) {
            const bool up = u >= J4; if (up) u -= J4;
            const int e = u / 128, v = u % 128;
            const float* src = (up ? p.w_up : p.w_gate) + ((size_t)layer * NE + e) * 1024 * 512;
            tcvt_tile(src, 512, (v % 16) * 64, (v / 16) * 64, 0, (bf16_t*)(ws + (up ? WS_WU : WS_WG)) + (size_t)e * 512 * 1024, 1024, lds); continue;
        }
        u -= J4 + J5;
        { const int e = u / 128, v = u % 128;
          const float* src = p.w_down + ((size_t)layer * NE + e) * 512 * 1024;
          tcvt_tile(src, 1024, (v % 8) * 64, (v / 8) * 64, 0, (bf16_t*)(ws + WS_WD) + (size_t)e * 1024 * 512, 512, lds); }
    }
    for (int t = bid; t < 64; t += nblk) {
        const int kv = t >> 5, kt = t & 31;
        tcvt_tile(p.cmp_w1 + ((size_t)layer * 2 + kv) * 2048 * 64, 64, kt * 64, 0, 0, (bf16_t*)(ws + WS_W1T) + (size_t)kv * 64 * 2048, 2048, lds);
    }
    if (bid >= nblk - 2) {
        const int kv = nblk - 1 - bid, n = tid & 63, part = tid >> 6;
        const float* w1 = p.cmp_w1 + ((size_t)layer * 2 + kv) * 2048 * 64; const float* pos = p.cmp_pos + ((size_t)layer * 2 + kv) * 2048;
        float a = 0.f;
        for (int k = part * 512; k < part * 512 + 512; ++k) a += pos[k] * w1[(size_t)k * 64 + n];
        float* red = (float*)lds;
        __syncthreads(); red[tid] = a; __syncthreads();
        if (tid < 64) ((float*)(ws + WS_B1))[kv * 64 + tid] = red[tid] + red[tid + 64] + red[tid + 128] + red[tid + 192];
        __syncthreads();
    }
    if (layer == 0) {
        const float4* xs = (const float4*)p.x; u32x2* xb = (u32x2*)(ws + WS_XB);
        for (size_t i = (size_t)bid * NTHREADS + tid; i < (size_t)T_ * 1024 / 4; i += (size_t)nblk * NTHREADS) {
            float4 v = xs[i]; u32x2 w; w.x = pack2(v.x, v.y); w.y = pack2(v.z, v.w); xb[i] = w;
        }
        for (int n = bid * NTHREADS + tid; n < 8192; n += nblk * NTHREADS) {
            int bk;
            if (n < 16) bk = n;
            else { const int th[15] = {22, 30, 40, 54, 73, 99, 134, 182, 246, 332, 450, 609, 825, 1117, 1513}; bk = 16;
#pragma unroll
                for (int k = 0; k < 15; ++k) bk += (n >= th[k]) ? 1 : 0; }
            (ws + WS_BUCKET)[n] = (unsigned char)bk;
        }
        for (int i = bid * NTHREADS + tid; i < 8192 * 32; i += nblk * NTHREADS) {
            const int pos = i >> 5, d = i & 31;
            const float inv = powf(10000.f, -(float)d * 2.0f / 64.f);
            const float ang = (float)pos * inv;
            float sn, cs; sincosf(ang, &sn, &cs);
            ((float2*)(ws + WS_ROPE))[i] = make_float2(cs, sn);
        }
        if (bid == 0 && tid < 64) ((unsigned*)(ws + WS_CTL))[CW_CNT + tid] = 0u;
    }
}

__device__ void phase_g1(const Params& p, int layer, unsigned char* lds) {
    unsigned char* ws = launder(p.ws);
    const bf16_t* XB = (const bf16_t*)(ws + WS_XB);
    const bf16_t* WT = (const bf16_t*)(ws + WS_WIN);
    bf16_t* P = (bf16_t*)(ws + WS_P);
    const int tid = threadIdx.x + vzero(), lane = tid & 63, wid = tid >> 6, wr = wid >> 1, wc = wid & 1, fr = lane & 15, fq = lane >> 4;
    const int ldrow = 8 * wid + (lane >> 3), ldc = ((lane & 7) ^ (lane >> 3)) * 8;
    const float2* rope = (const float2*)(ws + WS_ROPE);
    for (int t = blockIdx.x; t < 128 * 51; t += gridDim.x) {
        const int mt = t / 51, nt = t % 51, m0 = mt * 128, n0 = nt * 128;
        const bool transposed = (nt == 7) || (nt == 9) || (nt >= 18 && nt <= 25);
        const bf16_t* mp[4]; const bf16_t* np[4];
#pragma unroll
        for (int i = 0; i < 4; ++i) {
            const bf16_t* wrow = WT + (size_t)(n0 + 32 * i + ldrow) * 1024 + ldc;
            const bf16_t* xrow = XB + (size_t)(m0 + 32 * i + ldrow) * 1024 + ldc;
            mp[i] = transposed ? xrow : wrow; np[i] = transposed ? wrow : xrow;
        }
        f32x4 acc[4][4]; zero_acc(acc);
        gemm_kloop(mp, np, 16, lds, acc);
        if (!transposed) {
            const int kind = (nt >= 10 && nt <= 13) ? 1 : (nt >= 14 && nt <= 17) ? 2 : (nt >= 26 && nt <= 33) ? 3 : (nt >= 34) ? 4 : 0;
            if (kind == 1 || kind == 2) {
                const float sc = (kind == 2) ? 0.125f : 1.0f;
#pragma unroll
                for (int ni = 0; ni < 4; ++ni) {
                    const int tok = m0 + 64 * wc + 16 * ni + fr, pos = tok & (S_ - 1);
#pragma unroll
                    for (int mi = 0; mi < 2; ++mi) {
                        const int d = 16 * mi + 4 * fq;
                        const float4 cs01 = *(const float4*)(rope + pos * 32 + d), cs23 = *(const float4*)(rope + pos * 32 + d + 2);
                        const float c[4] = {cs01.x, cs01.z, cs23.x, cs23.z}, s[4] = {cs01.y, cs01.w, cs23.y, cs23.w};
                        f32x4 x1 = acc[mi][ni], x2 = acc[mi + 2][ni], y1, y2;
#pragma unroll
                        for (int r = 0; r < 4; ++r) { y1[r] = (x1[r] * c[r] - x2[r] * s[r]) * sc; y2[r] = (x1[r] * s[r] + x2[r] * c[r]) * sc; }
                        acc[mi][ni] = y1; acc[mi + 2][ni] = y2;
                    }
                }
            }
#pragma unroll
            for (int mi = 0; mi < 4; ++mi)
#pragma unroll
                for (int ni = 0; ni < 4; ++ni) {
                    const int n = n0 + 64 * wr + 16 * mi + 4 * fq, tok = m0 + 64 * wc + 16 * ni + fr;
                    f32x4 v = acc[mi][ni];
                    if (kind == 3) {
#pragma unroll
                        for (int r = 0; r < 4; ++r) v[r] = v[r] * sigmoidf_(v[r]);
                    } else if (kind == 4) {
#pragma unroll
                        for (int r = 0; r < 4; ++r) v[r] = sigmoidf_(v[r]);
                    }
                    *(u32x2*)(P + (size_t)tok * LD + n) = pack4(v);
                }
        } else {
#pragma unroll
            for (int mi = 0; mi < 4; ++mi)
#pragma unroll
                for (int ni = 0; ni < 4; ++ni) {
                    const int tok = m0 + 64 * wr + 16 * mi + 4 * fq, n = n0 + 64 * wc + 16 * ni + fr;
                    const int b = tok >> 13, s = tok & (S_ - 1);
                    bf16_t* dst;
                    if (nt == 7) { const int c = n - C_VS; dst = (bf16_t*)(ws + WS_VST) + ((size_t)(b * 2 + (c >> 6)) * 64 + (c & 63)) * S_ + s; }
                    else if (nt == 9) { const int c = n - C_VW; dst = (bf16_t*)(ws + WS_VWT) + ((size_t)(b * 2 + (c >> 6)) * 64 + (c & 63)) * S_ + s; }
                    else { const int c = n - C_VR; dst = (bf16_t*)(ws + WS_VRT) + ((size_t)(b * 8 + (c >> 7)) * 128 + (c & 127)) * S_ + s; }
                    *(u32x2*)dst = pack4(acc[mi][ni]);
                }
        }
    }
}

__device__ __forceinline__ void load_tile64(const bf16_t* base, size_t rowStride, unsigned char* dst, int wid, int lane) {
    const int c = ((lane & 7) ^ (lane >> 3)) * 8;
#pragma unroll
    for (int i = 0; i < 2; ++i) { const int j = wid + 4 * i, row = 8 * j + (lane >> 3); glds16(base + (size_t)row * rowStride + c, dst + j * 1024); }
}
__device__ __forceinline__ void load_tile128(const bf16_t* base, size_t rowStride, unsigned char* dst, int wid, int lane) {
    const int c = ((lane & 7) ^ (lane >> 3)) * 8;
#pragma unroll
    for (int i = 0; i < 4; ++i) { const int j = wid + 4 * i, row = 8 * j + (lane >> 3); glds16(base + (size_t)row * rowStride + c, dst + j * 1024); }
}
__device__ __forceinline__ void load_tile128w(const bf16_t* base, size_t rowStride, unsigned char* dst, int wid, int lane) {
    const int c = ((lane & 15) ^ ((4 * wid + (lane >> 4)) & 15)) * 8;
#pragma unroll
    for (int i = 0; i < 8; ++i) { const int j = wid + 4 * i, row = 4 * j + (lane >> 4); glds16(base + (size_t)row * rowStride + c, dst + j * 1024); }
}
__device__ __forceinline__ bf16x8 lds_frag128(const unsigned char* tile, int row, int chunk) {
    return *(const bf16x8*)(tile + row * 128 + ((chunk ^ (row & 7)) << 4));
}
__device__ __forceinline__ bf16x8 lds_frag256(const unsigned char* tile, int row, int chunk) {
    return *(const bf16x8*)(tile + row * 256 + ((chunk ^ (row & 15)) << 4));
}
__device__ __forceinline__ bf16x8 lds_vfrag128(const unsigned char* tile, int row, int kbase, int fq) {
    const int ca = (kbase >> 3) + (fq >> 1), hb = (fq & 1) * 8;
    const u32x2 a = *(const u32x2*)(tile + row * 128 + ((ca ^ (row & 7)) << 4) + hb);
    const u32x2 b = *(const u32x2*)(tile + row * 128 + (((ca + 2) ^ (row & 7)) << 4) + hb);
    u32x4 w; w.x = a.x; w.y = a.y; w.z = b.x; w.w = b.y;
    return __builtin_bit_cast(bf16x8, w);
}
__device__ __forceinline__ bf16x8 lds_vfrag256(const unsigned char* tile, int row, int kbase, int fq) {
    const int ca = (kbase >> 3) + (fq >> 1), hb = (fq & 1) * 8;
    const u32x2 a = *(const u32x2*)(tile + row * 256 + ((ca ^ (row & 15)) << 4) + hb);
    const u32x2 b = *(const u32x2*)(tile + row * 256 + (((ca + 2) ^ (row & 15)) << 4) + hb);
    u32x4 w; w.x = a.x; w.y = a.y; w.z = b.x; w.w = b.y;
    return __builtin_bit_cast(bf16x8, w);
}
__device__ __forceinline__ bf16x8 pack8(f32x4 a, f32x4 b) {
    u32x4 w; w.x = pack2(a[0], a[1]); w.y = pack2(a[2], a[3]); w.z = pack2(b[0], b[1]); w.w = pack2(b[2], b[3]);
    return __builtin_bit_cast(bf16x8, w);
}

__device__ __forceinline__ float gelu_tanh(float x) {
    const float u = 0.7978845608028654f * (x + 0.044715f * x * x * x);
    return 0.5f * x * (1.f + tanhf(u));
}
__device__ void compress_item(const Params& p, int layer, int item, unsigned char* lds) {
    unsigned char* ws = launder(p.ws);
    const int tid = threadIdx.x + vzero(), lane = tid & 63, wid = tid >> 6, wr = wid >> 1, wc = wid & 1, fr = lane & 15, fq = lane >> 4;
    const int mtile = item & 3, g = (item >> 2) & 1, b = (item >> 3) & 1, kv = item >> 4;
    const int i0 = mtile * 128;
    const bf16_t* P = (const bf16_t*)(ws + WS_P);
    const bf16_t* W1T = (const bf16_t*)(ws + WS_W1T) + (size_t)kv * 64 * 2048;
    const int col = (kv ? C_VC : C_KC) + g * 64;
    const int ldc = ((lane & 7) ^ (lane >> 3)) * 8;
    const bf16_t* ap[4];
#pragma unroll
    for (int i = 0; i < 4; ++i) ap[i] = P + ((size_t)b * S_ + 16 * (i0 + 32 * i + 8 * wid + (lane >> 3))) * LD + col + ldc;
    const bf16_t* bp[2];
#pragma unroll
    for (int i = 0; i < 2; ++i) bp[i] = W1T + (size_t)(8 * (wid + 4 * i) + (lane >> 3)) * 2048 + ldc;
    f32x4 acc[4][2];
#pragma unroll
    for (int i = 0; i < 4; ++i)
#pragma unroll
        for (int j = 0; j < 2; ++j) acc[i][j] = (f32x4){0.f, 0.f, 0.f, 0.f};
    __syncthreads();
#define CSTAGE(buf, l) do { unsigned char* st_ = lds + (buf) * 24576; \
        _Pragma("unroll") for (int i = 0; i < 4; ++i) glds16(ap[i] + (size_t)(l) * LD, st_ + (4 * i + wid) * 1024); \
        _Pragma("unroll") for (int i = 0; i < 2; ++i) glds16(bp[i] + (l) * 64, st_ + 16384 + (wid + 4 * i) * 1024); } while (0)
    CSTAGE(0, 0); wait_vm0(); __syncthreads();
    for (int l = 0; l < 32; ++l) {
        const unsigned char* st = lds + (l & 1) * 24576;
        if (l + 1 < 32) CSTAGE((l + 1) & 1, l + 1);
#pragma unroll
        for (int ks = 0; ks < 2; ++ks) {
            bf16x8 a[4], bb[2];
#pragma unroll
            for (int i = 0; i < 4; ++i) a[i] = lds_frag128(st, 64 * wr + 16 * i + fr, 4 * ks + fq);
#pragma unroll
            for (int j = 0; j < 2; ++j) bb[j] = lds_frag128(st + 16384, 32 * wc + 16 * j + fr, 4 * ks + fq);
#pragma unroll
            for (int i = 0; i < 4; ++i)
#pragma unroll
                for (int j = 0; j < 2; ++j) acc[i][j] = mfma16(a[i], bb[j], acc[i][j]);
        }
        wait_vm0(); __syncthreads();
    }
#undef CSTAGE
    float* hid = (float*)lds;
    const float* b1 = (const float*)(ws + WS_B1) + kv * 64;
#pragma unroll
    for (int j = 0; j < 2; ++j) {
        const int n = 32 * wc + 16 * j + fr; const float bias = b1[n + vzero()];
#pragma unroll
        for (int i = 0; i < 4; ++i)
#pragma unroll
            for (int r = 0; r < 4; ++r) hid[(64 * wr + 16 * i + 4 * fq + r) * 65 + n] = gelu_tanh(acc[i][j][r] + bias);
    }
    __syncthreads();
    {
        const int row = tid >> 1, nb = (tid & 1) * 32, ci = i0 + row;
        const float* w2 = p.cmp_w2 + ((size_t)layer * 2 + kv) * 64 * 64;
        float o[32];
#pragma unroll
        for (int q = 0; q < 32; ++q) o[q] = 0.f;
        for (int n = 0; n < 64; ++n) {
            const float h = hid[row * 65 + n];
#pragma unroll
            for (int q4 = 0; q4 < 8; ++q4) { const float4 w = *(const float4*)(w2 + n * 64 + nb + 4 * q4); o[4 * q4] += h * w.x; o[4 * q4 + 1] += h * w.y; o[4 * q4 + 2] += h * w.z; o[4 * q4 + 3] += h * w.w; }
        }
        if (kv == 0) {
            bf16_t* dst = (bf16_t*)(ws + WS_KCC) + ((size_t)(b * 2 + g) * 512 + ci) * 64 + nb;
#pragma unroll
            for (int q = 0; q < 32; q += 4) { f32x4 v = {o[q], o[q + 1], o[q + 2], o[q + 3]}; if (ci >= 511) v = (f32x4){0.f, 0.f, 0.f, 0.f}; *(u32x2*)(dst + q) = pack4(v); }
        } else {
            bf16_t* dst = (bf16_t*)(ws + WS_VCCT) + ((size_t)(b * 2 + g) * 64 + nb) * 512 + ci;
#pragma unroll
            for (int q = 0; q < 32; ++q) dst[(size_t)q * 512] = f2bf(ci >= 511 ? 0.f : o[q]);
        }
    }
    __syncthreads();
}

__device__ __forceinline__ float ret_lg2(int h) { const float gam = 1.f - exp2f(-5.f - (float)h); return log2f(gam); }

__device__ void retkv_item(const Params& p, int item, unsigned char* lds) {
    unsigned char* ws = launder(p.ws);
    const int tid = threadIdx.x + vzero(), lane = tid & 63, wid = tid >> 6, fr = lane & 15, fq = lane >> 4;
    const int n = item & 63, h = (item >> 6) & 7, b = item >> 9;
    const size_t tok0 = (size_t)b * S_ + 128 * n;
    unsigned char* vL = lds; unsigned char* kL = lds + 32768;
    load_tile128w((const bf16_t*)(ws + WS_VRT) + ((size_t)(b * 8 + h) * 128) * S_ + 128 * n, S_, vL, wid, lane);
    load_tile128((const bf16_t*)(ws + WS_P) + tok0 * LD + C_KR + h * 64, LD, kL, wid, lane);
    wait_vm0(); __syncthreads();
    const float lg2 = ret_lg2(h);
    f32x4 acc[2][4];
#pragma unroll
    for (int m = 0; m < 2; ++m)
#pragma unroll
        for (int nt = 0; nt < 4; ++nt) acc[m][nt] = (f32x4){0.f, 0.f, 0.f, 0.f};
#pragma unroll
    for (int ks = 0; ks < 4; ++ks) {
        bf16x8 a[2], bb[4];
#pragma unroll
        for (int m = 0; m < 2; ++m) a[m] = lds_frag256(vL, 32 * wid + 16 * m + fr, 4 * ks + fq);
        float dec[8];
#pragma unroll
        for (int j = 0; j < 8; ++j) dec[j] = exp2f((float)(127 - (32 * ks + 8 * fq + j)) * lg2);
#pragma unroll
        for (int nt = 0; nt < 4; ++nt) {
            const int d = 16 * nt + fr;
            float v[8];
#pragma unroll
            for (int j = 0; j < 8; ++j) {
                const int tk = 32 * ks + 8 * fq + j;
                const bf16_t kvv = *(const bf16_t*)(kL + tk * 128 + (((d >> 3) ^ (tk & 7)) << 4) + (d & 7) * 2);
                v[j] = bf2f(kvv) * dec[j];
            }
            u32x4 w; w.x = pack2(v[0], v[1]); w.y = pack2(v[2], v[3]); w.z = pack2(v[4], v[5]); w.w = pack2(v[6], v[7]);
            bb[nt] = __builtin_bit_cast(bf16x8, w);
        }
#pragma unroll
        for (int m = 0; m < 2; ++m)
#pragma unroll
            for (int nt = 0; nt < 4; ++nt) acc[m][nt] = mfma16(a[m], bb[nt], acc[m][nt]);
    }
    float* KVT = (float*)(ws + WS_KVT) + ((size_t)(b * 8 + h) * 64 + n) * 8192;
#pragma unroll
    for (int m = 0; m < 2; ++m)
#pragma unroll
        for (int nt = 0; nt < 4; ++nt)
#pragma unroll
            for (int r = 0; r < 4; ++r) KVT[(32 * wid + 16 * m + 4 * fq + r) * 64 + 16 * nt + fr] = acc[m][nt][r];
    __syncthreads();
}

__device__ void phase_p2(const Params& p, int layer, unsigned char* lds) {
    for (int it = blockIdx.x; it < 1024 + 32; it += gridDim.x) {
        if (it < 32) compress_item(p, layer, it, lds); else retkv_item(p, it - 32, lds);
    }
}

constexpr int NSA_IMP = 32768, NSA_BUCKET = 65792, NSA_BIAS = 73984;

struct NsaLane { int t; int fr, fq, wid, lane; };

template <int BR, int PASS>
__device__ __forceinline__ void nsa_half(const unsigned char* kL, const unsigned char* vL, const unsigned char* lds, const bf16_t* qptr,
                                         f32x4 (&O)[4][4], float (&m)[4], float (&l)[4], int tile, int hf, bool selbit, const NsaLane& L, int qrow) {
    const int fr = L.fr, fq = L.fq;
    bf16x8 Kf[2][2];
#pragma unroll
    for (int i = 0; i < 2; ++i)
#pragma unroll
        for (int ks = 0; ks < 2; ++ks) Kf[i][ks] = lds_frag128(kL, 32 * hf + 16 * i + fr, 4 * ks + fq);
    unsigned vmask = 0; unsigned bk[2];
    const unsigned char* bucketL = lds + NSA_BUCKET;
#pragma unroll
    for (int i = 0; i < 2; ++i) {
        unsigned pk = 0;
#pragma unroll
        for (int r = 0; r < 4; ++r) {
            const int kk = 32 * hf + 16 * i + 4 * fq + r;
            int rel; bool ok;
            if (BR == 0) { rel = L.t - (16 * (64 * tile + kk) + 31); ok = rel >= 0; }
            else if (BR == 1) { rel = L.t - (64 * tile + kk); ok = selbit && rel >= 0; }
            else { rel = L.t - (64 * tile + kk); ok = rel >= 0 && rel < 512; }
            int rc = rel < 0 ? 0 : rel; rc = rc > 8191 ? 8191 : rc;
            pk |= (unsigned)bucketL[rc] << (8 * r);
            vmask |= (ok ? 1u : 0u) << (4 * i + r);
        }
        bk[i] = pk;
    }
    const float* biasL = (const float*)(lds + NSA_BIAS);
    float ia[2] = {0.f, 0.f}, ic[2] = {0.f, 0.f};
#pragma unroll
    for (int nt = 0; nt < 4; ++nt) {
        asm volatile("" ::: "memory");
        f32x4 S[2];
        const bf16x8 q0 = *(const bf16x8*)(qptr + nt * 64), q1 = *(const bf16x8*)(qptr + nt * 64 + 32);
#pragma unroll
        for (int i = 0; i < 2; ++i) {
            S[i] = (f32x4){0.f, 0.f, 0.f, 0.f};
            S[i] = mfma16(Kf[i][0], q0, S[i]); S[i] = mfma16(Kf[i][1], q1, S[i]);
        }
        float tmax = -1e30f;
#pragma unroll
        for (int i = 0; i < 2; ++i)
#pragma unroll
            for (int r = 0; r < 4; ++r) {
                const float bias = biasL[nt * 32 + ((bk[i] >> (8 * r)) & 0xffu)];
                const bool ok = (vmask >> (4 * i + r)) & 1u;
                const float sv = ok ? S[i][r] * 0.125f + bias : -1e30f;
                S[i][r] = sv; tmax = fmaxf(tmax, sv);
            }
        if (PASS != 1) {
            tmax = fmaxf(tmax, __shfl_xor(tmax, 16)); tmax = fmaxf(tmax, __shfl_xor(tmax, 32));
            const float mnew = fmaxf(m[nt], tmax), alpha = __expf(m[nt] - mnew);
            float psum = 0.f;
#pragma unroll
            for (int i = 0; i < 2; ++i)
#pragma unroll
                for (int r = 0; r < 4; ++r) {
                    const bool ok = (vmask >> (4 * i + r)) & 1u;
                    const float pv = ok ? __expf(S[i][r] - mnew) : 0.f;
                    S[i][r] = pv; psum += pv;
                }
            psum += __shfl_xor(psum, 16); psum += __shfl_xor(psum, 32);
            l[nt] = l[nt] * alpha + psum; m[nt] = mnew;
            if (PASS == 2) {
#pragma unroll
                for (int mt = 0; mt < 4; ++mt) O[mt][nt] = O[mt][nt] * alpha;
            }
        } else {
#pragma unroll
            for (int i = 0; i < 2; ++i) {
#pragma unroll
                for (int r = 0; r < 4; ++r) {
                    const bool ok = (vmask >> (4 * i + r)) & 1u;
                    S[i][r] = ok ? __expf(S[i][r] - m[nt]) * l[nt] : 0.f;
                }
                ia[i] += S[i][0] + S[i][1] + S[i][2] + 0.5f * S[i][3];
                ic[i] += 0.5f * S[i][3];
            }
        }
        if (PASS != 0) {
            const bf16x8 Pb = pack8(S[0], S[1]);
#pragma unroll
            for (int mt = 0; mt < 4; ++mt) O[mt][nt] = mfma16(lds_vfrag128(vL, 16 * mt + fr, 32 * hf, fq), Pb, O[mt][nt]);
        }
    }
    if (PASS == 1) {
        float* imp = (float*)(lds + NSA_IMP) + qrow * 129;
        asm volatile("" ::: "memory"); __builtin_amdgcn_wave_barrier();
#pragma unroll
        for (int i = 0; i < 2; ++i) { const int j = 16 * tile + 8 * hf + 4 * i + fq; imp[j] += ia[i]; }
        asm volatile("s_waitcnt lgkmcnt(0)" ::: "memory"); __builtin_amdgcn_wave_barrier();
#pragma unroll
        for (int i = 0; i < 2; ++i) { const int j = 16 * tile + 8 * hf + 4 * i + fq + 1; if (j < 128) imp[j] += ic[i]; }
        asm volatile("s_waitcnt lgkmcnt(0)" ::: "memory"); __builtin_amdgcn_wave_barrier();
    }
}
template <int BR, int PASS>
__device__ __forceinline__ void nsa_tile(const unsigned char* kL, const unsigned char* vL, const unsigned char* lds, const bf16_t* qptr,
                                         f32x4 (&O)[4][4], float (&m)[4], float (&l)[4], int tile, bool selbit, const NsaLane& L, int qrow) {
#pragma unroll 1
    for (int hf = 0; hf < 2; ++hf) nsa_half<BR, PASS>(kL, vL, lds, qptr, O, m, l, tile, hf, selbit, L, qrow);
}

__device__ void cmp_item(const Params& p, int item, unsigned char* lds) {
    unsigned char* ws = launder(p.ws);
    const int tid = threadIdx.x + vzero(), lane = tid & 63, wid = tid >> 6, fr = lane & 15, fq = lane >> 4;
    const int combo = item & 3, qt = 127 - (item >> 2), b = combo >> 1, g = combo & 1;
    const int q0 = qt * 64, qrow = 16 * wid + fr;
    NsaLane L; L.t = q0 + qrow; L.fr = fr; L.fq = fq; L.wid = wid; L.lane = lane;
    const size_t tok = (size_t)b * S_ + L.t;
    const bf16_t* P = (const bf16_t*)(ws + WS_P);
    __syncthreads();
    if (tid < 128) ((float*)(lds + NSA_BIAS))[tid] = p.rel_bias[(tid & 31) * 8 + 4 * g + (tid >> 5)];
    for (int i = tid; i < 64 * 129; i += NTHREADS) ((float*)(lds + NSA_IMP))[i] = 0.f;
    const bf16_t* Qf = P + tok * LD + C_QA + (4 * g) * 64 + 8 * fq;
    __syncthreads();
    f32x4 O[4][4]; float m[4], l[4];
    const bf16_t* gates = P + tok * LD + C_GA + (4 * g) * 3;
    const bf16_t* kc = (const bf16_t*)(ws + WS_KCC) + (size_t)(b * 2 + g) * 512 * 64;
    const bf16_t* vc = (const bf16_t*)(ws + WS_VCCT) + (size_t)(b * 2 + g) * 64 * 512;
    const int ntc = ((q0 + 32) >> 4) / 64 + 1;
#pragma unroll
    for (int nt = 0; nt < 4; ++nt) { m[nt] = -1e30f; l[nt] = 0.f; }
    load_tile64(kc, 64, lds, wid, lane);
    wait_vm0(); __syncthreads();
    for (int it = 0; it < ntc; ++it) {
        unsigned char* cur = lds + (it & 1) * 16384;
        if (it + 1 < ntc) load_tile64(kc + (size_t)(it + 1) * 64 * 64, 64, lds + ((it + 1) & 1) * 16384, wid, lane);
        nsa_tile<0, 0>(cur, cur + 8192, lds, Qf, O, m, l, it, true, L, qrow);
        wait_vm0(); __syncthreads();
    }
#pragma unroll
    for (int nt = 0; nt < 4; ++nt) l[nt] = l[nt] > 0.f ? 1.f / l[nt] : 0.f;
#pragma unroll
    for (int mt = 0; mt < 4; ++mt)
#pragma unroll
        for (int nt = 0; nt < 4; ++nt) O[mt][nt] = (f32x4){0.f, 0.f, 0.f, 0.f};
    load_tile64(kc, 64, lds, wid, lane); load_tile64(vc, 512, lds + 8192, wid, lane);
    wait_vm0(); __syncthreads();
    for (int it = 0; it < ntc; ++it) {
        unsigned char* cur = lds + (it & 1) * 16384;
        if (it + 1 < ntc) { unsigned char* nx = lds + ((it + 1) & 1) * 16384;
            load_tile64(kc + (size_t)(it + 1) * 64 * 64, 64, nx, wid, lane); load_tile64(vc + (it + 1) * 64, 512, nx + 8192, wid, lane); }
        nsa_tile<0, 1>(cur, cur + 8192, lds, Qf, O, m, l, it, true, L, qrow);
        wait_vm0(); __syncthreads();
    }
    bf16_t* YC = (bf16_t*)(ws + WS_YC) + tok * 512 + (4 * g) * 64;
#pragma unroll
    for (int nt = 0; nt < 4; ++nt) {
        const float gt = bf2f(gates[nt * 3 + 0]);
#pragma unroll
        for (int mt = 0; mt < 4; ++mt) *(u32x2*)(YC + nt * 64 + 16 * mt + 4 * fq) = pack4(O[mt][nt] * gt);
    }
    const int cur = qt;
    {
        float* imp = (float*)(lds + NSA_IMP) + qrow * 129 + 32 * fq;
        asm volatile("s_waitcnt lgkmcnt(0)" ::: "memory"); __builtin_amdgcn_wave_barrier();
#pragma unroll
        for (int i = 0; i < 32; ++i) {
            const int j = 32 * fq + i;
            const float v = imp[i];
            imp[i] = j > cur ? -1.f : v + ((j == 0 || j == cur || j == cur - 1) ? 1.0e4f : 0.f);
        }
        unsigned word = 0;
#pragma unroll 1
        for (int round = 0; round < 16; ++round) {
            float bv = imp[0]; int bi = 0;
#pragma unroll
            for (int i = 1; i < 32; ++i) { const float v = imp[i]; if (v > bv) { bv = v; bi = i; } }
            int gi = 32 * fq + bi;
#pragma unroll
            for (int off = 16; off <= 32; off <<= 1) {
                const float ov = __shfl_xor(bv, off); const int oi = __shfl_xor(gi, off);
                if (ov > bv || (ov == bv && oi < gi)) { bv = ov; gi = oi; }
            }
            if (bv >= 0.f && (gi >> 5) == fq) { word |= 1u << (gi & 31); imp[gi & 31] = -2.f; }
        }
        ((unsigned*)(ws + WS_SELW))[(tok * 2 + g) * 4 + fq] = word;
    }
}

__device__ void win_item(const Params& p, int item, unsigned char* lds) {
    unsigned char* ws = launder(p.ws);
    const int tid = threadIdx.x + vzero(), lane = tid & 63, wid = tid >> 6, fr = lane & 15, fq = lane >> 4;
    const int combo = item & 3, qt = 127 - (item >> 2), b = combo >> 1, g = combo & 1;
    const int q0 = qt * 64, qrow = 16 * wid + fr;
    NsaLane L; L.t = q0 + qrow; L.fr = fr; L.fq = fq; L.wid = wid; L.lane = lane;
    const size_t tok = (size_t)b * S_ + L.t;
    const bf16_t* P = (const bf16_t*)(ws + WS_P);
    __syncthreads();
    if (tid < 128) ((float*)(lds + NSA_BIAS))[tid] = p.rel_bias[(tid & 31) * 8 + 4 * g + (tid >> 5)];
    const bf16_t* Qf = P + tok * LD + C_QA + (4 * g) * 64 + 8 * fq;
    __syncthreads();
    f32x4 O[4][4]; float m[4], l[4];
    const bf16_t* gates = P + tok * LD + C_GA + (4 * g) * 3;
#pragma unroll
    for (int nt = 0; nt < 4; ++nt) { m[nt] = -1e30f; l[nt] = 0.f; }
#pragma unroll
    for (int mt = 0; mt < 4; ++mt)
#pragma unroll
        for (int nt = 0; nt < 4; ++nt) O[mt][nt] = (f32x4){0.f, 0.f, 0.f, 0.f};
    {
        const bf16_t* kb = P + ((size_t)b * S_) * LD + C_KW + g * 64;
        const bf16_t* vb = (const bf16_t*)(ws + WS_VWT) + (size_t)(b * 2 + g) * 64 * S_;
        const int k_lo = qt - 8 > 0 ? qt - 8 : 0, ntw = qt - k_lo + 1;
        load_tile64(kb + (size_t)k_lo * 64 * LD, LD, lds, wid, lane); load_tile64(vb + k_lo * 64, S_, lds + 8192, wid, lane);
        wait_vm0(); __syncthreads();
        for (int it = 0; it < ntw; ++it) {
            unsigned char* cu = lds + (it & 1) * 16384;
            if (it + 1 < ntw) { unsigned char* nx = lds + ((it + 1) & 1) * 16384;
                load_tile64(kb + (size_t)(k_lo + it + 1) * 64 * LD, LD, nx, wid, lane); load_tile64(vb + (k_lo + it + 1) * 64, S_, nx + 8192, wid, lane); }
            nsa_tile<2, 2>(cu, cu + 8192, lds, Qf, O, m, l, k_lo + it, true, L, qrow);
            wait_vm0(); __syncthreads();
        }
    }
    bf16_t* YW = (bf16_t*)(ws + WS_YW) + tok * 512 + (4 * g) * 64;
#pragma unroll
    for (int nt = 0; nt < 4; ++nt) {
        const float gt = bf2f(gates[nt * 3 + 2]) * (l[nt] > 0.f ? 1.f / l[nt] : 0.f);
#pragma unroll
        for (int mt = 0; mt < 4; ++mt) *(u32x2*)(YW + nt * 64 + 16 * mt + 4 * fq) = pack4(O[mt][nt] * gt);
    }
}

constexpr int SEL_BIAS2 = 40960;
constexpr float LOG2E = 1.4426950408889634f;
__device__ __forceinline__ int t5_first(int bk) {
    const int th[16] = {16, 22, 30, 40, 54, 73, 99, 134, 182, 246, 332, 450, 609, 825, 1117, 1513};
    int r = 16;
#pragma unroll
    for (int k = 0; k < 16; ++k) r = (bk == 16 + k) ? th[k] : r;
    return r;
}
template <bool FAST, int HF>
__device__ __forceinline__ void sel_ntile(const bf16x8 (&Kf)[2][2], const bf16x8 (&Vf)[4], const bf16x8& q0, const bf16x8& q1, f32x4 (&O)[4], float& m, float& l,
                                          bool sb, int relb, int th, float blo, float bhi, const unsigned char* lds, int hl) {
    f32x4 S[2];
#pragma unroll
    for (int i = 0; i < 2; ++i) { S[i] = (f32x4){0.f, 0.f, 0.f, 0.f}; S[i] = mfma16(Kf[i][0], q0, S[i]); S[i] = mfma16(Kf[i][1], q1, S[i]); }
    float tmax = -1e30f;
    unsigned vm = 0;
#pragma unroll
    for (int i = 0; i < 2; ++i)
#pragma unroll
        for (int r = 0; r < 4; ++r) {
            const int rel = relb - (32 * HF + 16 * i + r);
            float bias; bool ok;
            if (FAST) { bias = rel >= th ? bhi : blo; ok = sb; }
            else {
                int rc = rel < 0 ? 0 : rel; rc = rc > 8191 ? 8191 : rc;
                bias = ((const float*)(lds + SEL_BIAS2))[hl * 32 + (lds + NSA_BUCKET)[rc]]; ok = sb && rel >= 0;
            }
            const float sv = ok ? S[i][r] * (0.125f * LOG2E) + bias : -1e30f;
            vm |= (ok ? 1u : 0u) << (4 * i + r);
            S[i][r] = sv; tmax = fmaxf(tmax, sv);
        }
    tmax = fmaxf(tmax, __shfl_xor(tmax, 16)); tmax = fmaxf(tmax, __shfl_xor(tmax, 32));
    const float mnew = fmaxf(m, tmax), alpha = __builtin_amdgcn_exp2f(m - mnew);
    float psum = 0.f;
#pragma unroll
    for (int i = 0; i < 2; ++i)
#pragma unroll
        for (int r = 0; r < 4; ++r) { const float pv = ((vm >> (4 * i + r)) & 1u) ? __builtin_amdgcn_exp2f(S[i][r] - mnew) : 0.f; S[i][r] = pv; psum += pv; }
    psum += __shfl_xor(psum, 16); psum += __shfl_xor(psum, 32);
    l = l * alpha + psum; m = mnew;
    const bf16x8 Pb = pack8(S[0], S[1]);
#pragma unroll
    for (int mt = 0; mt < 4; ++mt) { O[mt] = O[mt] * alpha; O[mt] = mfma16(Vf[mt], Pb, O[mt]); }
}
template <bool FAST, int HF>
__device__ __forceinline__ void sel_half(const unsigned char* kL, const unsigned char* vL, const unsigned char* lds, const bf16x8 (&Qf)[2][2], f32x4 (&O)[2][4], float (&m)[2], float (&l)[2],
                                         const bool (&sb)[2], const bool (&need)[2], const int (&relb)[2], int th, float blo, float bhi, int hl, int fr, int fq) {
    bf16x8 Kf[2][2], Vf[4];
#pragma unroll
    for (int i = 0; i < 2; ++i)
#pragma unroll
        for (int ks = 0; ks < 2; ++ks) Kf[i][ks] = lds_frag128(kL, 32 * HF + 16 * i + fr, 4 * ks + fq);
#pragma unroll
    for (int mt = 0; mt < 4; ++mt) Vf[mt] = lds_vfrag128(vL, 16 * mt + fr, 32 * HF, fq);
    if (need[0]) sel_ntile<FAST, HF>(Kf, Vf, Qf[0][0], Qf[0][1], O[0], m[0], l[0], sb[0], relb[0], th, blo, bhi, lds, hl);
    if (need[1]) sel_ntile<FAST, HF>(Kf, Vf, Qf[1][0], Qf[1][1], O[1], m[1], l[1], sb[1], relb[1], th, blo, bhi, lds, hl);
}
__device__ void sel_item(const Params& p, int v, unsigned char* lds) {
    unsigned char* ws = launder(p.ws);
    const int tid = threadIdx.x + vzero(), lane = tid & 63, wid = tid >> 6, fr = lane & 15, fq = lane >> 4;
    const int qt = 127 - (v >> 3), sub = v & 7, b = sub >> 2, g = (sub >> 1) & 1, half = sub & 1;
    const int q0 = qt * 64 + 32 * half, cur = qt, hl = fr & 3;
    const bf16_t* P = (const bf16_t*)(ws + WS_P);
    __syncthreads();
    if (tid < 128) ((float*)(lds + SEL_BIAS2))[tid] = p.rel_bias[(tid & 31) * 8 + 4 * g + (tid >> 5)] * LOG2E;
    int t[2]; size_t tok[2]; bf16x8 Qf[2][2]; unsigned selw[2][4];
#pragma unroll
    for (int nt = 0; nt < 2; ++nt) {
        t[nt] = q0 + 8 * wid + 4 * nt + (fr >> 2); tok[nt] = (size_t)b * S_ + t[nt];
#pragma unroll
        for (int ks = 0; ks < 2; ++ks) Qf[nt][ks] = *(const bf16x8*)(P + tok[nt] * LD + C_QA + (4 * g + hl) * 64 + 32 * ks + 8 * fq);
        const u32x4 w = *(const u32x4*)((const unsigned*)(ws + WS_SELW) + (tok[nt] * 2 + g) * 4);
        selw[nt][0] = w.x; selw[nt][1] = w.y; selw[nt][2] = w.z; selw[nt][3] = w.w;
    }
    f32x4 O[2][4]; float m[2], l[2];
#pragma unroll
    for (int nt = 0; nt < 2; ++nt) { m[nt] = -1e30f; l[nt] = 0.f;
#pragma unroll
        for (int mt = 0; mt < 4; ++mt) O[nt][mt] = (f32x4){0.f, 0.f, 0.f, 0.f}; }
    const bf16_t* kb = P + ((size_t)b * S_) * LD + C_KS + g * 64;
    const bf16_t* vb = (const bf16_t*)(ws + WS_VST) + (size_t)(b * 2 + g) * 64 * S_;
    const int nts = cur + 1;
    load_tile64(kb, LD, lds, wid, lane); load_tile64(vb, S_, lds + 8192, wid, lane);
    wait_vm0(); __syncthreads();
    const unsigned char* bucketL = lds + NSA_BUCKET;
    for (int j = 0; j < nts; ++j) {
        const unsigned char* cu = lds + (j & 1) * 16384;
        if (j + 1 < nts) { unsigned char* nx = lds + ((j + 1) & 1) * 16384;
            load_tile64(kb + (size_t)(j + 1) * 64 * LD, LD, nx, wid, lane); load_tile64(vb + (j + 1) * 64, S_, nx + 8192, wid, lane); }
        bool sb[2], need[2]; int relb[2];
#pragma unroll
        for (int nt = 0; nt < 2; ++nt) {
            const unsigned w = j < 32 ? selw[nt][0] : j < 64 ? selw[nt][1] : j < 96 ? selw[nt][2] : selw[nt][3];
            sb[nt] = (w >> (j & 31)) & 1u; need[nt] = __ballot(sb[nt]) != 0ull; relb[nt] = t[nt] - 64 * j - 4 * fq;
        }
        if (need[0] || need[1]) {
            const int rmin = q0 - 64 * j - 63, rmax = q0 + 31 - 64 * j;
            bool fast = false; int th = 0; float blo = 0.f, bhi = 0.f;
            if (rmin >= 16) {
                const int b0 = bucketL[rmin], b1 = bucketL[rmax > 8191 ? 8191 : rmax];
                if (b1 - b0 <= 1) { fast = true; th = t5_first(b1); if (b1 == b0) th = 0;
                    blo = ((const float*)(lds + SEL_BIAS2))[hl * 32 + b0]; bhi = ((const float*)(lds + SEL_BIAS2))[hl * 32 + b1]; }
            }
            if (fast) {
                sel_half<true, 0>(cu, cu + 8192, lds, Qf, O, m, l, sb, need, relb, th, blo, bhi, hl, fr, fq);
                sel_half<true, 1>(cu, cu + 8192, lds, Qf, O, m, l, sb, need, relb, th, blo, bhi, hl, fr, fq);
            } else {
                sel_half<false, 0>(cu, cu + 8192, lds, Qf, O, m, l, sb, need, relb, th, blo, bhi, hl, fr, fq);
                sel_half<false, 1>(cu, cu + 8192, lds, Qf, O, m, l, sb, need, relb, th, blo, bhi, hl, fr, fq);
            }
        }
        wait_vm0(); __syncthreads();
    }
#pragma unroll
    for (int nt = 0; nt < 2; ++nt) {
        const float gt = bf2f(P[tok[nt] * LD + C_GA + (4 * g + hl) * 3 + 1]) * (l[nt] > 0.f ? 1.f / l[nt] : 0.f);
        const size_t o = tok[nt] * 512 + (4 * g + hl) * 64;
#pragma unroll
        for (int mt = 0; mt < 4; ++mt) {
            const f32x4 yc = unpack4(*(const u32x2*)((const bf16_t*)(ws + WS_YC) + o + 16 * mt + 4 * fq));
            const f32x4 yw = unpack4(*(const u32x2*)((const bf16_t*)(ws + WS_YW) + o + 16 * mt + 4 * fq));
            *(u32x2*)((bf16_t*)(ws + WS_YA) + o + 16 * mt + 4 * fq) = pack4(yc + yw + O[nt][mt] * gt);
        }
    }
}

__device__ void scan_item(const Params& p, int item) {
    unsigned char* ws = launder(p.ws);
    const int idx = item * NTHREADS + threadIdx.x;
    const int bh = idx >> 13, ed = idx & 8191, h = bh & 7;
    const float dec = exp2f(128.f * ret_lg2(h));
    const float* KVT = (const float*)(ws + WS_KVT) + (size_t)bh * 64 * 8192 + ed;
    bf16_t* SPT = (bf16_t*)(ws + WS_SPT) + (size_t)bh * 64 * 8192 + ed;
    float s = 0.f;
    for (int n = 0; n < 64; ++n) { SPT[(size_t)n * 8192] = f2bf(s); s = s * dec + KVT[(size_t)n * 8192]; }
}

__device__ void phase_p3(const Params& p, unsigned char* lds) {
    for (int i = threadIdx.x; i < 8192 / 16; i += NTHREADS) ((u32x4*)(lds + NSA_BUCKET))[i] = ((const u32x4*)(p.ws + WS_BUCKET))[i];
    __syncthreads();
    for (int it = blockIdx.x; it < 1536; it += gridDim.x) {
        if (it < 512) cmp_item(p, it, lds); else if (it < 1024) win_item(p, it - 512, lds); else scan_item(p, it - 1024);
    }
}

__device__ void retout_item(const Params& p, int item, unsigned char* lds) {
    unsigned char* ws = launder(p.ws);
    const int tid = threadIdx.x + vzero(), lane = tid & 63, wid = tid >> 6, fr = lane & 15, fq = lane >> 4;
    const int n = item & 63, h = (item >> 6) & 7, b = item >> 9;
    const size_t tok0 = (size_t)b * S_ + 128 * n;
    const bf16_t* P = (const bf16_t*)(ws + WS_P);
    unsigned char* vL = lds; unsigned char* kL = lds + 32768; unsigned char* sL = lds + 49152;
    __syncthreads();
    load_tile128w((const bf16_t*)(ws + WS_VRT) + ((size_t)(b * 8 + h) * 128) * S_ + 128 * n, S_, vL, wid, lane);
    load_tile128(P + tok0 * LD + C_KR + h * 64, LD, kL, wid, lane);
    load_tile128((const bf16_t*)(ws + WS_SPT) + ((size_t)(b * 8 + h) * 64 + n) * 8192, 64, sL, wid, lane);
    bf16x8 Qf[2][2];
#pragma unroll
    for (int nt = 0; nt < 2; ++nt)
#pragma unroll
        for (int ks = 0; ks < 2; ++ks) Qf[nt][ks] = *(const bf16x8*)(P + (tok0 + 32 * wid + 16 * nt + fr) * LD + C_QR + h * 64 + 32 * ks + 8 * fq);
    wait_vm0(); __syncthreads();
    const float lg2 = ret_lg2(h);
    f32x4 Y[8][2];
#pragma unroll
    for (int m = 0; m < 8; ++m)
#pragma unroll
        for (int nt = 0; nt < 2; ++nt) Y[m][nt] = (f32x4){0.f, 0.f, 0.f, 0.f};
#pragma unroll
    for (int m = 0; m < 8; ++m)
#pragma unroll
        for (int ks = 0; ks < 2; ++ks) {
            const bf16x8 a = lds_frag128(sL, 16 * m + fr, 4 * ks + fq);
#pragma unroll
            for (int nt = 0; nt < 2; ++nt) Y[m][nt] = mfma16(a, Qf[nt][ks], Y[m][nt]);
        }
#pragma unroll
    for (int nt = 0; nt < 2; ++nt) {
        const float sc = exp2f((float)(32 * wid + 16 * nt + fr + 1) * lg2);
#pragma unroll
        for (int m = 0; m < 8; ++m) Y[m][nt] = Y[m][nt] * sc;
    }
#pragma unroll 1
    for (int s = 0; s < 4; ++s) {
        f32x4 St[2][2];
#pragma unroll
        for (int hh = 0; hh < 2; ++hh) {
            const int mt = 2 * s + hh;
#pragma unroll
            for (int nt = 0; nt < 2; ++nt) St[hh][nt] = (f32x4){0.f, 0.f, 0.f, 0.f};
#pragma unroll
            for (int ks = 0; ks < 2; ++ks) {
                const bf16x8 a = lds_frag128(kL, 16 * mt + fr, 4 * ks + fq);
#pragma unroll
                for (int nt = 0; nt < 2; ++nt) St[hh][nt] = mfma16(a, Qf[nt][ks], St[hh][nt]);
            }
#pragma unroll
            for (int nt = 0; nt < 2; ++nt) {
                const int qi = 32 * wid + 16 * nt + fr;
#pragma unroll
                for (int r = 0; r < 4; ++r) {
                    const int kj = 16 * mt + 4 * fq + r;
                    const float dm = qi >= kj ? exp2f((float)(qi - kj) * lg2) : 0.f;
                    St[hh][nt][r] *= dm;
                }
            }
        }
        bf16x8 Pb[2];
#pragma unroll
        for (int nt = 0; nt < 2; ++nt) Pb[nt] = pack8(St[0][nt], St[1][nt]);
#pragma unroll
        for (int m = 0; m < 8; ++m) {
            const bf16x8 a = lds_vfrag256(vL, 16 * m + fr, 32 * s, fq);
#pragma unroll
            for (int nt = 0; nt < 2; ++nt) Y[m][nt] = mfma16(a, Pb[nt], Y[m][nt]);
        }
    }
    bf16_t* YB = (bf16_t*)(ws + WS_YB);
#pragma unroll
    for (int nt = 0; nt < 2; ++nt) {
        float sum = 0.f;
#pragma unroll
        for (int m = 0; m < 8; ++m) sum += Y[m][nt][0] + Y[m][nt][1] + Y[m][nt][2] + Y[m][nt][3];
        sum += __shfl_xor(sum, 16); sum += __shfl_xor(sum, 32);
        const float mu = sum * (1.f / 128.f);
        float vs = 0.f;
#pragma unroll
        for (int m = 0; m < 8; ++m)
#pragma unroll
            for (int r = 0; r < 4; ++r) { const float dlt = Y[m][nt][r] - mu; vs += dlt * dlt; }
        vs += __shfl_xor(vs, 16); vs += __shfl_xor(vs, 32);
        const float rstd = rsqrtf(vs * (1.f / 128.f) + 1e-5f);
        const size_t tk = tok0 + 32 * wid + 16 * nt + fr;
#pragma unroll
        for (int m = 0; m < 8; ++m) {
            const f32x4 gt = unpack4(*(const u32x2*)(P + tk * LD + C_GR + h * 128 + 16 * m + 4 * fq));
            f32x4 v;
#pragma unroll
            for (int r = 0; r < 4; ++r) v[r] = (Y[m][nt][r] - mu) * rstd * gt[r];
            *(u32x2*)(YB + tk * 1024 + h * 128 + 16 * m + 4 * fq) = pack4(v);
        }
    }
}
__device__ void phase_p4(const Params& p, unsigned char* lds) {
    for (int i = threadIdx.x; i < 8192 / 16; i += NTHREADS) ((u32x4*)(lds + NSA_BUCKET))[i] = ((const u32x4*)(p.ws + WS_BUCKET))[i];
    __syncthreads();
    for (int it = blockIdx.x; it < 2048; it += gridDim.x) {
        if (it < 1024) sel_item(p, it < 512 ? it : 1535 - it, lds); else retout_item(p, it - 1024, lds);
    }
}

__device__ void phase_g2(const Params& p, unsigned char* lds) {
    unsigned char* ws = launder(p.ws);
    const bf16_t* P = (const bf16_t*)(ws + WS_P);
    for (int t = blockIdx.x; t < 128 * 8; t += gridDim.x) {
        const int mt = t >> 3, nt = t & 7, m0 = mt * 128, n0 = nt * 128;
        const int tid = threadIdx.x + vzero(), lane = tid & 63, wid = tid >> 6, wr = wid >> 1, wc = wid & 1, fr = lane & 15, fq = lane >> 4;
        const int ldrow = 8 * wid + (lane >> 3), ldc = ((lane & 7) ^ (lane >> 3)) * 8;
        const bf16_t* mp[4]; const bf16_t* np[4];
        bf16_t* MG = (bf16_t*)(ws + WS_MG);
        { f32x4 acc1[4][4]; zero_acc(acc1);
#pragma unroll
        for (int i = 0; i < 4; ++i) { mp[i] = (const bf16_t*)(ws + WS_WA) + (size_t)(n0 + 32 * i + ldrow) * 512 + ldc; np[i] = (const bf16_t*)(ws + WS_YA) + (size_t)(m0 + 32 * i + ldrow) * 512 + ldc; }
        gemm_kloop(mp, np, 8, lds, acc1);
#pragma unroll
        for (int mi = 0; mi < 4; ++mi)
#pragma unroll
            for (int ni = 0; ni < 4; ++ni) {
                const int n = n0 + 64 * wr + 16 * mi + 4 * fq; const size_t tok = m0 + 64 * wc + 16 * ni + fr;
                const f32x4 ga = unpack4(*(const u32x2*)(P + tok * LD + C_MA + n));
                *(u32x2*)(MG + tok * 1024 + n) = pack4(ga * acc1[mi][ni]);
            } }
        { f32x4 acc2[4][4]; zero_acc(acc2);
#pragma unroll
        for (int i = 0; i < 4; ++i) { mp[i] = (const bf16_t*)(ws + WS_WB) + (size_t)(n0 + 32 * i + ldrow) * 1024 + ldc; np[i] = (const bf16_t*)(ws + WS_YB) + (size_t)(m0 + 32 * i + ldrow) * 1024 + ldc; }
        gemm_kloop(mp, np, 16, lds, acc2);
#pragma unroll
        for (int mi = 0; mi < 4; ++mi)
#pragma unroll
            for (int ni = 0; ni < 4; ++ni) {
                const int n = n0 + 64 * wr + 16 * mi + 4 * fq; const size_t tok = m0 + 64 * wc + 16 * ni + fr;
                const f32x4 gb = unpack4(*(const u32x2*)(P + tok * LD + C_MB + n));
                const f32x4 v = unpack4(*(const u32x2*)(MG + tok * 1024 + n)) + gb * acc2[mi][ni];
                *(u32x2*)(MG + tok * 1024 + n) = pack4(v);
            } }
    }
}

__device__ void phase_g3(const Params& p, int layer, unsigned char* lds) {
    unsigned char* ws = launder(p.ws);
    const int tid = threadIdx.x + vzero(), lane = tid & 63, wid = tid >> 6, wr = wid >> 1, wc = wid & 1, fr = lane & 15, fq = lane >> 4;
    const int ldrow = 8 * wid + (lane >> 3), ldc = ((lane & 7) ^ (lane >> 3)) * 8;
    const float* X = layer == 0 ? p.x : (const float*)(ws + WS_X);
    float* H1 = (float*)(ws + WS_H1);
    for (int t = blockIdx.x; t < 128 * 8; t += gridDim.x) {
        const int mt = t >> 3, nt = t & 7, m0 = mt * 128, n0 = nt * 128;
        const bf16_t* mp[4]; const bf16_t* np[4];
        f32x4 acc[4][4]; zero_acc(acc);
#pragma unroll
        for (int i = 0; i < 4; ++i) { mp[i] = (const bf16_t*)(ws + WS_WO) + (size_t)(n0 + 32 * i + ldrow) * 1024 + ldc; np[i] = (const bf16_t*)(ws + WS_MG) + (size_t)(m0 + 32 * i + ldrow) * 1024 + ldc; }
        gemm_kloop(mp, np, 16, lds, acc);
#pragma unroll
        for (int mi = 0; mi < 4; ++mi)
#pragma unroll
            for (int ni = 0; ni < 4; ++ni) {
                const int n = n0 + 64 * wr + 16 * mi + 4 * fq; const size_t tok = m0 + 64 * wc + 16 * ni + fr;
                const f32x4 xv = *(const f32x4*)(X + tok * 1024 + n);
                *(f32x4*)(H1 + tok * 1024 + n) = xv * DN_ALPHA + acc[mi][ni];
            }
    }
}

__device__ void phase_ln1(const Params& p, int layer, unsigned char* lds) {
    unsigned char* ws = launder(p.ws);
    const int tid = threadIdx.x + vzero(), lane = tid & 63, wid = tid >> 6;
    float* wrL = (float*)lds;
    for (int i = tid; i < 1024 * 16; i += NTHREADS) wrL[(i & 15) * 1024 + (i >> 4)] = p.w_router[i];
    __syncthreads();
    const float* H1 = (const float*)(ws + WS_H1);
    float* X1 = (float*)(ws + WS_X1); bf16_t* X1B = (bf16_t*)(ws + WS_X1B);
    const float* gam = p.ln1_g + layer * 1024; const float* bet = p.ln1_b + layer * 1024;
    unsigned* cnt = (unsigned*)(ws + WS_CTL) + CW_CNT + layer * 16;
    int* LIST = (int*)(ws + WS_LIST); float* WTS = (float*)(ws + WS_WTS);
    for (int tok = blockIdx.x * 4 + wid; tok < T_; tok += gridDim.x * 4) {
        float4 v[4];
#pragma unroll
        for (int j = 0; j < 4; ++j) v[j] = *(const float4*)(H1 + (size_t)tok * 1024 + 256 * j + 4 * lane);
        float s = 0.f;
#pragma unroll
        for (int j = 0; j < 4; ++j) s += v[j].x + v[j].y + v[j].z + v[j].w;
#pragma unroll
        for (int o = 1; o < 64; o <<= 1) s += __shfl_xor(s, o);
        const float mu = s * (1.f / 1024.f);
        float q = 0.f;
#pragma unroll
        for (int j = 0; j < 4; ++j) { const float a = v[j].x - mu, b2 = v[j].y - mu, c = v[j].z - mu, d = v[j].w - mu; q += a * a + b2 * b2 + c * c + d * d; }
#pragma unroll
        for (int o = 1; o < 64; o <<= 1) q += __shfl_xor(q, o);
        const float rstd = rsqrtf(q * (1.f / 1024.f) + 1e-5f);
        float4 y[4];
#pragma unroll
        for (int j = 0; j < 4; ++j) {
            const int d0 = 256 * j + 4 * lane;
            const float4 gg = *(const float4*)(gam + d0), bb = *(const float4*)(bet + d0);
            y[j].x = (v[j].x - mu) * rstd * gg.x + bb.x; y[j].y = (v[j].y - mu) * rstd * gg.y + bb.y; y[j].z = (v[j].z - mu) * rstd * gg.z + bb.z; y[j].w = (v[j].w - mu) * rstd * gg.w + bb.w;
            *(float4*)(X1 + (size_t)tok * 1024 + d0) = y[j];
            u32x2 w; w.x = pack2(y[j].x, y[j].y); w.y = pack2(y[j].z, y[j].w);
            *(u32x2*)(X1B + (size_t)tok * 1024 + d0) = w;
        }
        float lg[16];
#pragma unroll
        for (int e = 0; e < 16; ++e) {
            float a = 0.f;
#pragma unroll
            for (int j = 0; j < 4; ++j) { const float4 w4 = *(const float4*)(wrL + e * 1024 + 256 * j + 4 * lane); a += y[j].x * w4.x + y[j].y * w4.y + y[j].z * w4.z + y[j].w * w4.w; }
            lg[e] = a;
        }
#pragma unroll
        for (int e = 0; e < 16; ++e) {
#pragma unroll
            for (int o = 1; o < 64; o <<= 1) lg[e] += __shfl_xor(lg[e], o);
        }
        float mx = lg[0];
#pragma unroll
        for (int e = 1; e < 16; ++e) mx = fmaxf(mx, lg[e]);
        float pr[16], ps = 0.f;
#pragma unroll
        for (int e = 0; e < 16; ++e) { pr[e] = expf(lg[e] - mx); ps += pr[e]; }
        const float ips = 1.f / ps;
        float sel[16];
#pragma unroll
        for (int e = 0; e < 16; ++e) { pr[e] *= ips; sel[e] = pr[e] + p.router_bias[e]; }
        int best = 0; float bestv = -1e30f;
#pragma unroll
        for (int gI = 0; gI < 4; ++gI) {
            float a = -1e30f, b2 = -1e30f;
#pragma unroll
            for (int k = 0; k < 4; ++k) { const float x = sel[4 * gI + k]; if (x > a) { b2 = a; a = x; } else if (x > b2) b2 = x; }
            const float gs = a + b2;
            if (gs > bestv) { bestv = gs; best = gI; }
        }
        float s4[4], p4[4];
#pragma unroll
        for (int k = 0; k < 4; ++k) { s4[k] = 0.f; p4[k] = 0.f; }
#pragma unroll
        for (int gI = 0; gI < 4; ++gI) if (gI == best) {
#pragma unroll
            for (int k = 0; k < 4; ++k) { s4[k] = sel[4 * gI + k]; p4[k] = pr[4 * gI + k]; }
        }
        int i0 = 0; float a0 = s4[0];
#pragma unroll
        for (int k = 1; k < 4; ++k) if (s4[k] > a0) { a0 = s4[k]; i0 = k; }
        int i1 = -1; float a1 = -1e30f;
#pragma unroll
        for (int k = 0; k < 4; ++k) if (k != i0 && s4[k] > a1) { a1 = s4[k]; i1 = k; }
        float w0 = 0.f, w1 = 0.f;
#pragma unroll
        for (int k = 0; k < 4; ++k) { if (k == i0) w0 = p4[k]; if (k == i1) w1 = p4[k]; }
        const float iw = 1.f / (w0 + w1);
        if (lane == 0) {
            const int e0 = best * 4 + i0, e1 = best * 4 + i1;
            const unsigned p0 = atomicAdd(&cnt[e0], 1u); LIST[(size_t)e0 * T_ + p0] = tok * 2;
            const unsigned p1 = atomicAdd(&cnt[e1], 1u); LIST[(size_t)e1 * T_ + p1] = tok * 2 + 1;
            WTS[tok * 2] = w0 * iw; WTS[tok * 2 + 1] = w1 * iw;
        }
    }
}

__device__ __forceinline__ bool moe_find(const unsigned* cnt, int t, int colTiles, int& e, int& rt, int& ct, int& cnte, int& off) {
    int base = 0; off = 0;
    for (int k = 0; k < NE; ++k) {
        const int c = __builtin_amdgcn_readfirstlane((int)cnt[k]), nt = ((c + 127) >> 7) * colTiles;
        if (t < base + nt) { e = k; cnte = c; const int u = t - base; rt = u / colTiles; ct = u % colTiles;
            e = __builtin_amdgcn_readfirstlane(e); cnte = __builtin_amdgcn_readfirstlane(cnte); rt = __builtin_amdgcn_readfirstlane(rt);
            ct = __builtin_amdgcn_readfirstlane(ct); off = __builtin_amdgcn_readfirstlane(off); return true; }
        base += nt; off += c;
    }
    return false;
}
__device__ void phase_m2(const Params& p, int layer, unsigned char* lds) {
    unsigned char* ws = launder(p.ws);
    const int tid = threadIdx.x + vzero(), lane = tid & 63, wid = tid >> 6, wr = wid >> 1, wc = wid & 1, fr = lane & 15, fq = lane >> 4;
    const int ldrow = 8 * wid + (lane >> 3), ldc = ((lane & 7) ^ (lane >> 3)) * 8;
    const unsigned* cnt = (const unsigned*)(ws + WS_CTL) + CW_CNT + layer * 16 + vzero();
    const int* LIST = (const int*)(ws + WS_LIST);
    const bf16_t* X1B = (const bf16_t*)(ws + WS_X1B);
    bf16_t* HB = (bf16_t*)(ws + WS_HB);
    for (int t = blockIdx.x;; t += gridDim.x) {
        int e, rt, ct, cnte, off;
        if (!moe_find(cnt, t, 8, e, rt, ct, cnte, off)) break;
        const bf16_t* mp[4]; const bf16_t* np[4];
#pragma unroll
        for (int i = 0; i < 4; ++i) {
            const int rho = 32 * i + ldrow, blk = rho >> 4, nn = ct * 64 + (blk >> 1) * 16 + (rho & 15);
            mp[i] = (const bf16_t*)(ws + ((blk & 1) ? WS_WU : WS_WG)) + ((size_t)e * 512 + nn) * 1024 + ldc;
            int idx = rt * 128 + rho; idx = idx < cnte ? idx : cnte - 1;
            const int a = LIST[(size_t)e * T_ + idx];
            np[i] = X1B + (size_t)(a >> 1) * 1024 + ldc;
        }
        f32x4 acc[4][4]; zero_acc(acc);
        gemm_kloop(mp, np, 16, lds, acc);
#pragma unroll
        for (int mp2 = 0; mp2 < 2; ++mp2)
#pragma unroll
            for (int ni = 0; ni < 4; ++ni) {
                const int idx = rt * 128 + 64 * wc + 16 * ni + fr;
                if (idx < cnte) {
                    const int n = ct * 64 + (2 * wr + mp2) * 16 + 4 * fq;
                    const f32x4 gv = acc[2 * mp2][ni], uv = acc[2 * mp2 + 1][ni];
                    f32x4 hv;
#pragma unroll
                    for (int r = 0; r < 4; ++r) hv[r] = gv[r] * sigmoidf_(gv[r]) * uv[r];
                    *(u32x2*)(HB + (size_t)(off + idx) * 512 + n) = pack4(hv);
                }
            }
    }
}
__device__ void phase_m3(const Params& p, int layer, unsigned char* lds) {
    unsigned char* ws = launder(p.ws);
    const int tid = threadIdx.x + vzero(), lane = tid & 63, wid = tid >> 6, wr = wid >> 1, wc = wid & 1, fr = lane & 15, fq = lane >> 4;
    const int ldrow = 8 * wid + (lane >> 3), ldc = ((lane & 7) ^ (lane >> 3)) * 8;
    const unsigned* cnt = (const unsigned*)(ws + WS_CTL) + CW_CNT + layer * 16 + vzero();
    const int* LIST = (const int*)(ws + WS_LIST);
    const bf16_t* HB = (const bf16_t*)(ws + WS_HB);
    bf16_t* CT = (bf16_t*)(ws + WS_CT);
    for (int t = blockIdx.x;; t += gridDim.x) {
        int e, rt, ct, cnte, off;
        if (!moe_find(cnt, t, 8, e, rt, ct, cnte, off)) break;
        const bf16_t* mp[4]; const bf16_t* np[4];
#pragma unroll
        for (int i = 0; i < 4; ++i) {
            const int rho = 32 * i + ldrow;
            mp[i] = (const bf16_t*)(ws + WS_WD) + ((size_t)e * 1024 + ct * 128 + rho) * 512 + ldc;
            int idx = rt * 128 + rho; idx = idx < cnte ? idx : cnte - 1;
            np[i] = HB + (size_t)(off + idx) * 512 + ldc;
        }
        f32x4 acc[4][4]; zero_acc(acc);
        gemm_kloop(mp, np, 8, lds, acc);
#pragma unroll
        for (int ni = 0; ni < 4; ++ni) {
            const int idx = rt * 128 + 64 * wc + 16 * ni + fr;
            if (idx < cnte) {
                const int a = LIST[(size_t)e * T_ + idx];
#pragma unroll
                for (int mi = 0; mi < 4; ++mi) {
                    const int n = ct * 128 + 64 * wr + 16 * mi + 4 * fq;
                    *(u32x2*)(CT + (size_t)a * 1024 + n) = pack4(acc[mi][ni]);
                }
            }
        }
    }
}

__device__ void phase_ln2(const Params& p, int layer) {
    unsigned char* ws = launder(p.ws);
    const int tid = threadIdx.x + vzero(), lane = tid & 63, wid = tid >> 6;
    const float* X1 = (const float*)(ws + WS_X1); const bf16_t* CT = (const bf16_t*)(ws + WS_CT); const float* WTS = (const float*)(ws + WS_WTS);
    float* XO = layer == NLAYER - 1 ? p.out : (float*)(ws + WS_X); bf16_t* XB = (bf16_t*)(ws + WS_XB);
    const float* gam = p.ln2_g + layer * 1024; const float* bet = p.ln2_b + layer * 1024;
    for (int tok = blockIdx.x * 4 + wid; tok < T_; tok += gridDim.x * 4) {
        const float w0 = WTS[tok * 2 + vzero()], w1 = WTS[tok * 2 + 1 + vzero()];
        float4 v[4];
#pragma unroll
        for (int j = 0; j < 4; ++j) {
            const int d0 = 256 * j + 4 * lane;
            const float4 xv = *(const float4*)(X1 + (size_t)tok * 1024 + d0);
            const f32x4 c0 = unpack4(*(const u32x2*)(CT + (size_t)(tok * 2) * 1024 + d0)), c1 = unpack4(*(const u32x2*)(CT + (size_t)(tok * 2 + 1) * 1024 + d0));
            v[j].x = xv.x * DN_ALPHA + w0 * c0[0] + w1 * c1[0]; v[j].y = xv.y * DN_ALPHA + w0 * c0[1] + w1 * c1[1];
            v[j].z = xv.z * DN_ALPHA + w0 * c0[2] + w1 * c1[2]; v[j].w = xv.w * DN_ALPHA + w0 * c0[3] + w1 * c1[3];
        }
        float s = 0.f;
#pragma unroll
        for (int j = 0; j < 4; ++j) s += v[j].x + v[j].y + v[j].z + v[j].w;
#pragma unroll
        for (int o = 1; o < 64; o <<= 1) s += __shfl_xor(s, o);
        const float mu = s * (1.f / 1024.f);
        float q = 0.f;
#pragma unroll
        for (int j = 0; j < 4; ++j) { const float a = v[j].x - mu, b2 = v[j].y - mu, c = v[j].z - mu, d = v[j].w - mu; q += a * a + b2 * b2 + c * c + d * d; }
#pragma unroll
        for (int o = 1; o < 64; o <<= 1) q += __shfl_xor(q, o);
        const float rstd = rsqrtf(q * (1.f / 1024.f) + 1e-5f);
#pragma unroll
        for (int j = 0; j < 4; ++j) {
            const int d0 = 256 * j + 4 * lane;
            const float4 gg = *(const float4*)(gam + d0), bb = *(const float4*)(bet + d0);
            float4 y; y.x = (v[j].x - mu) * rstd * gg.x + bb.x; y.y = (v[j].y - mu) * rstd * gg.y + bb.y; y.z = (v[j].z - mu) * rstd * gg.z + bb.z; y.w = (v[j].w - mu) * rstd * gg.w + bb.w;
            *(float4*)(XO + (size_t)tok * 1024 + d0) = y;
            u32x2 w; w.x = pack2(y.x, y.y); w.y = pack2(y.z, y.w);
            *(u32x2*)(XB + (size_t)tok * 1024 + d0) = w;
        }
    }
}

#define XB_TMO      128
#define XB_XCNT(j)  (256  + 64 * (j))
#define XB_XSUB(j)  (1280 + 64 * (j))
#define XB_XGEN(j)  (2304 + 64 * (j))
#define XB_TOP      3328
#define XB_TOPGEN   3392
#define XCD_BAR_WORDS 3456
#define XB_SPIN_CAP (1u << 22)
#define LAS __attribute__((address_space(3)))
__device__ __forceinline__ unsigned xb_ld(unsigned* p)              { return __hip_atomic_load(p, __ATOMIC_RELAXED, __HIP_MEMORY_SCOPE_AGENT); }
__device__ __forceinline__ unsigned xb_add(unsigned* p, unsigned v) { return __hip_atomic_fetch_add(p, v, __ATOMIC_RELAXED, __HIP_MEMORY_SCOPE_AGENT); }
__device__ __forceinline__ unsigned xb_xcc_id() { return (unsigned)__builtin_amdgcn_s_getreg((3 << 11) | 20) & 0xFu; }
#define XB_SPIN(cond, bar) do { unsigned _sp = 0; while (cond) { __builtin_amdgcn_s_sleep(1); \
    if ((++_sp & 255u) == 0u) { if (xb_ld(&(bar)[XB_TMO])) break; if (_sp > XB_SPIN_CAP) { atomicAdd(&(bar)[XB_TMO], 1u); break; } } } } while (0)
struct XcdBarrier { unsigned* bar; unsigned x; volatile LAS unsigned* st; };
__device__ __forceinline__ XcdBarrier xcd_barrier_post(unsigned* bar, volatile LAS unsigned* st) {
    XcdBarrier b; b.bar = bar; b.x = xb_xcc_id(); b.st = st;
    if (threadIdx.x == 0) (void)xb_add(&bar[XB_XCNT(b.x)], 1u);
    return b;
}
__device__ __forceinline__ void xcd_barrier_complete(unsigned* bar, unsigned x, unsigned& nloc, unsigned& nx) {
    const unsigned G = gridDim.x * gridDim.y * gridDim.z;
    unsigned sum, cnt, mine, sp = 0u;
    for (;;) {
        sum = 0u; cnt = 0u; mine = 0u;
#pragma unroll
        for (unsigned j = 0; j < 16; ++j) { const unsigned c = xb_ld(&bar[XB_XCNT(j)]); sum += c; cnt += (c > 0u) ? 1u : 0u; mine = (j == x) ? c : mine; }
        if (sum == G) break;
        __builtin_amdgcn_s_sleep(1);
        if ((++sp & 255u) == 0u) { if (xb_ld(&bar[XB_TMO])) break; if (sp > XB_SPIN_CAP) { atomicAdd(&bar[XB_TMO], 1u); break; } }
    }
    nloc = mine > 0u ? mine : 1u; nx = cnt > 0u ? cnt : 1u;
}
__device__ __forceinline__ void xcd_barrier(const XcdBarrier& b) {
    asm volatile("s_waitcnt vmcnt(0)" ::: "memory");
    __syncthreads();
    if (threadIdx.x == 0) {
        unsigned* bar = b.bar;
        __builtin_amdgcn_s_waitcnt(0);
        unsigned nloc = b.st[0], nx = b.st[1];
        if (nloc == 0u) { xcd_barrier_complete(bar, b.x, nloc, nx); b.st[0] = nloc; b.st[1] = nx; }
        const unsigned old = xb_add(&bar[XB_XSUB(b.x)], 1u);
        const unsigned gen = old / nloc;
        if (old + 1u == (gen + 1u) * nloc) {
            __builtin_amdgcn_fence(__ATOMIC_RELEASE, "agent");
            asm volatile("s_waitcnt vmcnt(0)" ::: "memory");
            const unsigned og = xb_add(&bar[XB_TOP], 1u);
            const unsigned tg = og / nx;
            if (og + 1u == (tg + 1u) * nx) xb_add(&bar[XB_TOPGEN], 1u);
            else XB_SPIN(xb_ld(&bar[XB_TOPGEN]) == tg, bar);
            __builtin_amdgcn_fence(__ATOMIC_ACQUIRE, "agent");
            xb_add(&bar[XB_XGEN(b.x)], 1u);
            asm volatile("s_waitcnt vmcnt(0)" ::: "memory");
        } else {
            XB_SPIN(xb_ld(&bar[XB_XGEN(b.x)]) == gen, bar);
            __builtin_amdgcn_fence(__ATOMIC_ACQUIRE, "agent");
            asm volatile("s_waitcnt vmcnt(0)" ::: "memory");
        }
    }
    __syncthreads();
}

constexpr int PH_PER_LAYER = 11, N_PHASES = PH_PER_LAYER * NLAYER;
__global__ void __launch_bounds__(NTHREADS, 2) mega(Params p) {
    extern __shared__ __attribute__((aligned(16))) unsigned char lds[];
#if SINGLE_LAUNCH
    volatile LAS unsigned* xbw = (volatile LAS unsigned*)(lds + LDS_BYTES - 16);
    if (threadIdx.x < 4) xbw[threadIdx.x] = 0u;
    __syncthreads();
    XcdBarrier xbar = xcd_barrier_post((unsigned*)(p.ws + WS_CTL) + CW_BAR, xbw);
#endif
    for (int ph = p.ph_lo; ph < p.ph_hi; ++ph) {
        const int layer = ph / PH_PER_LAYER, k = ph % PH_PER_LAYER;
#ifdef ONLY_PHASE
        if (k != ONLY_PHASE) continue;
#endif
#ifdef REPEAT_MASK
        for (int rep = 0; rep < (((REPEAT_MASK) >> k) & 1) + 1; ++rep) {
        if (rep) __syncthreads();
#endif
        switch (k) {
            case 0: phase_pw(p, layer, lds); break;
            case 1: phase_g1(p, layer, lds); break;
            case 2: phase_p2(p, layer, lds); break;
            case 3: phase_p3(p, lds); break;
            case 4: phase_p4(p, lds); break;
            case 5: phase_g2(p, lds); break;
            case 6: phase_g3(p, layer, lds); break;
            case 7: phase_ln1(p, layer, lds); break;
            case 8: phase_m2(p, layer, lds); break;
            case 9: phase_m3(p, layer, lds); break;
            case 10: phase_ln2(p, layer); break;
        }
#ifdef REPEAT_MASK
        }
#endif
#if SINGLE_LAUNCH
        if (ph + 1 < p.ph_hi) { if (ph == p.ph_lo) cg::this_grid().sync(); else xcd_barrier(xbar); }
#endif
    }
}

extern "C" void kernel_launch(void* const* d_in, const int* in_sizes, int n_in, void* d_out, int out_size, void* d_ws, size_t ws_size, hipStream_t stream) {
    static int grid = 0;
    if (grid == 0) {
        if (n_in != 18 || ws_size < WS_END) { fprintf(stderr, "kernel_launch: unexpected n_in %d or ws_size %zu < %zu\n", n_in, ws_size, (size_t)WS_END); grid = -1; return; }
        int dev = 0, cus = 0, per_cu = 0;
        hipGetDevice(&dev); hipDeviceGetAttribute(&cus, hipDeviceAttributeMultiprocessorCount, dev);
        hipFuncSetAttribute((const void*)mega, hipFuncAttributeMaxDynamicSharedMemorySize, LDS_BYTES);
        hipOccupancyMaxActiveBlocksPerMultiprocessor(&per_cu, (const void*)mega, NTHREADS, LDS_BYTES);
        if (per_cu < 1) per_cu = 1;
        if (per_cu > 2) per_cu = 2;
        grid = cus * per_cu;
        (void)hipGetLastError();
    }
    if (grid < 0) return;
    Params p{};
    p.x = (const float*)d_in[0]; p.w_in = (const float*)d_in[1]; p.cmp_pos = (const float*)d_in[2]; p.cmp_w1 = (const float*)d_in[3]; p.cmp_w2 = (const float*)d_in[4];
    p.w_br_a = (const float*)d_in[5]; p.w_br_b = (const float*)d_in[6]; p.w_o = (const float*)d_in[7]; p.ln1_g = (const float*)d_in[8]; p.ln1_b = (const float*)d_in[9];
    p.w_router = (const float*)d_in[10]; p.router_bias = (const float*)d_in[11]; p.w_gate = (const float*)d_in[12]; p.w_up = (const float*)d_in[13]; p.w_down = (const float*)d_in[14];
    p.ln2_g = (const float*)d_in[15]; p.ln2_b = (const float*)d_in[16]; p.rel_bias = (const float*)d_in[17];
    p.out = (float*)d_out; p.ws = (unsigned char*)d_ws;
#if SINGLE_LAUNCH
    hipMemsetAsync((unsigned char*)d_ws + WS_CTL + (size_t)CW_BAR * 4, 0, XCD_BAR_WORDS * 4, stream);
    p.ph_lo = 0; p.ph_hi = N_PHASES;
    void* args[] = {&p};
    hipError_t e = hipLaunchCooperativeKernel((const void*)mega, dim3(grid), dim3(NTHREADS), args, LDS_BYTES, stream);
    if (e != hipSuccess) fprintf(stderr, "cooperative launch failed: %s (grid %d)\n", hipGetErrorString(e), grid);
#else
    for (int ph = 0; ph < N_PHASES; ++ph) {
        p.ph_lo = ph; p.ph_hi = ph + 1;
        hipLaunchKernelGGL(mega, dim3(grid), dim3(NTHREADS), LDS_BYTES, stream, p);
    }
#endif
}
```

```cpp
#include <hip/hip_runtime.h>
#include <hip/hip_cooperative_groups.h>
#include <cstdio>
#include <cstdint>
namespace cg = cooperative_groups;

#ifndef SINGLE_LAUNCH
#define SINGLE_LAUNCH 1
#endif

typedef unsigned short bf16_t;
typedef short bf16x8 __attribute__((ext_vector_type(8)));
typedef float f32x4 __attribute__((ext_vector_type(4)));
typedef unsigned u32x2 __attribute__((ext_vector_type(2)));
typedef unsigned u32x4 __attribute__((ext_vector_type(4)));

constexpr int B_ = 2, S_ = 8192, D_ = 1024, T_ = B_ * S_, NLAYER = 4;
constexpr int DIN = 6424;
constexpr int LD = 6528;
constexpr int C_QA = 0, C_KC = 512, C_VC = 640, C_KS = 768, C_VS = 896, C_KW = 1024, C_VW = 1152, C_QR = 1280, C_KR = 1792,
              C_VR = 2304, C_GR = 3328, C_MA = 4352, C_MB = 5376, C_GA = 6400;
constexpr float DN_ALPHA = 1.681792830507429f;
constexpr int NE = 16;

constexpr size_t al256(size_t x) { return (x + 255) & ~(size_t)255; }
constexpr size_t WS_CTL = 0;
constexpr size_t WS_BUCKET = 65536;
constexpr size_t WS_ROPE = WS_BUCKET + 8192;
constexpr size_t WS_WIN = WS_ROPE + (size_t)8192 * 32 * 8;
constexpr size_t WS_WA = WS_WIN + (size_t)LD * 1024 * 2;
constexpr size_t WS_WB = WS_WA + (size_t)1024 * 512 * 2;
constexpr size_t WS_WO = WS_WB + (size_t)1024 * 1024 * 2;
constexpr size_t WS_WG = WS_WO + (size_t)1024 * 1024 * 2;
constexpr size_t WS_WU = WS_WG + (size_t)16 * 512 * 1024 * 2;
constexpr size_t WS_WD = WS_WU + (size_t)16 * 512 * 1024 * 2;
constexpr size_t WS_XB = WS_WD + (size_t)16 * 512 * 1024 * 2;
constexpr size_t WS_X = WS_XB + (size_t)T_ * 1024 * 2;
constexpr size_t WS_MG = WS_X + (size_t)T_ * 1024 * 4;
constexpr size_t WS_KCC = WS_MG + (size_t)T_ * 1024 * 2;
constexpr size_t WS_VCCT = WS_KCC + (size_t)4 * 512 * 64 * 2;
constexpr size_t WS_W1T = WS_VCCT + (size_t)4 * 512 * 64 * 2;
constexpr size_t WS_B1 = WS_W1T + (size_t)2 * 64 * 2048 * 2;
constexpr size_t WS_R = WS_B1 + 1024;
constexpr size_t WS_P = WS_R;
constexpr size_t WS_VST = WS_P + (size_t)T_ * LD * 2;
constexpr size_t WS_VWT = WS_VST + (size_t)4 * 64 * S_ * 2;
constexpr size_t WS_VRT = WS_VWT + (size_t)4 * 64 * S_ * 2;
constexpr size_t WS_KVT = WS_VRT + (size_t)16 * 128 * S_ * 2;
constexpr size_t WS_SPT = WS_KVT + (size_t)16 * 64 * 8192 * 4;
constexpr size_t WS_YC = WS_SPT + (size_t)16 * 64 * 8192 * 2;
constexpr size_t WS_YW = WS_YC + (size_t)T_ * 512 * 2;
constexpr size_t WS_YA = WS_YW + (size_t)T_ * 512 * 2;
constexpr size_t WS_YB = WS_YA + (size_t)T_ * 512 * 2;
constexpr size_t WS_SELW = WS_YB + (size_t)T_ * 1024 * 2;
constexpr size_t WS_ENDA = WS_SELW + (size_t)T_ * 2 * 4 * 4;
constexpr size_t WS_H1 = WS_R;
constexpr size_t WS_X1 = WS_H1 + (size_t)T_ * 1024 * 4;
constexpr size_t WS_X1B = WS_X1 + (size_t)T_ * 1024 * 4;
constexpr size_t WS_HB = WS_X1B + (size_t)T_ * 1024 * 2;
constexpr size_t WS_CT = WS_P + (size_t)T_ * LD * 2;
constexpr size_t WS_LIST = WS_CT + (size_t)2 * T_ * 1024 * 2;
constexpr size_t WS_WTS = WS_LIST + (size_t)16 * T_ * 4;
constexpr size_t WS_ENDB = WS_WTS + (size_t)2 * T_ * 4;
static_assert(WS_HB + (size_t)2 * T_ * 512 * 2 <= WS_CT, "view B overlap");
constexpr size_t WS_END = WS_ENDA > WS_ENDB ? WS_ENDA : WS_ENDB;

constexpr int CW_CNT = 4096;
constexpr int CW_BAR = 8192;

constexpr int LDS_BYTES = 75776;
constexpr int NTHREADS = 256;

struct Params {
    const float* x; const float* w_in; const float* cmp_pos; const float* cmp_w1; const float* cmp_w2;
    const float* w_br_a; const float* w_br_b; const float* w_o; const float* ln1_g; const float* ln1_b;
    const float* w_router; const float* router_bias; const float* w_gate; const float* w_up; const float* w_down;
    const float* ln2_g; const float* ln2_b; const float* rel_bias;
    float* out; unsigned char* ws;
    int ph_lo, ph_hi;
};

__device__ __forceinline__ bf16_t f2bf(float f) { unsigned u = __float_as_uint(f); u += 0x7fffu + ((u >> 16) & 1u); return (bf16_t)(u >> 16); }
__device__ __forceinline__ float bf2f(unsigned h) { return __uint_as_float(h << 16); }
__device__ __forceinline__ unsigned pack2(float lo, float hi) { return (unsigned)f2bf(lo) | ((unsigned)f2bf(hi) << 16); }
__device__ __forceinline__ u32x2 pack4(f32x4 v) { u32x2 r; r.x = pack2(v[0], v[1]); r.y = pack2(v[2], v[3]); return r; }
__device__ __forceinline__ f32x4 unpack4(u32x2 u) { f32x4 r; r[0] = bf2f(u.x & 0xffffu); r[1] = bf2f(u.x >> 16); r[2] = bf2f(u.y & 0xffffu); r[3] = bf2f(u.y >> 16); return r; }
__device__ __forceinline__ float sigmoidf_(float x) { return 1.f / (1.f + __expf(-x)); }
__device__ __forceinline__ int vzero() { int z; asm volatile("v_mov_b32 %0, 0" : "=v"(z)); return z; }
__device__ __forceinline__ unsigned char* launder(unsigned char* q) { asm volatile("" : "+s"(q)); return q; }
__device__ __forceinline__ void wait_vm0() { asm volatile("s_waitcnt vmcnt(0)" ::: "memory"); }

__device__ __forceinline__ void glds16(const void* g, void* l) {
    __builtin_amdgcn_global_load_lds((const __attribute__((address_space(1))) unsigned*)g,
                                     (__attribute__((address_space(3))) unsigned*)l, 16, 0, 0);
}
__device__ __forceinline__ f32x4 mfma16(bf16x8 a, bf16x8 b, f32x4 c) { return __builtin_amdgcn_mfma_f32_16x16x32_bf16(a, b, c, 0, 0, 0); }

__device__ __forceinline__ void gemm_stage(const bf16_t* const (&mp)[4], const bf16_t* const (&np)[4], int kt, unsigned char* st, int wid) {
#pragma unroll
    for (int i = 0; i < 4; ++i) {
        glds16(mp[i] + kt * 64, st + (4 * i + wid) * 1024);
        glds16(np[i] + kt * 64, st + 16384 + (4 * i + wid) * 1024);
    }
}
__device__ __forceinline__ void gemm_compute(const unsigned char* st, f32x4 (&acc)[4][4], int wr, int wc, int fr, int fq) {
#pragma unroll
    for (int ks = 0; ks < 2; ++ks) {
        bf16x8 a[4], b[4];
        const int sw = ((4 * ks + fq) ^ (fr & 7)) << 4;
#pragma unroll
        for (int i = 0; i < 4; ++i) {
            a[i] = *(const bf16x8*)(st + (64 * wr + 16 * i + fr) * 128 + sw);
            b[i] = *(const bf16x8*)(st + 16384 + (64 * wc + 16 * i + fr) * 128 + sw);
        }
#pragma unroll
        for (int i = 0; i < 4; ++i)
#pragma unroll
            for (int j = 0; j < 4; ++j) acc[i][j] = mfma16(a[i], b[j], acc[i][j]);
    }
}
__device__ __forceinline__ void gemm_kloop(const bf16_t* const (&mp)[4], const bf16_t* const (&np)[4], int nk, unsigned char* lds, f32x4 (&acc)[4][4]) {
    const int tid = threadIdx.x + vzero(), lane = tid & 63, wid = tid >> 6, wr = wid >> 1, wc = wid & 1, fr = lane & 15, fq = lane >> 4;
    gemm_stage(mp, np, 0, lds, wid);
    wait_vm0(); __syncthreads();
    for (int kt = 0; kt < nk; ++kt) {
        unsigned char* cur = lds + (kt & 1) * 32768;
        if (kt + 1 < nk) gemm_stage(mp, np, kt + 1, lds + ((kt + 1) & 1) * 32768, wid);
        gemm_compute(cur, acc, wr, wc, fr, fq);
        wait_vm0(); __syncthreads();
    }
}
__device__ __forceinline__ void zero_acc(f32x4 (&acc)[4][4]) {
#pragma unroll
    for (int i = 0; i < 4; ++i)
#pragma unroll
        for (int j = 0; j < 4; ++j) acc[i][j] = (f32x4){0.f, 0.f, 0.f, 0.f};
}

__device__ void tcvt_tile(const float* src, int ld_src, int k0, int n0, int mode, bf16_t* dst, int kdst, unsigned char* lds) {
    float* tile = (float*)lds;
    const int tid = threadIdx.x + vzero();
#pragma unroll
    for (int i = 0; i < 4; ++i) {
        const int kk = (tid >> 4) + 16 * i, c4 = (tid & 15) * 4, cd = n0 + c4;
        int orig = cd; bool ok = true;
        if (mode == 1) { if (cd < 1280) orig = cd; else if (cd < 6400) orig = cd + 24; else if (cd < 6424) orig = cd - 6400 + 1280; else ok = false; }
        float4 v = make_float4(0.f, 0.f, 0.f, 0.f);
        if (ok) v = *(const float4*)(src + (size_t)(k0 + kk) * ld_src + orig);
        tile[kk * 65 + c4 + 0] = v.x; tile[kk * 65 + c4 + 1] = v.y; tile[kk * 65 + c4 + 2] = v.z; tile[kk * 65 + c4 + 3] = v.w;
    }
    __syncthreads();
#pragma unroll
    for (int i = 0; i < 2; ++i) {
        const int q = tid + 256 * i, n = q >> 3, kc = q & 7;
        float v[8];
#pragma unroll
        for (int j = 0; j < 8; ++j) v[j] = tile[(kc * 8 + j) * 65 + n];
        u32x4 w; w.x = pack2(v[0], v[1]); w.y = pack2(v[2], v[3]); w.z = pack2(v[4], v[5]); w.w = pack2(v[6], v[7]);
        *(u32x4*)(dst + (size_t)(n0 + n) * kdst + k0 + kc * 8) = w;
    }
    __syncthreads();
}

__device__ void phase_pw(const Params& p, int layer, unsigned char* lds) {
    const int bid = blockIdx.x, nblk = gridDim.x, tid = threadIdx.x + vzero();
    unsigned char* ws = launder(p.ws);
    constexpr int J0 = 16 * 102, J1 = 8 * 16, J2 = 256, J3 = 256, J4 = 2048, J5 = 2048, J6 = 2048, JT = J0 + J1 + J2 + J3 + J4 + J5 + J6;
    for (int t = bid; t < JT; t += nblk) {
        int u = t;
        if (u < J0) { tcvt_tile(p.w_in + (size_t)layer * 1024 * DIN, DIN, (u % 16) * 64, (u / 16) * 64, 1, (bf16_t*)(ws + WS_WIN), 1024, lds); continue; }
        u -= J0;
        if (u < J1) { tcvt_tile(p.w_br_a + (size_t)layer * 512 * 1024, 1024, (u % 8) * 64, (u / 8) * 64, 0, (bf16_t*)(ws + WS_WA), 512, lds); continue; }
        u -= J1;
        if (u < J2) { tcvt_tile(p.w_br_b + (size_t)layer * 1024 * 1024, 1024, (u % 16) * 64, (u / 16) * 64, 0, (bf16_t*)(ws + WS_WB), 1024, lds); continue; }
        u -= J2;
        if (u < J3) { tcvt_tile(p.w_o + (size_t)layer * 1024 * 1024, 1024, (u % 16) * 64, (u / 16) * 64, 0, (bf16_t*)(ws + WS_WO), 1024, lds); continue; }
        u -= J3;
        if (u < J4 + J5) {
            const bool up = u >= J4; if (up) u -= J4;
            const int e = u / 128, v = u % 128;
            const float* src = (up ? p.w_up : p.w_gate) + ((size_t)layer * NE + e) * 1024 * 512;
            tcvt_tile(src, 512, (v % 16) * 64, (v / 16) * 64, 0, (bf16_t*)(ws + (up ? WS_WU : WS_WG)) + (size_t)e * 512 * 1024, 1024, lds); continue;
        }
        u -= J4 + J5;
        { const int e = u / 128, v = u % 128;
          const float* src = p.w_down + ((size_t)layer * NE + e) * 512 * 1024;
          tcvt_tile(src, 1024, (v % 8) * 64, (v / 8) * 64, 0, (bf16_t*)(ws + WS_WD) + (size_t)e * 1024 * 512, 512, lds); }
    }
    for (int t = bid; t < 64; t += nblk) {
        const int kv = t >> 5, kt = t & 31;
        tcvt_tile(p.cmp_w1 + ((size_t)layer * 2 + kv) * 2048 * 64, 64, kt * 64, 0, 0, (bf16_t*)(ws + WS_W1T) + (size_t)kv * 64 * 2048, 2048, lds);
    }
    if (bid >= nblk - 2) {
        const int kv = nblk - 1 - bid, n = tid & 63, part = tid >> 6;
        const float* w1 = p.cmp_w1 + ((size_t)layer * 2 + kv) * 2048 * 64; const float* pos = p.cmp_pos + ((size_t)layer * 2 + kv) * 2048;
        float a = 0.f;
        for (int k = part * 512; k < part * 512 + 512; ++k) a += pos[k] * w1[(size_t)k * 64 + n];
        float* red = (float*)lds;
        __syncthreads(); red[tid] = a; __syncthreads();
        if (tid < 64) ((float*)(ws + WS_B1))[kv * 64 + tid] = red[tid] + red[tid + 64] + red[tid + 128] + red[tid + 192];
        __syncthreads();
    }
    if (layer == 0) {
        const float4* xs = (const float4*)p.x; u32x2* xb = (u32x2*)(ws + WS_XB);
        for (size_t i = (size_t)bid * NTHREADS + tid; i < (size_t)T_ * 1024 / 4; i += (size_t)nblk * NTHREADS) {
            float4 v = xs[i]; u32x2 w; w.x = pack2(v.x, v.y); w.y = pack2(v.z, v.w); xb[i] = w;
        }
        for (int n = bid * NTHREADS + tid; n < 8192; n += nblk * NTHREADS) {
            int bk;
            if (n < 16) bk = n;
            else { const int th[15] = {22, 30, 40, 54, 73, 99, 134, 182, 246, 332, 450, 609, 825, 1117, 1513}; bk = 16;
#pragma unroll
                for (int k = 0; k < 15; ++k) bk += (n >= th[k]) ? 1 : 0; }
            (ws + WS_BUCKET)[n] = (unsigned char)bk;
        }
        for (int i = bid * NTHREADS + tid; i < 8192 * 32; i += nblk * NTHREADS) {
            const int pos = i >> 5, d = i & 31;
            const float inv = powf(10000.f, -(float)d * 2.0f / 64.f);
            const float ang = (float)pos * inv;
            float sn, cs; sincosf(ang, &sn, &cs);
            ((float2*)(ws + WS_ROPE))[i] = make_float2(cs, sn);
        }
        if (bid == 0) for (int i = tid; i < 8192; i += NTHREADS) ((unsigned*)(ws + WS_CTL))[i] = 0u;
    }
}

__device__ void phase_g1(const Params& p, int layer, unsigned char* lds) {
    unsigned char* ws = launder(p.ws);
    const bf16_t* XB = (const bf16_t*)(ws + WS_XB);
    const bf16_t* WT = (const bf16_t*)(ws + WS_WIN);
    bf16_t* P = (bf16_t*)(ws + WS_P);
    const int tid = threadIdx.x + vzero(), lane = tid & 63, wid = tid >> 6, wr = wid >> 1, wc = wid & 1, fr = lane & 15, fq = lane >> 4;
    const int ldrow = 8 * wid + (lane >> 3), ldc = ((lane & 7) ^ (lane >> 3)) * 8;
    const float2* rope = (const float2*)(ws + WS_ROPE);
    for (int t = blockIdx.x; t < 128 * 51; t += gridDim.x) {
        const int mt = t / 51, nt = t % 51, m0 = mt * 128, n0 = nt * 128;
        const bool transposed = (nt == 7) || (nt == 9) || (nt >= 18 && nt <= 25);
        const bf16_t* mp[4]; const bf16_t* np[4];
#pragma unroll
        for (int i = 0; i < 4; ++i) {
            const bf16_t* wrow = WT + (size_t)(n0 + 32 * i + ldrow) * 1024 + ldc;
            const bf16_t* xrow = XB + (size_t)(m0 + 32 * i + ldrow) * 1024 + ldc;
            mp[i] = transposed ? xrow : wrow; np[i] = transposed ? wrow : xrow;
        }
        f32x4 acc[4][4]; zero_acc(acc);
        gemm_kloop(mp, np, 16, lds, acc);
        if (!transposed) {
            const int kind = (nt >= 10 && nt <= 13) ? 1 : (nt >= 14 && nt <= 17) ? 2 : (nt >= 26 && nt <= 33) ? 3 : (nt >= 34) ? 4 : 0;
            if (kind == 1 || kind == 2) {
                const float sc = (kind == 2) ? 0.125f : 1.0f;
#pragma unroll
                for (int ni = 0; ni < 4; ++ni) {
                    const int tok = m0 + 64 * wc + 16 * ni + fr, pos = tok & (S_ - 1);
#pragma unroll
                    for (int mi = 0; mi < 2; ++mi) {
                        const int d = 16 * mi + 4 * fq;
                        const float4 cs01 = *(const float4*)(rope + pos * 32 + d), cs23 = *(const float4*)(rope + pos * 32 + d + 2);
                        const float c[4] = {cs01.x, cs01.z, cs23.x, cs23.z}, s[4] = {cs01.y, cs01.w, cs23.y, cs23.w};
                        f32x4 x1 = acc[mi][ni], x2 = acc[mi + 2][ni], y1, y2;
#pragma unroll
                        for (int r = 0; r < 4; ++r) { y1[r] = (x1[r] * c[r] - x2[r] * s[r]) * sc; y2[r] = (x1[r] * s[r] + x2[r] * c[r]) * sc; }
                        acc[mi][ni] = y1; acc[mi + 2][ni] = y2;
                    }
                }
            }
#pragma unroll
            for (int mi = 0; mi < 4; ++mi)
#pragma unroll
                for (int ni = 0; ni < 4; ++ni) {
                    const int n = n0 + 64 * wr + 16 * mi + 4 * fq, tok = m0 + 64 * wc + 16 * ni + fr;
                    f32x4 v = acc[mi][ni];
                    if (kind == 3) {
#pragma unroll
                        for (int r = 0; r < 4; ++r) v[r] = v[r] * sigmoidf_(v[r]);
                    } else if (kind == 4) {
#pragma unroll
                        for (int r = 0; r < 4; ++r) v[r] = sigmoidf_(v[r]);
                    }
                    *(u32x2*)(P + (size_t)tok * LD + n) = pack4(v);
                }
        } else {
#pragma unroll
            for (int mi = 0; mi < 4; ++mi)
#pragma unroll
                for (int ni = 0; ni < 4; ++ni) {
                    const int tok = m0 + 64 * wr + 16 * mi + 4 * fq, n = n0 + 64 * wc + 16 * ni + fr;
                    const int b = tok >> 13, s = tok & (S_ - 1);
                    bf16_t* dst;
                    if (nt == 7) { const int c = n - C_VS; dst = (bf16_t*)(ws + WS_VST) + ((size_t)(b * 2 + (c >> 6)) * 64 + (c & 63)) * S_ + s; }
                    else if (nt == 9) { const int c = n - C_VW; dst = (bf16_t*)(ws + WS_VWT) + ((size_t)(b * 2 + (c >> 6)) * 64 + (c & 63)) * S_ + s; }
                    else { const int c = n - C_VR; dst = (bf16_t*)(ws + WS_VRT) + ((size_t)(b * 8 + (c >> 7)) * 128 + (c & 127)) * S_ + s; }
                    *(u32x2*)dst = pack4(acc[mi][ni]);
                }
        }
    }
}

__device__ __forceinline__ void load_tile64(const bf16_t* base, size_t rowStride, unsigned char* dst, int wid, int lane) {
    const int c = ((lane & 7) ^ (lane >> 3)) * 8;
#pragma unroll
    for (int i = 0; i < 2; ++i) { const int j = wid + 4 * i, row = 8 * j + (lane >> 3); glds16(base + (size_t)row * rowStride + c, dst + j * 1024); }
}
__device__ __forceinline__ void load_tile128(const bf16_t* base, size_t rowStride, unsigned char* dst, int wid, int lane) {
    const int c = ((lane & 7) ^ (lane >> 3)) * 8;
#pragma unroll
    for (int i = 0; i < 4; ++i) { const int j = wid + 4 * i, row = 8 * j + (lane >> 3); glds16(base + (size_t)row * rowStride + c, dst + j * 1024); }
}
__device__ __forceinline__ void load_tile128w(const bf16_t* base, size_t rowStride, unsigned char* dst, int wid, int lane) {
    const int c = ((lane & 15) ^ ((4 * wid + (lane >> 4)) & 15)) * 8;
#pragma unroll
    for (int i = 0; i < 8; ++i) { const int j = wid + 4 * i, row = 4 * j + (lane >> 4); glds16(base + (size_t)row * rowStride + c, dst + j * 1024); }
}
__device__ __forceinline__ bf16x8 lds_frag128(const unsigned char* tile, int row, int chunk) {
    return *(const bf16x8*)(tile + row * 128 + ((chunk ^ (row & 7)) << 4));
}
__device__ __forceinline__ bf16x8 lds_frag256(const unsigned char* tile, int row, int chunk) {
    return *(const bf16x8*)(tile + row * 256 + ((chunk ^ (row & 15)) << 4));
}
__device__ __forceinline__ bf16x8 lds_vfrag128(const unsigned char* tile, int row, int kbase, int fq) {
    const int ca = (kbase >> 3) + (fq >> 1), hb = (fq & 1) * 8;
    const u32x2 a = *(const u32x2*)(tile + row * 128 + ((ca ^ (row & 7)) << 4) + hb);
    const u32x2 b = *(const u32x2*)(tile + row * 128 + (((ca + 2) ^ (row & 7)) << 4) + hb);
    u32x4 w; w.x = a.x; w.y = a.y; w.z = b.x; w.w = b.y;
    return __builtin_bit_cast(bf16x8, w);
}
__device__ __forceinline__ bf16x8 lds_vfrag256(const unsigned char* tile, int row, int kbase, int fq) {
    const int ca = (kbase >> 3) + (fq >> 1), hb = (fq & 1) * 8;
    const u32x2 a = *(const u32x2*)(tile + row * 256 + ((ca ^ (row & 15)) << 4) + hb);
    const u32x2 b = *(const u32x2*)(tile + row * 256 + (((ca + 2) ^ (row & 15)) << 4) + hb);
    u32x4 w; w.x = a.x; w.y = a.y; w.z = b.x; w.w = b.y;
    return __builtin_bit_cast(bf16x8, w);
}
__device__ __forceinline__ bf16x8 pack8(f32x4 a, f32x4 b) {
    u32x4 w; w.x = pack2(a[0], a[1]); w.y = pack2(a[2], a[3]); w.z = pack2(b[0], b[1]); w.w = pack2(b[2], b[3]);
    return __builtin_bit_cast(bf16x8, w);
}

__device__ __forceinline__ float gelu_tanh(float x) {
    const float u = 0.7978845608028654f * (x + 0.044715f * x * x * x);
    return 0.5f * x * (1.f + tanhf(u));
}
__device__ void compress_item(const Params& p, int layer, int item, unsigned char* lds) {
    unsigned char* ws = launder(p.ws);
    const int tid = threadIdx.x + vzero(), lane = tid & 63, wid = tid >> 6, wr = wid >> 1, wc = wid & 1, fr = lane & 15, fq = lane >> 4;
    const int mtile = item & 3, g = (item >> 2) & 1, b = (item >> 3) & 1, kv = item >> 4;
    const int i0 = mtile * 128;
    const bf16_t* P = (const bf16_t*)(ws + WS_P);
    const bf16_t* W1T = (const bf16_t*)(ws + WS_W1T) + (size_t)kv * 64 * 2048;
    const int col = (kv ? C_VC : C_KC) + g * 64;
    const int ldc = ((lane & 7) ^ (lane >> 3)) * 8;
    const bf16_t* ap[4];
#pragma unroll
    for (int i = 0; i < 4; ++i) ap[i] = P + ((size_t)b * S_ + 16 * (i0 + 32 * i + 8 * wid + (lane >> 3))) * LD + col + ldc;
    const bf16_t* bp[2];
#pragma unroll
    for (int i = 0; i < 2; ++i) bp[i] = W1T + (size_t)(8 * (wid + 4 * i) + (lane >> 3)) * 2048 + ldc;
    f32x4 acc[4][2];
#pragma unroll
    for (int i = 0; i < 4; ++i)
#pragma unroll
        for (int j = 0; j < 2; ++j) acc[i][j] = (f32x4){0.f, 0.f, 0.f, 0.f};
    __syncthreads();
#define CSTAGE(buf, l) do { unsigned char* st_ = lds + (buf) * 24576; \
        _Pragma("unroll") for (int i = 0; i < 4; ++i) glds16(ap[i] + (size_t)(l) * LD, st_ + (4 * i + wid) * 1024); \
        _Pragma("unroll") for (int i = 0; i < 2; ++i) glds16(bp[i] + (l) * 64, st_ + 16384 + (wid + 4 * i) * 1024); } while (0)
    CSTAGE(0, 0); wait_vm0(); __syncthreads();
    for (int l = 0; l < 32; ++l) {
        const unsigned char* st = lds + (l & 1) * 24576;
        if (l + 1 < 32) CSTAGE((l + 1) & 1, l + 1);
#pragma unroll
        for (int ks = 0; ks < 2; ++ks) {
            bf16x8 a[4], bb[2];
#pragma unroll
            for (int i = 0; i < 4; ++i) a[i] = lds_frag128(st, 64 * wr + 16 * i + fr, 4 * ks + fq);
#pragma unroll
            for (int j = 0; j < 2; ++j) bb[j] = lds_frag128(st + 16384, 32 * wc + 16 * j + fr, 4 * ks + fq);
#pragma unroll
            for (int i = 0; i < 4; ++i)
#pragma unroll
                for (int j = 0; j < 2; ++j) acc[i][j] = mfma16(a[i], bb[j], acc[i][j]);
        }
        wait_vm0(); __syncthreads();
    }
#undef CSTAGE
    float* hid = (float*)lds;
    const float* b1 = (const float*)(ws + WS_B1) + kv * 64;
#pragma unroll
    for (int j = 0; j < 2; ++j) {
        const int n = 32 * wc + 16 * j + fr; const float bias = b1[n + vzero()];
#pragma unroll
        for (int i = 0; i < 4; ++i)
#pragma unroll
            for (int r = 0; r < 4; ++r) hid[(64 * wr + 16 * i + 4 * fq + r) * 65 + n] = gelu_tanh(acc[i][j][r] + bias);
    }
    __syncthreads();
    {
        const int row = tid >> 1, nb = (tid & 1) * 32, ci = i0 + row;
        const float* w2 = p.cmp_w2 + ((size_t)layer * 2 + kv) * 64 * 64;
        float o[32];
#pragma unroll
        for (int q = 0; q < 32; ++q) o[q] = 0.f;
        for (int n = 0; n < 64; ++n) {
            const float h = hid[row * 65 + n];
#pragma unroll
            for (int q4 = 0; q4 < 8; ++q4) { const float4 w = *(const float4*)(w2 + n * 64 + nb + 4 * q4); o[4 * q4] += h * w.x; o[4 * q4 + 1] += h * w.y; o[4 * q4 + 2] += h * w.z; o[4 * q4 + 3] += h * w.w; }
        }
        if (kv == 0) {
            bf16_t* dst = (bf16_t*)(ws + WS_KCC) + ((size_t)(b * 2 + g) * 512 + ci) * 64 + nb;
#pragma unroll
            for (int q = 0; q < 32; q += 4) { f32x4 v = {o[q], o[q + 1], o[q + 2], o[q + 3]}; if (ci >= 511) v = (f32x4){0.f, 0.f, 0.f, 0.f}; *(u32x2*)(dst + q) = pack4(v); }
        } else {
            bf16_t* dst = (bf16_t*)(ws + WS_VCCT) + ((size_t)(b * 2 + g) * 64 + nb) * 512 + ci;
#pragma unroll
            for (int q = 0; q < 32; ++q) dst[(size_t)q * 512] = f2bf(ci >= 511 ? 0.f : o[q]);
        }
    }
    __syncthreads();
}

__device__ __forceinline__ float ret_lg2(int h) { const float gam = 1.f - exp2f(-5.f - (float)h); return log2f(gam); }

__device__ void retkv_item(const Params& p, int item, unsigned char* lds) {
    unsigned char* ws = launder(p.ws);
    const int tid = threadIdx.x + vzero(), lane = tid & 63, wid = tid >> 6, fr = lane & 15, fq = lane >> 4;
    const int n = item & 63, h = (item >> 6) & 7, b = item >> 9;
    const size_t tok0 = (size_t)b * S_ + 128 * n;
    unsigned char* vL = lds; unsigned char* kL = lds + 32768;
    load_tile128w((const bf16_t*)(ws + WS_VRT) + ((size_t)(b * 8 + h) * 128) * S_ + 128 * n, S_, vL, wid, lane);
    load_tile128((const bf16_t*)(ws + WS_P) + tok0 * LD + C_KR + h * 64, LD, kL, wid, lane);
    wait_vm0(); __syncthreads();
    const float lg2 = ret_lg2(h);
    f32x4 acc[2][4];
#pragma unroll
    for (int m = 0; m < 2; ++m)
#pragma unroll
        for (int nt = 0; nt < 4; ++nt) acc[m][nt] = (f32x4){0.f, 0.f, 0.f, 0.f};
#pragma unroll
    for (int ks = 0; ks < 4; ++ks) {
        bf16x8 a[2], bb[4];
#pragma unroll
        for (int m = 0; m < 2; ++m) a[m] = lds_frag256(vL, 32 * wid + 16 * m + fr, 4 * ks + fq);
        float dec[8];
#pragma unroll
        for (int j = 0; j < 8; ++j) dec[j] = exp2f((float)(127 - (32 * ks + 8 * fq + j)) * lg2);
#pragma unroll
        for (int nt = 0; nt < 4; ++nt) {
            const int d = 16 * nt + fr;
            float v[8];
#pragma unroll
            for (int j = 0; j < 8; ++j) {
                const int tk = 32 * ks + 8 * fq + j;
                const bf16_t kvv = *(const bf16_t*)(kL + tk * 128 + (((d >> 3) ^ (tk & 7)) << 4) + (d & 7) * 2);
                v[j] = bf2f(kvv) * dec[j];
            }
            u32x4 w; w.x = pack2(v[0], v[1]); w.y = pack2(v[2], v[3]); w.z = pack2(v[4], v[5]); w.w = pack2(v[6], v[7]);
            bb[nt] = __builtin_bit_cast(bf16x8, w);
        }
#pragma unroll
        for (int m = 0; m < 2; ++m)
#pragma unroll
            for (int nt = 0; nt < 4; ++nt) acc[m][nt] = mfma16(a[m], bb[nt], acc[m][nt]);
    }
    float* KVT = (float*)(ws + WS_KVT) + ((size_t)(b * 8 + h) * 64 + n) * 8192;
#pragma unroll
    for (int m = 0; m < 2; ++m)
#pragma unroll
        for (int nt = 0; nt < 4; ++nt)
#pragma unroll
            for (int r = 0; r < 4; ++r) KVT[(32 * wid + 16 * m + 4 * fq + r) * 64 + 16 * nt + fr] = acc[m][nt][r];
    __syncthreads();
}

__device__ void phase_p2(const Params& p, int layer, unsigned char* lds) {
    for (int it = blockIdx.x; it < 1024 + 32; it += gridDim.x) {
        if (it < 32) compress_item(p, layer, it, lds); else retkv_item(p, it - 32, lds);
    }
}

constexpr int NSA_IMP = 32768, NSA_BUCKET = 65792, NSA_BIAS = 73984;

struct NsaLane { int t; int fr, fq, wid, lane; };

template <int BR, int PASS>
__device__ __forceinline__ void nsa_half(const unsigned char* kL, const unsigned char* vL, const unsigned char* lds, const bf16_t* qptr,
                                         f32x4 (&O)[4][4], float (&m)[4], float (&l)[4], int tile, int hf, bool selbit, const NsaLane& L, int qrow) {
    const int fr = L.fr, fq = L.fq;
    bf16x8 Kf[2][2];
#pragma unroll
    for (int i = 0; i < 2; ++i)
#pragma unroll
        for (int ks = 0; ks < 2; ++ks) Kf[i][ks] = lds_frag128(kL, 32 * hf + 16 * i + fr, 4 * ks + fq);
    unsigned vmask = 0; unsigned bk[2];
    const unsigned char* bucketL = lds + NSA_BUCKET;
#pragma unroll
    for (int i = 0; i < 2; ++i) {
        unsigned pk = 0;
#pragma unroll
        for (int r = 0; r < 4; ++r) {
            const int kk = 32 * hf + 16 * i + 4 * fq + r;
            int rel; bool ok;
            if (BR == 0) { rel = L.t - (16 * (64 * tile + kk) + 31); ok = rel >= 0; }
            else if (BR == 1) { rel = L.t - (64 * tile + kk); ok = selbit && rel >= 0; }
            else { rel = L.t - (64 * tile + kk); ok = rel >= 0 && rel < 512; }
            int rc = rel < 0 ? 0 : rel; rc = rc > 8191 ? 8191 : rc;
            pk |= (unsigned)bucketL[rc] << (8 * r);
            vmask |= (ok ? 1u : 0u) << (4 * i + r);
        }
        bk[i] = pk;
    }
    const float* biasL = (const float*)(lds + NSA_BIAS);
    float ia[2] = {0.f, 0.f}, ic[2] = {0.f, 0.f};
#pragma unroll
    for (int nt = 0; nt < 4; ++nt) {
        asm volatile("" ::: "memory");
        f32x4 S[2];
        const bf16x8 q0 = *(const bf16x8*)(qptr + nt * 64), q1 = *(const bf16x8*)(qptr + nt * 64 + 32);
#pragma unroll
        for (int i = 0; i < 2; ++i) {
            S[i] = (f32x4){0.f, 0.f, 0.f, 0.f};
            S[i] = mfma16(Kf[i][0], q0, S[i]); S[i] = mfma16(Kf[i][1], q1, S[i]);
        }
        float tmax = -1e30f;
#pragma unroll
        for (int i = 0; i < 2; ++i)
#pragma unroll
            for (int r = 0; r < 4; ++r) {
                const float bias = biasL[nt * 32 + ((bk[i] >> (8 * r)) & 0xffu)];
                const bool ok = (vmask >> (4 * i + r)) & 1u;
                const float sv = ok ? S[i][r] * 0.125f + bias : -1e30f;
                S[i][r] = sv; tmax = fmaxf(tmax, sv);
            }
        if (PASS != 1) {
            tmax = fmaxf(tmax, __shfl_xor(tmax, 16)); tmax = fmaxf(tmax, __shfl_xor(tmax, 32));
            const float mnew = fmaxf(m[nt], tmax), alpha = __expf(m[nt] - mnew);
            float psum = 0.f;
#pragma unroll
            for (int i = 0; i < 2; ++i)
#pragma unroll
                for (int r = 0; r < 4; ++r) {
                    const bool ok = (vmask >> (4 * i + r)) & 1u;
                    const float pv = ok ? __expf(S[i][r] - mnew) : 0.f;
                    S[i][r] = pv; psum += pv;
                }
            psum += __shfl_xor(psum, 16); psum += __shfl_xor(psum, 32);
            l[nt] = l[nt] * alpha + psum; m[nt] = mnew;
            if (PASS == 2) {
#pragma unroll
                for (int mt = 0; mt < 4; ++mt) O[mt][nt] = O[mt][nt] * alpha;
            }
        } else {
#pragma unroll
            for (int i = 0; i < 2; ++i) {
#pragma unroll
                for (int r = 0; r < 4; ++r) {
                    const bool ok = (vmask >> (4 * i + r)) & 1u;
                    S[i][r] = ok ? __expf(S[i][r] - m[nt]) * l[nt] : 0.f;
                }
                ia[i] += S[i][0] + S[i][1] + S[i][2] + 0.5f * S[i][3];
                ic[i] += 0.5f * S[i][3];
            }
        }
        if (PASS != 0) {
            const bf16x8 Pb = pack8(S[0], S[1]);
#pragma unroll
            for (int mt = 0; mt < 4; ++mt) O[mt][nt] = mfma16(lds_vfrag128(vL, 16 * mt + fr, 32 * hf, fq), Pb, O[mt][nt]);
        }
    }
    if (PASS == 1) {
        float* imp = (float*)(lds + NSA_IMP) + qrow * 129;
        asm volatile("" ::: "memory"); __builtin_amdgcn_wave_barrier();
#pragma unroll
        for (int i = 0; i < 2; ++i) { const int j = 16 * tile + 8 * hf + 4 * i + fq; imp[j] += ia[i]; }
        asm volatile("s_waitcnt lgkmcnt(0)" ::: "memory"); __builtin_amdgcn_wave_barrier();
#pragma unroll
        for (int i = 0; i < 2; ++i) { const int j = 16 * tile + 8 * hf + 4 * i + fq + 1; if (j < 128) imp[j] += ic[i]; }
        asm volatile("s_waitcnt lgkmcnt(0)" ::: "memory"); __builtin_amdgcn_wave_barrier();
    }
}
template <int BR, int PASS>
__device__ __forceinline__ void nsa_tile(const unsigned char* kL, const unsigned char* vL, const unsigned char* lds, const bf16_t* qptr,
                                         f32x4 (&O)[4][4], float (&m)[4], float (&l)[4], int tile, bool selbit, const NsaLane& L, int qrow) {
#pragma unroll 1
    for (int hf = 0; hf < 2; ++hf) nsa_half<BR, PASS>(kL, vL, lds, qptr, O, m, l, tile, hf, selbit, L, qrow);
}

__device__ void cmp_item(const Params& p, int item, unsigned char* lds) {
    unsigned char* ws = launder(p.ws);
    const int tid = threadIdx.x + vzero(), lane = tid & 63, wid = tid >> 6, fr = lane & 15, fq = lane >> 4;
    const int combo = item & 3, qt = 127 - (item >> 2), b = combo >> 1, g = combo & 1;
    const int q0 = qt * 64, qrow = 16 * wid + fr;
    NsaLane L; L.t = q0 + qrow; L.fr = fr; L.fq = fq; L.wid = wid; L.lane = lane;
    const size_t tok = (size_t)b * S_ + L.t;
    const bf16_t* P = (const bf16_t*)(ws + WS_P);
    __syncthreads();
    if (tid < 128) ((float*)(lds + NSA_BIAS))[tid] = p.rel_bias[(tid & 31) * 8 + 4 * g + (tid >> 5)];
    for (int i = tid; i < 64 * 129; i += NTHREADS) ((float*)(lds + NSA_IMP))[i] = 0.f;
    const bf16_t* Qf = P + tok * LD + C_QA + (4 * g) * 64 + 8 * fq;
    __syncthreads();
    f32x4 O[4][4]; float m[4], l[4];
    const bf16_t* gates = P + tok * LD + C_GA + (4 * g) * 3;
    const bf16_t* kc = (const bf16_t*)(ws + WS_KCC) + (size_t)(b * 2 + g) * 512 * 64;
    const bf16_t* vc = (const bf16_t*)(ws + WS_VCCT) + (size_t)(b * 2 + g) * 64 * 512;
    const int ntc = ((q0 + 32) >> 4) / 64 + 1;
#pragma unroll
    for (int nt = 0; nt < 4; ++nt) { m[nt] = -1e30f; l[nt] = 0.f; }
    load_tile64(kc, 64, lds, wid, lane);
    wait_vm0(); __syncthreads();
    for (int it = 0; it < ntc; ++it) {
        unsigned char* cur = lds + (it & 1) * 16384;
        if (it + 1 < ntc) load_tile64(kc + (size_t)(it + 1) * 64 * 64, 64, lds + ((it + 1) & 1) * 16384, wid, lane);
        nsa_tile<0, 0>(cur, cur + 8192, lds, Qf, O, m, l, it, true, L, qrow);
        wait_vm0(); __syncthreads();
    }
#pragma unroll
    for (int nt = 0; nt < 4; ++nt) l[nt] = l[nt] > 0.f ? 1.f / l[nt] : 0.f;
#pragma unroll
    for (int mt = 0; mt < 4; ++mt)
#pragma unroll
        for (int nt = 0; nt < 4; ++nt) O[mt][nt] = (f32x4){0.f, 0.f, 0.f, 0.f};
    load_tile64(kc, 64, lds, wid, lane); load_tile64(vc, 512, lds + 8192, wid, lane);
    wait_vm0(); __syncthreads();
    for (int it = 0; it < ntc; ++it) {
        unsigned char* cur = lds + (it & 1) * 16384;
        if (it + 1 < ntc) { unsigned char* nx = lds + ((it + 1) & 1) * 16384;
            load_tile64(kc + (size_t)(it + 1) * 64 * 64, 64, nx, wid, lane); load_tile64(vc + (it + 1) * 64, 512, nx + 8192, wid, lane); }
        nsa_tile<0, 1>(cur, cur + 8192, lds, Qf, O, m, l, it, true, L, qrow);
        wait_vm0(); __syncthreads();
    }
    bf16_t* YC = (bf16_t*)(ws + WS_YC) + tok * 512 + (4 * g) * 64;
#pragma unroll
    for (int nt = 0; nt < 4; ++nt) {
        const float gt = bf2f(gates[nt * 3 + 0]);
#pragma unroll
        for (int mt = 0; mt < 4; ++mt) *(u32x2*)(YC + nt * 64 + 16 * mt + 4 * fq) = pack4(O[mt][nt] * gt);
    }
    const int cur = qt;
    {
        float* imp = (float*)(lds + NSA_IMP) + qrow * 129 + 32 * fq;
        asm volatile("s_waitcnt lgkmcnt(0)" ::: "memory"); __builtin_amdgcn_wave_barrier();
#pragma unroll
        for (int i = 0; i < 32; ++i) {
            const int j = 32 * fq + i;
            const float v = imp[i];
            imp[i] = j > cur ? -1.f : v + ((j == 0 || j == cur || j == cur - 1) ? 1.0e4f : 0.f);
        }
        unsigned word = 0;
#pragma unroll 1
        for (int round = 0; round < 16; ++round) {
            float bv = imp[0]; int bi = 0;
#pragma unroll
            for (int i = 1; i < 32; ++i) { const float v = imp[i]; if (v > bv) { bv = v; bi = i; } }
            int gi = 32 * fq + bi;
#pragma unroll
            for (int off = 16; off <= 32; off <<= 1) {
                const float ov = __shfl_xor(bv, off); const int oi = __shfl_xor(gi, off);
                if (ov > bv || (ov == bv && oi < gi)) { bv = ov; gi = oi; }
            }
            if (bv >= 0.f && (gi >> 5) == fq) { word |= 1u << (gi & 31); imp[gi & 31] = -2.f; }
        }
        ((unsigned*)(ws + WS_SELW))[(tok * 2 + g) * 4 + fq] = word;
    }
}

__device__ void win_item(const Params& p, int item, unsigned char* lds) {
    unsigned char* ws = launder(p.ws);
    const int tid = threadIdx.x + vzero(), lane = tid & 63, wid = tid >> 6, fr = lane & 15, fq = lane >> 4;
    const int combo = item & 3, qt = 127 - (item >> 2), b = combo >> 1, g = combo & 1;
    const int q0 = qt * 64, qrow = 16 * wid + fr;
    NsaLane L; L.t = q0 + qrow; L.fr = fr; L.fq = fq; L.wid = wid; L.lane = lane;
    const size_t tok = (size_t)b * S_ + L.t;
    const bf16_t* P = (const bf16_t*)(ws + WS_P);
    __syncthreads();
    if (tid < 128) ((float*)(lds + NSA_BIAS))[tid] = p.rel_bias[(tid & 31) * 8 + 4 * g + (tid >> 5)];
    const bf16_t* Qf = P + tok * LD + C_QA + (4 * g) * 64 + 8 * fq;
    __syncthreads();
    f32x4 O[4][4]; float m[4], l[4];
    const bf16_t* gates = P + tok * LD + C_GA + (4 * g) * 3;
#pragma unroll
    for (int nt = 0; nt < 4; ++nt) { m[nt] = -1e30f; l[nt] = 0.f; }
#pragma unroll
    for (int mt = 0; mt < 4; ++mt)
#pragma unroll
        for (int nt = 0; nt < 4; ++nt) O[mt][nt] = (f32x4){0.f, 0.f, 0.f, 0.f};
    {
        const bf16_t* kb = P + ((size_t)b * S_) * LD + C_KW + g * 64;
        const bf16_t* vb = (const bf16_t*)(ws + WS_VWT) + (size_t)(b * 2 + g) * 64 * S_;
        const int k_lo = qt - 8 > 0 ? qt - 8 : 0, ntw = qt - k_lo + 1;
        load_tile64(kb + (size_t)k_lo * 64 * LD, LD, lds, wid, lane); load_tile64(vb + k_lo * 64, S_, lds + 8192, wid, lane);
        wait_vm0(); __syncthreads();
        for (int it = 0; it < ntw; ++it) {
            unsigned char* cu = lds + (it & 1) * 16384;
            if (it + 1 < ntw) { unsigned char* nx = lds + ((it + 1) & 1) * 16384;
                load_tile64(kb + (size_t)(k_lo + it + 1) * 64 * LD, LD, nx, wid, lane); load_tile64(vb + (k_lo + it + 1) * 64, S_, nx + 8192, wid, lane); }
            nsa_tile<2, 2>(cu, cu + 8192, lds, Qf, O, m, l, k_lo + it, true, L, qrow);
            wait_vm0(); __syncthreads();
        }
    }
    bf16_t* YW = (bf16_t*)(ws + WS_YW) + tok * 512 + (4 * g) * 64;
#pragma unroll
    for (int nt = 0; nt < 4; ++nt) {
        const float gt = bf2f(gates[nt * 3 + 2]) * (l[nt] > 0.f ? 1.f / l[nt] : 0.f);
#pragma unroll
        for (int mt = 0; mt < 4; ++mt) *(u32x2*)(YW + nt * 64 + 16 * mt + 4 * fq) = pack4(O[mt][nt] * gt);
    }
}

constexpr int SEL_BIAS2 = 40960;
constexpr float LOG2E = 1.4426950408889634f;
__device__ __forceinline__ int t5_first(int bk) {
    const int th[16] = {16, 22, 30, 40, 54, 73, 99, 134, 182, 246, 332, 450, 609, 825, 1117, 1513};
    int r = 16;
#pragma unroll
    for (int k = 0; k < 16; ++k) r = (bk == 16 + k) ? th[k] : r;
    return r;
}
template <bool FAST, int HF>
__device__ __forceinline__ void sel_ntile(const bf16x8 (&Kf)[2][2], const bf16x8 (&Vf)[4], const bf16x8& q0, const bf16x8& q1, f32x4 (&O)[4], float& m, float& l,
                                          bool sb, int relb, int th, float blo, float bhi, const unsigned char* lds, int hl) {
    f32x4 S[2];
#pragma unroll
    for (int i = 0; i < 2; ++i) { S[i] = (f32x4){0.f, 0.f, 0.f, 0.f}; S[i] = mfma16(Kf[i][0], q0, S[i]); S[i] = mfma16(Kf[i][1], q1, S[i]); }
    float tmax = -1e30f;
    unsigned vm = 0;
#pragma unroll
    for (int i = 0; i < 2; ++i)
#pragma unroll
        for (int r = 0; r < 4; ++r) {
            const int rel = relb - (32 * HF + 16 * i + r);
            float bias; bool ok;
            if (FAST) { bias = rel >= th ? bhi : blo; ok = sb; }
            else {
                int rc = rel < 0 ? 0 : rel; rc = rc > 8191 ? 8191 : rc;
                bias = ((const float*)(lds + SEL_BIAS2))[hl * 32 + (lds + NSA_BUCKET)[rc]]; ok = sb && rel >= 0;
            }
            const float sv = ok ? S[i][r] * (0.125f * LOG2E) + bias : -1e30f;
            vm |= (ok ? 1u : 0u) << (4 * i + r);
            S[i][r] = sv; tmax = fmaxf(tmax, sv);
        }
    tmax = fmaxf(tmax, __shfl_xor(tmax, 16)); tmax = fmaxf(tmax, __shfl_xor(tmax, 32));
    const float mnew = fmaxf(m, tmax), alpha = __builtin_amdgcn_exp2f(m - mnew);
    float psum = 0.f;
#pragma unroll
    for (int i = 0; i < 2; ++i)
#pragma unroll
        for (int r = 0; r < 4; ++r) { const float pv = ((vm >> (4 * i + r)) & 1u) ? __builtin_amdgcn_exp2f(S[i][r] - mnew) : 0.f; S[i][r] = pv; psum += pv; }
    psum += __shfl_xor(psum, 16); psum += __shfl_xor(psum, 32);
    l = l * alpha + psum; m = mnew;
    const bf16x8 Pb = pack8(S[0], S[1]);
#pragma unroll
    for (int mt = 0; mt < 4; ++mt) { O[mt] = O[mt] * alpha; O[mt] = mfma16(Vf[mt], Pb, O[mt]); }
}
template <bool FAST, int HF>
__device__ __forceinline__ void sel_half(const unsigned char* kL, const unsigned char* vL, const unsigned char* lds, const bf16x8 (&Qf)[2][2], f32x4 (&O)[2][4], float (&m)[2], float (&l)[2],
                                         const bool (&sb)[2], const bool (&need)[2], const int (&relb)[2], int th, float blo, float bhi, int hl, int fr, int fq) {
    bf16x8 Kf[2][2], Vf[4];
#pragma unroll
    for (int i = 0; i < 2; ++i)
#pragma unroll
        for (int ks = 0; ks < 2; ++ks) Kf[i][ks] = lds_frag128(kL, 32 * HF + 16 * i + fr, 4 * ks + fq);
#pragma unroll
    for (int mt = 0; mt < 4; ++mt) Vf[mt] = lds_vfrag128(vL, 16 * mt + fr, 32 * HF, fq);
    if (need[0]) sel_ntile<FAST, HF>(Kf, Vf, Qf[0][0], Qf[0][1], O[0], m[0], l[0], sb[0], relb[0], th, blo, bhi, lds, hl);
    if (need[1]) sel_ntile<FAST, HF>(Kf, Vf, Qf[1][0], Qf[1][1], O[1], m[1], l[1], sb[1], relb[1], th, blo, bhi, lds, hl);
}
__device__ void sel_item(const Params& p, int v, unsigned char* lds) {
    unsigned char* ws = launder(p.ws);
    const int tid = threadIdx.x + vzero(), lane = tid & 63, wid = tid >> 6, fr = lane & 15, fq = lane >> 4;
    const int qt = 127 - (v >> 3), sub = v & 7, b = sub >> 2, g = (sub >> 1) & 1, half = sub & 1;
    const int q0 = qt * 64 + 32 * half, cur = qt, hl = fr & 3;
    const bf16_t* P = (const bf16_t*)(ws + WS_P);
    __syncthreads();
    if (tid < 128) ((float*)(lds + SEL_BIAS2))[tid] = p.rel_bias[(tid & 31) * 8 + 4 * g + (tid >> 5)] * LOG2E;
    int t[2]; size_t tok[2]; bf16x8 Qf[2][2]; unsigned selw[2][4];
#pragma unroll
    for (int nt = 0; nt < 2; ++nt) {
        t[nt] = q0 + 8 * wid + 4 * nt + (fr >> 2); tok[nt] = (size_t)b * S_ + t[nt];
#pragma unroll
        for (int ks = 0; ks < 2; ++ks) Qf[nt][ks] = *(const bf16x8*)(P + tok[nt] * LD + C_QA + (4 * g + hl) * 64 + 32 * ks + 8 * fq);
        const u32x4 w = *(const u32x4*)((const unsigned*)(ws + WS_SELW) + (tok[nt] * 2 + g) * 4);
        selw[nt][0] = w.x; selw[nt][1] = w.y; selw[nt][2] = w.z; selw[nt][3] = w.w;
    }
    f32x4 O[2][4]; float m[2], l[2];
#pragma unroll
    for (int nt = 0; nt < 2; ++nt) { m[nt] = -1e30f; l[nt] = 0.f;
#pragma unroll
        for (int mt = 0; mt < 4; ++mt) O[nt][mt] = (f32x4){0.f, 0.f, 0.f, 0.f}; }
    const bf16_t* kb = P + ((size_t)b * S_) * LD + C_KS + g * 64;
    const bf16_t* vb = (const bf16_t*)(ws + WS_VST) + (size_t)(b * 2 + g) * 64 * S_;
    const int nts = cur + 1;
    load_tile64(kb, LD, lds, wid, lane); load_tile64(vb, S_, lds + 8192, wid, lane);
    wait_vm0(); __syncthreads();
    const unsigned char* bucketL = lds + NSA_BUCKET;
    for (int j = 0; j < nts; ++j) {
        const unsigned char* cu = lds + (j & 1) * 16384;
        if (j + 1 < nts) { unsigned char* nx = lds + ((j + 1) & 1) * 16384;
            load_tile64(kb + (size_t)(j + 1) * 64 * LD, LD, nx, wid, lane); load_tile64(vb + (j + 1) * 64, S_, nx + 8192, wid, lane); }
        bool sb[2], need[2]; int relb[2];
#pragma unroll
        for (int nt = 0; nt < 2; ++nt) {
            const unsigned w = j < 32 ? selw[nt][0] : j < 64 ? selw[nt][1] : j < 96 ? selw[nt][2] : selw[nt][3];
            sb[nt] = (w >> (j & 31)) & 1u; need[nt] = __ballot(sb[nt]) != 0ull; relb[nt] = t[nt] - 64 * j - 4 * fq;
        }
        if (need[0] || need[1]) {
            const int rmin = q0 - 64 * j - 63, rmax = q0 + 31 - 64 * j;
            bool fast = false; int th = 0; float blo = 0.f, bhi = 0.f;
            if (rmin >= 16) {
                const int b0 = bucketL[rmin], b1 = bucketL[rmax > 8191 ? 8191 : rmax];
                if (b1 - b0 <= 1) { fast = true; th = t5_first(b1); if (b1 == b0) th = 0;
                    blo = ((const float*)(lds + SEL_BIAS2))[hl * 32 + b0]; bhi = ((const float*)(lds + SEL_BIAS2))[hl * 32 + b1]; }
            }
            if (fast) {
                sel_half<true, 0>(cu, cu + 8192, lds, Qf, O, m, l, sb, need, relb, th, blo, bhi, hl, fr, fq);
                sel_half<true, 1>(cu, cu + 8192, lds, Qf, O, m, l, sb, need, relb, th, blo, bhi, hl, fr, fq);
            } else {
                sel_half<false, 0>(cu, cu + 8192, lds, Qf, O, m, l, sb, need, relb, th, blo, bhi, hl, fr, fq);
                sel_half<false, 1>(cu, cu + 8192, lds, Qf, O, m, l, sb, need, relb, th, blo, bhi, hl, fr, fq);
            }
        }
        wait_vm0(); __syncthreads();
    }
#pragma unroll
    for (int nt = 0; nt < 2; ++nt) {
        const float gt = bf2f(P[tok[nt] * LD + C_GA + (4 * g + hl) * 3 + 1]) * (l[nt] > 0.f ? 1.f / l[nt] : 0.f);
        const size_t o = tok[nt] * 512 + (4 * g + hl) * 64;
#pragma unroll
        for (int mt = 0; mt < 4; ++mt) {
            const f32x4 yc = unpack4(*(const u32x2*)((const bf16_t*)(ws + WS_YC) + o + 16 * mt + 4 * fq));
            const f32x4 yw = unpack4(*(const u32x2*)((const bf16_t*)(ws + WS_YW) + o + 16 * mt + 4 * fq));
            *(u32x2*)((bf16_t*)(ws + WS_YA) + o + 16 * mt + 4 * fq) = pack4(yc + yw + O[nt][mt] * gt);
        }
    }
}

__device__ void scan_item(const Params& p, int item) {
    unsigned char* ws = launder(p.ws);
    const int idx = item * NTHREADS + threadIdx.x;
    const int bh = idx >> 13, ed = idx & 8191, h = bh & 7;
    const float dec = exp2f(128.f * ret_lg2(h));
    const float* KVT = (const float*)(ws + WS_KVT) + (size_t)bh * 64 * 8192 + ed;
    bf16_t* SPT = (bf16_t*)(ws + WS_SPT) + (size_t)bh * 64 * 8192 + ed;
    float s = 0.f;
    for (int n = 0; n < 64; ++n) { SPT[(size_t)n * 8192] = f2bf(s); s = s * dec + KVT[(size_t)n * 8192]; }
}

__device__ void phase_p3(const Params& p, unsigned char* lds) {
    for (int i = threadIdx.x; i < 8192 / 16; i += NTHREADS) ((u32x4*)(lds + NSA_BUCKET))[i] = ((const u32x4*)(p.ws + WS_BUCKET))[i];
    __syncthreads();
    for (int it = blockIdx.x; it < 1536; it += gridDim.x) {
        if (it < 512) cmp_item(p, it, lds); else if (it < 1024) win_item(p, it - 512, lds); else scan_item(p, it - 1024);
    }
}

__device__ void retout_item(const Params& p, int item, unsigned char* lds) {
    unsigned char* ws = launder(p.ws);
    const int tid = threadIdx.x + vzero(), lane = tid & 63, wid = tid >> 6, fr = lane & 15, fq = lane >> 4;
    const int n = item & 63, h = (item >> 6) & 7, b = item >> 9;
    const size_t tok0 = (size_t)b * S_ + 128 * n;
    const bf16_t* P = (const bf16_t*)(ws + WS_P);
    unsigned char* vL = lds; unsigned char* kL = lds + 32768; unsigned char* sL = lds + 49152;
    __syncthreads();
    load_tile128w((const bf16_t*)(ws + WS_VRT) + ((size_t)(b * 8 + h) * 128) * S_ + 128 * n, S_, vL, wid, lane);
    load_tile128(P + tok0 * LD + C_KR + h * 64, LD, kL, wid, lane);
    load_tile128((const bf16_t*)(ws + WS_SPT) + ((size_t)(b * 8 + h) * 64 + n) * 8192, 64, sL, wid, lane);
    bf16x8 Qf[2][2];
#pragma unroll
    for (int nt = 0; nt < 2; ++nt)
#pragma unroll
        for (int ks = 0; ks < 2; ++ks) Qf[nt][ks] = *(const bf16x8*)(P + (tok0 + 32 * wid + 16 * nt + fr) * LD + C_QR + h * 64 + 32 * ks + 8 * fq);
    wait_vm0(); __syncthreads();
    const float lg2 = ret_lg2(h);
    f32x4 Y[8][2];
#pragma unroll
    for (int m = 0; m < 8; ++m)
#pragma unroll
        for (int nt = 0; nt < 2; ++nt) Y[m][nt] = (f32x4){0.f, 0.f, 0.f, 0.f};
#pragma unroll
    for (int m = 0; m < 8; ++m)
#pragma unroll
        for (int ks = 0; ks < 2; ++ks) {
            const bf16x8 a = lds_frag128(sL, 16 * m + fr, 4 * ks + fq);
#pragma unroll
            for (int nt = 0; nt < 2; ++nt) Y[m][nt] = mfma16(a, Qf[nt][ks], Y[m][nt]);
        }
#pragma unroll
    for (int nt = 0; nt < 2; ++nt) {
        const float sc = exp2f((float)(32 * wid + 16 * nt + fr + 1) * lg2);
#pragma unroll
        for (int m = 0; m < 8; ++m) Y[m][nt] = Y[m][nt] * sc;
    }
#pragma unroll 1
    for (int s = 0; s < 4; ++s) {
        f32x4 St[2][2];
#pragma unroll
        for (int hh = 0; hh < 2; ++hh) {
            const int mt = 2 * s + hh;
#pragma unroll
            for (int nt = 0; nt < 2; ++nt) St[hh][nt] = (f32x4){0.f, 0.f, 0.f, 0.f};
#pragma unroll
            for (int ks = 0; ks < 2; ++ks) {
                const bf16x8 a = lds_frag128(kL, 16 * mt + fr, 4 * ks + fq);
#pragma unroll
                for (int nt = 0; nt < 2; ++nt) St[hh][nt] = mfma16(a, Qf[nt][ks], St[hh][nt]);
            }
#pragma unroll
            for (int nt = 0; nt < 2; ++nt) {
                const int qi = 32 * wid + 16 * nt + fr;
#pragma unroll
                for (int r = 0; r < 4; ++r) {
                    const int kj = 16 * mt + 4 * fq + r;
                    const float dm = qi >= kj ? exp2f((float)(qi - kj) * lg2) : 0.f;
                    St[hh][nt][r] *= dm;
                }
            }
        }
        bf16x8 Pb[2];
#pragma unroll
        for (int nt = 0; nt < 2; ++nt) Pb[nt] = pack8(St[0][nt], St[1][nt]);
#pragma unroll
        for (int m = 0; m < 8; ++m) {
            const bf16x8 a = lds_vfrag256(vL, 16 * m + fr, 32 * s, fq);
#pragma unroll
            for (int nt = 0; nt < 2; ++nt) Y[m][nt] = mfma16(a, Pb[nt], Y[m][nt]);
        }
    }
    bf16_t* YB = (bf16_t*)(ws + WS_YB);
#pragma unroll
    for (int nt = 0; nt < 2; ++nt) {
        float sum = 0.f;
#pragma unroll
        for (int m = 0; m < 8; ++m) sum += Y[m][nt][0] + Y[m][nt][1] + Y[m][nt][2] + Y[m][nt][3];
        sum += __shfl_xor(sum, 16); sum += __shfl_xor(sum, 32);
        const float mu = sum * (1.f / 128.f);
        float vs = 0.f;
#pragma unroll
        for (int m = 0; m < 8; ++m)
#pragma unroll
            for (int r = 0; r < 4; ++r) { const float dlt = Y[m][nt][r] - mu; vs += dlt * dlt; }
        vs += __shfl_xor(vs, 16); vs += __shfl_xor(vs, 32);
        const float rstd = rsqrtf(vs * (1.f / 128.f) + 1e-5f);
        const size_t tk = tok0 + 32 * wid + 16 * nt + fr;
#pragma unroll
        for (int m = 0; m < 8; ++m) {
            const f32x4 gt = unpack4(*(const u32x2*)(P + tk * LD + C_GR + h * 128 + 16 * m + 4 * fq));
            f32x4 v;
#pragma unroll
            for (int r = 0; r < 4; ++r) v[r] = (Y[m][nt][r] - mu) * rstd * gt[r];
            *(u32x2*)(YB + tk * 1024 + h * 128 + 16 * m + 4 * fq) = pack4(v);
        }
    }
}
__device__ void phase_p4(const Params& p, unsigned char* lds) {
    for (int i = threadIdx.x; i < 8192 / 16; i += NTHREADS) ((u32x4*)(lds + NSA_BUCKET))[i] = ((const u32x4*)(p.ws + WS_BUCKET))[i];
    __syncthreads();
    for (int it = blockIdx.x; it < 2048; it += gridDim.x) {
        if (it < 1024) sel_item(p, it < 512 ? it : 1535 - it, lds); else retout_item(p, it - 1024, lds);
    }
}

__device__ void phase_g2(const Params& p, unsigned char* lds) {
    unsigned char* ws = launder(p.ws);
    const bf16_t* P = (const bf16_t*)(ws + WS_P);
    for (int t = blockIdx.x; t < 128 * 8; t += gridDim.x) {
        const int mt = t >> 3, nt = t & 7, m0 = mt * 128, n0 = nt * 128;
        const int tid = threadIdx.x + vzero(), lane = tid & 63, wid = tid >> 6, wr = wid >> 1, wc = wid & 1, fr = lane & 15, fq = lane >> 4;
        const int ldrow = 8 * wid + (lane >> 3), ldc = ((lane & 7) ^ (lane >> 3)) * 8;
        const bf16_t* mp[4]; const bf16_t* np[4];
        bf16_t* MG = (bf16_t*)(ws + WS_MG);
        { f32x4 acc1[4][4]; zero_acc(acc1);
#pragma unroll
        for (int i = 0; i < 4; ++i) { mp[i] = (const bf16_t*)(ws + WS_WA) + (size_t)(n0 + 32 * i + ldrow) * 512 + ldc; np[i] = (const bf16_t*)(ws + WS_YA) + (size_t)(m0 + 32 * i + ldrow) * 512 + ldc; }
        gemm_kloop(mp, np, 8, lds, acc1);
#pragma unroll
        for (int mi = 0; mi < 4; ++mi)
#pragma unroll
            for (int ni = 0; ni < 4; ++ni) {
                const int n = n0 + 64 * wr + 16 * mi + 4 * fq; const size_t tok = m0 + 64 * wc + 16 * ni + fr;
                const f32x4 ga = unpack4(*(const u32x2*)(P + tok * LD + C_MA + n));
                *(u32x2*)(MG + tok * 1024 + n) = pack4(ga * acc1[mi][ni]);
            } }
        { f32x4 acc2[4][4]; zero_acc(acc2);
#pragma unroll
        for (int i = 0; i < 4; ++i) { mp[i] = (const bf16_t*)(ws + WS_WB) + (size_t)(n0 + 32 * i + ldrow) * 1024 + ldc; np[i] = (const bf16_t*)(ws + WS_YB) + (size_t)(m0 + 32 * i + ldrow) * 1024 + ldc; }
        gemm_kloop(mp, np, 16, lds, acc2);
#pragma unroll
        for (int mi = 0; mi < 4; ++mi)
#pragma unroll
            for (int ni = 0; ni < 4; ++ni) {
                const int n = n0 + 64 * wr + 16 * mi + 4 * fq; const size_t tok = m0 + 64 * wc + 16 * ni + fr;
                const f32x4 gb = unpack4(*(const u32x2*)(P + tok * LD + C_MB + n));
                const f32x4 v = unpack4(*(const u32x2*)(MG + tok * 1024 + n)) + gb * acc2[mi][ni];
                *(u32x2*)(MG + tok * 1024 + n) = pack4(v);
            } }
    }
}

__device__ void phase_g3(const Params& p, int layer, unsigned char* lds) {
    unsigned char* ws = launder(p.ws);
    const int tid = threadIdx.x + vzero(), lane = tid & 63, wid = tid >> 6, wr = wid >> 1, wc = wid & 1, fr = lane & 15, fq = lane >> 4;
    const int ldrow = 8 * wid + (lane >> 3), ldc = ((lane & 7) ^ (lane >> 3)) * 8;
    const float* X = layer == 0 ? p.x : (const float*)(ws + WS_X);
    float* H1 = (float*)(ws + WS_H1);
    for (int t = blockIdx.x; t < 128 * 8; t += gridDim.x) {
        const int mt = t >> 3, nt = t & 7, m0 = mt * 128, n0 = nt * 128;
        const bf16_t* mp[4]; const bf16_t* np[4];
        f32x4 acc[4][4]; zero_acc(acc);
#pragma unroll
        for (int i = 0; i < 4; ++i) { mp[i] = (const bf16_t*)(ws + WS_WO) + (size_t)(n0 + 32 * i + ldrow) * 1024 + ldc; np[i] = (const bf16_t*)(ws + WS_MG) + (size_t)(m0 + 32 * i + ldrow) * 1024 + ldc; }
        gemm_kloop(mp, np, 16, lds, acc);
#pragma unroll
        for (int mi = 0; mi < 4; ++mi)
#pragma unroll
            for (int ni = 0; ni < 4; ++ni) {
                const int n = n0 + 64 * wr + 16 * mi + 4 * fq; const size_t tok = m0 + 64 * wc + 16 * ni + fr;
                const f32x4 xv = *(const f32x4*)(X + tok * 1024 + n);
                *(f32x4*)(H1 + tok * 1024 + n) = xv * DN_ALPHA + acc[mi][ni];
            }
    }
}

__device__ void phase_ln1(const Params& p, int layer, unsigned char* lds, bool dry) {
    unsigned char* ws = launder(p.ws);
    const int tid = threadIdx.x + vzero(), lane = tid & 63, wid = tid >> 6;
    float* wrL = (float*)lds;
    {
        float4 wv[16];
#pragma unroll
        for (int k = 0; k < 16; ++k) wv[k] = ((const float4*)p.w_router)[tid + 256 * k];
#pragma unroll
        for (int k = 0; k < 16; ++k) { const int i4 = tid + 256 * k, d = i4 >> 2, e0 = (i4 & 3) * 4;
            wrL[(e0 + 0) * 1024 + d] = wv[k].x; wrL[(e0 + 1) * 1024 + d] = wv[k].y; wrL[(e0 + 2) * 1024 + d] = wv[k].z; wrL[(e0 + 3) * 1024 + d] = wv[k].w; }
    }
    __syncthreads();
    const float* H1 = (const float*)(ws + WS_H1);
    float* X1 = (float*)(ws + WS_X1); bf16_t* X1B = (bf16_t*)(ws + WS_X1B);
    const float* gam = p.ln1_g + layer * 1024; const float* bet = p.ln1_b + layer * 1024;
    unsigned* cnt = (unsigned*)(ws + WS_CTL) + (dry ? 0 : CW_CNT) + layer * 1024;
    int* LIST = (int*)(ws + (dry ? WS_HB : WS_LIST)); float* WTS = (float*)(ws + (dry ? WS_HB + 4194304 : WS_WTS));
    for (int tok = blockIdx.x * 4 + wid; tok < T_; tok += gridDim.x * 4) {
        float4 v[4];
#pragma unroll
        for (int j = 0; j < 4; ++j) v[j] = *(const float4*)(H1 + (size_t)tok * 1024 + 256 * j + 4 * lane);
        float s = 0.f;
#pragma unroll
        for (int j = 0; j < 4; ++j) s += v[j].x + v[j].y + v[j].z + v[j].w;
#pragma unroll
        for (int o = 1; o < 64; o <<= 1) s += __shfl_xor(s, o);
        const float mu = s * (1.f / 1024.f);
        float q = 0.f;
#pragma unroll
        for (int j = 0; j < 4; ++j) { const float a = v[j].x - mu, b2 = v[j].y - mu, c = v[j].z - mu, d = v[j].w - mu; q += a * a + b2 * b2 + c * c + d * d; }
#pragma unroll
        for (int o = 1; o < 64; o <<= 1) q += __shfl_xor(q, o);
        const float rstd = rsqrtf(q * (1.f / 1024.f) + 1e-5f);
        float4 y[4];
#pragma unroll
        for (int j = 0; j < 4; ++j) {
            const int d0 = 256 * j + 4 * lane;
            const float4 gg = *(const float4*)(gam + d0), bb = *(const float4*)(bet + d0);
            y[j].x = (v[j].x - mu) * rstd * gg.x + bb.x; y[j].y = (v[j].y - mu) * rstd * gg.y + bb.y; y[j].z = (v[j].z - mu) * rstd * gg.z + bb.z; y[j].w = (v[j].w - mu) * rstd * gg.w + bb.w;
            *(float4*)(X1 + (size_t)tok * 1024 + d0) = y[j];
            u32x2 w; w.x = pack2(y[j].x, y[j].y); w.y = pack2(y[j].z, y[j].w);
            *(u32x2*)(X1B + (size_t)tok * 1024 + d0) = w;
        }
        float lg[16];
#pragma unroll
        for (int e = 0; e < 16; ++e) {
            float a = 0.f;
#pragma unroll
            for (int j = 0; j < 4; ++j) { const float4 w4 = *(const float4*)(wrL + e * 1024 + 256 * j + 4 * lane); a += y[j].x * w4.x + y[j].y * w4.y + y[j].z * w4.z + y[j].w * w4.w; }
            lg[e] = a;
        }
#pragma unroll
        for (int e = 0; e < 16; ++e) {
#pragma unroll
            for (int o = 1; o < 64; o <<= 1) lg[e] += __shfl_xor(lg[e], o);
        }
        float mx = lg[0];
#pragma unroll
        for (int e = 1; e < 16; ++e) mx = fmaxf(mx, lg[e]);
        float pr[16], ps = 0.f;
#pragma unroll
        for (int e = 0; e < 16; ++e) { pr[e] = expf(lg[e] - mx); ps += pr[e]; }
        const float ips = 1.f / ps;
        float sel[16];
#pragma unroll
        for (int e = 0; e < 16; ++e) { pr[e] *= ips; sel[e] = pr[e] + p.router_bias[e]; }
        int best = 0; float bestv = -1e30f;
#pragma unroll
        for (int gI = 0; gI < 4; ++gI) {
            float a = -1e30f, b2 = -1e30f;
#pragma unroll
            for (int k = 0; k < 4; ++k) { const float x = sel[4 * gI + k]; if (x > a) { b2 = a; a = x; } else if (x > b2) b2 = x; }
            const float gs = a + b2;
            if (gs > bestv) { bestv = gs; best = gI; }
        }
        float s4[4], p4[4];
#pragma unroll
        for (int k = 0; k < 4; ++k) { s4[k] = 0.f; p4[k] = 0.f; }
#pragma unroll
        for (int gI = 0; gI < 4; ++gI) if (gI == best) {
#pragma unroll
            for (int k = 0; k < 4; ++k) { s4[k] = sel[4 * gI + k]; p4[k] = pr[4 * gI + k]; }
        }
        int i0 = 0; float a0 = s4[0];
#pragma unroll
        for (int k = 1; k < 4; ++k) if (s4[k] > a0) { a0 = s4[k]; i0 = k; }
        int i1 = -1; float a1 = -1e30f;
#pragma unroll
        for (int k = 0; k < 4; ++k) if (k != i0 && s4[k] > a1) { a1 = s4[k]; i1 = k; }
        float w0 = 0.f, w1 = 0.f;
#pragma unroll
        for (int k = 0; k < 4; ++k) { if (k == i0) w0 = p4[k]; if (k == i1) w1 = p4[k]; }
        const float iw = 1.f / (w0 + w1);
        if (lane == 0) {
            const int e0 = best * 4 + i0, e1 = best * 4 + i1;
            const unsigned p0 = atomicAdd(&cnt[e0 * 64], 1u), p1 = atomicAdd(&cnt[e1 * 64], 1u);
            LIST[(size_t)e0 * T_ + p0] = tok * 2; LIST[(size_t)e1 * T_ + p1] = tok * 2 + 1;
            WTS[tok * 2] = w0 * iw; WTS[tok * 2 + 1] = w1 * iw;
        }
    }
}

__device__ __forceinline__ bool moe_find(const unsigned* cnt, int t, int colTiles, int& e, int& rt, int& ct, int& cnte, int& off) {
    int base = 0; off = 0;
    for (int k = 0; k < NE; ++k) {
        const int c = __builtin_amdgcn_readfirstlane((int)cnt[k * 64]), nt = ((c + 127) >> 7) * colTiles;
        if (t < base + nt) { e = k; cnte = c; const int u = t - base; rt = u / colTiles; ct = u % colTiles;
            e = __builtin_amdgcn_readfirstlane(e); cnte = __builtin_amdgcn_readfirstlane(cnte); rt = __builtin_amdgcn_readfirstlane(rt);
            ct = __builtin_amdgcn_readfirstlane(ct); off = __builtin_amdgcn_readfirstlane(off); return true; }
        base += nt; off += c;
    }
    return false;
}
__device__ void phase_m2(const Params& p, int layer, unsigned char* lds) {
    unsigned char* ws = launder(p.ws);
    const int tid = threadIdx.x + vzero(), lane = tid & 63, wid = tid >> 6, wr = wid >> 1, wc = wid & 1, fr = lane & 15, fq = lane >> 4;
    const int ldrow = 8 * wid + (lane >> 3), ldc = ((lane & 7) ^ (lane >> 3)) * 8;
    const unsigned* cnt = (const unsigned*)(ws + WS_CTL) + CW_CNT + layer * 1024 + vzero();
    const int* LIST = (const int*)(ws + WS_LIST);
    const bf16_t* X1B = (const bf16_t*)(ws + WS_X1B);
    bf16_t* HB = (bf16_t*)(ws + WS_HB);
    for (int t = blockIdx.x;; t += gridDim.x) {
        int e, rt, ct, cnte, off;
        if (!moe_find(cnt, t, 8, e, rt, ct, cnte, off)) break;
        const bf16_t* mp[4]; const bf16_t* np[4];
#pragma unroll
        for (int i = 0; i < 4; ++i) {
            const int rho = 32 * i + ldrow, blk = rho >> 4, nn = ct * 64 + (blk >> 1) * 16 + (rho & 15);
            mp[i] = (const bf16_t*)(ws + ((blk & 1) ? WS_WU : WS_WG)) + ((size_t)e * 512 + nn) * 1024 + ldc;
            int idx = rt * 128 + rho; idx = idx < cnte ? idx : cnte - 1;
            const int a = LIST[(size_t)e * T_ + idx];
            np[i] = X1B + (size_t)(a >> 1) * 1024 + ldc;
        }
        f32x4 acc[4][4]; zero_acc(acc);
        gemm_kloop(mp, np, 16, lds, acc);
#pragma unroll
        for (int mp2 = 0; mp2 < 2; ++mp2)
#pragma unroll
            for (int ni = 0; ni < 4; ++ni) {
                const int idx = rt * 128 + 64 * wc + 16 * ni + fr;
                if (idx < cnte) {
                    const int n = ct * 64 + (2 * wr + mp2) * 16 + 4 * fq;
                    const f32x4 gv = acc[2 * mp2][ni], uv = acc[2 * mp2 + 1][ni];
                    f32x4 hv;
#pragma unroll
                    for (int r = 0; r < 4; ++r) hv[r] = gv[r] * sigmoidf_(gv[r]) * uv[r];
                    *(u32x2*)(HB + (size_t)(off + idx) * 512 + n) = pack4(hv);
                }
            }
    }
}
__device__ void phase_m3(const Params& p, int layer, unsigned char* lds) {
    unsigned char* ws = launder(p.ws);
    const int tid = threadIdx.x + vzero(), lane = tid & 63, wid = tid >> 6, wr = wid >> 1, wc = wid & 1, fr = lane & 15, fq = lane >> 4;
    const int ldrow = 8 * wid + (lane >> 3), ldc = ((lane & 7) ^ (lane >> 3)) * 8;
    const unsigned* cnt = (const unsigned*)(ws + WS_CTL) + CW_CNT + layer * 1024 + vzero();
    const int* LIST = (const int*)(ws + WS_LIST);
    const bf16_t* HB = (const bf16_t*)(ws + WS_HB);
    bf16_t* CT = (bf16_t*)(ws + WS_CT);
    for (int t = blockIdx.x;; t += gridDim.x) {
        int e, rt, ct, cnte, off;
        if (!moe_find(cnt, t, 8, e, rt, ct, cnte, off)) break;
        const bf16_t* mp[4]; const bf16_t* np[4];
#pragma unroll
        for (int i = 0; i < 4; ++i) {
            const int rho = 32 * i + ldrow;
            mp[i] = (const bf16_t*)(ws + WS_WD) + ((size_t)e * 1024 + ct * 128 + rho) * 512 + ldc;
            int idx = rt * 128 + rho; idx = idx < cnte ? idx : cnte - 1;
            np[i] = HB + (size_t)(off + idx) * 512 + ldc;
        }
        f32x4 acc[4][4]; zero_acc(acc);
        gemm_kloop(mp, np, 8, lds, acc);
#pragma unroll
        for (int ni = 0; ni < 4; ++ni) {
            const int idx = rt * 128 + 64 * wc + 16 * ni + fr;
            if (idx < cnte) {
                const int a = LIST[(size_t)e * T_ + idx];
#pragma unroll
                for (int mi = 0; mi < 4; ++mi) {
                    const int n = ct * 128 + 64 * wr + 16 * mi + 4 * fq;
                    *(u32x2*)(CT + (size_t)a * 1024 + n) = pack4(acc[mi][ni]);
                }
            }
        }
    }
}

__device__ void phase_ln2(const Params& p, int layer) {
    unsigned char* ws = launder(p.ws);
    const int tid = threadIdx.x + vzero(), lane = tid & 63, wid = tid >> 6;
    const float* X1 = (const float*)(ws + WS_X1); const bf16_t* CT = (const bf16_t*)(ws + WS_CT); const float* WTS = (const float*)(ws + WS_WTS);
    float* XO = layer == NLAYER - 1 ? p.out : (float*)(ws + WS_X); bf16_t* XB = (bf16_t*)(ws + WS_XB);
    const float* gam = p.ln2_g + layer * 1024; const float* bet = p.ln2_b + layer * 1024;
    for (int tok = blockIdx.x * 4 + wid; tok < T_; tok += gridDim.x * 4) {
        const float w0 = WTS[tok * 2 + vzero()], w1 = WTS[tok * 2 + 1 + vzero()];
        float4 v[4];
#pragma unroll
        for (int j = 0; j < 4; ++j) {
            const int d0 = 256 * j + 4 * lane;
            const float4 xv = *(const float4*)(X1 + (size_t)tok * 1024 + d0);
            const f32x4 c0 = unpack4(*(const u32x2*)(CT + (size_t)(tok * 2) * 1024 + d0)), c1 = unpack4(*(const u32x2*)(CT + (size_t)(tok * 2 + 1) * 1024 + d0));
            v[j].x = xv.x * DN_ALPHA + w0 * c0[0] + w1 * c1[0]; v[j].y = xv.y * DN_ALPHA + w0 * c0[1] + w1 * c1[1];
            v[j].z = xv.z * DN_ALPHA + w0 * c0[2] + w1 * c1[2]; v[j].w = xv.w * DN_ALPHA + w0 * c0[3] + w1 * c1[3];
        }
        float s = 0.f;
#pragma unroll
        for (int j = 0; j < 4; ++j) s += v[j].x + v[j].y + v[j].z + v[j].w;
#pragma unroll
        for (int o = 1; o < 64; o <<= 1) s += __shfl_xor(s, o);
        const float mu = s * (1.f / 1024.f);
        float q = 0.f;
#pragma unroll
        for (int j = 0; j < 4; ++j) { const float a = v[j].x - mu, b2 = v[j].y - mu, c = v[j].z - mu, d = v[j].w - mu; q += a * a + b2 * b2 + c * c + d * d; }
#pragma unroll
        for (int o = 1; o < 64; o <<= 1) q += __shfl_xor(q, o);
        const float rstd = rsqrtf(q * (1.f / 1024.f) + 1e-5f);
#pragma unroll
        for (int j = 0; j < 4; ++j) {
            const int d0 = 256 * j + 4 * lane;
            const float4 gg = *(const float4*)(gam + d0), bb = *(const float4*)(bet + d0);
            float4 y; y.x = (v[j].x - mu) * rstd * gg.x + bb.x; y.y = (v[j].y - mu) * rstd * gg.y + bb.y; y.z = (v[j].z - mu) * rstd * gg.z + bb.z; y.w = (v[j].w - mu) * rstd * gg.w + bb.w;
            *(float4*)(XO + (size_t)tok * 1024 + d0) = y;
            u32x2 w; w.x = pack2(y.x, y.y); w.y = pack2(y.z, y.w);
            *(u32x2*)(XB + (size_t)tok * 1024 + d0) = w;
        }
    }
}

#define XB_TMO      128
#define XB_XCNT(j)  (256  + 64 * (j))
#define XB_XSUB(j)  (1280 + 64 * (j))
#define XB_XGEN(j)  (2304 + 64 * (j))
#define XB_TOP      3328
#define XB_TOPGEN   3392
#define XCD_BAR_WORDS 3456
#define XB_SPIN_CAP (1u << 22)
#define LAS __attribute__((address_space(3)))
__device__ __forceinline__ unsigned xb_ld(unsigned* p)              { return __hip_atomic_load(p, __ATOMIC_RELAXED, __HIP_MEMORY_SCOPE_AGENT); }
__device__ __forceinline__ unsigned xb_add(unsigned* p, unsigned v) { return __hip_atomic_fetch_add(p, v, __ATOMIC_RELAXED, __HIP_MEMORY_SCOPE_AGENT); }
__device__ __forceinline__ unsigned xb_xcc_id() { return (unsigned)__builtin_amdgcn_s_getreg((3 << 11) | 20) & 0xFu; }
#define XB_SPIN(cond, bar) do { unsigned _sp = 0; while (cond) { __builtin_amdgcn_s_sleep(1); \
    if ((++_sp & 255u) == 0u) { if (xb_ld(&(bar)[XB_TMO])) break; if (_sp > XB_SPIN_CAP) { atomicAdd(&(bar)[XB_TMO], 1u); break; } } } } while (0)
struct XcdBarrier { unsigned* bar; unsigned x; volatile LAS unsigned* st; };
__device__ __forceinline__ XcdBarrier xcd_barrier_post(unsigned* bar, volatile LAS unsigned* st) {
    XcdBarrier b; b.bar = bar; b.x = xb_xcc_id(); b.st = st;
    if (threadIdx.x == 0) (void)xb_add(&bar[XB_XCNT(b.x)], 1u);
    return b;
}
__device__ __forceinline__ void xcd_barrier_complete(unsigned* bar, unsigned x, unsigned& nloc, unsigned& nx) {
    const unsigned G = gridDim.x * gridDim.y * gridDim.z;
    unsigned sum, cnt, mine, sp = 0u;
    for (;;) {
        sum = 0u; cnt = 0u; mine = 0u;
#pragma unroll
        for (unsigned j = 0; j < 16; ++j) { const unsigned c = xb_ld(&bar[XB_XCNT(j)]); sum += c; cnt += (c > 0u) ? 1u : 0u; mine = (j == x) ? c : mine; }
        if (sum == G) break;
        __builtin_amdgcn_s_sleep(1);
        if ((++sp & 255u) == 0u) { if (xb_ld(&bar[XB_TMO])) break; if (sp > XB_SPIN_CAP) { atomicAdd(&bar[XB_TMO], 1u); break; } }
    }
    nloc = mine > 0u ? mine : 1u; nx = cnt > 0u ? cnt : 1u;
}
__device__ __forceinline__ void xcd_barrier(const XcdBarrier& b) {
    asm volatile("s_waitcnt vmcnt(0)" ::: "memory");
    __syncthreads();
    if (threadIdx.x == 0) {
        unsigned* bar = b.bar;
        __builtin_amdgcn_s_waitcnt(0);
        unsigned nloc = b.st[0], nx = b.st[1];
        if (nloc == 0u) { xcd_barrier_complete(bar, b.x, nloc, nx); b.st[0] = nloc; b.st[1] = nx; }
        const unsigned old = xb_add(&bar[XB_XSUB(b.x)], 1u);
        const unsigned gen = old / nloc;
        if (old + 1u == (gen + 1u) * nloc) {
            __builtin_amdgcn_fence(__ATOMIC_RELEASE, "agent");
            asm volatile("s_waitcnt vmcnt(0)" ::: "memory");
            const unsigned og = xb_add(&bar[XB_TOP], 1u);
            const unsigned tg = og / nx;
            if (og + 1u == (tg + 1u) * nx) xb_add(&bar[XB_TOPGEN], 1u);
            else XB_SPIN(xb_ld(&bar[XB_TOPGEN]) == tg, bar);
            __builtin_amdgcn_fence(__ATOMIC_ACQUIRE, "agent");
            xb_add(&bar[XB_XGEN(b.x)], 1u);
            asm volatile("s_waitcnt vmcnt(0)" ::: "memory");
        } else {
            XB_SPIN(xb_ld(&bar[XB_XGEN(b.x)]) == gen, bar);
            __builtin_amdgcn_fence(__ATOMIC_ACQUIRE, "agent");
            asm volatile("s_waitcnt vmcnt(0)" ::: "memory");
        }
    }
    __syncthreads();
}

constexpr int PH_PER_LAYER = 11, N_PHASES = PH_PER_LAYER * NLAYER;
__global__ void __launch_bounds__(NTHREADS, 2) mega(Params p) {
    extern __shared__ __attribute__((aligned(16))) unsigned char lds[];
#if SINGLE_LAUNCH
    volatile LAS unsigned* xbw = (volatile LAS unsigned*)(lds + LDS_BYTES - 16);
    if (threadIdx.x < 4) xbw[threadIdx.x] = 0u;
    __syncthreads();
    XcdBarrier xbar = xcd_barrier_post((unsigned*)(p.ws + WS_CTL) + CW_BAR, xbw);
#endif
    for (int ph = p.ph_lo; ph < p.ph_hi; ++ph) {
        const int layer = ph / PH_PER_LAYER, k = ph % PH_PER_LAYER;
#ifdef ONLY_PHASE
        if (k != ONLY_PHASE) continue;
#endif
#ifdef REPEAT_MASK
        for (int rep = 0; rep < (((REPEAT_MASK) >> k) & 1) + 1; ++rep) {
        if (rep) __syncthreads();
#endif
        switch (k) {
            case 0: phase_pw(p, layer, lds); break;
            case 1: phase_g1(p, layer, lds); break;
            case 2: phase_p2(p, layer, lds); break;
            case 3: phase_p3(p, lds); break;
            case 4: phase_p4(p, lds); break;
            case 5: phase_g2(p, lds); break;
            case 6: phase_g3(p, layer, lds); break;
#ifdef REPEAT_MASK
            case 7: phase_ln1(p, layer, lds, (((REPEAT_MASK) >> 7) & 1) && rep == 0); break;
#else
            case 7: phase_ln1(p, layer, lds, false); break;
#endif
            case 8: phase_m2(p, layer, lds); break;
            case 9: phase_m3(p, layer, lds); break;
            case 10: phase_ln2(p, layer); break;
        }
#ifdef REPEAT_MASK
        }
#endif
#if SINGLE_LAUNCH
        if (ph + 1 < p.ph_hi) { if (ph == p.ph_lo) cg::this_grid().sync(); else xcd_barrier(xbar); }
#endif
    }
}

extern "C" void kernel_launch(void* const* d_in, const int* in_sizes, int n_in, void* d_out, int out_size, void* d_ws, size_t ws_size, hipStream_t stream) {
    static int grid = 0;
    if (grid == 0) {
        if (n_in != 18 || ws_size < WS_END) { fprintf(stderr, "kernel_launch: unexpected n_in %d or ws_size %zu < %zu\n", n_in, ws_size, (size_t)WS_END); grid = -1; return; }
        int dev = 0, cus = 0, per_cu = 0;
        hipGetDevice(&dev); hipDeviceGetAttribute(&cus, hipDeviceAttributeMultiprocessorCount, dev);
        hipFuncSetAttribute((const void*)mega, hipFuncAttributeMaxDynamicSharedMemorySize, LDS_BYTES);
        hipOccupancyMaxActiveBlocksPerMultiprocessor(&per_cu, (const void*)mega, NTHREADS, LDS_BYTES);
        if (per_cu < 1) per_cu = 1;
        if (per_cu > 2) per_cu = 2;
        grid = cus * per_cu;
        (void)hipGetLastError();
    }
    if (grid < 0) return;
    Params p{};
    p.x = (const float*)d_in[0]; p.w_in = (const float*)d_in[1]; p.cmp_pos = (const float*)d_in[2]; p.cmp_w1 = (const float*)d_in[3]; p.cmp_w2 = (const float*)d_in[4];
    p.w_br_a = (const float*)d_in[5]; p.w_br_b = (const float*)d_in[6]; p.w_o = (const float*)d_in[7]; p.ln1_g = (const float*)d_in[8]; p.ln1_b = (const float*)d_in[9];
    p.w_router = (const float*)d_in[10]; p.router_bias = (const float*)d_in[11]; p.w_gate = (const float*)d_in[12]; p.w_up = (const float*)d_in[13]; p.w_down = (const float*)d_in[14];
    p.ln2_g = (const float*)d_in[15]; p.ln2_b = (const float*)d_in[16]; p.rel_bias = (const float*)d_in[17];
    p.out = (float*)d_out; p.ws = (unsigned char*)d_ws;
#if SINGLE_LAUNCH
    hipMemsetAsync((unsigned char*)d_ws + WS_CTL + (size_t)CW_BAR * 4, 0, XCD_BAR_WORDS * 4, stream);
    p.ph_lo = 0; p.ph_hi = N_PHASES;
    void* args[] = {&p};
    hipError_t e = hipLaunchCooperativeKernel((const void*)mega, dim3(grid), dim3(NTHREADS), args, LDS_BYTES, stream);
    if (e != hipSuccess) fprintf(stderr, "cooperative launch failed: %s (grid %d)\n", hipGetErrorString(e), grid);
#else
    for (int ph = 0; ph < N_PHASES; ++ph) {
        p.ph_lo = ph; p.ph_hi = ph + 1;
        hipLaunchKernelGGL(mega, dim3(grid), dim3(NTHREADS), LDS_BYTES, stream, p);
    }
#endif
}
```

```cpp
#include <hip/hip_runtime.h>
#include <hip/hip_cooperative_groups.h>
#include <cstdio>
#include <cstdint>
namespace cg = cooperative_groups;

#ifndef SINGLE_LAUNCH
#define SINGLE_LAUNCH 1
#endif

typedef unsigned short bf16_t;
typedef short bf16x8 __attribute__((ext_vector_type(8)));
typedef float f32x4 __attribute__((ext_vector_type(4)));
typedef unsigned u32x2 __attribute__((ext_vector_type(2)));
typedef unsigned u32x4 __attribute__((ext_vector_type(4)));

constexpr int B_ = 2, S_ = 8192, D_ = 1024, T_ = B_ * S_, NLAYER = 4;
constexpr int DIN = 6424;
constexpr int LD = 6528;
constexpr int C_QA = 0, C_KC = 512, C_VC = 640, C_KS = 768, C_VS = 896, C_KW = 1024, C_VW = 1152, C_QR = 1280, C_KR = 1792,
              C_VR = 2304, C_GR = 3328, C_MA = 4352, C_MB = 5376, C_GA = 6400;
constexpr float DN_ALPHA = 1.681792830507429f;
constexpr int NE = 16;

constexpr size_t al256(size_t x) { return (x + 255) & ~(size_t)255; }
constexpr size_t WS_CTL = 0;
constexpr size_t WS_BUCKET = 65536;
constexpr size_t WS_ROPE = WS_BUCKET + 8192;
constexpr size_t WS_WIN = WS_ROPE + (size_t)8192 * 32 * 8;
constexpr size_t WS_WA = WS_WIN + (size_t)LD * 1024 * 2;
constexpr size_t WS_WB = WS_WA + (size_t)1024 * 512 * 2;
constexpr size_t WS_WO = WS_WB + (size_t)1024 * 1024 * 2;
constexpr size_t WS_WG = WS_WO + (size_t)1024 * 1024 * 2;
constexpr size_t WS_WU = WS_WG + (size_t)16 * 512 * 1024 * 2;
constexpr size_t WS_WD = WS_WU + (size_t)16 * 512 * 1024 * 2;
constexpr size_t WS_XB = WS_WD + (size_t)16 * 512 * 1024 * 2;
constexpr size_t WS_X = WS_XB + (size_t)T_ * 1024 * 2;
constexpr size_t WS_MG = WS_X + (size_t)T_ * 1024 * 4;
constexpr size_t WS_KCC = WS_MG + (size_t)T_ * 1024 * 2;
constexpr size_t WS_VCCT = WS_KCC + (size_t)4 * 512 * 64 * 2;
constexpr size_t WS_W1T = WS_VCCT + (size_t)4 * 512 * 64 * 2;
constexpr size_t WS_B1 = WS_W1T + (size_t)2 * 64 * 2048 * 2;
constexpr size_t WS_R = WS_B1 + 1024;
constexpr size_t WS_P = WS_R;
constexpr size_t WS_VST = WS_P + (size_t)T_ * LD * 2;
constexpr size_t WS_VWT = WS_VST + (size_t)4 * 64 * S_ * 2;
constexpr size_t WS_VRT = WS_VWT + (size_t)4 * 64 * S_ * 2;
constexpr size_t WS_KVT = WS_VRT + (size_t)16 * 128 * S_ * 2;
constexpr size_t WS_SPT = WS_KVT + (size_t)16 * 64 * 8192 * 4;
constexpr size_t WS_YC = WS_SPT + (size_t)16 * 64 * 8192 * 2;
constexpr size_t WS_YW = WS_YC + (size_t)T_ * 512 * 2;
constexpr size_t WS_YA = WS_YW + (size_t)T_ * 512 * 2;
constexpr size_t WS_YB = WS_YA + (size_t)T_ * 512 * 2;
constexpr size_t WS_SELW = WS_YB + (size_t)T_ * 1024 * 2;
constexpr size_t WS_ENDA = WS_SELW + (size_t)T_ * 2 * 4 * 4;
constexpr size_t WS_H1 = WS_R;
constexpr size_t WS_X1 = WS_H1 + (size_t)T_ * 1024 * 4;
constexpr size_t WS_X1B = WS_X1 + (size_t)T_ * 1024 * 4;
constexpr size_t WS_HB = WS_X1B + (size_t)T_ * 1024 * 2;
constexpr size_t WS_CT = WS_P + (size_t)T_ * LD * 2;
constexpr size_t WS_LIST = WS_CT + (size_t)2 * T_ * 1024 * 2;
constexpr size_t WS_WTS = WS_LIST + (size_t)16 * T_ * 4;
constexpr size_t WS_ENDB = WS_WTS + (size_t)2 * T_ * 4;
static_assert(WS_HB + (size_t)2 * T_ * 512 * 2 <= WS_CT, "view B overlap");
constexpr size_t WS_END = WS_ENDA > WS_ENDB ? WS_ENDA : WS_ENDB;

constexpr int CW_CNT = 4096;
constexpr int CW_BAR = 8192;

constexpr int LDS_BYTES = 75776;
constexpr int NTHREADS = 256;

struct Params {
    const float* x; const float* w_in; const float* cmp_pos; const float* cmp_w1; const float* cmp_w2;
    const float* w_br_a; const float* w_br_b; const float* w_o; const float* ln1_g; const float* ln1_b;
    const float* w_router; const float* router_bias; const float* w_gate; const float* w_up; const float* w_down;
    const float* ln2_g; const float* ln2_b; const float* rel_bias;
    float* out; unsigned char* ws;
    int ph_lo, ph_hi;
};

__device__ __forceinline__ bf16_t f2bf(float f) { unsigned u = __float_as_uint(f); u += 0x7fffu + ((u >> 16) & 1u); return (bf16_t)(u >> 16); }
__device__ __forceinline__ float bf2f(unsigned h) { return __uint_as_float(h << 16); }
__device__ __forceinline__ unsigned pack2(float lo, float hi) { return (unsigned)f2bf(lo) | ((unsigned)f2bf(hi) << 16); }
__device__ __forceinline__ u32x2 pack4(f32x4 v) { u32x2 r; r.x = pack2(v[0], v[1]); r.y = pack2(v[2], v[3]); return r; }
__device__ __forceinline__ f32x4 unpack4(u32x2 u) { f32x4 r; r[0] = bf2f(u.x & 0xffffu); r[1] = bf2f(u.x >> 16); r[2] = bf2f(u.y & 0xffffu); r[3] = bf2f(u.y >> 16); return r; }
__device__ __forceinline__ float sigmoidf_(float x) { return 1.f / (1.f + __expf(-x)); }
__device__ __forceinline__ int vzero() { int z; asm volatile("v_mov_b32 %0, 0" : "=v"(z)); return z; }
__device__ __forceinline__ unsigned char* launder(unsigned char* q) { asm volatile("" : "+s"(q)); return q; }
__device__ __forceinline__ void wait_vm0() { asm volatile("s_waitcnt vmcnt(0)" ::: "memory"); }

__device__ __forceinline__ void glds16(const void* g, void* l) {
    __builtin_amdgcn_global_load_lds((const __attribute__((address_space(1))) unsigned*)g,
                                     (__attribute__((address_space(3))) unsigned*)l, 16, 0, 0);
}
__device__ __forceinline__ f32x4 mfma16(bf16x8 a, bf16x8 b, f32x4 c) { return __builtin_amdgcn_mfma_f32_16x16x32_bf16(a, b, c, 0, 0, 0); }

__device__ __forceinline__ void gemm_stage(const bf16_t* const (&mp)[4], const bf16_t* const (&np)[4], int kt, unsigned char* st, int wid) {
#pragma unroll
    for (int i = 0; i < 4; ++i) {
        glds16(mp[i] + kt * 64, st + (4 * i + wid) * 1024);
        glds16(np[i] + kt * 64, st + 16384 + (4 * i + wid) * 1024);
    }
}
__device__ __forceinline__ void gemm_compute(const unsigned char* st, f32x4 (&acc)[4][4], int wr, int wc, int fr, int fq) {
#pragma unroll
    for (int ks = 0; ks < 2; ++ks) {
        bf16x8 a[4], b[4];
        const int sw = ((4 * ks + fq) ^ (fr & 7)) << 4;
#pragma unroll
        for (int i = 0; i < 4; ++i) {
            a[i] = *(const bf16x8*)(st + (64 * wr + 16 * i + fr) * 128 + sw);
            b[i] = *(const bf16x8*)(st + 16384 + (64 * wc + 16 * i + fr) * 128 + sw);
        }
#pragma unroll
        for (int i = 0; i < 4; ++i)
#pragma unroll
            for (int j = 0; j < 4; ++j) acc[i][j] = mfma16(a[i], b[j], acc[i][j]);
    }
}
#define WAIT_V(n) asm volatile("s_waitcnt vmcnt(%0)" ::"n"(n) : "memory")
#define RAW_BARRIER() do { asm volatile("s_waitcnt lgkmcnt(0)" ::: "memory"); __builtin_amdgcn_s_barrier(); } while (0)
__device__ __forceinline__ void gemm_kloop(const bf16_t* const (&mp)[4], const bf16_t* const (&np)[4], int nk, unsigned char* lds, f32x4 (&acc)[4][4]) {
    const int tid = threadIdx.x, lane = tid & 63, wid = tid >> 6, wr = wid >> 1, wc = wid & 1, fr = lane & 15, fq = lane >> 4;
    gemm_stage(mp, np, 0, lds, wid);
    gemm_stage(mp, np, 1, lds + 32768, wid);
    for (int kt = 0; kt < nk; ++kt) {
        unsigned char* cur = lds + (kt & 1) * 32768;
        if (kt + 1 < nk) WAIT_V(8); else WAIT_V(0);
        RAW_BARRIER();
        bf16x8 a[2][4], b[2][4];
#pragma unroll
        for (int ks = 0; ks < 2; ++ks) {
            const int sw = ((4 * ks + fq) ^ (fr & 7)) << 4;
#pragma unroll
            for (int i = 0; i < 4; ++i) {
                a[ks][i] = *(const bf16x8*)(cur + (64 * wr + 16 * i + fr) * 128 + sw);
                b[ks][i] = *(const bf16x8*)(cur + 16384 + (64 * wc + 16 * i + fr) * 128 + sw);
            }
        }
        RAW_BARRIER();
        if (kt + 2 < nk) gemm_stage(mp, np, kt + 2, cur, wid);
#pragma unroll
        for (int ks = 0; ks < 2; ++ks)
#pragma unroll
            for (int i = 0; i < 4; ++i)
#pragma unroll
                for (int j = 0; j < 4; ++j) acc[i][j] = mfma16(a[ks][i], b[ks][j], acc[i][j]);
    }
    __syncthreads();
}
__device__ __forceinline__ void zero_acc(f32x4 (&acc)[4][4]) {
#pragma unroll
    for (int i = 0; i < 4; ++i)
#pragma unroll
        for (int j = 0; j < 4; ++j) acc[i][j] = (f32x4){0.f, 0.f, 0.f, 0.f};
}

__device__ void tcvt_tile(const float* src, int ld_src, int k0, int n0, int mode, bf16_t* dst, int kdst, unsigned char* lds) {
    float* tile = (float*)lds;
    const int tid = threadIdx.x + vzero();
#pragma unroll
    for (int i = 0; i < 4; ++i) {
        const int kk = (tid >> 4) + 16 * i, c4 = (tid & 15) * 4, cd = n0 + c4;
        int orig = cd; bool ok = true;
        if (mode == 1) { if (cd < 1280) orig = cd; else if (cd < 6400) orig = cd + 24; else if (cd < 6424) orig = cd - 6400 + 1280; else ok = false; }
        float4 v = make_float4(0.f, 0.f, 0.f, 0.f);
        if (ok) v = *(const float4*)(src + (size_t)(k0 + kk) * ld_src + orig);
        tile[kk * 65 + c4 + 0] = v.x; tile[kk * 65 + c4 + 1] = v.y; tile[kk * 65 + c4 + 2] = v.z; tile[kk * 65 + c4 + 3] = v.w;
    }
    __syncthreads();
#pragma unroll
    for (int i = 0; i < 2; ++i) {
        const int q = tid + 256 * i, n = q >> 3, kc = q & 7;
        float v[8];
#pragma unroll
        for (int j = 0; j < 8; ++j) v[j] = tile[(kc * 8 + j) * 65 + n];
        u32x4 w; w.x = pack2(v[0], v[1]); w.y = pack2(v[2], v[3]); w.z = pack2(v[4], v[5]); w.w = pack2(v[6], v[7]);
        *(u32x4*)(dst + (size_t)(n0 + n) * kdst + k0 + kc * 8) = w;
    }
    __syncthreads();
}

__device__ void phase_pw(const Params& p, int layer, unsigned char* lds) {
    const int bid = blockIdx.x, nblk = gridDim.x, tid = threadIdx.x + vzero();
    unsigned char* ws = launder(p.ws);
    constexpr int J0 = 16 * 102, J1 = 8 * 16, J2 = 256, J3 = 256, J4 = 2048, J5 = 2048, J6 = 2048, JT = J0 + J1 + J2 + J3 + J4 + J5 + J6;
    for (int t = bid; t < JT; t += nblk) {
        int u = t;
        if (u < J0) { tcvt_tile(p.w_in + (size_t)layer * 1024 * DIN, DIN, (u % 16) * 64, (u / 16) * 64, 1, (bf16_t*)(ws + WS_WIN), 1024, lds); continue; }
        u -= J0;
        if (u < J1) { tcvt_tile(p.w_br_a + (size_t)layer * 512 * 1024, 1024, (u % 8) * 64, (u / 8) * 64, 0, (bf16_t*)(ws + WS_WA), 512, lds); continue; }
        u -= J1;
        if (u < J2) { tcvt_tile(p.w_br_b + (size_t)layer * 1024 * 1024, 1024, (u % 16) * 64, (u / 16) * 64, 0, (bf16_t*)(ws + WS_WB), 1024, lds); continue; }
        u -= J2;
        if (u < J3) { tcvt_tile(p.w_o + (size_t)layer * 1024 * 1024, 1024, (u % 16) * 64, (u / 16) * 64, 0, (bf16_t*)(ws + WS_WO), 1024, lds); continue; }
        u -= J3;
        if (u < J4 + J5) {
            const bool up = u >= J4; if (up) u -= J4;
            const int e = u / 128, v = u % 128;
            const float* src = (up ? p.w_up : p.w_gate) + ((size_t)layer * NE + e) * 1024 * 512;
            tcvt_tile(src, 512, (v % 16) * 64, (v / 16) * 64, 0, (bf16_t*)(ws + (up ? WS_WU : WS_WG)) + (size_t)e * 512 * 1024, 1024, lds); continue;
        }
        u -= J4 + J5;
        { const int e = u / 128, v = u % 128;
          const float* src = p.w_down + ((size_t)layer * NE + e) * 512 * 1024;
          tcvt_tile(src, 1024, (v % 8) * 64, (v / 8) * 64, 0, (bf16_t*)(ws + WS_WD) + (size_t)e * 1024 * 512, 512, lds); }
    }
    for (int t = bid; t < 64; t += nblk) {
        const int kv = t >> 5, kt = t & 31;
        tcvt_tile(p.cmp_w1 + ((size_t)layer * 2 + kv) * 2048 * 64, 64, kt * 64, 0, 0, (bf16_t*)(ws + WS_W1T) + (size_t)kv * 64 * 2048, 2048, lds);
    }
    if (bid >= nblk - 2) {
        const int kv = nblk - 1 - bid, n = tid & 63, part = tid >> 6;
        const float* w1 = p.cmp_w1 + ((size_t)layer * 2 + kv) * 2048 * 64; const float* pos = p.cmp_pos + ((size_t)layer * 2 + kv) * 2048;
        float a = 0.f;
        for (int k = part * 512; k < part * 512 + 512; ++k) a += pos[k] * w1[(size_t)k * 64 + n];
        float* red = (float*)lds;
        __syncthreads(); red[tid] = a; __syncthreads();
        if (tid < 64) ((float*)(ws + WS_B1))[kv * 64 + tid] = red[tid] + red[tid + 64] + red[tid + 128] + red[tid + 192];
        __syncthreads();
    }
    if (layer == 0) {
        const float4* xs = (const float4*)p.x; u32x2* xb = (u32x2*)(ws + WS_XB);
        for (size_t i = (size_t)bid * NTHREADS + tid; i < (size_t)T_ * 1024 / 4; i += (size_t)nblk * NTHREADS) {
            float4 v = xs[i]; u32x2 w; w.x = pack2(v.x, v.y); w.y = pack2(v.z, v.w); xb[i] = w;
        }
        for (int n = bid * NTHREADS + tid; n < 8192; n += nblk * NTHREADS) {
            int bk;
            if (n < 16) bk = n;
            else { const int th[15] = {22, 30, 40, 54, 73, 99, 134, 182, 246, 332, 450, 609, 825, 1117, 1513}; bk = 16;
#pragma unroll
                for (int k = 0; k < 15; ++k) bk += (n >= th[k]) ? 1 : 0; }
            (ws + WS_BUCKET)[n] = (unsigned char)bk;
        }
        for (int i = bid * NTHREADS + tid; i < 8192 * 32; i += nblk * NTHREADS) {
            const int pos = i >> 5, d = i & 31;
            const float inv = powf(10000.f, -(float)d * 2.0f / 64.f);
            const float ang = (float)pos * inv;
            float sn, cs; sincosf(ang, &sn, &cs);
            ((float2*)(ws + WS_ROPE))[i] = make_float2(cs, sn);
        }
        if (bid == 0) for (int i = tid; i < 8192; i += NTHREADS) ((unsigned*)(ws + WS_CTL))[i] = 0u;
    }
}

__device__ void phase_g1(const Params& p, int layer, unsigned char* lds) {
    unsigned char* ws = launder(p.ws);
    const bf16_t* XB = (const bf16_t*)(ws + WS_XB);
    const bf16_t* WT = (const bf16_t*)(ws + WS_WIN);
    bf16_t* P = (bf16_t*)(ws + WS_P);
    const int tid = threadIdx.x + vzero(), lane = tid & 63, wid = tid >> 6, wr = wid >> 1, wc = wid & 1, fr = lane & 15, fq = lane >> 4;
    const int ldrow = 8 * wid + (lane >> 3), ldc = ((lane & 7) ^ (lane >> 3)) * 8;
    const float2* rope = (const float2*)(ws + WS_ROPE);
    const int xcd = blockIdx.x & 7, slot = blockIdx.x >> 3, per = gridDim.x >> 3;
    for (int i = slot; i < 816; i += per) {
        int mt, nt;
        if (i < 768) { mt = i / 6; nt = xcd + 8 * (i % 6); } else { const int u = i - 768; mt = 16 * xcd + u / 3; nt = 48 + u % 3; }
        const int m0 = mt * 128, n0 = nt * 128;
        const bool transposed = (nt == 7) || (nt == 9) || (nt >= 18 && nt <= 25);
        const bf16_t* mp[4]; const bf16_t* np[4];
#pragma unroll
        for (int i = 0; i < 4; ++i) {
            const bf16_t* wrow = WT + (size_t)(n0 + 32 * i + ldrow) * 1024 + ldc;
            const bf16_t* xrow = XB + (size_t)(m0 + 32 * i + ldrow) * 1024 + ldc;
            mp[i] = transposed ? xrow : wrow; np[i] = transposed ? wrow : xrow;
        }
        f32x4 acc[4][4]; zero_acc(acc);
        gemm_kloop(mp, np, 16, lds, acc);
        if (!transposed) {
            const int kind = (nt >= 10 && nt <= 13) ? 1 : (nt >= 14 && nt <= 17) ? 2 : (nt >= 26 && nt <= 33) ? 3 : (nt >= 34) ? 4 : 0;
            if (kind == 1 || kind == 2) {
                const float sc = (kind == 2) ? 0.125f : 1.0f;
#pragma unroll
                for (int ni = 0; ni < 4; ++ni) {
                    const int tok = m0 + 64 * wc + 16 * ni + fr, pos = tok & (S_ - 1);
#pragma unroll
                    for (int mi = 0; mi < 2; ++mi) {
                        const int d = 16 * mi + 4 * fq;
                        const float4 cs01 = *(const float4*)(rope + pos * 32 + d), cs23 = *(const float4*)(rope + pos * 32 + d + 2);
                        const float c[4] = {cs01.x, cs01.z, cs23.x, cs23.z}, s[4] = {cs01.y, cs01.w, cs23.y, cs23.w};
                        f32x4 x1 = acc[mi][ni], x2 = acc[mi + 2][ni], y1, y2;
#pragma unroll
                        for (int r = 0; r < 4; ++r) { y1[r] = (x1[r] * c[r] - x2[r] * s[r]) * sc; y2[r] = (x1[r] * s[r] + x2[r] * c[r]) * sc; }
                        acc[mi][ni] = y1; acc[mi + 2][ni] = y2;
                    }
                }
            }
#pragma unroll
            for (int mi = 0; mi < 4; ++mi)
#pragma unroll
                for (int ni = 0; ni < 4; ++ni) {
                    const int n = n0 + 64 * wr + 16 * mi + 4 * fq, tok = m0 + 64 * wc + 16 * ni + fr;
                    f32x4 v = acc[mi][ni];
                    if (kind == 3) {
#pragma unroll
                        for (int r = 0; r < 4; ++r) v[r] = v[r] * sigmoidf_(v[r]);
                    } else if (kind == 4) {
#pragma unroll
                        for (int r = 0; r < 4; ++r) v[r] = sigmoidf_(v[r]);
                    }
                    *(u32x2*)(P + (size_t)tok * LD + n) = pack4(v);
                }
        } else {
#pragma unroll
            for (int mi = 0; mi < 4; ++mi)
#pragma unroll
                for (int ni = 0; ni < 4; ++ni) {
                    const int tok = m0 + 64 * wr + 16 * mi + 4 * fq, n = n0 + 64 * wc + 16 * ni + fr;
                    const int b = tok >> 13, s = tok & (S_ - 1);
                    bf16_t* dst;
                    if (nt == 7) { const int c = n - C_VS; dst = (bf16_t*)(ws + WS_VST) + ((size_t)(b * 2 + (c >> 6)) * 64 + (c & 63)) * S_ + s; }
                    else if (nt == 9) { const int c = n - C_VW; dst = (bf16_t*)(ws + WS_VWT) + ((size_t)(b * 2 + (c >> 6)) * 64 + (c & 63)) * S_ + s; }
                    else { const int c = n - C_VR; dst = (bf16_t*)(ws + WS_VRT) + ((size_t)(b * 8 + (c >> 7)) * 128 + (c & 127)) * S_ + s; }
                    *(u32x2*)dst = pack4(acc[mi][ni]);
                }
        }
    }
}

__device__ __forceinline__ void load_tile64(const bf16_t* base, size_t rowStride, unsigned char* dst, int wid, int lane) {
    const int c = ((lane & 7) ^ (lane >> 3)) * 8;
#pragma unroll
    for (int i = 0; i < 2; ++i) { const int j = wid + 4 * i, row = 8 * j + (lane >> 3); glds16(base + (size_t)row * rowStride + c, dst + j * 1024); }
}
__device__ __forceinline__ void load_tile128(const bf16_t* base, size_t rowStride, unsigned char* dst, int wid, int lane) {
    const int c = ((lane & 7) ^ (lane >> 3)) * 8;
#pragma unroll
    for (int i = 0; i < 4; ++i) { const int j = wid + 4 * i, row = 8 * j + (lane >> 3); glds16(base + (size_t)row * rowStride + c, dst + j * 1024); }
}
__device__ __forceinline__ void load_tile128w(const bf16_t* base, size_t rowStride, unsigned char* dst, int wid, int lane) {
    const int c = ((lane & 15) ^ ((4 * wid + (lane >> 4)) & 15)) * 8;
#pragma unroll
    for (int i = 0; i < 8; ++i) { const int j = wid + 4 * i, row = 4 * j + (lane >> 4); glds16(base + (size_t)row * rowStride + c, dst + j * 1024); }
}
__device__ __forceinline__ bf16x8 lds_frag128(const unsigned char* tile, int row, int chunk) {
    return *(const bf16x8*)(tile + row * 128 + ((chunk ^ (row & 7)) << 4));
}
__device__ __forceinline__ bf16x8 lds_frag256(const unsigned char* tile, int row, int chunk) {
    return *(const bf16x8*)(tile + row * 256 + ((chunk ^ (row & 15)) << 4));
}
__device__ __forceinline__ bf16x8 lds_vfrag128(const unsigned char* tile, int row, int kbase, int fq) {
    const int ca = (kbase >> 3) + (fq >> 1), hb = (fq & 1) * 8;
    const u32x2 a = *(const u32x2*)(tile + row * 128 + ((ca ^ (row & 7)) << 4) + hb);
    const u32x2 b = *(const u32x2*)(tile + row * 128 + (((ca + 2) ^ (row & 7)) << 4) + hb);
    u32x4 w; w.x = a.x; w.y = a.y; w.z = b.x; w.w = b.y;
    return __builtin_bit_cast(bf16x8, w);
}
__device__ __forceinline__ bf16x8 lds_vfrag256(const unsigned char* tile, int row, int kbase, int fq) {
    const int ca = (kbase >> 3) + (fq >> 1), hb = (fq & 1) * 8;
    const u32x2 a = *(const u32x2*)(tile + row * 256 + ((ca ^ (row & 15)) << 4) + hb);
    const u32x2 b = *(const u32x2*)(tile + row * 256 + (((ca + 2) ^ (row & 15)) << 4) + hb);
    u32x4 w; w.x = a.x; w.y = a.y; w.z = b.x; w.w = b.y;
    return __builtin_bit_cast(bf16x8, w);
}
__device__ __forceinline__ bf16x8 pack8(f32x4 a, f32x4 b) {
    u32x4 w; w.x = pack2(a[0], a[1]); w.y = pack2(a[2], a[3]); w.z = pack2(b[0], b[1]); w.w = pack2(b[2], b[3]);
    return __builtin_bit_cast(bf16x8, w);
}

__device__ __forceinline__ float gelu_tanh(float x) {
    const float u = 0.7978845608028654f * (x + 0.044715f * x * x * x);
    return 0.5f * x * (1.f + tanhf(u));
}
__device__ void compress_item(const Params& p, int layer, int item, unsigned char* lds) {
    unsigned char* ws = launder(p.ws);
    const int tid = threadIdx.x + vzero(), lane = tid & 63, wid = tid >> 6, wr = wid >> 1, wc = wid & 1, fr = lane & 15, fq = lane >> 4;
    const int mtile = item & 3, g = (item >> 2) & 1, b = (item >> 3) & 1, kv = item >> 4;
    const int i0 = mtile * 128;
    const bf16_t* P = (const bf16_t*)(ws + WS_P);
    const bf16_t* W1T = (const bf16_t*)(ws + WS_W1T) + (size_t)kv * 64 * 2048;
    const int col = (kv ? C_VC : C_KC) + g * 64;
    const int ldc = ((lane & 7) ^ (lane >> 3)) * 8;
    const bf16_t* ap[4];
#pragma unroll
    for (int i = 0; i < 4; ++i) ap[i] = P + ((size_t)b * S_ + 16 * (i0 + 32 * i + 8 * wid + (lane >> 3))) * LD + col + ldc;
    const bf16_t* bp[2];
#pragma unroll
    for (int i = 0; i < 2; ++i) bp[i] = W1T + (size_t)(8 * (wid + 4 * i) + (lane >> 3)) * 2048 + ldc;
    f32x4 acc[4][2];
#pragma unroll
    for (int i = 0; i < 4; ++i)
#pragma unroll
        for (int j = 0; j < 2; ++j) acc[i][j] = (f32x4){0.f, 0.f, 0.f, 0.f};
    __syncthreads();
#define CSTAGE(buf, l) do { unsigned char* st_ = lds + (buf) * 24576; \
        _Pragma("unroll") for (int i = 0; i < 4; ++i) glds16(ap[i] + (size_t)(l) * LD, st_ + (4 * i + wid) * 1024); \
        _Pragma("unroll") for (int i = 0; i < 2; ++i) glds16(bp[i] + (l) * 64, st_ + 16384 + (wid + 4 * i) * 1024); } while (0)
    CSTAGE(0, 0); wait_vm0(); __syncthreads();
    for (int l = 0; l < 32; ++l) {
        const unsigned char* st = lds + (l & 1) * 24576;
        if (l + 1 < 32) CSTAGE((l + 1) & 1, l + 1);
#pragma unroll
        for (int ks = 0; ks < 2; ++ks) {
            bf16x8 a[4], bb[2];
#pragma unroll
            for (int i = 0; i < 4; ++i) a[i] = lds_frag128(st, 64 * wr + 16 * i + fr, 4 * ks + fq);
#pragma unroll
            for (int j = 0; j < 2; ++j) bb[j] = lds_frag128(st + 16384, 32 * wc + 16 * j + fr, 4 * ks + fq);
#pragma unroll
            for (int i = 0; i < 4; ++i)
#pragma unroll
                for (int j = 0; j < 2; ++j) acc[i][j] = mfma16(a[i], bb[j], acc[i][j]);
        }
        wait_vm0(); __syncthreads();
    }
#undef CSTAGE
    float* hid = (float*)lds;
    const float* b1 = (const float*)(ws + WS_B1) + kv * 64;
#pragma unroll
    for (int j = 0; j < 2; ++j) {
        const int n = 32 * wc + 16 * j + fr; const float bias = b1[n + vzero()];
#pragma unroll
        for (int i = 0; i < 4; ++i)
#pragma unroll
            for (int r = 0; r < 4; ++r) hid[(64 * wr + 16 * i + 4 * fq + r) * 65 + n] = gelu_tanh(acc[i][j][r] + bias);
    }
    __syncthreads();
    {
        const int row = tid >> 1, nb = (tid & 1) * 32, ci = i0 + row;
        const float* w2 = p.cmp_w2 + ((size_t)layer * 2 + kv) * 64 * 64;
        float o[32];
#pragma unroll
        for (int q = 0; q < 32; ++q) o[q] = 0.f;
        for (int n = 0; n < 64; ++n) {
            const float h = hid[row * 65 + n];
#pragma unroll
            for (int q4 = 0; q4 < 8; ++q4) { const float4 w = *(const float4*)(w2 + n * 64 + nb + 4 * q4); o[4 * q4] += h * w.x; o[4 * q4 + 1] += h * w.y; o[4 * q4 + 2] += h * w.z; o[4 * q4 + 3] += h * w.w; }
        }
        if (kv == 0) {
            bf16_t* dst = (bf16_t*)(ws + WS_KCC) + ((size_t)(b * 2 + g) * 512 + ci) * 64 + nb;
#pragma unroll
            for (int q = 0; q < 32; q += 4) { f32x4 v = {o[q], o[q + 1], o[q + 2], o[q + 3]}; if (ci >= 511) v = (f32x4){0.f, 0.f, 0.f, 0.f}; *(u32x2*)(dst + q) = pack4(v); }
        } else {
            bf16_t* dst = (bf16_t*)(ws + WS_VCCT) + ((size_t)(b * 2 + g) * 64 + nb) * 512 + ci;
#pragma unroll
            for (int q = 0; q < 32; ++q) dst[(size_t)q * 512] = f2bf(ci >= 511 ? 0.f : o[q]);
        }
    }
    __syncthreads();
}

__device__ __forceinline__ float ret_lg2(int h) { const float gam = 1.f - exp2f(-5.f - (float)h); return log2f(gam); }

__device__ void retkv_item(const Params& p, int item, unsigned char* lds) {
    unsigned char* ws = launder(p.ws);
    const int tid = threadIdx.x + vzero(), lane = tid & 63, wid = tid >> 6, fr = lane & 15, fq = lane >> 4;
    const int n = item & 63, h = (item >> 6) & 7, b = item >> 9;
    const size_t tok0 = (size_t)b * S_ + 128 * n;
    unsigned char* vL = lds; unsigned char* kL = lds + 32768;
    load_tile128w((const bf16_t*)(ws + WS_VRT) + ((size_t)(b * 8 + h) * 128) * S_ + 128 * n, S_, vL, wid, lane);
    load_tile128((const bf16_t*)(ws + WS_P) + tok0 * LD + C_KR + h * 64, LD, kL, wid, lane);
    wait_vm0(); __syncthreads();
    const float lg2 = ret_lg2(h);
    f32x4 acc[2][4];
#pragma unroll
    for (int m = 0; m < 2; ++m)
#pragma unroll
        for (int nt = 0; nt < 4; ++nt) acc[m][nt] = (f32x4){0.f, 0.f, 0.f, 0.f};
#pragma unroll
    for (int ks = 0; ks < 4; ++ks) {
        bf16x8 a[2], bb[4];
#pragma unroll
        for (int m = 0; m < 2; ++m) a[m] = lds_frag256(vL, 32 * wid + 16 * m + fr, 4 * ks + fq);
        float dec[8];
#pragma unroll
        for (int j = 0; j < 8; ++j) dec[j] = exp2f((float)(127 - (32 * ks + 8 * fq + j)) * lg2);
#pragma unroll
        for (int nt = 0; nt < 4; ++nt) {
            const int d = 16 * nt + fr;
            float v[8];
#pragma unroll
            for (int j = 0; j < 8; ++j) {
                const int tk = 32 * ks + 8 * fq + j;
                const bf16_t kvv = *(const bf16_t*)(kL + tk * 128 + (((d >> 3) ^ (tk & 7)) << 4) + (d & 7) * 2);
                v[j] = bf2f(kvv) * dec[j];
            }
            u32x4 w; w.x = pack2(v[0], v[1]); w.y = pack2(v[2], v[3]); w.z = pack2(v[4], v[5]); w.w = pack2(v[6], v[7]);
            bb[nt] = __builtin_bit_cast(bf16x8, w);
        }
#pragma unroll
        for (int m = 0; m < 2; ++m)
#pragma unroll
            for (int nt = 0; nt < 4; ++nt) acc[m][nt] = mfma16(a[m], bb[nt], acc[m][nt]);
    }
    float* KVT = (float*)(ws + WS_KVT) + ((size_t)(b * 8 + h) * 64 + n) * 8192;
#pragma unroll
    for (int m = 0; m < 2; ++m)
#pragma unroll
        for (int nt = 0; nt < 4; ++nt)
#pragma unroll
            for (int r = 0; r < 4; ++r) KVT[(32 * wid + 16 * m + 4 * fq + r) * 64 + 16 * nt + fr] = acc[m][nt][r];
    __syncthreads();
}

__device__ void phase_p2(const Params& p, int layer, unsigned char* lds) {
    for (int it = blockIdx.x; it < 1024 + 32; it += gridDim.x) {
        if (it < 32) compress_item(p, layer, it, lds); else retkv_item(p, it - 32, lds);
    }
}

constexpr int NSA_IMP = 32768, NSA_BUCKET = 65792, NSA_BIAS = 73984;

struct NsaLane { int t; int fr, fq, wid, lane; };

template <int BR, int PASS>
__device__ __forceinline__ void nsa_half(const unsigned char* kL, const unsigned char* vL, const unsigned char* lds, const bf16_t* qptr,
                                         f32x4 (&O)[4][4], float (&m)[4], float (&l)[4], int tile, int hf, bool selbit, const NsaLane& L, int qrow) {
    const int fr = L.fr, fq = L.fq;
    bf16x8 Kf[2][2];
#pragma unroll
    for (int i = 0; i < 2; ++i)
#pragma unroll
        for (int ks = 0; ks < 2; ++ks) Kf[i][ks] = lds_frag128(kL, 32 * hf + 16 * i + fr, 4 * ks + fq);
    unsigned vmask = 0; unsigned bk[2];
    const unsigned char* bucketL = lds + NSA_BUCKET;
#pragma unroll
    for (int i = 0; i < 2; ++i) {
        unsigned pk = 0;
#pragma unroll
        for (int r = 0; r < 4; ++r) {
            const int kk = 32 * hf + 16 * i + 4 * fq + r;
            int rel; bool ok;
            if (BR == 0) { rel = L.t - (16 * (64 * tile + kk) + 31); ok = rel >= 0; }
            else if (BR == 1) { rel = L.t - (64 * tile + kk); ok = selbit && rel >= 0; }
            else { rel = L.t - (64 * tile + kk); ok = rel >= 0 && rel < 512; }
            int rc = rel < 0 ? 0 : rel; rc = rc > 8191 ? 8191 : rc;
            pk |= (unsigned)bucketL[rc] << (8 * r);
            vmask |= (ok ? 1u : 0u) << (4 * i + r);
        }
        bk[i] = pk;
    }
    const float* biasL = (const float*)(lds + NSA_BIAS);
    float ia[2] = {0.f, 0.f}, ic[2] = {0.f, 0.f};
#pragma unroll
    for (int nt = 0; nt < 4; ++nt) {
        asm volatile("" ::: "memory");
        f32x4 S[2];
        const bf16x8 q0 = *(const bf16x8*)(qptr + nt * 64), q1 = *(const bf16x8*)(qptr + nt * 64 + 32);
#pragma unroll
        for (int i = 0; i < 2; ++i) {
            S[i] = (f32x4){0.f, 0.f, 0.f, 0.f};
            S[i] = mfma16(Kf[i][0], q0, S[i]); S[i] = mfma16(Kf[i][1], q1, S[i]);
        }
        float tmax = -1e30f;
#pragma unroll
        for (int i = 0; i < 2; ++i)
#pragma unroll
            for (int r = 0; r < 4; ++r) {
                const float bias = biasL[nt * 32 + ((bk[i] >> (8 * r)) & 0xffu)];
                const bool ok = (vmask >> (4 * i + r)) & 1u;
                const float sv = ok ? S[i][r] * 0.125f + bias : -1e30f;
                S[i][r] = sv; tmax = fmaxf(tmax, sv);
            }
        if (PASS != 1) {
            tmax = fmaxf(tmax, __shfl_xor(tmax, 16)); tmax = fmaxf(tmax, __shfl_xor(tmax, 32));
            const float mnew = fmaxf(m[nt], tmax), alpha = __expf(m[nt] - mnew);
            float psum = 0.f;
#pragma unroll
            for (int i = 0; i < 2; ++i)
#pragma unroll
                for (int r = 0; r < 4; ++r) {
                    const bool ok = (vmask >> (4 * i + r)) & 1u;
                    const float pv = ok ? __expf(S[i][r] - mnew) : 0.f;
                    S[i][r] = pv; psum += pv;
                }
            psum += __shfl_xor(psum, 16); psum += __shfl_xor(psum, 32);
            l[nt] = l[nt] * alpha + psum; m[nt] = mnew;
            if (PASS == 2) {
#pragma unroll
                for (int mt = 0; mt < 4; ++mt) O[mt][nt] = O[mt][nt] * alpha;
            }
        } else {
#pragma unroll
            for (int i = 0; i < 2; ++i) {
#pragma unroll
                for (int r = 0; r < 4; ++r) {
                    const bool ok = (vmask >> (4 * i + r)) & 1u;
                    S[i][r] = ok ? __expf(S[i][r] - m[nt]) * l[nt] : 0.f;
                }
                ia[i] += S[i][0] + S[i][1] + S[i][2] + 0.5f * S[i][3];
                ic[i] += 0.5f * S[i][3];
            }
        }
        if (PASS != 0) {
            const bf16x8 Pb = pack8(S[0], S[1]);
#pragma unroll
            for (int mt = 0; mt < 4; ++mt) O[mt][nt] = mfma16(lds_vfrag128(vL, 16 * mt + fr, 32 * hf, fq), Pb, O[mt][nt]);
        }
    }
    if (PASS == 1) {
        float* imp = (float*)(lds + NSA_IMP) + qrow * 129;
        asm volatile("" ::: "memory"); __builtin_amdgcn_wave_barrier();
#pragma unroll
        for (int i = 0; i < 2; ++i) { const int j = 16 * tile + 8 * hf + 4 * i + fq; imp[j] += ia[i]; }
        asm volatile("s_waitcnt lgkmcnt(0)" ::: "memory"); __builtin_amdgcn_wave_barrier();
#pragma unroll
        for (int i = 0; i < 2; ++i) { const int j = 16 * tile + 8 * hf + 4 * i + fq + 1; if (j < 128) imp[j] += ic[i]; }
        asm volatile("s_waitcnt lgkmcnt(0)" ::: "memory"); __builtin_amdgcn_wave_barrier();
    }
}
template <int BR, int PASS>
__device__ __forceinline__ void nsa_tile(const unsigned char* kL, const unsigned char* vL, const unsigned char* lds, const bf16_t* qptr,
                                         f32x4 (&O)[4][4], float (&m)[4], float (&l)[4], int tile, bool selbit, const NsaLane& L, int qrow) {
#pragma unroll 1
    for (int hf = 0; hf < 2; ++hf) nsa_half<BR, PASS>(kL, vL, lds, qptr, O, m, l, tile, hf, selbit, L, qrow);
}

__device__ void cmp_item(const Params& p, int item, unsigned char* lds) {
    unsigned char* ws = launder(p.ws);
    const int tid = threadIdx.x + vzero(), lane = tid & 63, wid = tid >> 6, fr = lane & 15, fq = lane >> 4;
    const int combo = item & 3, qt = 127 - (item >> 2), b = combo >> 1, g = combo & 1;
    const int q0 = qt * 64, qrow = 16 * wid + fr;
    NsaLane L; L.t = q0 + qrow; L.fr = fr; L.fq = fq; L.wid = wid; L.lane = lane;
    const size_t tok = (size_t)b * S_ + L.t;
    const bf16_t* P = (const bf16_t*)(ws + WS_P);
    __syncthreads();
    if (tid < 128) ((float*)(lds + NSA_BIAS))[tid] = p.rel_bias[(tid & 31) * 8 + 4 * g + (tid >> 5)];
    for (int i = tid; i < 64 * 129; i += NTHREADS) ((float*)(lds + NSA_IMP))[i] = 0.f;
    const bf16_t* Qf = P + tok * LD + C_QA + (4 * g) * 64 + 8 * fq;
    __syncthreads();
    f32x4 O[4][4]; float m[4], l[4];
    const bf16_t* gates = P + tok * LD + C_GA + (4 * g) * 3;
    const bf16_t* kc = (const bf16_t*)(ws + WS_KCC) + (size_t)(b * 2 + g) * 512 * 64;
    const bf16_t* vc = (const bf16_t*)(ws + WS_VCCT) + (size_t)(b * 2 + g) * 64 * 512;
    const int ntc = ((q0 + 32) >> 4) / 64 + 1;
#pragma unroll
    for (int nt = 0; nt < 4; ++nt) { m[nt] = -1e30f; l[nt] = 0.f; }
    load_tile64(kc, 64, lds, wid, lane);
    wait_vm0(); __syncthreads();
    for (int it = 0; it < ntc; ++it) {
        unsigned char* cur = lds + (it & 1) * 16384;
        if (it + 1 < ntc) load_tile64(kc + (size_t)(it + 1) * 64 * 64, 64, lds + ((it + 1) & 1) * 16384, wid, lane);
        nsa_tile<0, 0>(cur, cur + 8192, lds, Qf, O, m, l, it, true, L, qrow);
        wait_vm0(); __syncthreads();
    }
#pragma unroll
    for (int nt = 0; nt < 4; ++nt) l[nt] = l[nt] > 0.f ? 1.f / l[nt] : 0.f;
#pragma unroll
    for (int mt = 0; mt < 4; ++mt)
#pragma unroll
        for (int nt = 0; nt < 4; ++nt) O[mt][nt] = (f32x4){0.f, 0.f, 0.f, 0.f};
    load_tile64(kc, 64, lds, wid, lane); load_tile64(vc, 512, lds + 8192, wid, lane);
    wait_vm0(); __syncthreads();
    for (int it = 0; it < ntc; ++it) {
        unsigned char* cur = lds + (it & 1) * 16384;
        if (it + 1 < ntc) { unsigned char* nx = lds + ((it + 1) & 1) * 16384;
            load_tile64(kc + (size_t)(it + 1) * 64 * 64, 64, nx, wid, lane); load_tile64(vc + (it + 1) * 64, 512, nx + 8192, wid, lane); }
        nsa_tile<0, 1>(cur, cur + 8192, lds, Qf, O, m, l, it, true, L, qrow);
        wait_vm0(); __syncthreads();
    }
    bf16_t* YC = (bf16_t*)(ws + WS_YC) + tok * 512 + (4 * g) * 64;
#pragma unroll
    for (int nt = 0; nt < 4; ++nt) {
        const float gt = bf2f(gates[nt * 3 + 0]);
#pragma unroll
        for (int mt = 0; mt < 4; ++mt) *(u32x2*)(YC + nt * 64 + 16 * mt + 4 * fq) = pack4(O[mt][nt] * gt);
    }
    const int cur = qt;
    {
        float* imp = (float*)(lds + NSA_IMP) + qrow * 129 + 32 * fq;
        asm volatile("s_waitcnt lgkmcnt(0)" ::: "memory"); __builtin_amdgcn_wave_barrier();
#pragma unroll
        for (int i = 0; i < 32; ++i) {
            const int j = 32 * fq + i;
            const float v = imp[i];
            imp[i] = j > cur ? -1.f : v + ((j == 0 || j == cur || j == cur - 1) ? 1.0e4f : 0.f);
        }
        unsigned word = 0;
#pragma unroll 1
        for (int round = 0; round < 16; ++round) {
            float bv = imp[0]; int bi = 0;
#pragma unroll
            for (int i = 1; i < 32; ++i) { const float v = imp[i]; if (v > bv) { bv = v; bi = i; } }
            int gi = 32 * fq + bi;
#pragma unroll
            for (int off = 16; off <= 32; off <<= 1) {
                const float ov = __shfl_xor(bv, off); const int oi = __shfl_xor(gi, off);
                if (ov > bv || (ov == bv && oi < gi)) { bv = ov; gi = oi; }
            }
            if (bv >= 0.f && (gi >> 5) == fq) { word |= 1u << (gi & 31); imp[gi & 31] = -2.f; }
        }
        ((unsigned*)(ws + WS_SELW))[(tok * 2 + g) * 4 + fq] = word;
    }
}

__device__ void win_item(const Params& p, int item, unsigned char* lds) {
    unsigned char* ws = launder(p.ws);
    const int tid = threadIdx.x + vzero(), lane = tid & 63, wid = tid >> 6, fr = lane & 15, fq = lane >> 4;
    const int combo = item & 3, qt = 127 - (item >> 2), b = combo >> 1, g = combo & 1;
    const int q0 = qt * 64, qrow = 16 * wid + fr;
    NsaLane L; L.t = q0 + qrow; L.fr = fr; L.fq = fq; L.wid = wid; L.lane = lane;
    const size_t tok = (size_t)b * S_ + L.t;
    const bf16_t* P = (const bf16_t*)(ws + WS_P);
    __syncthreads();
    if (tid < 128) ((float*)(lds + NSA_BIAS))[tid] = p.rel_bias[(tid & 31) * 8 + 4 * g + (tid >> 5)];
    const bf16_t* Qf = P + tok * LD + C_QA + (4 * g) * 64 + 8 * fq;
    __syncthreads();
    f32x4 O[4][4]; float m[4], l[4];
    const bf16_t* gates = P + tok * LD + C_GA + (4 * g) * 3;
#pragma unroll
    for (int nt = 0; nt < 4; ++nt) { m[nt] = -1e30f; l[nt] = 0.f; }
#pragma unroll
    for (int mt = 0; mt < 4; ++mt)
#pragma unroll
        for (int nt = 0; nt < 4; ++nt) O[mt][nt] = (f32x4){0.f, 0.f, 0.f, 0.f};
    {
        const bf16_t* kb = P + ((size_t)b * S_) * LD + C_KW + g * 64;
        const bf16_t* vb = (const bf16_t*)(ws + WS_VWT) + (size_t)(b * 2 + g) * 64 * S_;
        const int k_lo = qt - 8 > 0 ? qt - 8 : 0, ntw = qt - k_lo + 1;
        load_tile64(kb + (size_t)k_lo * 64 * LD, LD, lds, wid, lane); load_tile64(vb + k_lo * 64, S_, lds + 8192, wid, lane);
        wait_vm0(); __syncthreads();
        for (int it = 0; it < ntw; ++it) {
            unsigned char* cu = lds + (it & 1) * 16384;
            if (it + 1 < ntw) { unsigned char* nx = lds + ((it + 1) & 1) * 16384;
                load_tile64(kb + (size_t)(k_lo + it + 1) * 64 * LD, LD, nx, wid, lane); load_tile64(vb + (k_lo + it + 1) * 64, S_, nx + 8192, wid, lane); }
            nsa_tile<2, 2>(cu, cu + 8192, lds, Qf, O, m, l, k_lo + it, true, L, qrow);
            wait_vm0(); __syncthreads();
        }
    }
    bf16_t* YW = (bf16_t*)(ws + WS_YW) + tok * 512 + (4 * g) * 64;
#pragma unroll
    for (int nt = 0; nt < 4; ++nt) {
        const float gt = bf2f(gates[nt * 3 + 2]) * (l[nt] > 0.f ? 1.f / l[nt] : 0.f);
#pragma unroll
        for (int mt = 0; mt < 4; ++mt) *(u32x2*)(YW + nt * 64 + 16 * mt + 4 * fq) = pack4(O[mt][nt] * gt);
    }
}

constexpr int SEL_BIAS2 = 40960;
constexpr float LOG2E = 1.4426950408889634f;
__device__ __forceinline__ int t5_first(int bk) {
    const int th[16] = {16, 22, 30, 40, 54, 73, 99, 134, 182, 246, 332, 450, 609, 825, 1117, 1513};
    int r = 16;
#pragma unroll
    for (int k = 0; k < 16; ++k) r = (bk == 16 + k) ? th[k] : r;
    return r;
}
template <bool FAST, int HF>
__device__ __forceinline__ void sel_ntile(const bf16x8 (&Kf)[2][2], const bf16x8 (&Vf)[4], const bf16x8& q0, const bf16x8& q1, f32x4 (&O)[4], float& m, float& l,
                                          bool sb, int relb, int th, float blo, float bhi, const unsigned char* lds, int hl) {
    f32x4 S[2];
#pragma unroll
    for (int i = 0; i < 2; ++i) { S[i] = (f32x4){0.f, 0.f, 0.f, 0.f}; S[i] = mfma16(Kf[i][0], q0, S[i]); S[i] = mfma16(Kf[i][1], q1, S[i]); }
    float tmax = -1e30f;
    unsigned vm = 0;
#pragma unroll
    for (int i = 0; i < 2; ++i)
#pragma unroll
        for (int r = 0; r < 4; ++r) {
            const int rel = relb - (32 * HF + 16 * i + r);
            float bias; bool ok;
            if (FAST) { bias = rel >= th ? bhi : blo; ok = sb; }
            else {
                int rc = rel < 0 ? 0 : rel; rc = rc > 8191 ? 8191 : rc;
                bias = ((const float*)(lds + SEL_BIAS2))[hl * 32 + (lds + NSA_BUCKET)[rc]]; ok = sb && rel >= 0;
            }
            const float sv = ok ? S[i][r] * (0.125f * LOG2E) + bias : -1e30f;
            vm |= (ok ? 1u : 0u) << (4 * i + r);
            S[i][r] = sv; tmax = fmaxf(tmax, sv);
        }
    tmax = fmaxf(tmax, __shfl_xor(tmax, 16)); tmax = fmaxf(tmax, __shfl_xor(tmax, 32));
    const float mnew = fmaxf(m, tmax), alpha = __builtin_amdgcn_exp2f(m - mnew);
    float psum = 0.f;
#pragma unroll
    for (int i = 0; i < 2; ++i)
#pragma unroll
        for (int r = 0; r < 4; ++r) { const float pv = ((vm >> (4 * i + r)) & 1u) ? __builtin_amdgcn_exp2f(S[i][r] - mnew) : 0.f; S[i][r] = pv; psum += pv; }
    psum += __shfl_xor(psum, 16); psum += __shfl_xor(psum, 32);
    l = l * alpha + psum; m = mnew;
    const bf16x8 Pb = pack8(S[0], S[1]);
#pragma unroll
    for (int mt = 0; mt < 4; ++mt) { O[mt] = O[mt] * alpha; O[mt] = mfma16(Vf[mt], Pb, O[mt]); }
}
template <bool FAST, int HF>
__device__ __forceinline__ void sel_half(const unsigned char* kL, const unsigned char* vL, const unsigned char* lds, const bf16x8 (&Qf)[2][2], f32x4 (&O)[2][4], float (&m)[2], float (&l)[2],
                                         const bool (&sb)[2], const bool (&need)[2], const int (&relb)[2], int th, float blo, float bhi, int hl, int fr, int fq) {
    bf16x8 Kf[2][2], Vf[4];
#pragma unroll
    for (int i = 0; i < 2; ++i)
#pragma unroll
        for (int ks = 0; ks < 2; ++ks) Kf[i][ks] = lds_frag128(kL, 32 * HF + 16 * i + fr, 4 * ks + fq);
#pragma unroll
    for (int mt = 0; mt < 4; ++mt) Vf[mt] = lds_vfrag128(vL, 16 * mt + fr, 32 * HF, fq);
    if (need[0]) sel_ntile<FAST, HF>(Kf, Vf, Qf[0][0], Qf[0][1], O[0], m[0], l[0], sb[0], relb[0], th, blo, bhi, lds, hl);
    if (need[1]) sel_ntile<FAST, HF>(Kf, Vf, Qf[1][0], Qf[1][1], O[1], m[1], l[1], sb[1], relb[1], th, blo, bhi, lds, hl);
}
__device__ void sel_item(const Params& p, int v, unsigned char* lds) {
    unsigned char* ws = launder(p.ws);
    const int tid = threadIdx.x + vzero(), lane = tid & 63, wid = tid >> 6, fr = lane & 15, fq = lane >> 4;
    const int qt = 127 - (v >> 3), sub = v & 7, b = sub >> 2, g = (sub >> 1) & 1, half = sub & 1;
    const int q0 = qt * 64 + 32 * half, cur = qt, hl = fr & 3;
    const bf16_t* P = (const bf16_t*)(ws + WS_P);
    __syncthreads();
    if (tid < 128) ((float*)(lds + SEL_BIAS2))[tid] = p.rel_bias[(tid & 31) * 8 + 4 * g + (tid >> 5)] * LOG2E;
    int t[2]; size_t tok[2]; bf16x8 Qf[2][2]; unsigned selw[2][4];
#pragma unroll
    for (int nt = 0; nt < 2; ++nt) {
        t[nt] = q0 + 8 * wid + 4 * nt + (fr >> 2); tok[nt] = (size_t)b * S_ + t[nt];
#pragma unroll
        for (int ks = 0; ks < 2; ++ks) Qf[nt][ks] = *(const bf16x8*)(P + tok[nt] * LD + C_QA + (4 * g + hl) * 64 + 32 * ks + 8 * fq);
        const u32x4 w = *(const u32x4*)((const unsigned*)(ws + WS_SELW) + (tok[nt] * 2 + g) * 4);
        selw[nt][0] = w.x; selw[nt][1] = w.y; selw[nt][2] = w.z; selw[nt][3] = w.w;
    }
    f32x4 O[2][4]; float m[2], l[2];
#pragma unroll
    for (int nt = 0; nt < 2; ++nt) { m[nt] = -1e30f; l[nt] = 0.f;
#pragma unroll
        for (int mt = 0; mt < 4; ++mt) O[nt][mt] = (f32x4){0.f, 0.f, 0.f, 0.f}; }
    const bf16_t* kb = P + ((size_t)b * S_) * LD + C_KS + g * 64;
    const bf16_t* vb = (const bf16_t*)(ws + WS_VST) + (size_t)(b * 2 + g) * 64 * S_;
    const int nts = cur + 1;
    load_tile64(kb, LD, lds, wid, lane); load_tile64(vb, S_, lds + 8192, wid, lane);
    wait_vm0(); __syncthreads();
    const unsigned char* bucketL = lds + NSA_BUCKET;
    for (int j = 0; j < nts; ++j) {
        const unsigned char* cu = lds + (j & 1) * 16384;
        if (j + 1 < nts) { unsigned char* nx = lds + ((j + 1) & 1) * 16384;
            load_tile64(kb + (size_t)(j + 1) * 64 * LD, LD, nx, wid, lane); load_tile64(vb + (j + 1) * 64, S_, nx + 8192, wid, lane); }
        bool sb[2], need[2]; int relb[2];
#pragma unroll
        for (int nt = 0; nt < 2; ++nt) {
            const unsigned w = j < 32 ? selw[nt][0] : j < 64 ? selw[nt][1] : j < 96 ? selw[nt][2] : selw[nt][3];
            sb[nt] = (w >> (j & 31)) & 1u; need[nt] = __ballot(sb[nt]) != 0ull; relb[nt] = t[nt] - 64 * j - 4 * fq;
        }
        if (need[0] || need[1]) {
            const int rmin = q0 - 64 * j - 63, rmax = q0 + 31 - 64 * j;
            bool fast = false; int th = 0; float blo = 0.f, bhi = 0.f;
            if (rmin >= 16) {
                const int b0 = bucketL[rmin], b1 = bucketL[rmax > 8191 ? 8191 : rmax];
                if (b1 - b0 <= 1) { fast = true; th = t5_first(b1); if (b1 == b0) th = 0;
                    blo = ((const float*)(lds + SEL_BIAS2))[hl * 32 + b0]; bhi = ((const float*)(lds + SEL_BIAS2))[hl * 32 + b1]; }
            }
            if (fast) {
                sel_half<true, 0>(cu, cu + 8192, lds, Qf, O, m, l, sb, need, relb, th, blo, bhi, hl, fr, fq);
                sel_half<true, 1>(cu, cu + 8192, lds, Qf, O, m, l, sb, need, relb, th, blo, bhi, hl, fr, fq);
            } else {
                sel_half<false, 0>(cu, cu + 8192, lds, Qf, O, m, l, sb, need, relb, th, blo, bhi, hl, fr, fq);
                sel_half<false, 1>(cu, cu + 8192, lds, Qf, O, m, l, sb, need, relb, th, blo, bhi, hl, fr, fq);
            }
        }
        wait_vm0(); __syncthreads();
    }
#pragma unroll
    for (int nt = 0; nt < 2; ++nt) {
        const float gt = bf2f(P[tok[nt] * LD + C_GA + (4 * g + hl) * 3 + 1]) * (l[nt] > 0.f ? 1.f / l[nt] : 0.f);
        const size_t o = tok[nt] * 512 + (4 * g + hl) * 64;
#pragma unroll
        for (int mt = 0; mt < 4; ++mt) {
            const f32x4 yc = unpack4(*(const u32x2*)((const bf16_t*)(ws + WS_YC) + o + 16 * mt + 4 * fq));
            const f32x4 yw = unpack4(*(const u32x2*)((const bf16_t*)(ws + WS_YW) + o + 16 * mt + 4 * fq));
            *(u32x2*)((bf16_t*)(ws + WS_YA) + o + 16 * mt + 4 * fq) = pack4(yc + yw + O[nt][mt] * gt);
        }
    }
}

__device__ void scan_item(const Params& p, int item) {
    unsigned char* ws = launder(p.ws);
    const int idx = item * NTHREADS + threadIdx.x;
    const int bh = idx >> 13, ed = idx & 8191, h = bh & 7;
    const float dec = exp2f(128.f * ret_lg2(h));
    const float* KVT = (const float*)(ws + WS_KVT) + (size_t)bh * 64 * 8192 + ed;
    bf16_t* SPT = (bf16_t*)(ws + WS_SPT) + (size_t)bh * 64 * 8192 + ed;
    float s = 0.f;
    for (int n = 0; n < 64; ++n) { SPT[(size_t)n * 8192] = f2bf(s); s = s * dec + KVT[(size_t)n * 8192]; }
}

__device__ void phase_p3(const Params& p, unsigned char* lds) {
    for (int i = threadIdx.x; i < 8192 / 16; i += NTHREADS) ((u32x4*)(lds + NSA_BUCKET))[i] = ((const u32x4*)(p.ws + WS_BUCKET))[i];
    __syncthreads();
    for (int it = blockIdx.x; it < 1536; it += gridDim.x) {
        if (it < 512) cmp_item(p, it, lds); else if (it < 1024) win_item(p, it - 512, lds); else scan_item(p, it - 1024);
    }
}

__device__ void retout_item(const Params& p, int item, unsigned char* lds) {
    unsigned char* ws = launder(p.ws);
    const int tid = threadIdx.x + vzero(), lane = tid & 63, wid = tid >> 6, fr = lane & 15, fq = lane >> 4;
    const int n = item & 63, h = (item >> 6) & 7, b = item >> 9;
    const size_t tok0 = (size_t)b * S_ + 128 * n;
    const bf16_t* P = (const bf16_t*)(ws + WS_P);
    unsigned char* vL = lds; unsigned char* kL = lds + 32768; unsigned char* sL = lds + 49152;
    __syncthreads();
    load_tile128w((const bf16_t*)(ws + WS_VRT) + ((size_t)(b * 8 + h) * 128) * S_ + 128 * n, S_, vL, wid, lane);
    load_tile128(P + tok0 * LD + C_KR + h * 64, LD, kL, wid, lane);
    load_tile128((const bf16_t*)(ws + WS_SPT) + ((size_t)(b * 8 + h) * 64 + n) * 8192, 64, sL, wid, lane);
    bf16x8 Qf[2][2];
#pragma unroll
    for (int nt = 0; nt < 2; ++nt)
#pragma unroll
        for (int ks = 0; ks < 2; ++ks) Qf[nt][ks] = *(const bf16x8*)(P + (tok0 + 32 * wid + 16 * nt + fr) * LD + C_QR + h * 64 + 32 * ks + 8 * fq);
    wait_vm0(); __syncthreads();
    const float lg2 = ret_lg2(h);
    f32x4 Y[8][2];
#pragma unroll
    for (int m = 0; m < 8; ++m)
#pragma unroll
        for (int nt = 0; nt < 2; ++nt) Y[m][nt] = (f32x4){0.f, 0.f, 0.f, 0.f};
#pragma unroll
    for (int m = 0; m < 8; ++m)
#pragma unroll
        for (int ks = 0; ks < 2; ++ks) {
            const bf16x8 a = lds_frag128(sL, 16 * m + fr, 4 * ks + fq);
#pragma unroll
            for (int nt = 0; nt < 2; ++nt) Y[m][nt] = mfma16(a, Qf[nt][ks], Y[m][nt]);
        }
#pragma unroll
    for (int nt = 0; nt < 2; ++nt) {
        const float sc = exp2f((float)(32 * wid + 16 * nt + fr + 1) * lg2);
#pragma unroll
        for (int m = 0; m < 8; ++m) Y[m][nt] = Y[m][nt] * sc;
    }
#pragma unroll 1
    for (int s = 0; s < 4; ++s) {
        f32x4 St[2][2];
#pragma unroll
        for (int hh = 0; hh < 2; ++hh) {
            const int mt = 2 * s + hh;
#pragma unroll
            for (int nt = 0; nt < 2; ++nt) St[hh][nt] = (f32x4){0.f, 0.f, 0.f, 0.f};
#pragma unroll
            for (int ks = 0; ks < 2; ++ks) {
                const bf16x8 a = lds_frag128(kL, 16 * mt + fr, 4 * ks + fq);
#pragma unroll
                for (int nt = 0; nt < 2; ++nt) St[hh][nt] = mfma16(a, Qf[nt][ks], St[hh][nt]);
            }
#pragma unroll
            for (int nt = 0; nt < 2; ++nt) {
                const int qi = 32 * wid + 16 * nt + fr;
#pragma unroll
                for (int r = 0; r < 4; ++r) {
                    const int kj = 16 * mt + 4 * fq + r;
                    const float dm = qi >= kj ? exp2f((float)(qi - kj) * lg2) : 0.f;
                    St[hh][nt][r] *= dm;
                }
            }
        }
        bf16x8 Pb[2];
#pragma unroll
        for (int nt = 0; nt < 2; ++nt) Pb[nt] = pack8(St[0][nt], St[1][nt]);
#pragma unroll
        for (int m = 0; m < 8; ++m) {
            const bf16x8 a = lds_vfrag256(vL, 16 * m + fr, 32 * s, fq);
#pragma unroll
            for (int nt = 0; nt < 2; ++nt) Y[m][nt] = mfma16(a, Pb[nt], Y[m][nt]);
        }
    }
    bf16_t* YB = (bf16_t*)(ws + WS_YB);
#pragma unroll
    for (int nt = 0; nt < 2; ++nt) {
        float sum = 0.f;
#pragma unroll
        for (int m = 0; m < 8; ++m) sum += Y[m][nt][0] + Y[m][nt][1] + Y[m][nt][2] + Y[m][nt][3];
        sum += __shfl_xor(sum, 16); sum += __shfl_xor(sum, 32);
        const float mu = sum * (1.f / 128.f);
        float vs = 0.f;
#pragma unroll
        for (int m = 0; m < 8; ++m)
#pragma unroll
            for (int r = 0; r < 4; ++r) { const float dlt = Y[m][nt][r] - mu; vs += dlt * dlt; }
        vs += __shfl_xor(vs, 16); vs += __shfl_xor(vs, 32);
        const float rstd = rsqrtf(vs * (1.f / 128.f) + 1e-5f);
        const size_t tk = tok0 + 32 * wid + 16 * nt + fr;
#pragma unroll
        for (int m = 0; m < 8; ++m) {
            const f32x4 gt = unpack4(*(const u32x2*)(P + tk * LD + C_GR + h * 128 + 16 * m + 4 * fq));
            f32x4 v;
#pragma unroll
            for (int r = 0; r < 4; ++r) v[r] = (Y[m][nt][r] - mu) * rstd * gt[r];
            *(u32x2*)(YB + tk * 1024 + h * 128 + 16 * m + 4 * fq) = pack4(v);
        }
    }
}
__device__ void phase_p4(const Params& p, unsigned char* lds) {
    for (int i = threadIdx.x; i < 8192 / 16; i += NTHREADS) ((u32x4*)(lds + NSA_BUCKET))[i] = ((const u32x4*)(p.ws + WS_BUCKET))[i];
    __syncthreads();
    for (int it = blockIdx.x; it < 2048; it += gridDim.x) {
        if (it < 1024) sel_item(p, it < 512 ? it : 1535 - it, lds); else retout_item(p, it - 1024, lds);
    }
}

__device__ void phase_g2(const Params& p, unsigned char* lds) {
    unsigned char* ws = launder(p.ws);
    const bf16_t* P = (const bf16_t*)(ws + WS_P);
    for (int t = (blockIdx.x & 7) * 128 + (blockIdx.x >> 3); t < ((blockIdx.x & 7) + 1) * 128; t += (gridDim.x >> 3)) {
        const int mt = t >> 3, nt = t & 7, m0 = mt * 128, n0 = nt * 128;
        const int tid = threadIdx.x + vzero(), lane = tid & 63, wid = tid >> 6, wr = wid >> 1, wc = wid & 1, fr = lane & 15, fq = lane >> 4;
        const int ldrow = 8 * wid + (lane >> 3), ldc = ((lane & 7) ^ (lane >> 3)) * 8;
        const bf16_t* mp[4]; const bf16_t* np[4];
        bf16_t* MG = (bf16_t*)(ws + WS_MG);
        { f32x4 acc1[4][4]; zero_acc(acc1);
#pragma unroll
        for (int i = 0; i < 4; ++i) { mp[i] = (const bf16_t*)(ws + WS_WA) + (size_t)(n0 + 32 * i + ldrow) * 512 + ldc; np[i] = (const bf16_t*)(ws + WS_YA) + (size_t)(m0 + 32 * i + ldrow) * 512 + ldc; }
        gemm_kloop(mp, np, 8, lds, acc1);
#pragma unroll
        for (int mi = 0; mi < 4; ++mi)
#pragma unroll
            for (int ni = 0; ni < 4; ++ni) {
                const int n = n0 + 64 * wr + 16 * mi + 4 * fq; const size_t tok = m0 + 64 * wc + 16 * ni + fr;
                const f32x4 ga = unpack4(*(const u32x2*)(P + tok * LD + C_MA + n));
                *(u32x2*)(MG + tok * 1024 + n) = pack4(ga * acc1[mi][ni]);
            } }
        { f32x4 acc2[4][4]; zero_acc(acc2);
#pragma unroll
        for (int i = 0; i < 4; ++i) { mp[i] = (const bf16_t*)(ws + WS_WB) + (size_t)(n0 + 32 * i + ldrow) * 1024 + ldc; np[i] = (const bf16_t*)(ws + WS_YB) + (size_t)(m0 + 32 * i + ldrow) * 1024 + ldc; }
        gemm_kloop(mp, np, 16, lds, acc2);
#pragma unroll
        for (int mi = 0; mi < 4; ++mi)
#pragma unroll
            for (int ni = 0; ni < 4; ++ni) {
                const int n = n0 + 64 * wr + 16 * mi + 4 * fq; const size_t tok = m0 + 64 * wc + 16 * ni + fr;
                const f32x4 gb = unpack4(*(const u32x2*)(P + tok * LD + C_MB + n));
                const f32x4 v = unpack4(*(const u32x2*)(MG + tok * 1024 + n)) + gb * acc2[mi][ni];
                *(u32x2*)(MG + tok * 1024 + n) = pack4(v);
            } }
    }
}

__device__ void phase_g3(const Params& p, int layer, unsigned char* lds) {
    unsigned char* ws = launder(p.ws);
    const int tid = threadIdx.x + vzero(), lane = tid & 63, wid = tid >> 6, wr = wid >> 1, wc = wid & 1, fr = lane & 15, fq = lane >> 4;
    const int ldrow = 8 * wid + (lane >> 3), ldc = ((lane & 7) ^ (lane >> 3)) * 8;
    const float* X = layer == 0 ? p.x : (const float*)(ws + WS_X);
    float* H1 = (float*)(ws + WS_H1);
    for (int t = (blockIdx.x & 7) * 128 + (blockIdx.x >> 3); t < ((blockIdx.x & 7) + 1) * 128; t += (gridDim.x >> 3)) {
        const int mt = t >> 3, nt = t & 7, m0 = mt * 128, n0 = nt * 128;
        const bf16_t* mp[4]; const bf16_t* np[4];
        f32x4 acc[4][4]; zero_acc(acc);
#pragma unroll
        for (int i = 0; i < 4; ++i) { mp[i] = (const bf16_t*)(ws + WS_WO) + (size_t)(n0 + 32 * i + ldrow) * 1024 + ldc; np[i] = (const bf16_t*)(ws + WS_MG) + (size_t)(m0 + 32 * i + ldrow) * 1024 + ldc; }
        gemm_kloop(mp, np, 16, lds, acc);
#pragma unroll
        for (int mi = 0; mi < 4; ++mi)
#pragma unroll
            for (int ni = 0; ni < 4; ++ni) {
                const int n = n0 + 64 * wr + 16 * mi + 4 * fq; const size_t tok = m0 + 64 * wc + 16 * ni + fr;
                const f32x4 xv = *(const f32x4*)(X + tok * 1024 + n);
                *(f32x4*)(H1 + tok * 1024 + n) = xv * DN_ALPHA + acc[mi][ni];
            }
    }
}

__device__ void phase_ln1(const Params& p, int layer, unsigned char* lds, bool dry) {
    unsigned char* ws = launder(p.ws);
    const int tid = threadIdx.x + vzero(), lane = tid & 63, wid = tid >> 6;
    float* wrL = (float*)lds;
    {
        float4 wv[16];
#pragma unroll
        for (int k = 0; k < 16; ++k) wv[k] = ((const float4*)p.w_router)[tid + 256 * k];
#pragma unroll
        for (int k = 0; k < 16; ++k) { const int i4 = tid + 256 * k, d = i4 >> 2, e0 = (i4 & 3) * 4;
            wrL[(e0 + 0) * 1024 + d] = wv[k].x; wrL[(e0 + 1) * 1024 + d] = wv[k].y; wrL[(e0 + 2) * 1024 + d] = wv[k].z; wrL[(e0 + 3) * 1024 + d] = wv[k].w; }
    }
    __syncthreads();
    const float* H1 = (const float*)(ws + WS_H1);
    float* X1 = (float*)(ws + WS_X1); bf16_t* X1B = (bf16_t*)(ws + WS_X1B);
    const float* gam = p.ln1_g + layer * 1024; const float* bet = p.ln1_b + layer * 1024;
    unsigned* cnt = (unsigned*)(ws + WS_CTL) + (dry ? 0 : CW_CNT) + layer * 1024;
    int* LIST = (int*)(ws + (dry ? WS_HB : WS_LIST)); float* WTS = (float*)(ws + (dry ? WS_HB + 4194304 : WS_WTS));
    for (int tok = blockIdx.x * 4 + wid; tok < T_; tok += gridDim.x * 4) {
        float4 v[4];
#pragma unroll
        for (int j = 0; j < 4; ++j) v[j] = *(const float4*)(H1 + (size_t)tok * 1024 + 256 * j + 4 * lane);
        float s = 0.f;
#pragma unroll
        for (int j = 0; j < 4; ++j) s += v[j].x + v[j].y + v[j].z + v[j].w;
#pragma unroll
        for (int o = 1; o < 64; o <<= 1) s += __shfl_xor(s, o);
        const float mu = s * (1.f / 1024.f);
        float q = 0.f;
#pragma unroll
        for (int j = 0; j < 4; ++j) { const float a = v[j].x - mu, b2 = v[j].y - mu, c = v[j].z - mu, d = v[j].w - mu; q += a * a + b2 * b2 + c * c + d * d; }
#pragma unroll
        for (int o = 1; o < 64; o <<= 1) q += __shfl_xor(q, o);
        const float rstd = rsqrtf(q * (1.f / 1024.f) + 1e-5f);
        float4 y[4];
#pragma unroll
        for (int j = 0; j < 4; ++j) {
            const int d0 = 256 * j + 4 * lane;
            const float4 gg = *(const float4*)(gam + d0), bb = *(const float4*)(bet + d0);
            y[j].x = (v[j].x - mu) * rstd * gg.x + bb.x; y[j].y = (v[j].y - mu) * rstd * gg.y + bb.y; y[j].z = (v[j].z - mu) * rstd * gg.z + bb.z; y[j].w = (v[j].w - mu) * rstd * gg.w + bb.w;
            *(float4*)(X1 + (size_t)tok * 1024 + d0) = y[j];
            u32x2 w; w.x = pack2(y[j].x, y[j].y); w.y = pack2(y[j].z, y[j].w);
            *(u32x2*)(X1B + (size_t)tok * 1024 + d0) = w;
        }
        float lg[16];
#pragma unroll
        for (int e = 0; e < 16; ++e) {
            float a = 0.f;
#pragma unroll
            for (int j = 0; j < 4; ++j) { const float4 w4 = *(const float4*)(wrL + e * 1024 + 256 * j + 4 * lane); a += y[j].x * w4.x + y[j].y * w4.y + y[j].z * w4.z + y[j].w * w4.w; }
            lg[e] = a;
        }
#pragma unroll
        for (int e = 0; e < 16; ++e) {
#pragma unroll
            for (int o = 1; o < 64; o <<= 1) lg[e] += __shfl_xor(lg[e], o);
        }
        float mx = lg[0];
#pragma unroll
        for (int e = 1; e < 16; ++e) mx = fmaxf(mx, lg[e]);
        float pr[16], ps = 0.f;
#pragma unroll
        for (int e = 0; e < 16; ++e) { pr[e] = expf(lg[e] - mx); ps += pr[e]; }
        const float ips = 1.f / ps;
        float sel[16];
#pragma unroll
        for (int e = 0; e < 16; ++e) { pr[e] *= ips; sel[e] = pr[e] + p.router_bias[e]; }
        int best = 0; float bestv = -1e30f;
#pragma unroll
        for (int gI = 0; gI < 4; ++gI) {
            float a = -1e30f, b2 = -1e30f;
#pragma unroll
            for (int k = 0; k < 4; ++k) { const float x = sel[4 * gI + k]; if (x > a) { b2 = a; a = x; } else if (x > b2) b2 = x; }
            const float gs = a + b2;
            if (gs > bestv) { bestv = gs; best = gI; }
        }
        float s4[4], p4[4];
#pragma unroll
        for (int k = 0; k < 4; ++k) { s4[k] = 0.f; p4[k] = 0.f; }
#pragma unroll
        for (int gI = 0; gI < 4; ++gI) if (gI == best) {
#pragma unroll
            for (int k = 0; k < 4; ++k) { s4[k] = sel[4 * gI + k]; p4[k] = pr[4 * gI + k]; }
        }
        int i0 = 0; float a0 = s4[0];
#pragma unroll
        for (int k = 1; k < 4; ++k) if (s4[k] > a0) { a0 = s4[k]; i0 = k; }
        int i1 = -1; float a1 = -1e30f;
#pragma unroll
        for (int k = 0; k < 4; ++k) if (k != i0 && s4[k] > a1) { a1 = s4[k]; i1 = k; }
        float w0 = 0.f, w1 = 0.f;
#pragma unroll
        for (int k = 0; k < 4; ++k) { if (k == i0) w0 = p4[k]; if (k == i1) w1 = p4[k]; }
        const float iw = 1.f / (w0 + w1);
        if (lane == 0) {
            const int e0 = best * 4 + i0, e1 = best * 4 + i1;
            const unsigned p0 = atomicAdd(&cnt[e0 * 64], 1u), p1 = atomicAdd(&cnt[e1 * 64], 1u);
            LIST[(size_t)e0 * T_ + p0] = tok * 2; LIST[(size_t)e1 * T_ + p1] = tok * 2 + 1;
            WTS[tok * 2] = w0 * iw; WTS[tok * 2 + 1] = w1 * iw;
        }
    }
}

__device__ __forceinline__ bool moe_find(const unsigned* cnt, int t, int colTiles, int& e, int& rt, int& ct, int& cnte, int& off) {
    int base = 0; off = 0;
    for (int k = 0; k < NE; ++k) {
        const int c = __builtin_amdgcn_readfirstlane((int)cnt[k * 64]), nt = ((c + 127) >> 7) * colTiles;
        if (t < base + nt) { e = k; cnte = c; const int u = t - base; rt = u / colTiles; ct = u % colTiles;
            e = __builtin_amdgcn_readfirstlane(e); cnte = __builtin_amdgcn_readfirstlane(cnte); rt = __builtin_amdgcn_readfirstlane(rt);
            ct = __builtin_amdgcn_readfirstlane(ct); off = __builtin_amdgcn_readfirstlane(off); return true; }
        base += nt; off += c;
    }
    return false;
}
__device__ void phase_m2(const Params& p, int layer, unsigned char* lds) {
    unsigned char* ws = launder(p.ws);
    const int tid = threadIdx.x + vzero(), lane = tid & 63, wid = tid >> 6, wr = wid >> 1, wc = wid & 1, fr = lane & 15, fq = lane >> 4;
    const int ldrow = 8 * wid + (lane >> 3), ldc = ((lane & 7) ^ (lane >> 3)) * 8;
    const unsigned* cnt = (const unsigned*)(ws + WS_CTL) + CW_CNT + layer * 1024 + vzero();
    const int* LIST = (const int*)(ws + WS_LIST);
    const bf16_t* X1B = (const bf16_t*)(ws + WS_X1B);
    bf16_t* HB = (bf16_t*)(ws + WS_HB);
    int ntile = 0;
    for (int k = 0; k < NE; ++k) ntile += ((__builtin_amdgcn_readfirstlane((int)cnt[k * 64]) + 127) >> 7) * 8;
    const int t_lo = (ntile * (int)(blockIdx.x & 7)) >> 3, t_hi = (ntile * (int)((blockIdx.x & 7) + 1)) >> 3;
    for (int t = t_lo + (blockIdx.x >> 3); t < t_hi; t += (gridDim.x >> 3)) {
        int e, rt, ct, cnte, off;
        if (!moe_find(cnt, t, 8, e, rt, ct, cnte, off)) break;
        const bf16_t* mp[4]; const bf16_t* np[4];
#pragma unroll
        for (int i = 0; i < 4; ++i) {
            const int rho = 32 * i + ldrow, blk = rho >> 4, nn = ct * 64 + (blk >> 1) * 16 + (rho & 15);
            mp[i] = (const bf16_t*)(ws + ((blk & 1) ? WS_WU : WS_WG)) + ((size_t)e * 512 + nn) * 1024 + ldc;
            int idx = rt * 128 + rho; idx = idx < cnte ? idx : cnte - 1;
            const int a = LIST[(size_t)e * T_ + idx];
            np[i] = X1B + (size_t)(a >> 1) * 1024 + ldc;
        }
        f32x4 acc[4][4]; zero_acc(acc);
        gemm_kloop(mp, np, 16, lds, acc);
#pragma unroll
        for (int mp2 = 0; mp2 < 2; ++mp2)
#pragma unroll
            for (int ni = 0; ni < 4; ++ni) {
                const int idx = rt * 128 + 64 * wc + 16 * ni + fr;
                if (idx < cnte) {
                    const int n = ct * 64 + (2 * wr + mp2) * 16 + 4 * fq;
                    const f32x4 gv = acc[2 * mp2][ni], uv = acc[2 * mp2 + 1][ni];
                    f32x4 hv;
#pragma unroll
                    for (int r = 0; r < 4; ++r) hv[r] = gv[r] * sigmoidf_(gv[r]) * uv[r];
                    *(u32x2*)(HB + (size_t)(off + idx) * 512 + n) = pack4(hv);
                }
            }
    }
}
__device__ void phase_m3(const Params& p, int layer, unsigned char* lds) {
    unsigned char* ws = launder(p.ws);
    const int tid = threadIdx.x + vzero(), lane = tid & 63, wid = tid >> 6, wr = wid >> 1, wc = wid & 1, fr = lane & 15, fq = lane >> 4;
    const int ldrow = 8 * wid + (lane >> 3), ldc = ((lane & 7) ^ (lane >> 3)) * 8;
    const unsigned* cnt = (const unsigned*)(ws + WS_CTL) + CW_CNT + layer * 1024 + vzero();
    const int* LIST = (const int*)(ws + WS_LIST);
    const bf16_t* HB = (const bf16_t*)(ws + WS_HB);
    bf16_t* CT = (bf16_t*)(ws + WS_CT);
    int ntile = 0;
    for (int k = 0; k < NE; ++k) ntile += ((__builtin_amdgcn_readfirstlane((int)cnt[k * 64]) + 127) >> 7) * 8;
    const int t_lo = (ntile * (int)(blockIdx.x & 7)) >> 3, t_hi = (ntile * (int)((blockIdx.x & 7) + 1)) >> 3;
    for (int t = t_lo + (blockIdx.x >> 3); t < t_hi; t += (gridDim.x >> 3)) {
        int e, rt, ct, cnte, off;
        if (!moe_find(cnt, t, 8, e, rt, ct, cnte, off)) break;
        const bf16_t* mp[4]; const bf16_t* np[4];
#pragma unroll
        for (int i = 0; i < 4; ++i) {
            const int rho = 32 * i + ldrow;
            mp[i] = (const bf16_t*)(ws + WS_WD) + ((size_t)e * 1024 + ct * 128 + rho) * 512 + ldc;
            int idx = rt * 128 + rho; idx = idx < cnte ? idx : cnte - 1;
            np[i] = HB + (size_t)(off + idx) * 512 + ldc;
        }
        f32x4 acc[4][4]; zero_acc(acc);
        gemm_kloop(mp, np, 8, lds, acc);
#pragma unroll
        for (int ni = 0; ni < 4; ++ni) {
            const int idx = rt * 128 + 64 * wc + 16 * ni + fr;
            if (idx < cnte) {
                const int a = LIST[(size_t)e * T_ + idx];
#pragma unroll
                for (int mi = 0; mi < 4; ++mi) {
                    const int n = ct * 128 + 64 * wr + 16 * mi + 4 * fq;
                    *(u32x2*)(CT + (size_t)a * 1024 + n) = pack4(acc[mi][ni]);
                }
            }
        }
    }
}

__device__ void phase_ln2(const Params& p, int layer) {
    unsigned char* ws = launder(p.ws);
    const int tid = threadIdx.x + vzero(), lane = tid & 63, wid = tid >> 6;
    const float* X1 = (const float*)(ws + WS_X1); const bf16_t* CT = (const bf16_t*)(ws + WS_CT); const float* WTS = (const float*)(ws + WS_WTS);
    float* XO = layer == NLAYER - 1 ? p.out : (float*)(ws + WS_X); bf16_t* XB = (bf16_t*)(ws + WS_XB);
    const float* gam = p.ln2_g + layer * 1024; const float* bet = p.ln2_b + layer * 1024;
    for (int tok = blockIdx.x * 4 + wid; tok < T_; tok += gridDim.x * 4) {
        const float w0 = WTS[tok * 2 + vzero()], w1 = WTS[tok * 2 + 1 + vzero()];
        float4 v[4];
#pragma unroll
        for (int j = 0; j < 4; ++j) {
            const int d0 = 256 * j + 4 * lane;
            const float4 xv = *(const float4*)(X1 + (size_t)tok * 1024 + d0);
            const f32x4 c0 = unpack4(*(const u32x2*)(CT + (size_t)(tok * 2) * 1024 + d0)), c1 = unpack4(*(const u32x2*)(CT + (size_t)(tok * 2 + 1) * 1024 + d0));
            v[j].x = xv.x * DN_ALPHA + w0 * c0[0] + w1 * c1[0]; v[j].y = xv.y * DN_ALPHA + w0 * c0[1] + w1 * c1[1];
            v[j].z = xv.z * DN_ALPHA + w0 * c0[2] + w1 * c1[2]; v[j].w = xv.w * DN_ALPHA + w0 * c0[3] + w1 * c1[3];
        }
        float s = 0.f;
#pragma unroll
        for (int j = 0; j < 4; ++j) s += v[j].x + v[j].y + v[j].z + v[j].w;
#pragma unroll
        for (int o = 1; o < 64; o <<= 1) s += __shfl_xor(s, o);
        const float mu = s * (1.f / 1024.f);
        float q = 0.f;
#pragma unroll
        for (int j = 0; j < 4; ++j) { const float a = v[j].x - mu, b2 = v[j].y - mu, c = v[j].z - mu, d = v[j].w - mu; q += a * a + b2 * b2 + c * c + d * d; }
#pragma unroll
        for (int o = 1; o < 64; o <<= 1) q += __shfl_xor(q, o);
        const float rstd = rsqrtf(q * (1.f / 1024.f) + 1e-5f);
#pragma unroll
        for (int j = 0; j < 4; ++j) {
            const int d0 = 256 * j + 4 * lane;
            const float4 gg = *(const float4*)(gam + d0), bb = *(const float4*)(bet + d0);
            float4 y; y.x = (v[j].x - mu) * rstd * gg.x + bb.x; y.y = (v[j].y - mu) * rstd * gg.y + bb.y; y.z = (v[j].z - mu) * rstd * gg.z + bb.z; y.w = (v[j].w - mu) * rstd * gg.w + bb.w;
            *(float4*)(XO + (size_t)tok * 1024 + d0) = y;
            u32x2 w; w.x = pack2(y.x, y.y); w.y = pack2(y.z, y.w);
            *(u32x2*)(XB + (size_t)tok * 1024 + d0) = w;
        }
    }
}

#define XB_TMO      128
#define XB_XCNT(j)  (256  + 64 * (j))
#define XB_XSUB(j)  (1280 + 64 * (j))
#define XB_XGEN(j)  (2304 + 64 * (j))
#define XB_TOP      3328
#define XB_TOPGEN   3392
#define XCD_BAR_WORDS 3456
#define XB_SPIN_CAP (1u << 22)
#define LAS __attribute__((address_space(3)))
__device__ __forceinline__ unsigned xb_ld(unsigned* p)              { return __hip_atomic_load(p, __ATOMIC_RELAXED, __HIP_MEMORY_SCOPE_AGENT); }
__device__ __forceinline__ unsigned xb_add(unsigned* p, unsigned v) { return __hip_atomic_fetch_add(p, v, __ATOMIC_RELAXED, __HIP_MEMORY_SCOPE_AGENT); }
__device__ __forceinline__ unsigned xb_xcc_id() { return (unsigned)__builtin_amdgcn_s_getreg((3 << 11) | 20) & 0xFu; }
#define XB_SPIN(cond, bar) do { unsigned _sp = 0; while (cond) { __builtin_amdgcn_s_sleep(1); \
    if ((++_sp & 255u) == 0u) { if (xb_ld(&(bar)[XB_TMO])) break; if (_sp > XB_SPIN_CAP) { atomicAdd(&(bar)[XB_TMO], 1u); break; } } } } while (0)
struct XcdBarrier { unsigned* bar; unsigned x; volatile LAS unsigned* st; };
__device__ __forceinline__ XcdBarrier xcd_barrier_post(unsigned* bar, volatile LAS unsigned* st) {
    XcdBarrier b; b.bar = bar; b.x = xb_xcc_id(); b.st = st;
    if (threadIdx.x == 0) (void)xb_add(&bar[XB_XCNT(b.x)], 1u);
    return b;
}
__device__ __forceinline__ void xcd_barrier_complete(unsigned* bar, unsigned x, unsigned& nloc, unsigned& nx) {
    const unsigned G = gridDim.x * gridDim.y * gridDim.z;
    unsigned sum, cnt, mine, sp = 0u;
    for (;;) {
        sum = 0u; cnt = 0u; mine = 0u;
#pragma unroll
        for (unsigned j = 0; j < 16; ++j) { const unsigned c = xb_ld(&bar[XB_XCNT(j)]); sum += c; cnt += (c > 0u) ? 1u : 0u; mine = (j == x) ? c : mine; }
        if (sum == G) break;
        __builtin_amdgcn_s_sleep(1);
        if ((++sp & 255u) == 0u) { if (xb_ld(&bar[XB_TMO])) break; if (sp > XB_SPIN_CAP) { atomicAdd(&bar[XB_TMO], 1u); break; } }
    }
    nloc = mine > 0u ? mine : 1u; nx = cnt > 0u ? cnt : 1u;
}
__device__ __forceinline__ void xcd_barrier(const XcdBarrier& b) {
    asm volatile("s_waitcnt vmcnt(0)" ::: "memory");
    __syncthreads();
    if (threadIdx.x == 0) {
        unsigned* bar = b.bar;
        __builtin_amdgcn_s_waitcnt(0);
        unsigned nloc = b.st[0], nx = b.st[1];
        if (nloc == 0u) { xcd_barrier_complete(bar, b.x, nloc, nx); b.st[0] = nloc; b.st[1] = nx; }
        const unsigned old = xb_add(&bar[XB_XSUB(b.x)], 1u);
        const unsigned gen = old / nloc;
        if (old + 1u == (gen + 1u) * nloc) {
            __builtin_amdgcn_fence(__ATOMIC_RELEASE, "agent");
            asm volatile("s_waitcnt vmcnt(0)" ::: "memory");
            const unsigned og = xb_add(&bar[XB_TOP], 1u);
            const unsigned tg = og / nx;
            if (og + 1u == (tg + 1u) * nx) xb_add(&bar[XB_TOPGEN], 1u);
            else XB_SPIN(xb_ld(&bar[XB_TOPGEN]) == tg, bar);
            __builtin_amdgcn_fence(__ATOMIC_ACQUIRE, "agent");
            xb_add(&bar[XB_XGEN(b.x)], 1u);
            asm volatile("s_waitcnt vmcnt(0)" ::: "memory");
        } else {
            XB_SPIN(xb_ld(&bar[XB_XGEN(b.x)]) == gen, bar);
            __builtin_amdgcn_fence(__ATOMIC_ACQUIRE, "agent");
            asm volatile("s_waitcnt vmcnt(0)" ::: "memory");
        }
    }
    __syncthreads();
}

constexpr int PH_PER_LAYER = 11, N_PHASES = PH_PER_LAYER * NLAYER;
__global__ void __launch_bounds__(NTHREADS, 2) mega(Params p) {
    extern __shared__ __attribute__((aligned(16))) unsigned char lds[];
#if SINGLE_LAUNCH
    volatile LAS unsigned* xbw = (volatile LAS unsigned*)(lds + LDS_BYTES - 16);
    if (threadIdx.x < 4) xbw[threadIdx.x] = 0u;
    __syncthreads();
    XcdBarrier xbar = xcd_barrier_post((unsigned*)(p.ws + WS_CTL) + CW_BAR, xbw);
#endif
    for (int ph = p.ph_lo; ph < p.ph_hi; ++ph) {
        const int layer = ph / PH_PER_LAYER, k = ph % PH_PER_LAYER;
#ifdef ONLY_PHASE
        if (k != ONLY_PHASE) continue;
#endif
#ifdef REPEAT_MASK
        for (int rep = 0; rep < (((REPEAT_MASK) >> k) & 1) + 1; ++rep) {
        if (rep) __syncthreads();
#endif
        switch (k) {
            case 0: phase_pw(p, layer, lds); break;
            case 1: phase_g1(p, layer, lds); break;
            case 2: phase_p2(p, layer, lds); break;
            case 3: phase_p3(p, lds); break;
            case 4: phase_p4(p, lds); break;
            case 5: phase_g2(p, lds); break;
            case 6: phase_g3(p, layer, lds); break;
#ifdef REPEAT_MASK
            case 7: phase_ln1(p, layer, lds, (((REPEAT_MASK) >> 7) & 1) && rep == 0); break;
#else
            case 7: phase_ln1(p, layer, lds, false); break;
#endif
            case 8: phase_m2(p, layer, lds); break;
            case 9: phase_m3(p, layer, lds); break;
            case 10: phase_ln2(p, layer); break;
        }
#ifdef REPEAT_MASK
        }
#endif
#if SINGLE_LAUNCH
        if (ph + 1 < p.ph_hi) { if (ph == p.ph_lo) cg::this_grid().sync(); else xcd_barrier(xbar); }
#endif
    }
}

extern "C" void kernel_launch(void* const* d_in, const int* in_sizes, int n_in, void* d_out, int out_size, void* d_ws, size_t ws_size, hipStream_t stream) {
    static int grid = 0;
    if (grid == 0) {
        if (n_in != 18 || ws_size < WS_END) { fprintf(stderr, "kernel_launch: unexpected n_in %d or ws_size %zu < %zu\n", n_in, ws_size, (size_t)WS_END); grid = -1; return; }
        int dev = 0, cus = 0, per_cu = 0;
        hipGetDevice(&dev); hipDeviceGetAttribute(&cus, hipDeviceAttributeMultiprocessorCount, dev);
        hipFuncSetAttribute((const void*)mega, hipFuncAttributeMaxDynamicSharedMemorySize, LDS_BYTES);
        hipOccupancyMaxActiveBlocksPerMultiprocessor(&per_cu, (const void*)mega, NTHREADS, LDS_BYTES);
        if (per_cu < 1) per_cu = 1;
        if (per_cu > 2) per_cu = 2;
        grid = cus * per_cu;
        (void)hipGetLastError();
    }
    if (grid < 0) return;
    Params p{};
    p.x = (const float*)d_in[0]; p.w_in = (const float*)d_in[1]; p.cmp_pos = (const float*)d_in[2]; p.cmp_w1 = (const float*)d_in[3]; p.cmp_w2 = (const float*)d_in[4];
    p.w_br_a = (const float*)d_in[5]; p.w_br_b = (const float*)d_in[6]; p.w_o = (const float*)d_in[7]; p.ln1_g = (const float*)d_in[8]; p.ln1_b = (const float*)d_in[9];
    p.w_router = (const float*)d_in[10]; p.router_bias = (const float*)d_in[11]; p.w_gate = (const float*)d_in[12]; p.w_up = (const float*)d_in[13]; p.w_down = (const float*)d_in[14];
    p.ln2_g = (const float*)d_in[15]; p.ln2_b = (const float*)d_in[16]; p.rel_bias = (const float*)d_in[17];
    p.out = (float*)d_out; p.ws = (unsigned char*)d_ws;
#if SINGLE_LAUNCH
    hipMemsetAsync((unsigned char*)d_ws + WS_CTL + (size_t)CW_BAR * 4, 0, XCD_BAR_WORDS * 4, stream);
    p.ph_lo = 0; p.ph_hi = N_PHASES;
    void* args[] = {&p};
    hipError_t e = hipLaunchCooperativeKernel((const void*)mega, dim3(grid), dim3(NTHREADS), args, LDS_BYTES, stream);
    if (e != hipSuccess) fprintf(stderr, "cooperative launch failed: %s (grid %d)\n", hipGetErrorString(e), grid);
#else
    for (int ph = 0; ph < N_PHASES; ++ph) {
        p.ph_lo = ph; p.ph_hi = ph + 1;
        hipLaunchKernelGGL(mega, dim3(grid), dim3(NTHREADS), LDS_BYTES, stream, p);
    }
#endif
}
```

```cpp
#include <hip/hip_runtime.h>
#include <hip/hip_cooperative_groups.h>
#include <cstdio>
#include <cstdint>
namespace cg = cooperative_groups;

#ifndef SINGLE_LAUNCH
#define SINGLE_LAUNCH 1
#endif

typedef unsigned short bf16_t;
typedef short bf16x8 __attribute__((ext_vector_type(8)));
typedef float f32x4 __attribute__((ext_vector_type(4)));
typedef unsigned u32x2 __attribute__((ext_vector_type(2)));
typedef unsigned u32x4 __attribute__((ext_vector_type(4)));

constexpr int B_ = 2, S_ = 8192, D_ = 1024, T_ = B_ * S_, NLAYER = 4;
constexpr int DIN = 6424;
constexpr int LD = 6528;
constexpr int C_QA = 0, C_KC = 512, C_VC = 640, C_KS = 768, C_VS = 896, C_KW = 1024, C_VW = 1152, C_QR = 1280, C_KR = 1792,
              C_VR = 2304, C_GR = 3328, C_MA = 4352, C_MB = 5376, C_GA = 6400;
constexpr float DN_ALPHA = 1.681792830507429f;
constexpr int NE = 16;

constexpr size_t al256(size_t x) { return (x + 255) & ~(size_t)255; }
constexpr size_t WS_CTL = 0;
constexpr size_t WS_BUCKET = 65536;
constexpr size_t WS_ROPE = WS_BUCKET + 8192;
constexpr size_t WS_WIN = WS_ROPE + (size_t)8192 * 32 * 8;
constexpr size_t WS_WA = WS_WIN + (size_t)LD * 1024 * 2;
constexpr size_t WS_WB = WS_WA + (size_t)1024 * 512 * 2;
constexpr size_t WS_WO = WS_WB + (size_t)1024 * 1024 * 2;
constexpr size_t WS_WG = WS_WO + (size_t)1024 * 1024 * 2;
constexpr size_t WS_WU = WS_WG + (size_t)16 * 512 * 1024 * 2;
constexpr size_t WS_WD = WS_WU + (size_t)16 * 512 * 1024 * 2;
constexpr size_t WS_XB = WS_WD + (size_t)16 * 512 * 1024 * 2;
constexpr size_t WS_X = WS_XB + (size_t)T_ * 1024 * 2;
constexpr size_t WS_MG = WS_X + (size_t)T_ * 1024 * 4;
constexpr size_t WS_KCC = WS_MG + (size_t)T_ * 1024 * 2;
constexpr size_t WS_VCCT = WS_KCC + (size_t)4 * 512 * 64 * 2;
constexpr size_t WS_W1T = WS_VCCT + (size_t)4 * 512 * 64 * 2;
constexpr size_t WS_B1 = WS_W1T + (size_t)2 * 64 * 2048 * 2;
constexpr size_t WS_R = WS_B1 + 1024;
constexpr size_t WS_P = WS_R;
constexpr size_t WS_VST = WS_P + (size_t)T_ * LD * 2;
constexpr size_t WS_VWT = WS_VST + (size_t)4 * 64 * S_ * 2;
constexpr size_t WS_VRT = WS_VWT + (size_t)4 * 64 * S_ * 2;
constexpr size_t WS_KVT = WS_VRT + (size_t)16 * 128 * S_ * 2;
constexpr size_t WS_SPT = WS_KVT + (size_t)16 * 64 * 8192 * 4;
constexpr size_t WS_YC = WS_SPT + (size_t)16 * 64 * 8192 * 2;
constexpr size_t WS_YW = WS_YC + (size_t)T_ * 512 * 2;
constexpr size_t WS_YA = WS_YW + (size_t)T_ * 512 * 2;
constexpr size_t WS_YB = WS_YA + (size_t)T_ * 512 * 2;
constexpr size_t WS_SELW = WS_YB + (size_t)T_ * 1024 * 2;
constexpr size_t WS_ENDA = WS_SELW + (size_t)T_ * 2 * 4 * 4;
constexpr size_t WS_H1 = WS_R;
constexpr size_t WS_X1 = WS_H1 + (size_t)T_ * 1024 * 4;
constexpr size_t WS_X1B = WS_X1 + (size_t)T_ * 1024 * 4;
constexpr size_t WS_HB = WS_X1B + (size_t)T_ * 1024 * 2;
constexpr size_t WS_CT = WS_P + (size_t)T_ * LD * 2;
constexpr size_t WS_LIST = WS_CT + (size_t)2 * T_ * 1024 * 2;
constexpr size_t WS_WTS = WS_LIST + (size_t)16 * T_ * 4;
constexpr size_t WS_ENDB = WS_WTS + (size_t)2 * T_ * 4;
static_assert(WS_HB + (size_t)2 * T_ * 512 * 2 <= WS_CT, "view B overlap");
constexpr size_t WS_END = WS_ENDA > WS_ENDB ? WS_ENDA : WS_ENDB;

constexpr int CW_CNT = 4096;
constexpr int CW_BAR = 8192;

constexpr int LDS_BYTES = 75776;
constexpr int NTHREADS = 256;

struct Params {
    const float* x; const float* w_in; const float* cmp_pos; const float* cmp_w1; const float* cmp_w2;
    const float* w_br_a; const float* w_br_b; const float* w_o; const float* ln1_g; const float* ln1_b;
    const float* w_router; const float* router_bias; const float* w_gate; const float* w_up; const float* w_down;
    const float* ln2_g; const float* ln2_b; const float* rel_bias;
    float* out; unsigned char* ws;
    int ph_lo, ph_hi;
};

__device__ __forceinline__ bf16_t f2bf(float f) { unsigned u = __float_as_uint(f); u += 0x7fffu + ((u >> 16) & 1u); return (bf16_t)(u >> 16); }
__device__ __forceinline__ float bf2f(unsigned h) { return __uint_as_float(h << 16); }
typedef __bf16 bf16x2_t __attribute__((ext_vector_type(2)));
typedef float f32x2_t __attribute__((ext_vector_type(2)));
__device__ __forceinline__ unsigned pack2(float lo, float hi) { const f32x2_t f = {lo, hi}; return __builtin_bit_cast(unsigned, __builtin_convertvector(f, bf16x2_t)); }
__device__ __forceinline__ u32x2 pack4(f32x4 v) { u32x2 r; r.x = pack2(v[0], v[1]); r.y = pack2(v[2], v[3]); return r; }
__device__ __forceinline__ f32x4 unpack4(u32x2 u) { f32x4 r; r[0] = bf2f(u.x & 0xffffu); r[1] = bf2f(u.x >> 16); r[2] = bf2f(u.y & 0xffffu); r[3] = bf2f(u.y >> 16); return r; }
__device__ __forceinline__ float rows_max(float v) {
    u32x2 r = __builtin_amdgcn_permlane16_swap(__float_as_uint(v), __float_as_uint(v), false, false);
    v = fmaxf(__uint_as_float(r.x), __uint_as_float(r.y));
    r = __builtin_amdgcn_permlane32_swap(__float_as_uint(v), __float_as_uint(v), false, false);
    return fmaxf(__uint_as_float(r.x), __uint_as_float(r.y));
}
__device__ __forceinline__ float rows_sum(float v) {
    u32x2 r = __builtin_amdgcn_permlane16_swap(__float_as_uint(v), __float_as_uint(v), false, false);
    v = __uint_as_float(r.x) + __uint_as_float(r.y);
    r = __builtin_amdgcn_permlane32_swap(__float_as_uint(v), __float_as_uint(v), false, false);
    return __uint_as_float(r.x) + __uint_as_float(r.y);
}
__device__ __forceinline__ float sigmoidf_(float x) { return 1.f / (1.f + __expf(-x)); }
__device__ __forceinline__ int vzero() { int z; asm volatile("v_mov_b32 %0, 0" : "=v"(z)); return z; }
__device__ __forceinline__ unsigned char* launder(unsigned char* q) { asm volatile("" : "+s"(q)); return q; }
__device__ __forceinline__ void wait_vm0() { asm volatile("s_waitcnt vmcnt(0)" ::: "memory"); }

__device__ __forceinline__ void glds16(const void* g, void* l) {
    __builtin_amdgcn_global_load_lds((const __attribute__((address_space(1))) unsigned*)g,
                                     (__attribute__((address_space(3))) unsigned*)l, 16, 0, 0);
}
__device__ __forceinline__ f32x4 mfma16(bf16x8 a, bf16x8 b, f32x4 c) { return __builtin_amdgcn_mfma_f32_16x16x32_bf16(a, b, c, 0, 0, 0); }

__device__ __forceinline__ void gemm_stage(const bf16_t* const (&mp)[4], const bf16_t* const (&np)[4], int kt, unsigned char* st, int wid) {
#pragma unroll
    for (int i = 0; i < 4; ++i) {
        glds16(mp[i] + kt * 64, st + (4 * i + wid) * 1024);
        glds16(np[i] + kt * 64, st + 16384 + (4 * i + wid) * 1024);
    }
}
__device__ __forceinline__ void gemm_compute(const unsigned char* st, f32x4 (&acc)[4][4], int wr, int wc, int fr, int fq) {
#pragma unroll
    for (int ks = 0; ks < 2; ++ks) {
        bf16x8 a[4], b[4];
        const int sw = ((4 * ks + fq) ^ (fr & 7)) << 4;
#pragma unroll
        for (int i = 0; i < 4; ++i) {
            a[i] = *(const bf16x8*)(st + (64 * wr + 16 * i + fr) * 128 + sw);
            b[i] = *(const bf16x8*)(st + 16384 + (64 * wc + 16 * i + fr) * 128 + sw);
        }
#pragma unroll
        for (int i = 0; i < 4; ++i)
#pragma unroll
            for (int j = 0; j < 4; ++j) acc[i][j] = mfma16(a[i], b[j], acc[i][j]);
    }
}
#define WAIT_V(n) asm volatile("s_waitcnt vmcnt(%0)" ::"n"(n) : "memory")
#define RAW_BARRIER() do { asm volatile("s_waitcnt lgkmcnt(0)" ::: "memory"); __builtin_amdgcn_s_barrier(); } while (0)
__device__ __forceinline__ void gemm_kloop(const bf16_t* const (&mp)[4], const bf16_t* const (&np)[4], int nk, unsigned char* lds, f32x4 (&acc)[4][4]) {
    const int tid = threadIdx.x, lane = tid & 63, wid = tid >> 6, wr = wid >> 1, wc = wid & 1, fr = lane & 15, fq = lane >> 4;
    gemm_stage(mp, np, 0, lds, wid);
    gemm_stage(mp, np, 1, lds + 32768, wid);
    for (int kt = 0; kt < nk; ++kt) {
        unsigned char* cur = lds + (kt & 1) * 32768;
        if (kt + 1 < nk) WAIT_V(8); else WAIT_V(0);
        RAW_BARRIER();
        bf16x8 a[2][4], b[2][4];
#pragma unroll
        for (int ks = 0; ks < 2; ++ks) {
            const int sw = ((4 * ks + fq) ^ (fr & 7)) << 4;
#pragma unroll
            for (int i = 0; i < 4; ++i) {
                a[ks][i] = *(const bf16x8*)(cur + (64 * wr + 16 * i + fr) * 128 + sw);
                b[ks][i] = *(const bf16x8*)(cur + 16384 + (64 * wc + 16 * i + fr) * 128 + sw);
            }
        }
        RAW_BARRIER();
        if (kt + 2 < nk) gemm_stage(mp, np, kt + 2, cur, wid);
#pragma unroll
        for (int ks = 0; ks < 2; ++ks)
#pragma unroll
            for (int i = 0; i < 4; ++i)
#pragma unroll
                for (int j = 0; j < 4; ++j) acc[i][j] = mfma16(a[ks][i], b[ks][j], acc[i][j]);
    }
    __syncthreads();
}
__device__ __forceinline__ void zero_acc(f32x4 (&acc)[4][4]) {
#pragma unroll
    for (int i = 0; i < 4; ++i)
#pragma unroll
        for (int j = 0; j < 4; ++j) acc[i][j] = (f32x4){0.f, 0.f, 0.f, 0.f};
}

__device__ void tcvt_tile(const float* src, int ld_src, int k0, int n0, int mode, bf16_t* dst, int kdst, unsigned char* lds) {
    float* tile = (float*)lds;
    const int tid = threadIdx.x + vzero();
#pragma unroll
    for (int i = 0; i < 4; ++i) {
        const int kk = (tid >> 4) + 16 * i, c4 = (tid & 15) * 4, cd = n0 + c4;
        int orig = cd; bool ok = true;
        if (mode == 1) { if (cd < 1280) orig = cd; else if (cd < 6400) orig = cd + 24; else if (cd < 6424) orig = cd - 6400 + 1280; else ok = false; }
        float4 v = make_float4(0.f, 0.f, 0.f, 0.f);
        if (ok) v = *(const float4*)(src + (size_t)(k0 + kk) * ld_src + orig);
        tile[kk * 65 + c4 + 0] = v.x; tile[kk * 65 + c4 + 1] = v.y; tile[kk * 65 + c4 + 2] = v.z; tile[kk * 65 + c4 + 3] = v.w;
    }
    __syncthreads();
#pragma unroll
    for (int i = 0; i < 2; ++i) {
        const int q = tid + 256 * i, n = q >> 3, kc = q & 7;
        float v[8];
#pragma unroll
        for (int j = 0; j < 8; ++j) v[j] = tile[(kc * 8 + j) * 65 + n];
        u32x4 w; w.x = pack2(v[0], v[1]); w.y = pack2(v[2], v[3]); w.z = pack2(v[4], v[5]); w.w = pack2(v[6], v[7]);
        *(u32x4*)(dst + (size_t)(n0 + n) * kdst + k0 + kc * 8) = w;
    }
    __syncthreads();
}

__device__ void phase_pw(const Params& p, int layer, unsigned char* lds) {
    const int bid = blockIdx.x, nblk = gridDim.x, tid = threadIdx.x + vzero();
    unsigned char* ws = launder(p.ws);
    constexpr int J0 = 16 * 102, J1 = 8 * 16, J2 = 256, J3 = 256, J4 = 2048, J5 = 2048, J6 = 2048, JT = J0 + J1 + J2 + J3 + J4 + J5 + J6;
    for (int t = bid; t < JT; t += nblk) {
        int u = t;
        if (u < J0) { tcvt_tile(p.w_in + (size_t)layer * 1024 * DIN, DIN, (u % 16) * 64, (u / 16) * 64, 1, (bf16_t*)(ws + WS_WIN), 1024, lds); continue; }
        u -= J0;
        if (u < J1) { tcvt_tile(p.w_br_a + (size_t)layer * 512 * 1024, 1024, (u % 8) * 64, (u / 8) * 64, 0, (bf16_t*)(ws + WS_WA), 512, lds); continue; }
        u -= J1;
        if (u < J2) { tcvt_tile(p.w_br_b + (size_t)layer * 1024 * 1024, 1024, (u % 16) * 64, (u / 16) * 64, 0, (bf16_t*)(ws + WS_WB), 1024, lds); continue; }
        u -= J2;
        if (u < J3) { tcvt_tile(p.w_o + (size_t)layer * 1024 * 1024, 1024, (u % 16) * 64, (u / 16) * 64, 0, (bf16_t*)(ws + WS_WO), 1024, lds); continue; }
        u -= J3;
        if (u < J4 + J5) {
            const bool up = u >= J4; if (up) u -= J4;
            const int e = u / 128, v = u % 128;
            const float* src = (up ? p.w_up : p.w_gate) + ((size_t)layer * NE + e) * 1024 * 512;
            tcvt_tile(src, 512, (v % 16) * 64, (v / 16) * 64, 0, (bf16_t*)(ws + (up ? WS_WU : WS_WG)) + (size_t)e * 512 * 1024, 1024, lds); continue;
        }
        u -= J4 + J5;
        { const int e = u / 128, v = u % 128;
          const float* src = p.w_down + ((size_t)layer * NE + e) * 512 * 1024;
          tcvt_tile(src, 1024, (v % 8) * 64, (v / 8) * 64, 0, (bf16_t*)(ws + WS_WD) + (size_t)e * 1024 * 512, 512, lds); }
    }
    for (int t = bid; t < 64; t += nblk) {
        const int kv = t >> 5, kt = t & 31;
        tcvt_tile(p.cmp_w1 + ((size_t)layer * 2 + kv) * 2048 * 64, 64, kt * 64, 0, 0, (bf16_t*)(ws + WS_W1T) + (size_t)kv * 64 * 2048, 2048, lds);
    }
    if (bid >= nblk - 2) {
        const int kv = nblk - 1 - bid, n = tid & 63, part = tid >> 6;
        const float* w1 = p.cmp_w1 + ((size_t)layer * 2 + kv) * 2048 * 64; const float* pos = p.cmp_pos + ((size_t)layer * 2 + kv) * 2048;
        float a = 0.f;
        for (int k = part * 512; k < part * 512 + 512; ++k) a += pos[k] * w1[(size_t)k * 64 + n];
        float* red = (float*)lds;
        __syncthreads(); red[tid] = a; __syncthreads();
        if (tid < 64) ((float*)(ws + WS_B1))[kv * 64 + tid] = red[tid] + red[tid + 64] + red[tid + 128] + red[tid + 192];
        __syncthreads();
    }
    if (layer == 0) {
        const float4* xs = (const float4*)p.x; u32x2* xb = (u32x2*)(ws + WS_XB);
        for (size_t i = (size_t)bid * NTHREADS + tid; i < (size_t)T_ * 1024 / 4; i += (size_t)nblk * NTHREADS) {
            float4 v = xs[i]; u32x2 w; w.x = pack2(v.x, v.y); w.y = pack2(v.z, v.w); xb[i] = w;
        }
        for (int n = bid * NTHREADS + tid; n < 8192; n += nblk * NTHREADS) {
            int bk;
            if (n < 16) bk = n;
            else { const int th[15] = {22, 30, 40, 54, 73, 99, 134, 182, 246, 332, 450, 609, 825, 1117, 1513}; bk = 16;
#pragma unroll
                for (int k = 0; k < 15; ++k) bk += (n >= th[k]) ? 1 : 0; }
            (ws + WS_BUCKET)[n] = (unsigned char)bk;
        }
        for (int i = bid * NTHREADS + tid; i < 8192 * 32; i += nblk * NTHREADS) {
            const int pos = i >> 5, d = i & 31;
            const float inv = powf(10000.f, -(float)d * 2.0f / 64.f);
            const float ang = (float)pos * inv;
            float sn, cs; sincosf(ang, &sn, &cs);
            ((float2*)(ws + WS_ROPE))[i] = make_float2(cs, sn);
        }
        if (bid == 0) for (int i = tid; i < 8192; i += NTHREADS) ((unsigned*)(ws + WS_CTL))[i] = 0u;
    }
}

__device__ void phase_g1(const Params& p, int layer, unsigned char* lds) {
    unsigned char* ws = launder(p.ws);
    const bf16_t* XB = (const bf16_t*)(ws + WS_XB);
    const bf16_t* WT = (const bf16_t*)(ws + WS_WIN);
    bf16_t* P = (bf16_t*)(ws + WS_P);
    const int tid = threadIdx.x + vzero(), lane = tid & 63, wid = tid >> 6, wr = wid >> 1, wc = wid & 1, fr = lane & 15, fq = lane >> 4;
    const int ldrow = 8 * wid + (lane >> 3), ldc = ((lane & 7) ^ (lane >> 3)) * 8;
    const float2* rope = (const float2*)(ws + WS_ROPE);
    const int xcd = blockIdx.x & 7, slot = blockIdx.x >> 3, per = gridDim.x >> 3;
    for (int i = slot; i < 816; i += per) {
        int mt, nt;
        if (i < 768) { mt = i / 6; nt = xcd + 8 * (i % 6); } else { const int u = i - 768; mt = 16 * xcd + u / 3; nt = 48 + u % 3; }
        const int m0 = mt * 128, n0 = nt * 128;
        const bool transposed = (nt == 7) || (nt == 9) || (nt >= 18 && nt <= 25);
        const bf16_t* mp[4]; const bf16_t* np[4];
#pragma unroll
        for (int i = 0; i < 4; ++i) {
            const bf16_t* wrow = WT + (size_t)(n0 + 32 * i + ldrow) * 1024 + ldc;
            const bf16_t* xrow = XB + (size_t)(m0 + 32 * i + ldrow) * 1024 + ldc;
            mp[i] = transposed ? xrow : wrow; np[i] = transposed ? wrow : xrow;
        }
        f32x4 acc[4][4]; zero_acc(acc);
        gemm_kloop(mp, np, 16, lds, acc);
        if (!transposed) {
            const int kind = (nt >= 10 && nt <= 13) ? 1 : (nt >= 14 && nt <= 17) ? 2 : (nt >= 26 && nt <= 33) ? 3 : (nt >= 34) ? 4 : 0;
            if (kind == 1 || kind == 2) {
                const float sc = (kind == 2) ? 0.125f : 1.0f;
#pragma unroll
                for (int ni = 0; ni < 4; ++ni) {
                    const int tok = m0 + 64 * wc + 16 * ni + fr, pos = tok & (S_ - 1);
#pragma unroll
                    for (int mi = 0; mi < 2; ++mi) {
                        const int d = 16 * mi + 4 * fq;
                        const float4 cs01 = *(const float4*)(rope + pos * 32 + d), cs23 = *(const float4*)(rope + pos * 32 + d + 2);
                        const float c[4] = {cs01.x, cs01.z, cs23.x, cs23.z}, s[4] = {cs01.y, cs01.w, cs23.y, cs23.w};
                        f32x4 x1 = acc[mi][ni], x2 = acc[mi + 2][ni], y1, y2;
#pragma unroll
                        for (int r = 0; r < 4; ++r) { y1[r] = (x1[r] * c[r] - x2[r] * s[r]) * sc; y2[r] = (x1[r] * s[r] + x2[r] * c[r]) * sc; }
                        acc[mi][ni] = y1; acc[mi + 2][ni] = y2;
                    }
                }
            }
#pragma unroll
            for (int mi = 0; mi < 4; ++mi)
#pragma unroll
                for (int ni = 0; ni < 4; ++ni) {
                    const int n = n0 + 64 * wr + 16 * mi + 4 * fq, tok = m0 + 64 * wc + 16 * ni + fr;
                    f32x4 v = acc[mi][ni];
                    if (kind == 3) {
#pragma unroll
                        for (int r = 0; r < 4; ++r) v[r] = v[r] * sigmoidf_(v[r]);
                    } else if (kind == 4) {
#pragma unroll
                        for (int r = 0; r < 4; ++r) v[r] = sigmoidf_(v[r]);
                    }
                    *(u32x2*)(P + (size_t)tok * LD + n) = pack4(v);
                }
        } else {
#pragma unroll
            for (int mi = 0; mi < 4; ++mi)
#pragma unroll
                for (int ni = 0; ni < 4; ++ni) {
                    const int tok = m0 + 64 * wr + 16 * mi + 4 * fq, n = n0 + 64 * wc + 16 * ni + fr;
                    const int b = tok >> 13, s = tok & (S_ - 1);
                    bf16_t* dst;
                    if (nt == 7) { const int c = n - C_VS; dst = (bf16_t*)(ws + WS_VST) + ((size_t)(b * 2 + (c >> 6)) * 64 + (c & 63)) * S_ + s; }
                    else if (nt == 9) { const int c = n - C_VW; dst = (bf16_t*)(ws + WS_VWT) + ((size_t)(b * 2 + (c >> 6)) * 64 + (c & 63)) * S_ + s; }
                    else { const int c = n - C_VR; dst = (bf16_t*)(ws + WS_VRT) + ((size_t)(b * 8 + (c >> 7)) * 128 + (c & 127)) * S_ + s; }
                    *(u32x2*)dst = pack4(acc[mi][ni]);
                }
        }
    }
}

__device__ __forceinline__ void load_tile64(const bf16_t* base, size_t rowStride, unsigned char* dst, int wid, int lane) {
    const int c = ((lane & 7) ^ (lane >> 3)) * 8;
#pragma unroll
    for (int i = 0; i < 2; ++i) { const int j = wid + 4 * i, row = 8 * j + (lane >> 3); glds16(base + (size_t)row * rowStride + c, dst + j * 1024); }
}
__device__ __forceinline__ void load_tile128(const bf16_t* base, size_t rowStride, unsigned char* dst, int wid, int lane) {
    const int c = ((lane & 7) ^ (lane >> 3)) * 8;
#pragma unroll
    for (int i = 0; i < 4; ++i) { const int j = wid + 4 * i, row = 8 * j + (lane >> 3); glds16(base + (size_t)row * rowStride + c, dst + j * 1024); }
}
__device__ __forceinline__ void load_tile128w(const bf16_t* base, size_t rowStride, unsigned char* dst, int wid, int lane) {
    const int c = ((lane & 15) ^ ((4 * wid + (lane >> 4)) & 15)) * 8;
#pragma unroll
    for (int i = 0; i < 8; ++i) { const int j = wid + 4 * i, row = 4 * j + (lane >> 4); glds16(base + (size_t)row * rowStride + c, dst + j * 1024); }
}
__device__ __forceinline__ bf16x8 lds_frag128(const unsigned char* tile, int row, int chunk) {
    return *(const bf16x8*)(tile + row * 128 + ((chunk ^ (row & 7)) << 4));
}
__device__ __forceinline__ bf16x8 lds_frag256(const unsigned char* tile, int row, int chunk) {
    return *(const bf16x8*)(tile + row * 256 + ((chunk ^ (row & 15)) << 4));
}
__device__ __forceinline__ bf16x8 lds_vfrag128(const unsigned char* tile, int row, int kbase, int fq) {
    const int ca = (kbase >> 3) + (fq >> 1), hb = (fq & 1) * 8;
    const u32x2 a = *(const u32x2*)(tile + row * 128 + ((ca ^ (row & 7)) << 4) + hb);
    const u32x2 b = *(const u32x2*)(tile + row * 128 + (((ca + 2) ^ (row & 7)) << 4) + hb);
    u32x4 w; w.x = a.x; w.y = a.y; w.z = b.x; w.w = b.y;
    return __builtin_bit_cast(bf16x8, w);
}
__device__ __forceinline__ bf16x8 lds_vfrag256(const unsigned char* tile, int row, int kbase, int fq) {
    const int ca = (kbase >> 3) + (fq >> 1), hb = (fq & 1) * 8;
    const u32x2 a = *(const u32x2*)(tile + row * 256 + ((ca ^ (row & 15)) << 4) + hb);
    const u32x2 b = *(const u32x2*)(tile + row * 256 + (((ca + 2) ^ (row & 15)) << 4) + hb);
    u32x4 w; w.x = a.x; w.y = a.y; w.z = b.x; w.w = b.y;
    return __builtin_bit_cast(bf16x8, w);
}
__device__ __forceinline__ bf16x8 pack8(f32x4 a, f32x4 b) {
    u32x4 w; w.x = pack2(a[0], a[1]); w.y = pack2(a[2], a[3]); w.z = pack2(b[0], b[1]); w.w = pack2(b[2], b[3]);
    return __builtin_bit_cast(bf16x8, w);
}

__device__ __forceinline__ float gelu_tanh(float x) {
    const float u = 0.7978845608028654f * (x + 0.044715f * x * x * x);
    return 0.5f * x * (1.f + tanhf(u));
}
__device__ void compress_item(const Params& p, int layer, int item, unsigned char* lds) {
    unsigned char* ws = launder(p.ws);
    const int tid = threadIdx.x + vzero(), lane = tid & 63, wid = tid >> 6, wr = wid >> 1, wc = wid & 1, fr = lane & 15, fq = lane >> 4;
    const int mtile = item & 3, g = (item >> 2) & 1, b = (item >> 3) & 1, kv = item >> 4;
    const int i0 = mtile * 128;
    const bf16_t* P = (const bf16_t*)(ws + WS_P);
    const bf16_t* W1T = (const bf16_t*)(ws + WS_W1T) + (size_t)kv * 64 * 2048;
    const int col = (kv ? C_VC : C_KC) + g * 64;
    const int ldc = ((lane & 7) ^ (lane >> 3)) * 8;
    const bf16_t* ap[4];
#pragma unroll
    for (int i = 0; i < 4; ++i) ap[i] = P + ((size_t)b * S_ + 16 * (i0 + 32 * i + 8 * wid + (lane >> 3))) * LD + col + ldc;
    const bf16_t* bp[2];
#pragma unroll
    for (int i = 0; i < 2; ++i) bp[i] = W1T + (size_t)(8 * (wid + 4 * i) + (lane >> 3)) * 2048 + ldc;
    f32x4 acc[4][2];
#pragma unroll
    for (int i = 0; i < 4; ++i)
#pragma unroll
        for (int j = 0; j < 2; ++j) acc[i][j] = (f32x4){0.f, 0.f, 0.f, 0.f};
    __syncthreads();
#define CSTAGE(buf, l) do { unsigned char* st_ = lds + (buf) * 24576; \
        _Pragma("unroll") for (int i = 0; i < 4; ++i) glds16(ap[i] + (size_t)(l) * LD, st_ + (4 * i + wid) * 1024); \
        _Pragma("unroll") for (int i = 0; i < 2; ++i) glds16(bp[i] + (l) * 64, st_ + 16384 + (wid + 4 * i) * 1024); } while (0)
    CSTAGE(0, 0); wait_vm0(); __syncthreads();
    for (int l = 0; l < 32; ++l) {
        const unsigned char* st = lds + (l & 1) * 24576;
        if (l + 1 < 32) CSTAGE((l + 1) & 1, l + 1);
#pragma unroll
        for (int ks = 0; ks < 2; ++ks) {
            bf16x8 a[4], bb[2];
#pragma unroll
            for (int i = 0; i < 4; ++i) a[i] = lds_frag128(st, 64 * wr + 16 * i + fr, 4 * ks + fq);
#pragma unroll
            for (int j = 0; j < 2; ++j) bb[j] = lds_frag128(st + 16384, 32 * wc + 16 * j + fr, 4 * ks + fq);
#pragma unroll
            for (int i = 0; i < 4; ++i)
#pragma unroll
                for (int j = 0; j < 2; ++j) acc[i][j] = mfma16(a[i], bb[j], acc[i][j]);
        }
        wait_vm0(); __syncthreads();
    }
#undef CSTAGE
    float* hid = (float*)lds;
    const float* b1 = (const float*)(ws + WS_B1) + kv * 64;
#pragma unroll
    for (int j = 0; j < 2; ++j) {
        const int n = 32 * wc + 16 * j + fr; const float bias = b1[n + vzero()];
#pragma unroll
        for (int i = 0; i < 4; ++i)
#pragma unroll
            for (int r = 0; r < 4; ++r) hid[(64 * wr + 16 * i + 4 * fq + r) * 65 + n] = gelu_tanh(acc[i][j][r] + bias);
    }
    __syncthreads();
    {
        const int row = tid >> 1, nb = (tid & 1) * 32, ci = i0 + row;
        const float* w2 = p.cmp_w2 + ((size_t)layer * 2 + kv) * 64 * 64;
        float o[32];
#pragma unroll
        for (int q = 0; q < 32; ++q) o[q] = 0.f;
        for (int n = 0; n < 64; ++n) {
            const float h = hid[row * 65 + n];
#pragma unroll
            for (int q4 = 0; q4 < 8; ++q4) { const float4 w = *(const float4*)(w2 + n * 64 + nb + 4 * q4); o[4 * q4] += h * w.x; o[4 * q4 + 1] += h * w.y; o[4 * q4 + 2] += h * w.z; o[4 * q4 + 3] += h * w.w; }
        }
        if (kv == 0) {
            bf16_t* dst = (bf16_t*)(ws + WS_KCC) + ((size_t)(b * 2 + g) * 512 + ci) * 64 + nb;
#pragma unroll
            for (int q = 0; q < 32; q += 4) { f32x4 v = {o[q], o[q + 1], o[q + 2], o[q + 3]}; if (ci >= 511) v = (f32x4){0.f, 0.f, 0.f, 0.f}; *(u32x2*)(dst + q) = pack4(v); }
        } else {
            bf16_t* dst = (bf16_t*)(ws + WS_VCCT) + ((size_t)(b * 2 + g) * 64 + nb) * 512 + ci;
#pragma unroll
            for (int q = 0; q < 32; ++q) dst[(size_t)q * 512] = f2bf(ci >= 511 ? 0.f : o[q]);
        }
    }
    __syncthreads();
}

__device__ __forceinline__ float ret_lg2(int h) { const float gam = 1.f - exp2f(-5.f - (float)h); return log2f(gam); }

__device__ void retkv_item(const Params& p, int item, unsigned char* lds) {
    unsigned char* ws = launder(p.ws);
    const int tid = threadIdx.x + vzero(), lane = tid & 63, wid = tid >> 6, fr = lane & 15, fq = lane >> 4;
    const int n = item & 63, h = (item >> 6) & 7, b = item >> 9;
    const size_t tok0 = (size_t)b * S_ + 128 * n;
    unsigned char* vL = lds; unsigned char* kL = lds + 32768;
    load_tile128w((const bf16_t*)(ws + WS_VRT) + ((size_t)(b * 8 + h) * 128) * S_ + 128 * n, S_, vL, wid, lane);
    load_tile128((const bf16_t*)(ws + WS_P) + tok0 * LD + C_KR + h * 64, LD, kL, wid, lane);
    wait_vm0(); __syncthreads();
    const float lg2 = ret_lg2(h);
    f32x4 acc[2][4];
#pragma unroll
    for (int m = 0; m < 2; ++m)
#pragma unroll
        for (int nt = 0; nt < 4; ++nt) acc[m][nt] = (f32x4){0.f, 0.f, 0.f, 0.f};
#pragma unroll
    for (int ks = 0; ks < 4; ++ks) {
        bf16x8 a[2], bb[4];
#pragma unroll
        for (int m = 0; m < 2; ++m) a[m] = lds_frag256(vL, 32 * wid + 16 * m + fr, 4 * ks + fq);
        float dec[8];
#pragma unroll
        for (int j = 0; j < 8; ++j) dec[j] = exp2f((float)(127 - (32 * ks + 8 * fq + j)) * lg2);
#pragma unroll
        for (int nt = 0; nt < 4; ++nt) {
            const int d = 16 * nt + fr;
            float v[8];
#pragma unroll
            for (int j = 0; j < 8; ++j) {
                const int tk = 32 * ks + 8 * fq + j;
                const bf16_t kvv = *(const bf16_t*)(kL + tk * 128 + (((d >> 3) ^ (tk & 7)) << 4) + (d & 7) * 2);
                v[j] = bf2f(kvv) * dec[j];
            }
            u32x4 w; w.x = pack2(v[0], v[1]); w.y = pack2(v[2], v[3]); w.z = pack2(v[4], v[5]); w.w = pack2(v[6], v[7]);
            bb[nt] = __builtin_bit_cast(bf16x8, w);
        }
#pragma unroll
        for (int m = 0; m < 2; ++m)
#pragma unroll
            for (int nt = 0; nt < 4; ++nt) acc[m][nt] = mfma16(a[m], bb[nt], acc[m][nt]);
    }
    float* KVT = (float*)(ws + WS_KVT) + ((size_t)(b * 8 + h) * 64 + n) * 8192;
#pragma unroll
    for (int m = 0; m < 2; ++m)
#pragma unroll
        for (int nt = 0; nt < 4; ++nt)
#pragma unroll
            for (int r = 0; r < 4; ++r) KVT[(32 * wid + 16 * m + 4 * fq + r) * 64 + 16 * nt + fr] = acc[m][nt][r];
    __syncthreads();
}

__device__ void phase_p2(const Params& p, int layer, unsigned char* lds) {
    for (int it = blockIdx.x; it < 1024 + 32; it += gridDim.x) {
        if (it < 32) compress_item(p, layer, it, lds); else retkv_item(p, it - 32, lds);
    }
}

constexpr int NSA_IMP = 32768, NSA_BUCKET = 65792, NSA_BIAS = 73984;

struct NsaLane { int t; int fr, fq, wid, lane; };

template <int BR, int PASS>
__device__ __forceinline__ void nsa_half(const unsigned char* kL, const unsigned char* vL, const unsigned char* lds, const bf16_t* qptr,
                                         f32x4 (&O)[4][4], float (&m)[4], float (&l)[4], int tile, int hf, bool selbit, const NsaLane& L, int qrow) {
    const int fr = L.fr, fq = L.fq;
    bf16x8 Kf[2][2];
#pragma unroll
    for (int i = 0; i < 2; ++i)
#pragma unroll
        for (int ks = 0; ks < 2; ++ks) Kf[i][ks] = lds_frag128(kL, 32 * hf + 16 * i + fr, 4 * ks + fq);
    unsigned vmask = 0; unsigned bk[2];
    const unsigned char* bucketL = lds + NSA_BUCKET;
#pragma unroll
    for (int i = 0; i < 2; ++i) {
        unsigned pk = 0;
#pragma unroll
        for (int r = 0; r < 4; ++r) {
            const int kk = 32 * hf + 16 * i + 4 * fq + r;
            int rel; bool ok;
            if (BR == 0) { rel = L.t - (16 * (64 * tile + kk) + 31); ok = rel >= 0; }
            else if (BR == 1) { rel = L.t - (64 * tile + kk); ok = selbit && rel >= 0; }
            else { rel = L.t - (64 * tile + kk); ok = rel >= 0 && rel < 512; }
            int rc = rel < 0 ? 0 : rel; rc = rc > 8191 ? 8191 : rc;
            pk |= (unsigned)bucketL[rc] << (8 * r);
            vmask |= (ok ? 1u : 0u) << (4 * i + r);
        }
        bk[i] = pk;
    }
    const float* biasL = (const float*)(lds + NSA_BIAS);
    float ia[2] = {0.f, 0.f}, ic[2] = {0.f, 0.f};
#pragma unroll
    for (int nt = 0; nt < 4; ++nt) {
        asm volatile("" ::: "memory");
        f32x4 S[2];
        const bf16x8 q0 = *(const bf16x8*)(qptr + nt * 64), q1 = *(const bf16x8*)(qptr + nt * 64 + 32);
#pragma unroll
        for (int i = 0; i < 2; ++i) {
            S[i] = (f32x4){0.f, 0.f, 0.f, 0.f};
            S[i] = mfma16(Kf[i][0], q0, S[i]); S[i] = mfma16(Kf[i][1], q1, S[i]);
        }
        float tmax = -1e30f;
#pragma unroll
        for (int i = 0; i < 2; ++i)
#pragma unroll
            for (int r = 0; r < 4; ++r) {
                const float bias = biasL[nt * 32 + ((bk[i] >> (8 * r)) & 0xffu)];
                const bool ok = (vmask >> (4 * i + r)) & 1u;
                const float sv = ok ? S[i][r] * 0.125f + bias : -1e30f;
                S[i][r] = sv; tmax = fmaxf(tmax, sv);
            }
        if (PASS != 1) {
            tmax = rows_max(tmax);
            const float mnew = fmaxf(m[nt], tmax), alpha = __expf(m[nt] - mnew);
            float psum = 0.f;
#pragma unroll
            for (int i = 0; i < 2; ++i)
#pragma unroll
                for (int r = 0; r < 4; ++r) {
                    const bool ok = (vmask >> (4 * i + r)) & 1u;
                    const float pv = ok ? __expf(S[i][r] - mnew) : 0.f;
                    S[i][r] = pv; psum += pv;
                }
            psum = rows_sum(psum);
            l[nt] = l[nt] * alpha + psum; m[nt] = mnew;
            if (PASS == 2) {
#pragma unroll
                for (int mt = 0; mt < 4; ++mt) O[mt][nt] = O[mt][nt] * alpha;
            }
        } else {
#pragma unroll
            for (int i = 0; i < 2; ++i) {
#pragma unroll
                for (int r = 0; r < 4; ++r) {
                    const bool ok = (vmask >> (4 * i + r)) & 1u;
                    S[i][r] = ok ? __expf(S[i][r] - m[nt]) * l[nt] : 0.f;
                }
                ia[i] += S[i][0] + S[i][1] + S[i][2] + 0.5f * S[i][3];
                ic[i] += 0.5f * S[i][3];
            }
        }
        if (PASS != 0) {
            const bf16x8 Pb = pack8(S[0], S[1]);
#pragma unroll
            for (int mt = 0; mt < 4; ++mt) O[mt][nt] = mfma16(lds_vfrag128(vL, 16 * mt + fr, 32 * hf, fq), Pb, O[mt][nt]);
        }
    }
    if (PASS == 1) {
        float* imp = (float*)(lds + NSA_IMP) + qrow * 129;
        asm volatile("" ::: "memory"); __builtin_amdgcn_wave_barrier();
#pragma unroll
        for (int i = 0; i < 2; ++i) { const int j = 16 * tile + 8 * hf + 4 * i + fq; imp[j] += ia[i]; }
        asm volatile("s_waitcnt lgkmcnt(0)" ::: "memory"); __builtin_amdgcn_wave_barrier();
#pragma unroll
        for (int i = 0; i < 2; ++i) { const int j = 16 * tile + 8 * hf + 4 * i + fq + 1; if (j < 128) imp[j] += ic[i]; }
        asm volatile("s_waitcnt lgkmcnt(0)" ::: "memory"); __builtin_amdgcn_wave_barrier();
    }
}
template <int BR, int PASS>
__device__ __forceinline__ void nsa_tile(const unsigned char* kL, const unsigned char* vL, const unsigned char* lds, const bf16_t* qptr,
                                         f32x4 (&O)[4][4], float (&m)[4], float (&l)[4], int tile, bool selbit, const NsaLane& L, int qrow) {
#pragma unroll 1
    for (int hf = 0; hf < 2; ++hf) nsa_half<BR, PASS>(kL, vL, lds, qptr, O, m, l, tile, hf, selbit, L, qrow);
}

__device__ void cmp_item(const Params& p, int item, unsigned char* lds) {
    unsigned char* ws = launder(p.ws);
    const int tid = threadIdx.x + vzero(), lane = tid & 63, wid = tid >> 6, fr = lane & 15, fq = lane >> 4;
    const int combo = item & 3, qt = 127 - (item >> 2), b = combo >> 1, g = combo & 1;
    const int q0 = qt * 64, qrow = 16 * wid + fr;
    NsaLane L; L.t = q0 + qrow; L.fr = fr; L.fq = fq; L.wid = wid; L.lane = lane;
    const size_t tok = (size_t)b * S_ + L.t;
    const bf16_t* P = (const bf16_t*)(ws + WS_P);
    __syncthreads();
    if (tid < 128) ((float*)(lds + NSA_BIAS))[tid] = p.rel_bias[(tid & 31) * 8 + 4 * g + (tid >> 5)];
    for (int i = tid; i < 64 * 129; i += NTHREADS) ((float*)(lds + NSA_IMP))[i] = 0.f;
    const bf16_t* Qf = P + tok * LD + C_QA + (4 * g) * 64 + 8 * fq;
    __syncthreads();
    f32x4 O[4][4]; float m[4], l[4];
    const bf16_t* gates = P + tok * LD + C_GA + (4 * g) * 3;
    const bf16_t* kc = (const bf16_t*)(ws + WS_KCC) + (size_t)(b * 2 + g) * 512 * 64;
    const bf16_t* vc = (const bf16_t*)(ws + WS_VCCT) + (size_t)(b * 2 + g) * 64 * 512;
    const int ntc = ((q0 + 32) >> 4) / 64 + 1;
#pragma unroll
    for (int nt = 0; nt < 4; ++nt) { m[nt] = -1e30f; l[nt] = 0.f; }
    load_tile64(kc, 64, lds, wid, lane);
    wait_vm0(); __syncthreads();
    for (int it = 0; it < ntc; ++it) {
        unsigned char* cur = lds + (it & 1) * 16384;
        if (it + 1 < ntc) load_tile64(kc + (size_t)(it + 1) * 64 * 64, 64, lds + ((it + 1) & 1) * 16384, wid, lane);
        nsa_tile<0, 0>(cur, cur + 8192, lds, Qf, O, m, l, it, true, L, qrow);
        wait_vm0(); __syncthreads();
    }
#pragma unroll
    for (int nt = 0; nt < 4; ++nt) l[nt] = l[nt] > 0.f ? 1.f / l[nt] : 0.f;
#pragma unroll
    for (int mt = 0; mt < 4; ++mt)
#pragma unroll
        for (int nt = 0; nt < 4; ++nt) O[mt][nt] = (f32x4){0.f, 0.f, 0.f, 0.f};
    load_tile64(kc, 64, lds, wid, lane); load_tile64(vc, 512, lds + 8192, wid, lane);
    wait_vm0(); __syncthreads();
    for (int it = 0; it < ntc; ++it) {
        unsigned char* cur = lds + (it & 1) * 16384;
        if (it + 1 < ntc) { unsigned char* nx = lds + ((it + 1) & 1) * 16384;
            load_tile64(kc + (size_t)(it + 1) * 64 * 64, 64, nx, wid, lane); load_tile64(vc + (it + 1) * 64, 512, nx + 8192, wid, lane); }
        nsa_tile<0, 1>(cur, cur + 8192, lds, Qf, O, m, l, it, true, L, qrow);
        wait_vm0(); __syncthreads();
    }
    bf16_t* YC = (bf16_t*)(ws + WS_YC) + tok * 512 + (4 * g) * 64;
#pragma unroll
    for (int nt = 0; nt < 4; ++nt) {
        const float gt = bf2f(gates[nt * 3 + 0]);
#pragma unroll
        for (int mt = 0; mt < 4; ++mt) *(u32x2*)(YC + nt * 64 + 16 * mt + 4 * fq) = pack4(O[mt][nt] * gt);
    }
    const int cur = qt;
    {
        float* imp = (float*)(lds + NSA_IMP) + qrow * 129 + 32 * fq;
        asm volatile("s_waitcnt lgkmcnt(0)" ::: "memory"); __builtin_amdgcn_wave_barrier();
#pragma unroll
        for (int i = 0; i < 32; ++i) {
            const int j = 32 * fq + i;
            const float v = imp[i];
            imp[i] = j > cur ? -1.f : v + ((j == 0 || j == cur || j == cur - 1) ? 1.0e4f : 0.f);
        }
        unsigned word = 0;
#pragma unroll 1
        for (int round = 0; round < 16; ++round) {
            float bv = imp[0]; int bi = 0;
#pragma unroll
            for (int i = 1; i < 32; ++i) { const float v = imp[i]; if (v > bv) { bv = v; bi = i; } }
            int gi = 32 * fq + bi;
#pragma unroll
            for (int off = 16; off <= 32; off <<= 1) {
                const float ov = __shfl_xor(bv, off); const int oi = __shfl_xor(gi, off);
                if (ov > bv || (ov == bv && oi < gi)) { bv = ov; gi = oi; }
            }
            if (bv >= 0.f && (gi >> 5) == fq) { word |= 1u << (gi & 31); imp[gi & 31] = -2.f; }
        }
        ((unsigned*)(ws + WS_SELW))[(tok * 2 + g) * 4 + fq] = word;
    }
}

__device__ void win_item(const Params& p, int item, unsigned char* lds) {
    unsigned char* ws = launder(p.ws);
    const int tid = threadIdx.x + vzero(), lane = tid & 63, wid = tid >> 6, fr = lane & 15, fq = lane >> 4;
    const int combo = item & 3, qt = 127 - (item >> 2), b = combo >> 1, g = combo & 1;
    const int q0 = qt * 64, qrow = 16 * wid + fr;
    NsaLane L; L.t = q0 + qrow; L.fr = fr; L.fq = fq; L.wid = wid; L.lane = lane;
    const size_t tok = (size_t)b * S_ + L.t;
    const bf16_t* P = (const bf16_t*)(ws + WS_P);
    __syncthreads();
    if (tid < 128) ((float*)(lds + NSA_BIAS))[tid] = p.rel_bias[(tid & 31) * 8 + 4 * g + (tid >> 5)];
    const bf16_t* Qf = P + tok * LD + C_QA + (4 * g) * 64 + 8 * fq;
    __syncthreads();
    f32x4 O[4][4]; float m[4], l[4];
    const bf16_t* gates = P + tok * LD + C_GA + (4 * g) * 3;
#pragma unroll
    for (int nt = 0; nt < 4; ++nt) { m[nt] = -1e30f; l[nt] = 0.f; }
#pragma unroll
    for (int mt = 0; mt < 4; ++mt)
#pragma unroll
        for (int nt = 0; nt < 4; ++nt) O[mt][nt] = (f32x4){0.f, 0.f, 0.f, 0.f};
    {
        const bf16_t* kb = P + ((size_t)b * S_) * LD + C_KW + g * 64;
        const bf16_t* vb = (const bf16_t*)(ws + WS_VWT) + (size_t)(b * 2 + g) * 64 * S_;
        const int k_lo = qt - 8 > 0 ? qt - 8 : 0, ntw = qt - k_lo + 1;
        load_tile64(kb + (size_t)k_lo * 64 * LD, LD, lds, wid, lane); load_tile64(vb + k_lo * 64, S_, lds + 8192, wid, lane);
        wait_vm0(); __syncthreads();
        for (int it = 0; it < ntw; ++it) {
            unsigned char* cu = lds + (it & 1) * 16384;
            if (it + 1 < ntw) { unsigned char* nx = lds + ((it + 1) & 1) * 16384;
                load_tile64(kb + (size_t)(k_lo + it + 1) * 64 * LD, LD, nx, wid, lane); load_tile64(vb + (k_lo + it + 1) * 64, S_, nx + 8192, wid, lane); }
            nsa_tile<2, 2>(cu, cu + 8192, lds, Qf, O, m, l, k_lo + it, true, L, qrow);
            wait_vm0(); __syncthreads();
        }
    }
    bf16_t* YW = (bf16_t*)(ws + WS_YW) + tok * 512 + (4 * g) * 64;
#pragma unroll
    for (int nt = 0; nt < 4; ++nt) {
        const float gt = bf2f(gates[nt * 3 + 2]) * (l[nt] > 0.f ? 1.f / l[nt] : 0.f);
#pragma unroll
        for (int mt = 0; mt < 4; ++mt) *(u32x2*)(YW + nt * 64 + 16 * mt + 4 * fq) = pack4(O[mt][nt] * gt);
    }
}

constexpr int SEL_BIAS2 = NSA_BIAS;
constexpr float LOG2E = 1.4426950408889634f;
__device__ __forceinline__ int t5_first(int bk) {
    const int th[16] = {16, 22, 30, 40, 54, 73, 99, 134, 182, 246, 332, 450, 609, 825, 1117, 1513};
    int r = 16;
#pragma unroll
    for (int k = 0; k < 16; ++k) r = (bk == 16 + k) ? th[k] : r;
    return r;
}
template <bool FAST, int HF>
__device__ __forceinline__ void sel_ntile(const bf16x8 (&Kf)[2][2], const bf16x8 (&Vf)[4], const bf16x8& q0, const bf16x8& q1, f32x4 (&O)[4], float& m, float& l,
                                          bool sb, int relb, int th, float blo, float bhi, const unsigned char* lds, int hl) {
    f32x4 S[2];
#pragma unroll
    for (int i = 0; i < 2; ++i) { S[i] = (f32x4){0.f, 0.f, 0.f, 0.f}; S[i] = mfma16(Kf[i][0], q0, S[i]); S[i] = mfma16(Kf[i][1], q1, S[i]); }
    float tmax = -1e30f;
    const float scl = (!FAST || sb) ? 0.125f * LOG2E : 0.f;
    if (FAST && !sb) { blo = -1e30f; bhi = -1e30f; }
#pragma unroll
    for (int i = 0; i < 2; ++i)
#pragma unroll
        for (int r = 0; r < 4; ++r) {
            const int rel = relb - (32 * HF + 16 * i + r);
            float bias; bool ok;
            if (FAST) { S[i][r] = S[i][r] * scl + (rel >= th ? bhi : blo); tmax = fmaxf(tmax, S[i][r]); continue; }
            else {
                int rc = rel < 0 ? 0 : rel; rc = rc > 8191 ? 8191 : rc;
                bias = ((const float*)(lds + SEL_BIAS2))[hl * 32 + (lds + NSA_BUCKET)[rc]]; ok = sb && rel >= 0;
            }
            const float sv = ok ? S[i][r] * (0.125f * LOG2E) + bias : -1e30f;
            S[i][r] = sv; tmax = fmaxf(tmax, sv);
        }
    tmax = rows_max(tmax);
    const float mnew = fmaxf(m, tmax), alpha = __builtin_amdgcn_exp2f(m - mnew);
    float psum = 0.f;
#pragma unroll
    for (int i = 0; i < 2; ++i)
#pragma unroll
        for (int r = 0; r < 4; ++r) { const float pv = __builtin_amdgcn_exp2f(S[i][r] - mnew); S[i][r] = pv; psum += pv; }
    psum = rows_sum(psum);
    l = l * alpha + psum; m = mnew;
    const bf16x8 Pb = pack8(S[0], S[1]);
#pragma unroll
    for (int mt = 0; mt < 4; ++mt) { O[mt] = O[mt] * alpha; O[mt] = mfma16(Vf[mt], Pb, O[mt]); }
}
template <bool FAST, int HF>
__device__ __forceinline__ void sel_half(const unsigned char* kL, const unsigned char* vL, const unsigned char* lds, const bf16x8 (&Qf)[2][2], f32x4 (&O)[2][4], float (&m)[2], float (&l)[2],
                                         const bool (&sb)[2], const bool (&need)[2], const int (&relb)[2], int th, float blo, float bhi, int hl, int fr, int fq) {
    bf16x8 Kf[2][2], Vf[4];
#pragma unroll
    for (int i = 0; i < 2; ++i)
#pragma unroll
        for (int ks = 0; ks < 2; ++ks) Kf[i][ks] = lds_frag128(kL, 32 * HF + 16 * i + fr, 4 * ks + fq);
#pragma unroll
    for (int mt = 0; mt < 4; ++mt) Vf[mt] = lds_vfrag128(vL, 16 * mt + fr, 32 * HF, fq);
    if (need[0]) sel_ntile<FAST, HF>(Kf, Vf, Qf[0][0], Qf[0][1], O[0], m[0], l[0], sb[0], relb[0], th, blo, bhi, lds, hl);
    if (need[1]) sel_ntile<FAST, HF>(Kf, Vf, Qf[1][0], Qf[1][1], O[1], m[1], l[1], sb[1], relb[1], th, blo, bhi, lds, hl);
}
__device__ void sel_item(const Params& p, int v, unsigned char* lds) {
    unsigned char* ws = launder(p.ws);
    const int tid = threadIdx.x + vzero(), lane = tid & 63, wid = tid >> 6, fr = lane & 15, fq = lane >> 4;
    const int qt = 127 - (v >> 3), sub = v & 7, b = sub >> 2, g = (sub >> 1) & 1, half = sub & 1;
    const int q0 = qt * 64 + 32 * half, cur = qt, hl = fr & 3;
    const bf16_t* P = (const bf16_t*)(ws + WS_P);
    __syncthreads();
    if (tid < 128) ((float*)(lds + SEL_BIAS2))[tid] = p.rel_bias[(tid & 31) * 8 + 4 * g + (tid >> 5)] * LOG2E;
    int t[2]; size_t tok[2]; bf16x8 Qf[2][2]; unsigned selw[2][4];
#pragma unroll
    for (int nt = 0; nt < 2; ++nt) {
        t[nt] = q0 + 8 * wid + 4 * nt + (fr >> 2); tok[nt] = (size_t)b * S_ + t[nt];
#pragma unroll
        for (int ks = 0; ks < 2; ++ks) Qf[nt][ks] = *(const bf16x8*)(P + tok[nt] * LD + C_QA + (4 * g + hl) * 64 + 32 * ks + 8 * fq);
        const u32x4 w = *(const u32x4*)((const unsigned*)(ws + WS_SELW) + (tok[nt] * 2 + g) * 4);
        selw[nt][0] = w.x; selw[nt][1] = w.y; selw[nt][2] = w.z; selw[nt][3] = w.w;
    }
    f32x4 O[2][4]; float m[2], l[2];
#pragma unroll
    for (int nt = 0; nt < 2; ++nt) { m[nt] = -5e29f; l[nt] = 0.f;
#pragma unroll
        for (int mt = 0; mt < 4; ++mt) O[nt][mt] = (f32x4){0.f, 0.f, 0.f, 0.f}; }
    const bf16_t* kb = P + ((size_t)b * S_) * LD + C_KS + g * 64;
    const bf16_t* vb = (const bf16_t*)(ws + WS_VST) + (size_t)(b * 2 + g) * 64 * S_;
    const int nts = cur + 1;
#define SEL_ISSUE(jj) do { unsigned char* st_ = lds + ((jj) & 3) * 16384; load_tile64(kb + (size_t)(jj) * 64 * LD, LD, st_, wid, lane); load_tile64(vb + (jj) * 64, S_, st_ + 8192, wid, lane); } while (0)
    asm volatile("s_waitcnt vmcnt(0)" ::: "memory");
    SEL_ISSUE(0); if (nts > 1) SEL_ISSUE(1); if (nts > 2) SEL_ISSUE(2);
    const unsigned char* bucketL = lds + NSA_BUCKET;
    for (int j = 0; j < nts; ++j) {
        const unsigned char* cu = lds + (j & 3) * 16384;
        if (j + 2 < nts) WAIT_V(8); else if (j + 1 < nts) WAIT_V(4); else WAIT_V(0);
        RAW_BARRIER();
        if (j + 3 < nts) SEL_ISSUE(j + 3);
        bool sb[2], need[2]; int relb[2];
#pragma unroll
        for (int nt = 0; nt < 2; ++nt) {
            const unsigned w = j < 32 ? selw[nt][0] : j < 64 ? selw[nt][1] : j < 96 ? selw[nt][2] : selw[nt][3];
            sb[nt] = (w >> (j & 31)) & 1u; need[nt] = __ballot(sb[nt]) != 0ull; relb[nt] = t[nt] - 64 * j - 4 * fq;
        }
        if (need[0] || need[1]) {
            const int rmin = q0 - 64 * j - 63, rmax = q0 + 31 - 64 * j;
            bool fast = false; int th = 0; float blo = 0.f, bhi = 0.f;
            if (rmin >= 16) {
                const int b0 = bucketL[rmin], b1 = bucketL[rmax > 8191 ? 8191 : rmax];
                if (b1 - b0 <= 1) { fast = true; th = t5_first(b1); if (b1 == b0) th = 0;
                    blo = ((const float*)(lds + SEL_BIAS2))[hl * 32 + b0]; bhi = ((const float*)(lds + SEL_BIAS2))[hl * 32 + b1]; }
            }
            if (fast) {
                sel_half<true, 0>(cu, cu + 8192, lds, Qf, O, m, l, sb, need, relb, th, blo, bhi, hl, fr, fq);
                sel_half<true, 1>(cu, cu + 8192, lds, Qf, O, m, l, sb, need, relb, th, blo, bhi, hl, fr, fq);
            } else {
                sel_half<false, 0>(cu, cu + 8192, lds, Qf, O, m, l, sb, need, relb, th, blo, bhi, hl, fr, fq);
                sel_half<false, 1>(cu, cu + 8192, lds, Qf, O, m, l, sb, need, relb, th, blo, bhi, hl, fr, fq);
            }
        }
    }
#undef SEL_ISSUE
    __syncthreads();
#pragma unroll
    for (int nt = 0; nt < 2; ++nt) {
        const float gt = bf2f(P[tok[nt] * LD + C_GA + (4 * g + hl) * 3 + 1]) * (l[nt] > 0.f ? 1.f / l[nt] : 0.f);
        const size_t o = tok[nt] * 512 + (4 * g + hl) * 64;
#pragma unroll
        for (int mt = 0; mt < 4; ++mt) {
            const f32x4 yc = unpack4(*(const u32x2*)((const bf16_t*)(ws + WS_YC) + o + 16 * mt + 4 * fq));
            const f32x4 yw = unpack4(*(const u32x2*)((const bf16_t*)(ws + WS_YW) + o + 16 * mt + 4 * fq));
            *(u32x2*)((bf16_t*)(ws + WS_YA) + o + 16 * mt + 4 * fq) = pack4(yc + yw + O[nt][mt] * gt);
        }
    }
}

__device__ void scan_item(const Params& p, int item) {
    unsigned char* ws = launder(p.ws);
    const int idx = item * NTHREADS + threadIdx.x;
    const int bh = idx >> 13, ed = idx & 8191, h = bh & 7;
    const float dec = exp2f(128.f * ret_lg2(h));
    const float* KVT = (const float*)(ws + WS_KVT) + (size_t)bh * 64 * 8192 + ed;
    bf16_t* SPT = (bf16_t*)(ws + WS_SPT) + (size_t)bh * 64 * 8192 + ed;
    float s = 0.f;
    for (int n = 0; n < 64; ++n) { SPT[(size_t)n * 8192] = f2bf(s); s = s * dec + KVT[(size_t)n * 8192]; }
}

__device__ void phase_p3(const Params& p, unsigned char* lds) {
    for (int i = threadIdx.x; i < 8192 / 16; i += NTHREADS) ((u32x4*)(lds + NSA_BUCKET))[i] = ((const u32x4*)(p.ws + WS_BUCKET))[i];
    __syncthreads();
    for (int it = blockIdx.x; it < 1536; it += gridDim.x) {
        if (it < 512) cmp_item(p, it, lds); else if (it < 1024) win_item(p, it - 512, lds); else scan_item(p, it - 1024);
    }
}

__device__ void retout_item(const Params& p, int item, unsigned char* lds) {
    unsigned char* ws = launder(p.ws);
    const int tid = threadIdx.x + vzero(), lane = tid & 63, wid = tid >> 6, fr = lane & 15, fq = lane >> 4;
    const int n = item & 63, h = (item >> 6) & 7, b = item >> 9;
    const size_t tok0 = (size_t)b * S_ + 128 * n;
    const bf16_t* P = (const bf16_t*)(ws + WS_P);
    unsigned char* vL = lds; unsigned char* kL = lds + 32768; unsigned char* sL = lds + 49152;
    __syncthreads();
    load_tile128w((const bf16_t*)(ws + WS_VRT) + ((size_t)(b * 8 + h) * 128) * S_ + 128 * n, S_, vL, wid, lane);
    load_tile128(P + tok0 * LD + C_KR + h * 64, LD, kL, wid, lane);
    load_tile128((const bf16_t*)(ws + WS_SPT) + ((size_t)(b * 8 + h) * 64 + n) * 8192, 64, sL, wid, lane);
    bf16x8 Qf[2][2];
#pragma unroll
    for (int nt = 0; nt < 2; ++nt)
#pragma unroll
        for (int ks = 0; ks < 2; ++ks) Qf[nt][ks] = *(const bf16x8*)(P + (tok0 + 32 * wid + 16 * nt + fr) * LD + C_QR + h * 64 + 32 * ks + 8 * fq);
    wait_vm0(); __syncthreads();
    const float lg2 = ret_lg2(h);
    f32x4 Y[8][2];
#pragma unroll
    for (int m = 0; m < 8; ++m)
#pragma unroll
        for (int nt = 0; nt < 2; ++nt) Y[m][nt] = (f32x4){0.f, 0.f, 0.f, 0.f};
#pragma unroll
    for (int m = 0; m < 8; ++m)
#pragma unroll
        for (int ks = 0; ks < 2; ++ks) {
            const bf16x8 a = lds_frag128(sL, 16 * m + fr, 4 * ks + fq);
#pragma unroll
            for (int nt = 0; nt < 2; ++nt) Y[m][nt] = mfma16(a, Qf[nt][ks], Y[m][nt]);
        }
#pragma unroll
    for (int nt = 0; nt < 2; ++nt) {
        const float sc = exp2f((float)(32 * wid + 16 * nt + fr + 1) * lg2);
#pragma unroll
        for (int m = 0; m < 8; ++m) Y[m][nt] = Y[m][nt] * sc;
    }
#pragma unroll 1
    for (int s = 0; s < 4; ++s) {
        f32x4 St[2][2];
#pragma unroll
        for (int hh = 0; hh < 2; ++hh) {
            const int mt = 2 * s + hh;
#pragma unroll
            for (int nt = 0; nt < 2; ++nt) St[hh][nt] = (f32x4){0.f, 0.f, 0.f, 0.f};
#pragma unroll
            for (int ks = 0; ks < 2; ++ks) {
                const bf16x8 a = lds_frag128(kL, 16 * mt + fr, 4 * ks + fq);
#pragma unroll
                for (int nt = 0; nt < 2; ++nt) St[hh][nt] = mfma16(a, Qf[nt][ks], St[hh][nt]);
            }
#pragma unroll
            for (int nt = 0; nt < 2; ++nt) {
                const int qi = 32 * wid + 16 * nt + fr;
#pragma unroll
                for (int r = 0; r < 4; ++r) {
                    const int kj = 16 * mt + 4 * fq + r;
                    const float dm = qi >= kj ? exp2f((float)(qi - kj) * lg2) : 0.f;
                    St[hh][nt][r] *= dm;
                }
            }
        }
        bf16x8 Pb[2];
#pragma unroll
        for (int nt = 0; nt < 2; ++nt) Pb[nt] = pack8(St[0][nt], St[1][nt]);
#pragma unroll
        for (int m = 0; m < 8; ++m) {
            const bf16x8 a = lds_vfrag256(vL, 16 * m + fr, 32 * s, fq);
#pragma unroll
            for (int nt = 0; nt < 2; ++nt) Y[m][nt] = mfma16(a, Pb[nt], Y[m][nt]);
        }
    }
    bf16_t* YB = (bf16_t*)(ws + WS_YB);
#pragma unroll
    for (int nt = 0; nt < 2; ++nt) {
        float sum = 0.f;
#pragma unroll
        for (int m = 0; m < 8; ++m) sum += Y[m][nt][0] + Y[m][nt][1] + Y[m][nt][2] + Y[m][nt][3];
        sum = rows_sum(sum);
        const float mu = sum * (1.f / 128.f);
        float vs = 0.f;
#pragma unroll
        for (int m = 0; m < 8; ++m)
#pragma unroll
            for (int r = 0; r < 4; ++r) { const float dlt = Y[m][nt][r] - mu; vs += dlt * dlt; }
        vs = rows_sum(vs);
        const float rstd = rsqrtf(vs * (1.f / 128.f) + 1e-5f);
        const size_t tk = tok0 + 32 * wid + 16 * nt + fr;
#pragma unroll
        for (int m = 0; m < 8; ++m) {
            const f32x4 gt = unpack4(*(const u32x2*)(P + tk * LD + C_GR + h * 128 + 16 * m + 4 * fq));
            f32x4 v;
#pragma unroll
            for (int r = 0; r < 4; ++r) v[r] = (Y[m][nt][r] - mu) * rstd * gt[r];
            *(u32x2*)(YB + tk * 1024 + h * 128 + 16 * m + 4 * fq) = pack4(v);
        }
    }
}
__device__ void phase_p4(const Params& p, unsigned char* lds) {
    for (int i = threadIdx.x; i < 8192 / 16; i += NTHREADS) ((u32x4*)(lds + NSA_BUCKET))[i] = ((const u32x4*)(p.ws + WS_BUCKET))[i];
    __syncthreads();
    for (int it = blockIdx.x; it < 2048; it += gridDim.x) {
        if (it < 1024) sel_item(p, it < 512 ? it : 1535 - it, lds); else retout_item(p, it - 1024, lds);
    }
}

__device__ void phase_g2(const Params& p, unsigned char* lds) {
    unsigned char* ws = launder(p.ws);
    const bf16_t* P = (const bf16_t*)(ws + WS_P);
    for (int t = (blockIdx.x & 7) * 128 + (blockIdx.x >> 3); t < ((blockIdx.x & 7) + 1) * 128; t += (gridDim.x >> 3)) {
        const int mt = t >> 3, nt = t & 7, m0 = mt * 128, n0 = nt * 128;
        const int tid = threadIdx.x + vzero(), lane = tid & 63, wid = tid >> 6, wr = wid >> 1, wc = wid & 1, fr = lane & 15, fq = lane >> 4;
        const int ldrow = 8 * wid + (lane >> 3), ldc = ((lane & 7) ^ (lane >> 3)) * 8;
        const bf16_t* mp[4]; const bf16_t* np[4];
        bf16_t* MG = (bf16_t*)(ws + WS_MG);
        { f32x4 acc1[4][4]; zero_acc(acc1);
#pragma unroll
        for (int i = 0; i < 4; ++i) { mp[i] = (const bf16_t*)(ws + WS_WA) + (size_t)(n0 + 32 * i + ldrow) * 512 + ldc; np[i] = (const bf16_t*)(ws + WS_YA) + (size_t)(m0 + 32 * i + ldrow) * 512 + ldc; }
        gemm_kloop(mp, np, 8, lds, acc1);
#pragma unroll
        for (int mi = 0; mi < 4; ++mi)
#pragma unroll
            for (int ni = 0; ni < 4; ++ni) {
                const int n = n0 + 64 * wr + 16 * mi + 4 * fq; const size_t tok = m0 + 64 * wc + 16 * ni + fr;
                const f32x4 ga = unpack4(*(const u32x2*)(P + tok * LD + C_MA + n));
                *(u32x2*)(MG + tok * 1024 + n) = pack4(ga * acc1[mi][ni]);
            } }
        { f32x4 acc2[4][4]; zero_acc(acc2);
#pragma unroll
        for (int i = 0; i < 4; ++i) { mp[i] = (const bf16_t*)(ws + WS_WB) + (size_t)(n0 + 32 * i + ldrow) * 1024 + ldc; np[i] = (const bf16_t*)(ws + WS_YB) + (size_t)(m0 + 32 * i + ldrow) * 1024 + ldc; }
        gemm_kloop(mp, np, 16, lds, acc2);
#pragma unroll
        for (int mi = 0; mi < 4; ++mi)
#pragma unroll
            for (int ni = 0; ni < 4; ++ni) {
                const int n = n0 + 64 * wr + 16 * mi + 4 * fq; const size_t tok = m0 + 64 * wc + 16 * ni + fr;
                const f32x4 gb = unpack4(*(const u32x2*)(P + tok * LD + C_MB + n));
                const f32x4 v = unpack4(*(const u32x2*)(MG + tok * 1024 + n)) + gb * acc2[mi][ni];
                *(u32x2*)(MG + tok * 1024 + n) = pack4(v);
            } }
    }
}

__device__ void phase_g3(const Params& p, int layer, unsigned char* lds) {
    unsigned char* ws = launder(p.ws);
    const int tid = threadIdx.x + vzero(), lane = tid & 63, wid = tid >> 6, wr = wid >> 1, wc = wid & 1, fr = lane & 15, fq = lane >> 4;
    const int ldrow = 8 * wid + (lane >> 3), ldc = ((lane & 7) ^ (lane >> 3)) * 8;
    const float* X = layer == 0 ? p.x : (const float*)(ws + WS_X);
    float* H1 = (float*)(ws + WS_H1);
    for (int t = (blockIdx.x & 7) * 128 + (blockIdx.x >> 3); t < ((blockIdx.x & 7) + 1) * 128; t += (gridDim.x >> 3)) {
        const int mt = t >> 3, nt = t & 7, m0 = mt * 128, n0 = nt * 128;
        const bf16_t* mp[4]; const bf16_t* np[4];
        f32x4 acc[4][4]; zero_acc(acc);
#pragma unroll
        for (int i = 0; i < 4; ++i) { mp[i] = (const bf16_t*)(ws + WS_WO) + (size_t)(n0 + 32 * i + ldrow) * 1024 + ldc; np[i] = (const bf16_t*)(ws + WS_MG) + (size_t)(m0 + 32 * i + ldrow) * 1024 + ldc; }
        gemm_kloop(mp, np, 16, lds, acc);
#pragma unroll
        for (int mi = 0; mi < 4; ++mi)
#pragma unroll
            for (int ni = 0; ni < 4; ++ni) {
                const int n = n0 + 64 * wr + 16 * mi + 4 * fq; const size_t tok = m0 + 64 * wc + 16 * ni + fr;
                const f32x4 xv = *(const f32x4*)(X + tok * 1024 + n);
                *(f32x4*)(H1 + tok * 1024 + n) = xv * DN_ALPHA + acc[mi][ni];
            }
    }
}

__device__ void phase_ln1(const Params& p, int layer, unsigned char* lds, bool dry) {
    unsigned char* ws = launder(p.ws);
    const int tid = threadIdx.x + vzero(), lane = tid & 63, wid = tid >> 6;
    float* wrL = (float*)lds;
    {
        float4 wv[16];
#pragma unroll
        for (int k = 0; k < 16; ++k) wv[k] = ((const float4*)p.w_router)[tid + 256 * k];
#pragma unroll
        for (int k = 0; k < 16; ++k) { const int i4 = tid + 256 * k, d = i4 >> 2, e0 = (i4 & 3) * 4;
            wrL[(e0 + 0) * 1024 + d] = wv[k].x; wrL[(e0 + 1) * 1024 + d] = wv[k].y; wrL[(e0 + 2) * 1024 + d] = wv[k].z; wrL[(e0 + 3) * 1024 + d] = wv[k].w; }
    }
    __syncthreads();
    const float* H1 = (const float*)(ws + WS_H1);
    float* X1 = (float*)(ws + WS_X1); bf16_t* X1B = (bf16_t*)(ws + WS_X1B);
    const float* gam = p.ln1_g + layer * 1024; const float* bet = p.ln1_b + layer * 1024;
    unsigned* cnt = (unsigned*)(ws + WS_CTL) + (dry ? 0 : CW_CNT) + layer * 1024;
    int* LIST = (int*)(ws + (dry ? WS_HB : WS_LIST)); float* WTS = (float*)(ws + (dry ? WS_HB + 4194304 : WS_WTS));
    for (int tok = blockIdx.x * 4 + wid; tok < T_; tok += gridDim.x * 4) {
        float4 v[4];
#pragma unroll
        for (int j = 0; j < 4; ++j) v[j] = *(const float4*)(H1 + (size_t)tok * 1024 + 256 * j + 4 * lane);
        float s = 0.f;
#pragma unroll
        for (int j = 0; j < 4; ++j) s += v[j].x + v[j].y + v[j].z + v[j].w;
#pragma unroll
        for (int o = 1; o < 64; o <<= 1) s += __shfl_xor(s, o);
        const float mu = s * (1.f / 1024.f);
        float q = 0.f;
#pragma unroll
        for (int j = 0; j < 4; ++j) { const float a = v[j].x - mu, b2 = v[j].y - mu, c = v[j].z - mu, d = v[j].w - mu; q += a * a + b2 * b2 + c * c + d * d; }
#pragma unroll
        for (int o = 1; o < 64; o <<= 1) q += __shfl_xor(q, o);
        const float rstd = rsqrtf(q * (1.f / 1024.f) + 1e-5f);
        float4 y[4];
#pragma unroll
        for (int j = 0; j < 4; ++j) {
            const int d0 = 256 * j + 4 * lane;
            const float4 gg = *(const float4*)(gam + d0), bb = *(const float4*)(bet + d0);
            y[j].x = (v[j].x - mu) * rstd * gg.x + bb.x; y[j].y = (v[j].y - mu) * rstd * gg.y + bb.y; y[j].z = (v[j].z - mu) * rstd * gg.z + bb.z; y[j].w = (v[j].w - mu) * rstd * gg.w + bb.w;
            *(float4*)(X1 + (size_t)tok * 1024 + d0) = y[j];
            u32x2 w; w.x = pack2(y[j].x, y[j].y); w.y = pack2(y[j].z, y[j].w);
            *(u32x2*)(X1B + (size_t)tok * 1024 + d0) = w;
        }
        float lg[16];
#pragma unroll
        for (int e = 0; e < 16; ++e) {
            float a = 0.f;
#pragma unroll
            for (int j = 0; j < 4; ++j) { const float4 w4 = *(const float4*)(wrL + e * 1024 + 256 * j + 4 * lane); a += y[j].x * w4.x + y[j].y * w4.y + y[j].z * w4.z + y[j].w * w4.w; }
            lg[e] = a;
        }
#pragma unroll
        for (int e = 0; e < 16; ++e) {
#pragma unroll
            for (int o = 1; o < 64; o <<= 1) lg[e] += __shfl_xor(lg[e], o);
        }
        float mx = lg[0];
#pragma unroll
        for (int e = 1; e < 16; ++e) mx = fmaxf(mx, lg[e]);
        float pr[16], ps = 0.f;
#pragma unroll
        for (int e = 0; e < 16; ++e) { pr[e] = expf(lg[e] - mx); ps += pr[e]; }
        const float ips = 1.f / ps;
        float sel[16];
#pragma unroll
        for (int e = 0; e < 16; ++e) { pr[e] *= ips; sel[e] = pr[e] + p.router_bias[e]; }
        int best = 0; float bestv = -1e30f;
#pragma unroll
        for (int gI = 0; gI < 4; ++gI) {
            float a = -1e30f, b2 = -1e30f;
#pragma unroll
            for (int k = 0; k < 4; ++k) { const float x = sel[4 * gI + k]; if (x > a) { b2 = a; a = x; } else if (x > b2) b2 = x; }
            const float gs = a + b2;
            if (gs > bestv) { bestv = gs; best = gI; }
        }
        float s4[4], p4[4];
#pragma unroll
        for (int k = 0; k < 4; ++k) { s4[k] = 0.f; p4[k] = 0.f; }
#pragma unroll
        for (int gI = 0; gI < 4; ++gI) if (gI == best) {
#pragma unroll
            for (int k = 0; k < 4; ++k) { s4[k] = sel[4 * gI + k]; p4[k] = pr[4 * gI + k]; }
        }
        int i0 = 0; float a0 = s4[0];
#pragma unroll
        for (int k = 1; k < 4; ++k) if (s4[k] > a0) { a0 = s4[k]; i0 = k; }
        int i1 = -1; float a1 = -1e30f;
#pragma unroll
        for (int k = 0; k < 4; ++k) if (k != i0 && s4[k] > a1) { a1 = s4[k]; i1 = k; }
        float w0 = 0.f, w1 = 0.f;
#pragma unroll
        for (int k = 0; k < 4; ++k) { if (k == i0) w0 = p4[k]; if (k == i1) w1 = p4[k]; }
        const float iw = 1.f / (w0 + w1);
        if (lane == 0) {
            const int e0 = best * 4 + i0, e1 = best * 4 + i1;
            const unsigned p0 = atomicAdd(&cnt[e0 * 64], 1u), p1 = atomicAdd(&cnt[e1 * 64], 1u);
            LIST[(size_t)e0 * T_ + p0] = tok * 2; LIST[(size_t)e1 * T_ + p1] = tok * 2 + 1;
            WTS[tok * 2] = w0 * iw; WTS[tok * 2 + 1] = w1 * iw;
        }
    }
}

__device__ __forceinline__ bool moe_find(const unsigned* cnt, int t, int colTiles, int& e, int& rt, int& ct, int& cnte, int& off) {
    int base = 0; off = 0;
    for (int k = 0; k < NE; ++k) {
        const int c = __builtin_amdgcn_readfirstlane((int)cnt[k * 64]), nt = ((c + 127) >> 7) * colTiles;
        if (t < base + nt) { e = k; cnte = c; const int u = t - base; rt = u / colTiles; ct = u % colTiles;
            e = __builtin_amdgcn_readfirstlane(e); cnte = __builtin_amdgcn_readfirstlane(cnte); rt = __builtin_amdgcn_readfirstlane(rt);
            ct = __builtin_amdgcn_readfirstlane(ct); off = __builtin_amdgcn_readfirstlane(off); return true; }
        base += nt; off += c;
    }
    return false;
}
__device__ void phase_m2(const Params& p, int layer, unsigned char* lds) {
    unsigned char* ws = launder(p.ws);
    const int tid = threadIdx.x + vzero(), lane = tid & 63, wid = tid >> 6, wr = wid >> 1, wc = wid & 1, fr = lane & 15, fq = lane >> 4;
    const int ldrow = 8 * wid + (lane >> 3), ldc = ((lane & 7) ^ (lane >> 3)) * 8;
    const unsigned* cnt = (const unsigned*)(ws + WS_CTL) + CW_CNT + layer * 1024 + vzero();
    const int* LIST = (const int*)(ws + WS_LIST);
    const bf16_t* X1B = (const bf16_t*)(ws + WS_X1B);
    bf16_t* HB = (bf16_t*)(ws + WS_HB);
    int ntile = 0;
    for (int k = 0; k < NE; ++k) ntile += ((__builtin_amdgcn_readfirstlane((int)cnt[k * 64]) + 127) >> 7) * 8;
    const int t_lo = (ntile * (int)(blockIdx.x & 7)) >> 3, t_hi = (ntile * (int)((blockIdx.x & 7) + 1)) >> 3;
    for (int t = t_lo + (blockIdx.x >> 3); t < t_hi; t += (gridDim.x >> 3)) {
        int e, rt, ct, cnte, off;
        if (!moe_find(cnt, t, 8, e, rt, ct, cnte, off)) break;
        const bf16_t* mp[4]; const bf16_t* np[4];
#pragma unroll
        for (int i = 0; i < 4; ++i) {
            const int rho = 32 * i + ldrow, blk = rho >> 4, nn = ct * 64 + (blk >> 1) * 16 + (rho & 15);
            mp[i] = (const bf16_t*)(ws + ((blk & 1) ? WS_WU : WS_WG)) + ((size_t)e * 512 + nn) * 1024 + ldc;
            int idx = rt * 128 + rho; idx = idx < cnte ? idx : cnte - 1;
            const int a = LIST[(size_t)e * T_ + idx];
            np[i] = X1B + (size_t)(a >> 1) * 1024 + ldc;
        }
        f32x4 acc[4][4]; zero_acc(acc);
        gemm_kloop(mp, np, 16, lds, acc);
#pragma unroll
        for (int mp2 = 0; mp2 < 2; ++mp2)
#pragma unroll
            for (int ni = 0; ni < 4; ++ni) {
                const int idx = rt * 128 + 64 * wc + 16 * ni + fr;
                if (idx < cnte) {
                    const int n = ct * 64 + (2 * wr + mp2) * 16 + 4 * fq;
                    const f32x4 gv = acc[2 * mp2][ni], uv = acc[2 * mp2 + 1][ni];
                    f32x4 hv;
#pragma unroll
                    for (int r = 0; r < 4; ++r) hv[r] = gv[r] * sigmoidf_(gv[r]) * uv[r];
                    *(u32x2*)(HB + (size_t)(off + idx) * 512 + n) = pack4(hv);
                }
            }
    }
}
__device__ void phase_m3(const Params& p, int layer, unsigned char* lds) {
    unsigned char* ws = launder(p.ws);
    const int tid = threadIdx.x + vzero(), lane = tid & 63, wid = tid >> 6, wr = wid >> 1, wc = wid & 1, fr = lane & 15, fq = lane >> 4;
    const int ldrow = 8 * wid + (lane >> 3), ldc = ((lane & 7) ^ (lane >> 3)) * 8;
    const unsigned* cnt = (const unsigned*)(ws + WS_CTL) + CW_CNT + layer * 1024 + vzero();
    const int* LIST = (const int*)(ws + WS_LIST);
    const bf16_t* HB = (const bf16_t*)(ws + WS_HB);
    bf16_t* CT = (bf16_t*)(ws + WS_CT);
    int ntile = 0;
    for (int k = 0; k < NE; ++k) ntile += ((__builtin_amdgcn_readfirstlane((int)cnt[k * 64]) + 127) >> 7) * 8;
    const int t_lo = (ntile * (int)(blockIdx.x & 7)) >> 3, t_hi = (ntile * (int)((blockIdx.x & 7) + 1)) >> 3;
    for (int t = t_lo + (blockIdx.x >> 3); t < t_hi; t += (gridDim.x >> 3)) {
        int e, rt, ct, cnte, off;
        if (!moe_find(cnt, t, 8, e, rt, ct, cnte, off)) break;
        const bf16_t* mp[4]; const bf16_t* np[4];
#pragma unroll
        for (int i = 0; i < 4; ++i) {
            const int rho = 32 * i + ldrow;
            mp[i] = (const bf16_t*)(ws + WS_WD) + ((size_t)e * 1024 + ct * 128 + rho) * 512 + ldc;
            int idx = rt * 128 + rho; idx = idx < cnte ? idx : cnte - 1;
            np[i] = HB + (size_t)(off + idx) * 512 + ldc;
        }
        f32x4 acc[4][4]; zero_acc(acc);
        gemm_kloop(mp, np, 8, lds, acc);
#pragma unroll
        for (int ni = 0; ni < 4; ++ni) {
            const int idx = rt * 128 + 64 * wc + 16 * ni + fr;
            if (idx < cnte) {
                const int a = LIST[(size_t)e * T_ + idx];
#pragma unroll
                for (int mi = 0; mi < 4; ++mi) {
                    const int n = ct * 128 + 64 * wr + 16 * mi + 4 * fq;
                    *(u32x2*)(CT + (size_t)a * 1024 + n) = pack4(acc[mi][ni]);
                }
            }
        }
    }
}

__device__ void phase_ln2(const Params& p, int layer) {
    unsigned char* ws = launder(p.ws);
    const int tid = threadIdx.x + vzero(), lane = tid & 63, wid = tid >> 6;
    const float* X1 = (const float*)(ws + WS_X1); const bf16_t* CT = (const bf16_t*)(ws + WS_CT); const float* WTS = (const float*)(ws + WS_WTS);
    float* XO = layer == NLAYER - 1 ? p.out : (float*)(ws + WS_X); bf16_t* XB = (bf16_t*)(ws + WS_XB);
    const float* gam = p.ln2_g + layer * 1024; const float* bet = p.ln2_b + layer * 1024;
    for (int tok = blockIdx.x * 4 + wid; tok < T_; tok += gridDim.x * 4) {
        const float w0 = WTS[tok * 2 + vzero()], w1 = WTS[tok * 2 + 1 + vzero()];
        float4 v[4];
#pragma unroll
        for (int j = 0; j < 4; ++j) {
            const int d0 = 256 * j + 4 * lane;
            const float4 xv = *(const float4*)(X1 + (size_t)tok * 1024 + d0);
            const f32x4 c0 = unpack4(*(const u32x2*)(CT + (size_t)(tok * 2) * 1024 + d0)), c1 = unpack4(*(const u32x2*)(CT + (size_t)(tok * 2 + 1) * 1024 + d0));
            v[j].x = xv.x * DN_ALPHA + w0 * c0[0] + w1 * c1[0]; v[j].y = xv.y * DN_ALPHA + w0 * c0[1] + w1 * c1[1];
            v[j].z = xv.z * DN_ALPHA + w0 * c0[2] + w1 * c1[2]; v[j].w = xv.w * DN_ALPHA + w0 * c0[3] + w1 * c1[3];
        }
        float s = 0.f;
#pragma unroll
        for (int j = 0; j < 4; ++j) s += v[j].x + v[j].y + v[j].z + v[j].w;
#pragma unroll
        for (int o = 1; o < 64; o <<= 1) s += __shfl_xor(s, o);
        const float mu = s * (1.f / 1024.f);
        float q = 0.f;
#pragma unroll
        for (int j = 0; j < 4; ++j) { const float a = v[j].x - mu, b2 = v[j].y - mu, c = v[j].z - mu, d = v[j].w - mu; q += a * a + b2 * b2 + c * c + d * d; }
#pragma unroll
        for (int o = 1; o < 64; o <<= 1) q += __shfl_xor(q, o);
        const float rstd = rsqrtf(q * (1.f / 1024.f) + 1e-5f);
#pragma unroll
        for (int j = 0; j < 4; ++j) {
            const int d0 = 256 * j + 4 * lane;
            const float4 gg = *(const float4*)(gam + d0), bb = *(const float4*)(bet + d0);
            float4 y; y.x = (v[j].x - mu) * rstd * gg.x + bb.x; y.y = (v[j].y - mu) * rstd * gg.y + bb.y; y.z = (v[j].z - mu) * rstd * gg.z + bb.z; y.w = (v[j].w - mu) * rstd * gg.w + bb.w;
            *(float4*)(XO + (size_t)tok * 1024 + d0) = y;
            u32x2 w; w.x = pack2(y.x, y.y); w.y = pack2(y.z, y.w);
            *(u32x2*)(XB + (size_t)tok * 1024 + d0) = w;
        }
    }
}

#define XB_TMO      128
#define XB_XCNT(j)  (256  + 64 * (j))
#define XB_XSUB(j)  (1280 + 64 * (j))
#define XB_XGEN(j)  (2304 + 64 * (j))
#define XB_TOP      3328
#define XB_TOPGEN   3392
#define XCD_BAR_WORDS 3456
#define XB_SPIN_CAP (1u << 22)
#define LAS __attribute__((address_space(3)))
__device__ __forceinline__ unsigned xb_ld(unsigned* p)              { return __hip_atomic_load(p, __ATOMIC_RELAXED, __HIP_MEMORY_SCOPE_AGENT); }
__device__ __forceinline__ unsigned xb_add(unsigned* p, unsigned v) { return __hip_atomic_fetch_add(p, v, __ATOMIC_RELAXED, __HIP_MEMORY_SCOPE_AGENT); }
__device__ __forceinline__ unsigned xb_xcc_id() { return (unsigned)__builtin_amdgcn_s_getreg((3 << 11) | 20) & 0xFu; }
#define XB_SPIN(cond, bar) do { unsigned _sp = 0; while (cond) { __builtin_amdgcn_s_sleep(1); \
    if ((++_sp & 255u) == 0u) { if (xb_ld(&(bar)[XB_TMO])) break; if (_sp > XB_SPIN_CAP) { atomicAdd(&(bar)[XB_TMO], 1u); break; } } } } while (0)
struct XcdBarrier { unsigned* bar; unsigned x; volatile LAS unsigned* st; };
__device__ __forceinline__ XcdBarrier xcd_barrier_post(unsigned* bar, volatile LAS unsigned* st) {
    XcdBarrier b; b.bar = bar; b.x = xb_xcc_id(); b.st = st;
    if (threadIdx.x == 0) (void)xb_add(&bar[XB_XCNT(b.x)], 1u);
    return b;
}
__device__ __forceinline__ void xcd_barrier_complete(unsigned* bar, unsigned x, unsigned& nloc, unsigned& nx) {
    const unsigned G = gridDim.x * gridDim.y * gridDim.z;
    unsigned sum, cnt, mine, sp = 0u;
    for (;;) {
        sum = 0u; cnt = 0u; mine = 0u;
#pragma unroll
        for (unsigned j = 0; j < 16; ++j) { const unsigned c = xb_ld(&bar[XB_XCNT(j)]); sum += c; cnt += (c > 0u) ? 1u : 0u; mine = (j == x) ? c : mine; }
        if (sum == G) break;
        __builtin_amdgcn_s_sleep(1);
        if ((++sp & 255u) == 0u) { if (xb_ld(&bar[XB_TMO])) break; if (sp > XB_SPIN_CAP) { atomicAdd(&bar[XB_TMO], 1u); break; } }
    }
    nloc = mine > 0u ? mine : 1u; nx = cnt > 0u ? cnt : 1u;
}
__device__ __forceinline__ void xcd_barrier(const XcdBarrier& b) {
    asm volatile("s_waitcnt vmcnt(0)" ::: "memory");
    __syncthreads();
    if (threadIdx.x == 0) {
        unsigned* bar = b.bar;
        __builtin_amdgcn_s_waitcnt(0);
        unsigned nloc = b.st[0], nx = b.st[1];
        if (nloc == 0u) { xcd_barrier_complete(bar, b.x, nloc, nx); b.st[0] = nloc; b.st[1] = nx; }
        const unsigned old = xb_add(&bar[XB_XSUB(b.x)], 1u);
        const unsigned gen = old / nloc;
        if (old + 1u == (gen + 1u) * nloc) {
            __builtin_amdgcn_fence(__ATOMIC_RELEASE, "agent");
            asm volatile("s_waitcnt vmcnt(0)" ::: "memory");
            const unsigned og = xb_add(&bar[XB_TOP], 1u);
            const unsigned tg = og / nx;
            if (og + 1u == (tg + 1u) * nx) xb_add(&bar[XB_TOPGEN], 1u);
            else XB_SPIN(xb_ld(&bar[XB_TOPGEN]) == tg, bar);
            __builtin_amdgcn_fence(__ATOMIC_ACQUIRE, "agent");
            xb_add(&bar[XB_XGEN(b.x)], 1u);
            asm volatile("s_waitcnt vmcnt(0)" ::: "memory");
        } else {
            XB_SPIN(xb_ld(&bar[XB_XGEN(b.x)]) == gen, bar);
            __builtin_amdgcn_fence(__ATOMIC_ACQUIRE, "agent");
            asm volatile("s_waitcnt vmcnt(0)" ::: "memory");
        }
    }
    __syncthreads();
}

constexpr int PH_PER_LAYER = 11, N_PHASES = PH_PER_LAYER * NLAYER;
__global__ void __launch_bounds__(NTHREADS, 2) mega(Params p) {
    extern __shared__ __attribute__((aligned(16))) unsigned char lds[];
#if SINGLE_LAUNCH
    volatile LAS unsigned* xbw = (volatile LAS unsigned*)(lds + LDS_BYTES - 16);
    if (threadIdx.x < 4) xbw[threadIdx.x] = 0u;
    __syncthreads();
    XcdBarrier xbar = xcd_barrier_post((unsigned*)(p.ws + WS_CTL) + CW_BAR, xbw);
#endif
    for (int ph = p.ph_lo; ph < p.ph_hi; ++ph) {
        const int layer = ph / PH_PER_LAYER, k = ph % PH_PER_LAYER;
#ifdef ONLY_PHASE
        if (k != ONLY_PHASE) continue;
#endif
#ifdef REPEAT_MASK
        for (int rep = 0; rep < (((REPEAT_MASK) >> k) & 1) + 1; ++rep) {
        if (rep) __syncthreads();
#endif
        switch (k) {
            case 0: phase_pw(p, layer, lds); break;
            case 1: phase_g1(p, layer, lds); break;
            case 2: phase_p2(p, layer, lds); break;
            case 3: phase_p3(p, lds); break;
            case 4: phase_p4(p, lds); break;
            case 5: phase_g2(p, lds); break;
            case 6: phase_g3(p, layer, lds); break;
#ifdef REPEAT_MASK
            case 7: phase_ln1(p, layer, lds, (((REPEAT_MASK) >> 7) & 1) && rep == 0); break;
#else
            case 7: phase_ln1(p, layer, lds, false); break;
#endif
            case 8: phase_m2(p, layer, lds); break;
            case 9: phase_m3(p, layer, lds); break;
            case 10: phase_ln2(p, layer); break;
        }
#ifdef REPEAT_MASK
        }
#endif
#if SINGLE_LAUNCH
        if (ph + 1 < p.ph_hi) { if (ph == p.ph_lo) cg::this_grid().sync(); else xcd_barrier(xbar); }
#endif
    }
}

extern "C" void kernel_launch(void* const* d_in, const int* in_sizes, int n_in, void* d_out, int out_size, void* d_ws, size_t ws_size, hipStream_t stream) {
    static int grid = 0;
    if (grid == 0) {
        if (n_in != 18 || ws_size < WS_END) { fprintf(stderr, "kernel_launch: unexpected n_in %d or ws_size %zu < %zu\n", n_in, ws_size, (size_t)WS_END); grid = -1; return; }
        int dev = 0, cus = 0, per_cu = 0;
        hipGetDevice(&dev); hipDeviceGetAttribute(&cus, hipDeviceAttributeMultiprocessorCount, dev);
        hipFuncSetAttribute((const void*)mega, hipFuncAttributeMaxDynamicSharedMemorySize, LDS_BYTES);
        hipOccupancyMaxActiveBlocksPerMultiprocessor(&per_cu, (const void*)mega, NTHREADS, LDS_BYTES);
        if (per_cu < 1) per_cu = 1;
        if (per_cu > 2) per_cu = 2;
        grid = cus * per_cu;
        (void)hipGetLastError();
    }
    if (grid < 0) return;
    Params p{};
    p.x = (const float*)d_in[0]; p.w_in = (const float*)d_in[1]; p.cmp_pos = (const float*)d_in[2]; p.cmp_w1 = (const float*)d_in[3]; p.cmp_w2 = (const float*)d_in[4];
    p.w_br_a = (const float*)d_in[5]; p.w_br_b = (const float*)d_in[6]; p.w_o = (const float*)d_in[7]; p.ln1_g = (const float*)d_in[8]; p.ln1_b = (const float*)d_in[9];
    p.w_router = (const float*)d_in[10]; p.router_bias = (const float*)d_in[11]; p.w_gate = (const float*)d_in[12]; p.w_up = (const float*)d_in[13]; p.w_down = (const float*)d_in[14];
    p.ln2_g = (const float*)d_in[15]; p.ln2_b = (const float*)d_in[16]; p.rel_bias = (const float*)d_in[17];
    p.out = (float*)d_out; p.ws = (unsigned char*)d_ws;
#if SINGLE_LAUNCH
    hipMemsetAsync((unsigned char*)d_ws + WS_CTL + (size_t)CW_BAR * 4, 0, XCD_BAR_WORDS * 4, stream);
    p.ph_lo = 0; p.ph_hi = N_PHASES;
    void* args[] = {&p};
    hipError_t e = hipLaunchCooperativeKernel((const void*)mega, dim3(grid), dim3(NTHREADS), args, LDS_BYTES, stream);
    if (e != hipSuccess) fprintf(stderr, "cooperative launch failed: %s (grid %d)\n", hipGetErrorString(e), grid);
#else
    for (int ph = 0; ph < N_PHASES; ++ph) {
        p.ph_lo = ph; p.ph_hi = ph + 1;
        hipLaunchKernelGGL(mega, dim3(grid), dim3(NTHREADS), LDS_BYTES, stream, p);
    }
#endif
}
```

```cpp
#include <hip/hip_runtime.h>
#include <hip/hip_cooperative_groups.h>
#include <cstdio>
#include <cstdint>
namespace cg = cooperative_groups;

#ifndef SINGLE_LAUNCH
#define SINGLE_LAUNCH 1
#endif

typedef unsigned short bf16_t;
typedef short bf16x8 __attribute__((ext_vector_type(8)));
typedef float f32x4 __attribute__((ext_vector_type(4)));
typedef unsigned u32x2 __attribute__((ext_vector_type(2)));
typedef unsigned u32x4 __attribute__((ext_vector_type(4)));

constexpr int B_ = 2, S_ = 8192, D_ = 1024, T_ = B_ * S_, NLAYER = 4;
constexpr int DIN = 6424;
constexpr int LD = 6528;
constexpr int C_QA = 0, C_KC = 512, C_VC = 640, C_KS = 768, C_VS = 896, C_KW = 1024, C_VW = 1152, C_QR = 1280, C_KR = 1792,
              C_VR = 2304, C_GR = 3328, C_MA = 4352, C_MB = 5376, C_GA = 6400;
constexpr float DN_ALPHA = 1.681792830507429f;
constexpr int NE = 16;

constexpr size_t al256(size_t x) { return (x + 255) & ~(size_t)255; }
constexpr size_t WS_CTL = 0;
constexpr size_t WS_BUCKET = 65536;
constexpr size_t WS_ROPE = WS_BUCKET + 8192;
constexpr size_t WS_WIN = WS_ROPE + (size_t)8192 * 32 * 8;
constexpr size_t WS_WA = WS_WIN + (size_t)LD * 1024 * 2;
constexpr size_t WS_WB = WS_WA + (size_t)1024 * 512 * 2;
constexpr size_t WS_WO = WS_WB + (size_t)1024 * 1024 * 2;
constexpr size_t WS_WG = WS_WO + (size_t)1024 * 1024 * 2;
constexpr size_t WS_WU = WS_WG + (size_t)16 * 512 * 1024 * 2;
constexpr size_t WS_WD = WS_WU + (size_t)16 * 512 * 1024 * 2;
constexpr size_t WS_XB = WS_WD + (size_t)16 * 512 * 1024 * 2;
constexpr size_t WS_X = WS_XB + (size_t)T_ * 1024 * 2;
constexpr size_t WS_MG = WS_X + (size_t)T_ * 1024 * 4;
constexpr size_t WS_KCC = WS_MG + (size_t)T_ * 1024 * 2;
constexpr size_t WS_VCCT = WS_KCC + (size_t)4 * 512 * 64 * 2;
constexpr size_t WS_W1T = WS_VCCT + (size_t)4 * 512 * 64 * 2;
constexpr size_t WS_B1 = WS_W1T + (size_t)2 * 64 * 2048 * 2;
constexpr size_t WS_R = WS_B1 + 1024;
constexpr size_t WS_P = WS_R;
constexpr size_t WS_VST = WS_P + (size_t)T_ * LD * 2;
constexpr size_t WS_VWT = WS_VST + (size_t)4 * 64 * S_ * 2;
constexpr size_t WS_VRT = WS_VWT + (size_t)4 * 64 * S_ * 2;
constexpr size_t WS_KVT = WS_VRT + (size_t)16 * 128 * S_ * 2;
constexpr size_t WS_SPT = WS_KVT + (size_t)16 * 64 * 8192 * 4;
constexpr size_t WS_YC = WS_SPT + (size_t)16 * 64 * 8192 * 2;
constexpr size_t WS_YW = WS_YC + (size_t)T_ * 512 * 2;
constexpr size_t WS_YA = WS_YW + (size_t)T_ * 512 * 2;
constexpr size_t WS_YB = WS_YA + (size_t)T_ * 512 * 2;
constexpr size_t WS_SELW = WS_YB + (size_t)T_ * 1024 * 2;
constexpr size_t WS_ENDA = WS_SELW + (size_t)T_ * 2 * 4 * 4;
constexpr size_t WS_H1 = WS_R;
constexpr size_t WS_X1 = WS_H1 + (size_t)T_ * 1024 * 4;
constexpr size_t WS_X1B = WS_X1 + (size_t)T_ * 1024 * 4;
constexpr size_t WS_HB = WS_X1B + (size_t)T_ * 1024 * 2;
constexpr size_t WS_CT = WS_P + (size_t)T_ * LD * 2;
constexpr size_t WS_LIST = WS_CT + (size_t)2 * T_ * 1024 * 2;
constexpr size_t WS_WTS = WS_LIST + (size_t)16 * T_ * 4;
constexpr size_t WS_ENDB = WS_WTS + (size_t)2 * T_ * 4;
static_assert(WS_HB + (size_t)2 * T_ * 512 * 2 <= WS_CT, "view B overlap");
constexpr size_t WS_END = WS_ENDA > WS_ENDB ? WS_ENDA : WS_ENDB;

constexpr int CW_CNT = 4096;
constexpr int CW_BAR = 8192;

constexpr int LDS_BYTES = 75776;
constexpr int NTHREADS = 256;

struct Params {
    const float* x; const float* w_in; const float* cmp_pos; const float* cmp_w1; const float* cmp_w2;
    const float* w_br_a; const float* w_br_b; const float* w_o; const float* ln1_g; const float* ln1_b;
    const float* w_router; const float* router_bias; const float* w_gate; const float* w_up; const float* w_down;
    const float* ln2_g; const float* ln2_b; const float* rel_bias;
    float* out; unsigned char* ws;
    int ph_lo, ph_hi;
};

__device__ __forceinline__ bf16_t f2bf(float f) { unsigned u = __float_as_uint(f); u += 0x7fffu + ((u >> 16) & 1u); return (bf16_t)(u >> 16); }
__device__ __forceinline__ float bf2f(unsigned h) { return __uint_as_float(h << 16); }
typedef __bf16 bf16x2_t __attribute__((ext_vector_type(2)));
typedef float f32x2_t __attribute__((ext_vector_type(2)));
__device__ __forceinline__ unsigned pack2(float lo, float hi) { const f32x2_t f = {lo, hi}; return __builtin_bit_cast(unsigned, __builtin_convertvector(f, bf16x2_t)); }
__device__ __forceinline__ u32x2 pack4(f32x4 v) { u32x2 r; r.x = pack2(v[0], v[1]); r.y = pack2(v[2], v[3]); return r; }
__device__ __forceinline__ f32x4 unpack4(u32x2 u) { f32x4 r; r[0] = bf2f(u.x & 0xffffu); r[1] = bf2f(u.x >> 16); r[2] = bf2f(u.y & 0xffffu); r[3] = bf2f(u.y >> 16); return r; }
__device__ __forceinline__ float rows_max(float v) {
    u32x2 r = __builtin_amdgcn_permlane16_swap(__float_as_uint(v), __float_as_uint(v), false, false);
    v = fmaxf(__uint_as_float(r.x), __uint_as_float(r.y));
    r = __builtin_amdgcn_permlane32_swap(__float_as_uint(v), __float_as_uint(v), false, false);
    return fmaxf(__uint_as_float(r.x), __uint_as_float(r.y));
}
__device__ __forceinline__ float rows_sum(float v) {
    u32x2 r = __builtin_amdgcn_permlane16_swap(__float_as_uint(v), __float_as_uint(v), false, false);
    v = __uint_as_float(r.x) + __uint_as_float(r.y);
    r = __builtin_amdgcn_permlane32_swap(__float_as_uint(v), __float_as_uint(v), false, false);
    return __uint_as_float(r.x) + __uint_as_float(r.y);
}
__device__ __forceinline__ float sigmoidf_(float x) { return 1.f / (1.f + __expf(-x)); }
__device__ __forceinline__ int vzero() { int z; asm volatile("v_mov_b32 %0, 0" : "=v"(z)); return z; }
__device__ __forceinline__ unsigned char* launder(unsigned char* q) { asm volatile("" : "+s"(q)); return q; }
__device__ __forceinline__ void wait_vm0() { asm volatile("s_waitcnt vmcnt(0)" ::: "memory"); }

__device__ __forceinline__ void glds16(const void* g, void* l) {
    __builtin_amdgcn_global_load_lds((const __attribute__((address_space(1))) unsigned*)g,
                                     (__attribute__((address_space(3))) unsigned*)l, 16, 0, 0);
}
__device__ __forceinline__ f32x4 mfma16(bf16x8 a, bf16x8 b, f32x4 c) { return __builtin_amdgcn_mfma_f32_16x16x32_bf16(a, b, c, 0, 0, 0); }

__device__ __forceinline__ void gemm_stage(const bf16_t* const (&mp)[4], const bf16_t* const (&np)[4], int kt, unsigned char* st, int wid) {
#pragma unroll
    for (int i = 0; i < 4; ++i) {
        glds16(mp[i] + kt * 64, st + (4 * i + wid) * 1024);
        glds16(np[i] + kt * 64, st + 16384 + (4 * i + wid) * 1024);
    }
}
__device__ __forceinline__ void gemm_compute(const unsigned char* st, f32x4 (&acc)[4][4], int wr, int wc, int fr, int fq) {
#pragma unroll
    for (int ks = 0; ks < 2; ++ks) {
        bf16x8 a[4], b[4];
        const int sw = ((4 * ks + fq) ^ (fr & 7)) << 4;
#pragma unroll
        for (int i = 0; i < 4; ++i) {
            a[i] = *(const bf16x8*)(st + (64 * wr + 16 * i + fr) * 128 + sw);
            b[i] = *(const bf16x8*)(st + 16384 + (64 * wc + 16 * i + fr) * 128 + sw);
        }
#pragma unroll
        for (int i = 0; i < 4; ++i)
#pragma unroll
            for (int j = 0; j < 4; ++j) acc[i][j] = mfma16(a[i], b[j], acc[i][j]);
    }
}
#define WAIT_V(n) asm volatile("s_waitcnt vmcnt(%0)" ::"n"(n) : "memory")
#define RAW_BARRIER() do { asm volatile("s_waitcnt lgkmcnt(0)" ::: "memory"); __builtin_amdgcn_s_barrier(); } while (0)
__device__ __forceinline__ void gemm_kloop(const bf16_t* const (&mp)[4], const bf16_t* const (&np)[4], int nk, unsigned char* lds, f32x4 (&acc)[4][4]) {
    const int tid = threadIdx.x, lane = tid & 63, wid = tid >> 6, wr = wid >> 1, wc = wid & 1, fr = lane & 15, fq = lane >> 4;
    gemm_stage(mp, np, 0, lds, wid);
    gemm_stage(mp, np, 1, lds + 32768, wid);
    for (int kt = 0; kt < nk; ++kt) {
        unsigned char* cur = lds + (kt & 1) * 32768;
        if (kt + 1 < nk) WAIT_V(8); else WAIT_V(0);
        RAW_BARRIER();
        bf16x8 a[2][4], b[2][4];
#pragma unroll
        for (int ks = 0; ks < 2; ++ks) {
            const int sw = ((4 * ks + fq) ^ (fr & 7)) << 4;
#pragma unroll
            for (int i = 0; i < 4; ++i) {
                a[ks][i] = *(const bf16x8*)(cur + (64 * wr + 16 * i + fr) * 128 + sw);
                b[ks][i] = *(const bf16x8*)(cur + 16384 + (64 * wc + 16 * i + fr) * 128 + sw);
            }
        }
        RAW_BARRIER();
        if (kt + 2 < nk) gemm_stage(mp, np, kt + 2, cur, wid);
#pragma unroll
        for (int ks = 0; ks < 2; ++ks)
#pragma unroll
            for (int i = 0; i < 4; ++i)
#pragma unroll
                for (int j = 0; j < 4; ++j) acc[i][j] = mfma16(a[ks][i], b[ks][j], acc[i][j]);
    }
    __syncthreads();
}
__device__ __forceinline__ void zero_acc(f32x4 (&acc)[4][4]) {
#pragma unroll
    for (int i = 0; i < 4; ++i)
#pragma unroll
        for (int j = 0; j < 4; ++j) acc[i][j] = (f32x4){0.f, 0.f, 0.f, 0.f};
}

__device__ void tcvt_tile(const float* src, int ld_src, int k0, int n0, int mode, bf16_t* dst, int kdst, unsigned char* lds) {
    float* tile = (float*)lds;
    const int tid = threadIdx.x + vzero();
#pragma unroll
    for (int i = 0; i < 4; ++i) {
        const int kk = (tid >> 4) + 16 * i, c4 = (tid & 15) * 4, cd = n0 + c4;
        int orig = cd; bool ok = true;
        if (mode == 1) { if (cd < 1280) orig = cd; else if (cd < 6400) orig = cd + 24; else if (cd < 6424) orig = cd - 6400 + 1280; else ok = false; }
        float4 v = make_float4(0.f, 0.f, 0.f, 0.f);
        if (ok) v = *(const float4*)(src + (size_t)(k0 + kk) * ld_src + orig);
        tile[kk * 65 + c4 + 0] = v.x; tile[kk * 65 + c4 + 1] = v.y; tile[kk * 65 + c4 + 2] = v.z; tile[kk * 65 + c4 + 3] = v.w;
    }
    __syncthreads();
#pragma unroll
    for (int i = 0; i < 2; ++i) {
        const int q = tid + 256 * i, n = q >> 3, kc = q & 7;
        float v[8];
#pragma unroll
        for (int j = 0; j < 8; ++j) v[j] = tile[(kc * 8 + j) * 65 + n];
        u32x4 w; w.x = pack2(v[0], v[1]); w.y = pack2(v[2], v[3]); w.z = pack2(v[4], v[5]); w.w = pack2(v[6], v[7]);
        *(u32x4*)(dst + (size_t)(n0 + n) * kdst + k0 + kc * 8) = w;
    }
    __syncthreads();
}

__device__ void phase_pw(const Params& p, int layer, unsigned char* lds, int parts) {
    const int bid = blockIdx.x, nblk = gridDim.x, tid = threadIdx.x + vzero();
    unsigned char* ws = launder(p.ws);
    constexpr int J0 = 16 * 102, J1 = 8 * 16, J2 = 256, J3 = 256, J4 = 2048, J5 = 2048, J6 = 2048, JT = J0 + J1 + J2 + J3 + J4 + J5 + J6;
    const int t_lo = (parts & 1) ? 0 : (parts & 2) ? J0 : J0 + J1 + J2 + J3;
    const int t_hi = (parts & 4) ? JT : (parts & 2) ? J0 + J1 + J2 + J3 : (parts & 1) ? J0 : 0;
    for (int t = t_lo + bid; t < t_hi; t += nblk) {
        int u = t;
        if (u < J0) { tcvt_tile(p.w_in + (size_t)layer * 1024 * DIN, DIN, (u % 16) * 64, (u / 16) * 64, 1, (bf16_t*)(ws + WS_WIN), 1024, lds); continue; }
        u -= J0;
        if (u < J1) { tcvt_tile(p.w_br_a + (size_t)layer * 512 * 1024, 1024, (u % 8) * 64, (u / 8) * 64, 0, (bf16_t*)(ws + WS_WA), 512, lds); continue; }
        u -= J1;
        if (u < J2) { tcvt_tile(p.w_br_b + (size_t)layer * 1024 * 1024, 1024, (u % 16) * 64, (u / 16) * 64, 0, (bf16_t*)(ws + WS_WB), 1024, lds); continue; }
        u -= J2;
        if (u < J3) { tcvt_tile(p.w_o + (size_t)layer * 1024 * 1024, 1024, (u % 16) * 64, (u / 16) * 64, 0, (bf16_t*)(ws + WS_WO), 1024, lds); continue; }
        u -= J3;
        if (u < J4 + J5) {
            const bool up = u >= J4; if (up) u -= J4;
            const int e = u / 128, v = u % 128;
            const float* src = (up ? p.w_up : p.w_gate) + ((size_t)layer * NE + e) * 1024 * 512;
            tcvt_tile(src, 512, (v % 16) * 64, (v / 16) * 64, 0, (bf16_t*)(ws + (up ? WS_WU : WS_WG)) + (size_t)e * 512 * 1024, 1024, lds); continue;
        }
        u -= J4 + J5;
        { const int e = u / 128, v = u % 128;
          const float* src = p.w_down + ((size_t)layer * NE + e) * 512 * 1024;
          tcvt_tile(src, 1024, (v % 8) * 64, (v / 8) * 64, 0, (bf16_t*)(ws + WS_WD) + (size_t)e * 1024 * 512, 512, lds); }
    }
    if (parts & 1) {
    for (int t = bid; t < 64; t += nblk) {
        const int kv = t >> 5, kt = t & 31;
        tcvt_tile(p.cmp_w1 + ((size_t)layer * 2 + kv) * 2048 * 64, 64, kt * 64, 0, 0, (bf16_t*)(ws + WS_W1T) + (size_t)kv * 64 * 2048, 2048, lds);
    }
    if (bid >= nblk - 2) {
        const int kv = nblk - 1 - bid, n = tid & 63, part = tid >> 6;
        const float* w1 = p.cmp_w1 + ((size_t)layer * 2 + kv) * 2048 * 64; const float* pos = p.cmp_pos + ((size_t)layer * 2 + kv) * 2048;
        float a = 0.f;
        for (int k = part * 512; k < part * 512 + 512; ++k) a += pos[k] * w1[(size_t)k * 64 + n];
        float* red = (float*)lds;
        __syncthreads(); red[tid] = a; __syncthreads();
        if (tid < 64) ((float*)(ws + WS_B1))[kv * 64 + tid] = red[tid] + red[tid + 64] + red[tid + 128] + red[tid + 192];
        __syncthreads();
    }
    }
    if (parts & 8) {
        const float4* xs = (const float4*)p.x; u32x2* xb = (u32x2*)(ws + WS_XB);
        for (size_t i = (size_t)bid * NTHREADS + tid; i < (size_t)T_ * 1024 / 4; i += (size_t)nblk * NTHREADS) {
            float4 v = xs[i]; u32x2 w; w.x = pack2(v.x, v.y); w.y = pack2(v.z, v.w); xb[i] = w;
        }
        for (int n = bid * NTHREADS + tid; n < 8192; n += nblk * NTHREADS) {
            int bk;
            if (n < 16) bk = n;
            else { const int th[15] = {22, 30, 40, 54, 73, 99, 134, 182, 246, 332, 450, 609, 825, 1117, 1513}; bk = 16;
#pragma unroll
                for (int k = 0; k < 15; ++k) bk += (n >= th[k]) ? 1 : 0; }
            (ws + WS_BUCKET)[n] = (unsigned char)bk;
        }
        for (int i = bid * NTHREADS + tid; i < 8192 * 32; i += nblk * NTHREADS) {
            const int pos = i >> 5, d = i & 31;
            const float inv = powf(10000.f, -(float)d * 2.0f / 64.f);
            const float ang = (float)pos * inv;
            float sn, cs; sincosf(ang, &sn, &cs);
            ((float2*)(ws + WS_ROPE))[i] = make_float2(cs, sn);
        }
        if (bid == 0) for (int i = tid; i < 8192; i += NTHREADS) ((unsigned*)(ws + WS_CTL))[i] = 0u;
    }
}

__device__ void phase_g1(const Params& p, int layer, unsigned char* lds) {
    unsigned char* ws = launder(p.ws);
    const bf16_t* XB = (const bf16_t*)(ws + WS_XB);
    const bf16_t* WT = (const bf16_t*)(ws + WS_WIN);
    bf16_t* P = (bf16_t*)(ws + WS_P);
    const int tid = threadIdx.x + vzero(), lane = tid & 63, wid = tid >> 6, wr = wid >> 1, wc = wid & 1, fr = lane & 15, fq = lane >> 4;
    const int ldrow = 8 * wid + (lane >> 3), ldc = ((lane & 7) ^ (lane >> 3)) * 8;
    const float2* rope = (const float2*)(ws + WS_ROPE);
    const int xcd = blockIdx.x & 7, slot = blockIdx.x >> 3, per = gridDim.x >> 3;
    for (int i = slot; i < 816; i += per) {
        int mt, nt;
        if (i < 768) { mt = i / 6; nt = xcd + 8 * (i % 6); } else { const int u = i - 768; mt = 16 * xcd + u / 3; nt = 48 + u % 3; }
        const int m0 = mt * 128, n0 = nt * 128;
        const bool transposed = (nt == 7) || (nt == 9) || (nt >= 18 && nt <= 25);
        const bf16_t* mp[4]; const bf16_t* np[4];
#pragma unroll
        for (int i = 0; i < 4; ++i) {
            const bf16_t* wrow = WT + (size_t)(n0 + 32 * i + ldrow) * 1024 + ldc;
            const bf16_t* xrow = XB + (size_t)(m0 + 32 * i + ldrow) * 1024 + ldc;
            mp[i] = transposed ? xrow : wrow; np[i] = transposed ? wrow : xrow;
        }
        f32x4 acc[4][4]; zero_acc(acc);
        gemm_kloop(mp, np, 16, lds, acc);
        if (!transposed) {
            const int kind = (nt >= 10 && nt <= 13) ? 1 : (nt >= 14 && nt <= 17) ? 2 : (nt >= 26 && nt <= 33) ? 3 : (nt >= 34) ? 4 : 0;
            if (kind == 1 || kind == 2) {
                const float sc = (kind == 2) ? 0.125f : 1.0f;
#pragma unroll
                for (int ni = 0; ni < 4; ++ni) {
                    const int tok = m0 + 64 * wc + 16 * ni + fr, pos = tok & (S_ - 1);
#pragma unroll
                    for (int mi = 0; mi < 2; ++mi) {
                        const int d = 16 * mi + 4 * fq;
                        const float4 cs01 = *(const float4*)(rope + pos * 32 + d), cs23 = *(const float4*)(rope + pos * 32 + d + 2);
                        const float c[4] = {cs01.x, cs01.z, cs23.x, cs23.z}, s[4] = {cs01.y, cs01.w, cs23.y, cs23.w};
                        f32x4 x1 = acc[mi][ni], x2 = acc[mi + 2][ni], y1, y2;
#pragma unroll
                        for (int r = 0; r < 4; ++r) { y1[r] = (x1[r] * c[r] - x2[r] * s[r]) * sc; y2[r] = (x1[r] * s[r] + x2[r] * c[r]) * sc; }
                        acc[mi][ni] = y1; acc[mi + 2][ni] = y2;
                    }
                }
            }
#pragma unroll
            for (int mi = 0; mi < 4; ++mi)
#pragma unroll
                for (int ni = 0; ni < 4; ++ni) {
                    const int n = n0 + 64 * wr + 16 * mi + 4 * fq, tok = m0 + 64 * wc + 16 * ni + fr;
                    f32x4 v = acc[mi][ni];
                    if (kind == 3) {
#pragma unroll
                        for (int r = 0; r < 4; ++r) v[r] = v[r] * sigmoidf_(v[r]);
                    } else if (kind == 4) {
#pragma unroll
                        for (int r = 0; r < 4; ++r) v[r] = sigmoidf_(v[r]);
                    }
                    *(u32x2*)(P + (size_t)tok * LD + n) = pack4(v);
                }
        } else {
#pragma unroll
            for (int mi = 0; mi < 4; ++mi)
#pragma unroll
                for (int ni = 0; ni < 4; ++ni) {
                    const int tok = m0 + 64 * wr + 16 * mi + 4 * fq, n = n0 + 64 * wc + 16 * ni + fr;
                    const int b = tok >> 13, s = tok & (S_ - 1);
                    bf16_t* dst;
                    if (nt == 7) { const int c = n - C_VS; dst = (bf16_t*)(ws + WS_VST) + ((size_t)(b * 2 + (c >> 6)) * 64 + (c & 63)) * S_ + s; }
                    else if (nt == 9) { const int c = n - C_VW; dst = (bf16_t*)(ws + WS_VWT) + ((size_t)(b * 2 + (c >> 6)) * 64 + (c & 63)) * S_ + s; }
                    else { const int c = n - C_VR; dst = (bf16_t*)(ws + WS_VRT) + ((size_t)(b * 8 + (c >> 7)) * 128 + (c & 127)) * S_ + s; }
                    *(u32x2*)dst = pack4(acc[mi][ni]);
                }
        }
    }
}

__device__ __forceinline__ void load_tile64(const bf16_t* base, size_t rowStride, unsigned char* dst, int wid, int lane) {
    const int c = ((lane & 7) ^ (lane >> 3)) * 8;
#pragma unroll
    for (int i = 0; i < 2; ++i) { const int j = wid + 4 * i, row = 8 * j + (lane >> 3); glds16(base + (size_t)row * rowStride + c, dst + j * 1024); }
}
__device__ __forceinline__ void load_tile128(const bf16_t* base, size_t rowStride, unsigned char* dst, int wid, int lane) {
    const int c = ((lane & 7) ^ (lane >> 3)) * 8;
#pragma unroll
    for (int i = 0; i < 4; ++i) { const int j = wid + 4 * i, row = 8 * j + (lane >> 3); glds16(base + (size_t)row * rowStride + c, dst + j * 1024); }
}
__device__ __forceinline__ void load_tile128w(const bf16_t* base, size_t rowStride, unsigned char* dst, int wid, int lane) {
    const int c = ((lane & 15) ^ ((4 * wid + (lane >> 4)) & 15)) * 8;
#pragma unroll
    for (int i = 0; i < 8; ++i) { const int j = wid + 4 * i, row = 4 * j + (lane >> 4); glds16(base + (size_t)row * rowStride + c, dst + j * 1024); }
}
__device__ __forceinline__ bf16x8 lds_frag128(const unsigned char* tile, int row, int chunk) {
    return *(const bf16x8*)(tile + row * 128 + ((chunk ^ (row & 7)) << 4));
}
__device__ __forceinline__ bf16x8 lds_frag256(const unsigned char* tile, int row, int chunk) {
    return *(const bf16x8*)(tile + row * 256 + ((chunk ^ (row & 15)) << 4));
}
__device__ __forceinline__ bf16x8 lds_vfrag128(const unsigned char* tile, int row, int kbase, int fq) {
    const int ca = (kbase >> 3) + (fq >> 1), hb = (fq & 1) * 8;
    const u32x2 a = *(const u32x2*)(tile + row * 128 + ((ca ^ (row & 7)) << 4) + hb);
    const u32x2 b = *(const u32x2*)(tile + row * 128 + (((ca + 2) ^ (row & 7)) << 4) + hb);
    u32x4 w; w.x = a.x; w.y = a.y; w.z = b.x; w.w = b.y;
    return __builtin_bit_cast(bf16x8, w);
}
__device__ __forceinline__ bf16x8 lds_vfrag256(const unsigned char* tile, int row, int kbase, int fq) {
    const int ca = (kbase >> 3) + (fq >> 1), hb = (fq & 1) * 8;
    const u32x2 a = *(const u32x2*)(tile + row * 256 + ((ca ^ (row & 15)) << 4) + hb);
    const u32x2 b = *(const u32x2*)(tile + row * 256 + (((ca + 2) ^ (row & 15)) << 4) + hb);
    u32x4 w; w.x = a.x; w.y = a.y; w.z = b.x; w.w = b.y;
    return __builtin_bit_cast(bf16x8, w);
}
__device__ __forceinline__ bf16x8 pack8(f32x4 a, f32x4 b) {
    u32x4 w; w.x = pack2(a[0], a[1]); w.y = pack2(a[2], a[3]); w.z = pack2(b[0], b[1]); w.w = pack2(b[2], b[3]);
    return __builtin_bit_cast(bf16x8, w);
}

__device__ __forceinline__ float gelu_tanh(float x) {
    const float u = 0.7978845608028654f * (x + 0.044715f * x * x * x);
    return 0.5f * x * (1.f + tanhf(u));
}
__device__ void compress_item(const Params& p, int layer, int item, unsigned char* lds) {
    unsigned char* ws = launder(p.ws);
    const int tid = threadIdx.x + vzero(), lane = tid & 63, wid = tid >> 6, wr = wid >> 1, wc = wid & 1, fr = lane & 15, fq = lane >> 4;
    const int mtile = item & 3, g = (item >> 2) & 1, b = (item >> 3) & 1, kv = item >> 4;
    const int i0 = mtile * 128;
    const bf16_t* P = (const bf16_t*)(ws + WS_P);
    const bf16_t* W1T = (const bf16_t*)(ws + WS_W1T) + (size_t)kv * 64 * 2048;
    const int col = (kv ? C_VC : C_KC) + g * 64;
    const int ldc = ((lane & 7) ^ (lane >> 3)) * 8;
    const bf16_t* ap[4];
#pragma unroll
    for (int i = 0; i < 4; ++i) ap[i] = P + ((size_t)b * S_ + 16 * (i0 + 32 * i + 8 * wid + (lane >> 3))) * LD + col + ldc;
    const bf16_t* bp[2];
#pragma unroll
    for (int i = 0; i < 2; ++i) bp[i] = W1T + (size_t)(8 * (wid + 4 * i) + (lane >> 3)) * 2048 + ldc;
    f32x4 acc[4][2];
#pragma unroll
    for (int i = 0; i < 4; ++i)
#pragma unroll
        for (int j = 0; j < 2; ++j) acc[i][j] = (f32x4){0.f, 0.f, 0.f, 0.f};
    __syncthreads();
#define CSTAGE(buf, l) do { unsigned char* st_ = lds + (buf) * 24576; \
        _Pragma("unroll") for (int i = 0; i < 4; ++i) glds16(ap[i] + (size_t)(l) * LD, st_ + (4 * i + wid) * 1024); \
        _Pragma("unroll") for (int i = 0; i < 2; ++i) glds16(bp[i] + (l) * 64, st_ + 16384 + (wid + 4 * i) * 1024); } while (0)
    CSTAGE(0, 0); wait_vm0(); __syncthreads();
    for (int l = 0; l < 32; ++l) {
        const unsigned char* st = lds + (l & 1) * 24576;
        if (l + 1 < 32) CSTAGE((l + 1) & 1, l + 1);
#pragma unroll
        for (int ks = 0; ks < 2; ++ks) {
            bf16x8 a[4], bb[2];
#pragma unroll
            for (int i = 0; i < 4; ++i) a[i] = lds_frag128(st, 64 * wr + 16 * i + fr, 4 * ks + fq);
#pragma unroll
            for (int j = 0; j < 2; ++j) bb[j] = lds_frag128(st + 16384, 32 * wc + 16 * j + fr, 4 * ks + fq);
#pragma unroll
            for (int i = 0; i < 4; ++i)
#pragma unroll
                for (int j = 0; j < 2; ++j) acc[i][j] = mfma16(a[i], bb[j], acc[i][j]);
        }
        wait_vm0(); __syncthreads();
    }
#undef CSTAGE
    float* hid = (float*)lds;
    const float* b1 = (const float*)(ws + WS_B1) + kv * 64;
#pragma unroll
    for (int j = 0; j < 2; ++j) {
        const int n = 32 * wc + 16 * j + fr; const float bias = b1[n + vzero()];
#pragma unroll
        for (int i = 0; i < 4; ++i)
#pragma unroll
            for (int r = 0; r < 4; ++r) hid[(64 * wr + 16 * i + 4 * fq + r) * 65 + n] = gelu_tanh(acc[i][j][r] + bias);
    }
    __syncthreads();
    {
        const int row = tid >> 1, nb = (tid & 1) * 32, ci = i0 + row;
        const float* w2 = p.cmp_w2 + ((size_t)layer * 2 + kv) * 64 * 64;
        float o[32];
#pragma unroll
        for (int q = 0; q < 32; ++q) o[q] = 0.f;
        for (int n = 0; n < 64; ++n) {
            const float h = hid[row * 65 + n];
#pragma unroll
            for (int q4 = 0; q4 < 8; ++q4) { const float4 w = *(const float4*)(w2 + n * 64 + nb + 4 * q4); o[4 * q4] += h * w.x; o[4 * q4 + 1] += h * w.y; o[4 * q4 + 2] += h * w.z; o[4 * q4 + 3] += h * w.w; }
        }
        if (kv == 0) {
            bf16_t* dst = (bf16_t*)(ws + WS_KCC) + ((size_t)(b * 2 + g) * 512 + ci) * 64 + nb;
#pragma unroll
            for (int q = 0; q < 32; q += 4) { f32x4 v = {o[q], o[q + 1], o[q + 2], o[q + 3]}; if (ci >= 511) v = (f32x4){0.f, 0.f, 0.f, 0.f}; *(u32x2*)(dst + q) = pack4(v); }
        } else {
            bf16_t* dst = (bf16_t*)(ws + WS_VCCT) + ((size_t)(b * 2 + g) * 64 + nb) * 512 + ci;
#pragma unroll
            for (int q = 0; q < 32; ++q) dst[(size_t)q * 512] = f2bf(ci >= 511 ? 0.f : o[q]);
        }
    }
    __syncthreads();
}

__device__ __forceinline__ float ret_lg2(int h) { const float gam = 1.f - exp2f(-5.f - (float)h); return log2f(gam); }

__device__ void retkv_item(const Params& p, int item, unsigned char* lds) {
    unsigned char* ws = launder(p.ws);
    const int tid = threadIdx.x + vzero(), lane = tid & 63, wid = tid >> 6, fr = lane & 15, fq = lane >> 4;
    const int n = item & 63, h = (item >> 6) & 7, b = item >> 9;
    const size_t tok0 = (size_t)b * S_ + 128 * n;
    unsigned char* vL = lds; unsigned char* kL = lds + 32768;
    load_tile128w((const bf16_t*)(ws + WS_VRT) + ((size_t)(b * 8 + h) * 128) * S_ + 128 * n, S_, vL, wid, lane);
    load_tile128((const bf16_t*)(ws + WS_P) + tok0 * LD + C_KR + h * 64, LD, kL, wid, lane);
    wait_vm0(); __syncthreads();
    const float lg2 = ret_lg2(h);
    f32x4 acc[2][4];
#pragma unroll
    for (int m = 0; m < 2; ++m)
#pragma unroll
        for (int nt = 0; nt < 4; ++nt) acc[m][nt] = (f32x4){0.f, 0.f, 0.f, 0.f};
#pragma unroll
    for (int ks = 0; ks < 4; ++ks) {
        bf16x8 a[2], bb[4];
#pragma unroll
        for (int m = 0; m < 2; ++m) a[m] = lds_frag256(vL, 32 * wid + 16 * m + fr, 4 * ks + fq);
        float dec[8];
#pragma unroll
        for (int j = 0; j < 8; ++j) dec[j] = exp2f((float)(127 - (32 * ks + 8 * fq + j)) * lg2);
#pragma unroll
        for (int nt = 0; nt < 4; ++nt) {
            const int d = 16 * nt + fr;
            float v[8];
#pragma unroll
            for (int j = 0; j < 8; ++j) {
                const int tk = 32 * ks + 8 * fq + j;
                const bf16_t kvv = *(const bf16_t*)(kL + tk * 128 + (((d >> 3) ^ (tk & 7)) << 4) + (d & 7) * 2);
                v[j] = bf2f(kvv) * dec[j];
            }
            u32x4 w; w.x = pack2(v[0], v[1]); w.y = pack2(v[2], v[3]); w.z = pack2(v[4], v[5]); w.w = pack2(v[6], v[7]);
            bb[nt] = __builtin_bit_cast(bf16x8, w);
        }
#pragma unroll
        for (int m = 0; m < 2; ++m)
#pragma unroll
            for (int nt = 0; nt < 4; ++nt) acc[m][nt] = mfma16(a[m], bb[nt], acc[m][nt]);
    }
    float* KVT = (float*)(ws + WS_KVT) + ((size_t)(b * 8 + h) * 64 + n) * 8192;
#pragma unroll
    for (int m = 0; m < 2; ++m)
#pragma unroll
        for (int nt = 0; nt < 4; ++nt)
#pragma unroll
            for (int r = 0; r < 4; ++r) KVT[(32 * wid + 16 * m + 4 * fq + r) * 64 + 16 * nt + fr] = acc[m][nt][r];
    __syncthreads();
}

__device__ void phase_p2(const Params& p, int layer, unsigned char* lds) {
    for (int it = blockIdx.x; it < 1024 + 32; it += gridDim.x) {
        if (it < 32) compress_item(p, layer, it, lds); else retkv_item(p, it - 32, lds);
    }
}

constexpr int NSA_IMP = 32768, NSA_BUCKET = 65792, NSA_BIAS = 73984;

struct NsaLane { int t; int fr, fq, wid, lane; };

template <int BR, int PASS>
__device__ __forceinline__ void nsa_half(const unsigned char* kL, const unsigned char* vL, const unsigned char* lds, const bf16_t* qptr,
                                         f32x4 (&O)[4][4], float (&m)[4], float (&l)[4], int tile, int hf, bool selbit, const NsaLane& L, int qrow) {
    const int fr = L.fr, fq = L.fq;
    bf16x8 Kf[2][2];
#pragma unroll
    for (int i = 0; i < 2; ++i)
#pragma unroll
        for (int ks = 0; ks < 2; ++ks) Kf[i][ks] = lds_frag128(kL, 32 * hf + 16 * i + fr, 4 * ks + fq);
    unsigned vmask = 0; unsigned bk[2];
    const unsigned char* bucketL = lds + NSA_BUCKET;
#pragma unroll
    for (int i = 0; i < 2; ++i) {
        unsigned pk = 0;
#pragma unroll
        for (int r = 0; r < 4; ++r) {
            const int kk = 32 * hf + 16 * i + 4 * fq + r;
            int rel; bool ok;
            if (BR == 0) { rel = L.t - (16 * (64 * tile + kk) + 31); ok = rel >= 0; }
            else if (BR == 1) { rel = L.t - (64 * tile + kk); ok = selbit && rel >= 0; }
            else { rel = L.t - (64 * tile + kk); ok = rel >= 0 && rel < 512; }
            int rc = rel < 0 ? 0 : rel; rc = rc > 8191 ? 8191 : rc;
            pk |= (unsigned)bucketL[rc] << (8 * r);
            vmask |= (ok ? 1u : 0u) << (4 * i + r);
        }
        bk[i] = pk;
    }
    const float* biasL = (const float*)(lds + NSA_BIAS);
    float ia[2] = {0.f, 0.f}, ic[2] = {0.f, 0.f};
#pragma unroll
    for (int nt = 0; nt < 4; ++nt) {
        asm volatile("" ::: "memory");
        f32x4 S[2];
        const bf16x8 q0 = *(const bf16x8*)(qptr + nt * 64), q1 = *(const bf16x8*)(qptr + nt * 64 + 32);
#pragma unroll
        for (int i = 0; i < 2; ++i) {
            S[i] = (f32x4){0.f, 0.f, 0.f, 0.f};
            S[i] = mfma16(Kf[i][0], q0, S[i]); S[i] = mfma16(Kf[i][1], q1, S[i]);
        }
        float tmax = -1e30f;
        float bsv[2][4];
#pragma unroll
        for (int i = 0; i < 2; ++i)
#pragma unroll
            for (int r = 0; r < 4; ++r) { bsv[i][r] = biasL[nt * 32 + ((bk[i] >> (8 * r)) & 0xffu)]; asm volatile("" : "+v"(bsv[i][r])); }
#pragma unroll
        for (int i = 0; i < 2; ++i)
#pragma unroll
            for (int r = 0; r < 4; ++r) {
                const bool ok = (vmask >> (4 * i + r)) & 1u;
                const float sv = S[i][r] * 0.125f + bsv[i][r];
                S[i][r] = ok ? sv : -1e30f; tmax = fmaxf(tmax, S[i][r]);
            }
        if (PASS != 1) {
            tmax = rows_max(tmax);
            const float mnew = fmaxf(m[nt], tmax), alpha = __expf(m[nt] - mnew);
            float psum = 0.f;
#pragma unroll
            for (int i = 0; i < 2; ++i)
#pragma unroll
                for (int r = 0; r < 4; ++r) {
                    const bool ok = (vmask >> (4 * i + r)) & 1u;
                    const float pv = ok ? __expf(S[i][r] - mnew) : 0.f;
                    S[i][r] = pv; psum += pv;
                }
            psum = rows_sum(psum);
            l[nt] = l[nt] * alpha + psum; m[nt] = mnew;
            if (PASS == 2) {
#pragma unroll
                for (int mt = 0; mt < 4; ++mt) O[mt][nt] = O[mt][nt] * alpha;
            }
        } else {
#pragma unroll
            for (int i = 0; i < 2; ++i) {
#pragma unroll
                for (int r = 0; r < 4; ++r) {
                    const bool ok = (vmask >> (4 * i + r)) & 1u;
                    S[i][r] = ok ? __expf(S[i][r] - m[nt]) * l[nt] : 0.f;
                }
                ia[i] += S[i][0] + S[i][1] + S[i][2] + 0.5f * S[i][3];
                ic[i] += 0.5f * S[i][3];
            }
        }
        if (PASS != 0) {
            const bf16x8 Pb = pack8(S[0], S[1]);
#pragma unroll
            for (int mt = 0; mt < 4; ++mt) O[mt][nt] = mfma16(lds_vfrag128(vL, 16 * mt + fr, 32 * hf, fq), Pb, O[mt][nt]);
        }
    }
    if (PASS == 1) {
        float* imp = (float*)(lds + NSA_IMP) + qrow * 129;
        asm volatile("" ::: "memory"); __builtin_amdgcn_wave_barrier();
#pragma unroll
        for (int i = 0; i < 2; ++i) { const int j = 16 * tile + 8 * hf + 4 * i + fq; imp[j] += ia[i]; }
        asm volatile("s_waitcnt lgkmcnt(0)" ::: "memory"); __builtin_amdgcn_wave_barrier();
#pragma unroll
        for (int i = 0; i < 2; ++i) { const int j = 16 * tile + 8 * hf + 4 * i + fq + 1; if (j < 128) imp[j] += ic[i]; }
        asm volatile("s_waitcnt lgkmcnt(0)" ::: "memory"); __builtin_amdgcn_wave_barrier();
    }
}
template <int BR, int PASS>
__device__ __forceinline__ void nsa_tile(const unsigned char* kL, const unsigned char* vL, const unsigned char* lds, const bf16_t* qptr,
                                         f32x4 (&O)[4][4], float (&m)[4], float (&l)[4], int tile, bool selbit, const NsaLane& L, int qrow) {
#pragma unroll 1
    for (int hf = 0; hf < 2; ++hf) nsa_half<BR, PASS>(kL, vL, lds, qptr, O, m, l, tile, hf, selbit, L, qrow);
}

__device__ void cmp_item(const Params& p, int item, unsigned char* lds) {
    unsigned char* ws = launder(p.ws);
    const int tid = threadIdx.x + vzero(), lane = tid & 63, wid = tid >> 6, fr = lane & 15, fq = lane >> 4;
    const int combo = item & 3, qt = 127 - (item >> 2), b = combo >> 1, g = combo & 1;
    const int q0 = qt * 64, qrow = 16 * wid + fr;
    NsaLane L; L.t = q0 + qrow; L.fr = fr; L.fq = fq; L.wid = wid; L.lane = lane;
    const size_t tok = (size_t)b * S_ + L.t;
    const bf16_t* P = (const bf16_t*)(ws + WS_P);
    __syncthreads();
    if (tid < 128) ((float*)(lds + NSA_BIAS))[tid] = p.rel_bias[(tid & 31) * 8 + 4 * g + (tid >> 5)];
    for (int i = tid; i < 64 * 129; i += NTHREADS) ((float*)(lds + NSA_IMP))[i] = 0.f;
    const bf16_t* Qf = P + tok * LD + C_QA + (4 * g) * 64 + 8 * fq;
    __syncthreads();
    f32x4 O[4][4]; float m[4], l[4];
    const bf16_t* gates = P + tok * LD + C_GA + (4 * g) * 3;
    const bf16_t* kc = (const bf16_t*)(ws + WS_KCC) + (size_t)(b * 2 + g) * 512 * 64;
    const bf16_t* vc = (const bf16_t*)(ws + WS_VCCT) + (size_t)(b * 2 + g) * 64 * 512;
    const int ntc = ((q0 + 32) >> 4) / 64 + 1;
#pragma unroll
    for (int nt = 0; nt < 4; ++nt) { m[nt] = -1e30f; l[nt] = 0.f; }
    load_tile64(kc, 64, lds, wid, lane);
    wait_vm0(); __syncthreads();
    for (int it = 0; it < ntc; ++it) {
        unsigned char* cur = lds + (it & 1) * 16384;
        if (it + 1 < ntc) load_tile64(kc + (size_t)(it + 1) * 64 * 64, 64, lds + ((it + 1) & 1) * 16384, wid, lane);
        nsa_tile<0, 0>(cur, cur + 8192, lds, Qf, O, m, l, it, true, L, qrow);
        wait_vm0(); __syncthreads();
    }
#pragma unroll
    for (int nt = 0; nt < 4; ++nt) l[nt] = l[nt] > 0.f ? 1.f / l[nt] : 0.f;
#pragma unroll
    for (int mt = 0; mt < 4; ++mt)
#pragma unroll
        for (int nt = 0; nt < 4; ++nt) O[mt][nt] = (f32x4){0.f, 0.f, 0.f, 0.f};
    load_tile64(kc, 64, lds, wid, lane); load_tile64(vc, 512, lds + 8192, wid, lane);
    wait_vm0(); __syncthreads();
    for (int it = 0; it < ntc; ++it) {
        unsigned char* cur = lds + (it & 1) * 16384;
        if (it + 1 < ntc) { unsigned char* nx = lds + ((it + 1) & 1) * 16384;
            load_tile64(kc + (size_t)(it + 1) * 64 * 64, 64, nx, wid, lane); load_tile64(vc + (it + 1) * 64, 512, nx + 8192, wid, lane); }
        nsa_tile<0, 1>(cur, cur + 8192, lds, Qf, O, m, l, it, true, L, qrow);
        wait_vm0(); __syncthreads();
    }
    bf16_t* YC = (bf16_t*)(ws + WS_YC) + tok * 512 + (4 * g) * 64;
#pragma unroll
    for (int nt = 0; nt < 4; ++nt) {
        const float gt = bf2f(gates[nt * 3 + 0]);
#pragma unroll
        for (int mt = 0; mt < 4; ++mt) *(u32x2*)(YC + nt * 64 + 16 * mt + 4 * fq) = pack4(O[mt][nt] * gt);
    }
    const int cur = qt;
    {
        float* imp = (float*)(lds + NSA_IMP) + qrow * 129 + 32 * fq;
        asm volatile("s_waitcnt lgkmcnt(0)" ::: "memory"); __builtin_amdgcn_wave_barrier();
#pragma unroll
        for (int i = 0; i < 32; ++i) {
            const int j = 32 * fq + i;
            const float v = imp[i];
            imp[i] = j > cur ? -1.f : v + ((j == 0 || j == cur || j == cur - 1) ? 1.0e4f : 0.f);
        }
        unsigned word = 0;
#pragma unroll 1
        for (int round = 0; round < 16; ++round) {
            float bv = imp[0]; int bi = 0;
#pragma unroll
            for (int i = 1; i < 32; ++i) { const float v = imp[i]; if (v > bv) { bv = v; bi = i; } }
            int gi = 32 * fq + bi;
#pragma unroll
            for (int off = 16; off <= 32; off <<= 1) {
                const float ov = __shfl_xor(bv, off); const int oi = __shfl_xor(gi, off);
                if (ov > bv || (ov == bv && oi < gi)) { bv = ov; gi = oi; }
            }
            if (bv >= 0.f && (gi >> 5) == fq) { word |= 1u << (gi & 31); imp[gi & 31] = -2.f; }
        }
        ((unsigned*)(ws + WS_SELW))[(tok * 2 + g) * 4 + fq] = word;
    }
}

__device__ void win_item(const Params& p, int item, unsigned char* lds) {
    unsigned char* ws = launder(p.ws);
    const int tid = threadIdx.x + vzero(), lane = tid & 63, wid = tid >> 6, fr = lane & 15, fq = lane >> 4;
    const int combo = item & 3, qt = 127 - (item >> 2), b = combo >> 1, g = combo & 1;
    const int q0 = qt * 64, qrow = 16 * wid + fr;
    NsaLane L; L.t = q0 + qrow; L.fr = fr; L.fq = fq; L.wid = wid; L.lane = lane;
    const size_t tok = (size_t)b * S_ + L.t;
    const bf16_t* P = (const bf16_t*)(ws + WS_P);
    __syncthreads();
    if (tid < 128) ((float*)(lds + NSA_BIAS))[tid] = p.rel_bias[(tid & 31) * 8 + 4 * g + (tid >> 5)];
    const bf16_t* Qf = P + tok * LD + C_QA + (4 * g) * 64 + 8 * fq;
    __syncthreads();
    f32x4 O[4][4]; float m[4], l[4];
    const bf16_t* gates = P + tok * LD + C_GA + (4 * g) * 3;
#pragma unroll
    for (int nt = 0; nt < 4; ++nt) { m[nt] = -1e30f; l[nt] = 0.f; }
#pragma unroll
    for (int mt = 0; mt < 4; ++mt)
#pragma unroll
        for (int nt = 0; nt < 4; ++nt) O[mt][nt] = (f32x4){0.f, 0.f, 0.f, 0.f};
    {
        const bf16_t* kb = P + ((size_t)b * S_) * LD + C_KW + g * 64;
        const bf16_t* vb = (const bf16_t*)(ws + WS_VWT) + (size_t)(b * 2 + g) * 64 * S_;
        const int k_lo = qt - 8 > 0 ? qt - 8 : 0, ntw = qt - k_lo + 1;
        load_tile64(kb + (size_t)k_lo * 64 * LD, LD, lds, wid, lane); load_tile64(vb + k_lo * 64, S_, lds + 8192, wid, lane);
        wait_vm0(); __syncthreads();
        for (int it = 0; it < ntw; ++it) {
            unsigned char* cu = lds + (it & 1) * 16384;
            if (it + 1 < ntw) { unsigned char* nx = lds + ((it + 1) & 1) * 16384;
                load_tile64(kb + (size_t)(k_lo + it + 1) * 64 * LD, LD, nx, wid, lane); load_tile64(vb + (k_lo + it + 1) * 64, S_, nx + 8192, wid, lane); }
            nsa_tile<2, 2>(cu, cu + 8192, lds, Qf, O, m, l, k_lo + it, true, L, qrow);
            wait_vm0(); __syncthreads();
        }
    }
    bf16_t* YW = (bf16_t*)(ws + WS_YW) + tok * 512 + (4 * g) * 64;
#pragma unroll
    for (int nt = 0; nt < 4; ++nt) {
        const float gt = bf2f(gates[nt * 3 + 2]) * (l[nt] > 0.f ? 1.f / l[nt] : 0.f);
#pragma unroll
        for (int mt = 0; mt < 4; ++mt) *(u32x2*)(YW + nt * 64 + 16 * mt + 4 * fq) = pack4(O[mt][nt] * gt);
    }
}

constexpr int SEL_BIAS2 = NSA_BIAS;
constexpr float LOG2E = 1.4426950408889634f;
__device__ __forceinline__ int t5_first(int bk) {
    const int th[16] = {16, 22, 30, 40, 54, 73, 99, 134, 182, 246, 332, 450, 609, 825, 1117, 1513};
    int r = 16;
#pragma unroll
    for (int k = 0; k < 16; ++k) r = (bk == 16 + k) ? th[k] : r;
    return r;
}
template <bool FAST>
__device__ __forceinline__ void sel_ntile(const bf16x8 (&Kf)[4][2], const bf16x8 (&Vf)[4][2], const bf16x8& q0, const bf16x8& q1, f32x4 (&O)[4], float& m, float& l,
                                          bool sb, int relb, int th, float blo, float bhi, const unsigned char* lds, int hl) {
    f32x4 S[4];
#pragma unroll
    for (int i = 0; i < 4; ++i) { S[i] = (f32x4){0.f, 0.f, 0.f, 0.f}; S[i] = mfma16(Kf[i][0], q0, S[i]); S[i] = mfma16(Kf[i][1], q1, S[i]); }
    float tmax = -1e30f;
    const float scl = (!FAST || sb) ? 0.125f * LOG2E : 0.f;
    if (FAST) { blo = (sb ? blo : -1e30f) - m; bhi = (sb ? bhi : -1e30f) - m; }
    if (FAST) {
#pragma unroll
        for (int i = 0; i < 4; ++i)
#pragma unroll
            for (int r = 0; r < 4; ++r) { const int rel = relb - (16 * i + r); S[i][r] = S[i][r] * scl + (rel >= th ? bhi : blo); tmax = fmaxf(tmax, S[i][r]); }
    } else {
        unsigned bkt[4][4]; float bs[4][4];
#pragma unroll
        for (int i = 0; i < 4; ++i)
#pragma unroll
            for (int r = 0; r < 4; ++r) { const int rel = relb - (16 * i + r); int rc = rel < 0 ? 0 : rel; rc = rc > 8191 ? 8191 : rc; bkt[i][r] = (lds + NSA_BUCKET)[rc]; }
#pragma unroll
        for (int i = 0; i < 4; ++i)
#pragma unroll
            for (int r = 0; r < 4; ++r) { bs[i][r] = ((const float*)(lds + SEL_BIAS2))[hl * 32 + bkt[i][r]]; asm volatile("" : "+v"(bs[i][r])); }
        const float ninf = -1e30f;
#pragma unroll
        for (int i = 0; i < 4; ++i)
#pragma unroll
            for (int r = 0; r < 4; ++r) {
                const int rel = relb - (16 * i + r);
                const float sv = S[i][r] * (0.125f * LOG2E) + (bs[i][r] - m);
                S[i][r] = (sb && rel >= 0) ? sv : ninf; tmax = fmaxf(tmax, S[i][r]);
            }
    }
    tmax = rows_max(tmax);
    if (__ballot(tmax > 8.f) != 0ull) {
        const float d = fmaxf(tmax, 0.f), alpha = __builtin_amdgcn_exp2f(-d);
        m += d; l *= alpha;
#pragma unroll
        for (int mt = 0; mt < 4; ++mt) O[mt] = O[mt] * alpha;
#pragma unroll
        for (int i = 0; i < 4; ++i)
#pragma unroll
            for (int r = 0; r < 4; ++r) S[i][r] -= d;
    }
    float psum = 0.f;
#pragma unroll
    for (int i = 0; i < 4; ++i)
#pragma unroll
        for (int r = 0; r < 4; ++r) { const float pv = __builtin_amdgcn_exp2f(S[i][r]); S[i][r] = pv; psum += pv; }
    l += rows_sum(psum);
    const bf16x8 Pb0 = pack8(S[0], S[1]), Pb1 = pack8(S[2], S[3]);
#pragma unroll
    for (int mt = 0; mt < 4; ++mt) { O[mt] = mfma16(Vf[mt][0], Pb0, O[mt]); O[mt] = mfma16(Vf[mt][1], Pb1, O[mt]); }
}
template <bool FAST>
__device__ __forceinline__ void sel_tile(const unsigned char* kL, const unsigned char* vL, const unsigned char* lds, const bf16x8 (&Qf)[2][2], f32x4 (&O)[2][4], float (&m)[2], float (&l)[2],
                                         const bool (&sb)[2], const bool (&need)[2], const int (&relb)[2], int th, float blo, float bhi, int hl, int fr, int fq) {
    bf16x8 Kf[4][2], Vf[4][2];
#pragma unroll
    for (int i = 0; i < 4; ++i)
#pragma unroll
        for (int ks = 0; ks < 2; ++ks) Kf[i][ks] = lds_frag128(kL, 16 * i + fr, 4 * ks + fq);
#pragma unroll
    for (int mt = 0; mt < 4; ++mt)
#pragma unroll
        for (int hf = 0; hf < 2; ++hf) Vf[mt][hf] = lds_vfrag128(vL, 16 * mt + fr, 32 * hf, fq);
    if (need[0]) sel_ntile<FAST>(Kf, Vf, Qf[0][0], Qf[0][1], O[0], m[0], l[0], sb[0], relb[0], th, blo, bhi, lds, hl);
    if (need[1]) sel_ntile<FAST>(Kf, Vf, Qf[1][0], Qf[1][1], O[1], m[1], l[1], sb[1], relb[1], th, blo, bhi, lds, hl);
}
template <int VAR>
__device__ void sel_item(const Params& p, int v, unsigned char* lds) {
    unsigned char* ws = launder(p.ws);
    const int tid = threadIdx.x + vzero(), lane = tid & 63, wid = tid >> 6, fr = lane & 15, fq = lane >> 4;
    const int qt = 127 - (v >> 3), sub = v & 7, b = sub >> 2, g = (sub >> 1) & 1, half = sub & 1;
    const int q0 = qt * 64 + 32 * half, cur = qt, hl = fr & 3;
    const bf16_t* P = (const bf16_t*)(ws + WS_P);
    __syncthreads();
    if (tid < 128) ((float*)(lds + SEL_BIAS2))[tid] = p.rel_bias[(tid & 31) * 8 + 4 * g + (tid >> 5)] * LOG2E;
    int t[2]; size_t tok[2]; bf16x8 Qf[2][2]; unsigned selw[2][4];
#pragma unroll
    for (int nt = 0; nt < 2; ++nt) {
        t[nt] = q0 + 8 * wid + 4 * nt + (fr >> 2); tok[nt] = (size_t)b * S_ + t[nt];
#pragma unroll
        for (int ks = 0; ks < 2; ++ks) Qf[nt][ks] = *(const bf16x8*)(P + tok[nt] * LD + C_QA + (4 * g + hl) * 64 + 32 * ks + 8 * fq);
        const u32x4 w = *(const u32x4*)((const unsigned*)(ws + WS_SELW) + (tok[nt] * 2 + g) * 4);
        selw[nt][0] = w.x; selw[nt][1] = w.y; selw[nt][2] = w.z; selw[nt][3] = w.w;
    }
    f32x4 O[2][4]; float m[2], l[2];
#pragma unroll
    for (int nt = 0; nt < 2; ++nt) { m[nt] = -1000.f; l[nt] = 0.f;
#pragma unroll
        for (int mt = 0; mt < 4; ++mt) O[nt][mt] = (f32x4){0.f, 0.f, 0.f, 0.f}; }
    const bf16_t* kb = P + ((size_t)b * S_) * LD + C_KS + g * 64;
    const bf16_t* vb = (const bf16_t*)(ws + WS_VST) + (size_t)(b * 2 + g) * 64 * S_;
    const int nts = cur + 1;
#define SEL_ISSUE(jj) do { unsigned char* st_ = lds + ((jj) & 3) * 16384; load_tile64(kb + (size_t)(jj) * 64 * LD, LD, st_, wid, lane); load_tile64(vb + (jj) * 64, S_, st_ + 8192, wid, lane); } while (0)
    asm volatile("s_waitcnt vmcnt(0)" ::: "memory");
    SEL_ISSUE(0); if (nts > 1) SEL_ISSUE(1); if (nts > 2) SEL_ISSUE(2);
    const unsigned char* bucketL = lds + NSA_BUCKET;
    for (int j = 0; j < nts; ++j) {
        const unsigned char* cu = lds + (j & 3) * 16384;
        if (j + 2 < nts) WAIT_V(8); else if (j + 1 < nts) WAIT_V(4); else WAIT_V(0);
        RAW_BARRIER();
        if (j + 3 < nts) SEL_ISSUE(j + 3);
        bool sb[2], need[2]; int relb[2];
#pragma unroll
        for (int nt = 0; nt < 2; ++nt) {
            const unsigned w = j < 32 ? selw[nt][0] : j < 64 ? selw[nt][1] : j < 96 ? selw[nt][2] : selw[nt][3];
            sb[nt] = (w >> (j & 31)) & 1u; need[nt] = __ballot(sb[nt]) != 0ull; relb[nt] = t[nt] - 64 * j - 4 * fq;
        }
        if (VAR == 1) { need[0] = false; need[1] = false; }
        if (VAR == 2) { if (!(need[0] || need[1])) { need[0] = false; } else { need[0] = true; need[1] = true; } }
        if (need[0] || need[1]) {
            const int rmin = q0 - 64 * j - 63, rmax = q0 + 31 - 64 * j;
            bool fast = false; int th = 0; float blo = 0.f, bhi = 0.f;
            if (rmin >= 16) {
                const int b0 = bucketL[rmin], b1 = bucketL[rmax > 8191 ? 8191 : rmax];
                if (b1 - b0 <= 1) { fast = true; th = t5_first(b1); if (b1 == b0) th = 0;
                    blo = ((const float*)(lds + SEL_BIAS2))[hl * 32 + b0]; bhi = ((const float*)(lds + SEL_BIAS2))[hl * 32 + b1]; }
            }
            if (fast) sel_tile<true>(cu, cu + 8192, lds, Qf, O, m, l, sb, need, relb, th, blo, bhi, hl, fr, fq);
            else sel_tile<false>(cu, cu + 8192, lds, Qf, O, m, l, sb, need, relb, th, blo, bhi, hl, fr, fq);
        }
    }
#undef SEL_ISSUE
    __syncthreads();
#pragma unroll
    for (int nt = 0; nt < 2; ++nt) {
        const float gt = bf2f(P[tok[nt] * LD + C_GA + (4 * g + hl) * 3 + 1]) * (l[nt] > 0.f ? 1.f / l[nt] : 0.f);
        const size_t o = tok[nt] * 512 + (4 * g + hl) * 64;
#pragma unroll
        for (int mt = 0; mt < 4; ++mt) {
            const f32x4 yc = unpack4(*(const u32x2*)((const bf16_t*)(ws + WS_YC) + o + 16 * mt + 4 * fq));
            const f32x4 yw = unpack4(*(const u32x2*)((const bf16_t*)(ws + WS_YW) + o + 16 * mt + 4 * fq));
            if (VAR == 0 || VAR == 3) *(u32x2*)((bf16_t*)(ws + WS_YA) + o + 16 * mt + 4 * fq) = pack4(yc + yw + O[nt][mt] * gt);
            else asm volatile("" :: "v"(O[nt][mt]));
        }
    }
}

__device__ void scan_item(const Params& p, int item) {
    unsigned char* ws = launder(p.ws);
    const int idx = item * NTHREADS + threadIdx.x;
    const int bh = idx >> 13, ed = idx & 8191, h = bh & 7;
    const float dec = exp2f(128.f * ret_lg2(h));
    const float* KVT = (const float*)(ws + WS_KVT) + (size_t)bh * 64 * 8192 + ed;
    bf16_t* SPT = (bf16_t*)(ws + WS_SPT) + (size_t)bh * 64 * 8192 + ed;
    float s = 0.f;
    for (int n = 0; n < 64; ++n) { SPT[(size_t)n * 8192] = f2bf(s); s = s * dec + KVT[(size_t)n * 8192]; }
}

__device__ void phase_p3(const Params& p, unsigned char* lds) {
    for (int i = threadIdx.x; i < 8192 / 16; i += NTHREADS) ((u32x4*)(lds + NSA_BUCKET))[i] = ((const u32x4*)(p.ws + WS_BUCKET))[i];
    __syncthreads();
    for (int it = blockIdx.x; it < 1536; it += gridDim.x) {
        if (it < 512) cmp_item(p, it, lds); else if (it < 1024) win_item(p, it - 512, lds); else scan_item(p, it - 1024);
    }
}

__device__ void retout_item(const Params& p, int item, unsigned char* lds) {
    unsigned char* ws = launder(p.ws);
    const int tid = threadIdx.x + vzero(), lane = tid & 63, wid = tid >> 6, fr = lane & 15, fq = lane >> 4;
    const int n = item & 63, h = (item >> 6) & 7, b = item >> 9;
    const size_t tok0 = (size_t)b * S_ + 128 * n;
    const bf16_t* P = (const bf16_t*)(ws + WS_P);
    unsigned char* vL = lds; unsigned char* kL = lds + 32768; unsigned char* sL = lds + 49152;
    __syncthreads();
    load_tile128w((const bf16_t*)(ws + WS_VRT) + ((size_t)(b * 8 + h) * 128) * S_ + 128 * n, S_, vL, wid, lane);
    load_tile128(P + tok0 * LD + C_KR + h * 64, LD, kL, wid, lane);
    load_tile128((const bf16_t*)(ws + WS_SPT) + ((size_t)(b * 8 + h) * 64 + n) * 8192, 64, sL, wid, lane);
    bf16x8 Qf[2][2];
#pragma unroll
    for (int nt = 0; nt < 2; ++nt)
#pragma unroll
        for (int ks = 0; ks < 2; ++ks) Qf[nt][ks] = *(const bf16x8*)(P + (tok0 + 32 * wid + 16 * nt + fr) * LD + C_QR + h * 64 + 32 * ks + 8 * fq);
    wait_vm0(); __syncthreads();
    const float lg2 = ret_lg2(h);
    f32x4 Y[8][2];
#pragma unroll
    for (int m = 0; m < 8; ++m)
#pragma unroll
        for (int nt = 0; nt < 2; ++nt) Y[m][nt] = (f32x4){0.f, 0.f, 0.f, 0.f};
#pragma unroll
    for (int m = 0; m < 8; ++m)
#pragma unroll
        for (int ks = 0; ks < 2; ++ks) {
            const bf16x8 a = lds_frag128(sL, 16 * m + fr, 4 * ks + fq);
#pragma unroll
            for (int nt = 0; nt < 2; ++nt) Y[m][nt] = mfma16(a, Qf[nt][ks], Y[m][nt]);
        }
#pragma unroll
    for (int nt = 0; nt < 2; ++nt) {
        const float sc = exp2f((float)(32 * wid + 16 * nt + fr + 1) * lg2);
#pragma unroll
        for (int m = 0; m < 8; ++m) Y[m][nt] = Y[m][nt] * sc;
    }
#pragma unroll 1
    for (int s = 0; s < 4; ++s) {
        f32x4 St[2][2];
#pragma unroll
        for (int hh = 0; hh < 2; ++hh) {
            const int mt = 2 * s + hh;
#pragma unroll
            for (int nt = 0; nt < 2; ++nt) St[hh][nt] = (f32x4){0.f, 0.f, 0.f, 0.f};
#pragma unroll
            for (int ks = 0; ks < 2; ++ks) {
                const bf16x8 a = lds_frag128(kL, 16 * mt + fr, 4 * ks + fq);
#pragma unroll
                for (int nt = 0; nt < 2; ++nt) St[hh][nt] = mfma16(a, Qf[nt][ks], St[hh][nt]);
            }
#pragma unroll
            for (int nt = 0; nt < 2; ++nt) {
                const int qi = 32 * wid + 16 * nt + fr;
#pragma unroll
                for (int r = 0; r < 4; ++r) {
                    const int kj = 16 * mt + 4 * fq + r;
                    const float dm = qi >= kj ? exp2f((float)(qi - kj) * lg2) : 0.f;
                    St[hh][nt][r] *= dm;
                }
            }
        }
        bf16x8 Pb[2];
#pragma unroll
        for (int nt = 0; nt < 2; ++nt) Pb[nt] = pack8(St[0][nt], St[1][nt]);
#pragma unroll
        for (int m = 0; m < 8; ++m) {
            const bf16x8 a = lds_vfrag256(vL, 16 * m + fr, 32 * s, fq);
#pragma unroll
            for (int nt = 0; nt < 2; ++nt) Y[m][nt] = mfma16(a, Pb[nt], Y[m][nt]);
        }
    }
    bf16_t* YB = (bf16_t*)(ws + WS_YB);
#pragma unroll
    for (int nt = 0; nt < 2; ++nt) {
        float sum = 0.f;
#pragma unroll
        for (int m = 0; m < 8; ++m) sum += Y[m][nt][0] + Y[m][nt][1] + Y[m][nt][2] + Y[m][nt][3];
        sum = rows_sum(sum);
        const float mu = sum * (1.f / 128.f);
        float vs = 0.f;
#pragma unroll
        for (int m = 0; m < 8; ++m)
#pragma unroll
            for (int r = 0; r < 4; ++r) { const float dlt = Y[m][nt][r] - mu; vs += dlt * dlt; }
        vs = rows_sum(vs);
        const float rstd = rsqrtf(vs * (1.f / 128.f) + 1e-5f);
        const size_t tk = tok0 + 32 * wid + 16 * nt + fr;
#pragma unroll
        for (int m = 0; m < 8; ++m) {
            const f32x4 gt = unpack4(*(const u32x2*)(P + tk * LD + C_GR + h * 128 + 16 * m + 4 * fq));
            f32x4 v;
#pragma unroll
            for (int r = 0; r < 4; ++r) v[r] = (Y[m][nt][r] - mu) * rstd * gt[r];
            *(u32x2*)(YB + tk * 1024 + h * 128 + 16 * m + 4 * fq) = pack4(v);
        }
    }
}
__device__ void phase_p4(const Params& p, unsigned char* lds) {
    for (int i = threadIdx.x; i < 8192 / 16; i += NTHREADS) ((u32x4*)(lds + NSA_BUCKET))[i] = ((const u32x4*)(p.ws + WS_BUCKET))[i];
    __syncthreads();
    for (int it = blockIdx.x; it < 2048; it += gridDim.x) {
        if (it < 1024) sel_item<0>(p, it < 512 ? it : 1535 - it, lds); else retout_item(p, it - 1024, lds);
    }
#ifdef EXTRA_SEL
    __syncthreads();
    for (int it = blockIdx.x; it < 1024; it += gridDim.x) {
        sel_item<EXTRA_SEL>(p, it < 512 ? it : 1535 - it, lds);
    }
#endif
}

__device__ void phase_g2(const Params& p, unsigned char* lds) {
    unsigned char* ws = launder(p.ws);
    const bf16_t* P = (const bf16_t*)(ws + WS_P);
    for (int t = (blockIdx.x & 7) * 128 + (blockIdx.x >> 3); t < ((blockIdx.x & 7) + 1) * 128; t += (gridDim.x >> 3)) {
        const int mt = t >> 3, nt = t & 7, m0 = mt * 128, n0 = nt * 128;
        const int tid = threadIdx.x + vzero(), lane = tid & 63, wid = tid >> 6, wr = wid >> 1, wc = wid & 1, fr = lane & 15, fq = lane >> 4;
        const int ldrow = 8 * wid + (lane >> 3), ldc = ((lane & 7) ^ (lane >> 3)) * 8;
        const bf16_t* mp[4]; const bf16_t* np[4];
        bf16_t* MG = (bf16_t*)(ws + WS_MG);
        { f32x4 acc1[4][4]; zero_acc(acc1);
#pragma unroll
        for (int i = 0; i < 4; ++i) { mp[i] = (const bf16_t*)(ws + WS_WA) + (size_t)(n0 + 32 * i + ldrow) * 512 + ldc; np[i] = (const bf16_t*)(ws + WS_YA) + (size_t)(m0 + 32 * i + ldrow) * 512 + ldc; }
        gemm_kloop(mp, np, 8, lds, acc1);
#pragma unroll
        for (int mi = 0; mi < 4; ++mi)
#pragma unroll
            for (int ni = 0; ni < 4; ++ni) {
                const int n = n0 + 64 * wr + 16 * mi + 4 * fq; const size_t tok = m0 + 64 * wc + 16 * ni + fr;
                const f32x4 ga = unpack4(*(const u32x2*)(P + tok * LD + C_MA + n));
                *(u32x2*)(MG + tok * 1024 + n) = pack4(ga * acc1[mi][ni]);
            } }
        { f32x4 acc2[4][4]; zero_acc(acc2);
#pragma unroll
        for (int i = 0; i < 4; ++i) { mp[i] = (const bf16_t*)(ws + WS_WB) + (size_t)(n0 + 32 * i + ldrow) * 1024 + ldc; np[i] = (const bf16_t*)(ws + WS_YB) + (size_t)(m0 + 32 * i + ldrow) * 1024 + ldc; }
        gemm_kloop(mp, np, 16, lds, acc2);
#pragma unroll
        for (int mi = 0; mi < 4; ++mi)
#pragma unroll
            for (int ni = 0; ni < 4; ++ni) {
                const int n = n0 + 64 * wr + 16 * mi + 4 * fq; const size_t tok = m0 + 64 * wc + 16 * ni + fr;
                const f32x4 gb = unpack4(*(const u32x2*)(P + tok * LD + C_MB + n));
                const f32x4 v = unpack4(*(const u32x2*)(MG + tok * 1024 + n)) + gb * acc2[mi][ni];
                *(u32x2*)(MG + tok * 1024 + n) = pack4(v);
            } }
    }
}

__device__ void phase_g3(const Params& p, int layer, unsigned char* lds) {
    unsigned char* ws = launder(p.ws);
    const int tid = threadIdx.x + vzero(), lane = tid & 63, wid = tid >> 6, wr = wid >> 1, wc = wid & 1, fr = lane & 15, fq = lane >> 4;
    const int ldrow = 8 * wid + (lane >> 3), ldc = ((lane & 7) ^ (lane >> 3)) * 8;
    const float* X = layer == 0 ? p.x : (const float*)(ws + WS_X);
    float* H1 = (float*)(ws + WS_H1);
    for (int t = (blockIdx.x & 7) * 128 + (blockIdx.x >> 3); t < ((blockIdx.x & 7) + 1) * 128; t += (gridDim.x >> 3)) {
        const int mt = t >> 3, nt = t & 7, m0 = mt * 128, n0 = nt * 128;
        const bf16_t* mp[4]; const bf16_t* np[4];
        f32x4 acc[4][4]; zero_acc(acc);
#pragma unroll
        for (int i = 0; i < 4; ++i) { mp[i] = (const bf16_t*)(ws + WS_WO) + (size_t)(n0 + 32 * i + ldrow) * 1024 + ldc; np[i] = (const bf16_t*)(ws + WS_MG) + (size_t)(m0 + 32 * i + ldrow) * 1024 + ldc; }
        gemm_kloop(mp, np, 16, lds, acc);
#pragma unroll
        for (int mi = 0; mi < 4; ++mi)
#pragma unroll
            for (int ni = 0; ni < 4; ++ni) {
                const int n = n0 + 64 * wr + 16 * mi + 4 * fq; const size_t tok = m0 + 64 * wc + 16 * ni + fr;
                const f32x4 xv = *(const f32x4*)(X + tok * 1024 + n);
                *(f32x4*)(H1 + tok * 1024 + n) = xv * DN_ALPHA + acc[mi][ni];
            }
    }
}

__device__ void phase_ln1(const Params& p, int layer, unsigned char* lds, bool dry) {
    unsigned char* ws = launder(p.ws);
    const int tid = threadIdx.x + vzero(), lane = tid & 63, wid = tid >> 6;
    float* wrL = (float*)lds;
    {
        float4 wv[16];
#pragma unroll
        for (int k = 0; k < 16; ++k) wv[k] = ((const float4*)p.w_router)[tid + 256 * k];
#pragma unroll
        for (int k = 0; k < 16; ++k) { const int i4 = tid + 256 * k, d = i4 >> 2, e0 = (i4 & 3) * 4;
            wrL[(e0 + 0) * 1024 + d] = wv[k].x; wrL[(e0 + 1) * 1024 + d] = wv[k].y; wrL[(e0 + 2) * 1024 + d] = wv[k].z; wrL[(e0 + 3) * 1024 + d] = wv[k].w; }
    }
    __syncthreads();
    const float* H1 = (const float*)(ws + WS_H1);
    float* X1 = (float*)(ws + WS_X1); bf16_t* X1B = (bf16_t*)(ws + WS_X1B);
    const float* gam = p.ln1_g + layer * 1024; const float* bet = p.ln1_b + layer * 1024;
    unsigned* cnt = (unsigned*)(ws + WS_CTL) + (dry ? 0 : CW_CNT) + layer * 1024;
    int* LIST = (int*)(ws + (dry ? WS_HB : WS_LIST)); float* WTS = (float*)(ws + (dry ? WS_HB + 4194304 : WS_WTS));
    for (int tok = blockIdx.x * 4 + wid; tok < T_; tok += gridDim.x * 4) {
        float4 v[4];
#pragma unroll
        for (int j = 0; j < 4; ++j) v[j] = *(const float4*)(H1 + (size_t)tok * 1024 + 256 * j + 4 * lane);
        float s = 0.f;
#pragma unroll
        for (int j = 0; j < 4; ++j) s += v[j].x + v[j].y + v[j].z + v[j].w;
#pragma unroll
        for (int o = 1; o < 64; o <<= 1) s += __shfl_xor(s, o);
        const float mu = s * (1.f / 1024.f);
        float q = 0.f;
#pragma unroll
        for (int j = 0; j < 4; ++j) { const float a = v[j].x - mu, b2 = v[j].y - mu, c = v[j].z - mu, d = v[j].w - mu; q += a * a + b2 * b2 + c * c + d * d; }
#pragma unroll
        for (int o = 1; o < 64; o <<= 1) q += __shfl_xor(q, o);
        const float rstd = rsqrtf(q * (1.f / 1024.f) + 1e-5f);
        float4 y[4];
#pragma unroll
        for (int j = 0; j < 4; ++j) {
            const int d0 = 256 * j + 4 * lane;
            const float4 gg = *(const float4*)(gam + d0), bb = *(const float4*)(bet + d0);
            y[j].x = (v[j].x - mu) * rstd * gg.x + bb.x; y[j].y = (v[j].y - mu) * rstd * gg.y + bb.y; y[j].z = (v[j].z - mu) * rstd * gg.z + bb.z; y[j].w = (v[j].w - mu) * rstd * gg.w + bb.w;
            *(float4*)(X1 + (size_t)tok * 1024 + d0) = y[j];
            u32x2 w; w.x = pack2(y[j].x, y[j].y); w.y = pack2(y[j].z, y[j].w);
            *(u32x2*)(X1B + (size_t)tok * 1024 + d0) = w;
        }
        float lg[16];
#pragma unroll
        for (int e = 0; e < 16; ++e) {
            float a = 0.f;
#pragma unroll
            for (int j = 0; j < 4; ++j) { const float4 w4 = *(const float4*)(wrL + e * 1024 + 256 * j + 4 * lane); a += y[j].x * w4.x + y[j].y * w4.y + y[j].z * w4.z + y[j].w * w4.w; }
            lg[e] = a;
        }
#pragma unroll
        for (int e = 0; e < 16; ++e) {
#pragma unroll
            for (int o = 1; o < 64; o <<= 1) lg[e] += __shfl_xor(lg[e], o);
        }
        float mx = lg[0];
#pragma unroll
        for (int e = 1; e < 16; ++e) mx = fmaxf(mx, lg[e]);
        float pr[16], ps = 0.f;
#pragma unroll
        for (int e = 0; e < 16; ++e) { pr[e] = expf(lg[e] - mx); ps += pr[e]; }
        const float ips = 1.f / ps;
        float sel[16];
#pragma unroll
        for (int e = 0; e < 16; ++e) { pr[e] *= ips; sel[e] = pr[e] + p.router_bias[e]; }
        int best = 0; float bestv = -1e30f;
#pragma unroll
        for (int gI = 0; gI < 4; ++gI) {
            float a = -1e30f, b2 = -1e30f;
#pragma unroll
            for (int k = 0; k < 4; ++k) { const float x = sel[4 * gI + k]; if (x > a) { b2 = a; a = x; } else if (x > b2) b2 = x; }
            const float gs = a + b2;
            if (gs > bestv) { bestv = gs; best = gI; }
        }
        float s4[4], p4[4];
#pragma unroll
        for (int k = 0; k < 4; ++k) { s4[k] = 0.f; p4[k] = 0.f; }
#pragma unroll
        for (int gI = 0; gI < 4; ++gI) if (gI == best) {
#pragma unroll
            for (int k = 0; k < 4; ++k) { s4[k] = sel[4 * gI + k]; p4[k] = pr[4 * gI + k]; }
        }
        int i0 = 0; float a0 = s4[0];
#pragma unroll
        for (int k = 1; k < 4; ++k) if (s4[k] > a0) { a0 = s4[k]; i0 = k; }
        int i1 = -1; float a1 = -1e30f;
#pragma unroll
        for (int k = 0; k < 4; ++k) if (k != i0 && s4[k] > a1) { a1 = s4[k]; i1 = k; }
        float w0 = 0.f, w1 = 0.f;
#pragma unroll
        for (int k = 0; k < 4; ++k) { if (k == i0) w0 = p4[k]; if (k == i1) w1 = p4[k]; }
        const float iw = 1.f / (w0 + w1);
        if (lane == 0) {
            const int e0 = best * 4 + i0, e1 = best * 4 + i1;
            const unsigned p0 = atomicAdd(&cnt[e0 * 64], 1u), p1 = atomicAdd(&cnt[e1 * 64], 1u);
            LIST[(size_t)e0 * T_ + p0] = tok * 2; LIST[(size_t)e1 * T_ + p1] = tok * 2 + 1;
            WTS[tok * 2] = w0 * iw; WTS[tok * 2 + 1] = w1 * iw;
        }
    }
}

__device__ __forceinline__ bool moe_find(const unsigned* cnt, int t, int colTiles, int& e, int& rt, int& ct, int& cnte, int& off) {
    int base = 0; off = 0;
    for (int k = 0; k < NE; ++k) {
        const int c = __builtin_amdgcn_readfirstlane((int)cnt[k * 64]), nt = ((c + 127) >> 7) * colTiles;
        if (t < base + nt) { e = k; cnte = c; const int u = t - base; rt = u / colTiles; ct = u % colTiles;
            e = __builtin_amdgcn_readfirstlane(e); cnte = __builtin_amdgcn_readfirstlane(cnte); rt = __builtin_amdgcn_readfirstlane(rt);
            ct = __builtin_amdgcn_readfirstlane(ct); off = __builtin_amdgcn_readfirstlane(off); return true; }
        base += nt; off += c;
    }
    return false;
}
__device__ void phase_m2(const Params& p, int layer, unsigned char* lds) {
    unsigned char* ws = launder(p.ws);
    const int tid = threadIdx.x + vzero(), lane = tid & 63, wid = tid >> 6, wr = wid >> 1, wc = wid & 1, fr = lane & 15, fq = lane >> 4;
    const int ldrow = 8 * wid + (lane >> 3), ldc = ((lane & 7) ^ (lane >> 3)) * 8;
    const unsigned* cnt = (const unsigned*)(ws + WS_CTL) + CW_CNT + layer * 1024 + vzero();
    const int* LIST = (const int*)(ws + WS_LIST);
    const bf16_t* X1B = (const bf16_t*)(ws + WS_X1B);
    bf16_t* HB = (bf16_t*)(ws + WS_HB);
    int ntile = 0;
    for (int k = 0; k < NE; ++k) ntile += ((__builtin_amdgcn_readfirstlane((int)cnt[k * 64]) + 127) >> 7) * 8;
    const int t_lo = (ntile * (int)(blockIdx.x & 7)) >> 3, t_hi = (ntile * (int)((blockIdx.x & 7) + 1)) >> 3;
    for (int t = t_lo + (blockIdx.x >> 3); t < t_hi; t += (gridDim.x >> 3)) {
        int e, rt, ct, cnte, off;
        if (!moe_find(cnt, t, 8, e, rt, ct, cnte, off)) break;
        const bf16_t* mp[4]; const bf16_t* np[4];
#pragma unroll
        for (int i = 0; i < 4; ++i) {
            const int rho = 32 * i + ldrow, blk = rho >> 4, nn = ct * 64 + (blk >> 1) * 16 + (rho & 15);
            mp[i] = (const bf16_t*)(ws + ((blk & 1) ? WS_WU : WS_WG)) + ((size_t)e * 512 + nn) * 1024 + ldc;
            int idx = rt * 128 + rho; idx = idx < cnte ? idx : cnte - 1;
            const int a = LIST[(size_t)e * T_ + idx];
            np[i] = X1B + (size_t)(a >> 1) * 1024 + ldc;
        }
        f32x4 acc[4][4]; zero_acc(acc);
        gemm_kloop(mp, np, 16, lds, acc);
#pragma unroll
        for (int mp2 = 0; mp2 < 2; ++mp2)
#pragma unroll
            for (int ni = 0; ni < 4; ++ni) {
                const int idx = rt * 128 + 64 * wc + 16 * ni + fr;
                if (idx < cnte) {
                    const int n = ct * 64 + (2 * wr + mp2) * 16 + 4 * fq;
                    const f32x4 gv = acc[2 * mp2][ni], uv = acc[2 * mp2 + 1][ni];
                    f32x4 hv;
#pragma unroll
                    for (int r = 0; r < 4; ++r) hv[r] = gv[r] * sigmoidf_(gv[r]) * uv[r];
                    *(u32x2*)(HB + (size_t)(off + idx) * 512 + n) = pack4(hv);
                }
            }
    }
}
__device__ void phase_m3(const Params& p, int layer, unsigned char* lds) {
    unsigned char* ws = launder(p.ws);
    const int tid = threadIdx.x + vzero(), lane = tid & 63, wid = tid >> 6, wr = wid >> 1, wc = wid & 1, fr = lane & 15, fq = lane >> 4;
    const int ldrow = 8 * wid + (lane >> 3), ldc = ((lane & 7) ^ (lane >> 3)) * 8;
    const unsigned* cnt = (const unsigned*)(ws + WS_CTL) + CW_CNT + layer * 1024 + vzero();
    const int* LIST = (const int*)(ws + WS_LIST);
    const bf16_t* HB = (const bf16_t*)(ws + WS_HB);
    bf16_t* CT = (bf16_t*)(ws + WS_CT);
    int ntile = 0;
    for (int k = 0; k < NE; ++k) ntile += ((__builtin_amdgcn_readfirstlane((int)cnt[k * 64]) + 127) >> 7) * 8;
    const int t_lo = (ntile * (int)(blockIdx.x & 7)) >> 3, t_hi = (ntile * (int)((blockIdx.x & 7) + 1)) >> 3;
    for (int t = t_lo + (blockIdx.x >> 3); t < t_hi; t += (gridDim.x >> 3)) {
        int e, rt, ct, cnte, off;
        if (!moe_find(cnt, t, 8, e, rt, ct, cnte, off)) break;
        const bf16_t* mp[4]; const bf16_t* np[4];
#pragma unroll
        for (int i = 0; i < 4; ++i) {
            const int rho = 32 * i + ldrow;
            mp[i] = (const bf16_t*)(ws + WS_WD) + ((size_t)e * 1024 + ct * 128 + rho) * 512 + ldc;
            int idx = rt * 128 + rho; idx = idx < cnte ? idx : cnte - 1;
            np[i] = HB + (size_t)(off + idx) * 512 + ldc;
        }
        f32x4 acc[4][4]; zero_acc(acc);
        gemm_kloop(mp, np, 8, lds, acc);
#pragma unroll
        for (int ni = 0; ni < 4; ++ni) {
            const int idx = rt * 128 + 64 * wc + 16 * ni + fr;
            if (idx < cnte) {
                const int a = LIST[(size_t)e * T_ + idx];
#pragma unroll
                for (int mi = 0; mi < 4; ++mi) {
                    const int n = ct * 128 + 64 * wr + 16 * mi + 4 * fq;
                    *(u32x2*)(CT + (size_t)a * 1024 + n) = pack4(acc[mi][ni]);
                }
            }
        }
    }
}

__device__ void phase_ln2(const Params& p, int layer) {
    unsigned char* ws = launder(p.ws);
    const int tid = threadIdx.x + vzero(), lane = tid & 63, wid = tid >> 6;
    const float* X1 = (const float*)(ws + WS_X1); const bf16_t* CT = (const bf16_t*)(ws + WS_CT); const float* WTS = (const float*)(ws + WS_WTS);
    float* XO = layer == NLAYER - 1 ? p.out : (float*)(ws + WS_X); bf16_t* XB = (bf16_t*)(ws + WS_XB);
    const float* gam = p.ln2_g + layer * 1024; const float* bet = p.ln2_b + layer * 1024;
    constexpr int U = 4;
    const int nwave = gridDim.x * 4, wv = blockIdx.x * 4 + wid;
    for (int t0 = wv * U; t0 < T_; t0 += nwave * U) {
        float4 v[U][4]; float s[U], q[U];
#pragma unroll
        for (int u = 0; u < U; ++u) {
            const int tok = t0 + u;
            const float w0 = WTS[tok * 2 + vzero()], w1 = WTS[tok * 2 + 1 + vzero()];
            s[u] = 0.f; q[u] = 0.f;
#pragma unroll
            for (int j = 0; j < 4; ++j) {
                const int d0 = 256 * j + 4 * lane;
                const float4 xv = *(const float4*)(X1 + (size_t)tok * 1024 + d0);
                const f32x4 c0 = unpack4(*(const u32x2*)(CT + (size_t)(tok * 2) * 1024 + d0)), c1 = unpack4(*(const u32x2*)(CT + (size_t)(tok * 2 + 1) * 1024 + d0));
                v[u][j].x = xv.x * DN_ALPHA + w0 * c0[0] + w1 * c1[0]; v[u][j].y = xv.y * DN_ALPHA + w0 * c0[1] + w1 * c1[1];
                v[u][j].z = xv.z * DN_ALPHA + w0 * c0[2] + w1 * c1[2]; v[u][j].w = xv.w * DN_ALPHA + w0 * c0[3] + w1 * c1[3];
                s[u] += v[u][j].x + v[u][j].y + v[u][j].z + v[u][j].w;
                q[u] += v[u][j].x * v[u][j].x + v[u][j].y * v[u][j].y + v[u][j].z * v[u][j].z + v[u][j].w * v[u][j].w;
            }
        }
#pragma unroll
        for (int o = 1; o < 64; o <<= 1) {
#pragma unroll
            for (int u = 0; u < U; ++u) { s[u] += __shfl_xor(s[u], o); q[u] += __shfl_xor(q[u], o); }
        }
#pragma unroll
        for (int j = 0; j < 4; ++j) {
            const int d0 = 256 * j + 4 * lane;
            const float4 gg = *(const float4*)(gam + d0), bb = *(const float4*)(bet + d0);
#pragma unroll
            for (int u = 0; u < U; ++u) {
                const int tok = t0 + u;
                const float mu = s[u] * (1.f / 1024.f), var = fmaxf(q[u] * (1.f / 1024.f) - mu * mu, 0.f), rstd = rsqrtf(var + 1e-5f);
                float4 y; y.x = (v[u][j].x - mu) * rstd * gg.x + bb.x; y.y = (v[u][j].y - mu) * rstd * gg.y + bb.y; y.z = (v[u][j].z - mu) * rstd * gg.z + bb.z; y.w = (v[u][j].w - mu) * rstd * gg.w + bb.w;
                *(float4*)(XO + (size_t)tok * 1024 + d0) = y;
                u32x2 w; w.x = pack2(y.x, y.y); w.y = pack2(y.z, y.w);
                *(u32x2*)(XB + (size_t)tok * 1024 + d0) = w;
            }
        }
    }
}

#define XB_TMO      128
#define XB_XCNT(j)  (256  + 64 * (j))
#define XB_XSUB(j)  (1280 + 64 * (j))
#define XB_XGEN(j)  (2304 + 64 * (j))
#define XB_TOP      3328
#define XB_TOPGEN   3392
#define XCD_BAR_WORDS 3456
#define XB_SPIN_CAP (1u << 22)
#define LAS __attribute__((address_space(3)))
__device__ __forceinline__ unsigned xb_ld(unsigned* p)              { return __hip_atomic_load(p, __ATOMIC_RELAXED, __HIP_MEMORY_SCOPE_AGENT); }
__device__ __forceinline__ unsigned xb_add(unsigned* p, unsigned v) { return __hip_atomic_fetch_add(p, v, __ATOMIC_RELAXED, __HIP_MEMORY_SCOPE_AGENT); }
__device__ __forceinline__ unsigned xb_xcc_id() { return (unsigned)__builtin_amdgcn_s_getreg((3 << 11) | 20) & 0xFu; }
#define XB_SPIN(cond, bar) do { unsigned _sp = 0; while (cond) { __builtin_amdgcn_s_sleep(1); \
    if ((++_sp & 255u) == 0u) { if (xb_ld(&(bar)[XB_TMO])) break; if (_sp > XB_SPIN_CAP) { atomicAdd(&(bar)[XB_TMO], 1u); break; } } } } while (0)
struct XcdBarrier { unsigned* bar; unsigned x; volatile LAS unsigned* st; };
__device__ __forceinline__ XcdBarrier xcd_barrier_post(unsigned* bar, volatile LAS unsigned* st) {
    XcdBarrier b; b.bar = bar; b.x = xb_xcc_id(); b.st = st;
    if (threadIdx.x == 0) (void)xb_add(&bar[XB_XCNT(b.x)], 1u);
    return b;
}
__device__ __forceinline__ void xcd_barrier_complete(unsigned* bar, unsigned x, unsigned& nloc, unsigned& nx) {
    const unsigned G = gridDim.x * gridDim.y * gridDim.z;
    unsigned sum, cnt, mine, sp = 0u;
    for (;;) {
        sum = 0u; cnt = 0u; mine = 0u;
#pragma unroll
        for (unsigned j = 0; j < 16; ++j) { const unsigned c = xb_ld(&bar[XB_XCNT(j)]); sum += c; cnt += (c > 0u) ? 1u : 0u; mine = (j == x) ? c : mine; }
        if (sum == G) break;
        __builtin_amdgcn_s_sleep(1);
        if ((++sp & 255u) == 0u) { if (xb_ld(&bar[XB_TMO])) break; if (sp > XB_SPIN_CAP) { atomicAdd(&bar[XB_TMO], 1u); break; } }
    }
    nloc = mine > 0u ? mine : 1u; nx = cnt > 0u ? cnt : 1u;
}
__device__ __forceinline__ void xcd_barrier(const XcdBarrier& b) {
    asm volatile("s_waitcnt vmcnt(0)" ::: "memory");
    __syncthreads();
    if (threadIdx.x == 0) {
        unsigned* bar = b.bar;
        __builtin_amdgcn_s_waitcnt(0);
        unsigned nloc = b.st[0], nx = b.st[1];
        if (nloc == 0u) { xcd_barrier_complete(bar, b.x, nloc, nx); b.st[0] = nloc; b.st[1] = nx; }
        const unsigned old = xb_add(&bar[XB_XSUB(b.x)], 1u);
        const unsigned gen = old / nloc;
        if (old + 1u == (gen + 1u) * nloc) {
            __builtin_amdgcn_fence(__ATOMIC_RELEASE, "agent");
            asm volatile("s_waitcnt vmcnt(0)" ::: "memory");
            const unsigned og = xb_add(&bar[XB_TOP], 1u);
            const unsigned tg = og / nx;
            if (og + 1u == (tg + 1u) * nx) xb_add(&bar[XB_TOPGEN], 1u);
            else XB_SPIN(xb_ld(&bar[XB_TOPGEN]) == tg, bar);
            __builtin_amdgcn_fence(__ATOMIC_ACQUIRE, "agent");
            xb_add(&bar[XB_XGEN(b.x)], 1u);
            asm volatile("s_waitcnt vmcnt(0)" ::: "memory");
        } else {
            XB_SPIN(xb_ld(&bar[XB_XGEN(b.x)]) == gen, bar);
            __builtin_amdgcn_fence(__ATOMIC_ACQUIRE, "agent");
            asm volatile("s_waitcnt vmcnt(0)" ::: "memory");
        }
    }
    __syncthreads();
}

constexpr int PH_PER_LAYER = 11, N_PHASES = PH_PER_LAYER * NLAYER;
__global__ void __launch_bounds__(NTHREADS, 2) mega(Params p) {
    extern __shared__ __attribute__((aligned(16))) unsigned char lds[];
#if SINGLE_LAUNCH
    volatile LAS unsigned* xbw = (volatile LAS unsigned*)(lds + LDS_BYTES - 16);
    if (threadIdx.x < 4) xbw[threadIdx.x] = 0u;
    __syncthreads();
    XcdBarrier xbar = xcd_barrier_post((unsigned*)(p.ws + WS_CTL) + CW_BAR, xbw);
#endif
    for (int ph = p.ph_lo; ph < p.ph_hi; ++ph) {
        const int layer = ph / PH_PER_LAYER, k = ph % PH_PER_LAYER;
        if (k == 0 && layer > 0) continue;
#ifdef ONLY_PHASE
        if (k != ONLY_PHASE) continue;
#endif
#ifdef REPEAT_MASK
        for (int rep = 0; rep < (((REPEAT_MASK) >> k) & 1) + 1; ++rep) {
        if (rep) __syncthreads();
#endif
        switch (k) {
            case 0: phase_pw(p, layer, lds, 15); break;
            case 1: phase_g1(p, layer, lds); break;
            case 2: phase_p2(p, layer, lds); break;
            case 3: phase_p3(p, lds); if (layer + 1 < NLAYER) { __syncthreads(); phase_pw(p, layer + 1, lds, 1); } break;
            case 4: if (layer > 0 && ((blockIdx.x >> 3) & 1)) { phase_pw(p, layer, lds, 4); __syncthreads(); }
                    phase_p4(p, lds);
                    if (layer > 0 && !((blockIdx.x >> 3) & 1)) { __syncthreads(); phase_pw(p, layer, lds, 4); } break;
            case 5: phase_g2(p, lds); break;
            case 6: phase_g3(p, layer, lds); break;
#ifdef REPEAT_MASK
            case 7: phase_ln1(p, layer, lds, (((REPEAT_MASK) >> 7) & 1) && rep == 0); break;
#else
            case 7: phase_ln1(p, layer, lds, false); if (layer + 1 < NLAYER) { __syncthreads(); phase_pw(p, layer + 1, lds, 2); } break;
#endif
            case 8: phase_m2(p, layer, lds); break;
            case 9: phase_m3(p, layer, lds); break;
            case 10: phase_ln2(p, layer); break;
        }
#ifdef REPEAT_MASK
        }
#endif
#if SINGLE_LAUNCH
        if (ph + 1 < p.ph_hi) { if (ph == p.ph_lo) cg::this_grid().sync(); else xcd_barrier(xbar); }
#endif
    }
}

extern "C" void kernel_launch(void* const* d_in, const int* in_sizes, int n_in, void* d_out, int out_size, void* d_ws, size_t ws_size, hipStream_t stream) {
    static int grid = 0;
    if (grid == 0) {
        if (n_in != 18 || ws_size < WS_END) { fprintf(stderr, "kernel_launch: unexpected n_in %d or ws_size %zu < %zu\n", n_in, ws_size, (size_t)WS_END); grid = -1; return; }
        int dev = 0, cus = 0, per_cu = 0;
        hipGetDevice(&dev); hipDeviceGetAttribute(&cus, hipDeviceAttributeMultiprocessorCount, dev);
        hipFuncSetAttribute((const void*)mega, hipFuncAttributeMaxDynamicSharedMemorySize, LDS_BYTES);
        hipOccupancyMaxActiveBlocksPerMultiprocessor(&per_cu, (const void*)mega, NTHREADS, LDS_BYTES);
        if (per_cu < 1) per_cu = 1;
        if (per_cu > 2) per_cu = 2;
        grid = cus * per_cu;
        (void)hipGetLastError();
    }
    if (grid < 0) return;
    Params p{};
    p.x = (const float*)d_in[0]; p.w_in = (const float*)d_in[1]; p.cmp_pos = (const float*)d_in[2]; p.cmp_w1 = (const float*)d_in[3]; p.cmp_w2 = (const float*)d_in[4];
    p.w_br_a = (const float*)d_in[5]; p.w_br_b = (const float*)d_in[6]; p.w_o = (const float*)d_in[7]; p.ln1_g = (const float*)d_in[8]; p.ln1_b = (const float*)d_in[9];
    p.w_router = (const float*)d_in[10]; p.router_bias = (const float*)d_in[11]; p.w_gate = (const float*)d_in[12]; p.w_up = (const float*)d_in[13]; p.w_down = (const float*)d_in[14];
    p.ln2_g = (const float*)d_in[15]; p.ln2_b = (const float*)d_in[16]; p.rel_bias = (const float*)d_in[17];
    p.out = (float*)d_out; p.ws = (unsigned char*)d_ws;
#if SINGLE_LAUNCH
    hipMemsetAsync((unsigned char*)d_ws + WS_CTL + (size_t)CW_BAR * 4, 0, XCD_BAR_WORDS * 4, stream);
    p.ph_lo = 0; p.ph_hi = N_PHASES;
    void* args[] = {&p};
    hipError_t e = hipLaunchCooperativeKernel((const void*)mega, dim3(grid), dim3(NTHREADS), args, LDS_BYTES, stream);
    if (e != hipSuccess) fprintf(stderr, "cooperative launch failed: %s (grid %d)\n", hipGetErrorString(e), grid);
#else
    for (int ph = 0; ph < N_PHASES; ++ph) {
        p.ph_lo = ph; p.ph_hi = ph + 1;
        hipLaunchKernelGGL(mega, dim3(grid), dim3(NTHREADS), LDS_BYTES, stream, p);
    }
#endif
}
```

```cpp
#include <hip/hip_runtime.h>
#include <hip/hip_cooperative_groups.h>
#include <cstdio>
#include <cstdint>
namespace cg = cooperative_groups;

#ifndef SINGLE_LAUNCH
#define SINGLE_LAUNCH 1
#endif

typedef unsigned short bf16_t;
typedef short bf16x8 __attribute__((ext_vector_type(8)));
typedef float f32x4 __attribute__((ext_vector_type(4)));
typedef unsigned u32x2 __attribute__((ext_vector_type(2)));
typedef unsigned u32x4 __attribute__((ext_vector_type(4)));

constexpr int B_ = 2, S_ = 8192, D_ = 1024, T_ = B_ * S_, NLAYER = 4;
constexpr int DIN = 6424;
constexpr int LD = 5376;
constexpr int NW = 6656;
constexpr int C_QA = 0, C_KC = 512, C_VC = 640, C_KS = 768, C_KW = 896, C_QR = 1024, C_KR = 1536, C_GR = 2048, C_MA = 3072, C_MB = 4096, C_GA = 5120,
              C_VS = 5376, C_VW = 5504, C_VR = 5632;
constexpr float DN_ALPHA = 1.681792830507429f;
constexpr int NE = 16;

constexpr size_t al256(size_t x) { return (x + 255) & ~(size_t)255; }
constexpr size_t WS_CTL = 0;
constexpr size_t WS_BUCKET = 65536;
constexpr size_t WS_ROPE = WS_BUCKET + 8192;
constexpr size_t WS_WIN = WS_ROPE + (size_t)8192 * 32 * 8;
constexpr size_t WS_WA = WS_WIN + (size_t)NW * 1024 * 2;
constexpr size_t WS_WB = WS_WA + (size_t)1024 * 512 * 2;
constexpr size_t WS_WO = WS_WB + (size_t)1024 * 1024 * 2;
constexpr size_t WS_WG = WS_WO + (size_t)1024 * 1024 * 2;
constexpr size_t WS_WU = WS_WG + (size_t)16 * 512 * 1024 * 2;
constexpr size_t WS_WD = WS_WU + (size_t)16 * 512 * 1024 * 2;
constexpr size_t WS_XB = WS_WD + (size_t)16 * 512 * 1024 * 2;
constexpr size_t WS_X = WS_XB + (size_t)T_ * 1024 * 2;
constexpr size_t WS_MG = WS_X + (size_t)T_ * 1024 * 4;
constexpr size_t WS_KCC = WS_MG + (size_t)T_ * 1024 * 2;
constexpr size_t WS_VCCT = WS_KCC + (size_t)4 * 512 * 64 * 2;
constexpr size_t WS_W1T = WS_VCCT + (size_t)4 * 512 * 64 * 2;
constexpr size_t WS_B1 = WS_W1T + (size_t)2 * 64 * 2048 * 2;
constexpr size_t WS_R = WS_B1 + 1024;
constexpr size_t WS_P = WS_R;
constexpr size_t WS_VST = WS_P + (size_t)T_ * LD * 2;
constexpr size_t WS_VWT = WS_VST + (size_t)4 * 64 * S_ * 2;
constexpr size_t WS_VRT = WS_VWT + (size_t)4 * 64 * S_ * 2;
constexpr size_t WS_KVT = WS_VRT + (size_t)16 * 128 * S_ * 2;
constexpr size_t WS_SPT = WS_KVT + (size_t)16 * 64 * 8192 * 4;
constexpr size_t WS_YC = WS_SPT + (size_t)16 * 64 * 8192 * 2;
constexpr size_t WS_YW = WS_YC + (size_t)T_ * 512 * 2;
constexpr size_t WS_YA = WS_YW + (size_t)T_ * 512 * 2;
constexpr size_t WS_YB = WS_YA + (size_t)T_ * 512 * 2;
constexpr size_t WS_SELW = WS_YB + (size_t)T_ * 1024 * 2;
constexpr size_t WS_ENDA = WS_SELW + (size_t)T_ * 2 * 4 * 4;
constexpr size_t WS_H1 = WS_R;
constexpr size_t WS_X1 = WS_H1 + (size_t)T_ * 1024 * 4;
constexpr size_t WS_X1B = WS_X1 + (size_t)T_ * 1024 * 4;
constexpr size_t WS_HB = WS_X1B + (size_t)T_ * 1024 * 2;
constexpr size_t WS_CT = WS_HB + (size_t)2 * T_ * 512 * 2;
constexpr size_t WS_LIST = WS_CT + (size_t)2 * T_ * 1024 * 2;
constexpr size_t WS_WTS = WS_LIST + (size_t)16 * T_ * 4;
constexpr size_t WS_ENDB = WS_WTS + (size_t)2 * T_ * 4;
static_assert(WS_HB + (size_t)2 * T_ * 512 * 2 <= WS_CT, "view B overlap");
constexpr size_t WS_END = WS_ENDA > WS_ENDB ? WS_ENDA : WS_ENDB;

constexpr int CW_CNT = 4096;
constexpr int CW_BAR = 8192;

constexpr int HALF_LDS = 75776, LDS_BYTES = 2 * HALF_LDS + 16;
constexpr int NTHREADS = 512, HT = 256;

struct Params {
    const float* x; const float* w_in; const float* cmp_pos; const float* cmp_w1; const float* cmp_w2;
    const float* w_br_a; const float* w_br_b; const float* w_o; const float* ln1_g; const float* ln1_b;
    const float* w_router; const float* router_bias; const float* w_gate; const float* w_up; const float* w_down;
    const float* ln2_g; const float* ln2_b; const float* rel_bias;
    float* out; unsigned char* ws;
    int ph_lo, ph_hi;
};

__device__ __forceinline__ bf16_t f2bf(float f) { unsigned u = __float_as_uint(f); u += 0x7fffu + ((u >> 16) & 1u); return (bf16_t)(u >> 16); }
__device__ __forceinline__ float bf2f(unsigned h) { return __uint_as_float(h << 16); }
typedef __bf16 bf16x2_t __attribute__((ext_vector_type(2)));
typedef float f32x2_t __attribute__((ext_vector_type(2)));
__device__ __forceinline__ unsigned pack2(float lo, float hi) { const f32x2_t f = {lo, hi}; return __builtin_bit_cast(unsigned, __builtin_convertvector(f, bf16x2_t)); }
__device__ __forceinline__ u32x2 pack4(f32x4 v) { u32x2 r; r.x = pack2(v[0], v[1]); r.y = pack2(v[2], v[3]); return r; }
__device__ __forceinline__ f32x4 unpack4(u32x2 u) { f32x4 r; r[0] = bf2f(u.x & 0xffffu); r[1] = bf2f(u.x >> 16); r[2] = bf2f(u.y & 0xffffu); r[3] = bf2f(u.y >> 16); return r; }
__device__ __forceinline__ float rows_max(float v) {
    u32x2 r = __builtin_amdgcn_permlane16_swap(__float_as_uint(v), __float_as_uint(v), false, false);
    v = fmaxf(__uint_as_float(r.x), __uint_as_float(r.y));
    r = __builtin_amdgcn_permlane32_swap(__float_as_uint(v), __float_as_uint(v), false, false);
    return fmaxf(__uint_as_float(r.x), __uint_as_float(r.y));
}
__device__ __forceinline__ float rows_sum(float v) {
    u32x2 r = __builtin_amdgcn_permlane16_swap(__float_as_uint(v), __float_as_uint(v), false, false);
    v = __uint_as_float(r.x) + __uint_as_float(r.y);
    r = __builtin_amdgcn_permlane32_swap(__float_as_uint(v), __float_as_uint(v), false, false);
    return __uint_as_float(r.x) + __uint_as_float(r.y);
}
__device__ __forceinline__ float sigmoidf_(float x) { return 1.f / (1.f + __expf(-x)); }
__device__ __forceinline__ int ltid() { int t = threadIdx.x; asm volatile("" : "+v"(t)); return t; }
__device__ __forceinline__ int vzero() { int z; asm volatile("v_mov_b32 %0, 0" : "=v"(z)); return z; }
__device__ __forceinline__ unsigned char* launder(unsigned char* q) { asm volatile("" : "+s"(q)); return q; }
__device__ __forceinline__ void wait_vm0() { asm volatile("s_waitcnt vmcnt(0)" ::: "memory"); }

__device__ __forceinline__ void glds16(const void* g, void* l) {
    __builtin_amdgcn_global_load_lds((const __attribute__((address_space(1))) unsigned*)g,
                                     (__attribute__((address_space(3))) unsigned*)l, 16, 0, 0);
}
__device__ __forceinline__ f32x4 mfma16(bf16x8 a, bf16x8 b, f32x4 c) { return __builtin_amdgcn_mfma_f32_16x16x32_bf16(a, b, c, 0, 0, 0); }

#define WAIT_V(n) asm volatile("s_waitcnt vmcnt(%0)" ::"n"(n) : "memory")
#define RAW_BARRIER() do { asm volatile("s_waitcnt lgkmcnt(0)" ::: "memory"); __builtin_amdgcn_s_barrier(); } while (0)
__device__ __forceinline__ void bglds16(__amdgpu_buffer_rsrc_t r, unsigned voff, int soff, void* l) {
    __builtin_amdgcn_raw_ptr_buffer_load_lds(r, (__attribute__((address_space(3))) void*)l, 16, (int)voff, soff, 0, 0);
}
template <int NJ, bool GN>
__device__ __forceinline__ void gemm8_stage(__amdgpu_buffer_rsrc_t mr, int mld, unsigned mvo, __amdgpu_buffer_rsrc_t nr, int nld, const unsigned (&nvo)[NJ], int kt, unsigned char* st, int wid) {
#pragma unroll
    for (int i = 0; i < 4; ++i) bglds16(mr, mvo, (64 * i * mld + kt * 64) * 2, st + (8 * i + wid) * 1024);
#pragma unroll
    for (int i = 0; i < NJ; ++i) bglds16(nr, nvo[i], ((GN ? 0 : 64 * i * nld) + kt * 64) * 2, st + 32768 + (8 * i + wid) * 1024);
}
template <int NJ, bool GN>
__device__ __forceinline__ void gemm8_kloop(const bf16_t* mb, int mld, unsigned mvo, const bf16_t* nb, int nld, const unsigned (&nvo)[NJ], int nk, unsigned char* lds, f32x4 (&acc)[8][NJ], int tid) {
    const int lane = tid & 63, wid = tid >> 6, wr = wid >> 2, wc = wid & 3, fr = lane & 15, fq = lane >> 4;
    const __amdgpu_buffer_rsrc_t mr = __builtin_amdgcn_make_buffer_rsrc((void*)mb, 0, 0x7fffffff, 0x00020000);
    const __amdgpu_buffer_rsrc_t nr = __builtin_amdgcn_make_buffer_rsrc((void*)nb, 0, 0x7fffffff, 0x00020000);
    gemm8_stage<NJ, GN>(mr, mld, mvo, nr, nld, nvo, 0, lds, wid);
    gemm8_stage<NJ, GN>(mr, mld, mvo, nr, nld, nvo, 1, lds + 65536, wid);
    for (int kt = 0; kt < nk; ++kt) {
        unsigned char* cur = lds + (kt & 1) * 65536;
        if (kt + 1 < nk) WAIT_V(4 + NJ); else WAIT_V(0);
        RAW_BARRIER();
        bf16x8 a[4], b[NJ];
        const unsigned char* ab = cur + (128 * wr + fr) * 128;
        const unsigned char* bb = cur + 32768 + (16 * NJ * wc + fr) * 128;
        const int sw0 = ((fq) ^ (fr & 7)) << 4, sw1 = ((4 + fq) ^ (fr & 7)) << 4;
#pragma unroll
        for (int j = 0; j < NJ; ++j) b[j] = *(const bf16x8*)(bb + j * 2048 + sw0);
#pragma unroll
        for (int mh = 0; mh < 2; ++mh) {
#pragma unroll
            for (int i = 0; i < 4; ++i) a[i] = *(const bf16x8*)(ab + (4 * mh + i) * 2048 + sw0);
#pragma unroll
            for (int i = 0; i < 4; ++i)
#pragma unroll
                for (int j = 0; j < NJ; ++j) acc[4 * mh + i][j] = mfma16(a[i], b[j], acc[4 * mh + i][j]);
        }
#pragma unroll
        for (int j = 0; j < NJ; ++j) b[j] = *(const bf16x8*)(bb + j * 2048 + sw1);
#pragma unroll
        for (int i = 0; i < 4; ++i) a[i] = *(const bf16x8*)(ab + i * 2048 + sw1);
#pragma unroll
        for (int i = 0; i < 4; ++i)
#pragma unroll
            for (int j = 0; j < NJ; ++j) acc[i][j] = mfma16(a[i], b[j], acc[i][j]);
#pragma unroll
        for (int i = 0; i < 4; ++i) a[i] = *(const bf16x8*)(ab + (4 + i) * 2048 + sw1);
        RAW_BARRIER();
        if (kt + 2 < nk) gemm8_stage<NJ, GN>(mr, mld, mvo, nr, nld, nvo, kt + 2, cur, wid);
#pragma unroll
        for (int i = 0; i < 4; ++i)
#pragma unroll
            for (int j = 0; j < NJ; ++j) acc[4 + i][j] = mfma16(a[i], b[j], acc[4 + i][j]);
    }
    __syncthreads();
    __builtin_amdgcn_sched_barrier(0);
}
template <int NJ>
__device__ __forceinline__ void zero_acc8(f32x4 (&acc)[8][NJ]) {
#pragma unroll
    for (int i = 0; i < 8; ++i)
#pragma unroll
        for (int j = 0; j < NJ; ++j) acc[i][j] = (f32x4){0.f, 0.f, 0.f, 0.f};
}

namespace pg8 {
#define PG8_LAS __attribute__((address_space(3)))
constexpr int BM = 256, BK = 64, HALF = 128, HTB = HALF * BK * 2, STAGE_BYTES = 8 * HTB;
__device__ __forceinline__ int lds_byte(int r, int c) { const int st = (r >> 4) * 2 + (c >> 5), rr = r & 15, cc = c & 31, ob = rr * 64 + cc * 2; return st * 1024 + (ob ^ (((ob >> 9) & 1) << 5)); }
__device__ __forceinline__ void stage_rc(int b, int& R, int& C) { const int st = b / 1024, sb = b % 1024, swz = sb ^ (((sb >> 9) & 1) << 5); R = (st >> 1) * 16 + swz / 64; C = (st & 1) * 32 + (swz % 64) / 2; }
__device__ __forceinline__ int perm32(int rho) { const int n = rho >> 4, i = rho & 15; return 8 * (i >> 2) + 4 * n + (i & 3); }
struct Unit { int pm, pn; };
template <class Epi, class Sched>
__device__ __forceinline__ void gemm_phase(unsigned char* lds_, const int K, const Sched& S, const Epi& E, const int tid) {
    PG8_LAS unsigned char* lds = (PG8_LAS unsigned char*)lds_;
    const int wid = __builtin_amdgcn_readfirstlane(tid >> 6), lane = tid & 63, wr = wid >> 2, wc = wid & 3, fr = lane & 15, fq = lane >> 4;
    const int nt = K / BK;
    unsigned voffA[2], voffB[2];
#pragma unroll
    for (int i = 0; i < 2; ++i) { int R, C; stage_rc(tid * 16 + i * 8192, R, C); const int Rb = (R & ~31) + perm32(R & 31);
        voffA[i] = (unsigned)(R * K + C) * 2u; voffB[i] = (unsigned)(Rb * K + C) * 2u; }
    const size_t kstep = (size_t)(BK * 2);
    const size_t hstep = (size_t)HALF * K * 2;
    const unsigned ldsw = (unsigned)wid * 1024u;
    const int aoff = lds_byte(wr * 64 + fr, fq * 8), boff = lds_byte(wc * 32 + fr, fq * 8);
#define PG8_SA(b, h) (((b) * 2 + (h)) * HTB)
#define PG8_SB(b, h) ((4 + (b) * 2 + (h)) * HTB)
#define PG8_STAGE(bufoff, gbase, voff) do { _Pragma("unroll") for (int _i = 0; _i < 2; ++_i) \
        __builtin_amdgcn_global_load_lds((const __attribute__((address_space(1))) unsigned*)((const char*)(gbase) + (voff)[_i]), (PG8_LAS unsigned*)(lds + (bufoff) + ldsw + _i * 8192), 16, 0, 0); } while (0)
#define PG8_LDA(dst, b, h) do { _Pragma("unroll") for (int m = 0; m < 4; ++m) _Pragma("unroll") for (int k = 0; k < 2; ++k) dst[m][k] = *(const PG8_LAS bf16x8*)(lds + PG8_SA(b, h) + aoff + m * 2048 + k * 1024); } while (0)
#define PG8_LDB(dst, b, h) do { _Pragma("unroll") for (int n = 0; n < 2; ++n) _Pragma("unroll") for (int k = 0; k < 2; ++k) dst[n][k] = *(const PG8_LAS bf16x8*)(lds + PG8_SB(b, h) + boff + n * 2048 + k * 1024); } while (0)
#define PG8_MMA(ai, bj, At, Bt) do { __builtin_amdgcn_s_setprio(1); _Pragma("unroll") for (int m = 0; m < 4; ++m) _Pragma("unroll") for (int n = 0; n < 2; ++n) _Pragma("unroll") for (int k = 0; k < 2; ++k) \
        acc[ai][bj][m][n] = __builtin_amdgcn_mfma_f32_16x16x32_bf16(Bt[n][k], At[m][k], acc[ai][bj][m][n], 0, 0, 0); __builtin_amdgcn_s_setprio(0); } while (0)
#define PG8_WAIT_V(n) asm volatile("s_waitcnt vmcnt(" #n ")" ::: "memory")
#define PG8_WAIT_L(n) asm volatile("s_waitcnt lgkmcnt(" #n ")" ::: "memory")
#define PG8_BAR __builtin_amdgcn_s_barrier()
#define PG8_SCHED __builtin_amdgcn_sched_barrier(0)
    Unit cur, nxt; int ui = 0;
    if (!S.next(0, cur)) return;
    f32x4 acc[2][2][4][2];
#pragma unroll
    for (int a = 0; a < 2; ++a)
#pragma unroll
        for (int b = 0; b < 2; ++b)
#pragma unroll
            for (int m = 0; m < 4; ++m)
#pragma unroll
                for (int n = 0; n < 2; ++n) acc[a][b][m][n] = (f32x4){0.f, 0.f, 0.f, 0.f};
    bf16x8 At[4][2], B0[2][2], B1[2][2];
    const char* cA; const char* cB; S.ptrs(cur, cA, cB);
    PG8_STAGE(PG8_SB(0, 0), cB, voffB); PG8_STAGE(PG8_SA(0, 0), cA, voffA); PG8_STAGE(PG8_SB(0, 1), cB + hstep, voffB); PG8_STAGE(PG8_SA(0, 1), cA + hstep, voffA);
    if (wr == 1) PG8_BAR;
    PG8_WAIT_V(4); PG8_BAR;
    PG8_STAGE(PG8_SB(1, 0), cB + kstep, voffB); PG8_STAGE(PG8_SA(1, 0), cA + kstep, voffA); PG8_STAGE(PG8_SB(1, 1), cB + hstep + kstep, voffB);
    PG8_WAIT_V(6); PG8_BAR;
    for (;;) {
        const bool has_next = S.next(ui + 1, nxt);
        const char* nA = cA; const char* nB = cB; if (has_next) S.ptrs(nxt, nA, nB);
        for (int t = 0; t < nt; t += 2) {
            const bool last = (t == nt - 2);
            const char* a1 = cA + (size_t)(t + 1) * kstep;
            const char* a2 = last ? nA : cA + (size_t)(t + 2) * kstep; const char* b2 = last ? nB : cB + (size_t)(t + 2) * kstep;
            const char* a3 = a2 + kstep; const char* b3 = b2 + kstep;
            PG8_LDB(B0, 0, 0); PG8_SCHED; PG8_LDA(At, 0, 0); PG8_STAGE(PG8_SA(1, 1), a1 + hstep, voffA);
            PG8_WAIT_L(8); PG8_BAR; PG8_WAIT_L(0); PG8_MMA(0, 0, At, B0); PG8_BAR; PG8_SCHED;
            PG8_LDB(B1, 0, 1); PG8_STAGE(PG8_SB(0, 0), b2, voffB);
            PG8_BAR; PG8_WAIT_L(0); PG8_MMA(0, 1, At, B1); PG8_BAR;
            PG8_LDA(At, 0, 1); PG8_STAGE(PG8_SA(0, 0), a2, voffA);
            PG8_BAR; PG8_WAIT_L(0); PG8_MMA(1, 0, At, B0); PG8_BAR; PG8_SCHED;
            PG8_STAGE(PG8_SB(0, 1), b2 + hstep, voffB);
            PG8_WAIT_V(6); PG8_BAR; PG8_MMA(1, 1, At, B1); PG8_BAR;
            PG8_LDB(B0, 1, 0); PG8_SCHED; PG8_LDA(At, 1, 0); PG8_STAGE(PG8_SA(0, 1), a2 + hstep, voffA);
            PG8_WAIT_L(8); PG8_BAR; PG8_WAIT_L(0); PG8_MMA(0, 0, At, B0); PG8_BAR; PG8_SCHED;
            PG8_LDB(B1, 1, 1); PG8_STAGE(PG8_SB(1, 0), b3, voffB);
            PG8_BAR; PG8_WAIT_L(0); PG8_MMA(0, 1, At, B1); PG8_BAR;
            PG8_LDA(At, 1, 1); PG8_STAGE(PG8_SA(1, 0), a3, voffA);
            PG8_BAR; PG8_WAIT_L(0); PG8_MMA(1, 0, At, B0); PG8_BAR; PG8_SCHED;
            PG8_STAGE(PG8_SB(1, 1), b3 + hstep, voffB);
            PG8_WAIT_V(6); PG8_BAR; PG8_MMA(1, 1, At, B1); PG8_BAR;
        }
        E(acc, cur, wr, wc, fr, fq);
        if (!has_next) break;
#pragma unroll
        for (int a = 0; a < 2; ++a)
#pragma unroll
            for (int b = 0; b < 2; ++b)
#pragma unroll
                for (int m = 0; m < 4; ++m)
#pragma unroll
                    for (int n = 0; n < 2; ++n) acc[a][b][m][n] = (f32x4){0.f, 0.f, 0.f, 0.f};
        cur = nxt; cA = nA; cB = nB; ++ui;
    }
    PG8_WAIT_V(0);
    if (wr == 0) PG8_BAR;
    PG8_BAR;
#undef PG8_SA
#undef PG8_SB
#undef PG8_STAGE
#undef PG8_LDA
#undef PG8_LDB
#undef PG8_MMA
#undef PG8_WAIT_V
#undef PG8_WAIT_L
#undef PG8_BAR
#undef PG8_SCHED
}
}

__device__ void tcvt_tile(const float* src, int ld_src, int k0, int n0, int mode, bf16_t* dst, int kdst, unsigned char* lds, int half) {
    float* tile = (float*)lds;
    const int tid = (ltid() & 255);
#pragma unroll
    for (int i = 0; i < 4; ++i) {
        const int kk = (tid >> 4) + 16 * i, c4 = (tid & 15) * 4, cd = n0 + c4;
        int orig = cd; bool ok = true;
        if (mode == 1) {
            if (cd < 896) orig = cd;
            else if (cd < 1024) orig = cd - 896 + 1024;
            else if (cd < 2048) { const int q = cd - 1024, hd = q >> 6, pp = q & 63;
                const int d = (pp & 4) ? 32 + 4 * (pp >> 3) + (pp & 3) : 4 * (pp >> 3) + (pp & 3);
                orig = 1304 + hd * 64 + d; }
            else if (cd < 5120) orig = cd - 2048 + 3352;
            else if (cd < 5144) orig = cd - 5120 + 1280;
            else if (cd < 5376) ok = false;
            else if (cd < 5504) orig = cd - 5376 + 896;
            else if (cd < 5632) orig = cd - 5504 + 1152;
            else orig = cd - 5632 + 2328;
        }
        float4 v = make_float4(0.f, 0.f, 0.f, 0.f);
        if (ok) v = *(const float4*)(src + (size_t)(k0 + kk) * ld_src + orig);
        tile[kk * 65 + c4 + 0] = v.x; tile[kk * 65 + c4 + 1] = v.y; tile[kk * 65 + c4 + 2] = v.z; tile[kk * 65 + c4 + 3] = v.w;
    }
    __syncthreads();
#pragma unroll
    for (int i = 0; i < 2; ++i) {
        const int q = tid + 256 * i, n = q >> 3, kc = q & 7;
        float v[8];
#pragma unroll
        for (int j = 0; j < 8; ++j) v[j] = tile[(kc * 8 + j) * 65 + n];
        u32x4 w; w.x = pack2(v[0], v[1]); w.y = pack2(v[2], v[3]); w.z = pack2(v[4], v[5]); w.w = pack2(v[6], v[7]);
        *(u32x4*)(dst + (size_t)(n0 + n) * kdst + k0 + kc * 8) = w;
    }
    __syncthreads();
}

__device__ void phase_pw(const Params& p, int layer, unsigned char* lds, int parts, int half) {
    const int bid = (blockIdx.x * 2 + half), nblk = (gridDim.x * 2), tid = (ltid() & 255);
    unsigned char* ws = launder(p.ws);
    constexpr int J0 = 16 * 104, J1 = 8 * 16, J2 = 256, J3 = 256, J4 = 2048, J5 = 2048, J6 = 2048, JT = J0 + J1 + J2 + J3 + J4 + J5 + J6;
    const int t_lo = (parts & 1) ? 0 : (parts & 2) ? J0 : J0 + J1 + J2 + J3;
    const int t_hi = (parts & 4) ? JT : (parts & 2) ? J0 + J1 + J2 + J3 : (parts & 1) ? J0 : 0;
    for (int t = t_lo + bid; t < t_hi; t += nblk) {
        int u = t;
        if (u < J0) { tcvt_tile(p.w_in + (size_t)layer * 1024 * DIN, DIN, (u % 16) * 64, (u / 16) * 64, 1, (bf16_t*)(ws + WS_WIN), 1024, lds, half); continue; }
        u -= J0;
        if (u < J1) { tcvt_tile(p.w_br_a + (size_t)layer * 512 * 1024, 1024, (u % 8) * 64, (u / 8) * 64, 0, (bf16_t*)(ws + WS_WA), 512, lds, half); continue; }
        u -= J1;
        if (u < J2) { tcvt_tile(p.w_br_b + (size_t)layer * 1024 * 1024, 1024, (u % 16) * 64, (u / 16) * 64, 0, (bf16_t*)(ws + WS_WB), 1024, lds, half); continue; }
        u -= J2;
        if (u < J3) { tcvt_tile(p.w_o + (size_t)layer * 1024 * 1024, 1024, (u % 16) * 64, (u / 16) * 64, 0, (bf16_t*)(ws + WS_WO), 1024, lds, half); continue; }
        u -= J3;
        if (u < J4 + J5) {
            const bool up = u >= J4; if (up) u -= J4;
            const int e = u / 128, v = u % 128;
            const float* src = (up ? p.w_up : p.w_gate) + ((size_t)layer * NE + e) * 1024 * 512;
            tcvt_tile(src, 512, (v % 16) * 64, (v / 16) * 64, 0, (bf16_t*)(ws + (up ? WS_WU : WS_WG)) + (size_t)e * 512 * 1024, 1024, lds, half); continue;
        }
        u -= J4 + J5;
        { const int e = u / 128, v = u % 128;
          const float* src = p.w_down + ((size_t)layer * NE + e) * 512 * 1024;
          tcvt_tile(src, 1024, (v % 8) * 64, (v / 8) * 64, 0, (bf16_t*)(ws + WS_WD) + (size_t)e * 1024 * 512, 512, lds, half); }
    }
    if (parts & 1) {
    for (int t = bid; t < 64; t += nblk) {
        const int kv = t >> 5, kt = t & 31;
        tcvt_tile(p.cmp_w1 + ((size_t)layer * 2 + kv) * 2048 * 64, 64, kt * 64, 0, 0, (bf16_t*)(ws + WS_W1T) + (size_t)kv * 64 * 2048, 2048, lds, half);
    }
    if (bid >= nblk - 2) {
        const int kv = nblk - 1 - bid, n = tid & 63, part = tid >> 6;
        const float* w1 = p.cmp_w1 + ((size_t)layer * 2 + kv) * 2048 * 64; const float* pos = p.cmp_pos + ((size_t)layer * 2 + kv) * 2048;
        float a = 0.f;
        for (int k = part * 512; k < part * 512 + 512; ++k) a += pos[k] * w1[(size_t)k * 64 + n];
        float* red = (float*)lds;
        __syncthreads(); red[tid] = a; __syncthreads();
        if (tid < 64) ((float*)(ws + WS_B1))[kv * 64 + tid] = red[tid] + red[tid + 64] + red[tid + 128] + red[tid + 192];
        __syncthreads();
    }
    }
    if (parts & 8) {
        const float4* xs = (const float4*)p.x; u32x2* xb = (u32x2*)(ws + WS_XB);
        for (size_t i = (size_t)bid * HT + tid; i < (size_t)T_ * 1024 / 4; i += (size_t)nblk * HT) {
            float4 v = xs[i]; u32x2 w; w.x = pack2(v.x, v.y); w.y = pack2(v.z, v.w); xb[i] = w;
        }
        for (int n = bid * HT + tid; n < 8192; n += nblk * HT) {
            int bk;
            if (n < 16) bk = n;
            else { const int th[15] = {22, 30, 40, 54, 73, 99, 134, 182, 246, 332, 450, 609, 825, 1117, 1513}; bk = 16;
#pragma unroll
                for (int k = 0; k < 15; ++k) bk += (n >= th[k]) ? 1 : 0; }
            (ws + WS_BUCKET)[n] = (unsigned char)bk;
        }
        for (int i = bid * HT + tid; i < 8192 * 32; i += nblk * HT) {
            const int pos = i >> 5, d = i & 31;
            const float inv = powf(10000.f, -(float)d * 2.0f / 64.f);
            const float ang = (float)pos * inv;
            float sn, cs; sincosf(ang, &sn, &cs);
            ((float2*)(ws + WS_ROPE))[i] = make_float2(cs, sn);
        }
        if (bid == 0) for (int i = tid; i < 8192; i += HT) ((unsigned*)(ws + WS_CTL))[i] = 0u;
    }
}

__device__ __forceinline__ float fsig(float x) { return __builtin_amdgcn_rcpf(1.f + __builtin_amdgcn_exp2f(-1.4426950408889634f * x)); }
template <int KIND>
__device__ __forceinline__ void g1_epi(const f32x4 (&acc)[2][2][4][2], unsigned char* ws, int r0, int c0, int wr, int wc, int fr, int fq) {
#pragma unroll
    for (int ai = 0; ai < 2; ++ai)
#pragma unroll
        for (int m = 0; m < 4; ++m) {
            const int row = r0 + 128 * ai + 64 * wr + 16 * m + fr + vzero();
#pragma unroll
            for (int bj = 0; bj < 2; ++bj) {
                const int col = c0 + 128 * bj + 32 * wc + 8 * fq;
                f32x4 v0 = acc[ai][bj][m][0], v1 = acc[ai][bj][m][1];
                if (KIND == 5) {
                    const int b = col >> 13, sq = col & (S_ - 1);
                    bf16_t* dst;
                    if (row < C_VW) { const int c = row - C_VS; dst = (bf16_t*)(ws + WS_VST) + ((size_t)(b * 2 + (c >> 6)) * 64 + (c & 63)) * S_ + sq; }
                    else if (row < C_VR) { const int c = row - C_VW; dst = (bf16_t*)(ws + WS_VWT) + ((size_t)(b * 2 + (c >> 6)) * 64 + (c & 63)) * S_ + sq; }
                    else { const int c = row - C_VR; dst = (bf16_t*)(ws + WS_VRT) + ((size_t)(b * 8 + (c >> 7)) * 128 + (c & 127)) * S_ + sq; }
                    u32x4 w; w.x = pack2(v0[0], v0[1]); w.y = pack2(v0[2], v0[3]); w.z = pack2(v1[0], v1[1]); w.w = pack2(v1[2], v1[3]);
                    *(u32x4*)dst = w;
                    continue;
                }
                if (KIND == 1 || KIND == 2) {
                    const float2* rope = (const float2*)(ws + WS_ROPE);
                    const int pos = row & (S_ - 1), d = 16 * (wc & 1) + 4 * fq;
                    const float4 cs01 = *(const float4*)(rope + pos * 32 + d), cs23 = *(const float4*)(rope + pos * 32 + d + 2);
                    const float c[4] = {cs01.x, cs01.z, cs23.x, cs23.z}, sn[4] = {cs01.y, cs01.w, cs23.y, cs23.w};
                    const float sc = (KIND == 2) ? 0.125f : 1.0f;
                    f32x4 y1, y2;
#pragma unroll
                    for (int r = 0; r < 4; ++r) { y1[r] = (v0[r] * c[r] - v1[r] * sn[r]) * sc; y2[r] = (v0[r] * sn[r] + v1[r] * c[r]) * sc; }
                    v0 = y1; v1 = y2;
                } else if (KIND == 3) {
#pragma unroll
                    for (int r = 0; r < 4; ++r) { v0[r] = v0[r] * fsig(v0[r]); v1[r] = v1[r] * fsig(v1[r]); }
                } else if (KIND == 4) {
#pragma unroll
                    for (int r = 0; r < 4; ++r) { v0[r] = fsig(v0[r]); v1[r] = fsig(v1[r]); }
                }
                u32x4 w; w.x = pack2(v0[0], v0[1]); w.y = pack2(v0[2], v0[3]); w.z = pack2(v1[0], v1[1]); w.w = pack2(v1[2], v1[3]);
                *(u32x4*)((bf16_t*)(ws + WS_P) + (size_t)row * LD + col) = w;
            }
        }
}
struct G1Order {
    const unsigned char* xb; const unsigned char* wt; int xcd, slot, per;
    __device__ __forceinline__ bool next(int i, pg8::Unit& u) const {
        const int j = slot + i * per; if (j >= 208) return false;
        if (j < 192) { u.pm = j / 3; u.pn = xcd + 8 * (j % 3); } else { const int q = j - 192; u.pm = 8 * xcd + (q >> 1); u.pn = 24 + (q & 1); }
        return true;
    }
    __device__ __forceinline__ void ptrs(const pg8::Unit& u, const char*& A, const char*& B) const {
        const char* x = (const char*)xb + (size_t)u.pm * 256 * 1024 * 2; const char* w = (const char*)wt + (size_t)u.pn * 256 * 1024 * 2;
        if (u.pn >= 21) { A = w; B = x; } else { A = x; B = w; }
    }
};
struct G1Epi {
    unsigned char* ws;
    __device__ __forceinline__ void operator()(const f32x4 (&acc)[2][2][4][2], const pg8::Unit& u, int wr, int wc, int fr, int fq) const {
        const int pn = u.pn, tok0 = u.pm * 256, n0 = pn * 256;
        if (pn >= 21) g1_epi<5>(acc, ws, n0, tok0, wr, wc, fr, fq);
        else if (pn >= 12) g1_epi<4>(acc, ws, tok0, n0, wr, wc, fr, fq);
        else if (pn >= 8) g1_epi<3>(acc, ws, tok0, n0, wr, wc, fr, fq);
        else if (pn >= 6) g1_epi<2>(acc, ws, tok0, n0, wr, wc, fr, fq);
        else if (pn >= 4) g1_epi<1>(acc, ws, tok0, n0, wr, wc, fr, fq);
        else g1_epi<0>(acc, ws, tok0, n0, wr, wc, fr, fq);
    }
};
__device__ void phase_g1(const Params& p, int layer, unsigned char* lds) {
    unsigned char* ws = launder(p.ws);
    G1Order S; S.xb = ws + WS_XB; S.wt = ws + WS_WIN; S.xcd = blockIdx.x & 7; S.slot = blockIdx.x >> 3; S.per = gridDim.x >> 3;
    G1Epi E; E.ws = ws;
    pg8::gemm_phase<G1Epi, G1Order>(lds, 1024, S, E, ltid());
}

__device__ __forceinline__ void load_tile64(const bf16_t* base, size_t rowStride, unsigned char* dst, int wid, int lane) {
    const int c = ((lane & 7) ^ (lane >> 3)) * 8;
#pragma unroll
    for (int i = 0; i < 2; ++i) { const int j = wid + 4 * i, row = 8 * j + (lane >> 3); glds16(base + (size_t)row * rowStride + c, dst + j * 1024); }
}
__device__ __forceinline__ void load_tile128(const bf16_t* base, size_t rowStride, unsigned char* dst, int wid, int lane) {
    const int c = ((lane & 7) ^ (lane >> 3)) * 8;
#pragma unroll
    for (int i = 0; i < 4; ++i) { const int j = wid + 4 * i, row = 8 * j + (lane >> 3); glds16(base + (size_t)row * rowStride + c, dst + j * 1024); }
}
__device__ __forceinline__ void load_tile128w(const bf16_t* base, size_t rowStride, unsigned char* dst, int wid, int lane) {
    const int c = ((lane & 15) ^ ((4 * wid + (lane >> 4)) & 15)) * 8;
#pragma unroll
    for (int i = 0; i < 8; ++i) { const int j = wid + 4 * i, row = 4 * j + (lane >> 4); glds16(base + (size_t)row * rowStride + c, dst + j * 1024); }
}
__device__ __forceinline__ bf16x8 lds_frag128(const unsigned char* tile, int row, int chunk) {
    return *(const bf16x8*)(tile + row * 128 + ((chunk ^ (row & 7)) << 4));
}
__device__ __forceinline__ bf16x8 lds_frag256(const unsigned char* tile, int row, int chunk) {
    return *(const bf16x8*)(tile + row * 256 + ((chunk ^ (row & 15)) << 4));
}
__device__ __forceinline__ bf16x8 lds_vfrag128(const unsigned char* tile, int row, int kbase, int fq) {
    const int ca = (kbase >> 3) + (fq >> 1), hb = (fq & 1) * 8;
    const u32x2 a = *(const u32x2*)(tile + row * 128 + ((ca ^ (row & 7)) << 4) + hb);
    const u32x2 b = *(const u32x2*)(tile + row * 128 + (((ca + 2) ^ (row & 7)) << 4) + hb);
    u32x4 w; w.x = a.x; w.y = a.y; w.z = b.x; w.w = b.y;
    return __builtin_bit_cast(bf16x8, w);
}
__device__ __forceinline__ bf16x8 lds_vfrag256(const unsigned char* tile, int row, int kbase, int fq) {
    const int ca = (kbase >> 3) + (fq >> 1), hb = (fq & 1) * 8;
    const u32x2 a = *(const u32x2*)(tile + row * 256 + ((ca ^ (row & 15)) << 4) + hb);
    const u32x2 b = *(const u32x2*)(tile + row * 256 + (((ca + 2) ^ (row & 15)) << 4) + hb);
    u32x4 w; w.x = a.x; w.y = a.y; w.z = b.x; w.w = b.y;
    return __builtin_bit_cast(bf16x8, w);
}
__device__ __forceinline__ bf16x8 pack8(f32x4 a, f32x4 b) {
    u32x4 w; w.x = pack2(a[0], a[1]); w.y = pack2(a[2], a[3]); w.z = pack2(b[0], b[1]); w.w = pack2(b[2], b[3]);
    return __builtin_bit_cast(bf16x8, w);
}

__device__ __forceinline__ float gelu_tanh(float x) {
    const float u = 0.7978845608028654f * (x + 0.044715f * x * x * x);
    return 0.5f * x * (1.f + tanhf(u));
}
__device__ void compress_item(const Params& p, int layer, int item, unsigned char* lds, int half) {
    unsigned char* ws = launder(p.ws);
    const int tid = (ltid() & 255), lane = tid & 63, wid = tid >> 6, wr = wid >> 1, wc = wid & 1, fr = lane & 15, fq = lane >> 4;
    const int mtile = item & 3, g = (item >> 2) & 1, b = (item >> 3) & 1, kv = item >> 4;
    const int i0 = mtile * 128;
    const bf16_t* P = (const bf16_t*)(ws + WS_P);
    const bf16_t* W1T = (const bf16_t*)(ws + WS_W1T) + (size_t)kv * 64 * 2048;
    const int col = (kv ? C_VC : C_KC) + g * 64;
    const int ldc = ((lane & 7) ^ (lane >> 3)) * 8;
    const bf16_t* ap[4];
#pragma unroll
    for (int i = 0; i < 4; ++i) ap[i] = P + ((size_t)b * S_ + 16 * (i0 + 32 * i + 8 * wid + (lane >> 3))) * LD + col + ldc;
    const bf16_t* bp[2];
#pragma unroll
    for (int i = 0; i < 2; ++i) bp[i] = W1T + (size_t)(8 * (wid + 4 * i) + (lane >> 3)) * 2048 + ldc;
    f32x4 acc[4][2];
#pragma unroll
    for (int i = 0; i < 4; ++i)
#pragma unroll
        for (int j = 0; j < 2; ++j) acc[i][j] = (f32x4){0.f, 0.f, 0.f, 0.f};
    __syncthreads();
#define CSTAGE(buf, l) do { unsigned char* st_ = lds + (buf) * 24576; \
        _Pragma("unroll") for (int i = 0; i < 4; ++i) glds16(ap[i] + (size_t)(l) * LD, st_ + (4 * i + wid) * 1024); \
        _Pragma("unroll") for (int i = 0; i < 2; ++i) glds16(bp[i] + (l) * 64, st_ + 16384 + (wid + 4 * i) * 1024); } while (0)
    CSTAGE(0, 0); wait_vm0(); __syncthreads();
    for (int l = 0; l < 32; ++l) {
        const unsigned char* st = lds + (l & 1) * 24576;
        if (l + 1 < 32) CSTAGE((l + 1) & 1, l + 1);
#pragma unroll
        for (int ks = 0; ks < 2; ++ks) {
            bf16x8 a[4], bb[2];
#pragma unroll
            for (int i = 0; i < 4; ++i) a[i] = lds_frag128(st, 64 * wr + 16 * i + fr, 4 * ks + fq);
#pragma unroll
            for (int j = 0; j < 2; ++j) bb[j] = lds_frag128(st + 16384, 32 * wc + 16 * j + fr, 4 * ks + fq);
#pragma unroll
            for (int i = 0; i < 4; ++i)
#pragma unroll
                for (int j = 0; j < 2; ++j) acc[i][j] = mfma16(a[i], bb[j], acc[i][j]);
        }
        wait_vm0(); __syncthreads();
    }
#undef CSTAGE
    float* hid = (float*)lds;
    const float* b1 = (const float*)(ws + WS_B1) + kv * 64;
#pragma unroll
    for (int j = 0; j < 2; ++j) {
        const int n = 32 * wc + 16 * j + fr; const float bias = b1[n + vzero()];
#pragma unroll
        for (int i = 0; i < 4; ++i)
#pragma unroll
            for (int r = 0; r < 4; ++r) hid[(64 * wr + 16 * i + 4 * fq + r) * 65 + n] = gelu_tanh(acc[i][j][r] + bias);
    }
    __syncthreads();
    {
        const int row = tid >> 1, nb = (tid & 1) * 32, ci = i0 + row;
        const float* w2 = p.cmp_w2 + ((size_t)layer * 2 + kv) * 64 * 64;
        float o[32];
#pragma unroll
        for (int q = 0; q < 32; ++q) o[q] = 0.f;
        for (int n = 0; n < 64; ++n) {
            const float h = hid[row * 65 + n];
#pragma unroll
            for (int q4 = 0; q4 < 8; ++q4) { const float4 w = *(const float4*)(w2 + n * 64 + nb + 4 * q4); o[4 * q4] += h * w.x; o[4 * q4 + 1] += h * w.y; o[4 * q4 + 2] += h * w.z; o[4 * q4 + 3] += h * w.w; }
        }
        if (kv == 0) {
            bf16_t* dst = (bf16_t*)(ws + WS_KCC) + ((size_t)(b * 2 + g) * 512 + ci) * 64 + nb;
#pragma unroll
            for (int q = 0; q < 32; q += 4) { f32x4 v = {o[q], o[q + 1], o[q + 2], o[q + 3]}; if (ci >= 511) v = (f32x4){0.f, 0.f, 0.f, 0.f}; *(u32x2*)(dst + q) = pack4(v); }
        } else {
            bf16_t* dst = (bf16_t*)(ws + WS_VCCT) + ((size_t)(b * 2 + g) * 64 + nb) * 512 + ci;
#pragma unroll
            for (int q = 0; q < 32; ++q) dst[(size_t)q * 512] = f2bf(ci >= 511 ? 0.f : o[q]);
        }
    }
    __syncthreads();
}

__device__ __forceinline__ float ret_lg2(int h) { const float gam = 1.f - exp2f(-5.f - (float)h); return log2f(gam); }

__device__ void retkv_item(const Params& p, int item, unsigned char* lds, int half) {
    unsigned char* ws = launder(p.ws);
    const int tid = (ltid() & 255), lane = tid & 63, wid = tid >> 6, fr = lane & 15, fq = lane >> 4;
    const int n = item & 63, h = (item >> 6) & 7, b = item >> 9;
    const size_t tok0 = (size_t)b * S_ + 128 * n;
    unsigned char* vL = lds; unsigned char* kL = lds + 32768;
    load_tile128w((const bf16_t*)(ws + WS_VRT) + ((size_t)(b * 8 + h) * 128) * S_ + 128 * n, S_, vL, wid, lane);
    load_tile128((const bf16_t*)(ws + WS_P) + tok0 * LD + C_KR + h * 64, LD, kL, wid, lane);
    wait_vm0(); __syncthreads();
    const float lg2 = ret_lg2(h);
    f32x4 acc[2][4];
#pragma unroll
    for (int m = 0; m < 2; ++m)
#pragma unroll
        for (int nt = 0; nt < 4; ++nt) acc[m][nt] = (f32x4){0.f, 0.f, 0.f, 0.f};
#pragma unroll
    for (int ks = 0; ks < 4; ++ks) {
        bf16x8 a[2], bb[4];
#pragma unroll
        for (int m = 0; m < 2; ++m) a[m] = lds_frag256(vL, 32 * wid + 16 * m + fr, 4 * ks + fq);
        float dec[8];
#pragma unroll
        for (int j = 0; j < 8; ++j) dec[j] = exp2f((float)(127 - (32 * ks + 8 * fq + j)) * lg2);
#pragma unroll
        for (int nt = 0; nt < 4; ++nt) {
            const int d = 16 * nt + fr;
            float v[8];
#pragma unroll
            for (int j = 0; j < 8; ++j) {
                const int tk = 32 * ks + 8 * fq + j;
                const bf16_t kvv = *(const bf16_t*)(kL + tk * 128 + (((d >> 3) ^ (tk & 7)) << 4) + (d & 7) * 2);
                v[j] = bf2f(kvv) * dec[j];
            }
            u32x4 w; w.x = pack2(v[0], v[1]); w.y = pack2(v[2], v[3]); w.z = pack2(v[4], v[5]); w.w = pack2(v[6], v[7]);
            bb[nt] = __builtin_bit_cast(bf16x8, w);
        }
#pragma unroll
        for (int m = 0; m < 2; ++m)
#pragma unroll
            for (int nt = 0; nt < 4; ++nt) acc[m][nt] = mfma16(a[m], bb[nt], acc[m][nt]);
    }
    float* KVT = (float*)(ws + WS_KVT) + ((size_t)(b * 8 + h) * 64 + n) * 8192;
#pragma unroll
    for (int m = 0; m < 2; ++m)
#pragma unroll
        for (int nt = 0; nt < 4; ++nt)
#pragma unroll
            for (int r = 0; r < 4; ++r) KVT[(32 * wid + 16 * m + 4 * fq + r) * 64 + 16 * nt + fr] = acc[m][nt][r];
    __syncthreads();
}

__device__ void phase_p2(const Params& p, int layer, unsigned char* lds, int half) {
    for (int it = (blockIdx.x * 2 + half); it < 1024 + 32; it += (gridDim.x * 2)) {
        if (it < 32) compress_item(p, layer, it, lds, half); else retkv_item(p, it - 32, lds, half);
    }
}

constexpr int NSA_IMP = 32768, NSA_BUCKET = 65792, NSA_BIAS = 73984;

struct NsaLane { int t; int fr, fq, wid, lane; };

template <int BR, int PASS>
__device__ __forceinline__ void nsa_half(const unsigned char* kL, const unsigned char* vL, const unsigned char* lds, const bf16_t* qptr,
                                         f32x4 (&O)[4][4], float (&m)[4], float (&l)[4], int tile, int hf, bool selbit, const NsaLane& L, int qrow) {
    const int fr = L.fr, fq = L.fq;
    bf16x8 Kf[2][2];
#pragma unroll
    for (int i = 0; i < 2; ++i)
#pragma unroll
        for (int ks = 0; ks < 2; ++ks) Kf[i][ks] = lds_frag128(kL, 32 * hf + 16 * i + fr, 4 * ks + fq);
    unsigned vmask = 0; unsigned bk[2];
    const unsigned char* bucketL = lds + NSA_BUCKET;
#pragma unroll
    for (int i = 0; i < 2; ++i) {
        unsigned pk = 0;
#pragma unroll
        for (int r = 0; r < 4; ++r) {
            const int kk = 32 * hf + 16 * i + 4 * fq + r;
            int rel; bool ok;
            if (BR == 0) { rel = L.t - (16 * (64 * tile + kk) + 31); ok = rel >= 0; }
            else if (BR == 1) { rel = L.t - (64 * tile + kk); ok = selbit && rel >= 0; }
            else { rel = L.t - (64 * tile + kk); ok = rel >= 0 && rel < 512; }
            int rc = rel < 0 ? 0 : rel; rc = rc > 8191 ? 8191 : rc;
            pk |= (unsigned)bucketL[rc] << (8 * r);
            vmask |= (ok ? 1u : 0u) << (4 * i + r);
        }
        bk[i] = pk;
    }
    const float* biasL = (const float*)(lds + NSA_BIAS);
    float ia[2] = {0.f, 0.f}, ic[2] = {0.f, 0.f};
#pragma unroll
    for (int nt = 0; nt < 4; ++nt) {
        asm volatile("" ::: "memory");
        f32x4 S[2];
        const bf16x8 q0 = *(const bf16x8*)(qptr + nt * 64), q1 = *(const bf16x8*)(qptr + nt * 64 + 32);
#pragma unroll
        for (int i = 0; i < 2; ++i) {
            S[i] = (f32x4){0.f, 0.f, 0.f, 0.f};
            S[i] = mfma16(Kf[i][0], q0, S[i]); S[i] = mfma16(Kf[i][1], q1, S[i]);
        }
        float tmax = -1e30f;
        float bsv[2][4];
#pragma unroll
        for (int i = 0; i < 2; ++i)
#pragma unroll
            for (int r = 0; r < 4; ++r) { bsv[i][r] = biasL[nt * 32 + ((bk[i] >> (8 * r)) & 0xffu)]; asm volatile("" : "+v"(bsv[i][r])); }
#pragma unroll
        for (int i = 0; i < 2; ++i)
#pragma unroll
            for (int r = 0; r < 4; ++r) {
                const bool ok = (vmask >> (4 * i + r)) & 1u;
                const float sv = S[i][r] * 0.125f + bsv[i][r];
                S[i][r] = ok ? sv : -1e30f; tmax = fmaxf(tmax, S[i][r]);
            }
        if (PASS != 1) {
            tmax = rows_max(tmax);
            const float mnew = fmaxf(m[nt], tmax), alpha = __expf(m[nt] - mnew);
            float psum = 0.f;
#pragma unroll
            for (int i = 0; i < 2; ++i)
#pragma unroll
                for (int r = 0; r < 4; ++r) {
                    const bool ok = (vmask >> (4 * i + r)) & 1u;
                    const float pv = ok ? __expf(S[i][r] - mnew) : 0.f;
                    S[i][r] = pv; psum += pv;
                }
            psum = rows_sum(psum);
            l[nt] = l[nt] * alpha + psum; m[nt] = mnew;
            if (PASS == 2) {
#pragma unroll
                for (int mt = 0; mt < 4; ++mt) O[mt][nt] = O[mt][nt] * alpha;
            }
        } else {
#pragma unroll
            for (int i = 0; i < 2; ++i) {
#pragma unroll
                for (int r = 0; r < 4; ++r) {
                    const bool ok = (vmask >> (4 * i + r)) & 1u;
                    S[i][r] = ok ? __expf(S[i][r] - m[nt]) * l[nt] : 0.f;
                }
                ia[i] += S[i][0] + S[i][1] + S[i][2] + 0.5f * S[i][3];
                ic[i] += 0.5f * S[i][3];
            }
        }
        if (PASS != 0) {
            const bf16x8 Pb = pack8(S[0], S[1]);
#pragma unroll
            for (int mt = 0; mt < 4; ++mt) O[mt][nt] = mfma16(lds_vfrag128(vL, 16 * mt + fr, 32 * hf, fq), Pb, O[mt][nt]);
        }
    }
    if (PASS == 1) {
        float* imp = (float*)(lds + NSA_IMP) + qrow * 129;
        asm volatile("" ::: "memory"); __builtin_amdgcn_wave_barrier();
#pragma unroll
        for (int i = 0; i < 2; ++i) { const int j = 16 * tile + 8 * hf + 4 * i + fq; imp[j] += ia[i]; }
        asm volatile("s_waitcnt lgkmcnt(0)" ::: "memory"); __builtin_amdgcn_wave_barrier();
#pragma unroll
        for (int i = 0; i < 2; ++i) { const int j = 16 * tile + 8 * hf + 4 * i + fq + 1; if (j < 128) imp[j] += ic[i]; }
        asm volatile("s_waitcnt lgkmcnt(0)" ::: "memory"); __builtin_amdgcn_wave_barrier();
    }
}
template <int BR, int PASS>
__device__ __forceinline__ void nsa_tile(const unsigned char* kL, const unsigned char* vL, const unsigned char* lds, const bf16_t* qptr,
                                         f32x4 (&O)[4][4], float (&m)[4], float (&l)[4], int tile, bool selbit, const NsaLane& L, int qrow) {
#pragma unroll 1
    for (int hf = 0; hf < 2; ++hf) nsa_half<BR, PASS>(kL, vL, lds, qptr, O, m, l, tile, hf, selbit, L, qrow);
}

__device__ void cmp_item(const Params& p, int item, unsigned char* lds, int half) {
    unsigned char* ws = launder(p.ws);
    const int tid = (ltid() & 255), lane = tid & 63, wid = tid >> 6, fr = lane & 15, fq = lane >> 4;
    const int combo = item & 3, qt = 127 - (item >> 2), b = combo >> 1, g = combo & 1;
    const int q0 = qt * 64, qrow = 16 * wid + fr;
    NsaLane L; L.t = q0 + qrow; L.fr = fr; L.fq = fq; L.wid = wid; L.lane = lane;
    const size_t tok = (size_t)b * S_ + L.t;
    const bf16_t* P = (const bf16_t*)(ws + WS_P);
    __syncthreads();
    if (tid < 128) ((float*)(lds + NSA_BIAS))[tid] = p.rel_bias[(tid & 31) * 8 + 4 * g + (tid >> 5)];
    for (int i = tid; i < 64 * 129; i += HT) ((float*)(lds + NSA_IMP))[i] = 0.f;
    const bf16_t* Qf = P + tok * LD + C_QA + (4 * g) * 64 + 8 * fq;
    __syncthreads();
    f32x4 O[4][4]; float m[4], l[4];
    const bf16_t* gates = P + tok * LD + C_GA + (4 * g) * 3;
    const bf16_t* kc = (const bf16_t*)(ws + WS_KCC) + (size_t)(b * 2 + g) * 512 * 64;
    const bf16_t* vc = (const bf16_t*)(ws + WS_VCCT) + (size_t)(b * 2 + g) * 64 * 512;
    const int ntc = ((q0 + 32) >> 4) / 64 + 1;
#pragma unroll
    for (int nt = 0; nt < 4; ++nt) { m[nt] = -1e30f; l[nt] = 0.f; }
    load_tile64(kc, 64, lds, wid, lane);
    wait_vm0(); __syncthreads();
    for (int it = 0; it < ntc; ++it) {
        unsigned char* cur = lds + (it & 1) * 16384;
        if (it + 1 < ntc) load_tile64(kc + (size_t)(it + 1) * 64 * 64, 64, lds + ((it + 1) & 1) * 16384, wid, lane);
        nsa_tile<0, 0>(cur, cur + 8192, lds, Qf, O, m, l, it, true, L, qrow);
        wait_vm0(); __syncthreads();
    }
#pragma unroll
    for (int nt = 0; nt < 4; ++nt) l[nt] = l[nt] > 0.f ? 1.f / l[nt] : 0.f;
#pragma unroll
    for (int mt = 0; mt < 4; ++mt)
#pragma unroll
        for (int nt = 0; nt < 4; ++nt) O[mt][nt] = (f32x4){0.f, 0.f, 0.f, 0.f};
    load_tile64(kc, 64, lds, wid, lane); load_tile64(vc, 512, lds + 8192, wid, lane);
    wait_vm0(); __syncthreads();
    for (int it = 0; it < ntc; ++it) {
        unsigned char* cur = lds + (it & 1) * 16384;
        if (it + 1 < ntc) { unsigned char* nx = lds + ((it + 1) & 1) * 16384;
            load_tile64(kc + (size_t)(it + 1) * 64 * 64, 64, nx, wid, lane); load_tile64(vc + (it + 1) * 64, 512, nx + 8192, wid, lane); }
        nsa_tile<0, 1>(cur, cur + 8192, lds, Qf, O, m, l, it, true, L, qrow);
        wait_vm0(); __syncthreads();
    }
    bf16_t* YC = (bf16_t*)(ws + WS_YC) + tok * 512 + (4 * g) * 64;
#pragma unroll
    for (int nt = 0; nt < 4; ++nt) {
        const float gt = bf2f(gates[nt * 3 + 0]);
#pragma unroll
        for (int mt = 0; mt < 4; ++mt) *(u32x2*)(YC + nt * 64 + 16 * mt + 4 * fq) = pack4(O[mt][nt] * gt);
    }
    const int cur = qt;
    {
        float* imp = (float*)(lds + NSA_IMP) + qrow * 129 + 32 * fq;
        asm volatile("s_waitcnt lgkmcnt(0)" ::: "memory"); __builtin_amdgcn_wave_barrier();
#pragma unroll
        for (int i = 0; i < 32; ++i) {
            const int j = 32 * fq + i;
            const float v = imp[i];
            imp[i] = j > cur ? -1.f : v + ((j == 0 || j == cur || j == cur - 1) ? 1.0e4f : 0.f);
        }
        unsigned word = 0;
#pragma unroll 1
        for (int round = 0; round < 16; ++round) {
            float bv = imp[0]; int bi = 0;
#pragma unroll
            for (int i = 1; i < 32; ++i) { const float v = imp[i]; if (v > bv) { bv = v; bi = i; } }
            int gi = 32 * fq + bi;
#pragma unroll
            for (int off = 16; off <= 32; off <<= 1) {
                const float ov = __shfl_xor(bv, off); const int oi = __shfl_xor(gi, off);
                if (ov > bv || (ov == bv && oi < gi)) { bv = ov; gi = oi; }
            }
            if (bv >= 0.f && (gi >> 5) == fq) { word |= 1u << (gi & 31); imp[gi & 31] = -2.f; }
        }
        ((unsigned*)(ws + WS_SELW))[(tok * 2 + g) * 4 + fq] = word;
    }
}

__device__ void win_item(const Params& p, int item, unsigned char* lds, int half) {
    unsigned char* ws = launder(p.ws);
    const int tid = (ltid() & 255), lane = tid & 63, wid = tid >> 6, fr = lane & 15, fq = lane >> 4;
    const int combo = item & 3, qt = 127 - (item >> 2), b = combo >> 1, g = combo & 1;
    const int q0 = qt * 64, qrow = 16 * wid + fr;
    NsaLane L; L.t = q0 + qrow; L.fr = fr; L.fq = fq; L.wid = wid; L.lane = lane;
    const size_t tok = (size_t)b * S_ + L.t;
    const bf16_t* P = (const bf16_t*)(ws + WS_P);
    __syncthreads();
    if (tid < 128) ((float*)(lds + NSA_BIAS))[tid] = p.rel_bias[(tid & 31) * 8 + 4 * g + (tid >> 5)];
    const bf16_t* Qf = P + tok * LD + C_QA + (4 * g) * 64 + 8 * fq;
    __syncthreads();
    f32x4 O[4][4]; float m[4], l[4];
    const bf16_t* gates = P + tok * LD + C_GA + (4 * g) * 3;
#pragma unroll
    for (int nt = 0; nt < 4; ++nt) { m[nt] = -1e30f; l[nt] = 0.f; }
#pragma unroll
    for (int mt = 0; mt < 4; ++mt)
#pragma unroll
        for (int nt = 0; nt < 4; ++nt) O[mt][nt] = (f32x4){0.f, 0.f, 0.f, 0.f};
    {
        const bf16_t* kb = P + ((size_t)b * S_) * LD + C_KW + g * 64;
        const bf16_t* vb = (const bf16_t*)(ws + WS_VWT) + (size_t)(b * 2 + g) * 64 * S_;
        const int k_lo = qt - 8 > 0 ? qt - 8 : 0, ntw = qt - k_lo + 1;
        load_tile64(kb + (size_t)k_lo * 64 * LD, LD, lds, wid, lane); load_tile64(vb + k_lo * 64, S_, lds + 8192, wid, lane);
        wait_vm0(); __syncthreads();
        for (int it = 0; it < ntw; ++it) {
            unsigned char* cu = lds + (it & 1) * 16384;
            if (it + 1 < ntw) { unsigned char* nx = lds + ((it + 1) & 1) * 16384;
                load_tile64(kb + (size_t)(k_lo + it + 1) * 64 * LD, LD, nx, wid, lane); load_tile64(vb + (k_lo + it + 1) * 64, S_, nx + 8192, wid, lane); }
            nsa_tile<2, 2>(cu, cu + 8192, lds, Qf, O, m, l, k_lo + it, true, L, qrow);
            wait_vm0(); __syncthreads();
        }
    }
    bf16_t* YW = (bf16_t*)(ws + WS_YW) + tok * 512 + (4 * g) * 64;
#pragma unroll
    for (int nt = 0; nt < 4; ++nt) {
        const float gt = bf2f(gates[nt * 3 + 2]) * (l[nt] > 0.f ? 1.f / l[nt] : 0.f);
#pragma unroll
        for (int mt = 0; mt < 4; ++mt) *(u32x2*)(YW + nt * 64 + 16 * mt + 4 * fq) = pack4(O[mt][nt] * gt);
    }
}

constexpr int SEL_BIAS2 = NSA_BIAS;
constexpr float LOG2E = 1.4426950408889634f;
__device__ __forceinline__ int t5_first(int bk) {
    const int th[16] = {16, 22, 30, 40, 54, 73, 99, 134, 182, 246, 332, 450, 609, 825, 1117, 1513};
    int r = 16;
#pragma unroll
    for (int k = 0; k < 16; ++k) r = (bk == 16 + k) ? th[k] : r;
    return r;
}
template <bool FAST>
__device__ __forceinline__ void sel_ntile(const bf16x8 (&Kf)[4][2], const bf16x8 (&Vf)[4][2], const bf16x8& q0, const bf16x8& q1, f32x4 (&O)[4], float& m, float& l,
                                          bool sb, int relb, int th, float blo, float bhi, const unsigned char* lds, int hl) {
    f32x4 S[4];
#pragma unroll
    for (int i = 0; i < 4; ++i) { S[i] = (f32x4){0.f, 0.f, 0.f, 0.f}; S[i] = mfma16(Kf[i][0], q0, S[i]); S[i] = mfma16(Kf[i][1], q1, S[i]); }
    float tmax = -1e30f;
    const float scl = (!FAST || sb) ? 0.125f * LOG2E : 0.f;
    if (FAST) { blo = (sb ? blo : -1e30f) - m; bhi = (sb ? bhi : -1e30f) - m; }
    if (FAST) {
#pragma unroll
        for (int i = 0; i < 4; ++i)
#pragma unroll
            for (int r = 0; r < 4; ++r) { const int rel = relb - (16 * i + r); S[i][r] = S[i][r] * scl + (rel >= th ? bhi : blo); tmax = fmaxf(tmax, S[i][r]); }
    } else {
        unsigned bkt[4][4]; float bs[4][4];
#pragma unroll
        for (int i = 0; i < 4; ++i)
#pragma unroll
            for (int r = 0; r < 4; ++r) { const int rel = relb - (16 * i + r); int rc = rel < 0 ? 0 : rel; rc = rc > 8191 ? 8191 : rc; bkt[i][r] = (lds + NSA_BUCKET)[rc]; }
#pragma unroll
        for (int i = 0; i < 4; ++i)
#pragma unroll
            for (int r = 0; r < 4; ++r) { bs[i][r] = ((const float*)(lds + SEL_BIAS2))[hl * 32 + bkt[i][r]]; asm volatile("" : "+v"(bs[i][r])); }
        const float ninf = -1e30f;
#pragma unroll
        for (int i = 0; i < 4; ++i)
#pragma unroll
            for (int r = 0; r < 4; ++r) {
                const int rel = relb - (16 * i + r);
                const float sv = S[i][r] * (0.125f * LOG2E) + (bs[i][r] - m);
                S[i][r] = (sb && rel >= 0) ? sv : ninf; tmax = fmaxf(tmax, S[i][r]);
            }
    }
    tmax = rows_max(tmax);
    if (__ballot(tmax > 8.f) != 0ull) {
        const float d = fmaxf(tmax, 0.f), alpha = __builtin_amdgcn_exp2f(-d);
        m += d; l *= alpha;
#pragma unroll
        for (int mt = 0; mt < 4; ++mt) O[mt] = O[mt] * alpha;
#pragma unroll
        for (int i = 0; i < 4; ++i)
#pragma unroll
            for (int r = 0; r < 4; ++r) S[i][r] -= d;
    }
    float psum = 0.f;
#pragma unroll
    for (int i = 0; i < 4; ++i)
#pragma unroll
        for (int r = 0; r < 4; ++r) { const float pv = __builtin_amdgcn_exp2f(S[i][r]); S[i][r] = pv; psum += pv; }
    l += rows_sum(psum);
    const bf16x8 Pb0 = pack8(S[0], S[1]), Pb1 = pack8(S[2], S[3]);
#pragma unroll
    for (int mt = 0; mt < 4; ++mt) { O[mt] = mfma16(Vf[mt][0], Pb0, O[mt]); O[mt] = mfma16(Vf[mt][1], Pb1, O[mt]); }
}
template <bool FAST>
__device__ __forceinline__ void sel_tile(const unsigned char* kL, const unsigned char* vL, const unsigned char* lds, const bf16x8 (&Qf)[2][2], f32x4 (&O)[2][4], float (&m)[2], float (&l)[2],
                                         const bool (&sb)[2], const bool (&need)[2], const int (&relb)[2], int th, float blo, float bhi, int hl, int fr, int fq) {
    bf16x8 Kf[4][2], Vf[4][2];
#pragma unroll
    for (int i = 0; i < 4; ++i)
#pragma unroll
        for (int ks = 0; ks < 2; ++ks) Kf[i][ks] = lds_frag128(kL, 16 * i + fr, 4 * ks + fq);
#pragma unroll
    for (int mt = 0; mt < 4; ++mt)
#pragma unroll
        for (int hf = 0; hf < 2; ++hf) Vf[mt][hf] = lds_vfrag128(vL, 16 * mt + fr, 32 * hf, fq);
    if (need[0]) sel_ntile<FAST>(Kf, Vf, Qf[0][0], Qf[0][1], O[0], m[0], l[0], sb[0], relb[0], th, blo, bhi, lds, hl);
    if (need[1]) sel_ntile<FAST>(Kf, Vf, Qf[1][0], Qf[1][1], O[1], m[1], l[1], sb[1], relb[1], th, blo, bhi, lds, hl);
}
template <int VAR>
__device__ void sel_item(const Params& p, int v, unsigned char* lds, int half) {
    unsigned char* ws = launder(p.ws);
    const int tid = (ltid() & 255), lane = tid & 63, wid = tid >> 6, fr = lane & 15, fq = lane >> 4;
    const int qt = 127 - (v >> 3), sub = v & 7, b = sub >> 2, g = (sub >> 1) & 1, qh = sub & 1;
    const int q0 = qt * 64 + 32 * qh, cur = qt, hl = fr & 3;
    const bf16_t* P = (const bf16_t*)(ws + WS_P);
    __syncthreads();
    if (tid < 128) ((float*)(lds + SEL_BIAS2))[tid] = p.rel_bias[(tid & 31) * 8 + 4 * g + (tid >> 5)] * LOG2E;
    int t[2]; size_t tok[2]; bf16x8 Qf[2][2]; unsigned selw[2][4];
#pragma unroll
    for (int nt = 0; nt < 2; ++nt) {
        t[nt] = q0 + 8 * wid + 4 * nt + (fr >> 2); tok[nt] = (size_t)b * S_ + t[nt];
#pragma unroll
        for (int ks = 0; ks < 2; ++ks) Qf[nt][ks] = *(const bf16x8*)(P + tok[nt] * LD + C_QA + (4 * g + hl) * 64 + 32 * ks + 8 * fq);
        const u32x4 w = *(const u32x4*)((const unsigned*)(ws + WS_SELW) + (tok[nt] * 2 + g) * 4);
        selw[nt][0] = w.x; selw[nt][1] = w.y; selw[nt][2] = w.z; selw[nt][3] = w.w;
    }
    f32x4 O[2][4]; float m[2], l[2];
#pragma unroll
    for (int nt = 0; nt < 2; ++nt) { m[nt] = -1000.f; l[nt] = 0.f;
#pragma unroll
        for (int mt = 0; mt < 4; ++mt) O[nt][mt] = (f32x4){0.f, 0.f, 0.f, 0.f}; }
    const bf16_t* kb = P + ((size_t)b * S_) * LD + C_KS + g * 64;
    const bf16_t* vb = (const bf16_t*)(ws + WS_VST) + (size_t)(b * 2 + g) * 64 * S_;
    const int nts = cur + 1;
#define SEL_ISSUE(jj) do { unsigned char* st_ = lds + ((jj) & 3) * 16384; load_tile64(kb + (size_t)(jj) * 64 * LD, LD, st_, wid, lane); load_tile64(vb + (jj) * 64, S_, st_ + 8192, wid, lane); } while (0)
    asm volatile("s_waitcnt vmcnt(0)" ::: "memory");
    SEL_ISSUE(0); if (nts > 1) SEL_ISSUE(1); if (nts > 2) SEL_ISSUE(2);
    const unsigned char* bucketL = lds + NSA_BUCKET;
    for (int j = 0; j < nts; ++j) {
        const unsigned char* cu = lds + (j & 3) * 16384;
        if (j + 2 < nts) WAIT_V(8); else if (j + 1 < nts) WAIT_V(4); else WAIT_V(0);
        RAW_BARRIER();
        if (j + 3 < nts) SEL_ISSUE(j + 3);
        bool sb[2], need[2]; int relb[2];
#pragma unroll
        for (int nt = 0; nt < 2; ++nt) {
            const unsigned w = j < 32 ? selw[nt][0] : j < 64 ? selw[nt][1] : j < 96 ? selw[nt][2] : selw[nt][3];
            sb[nt] = (w >> (j & 31)) & 1u; need[nt] = __ballot(sb[nt]) != 0ull; relb[nt] = t[nt] - 64 * j - 4 * fq;
        }
        if (VAR == 1) { need[0] = false; need[1] = false; }
        if (VAR == 2) { if (!(need[0] || need[1])) { need[0] = false; } else { need[0] = true; need[1] = true; } }
        if (need[0] || need[1]) {
            const int rmin = q0 - 64 * j - 63, rmax = q0 + 31 - 64 * j;
            bool fast = false; int th = 0; float blo = 0.f, bhi = 0.f;
            if (rmin >= 16) {
                const int b0 = bucketL[rmin], b1 = bucketL[rmax > 8191 ? 8191 : rmax];
                if (b1 - b0 <= 1) { fast = true; th = t5_first(b1); if (b1 == b0) th = 0;
                    blo = ((const float*)(lds + SEL_BIAS2))[hl * 32 + b0]; bhi = ((const float*)(lds + SEL_BIAS2))[hl * 32 + b1]; }
            }
            if (fast) sel_tile<true>(cu, cu + 8192, lds, Qf, O, m, l, sb, need, relb, th, blo, bhi, hl, fr, fq);
            else sel_tile<false>(cu, cu + 8192, lds, Qf, O, m, l, sb, need, relb, th, blo, bhi, hl, fr, fq);
        }
    }
#undef SEL_ISSUE
    __syncthreads();
#pragma unroll
    for (int nt = 0; nt < 2; ++nt) {
        const float gt = bf2f(P[tok[nt] * LD + C_GA + (4 * g + hl) * 3 + 1]) * (l[nt] > 0.f ? 1.f / l[nt] : 0.f);
        const size_t o = tok[nt] * 512 + (4 * g + hl) * 64;
#pragma unroll
        for (int mt = 0; mt < 4; ++mt) {
            const f32x4 yc = unpack4(*(const u32x2*)((const bf16_t*)(ws + WS_YC) + o + 16 * mt + 4 * fq));
            const f32x4 yw = unpack4(*(const u32x2*)((const bf16_t*)(ws + WS_YW) + o + 16 * mt + 4 * fq));
            if (VAR == 0 || VAR == 3) *(u32x2*)((bf16_t*)(ws + WS_YA) + o + 16 * mt + 4 * fq) = pack4(yc + yw + O[nt][mt] * gt);
            else asm volatile("" :: "v"(O[nt][mt]));
        }
    }
}

__device__ void scan_item(const Params& p, int item, int half) {
    unsigned char* ws = launder(p.ws);
    const int idx = item * HT + (ltid() & 255);
    const int bh = idx >> 13, ed = idx & 8191, h = bh & 7;
    const float dec = exp2f(128.f * ret_lg2(h));
    const float* KVT = (const float*)(ws + WS_KVT) + (size_t)bh * 64 * 8192 + ed;
    bf16_t* SPT = (bf16_t*)(ws + WS_SPT) + (size_t)bh * 64 * 8192 + ed;
    float s = 0.f;
    for (int n = 0; n < 64; ++n) { SPT[(size_t)n * 8192] = f2bf(s); s = s * dec + KVT[(size_t)n * 8192]; }
}

__device__ void phase_p3(const Params& p, unsigned char* lds, int half) {
    for (int i = (ltid() & 255); i < 8192 / 16; i += HT) ((u32x4*)(lds + NSA_BUCKET))[i] = ((const u32x4*)(launder(p.ws) + WS_BUCKET))[i];
    __syncthreads();
    for (int it = (blockIdx.x * 2 + half); it < 1536; it += (gridDim.x * 2)) {
        if (it < 512) cmp_item(p, it, lds, half); else if (it < 1024) win_item(p, it - 512, lds, half); else scan_item(p, it - 1024, half);
    }
}

__device__ void retout_item(const Params& p, int item, unsigned char* lds, int half) {
    unsigned char* ws = launder(p.ws);
    const int tid = (ltid() & 255), lane = tid & 63, wid = tid >> 6, fr = lane & 15, fq = lane >> 4;
    const int n = item & 63, h = (item >> 6) & 7, b = item >> 9;
    const size_t tok0 = (size_t)b * S_ + 128 * n;
    const bf16_t* P = (const bf16_t*)(ws + WS_P);
    unsigned char* vL = lds; unsigned char* kL = lds + 32768; unsigned char* sL = lds + 49152;
    __syncthreads();
    load_tile128w((const bf16_t*)(ws + WS_VRT) + ((size_t)(b * 8 + h) * 128) * S_ + 128 * n, S_, vL, wid, lane);
    load_tile128(P + tok0 * LD + C_KR + h * 64, LD, kL, wid, lane);
    load_tile128((const bf16_t*)(ws + WS_SPT) + ((size_t)(b * 8 + h) * 64 + n) * 8192, 64, sL, wid, lane);
    bf16x8 Qf[2][2];
#pragma unroll
    for (int nt = 0; nt < 2; ++nt)
#pragma unroll
        for (int ks = 0; ks < 2; ++ks) Qf[nt][ks] = *(const bf16x8*)(P + (tok0 + 32 * wid + 16 * nt + fr) * LD + C_QR + h * 64 + 32 * ks + 8 * fq);
    wait_vm0(); __syncthreads();
    const float lg2 = ret_lg2(h);
    f32x4 Y[8][2];
#pragma unroll
    for (int m = 0; m < 8; ++m)
#pragma unroll
        for (int nt = 0; nt < 2; ++nt) Y[m][nt] = (f32x4){0.f, 0.f, 0.f, 0.f};
#pragma unroll
    for (int m = 0; m < 8; ++m)
#pragma unroll
        for (int ks = 0; ks < 2; ++ks) {
            const bf16x8 a = lds_frag128(sL, 16 * m + fr, 4 * ks + fq);
#pragma unroll
            for (int nt = 0; nt < 2; ++nt) Y[m][nt] = mfma16(a, Qf[nt][ks], Y[m][nt]);
        }
#pragma unroll
    for (int nt = 0; nt < 2; ++nt) {
        const float sc = exp2f((float)(32 * wid + 16 * nt + fr + 1) * lg2);
#pragma unroll
        for (int m = 0; m < 8; ++m) Y[m][nt] = Y[m][nt] * sc;
    }
#pragma unroll 1
    for (int s = 0; s < 4; ++s) {
        f32x4 St[2][2];
#pragma unroll
        for (int hh = 0; hh < 2; ++hh) {
            const int mt = 2 * s + hh;
#pragma unroll
            for (int nt = 0; nt < 2; ++nt) St[hh][nt] = (f32x4){0.f, 0.f, 0.f, 0.f};
#pragma unroll
            for (int ks = 0; ks < 2; ++ks) {
                const bf16x8 a = lds_frag128(kL, 16 * mt + fr, 4 * ks + fq);
#pragma unroll
                for (int nt = 0; nt < 2; ++nt) St[hh][nt] = mfma16(a, Qf[nt][ks], St[hh][nt]);
            }
#pragma unroll
            for (int nt = 0; nt < 2; ++nt) {
                const int qi = 32 * wid + 16 * nt + fr;
#pragma unroll
                for (int r = 0; r < 4; ++r) {
                    const int kj = 16 * mt + 4 * fq + r;
                    const float dm = qi >= kj ? exp2f((float)(qi - kj) * lg2) : 0.f;
                    St[hh][nt][r] *= dm;
                }
            }
        }
        bf16x8 Pb[2];
#pragma unroll
        for (int nt = 0; nt < 2; ++nt) Pb[nt] = pack8(St[0][nt], St[1][nt]);
#pragma unroll
        for (int m = 0; m < 8; ++m) {
            const bf16x8 a = lds_vfrag256(vL, 16 * m + fr, 32 * s, fq);
#pragma unroll
            for (int nt = 0; nt < 2; ++nt) Y[m][nt] = mfma16(a, Pb[nt], Y[m][nt]);
        }
    }
    bf16_t* YB = (bf16_t*)(ws + WS_YB);
#pragma unroll
    for (int nt = 0; nt < 2; ++nt) {
        float sum = 0.f;
#pragma unroll
        for (int m = 0; m < 8; ++m) sum += Y[m][nt][0] + Y[m][nt][1] + Y[m][nt][2] + Y[m][nt][3];
        sum = rows_sum(sum);
        const float mu = sum * (1.f / 128.f);
        float vs = 0.f;
#pragma unroll
        for (int m = 0; m < 8; ++m)
#pragma unroll
            for (int r = 0; r < 4; ++r) { const float dlt = Y[m][nt][r] - mu; vs += dlt * dlt; }
        vs = rows_sum(vs);
        const float rstd = rsqrtf(vs * (1.f / 128.f) + 1e-5f);
        const size_t tk = tok0 + 32 * wid + 16 * nt + fr;
#pragma unroll
        for (int m = 0; m < 8; ++m) {
            const f32x4 gt = unpack4(*(const u32x2*)(P + tk * LD + C_GR + h * 128 + 16 * m + 4 * fq));
            f32x4 v;
#pragma unroll
            for (int r = 0; r < 4; ++r) v[r] = (Y[m][nt][r] - mu) * rstd * gt[r];
            *(u32x2*)(YB + tk * 1024 + h * 128 + 16 * m + 4 * fq) = pack4(v);
        }
    }
}
__device__ void phase_p4(const Params& p, unsigned char* lds, int half) {
    for (int i = (ltid() & 255); i < 8192 / 16; i += HT) ((u32x4*)(lds + NSA_BUCKET))[i] = ((const u32x4*)(launder(p.ws) + WS_BUCKET))[i];
    __syncthreads();
    for (int it = (blockIdx.x * 2 + half); it < 2048; it += (gridDim.x * 2)) {
        if (it < 1024) sel_item<0>(p, it < 512 ? it : 1535 - it, lds, half); else retout_item(p, it - 1024, lds, half);
    }
#ifdef EXTRA_SEL
    __syncthreads();
    for (int it = (blockIdx.x * 2 + half); it < 1024; it += (gridDim.x * 2)) {
        sel_item<EXTRA_SEL>(p, it < 512 ? it : 1535 - it, lds, half);
    }
#endif
}

struct RowOrder {
    const unsigned char* a; const unsigned char* b; int K, xcd, slot, per;
    __device__ __forceinline__ bool next(int i, pg8::Unit& u) const { const int t = xcd * 32 + slot + i * per; if (t >= (xcd + 1) * 32) return false; u.pm = t >> 2; u.pn = t & 3; return true; }
    __device__ __forceinline__ void ptrs(const pg8::Unit& u, const char*& A, const char*& B) const { A = (const char*)a + (size_t)u.pm * 256 * K * 2; B = (const char*)b + (size_t)u.pn * 256 * K * 2; }
};
template <int MODE>
struct MixEpi {
    unsigned char* ws; const float* X;
    __device__ __forceinline__ void operator()(const f32x4 (&acc)[2][2][4][2], const pg8::Unit& u, int wr, int wc, int fr, int fq) const {
#pragma unroll
        for (int ai = 0; ai < 2; ++ai)
#pragma unroll
            for (int m = 0; m < 4; ++m) {
                const size_t tok = (size_t)(u.pm * 256 + 128 * ai + 64 * wr + 16 * m + fr + vzero());
#pragma unroll
                for (int bj = 0; bj < 2; ++bj) {
                    const int n = u.pn * 256 + 128 * bj + 32 * wc + 8 * fq;
                    const f32x4 v0 = acc[ai][bj][m][0], v1 = acc[ai][bj][m][1];
                    if (MODE == 2) {
                        const f32x4 x0 = *(const f32x4*)(X + tok * 1024 + n), x1 = *(const f32x4*)(X + tok * 1024 + n + 4);
                        float* H1 = (float*)(ws + WS_H1);
                        *(f32x4*)(H1 + tok * 1024 + n) = x0 * DN_ALPHA + v0; *(f32x4*)(H1 + tok * 1024 + n + 4) = x1 * DN_ALPHA + v1;
                    } else {
                        const u32x4 gw = *(const u32x4*)((const bf16_t*)(ws + WS_P) + tok * LD + (MODE == 0 ? C_MA : C_MB) + n);
                        const f32x4 g0 = unpack4((u32x2){gw.x, gw.y}), g1 = unpack4((u32x2){gw.z, gw.w});
                        f32x4 o0 = g0 * v0, o1 = g1 * v1;
                        bf16_t* MG = (bf16_t*)(ws + WS_MG) + tok * 1024 + n;
                        if (MODE == 1) { const u32x4 pw = *(const u32x4*)MG; o0 = o0 + unpack4((u32x2){pw.x, pw.y}); o1 = o1 + unpack4((u32x2){pw.z, pw.w}); }
                        u32x4 w; w.x = pack2(o0[0], o0[1]); w.y = pack2(o0[2], o0[3]); w.z = pack2(o1[0], o1[1]); w.w = pack2(o1[2], o1[3]);
                        *(u32x4*)MG = w;
                    }
                }
            }
    }
};
__device__ void phase_g2(const Params& p, unsigned char* lds) {
    unsigned char* ws = launder(p.ws);
    RowOrder S; S.xcd = blockIdx.x & 7; S.slot = blockIdx.x >> 3; S.per = gridDim.x >> 3;
    { S.a = ws + WS_YA; S.b = ws + WS_WA; S.K = 512; MixEpi<0> E; E.ws = ws; E.X = nullptr; pg8::gemm_phase<MixEpi<0>, RowOrder>(lds, 512, S, E, ltid()); }
    { S.a = ws + WS_YB; S.b = ws + WS_WB; S.K = 1024; MixEpi<1> E; E.ws = ws; E.X = nullptr; pg8::gemm_phase<MixEpi<1>, RowOrder>(lds, 1024, S, E, ltid()); }
}
__device__ void phase_g3(const Params& p, int layer, unsigned char* lds) {
    unsigned char* ws = launder(p.ws);
    RowOrder S; S.xcd = blockIdx.x & 7; S.slot = blockIdx.x >> 3; S.per = gridDim.x >> 3; S.a = ws + WS_MG; S.b = ws + WS_WO; S.K = 1024;
    MixEpi<2> E; E.ws = ws; E.X = layer == 0 ? p.x : (const float*)(ws + WS_X);
    pg8::gemm_phase<MixEpi<2>, RowOrder>(lds, 1024, S, E, ltid());
}

__device__ void phase_ln1(const Params& p, int layer, unsigned char* lds, bool dry, int half) {
    unsigned char* ws = launder(p.ws);
    const int tid = (ltid() & 255), lane = tid & 63, wid = tid >> 6;
    float* wrL = (float*)lds;
    {
        float4 wv[16];
#pragma unroll
        for (int k = 0; k < 16; ++k) wv[k] = ((const float4*)p.w_router)[tid + 256 * k];
#pragma unroll
        for (int k = 0; k < 16; ++k) { const int i4 = tid + 256 * k, d = i4 >> 2, e0 = (i4 & 3) * 4;
            wrL[(e0 + 0) * 1024 + d] = wv[k].x; wrL[(e0 + 1) * 1024 + d] = wv[k].y; wrL[(e0 + 2) * 1024 + d] = wv[k].z; wrL[(e0 + 3) * 1024 + d] = wv[k].w; }
    }
    __syncthreads();
    const float* H1 = (const float*)(ws + WS_H1);
    float* X1 = (float*)(ws + WS_X1); bf16_t* X1B = (bf16_t*)(ws + WS_X1B);
    const float* gam = p.ln1_g + layer * 1024; const float* bet = p.ln1_b + layer * 1024;
    unsigned* cnt = (unsigned*)(ws + WS_CTL) + (dry ? 0 : CW_CNT) + layer * 1024;
    int* LIST = (int*)(ws + (dry ? WS_HB : WS_LIST)); float* WTS = (float*)(ws + (dry ? WS_HB + 4194304 : WS_WTS));
    for (int tok = (blockIdx.x * 2 + half) * 4 + wid; tok < T_; tok += (gridDim.x * 2) * 4) {
        float4 v[4];
#pragma unroll
        for (int j = 0; j < 4; ++j) v[j] = *(const float4*)(H1 + (size_t)tok * 1024 + 256 * j + 4 * lane);
        float s = 0.f;
#pragma unroll
        for (int j = 0; j < 4; ++j) s += v[j].x + v[j].y + v[j].z + v[j].w;
#pragma unroll
        for (int o = 1; o < 64; o <<= 1) s += __shfl_xor(s, o);
        const float mu = s * (1.f / 1024.f);
        float q = 0.f;
#pragma unroll
        for (int j = 0; j < 4; ++j) { const float a = v[j].x - mu, b2 = v[j].y - mu, c = v[j].z - mu, d = v[j].w - mu; q += a * a + b2 * b2 + c * c + d * d; }
#pragma unroll
        for (int o = 1; o < 64; o <<= 1) q += __shfl_xor(q, o);
        const float rstd = rsqrtf(q * (1.f / 1024.f) + 1e-5f);
        float4 y[4];
#pragma unroll
        for (int j = 0; j < 4; ++j) {
            const int d0 = 256 * j + 4 * lane;
            const float4 gg = *(const float4*)(gam + d0), bb = *(const float4*)(bet + d0);
            y[j].x = (v[j].x - mu) * rstd * gg.x + bb.x; y[j].y = (v[j].y - mu) * rstd * gg.y + bb.y; y[j].z = (v[j].z - mu) * rstd * gg.z + bb.z; y[j].w = (v[j].w - mu) * rstd * gg.w + bb.w;
            *(float4*)(X1 + (size_t)tok * 1024 + d0) = y[j];
            u32x2 w; w.x = pack2(y[j].x, y[j].y); w.y = pack2(y[j].z, y[j].w);
            *(u32x2*)(X1B + (size_t)tok * 1024 + d0) = w;
        }
        float lg[16];
#pragma unroll
        for (int e = 0; e < 16; ++e) {
            float a = 0.f;
#pragma unroll
            for (int j = 0; j < 4; ++j) { const float4 w4 = *(const float4*)(wrL + e * 1024 + 256 * j + 4 * lane); a += y[j].x * w4.x + y[j].y * w4.y + y[j].z * w4.z + y[j].w * w4.w; }
            lg[e] = a;
        }
#pragma unroll
        for (int e = 0; e < 16; ++e) {
#pragma unroll
            for (int o = 1; o < 64; o <<= 1) lg[e] += __shfl_xor(lg[e], o);
        }
        float mx = lg[0];
#pragma unroll
        for (int e = 1; e < 16; ++e) mx = fmaxf(mx, lg[e]);
        float pr[16], ps = 0.f;
#pragma unroll
        for (int e = 0; e < 16; ++e) { pr[e] = expf(lg[e] - mx); ps += pr[e]; }
        const float ips = 1.f / ps;
        float sel[16];
#pragma unroll
        for (int e = 0; e < 16; ++e) { pr[e] *= ips; sel[e] = pr[e] + p.router_bias[e]; }
        int best = 0; float bestv = -1e30f;
#pragma unroll
        for (int gI = 0; gI < 4; ++gI) {
            float a = -1e30f, b2 = -1e30f;
#pragma unroll
            for (int k = 0; k < 4; ++k) { const float x = sel[4 * gI + k]; if (x > a) { b2 = a; a = x; } else if (x > b2) b2 = x; }
            const float gs = a + b2;
            if (gs > bestv) { bestv = gs; best = gI; }
        }
        float s4[4], p4[4];
#pragma unroll
        for (int k = 0; k < 4; ++k) { s4[k] = 0.f; p4[k] = 0.f; }
#pragma unroll
        for (int gI = 0; gI < 4; ++gI) if (gI == best) {
#pragma unroll
            for (int k = 0; k < 4; ++k) { s4[k] = sel[4 * gI + k]; p4[k] = pr[4 * gI + k]; }
        }
        int i0 = 0; float a0 = s4[0];
#pragma unroll
        for (int k = 1; k < 4; ++k) if (s4[k] > a0) { a0 = s4[k]; i0 = k; }
        int i1 = -1; float a1 = -1e30f;
#pragma unroll
        for (int k = 0; k < 4; ++k) if (k != i0 && s4[k] > a1) { a1 = s4[k]; i1 = k; }
        float w0 = 0.f, w1 = 0.f;
#pragma unroll
        for (int k = 0; k < 4; ++k) { if (k == i0) w0 = p4[k]; if (k == i1) w1 = p4[k]; }
        const float iw = 1.f / (w0 + w1);
        if (lane == 0) {
            const int e0 = best * 4 + i0, e1 = best * 4 + i1;
            const unsigned p0 = atomicAdd(&cnt[e0 * 64], 1u), p1 = atomicAdd(&cnt[e1 * 64], 1u);
            LIST[(size_t)e0 * T_ + p0] = tok * 2; LIST[(size_t)e1 * T_ + p1] = tok * 2 + 1;
            WTS[tok * 2] = w0 * iw; WTS[tok * 2 + 1] = w1 * iw;
        }
    }
}

__device__ __forceinline__ bool moe_find(const unsigned* cnt, int t, int colTiles, int& e, int& rt, int& ct, int& cnte, int& off) {
    int base = 0; off = 0;
    for (int k = 0; k < NE; ++k) {
        const int c = __builtin_amdgcn_readfirstlane((int)cnt[k * 64]), nt = ((c + 127) >> 7) * colTiles;
        if (t < base + nt) { e = k; cnte = c; const int u = t - base; rt = u / colTiles; ct = u % colTiles;
            e = __builtin_amdgcn_readfirstlane(e); cnte = __builtin_amdgcn_readfirstlane(cnte); rt = __builtin_amdgcn_readfirstlane(rt);
            ct = __builtin_amdgcn_readfirstlane(ct); off = __builtin_amdgcn_readfirstlane(off); return true; }
        base += nt; off += c;
    }
    return false;
}
__device__ void phase_m2(const Params& p, int layer, unsigned char* lds) {
    unsigned char* ws = launder(p.ws);
    const unsigned* cnt = (const unsigned*)(ws + WS_CTL) + CW_CNT + layer * 1024 + vzero();
    const int* LIST = (const int*)(ws + WS_LIST);
    const bf16_t* X1B = (const bf16_t*)(ws + WS_X1B);
    bf16_t* HB = (bf16_t*)(ws + WS_HB);
    int ntile = 0;
    for (int k = 0; k < NE; ++k) ntile += ((__builtin_amdgcn_readfirstlane((int)cnt[k * 64]) + 127) >> 7) * 4;
    const int t_lo = (ntile * (int)(blockIdx.x & 7)) >> 3, t_hi = (ntile * (int)((blockIdx.x & 7) + 1)) >> 3;
    for (int t = t_lo + (blockIdx.x >> 3); t < t_hi; t += (gridDim.x >> 3)) {
        int e, rt, ct, cnte, off;
        if (!moe_find(cnt, t, 4, e, rt, ct, cnte, off)) break;
        const int tid = ltid(), lane = tid & 63, wid = tid >> 6, wr = wid >> 2, wc = wid & 3, fr = lane & 15, fq = lane >> 4;
        const int ldrow = 8 * wid + (lane >> 3), ldc = ((lane & 7) ^ (lane >> 3)) * 8;
        const unsigned mvo = (unsigned)(((ldrow >> 4) & 1) * (int)(WS_WU - WS_WG)) + (unsigned)((16 * (ldrow >> 5) + (ldrow & 15)) * 1024 + ldc) * 2u;
        unsigned nvo[2];
#pragma unroll
        for (int q = 0; q < 2; ++q) {
            int idx = rt * 128 + 64 * q + ldrow; idx = idx < cnte ? idx : cnte - 1;
            const int a = LIST[(size_t)e * T_ + idx];
            nvo[q] = (unsigned)((a >> 1) * 1024 + ldc) * 2u;
        }
        f32x4 acc[8][2]; zero_acc8<2>(acc);
        gemm8_kloop<2, true>((const bf16_t*)(ws + WS_WG) + ((size_t)e * 512 + ct * 128) * 1024, 512, mvo, X1B, 0, nvo, 16, lds, acc, tid);
#pragma unroll
        for (int mp2 = 0; mp2 < 4; ++mp2)
#pragma unroll
            for (int ni = 0; ni < 2; ++ni) {
                const int idx = rt * 128 + 32 * wc + 16 * ni + fr;
                if (idx < cnte) {
                    const int n = ct * 128 + (4 * wr + mp2) * 16 + 4 * fq;
                    const f32x4 gv = acc[2 * mp2][ni], uv = acc[2 * mp2 + 1][ni];
                    f32x4 hv;
#pragma unroll
                    for (int r = 0; r < 4; ++r) hv[r] = gv[r] * sigmoidf_(gv[r]) * uv[r];
                    *(u32x2*)(HB + (size_t)(off + idx) * 512 + n) = pack4(hv);
                }
            }
    }
}
__device__ void phase_m3(const Params& p, int layer, unsigned char* lds) {
    unsigned char* ws = launder(p.ws);
    const unsigned* cnt = (const unsigned*)(ws + WS_CTL) + CW_CNT + layer * 1024 + vzero();
    const int* LIST = (const int*)(ws + WS_LIST);
    const bf16_t* HB = (const bf16_t*)(ws + WS_HB);
    bf16_t* CT = (bf16_t*)(ws + WS_CT);
    int ntile = 0;
    for (int k = 0; k < NE; ++k) ntile += ((__builtin_amdgcn_readfirstlane((int)cnt[k * 64]) + 127) >> 7) * 4;
    const int t_lo = (ntile * (int)(blockIdx.x & 7)) >> 3, t_hi = (ntile * (int)((blockIdx.x & 7) + 1)) >> 3;
    for (int t = t_lo + (blockIdx.x >> 3); t < t_hi; t += (gridDim.x >> 3)) {
        int e, rt, ct, cnte, off;
        if (!moe_find(cnt, t, 4, e, rt, ct, cnte, off)) break;
        const int tid = ltid(), lane = tid & 63, wid = tid >> 6, wr = wid >> 2, wc = wid & 3, fr = lane & 15, fq = lane >> 4;
        const int ldrow = 8 * wid + (lane >> 3), ldc = ((lane & 7) ^ (lane >> 3)) * 8;
        const unsigned mvo = (unsigned)(ldrow * 512 + ldc) * 2u;
        unsigned nvo[2];
#pragma unroll
        for (int q = 0; q < 2; ++q) { int idx = rt * 128 + 64 * q + ldrow; idx = idx < cnte ? idx : cnte - 1; nvo[q] = (unsigned)((off + idx) * 512 + ldc) * 2u; }
        f32x4 acc[8][2]; zero_acc8<2>(acc);
        gemm8_kloop<2, true>((const bf16_t*)(ws + WS_WD) + ((size_t)e * 1024 + ct * 256) * 512, 512, mvo, HB, 0, nvo, 8, lds, acc, tid);
#pragma unroll
        for (int ni = 0; ni < 2; ++ni) {
            const int idx = rt * 128 + 32 * wc + 16 * ni + fr;
            if (idx < cnte) {
                const int a = LIST[(size_t)e * T_ + idx];
#pragma unroll
                for (int mi = 0; mi < 8; ++mi) {
                    const int n = ct * 256 + 128 * wr + 16 * mi + 4 * fq;
                    *(u32x2*)(CT + (size_t)a * 1024 + n) = pack4(acc[mi][ni]);
                }
            }
        }
    }
}

__device__ void phase_ln2(const Params& p, int layer, int half) {
    unsigned char* ws = launder(p.ws);
    const int tid = (ltid() & 255), lane = tid & 63, wid = tid >> 6;
    const float* X1 = (const float*)(ws + WS_X1); const bf16_t* CT = (const bf16_t*)(ws + WS_CT); const float* WTS = (const float*)(ws + WS_WTS);
    float* XO = layer == NLAYER - 1 ? p.out : (float*)(ws + WS_X); bf16_t* XB = (bf16_t*)(ws + WS_XB);
    const float* gam = p.ln2_g + layer * 1024; const float* bet = p.ln2_b + layer * 1024;
    constexpr int U = 4;
    const int nwave = (gridDim.x * 2) * 4, wv = (blockIdx.x * 2 + half) * 4 + wid;
    for (int t0 = wv * U; t0 < T_; t0 += nwave * U) {
        float4 v[U][4]; float s[U], q[U];
#pragma unroll
        for (int u = 0; u < U; ++u) {
            const int tok = t0 + u;
            const float w0 = WTS[tok * 2 + vzero()], w1 = WTS[tok * 2 + 1 + vzero()];
            s[u] = 0.f; q[u] = 0.f;
#pragma unroll
            for (int j = 0; j < 4; ++j) {
                const int d0 = 256 * j + 4 * lane;
                const float4 xv = *(const float4*)(X1 + (size_t)tok * 1024 + d0);
                const f32x4 c0 = unpack4(*(const u32x2*)(CT + (size_t)(tok * 2) * 1024 + d0)), c1 = unpack4(*(const u32x2*)(CT + (size_t)(tok * 2 + 1) * 1024 + d0));
                v[u][j].x = xv.x * DN_ALPHA + w0 * c0[0] + w1 * c1[0]; v[u][j].y = xv.y * DN_ALPHA + w0 * c0[1] + w1 * c1[1];
                v[u][j].z = xv.z * DN_ALPHA + w0 * c0[2] + w1 * c1[2]; v[u][j].w = xv.w * DN_ALPHA + w0 * c0[3] + w1 * c1[3];
                s[u] += v[u][j].x + v[u][j].y + v[u][j].z + v[u][j].w;
                q[u] += v[u][j].x * v[u][j].x + v[u][j].y * v[u][j].y + v[u][j].z * v[u][j].z + v[u][j].w * v[u][j].w;
            }
        }
#pragma unroll
        for (int o = 1; o < 64; o <<= 1) {
#pragma unroll
            for (int u = 0; u < U; ++u) { s[u] += __shfl_xor(s[u], o); q[u] += __shfl_xor(q[u], o); }
        }
#pragma unroll
        for (int j = 0; j < 4; ++j) {
            const int d0 = 256 * j + 4 * lane;
            const float4 gg = *(const float4*)(gam + d0), bb = *(const float4*)(bet + d0);
#pragma unroll
            for (int u = 0; u < U; ++u) {
                const int tok = t0 + u;
                const float mu = s[u] * (1.f / 1024.f), var = fmaxf(q[u] * (1.f / 1024.f) - mu * mu, 0.f), rstd = rsqrtf(var + 1e-5f);
                float4 y; y.x = (v[u][j].x - mu) * rstd * gg.x + bb.x; y.y = (v[u][j].y - mu) * rstd * gg.y + bb.y; y.z = (v[u][j].z - mu) * rstd * gg.z + bb.z; y.w = (v[u][j].w - mu) * rstd * gg.w + bb.w;
                *(float4*)(XO + (size_t)tok * 1024 + d0) = y;
                u32x2 w; w.x = pack2(y.x, y.y); w.y = pack2(y.z, y.w);
                *(u32x2*)(XB + (size_t)tok * 1024 + d0) = w;
            }
        }
    }
}

#define XB_TMO      128
#define XB_XCNT(j)  (256  + 64 * (j))
#define XB_XSUB(j)  (1280 + 64 * (j))
#define XB_XGEN(j)  (2304 + 64 * (j))
#define XB_TOP      3328
#define XB_TOPGEN   3392
#define XCD_BAR_WORDS 3456
#define XB_SPIN_CAP (1u << 22)
#define LAS __attribute__((address_space(3)))
__device__ __forceinline__ unsigned xb_ld(unsigned* p)              { return __hip_atomic_load(p, __ATOMIC_RELAXED, __HIP_MEMORY_SCOPE_AGENT); }
__device__ __forceinline__ unsigned xb_add(unsigned* p, unsigned v) { return __hip_atomic_fetch_add(p, v, __ATOMIC_RELAXED, __HIP_MEMORY_SCOPE_AGENT); }
__device__ __forceinline__ unsigned xb_xcc_id() { return (unsigned)__builtin_amdgcn_s_getreg((3 << 11) | 20) & 0xFu; }
#define XB_SPIN(cond, bar) do { unsigned _sp = 0; while (cond) { __builtin_amdgcn_s_sleep(1); \
    if ((++_sp & 255u) == 0u) { if (xb_ld(&(bar)[XB_TMO])) break; if (_sp > XB_SPIN_CAP) { atomicAdd(&(bar)[XB_TMO], 1u); break; } } } } while (0)
struct XcdBarrier { unsigned* bar; unsigned x; volatile LAS unsigned* st; };
__device__ __forceinline__ XcdBarrier xcd_barrier_post(unsigned* bar, volatile LAS unsigned* st) {
    XcdBarrier b; b.bar = bar; b.x = xb_xcc_id(); b.st = st;
    if (threadIdx.x == 0) (void)xb_add(&bar[XB_XCNT(b.x)], 1u);
    return b;
}
__device__ __forceinline__ void xcd_barrier_complete(unsigned* bar, unsigned x, unsigned& nloc, unsigned& nx) {
    const unsigned G = gridDim.x * gridDim.y * gridDim.z;
    unsigned sum, cnt, mine, sp = 0u;
    for (;;) {
        sum = 0u; cnt = 0u; mine = 0u;
#pragma unroll
        for (unsigned j = 0; j < 16; ++j) { const unsigned c = xb_ld(&bar[XB_XCNT(j)]); sum += c; cnt += (c > 0u) ? 1u : 0u; mine = (j == x) ? c : mine; }
        if (sum == G) break;
        __builtin_amdgcn_s_sleep(1);
        if ((++sp & 255u) == 0u) { if (xb_ld(&bar[XB_TMO])) break; if (sp > XB_SPIN_CAP) { atomicAdd(&bar[XB_TMO], 1u); break; } }
    }
    nloc = mine > 0u ? mine : 1u; nx = cnt > 0u ? cnt : 1u;
}
__device__ __forceinline__ void xcd_barrier(const XcdBarrier& b) {
    asm volatile("s_waitcnt vmcnt(0)" ::: "memory");
    __syncthreads();
    if (threadIdx.x == 0) {
        unsigned* bar = b.bar;
        __builtin_amdgcn_s_waitcnt(0);
        unsigned nloc = b.st[0], nx = b.st[1];
        if (nloc == 0u) { xcd_barrier_complete(bar, b.x, nloc, nx); b.st[0] = nloc; b.st[1] = nx; }
        const unsigned old = xb_add(&bar[XB_XSUB(b.x)], 1u);
        const unsigned gen = old / nloc;
        if (old + 1u == (gen + 1u) * nloc) {
            __builtin_amdgcn_fence(__ATOMIC_RELEASE, "agent");
            asm volatile("s_waitcnt vmcnt(0)" ::: "memory");
            const unsigned og = xb_add(&bar[XB_TOP], 1u);
            const unsigned tg = og / nx;
            if (og + 1u == (tg + 1u) * nx) xb_add(&bar[XB_TOPGEN], 1u);
            else XB_SPIN(xb_ld(&bar[XB_TOPGEN]) == tg, bar);
            __builtin_amdgcn_fence(__ATOMIC_ACQUIRE, "agent");
            xb_add(&bar[XB_XGEN(b.x)], 1u);
            asm volatile("s_waitcnt vmcnt(0)" ::: "memory");
        } else {
            XB_SPIN(xb_ld(&bar[XB_XGEN(b.x)]) == gen, bar);
            __builtin_amdgcn_fence(__ATOMIC_ACQUIRE, "agent");
            asm volatile("s_waitcnt vmcnt(0)" ::: "memory");
        }
    }
    __syncthreads();
}

constexpr int PH_PER_LAYER = 11, N_PHASES = PH_PER_LAYER * NLAYER;
__global__ void __launch_bounds__(NTHREADS, 2) mega(Params p) {
    extern __shared__ __attribute__((aligned(16))) unsigned char lds[];
#if SINGLE_LAUNCH
    volatile LAS unsigned* xbw = (volatile LAS unsigned*)(lds + LDS_BYTES - 16);
    if (threadIdx.x < 4) xbw[threadIdx.x] = 0u;
    __syncthreads();
    XcdBarrier xbar = xcd_barrier_post((unsigned*)(p.ws + WS_CTL) + CW_BAR, xbw);
#endif
    const int half = __builtin_amdgcn_readfirstlane((int)(threadIdx.x >> 8));
    unsigned char* ldsh = lds + half * HALF_LDS;
    for (int ph = p.ph_lo; ph < p.ph_hi; ++ph) {
        const int layer = ph / PH_PER_LAYER, k = ph % PH_PER_LAYER;
        if (k == 0 && layer > 0) continue;
#ifdef ONLY_PHASE
        if (k != ONLY_PHASE) continue;
#endif
#ifdef REPEAT_MASK
        for (int rep = 0; rep < (((REPEAT_MASK) >> k) & 1) + 1; ++rep) {
        if (rep) __syncthreads();
#endif
        switch (k) {
            case 0: phase_pw(p, layer, ldsh, 15, half); break;
            case 1: phase_g1(p, layer, lds); break;
            case 2: phase_p2(p, layer, ldsh, half); break;
            case 3: phase_p3(p, ldsh, half); if (layer + 1 < NLAYER) { __syncthreads(); phase_pw(p, layer + 1, ldsh, 1, half); } break;
            case 4: if (layer > 0 && half == 0) { phase_pw(p, layer, ldsh, 4, half); __syncthreads(); }
                    phase_p4(p, ldsh, half);
                    if (layer > 0 && half == 1) { __syncthreads(); phase_pw(p, layer, ldsh, 4, half); } break;
            case 5: phase_g2(p, lds); break;
            case 6: phase_g3(p, layer, lds); break;
#ifdef REPEAT_MASK
            case 7: phase_ln1(p, layer, ldsh, (((REPEAT_MASK) >> 7) & 1) && rep == 0, half); break;
#else
            case 7: phase_ln1(p, layer, ldsh, false, half); if (layer + 1 < NLAYER) { __syncthreads(); phase_pw(p, layer + 1, ldsh, 2, half); } break;
#endif
            case 8: phase_m2(p, layer, lds); break;
            case 9: phase_m3(p, layer, lds); break;
            case 10: phase_ln2(p, layer, half); break;
        }
#ifdef REPEAT_MASK
        }
#endif
#if SINGLE_LAUNCH
        if (ph + 1 < p.ph_hi) { if (ph == p.ph_lo) cg::this_grid().sync(); else xcd_barrier(xbar); }
#endif
    }
}

extern "C" void kernel_launch(void* const* d_in, const int* in_sizes, int n_in, void* d_out, int out_size, void* d_ws, size_t ws_size, hipStream_t stream) {
    static int grid = 0;
    if (grid == 0) {
        if (n_in != 18 || ws_size < WS_END) { fprintf(stderr, "kernel_launch: unexpected n_in %d or ws_size %zu < %zu\n", n_in, ws_size, (size_t)WS_END); grid = -1; return; }
        int dev = 0, cus = 0, per_cu = 0;
        hipGetDevice(&dev); hipDeviceGetAttribute(&cus, hipDeviceAttributeMultiprocessorCount, dev);
        hipFuncSetAttribute((const void*)mega, hipFuncAttributeMaxDynamicSharedMemorySize, LDS_BYTES);
        hipOccupancyMaxActiveBlocksPerMultiprocessor(&per_cu, (const void*)mega, NTHREADS, LDS_BYTES);
        if (per_cu < 1) per_cu = 1;
        if (per_cu > 1) per_cu = 1;
        grid = cus * per_cu;
        (void)hipGetLastError();
    }
    if (grid < 0) return;
    Params p{};
    p.x = (const float*)d_in[0]; p.w_in = (const float*)d_in[1]; p.cmp_pos = (const float*)d_in[2]; p.cmp_w1 = (const float*)d_in[3]; p.cmp_w2 = (const float*)d_in[4];
    p.w_br_a = (const float*)d_in[5]; p.w_br_b = (const float*)d_in[6]; p.w_o = (const float*)d_in[7]; p.ln1_g = (const float*)d_in[8]; p.ln1_b = (const float*)d_in[9];
    p.w_router = (const float*)d_in[10]; p.router_bias = (const float*)d_in[11]; p.w_gate = (const float*)d_in[12]; p.w_up = (const float*)d_in[13]; p.w_down = (const float*)d_in[14];
    p.ln2_g = (const float*)d_in[15]; p.ln2_b = (const float*)d_in[16]; p.rel_bias = (const float*)d_in[17];
    p.out = (float*)d_out; p.ws = (unsigned char*)d_ws;
#if SINGLE_LAUNCH
    hipMemsetAsync((unsigned char*)d_ws + WS_CTL + (size_t)CW_BAR * 4, 0, XCD_BAR_WORDS * 4, stream);
    p.ph_lo = 0; p.ph_hi = N_PHASES;
    void* args[] = {&p};
    hipError_t e = hipLaunchCooperativeKernel((const void*)mega, dim3(grid), dim3(NTHREADS), args, LDS_BYTES, stream);
    if (e != hipSuccess) fprintf(stderr, "cooperative launch failed: %s (grid %d)\n", hipGetErrorString(e), grid);
#else
    for (int ph = 0; ph < N_PHASES; ++ph) {
        p.ph_lo = ph; p.ph_hi = ph + 1;
        hipLaunchKernelGGL(mega, dim3(grid), dim3(NTHREADS), LDS_BYTES, stream, p);
    }
#endif
}
```

```cpp
#include <hip/hip_runtime.h>
#include <hip/hip_cooperative_groups.h>
#include <cstdio>
#include <cstdint>
namespace cg = cooperative_groups;

#ifndef SINGLE_LAUNCH
#define SINGLE_LAUNCH 1
#endif

typedef unsigned short bf16_t;
typedef short bf16x8 __attribute__((ext_vector_type(8)));
typedef float f32x4 __attribute__((ext_vector_type(4)));
typedef unsigned u32x2 __attribute__((ext_vector_type(2)));
typedef unsigned u32x4 __attribute__((ext_vector_type(4)));

constexpr int B_ = 2, S_ = 8192, D_ = 1024, T_ = B_ * S_, NLAYER = 4;
constexpr int DIN = 6424;
constexpr int LD = 5376;
constexpr int NW = 6656;
constexpr int C_QA = 0, C_KC = 512, C_VC = 640, C_KS = 768, C_KW = 896, C_QR = 1024, C_KR = 1536, C_GR = 2048, C_MA = 3072, C_MB = 4096, C_GA = 5120,
              C_VS = 5376, C_VW = 5504, C_VR = 5632;
constexpr float DN_ALPHA = 1.681792830507429f;
constexpr int NE = 16;

constexpr size_t al256(size_t x) { return (x + 255) & ~(size_t)255; }
constexpr size_t WS_CTL = 0;
constexpr size_t WS_BUCKET = 65536;
constexpr size_t WS_ROPE = WS_BUCKET + 8192;
constexpr size_t WS_WIN = WS_ROPE + (size_t)8192 * 32 * 8;
constexpr size_t WS_WA = WS_WIN + (size_t)NW * 1024 * 2;
constexpr size_t WS_WB = WS_WA + (size_t)1024 * 512 * 2;
constexpr size_t WS_WO = WS_WB + (size_t)1024 * 1024 * 2;
constexpr size_t WS_WG = WS_WO + (size_t)1024 * 1024 * 2;
constexpr size_t WS_WU = WS_WG + (size_t)16 * 512 * 1024 * 2;
constexpr size_t WS_WD = WS_WU + (size_t)16 * 512 * 1024 * 2;
constexpr size_t WS_XB = WS_WD + (size_t)16 * 512 * 1024 * 2;
constexpr size_t WS_X = WS_XB + (size_t)T_ * 1024 * 2;
constexpr size_t WS_MG = WS_X + (size_t)T_ * 1024 * 4;
constexpr size_t WS_KCC = WS_MG + (size_t)T_ * 1024 * 2;
constexpr size_t WS_VCCT = WS_KCC + (size_t)4 * 512 * 64 * 2;
constexpr size_t WS_W1T = WS_VCCT + (size_t)4 * 512 * 64 * 2;
constexpr size_t WS_B1 = WS_W1T + (size_t)2 * 64 * 2048 * 2;
constexpr size_t WS_R = WS_B1 + 1024;
constexpr size_t WS_P = WS_R;
constexpr size_t WS_VST = WS_P + (size_t)T_ * LD * 2;
constexpr size_t WS_VWT = WS_VST + (size_t)4 * 64 * S_ * 2;
constexpr size_t WS_VRT = WS_VWT + (size_t)4 * 64 * S_ * 2;
constexpr size_t WS_KVT = WS_VRT + (size_t)16 * 128 * S_ * 2;
constexpr size_t WS_SPT = WS_KVT + (size_t)16 * 64 * 8192 * 4;
constexpr size_t WS_YC = WS_SPT + (size_t)16 * 64 * 8192 * 2;
constexpr size_t WS_YW = WS_YC + (size_t)T_ * 512 * 2;
constexpr size_t WS_YA = WS_YW + (size_t)T_ * 512 * 2;
constexpr size_t WS_YB = WS_YA + (size_t)T_ * 512 * 2;
constexpr size_t WS_SELW = WS_YB + (size_t)T_ * 1024 * 2;
constexpr size_t WS_ENDA = WS_SELW + (size_t)T_ * 2 * 4 * 4;
constexpr size_t WS_H1 = WS_R;
constexpr size_t WS_X1 = WS_H1 + (size_t)T_ * 1024 * 4;
constexpr size_t WS_X1B = WS_X1 + (size_t)T_ * 1024 * 4;
constexpr size_t WS_HB = WS_X1B + (size_t)T_ * 1024 * 2;
constexpr size_t WS_CT = WS_HB + (size_t)2 * T_ * 512 * 2;
constexpr size_t WS_LIST = WS_CT + (size_t)2 * T_ * 1024 * 2;
constexpr size_t WS_WTS = WS_LIST + (size_t)16 * T_ * 4;
constexpr size_t WS_ENDB = WS_WTS + (size_t)2 * T_ * 4;
static_assert(WS_HB + (size_t)2 * T_ * 512 * 2 <= WS_CT, "view B overlap");
constexpr size_t WS_END = WS_ENDA > WS_ENDB ? WS_ENDA : WS_ENDB;

constexpr int CW_CNT = 4096;
constexpr int CW_BAR = 8192;

constexpr int HALF_LDS = 75776, LDS_BYTES = 2 * HALF_LDS + 16;
constexpr int NTHREADS = 512, HT = 256;

struct Params {
    const float* x; const float* w_in; const float* cmp_pos; const float* cmp_w1; const float* cmp_w2;
    const float* w_br_a; const float* w_br_b; const float* w_o; const float* ln1_g; const float* ln1_b;
    const float* w_router; const float* router_bias; const float* w_gate; const float* w_up; const float* w_down;
    const float* ln2_g; const float* ln2_b; const float* rel_bias;
    float* out; unsigned char* ws;
    int ph_lo, ph_hi;
};

__device__ __forceinline__ bf16_t f2bf(float f) { unsigned u = __float_as_uint(f); u += 0x7fffu + ((u >> 16) & 1u); return (bf16_t)(u >> 16); }
__device__ __forceinline__ float bf2f(unsigned h) { return __uint_as_float(h << 16); }
typedef __bf16 bf16x2_t __attribute__((ext_vector_type(2)));
typedef float f32x2_t __attribute__((ext_vector_type(2)));
__device__ __forceinline__ unsigned pack2(float lo, float hi) { const f32x2_t f = {lo, hi}; return __builtin_bit_cast(unsigned, __builtin_convertvector(f, bf16x2_t)); }
__device__ __forceinline__ u32x2 pack4(f32x4 v) { u32x2 r; r.x = pack2(v[0], v[1]); r.y = pack2(v[2], v[3]); return r; }
__device__ __forceinline__ f32x4 unpack4(u32x2 u) { f32x4 r; r[0] = bf2f(u.x & 0xffffu); r[1] = bf2f(u.x >> 16); r[2] = bf2f(u.y & 0xffffu); r[3] = bf2f(u.y >> 16); return r; }
__device__ __forceinline__ float rows_max(float v) {
    u32x2 r = __builtin_amdgcn_permlane16_swap(__float_as_uint(v), __float_as_uint(v), false, false);
    v = fmaxf(__uint_as_float(r.x), __uint_as_float(r.y));
    r = __builtin_amdgcn_permlane32_swap(__float_as_uint(v), __float_as_uint(v), false, false);
    return fmaxf(__uint_as_float(r.x), __uint_as_float(r.y));
}
__device__ __forceinline__ float rows_sum(float v) {
    u32x2 r = __builtin_amdgcn_permlane16_swap(__float_as_uint(v), __float_as_uint(v), false, false);
    v = __uint_as_float(r.x) + __uint_as_float(r.y);
    r = __builtin_amdgcn_permlane32_swap(__float_as_uint(v), __float_as_uint(v), false, false);
    return __uint_as_float(r.x) + __uint_as_float(r.y);
}
__device__ __forceinline__ float wave_sum(float v) {
    v += __int_as_float(__builtin_amdgcn_ds_swizzle(__float_as_int(v), 0x041F));
    v += __int_as_float(__builtin_amdgcn_ds_swizzle(__float_as_int(v), 0x081F));
    v += __int_as_float(__builtin_amdgcn_ds_swizzle(__float_as_int(v), 0x101F));
    v += __int_as_float(__builtin_amdgcn_ds_swizzle(__float_as_int(v), 0x201F));
    v += __int_as_float(__builtin_amdgcn_ds_swizzle(__float_as_int(v), 0x401F));
    const u32x2 r = __builtin_amdgcn_permlane32_swap(__float_as_uint(v), __float_as_uint(v), false, false);
    return __uint_as_float(r.x) + __uint_as_float(r.y);
}
__device__ __forceinline__ float sigmoidf_(float x) { return 1.f / (1.f + __expf(-x)); }
__device__ __forceinline__ int ltid() { int t = threadIdx.x; asm volatile("" : "+v"(t)); return t; }
__device__ __forceinline__ int vzero() { int z; asm volatile("v_mov_b32 %0, 0" : "=v"(z)); return z; }
__device__ __forceinline__ unsigned char* launder(unsigned char* q) { asm volatile("" : "+s"(q)); return q; }
__device__ __forceinline__ void wait_vm0() { asm volatile("s_waitcnt vmcnt(0)" ::: "memory"); }

__device__ __forceinline__ void glds16(const void* g, void* l) {
    __builtin_amdgcn_global_load_lds((const __attribute__((address_space(1))) unsigned*)g,
                                     (__attribute__((address_space(3))) unsigned*)l, 16, 0, 0);
}
__device__ __forceinline__ f32x4 mfma16(bf16x8 a, bf16x8 b, f32x4 c) { return __builtin_amdgcn_mfma_f32_16x16x32_bf16(a, b, c, 0, 0, 0); }

#define WAIT_V(n) asm volatile("s_waitcnt vmcnt(%0)" ::"n"(n) : "memory")
#define RAW_BARRIER() do { asm volatile("s_waitcnt lgkmcnt(0)" ::: "memory"); __builtin_amdgcn_s_barrier(); } while (0)
__device__ __forceinline__ void bglds16(__amdgpu_buffer_rsrc_t r, unsigned voff, int soff, void* l) {
    __builtin_amdgcn_raw_ptr_buffer_load_lds(r, (__attribute__((address_space(3))) void*)l, 16, (int)voff, soff, 0, 0);
}
template <int NJ, bool GN>
__device__ __forceinline__ void gemm8_stage(__amdgpu_buffer_rsrc_t mr, int mld, unsigned mvo, __amdgpu_buffer_rsrc_t nr, int nld, const unsigned (&nvo)[NJ], int kt, unsigned char* st, int wid) {
#pragma unroll
    for (int i = 0; i < 4; ++i) bglds16(mr, mvo, (64 * i * mld + kt * 64) * 2, st + (8 * i + wid) * 1024);
#pragma unroll
    for (int i = 0; i < NJ; ++i) bglds16(nr, nvo[i], ((GN ? 0 : 64 * i * nld) + kt * 64) * 2, st + 32768 + (8 * i + wid) * 1024);
}
template <int NJ, bool GN>
__device__ __forceinline__ void gemm8_kloop(const bf16_t* mb, int mld, unsigned mvo, const bf16_t* nb, int nld, const unsigned (&nvo)[NJ], int nk, unsigned char* lds, f32x4 (&acc)[8][NJ], int tid) {
    const int lane = tid & 63, wid = tid >> 6, wr = wid >> 2, wc = wid & 3, fr = lane & 15, fq = lane >> 4;
    const __amdgpu_buffer_rsrc_t mr = __builtin_amdgcn_make_buffer_rsrc((void*)mb, 0, 0x7fffffff, 0x00020000);
    const __amdgpu_buffer_rsrc_t nr = __builtin_amdgcn_make_buffer_rsrc((void*)nb, 0, 0x7fffffff, 0x00020000);
    gemm8_stage<NJ, GN>(mr, mld, mvo, nr, nld, nvo, 0, lds, wid);
    gemm8_stage<NJ, GN>(mr, mld, mvo, nr, nld, nvo, 1, lds + 65536, wid);
    for (int kt = 0; kt < nk; ++kt) {
        unsigned char* cur = lds + (kt & 1) * 65536;
        if (kt + 1 < nk) WAIT_V(4 + NJ); else WAIT_V(0);
        RAW_BARRIER();
        bf16x8 a[4], b[NJ];
        const unsigned char* ab = cur + (128 * wr + fr) * 128;
        const unsigned char* bb = cur + 32768 + (16 * NJ * wc + fr) * 128;
        const int sw0 = ((fq) ^ (fr & 7)) << 4, sw1 = ((4 + fq) ^ (fr & 7)) << 4;
#pragma unroll
        for (int j = 0; j < NJ; ++j) b[j] = *(const bf16x8*)(bb + j * 2048 + sw0);
#pragma unroll
        for (int mh = 0; mh < 2; ++mh) {
#pragma unroll
            for (int i = 0; i < 4; ++i) a[i] = *(const bf16x8*)(ab + (4 * mh + i) * 2048 + sw0);
#pragma unroll
            for (int i = 0; i < 4; ++i)
#pragma unroll
                for (int j = 0; j < NJ; ++j) acc[4 * mh + i][j] = mfma16(a[i], b[j], acc[4 * mh + i][j]);
        }
#pragma unroll
        for (int j = 0; j < NJ; ++j) b[j] = *(const bf16x8*)(bb + j * 2048 + sw1);
#pragma unroll
        for (int i = 0; i < 4; ++i) a[i] = *(const bf16x8*)(ab + i * 2048 + sw1);
#pragma unroll
        for (int i = 0; i < 4; ++i)
#pragma unroll
            for (int j = 0; j < NJ; ++j) acc[i][j] = mfma16(a[i], b[j], acc[i][j]);
#pragma unroll
        for (int i = 0; i < 4; ++i) a[i] = *(const bf16x8*)(ab + (4 + i) * 2048 + sw1);
        RAW_BARRIER();
        if (kt + 2 < nk) gemm8_stage<NJ, GN>(mr, mld, mvo, nr, nld, nvo, kt + 2, cur, wid);
#pragma unroll
        for (int i = 0; i < 4; ++i)
#pragma unroll
            for (int j = 0; j < NJ; ++j) acc[4 + i][j] = mfma16(a[i], b[j], acc[4 + i][j]);
    }
    __syncthreads();
    __builtin_amdgcn_sched_barrier(0);
}
template <int NJ>
__device__ __forceinline__ void zero_acc8(f32x4 (&acc)[8][NJ]) {
#pragma unroll
    for (int i = 0; i < 8; ++i)
#pragma unroll
        for (int j = 0; j < NJ; ++j) acc[i][j] = (f32x4){0.f, 0.f, 0.f, 0.f};
}

namespace pg8 {
#define PG8_LAS __attribute__((address_space(3)))
constexpr int BM = 256, BK = 64, HALF = 128, HTB = HALF * BK * 2, STAGE_BYTES = 8 * HTB;
__device__ __forceinline__ int lds_byte(int r, int c) { const int st = (r >> 4) * 2 + (c >> 5), rr = r & 15, cc = c & 31, ob = rr * 64 + cc * 2; return st * 1024 + (ob ^ (((ob >> 9) & 1) << 5)); }
__device__ __forceinline__ void stage_rc(int b, int& R, int& C) { const int st = b / 1024, sb = b % 1024, swz = sb ^ (((sb >> 9) & 1) << 5); R = (st >> 1) * 16 + swz / 64; C = (st & 1) * 32 + (swz % 64) / 2; }
__device__ __forceinline__ int perm32(int rho) { const int n = rho >> 4, i = rho & 15; return 8 * (i >> 2) + 4 * n + (i & 3); }
struct Unit { int pm, pn; };
template <class Epi, class Sched>
__device__ __forceinline__ void gemm_phase(unsigned char* lds_, const int K, const Sched& S, const Epi& E, const int tid, const unsigned char* wsbase) {
    PG8_LAS unsigned char* lds = (PG8_LAS unsigned char*)lds_;
    const int wid = __builtin_amdgcn_readfirstlane(tid >> 6), lane = tid & 63, wr = wid >> 2, wc = wid & 3, fr = lane & 15, fq = lane >> 4;
    const int nt = K / BK;
    unsigned voffA[2], voffB[2];
#pragma unroll
    for (int i = 0; i < 2; ++i) { int R, C; stage_rc(tid * 16 + i * 8192, R, C); const int Rb = (R & ~31) + perm32(R & 31);
        voffA[i] = (unsigned)(R * K + C) * 2u; voffB[i] = (unsigned)(Rb * K + C) * 2u; }
    const unsigned kstep = (unsigned)(BK * 2);
    const unsigned hstep = (unsigned)HALF * K * 2;
    const __amdgpu_buffer_rsrc_t rsrc = __builtin_amdgcn_make_buffer_rsrc((void*)wsbase, 0, 0x7fffffff, 0x00020000);
    const unsigned ldsw = (unsigned)wid * 1024u;
    const int aoff = lds_byte(wr * 64 + fr, fq * 8), boff = lds_byte(wc * 32 + fr, fq * 8);
#define PG8_SA(b, h) (((b) * 2 + (h)) * HTB)
#define PG8_SB(b, h) ((4 + (b) * 2 + (h)) * HTB)
#define PG8_STAGE(bufoff, gbase, voff) do { _Pragma("unroll") for (int _i = 0; _i < 2; ++_i) \
        __builtin_amdgcn_raw_ptr_buffer_load_lds(rsrc, (PG8_LAS void*)(lds + (bufoff) + ldsw + _i * 8192), 16, (int)(voff)[_i], (int)(gbase), 0, 0); } while (0)
#define PG8_LDA(dst, b, h) do { _Pragma("unroll") for (int m = 0; m < 4; ++m) _Pragma("unroll") for (int k = 0; k < 2; ++k) dst[m][k] = *(const PG8_LAS bf16x8*)(lds + PG8_SA(b, h) + aoff + m * 2048 + k * 1024); } while (0)
#define PG8_LDB(dst, b, h) do { _Pragma("unroll") for (int n = 0; n < 2; ++n) _Pragma("unroll") for (int k = 0; k < 2; ++k) dst[n][k] = *(const PG8_LAS bf16x8*)(lds + PG8_SB(b, h) + boff + n * 2048 + k * 1024); } while (0)
#define PG8_MMA(ai, bj, At, Bt) do { __builtin_amdgcn_s_setprio(1); _Pragma("unroll") for (int m = 0; m < 4; ++m) _Pragma("unroll") for (int n = 0; n < 2; ++n) _Pragma("unroll") for (int k = 0; k < 2; ++k) \
        acc[ai][bj][m][n] = __builtin_amdgcn_mfma_f32_16x16x32_bf16(Bt[n][k], At[m][k], acc[ai][bj][m][n], 0, 0, 0); __builtin_amdgcn_s_setprio(0); } while (0)
#define PG8_WAIT_V(n) asm volatile("s_waitcnt vmcnt(" #n ")" ::: "memory")
#define PG8_WAIT_L(n) asm volatile("s_waitcnt lgkmcnt(" #n ")" ::: "memory")
#define PG8_BAR __builtin_amdgcn_s_barrier()
#define PG8_SCHED __builtin_amdgcn_sched_barrier(0)
    typename Sched::U cur, nxt; int ui = 0;
    if (!S.next(0, cur)) return;
    unsigned cA, cB; S.ptrs(cur, cA, cB);
    constexpr bool GA = Sched::GATHER;
    unsigned vA[GA ? 2 : 1][2], nvA[GA ? 2 : 1][2];
    if constexpr (GA) { S.rows(cur, tid, vA);
#pragma unroll
        for (int h = 0; h < 2; ++h)
#pragma unroll
            for (int i = 0; i < 2; ++i) nvA[h][i] = vA[h][i]; }
#define PG8_STAGE_A(bufoff, gbase, h, nextu) do { if constexpr (GA) { if (nextu) PG8_STAGE(bufoff, gbase, nvA[h]); else PG8_STAGE(bufoff, gbase, vA[h]); } \
        else PG8_STAGE(bufoff, (gbase) + (h) * hstep, voffA); } while (0)
    PG8_STAGE(PG8_SB(0, 0), cB, voffB); PG8_STAGE_A(PG8_SA(0, 0), cA, 0, false); PG8_STAGE(PG8_SB(0, 1), cB + hstep, voffB); PG8_STAGE_A(PG8_SA(0, 1), cA, 1, false);
    if (wr == 1) PG8_BAR;
    PG8_WAIT_V(4); PG8_BAR;
    PG8_STAGE(PG8_SB(1, 0), cB + kstep, voffB); PG8_STAGE_A(PG8_SA(1, 0), cA + kstep, 0, false); PG8_STAGE(PG8_SB(1, 1), cB + hstep + kstep, voffB);
    PG8_WAIT_V(6); PG8_BAR;
    PG8_SCHED;
    f32x4 acc[2][2][4][2];
#pragma unroll
    for (int a = 0; a < 2; ++a)
#pragma unroll
        for (int b = 0; b < 2; ++b)
#pragma unroll
            for (int m = 0; m < 4; ++m)
#pragma unroll
                for (int n = 0; n < 2; ++n) acc[a][b][m][n] = (f32x4){0.f, 0.f, 0.f, 0.f};
    bf16x8 At[4][2], B0[2][2], B1[2][2];
    for (;;) {
        const bool has_next = S.next(ui + 1, nxt);
        unsigned nA = cA, nB = cB; if (has_next) S.ptrs(nxt, nA, nB);
        if constexpr (GA) { if (has_next) S.rows(nxt, tid, nvA); }
        for (int t = 0; t < nt; t += 2) {
            const bool last = (t == nt - 2);
            const unsigned a1 = cA + (unsigned)(t + 1) * kstep;
            const unsigned a2 = last ? nA : cA + (unsigned)(t + 2) * kstep, b2 = last ? nB : cB + (unsigned)(t + 2) * kstep;
            const unsigned a3 = a2 + kstep, b3 = b2 + kstep;
            PG8_LDB(B0, 0, 0); PG8_SCHED; PG8_LDA(At, 0, 0); PG8_STAGE_A(PG8_SA(1, 1), a1, 1, false);
            PG8_WAIT_L(8); PG8_BAR; PG8_WAIT_L(0); PG8_MMA(0, 0, At, B0); PG8_BAR; PG8_SCHED;
            PG8_LDB(B1, 0, 1); PG8_STAGE(PG8_SB(0, 0), b2, voffB);
            PG8_BAR; PG8_WAIT_L(0); PG8_MMA(0, 1, At, B1); PG8_BAR;
            PG8_LDA(At, 0, 1); PG8_STAGE_A(PG8_SA(0, 0), a2, 0, last);
            PG8_BAR; PG8_WAIT_L(0); PG8_MMA(1, 0, At, B0); PG8_BAR; PG8_SCHED;
            PG8_STAGE(PG8_SB(0, 1), b2 + hstep, voffB);
            PG8_WAIT_V(6); PG8_BAR; PG8_MMA(1, 1, At, B1); PG8_BAR;
            PG8_LDB(B0, 1, 0); PG8_SCHED; PG8_LDA(At, 1, 0); PG8_STAGE_A(PG8_SA(0, 1), a2, 1, last);
            PG8_WAIT_L(8); PG8_BAR; PG8_WAIT_L(0); PG8_MMA(0, 0, At, B0); PG8_BAR; PG8_SCHED;
            PG8_LDB(B1, 1, 1); PG8_STAGE(PG8_SB(1, 0), b3, voffB);
            PG8_BAR; PG8_WAIT_L(0); PG8_MMA(0, 1, At, B1); PG8_BAR;
            PG8_LDA(At, 1, 1); PG8_STAGE_A(PG8_SA(1, 0), a3, 0, last);
            PG8_BAR; PG8_WAIT_L(0); PG8_MMA(1, 0, At, B0); PG8_BAR; PG8_SCHED;
            PG8_STAGE(PG8_SB(1, 1), b3 + hstep, voffB);
            PG8_WAIT_V(6); PG8_BAR; PG8_MMA(1, 1, At, B1); PG8_BAR;
        }
        E(acc, cur, wr, wc, fr, fq);
        if (!has_next) break;
#pragma unroll
        for (int a = 0; a < 2; ++a)
#pragma unroll
            for (int b = 0; b < 2; ++b)
#pragma unroll
                for (int m = 0; m < 4; ++m)
#pragma unroll
                    for (int n = 0; n < 2; ++n) acc[a][b][m][n] = (f32x4){0.f, 0.f, 0.f, 0.f};
        cur = nxt; cA = nA; cB = nB; ++ui;
        if constexpr (GA) {
#pragma unroll
            for (int h = 0; h < 2; ++h)
#pragma unroll
                for (int i = 0; i < 2; ++i) vA[h][i] = nvA[h][i]; }
    }
    PG8_WAIT_V(0);
    if (wr == 0) PG8_BAR;
    PG8_BAR;
#undef PG8_SA
#undef PG8_SB
#undef PG8_STAGE
#undef PG8_STAGE_A
#undef PG8_LDA
#undef PG8_LDB
#undef PG8_MMA
#undef PG8_WAIT_V
#undef PG8_WAIT_L
#undef PG8_BAR
#undef PG8_SCHED
}
}

__device__ void tcvt_tile(const float* src, int ld_src, int k0, int n0, int mode, bf16_t* dst, int kdst, unsigned char* lds, int half) {
    float* tile = (float*)lds;
    const int tid = (ltid() & 255);
#pragma unroll
    for (int i = 0; i < 4; ++i) {
        const int kk = (tid >> 4) + 16 * i, c4 = (tid & 15) * 4, cd = n0 + c4;
        int orig = cd; bool ok = true;
        if (mode == 1) {
            if (cd < 896) orig = cd;
            else if (cd < 1024) orig = cd - 896 + 1024;
            else if (cd < 2048) { const int q = cd - 1024, hd = q >> 6, pp = q & 63;
                const int d = (pp & 4) ? 32 + 4 * (pp >> 3) + (pp & 3) : 4 * (pp >> 3) + (pp & 3);
                orig = 1304 + hd * 64 + d; }
            else if (cd < 5120) orig = cd - 2048 + 3352;
            else if (cd < 5144) orig = cd - 5120 + 1280;
            else if (cd < 5376) ok = false;
            else if (cd < 5504) orig = cd - 5376 + 896;
            else if (cd < 5632) orig = cd - 5504 + 1152;
            else orig = cd - 5632 + 2328;
        }
        float4 v = make_float4(0.f, 0.f, 0.f, 0.f);
        if (ok) v = *(const float4*)(src + (size_t)(k0 + kk) * ld_src + orig);
        tile[kk * 65 + c4 + 0] = v.x; tile[kk * 65 + c4 + 1] = v.y; tile[kk * 65 + c4 + 2] = v.z; tile[kk * 65 + c4 + 3] = v.w;
    }
    __syncthreads();
#pragma unroll
    for (int i = 0; i < 2; ++i) {
        const int q = tid + 256 * i, n = q >> 3, kc = q & 7;
        float v[8];
#pragma unroll
        for (int j = 0; j < 8; ++j) v[j] = tile[(kc * 8 + j) * 65 + n];
        u32x4 w; w.x = pack2(v[0], v[1]); w.y = pack2(v[2], v[3]); w.z = pack2(v[4], v[5]); w.w = pack2(v[6], v[7]);
        int drow = n0 + n; if (mode >= 2) drow = 8 * (drow >> 2) + (drow & 3) + (mode == 3 ? 4 : 0);
        *(u32x4*)(dst + (size_t)drow * kdst + k0 + kc * 8) = w;
    }
    __syncthreads();
}

__device__ void phase_pw(const Params& p, int layer, unsigned char* lds, int parts, int half) {
    const int bid = (blockIdx.x * 2 + half), nblk = (gridDim.x * 2), tid = (ltid() & 255);
    unsigned char* ws = launder(p.ws);
    constexpr int J0 = 16 * 104, J1 = 8 * 16, J2 = 256, J3 = 256, J4 = 2048, J5 = 2048, J6 = 2048, JT = J0 + J1 + J2 + J3 + J4 + J5 + J6;
    const int t_lo = (parts & 1) ? 0 : (parts & 2) ? J0 : J0 + J1 + J2 + J3;
    const int t_hi = (parts & 4) ? JT : (parts & 2) ? J0 + J1 + J2 + J3 : (parts & 1) ? J0 : 0;
    for (int t = t_lo + bid; t < t_hi; t += nblk) {
        int u = t;
        if (u < J0) { tcvt_tile(p.w_in + (size_t)layer * 1024 * DIN, DIN, (u % 16) * 64, (u / 16) * 64, 1, (bf16_t*)(ws + WS_WIN), 1024, lds, half); continue; }
        u -= J0;
        if (u < J1) { tcvt_tile(p.w_br_a + (size_t)layer * 512 * 1024, 1024, (u % 8) * 64, (u / 8) * 64, 0, (bf16_t*)(ws + WS_WA), 512, lds, half); continue; }
        u -= J1;
        if (u < J2) { tcvt_tile(p.w_br_b + (size_t)layer * 1024 * 1024, 1024, (u % 16) * 64, (u / 16) * 64, 0, (bf16_t*)(ws + WS_WB), 1024, lds, half); continue; }
        u -= J2;
        if (u < J3) { tcvt_tile(p.w_o + (size_t)layer * 1024 * 1024, 1024, (u % 16) * 64, (u / 16) * 64, 0, (bf16_t*)(ws + WS_WO), 1024, lds, half); continue; }
        u -= J3;
        if (u < J4 + J5) {
            const bool up = u >= J4; if (up) u -= J4;
            const int e = u / 128, v = u % 128;
            const float* src = (up ? p.w_up : p.w_gate) + ((size_t)layer * NE + e) * 1024 * 512;
            tcvt_tile(src, 512, (v % 16) * 64, (v / 16) * 64, up ? 3 : 2, (bf16_t*)(ws + WS_WG) + (size_t)e * 1024 * 1024, 1024, lds, half); continue;
        }
        u -= J4 + J5;
        { const int e = u / 128, v = u % 128;
          const float* src = p.w_down + ((size_t)layer * NE + e) * 512 * 1024;
          tcvt_tile(src, 1024, (v % 8) * 64, (v / 8) * 64, 0, (bf16_t*)(ws + WS_WD) + (size_t)e * 1024 * 512, 512, lds, half); }
    }
    if (parts & 1) {
    for (int t = bid; t < 64; t += nblk) {
        const int kv = t >> 5, kt = t & 31;
        tcvt_tile(p.cmp_w1 + ((size_t)layer * 2 + kv) * 2048 * 64, 64, kt * 64, 0, 0, (bf16_t*)(ws + WS_W1T) + (size_t)kv * 64 * 2048, 2048, lds, half);
    }
    if (bid >= nblk - 2) {
        const int kv = nblk - 1 - bid, n = tid & 63, part = tid >> 6;
        const float* w1 = p.cmp_w1 + ((size_t)layer * 2 + kv) * 2048 * 64; const float* pos = p.cmp_pos + ((size_t)layer * 2 + kv) * 2048;
        float a = 0.f;
        for (int k = part * 512; k < part * 512 + 512; ++k) a += pos[k] * w1[(size_t)k * 64 + n];
        float* red = (float*)lds;
        __syncthreads(); red[tid] = a; __syncthreads();
        if (tid < 64) ((float*)(ws + WS_B1))[kv * 64 + tid] = red[tid] + red[tid + 64] + red[tid + 128] + red[tid + 192];
        __syncthreads();
    }
    }
    if (parts & 8) {
        const float4* xs = (const float4*)p.x; u32x2* xb = (u32x2*)(ws + WS_XB);
        for (size_t i = (size_t)bid * HT + tid; i < (size_t)T_ * 1024 / 4; i += (size_t)nblk * HT) {
            float4 v = xs[i]; u32x2 w; w.x = pack2(v.x, v.y); w.y = pack2(v.z, v.w); xb[i] = w;
        }
        for (int n = bid * HT + tid; n < 8192; n += nblk * HT) {
            int bk;
            if (n < 16) bk = n;
            else { const int th[15] = {22, 30, 40, 54, 73, 99, 134, 182, 246, 332, 450, 609, 825, 1117, 1513}; bk = 16;
#pragma unroll
                for (int k = 0; k < 15; ++k) bk += (n >= th[k]) ? 1 : 0; }
            (ws + WS_BUCKET)[n] = (unsigned char)bk;
        }
        for (int i = bid * HT + tid; i < 8192 * 32; i += nblk * HT) {
            const int pos = i >> 5, d = i & 31;
            const float inv = powf(10000.f, -(float)d * 2.0f / 64.f);
            const float ang = (float)pos * inv;
            float sn, cs; sincosf(ang, &sn, &cs);
            ((float2*)(ws + WS_ROPE))[i] = make_float2(cs, sn);
        }
        if (bid == 0) for (int i = tid; i < 8192; i += HT) ((unsigned*)(ws + WS_CTL))[i] = 0u;
    }
}

__device__ __forceinline__ float fsig(float x) { return __builtin_amdgcn_rcpf(1.f + __builtin_amdgcn_exp2f(-1.4426950408889634f * x)); }
template <int KIND>
__device__ __forceinline__ void g1_epi(const f32x4 (&acc)[2][2][4][2], unsigned char* ws, int r0, int c0, int wr, int wc, int fr, int fq) {
#pragma unroll
    for (int ai = 0; ai < 2; ++ai)
#pragma unroll
        for (int m = 0; m < 4; ++m) {
            const int row = r0 + 128 * ai + 64 * wr + 16 * m + fr + vzero();
#pragma unroll
            for (int bj = 0; bj < 2; ++bj) {
                const int col = c0 + 128 * bj + 32 * wc + 8 * fq;
                f32x4 v0 = acc[ai][bj][m][0], v1 = acc[ai][bj][m][1];
                if (KIND == 5) {
                    const int b = col >> 13, sq = col & (S_ - 1);
                    bf16_t* dst;
                    if (row < C_VW) { const int c = row - C_VS; dst = (bf16_t*)(ws + WS_VST) + ((size_t)(b * 2 + (c >> 6)) * 64 + (c & 63)) * S_ + sq; }
                    else if (row < C_VR) { const int c = row - C_VW; dst = (bf16_t*)(ws + WS_VWT) + ((size_t)(b * 2 + (c >> 6)) * 64 + (c & 63)) * S_ + sq; }
                    else { const int c = row - C_VR; dst = (bf16_t*)(ws + WS_VRT) + ((size_t)(b * 8 + (c >> 7)) * 128 + (c & 127)) * S_ + sq; }
                    u32x4 w; w.x = pack2(v0[0], v0[1]); w.y = pack2(v0[2], v0[3]); w.z = pack2(v1[0], v1[1]); w.w = pack2(v1[2], v1[3]);
                    *(u32x4*)dst = w;
                    continue;
                }
                if (KIND == 1 || KIND == 2) {
                    const float2* rope = (const float2*)(ws + WS_ROPE);
                    const int pos = row & (S_ - 1), d = 16 * (wc & 1) + 4 * fq;
                    const float4 cs01 = *(const float4*)(rope + pos * 32 + d), cs23 = *(const float4*)(rope + pos * 32 + d + 2);
                    const float c[4] = {cs01.x, cs01.z, cs23.x, cs23.z}, sn[4] = {cs01.y, cs01.w, cs23.y, cs23.w};
                    const float sc = (KIND == 2) ? 0.125f : 1.0f;
                    f32x4 y1, y2;
#pragma unroll
                    for (int r = 0; r < 4; ++r) { y1[r] = (v0[r] * c[r] - v1[r] * sn[r]) * sc; y2[r] = (v0[r] * sn[r] + v1[r] * c[r]) * sc; }
                    v0 = y1; v1 = y2;
                } else if (KIND == 3) {
#pragma unroll
                    for (int r = 0; r < 4; ++r) { v0[r] = v0[r] * fsig(v0[r]); v1[r] = v1[r] * fsig(v1[r]); }
                } else if (KIND == 4) {
#pragma unroll
                    for (int r = 0; r < 4; ++r) { v0[r] = fsig(v0[r]); v1[r] = fsig(v1[r]); }
                }
                u32x4 w; w.x = pack2(v0[0], v0[1]); w.y = pack2(v0[2], v0[3]); w.z = pack2(v1[0], v1[1]); w.w = pack2(v1[2], v1[3]);
                *(u32x4*)((bf16_t*)(ws + WS_P) + (size_t)row * LD + col) = w;
            }
        }
}
struct G1Order {      typedef pg8::Unit U; static constexpr bool GATHER = false;
    int xcd, slot, per;
    __device__ __forceinline__ bool next(int i, pg8::Unit& u) const {
        const int j = slot + i * per; if (j >= 208) return false;
        if (j < 192) { u.pm = j / 3; u.pn = xcd + 8 * (j % 3); } else { const int q = j - 192; u.pm = 8 * xcd + (q >> 1); u.pn = 24 + (q & 1); }
        return true;
    }
    __device__ __forceinline__ void ptrs(const pg8::Unit& u, unsigned& A, unsigned& B) const {
        const unsigned x = (unsigned)WS_XB + (unsigned)u.pm * (256u * 1024u * 2u), w = (unsigned)WS_WIN + (unsigned)u.pn * (256u * 1024u * 2u);
        if (u.pn >= 21) { A = w; B = x; } else { A = x; B = w; }
    }
};
struct G1Epi {
    unsigned char* ws;
    __device__ __forceinline__ void operator()(const f32x4 (&acc)[2][2][4][2], const pg8::Unit& u, int wr, int wc, int fr, int fq) const {
        const int pn = u.pn, tok0 = u.pm * 256, n0 = pn * 256;
        if (pn >= 21) g1_epi<5>(acc, ws, n0, tok0, wr, wc, fr, fq);
        else if (pn >= 12) g1_epi<4>(acc, ws, tok0, n0, wr, wc, fr, fq);
        else if (pn >= 8) g1_epi<3>(acc, ws, tok0, n0, wr, wc, fr, fq);
        else if (pn >= 6) g1_epi<2>(acc, ws, tok0, n0, wr, wc, fr, fq);
        else if (pn >= 4) g1_epi<1>(acc, ws, tok0, n0, wr, wc, fr, fq);
        else g1_epi<0>(acc, ws, tok0, n0, wr, wc, fr, fq);
    }
};
__device__ void phase_g1(const Params& p, int layer, unsigned char* lds) {
    unsigned char* ws = launder(p.ws);
    G1Order S; S.xcd = blockIdx.x & 7; S.slot = blockIdx.x >> 3; S.per = gridDim.x >> 3;
    G1Epi E; E.ws = ws;
    pg8::gemm_phase<G1Epi, G1Order>(lds, 1024, S, E, ltid(), ws);
}

__device__ __forceinline__ void load_tile64(const bf16_t* base, size_t rowStride, unsigned char* dst, int wid, int lane) {
    const int c = ((lane & 7) ^ (lane >> 3)) * 8;
#pragma unroll
    for (int i = 0; i < 2; ++i) { const int j = wid + 4 * i, row = 8 * j + (lane >> 3); glds16(base + (size_t)row * rowStride + c, dst + j * 1024); }
}
__device__ __forceinline__ void load_tile128(const bf16_t* base, size_t rowStride, unsigned char* dst, int wid, int lane) {
    const int c = ((lane & 7) ^ (lane >> 3)) * 8;
#pragma unroll
    for (int i = 0; i < 4; ++i) { const int j = wid + 4 * i, row = 8 * j + (lane >> 3); glds16(base + (size_t)row * rowStride + c, dst + j * 1024); }
}
__device__ __forceinline__ void load_tile128w(const bf16_t* base, size_t rowStride, unsigned char* dst, int wid, int lane) {
    const int c = ((lane & 15) ^ ((4 * wid + (lane >> 4)) & 15)) * 8;
#pragma unroll
    for (int i = 0; i < 8; ++i) { const int j = wid + 4 * i, row = 4 * j + (lane >> 4); glds16(base + (size_t)row * rowStride + c, dst + j * 1024); }
}
__device__ __forceinline__ bf16x8 lds_frag128(const unsigned char* tile, int row, int chunk) {
    return *(const bf16x8*)(tile + row * 128 + ((chunk ^ (row & 7)) << 4));
}
__device__ __forceinline__ bf16x8 lds_frag256(const unsigned char* tile, int row, int chunk) {
    return *(const bf16x8*)(tile + row * 256 + ((chunk ^ (row & 15)) << 4));
}
__device__ __forceinline__ bf16x8 lds_vfrag128(const unsigned char* tile, int row, int kbase, int fq) {
    const int ca = (kbase >> 3) + (fq >> 1), hb = (fq & 1) * 8;
    const u32x2 a = *(const u32x2*)(tile + row * 128 + ((ca ^ (row & 7)) << 4) + hb);
    const u32x2 b = *(const u32x2*)(tile + row * 128 + (((ca + 2) ^ (row & 7)) << 4) + hb);
    u32x4 w; w.x = a.x; w.y = a.y; w.z = b.x; w.w = b.y;
    return __builtin_bit_cast(bf16x8, w);
}
__device__ __forceinline__ bf16x8 lds_vfrag256(const unsigned char* tile, int row, int kbase, int fq) {
    const int ca = (kbase >> 3) + (fq >> 1), hb = (fq & 1) * 8;
    const u32x2 a = *(const u32x2*)(tile + row * 256 + ((ca ^ (row & 15)) << 4) + hb);
    const u32x2 b = *(const u32x2*)(tile + row * 256 + (((ca + 2) ^ (row & 15)) << 4) + hb);
    u32x4 w; w.x = a.x; w.y = a.y; w.z = b.x; w.w = b.y;
    return __builtin_bit_cast(bf16x8, w);
}
__device__ __forceinline__ bf16x8 pack8(f32x4 a, f32x4 b) {
    u32x4 w; w.x = pack2(a[0], a[1]); w.y = pack2(a[2], a[3]); w.z = pack2(b[0], b[1]); w.w = pack2(b[2], b[3]);
    return __builtin_bit_cast(bf16x8, w);
}

__device__ __forceinline__ float gelu_tanh(float x) {
    const float u = 0.7978845608028654f * (x + 0.044715f * x * x * x);
    return 0.5f * x * (1.f + tanhf(u));
}
__device__ void compress_item(const Params& p, int layer, int item, unsigned char* lds, int half) {
    unsigned char* ws = launder(p.ws);
    const int tid = (ltid() & 255), lane = tid & 63, wid = tid >> 6, wr = wid >> 1, wc = wid & 1, fr = lane & 15, fq = lane >> 4;
    const int mtile = item & 3, g = (item >> 2) & 1, b = (item >> 3) & 1, kv = item >> 4;
    const int i0 = mtile * 128;
    const bf16_t* P = (const bf16_t*)(ws + WS_P);
    const bf16_t* W1T = (const bf16_t*)(ws + WS_W1T) + (size_t)kv * 64 * 2048;
    const int col = (kv ? C_VC : C_KC) + g * 64;
    const int ldc = ((lane & 7) ^ (lane >> 3)) * 8;
    const bf16_t* ap[4];
#pragma unroll
    for (int i = 0; i < 4; ++i) ap[i] = P + ((size_t)b * S_ + 16 * (i0 + 32 * i + 8 * wid + (lane >> 3))) * LD + col + ldc;
    const bf16_t* bp[2];
#pragma unroll
    for (int i = 0; i < 2; ++i) bp[i] = W1T + (size_t)(8 * (wid + 4 * i) + (lane >> 3)) * 2048 + ldc;
    f32x4 acc[4][2];
#pragma unroll
    for (int i = 0; i < 4; ++i)
#pragma unroll
        for (int j = 0; j < 2; ++j) acc[i][j] = (f32x4){0.f, 0.f, 0.f, 0.f};
    __syncthreads();
#define CSTAGE(buf, l) do { unsigned char* st_ = lds + (buf) * 24576; \
        _Pragma("unroll") for (int i = 0; i < 4; ++i) glds16(ap[i] + (size_t)(l) * LD, st_ + (4 * i + wid) * 1024); \
        _Pragma("unroll") for (int i = 0; i < 2; ++i) glds16(bp[i] + (l) * 64, st_ + 16384 + (wid + 4 * i) * 1024); } while (0)
    CSTAGE(0, 0); wait_vm0(); __syncthreads();
    for (int l = 0; l < 32; ++l) {
        const unsigned char* st = lds + (l & 1) * 24576;
        if (l + 1 < 32) CSTAGE((l + 1) & 1, l + 1);
#pragma unroll
        for (int ks = 0; ks < 2; ++ks) {
            bf16x8 a[4], bb[2];
#pragma unroll
            for (int i = 0; i < 4; ++i) a[i] = lds_frag128(st, 64 * wr + 16 * i + fr, 4 * ks + fq);
#pragma unroll
            for (int j = 0; j < 2; ++j) bb[j] = lds_frag128(st + 16384, 32 * wc + 16 * j + fr, 4 * ks + fq);
#pragma unroll
            for (int i = 0; i < 4; ++i)
#pragma unroll
                for (int j = 0; j < 2; ++j) acc[i][j] = mfma16(a[i], bb[j], acc[i][j]);
        }
        wait_vm0(); __syncthreads();
    }
#undef CSTAGE
    float* hid = (float*)lds;
    const float* b1 = (const float*)(ws + WS_B1) + kv * 64;
#pragma unroll
    for (int j = 0; j < 2; ++j) {
        const int n = 32 * wc + 16 * j + fr; const float bias = b1[n + vzero()];
#pragma unroll
        for (int i = 0; i < 4; ++i)
#pragma unroll
            for (int r = 0; r < 4; ++r) hid[(64 * wr + 16 * i + 4 * fq + r) * 65 + n] = gelu_tanh(acc[i][j][r] + bias);
    }
    __syncthreads();
    {
        const int row = tid >> 1, nb = (tid & 1) * 32, ci = i0 + row;
        const float* w2 = p.cmp_w2 + ((size_t)layer * 2 + kv) * 64 * 64;
        float o[32];
#pragma unroll
        for (int q = 0; q < 32; ++q) o[q] = 0.f;
        for (int n = 0; n < 64; ++n) {
            const float h = hid[row * 65 + n];
#pragma unroll
            for (int q4 = 0; q4 < 8; ++q4) { const float4 w = *(const float4*)(w2 + n * 64 + nb + 4 * q4); o[4 * q4] += h * w.x; o[4 * q4 + 1] += h * w.y; o[4 * q4 + 2] += h * w.z; o[4 * q4 + 3] += h * w.w; }
        }
        if (kv == 0) {
            bf16_t* dst = (bf16_t*)(ws + WS_KCC) + ((size_t)(b * 2 + g) * 512 + ci) * 64 + nb;
#pragma unroll
            for (int q = 0; q < 32; q += 4) { f32x4 v = {o[q], o[q + 1], o[q + 2], o[q + 3]}; if (ci >= 511) v = (f32x4){0.f, 0.f, 0.f, 0.f}; *(u32x2*)(dst + q) = pack4(v); }
        } else {
            bf16_t* dst = (bf16_t*)(ws + WS_VCCT) + ((size_t)(b * 2 + g) * 64 + nb) * 512 + ci;
#pragma unroll
            for (int q = 0; q < 32; ++q) dst[(size_t)q * 512] = f2bf(ci >= 511 ? 0.f : o[q]);
        }
    }
    __syncthreads();
}

__device__ __forceinline__ float ret_lg2(int h) { const float gam = 1.f - exp2f(-5.f - (float)h); return log2f(gam); }

__device__ void retkv_item(const Params& p, int item, unsigned char* lds, int half) {
    unsigned char* ws = launder(p.ws);
    const int tid = (ltid() & 255), lane = tid & 63, wid = tid >> 6, fr = lane & 15, fq = lane >> 4;
    const int n = item & 63, h = (item >> 6) & 7, b = item >> 9;
    const size_t tok0 = (size_t)b * S_ + 128 * n;
    unsigned char* vL = lds; unsigned char* kL = lds + 32768;
    load_tile128w((const bf16_t*)(ws + WS_VRT) + ((size_t)(b * 8 + h) * 128) * S_ + 128 * n, S_, vL, wid, lane);
    load_tile128((const bf16_t*)(ws + WS_P) + tok0 * LD + C_KR + h * 64, LD, kL, wid, lane);
    wait_vm0(); __syncthreads();
    const float lg2 = ret_lg2(h);
    f32x4 acc[2][4];
#pragma unroll
    for (int m = 0; m < 2; ++m)
#pragma unroll
        for (int nt = 0; nt < 4; ++nt) acc[m][nt] = (f32x4){0.f, 0.f, 0.f, 0.f};
#pragma unroll
    for (int ks = 0; ks < 4; ++ks) {
        bf16x8 a[2], bb[4];
#pragma unroll
        for (int m = 0; m < 2; ++m) a[m] = lds_frag256(vL, 32 * wid + 16 * m + fr, 4 * ks + fq);
        float dec[8];
#pragma unroll
        for (int j = 0; j < 8; ++j) dec[j] = exp2f((float)(127 - (32 * ks + 8 * fq + j)) * lg2);
#pragma unroll
        for (int nt = 0; nt < 4; ++nt) {
            const int d = 16 * nt + fr;
            float v[8];
#pragma unroll
            for (int j = 0; j < 8; ++j) {
                const int tk = 32 * ks + 8 * fq + j;
                const bf16_t kvv = *(const bf16_t*)(kL + tk * 128 + (((d >> 3) ^ (tk & 7)) << 4) + (d & 7) * 2);
                v[j] = bf2f(kvv) * dec[j];
            }
            u32x4 w; w.x = pack2(v[0], v[1]); w.y = pack2(v[2], v[3]); w.z = pack2(v[4], v[5]); w.w = pack2(v[6], v[7]);
            bb[nt] = __builtin_bit_cast(bf16x8, w);
        }
#pragma unroll
        for (int m = 0; m < 2; ++m)
#pragma unroll
            for (int nt = 0; nt < 4; ++nt) acc[m][nt] = mfma16(a[m], bb[nt], acc[m][nt]);
    }
    float* KVT = (float*)(ws + WS_KVT) + ((size_t)(b * 8 + h) * 64 + n) * 8192;
#pragma unroll
    for (int m = 0; m < 2; ++m)
#pragma unroll
        for (int nt = 0; nt < 4; ++nt)
#pragma unroll
            for (int r = 0; r < 4; ++r) KVT[(32 * wid + 16 * m + 4 * fq + r) * 64 + 16 * nt + fr] = acc[m][nt][r];
    __syncthreads();
}

__device__ void phase_p2(const Params& p, int layer, unsigned char* lds, int half) {
    for (int it = (blockIdx.x * 2 + half); it < 1024 + 32; it += (gridDim.x * 2)) {
        if (it < 32) compress_item(p, layer, it, lds, half); else retkv_item(p, it - 32, lds, half);
    }
}

constexpr int NSA_IMP = 32768, NSA_BUCKET = 65792, NSA_BIAS = 73984;

struct NsaLane { int t; int fr, fq, wid, lane; };

template <int BR, int PASS>
__device__ __forceinline__ void nsa_half(const unsigned char* kL, const unsigned char* vL, const unsigned char* lds, const bf16_t* qptr,
                                         f32x4 (&O)[4][4], float (&m)[4], float (&l)[4], int tile, int hf, bool selbit, const NsaLane& L, int qrow) {
    const int fr = L.fr, fq = L.fq;
    bf16x8 Kf[2][2];
#pragma unroll
    for (int i = 0; i < 2; ++i)
#pragma unroll
        for (int ks = 0; ks < 2; ++ks) Kf[i][ks] = lds_frag128(kL, 32 * hf + 16 * i + fr, 4 * ks + fq);
    unsigned vmask = 0; unsigned bk[2];
    const unsigned char* bucketL = lds + NSA_BUCKET;
#pragma unroll
    for (int i = 0; i < 2; ++i) {
        unsigned pk = 0;
#pragma unroll
        for (int r = 0; r < 4; ++r) {
            const int kk = 32 * hf + 16 * i + 4 * fq + r;
            int rel; bool ok;
            if (BR == 0) { rel = L.t - (16 * (64 * tile + kk) + 31); ok = rel >= 0; }
            else if (BR == 1) { rel = L.t - (64 * tile + kk); ok = selbit && rel >= 0; }
            else { rel = L.t - (64 * tile + kk); ok = rel >= 0 && rel < 512; }
            int rc = rel < 0 ? 0 : rel; rc = rc > 8191 ? 8191 : rc;
            pk |= (unsigned)bucketL[rc] << (8 * r);
            vmask |= (ok ? 1u : 0u) << (4 * i + r);
        }
        bk[i] = pk;
    }
    const float* biasL = (const float*)(lds + NSA_BIAS);
    float ia[2] = {0.f, 0.f}, ic[2] = {0.f, 0.f};
#pragma unroll
    for (int nt = 0; nt < 4; ++nt) {
        asm volatile("" ::: "memory");
        f32x4 S[2];
        const bf16x8 q0 = *(const bf16x8*)(qptr + nt * 64), q1 = *(const bf16x8*)(qptr + nt * 64 + 32);
#pragma unroll
        for (int i = 0; i < 2; ++i) {
            S[i] = (f32x4){0.f, 0.f, 0.f, 0.f};
            S[i] = mfma16(Kf[i][0], q0, S[i]); S[i] = mfma16(Kf[i][1], q1, S[i]);
        }
        float tmax = -1e30f;
        float bsv[2][4];
#pragma unroll
        for (int i = 0; i < 2; ++i)
#pragma unroll
            for (int r = 0; r < 4; ++r) { bsv[i][r] = biasL[nt * 32 + ((bk[i] >> (8 * r)) & 0xffu)]; asm volatile("" : "+v"(bsv[i][r])); }
#pragma unroll
        for (int i = 0; i < 2; ++i)
#pragma unroll
            for (int r = 0; r < 4; ++r) {
                const bool ok = (vmask >> (4 * i + r)) & 1u;
                const float sv = S[i][r] * 0.125f + bsv[i][r];
                S[i][r] = ok ? sv : -1e30f; tmax = fmaxf(tmax, S[i][r]);
            }
        if (PASS != 1) {
            tmax = rows_max(tmax);
            const float mnew = fmaxf(m[nt], tmax), alpha = __expf(m[nt] - mnew);
            float psum = 0.f;
#pragma unroll
            for (int i = 0; i < 2; ++i)
#pragma unroll
                for (int r = 0; r < 4; ++r) {
                    const bool ok = (vmask >> (4 * i + r)) & 1u;
                    const float pv = ok ? __expf(S[i][r] - mnew) : 0.f;
                    S[i][r] = pv; psum += pv;
                }
            psum = rows_sum(psum);
            l[nt] = l[nt] * alpha + psum; m[nt] = mnew;
            if (PASS == 2) {
#pragma unroll
                for (int mt = 0; mt < 4; ++mt) O[mt][nt] = O[mt][nt] * alpha;
            }
        } else {
#pragma unroll
            for (int i = 0; i < 2; ++i) {
#pragma unroll
                for (int r = 0; r < 4; ++r) {
                    const bool ok = (vmask >> (4 * i + r)) & 1u;
                    S[i][r] = ok ? __expf(S[i][r] - m[nt]) * l[nt] : 0.f;
                }
                ia[i] += S[i][0] + S[i][1] + S[i][2] + 0.5f * S[i][3];
                ic[i] += 0.5f * S[i][3];
            }
        }
        if (PASS != 0) {
            const bf16x8 Pb = pack8(S[0], S[1]);
#pragma unroll
            for (int mt = 0; mt < 4; ++mt) O[mt][nt] = mfma16(lds_vfrag128(vL, 16 * mt + fr, 32 * hf, fq), Pb, O[mt][nt]);
        }
    }
    if (PASS == 1) {
        float* imp = (float*)(lds + NSA_IMP) + qrow * 129;
        asm volatile("" ::: "memory"); __builtin_amdgcn_wave_barrier();
#pragma unroll
        for (int i = 0; i < 2; ++i) { const int j = 16 * tile + 8 * hf + 4 * i + fq; imp[j] += ia[i]; }
        asm volatile("s_waitcnt lgkmcnt(0)" ::: "memory"); __builtin_amdgcn_wave_barrier();
#pragma unroll
        for (int i = 0; i < 2; ++i) { const int j = 16 * tile + 8 * hf + 4 * i + fq + 1; if (j < 128) imp[j] += ic[i]; }
        asm volatile("s_waitcnt lgkmcnt(0)" ::: "memory"); __builtin_amdgcn_wave_barrier();
    }
}
template <int BR, int PASS>
__device__ __forceinline__ void nsa_tile(const unsigned char* kL, const unsigned char* vL, const unsigned char* lds, const bf16_t* qptr,
                                         f32x4 (&O)[4][4], float (&m)[4], float (&l)[4], int tile, bool selbit, const NsaLane& L, int qrow) {
#pragma unroll 1
    for (int hf = 0; hf < 2; ++hf) nsa_half<BR, PASS>(kL, vL, lds, qptr, O, m, l, tile, hf, selbit, L, qrow);
}

__device__ void cmp_item(const Params& p, int item, unsigned char* lds, int half) {
    unsigned char* ws = launder(p.ws);
    const int tid = (ltid() & 255), lane = tid & 63, wid = tid >> 6, fr = lane & 15, fq = lane >> 4;
    const int combo = item & 3, qt = 127 - (item >> 2), b = combo >> 1, g = combo & 1;
    const int q0 = qt * 64, qrow = 16 * wid + fr;
    NsaLane L; L.t = q0 + qrow; L.fr = fr; L.fq = fq; L.wid = wid; L.lane = lane;
    const size_t tok = (size_t)b * S_ + L.t;
    const bf16_t* P = (const bf16_t*)(ws + WS_P);
    __syncthreads();
    if (tid < 128) ((float*)(lds + NSA_BIAS))[tid] = p.rel_bias[(tid & 31) * 8 + 4 * g + (tid >> 5)];
    for (int i = tid; i < 64 * 129; i += HT) ((float*)(lds + NSA_IMP))[i] = 0.f;
    const bf16_t* Qf = P + tok * LD + C_QA + (4 * g) * 64 + 8 * fq;
    __syncthreads();
    f32x4 O[4][4]; float m[4], l[4];
    const bf16_t* gates = P + tok * LD + C_GA + (4 * g) * 3;
    const bf16_t* kc = (const bf16_t*)(ws + WS_KCC) + (size_t)(b * 2 + g) * 512 * 64;
    const bf16_t* vc = (const bf16_t*)(ws + WS_VCCT) + (size_t)(b * 2 + g) * 64 * 512;
    const int ntc = ((q0 + 32) >> 4) / 64 + 1;
#pragma unroll
    for (int nt = 0; nt < 4; ++nt) { m[nt] = -1e30f; l[nt] = 0.f; }
    load_tile64(kc, 64, lds, wid, lane);
    wait_vm0(); __syncthreads();
    for (int it = 0; it < ntc; ++it) {
        unsigned char* cur = lds + (it & 1) * 16384;
        if (it + 1 < ntc) load_tile64(kc + (size_t)(it + 1) * 64 * 64, 64, lds + ((it + 1) & 1) * 16384, wid, lane);
        nsa_tile<0, 0>(cur, cur + 8192, lds, Qf, O, m, l, it, true, L, qrow);
        wait_vm0(); __syncthreads();
    }
#pragma unroll
    for (int nt = 0; nt < 4; ++nt) l[nt] = l[nt] > 0.f ? 1.f / l[nt] : 0.f;
#pragma unroll
    for (int mt = 0; mt < 4; ++mt)
#pragma unroll
        for (int nt = 0; nt < 4; ++nt) O[mt][nt] = (f32x4){0.f, 0.f, 0.f, 0.f};
    load_tile64(kc, 64, lds, wid, lane); load_tile64(vc, 512, lds + 8192, wid, lane);
    wait_vm0(); __syncthreads();
    for (int it = 0; it < ntc; ++it) {
        unsigned char* cur = lds + (it & 1) * 16384;
        if (it + 1 < ntc) { unsigned char* nx = lds + ((it + 1) & 1) * 16384;
            load_tile64(kc + (size_t)(it + 1) * 64 * 64, 64, nx, wid, lane); load_tile64(vc + (it + 1) * 64, 512, nx + 8192, wid, lane); }
        nsa_tile<0, 1>(cur, cur + 8192, lds, Qf, O, m, l, it, true, L, qrow);
        wait_vm0(); __syncthreads();
    }
    bf16_t* YC = (bf16_t*)(ws + WS_YC) + tok * 512 + (4 * g) * 64;
#pragma unroll
    for (int nt = 0; nt < 4; ++nt) {
        const float gt = bf2f(gates[nt * 3 + 0]);
#pragma unroll
        for (int mt = 0; mt < 4; ++mt) *(u32x2*)(YC + nt * 64 + 16 * mt + 4 * fq) = pack4(O[mt][nt] * gt);
    }
    const int cur = qt;
    {
        float* imp = (float*)(lds + NSA_IMP) + qrow * 129 + 32 * fq;
        asm volatile("s_waitcnt lgkmcnt(0)" ::: "memory"); __builtin_amdgcn_wave_barrier();
#pragma unroll
        for (int i = 0; i < 32; ++i) {
            const int j = 32 * fq + i;
            const float v = imp[i];
            imp[i] = j > cur ? -1.f : v + ((j == 0 || j == cur || j == cur - 1) ? 1.0e4f : 0.f);
        }
        unsigned word = 0;
#pragma unroll 1
        for (int round = 0; round < 16; ++round) {
            float bv = imp[0]; int bi = 0;
#pragma unroll
            for (int i = 1; i < 32; ++i) { const float v = imp[i]; if (v > bv) { bv = v; bi = i; } }
            int gi = 32 * fq + bi;
            {
                u32x2 rv = __builtin_amdgcn_permlane16_swap(__float_as_uint(bv), __float_as_uint(bv), false, false);
                u32x2 ri = __builtin_amdgcn_permlane16_swap((unsigned)gi, (unsigned)gi, false, false);
                float v0 = __uint_as_float(rv.x), v1 = __uint_as_float(rv.y); int i0 = (int)ri.x, i1 = (int)ri.y;
                if (v1 > v0 || (v1 == v0 && i1 < i0)) { v0 = v1; i0 = i1; }
                rv = __builtin_amdgcn_permlane32_swap(__float_as_uint(v0), __float_as_uint(v0), false, false);
                ri = __builtin_amdgcn_permlane32_swap((unsigned)i0, (unsigned)i0, false, false);
                v0 = __uint_as_float(rv.x); v1 = __uint_as_float(rv.y); i0 = (int)ri.x; i1 = (int)ri.y;
                if (v1 > v0 || (v1 == v0 && i1 < i0)) { v0 = v1; i0 = i1; }
                bv = v0; gi = i0;
            }
            if (bv >= 0.f && (gi >> 5) == fq) { word |= 1u << (gi & 31); imp[gi & 31] = -2.f; }
        }
        ((unsigned*)(ws + WS_SELW))[(tok * 2 + g) * 4 + fq] = word;
    }
}

__device__ void win_item(const Params& p, int item, unsigned char* lds, int half) {
    unsigned char* ws = launder(p.ws);
    const int tid = (ltid() & 255), lane = tid & 63, wid = tid >> 6, fr = lane & 15, fq = lane >> 4;
    const int combo = item & 3, qt = 127 - (item >> 2), b = combo >> 1, g = combo & 1;
    const int q0 = qt * 64, qrow = 16 * wid + fr;
    NsaLane L; L.t = q0 + qrow; L.fr = fr; L.fq = fq; L.wid = wid; L.lane = lane;
    const size_t tok = (size_t)b * S_ + L.t;
    const bf16_t* P = (const bf16_t*)(ws + WS_P);
    __syncthreads();
    if (tid < 128) ((float*)(lds + NSA_BIAS))[tid] = p.rel_bias[(tid & 31) * 8 + 4 * g + (tid >> 5)];
    const bf16_t* Qf = P + tok * LD + C_QA + (4 * g) * 64 + 8 * fq;
    __syncthreads();
    f32x4 O[4][4]; float m[4], l[4];
    const bf16_t* gates = P + tok * LD + C_GA + (4 * g) * 3;
#pragma unroll
    for (int nt = 0; nt < 4; ++nt) { m[nt] = -1e30f; l[nt] = 0.f; }
#pragma unroll
    for (int mt = 0; mt < 4; ++mt)
#pragma unroll
        for (int nt = 0; nt < 4; ++nt) O[mt][nt] = (f32x4){0.f, 0.f, 0.f, 0.f};
    {
        const bf16_t* kb = P + ((size_t)b * S_) * LD + C_KW + g * 64;
        const bf16_t* vb = (const bf16_t*)(ws + WS_VWT) + (size_t)(b * 2 + g) * 64 * S_;
        const int k_lo = qt - 8 > 0 ? qt - 8 : 0, ntw = qt - k_lo + 1;
        load_tile64(kb + (size_t)k_lo * 64 * LD, LD, lds, wid, lane); load_tile64(vb + k_lo * 64, S_, lds + 8192, wid, lane);
        wait_vm0(); __syncthreads();
        for (int it = 0; it < ntw; ++it) {
            unsigned char* cu = lds + (it & 1) * 16384;
            if (it + 1 < ntw) { unsigned char* nx = lds + ((it + 1) & 1) * 16384;
                load_tile64(kb + (size_t)(k_lo + it + 1) * 64 * LD, LD, nx, wid, lane); load_tile64(vb + (k_lo + it + 1) * 64, S_, nx + 8192, wid, lane); }
            nsa_tile<2, 2>(cu, cu + 8192, lds, Qf, O, m, l, k_lo + it, true, L, qrow);
            wait_vm0(); __syncthreads();
        }
    }
    bf16_t* YW = (bf16_t*)(ws + WS_YW) + tok * 512 + (4 * g) * 64;
#pragma unroll
    for (int nt = 0; nt < 4; ++nt) {
        const float gt = bf2f(gates[nt * 3 + 2]) * (l[nt] > 0.f ? 1.f / l[nt] : 0.f);
#pragma unroll
        for (int mt = 0; mt < 4; ++mt) *(u32x2*)(YW + nt * 64 + 16 * mt + 4 * fq) = pack4(O[mt][nt] * gt);
    }
}

constexpr int SEL_BIAS2 = NSA_BIAS;
constexpr float LOG2E = 1.4426950408889634f;
__device__ __forceinline__ int t5_first(int bk) {
    const int th[16] = {16, 22, 30, 40, 54, 73, 99, 134, 182, 246, 332, 450, 609, 825, 1117, 1513};
    int r = 16;
#pragma unroll
    for (int k = 0; k < 16; ++k) r = (bk == 16 + k) ? th[k] : r;
    return r;
}
template <bool FAST>
__device__ __forceinline__ void sel_ntile(const bf16x8 (&Kf)[4][2], const bf16x8 (&Vf)[4][2], const bf16x8& q0, const bf16x8& q1, f32x4 (&O)[4], float& m, float& l,
                                          bool sb, int relb, int th, float blo, float bhi, const unsigned char* lds, int hl) {
    f32x4 S[4];
#pragma unroll
    for (int i = 0; i < 4; ++i) { S[i] = (f32x4){0.f, 0.f, 0.f, 0.f}; S[i] = mfma16(Kf[i][0], q0, S[i]); S[i] = mfma16(Kf[i][1], q1, S[i]); }
    float tmax = -1e30f;
    const float scl = (!FAST || sb) ? 0.125f * LOG2E : 0.f;
    if (FAST) { blo = (sb ? blo : -1e30f) - m; bhi = (sb ? bhi : -1e30f) - m; }
    if (FAST) {
#pragma unroll
        for (int i = 0; i < 4; ++i)
#pragma unroll
            for (int r = 0; r < 4; ++r) { const int rel = relb - (16 * i + r); S[i][r] = S[i][r] * scl + (rel >= th ? bhi : blo); tmax = fmaxf(tmax, S[i][r]); }
    } else {
        unsigned bkt[4][4]; float bs[4][4];
#pragma unroll
        for (int i = 0; i < 4; ++i)
#pragma unroll
            for (int r = 0; r < 4; ++r) { const int rel = relb - (16 * i + r); int rc = rel < 0 ? 0 : rel; rc = rc > 8191 ? 8191 : rc; bkt[i][r] = (lds + NSA_BUCKET)[rc]; }
#pragma unroll
        for (int i = 0; i < 4; ++i)
#pragma unroll
            for (int r = 0; r < 4; ++r) { bs[i][r] = ((const float*)(lds + SEL_BIAS2))[hl * 32 + bkt[i][r]]; asm volatile("" : "+v"(bs[i][r])); }
        const float ninf = -1e30f;
#pragma unroll
        for (int i = 0; i < 4; ++i)
#pragma unroll
            for (int r = 0; r < 4; ++r) {
                const int rel = relb - (16 * i + r);
                const float sv = S[i][r] * (0.125f * LOG2E) + (bs[i][r] - m);
                S[i][r] = (sb && rel >= 0) ? sv : ninf; tmax = fmaxf(tmax, S[i][r]);
            }
    }
    tmax = rows_max(tmax);
    if (__ballot(tmax > 8.f) != 0ull) {
        const float d = fmaxf(tmax, 0.f), alpha = __builtin_amdgcn_exp2f(-d);
        m += d; l *= alpha;
#pragma unroll
        for (int mt = 0; mt < 4; ++mt) O[mt] = O[mt] * alpha;
#pragma unroll
        for (int i = 0; i < 4; ++i)
#pragma unroll
            for (int r = 0; r < 4; ++r) S[i][r] -= d;
    }
    float psum = 0.f;
#pragma unroll
    for (int i = 0; i < 4; ++i)
#pragma unroll
        for (int r = 0; r < 4; ++r) { const float pv = __builtin_amdgcn_exp2f(S[i][r]); S[i][r] = pv; psum += pv; }
    l += rows_sum(psum);
    const bf16x8 Pb0 = pack8(S[0], S[1]), Pb1 = pack8(S[2], S[3]);
#pragma unroll
    for (int mt = 0; mt < 4; ++mt) { O[mt] = mfma16(Vf[mt][0], Pb0, O[mt]); O[mt] = mfma16(Vf[mt][1], Pb1, O[mt]); }
}
template <bool FAST>
__device__ __forceinline__ void sel_tile(const unsigned char* kL, const unsigned char* vL, const unsigned char* lds, const bf16x8 (&Qf)[2][2], f32x4 (&O)[2][4], float (&m)[2], float (&l)[2],
                                         const bool (&sb)[2], const bool (&need)[2], const int (&relb)[2], int th, float blo, float bhi, int hl, int fr, int fq) {
    bf16x8 Kf[4][2], Vf[4][2];
#pragma unroll
    for (int i = 0; i < 4; ++i)
#pragma unroll
        for (int ks = 0; ks < 2; ++ks) Kf[i][ks] = lds_frag128(kL, 16 * i + fr, 4 * ks + fq);
#pragma unroll
    for (int mt = 0; mt < 4; ++mt)
#pragma unroll
        for (int hf = 0; hf < 2; ++hf) Vf[mt][hf] = lds_vfrag128(vL, 16 * mt + fr, 32 * hf, fq);
    if (need[0]) sel_ntile<FAST>(Kf, Vf, Qf[0][0], Qf[0][1], O[0], m[0], l[0], sb[0], relb[0], th, blo, bhi, lds, hl);
    if (need[1]) sel_ntile<FAST>(Kf, Vf, Qf[1][0], Qf[1][1], O[1], m[1], l[1], sb[1], relb[1], th, blo, bhi, lds, hl);
}
template <int VAR>
__device__ void sel_item(const Params& p, int v, unsigned char* lds, int half) {
    unsigned char* ws = launder(p.ws);
    const int tid = (ltid() & 255), lane = tid & 63, wid = tid >> 6, fr = lane & 15, fq = lane >> 4;
    const int qt = 127 - (v >> 3), sub = v & 7, b = sub >> 2, g = (sub >> 1) & 1, qh = sub & 1;
    const int q0 = qt * 64 + 32 * qh, cur = qt, hl = fr & 3;
    const bf16_t* P = (const bf16_t*)(ws + WS_P);
    __syncthreads();
    if (tid < 128) ((float*)(lds + SEL_BIAS2))[tid] = p.rel_bias[(tid & 31) * 8 + 4 * g + (tid >> 5)] * LOG2E;
    int t[2]; size_t tok[2]; bf16x8 Qf[2][2]; unsigned selw[2][4];
#pragma unroll
    for (int nt = 0; nt < 2; ++nt) {
        t[nt] = q0 + 8 * wid + 4 * nt + (fr >> 2); tok[nt] = (size_t)b * S_ + t[nt];
#pragma unroll
        for (int ks = 0; ks < 2; ++ks) Qf[nt][ks] = *(const bf16x8*)(P + tok[nt] * LD + C_QA + (4 * g + hl) * 64 + 32 * ks + 8 * fq);
        const u32x4 w = *(const u32x4*)((const unsigned*)(ws + WS_SELW) + (tok[nt] * 2 + g) * 4);
        selw[nt][0] = w.x; selw[nt][1] = w.y; selw[nt][2] = w.z; selw[nt][3] = w.w;
    }
    f32x4 O[2][4]; float m[2], l[2];
#pragma unroll
    for (int nt = 0; nt < 2; ++nt) { m[nt] = -1000.f; l[nt] = 0.f;
#pragma unroll
        for (int mt = 0; mt < 4; ++mt) O[nt][mt] = (f32x4){0.f, 0.f, 0.f, 0.f}; }
    const bf16_t* kb = P + ((size_t)b * S_) * LD + C_KS + g * 64;
    const bf16_t* vb = (const bf16_t*)(ws + WS_VST) + (size_t)(b * 2 + g) * 64 * S_;
    const int nts = cur + 1;
#define SEL_ISSUE(jj) do { unsigned char* st_ = lds + ((jj) & 3) * 16384; load_tile64(kb + (size_t)(jj) * 64 * LD, LD, st_, wid, lane); load_tile64(vb + (jj) * 64, S_, st_ + 8192, wid, lane); } while (0)
    asm volatile("s_waitcnt vmcnt(0)" ::: "memory");
    SEL_ISSUE(0); if (nts > 1) SEL_ISSUE(1); if (nts > 2) SEL_ISSUE(2);
    const unsigned char* bucketL = lds + NSA_BUCKET;
    for (int j = 0; j < nts; ++j) {
        const unsigned char* cu = lds + (j & 3) * 16384;
        if (j + 2 < nts) WAIT_V(8); else if (j + 1 < nts) WAIT_V(4); else WAIT_V(0);
        RAW_BARRIER();
        if (j + 3 < nts) SEL_ISSUE(j + 3);
        bool sb[2], need[2]; int relb[2];
#pragma unroll
        for (int nt = 0; nt < 2; ++nt) {
            const unsigned w = j < 32 ? selw[nt][0] : j < 64 ? selw[nt][1] : j < 96 ? selw[nt][2] : selw[nt][3];
            sb[nt] = (w >> (j & 31)) & 1u; need[nt] = __ballot(sb[nt]) != 0ull; relb[nt] = t[nt] - 64 * j - 4 * fq;
        }
        if (VAR == 1) { need[0] = false; need[1] = false; }
        if (VAR == 2) { if (!(need[0] || need[1])) { need[0] = false; } else { need[0] = true; need[1] = true; } }
        if (need[0] || need[1]) {
            const int rmin = q0 - 64 * j - 63, rmax = q0 + 31 - 64 * j;
            bool fast = false; int th = 0; float blo = 0.f, bhi = 0.f;
            if (rmin >= 16) {
                const int b0 = bucketL[rmin], b1 = bucketL[rmax > 8191 ? 8191 : rmax];
                if (b1 - b0 <= 1) { fast = true; th = t5_first(b1); if (b1 == b0) th = 0;
                    blo = ((const float*)(lds + SEL_BIAS2))[hl * 32 + b0]; bhi = ((const float*)(lds + SEL_BIAS2))[hl * 32 + b1]; }
            }
            if (fast) sel_tile<true>(cu, cu + 8192, lds, Qf, O, m, l, sb, need, relb, th, blo, bhi, hl, fr, fq);
            else sel_tile<false>(cu, cu + 8192, lds, Qf, O, m, l, sb, need, relb, th, blo, bhi, hl, fr, fq);
        }
    }
#undef SEL_ISSUE
    __syncthreads();
#pragma unroll
    for (int nt = 0; nt < 2; ++nt) {
        const float gt = bf2f(P[tok[nt] * LD + C_GA + (4 * g + hl) * 3 + 1]) * (l[nt] > 0.f ? 1.f / l[nt] : 0.f);
        const size_t o = tok[nt] * 512 + (4 * g + hl) * 64;
#pragma unroll
        for (int mt = 0; mt < 4; ++mt) {
            const f32x4 yc = unpack4(*(const u32x2*)((const bf16_t*)(ws + WS_YC) + o + 16 * mt + 4 * fq));
            const f32x4 yw = unpack4(*(const u32x2*)((const bf16_t*)(ws + WS_YW) + o + 16 * mt + 4 * fq));
            if (VAR == 0 || VAR == 3) *(u32x2*)((bf16_t*)(ws + WS_YA) + o + 16 * mt + 4 * fq) = pack4(yc + yw + O[nt][mt] * gt);
            else asm volatile("" :: "v"(O[nt][mt]));
        }
    }
}

__device__ void scan_item(const Params& p, int item, int half) {
    unsigned char* ws = launder(p.ws);
    const int idx = item * HT + (ltid() & 255);
    const int bh = idx >> 13, ed = idx & 8191, h = bh & 7;
    const float dec = exp2f(128.f * ret_lg2(h));
    const float* KVT = (const float*)(ws + WS_KVT) + (size_t)bh * 64 * 8192 + ed;
    bf16_t* SPT = (bf16_t*)(ws + WS_SPT) + (size_t)bh * 64 * 8192 + ed;
    float s = 0.f;
    for (int n = 0; n < 64; ++n) { SPT[(size_t)n * 8192] = f2bf(s); s = s * dec + KVT[(size_t)n * 8192]; }
}

__device__ void phase_p3(const Params& p, unsigned char* lds, int half) {
    for (int i = (ltid() & 255); i < 8192 / 16; i += HT) ((u32x4*)(lds + NSA_BUCKET))[i] = ((const u32x4*)(launder(p.ws) + WS_BUCKET))[i];
    __syncthreads();
    for (int it = (blockIdx.x * 2 + half); it < 1536; it += (gridDim.x * 2)) {
        if (it < 512) cmp_item(p, it, lds, half); else if (it < 1024) win_item(p, it - 512, lds, half); else scan_item(p, it - 1024, half);
    }
}

__device__ void retout_item(const Params& p, int item, unsigned char* lds, int half) {
    unsigned char* ws = launder(p.ws);
    const int tid = (ltid() & 255), lane = tid & 63, wid = tid >> 6, fr = lane & 15, fq = lane >> 4;
    const int n = item & 63, h = (item >> 6) & 7, b = item >> 9;
    const size_t tok0 = (size_t)b * S_ + 128 * n;
    const bf16_t* P = (const bf16_t*)(ws + WS_P);
    unsigned char* vL = lds; unsigned char* kL = lds + 32768; unsigned char* sL = lds + 49152;
    __syncthreads();
    load_tile128w((const bf16_t*)(ws + WS_VRT) + ((size_t)(b * 8 + h) * 128) * S_ + 128 * n, S_, vL, wid, lane);
    load_tile128(P + tok0 * LD + C_KR + h * 64, LD, kL, wid, lane);
    load_tile128((const bf16_t*)(ws + WS_SPT) + ((size_t)(b * 8 + h) * 64 + n) * 8192, 64, sL, wid, lane);
    bf16x8 Qf[2][2];
#pragma unroll
    for (int nt = 0; nt < 2; ++nt)
#pragma unroll
        for (int ks = 0; ks < 2; ++ks) Qf[nt][ks] = *(const bf16x8*)(P + (tok0 + 32 * wid + 16 * nt + fr) * LD + C_QR + h * 64 + 32 * ks + 8 * fq);
    wait_vm0(); __syncthreads();
    const float lg2 = ret_lg2(h);
    f32x4 Y[8][2];
#pragma unroll
    for (int m = 0; m < 8; ++m)
#pragma unroll
        for (int nt = 0; nt < 2; ++nt) Y[m][nt] = (f32x4){0.f, 0.f, 0.f, 0.f};
#pragma unroll
    for (int m = 0; m < 8; ++m)
#pragma unroll
        for (int ks = 0; ks < 2; ++ks) {
            const bf16x8 a = lds_frag128(sL, 16 * m + fr, 4 * ks + fq);
#pragma unroll
            for (int nt = 0; nt < 2; ++nt) Y[m][nt] = mfma16(a, Qf[nt][ks], Y[m][nt]);
        }
#pragma unroll
    for (int nt = 0; nt < 2; ++nt) {
        const float sc = exp2f((float)(32 * wid + 16 * nt + fr + 1) * lg2);
#pragma unroll
        for (int m = 0; m < 8; ++m) Y[m][nt] = Y[m][nt] * sc;
    }
#pragma unroll 1
    for (int s = 0; s < 4; ++s) {
        f32x4 St[2][2];
#pragma unroll
        for (int hh = 0; hh < 2; ++hh) {
            const int mt = 2 * s + hh;
#pragma unroll
            for (int nt = 0; nt < 2; ++nt) St[hh][nt] = (f32x4){0.f, 0.f, 0.f, 0.f};
#pragma unroll
            for (int ks = 0; ks < 2; ++ks) {
                const bf16x8 a = lds_frag128(kL, 16 * mt + fr, 4 * ks + fq);
#pragma unroll
                for (int nt = 0; nt < 2; ++nt) St[hh][nt] = mfma16(a, Qf[nt][ks], St[hh][nt]);
            }
#pragma unroll
            for (int nt = 0; nt < 2; ++nt) {
                const int qi = 32 * wid + 16 * nt + fr;
#pragma unroll
                for (int r = 0; r < 4; ++r) {
                    const int kj = 16 * mt + 4 * fq + r;
                    const float dm = qi >= kj ? exp2f((float)(qi - kj) * lg2) : 0.f;
                    St[hh][nt][r] *= dm;
                }
            }
        }
        bf16x8 Pb[2];
#pragma unroll
        for (int nt = 0; nt < 2; ++nt) Pb[nt] = pack8(St[0][nt], St[1][nt]);
#pragma unroll
        for (int m = 0; m < 8; ++m) {
            const bf16x8 a = lds_vfrag256(vL, 16 * m + fr, 32 * s, fq);
#pragma unroll
            for (int nt = 0; nt < 2; ++nt) Y[m][nt] = mfma16(a, Pb[nt], Y[m][nt]);
        }
    }
    bf16_t* YB = (bf16_t*)(ws + WS_YB);
#pragma unroll
    for (int nt = 0; nt < 2; ++nt) {
        float sum = 0.f;
#pragma unroll
        for (int m = 0; m < 8; ++m) sum += Y[m][nt][0] + Y[m][nt][1] + Y[m][nt][2] + Y[m][nt][3];
        sum = rows_sum(sum);
        const float mu = sum * (1.f / 128.f);
        float vs = 0.f;
#pragma unroll
        for (int m = 0; m < 8; ++m)
#pragma unroll
            for (int r = 0; r < 4; ++r) { const float dlt = Y[m][nt][r] - mu; vs += dlt * dlt; }
        vs = rows_sum(vs);
        const float rstd = rsqrtf(vs * (1.f / 128.f) + 1e-5f);
        const size_t tk = tok0 + 32 * wid + 16 * nt + fr;
#pragma unroll
        for (int m = 0; m < 8; ++m) {
            const f32x4 gt = unpack4(*(const u32x2*)(P + tk * LD + C_GR + h * 128 + 16 * m + 4 * fq));
            f32x4 v;
#pragma unroll
            for (int r = 0; r < 4; ++r) v[r] = (Y[m][nt][r] - mu) * rstd * gt[r];
            *(u32x2*)(YB + tk * 1024 + h * 128 + 16 * m + 4 * fq) = pack4(v);
        }
    }
}
__device__ void phase_p4(const Params& p, unsigned char* lds, int half) {
    for (int i = (ltid() & 255); i < 8192 / 16; i += HT) ((u32x4*)(lds + NSA_BUCKET))[i] = ((const u32x4*)(launder(p.ws) + WS_BUCKET))[i];
    __syncthreads();
    for (int it = (blockIdx.x * 2 + half); it < 2048; it += (gridDim.x * 2)) {
        if (it < 1024) sel_item<0>(p, it < 512 ? it : 1535 - it, lds, half); else retout_item(p, it - 1024, lds, half);
    }
#ifdef EXTRA_SEL
    __syncthreads();
    for (int it = (blockIdx.x * 2 + half); it < 1024; it += (gridDim.x * 2)) {
        sel_item<EXTRA_SEL>(p, it < 512 ? it : 1535 - it, lds, half);
    }
#endif
}

struct RowOrder {     typedef pg8::Unit U; static constexpr bool GATHER = false;
    unsigned a, b; int K, xcd, slot, per;
    __device__ __forceinline__ bool next(int i, pg8::Unit& u) const { const int t = xcd * 32 + slot + i * per; if (t >= (xcd + 1) * 32) return false; u.pm = t >> 2; u.pn = t & 3; return true; }
    __device__ __forceinline__ void ptrs(const pg8::Unit& u, unsigned& A, unsigned& B) const { A = a + (unsigned)u.pm * 512u * (unsigned)K; B = b + (unsigned)u.pn * 512u * (unsigned)K; }
};
template <int MODE>
struct MixEpi {
    unsigned char* ws; const float* X;
    __device__ __forceinline__ void operator()(const f32x4 (&acc)[2][2][4][2], const pg8::Unit& u, int wr, int wc, int fr, int fq) const {
#pragma unroll
        for (int ai = 0; ai < 2; ++ai)
#pragma unroll
            for (int m = 0; m < 4; ++m) {
                const size_t tok = (size_t)(u.pm * 256 + 128 * ai + 64 * wr + 16 * m + fr + vzero());
#pragma unroll
                for (int bj = 0; bj < 2; ++bj) {
                    const int n = u.pn * 256 + 128 * bj + 32 * wc + 8 * fq;
                    const f32x4 v0 = acc[ai][bj][m][0], v1 = acc[ai][bj][m][1];
                    if (MODE == 2) {
                        const f32x4 x0 = *(const f32x4*)(X + tok * 1024 + n), x1 = *(const f32x4*)(X + tok * 1024 + n + 4);
                        float* H1 = (float*)(ws + WS_H1);
                        *(f32x4*)(H1 + tok * 1024 + n) = x0 * DN_ALPHA + v0; *(f32x4*)(H1 + tok * 1024 + n + 4) = x1 * DN_ALPHA + v1;
                    } else {
                        const u32x4 gw = *(const u32x4*)((const bf16_t*)(ws + WS_P) + tok * LD + (MODE == 0 ? C_MA : C_MB) + n);
                        const f32x4 g0 = unpack4((u32x2){gw.x, gw.y}), g1 = unpack4((u32x2){gw.z, gw.w});
                        f32x4 o0 = g0 * v0, o1 = g1 * v1;
                        bf16_t* MG = (bf16_t*)(ws + WS_MG) + tok * 1024 + n;
                        if (MODE == 1) { const u32x4 pw = *(const u32x4*)MG; o0 = o0 + unpack4((u32x2){pw.x, pw.y}); o1 = o1 + unpack4((u32x2){pw.z, pw.w}); }
                        u32x4 w; w.x = pack2(o0[0], o0[1]); w.y = pack2(o0[2], o0[3]); w.z = pack2(o1[0], o1[1]); w.w = pack2(o1[2], o1[3]);
                        *(u32x4*)MG = w;
                    }
                }
            }
    }
};
__device__ void phase_g2(const Params& p, unsigned char* lds) {
    unsigned char* ws = launder(p.ws);
    RowOrder S; S.xcd = blockIdx.x & 7; S.slot = blockIdx.x >> 3; S.per = gridDim.x >> 3;
    { S.a = (unsigned)WS_YA; S.b = (unsigned)WS_WA; S.K = 512; MixEpi<0> E; E.ws = ws; E.X = nullptr; pg8::gemm_phase<MixEpi<0>, RowOrder>(lds, 512, S, E, ltid(), ws); }
    { S.a = (unsigned)WS_YB; S.b = (unsigned)WS_WB; S.K = 1024; MixEpi<1> E; E.ws = ws; E.X = nullptr; pg8::gemm_phase<MixEpi<1>, RowOrder>(lds, 1024, S, E, ltid(), ws); }
}
__device__ void phase_g3(const Params& p, int layer, unsigned char* lds) {
    unsigned char* ws = launder(p.ws);
    RowOrder S; S.xcd = blockIdx.x & 7; S.slot = blockIdx.x >> 3; S.per = gridDim.x >> 3; S.a = (unsigned)WS_MG; S.b = (unsigned)WS_WO; S.K = 1024;
    MixEpi<2> E; E.ws = ws; E.X = layer == 0 ? p.x : (const float*)(ws + WS_X);
    pg8::gemm_phase<MixEpi<2>, RowOrder>(lds, 1024, S, E, ltid(), ws);
}

__device__ void phase_ln1(const Params& p, int layer, unsigned char* lds, bool dry, int half) {
    unsigned char* ws = launder(p.ws);
    const int tid = (ltid() & 255), lane = tid & 63, wid = tid >> 6;
    float* wrL = (float*)lds;
    {
        float4 wv[16];
#pragma unroll
        for (int k = 0; k < 16; ++k) wv[k] = ((const float4*)p.w_router)[tid + 256 * k];
#pragma unroll
        for (int k = 0; k < 16; ++k) { const int i4 = tid + 256 * k, d = i4 >> 2, e0 = (i4 & 3) * 4;
            wrL[(e0 + 0) * 1024 + d] = wv[k].x; wrL[(e0 + 1) * 1024 + d] = wv[k].y; wrL[(e0 + 2) * 1024 + d] = wv[k].z; wrL[(e0 + 3) * 1024 + d] = wv[k].w; }
    }
    __syncthreads();
    const float* H1 = (const float*)(ws + WS_H1);
    float* X1 = (float*)(ws + WS_X1); bf16_t* X1B = (bf16_t*)(ws + WS_X1B);
    const float* gam = p.ln1_g + layer * 1024; const float* bet = p.ln1_b + layer * 1024;
    unsigned* cnt = (unsigned*)(ws + WS_CTL) + (dry ? 0 : CW_CNT) + layer * 1024;
    int* LIST = (int*)(ws + (dry ? WS_HB : WS_LIST)); float* WTS = (float*)(ws + (dry ? WS_HB + 4194304 : WS_WTS));
    for (int tok = (blockIdx.x * 2 + half) * 4 + wid; tok < T_; tok += (gridDim.x * 2) * 4) {
        float4 v[4];
#pragma unroll
        for (int j = 0; j < 4; ++j) v[j] = *(const float4*)(H1 + (size_t)tok * 1024 + 256 * j + 4 * lane);
        float s = 0.f;
#pragma unroll
        for (int j = 0; j < 4; ++j) s += v[j].x + v[j].y + v[j].z + v[j].w;
        s = wave_sum(s);
        const float mu = s * (1.f / 1024.f);
        float q = 0.f;
#pragma unroll
        for (int j = 0; j < 4; ++j) { const float a = v[j].x - mu, b2 = v[j].y - mu, c = v[j].z - mu, d = v[j].w - mu; q += a * a + b2 * b2 + c * c + d * d; }
        q = wave_sum(q);
        const float rstd = rsqrtf(q * (1.f / 1024.f) + 1e-5f);
        float4 y[4];
#pragma unroll
        for (int j = 0; j < 4; ++j) {
            const int d0 = 256 * j + 4 * lane;
            const float4 gg = *(const float4*)(gam + d0), bb = *(const float4*)(bet + d0);
            y[j].x = (v[j].x - mu) * rstd * gg.x + bb.x; y[j].y = (v[j].y - mu) * rstd * gg.y + bb.y; y[j].z = (v[j].z - mu) * rstd * gg.z + bb.z; y[j].w = (v[j].w - mu) * rstd * gg.w + bb.w;
            *(float4*)(X1 + (size_t)tok * 1024 + d0) = y[j];
            u32x2 w; w.x = pack2(y[j].x, y[j].y); w.y = pack2(y[j].z, y[j].w);
            *(u32x2*)(X1B + (size_t)tok * 1024 + d0) = w;
        }
        float lg[16];
#pragma unroll
        for (int e = 0; e < 16; ++e) {
            float a = 0.f;
#pragma unroll
            for (int j = 0; j < 4; ++j) { const float4 w4 = *(const float4*)(wrL + e * 1024 + 256 * j + 4 * lane); a += y[j].x * w4.x + y[j].y * w4.y + y[j].z * w4.z + y[j].w * w4.w; }
            lg[e] = a;
        }
#pragma unroll
        for (int e = 0; e < 16; ++e) {
            lg[e] = wave_sum(lg[e]);
        }
        float mx = lg[0];
#pragma unroll
        for (int e = 1; e < 16; ++e) mx = fmaxf(mx, lg[e]);
        float pr[16], ps = 0.f;
#pragma unroll
        for (int e = 0; e < 16; ++e) { pr[e] = expf(lg[e] - mx); ps += pr[e]; }
        const float ips = 1.f / ps;
        float sel[16];
#pragma unroll
        for (int e = 0; e < 16; ++e) { pr[e] *= ips; sel[e] = pr[e] + p.router_bias[e]; }
        int best = 0; float bestv = -1e30f;
#pragma unroll
        for (int gI = 0; gI < 4; ++gI) {
            float a = -1e30f, b2 = -1e30f;
#pragma unroll
            for (int k = 0; k < 4; ++k) { const float x = sel[4 * gI + k]; if (x > a) { b2 = a; a = x; } else if (x > b2) b2 = x; }
            const float gs = a + b2;
            if (gs > bestv) { bestv = gs; best = gI; }
        }
        float s4[4], p4[4];
#pragma unroll
        for (int k = 0; k < 4; ++k) { s4[k] = 0.f; p4[k] = 0.f; }
#pragma unroll
        for (int gI = 0; gI < 4; ++gI) if (gI == best) {
#pragma unroll
            for (int k = 0; k < 4; ++k) { s4[k] = sel[4 * gI + k]; p4[k] = pr[4 * gI + k]; }
        }
        int i0 = 0; float a0 = s4[0];
#pragma unroll
        for (int k = 1; k < 4; ++k) if (s4[k] > a0) { a0 = s4[k]; i0 = k; }
        int i1 = -1; float a1 = -1e30f;
#pragma unroll
        for (int k = 0; k < 4; ++k) if (k != i0 && s4[k] > a1) { a1 = s4[k]; i1 = k; }
        float w0 = 0.f, w1 = 0.f;
#pragma unroll
        for (int k = 0; k < 4; ++k) { if (k == i0) w0 = p4[k]; if (k == i1) w1 = p4[k]; }
        const float iw = 1.f / (w0 + w1);
        if (lane == 0) {
            const int e0 = best * 4 + i0, e1 = best * 4 + i1;
            const unsigned p0 = atomicAdd(&cnt[e0 * 64], 1u), p1 = atomicAdd(&cnt[e1 * 64], 1u);
            LIST[(size_t)e0 * T_ + p0] = tok * 2; LIST[(size_t)e1 * T_ + p1] = tok * 2 + 1;
            WTS[tok * 2] = w0 * iw; WTS[tok * 2 + 1] = w1 * iw;
        }
    }
}

struct MoeUnit { int e, rt, ct, cnt, off; };
struct MoeOrderBase {
    const unsigned* cntp; int t_lo, t_hi, slot, per;
    __device__ __forceinline__ void init(const unsigned* cnt) {
        cntp = cnt; int ntile = 0;
#pragma unroll
        for (int k = 0; k < NE; ++k) ntile += ((__builtin_amdgcn_readfirstlane((int)cnt[k * 64]) + 255) >> 8) * 4;
        t_lo = (ntile * (int)(blockIdx.x & 7)) >> 3; t_hi = (ntile * (int)((blockIdx.x & 7) + 1)) >> 3; slot = blockIdx.x >> 3; per = gridDim.x >> 3;
    }
    __device__ __forceinline__ bool next(int i, MoeUnit& u) const {
        const int t = t_lo + slot + i * per; if (t >= t_hi) return false;
        int base = 0, off = 0; bool found = false;
#pragma unroll
        for (int k = 0; k < NE; ++k) {
            const int ck = __builtin_amdgcn_readfirstlane((int)cntp[k * 64]), nt = ((ck + 255) >> 8) * 4;
            if (!found && t < base + nt) { found = true; u.e = k; u.cnt = ck; u.off = off; u.rt = (t - base) >> 2; u.ct = (t - base) & 3; }
            base += nt; off += ck;
        }
        return found;
    }
};
struct M2Order : MoeOrderBase {
    typedef MoeUnit U; static constexpr bool GATHER = true;
    const int* list;
    __device__ __forceinline__ void ptrs(const MoeUnit& u, unsigned& A, unsigned& B) const { A = (unsigned)WS_X1B; B = (unsigned)WS_WG + ((unsigned)u.e * 1024u + (unsigned)u.ct * 256u) * 2048u; }
    __device__ __forceinline__ void rows(const MoeUnit& u, int tid, unsigned (&v)[2][2]) const {
#pragma unroll
        for (int i = 0; i < 2; ++i) { int R, C; pg8::stage_rc((tid + vzero()) * 16 + i * 8192, R, C);
#pragma unroll
            for (int h = 0; h < 2; ++h) { int idx = u.rt * 256 + 128 * h + R; idx = idx < u.cnt ? idx : u.cnt - 1; const int a = (list + (size_t)u.e * T_)[idx]; v[h][i] = ((unsigned)(a >> 1) << 11) + (unsigned)C * 2u; } }
    }
};
struct M3Order : MoeOrderBase {
    typedef MoeUnit U; static constexpr bool GATHER = false;
    __device__ __forceinline__ void ptrs(const MoeUnit& u, unsigned& A, unsigned& B) const { A = (unsigned)WS_HB + ((unsigned)u.off + (unsigned)u.rt * 256u) * 1024u; B = (unsigned)WS_WD + ((unsigned)u.e * 1024u + (unsigned)u.ct * 256u) * 1024u; }
};
struct M2Epi {
    unsigned char* ws;
    __device__ __forceinline__ void operator()(const f32x4 (&acc)[2][2][4][2], const MoeUnit& u, int wr, int wc, int fr, int fq) const {
        bf16_t* HB = (bf16_t*)(ws + WS_HB);
#pragma unroll
        for (int ai = 0; ai < 2; ++ai)
#pragma unroll
            for (int m = 0; m < 4; ++m) {
                const int idx = u.rt * 256 + 128 * ai + 64 * wr + 16 * m + fr + vzero();
                if (idx < u.cnt) {
#pragma unroll
                    for (int bj = 0; bj < 2; ++bj) {
                        const int hcol = 4 * (32 * u.ct + 16 * bj + 4 * wc + fq);
                        const f32x4 gv = acc[ai][bj][m][0], uv = acc[ai][bj][m][1]; f32x4 hv;
#pragma unroll
                        for (int r = 0; r < 4; ++r) hv[r] = gv[r] * fsig(gv[r]) * uv[r];
                        *(u32x2*)(HB + (size_t)(u.off + idx) * 512 + hcol) = pack4(hv);
                    }
                }
            }
    }
};
struct M3Epi {
    unsigned char* ws; const int* list;
    __device__ __forceinline__ void operator()(const f32x4 (&acc)[2][2][4][2], const MoeUnit& u, int wr, int wc, int fr, int fq) const {
        bf16_t* CT = (bf16_t*)(ws + WS_CT);
#pragma unroll
        for (int ai = 0; ai < 2; ++ai)
#pragma unroll
            for (int m = 0; m < 4; ++m) {
                const int idx = u.rt * 256 + 128 * ai + 64 * wr + 16 * m + fr + vzero();
                if (idx < u.cnt) {
                    const int a = list[(size_t)u.e * T_ + idx];
#pragma unroll
                    for (int bj = 0; bj < 2; ++bj) {
                        const int n = u.ct * 256 + 128 * bj + 32 * wc + 8 * fq;
                        const f32x4 v0 = acc[ai][bj][m][0], v1 = acc[ai][bj][m][1];
                        u32x4 w; w.x = pack2(v0[0], v0[1]); w.y = pack2(v0[2], v0[3]); w.z = pack2(v1[0], v1[1]); w.w = pack2(v1[2], v1[3]);
                        *(u32x4*)(CT + (size_t)a * 1024 + n) = w;
                    }
                }
            }
    }
};
__device__ void phase_m2(const Params& p, int layer, unsigned char* lds) {
    unsigned char* ws = launder(p.ws);
    M2Order S; S.init((const unsigned*)(ws + WS_CTL) + CW_CNT + layer * 1024 + vzero());
    S.list = (const int*)(ws + WS_LIST);
    M2Epi E; E.ws = ws;
    pg8::gemm_phase<M2Epi, M2Order>(lds, 1024, S, E, ltid(), ws);
}
__device__ void phase_m3(const Params& p, int layer, unsigned char* lds) {
    unsigned char* ws = launder(p.ws);
    M3Order S; S.init((const unsigned*)(ws + WS_CTL) + CW_CNT + layer * 1024 + vzero());
    M3Epi E; E.ws = ws; E.list = (const int*)(ws + WS_LIST);
    pg8::gemm_phase<M3Epi, M3Order>(lds, 512, S, E, ltid(), ws);
}

__device__ void phase_ln2(const Params& p, int layer, int half) {
    unsigned char* ws = launder(p.ws);
    const int tid = (ltid() & 255), lane = tid & 63, wid = tid >> 6;
    const float* X1 = (const float*)(ws + WS_X1); const bf16_t* CT = (const bf16_t*)(ws + WS_CT); const float* WTS = (const float*)(ws + WS_WTS);
    float* XO = layer == NLAYER - 1 ? p.out : (float*)(ws + WS_X); bf16_t* XB = (bf16_t*)(ws + WS_XB);
    const float* gam = p.ln2_g + layer * 1024; const float* bet = p.ln2_b + layer * 1024;
    constexpr int U = 4;
    const int nwave = (gridDim.x * 2) * 4, wv = (blockIdx.x * 2 + half) * 4 + wid;
    for (int t0 = wv * U; t0 < T_; t0 += nwave * U) {
        float4 v[U][4]; float s[U], q[U];
#pragma unroll
        for (int u = 0; u < U; ++u) {
            const int tok = t0 + u;
            const float w0 = WTS[tok * 2 + vzero()], w1 = WTS[tok * 2 + 1 + vzero()];
            s[u] = 0.f; q[u] = 0.f;
#pragma unroll
            for (int j = 0; j < 4; ++j) {
                const int d0 = 256 * j + 4 * lane;
                const float4 xv = *(const float4*)(X1 + (size_t)tok * 1024 + d0);
                const f32x4 c0 = unpack4(*(const u32x2*)(CT + (size_t)(tok * 2) * 1024 + d0)), c1 = unpack4(*(const u32x2*)(CT + (size_t)(tok * 2 + 1) * 1024 + d0));
                v[u][j].x = xv.x * DN_ALPHA + w0 * c0[0] + w1 * c1[0]; v[u][j].y = xv.y * DN_ALPHA + w0 * c0[1] + w1 * c1[1];
                v[u][j].z = xv.z * DN_ALPHA + w0 * c0[2] + w1 * c1[2]; v[u][j].w = xv.w * DN_ALPHA + w0 * c0[3] + w1 * c1[3];
                s[u] += v[u][j].x + v[u][j].y + v[u][j].z + v[u][j].w;
                q[u] += v[u][j].x * v[u][j].x + v[u][j].y * v[u][j].y + v[u][j].z * v[u][j].z + v[u][j].w * v[u][j].w;
            }
        }
#pragma unroll
        for (int u = 0; u < U; ++u) { s[u] = wave_sum(s[u]); q[u] = wave_sum(q[u]); }
#pragma unroll
        for (int j = 0; j < 4; ++j) {
            const int d0 = 256 * j + 4 * lane;
            const float4 gg = *(const float4*)(gam + d0), bb = *(const float4*)(bet + d0);
#pragma unroll
            for (int u = 0; u < U; ++u) {
                const int tok = t0 + u;
                const float mu = s[u] * (1.f / 1024.f), var = fmaxf(q[u] * (1.f / 1024.f) - mu * mu, 0.f), rstd = rsqrtf(var + 1e-5f);
                float4 y; y.x = (v[u][j].x - mu) * rstd * gg.x + bb.x; y.y = (v[u][j].y - mu) * rstd * gg.y + bb.y; y.z = (v[u][j].z - mu) * rstd * gg.z + bb.z; y.w = (v[u][j].w - mu) * rstd * gg.w + bb.w;
                *(float4*)(XO + (size_t)tok * 1024 + d0) = y;
                u32x2 w; w.x = pack2(y.x, y.y); w.y = pack2(y.z, y.w);
                *(u32x2*)(XB + (size_t)tok * 1024 + d0) = w;
            }
        }
    }
}

#define XB_TMO      128
#define XB_XCNT(j)  (256  + 64 * (j))
#define XB_XSUB(j)  (1280 + 64 * (j))
#define XB_XGEN(j)  (2304 + 64 * (j))
#define XB_TOP      3328
#define XB_TOPGEN   3392
#define XCD_BAR_WORDS 3456
#define XB_SPIN_CAP (1u << 22)
#define LAS __attribute__((address_space(3)))
__device__ __forceinline__ unsigned xb_ld(unsigned* p)              { return __hip_atomic_load(p, __ATOMIC_RELAXED, __HIP_MEMORY_SCOPE_AGENT); }
__device__ __forceinline__ unsigned xb_add(unsigned* p, unsigned v) { return __hip_atomic_fetch_add(p, v, __ATOMIC_RELAXED, __HIP_MEMORY_SCOPE_AGENT); }
__device__ __forceinline__ unsigned xb_xcc_id() { return (unsigned)__builtin_amdgcn_s_getreg((3 << 11) | 20) & 0xFu; }
#define XB_SPIN(cond, bar) do { unsigned _sp = 0; while (cond) { __builtin_amdgcn_s_sleep(1); \
    if ((++_sp & 255u) == 0u) { if (xb_ld(&(bar)[XB_TMO])) break; if (_sp > XB_SPIN_CAP) { atomicAdd(&(bar)[XB_TMO], 1u); break; } } } } while (0)
struct XcdBarrier { unsigned* bar; unsigned x; volatile LAS unsigned* st; };
__device__ __forceinline__ XcdBarrier xcd_barrier_post(unsigned* bar, volatile LAS unsigned* st) {
    XcdBarrier b; b.bar = bar; b.x = xb_xcc_id(); b.st = st;
    if (threadIdx.x == 0) (void)xb_add(&bar[XB_XCNT(b.x)], 1u);
    return b;
}
__device__ __forceinline__ void xcd_barrier_complete(unsigned* bar, unsigned x, unsigned& nloc, unsigned& nx) {
    const unsigned G = gridDim.x * gridDim.y * gridDim.z;
    unsigned sum, cnt, mine, sp = 0u;
    for (;;) {
        sum = 0u; cnt = 0u; mine = 0u;
#pragma unroll
        for (unsigned j = 0; j < 16; ++j) { const unsigned c = xb_ld(&bar[XB_XCNT(j)]); sum += c; cnt += (c > 0u) ? 1u : 0u; mine = (j == x) ? c : mine; }
        if (sum == G) break;
        __builtin_amdgcn_s_sleep(1);
        if ((++sp & 255u) == 0u) { if (xb_ld(&bar[XB_TMO])) break; if (sp > XB_SPIN_CAP) { atomicAdd(&bar[XB_TMO], 1u); break; } }
    }
    nloc = mine > 0u ? mine : 1u; nx = cnt > 0u ? cnt : 1u;
}
__device__ __forceinline__ void xcd_barrier(const XcdBarrier& b) {
    asm volatile("s_waitcnt vmcnt(0)" ::: "memory");
    __syncthreads();
    if (threadIdx.x == 0) {
        unsigned* bar = b.bar;
        __builtin_amdgcn_s_waitcnt(0);
        unsigned nloc = b.st[0], nx = b.st[1];
        if (nloc == 0u) { xcd_barrier_complete(bar, b.x, nloc, nx); b.st[0] = nloc; b.st[1] = nx; }
        const unsigned old = xb_add(&bar[XB_XSUB(b.x)], 1u);
        const unsigned gen = old / nloc;
        if (old + 1u == (gen + 1u) * nloc) {
            __builtin_amdgcn_fence(__ATOMIC_RELEASE, "agent");
            asm volatile("s_waitcnt vmcnt(0)" ::: "memory");
            const unsigned og = xb_add(&bar[XB_TOP], 1u);
            const unsigned tg = og / nx;
            if (og + 1u == (tg + 1u) * nx) xb_add(&bar[XB_TOPGEN], 1u);
            else XB_SPIN(xb_ld(&bar[XB_TOPGEN]) == tg, bar);
            __builtin_amdgcn_fence(__ATOMIC_ACQUIRE, "agent");
            xb_add(&bar[XB_XGEN(b.x)], 1u);
            asm volatile("s_waitcnt vmcnt(0)" ::: "memory");
        } else {
            XB_SPIN(xb_ld(&bar[XB_XGEN(b.x)]) == gen, bar);
            __builtin_amdgcn_fence(__ATOMIC_ACQUIRE, "agent");
            asm volatile("s_waitcnt vmcnt(0)" ::: "memory");
        }
    }
    __syncthreads();
}

constexpr int PH_PER_LAYER = 11, N_PHASES = PH_PER_LAYER * NLAYER;
__global__ void __launch_bounds__(NTHREADS, 2) mega(Params p) {
    extern __shared__ __attribute__((aligned(16))) unsigned char lds[];
#if SINGLE_LAUNCH
    volatile LAS unsigned* xbw = (volatile LAS unsigned*)(lds + LDS_BYTES - 16);
    if (threadIdx.x < 4) xbw[threadIdx.x] = 0u;
    __syncthreads();
    XcdBarrier xbar = xcd_barrier_post((unsigned*)(p.ws + WS_CTL) + CW_BAR, xbw);
#endif
    const int half = __builtin_amdgcn_readfirstlane((int)(threadIdx.x >> 8));
    unsigned char* ldsh = lds + half * HALF_LDS;
    for (int ph = p.ph_lo; ph < p.ph_hi; ++ph) {
        const int layer = ph / PH_PER_LAYER, k = ph % PH_PER_LAYER;
        if (k == 0 && layer > 0) continue;
#ifdef ONLY_PHASE
        if (k != ONLY_PHASE) continue;
#endif
#ifdef REPEAT_MASK
        for (int rep = 0; rep < (((REPEAT_MASK) >> k) & 1) + 1; ++rep) {
        if (rep) __syncthreads();
#endif
        switch (k) {
            case 0: phase_pw(p, layer, ldsh, 15, half); break;
            case 1: phase_g1(p, layer, lds); break;
            case 2: phase_p2(p, layer, ldsh, half); break;
            case 3: phase_p3(p, ldsh, half); if (layer + 1 < NLAYER) { __syncthreads(); phase_pw(p, layer + 1, ldsh, 1, half); } break;
            case 4: if (layer > 0 && half == 0) { phase_pw(p, layer, ldsh, 4, half); __syncthreads(); }
                    phase_p4(p, ldsh, half);
                    if (layer > 0 && half == 1) { __syncthreads(); phase_pw(p, layer, ldsh, 4, half); } break;
            case 5: phase_g2(p, lds); break;
            case 6: phase_g3(p, layer, lds); break;
#ifdef REPEAT_MASK
            case 7: phase_ln1(p, layer, ldsh, (((REPEAT_MASK) >> 7) & 1) && rep == 0, half); break;
#else
            case 7: phase_ln1(p, layer, ldsh, false, half); if (layer + 1 < NLAYER) { __syncthreads(); phase_pw(p, layer + 1, ldsh, 2, half); } break;
#endif
            case 8: phase_m2(p, layer, lds); break;
            case 9: phase_m3(p, layer, lds); break;
            case 10: phase_ln2(p, layer, half); break;
        }
#ifdef REPEAT_MASK
        }
#endif
#if SINGLE_LAUNCH
        if (ph + 1 < p.ph_hi) { if (ph == p.ph_lo) cg::this_grid().sync(); else xcd_barrier(xbar); }
#endif
    }
}

extern "C" void kernel_launch(void* const* d_in, const int* in_sizes, int n_in, void* d_out, int out_size, void* d_ws, size_t ws_size, hipStream_t stream) {
    static int grid = 0;
    if (grid == 0) {
        if (n_in != 18 || ws_size < WS_END) { fprintf(stderr, "kernel_launch: unexpected n_in %d or ws_size %zu < %zu\n", n_in, ws_size, (size_t)WS_END); grid = -1; return; }
        int dev = 0, cus = 0, per_cu = 0;
        hipGetDevice(&dev); hipDeviceGetAttribute(&cus, hipDeviceAttributeMultiprocessorCount, dev);
        hipFuncSetAttribute((const void*)mega, hipFuncAttributeMaxDynamicSharedMemorySize, LDS_BYTES);
        hipOccupancyMaxActiveBlocksPerMultiprocessor(&per_cu, (const void*)mega, NTHREADS, LDS_BYTES);
        if (per_cu < 1) per_cu = 1;
        if (per_cu > 1) per_cu = 1;
        grid = cus * per_cu;
        (void)hipGetLastError();
    }
    if (grid < 0) return;
    Params p{};
    p.x = (const float*)d_in[0]; p.w_in = (const float*)d_in[1]; p.cmp_pos = (const float*)d_in[2]; p.cmp_w1 = (const float*)d_in[3]; p.cmp_w2 = (const float*)d_in[4];
    p.w_br_a = (const float*)d_in[5]; p.w_br_b = (const float*)d_in[6]; p.w_o = (const float*)d_in[7]; p.ln1_g = (const float*)d_in[8]; p.ln1_b = (const float*)d_in[9];
    p.w_router = (const float*)d_in[10]; p.router_bias = (const float*)d_in[11]; p.w_gate = (const float*)d_in[12]; p.w_up = (const float*)d_in[13]; p.w_down = (const float*)d_in[14];
    p.ln2_g = (const float*)d_in[15]; p.ln2_b = (const float*)d_in[16]; p.rel_bias = (const float*)d_in[17];
    p.out = (float*)d_out; p.ws = (unsigned char*)d_ws;
#if SINGLE_LAUNCH
    hipMemsetAsync((unsigned char*)d_ws + WS_CTL + (size_t)CW_BAR * 4, 0, XCD_BAR_WORDS * 4, stream);
    p.ph_lo = 0; p.ph_hi = N_PHASES;
    void* args[] = {&p};
    hipError_t e = hipLaunchCooperativeKernel((const void*)mega, dim3(grid), dim3(NTHREADS), args, LDS_BYTES, stream);
    if (e != hipSuccess) fprintf(stderr, "cooperative launch failed: %s (grid %d)\n", hipGetErrorString(e), grid);
#else
    for (int ph = 0; ph < N_PHASES; ++ph) {
        p.ph_lo = ph; p.ph_hi = ph + 1;
        hipLaunchKernelGGL(mega, dim3(grid), dim3(NTHREADS), LDS_BYTES, stream, p);
    }
#endif
}
```

```cpp
#include <hip/hip_runtime.h>
#include <hip/hip_cooperative_groups.h>
#include <cstdio>
#include <cstdint>
namespace cg = cooperative_groups;

#ifndef REPEAT_MASK
#define REPEAT_MASK 0
#endif
#ifndef SINGLE_LAUNCH
#define SINGLE_LAUNCH 1
#endif

typedef unsigned short bf16_t;
typedef short bf16x8 __attribute__((ext_vector_type(8)));
typedef float f32x4 __attribute__((ext_vector_type(4)));
typedef unsigned u32x2 __attribute__((ext_vector_type(2)));
typedef unsigned u32x4 __attribute__((ext_vector_type(4)));

constexpr int B_ = 2, S_ = 8192, D_ = 1024, T_ = B_ * S_, NLAYER = 4;
constexpr int DIN = 6424;
constexpr int LD = 5376;
constexpr int NW = 6656;
constexpr int C_QA = 0, C_KC = 512, C_VC = 640, C_KS = 768, C_KW = 896, C_QR = 1024, C_KR = 1536, C_GR = 2048, C_MA = 3072, C_MB = 4096, C_GA = 5120,
              C_VS = 5376, C_VW = 5504, C_VR = 5632;
constexpr float DN_ALPHA = 1.681792830507429f;
constexpr int NE = 16;

constexpr size_t al256(size_t x) { return (x + 255) & ~(size_t)255; }
constexpr size_t WS_CTL = 0;
constexpr size_t WS_BUCKET = 65536;
constexpr size_t WS_ROPE = WS_BUCKET + 8192;
constexpr size_t WS_WIN = WS_ROPE + (size_t)8192 * 32 * 8;
constexpr size_t WS_WA = WS_WIN + (size_t)NW * 1024 * 2;
constexpr size_t WS_WB = WS_WA + (size_t)1024 * 512 * 2;
constexpr size_t WS_WO = WS_WB + (size_t)1024 * 1024 * 2;
constexpr size_t WS_WG = WS_WO + (size_t)1024 * 1024 * 2;
constexpr size_t WS_WU = WS_WG + (size_t)16 * 512 * 1024 * 2;
constexpr size_t WS_WD = WS_WU + (size_t)16 * 512 * 1024 * 2;
constexpr size_t WS_XB = WS_WD + (size_t)16 * 512 * 1024 * 2;
constexpr size_t WS_X = WS_XB + (size_t)T_ * 1024 * 2;
constexpr size_t WS_MG = WS_X + (size_t)T_ * 1024 * 4;
constexpr size_t WS_KCC = WS_MG + (size_t)T_ * 1024 * 2;
constexpr size_t WS_VCCT = WS_KCC + (size_t)4 * 512 * 64 * 2;
constexpr size_t WS_W1T = WS_VCCT + (size_t)4 * 512 * 64 * 2;
constexpr size_t WS_B1 = WS_W1T + (size_t)2 * 64 * 2048 * 2;
constexpr size_t WS_R = WS_B1 + 1024;
constexpr size_t WS_P = WS_R;
constexpr size_t WS_VST = WS_P + (size_t)T_ * LD * 2;
constexpr size_t WS_VWT = WS_VST + (size_t)4 * 64 * S_ * 2;
constexpr size_t WS_VRT = WS_VWT + (size_t)4 * 64 * S_ * 2;
constexpr size_t WS_KVT = WS_VRT + (size_t)16 * 128 * S_ * 2;
constexpr size_t WS_SPT = WS_KVT + (size_t)16 * 64 * 8192 * 4;
constexpr size_t WS_YC = WS_SPT + (size_t)16 * 64 * 8192 * 2;
constexpr size_t WS_YW = WS_YC + (size_t)T_ * 512 * 2;
constexpr size_t WS_YA = WS_YW + (size_t)T_ * 512 * 2;
constexpr size_t WS_YB = WS_YA + (size_t)T_ * 512 * 2;
constexpr size_t WS_SELW = WS_YB + (size_t)T_ * 1024 * 2;
constexpr size_t WS_ENDA = WS_SELW + (size_t)T_ * 2 * 4 * 4;
constexpr size_t WS_H1 = WS_R;
constexpr size_t WS_X1 = WS_H1 + (size_t)T_ * 1024 * 4;
constexpr size_t WS_X1B = WS_X1 + (size_t)T_ * 1024 * 4;
constexpr size_t WS_HB = WS_X1B + (size_t)T_ * 1024 * 2;
constexpr size_t WS_CT = WS_HB + (size_t)2 * T_ * 512 * 2;
constexpr size_t WS_LIST = WS_CT + (size_t)2 * T_ * 1024 * 2;
constexpr size_t WS_WTS = WS_LIST + (size_t)16 * T_ * 4;
constexpr size_t WS_ENDB = WS_WTS + (size_t)2 * T_ * 4;
static_assert(WS_HB + (size_t)2 * T_ * 512 * 2 <= WS_CT, "view B overlap");
constexpr size_t WS_END = WS_ENDA > WS_ENDB ? WS_ENDA : WS_ENDB;

constexpr int CW_CNT = 4096;
constexpr int CW_BAR = 8192;

constexpr int HALF_LDS = 75776, LDS_BYTES = 2 * HALF_LDS + 16;
constexpr int NTHREADS = 512, HT = 256;

struct Params {
    const float* x; const float* w_in; const float* cmp_pos; const float* cmp_w1; const float* cmp_w2;
    const float* w_br_a; const float* w_br_b; const float* w_o; const float* ln1_g; const float* ln1_b;
    const float* w_router; const float* router_bias; const float* w_gate; const float* w_up; const float* w_down;
    const float* ln2_g; const float* ln2_b; const float* rel_bias;
    float* out; unsigned char* ws;
    int ph_lo, ph_hi, rep_mask, pad_;
};

__device__ __forceinline__ bf16_t f2bf(float f) { unsigned u = __float_as_uint(f); u += 0x7fffu + ((u >> 16) & 1u); return (bf16_t)(u >> 16); }
__device__ __forceinline__ float bf2f(unsigned h) { return __uint_as_float(h << 16); }
typedef __bf16 bf16x2_t __attribute__((ext_vector_type(2)));
typedef float f32x2_t __attribute__((ext_vector_type(2)));
__device__ __forceinline__ unsigned pack2(float lo, float hi) { const f32x2_t f = {lo, hi}; return __builtin_bit_cast(unsigned, __builtin_convertvector(f, bf16x2_t)); }
__device__ __forceinline__ u32x2 pack4(f32x4 v) { u32x2 r; r.x = pack2(v[0], v[1]); r.y = pack2(v[2], v[3]); return r; }
__device__ __forceinline__ f32x4 unpack4(u32x2 u) { f32x4 r; r[0] = bf2f(u.x & 0xffffu); r[1] = bf2f(u.x >> 16); r[2] = bf2f(u.y & 0xffffu); r[3] = bf2f(u.y >> 16); return r; }
__device__ __forceinline__ float rows_max(float v) {
    u32x2 r = __builtin_amdgcn_permlane16_swap(__float_as_uint(v), __float_as_uint(v), false, false);
    v = fmaxf(__uint_as_float(r.x), __uint_as_float(r.y));
    r = __builtin_amdgcn_permlane32_swap(__float_as_uint(v), __float_as_uint(v), false, false);
    return fmaxf(__uint_as_float(r.x), __uint_as_float(r.y));
}
__device__ __forceinline__ float rows_sum(float v) {
    u32x2 r = __builtin_amdgcn_permlane16_swap(__float_as_uint(v), __float_as_uint(v), false, false);
    v = __uint_as_float(r.x) + __uint_as_float(r.y);
    r = __builtin_amdgcn_permlane32_swap(__float_as_uint(v), __float_as_uint(v), false, false);
    return __uint_as_float(r.x) + __uint_as_float(r.y);
}
__device__ __forceinline__ float wave_sum(float v) {
    v += __int_as_float(__builtin_amdgcn_ds_swizzle(__float_as_int(v), 0x041F));
    v += __int_as_float(__builtin_amdgcn_ds_swizzle(__float_as_int(v), 0x081F));
    v += __int_as_float(__builtin_amdgcn_ds_swizzle(__float_as_int(v), 0x101F));
    v += __int_as_float(__builtin_amdgcn_ds_swizzle(__float_as_int(v), 0x201F));
    v += __int_as_float(__builtin_amdgcn_ds_swizzle(__float_as_int(v), 0x401F));
    const u32x2 r = __builtin_amdgcn_permlane32_swap(__float_as_uint(v), __float_as_uint(v), false, false);
    return __uint_as_float(r.x) + __uint_as_float(r.y);
}
__device__ __forceinline__ float sigmoidf_(float x) { return 1.f / (1.f + __expf(-x)); }
__device__ __forceinline__ int ltid() { int t = threadIdx.x; asm volatile("" : "+v"(t)); return t; }
__device__ __forceinline__ int vzero() { int z; asm volatile("v_mov_b32 %0, 0" : "=v"(z)); return z; }
__device__ __forceinline__ unsigned char* launder(unsigned char* q) { asm volatile("" : "+s"(q)); return q; }
__device__ __forceinline__ void wait_vm0() { asm volatile("s_waitcnt vmcnt(0)" ::: "memory"); }

__device__ __forceinline__ void glds16(const void* g, void* l) {
    __builtin_amdgcn_global_load_lds((const __attribute__((address_space(1))) unsigned*)g,
                                     (__attribute__((address_space(3))) unsigned*)l, 16, 0, 0);
}
__device__ __forceinline__ f32x4 mfma16(bf16x8 a, bf16x8 b, f32x4 c) { return __builtin_amdgcn_mfma_f32_16x16x32_bf16(a, b, c, 0, 0, 0); }

#define WAIT_V(n) asm volatile("s_waitcnt vmcnt(%0)" ::"n"(n) : "memory")
#define RAW_BARRIER() do { asm volatile("s_waitcnt lgkmcnt(0)" ::: "memory"); __builtin_amdgcn_s_barrier(); } while (0)
__device__ __forceinline__ void bglds16(__amdgpu_buffer_rsrc_t r, unsigned voff, int soff, void* l) {
    __builtin_amdgcn_raw_ptr_buffer_load_lds(r, (__attribute__((address_space(3))) void*)l, 16, (int)voff, soff, 0, 0);
}
template <int NJ, bool GN>
__device__ __forceinline__ void gemm8_stage(__amdgpu_buffer_rsrc_t mr, int mld, unsigned mvo, __amdgpu_buffer_rsrc_t nr, int nld, const unsigned (&nvo)[NJ], int kt, unsigned char* st, int wid) {
#pragma unroll
    for (int i = 0; i < 4; ++i) bglds16(mr, mvo, (64 * i * mld + kt * 64) * 2, st + (8 * i + wid) * 1024);
#pragma unroll
    for (int i = 0; i < NJ; ++i) bglds16(nr, nvo[i], ((GN ? 0 : 64 * i * nld) + kt * 64) * 2, st + 32768 + (8 * i + wid) * 1024);
}
template <int NJ, bool GN>
__device__ __forceinline__ void gemm8_kloop(const bf16_t* mb, int mld, unsigned mvo, const bf16_t* nb, int nld, const unsigned (&nvo)[NJ], int nk, unsigned char* lds, f32x4 (&acc)[8][NJ], int tid) {
    const int lane = tid & 63, wid = tid >> 6, wr = wid >> 2, wc = wid & 3, fr = lane & 15, fq = lane >> 4;
    const __amdgpu_buffer_rsrc_t mr = __builtin_amdgcn_make_buffer_rsrc((void*)mb, 0, 0x7fffffff, 0x00020000);
    const __amdgpu_buffer_rsrc_t nr = __builtin_amdgcn_make_buffer_rsrc((void*)nb, 0, 0x7fffffff, 0x00020000);
    gemm8_stage<NJ, GN>(mr, mld, mvo, nr, nld, nvo, 0, lds, wid);
    gemm8_stage<NJ, GN>(mr, mld, mvo, nr, nld, nvo, 1, lds + 65536, wid);
    for (int kt = 0; kt < nk; ++kt) {
        unsigned char* cur = lds + (kt & 1) * 65536;
        if (kt + 1 < nk) WAIT_V(4 + NJ); else WAIT_V(0);
        RAW_BARRIER();
        bf16x8 a[4], b[NJ];
        const unsigned char* ab = cur + (128 * wr + fr) * 128;
        const unsigned char* bb = cur + 32768 + (16 * NJ * wc + fr) * 128;
        const int sw0 = ((fq) ^ (fr & 7)) << 4, sw1 = ((4 + fq) ^ (fr & 7)) << 4;
#pragma unroll
        for (int j = 0; j < NJ; ++j) b[j] = *(const bf16x8*)(bb + j * 2048 + sw0);
#pragma unroll
        for (int mh = 0; mh < 2; ++mh) {
#pragma unroll
            for (int i = 0; i < 4; ++i) a[i] = *(const bf16x8*)(ab + (4 * mh + i) * 2048 + sw0);
#pragma unroll
            for (int i = 0; i < 4; ++i)
#pragma unroll
                for (int j = 0; j < NJ; ++j) acc[4 * mh + i][j] = mfma16(a[i], b[j], acc[4 * mh + i][j]);
        }
#pragma unroll
        for (int j = 0; j < NJ; ++j) b[j] = *(const bf16x8*)(bb + j * 2048 + sw1);
#pragma unroll
        for (int i = 0; i < 4; ++i) a[i] = *(const bf16x8*)(ab + i * 2048 + sw1);
#pragma unroll
        for (int i = 0; i < 4; ++i)
#pragma unroll
            for (int j = 0; j < NJ; ++j) acc[i][j] = mfma16(a[i], b[j], acc[i][j]);
#pragma unroll
        for (int i = 0; i < 4; ++i) a[i] = *(const bf16x8*)(ab + (4 + i) * 2048 + sw1);
        RAW_BARRIER();
        if (kt + 2 < nk) gemm8_stage<NJ, GN>(mr, mld, mvo, nr, nld, nvo, kt + 2, cur, wid);
#pragma unroll
        for (int i = 0; i < 4; ++i)
#pragma unroll
            for (int j = 0; j < NJ; ++j) acc[4 + i][j] = mfma16(a[i], b[j], acc[4 + i][j]);
    }
    __syncthreads();
    __builtin_amdgcn_sched_barrier(0);
}
template <int NJ>
__device__ __forceinline__ void zero_acc8(f32x4 (&acc)[8][NJ]) {
#pragma unroll
    for (int i = 0; i < 8; ++i)
#pragma unroll
        for (int j = 0; j < NJ; ++j) acc[i][j] = (f32x4){0.f, 0.f, 0.f, 0.f};
}

namespace pg8 {
#define PG8_LAS __attribute__((address_space(3)))
constexpr int BM = 256, BK = 64, HALF = 128, HTB = HALF * BK * 2, STAGE_BYTES = 8 * HTB;
__device__ __forceinline__ int lds_byte(int r, int c) { const int st = (r >> 4) * 2 + (c >> 5), rr = r & 15, cc = c & 31, ob = rr * 64 + cc * 2; return st * 1024 + (ob ^ (((ob >> 9) & 1) << 5)); }
__device__ __forceinline__ void stage_rc(int b, int& R, int& C) { const int st = b / 1024, sb = b % 1024, swz = sb ^ (((sb >> 9) & 1) << 5); R = (st >> 1) * 16 + swz / 64; C = (st & 1) * 32 + (swz % 64) / 2; }
__device__ __forceinline__ int perm32(int rho) { const int n = rho >> 4, i = rho & 15; return 8 * (i >> 2) + 4 * n + (i & 3); }
struct Unit { int pm, pn; };
template <class Epi, class Sched>
__device__ __forceinline__ void gemm_phase(unsigned char* lds_, const int K, const Sched& S, const Epi& E, const int tid, const unsigned char* wsbase) {
    PG8_LAS unsigned char* lds = (PG8_LAS unsigned char*)lds_;
    const int wid = __builtin_amdgcn_readfirstlane(tid >> 6), lane = tid & 63, wr = wid >> 2, wc = wid & 3, fr = lane & 15, fq = lane >> 4;
    const int nt = K / BK;
    unsigned voffA[2], voffB[2];
#pragma unroll
    for (int i = 0; i < 2; ++i) { int R, C; stage_rc(tid * 16 + i * 8192, R, C); const int Rb = (R & ~31) + perm32(R & 31);
        voffA[i] = (unsigned)(R * K + C) * 2u; voffB[i] = (unsigned)(Rb * K + C) * 2u; }
    const unsigned kstep = (unsigned)(BK * 2);
    const unsigned hstep = (unsigned)HALF * K * 2;
    const __amdgpu_buffer_rsrc_t rsrc = __builtin_amdgcn_make_buffer_rsrc((void*)wsbase, 0, 0x7fffffff, 0x00020000);
    const unsigned ldsw = (unsigned)wid * 1024u;
    const int aoff = lds_byte(wr * 64 + fr, fq * 8), boff = lds_byte(wc * 32 + fr, fq * 8);
#define PG8_SA(b, h) (((b) * 2 + (h)) * HTB)
#define PG8_SB(b, h) ((4 + (b) * 2 + (h)) * HTB)
#define PG8_STAGE(bufoff, gbase, voff) do { _Pragma("unroll") for (int _i = 0; _i < 2; ++_i) \
        __builtin_amdgcn_raw_ptr_buffer_load_lds(rsrc, (PG8_LAS void*)(lds + (bufoff) + ldsw + _i * 8192), 16, (int)(voff)[_i], (int)(gbase), 0, 0); } while (0)
#define PG8_LDA(dst, b, h) do { _Pragma("unroll") for (int m = 0; m < 4; ++m) _Pragma("unroll") for (int k = 0; k < 2; ++k) dst[m][k] = *(const PG8_LAS bf16x8*)(lds + PG8_SA(b, h) + aoff + m * 2048 + k * 1024); } while (0)
#define PG8_LDB(dst, b, h) do { _Pragma("unroll") for (int n = 0; n < 2; ++n) _Pragma("unroll") for (int k = 0; k < 2; ++k) dst[n][k] = *(const PG8_LAS bf16x8*)(lds + PG8_SB(b, h) + boff + n * 2048 + k * 1024); } while (0)
#define PG8_MMA(ai, bj, At, Bt) do { __builtin_amdgcn_s_setprio(1); _Pragma("unroll") for (int m = 0; m < 4; ++m) _Pragma("unroll") for (int n = 0; n < 2; ++n) _Pragma("unroll") for (int k = 0; k < 2; ++k) \
        acc[ai][bj][m][n] = __builtin_amdgcn_mfma_f32_16x16x32_bf16(Bt[n][k], At[m][k], acc[ai][bj][m][n], 0, 0, 0); __builtin_amdgcn_s_setprio(0); } while (0)
#define PG8_WAIT_V(n) asm volatile("s_waitcnt vmcnt(" #n ")" ::: "memory")
#define PG8_WAIT_L(n) asm volatile("s_waitcnt lgkmcnt(" #n ")" ::: "memory")
#define PG8_BAR __builtin_amdgcn_s_barrier()
#define PG8_SCHED __builtin_amdgcn_sched_barrier(0)
    typename Sched::U cur, nxt; int ui = 0;
    if (!S.next(0, cur)) return;
    unsigned cA, cB; S.ptrs(cur, cA, cB);
    constexpr bool GA = Sched::GATHER;
    unsigned vA[GA ? 2 : 1][2], nvA[GA ? 2 : 1][2];
    if constexpr (GA) { S.rows(cur, tid, vA);
#pragma unroll
        for (int h = 0; h < 2; ++h)
#pragma unroll
            for (int i = 0; i < 2; ++i) nvA[h][i] = vA[h][i]; }
#define PG8_STAGE_A(bufoff, gbase, h, nextu) do { if constexpr (GA) { if (nextu) PG8_STAGE(bufoff, gbase, nvA[h]); else PG8_STAGE(bufoff, gbase, vA[h]); } \
        else PG8_STAGE(bufoff, (gbase) + (h) * hstep, voffA); } while (0)
    PG8_STAGE(PG8_SB(0, 0), cB, voffB); PG8_STAGE_A(PG8_SA(0, 0), cA, 0, false); PG8_STAGE(PG8_SB(0, 1), cB + hstep, voffB); PG8_STAGE_A(PG8_SA(0, 1), cA, 1, false);
    if (wr == 1) PG8_BAR;
    PG8_WAIT_V(4); PG8_BAR;
    PG8_STAGE(PG8_SB(1, 0), cB + kstep, voffB); PG8_STAGE_A(PG8_SA(1, 0), cA + kstep, 0, false); PG8_STAGE(PG8_SB(1, 1), cB + hstep + kstep, voffB);
    PG8_WAIT_V(6); PG8_BAR;
    PG8_SCHED;
    f32x4 acc[2][2][4][2];
#pragma unroll
    for (int a = 0; a < 2; ++a)
#pragma unroll
        for (int b = 0; b < 2; ++b)
#pragma unroll
            for (int m = 0; m < 4; ++m)
#pragma unroll
                for (int n = 0; n < 2; ++n) acc[a][b][m][n] = (f32x4){0.f, 0.f, 0.f, 0.f};
    bf16x8 At[4][2], B0[2][2], B1[2][2];
    for (;;) {
        const bool has_next = S.next(ui + 1, nxt);
        unsigned nA = cA, nB = cB; if (has_next) S.ptrs(nxt, nA, nB);
        if constexpr (GA) { if (has_next) S.rows(nxt, tid, nvA); }
        for (int t = 0; t < nt; t += 2) {
            const bool last = (t == nt - 2);
            const unsigned a1 = cA + (unsigned)(t + 1) * kstep;
            const unsigned a2 = last ? nA : cA + (unsigned)(t + 2) * kstep, b2 = last ? nB : cB + (unsigned)(t + 2) * kstep;
            const unsigned a3 = a2 + kstep, b3 = b2 + kstep;
            PG8_LDB(B0, 0, 0); PG8_SCHED; PG8_LDA(At, 0, 0); PG8_STAGE_A(PG8_SA(1, 1), a1, 1, false);
            PG8_WAIT_L(8); PG8_BAR; PG8_WAIT_L(0); PG8_MMA(0, 0, At, B0); PG8_BAR; PG8_SCHED;
            PG8_LDB(B1, 0, 1); PG8_STAGE(PG8_SB(0, 0), b2, voffB);
            PG8_BAR; PG8_WAIT_L(0); PG8_MMA(0, 1, At, B1); PG8_BAR;
            PG8_LDA(At, 0, 1); PG8_STAGE_A(PG8_SA(0, 0), a2, 0, last);
            PG8_BAR; PG8_WAIT_L(0); PG8_MMA(1, 0, At, B0); PG8_BAR; PG8_SCHED;
            PG8_STAGE(PG8_SB(0, 1), b2 + hstep, voffB);
            PG8_WAIT_V(6); PG8_BAR; PG8_MMA(1, 1, At, B1); PG8_BAR;
            PG8_LDB(B0, 1, 0); PG8_SCHED; PG8_LDA(At, 1, 0); PG8_STAGE_A(PG8_SA(0, 1), a2, 1, last);
            PG8_WAIT_L(8); PG8_BAR; PG8_WAIT_L(0); PG8_MMA(0, 0, At, B0); PG8_BAR; PG8_SCHED;
            PG8_LDB(B1, 1, 1); PG8_STAGE(PG8_SB(1, 0), b3, voffB);
            PG8_BAR; PG8_WAIT_L(0); PG8_MMA(0, 1, At, B1); PG8_BAR;
            PG8_LDA(At, 1, 1); PG8_STAGE_A(PG8_SA(1, 0), a3, 0, last);
            PG8_BAR; PG8_WAIT_L(0); PG8_MMA(1, 0, At, B0); PG8_BAR; PG8_SCHED;
            PG8_STAGE(PG8_SB(1, 1), b3 + hstep, voffB);
            PG8_WAIT_V(6); PG8_BAR; PG8_MMA(1, 1, At, B1); PG8_BAR;
        }
        E(acc, cur, wr, wc, fr, fq);
        if (!has_next) break;
#pragma unroll
        for (int a = 0; a < 2; ++a)
#pragma unroll
            for (int b = 0; b < 2; ++b)
#pragma unroll
                for (int m = 0; m < 4; ++m)
#pragma unroll
                    for (int n = 0; n < 2; ++n) acc[a][b][m][n] = (f32x4){0.f, 0.f, 0.f, 0.f};
        cur = nxt; cA = nA; cB = nB; ++ui;
        if constexpr (GA) {
#pragma unroll
            for (int h = 0; h < 2; ++h)
#pragma unroll
                for (int i = 0; i < 2; ++i) vA[h][i] = nvA[h][i]; }
    }
    PG8_WAIT_V(0);
    if (wr == 0) PG8_BAR;
    PG8_BAR;
#undef PG8_SA
#undef PG8_SB
#undef PG8_STAGE
#undef PG8_STAGE_A
#undef PG8_LDA
#undef PG8_LDB
#undef PG8_MMA
#undef PG8_WAIT_V
#undef PG8_WAIT_L
#undef PG8_BAR
#undef PG8_SCHED
}
}

struct TJob { const float* src; bf16_t* dst; int ld, k0, n0, mode, kdst; };
__device__ __forceinline__ void tcvt_load(const TJob& J, float4 (&v)[4], int tid) {
#pragma unroll
    for (int i = 0; i < 4; ++i) {
        const int kk = (tid >> 4) + 16 * i, c4 = (tid & 15) * 4, cd = J.n0 + c4;
        int orig = cd; bool ok = true;
        if (J.mode == 1) {
            if (cd < 896) orig = cd;
            else if (cd < 1024) orig = cd - 896 + 1024;
            else if (cd < 2048) { const int q = cd - 1024, hd = q >> 6, pp = q & 63;
                const int d = (pp & 4) ? 32 + 4 * (pp >> 3) + (pp & 3) : 4 * (pp >> 3) + (pp & 3);
                orig = 1304 + hd * 64 + d; }
            else if (cd < 5120) orig = cd - 2048 + 3352;
            else if (cd < 5144) orig = cd - 5120 + 1280;
            else if (cd < 5376) ok = false;
            else if (cd < 5504) orig = cd - 5376 + 896;
            else if (cd < 5632) orig = cd - 5504 + 1152;
            else orig = cd - 5632 + 2328;
        }
        v[i] = make_float4(0.f, 0.f, 0.f, 0.f);
        if (ok) v[i] = *(const float4*)(J.src + (size_t)(J.k0 + kk) * J.ld + orig);
    }
}
__device__ __forceinline__ void tcvt_finish(const TJob& J, const float4 (&v)[4], unsigned char* lds, int tid) {
    float* tile = (float*)lds;
#pragma unroll
    for (int i = 0; i < 4; ++i) {
        const int kk = (tid >> 4) + 16 * i, c4 = (tid & 15) * 4;
        tile[kk * 65 + c4 + 0] = v[i].x; tile[kk * 65 + c4 + 1] = v[i].y; tile[kk * 65 + c4 + 2] = v[i].z; tile[kk * 65 + c4 + 3] = v[i].w;
    }
    __syncthreads();
#pragma unroll
    for (int i = 0; i < 2; ++i) {
        const int q = tid + 256 * i, n = q >> 3, kc = q & 7;
        float x[8];
#pragma unroll
        for (int j = 0; j < 8; ++j) x[j] = tile[(kc * 8 + j) * 65 + n];
        u32x4 w; w.x = pack2(x[0], x[1]); w.y = pack2(x[2], x[3]); w.z = pack2(x[4], x[5]); w.w = pack2(x[6], x[7]);
        int drow = J.n0 + n; if (J.mode >= 2) drow = 8 * (drow >> 2) + (drow & 3) + (J.mode == 3 ? 4 : 0);
        *(u32x4*)(J.dst + (size_t)drow * J.kdst + J.k0 + kc * 8) = w;
    }
    __syncthreads();
}
__device__ __forceinline__ void tcvt_tile(const float* src, int ld_src, int k0, int n0, int mode, bf16_t* dst, int kdst, unsigned char* lds, int half) {
    TJob J; J.src = src; J.dst = dst; J.ld = ld_src; J.k0 = k0; J.n0 = n0; J.mode = mode; J.kdst = kdst;
    const int tid = (ltid() & 255); float4 v[4];
    tcvt_load(J, v, tid); tcvt_finish(J, v, lds, tid);
}

__device__ __forceinline__ void tcvt_decode(const Params& p, unsigned char* ws, int layer, int t, TJob& J) {
    constexpr int J0 = 16 * 104, J1 = 8 * 16, J2 = 256, J3 = 256, J4 = 2048, J5 = 2048;
    int u = t;
        if (u < J0) { J.src = p.w_in + (size_t)layer * 1024 * DIN; J.ld = DIN; J.k0 = (u % 16) * 64; J.n0 = (u / 16) * 64; J.mode = 1; J.dst = (bf16_t*)(ws + WS_WIN); J.kdst = 1024; return; }
        u -= J0;
        if (u < J1) { J.src = p.w_br_a + (size_t)layer * 512 * 1024; J.ld = 1024; J.k0 = (u % 8) * 64; J.n0 = (u / 8) * 64; J.mode = 0; J.dst = (bf16_t*)(ws + WS_WA); J.kdst = 512; return; }
        u -= J1;
        if (u < J2) { J.src = p.w_br_b + (size_t)layer * 1024 * 1024; J.ld = 1024; J.k0 = (u % 16) * 64; J.n0 = (u / 16) * 64; J.mode = 0; J.dst = (bf16_t*)(ws + WS_WB); J.kdst = 1024; return; }
        u -= J2;
        if (u < J3) { J.src = p.w_o + (size_t)layer * 1024 * 1024; J.ld = 1024; J.k0 = (u % 16) * 64; J.n0 = (u / 16) * 64; J.mode = 0; J.dst = (bf16_t*)(ws + WS_WO); J.kdst = 1024; return; }
        u -= J3;
        if (u < J4 + J5) {
            const bool up = u >= J4; if (up) u -= J4;
            const int e = u / 128, v = u % 128;
            J.src = (up ? p.w_up : p.w_gate) + ((size_t)layer * NE + e) * 1024 * 512; J.ld = 512; J.k0 = (v % 16) * 64; J.n0 = (v / 16) * 64; J.mode = up ? 3 : 2;
            J.dst = (bf16_t*)(ws + WS_WG) + (size_t)e * 1024 * 1024; J.kdst = 1024; return;
        }
        u -= J4 + J5;
        { const int e = u / 128, v = u % 128;
          J.src = p.w_down + ((size_t)layer * NE + e) * 512 * 1024; J.ld = 1024; J.k0 = (v % 8) * 64; J.n0 = (v / 8) * 64; J.mode = 0; J.dst = (bf16_t*)(ws + WS_WD) + (size_t)e * 1024 * 512; J.kdst = 512; }
}


__device__ __forceinline__ void phase_pw(const Params& p, int layer, unsigned char* lds, int parts, int half) {
    const int bid = (blockIdx.x * 2 + half), nblk = (gridDim.x * 2), tid = (ltid() & 255);
    unsigned char* ws = launder(p.ws);
    constexpr int J0 = 16 * 104, J1 = 8 * 16, J2 = 256, J3 = 256, J4 = 2048, J5 = 2048, J6 = 2048, JT = J0 + J1 + J2 + J3 + J4 + J5 + J6;
    const int t_lo = (parts & 1) ? 0 : (parts & 2) ? J0 : J0 + J1 + J2 + J3;
    const int t_hi = (parts & 4) ? JT : (parts & 2) ? J0 + J1 + J2 + J3 : (parts & 1) ? J0 : 0;
    if (t_lo + bid < t_hi) {
        float4 v[4]; { TJob J; tcvt_decode(p, ws, layer, t_lo + bid, J); tcvt_load(J, v, tid); }
        for (int t = t_lo + bid; t < t_hi; t += nblk) {
            float4 vn[4];
            if (t + nblk < t_hi) { TJob J; tcvt_decode(p, ws, layer, t + nblk, J); tcvt_load(J, vn, tid); }
            { TJob J; tcvt_decode(p, ws, layer, t, J); tcvt_finish(J, v, lds, tid); }
#pragma unroll
            for (int i = 0; i < 4; ++i) v[i] = vn[i];
        }
    }
    if (parts & 1) {
    for (int t = bid; t < 64; t += nblk) {
        const int kv = t >> 5, kt = t & 31;
        tcvt_tile(p.cmp_w1 + ((size_t)layer * 2 + kv) * 2048 * 64, 64, kt * 64, 0, 0, (bf16_t*)(ws + WS_W1T) + (size_t)kv * 64 * 2048, 2048, lds, half);
    }
    if (bid >= nblk - 2) {
        const int kv = nblk - 1 - bid, n = tid & 63, part = tid >> 6;
        const float* w1 = p.cmp_w1 + ((size_t)layer * 2 + kv) * 2048 * 64; const float* pos = p.cmp_pos + ((size_t)layer * 2 + kv) * 2048;
        float a = 0.f;
        for (int k = part * 512; k < part * 512 + 512; ++k) a += pos[k] * w1[(size_t)k * 64 + n];
        float* red = (float*)lds;
        __syncthreads(); red[tid] = a; __syncthreads();
        if (tid < 64) ((float*)(ws + WS_B1))[kv * 64 + tid] = red[tid] + red[tid + 64] + red[tid + 128] + red[tid + 192];
        __syncthreads();
    }
    }
    if (parts & 8) {
        const float4* xs = (const float4*)p.x; u32x2* xb = (u32x2*)(ws + WS_XB);
        for (size_t i = (size_t)bid * HT + tid; i < (size_t)T_ * 1024 / 4; i += (size_t)nblk * HT) {
            float4 v = xs[i]; u32x2 w; w.x = pack2(v.x, v.y); w.y = pack2(v.z, v.w); xb[i] = w;
        }
        for (int n = bid * HT + tid; n < 8192; n += nblk * HT) {
            int bk;
            if (n < 16) bk = n;
            else { const int th[15] = {22, 30, 40, 54, 73, 99, 134, 182, 246, 332, 450, 609, 825, 1117, 1513}; bk = 16;
#pragma unroll
                for (int k = 0; k < 15; ++k) bk += (n >= th[k]) ? 1 : 0; }
            (ws + WS_BUCKET)[n] = (unsigned char)bk;
        }
        for (int i = bid * HT + tid; i < 8192 * 32; i += nblk * HT) {
            const int pos = i >> 5, d = i & 31;
            const float inv = powf(10000.f, -(float)d * 2.0f / 64.f);
            const float ang = (float)pos * inv;
            float sn, cs; sincosf(ang, &sn, &cs);
            ((float2*)(ws + WS_ROPE))[i] = make_float2(cs, sn);
        }
        if (bid == 0) for (int i = tid; i < 8192; i += HT) ((unsigned*)(ws + WS_CTL))[i] = 0u;
    }
}

__device__ __forceinline__ float fsig(float x) { return __builtin_amdgcn_rcpf(1.f + __builtin_amdgcn_exp2f(-1.4426950408889634f * x)); }
template <int KIND>
__device__ __forceinline__ void g1_epi(const f32x4 (&acc)[2][2][4][2], unsigned char* ws, int r0, int c0, int wr, int wc, int fr, int fq) {
#pragma unroll
    for (int ai = 0; ai < 2; ++ai)
#pragma unroll
        for (int m = 0; m < 4; ++m) {
            const int row = r0 + 128 * ai + 64 * wr + 16 * m + fr + vzero();
#pragma unroll
            for (int bj = 0; bj < 2; ++bj) {
                const int col = c0 + 128 * bj + 32 * wc + 8 * fq;
                f32x4 v0 = acc[ai][bj][m][0], v1 = acc[ai][bj][m][1];
                if (KIND == 5) {
                    const int b = col >> 13, sq = col & (S_ - 1);
                    bf16_t* dst;
                    if (row < C_VW) { const int c = row - C_VS; dst = (bf16_t*)(ws + WS_VST) + ((size_t)(b * 2 + (c >> 6)) * 64 + (c & 63)) * S_ + sq; }
                    else if (row < C_VR) { const int c = row - C_VW; dst = (bf16_t*)(ws + WS_VWT) + ((size_t)(b * 2 + (c >> 6)) * 64 + (c & 63)) * S_ + sq; }
                    else { const int c = row - C_VR; dst = (bf16_t*)(ws + WS_VRT) + ((size_t)(b * 8 + (c >> 7)) * 128 + (c & 127)) * S_ + sq; }
                    u32x4 w; w.x = pack2(v0[0], v0[1]); w.y = pack2(v0[2], v0[3]); w.z = pack2(v1[0], v1[1]); w.w = pack2(v1[2], v1[3]);
                    *(u32x4*)dst = w;
                    continue;
                }
                if (KIND == 1 || KIND == 2) {
                    const float2* rope = (const float2*)(ws + WS_ROPE);
                    const int pos = row & (S_ - 1), d = 16 * (wc & 1) + 4 * fq;
                    const float4 cs01 = *(const float4*)(rope + pos * 32 + d), cs23 = *(const float4*)(rope + pos * 32 + d + 2);
                    const float c[4] = {cs01.x, cs01.z, cs23.x, cs23.z}, sn[4] = {cs01.y, cs01.w, cs23.y, cs23.w};
                    const float sc = (KIND == 2) ? 0.125f : 1.0f;
                    f32x4 y1, y2;
#pragma unroll
                    for (int r = 0; r < 4; ++r) { y1[r] = (v0[r] * c[r] - v1[r] * sn[r]) * sc; y2[r] = (v0[r] * sn[r] + v1[r] * c[r]) * sc; }
                    v0 = y1; v1 = y2;
                } else if (KIND == 3) {
#pragma unroll
                    for (int r = 0; r < 4; ++r) { v0[r] = v0[r] * fsig(v0[r]); v1[r] = v1[r] * fsig(v1[r]); }
                } else if (KIND == 4) {
#pragma unroll
                    for (int r = 0; r < 4; ++r) { v0[r] = fsig(v0[r]); v1[r] = fsig(v1[r]); }
                }
                u32x4 w; w.x = pack2(v0[0], v0[1]); w.y = pack2(v0[2], v0[3]); w.z = pack2(v1[0], v1[1]); w.w = pack2(v1[2], v1[3]);
                *(u32x4*)((bf16_t*)(ws + WS_P) + (size_t)row * LD + col) = w;
            }
        }
}
struct G1Order {      typedef pg8::Unit U; static constexpr bool GATHER = false;
    int xcd, slot, per;
    __device__ __forceinline__ bool next(int i, pg8::Unit& u) const {
        const int j = slot + i * per; if (j >= 208) return false;
        if (j < 192) { u.pm = j / 3; u.pn = xcd + 8 * (j % 3); } else { const int q = j - 192; u.pm = 8 * xcd + (q >> 1); u.pn = 24 + (q & 1); }
        return true;
    }
    __device__ __forceinline__ void ptrs(const pg8::Unit& u, unsigned& A, unsigned& B) const {
        const unsigned x = (unsigned)WS_XB + (unsigned)u.pm * (256u * 1024u * 2u), w = (unsigned)WS_WIN + (unsigned)u.pn * (256u * 1024u * 2u);
        if (u.pn >= 21) { A = w; B = x; } else { A = x; B = w; }
    }
};
struct G1Epi {
    unsigned char* ws;
    __device__ __forceinline__ void operator()(const f32x4 (&acc)[2][2][4][2], const pg8::Unit& u, int wr, int wc, int fr, int fq) const {
        const int pn = u.pn, tok0 = u.pm * 256, n0 = pn * 256;
        if (pn >= 21) g1_epi<5>(acc, ws, n0, tok0, wr, wc, fr, fq);
        else if (pn >= 12) g1_epi<4>(acc, ws, tok0, n0, wr, wc, fr, fq);
        else if (pn >= 8) g1_epi<3>(acc, ws, tok0, n0, wr, wc, fr, fq);
        else if (pn >= 6) g1_epi<2>(acc, ws, tok0, n0, wr, wc, fr, fq);
        else if (pn >= 4) g1_epi<1>(acc, ws, tok0, n0, wr, wc, fr, fq);
        else g1_epi<0>(acc, ws, tok0, n0, wr, wc, fr, fq);
    }
};
__device__ __forceinline__ void phase_g1(const Params& p, int layer, unsigned char* lds) {
    unsigned char* ws = launder(p.ws);
    G1Order S; S.xcd = blockIdx.x & 7; S.slot = blockIdx.x >> 3; S.per = gridDim.x >> 3;
    G1Epi E; E.ws = ws;
    pg8::gemm_phase<G1Epi, G1Order>(lds, 1024, S, E, ltid(), ws);
}

__device__ __forceinline__ void load_tile64(const bf16_t* base, size_t rowStride, unsigned char* dst, int wid, int lane) {
    const int c = ((lane & 7) ^ (lane >> 3)) * 8;
#pragma unroll
    for (int i = 0; i < 2; ++i) { const int j = wid + 4 * i, row = 8 * j + (lane >> 3); glds16(base + (size_t)row * rowStride + c, dst + j * 1024); }
}
__device__ __forceinline__ void load_tile128(const bf16_t* base, size_t rowStride, unsigned char* dst, int wid, int lane) {
    const int c = ((lane & 7) ^ (lane >> 3)) * 8;
#pragma unroll
    for (int i = 0; i < 4; ++i) { const int j = wid + 4 * i, row = 8 * j + (lane >> 3); glds16(base + (size_t)row * rowStride + c, dst + j * 1024); }
}
__device__ __forceinline__ void load_tile128w(const bf16_t* base, size_t rowStride, unsigned char* dst, int wid, int lane) {
    const int c = ((lane & 15) ^ ((4 * wid + (lane >> 4)) & 15)) * 8;
#pragma unroll
    for (int i = 0; i < 8; ++i) { const int j = wid + 4 * i, row = 4 * j + (lane >> 4); glds16(base + (size_t)row * rowStride + c, dst + j * 1024); }
}
__device__ __forceinline__ bf16x8 lds_frag128(const unsigned char* tile, int row, int chunk) {
    return *(const bf16x8*)(tile + row * 128 + ((chunk ^ (row & 7)) << 4));
}
__device__ __forceinline__ bf16x8 lds_frag256(const unsigned char* tile, int row, int chunk) {
    return *(const bf16x8*)(tile + row * 256 + ((chunk ^ (row & 15)) << 4));
}
__device__ __forceinline__ bf16x8 lds_vfrag128(const unsigned char* tile, int row, int kbase, int fq) {
    const int ca = (kbase >> 3) + (fq >> 1), hb = (fq & 1) * 8;
    const u32x2 a = *(const u32x2*)(tile + row * 128 + ((ca ^ (row & 7)) << 4) + hb);
    const u32x2 b = *(const u32x2*)(tile + row * 128 + (((ca + 2) ^ (row & 7)) << 4) + hb);
    u32x4 w; w.x = a.x; w.y = a.y; w.z = b.x; w.w = b.y;
    return __builtin_bit_cast(bf16x8, w);
}
__device__ __forceinline__ bf16x8 lds_vfrag256(const unsigned char* tile, int row, int kbase, int fq) {
    const int ca = (kbase >> 3) + (fq >> 1), hb = (fq & 1) * 8;
    const u32x2 a = *(const u32x2*)(tile + row * 256 + ((ca ^ (row & 15)) << 4) + hb);
    const u32x2 b = *(const u32x2*)(tile + row * 256 + (((ca + 2) ^ (row & 15)) << 4) + hb);
    u32x4 w; w.x = a.x; w.y = a.y; w.z = b.x; w.w = b.y;
    return __builtin_bit_cast(bf16x8, w);
}
__device__ __forceinline__ bf16x8 pack8(f32x4 a, f32x4 b) {
    u32x4 w; w.x = pack2(a[0], a[1]); w.y = pack2(a[2], a[3]); w.z = pack2(b[0], b[1]); w.w = pack2(b[2], b[3]);
    return __builtin_bit_cast(bf16x8, w);
}

__device__ __forceinline__ float gelu_tanh(float x) {
    const float u = 0.7978845608028654f * (x + 0.044715f * x * x * x);
    return 0.5f * x * (1.f + tanhf(u));
}
__device__ __forceinline__ void compress_item(const Params& p, int layer, int item, unsigned char* lds, int half) {
    unsigned char* ws = launder(p.ws);
    const int tid = (ltid() & 255), lane = tid & 63, wid = tid >> 6, wr = wid >> 1, wc = wid & 1, fr = lane & 15, fq = lane >> 4;
    const int mtile = item & 3, g = (item >> 2) & 1, b = (item >> 3) & 1, kv = item >> 4;
    const int i0 = mtile * 128;
    const bf16_t* P = (const bf16_t*)(ws + WS_P);
    const bf16_t* W1T = (const bf16_t*)(ws + WS_W1T) + (size_t)kv * 64 * 2048;
    const int col = (kv ? C_VC : C_KC) + g * 64;
    const int ldc = ((lane & 7) ^ (lane >> 3)) * 8;
    const bf16_t* ap[4];
#pragma unroll
    for (int i = 0; i < 4; ++i) ap[i] = P + ((size_t)b * S_ + 16 * (i0 + 32 * i + 8 * wid + (lane >> 3))) * LD + col + ldc;
    const bf16_t* bp[2];
#pragma unroll
    for (int i = 0; i < 2; ++i) bp[i] = W1T + (size_t)(8 * (wid + 4 * i) + (lane >> 3)) * 2048 + ldc;
    f32x4 acc[4][2];
#pragma unroll
    for (int i = 0; i < 4; ++i)
#pragma unroll
        for (int j = 0; j < 2; ++j) acc[i][j] = (f32x4){0.f, 0.f, 0.f, 0.f};
    __syncthreads();
#define CSTAGE(buf, l) do { unsigned char* st_ = lds + (buf) * 24576; \
        _Pragma("unroll") for (int i = 0; i < 4; ++i) glds16(ap[i] + (size_t)(l) * LD, st_ + (4 * i + wid) * 1024); \
        _Pragma("unroll") for (int i = 0; i < 2; ++i) glds16(bp[i] + (l) * 64, st_ + 16384 + (wid + 4 * i) * 1024); } while (0)
    CSTAGE(0, 0); wait_vm0(); __syncthreads();
    for (int l = 0; l < 32; ++l) {
        const unsigned char* st = lds + (l & 1) * 24576;
        if (l + 1 < 32) CSTAGE((l + 1) & 1, l + 1);
#pragma unroll
        for (int ks = 0; ks < 2; ++ks) {
            bf16x8 a[4], bb[2];
#pragma unroll
            for (int i = 0; i < 4; ++i) a[i] = lds_frag128(st, 64 * wr + 16 * i + fr, 4 * ks + fq);
#pragma unroll
            for (int j = 0; j < 2; ++j) bb[j] = lds_frag128(st + 16384, 32 * wc + 16 * j + fr, 4 * ks + fq);
#pragma unroll
            for (int i = 0; i < 4; ++i)
#pragma unroll
                for (int j = 0; j < 2; ++j) acc[i][j] = mfma16(a[i], bb[j], acc[i][j]);
        }
        wait_vm0(); __syncthreads();
    }
#undef CSTAGE
    float* hid = (float*)lds;
    const float* b1 = (const float*)(ws + WS_B1) + kv * 64;
#pragma unroll
    for (int j = 0; j < 2; ++j) {
        const int n = 32 * wc + 16 * j + fr; const float bias = b1[n + vzero()];
#pragma unroll
        for (int i = 0; i < 4; ++i)
#pragma unroll
            for (int r = 0; r < 4; ++r) hid[(64 * wr + 16 * i + 4 * fq + r) * 65 + n] = gelu_tanh(acc[i][j][r] + bias);
    }
    __syncthreads();
    {
        const int row = tid >> 1, nb = (tid & 1) * 32, ci = i0 + row;
        const float* w2 = p.cmp_w2 + ((size_t)layer * 2 + kv) * 64 * 64;
        float o[32];
#pragma unroll
        for (int q = 0; q < 32; ++q) o[q] = 0.f;
        for (int n = 0; n < 64; ++n) {
            const float h = hid[row * 65 + n];
#pragma unroll
            for (int q4 = 0; q4 < 8; ++q4) { const float4 w = *(const float4*)(w2 + n * 64 + nb + 4 * q4); o[4 * q4] += h * w.x; o[4 * q4 + 1] += h * w.y; o[4 * q4 + 2] += h * w.z; o[4 * q4 + 3] += h * w.w; }
        }
        if (kv == 0) {
            bf16_t* dst = (bf16_t*)(ws + WS_KCC) + ((size_t)(b * 2 + g) * 512 + ci) * 64 + nb;
#pragma unroll
            for (int q = 0; q < 32; q += 4) { f32x4 v = {o[q], o[q + 1], o[q + 2], o[q + 3]}; if (ci >= 511) v = (f32x4){0.f, 0.f, 0.f, 0.f}; *(u32x2*)(dst + q) = pack4(v); }
        } else {
            bf16_t* dst = (bf16_t*)(ws + WS_VCCT) + ((size_t)(b * 2 + g) * 64 + nb) * 512 + ci;
#pragma unroll
            for (int q = 0; q < 32; ++q) dst[(size_t)q * 512] = f2bf(ci >= 511 ? 0.f : o[q]);
        }
    }
    __syncthreads();
}

__device__ __forceinline__ float ret_lg2(int h) { const float gam = 1.f - exp2f(-5.f - (float)h); return log2f(gam); }

__device__ __forceinline__ void retkv_item(const Params& p, int item, unsigned char* lds, int half) {
    unsigned char* ws = launder(p.ws);
    const int tid = (ltid() & 255), lane = tid & 63, wid = tid >> 6, fr = lane & 15, fq = lane >> 4;
    const int n = item & 63, h = (item >> 6) & 7, b = item >> 9;
    const size_t tok0 = (size_t)b * S_ + 128 * n;
    unsigned char* vL = lds; unsigned char* kL = lds + 32768;
    load_tile128w((const bf16_t*)(ws + WS_VRT) + ((size_t)(b * 8 + h) * 128) * S_ + 128 * n, S_, vL, wid, lane);
    load_tile128((const bf16_t*)(ws + WS_P) + tok0 * LD + C_KR + h * 64, LD, kL, wid, lane);
    wait_vm0(); __syncthreads();
    const float lg2 = ret_lg2(h);
    f32x4 acc[2][4];
#pragma unroll
    for (int m = 0; m < 2; ++m)
#pragma unroll
        for (int nt = 0; nt < 4; ++nt) acc[m][nt] = (f32x4){0.f, 0.f, 0.f, 0.f};
#pragma unroll
    for (int ks = 0; ks < 4; ++ks) {
        bf16x8 a[2], bb[4];
#pragma unroll
        for (int m = 0; m < 2; ++m) a[m] = lds_frag256(vL, 32 * wid + 16 * m + fr, 4 * ks + fq);
        float dec[8];
#pragma unroll
        for (int j = 0; j < 8; ++j) dec[j] = exp2f((float)(127 - (32 * ks + 8 * fq + j)) * lg2);
#pragma unroll
        for (int nt = 0; nt < 4; ++nt) {
            const int d = 16 * nt + fr;
            float v[8];
#pragma unroll
            for (int j = 0; j < 8; ++j) {
                const int tk = 32 * ks + 8 * fq + j;
                const bf16_t kvv = *(const bf16_t*)(kL + tk * 128 + (((d >> 3) ^ (tk & 7)) << 4) + (d & 7) * 2);
                v[j] = bf2f(kvv) * dec[j];
            }
            u32x4 w; w.x = pack2(v[0], v[1]); w.y = pack2(v[2], v[3]); w.z = pack2(v[4], v[5]); w.w = pack2(v[6], v[7]);
            bb[nt] = __builtin_bit_cast(bf16x8, w);
        }
#pragma unroll
        for (int m = 0; m < 2; ++m)
#pragma unroll
            for (int nt = 0; nt < 4; ++nt) acc[m][nt] = mfma16(a[m], bb[nt], acc[m][nt]);
    }
    float* KVT = (float*)(ws + WS_KVT) + ((size_t)(b * 8 + h) * 64 + n) * 8192;
#pragma unroll
    for (int m = 0; m < 2; ++m)
#pragma unroll
        for (int nt = 0; nt < 4; ++nt)
#pragma unroll
            for (int r = 0; r < 4; ++r) KVT[(32 * wid + 16 * m + 4 * fq + r) * 64 + 16 * nt + fr] = acc[m][nt][r];
    __syncthreads();
}

__device__ __forceinline__ void phase_p2(const Params& p, int layer, unsigned char* lds, int half) {
    for (int it = (blockIdx.x * 2 + half); it < 1024 + 32; it += (gridDim.x * 2)) {
        if (it < 32) compress_item(p, layer, it, lds, half); else retkv_item(p, it - 32, lds, half);
    }
}

constexpr int NSA_IMP = 32768, NSA_BUCKET = 65792, NSA_BIAS = 73984;

struct NsaLane { int t; int fr, fq, wid, lane; };

template <int BR, int PASS>
__device__ __forceinline__ void nsa_half(const unsigned char* kL, const unsigned char* vL, const unsigned char* lds, const bf16_t* qptr,
                                         f32x4 (&O)[4][4], float (&m)[4], float (&l)[4], int tile, int hf, bool selbit, const NsaLane& L, int qrow) {
    const int fr = L.fr, fq = L.fq;
    bf16x8 Kf[2][2];
#pragma unroll
    for (int i = 0; i < 2; ++i)
#pragma unroll
        for (int ks = 0; ks < 2; ++ks) Kf[i][ks] = lds_frag128(kL, 32 * hf + 16 * i + fr, 4 * ks + fq);
    unsigned vmask = 0; unsigned bk[2];
    const unsigned char* bucketL = lds + NSA_BUCKET;
#pragma unroll
    for (int i = 0; i < 2; ++i) {
        unsigned pk = 0;
#pragma unroll
        for (int r = 0; r < 4; ++r) {
            const int kk = 32 * hf + 16 * i + 4 * fq + r;
            int rel; bool ok;
            if (BR == 0) { rel = L.t - (16 * (64 * tile + kk) + 31); ok = rel >= 0; }
            else if (BR == 1) { rel = L.t - (64 * tile + kk); ok = selbit && rel >= 0; }
            else { rel = L.t - (64 * tile + kk); ok = rel >= 0 && rel < 512; }
            int rc = rel < 0 ? 0 : rel; rc = rc > 8191 ? 8191 : rc;
            pk |= (unsigned)bucketL[rc] << (8 * r);
            vmask |= (ok ? 1u : 0u) << (4 * i + r);
        }
        bk[i] = pk;
    }
    const float* biasL = (const float*)(lds + NSA_BIAS);
    float ia[2] = {0.f, 0.f}, ic[2] = {0.f, 0.f};
#pragma unroll
    for (int nt = 0; nt < 4; ++nt) {
        asm volatile("" ::: "memory");
        f32x4 S[2];
        const bf16x8 q0 = *(const bf16x8*)(qptr + nt * 64), q1 = *(const bf16x8*)(qptr + nt * 64 + 32);
#pragma unroll
        for (int i = 0; i < 2; ++i) {
            S[i] = (f32x4){0.f, 0.f, 0.f, 0.f};
            S[i] = mfma16(Kf[i][0], q0, S[i]); S[i] = mfma16(Kf[i][1], q1, S[i]);
        }
        float tmax = -1e30f;
        float bsv[2][4];
#pragma unroll
        for (int i = 0; i < 2; ++i)
#pragma unroll
            for (int r = 0; r < 4; ++r) bsv[i][r] = biasL[nt * 32 + ((bk[i] >> (8 * r)) & 0xffu)];
        asm volatile("" : "+v"(bsv[0][0]), "+v"(bsv[0][1]), "+v"(bsv[0][2]), "+v"(bsv[0][3]), "+v"(bsv[1][0]), "+v"(bsv[1][1]), "+v"(bsv[1][2]), "+v"(bsv[1][3]));
#pragma unroll
        for (int i = 0; i < 2; ++i)
#pragma unroll
            for (int r = 0; r < 4; ++r) {
                const bool ok = (vmask >> (4 * i + r)) & 1u;
                const float sv = S[i][r] * 0.125f + bsv[i][r];
                S[i][r] = ok ? sv : -1e30f; tmax = fmaxf(tmax, S[i][r]);
            }
        if (PASS != 1) {
            tmax = rows_max(tmax);
            const float mnew = fmaxf(m[nt], tmax), alpha = __expf(m[nt] - mnew);
            float psum = 0.f;
#pragma unroll
            for (int i = 0; i < 2; ++i)
#pragma unroll
                for (int r = 0; r < 4; ++r) {
                    const bool ok = (vmask >> (4 * i + r)) & 1u;
                    const float pv = ok ? __expf(S[i][r] - mnew) : 0.f;
                    S[i][r] = pv; psum += pv;
                }
            psum = rows_sum(psum);
            l[nt] = l[nt] * alpha + psum; m[nt] = mnew;
            if (PASS == 2) {
#pragma unroll
                for (int mt = 0; mt < 4; ++mt) O[mt][nt] = O[mt][nt] * alpha;
            }
        } else {
#pragma unroll
            for (int i = 0; i < 2; ++i) {
#pragma unroll
                for (int r = 0; r < 4; ++r) {
                    const bool ok = (vmask >> (4 * i + r)) & 1u;
                    S[i][r] = ok ? __expf(S[i][r] - m[nt]) * l[nt] : 0.f;
                }
                ia[i] += S[i][0] + S[i][1] + S[i][2] + 0.5f * S[i][3];
                ic[i] += 0.5f * S[i][3];
            }
        }
        if (PASS != 0) {
            const bf16x8 Pb = pack8(S[0], S[1]);
#pragma unroll
            for (int mt = 0; mt < 4; ++mt) O[mt][nt] = mfma16(lds_vfrag128(vL, 16 * mt + fr, 32 * hf, fq), Pb, O[mt][nt]);
        }
    }
    if (PASS == 1) {
        float* imp = (float*)(lds + NSA_IMP) + qrow * 129;
        asm volatile("" ::: "memory"); __builtin_amdgcn_wave_barrier();
#pragma unroll
        for (int i = 0; i < 2; ++i) { const int j = 16 * tile + 8 * hf + 4 * i + fq; imp[j] += ia[i]; }
        asm volatile("s_waitcnt lgkmcnt(0)" ::: "memory"); __builtin_amdgcn_wave_barrier();
#pragma unroll
        for (int i = 0; i < 2; ++i) { const int j = 16 * tile + 8 * hf + 4 * i + fq + 1; if (j < 128) imp[j] += ic[i]; }
        asm volatile("s_waitcnt lgkmcnt(0)" ::: "memory"); __builtin_amdgcn_wave_barrier();
    }
}
template <int BR, int PASS>
__device__ __forceinline__ void nsa_tile(const unsigned char* kL, const unsigned char* vL, const unsigned char* lds, const bf16_t* qptr,
                                         f32x4 (&O)[4][4], float (&m)[4], float (&l)[4], int tile, bool selbit, const NsaLane& L, int qrow) {
#pragma unroll 1
    for (int hf = 0; hf < 2; ++hf) nsa_half<BR, PASS>(kL, vL, lds, qptr, O, m, l, tile, hf, selbit, L, qrow);
}

__device__ __forceinline__ void cmp_item(const Params& p, int item, unsigned char* lds, int half) {
    unsigned char* ws = launder(p.ws);
    const int tid = (ltid() & 255), lane = tid & 63, wid = tid >> 6, fr = lane & 15, fq = lane >> 4;
    const int combo = item & 3, qt = 127 - (item >> 2), b = combo >> 1, g = combo & 1;
    const int q0 = qt * 64, qrow = 16 * wid + fr;
    NsaLane L; L.t = q0 + qrow; L.fr = fr; L.fq = fq; L.wid = wid; L.lane = lane;
    const size_t tok = (size_t)b * S_ + L.t;
    const bf16_t* P = (const bf16_t*)(ws + WS_P);
    __syncthreads();
    if (tid < 128) ((float*)(lds + NSA_BIAS))[tid] = p.rel_bias[(tid & 31) * 8 + 4 * g + (tid >> 5)];
    for (int i = tid; i < 64 * 129; i += HT) ((float*)(lds + NSA_IMP))[i] = 0.f;
    const bf16_t* Qf = P + tok * LD + C_QA + (4 * g) * 64 + 8 * fq;
    __syncthreads();
    f32x4 O[4][4]; float m[4], l[4];
    const bf16_t* gates = P + tok * LD + C_GA + (4 * g) * 3;
    const bf16_t* kc = (const bf16_t*)(ws + WS_KCC) + (size_t)(b * 2 + g) * 512 * 64;
    const bf16_t* vc = (const bf16_t*)(ws + WS_VCCT) + (size_t)(b * 2 + g) * 64 * 512;
    const int ntc = ((q0 + 32) >> 4) / 64 + 1;
#pragma unroll
    for (int nt = 0; nt < 4; ++nt) { m[nt] = -1e30f; l[nt] = 0.f; }
    load_tile64(kc, 64, lds, wid, lane);
    wait_vm0(); __syncthreads();
    for (int it = 0; it < ntc; ++it) {
        unsigned char* cur = lds + (it & 1) * 16384;
        if (it + 1 < ntc) load_tile64(kc + (size_t)(it + 1) * 64 * 64, 64, lds + ((it + 1) & 1) * 16384, wid, lane);
        nsa_tile<0, 0>(cur, cur + 8192, lds, Qf, O, m, l, it, true, L, qrow);
        wait_vm0(); __syncthreads();
    }
#pragma unroll
    for (int nt = 0; nt < 4; ++nt) l[nt] = l[nt] > 0.f ? 1.f / l[nt] : 0.f;
#pragma unroll
    for (int mt = 0; mt < 4; ++mt)
#pragma unroll
        for (int nt = 0; nt < 4; ++nt) O[mt][nt] = (f32x4){0.f, 0.f, 0.f, 0.f};
    load_tile64(kc, 64, lds, wid, lane); load_tile64(vc, 512, lds + 8192, wid, lane);
    wait_vm0(); __syncthreads();
    for (int it = 0; it < ntc; ++it) {
        unsigned char* cur = lds + (it & 1) * 16384;
        if (it + 1 < ntc) { unsigned char* nx = lds + ((it + 1) & 1) * 16384;
            load_tile64(kc + (size_t)(it + 1) * 64 * 64, 64, nx, wid, lane); load_tile64(vc + (it + 1) * 64, 512, nx + 8192, wid, lane); }
        nsa_tile<0, 1>(cur, cur + 8192, lds, Qf, O, m, l, it, true, L, qrow);
        wait_vm0(); __syncthreads();
    }
    bf16_t* YC = (bf16_t*)(ws + WS_YC) + tok * 512 + (4 * g) * 64;
#pragma unroll
    for (int nt = 0; nt < 4; ++nt) {
        const float gt = bf2f(gates[nt * 3 + 0]);
#pragma unroll
        for (int mt = 0; mt < 4; ++mt) *(u32x2*)(YC + nt * 64 + 16 * mt + 4 * fq) = pack4(O[mt][nt] * gt);
    }
    const int cur = qt;
    {
        float* imp = (float*)(lds + NSA_IMP) + qrow * 129 + 32 * fq;
        asm volatile("s_waitcnt lgkmcnt(0)" ::: "memory"); __builtin_amdgcn_wave_barrier();
#pragma unroll
        for (int i = 0; i < 32; ++i) {
            const int j = 32 * fq + i;
            const float v = imp[i];
            imp[i] = j > cur ? -1.f : v + ((j == 0 || j == cur || j == cur - 1) ? 1.0e4f : 0.f);
        }
        unsigned word = 0;
#pragma unroll 1
        for (int round = 0; round < 16; ++round) {
            float bv = imp[0]; int bi = 0;
#pragma unroll
            for (int i = 1; i < 32; ++i) { const float v = imp[i]; if (v > bv) { bv = v; bi = i; } }
            int gi = 32 * fq + bi;
            {
                u32x2 rv = __builtin_amdgcn_permlane16_swap(__float_as_uint(bv), __float_as_uint(bv), false, false);
                u32x2 ri = __builtin_amdgcn_permlane16_swap((unsigned)gi, (unsigned)gi, false, false);
                float v0 = __uint_as_float(rv.x), v1 = __uint_as_float(rv.y); int i0 = (int)ri.x, i1 = (int)ri.y;
                if (v1 > v0 || (v1 == v0 && i1 < i0)) { v0 = v1; i0 = i1; }
                rv = __builtin_amdgcn_permlane32_swap(__float_as_uint(v0), __float_as_uint(v0), false, false);
                ri = __builtin_amdgcn_permlane32_swap((unsigned)i0, (unsigned)i0, false, false);
                v0 = __uint_as_float(rv.x); v1 = __uint_as_float(rv.y); i0 = (int)ri.x; i1 = (int)ri.y;
                if (v1 > v0 || (v1 == v0 && i1 < i0)) { v0 = v1; i0 = i1; }
                bv = v0; gi = i0;
            }
            if (bv >= 0.f && (gi >> 5) == fq) { word |= 1u << (gi & 31); imp[gi & 31] = -2.f; }
        }
        ((unsigned*)(ws + WS_SELW))[(tok * 2 + g) * 4 + fq] = word;
    }
}

__device__ __forceinline__ void win_item(const Params& p, int item, unsigned char* lds, int half) {
    unsigned char* ws = launder(p.ws);
    const int tid = (ltid() & 255), lane = tid & 63, wid = tid >> 6, fr = lane & 15, fq = lane >> 4;
    const int combo = item & 3, qt = 127 - (item >> 2), b = combo >> 1, g = combo & 1;
    const int q0 = qt * 64, qrow = 16 * wid + fr;
    NsaLane L; L.t = q0 + qrow; L.fr = fr; L.fq = fq; L.wid = wid; L.lane = lane;
    const size_t tok = (size_t)b * S_ + L.t;
    const bf16_t* P = (const bf16_t*)(ws + WS_P);
    __syncthreads();
    if (tid < 128) ((float*)(lds + NSA_BIAS))[tid] = p.rel_bias[(tid & 31) * 8 + 4 * g + (tid >> 5)];
    const bf16_t* Qf = P + tok * LD + C_QA + (4 * g) * 64 + 8 * fq;
    __syncthreads();
    f32x4 O[4][4]; float m[4], l[4];
    const bf16_t* gates = P + tok * LD + C_GA + (4 * g) * 3;
#pragma unroll
    for (int nt = 0; nt < 4; ++nt) { m[nt] = -1e30f; l[nt] = 0.f; }
#pragma unroll
    for (int mt = 0; mt < 4; ++mt)
#pragma unroll
        for (int nt = 0; nt < 4; ++nt) O[mt][nt] = (f32x4){0.f, 0.f, 0.f, 0.f};
    {
        const bf16_t* kb = P + ((size_t)b * S_) * LD + C_KW + g * 64;
        const bf16_t* vb = (const bf16_t*)(ws + WS_VWT) + (size_t)(b * 2 + g) * 64 * S_;
        const int k_lo = qt - 8 > 0 ? qt - 8 : 0, ntw = qt - k_lo + 1;
        load_tile64(kb + (size_t)k_lo * 64 * LD, LD, lds, wid, lane); load_tile64(vb + k_lo * 64, S_, lds + 8192, wid, lane);
        wait_vm0(); __syncthreads();
        for (int it = 0; it < ntw; ++it) {
            unsigned char* cu = lds + (it & 1) * 16384;
            if (it + 1 < ntw) { unsigned char* nx = lds + ((it + 1) & 1) * 16384;
                load_tile64(kb + (size_t)(k_lo + it + 1) * 64 * LD, LD, nx, wid, lane); load_tile64(vb + (k_lo + it + 1) * 64, S_, nx + 8192, wid, lane); }
            nsa_tile<2, 2>(cu, cu + 8192, lds, Qf, O, m, l, k_lo + it, true, L, qrow);
            wait_vm0(); __syncthreads();
        }
    }
    bf16_t* YW = (bf16_t*)(ws + WS_YW) + tok * 512 + (4 * g) * 64;
#pragma unroll
    for (int nt = 0; nt < 4; ++nt) {
        const float gt = bf2f(gates[nt * 3 + 2]) * (l[nt] > 0.f ? 1.f / l[nt] : 0.f);
#pragma unroll
        for (int mt = 0; mt < 4; ++mt) *(u32x2*)(YW + nt * 64 + 16 * mt + 4 * fq) = pack4(O[mt][nt] * gt);
    }
}

constexpr int SEL_BIAS2 = NSA_BIAS;
constexpr float LOG2E = 1.4426950408889634f;
__device__ __forceinline__ int t5_first(int bk) {
    const int th[16] = {16, 22, 30, 40, 54, 73, 99, 134, 182, 246, 332, 450, 609, 825, 1117, 1513};
    int r = 16;
#pragma unroll
    for (int k = 0; k < 16; ++k) r = (bk == 16 + k) ? th[k] : r;
    return r;
}
template <bool FAST>
__device__ __forceinline__ void sel_ntile(const bf16x8 (&Kf)[4][2], const bf16x8 (&Vf)[4][2], const bf16x8& q0, const bf16x8& q1, f32x4 (&O)[4], float& m, float& l,
                                          bool sb, int relb, int th, float blo, float bhi, const unsigned char* lds, int hl) {
    f32x4 S[4];
#pragma unroll
    for (int i = 0; i < 4; ++i) { S[i] = (f32x4){0.f, 0.f, 0.f, 0.f}; S[i] = mfma16(Kf[i][0], q0, S[i]); S[i] = mfma16(Kf[i][1], q1, S[i]); }
    float tmax = -1e30f;
    const float scl = (!FAST || sb) ? 0.125f * LOG2E : 0.f;
    if (FAST) { blo = (sb ? blo : -1e30f) - m; bhi = (sb ? bhi : -1e30f) - m; }
    if (FAST) {
#pragma unroll
        for (int i = 0; i < 4; ++i)
#pragma unroll
            for (int r = 0; r < 4; ++r) { const int rel = relb - (16 * i + r); S[i][r] = S[i][r] * scl + (rel >= th ? bhi : blo); tmax = fmaxf(tmax, S[i][r]); }
    } else {
        unsigned bkt[4][4]; float bs[4][4];
#pragma unroll
        for (int i = 0; i < 4; ++i)
#pragma unroll
            for (int r = 0; r < 4; ++r) { const int rel = relb - (16 * i + r); int rc = rel < 0 ? 0 : rel; rc = rc > 8191 ? 8191 : rc; bkt[i][r] = (lds + NSA_BUCKET)[rc]; }
#pragma unroll
        for (int i = 0; i < 4; ++i)
#pragma unroll
            for (int r = 0; r < 4; ++r) bs[i][r] = ((const float*)(lds + SEL_BIAS2))[hl * 32 + bkt[i][r]];
        asm volatile("" : "+v"(bs[0][0]), "+v"(bs[0][1]), "+v"(bs[0][2]), "+v"(bs[0][3]), "+v"(bs[1][0]), "+v"(bs[1][1]), "+v"(bs[1][2]), "+v"(bs[1][3]),
                          "+v"(bs[2][0]), "+v"(bs[2][1]), "+v"(bs[2][2]), "+v"(bs[2][3]), "+v"(bs[3][0]), "+v"(bs[3][1]), "+v"(bs[3][2]), "+v"(bs[3][3]));
        const float ninf = -1e30f;
#pragma unroll
        for (int i = 0; i < 4; ++i)
#pragma unroll
            for (int r = 0; r < 4; ++r) {
                const int rel = relb - (16 * i + r);
                const float sv = S[i][r] * (0.125f * LOG2E) + (bs[i][r] - m);
                S[i][r] = (sb && rel >= 0) ? sv : ninf; tmax = fmaxf(tmax, S[i][r]);
            }
    }
    tmax = rows_max(tmax);
    if (__ballot(tmax > 8.f) != 0ull) {
        const float d = fmaxf(tmax, 0.f), alpha = __builtin_amdgcn_exp2f(-d);
        m += d; l *= alpha;
#pragma unroll
        for (int mt = 0; mt < 4; ++mt) O[mt] = O[mt] * alpha;
#pragma unroll
        for (int i = 0; i < 4; ++i)
#pragma unroll
            for (int r = 0; r < 4; ++r) S[i][r] -= d;
    }
    float psum = 0.f;
#pragma unroll
    for (int i = 0; i < 4; ++i)
#pragma unroll
        for (int r = 0; r < 4; ++r) { const float pv = __builtin_amdgcn_exp2f(S[i][r]); S[i][r] = pv; psum += pv; }
    l += rows_sum(psum);
    const bf16x8 Pb0 = pack8(S[0], S[1]), Pb1 = pack8(S[2], S[3]);
#pragma unroll
    for (int mt = 0; mt < 4; ++mt) { O[mt] = mfma16(Vf[mt][0], Pb0, O[mt]); O[mt] = mfma16(Vf[mt][1], Pb1, O[mt]); }
}
template <bool FAST>
__device__ __forceinline__ void sel_tile(const unsigned char* kL, const unsigned char* vL, const unsigned char* lds, const bf16x8 (&Qf)[2][2], f32x4 (&O)[2][4], float (&m)[2], float (&l)[2],
                                         const bool (&sb)[2], const bool (&need)[2], const int (&relb)[2], int th, float blo, float bhi, int hl, int fr, int fq) {
    bf16x8 Kf[4][2], Vf[4][2];
#pragma unroll
    for (int i = 0; i < 4; ++i)
#pragma unroll
        for (int ks = 0; ks < 2; ++ks) Kf[i][ks] = lds_frag128(kL, 16 * i + fr, 4 * ks + fq);
#pragma unroll
    for (int mt = 0; mt < 4; ++mt)
#pragma unroll
        for (int hf = 0; hf < 2; ++hf) Vf[mt][hf] = lds_vfrag128(vL, 16 * mt + fr, 32 * hf, fq);
    if (need[0]) sel_ntile<FAST>(Kf, Vf, Qf[0][0], Qf[0][1], O[0], m[0], l[0], sb[0], relb[0], th, blo, bhi, lds, hl);
    if (need[1]) sel_ntile<FAST>(Kf, Vf, Qf[1][0], Qf[1][1], O[1], m[1], l[1], sb[1], relb[1], th, blo, bhi, lds, hl);
}
template <int VAR>
__device__ __forceinline__ void sel_item(const Params& p, int v, unsigned char* lds, int half) {
    unsigned char* ws = launder(p.ws);
    const int tid = (ltid() & 255), lane = tid & 63, wid = tid >> 6, fr = lane & 15, fq = lane >> 4;
    const int qt = 127 - (v >> 3), sub = v & 7, b = sub >> 2, g = (sub >> 1) & 1, qh = sub & 1;
    const int q0 = qt * 64 + 32 * qh, cur = qt, hl = fr & 3;
    const bf16_t* P = (const bf16_t*)(ws + WS_P);
    __syncthreads();
    if (tid < 128) ((float*)(lds + SEL_BIAS2))[tid] = p.rel_bias[(tid & 31) * 8 + 4 * g + (tid >> 5)] * LOG2E;
    int t[2]; size_t tok[2]; bf16x8 Qf[2][2]; unsigned selw[2][4];
#pragma unroll
    for (int nt = 0; nt < 2; ++nt) {
        t[nt] = q0 + 8 * wid + 4 * nt + (fr >> 2); tok[nt] = (size_t)b * S_ + t[nt];
#pragma unroll
        for (int ks = 0; ks < 2; ++ks) Qf[nt][ks] = *(const bf16x8*)(P + tok[nt] * LD + C_QA + (4 * g + hl) * 64 + 32 * ks + 8 * fq);
        const u32x4 w = *(const u32x4*)((const unsigned*)(ws + WS_SELW) + (tok[nt] * 2 + g) * 4);
        selw[nt][0] = w.x; selw[nt][1] = w.y; selw[nt][2] = w.z; selw[nt][3] = w.w;
    }
    f32x4 O[2][4]; float m[2], l[2];
#pragma unroll
    for (int nt = 0; nt < 2; ++nt) { m[nt] = -1000.f; l[nt] = 0.f;
#pragma unroll
        for (int mt = 0; mt < 4; ++mt) O[nt][mt] = (f32x4){0.f, 0.f, 0.f, 0.f}; }
    const bf16_t* kb = P + ((size_t)b * S_) * LD + C_KS + g * 64;
    const bf16_t* vb = (const bf16_t*)(ws + WS_VST) + (size_t)(b * 2 + g) * 64 * S_;
    const int nts = cur + 1;
#define SEL_ISSUE(jj) do { unsigned char* st_ = lds + ((jj) & 3) * 16384; load_tile64(kb + (size_t)(jj) * 64 * LD, LD, st_, wid, lane); load_tile64(vb + (jj) * 64, S_, st_ + 8192, wid, lane); } while (0)
    asm volatile("s_waitcnt vmcnt(0)" ::: "memory");
    SEL_ISSUE(0); if (nts > 1) SEL_ISSUE(1); if (nts > 2) SEL_ISSUE(2);
    const unsigned char* bucketL = lds + NSA_BUCKET;
    for (int j = 0; j < nts; ++j) {
        const unsigned char* cu = lds + (j & 3) * 16384;
        if (j + 2 < nts) WAIT_V(8); else if (j + 1 < nts) WAIT_V(4); else WAIT_V(0);
        RAW_BARRIER();
        if (j + 3 < nts) SEL_ISSUE(j + 3);
        bool sb[2], need[2]; int relb[2];
#pragma unroll
        for (int nt = 0; nt < 2; ++nt) {
            const unsigned w = j < 32 ? selw[nt][0] : j < 64 ? selw[nt][1] : j < 96 ? selw[nt][2] : selw[nt][3];
            sb[nt] = (w >> (j & 31)) & 1u; need[nt] = __ballot(sb[nt]) != 0ull; relb[nt] = t[nt] - 64 * j - 4 * fq;
        }
        if (VAR == 1) { need[0] = false; need[1] = false; }
        if (VAR == 2) { if (!(need[0] || need[1])) { need[0] = false; } else { need[0] = true; need[1] = true; } }
        if (need[0] || need[1]) {
            const int rmin = q0 - 64 * j - 63, rmax = q0 + 31 - 64 * j;
            bool fast = false; int th = 0; float blo = 0.f, bhi = 0.f;
            if (rmin >= 16) {
                const int b0 = bucketL[rmin], b1 = bucketL[rmax > 8191 ? 8191 : rmax];
                if (b1 - b0 <= 1) { fast = true; th = t5_first(b1); if (b1 == b0) th = 0;
                    blo = ((const float*)(lds + SEL_BIAS2))[hl * 32 + b0]; bhi = ((const float*)(lds + SEL_BIAS2))[hl * 32 + b1]; }
            }
            if (fast) sel_tile<true>(cu, cu + 8192, lds, Qf, O, m, l, sb, need, relb, th, blo, bhi, hl, fr, fq);
            else sel_tile<false>(cu, cu + 8192, lds, Qf, O, m, l, sb, need, relb, th, blo, bhi, hl, fr, fq);
        }
    }
#undef SEL_ISSUE
    __syncthreads();
#pragma unroll
    for (int nt = 0; nt < 2; ++nt) {
        const float gt = bf2f(P[tok[nt] * LD + C_GA + (4 * g + hl) * 3 + 1]) * (l[nt] > 0.f ? 1.f / l[nt] : 0.f);
        const size_t o = tok[nt] * 512 + (4 * g + hl) * 64;
#pragma unroll
        for (int mt = 0; mt < 4; ++mt) {
            const f32x4 yc = unpack4(*(const u32x2*)((const bf16_t*)(ws + WS_YC) + o + 16 * mt + 4 * fq));
            const f32x4 yw = unpack4(*(const u32x2*)((const bf16_t*)(ws + WS_YW) + o + 16 * mt + 4 * fq));
            if (VAR == 0 || VAR == 3) *(u32x2*)((bf16_t*)(ws + WS_YA) + o + 16 * mt + 4 * fq) = pack4(yc + yw + O[nt][mt] * gt);
            else asm volatile("" :: "v"(O[nt][mt]));
        }
    }
}

__device__ __forceinline__ void scan_item(const Params& p, int item, int half) {
    unsigned char* ws = launder(p.ws);
    const int idx = item * HT + (ltid() & 255);
    const int bh = idx >> 13, ed = idx & 8191, h = bh & 7;
    const float dec = exp2f(128.f * ret_lg2(h));
    const float* KVT = (const float*)(ws + WS_KVT) + (size_t)bh * 64 * 8192 + ed;
    bf16_t* SPT = (bf16_t*)(ws + WS_SPT) + (size_t)bh * 64 * 8192 + ed;
    float s = 0.f;
    for (int n = 0; n < 64; ++n) { SPT[(size_t)n * 8192] = f2bf(s); s = s * dec + KVT[(size_t)n * 8192]; }
}

__device__ __forceinline__ void phase_p3(const Params& p, unsigned char* lds, int half) {
    for (int i = (ltid() & 255); i < 8192 / 16; i += HT) ((u32x4*)(lds + NSA_BUCKET))[i] = ((const u32x4*)(launder(p.ws) + WS_BUCKET))[i];
    __syncthreads();
    for (int it = (blockIdx.x * 2 + half); it < 1536; it += (gridDim.x * 2)) {
        if (it < 512) cmp_item(p, it, lds, half); else if (it < 1024) win_item(p, it - 512, lds, half); else scan_item(p, it - 1024, half);
    }
}

__device__ __forceinline__ void retout_item(const Params& p, int item, unsigned char* lds, int half) {
    unsigned char* ws = launder(p.ws);
    const int tid = (ltid() & 255), lane = tid & 63, wid = tid >> 6, fr = lane & 15, fq = lane >> 4;
    const int n = item & 63, h = (item >> 6) & 7, b = item >> 9;
    const size_t tok0 = (size_t)b * S_ + 128 * n;
    const bf16_t* P = (const bf16_t*)(ws + WS_P);
    unsigned char* vL = lds; unsigned char* kL = lds + 32768; unsigned char* sL = lds + 49152;
    __syncthreads();
    load_tile128w((const bf16_t*)(ws + WS_VRT) + ((size_t)(b * 8 + h) * 128) * S_ + 128 * n, S_, vL, wid, lane);
    load_tile128(P + tok0 * LD + C_KR + h * 64, LD, kL, wid, lane);
    load_tile128((const bf16_t*)(ws + WS_SPT) + ((size_t)(b * 8 + h) * 64 + n) * 8192, 64, sL, wid, lane);
    bf16x8 Qf[2][2];
#pragma unroll
    for (int nt = 0; nt < 2; ++nt)
#pragma unroll
        for (int ks = 0; ks < 2; ++ks) Qf[nt][ks] = *(const bf16x8*)(P + (tok0 + 32 * wid + 16 * nt + fr) * LD + C_QR + h * 64 + 32 * ks + 8 * fq);
    wait_vm0(); __syncthreads();
    const float lg2 = ret_lg2(h);
    f32x4 Y[8][2];
#pragma unroll
    for (int m = 0; m < 8; ++m)
#pragma unroll
        for (int nt = 0; nt < 2; ++nt) Y[m][nt] = (f32x4){0.f, 0.f, 0.f, 0.f};
#pragma unroll
    for (int m = 0; m < 8; ++m)
#pragma unroll
        for (int ks = 0; ks < 2; ++ks) {
            const bf16x8 a = lds_frag128(sL, 16 * m + fr, 4 * ks + fq);
#pragma unroll
            for (int nt = 0; nt < 2; ++nt) Y[m][nt] = mfma16(a, Qf[nt][ks], Y[m][nt]);
        }
#pragma unroll
    for (int nt = 0; nt < 2; ++nt) {
        const float sc = exp2f((float)(32 * wid + 16 * nt + fr + 1) * lg2);
#pragma unroll
        for (int m = 0; m < 8; ++m) Y[m][nt] = Y[m][nt] * sc;
    }
#pragma unroll 1
    for (int s = 0; s < 4; ++s) {
        f32x4 St[2][2];
#pragma unroll
        for (int hh = 0; hh < 2; ++hh) {
            const int mt = 2 * s + hh;
#pragma unroll
            for (int nt = 0; nt < 2; ++nt) St[hh][nt] = (f32x4){0.f, 0.f, 0.f, 0.f};
#pragma unroll
            for (int ks = 0; ks < 2; ++ks) {
                const bf16x8 a = lds_frag128(kL, 16 * mt + fr, 4 * ks + fq);
#pragma unroll
                for (int nt = 0; nt < 2; ++nt) St[hh][nt] = mfma16(a, Qf[nt][ks], St[hh][nt]);
            }
#pragma unroll
            for (int nt = 0; nt < 2; ++nt) {
                const int qi = 32 * wid + 16 * nt + fr;
#pragma unroll
                for (int r = 0; r < 4; ++r) {
                    const int kj = 16 * mt + 4 * fq + r;
                    const float dm = qi >= kj ? exp2f((float)(qi - kj) * lg2) : 0.f;
                    St[hh][nt][r] *= dm;
                }
            }
        }
        bf16x8 Pb[2];
#pragma unroll
        for (int nt = 0; nt < 2; ++nt) Pb[nt] = pack8(St[0][nt], St[1][nt]);
#pragma unroll
        for (int m = 0; m < 8; ++m) {
            const bf16x8 a = lds_vfrag256(vL, 16 * m + fr, 32 * s, fq);
#pragma unroll
            for (int nt = 0; nt < 2; ++nt) Y[m][nt] = mfma16(a, Pb[nt], Y[m][nt]);
        }
    }
    bf16_t* YB = (bf16_t*)(ws + WS_YB);
#pragma unroll
    for (int nt = 0; nt < 2; ++nt) {
        float sum = 0.f;
#pragma unroll
        for (int m = 0; m < 8; ++m) sum += Y[m][nt][0] + Y[m][nt][1] + Y[m][nt][2] + Y[m][nt][3];
        sum = rows_sum(sum);
        const float mu = sum * (1.f / 128.f);
        float vs = 0.f;
#pragma unroll
        for (int m = 0; m < 8; ++m)
#pragma unroll
            for (int r = 0; r < 4; ++r) { const float dlt = Y[m][nt][r] - mu; vs += dlt * dlt; }
        vs = rows_sum(vs);
        const float rstd = rsqrtf(vs * (1.f / 128.f) + 1e-5f);
        const size_t tk = tok0 + 32 * wid + 16 * nt + fr;
#pragma unroll
        for (int m = 0; m < 8; ++m) {
            const f32x4 gt = unpack4(*(const u32x2*)(P + tk * LD + C_GR + h * 128 + 16 * m + 4 * fq));
            f32x4 v;
#pragma unroll
            for (int r = 0; r < 4; ++r) v[r] = (Y[m][nt][r] - mu) * rstd * gt[r];
            *(u32x2*)(YB + tk * 1024 + h * 128 + 16 * m + 4 * fq) = pack4(v);
        }
    }
}
__device__ __forceinline__ void phase_p4(const Params& p, unsigned char* lds, int half, int what) {
    for (int i = (ltid() & 255); i < 8192 / 16; i += HT) ((u32x4*)(lds + NSA_BUCKET))[i] = ((const u32x4*)(launder(p.ws) + WS_BUCKET))[i];
    __syncthreads();
    for (int it = (blockIdx.x * 2 + half) + ((what & 1) ? 0 : 1024); it < ((what & 2) ? 2048 : 1024); it += (gridDim.x * 2)) {
        if (it < 1024) sel_item<0>(p, it < 512 ? it : 1535 - it, lds, half); else retout_item(p, it - 1024, lds, half);
    }
#ifdef EXTRA_SEL
    __syncthreads();
    for (int it = (blockIdx.x * 2 + half); it < 1024; it += (gridDim.x * 2)) {
        sel_item<EXTRA_SEL>(p, it < 512 ? it : 1535 - it, lds, half);
    }
#endif
}

struct RowOrder {     typedef pg8::Unit U; static constexpr bool GATHER = false;
    unsigned a, b; int K, xcd, slot, per;
    __device__ __forceinline__ bool next(int i, pg8::Unit& u) const { const int t = xcd * 32 + slot + i * per; if (t >= (xcd + 1) * 32) return false; u.pm = t >> 2; u.pn = t & 3; return true; }
    __device__ __forceinline__ void ptrs(const pg8::Unit& u, unsigned& A, unsigned& B) const { A = a + (unsigned)u.pm * 512u * (unsigned)K; B = b + (unsigned)u.pn * 512u * (unsigned)K; }
};
template <int MODE>
struct MixEpi {
    unsigned char* ws; const float* X;
    __device__ __forceinline__ void operator()(const f32x4 (&acc)[2][2][4][2], const pg8::Unit& u, int wr, int wc, int fr, int fq) const {
#pragma unroll
        for (int ai = 0; ai < 2; ++ai)
#pragma unroll
            for (int m = 0; m < 4; ++m) {
                const size_t tok = (size_t)(u.pm * 256 + 128 * ai + 64 * wr + 16 * m + fr + vzero());
#pragma unroll
                for (int bj = 0; bj < 2; ++bj) {
                    const int n = u.pn * 256 + 128 * bj + 32 * wc + 8 * fq;
                    const f32x4 v0 = acc[ai][bj][m][0], v1 = acc[ai][bj][m][1];
                    if (MODE == 2) {
                        const f32x4 x0 = *(const f32x4*)(X + tok * 1024 + n), x1 = *(const f32x4*)(X + tok * 1024 + n + 4);
                        float* H1 = (float*)(ws + WS_H1);
                        *(f32x4*)(H1 + tok * 1024 + n) = x0 * DN_ALPHA + v0; *(f32x4*)(H1 + tok * 1024 + n + 4) = x1 * DN_ALPHA + v1;
                    } else {
                        const u32x4 gw = *(const u32x4*)((const bf16_t*)(ws + WS_P) + tok * LD + (MODE == 0 ? C_MA : C_MB) + n);
                        const f32x4 g0 = unpack4((u32x2){gw.x, gw.y}), g1 = unpack4((u32x2){gw.z, gw.w});
                        f32x4 o0 = g0 * v0, o1 = g1 * v1;
                        bf16_t* MG = (bf16_t*)(ws + WS_MG) + tok * 1024 + n;
                        if (MODE == 1) { const u32x4 pw = *(const u32x4*)MG; o0 = o0 + unpack4((u32x2){pw.x, pw.y}); o1 = o1 + unpack4((u32x2){pw.z, pw.w}); }
                        u32x4 w; w.x = pack2(o0[0], o0[1]); w.y = pack2(o0[2], o0[3]); w.z = pack2(o1[0], o1[1]); w.w = pack2(o1[2], o1[3]);
                        *(u32x4*)MG = w;
                    }
                }
            }
    }
};
__device__ __forceinline__ void phase_g2(const Params& p, unsigned char* lds) {
    unsigned char* ws = launder(p.ws);
    RowOrder S; S.xcd = blockIdx.x & 7; S.slot = blockIdx.x >> 3; S.per = gridDim.x >> 3;
    { S.a = (unsigned)WS_YA; S.b = (unsigned)WS_WA; S.K = 512; MixEpi<0> E; E.ws = ws; E.X = nullptr; pg8::gemm_phase<MixEpi<0>, RowOrder>(lds, 512, S, E, ltid(), ws); }
    { S.a = (unsigned)WS_YB; S.b = (unsigned)WS_WB; S.K = 1024; MixEpi<1> E; E.ws = ws; E.X = nullptr; pg8::gemm_phase<MixEpi<1>, RowOrder>(lds, 1024, S, E, ltid(), ws); }
}
__device__ __forceinline__ void phase_g3(const Params& p, int layer, unsigned char* lds) {
    unsigned char* ws = launder(p.ws);
    RowOrder S; S.xcd = blockIdx.x & 7; S.slot = blockIdx.x >> 3; S.per = gridDim.x >> 3; S.a = (unsigned)WS_MG; S.b = (unsigned)WS_WO; S.K = 1024;
    MixEpi<2> E; E.ws = ws; E.X = layer == 0 ? p.x : (const float*)(ws + WS_X);
    pg8::gemm_phase<MixEpi<2>, RowOrder>(lds, 1024, S, E, ltid(), ws);
}

__device__ __forceinline__ void phase_ln1(const Params& p, int layer, unsigned char* lds, bool dry, int half) {
    unsigned char* ws = launder(p.ws);
    const int tid = (ltid() & 255), lane = tid & 63, wid = tid >> 6;
    float* wrL = (float*)lds;
    {
        float4 wv[16];
#pragma unroll
        for (int k = 0; k < 16; ++k) wv[k] = ((const float4*)p.w_router)[tid + 256 * k];
#pragma unroll
        for (int k = 0; k < 16; ++k) { const int i4 = tid + 256 * k, d = i4 >> 2, e0 = (i4 & 3) * 4;
            wrL[(e0 + 0) * 1024 + d] = wv[k].x; wrL[(e0 + 1) * 1024 + d] = wv[k].y; wrL[(e0 + 2) * 1024 + d] = wv[k].z; wrL[(e0 + 3) * 1024 + d] = wv[k].w; }
    }
    __syncthreads();
    const float* H1 = (const float*)(ws + WS_H1);
    float* X1 = (float*)(ws + WS_X1); bf16_t* X1B = (bf16_t*)(ws + WS_X1B);
    const float* gam = p.ln1_g + layer * 1024; const float* bet = p.ln1_b + layer * 1024;
    unsigned* cnt = (unsigned*)(ws + WS_CTL) + (dry ? 0 : CW_CNT) + layer * 1024;
    int* LIST = (int*)(ws + (dry ? WS_HB : WS_LIST)); float* WTS = (float*)(ws + (dry ? WS_HB + 4194304 : WS_WTS));
    const int tstep = (gridDim.x * 2) * 4;
    float4 vn[4];
    { const int tok0 = (blockIdx.x * 2 + half) * 4 + wid;
#pragma unroll
      for (int j = 0; j < 4; ++j) vn[j] = *(const float4*)(H1 + (size_t)tok0 * 1024 + 256 * j + 4 * lane); }
    for (int tok = (blockIdx.x * 2 + half) * 4 + wid; tok < T_; tok += tstep) {
        float4 v[4];
#pragma unroll
        for (int j = 0; j < 4; ++j) v[j] = vn[j];
        { const int tn = tok + tstep < T_ ? tok + tstep : tok;
#pragma unroll
          for (int j = 0; j < 4; ++j) vn[j] = *(const float4*)(H1 + (size_t)tn * 1024 + 256 * j + 4 * lane); }
        float s = 0.f;
#pragma unroll
        for (int j = 0; j < 4; ++j) s += v[j].x + v[j].y + v[j].z + v[j].w;
        s = wave_sum(s);
        const float mu = s * (1.f / 1024.f);
        float q = 0.f;
#pragma unroll
        for (int j = 0; j < 4; ++j) { const float a = v[j].x - mu, b2 = v[j].y - mu, c = v[j].z - mu, d = v[j].w - mu; q += a * a + b2 * b2 + c * c + d * d; }
        q = wave_sum(q);
        const float rstd = rsqrtf(q * (1.f / 1024.f) + 1e-5f);
        float4 y[4];
#pragma unroll
        for (int j = 0; j < 4; ++j) {
            const int d0 = 256 * j + 4 * lane;
            const float4 gg = *(const float4*)(gam + d0), bb = *(const float4*)(bet + d0);
            y[j].x = (v[j].x - mu) * rstd * gg.x + bb.x; y[j].y = (v[j].y - mu) * rstd * gg.y + bb.y; y[j].z = (v[j].z - mu) * rstd * gg.z + bb.z; y[j].w = (v[j].w - mu) * rstd * gg.w + bb.w;
            *(float4*)(X1 + (size_t)tok * 1024 + d0) = y[j];
            u32x2 w; w.x = pack2(y[j].x, y[j].y); w.y = pack2(y[j].z, y[j].w);
            *(u32x2*)(X1B + (size_t)tok * 1024 + d0) = w;
        }
        float lg[16];
#pragma unroll
        for (int e = 0; e < 16; ++e) {
            float a = 0.f;
#pragma unroll
            for (int j = 0; j < 4; ++j) { const float4 w4 = *(const float4*)(wrL + e * 1024 + 256 * j + 4 * lane); a += y[j].x * w4.x + y[j].y * w4.y + y[j].z * w4.z + y[j].w * w4.w; }
            lg[e] = a;
        }
#pragma unroll
        for (int e = 0; e < 16; ++e) {
            lg[e] = wave_sum(lg[e]);
        }
        float mx = lg[0];
#pragma unroll
        for (int e = 1; e < 16; ++e) mx = fmaxf(mx, lg[e]);
        float pr[16], ps = 0.f;
#pragma unroll
        for (int e = 0; e < 16; ++e) { pr[e] = expf(lg[e] - mx); ps += pr[e]; }
        const float ips = 1.f / ps;
        float sel[16];
#pragma unroll
        for (int e = 0; e < 16; ++e) { pr[e] *= ips; sel[e] = pr[e] + p.router_bias[e]; }
        int best = 0; float bestv = -1e30f;
#pragma unroll
        for (int gI = 0; gI < 4; ++gI) {
            float a = -1e30f, b2 = -1e30f;
#pragma unroll
            for (int k = 0; k < 4; ++k) { const float x = sel[4 * gI + k]; if (x > a) { b2 = a; a = x; } else if (x > b2) b2 = x; }
            const float gs = a + b2;
            if (gs > bestv) { bestv = gs; best = gI; }
        }
        float s4[4], p4[4];
#pragma unroll
        for (int k = 0; k < 4; ++k) { s4[k] = 0.f; p4[k] = 0.f; }
#pragma unroll
        for (int gI = 0; gI < 4; ++gI) if (gI == best) {
#pragma unroll
            for (int k = 0; k < 4; ++k) { s4[k] = sel[4 * gI + k]; p4[k] = pr[4 * gI + k]; }
        }
        int i0 = 0; float a0 = s4[0];
#pragma unroll
        for (int k = 1; k < 4; ++k) if (s4[k] > a0) { a0 = s4[k]; i0 = k; }
        int i1 = -1; float a1 = -1e30f;
#pragma unroll
        for (int k = 0; k < 4; ++k) if (k != i0 && s4[k] > a1) { a1 = s4[k]; i1 = k; }
        float w0 = 0.f, w1 = 0.f;
#pragma unroll
        for (int k = 0; k < 4; ++k) { if (k == i0) w0 = p4[k]; if (k == i1) w1 = p4[k]; }
        const float iw = 1.f / (w0 + w1);
        if (lane == 0) {
            const int e0 = best * 4 + i0, e1 = best * 4 + i1;
            const unsigned p0 = atomicAdd(&cnt[e0 * 64], 1u), p1 = atomicAdd(&cnt[e1 * 64], 1u);
            LIST[(size_t)e0 * T_ + p0] = tok * 2; LIST[(size_t)e1 * T_ + p1] = tok * 2 + 1;
            WTS[tok * 2] = w0 * iw; WTS[tok * 2 + 1] = w1 * iw;
        }
    }
}

struct MoeUnit { int e, rt, ct, cnt, off; };
struct MoeOrderBase {
    const unsigned* cntp; int t_lo, t_hi, slot, per;
    __device__ __forceinline__ void init(const unsigned* cnt) {
        cntp = cnt; int ntile = 0;
#pragma unroll
        for (int k = 0; k < NE; ++k) ntile += ((__builtin_amdgcn_readfirstlane((int)cnt[k * 64]) + 255) >> 8) * 4;
        t_lo = (ntile * (int)(blockIdx.x & 7)) >> 3; t_hi = (ntile * (int)((blockIdx.x & 7) + 1)) >> 3; slot = blockIdx.x >> 3; per = gridDim.x >> 3;
    }
    __device__ __forceinline__ bool next(int i, MoeUnit& u) const {
        const int t = t_lo + slot + i * per; if (t >= t_hi) return false;
        int base = 0, off = 0; bool found = false;
#pragma unroll
        for (int k = 0; k < NE; ++k) {
            const int ck = __builtin_amdgcn_readfirstlane((int)cntp[k * 64]), nt = ((ck + 255) >> 8) * 4;
            if (!found && t < base + nt) { found = true; u.e = k; u.cnt = ck; u.off = off; u.rt = (t - base) >> 2; u.ct = (t - base) & 3; }
            base += nt; off += ck;
        }
        return found;
    }
};
struct M2Order : MoeOrderBase {
    typedef MoeUnit U; static constexpr bool GATHER = true;
    const int* list;
    __device__ __forceinline__ void ptrs(const MoeUnit& u, unsigned& A, unsigned& B) const { A = (unsigned)WS_X1B; B = (unsigned)WS_WG + ((unsigned)u.e * 1024u + (unsigned)u.ct * 256u) * 2048u; }
    __device__ __forceinline__ void rows(const MoeUnit& u, int tid, unsigned (&v)[2][2]) const {
#pragma unroll
        for (int i = 0; i < 2; ++i) { int R, C; pg8::stage_rc((tid + vzero()) * 16 + i * 8192, R, C);
#pragma unroll
            for (int h = 0; h < 2; ++h) { int idx = u.rt * 256 + 128 * h + R; idx = idx < u.cnt ? idx : u.cnt - 1; const int a = (list + (size_t)u.e * T_)[idx]; v[h][i] = ((unsigned)(a >> 1) << 11) + (unsigned)C * 2u; } }
    }
};
struct M3Order : MoeOrderBase {
    typedef MoeUnit U; static constexpr bool GATHER = false;
    __device__ __forceinline__ void ptrs(const MoeUnit& u, unsigned& A, unsigned& B) const { A = (unsigned)WS_HB + ((unsigned)u.off + (unsigned)u.rt * 256u) * 1024u; B = (unsigned)WS_WD + ((unsigned)u.e * 1024u + (unsigned)u.ct * 256u) * 1024u; }
};
struct M2Epi {
    unsigned char* ws;
    __device__ __forceinline__ void operator()(const f32x4 (&acc)[2][2][4][2], const MoeUnit& u, int wr, int wc, int fr, int fq) const {
        bf16_t* HB = (bf16_t*)(ws + WS_HB);
#pragma unroll
        for (int ai = 0; ai < 2; ++ai)
#pragma unroll
            for (int m = 0; m < 4; ++m) {
                const int idx = u.rt * 256 + 128 * ai + 64 * wr + 16 * m + fr + vzero();
                if (idx < u.cnt) {
#pragma unroll
                    for (int bj = 0; bj < 2; ++bj) {
                        const int hcol = 4 * (32 * u.ct + 16 * bj + 4 * wc + fq);
                        const f32x4 gv = acc[ai][bj][m][0], uv = acc[ai][bj][m][1]; f32x4 hv;
#pragma unroll
                        for (int r = 0; r < 4; ++r) hv[r] = gv[r] * fsig(gv[r]) * uv[r];
                        *(u32x2*)(HB + (size_t)(u.off + idx) * 512 + hcol) = pack4(hv);
                    }
                }
            }
    }
};
struct M3Epi {
    unsigned char* ws; const int* list;
    __device__ __forceinline__ void operator()(const f32x4 (&acc)[2][2][4][2], const MoeUnit& u, int wr, int wc, int fr, int fq) const {
        bf16_t* CT = (bf16_t*)(ws + WS_CT);
#pragma unroll
        for (int ai = 0; ai < 2; ++ai)
#pragma unroll
            for (int m = 0; m < 4; ++m) {
                const int idx = u.rt * 256 + 128 * ai + 64 * wr + 16 * m + fr + vzero();
                if (idx < u.cnt) {
                    const int a = list[(size_t)u.e * T_ + idx];
#pragma unroll
                    for (int bj = 0; bj < 2; ++bj) {
                        const int n = u.ct * 256 + 128 * bj + 32 * wc + 8 * fq;
                        const f32x4 v0 = acc[ai][bj][m][0], v1 = acc[ai][bj][m][1];
                        u32x4 w; w.x = pack2(v0[0], v0[1]); w.y = pack2(v0[2], v0[3]); w.z = pack2(v1[0], v1[1]); w.w = pack2(v1[2], v1[3]);
                        *(u32x4*)(CT + (size_t)a * 1024 + n) = w;
                    }
                }
            }
    }
};
__device__ __forceinline__ void phase_m2(const Params& p, int layer, unsigned char* lds) {
    unsigned char* ws = launder(p.ws);
    M2Order S; S.init((const unsigned*)(ws + WS_CTL) + CW_CNT + layer * 1024 + vzero());
    S.list = (const int*)(ws + WS_LIST);
    M2Epi E; E.ws = ws;
    pg8::gemm_phase<M2Epi, M2Order>(lds, 1024, S, E, ltid(), ws);
}
__device__ __forceinline__ void phase_m3(const Params& p, int layer, unsigned char* lds) {
    unsigned char* ws = launder(p.ws);
    M3Order S; S.init((const unsigned*)(ws + WS_CTL) + CW_CNT + layer * 1024 + vzero());
    M3Epi E; E.ws = ws; E.list = (const int*)(ws + WS_LIST);
    pg8::gemm_phase<M3Epi, M3Order>(lds, 512, S, E, ltid(), ws);
}

__device__ __forceinline__ void phase_ln2(const Params& p, int layer, int half) {
    unsigned char* ws = launder(p.ws);
    const int tid = (ltid() & 255), lane = tid & 63, wid = tid >> 6;
    const float* X1 = (const float*)(ws + WS_X1); const bf16_t* CT = (const bf16_t*)(ws + WS_CT); const float* WTS = (const float*)(ws + WS_WTS);
    float* XO = layer == NLAYER - 1 ? p.out : (float*)(ws + WS_X); bf16_t* XB = (bf16_t*)(ws + WS_XB);
    const float* gam = p.ln2_g + layer * 1024; const float* bet = p.ln2_b + layer * 1024;
    constexpr int U = 4;
    const int nwave = (gridDim.x * 2) * 4, wv = (blockIdx.x * 2 + half) * 4 + wid;
    for (int t0 = wv * U; t0 < T_; t0 += nwave * U) {
        float4 v[U][4]; float s[U], q[U];
#pragma unroll
        for (int u = 0; u < U; ++u) {
            const int tok = t0 + u;
            const float w0 = WTS[tok * 2 + vzero()], w1 = WTS[tok * 2 + 1 + vzero()];
            s[u] = 0.f; q[u] = 0.f;
#pragma unroll
            for (int j = 0; j < 4; ++j) {
                const int d0 = 256 * j + 4 * lane;
                const float4 xv = *(const float4*)(X1 + (size_t)tok * 1024 + d0);
                const f32x4 c0 = unpack4(*(const u32x2*)(CT + (size_t)(tok * 2) * 1024 + d0)), c1 = unpack4(*(const u32x2*)(CT + (size_t)(tok * 2 + 1) * 1024 + d0));
                v[u][j].x = xv.x * DN_ALPHA + w0 * c0[0] + w1 * c1[0]; v[u][j].y = xv.y * DN_ALPHA + w0 * c0[1] + w1 * c1[1];
                v[u][j].z = xv.z * DN_ALPHA + w0 * c0[2] + w1 * c1[2]; v[u][j].w = xv.w * DN_ALPHA + w0 * c0[3] + w1 * c1[3];
                s[u] += v[u][j].x + v[u][j].y + v[u][j].z + v[u][j].w;
                q[u] += v[u][j].x * v[u][j].x + v[u][j].y * v[u][j].y + v[u][j].z * v[u][j].z + v[u][j].w * v[u][j].w;
            }
        }
#pragma unroll
        for (int u = 0; u < U; ++u) { s[u] = wave_sum(s[u]); q[u] = wave_sum(q[u]); }
#pragma unroll
        for (int j = 0; j < 4; ++j) {
            const int d0 = 256 * j + 4 * lane;
            const float4 gg = *(const float4*)(gam + d0), bb = *(const float4*)(bet + d0);
#pragma unroll
            for (int u = 0; u < U; ++u) {
                const int tok = t0 + u;
                const float mu = s[u] * (1.f / 1024.f), var = fmaxf(q[u] * (1.f / 1024.f) - mu * mu, 0.f), rstd = rsqrtf(var + 1e-5f);
                float4 y; y.x = (v[u][j].x - mu) * rstd * gg.x + bb.x; y.y = (v[u][j].y - mu) * rstd * gg.y + bb.y; y.z = (v[u][j].z - mu) * rstd * gg.z + bb.z; y.w = (v[u][j].w - mu) * rstd * gg.w + bb.w;
                *(float4*)(XO + (size_t)tok * 1024 + d0) = y;
                u32x2 w; w.x = pack2(y.x, y.y); w.y = pack2(y.z, y.w);
                *(u32x2*)(XB + (size_t)tok * 1024 + d0) = w;
            }
        }
    }
}

#define XB_TMO      128
#define XB_XCNT(j)  (256  + 64 * (j))
#define XB_XSUB(j)  (1280 + 64 * (j))
#define XB_XGEN(j)  (2304 + 64 * (j))
#define XB_TOP      3328
#define XB_TOPGEN   3392
#define XCD_BAR_WORDS 3456
#define XB_SPIN_CAP (1u << 22)
#define LAS __attribute__((address_space(3)))
__device__ __forceinline__ unsigned xb_ld(unsigned* p)              { return __hip_atomic_load(p, __ATOMIC_RELAXED, __HIP_MEMORY_SCOPE_AGENT); }
__device__ __forceinline__ unsigned xb_add(unsigned* p, unsigned v) { return __hip_atomic_fetch_add(p, v, __ATOMIC_RELAXED, __HIP_MEMORY_SCOPE_AGENT); }
__device__ __forceinline__ unsigned xb_xcc_id() { return (unsigned)__builtin_amdgcn_s_getreg((3 << 11) | 20) & 0xFu; }
#define XB_SPIN(cond, bar) do { unsigned _sp = 0; while (cond) { __builtin_amdgcn_s_sleep(1); \
    if ((++_sp & 255u) == 0u) { if (xb_ld(&(bar)[XB_TMO])) break; if (_sp > XB_SPIN_CAP) { atomicAdd(&(bar)[XB_TMO], 1u); break; } } } } while (0)
struct XcdBarrier { unsigned* bar; unsigned x; volatile LAS unsigned* st; };
__device__ __forceinline__ XcdBarrier xcd_barrier_post(unsigned* bar, volatile LAS unsigned* st) {
    XcdBarrier b; b.bar = bar; b.x = xb_xcc_id(); b.st = st;
    if (threadIdx.x == 0) (void)xb_add(&bar[XB_XCNT(b.x)], 1u);
    return b;
}
__device__ __forceinline__ void xcd_barrier_complete(unsigned* bar, unsigned x, unsigned& nloc, unsigned& nx) {
    const unsigned G = gridDim.x * gridDim.y * gridDim.z;
    unsigned sum, cnt, mine, sp = 0u;
    for (;;) {
        sum = 0u; cnt = 0u; mine = 0u;
#pragma unroll
        for (unsigned j = 0; j < 16; ++j) { const unsigned c = xb_ld(&bar[XB_XCNT(j)]); sum += c; cnt += (c > 0u) ? 1u : 0u; mine = (j == x) ? c : mine; }
        if (sum == G) break;
        __builtin_amdgcn_s_sleep(1);
        if ((++sp & 255u) == 0u) { if (xb_ld(&bar[XB_TMO])) break; if (sp > XB_SPIN_CAP) { atomicAdd(&bar[XB_TMO], 1u); break; } }
    }
    nloc = mine > 0u ? mine : 1u; nx = cnt > 0u ? cnt : 1u;
}
__device__ __forceinline__ void xcd_barrier(const XcdBarrier& b) {
    asm volatile("s_waitcnt vmcnt(0)" ::: "memory");
    __syncthreads();
    if (threadIdx.x == 0) {
        unsigned* bar = b.bar;
        __builtin_amdgcn_s_waitcnt(0);
        unsigned nloc = b.st[0], nx = b.st[1];
        if (nloc == 0u) { xcd_barrier_complete(bar, b.x, nloc, nx); b.st[0] = nloc; b.st[1] = nx; }
        const unsigned old = xb_add(&bar[XB_XSUB(b.x)], 1u);
        const unsigned gen = old / nloc;
        if (old + 1u == (gen + 1u) * nloc) {
            __builtin_amdgcn_fence(__ATOMIC_RELEASE, "agent");
            asm volatile("s_waitcnt vmcnt(0)" ::: "memory");
            const unsigned og = xb_add(&bar[XB_TOP], 1u);
            const unsigned tg = og / nx;
            if (og + 1u == (tg + 1u) * nx) xb_add(&bar[XB_TOPGEN], 1u);
            else XB_SPIN(xb_ld(&bar[XB_TOPGEN]) == tg, bar);
            __builtin_amdgcn_fence(__ATOMIC_ACQUIRE, "agent");
            xb_add(&bar[XB_XGEN(b.x)], 1u);
            asm volatile("s_waitcnt vmcnt(0)" ::: "memory");
        } else {
            XB_SPIN(xb_ld(&bar[XB_XGEN(b.x)]) == gen, bar);
            __builtin_amdgcn_fence(__ATOMIC_ACQUIRE, "agent");
            asm volatile("s_waitcnt vmcnt(0)" ::: "memory");
        }
    }
    __syncthreads();
}

constexpr int PH_PER_LAYER = 11, N_PHASES = PH_PER_LAYER * NLAYER;
__global__ void __launch_bounds__(NTHREADS, 2) mega(Params p) {
    extern __shared__ __attribute__((aligned(16))) unsigned char lds[];
#if SINGLE_LAUNCH
    volatile LAS unsigned* xbw = (volatile LAS unsigned*)(lds + LDS_BYTES - 16);
    if (threadIdx.x < 4) xbw[threadIdx.x] = 0u;
    __syncthreads();
    XcdBarrier xbar = xcd_barrier_post((unsigned*)(p.ws + WS_CTL) + CW_BAR, xbw);
#endif
    const int half = __builtin_amdgcn_readfirstlane((int)(threadIdx.x >> 8));
    unsigned char* ldsh = lds + half * HALF_LDS;
    bool second = false;
    for (int ph = p.ph_lo; ph < p.ph_hi; ++ph) {
        const int layer = ph / PH_PER_LAYER, k = ph % PH_PER_LAYER;
        if (k == 0 && layer > 0) continue;
#ifdef ONLY_PHASE
        if (k != ONLY_PHASE) continue;
#endif
        switch (k) {
            case 0: phase_pw(p, layer, ldsh, 15, half); break;
            case 1: phase_g1(p, layer, lds); break;
            case 2: phase_p2(p, layer, ldsh, half); break;
            case 3: phase_p3(p, ldsh, half); if (layer + 1 < NLAYER) { __syncthreads(); phase_pw(p, layer + 1, ldsh, 1, half); } break;
            case 4: { const int sub = second ? ((p.rep_mask >> 12) & 7) : 7;
                    if ((sub & 4) && layer > 0 && half == 0) { phase_pw(p, layer, ldsh, 4, half); __syncthreads(); }
                    if (sub & 3) phase_p4(p, ldsh, half, sub & 3);
                    if ((sub & 4) && layer > 0 && half == 1) { __syncthreads(); phase_pw(p, layer, ldsh, 4, half); } } break;
            case 5: phase_g2(p, lds); break;
            case 6: phase_g3(p, layer, lds); break;
            case 7: phase_ln1(p, layer, ldsh, ((p.rep_mask >> 7) & 1) && !second, half); if (!second && layer + 1 < NLAYER) { __syncthreads(); phase_pw(p, layer + 1, ldsh, 2, half); } break;
            case 8: phase_m2(p, layer, lds); break;
            case 9: phase_m3(p, layer, lds); break;
            case 10: phase_ln2(p, layer, half); break;
        }

        if (ph + 1 < p.ph_hi) { if (ph == p.ph_lo && !second) cg::this_grid().sync(); else xcd_barrier(xbar); }
        if (((p.rep_mask >> k) & 1) && !second) { second = true; --ph; } else second = false;
    }
}

extern "C" void kernel_launch(void* const* d_in, const int* in_sizes, int n_in, void* d_out, int out_size, void* d_ws, size_t ws_size, hipStream_t stream) {
    static int grid = 0;
    if (grid == 0) {
        if (n_in != 18 || ws_size < WS_END) { fprintf(stderr, "kernel_launch: unexpected n_in %d or ws_size %zu < %zu\n", n_in, ws_size, (size_t)WS_END); grid = -1; return; }
        int dev = 0, cus = 0, per_cu = 0;
        hipGetDevice(&dev); hipDeviceGetAttribute(&cus, hipDeviceAttributeMultiprocessorCount, dev);
        hipFuncSetAttribute((const void*)mega, hipFuncAttributeMaxDynamicSharedMemorySize, LDS_BYTES);
        hipOccupancyMaxActiveBlocksPerMultiprocessor(&per_cu, (const void*)mega, NTHREADS, LDS_BYTES);
        if (per_cu < 1) per_cu = 1;
        if (per_cu > 1) per_cu = 1;
        grid = cus * per_cu;
        (void)hipGetLastError();
    }
    if (grid < 0) return;
    Params p{};
    p.x = (const float*)d_in[0]; p.w_in = (const float*)d_in[1]; p.cmp_pos = (const float*)d_in[2]; p.cmp_w1 = (const float*)d_in[3]; p.cmp_w2 = (const float*)d_in[4];
    p.w_br_a = (const float*)d_in[5]; p.w_br_b = (const float*)d_in[6]; p.w_o = (const float*)d_in[7]; p.ln1_g = (const float*)d_in[8]; p.ln1_b = (const float*)d_in[9];
    p.w_router = (const float*)d_in[10]; p.router_bias = (const float*)d_in[11]; p.w_gate = (const float*)d_in[12]; p.w_up = (const float*)d_in[13]; p.w_down = (const float*)d_in[14];
    p.ln2_g = (const float*)d_in[15]; p.ln2_b = (const float*)d_in[16]; p.rel_bias = (const float*)d_in[17];
    p.out = (float*)d_out; p.ws = (unsigned char*)d_ws; p.rep_mask = REPEAT_MASK;
#if SINGLE_LAUNCH
    hipMemsetAsync((unsigned char*)d_ws + WS_CTL + (size_t)CW_BAR * 4, 0, XCD_BAR_WORDS * 4, stream);
    p.ph_lo = 0; p.ph_hi = N_PHASES;
    void* args[] = {&p};
    hipError_t e = hipLaunchCooperativeKernel((const void*)mega, dim3(grid), dim3(NTHREADS), args, LDS_BYTES, stream);
    if (e != hipSuccess) fprintf(stderr, "cooperative launch failed: %s (grid %d)\n", hipGetErrorString(e), grid);
#else
    for (int ph = 0; ph < N_PHASES; ++ph) {
        p.ph_lo = ph; p.ph_hi = ph + 1;
        hipLaunchKernelGGL(mega, dim3(grid), dim3(NTHREADS), LDS_BYTES, stream, p);
    }
#endif
}
```

```cpp
#include <hip/hip_runtime.h>
#include <hip/hip_cooperative_groups.h>
#include <cstdio>
#include <cstdint>
namespace cg = cooperative_groups;

#ifndef REPEAT_MASK
#define REPEAT_MASK 0
#endif
#ifndef SINGLE_LAUNCH
#define SINGLE_LAUNCH 1
#endif

typedef unsigned short bf16_t;
typedef short bf16x8 __attribute__((ext_vector_type(8)));
typedef float f32x4 __attribute__((ext_vector_type(4)));
typedef unsigned u32x2 __attribute__((ext_vector_type(2)));
typedef unsigned u32x4 __attribute__((ext_vector_type(4)));

constexpr int B_ = 2, S_ = 8192, D_ = 1024, T_ = B_ * S_, NLAYER = 4;
constexpr int DIN = 6424;
constexpr int LD = 5376;
constexpr int NW = 6656;
constexpr int C_QA = 0, C_KC = 512, C_VC = 640, C_KS = 768, C_KW = 896, C_QR = 1024, C_KR = 1536, C_GR = 2048, C_MA = 3072, C_MB = 4096, C_GA = 5120,
              C_VS = 5376, C_VW = 5504, C_VR = 5632;
constexpr float DN_ALPHA = 1.681792830507429f;
constexpr int NE = 16;

constexpr size_t al256(size_t x) { return (x + 255) & ~(size_t)255; }
constexpr size_t WS_CTL = 0;
constexpr size_t WS_BUCKET = 65536;
constexpr size_t WS_ROPE = WS_BUCKET + 8192;
constexpr size_t WS_WIN = WS_ROPE + (size_t)8192 * 32 * 8;
constexpr size_t WS_WA = WS_WIN + (size_t)NW * 1024 * 2;
constexpr size_t WS_WB = WS_WA + (size_t)1024 * 512 * 2;
constexpr size_t WS_WO = WS_WB + (size_t)1024 * 1024 * 2;
constexpr size_t WS_WG = WS_WO + (size_t)1024 * 1024 * 2;
constexpr size_t WS_WU = WS_WG + (size_t)16 * 512 * 1024 * 2;
constexpr size_t WS_WD = WS_WU + (size_t)16 * 512 * 1024 * 2;
constexpr size_t WS_XB = WS_WD + (size_t)16 * 512 * 1024 * 2;
constexpr size_t WS_X = WS_XB + (size_t)T_ * 1024 * 2;
constexpr size_t WS_MG = WS_X + (size_t)T_ * 1024 * 4;
constexpr size_t WS_KCC = WS_MG + (size_t)T_ * 1024 * 2;
constexpr size_t WS_VCCT = WS_KCC + (size_t)4 * 512 * 64 * 2;
constexpr size_t WS_W1T = WS_VCCT + (size_t)4 * 512 * 64 * 2;
constexpr size_t WS_B1 = WS_W1T + (size_t)2 * 64 * 2048 * 2;
constexpr size_t WS_R = WS_B1 + 1024;
constexpr size_t WS_P = WS_R;
constexpr size_t WS_VST = WS_P + (size_t)T_ * LD * 2;
constexpr size_t WS_VWT = WS_VST + (size_t)4 * 64 * S_ * 2;
constexpr size_t WS_VRT = WS_VWT + (size_t)4 * 64 * S_ * 2;
constexpr size_t WS_KVT = WS_VRT + (size_t)16 * 128 * S_ * 2;
constexpr size_t WS_SPT = WS_KVT + (size_t)16 * 64 * 8192 * 4;
constexpr size_t WS_YC = WS_SPT + (size_t)16 * 64 * 8192 * 2;
constexpr size_t WS_YW = WS_YC + (size_t)T_ * 512 * 2;
constexpr size_t WS_YA = WS_YW + (size_t)T_ * 512 * 2;
constexpr size_t WS_YB = WS_YA + (size_t)T_ * 512 * 2;
constexpr size_t WS_SELW = WS_YB + (size_t)T_ * 1024 * 2;
constexpr size_t WS_ENDA = WS_SELW + (size_t)T_ * 2 * 4 * 4;
constexpr size_t WS_H1 = WS_R;
constexpr size_t WS_X1 = WS_H1 + (size_t)T_ * 1024 * 4;
constexpr size_t WS_X1B = WS_X1 + (size_t)T_ * 1024 * 4;
constexpr size_t WS_HB = WS_X1B + (size_t)T_ * 1024 * 2;
constexpr size_t WS_CT = WS_HB + (size_t)2 * T_ * 512 * 2;
constexpr size_t WS_LIST = WS_CT + (size_t)2 * T_ * 1024 * 2;
constexpr size_t WS_WTS = WS_LIST + (size_t)16 * T_ * 4;
constexpr size_t WS_ENDB = WS_WTS + (size_t)2 * T_ * 4;
static_assert(WS_HB + (size_t)2 * T_ * 512 * 2 <= WS_CT, "view B overlap");
constexpr size_t WS_END = WS_ENDA > WS_ENDB ? WS_ENDA : WS_ENDB;

constexpr int CW_CNT = 4096;
constexpr int CW_BAR = 8192;

constexpr int HALF_LDS = 75776, LDS_BYTES = 2 * HALF_LDS + 16;
constexpr int NTHREADS = 512, HT = 256;

struct Params {
    const float* x; const float* w_in; const float* cmp_pos; const float* cmp_w1; const float* cmp_w2;
    const float* w_br_a; const float* w_br_b; const float* w_o; const float* ln1_g; const float* ln1_b;
    const float* w_router; const float* router_bias; const float* w_gate; const float* w_up; const float* w_down;
    const float* ln2_g; const float* ln2_b; const float* rel_bias;
    float* out; unsigned char* ws;
    int ph_lo, ph_hi, rep_mask, pad_;
};

__device__ __forceinline__ bf16_t f2bf(float f) { unsigned u = __float_as_uint(f); u += 0x7fffu + ((u >> 16) & 1u); return (bf16_t)(u >> 16); }
__device__ __forceinline__ float bf2f(unsigned h) { return __uint_as_float(h << 16); }
typedef __bf16 bf16x2_t __attribute__((ext_vector_type(2)));
typedef float f32x2_t __attribute__((ext_vector_type(2)));
__device__ __forceinline__ unsigned pack2(float lo, float hi) { const f32x2_t f = {lo, hi}; return __builtin_bit_cast(unsigned, __builtin_convertvector(f, bf16x2_t)); }
__device__ __forceinline__ u32x2 pack4(f32x4 v) { u32x2 r; r.x = pack2(v[0], v[1]); r.y = pack2(v[2], v[3]); return r; }
__device__ __forceinline__ f32x4 unpack4(u32x2 u) { f32x4 r; r[0] = bf2f(u.x & 0xffffu); r[1] = bf2f(u.x >> 16); r[2] = bf2f(u.y & 0xffffu); r[3] = bf2f(u.y >> 16); return r; }
__device__ __forceinline__ float rows_max(float v) {
    u32x2 r = __builtin_amdgcn_permlane16_swap(__float_as_uint(v), __float_as_uint(v), false, false);
    v = fmaxf(__uint_as_float(r.x), __uint_as_float(r.y));
    r = __builtin_amdgcn_permlane32_swap(__float_as_uint(v), __float_as_uint(v), false, false);
    return fmaxf(__uint_as_float(r.x), __uint_as_float(r.y));
}
__device__ __forceinline__ float rows_sum(float v) {
    u32x2 r = __builtin_amdgcn_permlane16_swap(__float_as_uint(v), __float_as_uint(v), false, false);
    v = __uint_as_float(r.x) + __uint_as_float(r.y);
    r = __builtin_amdgcn_permlane32_swap(__float_as_uint(v), __float_as_uint(v), false, false);
    return __uint_as_float(r.x) + __uint_as_float(r.y);
}
__device__ __forceinline__ float wave_sum(float v) {
    v += __int_as_float(__builtin_amdgcn_ds_swizzle(__float_as_int(v), 0x041F));
    v += __int_as_float(__builtin_amdgcn_ds_swizzle(__float_as_int(v), 0x081F));
    v += __int_as_float(__builtin_amdgcn_ds_swizzle(__float_as_int(v), 0x101F));
    v += __int_as_float(__builtin_amdgcn_ds_swizzle(__float_as_int(v), 0x201F));
    v += __int_as_float(__builtin_amdgcn_ds_swizzle(__float_as_int(v), 0x401F));
    const u32x2 r = __builtin_amdgcn_permlane32_swap(__float_as_uint(v), __float_as_uint(v), false, false);
    return __uint_as_float(r.x) + __uint_as_float(r.y);
}
__device__ __forceinline__ float sigmoidf_(float x) { return 1.f / (1.f + __expf(-x)); }
__device__ __forceinline__ int ltid() { int t = threadIdx.x; asm volatile("" : "+v"(t)); return t; }
__device__ __forceinline__ int vzero() { int z; asm volatile("v_mov_b32 %0, 0" : "=v"(z)); return z; }
__device__ __forceinline__ unsigned char* launder(unsigned char* q) { asm volatile("" : "+s"(q)); return q; }
__device__ __forceinline__ void wait_vm0() { asm volatile("s_waitcnt vmcnt(0)" ::: "memory"); }

__device__ __forceinline__ void glds16(const void* g, void* l) {
    __builtin_amdgcn_global_load_lds((const __attribute__((address_space(1))) unsigned*)g,
                                     (__attribute__((address_space(3))) unsigned*)l, 16, 0, 0);
}
__device__ __forceinline__ f32x4 mfma16(bf16x8 a, bf16x8 b, f32x4 c) { return __builtin_amdgcn_mfma_f32_16x16x32_bf16(a, b, c, 0, 0, 0); }

#define WAIT_V(n) asm volatile("s_waitcnt vmcnt(%0)" ::"n"(n) : "memory")
#define RAW_BARRIER() do { asm volatile("s_waitcnt lgkmcnt(0)" ::: "memory"); __builtin_amdgcn_s_barrier(); } while (0)
__device__ __forceinline__ void bglds16(__amdgpu_buffer_rsrc_t r, unsigned voff, int soff, void* l) {
    __builtin_amdgcn_raw_ptr_buffer_load_lds(r, (__attribute__((address_space(3))) void*)l, 16, (int)voff, soff, 0, 0);
}
template <int NJ, bool GN>
__device__ __forceinline__ void gemm8_stage(__amdgpu_buffer_rsrc_t mr, int mld, unsigned mvo, __amdgpu_buffer_rsrc_t nr, int nld, const unsigned (&nvo)[NJ], int kt, unsigned char* st, int wid) {
#pragma unroll
    for (int i = 0; i < 4; ++i) bglds16(mr, mvo, (64 * i * mld + kt * 64) * 2, st + (8 * i + wid) * 1024);
#pragma unroll
    for (int i = 0; i < NJ; ++i) bglds16(nr, nvo[i], ((GN ? 0 : 64 * i * nld) + kt * 64) * 2, st + 32768 + (8 * i + wid) * 1024);
}
template <int NJ, bool GN>
__device__ __forceinline__ void gemm8_kloop(const bf16_t* mb, int mld, unsigned mvo, const bf16_t* nb, int nld, const unsigned (&nvo)[NJ], int nk, unsigned char* lds, f32x4 (&acc)[8][NJ], int tid) {
    const int lane = tid & 63, wid = tid >> 6, wr = wid >> 2, wc = wid & 3, fr = lane & 15, fq = lane >> 4;
    const __amdgpu_buffer_rsrc_t mr = __builtin_amdgcn_make_buffer_rsrc((void*)mb, 0, 0x7fffffff, 0x00020000);
    const __amdgpu_buffer_rsrc_t nr = __builtin_amdgcn_make_buffer_rsrc((void*)nb, 0, 0x7fffffff, 0x00020000);
    gemm8_stage<NJ, GN>(mr, mld, mvo, nr, nld, nvo, 0, lds, wid);
    gemm8_stage<NJ, GN>(mr, mld, mvo, nr, nld, nvo, 1, lds + 65536, wid);
    for (int kt = 0; kt < nk; ++kt) {
        unsigned char* cur = lds + (kt & 1) * 65536;
        if (kt + 1 < nk) WAIT_V(4 + NJ); else WAIT_V(0);
        RAW_BARRIER();
        bf16x8 a[4], b[NJ];
        const unsigned char* ab = cur + (128 * wr + fr) * 128;
        const unsigned char* bb = cur + 32768 + (16 * NJ * wc + fr) * 128;
        const int sw0 = ((fq) ^ (fr & 7)) << 4, sw1 = ((4 + fq) ^ (fr & 7)) << 4;
#pragma unroll
        for (int j = 0; j < NJ; ++j) b[j] = *(const bf16x8*)(bb + j * 2048 + sw0);
#pragma unroll
        for (int mh = 0; mh < 2; ++mh) {
#pragma unroll
            for (int i = 0; i < 4; ++i) a[i] = *(const bf16x8*)(ab + (4 * mh + i) * 2048 + sw0);
#pragma unroll
            for (int i = 0; i < 4; ++i)
#pragma unroll
                for (int j = 0; j < NJ; ++j) acc[4 * mh + i][j] = mfma16(a[i], b[j], acc[4 * mh + i][j]);
        }
#pragma unroll
        for (int j = 0; j < NJ; ++j) b[j] = *(const bf16x8*)(bb + j * 2048 + sw1);
#pragma unroll
        for (int i = 0; i < 4; ++i) a[i] = *(const bf16x8*)(ab + i * 2048 + sw1);
#pragma unroll
        for (int i = 0; i < 4; ++i)
#pragma unroll
            for (int j = 0; j < NJ; ++j) acc[i][j] = mfma16(a[i], b[j], acc[i][j]);
#pragma unroll
        for (int i = 0; i < 4; ++i) a[i] = *(const bf16x8*)(ab + (4 + i) * 2048 + sw1);
        RAW_BARRIER();
        if (kt + 2 < nk) gemm8_stage<NJ, GN>(mr, mld, mvo, nr, nld, nvo, kt + 2, cur, wid);
#pragma unroll
        for (int i = 0; i < 4; ++i)
#pragma unroll
            for (int j = 0; j < NJ; ++j) acc[4 + i][j] = mfma16(a[i], b[j], acc[4 + i][j]);
    }
    __syncthreads();
    __builtin_amdgcn_sched_barrier(0);
}
template <int NJ>
__device__ __forceinline__ void zero_acc8(f32x4 (&acc)[8][NJ]) {
#pragma unroll
    for (int i = 0; i < 8; ++i)
#pragma unroll
        for (int j = 0; j < NJ; ++j) acc[i][j] = (f32x4){0.f, 0.f, 0.f, 0.f};
}

namespace pg8 {
#define PG8_LAS __attribute__((address_space(3)))
constexpr int BM = 256, BK = 64, HALF = 128, HTB = HALF * BK * 2, STAGE_BYTES = 8 * HTB;
__device__ __forceinline__ int lds_byte(int r, int c) { const int st = (r >> 4) * 2 + (c >> 5), rr = r & 15, cc = c & 31, ob = rr * 64 + cc * 2; return st * 1024 + (ob ^ (((ob >> 9) & 1) << 5)); }
__device__ __forceinline__ void stage_rc(int b, int& R, int& C) { const int st = b / 1024, sb = b % 1024, swz = sb ^ (((sb >> 9) & 1) << 5); R = (st >> 1) * 16 + swz / 64; C = (st & 1) * 32 + (swz % 64) / 2; }
__device__ __forceinline__ int perm32(int rho) { const int n = rho >> 4, i = rho & 15; return 8 * (i >> 2) + 4 * n + (i & 3); }
struct Unit { int pm, pn; };
template <class Epi, class Sched>
__device__ __forceinline__ void gemm_phase(unsigned char* lds_, const int K, const Sched& S, const Epi& E, const int tid, const unsigned char* wsbase) {
    PG8_LAS unsigned char* lds = (PG8_LAS unsigned char*)lds_;
    const int wid = __builtin_amdgcn_readfirstlane(tid >> 6), lane = tid & 63, wr = wid >> 2, wc = wid & 3, fr = lane & 15, fq = lane >> 4;
    const int nt = K / BK;
    unsigned voffA[2], voffB[2];
#pragma unroll
    for (int i = 0; i < 2; ++i) { int R, C; stage_rc(tid * 16 + i * 8192, R, C); const int Rb = (R & ~31) + perm32(R & 31);
        voffA[i] = (unsigned)(R * K + C) * 2u; voffB[i] = (unsigned)(Rb * K + C) * 2u; }
    const unsigned kstep = (unsigned)(BK * 2);
    const unsigned hstep = (unsigned)HALF * K * 2;
    const __amdgpu_buffer_rsrc_t rsrc = __builtin_amdgcn_make_buffer_rsrc((void*)wsbase, 0, 0x7fffffff, 0x00020000);
    const unsigned ldsw = (unsigned)wid * 1024u;
    const int aoff = lds_byte(wr * 64 + fr, fq * 8), boff = lds_byte(wc * 32 + fr, fq * 8);
#define PG8_SA(b, h) (((b) * 2 + (h)) * HTB)
#define PG8_SB(b, h) ((4 + (b) * 2 + (h)) * HTB)
#define PG8_STAGE(bufoff, gbase, voff) do { _Pragma("unroll") for (int _i = 0; _i < 2; ++_i) \
        __builtin_amdgcn_raw_ptr_buffer_load_lds(rsrc, (PG8_LAS void*)(lds + (bufoff) + ldsw + _i * 8192), 16, (int)(voff)[_i], (int)(gbase), 0, 0); } while (0)
#define PG8_LDA(dst, b, h) do { _Pragma("unroll") for (int m = 0; m < 4; ++m) _Pragma("unroll") for (int k = 0; k < 2; ++k) dst[m][k] = *(const PG8_LAS bf16x8*)(lds + PG8_SA(b, h) + aoff + m * 2048 + k * 1024); } while (0)
#define PG8_LDB(dst, b, h) do { _Pragma("unroll") for (int n = 0; n < 2; ++n) _Pragma("unroll") for (int k = 0; k < 2; ++k) dst[n][k] = *(const PG8_LAS bf16x8*)(lds + PG8_SB(b, h) + boff + n * 2048 + k * 1024); } while (0)
#define PG8_MMA(ai, bj, At, Bt) do { __builtin_amdgcn_s_setprio(1); _Pragma("unroll") for (int m = 0; m < 4; ++m) _Pragma("unroll") for (int n = 0; n < 2; ++n) _Pragma("unroll") for (int k = 0; k < 2; ++k) \
        acc[ai][bj][m][n] = __builtin_amdgcn_mfma_f32_16x16x32_bf16(Bt[n][k], At[m][k], acc[ai][bj][m][n], 0, 0, 0); __builtin_amdgcn_s_setprio(0); } while (0)
#define PG8_WAIT_V(n) asm volatile("s_waitcnt vmcnt(" #n ")" ::: "memory")
#define PG8_WAIT_L(n) asm volatile("s_waitcnt lgkmcnt(" #n ")" ::: "memory")
#define PG8_BAR __builtin_amdgcn_s_barrier()
#define PG8_SCHED __builtin_amdgcn_sched_barrier(0)
    typename Sched::U cur, nxt; int ui = 0;
    if (!S.next(0, cur)) return;
    unsigned cA, cB; S.ptrs(cur, cA, cB);
    constexpr bool GA = Sched::GATHER;
    unsigned vA[GA ? 2 : 1][2], nvA[GA ? 2 : 1][2];
    if constexpr (GA) { S.rows(cur, tid, vA);
#pragma unroll
        for (int h = 0; h < 2; ++h)
#pragma unroll
            for (int i = 0; i < 2; ++i) nvA[h][i] = vA[h][i]; }
#define PG8_STAGE_A(bufoff, gbase, h, nextu) do { if constexpr (GA) { if (nextu) PG8_STAGE(bufoff, gbase, nvA[h]); else PG8_STAGE(bufoff, gbase, vA[h]); } \
        else PG8_STAGE(bufoff, (gbase) + (h) * hstep, voffA); } while (0)
    PG8_STAGE(PG8_SB(0, 0), cB, voffB); PG8_STAGE_A(PG8_SA(0, 0), cA, 0, false); PG8_STAGE(PG8_SB(0, 1), cB + hstep, voffB); PG8_STAGE_A(PG8_SA(0, 1), cA, 1, false);
    if (wr == 1) PG8_BAR;
    PG8_WAIT_V(4); PG8_BAR;
    PG8_STAGE(PG8_SB(1, 0), cB + kstep, voffB); PG8_STAGE_A(PG8_SA(1, 0), cA + kstep, 0, false); PG8_STAGE(PG8_SB(1, 1), cB + hstep + kstep, voffB);
    PG8_WAIT_V(6); PG8_BAR;
    PG8_SCHED;
    f32x4 acc[2][2][4][2];
#pragma unroll
    for (int a = 0; a < 2; ++a)
#pragma unroll
        for (int b = 0; b < 2; ++b)
#pragma unroll
            for (int m = 0; m < 4; ++m)
#pragma unroll
                for (int n = 0; n < 2; ++n) acc[a][b][m][n] = (f32x4){0.f, 0.f, 0.f, 0.f};
    bf16x8 At[4][2], B0[2][2], B1[2][2];
    for (;;) {
        const bool has_next = S.next(ui + 1, nxt);
        unsigned nA = cA, nB = cB; if (has_next) S.ptrs(nxt, nA, nB);
        if constexpr (GA) { if (has_next) S.rows(nxt, tid, nvA); }
        for (int t = 0; t < nt; t += 2) {
            const bool last = (t == nt - 2);
            const unsigned a1 = cA + (unsigned)(t + 1) * kstep;
            const unsigned a2 = last ? nA : cA + (unsigned)(t + 2) * kstep, b2 = last ? nB : cB + (unsigned)(t + 2) * kstep;
            const unsigned a3 = a2 + kstep, b3 = b2 + kstep;
            PG8_LDB(B0, 0, 0); PG8_SCHED; PG8_LDA(At, 0, 0); PG8_STAGE_A(PG8_SA(1, 1), a1, 1, false);
            PG8_WAIT_L(8); PG8_BAR; PG8_WAIT_L(0); PG8_MMA(0, 0, At, B0); PG8_BAR; PG8_SCHED;
            PG8_LDB(B1, 0, 1); PG8_STAGE(PG8_SB(0, 0), b2, voffB);
            PG8_BAR; PG8_WAIT_L(0); PG8_MMA(0, 1, At, B1); PG8_BAR;
            PG8_LDA(At, 0, 1); PG8_STAGE_A(PG8_SA(0, 0), a2, 0, last);
            PG8_BAR; PG8_WAIT_L(0); PG8_MMA(1, 0, At, B0); PG8_BAR; PG8_SCHED;
            PG8_STAGE(PG8_SB(0, 1), b2 + hstep, voffB);
            PG8_WAIT_V(6); PG8_BAR; PG8_MMA(1, 1, At, B1); PG8_BAR;
            PG8_LDB(B0, 1, 0); PG8_SCHED; PG8_LDA(At, 1, 0); PG8_STAGE_A(PG8_SA(0, 1), a2, 1, last);
            PG8_WAIT_L(8); PG8_BAR; PG8_WAIT_L(0); PG8_MMA(0, 0, At, B0); PG8_BAR; PG8_SCHED;
            PG8_LDB(B1, 1, 1); PG8_STAGE(PG8_SB(1, 0), b3, voffB);
            PG8_BAR; PG8_WAIT_L(0); PG8_MMA(0, 1, At, B1); PG8_BAR;
            PG8_LDA(At, 1, 1); PG8_STAGE_A(PG8_SA(1, 0), a3, 0, last);
            PG8_BAR; PG8_WAIT_L(0); PG8_MMA(1, 0, At, B0); PG8_BAR; PG8_SCHED;
            PG8_STAGE(PG8_SB(1, 1), b3 + hstep, voffB);
            PG8_WAIT_V(6); PG8_BAR; PG8_MMA(1, 1, At, B1); PG8_BAR;
        }
        E(acc, cur, wr, wc, fr, fq);
        if (!has_next) break;
#pragma unroll
        for (int a = 0; a < 2; ++a)
#pragma unroll
            for (int b = 0; b < 2; ++b)
#pragma unroll
                for (int m = 0; m < 4; ++m)
#pragma unroll
                    for (int n = 0; n < 2; ++n) acc[a][b][m][n] = (f32x4){0.f, 0.f, 0.f, 0.f};
        cur = nxt; cA = nA; cB = nB; ++ui;
        if constexpr (GA) {
#pragma unroll
            for (int h = 0; h < 2; ++h)
#pragma unroll
                for (int i = 0; i < 2; ++i) vA[h][i] = nvA[h][i]; }
    }
    PG8_WAIT_V(0);
    if (wr == 0) PG8_BAR;
    PG8_BAR;
#undef PG8_SA
#undef PG8_SB
#undef PG8_STAGE
#undef PG8_STAGE_A
#undef PG8_LDA
#undef PG8_LDB
#undef PG8_MMA
#undef PG8_WAIT_V
#undef PG8_WAIT_L
#undef PG8_BAR
#undef PG8_SCHED
}
}

struct TJob { const float* src; bf16_t* dst; int ld, k0, n0, mode, kdst; };
__device__ __forceinline__ void tcvt_load(const TJob& J, float4 (&v)[4], int tid) {
#pragma unroll
    for (int i = 0; i < 4; ++i) {
        const int kk = (tid >> 4) + 16 * i, c4 = (tid & 15) * 4, cd = J.n0 + c4;
        int orig = cd; bool ok = true;
        if (J.mode == 1) {
            if (cd < 896) orig = cd;
            else if (cd < 1024) orig = cd - 896 + 1024;
            else if (cd < 2048) { const int q = cd - 1024, hd = q >> 6, pp = q & 63;
                const int d = (pp & 4) ? 32 + 4 * (pp >> 3) + (pp & 3) : 4 * (pp >> 3) + (pp & 3);
                orig = 1304 + hd * 64 + d; }
            else if (cd < 5120) orig = cd - 2048 + 3352;
            else if (cd < 5144) orig = cd - 5120 + 1280;
            else if (cd < 5376) ok = false;
            else if (cd < 5504) orig = cd - 5376 + 896;
            else if (cd < 5632) orig = cd - 5504 + 1152;
            else orig = cd - 5632 + 2328;
        }
        v[i] = make_float4(0.f, 0.f, 0.f, 0.f);
        if (ok) v[i] = *(const float4*)(J.src + (size_t)(J.k0 + kk) * J.ld + orig);
    }
}
__device__ __forceinline__ void tcvt_finish(const TJob& J, const float4 (&v)[4], unsigned char* lds, int tid) {
    float* tile = (float*)lds;
#pragma unroll
    for (int i = 0; i < 4; ++i) {
        const int kk = (tid >> 4) + 16 * i, c4 = (tid & 15) * 4;
        tile[kk * 65 + c4 + 0] = v[i].x; tile[kk * 65 + c4 + 1] = v[i].y; tile[kk * 65 + c4 + 2] = v[i].z; tile[kk * 65 + c4 + 3] = v[i].w;
    }
    __syncthreads();
#pragma unroll
    for (int i = 0; i < 2; ++i) {
        const int q = tid + 256 * i, n = q >> 3, kc = q & 7;
        float x[8];
#pragma unroll
        for (int j = 0; j < 8; ++j) x[j] = tile[(kc * 8 + j) * 65 + n];
        u32x4 w; w.x = pack2(x[0], x[1]); w.y = pack2(x[2], x[3]); w.z = pack2(x[4], x[5]); w.w = pack2(x[6], x[7]);
        int drow = J.n0 + n; if (J.mode >= 2) drow = 8 * (drow >> 2) + (drow & 3) + (J.mode == 3 ? 4 : 0);
        *(u32x4*)(J.dst + (size_t)drow * J.kdst + J.k0 + kc * 8) = w;
    }
    __syncthreads();
}
__device__ __forceinline__ void tcvt_tile(const float* src, int ld_src, int k0, int n0, int mode, bf16_t* dst, int kdst, unsigned char* lds, int half) {
    TJob J; J.src = src; J.dst = dst; J.ld = ld_src; J.k0 = k0; J.n0 = n0; J.mode = mode; J.kdst = kdst;
    const int tid = (ltid() & 255); float4 v[4];
    tcvt_load(J, v, tid); tcvt_finish(J, v, lds, tid);
}

__device__ __forceinline__ void tcvt_decode(const Params& p, unsigned char* ws, int layer, int t, TJob& J) {
    constexpr int J0 = 16 * 104, J1 = 8 * 16, J2 = 256, J3 = 256, J4 = 2048, J5 = 2048;
    int u = t;
        if (u < J0) { J.src = p.w_in + (size_t)layer * 1024 * DIN; J.ld = DIN; J.k0 = (u % 16) * 64; J.n0 = (u / 16) * 64; J.mode = 1; J.dst = (bf16_t*)(ws + WS_WIN); J.kdst = 1024; return; }
        u -= J0;
        if (u < J1) { J.src = p.w_br_a + (size_t)layer * 512 * 1024; J.ld = 1024; J.k0 = (u % 8) * 64; J.n0 = (u / 8) * 64; J.mode = 0; J.dst = (bf16_t*)(ws + WS_WA); J.kdst = 512; return; }
        u -= J1;
        if (u < J2) { J.src = p.w_br_b + (size_t)layer * 1024 * 1024; J.ld = 1024; J.k0 = (u % 16) * 64; J.n0 = (u / 16) * 64; J.mode = 0; J.dst = (bf16_t*)(ws + WS_WB); J.kdst = 1024; return; }
        u -= J2;
        if (u < J3) { J.src = p.w_o + (size_t)layer * 1024 * 1024; J.ld = 1024; J.k0 = (u % 16) * 64; J.n0 = (u / 16) * 64; J.mode = 0; J.dst = (bf16_t*)(ws + WS_WO); J.kdst = 1024; return; }
        u -= J3;
        if (u < J4 + J5) {
            const bool up = u >= J4; if (up) u -= J4;
            const int e = u / 128, v = u % 128;
            J.src = (up ? p.w_up : p.w_gate) + ((size_t)layer * NE + e) * 1024 * 512; J.ld = 512; J.k0 = (v % 16) * 64; J.n0 = (v / 16) * 64; J.mode = up ? 3 : 2;
            J.dst = (bf16_t*)(ws + WS_WG) + (size_t)e * 1024 * 1024; J.kdst = 1024; return;
        }
        u -= J4 + J5;
        { const int e = u / 128, v = u % 128;
          J.src = p.w_down + ((size_t)layer * NE + e) * 512 * 1024; J.ld = 1024; J.k0 = (v % 8) * 64; J.n0 = (v / 8) * 64; J.mode = 0; J.dst = (bf16_t*)(ws + WS_WD) + (size_t)e * 1024 * 512; J.kdst = 512; }
}


__device__ __forceinline__ void phase_pw(const Params& p, int layer, unsigned char* lds, int parts, int half) {
    const int bid = (blockIdx.x * 2 + half), nblk = (gridDim.x * 2), tid = (ltid() & 255);
    unsigned char* ws = launder(p.ws);
    constexpr int J0 = 16 * 104, J1 = 8 * 16, J2 = 256, J3 = 256, J4 = 2048, J5 = 2048, J6 = 2048, JT = J0 + J1 + J2 + J3 + J4 + J5 + J6;
    const int t_lo = (parts & 1) ? 0 : (parts & 2) ? J0 : J0 + J1 + J2 + J3;
    const int t_hi = (parts & 4) ? JT : (parts & 2) ? J0 + J1 + J2 + J3 : (parts & 1) ? J0 : 0;
    if (t_lo + bid < t_hi) {
        float4 v[4]; { TJob J; tcvt_decode(p, ws, layer, t_lo + bid, J); tcvt_load(J, v, tid); }
        for (int t = t_lo + bid; t < t_hi; t += nblk) {
            float4 vn[4];
            if (t + nblk < t_hi) { TJob J; tcvt_decode(p, ws, layer, t + nblk, J); tcvt_load(J, vn, tid); }
            { TJob J; tcvt_decode(p, ws, layer, t, J); tcvt_finish(J, v, lds, tid); }
#pragma unroll
            for (int i = 0; i < 4; ++i) v[i] = vn[i];
        }
    }
    if (parts & 1) {
    for (int t = bid; t < 64; t += nblk) {
        const int kv = t >> 5, kt = t & 31;
        tcvt_tile(p.cmp_w1 + ((size_t)layer * 2 + kv) * 2048 * 64, 64, kt * 64, 0, 0, (bf16_t*)(ws + WS_W1T) + (size_t)kv * 64 * 2048, 2048, lds, half);
    }
    if (bid >= nblk - 2) {
        const int kv = nblk - 1 - bid, n = tid & 63, part = tid >> 6;
        const float* w1 = p.cmp_w1 + ((size_t)layer * 2 + kv) * 2048 * 64; const float* pos = p.cmp_pos + ((size_t)layer * 2 + kv) * 2048;
        float a = 0.f;
        for (int k = part * 512; k < part * 512 + 512; ++k) a += pos[k] * w1[(size_t)k * 64 + n];
        float* red = (float*)lds;
        __syncthreads(); red[tid] = a; __syncthreads();
        if (tid < 64) ((float*)(ws + WS_B1))[kv * 64 + tid] = red[tid] + red[tid + 64] + red[tid + 128] + red[tid + 192];
        __syncthreads();
    }
    }
    if (parts & 8) {
        const float4* xs = (const float4*)p.x; u32x2* xb = (u32x2*)(ws + WS_XB);
        for (size_t i = (size_t)bid * HT + tid; i < (size_t)T_ * 1024 / 4; i += (size_t)nblk * HT) {
            float4 v = xs[i]; u32x2 w; w.x = pack2(v.x, v.y); w.y = pack2(v.z, v.w); xb[i] = w;
        }
        for (int n = bid * HT + tid; n < 8192; n += nblk * HT) {
            int bk;
            if (n < 16) bk = n;
            else { const int th[15] = {22, 30, 40, 54, 73, 99, 134, 182, 246, 332, 450, 609, 825, 1117, 1513}; bk = 16;
#pragma unroll
                for (int k = 0; k < 15; ++k) bk += (n >= th[k]) ? 1 : 0; }
            (ws + WS_BUCKET)[n] = (unsigned char)bk;
        }
        for (int i = bid * HT + tid; i < 8192 * 32; i += nblk * HT) {
            const int pos = i >> 5, d = i & 31;
            const float inv = powf(10000.f, -(float)d * 2.0f / 64.f);
            const float ang = (float)pos * inv;
            float sn, cs; sincosf(ang, &sn, &cs);
            ((float2*)(ws + WS_ROPE))[i] = make_float2(cs, sn);
        }
        if (bid == 0) for (int i = tid; i < 8192; i += HT) ((unsigned*)(ws + WS_CTL))[i] = 0u;
    }
}

__device__ __forceinline__ float fsig(float x) { return __builtin_amdgcn_rcpf(1.f + __builtin_amdgcn_exp2f(-1.4426950408889634f * x)); }
template <int KIND>
__device__ __forceinline__ void g1_epi(const f32x4 (&acc)[2][2][4][2], unsigned char* ws, int r0, int c0, int wr, int wc, int fr, int fq) {
#pragma unroll
    for (int ai = 0; ai < 2; ++ai)
#pragma unroll
        for (int m = 0; m < 4; ++m) {
            const int row = r0 + 128 * ai + 64 * wr + 16 * m + fr + vzero();
#pragma unroll
            for (int bj = 0; bj < 2; ++bj) {
                const int col = c0 + 128 * bj + 32 * wc + 8 * fq;
                f32x4 v0 = acc[ai][bj][m][0], v1 = acc[ai][bj][m][1];
                if (KIND == 5) {
                    const int b = col >> 13, sq = col & (S_ - 1);
                    bf16_t* dst;
                    if (row < C_VW) { const int c = row - C_VS; dst = (bf16_t*)(ws + WS_VST) + ((size_t)(b * 2 + (c >> 6)) * 64 + (c & 63)) * S_ + sq; }
                    else if (row < C_VR) { const int c = row - C_VW; dst = (bf16_t*)(ws + WS_VWT) + ((size_t)(b * 2 + (c >> 6)) * 64 + (c & 63)) * S_ + sq; }
                    else { const int c = row - C_VR; dst = (bf16_t*)(ws + WS_VRT) + ((size_t)(b * 8 + (c >> 7)) * 128 + (c & 127)) * S_ + sq; }
                    u32x4 w; w.x = pack2(v0[0], v0[1]); w.y = pack2(v0[2], v0[3]); w.z = pack2(v1[0], v1[1]); w.w = pack2(v1[2], v1[3]);
                    *(u32x4*)dst = w;
                    continue;
                }
                if (KIND == 1 || KIND == 2) {
                    const float2* rope = (const float2*)(ws + WS_ROPE);
                    const int pos = row & (S_ - 1), d = 16 * (wc & 1) + 4 * fq;
                    const float4 cs01 = *(const float4*)(rope + pos * 32 + d), cs23 = *(const float4*)(rope + pos * 32 + d + 2);
                    const float c[4] = {cs01.x, cs01.z, cs23.x, cs23.z}, sn[4] = {cs01.y, cs01.w, cs23.y, cs23.w};
                    const float sc = (KIND == 2) ? 0.125f : 1.0f;
                    f32x4 y1, y2;
#pragma unroll
                    for (int r = 0; r < 4; ++r) { y1[r] = (v0[r] * c[r] - v1[r] * sn[r]) * sc; y2[r] = (v0[r] * sn[r] + v1[r] * c[r]) * sc; }
                    v0 = y1; v1 = y2;
                } else if (KIND == 3) {
#pragma unroll
                    for (int r = 0; r < 4; ++r) { v0[r] = v0[r] * fsig(v0[r]); v1[r] = v1[r] * fsig(v1[r]); }
                } else if (KIND == 4) {
#pragma unroll
                    for (int r = 0; r < 4; ++r) { v0[r] = fsig(v0[r]); v1[r] = fsig(v1[r]); }
                }
                u32x4 w; w.x = pack2(v0[0], v0[1]); w.y = pack2(v0[2], v0[3]); w.z = pack2(v1[0], v1[1]); w.w = pack2(v1[2], v1[3]);
                *(u32x4*)((bf16_t*)(ws + WS_P) + (size_t)row * LD + col) = w;
            }
        }
}
struct G1Order {      typedef pg8::Unit U; static constexpr bool GATHER = false;
    int xcd, slot, per;
    __device__ __forceinline__ bool next(int i, pg8::Unit& u) const {
        const int j = slot + i * per; if (j >= 208) return false;
        if (j < 192) { u.pm = j / 3; u.pn = xcd + 8 * (j % 3); } else { const int q = j - 192; u.pm = 8 * xcd + (q >> 1); u.pn = 24 + (q & 1); }
        return true;
    }
    __device__ __forceinline__ void ptrs(const pg8::Unit& u, unsigned& A, unsigned& B) const {
        const unsigned x = (unsigned)WS_XB + (unsigned)u.pm * (256u * 1024u * 2u), w = (unsigned)WS_WIN + (unsigned)u.pn * (256u * 1024u * 2u);
        if (u.pn >= 21) { A = w; B = x; } else { A = x; B = w; }
    }
};
struct G1Epi {
    unsigned char* ws;
    __device__ __forceinline__ void operator()(const f32x4 (&acc)[2][2][4][2], const pg8::Unit& u, int wr, int wc, int fr, int fq) const {
        const int pn = u.pn, tok0 = u.pm * 256, n0 = pn * 256;
        if (pn >= 21) g1_epi<5>(acc, ws, n0, tok0, wr, wc, fr, fq);
        else if (pn >= 12) g1_epi<4>(acc, ws, tok0, n0, wr, wc, fr, fq);
        else if (pn >= 8) g1_epi<3>(acc, ws, tok0, n0, wr, wc, fr, fq);
        else if (pn >= 6) g1_epi<2>(acc, ws, tok0, n0, wr, wc, fr, fq);
        else if (pn >= 4) g1_epi<1>(acc, ws, tok0, n0, wr, wc, fr, fq);
        else g1_epi<0>(acc, ws, tok0, n0, wr, wc, fr, fq);
    }
};
__device__ __forceinline__ void phase_g1(const Params& p, int layer, unsigned char* lds) {
    unsigned char* ws = launder(p.ws);
    G1Order S; S.xcd = blockIdx.x & 7; S.slot = blockIdx.x >> 3; S.per = gridDim.x >> 3;
    G1Epi E; E.ws = ws;
    pg8::gemm_phase<G1Epi, G1Order>(lds, 1024, S, E, ltid(), ws);
}

__device__ __forceinline__ void load_tile64(const bf16_t* base, size_t rowStride, unsigned char* dst, int wid, int lane) {
    const int c = ((lane & 7) ^ (lane >> 3)) * 8;
#pragma unroll
    for (int i = 0; i < 2; ++i) { const int j = wid + 4 * i, row = 8 * j + (lane >> 3); glds16(base + (size_t)row * rowStride + c, dst + j * 1024); }
}
__device__ __forceinline__ void load_tile128(const bf16_t* base, size_t rowStride, unsigned char* dst, int wid, int lane) {
    const int c = ((lane & 7) ^ (lane >> 3)) * 8;
#pragma unroll
    for (int i = 0; i < 4; ++i) { const int j = wid + 4 * i, row = 8 * j + (lane >> 3); glds16(base + (size_t)row * rowStride + c, dst + j * 1024); }
}
__device__ __forceinline__ void load_tile128w(const bf16_t* base, size_t rowStride, unsigned char* dst, int wid, int lane) {
    const int c = ((lane & 15) ^ ((4 * wid + (lane >> 4)) & 15)) * 8;
#pragma unroll
    for (int i = 0; i < 8; ++i) { const int j = wid + 4 * i, row = 4 * j + (lane >> 4); glds16(base + (size_t)row * rowStride + c, dst + j * 1024); }
}
__device__ __forceinline__ bf16x8 lds_frag128(const unsigned char* tile, int row, int chunk) {
    return *(const bf16x8*)(tile + row * 128 + ((chunk ^ (row & 7)) << 4));
}
__device__ __forceinline__ bf16x8 lds_frag256(const unsigned char* tile, int row, int chunk) {
    return *(const bf16x8*)(tile + row * 256 + ((chunk ^ (row & 15)) << 4));
}
__device__ __forceinline__ bf16x8 lds_vfrag128(const unsigned char* tile, int row, int kbase, int fq) {
    const int ca = (kbase >> 3) + (fq >> 1), hb = (fq & 1) * 8;
    const u32x2 a = *(const u32x2*)(tile + row * 128 + ((ca ^ (row & 7)) << 4) + hb);
    const u32x2 b = *(const u32x2*)(tile + row * 128 + (((ca + 2) ^ (row & 7)) << 4) + hb);
    u32x4 w; w.x = a.x; w.y = a.y; w.z = b.x; w.w = b.y;
    return __builtin_bit_cast(bf16x8, w);
}
__device__ __forceinline__ bf16x8 lds_vfrag256(const unsigned char* tile, int row, int kbase, int fq) {
    const int ca = (kbase >> 3) + (fq >> 1), hb = (fq & 1) * 8;
    const u32x2 a = *(const u32x2*)(tile + row * 256 + ((ca ^ (row & 15)) << 4) + hb);
    const u32x2 b = *(const u32x2*)(tile + row * 256 + (((ca + 2) ^ (row & 15)) << 4) + hb);
    u32x4 w; w.x = a.x; w.y = a.y; w.z = b.x; w.w = b.y;
    return __builtin_bit_cast(bf16x8, w);
}
__device__ __forceinline__ bf16x8 pack8(f32x4 a, f32x4 b) {
    u32x4 w; w.x = pack2(a[0], a[1]); w.y = pack2(a[2], a[3]); w.z = pack2(b[0], b[1]); w.w = pack2(b[2], b[3]);
    return __builtin_bit_cast(bf16x8, w);
}

__device__ __forceinline__ float gelu_tanh(float x) {
    const float u = 0.7978845608028654f * (x + 0.044715f * x * x * x);
    return 0.5f * x * (1.f + tanhf(u));
}
__device__ __forceinline__ void compress_item(const Params& p, int layer, int item, unsigned char* lds, int half) {
    unsigned char* ws = launder(p.ws);
    const int tid = (ltid() & 255), lane = tid & 63, wid = tid >> 6, wr = wid >> 1, wc = wid & 1, fr = lane & 15, fq = lane >> 4;
    const int mtile = item & 3, g = (item >> 2) & 1, b = (item >> 3) & 1, kv = item >> 4;
    const int i0 = mtile * 128;
    const bf16_t* P = (const bf16_t*)(ws + WS_P);
    const bf16_t* W1T = (const bf16_t*)(ws + WS_W1T) + (size_t)kv * 64 * 2048;
    const int col = (kv ? C_VC : C_KC) + g * 64;
    const int ldc = ((lane & 7) ^ (lane >> 3)) * 8;
    const bf16_t* ap[4];
#pragma unroll
    for (int i = 0; i < 4; ++i) ap[i] = P + ((size_t)b * S_ + 16 * (i0 + 32 * i + 8 * wid + (lane >> 3))) * LD + col + ldc;
    const bf16_t* bp[2];
#pragma unroll
    for (int i = 0; i < 2; ++i) bp[i] = W1T + (size_t)(8 * (wid + 4 * i) + (lane >> 3)) * 2048 + ldc;
    f32x4 acc[4][2];
#pragma unroll
    for (int i = 0; i < 4; ++i)
#pragma unroll
        for (int j = 0; j < 2; ++j) acc[i][j] = (f32x4){0.f, 0.f, 0.f, 0.f};
    __syncthreads();
#define CSTAGE(buf, l) do { unsigned char* st_ = lds + (buf) * 24576; \
        _Pragma("unroll") for (int i = 0; i < 4; ++i) glds16(ap[i] + (size_t)(l) * LD, st_ + (4 * i + wid) * 1024); \
        _Pragma("unroll") for (int i = 0; i < 2; ++i) glds16(bp[i] + (l) * 64, st_ + 16384 + (wid + 4 * i) * 1024); } while (0)
    CSTAGE(0, 0); wait_vm0(); __syncthreads();
    for (int l = 0; l < 32; ++l) {
        const unsigned char* st = lds + (l & 1) * 24576;
        if (l + 1 < 32) CSTAGE((l + 1) & 1, l + 1);
#pragma unroll
        for (int ks = 0; ks < 2; ++ks) {
            bf16x8 a[4], bb[2];
#pragma unroll
            for (int i = 0; i < 4; ++i) a[i] = lds_frag128(st, 64 * wr + 16 * i + fr, 4 * ks + fq);
#pragma unroll
            for (int j = 0; j < 2; ++j) bb[j] = lds_frag128(st + 16384, 32 * wc + 16 * j + fr, 4 * ks + fq);
#pragma unroll
            for (int i = 0; i < 4; ++i)
#pragma unroll
                for (int j = 0; j < 2; ++j) acc[i][j] = mfma16(a[i], bb[j], acc[i][j]);
        }
        wait_vm0(); __syncthreads();
    }
#undef CSTAGE
    float* hid = (float*)lds;
    const float* b1 = (const float*)(ws + WS_B1) + kv * 64;
#pragma unroll
    for (int j = 0; j < 2; ++j) {
        const int n = 32 * wc + 16 * j + fr; const float bias = b1[n + vzero()];
#pragma unroll
        for (int i = 0; i < 4; ++i)
#pragma unroll
            for (int r = 0; r < 4; ++r) hid[(64 * wr + 16 * i + 4 * fq + r) * 65 + n] = gelu_tanh(acc[i][j][r] + bias);
    }
    __syncthreads();
    {
        const int row = tid >> 1, nb = (tid & 1) * 32, ci = i0 + row;
        const float* w2 = p.cmp_w2 + ((size_t)layer * 2 + kv) * 64 * 64;
        float o[32];
#pragma unroll
        for (int q = 0; q < 32; ++q) o[q] = 0.f;
        for (int n = 0; n < 64; ++n) {
            const float h = hid[row * 65 + n];
#pragma unroll
            for (int q4 = 0; q4 < 8; ++q4) { const float4 w = *(const float4*)(w2 + n * 64 + nb + 4 * q4); o[4 * q4] += h * w.x; o[4 * q4 + 1] += h * w.y; o[4 * q4 + 2] += h * w.z; o[4 * q4 + 3] += h * w.w; }
        }
        if (kv == 0) {
            bf16_t* dst = (bf16_t*)(ws + WS_KCC) + ((size_t)(b * 2 + g) * 512 + ci) * 64 + nb;
#pragma unroll
            for (int q = 0; q < 32; q += 4) { f32x4 v = {o[q], o[q + 1], o[q + 2], o[q + 3]}; if (ci >= 511) v = (f32x4){0.f, 0.f, 0.f, 0.f}; *(u32x2*)(dst + q) = pack4(v); }
        } else {
            bf16_t* dst = (bf16_t*)(ws + WS_VCCT) + ((size_t)(b * 2 + g) * 64 + nb) * 512 + ci;
#pragma unroll
            for (int q = 0; q < 32; ++q) dst[(size_t)q * 512] = f2bf(ci >= 511 ? 0.f : o[q]);
        }
    }
    __syncthreads();
}

__device__ __forceinline__ float ret_lg2(int h) { const float gam = 1.f - exp2f(-5.f - (float)h); return log2f(gam); }

__device__ __forceinline__ void retkv_item(const Params& p, int item, unsigned char* lds, int half) {
    unsigned char* ws = launder(p.ws);
    const int tid = (ltid() & 255), lane = tid & 63, wid = tid >> 6, fr = lane & 15, fq = lane >> 4;
    const int n = item & 63, h = (item >> 6) & 7, b = item >> 9;
    const size_t tok0 = (size_t)b * S_ + 128 * n;
    unsigned char* vL = lds; unsigned char* kL = lds + 32768;
    load_tile128w((const bf16_t*)(ws + WS_VRT) + ((size_t)(b * 8 + h) * 128) * S_ + 128 * n, S_, vL, wid, lane);
    load_tile128((const bf16_t*)(ws + WS_P) + tok0 * LD + C_KR + h * 64, LD, kL, wid, lane);
    wait_vm0(); __syncthreads();
    const float lg2 = ret_lg2(h);
    f32x4 acc[2][4];
#pragma unroll
    for (int m = 0; m < 2; ++m)
#pragma unroll
        for (int nt = 0; nt < 4; ++nt) acc[m][nt] = (f32x4){0.f, 0.f, 0.f, 0.f};
#pragma unroll
    for (int ks = 0; ks < 4; ++ks) {
        bf16x8 a[2], bb[4];
#pragma unroll
        for (int m = 0; m < 2; ++m) a[m] = lds_frag256(vL, 32 * wid + 16 * m + fr, 4 * ks + fq);
        float dec[8];
#pragma unroll
        for (int j = 0; j < 8; ++j) dec[j] = exp2f((float)(127 - (32 * ks + 8 * fq + j)) * lg2);
#pragma unroll
        for (int nt = 0; nt < 4; ++nt) {
            const int d = 16 * nt + fr;
            float v[8];
#pragma unroll
            for (int j = 0; j < 8; ++j) {
                const int tk = 32 * ks + 8 * fq + j;
                const bf16_t kvv = *(const bf16_t*)(kL + tk * 128 + (((d >> 3) ^ (tk & 7)) << 4) + (d & 7) * 2);
                v[j] = bf2f(kvv) * dec[j];
            }
            u32x4 w; w.x = pack2(v[0], v[1]); w.y = pack2(v[2], v[3]); w.z = pack2(v[4], v[5]); w.w = pack2(v[6], v[7]);
            bb[nt] = __builtin_bit_cast(bf16x8, w);
        }
#pragma unroll
        for (int m = 0; m < 2; ++m)
#pragma unroll
            for (int nt = 0; nt < 4; ++nt) acc[m][nt] = mfma16(a[m], bb[nt], acc[m][nt]);
    }
    float* KVT = (float*)(ws + WS_KVT) + ((size_t)(b * 8 + h) * 64 + n) * 8192;
#pragma unroll
    for (int m = 0; m < 2; ++m)
#pragma unroll
        for (int nt = 0; nt < 4; ++nt)
#pragma unroll
            for (int r = 0; r < 4; ++r) KVT[(32 * wid + 16 * m + 4 * fq + r) * 64 + 16 * nt + fr] = acc[m][nt][r];
    __syncthreads();
}

__device__ __forceinline__ void phase_p2(const Params& p, int layer, unsigned char* lds, int half) {
    for (int it = (blockIdx.x * 2 + half); it < 1024 + 32; it += (gridDim.x * 2)) {
        if (it < 32) compress_item(p, layer, it, lds, half); else retkv_item(p, it - 32, lds, half);
    }
}

constexpr int NSA_IMP = 32768, NSA_BUCKET = 65792, NSA_BIAS = 73984;

struct NsaLane { int t; int fr, fq, wid, lane; };

template <int BR, int PASS>
__device__ __forceinline__ void nsa_half(const unsigned char* kL, const unsigned char* vL, const unsigned char* lds, const bf16x8 (&qptr)[4][2],
                                         f32x4 (&O)[4][4], float (&m)[4], float (&l)[4], int tile, int hf, bool selbit, const NsaLane& L, int qrow) {
    const int fr = L.fr, fq = L.fq;
    bf16x8 Kf[2][2];
#pragma unroll
    for (int i = 0; i < 2; ++i)
#pragma unroll
        for (int ks = 0; ks < 2; ++ks) Kf[i][ks] = lds_frag128(kL, 32 * hf + 16 * i + fr, 4 * ks + fq);
    bf16x8 Vf[4];
    if (PASS != 0) {
#pragma unroll
        for (int mt = 0; mt < 4; ++mt) Vf[mt] = lds_vfrag128(vL, 16 * mt + fr, 32 * hf, fq);
    }
    unsigned vmask = 0; unsigned bk[2];
    const unsigned char* bucketL = lds + NSA_BUCKET;
#pragma unroll
    for (int i = 0; i < 2; ++i) {
        unsigned pk = 0;
#pragma unroll
        for (int r = 0; r < 4; ++r) {
            const int kk = 32 * hf + 16 * i + 4 * fq + r;
            int rel; bool ok;
            if (BR == 0) { rel = L.t - (16 * (64 * tile + kk) + 31); ok = rel >= 0; }
            else if (BR == 1) { rel = L.t - (64 * tile + kk); ok = selbit && rel >= 0; }
            else { rel = L.t - (64 * tile + kk); ok = rel >= 0 && rel < 512; }
            int rc = rel < 0 ? 0 : rel; rc = rc > 8191 ? 8191 : rc;
            pk |= (unsigned)bucketL[rc] << (8 * r);
            vmask |= (ok ? 1u : 0u) << (4 * i + r);
        }
        bk[i] = pk;
    }
    const float* biasL = (const float*)(lds + NSA_BIAS);
    float ia[2] = {0.f, 0.f}, ic[2] = {0.f, 0.f};
#pragma unroll
    for (int nt = 0; nt < 4; ++nt) {
        f32x4 S[2];
        const bf16x8 q0 = qptr[nt][0], q1 = qptr[nt][1];
#pragma unroll
        for (int i = 0; i < 2; ++i) {
            S[i] = (f32x4){0.f, 0.f, 0.f, 0.f};
            S[i] = mfma16(Kf[i][0], q0, S[i]); S[i] = mfma16(Kf[i][1], q1, S[i]);
        }
        float tmax = -1e30f;
        float bsv[2][4];
#pragma unroll
        for (int i = 0; i < 2; ++i)
#pragma unroll
            for (int r = 0; r < 4; ++r) bsv[i][r] = biasL[nt * 32 + ((bk[i] >> (8 * r)) & 0xffu)];
        asm volatile("" : "+v"(bsv[0][0]), "+v"(bsv[0][1]), "+v"(bsv[0][2]), "+v"(bsv[0][3]), "+v"(bsv[1][0]), "+v"(bsv[1][1]), "+v"(bsv[1][2]), "+v"(bsv[1][3]));
#pragma unroll
        for (int i = 0; i < 2; ++i)
#pragma unroll
            for (int r = 0; r < 4; ++r) {
                const bool ok = (vmask >> (4 * i + r)) & 1u;
                const float sv = S[i][r] * 0.125f + bsv[i][r];
                S[i][r] = ok ? sv : -1e30f; tmax = fmaxf(tmax, S[i][r]);
            }
        if (PASS != 1) {
            tmax = rows_max(tmax);
            const float mnew = fmaxf(m[nt], tmax), alpha = __expf(m[nt] - mnew);
            float psum = 0.f;
#pragma unroll
            for (int i = 0; i < 2; ++i)
#pragma unroll
                for (int r = 0; r < 4; ++r) {
                    const bool ok = (vmask >> (4 * i + r)) & 1u;
                    const float pv = ok ? __expf(S[i][r] - mnew) : 0.f;
                    S[i][r] = pv; psum += pv;
                }
            psum = rows_sum(psum);
            l[nt] = l[nt] * alpha + psum; m[nt] = mnew;
            if (PASS == 2) {
#pragma unroll
                for (int mt = 0; mt < 4; ++mt) O[mt][nt] = O[mt][nt] * alpha;
            }
        } else {
#pragma unroll
            for (int i = 0; i < 2; ++i) {
#pragma unroll
                for (int r = 0; r < 4; ++r) {
                    const bool ok = (vmask >> (4 * i + r)) & 1u;
                    S[i][r] = ok ? __expf(S[i][r] - m[nt]) * l[nt] : 0.f;
                }
                ia[i] += S[i][0] + S[i][1] + S[i][2] + 0.5f * S[i][3];
                ic[i] += 0.5f * S[i][3];
            }
        }
        if (PASS != 0) {
            const bf16x8 Pb = pack8(S[0], S[1]);
#pragma unroll
            for (int mt = 0; mt < 4; ++mt) O[mt][nt] = mfma16(Vf[mt], Pb, O[mt][nt]);
        }
    }
    if (PASS == 1) {
        float* imp = (float*)(lds + NSA_IMP) + qrow * 129;
        asm volatile("" ::: "memory"); __builtin_amdgcn_wave_barrier();
#pragma unroll
        for (int i = 0; i < 2; ++i) { const int j = 16 * tile + 8 * hf + 4 * i + fq; imp[j] += ia[i]; }
        asm volatile("s_waitcnt lgkmcnt(0)" ::: "memory"); __builtin_amdgcn_wave_barrier();
#pragma unroll
        for (int i = 0; i < 2; ++i) { const int j = 16 * tile + 8 * hf + 4 * i + fq + 1; if (j < 128) imp[j] += ic[i]; }
        asm volatile("s_waitcnt lgkmcnt(0)" ::: "memory"); __builtin_amdgcn_wave_barrier();
    }
}
template <int BR, int PASS>
__device__ __forceinline__ void nsa_tile(const unsigned char* kL, const unsigned char* vL, const unsigned char* lds, const bf16x8 (&qptr)[4][2],
                                         f32x4 (&O)[4][4], float (&m)[4], float (&l)[4], int tile, bool selbit, const NsaLane& L, int qrow) {
#pragma unroll 1
    for (int hf = 0; hf < 2; ++hf) nsa_half<BR, PASS>(kL, vL, lds, qptr, O, m, l, tile, hf, selbit, L, qrow);
}

__device__ __forceinline__ void cmp_item(const Params& p, int item, unsigned char* lds, int half) {
    unsigned char* ws = launder(p.ws);
    const int tid = (ltid() & 255), lane = tid & 63, wid = tid >> 6, fr = lane & 15, fq = lane >> 4;
    const int combo = item & 3, qt = 127 - (item >> 2), b = combo >> 1, g = combo & 1;
    const int q0 = qt * 64, qrow = 16 * wid + fr;
    NsaLane L; L.t = q0 + qrow; L.fr = fr; L.fq = fq; L.wid = wid; L.lane = lane;
    const size_t tok = (size_t)b * S_ + L.t;
    const bf16_t* P = (const bf16_t*)(ws + WS_P);
    __syncthreads();
    if (tid < 128) ((float*)(lds + NSA_BIAS))[tid] = p.rel_bias[(tid & 31) * 8 + 4 * g + (tid >> 5)];
    for (int i = tid; i < 64 * 129; i += HT) ((float*)(lds + NSA_IMP))[i] = 0.f;
    bf16x8 Qf[4][2];
#pragma unroll
    for (int nt = 0; nt < 4; ++nt)
#pragma unroll
        for (int ks = 0; ks < 2; ++ks) Qf[nt][ks] = *(const bf16x8*)(P + tok * LD + C_QA + (4 * g + nt) * 64 + 32 * ks + 8 * fq);
    __syncthreads();
    f32x4 O[4][4]; float m[4], l[4];
    const bf16_t* gates = P + tok * LD + C_GA + (4 * g) * 3;
    const bf16_t* kc = (const bf16_t*)(ws + WS_KCC) + (size_t)(b * 2 + g) * 512 * 64;
    const bf16_t* vc = (const bf16_t*)(ws + WS_VCCT) + (size_t)(b * 2 + g) * 64 * 512;
    const int ntc = ((q0 + 32) >> 4) / 64 + 1;
#pragma unroll
    for (int nt = 0; nt < 4; ++nt) { m[nt] = -1e30f; l[nt] = 0.f; }
    load_tile64(kc, 64, lds, wid, lane);
    wait_vm0(); __syncthreads();
    for (int it = 0; it < ntc; ++it) {
        unsigned char* cur = lds + (it & 1) * 16384;
        if (it + 1 < ntc) load_tile64(kc + (size_t)(it + 1) * 64 * 64, 64, lds + ((it + 1) & 1) * 16384, wid, lane);
        nsa_tile<0, 0>(cur, cur + 8192, lds, Qf, O, m, l, it, true, L, qrow);
        wait_vm0(); __syncthreads();
    }
#pragma unroll
    for (int nt = 0; nt < 4; ++nt) l[nt] = l[nt] > 0.f ? 1.f / l[nt] : 0.f;
#pragma unroll
    for (int mt = 0; mt < 4; ++mt)
#pragma unroll
        for (int nt = 0; nt < 4; ++nt) O[mt][nt] = (f32x4){0.f, 0.f, 0.f, 0.f};
    load_tile64(kc, 64, lds, wid, lane); load_tile64(vc, 512, lds + 8192, wid, lane);
    wait_vm0(); __syncthreads();
    for (int it = 0; it < ntc; ++it) {
        unsigned char* cur = lds + (it & 1) * 16384;
        if (it + 1 < ntc) { unsigned char* nx = lds + ((it + 1) & 1) * 16384;
            load_tile64(kc + (size_t)(it + 1) * 64 * 64, 64, nx, wid, lane); load_tile64(vc + (it + 1) * 64, 512, nx + 8192, wid, lane); }
        nsa_tile<0, 1>(cur, cur + 8192, lds, Qf, O, m, l, it, true, L, qrow);
        wait_vm0(); __syncthreads();
    }
    bf16_t* YC = (bf16_t*)(ws + WS_YC) + tok * 512 + (4 * g) * 64;
#pragma unroll
    for (int nt = 0; nt < 4; ++nt) {
        const float gt = bf2f(gates[nt * 3 + 0]);
#pragma unroll
        for (int mt = 0; mt < 4; ++mt) *(u32x2*)(YC + nt * 64 + 16 * mt + 4 * fq) = pack4(O[mt][nt] * gt);
    }
    const int cur = qt;
    {
        float* imp = (float*)(lds + NSA_IMP) + qrow * 129 + 32 * fq;
        asm volatile("s_waitcnt lgkmcnt(0)" ::: "memory"); __builtin_amdgcn_wave_barrier();
#pragma unroll
        for (int i = 0; i < 32; ++i) {
            const int j = 32 * fq + i;
            const float v = imp[i];
            imp[i] = j > cur ? -1.f : v + ((j == 0 || j == cur || j == cur - 1) ? 1.0e4f : 0.f);
        }
        unsigned word = 0;
#pragma unroll 1
        for (int round = 0; round < 16; ++round) {
            float bv = imp[0]; int bi = 0;
#pragma unroll
            for (int i = 1; i < 32; ++i) { const float v = imp[i]; if (v > bv) { bv = v; bi = i; } }
            int gi = 32 * fq + bi;
            {
                u32x2 rv = __builtin_amdgcn_permlane16_swap(__float_as_uint(bv), __float_as_uint(bv), false, false);
                u32x2 ri = __builtin_amdgcn_permlane16_swap((unsigned)gi, (unsigned)gi, false, false);
                float v0 = __uint_as_float(rv.x), v1 = __uint_as_float(rv.y); int i0 = (int)ri.x, i1 = (int)ri.y;
                if (v1 > v0 || (v1 == v0 && i1 < i0)) { v0 = v1; i0 = i1; }
                rv = __builtin_amdgcn_permlane32_swap(__float_as_uint(v0), __float_as_uint(v0), false, false);
                ri = __builtin_amdgcn_permlane32_swap((unsigned)i0, (unsigned)i0, false, false);
                v0 = __uint_as_float(rv.x); v1 = __uint_as_float(rv.y); i0 = (int)ri.x; i1 = (int)ri.y;
                if (v1 > v0 || (v1 == v0 && i1 < i0)) { v0 = v1; i0 = i1; }
                bv = v0; gi = i0;
            }
            if (bv >= 0.f && (gi >> 5) == fq) { word |= 1u << (gi & 31); imp[gi & 31] = -2.f; }
        }
        ((unsigned*)(ws + WS_SELW))[(tok * 2 + g) * 4 + fq] = word;
    }
}

__device__ __forceinline__ void win_item(const Params& p, int item, unsigned char* lds, int half) {
    unsigned char* ws = launder(p.ws);
    const int tid = (ltid() & 255), lane = tid & 63, wid = tid >> 6, fr = lane & 15, fq = lane >> 4;
    const int combo = item & 3, qt = 127 - (item >> 2), b = combo >> 1, g = combo & 1;
    const int q0 = qt * 64, qrow = 16 * wid + fr;
    NsaLane L; L.t = q0 + qrow; L.fr = fr; L.fq = fq; L.wid = wid; L.lane = lane;
    const size_t tok = (size_t)b * S_ + L.t;
    const bf16_t* P = (const bf16_t*)(ws + WS_P);
    __syncthreads();
    if (tid < 128) ((float*)(lds + NSA_BIAS))[tid] = p.rel_bias[(tid & 31) * 8 + 4 * g + (tid >> 5)];
    bf16x8 Qf[4][2];
#pragma unroll
    for (int nt = 0; nt < 4; ++nt)
#pragma unroll
        for (int ks = 0; ks < 2; ++ks) Qf[nt][ks] = *(const bf16x8*)(P + tok * LD + C_QA + (4 * g + nt) * 64 + 32 * ks + 8 * fq);
    __syncthreads();
    f32x4 O[4][4]; float m[4], l[4];
    const bf16_t* gates = P + tok * LD + C_GA + (4 * g) * 3;
#pragma unroll
    for (int nt = 0; nt < 4; ++nt) { m[nt] = -1e30f; l[nt] = 0.f; }
#pragma unroll
    for (int mt = 0; mt < 4; ++mt)
#pragma unroll
        for (int nt = 0; nt < 4; ++nt) O[mt][nt] = (f32x4){0.f, 0.f, 0.f, 0.f};
    {
        const bf16_t* kb = P + ((size_t)b * S_) * LD + C_KW + g * 64;
        const bf16_t* vb = (const bf16_t*)(ws + WS_VWT) + (size_t)(b * 2 + g) * 64 * S_;
        const int k_lo = qt - 8 > 0 ? qt - 8 : 0, ntw = qt - k_lo + 1;
        load_tile64(kb + (size_t)k_lo * 64 * LD, LD, lds, wid, lane); load_tile64(vb + k_lo * 64, S_, lds + 8192, wid, lane);
        wait_vm0(); __syncthreads();
        for (int it = 0; it < ntw; ++it) {
            unsigned char* cu = lds + (it & 1) * 16384;
            if (it + 1 < ntw) { unsigned char* nx = lds + ((it + 1) & 1) * 16384;
                load_tile64(kb + (size_t)(k_lo + it + 1) * 64 * LD, LD, nx, wid, lane); load_tile64(vb + (k_lo + it + 1) * 64, S_, nx + 8192, wid, lane); }
            nsa_tile<2, 2>(cu, cu + 8192, lds, Qf, O, m, l, k_lo + it, true, L, qrow);
            wait_vm0(); __syncthreads();
        }
    }
    bf16_t* YW = (bf16_t*)(ws + WS_YW) + tok * 512 + (4 * g) * 64;
#pragma unroll
    for (int nt = 0; nt < 4; ++nt) {
        const float gt = bf2f(gates[nt * 3 + 2]) * (l[nt] > 0.f ? 1.f / l[nt] : 0.f);
#pragma unroll
        for (int mt = 0; mt < 4; ++mt) *(u32x2*)(YW + nt * 64 + 16 * mt + 4 * fq) = pack4(O[mt][nt] * gt);
    }
}

constexpr int SEL_BIAS2 = NSA_BIAS;
constexpr float LOG2E = 1.4426950408889634f;
__device__ __forceinline__ int t5_first(int bk) {
    const int th[16] = {16, 22, 30, 40, 54, 73, 99, 134, 182, 246, 332, 450, 609, 825, 1117, 1513};
    int r = 16;
#pragma unroll
    for (int k = 0; k < 16; ++k) r = (bk == 16 + k) ? th[k] : r;
    return r;
}
template <bool FAST>
__device__ __forceinline__ void sel_ntile(const bf16x8 (&Kf)[4][2], const unsigned char* vL, int fr, int fq, const bf16x8& q0, const bf16x8& q1, f32x4 (&O)[4], float& m, float& l,
                                          bool sb, int relb, int th, float blo, float bhi, const unsigned char* lds, int hl) {
    f32x4 S[4];
#pragma unroll
    for (int i = 0; i < 4; ++i) { S[i] = (f32x4){0.f, 0.f, 0.f, 0.f}; S[i] = mfma16(Kf[i][0], q0, S[i]); S[i] = mfma16(Kf[i][1], q1, S[i]); }
    float tmax = -1e30f;
    const float scl = (!FAST || sb) ? 0.125f * LOG2E : 0.f;
    if (FAST) { blo = (sb ? blo : -1e30f) - m; bhi = (sb ? bhi : -1e30f) - m; }
    if (FAST) {
#pragma unroll
        for (int i = 0; i < 4; ++i)
#pragma unroll
            for (int r = 0; r < 4; ++r) { const int rel = relb - (16 * i + r); S[i][r] = S[i][r] * scl + (rel >= th ? bhi : blo); tmax = fmaxf(tmax, S[i][r]); }
    } else {
        unsigned bkt[4][4]; float bs[4][4];
#pragma unroll
        for (int i = 0; i < 4; ++i)
#pragma unroll
            for (int r = 0; r < 4; ++r) { const int rel = relb - (16 * i + r); int rc = rel < 0 ? 0 : rel; rc = rc > 8191 ? 8191 : rc; bkt[i][r] = (lds + NSA_BUCKET)[rc]; }
#pragma unroll
        for (int i = 0; i < 4; ++i)
#pragma unroll
            for (int r = 0; r < 4; ++r) bs[i][r] = ((const float*)(lds + SEL_BIAS2))[hl * 32 + bkt[i][r]];
        asm volatile("" : "+v"(bs[0][0]), "+v"(bs[0][1]), "+v"(bs[0][2]), "+v"(bs[0][3]), "+v"(bs[1][0]), "+v"(bs[1][1]), "+v"(bs[1][2]), "+v"(bs[1][3]),
                          "+v"(bs[2][0]), "+v"(bs[2][1]), "+v"(bs[2][2]), "+v"(bs[2][3]), "+v"(bs[3][0]), "+v"(bs[3][1]), "+v"(bs[3][2]), "+v"(bs[3][3]));
        const float ninf = -1e30f;
#pragma unroll
        for (int i = 0; i < 4; ++i)
#pragma unroll
            for (int r = 0; r < 4; ++r) {
                const int rel = relb - (16 * i + r);
                const float sv = S[i][r] * (0.125f * LOG2E) + (bs[i][r] - m);
                S[i][r] = (sb && rel >= 0) ? sv : ninf; tmax = fmaxf(tmax, S[i][r]);
            }
    }
    tmax = rows_max(tmax);
    if (__ballot(tmax > 8.f) != 0ull) {
        const float d = fmaxf(tmax, 0.f), alpha = __builtin_amdgcn_exp2f(-d);
        m += d; l *= alpha;
#pragma unroll
        for (int mt = 0; mt < 4; ++mt) O[mt] = O[mt] * alpha;
#pragma unroll
        for (int i = 0; i < 4; ++i)
#pragma unroll
            for (int r = 0; r < 4; ++r) S[i][r] -= d;
    }
    float psum = 0.f;
#pragma unroll
    for (int i = 0; i < 4; ++i)
#pragma unroll
        for (int r = 0; r < 4; ++r) { const float pv = __builtin_amdgcn_exp2f(S[i][r]); S[i][r] = pv; psum += pv; }
    l += rows_sum(psum);
    const bf16x8 Pb0 = pack8(S[0], S[1]), Pb1 = pack8(S[2], S[3]);
#pragma unroll
    for (int mt = 0; mt < 4; ++mt) { O[mt] = mfma16(lds_vfrag128(vL, 16 * mt + fr, 0, fq), Pb0, O[mt]); O[mt] = mfma16(lds_vfrag128(vL, 16 * mt + fr, 32, fq), Pb1, O[mt]); }
}
__device__ __forceinline__ void sel_ntile2_fast(const bf16x8 (&Kf)[4][2], const unsigned char* vL, int fr, int fq, const bf16x8 (&Qf)[2][2], f32x4 (&O)[2][4], float (&m)[2], float (&l)[2],
                                                const bool (&sb)[2], const int (&relb)[2], int th, float blo, float bhi) {
    f32x4 S[2][4]; float tmax[2], bl[2], bh[2], scl[2];
#pragma unroll
    for (int b = 0; b < 2; ++b)
#pragma unroll
        for (int i = 0; i < 4; ++i) { S[b][i] = (f32x4){0.f, 0.f, 0.f, 0.f}; S[b][i] = mfma16(Kf[i][0], Qf[b][0], S[b][i]); S[b][i] = mfma16(Kf[i][1], Qf[b][1], S[b][i]); }
#pragma unroll
    for (int b = 0; b < 2; ++b) { scl[b] = sb[b] ? 0.125f * LOG2E : 0.f; bl[b] = (sb[b] ? blo : -1e30f) - m[b]; bh[b] = (sb[b] ? bhi : -1e30f) - m[b]; tmax[b] = -1e30f; }
#pragma unroll
    for (int b = 0; b < 2; ++b)
#pragma unroll
        for (int i = 0; i < 4; ++i)
#pragma unroll
            for (int r = 0; r < 4; ++r) { const int rel = relb[b] - (16 * i + r); S[b][i][r] = S[b][i][r] * scl[b] + (rel >= th ? bh[b] : bl[b]); tmax[b] = fmaxf(tmax[b], S[b][i][r]); }
#pragma unroll
    for (int b = 0; b < 2; ++b) tmax[b] = rows_max(tmax[b]);
    if (__ballot(tmax[0] > 8.f || tmax[1] > 8.f) != 0ull) {
#pragma unroll
        for (int b = 0; b < 2; ++b) {
            const float d = fmaxf(tmax[b], 0.f), alpha = __builtin_amdgcn_exp2f(-d);
            m[b] += d; l[b] *= alpha;
#pragma unroll
            for (int mt = 0; mt < 4; ++mt) O[b][mt] = O[b][mt] * alpha;
#pragma unroll
            for (int i = 0; i < 4; ++i)
#pragma unroll
                for (int r = 0; r < 4; ++r) S[b][i][r] -= d;
        }
    }
    float psum[2] = {0.f, 0.f};
#pragma unroll
    for (int b = 0; b < 2; ++b)
#pragma unroll
        for (int i = 0; i < 4; ++i)
#pragma unroll
            for (int r = 0; r < 4; ++r) { const float pv = __builtin_amdgcn_exp2f(S[b][i][r]); S[b][i][r] = pv; psum[b] += pv; }
#pragma unroll
    for (int b = 0; b < 2; ++b) l[b] += rows_sum(psum[b]);
    bf16x8 P0[2], P1[2];
#pragma unroll
    for (int b = 0; b < 2; ++b) { P0[b] = pack8(S[b][0], S[b][1]); P1[b] = pack8(S[b][2], S[b][3]); }
#pragma unroll
    for (int mt = 0; mt < 4; ++mt) {
        const bf16x8 v0 = lds_vfrag128(vL, 16 * mt + fr, 0, fq), v1 = lds_vfrag128(vL, 16 * mt + fr, 32, fq);
#pragma unroll
        for (int b = 0; b < 2; ++b) { O[b][mt] = mfma16(v0, P0[b], O[b][mt]); O[b][mt] = mfma16(v1, P1[b], O[b][mt]); }
    }
}
template <bool FAST>
__device__ __forceinline__ void sel_tile(const unsigned char* kL, const unsigned char* vL, const unsigned char* lds, const bf16x8 (&Qf)[2][2], f32x4 (&O)[2][4], float (&m)[2], float (&l)[2],
                                         const bool (&sb)[2], const bool (&need)[2], const int (&relb)[2], int th, float blo, float bhi, int hl, int fr, int fq) {
    bf16x8 Kf[4][2];
#pragma unroll
    for (int i = 0; i < 4; ++i)
#pragma unroll
        for (int ks = 0; ks < 2; ++ks) Kf[i][ks] = lds_frag128(kL, 16 * i + fr, 4 * ks + fq);
    if (FAST && need[0] && need[1]) { sel_ntile2_fast(Kf, vL, fr, fq, Qf, O, m, l, sb, relb, th, blo, bhi); return; }
    if (need[0]) sel_ntile<FAST>(Kf, vL, fr, fq, Qf[0][0], Qf[0][1], O[0], m[0], l[0], sb[0], relb[0], th, blo, bhi, lds, hl);
    if (need[1]) sel_ntile<FAST>(Kf, vL, fr, fq, Qf[1][0], Qf[1][1], O[1], m[1], l[1], sb[1], relb[1], th, blo, bhi, lds, hl);
}
template <int VAR>
__device__ __forceinline__ void sel_item(const Params& p, int v, unsigned char* lds, int half) {
    unsigned char* ws = launder(p.ws);
    const int tid = (ltid() & 255), lane = tid & 63, wid = tid >> 6, fr = lane & 15, fq = lane >> 4;
    const int qt = 127 - (v >> 3), sub = v & 7, b = sub >> 2, g = (sub >> 1) & 1, qh = sub & 1;
    const int q0 = qt * 64 + 32 * qh, cur = qt, hl = fr & 3;
    const bf16_t* P = (const bf16_t*)(ws + WS_P);
    __syncthreads();
    if (tid < 128) ((float*)(lds + SEL_BIAS2))[tid] = p.rel_bias[(tid & 31) * 8 + 4 * g + (tid >> 5)] * LOG2E;
    int t[2]; size_t tok[2]; bf16x8 Qf[2][2]; unsigned selw[2][4];
#pragma unroll
    for (int nt = 0; nt < 2; ++nt) {
        t[nt] = q0 + 8 * wid + 4 * nt + (fr >> 2); tok[nt] = (size_t)b * S_ + t[nt];
#pragma unroll
        for (int ks = 0; ks < 2; ++ks) Qf[nt][ks] = *(const bf16x8*)(P + tok[nt] * LD + C_QA + (4 * g + hl) * 64 + 32 * ks + 8 * fq);
        const u32x4 w = *(const u32x4*)((const unsigned*)(ws + WS_SELW) + (tok[nt] * 2 + g) * 4);
        selw[nt][0] = w.x; selw[nt][1] = w.y; selw[nt][2] = w.z; selw[nt][3] = w.w;
    }
    f32x4 O[2][4]; float m[2], l[2];
#pragma unroll
    for (int nt = 0; nt < 2; ++nt) { m[nt] = -1000.f; l[nt] = 0.f;
#pragma unroll
        for (int mt = 0; mt < 4; ++mt) O[nt][mt] = (f32x4){0.f, 0.f, 0.f, 0.f}; }
    const bf16_t* kb = P + ((size_t)b * S_) * LD + C_KS + g * 64;
    const bf16_t* vb = (const bf16_t*)(ws + WS_VST) + (size_t)(b * 2 + g) * 64 * S_;
    const int nts = cur + 1;
#define SEL_ISSUE(jj) do { unsigned char* st_ = lds + ((jj) & 3) * 16384; load_tile64(kb + (size_t)(jj) * 64 * LD, LD, st_, wid, lane); load_tile64(vb + (jj) * 64, S_, st_ + 8192, wid, lane); } while (0)
    asm volatile("s_waitcnt vmcnt(0)" ::: "memory");
    SEL_ISSUE(0); if (nts > 1) SEL_ISSUE(1); if (nts > 2) SEL_ISSUE(2);
    const unsigned char* bucketL = lds + NSA_BUCKET;
    for (int j = 0; j < nts; ++j) {
        const unsigned char* cu = lds + (j & 3) * 16384;
        if (j + 2 < nts) WAIT_V(8); else if (j + 1 < nts) WAIT_V(4); else WAIT_V(0);
        RAW_BARRIER();
        if (j + 3 < nts) SEL_ISSUE(j + 3);
        bool sb[2], need[2]; int relb[2];
#pragma unroll
        for (int nt = 0; nt < 2; ++nt) {
            const unsigned w = j < 32 ? selw[nt][0] : j < 64 ? selw[nt][1] : j < 96 ? selw[nt][2] : selw[nt][3];
            sb[nt] = (w >> (j & 31)) & 1u; need[nt] = __ballot(sb[nt]) != 0ull; relb[nt] = t[nt] - 64 * j - 4 * fq;
        }
        if (VAR == 1) { need[0] = false; need[1] = false; }
        if (VAR == 2) { if (!(need[0] || need[1])) { need[0] = false; } else { need[0] = true; need[1] = true; } }
        if (need[0] || need[1]) {
            const int rmin = q0 - 64 * j - 63, rmax = q0 + 31 - 64 * j;
            bool fast = false; int th = 0; float blo = 0.f, bhi = 0.f;
            if (rmin >= 16) {
                const int b0 = bucketL[rmin], b1 = bucketL[rmax > 8191 ? 8191 : rmax];
                if (b1 - b0 <= 1) { fast = true; th = t5_first(b1); if (b1 == b0) th = 0;
                    blo = ((const float*)(lds + SEL_BIAS2))[hl * 32 + b0]; bhi = ((const float*)(lds + SEL_BIAS2))[hl * 32 + b1]; }
            }
            if (fast) sel_tile<true>(cu, cu + 8192, lds, Qf, O, m, l, sb, need, relb, th, blo, bhi, hl, fr, fq);
            else sel_tile<false>(cu, cu + 8192, lds, Qf, O, m, l, sb, need, relb, th, blo, bhi, hl, fr, fq);
        }
    }
#undef SEL_ISSUE
    __syncthreads();
#pragma unroll
    for (int nt = 0; nt < 2; ++nt) {
        const float gt = bf2f(P[tok[nt] * LD + C_GA + (4 * g + hl) * 3 + 1]) * (l[nt] > 0.f ? 1.f / l[nt] : 0.f);
        const size_t o = tok[nt] * 512 + (4 * g + hl) * 64;
#pragma unroll
        for (int mt = 0; mt < 4; ++mt) {
            const f32x4 yc = unpack4(*(const u32x2*)((const bf16_t*)(ws + WS_YC) + o + 16 * mt + 4 * fq));
            const f32x4 yw = unpack4(*(const u32x2*)((const bf16_t*)(ws + WS_YW) + o + 16 * mt + 4 * fq));
            if (VAR == 0 || VAR == 3) *(u32x2*)((bf16_t*)(ws + WS_YA) + o + 16 * mt + 4 * fq) = pack4(yc + yw + O[nt][mt] * gt);
            else asm volatile("" :: "v"(O[nt][mt]));
        }
    }
}

__device__ __forceinline__ void scan_item(const Params& p, int item, int half) {
    unsigned char* ws = launder(p.ws);
    const int idx = item * HT + (ltid() & 255);
    const int bh = idx >> 13, ed = idx & 8191, h = bh & 7;
    const float dec = exp2f(128.f * ret_lg2(h));
    const float* KVT = (const float*)(ws + WS_KVT) + (size_t)bh * 64 * 8192 + ed;
    bf16_t* SPT = (bf16_t*)(ws + WS_SPT) + (size_t)bh * 64 * 8192 + ed;
    float s = 0.f;
    for (int n = 0; n < 64; ++n) { SPT[(size_t)n * 8192] = f2bf(s); s = s * dec + KVT[(size_t)n * 8192]; }
}

__device__ __forceinline__ void phase_p3(const Params& p, unsigned char* lds, int half, int what) {
    for (int i = (ltid() & 255); i < 8192 / 16; i += HT) ((u32x4*)(lds + NSA_BUCKET))[i] = ((const u32x4*)(launder(p.ws) + WS_BUCKET))[i];
    __syncthreads();
    for (int h = (blockIdx.x * 2 + half); h < 512; h += (gridDim.x * 2)) {
        if (what & 1) cmp_item(p, h, lds, half);
        if (what & 2) {
            if (h >= 128 && h < 384) win_item(p, h - 128, lds, half);
            else if (h >= 384) { win_item(p, 256 + 2 * (h - 384) - ((h & 1) ? 1 : 0) , lds, half); win_item(p, 256 + 2 * (h - 384) + ((h & 1) ? 0 : 1) + 1 - ((h & 1) ? 0 : 0), lds, half); }
        }
        if (what & 4) scan_item(p, h, half);
    }
}

__device__ __forceinline__ void retout_item(const Params& p, int item, unsigned char* lds, int half) {
    unsigned char* ws = launder(p.ws);
    const int tid = (ltid() & 255), lane = tid & 63, wid = tid >> 6, fr = lane & 15, fq = lane >> 4;
    const int n = item & 63, h = (item >> 6) & 7, b = item >> 9;
    const size_t tok0 = (size_t)b * S_ + 128 * n;
    const bf16_t* P = (const bf16_t*)(ws + WS_P);
    unsigned char* vL = lds; unsigned char* kL = lds + 32768; unsigned char* sL = lds + 49152;
    __syncthreads();
    load_tile128w((const bf16_t*)(ws + WS_VRT) + ((size_t)(b * 8 + h) * 128) * S_ + 128 * n, S_, vL, wid, lane);
    load_tile128(P + tok0 * LD + C_KR + h * 64, LD, kL, wid, lane);
    load_tile128((const bf16_t*)(ws + WS_SPT) + ((size_t)(b * 8 + h) * 64 + n) * 8192, 64, sL, wid, lane);
    bf16x8 Qf[2][2];
#pragma unroll
    for (int nt = 0; nt < 2; ++nt)
#pragma unroll
        for (int ks = 0; ks < 2; ++ks) Qf[nt][ks] = *(const bf16x8*)(P + (tok0 + 32 * wid + 16 * nt + fr) * LD + C_QR + h * 64 + 32 * ks + 8 * fq);
    wait_vm0(); __syncthreads();
    const float lg2 = ret_lg2(h);
    f32x4 Y[8][2];
#pragma unroll
    for (int m = 0; m < 8; ++m)
#pragma unroll
        for (int nt = 0; nt < 2; ++nt) Y[m][nt] = (f32x4){0.f, 0.f, 0.f, 0.f};
#pragma unroll
    for (int m = 0; m < 8; ++m)
#pragma unroll
        for (int ks = 0; ks < 2; ++ks) {
            const bf16x8 a = lds_frag128(sL, 16 * m + fr, 4 * ks + fq);
#pragma unroll
            for (int nt = 0; nt < 2; ++nt) Y[m][nt] = mfma16(a, Qf[nt][ks], Y[m][nt]);
        }
#pragma unroll
    for (int nt = 0; nt < 2; ++nt) {
        const float sc = exp2f((float)(32 * wid + 16 * nt + fr + 1) * lg2);
#pragma unroll
        for (int m = 0; m < 8; ++m) Y[m][nt] = Y[m][nt] * sc;
    }
#pragma unroll 1
    for (int s = 0; s < 4; ++s) {
        f32x4 St[2][2];
#pragma unroll
        for (int hh = 0; hh < 2; ++hh) {
            const int mt = 2 * s + hh;
#pragma unroll
            for (int nt = 0; nt < 2; ++nt) St[hh][nt] = (f32x4){0.f, 0.f, 0.f, 0.f};
#pragma unroll
            for (int ks = 0; ks < 2; ++ks) {
                const bf16x8 a = lds_frag128(kL, 16 * mt + fr, 4 * ks + fq);
#pragma unroll
                for (int nt = 0; nt < 2; ++nt) St[hh][nt] = mfma16(a, Qf[nt][ks], St[hh][nt]);
            }
#pragma unroll
            for (int nt = 0; nt < 2; ++nt) {
                const int qi = 32 * wid + 16 * nt + fr;
#pragma unroll
                for (int r = 0; r < 4; ++r) {
                    const int kj = 16 * mt + 4 * fq + r;
                    const float dm = qi >= kj ? exp2f((float)(qi - kj) * lg2) : 0.f;
                    St[hh][nt][r] *= dm;
                }
            }
        }
        bf16x8 Pb[2];
#pragma unroll
        for (int nt = 0; nt < 2; ++nt) Pb[nt] = pack8(St[0][nt], St[1][nt]);
#pragma unroll
        for (int m = 0; m < 8; ++m) {
            const bf16x8 a = lds_vfrag256(vL, 16 * m + fr, 32 * s, fq);
#pragma unroll
            for (int nt = 0; nt < 2; ++nt) Y[m][nt] = mfma16(a, Pb[nt], Y[m][nt]);
        }
    }
    bf16_t* YB = (bf16_t*)(ws + WS_YB);
#pragma unroll
    for (int nt = 0; nt < 2; ++nt) {
        float sum = 0.f;
#pragma unroll
        for (int m = 0; m < 8; ++m) sum += Y[m][nt][0] + Y[m][nt][1] + Y[m][nt][2] + Y[m][nt][3];
        sum = rows_sum(sum);
        const float mu = sum * (1.f / 128.f);
        float vs = 0.f;
#pragma unroll
        for (int m = 0; m < 8; ++m)
#pragma unroll
            for (int r = 0; r < 4; ++r) { const float dlt = Y[m][nt][r] - mu; vs += dlt * dlt; }
        vs = rows_sum(vs);
        const float rstd = rsqrtf(vs * (1.f / 128.f) + 1e-5f);
        const size_t tk = tok0 + 32 * wid + 16 * nt + fr;
#pragma unroll
        for (int m = 0; m < 8; ++m) {
            const f32x4 gt = unpack4(*(const u32x2*)(P + tk * LD + C_GR + h * 128 + 16 * m + 4 * fq));
            f32x4 v;
#pragma unroll
            for (int r = 0; r < 4; ++r) v[r] = (Y[m][nt][r] - mu) * rstd * gt[r];
            *(u32x2*)(YB + tk * 1024 + h * 128 + 16 * m + 4 * fq) = pack4(v);
        }
    }
}
__device__ __forceinline__ void phase_p4(const Params& p, unsigned char* lds, int half, int what) {
    for (int i = (ltid() & 255); i < 8192 / 16; i += HT) ((u32x4*)(lds + NSA_BUCKET))[i] = ((const u32x4*)(launder(p.ws) + WS_BUCKET))[i];
    __syncthreads();
    for (int it = (blockIdx.x * 2 + half) + ((what & 1) ? 0 : 1024); it < ((what & 2) ? 2048 : 1024); it += (gridDim.x * 2)) {
        if (it < 1024) sel_item<0>(p, it < 512 ? it : 1535 - it, lds, half); else retout_item(p, it - 1024, lds, half);
    }
#ifdef EXTRA_SEL
    __syncthreads();
    for (int it = (blockIdx.x * 2 + half); it < 1024; it += (gridDim.x * 2)) {
        sel_item<EXTRA_SEL>(p, it < 512 ? it : 1535 - it, lds, half);
    }
#endif
}

struct RowOrder {     typedef pg8::Unit U; static constexpr bool GATHER = false;
    unsigned a, b; int K, xcd, slot, per;
    __device__ __forceinline__ bool next(int i, pg8::Unit& u) const { const int t = xcd * 32 + slot + i * per; if (t >= (xcd + 1) * 32) return false; u.pm = t >> 2; u.pn = t & 3; return true; }
    __device__ __forceinline__ void ptrs(const pg8::Unit& u, unsigned& A, unsigned& B) const { A = a + (unsigned)u.pm * 512u * (unsigned)K; B = b + (unsigned)u.pn * 512u * (unsigned)K; }
};
template <int MODE>
struct MixEpi {
    unsigned char* ws; const float* X;
    __device__ __forceinline__ void operator()(const f32x4 (&acc)[2][2][4][2], const pg8::Unit& u, int wr, int wc, int fr, int fq) const {
#pragma unroll
        for (int ai = 0; ai < 2; ++ai)
#pragma unroll
            for (int m = 0; m < 4; ++m) {
                const size_t tok = (size_t)(u.pm * 256 + 128 * ai + 64 * wr + 16 * m + fr + vzero());
#pragma unroll
                for (int bj = 0; bj < 2; ++bj) {
                    const int n = u.pn * 256 + 128 * bj + 32 * wc + 8 * fq;
                    const f32x4 v0 = acc[ai][bj][m][0], v1 = acc[ai][bj][m][1];
                    if (MODE == 2) {
                        const f32x4 x0 = *(const f32x4*)(X + tok * 1024 + n), x1 = *(const f32x4*)(X + tok * 1024 + n + 4);
                        float* H1 = (float*)(ws + WS_H1);
                        *(f32x4*)(H1 + tok * 1024 + n) = x0 * DN_ALPHA + v0; *(f32x4*)(H1 + tok * 1024 + n + 4) = x1 * DN_ALPHA + v1;
                    } else {
                        const u32x4 gw = *(const u32x4*)((const bf16_t*)(ws + WS_P) + tok * LD + (MODE == 0 ? C_MA : C_MB) + n);
                        const f32x4 g0 = unpack4((u32x2){gw.x, gw.y}), g1 = unpack4((u32x2){gw.z, gw.w});
                        f32x4 o0 = g0 * v0, o1 = g1 * v1;
                        bf16_t* MG = (bf16_t*)(ws + WS_MG) + tok * 1024 + n;
                        if (MODE == 1) { const u32x4 pw = *(const u32x4*)MG; o0 = o0 + unpack4((u32x2){pw.x, pw.y}); o1 = o1 + unpack4((u32x2){pw.z, pw.w}); }
                        u32x4 w; w.x = pack2(o0[0], o0[1]); w.y = pack2(o0[2], o0[3]); w.z = pack2(o1[0], o1[1]); w.w = pack2(o1[2], o1[3]);
                        *(u32x4*)MG = w;
                    }
                }
            }
    }
};
__device__ __forceinline__ void phase_g2(const Params& p, unsigned char* lds) {
    unsigned char* ws = launder(p.ws);
    RowOrder S; S.xcd = blockIdx.x & 7; S.slot = blockIdx.x >> 3; S.per = gridDim.x >> 3;
    { S.a = (unsigned)WS_YA; S.b = (unsigned)WS_WA; S.K = 512; MixEpi<0> E; E.ws = ws; E.X = nullptr; pg8::gemm_phase<MixEpi<0>, RowOrder>(lds, 512, S, E, ltid(), ws); }
    { S.a = (unsigned)WS_YB; S.b = (unsigned)WS_WB; S.K = 1024; MixEpi<1> E; E.ws = ws; E.X = nullptr; pg8::gemm_phase<MixEpi<1>, RowOrder>(lds, 1024, S, E, ltid(), ws); }
}
__device__ __forceinline__ void phase_g3(const Params& p, int layer, unsigned char* lds) {
    unsigned char* ws = launder(p.ws);
    RowOrder S; S.xcd = blockIdx.x & 7; S.slot = blockIdx.x >> 3; S.per = gridDim.x >> 3; S.a = (unsigned)WS_MG; S.b = (unsigned)WS_WO; S.K = 1024;
    MixEpi<2> E; E.ws = ws; E.X = layer == 0 ? p.x : (const float*)(ws + WS_X);
    pg8::gemm_phase<MixEpi<2>, RowOrder>(lds, 1024, S, E, ltid(), ws);
}

__device__ __forceinline__ void phase_ln1(const Params& p, int layer, unsigned char* lds, bool dry, int half) {
    unsigned char* ws = launder(p.ws);
    const int tid = (ltid() & 255), lane = tid & 63, wid = tid >> 6;
    float* wrL = (float*)lds;
    {
        float4 wv[16];
#pragma unroll
        for (int k = 0; k < 16; ++k) wv[k] = ((const float4*)p.w_router)[tid + 256 * k];
#pragma unroll
        for (int k = 0; k < 16; ++k) { const int i4 = tid + 256 * k, d = i4 >> 2, e0 = (i4 & 3) * 4;
            wrL[(e0 + 0) * 1024 + d] = wv[k].x; wrL[(e0 + 1) * 1024 + d] = wv[k].y; wrL[(e0 + 2) * 1024 + d] = wv[k].z; wrL[(e0 + 3) * 1024 + d] = wv[k].w; }
    }
    __syncthreads();
    const float* H1 = (const float*)(ws + WS_H1);
    float* X1 = (float*)(ws + WS_X1); bf16_t* X1B = (bf16_t*)(ws + WS_X1B);
    const float* gam = p.ln1_g + layer * 1024; const float* bet = p.ln1_b + layer * 1024;
    unsigned* cnt = (unsigned*)(ws + WS_CTL) + (dry ? 0 : CW_CNT) + layer * 1024;
    int* LIST = (int*)(ws + (dry ? WS_HB : WS_LIST)); float* WTS = (float*)(ws + (dry ? WS_HB + 4194304 : WS_WTS));
    const int tstep = (gridDim.x * 2) * 4;
    float4 vn[4];
    { const int tok0 = (blockIdx.x * 2 + half) * 4 + wid;
#pragma unroll
      for (int j = 0; j < 4; ++j) vn[j] = *(const float4*)(H1 + (size_t)tok0 * 1024 + 256 * j + 4 * lane); }
    for (int tok = (blockIdx.x * 2 + half) * 4 + wid; tok < T_; tok += tstep) {
        float4 v[4];
#pragma unroll
        for (int j = 0; j < 4; ++j) v[j] = vn[j];
        { const int tn = tok + tstep < T_ ? tok + tstep : tok;
#pragma unroll
          for (int j = 0; j < 4; ++j) vn[j] = *(const float4*)(H1 + (size_t)tn * 1024 + 256 * j + 4 * lane); }
        float s = 0.f;
#pragma unroll
        for (int j = 0; j < 4; ++j) s += v[j].x + v[j].y + v[j].z + v[j].w;
        s = wave_sum(s);
        const float mu = s * (1.f / 1024.f);
        float q = 0.f;
#pragma unroll
        for (int j = 0; j < 4; ++j) { const float a = v[j].x - mu, b2 = v[j].y - mu, c = v[j].z - mu, d = v[j].w - mu; q += a * a + b2 * b2 + c * c + d * d; }
        q = wave_sum(q);
        const float rstd = rsqrtf(q * (1.f / 1024.f) + 1e-5f);
        float4 y[4];
#pragma unroll
        for (int j = 0; j < 4; ++j) {
            const int d0 = 256 * j + 4 * lane;
            const float4 gg = *(const float4*)(gam + d0), bb = *(const float4*)(bet + d0);
            y[j].x = (v[j].x - mu) * rstd * gg.x + bb.x; y[j].y = (v[j].y - mu) * rstd * gg.y + bb.y; y[j].z = (v[j].z - mu) * rstd * gg.z + bb.z; y[j].w = (v[j].w - mu) * rstd * gg.w + bb.w;
            *(float4*)(X1 + (size_t)tok * 1024 + d0) = y[j];
            u32x2 w; w.x = pack2(y[j].x, y[j].y); w.y = pack2(y[j].z, y[j].w);
            *(u32x2*)(X1B + (size_t)tok * 1024 + d0) = w;
        }
        float lg[16];
#pragma unroll
        for (int e = 0; e < 16; ++e) {
            float a = 0.f;
#pragma unroll
            for (int j = 0; j < 4; ++j) { const float4 w4 = *(const float4*)(wrL + e * 1024 + 256 * j + 4 * lane); a += y[j].x * w4.x + y[j].y * w4.y + y[j].z * w4.z + y[j].w * w4.w; }
            lg[e] = a;
        }
#pragma unroll
        for (int e = 0; e < 16; ++e) {
            lg[e] = wave_sum(lg[e]);
        }
        float mx = lg[0];
#pragma unroll
        for (int e = 1; e < 16; ++e) mx = fmaxf(mx, lg[e]);
        float pr[16], ps = 0.f;
#pragma unroll
        for (int e = 0; e < 16; ++e) { pr[e] = expf(lg[e] - mx); ps += pr[e]; }
        const float ips = 1.f / ps;
        float sel[16];
#pragma unroll
        for (int e = 0; e < 16; ++e) { pr[e] *= ips; sel[e] = pr[e] + p.router_bias[e]; }
        int best = 0; float bestv = -1e30f;
#pragma unroll
        for (int gI = 0; gI < 4; ++gI) {
            float a = -1e30f, b2 = -1e30f;
#pragma unroll
            for (int k = 0; k < 4; ++k) { const float x = sel[4 * gI + k]; if (x > a) { b2 = a; a = x; } else if (x > b2) b2 = x; }
            const float gs = a + b2;
            if (gs > bestv) { bestv = gs; best = gI; }
        }
        float s4[4], p4[4];
#pragma unroll
        for (int k = 0; k < 4; ++k) { s4[k] = 0.f; p4[k] = 0.f; }
#pragma unroll
        for (int gI = 0; gI < 4; ++gI) if (gI == best) {
#pragma unroll
            for (int k = 0; k < 4; ++k) { s4[k] = sel[4 * gI + k]; p4[k] = pr[4 * gI + k]; }
        }
        int i0 = 0; float a0 = s4[0];
#pragma unroll
        for (int k = 1; k < 4; ++k) if (s4[k] > a0) { a0 = s4[k]; i0 = k; }
        int i1 = -1; float a1 = -1e30f;
#pragma unroll
        for (int k = 0; k < 4; ++k) if (k != i0 && s4[k] > a1) { a1 = s4[k]; i1 = k; }
        float w0 = 0.f, w1 = 0.f;
#pragma unroll
        for (int k = 0; k < 4; ++k) { if (k == i0) w0 = p4[k]; if (k == i1) w1 = p4[k]; }
        const float iw = 1.f / (w0 + w1);
        if (lane == 0) {
            const int e0 = best * 4 + i0, e1 = best * 4 + i1;
            const unsigned p0 = atomicAdd(&cnt[e0 * 64], 1u), p1 = atomicAdd(&cnt[e1 * 64], 1u);
            LIST[(size_t)e0 * T_ + p0] = tok * 2; LIST[(size_t)e1 * T_ + p1] = tok * 2 + 1;
            WTS[tok * 2] = w0 * iw; WTS[tok * 2 + 1] = w1 * iw;
        }
    }
}

struct MoeUnit { int e, rt, ct, cnt, off; };
struct MoeOrderBase {
    const unsigned* cntp; int t_lo, t_hi, slot, per;
    __device__ __forceinline__ void init(const unsigned* cnt) {
        cntp = cnt; int ntile = 0;
#pragma unroll
        for (int k = 0; k < NE; ++k) ntile += ((__builtin_amdgcn_readfirstlane((int)cnt[k * 64]) + 255) >> 8) * 4;
        t_lo = (ntile * (int)(blockIdx.x & 7)) >> 3; t_hi = (ntile * (int)((blockIdx.x & 7) + 1)) >> 3; slot = blockIdx.x >> 3; per = gridDim.x >> 3;
    }
    __device__ __forceinline__ bool next(int i, MoeUnit& u) const {
        const int t = t_lo + slot + i * per; if (t >= t_hi) return false;
        int base = 0, off = 0; bool found = false;
#pragma unroll
        for (int k = 0; k < NE; ++k) {
            const int ck = __builtin_amdgcn_readfirstlane((int)cntp[k * 64]), nt = ((ck + 255) >> 8) * 4;
            if (!found && t < base + nt) { found = true; u.e = k; u.cnt = ck; u.off = off; u.rt = (t - base) >> 2; u.ct = (t - base) & 3; }
            base += nt; off += ck;
        }
        return found;
    }
};
struct M2Order : MoeOrderBase {
    typedef MoeUnit U; static constexpr bool GATHER = true;
    const int* list;
    __device__ __forceinline__ void ptrs(const MoeUnit& u, unsigned& A, unsigned& B) const { A = (unsigned)WS_X1B; B = (unsigned)WS_WG + ((unsigned)u.e * 1024u + (unsigned)u.ct * 256u) * 2048u; }
    __device__ __forceinline__ void rows(const MoeUnit& u, int tid, unsigned (&v)[2][2]) const {
#pragma unroll
        for (int i = 0; i < 2; ++i) { int R, C; pg8::stage_rc((tid + vzero()) * 16 + i * 8192, R, C);
#pragma unroll
            for (int h = 0; h < 2; ++h) { int idx = u.rt * 256 + 128 * h + R; idx = idx < u.cnt ? idx : u.cnt - 1; const int a = (list + (size_t)u.e * T_)[idx]; v[h][i] = ((unsigned)(a >> 1) << 11) + (unsigned)C * 2u; } }
    }
};
struct M3Order : MoeOrderBase {
    typedef MoeUnit U; static constexpr bool GATHER = false;
    __device__ __forceinline__ void ptrs(const MoeUnit& u, unsigned& A, unsigned& B) const { A = (unsigned)WS_HB + ((unsigned)u.off + (unsigned)u.rt * 256u) * 1024u; B = (unsigned)WS_WD + ((unsigned)u.e * 1024u + (unsigned)u.ct * 256u) * 1024u; }
};
struct M2Epi {
    unsigned char* ws;
    __device__ __forceinline__ void operator()(const f32x4 (&acc)[2][2][4][2], const MoeUnit& u, int wr, int wc, int fr, int fq) const {
        bf16_t* HB = (bf16_t*)(ws + WS_HB);
#pragma unroll
        for (int ai = 0; ai < 2; ++ai)
#pragma unroll
            for (int m = 0; m < 4; ++m) {
                const int idx = u.rt * 256 + 128 * ai + 64 * wr + 16 * m + fr + vzero();
                if (idx < u.cnt) {
#pragma unroll
                    for (int bj = 0; bj < 2; ++bj) {
                        const int hcol = 4 * (32 * u.ct + 16 * bj + 4 * wc + fq);
                        const f32x4 gv = acc[ai][bj][m][0], uv = acc[ai][bj][m][1]; f32x4 hv;
#pragma unroll
                        for (int r = 0; r < 4; ++r) hv[r] = gv[r] * fsig(gv[r]) * uv[r];
                        *(u32x2*)(HB + (size_t)(u.off + idx) * 512 + hcol) = pack4(hv);
                    }
                }
            }
    }
};
struct M3Epi {
    unsigned char* ws; const int* list;
    __device__ __forceinline__ void operator()(const f32x4 (&acc)[2][2][4][2], const MoeUnit& u, int wr, int wc, int fr, int fq) const {
        bf16_t* CT = (bf16_t*)(ws + WS_CT);
#pragma unroll
        for (int ai = 0; ai < 2; ++ai)
#pragma unroll
            for (int m = 0; m < 4; ++m) {
                const int idx = u.rt * 256 + 128 * ai + 64 * wr + 16 * m + fr + vzero();
                if (idx < u.cnt) {
                    const int a = list[(size_t)u.e * T_ + idx];
#pragma unroll
                    for (int bj = 0; bj < 2; ++bj) {
                        const int n = u.ct * 256 + 128 * bj + 32 * wc + 8 * fq;
                        const f32x4 v0 = acc[ai][bj][m][0], v1 = acc[ai][bj][m][1];
                        u32x4 w; w.x = pack2(v0[0], v0[1]); w.y = pack2(v0[2], v0[3]); w.z = pack2(v1[0], v1[1]); w.w = pack2(v1[2], v1[3]);
                        *(u32x4*)(CT + (size_t)a * 1024 + n) = w;
                    }
                }
            }
    }
};
__device__ __forceinline__ void phase_m2(const Params& p, int layer, unsigned char* lds) {
    unsigned char* ws = launder(p.ws);
    M2Order S; S.init((const unsigned*)(ws + WS_CTL) + CW_CNT + layer * 1024 + vzero());
    S.list = (const int*)(ws + WS_LIST);
    M2Epi E; E.ws = ws;
    pg8::gemm_phase<M2Epi, M2Order>(lds, 1024, S, E, ltid(), ws);
}
__device__ __forceinline__ void phase_m3(const Params& p, int layer, unsigned char* lds) {
    unsigned char* ws = launder(p.ws);
    M3Order S; S.init((const unsigned*)(ws + WS_CTL) + CW_CNT + layer * 1024 + vzero());
    M3Epi E; E.ws = ws; E.list = (const int*)(ws + WS_LIST);
    pg8::gemm_phase<M3Epi, M3Order>(lds, 512, S, E, ltid(), ws);
}

__device__ __forceinline__ void phase_ln2(const Params& p, int layer, int half) {
    unsigned char* ws = launder(p.ws);
    const int tid = (ltid() & 255), lane = tid & 63, wid = tid >> 6;
    const float* X1 = (const float*)(ws + WS_X1); const bf16_t* CT = (const bf16_t*)(ws + WS_CT); const float* WTS = (const float*)(ws + WS_WTS);
    float* XO = layer == NLAYER - 1 ? p.out : (float*)(ws + WS_X); bf16_t* XB = (bf16_t*)(ws + WS_XB);
    const float* gam = p.ln2_g + layer * 1024; const float* bet = p.ln2_b + layer * 1024;
    constexpr int U = 4;
    const int nwave = (gridDim.x * 2) * 4, wv = (blockIdx.x * 2 + half) * 4 + wid;
    for (int t0 = wv * U; t0 < T_; t0 += nwave * U) {
        float4 v[U][4]; float s[U], q[U];
#pragma unroll
        for (int u = 0; u < U; ++u) {
            const int tok = t0 + u;
            const float w0 = WTS[tok * 2 + vzero()], w1 = WTS[tok * 2 + 1 + vzero()];
            s[u] = 0.f; q[u] = 0.f;
#pragma unroll
            for (int j = 0; j < 4; ++j) {
                const int d0 = 256 * j + 4 * lane;
                const float4 xv = *(const float4*)(X1 + (size_t)tok * 1024 + d0);
                const f32x4 c0 = unpack4(*(const u32x2*)(CT + (size_t)(tok * 2) * 1024 + d0)), c1 = unpack4(*(const u32x2*)(CT + (size_t)(tok * 2 + 1) * 1024 + d0));
                v[u][j].x = xv.x * DN_ALPHA + w0 * c0[0] + w1 * c1[0]; v[u][j].y = xv.y * DN_ALPHA + w0 * c0[1] + w1 * c1[1];
                v[u][j].z = xv.z * DN_ALPHA + w0 * c0[2] + w1 * c1[2]; v[u][j].w = xv.w * DN_ALPHA + w0 * c0[3] + w1 * c1[3];
                s[u] += v[u][j].x + v[u][j].y + v[u][j].z + v[u][j].w;
                q[u] += v[u][j].x * v[u][j].x + v[u][j].y * v[u][j].y + v[u][j].z * v[u][j].z + v[u][j].w * v[u][j].w;
            }
        }
#pragma unroll
        for (int u = 0; u < U; ++u) { s[u] = wave_sum(s[u]); q[u] = wave_sum(q[u]); }
#pragma unroll
        for (int j = 0; j < 4; ++j) {
            const int d0 = 256 * j + 4 * lane;
            const float4 gg = *(const float4*)(gam + d0), bb = *(const float4*)(bet + d0);
#pragma unroll
            for (int u = 0; u < U; ++u) {
                const int tok = t0 + u;
                const float mu = s[u] * (1.f / 1024.f), var = fmaxf(q[u] * (1.f / 1024.f) - mu * mu, 0.f), rstd = rsqrtf(var + 1e-5f);
                float4 y; y.x = (v[u][j].x - mu) * rstd * gg.x + bb.x; y.y = (v[u][j].y - mu) * rstd * gg.y + bb.y; y.z = (v[u][j].z - mu) * rstd * gg.z + bb.z; y.w = (v[u][j].w - mu) * rstd * gg.w + bb.w;
                *(float4*)(XO + (size_t)tok * 1024 + d0) = y;
                u32x2 w; w.x = pack2(y.x, y.y); w.y = pack2(y.z, y.w);
                *(u32x2*)(XB + (size_t)tok * 1024 + d0) = w;
            }
        }
    }
}

#define XB_TMO      128
#define XB_XCNT(j)  (256  + 64 * (j))
#define XB_XSUB(j)  (1280 + 64 * (j))
#define XB_XGEN(j)  (2304 + 64 * (j))
#define XB_TOP      3328
#define XB_TOPGEN   3392
#define XCD_BAR_WORDS 3456
#define XB_SPIN_CAP (1u << 22)
#define LAS __attribute__((address_space(3)))
__device__ __forceinline__ unsigned xb_ld(unsigned* p)              { return __hip_atomic_load(p, __ATOMIC_RELAXED, __HIP_MEMORY_SCOPE_AGENT); }
__device__ __forceinline__ unsigned xb_add(unsigned* p, unsigned v) { return __hip_atomic_fetch_add(p, v, __ATOMIC_RELAXED, __HIP_MEMORY_SCOPE_AGENT); }
__device__ __forceinline__ unsigned xb_xcc_id() { return (unsigned)__builtin_amdgcn_s_getreg((3 << 11) | 20) & 0xFu; }
#define XB_SPIN(cond, bar) do { unsigned _sp = 0; while (cond) { __builtin_amdgcn_s_sleep(1); \
    if ((++_sp & 255u) == 0u) { if (xb_ld(&(bar)[XB_TMO])) break; if (_sp > XB_SPIN_CAP) { atomicAdd(&(bar)[XB_TMO], 1u); break; } } } } while (0)
struct XcdBarrier { unsigned* bar; unsigned x; volatile LAS unsigned* st; };
__device__ __forceinline__ XcdBarrier xcd_barrier_post(unsigned* bar, volatile LAS unsigned* st) {
    XcdBarrier b; b.bar = bar; b.x = xb_xcc_id(); b.st = st;
    if (threadIdx.x == 0) (void)xb_add(&bar[XB_XCNT(b.x)], 1u);
    return b;
}
__device__ __forceinline__ void xcd_barrier_complete(unsigned* bar, unsigned x, unsigned& nloc, unsigned& nx) {
    const unsigned G = gridDim.x * gridDim.y * gridDim.z;
    unsigned sum, cnt, mine, sp = 0u;
    for (;;) {
        sum = 0u; cnt = 0u; mine = 0u;
#pragma unroll
        for (unsigned j = 0; j < 16; ++j) { const unsigned c = xb_ld(&bar[XB_XCNT(j)]); sum += c; cnt += (c > 0u) ? 1u : 0u; mine = (j == x) ? c : mine; }
        if (sum == G) break;
        __builtin_amdgcn_s_sleep(1);
        if ((++sp & 255u) == 0u) { if (xb_ld(&bar[XB_TMO])) break; if (sp > XB_SPIN_CAP) { atomicAdd(&bar[XB_TMO], 1u); break; } }
    }
    nloc = mine > 0u ? mine : 1u; nx = cnt > 0u ? cnt : 1u;
}
__device__ __forceinline__ void xcd_barrier(const XcdBarrier& b) {
    asm volatile("s_waitcnt vmcnt(0)" ::: "memory");
    __syncthreads();
    if (threadIdx.x == 0) {
        unsigned* bar = b.bar;
        __builtin_amdgcn_s_waitcnt(0);
        unsigned nloc = b.st[0], nx = b.st[1];
        if (nloc == 0u) { xcd_barrier_complete(bar, b.x, nloc, nx); b.st[0] = nloc; b.st[1] = nx; }
        const unsigned old = xb_add(&bar[XB_XSUB(b.x)], 1u);
        const unsigned gen = old / nloc;
        if (old + 1u == (gen + 1u) * nloc) {
            __builtin_amdgcn_fence(__ATOMIC_RELEASE, "agent");
            asm volatile("s_waitcnt vmcnt(0)" ::: "memory");
            const unsigned og = xb_add(&bar[XB_TOP], 1u);
            const unsigned tg = og / nx;
            if (og + 1u == (tg + 1u) * nx) xb_add(&bar[XB_TOPGEN], 1u);
            else XB_SPIN(xb_ld(&bar[XB_TOPGEN]) == tg, bar);
            __builtin_amdgcn_fence(__ATOMIC_ACQUIRE, "agent");
            xb_add(&bar[XB_XGEN(b.x)], 1u);
            asm volatile("s_waitcnt vmcnt(0)" ::: "memory");
        } else {
            XB_SPIN(xb_ld(&bar[XB_XGEN(b.x)]) == gen, bar);
            __builtin_amdgcn_fence(__ATOMIC_ACQUIRE, "agent");
            asm volatile("s_waitcnt vmcnt(0)" ::: "memory");
        }
    }
    __syncthreads();
}

constexpr int PH_PER_LAYER = 11, N_PHASES = PH_PER_LAYER * NLAYER;
__global__ void __launch_bounds__(NTHREADS, 2) mega(Params p) {
    extern __shared__ __attribute__((aligned(16))) unsigned char lds[];
#if SINGLE_LAUNCH
    volatile LAS unsigned* xbw = (volatile LAS unsigned*)(lds + LDS_BYTES - 16);
    if (threadIdx.x < 4) xbw[threadIdx.x] = 0u;
    __syncthreads();
    XcdBarrier xbar = xcd_barrier_post((unsigned*)(p.ws + WS_CTL) + CW_BAR, xbw);
#endif
    const int half = __builtin_amdgcn_readfirstlane((int)(threadIdx.x >> 8));
    unsigned char* ldsh = lds + half * HALF_LDS;
    bool second = false;
    for (int ph = p.ph_lo; ph < p.ph_hi; ++ph) {
        const int layer = ph / PH_PER_LAYER, k = ph % PH_PER_LAYER;
        if (k == 0 && layer > 0) continue;
#ifdef ONLY_PHASE
        if (k != ONLY_PHASE) continue;
#endif
        switch (k) {
            case 0: phase_pw(p, layer, ldsh, 15, half); break;
            case 1: phase_g1(p, layer, lds); break;
            case 2: phase_p2(p, layer, ldsh, half); break;
            case 3: phase_p3(p, ldsh, half, second ? ((p.rep_mask >> 16) & 7) : 7); if (!second && layer + 1 < NLAYER) { __syncthreads(); phase_pw(p, layer + 1, ldsh, 1, half); } break;
            case 4: { const int sub = second ? ((p.rep_mask >> 12) & 7) : 7;
                    if ((sub & 4) && layer > 0 && half == 0) { phase_pw(p, layer, ldsh, 4, half); __syncthreads(); }
                    if (sub & 3) phase_p4(p, ldsh, half, sub & 3);
                    if ((sub & 4) && layer > 0 && half == 1) { __syncthreads(); phase_pw(p, layer, ldsh, 4, half); } } break;
            case 5: phase_g2(p, lds); break;
            case 6: phase_g3(p, layer, lds); break;
            case 7: phase_ln1(p, layer, ldsh, ((p.rep_mask >> 7) & 1) && !second, half); if (!second && layer + 1 < NLAYER) { __syncthreads(); phase_pw(p, layer + 1, ldsh, 2, half); } break;
            case 8: phase_m2(p, layer, lds); break;
            case 9: phase_m3(p, layer, lds); break;
            case 10: phase_ln2(p, layer, half); break;
        }

        if (ph + 1 < p.ph_hi) { if (ph == p.ph_lo && !second) cg::this_grid().sync(); else xcd_barrier(xbar); }
        if (((p.rep_mask >> k) & 1) && !second) { second = true; --ph; } else second = false;
    }
}

extern "C" void kernel_launch(void* const* d_in, const int* in_sizes, int n_in, void* d_out, int out_size, void* d_ws, size_t ws_size, hipStream_t stream) {
    static int grid = 0;
    if (grid == 0) {
        if (n_in != 18 || ws_size < WS_END) { fprintf(stderr, "kernel_launch: unexpected n_in %d or ws_size %zu < %zu\n", n_in, ws_size, (size_t)WS_END); grid = -1; return; }
        int dev = 0, cus = 0, per_cu = 0;
        hipGetDevice(&dev); hipDeviceGetAttribute(&cus, hipDeviceAttributeMultiprocessorCount, dev);
        hipFuncSetAttribute((const void*)mega, hipFuncAttributeMaxDynamicSharedMemorySize, LDS_BYTES);
        hipOccupancyMaxActiveBlocksPerMultiprocessor(&per_cu, (const void*)mega, NTHREADS, LDS_BYTES);
        if (per_cu < 1) per_cu = 1;
        if (per_cu > 1) per_cu = 1;
        grid = cus * per_cu;
        (void)hipGetLastError();
    }
    if (grid < 0) return;
    Params p{};
    p.x = (const float*)d_in[0]; p.w_in = (const float*)d_in[1]; p.cmp_pos = (const float*)d_in[2]; p.cmp_w1 = (const float*)d_in[3]; p.cmp_w2 = (const float*)d_in[4];
    p.w_br_a = (const float*)d_in[5]; p.w_br_b = (const float*)d_in[6]; p.w_o = (const float*)d_in[7]; p.ln1_g = (const float*)d_in[8]; p.ln1_b = (const float*)d_in[9];
    p.w_router = (const float*)d_in[10]; p.router_bias = (const float*)d_in[11]; p.w_gate = (const float*)d_in[12]; p.w_up = (const float*)d_in[13]; p.w_down = (const float*)d_in[14];
    p.ln2_g = (const float*)d_in[15]; p.ln2_b = (const float*)d_in[16]; p.rel_bias = (const float*)d_in[17];
    p.out = (float*)d_out; p.ws = (unsigned char*)d_ws; p.rep_mask = REPEAT_MASK;
#if SINGLE_LAUNCH
    hipMemsetAsync((unsigned char*)d_ws + WS_CTL + (size_t)CW_BAR * 4, 0, XCD_BAR_WORDS * 4, stream);
    p.ph_lo = 0; p.ph_hi = N_PHASES;
    void* args[] = {&p};
    hipError_t e = hipLaunchCooperativeKernel((const void*)mega, dim3(grid), dim3(NTHREADS), args, LDS_BYTES, stream);
    if (e != hipSuccess) fprintf(stderr, "cooperative launch failed: %s (grid %d)\n", hipGetErrorString(e), grid);
#else
    for (int ph = 0; ph < N_PHASES; ++ph) {
        p.ph_lo = ph; p.ph_hi = ph + 1;
        hipLaunchKernelGGL(mega, dim3(grid), dim3(NTHREADS), LDS_BYTES, stream, p);
    }
#endif
}
```

```cpp
#include <hip/hip_runtime.h>
#include <hip/hip_cooperative_groups.h>
#include <cstdio>
#include <cstdint>
namespace cg = cooperative_groups;

#ifndef REPEAT_MASK
#define REPEAT_MASK 0
#endif
#ifndef SINGLE_LAUNCH
#define SINGLE_LAUNCH 1
#endif

typedef unsigned short bf16_t;
typedef short bf16x8 __attribute__((ext_vector_type(8)));
typedef float f32x4 __attribute__((ext_vector_type(4)));
typedef unsigned u32x2 __attribute__((ext_vector_type(2)));
typedef unsigned u32x4 __attribute__((ext_vector_type(4)));

constexpr int B_ = 2, S_ = 8192, D_ = 1024, T_ = B_ * S_, NLAYER = 4;
constexpr int DIN = 6424;
constexpr int LD = 5376;
constexpr int NW = 6656;
constexpr int C_QA = 0, C_KC = 512, C_VC = 640, C_KS = 768, C_KW = 896, C_QR = 1024, C_KR = 1536, C_GR = 2048, C_MA = 3072, C_MB = 4096, C_GA = 5120,
              C_VS = 5376, C_VW = 5504, C_VR = 5632;
constexpr float DN_ALPHA = 1.681792830507429f;
constexpr int NE = 16;

constexpr size_t al256(size_t x) { return (x + 255) & ~(size_t)255; }
constexpr size_t WS_CTL = 0;
constexpr size_t WS_BUCKET = 65536;
constexpr size_t WS_ROPE = WS_BUCKET + 8192;
constexpr size_t WS_WIN = WS_ROPE + (size_t)8192 * 32 * 8;
constexpr size_t WS_WA = WS_WIN + (size_t)NW * 1024 * 2;
constexpr size_t WS_WB = WS_WA + (size_t)1024 * 512 * 2;
constexpr size_t WS_WO = WS_WB + (size_t)1024 * 1024 * 2;
constexpr size_t WS_WG = WS_WO + (size_t)1024 * 1024 * 2;
constexpr size_t WS_WU = WS_WG + (size_t)16 * 512 * 1024 * 2;
constexpr size_t WS_WD = WS_WU + (size_t)16 * 512 * 1024 * 2;
constexpr size_t WS_XB = WS_WD + (size_t)16 * 512 * 1024 * 2;
constexpr size_t WS_X = WS_XB + (size_t)T_ * 1024 * 2;
constexpr size_t WS_MG = WS_X + (size_t)T_ * 1024 * 4;
constexpr size_t WS_KCC = WS_MG + (size_t)T_ * 1024 * 2;
constexpr size_t WS_VCCT = WS_KCC + (size_t)4 * 512 * 64 * 2;
constexpr size_t WS_W1T = WS_VCCT + (size_t)4 * 512 * 64 * 2;
constexpr size_t WS_B1 = WS_W1T + (size_t)2 * 64 * 2048 * 2;
constexpr size_t WS_R = WS_B1 + 1024;
constexpr size_t WS_P = WS_R;
constexpr size_t WS_VST = WS_P + (size_t)T_ * LD * 2;
constexpr size_t WS_VWT = WS_VST + (size_t)4 * 64 * S_ * 2;
constexpr size_t WS_VRT = WS_VWT + (size_t)4 * 64 * S_ * 2;
constexpr size_t WS_KVT = WS_VRT + (size_t)16 * 128 * S_ * 2;
constexpr size_t WS_SPT = WS_KVT + (size_t)16 * 64 * 8192 * 4;
constexpr size_t WS_YC = WS_SPT + (size_t)16 * 64 * 8192 * 2;
constexpr size_t WS_YW = WS_YC + (size_t)T_ * 512 * 2;
constexpr size_t WS_YA = WS_YW + (size_t)T_ * 512 * 2;
constexpr size_t WS_YB = WS_YA + (size_t)T_ * 512 * 2;
constexpr size_t WS_SELW = WS_YB + (size_t)T_ * 1024 * 2;
constexpr size_t WS_ENDA = WS_SELW + (size_t)T_ * 2 * 4 * 4;
constexpr size_t WS_H1 = WS_R;
constexpr size_t WS_X1 = WS_H1 + (size_t)T_ * 1024 * 4;
constexpr size_t WS_X1B = WS_X1 + (size_t)T_ * 1024 * 4;
constexpr size_t WS_HB = WS_X1B + (size_t)T_ * 1024 * 2;
constexpr size_t WS_CT = WS_HB + (size_t)2 * T_ * 512 * 2;
constexpr size_t WS_LIST = WS_CT + (size_t)2 * T_ * 1024 * 2;
constexpr size_t WS_WTS = WS_LIST + (size_t)16 * T_ * 4;
constexpr size_t WS_ENDB = WS_WTS + (size_t)2 * T_ * 4;
static_assert(WS_HB + (size_t)2 * T_ * 512 * 2 <= WS_CT, "view B overlap");
constexpr size_t WS_END = WS_ENDA > WS_ENDB ? WS_ENDA : WS_ENDB;

constexpr int CW_CNT = 4096;
constexpr int CW_BAR = 8192;

constexpr int HALF_LDS = 75776, LDS_BYTES = 2 * HALF_LDS + 16;
constexpr int NTHREADS = 512, HT = 256;

struct Params {
    const float* x; const float* w_in; const float* cmp_pos; const float* cmp_w1; const float* cmp_w2;
    const float* w_br_a; const float* w_br_b; const float* w_o; const float* ln1_g; const float* ln1_b;
    const float* w_router; const float* router_bias; const float* w_gate; const float* w_up; const float* w_down;
    const float* ln2_g; const float* ln2_b; const float* rel_bias;
    float* out; unsigned char* ws;
    int ph_lo, ph_hi, rep_mask, pad_;
};

__device__ __forceinline__ bf16_t f2bf(float f) { unsigned u = __float_as_uint(f); u += 0x7fffu + ((u >> 16) & 1u); return (bf16_t)(u >> 16); }
__device__ __forceinline__ float bf2f(unsigned h) { return __uint_as_float(h << 16); }
typedef __bf16 bf16x2_t __attribute__((ext_vector_type(2)));
typedef float f32x2_t __attribute__((ext_vector_type(2)));
__device__ __forceinline__ unsigned pack2(float lo, float hi) { const f32x2_t f = {lo, hi}; return __builtin_bit_cast(unsigned, __builtin_convertvector(f, bf16x2_t)); }
__device__ __forceinline__ u32x2 pack4(f32x4 v) { u32x2 r; r.x = pack2(v[0], v[1]); r.y = pack2(v[2], v[3]); return r; }
__device__ __forceinline__ f32x4 unpack4(u32x2 u) { f32x4 r; r[0] = bf2f(u.x & 0xffffu); r[1] = bf2f(u.x >> 16); r[2] = bf2f(u.y & 0xffffu); r[3] = bf2f(u.y >> 16); return r; }
__device__ __forceinline__ float rows_max(float v) {
    u32x2 r = __builtin_amdgcn_permlane16_swap(__float_as_uint(v), __float_as_uint(v), false, false);
    v = fmaxf(__uint_as_float(r.x), __uint_as_float(r.y));
    r = __builtin_amdgcn_permlane32_swap(__float_as_uint(v), __float_as_uint(v), false, false);
    return fmaxf(__uint_as_float(r.x), __uint_as_float(r.y));
}
__device__ __forceinline__ float rows_sum(float v) {
    u32x2 r = __builtin_amdgcn_permlane16_swap(__float_as_uint(v), __float_as_uint(v), false, false);
    v = __uint_as_float(r.x) + __uint_as_float(r.y);
    r = __builtin_amdgcn_permlane32_swap(__float_as_uint(v), __float_as_uint(v), false, false);
    return __uint_as_float(r.x) + __uint_as_float(r.y);
}
__device__ __forceinline__ float wave_sum(float v) {
    v += __int_as_float(__builtin_amdgcn_ds_swizzle(__float_as_int(v), 0x041F));
    v += __int_as_float(__builtin_amdgcn_ds_swizzle(__float_as_int(v), 0x081F));
    v += __int_as_float(__builtin_amdgcn_ds_swizzle(__float_as_int(v), 0x101F));
    v += __int_as_float(__builtin_amdgcn_ds_swizzle(__float_as_int(v), 0x201F));
    v += __int_as_float(__builtin_amdgcn_ds_swizzle(__float_as_int(v), 0x401F));
    const u32x2 r = __builtin_amdgcn_permlane32_swap(__float_as_uint(v), __float_as_uint(v), false, false);
    return __uint_as_float(r.x) + __uint_as_float(r.y);
}
__device__ __forceinline__ float sigmoidf_(float x) { return 1.f / (1.f + __expf(-x)); }
__device__ __forceinline__ int ltid() { int t = threadIdx.x; asm volatile("" : "+v"(t)); return t; }
__device__ __forceinline__ int vzero() { int z; asm volatile("v_mov_b32 %0, 0" : "=v"(z)); return z; }
__device__ __forceinline__ unsigned char* launder(unsigned char* q) { asm volatile("" : "+s"(q)); return q; }
__device__ __forceinline__ void wait_vm0() { asm volatile("s_waitcnt vmcnt(0)" ::: "memory"); }

__device__ __forceinline__ void glds16(const void* g, void* l) {
    __builtin_amdgcn_global_load_lds((const __attribute__((address_space(1))) unsigned*)g,
                                     (__attribute__((address_space(3))) unsigned*)l, 16, 0, 0);
}
__device__ __forceinline__ f32x4 mfma16(bf16x8 a, bf16x8 b, f32x4 c) { return __builtin_amdgcn_mfma_f32_16x16x32_bf16(a, b, c, 0, 0, 0); }

#define WAIT_V(n) asm volatile("s_waitcnt vmcnt(%0)" ::"n"(n) : "memory")
#define RAW_BARRIER() do { asm volatile("s_waitcnt lgkmcnt(0)" ::: "memory"); __builtin_amdgcn_s_barrier(); } while (0)
__device__ __forceinline__ void bglds16(__amdgpu_buffer_rsrc_t r, unsigned voff, int soff, void* l) {
    __builtin_amdgcn_raw_ptr_buffer_load_lds(r, (__attribute__((address_space(3))) void*)l, 16, (int)voff, soff, 0, 0);
}
template <int NJ, bool GN>
__device__ __forceinline__ void gemm8_stage(__amdgpu_buffer_rsrc_t mr, int mld, unsigned mvo, __amdgpu_buffer_rsrc_t nr, int nld, const unsigned (&nvo)[NJ], int kt, unsigned char* st, int wid) {
#pragma unroll
    for (int i = 0; i < 4; ++i) bglds16(mr, mvo, (64 * i * mld + kt * 64) * 2, st + (8 * i + wid) * 1024);
#pragma unroll
    for (int i = 0; i < NJ; ++i) bglds16(nr, nvo[i], ((GN ? 0 : 64 * i * nld) + kt * 64) * 2, st + 32768 + (8 * i + wid) * 1024);
}
template <int NJ, bool GN>
__device__ __forceinline__ void gemm8_kloop(const bf16_t* mb, int mld, unsigned mvo, const bf16_t* nb, int nld, const unsigned (&nvo)[NJ], int nk, unsigned char* lds, f32x4 (&acc)[8][NJ], int tid) {
    const int lane = tid & 63, wid = tid >> 6, wr = wid >> 2, wc = wid & 3, fr = lane & 15, fq = lane >> 4;
    const __amdgpu_buffer_rsrc_t mr = __builtin_amdgcn_make_buffer_rsrc((void*)mb, 0, 0x7fffffff, 0x00020000);
    const __amdgpu_buffer_rsrc_t nr = __builtin_amdgcn_make_buffer_rsrc((void*)nb, 0, 0x7fffffff, 0x00020000);
    gemm8_stage<NJ, GN>(mr, mld, mvo, nr, nld, nvo, 0, lds, wid);
    gemm8_stage<NJ, GN>(mr, mld, mvo, nr, nld, nvo, 1, lds + 65536, wid);
    for (int kt = 0; kt < nk; ++kt) {
        unsigned char* cur = lds + (kt & 1) * 65536;
        if (kt + 1 < nk) WAIT_V(4 + NJ); else WAIT_V(0);
        RAW_BARRIER();
        bf16x8 a[4], b[NJ];
        const unsigned char* ab = cur + (128 * wr + fr) * 128;
        const unsigned char* bb = cur + 32768 + (16 * NJ * wc + fr) * 128;
        const int sw0 = ((fq) ^ (fr & 7)) << 4, sw1 = ((4 + fq) ^ (fr & 7)) << 4;
#pragma unroll
        for (int j = 0; j < NJ; ++j) b[j] = *(const bf16x8*)(bb + j * 2048 + sw0);
#pragma unroll
        for (int mh = 0; mh < 2; ++mh) {
#pragma unroll
            for (int i = 0; i < 4; ++i) a[i] = *(const bf16x8*)(ab + (4 * mh + i) * 2048 + sw0);
#pragma unroll
            for (int i = 0; i < 4; ++i)
#pragma unroll
                for (int j = 0; j < NJ; ++j) acc[4 * mh + i][j] = mfma16(a[i], b[j], acc[4 * mh + i][j]);
        }
#pragma unroll
        for (int j = 0; j < NJ; ++j) b[j] = *(const bf16x8*)(bb + j * 2048 + sw1);
#pragma unroll
        for (int i = 0; i < 4; ++i) a[i] = *(const bf16x8*)(ab + i * 2048 + sw1);
#pragma unroll
        for (int i = 0; i < 4; ++i)
#pragma unroll
            for (int j = 0; j < NJ; ++j) acc[i][j] = mfma16(a[i], b[j], acc[i][j]);
#pragma unroll
        for (int i = 0; i < 4; ++i) a[i] = *(const bf16x8*)(ab + (4 + i) * 2048 + sw1);
        RAW_BARRIER();
        if (kt + 2 < nk) gemm8_stage<NJ, GN>(mr, mld, mvo, nr, nld, nvo, kt + 2, cur, wid);
#pragma unroll
        for (int i = 0; i < 4; ++i)
#pragma unroll
            for (int j = 0; j < NJ; ++j) acc[4 + i][j] = mfma16(a[i], b[j], acc[4 + i][j]);
    }
    __syncthreads();
    __builtin_amdgcn_sched_barrier(0);
}
template <int NJ>
__device__ __forceinline__ void zero_acc8(f32x4 (&acc)[8][NJ]) {
#pragma unroll
    for (int i = 0; i < 8; ++i)
#pragma unroll
        for (int j = 0; j < NJ; ++j) acc[i][j] = (f32x4){0.f, 0.f, 0.f, 0.f};
}

namespace pg8 {
#define PG8_LAS __attribute__((address_space(3)))
constexpr int BM = 256, BK = 64, HALF = 128, HTB = HALF * BK * 2, STAGE_BYTES = 8 * HTB;
__device__ __forceinline__ int lds_byte(int r, int c) { const int st = (r >> 4) * 2 + (c >> 5), rr = r & 15, cc = c & 31, ob = rr * 64 + cc * 2; return st * 1024 + (ob ^ (((ob >> 9) & 1) << 5)); }
__device__ __forceinline__ void stage_rc(int b, int& R, int& C) { const int st = b / 1024, sb = b % 1024, swz = sb ^ (((sb >> 9) & 1) << 5); R = (st >> 1) * 16 + swz / 64; C = (st & 1) * 32 + (swz % 64) / 2; }
__device__ __forceinline__ int perm32(int rho) { const int n = rho >> 4, i = rho & 15; return 8 * (i >> 2) + 4 * n + (i & 3); }
struct Unit { int pm, pn; };
template <class Epi, class Sched>
__device__ __forceinline__ void gemm_phase(unsigned char* lds_, const int K, const Sched& S, const Epi& E, const int tid, const unsigned char* wsbase) {
    PG8_LAS unsigned char* lds = (PG8_LAS unsigned char*)lds_;
    const int wid = __builtin_amdgcn_readfirstlane(tid >> 6), lane = tid & 63, wr = wid >> 2, wc = wid & 3, fr = lane & 15, fq = lane >> 4;
    const int nt = K / BK;
    unsigned voffA[2], voffB[2];
#pragma unroll
    for (int i = 0; i < 2; ++i) { int R, C; stage_rc(tid * 16 + i * 8192, R, C); const int Rb = (R & ~31) + perm32(R & 31);
        voffA[i] = (unsigned)(R * K + C) * 2u; voffB[i] = (unsigned)(Rb * K + C) * 2u; }
    const unsigned kstep = (unsigned)(BK * 2);
    const unsigned hstep = (unsigned)HALF * K * 2;
    const __amdgpu_buffer_rsrc_t rsrc = __builtin_amdgcn_make_buffer_rsrc((void*)wsbase, 0, 0x7fffffff, 0x00020000);
    const unsigned ldsw = (unsigned)wid * 1024u;
    const int aoff = lds_byte(wr * 64 + fr, fq * 8), boff = lds_byte(wc * 32 + fr, fq * 8);
#define PG8_SA(b, h) (((b) * 2 + (h)) * HTB)
#define PG8_SB(b, h) ((4 + (b) * 2 + (h)) * HTB)
#define PG8_STAGE(bufoff, gbase, voff) do { _Pragma("unroll") for (int _i = 0; _i < 2; ++_i) \
        __builtin_amdgcn_raw_ptr_buffer_load_lds(rsrc, (PG8_LAS void*)(lds + (bufoff) + ldsw + _i * 8192), 16, (int)(voff)[_i], (int)(gbase), 0, 0); } while (0)
#define PG8_LDA(dst, b, h) do { _Pragma("unroll") for (int m = 0; m < 4; ++m) _Pragma("unroll") for (int k = 0; k < 2; ++k) dst[m][k] = *(const PG8_LAS bf16x8*)(lds + PG8_SA(b, h) + aoff + m * 2048 + k * 1024); } while (0)
#define PG8_LDB(dst, b, h) do { _Pragma("unroll") for (int n = 0; n < 2; ++n) _Pragma("unroll") for (int k = 0; k < 2; ++k) dst[n][k] = *(const PG8_LAS bf16x8*)(lds + PG8_SB(b, h) + boff + n * 2048 + k * 1024); } while (0)
#define PG8_MMA(ai, bj, At, Bt) do { __builtin_amdgcn_s_setprio(1); _Pragma("unroll") for (int m = 0; m < 4; ++m) _Pragma("unroll") for (int n = 0; n < 2; ++n) _Pragma("unroll") for (int k = 0; k < 2; ++k) \
        acc[ai][bj][m][n] = __builtin_amdgcn_mfma_f32_16x16x32_bf16(Bt[n][k], At[m][k], acc[ai][bj][m][n], 0, 0, 0); __builtin_amdgcn_s_setprio(0); } while (0)
#define PG8_WAIT_V(n) asm volatile("s_waitcnt vmcnt(" #n ")" ::: "memory")
#define PG8_WAIT_L(n) asm volatile("s_waitcnt lgkmcnt(" #n ")" ::: "memory")
#define PG8_BAR __builtin_amdgcn_s_barrier()
#define PG8_SCHED __builtin_amdgcn_sched_barrier(0)
    typename Sched::U cur, nxt; int ui = 0;
    if (!S.next(0, cur)) return;
    unsigned cA, cB; S.ptrs(cur, cA, cB);
    constexpr bool GA = Sched::GATHER;
    unsigned vA[GA ? 2 : 1][2], nvA[GA ? 2 : 1][2];
    if constexpr (GA) { S.rows(cur, tid, vA);
#pragma unroll
        for (int h = 0; h < 2; ++h)
#pragma unroll
            for (int i = 0; i < 2; ++i) nvA[h][i] = vA[h][i]; }
#define PG8_STAGE_A(bufoff, gbase, h, nextu) do { if constexpr (GA) { if (nextu) PG8_STAGE(bufoff, gbase, nvA[h]); else PG8_STAGE(bufoff, gbase, vA[h]); } \
        else PG8_STAGE(bufoff, (gbase) + (h) * hstep, voffA); } while (0)
    PG8_STAGE(PG8_SB(0, 0), cB, voffB); PG8_STAGE_A(PG8_SA(0, 0), cA, 0, false); PG8_STAGE(PG8_SB(0, 1), cB + hstep, voffB); PG8_STAGE_A(PG8_SA(0, 1), cA, 1, false);
    if (wr == 1) PG8_BAR;
    PG8_WAIT_V(4); PG8_BAR;
    PG8_STAGE(PG8_SB(1, 0), cB + kstep, voffB); PG8_STAGE_A(PG8_SA(1, 0), cA + kstep, 0, false); PG8_STAGE(PG8_SB(1, 1), cB + hstep + kstep, voffB);
    PG8_WAIT_V(6); PG8_BAR;
    PG8_SCHED;
    f32x4 acc[2][2][4][2];
#pragma unroll
    for (int a = 0; a < 2; ++a)
#pragma unroll
        for (int b = 0; b < 2; ++b)
#pragma unroll
            for (int m = 0; m < 4; ++m)
#pragma unroll
                for (int n = 0; n < 2; ++n) acc[a][b][m][n] = (f32x4){0.f, 0.f, 0.f, 0.f};
    bf16x8 At[4][2], B0[2][2], B1[2][2];
    for (;;) {
        const bool has_next = S.next(ui + 1, nxt);
        unsigned nA = cA, nB = cB; if (has_next) S.ptrs(nxt, nA, nB);
        if constexpr (GA) { if (has_next) S.rows(nxt, tid, nvA); }
        for (int t = 0; t < nt; t += 2) {
            const bool last = (t == nt - 2);
            const unsigned a1 = cA + (unsigned)(t + 1) * kstep;
            const unsigned a2 = last ? nA : cA + (unsigned)(t + 2) * kstep, b2 = last ? nB : cB + (unsigned)(t + 2) * kstep;
            const unsigned a3 = a2 + kstep, b3 = b2 + kstep;
            PG8_LDB(B0, 0, 0); PG8_SCHED; PG8_LDA(At, 0, 0); PG8_STAGE_A(PG8_SA(1, 1), a1, 1, false);
            PG8_WAIT_L(8); PG8_BAR; PG8_WAIT_L(0); PG8_MMA(0, 0, At, B0); PG8_BAR; PG8_SCHED;
            PG8_LDB(B1, 0, 1); PG8_STAGE(PG8_SB(0, 0), b2, voffB);
            PG8_BAR; PG8_WAIT_L(0); PG8_MMA(0, 1, At, B1); PG8_BAR;
            PG8_LDA(At, 0, 1); PG8_STAGE_A(PG8_SA(0, 0), a2, 0, last);
            PG8_BAR; PG8_WAIT_L(0); PG8_MMA(1, 0, At, B0); PG8_BAR; PG8_SCHED;
            PG8_STAGE(PG8_SB(0, 1), b2 + hstep, voffB);
            PG8_WAIT_V(6); PG8_BAR; PG8_MMA(1, 1, At, B1); PG8_BAR;
            PG8_LDB(B0, 1, 0); PG8_SCHED; PG8_LDA(At, 1, 0); PG8_STAGE_A(PG8_SA(0, 1), a2, 1, last);
            PG8_WAIT_L(8); PG8_BAR; PG8_WAIT_L(0); PG8_MMA(0, 0, At, B0); PG8_BAR; PG8_SCHED;
            PG8_LDB(B1, 1, 1); PG8_STAGE(PG8_SB(1, 0), b3, voffB);
            PG8_BAR; PG8_WAIT_L(0); PG8_MMA(0, 1, At, B1); PG8_BAR;
            PG8_LDA(At, 1, 1); PG8_STAGE_A(PG8_SA(1, 0), a3, 0, last);
            PG8_BAR; PG8_WAIT_L(0); PG8_MMA(1, 0, At, B0); PG8_BAR; PG8_SCHED;
            PG8_STAGE(PG8_SB(1, 1), b3 + hstep, voffB);
            PG8_WAIT_V(6); PG8_BAR; PG8_MMA(1, 1, At, B1); PG8_BAR;
        }
        E(acc, cur, wr, wc, fr, fq);
        if (!has_next) break;
#pragma unroll
        for (int a = 0; a < 2; ++a)
#pragma unroll
            for (int b = 0; b < 2; ++b)
#pragma unroll
                for (int m = 0; m < 4; ++m)
#pragma unroll
                    for (int n = 0; n < 2; ++n) acc[a][b][m][n] = (f32x4){0.f, 0.f, 0.f, 0.f};
        cur = nxt; cA = nA; cB = nB; ++ui;
        if constexpr (GA) {
#pragma unroll
            for (int h = 0; h < 2; ++h)
#pragma unroll
                for (int i = 0; i < 2; ++i) vA[h][i] = nvA[h][i]; }
    }
    PG8_WAIT_V(0);
    if (wr == 0) PG8_BAR;
    PG8_BAR;
#undef PG8_SA
#undef PG8_SB
#undef PG8_STAGE
#undef PG8_STAGE_A
#undef PG8_LDA
#undef PG8_LDB
#undef PG8_MMA
#undef PG8_WAIT_V
#undef PG8_WAIT_L
#undef PG8_BAR
#undef PG8_SCHED
}
}

struct TJob { const float* src; bf16_t* dst; int ld, k0, n0, mode, kdst; };
__device__ __forceinline__ void tcvt_load(const TJob& J, float4 (&v)[4], int tid) {
#pragma unroll
    for (int i = 0; i < 4; ++i) {
        const int kk = (tid >> 4) + 16 * i, c4 = (tid & 15) * 4, cd = J.n0 + c4;
        int orig = cd; bool ok = true;
        if (J.mode == 1) {
            if (cd < 896) orig = cd;
            else if (cd < 1024) orig = cd - 896 + 1024;
            else if (cd < 2048) { const int q = cd - 1024, hd = q >> 6, pp = q & 63;
                const int d = (pp & 4) ? 32 + 4 * (pp >> 3) + (pp & 3) : 4 * (pp >> 3) + (pp & 3);
                orig = 1304 + hd * 64 + d; }
            else if (cd < 5120) orig = cd - 2048 + 3352;
            else if (cd < 5144) orig = cd - 5120 + 1280;
            else if (cd < 5376) ok = false;
            else if (cd < 5504) orig = cd - 5376 + 896;
            else if (cd < 5632) orig = cd - 5504 + 1152;
            else orig = cd - 5632 + 2328;
        }
        v[i] = make_float4(0.f, 0.f, 0.f, 0.f);
        if (ok) v[i] = *(const float4*)(J.src + (size_t)(J.k0 + kk) * J.ld + orig);
    }
}
__device__ __forceinline__ void tcvt_finish(const TJob& J, const float4 (&v)[4], unsigned char* lds, int tid) {
    float* tile = (float*)lds;
#pragma unroll
    for (int i = 0; i < 4; ++i) {
        const int kk = (tid >> 4) + 16 * i, c4 = (tid & 15) * 4;
        tile[kk * 65 + c4 + 0] = v[i].x; tile[kk * 65 + c4 + 1] = v[i].y; tile[kk * 65 + c4 + 2] = v[i].z; tile[kk * 65 + c4 + 3] = v[i].w;
    }
    __syncthreads();
#pragma unroll
    for (int i = 0; i < 2; ++i) {
        const int q = tid + 256 * i, n = q >> 3, kc = q & 7;
        float x[8];
#pragma unroll
        for (int j = 0; j < 8; ++j) x[j] = tile[(kc * 8 + j) * 65 + n];
        u32x4 w; w.x = pack2(x[0], x[1]); w.y = pack2(x[2], x[3]); w.z = pack2(x[4], x[5]); w.w = pack2(x[6], x[7]);
        int drow = J.n0 + n; if (J.mode >= 2) drow = 8 * (drow >> 2) + (drow & 3) + (J.mode == 3 ? 4 : 0);
        *(u32x4*)(J.dst + (size_t)drow * J.kdst + J.k0 + kc * 8) = w;
    }
    __syncthreads();
}
__device__ __forceinline__ void tcvt_tile(const float* src, int ld_src, int k0, int n0, int mode, bf16_t* dst, int kdst, unsigned char* lds, int half) {
    TJob J; J.src = src; J.dst = dst; J.ld = ld_src; J.k0 = k0; J.n0 = n0; J.mode = mode; J.kdst = kdst;
    const int tid = (ltid() & 255); float4 v[4];
    tcvt_load(J, v, tid); tcvt_finish(J, v, lds, tid);
}

__device__ __forceinline__ void tcvt_decode(const Params& p, unsigned char* ws, int layer, int t, TJob& J) {
    constexpr int J0 = 16 * 104, J1 = 8 * 16, J2 = 256, J3 = 256, J4 = 2048, J5 = 2048;
    int u = t;
        if (u < J0) { J.src = p.w_in + (size_t)layer * 1024 * DIN; J.ld = DIN; J.k0 = (u % 16) * 64; J.n0 = (u / 16) * 64; J.mode = 1; J.dst = (bf16_t*)(ws + WS_WIN); J.kdst = 1024; return; }
        u -= J0;
        if (u < J1) { J.src = p.w_br_a + (size_t)layer * 512 * 1024; J.ld = 1024; J.k0 = (u % 8) * 64; J.n0 = (u / 8) * 64; J.mode = 0; J.dst = (bf16_t*)(ws + WS_WA); J.kdst = 512; return; }
        u -= J1;
        if (u < J2) { J.src = p.w_br_b + (size_t)layer * 1024 * 1024; J.ld = 1024; J.k0 = (u % 16) * 64; J.n0 = (u / 16) * 64; J.mode = 0; J.dst = (bf16_t*)(ws + WS_WB); J.kdst = 1024; return; }
        u -= J2;
        if (u < J3) { J.src = p.w_o + (size_t)layer * 1024 * 1024; J.ld = 1024; J.k0 = (u % 16) * 64; J.n0 = (u / 16) * 64; J.mode = 0; J.dst = (bf16_t*)(ws + WS_WO); J.kdst = 1024; return; }
        u -= J3;
        if (u < J4 + J5) {
            const bool up = u >= J4; if (up) u -= J4;
            const int e = u / 128, v = u % 128;
            J.src = (up ? p.w_up : p.w_gate) + ((size_t)layer * NE + e) * 1024 * 512; J.ld = 512; J.k0 = (v % 16) * 64; J.n0 = (v / 16) * 64; J.mode = up ? 3 : 2;
            J.dst = (bf16_t*)(ws + WS_WG) + (size_t)e * 1024 * 1024; J.kdst = 1024; return;
        }
        u -= J4 + J5;
        { const int e = u / 128, v = u % 128;
          J.src = p.w_down + ((size_t)layer * NE + e) * 512 * 1024; J.ld = 1024; J.k0 = (v % 8) * 64; J.n0 = (v / 8) * 64; J.mode = 0; J.dst = (bf16_t*)(ws + WS_WD) + (size_t)e * 1024 * 512; J.kdst = 512; }
}


__device__ __forceinline__ void phase_pw(const Params& p, int layer, unsigned char* lds, int parts, int half) {
    const int bid = (blockIdx.x * 2 + half), nblk = (gridDim.x * 2), tid = (ltid() & 255);
    unsigned char* ws = launder(p.ws);
    constexpr int J0 = 16 * 104, J1 = 8 * 16, J2 = 256, J3 = 256, J4 = 2048, J5 = 2048, J6 = 2048, JT = J0 + J1 + J2 + J3 + J4 + J5 + J6;
    const int t_lo = (parts & 1) ? 0 : (parts & 2) ? J0 : J0 + J1 + J2 + J3;
    const int t_hi = (parts & 4) ? JT : (parts & 2) ? J0 + J1 + J2 + J3 : (parts & 1) ? J0 : 0;
    if (t_lo + bid < t_hi) {
        float4 v[4]; { TJob J; tcvt_decode(p, ws, layer, t_lo + bid, J); tcvt_load(J, v, tid); }
        for (int t = t_lo + bid; t < t_hi; t += nblk) {
            float4 vn[4];
            if (t + nblk < t_hi) { TJob J; tcvt_decode(p, ws, layer, t + nblk, J); tcvt_load(J, vn, tid); }
            { TJob J; tcvt_decode(p, ws, layer, t, J); tcvt_finish(J, v, lds, tid); }
#pragma unroll
            for (int i = 0; i < 4; ++i) v[i] = vn[i];
        }
    }
    if (parts & 1) {
    for (int t = bid; t < 64; t += nblk) {
        const int kv = t >> 5, kt = t & 31;
        tcvt_tile(p.cmp_w1 + ((size_t)layer * 2 + kv) * 2048 * 64, 64, kt * 64, 0, 0, (bf16_t*)(ws + WS_W1T) + (size_t)kv * 64 * 2048, 2048, lds, half);
    }
    if (bid >= nblk - 2) {
        const int kv = nblk - 1 - bid, n = tid & 63, part = tid >> 6;
        const float* w1 = p.cmp_w1 + ((size_t)layer * 2 + kv) * 2048 * 64; const float* pos = p.cmp_pos + ((size_t)layer * 2 + kv) * 2048;
        float a = 0.f;
        for (int k = part * 512; k < part * 512 + 512; ++k) a += pos[k] * w1[(size_t)k * 64 + n];
        float* red = (float*)lds;
        __syncthreads(); red[tid] = a; __syncthreads();
        if (tid < 64) ((float*)(ws + WS_B1))[kv * 64 + tid] = red[tid] + red[tid + 64] + red[tid + 128] + red[tid + 192];
        __syncthreads();
    }
    }
    if (parts & 8) {
        const float4* xs = (const float4*)p.x; u32x2* xb = (u32x2*)(ws + WS_XB);
        for (size_t i = (size_t)bid * HT + tid; i < (size_t)T_ * 1024 / 4; i += (size_t)nblk * HT) {
            float4 v = xs[i]; u32x2 w; w.x = pack2(v.x, v.y); w.y = pack2(v.z, v.w); xb[i] = w;
        }
        for (int n = bid * HT + tid; n < 8192; n += nblk * HT) {
            int bk;
            if (n < 16) bk = n;
            else { const int th[15] = {22, 30, 40, 54, 73, 99, 134, 182, 246, 332, 450, 609, 825, 1117, 1513}; bk = 16;
#pragma unroll
                for (int k = 0; k < 15; ++k) bk += (n >= th[k]) ? 1 : 0; }
            (ws + WS_BUCKET)[n] = (unsigned char)bk;
        }
        for (int i = bid * HT + tid; i < 8192 * 32; i += nblk * HT) {
            const int pos = i >> 5, d = i & 31;
            const float inv = powf(10000.f, -(float)d * 2.0f / 64.f);
            const float ang = (float)pos * inv;
            float sn, cs; sincosf(ang, &sn, &cs);
            ((float2*)(ws + WS_ROPE))[i] = make_float2(cs, sn);
        }
        if (bid == 0) for (int i = tid; i < 8192; i += HT) ((unsigned*)(ws + WS_CTL))[i] = 0u;
    }
}

__device__ __forceinline__ float fsig(float x) { return __builtin_amdgcn_rcpf(1.f + __builtin_amdgcn_exp2f(-1.4426950408889634f * x)); }
template <int KIND>
__device__ __forceinline__ void g1_epi(const f32x4 (&acc)[2][2][4][2], unsigned char* ws, int r0, int c0, int wr, int wc, int fr, int fq) {
#pragma unroll
    for (int ai = 0; ai < 2; ++ai)
#pragma unroll
        for (int m = 0; m < 4; ++m) {
            const int row = r0 + 128 * ai + 64 * wr + 16 * m + fr + vzero();
#pragma unroll
            for (int bj = 0; bj < 2; ++bj) {
                const int col = c0 + 128 * bj + 32 * wc + 8 * fq;
                f32x4 v0 = acc[ai][bj][m][0], v1 = acc[ai][bj][m][1];
                if (KIND == 5) {
                    const int b = col >> 13, sq = col & (S_ - 1);
                    bf16_t* dst;
                    if (row < C_VW) { const int c = row - C_VS; dst = (bf16_t*)(ws + WS_VST) + ((size_t)(b * 2 + (c >> 6)) * 64 + (c & 63)) * S_ + sq; }
                    else if (row < C_VR) { const int c = row - C_VW; dst = (bf16_t*)(ws + WS_VWT) + ((size_t)(b * 2 + (c >> 6)) * 64 + (c & 63)) * S_ + sq; }
                    else { const int c = row - C_VR; dst = (bf16_t*)(ws + WS_VRT) + ((size_t)(b * 8 + (c >> 7)) * 128 + (c & 127)) * S_ + sq; }
                    u32x4 w; w.x = pack2(v0[0], v0[1]); w.y = pack2(v0[2], v0[3]); w.z = pack2(v1[0], v1[1]); w.w = pack2(v1[2], v1[3]);
                    *(u32x4*)dst = w;
                    continue;
                }
                if (KIND == 1 || KIND == 2) {
                    const float2* rope = (const float2*)(ws + WS_ROPE);
                    const int pos = row & (S_ - 1), d = 16 * (wc & 1) + 4 * fq;
                    const float4 cs01 = *(const float4*)(rope + pos * 32 + d), cs23 = *(const float4*)(rope + pos * 32 + d + 2);
                    const float c[4] = {cs01.x, cs01.z, cs23.x, cs23.z}, sn[4] = {cs01.y, cs01.w, cs23.y, cs23.w};
                    const float sc = (KIND == 2) ? 0.125f : 1.0f;
                    f32x4 y1, y2;
#pragma unroll
                    for (int r = 0; r < 4; ++r) { y1[r] = (v0[r] * c[r] - v1[r] * sn[r]) * sc; y2[r] = (v0[r] * sn[r] + v1[r] * c[r]) * sc; }
                    v0 = y1; v1 = y2;
                } else if (KIND == 3) {
#pragma unroll
                    for (int r = 0; r < 4; ++r) { v0[r] = v0[r] * fsig(v0[r]); v1[r] = v1[r] * fsig(v1[r]); }
                } else if (KIND == 4) {
#pragma unroll
                    for (int r = 0; r < 4; ++r) { v0[r] = fsig(v0[r]); v1[r] = fsig(v1[r]); }
                }
                u32x4 w; w.x = pack2(v0[0], v0[1]); w.y = pack2(v0[2], v0[3]); w.z = pack2(v1[0], v1[1]); w.w = pack2(v1[2], v1[3]);
                *(u32x4*)((bf16_t*)(ws + WS_P) + (size_t)row * LD + col) = w;
            }
        }
}
struct G1Order {      typedef pg8::Unit U; static constexpr bool GATHER = false;
    int xcd, slot, per;
    __device__ __forceinline__ bool next(int i, pg8::Unit& u) const {
        const int j = slot + i * per; if (j >= 208) return false;
        if (j < 192) { u.pm = j / 3; u.pn = xcd + 8 * (j % 3); } else { const int q = j - 192; u.pm = 8 * xcd + (q >> 1); u.pn = 24 + (q & 1); }
        return true;
    }
    __device__ __forceinline__ void ptrs(const pg8::Unit& u, unsigned& A, unsigned& B) const {
        const unsigned x = (unsigned)WS_XB + (unsigned)u.pm * (256u * 1024u * 2u), w = (unsigned)WS_WIN + (unsigned)u.pn * (256u * 1024u * 2u);
        if (u.pn >= 21) { A = w; B = x; } else { A = x; B = w; }
    }
};
struct G1Epi {
    unsigned char* ws;
    __device__ __forceinline__ void operator()(const f32x4 (&acc)[2][2][4][2], const pg8::Unit& u, int wr, int wc, int fr, int fq) const {
        const int pn = u.pn, tok0 = u.pm * 256, n0 = pn * 256;
        if (pn >= 21) g1_epi<5>(acc, ws, n0, tok0, wr, wc, fr, fq);
        else if (pn >= 12) g1_epi<4>(acc, ws, tok0, n0, wr, wc, fr, fq);
        else if (pn >= 8) g1_epi<3>(acc, ws, tok0, n0, wr, wc, fr, fq);
        else if (pn >= 6) g1_epi<2>(acc, ws, tok0, n0, wr, wc, fr, fq);
        else if (pn >= 4) g1_epi<1>(acc, ws, tok0, n0, wr, wc, fr, fq);
        else g1_epi<0>(acc, ws, tok0, n0, wr, wc, fr, fq);
    }
};
__device__ __forceinline__ void phase_g1(const Params& p, int layer, unsigned char* lds) {
    unsigned char* ws = launder(p.ws);
    G1Order S; S.xcd = blockIdx.x & 7; S.slot = blockIdx.x >> 3; S.per = gridDim.x >> 3;
    G1Epi E; E.ws = ws;
    pg8::gemm_phase<G1Epi, G1Order>(lds, 1024, S, E, ltid(), ws);
}

__device__ __forceinline__ void load_tile64(const bf16_t* base, size_t rowStride, unsigned char* dst, int wid, int lane) {
    const int c = ((lane & 7) ^ (lane >> 3)) * 8;
#pragma unroll
    for (int i = 0; i < 2; ++i) { const int j = wid + 4 * i, row = 8 * j + (lane >> 3); glds16(base + (size_t)row * rowStride + c, dst + j * 1024); }
}
__device__ __forceinline__ void load_tile128(const bf16_t* base, size_t rowStride, unsigned char* dst, int wid, int lane) {
    const int c = ((lane & 7) ^ (lane >> 3)) * 8;
#pragma unroll
    for (int i = 0; i < 4; ++i) { const int j = wid + 4 * i, row = 8 * j + (lane >> 3); glds16(base + (size_t)row * rowStride + c, dst + j * 1024); }
}
__device__ __forceinline__ void load_tile128w(const bf16_t* base, size_t rowStride, unsigned char* dst, int wid, int lane) {
    const int c = ((lane & 15) ^ ((4 * wid + (lane >> 4)) & 15)) * 8;
#pragma unroll
    for (int i = 0; i < 8; ++i) { const int j = wid + 4 * i, row = 4 * j + (lane >> 4); glds16(base + (size_t)row * rowStride + c, dst + j * 1024); }
}
__device__ __forceinline__ bf16x8 lds_frag128(const unsigned char* tile, int row, int chunk) {
    return *(const bf16x8*)(tile + row * 128 + ((chunk ^ (row & 7)) << 4));
}
__device__ __forceinline__ bf16x8 lds_frag256(const unsigned char* tile, int row, int chunk) {
    return *(const bf16x8*)(tile + row * 256 + ((chunk ^ (row & 15)) << 4));
}
__device__ __forceinline__ bf16x8 lds_vfrag128(const unsigned char* tile, int row, int kbase, int fq) {
    const int ca = (kbase >> 3) + (fq >> 1), hb = (fq & 1) * 8;
    const u32x2 a = *(const u32x2*)(tile + row * 128 + ((ca ^ (row & 7)) << 4) + hb);
    const u32x2 b = *(const u32x2*)(tile + row * 128 + (((ca + 2) ^ (row & 7)) << 4) + hb);
    u32x4 w; w.x = a.x; w.y = a.y; w.z = b.x; w.w = b.y;
    return __builtin_bit_cast(bf16x8, w);
}
__device__ __forceinline__ bf16x8 lds_vfrag256(const unsigned char* tile, int row, int kbase, int fq) {
    const int ca = (kbase >> 3) + (fq >> 1), hb = (fq & 1) * 8;
    const u32x2 a = *(const u32x2*)(tile + row * 256 + ((ca ^ (row & 15)) << 4) + hb);
    const u32x2 b = *(const u32x2*)(tile + row * 256 + (((ca + 2) ^ (row & 15)) << 4) + hb);
    u32x4 w; w.x = a.x; w.y = a.y; w.z = b.x; w.w = b.y;
    return __builtin_bit_cast(bf16x8, w);
}
__device__ __forceinline__ bf16x8 pack8(f32x4 a, f32x4 b) {
    u32x4 w; w.x = pack2(a[0], a[1]); w.y = pack2(a[2], a[3]); w.z = pack2(b[0], b[1]); w.w = pack2(b[2], b[3]);
    return __builtin_bit_cast(bf16x8, w);
}

__device__ __forceinline__ float gelu_tanh(float x) {
    const float u = 0.7978845608028654f * (x + 0.044715f * x * x * x);
    return 0.5f * x * (1.f + tanhf(u));
}
__device__ __forceinline__ void compress_item(const Params& p, int layer, int item, unsigned char* lds, int half) {
    unsigned char* ws = launder(p.ws);
    const int tid = (ltid() & 255), lane = tid & 63, wid = tid >> 6, wr = wid >> 1, wc = wid & 1, fr = lane & 15, fq = lane >> 4;
    const int mtile = item & 3, g = (item >> 2) & 1, b = (item >> 3) & 1, kv = item >> 4;
    const int i0 = mtile * 128;
    const bf16_t* P = (const bf16_t*)(ws + WS_P);
    const bf16_t* W1T = (const bf16_t*)(ws + WS_W1T) + (size_t)kv * 64 * 2048;
    const int col = (kv ? C_VC : C_KC) + g * 64;
    const int ldc = ((lane & 7) ^ (lane >> 3)) * 8;
    const bf16_t* ap[4];
#pragma unroll
    for (int i = 0; i < 4; ++i) ap[i] = P + ((size_t)b * S_ + 16 * (i0 + 32 * i + 8 * wid + (lane >> 3))) * LD + col + ldc;
    const bf16_t* bp[2];
#pragma unroll
    for (int i = 0; i < 2; ++i) bp[i] = W1T + (size_t)(8 * (wid + 4 * i) + (lane >> 3)) * 2048 + ldc;
    f32x4 acc[4][2];
#pragma unroll
    for (int i = 0; i < 4; ++i)
#pragma unroll
        for (int j = 0; j < 2; ++j) acc[i][j] = (f32x4){0.f, 0.f, 0.f, 0.f};
    __syncthreads();
#define CSTAGE(buf, l) do { unsigned char* st_ = lds + (buf) * 24576; \
        _Pragma("unroll") for (int i = 0; i < 4; ++i) glds16(ap[i] + (size_t)(l) * LD, st_ + (4 * i + wid) * 1024); \
        _Pragma("unroll") for (int i = 0; i < 2; ++i) glds16(bp[i] + (l) * 64, st_ + 16384 + (wid + 4 * i) * 1024); } while (0)
    CSTAGE(0, 0); wait_vm0(); __syncthreads();
    for (int l = 0; l < 32; ++l) {
        const unsigned char* st = lds + (l & 1) * 24576;
        if (l + 1 < 32) CSTAGE((l + 1) & 1, l + 1);
#pragma unroll
        for (int ks = 0; ks < 2; ++ks) {
            bf16x8 a[4], bb[2];
#pragma unroll
            for (int i = 0; i < 4; ++i) a[i] = lds_frag128(st, 64 * wr + 16 * i + fr, 4 * ks + fq);
#pragma unroll
            for (int j = 0; j < 2; ++j) bb[j] = lds_frag128(st + 16384, 32 * wc + 16 * j + fr, 4 * ks + fq);
#pragma unroll
            for (int i = 0; i < 4; ++i)
#pragma unroll
                for (int j = 0; j < 2; ++j) acc[i][j] = mfma16(a[i], bb[j], acc[i][j]);
        }
        wait_vm0(); __syncthreads();
    }
#undef CSTAGE
    float* hid = (float*)lds;
    const float* b1 = (const float*)(ws + WS_B1) + kv * 64;
#pragma unroll
    for (int j = 0; j < 2; ++j) {
        const int n = 32 * wc + 16 * j + fr; const float bias = b1[n + vzero()];
#pragma unroll
        for (int i = 0; i < 4; ++i)
#pragma unroll
            for (int r = 0; r < 4; ++r) hid[(64 * wr + 16 * i + 4 * fq + r) * 65 + n] = gelu_tanh(acc[i][j][r] + bias);
    }
    __syncthreads();
    {
        const int row = tid >> 1, nb = (tid & 1) * 32, ci = i0 + row;
        const float* w2 = p.cmp_w2 + ((size_t)layer * 2 + kv) * 64 * 64;
        float o[32];
#pragma unroll
        for (int q = 0; q < 32; ++q) o[q] = 0.f;
        for (int n = 0; n < 64; ++n) {
            const float h = hid[row * 65 + n];
#pragma unroll
            for (int q4 = 0; q4 < 8; ++q4) { const float4 w = *(const float4*)(w2 + n * 64 + nb + 4 * q4); o[4 * q4] += h * w.x; o[4 * q4 + 1] += h * w.y; o[4 * q4 + 2] += h * w.z; o[4 * q4 + 3] += h * w.w; }
        }
        if (kv == 0) {
            bf16_t* dst = (bf16_t*)(ws + WS_KCC) + ((size_t)(b * 2 + g) * 512 + ci) * 64 + nb;
#pragma unroll
            for (int q = 0; q < 32; q += 4) { f32x4 v = {o[q], o[q + 1], o[q + 2], o[q + 3]}; if (ci >= 511) v = (f32x4){0.f, 0.f, 0.f, 0.f}; *(u32x2*)(dst + q) = pack4(v); }
        } else {
            bf16_t* dst = (bf16_t*)(ws + WS_VCCT) + ((size_t)(b * 2 + g) * 64 + nb) * 512 + ci;
#pragma unroll
            for (int q = 0; q < 32; ++q) dst[(size_t)q * 512] = f2bf(ci >= 511 ? 0.f : o[q]);
        }
    }
    __syncthreads();
}

__device__ __forceinline__ float ret_lg2(int h) { const float gam = 1.f - exp2f(-5.f - (float)h); return log2f(gam); }

__device__ __forceinline__ void retkv_item(const Params& p, int item, unsigned char* lds, int half) {
    unsigned char* ws = launder(p.ws);
    const int tid = (ltid() & 255), lane = tid & 63, wid = tid >> 6, fr = lane & 15, fq = lane >> 4;
    const int n = item & 63, h = (item >> 6) & 7, b = item >> 9;
    const size_t tok0 = (size_t)b * S_ + 128 * n;
    unsigned char* vL = lds; unsigned char* kL = lds + 32768;
    load_tile128w((const bf16_t*)(ws + WS_VRT) + ((size_t)(b * 8 + h) * 128) * S_ + 128 * n, S_, vL, wid, lane);
    load_tile128((const bf16_t*)(ws + WS_P) + tok0 * LD + C_KR + h * 64, LD, kL, wid, lane);
    wait_vm0(); __syncthreads();
    const float lg2 = ret_lg2(h);
    f32x4 acc[2][4];
#pragma unroll
    for (int m = 0; m < 2; ++m)
#pragma unroll
        for (int nt = 0; nt < 4; ++nt) acc[m][nt] = (f32x4){0.f, 0.f, 0.f, 0.f};
#pragma unroll
    for (int ks = 0; ks < 4; ++ks) {
        bf16x8 a[2], bb[4];
#pragma unroll
        for (int m = 0; m < 2; ++m) a[m] = lds_frag256(vL, 32 * wid + 16 * m + fr, 4 * ks + fq);
        float dec[8];
#pragma unroll
        for (int j = 0; j < 8; ++j) dec[j] = exp2f((float)(127 - (32 * ks + 8 * fq + j)) * lg2);
#pragma unroll
        for (int nt = 0; nt < 4; ++nt) {
            const int d = 16 * nt + fr;
            float v[8];
#pragma unroll
            for (int j = 0; j < 8; ++j) {
                const int tk = 32 * ks + 8 * fq + j;
                const bf16_t kvv = *(const bf16_t*)(kL + tk * 128 + (((d >> 3) ^ (tk & 7)) << 4) + (d & 7) * 2);
                v[j] = bf2f(kvv) * dec[j];
            }
            u32x4 w; w.x = pack2(v[0], v[1]); w.y = pack2(v[2], v[3]); w.z = pack2(v[4], v[5]); w.w = pack2(v[6], v[7]);
            bb[nt] = __builtin_bit_cast(bf16x8, w);
        }
#pragma unroll
        for (int m = 0; m < 2; ++m)
#pragma unroll
            for (int nt = 0; nt < 4; ++nt) acc[m][nt] = mfma16(a[m], bb[nt], acc[m][nt]);
    }
    float* KVT = (float*)(ws + WS_KVT) + ((size_t)(b * 8 + h) * 64 + n) * 8192;
#pragma unroll
    for (int m = 0; m < 2; ++m)
#pragma unroll
        for (int nt = 0; nt < 4; ++nt)
#pragma unroll
            for (int r = 0; r < 4; ++r) KVT[(32 * wid + 16 * m + 4 * fq + r) * 64 + 16 * nt + fr] = acc[m][nt][r];
    __syncthreads();
}

__device__ __forceinline__ void phase_p2(const Params& p, int layer, unsigned char* lds, int half) {
    for (int it = (blockIdx.x * 2 + half); it < 1024 + 32; it += (gridDim.x * 2)) {
        if (it < 32) compress_item(p, layer, it, lds, half); else retkv_item(p, it - 32, lds, half);
    }
}

constexpr int NSA_IMP = 32768, NSA_BUCKET = 65792, NSA_BIAS = 73984;

struct NsaLane { int t; int fr, fq, wid, lane; };

template <int BR, int PASS>
__device__ __forceinline__ void nsa_half(const unsigned char* kL, const unsigned char* vL, const unsigned char* lds, const bf16x8 (&qptr)[4][2],
                                         f32x4 (&O)[4][4], float (&m)[4], float (&l)[4], int tile, int hf, bool selbit, const NsaLane& L, int qrow) {
    const int fr = L.fr, fq = L.fq;
    bf16x8 Kf[2][2];
#pragma unroll
    for (int i = 0; i < 2; ++i)
#pragma unroll
        for (int ks = 0; ks < 2; ++ks) Kf[i][ks] = lds_frag128(kL, 32 * hf + 16 * i + fr, 4 * ks + fq);
    bf16x8 Vf[4];
    if (PASS != 0) {
#pragma unroll
        for (int mt = 0; mt < 4; ++mt) Vf[mt] = lds_vfrag128(vL, 16 * mt + fr, 32 * hf, fq);
    }
    unsigned vmask = 0; unsigned bk[2];
    const unsigned char* bucketL = lds + NSA_BUCKET;
#pragma unroll
    for (int i = 0; i < 2; ++i) {
        unsigned pk = 0;
#pragma unroll
        for (int r = 0; r < 4; ++r) {
            const int kk = 32 * hf + 16 * i + 4 * fq + r;
            int rel; bool ok;
            if (BR == 0) { rel = L.t - (16 * (64 * tile + kk) + 31); ok = rel >= 0; }
            else if (BR == 1) { rel = L.t - (64 * tile + kk); ok = selbit && rel >= 0; }
            else { rel = L.t - (64 * tile + kk); ok = rel >= 0 && rel < 512; }
            int rc = rel < 0 ? 0 : rel; rc = rc > 8191 ? 8191 : rc;
            pk |= (unsigned)bucketL[rc] << (8 * r);
            vmask |= (ok ? 1u : 0u) << (4 * i + r);
        }
        bk[i] = pk;
    }
    const float* biasL = (const float*)(lds + NSA_BIAS);
    float ia[2] = {0.f, 0.f}, ic[2] = {0.f, 0.f};
#pragma unroll
    for (int nt = 0; nt < 4; ++nt) {
        f32x4 S[2];
        const bf16x8 q0 = qptr[nt][0], q1 = qptr[nt][1];
#pragma unroll
        for (int i = 0; i < 2; ++i) {
            S[i] = (f32x4){0.f, 0.f, 0.f, 0.f};
            S[i] = mfma16(Kf[i][0], q0, S[i]); S[i] = mfma16(Kf[i][1], q1, S[i]);
        }
        float tmax = -1e30f;
        float bsv[2][4];
#pragma unroll
        for (int i = 0; i < 2; ++i)
#pragma unroll
            for (int r = 0; r < 4; ++r) bsv[i][r] = biasL[nt * 32 + ((bk[i] >> (8 * r)) & 0xffu)];
        asm volatile("" : "+v"(bsv[0][0]), "+v"(bsv[0][1]), "+v"(bsv[0][2]), "+v"(bsv[0][3]), "+v"(bsv[1][0]), "+v"(bsv[1][1]), "+v"(bsv[1][2]), "+v"(bsv[1][3]));
#pragma unroll
        for (int i = 0; i < 2; ++i)
#pragma unroll
            for (int r = 0; r < 4; ++r) {
                const bool ok = (vmask >> (4 * i + r)) & 1u;
                const float sv = S[i][r] * 0.125f + bsv[i][r];
                S[i][r] = ok ? sv : -1e30f; tmax = fmaxf(tmax, S[i][r]);
            }
        if (PASS != 1) {
            tmax = rows_max(tmax);
            const float mnew = fmaxf(m[nt], tmax), alpha = __expf(m[nt] - mnew);
            float psum = 0.f;
#pragma unroll
            for (int i = 0; i < 2; ++i)
#pragma unroll
                for (int r = 0; r < 4; ++r) {
                    const bool ok = (vmask >> (4 * i + r)) & 1u;
                    const float pv = ok ? __expf(S[i][r] - mnew) : 0.f;
                    S[i][r] = pv; psum += pv;
                }
            psum = rows_sum(psum);
            l[nt] = l[nt] * alpha + psum; m[nt] = mnew;
            if (PASS == 2) {
#pragma unroll
                for (int mt = 0; mt < 4; ++mt) O[mt][nt] = O[mt][nt] * alpha;
            }
        } else {
#pragma unroll
            for (int i = 0; i < 2; ++i) {
#pragma unroll
                for (int r = 0; r < 4; ++r) {
                    const bool ok = (vmask >> (4 * i + r)) & 1u;
                    S[i][r] = ok ? __expf(S[i][r] - m[nt]) * l[nt] : 0.f;
                }
                ia[i] += S[i][0] + S[i][1] + S[i][2] + 0.5f * S[i][3];
                ic[i] += 0.5f * S[i][3];
            }
        }
        if (PASS != 0) {
            const bf16x8 Pb = pack8(S[0], S[1]);
#pragma unroll
            for (int mt = 0; mt < 4; ++mt) O[mt][nt] = mfma16(Vf[mt], Pb, O[mt][nt]);
        }
    }
    if (PASS == 1) {
        float* imp = (float*)(lds + NSA_IMP) + qrow * 129;
        asm volatile("" ::: "memory"); __builtin_amdgcn_wave_barrier();
#pragma unroll
        for (int i = 0; i < 2; ++i) { const int j = 16 * tile + 8 * hf + 4 * i + fq; imp[j] += ia[i]; }
        asm volatile("s_waitcnt lgkmcnt(0)" ::: "memory"); __builtin_amdgcn_wave_barrier();
#pragma unroll
        for (int i = 0; i < 2; ++i) { const int j = 16 * tile + 8 * hf + 4 * i + fq + 1; if (j < 128) imp[j] += ic[i]; }
        asm volatile("s_waitcnt lgkmcnt(0)" ::: "memory"); __builtin_amdgcn_wave_barrier();
    }
}
template <int BR, int PASS>
__device__ __forceinline__ void nsa_tile(const unsigned char* kL, const unsigned char* vL, const unsigned char* lds, const bf16x8 (&qptr)[4][2],
                                         f32x4 (&O)[4][4], float (&m)[4], float (&l)[4], int tile, bool selbit, const NsaLane& L, int qrow) {
#pragma unroll 1
    for (int hf = 0; hf < 2; ++hf) nsa_half<BR, PASS>(kL, vL, lds, qptr, O, m, l, tile, hf, selbit, L, qrow);
}

__device__ __forceinline__ void cmp_item(const Params& p, int item, unsigned char* lds, int half) {
    unsigned char* ws = launder(p.ws);
    const int tid = (ltid() & 255), lane = tid & 63, wid = tid >> 6, fr = lane & 15, fq = lane >> 4;
    const int combo = item & 3, qt = 127 - (item >> 2), b = combo >> 1, g = combo & 1;
    const int q0 = qt * 64, qrow = 16 * wid + fr;
    NsaLane L; L.t = q0 + qrow; L.fr = fr; L.fq = fq; L.wid = wid; L.lane = lane;
    const size_t tok = (size_t)b * S_ + L.t;
    const bf16_t* P = (const bf16_t*)(ws + WS_P);
    __syncthreads();
    if (tid < 128) ((float*)(lds + NSA_BIAS))[tid] = p.rel_bias[(tid & 31) * 8 + 4 * g + (tid >> 5)];
    for (int i = tid; i < 64 * 129; i += HT) ((float*)(lds + NSA_IMP))[i] = 0.f;
    bf16x8 Qf[4][2];
#pragma unroll
    for (int nt = 0; nt < 4; ++nt)
#pragma unroll
        for (int ks = 0; ks < 2; ++ks) Qf[nt][ks] = *(const bf16x8*)(P + tok * LD + C_QA + (4 * g + nt) * 64 + 32 * ks + 8 * fq);
    __syncthreads();
    f32x4 O[4][4]; float m[4], l[4];
    const bf16_t* gates = P + tok * LD + C_GA + (4 * g) * 3;
    const bf16_t* kc = (const bf16_t*)(ws + WS_KCC) + (size_t)(b * 2 + g) * 512 * 64;
    const bf16_t* vc = (const bf16_t*)(ws + WS_VCCT) + (size_t)(b * 2 + g) * 64 * 512;
    const int ntc = ((q0 + 32) >> 4) / 64 + 1;
#pragma unroll
    for (int nt = 0; nt < 4; ++nt) { m[nt] = -1e30f; l[nt] = 0.f; }
    load_tile64(kc, 64, lds, wid, lane);
    wait_vm0(); __syncthreads();
    for (int it = 0; it < ntc; ++it) {
        unsigned char* cur = lds + (it & 1) * 16384;
        if (it + 1 < ntc) load_tile64(kc + (size_t)(it + 1) * 64 * 64, 64, lds + ((it + 1) & 1) * 16384, wid, lane);
        nsa_tile<0, 0>(cur, cur + 8192, lds, Qf, O, m, l, it, true, L, qrow);
        wait_vm0(); __syncthreads();
    }
#pragma unroll
    for (int nt = 0; nt < 4; ++nt) l[nt] = l[nt] > 0.f ? 1.f / l[nt] : 0.f;
#pragma unroll
    for (int mt = 0; mt < 4; ++mt)
#pragma unroll
        for (int nt = 0; nt < 4; ++nt) O[mt][nt] = (f32x4){0.f, 0.f, 0.f, 0.f};
    load_tile64(kc, 64, lds, wid, lane); load_tile64(vc, 512, lds + 8192, wid, lane);
    wait_vm0(); __syncthreads();
    for (int it = 0; it < ntc; ++it) {
        unsigned char* cur = lds + (it & 1) * 16384;
        if (it + 1 < ntc) { unsigned char* nx = lds + ((it + 1) & 1) * 16384;
            load_tile64(kc + (size_t)(it + 1) * 64 * 64, 64, nx, wid, lane); load_tile64(vc + (it + 1) * 64, 512, nx + 8192, wid, lane); }
        nsa_tile<0, 1>(cur, cur + 8192, lds, Qf, O, m, l, it, true, L, qrow);
        wait_vm0(); __syncthreads();
    }
    bf16_t* YC = (bf16_t*)(ws + WS_YC) + tok * 512 + (4 * g) * 64;
#pragma unroll
    for (int nt = 0; nt < 4; ++nt) {
        const float gt = bf2f(gates[nt * 3 + 0]);
#pragma unroll
        for (int mt = 0; mt < 4; ++mt) *(u32x2*)(YC + nt * 64 + 16 * mt + 4 * fq) = pack4(O[mt][nt] * gt);
    }
    const int cur = qt;
    {
        float* imp = (float*)(lds + NSA_IMP) + qrow * 129 + 32 * fq;
        asm volatile("s_waitcnt lgkmcnt(0)" ::: "memory"); __builtin_amdgcn_wave_barrier();
#pragma unroll
        for (int i = 0; i < 32; ++i) {
            const int j = 32 * fq + i;
            const float v = imp[i];
            imp[i] = j > cur ? -1.f : v + ((j == 0 || j == cur || j == cur - 1) ? 1.0e4f : 0.f);
        }
        unsigned word = 0;
#pragma unroll 1
        for (int round = 0; round < 16; ++round) {
            float bv = imp[0]; int bi = 0;
#pragma unroll
            for (int i = 1; i < 32; ++i) { const float v = imp[i]; if (v > bv) { bv = v; bi = i; } }
            int gi = 32 * fq + bi;
            {
                u32x2 rv = __builtin_amdgcn_permlane16_swap(__float_as_uint(bv), __float_as_uint(bv), false, false);
                u32x2 ri = __builtin_amdgcn_permlane16_swap((unsigned)gi, (unsigned)gi, false, false);
                float v0 = __uint_as_float(rv.x), v1 = __uint_as_float(rv.y); int i0 = (int)ri.x, i1 = (int)ri.y;
                if (v1 > v0 || (v1 == v0 && i1 < i0)) { v0 = v1; i0 = i1; }
                rv = __builtin_amdgcn_permlane32_swap(__float_as_uint(v0), __float_as_uint(v0), false, false);
                ri = __builtin_amdgcn_permlane32_swap((unsigned)i0, (unsigned)i0, false, false);
                v0 = __uint_as_float(rv.x); v1 = __uint_as_float(rv.y); i0 = (int)ri.x; i1 = (int)ri.y;
                if (v1 > v0 || (v1 == v0 && i1 < i0)) { v0 = v1; i0 = i1; }
                bv = v0; gi = i0;
            }
            if (bv >= 0.f && (gi >> 5) == fq) { word |= 1u << (gi & 31); imp[gi & 31] = -2.f; }
        }
        ((unsigned*)(ws + WS_SELW))[(tok * 2 + g) * 4 + fq] = word;
    }
}

__device__ __forceinline__ void win_item(const Params& p, int item, unsigned char* lds, int half) {
    unsigned char* ws = launder(p.ws);
    const int tid = (ltid() & 255), lane = tid & 63, wid = tid >> 6, fr = lane & 15, fq = lane >> 4;
    const int combo = item & 3, qt = 127 - (item >> 2), b = combo >> 1, g = combo & 1;
    const int q0 = qt * 64, qrow = 16 * wid + fr;
    NsaLane L; L.t = q0 + qrow; L.fr = fr; L.fq = fq; L.wid = wid; L.lane = lane;
    const size_t tok = (size_t)b * S_ + L.t;
    const bf16_t* P = (const bf16_t*)(ws + WS_P);
    __syncthreads();
    if (tid < 128) ((float*)(lds + NSA_BIAS))[tid] = p.rel_bias[(tid & 31) * 8 + 4 * g + (tid >> 5)];
    bf16x8 Qf[4][2];
#pragma unroll
    for (int nt = 0; nt < 4; ++nt)
#pragma unroll
        for (int ks = 0; ks < 2; ++ks) Qf[nt][ks] = *(const bf16x8*)(P + tok * LD + C_QA + (4 * g + nt) * 64 + 32 * ks + 8 * fq);
    __syncthreads();
    f32x4 O[4][4]; float m[4], l[4];
    const bf16_t* gates = P + tok * LD + C_GA + (4 * g) * 3;
#pragma unroll
    for (int nt = 0; nt < 4; ++nt) { m[nt] = -1e30f; l[nt] = 0.f; }
#pragma unroll
    for (int mt = 0; mt < 4; ++mt)
#pragma unroll
        for (int nt = 0; nt < 4; ++nt) O[mt][nt] = (f32x4){0.f, 0.f, 0.f, 0.f};
    {
        const bf16_t* kb = P + ((size_t)b * S_) * LD + C_KW + g * 64;
        const bf16_t* vb = (const bf16_t*)(ws + WS_VWT) + (size_t)(b * 2 + g) * 64 * S_;
        const int k_lo = qt - 8 > 0 ? qt - 8 : 0, ntw = qt - k_lo + 1;
        load_tile64(kb + (size_t)k_lo * 64 * LD, LD, lds, wid, lane); load_tile64(vb + k_lo * 64, S_, lds + 8192, wid, lane);
        wait_vm0(); __syncthreads();
        for (int it = 0; it < ntw; ++it) {
            unsigned char* cu = lds + (it & 1) * 16384;
            if (it + 1 < ntw) { unsigned char* nx = lds + ((it + 1) & 1) * 16384;
                load_tile64(kb + (size_t)(k_lo + it + 1) * 64 * LD, LD, nx, wid, lane); load_tile64(vb + (k_lo + it + 1) * 64, S_, nx + 8192, wid, lane); }
            nsa_tile<2, 2>(cu, cu + 8192, lds, Qf, O, m, l, k_lo + it, true, L, qrow);
            wait_vm0(); __syncthreads();
        }
    }
    bf16_t* YW = (bf16_t*)(ws + WS_YW) + tok * 512 + (4 * g) * 64;
#pragma unroll
    for (int nt = 0; nt < 4; ++nt) {
        const float gt = bf2f(gates[nt * 3 + 2]) * (l[nt] > 0.f ? 1.f / l[nt] : 0.f);
#pragma unroll
        for (int mt = 0; mt < 4; ++mt) *(u32x2*)(YW + nt * 64 + 16 * mt + 4 * fq) = pack4(O[mt][nt] * gt);
    }
}

constexpr int SEL_RING = 8, SEL_BUCKET = SEL_RING * 16384, SEL_BIAS2 = SEL_BUCKET + 8192;
constexpr float LOG2E = 1.4426950408889634f;
__device__ __forceinline__ int t5_first(int bk) {
    const int th[16] = {16, 22, 30, 40, 54, 73, 99, 134, 182, 246, 332, 450, 609, 825, 1117, 1513};
    int r = 16;
#pragma unroll
    for (int k = 0; k < 16; ++k) r = (bk == 16 + k) ? th[k] : r;
    return r;
}
template <bool FAST>
__device__ __forceinline__ void sel_ntile(const bf16x8 (&Kf)[4][2], const unsigned char* vL, int fr, int fq, const bf16x8& q0, const bf16x8& q1, f32x4 (&O)[4], float& m, float& l,
                                          bool sb, int relb, int th, float blo, float bhi, const unsigned char* lds, int hl) {
    f32x4 S[4];
#pragma unroll
    for (int i = 0; i < 4; ++i) { S[i] = (f32x4){0.f, 0.f, 0.f, 0.f}; S[i] = mfma16(Kf[i][0], q0, S[i]); S[i] = mfma16(Kf[i][1], q1, S[i]); }
    float tmax = -1e30f;
    const float scl = (!FAST || sb) ? 0.125f * LOG2E : 0.f;
    if (FAST) { blo = (sb ? blo : -1e30f) - m; bhi = (sb ? bhi : -1e30f) - m; }
    if (FAST) {
#pragma unroll
        for (int i = 0; i < 4; ++i)
#pragma unroll
            for (int r = 0; r < 4; ++r) { const int rel = relb - (16 * i + r); S[i][r] = S[i][r] * scl + (rel >= th ? bhi : blo); tmax = fmaxf(tmax, S[i][r]); }
    } else {
        unsigned bkt[4][4]; float bs[4][4];
#pragma unroll
        for (int i = 0; i < 4; ++i)
#pragma unroll
            for (int r = 0; r < 4; ++r) { const int rel = relb - (16 * i + r); int rc = rel < 0 ? 0 : rel; rc = rc > 8191 ? 8191 : rc; bkt[i][r] = (lds + SEL_BUCKET)[rc]; }
#pragma unroll
        for (int i = 0; i < 4; ++i)
#pragma unroll
            for (int r = 0; r < 4; ++r) bs[i][r] = ((const float*)(lds + SEL_BIAS2))[hl * 32 + bkt[i][r]];
        asm volatile("" : "+v"(bs[0][0]), "+v"(bs[0][1]), "+v"(bs[0][2]), "+v"(bs[0][3]), "+v"(bs[1][0]), "+v"(bs[1][1]), "+v"(bs[1][2]), "+v"(bs[1][3]),
                          "+v"(bs[2][0]), "+v"(bs[2][1]), "+v"(bs[2][2]), "+v"(bs[2][3]), "+v"(bs[3][0]), "+v"(bs[3][1]), "+v"(bs[3][2]), "+v"(bs[3][3]));
        const float ninf = -1e30f;
#pragma unroll
        for (int i = 0; i < 4; ++i)
#pragma unroll
            for (int r = 0; r < 4; ++r) {
                const int rel = relb - (16 * i + r);
                const float sv = S[i][r] * (0.125f * LOG2E) + (bs[i][r] - m);
                S[i][r] = (sb && rel >= 0) ? sv : ninf; tmax = fmaxf(tmax, S[i][r]);
            }
    }
    tmax = rows_max(tmax);
    if (__ballot(tmax > 8.f) != 0ull) {
        const float d = fmaxf(tmax, 0.f), alpha = __builtin_amdgcn_exp2f(-d);
        m += d; l *= alpha;
#pragma unroll
        for (int mt = 0; mt < 4; ++mt) O[mt] = O[mt] * alpha;
#pragma unroll
        for (int i = 0; i < 4; ++i)
#pragma unroll
            for (int r = 0; r < 4; ++r) S[i][r] -= d;
    }
    float psum = 0.f;
#pragma unroll
    for (int i = 0; i < 4; ++i)
#pragma unroll
        for (int r = 0; r < 4; ++r) { const float pv = __builtin_amdgcn_exp2f(S[i][r]); S[i][r] = pv; psum += pv; }
    l += rows_sum(psum);
    const bf16x8 Pb0 = pack8(S[0], S[1]), Pb1 = pack8(S[2], S[3]);
#pragma unroll
    for (int mt = 0; mt < 4; ++mt) { O[mt] = mfma16(lds_vfrag128(vL, 16 * mt + fr, 0, fq), Pb0, O[mt]); O[mt] = mfma16(lds_vfrag128(vL, 16 * mt + fr, 32, fq), Pb1, O[mt]); }
}
__device__ __forceinline__ void sel_ntile2_fast(const bf16x8 (&Kf)[4][2], const unsigned char* vL, int fr, int fq, const bf16x8 (&Qf)[2][2], f32x4 (&O)[2][4], float (&m)[2], float (&l)[2],
                                                const bool (&sb)[2], const int (&relb)[2], int th, float blo, float bhi) {
    f32x4 S[2][4]; float tmax[2], bl[2], bh[2], scl[2];
#pragma unroll
    for (int b = 0; b < 2; ++b)
#pragma unroll
        for (int i = 0; i < 4; ++i) { S[b][i] = (f32x4){0.f, 0.f, 0.f, 0.f}; S[b][i] = mfma16(Kf[i][0], Qf[b][0], S[b][i]); S[b][i] = mfma16(Kf[i][1], Qf[b][1], S[b][i]); }
#pragma unroll
    for (int b = 0; b < 2; ++b) { scl[b] = sb[b] ? 0.125f * LOG2E : 0.f; bl[b] = (sb[b] ? blo : -1e30f) - m[b]; bh[b] = (sb[b] ? bhi : -1e30f) - m[b]; tmax[b] = -1e30f; }
#pragma unroll
    for (int b = 0; b < 2; ++b)
#pragma unroll
        for (int i = 0; i < 4; ++i)
#pragma unroll
            for (int r = 0; r < 4; ++r) { const int rel = relb[b] - (16 * i + r); S[b][i][r] = S[b][i][r] * scl[b] + (rel >= th ? bh[b] : bl[b]); tmax[b] = fmaxf(tmax[b], S[b][i][r]); }
#pragma unroll
    for (int b = 0; b < 2; ++b) tmax[b] = rows_max(tmax[b]);
    if (__ballot(tmax[0] > 8.f || tmax[1] > 8.f) != 0ull) {
#pragma unroll
        for (int b = 0; b < 2; ++b) {
            const float d = fmaxf(tmax[b], 0.f), alpha = __builtin_amdgcn_exp2f(-d);
            m[b] += d; l[b] *= alpha;
#pragma unroll
            for (int mt = 0; mt < 4; ++mt) O[b][mt] = O[b][mt] * alpha;
#pragma unroll
            for (int i = 0; i < 4; ++i)
#pragma unroll
                for (int r = 0; r < 4; ++r) S[b][i][r] -= d;
        }
    }
    float psum[2] = {0.f, 0.f};
#pragma unroll
    for (int b = 0; b < 2; ++b)
#pragma unroll
        for (int i = 0; i < 4; ++i)
#pragma unroll
            for (int r = 0; r < 4; ++r) { const float pv = __builtin_amdgcn_exp2f(S[b][i][r]); S[b][i][r] = pv; psum[b] += pv; }
#pragma unroll
    for (int b = 0; b < 2; ++b) l[b] += rows_sum(psum[b]);
    bf16x8 P0[2], P1[2];
#pragma unroll
    for (int b = 0; b < 2; ++b) { P0[b] = pack8(S[b][0], S[b][1]); P1[b] = pack8(S[b][2], S[b][3]); }
#pragma unroll
    for (int mt = 0; mt < 4; ++mt) {
        const bf16x8 v0 = lds_vfrag128(vL, 16 * mt + fr, 0, fq), v1 = lds_vfrag128(vL, 16 * mt + fr, 32, fq);
#pragma unroll
        for (int b = 0; b < 2; ++b) { O[b][mt] = mfma16(v0, P0[b], O[b][mt]); O[b][mt] = mfma16(v1, P1[b], O[b][mt]); }
    }
}
template <bool FAST>
__device__ __forceinline__ void sel_tile(const unsigned char* kL, const unsigned char* vL, const unsigned char* lds, const bf16x8 (&Qf)[2][2], f32x4 (&O)[2][4], float (&m)[2], float (&l)[2],
                                         const bool (&sb)[2], const bool (&need)[2], const int (&relb)[2], int th, float blo, float bhi, int hl, int fr, int fq) {
    bf16x8 Kf[4][2];
#pragma unroll
    for (int i = 0; i < 4; ++i)
#pragma unroll
        for (int ks = 0; ks < 2; ++ks) Kf[i][ks] = lds_frag128(kL, 16 * i + fr, 4 * ks + fq);
    if (FAST && need[0] && need[1]) { sel_ntile2_fast(Kf, vL, fr, fq, Qf, O, m, l, sb, relb, th, blo, bhi); return; }
    if (need[0]) sel_ntile<FAST>(Kf, vL, fr, fq, Qf[0][0], Qf[0][1], O[0], m[0], l[0], sb[0], relb[0], th, blo, bhi, lds, hl);
    if (need[1]) sel_ntile<FAST>(Kf, vL, fr, fq, Qf[1][0], Qf[1][1], O[1], m[1], l[1], sb[1], relb[1], th, blo, bhi, lds, hl);
}
template <int VAR>
__device__ __forceinline__ void sel_item(const Params& p, int v, unsigned char* lds) {
    unsigned char* ws = launder(p.ws);
    const int tid = ltid(), lane = tid & 63, wid = tid >> 6, fr = lane & 15, fq = lane >> 4;
    const int qt = 127 - (v >> 2), sub = v & 3, b = sub >> 1, g = sub & 1;
    const int q0 = qt * 64, cur = qt, hl = fr & 3;
    const bf16_t* P = (const bf16_t*)(ws + WS_P);
    __syncthreads();
    if (tid < 128) ((float*)(lds + SEL_BIAS2))[tid] = p.rel_bias[(tid & 31) * 8 + 4 * g + (tid >> 5)] * LOG2E;
    int t[2]; size_t tok[2]; bf16x8 Qf[2][2]; unsigned selw[2][4];
#pragma unroll
    for (int nt = 0; nt < 2; ++nt) {
        t[nt] = q0 + 8 * wid + 4 * nt + (fr >> 2); tok[nt] = (size_t)b * S_ + t[nt];
#pragma unroll
        for (int ks = 0; ks < 2; ++ks) Qf[nt][ks] = *(const bf16x8*)(P + tok[nt] * LD + C_QA + (4 * g + hl) * 64 + 32 * ks + 8 * fq);
        const u32x4 w = *(const u32x4*)((const unsigned*)(ws + WS_SELW) + (tok[nt] * 2 + g) * 4);
        selw[nt][0] = w.x; selw[nt][1] = w.y; selw[nt][2] = w.z; selw[nt][3] = w.w;
    }
    f32x4 O[2][4]; float m[2], l[2];
#pragma unroll
    for (int nt = 0; nt < 2; ++nt) { m[nt] = -1000.f; l[nt] = 0.f;
#pragma unroll
        for (int mt = 0; mt < 4; ++mt) O[nt][mt] = (f32x4){0.f, 0.f, 0.f, 0.f}; }
    const bf16_t* kb = P + ((size_t)b * S_) * LD + C_KS + g * 64;
    const bf16_t* vb = (const bf16_t*)(ws + WS_VST) + (size_t)(b * 2 + g) * 64 * S_;
    const int nts = cur + 1;
#define SEL_ISSUE(jj) do { unsigned char* st_ = lds + ((jj) & 7) * 16384; const int c_ = ((lane & 7) ^ (lane >> 3)) * 8, r_ = 8 * wid + (lane >> 3); \
        glds16(kb + ((size_t)(jj) * 64 + r_) * LD + c_, st_ + wid * 1024); glds16(vb + (size_t)r_ * S_ + (jj) * 64 + c_, st_ + 8192 + wid * 1024); } while (0)
    asm volatile("s_waitcnt vmcnt(0)" ::: "memory");
#pragma unroll
    for (int q = 0; q < 4; ++q) if (q < nts) SEL_ISSUE(q);
    const unsigned char* bucketL = lds + SEL_BUCKET;
    for (int jp = 0; jp < nts; jp += 4) {
        WAIT_V(0);
        RAW_BARRIER();
#pragma unroll
        for (int q = 4; q < 8; ++q) if (jp + q < nts) SEL_ISSUE(jp + q);
#pragma unroll 1
      for (int j = jp; j < jp + 4 && j < nts; ++j) {
        const unsigned char* cu = lds + (j & 7) * 16384;
        bool sb[2], need[2]; int relb[2];
#pragma unroll
        for (int nt = 0; nt < 2; ++nt) {
            const unsigned w = j < 32 ? selw[nt][0] : j < 64 ? selw[nt][1] : j < 96 ? selw[nt][2] : selw[nt][3];
            sb[nt] = (w >> (j & 31)) & 1u; need[nt] = __ballot(sb[nt]) != 0ull; relb[nt] = t[nt] - 64 * j - 4 * fq;
        }
        if (VAR == 1) { need[0] = false; need[1] = false; }
        if (VAR == 2) { if (!(need[0] || need[1])) { need[0] = false; } else { need[0] = true; need[1] = true; } }
        if (need[0] || need[1]) {
            const int rmin = q0 - 64 * j - 63, rmax = q0 + 31 - 64 * j;
            bool fast = false; int th = 0; float blo = 0.f, bhi = 0.f;
            if (rmin >= 16) {
                const int b0 = bucketL[rmin], b1 = bucketL[rmax > 8191 ? 8191 : rmax];
                if (b1 - b0 <= 1) { fast = true; th = t5_first(b1); if (b1 == b0) th = 0;
                    blo = ((const float*)(lds + SEL_BIAS2))[hl * 32 + b0]; bhi = ((const float*)(lds + SEL_BIAS2))[hl * 32 + b1]; }
            }
            if (fast) sel_tile<true>(cu, cu + 8192, lds, Qf, O, m, l, sb, need, relb, th, blo, bhi, hl, fr, fq);
            else sel_tile<false>(cu, cu + 8192, lds, Qf, O, m, l, sb, need, relb, th, blo, bhi, hl, fr, fq);
        }
      }
    }
#undef SEL_ISSUE
    __syncthreads();
#pragma unroll
    for (int nt = 0; nt < 2; ++nt) {
        const float gt = bf2f(P[tok[nt] * LD + C_GA + (4 * g + hl) * 3 + 1]) * (l[nt] > 0.f ? 1.f / l[nt] : 0.f);
        const size_t o = tok[nt] * 512 + (4 * g + hl) * 64;
#pragma unroll
        for (int mt = 0; mt < 4; ++mt) {
            const f32x4 yc = unpack4(*(const u32x2*)((const bf16_t*)(ws + WS_YC) + o + 16 * mt + 4 * fq));
            const f32x4 yw = unpack4(*(const u32x2*)((const bf16_t*)(ws + WS_YW) + o + 16 * mt + 4 * fq));
            if (VAR == 0 || VAR == 3) *(u32x2*)((bf16_t*)(ws + WS_YA) + o + 16 * mt + 4 * fq) = pack4(yc + yw + O[nt][mt] * gt);
            else asm volatile("" :: "v"(O[nt][mt]));
        }
    }
}

__device__ __forceinline__ void scan_item(const Params& p, int item, int half) {
    unsigned char* ws = launder(p.ws);
    const int idx = item * HT + (ltid() & 255);
    const int bh = idx >> 13, ed = idx & 8191, h = bh & 7;
    const float dec = exp2f(128.f * ret_lg2(h));
    const float* KVT = (const float*)(ws + WS_KVT) + (size_t)bh * 64 * 8192 + ed;
    bf16_t* SPT = (bf16_t*)(ws + WS_SPT) + (size_t)bh * 64 * 8192 + ed;
    float s = 0.f;
    for (int n = 0; n < 64; ++n) { SPT[(size_t)n * 8192] = f2bf(s); s = s * dec + KVT[(size_t)n * 8192]; }
}

__device__ __forceinline__ void phase_p3(const Params& p, unsigned char* lds, int half, int what) {
    for (int i = (ltid() & 255); i < 8192 / 16; i += HT) ((u32x4*)(lds + NSA_BUCKET))[i] = ((const u32x4*)(launder(p.ws) + WS_BUCKET))[i];
    __syncthreads();
    for (int h = (blockIdx.x * 2 + half); h < 512; h += (gridDim.x * 2)) {
        if (what & 1) cmp_item(p, h, lds, half);
        if (what & 2) {
            if (h >= 128 && h < 384) win_item(p, h - 128, lds, half);
            else if (h >= 384) { win_item(p, 256 + 2 * (h - 384) - ((h & 1) ? 1 : 0) , lds, half); win_item(p, 256 + 2 * (h - 384) + ((h & 1) ? 0 : 1) + 1 - ((h & 1) ? 0 : 0), lds, half); }
        }
        if (what & 4) scan_item(p, h, half);
    }
}

__device__ __forceinline__ void retout_item(const Params& p, int item, unsigned char* lds, int half) {
    unsigned char* ws = launder(p.ws);
    const int tid = (ltid() & 255), lane = tid & 63, wid = tid >> 6, fr = lane & 15, fq = lane >> 4;
    const int n = item & 63, h = (item >> 6) & 7, b = item >> 9;
    const size_t tok0 = (size_t)b * S_ + 128 * n;
    const bf16_t* P = (const bf16_t*)(ws + WS_P);
    unsigned char* vL = lds; unsigned char* kL = lds + 32768; unsigned char* sL = lds + 49152;
    __syncthreads();
    load_tile128w((const bf16_t*)(ws + WS_VRT) + ((size_t)(b * 8 + h) * 128) * S_ + 128 * n, S_, vL, wid, lane);
    load_tile128(P + tok0 * LD + C_KR + h * 64, LD, kL, wid, lane);
    load_tile128((const bf16_t*)(ws + WS_SPT) + ((size_t)(b * 8 + h) * 64 + n) * 8192, 64, sL, wid, lane);
    bf16x8 Qf[2][2];
#pragma unroll
    for (int nt = 0; nt < 2; ++nt)
#pragma unroll
        for (int ks = 0; ks < 2; ++ks) Qf[nt][ks] = *(const bf16x8*)(P + (tok0 + 32 * wid + 16 * nt + fr) * LD + C_QR + h * 64 + 32 * ks + 8 * fq);
    wait_vm0(); __syncthreads();
    const float lg2 = ret_lg2(h);
    f32x4 Y[8][2];
#pragma unroll
    for (int m = 0; m < 8; ++m)
#pragma unroll
        for (int nt = 0; nt < 2; ++nt) Y[m][nt] = (f32x4){0.f, 0.f, 0.f, 0.f};
#pragma unroll
    for (int m = 0; m < 8; ++m)
#pragma unroll
        for (int ks = 0; ks < 2; ++ks) {
            const bf16x8 a = lds_frag128(sL, 16 * m + fr, 4 * ks + fq);
#pragma unroll
            for (int nt = 0; nt < 2; ++nt) Y[m][nt] = mfma16(a, Qf[nt][ks], Y[m][nt]);
        }
#pragma unroll
    for (int nt = 0; nt < 2; ++nt) {
        const float sc = exp2f((float)(32 * wid + 16 * nt + fr + 1) * lg2);
#pragma unroll
        for (int m = 0; m < 8; ++m) Y[m][nt] = Y[m][nt] * sc;
    }
#pragma unroll 1
    for (int s = 0; s < 4; ++s) {
        f32x4 St[2][2];
#pragma unroll
        for (int hh = 0; hh < 2; ++hh) {
            const int mt = 2 * s + hh;
#pragma unroll
            for (int nt = 0; nt < 2; ++nt) St[hh][nt] = (f32x4){0.f, 0.f, 0.f, 0.f};
#pragma unroll
            for (int ks = 0; ks < 2; ++ks) {
                const bf16x8 a = lds_frag128(kL, 16 * mt + fr, 4 * ks + fq);
#pragma unroll
                for (int nt = 0; nt < 2; ++nt) St[hh][nt] = mfma16(a, Qf[nt][ks], St[hh][nt]);
            }
#pragma unroll
            for (int nt = 0; nt < 2; ++nt) {
                const int qi = 32 * wid + 16 * nt + fr;
#pragma unroll
                for (int r = 0; r < 4; ++r) {
                    const int kj = 16 * mt + 4 * fq + r;
                    const float dm = qi >= kj ? exp2f((float)(qi - kj) * lg2) : 0.f;
                    St[hh][nt][r] *= dm;
                }
            }
        }
        bf16x8 Pb[2];
#pragma unroll
        for (int nt = 0; nt < 2; ++nt) Pb[nt] = pack8(St[0][nt], St[1][nt]);
#pragma unroll
        for (int m = 0; m < 8; ++m) {
            const bf16x8 a = lds_vfrag256(vL, 16 * m + fr, 32 * s, fq);
#pragma unroll
            for (int nt = 0; nt < 2; ++nt) Y[m][nt] = mfma16(a, Pb[nt], Y[m][nt]);
        }
    }
    bf16_t* YB = (bf16_t*)(ws + WS_YB);
#pragma unroll
    for (int nt = 0; nt < 2; ++nt) {
        float sum = 0.f;
#pragma unroll
        for (int m = 0; m < 8; ++m) sum += Y[m][nt][0] + Y[m][nt][1] + Y[m][nt][2] + Y[m][nt][3];
        sum = rows_sum(sum);
        const float mu = sum * (1.f / 128.f);
        float vs = 0.f;
#pragma unroll
        for (int m = 0; m < 8; ++m)
#pragma unroll
            for (int r = 0; r < 4; ++r) { const float dlt = Y[m][nt][r] - mu; vs += dlt * dlt; }
        vs = rows_sum(vs);
        const float rstd = rsqrtf(vs * (1.f / 128.f) + 1e-5f);
        const size_t tk = tok0 + 32 * wid + 16 * nt + fr;
#pragma unroll
        for (int m = 0; m < 8; ++m) {
            const f32x4 gt = unpack4(*(const u32x2*)(P + tk * LD + C_GR + h * 128 + 16 * m + 4 * fq));
            f32x4 v;
#pragma unroll
            for (int r = 0; r < 4; ++r) v[r] = (Y[m][nt][r] - mu) * rstd * gt[r];
            *(u32x2*)(YB + tk * 1024 + h * 128 + 16 * m + 4 * fq) = pack4(v);
        }
    }
}
__device__ __forceinline__ void phase_p4_sel(const Params& p, unsigned char* lds) {
    for (int i = ltid(); i < 8192 / 16; i += NTHREADS) ((u32x4*)(lds + SEL_BUCKET))[i] = ((const u32x4*)(launder(p.ws) + WS_BUCKET))[i];
    __syncthreads();
    for (int it = blockIdx.x; it < 512; it += gridDim.x * 2) {
        sel_item<0>(p, it, lds);
        if (511 - it != it) sel_item<0>(p, 511 - it, lds);
    }
    __syncthreads();
}
__device__ __forceinline__ void phase_p4(const Params& p, unsigned char* lds, int half) {
    for (int it = (blockIdx.x * 2 + half); it < 1024; it += (gridDim.x * 2)) retout_item(p, it, lds, half);
}

struct RowOrder {     typedef pg8::Unit U; static constexpr bool GATHER = false;
    unsigned a, b; int K, xcd, slot, per;
    __device__ __forceinline__ bool next(int i, pg8::Unit& u) const { const int t = xcd * 32 + slot + i * per; if (t >= (xcd + 1) * 32) return false; u.pm = t >> 2; u.pn = t & 3; return true; }
    __device__ __forceinline__ void ptrs(const pg8::Unit& u, unsigned& A, unsigned& B) const { A = a + (unsigned)u.pm * 512u * (unsigned)K; B = b + (unsigned)u.pn * 512u * (unsigned)K; }
};
template <int MODE>
struct MixEpi {
    unsigned char* ws; const float* X;
    __device__ __forceinline__ void operator()(const f32x4 (&acc)[2][2][4][2], const pg8::Unit& u, int wr, int wc, int fr, int fq) const {
#pragma unroll
        for (int ai = 0; ai < 2; ++ai)
#pragma unroll
            for (int m = 0; m < 4; ++m) {
                const size_t tok = (size_t)(u.pm * 256 + 128 * ai + 64 * wr + 16 * m + fr + vzero());
#pragma unroll
                for (int bj = 0; bj < 2; ++bj) {
                    const int n = u.pn * 256 + 128 * bj + 32 * wc + 8 * fq;
                    const f32x4 v0 = acc[ai][bj][m][0], v1 = acc[ai][bj][m][1];
                    if (MODE == 2) {
                        const f32x4 x0 = *(const f32x4*)(X + tok * 1024 + n), x1 = *(const f32x4*)(X + tok * 1024 + n + 4);
                        float* H1 = (float*)(ws + WS_H1);
                        *(f32x4*)(H1 + tok * 1024 + n) = x0 * DN_ALPHA + v0; *(f32x4*)(H1 + tok * 1024 + n + 4) = x1 * DN_ALPHA + v1;
                    } else {
                        const u32x4 gw = *(const u32x4*)((const bf16_t*)(ws + WS_P) + tok * LD + (MODE == 0 ? C_MA : C_MB) + n);
                        const f32x4 g0 = unpack4((u32x2){gw.x, gw.y}), g1 = unpack4((u32x2){gw.z, gw.w});
                        f32x4 o0 = g0 * v0, o1 = g1 * v1;
                        bf16_t* MG = (bf16_t*)(ws + WS_MG) + tok * 1024 + n;
                        if (MODE == 1) { const u32x4 pw = *(const u32x4*)MG; o0 = o0 + unpack4((u32x2){pw.x, pw.y}); o1 = o1 + unpack4((u32x2){pw.z, pw.w}); }
                        u32x4 w; w.x = pack2(o0[0], o0[1]); w.y = pack2(o0[2], o0[3]); w.z = pack2(o1[0], o1[1]); w.w = pack2(o1[2], o1[3]);
                        *(u32x4*)MG = w;
                    }
                }
            }
    }
};
__device__ __forceinline__ void phase_g2(const Params& p, unsigned char* lds) {
    unsigned char* ws = launder(p.ws);
    RowOrder S; S.xcd = blockIdx.x & 7; S.slot = blockIdx.x >> 3; S.per = gridDim.x >> 3;
    { S.a = (unsigned)WS_YA; S.b = (unsigned)WS_WA; S.K = 512; MixEpi<0> E; E.ws = ws; E.X = nullptr; pg8::gemm_phase<MixEpi<0>, RowOrder>(lds, 512, S, E, ltid(), ws); }
    { S.a = (unsigned)WS_YB; S.b = (unsigned)WS_WB; S.K = 1024; MixEpi<1> E; E.ws = ws; E.X = nullptr; pg8::gemm_phase<MixEpi<1>, RowOrder>(lds, 1024, S, E, ltid(), ws); }
}
__device__ __forceinline__ void phase_g3(const Params& p, int layer, unsigned char* lds) {
    unsigned char* ws = launder(p.ws);
    RowOrder S; S.xcd = blockIdx.x & 7; S.slot = blockIdx.x >> 3; S.per = gridDim.x >> 3; S.a = (unsigned)WS_MG; S.b = (unsigned)WS_WO; S.K = 1024;
    MixEpi<2> E; E.ws = ws; E.X = layer == 0 ? p.x : (const float*)(ws + WS_X);
    pg8::gemm_phase<MixEpi<2>, RowOrder>(lds, 1024, S, E, ltid(), ws);
}

__device__ __forceinline__ void phase_ln1(const Params& p, int layer, unsigned char* lds, bool dry, int half) {
    unsigned char* ws = launder(p.ws);
    const int tid = (ltid() & 255), lane = tid & 63, wid = tid >> 6;
    float* wrL = (float*)lds;
    {
        float4 wv[16];
#pragma unroll
        for (int k = 0; k < 16; ++k) wv[k] = ((const float4*)p.w_router)[tid + 256 * k];
#pragma unroll
        for (int k = 0; k < 16; ++k) { const int i4 = tid + 256 * k, d = i4 >> 2, e0 = (i4 & 3) * 4;
            wrL[(e0 + 0) * 1024 + d] = wv[k].x; wrL[(e0 + 1) * 1024 + d] = wv[k].y; wrL[(e0 + 2) * 1024 + d] = wv[k].z; wrL[(e0 + 3) * 1024 + d] = wv[k].w; }
    }
    __syncthreads();
    const float* H1 = (const float*)(ws + WS_H1);
    float* X1 = (float*)(ws + WS_X1); bf16_t* X1B = (bf16_t*)(ws + WS_X1B);
    const float* gam = p.ln1_g + layer * 1024; const float* bet = p.ln1_b + layer * 1024;
    unsigned* cnt = (unsigned*)(ws + WS_CTL) + (dry ? 0 : CW_CNT) + layer * 1024;
    int* LIST = (int*)(ws + (dry ? WS_HB : WS_LIST)); float* WTS = (float*)(ws + (dry ? WS_HB + 4194304 : WS_WTS));
    const int tstep = (gridDim.x * 2) * 4;
    float4 vn[4];
    { const int tok0 = (blockIdx.x * 2 + half) * 4 + wid;
#pragma unroll
      for (int j = 0; j < 4; ++j) vn[j] = *(const float4*)(H1 + (size_t)tok0 * 1024 + 256 * j + 4 * lane); }
    for (int tok = (blockIdx.x * 2 + half) * 4 + wid; tok < T_; tok += tstep) {
        float4 v[4];
#pragma unroll
        for (int j = 0; j < 4; ++j) v[j] = vn[j];
        { const int tn = tok + tstep < T_ ? tok + tstep : tok;
#pragma unroll
          for (int j = 0; j < 4; ++j) vn[j] = *(const float4*)(H1 + (size_t)tn * 1024 + 256 * j + 4 * lane); }
        float s = 0.f;
#pragma unroll
        for (int j = 0; j < 4; ++j) s += v[j].x + v[j].y + v[j].z + v[j].w;
        s = wave_sum(s);
        const float mu = s * (1.f / 1024.f);
        float q = 0.f;
#pragma unroll
        for (int j = 0; j < 4; ++j) { const float a = v[j].x - mu, b2 = v[j].y - mu, c = v[j].z - mu, d = v[j].w - mu; q += a * a + b2 * b2 + c * c + d * d; }
        q = wave_sum(q);
        const float rstd = rsqrtf(q * (1.f / 1024.f) + 1e-5f);
        float4 y[4];
#pragma unroll
        for (int j = 0; j < 4; ++j) {
            const int d0 = 256 * j + 4 * lane;
            const float4 gg = *(const float4*)(gam + d0), bb = *(const float4*)(bet + d0);
            y[j].x = (v[j].x - mu) * rstd * gg.x + bb.x; y[j].y = (v[j].y - mu) * rstd * gg.y + bb.y; y[j].z = (v[j].z - mu) * rstd * gg.z + bb.z; y[j].w = (v[j].w - mu) * rstd * gg.w + bb.w;
            *(float4*)(X1 + (size_t)tok * 1024 + d0) = y[j];
            u32x2 w; w.x = pack2(y[j].x, y[j].y); w.y = pack2(y[j].z, y[j].w);
            *(u32x2*)(X1B + (size_t)tok * 1024 + d0) = w;
        }
        float lg[16];
#pragma unroll
        for (int e = 0; e < 16; ++e) {
            float a = 0.f;
#pragma unroll
            for (int j = 0; j < 4; ++j) { const float4 w4 = *(const float4*)(wrL + e * 1024 + 256 * j + 4 * lane); a += y[j].x * w4.x + y[j].y * w4.y + y[j].z * w4.z + y[j].w * w4.w; }
            lg[e] = a;
        }
#pragma unroll
        for (int e = 0; e < 16; ++e) {
            lg[e] = wave_sum(lg[e]);
        }
        float mx = lg[0];
#pragma unroll
        for (int e = 1; e < 16; ++e) mx = fmaxf(mx, lg[e]);
        float pr[16], ps = 0.f;
#pragma unroll
        for (int e = 0; e < 16; ++e) { pr[e] = expf(lg[e] - mx); ps += pr[e]; }
        const float ips = 1.f / ps;
        float sel[16];
#pragma unroll
        for (int e = 0; e < 16; ++e) { pr[e] *= ips; sel[e] = pr[e] + p.router_bias[e]; }
        int best = 0; float bestv = -1e30f;
#pragma unroll
        for (int gI = 0; gI < 4; ++gI) {
            float a = -1e30f, b2 = -1e30f;
#pragma unroll
            for (int k = 0; k < 4; ++k) { const float x = sel[4 * gI + k]; if (x > a) { b2 = a; a = x; } else if (x > b2) b2 = x; }
            const float gs = a + b2;
            if (gs > bestv) { bestv = gs; best = gI; }
        }
        float s4[4], p4[4];
#pragma unroll
        for (int k = 0; k < 4; ++k) { s4[k] = 0.f; p4[k] = 0.f; }
#pragma unroll
        for (int gI = 0; gI < 4; ++gI) if (gI == best) {
#pragma unroll
            for (int k = 0; k < 4; ++k) { s4[k] = sel[4 * gI + k]; p4[k] = pr[4 * gI + k]; }
        }
        int i0 = 0; float a0 = s4[0];
#pragma unroll
        for (int k = 1; k < 4; ++k) if (s4[k] > a0) { a0 = s4[k]; i0 = k; }
        int i1 = -1; float a1 = -1e30f;
#pragma unroll
        for (int k = 0; k < 4; ++k) if (k != i0 && s4[k] > a1) { a1 = s4[k]; i1 = k; }
        float w0 = 0.f, w1 = 0.f;
#pragma unroll
        for (int k = 0; k < 4; ++k) { if (k == i0) w0 = p4[k]; if (k == i1) w1 = p4[k]; }
        const float iw = 1.f / (w0 + w1);
        if (lane == 0) {
            const int e0 = best * 4 + i0, e1 = best * 4 + i1;
            const unsigned p0 = atomicAdd(&cnt[e0 * 64], 1u), p1 = atomicAdd(&cnt[e1 * 64], 1u);
            LIST[(size_t)e0 * T_ + p0] = tok * 2; LIST[(size_t)e1 * T_ + p1] = tok * 2 + 1;
            WTS[tok * 2] = w0 * iw; WTS[tok * 2 + 1] = w1 * iw;
        }
    }
}

struct MoeUnit { int e, rt, ct, cnt, off; };
struct MoeOrderBase {
    const unsigned* cntp; int t_lo, t_hi, slot, per;
    __device__ __forceinline__ void init(const unsigned* cnt) {
        cntp = cnt; int ntile = 0;
#pragma unroll
        for (int k = 0; k < NE; ++k) ntile += ((__builtin_amdgcn_readfirstlane((int)cnt[k * 64]) + 255) >> 8) * 4;
        t_lo = (ntile * (int)(blockIdx.x & 7)) >> 3; t_hi = (ntile * (int)((blockIdx.x & 7) + 1)) >> 3; slot = blockIdx.x >> 3; per = gridDim.x >> 3;
    }
    __device__ __forceinline__ bool next(int i, MoeUnit& u) const {
        const int t = t_lo + slot + i * per; if (t >= t_hi) return false;
        int base = 0, off = 0; bool found = false;
#pragma unroll
        for (int k = 0; k < NE; ++k) {
            const int ck = __builtin_amdgcn_readfirstlane((int)cntp[k * 64]), nt = ((ck + 255) >> 8) * 4;
            if (!found && t < base + nt) { found = true; u.e = k; u.cnt = ck; u.off = off; u.rt = (t - base) >> 2; u.ct = (t - base) & 3; }
            base += nt; off += ck;
        }
        return found;
    }
};
struct M2Order : MoeOrderBase {
    typedef MoeUnit U; static constexpr bool GATHER = true;
    const int* list;
    __device__ __forceinline__ void ptrs(const MoeUnit& u, unsigned& A, unsigned& B) const { A = (unsigned)WS_X1B; B = (unsigned)WS_WG + ((unsigned)u.e * 1024u + (unsigned)u.ct * 256u) * 2048u; }
    __device__ __forceinline__ void rows(const MoeUnit& u, int tid, unsigned (&v)[2][2]) const {
#pragma unroll
        for (int i = 0; i < 2; ++i) { int R, C; pg8::stage_rc((tid + vzero()) * 16 + i * 8192, R, C);
#pragma unroll
            for (int h = 0; h < 2; ++h) { int idx = u.rt * 256 + 128 * h + R; idx = idx < u.cnt ? idx : u.cnt - 1; const int a = (list + (size_t)u.e * T_)[idx]; v[h][i] = ((unsigned)(a >> 1) << 11) + (unsigned)C * 2u; } }
    }
};
struct M3Order : MoeOrderBase {
    typedef MoeUnit U; static constexpr bool GATHER = false;
    __device__ __forceinline__ void ptrs(const MoeUnit& u, unsigned& A, unsigned& B) const { A = (unsigned)WS_HB + ((unsigned)u.off + (unsigned)u.rt * 256u) * 1024u; B = (unsigned)WS_WD + ((unsigned)u.e * 1024u + (unsigned)u.ct * 256u) * 1024u; }
};
struct M2Epi {
    unsigned char* ws;
    __device__ __forceinline__ void operator()(const f32x4 (&acc)[2][2][4][2], const MoeUnit& u, int wr, int wc, int fr, int fq) const {
        bf16_t* HB = (bf16_t*)(ws + WS_HB);
#pragma unroll
        for (int ai = 0; ai < 2; ++ai)
#pragma unroll
            for (int m = 0; m < 4; ++m) {
                const int idx = u.rt * 256 + 128 * ai + 64 * wr + 16 * m + fr + vzero();
                if (idx < u.cnt) {
#pragma unroll
                    for (int bj = 0; bj < 2; ++bj) {
                        const int hcol = 4 * (32 * u.ct + 16 * bj + 4 * wc + fq);
                        const f32x4 gv = acc[ai][bj][m][0], uv = acc[ai][bj][m][1]; f32x4 hv;
#pragma unroll
                        for (int r = 0; r < 4; ++r) hv[r] = gv[r] * fsig(gv[r]) * uv[r];
                        *(u32x2*)(HB + (size_t)(u.off + idx) * 512 + hcol) = pack4(hv);
                    }
                }
            }
    }
};
struct M3Epi {
    unsigned char* ws; const int* list;
    __device__ __forceinline__ void operator()(const f32x4 (&acc)[2][2][4][2], const MoeUnit& u, int wr, int wc, int fr, int fq) const {
        bf16_t* CT = (bf16_t*)(ws + WS_CT);
#pragma unroll
        for (int ai = 0; ai < 2; ++ai)
#pragma unroll
            for (int m = 0; m < 4; ++m) {
                const int idx = u.rt * 256 + 128 * ai + 64 * wr + 16 * m + fr + vzero();
                if (idx < u.cnt) {
                    const int a = list[(size_t)u.e * T_ + idx];
#pragma unroll
                    for (int bj = 0; bj < 2; ++bj) {
                        const int n = u.ct * 256 + 128 * bj + 32 * wc + 8 * fq;
                        const f32x4 v0 = acc[ai][bj][m][0], v1 = acc[ai][bj][m][1];
                        u32x4 w; w.x = pack2(v0[0], v0[1]); w.y = pack2(v0[2], v0[3]); w.z = pack2(v1[0], v1[1]); w.w = pack2(v1[2], v1[3]);
                        *(u32x4*)(CT + (size_t)a * 1024 + n) = w;
                    }
                }
            }
    }
};
__device__ __forceinline__ void phase_m2(const Params& p, int layer, unsigned char* lds) {
    unsigned char* ws = launder(p.ws);
    M2Order S; S.init((const unsigned*)(ws + WS_CTL) + CW_CNT + layer * 1024 + vzero());
    S.list = (const int*)(ws + WS_LIST);
    M2Epi E; E.ws = ws;
    pg8::gemm_phase<M2Epi, M2Order>(lds, 1024, S, E, ltid(), ws);
}
__device__ __forceinline__ void phase_m3(const Params& p, int layer, unsigned char* lds) {
    unsigned char* ws = launder(p.ws);
    M3Order S; S.init((const unsigned*)(ws + WS_CTL) + CW_CNT + layer * 1024 + vzero());
    M3Epi E; E.ws = ws; E.list = (const int*)(ws + WS_LIST);
    pg8::gemm_phase<M3Epi, M3Order>(lds, 512, S, E, ltid(), ws);
}

__device__ __forceinline__ void phase_ln2(const Params& p, int layer, int half) {
    unsigned char* ws = launder(p.ws);
    const int tid = (ltid() & 255), lane = tid & 63, wid = tid >> 6;
    const float* X1 = (const float*)(ws + WS_X1); const bf16_t* CT = (const bf16_t*)(ws + WS_CT); const float* WTS = (const float*)(ws + WS_WTS);
    float* XO = layer == NLAYER - 1 ? p.out : (float*)(ws + WS_X); bf16_t* XB = (bf16_t*)(ws + WS_XB);
    const float* gam = p.ln2_g + layer * 1024; const float* bet = p.ln2_b + layer * 1024;
    constexpr int U = 4;
    const int nwave = (gridDim.x * 2) * 4, wv = (blockIdx.x * 2 + half) * 4 + wid;
    for (int t0 = wv * U; t0 < T_; t0 += nwave * U) {
        float4 v[U][4]; float s[U], q[U];
#pragma unroll
        for (int u = 0; u < U; ++u) {
            const int tok = t0 + u;
            const float w0 = WTS[tok * 2 + vzero()], w1 = WTS[tok * 2 + 1 + vzero()];
            s[u] = 0.f; q[u] = 0.f;
#pragma unroll
            for (int j = 0; j < 4; ++j) {
                const int d0 = 256 * j + 4 * lane;
                const float4 xv = *(const float4*)(X1 + (size_t)tok * 1024 + d0);
                const f32x4 c0 = unpack4(*(const u32x2*)(CT + (size_t)(tok * 2) * 1024 + d0)), c1 = unpack4(*(const u32x2*)(CT + (size_t)(tok * 2 + 1) * 1024 + d0));
                v[u][j].x = xv.x * DN_ALPHA + w0 * c0[0] + w1 * c1[0]; v[u][j].y = xv.y * DN_ALPHA + w0 * c0[1] + w1 * c1[1];
                v[u][j].z = xv.z * DN_ALPHA + w0 * c0[2] + w1 * c1[2]; v[u][j].w = xv.w * DN_ALPHA + w0 * c0[3] + w1 * c1[3];
                s[u] += v[u][j].x + v[u][j].y + v[u][j].z + v[u][j].w;
                q[u] += v[u][j].x * v[u][j].x + v[u][j].y * v[u][j].y + v[u][j].z * v[u][j].z + v[u][j].w * v[u][j].w;
            }
        }
#pragma unroll
        for (int u = 0; u < U; ++u) { s[u] = wave_sum(s[u]); q[u] = wave_sum(q[u]); }
#pragma unroll
        for (int j = 0; j < 4; ++j) {
            const int d0 = 256 * j + 4 * lane;
            const float4 gg = *(const float4*)(gam + d0), bb = *(const float4*)(bet + d0);
#pragma unroll
            for (int u = 0; u < U; ++u) {
                const int tok = t0 + u;
                const float mu = s[u] * (1.f / 1024.f), var = fmaxf(q[u] * (1.f / 1024.f) - mu * mu, 0.f), rstd = rsqrtf(var + 1e-5f);
                float4 y; y.x = (v[u][j].x - mu) * rstd * gg.x + bb.x; y.y = (v[u][j].y - mu) * rstd * gg.y + bb.y; y.z = (v[u][j].z - mu) * rstd * gg.z + bb.z; y.w = (v[u][j].w - mu) * rstd * gg.w + bb.w;
                *(float4*)(XO + (size_t)tok * 1024 + d0) = y;
                u32x2 w; w.x = pack2(y.x, y.y); w.y = pack2(y.z, y.w);
                *(u32x2*)(XB + (size_t)tok * 1024 + d0) = w;
            }
        }
    }
}

#define XB_TMO      128
#define XB_XCNT(j)  (256  + 64 * (j))
#define XB_XSUB(j)  (1280 + 64 * (j))
#define XB_XGEN(j)  (2304 + 64 * (j))
#define XB_TOP      3328
#define XB_TOPGEN   3392
#define XCD_BAR_WORDS 3456
#define XB_SPIN_CAP (1u << 22)
#define LAS __attribute__((address_space(3)))
__device__ __forceinline__ unsigned xb_ld(unsigned* p)              { return __hip_atomic_load(p, __ATOMIC_RELAXED, __HIP_MEMORY_SCOPE_AGENT); }
__device__ __forceinline__ unsigned xb_add(unsigned* p, unsigned v) { return __hip_atomic_fetch_add(p, v, __ATOMIC_RELAXED, __HIP_MEMORY_SCOPE_AGENT); }
__device__ __forceinline__ unsigned xb_xcc_id() { return (unsigned)__builtin_amdgcn_s_getreg((3 << 11) | 20) & 0xFu; }
#define XB_SPIN(cond, bar) do { unsigned _sp = 0; while (cond) { __builtin_amdgcn_s_sleep(1); \
    if ((++_sp & 255u) == 0u) { if (xb_ld(&(bar)[XB_TMO])) break; if (_sp > XB_SPIN_CAP) { atomicAdd(&(bar)[XB_TMO], 1u); break; } } } } while (0)
struct XcdBarrier { unsigned* bar; unsigned x; volatile LAS unsigned* st; };
__device__ __forceinline__ XcdBarrier xcd_barrier_post(unsigned* bar, volatile LAS unsigned* st) {
    XcdBarrier b; b.bar = bar; b.x = xb_xcc_id(); b.st = st;
    if (threadIdx.x == 0) (void)xb_add(&bar[XB_XCNT(b.x)], 1u);
    return b;
}
__device__ __forceinline__ void xcd_barrier_complete(unsigned* bar, unsigned x, unsigned& nloc, unsigned& nx) {
    const unsigned G = gridDim.x * gridDim.y * gridDim.z;
    unsigned sum, cnt, mine, sp = 0u;
    for (;;) {
        sum = 0u; cnt = 0u; mine = 0u;
#pragma unroll
        for (unsigned j = 0; j < 16; ++j) { const unsigned c = xb_ld(&bar[XB_XCNT(j)]); sum += c; cnt += (c > 0u) ? 1u : 0u; mine = (j == x) ? c : mine; }
        if (sum == G) break;
        __builtin_amdgcn_s_sleep(1);
        if ((++sp & 255u) == 0u) { if (xb_ld(&bar[XB_TMO])) break; if (sp > XB_SPIN_CAP) { atomicAdd(&bar[XB_TMO], 1u); break; } }
    }
    nloc = mine > 0u ? mine : 1u; nx = cnt > 0u ? cnt : 1u;
}
__device__ __forceinline__ void xcd_barrier(const XcdBarrier& b) {
    asm volatile("s_waitcnt vmcnt(0)" ::: "memory");
    __syncthreads();
    if (threadIdx.x == 0) {
        unsigned* bar = b.bar;
        __builtin_amdgcn_s_waitcnt(0);
        unsigned nloc = b.st[0], nx = b.st[1];
        if (nloc == 0u) { xcd_barrier_complete(bar, b.x, nloc, nx); b.st[0] = nloc; b.st[1] = nx; }
        const unsigned old = xb_add(&bar[XB_XSUB(b.x)], 1u);
        const unsigned gen = old / nloc;
        if (old + 1u == (gen + 1u) * nloc) {
            __builtin_amdgcn_fence(__ATOMIC_RELEASE, "agent");
            asm volatile("s_waitcnt vmcnt(0)" ::: "memory");
            const unsigned og = xb_add(&bar[XB_TOP], 1u);
            const unsigned tg = og / nx;
            if (og + 1u == (tg + 1u) * nx) xb_add(&bar[XB_TOPGEN], 1u);
            else XB_SPIN(xb_ld(&bar[XB_TOPGEN]) == tg, bar);
            __builtin_amdgcn_fence(__ATOMIC_ACQUIRE, "agent");
            xb_add(&bar[XB_XGEN(b.x)], 1u);
            asm volatile("s_waitcnt vmcnt(0)" ::: "memory");
        } else {
            XB_SPIN(xb_ld(&bar[XB_XGEN(b.x)]) == gen, bar);
            __builtin_amdgcn_fence(__ATOMIC_ACQUIRE, "agent");
            asm volatile("s_waitcnt vmcnt(0)" ::: "memory");
        }
    }
    __syncthreads();
}

constexpr int PH_PER_LAYER = 11, N_PHASES = PH_PER_LAYER * NLAYER;
__global__ void __launch_bounds__(NTHREADS, 2) mega(Params p) {
    extern __shared__ __attribute__((aligned(16))) unsigned char lds[];
#if SINGLE_LAUNCH
    volatile LAS unsigned* xbw = (volatile LAS unsigned*)(lds + LDS_BYTES - 16);
    if (threadIdx.x < 4) xbw[threadIdx.x] = 0u;
    __syncthreads();
    XcdBarrier xbar = xcd_barrier_post((unsigned*)(p.ws + WS_CTL) + CW_BAR, xbw);
#endif
    const int half = __builtin_amdgcn_readfirstlane((int)(threadIdx.x >> 8));
    unsigned char* ldsh = lds + half * HALF_LDS;
    bool second = false;
    for (int ph = p.ph_lo; ph < p.ph_hi; ++ph) {
        const int layer = ph / PH_PER_LAYER, k = ph % PH_PER_LAYER;
        if (k == 0 && layer > 0) continue;
#ifdef ONLY_PHASE
        if (k != ONLY_PHASE) continue;
#endif
        switch (k) {
            case 0: phase_pw(p, layer, ldsh, 15, half); break;
            case 1: phase_g1(p, layer, lds); break;
            case 2: phase_p2(p, layer, ldsh, half); break;
            case 3: phase_p3(p, ldsh, half, second ? ((p.rep_mask >> 16) & 7) : 7); if (!second && layer + 1 < NLAYER) { __syncthreads(); phase_pw(p, layer + 1, ldsh, 1, half); } break;
            case 4: { const int sub = second ? ((p.rep_mask >> 12) & 7) : 7;
                    if (sub & 1) phase_p4_sel(p, lds);
                    if ((sub & 4) && layer > 0 && half == 0) { phase_pw(p, layer, ldsh, 4, half); __syncthreads(); }
                    if (sub & 2) phase_p4(p, ldsh, half);
                    if ((sub & 4) && layer > 0 && half == 1) { __syncthreads(); phase_pw(p, layer, ldsh, 4, half); } } break;
            case 5: phase_g2(p, lds); break;
            case 6: phase_g3(p, layer, lds); break;
            case 7: phase_ln1(p, layer, ldsh, ((p.rep_mask >> 7) & 1) && !second, half); if (!second && layer + 1 < NLAYER) { __syncthreads(); phase_pw(p, layer + 1, ldsh, 2, half); } break;
            case 8: phase_m2(p, layer, lds); break;
            case 9: phase_m3(p, layer, lds); break;
            case 10: phase_ln2(p, layer, half); break;
        }

        if (ph + 1 < p.ph_hi) { if (ph == p.ph_lo && !second) cg::this_grid().sync(); else xcd_barrier(xbar); }
        if (((p.rep_mask >> k) & 1) && !second) { second = true; --ph; } else second = false;
    }
}

extern "C" void kernel_launch(void* const* d_in, const int* in_sizes, int n_in, void* d_out, int out_size, void* d_ws, size_t ws_size, hipStream_t stream) {
    static int grid = 0;
    if (grid == 0) {
        if (n_in != 18 || ws_size < WS_END) { fprintf(stderr, "kernel_launch: unexpected n_in %d or ws_size %zu < %zu\n", n_in, ws_size, (size_t)WS_END); grid = -1; return; }
        int dev = 0, cus = 0, per_cu = 0;
        hipGetDevice(&dev); hipDeviceGetAttribute(&cus, hipDeviceAttributeMultiprocessorCount, dev);
        hipFuncSetAttribute((const void*)mega, hipFuncAttributeMaxDynamicSharedMemorySize, LDS_BYTES);
        hipOccupancyMaxActiveBlocksPerMultiprocessor(&per_cu, (const void*)mega, NTHREADS, LDS_BYTES);
        if (per_cu < 1) per_cu = 1;
        if (per_cu > 1) per_cu = 1;
        grid = cus * per_cu;
        (void)hipGetLastError();
    }
    if (grid < 0) return;
    Params p{};
    p.x = (const float*)d_in[0]; p.w_in = (const float*)d_in[1]; p.cmp_pos = (const float*)d_in[2]; p.cmp_w1 = (const float*)d_in[3]; p.cmp_w2 = (const float*)d_in[4];
    p.w_br_a = (const float*)d_in[5]; p.w_br_b = (const float*)d_in[6]; p.w_o = (const float*)d_in[7]; p.ln1_g = (const float*)d_in[8]; p.ln1_b = (const float*)d_in[9];
    p.w_router = (const float*)d_in[10]; p.router_bias = (const float*)d_in[11]; p.w_gate = (const float*)d_in[12]; p.w_up = (const float*)d_in[13]; p.w_down = (const float*)d_in[14];
    p.ln2_g = (const float*)d_in[15]; p.ln2_b = (const float*)d_in[16]; p.rel_bias = (const float*)d_in[17];
    p.out = (float*)d_out; p.ws = (unsigned char*)d_ws; p.rep_mask = REPEAT_MASK;
#if SINGLE_LAUNCH
    hipMemsetAsync((unsigned char*)d_ws + WS_CTL + (size_t)CW_BAR * 4, 0, XCD_BAR_WORDS * 4, stream);
    p.ph_lo = 0; p.ph_hi = N_PHASES;
    void* args[] = {&p};
    hipError_t e = hipLaunchCooperativeKernel((const void*)mega, dim3(grid), dim3(NTHREADS), args, LDS_BYTES, stream);
    if (e != hipSuccess) fprintf(stderr, "cooperative launch failed: %s (grid %d)\n", hipGetErrorString(e), grid);
#else
    for (int ph = 0; ph < N_PHASES; ++ph) {
        p.ph_lo = ph; p.ph_hi = ph + 1;
        hipLaunchKernelGGL(mega, dim3(grid), dim3(NTHREADS), LDS_BYTES, stream, p);
    }
#endif
}
```

```cpp
#include <hip/hip_runtime.h>
#include <hip/hip_cooperative_groups.h>
#include <cstdio>
#include <cstdint>
namespace cg = cooperative_groups;

#ifndef REPEAT_MASK
#define REPEAT_MASK 0
#endif
#ifndef SINGLE_LAUNCH
#define SINGLE_LAUNCH 1
#endif

typedef unsigned short bf16_t;
typedef short bf16x8 __attribute__((ext_vector_type(8)));
typedef float f32x4 __attribute__((ext_vector_type(4)));
typedef unsigned u32x2 __attribute__((ext_vector_type(2)));
typedef unsigned u32x4 __attribute__((ext_vector_type(4)));

constexpr int B_ = 2, S_ = 8192, D_ = 1024, T_ = B_ * S_, NLAYER = 4;
constexpr int DIN = 6424;
constexpr int LD = 5376;
constexpr int NW = 6656;
constexpr int C_QA = 0, C_KC = 512, C_VC = 640, C_KS = 768, C_KW = 896, C_QR = 1024, C_KR = 1536, C_GR = 2048, C_MA = 3072, C_MB = 4096, C_GA = 5120,
              C_VS = 5376, C_VW = 5504, C_VR = 5632;
constexpr float DN_ALPHA = 1.681792830507429f;
constexpr int NE = 16;

constexpr size_t al256(size_t x) { return (x + 255) & ~(size_t)255; }
constexpr size_t WS_CTL = 0;
constexpr size_t WS_BUCKET = 65536;
constexpr size_t WS_ROPE = WS_BUCKET + 8192;
constexpr size_t WS_WIN = WS_ROPE + (size_t)8192 * 32 * 8;
constexpr size_t WS_WA = WS_WIN + (size_t)NW * 1024 * 2;
constexpr size_t WS_WB = WS_WA + (size_t)1024 * 512 * 2;
constexpr size_t WS_WO = WS_WB + (size_t)1024 * 1024 * 2;
constexpr size_t WS_WG = WS_WO + (size_t)1024 * 1024 * 2;
constexpr size_t WS_WU = WS_WG + (size_t)16 * 512 * 1024 * 2;
constexpr size_t WS_WD = WS_WU + (size_t)16 * 512 * 1024 * 2;
constexpr size_t WS_XB = WS_WD + (size_t)16 * 512 * 1024 * 2;
constexpr size_t WS_X = WS_XB + (size_t)T_ * 1024 * 2;
constexpr size_t WS_MG = WS_X + (size_t)T_ * 1024 * 4;
constexpr size_t WS_KCC = WS_MG + (size_t)T_ * 1024 * 2;
constexpr size_t WS_VCCT = WS_KCC + (size_t)4 * 512 * 64 * 2;
constexpr size_t WS_W1T = WS_VCCT + (size_t)4 * 512 * 64 * 2;
constexpr size_t WS_B1 = WS_W1T + (size_t)2 * 64 * 2048 * 2;
constexpr size_t WS_R = WS_B1 + 1024;
constexpr size_t WS_P = WS_R;
constexpr size_t WS_VST = WS_P + (size_t)T_ * LD * 2;
constexpr size_t WS_VWT = WS_VST + (size_t)4 * 64 * S_ * 2;
constexpr size_t WS_VRT = WS_VWT + (size_t)4 * 64 * S_ * 2;
constexpr size_t WS_KVT = WS_VRT + (size_t)16 * 128 * S_ * 2;
constexpr size_t WS_SPT = WS_KVT + (size_t)16 * 64 * 8192 * 4;
constexpr size_t WS_YC = WS_SPT + (size_t)16 * 64 * 8192 * 2;
constexpr size_t WS_YW = WS_YC + (size_t)T_ * 512 * 2;
constexpr size_t WS_YA = WS_YW + (size_t)T_ * 512 * 2;
constexpr size_t WS_YB = WS_YA + (size_t)T_ * 512 * 2;
constexpr size_t WS_SELW = WS_YB + (size_t)T_ * 1024 * 2;
constexpr size_t WS_ENDA = WS_SELW + (size_t)T_ * 2 * 4 * 4;
constexpr size_t WS_H1 = WS_R;
constexpr size_t WS_X1 = WS_H1 + (size_t)T_ * 1024 * 4;
constexpr size_t WS_X1B = WS_X1 + (size_t)T_ * 1024 * 4;
constexpr size_t WS_HB = WS_X1B + (size_t)T_ * 1024 * 2;
constexpr size_t WS_CT = WS_HB + (size_t)2 * T_ * 512 * 2;
constexpr size_t WS_LIST = WS_CT + (size_t)2 * T_ * 1024 * 2;
constexpr size_t WS_WTS = WS_LIST + (size_t)16 * T_ * 4;
constexpr size_t WS_ENDB = WS_WTS + (size_t)2 * T_ * 4;
static_assert(WS_HB + (size_t)2 * T_ * 512 * 2 <= WS_CT, "view B overlap");
constexpr size_t WS_END = WS_ENDA > WS_ENDB ? WS_ENDA : WS_ENDB;

constexpr int CW_CNT = 4096;
constexpr int CW_BAR = 8192;

constexpr int HALF_LDS = 75776, LDS_BYTES = 2 * HALF_LDS + 16;
constexpr int NTHREADS = 512, HT = 256;

struct Params {
    const float* x; const float* w_in; const float* cmp_pos; const float* cmp_w1; const float* cmp_w2;
    const float* w_br_a; const float* w_br_b; const float* w_o; const float* ln1_g; const float* ln1_b;
    const float* w_router; const float* router_bias; const float* w_gate; const float* w_up; const float* w_down;
    const float* ln2_g; const float* ln2_b; const float* rel_bias;
    float* out; unsigned char* ws;
    int ph_lo, ph_hi, rep_mask, pad_;
};

__device__ __forceinline__ bf16_t f2bf(float f) { unsigned u = __float_as_uint(f); u += 0x7fffu + ((u >> 16) & 1u); return (bf16_t)(u >> 16); }
__device__ __forceinline__ float bf2f(unsigned h) { return __uint_as_float(h << 16); }
typedef __bf16 bf16x2_t __attribute__((ext_vector_type(2)));
typedef float f32x2_t __attribute__((ext_vector_type(2)));
__device__ __forceinline__ unsigned pack2(float lo, float hi) { const f32x2_t f = {lo, hi}; return __builtin_bit_cast(unsigned, __builtin_convertvector(f, bf16x2_t)); }
__device__ __forceinline__ u32x2 pack4(f32x4 v) { u32x2 r; r.x = pack2(v[0], v[1]); r.y = pack2(v[2], v[3]); return r; }
__device__ __forceinline__ f32x4 unpack4(u32x2 u) { f32x4 r; r[0] = bf2f(u.x & 0xffffu); r[1] = bf2f(u.x >> 16); r[2] = bf2f(u.y & 0xffffu); r[3] = bf2f(u.y >> 16); return r; }
__device__ __forceinline__ float rows_max(float v) {
    u32x2 r = __builtin_amdgcn_permlane16_swap(__float_as_uint(v), __float_as_uint(v), false, false);
    v = fmaxf(__uint_as_float(r.x), __uint_as_float(r.y));
    r = __builtin_amdgcn_permlane32_swap(__float_as_uint(v), __float_as_uint(v), false, false);
    return fmaxf(__uint_as_float(r.x), __uint_as_float(r.y));
}
__device__ __forceinline__ float rows_sum(float v) {
    u32x2 r = __builtin_amdgcn_permlane16_swap(__float_as_uint(v), __float_as_uint(v), false, false);
    v = __uint_as_float(r.x) + __uint_as_float(r.y);
    r = __builtin_amdgcn_permlane32_swap(__float_as_uint(v), __float_as_uint(v), false, false);
    return __uint_as_float(r.x) + __uint_as_float(r.y);
}
__device__ __forceinline__ float wave_sum(float v) {
    v += __int_as_float(__builtin_amdgcn_ds_swizzle(__float_as_int(v), 0x041F));
    v += __int_as_float(__builtin_amdgcn_ds_swizzle(__float_as_int(v), 0x081F));
    v += __int_as_float(__builtin_amdgcn_ds_swizzle(__float_as_int(v), 0x101F));
    v += __int_as_float(__builtin_amdgcn_ds_swizzle(__float_as_int(v), 0x201F));
    v += __int_as_float(__builtin_amdgcn_ds_swizzle(__float_as_int(v), 0x401F));
    const u32x2 r = __builtin_amdgcn_permlane32_swap(__float_as_uint(v), __float_as_uint(v), false, false);
    return __uint_as_float(r.x) + __uint_as_float(r.y);
}
__device__ __forceinline__ float sigmoidf_(float x) { return 1.f / (1.f + __expf(-x)); }
__device__ __forceinline__ int ltid() { int t = threadIdx.x; asm volatile("" : "+v"(t)); return t; }
__device__ __forceinline__ int vzero() { int z; asm volatile("v_mov_b32 %0, 0" : "=v"(z)); return z; }
__device__ __forceinline__ unsigned char* launder(unsigned char* q) { asm volatile("" : "+s"(q)); return q; }
__device__ __forceinline__ void wait_vm0() { asm volatile("s_waitcnt vmcnt(0)" ::: "memory"); }

__device__ __forceinline__ void glds16(const void* g, void* l) {
    __builtin_amdgcn_global_load_lds((const __attribute__((address_space(1))) unsigned*)g,
                                     (__attribute__((address_space(3))) unsigned*)l, 16, 0, 0);
}
__device__ __forceinline__ f32x4 mfma16(bf16x8 a, bf16x8 b, f32x4 c) { return __builtin_amdgcn_mfma_f32_16x16x32_bf16(a, b, c, 0, 0, 0); }

#define WAIT_V(n) asm volatile("s_waitcnt vmcnt(%0)" ::"n"(n) : "memory")
#define RAW_BARRIER() do { asm volatile("s_waitcnt lgkmcnt(0)" ::: "memory"); __builtin_amdgcn_s_barrier(); } while (0)
__device__ __forceinline__ void bglds16(__amdgpu_buffer_rsrc_t r, unsigned voff, int soff, void* l) {
    __builtin_amdgcn_raw_ptr_buffer_load_lds(r, (__attribute__((address_space(3))) void*)l, 16, (int)voff, soff, 0, 0);
}
template <int NJ, bool GN>
__device__ __forceinline__ void gemm8_stage(__amdgpu_buffer_rsrc_t mr, int mld, unsigned mvo, __amdgpu_buffer_rsrc_t nr, int nld, const unsigned (&nvo)[NJ], int kt, unsigned char* st, int wid) {
#pragma unroll
    for (int i = 0; i < 4; ++i) bglds16(mr, mvo, (64 * i * mld + kt * 64) * 2, st + (8 * i + wid) * 1024);
#pragma unroll
    for (int i = 0; i < NJ; ++i) bglds16(nr, nvo[i], ((GN ? 0 : 64 * i * nld) + kt * 64) * 2, st + 32768 + (8 * i + wid) * 1024);
}
template <int NJ, bool GN>
__device__ __forceinline__ void gemm8_kloop(const bf16_t* mb, int mld, unsigned mvo, const bf16_t* nb, int nld, const unsigned (&nvo)[NJ], int nk, unsigned char* lds, f32x4 (&acc)[8][NJ], int tid) {
    const int lane = tid & 63, wid = tid >> 6, wr = wid >> 2, wc = wid & 3, fr = lane & 15, fq = lane >> 4;
    const __amdgpu_buffer_rsrc_t mr = __builtin_amdgcn_make_buffer_rsrc((void*)mb, 0, 0x7fffffff, 0x00020000);
    const __amdgpu_buffer_rsrc_t nr = __builtin_amdgcn_make_buffer_rsrc((void*)nb, 0, 0x7fffffff, 0x00020000);
    gemm8_stage<NJ, GN>(mr, mld, mvo, nr, nld, nvo, 0, lds, wid);
    gemm8_stage<NJ, GN>(mr, mld, mvo, nr, nld, nvo, 1, lds + 65536, wid);
    for (int kt = 0; kt < nk; ++kt) {
        unsigned char* cur = lds + (kt & 1) * 65536;
        if (kt + 1 < nk) WAIT_V(4 + NJ); else WAIT_V(0);
        RAW_BARRIER();
        bf16x8 a[4], b[NJ];
        const unsigned char* ab = cur + (128 * wr + fr) * 128;
        const unsigned char* bb = cur + 32768 + (16 * NJ * wc + fr) * 128;
        const int sw0 = ((fq) ^ (fr & 7)) << 4, sw1 = ((4 + fq) ^ (fr & 7)) << 4;
#pragma unroll
        for (int j = 0; j < NJ; ++j) b[j] = *(const bf16x8*)(bb + j * 2048 + sw0);
#pragma unroll
        for (int mh = 0; mh < 2; ++mh) {
#pragma unroll
            for (int i = 0; i < 4; ++i) a[i] = *(const bf16x8*)(ab + (4 * mh + i) * 2048 + sw0);
#pragma unroll
            for (int i = 0; i < 4; ++i)
#pragma unroll
                for (int j = 0; j < NJ; ++j) acc[4 * mh + i][j] = mfma16(a[i], b[j], acc[4 * mh + i][j]);
        }
#pragma unroll
        for (int j = 0; j < NJ; ++j) b[j] = *(const bf16x8*)(bb + j * 2048 + sw1);
#pragma unroll
        for (int i = 0; i < 4; ++i) a[i] = *(const bf16x8*)(ab + i * 2048 + sw1);
#pragma unroll
        for (int i = 0; i < 4; ++i)
#pragma unroll
            for (int j = 0; j < NJ; ++j) acc[i][j] = mfma16(a[i], b[j], acc[i][j]);
#pragma unroll
        for (int i = 0; i < 4; ++i) a[i] = *(const bf16x8*)(ab + (4 + i) * 2048 + sw1);
        RAW_BARRIER();
        if (kt + 2 < nk) gemm8_stage<NJ, GN>(mr, mld, mvo, nr, nld, nvo, kt + 2, cur, wid);
#pragma unroll
        for (int i = 0; i < 4; ++i)
#pragma unroll
            for (int j = 0; j < NJ; ++j) acc[4 + i][j] = mfma16(a[i], b[j], acc[4 + i][j]);
    }
    __syncthreads();
    __builtin_amdgcn_sched_barrier(0);
}
template <int NJ>
__device__ __forceinline__ void zero_acc8(f32x4 (&acc)[8][NJ]) {
#pragma unroll
    for (int i = 0; i < 8; ++i)
#pragma unroll
        for (int j = 0; j < NJ; ++j) acc[i][j] = (f32x4){0.f, 0.f, 0.f, 0.f};
}

namespace pg8 {
#define PG8_LAS __attribute__((address_space(3)))
constexpr int BM = 256, BK = 64, HALF = 128, HTB = HALF * BK * 2, STAGE_BYTES = 8 * HTB;
__device__ __forceinline__ int lds_byte(int r, int c) { const int st = (r >> 4) * 2 + (c >> 5), rr = r & 15, cc = c & 31, ob = rr * 64 + cc * 2; return st * 1024 + (ob ^ (((ob >> 9) & 1) << 5)); }
__device__ __forceinline__ void stage_rc(int b, int& R, int& C) { const int st = b / 1024, sb = b % 1024, swz = sb ^ (((sb >> 9) & 1) << 5); R = (st >> 1) * 16 + swz / 64; C = (st & 1) * 32 + (swz % 64) / 2; }
__device__ __forceinline__ int perm32(int rho) { const int n = rho >> 4, i = rho & 15; return 8 * (i >> 2) + 4 * n + (i & 3); }
struct Unit { int pm, pn; };
template <class Epi, class Sched>
__device__ __forceinline__ void gemm_phase(unsigned char* lds_, const int K, const Sched& S, const Epi& E, const int tid, const unsigned char* wsbase) {
    PG8_LAS unsigned char* lds = (PG8_LAS unsigned char*)lds_;
    const int wid = __builtin_amdgcn_readfirstlane(tid >> 6), lane = tid & 63, wr = wid >> 2, wc = wid & 3, fr = lane & 15, fq = lane >> 4;
    const int nt = K / BK;
    unsigned voffA[2], voffB[2];
#pragma unroll
    for (int i = 0; i < 2; ++i) { int R, C; stage_rc(tid * 16 + i * 8192, R, C); const int Rb = (R & ~31) + perm32(R & 31);
        voffA[i] = (unsigned)(R * K + C) * 2u; voffB[i] = (unsigned)(Rb * K + C) * 2u; }
    const unsigned kstep = (unsigned)(BK * 2);
    const unsigned hstep = (unsigned)HALF * K * 2;
    const __amdgpu_buffer_rsrc_t rsrc = __builtin_amdgcn_make_buffer_rsrc((void*)wsbase, 0, 0x7fffffff, 0x00020000);
    const unsigned ldsw = (unsigned)wid * 1024u;
    const int aoff = lds_byte(wr * 64 + fr, fq * 8), boff = lds_byte(wc * 32 + fr, fq * 8);
#define PG8_SA(b, h) (((b) * 2 + (h)) * HTB)
#define PG8_SB(b, h) ((4 + (b) * 2 + (h)) * HTB)
#define PG8_STAGE(bufoff, gbase, voff) do { _Pragma("unroll") for (int _i = 0; _i < 2; ++_i) \
        __builtin_amdgcn_raw_ptr_buffer_load_lds(rsrc, (PG8_LAS void*)(lds + (bufoff) + ldsw + _i * 8192), 16, (int)(voff)[_i], (int)(gbase), 0, 0); } while (0)
#define PG8_LDA(dst, b, h) do { _Pragma("unroll") for (int m = 0; m < 4; ++m) _Pragma("unroll") for (int k = 0; k < 2; ++k) dst[m][k] = *(const PG8_LAS bf16x8*)(lds + PG8_SA(b, h) + aoff + m * 2048 + k * 1024); } while (0)
#define PG8_LDB(dst, b, h) do { _Pragma("unroll") for (int n = 0; n < 2; ++n) _Pragma("unroll") for (int k = 0; k < 2; ++k) dst[n][k] = *(const PG8_LAS bf16x8*)(lds + PG8_SB(b, h) + boff + n * 2048 + k * 1024); } while (0)
#define PG8_MMA(ai, bj, At, Bt) do { __builtin_amdgcn_s_setprio(1); _Pragma("unroll") for (int m = 0; m < 4; ++m) _Pragma("unroll") for (int n = 0; n < 2; ++n) _Pragma("unroll") for (int k = 0; k < 2; ++k) \
        acc[ai][bj][m][n] = __builtin_amdgcn_mfma_f32_16x16x32_bf16(Bt[n][k], At[m][k], acc[ai][bj][m][n], 0, 0, 0); __builtin_amdgcn_s_setprio(0); } while (0)
#define PG8_WAIT_V(n) asm volatile("s_waitcnt vmcnt(" #n ")" ::: "memory")
#define PG8_WAIT_L(n) asm volatile("s_waitcnt lgkmcnt(" #n ")" ::: "memory")
#define PG8_BAR __builtin_amdgcn_s_barrier()
#define PG8_SCHED __builtin_amdgcn_sched_barrier(0)
    typename Sched::U cur, nxt; int ui = 0;
    if (!S.next(0, cur)) return;
    unsigned cA, cB; S.ptrs(cur, cA, cB);
    constexpr bool GA = Sched::GATHER;
    unsigned vA[GA ? 2 : 1][2], nvA[GA ? 2 : 1][2];
    if constexpr (GA) { S.rows(cur, tid, vA);
#pragma unroll
        for (int h = 0; h < 2; ++h)
#pragma unroll
            for (int i = 0; i < 2; ++i) nvA[h][i] = vA[h][i]; }
#define PG8_STAGE_A(bufoff, gbase, h, nextu) do { if constexpr (GA) { if (nextu) PG8_STAGE(bufoff, gbase, nvA[h]); else PG8_STAGE(bufoff, gbase, vA[h]); } \
        else PG8_STAGE(bufoff, (gbase) + (h) * hstep, voffA); } while (0)
    PG8_STAGE(PG8_SB(0, 0), cB, voffB); PG8_STAGE_A(PG8_SA(0, 0), cA, 0, false); PG8_STAGE(PG8_SB(0, 1), cB + hstep, voffB); PG8_STAGE_A(PG8_SA(0, 1), cA, 1, false);
    if (wr == 1) PG8_BAR;
    PG8_WAIT_V(4); PG8_BAR;
    PG8_STAGE(PG8_SB(1, 0), cB + kstep, voffB); PG8_STAGE_A(PG8_SA(1, 0), cA + kstep, 0, false); PG8_STAGE(PG8_SB(1, 1), cB + hstep + kstep, voffB);
    PG8_WAIT_V(6); PG8_BAR;
    PG8_SCHED;
    f32x4 acc[2][2][4][2];
#pragma unroll
    for (int a = 0; a < 2; ++a)
#pragma unroll
        for (int b = 0; b < 2; ++b)
#pragma unroll
            for (int m = 0; m < 4; ++m)
#pragma unroll
                for (int n = 0; n < 2; ++n) acc[a][b][m][n] = (f32x4){0.f, 0.f, 0.f, 0.f};
    bf16x8 At[4][2], B0[2][2], B1[2][2];
    for (;;) {
        const bool has_next = S.next(ui + 1, nxt);
        unsigned nA = cA, nB = cB; if (has_next) S.ptrs(nxt, nA, nB);
        if constexpr (GA) { if (has_next) S.rows(nxt, tid, nvA); }
        for (int t = 0; t < nt; t += 2) {
            const bool last = (t == nt - 2);
            const unsigned a1 = cA + (unsigned)(t + 1) * kstep;
            const unsigned a2 = last ? nA : cA + (unsigned)(t + 2) * kstep, b2 = last ? nB : cB + (unsigned)(t + 2) * kstep;
            const unsigned a3 = a2 + kstep, b3 = b2 + kstep;
            PG8_LDB(B0, 0, 0); PG8_SCHED; PG8_LDA(At, 0, 0); PG8_STAGE_A(PG8_SA(1, 1), a1, 1, false);
            PG8_WAIT_L(8); PG8_BAR; PG8_WAIT_L(0); PG8_MMA(0, 0, At, B0); PG8_BAR; PG8_SCHED;
            PG8_LDB(B1, 0, 1); PG8_STAGE(PG8_SB(0, 0), b2, voffB);
            PG8_BAR; PG8_WAIT_L(0); PG8_MMA(0, 1, At, B1); PG8_BAR;
            PG8_LDA(At, 0, 1); PG8_STAGE_A(PG8_SA(0, 0), a2, 0, last);
            PG8_BAR; PG8_WAIT_L(0); PG8_MMA(1, 0, At, B0); PG8_BAR; PG8_SCHED;
            PG8_STAGE(PG8_SB(0, 1), b2 + hstep, voffB);
            PG8_WAIT_V(6); PG8_BAR; PG8_MMA(1, 1, At, B1); PG8_BAR;
            PG8_LDB(B0, 1, 0); PG8_SCHED; PG8_LDA(At, 1, 0); PG8_STAGE_A(PG8_SA(0, 1), a2, 1, last);
            PG8_WAIT_L(8); PG8_BAR; PG8_WAIT_L(0); PG8_MMA(0, 0, At, B0); PG8_BAR; PG8_SCHED;
            PG8_LDB(B1, 1, 1); PG8_STAGE(PG8_SB(1, 0), b3, voffB);
            PG8_BAR; PG8_WAIT_L(0); PG8_MMA(0, 1, At, B1); PG8_BAR;
            PG8_LDA(At, 1, 1); PG8_STAGE_A(PG8_SA(1, 0), a3, 0, last);
            PG8_BAR; PG8_WAIT_L(0); PG8_MMA(1, 0, At, B0); PG8_BAR; PG8_SCHED;
            PG8_STAGE(PG8_SB(1, 1), b3 + hstep, voffB);
            PG8_WAIT_V(6); PG8_BAR; PG8_MMA(1, 1, At, B1); PG8_BAR;
        }
        E(acc, cur, wr, wc, fr, fq);
        if (!has_next) break;
#pragma unroll
        for (int a = 0; a < 2; ++a)
#pragma unroll
            for (int b = 0; b < 2; ++b)
#pragma unroll
                for (int m = 0; m < 4; ++m)
#pragma unroll
                    for (int n = 0; n < 2; ++n) acc[a][b][m][n] = (f32x4){0.f, 0.f, 0.f, 0.f};
        cur = nxt; cA = nA; cB = nB; ++ui;
        if constexpr (GA) {
#pragma unroll
            for (int h = 0; h < 2; ++h)
#pragma unroll
                for (int i = 0; i < 2; ++i) vA[h][i] = nvA[h][i]; }
    }
    PG8_WAIT_V(0);
    if (wr == 0) PG8_BAR;
    PG8_BAR;
#undef PG8_SA
#undef PG8_SB
#undef PG8_STAGE
#undef PG8_STAGE_A
#undef PG8_LDA
#undef PG8_LDB
#undef PG8_MMA
#undef PG8_WAIT_V
#undef PG8_WAIT_L
#undef PG8_BAR
#undef PG8_SCHED
}
}

struct TJob { const float* src; bf16_t* dst; int ld, k0, n0, mode, kdst; };
__device__ __forceinline__ void tcvt_load(const TJob& J, float4 (&v)[4], int tid) {
#pragma unroll
    for (int i = 0; i < 4; ++i) {
        const int kk = (tid >> 4) + 16 * i, c4 = (tid & 15) * 4, cd = J.n0 + c4;
        int orig = cd; bool ok = true;
        if (J.mode == 1) {
            if (cd < 896) orig = cd;
            else if (cd < 1024) orig = cd - 896 + 1024;
            else if (cd < 2048) { const int q = cd - 1024, hd = q >> 6, pp = q & 63;
                const int d = (pp & 4) ? 32 + 4 * (pp >> 3) + (pp & 3) : 4 * (pp >> 3) + (pp & 3);
                orig = 1304 + hd * 64 + d; }
            else if (cd < 5120) orig = cd - 2048 + 3352;
            else if (cd < 5144) orig = cd - 5120 + 1280;
            else if (cd < 5376) ok = false;
            else if (cd < 5504) orig = cd - 5376 + 896;
            else if (cd < 5632) orig = cd - 5504 + 1152;
            else orig = cd - 5632 + 2328;
        }
        v[i] = make_float4(0.f, 0.f, 0.f, 0.f);
        if (ok) v[i] = *(const float4*)(J.src + (size_t)(J.k0 + kk) * J.ld + orig);
    }
}
__device__ __forceinline__ void tcvt_finish(const TJob& J, const float4 (&v)[4], unsigned char* lds, int tid) {
    float* tile = (float*)lds;
#pragma unroll
    for (int i = 0; i < 4; ++i) {
        const int kk = (tid >> 4) + 16 * i, c4 = (tid & 15) * 4;
        tile[kk * 65 + c4 + 0] = v[i].x; tile[kk * 65 + c4 + 1] = v[i].y; tile[kk * 65 + c4 + 2] = v[i].z; tile[kk * 65 + c4 + 3] = v[i].w;
    }
    __syncthreads();
#pragma unroll
    for (int i = 0; i < 2; ++i) {
        const int q = tid + 256 * i, n = q >> 3, kc = q & 7;
        float x[8];
#pragma unroll
        for (int j = 0; j < 8; ++j) x[j] = tile[(kc * 8 + j) * 65 + n];
        u32x4 w; w.x = pack2(x[0], x[1]); w.y = pack2(x[2], x[3]); w.z = pack2(x[4], x[5]); w.w = pack2(x[6], x[7]);
        int drow = J.n0 + n; if (J.mode >= 2) drow = 8 * (drow >> 2) + (drow & 3) + (J.mode == 3 ? 4 : 0);
        *(u32x4*)(J.dst + (size_t)drow * J.kdst + J.k0 + kc * 8) = w;
    }
    __syncthreads();
}
__device__ __forceinline__ void tcvt_tile(const float* src, int ld_src, int k0, int n0, int mode, bf16_t* dst, int kdst, unsigned char* lds, int half) {
    TJob J; J.src = src; J.dst = dst; J.ld = ld_src; J.k0 = k0; J.n0 = n0; J.mode = mode; J.kdst = kdst;
    const int tid = (ltid() & 255); float4 v[4];
    tcvt_load(J, v, tid); tcvt_finish(J, v, lds, tid);
}

__device__ __forceinline__ void tcvt_decode(const Params& p, unsigned char* ws, int layer, int t, TJob& J) {
    constexpr int J0 = 16 * 104, J1 = 8 * 16, J2 = 256, J3 = 256, J4 = 2048, J5 = 2048;
    int u = t;
        if (u < J0) { J.src = p.w_in + (size_t)layer * 1024 * DIN; J.ld = DIN; J.k0 = (u % 16) * 64; J.n0 = (u / 16) * 64; J.mode = 1; J.dst = (bf16_t*)(ws + WS_WIN); J.kdst = 1024; return; }
        u -= J0;
        if (u < J1) { J.src = p.w_br_a + (size_t)layer * 512 * 1024; J.ld = 1024; J.k0 = (u % 8) * 64; J.n0 = (u / 8) * 64; J.mode = 0; J.dst = (bf16_t*)(ws + WS_WA); J.kdst = 512; return; }
        u -= J1;
        if (u < J2) { J.src = p.w_br_b + (size_t)layer * 1024 * 1024; J.ld = 1024; J.k0 = (u % 16) * 64; J.n0 = (u / 16) * 64; J.mode = 0; J.dst = (bf16_t*)(ws + WS_WB); J.kdst = 1024; return; }
        u -= J2;
        if (u < J3) { J.src = p.w_o + (size_t)layer * 1024 * 1024; J.ld = 1024; J.k0 = (u % 16) * 64; J.n0 = (u / 16) * 64; J.mode = 0; J.dst = (bf16_t*)(ws + WS_WO); J.kdst = 1024; return; }
        u -= J3;
        if (u < J4 + J5) {
            const bool up = u >= J4; if (up) u -= J4;
            const int e = u / 128, v = u % 128;
            J.src = (up ? p.w_up : p.w_gate) + ((size_t)layer * NE + e) * 1024 * 512; J.ld = 512; J.k0 = (v % 16) * 64; J.n0 = (v / 16) * 64; J.mode = up ? 3 : 2;
            J.dst = (bf16_t*)(ws + WS_WG) + (size_t)e * 1024 * 1024; J.kdst = 1024; return;
        }
        u -= J4 + J5;
        { const int e = u / 128, v = u % 128;
          J.src = p.w_down + ((size_t)layer * NE + e) * 512 * 1024; J.ld = 1024; J.k0 = (v % 8) * 64; J.n0 = (v / 8) * 64; J.mode = 0; J.dst = (bf16_t*)(ws + WS_WD) + (size_t)e * 1024 * 512; J.kdst = 512; }
}


__device__ __forceinline__ void phase_pw(const Params& p, int layer, unsigned char* lds, int parts, int half, int skip = 0) {
    if ((int)(blockIdx.x * 2 + half) < skip) return;
    const int bid = (blockIdx.x * 2 + half) - skip, nblk = (gridDim.x * 2) - skip, tid = (ltid() & 255);
    unsigned char* ws = launder(p.ws);
    constexpr int J0 = 16 * 104, J1 = 8 * 16, J2 = 256, J3 = 256, J4 = 2048, J5 = 2048, J6 = 2048, JT = J0 + J1 + J2 + J3 + J4 + J5 + J6;
    const int t_lo = (parts & 1) ? 0 : (parts & 2) ? J0 : J0 + J1 + J2 + J3;
    const int t_hi = (parts & 4) ? JT : (parts & 2) ? J0 + J1 + J2 + J3 : (parts & 1) ? J0 : 0;
    if (t_lo + bid < t_hi) {
        float4 v[4]; { TJob J; tcvt_decode(p, ws, layer, t_lo + bid, J); tcvt_load(J, v, tid); }
        for (int t = t_lo + bid; t < t_hi; t += nblk) {
            float4 vn[4];
            if (t + nblk < t_hi) { TJob J; tcvt_decode(p, ws, layer, t + nblk, J); tcvt_load(J, vn, tid); }
            { TJob J; tcvt_decode(p, ws, layer, t, J); tcvt_finish(J, v, lds, tid); }
#pragma unroll
            for (int i = 0; i < 4; ++i) v[i] = vn[i];
        }
    }
    if (parts & 16) {
    for (int t = bid; t < 64; t += nblk) {
        const int kv = t >> 5, kt = t & 31;
        tcvt_tile(p.cmp_w1 + ((size_t)layer * 2 + kv) * 2048 * 64, 64, kt * 64, 0, 0, (bf16_t*)(ws + WS_W1T) + (size_t)kv * 64 * 2048, 2048, lds, half);
    }
    if (bid >= nblk - 2) {
        const int kv = nblk - 1 - bid, n = tid & 63, part = tid >> 6;
        const float* w1 = p.cmp_w1 + ((size_t)layer * 2 + kv) * 2048 * 64; const float* pos = p.cmp_pos + ((size_t)layer * 2 + kv) * 2048;
        float a = 0.f;
        for (int k = part * 512; k < part * 512 + 512; ++k) a += pos[k] * w1[(size_t)k * 64 + n];
        float* red = (float*)lds;
        __syncthreads(); red[tid] = a; __syncthreads();
        if (tid < 64) ((float*)(ws + WS_B1))[kv * 64 + tid] = red[tid] + red[tid + 64] + red[tid + 128] + red[tid + 192];
        __syncthreads();
    }
    }
    if (parts & 8) {
        const float4* xs = (const float4*)p.x; u32x2* xb = (u32x2*)(ws + WS_XB);
        for (size_t i = (size_t)bid * HT + tid; i < (size_t)T_ * 1024 / 4; i += (size_t)nblk * HT) {
            float4 v = xs[i]; u32x2 w; w.x = pack2(v.x, v.y); w.y = pack2(v.z, v.w); xb[i] = w;
        }
        for (int n = bid * HT + tid; n < 8192; n += nblk * HT) {
            int bk;
            if (n < 16) bk = n;
            else { const int th[15] = {22, 30, 40, 54, 73, 99, 134, 182, 246, 332, 450, 609, 825, 1117, 1513}; bk = 16;
#pragma unroll
                for (int k = 0; k < 15; ++k) bk += (n >= th[k]) ? 1 : 0; }
            (ws + WS_BUCKET)[n] = (unsigned char)bk;
        }
        for (int i = bid * HT + tid; i < 8192 * 32; i += nblk * HT) {
            const int pos = i >> 5, d = i & 31;
            const float inv = powf(10000.f, -(float)d * 2.0f / 64.f);
            const float ang = (float)pos * inv;
            float sn, cs; sincosf(ang, &sn, &cs);
            ((float2*)(ws + WS_ROPE))[i] = make_float2(cs, sn);
        }
        if (bid == 0) for (int i = tid; i < 8192; i += HT) ((unsigned*)(ws + WS_CTL))[i] = 0u;
    }
}

__device__ __forceinline__ float fsig(float x) { return __builtin_amdgcn_rcpf(1.f + __builtin_amdgcn_exp2f(-1.4426950408889634f * x)); }
template <int KIND>
__device__ __forceinline__ void g1_epi(const f32x4 (&acc)[2][2][4][2], unsigned char* ws, int r0, int c0, int wr, int wc, int fr, int fq) {
#pragma unroll
    for (int ai = 0; ai < 2; ++ai)
#pragma unroll
        for (int m = 0; m < 4; ++m) {
            const int row = r0 + 128 * ai + 64 * wr + 16 * m + fr + vzero();
#pragma unroll
            for (int bj = 0; bj < 2; ++bj) {
                const int col = c0 + 128 * bj + 32 * wc + 8 * fq;
                f32x4 v0 = acc[ai][bj][m][0], v1 = acc[ai][bj][m][1];
                if (KIND == 5) {
                    const int b = col >> 13, sq = col & (S_ - 1);
                    bf16_t* dst;
                    if (row < C_VW) { const int c = row - C_VS; dst = (bf16_t*)(ws + WS_VST) + ((size_t)(b * 2 + (c >> 6)) * 64 + (c & 63)) * S_ + sq; }
                    else if (row < C_VR) { const int c = row - C_VW; dst = (bf16_t*)(ws + WS_VWT) + ((size_t)(b * 2 + (c >> 6)) * 64 + (c & 63)) * S_ + sq; }
                    else { const int c = row - C_VR; dst = (bf16_t*)(ws + WS_VRT) + ((size_t)(b * 8 + (c >> 7)) * 128 + (c & 127)) * S_ + sq; }
                    u32x4 w; w.x = pack2(v0[0], v0[1]); w.y = pack2(v0[2], v0[3]); w.z = pack2(v1[0], v1[1]); w.w = pack2(v1[2], v1[3]);
                    *(u32x4*)dst = w;
                    continue;
                }
                if (KIND == 1 || KIND == 2) {
                    const float2* rope = (const float2*)(ws + WS_ROPE);
                    const int pos = row & (S_ - 1), d = 16 * (wc & 1) + 4 * fq;
                    const float4 cs01 = *(const float4*)(rope + pos * 32 + d), cs23 = *(const float4*)(rope + pos * 32 + d + 2);
                    const float c[4] = {cs01.x, cs01.z, cs23.x, cs23.z}, sn[4] = {cs01.y, cs01.w, cs23.y, cs23.w};
                    const float sc = (KIND == 2) ? 0.125f : 1.0f;
                    f32x4 y1, y2;
#pragma unroll
                    for (int r = 0; r < 4; ++r) { y1[r] = (v0[r] * c[r] - v1[r] * sn[r]) * sc; y2[r] = (v0[r] * sn[r] + v1[r] * c[r]) * sc; }
                    v0 = y1; v1 = y2;
                } else if (KIND == 3) {
#pragma unroll
                    for (int r = 0; r < 4; ++r) { v0[r] = v0[r] * fsig(v0[r]); v1[r] = v1[r] * fsig(v1[r]); }
                } else if (KIND == 4) {
#pragma unroll
                    for (int r = 0; r < 4; ++r) { v0[r] = fsig(v0[r]); v1[r] = fsig(v1[r]); }
                }
                u32x4 w; w.x = pack2(v0[0], v0[1]); w.y = pack2(v0[2], v0[3]); w.z = pack2(v1[0], v1[1]); w.w = pack2(v1[2], v1[3]);
                *(u32x4*)((bf16_t*)(ws + WS_P) + (size_t)row * LD + col) = w;
            }
        }
}
struct G1Order {      typedef pg8::Unit U; static constexpr bool GATHER = false;
    int xcd, slot, per;
    __device__ __forceinline__ bool next(int i, pg8::Unit& u) const {
        const int j = slot + i * per; if (j >= 208) return false;
        if (j < 192) { u.pm = j / 3; u.pn = xcd + 8 * (j % 3); } else { const int q = j - 192; u.pm = 8 * xcd + (q >> 1); u.pn = 24 + (q & 1); }
        return true;
    }
    __device__ __forceinline__ void ptrs(const pg8::Unit& u, unsigned& A, unsigned& B) const {
        const unsigned x = (unsigned)WS_XB + (unsigned)u.pm * (256u * 1024u * 2u), w = (unsigned)WS_WIN + (unsigned)u.pn * (256u * 1024u * 2u);
        if (u.pn >= 21) { A = w; B = x; } else { A = x; B = w; }
    }
};
struct G1Epi {
    unsigned char* ws;
    __device__ __forceinline__ void operator()(const f32x4 (&acc)[2][2][4][2], const pg8::Unit& u, int wr, int wc, int fr, int fq) const {
        const int pn = u.pn, tok0 = u.pm * 256, n0 = pn * 256;
        if (pn >= 21) g1_epi<5>(acc, ws, n0, tok0, wr, wc, fr, fq);
        else if (pn >= 12) g1_epi<4>(acc, ws, tok0, n0, wr, wc, fr, fq);
        else if (pn >= 8) g1_epi<3>(acc, ws, tok0, n0, wr, wc, fr, fq);
        else if (pn >= 6) g1_epi<2>(acc, ws, tok0, n0, wr, wc, fr, fq);
        else if (pn >= 4) g1_epi<1>(acc, ws, tok0, n0, wr, wc, fr, fq);
        else g1_epi<0>(acc, ws, tok0, n0, wr, wc, fr, fq);
    }
};
__device__ __forceinline__ void phase_g1(const Params& p, int layer, unsigned char* lds) {
    unsigned char* ws = launder(p.ws);
    G1Order S; S.xcd = blockIdx.x & 7; S.slot = blockIdx.x >> 3; S.per = gridDim.x >> 3;
    G1Epi E; E.ws = ws;
    pg8::gemm_phase<G1Epi, G1Order>(lds, 1024, S, E, ltid(), ws);
}

__device__ __forceinline__ void load_tile64(const bf16_t* base, size_t rowStride, unsigned char* dst, int wid, int lane) {
    const int c = ((lane & 7) ^ (lane >> 3)) * 8;
#pragma unroll
    for (int i = 0; i < 2; ++i) { const int j = wid + 4 * i, row = 8 * j + (lane >> 3); glds16(base + (size_t)row * rowStride + c, dst + j * 1024); }
}
__device__ __forceinline__ void load_tile128(const bf16_t* base, size_t rowStride, unsigned char* dst, int wid, int lane) {
    const int c = ((lane & 7) ^ (lane >> 3)) * 8;
#pragma unroll
    for (int i = 0; i < 4; ++i) { const int j = wid + 4 * i, row = 8 * j + (lane >> 3); glds16(base + (size_t)row * rowStride + c, dst + j * 1024); }
}
__device__ __forceinline__ void load_tile128w(const bf16_t* base, size_t rowStride, unsigned char* dst, int wid, int lane) {
    const int c = ((lane & 15) ^ ((4 * wid + (lane >> 4)) & 15)) * 8;
#pragma unroll
    for (int i = 0; i < 8; ++i) { const int j = wid + 4 * i, row = 4 * j + (lane >> 4); glds16(base + (size_t)row * rowStride + c, dst + j * 1024); }
}
__device__ __forceinline__ bf16x8 lds_frag128(const unsigned char* tile, int row, int chunk) {
    return *(const bf16x8*)(tile + row * 128 + ((chunk ^ (row & 7)) << 4));
}
__device__ __forceinline__ bf16x8 lds_frag256(const unsigned char* tile, int row, int chunk) {
    return *(const bf16x8*)(tile + row * 256 + ((chunk ^ (row & 15)) << 4));
}
__device__ __forceinline__ bf16x8 lds_vfrag128(const unsigned char* tile, int row, int kbase, int fq) {
    const int ca = (kbase >> 3) + (fq >> 1), hb = (fq & 1) * 8;
    const u32x2 a = *(const u32x2*)(tile + row * 128 + ((ca ^ (row & 7)) << 4) + hb);
    const u32x2 b = *(const u32x2*)(tile + row * 128 + (((ca + 2) ^ (row & 7)) << 4) + hb);
    u32x4 w; w.x = a.x; w.y = a.y; w.z = b.x; w.w = b.y;
    return __builtin_bit_cast(bf16x8, w);
}
__device__ __forceinline__ bf16x8 lds_vfrag256(const unsigned char* tile, int row, int kbase, int fq) {
    const int ca = (kbase >> 3) + (fq >> 1), hb = (fq & 1) * 8;
    const u32x2 a = *(const u32x2*)(tile + row * 256 + ((ca ^ (row & 15)) << 4) + hb);
    const u32x2 b = *(const u32x2*)(tile + row * 256 + (((ca + 2) ^ (row & 15)) << 4) + hb);
    u32x4 w; w.x = a.x; w.y = a.y; w.z = b.x; w.w = b.y;
    return __builtin_bit_cast(bf16x8, w);
}
__device__ __forceinline__ bf16x8 pack8(f32x4 a, f32x4 b) {
    u32x4 w; w.x = pack2(a[0], a[1]); w.y = pack2(a[2], a[3]); w.z = pack2(b[0], b[1]); w.w = pack2(b[2], b[3]);
    return __builtin_bit_cast(bf16x8, w);
}

__device__ __forceinline__ float gelu_tanh(float x) {
    const float u = 0.7978845608028654f * (x + 0.044715f * x * x * x);
    return 0.5f * x * (1.f + tanhf(u));
}
__device__ __forceinline__ void compress_item(const Params& p, int layer, int item, unsigned char* lds, int half) {
    unsigned char* ws = launder(p.ws);
    const int tid = (ltid() & 255), lane = tid & 63, wid = tid >> 6, wr = wid >> 1, wc = wid & 1, fr = lane & 15, fq = lane >> 4;
    const int mtile = item & 3, g = (item >> 2) & 1, b = (item >> 3) & 1, kv = item >> 4;
    const int i0 = mtile * 128;
    const bf16_t* P = (const bf16_t*)(ws + WS_P);
    const bf16_t* W1T = (const bf16_t*)(ws + WS_W1T) + (size_t)kv * 64 * 2048;
    const int col = (kv ? C_VC : C_KC) + g * 64;
    const int ldc = ((lane & 7) ^ (lane >> 3)) * 8;
    const bf16_t* ap[4];
#pragma unroll
    for (int i = 0; i < 4; ++i) ap[i] = P + ((size_t)b * S_ + 16 * (i0 + 32 * i + 8 * wid + (lane >> 3))) * LD + col + ldc;
    const bf16_t* bp[2];
#pragma unroll
    for (int i = 0; i < 2; ++i) bp[i] = W1T + (size_t)(8 * (wid + 4 * i) + (lane >> 3)) * 2048 + ldc;
    f32x4 acc[4][2];
#pragma unroll
    for (int i = 0; i < 4; ++i)
#pragma unroll
        for (int j = 0; j < 2; ++j) acc[i][j] = (f32x4){0.f, 0.f, 0.f, 0.f};
    __syncthreads();
#define CSTAGE(buf, l) do { unsigned char* st_ = lds + (buf) * 24576; \
        _Pragma("unroll") for (int i = 0; i < 4; ++i) glds16(ap[i] + (size_t)(l) * LD, st_ + (4 * i + wid) * 1024); \
        _Pragma("unroll") for (int i = 0; i < 2; ++i) glds16(bp[i] + (l) * 64, st_ + 16384 + (wid + 4 * i) * 1024); } while (0)
    CSTAGE(0, 0); CSTAGE(1, 1);
    for (int l = 0; l < 32; ++l) {
        const unsigned char* st = lds + (l % 3) * 24576;
        if (l + 1 < 32) WAIT_V(6); else WAIT_V(0);
        RAW_BARRIER();
        if (l + 2 < 32) CSTAGE((l + 2) % 3, l + 2);
#pragma unroll
        for (int ks = 0; ks < 2; ++ks) {
            bf16x8 a[4], bb[2];
#pragma unroll
            for (int i = 0; i < 4; ++i) a[i] = lds_frag128(st, 64 * wr + 16 * i + fr, 4 * ks + fq);
#pragma unroll
            for (int j = 0; j < 2; ++j) bb[j] = lds_frag128(st + 16384, 32 * wc + 16 * j + fr, 4 * ks + fq);
#pragma unroll
            for (int i = 0; i < 4; ++i)
#pragma unroll
                for (int j = 0; j < 2; ++j) acc[i][j] = mfma16(a[i], bb[j], acc[i][j]);
        }
    }
    __syncthreads();
#undef CSTAGE
    float* hid = (float*)lds;
    const float* b1 = (const float*)(ws + WS_B1) + kv * 64;
#pragma unroll
    for (int j = 0; j < 2; ++j) {
        const int n = 32 * wc + 16 * j + fr; const float bias = b1[n + vzero()];
#pragma unroll
        for (int i = 0; i < 4; ++i)
#pragma unroll
            for (int r = 0; r < 4; ++r) hid[(64 * wr + 16 * i + 4 * fq + r) * 65 + n] = gelu_tanh(acc[i][j][r] + bias);
    }
    __syncthreads();
    {
        const int row = tid >> 1, nb = (tid & 1) * 32, ci = i0 + row;
        const float* w2 = p.cmp_w2 + ((size_t)layer * 2 + kv) * 64 * 64;
        float o[32];
#pragma unroll
        for (int q = 0; q < 32; ++q) o[q] = 0.f;
        for (int n = 0; n < 64; ++n) {
            const float h = hid[row * 65 + n];
#pragma unroll
            for (int q4 = 0; q4 < 8; ++q4) { const float4 w = *(const float4*)(w2 + n * 64 + nb + 4 * q4); o[4 * q4] += h * w.x; o[4 * q4 + 1] += h * w.y; o[4 * q4 + 2] += h * w.z; o[4 * q4 + 3] += h * w.w; }
        }
        if (kv == 0) {
            bf16_t* dst = (bf16_t*)(ws + WS_KCC) + ((size_t)(b * 2 + g) * 512 + ci) * 64 + nb;
#pragma unroll
            for (int q = 0; q < 32; q += 4) { f32x4 v = {o[q], o[q + 1], o[q + 2], o[q + 3]}; if (ci >= 511) v = (f32x4){0.f, 0.f, 0.f, 0.f}; *(u32x2*)(dst + q) = pack4(v); }
        } else {
            bf16_t* dst = (bf16_t*)(ws + WS_VCCT) + ((size_t)(b * 2 + g) * 64 + nb) * 512 + ci;
#pragma unroll
            for (int q = 0; q < 32; ++q) dst[(size_t)q * 512] = f2bf(ci >= 511 ? 0.f : o[q]);
        }
    }
    __syncthreads();
}

__device__ __forceinline__ float ret_lg2(int h) { const float gam = 1.f - exp2f(-5.f - (float)h); return log2f(gam); }

__device__ __forceinline__ void retkv_item(const Params& p, int item, unsigned char* lds, int half) {
    unsigned char* ws = launder(p.ws);
    const int tid = (ltid() & 255), lane = tid & 63, wid = tid >> 6, fr = lane & 15, fq = lane >> 4;
    const int n = item & 63, h = (item >> 6) & 7, b = item >> 9;
    const size_t tok0 = (size_t)b * S_ + 128 * n;
    unsigned char* vL = lds; unsigned char* kL = lds + 32768;
    load_tile128w((const bf16_t*)(ws + WS_VRT) + ((size_t)(b * 8 + h) * 128) * S_ + 128 * n, S_, vL, wid, lane);
    load_tile128((const bf16_t*)(ws + WS_P) + tok0 * LD + C_KR + h * 64, LD, kL, wid, lane);
    wait_vm0(); __syncthreads();
    const float lg2 = ret_lg2(h);
    f32x4 acc[2][4];
#pragma unroll
    for (int m = 0; m < 2; ++m)
#pragma unroll
        for (int nt = 0; nt < 4; ++nt) acc[m][nt] = (f32x4){0.f, 0.f, 0.f, 0.f};
#pragma unroll
    for (int ks = 0; ks < 4; ++ks) {
        bf16x8 a[2], bb[4];
#pragma unroll
        for (int m = 0; m < 2; ++m) a[m] = lds_frag256(vL, 32 * wid + 16 * m + fr, 4 * ks + fq);
        float dec[8];
#pragma unroll
        for (int j = 0; j < 8; ++j) dec[j] = exp2f((float)(127 - (32 * ks + 8 * fq + j)) * lg2);
#pragma unroll
        for (int nt = 0; nt < 4; ++nt) {
            const int d = 16 * nt + fr;
            float v[8];
#pragma unroll
            for (int j = 0; j < 8; ++j) {
                const int tk = 32 * ks + 8 * fq + j;
                const bf16_t kvv = *(const bf16_t*)(kL + tk * 128 + (((d >> 3) ^ (tk & 7)) << 4) + (d & 7) * 2);
                v[j] = bf2f(kvv) * dec[j];
            }
            u32x4 w; w.x = pack2(v[0], v[1]); w.y = pack2(v[2], v[3]); w.z = pack2(v[4], v[5]); w.w = pack2(v[6], v[7]);
            bb[nt] = __builtin_bit_cast(bf16x8, w);
        }
#pragma unroll
        for (int m = 0; m < 2; ++m)
#pragma unroll
            for (int nt = 0; nt < 4; ++nt) acc[m][nt] = mfma16(a[m], bb[nt], acc[m][nt]);
    }
    float* KVT = (float*)(ws + WS_KVT) + ((size_t)(b * 8 + h) * 64 + n) * 8192;
#pragma unroll
    for (int m = 0; m < 2; ++m)
#pragma unroll
        for (int nt = 0; nt < 4; ++nt)
#pragma unroll
            for (int r = 0; r < 4; ++r) KVT[(32 * wid + 16 * m + 4 * fq + r) * 64 + 16 * nt + fr] = acc[m][nt][r];
    __syncthreads();
}

__device__ __forceinline__ void phase_p2(const Params& p, int layer, unsigned char* lds, int half) {
    const int vb = blockIdx.x * 2 + half, nvb = gridDim.x * 2;
    if (vb < 32) compress_item(p, layer, vb, lds, half);
    else for (int it = vb - 32; it < 1024; it += nvb - 32) retkv_item(p, it, lds, half);
}

constexpr int NSA_IMP = 32768, NSA_BUCKET = 65792, NSA_BIAS = 73984;

struct NsaLane { int t; int fr, fq, wid, lane; };

template <int BR, int PASS>
__device__ __forceinline__ void nsa_half(const unsigned char* kL, const unsigned char* vL, const unsigned char* lds, const bf16x8 (&qptr)[4][2],
                                         f32x4 (&O)[4][4], float (&m)[4], float (&l)[4], int tile, int hf, bool selbit, const NsaLane& L, int qrow) {
    const int fr = L.fr, fq = L.fq;
    bf16x8 Kf[2][2];
#pragma unroll
    for (int i = 0; i < 2; ++i)
#pragma unroll
        for (int ks = 0; ks < 2; ++ks) Kf[i][ks] = lds_frag128(kL, 32 * hf + 16 * i + fr, 4 * ks + fq);
    bf16x8 Vf[4];
    if (PASS != 0) {
#pragma unroll
        for (int mt = 0; mt < 4; ++mt) Vf[mt] = lds_vfrag128(vL, 16 * mt + fr, 32 * hf, fq);
    }
    unsigned vmask = 0; unsigned bk[2];
    const unsigned char* bucketL = lds + NSA_BUCKET;
#pragma unroll
    for (int i = 0; i < 2; ++i) {
        unsigned pk = 0;
#pragma unroll
        for (int r = 0; r < 4; ++r) {
            const int kk = 32 * hf + 16 * i + 4 * fq + r;
            int rel; bool ok;
            if (BR == 0) { rel = L.t - (16 * (64 * tile + kk) + 31); ok = rel >= 0; }
            else if (BR == 1) { rel = L.t - (64 * tile + kk); ok = selbit && rel >= 0; }
            else { rel = L.t - (64 * tile + kk); ok = rel >= 0 && rel < 512; }
            int rc = rel < 0 ? 0 : rel; rc = rc > 8191 ? 8191 : rc;
            pk |= (unsigned)bucketL[rc] << (8 * r);
            vmask |= (ok ? 1u : 0u) << (4 * i + r);
        }
        bk[i] = pk;
    }
    const float* biasL = (const float*)(lds + NSA_BIAS);
    float ia[2] = {0.f, 0.f}, ic[2] = {0.f, 0.f};
#pragma unroll
    for (int nt = 0; nt < 4; ++nt) {
        f32x4 S[2];
        const bf16x8 q0 = qptr[nt][0], q1 = qptr[nt][1];
#pragma unroll
        for (int i = 0; i < 2; ++i) {
            S[i] = (f32x4){0.f, 0.f, 0.f, 0.f};
            S[i] = mfma16(Kf[i][0], q0, S[i]); S[i] = mfma16(Kf[i][1], q1, S[i]);
        }
        float tmax = -1e30f;
        float bsv[2][4];
#pragma unroll
        for (int i = 0; i < 2; ++i)
#pragma unroll
            for (int r = 0; r < 4; ++r) bsv[i][r] = biasL[nt * 32 + ((bk[i] >> (8 * r)) & 0xffu)];
        asm volatile("" : "+v"(bsv[0][0]), "+v"(bsv[0][1]), "+v"(bsv[0][2]), "+v"(bsv[0][3]), "+v"(bsv[1][0]), "+v"(bsv[1][1]), "+v"(bsv[1][2]), "+v"(bsv[1][3]));
#pragma unroll
        for (int i = 0; i < 2; ++i)
#pragma unroll
            for (int r = 0; r < 4; ++r) {
                const bool ok = (vmask >> (4 * i + r)) & 1u;
                const float sv = S[i][r] * 0.125f + bsv[i][r];
                S[i][r] = ok ? sv : -1e30f; tmax = fmaxf(tmax, S[i][r]);
            }
        if (PASS != 1) {
            tmax = rows_max(tmax);
            const float mnew = fmaxf(m[nt], tmax), alpha = __expf(m[nt] - mnew);
            float psum = 0.f;
#pragma unroll
            for (int i = 0; i < 2; ++i)
#pragma unroll
                for (int r = 0; r < 4; ++r) {
                    const bool ok = (vmask >> (4 * i + r)) & 1u;
                    const float pv = ok ? __expf(S[i][r] - mnew) : 0.f;
                    S[i][r] = pv; psum += pv;
                }
            psum = rows_sum(psum);
            l[nt] = l[nt] * alpha + psum; m[nt] = mnew;
            if (PASS == 2) {
#pragma unroll
                for (int mt = 0; mt < 4; ++mt) O[mt][nt] = O[mt][nt] * alpha;
            }
        } else {
#pragma unroll
            for (int i = 0; i < 2; ++i) {
#pragma unroll
                for (int r = 0; r < 4; ++r) {
                    const bool ok = (vmask >> (4 * i + r)) & 1u;
                    S[i][r] = ok ? __expf(S[i][r] - m[nt]) * l[nt] : 0.f;
                }
                ia[i] += S[i][0] + S[i][1] + S[i][2] + 0.5f * S[i][3];
                ic[i] += 0.5f * S[i][3];
            }
        }
        if (PASS != 0) {
            const bf16x8 Pb = pack8(S[0], S[1]);
#pragma unroll
            for (int mt = 0; mt < 4; ++mt) O[mt][nt] = mfma16(Vf[mt], Pb, O[mt][nt]);
        }
    }
    if (PASS == 1) {
        float* imp = (float*)(lds + NSA_IMP) + qrow * 129;
        asm volatile("" ::: "memory"); __builtin_amdgcn_wave_barrier();
#pragma unroll
        for (int i = 0; i < 2; ++i) { const int j = 16 * tile + 8 * hf + 4 * i + fq; imp[j] += ia[i]; }
        asm volatile("s_waitcnt lgkmcnt(0)" ::: "memory"); __builtin_amdgcn_wave_barrier();
#pragma unroll
        for (int i = 0; i < 2; ++i) { const int j = 16 * tile + 8 * hf + 4 * i + fq + 1; if (j < 128) imp[j] += ic[i]; }
        asm volatile("s_waitcnt lgkmcnt(0)" ::: "memory"); __builtin_amdgcn_wave_barrier();
    }
}
template <int BR, int PASS>
__device__ __forceinline__ void nsa_tile(const unsigned char* kL, const unsigned char* vL, const unsigned char* lds, const bf16x8 (&qptr)[4][2],
                                         f32x4 (&O)[4][4], float (&m)[4], float (&l)[4], int tile, bool selbit, const NsaLane& L, int qrow) {
#pragma unroll 1
    for (int hf = 0; hf < 2; ++hf) nsa_half<BR, PASS>(kL, vL, lds, qptr, O, m, l, tile, hf, selbit, L, qrow);
}

__device__ __forceinline__ void cmp_item(const Params& p, int item, unsigned char* lds, int half) {
    unsigned char* ws = launder(p.ws);
    const int tid = (ltid() & 255), lane = tid & 63, wid = tid >> 6, fr = lane & 15, fq = lane >> 4;
    const int combo = item & 3, qt = 127 - (item >> 2), b = combo >> 1, g = combo & 1;
    const int q0 = qt * 64, qrow = 16 * wid + fr;
    NsaLane L; L.t = q0 + qrow; L.fr = fr; L.fq = fq; L.wid = wid; L.lane = lane;
    const size_t tok = (size_t)b * S_ + L.t;
    const bf16_t* P = (const bf16_t*)(ws + WS_P);
    __syncthreads();
    if (tid < 128) ((float*)(lds + NSA_BIAS))[tid] = p.rel_bias[(tid & 31) * 8 + 4 * g + (tid >> 5)];
    for (int i = tid; i < 64 * 129; i += HT) ((float*)(lds + NSA_IMP))[i] = 0.f;
    bf16x8 Qf[4][2];
#pragma unroll
    for (int nt = 0; nt < 4; ++nt)
#pragma unroll
        for (int ks = 0; ks < 2; ++ks) Qf[nt][ks] = *(const bf16x8*)(P + tok * LD + C_QA + (4 * g + nt) * 64 + 32 * ks + 8 * fq);
    __syncthreads();
    f32x4 O[4][4]; float m[4], l[4];
    const bf16_t* gates = P + tok * LD + C_GA + (4 * g) * 3;
    const bf16_t* kc = (const bf16_t*)(ws + WS_KCC) + (size_t)(b * 2 + g) * 512 * 64;
    const bf16_t* vc = (const bf16_t*)(ws + WS_VCCT) + (size_t)(b * 2 + g) * 64 * 512;
    const int ntc = ((q0 + 32) >> 4) / 64 + 1;
#pragma unroll
    for (int nt = 0; nt < 4; ++nt) { m[nt] = -1e30f; l[nt] = 0.f; }
    load_tile64(kc, 64, lds, wid, lane);
    wait_vm0(); __syncthreads();
    for (int it = 0; it < ntc; ++it) {
        unsigned char* cur = lds + (it & 1) * 16384;
        if (it + 1 < ntc) load_tile64(kc + (size_t)(it + 1) * 64 * 64, 64, lds + ((it + 1) & 1) * 16384, wid, lane);
        nsa_tile<0, 0>(cur, cur + 8192, lds, Qf, O, m, l, it, true, L, qrow);
        wait_vm0(); __syncthreads();
    }
#pragma unroll
    for (int nt = 0; nt < 4; ++nt) l[nt] = l[nt] > 0.f ? 1.f / l[nt] : 0.f;
#pragma unroll
    for (int mt = 0; mt < 4; ++mt)
#pragma unroll
        for (int nt = 0; nt < 4; ++nt) O[mt][nt] = (f32x4){0.f, 0.f, 0.f, 0.f};
    load_tile64(kc, 64, lds, wid, lane); load_tile64(vc, 512, lds + 8192, wid, lane);
    wait_vm0(); __syncthreads();
    for (int it = 0; it < ntc; ++it) {
        unsigned char* cur = lds + (it & 1) * 16384;
        if (it + 1 < ntc) { unsigned char* nx = lds + ((it + 1) & 1) * 16384;
            load_tile64(kc + (size_t)(it + 1) * 64 * 64, 64, nx, wid, lane); load_tile64(vc + (it + 1) * 64, 512, nx + 8192, wid, lane); }
        nsa_tile<0, 1>(cur, cur + 8192, lds, Qf, O, m, l, it, true, L, qrow);
        wait_vm0(); __syncthreads();
    }
    bf16_t* YC = (bf16_t*)(ws + WS_YC) + tok * 512 + (4 * g) * 64;
#pragma unroll
    for (int nt = 0; nt < 4; ++nt) {
        const float gt = bf2f(gates[nt * 3 + 0]);
#pragma unroll
        for (int mt = 0; mt < 4; ++mt) *(u32x2*)(YC + nt * 64 + 16 * mt + 4 * fq) = pack4(O[mt][nt] * gt);
    }
    const int cur = qt;
    {
        float* imp = (float*)(lds + NSA_IMP) + qrow * 129 + 32 * fq;
        asm volatile("s_waitcnt lgkmcnt(0)" ::: "memory"); __builtin_amdgcn_wave_barrier();
#pragma unroll
        for (int i = 0; i < 32; ++i) {
            const int j = 32 * fq + i;
            const float v = imp[i];
            imp[i] = j > cur ? -1.f : v + ((j == 0 || j == cur || j == cur - 1) ? 1.0e4f : 0.f);
        }
        unsigned word = 0;
#pragma unroll 1
        for (int round = 0; round < 16; ++round) {
            float bv = imp[0]; int bi = 0;
#pragma unroll
            for (int i = 1; i < 32; ++i) { const float v = imp[i]; if (v > bv) { bv = v; bi = i; } }
            int gi = 32 * fq + bi;
            {
                u32x2 rv = __builtin_amdgcn_permlane16_swap(__float_as_uint(bv), __float_as_uint(bv), false, false);
                u32x2 ri = __builtin_amdgcn_permlane16_swap((unsigned)gi, (unsigned)gi, false, false);
                float v0 = __uint_as_float(rv.x), v1 = __uint_as_float(rv.y); int i0 = (int)ri.x, i1 = (int)ri.y;
                if (v1 > v0 || (v1 == v0 && i1 < i0)) { v0 = v1; i0 = i1; }
                rv = __builtin_amdgcn_permlane32_swap(__float_as_uint(v0), __float_as_uint(v0), false, false);
                ri = __builtin_amdgcn_permlane32_swap((unsigned)i0, (unsigned)i0, false, false);
                v0 = __uint_as_float(rv.x); v1 = __uint_as_float(rv.y); i0 = (int)ri.x; i1 = (int)ri.y;
                if (v1 > v0 || (v1 == v0 && i1 < i0)) { v0 = v1; i0 = i1; }
                bv = v0; gi = i0;
            }
            if (bv >= 0.f && (gi >> 5) == fq) { word |= 1u << (gi & 31); imp[gi & 31] = -2.f; }
        }
        ((unsigned*)(ws + WS_SELW))[(tok * 2 + g) * 4 + fq] = word;
    }
}

__device__ __forceinline__ void win_item(const Params& p, int item, unsigned char* lds, int half) {
    unsigned char* ws = launder(p.ws);
    const int tid = (ltid() & 255), lane = tid & 63, wid = tid >> 6, fr = lane & 15, fq = lane >> 4;
    const int combo = item & 3, qt = 127 - (item >> 2), b = combo >> 1, g = combo & 1;
    const int q0 = qt * 64, qrow = 16 * wid + fr;
    NsaLane L; L.t = q0 + qrow; L.fr = fr; L.fq = fq; L.wid = wid; L.lane = lane;
    const size_t tok = (size_t)b * S_ + L.t;
    const bf16_t* P = (const bf16_t*)(ws + WS_P);
    __syncthreads();
    if (tid < 128) ((float*)(lds + NSA_BIAS))[tid] = p.rel_bias[(tid & 31) * 8 + 4 * g + (tid >> 5)];
    bf16x8 Qf[4][2];
#pragma unroll
    for (int nt = 0; nt < 4; ++nt)
#pragma unroll
        for (int ks = 0; ks < 2; ++ks) Qf[nt][ks] = *(const bf16x8*)(P + tok * LD + C_QA + (4 * g + nt) * 64 + 32 * ks + 8 * fq);
    __syncthreads();
    f32x4 O[4][4]; float m[4], l[4];
    const bf16_t* gates = P + tok * LD + C_GA + (4 * g) * 3;
#pragma unroll
    for (int nt = 0; nt < 4; ++nt) { m[nt] = -1e30f; l[nt] = 0.f; }
#pragma unroll
    for (int mt = 0; mt < 4; ++mt)
#pragma unroll
        for (int nt = 0; nt < 4; ++nt) O[mt][nt] = (f32x4){0.f, 0.f, 0.f, 0.f};
    {
        const bf16_t* kb = P + ((size_t)b * S_) * LD + C_KW + g * 64;
        const bf16_t* vb = (const bf16_t*)(ws + WS_VWT) + (size_t)(b * 2 + g) * 64 * S_;
        const int k_lo = qt - 8 > 0 ? qt - 8 : 0, ntw = qt - k_lo + 1;
        load_tile64(kb + (size_t)k_lo * 64 * LD, LD, lds, wid, lane); load_tile64(vb + k_lo * 64, S_, lds + 8192, wid, lane);
        wait_vm0(); __syncthreads();
        for (int it = 0; it < ntw; ++it) {
            unsigned char* cu = lds + (it & 1) * 16384;
            if (it + 1 < ntw) { unsigned char* nx = lds + ((it + 1) & 1) * 16384;
                load_tile64(kb + (size_t)(k_lo + it + 1) * 64 * LD, LD, nx, wid, lane); load_tile64(vb + (k_lo + it + 1) * 64, S_, nx + 8192, wid, lane); }
            nsa_tile<2, 2>(cu, cu + 8192, lds, Qf, O, m, l, k_lo + it, true, L, qrow);
            wait_vm0(); __syncthreads();
        }
    }
    bf16_t* YW = (bf16_t*)(ws + WS_YW) + tok * 512 + (4 * g) * 64;
#pragma unroll
    for (int nt = 0; nt < 4; ++nt) {
        const float gt = bf2f(gates[nt * 3 + 2]) * (l[nt] > 0.f ? 1.f / l[nt] : 0.f);
#pragma unroll
        for (int mt = 0; mt < 4; ++mt) *(u32x2*)(YW + nt * 64 + 16 * mt + 4 * fq) = pack4(O[mt][nt] * gt);
    }
}

constexpr int SEL_RING = 8, SEL_BUCKET = SEL_RING * 16384, SEL_BIAS2 = SEL_BUCKET + 8192;
constexpr float LOG2E = 1.4426950408889634f;
__device__ __forceinline__ int t5_first(int bk) {
    const int th[16] = {16, 22, 30, 40, 54, 73, 99, 134, 182, 246, 332, 450, 609, 825, 1117, 1513};
    int r = 16;
#pragma unroll
    for (int k = 0; k < 16; ++k) r = (bk == 16 + k) ? th[k] : r;
    return r;
}
template <bool FAST>
__device__ __forceinline__ void sel_ntile(const bf16x8 (&Kf)[4][2], const unsigned char* vL, int fr, int fq, const bf16x8& q0, const bf16x8& q1, f32x4 (&O)[4], float& m, float& l,
                                          bool sb, int relb, int th, float blo, float bhi, const unsigned char* lds, int hl) {
    f32x4 S[4];
#pragma unroll
    for (int i = 0; i < 4; ++i) { S[i] = (f32x4){0.f, 0.f, 0.f, 0.f}; S[i] = mfma16(Kf[i][0], q0, S[i]); S[i] = mfma16(Kf[i][1], q1, S[i]); }
    float tmax = -1e30f;
    const float scl = (!FAST || sb) ? 0.125f * LOG2E : 0.f;
    if (FAST) { blo = (sb ? blo : -1e30f) - m; bhi = (sb ? bhi : -1e30f) - m; }
    if (FAST) {
#pragma unroll
        for (int i = 0; i < 4; ++i)
#pragma unroll
            for (int r = 0; r < 4; ++r) { const int rel = relb - (16 * i + r); S[i][r] = S[i][r] * scl + (rel >= th ? bhi : blo); tmax = fmaxf(tmax, S[i][r]); }
    } else {
        unsigned bkt[4][4]; float bs[4][4];
#pragma unroll
        for (int i = 0; i < 4; ++i)
#pragma unroll
            for (int r = 0; r < 4; ++r) { const int rel = relb - (16 * i + r); int rc = rel < 0 ? 0 : rel; rc = rc > 8191 ? 8191 : rc; bkt[i][r] = (lds + SEL_BUCKET)[rc]; }
#pragma unroll
        for (int i = 0; i < 4; ++i)
#pragma unroll
            for (int r = 0; r < 4; ++r) bs[i][r] = ((const float*)(lds + SEL_BIAS2))[hl * 32 + bkt[i][r]];
        asm volatile("" : "+v"(bs[0][0]), "+v"(bs[0][1]), "+v"(bs[0][2]), "+v"(bs[0][3]), "+v"(bs[1][0]), "+v"(bs[1][1]), "+v"(bs[1][2]), "+v"(bs[1][3]),
                          "+v"(bs[2][0]), "+v"(bs[2][1]), "+v"(bs[2][2]), "+v"(bs[2][3]), "+v"(bs[3][0]), "+v"(bs[3][1]), "+v"(bs[3][2]), "+v"(bs[3][3]));
        const float ninf = -1e30f;
#pragma unroll
        for (int i = 0; i < 4; ++i)
#pragma unroll
            for (int r = 0; r < 4; ++r) {
                const int rel = relb - (16 * i + r);
                const float sv = S[i][r] * (0.125f * LOG2E) + (bs[i][r] - m);
                S[i][r] = (sb && rel >= 0) ? sv : ninf; tmax = fmaxf(tmax, S[i][r]);
            }
    }
    tmax = rows_max(tmax);
    if (__ballot(tmax > 8.f) != 0ull) {
        const float d = fmaxf(tmax, 0.f), alpha = __builtin_amdgcn_exp2f(-d);
        m += d; l *= alpha;
#pragma unroll
        for (int mt = 0; mt < 4; ++mt) O[mt] = O[mt] * alpha;
#pragma unroll
        for (int i = 0; i < 4; ++i)
#pragma unroll
            for (int r = 0; r < 4; ++r) S[i][r] -= d;
    }
    float psum = 0.f;
#pragma unroll
    for (int i = 0; i < 4; ++i)
#pragma unroll
        for (int r = 0; r < 4; ++r) { const float pv = __builtin_amdgcn_exp2f(S[i][r]); S[i][r] = pv; psum += pv; }
    l += rows_sum(psum);
    const bf16x8 Pb0 = pack8(S[0], S[1]), Pb1 = pack8(S[2], S[3]);
#pragma unroll
    for (int mt = 0; mt < 4; ++mt) { O[mt] = mfma16(lds_vfrag128(vL, 16 * mt + fr, 0, fq), Pb0, O[mt]); O[mt] = mfma16(lds_vfrag128(vL, 16 * mt + fr, 32, fq), Pb1, O[mt]); }
}
__device__ __forceinline__ void sel_ntile2_fast(const bf16x8 (&Kf)[4][2], const unsigned char* vL, int fr, int fq, const bf16x8 (&Qf)[2][2], f32x4 (&O)[2][4], float (&m)[2], float (&l)[2],
                                                const bool (&sb)[2], const int (&relb)[2], int th, float blo, float bhi) {
    f32x4 S[2][4]; float tmax[2], bl[2], bh[2], scl[2];
#pragma unroll
    for (int b = 0; b < 2; ++b)
#pragma unroll
        for (int i = 0; i < 4; ++i) { S[b][i] = (f32x4){0.f, 0.f, 0.f, 0.f}; S[b][i] = mfma16(Kf[i][0], Qf[b][0], S[b][i]); S[b][i] = mfma16(Kf[i][1], Qf[b][1], S[b][i]); }
#pragma unroll
    for (int b = 0; b < 2; ++b) { scl[b] = sb[b] ? 0.125f * LOG2E : 0.f; bl[b] = (sb[b] ? blo : -1e30f) - m[b]; bh[b] = (sb[b] ? bhi : -1e30f) - m[b]; tmax[b] = -1e30f; }
#pragma unroll
    for (int b = 0; b < 2; ++b)
#pragma unroll
        for (int i = 0; i < 4; ++i)
#pragma unroll
            for (int r = 0; r < 4; ++r) { const int rel = relb[b] - (16 * i + r); S[b][i][r] = S[b][i][r] * scl[b] + (rel >= th ? bh[b] : bl[b]); tmax[b] = fmaxf(tmax[b], S[b][i][r]); }
#pragma unroll
    for (int b = 0; b < 2; ++b) tmax[b] = rows_max(tmax[b]);
    if (__ballot(tmax[0] > 8.f || tmax[1] > 8.f) != 0ull) {
#pragma unroll
        for (int b = 0; b < 2; ++b) {
            const float d = fmaxf(tmax[b], 0.f), alpha = __builtin_amdgcn_exp2f(-d);
            m[b] += d; l[b] *= alpha;
#pragma unroll
            for (int mt = 0; mt < 4; ++mt) O[b][mt] = O[b][mt] * alpha;
#pragma unroll
            for (int i = 0; i < 4; ++i)
#pragma unroll
                for (int r = 0; r < 4; ++r) S[b][i][r] -= d;
        }
    }
    float psum[2] = {0.f, 0.f};
#pragma unroll
    for (int b = 0; b < 2; ++b)
#pragma unroll
        for (int i = 0; i < 4; ++i)
#pragma unroll
            for (int r = 0; r < 4; ++r) { const float pv = __builtin_amdgcn_exp2f(S[b][i][r]); S[b][i][r] = pv; psum[b] += pv; }
#pragma unroll
    for (int b = 0; b < 2; ++b) l[b] += rows_sum(psum[b]);
    bf16x8 P0[2], P1[2];
#pragma unroll
    for (int b = 0; b < 2; ++b) { P0[b] = pack8(S[b][0], S[b][1]); P1[b] = pack8(S[b][2], S[b][3]); }
#pragma unroll
    for (int mt = 0; mt < 4; ++mt) {
        const bf16x8 v0 = lds_vfrag128(vL, 16 * mt + fr, 0, fq), v1 = lds_vfrag128(vL, 16 * mt + fr, 32, fq);
#pragma unroll
        for (int b = 0; b < 2; ++b) { O[b][mt] = mfma16(v0, P0[b], O[b][mt]); O[b][mt] = mfma16(v1, P1[b], O[b][mt]); }
    }
}
template <bool FAST>
__device__ __forceinline__ void sel_tile(const unsigned char* kL, const unsigned char* vL, const unsigned char* lds, const bf16x8 (&Qf)[2][2], f32x4 (&O)[2][4], float (&m)[2], float (&l)[2],
                                         const bool (&sb)[2], const bool (&need)[2], const int (&relb)[2], int th, float blo, float bhi, int hl, int fr, int fq) {
    bf16x8 Kf[4][2];
#pragma unroll
    for (int i = 0; i < 4; ++i)
#pragma unroll
        for (int ks = 0; ks < 2; ++ks) Kf[i][ks] = lds_frag128(kL, 16 * i + fr, 4 * ks + fq);
    if (FAST && need[0] && need[1]) { sel_ntile2_fast(Kf, vL, fr, fq, Qf, O, m, l, sb, relb, th, blo, bhi); return; }
    if (need[0]) sel_ntile<FAST>(Kf, vL, fr, fq, Qf[0][0], Qf[0][1], O[0], m[0], l[0], sb[0], relb[0], th, blo, bhi, lds, hl);
    if (need[1]) sel_ntile<FAST>(Kf, vL, fr, fq, Qf[1][0], Qf[1][1], O[1], m[1], l[1], sb[1], relb[1], th, blo, bhi, lds, hl);
}
template <int VAR>
__device__ __forceinline__ void sel_item(const Params& p, int v, unsigned char* lds) {
    unsigned char* ws = launder(p.ws);
    const int tid = ltid(), lane = tid & 63, wid = tid >> 6, fr = lane & 15, fq = lane >> 4;
    const int qt = 127 - (v >> 2), sub = v & 3, b = sub >> 1, g = sub & 1;
    const int q0 = qt * 64, cur = qt, hl = fr & 3;
    const bf16_t* P = (const bf16_t*)(ws + WS_P);
    __syncthreads();
    if (tid < 128) ((float*)(lds + SEL_BIAS2))[tid] = p.rel_bias[(tid & 31) * 8 + 4 * g + (tid >> 5)] * LOG2E;
    int t[2]; size_t tok[2]; bf16x8 Qf[2][2]; unsigned selw[2][4];
#pragma unroll
    for (int nt = 0; nt < 2; ++nt) {
        t[nt] = q0 + 8 * wid + 4 * nt + (fr >> 2); tok[nt] = (size_t)b * S_ + t[nt];
#pragma unroll
        for (int ks = 0; ks < 2; ++ks) Qf[nt][ks] = *(const bf16x8*)(P + tok[nt] * LD + C_QA + (4 * g + hl) * 64 + 32 * ks + 8 * fq);
        const u32x4 w = *(const u32x4*)((const unsigned*)(ws + WS_SELW) + (tok[nt] * 2 + g) * 4);
        selw[nt][0] = w.x; selw[nt][1] = w.y; selw[nt][2] = w.z; selw[nt][3] = w.w;
    }
    f32x4 O[2][4]; float m[2], l[2];
#pragma unroll
    for (int nt = 0; nt < 2; ++nt) { m[nt] = -1000.f; l[nt] = 0.f;
#pragma unroll
        for (int mt = 0; mt < 4; ++mt) O[nt][mt] = (f32x4){0.f, 0.f, 0.f, 0.f}; }
    const bf16_t* kb = P + ((size_t)b * S_) * LD + C_KS + g * 64;
    const bf16_t* vb = (const bf16_t*)(ws + WS_VST) + (size_t)(b * 2 + g) * 64 * S_;
    const int nts = cur + 1;
#define SEL_ISSUE(jj) do { unsigned char* st_ = lds + ((jj) & 7) * 16384; const int c_ = ((lane & 7) ^ (lane >> 3)) * 8, r_ = 8 * wid + (lane >> 3); \
        glds16(kb + ((size_t)(jj) * 64 + r_) * LD + c_, st_ + wid * 1024); glds16(vb + (size_t)r_ * S_ + (jj) * 64 + c_, st_ + 8192 + wid * 1024); } while (0)
    asm volatile("s_waitcnt vmcnt(0)" ::: "memory");
#pragma unroll
    for (int q = 0; q < 4; ++q) if (q < nts) SEL_ISSUE(q);
    const unsigned char* bucketL = lds + SEL_BUCKET;
    for (int jp = 0; jp < nts; jp += 4) {
        WAIT_V(0);
        RAW_BARRIER();
#pragma unroll
        for (int q = 4; q < 8; ++q) if (jp + q < nts) SEL_ISSUE(jp + q);
#pragma unroll 1
      for (int j = jp; j < jp + 4 && j < nts; ++j) {
        const unsigned char* cu = lds + (j & 7) * 16384;
        bool sb[2], need[2]; int relb[2];
#pragma unroll
        for (int nt = 0; nt < 2; ++nt) {
            const unsigned w = j < 32 ? selw[nt][0] : j < 64 ? selw[nt][1] : j < 96 ? selw[nt][2] : selw[nt][3];
            sb[nt] = (w >> (j & 31)) & 1u; need[nt] = __ballot(sb[nt]) != 0ull; relb[nt] = t[nt] - 64 * j - 4 * fq;
        }
        if (VAR == 1) { need[0] = false; need[1] = false; }
        if (VAR == 2) { if (!(need[0] || need[1])) { need[0] = false; } else { need[0] = true; need[1] = true; } }
        if (need[0] || need[1]) {
            const int rmin = q0 - 64 * j - 63, rmax = q0 + 31 - 64 * j;
            bool fast = false; int th = 0; float blo = 0.f, bhi = 0.f;
            if (rmin >= 16) {
                const int b0 = bucketL[rmin], b1 = bucketL[rmax > 8191 ? 8191 : rmax];
                if (b1 - b0 <= 1) { fast = true; th = t5_first(b1); if (b1 == b0) th = 0;
                    blo = ((const float*)(lds + SEL_BIAS2))[hl * 32 + b0]; bhi = ((const float*)(lds + SEL_BIAS2))[hl * 32 + b1]; }
            }
            if (fast) sel_tile<true>(cu, cu + 8192, lds, Qf, O, m, l, sb, need, relb, th, blo, bhi, hl, fr, fq);
            else sel_tile<false>(cu, cu + 8192, lds, Qf, O, m, l, sb, need, relb, th, blo, bhi, hl, fr, fq);
        }
      }
    }
#undef SEL_ISSUE
    __syncthreads();
#pragma unroll
    for (int nt = 0; nt < 2; ++nt) {
        const float gt = bf2f(P[tok[nt] * LD + C_GA + (4 * g + hl) * 3 + 1]) * (l[nt] > 0.f ? 1.f / l[nt] : 0.f);
        const size_t o = tok[nt] * 512 + (4 * g + hl) * 64;
#pragma unroll
        for (int mt = 0; mt < 4; ++mt) {
            const f32x4 yc = unpack4(*(const u32x2*)((const bf16_t*)(ws + WS_YC) + o + 16 * mt + 4 * fq));
            const f32x4 yw = unpack4(*(const u32x2*)((const bf16_t*)(ws + WS_YW) + o + 16 * mt + 4 * fq));
            if (VAR == 0 || VAR == 3) *(u32x2*)((bf16_t*)(ws + WS_YA) + o + 16 * mt + 4 * fq) = pack4(yc + yw + O[nt][mt] * gt);
            else asm volatile("" :: "v"(O[nt][mt]));
        }
    }
}

__device__ __forceinline__ void scan_item(const Params& p, int item, int half) {
    unsigned char* ws = launder(p.ws);
    const int idx = item * HT + (ltid() & 255);
    const int bh = idx >> 13, ed = idx & 8191, h = bh & 7;
    const float dec = exp2f(128.f * ret_lg2(h));
    const float* KVT = (const float*)(ws + WS_KVT) + (size_t)bh * 64 * 8192 + ed;
    bf16_t* SPT = (bf16_t*)(ws + WS_SPT) + (size_t)bh * 64 * 8192 + ed;
    float s = 0.f;
    for (int n = 0; n < 64; ++n) { SPT[(size_t)n * 8192] = f2bf(s); s = s * dec + KVT[(size_t)n * 8192]; }
}

__device__ __forceinline__ void phase_p3(const Params& p, unsigned char* lds, int half, int what) {
    for (int i = (ltid() & 255); i < 8192 / 16; i += HT) ((u32x4*)(lds + NSA_BUCKET))[i] = ((const u32x4*)(launder(p.ws) + WS_BUCKET))[i];
    __syncthreads();
    for (int h = (blockIdx.x * 2 + half); h < 512; h += (gridDim.x * 2)) {
        if (what & 1) cmp_item(p, h, lds, half);
        if (what & 2) {
            if (h >= 128 && h < 384) win_item(p, h - 128, lds, half);
            else if (h >= 384) { win_item(p, 256 + 2 * (h - 384) - ((h & 1) ? 1 : 0) , lds, half); win_item(p, 256 + 2 * (h - 384) + ((h & 1) ? 0 : 1) + 1 - ((h & 1) ? 0 : 0), lds, half); }
        }
        if (what & 4) scan_item(p, h, half);
    }
}

__device__ __forceinline__ void retout_item(const Params& p, int item, unsigned char* lds, int half) {
    unsigned char* ws = launder(p.ws);
    const int tid = (ltid() & 255), lane = tid & 63, wid = tid >> 6, fr = lane & 15, fq = lane >> 4;
    const int n = item & 63, h = (item >> 6) & 7, b = item >> 9;
    const size_t tok0 = (size_t)b * S_ + 128 * n;
    const bf16_t* P = (const bf16_t*)(ws + WS_P);
    unsigned char* vL = lds; unsigned char* kL = lds + 32768; unsigned char* sL = lds + 49152;
    __syncthreads();
    load_tile128w((const bf16_t*)(ws + WS_VRT) + ((size_t)(b * 8 + h) * 128) * S_ + 128 * n, S_, vL, wid, lane);
    load_tile128(P + tok0 * LD + C_KR + h * 64, LD, kL, wid, lane);
    load_tile128((const bf16_t*)(ws + WS_SPT) + ((size_t)(b * 8 + h) * 64 + n) * 8192, 64, sL, wid, lane);
    bf16x8 Qf[2][2];
#pragma unroll
    for (int nt = 0; nt < 2; ++nt)
#pragma unroll
        for (int ks = 0; ks < 2; ++ks) Qf[nt][ks] = *(const bf16x8*)(P + (tok0 + 32 * wid + 16 * nt + fr) * LD + C_QR + h * 64 + 32 * ks + 8 * fq);
    wait_vm0(); __syncthreads();
    const float lg2 = ret_lg2(h);
    f32x4 Y[8][2];
#pragma unroll
    for (int m = 0; m < 8; ++m)
#pragma unroll
        for (int nt = 0; nt < 2; ++nt) Y[m][nt] = (f32x4){0.f, 0.f, 0.f, 0.f};
#pragma unroll
    for (int m = 0; m < 8; ++m)
#pragma unroll
        for (int ks = 0; ks < 2; ++ks) {
            const bf16x8 a = lds_frag128(sL, 16 * m + fr, 4 * ks + fq);
#pragma unroll
            for (int nt = 0; nt < 2; ++nt) Y[m][nt] = mfma16(a, Qf[nt][ks], Y[m][nt]);
        }
#pragma unroll
    for (int nt = 0; nt < 2; ++nt) {
        const float sc = exp2f((float)(32 * wid + 16 * nt + fr + 1) * lg2);
#pragma unroll
        for (int m = 0; m < 8; ++m) Y[m][nt] = Y[m][nt] * sc;
    }
#pragma unroll 1
    for (int s = 0; s < 4; ++s) {
        f32x4 St[2][2];
#pragma unroll
        for (int hh = 0; hh < 2; ++hh) {
            const int mt = 2 * s + hh;
#pragma unroll
            for (int nt = 0; nt < 2; ++nt) St[hh][nt] = (f32x4){0.f, 0.f, 0.f, 0.f};
#pragma unroll
            for (int ks = 0; ks < 2; ++ks) {
                const bf16x8 a = lds_frag128(kL, 16 * mt + fr, 4 * ks + fq);
#pragma unroll
                for (int nt = 0; nt < 2; ++nt) St[hh][nt] = mfma16(a, Qf[nt][ks], St[hh][nt]);
            }
#pragma unroll
            for (int nt = 0; nt < 2; ++nt) {
                const int qi = 32 * wid + 16 * nt + fr;
#pragma unroll
                for (int r = 0; r < 4; ++r) {
                    const int kj = 16 * mt + 4 * fq + r;
                    const float dm = qi >= kj ? exp2f((float)(qi - kj) * lg2) : 0.f;
                    St[hh][nt][r] *= dm;
                }
            }
        }
        bf16x8 Pb[2];
#pragma unroll
        for (int nt = 0; nt < 2; ++nt) Pb[nt] = pack8(St[0][nt], St[1][nt]);
#pragma unroll
        for (int m = 0; m < 8; ++m) {
            const bf16x8 a = lds_vfrag256(vL, 16 * m + fr, 32 * s, fq);
#pragma unroll
            for (int nt = 0; nt < 2; ++nt) Y[m][nt] = mfma16(a, Pb[nt], Y[m][nt]);
        }
    }
    bf16_t* YB = (bf16_t*)(ws + WS_YB);
#pragma unroll
    for (int nt = 0; nt < 2; ++nt) {
        float sum = 0.f;
#pragma unroll
        for (int m = 0; m < 8; ++m) sum += Y[m][nt][0] + Y[m][nt][1] + Y[m][nt][2] + Y[m][nt][3];
        sum = rows_sum(sum);
        const float mu = sum * (1.f / 128.f);
        float vs = 0.f;
#pragma unroll
        for (int m = 0; m < 8; ++m)
#pragma unroll
            for (int r = 0; r < 4; ++r) { const float dlt = Y[m][nt][r] - mu; vs += dlt * dlt; }
        vs = rows_sum(vs);
        const float rstd = rsqrtf(vs * (1.f / 128.f) + 1e-5f);
        const size_t tk = tok0 + 32 * wid + 16 * nt + fr;
#pragma unroll
        for (int m = 0; m < 8; ++m) {
            const f32x4 gt = unpack4(*(const u32x2*)(P + tk * LD + C_GR + h * 128 + 16 * m + 4 * fq));
            f32x4 v;
#pragma unroll
            for (int r = 0; r < 4; ++r) v[r] = (Y[m][nt][r] - mu) * rstd * gt[r];
            *(u32x2*)(YB + tk * 1024 + h * 128 + 16 * m + 4 * fq) = pack4(v);
        }
    }
}
__device__ __forceinline__ void phase_p4_sel(const Params& p, unsigned char* lds) {
    for (int i = ltid(); i < 8192 / 16; i += NTHREADS) ((u32x4*)(lds + SEL_BUCKET))[i] = ((const u32x4*)(launder(p.ws) + WS_BUCKET))[i];
    __syncthreads();
    for (int it = blockIdx.x; it < 512; it += gridDim.x * 2) {
        sel_item<0>(p, it, lds);
        if (511 - it != it) sel_item<0>(p, 511 - it, lds);
    }
    __syncthreads();
}
__device__ __forceinline__ void phase_p4(const Params& p, unsigned char* lds, int half) {
    for (int it = (blockIdx.x * 2 + half); it < 1024; it += (gridDim.x * 2)) retout_item(p, it, lds, half);
}

struct RowOrder {     typedef pg8::Unit U; static constexpr bool GATHER = false;
    unsigned a, b; int K, xcd, slot, per;
    __device__ __forceinline__ bool next(int i, pg8::Unit& u) const { const int t = xcd * 32 + slot + i * per; if (t >= (xcd + 1) * 32) return false; u.pm = t >> 2; u.pn = t & 3; return true; }
    __device__ __forceinline__ void ptrs(const pg8::Unit& u, unsigned& A, unsigned& B) const { A = a + (unsigned)u.pm * 512u * (unsigned)K; B = b + (unsigned)u.pn * 512u * (unsigned)K; }
};
template <int MODE>
struct MixEpi {
    unsigned char* ws; const float* X;
    __device__ __forceinline__ void operator()(const f32x4 (&acc)[2][2][4][2], const pg8::Unit& u, int wr, int wc, int fr, int fq) const {
#pragma unroll
        for (int ai = 0; ai < 2; ++ai)
#pragma unroll
            for (int m = 0; m < 4; ++m) {
                const size_t tok = (size_t)(u.pm * 256 + 128 * ai + 64 * wr + 16 * m + fr + vzero());
#pragma unroll
                for (int bj = 0; bj < 2; ++bj) {
                    const int n = u.pn * 256 + 128 * bj + 32 * wc + 8 * fq;
                    const f32x4 v0 = acc[ai][bj][m][0], v1 = acc[ai][bj][m][1];
                    if (MODE == 2) {
                        const f32x4 x0 = *(const f32x4*)(X + tok * 1024 + n), x1 = *(const f32x4*)(X + tok * 1024 + n + 4);
                        float* H1 = (float*)(ws + WS_H1);
                        *(f32x4*)(H1 + tok * 1024 + n) = x0 * DN_ALPHA + v0; *(f32x4*)(H1 + tok * 1024 + n + 4) = x1 * DN_ALPHA + v1;
                    } else {
                        const u32x4 gw = *(const u32x4*)((const bf16_t*)(ws + WS_P) + tok * LD + (MODE == 0 ? C_MA : C_MB) + n);
                        const f32x4 g0 = unpack4((u32x2){gw.x, gw.y}), g1 = unpack4((u32x2){gw.z, gw.w});
                        f32x4 o0 = g0 * v0, o1 = g1 * v1;
                        bf16_t* MG = (bf16_t*)(ws + WS_MG) + tok * 1024 + n;
                        if (MODE == 1) { const u32x4 pw = *(const u32x4*)MG; o0 = o0 + unpack4((u32x2){pw.x, pw.y}); o1 = o1 + unpack4((u32x2){pw.z, pw.w}); }
                        u32x4 w; w.x = pack2(o0[0], o0[1]); w.y = pack2(o0[2], o0[3]); w.z = pack2(o1[0], o1[1]); w.w = pack2(o1[2], o1[3]);
                        *(u32x4*)MG = w;
                    }
                }
            }
    }
};
__device__ __forceinline__ void phase_g2(const Params& p, unsigned char* lds) {
    unsigned char* ws = launder(p.ws);
    RowOrder S; S.xcd = blockIdx.x & 7; S.slot = blockIdx.x >> 3; S.per = gridDim.x >> 3;
    { S.a = (unsigned)WS_YA; S.b = (unsigned)WS_WA; S.K = 512; MixEpi<0> E; E.ws = ws; E.X = nullptr; pg8::gemm_phase<MixEpi<0>, RowOrder>(lds, 512, S, E, ltid(), ws); }
    { S.a = (unsigned)WS_YB; S.b = (unsigned)WS_WB; S.K = 1024; MixEpi<1> E; E.ws = ws; E.X = nullptr; pg8::gemm_phase<MixEpi<1>, RowOrder>(lds, 1024, S, E, ltid(), ws); }
}
__device__ __forceinline__ void phase_g3(const Params& p, int layer, unsigned char* lds) {
    unsigned char* ws = launder(p.ws);
    RowOrder S; S.xcd = blockIdx.x & 7; S.slot = blockIdx.x >> 3; S.per = gridDim.x >> 3; S.a = (unsigned)WS_MG; S.b = (unsigned)WS_WO; S.K = 1024;
    MixEpi<2> E; E.ws = ws; E.X = layer == 0 ? p.x : (const float*)(ws + WS_X);
    pg8::gemm_phase<MixEpi<2>, RowOrder>(lds, 1024, S, E, ltid(), ws);
}

__device__ __forceinline__ void phase_ln1(const Params& p, int layer, unsigned char* lds, bool dry, int half) {
    unsigned char* ws = launder(p.ws);
    const int tid = (ltid() & 255), lane = tid & 63, wid = tid >> 6;
    float* wrL = (float*)lds;
    {
        float4 wv[16];
#pragma unroll
        for (int k = 0; k < 16; ++k) wv[k] = ((const float4*)p.w_router)[tid + 256 * k];
#pragma unroll
        for (int k = 0; k < 16; ++k) { const int i4 = tid + 256 * k, d = i4 >> 2, e0 = (i4 & 3) * 4;
            wrL[(e0 + 0) * 1024 + d] = wv[k].x; wrL[(e0 + 1) * 1024 + d] = wv[k].y; wrL[(e0 + 2) * 1024 + d] = wv[k].z; wrL[(e0 + 3) * 1024 + d] = wv[k].w; }
    }
    __syncthreads();
    const float* H1 = (const float*)(ws + WS_H1);
    float* X1 = (float*)(ws + WS_X1); bf16_t* X1B = (bf16_t*)(ws + WS_X1B);
    const float* gam = p.ln1_g + layer * 1024; const float* bet = p.ln1_b + layer * 1024;
    unsigned* cnt = (unsigned*)(ws + WS_CTL) + (dry ? 0 : CW_CNT) + layer * 1024;
    int* LIST = (int*)(ws + (dry ? WS_HB : WS_LIST)); float* WTS = (float*)(ws + (dry ? WS_HB + 4194304 : WS_WTS));
    const int tstep = (gridDim.x * 2) * 4;
    float4 vn[4];
    { const int tok0 = (blockIdx.x * 2 + half) * 4 + wid;
#pragma unroll
      for (int j = 0; j < 4; ++j) vn[j] = *(const float4*)(H1 + (size_t)tok0 * 1024 + 256 * j + 4 * lane); }
    for (int tok = (blockIdx.x * 2 + half) * 4 + wid; tok < T_; tok += tstep) {
        float4 v[4];
#pragma unroll
        for (int j = 0; j < 4; ++j) v[j] = vn[j];
        { const int tn = tok + tstep < T_ ? tok + tstep : tok;
#pragma unroll
          for (int j = 0; j < 4; ++j) vn[j] = *(const float4*)(H1 + (size_t)tn * 1024 + 256 * j + 4 * lane); }
        float s = 0.f;
#pragma unroll
        for (int j = 0; j < 4; ++j) s += v[j].x + v[j].y + v[j].z + v[j].w;
        s = wave_sum(s);
        const float mu = s * (1.f / 1024.f);
        float q = 0.f;
#pragma unroll
        for (int j = 0; j < 4; ++j) { const float a = v[j].x - mu, b2 = v[j].y - mu, c = v[j].z - mu, d = v[j].w - mu; q += a * a + b2 * b2 + c * c + d * d; }
        q = wave_sum(q);
        const float rstd = rsqrtf(q * (1.f / 1024.f) + 1e-5f);
        float4 y[4];
#pragma unroll
        for (int j = 0; j < 4; ++j) {
            const int d0 = 256 * j + 4 * lane;
            const float4 gg = *(const float4*)(gam + d0), bb = *(const float4*)(bet + d0);
            y[j].x = (v[j].x - mu) * rstd * gg.x + bb.x; y[j].y = (v[j].y - mu) * rstd * gg.y + bb.y; y[j].z = (v[j].z - mu) * rstd * gg.z + bb.z; y[j].w = (v[j].w - mu) * rstd * gg.w + bb.w;
            *(float4*)(X1 + (size_t)tok * 1024 + d0) = y[j];
            u32x2 w; w.x = pack2(y[j].x, y[j].y); w.y = pack2(y[j].z, y[j].w);
            *(u32x2*)(X1B + (size_t)tok * 1024 + d0) = w;
        }
        float lg[16];
#pragma unroll
        for (int e = 0; e < 16; ++e) {
            float a = 0.f;
#pragma unroll
            for (int j = 0; j < 4; ++j) { const float4 w4 = *(const float4*)(wrL + e * 1024 + 256 * j + 4 * lane); a += y[j].x * w4.x + y[j].y * w4.y + y[j].z * w4.z + y[j].w * w4.w; }
            lg[e] = a;
        }
#pragma unroll
        for (int e = 0; e < 16; ++e) {
            lg[e] = wave_sum(lg[e]);
        }
        float mx = lg[0];
#pragma unroll
        for (int e = 1; e < 16; ++e) mx = fmaxf(mx, lg[e]);
        float pr[16], ps = 0.f;
#pragma unroll
        for (int e = 0; e < 16; ++e) { pr[e] = expf(lg[e] - mx); ps += pr[e]; }
        const float ips = 1.f / ps;
        float sel[16];
#pragma unroll
        for (int e = 0; e < 16; ++e) { pr[e] *= ips; sel[e] = pr[e] + p.router_bias[e]; }
        int best = 0; float bestv = -1e30f;
#pragma unroll
        for (int gI = 0; gI < 4; ++gI) {
            float a = -1e30f, b2 = -1e30f;
#pragma unroll
            for (int k = 0; k < 4; ++k) { const float x = sel[4 * gI + k]; if (x > a) { b2 = a; a = x; } else if (x > b2) b2 = x; }
            const float gs = a + b2;
            if (gs > bestv) { bestv = gs; best = gI; }
        }
        float s4[4], p4[4];
#pragma unroll
        for (int k = 0; k < 4; ++k) { s4[k] = 0.f; p4[k] = 0.f; }
#pragma unroll
        for (int gI = 0; gI < 4; ++gI) if (gI == best) {
#pragma unroll
            for (int k = 0; k < 4; ++k) { s4[k] = sel[4 * gI + k]; p4[k] = pr[4 * gI + k]; }
        }
        int i0 = 0; float a0 = s4[0];
#pragma unroll
        for (int k = 1; k < 4; ++k) if (s4[k] > a0) { a0 = s4[k]; i0 = k; }
        int i1 = -1; float a1 = -1e30f;
#pragma unroll
        for (int k = 0; k < 4; ++k) if (k != i0 && s4[k] > a1) { a1 = s4[k]; i1 = k; }
        float w0 = 0.f, w1 = 0.f;
#pragma unroll
        for (int k = 0; k < 4; ++k) { if (k == i0) w0 = p4[k]; if (k == i1) w1 = p4[k]; }
        const float iw = 1.f / (w0 + w1);
        if (lane == 0) {
            const int e0 = best * 4 + i0, e1 = best * 4 + i1;
            const unsigned p0 = atomicAdd(&cnt[e0 * 64], 1u), p1 = atomicAdd(&cnt[e1 * 64], 1u);
            LIST[(size_t)e0 * T_ + p0] = tok * 2; LIST[(size_t)e1 * T_ + p1] = tok * 2 + 1;
            WTS[tok * 2] = w0 * iw; WTS[tok * 2 + 1] = w1 * iw;
        }
    }
}

struct MoeUnit { int e, rt, ct, cnt, off; };
struct MoeOrderBase {
    const unsigned* cntp; int t_lo, t_hi, slot, per;
    __device__ __forceinline__ void init(const unsigned* cnt) {
        cntp = cnt; int ntile = 0;
#pragma unroll
        for (int k = 0; k < NE; ++k) ntile += ((__builtin_amdgcn_readfirstlane((int)cnt[k * 64]) + 255) >> 8) * 4;
        t_lo = (ntile * (int)(blockIdx.x & 7)) >> 3; t_hi = (ntile * (int)((blockIdx.x & 7) + 1)) >> 3; slot = blockIdx.x >> 3; per = gridDim.x >> 3;
    }
    __device__ __forceinline__ bool next(int i, MoeUnit& u) const {
        const int t = t_lo + slot + i * per; if (t >= t_hi) return false;
        int base = 0, off = 0; bool found = false;
#pragma unroll
        for (int k = 0; k < NE; ++k) {
            const int ck = __builtin_amdgcn_readfirstlane((int)cntp[k * 64]), nt = ((ck + 255) >> 8) * 4;
            if (!found && t < base + nt) { found = true; u.e = k; u.cnt = ck; u.off = off; u.rt = (t - base) >> 2; u.ct = (t - base) & 3; }
            base += nt; off += ck;
        }
        return found;
    }
};
struct M2Order : MoeOrderBase {
    typedef MoeUnit U; static constexpr bool GATHER = true;
    const int* list;
    __device__ __forceinline__ void ptrs(const MoeUnit& u, unsigned& A, unsigned& B) const { A = (unsigned)WS_X1B; B = (unsigned)WS_WG + ((unsigned)u.e * 1024u + (unsigned)u.ct * 256u) * 2048u; }
    __device__ __forceinline__ void rows(const MoeUnit& u, int tid, unsigned (&v)[2][2]) const {
#pragma unroll
        for (int i = 0; i < 2; ++i) { int R, C; pg8::stage_rc((tid + vzero()) * 16 + i * 8192, R, C);
#pragma unroll
            for (int h = 0; h < 2; ++h) { int idx = u.rt * 256 + 128 * h + R; idx = idx < u.cnt ? idx : u.cnt - 1; const int a = (list + (size_t)u.e * T_)[idx]; v[h][i] = ((unsigned)(a >> 1) << 11) + (unsigned)C * 2u; } }
    }
};
struct M3Order : MoeOrderBase {
    typedef MoeUnit U; static constexpr bool GATHER = false;
    __device__ __forceinline__ void ptrs(const MoeUnit& u, unsigned& A, unsigned& B) const { A = (unsigned)WS_HB + ((unsigned)u.off + (unsigned)u.rt * 256u) * 1024u; B = (unsigned)WS_WD + ((unsigned)u.e * 1024u + (unsigned)u.ct * 256u) * 1024u; }
};
struct M2Epi {
    unsigned char* ws;
    __device__ __forceinline__ void operator()(const f32x4 (&acc)[2][2][4][2], const MoeUnit& u, int wr, int wc, int fr, int fq) const {
        bf16_t* HB = (bf16_t*)(ws + WS_HB);
#pragma unroll
        for (int ai = 0; ai < 2; ++ai)
#pragma unroll
            for (int m = 0; m < 4; ++m) {
                const int idx = u.rt * 256 + 128 * ai + 64 * wr + 16 * m + fr + vzero();
                if (idx < u.cnt) {
#pragma unroll
                    for (int bj = 0; bj < 2; ++bj) {
                        const int hcol = 4 * (32 * u.ct + 16 * bj + 4 * wc + fq);
                        const f32x4 gv = acc[ai][bj][m][0], uv = acc[ai][bj][m][1]; f32x4 hv;
#pragma unroll
                        for (int r = 0; r < 4; ++r) hv[r] = gv[r] * fsig(gv[r]) * uv[r];
                        *(u32x2*)(HB + (size_t)(u.off + idx) * 512 + hcol) = pack4(hv);
                    }
                }
            }
    }
};
struct M3Epi {
    unsigned char* ws; const int* list;
    __device__ __forceinline__ void operator()(const f32x4 (&acc)[2][2][4][2], const MoeUnit& u, int wr, int wc, int fr, int fq) const {
        bf16_t* CT = (bf16_t*)(ws + WS_CT);
#pragma unroll
        for (int ai = 0; ai < 2; ++ai)
#pragma unroll
            for (int m = 0; m < 4; ++m) {
                const int idx = u.rt * 256 + 128 * ai + 64 * wr + 16 * m + fr + vzero();
                if (idx < u.cnt) {
                    const int a = list[(size_t)u.e * T_ + idx];
#pragma unroll
                    for (int bj = 0; bj < 2; ++bj) {
                        const int n = u.ct * 256 + 128 * bj + 32 * wc + 8 * fq;
                        const f32x4 v0 = acc[ai][bj][m][0], v1 = acc[ai][bj][m][1];
                        u32x4 w; w.x = pack2(v0[0], v0[1]); w.y = pack2(v0[2], v0[3]); w.z = pack2(v1[0], v1[1]); w.w = pack2(v1[2], v1[3]);
                        *(u32x4*)(CT + (size_t)a * 1024 + n) = w;
                    }
                }
            }
    }
};
__device__ __forceinline__ void phase_m2(const Params& p, int layer, unsigned char* lds) {
    unsigned char* ws = launder(p.ws);
    M2Order S; S.init((const unsigned*)(ws + WS_CTL) + CW_CNT + layer * 1024 + vzero());
    S.list = (const int*)(ws + WS_LIST);
    M2Epi E; E.ws = ws;
    pg8::gemm_phase<M2Epi, M2Order>(lds, 1024, S, E, ltid(), ws);
}
__device__ __forceinline__ void phase_m3(const Params& p, int layer, unsigned char* lds) {
    unsigned char* ws = launder(p.ws);
    M3Order S; S.init((const unsigned*)(ws + WS_CTL) + CW_CNT + layer * 1024 + vzero());
    M3Epi E; E.ws = ws; E.list = (const int*)(ws + WS_LIST);
    pg8::gemm_phase<M3Epi, M3Order>(lds, 512, S, E, ltid(), ws);
}

__device__ __forceinline__ void phase_ln2(const Params& p, int layer, int half) {
    unsigned char* ws = launder(p.ws);
    const int tid = (ltid() & 255), lane = tid & 63, wid = tid >> 6;
    const float* X1 = (const float*)(ws + WS_X1); const bf16_t* CT = (const bf16_t*)(ws + WS_CT); const float* WTS = (const float*)(ws + WS_WTS);
    float* XO = layer == NLAYER - 1 ? p.out : (float*)(ws + WS_X); bf16_t* XB = (bf16_t*)(ws + WS_XB);
    const float* gam = p.ln2_g + layer * 1024; const float* bet = p.ln2_b + layer * 1024;
    constexpr int U = 4;
    const int nwave = (gridDim.x * 2) * 4, wv = (blockIdx.x * 2 + half) * 4 + wid;
    for (int t0 = wv * U; t0 < T_; t0 += nwave * U) {
        float4 v[U][4]; float s[U], q[U];
#pragma unroll
        for (int u = 0; u < U; ++u) {
            const int tok = t0 + u;
            const float w0 = WTS[tok * 2 + vzero()], w1 = WTS[tok * 2 + 1 + vzero()];
            s[u] = 0.f; q[u] = 0.f;
#pragma unroll
            for (int j = 0; j < 4; ++j) {
                const int d0 = 256 * j + 4 * lane;
                const float4 xv = *(const float4*)(X1 + (size_t)tok * 1024 + d0);
                const f32x4 c0 = unpack4(*(const u32x2*)(CT + (size_t)(tok * 2) * 1024 + d0)), c1 = unpack4(*(const u32x2*)(CT + (size_t)(tok * 2 + 1) * 1024 + d0));
                v[u][j].x = xv.x * DN_ALPHA + w0 * c0[0] + w1 * c1[0]; v[u][j].y = xv.y * DN_ALPHA + w0 * c0[1] + w1 * c1[1];
                v[u][j].z = xv.z * DN_ALPHA + w0 * c0[2] + w1 * c1[2]; v[u][j].w = xv.w * DN_ALPHA + w0 * c0[3] + w1 * c1[3];
                s[u] += v[u][j].x + v[u][j].y + v[u][j].z + v[u][j].w;
                q[u] += v[u][j].x * v[u][j].x + v[u][j].y * v[u][j].y + v[u][j].z * v[u][j].z + v[u][j].w * v[u][j].w;
            }
        }
#pragma unroll
        for (int u = 0; u < U; ++u) { s[u] = wave_sum(s[u]); q[u] = wave_sum(q[u]); }
#pragma unroll
        for (int j = 0; j < 4; ++j) {
            const int d0 = 256 * j + 4 * lane;
            const float4 gg = *(const float4*)(gam + d0), bb = *(const float4*)(bet + d0);
#pragma unroll
            for (int u = 0; u < U; ++u) {
                const int tok = t0 + u;
                const float mu = s[u] * (1.f / 1024.f), var = fmaxf(q[u] * (1.f / 1024.f) - mu * mu, 0.f), rstd = rsqrtf(var + 1e-5f);
                float4 y; y.x = (v[u][j].x - mu) * rstd * gg.x + bb.x; y.y = (v[u][j].y - mu) * rstd * gg.y + bb.y; y.z = (v[u][j].z - mu) * rstd * gg.z + bb.z; y.w = (v[u][j].w - mu) * rstd * gg.w + bb.w;
                *(float4*)(XO + (size_t)tok * 1024 + d0) = y;
                u32x2 w; w.x = pack2(y.x, y.y); w.y = pack2(y.z, y.w);
                *(u32x2*)(XB + (size_t)tok * 1024 + d0) = w;
            }
        }
    }
}

#define XB_TMO      128
#define XB_XCNT(j)  (256  + 64 * (j))
#define XB_XSUB(j)  (1280 + 64 * (j))
#define XB_XGEN(j)  (2304 + 64 * (j))
#define XB_TOP      3328
#define XB_TOPGEN   3392
#define XCD_BAR_WORDS 3456
#define XB_SPIN_CAP (1u << 22)
#define LAS __attribute__((address_space(3)))
__device__ __forceinline__ unsigned xb_ld(unsigned* p)              { return __hip_atomic_load(p, __ATOMIC_RELAXED, __HIP_MEMORY_SCOPE_AGENT); }
__device__ __forceinline__ unsigned xb_add(unsigned* p, unsigned v) { return __hip_atomic_fetch_add(p, v, __ATOMIC_RELAXED, __HIP_MEMORY_SCOPE_AGENT); }
__device__ __forceinline__ unsigned xb_xcc_id() { return (unsigned)__builtin_amdgcn_s_getreg((3 << 11) | 20) & 0xFu; }
#define XB_SPIN(cond, bar) do { unsigned _sp = 0; while (cond) { __builtin_amdgcn_s_sleep(1); \
    if ((++_sp & 255u) == 0u) { if (xb_ld(&(bar)[XB_TMO])) break; if (_sp > XB_SPIN_CAP) { atomicAdd(&(bar)[XB_TMO], 1u); break; } } } } while (0)
struct XcdBarrier { unsigned* bar; unsigned x; volatile LAS unsigned* st; };
__device__ __forceinline__ XcdBarrier xcd_barrier_post(unsigned* bar, volatile LAS unsigned* st) {
    XcdBarrier b; b.bar = bar; b.x = xb_xcc_id(); b.st = st;
    if (threadIdx.x == 0) (void)xb_add(&bar[XB_XCNT(b.x)], 1u);
    return b;
}
__device__ __forceinline__ void xcd_barrier_complete(unsigned* bar, unsigned x, unsigned& nloc, unsigned& nx) {
    const unsigned G = gridDim.x * gridDim.y * gridDim.z;
    unsigned sum, cnt, mine, sp = 0u;
    for (;;) {
        sum = 0u; cnt = 0u; mine = 0u;
#pragma unroll
        for (unsigned j = 0; j < 16; ++j) { const unsigned c = xb_ld(&bar[XB_XCNT(j)]); sum += c; cnt += (c > 0u) ? 1u : 0u; mine = (j == x) ? c : mine; }
        if (sum == G) break;
        __builtin_amdgcn_s_sleep(1);
        if ((++sp & 255u) == 0u) { if (xb_ld(&bar[XB_TMO])) break; if (sp > XB_SPIN_CAP) { atomicAdd(&bar[XB_TMO], 1u); break; } }
    }
    nloc = mine > 0u ? mine : 1u; nx = cnt > 0u ? cnt : 1u;
}
__device__ __forceinline__ void xcd_barrier(const XcdBarrier& b) {
    asm volatile("s_waitcnt vmcnt(0)" ::: "memory");
    __syncthreads();
    if (threadIdx.x == 0) {
        unsigned* bar = b.bar;
        __builtin_amdgcn_s_waitcnt(0);
        unsigned nloc = b.st[0], nx = b.st[1];
        if (nloc == 0u) { xcd_barrier_complete(bar, b.x, nloc, nx); b.st[0] = nloc; b.st[1] = nx; }
        const unsigned old = xb_add(&bar[XB_XSUB(b.x)], 1u);
        const unsigned gen = old / nloc;
        if (old + 1u == (gen + 1u) * nloc) {
            __builtin_amdgcn_fence(__ATOMIC_RELEASE, "agent");
            asm volatile("s_waitcnt vmcnt(0)" ::: "memory");
            const unsigned og = xb_add(&bar[XB_TOP], 1u);
            const unsigned tg = og / nx;
            if (og + 1u == (tg + 1u) * nx) xb_add(&bar[XB_TOPGEN], 1u);
            else XB_SPIN(xb_ld(&bar[XB_TOPGEN]) == tg, bar);
            __builtin_amdgcn_fence(__ATOMIC_ACQUIRE, "agent");
            xb_add(&bar[XB_XGEN(b.x)], 1u);
            asm volatile("s_waitcnt vmcnt(0)" ::: "memory");
        } else {
            XB_SPIN(xb_ld(&bar[XB_XGEN(b.x)]) == gen, bar);
            __builtin_amdgcn_fence(__ATOMIC_ACQUIRE, "agent");
            asm volatile("s_waitcnt vmcnt(0)" ::: "memory");
        }
    }
    __syncthreads();
}

constexpr int PH_PER_LAYER = 11, N_PHASES = PH_PER_LAYER * NLAYER;
__global__ void __launch_bounds__(NTHREADS, 2) mega(Params p) {
    extern __shared__ __attribute__((aligned(16))) unsigned char lds[];
#if SINGLE_LAUNCH
    volatile LAS unsigned* xbw = (volatile LAS unsigned*)(lds + LDS_BYTES - 16);
    if (threadIdx.x < 4) xbw[threadIdx.x] = 0u;
    __syncthreads();
    XcdBarrier xbar = xcd_barrier_post((unsigned*)(p.ws + WS_CTL) + CW_BAR, xbw);
#endif
    const int half = __builtin_amdgcn_readfirstlane((int)(threadIdx.x >> 8));
    unsigned char* ldsh = lds + half * HALF_LDS;
    bool second = false;
    for (int ph = p.ph_lo; ph < p.ph_hi; ++ph) {
        const int layer = ph / PH_PER_LAYER, k = ph % PH_PER_LAYER;
        if (k == 0 && layer > 0) continue;
#ifdef ONLY_PHASE
        if (k != ONLY_PHASE) continue;
#endif
        switch (k) {
            case 0: phase_pw(p, layer, ldsh, 1 | 16 | 8, half); break;
            case 1: phase_g1(p, layer, lds); break;
            case 2: phase_p2(p, layer, ldsh, half); if (!second && layer + 1 < NLAYER) { __syncthreads(); phase_pw(p, layer + 1, ldsh, 1, half, 32); } break;
            case 3: phase_p3(p, ldsh, half, second ? ((p.rep_mask >> 16) & 7) : 7); if (!second && layer + 1 < NLAYER) { __syncthreads(); phase_pw(p, layer + 1, ldsh, 16, half); }
                    if (!second && layer == 0) { __syncthreads(); phase_pw(p, 0, ldsh, 2, half); } break;
            case 4: { const int sub = second ? ((p.rep_mask >> 12) & 7) : 7;
                    if (sub & 1) phase_p4_sel(p, lds);
                    if ((sub & 4) && half == 0) { phase_pw(p, layer, ldsh, 4, half); __syncthreads(); }
                    if (sub & 2) phase_p4(p, ldsh, half);
                    if ((sub & 4) && half == 1) { __syncthreads(); phase_pw(p, layer, ldsh, 4, half); } } break;
            case 5: phase_g2(p, lds); break;
            case 6: phase_g3(p, layer, lds); break;
            case 7: phase_ln1(p, layer, ldsh, ((p.rep_mask >> 7) & 1) && !second, half); if (!second && layer + 1 < NLAYER) { __syncthreads(); phase_pw(p, layer + 1, ldsh, 2, half); } break;
            case 8: phase_m2(p, layer, lds); break;
            case 9: phase_m3(p, layer, lds); break;
            case 10: phase_ln2(p, layer, half); break;
        }

        if (ph + 1 < p.ph_hi) { if (ph == p.ph_lo && !second) cg::this_grid().sync(); else xcd_barrier(xbar); }
        if (((p.rep_mask >> k) & 1) && !second) { second = true; --ph; } else second = false;
    }
}

extern "C" void kernel_launch(void* const* d_in, const int* in_sizes, int n_in, void* d_out, int out_size, void* d_ws, size_t ws_size, hipStream_t stream) {
    static int grid = 0;
    if (grid == 0) {
        if (n_in != 18 || ws_size < WS_END) { fprintf(stderr, "kernel_launch: unexpected n_in %d or ws_size %zu < %zu\n", n_in, ws_size, (size_t)WS_END); grid = -1; return; }
        int dev = 0, cus = 0, per_cu = 0;
        hipGetDevice(&dev); hipDeviceGetAttribute(&cus, hipDeviceAttributeMultiprocessorCount, dev);
        hipFuncSetAttribute((const void*)mega, hipFuncAttributeMaxDynamicSharedMemorySize, LDS_BYTES);
        hipOccupancyMaxActiveBlocksPerMultiprocessor(&per_cu, (const void*)mega, NTHREADS, LDS_BYTES);
        if (per_cu < 1) per_cu = 1;
        if (per_cu > 1) per_cu = 1;
        grid = cus * per_cu;
        (void)hipGetLastError();
    }
    if (grid < 0) return;
    Params p{};
    p.x = (const float*)d_in[0]; p.w_in = (const float*)d_in[1]; p.cmp_pos = (const float*)d_in[2]; p.cmp_w1 = (const float*)d_in[3]; p.cmp_w2 = (const float*)d_in[4];
    p.w_br_a = (const float*)d_in[5]; p.w_br_b = (const float*)d_in[6]; p.w_o = (const float*)d_in[7]; p.ln1_g = (const float*)d_in[8]; p.ln1_b = (const float*)d_in[9];
    p.w_router = (const float*)d_in[10]; p.router_bias = (const float*)d_in[11]; p.w_gate = (const float*)d_in[12]; p.w_up = (const float*)d_in[13]; p.w_down = (const float*)d_in[14];
    p.ln2_g = (const float*)d_in[15]; p.ln2_b = (const float*)d_in[16]; p.rel_bias = (const float*)d_in[17];
    p.out = (float*)d_out; p.ws = (unsigned char*)d_ws; p.rep_mask = REPEAT_MASK;
#if SINGLE_LAUNCH
    hipMemsetAsync((unsigned char*)d_ws + WS_CTL + (size_t)CW_BAR * 4, 0, XCD_BAR_WORDS * 4, stream);
    p.ph_lo = 0; p.ph_hi = N_PHASES;
    void* args[] = {&p};
    hipError_t e = hipLaunchCooperativeKernel((const void*)mega, dim3(grid), dim3(NTHREADS), args, LDS_BYTES, stream);
    if (e != hipSuccess) fprintf(stderr, "cooperative launch failed: %s (grid %d)\n", hipGetErrorString(e), grid);
#else
    for (int ph = 0; ph < N_PHASES; ++ph) {
        p.ph_lo = ph; p.ph_hi = ph + 1;
        hipLaunchKernelGGL(mega, dim3(grid), dim3(NTHREADS), LDS_BYTES, stream, p);
    }
#endif
}
```

```cpp
#include <hip/hip_runtime.h>
#include <hip/hip_cooperative_groups.h>
#include <cstdio>
#include <cstdint>
namespace cg = cooperative_groups;

#ifndef REPEAT_MASK
#define REPEAT_MASK 0
#endif
#ifndef SINGLE_LAUNCH
#define SINGLE_LAUNCH 1
#endif

typedef unsigned short bf16_t;
typedef short bf16x8 __attribute__((ext_vector_type(8)));
typedef float f32x4 __attribute__((ext_vector_type(4)));
typedef unsigned u32x2 __attribute__((ext_vector_type(2)));
typedef unsigned u32x4 __attribute__((ext_vector_type(4)));

constexpr int B_ = 2, S_ = 8192, D_ = 1024, T_ = B_ * S_, NLAYER = 4;
constexpr int DIN = 6424;
constexpr int LD = 5376;
constexpr int NW = 6656;
constexpr int C_QA = 0, C_KC = 512, C_VC = 640, C_KS = 768, C_KW = 896, C_QR = 1024, C_KR = 1536, C_GR = 2048, C_MA = 3072, C_MB = 4096, C_GA = 5120,
              C_VS = 5376, C_VW = 5504, C_VR = 5632;
constexpr float DN_ALPHA = 1.681792830507429f;
constexpr int NE = 16;

constexpr size_t al256(size_t x) { return (x + 255) & ~(size_t)255; }
constexpr size_t WS_CTL = 0;
constexpr size_t WS_BUCKET = 65536;
constexpr size_t WS_ROPE = WS_BUCKET + 8192;
constexpr size_t WS_WIN = WS_ROPE + (size_t)8192 * 32 * 8;
constexpr size_t WS_WA = WS_WIN + (size_t)NW * 1024 * 2;
constexpr size_t WS_WB = WS_WA + (size_t)1024 * 512 * 2;
constexpr size_t WS_WO = WS_WB + (size_t)1024 * 1024 * 2;
constexpr size_t WS_WG = WS_WO + (size_t)1024 * 1024 * 2;
constexpr size_t WS_WU = WS_WG + (size_t)16 * 512 * 1024 * 2;
constexpr size_t WS_WD = WS_WU + (size_t)16 * 512 * 1024 * 2;
constexpr size_t WS_XB = WS_WD + (size_t)16 * 512 * 1024 * 2;
constexpr size_t WS_X = WS_XB + (size_t)T_ * 1024 * 2;
constexpr size_t WS_MG = WS_X + (size_t)T_ * 1024 * 4;
constexpr size_t WS_KCC = WS_MG + (size_t)T_ * 1024 * 2;
constexpr size_t WS_VCCT = WS_KCC + (size_t)4 * 512 * 64 * 2;
constexpr size_t WS_W1T = WS_VCCT + (size_t)4 * 512 * 64 * 2;
constexpr size_t WS_B1 = WS_W1T + (size_t)2 * 64 * 2048 * 2;
constexpr size_t WS_R = WS_B1 + 1024;
constexpr size_t WS_P = WS_R;
constexpr size_t WS_VST = WS_P + (size_t)T_ * LD * 2;
constexpr size_t WS_VWT = WS_VST + (size_t)4 * 64 * S_ * 2;
constexpr size_t WS_VRT = WS_VWT + (size_t)4 * 64 * S_ * 2;
constexpr size_t WS_KVT = WS_VRT + (size_t)16 * 128 * S_ * 2;
constexpr size_t WS_SPT = WS_KVT + (size_t)16 * 64 * 8192 * 4;
constexpr size_t WS_YC = WS_SPT + (size_t)16 * 64 * 8192 * 2;
constexpr size_t WS_YW = WS_YC + (size_t)T_ * 512 * 2;
constexpr size_t WS_YA = WS_YW + (size_t)T_ * 512 * 2;
constexpr size_t WS_YB = WS_YA + (size_t)T_ * 512 * 2;
constexpr size_t WS_SELW = WS_YB + (size_t)T_ * 1024 * 2;
constexpr size_t WS_ENDA = WS_SELW + (size_t)T_ * 2 * 4 * 4;
constexpr size_t WS_H1 = WS_R;
constexpr size_t WS_X1 = WS_H1 + (size_t)T_ * 1024 * 4;
constexpr size_t WS_X1B = WS_X1 + (size_t)T_ * 1024 * 4;
constexpr size_t WS_HB = WS_X1B + (size_t)T_ * 1024 * 2;
constexpr size_t WS_CT = WS_HB + (size_t)2 * T_ * 512 * 2;
constexpr size_t WS_LIST = WS_CT + (size_t)2 * T_ * 1024 * 2;
constexpr size_t WS_WTS = WS_LIST + (size_t)16 * T_ * 4;
constexpr size_t WS_ENDB = WS_WTS + (size_t)2 * T_ * 4;
static_assert(WS_HB + (size_t)2 * T_ * 512 * 2 <= WS_CT, "view B overlap");
constexpr size_t WS_END = WS_ENDA > WS_ENDB ? WS_ENDA : WS_ENDB;

constexpr int CW_CNT = 4096;
constexpr int CW_BAR = 8192;

constexpr int HALF_LDS = 75776, LDS_BYTES = 2 * HALF_LDS + 16;
constexpr int NTHREADS = 512, HT = 256;

struct Params {
    const float* x; const float* w_in; const float* cmp_pos; const float* cmp_w1; const float* cmp_w2;
    const float* w_br_a; const float* w_br_b; const float* w_o; const float* ln1_g; const float* ln1_b;
    const float* w_router; const float* router_bias; const float* w_gate; const float* w_up; const float* w_down;
    const float* ln2_g; const float* ln2_b; const float* rel_bias;
    float* out; unsigned char* ws;
    int ph_lo, ph_hi, rep_mask, pad_;
};

__device__ __forceinline__ bf16_t f2bf(float f) { unsigned u = __float_as_uint(f); u += 0x7fffu + ((u >> 16) & 1u); return (bf16_t)(u >> 16); }
__device__ __forceinline__ float bf2f(unsigned h) { return __uint_as_float(h << 16); }
typedef __bf16 bf16x2_t __attribute__((ext_vector_type(2)));
typedef float f32x2_t __attribute__((ext_vector_type(2)));
__device__ __forceinline__ unsigned pack2(float lo, float hi) { const f32x2_t f = {lo, hi}; return __builtin_bit_cast(unsigned, __builtin_convertvector(f, bf16x2_t)); }
__device__ __forceinline__ u32x2 pack4(f32x4 v) { u32x2 r; r.x = pack2(v[0], v[1]); r.y = pack2(v[2], v[3]); return r; }
__device__ __forceinline__ f32x4 unpack4(u32x2 u) { f32x4 r; r[0] = bf2f(u.x & 0xffffu); r[1] = bf2f(u.x >> 16); r[2] = bf2f(u.y & 0xffffu); r[3] = bf2f(u.y >> 16); return r; }
__device__ __forceinline__ float rows_max(float v) {
    u32x2 r = __builtin_amdgcn_permlane16_swap(__float_as_uint(v), __float_as_uint(v), false, false);
    v = fmaxf(__uint_as_float(r.x), __uint_as_float(r.y));
    r = __builtin_amdgcn_permlane32_swap(__float_as_uint(v), __float_as_uint(v), false, false);
    return fmaxf(__uint_as_float(r.x), __uint_as_float(r.y));
}
__device__ __forceinline__ float rows_sum(float v) {
    u32x2 r = __builtin_amdgcn_permlane16_swap(__float_as_uint(v), __float_as_uint(v), false, false);
    v = __uint_as_float(r.x) + __uint_as_float(r.y);
    r = __builtin_amdgcn_permlane32_swap(__float_as_uint(v), __float_as_uint(v), false, false);
    return __uint_as_float(r.x) + __uint_as_float(r.y);
}
__device__ __forceinline__ float wave_sum(float v) {
    v += __int_as_float(__builtin_amdgcn_mov_dpp(__float_as_int(v), 0xB1, 0xF, 0xF, true));
    v += __int_as_float(__builtin_amdgcn_mov_dpp(__float_as_int(v), 0x4E, 0xF, 0xF, true));
    v += __int_as_float(__builtin_amdgcn_mov_dpp(__float_as_int(v), 0x141, 0xF, 0xF, true));
    v += __int_as_float(__builtin_amdgcn_mov_dpp(__float_as_int(v), 0x140, 0xF, 0xF, true));
    return rows_sum(v);
}
__device__ __forceinline__ float sigmoidf_(float x) { return 1.f / (1.f + __expf(-x)); }
__device__ __forceinline__ int ltid() { int t = threadIdx.x; asm volatile("" : "+v"(t)); return t; }
__device__ __forceinline__ int vzero() { int z; asm volatile("v_mov_b32 %0, 0" : "=v"(z)); return z; }
__device__ __forceinline__ unsigned char* launder(unsigned char* q) { asm volatile("" : "+s"(q)); return q; }
__device__ __forceinline__ void wait_vm0() { asm volatile("s_waitcnt vmcnt(0)" ::: "memory"); }

__device__ __forceinline__ void glds16(const void* g, void* l) {
    __builtin_amdgcn_global_load_lds((const __attribute__((address_space(1))) unsigned*)g,
                                     (__attribute__((address_space(3))) unsigned*)l, 16, 0, 0);
}
__device__ __forceinline__ f32x4 mfma16(bf16x8 a, bf16x8 b, f32x4 c) { return __builtin_amdgcn_mfma_f32_16x16x32_bf16(a, b, c, 0, 0, 0); }

#define WAIT_V(n) asm volatile("s_waitcnt vmcnt(%0)" ::"n"(n) : "memory")
#define RAW_BARRIER() do { asm volatile("s_waitcnt lgkmcnt(0)" ::: "memory"); __builtin_amdgcn_s_barrier(); } while (0)
__device__ __forceinline__ void bglds16(__amdgpu_buffer_rsrc_t r, unsigned voff, int soff, void* l) {
    __builtin_amdgcn_raw_ptr_buffer_load_lds(r, (__attribute__((address_space(3))) void*)l, 16, (int)voff, soff, 0, 0);
}
template <int NJ, bool GN>
__device__ __forceinline__ void gemm8_stage(__amdgpu_buffer_rsrc_t mr, int mld, unsigned mvo, __amdgpu_buffer_rsrc_t nr, int nld, const unsigned (&nvo)[NJ], int kt, unsigned char* st, int wid) {
#pragma unroll
    for (int i = 0; i < 4; ++i) bglds16(mr, mvo, (64 * i * mld + kt * 64) * 2, st + (8 * i + wid) * 1024);
#pragma unroll
    for (int i = 0; i < NJ; ++i) bglds16(nr, nvo[i], ((GN ? 0 : 64 * i * nld) + kt * 64) * 2, st + 32768 + (8 * i + wid) * 1024);
}
template <int NJ, bool GN>
__device__ __forceinline__ void gemm8_kloop(const bf16_t* mb, int mld, unsigned mvo, const bf16_t* nb, int nld, const unsigned (&nvo)[NJ], int nk, unsigned char* lds, f32x4 (&acc)[8][NJ], int tid) {
    const int lane = tid & 63, wid = tid >> 6, wr = wid >> 2, wc = wid & 3, fr = lane & 15, fq = lane >> 4;
    const __amdgpu_buffer_rsrc_t mr = __builtin_amdgcn_make_buffer_rsrc((void*)mb, 0, 0x7fffffff, 0x00020000);
    const __amdgpu_buffer_rsrc_t nr = __builtin_amdgcn_make_buffer_rsrc((void*)nb, 0, 0x7fffffff, 0x00020000);
    gemm8_stage<NJ, GN>(mr, mld, mvo, nr, nld, nvo, 0, lds, wid);
    gemm8_stage<NJ, GN>(mr, mld, mvo, nr, nld, nvo, 1, lds + 65536, wid);
    for (int kt = 0; kt < nk; ++kt) {
        unsigned char* cur = lds + (kt & 1) * 65536;
        if (kt + 1 < nk) WAIT_V(4 + NJ); else WAIT_V(0);
        RAW_BARRIER();
        bf16x8 a[4], b[NJ];
        const unsigned char* ab = cur + (128 * wr + fr) * 128;
        const unsigned char* bb = cur + 32768 + (16 * NJ * wc + fr) * 128;
        const int sw0 = ((fq) ^ (fr & 7)) << 4, sw1 = ((4 + fq) ^ (fr & 7)) << 4;
#pragma unroll
        for (int j = 0; j < NJ; ++j) b[j] = *(const bf16x8*)(bb + j * 2048 + sw0);
#pragma unroll
        for (int mh = 0; mh < 2; ++mh) {
#pragma unroll
            for (int i = 0; i < 4; ++i) a[i] = *(const bf16x8*)(ab + (4 * mh + i) * 2048 + sw0);
#pragma unroll
            for (int i = 0; i < 4; ++i)
#pragma unroll
                for (int j = 0; j < NJ; ++j) acc[4 * mh + i][j] = mfma16(a[i], b[j], acc[4 * mh + i][j]);
        }
#pragma unroll
        for (int j = 0; j < NJ; ++j) b[j] = *(const bf16x8*)(bb + j * 2048 + sw1);
#pragma unroll
        for (int i = 0; i < 4; ++i) a[i] = *(const bf16x8*)(ab + i * 2048 + sw1);
#pragma unroll
        for (int i = 0; i < 4; ++i)
#pragma unroll
            for (int j = 0; j < NJ; ++j) acc[i][j] = mfma16(a[i], b[j], acc[i][j]);
#pragma unroll
        for (int i = 0; i < 4; ++i) a[i] = *(const bf16x8*)(ab + (4 + i) * 2048 + sw1);
        RAW_BARRIER();
        if (kt + 2 < nk) gemm8_stage<NJ, GN>(mr, mld, mvo, nr, nld, nvo, kt + 2, cur, wid);
#pragma unroll
        for (int i = 0; i < 4; ++i)
#pragma unroll
            for (int j = 0; j < NJ; ++j) acc[4 + i][j] = mfma16(a[i], b[j], acc[4 + i][j]);
    }
    __syncthreads();
    __builtin_amdgcn_sched_barrier(0);
}
template <int NJ>
__device__ __forceinline__ void zero_acc8(f32x4 (&acc)[8][NJ]) {
#pragma unroll
    for (int i = 0; i < 8; ++i)
#pragma unroll
        for (int j = 0; j < NJ; ++j) acc[i][j] = (f32x4){0.f, 0.f, 0.f, 0.f};
}

namespace pg8 {
#define PG8_LAS __attribute__((address_space(3)))
constexpr int BM = 256, BK = 64, HALF = 128, HTB = HALF * BK * 2, STAGE_BYTES = 8 * HTB;
__device__ __forceinline__ int lds_byte(int r, int c) { const int st = (r >> 4) * 2 + (c >> 5), rr = r & 15, cc = c & 31, ob = rr * 64 + cc * 2; return st * 1024 + (ob ^ (((ob >> 9) & 1) << 5)); }
__device__ __forceinline__ void stage_rc(int b, int& R, int& C) { const int st = b / 1024, sb = b % 1024, swz = sb ^ (((sb >> 9) & 1) << 5); R = (st >> 1) * 16 + swz / 64; C = (st & 1) * 32 + (swz % 64) / 2; }
__device__ __forceinline__ int perm32(int rho) { const int n = rho >> 4, i = rho & 15; return 8 * (i >> 2) + 4 * n + (i & 3); }
struct Unit { int pm, pn; };
template <class Epi, class Sched>
__device__ __forceinline__ void gemm_phase(unsigned char* lds_, const int K, const Sched& S, const Epi& E, const int tid, const unsigned char* wsbase) {
    PG8_LAS unsigned char* lds = (PG8_LAS unsigned char*)lds_;
    const int wid = __builtin_amdgcn_readfirstlane(tid >> 6), lane = tid & 63, wr = wid >> 2, wc = wid & 3, fr = lane & 15, fq = lane >> 4;
    const int nt = K / BK;
    unsigned voffA[2], voffB[2];
#pragma unroll
    for (int i = 0; i < 2; ++i) { int R, C; stage_rc(tid * 16 + i * 8192, R, C); const int Rb = (R & ~31) + perm32(R & 31);
        voffA[i] = (unsigned)(R * K + C) * 2u; voffB[i] = (unsigned)(Rb * K + C) * 2u; }
    const unsigned kstep = (unsigned)(BK * 2);
    const unsigned hstep = (unsigned)HALF * K * 2;
    const __amdgpu_buffer_rsrc_t rsrc = __builtin_amdgcn_make_buffer_rsrc((void*)wsbase, 0, 0x7fffffff, 0x00020000);
    const unsigned ldsw = (unsigned)wid * 1024u;
    const int aoff = lds_byte(wr * 64 + fr, fq * 8), boff = lds_byte(wc * 32 + fr, fq * 8);
#define PG8_SA(b, h) (((b) * 2 + (h)) * HTB)
#define PG8_SB(b, h) ((4 + (b) * 2 + (h)) * HTB)
#define PG8_STAGE(bufoff, gbase, voff) do { _Pragma("unroll") for (int _i = 0; _i < 2; ++_i) \
        __builtin_amdgcn_raw_ptr_buffer_load_lds(rsrc, (PG8_LAS void*)(lds + (bufoff) + ldsw + _i * 8192), 16, (int)(voff)[_i], (int)(gbase), 0, 0); } while (0)
#define PG8_LDA(dst, b, h) do { _Pragma("unroll") for (int m = 0; m < 4; ++m) _Pragma("unroll") for (int k = 0; k < 2; ++k) dst[m][k] = *(const PG8_LAS bf16x8*)(lds + PG8_SA(b, h) + aoff + m * 2048 + k * 1024); } while (0)
#define PG8_LDB(dst, b, h) do { _Pragma("unroll") for (int n = 0; n < 2; ++n) _Pragma("unroll") for (int k = 0; k < 2; ++k) dst[n][k] = *(const PG8_LAS bf16x8*)(lds + PG8_SB(b, h) + boff + n * 2048 + k * 1024); } while (0)
#define PG8_MMA(ai, bj, At, Bt) do { __builtin_amdgcn_s_setprio(1); _Pragma("unroll") for (int m = 0; m < 4; ++m) _Pragma("unroll") for (int n = 0; n < 2; ++n) _Pragma("unroll") for (int k = 0; k < 2; ++k) \
        acc[ai][bj][m][n] = __builtin_amdgcn_mfma_f32_16x16x32_bf16(Bt[n][k], At[m][k], acc[ai][bj][m][n], 0, 0, 0); __builtin_amdgcn_s_setprio(0); } while (0)
#define PG8_WAIT_V(n) asm volatile("s_waitcnt vmcnt(" #n ")" ::: "memory")
#define PG8_WAIT_L(n) asm volatile("s_waitcnt lgkmcnt(" #n ")" ::: "memory")
#define PG8_BAR __builtin_amdgcn_s_barrier()
#define PG8_SCHED __builtin_amdgcn_sched_barrier(0)
    typename Sched::U cur, nxt; int ui = 0;
    if (!S.next(0, cur)) return;
    unsigned cA, cB; S.ptrs(cur, cA, cB);
    constexpr bool GA = Sched::GATHER;
    unsigned vA[GA ? 2 : 1][2], nvA[GA ? 2 : 1][2];
    if constexpr (GA) { S.rows(cur, tid, vA);
#pragma unroll
        for (int h = 0; h < 2; ++h)
#pragma unroll
            for (int i = 0; i < 2; ++i) nvA[h][i] = vA[h][i]; }
#define PG8_STAGE_A(bufoff, gbase, h, nextu) do { if constexpr (GA) { if (nextu) PG8_STAGE(bufoff, gbase, nvA[h]); else PG8_STAGE(bufoff, gbase, vA[h]); } \
        else PG8_STAGE(bufoff, (gbase) + (h) * hstep, voffA); } while (0)
    PG8_STAGE(PG8_SB(0, 0), cB, voffB); PG8_STAGE_A(PG8_SA(0, 0), cA, 0, false); PG8_STAGE(PG8_SB(0, 1), cB + hstep, voffB); PG8_STAGE_A(PG8_SA(0, 1), cA, 1, false);
    if (wr == 1) PG8_BAR;
    PG8_WAIT_V(4); PG8_BAR;
    PG8_STAGE(PG8_SB(1, 0), cB + kstep, voffB); PG8_STAGE_A(PG8_SA(1, 0), cA + kstep, 0, false); PG8_STAGE(PG8_SB(1, 1), cB + hstep + kstep, voffB);
    PG8_WAIT_V(6); PG8_BAR;
    PG8_SCHED;
    f32x4 acc[2][2][4][2];
#pragma unroll
    for (int a = 0; a < 2; ++a)
#pragma unroll
        for (int b = 0; b < 2; ++b)
#pragma unroll
            for (int m = 0; m < 4; ++m)
#pragma unroll
                for (int n = 0; n < 2; ++n) acc[a][b][m][n] = (f32x4){0.f, 0.f, 0.f, 0.f};
    bf16x8 At[4][2], B0[2][2], B1[2][2];
    for (;;) {
        const bool has_next = S.next(ui + 1, nxt);
        unsigned nA = cA, nB = cB; if (has_next) S.ptrs(nxt, nA, nB);
        if constexpr (GA) { if (has_next) S.rows(nxt, tid, nvA); }
        for (int t = 0; t < nt; t += 2) {
            const bool last = (t == nt - 2);
            const unsigned a1 = cA + (unsigned)(t + 1) * kstep;
            const unsigned a2 = last ? nA : cA + (unsigned)(t + 2) * kstep, b2 = last ? nB : cB + (unsigned)(t + 2) * kstep;
            const unsigned a3 = a2 + kstep, b3 = b2 + kstep;
            PG8_LDB(B0, 0, 0); PG8_SCHED; PG8_LDA(At, 0, 0); PG8_STAGE_A(PG8_SA(1, 1), a1, 1, false);
            PG8_WAIT_L(8); PG8_BAR; PG8_WAIT_L(0); PG8_MMA(0, 0, At, B0); PG8_BAR; PG8_SCHED;
            PG8_LDB(B1, 0, 1); PG8_STAGE(PG8_SB(0, 0), b2, voffB);
            PG8_BAR; PG8_WAIT_L(0); PG8_MMA(0, 1, At, B1); PG8_BAR;
            PG8_LDA(At, 0, 1); PG8_STAGE_A(PG8_SA(0, 0), a2, 0, last);
            PG8_BAR; PG8_WAIT_L(0); PG8_MMA(1, 0, At, B0); PG8_BAR; PG8_SCHED;
            PG8_STAGE(PG8_SB(0, 1), b2 + hstep, voffB);
            PG8_WAIT_V(6); PG8_BAR; PG8_MMA(1, 1, At, B1); PG8_BAR;
            PG8_LDB(B0, 1, 0); PG8_SCHED; PG8_LDA(At, 1, 0); PG8_STAGE_A(PG8_SA(0, 1), a2, 1, last);
            PG8_WAIT_L(8); PG8_BAR; PG8_WAIT_L(0); PG8_MMA(0, 0, At, B0); PG8_BAR; PG8_SCHED;
            PG8_LDB(B1, 1, 1); PG8_STAGE(PG8_SB(1, 0), b3, voffB);
            PG8_BAR; PG8_WAIT_L(0); PG8_MMA(0, 1, At, B1); PG8_BAR;
            PG8_LDA(At, 1, 1); PG8_STAGE_A(PG8_SA(1, 0), a3, 0, last);
            PG8_BAR; PG8_WAIT_L(0); PG8_MMA(1, 0, At, B0); PG8_BAR; PG8_SCHED;
            PG8_STAGE(PG8_SB(1, 1), b3 + hstep, voffB);
            PG8_WAIT_V(6); PG8_BAR; PG8_MMA(1, 1, At, B1); PG8_BAR;
        }
        E(acc, cur, wr, wc, fr, fq);
        if (!has_next) break;
#pragma unroll
        for (int a = 0; a < 2; ++a)
#pragma unroll
            for (int b = 0; b < 2; ++b)
#pragma unroll
                for (int m = 0; m < 4; ++m)
#pragma unroll
                    for (int n = 0; n < 2; ++n) acc[a][b][m][n] = (f32x4){0.f, 0.f, 0.f, 0.f};
        cur = nxt; cA = nA; cB = nB; ++ui;
        if constexpr (GA) {
#pragma unroll
            for (int h = 0; h < 2; ++h)
#pragma unroll
                for (int i = 0; i < 2; ++i) vA[h][i] = nvA[h][i]; }
    }
    PG8_WAIT_V(0);
    if (wr == 0) PG8_BAR;
    PG8_BAR;
#undef PG8_SA
#undef PG8_SB
#undef PG8_STAGE
#undef PG8_STAGE_A
#undef PG8_LDA
#undef PG8_LDB
#undef PG8_MMA
#undef PG8_WAIT_V
#undef PG8_WAIT_L
#undef PG8_BAR
#undef PG8_SCHED
}
}

struct TJob { const float* src; bf16_t* dst; int ld, k0, n0, mode, kdst; };
__device__ __forceinline__ void tcvt_load(const TJob& J, float4 (&v)[4], int tid) {
#pragma unroll
    for (int i = 0; i < 4; ++i) {
        const int kk = (tid >> 4) + 16 * i, c4 = (tid & 15) * 4, cd = J.n0 + c4;
        int orig = cd; bool ok = true;
        if (J.mode == 1) {
            if (cd < 896) orig = cd;
            else if (cd < 1024) orig = cd - 896 + 1024;
            else if (cd < 2048) { const int q = cd - 1024, hd = q >> 6, pp = q & 63;
                const int d = (pp & 4) ? 32 + 4 * (pp >> 3) + (pp & 3) : 4 * (pp >> 3) + (pp & 3);
                orig = 1304 + hd * 64 + d; }
            else if (cd < 5120) orig = cd - 2048 + 3352;
            else if (cd < 5144) orig = cd - 5120 + 1280;
            else if (cd < 5376) ok = false;
            else if (cd < 5504) orig = cd - 5376 + 896;
            else if (cd < 5632) orig = cd - 5504 + 1152;
            else orig = cd - 5632 + 2328;
        }
        v[i] = make_float4(0.f, 0.f, 0.f, 0.f);
        if (ok) v[i] = *(const float4*)(J.src + (size_t)(J.k0 + kk) * J.ld + orig);
    }
}
__device__ __forceinline__ void tcvt_finish(const TJob& J, const float4 (&v)[4], unsigned char* lds, int tid) {
    float* tile = (float*)lds;
#pragma unroll
    for (int i = 0; i < 4; ++i) {
        const int kk = (tid >> 4) + 16 * i, c4 = (tid & 15) * 4;
        tile[kk * 65 + c4 + 0] = v[i].x; tile[kk * 65 + c4 + 1] = v[i].y; tile[kk * 65 + c4 + 2] = v[i].z; tile[kk * 65 + c4 + 3] = v[i].w;
    }
    __syncthreads();
#pragma unroll
    for (int i = 0; i < 2; ++i) {
        const int q = tid + 256 * i, n = q >> 3, kc = q & 7;
        float x[8];
#pragma unroll
        for (int j = 0; j < 8; ++j) x[j] = tile[(kc * 8 + j) * 65 + n];
        u32x4 w; w.x = pack2(x[0], x[1]); w.y = pack2(x[2], x[3]); w.z = pack2(x[4], x[5]); w.w = pack2(x[6], x[7]);
        int drow = J.n0 + n; if (J.mode >= 2) drow = 8 * (drow >> 2) + (drow & 3) + (J.mode == 3 ? 4 : 0);
        *(u32x4*)(J.dst + (size_t)drow * J.kdst + J.k0 + kc * 8) = w;
    }
    __syncthreads();
}
__device__ __forceinline__ void tcvt_tile(const float* src, int ld_src, int k0, int n0, int mode, bf16_t* dst, int kdst, unsigned char* lds, int half) {
    TJob J; J.src = src; J.dst = dst; J.ld = ld_src; J.k0 = k0; J.n0 = n0; J.mode = mode; J.kdst = kdst;
    const int tid = (ltid() & 255); float4 v[4];
    tcvt_load(J, v, tid); tcvt_finish(J, v, lds, tid);
}

__device__ __forceinline__ void tcvt_decode(const Params& p, unsigned char* ws, int layer, int t, TJob& J) {
    constexpr int J0 = 16 * 104, J1 = 8 * 16, J2 = 256, J3 = 256, J4 = 2048, J5 = 2048;
    int u = t;
        if (u < J0) { J.src = p.w_in + (size_t)layer * 1024 * DIN; J.ld = DIN; J.k0 = (u % 16) * 64; J.n0 = (u / 16) * 64; J.mode = 1; J.dst = (bf16_t*)(ws + WS_WIN); J.kdst = 1024; return; }
        u -= J0;
        if (u < J1) { J.src = p.w_br_a + (size_t)layer * 512 * 1024; J.ld = 1024; J.k0 = (u % 8) * 64; J.n0 = (u / 8) * 64; J.mode = 0; J.dst = (bf16_t*)(ws + WS_WA); J.kdst = 512; return; }
        u -= J1;
        if (u < J2) { J.src = p.w_br_b + (size_t)layer * 1024 * 1024; J.ld = 1024; J.k0 = (u % 16) * 64; J.n0 = (u / 16) * 64; J.mode = 0; J.dst = (bf16_t*)(ws + WS_WB); J.kdst = 1024; return; }
        u -= J2;
        if (u < J3) { J.src = p.w_o + (size_t)layer * 1024 * 1024; J.ld = 1024; J.k0 = (u % 16) * 64; J.n0 = (u / 16) * 64; J.mode = 0; J.dst = (bf16_t*)(ws + WS_WO); J.kdst = 1024; return; }
        u -= J3;
        if (u < J4 + J5) {
            const bool up = u >= J4; if (up) u -= J4;
            const int e = u / 128, v = u % 128;
            J.src = (up ? p.w_up : p.w_gate) + ((size_t)layer * NE + e) * 1024 * 512; J.ld = 512; J.k0 = (v % 16) * 64; J.n0 = (v / 16) * 64; J.mode = up ? 3 : 2;
            J.dst = (bf16_t*)(ws + WS_WG) + (size_t)e * 1024 * 1024; J.kdst = 1024; return;
        }
        u -= J4 + J5;
        { const int e = u / 128, v = u % 128;
          J.src = p.w_down + ((size_t)layer * NE + e) * 512 * 1024; J.ld = 1024; J.k0 = (v % 8) * 64; J.n0 = (v / 8) * 64; J.mode = 0; J.dst = (bf16_t*)(ws + WS_WD) + (size_t)e * 1024 * 512; J.kdst = 512; }
}


__device__ __forceinline__ void phase_pw(const Params& p, int layer, unsigned char* lds, int parts, int half, int skip = 0) {
    if ((int)(blockIdx.x * 2 + half) < skip) return;
    const int bid = (blockIdx.x * 2 + half) - skip, nblk = (gridDim.x * 2) - skip, tid = (ltid() & 255);
    unsigned char* ws = launder(p.ws);
    constexpr int J0 = 16 * 104, J1 = 8 * 16, J2 = 256, J3 = 256, J4 = 2048, J5 = 2048, J6 = 2048, JT = J0 + J1 + J2 + J3 + J4 + J5 + J6;
    const int t_lo = (parts & 1) ? 0 : (parts & 2) ? J0 : J0 + J1 + J2 + J3;
    const int t_hi = (parts & 4) ? JT : (parts & 2) ? J0 + J1 + J2 + J3 : (parts & 1) ? J0 : 0;
    if (t_lo + bid < t_hi) {
        float4 v[4]; { TJob J; tcvt_decode(p, ws, layer, t_lo + bid, J); tcvt_load(J, v, tid); }
        for (int t = t_lo + bid; t < t_hi; t += nblk) {
            float4 vn[4];
            if (t + nblk < t_hi) { TJob J; tcvt_decode(p, ws, layer, t + nblk, J); tcvt_load(J, vn, tid); }
            { TJob J; tcvt_decode(p, ws, layer, t, J); tcvt_finish(J, v, lds, tid); }
#pragma unroll
            for (int i = 0; i < 4; ++i) v[i] = vn[i];
        }
    }
    if (parts & 16) {
    for (int t = bid; t < 64; t += nblk) {
        const int kv = t >> 5, kt = t & 31;
        tcvt_tile(p.cmp_w1 + ((size_t)layer * 2 + kv) * 2048 * 64, 64, kt * 64, 0, 0, (bf16_t*)(ws + WS_W1T) + (size_t)kv * 64 * 2048, 2048, lds, half);
    }
    if (bid >= nblk - 2) {
        const int kv = nblk - 1 - bid, n = tid & 63, part = tid >> 6;
        const float* w1 = p.cmp_w1 + ((size_t)layer * 2 + kv) * 2048 * 64; const float* pos = p.cmp_pos + ((size_t)layer * 2 + kv) * 2048;
        float a = 0.f;
        for (int k = part * 512; k < part * 512 + 512; ++k) a += pos[k] * w1[(size_t)k * 64 + n];
        float* red = (float*)lds;
        __syncthreads(); red[tid] = a; __syncthreads();
        if (tid < 64) ((float*)(ws + WS_B1))[kv * 64 + tid] = red[tid] + red[tid + 64] + red[tid + 128] + red[tid + 192];
        __syncthreads();
    }
    }
    if (parts & 8) {
        const float4* xs = (const float4*)p.x; u32x2* xb = (u32x2*)(ws + WS_XB);
        for (size_t i = (size_t)bid * HT + tid; i < (size_t)T_ * 1024 / 4; i += (size_t)nblk * HT) {
            float4 v = xs[i]; u32x2 w; w.x = pack2(v.x, v.y); w.y = pack2(v.z, v.w); xb[i] = w;
        }
        for (int n = bid * HT + tid; n < 8192; n += nblk * HT) {
            int bk;
            if (n < 16) bk = n;
            else { const int th[15] = {22, 30, 40, 54, 73, 99, 134, 182, 246, 332, 450, 609, 825, 1117, 1513}; bk = 16;
#pragma unroll
                for (int k = 0; k < 15; ++k) bk += (n >= th[k]) ? 1 : 0; }
            (ws + WS_BUCKET)[n] = (unsigned char)bk;
        }
        for (int i = bid * HT + tid; i < 8192 * 32; i += nblk * HT) {
            const int pos = i >> 5, d = i & 31;
            const float inv = powf(10000.f, -(float)d * 2.0f / 64.f);
            const float ang = (float)pos * inv;
            float sn, cs; sincosf(ang, &sn, &cs);
            ((float2*)(ws + WS_ROPE))[i] = make_float2(cs, sn);
        }
        if (bid == 0) for (int i = tid; i < 8192; i += HT) ((unsigned*)(ws + WS_CTL))[i] = 0u;
    }
}

__device__ __forceinline__ float fsig(float x) { return __builtin_amdgcn_rcpf(1.f + __builtin_amdgcn_exp2f(-1.4426950408889634f * x)); }
template <int KIND>
__device__ __forceinline__ void g1_epi(const f32x4 (&acc)[2][2][4][2], unsigned char* ws, int r0, int c0, int wr, int wc, int fr, int fq) {
#pragma unroll
    for (int ai = 0; ai < 2; ++ai)
#pragma unroll
        for (int m = 0; m < 4; ++m) {
            const int row = r0 + 128 * ai + 64 * wr + 16 * m + fr + vzero();
#pragma unroll
            for (int bj = 0; bj < 2; ++bj) {
                const int col = c0 + 128 * bj + 32 * wc + 8 * fq;
                f32x4 v0 = acc[ai][bj][m][0], v1 = acc[ai][bj][m][1];
                if (KIND == 5) {
                    const int b = col >> 13, sq = col & (S_ - 1);
                    bf16_t* dst;
                    if (row < C_VW) { const int c = row - C_VS; dst = (bf16_t*)(ws + WS_VST) + ((size_t)(b * 2 + (c >> 6)) * 64 + (c & 63)) * S_ + sq; }
                    else if (row < C_VR) { const int c = row - C_VW; dst = (bf16_t*)(ws + WS_VWT) + ((size_t)(b * 2 + (c >> 6)) * 64 + (c & 63)) * S_ + sq; }
                    else { const int c = row - C_VR; dst = (bf16_t*)(ws + WS_VRT) + ((size_t)(b * 8 + (c >> 7)) * 128 + (c & 127)) * S_ + sq; }
                    u32x4 w; w.x = pack2(v0[0], v0[1]); w.y = pack2(v0[2], v0[3]); w.z = pack2(v1[0], v1[1]); w.w = pack2(v1[2], v1[3]);
                    *(u32x4*)dst = w;
                    continue;
                }
                if (KIND == 1 || KIND == 2) {
                    const float2* rope = (const float2*)(ws + WS_ROPE);
                    const int pos = row & (S_ - 1), d = 16 * (wc & 1) + 4 * fq;
                    const float4 cs01 = *(const float4*)(rope + pos * 32 + d), cs23 = *(const float4*)(rope + pos * 32 + d + 2);
                    const float c[4] = {cs01.x, cs01.z, cs23.x, cs23.z}, sn[4] = {cs01.y, cs01.w, cs23.y, cs23.w};
                    const float sc = (KIND == 2) ? 0.125f : 1.0f;
                    f32x4 y1, y2;
#pragma unroll
                    for (int r = 0; r < 4; ++r) { y1[r] = (v0[r] * c[r] - v1[r] * sn[r]) * sc; y2[r] = (v0[r] * sn[r] + v1[r] * c[r]) * sc; }
                    v0 = y1; v1 = y2;
                } else if (KIND == 3) {
#pragma unroll
                    for (int r = 0; r < 4; ++r) { v0[r] = v0[r] * fsig(v0[r]); v1[r] = v1[r] * fsig(v1[r]); }
                } else if (KIND == 4) {
#pragma unroll
                    for (int r = 0; r < 4; ++r) { v0[r] = fsig(v0[r]); v1[r] = fsig(v1[r]); }
                }
                u32x4 w; w.x = pack2(v0[0], v0[1]); w.y = pack2(v0[2], v0[3]); w.z = pack2(v1[0], v1[1]); w.w = pack2(v1[2], v1[3]);
                *(u32x4*)((bf16_t*)(ws + WS_P) + (size_t)row * LD + col) = w;
            }
        }
}
struct G1Order {      typedef pg8::Unit U; static constexpr bool GATHER = false;
    int xcd, slot, per;
    __device__ __forceinline__ bool next(int i, pg8::Unit& u) const {
        const int j = slot + i * per; if (j >= 208) return false;
        if (j < 192) { u.pm = j / 3; u.pn = xcd + 8 * (j % 3); } else { const int q = j - 192; u.pm = 8 * xcd + (q >> 1); u.pn = 24 + (q & 1); }
        return true;
    }
    __device__ __forceinline__ void ptrs(const pg8::Unit& u, unsigned& A, unsigned& B) const {
        const unsigned x = (unsigned)WS_XB + (unsigned)u.pm * (256u * 1024u * 2u), w = (unsigned)WS_WIN + (unsigned)u.pn * (256u * 1024u * 2u);
        if (u.pn >= 21) { A = w; B = x; } else { A = x; B = w; }
    }
};
struct G1Epi {
    unsigned char* ws;
    __device__ __forceinline__ void operator()(const f32x4 (&acc)[2][2][4][2], const pg8::Unit& u, int wr, int wc, int fr, int fq) const {
        const int pn = u.pn, tok0 = u.pm * 256, n0 = pn * 256;
        if (pn >= 21) g1_epi<5>(acc, ws, n0, tok0, wr, wc, fr, fq);
        else if (pn >= 12) g1_epi<4>(acc, ws, tok0, n0, wr, wc, fr, fq);
        else if (pn >= 8) g1_epi<3>(acc, ws, tok0, n0, wr, wc, fr, fq);
        else if (pn >= 6) g1_epi<2>(acc, ws, tok0, n0, wr, wc, fr, fq);
        else if (pn >= 4) g1_epi<1>(acc, ws, tok0, n0, wr, wc, fr, fq);
        else g1_epi<0>(acc, ws, tok0, n0, wr, wc, fr, fq);
    }
};
__device__ __forceinline__ void phase_g1(const Params& p, int layer, unsigned char* lds) {
    unsigned char* ws = launder(p.ws);
    G1Order S; S.xcd = blockIdx.x & 7; S.slot = blockIdx.x >> 3; S.per = gridDim.x >> 3;
    G1Epi E; E.ws = ws;
    pg8::gemm_phase<G1Epi, G1Order>(lds, 1024, S, E, ltid(), ws);
}

__device__ __forceinline__ void load_tile64(const bf16_t* base, size_t rowStride, unsigned char* dst, int wid, int lane) {
    const int c = ((lane & 7) ^ (lane >> 3)) * 8;
#pragma unroll
    for (int i = 0; i < 2; ++i) { const int j = wid + 4 * i, row = 8 * j + (lane >> 3); glds16(base + (size_t)row * rowStride + c, dst + j * 1024); }
}
__device__ __forceinline__ void load_tile128(const bf16_t* base, size_t rowStride, unsigned char* dst, int wid, int lane) {
    const int c = ((lane & 7) ^ (lane >> 3)) * 8;
#pragma unroll
    for (int i = 0; i < 4; ++i) { const int j = wid + 4 * i, row = 8 * j + (lane >> 3); glds16(base + (size_t)row * rowStride + c, dst + j * 1024); }
}
__device__ __forceinline__ void load_tile128w(const bf16_t* base, size_t rowStride, unsigned char* dst, int wid, int lane) {
    const int c = ((lane & 15) ^ ((4 * wid + (lane >> 4)) & 15)) * 8;
#pragma unroll
    for (int i = 0; i < 8; ++i) { const int j = wid + 4 * i, row = 4 * j + (lane >> 4); glds16(base + (size_t)row * rowStride + c, dst + j * 1024); }
}
__device__ __forceinline__ bf16x8 lds_frag128(const unsigned char* tile, int row, int chunk) {
    return *(const bf16x8*)(tile + row * 128 + ((chunk ^ (row & 7)) << 4));
}
__device__ __forceinline__ bf16x8 lds_frag256(const unsigned char* tile, int row, int chunk) {
    return *(const bf16x8*)(tile + row * 256 + ((chunk ^ (row & 15)) << 4));
}
__device__ __forceinline__ bf16x8 lds_vfrag128(const unsigned char* tile, int row, int kbase, int fq) {
    const int ca = (kbase >> 3) + (fq >> 1), hb = (fq & 1) * 8;
    const u32x2 a = *(const u32x2*)(tile + row * 128 + ((ca ^ (row & 7)) << 4) + hb);
    const u32x2 b = *(const u32x2*)(tile + row * 128 + (((ca + 2) ^ (row & 7)) << 4) + hb);
    u32x4 w; w.x = a.x; w.y = a.y; w.z = b.x; w.w = b.y;
    return __builtin_bit_cast(bf16x8, w);
}
__device__ __forceinline__ bf16x8 lds_vfrag256(const unsigned char* tile, int row, int kbase, int fq) {
    const int ca = (kbase >> 3) + (fq >> 1), hb = (fq & 1) * 8;
    const u32x2 a = *(const u32x2*)(tile + row * 256 + ((ca ^ (row & 15)) << 4) + hb);
    const u32x2 b = *(const u32x2*)(tile + row * 256 + (((ca + 2) ^ (row & 15)) << 4) + hb);
    u32x4 w; w.x = a.x; w.y = a.y; w.z = b.x; w.w = b.y;
    return __builtin_bit_cast(bf16x8, w);
}
__device__ __forceinline__ bf16x8 pack8(f32x4 a, f32x4 b) {
    u32x4 w; w.x = pack2(a[0], a[1]); w.y = pack2(a[2], a[3]); w.z = pack2(b[0], b[1]); w.w = pack2(b[2], b[3]);
    return __builtin_bit_cast(bf16x8, w);
}

__device__ __forceinline__ float gelu_tanh(float x) {
    const float u = 0.7978845608028654f * (x + 0.044715f * x * x * x);
    return 0.5f * x * (1.f + tanhf(u));
}
__device__ __forceinline__ void compress_item(const Params& p, int layer, int item, unsigned char* lds, int half) {
    unsigned char* ws = launder(p.ws);
    const int tid = (ltid() & 255), lane = tid & 63, wid = tid >> 6, wr = wid >> 1, wc = wid & 1, fr = lane & 15, fq = lane >> 4;
    const int mtile = item & 3, g = (item >> 2) & 1, b = (item >> 3) & 1, kv = item >> 4;
    const int i0 = mtile * 128;
    const bf16_t* P = (const bf16_t*)(ws + WS_P);
    const bf16_t* W1T = (const bf16_t*)(ws + WS_W1T) + (size_t)kv * 64 * 2048;
    const int col = (kv ? C_VC : C_KC) + g * 64;
    const int ldc = ((lane & 7) ^ (lane >> 3)) * 8;
    const bf16_t* ap[4];
#pragma unroll
    for (int i = 0; i < 4; ++i) ap[i] = P + ((size_t)b * S_ + 16 * (i0 + 32 * i + 8 * wid + (lane >> 3))) * LD + col + ldc;
    const bf16_t* bp[2];
#pragma unroll
    for (int i = 0; i < 2; ++i) bp[i] = W1T + (size_t)(8 * (wid + 4 * i) + (lane >> 3)) * 2048 + ldc;
    f32x4 acc[4][2];
#pragma unroll
    for (int i = 0; i < 4; ++i)
#pragma unroll
        for (int j = 0; j < 2; ++j) acc[i][j] = (f32x4){0.f, 0.f, 0.f, 0.f};
    __syncthreads();
#define CSTAGE(buf, l) do { unsigned char* st_ = lds + (buf) * 24576; \
        _Pragma("unroll") for (int i = 0; i < 4; ++i) glds16(ap[i] + (size_t)(l) * LD, st_ + (4 * i + wid) * 1024); \
        _Pragma("unroll") for (int i = 0; i < 2; ++i) glds16(bp[i] + (l) * 64, st_ + 16384 + (wid + 4 * i) * 1024); } while (0)
    CSTAGE(0, 0); CSTAGE(1, 1);
    for (int l = 0; l < 32; ++l) {
        const unsigned char* st = lds + (l % 3) * 24576;
        if (l + 1 < 32) WAIT_V(6); else WAIT_V(0);
        RAW_BARRIER();
        if (l + 2 < 32) CSTAGE((l + 2) % 3, l + 2);
#pragma unroll
        for (int ks = 0; ks < 2; ++ks) {
            bf16x8 a[4], bb[2];
#pragma unroll
            for (int i = 0; i < 4; ++i) a[i] = lds_frag128(st, 64 * wr + 16 * i + fr, 4 * ks + fq);
#pragma unroll
            for (int j = 0; j < 2; ++j) bb[j] = lds_frag128(st + 16384, 32 * wc + 16 * j + fr, 4 * ks + fq);
#pragma unroll
            for (int i = 0; i < 4; ++i)
#pragma unroll
                for (int j = 0; j < 2; ++j) acc[i][j] = mfma16(a[i], bb[j], acc[i][j]);
        }
    }
    __syncthreads();
#undef CSTAGE
    float* hid = (float*)lds;
    const float* b1 = (const float*)(ws + WS_B1) + kv * 64;
#pragma unroll
    for (int j = 0; j < 2; ++j) {
        const int n = 32 * wc + 16 * j + fr; const float bias = b1[n + vzero()];
#pragma unroll
        for (int i = 0; i < 4; ++i)
#pragma unroll
            for (int r = 0; r < 4; ++r) hid[(64 * wr + 16 * i + 4 * fq + r) * 65 + n] = gelu_tanh(acc[i][j][r] + bias);
    }
    __syncthreads();
    {
        const int row = tid >> 1, nb = (tid & 1) * 32, ci = i0 + row;
        const float* w2 = p.cmp_w2 + ((size_t)layer * 2 + kv) * 64 * 64;
        float o[32];
#pragma unroll
        for (int q = 0; q < 32; ++q) o[q] = 0.f;
        for (int n = 0; n < 64; ++n) {
            const float h = hid[row * 65 + n];
#pragma unroll
            for (int q4 = 0; q4 < 8; ++q4) { const float4 w = *(const float4*)(w2 + n * 64 + nb + 4 * q4); o[4 * q4] += h * w.x; o[4 * q4 + 1] += h * w.y; o[4 * q4 + 2] += h * w.z; o[4 * q4 + 3] += h * w.w; }
        }
        if (kv == 0) {
            bf16_t* dst = (bf16_t*)(ws + WS_KCC) + ((size_t)(b * 2 + g) * 512 + ci) * 64 + nb;
#pragma unroll
            for (int q = 0; q < 32; q += 4) { f32x4 v = {o[q], o[q + 1], o[q + 2], o[q + 3]}; if (ci >= 511) v = (f32x4){0.f, 0.f, 0.f, 0.f}; *(u32x2*)(dst + q) = pack4(v); }
        } else {
            bf16_t* dst = (bf16_t*)(ws + WS_VCCT) + ((size_t)(b * 2 + g) * 64 + nb) * 512 + ci;
#pragma unroll
            for (int q = 0; q < 32; ++q) dst[(size_t)q * 512] = f2bf(ci >= 511 ? 0.f : o[q]);
        }
    }
    __syncthreads();
}

__device__ __forceinline__ float ret_lg2(int h) { const float gam = 1.f - exp2f(-5.f - (float)h); return log2f(gam); }

__device__ __forceinline__ void retkv_item(const Params& p, int item, unsigned char* lds, int half) {
    unsigned char* ws = launder(p.ws);
    const int tid = (ltid() & 255), lane = tid & 63, wid = tid >> 6, fr = lane & 15, fq = lane >> 4;
    const int n = item & 63, h = (item >> 6) & 7, b = item >> 9;
    const size_t tok0 = (size_t)b * S_ + 128 * n;
    unsigned char* vL = lds; unsigned char* kL = lds + 32768;
    load_tile128w((const bf16_t*)(ws + WS_VRT) + ((size_t)(b * 8 + h) * 128) * S_ + 128 * n, S_, vL, wid, lane);
    load_tile128((const bf16_t*)(ws + WS_P) + tok0 * LD + C_KR + h * 64, LD, kL, wid, lane);
    wait_vm0(); __syncthreads();
    const float lg2 = ret_lg2(h);
    f32x4 acc[2][4];
#pragma unroll
    for (int m = 0; m < 2; ++m)
#pragma unroll
        for (int nt = 0; nt < 4; ++nt) acc[m][nt] = (f32x4){0.f, 0.f, 0.f, 0.f};
#pragma unroll
    for (int ks = 0; ks < 4; ++ks) {
        bf16x8 a[2], bb[4];
#pragma unroll
        for (int m = 0; m < 2; ++m) a[m] = lds_frag256(vL, 32 * wid + 16 * m + fr, 4 * ks + fq);
        float dec[8];
#pragma unroll
        for (int j = 0; j < 8; ++j) dec[j] = exp2f((float)(127 - (32 * ks + 8 * fq + j)) * lg2);
#pragma unroll
        for (int nt = 0; nt < 4; ++nt) {
            const int d = 16 * nt + fr;
            float v[8];
#pragma unroll
            for (int j = 0; j < 8; ++j) {
                const int tk = 32 * ks + 8 * fq + j;
                const bf16_t kvv = *(const bf16_t*)(kL + tk * 128 + (((d >> 3) ^ (tk & 7)) << 4) + (d & 7) * 2);
                v[j] = bf2f(kvv) * dec[j];
            }
            u32x4 w; w.x = pack2(v[0], v[1]); w.y = pack2(v[2], v[3]); w.z = pack2(v[4], v[5]); w.w = pack2(v[6], v[7]);
            bb[nt] = __builtin_bit_cast(bf16x8, w);
        }
#pragma unroll
        for (int m = 0; m < 2; ++m)
#pragma unroll
            for (int nt = 0; nt < 4; ++nt) acc[m][nt] = mfma16(a[m], bb[nt], acc[m][nt]);
    }
    float* KVT = (float*)(ws + WS_KVT) + ((size_t)(b * 8 + h) * 64 + n) * 8192;
#pragma unroll
    for (int m = 0; m < 2; ++m)
#pragma unroll
        for (int nt = 0; nt < 4; ++nt)
#pragma unroll
            for (int r = 0; r < 4; ++r) KVT[(32 * wid + 16 * m + 4 * fq + r) * 64 + 16 * nt + fr] = acc[m][nt][r];
    __syncthreads();
}

__device__ __forceinline__ void phase_p2(const Params& p, int layer, unsigned char* lds, int half) {
    const int vb = blockIdx.x * 2 + half, nvb = gridDim.x * 2;
    if (vb < 32) compress_item(p, layer, vb, lds, half);
    else for (int it = vb - 32; it < 1024; it += nvb - 32) retkv_item(p, it, lds, half);
}

constexpr int NSA_IMP = 32768, NSA_BUCKET = 65792, NSA_BIAS = 73984;

struct NsaLane { int t; int fr, fq, wid, lane; };

template <int BR, int PASS>
__device__ __forceinline__ void nsa_half(const unsigned char* kL, const unsigned char* vL, const unsigned char* lds, const bf16x8 (&qptr)[4][2],
                                         f32x4 (&O)[4][4], float (&m)[4], float (&l)[4], int tile, int hf, bool selbit, const NsaLane& L, int qrow) {
    const int fr = L.fr, fq = L.fq;
    bf16x8 Kf[2][2];
#pragma unroll
    for (int i = 0; i < 2; ++i)
#pragma unroll
        for (int ks = 0; ks < 2; ++ks) Kf[i][ks] = lds_frag128(kL, 32 * hf + 16 * i + fr, 4 * ks + fq);
    bf16x8 Vf[4];
    if (PASS != 0) {
#pragma unroll
        for (int mt = 0; mt < 4; ++mt) Vf[mt] = lds_vfrag128(vL, 16 * mt + fr, 32 * hf, fq);
    }
    unsigned vmask = 0; unsigned bk[2];
    const unsigned char* bucketL = lds + NSA_BUCKET;
#pragma unroll
    for (int i = 0; i < 2; ++i) {
        unsigned pk = 0;
#pragma unroll
        for (int r = 0; r < 4; ++r) {
            const int kk = 32 * hf + 16 * i + 4 * fq + r;
            int rel; bool ok;
            if (BR == 0) { rel = L.t - (16 * (64 * tile + kk) + 31); ok = rel >= 0; }
            else if (BR == 1) { rel = L.t - (64 * tile + kk); ok = selbit && rel >= 0; }
            else { rel = L.t - (64 * tile + kk); ok = rel >= 0 && rel < 512; }
            int rc = rel < 0 ? 0 : rel; rc = rc > 8191 ? 8191 : rc;
            pk |= (unsigned)bucketL[rc] << (8 * r);
            vmask |= (ok ? 1u : 0u) << (4 * i + r);
        }
        bk[i] = pk;
    }
    const float* biasL = (const float*)(lds + NSA_BIAS);
    float ia[2] = {0.f, 0.f}, ic[2] = {0.f, 0.f};
#pragma unroll
    for (int nt = 0; nt < 4; ++nt) {
        f32x4 S[2];
        const bf16x8 q0 = qptr[nt][0], q1 = qptr[nt][1];
#pragma unroll
        for (int i = 0; i < 2; ++i) {
            S[i] = (f32x4){0.f, 0.f, 0.f, 0.f};
            S[i] = mfma16(Kf[i][0], q0, S[i]); S[i] = mfma16(Kf[i][1], q1, S[i]);
        }
        float tmax = -1e30f;
        float bsv[2][4];
#pragma unroll
        for (int i = 0; i < 2; ++i)
#pragma unroll
            for (int r = 0; r < 4; ++r) bsv[i][r] = biasL[nt * 32 + ((bk[i] >> (8 * r)) & 0xffu)];
        asm volatile("" : "+v"(bsv[0][0]), "+v"(bsv[0][1]), "+v"(bsv[0][2]), "+v"(bsv[0][3]), "+v"(bsv[1][0]), "+v"(bsv[1][1]), "+v"(bsv[1][2]), "+v"(bsv[1][3]));
#pragma unroll
        for (int i = 0; i < 2; ++i)
#pragma unroll
            for (int r = 0; r < 4; ++r) {
                const bool ok = (vmask >> (4 * i + r)) & 1u;
                const float sv = S[i][r] * 0.125f + bsv[i][r];
                S[i][r] = ok ? sv : -1e30f; tmax = fmaxf(tmax, S[i][r]);
            }
        if (PASS != 1) {
            tmax = rows_max(tmax);
            const float mnew = fmaxf(m[nt], tmax), alpha = __expf(m[nt] - mnew);
            float psum = 0.f;
#pragma unroll
            for (int i = 0; i < 2; ++i)
#pragma unroll
                for (int r = 0; r < 4; ++r) {
                    const bool ok = (vmask >> (4 * i + r)) & 1u;
                    const float pv = ok ? __expf(S[i][r] - mnew) : 0.f;
                    S[i][r] = pv; psum += pv;
                }
            psum = rows_sum(psum);
            l[nt] = l[nt] * alpha + psum; m[nt] = mnew;
            if (PASS == 2) {
#pragma unroll
                for (int mt = 0; mt < 4; ++mt) O[mt][nt] = O[mt][nt] * alpha;
            }
        } else {
#pragma unroll
            for (int i = 0; i < 2; ++i) {
#pragma unroll
                for (int r = 0; r < 4; ++r) {
                    const bool ok = (vmask >> (4 * i + r)) & 1u;
                    S[i][r] = ok ? __expf(S[i][r] - m[nt]) * l[nt] : 0.f;
                }
                ia[i] += S[i][0] + S[i][1] + S[i][2] + 0.5f * S[i][3];
                ic[i] += 0.5f * S[i][3];
            }
        }
        if (PASS != 0) {
            const bf16x8 Pb = pack8(S[0], S[1]);
#pragma unroll
            for (int mt = 0; mt < 4; ++mt) O[mt][nt] = mfma16(Vf[mt], Pb, O[mt][nt]);
        }
    }
    if (PASS == 1) {
        float* imp = (float*)(lds + NSA_IMP) + qrow * 129;
        asm volatile("" ::: "memory"); __builtin_amdgcn_wave_barrier();
#pragma unroll
        for (int i = 0; i < 2; ++i) { const int j = 16 * tile + 8 * hf + 4 * i + fq; imp[j] += ia[i]; }
        asm volatile("s_waitcnt lgkmcnt(0)" ::: "memory"); __builtin_amdgcn_wave_barrier();
#pragma unroll
        for (int i = 0; i < 2; ++i) { const int j = 16 * tile + 8 * hf + 4 * i + fq + 1; if (j < 128) imp[j] += ic[i]; }
        asm volatile("s_waitcnt lgkmcnt(0)" ::: "memory"); __builtin_amdgcn_wave_barrier();
    }
}
template <int BR, int PASS>
__device__ __forceinline__ void nsa_tile(const unsigned char* kL, const unsigned char* vL, const unsigned char* lds, const bf16x8 (&qptr)[4][2],
                                         f32x4 (&O)[4][4], float (&m)[4], float (&l)[4], int tile, bool selbit, const NsaLane& L, int qrow) {
#pragma unroll 1
    for (int hf = 0; hf < 2; ++hf) nsa_half<BR, PASS>(kL, vL, lds, qptr, O, m, l, tile, hf, selbit, L, qrow);
}

__device__ __forceinline__ void cmp_item(const Params& p, int item, unsigned char* lds, int half) {
    unsigned char* ws = launder(p.ws);
    const int tid = (ltid() & 255), lane = tid & 63, wid = tid >> 6, fr = lane & 15, fq = lane >> 4;
    const int combo = item & 3, qt = 127 - (item >> 2), b = combo >> 1, g = combo & 1;
    const int q0 = qt * 64, qrow = 16 * wid + fr;
    NsaLane L; L.t = q0 + qrow; L.fr = fr; L.fq = fq; L.wid = wid; L.lane = lane;
    const size_t tok = (size_t)b * S_ + L.t;
    const bf16_t* P = (const bf16_t*)(ws + WS_P);
    __syncthreads();
    if (tid < 128) ((float*)(lds + NSA_BIAS))[tid] = p.rel_bias[(tid & 31) * 8 + 4 * g + (tid >> 5)];
    for (int i = tid; i < 64 * 129; i += HT) ((float*)(lds + NSA_IMP))[i] = 0.f;
    bf16x8 Qf[4][2];
#pragma unroll
    for (int nt = 0; nt < 4; ++nt)
#pragma unroll
        for (int ks = 0; ks < 2; ++ks) Qf[nt][ks] = *(const bf16x8*)(P + tok * LD + C_QA + (4 * g + nt) * 64 + 32 * ks + 8 * fq);
    __syncthreads();
    f32x4 O[4][4]; float m[4], l[4];
    const bf16_t* gates = P + tok * LD + C_GA + (4 * g) * 3;
    const bf16_t* kc = (const bf16_t*)(ws + WS_KCC) + (size_t)(b * 2 + g) * 512 * 64;
    const bf16_t* vc = (const bf16_t*)(ws + WS_VCCT) + (size_t)(b * 2 + g) * 64 * 512;
    const int ntc = ((q0 + 32) >> 4) / 64 + 1;
#pragma unroll
    for (int nt = 0; nt < 4; ++nt) { m[nt] = -1e30f; l[nt] = 0.f; }
    load_tile64(kc, 64, lds, wid, lane);
    wait_vm0(); __syncthreads();
    for (int it = 0; it < ntc; ++it) {
        unsigned char* cur = lds + (it & 1) * 16384;
        if (it + 1 < ntc) load_tile64(kc + (size_t)(it + 1) * 64 * 64, 64, lds + ((it + 1) & 1) * 16384, wid, lane);
        nsa_tile<0, 0>(cur, cur + 8192, lds, Qf, O, m, l, it, true, L, qrow);
        wait_vm0(); __syncthreads();
    }
#pragma unroll
    for (int nt = 0; nt < 4; ++nt) l[nt] = l[nt] > 0.f ? 1.f / l[nt] : 0.f;
#pragma unroll
    for (int mt = 0; mt < 4; ++mt)
#pragma unroll
        for (int nt = 0; nt < 4; ++nt) O[mt][nt] = (f32x4){0.f, 0.f, 0.f, 0.f};
    load_tile64(kc, 64, lds, wid, lane); load_tile64(vc, 512, lds + 8192, wid, lane);
    wait_vm0(); __syncthreads();
    for (int it = 0; it < ntc; ++it) {
        unsigned char* cur = lds + (it & 1) * 16384;
        if (it + 1 < ntc) { unsigned char* nx = lds + ((it + 1) & 1) * 16384;
            load_tile64(kc + (size_t)(it + 1) * 64 * 64, 64, nx, wid, lane); load_tile64(vc + (it + 1) * 64, 512, nx + 8192, wid, lane); }
        nsa_tile<0, 1>(cur, cur + 8192, lds, Qf, O, m, l, it, true, L, qrow);
        wait_vm0(); __syncthreads();
    }
    bf16_t* YC = (bf16_t*)(ws + WS_YC) + tok * 512 + (4 * g) * 64;
#pragma unroll
    for (int nt = 0; nt < 4; ++nt) {
        const float gt = bf2f(gates[nt * 3 + 0]);
#pragma unroll
        for (int mt = 0; mt < 4; ++mt) *(u32x2*)(YC + nt * 64 + 16 * mt + 4 * fq) = pack4(O[mt][nt] * gt);
    }
    const int cur = qt;
    {
        float* imp = (float*)(lds + NSA_IMP) + qrow * 129 + 32 * fq;
        asm volatile("s_waitcnt lgkmcnt(0)" ::: "memory"); __builtin_amdgcn_wave_barrier();
#pragma unroll
        for (int i = 0; i < 32; ++i) {
            const int j = 32 * fq + i;
            const float v = imp[i];
            imp[i] = j > cur ? -1.f : v + ((j == 0 || j == cur || j == cur - 1) ? 1.0e4f : 0.f);
        }
        unsigned word = 0;
#pragma unroll 1
        for (int round = 0; round < 16; ++round) {
            float bv = imp[0]; int bi = 0;
#pragma unroll
            for (int i = 1; i < 32; ++i) { const float v = imp[i]; if (v > bv) { bv = v; bi = i; } }
            int gi = 32 * fq + bi;
            {
                u32x2 rv = __builtin_amdgcn_permlane16_swap(__float_as_uint(bv), __float_as_uint(bv), false, false);
                u32x2 ri = __builtin_amdgcn_permlane16_swap((unsigned)gi, (unsigned)gi, false, false);
                float v0 = __uint_as_float(rv.x), v1 = __uint_as_float(rv.y); int i0 = (int)ri.x, i1 = (int)ri.y;
                if (v1 > v0 || (v1 == v0 && i1 < i0)) { v0 = v1; i0 = i1; }
                rv = __builtin_amdgcn_permlane32_swap(__float_as_uint(v0), __float_as_uint(v0), false, false);
                ri = __builtin_amdgcn_permlane32_swap((unsigned)i0, (unsigned)i0, false, false);
                v0 = __uint_as_float(rv.x); v1 = __uint_as_float(rv.y); i0 = (int)ri.x; i1 = (int)ri.y;
                if (v1 > v0 || (v1 == v0 && i1 < i0)) { v0 = v1; i0 = i1; }
                bv = v0; gi = i0;
            }
            if (bv >= 0.f && (gi >> 5) == fq) { word |= 1u << (gi & 31); imp[gi & 31] = -2.f; }
        }
        ((unsigned*)(ws + WS_SELW))[(tok * 2 + g) * 4 + fq] = word;
    }
}

__device__ __forceinline__ void win_item(const Params& p, int item, unsigned char* lds, int half) {
    unsigned char* ws = launder(p.ws);
    const int tid = (ltid() & 255), lane = tid & 63, wid = tid >> 6, fr = lane & 15, fq = lane >> 4;
    const int combo = item & 3, qt = 127 - (item >> 2), b = combo >> 1, g = combo & 1;
    const int q0 = qt * 64, qrow = 16 * wid + fr;
    NsaLane L; L.t = q0 + qrow; L.fr = fr; L.fq = fq; L.wid = wid; L.lane = lane;
    const size_t tok = (size_t)b * S_ + L.t;
    const bf16_t* P = (const bf16_t*)(ws + WS_P);
    __syncthreads();
    if (tid < 128) ((float*)(lds + NSA_BIAS))[tid] = p.rel_bias[(tid & 31) * 8 + 4 * g + (tid >> 5)];
    bf16x8 Qf[4][2];
#pragma unroll
    for (int nt = 0; nt < 4; ++nt)
#pragma unroll
        for (int ks = 0; ks < 2; ++ks) Qf[nt][ks] = *(const bf16x8*)(P + tok * LD + C_QA + (4 * g + nt) * 64 + 32 * ks + 8 * fq);
    __syncthreads();
    f32x4 O[4][4]; float m[4], l[4];
    const bf16_t* gates = P + tok * LD + C_GA + (4 * g) * 3;
#pragma unroll
    for (int nt = 0; nt < 4; ++nt) { m[nt] = -1e30f; l[nt] = 0.f; }
#pragma unroll
    for (int mt = 0; mt < 4; ++mt)
#pragma unroll
        for (int nt = 0; nt < 4; ++nt) O[mt][nt] = (f32x4){0.f, 0.f, 0.f, 0.f};
    {
        const bf16_t* kb = P + ((size_t)b * S_) * LD + C_KW + g * 64;
        const bf16_t* vb = (const bf16_t*)(ws + WS_VWT) + (size_t)(b * 2 + g) * 64 * S_;
        const int k_lo = qt - 8 > 0 ? qt - 8 : 0, ntw = qt - k_lo + 1;
        load_tile64(kb + (size_t)k_lo * 64 * LD, LD, lds, wid, lane); load_tile64(vb + k_lo * 64, S_, lds + 8192, wid, lane);
        wait_vm0(); __syncthreads();
        for (int it = 0; it < ntw; ++it) {
            unsigned char* cu = lds + (it & 1) * 16384;
            if (it + 1 < ntw) { unsigned char* nx = lds + ((it + 1) & 1) * 16384;
                load_tile64(kb + (size_t)(k_lo + it + 1) * 64 * LD, LD, nx, wid, lane); load_tile64(vb + (k_lo + it + 1) * 64, S_, nx + 8192, wid, lane); }
            nsa_tile<2, 2>(cu, cu + 8192, lds, Qf, O, m, l, k_lo + it, true, L, qrow);
            wait_vm0(); __syncthreads();
        }
    }
    bf16_t* YW = (bf16_t*)(ws + WS_YW) + tok * 512 + (4 * g) * 64;
#pragma unroll
    for (int nt = 0; nt < 4; ++nt) {
        const float gt = bf2f(gates[nt * 3 + 2]) * (l[nt] > 0.f ? 1.f / l[nt] : 0.f);
#pragma unroll
        for (int mt = 0; mt < 4; ++mt) *(u32x2*)(YW + nt * 64 + 16 * mt + 4 * fq) = pack4(O[mt][nt] * gt);
    }
}

constexpr int SEL_RING = 8, SEL_BUCKET = SEL_RING * 16384, SEL_BIAS2 = SEL_BUCKET + 8192;
constexpr float LOG2E = 1.4426950408889634f;
__device__ __forceinline__ int t5_first(int bk) {
    const int th[16] = {16, 22, 30, 40, 54, 73, 99, 134, 182, 246, 332, 450, 609, 825, 1117, 1513};
    int r = 16;
#pragma unroll
    for (int k = 0; k < 16; ++k) r = (bk == 16 + k) ? th[k] : r;
    return r;
}
template <bool FAST>
__device__ __forceinline__ void sel_ntile(const bf16x8 (&Kf)[4][2], const unsigned char* vL, int fr, int fq, const bf16x8& q0, const bf16x8& q1, f32x4 (&O)[4], float& m, float& l,
                                          bool sb, int relb, int th, float blo, float bhi, const unsigned char* lds, int hl) {
    f32x4 S[4];
#pragma unroll
    for (int i = 0; i < 4; ++i) { S[i] = (f32x4){0.f, 0.f, 0.f, 0.f}; S[i] = mfma16(Kf[i][0], q0, S[i]); S[i] = mfma16(Kf[i][1], q1, S[i]); }
    float tmax = -1e30f;
    const float scl = (!FAST || sb) ? 0.125f * LOG2E : 0.f;
    if (FAST) { blo = (sb ? blo : -1e30f) - m; bhi = (sb ? bhi : -1e30f) - m; }
    if (FAST) {
#pragma unroll
        for (int i = 0; i < 4; ++i)
#pragma unroll
            for (int r = 0; r < 4; ++r) { const int rel = relb - (16 * i + r); S[i][r] = S[i][r] * scl + (rel >= th ? bhi : blo); tmax = fmaxf(tmax, S[i][r]); }
    } else {
        unsigned bkt[4][4]; float bs[4][4];
#pragma unroll
        for (int i = 0; i < 4; ++i)
#pragma unroll
            for (int r = 0; r < 4; ++r) { const int rel = relb - (16 * i + r); int rc = rel < 0 ? 0 : rel; rc = rc > 8191 ? 8191 : rc; bkt[i][r] = (lds + SEL_BUCKET)[rc]; }
#pragma unroll
        for (int i = 0; i < 4; ++i)
#pragma unroll
            for (int r = 0; r < 4; ++r) bs[i][r] = ((const float*)(lds + SEL_BIAS2))[hl * 32 + bkt[i][r]];
        asm volatile("" : "+v"(bs[0][0]), "+v"(bs[0][1]), "+v"(bs[0][2]), "+v"(bs[0][3]), "+v"(bs[1][0]), "+v"(bs[1][1]), "+v"(bs[1][2]), "+v"(bs[1][3]),
                          "+v"(bs[2][0]), "+v"(bs[2][1]), "+v"(bs[2][2]), "+v"(bs[2][3]), "+v"(bs[3][0]), "+v"(bs[3][1]), "+v"(bs[3][2]), "+v"(bs[3][3]));
        const float ninf = -1e30f;
#pragma unroll
        for (int i = 0; i < 4; ++i)
#pragma unroll
            for (int r = 0; r < 4; ++r) {
                const int rel = relb - (16 * i + r);
                const float sv = S[i][r] * (0.125f * LOG2E) + (bs[i][r] - m);
                S[i][r] = (sb && rel >= 0) ? sv : ninf; tmax = fmaxf(tmax, S[i][r]);
            }
    }
    tmax = rows_max(tmax);
    if (__ballot(tmax > 8.f) != 0ull) {
        const float d = fmaxf(tmax, 0.f), alpha = __builtin_amdgcn_exp2f(-d);
        m += d; l *= alpha;
#pragma unroll
        for (int mt = 0; mt < 4; ++mt) O[mt] = O[mt] * alpha;
#pragma unroll
        for (int i = 0; i < 4; ++i)
#pragma unroll
            for (int r = 0; r < 4; ++r) S[i][r] -= d;
    }
    float psum = 0.f;
#pragma unroll
    for (int i = 0; i < 4; ++i)
#pragma unroll
        for (int r = 0; r < 4; ++r) { const float pv = __builtin_amdgcn_exp2f(S[i][r]); S[i][r] = pv; psum += pv; }
    l += rows_sum(psum);
    const bf16x8 Pb0 = pack8(S[0], S[1]), Pb1 = pack8(S[2], S[3]);
#pragma unroll
    for (int mt = 0; mt < 4; ++mt) { O[mt] = mfma16(lds_vfrag128(vL, 16 * mt + fr, 0, fq), Pb0, O[mt]); O[mt] = mfma16(lds_vfrag128(vL, 16 * mt + fr, 32, fq), Pb1, O[mt]); }
}
__device__ __forceinline__ void sel_ntile2_fast(const bf16x8 (&Kf)[4][2], const unsigned char* vL, int fr, int fq, const bf16x8 (&Qf)[2][2], f32x4 (&O)[2][4], float (&m)[2], float (&l)[2],
                                                const bool (&sb)[2], const int (&relb)[2], int th, float blo, float bhi) {
    f32x4 S[2][4]; float tmax[2], bl[2], bh[2], scl[2];
#pragma unroll
    for (int b = 0; b < 2; ++b)
#pragma unroll
        for (int i = 0; i < 4; ++i) { S[b][i] = (f32x4){0.f, 0.f, 0.f, 0.f}; S[b][i] = mfma16(Kf[i][0], Qf[b][0], S[b][i]); S[b][i] = mfma16(Kf[i][1], Qf[b][1], S[b][i]); }
#pragma unroll
    for (int b = 0; b < 2; ++b) { scl[b] = sb[b] ? 0.125f * LOG2E : 0.f; bl[b] = (sb[b] ? blo : -1e30f) - m[b]; bh[b] = (sb[b] ? bhi : -1e30f) - m[b]; tmax[b] = -1e30f; }
#pragma unroll
    for (int b = 0; b < 2; ++b)
#pragma unroll
        for (int i = 0; i < 4; ++i)
#pragma unroll
            for (int r = 0; r < 4; ++r) { const int rel = relb[b] - (16 * i + r); S[b][i][r] = S[b][i][r] * scl[b] + (rel >= th ? bh[b] : bl[b]); tmax[b] = fmaxf(tmax[b], S[b][i][r]); }
#pragma unroll
    for (int b = 0; b < 2; ++b) tmax[b] = rows_max(tmax[b]);
    if (__ballot(tmax[0] > 8.f || tmax[1] > 8.f) != 0ull) {
#pragma unroll
        for (int b = 0; b < 2; ++b) {
            const float d = fmaxf(tmax[b], 0.f), alpha = __builtin_amdgcn_exp2f(-d);
            m[b] += d; l[b] *= alpha;
#pragma unroll
            for (int mt = 0; mt < 4; ++mt) O[b][mt] = O[b][mt] * alpha;
#pragma unroll
            for (int i = 0; i < 4; ++i)
#pragma unroll
                for (int r = 0; r < 4; ++r) S[b][i][r] -= d;
        }
    }
    float psum[2] = {0.f, 0.f};
#pragma unroll
    for (int b = 0; b < 2; ++b)
#pragma unroll
        for (int i = 0; i < 4; ++i)
#pragma unroll
            for (int r = 0; r < 4; ++r) { const float pv = __builtin_amdgcn_exp2f(S[b][i][r]); S[b][i][r] = pv; psum[b] += pv; }
#pragma unroll
    for (int b = 0; b < 2; ++b) l[b] += rows_sum(psum[b]);
    bf16x8 P0[2], P1[2];
#pragma unroll
    for (int b = 0; b < 2; ++b) { P0[b] = pack8(S[b][0], S[b][1]); P1[b] = pack8(S[b][2], S[b][3]); }
#pragma unroll
    for (int mt = 0; mt < 4; ++mt) {
        const bf16x8 v0 = lds_vfrag128(vL, 16 * mt + fr, 0, fq), v1 = lds_vfrag128(vL, 16 * mt + fr, 32, fq);
#pragma unroll
        for (int b = 0; b < 2; ++b) { O[b][mt] = mfma16(v0, P0[b], O[b][mt]); O[b][mt] = mfma16(v1, P1[b], O[b][mt]); }
    }
}
template <bool FAST>
__device__ __forceinline__ void sel_tile(const unsigned char* kL, const unsigned char* vL, const unsigned char* lds, const bf16x8 (&Qf)[2][2], f32x4 (&O)[2][4], float (&m)[2], float (&l)[2],
                                         const bool (&sb)[2], const bool (&need)[2], const int (&relb)[2], int th, float blo, float bhi, int hl, int fr, int fq) {
    bf16x8 Kf[4][2];
#pragma unroll
    for (int i = 0; i < 4; ++i)
#pragma unroll
        for (int ks = 0; ks < 2; ++ks) Kf[i][ks] = lds_frag128(kL, 16 * i + fr, 4 * ks + fq);
    if (FAST && need[0] && need[1]) { sel_ntile2_fast(Kf, vL, fr, fq, Qf, O, m, l, sb, relb, th, blo, bhi); return; }
    if (need[0]) sel_ntile<FAST>(Kf, vL, fr, fq, Qf[0][0], Qf[0][1], O[0], m[0], l[0], sb[0], relb[0], th, blo, bhi, lds, hl);
    if (need[1]) sel_ntile<FAST>(Kf, vL, fr, fq, Qf[1][0], Qf[1][1], O[1], m[1], l[1], sb[1], relb[1], th, blo, bhi, lds, hl);
}
template <int VAR>
__device__ __forceinline__ void sel_item(const Params& p, int v, unsigned char* lds) {
    unsigned char* ws = launder(p.ws);
    const int tid = ltid(), lane = tid & 63, wid = tid >> 6, fr = lane & 15, fq = lane >> 4;
    const int qt = 127 - (v >> 2), sub = v & 3, b = sub >> 1, g = sub & 1;
    const int q0 = qt * 64, cur = qt, hl = fr & 3;
    const bf16_t* P = (const bf16_t*)(ws + WS_P);
    __syncthreads();
    if (tid < 128) ((float*)(lds + SEL_BIAS2))[tid] = p.rel_bias[(tid & 31) * 8 + 4 * g + (tid >> 5)] * LOG2E;
    int t[2]; size_t tok[2]; bf16x8 Qf[2][2]; unsigned selw[2][4];
#pragma unroll
    for (int nt = 0; nt < 2; ++nt) {
        t[nt] = q0 + 8 * wid + 4 * nt + (fr >> 2); tok[nt] = (size_t)b * S_ + t[nt];
#pragma unroll
        for (int ks = 0; ks < 2; ++ks) Qf[nt][ks] = *(const bf16x8*)(P + tok[nt] * LD + C_QA + (4 * g + hl) * 64 + 32 * ks + 8 * fq);
        const u32x4 w = *(const u32x4*)((const unsigned*)(ws + WS_SELW) + (tok[nt] * 2 + g) * 4);
        selw[nt][0] = w.x; selw[nt][1] = w.y; selw[nt][2] = w.z; selw[nt][3] = w.w;
    }
    f32x4 O[2][4]; float m[2], l[2];
#pragma unroll
    for (int nt = 0; nt < 2; ++nt) { m[nt] = -1000.f; l[nt] = 0.f;
#pragma unroll
        for (int mt = 0; mt < 4; ++mt) O[nt][mt] = (f32x4){0.f, 0.f, 0.f, 0.f}; }
    const bf16_t* kb = P + ((size_t)b * S_) * LD + C_KS + g * 64;
    const bf16_t* vb = (const bf16_t*)(ws + WS_VST) + (size_t)(b * 2 + g) * 64 * S_;
    const int nts = cur + 1;
#define SEL_ISSUE(jj) do { unsigned char* st_ = lds + ((jj) & 7) * 16384; const int c_ = ((lane & 7) ^ (lane >> 3)) * 8, r_ = 8 * wid + (lane >> 3); \
        glds16(kb + ((size_t)(jj) * 64 + r_) * LD + c_, st_ + wid * 1024); glds16(vb + (size_t)r_ * S_ + (jj) * 64 + c_, st_ + 8192 + wid * 1024); } while (0)
    asm volatile("s_waitcnt vmcnt(0)" ::: "memory");
#pragma unroll
    for (int q = 0; q < 4; ++q) if (q < nts) SEL_ISSUE(q);
    const unsigned char* bucketL = lds + SEL_BUCKET;
    for (int jp = 0; jp < nts; jp += 4) {
        WAIT_V(0);
        RAW_BARRIER();
#pragma unroll
        for (int q = 4; q < 8; ++q) if (jp + q < nts) SEL_ISSUE(jp + q);
#pragma unroll 1
      for (int j = jp; j < jp + 4 && j < nts; ++j) {
        const unsigned char* cu = lds + (j & 7) * 16384;
        bool sb[2], need[2]; int relb[2];
#pragma unroll
        for (int nt = 0; nt < 2; ++nt) {
            const unsigned w = j < 32 ? selw[nt][0] : j < 64 ? selw[nt][1] : j < 96 ? selw[nt][2] : selw[nt][3];
            sb[nt] = (w >> (j & 31)) & 1u; need[nt] = __ballot(sb[nt]) != 0ull; relb[nt] = t[nt] - 64 * j - 4 * fq;
        }
        if (VAR == 1) { need[0] = false; need[1] = false; }
        if (VAR == 2) { if (!(need[0] || need[1])) { need[0] = false; } else { need[0] = true; need[1] = true; } }
        if (need[0] || need[1]) {
            const int rmin = q0 - 64 * j - 63, rmax = q0 + 31 - 64 * j;
            bool fast = false; int th = 0; float blo = 0.f, bhi = 0.f;
            if (rmin >= 16) {
                const int b0 = bucketL[rmin], b1 = bucketL[rmax > 8191 ? 8191 : rmax];
                if (b1 - b0 <= 1) { fast = true; th = t5_first(b1); if (b1 == b0) th = 0;
                    blo = ((const float*)(lds + SEL_BIAS2))[hl * 32 + b0]; bhi = ((const float*)(lds + SEL_BIAS2))[hl * 32 + b1]; }
            }
            if (fast) sel_tile<true>(cu, cu + 8192, lds, Qf, O, m, l, sb, need, relb, th, blo, bhi, hl, fr, fq);
            else sel_tile<false>(cu, cu + 8192, lds, Qf, O, m, l, sb, need, relb, th, blo, bhi, hl, fr, fq);
        }
      }
    }
#undef SEL_ISSUE
    __syncthreads();
#pragma unroll
    for (int nt = 0; nt < 2; ++nt) {
        const float gt = bf2f(P[tok[nt] * LD + C_GA + (4 * g + hl) * 3 + 1]) * (l[nt] > 0.f ? 1.f / l[nt] : 0.f);
        const size_t o = tok[nt] * 512 + (4 * g + hl) * 64;
#pragma unroll
        for (int mt = 0; mt < 4; ++mt) {
            const f32x4 yc = unpack4(*(const u32x2*)((const bf16_t*)(ws + WS_YC) + o + 16 * mt + 4 * fq));
            const f32x4 yw = unpack4(*(const u32x2*)((const bf16_t*)(ws + WS_YW) + o + 16 * mt + 4 * fq));
            if (VAR == 0 || VAR == 3) *(u32x2*)((bf16_t*)(ws + WS_YA) + o + 16 * mt + 4 * fq) = pack4(yc + yw + O[nt][mt] * gt);
            else asm volatile("" :: "v"(O[nt][mt]));
        }
    }
}

__device__ __forceinline__ void scan_item(const Params& p, int item, int half) {
    unsigned char* ws = launder(p.ws);
    const int idx = item * HT + (ltid() & 255);
    const int bh = idx >> 13, ed = idx & 8191, h = bh & 7;
    const float dec = exp2f(128.f * ret_lg2(h));
    const float* KVT = (const float*)(ws + WS_KVT) + (size_t)bh * 64 * 8192 + ed;
    bf16_t* SPT = (bf16_t*)(ws + WS_SPT) + (size_t)bh * 64 * 8192 + ed;
    float s = 0.f;
    for (int n = 0; n < 64; ++n) { SPT[(size_t)n * 8192] = f2bf(s); s = s * dec + KVT[(size_t)n * 8192]; }
}

__device__ __forceinline__ void phase_p3(const Params& p, unsigned char* lds, int half, int what) {
    for (int i = (ltid() & 255); i < 8192 / 16; i += HT) ((u32x4*)(lds + NSA_BUCKET))[i] = ((const u32x4*)(launder(p.ws) + WS_BUCKET))[i];
    __syncthreads();
    for (int h = (blockIdx.x * 2 + half); h < 512; h += (gridDim.x * 2)) {
        if (what & 1) cmp_item(p, h, lds, half);
        if (what & 2) {
            if (h >= 128 && h < 384) win_item(p, h - 128, lds, half);
            else if (h >= 384) { win_item(p, 256 + 2 * (h - 384) - ((h & 1) ? 1 : 0) , lds, half); win_item(p, 256 + 2 * (h - 384) + ((h & 1) ? 0 : 1) + 1 - ((h & 1) ? 0 : 0), lds, half); }
        }
        if (what & 4) scan_item(p, h, half);
    }
}

__device__ __forceinline__ void retout_item(const Params& p, int item, unsigned char* lds, int half) {
    unsigned char* ws = launder(p.ws);
    const int tid = (ltid() & 255), lane = tid & 63, wid = tid >> 6, fr = lane & 15, fq = lane >> 4;
    const int n = item & 63, h = (item >> 6) & 7, b = item >> 9;
    const size_t tok0 = (size_t)b * S_ + 128 * n;
    const bf16_t* P = (const bf16_t*)(ws + WS_P);
    unsigned char* vL = lds; unsigned char* kL = lds + 32768; unsigned char* sL = lds + 49152;
    __syncthreads();
    load_tile128w((const bf16_t*)(ws + WS_VRT) + ((size_t)(b * 8 + h) * 128) * S_ + 128 * n, S_, vL, wid, lane);
    load_tile128(P + tok0 * LD + C_KR + h * 64, LD, kL, wid, lane);
    load_tile128((const bf16_t*)(ws + WS_SPT) + ((size_t)(b * 8 + h) * 64 + n) * 8192, 64, sL, wid, lane);
    bf16x8 Qf[2][2];
#pragma unroll
    for (int nt = 0; nt < 2; ++nt)
#pragma unroll
        for (int ks = 0; ks < 2; ++ks) Qf[nt][ks] = *(const bf16x8*)(P + (tok0 + 32 * wid + 16 * nt + fr) * LD + C_QR + h * 64 + 32 * ks + 8 * fq);
    wait_vm0(); __syncthreads();
    const float lg2 = ret_lg2(h);
    f32x4 Y[8][2];
#pragma unroll
    for (int m = 0; m < 8; ++m)
#pragma unroll
        for (int nt = 0; nt < 2; ++nt) Y[m][nt] = (f32x4){0.f, 0.f, 0.f, 0.f};
#pragma unroll
    for (int m = 0; m < 8; ++m)
#pragma unroll
        for (int ks = 0; ks < 2; ++ks) {
            const bf16x8 a = lds_frag128(sL, 16 * m + fr, 4 * ks + fq);
#pragma unroll
            for (int nt = 0; nt < 2; ++nt) Y[m][nt] = mfma16(a, Qf[nt][ks], Y[m][nt]);
        }
#pragma unroll
    for (int nt = 0; nt < 2; ++nt) {
        const float sc = exp2f((float)(32 * wid + 16 * nt + fr + 1) * lg2);
#pragma unroll
        for (int m = 0; m < 8; ++m) Y[m][nt] = Y[m][nt] * sc;
    }
#pragma unroll 1
    for (int s = 0; s < 4; ++s) {
        f32x4 St[2][2];
#pragma unroll
        for (int hh = 0; hh < 2; ++hh) {
            const int mt = 2 * s + hh;
#pragma unroll
            for (int nt = 0; nt < 2; ++nt) St[hh][nt] = (f32x4){0.f, 0.f, 0.f, 0.f};
#pragma unroll
            for (int ks = 0; ks < 2; ++ks) {
                const bf16x8 a = lds_frag128(kL, 16 * mt + fr, 4 * ks + fq);
#pragma unroll
                for (int nt = 0; nt < 2; ++nt) St[hh][nt] = mfma16(a, Qf[nt][ks], St[hh][nt]);
            }
#pragma unroll
            for (int nt = 0; nt < 2; ++nt) {
                const int qi = 32 * wid + 16 * nt + fr;
#pragma unroll
                for (int r = 0; r < 4; ++r) {
                    const int kj = 16 * mt + 4 * fq + r;
                    const float dm = qi >= kj ? exp2f((float)(qi - kj) * lg2) : 0.f;
                    St[hh][nt][r] *= dm;
                }
            }
        }
        bf16x8 Pb[2];
#pragma unroll
        for (int nt = 0; nt < 2; ++nt) Pb[nt] = pack8(St[0][nt], St[1][nt]);
#pragma unroll
        for (int m = 0; m < 8; ++m) {
            const bf16x8 a = lds_vfrag256(vL, 16 * m + fr, 32 * s, fq);
#pragma unroll
            for (int nt = 0; nt < 2; ++nt) Y[m][nt] = mfma16(a, Pb[nt], Y[m][nt]);
        }
    }
    bf16_t* YB = (bf16_t*)(ws + WS_YB);
#pragma unroll
    for (int nt = 0; nt < 2; ++nt) {
        float sum = 0.f;
#pragma unroll
        for (int m = 0; m < 8; ++m) sum += Y[m][nt][0] + Y[m][nt][1] + Y[m][nt][2] + Y[m][nt][3];
        sum = rows_sum(sum);
        const float mu = sum * (1.f / 128.f);
        float vs = 0.f;
#pragma unroll
        for (int m = 0; m < 8; ++m)
#pragma unroll
            for (int r = 0; r < 4; ++r) { const float dlt = Y[m][nt][r] - mu; vs += dlt * dlt; }
        vs = rows_sum(vs);
        const float rstd = rsqrtf(vs * (1.f / 128.f) + 1e-5f);
        const size_t tk = tok0 + 32 * wid + 16 * nt + fr;
#pragma unroll
        for (int m = 0; m < 8; ++m) {
            const f32x4 gt = unpack4(*(const u32x2*)(P + tk * LD + C_GR + h * 128 + 16 * m + 4 * fq));
            f32x4 v;
#pragma unroll
            for (int r = 0; r < 4; ++r) v[r] = (Y[m][nt][r] - mu) * rstd * gt[r];
            *(u32x2*)(YB + tk * 1024 + h * 128 + 16 * m + 4 * fq) = pack4(v);
        }
    }
}
__device__ __forceinline__ void phase_p4_sel(const Params& p, unsigned char* lds) {
    for (int i = ltid(); i < 8192 / 16; i += NTHREADS) ((u32x4*)(lds + SEL_BUCKET))[i] = ((const u32x4*)(launder(p.ws) + WS_BUCKET))[i];
    __syncthreads();
    for (int it = blockIdx.x; it < 512; it += gridDim.x * 2) {
        sel_item<0>(p, it, lds);
        if (511 - it != it) sel_item<0>(p, 511 - it, lds);
    }
    __syncthreads();
}
__device__ __forceinline__ void phase_p4(const Params& p, unsigned char* lds, int half) {
    for (int it = (blockIdx.x * 2 + half); it < 1024; it += (gridDim.x * 2)) retout_item(p, it, lds, half);
}

struct RowOrder {     typedef pg8::Unit U; static constexpr bool GATHER = false;
    unsigned a, b; int K, xcd, slot, per;
    __device__ __forceinline__ bool next(int i, pg8::Unit& u) const { const int t = xcd * 32 + slot + i * per; if (t >= (xcd + 1) * 32) return false; u.pm = t >> 2; u.pn = t & 3; return true; }
    __device__ __forceinline__ void ptrs(const pg8::Unit& u, unsigned& A, unsigned& B) const { A = a + (unsigned)u.pm * 512u * (unsigned)K; B = b + (unsigned)u.pn * 512u * (unsigned)K; }
};
template <int MODE>
struct MixEpi {
    unsigned char* ws; const float* X;
    __device__ __forceinline__ void operator()(const f32x4 (&acc)[2][2][4][2], const pg8::Unit& u, int wr, int wc, int fr, int fq) const {
#pragma unroll
        for (int ai = 0; ai < 2; ++ai)
#pragma unroll
            for (int m = 0; m < 4; ++m) {
                const size_t tok = (size_t)(u.pm * 256 + 128 * ai + 64 * wr + 16 * m + fr + vzero());
#pragma unroll
                for (int bj = 0; bj < 2; ++bj) {
                    const int n = u.pn * 256 + 128 * bj + 32 * wc + 8 * fq;
                    const f32x4 v0 = acc[ai][bj][m][0], v1 = acc[ai][bj][m][1];
                    if (MODE == 2) {
                        const f32x4 x0 = *(const f32x4*)(X + tok * 1024 + n), x1 = *(const f32x4*)(X + tok * 1024 + n + 4);
                        float* H1 = (float*)(ws + WS_H1);
                        *(f32x4*)(H1 + tok * 1024 + n) = x0 * DN_ALPHA + v0; *(f32x4*)(H1 + tok * 1024 + n + 4) = x1 * DN_ALPHA + v1;
                    } else {
                        const u32x4 gw = *(const u32x4*)((const bf16_t*)(ws + WS_P) + tok * LD + (MODE == 0 ? C_MA : C_MB) + n);
                        const f32x4 g0 = unpack4((u32x2){gw.x, gw.y}), g1 = unpack4((u32x2){gw.z, gw.w});
                        f32x4 o0 = g0 * v0, o1 = g1 * v1;
                        bf16_t* MG = (bf16_t*)(ws + WS_MG) + tok * 1024 + n;
                        if (MODE == 1) { const u32x4 pw = *(const u32x4*)MG; o0 = o0 + unpack4((u32x2){pw.x, pw.y}); o1 = o1 + unpack4((u32x2){pw.z, pw.w}); }
                        u32x4 w; w.x = pack2(o0[0], o0[1]); w.y = pack2(o0[2], o0[3]); w.z = pack2(o1[0], o1[1]); w.w = pack2(o1[2], o1[3]);
                        *(u32x4*)MG = w;
                    }
                }
            }
    }
};
__device__ __forceinline__ void phase_g2(const Params& p, unsigned char* lds) {
    unsigned char* ws = launder(p.ws);
    RowOrder S; S.xcd = blockIdx.x & 7; S.slot = blockIdx.x >> 3; S.per = gridDim.x >> 3;
    { S.a = (unsigned)WS_YA; S.b = (unsigned)WS_WA; S.K = 512; MixEpi<0> E; E.ws = ws; E.X = nullptr; pg8::gemm_phase<MixEpi<0>, RowOrder>(lds, 512, S, E, ltid(), ws); }
    { S.a = (unsigned)WS_YB; S.b = (unsigned)WS_WB; S.K = 1024; MixEpi<1> E; E.ws = ws; E.X = nullptr; pg8::gemm_phase<MixEpi<1>, RowOrder>(lds, 1024, S, E, ltid(), ws); }
}
__device__ __forceinline__ void phase_g3(const Params& p, int layer, unsigned char* lds) {
    unsigned char* ws = launder(p.ws);
    RowOrder S; S.xcd = blockIdx.x & 7; S.slot = blockIdx.x >> 3; S.per = gridDim.x >> 3; S.a = (unsigned)WS_MG; S.b = (unsigned)WS_WO; S.K = 1024;
    MixEpi<2> E; E.ws = ws; E.X = layer == 0 ? p.x : (const float*)(ws + WS_X);
    pg8::gemm_phase<MixEpi<2>, RowOrder>(lds, 1024, S, E, ltid(), ws);
}

__device__ __forceinline__ void phase_ln1(const Params& p, int layer, unsigned char* lds, bool dry, int half) {
    unsigned char* ws = launder(p.ws);
    const int tid = (ltid() & 255), lane = tid & 63, wid = tid >> 6;
    float* wrL = (float*)lds;
    {
        float4 wv[16];
#pragma unroll
        for (int k = 0; k < 16; ++k) wv[k] = ((const float4*)p.w_router)[tid + 256 * k];
#pragma unroll
        for (int k = 0; k < 16; ++k) { const int i4 = tid + 256 * k, d = i4 >> 2, e0 = (i4 & 3) * 4;
            wrL[(e0 + 0) * 1024 + d] = wv[k].x; wrL[(e0 + 1) * 1024 + d] = wv[k].y; wrL[(e0 + 2) * 1024 + d] = wv[k].z; wrL[(e0 + 3) * 1024 + d] = wv[k].w; }
    }
    __syncthreads();
    const float* H1 = (const float*)(ws + WS_H1);
    float* X1 = (float*)(ws + WS_X1); bf16_t* X1B = (bf16_t*)(ws + WS_X1B);
    const float* gam = p.ln1_g + layer * 1024; const float* bet = p.ln1_b + layer * 1024;
    unsigned* cnt = (unsigned*)(ws + WS_CTL) + (dry ? 0 : CW_CNT) + layer * 1024;
    int* LIST = (int*)(ws + (dry ? WS_HB : WS_LIST)); float* WTS = (float*)(ws + (dry ? WS_HB + 4194304 : WS_WTS));
    const int tstep = (gridDim.x * 2) * 4;
    float4 vn[4];
    { const int tok0 = (blockIdx.x * 2 + half) * 4 + wid;
#pragma unroll
      for (int j = 0; j < 4; ++j) vn[j] = *(const float4*)(H1 + (size_t)tok0 * 1024 + 256 * j + 4 * lane); }
    for (int tok = (blockIdx.x * 2 + half) * 4 + wid; tok < T_; tok += tstep) {
        float4 v[4];
#pragma unroll
        for (int j = 0; j < 4; ++j) v[j] = vn[j];
        { const int tn = tok + tstep < T_ ? tok + tstep : tok;
#pragma unroll
          for (int j = 0; j < 4; ++j) vn[j] = *(const float4*)(H1 + (size_t)tn * 1024 + 256 * j + 4 * lane); }
        float s = 0.f;
#pragma unroll
        for (int j = 0; j < 4; ++j) s += v[j].x + v[j].y + v[j].z + v[j].w;
        s = wave_sum(s);
        const float mu = s * (1.f / 1024.f);
        float q = 0.f;
#pragma unroll
        for (int j = 0; j < 4; ++j) { const float a = v[j].x - mu, b2 = v[j].y - mu, c = v[j].z - mu, d = v[j].w - mu; q += a * a + b2 * b2 + c * c + d * d; }
        q = wave_sum(q);
        const float rstd = rsqrtf(q * (1.f / 1024.f) + 1e-5f);
        float4 y[4];
#pragma unroll
        for (int j = 0; j < 4; ++j) {
            const int d0 = 256 * j + 4 * lane;
            const float4 gg = *(const float4*)(gam + d0), bb = *(const float4*)(bet + d0);
            y[j].x = (v[j].x - mu) * rstd * gg.x + bb.x; y[j].y = (v[j].y - mu) * rstd * gg.y + bb.y; y[j].z = (v[j].z - mu) * rstd * gg.z + bb.z; y[j].w = (v[j].w - mu) * rstd * gg.w + bb.w;
            *(float4*)(X1 + (size_t)tok * 1024 + d0) = y[j];
            u32x2 w; w.x = pack2(y[j].x, y[j].y); w.y = pack2(y[j].z, y[j].w);
            *(u32x2*)(X1B + (size_t)tok * 1024 + d0) = w;
        }
        float lg[16];
#pragma unroll
        for (int e = 0; e < 16; ++e) {
            float a = 0.f;
#pragma unroll
            for (int j = 0; j < 4; ++j) { const float4 w4 = *(const float4*)(wrL + e * 1024 + 256 * j + 4 * lane); a += y[j].x * w4.x + y[j].y * w4.y + y[j].z * w4.z + y[j].w * w4.w; }
            lg[e] = a;
        }
#pragma unroll
        for (int e = 0; e < 16; ++e) {
            lg[e] = wave_sum(lg[e]);
        }
        float mx = lg[0];
#pragma unroll
        for (int e = 1; e < 16; ++e) mx = fmaxf(mx, lg[e]);
        float pr[16], ps = 0.f;
#pragma unroll
        for (int e = 0; e < 16; ++e) { pr[e] = expf(lg[e] - mx); ps += pr[e]; }
        const float ips = 1.f / ps;
        float sel[16];
#pragma unroll
        for (int e = 0; e < 16; ++e) { pr[e] *= ips; sel[e] = pr[e] + p.router_bias[e]; }
        int best = 0; float bestv = -1e30f;
#pragma unroll
        for (int gI = 0; gI < 4; ++gI) {
            float a = -1e30f, b2 = -1e30f;
#pragma unroll
            for (int k = 0; k < 4; ++k) { const float x = sel[4 * gI + k]; if (x > a) { b2 = a; a = x; } else if (x > b2) b2 = x; }
            const float gs = a + b2;
            if (gs > bestv) { bestv = gs; best = gI; }
        }
        float s4[4], p4[4];
#pragma unroll
        for (int k = 0; k < 4; ++k) { s4[k] = 0.f; p4[k] = 0.f; }
#pragma unroll
        for (int gI = 0; gI < 4; ++gI) if (gI == best) {
#pragma unroll
            for (int k = 0; k < 4; ++k) { s4[k] = sel[4 * gI + k]; p4[k] = pr[4 * gI + k]; }
        }
        int i0 = 0; float a0 = s4[0];
#pragma unroll
        for (int k = 1; k < 4; ++k) if (s4[k] > a0) { a0 = s4[k]; i0 = k; }
        int i1 = -1; float a1 = -1e30f;
#pragma unroll
        for (int k = 0; k < 4; ++k) if (k != i0 && s4[k] > a1) { a1 = s4[k]; i1 = k; }
        float w0 = 0.f, w1 = 0.f;
#pragma unroll
        for (int k = 0; k < 4; ++k) { if (k == i0) w0 = p4[k]; if (k == i1) w1 = p4[k]; }
        const float iw = 1.f / (w0 + w1);
        if (lane == 0) {
            const int e0 = best * 4 + i0, e1 = best * 4 + i1;
            const unsigned p0 = atomicAdd(&cnt[e0 * 64], 1u), p1 = atomicAdd(&cnt[e1 * 64], 1u);
            LIST[(size_t)e0 * T_ + p0] = tok * 2; LIST[(size_t)e1 * T_ + p1] = tok * 2 + 1;
            WTS[tok * 2] = w0 * iw; WTS[tok * 2 + 1] = w1 * iw;
        }
    }
}

struct MoeUnit { int e, rt, ct, cnt, off; };
struct MoeOrderBase {
    const unsigned* cntp; int t_lo, t_hi, slot, per;
    __device__ __forceinline__ void init(const unsigned* cnt) {
        cntp = cnt; int ntile = 0;
#pragma unroll
        for (int k = 0; k < NE; ++k) ntile += ((__builtin_amdgcn_readfirstlane((int)cnt[k * 64]) + 255) >> 8) * 4;
        t_lo = (ntile * (int)(blockIdx.x & 7)) >> 3; t_hi = (ntile * (int)((blockIdx.x & 7) + 1)) >> 3; slot = blockIdx.x >> 3; per = gridDim.x >> 3;
    }
    __device__ __forceinline__ bool next(int i, MoeUnit& u) const {
        const int t = t_lo + slot + i * per; if (t >= t_hi) return false;
        int base = 0, off = 0; bool found = false;
#pragma unroll
        for (int k = 0; k < NE; ++k) {
            const int ck = __builtin_amdgcn_readfirstlane((int)cntp[k * 64]), nt = ((ck + 255) >> 8) * 4;
            if (!found && t < base + nt) { found = true; u.e = k; u.cnt = ck; u.off = off; u.rt = (t - base) >> 2; u.ct = (t - base) & 3; }
            base += nt; off += ck;
        }
        return found;
    }
};
struct M2Order : MoeOrderBase {
    typedef MoeUnit U; static constexpr bool GATHER = true;
    const int* list;
    __device__ __forceinline__ void ptrs(const MoeUnit& u, unsigned& A, unsigned& B) const { A = (unsigned)WS_X1B; B = (unsigned)WS_WG + ((unsigned)u.e * 1024u + (unsigned)u.ct * 256u) * 2048u; }
    __device__ __forceinline__ void rows(const MoeUnit& u, int tid, unsigned (&v)[2][2]) const {
#pragma unroll
        for (int i = 0; i < 2; ++i) { int R, C; pg8::stage_rc((tid + vzero()) * 16 + i * 8192, R, C);
#pragma unroll
            for (int h = 0; h < 2; ++h) { int idx = u.rt * 256 + 128 * h + R; idx = idx < u.cnt ? idx : u.cnt - 1; const int a = (list + (size_t)u.e * T_)[idx]; v[h][i] = ((unsigned)(a >> 1) << 11) + (unsigned)C * 2u; } }
    }
};
struct M3Order : MoeOrderBase {
    typedef MoeUnit U; static constexpr bool GATHER = false;
    __device__ __forceinline__ void ptrs(const MoeUnit& u, unsigned& A, unsigned& B) const { A = (unsigned)WS_HB + ((unsigned)u.off + (unsigned)u.rt * 256u) * 1024u; B = (unsigned)WS_WD + ((unsigned)u.e * 1024u + (unsigned)u.ct * 256u) * 1024u; }
};
struct M2Epi {
    unsigned char* ws;
    __device__ __forceinline__ void operator()(const f32x4 (&acc)[2][2][4][2], const MoeUnit& u, int wr, int wc, int fr, int fq) const {
        bf16_t* HB = (bf16_t*)(ws + WS_HB);
#pragma unroll
        for (int ai = 0; ai < 2; ++ai)
#pragma unroll
            for (int m = 0; m < 4; ++m) {
                const int idx = u.rt * 256 + 128 * ai + 64 * wr + 16 * m + fr + vzero();
                if (idx < u.cnt) {
#pragma unroll
                    for (int bj = 0; bj < 2; ++bj) {
                        const int hcol = 4 * (32 * u.ct + 16 * bj + 4 * wc + fq);
                        const f32x4 gv = acc[ai][bj][m][0], uv = acc[ai][bj][m][1]; f32x4 hv;
#pragma unroll
                        for (int r = 0; r < 4; ++r) hv[r] = gv[r] * fsig(gv[r]) * uv[r];
                        *(u32x2*)(HB + (size_t)(u.off + idx) * 512 + hcol) = pack4(hv);
                    }
                }
            }
    }
};
struct M3Epi {
    unsigned char* ws; const int* list;
    __device__ __forceinline__ void operator()(const f32x4 (&acc)[2][2][4][2], const MoeUnit& u, int wr, int wc, int fr, int fq) const {
        bf16_t* CT = (bf16_t*)(ws + WS_CT);
#pragma unroll
        for (int ai = 0; ai < 2; ++ai)
#pragma unroll
            for (int m = 0; m < 4; ++m) {
                const int idx = u.rt * 256 + 128 * ai + 64 * wr + 16 * m + fr + vzero();
                if (idx < u.cnt) {
                    const int a = list[(size_t)u.e * T_ + idx];
#pragma unroll
                    for (int bj = 0; bj < 2; ++bj) {
                        const int n = u.ct * 256 + 128 * bj + 32 * wc + 8 * fq;
                        const f32x4 v0 = acc[ai][bj][m][0], v1 = acc[ai][bj][m][1];
                        u32x4 w; w.x = pack2(v0[0], v0[1]); w.y = pack2(v0[2], v0[3]); w.z = pack2(v1[0], v1[1]); w.w = pack2(v1[2], v1[3]);
                        *(u32x4*)(CT + (size_t)a * 1024 + n) = w;
                    }
                }
            }
    }
};
__device__ __forceinline__ void phase_m2(const Params& p, int layer, unsigned char* lds) {
    unsigned char* ws = launder(p.ws);
    M2Order S; S.init((const unsigned*)(ws + WS_CTL) + CW_CNT + layer * 1024 + vzero());
    S.list = (const int*)(ws + WS_LIST);
    M2Epi E; E.ws = ws;
    pg8::gemm_phase<M2Epi, M2Order>(lds, 1024, S, E, ltid(), ws);
}
__device__ __forceinline__ void phase_m3(const Params& p, int layer, unsigned char* lds) {
    unsigned char* ws = launder(p.ws);
    M3Order S; S.init((const unsigned*)(ws + WS_CTL) + CW_CNT + layer * 1024 + vzero());
    M3Epi E; E.ws = ws; E.list = (const int*)(ws + WS_LIST);
    pg8::gemm_phase<M3Epi, M3Order>(lds, 512, S, E, ltid(), ws);
}

__device__ __forceinline__ void phase_ln2(const Params& p, int layer, int half) {
    unsigned char* ws = launder(p.ws);
    const int tid = (ltid() & 255), lane = tid & 63, wid = tid >> 6;
    const float* X1 = (const float*)(ws + WS_X1); const bf16_t* CT = (const bf16_t*)(ws + WS_CT); const float* WTS = (const float*)(ws + WS_WTS);
    float* XO = layer == NLAYER - 1 ? p.out : (float*)(ws + WS_X); bf16_t* XB = (bf16_t*)(ws + WS_XB);
    const float* gam = p.ln2_g + layer * 1024; const float* bet = p.ln2_b + layer * 1024;
    constexpr int U = 4;
    const int nwave = (gridDim.x * 2) * 4, wv = (blockIdx.x * 2 + half) * 4 + wid;
    for (int t0 = wv * U; t0 < T_; t0 += nwave * U) {
        float4 v[U][4]; float s[U], q[U];
#pragma unroll
        for (int u = 0; u < U; ++u) {
            const int tok = t0 + u;
            const float w0 = WTS[tok * 2 + vzero()], w1 = WTS[tok * 2 + 1 + vzero()];
            s[u] = 0.f; q[u] = 0.f;
#pragma unroll
            for (int j = 0; j < 4; ++j) {
                const int d0 = 256 * j + 4 * lane;
                const float4 xv = *(const float4*)(X1 + (size_t)tok * 1024 + d0);
                const f32x4 c0 = unpack4(*(const u32x2*)(CT + (size_t)(tok * 2) * 1024 + d0)), c1 = unpack4(*(const u32x2*)(CT + (size_t)(tok * 2 + 1) * 1024 + d0));
                v[u][j].x = xv.x * DN_ALPHA + w0 * c0[0] + w1 * c1[0]; v[u][j].y = xv.y * DN_ALPHA + w0 * c0[1] + w1 * c1[1];
                v[u][j].z = xv.z * DN_ALPHA + w0 * c0[2] + w1 * c1[2]; v[u][j].w = xv.w * DN_ALPHA + w0 * c0[3] + w1 * c1[3];
                s[u] += v[u][j].x + v[u][j].y + v[u][j].z + v[u][j].w;
                q[u] += v[u][j].x * v[u][j].x + v[u][j].y * v[u][j].y + v[u][j].z * v[u][j].z + v[u][j].w * v[u][j].w;
            }
        }
#pragma unroll
        for (int u = 0; u < U; ++u) { s[u] = wave_sum(s[u]); q[u] = wave_sum(q[u]); }
#pragma unroll
        for (int j = 0; j < 4; ++j) {
            const int d0 = 256 * j + 4 * lane;
            const float4 gg = *(const float4*)(gam + d0), bb = *(const float4*)(bet + d0);
#pragma unroll
            for (int u = 0; u < U; ++u) {
                const int tok = t0 + u;
                const float mu = s[u] * (1.f / 1024.f), var = fmaxf(q[u] * (1.f / 1024.f) - mu * mu, 0.f), rstd = rsqrtf(var + 1e-5f);
                float4 y; y.x = (v[u][j].x - mu) * rstd * gg.x + bb.x; y.y = (v[u][j].y - mu) * rstd * gg.y + bb.y; y.z = (v[u][j].z - mu) * rstd * gg.z + bb.z; y.w = (v[u][j].w - mu) * rstd * gg.w + bb.w;
                *(float4*)(XO + (size_t)tok * 1024 + d0) = y;
                u32x2 w; w.x = pack2(y.x, y.y); w.y = pack2(y.z, y.w);
                *(u32x2*)(XB + (size_t)tok * 1024 + d0) = w;
            }
        }
    }
}

#define XB_TMO      128
#define XB_XCNT(j)  (256  + 64 * (j))
#define XB_XSUB(j)  (1280 + 64 * (j))
#define XB_XGEN(j)  (2304 + 64 * (j))
#define XB_TOP      3328
#define XB_TOPGEN   3392
#define XCD_BAR_WORDS 3456
#define XB_SPIN_CAP (1u << 22)
#define LAS __attribute__((address_space(3)))
__device__ __forceinline__ unsigned xb_ld(unsigned* p)              { return __hip_atomic_load(p, __ATOMIC_RELAXED, __HIP_MEMORY_SCOPE_AGENT); }
__device__ __forceinline__ unsigned xb_add(unsigned* p, unsigned v) { return __hip_atomic_fetch_add(p, v, __ATOMIC_RELAXED, __HIP_MEMORY_SCOPE_AGENT); }
__device__ __forceinline__ unsigned xb_xcc_id() { return (unsigned)__builtin_amdgcn_s_getreg((3 << 11) | 20) & 0xFu; }
#define XB_SPIN(cond, bar) do { unsigned _sp = 0; while (cond) { __builtin_amdgcn_s_sleep(1); \
    if ((++_sp & 255u) == 0u) { if (xb_ld(&(bar)[XB_TMO])) break; if (_sp > XB_SPIN_CAP) { atomicAdd(&(bar)[XB_TMO], 1u); break; } } } } while (0)
struct XcdBarrier { unsigned* bar; unsigned x; volatile LAS unsigned* st; };
__device__ __forceinline__ XcdBarrier xcd_barrier_post(unsigned* bar, volatile LAS unsigned* st) {
    XcdBarrier b; b.bar = bar; b.x = xb_xcc_id(); b.st = st;
    if (threadIdx.x == 0) (void)xb_add(&bar[XB_XCNT(b.x)], 1u);
    return b;
}
__device__ __forceinline__ void xcd_barrier_complete(unsigned* bar, unsigned x, unsigned& nloc, unsigned& nx) {
    const unsigned G = gridDim.x * gridDim.y * gridDim.z;
    unsigned sum, cnt, mine, sp = 0u;
    for (;;) {
        sum = 0u; cnt = 0u; mine = 0u;
#pragma unroll
        for (unsigned j = 0; j < 16; ++j) { const unsigned c = xb_ld(&bar[XB_XCNT(j)]); sum += c; cnt += (c > 0u) ? 1u : 0u; mine = (j == x) ? c : mine; }
        if (sum == G) break;
        __builtin_amdgcn_s_sleep(1);
        if ((++sp & 255u) == 0u) { if (xb_ld(&bar[XB_TMO])) break; if (sp > XB_SPIN_CAP) { atomicAdd(&bar[XB_TMO], 1u); break; } }
    }
    nloc = mine > 0u ? mine : 1u; nx = cnt > 0u ? cnt : 1u;
}
__device__ __forceinline__ void xcd_barrier(const XcdBarrier& b) {
    asm volatile("s_waitcnt vmcnt(0)" ::: "memory");
    __syncthreads();
    if (threadIdx.x == 0) {
        unsigned* bar = b.bar;
        __builtin_amdgcn_s_waitcnt(0);
        unsigned nloc = b.st[0], nx = b.st[1];
        if (nloc == 0u) { xcd_barrier_complete(bar, b.x, nloc, nx); b.st[0] = nloc; b.st[1] = nx; }
        const unsigned old = xb_add(&bar[XB_XSUB(b.x)], 1u);
        const unsigned gen = old / nloc;
        if (old + 1u == (gen + 1u) * nloc) {
            __builtin_amdgcn_fence(__ATOMIC_RELEASE, "agent");
            asm volatile("s_waitcnt vmcnt(0)" ::: "memory");
            const unsigned og = xb_add(&bar[XB_TOP], 1u);
            const unsigned tg = og / nx;
            if (og + 1u == (tg + 1u) * nx) xb_add(&bar[XB_TOPGEN], 1u);
            else XB_SPIN(xb_ld(&bar[XB_TOPGEN]) == tg, bar);
            __builtin_amdgcn_fence(__ATOMIC_ACQUIRE, "agent");
            xb_add(&bar[XB_XGEN(b.x)], 1u);
            asm volatile("s_waitcnt vmcnt(0)" ::: "memory");
        } else {
            XB_SPIN(xb_ld(&bar[XB_XGEN(b.x)]) == gen, bar);
            __builtin_amdgcn_fence(__ATOMIC_ACQUIRE, "agent");
            asm volatile("s_waitcnt vmcnt(0)" ::: "memory");
        }
    }
    __syncthreads();
}

constexpr int PH_PER_LAYER = 11, N_PHASES = PH_PER_LAYER * NLAYER;
__global__ void __launch_bounds__(NTHREADS, 2) mega(Params p) {
    extern __shared__ __attribute__((aligned(16))) unsigned char lds[];
#if SINGLE_LAUNCH
    volatile LAS unsigned* xbw = (volatile LAS unsigned*)(lds + LDS_BYTES - 16);
    if (threadIdx.x < 4) xbw[threadIdx.x] = 0u;
    __syncthreads();
    XcdBarrier xbar = xcd_barrier_post((unsigned*)(p.ws + WS_CTL) + CW_BAR, xbw);
#endif
    const int half = __builtin_amdgcn_readfirstlane((int)(threadIdx.x >> 8));
    unsigned char* ldsh = lds + half * HALF_LDS;
    bool second = false;
    for (int ph = p.ph_lo; ph < p.ph_hi; ++ph) {
        const int layer = ph / PH_PER_LAYER, k = ph % PH_PER_LAYER;
        if (k == 0 && layer > 0) continue;
#ifdef ONLY_PHASE
        if (k != ONLY_PHASE) continue;
#endif
        switch (k) {
            case 0: phase_pw(p, layer, ldsh, 1 | 16 | 8, half); break;
            case 1: phase_g1(p, layer, lds); break;
            case 2: phase_p2(p, layer, ldsh, half); if (!second && layer + 1 < NLAYER) { __syncthreads(); phase_pw(p, layer + 1, ldsh, 1, half, 32); } break;
            case 3: phase_p3(p, ldsh, half, second ? ((p.rep_mask >> 16) & 7) : 7); if (!second && layer + 1 < NLAYER) { __syncthreads(); phase_pw(p, layer + 1, ldsh, 16, half); }
                    if (!second && layer == 0) { __syncthreads(); phase_pw(p, 0, ldsh, 2, half); } break;
            case 4: { const int sub = second ? ((p.rep_mask >> 12) & 7) : 7;
                    if (sub & 1) phase_p4_sel(p, lds);
                    if ((sub & 4) && half == 0) { phase_pw(p, layer, ldsh, 4, half); __syncthreads(); }
                    if (sub & 2) phase_p4(p, ldsh, half);
                    if ((sub & 4) && half == 1) { __syncthreads(); phase_pw(p, layer, ldsh, 4, half); } } break;
            case 5: phase_g2(p, lds); break;
            case 6: phase_g3(p, layer, lds); break;
            case 7: phase_ln1(p, layer, ldsh, ((p.rep_mask >> 7) & 1) && !second, half); if (!second && layer + 1 < NLAYER) { __syncthreads(); phase_pw(p, layer + 1, ldsh, 2, half); } break;
            case 8: phase_m2(p, layer, lds); break;
            case 9: phase_m3(p, layer, lds); break;
            case 10: phase_ln2(p, layer, half); break;
        }

        if (ph + 1 < p.ph_hi) { if (ph == p.ph_lo && !second) cg::this_grid().sync(); else xcd_barrier(xbar); }
        if (((p.rep_mask >> k) & 1) && !second) { second = true; --ph; } else second = false;
    }
}

extern "C" void kernel_launch(void* const* d_in, const int* in_sizes, int n_in, void* d_out, int out_size, void* d_ws, size_t ws_size, hipStream_t stream) {
    static int grid = 0;
    if (grid == 0) {
        if (n_in != 18 || ws_size < WS_END) { fprintf(stderr, "kernel_launch: unexpected n_in %d or ws_size %zu < %zu\n", n_in, ws_size, (size_t)WS_END); grid = -1; return; }
        int dev = 0, cus = 0, per_cu = 0;
        hipGetDevice(&dev); hipDeviceGetAttribute(&cus, hipDeviceAttributeMultiprocessorCount, dev);
        hipFuncSetAttribute((const void*)mega, hipFuncAttributeMaxDynamicSharedMemorySize, LDS_BYTES);
        hipOccupancyMaxActiveBlocksPerMultiprocessor(&per_cu, (const void*)mega, NTHREADS, LDS_BYTES);
        if (per_cu < 1) per_cu = 1;
        if (per_cu > 1) per_cu = 1;
        grid = cus * per_cu;
        (void)hipGetLastError();
    }
    if (grid < 0) return;
    Params p{};
    p.x = (const float*)d_in[0]; p.w_in = (const float*)d_in[1]; p.cmp_pos = (const float*)d_in[2]; p.cmp_w1 = (const float*)d_in[3]; p.cmp_w2 = (const float*)d_in[4];
    p.w_br_a = (const float*)d_in[5]; p.w_br_b = (const float*)d_in[6]; p.w_o = (const float*)d_in[7]; p.ln1_g = (const float*)d_in[8]; p.ln1_b = (const float*)d_in[9];
    p.w_router = (const float*)d_in[10]; p.router_bias = (const float*)d_in[11]; p.w_gate = (const float*)d_in[12]; p.w_up = (const float*)d_in[13]; p.w_down = (const float*)d_in[14];
    p.ln2_g = (const float*)d_in[15]; p.ln2_b = (const float*)d_in[16]; p.rel_bias = (const float*)d_in[17];
    p.out = (float*)d_out; p.ws = (unsigned char*)d_ws; p.rep_mask = REPEAT_MASK;
#if SINGLE_LAUNCH
    hipMemsetAsync((unsigned char*)d_ws + WS_CTL + (size_t)CW_BAR * 4, 0, XCD_BAR_WORDS * 4, stream);
    p.ph_lo = 0; p.ph_hi = N_PHASES;
    void* args[] = {&p};
    hipError_t e = hipLaunchCooperativeKernel((const void*)mega, dim3(grid), dim3(NTHREADS), args, LDS_BYTES, stream);
    if (e != hipSuccess) fprintf(stderr, "cooperative launch failed: %s (grid %d)\n", hipGetErrorString(e), grid);
#else
    for (int ph = 0; ph < N_PHASES; ++ph) {
        p.ph_lo = ph; p.ph_hi = ph + 1;
        hipLaunchKernelGGL(mega, dim3(grid), dim3(NTHREADS), LDS_BYTES, stream, p);
    }
#endif
}
```

```cpp
#include <hip/hip_runtime.h>
#include <hip/hip_cooperative_groups.h>
#include <cstdio>
#include <cstdint>
namespace cg = cooperative_groups;

#ifndef REPEAT_MASK
#define REPEAT_MASK 0
#endif
#ifndef SINGLE_LAUNCH
#define SINGLE_LAUNCH 1
#endif

typedef unsigned short bf16_t;
typedef short bf16x8 __attribute__((ext_vector_type(8)));
typedef float f32x4 __attribute__((ext_vector_type(4)));
typedef unsigned u32x2 __attribute__((ext_vector_type(2)));
typedef unsigned u32x4 __attribute__((ext_vector_type(4)));

constexpr int B_ = 2, S_ = 8192, D_ = 1024, T_ = B_ * S_, NLAYER = 4;
constexpr int DIN = 6424;
constexpr int LD = 5376;
constexpr int NW = 6656;
constexpr int C_QA = 0, C_KC = 512, C_VC = 640, C_KS = 768, C_KW = 896, C_QR = 1024, C_KR = 1536, C_GR = 2048, C_MA = 3072, C_MB = 4096, C_GA = 5120,
              C_VS = 5376, C_VW = 5504, C_VR = 5632;
constexpr float DN_ALPHA = 1.681792830507429f;
constexpr int NE = 16;

constexpr size_t al256(size_t x) { return (x + 255) & ~(size_t)255; }
constexpr size_t WS_CTL = 0;
constexpr size_t WS_BUCKET = 65536;
constexpr size_t WS_ROPE = WS_BUCKET + 8192;
constexpr size_t WS_WIN = WS_ROPE + (size_t)8192 * 32 * 8;
constexpr size_t WS_WA = WS_WIN + (size_t)NW * 1024 * 2;
constexpr size_t WS_WB = WS_WA + (size_t)1024 * 512 * 2;
constexpr size_t WS_WO = WS_WB + (size_t)1024 * 1024 * 2;
constexpr size_t WS_WG = WS_WO + (size_t)1024 * 1024 * 2;
constexpr size_t WS_WU = WS_WG + (size_t)16 * 512 * 1024 * 2;
constexpr size_t WS_WD = WS_WU + (size_t)16 * 512 * 1024 * 2;
constexpr size_t WS_XB = WS_WD + (size_t)16 * 512 * 1024 * 2;
constexpr size_t WS_X = WS_XB + (size_t)T_ * 1024 * 2;
constexpr size_t WS_MG = WS_X + (size_t)T_ * 1024 * 4;
constexpr size_t WS_KCC = WS_MG + (size_t)T_ * 1024 * 2;
constexpr size_t WS_VCCT = WS_KCC + (size_t)4 * 512 * 64 * 2;
constexpr size_t WS_W1T = WS_VCCT + (size_t)4 * 512 * 64 * 2;
constexpr size_t WS_B1 = WS_W1T + (size_t)2 * 64 * 2048 * 2;
constexpr size_t WS_R = WS_B1 + 1024;
constexpr size_t WS_P = WS_R;
constexpr size_t WS_VST = WS_P + (size_t)T_ * LD * 2;
constexpr size_t WS_VWT = WS_VST + (size_t)4 * 64 * S_ * 2;
constexpr size_t WS_VRT = WS_VWT + (size_t)4 * 64 * S_ * 2;
constexpr size_t WS_KVT = WS_VRT + (size_t)16 * 128 * S_ * 2;
constexpr size_t WS_SPT = WS_KVT + (size_t)16 * 64 * 8192 * 4;
constexpr size_t WS_YC = WS_SPT + (size_t)16 * 64 * 8192 * 2;
constexpr size_t WS_YW = WS_YC + (size_t)T_ * 512 * 2;
constexpr size_t WS_YA = WS_YW + (size_t)T_ * 512 * 2;
constexpr size_t WS_YB = WS_YA + (size_t)T_ * 512 * 2;
constexpr size_t WS_SELW = WS_YB + (size_t)T_ * 1024 * 2;
constexpr size_t WS_ENDA = WS_SELW + (size_t)T_ * 2 * 4 * 4;
constexpr size_t WS_H1 = WS_R;
constexpr size_t WS_X1 = WS_H1 + (size_t)T_ * 1024 * 4;
constexpr size_t WS_X1B = WS_X1 + (size_t)T_ * 1024 * 4;
constexpr size_t WS_HB = WS_X1B + (size_t)T_ * 1024 * 2;
constexpr size_t WS_CT = WS_HB + (size_t)2 * T_ * 512 * 2;
constexpr size_t WS_LIST = WS_CT + (size_t)2 * T_ * 1024 * 2;
constexpr size_t WS_WTS = WS_LIST + (size_t)16 * T_ * 4;
constexpr size_t WS_ENDB = WS_WTS + (size_t)2 * T_ * 4;
static_assert(WS_HB + (size_t)2 * T_ * 512 * 2 <= WS_CT, "view B overlap");
constexpr size_t WS_END = WS_ENDA > WS_ENDB ? WS_ENDA : WS_ENDB;

constexpr int CW_CNT = 4096;
constexpr int CW_BAR = 8192;

constexpr int HALF_LDS = 75776, LDS_BYTES = 2 * HALF_LDS + 16;
constexpr int NTHREADS = 512, HT = 256;

struct Params {
    const float* x; const float* w_in; const float* cmp_pos; const float* cmp_w1; const float* cmp_w2;
    const float* w_br_a; const float* w_br_b; const float* w_o; const float* ln1_g; const float* ln1_b;
    const float* w_router; const float* router_bias; const float* w_gate; const float* w_up; const float* w_down;
    const float* ln2_g; const float* ln2_b; const float* rel_bias;
    float* out; unsigned char* ws;
    int ph_lo, ph_hi, rep_mask, pad_;
};

__device__ __forceinline__ bf16_t f2bf(float f) { unsigned u = __float_as_uint(f); u += 0x7fffu + ((u >> 16) & 1u); return (bf16_t)(u >> 16); }
__device__ __forceinline__ float bf2f(unsigned h) { return __uint_as_float(h << 16); }
typedef __bf16 bf16x2_t __attribute__((ext_vector_type(2)));
typedef float f32x2_t __attribute__((ext_vector_type(2)));
__device__ __forceinline__ unsigned pack2(float lo, float hi) { const f32x2_t f = {lo, hi}; return __builtin_bit_cast(unsigned, __builtin_convertvector(f, bf16x2_t)); }
__device__ __forceinline__ u32x2 pack4(f32x4 v) { u32x2 r; r.x = pack2(v[0], v[1]); r.y = pack2(v[2], v[3]); return r; }
__device__ __forceinline__ f32x4 unpack4(u32x2 u) { f32x4 r; r[0] = bf2f(u.x & 0xffffu); r[1] = bf2f(u.x >> 16); r[2] = bf2f(u.y & 0xffffu); r[3] = bf2f(u.y >> 16); return r; }
__device__ __forceinline__ float rows_max(float v) {
    u32x2 r = __builtin_amdgcn_permlane16_swap(__float_as_uint(v), __float_as_uint(v), false, false);
    v = fmaxf(__uint_as_float(r.x), __uint_as_float(r.y));
    r = __builtin_amdgcn_permlane32_swap(__float_as_uint(v), __float_as_uint(v), false, false);
    return fmaxf(__uint_as_float(r.x), __uint_as_float(r.y));
}
__device__ __forceinline__ float rows_sum(float v) {
    u32x2 r = __builtin_amdgcn_permlane16_swap(__float_as_uint(v), __float_as_uint(v), false, false);
    v = __uint_as_float(r.x) + __uint_as_float(r.y);
    r = __builtin_amdgcn_permlane32_swap(__float_as_uint(v), __float_as_uint(v), false, false);
    return __uint_as_float(r.x) + __uint_as_float(r.y);
}
__device__ __forceinline__ float wave_sum(float v) {
    v += __int_as_float(__builtin_amdgcn_mov_dpp(__float_as_int(v), 0xB1, 0xF, 0xF, true));
    v += __int_as_float(__builtin_amdgcn_mov_dpp(__float_as_int(v), 0x4E, 0xF, 0xF, true));
    v += __int_as_float(__builtin_amdgcn_mov_dpp(__float_as_int(v), 0x141, 0xF, 0xF, true));
    v += __int_as_float(__builtin_amdgcn_mov_dpp(__float_as_int(v), 0x140, 0xF, 0xF, true));
    return rows_sum(v);
}
__device__ __forceinline__ float sigmoidf_(float x) { return 1.f / (1.f + __expf(-x)); }
__device__ __forceinline__ int ltid() { int t = threadIdx.x; asm volatile("" : "+v"(t)); return t; }
__device__ __forceinline__ int vzero() { int z; asm volatile("v_mov_b32 %0, 0" : "=v"(z)); return z; }
__device__ __forceinline__ unsigned char* launder(unsigned char* q) { asm volatile("" : "+s"(q)); return q; }
__device__ __forceinline__ void wait_vm0() { asm volatile("s_waitcnt vmcnt(0)" ::: "memory"); }

__device__ __forceinline__ void glds16(const void* g, void* l) {
    __builtin_amdgcn_global_load_lds((const __attribute__((address_space(1))) unsigned*)g,
                                     (__attribute__((address_space(3))) unsigned*)l, 16, 0, 0);
}
__device__ __forceinline__ f32x4 mfma16(bf16x8 a, bf16x8 b, f32x4 c) { return __builtin_amdgcn_mfma_f32_16x16x32_bf16(a, b, c, 0, 0, 0); }

#define WAIT_V(n) asm volatile("s_waitcnt vmcnt(%0)" ::"n"(n) : "memory")
#define RAW_BARRIER() do { asm volatile("s_waitcnt lgkmcnt(0)" ::: "memory"); __builtin_amdgcn_s_barrier(); } while (0)
__device__ __forceinline__ void bglds16(__amdgpu_buffer_rsrc_t r, unsigned voff, int soff, void* l) {
    __builtin_amdgcn_raw_ptr_buffer_load_lds(r, (__attribute__((address_space(3))) void*)l, 16, (int)voff, soff, 0, 0);
}
template <int NJ, bool GN>
__device__ __forceinline__ void gemm8_stage(__amdgpu_buffer_rsrc_t mr, int mld, unsigned mvo, __amdgpu_buffer_rsrc_t nr, int nld, const unsigned (&nvo)[NJ], int kt, unsigned char* st, int wid) {
#pragma unroll
    for (int i = 0; i < 4; ++i) bglds16(mr, mvo, (64 * i * mld + kt * 64) * 2, st + (8 * i + wid) * 1024);
#pragma unroll
    for (int i = 0; i < NJ; ++i) bglds16(nr, nvo[i], ((GN ? 0 : 64 * i * nld) + kt * 64) * 2, st + 32768 + (8 * i + wid) * 1024);
}
template <int NJ, bool GN>
__device__ __forceinline__ void gemm8_kloop(const bf16_t* mb, int mld, unsigned mvo, const bf16_t* nb, int nld, const unsigned (&nvo)[NJ], int nk, unsigned char* lds, f32x4 (&acc)[8][NJ], int tid) {
    const int lane = tid & 63, wid = tid >> 6, wr = wid >> 2, wc = wid & 3, fr = lane & 15, fq = lane >> 4;
    const __amdgpu_buffer_rsrc_t mr = __builtin_amdgcn_make_buffer_rsrc((void*)mb, 0, 0x7fffffff, 0x00020000);
    const __amdgpu_buffer_rsrc_t nr = __builtin_amdgcn_make_buffer_rsrc((void*)nb, 0, 0x7fffffff, 0x00020000);
    gemm8_stage<NJ, GN>(mr, mld, mvo, nr, nld, nvo, 0, lds, wid);
    gemm8_stage<NJ, GN>(mr, mld, mvo, nr, nld, nvo, 1, lds + 65536, wid);
    for (int kt = 0; kt < nk; ++kt) {
        unsigned char* cur = lds + (kt & 1) * 65536;
        if (kt + 1 < nk) WAIT_V(4 + NJ); else WAIT_V(0);
        RAW_BARRIER();
        bf16x8 a[4], b[NJ];
        const unsigned char* ab = cur + (128 * wr + fr) * 128;
        const unsigned char* bb = cur + 32768 + (16 * NJ * wc + fr) * 128;
        const int sw0 = ((fq) ^ (fr & 7)) << 4, sw1 = ((4 + fq) ^ (fr & 7)) << 4;
#pragma unroll
        for (int j = 0; j < NJ; ++j) b[j] = *(const bf16x8*)(bb + j * 2048 + sw0);
#pragma unroll
        for (int mh = 0; mh < 2; ++mh) {
#pragma unroll
            for (int i = 0; i < 4; ++i) a[i] = *(const bf16x8*)(ab + (4 * mh + i) * 2048 + sw0);
#pragma unroll
            for (int i = 0; i < 4; ++i)
#pragma unroll
                for (int j = 0; j < NJ; ++j) acc[4 * mh + i][j] = mfma16(a[i], b[j], acc[4 * mh + i][j]);
        }
#pragma unroll
        for (int j = 0; j < NJ; ++j) b[j] = *(const bf16x8*)(bb + j * 2048 + sw1);
#pragma unroll
        for (int i = 0; i < 4; ++i) a[i] = *(const bf16x8*)(ab + i * 2048 + sw1);
#pragma unroll
        for (int i = 0; i < 4; ++i)
#pragma unroll
            for (int j = 0; j < NJ; ++j) acc[i][j] = mfma16(a[i], b[j], acc[i][j]);
#pragma unroll
        for (int i = 0; i < 4; ++i) a[i] = *(const bf16x8*)(ab + (4 + i) * 2048 + sw1);
        RAW_BARRIER();
        if (kt + 2 < nk) gemm8_stage<NJ, GN>(mr, mld, mvo, nr, nld, nvo, kt + 2, cur, wid);
#pragma unroll
        for (int i = 0; i < 4; ++i)
#pragma unroll
            for (int j = 0; j < NJ; ++j) acc[4 + i][j] = mfma16(a[i], b[j], acc[4 + i][j]);
    }
    __syncthreads();
    __builtin_amdgcn_sched_barrier(0);
}
template <int NJ>
__device__ __forceinline__ void zero_acc8(f32x4 (&acc)[8][NJ]) {
#pragma unroll
    for (int i = 0; i < 8; ++i)
#pragma unroll
        for (int j = 0; j < NJ; ++j) acc[i][j] = (f32x4){0.f, 0.f, 0.f, 0.f};
}

namespace pg8 {
#define PG8_LAS __attribute__((address_space(3)))
constexpr int BM = 256, BK = 64, HALF = 128, HTB = HALF * BK * 2, STAGE_BYTES = 8 * HTB;
__device__ __forceinline__ int lds_byte(int r, int c) { const int st = (r >> 4) * 2 + (c >> 5), rr = r & 15, cc = c & 31, ob = rr * 64 + cc * 2; return st * 1024 + (ob ^ (((ob >> 9) & 1) << 5)); }
__device__ __forceinline__ void stage_rc(int b, int& R, int& C) { const int st = b / 1024, sb = b % 1024, swz = sb ^ (((sb >> 9) & 1) << 5); R = (st >> 1) * 16 + swz / 64; C = (st & 1) * 32 + (swz % 64) / 2; }
__device__ __forceinline__ int perm32(int rho) { const int n = rho >> 4, i = rho & 15; return 8 * (i >> 2) + 4 * n + (i & 3); }
struct Unit { int pm, pn; };
template <class Epi, class Sched>
__device__ __forceinline__ void gemm_phase(unsigned char* lds_, const int K, const Sched& S, const Epi& E, const int tid, const unsigned char* wsbase) {
    PG8_LAS unsigned char* lds = (PG8_LAS unsigned char*)lds_;
    const int wid = __builtin_amdgcn_readfirstlane(tid >> 6), lane = tid & 63, wr = wid >> 2, wc = wid & 3, fr = lane & 15, fq = lane >> 4;
    const int nt = K / BK;
    unsigned voffA[2], voffB[2];
#pragma unroll
    for (int i = 0; i < 2; ++i) { int R, C; stage_rc(tid * 16 + i * 8192, R, C); const int Rb = (R & ~31) + perm32(R & 31);
        voffA[i] = (unsigned)(R * K + C) * 2u; voffB[i] = (unsigned)(Rb * K + C) * 2u; }
    const unsigned kstep = (unsigned)(BK * 2);
    const unsigned hstep = (unsigned)HALF * K * 2;
    const __amdgpu_buffer_rsrc_t rsrc = __builtin_amdgcn_make_buffer_rsrc((void*)wsbase, 0, 0x7fffffff, 0x00020000);
    const unsigned ldsw = (unsigned)wid * 1024u;
    const int aoff = lds_byte(wr * 64 + fr, fq * 8), boff = lds_byte(wc * 32 + fr, fq * 8);
#define PG8_SA(b, h) (((b) * 2 + (h)) * HTB)
#define PG8_SB(b, h) ((4 + (b) * 2 + (h)) * HTB)
#define PG8_STAGE(bufoff, gbase, voff) do { _Pragma("unroll") for (int _i = 0; _i < 2; ++_i) \
        __builtin_amdgcn_raw_ptr_buffer_load_lds(rsrc, (PG8_LAS void*)(lds + (bufoff) + ldsw + _i * 8192), 16, (int)(voff)[_i], (int)(gbase), 0, 0); } while (0)
#define PG8_LDA(dst, b, h) do { _Pragma("unroll") for (int m = 0; m < 4; ++m) _Pragma("unroll") for (int k = 0; k < 2; ++k) dst[m][k] = *(const PG8_LAS bf16x8*)(lds + PG8_SA(b, h) + aoff + m * 2048 + k * 1024); } while (0)
#define PG8_LDB(dst, b, h) do { _Pragma("unroll") for (int n = 0; n < 2; ++n) _Pragma("unroll") for (int k = 0; k < 2; ++k) dst[n][k] = *(const PG8_LAS bf16x8*)(lds + PG8_SB(b, h) + boff + n * 2048 + k * 1024); } while (0)
#define PG8_MMA(ai, bj, At, Bt) do { __builtin_amdgcn_s_setprio(1); _Pragma("unroll") for (int m = 0; m < 4; ++m) _Pragma("unroll") for (int n = 0; n < 2; ++n) _Pragma("unroll") for (int k = 0; k < 2; ++k) \
        acc[ai][bj][m][n] = __builtin_amdgcn_mfma_f32_16x16x32_bf16(Bt[n][k], At[m][k], acc[ai][bj][m][n], 0, 0, 0); __builtin_amdgcn_s_setprio(0); } while (0)
#define PG8_WAIT_V(n) asm volatile("s_waitcnt vmcnt(" #n ")" ::: "memory")
#define PG8_WAIT_L(n) asm volatile("s_waitcnt lgkmcnt(" #n ")" ::: "memory")
#define PG8_BAR __builtin_amdgcn_s_barrier()
#define PG8_SCHED __builtin_amdgcn_sched_barrier(0)
    typename Sched::U cur, nxt; int ui = 0;
    if (!S.next(0, cur)) return;
    unsigned cA, cB; S.ptrs(cur, cA, cB);
    constexpr bool GA = Sched::GATHER;
    unsigned vA[GA ? 2 : 1][2], nvA[GA ? 2 : 1][2];
    if constexpr (GA) { S.rows(cur, tid, vA);
#pragma unroll
        for (int h = 0; h < 2; ++h)
#pragma unroll
            for (int i = 0; i < 2; ++i) nvA[h][i] = vA[h][i]; }
#define PG8_STAGE_A(bufoff, gbase, h, nextu) do { if constexpr (GA) { if (nextu) PG8_STAGE(bufoff, gbase, nvA[h]); else PG8_STAGE(bufoff, gbase, vA[h]); } \
        else PG8_STAGE(bufoff, (gbase) + (h) * hstep, voffA); } while (0)
    PG8_STAGE(PG8_SB(0, 0), cB, voffB); PG8_STAGE_A(PG8_SA(0, 0), cA, 0, false); PG8_STAGE(PG8_SB(0, 1), cB + hstep, voffB); PG8_STAGE_A(PG8_SA(0, 1), cA, 1, false);
    if (wr == 1) PG8_BAR;
    PG8_WAIT_V(4); PG8_BAR;
    PG8_STAGE(PG8_SB(1, 0), cB + kstep, voffB); PG8_STAGE_A(PG8_SA(1, 0), cA + kstep, 0, false); PG8_STAGE(PG8_SB(1, 1), cB + hstep + kstep, voffB);
    PG8_WAIT_V(6); PG8_BAR;
    PG8_SCHED;
    f32x4 acc[2][2][4][2];
#pragma unroll
    for (int a = 0; a < 2; ++a)
#pragma unroll
        for (int b = 0; b < 2; ++b)
#pragma unroll
            for (int m = 0; m < 4; ++m)
#pragma unroll
                for (int n = 0; n < 2; ++n) acc[a][b][m][n] = (f32x4){0.f, 0.f, 0.f, 0.f};
    bf16x8 At[4][2], B0[2][2], B1[2][2];
    for (;;) {
        const bool has_next = S.next(ui + 1, nxt);
        unsigned nA = cA, nB = cB; if (has_next) S.ptrs(nxt, nA, nB);
        if constexpr (GA) { if (has_next) S.rows(nxt, tid, nvA); }
        for (int t = 0; t < nt; t += 2) {
            const bool last = (t == nt - 2);
            const unsigned a1 = cA + (unsigned)(t + 1) * kstep;
            const unsigned a2 = last ? nA : cA + (unsigned)(t + 2) * kstep, b2 = last ? nB : cB + (unsigned)(t + 2) * kstep;
            const unsigned a3 = a2 + kstep, b3 = b2 + kstep;
            PG8_LDB(B0, 0, 0); PG8_SCHED; PG8_LDA(At, 0, 0); PG8_STAGE_A(PG8_SA(1, 1), a1, 1, false);
            PG8_WAIT_L(8); PG8_BAR; PG8_WAIT_L(0); PG8_MMA(0, 0, At, B0); PG8_BAR; PG8_SCHED;
            PG8_LDB(B1, 0, 1); PG8_STAGE(PG8_SB(0, 0), b2, voffB);
            PG8_BAR; PG8_WAIT_L(0); PG8_MMA(0, 1, At, B1); PG8_BAR;
            PG8_LDA(At, 0, 1); PG8_STAGE_A(PG8_SA(0, 0), a2, 0, last);
            PG8_BAR; PG8_WAIT_L(0); PG8_MMA(1, 0, At, B0); PG8_BAR; PG8_SCHED;
            PG8_STAGE(PG8_SB(0, 1), b2 + hstep, voffB);
            PG8_WAIT_V(6); PG8_BAR; PG8_MMA(1, 1, At, B1); PG8_BAR;
            PG8_LDB(B0, 1, 0); PG8_SCHED; PG8_LDA(At, 1, 0); PG8_STAGE_A(PG8_SA(0, 1), a2, 1, last);
            PG8_WAIT_L(8); PG8_BAR; PG8_WAIT_L(0); PG8_MMA(0, 0, At, B0); PG8_BAR; PG8_SCHED;
            PG8_LDB(B1, 1, 1); PG8_STAGE(PG8_SB(1, 0), b3, voffB);
            PG8_BAR; PG8_WAIT_L(0); PG8_MMA(0, 1, At, B1); PG8_BAR;
            PG8_LDA(At, 1, 1); PG8_STAGE_A(PG8_SA(1, 0), a3, 0, last);
            PG8_BAR; PG8_WAIT_L(0); PG8_MMA(1, 0, At, B0); PG8_BAR; PG8_SCHED;
            PG8_STAGE(PG8_SB(1, 1), b3 + hstep, voffB);
            PG8_WAIT_V(6); PG8_BAR; PG8_MMA(1, 1, At, B1); PG8_BAR;
        }
        E(acc, cur, wr, wc, fr, fq);
        if (!has_next) break;
#pragma unroll
        for (int a = 0; a < 2; ++a)
#pragma unroll
            for (int b = 0; b < 2; ++b)
#pragma unroll
                for (int m = 0; m < 4; ++m)
#pragma unroll
                    for (int n = 0; n < 2; ++n) acc[a][b][m][n] = (f32x4){0.f, 0.f, 0.f, 0.f};
        cur = nxt; cA = nA; cB = nB; ++ui;
        if constexpr (GA) {
#pragma unroll
            for (int h = 0; h < 2; ++h)
#pragma unroll
                for (int i = 0; i < 2; ++i) vA[h][i] = nvA[h][i]; }
    }
    PG8_WAIT_V(0);
    if (wr == 0) PG8_BAR;
    PG8_BAR;
#undef PG8_SA
#undef PG8_SB
#undef PG8_STAGE
#undef PG8_STAGE_A
#undef PG8_LDA
#undef PG8_LDB
#undef PG8_MMA
#undef PG8_WAIT_V
#undef PG8_WAIT_L
#undef PG8_BAR
#undef PG8_SCHED
}
}

struct TJob { const float* src; bf16_t* dst; int ld, k0, n0, mode, kdst; };
__device__ __forceinline__ void tcvt_load(const TJob& J, float4 (&v)[4], int tid) {
#pragma unroll
    for (int i = 0; i < 4; ++i) {
        const int kk = (tid >> 4) + 16 * i, c4 = (tid & 15) * 4, cd = J.n0 + c4;
        int orig = cd; bool ok = true;
        if (J.mode == 1) {
            if (cd < 896) orig = cd;
            else if (cd < 1024) orig = cd - 896 + 1024;
            else if (cd < 2048) { const int q = cd - 1024, hd = q >> 6, pp = q & 63;
                const int d = (pp & 4) ? 32 + 4 * (pp >> 3) + (pp & 3) : 4 * (pp >> 3) + (pp & 3);
                orig = 1304 + hd * 64 + d; }
            else if (cd < 5120) orig = cd - 2048 + 3352;
            else if (cd < 5144) orig = cd - 5120 + 1280;
            else if (cd < 5376) ok = false;
            else if (cd < 5504) orig = cd - 5376 + 896;
            else if (cd < 5632) orig = cd - 5504 + 1152;
            else orig = cd - 5632 + 2328;
        }
        v[i] = make_float4(0.f, 0.f, 0.f, 0.f);
        if (ok) v[i] = *(const float4*)(J.src + (size_t)(J.k0 + kk) * J.ld + orig);
    }
}
__device__ __forceinline__ void tcvt_finish(const TJob& J, const float4 (&v)[4], unsigned char* lds, int tid) {
    float* tile = (float*)lds;
#pragma unroll
    for (int i = 0; i < 4; ++i) {
        const int kk = (tid >> 4) + 16 * i, c4 = (tid & 15) * 4;
        tile[kk * 65 + c4 + 0] = v[i].x; tile[kk * 65 + c4 + 1] = v[i].y; tile[kk * 65 + c4 + 2] = v[i].z; tile[kk * 65 + c4 + 3] = v[i].w;
    }
    __syncthreads();
#pragma unroll
    for (int i = 0; i < 2; ++i) {
        const int q = tid + 256 * i, n = q >> 3, kc = q & 7;
        float x[8];
#pragma unroll
        for (int j = 0; j < 8; ++j) x[j] = tile[(kc * 8 + j) * 65 + n];
        u32x4 w; w.x = pack2(x[0], x[1]); w.y = pack2(x[2], x[3]); w.z = pack2(x[4], x[5]); w.w = pack2(x[6], x[7]);
        int drow = J.n0 + n; if (J.mode >= 2) drow = 8 * (drow >> 2) + (drow & 3) + (J.mode == 3 ? 4 : 0);
        *(u32x4*)(J.dst + (size_t)drow * J.kdst + J.k0 + kc * 8) = w;
    }
    __syncthreads();
}
__device__ __forceinline__ void tcvt_tile(const float* src, int ld_src, int k0, int n0, int mode, bf16_t* dst, int kdst, unsigned char* lds, int half) {
    TJob J; J.src = src; J.dst = dst; J.ld = ld_src; J.k0 = k0; J.n0 = n0; J.mode = mode; J.kdst = kdst;
    const int tid = (ltid() & 255); float4 v[4];
    tcvt_load(J, v, tid); tcvt_finish(J, v, lds, tid);
}

__device__ __forceinline__ void tcvt_decode(const Params& p, unsigned char* ws, int layer, int t, TJob& J) {
    constexpr int J0 = 16 * 104, J1 = 8 * 16, J2 = 256, J3 = 256, J4 = 2048, J5 = 2048;
    int u = t;
        if (u < J0) { J.src = p.w_in + (size_t)layer * 1024 * DIN; J.ld = DIN; J.k0 = (u % 16) * 64; J.n0 = (u / 16) * 64; J.mode = 1; J.dst = (bf16_t*)(ws + WS_WIN); J.kdst = 1024; return; }
        u -= J0;
        if (u < J1) { J.src = p.w_br_a + (size_t)layer * 512 * 1024; J.ld = 1024; J.k0 = (u % 8) * 64; J.n0 = (u / 8) * 64; J.mode = 0; J.dst = (bf16_t*)(ws + WS_WA); J.kdst = 512; return; }
        u -= J1;
        if (u < J2) { J.src = p.w_br_b + (size_t)layer * 1024 * 1024; J.ld = 1024; J.k0 = (u % 16) * 64; J.n0 = (u / 16) * 64; J.mode = 0; J.dst = (bf16_t*)(ws + WS_WB); J.kdst = 1024; return; }
        u -= J2;
        if (u < J3) { J.src = p.w_o + (size_t)layer * 1024 * 1024; J.ld = 1024; J.k0 = (u % 16) * 64; J.n0 = (u / 16) * 64; J.mode = 0; J.dst = (bf16_t*)(ws + WS_WO); J.kdst = 1024; return; }
        u -= J3;
        if (u < J4 + J5) {
            const bool up = u >= J4; if (up) u -= J4;
            const int e = u / 128, v = u % 128;
            J.src = (up ? p.w_up : p.w_gate) + ((size_t)layer * NE + e) * 1024 * 512; J.ld = 512; J.k0 = (v % 16) * 64; J.n0 = (v / 16) * 64; J.mode = up ? 3 : 2;
            J.dst = (bf16_t*)(ws + WS_WG) + (size_t)e * 1024 * 1024; J.kdst = 1024; return;
        }
        u -= J4 + J5;
        { const int e = u / 128, v = u % 128;
          J.src = p.w_down + ((size_t)layer * NE + e) * 512 * 1024; J.ld = 1024; J.k0 = (v % 8) * 64; J.n0 = (v / 8) * 64; J.mode = 0; J.dst = (bf16_t*)(ws + WS_WD) + (size_t)e * 1024 * 512; J.kdst = 512; }
}


__device__ __forceinline__ void phase_pw(const Params& p, int layer, unsigned char* lds, int parts, int half, int skip = 0) {
    if ((int)(blockIdx.x * 2 + half) < skip) return;
    const int bid = (blockIdx.x * 2 + half) - skip, nblk = (gridDim.x * 2) - skip, tid = (ltid() & 255);
    unsigned char* ws = launder(p.ws);
    constexpr int J0 = 16 * 104, J1 = 8 * 16, J2 = 256, J3 = 256, J4 = 2048, J5 = 2048, J6 = 2048, JT = J0 + J1 + J2 + J3 + J4 + J5 + J6;
    const int t_lo = (parts & 1) ? 0 : (parts & 2) ? J0 : J0 + J1 + J2 + J3;
    const int t_hi = (parts & 4) ? JT : (parts & 2) ? J0 + J1 + J2 + J3 : (parts & 1) ? J0 : 0;
    if (t_lo + bid < t_hi) {
        float4 v[4]; { TJob J; tcvt_decode(p, ws, layer, t_lo + bid, J); tcvt_load(J, v, tid); }
        for (int t = t_lo + bid; t < t_hi; t += nblk) {
            float4 vn[4];
            if (t + nblk < t_hi) { TJob J; tcvt_decode(p, ws, layer, t + nblk, J); tcvt_load(J, vn, tid); }
            { TJob J; tcvt_decode(p, ws, layer, t, J); tcvt_finish(J, v, lds, tid); }
#pragma unroll
            for (int i = 0; i < 4; ++i) v[i] = vn[i];
        }
    }
    if (parts & 16) {
    for (int t = bid; t < 64; t += nblk) {
        const int kv = t >> 5, kt = t & 31;
        tcvt_tile(p.cmp_w1 + ((size_t)layer * 2 + kv) * 2048 * 64, 64, kt * 64, 0, 0, (bf16_t*)(ws + WS_W1T) + (size_t)kv * 64 * 2048, 2048, lds, half);
    }
    if (bid >= nblk - 2) {
        const int kv = nblk - 1 - bid, n = tid & 63, part = tid >> 6;
        const float* w1 = p.cmp_w1 + ((size_t)layer * 2 + kv) * 2048 * 64; const float* pos = p.cmp_pos + ((size_t)layer * 2 + kv) * 2048;
        float a = 0.f;
        for (int k = part * 512; k < part * 512 + 512; ++k) a += pos[k] * w1[(size_t)k * 64 + n];
        float* red = (float*)lds;
        __syncthreads(); red[tid] = a; __syncthreads();
        if (tid < 64) ((float*)(ws + WS_B1))[kv * 64 + tid] = red[tid] + red[tid + 64] + red[tid + 128] + red[tid + 192];
        __syncthreads();
    }
    }
    if (parts & 8) {
        const float4* xs = (const float4*)p.x; u32x2* xb = (u32x2*)(ws + WS_XB);
        for (size_t i = (size_t)bid * HT + tid; i < (size_t)T_ * 1024 / 4; i += (size_t)nblk * HT) {
            float4 v = xs[i]; u32x2 w; w.x = pack2(v.x, v.y); w.y = pack2(v.z, v.w); xb[i] = w;
        }
        for (int n = bid * HT + tid; n < 8192; n += nblk * HT) {
            int bk;
            if (n < 16) bk = n;
            else { const int th[15] = {22, 30, 40, 54, 73, 99, 134, 182, 246, 332, 450, 609, 825, 1117, 1513}; bk = 16;
#pragma unroll
                for (int k = 0; k < 15; ++k) bk += (n >= th[k]) ? 1 : 0; }
            (ws + WS_BUCKET)[n] = (unsigned char)bk;
        }
        for (int i = bid * HT + tid; i < 8192 * 32; i += nblk * HT) {
            const int pos = i >> 5, d = i & 31;
            const float inv = powf(10000.f, -(float)d * 2.0f / 64.f);
            const float ang = (float)pos * inv;
            float sn, cs; sincosf(ang, &sn, &cs);
            ((float2*)(ws + WS_ROPE))[i] = make_float2(cs, sn);
        }
        if (bid == 0) for (int i = tid; i < 8192; i += HT) ((unsigned*)(ws + WS_CTL))[i] = 0u;
    }
}

__device__ __forceinline__ float fsig(float x) { return __builtin_amdgcn_rcpf(1.f + __builtin_amdgcn_exp2f(-1.4426950408889634f * x)); }
template <int KIND>
__device__ __forceinline__ void g1_epi(const f32x4 (&acc)[2][2][4][2], unsigned char* ws, int r0, int c0, int wr, int wc, int fr, int fq) {
#pragma unroll
    for (int ai = 0; ai < 2; ++ai)
#pragma unroll
        for (int m = 0; m < 4; ++m) {
            const int row = r0 + 128 * ai + 64 * wr + 16 * m + fr + vzero();
#pragma unroll
            for (int bj = 0; bj < 2; ++bj) {
                const int col = c0 + 128 * bj + 32 * wc + 8 * fq;
                f32x4 v0 = acc[ai][bj][m][0], v1 = acc[ai][bj][m][1];
                if (KIND == 5) {
                    const int b = col >> 13, sq = col & (S_ - 1);
                    bf16_t* dst;
                    if (row < C_VW) { const int c = row - C_VS; dst = (bf16_t*)(ws + WS_VST) + ((size_t)(b * 2 + (c >> 6)) * 64 + (c & 63)) * S_ + sq; }
                    else if (row < C_VR) { const int c = row - C_VW; dst = (bf16_t*)(ws + WS_VWT) + ((size_t)(b * 2 + (c >> 6)) * 64 + (c & 63)) * S_ + sq; }
                    else { const int c = row - C_VR; dst = (bf16_t*)(ws + WS_VRT) + ((size_t)(b * 8 + (c >> 7)) * 128 + (c & 127)) * S_ + sq; }
                    u32x4 w; w.x = pack2(v0[0], v0[1]); w.y = pack2(v0[2], v0[3]); w.z = pack2(v1[0], v1[1]); w.w = pack2(v1[2], v1[3]);
                    *(u32x4*)dst = w;
                    continue;
                }
                if (KIND == 1 || KIND == 2) {
                    const float2* rope = (const float2*)(ws + WS_ROPE);
                    const int pos = row & (S_ - 1), d = 16 * (wc & 1) + 4 * fq;
                    const float4 cs01 = *(const float4*)(rope + pos * 32 + d), cs23 = *(const float4*)(rope + pos * 32 + d + 2);
                    const float c[4] = {cs01.x, cs01.z, cs23.x, cs23.z}, sn[4] = {cs01.y, cs01.w, cs23.y, cs23.w};
                    const float sc = (KIND == 2) ? 0.125f : 1.0f;
                    f32x4 y1, y2;
#pragma unroll
                    for (int r = 0; r < 4; ++r) { y1[r] = (v0[r] * c[r] - v1[r] * sn[r]) * sc; y2[r] = (v0[r] * sn[r] + v1[r] * c[r]) * sc; }
                    v0 = y1; v1 = y2;
                } else if (KIND == 3) {
#pragma unroll
                    for (int r = 0; r < 4; ++r) { v0[r] = v0[r] * fsig(v0[r]); v1[r] = v1[r] * fsig(v1[r]); }
                } else if (KIND == 4) {
#pragma unroll
                    for (int r = 0; r < 4; ++r) { v0[r] = fsig(v0[r]); v1[r] = fsig(v1[r]); }
                }
                u32x4 w; w.x = pack2(v0[0], v0[1]); w.y = pack2(v0[2], v0[3]); w.z = pack2(v1[0], v1[1]); w.w = pack2(v1[2], v1[3]);
                *(u32x4*)((bf16_t*)(ws + WS_P) + (size_t)row * LD + col) = w;
            }
        }
}
struct G1Order {      typedef pg8::Unit U; static constexpr bool GATHER = false;
    int xcd, slot, per;
    __device__ __forceinline__ bool next(int i, pg8::Unit& u) const {
        const int j = slot + i * per; if (j >= 208) return false;
        if (j < 192) { u.pm = j / 3; u.pn = xcd + 8 * (j % 3); } else { const int q = j - 192; u.pm = 8 * xcd + (q >> 1); u.pn = 24 + (q & 1); }
        return true;
    }
    __device__ __forceinline__ void ptrs(const pg8::Unit& u, unsigned& A, unsigned& B) const {
        const unsigned x = (unsigned)WS_XB + (unsigned)u.pm * (256u * 1024u * 2u), w = (unsigned)WS_WIN + (unsigned)u.pn * (256u * 1024u * 2u);
        if (u.pn >= 21) { A = w; B = x; } else { A = x; B = w; }
    }
};
struct G1Epi {
    unsigned char* ws;
    __device__ __forceinline__ void operator()(const f32x4 (&acc)[2][2][4][2], const pg8::Unit& u, int wr, int wc, int fr, int fq) const {
        const int pn = u.pn, tok0 = u.pm * 256, n0 = pn * 256;
        if (pn >= 21) g1_epi<5>(acc, ws, n0, tok0, wr, wc, fr, fq);
        else if (pn >= 12) g1_epi<4>(acc, ws, tok0, n0, wr, wc, fr, fq);
        else if (pn >= 8) g1_epi<3>(acc, ws, tok0, n0, wr, wc, fr, fq);
        else if (pn >= 6) g1_epi<2>(acc, ws, tok0, n0, wr, wc, fr, fq);
        else if (pn >= 4) g1_epi<1>(acc, ws, tok0, n0, wr, wc, fr, fq);
        else g1_epi<0>(acc, ws, tok0, n0, wr, wc, fr, fq);
    }
};
__device__ __forceinline__ void phase_g1(const Params& p, int layer, unsigned char* lds) {
    unsigned char* ws = launder(p.ws);
    G1Order S; S.xcd = blockIdx.x & 7; S.slot = blockIdx.x >> 3; S.per = gridDim.x >> 3;
    G1Epi E; E.ws = ws;
    pg8::gemm_phase<G1Epi, G1Order>(lds, 1024, S, E, ltid(), ws);
}

__device__ __forceinline__ void load_tile64(const bf16_t* base, size_t rowStride, unsigned char* dst, int wid, int lane) {
    const int c = ((lane & 7) ^ (lane >> 3)) * 8;
#pragma unroll
    for (int i = 0; i < 2; ++i) { const int j = wid + 4 * i, row = 8 * j + (lane >> 3); glds16(base + (size_t)row * rowStride + c, dst + j * 1024); }
}
__device__ __forceinline__ void load_tile128(const bf16_t* base, size_t rowStride, unsigned char* dst, int wid, int lane) {
    const int c = ((lane & 7) ^ (lane >> 3)) * 8;
#pragma unroll
    for (int i = 0; i < 4; ++i) { const int j = wid + 4 * i, row = 8 * j + (lane >> 3); glds16(base + (size_t)row * rowStride + c, dst + j * 1024); }
}
__device__ __forceinline__ void load_tile128w(const bf16_t* base, size_t rowStride, unsigned char* dst, int wid, int lane) {
    const int c = ((lane & 15) ^ ((4 * wid + (lane >> 4)) & 15)) * 8;
#pragma unroll
    for (int i = 0; i < 8; ++i) { const int j = wid + 4 * i, row = 4 * j + (lane >> 4); glds16(base + (size_t)row * rowStride + c, dst + j * 1024); }
}
__device__ __forceinline__ bf16x8 lds_frag128(const unsigned char* tile, int row, int chunk) {
    return *(const bf16x8*)(tile + row * 128 + ((chunk ^ (row & 7)) << 4));
}
__device__ __forceinline__ bf16x8 lds_frag256(const unsigned char* tile, int row, int chunk) {
    return *(const bf16x8*)(tile + row * 256 + ((chunk ^ (row & 15)) << 4));
}
__device__ __forceinline__ bf16x8 lds_vfrag128(const unsigned char* tile, int row, int kbase, int fq) {
    const int ca = (kbase >> 3) + (fq >> 1), hb = (fq & 1) * 8;
    const u32x2 a = *(const u32x2*)(tile + row * 128 + ((ca ^ (row & 7)) << 4) + hb);
    const u32x2 b = *(const u32x2*)(tile + row * 128 + (((ca + 2) ^ (row & 7)) << 4) + hb);
    u32x4 w; w.x = a.x; w.y = a.y; w.z = b.x; w.w = b.y;
    return __builtin_bit_cast(bf16x8, w);
}
__device__ __forceinline__ bf16x8 lds_vfrag256(const unsigned char* tile, int row, int kbase, int fq) {
    const int ca = (kbase >> 3) + (fq >> 1), hb = (fq & 1) * 8;
    const u32x2 a = *(const u32x2*)(tile + row * 256 + ((ca ^ (row & 15)) << 4) + hb);
    const u32x2 b = *(const u32x2*)(tile + row * 256 + (((ca + 2) ^ (row & 15)) << 4) + hb);
    u32x4 w; w.x = a.x; w.y = a.y; w.z = b.x; w.w = b.y;
    return __builtin_bit_cast(bf16x8, w);
}
__device__ __forceinline__ bf16x8 pack8(f32x4 a, f32x4 b) {
    u32x4 w; w.x = pack2(a[0], a[1]); w.y = pack2(a[2], a[3]); w.z = pack2(b[0], b[1]); w.w = pack2(b[2], b[3]);
    return __builtin_bit_cast(bf16x8, w);
}

__device__ __forceinline__ float gelu_tanh(float x) {
    const float u = 0.7978845608028654f * (x + 0.044715f * x * x * x);
    return 0.5f * x * (1.f + tanhf(u));
}
__device__ __forceinline__ void compress_item(const Params& p, int layer, int item, unsigned char* lds, int half) {
    unsigned char* ws = launder(p.ws);
    const int tid = (ltid() & 255), lane = tid & 63, wid = tid >> 6, wr = wid >> 1, wc = wid & 1, fr = lane & 15, fq = lane >> 4;
    const int mtile = item & 3, g = (item >> 2) & 1, b = (item >> 3) & 1, kv = item >> 4;
    const int i0 = mtile * 128;
    const bf16_t* P = (const bf16_t*)(ws + WS_P);
    const bf16_t* W1T = (const bf16_t*)(ws + WS_W1T) + (size_t)kv * 64 * 2048;
    const int col = (kv ? C_VC : C_KC) + g * 64;
    const int ldc = ((lane & 7) ^ (lane >> 3)) * 8;
    const bf16_t* ap[4];
#pragma unroll
    for (int i = 0; i < 4; ++i) ap[i] = P + ((size_t)b * S_ + 16 * (i0 + 32 * i + 8 * wid + (lane >> 3))) * LD + col + ldc;
    const bf16_t* bp[2];
#pragma unroll
    for (int i = 0; i < 2; ++i) bp[i] = W1T + (size_t)(8 * (wid + 4 * i) + (lane >> 3)) * 2048 + ldc;
    f32x4 acc[4][2];
#pragma unroll
    for (int i = 0; i < 4; ++i)
#pragma unroll
        for (int j = 0; j < 2; ++j) acc[i][j] = (f32x4){0.f, 0.f, 0.f, 0.f};
    __syncthreads();
#define CSTAGE(buf, l) do { unsigned char* st_ = lds + (buf) * 24576; \
        _Pragma("unroll") for (int i = 0; i < 4; ++i) glds16(ap[i] + (size_t)(l) * LD, st_ + (4 * i + wid) * 1024); \
        _Pragma("unroll") for (int i = 0; i < 2; ++i) glds16(bp[i] + (l) * 64, st_ + 16384 + (wid + 4 * i) * 1024); } while (0)
    CSTAGE(0, 0); CSTAGE(1, 1);
    for (int l = 0; l < 32; ++l) {
        const unsigned char* st = lds + (l % 3) * 24576;
        if (l + 1 < 32) WAIT_V(6); else WAIT_V(0);
        RAW_BARRIER();
        if (l + 2 < 32) CSTAGE((l + 2) % 3, l + 2);
#pragma unroll
        for (int ks = 0; ks < 2; ++ks) {
            bf16x8 a[4], bb[2];
#pragma unroll
            for (int i = 0; i < 4; ++i) a[i] = lds_frag128(st, 64 * wr + 16 * i + fr, 4 * ks + fq);
#pragma unroll
            for (int j = 0; j < 2; ++j) bb[j] = lds_frag128(st + 16384, 32 * wc + 16 * j + fr, 4 * ks + fq);
#pragma unroll
            for (int i = 0; i < 4; ++i)
#pragma unroll
                for (int j = 0; j < 2; ++j) acc[i][j] = mfma16(a[i], bb[j], acc[i][j]);
        }
    }
    __syncthreads();
#undef CSTAGE
    float* hid = (float*)lds;
    const float* b1 = (const float*)(ws + WS_B1) + kv * 64;
#pragma unroll
    for (int j = 0; j < 2; ++j) {
        const int n = 32 * wc + 16 * j + fr; const float bias = b1[n + vzero()];
#pragma unroll
        for (int i = 0; i < 4; ++i)
#pragma unroll
            for (int r = 0; r < 4; ++r) hid[(64 * wr + 16 * i + 4 * fq + r) * 65 + n] = gelu_tanh(acc[i][j][r] + bias);
    }
    __syncthreads();
    {
        const int row = tid >> 1, nb = (tid & 1) * 32, ci = i0 + row;
        const float* w2 = p.cmp_w2 + ((size_t)layer * 2 + kv) * 64 * 64;
        float o[32];
#pragma unroll
        for (int q = 0; q < 32; ++q) o[q] = 0.f;
        for (int n = 0; n < 64; ++n) {
            const float h = hid[row * 65 + n];
#pragma unroll
            for (int q4 = 0; q4 < 8; ++q4) { const float4 w = *(const float4*)(w2 + n * 64 + nb + 4 * q4); o[4 * q4] += h * w.x; o[4 * q4 + 1] += h * w.y; o[4 * q4 + 2] += h * w.z; o[4 * q4 + 3] += h * w.w; }
        }
        if (kv == 0) {
            bf16_t* dst = (bf16_t*)(ws + WS_KCC) + ((size_t)(b * 2 + g) * 512 + ci) * 64 + nb;
#pragma unroll
            for (int q = 0; q < 32; q += 4) { f32x4 v = {o[q], o[q + 1], o[q + 2], o[q + 3]}; if (ci >= 511) v = (f32x4){0.f, 0.f, 0.f, 0.f}; *(u32x2*)(dst + q) = pack4(v); }
        } else {
            bf16_t* dst = (bf16_t*)(ws + WS_VCCT) + ((size_t)(b * 2 + g) * 64 + nb) * 512 + ci;
#pragma unroll
            for (int q = 0; q < 32; ++q) dst[(size_t)q * 512] = f2bf(ci >= 511 ? 0.f : o[q]);
        }
    }
    __syncthreads();
}

__device__ __forceinline__ float ret_lg2(int h) { const float gam = 1.f - exp2f(-5.f - (float)h); return log2f(gam); }

__device__ __forceinline__ void retkv_item(const Params& p, int item, unsigned char* lds, int half) {
    unsigned char* ws = launder(p.ws);
    const int tid = (ltid() & 255), lane = tid & 63, wid = tid >> 6, fr = lane & 15, fq = lane >> 4;
    const int n = item & 63, h = (item >> 6) & 7, b = item >> 9;
    const size_t tok0 = (size_t)b * S_ + 128 * n;
    unsigned char* vL = lds; unsigned char* kL = lds + 32768;
    load_tile128w((const bf16_t*)(ws + WS_VRT) + ((size_t)(b * 8 + h) * 128) * S_ + 128 * n, S_, vL, wid, lane);
    load_tile128((const bf16_t*)(ws + WS_P) + tok0 * LD + C_KR + h * 64, LD, kL, wid, lane);
    wait_vm0(); __syncthreads();
    const float lg2 = ret_lg2(h);
    f32x4 acc[2][4];
#pragma unroll
    for (int m = 0; m < 2; ++m)
#pragma unroll
        for (int nt = 0; nt < 4; ++nt) acc[m][nt] = (f32x4){0.f, 0.f, 0.f, 0.f};
#pragma unroll
    for (int ks = 0; ks < 4; ++ks) {
        bf16x8 a[2], bb[4];
#pragma unroll
        for (int m = 0; m < 2; ++m) a[m] = lds_frag256(vL, 32 * wid + 16 * m + fr, 4 * ks + fq);
        float dec[8];
#pragma unroll
        for (int j = 0; j < 8; ++j) dec[j] = exp2f((float)(127 - (32 * ks + 8 * fq + j)) * lg2);
#pragma unroll
        for (int nt = 0; nt < 4; ++nt) {
            const int d = 16 * nt + fr;
            float v[8];
#pragma unroll
            for (int j = 0; j < 8; ++j) {
                const int tk = 32 * ks + 8 * fq + j;
                const bf16_t kvv = *(const bf16_t*)(kL + tk * 128 + (((d >> 3) ^ (tk & 7)) << 4) + (d & 7) * 2);
                v[j] = bf2f(kvv) * dec[j];
            }
            u32x4 w; w.x = pack2(v[0], v[1]); w.y = pack2(v[2], v[3]); w.z = pack2(v[4], v[5]); w.w = pack2(v[6], v[7]);
            bb[nt] = __builtin_bit_cast(bf16x8, w);
        }
#pragma unroll
        for (int m = 0; m < 2; ++m)
#pragma unroll
            for (int nt = 0; nt < 4; ++nt) acc[m][nt] = mfma16(a[m], bb[nt], acc[m][nt]);
    }
    float* KVT = (float*)(ws + WS_KVT) + ((size_t)(b * 8 + h) * 64 + n) * 8192;
#pragma unroll
    for (int m = 0; m < 2; ++m)
#pragma unroll
        for (int nt = 0; nt < 4; ++nt)
#pragma unroll
            for (int r = 0; r < 4; ++r) KVT[(32 * wid + 16 * m + 4 * fq + r) * 64 + 16 * nt + fr] = acc[m][nt][r];
    __syncthreads();
}

__device__ __forceinline__ void phase_p2(const Params& p, int layer, unsigned char* lds, int half) {
    const int vb = blockIdx.x * 2 + half, nvb = gridDim.x * 2;
    if (vb < 32) compress_item(p, layer, vb, lds, half);
    else for (int it = vb - 32; it < 1024; it += nvb - 32) retkv_item(p, it, lds, half);
}

constexpr int NSA_IMP = 32768, NSA_BUCKET = 65792, NSA_BIAS = 73984;

struct NsaLane { int t; int fr, fq, wid, lane; };

template <int BR, int PASS>
__device__ __forceinline__ void nsa_half(const unsigned char* kL, const unsigned char* vL, const unsigned char* lds, const bf16x8 (&qptr)[4][2],
                                         f32x4 (&O)[4][4], float (&m)[4], float (&l)[4], int tile, int hf, bool selbit, const NsaLane& L, int qrow) {
    const int fr = L.fr, fq = L.fq;
    bf16x8 Kf[2][2];
#pragma unroll
    for (int i = 0; i < 2; ++i)
#pragma unroll
        for (int ks = 0; ks < 2; ++ks) Kf[i][ks] = lds_frag128(kL, 32 * hf + 16 * i + fr, 4 * ks + fq);
    bf16x8 Vf[4];
    if (PASS != 0) {
#pragma unroll
        for (int mt = 0; mt < 4; ++mt) Vf[mt] = lds_vfrag128(vL, 16 * mt + fr, 32 * hf, fq);
    }
    unsigned vmask = 0; unsigned bk[2];
    const unsigned char* bucketL = lds + NSA_BUCKET;
#pragma unroll
    for (int i = 0; i < 2; ++i) {
        unsigned pk = 0;
#pragma unroll
        for (int r = 0; r < 4; ++r) {
            const int kk = 32 * hf + 16 * i + 4 * fq + r;
            int rel; bool ok;
            if (BR == 0) { rel = L.t - (16 * (64 * tile + kk) + 31); ok = rel >= 0; }
            else if (BR == 1) { rel = L.t - (64 * tile + kk); ok = selbit && rel >= 0; }
            else { rel = L.t - (64 * tile + kk); ok = rel >= 0 && rel < 512; }
            int rc = rel < 0 ? 0 : rel; rc = rc > 8191 ? 8191 : rc;
            pk |= (unsigned)bucketL[rc] << (8 * r);
            vmask |= (ok ? 1u : 0u) << (4 * i + r);
        }
        bk[i] = pk;
    }
    const float* biasL = (const float*)(lds + NSA_BIAS);
    float ia[2] = {0.f, 0.f}, ic[2] = {0.f, 0.f};
#pragma unroll
    for (int nt = 0; nt < 4; ++nt) {
        f32x4 S[2];
        const bf16x8 q0 = qptr[nt][0], q1 = qptr[nt][1];
#pragma unroll
        for (int i = 0; i < 2; ++i) {
            S[i] = (f32x4){0.f, 0.f, 0.f, 0.f};
            S[i] = mfma16(Kf[i][0], q0, S[i]); S[i] = mfma16(Kf[i][1], q1, S[i]);
        }
        float tmax = -1e30f;
        float bsv[2][4];
#pragma unroll
        for (int i = 0; i < 2; ++i)
#pragma unroll
            for (int r = 0; r < 4; ++r) bsv[i][r] = biasL[nt * 32 + ((bk[i] >> (8 * r)) & 0xffu)];
        asm volatile("" : "+v"(bsv[0][0]), "+v"(bsv[0][1]), "+v"(bsv[0][2]), "+v"(bsv[0][3]), "+v"(bsv[1][0]), "+v"(bsv[1][1]), "+v"(bsv[1][2]), "+v"(bsv[1][3]));
#pragma unroll
        for (int i = 0; i < 2; ++i)
#pragma unroll
            for (int r = 0; r < 4; ++r) {
                const bool ok = (vmask >> (4 * i + r)) & 1u;
                const float sv = S[i][r] * 0.125f + bsv[i][r];
                S[i][r] = ok ? sv : -1e30f; tmax = fmaxf(tmax, S[i][r]);
            }
        if (PASS != 1) {
            tmax = rows_max(tmax);
            const float mnew = fmaxf(m[nt], tmax), alpha = __expf(m[nt] - mnew);
            float psum = 0.f;
#pragma unroll
            for (int i = 0; i < 2; ++i)
#pragma unroll
                for (int r = 0; r < 4; ++r) {
                    const bool ok = (vmask >> (4 * i + r)) & 1u;
                    const float pv = ok ? __expf(S[i][r] - mnew) : 0.f;
                    S[i][r] = pv; psum += pv;
                }
            psum = rows_sum(psum);
            l[nt] = l[nt] * alpha + psum; m[nt] = mnew;
            if (PASS == 2) {
#pragma unroll
                for (int mt = 0; mt < 4; ++mt) O[mt][nt] = O[mt][nt] * alpha;
            }
        } else {
#pragma unroll
            for (int i = 0; i < 2; ++i) {
#pragma unroll
                for (int r = 0; r < 4; ++r) {
                    const bool ok = (vmask >> (4 * i + r)) & 1u;
                    S[i][r] = ok ? __expf(S[i][r] - m[nt]) * l[nt] : 0.f;
                }
                ia[i] += S[i][0] + S[i][1] + S[i][2] + 0.5f * S[i][3];
                ic[i] += 0.5f * S[i][3];
            }
        }
        if (PASS != 0) {
            const bf16x8 Pb = pack8(S[0], S[1]);
#pragma unroll
            for (int mt = 0; mt < 4; ++mt) O[mt][nt] = mfma16(Vf[mt], Pb, O[mt][nt]);
        }
    }
    if (PASS == 1) {
        float* imp = (float*)(lds + NSA_IMP) + qrow * 129;
        asm volatile("" ::: "memory"); __builtin_amdgcn_wave_barrier();
#pragma unroll
        for (int i = 0; i < 2; ++i) { const int j = 16 * tile + 8 * hf + 4 * i + fq; imp[j] += ia[i]; }
        asm volatile("s_waitcnt lgkmcnt(0)" ::: "memory"); __builtin_amdgcn_wave_barrier();
#pragma unroll
        for (int i = 0; i < 2; ++i) { const int j = 16 * tile + 8 * hf + 4 * i + fq + 1; if (j < 128) imp[j] += ic[i]; }
        asm volatile("s_waitcnt lgkmcnt(0)" ::: "memory"); __builtin_amdgcn_wave_barrier();
    }
}
template <int BR, int PASS>
__device__ __forceinline__ void nsa_tile(const unsigned char* kL, const unsigned char* vL, const unsigned char* lds, const bf16x8 (&qptr)[4][2],
                                         f32x4 (&O)[4][4], float (&m)[4], float (&l)[4], int tile, bool selbit, const NsaLane& L, int qrow) {
#pragma unroll 1
    for (int hf = 0; hf < 2; ++hf) nsa_half<BR, PASS>(kL, vL, lds, qptr, O, m, l, tile, hf, selbit, L, qrow);
}

__device__ __forceinline__ void cmp_item(const Params& p, int item, unsigned char* lds, int half) {
    unsigned char* ws = launder(p.ws);
    const int tid = (ltid() & 255), lane = tid & 63, wid = tid >> 6, fr = lane & 15, fq = lane >> 4;
    const int combo = item & 3, qt = 127 - (item >> 2), b = combo >> 1, g = combo & 1;
    const int q0 = qt * 64, qrow = 16 * wid + fr;
    NsaLane L; L.t = q0 + qrow; L.fr = fr; L.fq = fq; L.wid = wid; L.lane = lane;
    const size_t tok = (size_t)b * S_ + L.t;
    const bf16_t* P = (const bf16_t*)(ws + WS_P);
    __syncthreads();
    if (tid < 128) ((float*)(lds + NSA_BIAS))[tid] = p.rel_bias[(tid & 31) * 8 + 4 * g + (tid >> 5)];
    for (int i = tid; i < 64 * 129; i += HT) ((float*)(lds + NSA_IMP))[i] = 0.f;
    bf16x8 Qf[4][2];
#pragma unroll
    for (int nt = 0; nt < 4; ++nt)
#pragma unroll
        for (int ks = 0; ks < 2; ++ks) Qf[nt][ks] = *(const bf16x8*)(P + tok * LD + C_QA + (4 * g + nt) * 64 + 32 * ks + 8 * fq);
    __syncthreads();
    f32x4 O[4][4]; float m[4], l[4];
    const bf16_t* gates = P + tok * LD + C_GA + (4 * g) * 3;
    const bf16_t* kc = (const bf16_t*)(ws + WS_KCC) + (size_t)(b * 2 + g) * 512 * 64;
    const bf16_t* vc = (const bf16_t*)(ws + WS_VCCT) + (size_t)(b * 2 + g) * 64 * 512;
    const int ntc = ((q0 + 32) >> 4) / 64 + 1;
#pragma unroll
    for (int nt = 0; nt < 4; ++nt) { m[nt] = -1e30f; l[nt] = 0.f; }
    load_tile64(kc, 64, lds, wid, lane);
    wait_vm0(); __syncthreads();
    for (int it = 0; it < ntc; ++it) {
        unsigned char* cur = lds + (it & 1) * 16384;
        if (it + 1 < ntc) load_tile64(kc + (size_t)(it + 1) * 64 * 64, 64, lds + ((it + 1) & 1) * 16384, wid, lane);
        nsa_tile<0, 0>(cur, cur + 8192, lds, Qf, O, m, l, it, true, L, qrow);
        wait_vm0(); __syncthreads();
    }
#pragma unroll
    for (int nt = 0; nt < 4; ++nt) l[nt] = l[nt] > 0.f ? 1.f / l[nt] : 0.f;
#pragma unroll
    for (int mt = 0; mt < 4; ++mt)
#pragma unroll
        for (int nt = 0; nt < 4; ++nt) O[mt][nt] = (f32x4){0.f, 0.f, 0.f, 0.f};
    load_tile64(kc, 64, lds, wid, lane); load_tile64(vc, 512, lds + 8192, wid, lane);
    wait_vm0(); __syncthreads();
    for (int it = 0; it < ntc; ++it) {
        unsigned char* cur = lds + (it & 1) * 16384;
        if (it + 1 < ntc) { unsigned char* nx = lds + ((it + 1) & 1) * 16384;
            load_tile64(kc + (size_t)(it + 1) * 64 * 64, 64, nx, wid, lane); load_tile64(vc + (it + 1) * 64, 512, nx + 8192, wid, lane); }
        nsa_tile<0, 1>(cur, cur + 8192, lds, Qf, O, m, l, it, true, L, qrow);
        wait_vm0(); __syncthreads();
    }
    bf16_t* YC = (bf16_t*)(ws + WS_YC) + tok * 512 + (4 * g) * 64;
#pragma unroll
    for (int nt = 0; nt < 4; ++nt) {
        const float gt = bf2f(gates[nt * 3 + 0]);
#pragma unroll
        for (int mt = 0; mt < 4; ++mt) *(u32x2*)(YC + nt * 64 + 16 * mt + 4 * fq) = pack4(O[mt][nt] * gt);
    }
    const int cur = qt;
    {
        float* imp = (float*)(lds + NSA_IMP) + qrow * 129 + 32 * fq;
        asm volatile("s_waitcnt lgkmcnt(0)" ::: "memory"); __builtin_amdgcn_wave_barrier();
#pragma unroll
        for (int i = 0; i < 32; ++i) {
            const int j = 32 * fq + i;
            const float v = imp[i];
            imp[i] = j > cur ? -1.f : v + ((j == 0 || j == cur || j == cur - 1) ? 1.0e4f : 0.f);
        }
        unsigned word = 0;
#pragma unroll 1
        for (int round = 0; round < 16; ++round) {
            float bv = imp[0]; int bi = 0;
#pragma unroll
            for (int i = 1; i < 32; ++i) { const float v = imp[i]; if (v > bv) { bv = v; bi = i; } }
            int gi = 32 * fq + bi;
            {
                u32x2 rv = __builtin_amdgcn_permlane16_swap(__float_as_uint(bv), __float_as_uint(bv), false, false);
                u32x2 ri = __builtin_amdgcn_permlane16_swap((unsigned)gi, (unsigned)gi, false, false);
                float v0 = __uint_as_float(rv.x), v1 = __uint_as_float(rv.y); int i0 = (int)ri.x, i1 = (int)ri.y;
                if (v1 > v0 || (v1 == v0 && i1 < i0)) { v0 = v1; i0 = i1; }
                rv = __builtin_amdgcn_permlane32_swap(__float_as_uint(v0), __float_as_uint(v0), false, false);
                ri = __builtin_amdgcn_permlane32_swap((unsigned)i0, (unsigned)i0, false, false);
                v0 = __uint_as_float(rv.x); v1 = __uint_as_float(rv.y); i0 = (int)ri.x; i1 = (int)ri.y;
                if (v1 > v0 || (v1 == v0 && i1 < i0)) { v0 = v1; i0 = i1; }
                bv = v0; gi = i0;
            }
            if (bv >= 0.f && (gi >> 5) == fq) { word |= 1u << (gi & 31); imp[gi & 31] = -2.f; }
        }
        ((unsigned*)(ws + WS_SELW))[(tok * 2 + g) * 4 + fq] = word;
    }
}

__device__ __forceinline__ void win_item(const Params& p, int item, unsigned char* lds, int half) {
    unsigned char* ws = launder(p.ws);
    const int tid = (ltid() & 255), lane = tid & 63, wid = tid >> 6, fr = lane & 15, fq = lane >> 4;
    const int combo = item & 3, qt = 127 - (item >> 2), b = combo >> 1, g = combo & 1;
    const int q0 = qt * 64, qrow = 16 * wid + fr;
    NsaLane L; L.t = q0 + qrow; L.fr = fr; L.fq = fq; L.wid = wid; L.lane = lane;
    const size_t tok = (size_t)b * S_ + L.t;
    const bf16_t* P = (const bf16_t*)(ws + WS_P);
    __syncthreads();
    if (tid < 128) ((float*)(lds + NSA_BIAS))[tid] = p.rel_bias[(tid & 31) * 8 + 4 * g + (tid >> 5)];
    bf16x8 Qf[4][2];
#pragma unroll
    for (int nt = 0; nt < 4; ++nt)
#pragma unroll
        for (int ks = 0; ks < 2; ++ks) Qf[nt][ks] = *(const bf16x8*)(P + tok * LD + C_QA + (4 * g + nt) * 64 + 32 * ks + 8 * fq);
    __syncthreads();
    f32x4 O[4][4]; float m[4], l[4];
    const bf16_t* gates = P + tok * LD + C_GA + (4 * g) * 3;
#pragma unroll
    for (int nt = 0; nt < 4; ++nt) { m[nt] = -1e30f; l[nt] = 0.f; }
#pragma unroll
    for (int mt = 0; mt < 4; ++mt)
#pragma unroll
        for (int nt = 0; nt < 4; ++nt) O[mt][nt] = (f32x4){0.f, 0.f, 0.f, 0.f};
    {
        const bf16_t* kb = P + ((size_t)b * S_) * LD + C_KW + g * 64;
        const bf16_t* vb = (const bf16_t*)(ws + WS_VWT) + (size_t)(b * 2 + g) * 64 * S_;
        const int k_lo = qt - 8 > 0 ? qt - 8 : 0, ntw = qt - k_lo + 1;
        load_tile64(kb + (size_t)k_lo * 64 * LD, LD, lds, wid, lane); load_tile64(vb + k_lo * 64, S_, lds + 8192, wid, lane);
        wait_vm0(); __syncthreads();
        for (int it = 0; it < ntw; ++it) {
            unsigned char* cu = lds + (it & 1) * 16384;
            if (it + 1 < ntw) { unsigned char* nx = lds + ((it + 1) & 1) * 16384;
                load_tile64(kb + (size_t)(k_lo + it + 1) * 64 * LD, LD, nx, wid, lane); load_tile64(vb + (k_lo + it + 1) * 64, S_, nx + 8192, wid, lane); }
            nsa_tile<2, 2>(cu, cu + 8192, lds, Qf, O, m, l, k_lo + it, true, L, qrow);
            wait_vm0(); __syncthreads();
        }
    }
    bf16_t* YW = (bf16_t*)(ws + WS_YW) + tok * 512 + (4 * g) * 64;
#pragma unroll
    for (int nt = 0; nt < 4; ++nt) {
        const float gt = bf2f(gates[nt * 3 + 2]) * (l[nt] > 0.f ? 1.f / l[nt] : 0.f);
#pragma unroll
        for (int mt = 0; mt < 4; ++mt) *(u32x2*)(YW + nt * 64 + 16 * mt + 4 * fq) = pack4(O[mt][nt] * gt);
    }
}

constexpr int SEL_RING = 8, SEL_BUCKET = SEL_RING * 16384, SEL_BIAS2 = SEL_BUCKET + 8192;
constexpr float LOG2E = 1.4426950408889634f;
__device__ __forceinline__ int t5_first(int bk) {
    const int th[16] = {16, 22, 30, 40, 54, 73, 99, 134, 182, 246, 332, 450, 609, 825, 1117, 1513};
    int r = 16;
#pragma unroll
    for (int k = 0; k < 16; ++k) r = (bk == 16 + k) ? th[k] : r;
    return r;
}
template <bool FAST>
__device__ __forceinline__ void sel_ntile(const bf16x8 (&Kf)[4][2], const unsigned char* vL, int fr, int fq, const bf16x8& q0, const bf16x8& q1, f32x4 (&O)[4], float& m, float& l,
                                          bool sb, int relb, int th, float blo, float bhi, const unsigned char* lds, int hl) {
    f32x4 S[4];
#pragma unroll
    for (int i = 0; i < 4; ++i) { S[i] = (f32x4){0.f, 0.f, 0.f, 0.f}; S[i] = mfma16(Kf[i][0], q0, S[i]); S[i] = mfma16(Kf[i][1], q1, S[i]); }
    float tmax = -1e30f;
    const float scl = (!FAST || sb) ? 0.125f * LOG2E : 0.f;
    if (FAST) { blo = (sb ? blo : -1e30f) - m; bhi = (sb ? bhi : -1e30f) - m; }
    if (FAST) {
#pragma unroll
        for (int i = 0; i < 4; ++i)
#pragma unroll
            for (int r = 0; r < 4; ++r) { const int rel = relb - (16 * i + r); S[i][r] = S[i][r] * scl + (rel >= th ? bhi : blo); tmax = fmaxf(tmax, S[i][r]); }
    } else {
        unsigned bkt[4][4]; float bs[4][4];
#pragma unroll
        for (int i = 0; i < 4; ++i)
#pragma unroll
            for (int r = 0; r < 4; ++r) { const int rel = relb - (16 * i + r); int rc = rel < 0 ? 0 : rel; rc = rc > 8191 ? 8191 : rc; bkt[i][r] = (lds + SEL_BUCKET)[rc]; }
#pragma unroll
        for (int i = 0; i < 4; ++i)
#pragma unroll
            for (int r = 0; r < 4; ++r) bs[i][r] = ((const float*)(lds + SEL_BIAS2))[hl * 32 + bkt[i][r]];
        asm volatile("" : "+v"(bs[0][0]), "+v"(bs[0][1]), "+v"(bs[0][2]), "+v"(bs[0][3]), "+v"(bs[1][0]), "+v"(bs[1][1]), "+v"(bs[1][2]), "+v"(bs[1][3]),
                          "+v"(bs[2][0]), "+v"(bs[2][1]), "+v"(bs[2][2]), "+v"(bs[2][3]), "+v"(bs[3][0]), "+v"(bs[3][1]), "+v"(bs[3][2]), "+v"(bs[3][3]));
        const float ninf = -1e30f;
#pragma unroll
        for (int i = 0; i < 4; ++i)
#pragma unroll
            for (int r = 0; r < 4; ++r) {
                const int rel = relb - (16 * i + r);
                const float sv = S[i][r] * (0.125f * LOG2E) + (bs[i][r] - m);
                S[i][r] = (sb && rel >= 0) ? sv : ninf; tmax = fmaxf(tmax, S[i][r]);
            }
    }
    tmax = rows_max(tmax);
    if (__ballot(tmax > 8.f) != 0ull) {
        const float d = fmaxf(tmax, 0.f), alpha = __builtin_amdgcn_exp2f(-d);
        m += d; l *= alpha;
#pragma unroll
        for (int mt = 0; mt < 4; ++mt) O[mt] = O[mt] * alpha;
#pragma unroll
        for (int i = 0; i < 4; ++i)
#pragma unroll
            for (int r = 0; r < 4; ++r) S[i][r] -= d;
    }
    float psum = 0.f;
#pragma unroll
    for (int i = 0; i < 4; ++i)
#pragma unroll
        for (int r = 0; r < 4; ++r) { const float pv = __builtin_amdgcn_exp2f(S[i][r]); S[i][r] = pv; psum += pv; }
    l += rows_sum(psum);
    const bf16x8 Pb0 = pack8(S[0], S[1]), Pb1 = pack8(S[2], S[3]);
#pragma unroll
    for (int mt = 0; mt < 4; ++mt) { O[mt] = mfma16(lds_vfrag128(vL, 16 * mt + fr, 0, fq), Pb0, O[mt]); O[mt] = mfma16(lds_vfrag128(vL, 16 * mt + fr, 32, fq), Pb1, O[mt]); }
}
__device__ __forceinline__ void sel_ntile2_fast(const bf16x8 (&Kf)[4][2], const unsigned char* vL, int fr, int fq, const bf16x8 (&Qf)[2][2], f32x4 (&O)[2][4], float (&m)[2], float (&l)[2],
                                                const bool (&sb)[2], const int (&relb)[2], int th, float blo, float bhi) {
    f32x4 S[2][4]; float tmax[2], bl[2], bh[2], scl[2];
#pragma unroll
    for (int b = 0; b < 2; ++b)
#pragma unroll
        for (int i = 0; i < 4; ++i) { S[b][i] = (f32x4){0.f, 0.f, 0.f, 0.f}; S[b][i] = mfma16(Kf[i][0], Qf[b][0], S[b][i]); S[b][i] = mfma16(Kf[i][1], Qf[b][1], S[b][i]); }
#pragma unroll
    for (int b = 0; b < 2; ++b) { scl[b] = sb[b] ? 0.125f * LOG2E : 0.f; bl[b] = (sb[b] ? blo : -1e30f) - m[b]; bh[b] = (sb[b] ? bhi : -1e30f) - m[b]; tmax[b] = -1e30f; }
#pragma unroll
    for (int b = 0; b < 2; ++b)
#pragma unroll
        for (int i = 0; i < 4; ++i)
#pragma unroll
            for (int r = 0; r < 4; ++r) { const int rel = relb[b] - (16 * i + r); S[b][i][r] = S[b][i][r] * scl[b] + (rel >= th ? bh[b] : bl[b]); tmax[b] = fmaxf(tmax[b], S[b][i][r]); }
#pragma unroll
    for (int b = 0; b < 2; ++b) tmax[b] = rows_max(tmax[b]);
    if (__ballot(tmax[0] > 8.f || tmax[1] > 8.f) != 0ull) {
#pragma unroll
        for (int b = 0; b < 2; ++b) {
            const float d = fmaxf(tmax[b], 0.f), alpha = __builtin_amdgcn_exp2f(-d);
            m[b] += d; l[b] *= alpha;
#pragma unroll
            for (int mt = 0; mt < 4; ++mt) O[b][mt] = O[b][mt] * alpha;
#pragma unroll
            for (int i = 0; i < 4; ++i)
#pragma unroll
                for (int r = 0; r < 4; ++r) S[b][i][r] -= d;
        }
    }
    float psum[2] = {0.f, 0.f};
#pragma unroll
    for (int b = 0; b < 2; ++b)
#pragma unroll
        for (int i = 0; i < 4; ++i)
#pragma unroll
            for (int r = 0; r < 4; ++r) { const float pv = __builtin_amdgcn_exp2f(S[b][i][r]); S[b][i][r] = pv; psum[b] += pv; }
#pragma unroll
    for (int b = 0; b < 2; ++b) l[b] += rows_sum(psum[b]);
    bf16x8 P0[2], P1[2];
#pragma unroll
    for (int b = 0; b < 2; ++b) { P0[b] = pack8(S[b][0], S[b][1]); P1[b] = pack8(S[b][2], S[b][3]); }
#pragma unroll
    for (int mt = 0; mt < 4; ++mt) {
        const bf16x8 v0 = lds_vfrag128(vL, 16 * mt + fr, 0, fq), v1 = lds_vfrag128(vL, 16 * mt + fr, 32, fq);
#pragma unroll
        for (int b = 0; b < 2; ++b) { O[b][mt] = mfma16(v0, P0[b], O[b][mt]); O[b][mt] = mfma16(v1, P1[b], O[b][mt]); }
    }
}
template <bool FAST>
__device__ __forceinline__ void sel_tile(const unsigned char* kL, const unsigned char* vL, const unsigned char* lds, const bf16x8 (&Qf)[2][2], f32x4 (&O)[2][4], float (&m)[2], float (&l)[2],
                                         const bool (&sb)[2], const bool (&need)[2], const int (&relb)[2], int th, float blo, float bhi, int hl, int fr, int fq) {
    bf16x8 Kf[4][2];
#pragma unroll
    for (int i = 0; i < 4; ++i)
#pragma unroll
        for (int ks = 0; ks < 2; ++ks) Kf[i][ks] = lds_frag128(kL, 16 * i + fr, 4 * ks + fq);
    if (FAST && need[0] && need[1]) { sel_ntile2_fast(Kf, vL, fr, fq, Qf, O, m, l, sb, relb, th, blo, bhi); return; }
    if (need[0]) sel_ntile<FAST>(Kf, vL, fr, fq, Qf[0][0], Qf[0][1], O[0], m[0], l[0], sb[0], relb[0], th, blo, bhi, lds, hl);
    if (need[1]) sel_ntile<FAST>(Kf, vL, fr, fq, Qf[1][0], Qf[1][1], O[1], m[1], l[1], sb[1], relb[1], th, blo, bhi, lds, hl);
}
template <int VAR>
__device__ __forceinline__ void sel_item(const Params& p, int v, unsigned char* lds) {
    unsigned char* ws = launder(p.ws);
    const int tid = ltid(), lane = tid & 63, wid = tid >> 6, fr = lane & 15, fq = lane >> 4;
    const int qt = 127 - (v >> 2), sub = v & 3, b = sub >> 1, g = sub & 1;
    const int q0 = qt * 64, cur = qt, hl = fr & 3;
    const bf16_t* P = (const bf16_t*)(ws + WS_P);
    __syncthreads();
    if (tid < 128) ((float*)(lds + SEL_BIAS2))[tid] = p.rel_bias[(tid & 31) * 8 + 4 * g + (tid >> 5)] * LOG2E;
    int t[2]; size_t tok[2]; bf16x8 Qf[2][2]; unsigned selw[2][4];
#pragma unroll
    for (int nt = 0; nt < 2; ++nt) {
        t[nt] = q0 + 8 * wid + 4 * nt + (fr >> 2); tok[nt] = (size_t)b * S_ + t[nt];
#pragma unroll
        for (int ks = 0; ks < 2; ++ks) Qf[nt][ks] = *(const bf16x8*)(P + tok[nt] * LD + C_QA + (4 * g + hl) * 64 + 32 * ks + 8 * fq);
        const u32x4 w = *(const u32x4*)((const unsigned*)(ws + WS_SELW) + (tok[nt] * 2 + g) * 4);
        selw[nt][0] = w.x; selw[nt][1] = w.y; selw[nt][2] = w.z; selw[nt][3] = w.w;
    }
    f32x4 O[2][4]; float m[2], l[2];
#pragma unroll
    for (int nt = 0; nt < 2; ++nt) { m[nt] = -1000.f; l[nt] = 0.f;
#pragma unroll
        for (int mt = 0; mt < 4; ++mt) O[nt][mt] = (f32x4){0.f, 0.f, 0.f, 0.f}; }
    const bf16_t* kb = P + ((size_t)b * S_) * LD + C_KS + g * 64;
    const bf16_t* vb = (const bf16_t*)(ws + WS_VST) + (size_t)(b * 2 + g) * 64 * S_;
    const int nts = cur + 1;
#define SEL_ISSUE(jj) do { unsigned char* st_ = lds + ((jj) & 7) * 16384; const int c_ = ((lane & 7) ^ (lane >> 3)) * 8, r_ = 8 * wid + (lane >> 3); \
        glds16(kb + ((size_t)(jj) * 64 + r_) * LD + c_, st_ + wid * 1024); glds16(vb + (size_t)r_ * S_ + (jj) * 64 + c_, st_ + 8192 + wid * 1024); } while (0)
    asm volatile("s_waitcnt vmcnt(0)" ::: "memory");
#pragma unroll
    for (int q = 0; q < 4; ++q) if (q < nts) SEL_ISSUE(q);
    const unsigned char* bucketL = lds + SEL_BUCKET;
    for (int jp = 0; jp < nts; jp += 4) {
        WAIT_V(0);
        RAW_BARRIER();
#pragma unroll
        for (int q = 4; q < 8; ++q) if (jp + q < nts) SEL_ISSUE(jp + q);
#pragma unroll 1
      for (int j = jp; j < jp + 4 && j < nts; ++j) {
        const unsigned char* cu = lds + (j & 7) * 16384;
        bool sb[2], need[2]; int relb[2];
#pragma unroll
        for (int nt = 0; nt < 2; ++nt) {
            const unsigned w = j < 32 ? selw[nt][0] : j < 64 ? selw[nt][1] : j < 96 ? selw[nt][2] : selw[nt][3];
            sb[nt] = (w >> (j & 31)) & 1u; need[nt] = __ballot(sb[nt]) != 0ull; relb[nt] = t[nt] - 64 * j - 4 * fq;
        }
        if (VAR == 1) { need[0] = false; need[1] = false; }
        if (VAR == 2) { if (!(need[0] || need[1])) { need[0] = false; } else { need[0] = true; need[1] = true; } }
        if (need[0] || need[1]) {
            const int rmin = q0 - 64 * j - 63, rmax = q0 + 31 - 64 * j;
            bool fast = false; int th = 0; float blo = 0.f, bhi = 0.f;
            if (rmin >= 16) {
                const int b0 = bucketL[rmin], b1 = bucketL[rmax > 8191 ? 8191 : rmax];
                if (b1 - b0 <= 1) { fast = true; th = t5_first(b1); if (b1 == b0) th = 0;
                    blo = ((const float*)(lds + SEL_BIAS2))[hl * 32 + b0]; bhi = ((const float*)(lds + SEL_BIAS2))[hl * 32 + b1]; }
            }
            if (fast) sel_tile<true>(cu, cu + 8192, lds, Qf, O, m, l, sb, need, relb, th, blo, bhi, hl, fr, fq);
            else sel_tile<false>(cu, cu + 8192, lds, Qf, O, m, l, sb, need, relb, th, blo, bhi, hl, fr, fq);
        }
      }
    }
#undef SEL_ISSUE
    __syncthreads();
#pragma unroll
    for (int nt = 0; nt < 2; ++nt) {
        const float gt = bf2f(P[tok[nt] * LD + C_GA + (4 * g + hl) * 3 + 1]) * (l[nt] > 0.f ? 1.f / l[nt] : 0.f);
        const size_t o = tok[nt] * 512 + (4 * g + hl) * 64;
#pragma unroll
        for (int mt = 0; mt < 4; ++mt) {
            const f32x4 yc = unpack4(*(const u32x2*)((const bf16_t*)(ws + WS_YC) + o + 16 * mt + 4 * fq));
            const f32x4 yw = unpack4(*(const u32x2*)((const bf16_t*)(ws + WS_YW) + o + 16 * mt + 4 * fq));
            if (VAR == 0 || VAR == 3) *(u32x2*)((bf16_t*)(ws + WS_YA) + o + 16 * mt + 4 * fq) = pack4(yc + yw + O[nt][mt] * gt);
            else asm volatile("" :: "v"(O[nt][mt]));
        }
    }
}

__device__ __forceinline__ void scan_item(const Params& p, int item, int half) {
    unsigned char* ws = launder(p.ws);
    const int idx = item * HT + (ltid() & 255);
    const int bh = idx >> 13, ed = idx & 8191, h = bh & 7;
    const float dec = exp2f(128.f * ret_lg2(h));
    const float* KVT = (const float*)(ws + WS_KVT) + (size_t)bh * 64 * 8192 + ed;
    bf16_t* SPT = (bf16_t*)(ws + WS_SPT) + (size_t)bh * 64 * 8192 + ed;
    float s = 0.f;
    for (int n = 0; n < 64; ++n) { SPT[(size_t)n * 8192] = f2bf(s); s = s * dec + KVT[(size_t)n * 8192]; }
}

__device__ __forceinline__ void phase_p3(const Params& p, unsigned char* lds, int half, int what) {
    for (int i = (ltid() & 255); i < 8192 / 16; i += HT) ((u32x4*)(lds + NSA_BUCKET))[i] = ((const u32x4*)(launder(p.ws) + WS_BUCKET))[i];
    __syncthreads();
    for (int h = (blockIdx.x * 2 + half); h < 512; h += (gridDim.x * 2)) {
        if (what & 1) cmp_item(p, h, lds, half);
        if (what & 2) {
            if (h >= 128 && h < 384) win_item(p, h - 128, lds, half);
            else if (h >= 384) { win_item(p, 256 + 2 * (h - 384) - ((h & 1) ? 1 : 0) , lds, half); win_item(p, 256 + 2 * (h - 384) + ((h & 1) ? 0 : 1) + 1 - ((h & 1) ? 0 : 0), lds, half); }
        }
        if (what & 4) scan_item(p, h, half);
    }
}

__device__ __forceinline__ void retout_item(const Params& p, int item, unsigned char* lds, int half) {
    unsigned char* ws = launder(p.ws);
    const int tid = (ltid() & 255), lane = tid & 63, wid = tid >> 6, fr = lane & 15, fq = lane >> 4;
    const int n = item & 63, h = (item >> 6) & 7, b = item >> 9;
    const size_t tok0 = (size_t)b * S_ + 128 * n;
    const bf16_t* P = (const bf16_t*)(ws + WS_P);
    unsigned char* vL = lds; unsigned char* kL = lds + 32768; unsigned char* sL = lds + 49152;
    __syncthreads();
    load_tile128w((const bf16_t*)(ws + WS_VRT) + ((size_t)(b * 8 + h) * 128) * S_ + 128 * n, S_, vL, wid, lane);
    load_tile128(P + tok0 * LD + C_KR + h * 64, LD, kL, wid, lane);
    load_tile128((const bf16_t*)(ws + WS_SPT) + ((size_t)(b * 8 + h) * 64 + n) * 8192, 64, sL, wid, lane);
    bf16x8 Qf[2][2];
#pragma unroll
    for (int nt = 0; nt < 2; ++nt)
#pragma unroll
        for (int ks = 0; ks < 2; ++ks) Qf[nt][ks] = *(const bf16x8*)(P + (tok0 + 32 * wid + 16 * nt + fr) * LD + C_QR + h * 64 + 32 * ks + 8 * fq);
    wait_vm0(); __syncthreads();
    const float lg2 = ret_lg2(h);
    f32x4 Y[8][2];
#pragma unroll
    for (int m = 0; m < 8; ++m)
#pragma unroll
        for (int nt = 0; nt < 2; ++nt) Y[m][nt] = (f32x4){0.f, 0.f, 0.f, 0.f};
#pragma unroll
    for (int m = 0; m < 8; ++m)
#pragma unroll
        for (int ks = 0; ks < 2; ++ks) {
            const bf16x8 a = lds_frag128(sL, 16 * m + fr, 4 * ks + fq);
#pragma unroll
            for (int nt = 0; nt < 2; ++nt) Y[m][nt] = mfma16(a, Qf[nt][ks], Y[m][nt]);
        }
#pragma unroll
    for (int nt = 0; nt < 2; ++nt) {
        const float sc = exp2f((float)(32 * wid + 16 * nt + fr + 1) * lg2);
#pragma unroll
        for (int m = 0; m < 8; ++m) Y[m][nt] = Y[m][nt] * sc;
    }
#pragma unroll 1
    for (int s = 0; s < 4; ++s) {
        f32x4 St[2][2];
#pragma unroll
        for (int hh = 0; hh < 2; ++hh) {
            const int mt = 2 * s + hh;
#pragma unroll
            for (int nt = 0; nt < 2; ++nt) St[hh][nt] = (f32x4){0.f, 0.f, 0.f, 0.f};
#pragma unroll
            for (int ks = 0; ks < 2; ++ks) {
                const bf16x8 a = lds_frag128(kL, 16 * mt + fr, 4 * ks + fq);
#pragma unroll
                for (int nt = 0; nt < 2; ++nt) St[hh][nt] = mfma16(a, Qf[nt][ks], St[hh][nt]);
            }
#pragma unroll
            for (int nt = 0; nt < 2; ++nt) {
                const int qi = 32 * wid + 16 * nt + fr;
#pragma unroll
                for (int r = 0; r < 4; ++r) {
                    const int kj = 16 * mt + 4 * fq + r;
                    const float dm = qi >= kj ? exp2f((float)(qi - kj) * lg2) : 0.f;
                    St[hh][nt][r] *= dm;
                }
            }
        }
        bf16x8 Pb[2];
#pragma unroll
        for (int nt = 0; nt < 2; ++nt) Pb[nt] = pack8(St[0][nt], St[1][nt]);
#pragma unroll
        for (int m = 0; m < 8; ++m) {
            const bf16x8 a = lds_vfrag256(vL, 16 * m + fr, 32 * s, fq);
#pragma unroll
            for (int nt = 0; nt < 2; ++nt) Y[m][nt] = mfma16(a, Pb[nt], Y[m][nt]);
        }
    }
    bf16_t* YB = (bf16_t*)(ws + WS_YB);
#pragma unroll
    for (int nt = 0; nt < 2; ++nt) {
        float sum = 0.f;
#pragma unroll
        for (int m = 0; m < 8; ++m) sum += Y[m][nt][0] + Y[m][nt][1] + Y[m][nt][2] + Y[m][nt][3];
        sum = rows_sum(sum);
        const float mu = sum * (1.f / 128.f);
        float vs = 0.f;
#pragma unroll
        for (int m = 0; m < 8; ++m)
#pragma unroll
            for (int r = 0; r < 4; ++r) { const float dlt = Y[m][nt][r] - mu; vs += dlt * dlt; }
        vs = rows_sum(vs);
        const float rstd = rsqrtf(vs * (1.f / 128.f) + 1e-5f);
        const size_t tk = tok0 + 32 * wid + 16 * nt + fr;
#pragma unroll
        for (int m = 0; m < 8; ++m) {
            const f32x4 gt = unpack4(*(const u32x2*)(P + tk * LD + C_GR + h * 128 + 16 * m + 4 * fq));
            f32x4 v;
#pragma unroll
            for (int r = 0; r < 4; ++r) v[r] = (Y[m][nt][r] - mu) * rstd * gt[r];
            *(u32x2*)(YB + tk * 1024 + h * 128 + 16 * m + 4 * fq) = pack4(v);
        }
    }
}
__device__ __forceinline__ void phase_p4_sel(const Params& p, unsigned char* lds) {
    for (int i = ltid(); i < 8192 / 16; i += NTHREADS) ((u32x4*)(lds + SEL_BUCKET))[i] = ((const u32x4*)(launder(p.ws) + WS_BUCKET))[i];
    __syncthreads();
    for (int it = blockIdx.x; it < 512; it += gridDim.x * 2) {
        sel_item<0>(p, it, lds);
        if (511 - it != it) sel_item<0>(p, 511 - it, lds);
    }
    __syncthreads();
}
__device__ __forceinline__ void phase_p4(const Params& p, unsigned char* lds, int half) {
    for (int it = (blockIdx.x * 2 + half); it < 1024; it += (gridDim.x * 2)) retout_item(p, it, lds, half);
}

struct RowOrder {     typedef pg8::Unit U; static constexpr bool GATHER = false;
    unsigned a, b; int K, xcd, slot, per;
    __device__ __forceinline__ bool next(int i, pg8::Unit& u) const { const int t = xcd * 32 + slot + i * per; if (t >= (xcd + 1) * 32) return false; u.pm = t >> 2; u.pn = t & 3; return true; }
    __device__ __forceinline__ void ptrs(const pg8::Unit& u, unsigned& A, unsigned& B) const { A = a + (unsigned)u.pm * 512u * (unsigned)K; B = b + (unsigned)u.pn * 512u * (unsigned)K; }
};
template <int MODE>
struct MixEpi {
    unsigned char* ws; const float* X;
    __device__ __forceinline__ void operator()(const f32x4 (&acc)[2][2][4][2], const pg8::Unit& u, int wr, int wc, int fr, int fq) const {
#pragma unroll
        for (int ai = 0; ai < 2; ++ai)
#pragma unroll
            for (int m = 0; m < 4; ++m) {
                const size_t tok = (size_t)(u.pm * 256 + 128 * ai + 64 * wr + 16 * m + fr + vzero());
#pragma unroll
                for (int bj = 0; bj < 2; ++bj) {
                    const int n = u.pn * 256 + 128 * bj + 32 * wc + 8 * fq;
                    const f32x4 v0 = acc[ai][bj][m][0], v1 = acc[ai][bj][m][1];
                    if (MODE == 2) {
                        const u32x4 xw = *(const u32x4*)((const bf16_t*)(ws + WS_XB) + tok * 1024 + n);
                        const f32x4 h0 = unpack4((u32x2){xw.x, xw.y}) * DN_ALPHA + v0, h1 = unpack4((u32x2){xw.z, xw.w}) * DN_ALPHA + v1;
                        u32x4 w; w.x = pack2(h0[0], h0[1]); w.y = pack2(h0[2], h0[3]); w.z = pack2(h1[0], h1[1]); w.w = pack2(h1[2], h1[3]);
                        *(u32x4*)((bf16_t*)(ws + WS_H1) + tok * 1024 + n) = w;
                    } else {
                        const u32x4 gw = *(const u32x4*)((const bf16_t*)(ws + WS_P) + tok * LD + (MODE == 0 ? C_MA : C_MB) + n);
                        const f32x4 g0 = unpack4((u32x2){gw.x, gw.y}), g1 = unpack4((u32x2){gw.z, gw.w});
                        f32x4 o0 = g0 * v0, o1 = g1 * v1;
                        bf16_t* MG = (bf16_t*)(ws + WS_MG) + tok * 1024 + n;
                        if (MODE == 1) { const u32x4 pw = *(const u32x4*)MG; o0 = o0 + unpack4((u32x2){pw.x, pw.y}); o1 = o1 + unpack4((u32x2){pw.z, pw.w}); }
                        u32x4 w; w.x = pack2(o0[0], o0[1]); w.y = pack2(o0[2], o0[3]); w.z = pack2(o1[0], o1[1]); w.w = pack2(o1[2], o1[3]);
                        *(u32x4*)MG = w;
                    }
                }
            }
    }
};
__device__ __forceinline__ void phase_g2(const Params& p, unsigned char* lds) {
    unsigned char* ws = launder(p.ws);
    RowOrder S; S.xcd = blockIdx.x & 7; S.slot = blockIdx.x >> 3; S.per = gridDim.x >> 3;
    { S.a = (unsigned)WS_YA; S.b = (unsigned)WS_WA; S.K = 512; MixEpi<0> E; E.ws = ws; E.X = nullptr; pg8::gemm_phase<MixEpi<0>, RowOrder>(lds, 512, S, E, ltid(), ws); }
    { S.a = (unsigned)WS_YB; S.b = (unsigned)WS_WB; S.K = 1024; MixEpi<1> E; E.ws = ws; E.X = nullptr; pg8::gemm_phase<MixEpi<1>, RowOrder>(lds, 1024, S, E, ltid(), ws); }
}
__device__ __forceinline__ void phase_g3(const Params& p, int layer, unsigned char* lds) {
    unsigned char* ws = launder(p.ws);
    RowOrder S; S.xcd = blockIdx.x & 7; S.slot = blockIdx.x >> 3; S.per = gridDim.x >> 3; S.a = (unsigned)WS_MG; S.b = (unsigned)WS_WO; S.K = 1024;
    MixEpi<2> E; E.ws = ws; E.X = nullptr;
    pg8::gemm_phase<MixEpi<2>, RowOrder>(lds, 1024, S, E, ltid(), ws);
}

__device__ __forceinline__ void phase_ln1(const Params& p, int layer, unsigned char* lds, bool dry, int half) {
    unsigned char* ws = launder(p.ws);
    const int tid = (ltid() & 255), lane = tid & 63, wid = tid >> 6;
    float* wrL = (float*)lds;
    {
        float4 wv[16];
#pragma unroll
        for (int k = 0; k < 16; ++k) wv[k] = ((const float4*)p.w_router)[tid + 256 * k];
#pragma unroll
        for (int k = 0; k < 16; ++k) { const int i4 = tid + 256 * k, d = i4 >> 2, e0 = (i4 & 3) * 4;
            wrL[(e0 + 0) * 1024 + d] = wv[k].x; wrL[(e0 + 1) * 1024 + d] = wv[k].y; wrL[(e0 + 2) * 1024 + d] = wv[k].z; wrL[(e0 + 3) * 1024 + d] = wv[k].w; }
    }
    __syncthreads();
    const bf16_t* H1 = (const bf16_t*)(ws + WS_H1);
    bf16_t* X1B = (bf16_t*)(ws + WS_X1B);
    const float* gam = p.ln1_g + layer * 1024; const float* bet = p.ln1_b + layer * 1024;
    unsigned* cnt = (unsigned*)(ws + WS_CTL) + (dry ? 0 : CW_CNT) + layer * 1024;
    int* LIST = (int*)(ws + (dry ? WS_HB : WS_LIST)); float* WTS = (float*)(ws + (dry ? WS_HB + 4194304 : WS_WTS));
    const int tstep = (gridDim.x * 2) * 4;
    u32x2 vn[4];
    { const int tok0 = (blockIdx.x * 2 + half) * 4 + wid;
#pragma unroll
      for (int j = 0; j < 4; ++j) vn[j] = *(const u32x2*)(H1 + (size_t)tok0 * 1024 + 256 * j + 4 * lane); }
    for (int tok = (blockIdx.x * 2 + half) * 4 + wid; tok < T_; tok += tstep) {
        float4 v[4];
#pragma unroll
        for (int j = 0; j < 4; ++j) { const f32x4 t = unpack4(vn[j]); v[j].x = t[0]; v[j].y = t[1]; v[j].z = t[2]; v[j].w = t[3]; }
        { const int tn = tok + tstep < T_ ? tok + tstep : tok;
#pragma unroll
          for (int j = 0; j < 4; ++j) vn[j] = *(const u32x2*)(H1 + (size_t)tn * 1024 + 256 * j + 4 * lane); }
        float s = 0.f;
#pragma unroll
        for (int j = 0; j < 4; ++j) s += v[j].x + v[j].y + v[j].z + v[j].w;
        s = wave_sum(s);
        const float mu = s * (1.f / 1024.f);
        float q = 0.f;
#pragma unroll
        for (int j = 0; j < 4; ++j) { const float a = v[j].x - mu, b2 = v[j].y - mu, c = v[j].z - mu, d = v[j].w - mu; q += a * a + b2 * b2 + c * c + d * d; }
        q = wave_sum(q);
        const float rstd = rsqrtf(q * (1.f / 1024.f) + 1e-5f);
        float4 y[4];
#pragma unroll
        for (int j = 0; j < 4; ++j) {
            const int d0 = 256 * j + 4 * lane;
            const float4 gg = *(const float4*)(gam + d0), bb = *(const float4*)(bet + d0);
            y[j].x = (v[j].x - mu) * rstd * gg.x + bb.x; y[j].y = (v[j].y - mu) * rstd * gg.y + bb.y; y[j].z = (v[j].z - mu) * rstd * gg.z + bb.z; y[j].w = (v[j].w - mu) * rstd * gg.w + bb.w;
            u32x2 w; w.x = pack2(y[j].x, y[j].y); w.y = pack2(y[j].z, y[j].w);
            *(u32x2*)(X1B + (size_t)tok * 1024 + d0) = w;
        }
        float lg[16];
#pragma unroll
        for (int e = 0; e < 16; ++e) {
            float a = 0.f;
#pragma unroll
            for (int j = 0; j < 4; ++j) { const float4 w4 = *(const float4*)(wrL + e * 1024 + 256 * j + 4 * lane); a += y[j].x * w4.x + y[j].y * w4.y + y[j].z * w4.z + y[j].w * w4.w; }
            lg[e] = a;
        }
#pragma unroll
        for (int e = 0; e < 16; ++e) {
            lg[e] = wave_sum(lg[e]);
        }
        float mx = lg[0];
#pragma unroll
        for (int e = 1; e < 16; ++e) mx = fmaxf(mx, lg[e]);
        float pr[16], ps = 0.f;
#pragma unroll
        for (int e = 0; e < 16; ++e) { pr[e] = expf(lg[e] - mx); ps += pr[e]; }
        const float ips = 1.f / ps;
        float sel[16];
#pragma unroll
        for (int e = 0; e < 16; ++e) { pr[e] *= ips; sel[e] = pr[e] + p.router_bias[e]; }
        int best = 0; float bestv = -1e30f;
#pragma unroll
        for (int gI = 0; gI < 4; ++gI) {
            float a = -1e30f, b2 = -1e30f;
#pragma unroll
            for (int k = 0; k < 4; ++k) { const float x = sel[4 * gI + k]; if (x > a) { b2 = a; a = x; } else if (x > b2) b2 = x; }
            const float gs = a + b2;
            if (gs > bestv) { bestv = gs; best = gI; }
        }
        float s4[4], p4[4];
#pragma unroll
        for (int k = 0; k < 4; ++k) { s4[k] = 0.f; p4[k] = 0.f; }
#pragma unroll
        for (int gI = 0; gI < 4; ++gI) if (gI == best) {
#pragma unroll
            for (int k = 0; k < 4; ++k) { s4[k] = sel[4 * gI + k]; p4[k] = pr[4 * gI + k]; }
        }
        int i0 = 0; float a0 = s4[0];
#pragma unroll
        for (int k = 1; k < 4; ++k) if (s4[k] > a0) { a0 = s4[k]; i0 = k; }
        int i1 = -1; float a1 = -1e30f;
#pragma unroll
        for (int k = 0; k < 4; ++k) if (k != i0 && s4[k] > a1) { a1 = s4[k]; i1 = k; }
        float w0 = 0.f, w1 = 0.f;
#pragma unroll
        for (int k = 0; k < 4; ++k) { if (k == i0) w0 = p4[k]; if (k == i1) w1 = p4[k]; }
        const float iw = 1.f / (w0 + w1);
        if (lane == 0) {
            const int e0 = best * 4 + i0, e1 = best * 4 + i1;
            const unsigned p0 = atomicAdd(&cnt[e0 * 64], 1u), p1 = atomicAdd(&cnt[e1 * 64], 1u);
            LIST[(size_t)e0 * T_ + p0] = tok * 2; LIST[(size_t)e1 * T_ + p1] = tok * 2 + 1;
            WTS[tok * 2] = w0 * iw; WTS[tok * 2 + 1] = w1 * iw;
        }
    }
}

struct MoeUnit { int e, rt, ct, cnt, off; };
struct MoeOrderBase {
    const unsigned* cntp; int t_lo, t_hi, slot, per;
    __device__ __forceinline__ void init(const unsigned* cnt) {
        cntp = cnt; int ntile = 0;
#pragma unroll
        for (int k = 0; k < NE; ++k) ntile += ((__builtin_amdgcn_readfirstlane((int)cnt[k * 64]) + 255) >> 8) * 4;
        t_lo = (ntile * (int)(blockIdx.x & 7)) >> 3; t_hi = (ntile * (int)((blockIdx.x & 7) + 1)) >> 3; slot = blockIdx.x >> 3; per = gridDim.x >> 3;
    }
    __device__ __forceinline__ bool next(int i, MoeUnit& u) const {
        const int t = t_lo + slot + i * per; if (t >= t_hi) return false;
        int base = 0, off = 0; bool found = false;
#pragma unroll
        for (int k = 0; k < NE; ++k) {
            const int ck = __builtin_amdgcn_readfirstlane((int)cntp[k * 64]), nt = ((ck + 255) >> 8) * 4;
            if (!found && t < base + nt) { found = true; u.e = k; u.cnt = ck; u.off = off; u.rt = (t - base) >> 2; u.ct = (t - base) & 3; }
            base += nt; off += ck;
        }
        return found;
    }
};
struct M2Order : MoeOrderBase {
    typedef MoeUnit U; static constexpr bool GATHER = true;
    const int* list;
    __device__ __forceinline__ void ptrs(const MoeUnit& u, unsigned& A, unsigned& B) const { A = (unsigned)WS_X1B; B = (unsigned)WS_WG + ((unsigned)u.e * 1024u + (unsigned)u.ct * 256u) * 2048u; }
    __device__ __forceinline__ void rows(const MoeUnit& u, int tid, unsigned (&v)[2][2]) const {
#pragma unroll
        for (int i = 0; i < 2; ++i) { int R, C; pg8::stage_rc((tid + vzero()) * 16 + i * 8192, R, C);
#pragma unroll
            for (int h = 0; h < 2; ++h) { int idx = u.rt * 256 + 128 * h + R; idx = idx < u.cnt ? idx : u.cnt - 1; const int a = (list + (size_t)u.e * T_)[idx]; v[h][i] = ((unsigned)(a >> 1) << 11) + (unsigned)C * 2u; } }
    }
};
struct M3Order : MoeOrderBase {
    typedef MoeUnit U; static constexpr bool GATHER = false;
    __device__ __forceinline__ void ptrs(const MoeUnit& u, unsigned& A, unsigned& B) const { A = (unsigned)WS_HB + ((unsigned)u.off + (unsigned)u.rt * 256u) * 1024u; B = (unsigned)WS_WD + ((unsigned)u.e * 1024u + (unsigned)u.ct * 256u) * 1024u; }
};
struct M2Epi {
    unsigned char* ws;
    __device__ __forceinline__ void operator()(const f32x4 (&acc)[2][2][4][2], const MoeUnit& u, int wr, int wc, int fr, int fq) const {
        bf16_t* HB = (bf16_t*)(ws + WS_HB);
#pragma unroll
        for (int ai = 0; ai < 2; ++ai)
#pragma unroll
            for (int m = 0; m < 4; ++m) {
                const int idx = u.rt * 256 + 128 * ai + 64 * wr + 16 * m + fr + vzero();
                if (idx < u.cnt) {
#pragma unroll
                    for (int bj = 0; bj < 2; ++bj) {
                        const int hcol = 4 * (32 * u.ct + 16 * bj + 4 * wc + fq);
                        const f32x4 gv = acc[ai][bj][m][0], uv = acc[ai][bj][m][1]; f32x4 hv;
#pragma unroll
                        for (int r = 0; r < 4; ++r) hv[r] = gv[r] * fsig(gv[r]) * uv[r];
                        *(u32x2*)(HB + (size_t)(u.off + idx) * 512 + hcol) = pack4(hv);
                    }
                }
            }
    }
};
struct M3Epi {
    unsigned char* ws; const int* list;
    __device__ __forceinline__ void operator()(const f32x4 (&acc)[2][2][4][2], const MoeUnit& u, int wr, int wc, int fr, int fq) const {
        bf16_t* CT = (bf16_t*)(ws + WS_CT);
#pragma unroll
        for (int ai = 0; ai < 2; ++ai)
#pragma unroll
            for (int m = 0; m < 4; ++m) {
                const int idx = u.rt * 256 + 128 * ai + 64 * wr + 16 * m + fr + vzero();
                if (idx < u.cnt) {
                    const int a = list[(size_t)u.e * T_ + idx];
#pragma unroll
                    for (int bj = 0; bj < 2; ++bj) {
                        const int n = u.ct * 256 + 128 * bj + 32 * wc + 8 * fq;
                        const f32x4 v0 = acc[ai][bj][m][0], v1 = acc[ai][bj][m][1];
                        u32x4 w; w.x = pack2(v0[0], v0[1]); w.y = pack2(v0[2], v0[3]); w.z = pack2(v1[0], v1[1]); w.w = pack2(v1[2], v1[3]);
                        *(u32x4*)(CT + (size_t)a * 1024 + n) = w;
                    }
                }
            }
    }
};
__device__ __forceinline__ void phase_m2(const Params& p, int layer, unsigned char* lds) {
    unsigned char* ws = launder(p.ws);
    M2Order S; S.init((const unsigned*)(ws + WS_CTL) + CW_CNT + layer * 1024 + vzero());
    S.list = (const int*)(ws + WS_LIST);
    M2Epi E; E.ws = ws;
    pg8::gemm_phase<M2Epi, M2Order>(lds, 1024, S, E, ltid(), ws);
}
__device__ __forceinline__ void phase_m3(const Params& p, int layer, unsigned char* lds) {
    unsigned char* ws = launder(p.ws);
    M3Order S; S.init((const unsigned*)(ws + WS_CTL) + CW_CNT + layer * 1024 + vzero());
    M3Epi E; E.ws = ws; E.list = (const int*)(ws + WS_LIST);
    pg8::gemm_phase<M3Epi, M3Order>(lds, 512, S, E, ltid(), ws);
}

__device__ __forceinline__ void phase_ln2(const Params& p, int layer, int half) {
    unsigned char* ws = launder(p.ws);
    const int tid = (ltid() & 255), lane = tid & 63, wid = tid >> 6;
    const bf16_t* X1 = (const bf16_t*)(ws + WS_X1B); const bf16_t* CT = (const bf16_t*)(ws + WS_CT); const float* WTS = (const float*)(ws + WS_WTS);
    float* XO = p.out; bf16_t* XB = (bf16_t*)(ws + WS_XB); const bool fin = layer == NLAYER - 1;
    const float* gam = p.ln2_g + layer * 1024; const float* bet = p.ln2_b + layer * 1024;
    constexpr int U = 4;
    const int nwave = (gridDim.x * 2) * 4, wv = (blockIdx.x * 2 + half) * 4 + wid;
    for (int t0 = wv * U; t0 < T_; t0 += nwave * U) {
        float4 v[U][4]; float s[U], q[U];
#pragma unroll
        for (int u = 0; u < U; ++u) {
            const int tok = t0 + u;
            const float w0 = WTS[tok * 2 + vzero()], w1 = WTS[tok * 2 + 1 + vzero()];
            s[u] = 0.f; q[u] = 0.f;
#pragma unroll
            for (int j = 0; j < 4; ++j) {
                const int d0 = 256 * j + 4 * lane;
                const f32x4 xt = unpack4(*(const u32x2*)(X1 + (size_t)tok * 1024 + d0)); float4 xv; xv.x = xt[0]; xv.y = xt[1]; xv.z = xt[2]; xv.w = xt[3];
                const f32x4 c0 = unpack4(*(const u32x2*)(CT + (size_t)(tok * 2) * 1024 + d0)), c1 = unpack4(*(const u32x2*)(CT + (size_t)(tok * 2 + 1) * 1024 + d0));
                v[u][j].x = xv.x * DN_ALPHA + w0 * c0[0] + w1 * c1[0]; v[u][j].y = xv.y * DN_ALPHA + w0 * c0[1] + w1 * c1[1];
                v[u][j].z = xv.z * DN_ALPHA + w0 * c0[2] + w1 * c1[2]; v[u][j].w = xv.w * DN_ALPHA + w0 * c0[3] + w1 * c1[3];
                s[u] += v[u][j].x + v[u][j].y + v[u][j].z + v[u][j].w;
                q[u] += v[u][j].x * v[u][j].x + v[u][j].y * v[u][j].y + v[u][j].z * v[u][j].z + v[u][j].w * v[u][j].w;
            }
        }
#pragma unroll
        for (int u = 0; u < U; ++u) { s[u] = wave_sum(s[u]); q[u] = wave_sum(q[u]); }
#pragma unroll
        for (int j = 0; j < 4; ++j) {
            const int d0 = 256 * j + 4 * lane;
            const float4 gg = *(const float4*)(gam + d0), bb = *(const float4*)(bet + d0);
#pragma unroll
            for (int u = 0; u < U; ++u) {
                const int tok = t0 + u;
                const float mu = s[u] * (1.f / 1024.f), var = fmaxf(q[u] * (1.f / 1024.f) - mu * mu, 0.f), rstd = rsqrtf(var + 1e-5f);
                float4 y; y.x = (v[u][j].x - mu) * rstd * gg.x + bb.x; y.y = (v[u][j].y - mu) * rstd * gg.y + bb.y; y.z = (v[u][j].z - mu) * rstd * gg.z + bb.z; y.w = (v[u][j].w - mu) * rstd * gg.w + bb.w;
                if (fin) *(float4*)(XO + (size_t)tok * 1024 + d0) = y;
                else { u32x2 w; w.x = pack2(y.x, y.y); w.y = pack2(y.z, y.w); *(u32x2*)(XB + (size_t)tok * 1024 + d0) = w; }
            }
        }
    }
}

#define XB_TMO      128
#define XB_XCNT(j)  (256  + 64 * (j))
#define XB_XSUB(j)  (1280 + 64 * (j))
#define XB_XGEN(j)  (2304 + 64 * (j))
#define XB_TOP      3328
#define XB_TOPGEN   3392
#define XCD_BAR_WORDS 3456
#define XB_SPIN_CAP (1u << 22)
#define LAS __attribute__((address_space(3)))
__device__ __forceinline__ unsigned xb_ld(unsigned* p)              { return __hip_atomic_load(p, __ATOMIC_RELAXED, __HIP_MEMORY_SCOPE_AGENT); }
__device__ __forceinline__ unsigned xb_add(unsigned* p, unsigned v) { return __hip_atomic_fetch_add(p, v, __ATOMIC_RELAXED, __HIP_MEMORY_SCOPE_AGENT); }
__device__ __forceinline__ unsigned xb_xcc_id() { return (unsigned)__builtin_amdgcn_s_getreg((3 << 11) | 20) & 0xFu; }
#define XB_SPIN(cond, bar) do { unsigned _sp = 0; while (cond) { __builtin_amdgcn_s_sleep(1); \
    if ((++_sp & 255u) == 0u) { if (xb_ld(&(bar)[XB_TMO])) break; if (_sp > XB_SPIN_CAP) { atomicAdd(&(bar)[XB_TMO], 1u); break; } } } } while (0)
struct XcdBarrier { unsigned* bar; unsigned x; volatile LAS unsigned* st; };
__device__ __forceinline__ XcdBarrier xcd_barrier_post(unsigned* bar, volatile LAS unsigned* st) {
    XcdBarrier b; b.bar = bar; b.x = xb_xcc_id(); b.st = st;
    if (threadIdx.x == 0) (void)xb_add(&bar[XB_XCNT(b.x)], 1u);
    return b;
}
__device__ __forceinline__ void xcd_barrier_complete(unsigned* bar, unsigned x, unsigned& nloc, unsigned& nx) {
    const unsigned G = gridDim.x * gridDim.y * gridDim.z;
    unsigned sum, cnt, mine, sp = 0u;
    for (;;) {
        sum = 0u; cnt = 0u; mine = 0u;
#pragma unroll
        for (unsigned j = 0; j < 16; ++j) { const unsigned c = xb_ld(&bar[XB_XCNT(j)]); sum += c; cnt += (c > 0u) ? 1u : 0u; mine = (j == x) ? c : mine; }
        if (sum == G) break;
        __builtin_amdgcn_s_sleep(1);
        if ((++sp & 255u) == 0u) { if (xb_ld(&bar[XB_TMO])) break; if (sp > XB_SPIN_CAP) { atomicAdd(&bar[XB_TMO], 1u); break; } }
    }
    nloc = mine > 0u ? mine : 1u; nx = cnt > 0u ? cnt : 1u;
}
__device__ __forceinline__ void xcd_barrier(const XcdBarrier& b) {
    asm volatile("s_waitcnt vmcnt(0)" ::: "memory");
    __syncthreads();
    if (threadIdx.x == 0) {
        unsigned* bar = b.bar;
        __builtin_amdgcn_s_waitcnt(0);
        unsigned nloc = b.st[0], nx = b.st[1];
        if (nloc == 0u) { xcd_barrier_complete(bar, b.x, nloc, nx); b.st[0] = nloc; b.st[1] = nx; }
        const unsigned old = xb_add(&bar[XB_XSUB(b.x)], 1u);
        const unsigned gen = old / nloc;
        if (old + 1u == (gen + 1u) * nloc) {
            __builtin_amdgcn_fence(__ATOMIC_RELEASE, "agent");
            asm volatile("s_waitcnt vmcnt(0)" ::: "memory");
            const unsigned og = xb_add(&bar[XB_TOP], 1u);
            const unsigned tg = og / nx;
            if (og + 1u == (tg + 1u) * nx) xb_add(&bar[XB_TOPGEN], 1u);
            else XB_SPIN(xb_ld(&bar[XB_TOPGEN]) == tg, bar);
            __builtin_amdgcn_fence(__ATOMIC_ACQUIRE, "agent");
            xb_add(&bar[XB_XGEN(b.x)], 1u);
            asm volatile("s_waitcnt vmcnt(0)" ::: "memory");
        } else {
            XB_SPIN(xb_ld(&bar[XB_XGEN(b.x)]) == gen, bar);
            __builtin_amdgcn_fence(__ATOMIC_ACQUIRE, "agent");
            asm volatile("s_waitcnt vmcnt(0)" ::: "memory");
        }
    }
    __syncthreads();
}

constexpr int PH_PER_LAYER = 11, N_PHASES = PH_PER_LAYER * NLAYER;
__global__ void __launch_bounds__(NTHREADS, 2) mega(Params p) {
    extern __shared__ __attribute__((aligned(16))) unsigned char lds[];
#if SINGLE_LAUNCH
    volatile LAS unsigned* xbw = (volatile LAS unsigned*)(lds + LDS_BYTES - 16);
    if (threadIdx.x < 4) xbw[threadIdx.x] = 0u;
    __syncthreads();
    XcdBarrier xbar = xcd_barrier_post((unsigned*)(p.ws + WS_CTL) + CW_BAR, xbw);
#endif
    const int half = __builtin_amdgcn_readfirstlane((int)(threadIdx.x >> 8));
    unsigned char* ldsh = lds + half * HALF_LDS;
    bool second = false;
    for (int ph = p.ph_lo; ph < p.ph_hi; ++ph) {
        const int layer = ph / PH_PER_LAYER, k = ph % PH_PER_LAYER;
        if (k == 0 && layer > 0) continue;
#ifdef ONLY_PHASE
        if (k != ONLY_PHASE) continue;
#endif
        switch (k) {
            case 0: phase_pw(p, layer, ldsh, 1 | 16 | 8, half); break;
            case 1: phase_g1(p, layer, lds); break;
            case 2: phase_p2(p, layer, ldsh, half); if (!second && layer + 1 < NLAYER) { __syncthreads(); phase_pw(p, layer + 1, ldsh, 1, half, 32); } break;
            case 3: phase_p3(p, ldsh, half, second ? ((p.rep_mask >> 16) & 7) : 7); if (!second && layer + 1 < NLAYER) { __syncthreads(); phase_pw(p, layer + 1, ldsh, 16, half); }
                    if (!second && layer == 0) { __syncthreads(); phase_pw(p, 0, ldsh, 2, half); } break;
            case 4: { const int sub = second ? ((p.rep_mask >> 12) & 7) : 7;
                    if (sub & 1) phase_p4_sel(p, lds);
                    if ((sub & 4) && half == 0) { phase_pw(p, layer, ldsh, 4, half); __syncthreads(); }
                    if (sub & 2) phase_p4(p, ldsh, half);
                    if ((sub & 4) && half == 1) { __syncthreads(); phase_pw(p, layer, ldsh, 4, half); } } break;
            case 5: phase_g2(p, lds); break;
            case 6: phase_g3(p, layer, lds); break;
            case 7: phase_ln1(p, layer, ldsh, ((p.rep_mask >> 7) & 1) && !second, half); if (!second && layer + 1 < NLAYER) { __syncthreads(); phase_pw(p, layer + 1, ldsh, 2, half); } break;
            case 8: phase_m2(p, layer, lds); break;
            case 9: phase_m3(p, layer, lds); break;
            case 10: phase_ln2(p, layer, half); break;
        }

        if (ph + 1 < p.ph_hi) { if (ph == p.ph_lo && !second) cg::this_grid().sync(); else xcd_barrier(xbar); }
        if (((p.rep_mask >> k) & 1) && !second) { second = true; --ph; } else second = false;
    }
}

extern "C" void kernel_launch(void* const* d_in, const int* in_sizes, int n_in, void* d_out, int out_size, void* d_ws, size_t ws_size, hipStream_t stream) {
    static int grid = 0;
    if (grid == 0) {
        if (n_in != 18 || ws_size < WS_END) { fprintf(stderr, "kernel_launch: unexpected n_in %d or ws_size %zu < %zu\n", n_in, ws_size, (size_t)WS_END); grid = -1; return; }
        int dev = 0, cus = 0, per_cu = 0;
        hipGetDevice(&dev); hipDeviceGetAttribute(&cus, hipDeviceAttributeMultiprocessorCount, dev);
        hipFuncSetAttribute((const void*)mega, hipFuncAttributeMaxDynamicSharedMemorySize, LDS_BYTES);
        hipOccupancyMaxActiveBlocksPerMultiprocessor(&per_cu, (const void*)mega, NTHREADS, LDS_BYTES);
        if (per_cu < 1) per_cu = 1;
        if (per_cu > 1) per_cu = 1;
        grid = cus * per_cu;
        (void)hipGetLastError();
    }
    if (grid < 0) return;
    Params p{};
    p.x = (const float*)d_in[0]; p.w_in = (const float*)d_in[1]; p.cmp_pos = (const float*)d_in[2]; p.cmp_w1 = (const float*)d_in[3]; p.cmp_w2 = (const float*)d_in[4];
    p.w_br_a = (const float*)d_in[5]; p.w_br_b = (const float*)d_in[6]; p.w_o = (const float*)d_in[7]; p.ln1_g = (const float*)d_in[8]; p.ln1_b = (const float*)d_in[9];
    p.w_router = (const float*)d_in[10]; p.router_bias = (const float*)d_in[11]; p.w_gate = (const float*)d_in[12]; p.w_up = (const float*)d_in[13]; p.w_down = (const float*)d_in[14];
    p.ln2_g = (const float*)d_in[15]; p.ln2_b = (const float*)d_in[16]; p.rel_bias = (const float*)d_in[17];
    p.out = (float*)d_out; p.ws = (unsigned char*)d_ws; p.rep_mask = REPEAT_MASK;
#if SINGLE_LAUNCH
    hipMemsetAsync((unsigned char*)d_ws + WS_CTL + (size_t)CW_BAR * 4, 0, XCD_BAR_WORDS * 4, stream);
    p.ph_lo = 0; p.ph_hi = N_PHASES;
    void* args[] = {&p};
    hipError_t e = hipLaunchCooperativeKernel((const void*)mega, dim3(grid), dim3(NTHREADS), args, LDS_BYTES, stream);
    if (e != hipSuccess) fprintf(stderr, "cooperative launch failed: %s (grid %d)\n", hipGetErrorString(e), grid);
#else
    for (int ph = 0; ph < N_PHASES; ++ph) {
        p.ph_lo = ph; p.ph_hi = ph + 1;
        hipLaunchKernelGGL(mega, dim3(grid), dim3(NTHREADS), LDS_BYTES, stream, p);
    }
#endif
}
```

```cpp
#include <hip/hip_runtime.h>
#include <hip/hip_cooperative_groups.h>
#include <cstdio>
#include <cstdint>
namespace cg = cooperative_groups;

#ifndef REPEAT_MASK
#define REPEAT_MASK 0
#endif
#ifndef SINGLE_LAUNCH
#define SINGLE_LAUNCH 1
#endif

typedef unsigned short bf16_t;
typedef short bf16x8 __attribute__((ext_vector_type(8)));
typedef float f32x4 __attribute__((ext_vector_type(4)));
typedef unsigned u32x2 __attribute__((ext_vector_type(2)));
typedef unsigned u32x4 __attribute__((ext_vector_type(4)));

constexpr int B_ = 2, S_ = 8192, D_ = 1024, T_ = B_ * S_, NLAYER = 4;
constexpr int DIN = 6424;
constexpr int LD = 5376;
constexpr int NW = 6656;
constexpr int C_QA = 0, C_KC = 512, C_VC = 640, C_KS = 768, C_KW = 896, C_QR = 1024, C_KR = 1536, C_GR = 2048, C_MA = 3072, C_MB = 4096, C_GA = 5120,
              C_VS = 5376, C_VW = 5504, C_VR = 5632;
constexpr float DN_ALPHA = 1.681792830507429f;
constexpr int NE = 16;

constexpr size_t al256(size_t x) { return (x + 255) & ~(size_t)255; }
constexpr size_t WS_CTL = 0;
constexpr size_t WS_BUCKET = 65536;
constexpr size_t WS_ROPE = WS_BUCKET + 8192;
constexpr size_t WS_WIN = WS_ROPE + (size_t)8192 * 32 * 8;
constexpr size_t WS_WA = WS_WIN + (size_t)NW * 1024 * 2;
constexpr size_t WS_WB = WS_WA + (size_t)1024 * 512 * 2;
constexpr size_t WS_WO = WS_WB + (size_t)1024 * 1024 * 2;
constexpr size_t WS_WG = WS_WO + (size_t)1024 * 1024 * 2;
constexpr size_t WS_WU = WS_WG + (size_t)16 * 512 * 1024 * 2;
constexpr size_t WS_WD = WS_WU + (size_t)16 * 512 * 1024 * 2;
constexpr size_t WS_XB = WS_WD + (size_t)16 * 512 * 1024 * 2;
constexpr size_t WS_X = WS_XB + (size_t)T_ * 1024 * 2;
constexpr size_t WS_MG = WS_X + (size_t)T_ * 1024 * 4;
constexpr size_t WS_KCC = WS_MG + (size_t)T_ * 1024 * 2;
constexpr size_t WS_VCCT = WS_KCC + (size_t)4 * 512 * 64 * 2;
constexpr size_t WS_W1T = WS_VCCT + (size_t)4 * 512 * 64 * 2;
constexpr size_t WS_B1 = WS_W1T + (size_t)2 * 64 * 2048 * 2;
constexpr size_t WS_R = WS_B1 + 1024;
constexpr size_t WS_P = WS_R;
constexpr size_t WS_VST = WS_P + (size_t)T_ * LD * 2;
constexpr size_t WS_VWT = WS_VST + (size_t)4 * 64 * S_ * 2;
constexpr size_t WS_VRT = WS_VWT + (size_t)4 * 64 * S_ * 2;
constexpr size_t WS_KVT = WS_VRT + (size_t)16 * 128 * S_ * 2;
constexpr size_t WS_SPT = WS_KVT + (size_t)16 * 64 * 8192 * 4;
constexpr size_t WS_YC = WS_SPT + (size_t)16 * 64 * 8192 * 2;
constexpr size_t WS_YW = WS_YC + (size_t)T_ * 512 * 2;
constexpr size_t WS_YA = WS_YW + (size_t)T_ * 512 * 2;
constexpr size_t WS_YB = WS_YA + (size_t)T_ * 512 * 2;
constexpr size_t WS_SELW = WS_YB + (size_t)T_ * 1024 * 2;
constexpr size_t WS_ENDA = WS_SELW + (size_t)T_ * 2 * 4 * 4;
constexpr size_t WS_H1 = WS_R;
constexpr size_t WS_X1 = WS_H1 + (size_t)T_ * 1024 * 4;
constexpr size_t WS_X1B = WS_X1 + (size_t)T_ * 1024 * 4;
constexpr size_t WS_HB = WS_X1B + (size_t)T_ * 1024 * 2;
constexpr size_t WS_CT = WS_HB + (size_t)2 * T_ * 512 * 2;
constexpr size_t WS_LIST = WS_CT + (size_t)2 * T_ * 1024 * 2;
constexpr size_t WS_WTS = WS_LIST + (size_t)16 * T_ * 4;
constexpr size_t WS_ENDB = WS_WTS + (size_t)2 * T_ * 4;
static_assert(WS_HB + (size_t)2 * T_ * 512 * 2 <= WS_CT, "view B overlap");
constexpr size_t WS_END = WS_ENDA > WS_ENDB ? WS_ENDA : WS_ENDB;

constexpr int CW_CNT = 4096;
constexpr int CW_BAR = 8192;

constexpr int HALF_LDS = 75776, LDS_BYTES = 2 * HALF_LDS + 16;
constexpr int NTHREADS = 512, HT = 256;

struct Params {
    const float* x; const float* w_in; const float* cmp_pos; const float* cmp_w1; const float* cmp_w2;
    const float* w_br_a; const float* w_br_b; const float* w_o; const float* ln1_g; const float* ln1_b;
    const float* w_router; const float* router_bias; const float* w_gate; const float* w_up; const float* w_down;
    const float* ln2_g; const float* ln2_b; const float* rel_bias;
    float* out; unsigned char* ws;
    int ph_lo, ph_hi, rep_mask, pad_;
};

__device__ __forceinline__ bf16_t f2bf(float f) { unsigned u = __float_as_uint(f); u += 0x7fffu + ((u >> 16) & 1u); return (bf16_t)(u >> 16); }
__device__ __forceinline__ float bf2f(unsigned h) { return __uint_as_float(h << 16); }
typedef __bf16 bf16x2_t __attribute__((ext_vector_type(2)));
typedef float f32x2_t __attribute__((ext_vector_type(2)));
__device__ __forceinline__ unsigned pack2(float lo, float hi) { const f32x2_t f = {lo, hi}; return __builtin_bit_cast(unsigned, __builtin_convertvector(f, bf16x2_t)); }
__device__ __forceinline__ u32x2 pack4(f32x4 v) { u32x2 r; r.x = pack2(v[0], v[1]); r.y = pack2(v[2], v[3]); return r; }
__device__ __forceinline__ f32x4 unpack4(u32x2 u) { f32x4 r; r[0] = bf2f(u.x & 0xffffu); r[1] = bf2f(u.x >> 16); r[2] = bf2f(u.y & 0xffffu); r[3] = bf2f(u.y >> 16); return r; }
__device__ __forceinline__ float rows_max(float v) {
    u32x2 r = __builtin_amdgcn_permlane16_swap(__float_as_uint(v), __float_as_uint(v), false, false);
    v = fmaxf(__uint_as_float(r.x), __uint_as_float(r.y));
    r = __builtin_amdgcn_permlane32_swap(__float_as_uint(v), __float_as_uint(v), false, false);
    return fmaxf(__uint_as_float(r.x), __uint_as_float(r.y));
}
__device__ __forceinline__ float rows_sum(float v) {
    u32x2 r = __builtin_amdgcn_permlane16_swap(__float_as_uint(v), __float_as_uint(v), false, false);
    v = __uint_as_float(r.x) + __uint_as_float(r.y);
    r = __builtin_amdgcn_permlane32_swap(__float_as_uint(v), __float_as_uint(v), false, false);
    return __uint_as_float(r.x) + __uint_as_float(r.y);
}
__device__ __forceinline__ float wave_sum(float v) {
    v += __int_as_float(__builtin_amdgcn_mov_dpp(__float_as_int(v), 0xB1, 0xF, 0xF, true));
    v += __int_as_float(__builtin_amdgcn_mov_dpp(__float_as_int(v), 0x4E, 0xF, 0xF, true));
    v += __int_as_float(__builtin_amdgcn_mov_dpp(__float_as_int(v), 0x141, 0xF, 0xF, true));
    v += __int_as_float(__builtin_amdgcn_mov_dpp(__float_as_int(v), 0x140, 0xF, 0xF, true));
    return rows_sum(v);
}
__device__ __forceinline__ float sigmoidf_(float x) { return 1.f / (1.f + __expf(-x)); }
__device__ __forceinline__ int ltid() { int t = threadIdx.x; asm volatile("" : "+v"(t)); return t; }
__device__ __forceinline__ int vzero() { int z; asm volatile("v_mov_b32 %0, 0" : "=v"(z)); return z; }
__device__ __forceinline__ unsigned char* launder(unsigned char* q) { asm volatile("" : "+s"(q)); return q; }
__device__ __forceinline__ void wait_vm0() { asm volatile("s_waitcnt vmcnt(0)" ::: "memory"); }

__device__ __forceinline__ void glds16(const void* g, void* l) {
    __builtin_amdgcn_global_load_lds((const __attribute__((address_space(1))) unsigned*)g,
                                     (__attribute__((address_space(3))) unsigned*)l, 16, 0, 0);
}
__device__ __forceinline__ f32x4 mfma16(bf16x8 a, bf16x8 b, f32x4 c) { return __builtin_amdgcn_mfma_f32_16x16x32_bf16(a, b, c, 0, 0, 0); }

#define WAIT_V(n) asm volatile("s_waitcnt vmcnt(%0)" ::"n"(n) : "memory")
#define RAW_BARRIER() do { asm volatile("s_waitcnt lgkmcnt(0)" ::: "memory"); __builtin_amdgcn_s_barrier(); } while (0)
__device__ __forceinline__ void bglds16(__amdgpu_buffer_rsrc_t r, unsigned voff, int soff, void* l) {
    __builtin_amdgcn_raw_ptr_buffer_load_lds(r, (__attribute__((address_space(3))) void*)l, 16, (int)voff, soff, 0, 0);
}
template <int NJ, bool GN>
__device__ __forceinline__ void gemm8_stage(__amdgpu_buffer_rsrc_t mr, int mld, unsigned mvo, __amdgpu_buffer_rsrc_t nr, int nld, const unsigned (&nvo)[NJ], int kt, unsigned char* st, int wid) {
#pragma unroll
    for (int i = 0; i < 4; ++i) bglds16(mr, mvo, (64 * i * mld + kt * 64) * 2, st + (8 * i + wid) * 1024);
#pragma unroll
    for (int i = 0; i < NJ; ++i) bglds16(nr, nvo[i], ((GN ? 0 : 64 * i * nld) + kt * 64) * 2, st + 32768 + (8 * i + wid) * 1024);
}
template <int NJ, bool GN>
__device__ __forceinline__ void gemm8_kloop(const bf16_t* mb, int mld, unsigned mvo, const bf16_t* nb, int nld, const unsigned (&nvo)[NJ], int nk, unsigned char* lds, f32x4 (&acc)[8][NJ], int tid) {
    const int lane = tid & 63, wid = tid >> 6, wr = wid >> 2, wc = wid & 3, fr = lane & 15, fq = lane >> 4;
    const __amdgpu_buffer_rsrc_t mr = __builtin_amdgcn_make_buffer_rsrc((void*)mb, 0, 0x7fffffff, 0x00020000);
    const __amdgpu_buffer_rsrc_t nr = __builtin_amdgcn_make_buffer_rsrc((void*)nb, 0, 0x7fffffff, 0x00020000);
    gemm8_stage<NJ, GN>(mr, mld, mvo, nr, nld, nvo, 0, lds, wid);
    gemm8_stage<NJ, GN>(mr, mld, mvo, nr, nld, nvo, 1, lds + 65536, wid);
    for (int kt = 0; kt < nk; ++kt) {
        unsigned char* cur = lds + (kt & 1) * 65536;
        if (kt + 1 < nk) WAIT_V(4 + NJ); else WAIT_V(0);
        RAW_BARRIER();
        bf16x8 a[4], b[NJ];
        const unsigned char* ab = cur + (128 * wr + fr) * 128;
        const unsigned char* bb = cur + 32768 + (16 * NJ * wc + fr) * 128;
        const int sw0 = ((fq) ^ (fr & 7)) << 4, sw1 = ((4 + fq) ^ (fr & 7)) << 4;
#pragma unroll
        for (int j = 0; j < NJ; ++j) b[j] = *(const bf16x8*)(bb + j * 2048 + sw0);
#pragma unroll
        for (int mh = 0; mh < 2; ++mh) {
#pragma unroll
            for (int i = 0; i < 4; ++i) a[i] = *(const bf16x8*)(ab + (4 * mh + i) * 2048 + sw0);
#pragma unroll
            for (int i = 0; i < 4; ++i)
#pragma unroll
                for (int j = 0; j < NJ; ++j) acc[4 * mh + i][j] = mfma16(a[i], b[j], acc[4 * mh + i][j]);
        }
#pragma unroll
        for (int j = 0; j < NJ; ++j) b[j] = *(const bf16x8*)(bb + j * 2048 + sw1);
#pragma unroll
        for (int i = 0; i < 4; ++i) a[i] = *(const bf16x8*)(ab + i * 2048 + sw1);
#pragma unroll
        for (int i = 0; i < 4; ++i)
#pragma unroll
            for (int j = 0; j < NJ; ++j) acc[i][j] = mfma16(a[i], b[j], acc[i][j]);
#pragma unroll
        for (int i = 0; i < 4; ++i) a[i] = *(const bf16x8*)(ab + (4 + i) * 2048 + sw1);
        RAW_BARRIER();
        if (kt + 2 < nk) gemm8_stage<NJ, GN>(mr, mld, mvo, nr, nld, nvo, kt + 2, cur, wid);
#pragma unroll
        for (int i = 0; i < 4; ++i)
#pragma unroll
            for (int j = 0; j < NJ; ++j) acc[4 + i][j] = mfma16(a[i], b[j], acc[4 + i][j]);
    }
    __syncthreads();
    __builtin_amdgcn_sched_barrier(0);
}
template <int NJ>
__device__ __forceinline__ void zero_acc8(f32x4 (&acc)[8][NJ]) {
#pragma unroll
    for (int i = 0; i < 8; ++i)
#pragma unroll
        for (int j = 0; j < NJ; ++j) acc[i][j] = (f32x4){0.f, 0.f, 0.f, 0.f};
}

namespace pg8 {
#define PG8_LAS __attribute__((address_space(3)))
constexpr int BM = 256, BK = 64, HALF = 128, HTB = HALF * BK * 2, STAGE_BYTES = 8 * HTB;
__device__ __forceinline__ int lds_byte(int r, int c) { const int st = (r >> 4) * 2 + (c >> 5), rr = r & 15, cc = c & 31, ob = rr * 64 + cc * 2; return st * 1024 + (ob ^ (((ob >> 9) & 1) << 5)); }
__device__ __forceinline__ void stage_rc(int b, int& R, int& C) { const int st = b / 1024, sb = b % 1024, swz = sb ^ (((sb >> 9) & 1) << 5); R = (st >> 1) * 16 + swz / 64; C = (st & 1) * 32 + (swz % 64) / 2; }
__device__ __forceinline__ int perm32(int rho) { const int n = rho >> 4, i = rho & 15; return 8 * (i >> 2) + 4 * n + (i & 3); }
struct Unit { int pm, pn; };
template <class Epi, class Sched>
__device__ __forceinline__ void gemm_phase(unsigned char* lds_, const int K, const Sched& S, const Epi& E, const int tid, const unsigned char* wsbase) {
    PG8_LAS unsigned char* lds = (PG8_LAS unsigned char*)lds_;
    const int wid = __builtin_amdgcn_readfirstlane(tid >> 6), lane = tid & 63, wr = wid >> 2, wc = wid & 3, fr = lane & 15, fq = lane >> 4;
    const int nt = K / BK;
    unsigned voffA[2], voffB[2];
#pragma unroll
    for (int i = 0; i < 2; ++i) { int R, C; stage_rc(tid * 16 + i * 8192, R, C); const int Rb = (R & ~31) + perm32(R & 31);
        voffA[i] = (unsigned)(R * K + C) * 2u; voffB[i] = (unsigned)(Rb * K + C) * 2u; }
    const unsigned kstep = (unsigned)(BK * 2);
    const unsigned hstep = (unsigned)HALF * K * 2;
    const __amdgpu_buffer_rsrc_t rsrc = __builtin_amdgcn_make_buffer_rsrc((void*)wsbase, 0, 0x7fffffff, 0x00020000);
    const unsigned ldsw = (unsigned)wid * 1024u;
    const int aoff = lds_byte(wr * 64 + fr, fq * 8), boff = lds_byte(wc * 32 + fr, fq * 8);
#define PG8_SA(b, h) (((b) * 2 + (h)) * HTB)
#define PG8_SB(b, h) ((4 + (b) * 2 + (h)) * HTB)
#define PG8_STAGE(bufoff, gbase, voff) do { _Pragma("unroll") for (int _i = 0; _i < 2; ++_i) \
        __builtin_amdgcn_raw_ptr_buffer_load_lds(rsrc, (PG8_LAS void*)(lds + (bufoff) + ldsw + _i * 8192), 16, (int)(voff)[_i], (int)(gbase), 0, 0); } while (0)
#define PG8_LDA(dst, b, h) do { _Pragma("unroll") for (int m = 0; m < 4; ++m) _Pragma("unroll") for (int k = 0; k < 2; ++k) dst[m][k] = *(const PG8_LAS bf16x8*)(lds + PG8_SA(b, h) + aoff + m * 2048 + k * 1024); } while (0)
#define PG8_LDB(dst, b, h) do { _Pragma("unroll") for (int n = 0; n < 2; ++n) _Pragma("unroll") for (int k = 0; k < 2; ++k) dst[n][k] = *(const PG8_LAS bf16x8*)(lds + PG8_SB(b, h) + boff + n * 2048 + k * 1024); } while (0)
#define PG8_MMA(ai, bj, At, Bt) do { __builtin_amdgcn_s_setprio(1); _Pragma("unroll") for (int m = 0; m < 4; ++m) _Pragma("unroll") for (int n = 0; n < 2; ++n) _Pragma("unroll") for (int k = 0; k < 2; ++k) \
        acc[ai][bj][m][n] = __builtin_amdgcn_mfma_f32_16x16x32_bf16(Bt[n][k], At[m][k], acc[ai][bj][m][n], 0, 0, 0); __builtin_amdgcn_s_setprio(0); } while (0)
#define PG8_WAIT_V(n) asm volatile("s_waitcnt vmcnt(" #n ")" ::: "memory")
#define PG8_WAIT_L(n) asm volatile("s_waitcnt lgkmcnt(" #n ")" ::: "memory")
#define PG8_BAR __builtin_amdgcn_s_barrier()
#define PG8_SCHED __builtin_amdgcn_sched_barrier(0)
    typename Sched::U cur, nxt; int ui = 0;
    if (!S.next(0, cur)) return;
    unsigned cA, cB; S.ptrs(cur, cA, cB);
    constexpr bool GA = Sched::GATHER;
    unsigned vA[GA ? 2 : 1][2], nvA[GA ? 2 : 1][2];
    if constexpr (GA) { S.rows(cur, tid, vA);
#pragma unroll
        for (int h = 0; h < 2; ++h)
#pragma unroll
            for (int i = 0; i < 2; ++i) nvA[h][i] = vA[h][i]; }
#define PG8_STAGE_A(bufoff, gbase, h, nextu) do { if constexpr (GA) { if (nextu) PG8_STAGE(bufoff, gbase, nvA[h]); else PG8_STAGE(bufoff, gbase, vA[h]); } \
        else PG8_STAGE(bufoff, (gbase) + (h) * hstep, voffA); } while (0)
    PG8_STAGE(PG8_SB(0, 0), cB, voffB); PG8_STAGE_A(PG8_SA(0, 0), cA, 0, false); PG8_STAGE(PG8_SB(0, 1), cB + hstep, voffB); PG8_STAGE_A(PG8_SA(0, 1), cA, 1, false);
    if (wr == 1) PG8_BAR;
    PG8_WAIT_V(4); PG8_BAR;
    PG8_STAGE(PG8_SB(1, 0), cB + kstep, voffB); PG8_STAGE_A(PG8_SA(1, 0), cA + kstep, 0, false); PG8_STAGE(PG8_SB(1, 1), cB + hstep + kstep, voffB);
    PG8_WAIT_V(6); PG8_BAR;
    PG8_SCHED;
    f32x4 acc[2][2][4][2];
#pragma unroll
    for (int a = 0; a < 2; ++a)
#pragma unroll
        for (int b = 0; b < 2; ++b)
#pragma unroll
            for (int m = 0; m < 4; ++m)
#pragma unroll
                for (int n = 0; n < 2; ++n) acc[a][b][m][n] = (f32x4){0.f, 0.f, 0.f, 0.f};
    bf16x8 At[4][2], B0[2][2], B1[2][2];
    for (;;) {
        const bool has_next = S.next(ui + 1, nxt);
        unsigned nA = cA, nB = cB; if (has_next) S.ptrs(nxt, nA, nB);
        if constexpr (GA) { if (has_next) S.rows(nxt, tid, nvA); }
        for (int t = 0; t < nt; t += 2) {
            const bool last = (t == nt - 2);
            const unsigned a1 = cA + (unsigned)(t + 1) * kstep;
            const unsigned a2 = last ? nA : cA + (unsigned)(t + 2) * kstep, b2 = last ? nB : cB + (unsigned)(t + 2) * kstep;
            const unsigned a3 = a2 + kstep, b3 = b2 + kstep;
            PG8_LDB(B0, 0, 0); PG8_SCHED; PG8_LDA(At, 0, 0); PG8_STAGE_A(PG8_SA(1, 1), a1, 1, false);
            PG8_WAIT_L(8); PG8_BAR; PG8_WAIT_L(0); PG8_MMA(0, 0, At, B0); PG8_BAR; PG8_SCHED;
            PG8_LDB(B1, 0, 1); PG8_STAGE(PG8_SB(0, 0), b2, voffB);
            PG8_BAR; PG8_WAIT_L(0); PG8_MMA(0, 1, At, B1); PG8_BAR;
            PG8_LDA(At, 0, 1); PG8_STAGE_A(PG8_SA(0, 0), a2, 0, last);
            PG8_BAR; PG8_WAIT_L(0); PG8_MMA(1, 0, At, B0); PG8_BAR; PG8_SCHED;
            PG8_STAGE(PG8_SB(0, 1), b2 + hstep, voffB);
            PG8_WAIT_V(6); PG8_BAR; PG8_MMA(1, 1, At, B1); PG8_BAR;
            PG8_LDB(B0, 1, 0); PG8_SCHED; PG8_LDA(At, 1, 0); PG8_STAGE_A(PG8_SA(0, 1), a2, 1, last);
            PG8_WAIT_L(8); PG8_BAR; PG8_WAIT_L(0); PG8_MMA(0, 0, At, B0); PG8_BAR; PG8_SCHED;
            PG8_LDB(B1, 1, 1); PG8_STAGE(PG8_SB(1, 0), b3, voffB);
            PG8_BAR; PG8_WAIT_L(0); PG8_MMA(0, 1, At, B1); PG8_BAR;
            PG8_LDA(At, 1, 1); PG8_STAGE_A(PG8_SA(1, 0), a3, 0, last);
            PG8_BAR; PG8_WAIT_L(0); PG8_MMA(1, 0, At, B0); PG8_BAR; PG8_SCHED;
            PG8_STAGE(PG8_SB(1, 1), b3 + hstep, voffB);
            PG8_WAIT_V(6); PG8_BAR; PG8_MMA(1, 1, At, B1); PG8_BAR;
        }
        E(acc, cur, wr, wc, fr, fq);
        if (!has_next) break;
#pragma unroll
        for (int a = 0; a < 2; ++a)
#pragma unroll
            for (int b = 0; b < 2; ++b)
#pragma unroll
                for (int m = 0; m < 4; ++m)
#pragma unroll
                    for (int n = 0; n < 2; ++n) acc[a][b][m][n] = (f32x4){0.f, 0.f, 0.f, 0.f};
        cur = nxt; cA = nA; cB = nB; ++ui;
        if constexpr (GA) {
#pragma unroll
            for (int h = 0; h < 2; ++h)
#pragma unroll
                for (int i = 0; i < 2; ++i) vA[h][i] = nvA[h][i]; }
    }
    PG8_WAIT_V(0);
    if (wr == 0) PG8_BAR;
    PG8_BAR;
#undef PG8_SA
#undef PG8_SB
#undef PG8_STAGE
#undef PG8_STAGE_A
#undef PG8_LDA
#undef PG8_LDB
#undef PG8_MMA
#undef PG8_WAIT_V
#undef PG8_WAIT_L
#undef PG8_BAR
#undef PG8_SCHED
}
}

struct TJob { const float* src; bf16_t* dst; int ld, k0, n0, mode, kdst; };
__device__ __forceinline__ void tcvt_load(const TJob& J, float4 (&v)[4], int tid) {
#pragma unroll
    for (int i = 0; i < 4; ++i) {
        const int kk = (tid >> 4) + 16 * i, c4 = (tid & 15) * 4, cd = J.n0 + c4;
        int orig = cd; bool ok = true;
        if (J.mode == 1) {
            if (cd < 896) orig = cd;
            else if (cd < 1024) orig = cd - 896 + 1024;
            else if (cd < 2048) { const int q = cd - 1024, hd = q >> 6, pp = q & 63;
                const int d = (pp & 4) ? 32 + 4 * (pp >> 3) + (pp & 3) : 4 * (pp >> 3) + (pp & 3);
                orig = 1304 + hd * 64 + d; }
            else if (cd < 5120) orig = cd - 2048 + 3352;
            else if (cd < 5144) orig = cd - 5120 + 1280;
            else if (cd < 5376) ok = false;
            else if (cd < 5504) orig = cd - 5376 + 896;
            else if (cd < 5632) orig = cd - 5504 + 1152;
            else orig = cd - 5632 + 2328;
        }
        v[i] = make_float4(0.f, 0.f, 0.f, 0.f);
        if (ok) v[i] = *(const float4*)(J.src + (size_t)(J.k0 + kk) * J.ld + orig);
    }
}
__device__ __forceinline__ void tcvt_finish(const TJob& J, const float4 (&v)[4], unsigned char* lds, int tid) {
    float* tile = (float*)lds;
#pragma unroll
    for (int i = 0; i < 4; ++i) {
        const int kk = (tid >> 4) + 16 * i, c4 = (tid & 15) * 4;
        tile[kk * 65 + c4 + 0] = v[i].x; tile[kk * 65 + c4 + 1] = v[i].y; tile[kk * 65 + c4 + 2] = v[i].z; tile[kk * 65 + c4 + 3] = v[i].w;
    }
    __syncthreads();
#pragma unroll
    for (int i = 0; i < 2; ++i) {
        const int q = tid + 256 * i, n = q >> 3, kc = q & 7;
        float x[8];
#pragma unroll
        for (int j = 0; j < 8; ++j) x[j] = tile[(kc * 8 + j) * 65 + n];
        u32x4 w; w.x = pack2(x[0], x[1]); w.y = pack2(x[2], x[3]); w.z = pack2(x[4], x[5]); w.w = pack2(x[6], x[7]);
        int drow = J.n0 + n; if (J.mode >= 2) drow = 8 * (drow >> 2) + (drow & 3) + (J.mode == 3 ? 4 : 0);
        *(u32x4*)(J.dst + (size_t)drow * J.kdst + J.k0 + kc * 8) = w;
    }
    __syncthreads();
}
__device__ __forceinline__ void tcvt_tile(const float* src, int ld_src, int k0, int n0, int mode, bf16_t* dst, int kdst, unsigned char* lds, int half) {
    TJob J; J.src = src; J.dst = dst; J.ld = ld_src; J.k0 = k0; J.n0 = n0; J.mode = mode; J.kdst = kdst;
    const int tid = (ltid() & 255); float4 v[4];
    tcvt_load(J, v, tid); tcvt_finish(J, v, lds, tid);
}

__device__ __forceinline__ void tcvt_decode(const Params& p, unsigned char* ws, int layer, int t, TJob& J) {
    constexpr int J0 = 16 * 104, J1 = 8 * 16, J2 = 256, J3 = 256, J4 = 2048, J5 = 2048;
    int u = t;
        if (u < J0) { J.src = p.w_in + (size_t)layer * 1024 * DIN; J.ld = DIN; J.k0 = (u % 16) * 64; J.n0 = (u / 16) * 64; J.mode = 1; J.dst = (bf16_t*)(ws + WS_WIN); J.kdst = 1024; return; }
        u -= J0;
        if (u < J1) { J.src = p.w_br_a + (size_t)layer * 512 * 1024; J.ld = 1024; J.k0 = (u % 8) * 64; J.n0 = (u / 8) * 64; J.mode = 0; J.dst = (bf16_t*)(ws + WS_WA); J.kdst = 512; return; }
        u -= J1;
        if (u < J2) { J.src = p.w_br_b + (size_t)layer * 1024 * 1024; J.ld = 1024; J.k0 = (u % 16) * 64; J.n0 = (u / 16) * 64; J.mode = 0; J.dst = (bf16_t*)(ws + WS_WB); J.kdst = 1024; return; }
        u -= J2;
        if (u < J3) { J.src = p.w_o + (size_t)layer * 1024 * 1024; J.ld = 1024; J.k0 = (u % 16) * 64; J.n0 = (u / 16) * 64; J.mode = 0; J.dst = (bf16_t*)(ws + WS_WO); J.kdst = 1024; return; }
        u -= J3;
        if (u < J4 + J5) {
            const bool up = u >= J4; if (up) u -= J4;
            const int e = u / 128, v = u % 128;
            J.src = (up ? p.w_up : p.w_gate) + ((size_t)layer * NE + e) * 1024 * 512; J.ld = 512; J.k0 = (v % 16) * 64; J.n0 = (v / 16) * 64; J.mode = up ? 3 : 2;
            J.dst = (bf16_t*)(ws + WS_WG) + (size_t)e * 1024 * 1024; J.kdst = 1024; return;
        }
        u -= J4 + J5;
        { const int e = u / 128, v = u % 128;
          J.src = p.w_down + ((size_t)layer * NE + e) * 512 * 1024; J.ld = 1024; J.k0 = (v % 8) * 64; J.n0 = (v / 8) * 64; J.mode = 0; J.dst = (bf16_t*)(ws + WS_WD) + (size_t)e * 1024 * 512; J.kdst = 512; }
}


__device__ __forceinline__ void phase_pw(const Params& p, int layer, unsigned char* lds, int parts, int half, int skip = 0) {
    if ((int)(blockIdx.x * 2 + half) < skip) return;
    const int bid = (blockIdx.x * 2 + half) - skip, nblk = (gridDim.x * 2) - skip, tid = (ltid() & 255);
    unsigned char* ws = launder(p.ws);
    constexpr int J0 = 16 * 104, J1 = 8 * 16, J2 = 256, J3 = 256, J4 = 2048, J5 = 2048, J6 = 2048, JT = J0 + J1 + J2 + J3 + J4 + J5 + J6;
    const int t_lo = (parts & 1) ? 0 : (parts & 2) ? J0 : J0 + J1 + J2 + J3;
    const int t_hi = (parts & 4) ? JT : (parts & 2) ? J0 + J1 + J2 + J3 : (parts & 1) ? J0 : 0;
    if (t_lo + bid < t_hi) {
        float4 v[4]; { TJob J; tcvt_decode(p, ws, layer, t_lo + bid, J); tcvt_load(J, v, tid); }
        for (int t = t_lo + bid; t < t_hi; t += nblk) {
            float4 vn[4];
            if (t + nblk < t_hi) { TJob J; tcvt_decode(p, ws, layer, t + nblk, J); tcvt_load(J, vn, tid); }
            { TJob J; tcvt_decode(p, ws, layer, t, J); tcvt_finish(J, v, lds, tid); }
#pragma unroll
            for (int i = 0; i < 4; ++i) v[i] = vn[i];
        }
    }
    if (parts & 16) {
    for (int t = bid; t < 64; t += nblk) {
        const int kv = t >> 5, kt = t & 31;
        tcvt_tile(p.cmp_w1 + ((size_t)layer * 2 + kv) * 2048 * 64, 64, kt * 64, 0, 0, (bf16_t*)(ws + WS_W1T) + (size_t)kv * 64 * 2048, 2048, lds, half);
    }
    if (bid >= nblk - 2) {
        const int kv = nblk - 1 - bid, n = tid & 63, part = tid >> 6;
        const float* w1 = p.cmp_w1 + ((size_t)layer * 2 + kv) * 2048 * 64; const float* pos = p.cmp_pos + ((size_t)layer * 2 + kv) * 2048;
        float a = 0.f;
        for (int k = part * 512; k < part * 512 + 512; ++k) a += pos[k] * w1[(size_t)k * 64 + n];
        float* red = (float*)lds;
        __syncthreads(); red[tid] = a; __syncthreads();
        if (tid < 64) ((float*)(ws + WS_B1))[kv * 64 + tid] = red[tid] + red[tid + 64] + red[tid + 128] + red[tid + 192];
        __syncthreads();
    }
    }
    if (parts & 8) {
        const float4* xs = (const float4*)p.x; u32x2* xb = (u32x2*)(ws + WS_XB);
        for (size_t i = (size_t)bid * HT + tid; i < (size_t)T_ * 1024 / 4; i += (size_t)nblk * HT) {
            float4 v = xs[i]; u32x2 w; w.x = pack2(v.x, v.y); w.y = pack2(v.z, v.w); xb[i] = w;
        }
        for (int n = bid * HT + tid; n < 8192; n += nblk * HT) {
            int bk;
            if (n < 16) bk = n;
            else { const int th[15] = {22, 30, 40, 54, 73, 99, 134, 182, 246, 332, 450, 609, 825, 1117, 1513}; bk = 16;
#pragma unroll
                for (int k = 0; k < 15; ++k) bk += (n >= th[k]) ? 1 : 0; }
            (ws + WS_BUCKET)[n] = (unsigned char)bk;
        }
        for (int i = bid * HT + tid; i < 8192 * 32; i += nblk * HT) {
            const int pos = i >> 5, d = i & 31;
            const float inv = powf(10000.f, -(float)d * 2.0f / 64.f);
            const float ang = (float)pos * inv;
            float sn, cs; sincosf(ang, &sn, &cs);
            ((float2*)(ws + WS_ROPE))[i] = make_float2(cs, sn);
        }
        if (bid == 0) for (int i = tid; i < 8192; i += HT) ((unsigned*)(ws + WS_CTL))[i] = 0u;
    }
}

__device__ __forceinline__ float fsig(float x) { return __builtin_amdgcn_rcpf(1.f + __builtin_amdgcn_exp2f(-1.4426950408889634f * x)); }
template <int KIND>
__device__ __forceinline__ void g1_epi(const f32x4 (&acc)[2][2][4][2], unsigned char* ws, int r0, int c0, int wr, int wc, int fr, int fq) {
#pragma unroll
    for (int ai = 0; ai < 2; ++ai)
#pragma unroll
        for (int m = 0; m < 4; ++m) {
            const int row = r0 + 128 * ai + 64 * wr + 16 * m + fr + vzero();
#pragma unroll
            for (int bj = 0; bj < 2; ++bj) {
                const int col = c0 + 128 * bj + 32 * wc + 8 * fq;
                f32x4 v0 = acc[ai][bj][m][0], v1 = acc[ai][bj][m][1];
                if (KIND == 5) {
                    const int b = col >> 13, sq = col & (S_ - 1);
                    bf16_t* dst;
                    if (row < C_VW) { const int c = row - C_VS; dst = (bf16_t*)(ws + WS_VST) + ((size_t)(b * 2 + (c >> 6)) * 64 + (c & 63)) * S_ + sq; }
                    else if (row < C_VR) { const int c = row - C_VW; dst = (bf16_t*)(ws + WS_VWT) + ((size_t)(b * 2 + (c >> 6)) * 64 + (c & 63)) * S_ + sq; }
                    else { const int c = row - C_VR; dst = (bf16_t*)(ws + WS_VRT) + ((size_t)(b * 8 + (c >> 7)) * 128 + (c & 127)) * S_ + sq; }
                    u32x4 w; w.x = pack2(v0[0], v0[1]); w.y = pack2(v0[2], v0[3]); w.z = pack2(v1[0], v1[1]); w.w = pack2(v1[2], v1[3]);
                    *(u32x4*)dst = w;
                    continue;
                }
                if (KIND == 1 || KIND == 2) {
                    const float2* rope = (const float2*)(ws + WS_ROPE);
                    const int pos = row & (S_ - 1), d = 16 * (wc & 1) + 4 * fq;
                    const float4 cs01 = *(const float4*)(rope + pos * 32 + d), cs23 = *(const float4*)(rope + pos * 32 + d + 2);
                    const float c[4] = {cs01.x, cs01.z, cs23.x, cs23.z}, sn[4] = {cs01.y, cs01.w, cs23.y, cs23.w};
                    const float sc = (KIND == 2) ? 0.125f : 1.0f;
                    f32x4 y1, y2;
#pragma unroll
                    for (int r = 0; r < 4; ++r) { y1[r] = (v0[r] * c[r] - v1[r] * sn[r]) * sc; y2[r] = (v0[r] * sn[r] + v1[r] * c[r]) * sc; }
                    v0 = y1; v1 = y2;
                } else if (KIND == 3) {
#pragma unroll
                    for (int r = 0; r < 4; ++r) { v0[r] = v0[r] * fsig(v0[r]); v1[r] = v1[r] * fsig(v1[r]); }
                } else if (KIND == 4) {
#pragma unroll
                    for (int r = 0; r < 4; ++r) { v0[r] = fsig(v0[r]); v1[r] = fsig(v1[r]); }
                }
                u32x4 w; w.x = pack2(v0[0], v0[1]); w.y = pack2(v0[2], v0[3]); w.z = pack2(v1[0], v1[1]); w.w = pack2(v1[2], v1[3]);
                *(u32x4*)((bf16_t*)(ws + WS_P) + (size_t)row * LD + col) = w;
            }
        }
}
struct G1Order {      typedef pg8::Unit U; static constexpr bool GATHER = false;
    int xcd, slot, per;
    __device__ __forceinline__ bool next(int i, pg8::Unit& u) const {
        const int j = slot + i * per; if (j >= 208) return false;
        if (j < 192) { u.pm = j / 3; u.pn = xcd + 8 * (j % 3); } else { const int q = j - 192; u.pm = 8 * xcd + (q >> 1); u.pn = 24 + (q & 1); }
        return true;
    }
    __device__ __forceinline__ void ptrs(const pg8::Unit& u, unsigned& A, unsigned& B) const {
        const unsigned x = (unsigned)WS_XB + (unsigned)u.pm * (256u * 1024u * 2u), w = (unsigned)WS_WIN + (unsigned)u.pn * (256u * 1024u * 2u);
        if (u.pn >= 21) { A = w; B = x; } else { A = x; B = w; }
    }
};
struct G1Epi {
    unsigned char* ws;
    __device__ __forceinline__ void operator()(const f32x4 (&acc)[2][2][4][2], const pg8::Unit& u, int wr, int wc, int fr, int fq) const {
        const int pn = u.pn, tok0 = u.pm * 256, n0 = pn * 256;
        if (pn >= 21) g1_epi<5>(acc, ws, n0, tok0, wr, wc, fr, fq);
        else if (pn >= 12) g1_epi<4>(acc, ws, tok0, n0, wr, wc, fr, fq);
        else if (pn >= 8) g1_epi<3>(acc, ws, tok0, n0, wr, wc, fr, fq);
        else if (pn >= 6) g1_epi<2>(acc, ws, tok0, n0, wr, wc, fr, fq);
        else if (pn >= 4) g1_epi<1>(acc, ws, tok0, n0, wr, wc, fr, fq);
        else g1_epi<0>(acc, ws, tok0, n0, wr, wc, fr, fq);
    }
};
__device__ __forceinline__ void phase_g1(const Params& p, int layer, unsigned char* lds) {
    unsigned char* ws = launder(p.ws);
    G1Order S; S.xcd = blockIdx.x & 7; S.slot = blockIdx.x >> 3; S.per = gridDim.x >> 3;
    G1Epi E; E.ws = ws;
    pg8::gemm_phase<G1Epi, G1Order>(lds, 1024, S, E, ltid(), ws);
}

__device__ __forceinline__ void load_tile64(const bf16_t* base, size_t rowStride, unsigned char* dst, int wid, int lane) {
    const int c = ((lane & 7) ^ (lane >> 3)) * 8;
#pragma unroll
    for (int i = 0; i < 2; ++i) { const int j = wid + 4 * i, row = 8 * j + (lane >> 3); glds16(base + (size_t)row * rowStride + c, dst + j * 1024); }
}
__device__ __forceinline__ void load_tile128(const bf16_t* base, size_t rowStride, unsigned char* dst, int wid, int lane) {
    const int c = ((lane & 7) ^ (lane >> 3)) * 8;
#pragma unroll
    for (int i = 0; i < 4; ++i) { const int j = wid + 4 * i, row = 8 * j + (lane >> 3); glds16(base + (size_t)row * rowStride + c, dst + j * 1024); }
}
__device__ __forceinline__ void load_tile128w(const bf16_t* base, size_t rowStride, unsigned char* dst, int wid, int lane) {
    const int c = ((lane & 15) ^ ((4 * wid + (lane >> 4)) & 15)) * 8;
#pragma unroll
    for (int i = 0; i < 8; ++i) { const int j = wid + 4 * i, row = 4 * j + (lane >> 4); glds16(base + (size_t)row * rowStride + c, dst + j * 1024); }
}
__device__ __forceinline__ bf16x8 lds_frag128(const unsigned char* tile, int row, int chunk) {
    return *(const bf16x8*)(tile + row * 128 + ((chunk ^ (row & 7)) << 4));
}
__device__ __forceinline__ bf16x8 lds_frag256(const unsigned char* tile, int row, int chunk) {
    return *(const bf16x8*)(tile + row * 256 + ((chunk ^ (row & 15)) << 4));
}
__device__ __forceinline__ bf16x8 lds_vfrag128(const unsigned char* tile, int row, int kbase, int fq) {
    const int ca = (kbase >> 3) + (fq >> 1), hb = (fq & 1) * 8;
    const u32x2 a = *(const u32x2*)(tile + row * 128 + ((ca ^ (row & 7)) << 4) + hb);
    const u32x2 b = *(const u32x2*)(tile + row * 128 + (((ca + 2) ^ (row & 7)) << 4) + hb);
    u32x4 w; w.x = a.x; w.y = a.y; w.z = b.x; w.w = b.y;
    return __builtin_bit_cast(bf16x8, w);
}
__device__ __forceinline__ bf16x8 lds_vfrag256(const unsigned char* tile, int row, int kbase, int fq) {
    const int ca = (kbase >> 3) + (fq >> 1), hb = (fq & 1) * 8;
    const u32x2 a = *(const u32x2*)(tile + row * 256 + ((ca ^ (row & 15)) << 4) + hb);
    const u32x2 b = *(const u32x2*)(tile + row * 256 + (((ca + 2) ^ (row & 15)) << 4) + hb);
    u32x4 w; w.x = a.x; w.y = a.y; w.z = b.x; w.w = b.y;
    return __builtin_bit_cast(bf16x8, w);
}
__device__ __forceinline__ bf16x8 pack8(f32x4 a, f32x4 b) {
    u32x4 w; w.x = pack2(a[0], a[1]); w.y = pack2(a[2], a[3]); w.z = pack2(b[0], b[1]); w.w = pack2(b[2], b[3]);
    return __builtin_bit_cast(bf16x8, w);
}

__device__ __forceinline__ float gelu_tanh(float x) {
    const float u = 0.7978845608028654f * (x + 0.044715f * x * x * x);
    return 0.5f * x * (1.f + tanhf(u));
}
__device__ __forceinline__ void compress_item(const Params& p, int layer, int item, unsigned char* lds, int half) {
    unsigned char* ws = launder(p.ws);
    const int tid = (ltid() & 255), lane = tid & 63, wid = tid >> 6, wr = wid >> 1, wc = wid & 1, fr = lane & 15, fq = lane >> 4;
    const int mtile = item & 3, g = (item >> 2) & 1, b = (item >> 3) & 1, kv = item >> 4;
    const int i0 = mtile * 128;
    const bf16_t* P = (const bf16_t*)(ws + WS_P);
    const bf16_t* W1T = (const bf16_t*)(ws + WS_W1T) + (size_t)kv * 64 * 2048;
    const int col = (kv ? C_VC : C_KC) + g * 64;
    const int ldc = ((lane & 7) ^ (lane >> 3)) * 8;
    const bf16_t* ap[4];
#pragma unroll
    for (int i = 0; i < 4; ++i) ap[i] = P + ((size_t)b * S_ + 16 * (i0 + 32 * i + 8 * wid + (lane >> 3))) * LD + col + ldc;
    const bf16_t* bp[2];
#pragma unroll
    for (int i = 0; i < 2; ++i) bp[i] = W1T + (size_t)(8 * (wid + 4 * i) + (lane >> 3)) * 2048 + ldc;
    f32x4 acc[4][2];
#pragma unroll
    for (int i = 0; i < 4; ++i)
#pragma unroll
        for (int j = 0; j < 2; ++j) acc[i][j] = (f32x4){0.f, 0.f, 0.f, 0.f};
    __syncthreads();
#define CSTAGE(buf, l) do { unsigned char* st_ = lds + (buf) * 24576; \
        _Pragma("unroll") for (int i = 0; i < 4; ++i) glds16(ap[i] + (size_t)(l) * LD, st_ + (4 * i + wid) * 1024); \
        _Pragma("unroll") for (int i = 0; i < 2; ++i) glds16(bp[i] + (l) * 64, st_ + 16384 + (wid + 4 * i) * 1024); } while (0)
    CSTAGE(0, 0); CSTAGE(1, 1);
    for (int l = 0; l < 32; ++l) {
        const unsigned char* st = lds + (l % 3) * 24576;
        if (l + 1 < 32) WAIT_V(6); else WAIT_V(0);
        RAW_BARRIER();
        if (l + 2 < 32) CSTAGE((l + 2) % 3, l + 2);
#pragma unroll
        for (int ks = 0; ks < 2; ++ks) {
            bf16x8 a[4], bb[2];
#pragma unroll
            for (int i = 0; i < 4; ++i) a[i] = lds_frag128(st, 64 * wr + 16 * i + fr, 4 * ks + fq);
#pragma unroll
            for (int j = 0; j < 2; ++j) bb[j] = lds_frag128(st + 16384, 32 * wc + 16 * j + fr, 4 * ks + fq);
#pragma unroll
            for (int i = 0; i < 4; ++i)
#pragma unroll
                for (int j = 0; j < 2; ++j) acc[i][j] = mfma16(a[i], bb[j], acc[i][j]);
        }
    }
    __syncthreads();
#undef CSTAGE
    float* hid = (float*)lds;
    const float* b1 = (const float*)(ws + WS_B1) + kv * 64;
#pragma unroll
    for (int j = 0; j < 2; ++j) {
        const int n = 32 * wc + 16 * j + fr; const float bias = b1[n + vzero()];
#pragma unroll
        for (int i = 0; i < 4; ++i)
#pragma unroll
            for (int r = 0; r < 4; ++r) hid[(64 * wr + 16 * i + 4 * fq + r) * 65 + n] = gelu_tanh(acc[i][j][r] + bias);
    }
    __syncthreads();
    {
        const int row = tid >> 1, nb = (tid & 1) * 32, ci = i0 + row;
        const float* w2 = p.cmp_w2 + ((size_t)layer * 2 + kv) * 64 * 64;
        float o[32];
#pragma unroll
        for (int q = 0; q < 32; ++q) o[q] = 0.f;
        for (int n = 0; n < 64; ++n) {
            const float h = hid[row * 65 + n];
#pragma unroll
            for (int q4 = 0; q4 < 8; ++q4) { const float4 w = *(const float4*)(w2 + n * 64 + nb + 4 * q4); o[4 * q4] += h * w.x; o[4 * q4 + 1] += h * w.y; o[4 * q4 + 2] += h * w.z; o[4 * q4 + 3] += h * w.w; }
        }
        if (kv == 0) {
            bf16_t* dst = (bf16_t*)(ws + WS_KCC) + ((size_t)(b * 2 + g) * 512 + ci) * 64 + nb;
#pragma unroll
            for (int q = 0; q < 32; q += 4) { f32x4 v = {o[q], o[q + 1], o[q + 2], o[q + 3]}; if (ci >= 511) v = (f32x4){0.f, 0.f, 0.f, 0.f}; *(u32x2*)(dst + q) = pack4(v); }
        } else {
            bf16_t* dst = (bf16_t*)(ws + WS_VCCT) + ((size_t)(b * 2 + g) * 64 + nb) * 512 + ci;
#pragma unroll
            for (int q = 0; q < 32; ++q) dst[(size_t)q * 512] = f2bf(ci >= 511 ? 0.f : o[q]);
        }
    }
    __syncthreads();
}

__device__ __forceinline__ float ret_lg2(int h) { const float gam = 1.f - exp2f(-5.f - (float)h); return log2f(gam); }

__device__ __forceinline__ void retkv_item(const Params& p, int item, unsigned char* lds, int half) {
    unsigned char* ws = launder(p.ws);
    const int tid = (ltid() & 255), lane = tid & 63, wid = tid >> 6, fr = lane & 15, fq = lane >> 4;
    const int n = item & 63, h = (item >> 6) & 7, b = item >> 9;
    const size_t tok0 = (size_t)b * S_ + 128 * n;
    unsigned char* vL = lds; unsigned char* kL = lds + 32768;
    load_tile128w((const bf16_t*)(ws + WS_VRT) + ((size_t)(b * 8 + h) * 128) * S_ + 128 * n, S_, vL, wid, lane);
    load_tile128((const bf16_t*)(ws + WS_P) + tok0 * LD + C_KR + h * 64, LD, kL, wid, lane);
    wait_vm0(); __syncthreads();
    const float lg2 = ret_lg2(h);
    f32x4 acc[2][4];
#pragma unroll
    for (int m = 0; m < 2; ++m)
#pragma unroll
        for (int nt = 0; nt < 4; ++nt) acc[m][nt] = (f32x4){0.f, 0.f, 0.f, 0.f};
#pragma unroll
    for (int ks = 0; ks < 4; ++ks) {
        bf16x8 a[2], bb[4];
#pragma unroll
        for (int m = 0; m < 2; ++m) a[m] = lds_frag256(vL, 32 * wid + 16 * m + fr, 4 * ks + fq);
        float dec[8];
#pragma unroll
        for (int j = 0; j < 8; ++j) dec[j] = exp2f((float)(127 - (32 * ks + 8 * fq + j)) * lg2);
#pragma unroll
        for (int nt = 0; nt < 4; ++nt) {
            const int d = 16 * nt + fr;
            float v[8];
#pragma unroll
            for (int j = 0; j < 8; ++j) {
                const int tk = 32 * ks + 8 * fq + j;
                const bf16_t kvv = *(const bf16_t*)(kL + tk * 128 + (((d >> 3) ^ (tk & 7)) << 4) + (d & 7) * 2);
                v[j] = bf2f(kvv) * dec[j];
            }
            u32x4 w; w.x = pack2(v[0], v[1]); w.y = pack2(v[2], v[3]); w.z = pack2(v[4], v[5]); w.w = pack2(v[6], v[7]);
            bb[nt] = __builtin_bit_cast(bf16x8, w);
        }
#pragma unroll
        for (int m = 0; m < 2; ++m)
#pragma unroll
            for (int nt = 0; nt < 4; ++nt) acc[m][nt] = mfma16(a[m], bb[nt], acc[m][nt]);
    }
    float* KVT = (float*)(ws + WS_KVT) + ((size_t)(b * 8 + h) * 64 + n) * 8192;
#pragma unroll
    for (int m = 0; m < 2; ++m)
#pragma unroll
        for (int nt = 0; nt < 4; ++nt)
#pragma unroll
            for (int r = 0; r < 4; ++r) KVT[(32 * wid + 16 * m + 4 * fq + r) * 64 + 16 * nt + fr] = acc[m][nt][r];
    __syncthreads();
}

__device__ __forceinline__ void phase_p2(const Params& p, int layer, unsigned char* lds, int half) {
    const int vb = blockIdx.x * 2 + half, nvb = gridDim.x * 2;
    if (vb < 32) compress_item(p, layer, vb, lds, half);
    else for (int it = vb - 32; it < 1024; it += nvb - 32) retkv_item(p, it, lds, half);
}

constexpr int NSA_IMP = 32768, NSA_BUCKET = 65792, NSA_BIAS = 73984;

struct NsaLane { int t; int fr, fq, wid, lane; };

template <int BR, int PASS>
__device__ __forceinline__ void nsa_half(const unsigned char* kL, const unsigned char* vL, const unsigned char* lds, const bf16x8 (&qptr)[4][2],
                                         f32x4 (&O)[4][4], float (&m)[4], float (&l)[4], int tile, int hf, bool selbit, const NsaLane& L, int qrow) {
    const int fr = L.fr, fq = L.fq;
    bf16x8 Kf[2][2];
#pragma unroll
    for (int i = 0; i < 2; ++i)
#pragma unroll
        for (int ks = 0; ks < 2; ++ks) Kf[i][ks] = lds_frag128(kL, 32 * hf + 16 * i + fr, 4 * ks + fq);
    bf16x8 Vf[4];
    if (PASS != 0) {
#pragma unroll
        for (int mt = 0; mt < 4; ++mt) Vf[mt] = lds_vfrag128(vL, 16 * mt + fr, 32 * hf, fq);
    }
    unsigned vmask = 0; unsigned bk[2];
    const unsigned char* bucketL = lds + NSA_BUCKET;
#pragma unroll
    for (int i = 0; i < 2; ++i) {
        unsigned pk = 0;
#pragma unroll
        for (int r = 0; r < 4; ++r) {
            const int kk = 32 * hf + 16 * i + 4 * fq + r;
            int rel; bool ok;
            if (BR == 0) { rel = L.t - (16 * (64 * tile + kk) + 31); ok = rel >= 0; }
            else if (BR == 1) { rel = L.t - (64 * tile + kk); ok = selbit && rel >= 0; }
            else { rel = L.t - (64 * tile + kk); ok = rel >= 0 && rel < 512; }
            int rc = rel < 0 ? 0 : rel; rc = rc > 8191 ? 8191 : rc;
            pk |= (unsigned)bucketL[rc] << (8 * r);
            vmask |= (ok ? 1u : 0u) << (4 * i + r);
        }
        bk[i] = pk;
    }
    const float* biasL = (const float*)(lds + NSA_BIAS);
    float ia[2] = {0.f, 0.f}, ic[2] = {0.f, 0.f};
#pragma unroll
    for (int nt = 0; nt < 4; ++nt) {
        f32x4 S[2];
        const bf16x8 q0 = qptr[nt][0], q1 = qptr[nt][1];
#pragma unroll
        for (int i = 0; i < 2; ++i) {
            S[i] = (f32x4){0.f, 0.f, 0.f, 0.f};
            S[i] = mfma16(Kf[i][0], q0, S[i]); S[i] = mfma16(Kf[i][1], q1, S[i]);
        }
        float tmax = -1e30f;
        float bsv[2][4];
#pragma unroll
        for (int i = 0; i < 2; ++i)
#pragma unroll
            for (int r = 0; r < 4; ++r) bsv[i][r] = biasL[nt * 32 + ((bk[i] >> (8 * r)) & 0xffu)];
        asm volatile("" : "+v"(bsv[0][0]), "+v"(bsv[0][1]), "+v"(bsv[0][2]), "+v"(bsv[0][3]), "+v"(bsv[1][0]), "+v"(bsv[1][1]), "+v"(bsv[1][2]), "+v"(bsv[1][3]));
#pragma unroll
        for (int i = 0; i < 2; ++i)
#pragma unroll
            for (int r = 0; r < 4; ++r) {
                const bool ok = (vmask >> (4 * i + r)) & 1u;
                const float sv = S[i][r] * 0.125f + bsv[i][r];
                S[i][r] = ok ? sv : -1e30f; tmax = fmaxf(tmax, S[i][r]);
            }
        if (PASS != 1) {
            tmax = rows_max(tmax);
            const float mnew = fmaxf(m[nt], tmax), alpha = __expf(m[nt] - mnew);
            float psum = 0.f;
#pragma unroll
            for (int i = 0; i < 2; ++i)
#pragma unroll
                for (int r = 0; r < 4; ++r) {
                    const bool ok = (vmask >> (4 * i + r)) & 1u;
                    const float pv = ok ? __expf(S[i][r] - mnew) : 0.f;
                    S[i][r] = pv; psum += pv;
                }
            psum = rows_sum(psum);
            l[nt] = l[nt] * alpha + psum; m[nt] = mnew;
            if (PASS == 2) {
#pragma unroll
                for (int mt = 0; mt < 4; ++mt) O[mt][nt] = O[mt][nt] * alpha;
            }
        } else {
#pragma unroll
            for (int i = 0; i < 2; ++i) {
#pragma unroll
                for (int r = 0; r < 4; ++r) {
                    const bool ok = (vmask >> (4 * i + r)) & 1u;
                    S[i][r] = ok ? __expf(S[i][r] - m[nt]) * l[nt] : 0.f;
                }
                ia[i] += S[i][0] + S[i][1] + S[i][2] + 0.5f * S[i][3];
                ic[i] += 0.5f * S[i][3];
            }
        }
        if (PASS != 0) {
            const bf16x8 Pb = pack8(S[0], S[1]);
#pragma unroll
            for (int mt = 0; mt < 4; ++mt) O[mt][nt] = mfma16(Vf[mt], Pb, O[mt][nt]);
        }
    }
    if (PASS == 1) {
        float* imp = (float*)(lds + NSA_IMP) + qrow * 129;
        asm volatile("" ::: "memory"); __builtin_amdgcn_wave_barrier();
#pragma unroll
        for (int i = 0; i < 2; ++i) { const int j = 16 * tile + 8 * hf + 4 * i + fq; imp[j] += ia[i]; }
        asm volatile("s_waitcnt lgkmcnt(0)" ::: "memory"); __builtin_amdgcn_wave_barrier();
#pragma unroll
        for (int i = 0; i < 2; ++i) { const int j = 16 * tile + 8 * hf + 4 * i + fq + 1; if (j < 128) imp[j] += ic[i]; }
        asm volatile("s_waitcnt lgkmcnt(0)" ::: "memory"); __builtin_amdgcn_wave_barrier();
    }
}
template <int BR, int PASS>
__device__ __forceinline__ void nsa_tile(const unsigned char* kL, const unsigned char* vL, const unsigned char* lds, const bf16x8 (&qptr)[4][2],
                                         f32x4 (&O)[4][4], float (&m)[4], float (&l)[4], int tile, bool selbit, const NsaLane& L, int qrow) {
#pragma unroll 1
    for (int hf = 0; hf < 2; ++hf) nsa_half<BR, PASS>(kL, vL, lds, qptr, O, m, l, tile, hf, selbit, L, qrow);
}

__device__ __forceinline__ void cmp_item(const Params& p, int item, unsigned char* lds, int half) {
    unsigned char* ws = launder(p.ws);
    const int tid = (ltid() & 255), lane = tid & 63, wid = tid >> 6, fr = lane & 15, fq = lane >> 4;
    const int combo = item & 3, qt = 127 - (item >> 2), b = combo >> 1, g = combo & 1;
    const int q0 = qt * 64, qrow = 16 * wid + fr;
    NsaLane L; L.t = q0 + qrow; L.fr = fr; L.fq = fq; L.wid = wid; L.lane = lane;
    const size_t tok = (size_t)b * S_ + L.t;
    const bf16_t* P = (const bf16_t*)(ws + WS_P);
    __syncthreads();
    if (tid < 128) ((float*)(lds + NSA_BIAS))[tid] = p.rel_bias[(tid & 31) * 8 + 4 * g + (tid >> 5)];
    for (int i = tid; i < 64 * 129; i += HT) ((float*)(lds + NSA_IMP))[i] = 0.f;
    bf16x8 Qf[4][2];
#pragma unroll
    for (int nt = 0; nt < 4; ++nt)
#pragma unroll
        for (int ks = 0; ks < 2; ++ks) Qf[nt][ks] = *(const bf16x8*)(P + tok * LD + C_QA + (4 * g + nt) * 64 + 32 * ks + 8 * fq);
    __syncthreads();
    f32x4 O[4][4]; float m[4], l[4];
    const bf16_t* gates = P + tok * LD + C_GA + (4 * g) * 3;
    const bf16_t* kc = (const bf16_t*)(ws + WS_KCC) + (size_t)(b * 2 + g) * 512 * 64;
    const bf16_t* vc = (const bf16_t*)(ws + WS_VCCT) + (size_t)(b * 2 + g) * 64 * 512;
    const int ntc = ((q0 + 32) >> 4) / 64 + 1;
#pragma unroll
    for (int nt = 0; nt < 4; ++nt) { m[nt] = -1e30f; l[nt] = 0.f; }
    load_tile64(kc, 64, lds, wid, lane);
    wait_vm0(); __syncthreads();
    for (int it = 0; it < ntc; ++it) {
        unsigned char* cur = lds + (it & 1) * 16384;
        if (it + 1 < ntc) load_tile64(kc + (size_t)(it + 1) * 64 * 64, 64, lds + ((it + 1) & 1) * 16384, wid, lane);
        nsa_tile<0, 0>(cur, cur + 8192, lds, Qf, O, m, l, it, true, L, qrow);
        wait_vm0(); __syncthreads();
    }
#pragma unroll
    for (int nt = 0; nt < 4; ++nt) l[nt] = l[nt] > 0.f ? 1.f / l[nt] : 0.f;
#pragma unroll
    for (int mt = 0; mt < 4; ++mt)
#pragma unroll
        for (int nt = 0; nt < 4; ++nt) O[mt][nt] = (f32x4){0.f, 0.f, 0.f, 0.f};
    load_tile64(kc, 64, lds, wid, lane); load_tile64(vc, 512, lds + 8192, wid, lane);
    wait_vm0(); __syncthreads();
    for (int it = 0; it < ntc; ++it) {
        unsigned char* cur = lds + (it & 1) * 16384;
        if (it + 1 < ntc) { unsigned char* nx = lds + ((it + 1) & 1) * 16384;
            load_tile64(kc + (size_t)(it + 1) * 64 * 64, 64, nx, wid, lane); load_tile64(vc + (it + 1) * 64, 512, nx + 8192, wid, lane); }
        nsa_tile<0, 1>(cur, cur + 8192, lds, Qf, O, m, l, it, true, L, qrow);
        wait_vm0(); __syncthreads();
    }
    bf16_t* YC = (bf16_t*)(ws + WS_YC) + tok * 512 + (4 * g) * 64;
#pragma unroll
    for (int nt = 0; nt < 4; ++nt) {
        const float gt = bf2f(gates[nt * 3 + 0]);
#pragma unroll
        for (int mt = 0; mt < 4; ++mt) *(u32x2*)(YC + nt * 64 + 16 * mt + 4 * fq) = pack4(O[mt][nt] * gt);
    }
    const int cur = qt;
    {
        float* imp = (float*)(lds + NSA_IMP) + qrow * 129 + 32 * fq;
        asm volatile("s_waitcnt lgkmcnt(0)" ::: "memory"); __builtin_amdgcn_wave_barrier();
#pragma unroll
        for (int i = 0; i < 32; ++i) {
            const int j = 32 * fq + i;
            const float v = imp[i];
            imp[i] = j > cur ? -1.f : v + ((j == 0 || j == cur || j == cur - 1) ? 1.0e4f : 0.f);
        }
        unsigned word = 0;
#pragma unroll 1
        for (int round = 0; round < 16; ++round) {
            float bv = imp[0]; int bi = 0;
#pragma unroll
            for (int i = 1; i < 32; ++i) { const float v = imp[i]; if (v > bv) { bv = v; bi = i; } }
            int gi = 32 * fq + bi;
            {
                u32x2 rv = __builtin_amdgcn_permlane16_swap(__float_as_uint(bv), __float_as_uint(bv), false, false);
                u32x2 ri = __builtin_amdgcn_permlane16_swap((unsigned)gi, (unsigned)gi, false, false);
                float v0 = __uint_as_float(rv.x), v1 = __uint_as_float(rv.y); int i0 = (int)ri.x, i1 = (int)ri.y;
                if (v1 > v0 || (v1 == v0 && i1 < i0)) { v0 = v1; i0 = i1; }
                rv = __builtin_amdgcn_permlane32_swap(__float_as_uint(v0), __float_as_uint(v0), false, false);
                ri = __builtin_amdgcn_permlane32_swap((unsigned)i0, (unsigned)i0, false, false);
                v0 = __uint_as_float(rv.x); v1 = __uint_as_float(rv.y); i0 = (int)ri.x; i1 = (int)ri.y;
                if (v1 > v0 || (v1 == v0 && i1 < i0)) { v0 = v1; i0 = i1; }
                bv = v0; gi = i0;
            }
            if (bv >= 0.f && (gi >> 5) == fq) { word |= 1u << (gi & 31); imp[gi & 31] = -2.f; }
        }
        ((unsigned*)(ws + WS_SELW))[(tok * 2 + g) * 4 + fq] = word;
    }
}

__device__ __forceinline__ void win_item(const Params& p, int item, unsigned char* lds, int half) {
    unsigned char* ws = launder(p.ws);
    const int tid = (ltid() & 255), lane = tid & 63, wid = tid >> 6, fr = lane & 15, fq = lane >> 4;
    const int combo = item & 3, qt = 127 - (item >> 2), b = combo >> 1, g = combo & 1;
    const int q0 = qt * 64, qrow = 16 * wid + fr;
    NsaLane L; L.t = q0 + qrow; L.fr = fr; L.fq = fq; L.wid = wid; L.lane = lane;
    const size_t tok = (size_t)b * S_ + L.t;
    const bf16_t* P = (const bf16_t*)(ws + WS_P);
    __syncthreads();
    if (tid < 128) ((float*)(lds + NSA_BIAS))[tid] = p.rel_bias[(tid & 31) * 8 + 4 * g + (tid >> 5)];
    bf16x8 Qf[4][2];
#pragma unroll
    for (int nt = 0; nt < 4; ++nt)
#pragma unroll
        for (int ks = 0; ks < 2; ++ks) Qf[nt][ks] = *(const bf16x8*)(P + tok * LD + C_QA + (4 * g + nt) * 64 + 32 * ks + 8 * fq);
    __syncthreads();
    f32x4 O[4][4]; float m[4], l[4];
    const bf16_t* gates = P + tok * LD + C_GA + (4 * g) * 3;
#pragma unroll
    for (int nt = 0; nt < 4; ++nt) { m[nt] = -1e30f; l[nt] = 0.f; }
#pragma unroll
    for (int mt = 0; mt < 4; ++mt)
#pragma unroll
        for (int nt = 0; nt < 4; ++nt) O[mt][nt] = (f32x4){0.f, 0.f, 0.f, 0.f};
    {
        const bf16_t* kb = P + ((size_t)b * S_) * LD + C_KW + g * 64;
        const bf16_t* vb = (const bf16_t*)(ws + WS_VWT) + (size_t)(b * 2 + g) * 64 * S_;
        const int k_lo = qt - 8 > 0 ? qt - 8 : 0, ntw = qt - k_lo + 1;
        load_tile64(kb + (size_t)k_lo * 64 * LD, LD, lds, wid, lane); load_tile64(vb + k_lo * 64, S_, lds + 8192, wid, lane);
        wait_vm0(); __syncthreads();
        for (int it = 0; it < ntw; ++it) {
            unsigned char* cu = lds + (it & 1) * 16384;
            if (it + 1 < ntw) { unsigned char* nx = lds + ((it + 1) & 1) * 16384;
                load_tile64(kb + (size_t)(k_lo + it + 1) * 64 * LD, LD, nx, wid, lane); load_tile64(vb + (k_lo + it + 1) * 64, S_, nx + 8192, wid, lane); }
            nsa_tile<2, 2>(cu, cu + 8192, lds, Qf, O, m, l, k_lo + it, true, L, qrow);
            wait_vm0(); __syncthreads();
        }
    }
    bf16_t* YW = (bf16_t*)(ws + WS_YW) + tok * 512 + (4 * g) * 64;
#pragma unroll
    for (int nt = 0; nt < 4; ++nt) {
        const float gt = bf2f(gates[nt * 3 + 2]) * (l[nt] > 0.f ? 1.f / l[nt] : 0.f);
#pragma unroll
        for (int mt = 0; mt < 4; ++mt) *(u32x2*)(YW + nt * 64 + 16 * mt + 4 * fq) = pack4(O[mt][nt] * gt);
    }
}

constexpr int SEL_RING = 8, SEL_BUCKET = SEL_RING * 16384, SEL_BIAS2 = SEL_BUCKET + 8192;
constexpr float LOG2E = 1.4426950408889634f;
__device__ __forceinline__ int t5_first(int bk) {
    const int th[16] = {16, 22, 30, 40, 54, 73, 99, 134, 182, 246, 332, 450, 609, 825, 1117, 1513};
    int r = 16;
#pragma unroll
    for (int k = 0; k < 16; ++k) r = (bk == 16 + k) ? th[k] : r;
    return r;
}
template <bool FAST>
__device__ __forceinline__ void sel_ntile(const bf16x8 (&Kf)[4][2], const unsigned char* vL, int fr, int fq, const bf16x8& q0, const bf16x8& q1, f32x4 (&O)[4], float& m, float& l,
                                          bool sb, int relb, int th, float blo, float bhi, const unsigned char* lds, int hl) {
    f32x4 S[4];
#pragma unroll
    for (int i = 0; i < 4; ++i) { S[i] = (f32x4){0.f, 0.f, 0.f, 0.f}; S[i] = mfma16(Kf[i][0], q0, S[i]); S[i] = mfma16(Kf[i][1], q1, S[i]); }
    float tmax = -1e30f;
    const float scl = (!FAST || sb) ? 0.125f * LOG2E : 0.f;
    if (FAST) { blo = (sb ? blo : -1e30f) - m; bhi = (sb ? bhi : -1e30f) - m; }
    if (FAST) {
#pragma unroll
        for (int i = 0; i < 4; ++i)
#pragma unroll
            for (int r = 0; r < 4; ++r) { const int rel = relb - (16 * i + r); S[i][r] = S[i][r] * scl + (rel >= th ? bhi : blo); tmax = fmaxf(tmax, S[i][r]); }
    } else {
        unsigned bkt[4][4]; float bs[4][4];
#pragma unroll
        for (int i = 0; i < 4; ++i)
#pragma unroll
            for (int r = 0; r < 4; ++r) { const int rel = relb - (16 * i + r); int rc = rel < 0 ? 0 : rel; rc = rc > 8191 ? 8191 : rc; bkt[i][r] = (lds + SEL_BUCKET)[rc]; }
#pragma unroll
        for (int i = 0; i < 4; ++i)
#pragma unroll
            for (int r = 0; r < 4; ++r) bs[i][r] = ((const float*)(lds + SEL_BIAS2))[hl * 32 + bkt[i][r]];
        asm volatile("" : "+v"(bs[0][0]), "+v"(bs[0][1]), "+v"(bs[0][2]), "+v"(bs[0][3]), "+v"(bs[1][0]), "+v"(bs[1][1]), "+v"(bs[1][2]), "+v"(bs[1][3]),
                          "+v"(bs[2][0]), "+v"(bs[2][1]), "+v"(bs[2][2]), "+v"(bs[2][3]), "+v"(bs[3][0]), "+v"(bs[3][1]), "+v"(bs[3][2]), "+v"(bs[3][3]));
        const float ninf = -1e30f;
#pragma unroll
        for (int i = 0; i < 4; ++i)
#pragma unroll
            for (int r = 0; r < 4; ++r) {
                const int rel = relb - (16 * i + r);
                const float sv = S[i][r] * (0.125f * LOG2E) + (bs[i][r] - m);
                S[i][r] = (sb && rel >= 0) ? sv : ninf; tmax = fmaxf(tmax, S[i][r]);
            }
    }
    tmax = rows_max(tmax);
    if (__ballot(tmax > 8.f) != 0ull) {
        const float d = fmaxf(tmax, 0.f), alpha = __builtin_amdgcn_exp2f(-d);
        m += d; l *= alpha;
#pragma unroll
        for (int mt = 0; mt < 4; ++mt) O[mt] = O[mt] * alpha;
#pragma unroll
        for (int i = 0; i < 4; ++i)
#pragma unroll
            for (int r = 0; r < 4; ++r) S[i][r] -= d;
    }
    float psum = 0.f;
#pragma unroll
    for (int i = 0; i < 4; ++i)
#pragma unroll
        for (int r = 0; r < 4; ++r) { const float pv = __builtin_amdgcn_exp2f(S[i][r]); S[i][r] = pv; psum += pv; }
    l += rows_sum(psum);
    const bf16x8 Pb0 = pack8(S[0], S[1]), Pb1 = pack8(S[2], S[3]);
#pragma unroll
    for (int mt = 0; mt < 4; ++mt) { O[mt] = mfma16(lds_vfrag128(vL, 16 * mt + fr, 0, fq), Pb0, O[mt]); O[mt] = mfma16(lds_vfrag128(vL, 16 * mt + fr, 32, fq), Pb1, O[mt]); }
}
__device__ __forceinline__ void sel_ntile2_fast(const bf16x8 (&Kf)[4][2], const unsigned char* vL, int fr, int fq, const bf16x8 (&Qf)[2][2], f32x4 (&O)[2][4], float (&m)[2], float (&l)[2],
                                                const bool (&sb)[2], const int (&relb)[2], int th, float blo, float bhi) {
    f32x4 S[2][4]; float tmax[2], bl[2], bh[2], scl[2];
#pragma unroll
    for (int b = 0; b < 2; ++b)
#pragma unroll
        for (int i = 0; i < 4; ++i) { S[b][i] = (f32x4){0.f, 0.f, 0.f, 0.f}; S[b][i] = mfma16(Kf[i][0], Qf[b][0], S[b][i]); S[b][i] = mfma16(Kf[i][1], Qf[b][1], S[b][i]); }
#pragma unroll
    for (int b = 0; b < 2; ++b) { scl[b] = sb[b] ? 0.125f * LOG2E : 0.f; bl[b] = (sb[b] ? blo : -1e30f) - m[b]; bh[b] = (sb[b] ? bhi : -1e30f) - m[b]; tmax[b] = -1e30f; }
#pragma unroll
    for (int b = 0; b < 2; ++b)
#pragma unroll
        for (int i = 0; i < 4; ++i)
#pragma unroll
            for (int r = 0; r < 4; ++r) { const int rel = relb[b] - (16 * i + r); S[b][i][r] = S[b][i][r] * scl[b] + (rel >= th ? bh[b] : bl[b]); tmax[b] = fmaxf(tmax[b], S[b][i][r]); }
#pragma unroll
    for (int b = 0; b < 2; ++b) tmax[b] = rows_max(tmax[b]);
    if (__ballot(tmax[0] > 8.f || tmax[1] > 8.f) != 0ull) {
#pragma unroll
        for (int b = 0; b < 2; ++b) {
            const float d = fmaxf(tmax[b], 0.f), alpha = __builtin_amdgcn_exp2f(-d);
            m[b] += d; l[b] *= alpha;
#pragma unroll
            for (int mt = 0; mt < 4; ++mt) O[b][mt] = O[b][mt] * alpha;
#pragma unroll
            for (int i = 0; i < 4; ++i)
#pragma unroll
                for (int r = 0; r < 4; ++r) S[b][i][r] -= d;
        }
    }
    float psum[2] = {0.f, 0.f};
#pragma unroll
    for (int b = 0; b < 2; ++b)
#pragma unroll
        for (int i = 0; i < 4; ++i)
#pragma unroll
            for (int r = 0; r < 4; ++r) { const float pv = __builtin_amdgcn_exp2f(S[b][i][r]); S[b][i][r] = pv; psum[b] += pv; }
#pragma unroll
    for (int b = 0; b < 2; ++b) l[b] += rows_sum(psum[b]);
    bf16x8 P0[2], P1[2];
#pragma unroll
    for (int b = 0; b < 2; ++b) { P0[b] = pack8(S[b][0], S[b][1]); P1[b] = pack8(S[b][2], S[b][3]); }
#pragma unroll
    for (int mt = 0; mt < 4; ++mt) {
        const bf16x8 v0 = lds_vfrag128(vL, 16 * mt + fr, 0, fq), v1 = lds_vfrag128(vL, 16 * mt + fr, 32, fq);
#pragma unroll
        for (int b = 0; b < 2; ++b) { O[b][mt] = mfma16(v0, P0[b], O[b][mt]); O[b][mt] = mfma16(v1, P1[b], O[b][mt]); }
    }
}
template <bool FAST>
__device__ __forceinline__ void sel_tile(const unsigned char* kL, const unsigned char* vL, const unsigned char* lds, const bf16x8 (&Qf)[2][2], f32x4 (&O)[2][4], float (&m)[2], float (&l)[2],
                                         const bool (&sb)[2], const bool (&need)[2], const int (&relb)[2], int th, float blo, float bhi, int hl, int fr, int fq) {
    bf16x8 Kf[4][2];
#pragma unroll
    for (int i = 0; i < 4; ++i)
#pragma unroll
        for (int ks = 0; ks < 2; ++ks) Kf[i][ks] = lds_frag128(kL, 16 * i + fr, 4 * ks + fq);
    if (FAST && need[0] && need[1]) { sel_ntile2_fast(Kf, vL, fr, fq, Qf, O, m, l, sb, relb, th, blo, bhi); return; }
    if (need[0]) sel_ntile<FAST>(Kf, vL, fr, fq, Qf[0][0], Qf[0][1], O[0], m[0], l[0], sb[0], relb[0], th, blo, bhi, lds, hl);
    if (need[1]) sel_ntile<FAST>(Kf, vL, fr, fq, Qf[1][0], Qf[1][1], O[1], m[1], l[1], sb[1], relb[1], th, blo, bhi, lds, hl);
}
template <int VAR>
__device__ __forceinline__ void sel_item(const Params& p, int v, unsigned char* lds) {
    unsigned char* ws = launder(p.ws);
    const int tid = ltid(), lane = tid & 63, wid = tid >> 6, fr = lane & 15, fq = lane >> 4;
    const int qt = 127 - (v >> 2), sub = v & 3, b = sub >> 1, g = sub & 1;
    const int q0 = qt * 64, cur = qt, hl = fr & 3;
    const bf16_t* P = (const bf16_t*)(ws + WS_P);
    __syncthreads();
    if (tid < 128) ((float*)(lds + SEL_BIAS2))[tid] = p.rel_bias[(tid & 31) * 8 + 4 * g + (tid >> 5)] * LOG2E;
    int t[2]; size_t tok[2]; bf16x8 Qf[2][2]; unsigned selw[2][4];
#pragma unroll
    for (int nt = 0; nt < 2; ++nt) {
        t[nt] = q0 + 8 * wid + 4 * nt + (fr >> 2); tok[nt] = (size_t)b * S_ + t[nt];
#pragma unroll
        for (int ks = 0; ks < 2; ++ks) Qf[nt][ks] = *(const bf16x8*)(P + tok[nt] * LD + C_QA + (4 * g + hl) * 64 + 32 * ks + 8 * fq);
        const u32x4 w = *(const u32x4*)((const unsigned*)(ws + WS_SELW) + (tok[nt] * 2 + g) * 4);
        selw[nt][0] = w.x; selw[nt][1] = w.y; selw[nt][2] = w.z; selw[nt][3] = w.w;
    }
    f32x4 O[2][4]; float m[2], l[2];
#pragma unroll
    for (int nt = 0; nt < 2; ++nt) { m[nt] = -1000.f; l[nt] = 0.f;
#pragma unroll
        for (int mt = 0; mt < 4; ++mt) O[nt][mt] = (f32x4){0.f, 0.f, 0.f, 0.f}; }
    const bf16_t* kb = P + ((size_t)b * S_) * LD + C_KS + g * 64;
    const bf16_t* vb = (const bf16_t*)(ws + WS_VST) + (size_t)(b * 2 + g) * 64 * S_;
    const int nts = cur + 1;
#define SEL_ISSUE(jj) do { unsigned char* st_ = lds + ((jj) & 7) * 16384; const int c_ = ((lane & 7) ^ (lane >> 3)) * 8, r_ = 8 * wid + (lane >> 3); \
        glds16(kb + ((size_t)(jj) * 64 + r_) * LD + c_, st_ + wid * 1024); glds16(vb + (size_t)r_ * S_ + (jj) * 64 + c_, st_ + 8192 + wid * 1024); } while (0)
    asm volatile("s_waitcnt vmcnt(0)" ::: "memory");
#pragma unroll
    for (int q = 0; q < 4; ++q) if (q < nts) SEL_ISSUE(q);
    const unsigned char* bucketL = lds + SEL_BUCKET;
    for (int jp = 0; jp < nts; jp += 4) {
        WAIT_V(0);
        RAW_BARRIER();
#pragma unroll
        for (int q = 4; q < 8; ++q) if (jp + q < nts) SEL_ISSUE(jp + q);
#pragma unroll 1
      for (int j = jp; j < jp + 4 && j < nts; ++j) {
        const unsigned char* cu = lds + (j & 7) * 16384;
        bool sb[2], need[2]; int relb[2];
#pragma unroll
        for (int nt = 0; nt < 2; ++nt) {
            const unsigned w = j < 32 ? selw[nt][0] : j < 64 ? selw[nt][1] : j < 96 ? selw[nt][2] : selw[nt][3];
            sb[nt] = (w >> (j & 31)) & 1u; need[nt] = __ballot(sb[nt]) != 0ull; relb[nt] = t[nt] - 64 * j - 4 * fq;
        }
        if (VAR == 1) { need[0] = false; need[1] = false; }
        if (VAR == 2) { if (!(need[0] || need[1])) { need[0] = false; } else { need[0] = true; need[1] = true; } }
        if (need[0] || need[1]) {
            const int rmin = q0 - 64 * j - 63, rmax = q0 + 31 - 64 * j;
            bool fast = false; int th = 0; float blo = 0.f, bhi = 0.f;
            if (rmin >= 16) {
                const int b0 = bucketL[rmin], b1 = bucketL[rmax > 8191 ? 8191 : rmax];
                if (b1 - b0 <= 1) { fast = true; th = t5_first(b1); if (b1 == b0) th = 0;
                    blo = ((const float*)(lds + SEL_BIAS2))[hl * 32 + b0]; bhi = ((const float*)(lds + SEL_BIAS2))[hl * 32 + b1]; }
            }
            if (fast) sel_tile<true>(cu, cu + 8192, lds, Qf, O, m, l, sb, need, relb, th, blo, bhi, hl, fr, fq);
            else sel_tile<false>(cu, cu + 8192, lds, Qf, O, m, l, sb, need, relb, th, blo, bhi, hl, fr, fq);
        }
      }
    }
#undef SEL_ISSUE
    __syncthreads();
#pragma unroll
    for (int nt = 0; nt < 2; ++nt) {
        const float gt = bf2f(P[tok[nt] * LD + C_GA + (4 * g + hl) * 3 + 1]) * (l[nt] > 0.f ? 1.f / l[nt] : 0.f);
        const size_t o = tok[nt] * 512 + (4 * g + hl) * 64;
#pragma unroll
        for (int mt = 0; mt < 4; ++mt) {
            const f32x4 yc = unpack4(*(const u32x2*)((const bf16_t*)(ws + WS_YC) + o + 16 * mt + 4 * fq));
            const f32x4 yw = unpack4(*(const u32x2*)((const bf16_t*)(ws + WS_YW) + o + 16 * mt + 4 * fq));
            if (VAR == 0 || VAR == 3) *(u32x2*)((bf16_t*)(ws + WS_YA) + o + 16 * mt + 4 * fq) = pack4(yc + yw + O[nt][mt] * gt);
            else asm volatile("" :: "v"(O[nt][mt]));
        }
    }
}

__device__ __forceinline__ void scan_item(const Params& p, int item, int half) {
    unsigned char* ws = launder(p.ws);
    const int idx = item * HT + (ltid() & 255);
    const int bh = idx >> 13, ed = idx & 8191, h = bh & 7;
    const float dec = exp2f(128.f * ret_lg2(h));
    const float* KVT = (const float*)(ws + WS_KVT) + (size_t)bh * 64 * 8192 + ed;
    bf16_t* SPT = (bf16_t*)(ws + WS_SPT) + (size_t)bh * 64 * 8192 + ed;
    float s = 0.f;
    for (int n = 0; n < 64; ++n) { SPT[(size_t)n * 8192] = f2bf(s); s = s * dec + KVT[(size_t)n * 8192]; }
}

__device__ __forceinline__ void phase_p3(const Params& p, unsigned char* lds, int half, int what) {
    for (int i = (ltid() & 255); i < 8192 / 16; i += HT) ((u32x4*)(lds + NSA_BUCKET))[i] = ((const u32x4*)(launder(p.ws) + WS_BUCKET))[i];
    __syncthreads();
    for (int h = (blockIdx.x * 2 + half); h < 512; h += (gridDim.x * 2)) {
        if (what & 1) cmp_item(p, h, lds, half);
        if (what & 2) {
            if (h >= 128 && h < 384) win_item(p, h - 128, lds, half);
            else if (h >= 384) { win_item(p, 256 + 2 * (h - 384) - ((h & 1) ? 1 : 0) , lds, half); win_item(p, 256 + 2 * (h - 384) + ((h & 1) ? 0 : 1) + 1 - ((h & 1) ? 0 : 0), lds, half); }
        }
        if (what & 4) scan_item(p, h, half);
    }
}

__device__ __forceinline__ void retout_item(const Params& p, int item, unsigned char* lds, int half) {
    unsigned char* ws = launder(p.ws);
    const int tid = (ltid() & 255), lane = tid & 63, wid = tid >> 6, fr = lane & 15, fq = lane >> 4;
    const int n = item & 63, h = (item >> 6) & 7, b = item >> 9;
    const size_t tok0 = (size_t)b * S_ + 128 * n;
    const bf16_t* P = (const bf16_t*)(ws + WS_P);
    unsigned char* vL = lds; unsigned char* kL = lds + 32768; unsigned char* sL = lds + 49152;
    __syncthreads();
    load_tile128w((const bf16_t*)(ws + WS_VRT) + ((size_t)(b * 8 + h) * 128) * S_ + 128 * n, S_, vL, wid, lane);
    load_tile128(P + tok0 * LD + C_KR + h * 64, LD, kL, wid, lane);
    load_tile128((const bf16_t*)(ws + WS_SPT) + ((size_t)(b * 8 + h) * 64 + n) * 8192, 64, sL, wid, lane);
    bf16x8 Qf[2][2];
#pragma unroll
    for (int nt = 0; nt < 2; ++nt)
#pragma unroll
        for (int ks = 0; ks < 2; ++ks) Qf[nt][ks] = *(const bf16x8*)(P + (tok0 + 32 * wid + 16 * nt + fr) * LD + C_QR + h * 64 + 32 * ks + 8 * fq);
    wait_vm0(); __syncthreads();
    const float lg2 = ret_lg2(h);
    f32x4 Y[8][2];
#pragma unroll
    for (int m = 0; m < 8; ++m)
#pragma unroll
        for (int nt = 0; nt < 2; ++nt) Y[m][nt] = (f32x4){0.f, 0.f, 0.f, 0.f};
#pragma unroll
    for (int m = 0; m < 8; ++m)
#pragma unroll
        for (int ks = 0; ks < 2; ++ks) {
            const bf16x8 a = lds_frag128(sL, 16 * m + fr, 4 * ks + fq);
#pragma unroll
            for (int nt = 0; nt < 2; ++nt) Y[m][nt] = mfma16(a, Qf[nt][ks], Y[m][nt]);
        }
#pragma unroll
    for (int nt = 0; nt < 2; ++nt) {
        const float sc = exp2f((float)(32 * wid + 16 * nt + fr + 1) * lg2);
#pragma unroll
        for (int m = 0; m < 8; ++m) Y[m][nt] = Y[m][nt] * sc;
    }
#pragma unroll 1
    for (int s = 0; s < 4; ++s) {
        f32x4 St[2][2];
#pragma unroll
        for (int hh = 0; hh < 2; ++hh) {
            const int mt = 2 * s + hh;
#pragma unroll
            for (int nt = 0; nt < 2; ++nt) St[hh][nt] = (f32x4){0.f, 0.f, 0.f, 0.f};
#pragma unroll
            for (int ks = 0; ks < 2; ++ks) {
                const bf16x8 a = lds_frag128(kL, 16 * mt + fr, 4 * ks + fq);
#pragma unroll
                for (int nt = 0; nt < 2; ++nt) St[hh][nt] = mfma16(a, Qf[nt][ks], St[hh][nt]);
            }
#pragma unroll
            for (int nt = 0; nt < 2; ++nt) {
                const int qi = 32 * wid + 16 * nt + fr;
#pragma unroll
                for (int r = 0; r < 4; ++r) {
                    const int kj = 16 * mt + 4 * fq + r;
                    const float dm = qi >= kj ? exp2f((float)(qi - kj) * lg2) : 0.f;
                    St[hh][nt][r] *= dm;
                }
            }
        }
        bf16x8 Pb[2];
#pragma unroll
        for (int nt = 0; nt < 2; ++nt) Pb[nt] = pack8(St[0][nt], St[1][nt]);
#pragma unroll
        for (int m = 0; m < 8; ++m) {
            const bf16x8 a = lds_vfrag256(vL, 16 * m + fr, 32 * s, fq);
#pragma unroll
            for (int nt = 0; nt < 2; ++nt) Y[m][nt] = mfma16(a, Pb[nt], Y[m][nt]);
        }
    }
    bf16_t* YB = (bf16_t*)(ws + WS_YB);
#pragma unroll
    for (int nt = 0; nt < 2; ++nt) {
        float sum = 0.f;
#pragma unroll
        for (int m = 0; m < 8; ++m) sum += Y[m][nt][0] + Y[m][nt][1] + Y[m][nt][2] + Y[m][nt][3];
        sum = rows_sum(sum);
        const float mu = sum * (1.f / 128.f);
        float vs = 0.f;
#pragma unroll
        for (int m = 0; m < 8; ++m)
#pragma unroll
            for (int r = 0; r < 4; ++r) { const float dlt = Y[m][nt][r] - mu; vs += dlt * dlt; }
        vs = rows_sum(vs);
        const float rstd = rsqrtf(vs * (1.f / 128.f) + 1e-5f);
        const size_t tk = tok0 + 32 * wid + 16 * nt + fr;
#pragma unroll
        for (int m = 0; m < 8; ++m) {
            const f32x4 gt = unpack4(*(const u32x2*)(P + tk * LD + C_GR + h * 128 + 16 * m + 4 * fq));
            f32x4 v;
#pragma unroll
            for (int r = 0; r < 4; ++r) v[r] = (Y[m][nt][r] - mu) * rstd * gt[r];
            *(u32x2*)(YB + tk * 1024 + h * 128 + 16 * m + 4 * fq) = pack4(v);
        }
    }
}
__device__ __forceinline__ void phase_p4_sel(const Params& p, unsigned char* lds) {
    for (int i = ltid(); i < 8192 / 16; i += NTHREADS) ((u32x4*)(lds + SEL_BUCKET))[i] = ((const u32x4*)(launder(p.ws) + WS_BUCKET))[i];
    __syncthreads();
    for (int it = blockIdx.x; it < 512; it += gridDim.x * 2) {
        sel_item<0>(p, it, lds);
        if (511 - it != it) sel_item<0>(p, 511 - it, lds);
    }
    __syncthreads();
}
__device__ __forceinline__ void phase_p4(const Params& p, unsigned char* lds, int half) {
    for (int it = (blockIdx.x * 2 + half); it < 1024; it += (gridDim.x * 2)) retout_item(p, it, lds, half);
}

struct RowOrder {     typedef pg8::Unit U; static constexpr bool GATHER = false;
    unsigned a, b; int K, xcd, slot, per;
    __device__ __forceinline__ bool next(int i, pg8::Unit& u) const { const int t = xcd * 32 + slot + i * per; if (t >= (xcd + 1) * 32) return false; u.pm = t >> 2; u.pn = t & 3; return true; }
    __device__ __forceinline__ void ptrs(const pg8::Unit& u, unsigned& A, unsigned& B) const { A = a + (unsigned)u.pm * 512u * (unsigned)K; B = b + (unsigned)u.pn * 512u * (unsigned)K; }
};
template <int MODE>
struct MixEpi {
    unsigned char* ws; const float* X;
    __device__ __forceinline__ void operator()(const f32x4 (&acc)[2][2][4][2], const pg8::Unit& u, int wr, int wc, int fr, int fq) const {
#pragma unroll
        for (int ai = 0; ai < 2; ++ai)
#pragma unroll
            for (int m = 0; m < 4; ++m) {
                const size_t tok = (size_t)(u.pm * 256 + 128 * ai + 64 * wr + 16 * m + fr + vzero());
#pragma unroll
                for (int bj = 0; bj < 2; ++bj) {
                    const int n = u.pn * 256 + 128 * bj + 32 * wc + 8 * fq;
                    const f32x4 v0 = acc[ai][bj][m][0], v1 = acc[ai][bj][m][1];
                    if (MODE == 2) {
                        const u32x4 xw = *(const u32x4*)((const bf16_t*)(ws + WS_XB) + tok * 1024 + n);
                        const f32x4 h0 = unpack4((u32x2){xw.x, xw.y}) * DN_ALPHA + v0, h1 = unpack4((u32x2){xw.z, xw.w}) * DN_ALPHA + v1;
                        u32x4 w; w.x = pack2(h0[0], h0[1]); w.y = pack2(h0[2], h0[3]); w.z = pack2(h1[0], h1[1]); w.w = pack2(h1[2], h1[3]);
                        *(u32x4*)((bf16_t*)(ws + WS_H1) + tok * 1024 + n) = w;
                    } else {
                        const u32x4 gw = *(const u32x4*)((const bf16_t*)(ws + WS_P) + tok * LD + (MODE == 0 ? C_MA : C_MB) + n);
                        const f32x4 g0 = unpack4((u32x2){gw.x, gw.y}), g1 = unpack4((u32x2){gw.z, gw.w});
                        f32x4 o0 = g0 * v0, o1 = g1 * v1;
                        bf16_t* MG = (bf16_t*)(ws + WS_MG) + tok * 1024 + n;
                        if (MODE == 1) { const u32x4 pw = *(const u32x4*)MG; o0 = o0 + unpack4((u32x2){pw.x, pw.y}); o1 = o1 + unpack4((u32x2){pw.z, pw.w}); }
                        u32x4 w; w.x = pack2(o0[0], o0[1]); w.y = pack2(o0[2], o0[3]); w.z = pack2(o1[0], o1[1]); w.w = pack2(o1[2], o1[3]);
                        *(u32x4*)MG = w;
                    }
                }
            }
    }
};
__device__ __forceinline__ void phase_g2(const Params& p, unsigned char* lds) {
    unsigned char* ws = launder(p.ws);
    RowOrder S; S.xcd = blockIdx.x & 7; S.slot = blockIdx.x >> 3; S.per = gridDim.x >> 3;
    { S.a = (unsigned)WS_YA; S.b = (unsigned)WS_WA; S.K = 512; MixEpi<0> E; E.ws = ws; E.X = nullptr; pg8::gemm_phase<MixEpi<0>, RowOrder>(lds, 512, S, E, ltid(), ws); }
    { S.a = (unsigned)WS_YB; S.b = (unsigned)WS_WB; S.K = 1024; MixEpi<1> E; E.ws = ws; E.X = nullptr; pg8::gemm_phase<MixEpi<1>, RowOrder>(lds, 1024, S, E, ltid(), ws); }
}
__device__ __forceinline__ void phase_g3(const Params& p, int layer, unsigned char* lds) {
    unsigned char* ws = launder(p.ws);
    RowOrder S; S.xcd = blockIdx.x & 7; S.slot = blockIdx.x >> 3; S.per = gridDim.x >> 3; S.a = (unsigned)WS_MG; S.b = (unsigned)WS_WO; S.K = 1024;
    MixEpi<2> E; E.ws = ws; E.X = nullptr;
    pg8::gemm_phase<MixEpi<2>, RowOrder>(lds, 1024, S, E, ltid(), ws);
}

__device__ __forceinline__ void phase_ln1(const Params& p, int layer, unsigned char* lds, bool dry, int half) {
    unsigned char* ws = launder(p.ws);
    const int tid = (ltid() & 255), lane = tid & 63, wid = tid >> 6;
    float* wrL = (float*)lds;
    float* lgL = (float*)(lds - half * HALF_LDS + 65536);
    {
        float4 wv[16];
#pragma unroll
        for (int k = 0; k < 16; ++k) wv[k] = ((const float4*)p.w_router)[tid + 256 * k];
#pragma unroll
        for (int k = 0; k < 16; ++k) { const int i4 = tid + 256 * k, d = i4 >> 2, e0 = (i4 & 3) * 4;
            wrL[(e0 + 0) * 1024 + d] = wv[k].x; wrL[(e0 + 1) * 1024 + d] = wv[k].y; wrL[(e0 + 2) * 1024 + d] = wv[k].z; wrL[(e0 + 3) * 1024 + d] = wv[k].w; }
    }
    __syncthreads();
    const bf16_t* H1 = (const bf16_t*)(ws + WS_H1);
    bf16_t* X1B = (bf16_t*)(ws + WS_X1B);
    const float* gam = p.ln1_g + layer * 1024; const float* bet = p.ln1_b + layer * 1024;
    unsigned* cnt = (unsigned*)(ws + WS_CTL) + (dry ? 0 : CW_CNT) + layer * 1024;
    int* LIST = (int*)(ws + (dry ? WS_HB : WS_LIST)); float* WTS = (float*)(ws + (dry ? WS_HB + 4194304 : WS_WTS));
    constexpr int U = 4;
    const int nwave = (gridDim.x * 2) * 4, wv = (blockIdx.x * 2 + half) * 4 + wid;
    const int nloc = ((T_ - wv * U + nwave * U - 1) / (nwave * U)) * (4 * U);
    u32x2 vn[U][4];
#pragma unroll
    for (int u = 0; u < U; ++u)
#pragma unroll
        for (int j = 0; j < 4; ++j) vn[u][j] = *(const u32x2*)(H1 + (size_t)(wv * U + u) * 1024 + 256 * j + 4 * lane);
    for (int t0 = wv * U; t0 < T_; t0 += nwave * U) {
        float4 y[U][4]; float s[U], q[U];
#pragma unroll
        for (int u = 0; u < U; ++u) {
            s[u] = 0.f;
#pragma unroll
            for (int j = 0; j < 4; ++j) { const f32x4 t = unpack4(vn[u][j]); y[u][j].x = t[0]; y[u][j].y = t[1]; y[u][j].z = t[2]; y[u][j].w = t[3]; s[u] += (t[0] + t[1]) + (t[2] + t[3]); }
        }
        { const int tn = t0 + nwave * U < T_ ? t0 + nwave * U : t0;
#pragma unroll
          for (int u = 0; u < U; ++u)
#pragma unroll
              for (int j = 0; j < 4; ++j) vn[u][j] = *(const u32x2*)(H1 + (size_t)(tn + u) * 1024 + 256 * j + 4 * lane); }
#pragma unroll
        for (int u = 0; u < U; ++u) s[u] = wave_sum(s[u]) * (1.f / 1024.f);
#pragma unroll
        for (int u = 0; u < U; ++u) {
            q[u] = 0.f;
#pragma unroll
            for (int j = 0; j < 4; ++j) { const float a = y[u][j].x - s[u], b2 = y[u][j].y - s[u], c = y[u][j].z - s[u], d = y[u][j].w - s[u]; q[u] += a * a + b2 * b2 + c * c + d * d; }
        }
#pragma unroll
        for (int u = 0; u < U; ++u) q[u] = rsqrtf(wave_sum(q[u]) * (1.f / 1024.f) + 1e-5f);
#pragma unroll
        for (int j = 0; j < 4; ++j) {
            const int d0 = 256 * j + 4 * lane;
            const float4 gg = *(const float4*)(gam + d0), bb = *(const float4*)(bet + d0);
#pragma unroll
            for (int u = 0; u < U; ++u) {
                y[u][j].x = (y[u][j].x - s[u]) * q[u] * gg.x + bb.x; y[u][j].y = (y[u][j].y - s[u]) * q[u] * gg.y + bb.y;
                y[u][j].z = (y[u][j].z - s[u]) * q[u] * gg.z + bb.z; y[u][j].w = (y[u][j].w - s[u]) * q[u] * gg.w + bb.w;
                u32x2 w; w.x = pack2(y[u][j].x, y[u][j].y); w.y = pack2(y[u][j].z, y[u][j].w);
                *(u32x2*)(X1B + (size_t)(t0 + u) * 1024 + d0) = w;
            }
        }
        float lg[U][16];
#pragma unroll
        for (int e = 0; e < 16; ++e) {
#pragma unroll
            for (int u = 0; u < U; ++u) lg[u][e] = 0.f;
#pragma unroll
            for (int j = 0; j < 4; ++j) { const float4 w4 = *(const float4*)(wrL + e * 1024 + 256 * j + 4 * lane);
#pragma unroll
                for (int u = 0; u < U; ++u) lg[u][e] += y[u][j].x * w4.x + y[u][j].y * w4.y + y[u][j].z * w4.z + y[u][j].w * w4.w; }
        }
        float myl = 0.f;
#pragma unroll
        for (int u = 0; u < U; ++u) {
            float w8[8], z4[4];
#pragma unroll
            for (int e = 0; e < 8; ++e) { const u32x2 r = __builtin_amdgcn_permlane32_swap(__float_as_uint(lg[u][e]), __float_as_uint(lg[u][e + 8]), false, false); w8[e] = __uint_as_float(r.x) + __uint_as_float(r.y); }
#pragma unroll
            for (int e = 0; e < 4; ++e) { const u32x2 r = __builtin_amdgcn_permlane16_swap(__float_as_uint(w8[e]), __float_as_uint(w8[e + 4]), false, false); z4[e] = __uint_as_float(r.x) + __uint_as_float(r.y); }
            const bool h8 = (lane & 8) != 0, h4 = (lane & 4) != 0;
            const float k0 = h8 ? z4[2] : z4[0], s0 = h8 ? z4[0] : z4[2], k1 = h8 ? z4[3] : z4[1], s1 = h8 ? z4[1] : z4[3];
            const float y0 = k0 + __int_as_float(__builtin_amdgcn_mov_dpp(__float_as_int(s0), 0x128, 0xF, 0xF, true));
            const float y1 = k1 + __int_as_float(__builtin_amdgcn_mov_dpp(__float_as_int(s1), 0x128, 0xF, 0xF, true));
            const float k2 = h4 ? y1 : y0, s2 = h4 ? y0 : y1;
            float x = k2 + __int_as_float(__builtin_amdgcn_mov_dpp(__float_as_int(s2), 0x141, 0xF, 0xF, true));
            x += __int_as_float(__builtin_amdgcn_mov_dpp(__float_as_int(x), 0xB1, 0xF, 0xF, true));
            x += __int_as_float(__builtin_amdgcn_mov_dpp(__float_as_int(x), 0x4E, 0xF, 0xF, true));
            if ((lane & 3) == u) myl = x;
        }
        static_assert(U == 4, "lane (l & 3) stores token u = l & 3");
        lgL[(half * nloc + ((t0 - wv * U) / (nwave * U)) * (4 * U) + wid * U + (lane & 3)) * 17 + (lane >> 2)] = myl;
    }
    __syncthreads();
    if (half == 0 && wid == 0)
    for (int l0 = 0; l0 < 2 * nloc; l0 += 64) {
        const int li = l0 + lane; const bool act = li < 2 * nloc;
        const int hq = li >= nloc ? 1 : 0, lh = li - hq * nloc;
        const int it = lh / (4 * U), wq = (lh / U) & 3, uq = lh % U, tok = act ? (((blockIdx.x * 2 + hq) * 4 + wq) * U + uq) + it * (nwave * U) : 0;
        float lgv[16];
#pragma unroll
        for (int e = 0; e < 16; ++e) lgv[e] = lgL[li * 17 + e];
        float mx = lgv[0];
#pragma unroll
        for (int e = 1; e < 16; ++e) mx = fmaxf(mx, lgv[e]);
        float pr[16], ps = 0.f;
#pragma unroll
        for (int e = 0; e < 16; ++e) { pr[e] = expf(lgv[e] - mx); ps += pr[e]; }
        const float ips = 1.f / ps;
        float sel[16];
#pragma unroll
        for (int e = 0; e < 16; ++e) { pr[e] *= ips; sel[e] = pr[e] + p.router_bias[e]; }
        int best = 0; float bestv = -1e30f;
#pragma unroll
        for (int gI = 0; gI < 4; ++gI) {
            float a = -1e30f, b2 = -1e30f;
#pragma unroll
            for (int k = 0; k < 4; ++k) { const float x = sel[4 * gI + k]; if (x > a) { b2 = a; a = x; } else if (x > b2) b2 = x; }
            const float gs = a + b2;
            if (gs > bestv) { bestv = gs; best = gI; }
        }
        float s4[4], p4[4];
#pragma unroll
        for (int k = 0; k < 4; ++k) { s4[k] = 0.f; p4[k] = 0.f; }
#pragma unroll
        for (int gI = 0; gI < 4; ++gI) if (gI == best) {
#pragma unroll
            for (int k = 0; k < 4; ++k) { s4[k] = sel[4 * gI + k]; p4[k] = pr[4 * gI + k]; }
        }
        int i0 = 0; float a0 = s4[0];
#pragma unroll
        for (int k = 1; k < 4; ++k) if (s4[k] > a0) { a0 = s4[k]; i0 = k; }
        int i1 = -1; float a1 = -1e30f;
#pragma unroll
        for (int k = 0; k < 4; ++k) if (k != i0 && s4[k] > a1) { a1 = s4[k]; i1 = k; }
        float w0 = 0.f, w1 = 0.f;
#pragma unroll
        for (int k = 0; k < 4; ++k) { if (k == i0) w0 = p4[k]; if (k == i1) w1 = p4[k]; }
        const float iw = 1.f / (w0 + w1);
        const int e0 = act ? best * 4 + i0 : -1, e1 = act ? best * 4 + i1 : -1;
        unsigned myc = 0, r0 = 0, r1 = 0;
#pragma unroll
        for (int e = 0; e < 16; ++e) {
            const unsigned long long m0 = __builtin_amdgcn_ballot_w64(e0 == e), m1 = __builtin_amdgcn_ballot_w64(e1 == e);
            const unsigned c0 = (unsigned)__builtin_popcountll(m0), c = c0 + (unsigned)__builtin_popcountll(m1);
            if (lane == e) myc = c;
            if (e0 == e) r0 = __builtin_amdgcn_mbcnt_hi((unsigned)(m0 >> 32), __builtin_amdgcn_mbcnt_lo((unsigned)m0, 0u));
            if (e1 == e) r1 = c0 + __builtin_amdgcn_mbcnt_hi((unsigned)(m1 >> 32), __builtin_amdgcn_mbcnt_lo((unsigned)m1, 0u));
        }
        unsigned mybase = 0;
        if (lane < 16 && myc != 0) mybase = atomicAdd(&cnt[lane * 64], myc);
        unsigned b0 = 0, b1 = 0;
#pragma unroll
        for (int e = 0; e < 16; ++e) { const unsigned be = (unsigned)__builtin_amdgcn_readlane((int)mybase, e); if (e0 == e) b0 = be; if (e1 == e) b1 = be; }
        if (act) {
            LIST[(size_t)e0 * T_ + b0 + r0] = tok * 2; LIST[(size_t)e1 * T_ + b1 + r1] = tok * 2 + 1;
            WTS[tok * 2] = w0 * iw; WTS[tok * 2 + 1] = w1 * iw;
        }
    }
}

struct MoeUnit { int e, rt, ct, cnt, off; };
struct MoeOrderBase {
    const unsigned* cntp; int t_lo, t_hi, slot, per;
    __device__ __forceinline__ void init(const unsigned* cnt) {
        cntp = cnt; int ntile = 0;
#pragma unroll
        for (int k = 0; k < NE; ++k) ntile += ((__builtin_amdgcn_readfirstlane((int)cnt[k * 64]) + 255) >> 8) * 4;
        t_lo = (ntile * (int)(blockIdx.x & 7)) >> 3; t_hi = (ntile * (int)((blockIdx.x & 7) + 1)) >> 3; slot = blockIdx.x >> 3; per = gridDim.x >> 3;
    }
    __device__ __forceinline__ bool next(int i, MoeUnit& u) const {
        const int t = t_lo + slot + i * per; if (t >= t_hi) return false;
        int base = 0, off = 0; bool found = false;
#pragma unroll
        for (int k = 0; k < NE; ++k) {
            const int ck = __builtin_amdgcn_readfirstlane((int)cntp[k * 64]), nt = ((ck + 255) >> 8) * 4;
            if (!found && t < base + nt) { found = true; u.e = k; u.cnt = ck; u.off = off; u.rt = (t - base) >> 2; u.ct = (t - base) & 3; }
            base += nt; off += ck;
        }
        return found;
    }
};
struct M2Order : MoeOrderBase {
    typedef MoeUnit U; static constexpr bool GATHER = true;
    const int* list;
    __device__ __forceinline__ void ptrs(const MoeUnit& u, unsigned& A, unsigned& B) const { A = (unsigned)WS_X1B; B = (unsigned)WS_WG + ((unsigned)u.e * 1024u + (unsigned)u.ct * 256u) * 2048u; }
    __device__ __forceinline__ void rows(const MoeUnit& u, int tid, unsigned (&v)[2][2]) const {
#pragma unroll
        for (int i = 0; i < 2; ++i) { int R, C; pg8::stage_rc((tid + vzero()) * 16 + i * 8192, R, C);
#pragma unroll
            for (int h = 0; h < 2; ++h) { int idx = u.rt * 256 + 128 * h + R; idx = idx < u.cnt ? idx : u.cnt - 1; const int a = (list + (size_t)u.e * T_)[idx]; v[h][i] = ((unsigned)(a >> 1) << 11) + (unsigned)C * 2u; } }
    }
};
struct M3Order : MoeOrderBase {
    typedef MoeUnit U; static constexpr bool GATHER = false;
    __device__ __forceinline__ void ptrs(const MoeUnit& u, unsigned& A, unsigned& B) const { A = (unsigned)WS_HB + ((unsigned)u.off + (unsigned)u.rt * 256u) * 1024u; B = (unsigned)WS_WD + ((unsigned)u.e * 1024u + (unsigned)u.ct * 256u) * 1024u; }
};
struct M2Epi {
    unsigned char* ws;
    __device__ __forceinline__ void operator()(const f32x4 (&acc)[2][2][4][2], const MoeUnit& u, int wr, int wc, int fr, int fq) const {
        bf16_t* HB = (bf16_t*)(ws + WS_HB);
#pragma unroll
        for (int ai = 0; ai < 2; ++ai)
#pragma unroll
            for (int m = 0; m < 4; ++m) {
                const int idx = u.rt * 256 + 128 * ai + 64 * wr + 16 * m + fr + vzero();
                if (idx < u.cnt) {
#pragma unroll
                    for (int bj = 0; bj < 2; ++bj) {
                        const int hcol = 4 * (32 * u.ct + 16 * bj + 4 * wc + fq);
                        const f32x4 gv = acc[ai][bj][m][0], uv = acc[ai][bj][m][1]; f32x4 hv;
#pragma unroll
                        for (int r = 0; r < 4; ++r) hv[r] = gv[r] * fsig(gv[r]) * uv[r];
                        *(u32x2*)(HB + (size_t)(u.off + idx) * 512 + hcol) = pack4(hv);
                    }
                }
            }
    }
};
struct M3Epi {
    unsigned char* ws; const int* list;
    __device__ __forceinline__ void operator()(const f32x4 (&acc)[2][2][4][2], const MoeUnit& u, int wr, int wc, int fr, int fq) const {
        bf16_t* CT = (bf16_t*)(ws + WS_CT);
#pragma unroll
        for (int ai = 0; ai < 2; ++ai)
#pragma unroll
            for (int m = 0; m < 4; ++m) {
                const int idx = u.rt * 256 + 128 * ai + 64 * wr + 16 * m + fr + vzero();
                if (idx < u.cnt) {
                    const int a = list[(size_t)u.e * T_ + idx];
#pragma unroll
                    for (int bj = 0; bj < 2; ++bj) {
                        const int n = u.ct * 256 + 128 * bj + 32 * wc + 8 * fq;
                        const f32x4 v0 = acc[ai][bj][m][0], v1 = acc[ai][bj][m][1];
                        u32x4 w; w.x = pack2(v0[0], v0[1]); w.y = pack2(v0[2], v0[3]); w.z = pack2(v1[0], v1[1]); w.w = pack2(v1[2], v1[3]);
                        *(u32x4*)(CT + (size_t)a * 1024 + n) = w;
                    }
                }
            }
    }
};
__device__ __forceinline__ void phase_m2(const Params& p, int layer, unsigned char* lds) {
    unsigned char* ws = launder(p.ws);
    M2Order S; S.init((const unsigned*)(ws + WS_CTL) + CW_CNT + layer * 1024 + vzero());
    S.list = (const int*)(ws + WS_LIST);
    M2Epi E; E.ws = ws;
    pg8::gemm_phase<M2Epi, M2Order>(lds, 1024, S, E, ltid(), ws);
}
__device__ __forceinline__ void phase_m3(const Params& p, int layer, unsigned char* lds) {
    unsigned char* ws = launder(p.ws);
    M3Order S; S.init((const unsigned*)(ws + WS_CTL) + CW_CNT + layer * 1024 + vzero());
    M3Epi E; E.ws = ws; E.list = (const int*)(ws + WS_LIST);
    pg8::gemm_phase<M3Epi, M3Order>(lds, 512, S, E, ltid(), ws);
}

__device__ __forceinline__ void phase_ln2(const Params& p, int layer, int half) {
    unsigned char* ws = launder(p.ws);
    const int tid = (ltid() & 255), lane = tid & 63, wid = tid >> 6;
    const bf16_t* X1 = (const bf16_t*)(ws + WS_X1B); const bf16_t* CT = (const bf16_t*)(ws + WS_CT); const float* WTS = (const float*)(ws + WS_WTS);
    float* XO = p.out; bf16_t* XB = (bf16_t*)(ws + WS_XB); const bool fin = layer == NLAYER - 1;
    const float* gam = p.ln2_g + layer * 1024; const float* bet = p.ln2_b + layer * 1024;
    constexpr int U = 4;
    const int nwave = (gridDim.x * 2) * 4, wv = (blockIdx.x * 2 + half) * 4 + wid;
    for (int t0 = wv * U; t0 < T_; t0 += nwave * U) {
        float4 v[U][4]; float s[U], q[U];
#pragma unroll
        for (int u = 0; u < U; ++u) {
            const int tok = t0 + u;
            const float w0 = WTS[tok * 2 + vzero()], w1 = WTS[tok * 2 + 1 + vzero()];
            s[u] = 0.f; q[u] = 0.f;
#pragma unroll
            for (int j = 0; j < 4; ++j) {
                const int d0 = 256 * j + 4 * lane;
                const f32x4 xt = unpack4(*(const u32x2*)(X1 + (size_t)tok * 1024 + d0)); float4 xv; xv.x = xt[0]; xv.y = xt[1]; xv.z = xt[2]; xv.w = xt[3];
                const f32x4 c0 = unpack4(*(const u32x2*)(CT + (size_t)(tok * 2) * 1024 + d0)), c1 = unpack4(*(const u32x2*)(CT + (size_t)(tok * 2 + 1) * 1024 + d0));
                v[u][j].x = xv.x * DN_ALPHA + w0 * c0[0] + w1 * c1[0]; v[u][j].y = xv.y * DN_ALPHA + w0 * c0[1] + w1 * c1[1];
                v[u][j].z = xv.z * DN_ALPHA + w0 * c0[2] + w1 * c1[2]; v[u][j].w = xv.w * DN_ALPHA + w0 * c0[3] + w1 * c1[3];
                s[u] += v[u][j].x + v[u][j].y + v[u][j].z + v[u][j].w;
                q[u] += v[u][j].x * v[u][j].x + v[u][j].y * v[u][j].y + v[u][j].z * v[u][j].z + v[u][j].w * v[u][j].w;
            }
        }
#pragma unroll
        for (int u = 0; u < U; ++u) { s[u] = wave_sum(s[u]); q[u] = wave_sum(q[u]); }
#pragma unroll
        for (int j = 0; j < 4; ++j) {
            const int d0 = 256 * j + 4 * lane;
            const float4 gg = *(const float4*)(gam + d0), bb = *(const float4*)(bet + d0);
#pragma unroll
            for (int u = 0; u < U; ++u) {
                const int tok = t0 + u;
                const float mu = s[u] * (1.f / 1024.f), var = fmaxf(q[u] * (1.f / 1024.f) - mu * mu, 0.f), rstd = rsqrtf(var + 1e-5f);
                float4 y; y.x = (v[u][j].x - mu) * rstd * gg.x + bb.x; y.y = (v[u][j].y - mu) * rstd * gg.y + bb.y; y.z = (v[u][j].z - mu) * rstd * gg.z + bb.z; y.w = (v[u][j].w - mu) * rstd * gg.w + bb.w;
                if (fin) *(float4*)(XO + (size_t)tok * 1024 + d0) = y;
                else { u32x2 w; w.x = pack2(y.x, y.y); w.y = pack2(y.z, y.w); *(u32x2*)(XB + (size_t)tok * 1024 + d0) = w; }
            }
        }
    }
}

#define XB_TMO      128
#define XB_XCNT(j)  (256  + 64 * (j))
#define XB_XSUB(j)  (1280 + 64 * (j))
#define XB_XGEN(j)  (2304 + 64 * (j))
#define XB_TOP      3328
#define XB_TOPGEN   3392
#define XCD_BAR_WORDS 3456
#define XB_SPIN_CAP (1u << 22)
#define LAS __attribute__((address_space(3)))
__device__ __forceinline__ unsigned xb_ld(unsigned* p)              { return __hip_atomic_load(p, __ATOMIC_RELAXED, __HIP_MEMORY_SCOPE_AGENT); }
__device__ __forceinline__ unsigned xb_add(unsigned* p, unsigned v) { return __hip_atomic_fetch_add(p, v, __ATOMIC_RELAXED, __HIP_MEMORY_SCOPE_AGENT); }
__device__ __forceinline__ unsigned xb_xcc_id() { return (unsigned)__builtin_amdgcn_s_getreg((3 << 11) | 20) & 0xFu; }
#define XB_SPIN(cond, bar) do { unsigned _sp = 0; while (cond) { __builtin_amdgcn_s_sleep(1); \
    if ((++_sp & 255u) == 0u) { if (xb_ld(&(bar)[XB_TMO])) break; if (_sp > XB_SPIN_CAP) { atomicAdd(&(bar)[XB_TMO], 1u); break; } } } } while (0)
struct XcdBarrier { unsigned* bar; unsigned x; volatile LAS unsigned* st; };
__device__ __forceinline__ XcdBarrier xcd_barrier_post(unsigned* bar, volatile LAS unsigned* st) {
    XcdBarrier b; b.bar = bar; b.x = xb_xcc_id(); b.st = st;
    if (threadIdx.x == 0) (void)xb_add(&bar[XB_XCNT(b.x)], 1u);
    return b;
}
__device__ __forceinline__ void xcd_barrier_complete(unsigned* bar, unsigned x, unsigned& nloc, unsigned& nx) {
    const unsigned G = gridDim.x * gridDim.y * gridDim.z;
    unsigned sum, cnt, mine, sp = 0u;
    for (;;) {
        sum = 0u; cnt = 0u; mine = 0u;
#pragma unroll
        for (unsigned j = 0; j < 16; ++j) { const unsigned c = xb_ld(&bar[XB_XCNT(j)]); sum += c; cnt += (c > 0u) ? 1u : 0u; mine = (j == x) ? c : mine; }
        if (sum == G) break;
        __builtin_amdgcn_s_sleep(1);
        if ((++sp & 255u) == 0u) { if (xb_ld(&bar[XB_TMO])) break; if (sp > XB_SPIN_CAP) { atomicAdd(&bar[XB_TMO], 1u); break; } }
    }
    nloc = mine > 0u ? mine : 1u; nx = cnt > 0u ? cnt : 1u;
}
__device__ __forceinline__ void xcd_barrier(const XcdBarrier& b) {
    asm volatile("s_waitcnt vmcnt(0)" ::: "memory");
    __syncthreads();
    if (threadIdx.x == 0) {
        unsigned* bar = b.bar;
        __builtin_amdgcn_s_waitcnt(0);
        unsigned nloc = b.st[0], nx = b.st[1];
        if (nloc == 0u) { xcd_barrier_complete(bar, b.x, nloc, nx); b.st[0] = nloc; b.st[1] = nx; }
        const unsigned old = xb_add(&bar[XB_XSUB(b.x)], 1u);
        const unsigned gen = old / nloc;
        if (old + 1u == (gen + 1u) * nloc) {
            __builtin_amdgcn_fence(__ATOMIC_RELEASE, "agent");
            asm volatile("s_waitcnt vmcnt(0)" ::: "memory");
            const unsigned og = xb_add(&bar[XB_TOP], 1u);
            const unsigned tg = og / nx;
            if (og + 1u == (tg + 1u) * nx) xb_add(&bar[XB_TOPGEN], 1u);
            else XB_SPIN(xb_ld(&bar[XB_TOPGEN]) == tg, bar);
            __builtin_amdgcn_fence(__ATOMIC_ACQUIRE, "agent");
            xb_add(&bar[XB_XGEN(b.x)], 1u);
            asm volatile("s_waitcnt vmcnt(0)" ::: "memory");
        } else {
            XB_SPIN(xb_ld(&bar[XB_XGEN(b.x)]) == gen, bar);
            __builtin_amdgcn_fence(__ATOMIC_ACQUIRE, "agent");
            asm volatile("s_waitcnt vmcnt(0)" ::: "memory");
        }
    }
    __syncthreads();
}

constexpr int PH_PER_LAYER = 11, N_PHASES = PH_PER_LAYER * NLAYER;
__global__ void __launch_bounds__(NTHREADS, 2) mega(Params p) {
    extern __shared__ __attribute__((aligned(16))) unsigned char lds[];
#if SINGLE_LAUNCH
    volatile LAS unsigned* xbw = (volatile LAS unsigned*)(lds + LDS_BYTES - 16);
    if (threadIdx.x < 4) xbw[threadIdx.x] = 0u;
    __syncthreads();
    XcdBarrier xbar = xcd_barrier_post((unsigned*)(p.ws + WS_CTL) + CW_BAR, xbw);
#endif
    const int half = __builtin_amdgcn_readfirstlane((int)(threadIdx.x >> 8));
    unsigned char* ldsh = lds + half * HALF_LDS;
    bool second = false;
    for (int ph = p.ph_lo; ph < p.ph_hi; ++ph) {
        const int layer = ph / PH_PER_LAYER, k = ph % PH_PER_LAYER;
        if (k == 0 && layer > 0) continue;
#ifdef ONLY_PHASE
        if (k != ONLY_PHASE) continue;
#endif
        switch (k) {
            case 0: phase_pw(p, layer, ldsh, 1 | 16 | 8, half); break;
            case 1: phase_g1(p, layer, lds); break;
            case 2: phase_p2(p, layer, ldsh, half); if (!second && layer + 1 < NLAYER) { __syncthreads(); phase_pw(p, layer + 1, ldsh, 1, half, 32); } break;
            case 3: phase_p3(p, ldsh, half, second ? ((p.rep_mask >> 16) & 7) : 7); if (!second && layer + 1 < NLAYER) { __syncthreads(); phase_pw(p, layer + 1, ldsh, 16, half); }
                    if (!second && layer == 0) { __syncthreads(); phase_pw(p, 0, ldsh, 2, half); } break;
            case 4: { const int sub = second ? ((p.rep_mask >> 12) & 7) : 7;
                    if (sub & 1) phase_p4_sel(p, lds);
                    if ((sub & 4) && half == 0) { phase_pw(p, layer, ldsh, 4, half); __syncthreads(); }
                    if (sub & 2) phase_p4(p, ldsh, half);
                    if ((sub & 4) && half == 1) { __syncthreads(); phase_pw(p, layer, ldsh, 4, half); } } break;
            case 5: phase_g2(p, lds); break;
            case 6: phase_g3(p, layer, lds); break;
            case 7: phase_ln1(p, layer, ldsh, ((p.rep_mask >> 7) & 1) && !second, half); if (!second && layer + 1 < NLAYER) { __syncthreads(); phase_pw(p, layer + 1, ldsh, 2, half); } break;
            case 8: phase_m2(p, layer, lds); break;
            case 9: phase_m3(p, layer, lds); break;
            case 10: phase_ln2(p, layer, half); break;
        }

        if (ph + 1 < p.ph_hi) { if (ph == p.ph_lo && !second) cg::this_grid().sync(); else xcd_barrier(xbar); }
        if (((p.rep_mask >> k) & 1) && !second) { second = true; --ph; } else second = false;
    }
}

extern "C" void kernel_launch(void* const* d_in, const int* in_sizes, int n_in, void* d_out, int out_size, void* d_ws, size_t ws_size, hipStream_t stream) {
    static int grid = 0;
    if (grid == 0) {
        if (n_in != 18 || ws_size < WS_END) { fprintf(stderr, "kernel_launch: unexpected n_in %d or ws_size %zu < %zu\n", n_in, ws_size, (size_t)WS_END); grid = -1; return; }
        int dev = 0, cus = 0, per_cu = 0;
        hipGetDevice(&dev); hipDeviceGetAttribute(&cus, hipDeviceAttributeMultiprocessorCount, dev);
        hipFuncSetAttribute((const void*)mega, hipFuncAttributeMaxDynamicSharedMemorySize, LDS_BYTES);
        hipOccupancyMaxActiveBlocksPerMultiprocessor(&per_cu, (const void*)mega, NTHREADS, LDS_BYTES);
        if (per_cu < 1) per_cu = 1;
        if (per_cu > 1) per_cu = 1;
        grid = cus * per_cu;
        (void)hipGetLastError();
    }
    if (grid < 0) return;
    Params p{};
    p.x = (const float*)d_in[0]; p.w_in = (const float*)d_in[1]; p.cmp_pos = (const float*)d_in[2]; p.cmp_w1 = (const float*)d_in[3]; p.cmp_w2 = (const float*)d_in[4];
    p.w_br_a = (const float*)d_in[5]; p.w_br_b = (const float*)d_in[6]; p.w_o = (const float*)d_in[7]; p.ln1_g = (const float*)d_in[8]; p.ln1_b = (const float*)d_in[9];
    p.w_router = (const float*)d_in[10]; p.router_bias = (const float*)d_in[11]; p.w_gate = (const float*)d_in[12]; p.w_up = (const float*)d_in[13]; p.w_down = (const float*)d_in[14];
    p.ln2_g = (const float*)d_in[15]; p.ln2_b = (const float*)d_in[16]; p.rel_bias = (const float*)d_in[17];
    p.out = (float*)d_out; p.ws = (unsigned char*)d_ws; p.rep_mask = REPEAT_MASK;
#if SINGLE_LAUNCH
    hipMemsetAsync((unsigned char*)d_ws + WS_CTL + (size_t)CW_BAR * 4, 0, XCD_BAR_WORDS * 4, stream);
    p.ph_lo = 0; p.ph_hi = N_PHASES;
    void* args[] = {&p};
    hipError_t e = hipLaunchCooperativeKernel((const void*)mega, dim3(grid), dim3(NTHREADS), args, LDS_BYTES, stream);
    if (e != hipSuccess) fprintf(stderr, "cooperative launch failed: %s (grid %d)\n", hipGetErrorString(e), grid);
#else
    for (int ph = 0; ph < N_PHASES; ++ph) {
        p.ph_lo = ph; p.ph_hi = ph + 1;
        hipLaunchKernelGGL(mega, dim3(grid), dim3(NTHREADS), LDS_BYTES, stream, p);
    }
#endif
}
```

```cpp
#include <hip/hip_runtime.h>
#include <hip/hip_cooperative_groups.h>
#include <cstdio>
#include <cstdint>
namespace cg = cooperative_groups;

#ifndef REPEAT_MASK
#define REPEAT_MASK 0
#endif
#ifndef SINGLE_LAUNCH
#define SINGLE_LAUNCH 1
#endif

typedef unsigned short bf16_t;
typedef short bf16x8 __attribute__((ext_vector_type(8)));
typedef float f32x4 __attribute__((ext_vector_type(4)));
typedef unsigned u32x2 __attribute__((ext_vector_type(2)));
typedef unsigned u32x4 __attribute__((ext_vector_type(4)));

constexpr int B_ = 2, S_ = 8192, D_ = 1024, T_ = B_ * S_, NLAYER = 4;
constexpr int DIN = 6424;
constexpr int LD = 5376;
constexpr int NW = 6656;
constexpr int C_QA = 0, C_KC = 512, C_VC = 640, C_KS = 768, C_KW = 896, C_QR = 1024, C_KR = 1536, C_GR = 2048, C_MA = 3072, C_MB = 4096, C_GA = 5120,
              C_VS = 5376, C_VW = 5504, C_VR = 5632;
constexpr float DN_ALPHA = 1.681792830507429f;
constexpr int NE = 16;

constexpr size_t al256(size_t x) { return (x + 255) & ~(size_t)255; }
constexpr size_t WS_CTL = 0;
constexpr size_t WS_BUCKET = 65536;
constexpr size_t WS_ROPE = WS_BUCKET + 8192;
constexpr size_t WS_WIN = WS_ROPE + (size_t)8192 * 32 * 8;
constexpr size_t WS_WA = WS_WIN + (size_t)NW * 1024 * 2;
constexpr size_t WS_WB = WS_WA + (size_t)1024 * 512 * 2;
constexpr size_t WS_WO = WS_WB + (size_t)1024 * 1024 * 2;
constexpr size_t WS_WG = WS_WO + (size_t)1024 * 1024 * 2;
constexpr size_t WS_WU = WS_WG + (size_t)16 * 512 * 1024 * 2;
constexpr size_t WS_WD = WS_WU + (size_t)16 * 512 * 1024 * 2;
constexpr size_t WS_XB = WS_WD + (size_t)16 * 512 * 1024 * 2;
constexpr size_t WS_X = WS_XB + (size_t)T_ * 1024 * 2;
constexpr size_t WS_MG = WS_X + (size_t)T_ * 1024 * 4;
constexpr size_t WS_KCC = WS_MG + (size_t)T_ * 1024 * 2;
constexpr size_t WS_VCCT = WS_KCC + (size_t)4 * 512 * 64 * 2;
constexpr size_t WS_W1T = WS_VCCT + (size_t)4 * 512 * 64 * 2;
constexpr size_t WS_B1 = WS_W1T + (size_t)2 * 64 * 2048 * 2;
constexpr size_t WS_R = WS_B1 + 1024;
constexpr size_t WS_P = WS_R;
constexpr size_t WS_VST = WS_P + (size_t)T_ * LD * 2;
constexpr size_t WS_VWT = WS_VST + (size_t)4 * 64 * S_ * 2;
constexpr size_t WS_VRT = WS_VWT + (size_t)4 * 64 * S_ * 2;
constexpr size_t WS_KVT = WS_VRT + (size_t)16 * 128 * S_ * 2;
constexpr size_t WS_SPT = WS_KVT + (size_t)16 * 64 * 8192 * 4;
constexpr size_t WS_YC = WS_SPT + (size_t)16 * 64 * 8192 * 2;
constexpr size_t WS_YW = WS_YC + (size_t)T_ * 512 * 2;
constexpr size_t WS_YA = WS_YW + (size_t)T_ * 512 * 2;
constexpr size_t WS_YB = WS_YA + (size_t)T_ * 512 * 2;
constexpr size_t WS_SELW = WS_YB + (size_t)T_ * 1024 * 2;
constexpr size_t WS_ENDA = WS_SELW + (size_t)T_ * 2 * 4 * 4;
constexpr size_t WS_H1 = WS_R;
constexpr size_t WS_X1 = WS_H1 + (size_t)T_ * 1024 * 4;
constexpr size_t WS_X1B = WS_X1 + (size_t)T_ * 1024 * 4;
constexpr size_t WS_HB = WS_X1B + (size_t)T_ * 1024 * 2;
constexpr size_t WS_CT = WS_HB + (size_t)2 * T_ * 512 * 2;
constexpr size_t WS_LIST = WS_CT + (size_t)2 * T_ * 1024 * 2;
constexpr size_t WS_WTS = WS_LIST + (size_t)16 * T_ * 4;
constexpr size_t WS_ENDB = WS_WTS + (size_t)2 * T_ * 4;
static_assert(WS_HB + (size_t)2 * T_ * 512 * 2 <= WS_CT, "view B overlap");
constexpr size_t WS_END = WS_ENDA > WS_ENDB ? WS_ENDA : WS_ENDB;

constexpr int CW_CNT = 4096;
constexpr int CW_BAR = 8192;

constexpr int HALF_LDS = 75776, LDS_BYTES = 2 * HALF_LDS + 16;
constexpr int NTHREADS = 512, HT = 256;

struct Params {
    const float* x; const float* w_in; const float* cmp_pos; const float* cmp_w1; const float* cmp_w2;
    const float* w_br_a; const float* w_br_b; const float* w_o; const float* ln1_g; const float* ln1_b;
    const float* w_router; const float* router_bias; const float* w_gate; const float* w_up; const float* w_down;
    const float* ln2_g; const float* ln2_b; const float* rel_bias;
    float* out; unsigned char* ws;
    int ph_lo, ph_hi, rep_mask, pad_;
};

__device__ __forceinline__ bf16_t f2bf(float f) { unsigned u = __float_as_uint(f); u += 0x7fffu + ((u >> 16) & 1u); return (bf16_t)(u >> 16); }
__device__ __forceinline__ float bf2f(unsigned h) { return __uint_as_float(h << 16); }
typedef __bf16 bf16x2_t __attribute__((ext_vector_type(2)));
typedef float f32x2_t __attribute__((ext_vector_type(2)));
__device__ __forceinline__ unsigned pack2(float lo, float hi) { const f32x2_t f = {lo, hi}; return __builtin_bit_cast(unsigned, __builtin_convertvector(f, bf16x2_t)); }
__device__ __forceinline__ u32x2 pack4(f32x4 v) { u32x2 r; r.x = pack2(v[0], v[1]); r.y = pack2(v[2], v[3]); return r; }
__device__ __forceinline__ f32x4 unpack4(u32x2 u) { f32x4 r; r[0] = bf2f(u.x & 0xffffu); r[1] = bf2f(u.x >> 16); r[2] = bf2f(u.y & 0xffffu); r[3] = bf2f(u.y >> 16); return r; }
__device__ __forceinline__ float rows_max(float v) {
    u32x2 r = __builtin_amdgcn_permlane16_swap(__float_as_uint(v), __float_as_uint(v), false, false);
    v = fmaxf(__uint_as_float(r.x), __uint_as_float(r.y));
    r = __builtin_amdgcn_permlane32_swap(__float_as_uint(v), __float_as_uint(v), false, false);
    return fmaxf(__uint_as_float(r.x), __uint_as_float(r.y));
}
__device__ __forceinline__ float rows_sum(float v) {
    u32x2 r = __builtin_amdgcn_permlane16_swap(__float_as_uint(v), __float_as_uint(v), false, false);
    v = __uint_as_float(r.x) + __uint_as_float(r.y);
    r = __builtin_amdgcn_permlane32_swap(__float_as_uint(v), __float_as_uint(v), false, false);
    return __uint_as_float(r.x) + __uint_as_float(r.y);
}
__device__ __forceinline__ float wave_sum(float v) {
    v += __int_as_float(__builtin_amdgcn_mov_dpp(__float_as_int(v), 0xB1, 0xF, 0xF, true));
    v += __int_as_float(__builtin_amdgcn_mov_dpp(__float_as_int(v), 0x4E, 0xF, 0xF, true));
    v += __int_as_float(__builtin_amdgcn_mov_dpp(__float_as_int(v), 0x141, 0xF, 0xF, true));
    v += __int_as_float(__builtin_amdgcn_mov_dpp(__float_as_int(v), 0x140, 0xF, 0xF, true));
    return rows_sum(v);
}
__device__ __forceinline__ float sigmoidf_(float x) { return 1.f / (1.f + __expf(-x)); }
__device__ __forceinline__ int ltid() { int t = threadIdx.x; asm volatile("" : "+v"(t)); return t; }
__device__ __forceinline__ int vzero() { int z; asm volatile("v_mov_b32 %0, 0" : "=v"(z)); return z; }
__device__ __forceinline__ unsigned char* launder(unsigned char* q) { asm volatile("" : "+s"(q)); return q; }
__device__ __forceinline__ void wait_vm0() { asm volatile("s_waitcnt vmcnt(0)" ::: "memory"); }

__device__ __forceinline__ void glds16(const void* g, void* l) {
    __builtin_amdgcn_global_load_lds((const __attribute__((address_space(1))) unsigned*)g,
                                     (__attribute__((address_space(3))) unsigned*)l, 16, 0, 0);
}
__device__ __forceinline__ f32x4 mfma16(bf16x8 a, bf16x8 b, f32x4 c) { return __builtin_amdgcn_mfma_f32_16x16x32_bf16(a, b, c, 0, 0, 0); }

#define WAIT_V(n) asm volatile("s_waitcnt vmcnt(%0)" ::"n"(n) : "memory")
#define RAW_BARRIER() do { asm volatile("s_waitcnt lgkmcnt(0)" ::: "memory"); __builtin_amdgcn_s_barrier(); } while (0)
__device__ __forceinline__ void bglds16(__amdgpu_buffer_rsrc_t r, unsigned voff, int soff, void* l) {
    __builtin_amdgcn_raw_ptr_buffer_load_lds(r, (__attribute__((address_space(3))) void*)l, 16, (int)voff, soff, 0, 0);
}
template <int NJ, bool GN>
__device__ __forceinline__ void gemm8_stage(__amdgpu_buffer_rsrc_t mr, int mld, unsigned mvo, __amdgpu_buffer_rsrc_t nr, int nld, const unsigned (&nvo)[NJ], int kt, unsigned char* st, int wid) {
#pragma unroll
    for (int i = 0; i < 4; ++i) bglds16(mr, mvo, (64 * i * mld + kt * 64) * 2, st + (8 * i + wid) * 1024);
#pragma unroll
    for (int i = 0; i < NJ; ++i) bglds16(nr, nvo[i], ((GN ? 0 : 64 * i * nld) + kt * 64) * 2, st + 32768 + (8 * i + wid) * 1024);
}
template <int NJ, bool GN>
__device__ __forceinline__ void gemm8_kloop(const bf16_t* mb, int mld, unsigned mvo, const bf16_t* nb, int nld, const unsigned (&nvo)[NJ], int nk, unsigned char* lds, f32x4 (&acc)[8][NJ], int tid) {
    const int lane = tid & 63, wid = tid >> 6, wr = wid >> 2, wc = wid & 3, fr = lane & 15, fq = lane >> 4;
    const __amdgpu_buffer_rsrc_t mr = __builtin_amdgcn_make_buffer_rsrc((void*)mb, 0, 0x7fffffff, 0x00020000);
    const __amdgpu_buffer_rsrc_t nr = __builtin_amdgcn_make_buffer_rsrc((void*)nb, 0, 0x7fffffff, 0x00020000);
    gemm8_stage<NJ, GN>(mr, mld, mvo, nr, nld, nvo, 0, lds, wid);
    gemm8_stage<NJ, GN>(mr, mld, mvo, nr, nld, nvo, 1, lds + 65536, wid);
    for (int kt = 0; kt < nk; ++kt) {
        unsigned char* cur = lds + (kt & 1) * 65536;
        if (kt + 1 < nk) WAIT_V(4 + NJ); else WAIT_V(0);
        RAW_BARRIER();
        bf16x8 a[4], b[NJ];
        const unsigned char* ab = cur + (128 * wr + fr) * 128;
        const unsigned char* bb = cur + 32768 + (16 * NJ * wc + fr) * 128;
        const int sw0 = ((fq) ^ (fr & 7)) << 4, sw1 = ((4 + fq) ^ (fr & 7)) << 4;
#pragma unroll
        for (int j = 0; j < NJ; ++j) b[j] = *(const bf16x8*)(bb + j * 2048 + sw0);
#pragma unroll
        for (int mh = 0; mh < 2; ++mh) {
#pragma unroll
            for (int i = 0; i < 4; ++i) a[i] = *(const bf16x8*)(ab + (4 * mh + i) * 2048 + sw0);
#pragma unroll
            for (int i = 0; i < 4; ++i)
#pragma unroll
                for (int j = 0; j < NJ; ++j) acc[4 * mh + i][j] = mfma16(a[i], b[j], acc[4 * mh + i][j]);
        }
#pragma unroll
        for (int j = 0; j < NJ; ++j) b[j] = *(const bf16x8*)(bb + j * 2048 + sw1);
#pragma unroll
        for (int i = 0; i < 4; ++i) a[i] = *(const bf16x8*)(ab + i * 2048 + sw1);
#pragma unroll
        for (int i = 0; i < 4; ++i)
#pragma unroll
            for (int j = 0; j < NJ; ++j) acc[i][j] = mfma16(a[i], b[j], acc[i][j]);
#pragma unroll
        for (int i = 0; i < 4; ++i) a[i] = *(const bf16x8*)(ab + (4 + i) * 2048 + sw1);
        RAW_BARRIER();
        if (kt + 2 < nk) gemm8_stage<NJ, GN>(mr, mld, mvo, nr, nld, nvo, kt + 2, cur, wid);
#pragma unroll
        for (int i = 0; i < 4; ++i)
#pragma unroll
            for (int j = 0; j < NJ; ++j) acc[4 + i][j] = mfma16(a[i], b[j], acc[4 + i][j]);
    }
    __syncthreads();
    __builtin_amdgcn_sched_barrier(0);
}
template <int NJ>
__device__ __forceinline__ void zero_acc8(f32x4 (&acc)[8][NJ]) {
#pragma unroll
    for (int i = 0; i < 8; ++i)
#pragma unroll
        for (int j = 0; j < NJ; ++j) acc[i][j] = (f32x4){0.f, 0.f, 0.f, 0.f};
}

namespace pg8 {
#define PG8_LAS __attribute__((address_space(3)))
constexpr int BM = 256, BK = 64, HALF = 128, HTB = HALF * BK * 2, STAGE_BYTES = 8 * HTB;
__device__ __forceinline__ int lds_byte(int r, int c) { const int st = (r >> 4) * 2 + (c >> 5), rr = r & 15, cc = c & 31, ob = rr * 64 + cc * 2; return st * 1024 + (ob ^ (((ob >> 9) & 1) << 5)); }
__device__ __forceinline__ void stage_rc(int b, int& R, int& C) { const int st = b / 1024, sb = b % 1024, swz = sb ^ (((sb >> 9) & 1) << 5); R = (st >> 1) * 16 + swz / 64; C = (st & 1) * 32 + (swz % 64) / 2; }
__device__ __forceinline__ int perm32(int rho) { const int n = rho >> 4, i = rho & 15; return 8 * (i >> 2) + 4 * n + (i & 3); }
struct Unit { int pm, pn; };
template <class Epi, class Sched>
__device__ __forceinline__ void gemm_phase(unsigned char* lds_, const int K, const Sched& S, const Epi& E, const int tid, const unsigned char* wsbase) {
    PG8_LAS unsigned char* lds = (PG8_LAS unsigned char*)lds_;
    const int wid = __builtin_amdgcn_readfirstlane(tid >> 6), lane = tid & 63, wr = wid >> 2, wc = wid & 3, fr = lane & 15, fq = lane >> 4;
    const int nt = K / BK;
    unsigned voffA[2], voffB[2];
#pragma unroll
    for (int i = 0; i < 2; ++i) { int R, C; stage_rc(tid * 16 + i * 8192, R, C); const int Rb = (R & ~31) + perm32(R & 31);
        voffA[i] = (unsigned)(R * K + C) * 2u; voffB[i] = (unsigned)(Rb * K + C) * 2u; }
    const unsigned kstep = (unsigned)(BK * 2);
    const unsigned hstep = (unsigned)HALF * K * 2;
    const __amdgpu_buffer_rsrc_t rsrc = __builtin_amdgcn_make_buffer_rsrc((void*)wsbase, 0, 0x7fffffff, 0x00020000);
    const unsigned ldsw = (unsigned)wid * 1024u;
    const int aoff = lds_byte(wr * 64 + fr, fq * 8), boff = lds_byte(wc * 32 + fr, fq * 8);
#define PG8_SA(b, h) (((b) * 2 + (h)) * HTB)
#define PG8_SB(b, h) ((4 + (b) * 2 + (h)) * HTB)
#define PG8_STAGE(bufoff, gbase, voff) do { _Pragma("unroll") for (int _i = 0; _i < 2; ++_i) \
        __builtin_amdgcn_raw_ptr_buffer_load_lds(rsrc, (PG8_LAS void*)(lds + (bufoff) + ldsw + _i * 8192), 16, (int)(voff)[_i], (int)(gbase), 0, 0); } while (0)
#define PG8_LDA(dst, b, h) do { _Pragma("unroll") for (int m = 0; m < 4; ++m) _Pragma("unroll") for (int k = 0; k < 2; ++k) dst[m][k] = *(const PG8_LAS bf16x8*)(lds + PG8_SA(b, h) + aoff + m * 2048 + k * 1024); } while (0)
#define PG8_LDB(dst, b, h) do { _Pragma("unroll") for (int n = 0; n < 2; ++n) _Pragma("unroll") for (int k = 0; k < 2; ++k) dst[n][k] = *(const PG8_LAS bf16x8*)(lds + PG8_SB(b, h) + boff + n * 2048 + k * 1024); } while (0)
#define PG8_MMA(ai, bj, At, Bt) do { __builtin_amdgcn_s_setprio(1); _Pragma("unroll") for (int m = 0; m < 4; ++m) _Pragma("unroll") for (int n = 0; n < 2; ++n) _Pragma("unroll") for (int k = 0; k < 2; ++k) \
        acc[ai][bj][m][n] = __builtin_amdgcn_mfma_f32_16x16x32_bf16(Bt[n][k], At[m][k], acc[ai][bj][m][n], 0, 0, 0); __builtin_amdgcn_s_setprio(0); } while (0)
#define PG8_WAIT_V(n) asm volatile("s_waitcnt vmcnt(" #n ")" ::: "memory")
#define PG8_WAIT_L(n) asm volatile("s_waitcnt lgkmcnt(" #n ")" ::: "memory")
#define PG8_BAR __builtin_amdgcn_s_barrier()
#define PG8_SCHED __builtin_amdgcn_sched_barrier(0)
    typename Sched::U cur, nxt; int ui = 0;
    if (!S.next(0, cur)) return;
    unsigned cA, cB; S.ptrs(cur, cA, cB);
    constexpr bool GA = Sched::GATHER;
    unsigned vA[GA ? 2 : 1][2], nvA[GA ? 2 : 1][2];
    if constexpr (GA) { S.rows(cur, tid, vA);
#pragma unroll
        for (int h = 0; h < 2; ++h)
#pragma unroll
            for (int i = 0; i < 2; ++i) nvA[h][i] = vA[h][i]; }
#define PG8_STAGE_A(bufoff, gbase, h, nextu) do { if constexpr (GA) { if (nextu) PG8_STAGE(bufoff, gbase, nvA[h]); else PG8_STAGE(bufoff, gbase, vA[h]); } \
        else PG8_STAGE(bufoff, (gbase) + (h) * hstep, voffA); } while (0)
    PG8_STAGE(PG8_SB(0, 0), cB, voffB); PG8_STAGE_A(PG8_SA(0, 0), cA, 0, false); PG8_STAGE(PG8_SB(0, 1), cB + hstep, voffB); PG8_STAGE_A(PG8_SA(0, 1), cA, 1, false);
    if (wr == 1) PG8_BAR;
    PG8_WAIT_V(4); PG8_BAR;
    PG8_STAGE(PG8_SB(1, 0), cB + kstep, voffB); PG8_STAGE_A(PG8_SA(1, 0), cA + kstep, 0, false); PG8_STAGE(PG8_SB(1, 1), cB + hstep + kstep, voffB);
    PG8_WAIT_V(6); PG8_BAR;
    PG8_SCHED;
    f32x4 acc[2][2][4][2];
#pragma unroll
    for (int a = 0; a < 2; ++a)
#pragma unroll
        for (int b = 0; b < 2; ++b)
#pragma unroll
            for (int m = 0; m < 4; ++m)
#pragma unroll
                for (int n = 0; n < 2; ++n) acc[a][b][m][n] = (f32x4){0.f, 0.f, 0.f, 0.f};
    bf16x8 At[4][2], B0[2][2], B1[2][2];
    for (;;) {
        const bool has_next = S.next(ui + 1, nxt);
        unsigned nA = cA, nB = cB; if (has_next) S.ptrs(nxt, nA, nB);
        if constexpr (GA) { if (has_next) S.rows(nxt, tid, nvA); }
        for (int t = 0; t < nt; t += 2) {
            const bool last = (t == nt - 2);
            const unsigned a1 = cA + (unsigned)(t + 1) * kstep;
            const unsigned a2 = last ? nA : cA + (unsigned)(t + 2) * kstep, b2 = last ? nB : cB + (unsigned)(t + 2) * kstep;
            const unsigned a3 = a2 + kstep, b3 = b2 + kstep;
            PG8_LDB(B0, 0, 0); PG8_SCHED; PG8_LDA(At, 0, 0); PG8_STAGE_A(PG8_SA(1, 1), a1, 1, false);
            PG8_WAIT_L(8); PG8_BAR; PG8_WAIT_L(0); PG8_MMA(0, 0, At, B0); PG8_BAR; PG8_SCHED;
            PG8_LDB(B1, 0, 1); PG8_STAGE(PG8_SB(0, 0), b2, voffB);
            PG8_BAR; PG8_WAIT_L(0); PG8_MMA(0, 1, At, B1); PG8_BAR;
            PG8_LDA(At, 0, 1); PG8_STAGE_A(PG8_SA(0, 0), a2, 0, last);
            PG8_BAR; PG8_WAIT_L(0); PG8_MMA(1, 0, At, B0); PG8_BAR; PG8_SCHED;
            PG8_STAGE(PG8_SB(0, 1), b2 + hstep, voffB);
            PG8_WAIT_V(6); PG8_BAR; PG8_MMA(1, 1, At, B1); PG8_BAR;
            PG8_LDB(B0, 1, 0); PG8_SCHED; PG8_LDA(At, 1, 0); PG8_STAGE_A(PG8_SA(0, 1), a2, 1, last);
            PG8_WAIT_L(8); PG8_BAR; PG8_WAIT_L(0); PG8_MMA(0, 0, At, B0); PG8_BAR; PG8_SCHED;
            PG8_LDB(B1, 1, 1); PG8_STAGE(PG8_SB(1, 0), b3, voffB);
            PG8_BAR; PG8_WAIT_L(0); PG8_MMA(0, 1, At, B1); PG8_BAR;
            PG8_LDA(At, 1, 1); PG8_STAGE_A(PG8_SA(1, 0), a3, 0, last);
            PG8_BAR; PG8_WAIT_L(0); PG8_MMA(1, 0, At, B0); PG8_BAR; PG8_SCHED;
            PG8_STAGE(PG8_SB(1, 1), b3 + hstep, voffB);
            PG8_WAIT_V(6); PG8_BAR; PG8_MMA(1, 1, At, B1); PG8_BAR;
        }
        E(acc, cur, wr, wc, fr, fq);
        if (!has_next) break;
#pragma unroll
        for (int a = 0; a < 2; ++a)
#pragma unroll
            for (int b = 0; b < 2; ++b)
#pragma unroll
                for (int m = 0; m < 4; ++m)
#pragma unroll
                    for (int n = 0; n < 2; ++n) acc[a][b][m][n] = (f32x4){0.f, 0.f, 0.f, 0.f};
        cur = nxt; cA = nA; cB = nB; ++ui;
        if constexpr (GA) {
#pragma unroll
            for (int h = 0; h < 2; ++h)
#pragma unroll
                for (int i = 0; i < 2; ++i) vA[h][i] = nvA[h][i]; }
    }
    PG8_WAIT_V(0);
    if (wr == 0) PG8_BAR;
    PG8_BAR;
#undef PG8_SA
#undef PG8_SB
#undef PG8_STAGE
#undef PG8_STAGE_A
#undef PG8_LDA
#undef PG8_LDB
#undef PG8_MMA
#undef PG8_WAIT_V
#undef PG8_WAIT_L
#undef PG8_BAR
#undef PG8_SCHED
}
}

struct TJob { const float* src; bf16_t* dst; int ld, k0, n0, mode, kdst; };
__device__ __forceinline__ void tcvt_load(const TJob& J, float4 (&v)[4], int tid) {
#pragma unroll
    for (int i = 0; i < 4; ++i) {
        const int kk = (tid >> 4) + 16 * i, c4 = (tid & 15) * 4, cd = J.n0 + c4;
        int orig = cd; bool ok = true;
        if (J.mode == 1) {
            if (cd < 896) orig = cd;
            else if (cd < 1024) orig = cd - 896 + 1024;
            else if (cd < 2048) { const int q = cd - 1024, hd = q >> 6, pp = q & 63;
                const int d = (pp & 4) ? 32 + 4 * (pp >> 3) + (pp & 3) : 4 * (pp >> 3) + (pp & 3);
                orig = 1304 + hd * 64 + d; }
            else if (cd < 5120) orig = cd - 2048 + 3352;
            else if (cd < 5144) orig = cd - 5120 + 1280;
            else if (cd < 5376) ok = false;
            else if (cd < 5504) orig = cd - 5376 + 896;
            else if (cd < 5632) orig = cd - 5504 + 1152;
            else orig = cd - 5632 + 2328;
        }
        v[i] = make_float4(0.f, 0.f, 0.f, 0.f);
        if (ok) v[i] = *(const float4*)(J.src + (size_t)(J.k0 + kk) * J.ld + orig);
    }
}
__device__ __forceinline__ void tcvt_finish(const TJob& J, const float4 (&v)[4], unsigned char* lds, int tid) {
    float* tile = (float*)lds;
#pragma unroll
    for (int i = 0; i < 4; ++i) {
        const int kk = (tid >> 4) + 16 * i, c4 = (tid & 15) * 4;
        tile[kk * 65 + c4 + 0] = v[i].x; tile[kk * 65 + c4 + 1] = v[i].y; tile[kk * 65 + c4 + 2] = v[i].z; tile[kk * 65 + c4 + 3] = v[i].w;
    }
    __syncthreads();
#pragma unroll
    for (int i = 0; i < 2; ++i) {
        const int q = tid + 256 * i, n = q >> 3, kc = q & 7;
        float x[8];
#pragma unroll
        for (int j = 0; j < 8; ++j) x[j] = tile[(kc * 8 + j) * 65 + n];
        u32x4 w; w.x = pack2(x[0], x[1]); w.y = pack2(x[2], x[3]); w.z = pack2(x[4], x[5]); w.w = pack2(x[6], x[7]);
        int drow = J.n0 + n; if (J.mode >= 2) drow = 8 * (drow >> 2) + (drow & 3) + (J.mode == 3 ? 4 : 0);
        *(u32x4*)(J.dst + (size_t)drow * J.kdst + J.k0 + kc * 8) = w;
    }
    __syncthreads();
}
__device__ __forceinline__ void tcvt_tile(const float* src, int ld_src, int k0, int n0, int mode, bf16_t* dst, int kdst, unsigned char* lds, int half) {
    TJob J; J.src = src; J.dst = dst; J.ld = ld_src; J.k0 = k0; J.n0 = n0; J.mode = mode; J.kdst = kdst;
    const int tid = (ltid() & 255); float4 v[4];
    tcvt_load(J, v, tid); tcvt_finish(J, v, lds, tid);
}

__device__ __forceinline__ void tcvt_decode(const Params& p, unsigned char* ws, int layer, int t, TJob& J) {
    constexpr int J0 = 16 * 104, J1 = 8 * 16, J2 = 256, J3 = 256, J4 = 2048, J5 = 2048;
    int u = t;
        if (u < J0) { J.src = p.w_in + (size_t)layer * 1024 * DIN; J.ld = DIN; J.k0 = (u % 16) * 64; J.n0 = (u / 16) * 64; J.mode = 1; J.dst = (bf16_t*)(ws + WS_WIN); J.kdst = 1024; return; }
        u -= J0;
        if (u < J1) { J.src = p.w_br_a + (size_t)layer * 512 * 1024; J.ld = 1024; J.k0 = (u % 8) * 64; J.n0 = (u / 8) * 64; J.mode = 0; J.dst = (bf16_t*)(ws + WS_WA); J.kdst = 512; return; }
        u -= J1;
        if (u < J2) { J.src = p.w_br_b + (size_t)layer * 1024 * 1024; J.ld = 1024; J.k0 = (u % 16) * 64; J.n0 = (u / 16) * 64; J.mode = 0; J.dst = (bf16_t*)(ws + WS_WB); J.kdst = 1024; return; }
        u -= J2;
        if (u < J3) { J.src = p.w_o + (size_t)layer * 1024 * 1024; J.ld = 1024; J.k0 = (u % 16) * 64; J.n0 = (u / 16) * 64; J.mode = 0; J.dst = (bf16_t*)(ws + WS_WO); J.kdst = 1024; return; }
        u -= J3;
        if (u < J4 + J5) {
            const bool up = u >= J4; if (up) u -= J4;
            const int e = u / 128, v = u % 128;
            J.src = (up ? p.w_up : p.w_gate) + ((size_t)layer * NE + e) * 1024 * 512; J.ld = 512; J.k0 = (v % 16) * 64; J.n0 = (v / 16) * 64; J.mode = up ? 3 : 2;
            J.dst = (bf16_t*)(ws + WS_WG) + (size_t)e * 1024 * 1024; J.kdst = 1024; return;
        }
        u -= J4 + J5;
        { const int e = u / 128, v = u % 128;
          J.src = p.w_down + ((size_t)layer * NE + e) * 512 * 1024; J.ld = 1024; J.k0 = (v % 8) * 64; J.n0 = (v / 8) * 64; J.mode = 0; J.dst = (bf16_t*)(ws + WS_WD) + (size_t)e * 1024 * 512; J.kdst = 512; }
}


__device__ __forceinline__ void phase_pw(const Params& p, int layer, unsigned char* lds, int parts, int half, int skip = 0) {
    if ((int)(blockIdx.x * 2 + half) < skip) return;
    const int bid = (blockIdx.x * 2 + half) - skip, nblk = (gridDim.x * 2) - skip, tid = (ltid() & 255);
    unsigned char* ws = launder(p.ws);
    constexpr int J0 = 16 * 104, J1 = 8 * 16, J2 = 256, J3 = 256, J4 = 2048, J5 = 2048, J6 = 2048, JT = J0 + J1 + J2 + J3 + J4 + J5 + J6;
    const int t_lo = (parts & 1) ? 0 : (parts & 2) ? J0 : J0 + J1 + J2 + J3;
    const int t_hi = (parts & 4) ? JT : (parts & 2) ? J0 + J1 + J2 + J3 : (parts & 1) ? J0 : 0;
    if (t_lo + bid < t_hi) {
        float4 v[4]; { TJob J; tcvt_decode(p, ws, layer, t_lo + bid, J); tcvt_load(J, v, tid); }
        for (int t = t_lo + bid; t < t_hi; t += nblk) {
            float4 vn[4];
            if (t + nblk < t_hi) { TJob J; tcvt_decode(p, ws, layer, t + nblk, J); tcvt_load(J, vn, tid); }
            { TJob J; tcvt_decode(p, ws, layer, t, J); tcvt_finish(J, v, lds, tid); }
#pragma unroll
            for (int i = 0; i < 4; ++i) v[i] = vn[i];
        }
    }
    if (parts & 16) {
    for (int t = bid; t < 64; t += nblk) {
        const int kv = t >> 5, kt = t & 31;
        tcvt_tile(p.cmp_w1 + ((size_t)layer * 2 + kv) * 2048 * 64, 64, kt * 64, 0, 0, (bf16_t*)(ws + WS_W1T) + (size_t)kv * 64 * 2048, 2048, lds, half);
    }
    if (bid >= nblk - 2) {
        const int kv = nblk - 1 - bid, n = tid & 63, part = tid >> 6;
        const float* w1 = p.cmp_w1 + ((size_t)layer * 2 + kv) * 2048 * 64; const float* pos = p.cmp_pos + ((size_t)layer * 2 + kv) * 2048;
        float a = 0.f;
        for (int k = part * 512; k < part * 512 + 512; ++k) a += pos[k] * w1[(size_t)k * 64 + n];
        float* red = (float*)lds;
        __syncthreads(); red[tid] = a; __syncthreads();
        if (tid < 64) ((float*)(ws + WS_B1))[kv * 64 + tid] = red[tid] + red[tid + 64] + red[tid + 128] + red[tid + 192];
        __syncthreads();
    }
    }
    if (parts & 8) {
        const float4* xs = (const float4*)p.x; u32x2* xb = (u32x2*)(ws + WS_XB);
        for (size_t i = (size_t)bid * HT + tid; i < (size_t)T_ * 1024 / 4; i += (size_t)nblk * HT) {
            float4 v = xs[i]; u32x2 w; w.x = pack2(v.x, v.y); w.y = pack2(v.z, v.w); xb[i] = w;
        }
        for (int n = bid * HT + tid; n < 8192; n += nblk * HT) {
            int bk;
            if (n < 16) bk = n;
            else { const int th[15] = {22, 30, 40, 54, 73, 99, 134, 182, 246, 332, 450, 609, 825, 1117, 1513}; bk = 16;
#pragma unroll
                for (int k = 0; k < 15; ++k) bk += (n >= th[k]) ? 1 : 0; }
            (ws + WS_BUCKET)[n] = (unsigned char)bk;
        }
        for (int i = bid * HT + tid; i < 8192 * 32; i += nblk * HT) {
            const int pos = i >> 5, d = i & 31;
            const float inv = powf(10000.f, -(float)d * 2.0f / 64.f);
            const float ang = (float)pos * inv;
            float sn, cs; sincosf(ang, &sn, &cs);
            ((float2*)(ws + WS_ROPE))[i] = make_float2(cs, sn);
        }
        if (bid == 0) for (int i = tid; i < 8192; i += HT) ((unsigned*)(ws + WS_CTL))[i] = 0u;
    }
}

__device__ __forceinline__ float fsig(float x) { return __builtin_amdgcn_rcpf(1.f + __builtin_amdgcn_exp2f(-1.4426950408889634f * x)); }
template <int KIND>
__device__ __forceinline__ void g1_epi(const f32x4 (&acc)[2][2][4][2], unsigned char* ws, int r0, int c0, int wr, int wc, int fr, int fq) {
#pragma unroll
    for (int ai = 0; ai < 2; ++ai)
#pragma unroll
        for (int m = 0; m < 4; ++m) {
            const int row = r0 + 128 * ai + 64 * wr + 16 * m + fr + vzero();
#pragma unroll
            for (int bj = 0; bj < 2; ++bj) {
                const int col = c0 + 128 * bj + 32 * wc + 8 * fq;
                f32x4 v0 = acc[ai][bj][m][0], v1 = acc[ai][bj][m][1];
                if (KIND == 5) {
                    const int b = col >> 13, sq = col & (S_ - 1);
                    bf16_t* dst;
                    if (row < C_VW) { const int c = row - C_VS; dst = (bf16_t*)(ws + WS_VST) + ((size_t)(b * 2 + (c >> 6)) * 64 + (c & 63)) * S_ + sq; }
                    else if (row < C_VR) { const int c = row - C_VW; dst = (bf16_t*)(ws + WS_VWT) + ((size_t)(b * 2 + (c >> 6)) * 64 + (c & 63)) * S_ + sq; }
                    else { const int c = row - C_VR; dst = (bf16_t*)(ws + WS_VRT) + ((size_t)(b * 8 + (c >> 7)) * 128 + (c & 127)) * S_ + sq; }
                    u32x4 w; w.x = pack2(v0[0], v0[1]); w.y = pack2(v0[2], v0[3]); w.z = pack2(v1[0], v1[1]); w.w = pack2(v1[2], v1[3]);
                    *(u32x4*)dst = w;
                    continue;
                }
                if (KIND == 1 || KIND == 2) {
                    const float2* rope = (const float2*)(ws + WS_ROPE);
                    const int pos = row & (S_ - 1), d = 16 * (wc & 1) + 4 * fq;
                    const float4 cs01 = *(const float4*)(rope + pos * 32 + d), cs23 = *(const float4*)(rope + pos * 32 + d + 2);
                    const float c[4] = {cs01.x, cs01.z, cs23.x, cs23.z}, sn[4] = {cs01.y, cs01.w, cs23.y, cs23.w};
                    const float sc = (KIND == 2) ? 0.125f : 1.0f;
                    f32x4 y1, y2;
#pragma unroll
                    for (int r = 0; r < 4; ++r) { y1[r] = (v0[r] * c[r] - v1[r] * sn[r]) * sc; y2[r] = (v0[r] * sn[r] + v1[r] * c[r]) * sc; }
                    v0 = y1; v1 = y2;
                } else if (KIND == 3) {
#pragma unroll
                    for (int r = 0; r < 4; ++r) { v0[r] = v0[r] * fsig(v0[r]); v1[r] = v1[r] * fsig(v1[r]); }
                } else if (KIND == 4) {
#pragma unroll
                    for (int r = 0; r < 4; ++r) { v0[r] = fsig(v0[r]); v1[r] = fsig(v1[r]); }
                }
                u32x4 w; w.x = pack2(v0[0], v0[1]); w.y = pack2(v0[2], v0[3]); w.z = pack2(v1[0], v1[1]); w.w = pack2(v1[2], v1[3]);
                *(u32x4*)((bf16_t*)(ws + WS_P) + (size_t)row * LD + col) = w;
            }
        }
}
struct G1Order {      typedef pg8::Unit U; static constexpr bool GATHER = false;
    int xcd, slot, per;
    __device__ __forceinline__ bool next(int i, pg8::Unit& u) const {
        const int j = slot + i * per; if (j >= 208) return false;
        if (j < 192) { u.pm = j / 3; u.pn = xcd + 8 * (j % 3); } else { const int q = j - 192; u.pm = 8 * xcd + (q >> 1); u.pn = 24 + (q & 1); }
        return true;
    }
    __device__ __forceinline__ void ptrs(const pg8::Unit& u, unsigned& A, unsigned& B) const {
        const unsigned x = (unsigned)WS_XB + (unsigned)u.pm * (256u * 1024u * 2u), w = (unsigned)WS_WIN + (unsigned)u.pn * (256u * 1024u * 2u);
        if (u.pn >= 21) { A = w; B = x; } else { A = x; B = w; }
    }
};
struct G1Epi {
    unsigned char* ws;
    __device__ __forceinline__ void operator()(const f32x4 (&acc)[2][2][4][2], const pg8::Unit& u, int wr, int wc, int fr, int fq) const {
        const int pn = u.pn, tok0 = u.pm * 256, n0 = pn * 256;
        if (pn >= 21) g1_epi<5>(acc, ws, n0, tok0, wr, wc, fr, fq);
        else if (pn >= 12) g1_epi<4>(acc, ws, tok0, n0, wr, wc, fr, fq);
        else if (pn >= 8) g1_epi<3>(acc, ws, tok0, n0, wr, wc, fr, fq);
        else if (pn >= 6) g1_epi<2>(acc, ws, tok0, n0, wr, wc, fr, fq);
        else if (pn >= 4) g1_epi<1>(acc, ws, tok0, n0, wr, wc, fr, fq);
        else g1_epi<0>(acc, ws, tok0, n0, wr, wc, fr, fq);
    }
};
__device__ __forceinline__ void phase_g1(const Params& p, int layer, unsigned char* lds) {
    unsigned char* ws = launder(p.ws);
    G1Order S; S.xcd = blockIdx.x & 7; S.slot = blockIdx.x >> 3; S.per = gridDim.x >> 3;
    G1Epi E; E.ws = ws;
    pg8::gemm_phase<G1Epi, G1Order>(lds, 1024, S, E, ltid(), ws);
}

__device__ __forceinline__ void load_tile64(const bf16_t* base, size_t rowStride, unsigned char* dst, int wid, int lane) {
    const int c = ((lane & 7) ^ (lane >> 3)) * 8;
#pragma unroll
    for (int i = 0; i < 2; ++i) { const int j = wid + 4 * i, row = 8 * j + (lane >> 3); glds16(base + (size_t)row * rowStride + c, dst + j * 1024); }
}
__device__ __forceinline__ void load_tile128(const bf16_t* base, size_t rowStride, unsigned char* dst, int wid, int lane) {
    const int c = ((lane & 7) ^ (lane >> 3)) * 8;
#pragma unroll
    for (int i = 0; i < 4; ++i) { const int j = wid + 4 * i, row = 8 * j + (lane >> 3); glds16(base + (size_t)row * rowStride + c, dst + j * 1024); }
}
__device__ __forceinline__ void load_tile128w(const bf16_t* base, size_t rowStride, unsigned char* dst, int wid, int lane) {
    const int c = ((lane & 15) ^ ((4 * wid + (lane >> 4)) & 15)) * 8;
#pragma unroll
    for (int i = 0; i < 8; ++i) { const int j = wid + 4 * i, row = 4 * j + (lane >> 4); glds16(base + (size_t)row * rowStride + c, dst + j * 1024); }
}
__device__ __forceinline__ bf16x8 lds_frag128(const unsigned char* tile, int row, int chunk) {
    return *(const bf16x8*)(tile + row * 128 + ((chunk ^ (row & 7)) << 4));
}
__device__ __forceinline__ bf16x8 lds_frag256(const unsigned char* tile, int row, int chunk) {
    return *(const bf16x8*)(tile + row * 256 + ((chunk ^ (row & 15)) << 4));
}
__device__ __forceinline__ bf16x8 lds_vfrag128(const unsigned char* tile, int row, int kbase, int fq) {
    const int ca = (kbase >> 3) + (fq >> 1), hb = (fq & 1) * 8;
    const u32x2 a = *(const u32x2*)(tile + row * 128 + ((ca ^ (row & 7)) << 4) + hb);
    const u32x2 b = *(const u32x2*)(tile + row * 128 + (((ca + 2) ^ (row & 7)) << 4) + hb);
    u32x4 w; w.x = a.x; w.y = a.y; w.z = b.x; w.w = b.y;
    return __builtin_bit_cast(bf16x8, w);
}
__device__ __forceinline__ bf16x8 lds_vfrag256(const unsigned char* tile, int row, int kbase, int fq) {
    const int ca = (kbase >> 3) + (fq >> 1), hb = (fq & 1) * 8;
    const u32x2 a = *(const u32x2*)(tile + row * 256 + ((ca ^ (row & 15)) << 4) + hb);
    const u32x2 b = *(const u32x2*)(tile + row * 256 + (((ca + 2) ^ (row & 15)) << 4) + hb);
    u32x4 w; w.x = a.x; w.y = a.y; w.z = b.x; w.w = b.y;
    return __builtin_bit_cast(bf16x8, w);
}
__device__ __forceinline__ bf16x8 pack8(f32x4 a, f32x4 b) {
    u32x4 w; w.x = pack2(a[0], a[1]); w.y = pack2(a[2], a[3]); w.z = pack2(b[0], b[1]); w.w = pack2(b[2], b[3]);
    return __builtin_bit_cast(bf16x8, w);
}

__device__ __forceinline__ float gelu_tanh(float x) {
    const float u = 0.7978845608028654f * (x + 0.044715f * x * x * x);
    return 0.5f * x * (1.f + tanhf(u));
}
__device__ __forceinline__ void compress_item(const Params& p, int layer, int item, unsigned char* lds, int half) {
    unsigned char* ws = launder(p.ws);
    const int tid = (ltid() & 255), lane = tid & 63, wid = tid >> 6, wr = wid >> 1, wc = wid & 1, fr = lane & 15, fq = lane >> 4;
    const int mtile = item & 3, g = (item >> 2) & 1, b = (item >> 3) & 1, kv = item >> 4;
    const int i0 = mtile * 128;
    const bf16_t* P = (const bf16_t*)(ws + WS_P);
    const bf16_t* W1T = (const bf16_t*)(ws + WS_W1T) + (size_t)kv * 64 * 2048;
    const int col = (kv ? C_VC : C_KC) + g * 64;
    const int ldc = ((lane & 7) ^ (lane >> 3)) * 8;
    const bf16_t* ap[4];
#pragma unroll
    for (int i = 0; i < 4; ++i) ap[i] = P + ((size_t)b * S_ + 16 * (i0 + 32 * i + 8 * wid + (lane >> 3))) * LD + col + ldc;
    const bf16_t* bp[2];
#pragma unroll
    for (int i = 0; i < 2; ++i) bp[i] = W1T + (size_t)(8 * (wid + 4 * i) + (lane >> 3)) * 2048 + ldc;
    f32x4 acc[4][2];
#pragma unroll
    for (int i = 0; i < 4; ++i)
#pragma unroll
        for (int j = 0; j < 2; ++j) acc[i][j] = (f32x4){0.f, 0.f, 0.f, 0.f};
    __syncthreads();
#define CSTAGE(buf, l) do { unsigned char* st_ = lds + (buf) * 24576; \
        _Pragma("unroll") for (int i = 0; i < 4; ++i) glds16(ap[i] + (size_t)(l) * LD, st_ + (4 * i + wid) * 1024); \
        _Pragma("unroll") for (int i = 0; i < 2; ++i) glds16(bp[i] + (l) * 64, st_ + 16384 + (wid + 4 * i) * 1024); } while (0)
    CSTAGE(0, 0); CSTAGE(1, 1);
    for (int l = 0; l < 32; ++l) {
        const unsigned char* st = lds + (l % 3) * 24576;
        if (l + 1 < 32) WAIT_V(6); else WAIT_V(0);
        RAW_BARRIER();
        if (l + 2 < 32) CSTAGE((l + 2) % 3, l + 2);
#pragma unroll
        for (int ks = 0; ks < 2; ++ks) {
            bf16x8 a[4], bb[2];
#pragma unroll
            for (int i = 0; i < 4; ++i) a[i] = lds_frag128(st, 64 * wr + 16 * i + fr, 4 * ks + fq);
#pragma unroll
            for (int j = 0; j < 2; ++j) bb[j] = lds_frag128(st + 16384, 32 * wc + 16 * j + fr, 4 * ks + fq);
#pragma unroll
            for (int i = 0; i < 4; ++i)
#pragma unroll
                for (int j = 0; j < 2; ++j) acc[i][j] = mfma16(a[i], bb[j], acc[i][j]);
        }
    }
    __syncthreads();
#undef CSTAGE
    float* hid = (float*)lds;
    const float* b1 = (const float*)(ws + WS_B1) + kv * 64;
#pragma unroll
    for (int j = 0; j < 2; ++j) {
        const int n = 32 * wc + 16 * j + fr; const float bias = b1[n + vzero()];
#pragma unroll
        for (int i = 0; i < 4; ++i)
#pragma unroll
            for (int r = 0; r < 4; ++r) hid[(64 * wr + 16 * i + 4 * fq + r) * 65 + n] = gelu_tanh(acc[i][j][r] + bias);
    }
    __syncthreads();
    {
        const int row = tid >> 1, nb = (tid & 1) * 32, ci = i0 + row;
        const float* w2 = p.cmp_w2 + ((size_t)layer * 2 + kv) * 64 * 64;
        float o[32];
#pragma unroll
        for (int q = 0; q < 32; ++q) o[q] = 0.f;
        for (int n = 0; n < 64; ++n) {
            const float h = hid[row * 65 + n];
#pragma unroll
            for (int q4 = 0; q4 < 8; ++q4) { const float4 w = *(const float4*)(w2 + n * 64 + nb + 4 * q4); o[4 * q4] += h * w.x; o[4 * q4 + 1] += h * w.y; o[4 * q4 + 2] += h * w.z; o[4 * q4 + 3] += h * w.w; }
        }
        if (kv == 0) {
            bf16_t* dst = (bf16_t*)(ws + WS_KCC) + ((size_t)(b * 2 + g) * 512 + ci) * 64 + nb;
#pragma unroll
            for (int q = 0; q < 32; q += 4) { f32x4 v = {o[q], o[q + 1], o[q + 2], o[q + 3]}; if (ci >= 511) v = (f32x4){0.f, 0.f, 0.f, 0.f}; *(u32x2*)(dst + q) = pack4(v); }
        } else {
            bf16_t* dst = (bf16_t*)(ws + WS_VCCT) + ((size_t)(b * 2 + g) * 64 + nb) * 512 + ci;
#pragma unroll
            for (int q = 0; q < 32; ++q) dst[(size_t)q * 512] = f2bf(ci >= 511 ? 0.f : o[q]);
        }
    }
    __syncthreads();
}

__device__ __forceinline__ float ret_lg2(int h) { const float gam = 1.f - exp2f(-5.f - (float)h); return log2f(gam); }

__device__ __forceinline__ void retkv_item(const Params& p, int item, unsigned char* lds, int half) {
    unsigned char* ws = launder(p.ws);
    const int tid = (ltid() & 255), lane = tid & 63, wid = tid >> 6, fr = lane & 15, fq = lane >> 4;
    const int n = item & 63, h = (item >> 6) & 7, b = item >> 9;
    const size_t tok0 = (size_t)b * S_ + 128 * n;
    unsigned char* vL = lds; unsigned char* kL = lds + 32768;
    load_tile128w((const bf16_t*)(ws + WS_VRT) + ((size_t)(b * 8 + h) * 128) * S_ + 128 * n, S_, vL, wid, lane);
    load_tile128((const bf16_t*)(ws + WS_P) + tok0 * LD + C_KR + h * 64, LD, kL, wid, lane);
    wait_vm0(); __syncthreads();
    const float lg2 = ret_lg2(h);
    f32x4 acc[2][4];
#pragma unroll
    for (int m = 0; m < 2; ++m)
#pragma unroll
        for (int nt = 0; nt < 4; ++nt) acc[m][nt] = (f32x4){0.f, 0.f, 0.f, 0.f};
#pragma unroll
    for (int ks = 0; ks < 4; ++ks) {
        bf16x8 a[2], bb[4];
#pragma unroll
        for (int m = 0; m < 2; ++m) a[m] = lds_frag256(vL, 32 * wid + 16 * m + fr, 4 * ks + fq);
        float dec[8];
#pragma unroll
        for (int j = 0; j < 8; ++j) dec[j] = exp2f((float)(127 - (32 * ks + 8 * fq + j)) * lg2);
#pragma unroll
        for (int nt = 0; nt < 4; ++nt) {
            const int d = 16 * nt + fr;
            float v[8];
#pragma unroll
            for (int j = 0; j < 8; ++j) {
                const int tk = 32 * ks + 8 * fq + j;
                const bf16_t kvv = *(const bf16_t*)(kL + tk * 128 + (((d >> 3) ^ (tk & 7)) << 4) + (d & 7) * 2);
                v[j] = bf2f(kvv) * dec[j];
            }
            u32x4 w; w.x = pack2(v[0], v[1]); w.y = pack2(v[2], v[3]); w.z = pack2(v[4], v[5]); w.w = pack2(v[6], v[7]);
            bb[nt] = __builtin_bit_cast(bf16x8, w);
        }
#pragma unroll
        for (int m = 0; m < 2; ++m)
#pragma unroll
            for (int nt = 0; nt < 4; ++nt) acc[m][nt] = mfma16(a[m], bb[nt], acc[m][nt]);
    }
    float* KVT = (float*)(ws + WS_KVT) + ((size_t)(b * 8 + h) * 64 + n) * 8192;
#pragma unroll
    for (int m = 0; m < 2; ++m)
#pragma unroll
        for (int nt = 0; nt < 4; ++nt)
#pragma unroll
            for (int r = 0; r < 4; ++r) KVT[(32 * wid + 16 * m + 4 * fq + r) * 64 + 16 * nt + fr] = acc[m][nt][r];
    __syncthreads();
}

__device__ __forceinline__ void phase_p2(const Params& p, int layer, unsigned char* lds, int half) {
    const int vb = blockIdx.x * 2 + half, nvb = gridDim.x * 2;
    if (vb < 32) compress_item(p, layer, vb, lds, half);
    else for (int it = vb - 32; it < 1024; it += nvb - 32) retkv_item(p, it, lds, half);
}

constexpr int NSA_IMP = 32768, NSA_BUCKET = 65792, NSA_BIAS = 73984;

struct NsaLane { int t; int fr, fq, wid, lane; };

template <int BR, int PASS>
__device__ __forceinline__ void nsa_half(const unsigned char* kL, const unsigned char* vL, const unsigned char* lds, const bf16x8 (&qptr)[4][2],
                                         f32x4 (&O)[4][4], float (&m)[4], float (&l)[4], int tile, int hf, bool selbit, const NsaLane& L, int qrow) {
    const int fr = L.fr, fq = L.fq;
    bf16x8 Kf[2][2];
#pragma unroll
    for (int i = 0; i < 2; ++i)
#pragma unroll
        for (int ks = 0; ks < 2; ++ks) Kf[i][ks] = lds_frag128(kL, 32 * hf + 16 * i + fr, 4 * ks + fq);
    bf16x8 Vf[4];
    if (PASS != 0) {
#pragma unroll
        for (int mt = 0; mt < 4; ++mt) Vf[mt] = lds_vfrag128(vL, 16 * mt + fr, 32 * hf, fq);
    }
    unsigned vmask = 0; unsigned bk[2];
    const unsigned char* bucketL = lds + NSA_BUCKET;
#pragma unroll
    for (int i = 0; i < 2; ++i) {
        unsigned pk = 0;
#pragma unroll
        for (int r = 0; r < 4; ++r) {
            const int kk = 32 * hf + 16 * i + 4 * fq + r;
            int rel; bool ok;
            if (BR == 0) { rel = L.t - (16 * (64 * tile + kk) + 31); ok = rel >= 0; }
            else if (BR == 1) { rel = L.t - (64 * tile + kk); ok = selbit && rel >= 0; }
            else { rel = L.t - (64 * tile + kk); ok = rel >= 0 && rel < 512; }
            int rc = rel < 0 ? 0 : rel; rc = rc > 8191 ? 8191 : rc;
            pk |= (unsigned)bucketL[rc] << (8 * r);
            vmask |= (ok ? 1u : 0u) << (4 * i + r);
        }
        bk[i] = pk;
    }
    const float* biasL = (const float*)(lds + NSA_BIAS);
    float ia[2] = {0.f, 0.f}, ic[2] = {0.f, 0.f};
#pragma unroll
    for (int nt = 0; nt < 4; ++nt) {
        f32x4 S[2];
        const bf16x8 q0 = qptr[nt][0], q1 = qptr[nt][1];
#pragma unroll
        for (int i = 0; i < 2; ++i) {
            S[i] = (f32x4){0.f, 0.f, 0.f, 0.f};
            S[i] = mfma16(Kf[i][0], q0, S[i]); S[i] = mfma16(Kf[i][1], q1, S[i]);
        }
        float tmax = -1e30f;
        float bsv[2][4];
#pragma unroll
        for (int i = 0; i < 2; ++i)
#pragma unroll
            for (int r = 0; r < 4; ++r) bsv[i][r] = biasL[nt * 32 + ((bk[i] >> (8 * r)) & 0xffu)];
        asm volatile("" : "+v"(bsv[0][0]), "+v"(bsv[0][1]), "+v"(bsv[0][2]), "+v"(bsv[0][3]), "+v"(bsv[1][0]), "+v"(bsv[1][1]), "+v"(bsv[1][2]), "+v"(bsv[1][3]));
#pragma unroll
        for (int i = 0; i < 2; ++i)
#pragma unroll
            for (int r = 0; r < 4; ++r) {
                const bool ok = (vmask >> (4 * i + r)) & 1u;
                const float sv = S[i][r] * 0.125f + bsv[i][r];
                S[i][r] = ok ? sv : -1e30f; tmax = fmaxf(tmax, S[i][r]);
            }
        if (PASS != 1) {
            tmax = rows_max(tmax);
            const float mnew = fmaxf(m[nt], tmax), alpha = __expf(m[nt] - mnew);
            float psum = 0.f;
#pragma unroll
            for (int i = 0; i < 2; ++i)
#pragma unroll
                for (int r = 0; r < 4; ++r) {
                    const bool ok = (vmask >> (4 * i + r)) & 1u;
                    const float pv = ok ? __expf(S[i][r] - mnew) : 0.f;
                    S[i][r] = pv; psum += pv;
                }
            psum = rows_sum(psum);
            l[nt] = l[nt] * alpha + psum; m[nt] = mnew;
            if (PASS == 2) {
#pragma unroll
                for (int mt = 0; mt < 4; ++mt) O[mt][nt] = O[mt][nt] * alpha;
            }
        } else {
#pragma unroll
            for (int i = 0; i < 2; ++i) {
#pragma unroll
                for (int r = 0; r < 4; ++r) {
                    const bool ok = (vmask >> (4 * i + r)) & 1u;
                    S[i][r] = ok ? __expf(S[i][r] - m[nt]) * l[nt] : 0.f;
                }
                ia[i] += S[i][0] + S[i][1] + S[i][2] + 0.5f * S[i][3];
                ic[i] += 0.5f * S[i][3];
            }
        }
        if (PASS != 0) {
            const bf16x8 Pb = pack8(S[0], S[1]);
#pragma unroll
            for (int mt = 0; mt < 4; ++mt) O[mt][nt] = mfma16(Vf[mt], Pb, O[mt][nt]);
        }
    }
    if (PASS == 1) {
        float* imp = (float*)(lds + NSA_IMP) + qrow * 129;
        asm volatile("" ::: "memory"); __builtin_amdgcn_wave_barrier();
#pragma unroll
        for (int i = 0; i < 2; ++i) { const int j = 16 * tile + 8 * hf + 4 * i + fq; imp[j] += ia[i]; }
        asm volatile("s_waitcnt lgkmcnt(0)" ::: "memory"); __builtin_amdgcn_wave_barrier();
#pragma unroll
        for (int i = 0; i < 2; ++i) { const int j = 16 * tile + 8 * hf + 4 * i + fq + 1; if (j < 128) imp[j] += ic[i]; }
        asm volatile("s_waitcnt lgkmcnt(0)" ::: "memory"); __builtin_amdgcn_wave_barrier();
    }
}
template <int BR, int PASS>
__device__ __forceinline__ void nsa_tile(const unsigned char* kL, const unsigned char* vL, const unsigned char* lds, const bf16x8 (&qptr)[4][2],
                                         f32x4 (&O)[4][4], float (&m)[4], float (&l)[4], int tile, bool selbit, const NsaLane& L, int qrow) {
#pragma unroll 1
    for (int hf = 0; hf < 2; ++hf) nsa_half<BR, PASS>(kL, vL, lds, qptr, O, m, l, tile, hf, selbit, L, qrow);
}

__device__ __forceinline__ void cmp_item(const Params& p, int item, unsigned char* lds, int half) {
    unsigned char* ws = launder(p.ws);
    const int tid = (ltid() & 255), lane = tid & 63, wid = tid >> 6, fr = lane & 15, fq = lane >> 4;
    const int combo = item & 3, qt = 127 - (item >> 2), b = combo >> 1, g = combo & 1;
    const int q0 = qt * 64, qrow = 16 * wid + fr;
    NsaLane L; L.t = q0 + qrow; L.fr = fr; L.fq = fq; L.wid = wid; L.lane = lane;
    const size_t tok = (size_t)b * S_ + L.t;
    const bf16_t* P = (const bf16_t*)(ws + WS_P);
    __syncthreads();
    if (tid < 128) ((float*)(lds + NSA_BIAS))[tid] = p.rel_bias[(tid & 31) * 8 + 4 * g + (tid >> 5)];
    for (int i = tid; i < 64 * 129; i += HT) ((float*)(lds + NSA_IMP))[i] = 0.f;
    bf16x8 Qf[4][2];
#pragma unroll
    for (int nt = 0; nt < 4; ++nt)
#pragma unroll
        for (int ks = 0; ks < 2; ++ks) Qf[nt][ks] = *(const bf16x8*)(P + tok * LD + C_QA + (4 * g + nt) * 64 + 32 * ks + 8 * fq);
    __syncthreads();
    f32x4 O[4][4]; float m[4], l[4];
    const bf16_t* gates = P + tok * LD + C_GA + (4 * g) * 3;
    const bf16_t* kc = (const bf16_t*)(ws + WS_KCC) + (size_t)(b * 2 + g) * 512 * 64;
    const bf16_t* vc = (const bf16_t*)(ws + WS_VCCT) + (size_t)(b * 2 + g) * 64 * 512;
    const int ntc = ((q0 + 32) >> 4) / 64 + 1;
#pragma unroll
    for (int nt = 0; nt < 4; ++nt) { m[nt] = -1e30f; l[nt] = 0.f; }
    load_tile64(kc, 64, lds, wid, lane);
    wait_vm0(); __syncthreads();
    for (int it = 0; it < ntc; ++it) {
        unsigned char* cur = lds + (it & 1) * 16384;
        if (it + 1 < ntc) load_tile64(kc + (size_t)(it + 1) * 64 * 64, 64, lds + ((it + 1) & 1) * 16384, wid, lane);
        nsa_tile<0, 0>(cur, cur + 8192, lds, Qf, O, m, l, it, true, L, qrow);
        wait_vm0(); __syncthreads();
    }
#pragma unroll
    for (int nt = 0; nt < 4; ++nt) l[nt] = l[nt] > 0.f ? 1.f / l[nt] : 0.f;
#pragma unroll
    for (int mt = 0; mt < 4; ++mt)
#pragma unroll
        for (int nt = 0; nt < 4; ++nt) O[mt][nt] = (f32x4){0.f, 0.f, 0.f, 0.f};
    load_tile64(kc, 64, lds, wid, lane); load_tile64(vc, 512, lds + 8192, wid, lane);
    wait_vm0(); __syncthreads();
    for (int it = 0; it < ntc; ++it) {
        unsigned char* cur = lds + (it & 1) * 16384;
        if (it + 1 < ntc) { unsigned char* nx = lds + ((it + 1) & 1) * 16384;
            load_tile64(kc + (size_t)(it + 1) * 64 * 64, 64, nx, wid, lane); load_tile64(vc + (it + 1) * 64, 512, nx + 8192, wid, lane); }
        nsa_tile<0, 1>(cur, cur + 8192, lds, Qf, O, m, l, it, true, L, qrow);
        wait_vm0(); __syncthreads();
    }
    bf16_t* YC = (bf16_t*)(ws + WS_YC) + tok * 512 + (4 * g) * 64;
#pragma unroll
    for (int nt = 0; nt < 4; ++nt) {
        const float gt = bf2f(gates[nt * 3 + 0]);
#pragma unroll
        for (int mt = 0; mt < 4; ++mt) *(u32x2*)(YC + nt * 64 + 16 * mt + 4 * fq) = pack4(O[mt][nt] * gt);
    }
    const int cur = qt;
    {
        float* imp = (float*)(lds + NSA_IMP) + qrow * 129 + 32 * fq;
        asm volatile("s_waitcnt lgkmcnt(0)" ::: "memory"); __builtin_amdgcn_wave_barrier();
#pragma unroll
        for (int i = 0; i < 32; ++i) {
            const int j = 32 * fq + i;
            const float v = imp[i];
            imp[i] = j > cur ? -1.f : v + ((j == 0 || j == cur || j == cur - 1) ? 1.0e4f : 0.f);
        }
        unsigned word = 0;
#pragma unroll 1
        for (int round = 0; round < 16; ++round) {
            float bv = imp[0]; int bi = 0;
#pragma unroll
            for (int i = 1; i < 32; ++i) { const float v = imp[i]; if (v > bv) { bv = v; bi = i; } }
            int gi = 32 * fq + bi;
            {
                u32x2 rv = __builtin_amdgcn_permlane16_swap(__float_as_uint(bv), __float_as_uint(bv), false, false);
                u32x2 ri = __builtin_amdgcn_permlane16_swap((unsigned)gi, (unsigned)gi, false, false);
                float v0 = __uint_as_float(rv.x), v1 = __uint_as_float(rv.y); int i0 = (int)ri.x, i1 = (int)ri.y;
                if (v1 > v0 || (v1 == v0 && i1 < i0)) { v0 = v1; i0 = i1; }
                rv = __builtin_amdgcn_permlane32_swap(__float_as_uint(v0), __float_as_uint(v0), false, false);
                ri = __builtin_amdgcn_permlane32_swap((unsigned)i0, (unsigned)i0, false, false);
                v0 = __uint_as_float(rv.x); v1 = __uint_as_float(rv.y); i0 = (int)ri.x; i1 = (int)ri.y;
                if (v1 > v0 || (v1 == v0 && i1 < i0)) { v0 = v1; i0 = i1; }
                bv = v0; gi = i0;
            }
            if (bv >= 0.f && (gi >> 5) == fq) { word |= 1u << (gi & 31); imp[gi & 31] = -2.f; }
        }
        ((unsigned*)(ws + WS_SELW))[(tok * 2 + g) * 4 + fq] = word;
    }
}

__device__ __forceinline__ void win_item(const Params& p, int item, unsigned char* lds, int half) {
    unsigned char* ws = launder(p.ws);
    const int tid = (ltid() & 255), lane = tid & 63, wid = tid >> 6, fr = lane & 15, fq = lane >> 4;
    const int combo = item & 3, qt = 127 - (item >> 2), b = combo >> 1, g = combo & 1;
    const int q0 = qt * 64, qrow = 16 * wid + fr;
    NsaLane L; L.t = q0 + qrow; L.fr = fr; L.fq = fq; L.wid = wid; L.lane = lane;
    const size_t tok = (size_t)b * S_ + L.t;
    const bf16_t* P = (const bf16_t*)(ws + WS_P);
    __syncthreads();
    if (tid < 128) ((float*)(lds + NSA_BIAS))[tid] = p.rel_bias[(tid & 31) * 8 + 4 * g + (tid >> 5)];
    bf16x8 Qf[4][2];
#pragma unroll
    for (int nt = 0; nt < 4; ++nt)
#pragma unroll
        for (int ks = 0; ks < 2; ++ks) Qf[nt][ks] = *(const bf16x8*)(P + tok * LD + C_QA + (4 * g + nt) * 64 + 32 * ks + 8 * fq);
    __syncthreads();
    f32x4 O[4][4]; float m[4], l[4];
    const bf16_t* gates = P + tok * LD + C_GA + (4 * g) * 3;
#pragma unroll
    for (int nt = 0; nt < 4; ++nt) { m[nt] = -1e30f; l[nt] = 0.f; }
#pragma unroll
    for (int mt = 0; mt < 4; ++mt)
#pragma unroll
        for (int nt = 0; nt < 4; ++nt) O[mt][nt] = (f32x4){0.f, 0.f, 0.f, 0.f};
    {
        const bf16_t* kb = P + ((size_t)b * S_) * LD + C_KW + g * 64;
        const bf16_t* vb = (const bf16_t*)(ws + WS_VWT) + (size_t)(b * 2 + g) * 64 * S_;
        const int k_lo = qt - 8 > 0 ? qt - 8 : 0, ntw = qt - k_lo + 1;
        load_tile64(kb + (size_t)k_lo * 64 * LD, LD, lds, wid, lane); load_tile64(vb + k_lo * 64, S_, lds + 8192, wid, lane);
        wait_vm0(); __syncthreads();
        for (int it = 0; it < ntw; ++it) {
            unsigned char* cu = lds + (it & 1) * 16384;
            if (it + 1 < ntw) { unsigned char* nx = lds + ((it + 1) & 1) * 16384;
                load_tile64(kb + (size_t)(k_lo + it + 1) * 64 * LD, LD, nx, wid, lane); load_tile64(vb + (k_lo + it + 1) * 64, S_, nx + 8192, wid, lane); }
            nsa_tile<2, 2>(cu, cu + 8192, lds, Qf, O, m, l, k_lo + it, true, L, qrow);
            wait_vm0(); __syncthreads();
        }
    }
    bf16_t* YW = (bf16_t*)(ws + WS_YW) + tok * 512 + (4 * g) * 64;
#pragma unroll
    for (int nt = 0; nt < 4; ++nt) {
        const float gt = bf2f(gates[nt * 3 + 2]) * (l[nt] > 0.f ? 1.f / l[nt] : 0.f);
#pragma unroll
        for (int mt = 0; mt < 4; ++mt) *(u32x2*)(YW + nt * 64 + 16 * mt + 4 * fq) = pack4(O[mt][nt] * gt);
    }
}

constexpr int SEL_RING = 8, SEL_BUCKET = SEL_RING * 16384, SEL_BIAS2 = SEL_BUCKET + 8192;
constexpr float LOG2E = 1.4426950408889634f;
__device__ __forceinline__ int t5_first(int bk) {
    const int th[16] = {16, 22, 30, 40, 54, 73, 99, 134, 182, 246, 332, 450, 609, 825, 1117, 1513};
    int r = 16;
#pragma unroll
    for (int k = 0; k < 16; ++k) r = (bk == 16 + k) ? th[k] : r;
    return r;
}
template <bool FAST>
__device__ __forceinline__ void sel_ntile(const bf16x8 (&Kf)[4][2], const unsigned char* vL, int fr, int fq, const bf16x8& q0, const bf16x8& q1, f32x4 (&O)[4], float& m, float& l,
                                          bool sb, int relb, int th, float blo, float bhi, const unsigned char* lds, int hl) {
    f32x4 S[4];
#pragma unroll
    for (int i = 0; i < 4; ++i) { S[i] = (f32x4){0.f, 0.f, 0.f, 0.f}; S[i] = mfma16(Kf[i][0], q0, S[i]); S[i] = mfma16(Kf[i][1], q1, S[i]); }
    float tmax = -1e30f;
    const float scl = (!FAST || sb) ? 0.125f * LOG2E : 0.f;
    if (FAST) { blo = (sb ? blo : -1e30f) - m; bhi = (sb ? bhi : -1e30f) - m; }
    if (FAST) {
#pragma unroll
        for (int i = 0; i < 4; ++i)
#pragma unroll
            for (int r = 0; r < 4; ++r) { const int rel = relb - (16 * i + r); S[i][r] = S[i][r] * scl + (rel >= th ? bhi : blo); tmax = fmaxf(tmax, S[i][r]); }
    } else {
        unsigned bkt[4][4]; float bs[4][4];
#pragma unroll
        for (int i = 0; i < 4; ++i)
#pragma unroll
            for (int r = 0; r < 4; ++r) { const int rel = relb - (16 * i + r); int rc = rel < 0 ? 0 : rel; rc = rc > 8191 ? 8191 : rc; bkt[i][r] = (lds + SEL_BUCKET)[rc]; }
#pragma unroll
        for (int i = 0; i < 4; ++i)
#pragma unroll
            for (int r = 0; r < 4; ++r) bs[i][r] = ((const float*)(lds + SEL_BIAS2))[hl * 32 + bkt[i][r]];
        asm volatile("" : "+v"(bs[0][0]), "+v"(bs[0][1]), "+v"(bs[0][2]), "+v"(bs[0][3]), "+v"(bs[1][0]), "+v"(bs[1][1]), "+v"(bs[1][2]), "+v"(bs[1][3]),
                          "+v"(bs[2][0]), "+v"(bs[2][1]), "+v"(bs[2][2]), "+v"(bs[2][3]), "+v"(bs[3][0]), "+v"(bs[3][1]), "+v"(bs[3][2]), "+v"(bs[3][3]));
        const float ninf = -1e30f;
#pragma unroll
        for (int i = 0; i < 4; ++i)
#pragma unroll
            for (int r = 0; r < 4; ++r) {
                const int rel = relb - (16 * i + r);
                const float sv = S[i][r] * (0.125f * LOG2E) + (bs[i][r] - m);
                S[i][r] = (sb && rel >= 0) ? sv : ninf; tmax = fmaxf(tmax, S[i][r]);
            }
    }
    tmax = rows_max(tmax);
    if (__ballot(tmax > 8.f) != 0ull) {
        const float d = fmaxf(tmax, 0.f), alpha = __builtin_amdgcn_exp2f(-d);
        m += d; l *= alpha;
#pragma unroll
        for (int mt = 0; mt < 4; ++mt) O[mt] = O[mt] * alpha;
#pragma unroll
        for (int i = 0; i < 4; ++i)
#pragma unroll
            for (int r = 0; r < 4; ++r) S[i][r] -= d;
    }
    float psum = 0.f;
#pragma unroll
    for (int i = 0; i < 4; ++i)
#pragma unroll
        for (int r = 0; r < 4; ++r) { const float pv = __builtin_amdgcn_exp2f(S[i][r]); S[i][r] = pv; psum += pv; }
    l += rows_sum(psum);
    const bf16x8 Pb0 = pack8(S[0], S[1]), Pb1 = pack8(S[2], S[3]);
#pragma unroll
    for (int mt = 0; mt < 4; ++mt) { O[mt] = mfma16(lds_vfrag128(vL, 16 * mt + fr, 0, fq), Pb0, O[mt]); O[mt] = mfma16(lds_vfrag128(vL, 16 * mt + fr, 32, fq), Pb1, O[mt]); }
}
__device__ __forceinline__ void sel_ntile2_fast(const bf16x8 (&Kf)[4][2], const unsigned char* vL, int fr, int fq, const bf16x8 (&Qf)[2][2], f32x4 (&O)[2][4], float (&m)[2], float (&l)[2],
                                                const bool (&sb)[2], const int (&relb)[2], int th, float blo, float bhi) {
    f32x4 S[2][4]; float tmax[2], bl[2], bh[2], scl[2];
#pragma unroll
    for (int b = 0; b < 2; ++b)
#pragma unroll
        for (int i = 0; i < 4; ++i) { S[b][i] = (f32x4){0.f, 0.f, 0.f, 0.f}; S[b][i] = mfma16(Kf[i][0], Qf[b][0], S[b][i]); S[b][i] = mfma16(Kf[i][1], Qf[b][1], S[b][i]); }
#pragma unroll
    for (int b = 0; b < 2; ++b) { scl[b] = sb[b] ? 0.125f * LOG2E : 0.f; bl[b] = (sb[b] ? blo : -1e30f) - m[b]; bh[b] = (sb[b] ? bhi : -1e30f) - m[b]; tmax[b] = -1e30f; }
#pragma unroll
    for (int b = 0; b < 2; ++b)
#pragma unroll
        for (int i = 0; i < 4; ++i)
#pragma unroll
            for (int r = 0; r < 4; ++r) { const int rel = relb[b] - (16 * i + r); S[b][i][r] = S[b][i][r] * scl[b] + (rel >= th ? bh[b] : bl[b]); tmax[b] = fmaxf(tmax[b], S[b][i][r]); }
#pragma unroll
    for (int b = 0; b < 2; ++b) tmax[b] = rows_max(tmax[b]);
    if (__ballot(tmax[0] > 8.f || tmax[1] > 8.f) != 0ull) {
#pragma unroll
        for (int b = 0; b < 2; ++b) {
            const float d = fmaxf(tmax[b], 0.f), alpha = __builtin_amdgcn_exp2f(-d);
            m[b] += d; l[b] *= alpha;
#pragma unroll
            for (int mt = 0; mt < 4; ++mt) O[b][mt] = O[b][mt] * alpha;
#pragma unroll
            for (int i = 0; i < 4; ++i)
#pragma unroll
                for (int r = 0; r < 4; ++r) S[b][i][r] -= d;
        }
    }
    float psum[2] = {0.f, 0.f};
#pragma unroll
    for (int b = 0; b < 2; ++b)
#pragma unroll
        for (int i = 0; i < 4; ++i)
#pragma unroll
            for (int r = 0; r < 4; ++r) { const float pv = __builtin_amdgcn_exp2f(S[b][i][r]); S[b][i][r] = pv; psum[b] += pv; }
#pragma unroll
    for (int b = 0; b < 2; ++b) l[b] += rows_sum(psum[b]);
    bf16x8 P0[2], P1[2];
#pragma unroll
    for (int b = 0; b < 2; ++b) { P0[b] = pack8(S[b][0], S[b][1]); P1[b] = pack8(S[b][2], S[b][3]); }
#pragma unroll
    for (int mt = 0; mt < 4; ++mt) {
        const bf16x8 v0 = lds_vfrag128(vL, 16 * mt + fr, 0, fq), v1 = lds_vfrag128(vL, 16 * mt + fr, 32, fq);
#pragma unroll
        for (int b = 0; b < 2; ++b) { O[b][mt] = mfma16(v0, P0[b], O[b][mt]); O[b][mt] = mfma16(v1, P1[b], O[b][mt]); }
    }
}
template <bool FAST>
__device__ __forceinline__ void sel_tile(const unsigned char* kL, const unsigned char* vL, const unsigned char* lds, const bf16x8 (&Qf)[2][2], f32x4 (&O)[2][4], float (&m)[2], float (&l)[2],
                                         const bool (&sb)[2], const bool (&need)[2], const int (&relb)[2], int th, float blo, float bhi, int hl, int fr, int fq) {
    bf16x8 Kf[4][2];
#pragma unroll
    for (int i = 0; i < 4; ++i)
#pragma unroll
        for (int ks = 0; ks < 2; ++ks) Kf[i][ks] = lds_frag128(kL, 16 * i + fr, 4 * ks + fq);
    if (FAST && need[0] && need[1]) { sel_ntile2_fast(Kf, vL, fr, fq, Qf, O, m, l, sb, relb, th, blo, bhi); return; }
    if (need[0]) sel_ntile<FAST>(Kf, vL, fr, fq, Qf[0][0], Qf[0][1], O[0], m[0], l[0], sb[0], relb[0], th, blo, bhi, lds, hl);
    if (need[1]) sel_ntile<FAST>(Kf, vL, fr, fq, Qf[1][0], Qf[1][1], O[1], m[1], l[1], sb[1], relb[1], th, blo, bhi, lds, hl);
}
template <int VAR>
__device__ __forceinline__ void sel_item(const Params& p, int v, unsigned char* lds) {
    unsigned char* ws = launder(p.ws);
    const int tid = ltid(), lane = tid & 63, wid = tid >> 6, fr = lane & 15, fq = lane >> 4;
    const int qt = 127 - (v >> 2), sub = v & 3, b = sub >> 1, g = sub & 1;
    const int q0 = qt * 64, cur = qt, hl = fr & 3;
    const bf16_t* P = (const bf16_t*)(ws + WS_P);
    __syncthreads();
    if (tid < 128) ((float*)(lds + SEL_BIAS2))[tid] = p.rel_bias[(tid & 31) * 8 + 4 * g + (tid >> 5)] * LOG2E;
    int t[2]; size_t tok[2]; bf16x8 Qf[2][2]; unsigned selw[2][4];
#pragma unroll
    for (int nt = 0; nt < 2; ++nt) {
        t[nt] = q0 + 8 * wid + 4 * nt + (fr >> 2); tok[nt] = (size_t)b * S_ + t[nt];
#pragma unroll
        for (int ks = 0; ks < 2; ++ks) Qf[nt][ks] = *(const bf16x8*)(P + tok[nt] * LD + C_QA + (4 * g + hl) * 64 + 32 * ks + 8 * fq);
        const u32x4 w = *(const u32x4*)((const unsigned*)(ws + WS_SELW) + (tok[nt] * 2 + g) * 4);
        selw[nt][0] = w.x; selw[nt][1] = w.y; selw[nt][2] = w.z; selw[nt][3] = w.w;
    }
    f32x4 O[2][4]; float m[2], l[2];
#pragma unroll
    for (int nt = 0; nt < 2; ++nt) { m[nt] = -1000.f; l[nt] = 0.f;
#pragma unroll
        for (int mt = 0; mt < 4; ++mt) O[nt][mt] = (f32x4){0.f, 0.f, 0.f, 0.f}; }
    const bf16_t* kb = P + ((size_t)b * S_) * LD + C_KS + g * 64;
    const bf16_t* vb = (const bf16_t*)(ws + WS_VST) + (size_t)(b * 2 + g) * 64 * S_;
    const int nts = cur + 1;
#define SEL_ISSUE(jj) do { unsigned char* st_ = lds + ((jj) & 7) * 16384; const int c_ = ((lane & 7) ^ (lane >> 3)) * 8, r_ = 8 * wid + (lane >> 3); \
        glds16(kb + ((size_t)(jj) * 64 + r_) * LD + c_, st_ + wid * 1024); glds16(vb + (size_t)r_ * S_ + (jj) * 64 + c_, st_ + 8192 + wid * 1024); } while (0)
    asm volatile("s_waitcnt vmcnt(0)" ::: "memory");
#pragma unroll
    for (int q = 0; q < 4; ++q) if (q < nts) SEL_ISSUE(q);
    const unsigned char* bucketL = lds + SEL_BUCKET;
    for (int jp = 0; jp < nts; jp += 4) {
        WAIT_V(0);
        RAW_BARRIER();
#pragma unroll
        for (int q = 4; q < 8; ++q) if (jp + q < nts) SEL_ISSUE(jp + q);
#pragma unroll 1
      for (int j = jp; j < jp + 4 && j < nts; ++j) {
        const unsigned char* cu = lds + (j & 7) * 16384;
        bool sb[2], need[2]; int relb[2];
#pragma unroll
        for (int nt = 0; nt < 2; ++nt) {
            const unsigned w = j < 32 ? selw[nt][0] : j < 64 ? selw[nt][1] : j < 96 ? selw[nt][2] : selw[nt][3];
            sb[nt] = (w >> (j & 31)) & 1u; need[nt] = __ballot(sb[nt]) != 0ull; relb[nt] = t[nt] - 64 * j - 4 * fq;
        }
        if (VAR == 1) { need[0] = false; need[1] = false; }
        if (VAR == 2) { if (!(need[0] || need[1])) { need[0] = false; } else { need[0] = true; need[1] = true; } }
        if (need[0] || need[1]) {
            const int rmin = q0 - 64 * j - 63, rmax = q0 + 31 - 64 * j;
            bool fast = false; int th = 0; float blo = 0.f, bhi = 0.f;
            if (rmin >= 16) {
                const int b0 = bucketL[rmin], b1 = bucketL[rmax > 8191 ? 8191 : rmax];
                if (b1 - b0 <= 1) { fast = true; th = t5_first(b1); if (b1 == b0) th = 0;
                    blo = ((const float*)(lds + SEL_BIAS2))[hl * 32 + b0]; bhi = ((const float*)(lds + SEL_BIAS2))[hl * 32 + b1]; }
            }
            if (fast) sel_tile<true>(cu, cu + 8192, lds, Qf, O, m, l, sb, need, relb, th, blo, bhi, hl, fr, fq);
            else sel_tile<false>(cu, cu + 8192, lds, Qf, O, m, l, sb, need, relb, th, blo, bhi, hl, fr, fq);
        }
      }
    }
#undef SEL_ISSUE
    __syncthreads();
#pragma unroll
    for (int nt = 0; nt < 2; ++nt) {
        const float gt = bf2f(P[tok[nt] * LD + C_GA + (4 * g + hl) * 3 + 1]) * (l[nt] > 0.f ? 1.f / l[nt] : 0.f);
        const size_t o = tok[nt] * 512 + (4 * g + hl) * 64;
#pragma unroll
        for (int mt = 0; mt < 4; ++mt) {
            const f32x4 yc = unpack4(*(const u32x2*)((const bf16_t*)(ws + WS_YC) + o + 16 * mt + 4 * fq));
            const f32x4 yw = unpack4(*(const u32x2*)((const bf16_t*)(ws + WS_YW) + o + 16 * mt + 4 * fq));
            if (VAR == 0 || VAR == 3) *(u32x2*)((bf16_t*)(ws + WS_YA) + o + 16 * mt + 4 * fq) = pack4(yc + yw + O[nt][mt] * gt);
            else asm volatile("" :: "v"(O[nt][mt]));
        }
    }
}

__device__ __forceinline__ void scan_item(const Params& p, int item, int half) {
    unsigned char* ws = launder(p.ws);
    const int idx = item * HT + (ltid() & 255);
    const int bh = idx >> 13, ed = idx & 8191, h = bh & 7;
    const float dec = exp2f(128.f * ret_lg2(h));
    const float* KVT = (const float*)(ws + WS_KVT) + (size_t)bh * 64 * 8192 + ed;
    bf16_t* SPT = (bf16_t*)(ws + WS_SPT) + (size_t)bh * 64 * 8192 + ed;
    float s = 0.f;
    for (int n = 0; n < 64; ++n) { SPT[(size_t)n * 8192] = f2bf(s); s = s * dec + KVT[(size_t)n * 8192]; }
}

__device__ __forceinline__ void phase_p3(const Params& p, unsigned char* lds, int half, int what) {
    for (int i = (ltid() & 255); i < 8192 / 16; i += HT) ((u32x4*)(lds + NSA_BUCKET))[i] = ((const u32x4*)(launder(p.ws) + WS_BUCKET))[i];
    __syncthreads();
    for (int h = (blockIdx.x * 2 + half); h < 512; h += (gridDim.x * 2)) {
        if (what & 1) cmp_item(p, h, lds, half);
        if (what & 2) {
            if (h >= 128 && h < 384) win_item(p, h - 128, lds, half);
            else if (h >= 384) { win_item(p, 256 + 2 * (h - 384) - ((h & 1) ? 1 : 0) , lds, half); win_item(p, 256 + 2 * (h - 384) + ((h & 1) ? 0 : 1) + 1 - ((h & 1) ? 0 : 0), lds, half); }
        }
        if (what & 4) scan_item(p, h, half);
    }
}

__device__ __forceinline__ void retout_item(const Params& p, int item, unsigned char* lds, int half) {
    unsigned char* ws = launder(p.ws);
    const int tid = (ltid() & 255), lane = tid & 63, wid = tid >> 6, fr = lane & 15, fq = lane >> 4;
    const int n = item & 63, h = (item >> 6) & 7, b = item >> 9;
    const size_t tok0 = (size_t)b * S_ + 128 * n;
    const bf16_t* P = (const bf16_t*)(ws + WS_P);
    unsigned char* vL = lds; unsigned char* kL = lds + 32768; unsigned char* sL = lds + 49152;
    __syncthreads();
    load_tile128w((const bf16_t*)(ws + WS_VRT) + ((size_t)(b * 8 + h) * 128) * S_ + 128 * n, S_, vL, wid, lane);
    load_tile128(P + tok0 * LD + C_KR + h * 64, LD, kL, wid, lane);
    load_tile128((const bf16_t*)(ws + WS_SPT) + ((size_t)(b * 8 + h) * 64 + n) * 8192, 64, sL, wid, lane);
    bf16x8 Qf[2][2];
#pragma unroll
    for (int nt = 0; nt < 2; ++nt)
#pragma unroll
        for (int ks = 0; ks < 2; ++ks) Qf[nt][ks] = *(const bf16x8*)(P + (tok0 + 32 * wid + 16 * nt + fr) * LD + C_QR + h * 64 + 32 * ks + 8 * fq);
    wait_vm0(); __syncthreads();
    const float lg2 = ret_lg2(h);
    f32x4 Y[8][2];
#pragma unroll
    for (int m = 0; m < 8; ++m)
#pragma unroll
        for (int nt = 0; nt < 2; ++nt) Y[m][nt] = (f32x4){0.f, 0.f, 0.f, 0.f};
#pragma unroll
    for (int m = 0; m < 8; ++m)
#pragma unroll
        for (int ks = 0; ks < 2; ++ks) {
            const bf16x8 a = lds_frag128(sL, 16 * m + fr, 4 * ks + fq);
#pragma unroll
            for (int nt = 0; nt < 2; ++nt) Y[m][nt] = mfma16(a, Qf[nt][ks], Y[m][nt]);
        }
#pragma unroll
    for (int nt = 0; nt < 2; ++nt) {
        const float sc = exp2f((float)(32 * wid + 16 * nt + fr + 1) * lg2);
#pragma unroll
        for (int m = 0; m < 8; ++m) Y[m][nt] = Y[m][nt] * sc;
    }
#pragma unroll 1
    for (int s = 0; s < 4; ++s) {
        f32x4 St[2][2];
#pragma unroll
        for (int hh = 0; hh < 2; ++hh) {
            const int mt = 2 * s + hh;
#pragma unroll
            for (int nt = 0; nt < 2; ++nt) St[hh][nt] = (f32x4){0.f, 0.f, 0.f, 0.f};
#pragma unroll
            for (int ks = 0; ks < 2; ++ks) {
                const bf16x8 a = lds_frag128(kL, 16 * mt + fr, 4 * ks + fq);
#pragma unroll
                for (int nt = 0; nt < 2; ++nt) St[hh][nt] = mfma16(a, Qf[nt][ks], St[hh][nt]);
            }
#pragma unroll
            for (int nt = 0; nt < 2; ++nt) {
                const int qi = 32 * wid + 16 * nt + fr;
#pragma unroll
                for (int r = 0; r < 4; ++r) {
                    const int kj = 16 * mt + 4 * fq + r;
                    const float dm = qi >= kj ? exp2f((float)(qi - kj) * lg2) : 0.f;
                    St[hh][nt][r] *= dm;
                }
            }
        }
        bf16x8 Pb[2];
#pragma unroll
        for (int nt = 0; nt < 2; ++nt) Pb[nt] = pack8(St[0][nt], St[1][nt]);
#pragma unroll
        for (int m = 0; m < 8; ++m) {
            const bf16x8 a = lds_vfrag256(vL, 16 * m + fr, 32 * s, fq);
#pragma unroll
            for (int nt = 0; nt < 2; ++nt) Y[m][nt] = mfma16(a, Pb[nt], Y[m][nt]);
        }
    }
    bf16_t* YB = (bf16_t*)(ws + WS_YB);
#pragma unroll
    for (int nt = 0; nt < 2; ++nt) {
        float sum = 0.f;
#pragma unroll
        for (int m = 0; m < 8; ++m) sum += Y[m][nt][0] + Y[m][nt][1] + Y[m][nt][2] + Y[m][nt][3];
        sum = rows_sum(sum);
        const float mu = sum * (1.f / 128.f);
        float vs = 0.f;
#pragma unroll
        for (int m = 0; m < 8; ++m)
#pragma unroll
            for (int r = 0; r < 4; ++r) { const float dlt = Y[m][nt][r] - mu; vs += dlt * dlt; }
        vs = rows_sum(vs);
        const float rstd = rsqrtf(vs * (1.f / 128.f) + 1e-5f);
        const size_t tk = tok0 + 32 * wid + 16 * nt + fr;
#pragma unroll
        for (int m = 0; m < 8; ++m) {
            const f32x4 gt = unpack4(*(const u32x2*)(P + tk * LD + C_GR + h * 128 + 16 * m + 4 * fq));
            f32x4 v;
#pragma unroll
            for (int r = 0; r < 4; ++r) v[r] = (Y[m][nt][r] - mu) * rstd * gt[r];
            *(u32x2*)(YB + tk * 1024 + h * 128 + 16 * m + 4 * fq) = pack4(v);
        }
    }
}
__device__ __forceinline__ void phase_p4_sel(const Params& p, unsigned char* lds) {
    for (int i = ltid(); i < 8192 / 16; i += NTHREADS) ((u32x4*)(lds + SEL_BUCKET))[i] = ((const u32x4*)(launder(p.ws) + WS_BUCKET))[i];
    __syncthreads();
    for (int it = blockIdx.x; it < 512; it += gridDim.x * 2) {
        sel_item<0>(p, it, lds);
        if (511 - it != it) sel_item<0>(p, 511 - it, lds);
    }
    __syncthreads();
}
__device__ __forceinline__ void phase_p4(const Params& p, unsigned char* lds, int half) {
    for (int it = (blockIdx.x * 2 + half); it < 1024; it += (gridDim.x * 2)) retout_item(p, it, lds, half);
}

struct RowOrder {     typedef pg8::Unit U; static constexpr bool GATHER = false;
    unsigned a, b; int K, xcd, slot, per;
    __device__ __forceinline__ bool next(int i, pg8::Unit& u) const { const int t = xcd * 32 + slot + i * per; if (t >= (xcd + 1) * 32) return false; u.pm = t >> 2; u.pn = t & 3; return true; }
    __device__ __forceinline__ void ptrs(const pg8::Unit& u, unsigned& A, unsigned& B) const { A = a + (unsigned)u.pm * 512u * (unsigned)K; B = b + (unsigned)u.pn * 512u * (unsigned)K; }
};
template <int MODE>
struct MixEpi {
    unsigned char* ws; const float* X;
    __device__ __forceinline__ void operator()(const f32x4 (&acc)[2][2][4][2], const pg8::Unit& u, int wr, int wc, int fr, int fq) const {
#pragma unroll
        for (int ai = 0; ai < 2; ++ai)
#pragma unroll
            for (int m = 0; m < 4; ++m) {
                const size_t tok = (size_t)(u.pm * 256 + 128 * ai + 64 * wr + 16 * m + fr + vzero());
#pragma unroll
                for (int bj = 0; bj < 2; ++bj) {
                    const int n = u.pn * 256 + 128 * bj + 32 * wc + 8 * fq;
                    const f32x4 v0 = acc[ai][bj][m][0], v1 = acc[ai][bj][m][1];
                    if (MODE == 2) {
                        const u32x4 xw = *(const u32x4*)((const bf16_t*)(ws + WS_XB) + tok * 1024 + n);
                        const f32x4 h0 = unpack4((u32x2){xw.x, xw.y}) * DN_ALPHA + v0, h1 = unpack4((u32x2){xw.z, xw.w}) * DN_ALPHA + v1;
                        u32x4 w; w.x = pack2(h0[0], h0[1]); w.y = pack2(h0[2], h0[3]); w.z = pack2(h1[0], h1[1]); w.w = pack2(h1[2], h1[3]);
                        *(u32x4*)((bf16_t*)(ws + WS_H1) + tok * 1024 + n) = w;
                    } else {
                        const u32x4 gw = *(const u32x4*)((const bf16_t*)(ws + WS_P) + tok * LD + (MODE == 0 ? C_MA : C_MB) + n);
                        const f32x4 g0 = unpack4((u32x2){gw.x, gw.y}), g1 = unpack4((u32x2){gw.z, gw.w});
                        f32x4 o0 = g0 * v0, o1 = g1 * v1;
                        bf16_t* MG = (bf16_t*)(ws + WS_MG) + tok * 1024 + n;
                        if (MODE == 1) { const u32x4 pw = *(const u32x4*)MG; o0 = o0 + unpack4((u32x2){pw.x, pw.y}); o1 = o1 + unpack4((u32x2){pw.z, pw.w}); }
                        u32x4 w; w.x = pack2(o0[0], o0[1]); w.y = pack2(o0[2], o0[3]); w.z = pack2(o1[0], o1[1]); w.w = pack2(o1[2], o1[3]);
                        *(u32x4*)MG = w;
                    }
                }
            }
    }
};
__device__ __forceinline__ void phase_g2(const Params& p, unsigned char* lds) {
    unsigned char* ws = launder(p.ws);
    RowOrder S; S.xcd = blockIdx.x & 7; S.slot = blockIdx.x >> 3; S.per = gridDim.x >> 3;
    { S.a = (unsigned)WS_YA; S.b = (unsigned)WS_WA; S.K = 512; MixEpi<0> E; E.ws = ws; E.X = nullptr; pg8::gemm_phase<MixEpi<0>, RowOrder>(lds, 512, S, E, ltid(), ws); }
    { S.a = (unsigned)WS_YB; S.b = (unsigned)WS_WB; S.K = 1024; MixEpi<1> E; E.ws = ws; E.X = nullptr; pg8::gemm_phase<MixEpi<1>, RowOrder>(lds, 1024, S, E, ltid(), ws); }
}
__device__ __forceinline__ void phase_g3(const Params& p, int layer, unsigned char* lds) {
    unsigned char* ws = launder(p.ws);
    RowOrder S; S.xcd = blockIdx.x & 7; S.slot = blockIdx.x >> 3; S.per = gridDim.x >> 3; S.a = (unsigned)WS_MG; S.b = (unsigned)WS_WO; S.K = 1024;
    MixEpi<2> E; E.ws = ws; E.X = nullptr;
    pg8::gemm_phase<MixEpi<2>, RowOrder>(lds, 1024, S, E, ltid(), ws);
}

__device__ __forceinline__ void phase_ln1(const Params& p, int layer, unsigned char* lds, bool dry, int half) {
    unsigned char* ws = launder(p.ws);
    const int tid = (ltid() & 255), lane = tid & 63, wid = tid >> 6;
    float* wrL = (float*)lds;
    float* lgL = (float*)(lds - half * HALF_LDS + 65536);
    {
        float4 wv[16];
#pragma unroll
        for (int k = 0; k < 16; ++k) wv[k] = ((const float4*)p.w_router)[tid + 256 * k];
#pragma unroll
        for (int k = 0; k < 16; ++k) { const int i4 = tid + 256 * k, d = i4 >> 2, e0 = (i4 & 3) * 4;
            wrL[(e0 + 0) * 1024 + d] = wv[k].x; wrL[(e0 + 1) * 1024 + d] = wv[k].y; wrL[(e0 + 2) * 1024 + d] = wv[k].z; wrL[(e0 + 3) * 1024 + d] = wv[k].w; }
    }
    __syncthreads();
    const bf16_t* H1 = (const bf16_t*)(ws + WS_H1);
    bf16_t* X1B = (bf16_t*)(ws + WS_X1B);
    const float* gam = p.ln1_g + layer * 1024; const float* bet = p.ln1_b + layer * 1024;
    unsigned* cnt = (unsigned*)(ws + WS_CTL) + (dry ? 0 : CW_CNT) + layer * 1024;
    int* LIST = (int*)(ws + (dry ? WS_HB : WS_LIST)); float* WTS = (float*)(ws + (dry ? WS_HB + 4194304 : WS_WTS));
    constexpr int U = 4;
    const int nwave = (gridDim.x * 2) * 4, wv = (blockIdx.x * 2 + half) * 4 + wid;
    const int nloc = ((T_ - wv * U + nwave * U - 1) / (nwave * U)) * (4 * U);
    u32x2 vn[U][4];
#pragma unroll
    for (int u = 0; u < U; ++u)
#pragma unroll
        for (int j = 0; j < 4; ++j) vn[u][j] = *(const u32x2*)(H1 + (size_t)(wv * U + u) * 1024 + 256 * j + 4 * lane);
    for (int t0 = wv * U; t0 < T_; t0 += nwave * U) {
        float4 y[U][4]; float s[U], q[U];
#pragma unroll
        for (int u = 0; u < U; ++u) {
            s[u] = 0.f;
#pragma unroll
            for (int j = 0; j < 4; ++j) { const f32x4 t = unpack4(vn[u][j]); y[u][j].x = t[0]; y[u][j].y = t[1]; y[u][j].z = t[2]; y[u][j].w = t[3]; s[u] += (t[0] + t[1]) + (t[2] + t[3]); }
        }
        { const int tn = t0 + nwave * U < T_ ? t0 + nwave * U : t0;
#pragma unroll
          for (int u = 0; u < U; ++u)
#pragma unroll
              for (int j = 0; j < 4; ++j) vn[u][j] = *(const u32x2*)(H1 + (size_t)(tn + u) * 1024 + 256 * j + 4 * lane); }
#pragma unroll
        for (int u = 0; u < U; ++u) s[u] = wave_sum(s[u]) * (1.f / 1024.f);
#pragma unroll
        for (int u = 0; u < U; ++u) {
            q[u] = 0.f;
#pragma unroll
            for (int j = 0; j < 4; ++j) { const float a = y[u][j].x - s[u], b2 = y[u][j].y - s[u], c = y[u][j].z - s[u], d = y[u][j].w - s[u]; q[u] += a * a + b2 * b2 + c * c + d * d; }
        }
#pragma unroll
        for (int u = 0; u < U; ++u) q[u] = rsqrtf(wave_sum(q[u]) * (1.f / 1024.f) + 1e-5f);
#pragma unroll
        for (int j = 0; j < 4; ++j) {
            const int d0 = 256 * j + 4 * lane;
            const float4 gg = *(const float4*)(gam + d0), bb = *(const float4*)(bet + d0);
#pragma unroll
            for (int u = 0; u < U; ++u) {
                y[u][j].x = (y[u][j].x - s[u]) * q[u] * gg.x + bb.x; y[u][j].y = (y[u][j].y - s[u]) * q[u] * gg.y + bb.y;
                y[u][j].z = (y[u][j].z - s[u]) * q[u] * gg.z + bb.z; y[u][j].w = (y[u][j].w - s[u]) * q[u] * gg.w + bb.w;
                u32x2 w; w.x = pack2(y[u][j].x, y[u][j].y); w.y = pack2(y[u][j].z, y[u][j].w);
                *(u32x2*)(X1B + (size_t)(t0 + u) * 1024 + d0) = w;
            }
        }
        float lg[U][16];
#pragma unroll
        for (int e = 0; e < 16; ++e) {
#pragma unroll
            for (int u = 0; u < U; ++u) lg[u][e] = 0.f;
#pragma unroll
            for (int j = 0; j < 4; ++j) { const float4 w4 = *(const float4*)(wrL + e * 1024 + 256 * j + 4 * lane);
#pragma unroll
                for (int u = 0; u < U; ++u) lg[u][e] += y[u][j].x * w4.x + y[u][j].y * w4.y + y[u][j].z * w4.z + y[u][j].w * w4.w; }
        }
        float myl = 0.f;
#pragma unroll
        for (int u = 0; u < U; ++u) {
            float w8[8], z4[4];
#pragma unroll
            for (int e = 0; e < 8; ++e) { const u32x2 r = __builtin_amdgcn_permlane32_swap(__float_as_uint(lg[u][e]), __float_as_uint(lg[u][e + 8]), false, false); w8[e] = __uint_as_float(r.x) + __uint_as_float(r.y); }
#pragma unroll
            for (int e = 0; e < 4; ++e) { const u32x2 r = __builtin_amdgcn_permlane16_swap(__float_as_uint(w8[e]), __float_as_uint(w8[e + 4]), false, false); z4[e] = __uint_as_float(r.x) + __uint_as_float(r.y); }
            const bool h8 = (lane & 8) != 0, h4 = (lane & 4) != 0;
            const float k0 = h8 ? z4[2] : z4[0], s0 = h8 ? z4[0] : z4[2], k1 = h8 ? z4[3] : z4[1], s1 = h8 ? z4[1] : z4[3];
            const float y0 = k0 + __int_as_float(__builtin_amdgcn_mov_dpp(__float_as_int(s0), 0x128, 0xF, 0xF, true));
            const float y1 = k1 + __int_as_float(__builtin_amdgcn_mov_dpp(__float_as_int(s1), 0x128, 0xF, 0xF, true));
            const float k2 = h4 ? y1 : y0, s2 = h4 ? y0 : y1;
            float x = k2 + __int_as_float(__builtin_amdgcn_mov_dpp(__float_as_int(s2), 0x141, 0xF, 0xF, true));
            x += __int_as_float(__builtin_amdgcn_mov_dpp(__float_as_int(x), 0xB1, 0xF, 0xF, true));
            x += __int_as_float(__builtin_amdgcn_mov_dpp(__float_as_int(x), 0x4E, 0xF, 0xF, true));
            if ((lane & 3) == u) myl = x;
        }
        static_assert(U == 4, "lane (l & 3) stores token u = l & 3");
        lgL[(half * nloc + ((t0 - wv * U) / (nwave * U)) * (4 * U) + wid * U + (lane & 3)) * 17 + (lane >> 2)] = myl;
    }
    __syncthreads();
    if (half == 0 && wid == 0)
    for (int l0 = 0; l0 < 2 * nloc; l0 += 64) {
        const int li = l0 + lane; const bool act = li < 2 * nloc;
        const int hq = li >= nloc ? 1 : 0, lh = li - hq * nloc;
        const int it = lh / (4 * U), wq = (lh / U) & 3, uq = lh % U, tok = act ? (((blockIdx.x * 2 + hq) * 4 + wq) * U + uq) + it * (nwave * U) : 0;
        float lgv[16];
#pragma unroll
        for (int e = 0; e < 16; ++e) lgv[e] = lgL[li * 17 + e];
        float mx = lgv[0];
#pragma unroll
        for (int e = 1; e < 16; ++e) mx = fmaxf(mx, lgv[e]);
        float pr[16], ps = 0.f;
#pragma unroll
        for (int e = 0; e < 16; ++e) { pr[e] = expf(lgv[e] - mx); ps += pr[e]; }
        const float ips = 1.f / ps;
        float sel[16];
#pragma unroll
        for (int e = 0; e < 16; ++e) { pr[e] *= ips; sel[e] = pr[e] + p.router_bias[e]; }
        int best = 0; float bestv = -1e30f;
#pragma unroll
        for (int gI = 0; gI < 4; ++gI) {
            float a = -1e30f, b2 = -1e30f;
#pragma unroll
            for (int k = 0; k < 4; ++k) { const float x = sel[4 * gI + k]; if (x > a) { b2 = a; a = x; } else if (x > b2) b2 = x; }
            const float gs = a + b2;
            if (gs > bestv) { bestv = gs; best = gI; }
        }
        float s4[4], p4[4];
#pragma unroll
        for (int k = 0; k < 4; ++k) { s4[k] = 0.f; p4[k] = 0.f; }
#pragma unroll
        for (int gI = 0; gI < 4; ++gI) if (gI == best) {
#pragma unroll
            for (int k = 0; k < 4; ++k) { s4[k] = sel[4 * gI + k]; p4[k] = pr[4 * gI + k]; }
        }
        int i0 = 0; float a0 = s4[0];
#pragma unroll
        for (int k = 1; k < 4; ++k) if (s4[k] > a0) { a0 = s4[k]; i0 = k; }
        int i1 = -1; float a1 = -1e30f;
#pragma unroll
        for (int k = 0; k < 4; ++k) if (k != i0 && s4[k] > a1) { a1 = s4[k]; i1 = k; }
        float w0 = 0.f, w1 = 0.f;
#pragma unroll
        for (int k = 0; k < 4; ++k) { if (k == i0) w0 = p4[k]; if (k == i1) w1 = p4[k]; }
        const float iw = 1.f / (w0 + w1);
        const int e0 = act ? best * 4 + i0 : -1, e1 = act ? best * 4 + i1 : -1;
        unsigned myc = 0, r0 = 0, r1 = 0;
#pragma unroll
        for (int e = 0; e < 16; ++e) {
            const unsigned long long m0 = __builtin_amdgcn_ballot_w64(e0 == e), m1 = __builtin_amdgcn_ballot_w64(e1 == e);
            const unsigned c0 = (unsigned)__builtin_popcountll(m0), c = c0 + (unsigned)__builtin_popcountll(m1);
            if (lane == e) myc = c;
            if (e0 == e) r0 = __builtin_amdgcn_mbcnt_hi((unsigned)(m0 >> 32), __builtin_amdgcn_mbcnt_lo((unsigned)m0, 0u));
            if (e1 == e) r1 = c0 + __builtin_amdgcn_mbcnt_hi((unsigned)(m1 >> 32), __builtin_amdgcn_mbcnt_lo((unsigned)m1, 0u));
        }
        unsigned mybase = 0;
        if (lane < 16 && myc != 0) mybase = atomicAdd(&cnt[lane * 64], myc);
        unsigned b0 = 0, b1 = 0;
#pragma unroll
        for (int e = 0; e < 16; ++e) { const unsigned be = (unsigned)__builtin_amdgcn_readlane((int)mybase, e); if (e0 == e) b0 = be; if (e1 == e) b1 = be; }
        if (act) {
            LIST[(size_t)e0 * T_ + b0 + r0] = tok * 2; LIST[(size_t)e1 * T_ + b1 + r1] = tok * 2 + 1;
            WTS[tok * 2] = w0 * iw; WTS[tok * 2 + 1] = w1 * iw;
        }
    }
}

struct MoeUnit { int e, rt, ct, cnt, off; };
struct MoeOrderBase {
    const unsigned* cntp; int t_lo, t_hi, slot, per;
    __device__ __forceinline__ void init(const unsigned* cnt) {
        cntp = cnt; int ntile = 0;
#pragma unroll
        for (int k = 0; k < NE; ++k) ntile += (__builtin_amdgcn_readfirstlane((int)cnt[k * 64]) >> 8) * 4;
        t_lo = (ntile * (int)(blockIdx.x & 7)) >> 3; t_hi = (ntile * (int)((blockIdx.x & 7) + 1)) >> 3; slot = blockIdx.x >> 3; per = gridDim.x >> 3;
    }
    __device__ __forceinline__ bool next(int i, MoeUnit& u) const {
        const int t = t_lo + slot + i * per; if (t >= t_hi) return false;
        int base = 0, off = 0; bool found = false;
#pragma unroll
        for (int k = 0; k < NE; ++k) {
            const int ck = __builtin_amdgcn_readfirstlane((int)cntp[k * 64]), nt = (ck >> 8) * 4;
            if (!found && t < base + nt) { found = true; u.e = k; u.cnt = ck; u.off = off; u.rt = (t - base) >> 2; u.ct = (t - base) & 3; }
            base += nt; off += ck;
        }
        return found;
    }
};
struct M2Order : MoeOrderBase {
    typedef MoeUnit U; static constexpr bool GATHER = true;
    const int* list;
    __device__ __forceinline__ void ptrs(const MoeUnit& u, unsigned& A, unsigned& B) const { A = (unsigned)WS_X1B; B = (unsigned)WS_WG + ((unsigned)u.e * 1024u + (unsigned)u.ct * 256u) * 2048u; }
    __device__ __forceinline__ void rows(const MoeUnit& u, int tid, unsigned (&v)[2][2]) const {
#pragma unroll
        for (int i = 0; i < 2; ++i) { int R, C; pg8::stage_rc((tid + vzero()) * 16 + i * 8192, R, C);
#pragma unroll
            for (int h = 0; h < 2; ++h) { int idx = u.rt * 256 + 128 * h + R; idx = idx < u.cnt ? idx : u.cnt - 1; const int a = (list + (size_t)u.e * T_)[idx]; v[h][i] = ((unsigned)(a >> 1) << 11) + (unsigned)C * 2u; } }
    }
};
struct M3Order : MoeOrderBase {
    typedef MoeUnit U; static constexpr bool GATHER = false;
    __device__ __forceinline__ void ptrs(const MoeUnit& u, unsigned& A, unsigned& B) const { A = (unsigned)WS_HB + ((unsigned)u.off + (unsigned)u.rt * 256u) * 1024u; B = (unsigned)WS_WD + ((unsigned)u.e * 1024u + (unsigned)u.ct * 256u) * 1024u; }
};
struct M2Epi {
    unsigned char* ws;
    __device__ __forceinline__ void operator()(const f32x4 (&acc)[2][2][4][2], const MoeUnit& u, int wr, int wc, int fr, int fq) const {
        bf16_t* HB = (bf16_t*)(ws + WS_HB);
#pragma unroll
        for (int ai = 0; ai < 2; ++ai)
#pragma unroll
            for (int m = 0; m < 4; ++m) {
                const int idx = u.rt * 256 + 128 * ai + 64 * wr + 16 * m + fr + vzero();
                if (idx < u.cnt) {
#pragma unroll
                    for (int bj = 0; bj < 2; ++bj) {
                        const int hcol = 4 * (32 * u.ct + 16 * bj + 4 * wc + fq);
                        const f32x4 gv = acc[ai][bj][m][0], uv = acc[ai][bj][m][1]; f32x4 hv;
#pragma unroll
                        for (int r = 0; r < 4; ++r) hv[r] = gv[r] * fsig(gv[r]) * uv[r];
                        *(u32x2*)(HB + (size_t)(u.off + idx) * 512 + hcol) = pack4(hv);
                    }
                }
            }
    }
};
struct M3Epi {
    unsigned char* ws; const int* list;
    __device__ __forceinline__ void operator()(const f32x4 (&acc)[2][2][4][2], const MoeUnit& u, int wr, int wc, int fr, int fq) const {
        bf16_t* CT = (bf16_t*)(ws + WS_CT);
#pragma unroll
        for (int ai = 0; ai < 2; ++ai)
#pragma unroll
            for (int m = 0; m < 4; ++m) {
                const int idx = u.rt * 256 + 128 * ai + 64 * wr + 16 * m + fr + vzero();
                if (idx < u.cnt) {
                    const int a = list[(size_t)u.e * T_ + idx];
#pragma unroll
                    for (int bj = 0; bj < 2; ++bj) {
                        const int n = u.ct * 256 + 128 * bj + 32 * wc + 8 * fq;
                        const f32x4 v0 = acc[ai][bj][m][0], v1 = acc[ai][bj][m][1];
                        u32x4 w; w.x = pack2(v0[0], v0[1]); w.y = pack2(v0[2], v0[3]); w.z = pack2(v1[0], v1[1]); w.w = pack2(v1[2], v1[3]);
                        *(u32x4*)(CT + (size_t)a * 1024 + n) = w;
                    }
                }
            }
    }
};
template <int MODE>
__device__ __forceinline__ void moe_rem_item(unsigned char* ws, const int* list, int e, int cnt, int off, int rh, int c64, unsigned char* lds) {
    constexpr int K = MODE == 0 ? 1024 : 512, NS = K / 64;
    const int tid = (ltid() & 255), lane = tid & 63, wid = tid >> 6, wr = wid >> 1, wc = wid & 1, fr = lane & 15, fq = lane >> 4;
    const int idx0 = (cnt & ~255) + 128 * rh;
    const int ldc = ((lane & 7) ^ (lane >> 3)) * 8;
    const bf16_t* ap[4];
#pragma unroll
    for (int i = 0; i < 4; ++i) {
        int idx = idx0 + 32 * i + 8 * wid + (lane >> 3); idx = idx < cnt ? idx : cnt - 1;
        if (MODE == 0) { const int a = list[(size_t)e * T_ + idx]; ap[i] = (const bf16_t*)(ws + WS_X1B) + (size_t)(a >> 1) * 1024 + ldc; }
        else ap[i] = (const bf16_t*)(ws + WS_HB) + (size_t)(off + idx) * 512 + ldc;
    }
    const bf16_t* bp[2];
#pragma unroll
    for (int i = 0; i < 2; ++i) {
        const int rho = 8 * (wid + 4 * i) + (lane >> 3), src = (rho & ~31) + pg8::perm32(rho & 31);
        bp[i] = (const bf16_t*)(ws + (MODE == 0 ? WS_WG : WS_WD)) + ((size_t)e * 1024 + 64 * c64 + src) * K + ldc;
    }
    f32x4 acc[4][2];
#pragma unroll
    for (int i = 0; i < 4; ++i)
#pragma unroll
        for (int j = 0; j < 2; ++j) acc[i][j] = (f32x4){0.f, 0.f, 0.f, 0.f};
    __syncthreads();
#define RSTAGE(buf, l) do { unsigned char* st_ = lds + (buf) * 24576; \
        _Pragma("unroll") for (int i = 0; i < 4; ++i) glds16(ap[i] + (l) * 64, st_ + (4 * i + wid) * 1024); \
        _Pragma("unroll") for (int i = 0; i < 2; ++i) glds16(bp[i] + (l) * 64, st_ + 16384 + (wid + 4 * i) * 1024); } while (0)
    RSTAGE(0, 0); RSTAGE(1, 1);
    for (int l = 0; l < NS; ++l) {
        const unsigned char* st = lds + (l % 3) * 24576;
        if (l + 1 < NS) WAIT_V(6); else WAIT_V(0);
        RAW_BARRIER();
        if (l + 2 < NS) RSTAGE((l + 2) % 3, l + 2);
#pragma unroll
        for (int ks = 0; ks < 2; ++ks) {
            bf16x8 a[4], bb[2];
#pragma unroll
            for (int i = 0; i < 4; ++i) a[i] = lds_frag128(st, 64 * wr + 16 * i + fr, 4 * ks + fq);
#pragma unroll
            for (int j = 0; j < 2; ++j) bb[j] = lds_frag128(st + 16384, 32 * wc + 16 * j + fr, 4 * ks + fq);
#pragma unroll
            for (int i = 0; i < 4; ++i)
#pragma unroll
                for (int j = 0; j < 2; ++j) acc[i][j] = mfma16(bb[j], a[i], acc[i][j]);
        }
    }
#undef RSTAGE
#pragma unroll
    for (int i = 0; i < 4; ++i) {
        const int idx = idx0 + 64 * wr + 16 * i + fr + vzero();
        if (idx < cnt) {
            if (MODE == 0) {
                f32x4 hv;
#pragma unroll
                for (int r = 0; r < 4; ++r) hv[r] = acc[i][0][r] * fsig(acc[i][0][r]) * acc[i][1][r];
                *(u32x2*)((bf16_t*)(ws + WS_HB) + (size_t)(off + idx) * 512 + 32 * c64 + 16 * wc + 4 * fq) = pack4(hv);
            } else {
                const int a = list[(size_t)e * T_ + idx];
                const f32x4 v0 = acc[i][0], v1 = acc[i][1];
                u32x4 w; w.x = pack2(v0[0], v0[1]); w.y = pack2(v0[2], v0[3]); w.z = pack2(v1[0], v1[1]); w.w = pack2(v1[2], v1[3]);
                *(u32x4*)((bf16_t*)(ws + WS_CT) + (size_t)a * 1024 + 64 * c64 + 32 * wc + 8 * fq) = w;
            }
        }
    }
    __syncthreads();
}
template <int MODE>
__device__ __forceinline__ void moe_rem(const unsigned* cntp, unsigned char* ws, const int* list, unsigned char* ldsh, int half) {
    for (int t = blockIdx.x * 2 + half; ; t += gridDim.x * 2) {
        int base = 0, off = 0, e = -1, cnt = 0, eoff = 0, loc = 0;
#pragma unroll
        for (int k = 0; k < NE; ++k) {
            const int ck = __builtin_amdgcn_readfirstlane((int)cntp[k * 64]), ni = (((ck & 255) + 127) >> 7) * 16;
            if (e < 0 && t < base + ni) { e = k; cnt = ck; eoff = off; loc = t - base; }
            base += ni; off += ck;
        }
        if (e < 0) break;
        moe_rem_item<MODE>(ws, list, e, cnt, eoff, loc >> 4, loc & 15, ldsh);
    }
}
__device__ __forceinline__ void phase_m2(const Params& p, int layer, unsigned char* lds, unsigned char* ldsh, int half) {
    unsigned char* ws = launder(p.ws);
    M2Order S; S.init((const unsigned*)(ws + WS_CTL) + CW_CNT + layer * 1024 + vzero());
    S.list = (const int*)(ws + WS_LIST);
    M2Epi E; E.ws = ws;
    pg8::gemm_phase<M2Epi, M2Order>(lds, 1024, S, E, ltid(), ws);
    moe_rem<0>(S.cntp, ws, S.list, ldsh, half);
}
__device__ __forceinline__ void phase_m3(const Params& p, int layer, unsigned char* lds, unsigned char* ldsh, int half) {
    unsigned char* ws = launder(p.ws);
    M3Order S; S.init((const unsigned*)(ws + WS_CTL) + CW_CNT + layer * 1024 + vzero());
    M3Epi E; E.ws = ws; E.list = (const int*)(ws + WS_LIST);
    pg8::gemm_phase<M3Epi, M3Order>(lds, 512, S, E, ltid(), ws);
    moe_rem<1>(S.cntp, ws, E.list, ldsh, half);
}

__device__ __forceinline__ void phase_ln2(const Params& p, int layer, int half) {
    unsigned char* ws = launder(p.ws);
    const int tid = (ltid() & 255), lane = tid & 63, wid = tid >> 6;
    const bf16_t* X1 = (const bf16_t*)(ws + WS_X1B); const bf16_t* CT = (const bf16_t*)(ws + WS_CT); const float* WTS = (const float*)(ws + WS_WTS);
    float* XO = p.out; bf16_t* XB = (bf16_t*)(ws + WS_XB); const bool fin = layer == NLAYER - 1;
    const float* gam = p.ln2_g + layer * 1024; const float* bet = p.ln2_b + layer * 1024;
    constexpr int U = 4;
    const int nwave = (gridDim.x * 2) * 4, wv = (blockIdx.x * 2 + half) * 4 + wid;
    for (int t0 = wv * U; t0 < T_; t0 += nwave * U) {
        float4 v[U][4]; float s[U], q[U];
#pragma unroll
        for (int u = 0; u < U; ++u) {
            const int tok = t0 + u;
            const float w0 = WTS[tok * 2 + vzero()], w1 = WTS[tok * 2 + 1 + vzero()];
            s[u] = 0.f; q[u] = 0.f;
#pragma unroll
            for (int j = 0; j < 4; ++j) {
                const int d0 = 256 * j + 4 * lane;
                const f32x4 xt = unpack4(*(const u32x2*)(X1 + (size_t)tok * 1024 + d0)); float4 xv; xv.x = xt[0]; xv.y = xt[1]; xv.z = xt[2]; xv.w = xt[3];
                const f32x4 c0 = unpack4(*(const u32x2*)(CT + (size_t)(tok * 2) * 1024 + d0)), c1 = unpack4(*(const u32x2*)(CT + (size_t)(tok * 2 + 1) * 1024 + d0));
                v[u][j].x = xv.x * DN_ALPHA + w0 * c0[0] + w1 * c1[0]; v[u][j].y = xv.y * DN_ALPHA + w0 * c0[1] + w1 * c1[1];
                v[u][j].z = xv.z * DN_ALPHA + w0 * c0[2] + w1 * c1[2]; v[u][j].w = xv.w * DN_ALPHA + w0 * c0[3] + w1 * c1[3];
                s[u] += v[u][j].x + v[u][j].y + v[u][j].z + v[u][j].w;
                q[u] += v[u][j].x * v[u][j].x + v[u][j].y * v[u][j].y + v[u][j].z * v[u][j].z + v[u][j].w * v[u][j].w;
            }
        }
#pragma unroll
        for (int u = 0; u < U; ++u) { s[u] = wave_sum(s[u]); q[u] = wave_sum(q[u]); }
#pragma unroll
        for (int j = 0; j < 4; ++j) {
            const int d0 = 256 * j + 4 * lane;
            const float4 gg = *(const float4*)(gam + d0), bb = *(const float4*)(bet + d0);
#pragma unroll
            for (int u = 0; u < U; ++u) {
                const int tok = t0 + u;
                const float mu = s[u] * (1.f / 1024.f), var = fmaxf(q[u] * (1.f / 1024.f) - mu * mu, 0.f), rstd = rsqrtf(var + 1e-5f);
                float4 y; y.x = (v[u][j].x - mu) * rstd * gg.x + bb.x; y.y = (v[u][j].y - mu) * rstd * gg.y + bb.y; y.z = (v[u][j].z - mu) * rstd * gg.z + bb.z; y.w = (v[u][j].w - mu) * rstd * gg.w + bb.w;
                if (fin) *(float4*)(XO + (size_t)tok * 1024 + d0) = y;
                else { u32x2 w; w.x = pack2(y.x, y.y); w.y = pack2(y.z, y.w); *(u32x2*)(XB + (size_t)tok * 1024 + d0) = w; }
            }
        }
    }
}

#define XB_TMO      128
#define XB_XCNT(j)  (256  + 64 * (j))
#define XB_XSUB(j)  (1280 + 64 * (j))
#define XB_XGEN(j)  (2304 + 64 * (j))
#define XB_TOP      3328
#define XB_TOPGEN   3392
#define XCD_BAR_WORDS 3456
#define XB_SPIN_CAP (1u << 22)
#define LAS __attribute__((address_space(3)))
__device__ __forceinline__ unsigned xb_ld(unsigned* p)              { return __hip_atomic_load(p, __ATOMIC_RELAXED, __HIP_MEMORY_SCOPE_AGENT); }
__device__ __forceinline__ unsigned xb_add(unsigned* p, unsigned v) { return __hip_atomic_fetch_add(p, v, __ATOMIC_RELAXED, __HIP_MEMORY_SCOPE_AGENT); }
__device__ __forceinline__ unsigned xb_xcc_id() { return (unsigned)__builtin_amdgcn_s_getreg((3 << 11) | 20) & 0xFu; }
#define XB_SPIN(cond, bar) do { unsigned _sp = 0; while (cond) { __builtin_amdgcn_s_sleep(1); \
    if ((++_sp & 255u) == 0u) { if (xb_ld(&(bar)[XB_TMO])) break; if (_sp > XB_SPIN_CAP) { atomicAdd(&(bar)[XB_TMO], 1u); break; } } } } while (0)
struct XcdBarrier { unsigned* bar; unsigned x; volatile LAS unsigned* st; };
__device__ __forceinline__ XcdBarrier xcd_barrier_post(unsigned* bar, volatile LAS unsigned* st) {
    XcdBarrier b; b.bar = bar; b.x = xb_xcc_id(); b.st = st;
    if (threadIdx.x == 0) (void)xb_add(&bar[XB_XCNT(b.x)], 1u);
    return b;
}
__device__ __forceinline__ void xcd_barrier_complete(unsigned* bar, unsigned x, unsigned& nloc, unsigned& nx) {
    const unsigned G = gridDim.x * gridDim.y * gridDim.z;
    unsigned sum, cnt, mine, sp = 0u;
    for (;;) {
        sum = 0u; cnt = 0u; mine = 0u;
#pragma unroll
        for (unsigned j = 0; j < 16; ++j) { const unsigned c = xb_ld(&bar[XB_XCNT(j)]); sum += c; cnt += (c > 0u) ? 1u : 0u; mine = (j == x) ? c : mine; }
        if (sum == G) break;
        __builtin_amdgcn_s_sleep(1);
        if ((++sp & 255u) == 0u) { if (xb_ld(&bar[XB_TMO])) break; if (sp > XB_SPIN_CAP) { atomicAdd(&bar[XB_TMO], 1u); break; } }
    }
    nloc = mine > 0u ? mine : 1u; nx = cnt > 0u ? cnt : 1u;
}
__device__ __forceinline__ void xcd_barrier(const XcdBarrier& b) {
    asm volatile("s_waitcnt vmcnt(0)" ::: "memory");
    __syncthreads();
    if (threadIdx.x == 0) {
        unsigned* bar = b.bar;
        __builtin_amdgcn_s_waitcnt(0);
        unsigned nloc = b.st[0], nx = b.st[1];
        if (nloc == 0u) { xcd_barrier_complete(bar, b.x, nloc, nx); b.st[0] = nloc; b.st[1] = nx; }
        const unsigned old = xb_add(&bar[XB_XSUB(b.x)], 1u);
        const unsigned gen = old / nloc;
        if (old + 1u == (gen + 1u) * nloc) {
            __builtin_amdgcn_fence(__ATOMIC_RELEASE, "agent");
            asm volatile("s_waitcnt vmcnt(0)" ::: "memory");
            const unsigned og = xb_add(&bar[XB_TOP], 1u);
            const unsigned tg = og / nx;
            if (og + 1u == (tg + 1u) * nx) xb_add(&bar[XB_TOPGEN], 1u);
            else XB_SPIN(xb_ld(&bar[XB_TOPGEN]) == tg, bar);
            __builtin_amdgcn_fence(__ATOMIC_ACQUIRE, "agent");
            xb_add(&bar[XB_XGEN(b.x)], 1u);
            asm volatile("s_waitcnt vmcnt(0)" ::: "memory");
        } else {
            XB_SPIN(xb_ld(&bar[XB_XGEN(b.x)]) == gen, bar);
            __builtin_amdgcn_fence(__ATOMIC_ACQUIRE, "agent");
            asm volatile("s_waitcnt vmcnt(0)" ::: "memory");
        }
    }
    __syncthreads();
}

constexpr int PH_PER_LAYER = 11, N_PHASES = PH_PER_LAYER * NLAYER;
__global__ void __launch_bounds__(NTHREADS, 2) mega(Params p) {
    extern __shared__ __attribute__((aligned(16))) unsigned char lds[];
#if SINGLE_LAUNCH
    volatile LAS unsigned* xbw = (volatile LAS unsigned*)(lds + LDS_BYTES - 16);
    if (threadIdx.x < 4) xbw[threadIdx.x] = 0u;
    __syncthreads();
    XcdBarrier xbar = xcd_barrier_post((unsigned*)(p.ws + WS_CTL) + CW_BAR, xbw);
#endif
    const int half = __builtin_amdgcn_readfirstlane((int)(threadIdx.x >> 8));
    unsigned char* ldsh = lds + half * HALF_LDS;
    bool second = false;
    for (int ph = p.ph_lo; ph < p.ph_hi; ++ph) {
        const int layer = ph / PH_PER_LAYER, k = ph % PH_PER_LAYER;
        if (k == 0 && layer > 0) continue;
#ifdef ONLY_PHASE
        if (k != ONLY_PHASE) continue;
#endif
        switch (k) {
            case 0: phase_pw(p, layer, ldsh, 1 | 16 | 8, half); break;
            case 1: phase_g1(p, layer, lds); break;
            case 2: phase_p2(p, layer, ldsh, half); if (!second && layer + 1 < NLAYER) { __syncthreads(); phase_pw(p, layer + 1, ldsh, 1, half, 32); } break;
            case 3: phase_p3(p, ldsh, half, second ? ((p.rep_mask >> 16) & 7) : 7); if (!second && layer + 1 < NLAYER) { __syncthreads(); phase_pw(p, layer + 1, ldsh, 16, half); }
                    if (!second && layer == 0) { __syncthreads(); phase_pw(p, 0, ldsh, 2, half); } break;
            case 4: { const int sub = second ? ((p.rep_mask >> 12) & 7) : 7;
                    if (sub & 1) phase_p4_sel(p, lds);
                    if ((sub & 4) && half == 0) { phase_pw(p, layer, ldsh, 4, half); __syncthreads(); }
                    if (sub & 2) phase_p4(p, ldsh, half);
                    if ((sub & 4) && half == 1) { __syncthreads(); phase_pw(p, layer, ldsh, 4, half); } } break;
            case 5: phase_g2(p, lds); break;
            case 6: phase_g3(p, layer, lds); break;
            case 7: phase_ln1(p, layer, ldsh, ((p.rep_mask >> 7) & 1) && !second, half); if (!second && layer + 1 < NLAYER) { __syncthreads(); phase_pw(p, layer + 1, ldsh, 2, half); } break;
            case 8: phase_m2(p, layer, lds, ldsh, half); break;
            case 9: phase_m3(p, layer, lds, ldsh, half); break;
            case 10: phase_ln2(p, layer, half); break;
        }

        if (ph + 1 < p.ph_hi) { if (ph == p.ph_lo && !second) cg::this_grid().sync(); else xcd_barrier(xbar); }
        if (((p.rep_mask >> k) & 1) && !second) { second = true; --ph; } else second = false;
    }
}

extern "C" void kernel_launch(void* const* d_in, const int* in_sizes, int n_in, void* d_out, int out_size, void* d_ws, size_t ws_size, hipStream_t stream) {
    static int grid = 0;
    if (grid == 0) {
        if (n_in != 18 || ws_size < WS_END) { fprintf(stderr, "kernel_launch: unexpected n_in %d or ws_size %zu < %zu\n", n_in, ws_size, (size_t)WS_END); grid = -1; return; }
        int dev = 0, cus = 0, per_cu = 0;
        hipGetDevice(&dev); hipDeviceGetAttribute(&cus, hipDeviceAttributeMultiprocessorCount, dev);
        hipFuncSetAttribute((const void*)mega, hipFuncAttributeMaxDynamicSharedMemorySize, LDS_BYTES);
        hipOccupancyMaxActiveBlocksPerMultiprocessor(&per_cu, (const void*)mega, NTHREADS, LDS_BYTES);
        if (per_cu < 1) per_cu = 1;
        if (per_cu > 1) per_cu = 1;
        grid = cus * per_cu;
        (void)hipGetLastError();
    }
    if (grid < 0) return;
    Params p{};
    p.x = (const float*)d_in[0]; p.w_in = (const float*)d_in[1]; p.cmp_pos = (const float*)d_in[2]; p.cmp_w1 = (const float*)d_in[3]; p.cmp_w2 = (const float*)d_in[4];
    p.w_br_a = (const float*)d_in[5]; p.w_br_b = (const float*)d_in[6]; p.w_o = (const float*)d_in[7]; p.ln1_g = (const float*)d_in[8]; p.ln1_b = (const float*)d_in[9];
    p.w_router = (const float*)d_in[10]; p.router_bias = (const float*)d_in[11]; p.w_gate = (const float*)d_in[12]; p.w_up = (const float*)d_in[13]; p.w_down = (const float*)d_in[14];
    p.ln2_g = (const float*)d_in[15]; p.ln2_b = (const float*)d_in[16]; p.rel_bias = (const float*)d_in[17];
    p.out = (float*)d_out; p.ws = (unsigned char*)d_ws; p.rep_mask = REPEAT_MASK;
#if SINGLE_LAUNCH
    hipMemsetAsync((unsigned char*)d_ws + WS_CTL + (size_t)CW_BAR * 4, 0, XCD_BAR_WORDS * 4, stream);
    p.ph_lo = 0; p.ph_hi = N_PHASES;
    void* args[] = {&p};
    hipError_t e = hipLaunchCooperativeKernel((const void*)mega, dim3(grid), dim3(NTHREADS), args, LDS_BYTES, stream);
    if (e != hipSuccess) fprintf(stderr, "cooperative launch failed: %s (grid %d)\n", hipGetErrorString(e), grid);
#else
    for (int ph = 0; ph < N_PHASES; ++ph) {
        p.ph_lo = ph; p.ph_hi = ph + 1;
        hipLaunchKernelGGL(mega, dim3(grid), dim3(NTHREADS), LDS_BYTES, stream, p);
    }
#endif
}
```

```cpp
#include <hip/hip_runtime.h>
#include <hip/hip_cooperative_groups.h>
#include <cstdio>
#include <cstdint>
namespace cg = cooperative_groups;

#ifndef REPEAT_MASK
#define REPEAT_MASK 0
#endif
#ifndef SINGLE_LAUNCH
#define SINGLE_LAUNCH 1
#endif

typedef unsigned short bf16_t;
typedef short bf16x8 __attribute__((ext_vector_type(8)));
typedef float f32x4 __attribute__((ext_vector_type(4)));
typedef unsigned u32x2 __attribute__((ext_vector_type(2)));
typedef unsigned u32x4 __attribute__((ext_vector_type(4)));

constexpr int B_ = 2, S_ = 8192, D_ = 1024, T_ = B_ * S_, NLAYER = 4;
constexpr int DIN = 6424;
constexpr int LD = 5376;
constexpr int NW = 6656;
constexpr int C_QA = 0, C_KC = 512, C_VC = 640, C_KS = 768, C_KW = 896, C_QR = 1024, C_KR = 1536, C_GR = 2048, C_MA = 3072, C_MB = 4096, C_GA = 5120,
              C_VS = 5376, C_VW = 5504, C_VR = 5632;
constexpr float DN_ALPHA = 1.681792830507429f;
constexpr int NE = 16;

constexpr size_t al256(size_t x) { return (x + 255) & ~(size_t)255; }
constexpr size_t WS_CTL = 0;
constexpr size_t WS_BUCKET = 65536;
constexpr size_t WS_ROPE = WS_BUCKET + 8192;
constexpr size_t WS_WIN = WS_ROPE + (size_t)8192 * 32 * 8;
constexpr size_t WS_WA = WS_WIN + (size_t)NW * 1024 * 2;
constexpr size_t WS_WB = WS_WA + (size_t)1024 * 512 * 2;
constexpr size_t WS_WO = WS_WB + (size_t)1024 * 1024 * 2;
constexpr size_t WS_WG = WS_WO + (size_t)1024 * 1024 * 2;
constexpr size_t WS_WU = WS_WG + (size_t)16 * 512 * 1024 * 2;
constexpr size_t WS_WD = WS_WU + (size_t)16 * 512 * 1024 * 2;
constexpr size_t WS_XB = WS_WD + (size_t)16 * 512 * 1024 * 2;
constexpr size_t WS_X = WS_XB + (size_t)T_ * 1024 * 2;
constexpr size_t WS_MG = WS_X + (size_t)T_ * 1024 * 4;
constexpr size_t WS_KCC = WS_MG + (size_t)T_ * 1024 * 2;
constexpr size_t WS_VCCT = WS_KCC + (size_t)4 * 512 * 64 * 2;
constexpr size_t WS_W1T = WS_VCCT + (size_t)4 * 512 * 64 * 2;
constexpr size_t WS_B1 = WS_W1T + (size_t)2 * 64 * 2048 * 2;
constexpr size_t WS_R = WS_B1 + 1024;
constexpr size_t WS_P = WS_R;
constexpr size_t WS_VST = WS_P + (size_t)T_ * LD * 2;
constexpr size_t WS_VWT = WS_VST + (size_t)4 * 64 * S_ * 2;
constexpr size_t WS_VRT = WS_VWT + (size_t)4 * 64 * S_ * 2;
constexpr size_t WS_KVT = WS_VRT + (size_t)16 * 128 * S_ * 2;
constexpr size_t WS_SPT = WS_KVT + (size_t)16 * 64 * 8192 * 4;
constexpr size_t WS_YC = WS_SPT + (size_t)16 * 64 * 8192 * 2;
constexpr size_t WS_YW = WS_YC + (size_t)T_ * 512 * 2;
constexpr size_t WS_YA = WS_YW + (size_t)T_ * 512 * 2;
constexpr size_t WS_YB = WS_YA + (size_t)T_ * 512 * 2;
constexpr size_t WS_SELW = WS_YB + (size_t)T_ * 1024 * 2;
constexpr size_t WS_ENDA = WS_SELW + (size_t)T_ * 2 * 4 * 4;
constexpr size_t WS_H1 = WS_R;
constexpr size_t WS_X1 = WS_H1 + (size_t)T_ * 1024 * 4;
constexpr size_t WS_X1B = WS_X1 + (size_t)T_ * 1024 * 4;
constexpr size_t WS_HB = WS_X1B + (size_t)T_ * 1024 * 2;
constexpr size_t WS_CT = WS_HB + (size_t)2 * T_ * 512 * 2;
constexpr size_t WS_LIST = WS_CT + (size_t)2 * T_ * 1024 * 2;
constexpr size_t WS_WTS = WS_LIST + (size_t)16 * T_ * 4;
constexpr size_t WS_ENDB = WS_WTS + (size_t)2 * T_ * 4;
static_assert(WS_HB + (size_t)2 * T_ * 512 * 2 <= WS_CT, "view B overlap");
constexpr size_t WS_END = WS_ENDA > WS_ENDB ? WS_ENDA : WS_ENDB;

constexpr int CW_CNT = 4096;
constexpr int CW_BAR = 8192;

constexpr int HALF_LDS = 75776, LDS_BYTES = 2 * HALF_LDS + 16;
constexpr int NTHREADS = 512, HT = 256;

struct Params {
    const float* x; const float* w_in; const float* cmp_pos; const float* cmp_w1; const float* cmp_w2;
    const float* w_br_a; const float* w_br_b; const float* w_o; const float* ln1_g; const float* ln1_b;
    const float* w_router; const float* router_bias; const float* w_gate; const float* w_up; const float* w_down;
    const float* ln2_g; const float* ln2_b; const float* rel_bias;
    float* out; unsigned char* ws;
    int ph_lo, ph_hi, rep_mask, pad_;
};

__device__ __forceinline__ bf16_t f2bf(float f) { unsigned u = __float_as_uint(f); u += 0x7fffu + ((u >> 16) & 1u); return (bf16_t)(u >> 16); }
__device__ __forceinline__ float bf2f(unsigned h) { return __uint_as_float(h << 16); }
typedef __bf16 bf16x2_t __attribute__((ext_vector_type(2)));
typedef float f32x2_t __attribute__((ext_vector_type(2)));
__device__ __forceinline__ unsigned pack2(float lo, float hi) { const f32x2_t f = {lo, hi}; return __builtin_bit_cast(unsigned, __builtin_convertvector(f, bf16x2_t)); }
__device__ __forceinline__ u32x2 pack4(f32x4 v) { u32x2 r; r.x = pack2(v[0], v[1]); r.y = pack2(v[2], v[3]); return r; }
__device__ __forceinline__ f32x4 unpack4(u32x2 u) { f32x4 r; r[0] = bf2f(u.x & 0xffffu); r[1] = bf2f(u.x >> 16); r[2] = bf2f(u.y & 0xffffu); r[3] = bf2f(u.y >> 16); return r; }
__device__ __forceinline__ float rows_max(float v) {
    u32x2 r = __builtin_amdgcn_permlane16_swap(__float_as_uint(v), __float_as_uint(v), false, false);
    v = fmaxf(__uint_as_float(r.x), __uint_as_float(r.y));
    r = __builtin_amdgcn_permlane32_swap(__float_as_uint(v), __float_as_uint(v), false, false);
    return fmaxf(__uint_as_float(r.x), __uint_as_float(r.y));
}
__device__ __forceinline__ float rows_sum(float v) {
    u32x2 r = __builtin_amdgcn_permlane16_swap(__float_as_uint(v), __float_as_uint(v), false, false);
    v = __uint_as_float(r.x) + __uint_as_float(r.y);
    r = __builtin_amdgcn_permlane32_swap(__float_as_uint(v), __float_as_uint(v), false, false);
    return __uint_as_float(r.x) + __uint_as_float(r.y);
}
__device__ __forceinline__ float wave_sum(float v) {
    v += __int_as_float(__builtin_amdgcn_mov_dpp(__float_as_int(v), 0xB1, 0xF, 0xF, true));
    v += __int_as_float(__builtin_amdgcn_mov_dpp(__float_as_int(v), 0x4E, 0xF, 0xF, true));
    v += __int_as_float(__builtin_amdgcn_mov_dpp(__float_as_int(v), 0x141, 0xF, 0xF, true));
    v += __int_as_float(__builtin_amdgcn_mov_dpp(__float_as_int(v), 0x140, 0xF, 0xF, true));
    return rows_sum(v);
}
__device__ __forceinline__ float sigmoidf_(float x) { return 1.f / (1.f + __expf(-x)); }
__device__ __forceinline__ int ltid() { int t = threadIdx.x; asm volatile("" : "+v"(t)); return t; }
__device__ __forceinline__ int vzero() { int z; asm volatile("v_mov_b32 %0, 0" : "=v"(z)); return z; }
__device__ __forceinline__ unsigned char* launder(unsigned char* q) { asm volatile("" : "+s"(q)); return q; }
__device__ __forceinline__ void wait_vm0() { asm volatile("s_waitcnt vmcnt(0)" ::: "memory"); }

__device__ __forceinline__ void glds16(const void* g, void* l) {
    __builtin_amdgcn_global_load_lds((const __attribute__((address_space(1))) unsigned*)g,
                                     (__attribute__((address_space(3))) unsigned*)l, 16, 0, 0);
}
__device__ __forceinline__ f32x4 mfma16(bf16x8 a, bf16x8 b, f32x4 c) { return __builtin_amdgcn_mfma_f32_16x16x32_bf16(a, b, c, 0, 0, 0); }

#define WAIT_V(n) asm volatile("s_waitcnt vmcnt(%0)" ::"n"(n) : "memory")
#define RAW_BARRIER() do { asm volatile("s_waitcnt lgkmcnt(0)" ::: "memory"); __builtin_amdgcn_s_barrier(); } while (0)
__device__ __forceinline__ void bglds16(__amdgpu_buffer_rsrc_t r, unsigned voff, int soff, void* l) {
    __builtin_amdgcn_raw_ptr_buffer_load_lds(r, (__attribute__((address_space(3))) void*)l, 16, (int)voff, soff, 0, 0);
}
template <int NJ, bool GN>
__device__ __forceinline__ void gemm8_stage(__amdgpu_buffer_rsrc_t mr, int mld, unsigned mvo, __amdgpu_buffer_rsrc_t nr, int nld, const unsigned (&nvo)[NJ], int kt, unsigned char* st, int wid) {
#pragma unroll
    for (int i = 0; i < 4; ++i) bglds16(mr, mvo, (64 * i * mld + kt * 64) * 2, st + (8 * i + wid) * 1024);
#pragma unroll
    for (int i = 0; i < NJ; ++i) bglds16(nr, nvo[i], ((GN ? 0 : 64 * i * nld) + kt * 64) * 2, st + 32768 + (8 * i + wid) * 1024);
}
template <int NJ, bool GN>
__device__ __forceinline__ void gemm8_kloop(const bf16_t* mb, int mld, unsigned mvo, const bf16_t* nb, int nld, const unsigned (&nvo)[NJ], int nk, unsigned char* lds, f32x4 (&acc)[8][NJ], int tid) {
    const int lane = tid & 63, wid = tid >> 6, wr = wid >> 2, wc = wid & 3, fr = lane & 15, fq = lane >> 4;
    const __amdgpu_buffer_rsrc_t mr = __builtin_amdgcn_make_buffer_rsrc((void*)mb, 0, 0x7fffffff, 0x00020000);
    const __amdgpu_buffer_rsrc_t nr = __builtin_amdgcn_make_buffer_rsrc((void*)nb, 0, 0x7fffffff, 0x00020000);
    gemm8_stage<NJ, GN>(mr, mld, mvo, nr, nld, nvo, 0, lds, wid);
    gemm8_stage<NJ, GN>(mr, mld, mvo, nr, nld, nvo, 1, lds + 65536, wid);
    for (int kt = 0; kt < nk; ++kt) {
        unsigned char* cur = lds + (kt & 1) * 65536;
        if (kt + 1 < nk) WAIT_V(4 + NJ); else WAIT_V(0);
        RAW_BARRIER();
        bf16x8 a[4], b[NJ];
        const unsigned char* ab = cur + (128 * wr + fr) * 128;
        const unsigned char* bb = cur + 32768 + (16 * NJ * wc + fr) * 128;
        const int sw0 = ((fq) ^ (fr & 7)) << 4, sw1 = ((4 + fq) ^ (fr & 7)) << 4;
#pragma unroll
        for (int j = 0; j < NJ; ++j) b[j] = *(const bf16x8*)(bb + j * 2048 + sw0);
#pragma unroll
        for (int mh = 0; mh < 2; ++mh) {
#pragma unroll
            for (int i = 0; i < 4; ++i) a[i] = *(const bf16x8*)(ab + (4 * mh + i) * 2048 + sw0);
#pragma unroll
            for (int i = 0; i < 4; ++i)
#pragma unroll
                for (int j = 0; j < NJ; ++j) acc[4 * mh + i][j] = mfma16(a[i], b[j], acc[4 * mh + i][j]);
        }
#pragma unroll
        for (int j = 0; j < NJ; ++j) b[j] = *(const bf16x8*)(bb + j * 2048 + sw1);
#pragma unroll
        for (int i = 0; i < 4; ++i) a[i] = *(const bf16x8*)(ab + i * 2048 + sw1);
#pragma unroll
        for (int i = 0; i < 4; ++i)
#pragma unroll
            for (int j = 0; j < NJ; ++j) acc[i][j] = mfma16(a[i], b[j], acc[i][j]);
#pragma unroll
        for (int i = 0; i < 4; ++i) a[i] = *(const bf16x8*)(ab + (4 + i) * 2048 + sw1);
        RAW_BARRIER();
        if (kt + 2 < nk) gemm8_stage<NJ, GN>(mr, mld, mvo, nr, nld, nvo, kt + 2, cur, wid);
#pragma unroll
        for (int i = 0; i < 4; ++i)
#pragma unroll
            for (int j = 0; j < NJ; ++j) acc[4 + i][j] = mfma16(a[i], b[j], acc[4 + i][j]);
    }
    __syncthreads();
    __builtin_amdgcn_sched_barrier(0);
}
template <int NJ>
__device__ __forceinline__ void zero_acc8(f32x4 (&acc)[8][NJ]) {
#pragma unroll
    for (int i = 0; i < 8; ++i)
#pragma unroll
        for (int j = 0; j < NJ; ++j) acc[i][j] = (f32x4){0.f, 0.f, 0.f, 0.f};
}

namespace pg8 {
#define PG8_LAS __attribute__((address_space(3)))
constexpr int BM = 256, BK = 64, HALF = 128, HTB = HALF * BK * 2, STAGE_BYTES = 8 * HTB;
__device__ __forceinline__ int lds_byte(int r, int c) { const int st = (r >> 4) * 2 + (c >> 5), rr = r & 15, cc = c & 31, ob = rr * 64 + cc * 2; return st * 1024 + (ob ^ (((ob >> 9) & 1) << 5)); }
__device__ __forceinline__ void stage_rc(int b, int& R, int& C) { const int st = b / 1024, sb = b % 1024, swz = sb ^ (((sb >> 9) & 1) << 5); R = (st >> 1) * 16 + swz / 64; C = (st & 1) * 32 + (swz % 64) / 2; }
__device__ __forceinline__ int perm32(int rho) { const int n = rho >> 4, i = rho & 15; return 8 * (i >> 2) + 4 * n + (i & 3); }
struct Unit { int pm, pn; };
template <class Epi, class Sched>
__device__ __forceinline__ void gemm_phase(unsigned char* lds_, const int K, const Sched& S, const Epi& E, const int tid, const unsigned char* wsbase) {
    PG8_LAS unsigned char* lds = (PG8_LAS unsigned char*)lds_;
    const int wid = __builtin_amdgcn_readfirstlane(tid >> 6), lane = tid & 63, wr = wid >> 2, wc = wid & 3, fr = lane & 15, fq = lane >> 4;
    const int nt = K / BK;
    unsigned voffA[2], voffB[2];
#pragma unroll
    for (int i = 0; i < 2; ++i) { int R, C; stage_rc(tid * 16 + i * 8192, R, C); const int Rb = (R & ~31) + perm32(R & 31);
        voffA[i] = (unsigned)(R * K + C) * 2u; voffB[i] = (unsigned)(Rb * K + C) * 2u; }
    const unsigned kstep = (unsigned)(BK * 2);
    const unsigned hstep = (unsigned)HALF * K * 2;
    const __amdgpu_buffer_rsrc_t rsrc = __builtin_amdgcn_make_buffer_rsrc((void*)wsbase, 0, 0x7fffffff, 0x00020000);
    const unsigned ldsw = (unsigned)wid * 1024u;
    const int aoff = lds_byte(wr * 64 + fr, fq * 8), boff = lds_byte(wc * 32 + fr, fq * 8);
#define PG8_SA(b, h) (((b) * 2 + (h)) * HTB)
#define PG8_SB(b, h) ((4 + (b) * 2 + (h)) * HTB)
#define PG8_STAGE(bufoff, gbase, voff) do { _Pragma("unroll") for (int _i = 0; _i < 2; ++_i) \
        __builtin_amdgcn_raw_ptr_buffer_load_lds(rsrc, (PG8_LAS void*)(lds + (bufoff) + ldsw + _i * 8192), 16, (int)(voff)[_i], (int)(gbase), 0, 0); } while (0)
#define PG8_LDA(dst, b, h) do { _Pragma("unroll") for (int m = 0; m < 4; ++m) _Pragma("unroll") for (int k = 0; k < 2; ++k) dst[m][k] = *(const PG8_LAS bf16x8*)(lds + PG8_SA(b, h) + aoff + m * 2048 + k * 1024); } while (0)
#define PG8_LDB(dst, b, h) do { _Pragma("unroll") for (int n = 0; n < 2; ++n) _Pragma("unroll") for (int k = 0; k < 2; ++k) dst[n][k] = *(const PG8_LAS bf16x8*)(lds + PG8_SB(b, h) + boff + n * 2048 + k * 1024); } while (0)
#define PG8_MMA(ai, bj, At, Bt) do { __builtin_amdgcn_s_setprio(1); _Pragma("unroll") for (int m = 0; m < 4; ++m) _Pragma("unroll") for (int n = 0; n < 2; ++n) _Pragma("unroll") for (int k = 0; k < 2; ++k) \
        acc[ai][bj][m][n] = __builtin_amdgcn_mfma_f32_16x16x32_bf16(Bt[n][k], At[m][k], acc[ai][bj][m][n], 0, 0, 0); __builtin_amdgcn_s_setprio(0); } while (0)
#define PG8_WAIT_V(n) asm volatile("s_waitcnt vmcnt(" #n ")" ::: "memory")
#define PG8_WAIT_L(n) asm volatile("s_waitcnt lgkmcnt(" #n ")" ::: "memory")
#define PG8_BAR __builtin_amdgcn_s_barrier()
#define PG8_SCHED __builtin_amdgcn_sched_barrier(0)
    typename Sched::U cur, nxt; int ui = 0;
    if (!S.next(0, cur)) return;
    unsigned cA, cB; S.ptrs(cur, cA, cB);
    constexpr bool GA = Sched::GATHER;
    unsigned vA[2], nvA[2];
    if constexpr (GA) { S.rows(cur, tid, vA); nvA[0] = vA[0]; nvA[1] = vA[1]; }
#define PG8_STAGE_G(bufoff, gbase, pk) do { const unsigned _cb = voffB[0] & (unsigned)(2 * K - 1); unsigned _vo[2] = {(((pk) & 0xffffu) * (unsigned)(2 * K)) + _cb, (((pk) >> 16) * (unsigned)(2 * K)) + _cb}; PG8_STAGE(bufoff, gbase, _vo); } while (0)
#define PG8_STAGE_A(bufoff, gbase, h, nextu) do { if constexpr (GA) { if (nextu) PG8_STAGE_G(bufoff, gbase, nvA[h]); else PG8_STAGE_G(bufoff, gbase, vA[h]); } \
        else PG8_STAGE(bufoff, (gbase) + (h) * hstep, voffA); } while (0)
    PG8_STAGE(PG8_SB(0, 0), cB, voffB); PG8_STAGE_A(PG8_SA(0, 0), cA, 0, false); PG8_STAGE(PG8_SB(0, 1), cB + hstep, voffB); PG8_STAGE_A(PG8_SA(0, 1), cA, 1, false);
    if (wr == 1) PG8_BAR;
    PG8_WAIT_V(4); PG8_BAR;
    PG8_STAGE(PG8_SB(1, 0), cB + kstep, voffB); PG8_STAGE_A(PG8_SA(1, 0), cA + kstep, 0, false); PG8_STAGE(PG8_SB(1, 1), cB + hstep + kstep, voffB);
    PG8_WAIT_V(6); PG8_BAR;
    PG8_SCHED;
    f32x4 acc[2][2][4][2];
#pragma unroll
    for (int a = 0; a < 2; ++a)
#pragma unroll
        for (int b = 0; b < 2; ++b)
#pragma unroll
            for (int m = 0; m < 4; ++m)
#pragma unroll
                for (int n = 0; n < 2; ++n) acc[a][b][m][n] = (f32x4){0.f, 0.f, 0.f, 0.f};
    bf16x8 At[4][2], B0[2][2], B1[2][2];
    for (;;) {
        const bool has_next = S.next(ui + 1, nxt);
        unsigned nA = cA, nB = cB; if (has_next) S.ptrs(nxt, nA, nB);
        if constexpr (GA) { if (has_next) S.rows(nxt, tid, nvA); }
        for (int t = 0; t < nt; t += 2) {
            const bool last = (t == nt - 2);
            const unsigned a1 = cA + (unsigned)(t + 1) * kstep;
            const unsigned a2 = last ? nA : cA + (unsigned)(t + 2) * kstep, b2 = last ? nB : cB + (unsigned)(t + 2) * kstep;
            const unsigned a3 = a2 + kstep, b3 = b2 + kstep;
            PG8_LDB(B0, 0, 0); PG8_SCHED; PG8_LDA(At, 0, 0); PG8_STAGE_A(PG8_SA(1, 1), a1, 1, false);
            PG8_WAIT_L(8); PG8_BAR; PG8_WAIT_L(0); PG8_MMA(0, 0, At, B0); PG8_BAR; PG8_SCHED;
            PG8_LDB(B1, 0, 1); PG8_STAGE(PG8_SB(0, 0), b2, voffB);
            PG8_BAR; PG8_WAIT_L(0); PG8_MMA(0, 1, At, B1); PG8_BAR;
            PG8_LDA(At, 0, 1); PG8_STAGE_A(PG8_SA(0, 0), a2, 0, last);
            PG8_BAR; PG8_WAIT_L(0); PG8_MMA(1, 0, At, B0); PG8_BAR; PG8_SCHED;
            PG8_STAGE(PG8_SB(0, 1), b2 + hstep, voffB);
            PG8_WAIT_V(6); PG8_BAR; PG8_MMA(1, 1, At, B1); PG8_BAR;
            PG8_LDB(B0, 1, 0); PG8_SCHED; PG8_LDA(At, 1, 0); PG8_STAGE_A(PG8_SA(0, 1), a2, 1, last);
            PG8_WAIT_L(8); PG8_BAR; PG8_WAIT_L(0); PG8_MMA(0, 0, At, B0); PG8_BAR; PG8_SCHED;
            PG8_LDB(B1, 1, 1); PG8_STAGE(PG8_SB(1, 0), b3, voffB);
            PG8_BAR; PG8_WAIT_L(0); PG8_MMA(0, 1, At, B1); PG8_BAR;
            PG8_LDA(At, 1, 1); PG8_STAGE_A(PG8_SA(1, 0), a3, 0, last);
            PG8_BAR; PG8_WAIT_L(0); PG8_MMA(1, 0, At, B0); PG8_BAR; PG8_SCHED;
            PG8_STAGE(PG8_SB(1, 1), b3 + hstep, voffB);
            PG8_WAIT_V(6); PG8_BAR; PG8_MMA(1, 1, At, B1); PG8_BAR;
        }
        E(acc, cur, wr, wc, fr, fq);
        if (!has_next) break;
#pragma unroll
        for (int a = 0; a < 2; ++a)
#pragma unroll
            for (int b = 0; b < 2; ++b)
#pragma unroll
                for (int m = 0; m < 4; ++m)
#pragma unroll
                    for (int n = 0; n < 2; ++n) acc[a][b][m][n] = (f32x4){0.f, 0.f, 0.f, 0.f};
        cur = nxt; cA = nA; cB = nB; ++ui;
        if constexpr (GA) { vA[0] = nvA[0]; vA[1] = nvA[1]; }
    }
    PG8_WAIT_V(0);
    if (wr == 0) PG8_BAR;
    PG8_BAR;
#undef PG8_SA
#undef PG8_SB
#undef PG8_STAGE
#undef PG8_STAGE_A
#undef PG8_STAGE_G
#undef PG8_LDA
#undef PG8_LDB
#undef PG8_MMA
#undef PG8_WAIT_V
#undef PG8_WAIT_L
#undef PG8_BAR
#undef PG8_SCHED
}
}

struct TJob { const float* src; bf16_t* dst; int ld, k0, n0, mode, kdst; };
__device__ __forceinline__ void tcvt_load(const TJob& J, float4 (&v)[4], int tid) {
#pragma unroll
    for (int i = 0; i < 4; ++i) {
        const int kk = (tid >> 4) + 16 * i, c4 = (tid & 15) * 4, cd = J.n0 + c4;
        int orig = cd; bool ok = true;
        if (J.mode == 1) {
            if (cd < 896) orig = cd;
            else if (cd < 1024) orig = cd - 896 + 1024;
            else if (cd < 2048) { const int q = cd - 1024, hd = q >> 6, pp = q & 63;
                const int d = (pp & 4) ? 32 + 4 * (pp >> 3) + (pp & 3) : 4 * (pp >> 3) + (pp & 3);
                orig = 1304 + hd * 64 + d; }
            else if (cd < 5120) orig = cd - 2048 + 3352;
            else if (cd < 5144) orig = cd - 5120 + 1280;
            else if (cd < 5376) ok = false;
            else if (cd < 5504) orig = cd - 5376 + 896;
            else if (cd < 5632) orig = cd - 5504 + 1152;
            else orig = cd - 5632 + 2328;
        }
        v[i] = make_float4(0.f, 0.f, 0.f, 0.f);
        if (ok) v[i] = *(const float4*)(J.src + (size_t)(J.k0 + kk) * J.ld + orig);
    }
}
__device__ __forceinline__ void tcvt_finish(const TJob& J, const float4 (&v)[4], unsigned char* lds, int tid) {
    float* tile = (float*)lds;
#pragma unroll
    for (int i = 0; i < 4; ++i) {
        const int kk = (tid >> 4) + 16 * i, c4 = (tid & 15) * 4;
        tile[kk * 65 + c4 + 0] = v[i].x; tile[kk * 65 + c4 + 1] = v[i].y; tile[kk * 65 + c4 + 2] = v[i].z; tile[kk * 65 + c4 + 3] = v[i].w;
    }
    __syncthreads();
#pragma unroll
    for (int i = 0; i < 2; ++i) {
        const int q = tid + 256 * i, n = q >> 3, kc = q & 7;
        float x[8];
#pragma unroll
        for (int j = 0; j < 8; ++j) x[j] = tile[(kc * 8 + j) * 65 + n];
        u32x4 w; w.x = pack2(x[0], x[1]); w.y = pack2(x[2], x[3]); w.z = pack2(x[4], x[5]); w.w = pack2(x[6], x[7]);
        int drow = J.n0 + n; if (J.mode >= 2) drow = 8 * (drow >> 2) + (drow & 3) + (J.mode == 3 ? 4 : 0);
        *(u32x4*)(J.dst + (size_t)drow * J.kdst + J.k0 + kc * 8) = w;
    }
    __syncthreads();
}
__device__ __forceinline__ void tcvt_tile(const float* src, int ld_src, int k0, int n0, int mode, bf16_t* dst, int kdst, unsigned char* lds, int half) {
    TJob J; J.src = src; J.dst = dst; J.ld = ld_src; J.k0 = k0; J.n0 = n0; J.mode = mode; J.kdst = kdst;
    const int tid = (ltid() & 255); float4 v[4];
    tcvt_load(J, v, tid); tcvt_finish(J, v, lds, tid);
}

__device__ __forceinline__ void tcvt_decode(const Params& p, unsigned char* ws, int layer, int t, TJob& J) {
    constexpr int J0 = 16 * 104, J1 = 8 * 16, J2 = 256, J3 = 256, J4 = 2048, J5 = 2048;
    int u = t;
        if (u < J0) { J.src = p.w_in + (size_t)layer * 1024 * DIN; J.ld = DIN; J.k0 = (u % 16) * 64; J.n0 = (u / 16) * 64; J.mode = 1; J.dst = (bf16_t*)(ws + WS_WIN); J.kdst = 1024; return; }
        u -= J0;
        if (u < J1) { J.src = p.w_br_a + (size_t)layer * 512 * 1024; J.ld = 1024; J.k0 = (u % 8) * 64; J.n0 = (u / 8) * 64; J.mode = 0; J.dst = (bf16_t*)(ws + WS_WA); J.kdst = 512; return; }
        u -= J1;
        if (u < J2) { J.src = p.w_br_b + (size_t)layer * 1024 * 1024; J.ld = 1024; J.k0 = (u % 16) * 64; J.n0 = (u / 16) * 64; J.mode = 0; J.dst = (bf16_t*)(ws + WS_WB); J.kdst = 1024; return; }
        u -= J2;
        if (u < J3) { J.src = p.w_o + (size_t)layer * 1024 * 1024; J.ld = 1024; J.k0 = (u % 16) * 64; J.n0 = (u / 16) * 64; J.mode = 0; J.dst = (bf16_t*)(ws + WS_WO); J.kdst = 1024; return; }
        u -= J3;
        if (u < J4 + J5) {
            const bool up = u >= J4; if (up) u -= J4;
            const int e = u / 128, v = u % 128;
            J.src = (up ? p.w_up : p.w_gate) + ((size_t)layer * NE + e) * 1024 * 512; J.ld = 512; J.k0 = (v % 16) * 64; J.n0 = (v / 16) * 64; J.mode = up ? 3 : 2;
            J.dst = (bf16_t*)(ws + WS_WG) + (size_t)e * 1024 * 1024; J.kdst = 1024; return;
        }
        u -= J4 + J5;
        { const int e = u / 128, v = u % 128;
          J.src = p.w_down + ((size_t)layer * NE + e) * 512 * 1024; J.ld = 1024; J.k0 = (v % 8) * 64; J.n0 = (v / 8) * 64; J.mode = 0; J.dst = (bf16_t*)(ws + WS_WD) + (size_t)e * 1024 * 512; J.kdst = 512; }
}


__device__ __forceinline__ void phase_pw(const Params& p, int layer, unsigned char* lds, int parts, int half, int skip = 0) {
    const int hq = __builtin_amdgcn_readfirstlane(ltid() >> 8);
    if ((int)(blockIdx.x * 2 + hq) < skip) return;
    const int bid = (blockIdx.x * 2 + hq) - skip, nblk = (gridDim.x * 2) - skip, tid = (ltid() & 255);
    unsigned char* ws = launder(p.ws);
    constexpr int J0 = 16 * 104, J1 = 8 * 16, J2 = 256, J3 = 256, J4 = 2048, J5 = 2048, J6 = 2048, JT = J0 + J1 + J2 + J3 + J4 + J5 + J6;
    const int t_lo = (parts & 1) ? 0 : (parts & 2) ? J0 : J0 + J1 + J2 + J3;
    const int t_hi = (parts & 4) ? JT : (parts & 2) ? J0 + J1 + J2 + J3 : (parts & 1) ? J0 : 0;
    if (t_lo + bid < t_hi) {
        float4 v[4]; { TJob J; tcvt_decode(p, ws, layer, t_lo + bid, J); tcvt_load(J, v, tid); }
        for (int t = t_lo + bid; t < t_hi; t += nblk) {
            float4 vn[4];
            if (t + nblk < t_hi) { TJob J; tcvt_decode(p, ws, layer, t + nblk, J); tcvt_load(J, vn, tid); }
            { TJob J; tcvt_decode(p, ws, layer, t, J); tcvt_finish(J, v, lds, tid); }
#pragma unroll
            for (int i = 0; i < 4; ++i) v[i] = vn[i];
        }
    }
    if (parts & 16) {
    for (int t = bid; t < 64; t += nblk) {
        const int kv = t >> 5, kt = t & 31;
        tcvt_tile(p.cmp_w1 + ((size_t)layer * 2 + kv) * 2048 * 64, 64, kt * 64, 0, 0, (bf16_t*)(ws + WS_W1T) + (size_t)kv * 64 * 2048, 2048, lds, half);
    }
    if (bid >= nblk - 2) {
        const int kv = nblk - 1 - bid, n = tid & 63, part = tid >> 6;
        const float* w1 = p.cmp_w1 + ((size_t)layer * 2 + kv) * 2048 * 64; const float* pos = p.cmp_pos + ((size_t)layer * 2 + kv) * 2048;
        float a = 0.f;
        for (int k = part * 512; k < part * 512 + 512; ++k) a += pos[k] * w1[(size_t)k * 64 + n];
        float* red = (float*)lds;
        __syncthreads(); red[tid] = a; __syncthreads();
        if (tid < 64) ((float*)(ws + WS_B1))[kv * 64 + tid] = red[tid] + red[tid + 64] + red[tid + 128] + red[tid + 192];
        __syncthreads();
    }
    }
    if (parts & 8) {
        const float4* xs = (const float4*)p.x; u32x2* xb = (u32x2*)(ws + WS_XB);
        for (size_t i = (size_t)bid * HT + tid; i < (size_t)T_ * 1024 / 4; i += (size_t)nblk * HT) {
            float4 v = xs[i]; u32x2 w; w.x = pack2(v.x, v.y); w.y = pack2(v.z, v.w); xb[i] = w;
        }
        for (int n = bid * HT + tid; n < 8192; n += nblk * HT) {
            int bk;
            if (n < 16) bk = n;
            else { const int th[15] = {22, 30, 40, 54, 73, 99, 134, 182, 246, 332, 450, 609, 825, 1117, 1513}; bk = 16;
#pragma unroll
                for (int k = 0; k < 15; ++k) bk += (n >= th[k]) ? 1 : 0; }
            (ws + WS_BUCKET)[n] = (unsigned char)bk;
        }
        for (int i = bid * HT + tid; i < 8192 * 32; i += nblk * HT) {
            const int pos = i >> 5, d = i & 31;
            const float inv = powf(10000.f, -(float)d * 2.0f / 64.f);
            const float ang = (float)pos * inv;
            float sn, cs; sincosf(ang, &sn, &cs);
            ((float2*)(ws + WS_ROPE))[i] = make_float2(cs, sn);
        }
        if (bid == 0) for (int i = tid; i < 8192; i += HT) ((unsigned*)(ws + WS_CTL))[i] = 0u;
    }
}

__device__ __forceinline__ float fsig(float x) { return __builtin_amdgcn_rcpf(1.f + __builtin_amdgcn_exp2f(-1.4426950408889634f * x)); }
template <int KIND>
__device__ __forceinline__ void g1_epi(const f32x4 (&acc)[2][2][4][2], unsigned char* ws, int r0, int c0, int wr, int wc, int fr, int fq) {
#pragma unroll
    for (int ai = 0; ai < 2; ++ai)
#pragma unroll
        for (int m = 0; m < 4; ++m) {
            const int row = r0 + 128 * ai + 64 * wr + 16 * m + fr + vzero();
#pragma unroll
            for (int bj = 0; bj < 2; ++bj) {
                const int col = c0 + 128 * bj + 32 * wc + 8 * fq;
                f32x4 v0 = acc[ai][bj][m][0], v1 = acc[ai][bj][m][1];
                if (KIND == 5) {
                    const int b = col >> 13, sq = col & (S_ - 1);
                    bf16_t* dst;
                    if (row < C_VW) { const int c = row - C_VS; dst = (bf16_t*)(ws + WS_VST) + ((size_t)(b * 2 + (c >> 6)) * 64 + (c & 63)) * S_ + sq; }
                    else if (row < C_VR) { const int c = row - C_VW; dst = (bf16_t*)(ws + WS_VWT) + ((size_t)(b * 2 + (c >> 6)) * 64 + (c & 63)) * S_ + sq; }
                    else { const int c = row - C_VR; dst = (bf16_t*)(ws + WS_VRT) + ((size_t)(b * 8 + (c >> 7)) * 128 + (c & 127)) * S_ + sq; }
                    u32x4 w; w.x = pack2(v0[0], v0[1]); w.y = pack2(v0[2], v0[3]); w.z = pack2(v1[0], v1[1]); w.w = pack2(v1[2], v1[3]);
                    *(u32x4*)dst = w;
                    continue;
                }
                if (KIND == 1 || KIND == 2) {
                    const float2* rope = (const float2*)(ws + WS_ROPE);
                    const int pos = row & (S_ - 1), d = 16 * (wc & 1) + 4 * fq;
                    const float4 cs01 = *(const float4*)(rope + pos * 32 + d), cs23 = *(const float4*)(rope + pos * 32 + d + 2);
                    const float c[4] = {cs01.x, cs01.z, cs23.x, cs23.z}, sn[4] = {cs01.y, cs01.w, cs23.y, cs23.w};
                    const float sc = (KIND == 2) ? 0.125f : 1.0f;
                    f32x4 y1, y2;
#pragma unroll
                    for (int r = 0; r < 4; ++r) { y1[r] = (v0[r] * c[r] - v1[r] * sn[r]) * sc; y2[r] = (v0[r] * sn[r] + v1[r] * c[r]) * sc; }
                    v0 = y1; v1 = y2;
                } else if (KIND == 3) {
#pragma unroll
                    for (int r = 0; r < 4; ++r) { v0[r] = v0[r] * fsig(v0[r]); v1[r] = v1[r] * fsig(v1[r]); }
                } else if (KIND == 4) {
#pragma unroll
                    for (int r = 0; r < 4; ++r) { v0[r] = fsig(v0[r]); v1[r] = fsig(v1[r]); }
                }
                u32x4 w; w.x = pack2(v0[0], v0[1]); w.y = pack2(v0[2], v0[3]); w.z = pack2(v1[0], v1[1]); w.w = pack2(v1[2], v1[3]);
                *(u32x4*)((bf16_t*)(ws + WS_P) + (size_t)row * LD + col) = w;
            }
        }
}
struct G1Order {      typedef pg8::Unit U; static constexpr bool GATHER = false;
    int xcd, slot, per;
    __device__ __forceinline__ bool next(int i, pg8::Unit& u) const {
        const int j = slot + i * per; if (j >= 208) return false;
        if (j < 192) { u.pm = j / 3; u.pn = xcd + 8 * (j % 3); } else { const int q = j - 192; u.pm = 8 * xcd + (q >> 1); u.pn = 24 + (q & 1); }
        return true;
    }
    __device__ __forceinline__ void ptrs(const pg8::Unit& u, unsigned& A, unsigned& B) const {
        const unsigned x = (unsigned)WS_XB + (unsigned)u.pm * (256u * 1024u * 2u), w = (unsigned)WS_WIN + (unsigned)u.pn * (256u * 1024u * 2u);
        if (u.pn >= 21) { A = w; B = x; } else { A = x; B = w; }
    }
};
struct G1Epi {
    unsigned char* ws;
    __device__ __forceinline__ void operator()(const f32x4 (&acc)[2][2][4][2], const pg8::Unit& u, int wr, int wc, int fr, int fq) const {
        const int pn = u.pn, tok0 = u.pm * 256, n0 = pn * 256;
        if (pn >= 21) g1_epi<5>(acc, ws, n0, tok0, wr, wc, fr, fq);
        else if (pn >= 12) g1_epi<4>(acc, ws, tok0, n0, wr, wc, fr, fq);
        else if (pn >= 8) g1_epi<3>(acc, ws, tok0, n0, wr, wc, fr, fq);
        else if (pn >= 6) g1_epi<2>(acc, ws, tok0, n0, wr, wc, fr, fq);
        else if (pn >= 4) g1_epi<1>(acc, ws, tok0, n0, wr, wc, fr, fq);
        else g1_epi<0>(acc, ws, tok0, n0, wr, wc, fr, fq);
    }
};
__device__ __forceinline__ void phase_g1(const Params& p, int layer, unsigned char* lds) {
    unsigned char* ws = launder(p.ws);
    G1Order S; S.xcd = blockIdx.x & 7; S.slot = blockIdx.x >> 3; S.per = gridDim.x >> 3;
    G1Epi E; E.ws = ws;
    pg8::gemm_phase<G1Epi, G1Order>(lds, 1024, S, E, ltid(), ws);
}

__device__ __forceinline__ void load_tile64(const bf16_t* base, size_t rowStride, unsigned char* dst, int wid, int lane) {
    const int c = ((lane & 7) ^ (lane >> 3)) * 8;
#pragma unroll
    for (int i = 0; i < 2; ++i) { const int j = wid + 4 * i, row = 8 * j + (lane >> 3); glds16(base + (size_t)row * rowStride + c, dst + j * 1024); }
}
__device__ __forceinline__ void load_tile128(const bf16_t* base, size_t rowStride, unsigned char* dst, int wid, int lane) {
    const int c = ((lane & 7) ^ (lane >> 3)) * 8;
#pragma unroll
    for (int i = 0; i < 4; ++i) { const int j = wid + 4 * i, row = 8 * j + (lane >> 3); glds16(base + (size_t)row * rowStride + c, dst + j * 1024); }
}
__device__ __forceinline__ void load_tile128w(const bf16_t* base, size_t rowStride, unsigned char* dst, int wid, int lane) {
    const int c = ((lane & 15) ^ ((4 * wid + (lane >> 4)) & 15)) * 8;
#pragma unroll
    for (int i = 0; i < 8; ++i) { const int j = wid + 4 * i, row = 4 * j + (lane >> 4); glds16(base + (size_t)row * rowStride + c, dst + j * 1024); }
}
__device__ __forceinline__ bf16x8 lds_frag128(const unsigned char* tile, int row, int chunk) {
    return *(const bf16x8*)(tile + row * 128 + ((chunk ^ (row & 7)) << 4));
}
__device__ __forceinline__ bf16x8 lds_frag256(const unsigned char* tile, int row, int chunk) {
    return *(const bf16x8*)(tile + row * 256 + ((chunk ^ (row & 15)) << 4));
}
__device__ __forceinline__ bf16x8 lds_vfrag128(const unsigned char* tile, int row, int kbase, int fq) {
    const int ca = (kbase >> 3) + (fq >> 1), hb = (fq & 1) * 8;
    const u32x2 a = *(const u32x2*)(tile + row * 128 + ((ca ^ (row & 7)) << 4) + hb);
    const u32x2 b = *(const u32x2*)(tile + row * 128 + (((ca + 2) ^ (row & 7)) << 4) + hb);
    u32x4 w; w.x = a.x; w.y = a.y; w.z = b.x; w.w = b.y;
    return __builtin_bit_cast(bf16x8, w);
}
__device__ __forceinline__ bf16x8 lds_vfrag256(const unsigned char* tile, int row, int kbase, int fq) {
    const int ca = (kbase >> 3) + (fq >> 1), hb = (fq & 1) * 8;
    const u32x2 a = *(const u32x2*)(tile + row * 256 + ((ca ^ (row & 15)) << 4) + hb);
    const u32x2 b = *(const u32x2*)(tile + row * 256 + (((ca + 2) ^ (row & 15)) << 4) + hb);
    u32x4 w; w.x = a.x; w.y = a.y; w.z = b.x; w.w = b.y;
    return __builtin_bit_cast(bf16x8, w);
}
__device__ __forceinline__ bf16x8 pack8(f32x4 a, f32x4 b) {
    u32x4 w; w.x = pack2(a[0], a[1]); w.y = pack2(a[2], a[3]); w.z = pack2(b[0], b[1]); w.w = pack2(b[2], b[3]);
    return __builtin_bit_cast(bf16x8, w);
}

__device__ __forceinline__ float gelu_tanh(float x) {
    const float u = 0.7978845608028654f * (x + 0.044715f * x * x * x);
    return 0.5f * x * (1.f + tanhf(u));
}
__device__ __forceinline__ void compress_item(const Params& p, int layer, int item, unsigned char* lds, int half) {
    unsigned char* ws = launder(p.ws);
    const int tid = (ltid() & 255), lane = tid & 63, wid = tid >> 6, wr = wid >> 1, wc = wid & 1, fr = lane & 15, fq = lane >> 4;
    const int mtile = item & 3, g = (item >> 2) & 1, b = (item >> 3) & 1, kv = item >> 4;
    const int i0 = mtile * 128;
    const bf16_t* P = (const bf16_t*)(ws + WS_P);
    const bf16_t* W1T = (const bf16_t*)(ws + WS_W1T) + (size_t)kv * 64 * 2048;
    const int col = (kv ? C_VC : C_KC) + g * 64;
    const int ldc = ((lane & 7) ^ (lane >> 3)) * 8;
    const bf16_t* ap[4];
#pragma unroll
    for (int i = 0; i < 4; ++i) ap[i] = P + ((size_t)b * S_ + 16 * (i0 + 32 * i + 8 * wid + (lane >> 3))) * LD + col + ldc;
    const bf16_t* bp[2];
#pragma unroll
    for (int i = 0; i < 2; ++i) bp[i] = W1T + (size_t)(8 * (wid + 4 * i) + (lane >> 3)) * 2048 + ldc;
    f32x4 acc[4][2];
#pragma unroll
    for (int i = 0; i < 4; ++i)
#pragma unroll
        for (int j = 0; j < 2; ++j) acc[i][j] = (f32x4){0.f, 0.f, 0.f, 0.f};
    __syncthreads();
#define CSTAGE(buf, l) do { unsigned char* st_ = lds + (buf) * 24576; \
        _Pragma("unroll") for (int i = 0; i < 4; ++i) glds16(ap[i] + (size_t)(l) * LD, st_ + (4 * i + wid) * 1024); \
        _Pragma("unroll") for (int i = 0; i < 2; ++i) glds16(bp[i] + (l) * 64, st_ + 16384 + (wid + 4 * i) * 1024); } while (0)
    CSTAGE(0, 0); CSTAGE(1, 1);
    for (int l = 0; l < 32; ++l) {
        const unsigned char* st = lds + (l % 3) * 24576;
        if (l + 1 < 32) WAIT_V(6); else WAIT_V(0);
        RAW_BARRIER();
        if (l + 2 < 32) CSTAGE((l + 2) % 3, l + 2);
#pragma unroll
        for (int ks = 0; ks < 2; ++ks) {
            bf16x8 a[4], bb[2];
#pragma unroll
            for (int i = 0; i < 4; ++i) a[i] = lds_frag128(st, 64 * wr + 16 * i + fr, 4 * ks + fq);
#pragma unroll
            for (int j = 0; j < 2; ++j) bb[j] = lds_frag128(st + 16384, 32 * wc + 16 * j + fr, 4 * ks + fq);
#pragma unroll
            for (int i = 0; i < 4; ++i)
#pragma unroll
                for (int j = 0; j < 2; ++j) acc[i][j] = mfma16(a[i], bb[j], acc[i][j]);
        }
    }
    __syncthreads();
#undef CSTAGE
    float* hid = (float*)lds;
    const float* b1 = (const float*)(ws + WS_B1) + kv * 64;
#pragma unroll
    for (int j = 0; j < 2; ++j) {
        const int n = 32 * wc + 16 * j + fr; const float bias = b1[n + vzero()];
#pragma unroll
        for (int i = 0; i < 4; ++i)
#pragma unroll
            for (int r = 0; r < 4; ++r) hid[(64 * wr + 16 * i + 4 * fq + r) * 65 + n] = gelu_tanh(acc[i][j][r] + bias);
    }
    __syncthreads();
    {
        const int row = tid >> 1, nb = (tid & 1) * 32, ci = i0 + row;
        const float* w2 = p.cmp_w2 + ((size_t)layer * 2 + kv) * 64 * 64;
        float o[32];
#pragma unroll
        for (int q = 0; q < 32; ++q) o[q] = 0.f;
        for (int n = 0; n < 64; ++n) {
            const float h = hid[row * 65 + n];
#pragma unroll
            for (int q4 = 0; q4 < 8; ++q4) { const float4 w = *(const float4*)(w2 + n * 64 + nb + 4 * q4); o[4 * q4] += h * w.x; o[4 * q4 + 1] += h * w.y; o[4 * q4 + 2] += h * w.z; o[4 * q4 + 3] += h * w.w; }
        }
        if (kv == 0) {
            bf16_t* dst = (bf16_t*)(ws + WS_KCC) + ((size_t)(b * 2 + g) * 512 + ci) * 64 + nb;
#pragma unroll
            for (int q = 0; q < 32; q += 4) { f32x4 v = {o[q], o[q + 1], o[q + 2], o[q + 3]}; if (ci >= 511) v = (f32x4){0.f, 0.f, 0.f, 0.f}; *(u32x2*)(dst + q) = pack4(v); }
        } else {
            bf16_t* dst = (bf16_t*)(ws + WS_VCCT) + ((size_t)(b * 2 + g) * 64 + nb) * 512 + ci;
#pragma unroll
            for (int q = 0; q < 32; ++q) dst[(size_t)q * 512] = f2bf(ci >= 511 ? 0.f : o[q]);
        }
    }
    __syncthreads();
}

__device__ __forceinline__ float ret_lg2(int h) { const float gam = 1.f - exp2f(-5.f - (float)h); return log2f(gam); }

__device__ __forceinline__ void retkv_item(const Params& p, int item, unsigned char* lds, int half) {
    unsigned char* ws = launder(p.ws);
    const int tid = (ltid() & 255), lane = tid & 63, wid = tid >> 6, fr = lane & 15, fq = lane >> 4;
    const int n = item & 63, h = (item >> 6) & 7, b = item >> 9;
    const size_t tok0 = (size_t)b * S_ + 128 * n;
    unsigned char* vL = lds; unsigned char* kL = lds + 32768;
    load_tile128w((const bf16_t*)(ws + WS_VRT) + ((size_t)(b * 8 + h) * 128) * S_ + 128 * n, S_, vL, wid, lane);
    load_tile128((const bf16_t*)(ws + WS_P) + tok0 * LD + C_KR + h * 64, LD, kL, wid, lane);
    wait_vm0(); __syncthreads();
    const float lg2 = ret_lg2(h);
    f32x4 acc[2][4];
#pragma unroll
    for (int m = 0; m < 2; ++m)
#pragma unroll
        for (int nt = 0; nt < 4; ++nt) acc[m][nt] = (f32x4){0.f, 0.f, 0.f, 0.f};
#pragma unroll
    for (int ks = 0; ks < 4; ++ks) {
        bf16x8 a[2], bb[4];
#pragma unroll
        for (int m = 0; m < 2; ++m) a[m] = lds_frag256(vL, 32 * wid + 16 * m + fr, 4 * ks + fq);
        float dec[8];
#pragma unroll
        for (int j = 0; j < 8; ++j) dec[j] = exp2f((float)(127 - (32 * ks + 8 * fq + j)) * lg2);
#pragma unroll
        for (int nt = 0; nt < 4; ++nt) {
            const int d = 16 * nt + fr;
            float v[8];
#pragma unroll
            for (int j = 0; j < 8; ++j) {
                const int tk = 32 * ks + 8 * fq + j;
                const bf16_t kvv = *(const bf16_t*)(kL + tk * 128 + (((d >> 3) ^ (tk & 7)) << 4) + (d & 7) * 2);
                v[j] = bf2f(kvv) * dec[j];
            }
            u32x4 w; w.x = pack2(v[0], v[1]); w.y = pack2(v[2], v[3]); w.z = pack2(v[4], v[5]); w.w = pack2(v[6], v[7]);
            bb[nt] = __builtin_bit_cast(bf16x8, w);
        }
#pragma unroll
        for (int m = 0; m < 2; ++m)
#pragma unroll
            for (int nt = 0; nt < 4; ++nt) acc[m][nt] = mfma16(a[m], bb[nt], acc[m][nt]);
    }
    float* KVT = (float*)(ws + WS_KVT) + ((size_t)(b * 8 + h) * 64 + n) * 8192;
#pragma unroll
    for (int m = 0; m < 2; ++m)
#pragma unroll
        for (int nt = 0; nt < 4; ++nt)
#pragma unroll
            for (int r = 0; r < 4; ++r) KVT[(32 * wid + 16 * m + 4 * fq + r) * 64 + 16 * nt + fr] = acc[m][nt][r];
    __syncthreads();
}

__device__ __forceinline__ void phase_p2(const Params& p, int layer, unsigned char* lds, int half) {
    const int vb = blockIdx.x * 2 + half, nvb = gridDim.x * 2;
    if (vb < 32) compress_item(p, layer, vb, lds, half);
    else for (int it = vb - 32; it < 1024; it += nvb - 32) retkv_item(p, it, lds, half);
}

constexpr int NSA_IMP = 32768, NSA_BUCKET = 65792, NSA_BIAS = 73984;

struct NsaLane { int t; int fr, fq, wid, lane; };

constexpr float LOG2E = 1.4426950408889634f;
__device__ __forceinline__ int t5_first(int bk) {
    const int th[16] = {16, 22, 30, 40, 54, 73, 99, 134, 182, 246, 332, 450, 609, 825, 1117, 1513};
    int r = 16;
#pragma unroll
    for (int k = 0; k < 16; ++k) r = (bk == 16 + k) ? th[k] : r;
    return r;
}
template <int BR, int PASS>
__device__ __forceinline__ void nsa_half(const unsigned char* kL, const unsigned char* vL, const unsigned char* lds, const bf16x8 (&qptr)[4][2],
                                         f32x4 (&O)[4][4], float (&m)[4], float (&l)[4], int tile, int hf, const NsaLane& L, int qrow, const bool FAST, int th, int b0, int b1) {
    const int fr = L.lane & 15, fq = L.lane >> 4;
    constexpr float C2 = 0.125f * LOG2E;
    bf16x8 Kf[2][2];
#pragma unroll
    for (int i = 0; i < 2; ++i)
#pragma unroll
        for (int ks = 0; ks < 2; ++ks) Kf[i][ks] = lds_frag128(kL, 32 * hf + 16 * i + fr, 4 * ks + fq);
    bf16x8 Vf[4];
    if (PASS != 0) {
#pragma unroll
        for (int mt = 0; mt < 4; ++mt) Vf[mt] = lds_vfrag128(vL, 16 * mt + fr, 32 * hf, fq);
    }
    unsigned vmask = 0; unsigned bk[2] = {0u, 0u}; bool hi[2][4];
    if (!FAST) {
        const unsigned char* bucketL = lds + NSA_BUCKET;
#pragma unroll
        for (int i = 0; i < 2; ++i) {
            unsigned pk = 0;
#pragma unroll
            for (int r = 0; r < 4; ++r) {
                const int kk = 32 * hf + 16 * i + 4 * fq + r;
                int rel; bool ok;
                if (BR == 0) { rel = L.t - (16 * (64 * tile + kk) + 31); ok = rel >= 0; }
                else { rel = L.t - (64 * tile + kk); ok = rel >= 0 && rel < 512; }
                int rc = rel < 0 ? 0 : rel; rc = rc > 8191 ? 8191 : rc;
                pk |= (unsigned)bucketL[rc] << (8 * r);
                vmask |= (ok ? 1u : 0u) << (4 * i + r);
                hi[i][r] = false;
            }
            bk[i] = pk;
        }
    } else {
        const int kbase = 64 * tile + 32 * hf + 4 * fq;
        const int lim = BR == 0 ? L.t - th - 31 - 16 * kbase : L.t - th - kbase;
#pragma unroll
        for (int i = 0; i < 2; ++i)
#pragma unroll
            for (int r = 0; r < 4; ++r) hi[i][r] = (BR == 0 ? 16 : 1) * (16 * i + r) <= lim;
    }
    const float* biasL = (const float*)(lds + NSA_BIAS);
    float ia[2] = {0.f, 0.f}, ic[2] = {0.f, 0.f};
#pragma unroll
    for (int nt = 0; nt < 4; ++nt) {
        f32x4 S[2];
        const bf16x8 q0 = qptr[nt][0], q1 = qptr[nt][1];
#pragma unroll
        for (int i = 0; i < 2; ++i) {
            S[i] = (f32x4){0.f, 0.f, 0.f, 0.f};
            S[i] = mfma16(Kf[i][0], q0, S[i]); S[i] = mfma16(Kf[i][1], q1, S[i]);
        }
        float tmax = -1e30f;
        if (!FAST) {
#pragma unroll
            for (int i = 0; i < 2; ++i) {
                float bsv[4];
#pragma unroll
                for (int r = 0; r < 4; ++r) bsv[r] = biasL[nt * 32 + ((bk[i] >> (8 * r)) & 0xffu)];
                asm volatile("" : "+v"(bsv[0]), "+v"(bsv[1]), "+v"(bsv[2]), "+v"(bsv[3]));
#pragma unroll
                for (int r = 0; r < 4; ++r) {
                    const bool ok = (vmask >> (4 * i + r)) & 1u;
                    const float sv = S[i][r] * C2 + bsv[r];
                    S[i][r] = ok ? sv : -1e30f; tmax = fmaxf(tmax, S[i][r]);
                }
            }
        } else {
            const float blo = biasL[nt * 32 + b0], bhi = biasL[nt * 32 + b1];
#pragma unroll
            for (int i = 0; i < 2; ++i)
#pragma unroll
                for (int r = 0; r < 4; ++r) { S[i][r] = S[i][r] * C2 + (hi[i][r] ? bhi : blo); tmax = fmaxf(tmax, S[i][r]); }
        }
        if (PASS != 1) {
            if (__builtin_amdgcn_ballot_w64(tmax > m[nt] + 8.f) != 0ull) {
                const float tm = rows_max(tmax);
                const float mnew = tm > m[nt] + 8.f ? tm : m[nt], alpha = __builtin_amdgcn_exp2f(m[nt] - mnew);
                l[nt] *= alpha; m[nt] = mnew;
                if (PASS == 2) {
#pragma unroll
                    for (int mt = 0; mt < 4; ++mt) O[mt][nt] = O[mt][nt] * alpha;
                }
            }
            float psum = 0.f;
#pragma unroll
            for (int i = 0; i < 2; ++i)
#pragma unroll
                for (int r = 0; r < 4; ++r) S[i][r] = __builtin_amdgcn_exp2f(S[i][r] - m[nt]);
            if (!FAST) {
#pragma unroll
                for (int i = 0; i < 2; ++i)
#pragma unroll
                    for (int r = 0; r < 4; ++r) { const bool ok = (vmask >> (4 * i + r)) & 1u; S[i][r] = ok ? S[i][r] : 0.f; }
            }
#pragma unroll
            for (int i = 0; i < 2; ++i)
#pragma unroll
                for (int r = 0; r < 4; ++r) psum += S[i][r];
            l[nt] += psum;
        } else {
#pragma unroll
            for (int i = 0; i < 2; ++i) {
#pragma unroll
                for (int r = 0; r < 4; ++r) S[i][r] = __builtin_amdgcn_exp2f(S[i][r] - m[nt]) * l[nt];
            }
            if (!FAST) {
#pragma unroll
                for (int i = 0; i < 2; ++i)
#pragma unroll
                    for (int r = 0; r < 4; ++r) { const bool ok = (vmask >> (4 * i + r)) & 1u; S[i][r] = ok ? S[i][r] : 0.f; }
            }
#pragma unroll
            for (int i = 0; i < 2; ++i) {
                ia[i] += S[i][0] + S[i][1] + S[i][2] + 0.5f * S[i][3];
                ic[i] += 0.5f * S[i][3];
            }
        }
        if (PASS != 0) {
            const bf16x8 Pb = pack8(S[0], S[1]);
#pragma unroll
            for (int mt = 0; mt < 4; ++mt) O[mt][nt] = mfma16(Vf[mt], Pb, O[mt][nt]);
        }
        if (nt & 1) __builtin_amdgcn_sched_barrier(0);
    }
    if (PASS == 1) {
        float* imp = (float*)(lds + NSA_IMP) + qrow * 129;
        asm volatile("" ::: "memory"); __builtin_amdgcn_wave_barrier();
#pragma unroll
        for (int i = 0; i < 2; ++i) { const int j = 16 * tile + 8 * hf + 4 * i + fq; imp[j] += ia[i]; }
        asm volatile("s_waitcnt lgkmcnt(0)" ::: "memory"); __builtin_amdgcn_wave_barrier();
#pragma unroll
        for (int i = 0; i < 2; ++i) { const int j = 16 * tile + 8 * hf + 4 * i + fq + 1; if (j < 128) imp[j] += ic[i]; }
        asm volatile("s_waitcnt lgkmcnt(0)" ::: "memory"); __builtin_amdgcn_wave_barrier();
    }
}
template <int BR, int PASS>
__device__ __forceinline__ void nsa_tile(const unsigned char* kL, const unsigned char* vL, const unsigned char* lds, const bf16x8 (&qptr)[4][2],
                                         f32x4 (&O)[4][4], float (&m)[4], float (&l)[4], int tile, const NsaLane& L, int qrow) {
    const int tq0 = __builtin_amdgcn_readfirstlane(L.t - (L.lane & 15));
#pragma unroll 1
    for (int hf = 0; hf < 2; ++hf) {
        const int kfirst = 64 * tile + 32 * hf, pmin = BR == 0 ? 16 * kfirst + 31 : kfirst, pmax = BR == 0 ? 16 * (kfirst + 31) + 31 : kfirst + 31;
        const int rmin = tq0 - pmax, rmax = tq0 + 15 - pmin;
        bool fast = false; int th = 0, b0 = 0, b1 = 0;
        if (rmin >= 16 && (BR != 2 || rmax < 512)) {
            const unsigned char* bucketL = lds + NSA_BUCKET;
            b0 = __builtin_amdgcn_readfirstlane((int)bucketL[rmin]); b1 = __builtin_amdgcn_readfirstlane((int)bucketL[rmax > 8191 ? 8191 : rmax]);
            if (b1 - b0 <= 1) { fast = true; th = b1 == b0 ? 0 : t5_first(b1); }
        }
        nsa_half<BR, PASS>(kL, vL, lds, qptr, O, m, l, tile, hf, L, qrow, fast, th, b0, b1);
    }
}

__device__ __forceinline__ void cmp_item(const Params& p, int item, unsigned char* lds, int half) {
    unsigned char* ws = launder(p.ws);
    const int tid = (ltid() & 255), lane = tid & 63, wid = tid >> 6, fr = lane & 15, fq = lane >> 4;
    const int combo = item & 3, qt = 127 - (item >> 2), b = combo >> 1, g = combo & 1;
    const int q0 = qt * 64, qrow = 16 * wid + fr;
    NsaLane L; L.t = q0 + qrow; L.fr = fr; L.fq = fq; L.wid = wid; L.lane = lane;
    const size_t tok = (size_t)b * S_ + L.t;
    const bf16_t* P = (const bf16_t*)(ws + WS_P);
    __syncthreads();
    if (tid < 128) ((float*)(lds + NSA_BIAS))[tid] = p.rel_bias[(tid & 31) * 8 + 4 * g + (tid >> 5)] * LOG2E;
    for (int i = tid; i < 64 * 129; i += HT) ((float*)(lds + NSA_IMP))[i] = 0.f;
    bf16x8 Qf[4][2];
#pragma unroll
    for (int nt = 0; nt < 4; ++nt)
#pragma unroll
        for (int ks = 0; ks < 2; ++ks) Qf[nt][ks] = *(const bf16x8*)(P + tok * LD + C_QA + (4 * g + nt) * 64 + 32 * ks + 8 * fq);
    __syncthreads();
    f32x4 O[4][4]; float m[4], l[4];
    const bf16_t* gates = P + tok * LD + C_GA + (4 * g) * 3;
    const bf16_t* kc = (const bf16_t*)(ws + WS_KCC) + (size_t)(b * 2 + g) * 512 * 64;
    const bf16_t* vc = (const bf16_t*)(ws + WS_VCCT) + (size_t)(b * 2 + g) * 64 * 512;
    const int ntc = ((q0 + 32) >> 4) / 64 + 1;
#pragma unroll
    for (int nt = 0; nt < 4; ++nt) { m[nt] = -1e30f; l[nt] = 0.f; }
    load_tile64(kc, 64, lds, wid, lane);
    wait_vm0(); __syncthreads();
    for (int it = 0; it < ntc; ++it) {
        unsigned char* cur = lds + (it & 1) * 16384;
        if (it + 1 < ntc) load_tile64(kc + (size_t)(it + 1) * 64 * 64, 64, lds + ((it + 1) & 1) * 16384, wid, lane);
        nsa_tile<0, 0>(cur, cur + 8192, lds, Qf, O, m, l, it, L, qrow);
        wait_vm0(); __syncthreads();
    }
#pragma unroll
    for (int nt = 0; nt < 4; ++nt) { l[nt] = rows_sum(l[nt]); l[nt] = l[nt] > 0.f ? 1.f / l[nt] : 0.f; }
#pragma unroll
    for (int mt = 0; mt < 4; ++mt)
#pragma unroll
        for (int nt = 0; nt < 4; ++nt) O[mt][nt] = (f32x4){0.f, 0.f, 0.f, 0.f};
    load_tile64(kc, 64, lds, wid, lane); load_tile64(vc, 512, lds + 8192, wid, lane);
    wait_vm0(); __syncthreads();
    for (int it = 0; it < ntc; ++it) {
        unsigned char* cur = lds + (it & 1) * 16384;
        if (it + 1 < ntc) { unsigned char* nx = lds + ((it + 1) & 1) * 16384;
            load_tile64(kc + (size_t)(it + 1) * 64 * 64, 64, nx, wid, lane); load_tile64(vc + (it + 1) * 64, 512, nx + 8192, wid, lane); }
        nsa_tile<0, 1>(cur, cur + 8192, lds, Qf, O, m, l, it, L, qrow);
        wait_vm0(); __syncthreads();
    }
    bf16_t* YC = (bf16_t*)(ws + WS_YC) + tok * 512 + (4 * g) * 64;
#pragma unroll
    for (int nt = 0; nt < 4; ++nt) {
        const float gt = bf2f(gates[nt * 3 + 0]);
#pragma unroll
        for (int mt = 0; mt < 4; ++mt) *(u32x2*)(YC + nt * 64 + 16 * mt + 4 * fq) = pack4(O[mt][nt] * gt);
    }
    const int cur = qt;
    {
        float* imp = (float*)(lds + NSA_IMP) + qrow * 129 + 32 * fq;
        asm volatile("s_waitcnt lgkmcnt(0)" ::: "memory"); __builtin_amdgcn_wave_barrier();
#pragma unroll
        for (int i = 0; i < 32; ++i) {
            const int j = 32 * fq + i;
            const float v = imp[i];
            imp[i] = j > cur ? -1.f : v + ((j == 0 || j == cur || j == cur - 1) ? 1.0e4f : 0.f);
        }
        unsigned word = 0;
#pragma unroll 1
        for (int round = 0; round < 16; ++round) {
            float bv = imp[0]; int bi = 0;
#pragma unroll
            for (int i = 1; i < 32; ++i) { const float v = imp[i]; if (v > bv) { bv = v; bi = i; } }
            int gi = 32 * fq + bi;
            {
                u32x2 rv = __builtin_amdgcn_permlane16_swap(__float_as_uint(bv), __float_as_uint(bv), false, false);
                u32x2 ri = __builtin_amdgcn_permlane16_swap((unsigned)gi, (unsigned)gi, false, false);
                float v0 = __uint_as_float(rv.x), v1 = __uint_as_float(rv.y); int i0 = (int)ri.x, i1 = (int)ri.y;
                if (v1 > v0 || (v1 == v0 && i1 < i0)) { v0 = v1; i0 = i1; }
                rv = __builtin_amdgcn_permlane32_swap(__float_as_uint(v0), __float_as_uint(v0), false, false);
                ri = __builtin_amdgcn_permlane32_swap((unsigned)i0, (unsigned)i0, false, false);
                v0 = __uint_as_float(rv.x); v1 = __uint_as_float(rv.y); i0 = (int)ri.x; i1 = (int)ri.y;
                if (v1 > v0 || (v1 == v0 && i1 < i0)) { v0 = v1; i0 = i1; }
                bv = v0; gi = i0;
            }
            if (bv >= 0.f && (gi >> 5) == fq) { word |= 1u << (gi & 31); imp[gi & 31] = -2.f; }
        }
        ((unsigned*)(ws + WS_SELW))[(tok * 2 + g) * 4 + fq] = word;
    }
}

__device__ __forceinline__ void win_item(const Params& p, int item, unsigned char* lds, int half) {
    unsigned char* ws = launder(p.ws);
    const int tid = (ltid() & 255), lane = tid & 63, wid = tid >> 6, fr = lane & 15, fq = lane >> 4;
    const int combo = item & 3, qt = 127 - (item >> 2), b = combo >> 1, g = combo & 1;
    const int q0 = qt * 64, qrow = 16 * wid + fr;
    NsaLane L; L.t = q0 + qrow; L.fr = fr; L.fq = fq; L.wid = wid; L.lane = lane;
    const size_t tok = (size_t)b * S_ + L.t;
    const bf16_t* P = (const bf16_t*)(ws + WS_P);
    __syncthreads();
    if (tid < 128) ((float*)(lds + NSA_BIAS))[tid] = p.rel_bias[(tid & 31) * 8 + 4 * g + (tid >> 5)] * LOG2E;
    bf16x8 Qf[4][2];
#pragma unroll
    for (int nt = 0; nt < 4; ++nt)
#pragma unroll
        for (int ks = 0; ks < 2; ++ks) Qf[nt][ks] = *(const bf16x8*)(P + tok * LD + C_QA + (4 * g + nt) * 64 + 32 * ks + 8 * fq);
    __syncthreads();
    f32x4 O[4][4]; float m[4], l[4];
    const bf16_t* gates = P + tok * LD + C_GA + (4 * g) * 3;
#pragma unroll
    for (int nt = 0; nt < 4; ++nt) { m[nt] = -1e30f; l[nt] = 0.f; }
#pragma unroll
    for (int mt = 0; mt < 4; ++mt)
#pragma unroll
        for (int nt = 0; nt < 4; ++nt) O[mt][nt] = (f32x4){0.f, 0.f, 0.f, 0.f};
    {
        const bf16_t* kb = P + ((size_t)b * S_) * LD + C_KW + g * 64;
        const bf16_t* vb = (const bf16_t*)(ws + WS_VWT) + (size_t)(b * 2 + g) * 64 * S_;
        const int k_lo = qt - 8 > 0 ? qt - 8 : 0, ntw = qt - k_lo + 1;
        load_tile64(kb + (size_t)k_lo * 64 * LD, LD, lds, wid, lane); load_tile64(vb + k_lo * 64, S_, lds + 8192, wid, lane);
        wait_vm0(); __syncthreads();
        for (int it = 0; it < ntw; ++it) {
            unsigned char* cu = lds + (it & 1) * 16384;
            if (it + 1 < ntw) { unsigned char* nx = lds + ((it + 1) & 1) * 16384;
                load_tile64(kb + (size_t)(k_lo + it + 1) * 64 * LD, LD, nx, wid, lane); load_tile64(vb + (k_lo + it + 1) * 64, S_, nx + 8192, wid, lane); }
            nsa_tile<2, 2>(cu, cu + 8192, lds, Qf, O, m, l, k_lo + it, L, qrow);
            wait_vm0(); __syncthreads();
        }
    }
    bf16_t* YW = (bf16_t*)(ws + WS_YW) + tok * 512 + (4 * g) * 64;
#pragma unroll
    for (int nt = 0; nt < 4; ++nt) {
        const float lt = rows_sum(l[nt]), gt = bf2f(gates[nt * 3 + 2]) * (lt > 0.f ? 1.f / lt : 0.f);
#pragma unroll
        for (int mt = 0; mt < 4; ++mt) *(u32x2*)(YW + nt * 64 + 16 * mt + 4 * fq) = pack4(O[mt][nt] * gt);
    }
}

constexpr int SEL_RING = 8, SEL_BUCKET = SEL_RING * 16384, SEL_BIAS2 = SEL_BUCKET + 8192;
template <bool FAST>
__device__ __forceinline__ void sel_ntile(const bf16x8 (&Kf)[4][2], const unsigned char* vL, int fr, int fq, const bf16x8& q0, const bf16x8& q1, f32x4 (&O)[4], float& m, float& l,
                                          bool sb, int relb, int th, float blo, float bhi, const unsigned char* lds, int hl) {
    f32x4 S[4];
#pragma unroll
    for (int i = 0; i < 4; ++i) { S[i] = (f32x4){0.f, 0.f, 0.f, 0.f}; S[i] = mfma16(Kf[i][0], q0, S[i]); S[i] = mfma16(Kf[i][1], q1, S[i]); }
    float tmax = -1e30f;
    const float scl = (!FAST || sb) ? 0.125f * LOG2E : 0.f;
    if (FAST) { blo = (sb ? blo : -1e30f) - m; bhi = (sb ? bhi : -1e30f) - m; }
    if (FAST) {
#pragma unroll
        for (int i = 0; i < 4; ++i)
#pragma unroll
            for (int r = 0; r < 4; ++r) { const int rel = relb - (16 * i + r); S[i][r] = S[i][r] * scl + (rel >= th ? bhi : blo); tmax = fmaxf(tmax, S[i][r]); }
    } else {
        unsigned bkt[4][4]; float bs[4][4];
#pragma unroll
        for (int i = 0; i < 4; ++i)
#pragma unroll
            for (int r = 0; r < 4; ++r) { const int rel = relb - (16 * i + r); int rc = rel < 0 ? 0 : rel; rc = rc > 8191 ? 8191 : rc; bkt[i][r] = (lds + SEL_BUCKET)[rc]; }
#pragma unroll
        for (int i = 0; i < 4; ++i)
#pragma unroll
            for (int r = 0; r < 4; ++r) bs[i][r] = ((const float*)(lds + SEL_BIAS2))[hl * 32 + bkt[i][r]];
        asm volatile("" : "+v"(bs[0][0]), "+v"(bs[0][1]), "+v"(bs[0][2]), "+v"(bs[0][3]), "+v"(bs[1][0]), "+v"(bs[1][1]), "+v"(bs[1][2]), "+v"(bs[1][3]),
                          "+v"(bs[2][0]), "+v"(bs[2][1]), "+v"(bs[2][2]), "+v"(bs[2][3]), "+v"(bs[3][0]), "+v"(bs[3][1]), "+v"(bs[3][2]), "+v"(bs[3][3]));
        const float ninf = -1e30f;
#pragma unroll
        for (int i = 0; i < 4; ++i)
#pragma unroll
            for (int r = 0; r < 4; ++r) {
                const int rel = relb - (16 * i + r);
                const float sv = S[i][r] * (0.125f * LOG2E) + (bs[i][r] - m);
                S[i][r] = (sb && rel >= 0) ? sv : ninf; tmax = fmaxf(tmax, S[i][r]);
            }
    }
    tmax = rows_max(tmax);
    if (__ballot(tmax > 8.f) != 0ull) {
        const float d = fmaxf(tmax, 0.f), alpha = __builtin_amdgcn_exp2f(-d);
        m += d; l *= alpha;
#pragma unroll
        for (int mt = 0; mt < 4; ++mt) O[mt] = O[mt] * alpha;
#pragma unroll
        for (int i = 0; i < 4; ++i)
#pragma unroll
            for (int r = 0; r < 4; ++r) S[i][r] -= d;
    }
    float psum = 0.f;
#pragma unroll
    for (int i = 0; i < 4; ++i)
#pragma unroll
        for (int r = 0; r < 4; ++r) { const float pv = __builtin_amdgcn_exp2f(S[i][r]); S[i][r] = pv; psum += pv; }
    l += rows_sum(psum);
    const bf16x8 Pb0 = pack8(S[0], S[1]), Pb1 = pack8(S[2], S[3]);
#pragma unroll
    for (int mt = 0; mt < 4; ++mt) { O[mt] = mfma16(lds_vfrag128(vL, 16 * mt + fr, 0, fq), Pb0, O[mt]); O[mt] = mfma16(lds_vfrag128(vL, 16 * mt + fr, 32, fq), Pb1, O[mt]); }
}
__device__ __forceinline__ void sel_ntile2_fast(const bf16x8 (&Kf)[4][2], const unsigned char* vL, int fr, int fq, const bf16x8 (&Qf)[2][2], f32x4 (&O)[2][4], float (&m)[2], float (&l)[2],
                                                const bool (&sb)[2], const int (&relb)[2], int th, float blo, float bhi) {
    f32x4 S[2][4]; float tmax[2], bl[2], bh[2], scl[2];
#pragma unroll
    for (int b = 0; b < 2; ++b)
#pragma unroll
        for (int i = 0; i < 4; ++i) { S[b][i] = (f32x4){0.f, 0.f, 0.f, 0.f}; S[b][i] = mfma16(Kf[i][0], Qf[b][0], S[b][i]); S[b][i] = mfma16(Kf[i][1], Qf[b][1], S[b][i]); }
#pragma unroll
    for (int b = 0; b < 2; ++b) { scl[b] = sb[b] ? 0.125f * LOG2E : 0.f; bl[b] = (sb[b] ? blo : -1e30f) - m[b]; bh[b] = (sb[b] ? bhi : -1e30f) - m[b]; tmax[b] = -1e30f; }
#pragma unroll
    for (int b = 0; b < 2; ++b)
#pragma unroll
        for (int i = 0; i < 4; ++i)
#pragma unroll
            for (int r = 0; r < 4; ++r) { const int rel = relb[b] - (16 * i + r); S[b][i][r] = S[b][i][r] * scl[b] + (rel >= th ? bh[b] : bl[b]); tmax[b] = fmaxf(tmax[b], S[b][i][r]); }
#pragma unroll
    for (int b = 0; b < 2; ++b) tmax[b] = rows_max(tmax[b]);
    if (__ballot(tmax[0] > 8.f || tmax[1] > 8.f) != 0ull) {
#pragma unroll
        for (int b = 0; b < 2; ++b) {
            const float d = fmaxf(tmax[b], 0.f), alpha = __builtin_amdgcn_exp2f(-d);
            m[b] += d; l[b] *= alpha;
#pragma unroll
            for (int mt = 0; mt < 4; ++mt) O[b][mt] = O[b][mt] * alpha;
#pragma unroll
            for (int i = 0; i < 4; ++i)
#pragma unroll
                for (int r = 0; r < 4; ++r) S[b][i][r] -= d;
        }
    }
    float psum[2] = {0.f, 0.f};
#pragma unroll
    for (int b = 0; b < 2; ++b)
#pragma unroll
        for (int i = 0; i < 4; ++i)
#pragma unroll
            for (int r = 0; r < 4; ++r) { const float pv = __builtin_amdgcn_exp2f(S[b][i][r]); S[b][i][r] = pv; psum[b] += pv; }
#pragma unroll
    for (int b = 0; b < 2; ++b) l[b] += rows_sum(psum[b]);
    bf16x8 P0[2], P1[2];
#pragma unroll
    for (int b = 0; b < 2; ++b) { P0[b] = pack8(S[b][0], S[b][1]); P1[b] = pack8(S[b][2], S[b][3]); }
#pragma unroll
    for (int mt = 0; mt < 4; ++mt) {
        const bf16x8 v0 = lds_vfrag128(vL, 16 * mt + fr, 0, fq), v1 = lds_vfrag128(vL, 16 * mt + fr, 32, fq);
#pragma unroll
        for (int b = 0; b < 2; ++b) { O[b][mt] = mfma16(v0, P0[b], O[b][mt]); O[b][mt] = mfma16(v1, P1[b], O[b][mt]); }
    }
}
template <bool FAST>
__device__ __forceinline__ void sel_tile(const unsigned char* kL, const unsigned char* vL, const unsigned char* lds, const bf16x8 (&Qf)[2][2], f32x4 (&O)[2][4], float (&m)[2], float (&l)[2],
                                         const bool (&sb)[2], const bool (&need)[2], const int (&relb)[2], int th, float blo, float bhi, int hl, int fr, int fq) {
    bf16x8 Kf[4][2];
#pragma unroll
    for (int i = 0; i < 4; ++i)
#pragma unroll
        for (int ks = 0; ks < 2; ++ks) Kf[i][ks] = lds_frag128(kL, 16 * i + fr, 4 * ks + fq);
    if (FAST && need[0] && need[1]) { sel_ntile2_fast(Kf, vL, fr, fq, Qf, O, m, l, sb, relb, th, blo, bhi); return; }
    if (need[0]) sel_ntile<FAST>(Kf, vL, fr, fq, Qf[0][0], Qf[0][1], O[0], m[0], l[0], sb[0], relb[0], th, blo, bhi, lds, hl);
    if (need[1]) sel_ntile<FAST>(Kf, vL, fr, fq, Qf[1][0], Qf[1][1], O[1], m[1], l[1], sb[1], relb[1], th, blo, bhi, lds, hl);
}
template <int VAR>
__device__ __forceinline__ void sel_item(const Params& p, int v, unsigned char* lds) {
    unsigned char* ws = launder(p.ws);
    const int tid = ltid(), lane = tid & 63, wid = tid >> 6, fr = lane & 15, fq = lane >> 4;
    const int qt = 127 - (v >> 2), sub = v & 3, b = sub >> 1, g = sub & 1;
    const int q0 = qt * 64, cur = qt, hl = fr & 3;
    const bf16_t* P = (const bf16_t*)(ws + WS_P);
    __syncthreads();
    if (tid < 128) ((float*)(lds + SEL_BIAS2))[tid] = p.rel_bias[(tid & 31) * 8 + 4 * g + (tid >> 5)] * LOG2E;
    int t[2]; size_t tok[2]; bf16x8 Qf[2][2]; unsigned selw[2][4];
#pragma unroll
    for (int nt = 0; nt < 2; ++nt) {
        t[nt] = q0 + 8 * wid + 4 * nt + (fr >> 2); tok[nt] = (size_t)b * S_ + t[nt];
#pragma unroll
        for (int ks = 0; ks < 2; ++ks) Qf[nt][ks] = *(const bf16x8*)(P + tok[nt] * LD + C_QA + (4 * g + hl) * 64 + 32 * ks + 8 * fq);
        const u32x4 w = *(const u32x4*)((const unsigned*)(ws + WS_SELW) + (tok[nt] * 2 + g) * 4);
        selw[nt][0] = w.x; selw[nt][1] = w.y; selw[nt][2] = w.z; selw[nt][3] = w.w;
    }
    f32x4 O[2][4]; float m[2], l[2];
#pragma unroll
    for (int nt = 0; nt < 2; ++nt) { m[nt] = -1000.f; l[nt] = 0.f;
#pragma unroll
        for (int mt = 0; mt < 4; ++mt) O[nt][mt] = (f32x4){0.f, 0.f, 0.f, 0.f}; }
    const bf16_t* kb = P + ((size_t)b * S_) * LD + C_KS + g * 64;
    const bf16_t* vb = (const bf16_t*)(ws + WS_VST) + (size_t)(b * 2 + g) * 64 * S_;
    const int nts = cur + 1;
#define SEL_ISSUE(jj) do { unsigned char* st_ = lds + ((jj) & 7) * 16384; const int c_ = ((lane & 7) ^ (lane >> 3)) * 8, r_ = 8 * wid + (lane >> 3); \
        glds16(kb + ((size_t)(jj) * 64 + r_) * LD + c_, st_ + wid * 1024); glds16(vb + (size_t)r_ * S_ + (jj) * 64 + c_, st_ + 8192 + wid * 1024); } while (0)
    asm volatile("s_waitcnt vmcnt(0)" ::: "memory");
#pragma unroll
    for (int q = 0; q < 4; ++q) if (q < nts) SEL_ISSUE(q);
    const unsigned char* bucketL = lds + SEL_BUCKET;
    for (int jp = 0; jp < nts; jp += 4) {
        WAIT_V(0);
        RAW_BARRIER();
#pragma unroll
        for (int q = 4; q < 8; ++q) if (jp + q < nts) SEL_ISSUE(jp + q);
#pragma unroll 1
      for (int j = jp; j < jp + 4 && j < nts; ++j) {
        const unsigned char* cu = lds + (j & 7) * 16384;
        bool sb[2], need[2]; int relb[2];
#pragma unroll
        for (int nt = 0; nt < 2; ++nt) {
            const unsigned w = j < 32 ? selw[nt][0] : j < 64 ? selw[nt][1] : j < 96 ? selw[nt][2] : selw[nt][3];
            sb[nt] = (w >> (j & 31)) & 1u; need[nt] = __ballot(sb[nt]) != 0ull; relb[nt] = t[nt] - 64 * j - 4 * fq;
        }
        if (VAR == 1) { need[0] = false; need[1] = false; }
        if (VAR == 2) { if (!(need[0] || need[1])) { need[0] = false; } else { need[0] = true; need[1] = true; } }
        if (need[0] || need[1]) {
            const int rmin = q0 - 64 * j - 63, rmax = q0 + 31 - 64 * j;
            bool fast = false; int th = 0; float blo = 0.f, bhi = 0.f;
            if (rmin >= 16) {
                const int b0 = bucketL[rmin], b1 = bucketL[rmax > 8191 ? 8191 : rmax];
                if (b1 - b0 <= 1) { fast = true; th = t5_first(b1); if (b1 == b0) th = 0;
                    blo = ((const float*)(lds + SEL_BIAS2))[hl * 32 + b0]; bhi = ((const float*)(lds + SEL_BIAS2))[hl * 32 + b1]; }
            }
            if (fast) sel_tile<true>(cu, cu + 8192, lds, Qf, O, m, l, sb, need, relb, th, blo, bhi, hl, fr, fq);
            else sel_tile<false>(cu, cu + 8192, lds, Qf, O, m, l, sb, need, relb, th, blo, bhi, hl, fr, fq);
        }
      }
    }
#undef SEL_ISSUE
    __syncthreads();
#pragma unroll
    for (int nt = 0; nt < 2; ++nt) {
        const float gt = bf2f(P[tok[nt] * LD + C_GA + (4 * g + hl) * 3 + 1]) * (l[nt] > 0.f ? 1.f / l[nt] : 0.f);
        const size_t o = tok[nt] * 512 + (4 * g + hl) * 64;
#pragma unroll
        for (int mt = 0; mt < 4; ++mt) {
            const f32x4 yc = unpack4(*(const u32x2*)((const bf16_t*)(ws + WS_YC) + o + 16 * mt + 4 * fq));
            const f32x4 yw = unpack4(*(const u32x2*)((const bf16_t*)(ws + WS_YW) + o + 16 * mt + 4 * fq));
            if (VAR == 0 || VAR == 3) *(u32x2*)((bf16_t*)(ws + WS_YA) + o + 16 * mt + 4 * fq) = pack4(yc + yw + O[nt][mt] * gt);
            else asm volatile("" :: "v"(O[nt][mt]));
        }
    }
}

__device__ __forceinline__ void scan_item(const Params& p, int item, int half) {
    unsigned char* ws = launder(p.ws);
    const int idx = item * HT + (ltid() & 255);
    const int bh = idx >> 13, ed = idx & 8191, h = bh & 7;
    const float dec = exp2f(128.f * ret_lg2(h));
    const float* KVT = (const float*)(ws + WS_KVT) + (size_t)bh * 64 * 8192 + ed;
    bf16_t* SPT = (bf16_t*)(ws + WS_SPT) + (size_t)bh * 64 * 8192 + ed;
    float s = 0.f;
    for (int n = 0; n < 64; ++n) { SPT[(size_t)n * 8192] = f2bf(s); s = s * dec + KVT[(size_t)n * 8192]; }
}

__device__ __forceinline__ void phase_p3(const Params& p, unsigned char* lds, int half, int what) {
    for (int i = (ltid() & 255); i < 8192 / 16; i += HT) ((u32x4*)(lds + NSA_BUCKET))[i] = ((const u32x4*)(launder(p.ws) + WS_BUCKET))[i];
    __syncthreads();
    for (int h = (blockIdx.x * 2 + half); h < 512; h += (gridDim.x * 2)) {
        if (what & 1) cmp_item(p, h, lds, half);
        if (what & 2) {
            if (h >= 128 && h < 384) win_item(p, h - 128, lds, half);
            else if (h >= 384) { win_item(p, 256 + 2 * (h - 384) - ((h & 1) ? 1 : 0) , lds, half); win_item(p, 256 + 2 * (h - 384) + ((h & 1) ? 0 : 1) + 1 - ((h & 1) ? 0 : 0), lds, half); }
        }
        if (what & 4) scan_item(p, h, half);
    }
}

__device__ __forceinline__ void retout_item(const Params& p, int item, unsigned char* lds, int half) {
    unsigned char* ws = launder(p.ws);
    const int tid = (ltid() & 255), lane = tid & 63, wid = tid >> 6, fr = lane & 15, fq = lane >> 4;
    const int n = item & 63, h = (item >> 6) & 7, b = item >> 9;
    const size_t tok0 = (size_t)b * S_ + 128 * n;
    const bf16_t* P = (const bf16_t*)(ws + WS_P);
    unsigned char* vL = lds; unsigned char* kL = lds + 32768; unsigned char* sL = lds + 49152;
    __syncthreads();
    load_tile128w((const bf16_t*)(ws + WS_VRT) + ((size_t)(b * 8 + h) * 128) * S_ + 128 * n, S_, vL, wid, lane);
    load_tile128(P + tok0 * LD + C_KR + h * 64, LD, kL, wid, lane);
    load_tile128((const bf16_t*)(ws + WS_SPT) + ((size_t)(b * 8 + h) * 64 + n) * 8192, 64, sL, wid, lane);
    bf16x8 Qf[2][2];
#pragma unroll
    for (int nt = 0; nt < 2; ++nt)
#pragma unroll
        for (int ks = 0; ks < 2; ++ks) Qf[nt][ks] = *(const bf16x8*)(P + (tok0 + 32 * wid + 16 * nt + fr) * LD + C_QR + h * 64 + 32 * ks + 8 * fq);
    wait_vm0(); __syncthreads();
    const float lg2 = ret_lg2(h);
    f32x4 Y[8][2];
#pragma unroll
    for (int m = 0; m < 8; ++m)
#pragma unroll
        for (int nt = 0; nt < 2; ++nt) Y[m][nt] = (f32x4){0.f, 0.f, 0.f, 0.f};
#pragma unroll
    for (int m = 0; m < 8; ++m)
#pragma unroll
        for (int ks = 0; ks < 2; ++ks) {
            const bf16x8 a = lds_frag128(sL, 16 * m + fr, 4 * ks + fq);
#pragma unroll
            for (int nt = 0; nt < 2; ++nt) Y[m][nt] = mfma16(a, Qf[nt][ks], Y[m][nt]);
        }
#pragma unroll
    for (int nt = 0; nt < 2; ++nt) {
        const float sc = exp2f((float)(32 * wid + 16 * nt + fr + 1) * lg2);
#pragma unroll
        for (int m = 0; m < 8; ++m) Y[m][nt] = Y[m][nt] * sc;
    }
#pragma unroll 1
    for (int s = 0; s < 4; ++s) {
        f32x4 St[2][2];
#pragma unroll
        for (int hh = 0; hh < 2; ++hh) {
            const int mt = 2 * s + hh;
#pragma unroll
            for (int nt = 0; nt < 2; ++nt) St[hh][nt] = (f32x4){0.f, 0.f, 0.f, 0.f};
#pragma unroll
            for (int ks = 0; ks < 2; ++ks) {
                const bf16x8 a = lds_frag128(kL, 16 * mt + fr, 4 * ks + fq);
#pragma unroll
                for (int nt = 0; nt < 2; ++nt) St[hh][nt] = mfma16(a, Qf[nt][ks], St[hh][nt]);
            }
#pragma unroll
            for (int nt = 0; nt < 2; ++nt) {
                const int qi = 32 * wid + 16 * nt + fr;
#pragma unroll
                for (int r = 0; r < 4; ++r) {
                    const int kj = 16 * mt + 4 * fq + r;
                    const float dm = qi >= kj ? exp2f((float)(qi - kj) * lg2) : 0.f;
                    St[hh][nt][r] *= dm;
                }
            }
        }
        bf16x8 Pb[2];
#pragma unroll
        for (int nt = 0; nt < 2; ++nt) Pb[nt] = pack8(St[0][nt], St[1][nt]);
#pragma unroll
        for (int m = 0; m < 8; ++m) {
            const bf16x8 a = lds_vfrag256(vL, 16 * m + fr, 32 * s, fq);
#pragma unroll
            for (int nt = 0; nt < 2; ++nt) Y[m][nt] = mfma16(a, Pb[nt], Y[m][nt]);
        }
    }
    bf16_t* YB = (bf16_t*)(ws + WS_YB);
#pragma unroll
    for (int nt = 0; nt < 2; ++nt) {
        float sum = 0.f;
#pragma unroll
        for (int m = 0; m < 8; ++m) sum += Y[m][nt][0] + Y[m][nt][1] + Y[m][nt][2] + Y[m][nt][3];
        sum = rows_sum(sum);
        const float mu = sum * (1.f / 128.f);
        float vs = 0.f;
#pragma unroll
        for (int m = 0; m < 8; ++m)
#pragma unroll
            for (int r = 0; r < 4; ++r) { const float dlt = Y[m][nt][r] - mu; vs += dlt * dlt; }
        vs = rows_sum(vs);
        const float rstd = rsqrtf(vs * (1.f / 128.f) + 1e-5f);
        const size_t tk = tok0 + 32 * wid + 16 * nt + fr;
#pragma unroll
        for (int m = 0; m < 8; ++m) {
            const f32x4 gt = unpack4(*(const u32x2*)(P + tk * LD + C_GR + h * 128 + 16 * m + 4 * fq));
            f32x4 v;
#pragma unroll
            for (int r = 0; r < 4; ++r) v[r] = (Y[m][nt][r] - mu) * rstd * gt[r];
            *(u32x2*)(YB + tk * 1024 + h * 128 + 16 * m + 4 * fq) = pack4(v);
        }
    }
}
__device__ __forceinline__ void phase_p4_sel(const Params& p, unsigned char* lds) {
    for (int i = ltid(); i < 8192 / 16; i += NTHREADS) ((u32x4*)(lds + SEL_BUCKET))[i] = ((const u32x4*)(launder(p.ws) + WS_BUCKET))[i];
    __syncthreads();
    for (int it = blockIdx.x; it < 512; it += gridDim.x * 2) {
        sel_item<0>(p, it, lds);
        if (511 - it != it) sel_item<0>(p, 511 - it, lds);
    }
    __syncthreads();
}
__device__ __forceinline__ void phase_p4(const Params& p, unsigned char* lds, int half) {
    for (int it = (blockIdx.x * 2 + half); it < 1024; it += (gridDim.x * 2)) retout_item(p, it, lds, half);
}

struct RowOrder {     typedef pg8::Unit U; static constexpr bool GATHER = false;
    unsigned a, b; int K, xcd, slot, per;
    __device__ __forceinline__ bool next(int i, pg8::Unit& u) const { const int t = xcd * 32 + slot + i * per; if (t >= (xcd + 1) * 32) return false; u.pm = t >> 2; u.pn = t & 3; return true; }
    __device__ __forceinline__ void ptrs(const pg8::Unit& u, unsigned& A, unsigned& B) const { A = a + (unsigned)u.pm * 512u * (unsigned)K; B = b + (unsigned)u.pn * 512u * (unsigned)K; }
};
template <int MODE>
struct MixEpi {
    unsigned char* ws; const float* X;
    __device__ __forceinline__ void operator()(const f32x4 (&acc)[2][2][4][2], const pg8::Unit& u, int wr, int wc, int fr, int fq) const {
#pragma unroll
        for (int ai = 0; ai < 2; ++ai)
#pragma unroll
            for (int m = 0; m < 4; ++m) {
                const size_t tok = (size_t)(u.pm * 256 + 128 * ai + 64 * wr + 16 * m + fr + vzero());
#pragma unroll
                for (int bj = 0; bj < 2; ++bj) {
                    const int n = u.pn * 256 + 128 * bj + 32 * wc + 8 * fq;
                    const f32x4 v0 = acc[ai][bj][m][0], v1 = acc[ai][bj][m][1];
                    if (MODE == 2) {
                        const u32x4 xw = *(const u32x4*)((const bf16_t*)(ws + WS_XB) + tok * 1024 + n);
                        const f32x4 h0 = unpack4((u32x2){xw.x, xw.y}) * DN_ALPHA + v0, h1 = unpack4((u32x2){xw.z, xw.w}) * DN_ALPHA + v1;
                        u32x4 w; w.x = pack2(h0[0], h0[1]); w.y = pack2(h0[2], h0[3]); w.z = pack2(h1[0], h1[1]); w.w = pack2(h1[2], h1[3]);
                        *(u32x4*)((bf16_t*)(ws + WS_H1) + tok * 1024 + n) = w;
                    } else {
                        const u32x4 gw = *(const u32x4*)((const bf16_t*)(ws + WS_P) + tok * LD + (MODE == 0 ? C_MA : C_MB) + n);
                        const f32x4 g0 = unpack4((u32x2){gw.x, gw.y}), g1 = unpack4((u32x2){gw.z, gw.w});
                        f32x4 o0 = g0 * v0, o1 = g1 * v1;
                        bf16_t* MG = (bf16_t*)(ws + WS_MG) + tok * 1024 + n;
                        if (MODE == 1) { const u32x4 pw = *(const u32x4*)MG; o0 = o0 + unpack4((u32x2){pw.x, pw.y}); o1 = o1 + unpack4((u32x2){pw.z, pw.w}); }
                        u32x4 w; w.x = pack2(o0[0], o0[1]); w.y = pack2(o0[2], o0[3]); w.z = pack2(o1[0], o1[1]); w.w = pack2(o1[2], o1[3]);
                        *(u32x4*)MG = w;
                    }
                }
            }
    }
};
__device__ __forceinline__ void phase_g2(const Params& p, unsigned char* lds) {
    unsigned char* ws = launder(p.ws);
    RowOrder S; S.xcd = blockIdx.x & 7; S.slot = blockIdx.x >> 3; S.per = gridDim.x >> 3;
    { S.a = (unsigned)WS_YA; S.b = (unsigned)WS_WA; S.K = 512; MixEpi<0> E; E.ws = ws; E.X = nullptr; pg8::gemm_phase<MixEpi<0>, RowOrder>(lds, 512, S, E, ltid(), ws); }
    { S.a = (unsigned)WS_YB; S.b = (unsigned)WS_WB; S.K = 1024; MixEpi<1> E; E.ws = ws; E.X = nullptr; pg8::gemm_phase<MixEpi<1>, RowOrder>(lds, 1024, S, E, ltid(), ws); }
}
__device__ __forceinline__ void phase_g3(const Params& p, int layer, unsigned char* lds) {
    unsigned char* ws = launder(p.ws);
    RowOrder S; S.xcd = blockIdx.x & 7; S.slot = blockIdx.x >> 3; S.per = gridDim.x >> 3; S.a = (unsigned)WS_MG; S.b = (unsigned)WS_WO; S.K = 1024;
    MixEpi<2> E; E.ws = ws; E.X = nullptr;
    pg8::gemm_phase<MixEpi<2>, RowOrder>(lds, 1024, S, E, ltid(), ws);
}

__device__ __forceinline__ void phase_ln1(const Params& p, int layer, unsigned char* lds, bool dry, int half) {
    unsigned char* ws = launder(p.ws);
    const int tid = (ltid() & 255), lane = tid & 63, wid = tid >> 6;
    float* wrL = (float*)lds;
    float* lgL = (float*)(lds - half * HALF_LDS + 65536);
    {
        float4 wv[16];
#pragma unroll
        for (int k = 0; k < 16; ++k) wv[k] = ((const float4*)p.w_router)[tid + 256 * k];
#pragma unroll
        for (int k = 0; k < 16; ++k) { const int i4 = tid + 256 * k, d = i4 >> 2, e0 = (i4 & 3) * 4;
            wrL[(e0 + 0) * 1024 + d] = wv[k].x; wrL[(e0 + 1) * 1024 + d] = wv[k].y; wrL[(e0 + 2) * 1024 + d] = wv[k].z; wrL[(e0 + 3) * 1024 + d] = wv[k].w; }
    }
    __syncthreads();
    const bf16_t* H1 = (const bf16_t*)(ws + WS_H1);
    bf16_t* X1B = (bf16_t*)(ws + WS_X1B);
    const float* gam = p.ln1_g + layer * 1024; const float* bet = p.ln1_b + layer * 1024;
    unsigned* cnt = (unsigned*)(ws + WS_CTL) + (dry ? 0 : CW_CNT) + layer * 1024;
    int* LIST = (int*)(ws + (dry ? WS_HB : WS_LIST)); float* WTS = (float*)(ws + (dry ? WS_HB + 4194304 : WS_WTS));
    constexpr int U = 4;
    const int nwave = (gridDim.x * 2) * 4, wv = (blockIdx.x * 2 + half) * 4 + wid;
    const int nloc = ((T_ - wv * U + nwave * U - 1) / (nwave * U)) * (4 * U);
    u32x2 vn[U][4];
#pragma unroll
    for (int u = 0; u < U; ++u)
#pragma unroll
        for (int j = 0; j < 4; ++j) vn[u][j] = *(const u32x2*)(H1 + (size_t)(wv * U + u) * 1024 + 256 * j + 4 * lane);
    for (int t0 = wv * U; t0 < T_; t0 += nwave * U) {
        float4 y[U][4]; float s[U], q[U];
#pragma unroll
        for (int u = 0; u < U; ++u) {
            s[u] = 0.f;
#pragma unroll
            for (int j = 0; j < 4; ++j) { const f32x4 t = unpack4(vn[u][j]); y[u][j].x = t[0]; y[u][j].y = t[1]; y[u][j].z = t[2]; y[u][j].w = t[3]; s[u] += (t[0] + t[1]) + (t[2] + t[3]); }
        }
        { const int tn = t0 + nwave * U < T_ ? t0 + nwave * U : t0;
#pragma unroll
          for (int u = 0; u < U; ++u)
#pragma unroll
              for (int j = 0; j < 4; ++j) vn[u][j] = *(const u32x2*)(H1 + (size_t)(tn + u) * 1024 + 256 * j + 4 * lane); }
#pragma unroll
        for (int u = 0; u < U; ++u) s[u] = wave_sum(s[u]) * (1.f / 1024.f);
#pragma unroll
        for (int u = 0; u < U; ++u) {
            q[u] = 0.f;
#pragma unroll
            for (int j = 0; j < 4; ++j) { const float a = y[u][j].x - s[u], b2 = y[u][j].y - s[u], c = y[u][j].z - s[u], d = y[u][j].w - s[u]; q[u] += a * a + b2 * b2 + c * c + d * d; }
        }
#pragma unroll
        for (int u = 0; u < U; ++u) q[u] = rsqrtf(wave_sum(q[u]) * (1.f / 1024.f) + 1e-5f);
#pragma unroll
        for (int j = 0; j < 4; ++j) {
            const int d0 = 256 * j + 4 * lane;
            const float4 gg = *(const float4*)(gam + d0), bb = *(const float4*)(bet + d0);
#pragma unroll
            for (int u = 0; u < U; ++u) {
                y[u][j].x = (y[u][j].x - s[u]) * q[u] * gg.x + bb.x; y[u][j].y = (y[u][j].y - s[u]) * q[u] * gg.y + bb.y;
                y[u][j].z = (y[u][j].z - s[u]) * q[u] * gg.z + bb.z; y[u][j].w = (y[u][j].w - s[u]) * q[u] * gg.w + bb.w;
                u32x2 w; w.x = pack2(y[u][j].x, y[u][j].y); w.y = pack2(y[u][j].z, y[u][j].w);
                *(u32x2*)(X1B + (size_t)(t0 + u) * 1024 + d0) = w;
            }
        }
        float lg[U][16];
#pragma unroll
        for (int e = 0; e < 16; ++e) {
#pragma unroll
            for (int u = 0; u < U; ++u) lg[u][e] = 0.f;
#pragma unroll
            for (int j = 0; j < 4; ++j) { const float4 w4 = *(const float4*)(wrL + e * 1024 + 256 * j + 4 * lane);
#pragma unroll
                for (int u = 0; u < U; ++u) lg[u][e] += y[u][j].x * w4.x + y[u][j].y * w4.y + y[u][j].z * w4.z + y[u][j].w * w4.w; }
        }
        float myl = 0.f;
#pragma unroll
        for (int u = 0; u < U; ++u) {
            float w8[8], z4[4];
#pragma unroll
            for (int e = 0; e < 8; ++e) { const u32x2 r = __builtin_amdgcn_permlane32_swap(__float_as_uint(lg[u][e]), __float_as_uint(lg[u][e + 8]), false, false); w8[e] = __uint_as_float(r.x) + __uint_as_float(r.y); }
#pragma unroll
            for (int e = 0; e < 4; ++e) { const u32x2 r = __builtin_amdgcn_permlane16_swap(__float_as_uint(w8[e]), __float_as_uint(w8[e + 4]), false, false); z4[e] = __uint_as_float(r.x) + __uint_as_float(r.y); }
            const bool h8 = (lane & 8) != 0, h4 = (lane & 4) != 0;
            const float k0 = h8 ? z4[2] : z4[0], s0 = h8 ? z4[0] : z4[2], k1 = h8 ? z4[3] : z4[1], s1 = h8 ? z4[1] : z4[3];
            const float y0 = k0 + __int_as_float(__builtin_amdgcn_mov_dpp(__float_as_int(s0), 0x128, 0xF, 0xF, true));
            const float y1 = k1 + __int_as_float(__builtin_amdgcn_mov_dpp(__float_as_int(s1), 0x128, 0xF, 0xF, true));
            const float k2 = h4 ? y1 : y0, s2 = h4 ? y0 : y1;
            float x = k2 + __int_as_float(__builtin_amdgcn_mov_dpp(__float_as_int(s2), 0x141, 0xF, 0xF, true));
            x += __int_as_float(__builtin_amdgcn_mov_dpp(__float_as_int(x), 0xB1, 0xF, 0xF, true));
            x += __int_as_float(__builtin_amdgcn_mov_dpp(__float_as_int(x), 0x4E, 0xF, 0xF, true));
            if ((lane & 3) == u) myl = x;
        }
        static_assert(U == 4, "lane (l & 3) stores token u = l & 3");
        lgL[(half * nloc + ((t0 - wv * U) / (nwave * U)) * (4 * U) + wid * U + (lane & 3)) * 17 + (lane >> 2)] = myl;
    }
    __syncthreads();
    if (half == 0 && wid == 0)
    for (int l0 = 0; l0 < 2 * nloc; l0 += 64) {
        const int li = l0 + lane; const bool act = li < 2 * nloc;
        const int hq = li >= nloc ? 1 : 0, lh = li - hq * nloc;
        const int it = lh / (4 * U), wq = (lh / U) & 3, uq = lh % U, tok = act ? (((blockIdx.x * 2 + hq) * 4 + wq) * U + uq) + it * (nwave * U) : 0;
        float lgv[16];
#pragma unroll
        for (int e = 0; e < 16; ++e) lgv[e] = lgL[li * 17 + e];
        float mx = lgv[0];
#pragma unroll
        for (int e = 1; e < 16; ++e) mx = fmaxf(mx, lgv[e]);
        float pr[16], ps = 0.f;
#pragma unroll
        for (int e = 0; e < 16; ++e) { pr[e] = expf(lgv[e] - mx); ps += pr[e]; }
        const float ips = 1.f / ps;
        float sel[16];
#pragma unroll
        for (int e = 0; e < 16; ++e) { pr[e] *= ips; sel[e] = pr[e] + p.router_bias[e]; }
        int best = 0; float bestv = -1e30f;
#pragma unroll
        for (int gI = 0; gI < 4; ++gI) {
            float a = -1e30f, b2 = -1e30f;
#pragma unroll
            for (int k = 0; k < 4; ++k) { const float x = sel[4 * gI + k]; if (x > a) { b2 = a; a = x; } else if (x > b2) b2 = x; }
            const float gs = a + b2;
            if (gs > bestv) { bestv = gs; best = gI; }
        }
        float s4[4], p4[4];
#pragma unroll
        for (int k = 0; k < 4; ++k) { s4[k] = 0.f; p4[k] = 0.f; }
#pragma unroll
        for (int gI = 0; gI < 4; ++gI) if (gI == best) {
#pragma unroll
            for (int k = 0; k < 4; ++k) { s4[k] = sel[4 * gI + k]; p4[k] = pr[4 * gI + k]; }
        }
        int i0 = 0; float a0 = s4[0];
#pragma unroll
        for (int k = 1; k < 4; ++k) if (s4[k] > a0) { a0 = s4[k]; i0 = k; }
        int i1 = -1; float a1 = -1e30f;
#pragma unroll
        for (int k = 0; k < 4; ++k) if (k != i0 && s4[k] > a1) { a1 = s4[k]; i1 = k; }
        float w0 = 0.f, w1 = 0.f;
#pragma unroll
        for (int k = 0; k < 4; ++k) { if (k == i0) w0 = p4[k]; if (k == i1) w1 = p4[k]; }
        const float iw = 1.f / (w0 + w1);
        const int e0 = act ? best * 4 + i0 : -1, e1 = act ? best * 4 + i1 : -1;
        unsigned myc = 0, r0 = 0, r1 = 0;
#pragma unroll
        for (int e = 0; e < 16; ++e) {
            const unsigned long long m0 = __builtin_amdgcn_ballot_w64(e0 == e), m1 = __builtin_amdgcn_ballot_w64(e1 == e);
            const unsigned c0 = (unsigned)__builtin_popcountll(m0), c = c0 + (unsigned)__builtin_popcountll(m1);
            if (lane == e) myc = c;
            if (e0 == e) r0 = __builtin_amdgcn_mbcnt_hi((unsigned)(m0 >> 32), __builtin_amdgcn_mbcnt_lo((unsigned)m0, 0u));
            if (e1 == e) r1 = c0 + __builtin_amdgcn_mbcnt_hi((unsigned)(m1 >> 32), __builtin_amdgcn_mbcnt_lo((unsigned)m1, 0u));
        }
        unsigned mybase = 0;
        if (lane < 16 && myc != 0) mybase = atomicAdd(&cnt[lane * 64], myc);
        unsigned b0 = 0, b1 = 0;
#pragma unroll
        for (int e = 0; e < 16; ++e) { const unsigned be = (unsigned)__builtin_amdgcn_readlane((int)mybase, e); if (e0 == e) b0 = be; if (e1 == e) b1 = be; }
        if (act) {
            LIST[(size_t)e0 * T_ + b0 + r0] = tok * 2; LIST[(size_t)e1 * T_ + b1 + r1] = tok * 2 + 1;
            WTS[tok * 2] = w0 * iw; WTS[tok * 2 + 1] = w1 * iw;
        }
    }
}

struct MoeUnit { int e, rt, ct, cnt, off; };
struct MoeOrderBase {
    const unsigned* cntp; int t_lo, t_hi, slot, per;
    __device__ __forceinline__ void init(const unsigned* cnt) {
        cntp = cnt; int ntile = 0;
#pragma unroll
        for (int k = 0; k < NE; ++k) ntile += (__builtin_amdgcn_readfirstlane((int)cnt[k * 64]) >> 8) * 4;
        t_lo = (ntile * (int)(blockIdx.x & 7)) >> 3; t_hi = (ntile * (int)((blockIdx.x & 7) + 1)) >> 3; slot = blockIdx.x >> 3; per = gridDim.x >> 3;
    }
    __device__ __forceinline__ bool next(int i, MoeUnit& u) const {
        const int t = t_lo + slot + i * per; if (t >= t_hi) return false;
        int base = 0, off = 0; bool found = false;
#pragma unroll
        for (int k = 0; k < NE; ++k) {
            const int ck = __builtin_amdgcn_readfirstlane((int)cntp[k * 64]), nt = (ck >> 8) * 4;
            if (!found && t < base + nt) { found = true; u.e = k; u.cnt = ck; u.off = off; u.rt = (t - base) >> 2; u.ct = (t - base) & 3; }
            base += nt; off += ck;
        }
        return found;
    }
};
struct M2Order : MoeOrderBase {
    typedef MoeUnit U; static constexpr bool GATHER = true;
    const int* list;
    __device__ __forceinline__ void ptrs(const MoeUnit& u, unsigned& A, unsigned& B) const { A = (unsigned)WS_X1B; B = (unsigned)WS_WG + ((unsigned)u.e * 1024u + (unsigned)u.ct * 256u) * 2048u; }
    __device__ __forceinline__ void rows(const MoeUnit& u, int tid, unsigned (&v)[2]) const {
        v[0] = 0u; v[1] = 0u;
#pragma unroll
        for (int i = 0; i < 2; ++i) { int R, C; pg8::stage_rc((tid + vzero()) * 16 + i * 8192, R, C);
#pragma unroll
            for (int h = 0; h < 2; ++h) { int idx = u.rt * 256 + 128 * h + R; idx = idx < u.cnt ? idx : u.cnt - 1; const int a = (list + (size_t)u.e * T_)[idx]; v[h] |= (unsigned)(a >> 1) << (16 * i); } }
    }
};
struct M3Order : MoeOrderBase {
    typedef MoeUnit U; static constexpr bool GATHER = false;
    __device__ __forceinline__ void ptrs(const MoeUnit& u, unsigned& A, unsigned& B) const { A = (unsigned)WS_HB + ((unsigned)u.off + (unsigned)u.rt * 256u) * 1024u; B = (unsigned)WS_WD + ((unsigned)u.e * 1024u + (unsigned)u.ct * 256u) * 1024u; }
};
struct M2Epi {
    unsigned char* ws;
    __device__ __forceinline__ void operator()(const f32x4 (&acc)[2][2][4][2], const MoeUnit& u, int wr, int wc, int fr, int fq) const {
        bf16_t* HB = (bf16_t*)(ws + WS_HB);
#pragma unroll
        for (int ai = 0; ai < 2; ++ai)
#pragma unroll
            for (int m = 0; m < 4; ++m) {
                const int idx = u.rt * 256 + 128 * ai + 64 * wr + 16 * m + fr + vzero();
                if (idx < u.cnt) {
#pragma unroll
                    for (int bj = 0; bj < 2; ++bj) {
                        const int hcol = 4 * (32 * u.ct + 16 * bj + 4 * wc + fq);
                        const f32x4 gv = acc[ai][bj][m][0], uv = acc[ai][bj][m][1]; f32x4 hv;
#pragma unroll
                        for (int r = 0; r < 4; ++r) hv[r] = gv[r] * fsig(gv[r]) * uv[r];
                        *(u32x2*)(HB + (size_t)(u.off + idx) * 512 + hcol) = pack4(hv);
                    }
                }
            }
    }
};
struct M3Epi {
    unsigned char* ws; const int* list;
    __device__ __forceinline__ void operator()(const f32x4 (&acc)[2][2][4][2], const MoeUnit& u, int wr, int wc, int fr, int fq) const {
        bf16_t* CT = (bf16_t*)(ws + WS_CT);
#pragma unroll
        for (int ai = 0; ai < 2; ++ai)
#pragma unroll
            for (int m = 0; m < 4; ++m) {
                const int idx = u.rt * 256 + 128 * ai + 64 * wr + 16 * m + fr + vzero();
                if (idx < u.cnt) {
                    const int a = list[(size_t)u.e * T_ + idx];
#pragma unroll
                    for (int bj = 0; bj < 2; ++bj) {
                        const int n = u.ct * 256 + 128 * bj + 32 * wc + 8 * fq;
                        const f32x4 v0 = acc[ai][bj][m][0], v1 = acc[ai][bj][m][1];
                        u32x4 w; w.x = pack2(v0[0], v0[1]); w.y = pack2(v0[2], v0[3]); w.z = pack2(v1[0], v1[1]); w.w = pack2(v1[2], v1[3]);
                        *(u32x4*)(CT + (size_t)a * 1024 + n) = w;
                    }
                }
            }
    }
};
template <int MODE>
__device__ __forceinline__ void moe_rem_item(unsigned char* ws, const int* list, int e, int cnt, int off, int rh, int c64, unsigned char* lds) {
    constexpr int K = MODE == 0 ? 1024 : 512, NS = K / 64;
    const int tid = (ltid() & 255), lane = tid & 63, wid = tid >> 6, wr = wid >> 1, wc = wid & 1, fr = lane & 15, fq = lane >> 4;
    const int idx0 = (cnt & ~255) + 128 * rh;
    const int ldc = ((lane & 7) ^ (lane >> 3)) * 8;
    const bf16_t* ap[4];
#pragma unroll
    for (int i = 0; i < 4; ++i) {
        int idx = idx0 + 32 * i + 8 * wid + (lane >> 3); idx = idx < cnt ? idx : cnt - 1;
        if (MODE == 0) { const int a = list[(size_t)e * T_ + idx]; ap[i] = (const bf16_t*)(ws + WS_X1B) + (size_t)(a >> 1) * 1024 + ldc; }
        else ap[i] = (const bf16_t*)(ws + WS_HB) + (size_t)(off + idx) * 512 + ldc;
    }
    const bf16_t* bp[2];
#pragma unroll
    for (int i = 0; i < 2; ++i) {
        const int rho = 8 * (wid + 4 * i) + (lane >> 3), src = (rho & ~31) + pg8::perm32(rho & 31);
        bp[i] = (const bf16_t*)(ws + (MODE == 0 ? WS_WG : WS_WD)) + ((size_t)e * 1024 + 64 * c64 + src) * K + ldc;
    }
    f32x4 acc[4][2];
#pragma unroll
    for (int i = 0; i < 4; ++i)
#pragma unroll
        for (int j = 0; j < 2; ++j) acc[i][j] = (f32x4){0.f, 0.f, 0.f, 0.f};
    __syncthreads();
#define RSTAGE(buf, l) do { unsigned char* st_ = lds + (buf) * 24576; \
        _Pragma("unroll") for (int i = 0; i < 4; ++i) glds16(ap[i] + (l) * 64, st_ + (4 * i + wid) * 1024); \
        _Pragma("unroll") for (int i = 0; i < 2; ++i) glds16(bp[i] + (l) * 64, st_ + 16384 + (wid + 4 * i) * 1024); } while (0)
    RSTAGE(0, 0); RSTAGE(1, 1);
    for (int l = 0; l < NS; ++l) {
        const unsigned char* st = lds + (l % 3) * 24576;
        if (l + 1 < NS) WAIT_V(6); else WAIT_V(0);
        RAW_BARRIER();
        if (l + 2 < NS) RSTAGE((l + 2) % 3, l + 2);
#pragma unroll
        for (int ks = 0; ks < 2; ++ks) {
            bf16x8 a[4], bb[2];
#pragma unroll
            for (int i = 0; i < 4; ++i) a[i] = lds_frag128(st, 64 * wr + 16 * i + fr, 4 * ks + fq);
#pragma unroll
            for (int j = 0; j < 2; ++j) bb[j] = lds_frag128(st + 16384, 32 * wc + 16 * j + fr, 4 * ks + fq);
#pragma unroll
            for (int i = 0; i < 4; ++i)
#pragma unroll
                for (int j = 0; j < 2; ++j) acc[i][j] = mfma16(bb[j], a[i], acc[i][j]);
        }
    }
#undef RSTAGE
#pragma unroll
    for (int i = 0; i < 4; ++i) {
        const int idx = idx0 + 64 * wr + 16 * i + fr + vzero();
        if (idx < cnt) {
            if (MODE == 0) {
                f32x4 hv;
#pragma unroll
                for (int r = 0; r < 4; ++r) hv[r] = acc[i][0][r] * fsig(acc[i][0][r]) * acc[i][1][r];
                *(u32x2*)((bf16_t*)(ws + WS_HB) + (size_t)(off + idx) * 512 + 32 * c64 + 16 * wc + 4 * fq) = pack4(hv);
            } else {
                const int a = list[(size_t)e * T_ + idx];
                const f32x4 v0 = acc[i][0], v1 = acc[i][1];
                u32x4 w; w.x = pack2(v0[0], v0[1]); w.y = pack2(v0[2], v0[3]); w.z = pack2(v1[0], v1[1]); w.w = pack2(v1[2], v1[3]);
                *(u32x4*)((bf16_t*)(ws + WS_CT) + (size_t)a * 1024 + 64 * c64 + 32 * wc + 8 * fq) = w;
            }
        }
    }
    __syncthreads();
}
template <int MODE>
__device__ __forceinline__ void moe_rem(const unsigned* cntp, unsigned char* ws, const int* list, unsigned char* ldsh, int half) {
    for (int t = blockIdx.x * 2 + half; ; t += gridDim.x * 2) {
        int base = 0, off = 0, e = -1, cnt = 0, eoff = 0, loc = 0;
#pragma unroll
        for (int k = 0; k < NE; ++k) {
            const int ck = __builtin_amdgcn_readfirstlane((int)cntp[k * 64]), ni = (((ck & 255) + 127) >> 7) * 16;
            if (e < 0 && t < base + ni) { e = k; cnt = ck; eoff = off; loc = t - base; }
            base += ni; off += ck;
        }
        if (e < 0) break;
        moe_rem_item<MODE>(ws, list, e, cnt, eoff, loc >> 4, loc & 15, ldsh);
    }
}
__device__ __forceinline__ void phase_m2(const Params& p, int layer, unsigned char* lds, unsigned char* ldsh, int half) {
    unsigned char* ws = launder(p.ws);
    M2Order S; S.init((const unsigned*)(ws + WS_CTL) + CW_CNT + layer * 1024 + vzero());
    S.list = (const int*)(ws + WS_LIST);
    M2Epi E; E.ws = ws;
    pg8::gemm_phase<M2Epi, M2Order>(lds, 1024, S, E, ltid(), ws);
    moe_rem<0>(S.cntp, ws, S.list, ldsh, half);
}
__device__ __forceinline__ void phase_m3(const Params& p, int layer, unsigned char* lds, unsigned char* ldsh, int half) {
    unsigned char* ws = launder(p.ws);
    M3Order S; S.init((const unsigned*)(ws + WS_CTL) + CW_CNT + layer * 1024 + vzero());
    M3Epi E; E.ws = ws; E.list = (const int*)(ws + WS_LIST);
    pg8::gemm_phase<M3Epi, M3Order>(lds, 512, S, E, ltid(), ws);
    moe_rem<1>(S.cntp, ws, E.list, ldsh, half);
}

__device__ __forceinline__ void phase_ln2(const Params& p, int layer, int half) {
    unsigned char* ws = launder(p.ws);
    const int tid = (ltid() & 255), lane = tid & 63, wid = tid >> 6;
    const bf16_t* X1 = (const bf16_t*)(ws + WS_X1B); const bf16_t* CT = (const bf16_t*)(ws + WS_CT); const float* WTS = (const float*)(ws + WS_WTS);
    float* XO = p.out; bf16_t* XB = (bf16_t*)(ws + WS_XB); const bool fin = layer == NLAYER - 1;
    const float* gam = p.ln2_g + layer * 1024; const float* bet = p.ln2_b + layer * 1024;
    constexpr int U = 4;
    const int nwave = (gridDim.x * 2) * 4, wv = (blockIdx.x * 2 + half) * 4 + wid;
    for (int t0 = wv * U; t0 < T_; t0 += nwave * U) {
        float4 v[U][4]; float s[U], q[U];
#pragma unroll
        for (int u = 0; u < U; ++u) {
            const int tok = t0 + u;
            const float w0 = WTS[tok * 2 + vzero()], w1 = WTS[tok * 2 + 1 + vzero()];
            s[u] = 0.f; q[u] = 0.f;
#pragma unroll
            for (int j = 0; j < 4; ++j) {
                const int d0 = 256 * j + 4 * lane;
                const f32x4 xt = unpack4(*(const u32x2*)(X1 + (size_t)tok * 1024 + d0)); float4 xv; xv.x = xt[0]; xv.y = xt[1]; xv.z = xt[2]; xv.w = xt[3];
                const f32x4 c0 = unpack4(*(const u32x2*)(CT + (size_t)(tok * 2) * 1024 + d0)), c1 = unpack4(*(const u32x2*)(CT + (size_t)(tok * 2 + 1) * 1024 + d0));
                v[u][j].x = xv.x * DN_ALPHA + w0 * c0[0] + w1 * c1[0]; v[u][j].y = xv.y * DN_ALPHA + w0 * c0[1] + w1 * c1[1];
                v[u][j].z = xv.z * DN_ALPHA + w0 * c0[2] + w1 * c1[2]; v[u][j].w = xv.w * DN_ALPHA + w0 * c0[3] + w1 * c1[3];
                s[u] += v[u][j].x + v[u][j].y + v[u][j].z + v[u][j].w;
                q[u] += v[u][j].x * v[u][j].x + v[u][j].y * v[u][j].y + v[u][j].z * v[u][j].z + v[u][j].w * v[u][j].w;
            }
        }
#pragma unroll
        for (int u = 0; u < U; ++u) { s[u] = wave_sum(s[u]); q[u] = wave_sum(q[u]); }
#pragma unroll
        for (int j = 0; j < 4; ++j) {
            const int d0 = 256 * j + 4 * lane;
            const float4 gg = *(const float4*)(gam + d0), bb = *(const float4*)(bet + d0);
#pragma unroll
            for (int u = 0; u < U; ++u) {
                const int tok = t0 + u;
                const float mu = s[u] * (1.f / 1024.f), var = fmaxf(q[u] * (1.f / 1024.f) - mu * mu, 0.f), rstd = rsqrtf(var + 1e-5f);
                float4 y; y.x = (v[u][j].x - mu) * rstd * gg.x + bb.x; y.y = (v[u][j].y - mu) * rstd * gg.y + bb.y; y.z = (v[u][j].z - mu) * rstd * gg.z + bb.z; y.w = (v[u][j].w - mu) * rstd * gg.w + bb.w;
                if (fin) *(float4*)(XO + (size_t)tok * 1024 + d0) = y;
                else { u32x2 w; w.x = pack2(y.x, y.y); w.y = pack2(y.z, y.w); *(u32x2*)(XB + (size_t)tok * 1024 + d0) = w; }
            }
        }
    }
}

#define XB_TMO      128
#define XB_XCNT(j)  (256  + 64 * (j))
#define XB_XSUB(j)  (1280 + 64 * (j))
#define XB_XGEN(j)  (2304 + 64 * (j))
#define XB_TOP      3328
#define XB_TOPGEN   3392
#define XCD_BAR_WORDS 3456
#define XB_SPIN_CAP (1u << 22)
#define LAS __attribute__((address_space(3)))
__device__ __forceinline__ unsigned xb_ld(unsigned* p)              { return __hip_atomic_load(p, __ATOMIC_RELAXED, __HIP_MEMORY_SCOPE_AGENT); }
__device__ __forceinline__ unsigned xb_add(unsigned* p, unsigned v) { return __hip_atomic_fetch_add(p, v, __ATOMIC_RELAXED, __HIP_MEMORY_SCOPE_AGENT); }
__device__ __forceinline__ unsigned xb_xcc_id() { return (unsigned)__builtin_amdgcn_s_getreg((3 << 11) | 20) & 0xFu; }
#define XB_SPIN(cond, bar) do { unsigned _sp = 0; while (cond) { __builtin_amdgcn_s_sleep(1); \
    if ((++_sp & 255u) == 0u) { if (xb_ld(&(bar)[XB_TMO])) break; if (_sp > XB_SPIN_CAP) { atomicAdd(&(bar)[XB_TMO], 1u); break; } } } } while (0)
struct XcdBarrier { unsigned* bar; unsigned x; volatile LAS unsigned* st; };
__device__ __forceinline__ XcdBarrier xcd_barrier_post(unsigned* bar, volatile LAS unsigned* st) {
    XcdBarrier b; b.bar = bar; b.x = xb_xcc_id(); b.st = st;
    if (threadIdx.x == 0) (void)xb_add(&bar[XB_XCNT(b.x)], 1u);
    return b;
}
__device__ __forceinline__ void xcd_barrier_complete(unsigned* bar, unsigned x, unsigned& nloc, unsigned& nx) {
    const unsigned G = gridDim.x * gridDim.y * gridDim.z;
    unsigned sum, cnt, mine, sp = 0u;
    for (;;) {
        sum = 0u; cnt = 0u; mine = 0u;
#pragma unroll
        for (unsigned j = 0; j < 16; ++j) { const unsigned c = xb_ld(&bar[XB_XCNT(j)]); sum += c; cnt += (c > 0u) ? 1u : 0u; mine = (j == x) ? c : mine; }
        if (sum == G) break;
        __builtin_amdgcn_s_sleep(1);
        if ((++sp & 255u) == 0u) { if (xb_ld(&bar[XB_TMO])) break; if (sp > XB_SPIN_CAP) { atomicAdd(&bar[XB_TMO], 1u); break; } }
    }
    nloc = mine > 0u ? mine : 1u; nx = cnt > 0u ? cnt : 1u;
}
__device__ __forceinline__ void xcd_barrier(const XcdBarrier& b) {
    asm volatile("s_waitcnt vmcnt(0)" ::: "memory");
    __syncthreads();
    if (threadIdx.x == 0) {
        unsigned* bar = b.bar;
        __builtin_amdgcn_s_waitcnt(0);
        unsigned nloc = b.st[0], nx = b.st[1];
        if (nloc == 0u) { xcd_barrier_complete(bar, b.x, nloc, nx); b.st[0] = nloc; b.st[1] = nx; }
        const unsigned old = xb_add(&bar[XB_XSUB(b.x)], 1u);
        const unsigned gen = old / nloc;
        if (old + 1u == (gen + 1u) * nloc) {
            __builtin_amdgcn_fence(__ATOMIC_RELEASE, "agent");
            asm volatile("s_waitcnt vmcnt(0)" ::: "memory");
            const unsigned og = xb_add(&bar[XB_TOP], 1u);
            const unsigned tg = og / nx;
            if (og + 1u == (tg + 1u) * nx) xb_add(&bar[XB_TOPGEN], 1u);
            else XB_SPIN(xb_ld(&bar[XB_TOPGEN]) == tg, bar);
            __builtin_amdgcn_fence(__ATOMIC_ACQUIRE, "agent");
            xb_add(&bar[XB_XGEN(b.x)], 1u);
            asm volatile("s_waitcnt vmcnt(0)" ::: "memory");
        } else {
            XB_SPIN(xb_ld(&bar[XB_XGEN(b.x)]) == gen, bar);
            __builtin_amdgcn_fence(__ATOMIC_ACQUIRE, "agent");
            asm volatile("s_waitcnt vmcnt(0)" ::: "memory");
        }
    }
    __syncthreads();
}

constexpr int PH_PER_LAYER = 11, N_PHASES = PH_PER_LAYER * NLAYER;
__global__ void __launch_bounds__(NTHREADS, 2) mega(Params p) {
    extern __shared__ __attribute__((aligned(16))) unsigned char lds[];
#if SINGLE_LAUNCH
    volatile LAS unsigned* xbw = (volatile LAS unsigned*)(lds + LDS_BYTES - 16);
    if (threadIdx.x < 4) xbw[threadIdx.x] = 0u;
    __syncthreads();
    XcdBarrier xbar = xcd_barrier_post((unsigned*)(p.ws + WS_CTL) + CW_BAR, xbw);
#endif
    const int half = __builtin_amdgcn_readfirstlane((int)(threadIdx.x >> 8));
    unsigned char* ldsh = lds + half * HALF_LDS;
    bool second = false;
    for (int ph = p.ph_lo; ph < p.ph_hi; ++ph) {
        const int layer = ph / PH_PER_LAYER, k = ph % PH_PER_LAYER;
        if (k == 0 && layer > 0) continue;
#ifdef ONLY_PHASE
        if (k != ONLY_PHASE) continue;
#endif
        switch (k) {
            case 0: phase_pw(p, layer, ldsh, 1 | 16 | 8, half); break;
            case 1: phase_g1(p, layer, lds); break;
            case 2: phase_p2(p, layer, ldsh, half); if (!second && layer + 1 < NLAYER) { __syncthreads(); phase_pw(p, layer + 1, ldsh, 1, half, 32); } break;
            case 3: phase_p3(p, ldsh, half, second ? ((p.rep_mask >> 16) & 7) : 7); if (!second && layer + 1 < NLAYER) { __syncthreads(); phase_pw(p, layer + 1, ldsh, 16, half); }
                    if (!second && layer == 0) { __syncthreads(); phase_pw(p, 0, ldsh, 2, half); } break;
            case 4: { const int sub = second ? ((p.rep_mask >> 12) & 7) : 7;
                    if (sub & 1) phase_p4_sel(p, lds);
                    if ((sub & 4) && half == 0) { phase_pw(p, layer, ldsh, 4, half); __syncthreads(); }
                    if (sub & 2) phase_p4(p, ldsh, half);
                    if ((sub & 4) && half == 1) { __syncthreads(); phase_pw(p, layer, ldsh, 4, half); } } break;
            case 5: phase_g2(p, lds); break;
            case 6: phase_g3(p, layer, lds); break;
            case 7: phase_ln1(p, layer, ldsh, ((p.rep_mask >> 7) & 1) && !second, half); if (!second && layer + 1 < NLAYER) { __syncthreads(); phase_pw(p, layer + 1, ldsh, 2, half); } break;
            case 8: phase_m2(p, layer, lds, ldsh, half); break;
            case 9: phase_m3(p, layer, lds, ldsh, half); break;
            case 10: phase_ln2(p, layer, half); break;
        }

        if (ph + 1 < p.ph_hi) { if (ph == p.ph_lo && !second) cg::this_grid().sync(); else xcd_barrier(xbar); }
        if (((p.rep_mask >> k) & 1) && !second) { second = true; --ph; } else second = false;
    }
}

extern "C" void kernel_launch(void* const* d_in, const int* in_sizes, int n_in, void* d_out, int out_size, void* d_ws, size_t ws_size, hipStream_t stream) {
    static int grid = 0;
    if (grid == 0) {
        if (n_in != 18 || ws_size < WS_END) { fprintf(stderr, "kernel_launch: unexpected n_in %d or ws_size %zu < %zu\n", n_in, ws_size, (size_t)WS_END); grid = -1; return; }
        int dev = 0, cus = 0, per_cu = 0;
        hipGetDevice(&dev); hipDeviceGetAttribute(&cus, hipDeviceAttributeMultiprocessorCount, dev);
        hipFuncSetAttribute((const void*)mega, hipFuncAttributeMaxDynamicSharedMemorySize, LDS_BYTES);
        hipOccupancyMaxActiveBlocksPerMultiprocessor(&per_cu, (const void*)mega, NTHREADS, LDS_BYTES);
        if (per_cu < 1) per_cu = 1;
        if (per_cu > 1) per_cu = 1;
        grid = cus * per_cu;
        (void)hipGetLastError();
    }
    if (grid < 0) return;
    Params p{};
    p.x = (const float*)d_in[0]; p.w_in = (const float*)d_in[1]; p.cmp_pos = (const float*)d_in[2]; p.cmp_w1 = (const float*)d_in[3]; p.cmp_w2 = (const float*)d_in[4];
    p.w_br_a = (const float*)d_in[5]; p.w_br_b = (const float*)d_in[6]; p.w_o = (const float*)d_in[7]; p.ln1_g = (const float*)d_in[8]; p.ln1_b = (const float*)d_in[9];
    p.w_router = (const float*)d_in[10]; p.router_bias = (const float*)d_in[11]; p.w_gate = (const float*)d_in[12]; p.w_up = (const float*)d_in[13]; p.w_down = (const float*)d_in[14];
    p.ln2_g = (const float*)d_in[15]; p.ln2_b = (const float*)d_in[16]; p.rel_bias = (const float*)d_in[17];
    p.out = (float*)d_out; p.ws = (unsigned char*)d_ws; p.rep_mask = REPEAT_MASK;
#if SINGLE_LAUNCH
    hipMemsetAsync((unsigned char*)d_ws + WS_CTL + (size_t)CW_BAR * 4, 0, XCD_BAR_WORDS * 4, stream);
    p.ph_lo = 0; p.ph_hi = N_PHASES;
    void* args[] = {&p};
    hipError_t e = hipLaunchCooperativeKernel((const void*)mega, dim3(grid), dim3(NTHREADS), args, LDS_BYTES, stream);
    if (e != hipSuccess) fprintf(stderr, "cooperative launch failed: %s (grid %d)\n", hipGetErrorString(e), grid);
#else
    for (int ph = 0; ph < N_PHASES; ++ph) {
        p.ph_lo = ph; p.ph_hi = ph + 1;
        hipLaunchKernelGGL(mega, dim3(grid), dim3(NTHREADS), LDS_BYTES, stream, p);
    }
#endif
}
```

```cpp
#include <hip/hip_runtime.h>
#include <hip/hip_cooperative_groups.h>
#include <cstdio>
#include <cstdint>
namespace cg = cooperative_groups;

#ifndef REPEAT_MASK
#define REPEAT_MASK 0
#endif
#ifndef SINGLE_LAUNCH
#define SINGLE_LAUNCH 1
#endif

typedef unsigned short bf16_t;
typedef short bf16x8 __attribute__((ext_vector_type(8)));
typedef float f32x4 __attribute__((ext_vector_type(4)));
typedef unsigned u32x2 __attribute__((ext_vector_type(2)));
typedef unsigned u32x4 __attribute__((ext_vector_type(4)));

constexpr int B_ = 2, S_ = 8192, D_ = 1024, T_ = B_ * S_, NLAYER = 4;
constexpr int DIN = 6424;
constexpr int LD = 5376;
constexpr int NW = 6656;
constexpr int C_QA = 0, C_KC = 512, C_VC = 640, C_KS = 768, C_KW = 896, C_QR = 1024, C_KR = 1536, C_GR = 2048, C_MA = 3072, C_MB = 4096, C_GA = 5120,
              C_VS = 5376, C_VW = 5504, C_VR = 5632;
constexpr float DN_ALPHA = 1.681792830507429f;
constexpr int NE = 16;

constexpr size_t al256(size_t x) { return (x + 255) & ~(size_t)255; }
constexpr size_t WS_CTL = 0;
constexpr size_t WS_BUCKET = 65536;
constexpr size_t WS_ROPE = WS_BUCKET + 8192;
constexpr size_t WS_WIN = WS_ROPE + (size_t)8192 * 32 * 8;
constexpr size_t WS_WA = WS_WIN + (size_t)NW * 1024 * 2;
constexpr size_t WS_WB = WS_WA + (size_t)1024 * 512 * 2;
constexpr size_t WS_WO = WS_WB + (size_t)1024 * 1024 * 2;
constexpr size_t WS_WG = WS_WO + (size_t)1024 * 1024 * 2;
constexpr size_t WS_WU = WS_WG + (size_t)16 * 512 * 1024 * 2;
constexpr size_t WS_WD = WS_WU + (size_t)16 * 512 * 1024 * 2;
constexpr size_t WS_XB = WS_WD + (size_t)16 * 512 * 1024 * 2;
constexpr size_t WS_X = WS_XB + (size_t)T_ * 1024 * 2;
constexpr size_t WS_MG = WS_X + (size_t)T_ * 1024 * 4;
constexpr size_t WS_KCC = WS_MG + (size_t)T_ * 1024 * 2;
constexpr size_t WS_VCCT = WS_KCC + (size_t)4 * 512 * 64 * 2;
constexpr size_t WS_W1T = WS_VCCT + (size_t)4 * 512 * 64 * 2;
constexpr size_t WS_B1 = WS_W1T + (size_t)2 * 64 * 2048 * 2;
constexpr size_t WS_R = WS_B1 + 1024;
constexpr size_t WS_P = WS_R;
constexpr size_t WS_VST = WS_P + (size_t)T_ * LD * 2;
constexpr size_t WS_VWT = WS_VST + (size_t)4 * 64 * S_ * 2;
constexpr size_t WS_VRT = WS_VWT + (size_t)4 * 64 * S_ * 2;
constexpr size_t WS_KVT = WS_VRT + (size_t)16 * 128 * S_ * 2;
constexpr size_t WS_SPT = WS_KVT + (size_t)16 * 64 * 8192 * 4;
constexpr size_t WS_YC = WS_SPT + (size_t)16 * 64 * 8192 * 2;
constexpr size_t WS_YW = WS_YC + (size_t)T_ * 512 * 2;
constexpr size_t WS_YA = WS_YW + (size_t)T_ * 512 * 2;
constexpr size_t WS_YB = WS_YA + (size_t)T_ * 512 * 2;
constexpr size_t WS_SELW = WS_YB + (size_t)T_ * 1024 * 2;
constexpr size_t WS_ENDA = WS_SELW + (size_t)T_ * 2 * 4 * 4;
constexpr size_t WS_H1 = WS_R;
constexpr size_t WS_X1 = WS_H1 + (size_t)T_ * 1024 * 4;
constexpr size_t WS_X1B = WS_X1 + (size_t)T_ * 1024 * 4;
constexpr size_t WS_HB = WS_X1B + (size_t)T_ * 1024 * 2;
constexpr size_t WS_CT = WS_HB + (size_t)2 * T_ * 512 * 2;
constexpr size_t WS_LIST = WS_CT + (size_t)2 * T_ * 1024 * 2;
constexpr size_t WS_WTS = WS_LIST + (size_t)16 * T_ * 4;
constexpr size_t WS_ENDB = WS_WTS + (size_t)2 * T_ * 4;
static_assert(WS_HB + (size_t)2 * T_ * 512 * 2 <= WS_CT, "view B overlap");
constexpr size_t WS_END = WS_ENDA > WS_ENDB ? WS_ENDA : WS_ENDB;

constexpr int CW_CNT = 4096;
constexpr int CW_BAR = 8192;

constexpr int HALF_LDS = 75776, LDS_BYTES = 2 * HALF_LDS + 16;
constexpr int NTHREADS = 512, HT = 256;

struct Params {
    const float* x; const float* w_in; const float* cmp_pos; const float* cmp_w1; const float* cmp_w2;
    const float* w_br_a; const float* w_br_b; const float* w_o; const float* ln1_g; const float* ln1_b;
    const float* w_router; const float* router_bias; const float* w_gate; const float* w_up; const float* w_down;
    const float* ln2_g; const float* ln2_b; const float* rel_bias;
    float* out; unsigned char* ws;
    int ph_lo, ph_hi, rep_mask, pad_;
};

__device__ __forceinline__ bf16_t f2bf(float f) { unsigned u = __float_as_uint(f); u += 0x7fffu + ((u >> 16) & 1u); return (bf16_t)(u >> 16); }
__device__ __forceinline__ float bf2f(unsigned h) { return __uint_as_float(h << 16); }
typedef __bf16 bf16x2_t __attribute__((ext_vector_type(2)));
typedef float f32x2_t __attribute__((ext_vector_type(2)));
__device__ __forceinline__ unsigned pack2(float lo, float hi) { const f32x2_t f = {lo, hi}; return __builtin_bit_cast(unsigned, __builtin_convertvector(f, bf16x2_t)); }
__device__ __forceinline__ u32x2 pack4(f32x4 v) { u32x2 r; r.x = pack2(v[0], v[1]); r.y = pack2(v[2], v[3]); return r; }
__device__ __forceinline__ f32x4 unpack4(u32x2 u) { f32x4 r; r[0] = bf2f(u.x & 0xffffu); r[1] = bf2f(u.x >> 16); r[2] = bf2f(u.y & 0xffffu); r[3] = bf2f(u.y >> 16); return r; }
__device__ __forceinline__ float rows_max(float v) {
    u32x2 r = __builtin_amdgcn_permlane16_swap(__float_as_uint(v), __float_as_uint(v), false, false);
    v = fmaxf(__uint_as_float(r.x), __uint_as_float(r.y));
    r = __builtin_amdgcn_permlane32_swap(__float_as_uint(v), __float_as_uint(v), false, false);
    return fmaxf(__uint_as_float(r.x), __uint_as_float(r.y));
}
__device__ __forceinline__ float rows_sum(float v) {
    u32x2 r = __builtin_amdgcn_permlane16_swap(__float_as_uint(v), __float_as_uint(v), false, false);
    v = __uint_as_float(r.x) + __uint_as_float(r.y);
    r = __builtin_amdgcn_permlane32_swap(__float_as_uint(v), __float_as_uint(v), false, false);
    return __uint_as_float(r.x) + __uint_as_float(r.y);
}
__device__ __forceinline__ float wave_sum(float v) {
    v += __int_as_float(__builtin_amdgcn_mov_dpp(__float_as_int(v), 0xB1, 0xF, 0xF, true));
    v += __int_as_float(__builtin_amdgcn_mov_dpp(__float_as_int(v), 0x4E, 0xF, 0xF, true));
    v += __int_as_float(__builtin_amdgcn_mov_dpp(__float_as_int(v), 0x141, 0xF, 0xF, true));
    v += __int_as_float(__builtin_amdgcn_mov_dpp(__float_as_int(v), 0x140, 0xF, 0xF, true));
    return rows_sum(v);
}
__device__ __forceinline__ float sigmoidf_(float x) { return 1.f / (1.f + __expf(-x)); }
__device__ __forceinline__ int ltid() { int t = threadIdx.x; asm volatile("" : "+v"(t)); return t; }
__device__ __forceinline__ int vzero() { int z; asm volatile("v_mov_b32 %0, 0" : "=v"(z)); return z; }
__device__ __forceinline__ unsigned char* launder(unsigned char* q) { asm volatile("" : "+s"(q)); return q; }
__device__ __forceinline__ void wait_vm0() { asm volatile("s_waitcnt vmcnt(0)" ::: "memory"); }

__device__ __forceinline__ void glds16(const void* g, void* l) {
    __builtin_amdgcn_global_load_lds((const __attribute__((address_space(1))) unsigned*)g,
                                     (__attribute__((address_space(3))) unsigned*)l, 16, 0, 0);
}
__device__ __forceinline__ f32x4 mfma16(bf16x8 a, bf16x8 b, f32x4 c) { return __builtin_amdgcn_mfma_f32_16x16x32_bf16(a, b, c, 0, 0, 0); }

#define WAIT_V(n) asm volatile("s_waitcnt vmcnt(%0)" ::"n"(n) : "memory")
#define RAW_BARRIER() do { asm volatile("s_waitcnt lgkmcnt(0)" ::: "memory"); __builtin_amdgcn_s_barrier(); } while (0)
__device__ __forceinline__ void bglds16(__amdgpu_buffer_rsrc_t r, unsigned voff, int soff, void* l) {
    __builtin_amdgcn_raw_ptr_buffer_load_lds(r, (__attribute__((address_space(3))) void*)l, 16, (int)voff, soff, 0, 0);
}
template <int NJ, bool GN>
__device__ __forceinline__ void gemm8_stage(__amdgpu_buffer_rsrc_t mr, int mld, unsigned mvo, __amdgpu_buffer_rsrc_t nr, int nld, const unsigned (&nvo)[NJ], int kt, unsigned char* st, int wid) {
#pragma unroll
    for (int i = 0; i < 4; ++i) bglds16(mr, mvo, (64 * i * mld + kt * 64) * 2, st + (8 * i + wid) * 1024);
#pragma unroll
    for (int i = 0; i < NJ; ++i) bglds16(nr, nvo[i], ((GN ? 0 : 64 * i * nld) + kt * 64) * 2, st + 32768 + (8 * i + wid) * 1024);
}
template <int NJ, bool GN>
__device__ __forceinline__ void gemm8_kloop(const bf16_t* mb, int mld, unsigned mvo, const bf16_t* nb, int nld, const unsigned (&nvo)[NJ], int nk, unsigned char* lds, f32x4 (&acc)[8][NJ], int tid) {
    const int lane = tid & 63, wid = tid >> 6, wr = wid >> 2, wc = wid & 3, fr = lane & 15, fq = lane >> 4;
    const __amdgpu_buffer_rsrc_t mr = __builtin_amdgcn_make_buffer_rsrc((void*)mb, 0, 0x7fffffff, 0x00020000);
    const __amdgpu_buffer_rsrc_t nr = __builtin_amdgcn_make_buffer_rsrc((void*)nb, 0, 0x7fffffff, 0x00020000);
    gemm8_stage<NJ, GN>(mr, mld, mvo, nr, nld, nvo, 0, lds, wid);
    gemm8_stage<NJ, GN>(mr, mld, mvo, nr, nld, nvo, 1, lds + 65536, wid);
    for (int kt = 0; kt < nk; ++kt) {
        unsigned char* cur = lds + (kt & 1) * 65536;
        if (kt + 1 < nk) WAIT_V(4 + NJ); else WAIT_V(0);
        RAW_BARRIER();
        bf16x8 a[4], b[NJ];
        const unsigned char* ab = cur + (128 * wr + fr) * 128;
        const unsigned char* bb = cur + 32768 + (16 * NJ * wc + fr) * 128;
        const int sw0 = ((fq) ^ (fr & 7)) << 4, sw1 = ((4 + fq) ^ (fr & 7)) << 4;
#pragma unroll
        for (int j = 0; j < NJ; ++j) b[j] = *(const bf16x8*)(bb + j * 2048 + sw0);
#pragma unroll
        for (int mh = 0; mh < 2; ++mh) {
#pragma unroll
            for (int i = 0; i < 4; ++i) a[i] = *(const bf16x8*)(ab + (4 * mh + i) * 2048 + sw0);
#pragma unroll
            for (int i = 0; i < 4; ++i)
#pragma unroll
                for (int j = 0; j < NJ; ++j) acc[4 * mh + i][j] = mfma16(a[i], b[j], acc[4 * mh + i][j]);
        }
#pragma unroll
        for (int j = 0; j < NJ; ++j) b[j] = *(const bf16x8*)(bb + j * 2048 + sw1);
#pragma unroll
        for (int i = 0; i < 4; ++i) a[i] = *(const bf16x8*)(ab + i * 2048 + sw1);
#pragma unroll
        for (int i = 0; i < 4; ++i)
#pragma unroll
            for (int j = 0; j < NJ; ++j) acc[i][j] = mfma16(a[i], b[j], acc[i][j]);
#pragma unroll
        for (int i = 0; i < 4; ++i) a[i] = *(const bf16x8*)(ab + (4 + i) * 2048 + sw1);
        RAW_BARRIER();
        if (kt + 2 < nk) gemm8_stage<NJ, GN>(mr, mld, mvo, nr, nld, nvo, kt + 2, cur, wid);
#pragma unroll
        for (int i = 0; i < 4; ++i)
#pragma unroll
            for (int j = 0; j < NJ; ++j) acc[4 + i][j] = mfma16(a[i], b[j], acc[4 + i][j]);
    }
    __syncthreads();
    __builtin_amdgcn_sched_barrier(0);
}
template <int NJ>
__device__ __forceinline__ void zero_acc8(f32x4 (&acc)[8][NJ]) {
#pragma unroll
    for (int i = 0; i < 8; ++i)
#pragma unroll
        for (int j = 0; j < NJ; ++j) acc[i][j] = (f32x4){0.f, 0.f, 0.f, 0.f};
}

namespace pg8 {
#define PG8_LAS __attribute__((address_space(3)))
constexpr int BM = 256, BK = 64, HALF = 128, HTB = HALF * BK * 2, STAGE_BYTES = 8 * HTB;
__device__ __forceinline__ int lds_byte(int r, int c) { const int st = (r >> 4) * 2 + (c >> 5), rr = r & 15, cc = c & 31, ob = rr * 64 + cc * 2; return st * 1024 + (ob ^ (((ob >> 9) & 1) << 5)); }
__device__ __forceinline__ void stage_rc(int b, int& R, int& C) { const int st = b / 1024, sb = b % 1024, swz = sb ^ (((sb >> 9) & 1) << 5); R = (st >> 1) * 16 + swz / 64; C = (st & 1) * 32 + (swz % 64) / 2; }
__device__ __forceinline__ int perm32(int rho) { const int n = rho >> 4, i = rho & 15; return 8 * (i >> 2) + 4 * n + (i & 3); }
struct Unit { int pm, pn; };
template <class Epi, class Sched>
__device__ __forceinline__ void gemm_phase(unsigned char* lds_, const int K, const Sched& S, const Epi& E, const int tid, const unsigned char* wsbase) {
    PG8_LAS unsigned char* lds = (PG8_LAS unsigned char*)lds_;
    const int wid = __builtin_amdgcn_readfirstlane(tid >> 6), lane = tid & 63, wr = wid >> 2, wc = wid & 3, fr = lane & 15, fq = lane >> 4;
    const int nt = K / BK;
    unsigned voffA[2], voffB[2];
#pragma unroll
    for (int i = 0; i < 2; ++i) { int R, C; stage_rc(tid * 16 + i * 8192, R, C); const int Rb = (R & ~31) + perm32(R & 31);
        voffA[i] = (unsigned)(R * K + C) * 2u; voffB[i] = (unsigned)(Rb * K + C) * 2u; }
    const unsigned kstep = (unsigned)(BK * 2);
    const unsigned hstep = (unsigned)HALF * K * 2;
    const __amdgpu_buffer_rsrc_t rsrc = __builtin_amdgcn_make_buffer_rsrc((void*)wsbase, 0, 0x7fffffff, 0x00020000);
    const unsigned ldsw = (unsigned)wid * 1024u;
    const int aoff = lds_byte(wr * 64 + fr, fq * 8), boff = lds_byte(wc * 32 + fr, fq * 8);
#define PG8_SA(b, h) (((b) * 2 + (h)) * HTB)
#define PG8_SB(b, h) ((4 + (b) * 2 + (h)) * HTB)
#define PG8_STAGE(bufoff, gbase, voff) do { _Pragma("unroll") for (int _i = 0; _i < 2; ++_i) \
        __builtin_amdgcn_raw_ptr_buffer_load_lds(rsrc, (PG8_LAS void*)(lds + (bufoff) + ldsw + _i * 8192), 16, (int)(voff)[_i], (int)(gbase), 0, 0); } while (0)
#define PG8_LDA(dst, b, h) do { _Pragma("unroll") for (int m = 0; m < 4; ++m) _Pragma("unroll") for (int k = 0; k < 2; ++k) dst[m][k] = *(const PG8_LAS bf16x8*)(lds + PG8_SA(b, h) + aoff + m * 2048 + k * 1024); } while (0)
#define PG8_LDB(dst, b, h) do { _Pragma("unroll") for (int n = 0; n < 2; ++n) _Pragma("unroll") for (int k = 0; k < 2; ++k) dst[n][k] = *(const PG8_LAS bf16x8*)(lds + PG8_SB(b, h) + boff + n * 2048 + k * 1024); } while (0)
#define PG8_MMA(ai, bj, At, Bt) do { __builtin_amdgcn_s_setprio(1); _Pragma("unroll") for (int m = 0; m < 4; ++m) _Pragma("unroll") for (int n = 0; n < 2; ++n) _Pragma("unroll") for (int k = 0; k < 2; ++k) \
        acc[ai][bj][m][n] = __builtin_amdgcn_mfma_f32_16x16x32_bf16(Bt[n][k], At[m][k], acc[ai][bj][m][n], 0, 0, 0); __builtin_amdgcn_s_setprio(0); } while (0)
#define PG8_WAIT_V(n) asm volatile("s_waitcnt vmcnt(" #n ")" ::: "memory")
#define PG8_WAIT_L(n) asm volatile("s_waitcnt lgkmcnt(" #n ")" ::: "memory")
#define PG8_BAR __builtin_amdgcn_s_barrier()
#define PG8_SCHED __builtin_amdgcn_sched_barrier(0)
    typename Sched::U cur, nxt; int ui = 0;
    if (!S.next(0, cur)) return;
    unsigned cA, cB; S.ptrs(cur, cA, cB);
    constexpr bool GA = Sched::GATHER;
    unsigned vA[2], nvA[2];
    if constexpr (GA) { S.rows(cur, tid, vA); nvA[0] = vA[0]; nvA[1] = vA[1]; }
#define PG8_STAGE_G(bufoff, gbase, pk) do { const unsigned _cb = voffB[0] & (unsigned)(2 * K - 1); unsigned _vo[2] = {(((pk) & 0xffffu) * (unsigned)(2 * K)) + _cb, (((pk) >> 16) * (unsigned)(2 * K)) + _cb}; PG8_STAGE(bufoff, gbase, _vo); } while (0)
#define PG8_STAGE_A(bufoff, gbase, h, nextu) do { if constexpr (GA) { if (nextu) PG8_STAGE_G(bufoff, gbase, nvA[h]); else PG8_STAGE_G(bufoff, gbase, vA[h]); } \
        else PG8_STAGE(bufoff, (gbase) + (h) * hstep, voffA); } while (0)
    PG8_STAGE(PG8_SB(0, 0), cB, voffB); PG8_STAGE_A(PG8_SA(0, 0), cA, 0, false); PG8_STAGE(PG8_SB(0, 1), cB + hstep, voffB); PG8_STAGE_A(PG8_SA(0, 1), cA, 1, false);
    if (wr == 1) PG8_BAR;
    PG8_WAIT_V(4); PG8_BAR;
    PG8_STAGE(PG8_SB(1, 0), cB + kstep, voffB); PG8_STAGE_A(PG8_SA(1, 0), cA + kstep, 0, false); PG8_STAGE(PG8_SB(1, 1), cB + hstep + kstep, voffB);
    PG8_WAIT_V(6); PG8_BAR;
    PG8_SCHED;
    f32x4 acc[2][2][4][2];
#pragma unroll
    for (int a = 0; a < 2; ++a)
#pragma unroll
        for (int b = 0; b < 2; ++b)
#pragma unroll
            for (int m = 0; m < 4; ++m)
#pragma unroll
                for (int n = 0; n < 2; ++n) acc[a][b][m][n] = (f32x4){0.f, 0.f, 0.f, 0.f};
    bf16x8 At[4][2], B0[2][2], B1[2][2];
    for (;;) {
        const bool has_next = S.next(ui + 1, nxt);
        unsigned nA = cA, nB = cB; if (has_next) S.ptrs(nxt, nA, nB);
        if constexpr (GA) { if (has_next) S.rows(nxt, tid, nvA); }
        for (int t = 0; t < nt; t += 2) {
            if constexpr (Epi::MID_T > 0) { if (t == Epi::MID_T) E.mid(acc, cur, wr, wc, fr, fq); }
            const bool last = (t == nt - 2);
            const unsigned a1 = cA + (unsigned)(t + 1) * kstep;
            const unsigned a2 = last ? nA : cA + (unsigned)(t + 2) * kstep, b2 = last ? nB : cB + (unsigned)(t + 2) * kstep;
            const unsigned a3 = a2 + kstep, b3 = b2 + kstep;
            PG8_LDB(B0, 0, 0); PG8_SCHED; PG8_LDA(At, 0, 0); PG8_STAGE_A(PG8_SA(1, 1), a1, 1, false);
            PG8_WAIT_L(8); PG8_BAR; PG8_WAIT_L(0); PG8_MMA(0, 0, At, B0); PG8_BAR; PG8_SCHED;
            PG8_LDB(B1, 0, 1); PG8_STAGE(PG8_SB(0, 0), b2, voffB);
            PG8_BAR; PG8_WAIT_L(0); PG8_MMA(0, 1, At, B1); PG8_BAR;
            PG8_LDA(At, 0, 1); PG8_STAGE_A(PG8_SA(0, 0), a2, 0, last);
            PG8_BAR; PG8_WAIT_L(0); PG8_MMA(1, 0, At, B0); PG8_BAR; PG8_SCHED;
            PG8_STAGE(PG8_SB(0, 1), b2 + hstep, voffB);
            PG8_WAIT_V(6); PG8_BAR; PG8_MMA(1, 1, At, B1); PG8_BAR;
            PG8_LDB(B0, 1, 0); PG8_SCHED; PG8_LDA(At, 1, 0); PG8_STAGE_A(PG8_SA(0, 1), a2, 1, last);
            PG8_WAIT_L(8); PG8_BAR; PG8_WAIT_L(0); PG8_MMA(0, 0, At, B0); PG8_BAR; PG8_SCHED;
            PG8_LDB(B1, 1, 1); PG8_STAGE(PG8_SB(1, 0), b3, voffB);
            PG8_BAR; PG8_WAIT_L(0); PG8_MMA(0, 1, At, B1); PG8_BAR;
            PG8_LDA(At, 1, 1); PG8_STAGE_A(PG8_SA(1, 0), a3, 0, last);
            PG8_BAR; PG8_WAIT_L(0); PG8_MMA(1, 0, At, B0); PG8_BAR; PG8_SCHED;
            PG8_STAGE(PG8_SB(1, 1), b3 + hstep, voffB);
            PG8_WAIT_V(6); PG8_BAR; PG8_MMA(1, 1, At, B1); PG8_BAR;
        }
        E(acc, cur, wr, wc, fr, fq);
        if (!has_next) break;
#pragma unroll
        for (int a = 0; a < 2; ++a)
#pragma unroll
            for (int b = 0; b < 2; ++b)
#pragma unroll
                for (int m = 0; m < 4; ++m)
#pragma unroll
                    for (int n = 0; n < 2; ++n) acc[a][b][m][n] = (f32x4){0.f, 0.f, 0.f, 0.f};
        cur = nxt; cA = nA; cB = nB; ++ui;
        if constexpr (GA) { vA[0] = nvA[0]; vA[1] = nvA[1]; }
    }
    PG8_WAIT_V(0);
    if (wr == 0) PG8_BAR;
    PG8_BAR;
#undef PG8_SA
#undef PG8_SB
#undef PG8_STAGE
#undef PG8_STAGE_A
#undef PG8_STAGE_G
#undef PG8_LDA
#undef PG8_LDB
#undef PG8_MMA
#undef PG8_WAIT_V
#undef PG8_WAIT_L
#undef PG8_BAR
#undef PG8_SCHED
}
}

struct TJob { const float* src; bf16_t* dst; int ld, k0, n0, mode, kdst; };
__device__ __forceinline__ void tcvt_load(const TJob& J, float4 (&v)[4], int tid) {
#pragma unroll
    for (int i = 0; i < 4; ++i) {
        const int kk = (tid >> 4) + 16 * i, c4 = (tid & 15) * 4, cd = J.n0 + c4;
        int orig = cd; bool ok = true;
        if (J.mode == 1) {
            if (cd < 896) orig = cd;
            else if (cd < 1024) orig = cd - 896 + 1024;
            else if (cd < 2048) { const int q = cd - 1024, hd = q >> 6, pp = q & 63;
                const int d = (pp & 4) ? 32 + 4 * (pp >> 3) + (pp & 3) : 4 * (pp >> 3) + (pp & 3);
                orig = 1304 + hd * 64 + d; }
            else if (cd < 5120) orig = cd - 2048 + 3352;
            else if (cd < 5144) orig = cd - 5120 + 1280;
            else if (cd < 5376) ok = false;
            else if (cd < 5504) orig = cd - 5376 + 896;
            else if (cd < 5632) orig = cd - 5504 + 1152;
            else orig = cd - 5632 + 2328;
        }
        v[i] = make_float4(0.f, 0.f, 0.f, 0.f);
        if (ok) v[i] = *(const float4*)(J.src + (size_t)(J.k0 + kk) * J.ld + orig);
    }
}
__device__ __forceinline__ void tcvt_finish(const TJob& J, const float4 (&v)[4], unsigned char* lds, int tid) {
    float* tile = (float*)lds;
#pragma unroll
    for (int i = 0; i < 4; ++i) {
        const int kk = (tid >> 4) + 16 * i, c4 = (tid & 15) * 4;
        tile[kk * 65 + c4 + 0] = v[i].x; tile[kk * 65 + c4 + 1] = v[i].y; tile[kk * 65 + c4 + 2] = v[i].z; tile[kk * 65 + c4 + 3] = v[i].w;
    }
    __syncthreads();
#pragma unroll
    for (int i = 0; i < 2; ++i) {
        const int q = tid + 256 * i, n = q >> 3, kc = q & 7;
        float x[8];
#pragma unroll
        for (int j = 0; j < 8; ++j) x[j] = tile[(kc * 8 + j) * 65 + n];
        u32x4 w; w.x = pack2(x[0], x[1]); w.y = pack2(x[2], x[3]); w.z = pack2(x[4], x[5]); w.w = pack2(x[6], x[7]);
        int drow = J.n0 + n; if (J.mode >= 2) drow = 8 * (drow >> 2) + (drow & 3) + (J.mode == 3 ? 4 : 0);
        *(u32x4*)(J.dst + (size_t)drow * J.kdst + J.k0 + kc * 8) = w;
    }
    __syncthreads();
}
__device__ __forceinline__ void tcvt_tile(const float* src, int ld_src, int k0, int n0, int mode, bf16_t* dst, int kdst, unsigned char* lds, int half) {
    TJob J; J.src = src; J.dst = dst; J.ld = ld_src; J.k0 = k0; J.n0 = n0; J.mode = mode; J.kdst = kdst;
    const int tid = (ltid() & 255); float4 v[4];
    tcvt_load(J, v, tid); tcvt_finish(J, v, lds, tid);
}

__device__ __forceinline__ void tcvt_decode(const Params& p, unsigned char* ws, int layer, int t, TJob& J) {
    constexpr int J0 = 16 * 104, J1 = 8 * 16, J2 = 256, J3 = 256, J4 = 2048, J5 = 2048;
    int u = t;
        if (u < J0) { J.src = p.w_in + (size_t)layer * 1024 * DIN; J.ld = DIN; J.k0 = (u % 16) * 64; J.n0 = (u / 16) * 64; J.mode = 1; J.dst = (bf16_t*)(ws + WS_WIN); J.kdst = 1024; return; }
        u -= J0;
        if (u < J1) { J.src = p.w_br_a + (size_t)layer * 512 * 1024; J.ld = 1024; J.k0 = (u % 8) * 64; J.n0 = (u / 8) * 64; J.mode = 0; J.dst = (bf16_t*)(ws + WS_WA); J.kdst = 1536; return; }
        u -= J1;
        if (u < J2) { J.src = p.w_br_b + (size_t)layer * 1024 * 1024; J.ld = 1024; J.k0 = (u % 16) * 64; J.n0 = (u / 16) * 64; J.mode = 0; J.dst = (bf16_t*)(ws + WS_WA) + 512; J.kdst = 1536; return; }
        u -= J2;
        if (u < J3) { J.src = p.w_o + (size_t)layer * 1024 * 1024; J.ld = 1024; J.k0 = (u % 16) * 64; J.n0 = (u / 16) * 64; J.mode = 0; J.dst = (bf16_t*)(ws + WS_WO); J.kdst = 1024; return; }
        u -= J3;
        if (u < J4 + J5) {
            const bool up = u >= J4; if (up) u -= J4;
            const int e = u / 128, v = u % 128;
            J.src = (up ? p.w_up : p.w_gate) + ((size_t)layer * NE + e) * 1024 * 512; J.ld = 512; J.k0 = (v % 16) * 64; J.n0 = (v / 16) * 64; J.mode = up ? 3 : 2;
            J.dst = (bf16_t*)(ws + WS_WG) + (size_t)e * 1024 * 1024; J.kdst = 1024; return;
        }
        u -= J4 + J5;
        { const int e = u / 128, v = u % 128;
          J.src = p.w_down + ((size_t)layer * NE + e) * 512 * 1024; J.ld = 1024; J.k0 = (v % 8) * 64; J.n0 = (v / 8) * 64; J.mode = 0; J.dst = (bf16_t*)(ws + WS_WD) + (size_t)e * 1024 * 512; J.kdst = 512; }
}


__device__ __forceinline__ void phase_pw(const Params& p, int layer, unsigned char* lds, int parts, int half, int skip = 0) {
    const int hq = __builtin_amdgcn_readfirstlane(ltid() >> 8);
    if ((int)(blockIdx.x * 2 + hq) < skip) return;
    const int bid = (blockIdx.x * 2 + hq) - skip, nblk = (gridDim.x * 2) - skip, tid = (ltid() & 255);
    unsigned char* ws = launder(p.ws);
    constexpr int J0 = 16 * 104, J1 = 8 * 16, J2 = 256, J3 = 256, J4 = 2048, J5 = 2048, J6 = 2048, JT = J0 + J1 + J2 + J3 + J4 + J5 + J6;
    const int t_lo = (parts & 1) ? 0 : (parts & 2) ? J0 : J0 + J1 + J2 + J3;
    const int t_hi = (parts & 4) ? JT : (parts & 2) ? J0 + J1 + J2 + J3 : (parts & 1) ? J0 : 0;
    if (t_lo + bid < t_hi) {
        float4 v[4]; { TJob J; tcvt_decode(p, ws, layer, t_lo + bid, J); tcvt_load(J, v, tid); }
        for (int t = t_lo + bid; t < t_hi; t += nblk) {
            float4 vn[4];
            if (t + nblk < t_hi) { TJob J; tcvt_decode(p, ws, layer, t + nblk, J); tcvt_load(J, vn, tid); }
            { TJob J; tcvt_decode(p, ws, layer, t, J); tcvt_finish(J, v, lds, tid); }
#pragma unroll
            for (int i = 0; i < 4; ++i) v[i] = vn[i];
        }
    }
    if (parts & 16) {
    for (int t = bid; t < 64; t += nblk) {
        const int kv = t >> 5, kt = t & 31;
        tcvt_tile(p.cmp_w1 + ((size_t)layer * 2 + kv) * 2048 * 64, 64, kt * 64, 0, 0, (bf16_t*)(ws + WS_W1T) + (size_t)kv * 64 * 2048, 2048, lds, half);
    }
    if (bid >= nblk - 2) {
        const int kv = nblk - 1 - bid, n = tid & 63, part = tid >> 6;
        const float* w1 = p.cmp_w1 + ((size_t)layer * 2 + kv) * 2048 * 64; const float* pos = p.cmp_pos + ((size_t)layer * 2 + kv) * 2048;
        float a = 0.f;
        for (int k = part * 512; k < part * 512 + 512; ++k) a += pos[k] * w1[(size_t)k * 64 + n];
        float* red = (float*)lds;
        __syncthreads(); red[tid] = a; __syncthreads();
        if (tid < 64) ((float*)(ws + WS_B1))[kv * 64 + tid] = red[tid] + red[tid + 64] + red[tid + 128] + red[tid + 192];
        __syncthreads();
    }
    }
    if (parts & 8) {
        const float4* xs = (const float4*)p.x; u32x2* xb = (u32x2*)(ws + WS_XB);
        for (size_t i = (size_t)bid * HT + tid; i < (size_t)T_ * 1024 / 4; i += (size_t)nblk * HT) {
            float4 v = xs[i]; u32x2 w; w.x = pack2(v.x, v.y); w.y = pack2(v.z, v.w); xb[i] = w;
        }
        for (int n = bid * HT + tid; n < 8192; n += nblk * HT) {
            int bk;
            if (n < 16) bk = n;
            else { const int th[15] = {22, 30, 40, 54, 73, 99, 134, 182, 246, 332, 450, 609, 825, 1117, 1513}; bk = 16;
#pragma unroll
                for (int k = 0; k < 15; ++k) bk += (n >= th[k]) ? 1 : 0; }
            (ws + WS_BUCKET)[n] = (unsigned char)bk;
        }
        for (int i = bid * HT + tid; i < 8192 * 32; i += nblk * HT) {
            const int pos = i >> 5, d = i & 31;
            const float inv = powf(10000.f, -(float)d * 2.0f / 64.f);
            const float ang = (float)pos * inv;
            float sn, cs; sincosf(ang, &sn, &cs);
            ((float2*)(ws + WS_ROPE))[i] = make_float2(cs, sn);
        }
        if (bid == 0) for (int i = tid; i < 8192; i += HT) ((unsigned*)(ws + WS_CTL))[i] = 0u;
    }
}

__device__ __forceinline__ float fsig(float x) { return __builtin_amdgcn_rcpf(1.f + __builtin_amdgcn_exp2f(-1.4426950408889634f * x)); }
template <int KIND>
__device__ __forceinline__ void g1_epi(const f32x4 (&acc)[2][2][4][2], unsigned char* ws, int r0, int c0, int wr, int wc, int fr, int fq) {
#pragma unroll
    for (int ai = 0; ai < 2; ++ai)
#pragma unroll
        for (int m = 0; m < 4; ++m) {
            const int row = r0 + 128 * ai + 64 * wr + 16 * m + fr + vzero();
#pragma unroll
            for (int bj = 0; bj < 2; ++bj) {
                const int col = c0 + 128 * bj + 32 * wc + 8 * fq;
                f32x4 v0 = acc[ai][bj][m][0], v1 = acc[ai][bj][m][1];
                if (KIND == 5) {
                    const int b = col >> 13, sq = col & (S_ - 1);
                    bf16_t* dst;
                    if (row < C_VW) { const int c = row - C_VS; dst = (bf16_t*)(ws + WS_VST) + ((size_t)(b * 2 + (c >> 6)) * 64 + (c & 63)) * S_ + sq; }
                    else if (row < C_VR) { const int c = row - C_VW; dst = (bf16_t*)(ws + WS_VWT) + ((size_t)(b * 2 + (c >> 6)) * 64 + (c & 63)) * S_ + sq; }
                    else { const int c = row - C_VR; dst = (bf16_t*)(ws + WS_VRT) + ((size_t)(b * 8 + (c >> 7)) * 128 + (c & 127)) * S_ + sq; }
                    u32x4 w; w.x = pack2(v0[0], v0[1]); w.y = pack2(v0[2], v0[3]); w.z = pack2(v1[0], v1[1]); w.w = pack2(v1[2], v1[3]);
                    *(u32x4*)dst = w;
                    continue;
                }
                if (KIND == 1 || KIND == 2) {
                    const float2* rope = (const float2*)(ws + WS_ROPE);
                    const int pos = row & (S_ - 1), d = 16 * (wc & 1) + 4 * fq;
                    const float4 cs01 = *(const float4*)(rope + pos * 32 + d), cs23 = *(const float4*)(rope + pos * 32 + d + 2);
                    const float c[4] = {cs01.x, cs01.z, cs23.x, cs23.z}, sn[4] = {cs01.y, cs01.w, cs23.y, cs23.w};
                    const float sc = (KIND == 2) ? 0.125f : 1.0f;
                    f32x4 y1, y2;
#pragma unroll
                    for (int r = 0; r < 4; ++r) { y1[r] = (v0[r] * c[r] - v1[r] * sn[r]) * sc; y2[r] = (v0[r] * sn[r] + v1[r] * c[r]) * sc; }
                    v0 = y1; v1 = y2;
                } else if (KIND == 3) {
#pragma unroll
                    for (int r = 0; r < 4; ++r) { v0[r] = v0[r] * fsig(v0[r]); v1[r] = v1[r] * fsig(v1[r]); }
                } else if (KIND == 4) {
#pragma unroll
                    for (int r = 0; r < 4; ++r) { v0[r] = fsig(v0[r]); v1[r] = fsig(v1[r]); }
                }
                u32x4 w; w.x = pack2(v0[0], v0[1]); w.y = pack2(v0[2], v0[3]); w.z = pack2(v1[0], v1[1]); w.w = pack2(v1[2], v1[3]);
                *(u32x4*)((bf16_t*)(ws + WS_P) + (size_t)row * LD + col) = w;
            }
        }
}
struct G1Order {      typedef pg8::Unit U; static constexpr bool GATHER = false;
    int xcd, slot, per;
    __device__ __forceinline__ bool next(int i, pg8::Unit& u) const {
        const int j = slot + i * per; if (j >= 208) return false;
        if (j < 192) { u.pm = j / 3; u.pn = xcd + 8 * (j % 3); } else { const int q = j - 192; u.pm = 8 * xcd + (q >> 1); u.pn = 24 + (q & 1); }
        return true;
    }
    __device__ __forceinline__ void ptrs(const pg8::Unit& u, unsigned& A, unsigned& B) const {
        const unsigned x = (unsigned)WS_XB + (unsigned)u.pm * (256u * 1024u * 2u), w = (unsigned)WS_WIN + (unsigned)u.pn * (256u * 1024u * 2u);
        if (u.pn >= 21) { A = w; B = x; } else { A = x; B = w; }
    }
};
struct G1Epi {
    static constexpr int MID_T = 0;
    unsigned char* ws;
    __device__ __forceinline__ void operator()(const f32x4 (&acc)[2][2][4][2], const pg8::Unit& u, int wr, int wc, int fr, int fq) const {
        const int pn = u.pn, tok0 = u.pm * 256, n0 = pn * 256;
        if (pn >= 21) g1_epi<5>(acc, ws, n0, tok0, wr, wc, fr, fq);
        else if (pn >= 12) g1_epi<4>(acc, ws, tok0, n0, wr, wc, fr, fq);
        else if (pn >= 8) g1_epi<3>(acc, ws, tok0, n0, wr, wc, fr, fq);
        else if (pn >= 6) g1_epi<2>(acc, ws, tok0, n0, wr, wc, fr, fq);
        else if (pn >= 4) g1_epi<1>(acc, ws, tok0, n0, wr, wc, fr, fq);
        else g1_epi<0>(acc, ws, tok0, n0, wr, wc, fr, fq);
    }
};
__device__ __forceinline__ void phase_g1(const Params& p, int layer, unsigned char* lds) {
    unsigned char* ws = launder(p.ws);
    G1Order S; S.xcd = blockIdx.x & 7; S.slot = blockIdx.x >> 3; S.per = gridDim.x >> 3;
    G1Epi E; E.ws = ws;
    pg8::gemm_phase<G1Epi, G1Order>(lds, 1024, S, E, ltid(), ws);
}

__device__ __forceinline__ void load_tile64(const bf16_t* base, size_t rowStride, unsigned char* dst, int wid, int lane) {
    const int c = ((lane & 7) ^ (lane >> 3)) * 8;
#pragma unroll
    for (int i = 0; i < 2; ++i) { const int j = wid + 4 * i, row = 8 * j + (lane >> 3); glds16(base + (size_t)row * rowStride + c, dst + j * 1024); }
}
__device__ __forceinline__ void load_tile128(const bf16_t* base, size_t rowStride, unsigned char* dst, int wid, int lane) {
    const int c = ((lane & 7) ^ (lane >> 3)) * 8;
#pragma unroll
    for (int i = 0; i < 4; ++i) { const int j = wid + 4 * i, row = 8 * j + (lane >> 3); glds16(base + (size_t)row * rowStride + c, dst + j * 1024); }
}
__device__ __forceinline__ void load_tile128w(const bf16_t* base, size_t rowStride, unsigned char* dst, int wid, int lane) {
    const int c = ((lane & 15) ^ ((4 * wid + (lane >> 4)) & 15)) * 8;
#pragma unroll
    for (int i = 0; i < 8; ++i) { const int j = wid + 4 * i, row = 4 * j + (lane >> 4); glds16(base + (size_t)row * rowStride + c, dst + j * 1024); }
}
__device__ __forceinline__ bf16x8 lds_frag128(const unsigned char* tile, int row, int chunk) {
    return *(const bf16x8*)(tile + row * 128 + ((chunk ^ (row & 7)) << 4));
}
__device__ __forceinline__ bf16x8 lds_frag256(const unsigned char* tile, int row, int chunk) {
    return *(const bf16x8*)(tile + row * 256 + ((chunk ^ (row & 15)) << 4));
}
__device__ __forceinline__ bf16x8 lds_vfrag128(const unsigned char* tile, int row, int kbase, int fq) {
    const int ca = (kbase >> 3) + (fq >> 1), hb = (fq & 1) * 8;
    const u32x2 a = *(const u32x2*)(tile + row * 128 + ((ca ^ (row & 7)) << 4) + hb);
    const u32x2 b = *(const u32x2*)(tile + row * 128 + (((ca + 2) ^ (row & 7)) << 4) + hb);
    u32x4 w; w.x = a.x; w.y = a.y; w.z = b.x; w.w = b.y;
    return __builtin_bit_cast(bf16x8, w);
}
__device__ __forceinline__ bf16x8 lds_vfrag256(const unsigned char* tile, int row, int kbase, int fq) {
    const int ca = (kbase >> 3) + (fq >> 1), hb = (fq & 1) * 8;
    const u32x2 a = *(const u32x2*)(tile + row * 256 + ((ca ^ (row & 15)) << 4) + hb);
    const u32x2 b = *(const u32x2*)(tile + row * 256 + (((ca + 2) ^ (row & 15)) << 4) + hb);
    u32x4 w; w.x = a.x; w.y = a.y; w.z = b.x; w.w = b.y;
    return __builtin_bit_cast(bf16x8, w);
}
__device__ __forceinline__ bf16x8 pack8(f32x4 a, f32x4 b) {
    u32x4 w; w.x = pack2(a[0], a[1]); w.y = pack2(a[2], a[3]); w.z = pack2(b[0], b[1]); w.w = pack2(b[2], b[3]);
    return __builtin_bit_cast(bf16x8, w);
}

__device__ __forceinline__ float gelu_tanh(float x) {
    const float u = 0.7978845608028654f * (x + 0.044715f * x * x * x);
    return 0.5f * x * (1.f + tanhf(u));
}
__device__ __forceinline__ void compress_item(const Params& p, int layer, int item, unsigned char* lds, int half) {
    unsigned char* ws = launder(p.ws);
    const int tid = (ltid() & 255), lane = tid & 63, wid = tid >> 6, wr = wid >> 1, wc = wid & 1, fr = lane & 15, fq = lane >> 4;
    const int mtile = item & 3, g = (item >> 2) & 1, b = (item >> 3) & 1, kv = item >> 4;
    const int i0 = mtile * 128;
    const bf16_t* P = (const bf16_t*)(ws + WS_P);
    const bf16_t* W1T = (const bf16_t*)(ws + WS_W1T) + (size_t)kv * 64 * 2048;
    const int col = (kv ? C_VC : C_KC) + g * 64;
    const int ldc = ((lane & 7) ^ (lane >> 3)) * 8;
    const bf16_t* ap[4];
#pragma unroll
    for (int i = 0; i < 4; ++i) ap[i] = P + ((size_t)b * S_ + 16 * (i0 + 32 * i + 8 * wid + (lane >> 3))) * LD + col + ldc;
    const bf16_t* bp[2];
#pragma unroll
    for (int i = 0; i < 2; ++i) bp[i] = W1T + (size_t)(8 * (wid + 4 * i) + (lane >> 3)) * 2048 + ldc;
    f32x4 acc[4][2];
#pragma unroll
    for (int i = 0; i < 4; ++i)
#pragma unroll
        for (int j = 0; j < 2; ++j) acc[i][j] = (f32x4){0.f, 0.f, 0.f, 0.f};
    __syncthreads();
#define CSTAGE(buf, l) do { unsigned char* st_ = lds + (buf) * 24576; \
        _Pragma("unroll") for (int i = 0; i < 4; ++i) glds16(ap[i] + (size_t)(l) * LD, st_ + (4 * i + wid) * 1024); \
        _Pragma("unroll") for (int i = 0; i < 2; ++i) glds16(bp[i] + (l) * 64, st_ + 16384 + (wid + 4 * i) * 1024); } while (0)
    CSTAGE(0, 0); CSTAGE(1, 1);
    for (int l = 0; l < 32; ++l) {
        const unsigned char* st = lds + (l % 3) * 24576;
        if (l + 1 < 32) WAIT_V(6); else WAIT_V(0);
        RAW_BARRIER();
        if (l + 2 < 32) CSTAGE((l + 2) % 3, l + 2);
#pragma unroll
        for (int ks = 0; ks < 2; ++ks) {
            bf16x8 a[4], bb[2];
#pragma unroll
            for (int i = 0; i < 4; ++i) a[i] = lds_frag128(st, 64 * wr + 16 * i + fr, 4 * ks + fq);
#pragma unroll
            for (int j = 0; j < 2; ++j) bb[j] = lds_frag128(st + 16384, 32 * wc + 16 * j + fr, 4 * ks + fq);
#pragma unroll
            for (int i = 0; i < 4; ++i)
#pragma unroll
                for (int j = 0; j < 2; ++j) acc[i][j] = mfma16(a[i], bb[j], acc[i][j]);
        }
    }
    __syncthreads();
#undef CSTAGE
    float* hid = (float*)lds;
    const float* b1 = (const float*)(ws + WS_B1) + kv * 64;
#pragma unroll
    for (int j = 0; j < 2; ++j) {
        const int n = 32 * wc + 16 * j + fr; const float bias = b1[n + vzero()];
#pragma unroll
        for (int i = 0; i < 4; ++i)
#pragma unroll
            for (int r = 0; r < 4; ++r) hid[(64 * wr + 16 * i + 4 * fq + r) * 65 + n] = gelu_tanh(acc[i][j][r] + bias);
    }
    __syncthreads();
    {
        const int row = tid >> 1, nb = (tid & 1) * 32, ci = i0 + row;
        const float* w2 = p.cmp_w2 + ((size_t)layer * 2 + kv) * 64 * 64;
        float o[32];
#pragma unroll
        for (int q = 0; q < 32; ++q) o[q] = 0.f;
        for (int n = 0; n < 64; ++n) {
            const float h = hid[row * 65 + n];
#pragma unroll
            for (int q4 = 0; q4 < 8; ++q4) { const float4 w = *(const float4*)(w2 + n * 64 + nb + 4 * q4); o[4 * q4] += h * w.x; o[4 * q4 + 1] += h * w.y; o[4 * q4 + 2] += h * w.z; o[4 * q4 + 3] += h * w.w; }
        }
        if (kv == 0) {
            bf16_t* dst = (bf16_t*)(ws + WS_KCC) + ((size_t)(b * 2 + g) * 512 + ci) * 64 + nb;
#pragma unroll
            for (int q = 0; q < 32; q += 4) { f32x4 v = {o[q], o[q + 1], o[q + 2], o[q + 3]}; if (ci >= 511) v = (f32x4){0.f, 0.f, 0.f, 0.f}; *(u32x2*)(dst + q) = pack4(v); }
        } else {
            bf16_t* dst = (bf16_t*)(ws + WS_VCCT) + ((size_t)(b * 2 + g) * 64 + nb) * 512 + ci;
#pragma unroll
            for (int q = 0; q < 32; ++q) dst[(size_t)q * 512] = f2bf(ci >= 511 ? 0.f : o[q]);
        }
    }
    __syncthreads();
}

__device__ __forceinline__ float ret_lg2(int h) { const float gam = 1.f - exp2f(-5.f - (float)h); return log2f(gam); }

__device__ __forceinline__ void retkv_item(const Params& p, int item, unsigned char* lds, int half) {
    unsigned char* ws = launder(p.ws);
    const int tid = (ltid() & 255), lane = tid & 63, wid = tid >> 6, fr = lane & 15, fq = lane >> 4;
    const int n = item & 63, h = (item >> 6) & 7, b = item >> 9;
    const size_t tok0 = (size_t)b * S_ + 128 * n;
    unsigned char* vL = lds; unsigned char* kL = lds + 32768;
    load_tile128w((const bf16_t*)(ws + WS_VRT) + ((size_t)(b * 8 + h) * 128) * S_ + 128 * n, S_, vL, wid, lane);
    load_tile128((const bf16_t*)(ws + WS_P) + tok0 * LD + C_KR + h * 64, LD, kL, wid, lane);
    wait_vm0(); __syncthreads();
    const float lg2 = ret_lg2(h);
    f32x4 acc[2][4];
#pragma unroll
    for (int m = 0; m < 2; ++m)
#pragma unroll
        for (int nt = 0; nt < 4; ++nt) acc[m][nt] = (f32x4){0.f, 0.f, 0.f, 0.f};
#pragma unroll
    for (int ks = 0; ks < 4; ++ks) {
        bf16x8 a[2], bb[4];
#pragma unroll
        for (int m = 0; m < 2; ++m) a[m] = lds_frag256(vL, 32 * wid + 16 * m + fr, 4 * ks + fq);
        float dec[8];
#pragma unroll
        for (int j = 0; j < 8; ++j) dec[j] = exp2f((float)(127 - (32 * ks + 8 * fq + j)) * lg2);
#pragma unroll
        for (int nt = 0; nt < 4; ++nt) {
            const int d = 16 * nt + fr;
            float v[8];
#pragma unroll
            for (int j = 0; j < 8; ++j) {
                const int tk = 32 * ks + 8 * fq + j;
                const bf16_t kvv = *(const bf16_t*)(kL + tk * 128 + (((d >> 3) ^ (tk & 7)) << 4) + (d & 7) * 2);
                v[j] = bf2f(kvv) * dec[j];
            }
            u32x4 w; w.x = pack2(v[0], v[1]); w.y = pack2(v[2], v[3]); w.z = pack2(v[4], v[5]); w.w = pack2(v[6], v[7]);
            bb[nt] = __builtin_bit_cast(bf16x8, w);
        }
#pragma unroll
        for (int m = 0; m < 2; ++m)
#pragma unroll
            for (int nt = 0; nt < 4; ++nt) acc[m][nt] = mfma16(a[m], bb[nt], acc[m][nt]);
    }
    float* KVT = (float*)(ws + WS_KVT) + ((size_t)(b * 8 + h) * 64 + n) * 8192;
#pragma unroll
    for (int m = 0; m < 2; ++m)
#pragma unroll
        for (int nt = 0; nt < 4; ++nt)
#pragma unroll
            for (int r = 0; r < 4; ++r) KVT[(32 * wid + 16 * m + 4 * fq + r) * 64 + 16 * nt + fr] = acc[m][nt][r];
    __syncthreads();
}

__device__ __forceinline__ void phase_p2(const Params& p, int layer, unsigned char* lds, int half) {
    const int vb = blockIdx.x * 2 + half, nvb = gridDim.x * 2;
    if (vb < 32) compress_item(p, layer, vb, lds, half);
    else for (int it = vb - 32; it < 1024; it += nvb - 32) retkv_item(p, it, lds, half);
}

constexpr int NSA_IMP = 32768, NSA_BUCKET = 65792, NSA_BIAS = 73984;

struct NsaLane { int t; int fr, fq, wid, lane; };

constexpr float LOG2E = 1.4426950408889634f;
__device__ __forceinline__ int t5_first(int bk) {
    const int th[16] = {16, 22, 30, 40, 54, 73, 99, 134, 182, 246, 332, 450, 609, 825, 1117, 1513};
    int r = 16;
#pragma unroll
    for (int k = 0; k < 16; ++k) r = (bk == 16 + k) ? th[k] : r;
    return r;
}
template <int BR, int PASS>
__device__ __forceinline__ void nsa_half(const unsigned char* kL, const unsigned char* vL, const unsigned char* lds, const bf16x8 (&qptr)[4][2],
                                         f32x4 (&O)[4][4], float (&m)[4], float (&l)[4], int tile, int hf, const NsaLane& L, int qrow, const bool FAST, int th, int b0, int b1) {
    const int fr = L.lane & 15, fq = L.lane >> 4;
    constexpr float C2 = 0.125f * LOG2E;
    bf16x8 Kf[2][2];
#pragma unroll
    for (int i = 0; i < 2; ++i)
#pragma unroll
        for (int ks = 0; ks < 2; ++ks) Kf[i][ks] = lds_frag128(kL, 32 * hf + 16 * i + fr, 4 * ks + fq);
    bf16x8 Vf[4];
    if (PASS != 0) {
#pragma unroll
        for (int mt = 0; mt < 4; ++mt) Vf[mt] = lds_vfrag128(vL, 16 * mt + fr, 32 * hf, fq);
    }
    unsigned vmask = 0; unsigned bk[2] = {0u, 0u}; bool hi[2][4];
    if (!FAST) {
        const unsigned char* bucketL = lds + NSA_BUCKET;
#pragma unroll
        for (int i = 0; i < 2; ++i) {
            unsigned pk = 0;
#pragma unroll
            for (int r = 0; r < 4; ++r) {
                const int kk = 32 * hf + 16 * i + 4 * fq + r;
                int rel; bool ok;
                if (BR == 0) { rel = L.t - (16 * (64 * tile + kk) + 31); ok = rel >= 0; }
                else { rel = L.t - (64 * tile + kk); ok = rel >= 0 && rel < 512; }
                int rc = rel < 0 ? 0 : rel; rc = rc > 8191 ? 8191 : rc;
                pk |= (unsigned)bucketL[rc] << (8 * r);
                vmask |= (ok ? 1u : 0u) << (4 * i + r);
                hi[i][r] = false;
            }
            bk[i] = pk;
        }
    } else {
        const int kbase = 64 * tile + 32 * hf + 4 * fq;
        const int lim = BR == 0 ? L.t - th - 31 - 16 * kbase : L.t - th - kbase;
#pragma unroll
        for (int i = 0; i < 2; ++i)
#pragma unroll
            for (int r = 0; r < 4; ++r) hi[i][r] = (BR == 0 ? 16 : 1) * (16 * i + r) <= lim;
    }
    const float* biasL = (const float*)(lds + NSA_BIAS);
    float ia[2] = {0.f, 0.f}, ic[2] = {0.f, 0.f};
#pragma unroll
    for (int nt = 0; nt < 4; ++nt) {
        f32x4 S[2];
        const bf16x8 q0 = qptr[nt][0], q1 = qptr[nt][1];
#pragma unroll
        for (int i = 0; i < 2; ++i) {
            S[i] = (f32x4){0.f, 0.f, 0.f, 0.f};
            S[i] = mfma16(Kf[i][0], q0, S[i]); S[i] = mfma16(Kf[i][1], q1, S[i]);
        }
        float tmax = -1e30f;
        if (!FAST) {
#pragma unroll
            for (int i = 0; i < 2; ++i) {
                float bsv[4];
#pragma unroll
                for (int r = 0; r < 4; ++r) bsv[r] = biasL[nt * 32 + ((bk[i] >> (8 * r)) & 0xffu)];
                asm volatile("" : "+v"(bsv[0]), "+v"(bsv[1]), "+v"(bsv[2]), "+v"(bsv[3]));
#pragma unroll
                for (int r = 0; r < 4; ++r) {
                    const bool ok = (vmask >> (4 * i + r)) & 1u;
                    const float sv = S[i][r] * C2 + bsv[r];
                    S[i][r] = ok ? sv : -1e30f; tmax = fmaxf(tmax, S[i][r]);
                }
            }
        } else {
            const float blo = biasL[nt * 32 + b0], bhi = biasL[nt * 32 + b1];
#pragma unroll
            for (int i = 0; i < 2; ++i)
#pragma unroll
                for (int r = 0; r < 4; ++r) { S[i][r] = S[i][r] * C2 + (hi[i][r] ? bhi : blo); tmax = fmaxf(tmax, S[i][r]); }
        }
        if (PASS != 1) {
            if (__builtin_amdgcn_ballot_w64(tmax > m[nt] + 8.f) != 0ull) {
                const float tm = rows_max(tmax);
                const float mnew = tm > m[nt] + 8.f ? tm : m[nt], alpha = __builtin_amdgcn_exp2f(m[nt] - mnew);
                l[nt] *= alpha; m[nt] = mnew;
                if (PASS == 2) {
#pragma unroll
                    for (int mt = 0; mt < 4; ++mt) O[mt][nt] = O[mt][nt] * alpha;
                }
            }
            float psum = 0.f;
#pragma unroll
            for (int i = 0; i < 2; ++i)
#pragma unroll
                for (int r = 0; r < 4; ++r) S[i][r] = __builtin_amdgcn_exp2f(S[i][r] - m[nt]);
            if (!FAST) {
#pragma unroll
                for (int i = 0; i < 2; ++i)
#pragma unroll
                    for (int r = 0; r < 4; ++r) { const bool ok = (vmask >> (4 * i + r)) & 1u; S[i][r] = ok ? S[i][r] : 0.f; }
            }
#pragma unroll
            for (int i = 0; i < 2; ++i)
#pragma unroll
                for (int r = 0; r < 4; ++r) psum += S[i][r];
            l[nt] += psum;
        } else {
#pragma unroll
            for (int i = 0; i < 2; ++i) {
#pragma unroll
                for (int r = 0; r < 4; ++r) S[i][r] = __builtin_amdgcn_exp2f(S[i][r] - m[nt]) * l[nt];
            }
            if (!FAST) {
#pragma unroll
                for (int i = 0; i < 2; ++i)
#pragma unroll
                    for (int r = 0; r < 4; ++r) { const bool ok = (vmask >> (4 * i + r)) & 1u; S[i][r] = ok ? S[i][r] : 0.f; }
            }
#pragma unroll
            for (int i = 0; i < 2; ++i) {
                ia[i] += S[i][0] + S[i][1] + S[i][2] + 0.5f * S[i][3];
                ic[i] += 0.5f * S[i][3];
            }
        }
        if (PASS != 0) {
            const bf16x8 Pb = pack8(S[0], S[1]);
#pragma unroll
            for (int mt = 0; mt < 4; ++mt) O[mt][nt] = mfma16(Vf[mt], Pb, O[mt][nt]);
        }
        if (nt & 1) __builtin_amdgcn_sched_barrier(0);
    }
    if (PASS == 1) {
        float* imp = (float*)(lds + NSA_IMP) + qrow * 129;
        asm volatile("" ::: "memory"); __builtin_amdgcn_wave_barrier();
#pragma unroll
        for (int i = 0; i < 2; ++i) { const int j = 16 * tile + 8 * hf + 4 * i + fq; imp[j] += ia[i]; }
        asm volatile("s_waitcnt lgkmcnt(0)" ::: "memory"); __builtin_amdgcn_wave_barrier();
#pragma unroll
        for (int i = 0; i < 2; ++i) { const int j = 16 * tile + 8 * hf + 4 * i + fq + 1; if (j < 128) imp[j] += ic[i]; }
        asm volatile("s_waitcnt lgkmcnt(0)" ::: "memory"); __builtin_amdgcn_wave_barrier();
    }
}
template <int BR, int PASS>
__device__ __forceinline__ void nsa_tile(const unsigned char* kL, const unsigned char* vL, const unsigned char* lds, const bf16x8 (&qptr)[4][2],
                                         f32x4 (&O)[4][4], float (&m)[4], float (&l)[4], int tile, const NsaLane& L, int qrow) {
    const int tq0 = __builtin_amdgcn_readfirstlane(L.t - (L.lane & 15));
#pragma unroll 1
    for (int hf = 0; hf < 2; ++hf) {
        const int kfirst = 64 * tile + 32 * hf, pmin = BR == 0 ? 16 * kfirst + 31 : kfirst, pmax = BR == 0 ? 16 * (kfirst + 31) + 31 : kfirst + 31;
        const int rmin = tq0 - pmax, rmax = tq0 + 15 - pmin;
        bool fast = false; int th = 0, b0 = 0, b1 = 0;
        if (rmin >= 16 && (BR != 2 || rmax < 512)) {
            const unsigned char* bucketL = lds + NSA_BUCKET;
            b0 = __builtin_amdgcn_readfirstlane((int)bucketL[rmin]); b1 = __builtin_amdgcn_readfirstlane((int)bucketL[rmax > 8191 ? 8191 : rmax]);
            if (b1 - b0 <= 1) { fast = true; th = b1 == b0 ? 0 : t5_first(b1); }
        }
        nsa_half<BR, PASS>(kL, vL, lds, qptr, O, m, l, tile, hf, L, qrow, fast, th, b0, b1);
    }
}

__device__ __forceinline__ void cmp_item(const Params& p, int item, unsigned char* lds, int half) {
    unsigned char* ws = launder(p.ws);
    const int tid = (ltid() & 255), lane = tid & 63, wid = tid >> 6, fr = lane & 15, fq = lane >> 4;
    const int combo = item & 3, qt = 127 - (item >> 2), b = combo >> 1, g = combo & 1;
    const int q0 = qt * 64, qrow = 16 * wid + fr;
    NsaLane L; L.t = q0 + qrow; L.fr = fr; L.fq = fq; L.wid = wid; L.lane = lane;
    const size_t tok = (size_t)b * S_ + L.t;
    const bf16_t* P = (const bf16_t*)(ws + WS_P);
    __syncthreads();
    if (tid < 128) ((float*)(lds + NSA_BIAS))[tid] = p.rel_bias[(tid & 31) * 8 + 4 * g + (tid >> 5)] * LOG2E;
    for (int i = tid; i < 64 * 129; i += HT) ((float*)(lds + NSA_IMP))[i] = 0.f;
    bf16x8 Qf[4][2];
#pragma unroll
    for (int nt = 0; nt < 4; ++nt)
#pragma unroll
        for (int ks = 0; ks < 2; ++ks) Qf[nt][ks] = *(const bf16x8*)(P + tok * LD + C_QA + (4 * g + nt) * 64 + 32 * ks + 8 * fq);
    __syncthreads();
    f32x4 O[4][4]; float m[4], l[4];
    const bf16_t* gates = P + tok * LD + C_GA + (4 * g) * 3;
    const bf16_t* kc = (const bf16_t*)(ws + WS_KCC) + (size_t)(b * 2 + g) * 512 * 64;
    const bf16_t* vc = (const bf16_t*)(ws + WS_VCCT) + (size_t)(b * 2 + g) * 64 * 512;
    const int ntc = ((q0 + 32) >> 4) / 64 + 1;
#pragma unroll
    for (int nt = 0; nt < 4; ++nt) { m[nt] = -1e30f; l[nt] = 0.f; }
    load_tile64(kc, 64, lds, wid, lane);
    wait_vm0(); __syncthreads();
    for (int it = 0; it < ntc; ++it) {
        unsigned char* cur = lds + (it & 1) * 16384;
        if (it + 1 < ntc) load_tile64(kc + (size_t)(it + 1) * 64 * 64, 64, lds + ((it + 1) & 1) * 16384, wid, lane);
        nsa_tile<0, 0>(cur, cur + 8192, lds, Qf, O, m, l, it, L, qrow);
        wait_vm0(); __syncthreads();
    }
#pragma unroll
    for (int nt = 0; nt < 4; ++nt) { l[nt] = rows_sum(l[nt]); l[nt] = l[nt] > 0.f ? 1.f / l[nt] : 0.f; }
#pragma unroll
    for (int mt = 0; mt < 4; ++mt)
#pragma unroll
        for (int nt = 0; nt < 4; ++nt) O[mt][nt] = (f32x4){0.f, 0.f, 0.f, 0.f};
    load_tile64(kc, 64, lds, wid, lane); load_tile64(vc, 512, lds + 8192, wid, lane);
    wait_vm0(); __syncthreads();
    for (int it = 0; it < ntc; ++it) {
        unsigned char* cur = lds + (it & 1) * 16384;
        if (it + 1 < ntc) { unsigned char* nx = lds + ((it + 1) & 1) * 16384;
            load_tile64(kc + (size_t)(it + 1) * 64 * 64, 64, nx, wid, lane); load_tile64(vc + (it + 1) * 64, 512, nx + 8192, wid, lane); }
        nsa_tile<0, 1>(cur, cur + 8192, lds, Qf, O, m, l, it, L, qrow);
        wait_vm0(); __syncthreads();
    }
    bf16_t* YC = (bf16_t*)(ws + WS_YC) + tok * 512 + (4 * g) * 64;
#pragma unroll
    for (int nt = 0; nt < 4; ++nt) {
        const float gt = bf2f(gates[nt * 3 + 0]);
#pragma unroll
        for (int mt = 0; mt < 4; ++mt) *(u32x2*)(YC + nt * 64 + 16 * mt + 4 * fq) = pack4(O[mt][nt] * gt);
    }
    const int cur = qt;
    {
        float* imp = (float*)(lds + NSA_IMP) + qrow * 129 + 32 * fq;
        asm volatile("s_waitcnt lgkmcnt(0)" ::: "memory"); __builtin_amdgcn_wave_barrier();
#pragma unroll
        for (int i = 0; i < 32; ++i) {
            const int j = 32 * fq + i;
            const float v = imp[i];
            imp[i] = j > cur ? -1.f : v + ((j == 0 || j == cur || j == cur - 1) ? 1.0e4f : 0.f);
        }
        unsigned word = 0;
#pragma unroll 1
        for (int round = 0; round < 16; ++round) {
            float bv = imp[0]; int bi = 0;
#pragma unroll
            for (int i = 1; i < 32; ++i) { const float v = imp[i]; if (v > bv) { bv = v; bi = i; } }
            int gi = 32 * fq + bi;
            {
                u32x2 rv = __builtin_amdgcn_permlane16_swap(__float_as_uint(bv), __float_as_uint(bv), false, false);
                u32x2 ri = __builtin_amdgcn_permlane16_swap((unsigned)gi, (unsigned)gi, false, false);
                float v0 = __uint_as_float(rv.x), v1 = __uint_as_float(rv.y); int i0 = (int)ri.x, i1 = (int)ri.y;
                if (v1 > v0 || (v1 == v0 && i1 < i0)) { v0 = v1; i0 = i1; }
                rv = __builtin_amdgcn_permlane32_swap(__float_as_uint(v0), __float_as_uint(v0), false, false);
                ri = __builtin_amdgcn_permlane32_swap((unsigned)i0, (unsigned)i0, false, false);
                v0 = __uint_as_float(rv.x); v1 = __uint_as_float(rv.y); i0 = (int)ri.x; i1 = (int)ri.y;
                if (v1 > v0 || (v1 == v0 && i1 < i0)) { v0 = v1; i0 = i1; }
                bv = v0; gi = i0;
            }
            if (bv >= 0.f && (gi >> 5) == fq) { word |= 1u << (gi & 31); imp[gi & 31] = -2.f; }
        }
        ((unsigned*)(ws + WS_SELW))[(tok * 2 + g) * 4 + fq] = word;
    }
}

__device__ __forceinline__ void win_item(const Params& p, int item, unsigned char* lds, int half) {
    unsigned char* ws = launder(p.ws);
    const int tid = (ltid() & 255), lane = tid & 63, wid = tid >> 6, fr = lane & 15, fq = lane >> 4;
    const int combo = item & 3, qt = 127 - (item >> 2), b = combo >> 1, g = combo & 1;
    const int q0 = qt * 64, qrow = 16 * wid + fr;
    NsaLane L; L.t = q0 + qrow; L.fr = fr; L.fq = fq; L.wid = wid; L.lane = lane;
    const size_t tok = (size_t)b * S_ + L.t;
    const bf16_t* P = (const bf16_t*)(ws + WS_P);
    __syncthreads();
    if (tid < 128) ((float*)(lds + NSA_BIAS))[tid] = p.rel_bias[(tid & 31) * 8 + 4 * g + (tid >> 5)] * LOG2E;
    bf16x8 Qf[4][2];
#pragma unroll
    for (int nt = 0; nt < 4; ++nt)
#pragma unroll
        for (int ks = 0; ks < 2; ++ks) Qf[nt][ks] = *(const bf16x8*)(P + tok * LD + C_QA + (4 * g + nt) * 64 + 32 * ks + 8 * fq);
    __syncthreads();
    f32x4 O[4][4]; float m[4], l[4];
    const bf16_t* gates = P + tok * LD + C_GA + (4 * g) * 3;
#pragma unroll
    for (int nt = 0; nt < 4; ++nt) { m[nt] = -1e30f; l[nt] = 0.f; }
#pragma unroll
    for (int mt = 0; mt < 4; ++mt)
#pragma unroll
        for (int nt = 0; nt < 4; ++nt) O[mt][nt] = (f32x4){0.f, 0.f, 0.f, 0.f};
    {
        const bf16_t* kb = P + ((size_t)b * S_) * LD + C_KW + g * 64;
        const bf16_t* vb = (const bf16_t*)(ws + WS_VWT) + (size_t)(b * 2 + g) * 64 * S_;
        const int k_lo = qt - 8 > 0 ? qt - 8 : 0, ntw = qt - k_lo + 1;
        load_tile64(kb + (size_t)k_lo * 64 * LD, LD, lds, wid, lane); load_tile64(vb + k_lo * 64, S_, lds + 8192, wid, lane);
        wait_vm0(); __syncthreads();
        for (int it = 0; it < ntw; ++it) {
            unsigned char* cu = lds + (it & 1) * 16384;
            if (it + 1 < ntw) { unsigned char* nx = lds + ((it + 1) & 1) * 16384;
                load_tile64(kb + (size_t)(k_lo + it + 1) * 64 * LD, LD, nx, wid, lane); load_tile64(vb + (k_lo + it + 1) * 64, S_, nx + 8192, wid, lane); }
            nsa_tile<2, 2>(cu, cu + 8192, lds, Qf, O, m, l, k_lo + it, L, qrow);
            wait_vm0(); __syncthreads();
        }
    }
    bf16_t* YW = (bf16_t*)(ws + WS_YW) + tok * 512 + (4 * g) * 64;
#pragma unroll
    for (int nt = 0; nt < 4; ++nt) {
        const float lt = rows_sum(l[nt]), gt = bf2f(gates[nt * 3 + 2]) * (lt > 0.f ? 1.f / lt : 0.f);
#pragma unroll
        for (int mt = 0; mt < 4; ++mt) *(u32x2*)(YW + nt * 64 + 16 * mt + 4 * fq) = pack4(O[mt][nt] * gt);
    }
}

constexpr int SEL_RING = 8, SEL_BUCKET = SEL_RING * 16384, SEL_BIAS2 = SEL_BUCKET + 8192;
template <bool FAST>
__device__ __forceinline__ void sel_ntile(const bf16x8 (&Kf)[4][2], const unsigned char* vL, int fr, int fq, const bf16x8& q0, const bf16x8& q1, f32x4 (&O)[4], float& m, float& l,
                                          bool sb, int relb, int th, float blo, float bhi, const unsigned char* lds, int hl) {
    f32x4 S[4];
#pragma unroll
    for (int i = 0; i < 4; ++i) { S[i] = (f32x4){0.f, 0.f, 0.f, 0.f}; S[i] = mfma16(Kf[i][0], q0, S[i]); S[i] = mfma16(Kf[i][1], q1, S[i]); }
    float tmax = -1e30f;
    const float scl = (!FAST || sb) ? 0.125f * LOG2E : 0.f;
    if (FAST) { blo = (sb ? blo : -1e30f) - m; bhi = (sb ? bhi : -1e30f) - m; }
    if (FAST) {
#pragma unroll
        for (int i = 0; i < 4; ++i)
#pragma unroll
            for (int r = 0; r < 4; ++r) { const int rel = relb - (16 * i + r); S[i][r] = S[i][r] * scl + (rel >= th ? bhi : blo); tmax = fmaxf(tmax, S[i][r]); }
    } else {
        unsigned bkt[4][4]; float bs[4][4];
#pragma unroll
        for (int i = 0; i < 4; ++i)
#pragma unroll
            for (int r = 0; r < 4; ++r) { const int rel = relb - (16 * i + r); int rc = rel < 0 ? 0 : rel; rc = rc > 8191 ? 8191 : rc; bkt[i][r] = (lds + SEL_BUCKET)[rc]; }
#pragma unroll
        for (int i = 0; i < 4; ++i)
#pragma unroll
            for (int r = 0; r < 4; ++r) bs[i][r] = ((const float*)(lds + SEL_BIAS2))[hl * 32 + bkt[i][r]];
        asm volatile("" : "+v"(bs[0][0]), "+v"(bs[0][1]), "+v"(bs[0][2]), "+v"(bs[0][3]), "+v"(bs[1][0]), "+v"(bs[1][1]), "+v"(bs[1][2]), "+v"(bs[1][3]),
                          "+v"(bs[2][0]), "+v"(bs[2][1]), "+v"(bs[2][2]), "+v"(bs[2][3]), "+v"(bs[3][0]), "+v"(bs[3][1]), "+v"(bs[3][2]), "+v"(bs[3][3]));
        const float ninf = -1e30f;
#pragma unroll
        for (int i = 0; i < 4; ++i)
#pragma unroll
            for (int r = 0; r < 4; ++r) {
                const int rel = relb - (16 * i + r);
                const float sv = S[i][r] * (0.125f * LOG2E) + (bs[i][r] - m);
                S[i][r] = (sb && rel >= 0) ? sv : ninf; tmax = fmaxf(tmax, S[i][r]);
            }
    }
    tmax = rows_max(tmax);
    if (__ballot(tmax > 8.f) != 0ull) {
        const float d = fmaxf(tmax, 0.f), alpha = __builtin_amdgcn_exp2f(-d);
        m += d; l *= alpha;
#pragma unroll
        for (int mt = 0; mt < 4; ++mt) O[mt] = O[mt] * alpha;
#pragma unroll
        for (int i = 0; i < 4; ++i)
#pragma unroll
            for (int r = 0; r < 4; ++r) S[i][r] -= d;
    }
    float psum = 0.f;
#pragma unroll
    for (int i = 0; i < 4; ++i)
#pragma unroll
        for (int r = 0; r < 4; ++r) { const float pv = __builtin_amdgcn_exp2f(S[i][r]); S[i][r] = pv; psum += pv; }
    l += rows_sum(psum);
    const bf16x8 Pb0 = pack8(S[0], S[1]), Pb1 = pack8(S[2], S[3]);
#pragma unroll
    for (int mt = 0; mt < 4; ++mt) { O[mt] = mfma16(lds_vfrag128(vL, 16 * mt + fr, 0, fq), Pb0, O[mt]); O[mt] = mfma16(lds_vfrag128(vL, 16 * mt + fr, 32, fq), Pb1, O[mt]); }
}
__device__ __forceinline__ void sel_ntile2_fast(const bf16x8 (&Kf)[4][2], const unsigned char* vL, int fr, int fq, const bf16x8 (&Qf)[2][2], f32x4 (&O)[2][4], float (&m)[2], float (&l)[2],
                                                const bool (&sb)[2], const int (&relb)[2], int th, float blo, float bhi) {
    f32x4 S[2][4]; float tmax[2], bl[2], bh[2], scl[2];
#pragma unroll
    for (int b = 0; b < 2; ++b)
#pragma unroll
        for (int i = 0; i < 4; ++i) { S[b][i] = (f32x4){0.f, 0.f, 0.f, 0.f}; S[b][i] = mfma16(Kf[i][0], Qf[b][0], S[b][i]); S[b][i] = mfma16(Kf[i][1], Qf[b][1], S[b][i]); }
#pragma unroll
    for (int b = 0; b < 2; ++b) { scl[b] = sb[b] ? 0.125f * LOG2E : 0.f; bl[b] = (sb[b] ? blo : -1e30f) - m[b]; bh[b] = (sb[b] ? bhi : -1e30f) - m[b]; tmax[b] = -1e30f; }
#pragma unroll
    for (int b = 0; b < 2; ++b)
#pragma unroll
        for (int i = 0; i < 4; ++i)
#pragma unroll
            for (int r = 0; r < 4; ++r) { const int rel = relb[b] - (16 * i + r); S[b][i][r] = S[b][i][r] * scl[b] + (rel >= th ? bh[b] : bl[b]); tmax[b] = fmaxf(tmax[b], S[b][i][r]); }
#pragma unroll
    for (int b = 0; b < 2; ++b) tmax[b] = rows_max(tmax[b]);
    if (__ballot(tmax[0] > 8.f || tmax[1] > 8.f) != 0ull) {
#pragma unroll
        for (int b = 0; b < 2; ++b) {
            const float d = fmaxf(tmax[b], 0.f), alpha = __builtin_amdgcn_exp2f(-d);
            m[b] += d; l[b] *= alpha;
#pragma unroll
            for (int mt = 0; mt < 4; ++mt) O[b][mt] = O[b][mt] * alpha;
#pragma unroll
            for (int i = 0; i < 4; ++i)
#pragma unroll
                for (int r = 0; r < 4; ++r) S[b][i][r] -= d;
        }
    }
    float psum[2] = {0.f, 0.f};
#pragma unroll
    for (int b = 0; b < 2; ++b)
#pragma unroll
        for (int i = 0; i < 4; ++i)
#pragma unroll
            for (int r = 0; r < 4; ++r) { const float pv = __builtin_amdgcn_exp2f(S[b][i][r]); S[b][i][r] = pv; psum[b] += pv; }
#pragma unroll
    for (int b = 0; b < 2; ++b) l[b] += rows_sum(psum[b]);
    bf16x8 P0[2], P1[2];
#pragma unroll
    for (int b = 0; b < 2; ++b) { P0[b] = pack8(S[b][0], S[b][1]); P1[b] = pack8(S[b][2], S[b][3]); }
#pragma unroll
    for (int mt = 0; mt < 4; ++mt) {
        const bf16x8 v0 = lds_vfrag128(vL, 16 * mt + fr, 0, fq), v1 = lds_vfrag128(vL, 16 * mt + fr, 32, fq);
#pragma unroll
        for (int b = 0; b < 2; ++b) { O[b][mt] = mfma16(v0, P0[b], O[b][mt]); O[b][mt] = mfma16(v1, P1[b], O[b][mt]); }
    }
}
template <bool FAST>
__device__ __forceinline__ void sel_tile(const unsigned char* kL, const unsigned char* vL, const unsigned char* lds, const bf16x8 (&Qf)[2][2], f32x4 (&O)[2][4], float (&m)[2], float (&l)[2],
                                         const bool (&sb)[2], const bool (&need)[2], const int (&relb)[2], int th, float blo, float bhi, int hl, int fr, int fq) {
    bf16x8 Kf[4][2];
#pragma unroll
    for (int i = 0; i < 4; ++i)
#pragma unroll
        for (int ks = 0; ks < 2; ++ks) Kf[i][ks] = lds_frag128(kL, 16 * i + fr, 4 * ks + fq);
    if (FAST && need[0] && need[1]) { sel_ntile2_fast(Kf, vL, fr, fq, Qf, O, m, l, sb, relb, th, blo, bhi); return; }
    if (need[0]) sel_ntile<FAST>(Kf, vL, fr, fq, Qf[0][0], Qf[0][1], O[0], m[0], l[0], sb[0], relb[0], th, blo, bhi, lds, hl);
    if (need[1]) sel_ntile<FAST>(Kf, vL, fr, fq, Qf[1][0], Qf[1][1], O[1], m[1], l[1], sb[1], relb[1], th, blo, bhi, lds, hl);
}
template <int VAR>
__device__ __forceinline__ void sel_item(const Params& p, int v, unsigned char* lds) {
    unsigned char* ws = launder(p.ws);
    const int tid = ltid(), lane = tid & 63, wid = tid >> 6, fr = lane & 15, fq = lane >> 4;
    const int qt = 127 - (v >> 2), sub = v & 3, b = sub >> 1, g = sub & 1;
    const int q0 = qt * 64, cur = qt, hl = fr & 3;
    const bf16_t* P = (const bf16_t*)(ws + WS_P);
    __syncthreads();
    if (tid < 128) ((float*)(lds + SEL_BIAS2))[tid] = p.rel_bias[(tid & 31) * 8 + 4 * g + (tid >> 5)] * LOG2E;
    int t[2]; size_t tok[2]; bf16x8 Qf[2][2]; unsigned selw[2][4];
#pragma unroll
    for (int nt = 0; nt < 2; ++nt) {
        t[nt] = q0 + 8 * wid + 4 * nt + (fr >> 2); tok[nt] = (size_t)b * S_ + t[nt];
#pragma unroll
        for (int ks = 0; ks < 2; ++ks) Qf[nt][ks] = *(const bf16x8*)(P + tok[nt] * LD + C_QA + (4 * g + hl) * 64 + 32 * ks + 8 * fq);
        const u32x4 w = *(const u32x4*)((const unsigned*)(ws + WS_SELW) + (tok[nt] * 2 + g) * 4);
        selw[nt][0] = w.x; selw[nt][1] = w.y; selw[nt][2] = w.z; selw[nt][3] = w.w;
    }
    f32x4 O[2][4]; float m[2], l[2];
#pragma unroll
    for (int nt = 0; nt < 2; ++nt) { m[nt] = -1000.f; l[nt] = 0.f;
#pragma unroll
        for (int mt = 0; mt < 4; ++mt) O[nt][mt] = (f32x4){0.f, 0.f, 0.f, 0.f}; }
    const bf16_t* kb = P + ((size_t)b * S_) * LD + C_KS + g * 64;
    const bf16_t* vb = (const bf16_t*)(ws + WS_VST) + (size_t)(b * 2 + g) * 64 * S_;
    const int nts = cur + 1;
#define SEL_ISSUE(jj) do { unsigned char* st_ = lds + ((jj) & 7) * 16384; const int c_ = ((lane & 7) ^ (lane >> 3)) * 8, r_ = 8 * wid + (lane >> 3); \
        glds16(kb + ((size_t)(jj) * 64 + r_) * LD + c_, st_ + wid * 1024); glds16(vb + (size_t)r_ * S_ + (jj) * 64 + c_, st_ + 8192 + wid * 1024); } while (0)
    asm volatile("s_waitcnt vmcnt(0)" ::: "memory");
#pragma unroll
    for (int q = 0; q < 4; ++q) if (q < nts) SEL_ISSUE(q);
    const unsigned char* bucketL = lds + SEL_BUCKET;
    for (int jp = 0; jp < nts; jp += 4) {
        WAIT_V(0);
        RAW_BARRIER();
#pragma unroll
        for (int q = 4; q < 8; ++q) if (jp + q < nts) SEL_ISSUE(jp + q);
#pragma unroll 1
      for (int j = jp; j < jp + 4 && j < nts; ++j) {
        const unsigned char* cu = lds + (j & 7) * 16384;
        bool sb[2], need[2]; int relb[2];
#pragma unroll
        for (int nt = 0; nt < 2; ++nt) {
            const unsigned w = j < 32 ? selw[nt][0] : j < 64 ? selw[nt][1] : j < 96 ? selw[nt][2] : selw[nt][3];
            sb[nt] = (w >> (j & 31)) & 1u; need[nt] = __ballot(sb[nt]) != 0ull; relb[nt] = t[nt] - 64 * j - 4 * fq;
        }
        if (VAR == 1) { need[0] = false; need[1] = false; }
        if (VAR == 2) { if (!(need[0] || need[1])) { need[0] = false; } else { need[0] = true; need[1] = true; } }
        if (need[0] || need[1]) {
            const int rmin = q0 - 64 * j - 63, rmax = q0 + 31 - 64 * j;
            bool fast = false; int th = 0; float blo = 0.f, bhi = 0.f;
            if (rmin >= 16) {
                const int b0 = bucketL[rmin], b1 = bucketL[rmax > 8191 ? 8191 : rmax];
                if (b1 - b0 <= 1) { fast = true; th = t5_first(b1); if (b1 == b0) th = 0;
                    blo = ((const float*)(lds + SEL_BIAS2))[hl * 32 + b0]; bhi = ((const float*)(lds + SEL_BIAS2))[hl * 32 + b1]; }
            }
            if (fast) sel_tile<true>(cu, cu + 8192, lds, Qf, O, m, l, sb, need, relb, th, blo, bhi, hl, fr, fq);
            else sel_tile<false>(cu, cu + 8192, lds, Qf, O, m, l, sb, need, relb, th, blo, bhi, hl, fr, fq);
        }
      }
    }
#undef SEL_ISSUE
    __syncthreads();
#pragma unroll
    for (int nt = 0; nt < 2; ++nt) {
        const float gt = bf2f(P[tok[nt] * LD + C_GA + (4 * g + hl) * 3 + 1]) * (l[nt] > 0.f ? 1.f / l[nt] : 0.f);
        const size_t o = tok[nt] * 512 + (4 * g + hl) * 64;
#pragma unroll
        for (int mt = 0; mt < 4; ++mt) {
            const f32x4 yc = unpack4(*(const u32x2*)((const bf16_t*)(ws + WS_YC) + o + 16 * mt + 4 * fq));
            const f32x4 yw = unpack4(*(const u32x2*)((const bf16_t*)(ws + WS_YW) + o + 16 * mt + 4 * fq));
            if (VAR == 0 || VAR == 3) *(u32x2*)((bf16_t*)(ws + WS_YA) + tok[nt] * 1536 + (4 * g + hl) * 64 + 16 * mt + 4 * fq) = pack4(yc + yw + O[nt][mt] * gt);
            else asm volatile("" :: "v"(O[nt][mt]));
        }
    }
}

__device__ __forceinline__ void scan_item(const Params& p, int item, int half) {
    unsigned char* ws = launder(p.ws);
    const int idx = item * HT + (ltid() & 255);
    const int bh = idx >> 13, ed = idx & 8191, h = bh & 7;
    const float dec = exp2f(128.f * ret_lg2(h));
    const float* KVT = (const float*)(ws + WS_KVT) + (size_t)bh * 64 * 8192 + ed;
    bf16_t* SPT = (bf16_t*)(ws + WS_SPT) + (size_t)bh * 64 * 8192 + ed;
    float s = 0.f;
    for (int n = 0; n < 64; ++n) { SPT[(size_t)n * 8192] = f2bf(s); s = s * dec + KVT[(size_t)n * 8192]; }
}

__device__ __forceinline__ void phase_p3(const Params& p, unsigned char* lds, int half, int what) {
    for (int i = (ltid() & 255); i < 8192 / 16; i += HT) ((u32x4*)(lds + NSA_BUCKET))[i] = ((const u32x4*)(launder(p.ws) + WS_BUCKET))[i];
    __syncthreads();
    for (int h = (blockIdx.x * 2 + half); h < 512; h += (gridDim.x * 2)) {
        if (what & 1) cmp_item(p, h, lds, half);
        if (what & 2) {
            if (h >= 128 && h < 384) win_item(p, h - 128, lds, half);
            else if (h >= 384) { win_item(p, 256 + 2 * (h - 384) - ((h & 1) ? 1 : 0) , lds, half); win_item(p, 256 + 2 * (h - 384) + ((h & 1) ? 0 : 1) + 1 - ((h & 1) ? 0 : 0), lds, half); }
        }
        if (what & 4) scan_item(p, h, half);
    }
}

__device__ __forceinline__ void retout_item(const Params& p, int item, unsigned char* lds, int half) {
    unsigned char* ws = launder(p.ws);
    const int tid = (ltid() & 255), lane = tid & 63, wid = tid >> 6, fr = lane & 15, fq = lane >> 4;
    const int n = item & 63, h = (item >> 6) & 7, b = item >> 9;
    const size_t tok0 = (size_t)b * S_ + 128 * n;
    const bf16_t* P = (const bf16_t*)(ws + WS_P);
    unsigned char* vL = lds; unsigned char* kL = lds + 32768; unsigned char* sL = lds + 49152;
    __syncthreads();
    load_tile128w((const bf16_t*)(ws + WS_VRT) + ((size_t)(b * 8 + h) * 128) * S_ + 128 * n, S_, vL, wid, lane);
    load_tile128(P + tok0 * LD + C_KR + h * 64, LD, kL, wid, lane);
    load_tile128((const bf16_t*)(ws + WS_SPT) + ((size_t)(b * 8 + h) * 64 + n) * 8192, 64, sL, wid, lane);
    bf16x8 Qf[2][2];
#pragma unroll
    for (int nt = 0; nt < 2; ++nt)
#pragma unroll
        for (int ks = 0; ks < 2; ++ks) Qf[nt][ks] = *(const bf16x8*)(P + (tok0 + 32 * wid + 16 * nt + fr) * LD + C_QR + h * 64 + 32 * ks + 8 * fq);
    wait_vm0(); __syncthreads();
    const float lg2 = ret_lg2(h);
    f32x4 Y[8][2];
#pragma unroll
    for (int m = 0; m < 8; ++m)
#pragma unroll
        for (int nt = 0; nt < 2; ++nt) Y[m][nt] = (f32x4){0.f, 0.f, 0.f, 0.f};
#pragma unroll
    for (int m = 0; m < 8; ++m)
#pragma unroll
        for (int ks = 0; ks < 2; ++ks) {
            const bf16x8 a = lds_frag128(sL, 16 * m + fr, 4 * ks + fq);
#pragma unroll
            for (int nt = 0; nt < 2; ++nt) Y[m][nt] = mfma16(a, Qf[nt][ks], Y[m][nt]);
        }
#pragma unroll
    for (int nt = 0; nt < 2; ++nt) {
        const float sc = exp2f((float)(32 * wid + 16 * nt + fr + 1) * lg2);
#pragma unroll
        for (int m = 0; m < 8; ++m) Y[m][nt] = Y[m][nt] * sc;
    }
#pragma unroll 1
    for (int s = 0; s < 4; ++s) {
        f32x4 St[2][2];
#pragma unroll
        for (int hh = 0; hh < 2; ++hh) {
            const int mt = 2 * s + hh;
#pragma unroll
            for (int nt = 0; nt < 2; ++nt) St[hh][nt] = (f32x4){0.f, 0.f, 0.f, 0.f};
#pragma unroll
            for (int ks = 0; ks < 2; ++ks) {
                const bf16x8 a = lds_frag128(kL, 16 * mt + fr, 4 * ks + fq);
#pragma unroll
                for (int nt = 0; nt < 2; ++nt) St[hh][nt] = mfma16(a, Qf[nt][ks], St[hh][nt]);
            }
#pragma unroll
            for (int nt = 0; nt < 2; ++nt) {
                const int qi = 32 * wid + 16 * nt + fr;
#pragma unroll
                for (int r = 0; r < 4; ++r) {
                    const int kj = 16 * mt + 4 * fq + r;
                    const float dm = qi >= kj ? exp2f((float)(qi - kj) * lg2) : 0.f;
                    St[hh][nt][r] *= dm;
                }
            }
        }
        bf16x8 Pb[2];
#pragma unroll
        for (int nt = 0; nt < 2; ++nt) Pb[nt] = pack8(St[0][nt], St[1][nt]);
#pragma unroll
        for (int m = 0; m < 8; ++m) {
            const bf16x8 a = lds_vfrag256(vL, 16 * m + fr, 32 * s, fq);
#pragma unroll
            for (int nt = 0; nt < 2; ++nt) Y[m][nt] = mfma16(a, Pb[nt], Y[m][nt]);
        }
    }
    bf16_t* YB = (bf16_t*)(ws + WS_YA) + 512;
#pragma unroll
    for (int nt = 0; nt < 2; ++nt) {
        float sum = 0.f;
#pragma unroll
        for (int m = 0; m < 8; ++m) sum += Y[m][nt][0] + Y[m][nt][1] + Y[m][nt][2] + Y[m][nt][3];
        sum = rows_sum(sum);
        const float mu = sum * (1.f / 128.f);
        float vs = 0.f;
#pragma unroll
        for (int m = 0; m < 8; ++m)
#pragma unroll
            for (int r = 0; r < 4; ++r) { const float dlt = Y[m][nt][r] - mu; vs += dlt * dlt; }
        vs = rows_sum(vs);
        const float rstd = rsqrtf(vs * (1.f / 128.f) + 1e-5f);
        const size_t tk = tok0 + 32 * wid + 16 * nt + fr;
#pragma unroll
        for (int m = 0; m < 8; ++m) {
            const f32x4 gt = unpack4(*(const u32x2*)(P + tk * LD + C_GR + h * 128 + 16 * m + 4 * fq));
            f32x4 v;
#pragma unroll
            for (int r = 0; r < 4; ++r) v[r] = (Y[m][nt][r] - mu) * rstd * gt[r];
            *(u32x2*)(YB + tk * 1536 + h * 128 + 16 * m + 4 * fq) = pack4(v);
        }
    }
}
__device__ __forceinline__ void phase_p4_sel(const Params& p, unsigned char* lds) {
    for (int i = ltid(); i < 8192 / 16; i += NTHREADS) ((u32x4*)(lds + SEL_BUCKET))[i] = ((const u32x4*)(launder(p.ws) + WS_BUCKET))[i];
    __syncthreads();
    for (int it = blockIdx.x; it < 512; it += gridDim.x * 2) {
        sel_item<0>(p, it, lds);
        if (511 - it != it) sel_item<0>(p, 511 - it, lds);
    }
    __syncthreads();
}
__device__ __forceinline__ void phase_p4(const Params& p, unsigned char* lds, int half) {
    for (int it = (blockIdx.x * 2 + half); it < 1024; it += (gridDim.x * 2)) retout_item(p, it, lds, half);
}

struct RowOrder {     typedef pg8::Unit U; static constexpr bool GATHER = false;
    unsigned a, b; int K, xcd, slot, per;
    __device__ __forceinline__ bool next(int i, pg8::Unit& u) const { const int t = xcd * 32 + slot + i * per; if (t >= (xcd + 1) * 32) return false; u.pm = t >> 2; u.pn = t & 3; return true; }
    __device__ __forceinline__ void ptrs(const pg8::Unit& u, unsigned& A, unsigned& B) const { A = a + (unsigned)u.pm * 512u * (unsigned)K; B = b + (unsigned)u.pn * 512u * (unsigned)K; }
};
template <int MODE>
struct MixEpi {
    static constexpr int MID_T = MODE == 0 ? 8 : 0;
    unsigned char* ws; const float* X;
    __device__ __forceinline__ void mid(f32x4 (&acc)[2][2][4][2], const pg8::Unit& u, int wr, int wc, int fr, int fq) const {
#pragma unroll
        for (int ai = 0; ai < 2; ++ai) {
            __builtin_amdgcn_sched_barrier(0);
#pragma unroll
            for (int m = 0; m < 4; ++m) {
                const size_t tok = (size_t)(u.pm * 256 + 128 * ai + 64 * wr + 16 * m + fr + vzero());
#pragma unroll
                for (int bj = 0; bj < 2; ++bj) {
                    const int n = u.pn * 256 + 128 * bj + 32 * wc + 8 * fq;
                    const u32x4 ga = *(const u32x4*)((const bf16_t*)(ws + WS_P) + tok * LD + C_MA + n), gb = *(const u32x4*)((const bf16_t*)(ws + WS_P) + tok * LD + C_MB + n);
                    const f32x4 a0 = unpack4((u32x2){ga.x, ga.y}), a1 = unpack4((u32x2){ga.z, ga.w}), b0 = unpack4((u32x2){gb.x, gb.y}), b1 = unpack4((u32x2){gb.z, gb.w});
#pragma unroll
                    for (int r = 0; r < 4; ++r) { acc[ai][bj][m][0][r] *= a0[r] * __builtin_amdgcn_rcpf(fmaxf(b0[r], 1e-30f)); acc[ai][bj][m][1][r] *= a1[r] * __builtin_amdgcn_rcpf(fmaxf(b1[r], 1e-30f)); }
                }
            }
        }
        __builtin_amdgcn_sched_barrier(0);
    }
    __device__ __forceinline__ void operator()(const f32x4 (&acc)[2][2][4][2], const pg8::Unit& u, int wr, int wc, int fr, int fq) const {
#pragma unroll
        for (int ai = 0; ai < 2; ++ai)
#pragma unroll
            for (int m = 0; m < 4; ++m) {
                const size_t tok = (size_t)(u.pm * 256 + 128 * ai + 64 * wr + 16 * m + fr + vzero());
#pragma unroll
                for (int bj = 0; bj < 2; ++bj) {
                    const int n = u.pn * 256 + 128 * bj + 32 * wc + 8 * fq;
                    const f32x4 v0 = acc[ai][bj][m][0], v1 = acc[ai][bj][m][1];
                    if (MODE == 2) {
                        const u32x4 xw = *(const u32x4*)((const bf16_t*)(ws + WS_XB) + tok * 1024 + n);
                        const f32x4 h0 = unpack4((u32x2){xw.x, xw.y}) * DN_ALPHA + v0, h1 = unpack4((u32x2){xw.z, xw.w}) * DN_ALPHA + v1;
                        u32x4 w; w.x = pack2(h0[0], h0[1]); w.y = pack2(h0[2], h0[3]); w.z = pack2(h1[0], h1[1]); w.w = pack2(h1[2], h1[3]);
                        *(u32x4*)((bf16_t*)(ws + WS_H1) + tok * 1024 + n) = w;
                    } else {
                        const u32x4 gw = *(const u32x4*)((const bf16_t*)(ws + WS_P) + tok * LD + C_MB + n);
                        const f32x4 g0 = unpack4((u32x2){gw.x, gw.y}), g1 = unpack4((u32x2){gw.z, gw.w});
                        const f32x4 o0 = g0 * v0, o1 = g1 * v1;
                        u32x4 w; w.x = pack2(o0[0], o0[1]); w.y = pack2(o0[2], o0[3]); w.z = pack2(o1[0], o1[1]); w.w = pack2(o1[2], o1[3]);
                        *(u32x4*)((bf16_t*)(ws + WS_MG) + tok * 1024 + n) = w;
                    }
                }
            }
    }
};
__device__ __forceinline__ void phase_g2(const Params& p, unsigned char* lds) {
    unsigned char* ws = launder(p.ws);
    RowOrder S; S.xcd = blockIdx.x & 7; S.slot = blockIdx.x >> 3; S.per = gridDim.x >> 3;
    S.a = (unsigned)WS_YA; S.b = (unsigned)WS_WA; S.K = 1536; MixEpi<0> E; E.ws = ws; E.X = nullptr;
    pg8::gemm_phase<MixEpi<0>, RowOrder>(lds, 1536, S, E, ltid(), ws);
}
__device__ __forceinline__ void phase_g3(const Params& p, int layer, unsigned char* lds) {
    unsigned char* ws = launder(p.ws);
    RowOrder S; S.xcd = blockIdx.x & 7; S.slot = blockIdx.x >> 3; S.per = gridDim.x >> 3; S.a = (unsigned)WS_MG; S.b = (unsigned)WS_WO; S.K = 1024;
    MixEpi<2> E; E.ws = ws; E.X = nullptr;
    pg8::gemm_phase<MixEpi<2>, RowOrder>(lds, 1024, S, E, ltid(), ws);
}

__device__ __forceinline__ void phase_ln1(const Params& p, int layer, unsigned char* lds, bool dry, int half) {
    unsigned char* ws = launder(p.ws);
    const int tid = (ltid() & 255), lane = tid & 63, wid = tid >> 6;
    float* wrL = (float*)lds;
    float* lgL = (float*)(lds - half * HALF_LDS + 65536);
    {
        float4 wv[16];
#pragma unroll
        for (int k = 0; k < 16; ++k) wv[k] = ((const float4*)p.w_router)[tid + 256 * k];
#pragma unroll
        for (int k = 0; k < 16; ++k) { const int i4 = tid + 256 * k, d = i4 >> 2, e0 = (i4 & 3) * 4;
            wrL[(e0 + 0) * 1024 + d] = wv[k].x; wrL[(e0 + 1) * 1024 + d] = wv[k].y; wrL[(e0 + 2) * 1024 + d] = wv[k].z; wrL[(e0 + 3) * 1024 + d] = wv[k].w; }
    }
    __syncthreads();
    const bf16_t* H1 = (const bf16_t*)(ws + WS_H1);
    bf16_t* X1B = (bf16_t*)(ws + WS_X1B);
    const float* gam = p.ln1_g + layer * 1024; const float* bet = p.ln1_b + layer * 1024;
    unsigned* cnt = (unsigned*)(ws + WS_CTL) + (dry ? 0 : CW_CNT) + layer * 1024;
    int* LIST = (int*)(ws + (dry ? WS_HB : WS_LIST)); float* WTS = (float*)(ws + (dry ? WS_HB + 4194304 : WS_WTS));
    constexpr int U = 4;
    const int nwave = (gridDim.x * 2) * 4, wv = (blockIdx.x * 2 + half) * 4 + wid;
    const int nloc = ((T_ - wv * U + nwave * U - 1) / (nwave * U)) * (4 * U);
    u32x2 vn[U][4];
#pragma unroll
    for (int u = 0; u < U; ++u)
#pragma unroll
        for (int j = 0; j < 4; ++j) vn[u][j] = *(const u32x2*)(H1 + (size_t)(wv * U + u) * 1024 + 256 * j + 4 * lane);
    for (int t0 = wv * U; t0 < T_; t0 += nwave * U) {
        float4 y[U][4]; float s[U], q[U];
#pragma unroll
        for (int u = 0; u < U; ++u) {
            s[u] = 0.f;
#pragma unroll
            for (int j = 0; j < 4; ++j) { const f32x4 t = unpack4(vn[u][j]); y[u][j].x = t[0]; y[u][j].y = t[1]; y[u][j].z = t[2]; y[u][j].w = t[3]; s[u] += (t[0] + t[1]) + (t[2] + t[3]); }
        }
        { const int tn = t0 + nwave * U < T_ ? t0 + nwave * U : t0;
#pragma unroll
          for (int u = 0; u < U; ++u)
#pragma unroll
              for (int j = 0; j < 4; ++j) vn[u][j] = *(const u32x2*)(H1 + (size_t)(tn + u) * 1024 + 256 * j + 4 * lane); }
#pragma unroll
        for (int u = 0; u < U; ++u) s[u] = wave_sum(s[u]) * (1.f / 1024.f);
#pragma unroll
        for (int u = 0; u < U; ++u) {
            q[u] = 0.f;
#pragma unroll
            for (int j = 0; j < 4; ++j) { const float a = y[u][j].x - s[u], b2 = y[u][j].y - s[u], c = y[u][j].z - s[u], d = y[u][j].w - s[u]; q[u] += a * a + b2 * b2 + c * c + d * d; }
        }
#pragma unroll
        for (int u = 0; u < U; ++u) q[u] = rsqrtf(wave_sum(q[u]) * (1.f / 1024.f) + 1e-5f);
#pragma unroll
        for (int j = 0; j < 4; ++j) {
            const int d0 = 256 * j + 4 * lane;
            const float4 gg = *(const float4*)(gam + d0), bb = *(const float4*)(bet + d0);
#pragma unroll
            for (int u = 0; u < U; ++u) {
                y[u][j].x = (y[u][j].x - s[u]) * q[u] * gg.x + bb.x; y[u][j].y = (y[u][j].y - s[u]) * q[u] * gg.y + bb.y;
                y[u][j].z = (y[u][j].z - s[u]) * q[u] * gg.z + bb.z; y[u][j].w = (y[u][j].w - s[u]) * q[u] * gg.w + bb.w;
                u32x2 w; w.x = pack2(y[u][j].x, y[u][j].y); w.y = pack2(y[u][j].z, y[u][j].w);
                *(u32x2*)(X1B + (size_t)(t0 + u) * 1024 + d0) = w;
            }
        }
        float lg[U][16];
#pragma unroll
        for (int e = 0; e < 16; ++e) {
#pragma unroll
            for (int u = 0; u < U; ++u) lg[u][e] = 0.f;
#pragma unroll
            for (int j = 0; j < 4; ++j) { const float4 w4 = *(const float4*)(wrL + e * 1024 + 256 * j + 4 * lane);
#pragma unroll
                for (int u = 0; u < U; ++u) lg[u][e] += y[u][j].x * w4.x + y[u][j].y * w4.y + y[u][j].z * w4.z + y[u][j].w * w4.w; }
        }
        float myl = 0.f;
#pragma unroll
        for (int u = 0; u < U; ++u) {
            float w8[8], z4[4];
#pragma unroll
            for (int e = 0; e < 8; ++e) { const u32x2 r = __builtin_amdgcn_permlane32_swap(__float_as_uint(lg[u][e]), __float_as_uint(lg[u][e + 8]), false, false); w8[e] = __uint_as_float(r.x) + __uint_as_float(r.y); }
#pragma unroll
            for (int e = 0; e < 4; ++e) { const u32x2 r = __builtin_amdgcn_permlane16_swap(__float_as_uint(w8[e]), __float_as_uint(w8[e + 4]), false, false); z4[e] = __uint_as_float(r.x) + __uint_as_float(r.y); }
            const bool h8 = (lane & 8) != 0, h4 = (lane & 4) != 0;
            const float k0 = h8 ? z4[2] : z4[0], s0 = h8 ? z4[0] : z4[2], k1 = h8 ? z4[3] : z4[1], s1 = h8 ? z4[1] : z4[3];
            const float y0 = k0 + __int_as_float(__builtin_amdgcn_mov_dpp(__float_as_int(s0), 0x128, 0xF, 0xF, true));
            const float y1 = k1 + __int_as_float(__builtin_amdgcn_mov_dpp(__float_as_int(s1), 0x128, 0xF, 0xF, true));
            const float k2 = h4 ? y1 : y0, s2 = h4 ? y0 : y1;
            float x = k2 + __int_as_float(__builtin_amdgcn_mov_dpp(__float_as_int(s2), 0x141, 0xF, 0xF, true));
            x += __int_as_float(__builtin_amdgcn_mov_dpp(__float_as_int(x), 0xB1, 0xF, 0xF, true));
            x += __int_as_float(__builtin_amdgcn_mov_dpp(__float_as_int(x), 0x4E, 0xF, 0xF, true));
            if ((lane & 3) == u) myl = x;
        }
        static_assert(U == 4, "lane (l & 3) stores token u = l & 3");
        lgL[(half * nloc + ((t0 - wv * U) / (nwave * U)) * (4 * U) + wid * U + (lane & 3)) * 17 + (lane >> 2)] = myl;
    }
    __syncthreads();
    if (half == 0 && wid == 0)
    for (int l0 = 0; l0 < 2 * nloc; l0 += 64) {
        const int li = l0 + lane; const bool act = li < 2 * nloc;
        const int hq = li >= nloc ? 1 : 0, lh = li - hq * nloc;
        const int it = lh / (4 * U), wq = (lh / U) & 3, uq = lh % U, tok = act ? (((blockIdx.x * 2 + hq) * 4 + wq) * U + uq) + it * (nwave * U) : 0;
        float lgv[16];
#pragma unroll
        for (int e = 0; e < 16; ++e) lgv[e] = lgL[li * 17 + e];
        float mx = lgv[0];
#pragma unroll
        for (int e = 1; e < 16; ++e) mx = fmaxf(mx, lgv[e]);
        float pr[16], ps = 0.f;
#pragma unroll
        for (int e = 0; e < 16; ++e) { pr[e] = expf(lgv[e] - mx); ps += pr[e]; }
        const float ips = 1.f / ps;
        float sel[16];
#pragma unroll
        for (int e = 0; e < 16; ++e) { pr[e] *= ips; sel[e] = pr[e] + p.router_bias[e]; }
        int best = 0; float bestv = -1e30f;
#pragma unroll
        for (int gI = 0; gI < 4; ++gI) {
            float a = -1e30f, b2 = -1e30f;
#pragma unroll
            for (int k = 0; k < 4; ++k) { const float x = sel[4 * gI + k]; if (x > a) { b2 = a; a = x; } else if (x > b2) b2 = x; }
            const float gs = a + b2;
            if (gs > bestv) { bestv = gs; best = gI; }
        }
        float s4[4], p4[4];
#pragma unroll
        for (int k = 0; k < 4; ++k) { s4[k] = 0.f; p4[k] = 0.f; }
#pragma unroll
        for (int gI = 0; gI < 4; ++gI) if (gI == best) {
#pragma unroll
            for (int k = 0; k < 4; ++k) { s4[k] = sel[4 * gI + k]; p4[k] = pr[4 * gI + k]; }
        }
        int i0 = 0; float a0 = s4[0];
#pragma unroll
        for (int k = 1; k < 4; ++k) if (s4[k] > a0) { a0 = s4[k]; i0 = k; }
        int i1 = -1; float a1 = -1e30f;
#pragma unroll
        for (int k = 0; k < 4; ++k) if (k != i0 && s4[k] > a1) { a1 = s4[k]; i1 = k; }
        float w0 = 0.f, w1 = 0.f;
#pragma unroll
        for (int k = 0; k < 4; ++k) { if (k == i0) w0 = p4[k]; if (k == i1) w1 = p4[k]; }
        const float iw = 1.f / (w0 + w1);
        const int e0 = act ? best * 4 + i0 : -1, e1 = act ? best * 4 + i1 : -1;
        unsigned myc = 0, r0 = 0, r1 = 0;
#pragma unroll
        for (int e = 0; e < 16; ++e) {
            const unsigned long long m0 = __builtin_amdgcn_ballot_w64(e0 == e), m1 = __builtin_amdgcn_ballot_w64(e1 == e);
            const unsigned c0 = (unsigned)__builtin_popcountll(m0), c = c0 + (unsigned)__builtin_popcountll(m1);
            if (lane == e) myc = c;
            if (e0 == e) r0 = __builtin_amdgcn_mbcnt_hi((unsigned)(m0 >> 32), __builtin_amdgcn_mbcnt_lo((unsigned)m0, 0u));
            if (e1 == e) r1 = c0 + __builtin_amdgcn_mbcnt_hi((unsigned)(m1 >> 32), __builtin_amdgcn_mbcnt_lo((unsigned)m1, 0u));
        }
        unsigned mybase = 0;
        if (lane < 16 && myc != 0) mybase = atomicAdd(&cnt[lane * 64], myc);
        unsigned b0 = 0, b1 = 0;
#pragma unroll
        for (int e = 0; e < 16; ++e) { const unsigned be = (unsigned)__builtin_amdgcn_readlane((int)mybase, e); if (e0 == e) b0 = be; if (e1 == e) b1 = be; }
        if (act) {
            LIST[(size_t)e0 * T_ + b0 + r0] = tok * 2; LIST[(size_t)e1 * T_ + b1 + r1] = tok * 2 + 1;
            WTS[tok * 2] = w0 * iw; WTS[tok * 2 + 1] = w1 * iw;
        }
    }
}

struct MoeUnit { int e, rt, ct, cnt, off; };
struct MoeOrderBase {
    const unsigned* cntp; int t_lo, t_hi, slot, per;
    __device__ __forceinline__ void init(const unsigned* cnt) {
        cntp = cnt; int ntile = 0;
#pragma unroll
        for (int k = 0; k < NE; ++k) ntile += (__builtin_amdgcn_readfirstlane((int)cnt[k * 64]) >> 8) * 4;
        t_lo = (ntile * (int)(blockIdx.x & 7)) >> 3; t_hi = (ntile * (int)((blockIdx.x & 7) + 1)) >> 3; slot = blockIdx.x >> 3; per = gridDim.x >> 3;
    }
    __device__ __forceinline__ bool next(int i, MoeUnit& u) const {
        const int t = t_lo + slot + i * per; if (t >= t_hi) return false;
        int base = 0, off = 0; bool found = false;
#pragma unroll
        for (int k = 0; k < NE; ++k) {
            const int ck = __builtin_amdgcn_readfirstlane((int)cntp[k * 64]), nt = (ck >> 8) * 4;
            if (!found && t < base + nt) { found = true; u.e = k; u.cnt = ck; u.off = off; u.rt = (t - base) >> 2; u.ct = (t - base) & 3; }
            base += nt; off += ck;
        }
        return found;
    }
};
struct M2Order : MoeOrderBase {
    typedef MoeUnit U; static constexpr bool GATHER = true;
    const int* list;
    __device__ __forceinline__ void ptrs(const MoeUnit& u, unsigned& A, unsigned& B) const { A = (unsigned)WS_X1B; B = (unsigned)WS_WG + ((unsigned)u.e * 1024u + (unsigned)u.ct * 256u) * 2048u; }
    __device__ __forceinline__ void rows(const MoeUnit& u, int tid, unsigned (&v)[2]) const {
        v[0] = 0u; v[1] = 0u;
#pragma unroll
        for (int i = 0; i < 2; ++i) { int R, C; pg8::stage_rc((tid + vzero()) * 16 + i * 8192, R, C);
#pragma unroll
            for (int h = 0; h < 2; ++h) { int idx = u.rt * 256 + 128 * h + R; idx = idx < u.cnt ? idx : u.cnt - 1; const int a = (list + (size_t)u.e * T_)[idx]; v[h] |= (unsigned)(a >> 1) << (16 * i); } }
    }
};
struct M3Order : MoeOrderBase {
    typedef MoeUnit U; static constexpr bool GATHER = false;
    __device__ __forceinline__ void ptrs(const MoeUnit& u, unsigned& A, unsigned& B) const { A = (unsigned)WS_HB + ((unsigned)u.off + (unsigned)u.rt * 256u) * 1024u; B = (unsigned)WS_WD + ((unsigned)u.e * 1024u + (unsigned)u.ct * 256u) * 1024u; }
};
struct M2Epi {
    static constexpr int MID_T = 0;
    unsigned char* ws;
    __device__ __forceinline__ void operator()(const f32x4 (&acc)[2][2][4][2], const MoeUnit& u, int wr, int wc, int fr, int fq) const {
        bf16_t* HB = (bf16_t*)(ws + WS_HB);
#pragma unroll
        for (int ai = 0; ai < 2; ++ai)
#pragma unroll
            for (int m = 0; m < 4; ++m) {
                const int idx = u.rt * 256 + 128 * ai + 64 * wr + 16 * m + fr + vzero();
                if (idx < u.cnt) {
#pragma unroll
                    for (int bj = 0; bj < 2; ++bj) {
                        const int hcol = 4 * (32 * u.ct + 16 * bj + 4 * wc + fq);
                        const f32x4 gv = acc[ai][bj][m][0], uv = acc[ai][bj][m][1]; f32x4 hv;
#pragma unroll
                        for (int r = 0; r < 4; ++r) hv[r] = gv[r] * fsig(gv[r]) * uv[r];
                        *(u32x2*)(HB + (size_t)(u.off + idx) * 512 + hcol) = pack4(hv);
                    }
                }
            }
    }
};
struct M3Epi {
    static constexpr int MID_T = 0;
    unsigned char* ws; const int* list;
    __device__ __forceinline__ void operator()(const f32x4 (&acc)[2][2][4][2], const MoeUnit& u, int wr, int wc, int fr, int fq) const {
        bf16_t* CT = (bf16_t*)(ws + WS_CT);
#pragma unroll
        for (int ai = 0; ai < 2; ++ai)
#pragma unroll
            for (int m = 0; m < 4; ++m) {
                const int idx = u.rt * 256 + 128 * ai + 64 * wr + 16 * m + fr + vzero();
                if (idx < u.cnt) {
                    const int a = list[(size_t)u.e * T_ + idx];
#pragma unroll
                    for (int bj = 0; bj < 2; ++bj) {
                        const int n = u.ct * 256 + 128 * bj + 32 * wc + 8 * fq;
                        const f32x4 v0 = acc[ai][bj][m][0], v1 = acc[ai][bj][m][1];
                        u32x4 w; w.x = pack2(v0[0], v0[1]); w.y = pack2(v0[2], v0[3]); w.z = pack2(v1[0], v1[1]); w.w = pack2(v1[2], v1[3]);
                        *(u32x4*)(CT + (size_t)a * 1024 + n) = w;
                    }
                }
            }
    }
};
template <int MODE>
__device__ __forceinline__ void moe_rem_item(unsigned char* ws, const int* list, int e, int cnt, int off, int rh, int c64, unsigned char* lds) {
    constexpr int K = MODE == 0 ? 1024 : 512, NS = K / 64;
    const int tid = (ltid() & 255), lane = tid & 63, wid = tid >> 6, wr = wid >> 1, wc = wid & 1, fr = lane & 15, fq = lane >> 4;
    const int idx0 = (cnt & ~255) + 128 * rh;
    const int ldc = ((lane & 7) ^ (lane >> 3)) * 8;
    const bf16_t* ap[4];
#pragma unroll
    for (int i = 0; i < 4; ++i) {
        int idx = idx0 + 32 * i + 8 * wid + (lane >> 3); idx = idx < cnt ? idx : cnt - 1;
        if (MODE == 0) { const int a = list[(size_t)e * T_ + idx]; ap[i] = (const bf16_t*)(ws + WS_X1B) + (size_t)(a >> 1) * 1024 + ldc; }
        else ap[i] = (const bf16_t*)(ws + WS_HB) + (size_t)(off + idx) * 512 + ldc;
    }
    const bf16_t* bp[2];
#pragma unroll
    for (int i = 0; i < 2; ++i) {
        const int rho = 8 * (wid + 4 * i) + (lane >> 3), src = (rho & ~31) + pg8::perm32(rho & 31);
        bp[i] = (const bf16_t*)(ws + (MODE == 0 ? WS_WG : WS_WD)) + ((size_t)e * 1024 + 64 * c64 + src) * K + ldc;
    }
    f32x4 acc[4][2];
#pragma unroll
    for (int i = 0; i < 4; ++i)
#pragma unroll
        for (int j = 0; j < 2; ++j) acc[i][j] = (f32x4){0.f, 0.f, 0.f, 0.f};
    __syncthreads();
#define RSTAGE(buf, l) do { unsigned char* st_ = lds + (buf) * 24576; \
        _Pragma("unroll") for (int i = 0; i < 4; ++i) glds16(ap[i] + (l) * 64, st_ + (4 * i + wid) * 1024); \
        _Pragma("unroll") for (int i = 0; i < 2; ++i) glds16(bp[i] + (l) * 64, st_ + 16384 + (wid + 4 * i) * 1024); } while (0)
    RSTAGE(0, 0); RSTAGE(1, 1);
    for (int l = 0; l < NS; ++l) {
        const unsigned char* st = lds + (l % 3) * 24576;
        if (l + 1 < NS) WAIT_V(6); else WAIT_V(0);
        RAW_BARRIER();
        if (l + 2 < NS) RSTAGE((l + 2) % 3, l + 2);
#pragma unroll
        for (int ks = 0; ks < 2; ++ks) {
            bf16x8 a[4], bb[2];
#pragma unroll
            for (int i = 0; i < 4; ++i) a[i] = lds_frag128(st, 64 * wr + 16 * i + fr, 4 * ks + fq);
#pragma unroll
            for (int j = 0; j < 2; ++j) bb[j] = lds_frag128(st + 16384, 32 * wc + 16 * j + fr, 4 * ks + fq);
#pragma unroll
            for (int i = 0; i < 4; ++i)
#pragma unroll
                for (int j = 0; j < 2; ++j) acc[i][j] = mfma16(bb[j], a[i], acc[i][j]);
        }
    }
#undef RSTAGE
#pragma unroll
    for (int i = 0; i < 4; ++i) {
        const int idx = idx0 + 64 * wr + 16 * i + fr + vzero();
        if (idx < cnt) {
            if (MODE == 0) {
                f32x4 hv;
#pragma unroll
                for (int r = 0; r < 4; ++r) hv[r] = acc[i][0][r] * fsig(acc[i][0][r]) * acc[i][1][r];
                *(u32x2*)((bf16_t*)(ws + WS_HB) + (size_t)(off + idx) * 512 + 32 * c64 + 16 * wc + 4 * fq) = pack4(hv);
            } else {
                const int a = list[(size_t)e * T_ + idx];
                const f32x4 v0 = acc[i][0], v1 = acc[i][1];
                u32x4 w; w.x = pack2(v0[0], v0[1]); w.y = pack2(v0[2], v0[3]); w.z = pack2(v1[0], v1[1]); w.w = pack2(v1[2], v1[3]);
                *(u32x4*)((bf16_t*)(ws + WS_CT) + (size_t)a * 1024 + 64 * c64 + 32 * wc + 8 * fq) = w;
            }
        }
    }
    __syncthreads();
}
template <int MODE>
__device__ __forceinline__ void moe_rem(const unsigned* cntp, unsigned char* ws, const int* list, unsigned char* ldsh, int half) {
    for (int t = blockIdx.x * 2 + half; ; t += gridDim.x * 2) {
        int base = 0, off = 0, e = -1, cnt = 0, eoff = 0, loc = 0;
#pragma unroll
        for (int k = 0; k < NE; ++k) {
            const int ck = __builtin_amdgcn_readfirstlane((int)cntp[k * 64]), ni = (((ck & 255) + 127) >> 7) * 16;
            if (e < 0 && t < base + ni) { e = k; cnt = ck; eoff = off; loc = t - base; }
            base += ni; off += ck;
        }
        if (e < 0) break;
        moe_rem_item<MODE>(ws, list, e, cnt, eoff, loc >> 4, loc & 15, ldsh);
    }
}
__device__ __forceinline__ void phase_m2(const Params& p, int layer, unsigned char* lds, unsigned char* ldsh, int half) {
    unsigned char* ws = launder(p.ws);
    M2Order S; S.init((const unsigned*)(ws + WS_CTL) + CW_CNT + layer * 1024 + vzero());
    S.list = (const int*)(ws + WS_LIST);
    M2Epi E; E.ws = ws;
    pg8::gemm_phase<M2Epi, M2Order>(lds, 1024, S, E, ltid(), ws);
    moe_rem<0>(S.cntp, ws, S.list, ldsh, half);
}
__device__ __forceinline__ void phase_m3(const Params& p, int layer, unsigned char* lds, unsigned char* ldsh, int half) {
    unsigned char* ws = launder(p.ws);
    M3Order S; S.init((const unsigned*)(ws + WS_CTL) + CW_CNT + layer * 1024 + vzero());
    M3Epi E; E.ws = ws; E.list = (const int*)(ws + WS_LIST);
    pg8::gemm_phase<M3Epi, M3Order>(lds, 512, S, E, ltid(), ws);
    moe_rem<1>(S.cntp, ws, E.list, ldsh, half);
}

__device__ __forceinline__ void phase_ln2(const Params& p, int layer, int half) {
    unsigned char* ws = launder(p.ws);
    const int tid = (ltid() & 255), lane = tid & 63, wid = tid >> 6;
    const bf16_t* X1 = (const bf16_t*)(ws + WS_X1B); const bf16_t* CT = (const bf16_t*)(ws + WS_CT); const float* WTS = (const float*)(ws + WS_WTS);
    float* XO = p.out; bf16_t* XB = (bf16_t*)(ws + WS_XB); const bool fin = layer == NLAYER - 1;
    const float* gam = p.ln2_g + layer * 1024; const float* bet = p.ln2_b + layer * 1024;
    constexpr int U = 4;
    const int nwave = (gridDim.x * 2) * 4, wv = (blockIdx.x * 2 + half) * 4 + wid;
    for (int t0 = wv * U; t0 < T_; t0 += nwave * U) {
        float4 v[U][4]; float s[U], q[U];
#pragma unroll
        for (int u = 0; u < U; ++u) {
            const int tok = t0 + u;
            const float w0 = WTS[tok * 2 + vzero()], w1 = WTS[tok * 2 + 1 + vzero()];
            s[u] = 0.f; q[u] = 0.f;
#pragma unroll
            for (int j = 0; j < 4; ++j) {
                const int d0 = 256 * j + 4 * lane;
                const f32x4 xt = unpack4(*(const u32x2*)(X1 + (size_t)tok * 1024 + d0)); float4 xv; xv.x = xt[0]; xv.y = xt[1]; xv.z = xt[2]; xv.w = xt[3];
                const f32x4 c0 = unpack4(*(const u32x2*)(CT + (size_t)(tok * 2) * 1024 + d0)), c1 = unpack4(*(const u32x2*)(CT + (size_t)(tok * 2 + 1) * 1024 + d0));
                v[u][j].x = xv.x * DN_ALPHA + w0 * c0[0] + w1 * c1[0]; v[u][j].y = xv.y * DN_ALPHA + w0 * c0[1] + w1 * c1[1];
                v[u][j].z = xv.z * DN_ALPHA + w0 * c0[2] + w1 * c1[2]; v[u][j].w = xv.w * DN_ALPHA + w0 * c0[3] + w1 * c1[3];
                s[u] += v[u][j].x + v[u][j].y + v[u][j].z + v[u][j].w;
                q[u] += v[u][j].x * v[u][j].x + v[u][j].y * v[u][j].y + v[u][j].z * v[u][j].z + v[u][j].w * v[u][j].w;
            }
        }
#pragma unroll
        for (int u = 0; u < U; ++u) { s[u] = wave_sum(s[u]); q[u] = wave_sum(q[u]); }
#pragma unroll
        for (int j = 0; j < 4; ++j) {
            const int d0 = 256 * j + 4 * lane;
            const float4 gg = *(const float4*)(gam + d0), bb = *(const float4*)(bet + d0);
#pragma unroll
            for (int u = 0; u < U; ++u) {
                const int tok = t0 + u;
                const float mu = s[u] * (1.f / 1024.f), var = fmaxf(q[u] * (1.f / 1024.f) - mu * mu, 0.f), rstd = rsqrtf(var + 1e-5f);
                float4 y; y.x = (v[u][j].x - mu) * rstd * gg.x + bb.x; y.y = (v[u][j].y - mu) * rstd * gg.y + bb.y; y.z = (v[u][j].z - mu) * rstd * gg.z + bb.z; y.w = (v[u][j].w - mu) * rstd * gg.w + bb.w;
                if (fin) *(float4*)(XO + (size_t)tok * 1024 + d0) = y;
                else { u32x2 w; w.x = pack2(y.x, y.y); w.y = pack2(y.z, y.w); *(u32x2*)(XB + (size_t)tok * 1024 + d0) = w; }
            }
        }
    }
}

#define XB_TMO      128
#define XB_XCNT(j)  (256  + 64 * (j))
#define XB_XSUB(j)  (1280 + 64 * (j))
#define XB_XGEN(j)  (2304 + 64 * (j))
#define XB_TOP      3328
#define XB_TOPGEN   3392
#define XCD_BAR_WORDS 3456
#define XB_SPIN_CAP (1u << 22)
#define LAS __attribute__((address_space(3)))
__device__ __forceinline__ unsigned xb_ld(unsigned* p)              { return __hip_atomic_load(p, __ATOMIC_RELAXED, __HIP_MEMORY_SCOPE_AGENT); }
__device__ __forceinline__ unsigned xb_add(unsigned* p, unsigned v) { return __hip_atomic_fetch_add(p, v, __ATOMIC_RELAXED, __HIP_MEMORY_SCOPE_AGENT); }
__device__ __forceinline__ unsigned xb_xcc_id() { return (unsigned)__builtin_amdgcn_s_getreg((3 << 11) | 20) & 0xFu; }
#define XB_SPIN(cond, bar) do { unsigned _sp = 0; while (cond) { __builtin_amdgcn_s_sleep(1); \
    if ((++_sp & 255u) == 0u) { if (xb_ld(&(bar)[XB_TMO])) break; if (_sp > XB_SPIN_CAP) { atomicAdd(&(bar)[XB_TMO], 1u); break; } } } } while (0)
struct XcdBarrier { unsigned* bar; unsigned x; volatile LAS unsigned* st; };
__device__ __forceinline__ XcdBarrier xcd_barrier_post(unsigned* bar, volatile LAS unsigned* st) {
    XcdBarrier b; b.bar = bar; b.x = xb_xcc_id(); b.st = st;
    if (threadIdx.x == 0) (void)xb_add(&bar[XB_XCNT(b.x)], 1u);
    return b;
}
__device__ __forceinline__ void xcd_barrier_complete(unsigned* bar, unsigned x, unsigned& nloc, unsigned& nx) {
    const unsigned G = gridDim.x * gridDim.y * gridDim.z;
    unsigned sum, cnt, mine, sp = 0u;
    for (;;) {
        sum = 0u; cnt = 0u; mine = 0u;
#pragma unroll
        for (unsigned j = 0; j < 16; ++j) { const unsigned c = xb_ld(&bar[XB_XCNT(j)]); sum += c; cnt += (c > 0u) ? 1u : 0u; mine = (j == x) ? c : mine; }
        if (sum == G) break;
        __builtin_amdgcn_s_sleep(1);
        if ((++sp & 255u) == 0u) { if (xb_ld(&bar[XB_TMO])) break; if (sp > XB_SPIN_CAP) { atomicAdd(&bar[XB_TMO], 1u); break; } }
    }
    nloc = mine > 0u ? mine : 1u; nx = cnt > 0u ? cnt : 1u;
}
__device__ __forceinline__ void xcd_barrier(const XcdBarrier& b) {
    asm volatile("s_waitcnt vmcnt(0)" ::: "memory");
    __syncthreads();
    if (threadIdx.x == 0) {
        unsigned* bar = b.bar;
        __builtin_amdgcn_s_waitcnt(0);
        unsigned nloc = b.st[0], nx = b.st[1];
        if (nloc == 0u) { xcd_barrier_complete(bar, b.x, nloc, nx); b.st[0] = nloc; b.st[1] = nx; }
        const unsigned old = xb_add(&bar[XB_XSUB(b.x)], 1u);
        const unsigned gen = old / nloc;
        if (old + 1u == (gen + 1u) * nloc) {
            __builtin_amdgcn_fence(__ATOMIC_RELEASE, "agent");
            asm volatile("s_waitcnt vmcnt(0)" ::: "memory");
            const unsigned og = xb_add(&bar[XB_TOP], 1u);
            const unsigned tg = og / nx;
            if (og + 1u == (tg + 1u) * nx) xb_add(&bar[XB_TOPGEN], 1u);
            else XB_SPIN(xb_ld(&bar[XB_TOPGEN]) == tg, bar);
            __builtin_amdgcn_fence(__ATOMIC_ACQUIRE, "agent");
            xb_add(&bar[XB_XGEN(b.x)], 1u);
            asm volatile("s_waitcnt vmcnt(0)" ::: "memory");
        } else {
            XB_SPIN(xb_ld(&bar[XB_XGEN(b.x)]) == gen, bar);
            __builtin_amdgcn_fence(__ATOMIC_ACQUIRE, "agent");
            asm volatile("s_waitcnt vmcnt(0)" ::: "memory");
        }
    }
    __syncthreads();
}

constexpr int PH_PER_LAYER = 11, N_PHASES = PH_PER_LAYER * NLAYER;
__global__ void __launch_bounds__(NTHREADS, 2) mega(Params p) {
    extern __shared__ __attribute__((aligned(16))) unsigned char lds[];
#if SINGLE_LAUNCH
    volatile LAS unsigned* xbw = (volatile LAS unsigned*)(lds + LDS_BYTES - 16);
    if (threadIdx.x < 4) xbw[threadIdx.x] = 0u;
    __syncthreads();
    XcdBarrier xbar = xcd_barrier_post((unsigned*)(p.ws + WS_CTL) + CW_BAR, xbw);
#endif
    const int half = __builtin_amdgcn_readfirstlane((int)(threadIdx.x >> 8));
    unsigned char* ldsh = lds + half * HALF_LDS;
    bool second = false;
    for (int ph = p.ph_lo; ph < p.ph_hi; ++ph) {
        const int layer = ph / PH_PER_LAYER, k = ph % PH_PER_LAYER;
        if (k == 0 && layer > 0) continue;
#ifdef ONLY_PHASE
        if (k != ONLY_PHASE) continue;
#endif
        switch (k) {
            case 0: phase_pw(p, layer, ldsh, 1 | 16 | 8, half); break;
            case 1: phase_g1(p, layer, lds); break;
            case 2: phase_p2(p, layer, ldsh, half); if (!second && layer + 1 < NLAYER) { __syncthreads(); phase_pw(p, layer + 1, ldsh, 1, half, 32); } break;
            case 3: phase_p3(p, ldsh, half, second ? ((p.rep_mask >> 16) & 7) : 7); if (!second && layer + 1 < NLAYER) { __syncthreads(); phase_pw(p, layer + 1, ldsh, 16, half); }
                    if (!second && layer == 0) { __syncthreads(); phase_pw(p, 0, ldsh, 2, half); } break;
            case 4: { const int sub = second ? ((p.rep_mask >> 12) & 7) : 7;
                    if (sub & 1) phase_p4_sel(p, lds);
                    if ((sub & 4) && half == 0) { phase_pw(p, layer, ldsh, 4, half); __syncthreads(); }
                    if (sub & 2) phase_p4(p, ldsh, half);
                    if ((sub & 4) && half == 1) { __syncthreads(); phase_pw(p, layer, ldsh, 4, half); } } break;
            case 5: phase_g2(p, lds); break;
            case 6: phase_g3(p, layer, lds); break;
            case 7: phase_ln1(p, layer, ldsh, ((p.rep_mask >> 7) & 1) && !second, half); if (!second && layer + 1 < NLAYER) { __syncthreads(); phase_pw(p, layer + 1, ldsh, 2, half); } break;
            case 8: phase_m2(p, layer, lds, ldsh, half); break;
            case 9: phase_m3(p, layer, lds, ldsh, half); break;
            case 10: phase_ln2(p, layer, half); break;
        }

        if (ph + 1 < p.ph_hi) { if (ph == p.ph_lo && !second) cg::this_grid().sync(); else xcd_barrier(xbar); }
        if (((p.rep_mask >> k) & 1) && !second) { second = true; --ph; } else second = false;
    }
}

extern "C" void kernel_launch(void* const* d_in, const int* in_sizes, int n_in, void* d_out, int out_size, void* d_ws, size_t ws_size, hipStream_t stream) {
    static int grid = 0;
    if (grid == 0) {
        if (n_in != 18 || ws_size < WS_END) { fprintf(stderr, "kernel_launch: unexpected n_in %d or ws_size %zu < %zu\n", n_in, ws_size, (size_t)WS_END); grid = -1; return; }
        int dev = 0, cus = 0, per_cu = 0;
        hipGetDevice(&dev); hipDeviceGetAttribute(&cus, hipDeviceAttributeMultiprocessorCount, dev);
        hipFuncSetAttribute((const void*)mega, hipFuncAttributeMaxDynamicSharedMemorySize, LDS_BYTES);
        hipOccupancyMaxActiveBlocksPerMultiprocessor(&per_cu, (const void*)mega, NTHREADS, LDS_BYTES);
        if (per_cu < 1) per_cu = 1;
        if (per_cu > 1) per_cu = 1;
        grid = cus * per_cu;
        (void)hipGetLastError();
    }
    if (grid < 0) return;
    Params p{};
    p.x = (const float*)d_in[0]; p.w_in = (const float*)d_in[1]; p.cmp_pos = (const float*)d_in[2]; p.cmp_w1 = (const float*)d_in[3]; p.cmp_w2 = (const float*)d_in[4];
    p.w_br_a = (const float*)d_in[5]; p.w_br_b = (const float*)d_in[6]; p.w_o = (const float*)d_in[7]; p.ln1_g = (const float*)d_in[8]; p.ln1_b = (const float*)d_in[9];
    p.w_router = (const float*)d_in[10]; p.router_bias = (const float*)d_in[11]; p.w_gate = (const float*)d_in[12]; p.w_up = (const float*)d_in[13]; p.w_down = (const float*)d_in[14];
    p.ln2_g = (const float*)d_in[15]; p.ln2_b = (const float*)d_in[16]; p.rel_bias = (const float*)d_in[17];
    p.out = (float*)d_out; p.ws = (unsigned char*)d_ws; p.rep_mask = REPEAT_MASK;
#if SINGLE_LAUNCH
    hipMemsetAsync((unsigned char*)d_ws + WS_CTL + (size_t)CW_BAR * 4, 0, XCD_BAR_WORDS * 4, stream);
    p.ph_lo = 0; p.ph_hi = N_PHASES;
    void* args[] = {&p};
    hipError_t e = hipLaunchCooperativeKernel((const void*)mega, dim3(grid), dim3(NTHREADS), args, LDS_BYTES, stream);
    if (e != hipSuccess) fprintf(stderr, "cooperative launch failed: %s (grid %d)\n", hipGetErrorString(e), grid);
#else
    for (int ph = 0; ph < N_PHASES; ++ph) {
        p.ph_lo = ph; p.ph_hi = ph + 1;
        hipLaunchKernelGGL(mega, dim3(grid), dim3(NTHREADS), LDS_BYTES, stream, p);
    }
#endif
}
```

```cpp
#include <hip/hip_runtime.h>
#include <hip/hip_cooperative_groups.h>
#include <cstdio>
#include <cstdint>
namespace cg = cooperative_groups;

#ifndef REPEAT_MASK
#define REPEAT_MASK 0
#endif
#ifndef SINGLE_LAUNCH
#define SINGLE_LAUNCH 1
#endif

typedef unsigned short bf16_t;
typedef short bf16x8 __attribute__((ext_vector_type(8)));
typedef float f32x4 __attribute__((ext_vector_type(4)));
typedef unsigned u32x2 __attribute__((ext_vector_type(2)));
typedef unsigned u32x4 __attribute__((ext_vector_type(4)));

constexpr int B_ = 2, S_ = 8192, D_ = 1024, T_ = B_ * S_, NLAYER = 4;
constexpr int DIN = 6424;
constexpr int LD = 5376;
constexpr int NW = 6656;
constexpr int C_QA = 0, C_KC = 512, C_VC = 640, C_KS = 768, C_KW = 896, C_QR = 1024, C_KR = 1536, C_GR = 2048, C_MA = 3072, C_MB = 4096, C_GA = 5120,
              C_VS = 5376, C_VW = 5504, C_VR = 5632;
constexpr float DN_ALPHA = 1.681792830507429f;
constexpr int NE = 16;

constexpr size_t al256(size_t x) { return (x + 255) & ~(size_t)255; }
constexpr size_t WS_CTL = 0;
constexpr size_t WS_BUCKET = 65536;
constexpr size_t WS_ROPE = WS_BUCKET + 8192;
constexpr size_t WS_WIN = WS_ROPE + (size_t)8192 * 32 * 8;
constexpr size_t WS_WA = WS_WIN + (size_t)NW * 1024 * 2;
constexpr size_t WS_WB = WS_WA + (size_t)1024 * 512 * 2;
constexpr size_t WS_WO = WS_WB + (size_t)1024 * 1024 * 2;
constexpr size_t WS_WG = WS_WO + (size_t)1024 * 1024 * 2;
constexpr size_t WS_WU = WS_WG + (size_t)16 * 512 * 1024 * 2;
constexpr size_t WS_WD = WS_WU + (size_t)16 * 512 * 1024 * 2;
constexpr size_t WS_XB = WS_WD + (size_t)16 * 512 * 1024 * 2;
constexpr size_t WS_X = WS_XB + (size_t)T_ * 1024 * 2;
constexpr size_t WS_MG = WS_X + (size_t)T_ * 1024 * 4;
constexpr size_t WS_KCC = WS_MG + (size_t)T_ * 1024 * 2;
constexpr size_t WS_VCCT = WS_KCC + (size_t)4 * 512 * 64 * 2;
constexpr size_t WS_W1T = WS_VCCT + (size_t)4 * 512 * 64 * 2;
constexpr size_t WS_B1 = WS_W1T + (size_t)2 * 64 * 2048 * 2;
constexpr size_t WS_R = WS_B1 + 1024;
constexpr size_t WS_P = WS_R;
constexpr size_t WS_VST = WS_P + (size_t)T_ * LD * 2;
constexpr size_t WS_VWT = WS_VST + (size_t)4 * 64 * S_ * 2;
constexpr size_t WS_VRT = WS_VWT + (size_t)4 * 64 * S_ * 2;
constexpr size_t WS_KVT = WS_VRT + (size_t)16 * 128 * S_ * 2;
constexpr size_t WS_SPT = WS_KVT + (size_t)16 * 64 * 8192 * 4;
constexpr size_t WS_YC = WS_SPT + (size_t)16 * 64 * 8192 * 2;
constexpr size_t WS_YW = WS_YC + (size_t)T_ * 512 * 2;
constexpr size_t WS_YA = WS_YW + (size_t)T_ * 512 * 2;
constexpr size_t WS_YB = WS_YA + (size_t)T_ * 512 * 2;
constexpr size_t WS_SELW = WS_YB + (size_t)T_ * 1024 * 2;
constexpr size_t WS_ENDA = WS_SELW + (size_t)T_ * 2 * 4 * 4;
constexpr size_t WS_H1 = WS_R;
constexpr size_t WS_X1 = WS_H1 + (size_t)T_ * 1024 * 4;
constexpr size_t WS_X1B = WS_X1 + (size_t)T_ * 1024 * 4;
constexpr size_t WS_HB = WS_X1B + (size_t)T_ * 1024 * 2;
constexpr size_t WS_CT = WS_HB + (size_t)2 * T_ * 512 * 2;
constexpr size_t WS_LIST = WS_CT + (size_t)2 * T_ * 1024 * 2;
constexpr size_t WS_WTS = WS_LIST + (size_t)16 * T_ * 4;
constexpr size_t WS_ENDB = WS_WTS + (size_t)2 * T_ * 4;
static_assert(WS_HB + (size_t)2 * T_ * 512 * 2 <= WS_CT, "view B overlap");
constexpr size_t WS_END = WS_ENDA > WS_ENDB ? WS_ENDA : WS_ENDB;

constexpr int CW_CNT = 4096;
constexpr int CW_BAR = 8192;

constexpr int HALF_LDS = 75776, LDS_BYTES = 2 * HALF_LDS + 16;
constexpr int NTHREADS = 512, HT = 256;

struct Params {
    const float* x; const float* w_in; const float* cmp_pos; const float* cmp_w1; const float* cmp_w2;
    const float* w_br_a; const float* w_br_b; const float* w_o; const float* ln1_g; const float* ln1_b;
    const float* w_router; const float* router_bias; const float* w_gate; const float* w_up; const float* w_down;
    const float* ln2_g; const float* ln2_b; const float* rel_bias;
    float* out; unsigned char* ws;
    int ph_lo, ph_hi, rep_mask, pad_;
};

__device__ __forceinline__ bf16_t f2bf(float f) { unsigned u = __float_as_uint(f); u += 0x7fffu + ((u >> 16) & 1u); return (bf16_t)(u >> 16); }
__device__ __forceinline__ float bf2f(unsigned h) { return __uint_as_float(h << 16); }
typedef __bf16 bf16x2_t __attribute__((ext_vector_type(2)));
typedef float f32x2_t __attribute__((ext_vector_type(2)));
__device__ __forceinline__ unsigned pack2(float lo, float hi) { const f32x2_t f = {lo, hi}; return __builtin_bit_cast(unsigned, __builtin_convertvector(f, bf16x2_t)); }
__device__ __forceinline__ u32x2 pack4(f32x4 v) { u32x2 r; r.x = pack2(v[0], v[1]); r.y = pack2(v[2], v[3]); return r; }
__device__ __forceinline__ f32x4 unpack4(u32x2 u) { f32x4 r; r[0] = bf2f(u.x & 0xffffu); r[1] = bf2f(u.x >> 16); r[2] = bf2f(u.y & 0xffffu); r[3] = bf2f(u.y >> 16); return r; }
__device__ __forceinline__ float rows_max(float v) {
    u32x2 r = __builtin_amdgcn_permlane16_swap(__float_as_uint(v), __float_as_uint(v), false, false);
    v = fmaxf(__uint_as_float(r.x), __uint_as_float(r.y));
    r = __builtin_amdgcn_permlane32_swap(__float_as_uint(v), __float_as_uint(v), false, false);
    return fmaxf(__uint_as_float(r.x), __uint_as_float(r.y));
}
__device__ __forceinline__ float rows_sum(float v) {
    u32x2 r = __builtin_amdgcn_permlane16_swap(__float_as_uint(v), __float_as_uint(v), false, false);
    v = __uint_as_float(r.x) + __uint_as_float(r.y);
    r = __builtin_amdgcn_permlane32_swap(__float_as_uint(v), __float_as_uint(v), false, false);
    return __uint_as_float(r.x) + __uint_as_float(r.y);
}
__device__ __forceinline__ float wave_sum(float v) {
    v += __int_as_float(__builtin_amdgcn_mov_dpp(__float_as_int(v), 0xB1, 0xF, 0xF, true));
    v += __int_as_float(__builtin_amdgcn_mov_dpp(__float_as_int(v), 0x4E, 0xF, 0xF, true));
    v += __int_as_float(__builtin_amdgcn_mov_dpp(__float_as_int(v), 0x141, 0xF, 0xF, true));
    v += __int_as_float(__builtin_amdgcn_mov_dpp(__float_as_int(v), 0x140, 0xF, 0xF, true));
    return rows_sum(v);
}
__device__ __forceinline__ float sigmoidf_(float x) { return 1.f / (1.f + __expf(-x)); }
__device__ __forceinline__ int ltid() { int t = threadIdx.x; asm volatile("" : "+v"(t)); return t; }
__device__ __forceinline__ int vzero() { int z; asm volatile("v_mov_b32 %0, 0" : "=v"(z)); return z; }
__device__ __forceinline__ unsigned char* launder(unsigned char* q) { asm volatile("" : "+s"(q)); return q; }
__device__ __forceinline__ void wait_vm0() { asm volatile("s_waitcnt vmcnt(0)" ::: "memory"); }

__device__ __forceinline__ void glds16(const void* g, void* l) {
    __builtin_amdgcn_global_load_lds((const __attribute__((address_space(1))) unsigned*)g,
                                     (__attribute__((address_space(3))) unsigned*)l, 16, 0, 0);
}
__device__ __forceinline__ f32x4 mfma16(bf16x8 a, bf16x8 b, f32x4 c) { return __builtin_amdgcn_mfma_f32_16x16x32_bf16(a, b, c, 0, 0, 0); }

#define WAIT_V(n) asm volatile("s_waitcnt vmcnt(%0)" ::"n"(n) : "memory")
#define RAW_BARRIER() do { asm volatile("s_waitcnt lgkmcnt(0)" ::: "memory"); __builtin_amdgcn_s_barrier(); } while (0)
__device__ __forceinline__ void bglds16(__amdgpu_buffer_rsrc_t r, unsigned voff, int soff, void* l) {
    __builtin_amdgcn_raw_ptr_buffer_load_lds(r, (__attribute__((address_space(3))) void*)l, 16, (int)voff, soff, 0, 0);
}
template <int NJ, bool GN>
__device__ __forceinline__ void gemm8_stage(__amdgpu_buffer_rsrc_t mr, int mld, unsigned mvo, __amdgpu_buffer_rsrc_t nr, int nld, const unsigned (&nvo)[NJ], int kt, unsigned char* st, int wid) {
#pragma unroll
    for (int i = 0; i < 4; ++i) bglds16(mr, mvo, (64 * i * mld + kt * 64) * 2, st + (8 * i + wid) * 1024);
#pragma unroll
    for (int i = 0; i < NJ; ++i) bglds16(nr, nvo[i], ((GN ? 0 : 64 * i * nld) + kt * 64) * 2, st + 32768 + (8 * i + wid) * 1024);
}
template <int NJ, bool GN>
__device__ __forceinline__ void gemm8_kloop(const bf16_t* mb, int mld, unsigned mvo, const bf16_t* nb, int nld, const unsigned (&nvo)[NJ], int nk, unsigned char* lds, f32x4 (&acc)[8][NJ], int tid) {
    const int lane = tid & 63, wid = tid >> 6, wr = wid >> 2, wc = wid & 3, fr = lane & 15, fq = lane >> 4;
    const __amdgpu_buffer_rsrc_t mr = __builtin_amdgcn_make_buffer_rsrc((void*)mb, 0, 0x7fffffff, 0x00020000);
    const __amdgpu_buffer_rsrc_t nr = __builtin_amdgcn_make_buffer_rsrc((void*)nb, 0, 0x7fffffff, 0x00020000);
    gemm8_stage<NJ, GN>(mr, mld, mvo, nr, nld, nvo, 0, lds, wid);
    gemm8_stage<NJ, GN>(mr, mld, mvo, nr, nld, nvo, 1, lds + 65536, wid);
    for (int kt = 0; kt < nk; ++kt) {
        unsigned char* cur = lds + (kt & 1) * 65536;
        if (kt + 1 < nk) WAIT_V(4 + NJ); else WAIT_V(0);
        RAW_BARRIER();
        bf16x8 a[4], b[NJ];
        const unsigned char* ab = cur + (128 * wr + fr) * 128;
        const unsigned char* bb = cur + 32768 + (16 * NJ * wc + fr) * 128;
        const int sw0 = ((fq) ^ (fr & 7)) << 4, sw1 = ((4 + fq) ^ (fr & 7)) << 4;
#pragma unroll
        for (int j = 0; j < NJ; ++j) b[j] = *(const bf16x8*)(bb + j * 2048 + sw0);
#pragma unroll
        for (int mh = 0; mh < 2; ++mh) {
#pragma unroll
            for (int i = 0; i < 4; ++i) a[i] = *(const bf16x8*)(ab + (4 * mh + i) * 2048 + sw0);
#pragma unroll
            for (int i = 0; i < 4; ++i)
#pragma unroll
                for (int j = 0; j < NJ; ++j) acc[4 * mh + i][j] = mfma16(a[i], b[j], acc[4 * mh + i][j]);
        }
#pragma unroll
        for (int j = 0; j < NJ; ++j) b[j] = *(const bf16x8*)(bb + j * 2048 + sw1);
#pragma unroll
        for (int i = 0; i < 4; ++i) a[i] = *(const bf16x8*)(ab + i * 2048 + sw1);
#pragma unroll
        for (int i = 0; i < 4; ++i)
#pragma unroll
            for (int j = 0; j < NJ; ++j) acc[i][j] = mfma16(a[i], b[j], acc[i][j]);
#pragma unroll
        for (int i = 0; i < 4; ++i) a[i] = *(const bf16x8*)(ab + (4 + i) * 2048 + sw1);
        RAW_BARRIER();
        if (kt + 2 < nk) gemm8_stage<NJ, GN>(mr, mld, mvo, nr, nld, nvo, kt + 2, cur, wid);
#pragma unroll
        for (int i = 0; i < 4; ++i)
#pragma unroll
            for (int j = 0; j < NJ; ++j) acc[4 + i][j] = mfma16(a[i], b[j], acc[4 + i][j]);
    }
    __syncthreads();
    __builtin_amdgcn_sched_barrier(0);
}
template <int NJ>
__device__ __forceinline__ void zero_acc8(f32x4 (&acc)[8][NJ]) {
#pragma unroll
    for (int i = 0; i < 8; ++i)
#pragma unroll
        for (int j = 0; j < NJ; ++j) acc[i][j] = (f32x4){0.f, 0.f, 0.f, 0.f};
}

namespace pg8 {
#define PG8_LAS __attribute__((address_space(3)))
constexpr int BM = 256, BK = 64, HALF = 128, HTB = HALF * BK * 2, STAGE_BYTES = 8 * HTB;
__device__ __forceinline__ int lds_byte(int r, int c) { const int st = (r >> 4) * 2 + (c >> 5), rr = r & 15, cc = c & 31, ob = rr * 64 + cc * 2; return st * 1024 + (ob ^ (((ob >> 9) & 1) << 5)); }
__device__ __forceinline__ void stage_rc(int b, int& R, int& C) { const int st = b / 1024, sb = b % 1024, swz = sb ^ (((sb >> 9) & 1) << 5); R = (st >> 1) * 16 + swz / 64; C = (st & 1) * 32 + (swz % 64) / 2; }
__device__ __forceinline__ int perm32(int rho) { const int n = rho >> 4, i = rho & 15; return 8 * (i >> 2) + 4 * n + (i & 3); }
struct Unit { int pm, pn; };
template <class Epi, class Sched>
__device__ __forceinline__ void gemm_phase(unsigned char* lds_, const int K, const Sched& S, const Epi& E, const int tid, const unsigned char* wsbase) {
    PG8_LAS unsigned char* lds = (PG8_LAS unsigned char*)lds_;
    const int wid = __builtin_amdgcn_readfirstlane(tid >> 6), lane = tid & 63, wr = wid >> 2, wc = wid & 3, fr = lane & 15, fq = lane >> 4;
    const int nt = K / BK;
    unsigned voffA[2], voffB[2];
#pragma unroll
    for (int i = 0; i < 2; ++i) { int R, C; stage_rc(tid * 16 + i * 8192, R, C); const int Rb = (R & ~31) + perm32(R & 31);
        voffA[i] = (unsigned)(R * K + C) * 2u; voffB[i] = (unsigned)(Rb * K + C) * 2u; }
    const unsigned kstep = (unsigned)(BK * 2);
    const unsigned hstep = (unsigned)HALF * K * 2;
    const __amdgpu_buffer_rsrc_t rsrc = __builtin_amdgcn_make_buffer_rsrc((void*)wsbase, 0, 0x7fffffff, 0x00020000);
    const unsigned ldsw = (unsigned)wid * 1024u;
    const int aoff = lds_byte(wr * 64 + fr, fq * 8), boff = lds_byte(wc * 32 + fr, fq * 8);
#define PG8_SA(b, h) (((b) * 2 + (h)) * HTB)
#define PG8_SB(b, h) ((4 + (b) * 2 + (h)) * HTB)
#define PG8_STAGE(bufoff, gbase, voff) do { _Pragma("unroll") for (int _i = 0; _i < 2; ++_i) \
        __builtin_amdgcn_raw_ptr_buffer_load_lds(rsrc, (PG8_LAS void*)(lds + (bufoff) + ldsw + _i * 8192), 16, (int)(voff)[_i], (int)(gbase), 0, 0); } while (0)
#define PG8_LDA(dst, b, h) do { _Pragma("unroll") for (int m = 0; m < 4; ++m) _Pragma("unroll") for (int k = 0; k < 2; ++k) dst[m][k] = *(const PG8_LAS bf16x8*)(lds + PG8_SA(b, h) + aoff + m * 2048 + k * 1024); } while (0)
#define PG8_LDB(dst, b, h) do { _Pragma("unroll") for (int n = 0; n < 2; ++n) _Pragma("unroll") for (int k = 0; k < 2; ++k) dst[n][k] = *(const PG8_LAS bf16x8*)(lds + PG8_SB(b, h) + boff + n * 2048 + k * 1024); } while (0)
#define PG8_MMA(ai, bj, At, Bt) do { __builtin_amdgcn_s_setprio(1); _Pragma("unroll") for (int m = 0; m < 4; ++m) _Pragma("unroll") for (int n = 0; n < 2; ++n) _Pragma("unroll") for (int k = 0; k < 2; ++k) \
        acc[ai][bj][m][n] = __builtin_amdgcn_mfma_f32_16x16x32_bf16(Bt[n][k], At[m][k], acc[ai][bj][m][n], 0, 0, 0); __builtin_amdgcn_s_setprio(0); } while (0)
#define PG8_WAIT_V(n) asm volatile("s_waitcnt vmcnt(" #n ")" ::: "memory")
#define PG8_WAIT_L(n) asm volatile("s_waitcnt lgkmcnt(" #n ")" ::: "memory")
#define PG8_BAR __builtin_amdgcn_s_barrier()
#define PG8_SCHED __builtin_amdgcn_sched_barrier(0)
    typename Sched::U cur, nxt; int ui = 0;
    if (!S.next(0, cur)) return;
    unsigned cA, cB; S.ptrs(cur, cA, cB);
    constexpr bool GA = Sched::GATHER;
    unsigned vA[2], nvA[2];
    if constexpr (GA) { S.rows(cur, tid, vA); nvA[0] = vA[0]; nvA[1] = vA[1]; }
#define PG8_STAGE_G(bufoff, gbase, pk) do { const unsigned _cb = voffB[0] & (unsigned)(2 * K - 1); unsigned _vo[2] = {(((pk) & 0xffffu) * (unsigned)(2 * K)) + _cb, (((pk) >> 16) * (unsigned)(2 * K)) + _cb}; PG8_STAGE(bufoff, gbase, _vo); } while (0)
#define PG8_STAGE_A(bufoff, gbase, h, nextu) do { if constexpr (GA) { if (nextu) PG8_STAGE_G(bufoff, gbase, nvA[h]); else PG8_STAGE_G(bufoff, gbase, vA[h]); } \
        else PG8_STAGE(bufoff, (gbase) + (h) * hstep, voffA); } while (0)
    PG8_STAGE(PG8_SB(0, 0), cB, voffB); PG8_STAGE_A(PG8_SA(0, 0), cA, 0, false); PG8_STAGE(PG8_SB(0, 1), cB + hstep, voffB); PG8_STAGE_A(PG8_SA(0, 1), cA, 1, false);
    if (wr == 1) PG8_BAR;
    PG8_WAIT_V(4); PG8_BAR;
    PG8_STAGE(PG8_SB(1, 0), cB + kstep, voffB); PG8_STAGE_A(PG8_SA(1, 0), cA + kstep, 0, false); PG8_STAGE(PG8_SB(1, 1), cB + hstep + kstep, voffB);
    PG8_WAIT_V(6); PG8_BAR;
    PG8_SCHED;
    f32x4 acc[2][2][4][2];
#pragma unroll
    for (int a = 0; a < 2; ++a)
#pragma unroll
        for (int b = 0; b < 2; ++b)
#pragma unroll
            for (int m = 0; m < 4; ++m)
#pragma unroll
                for (int n = 0; n < 2; ++n) acc[a][b][m][n] = (f32x4){0.f, 0.f, 0.f, 0.f};
    bf16x8 At[4][2], B0[2][2], B1[2][2];
    for (;;) {
        const bool has_next = S.next(ui + 1, nxt);
        unsigned nA = cA, nB = cB; if (has_next) S.ptrs(nxt, nA, nB);
        if constexpr (GA) { if (has_next) S.rows(nxt, tid, nvA); }
        for (int t = 0; t < nt; t += 2) {
            if constexpr (Epi::MID_T > 0) { if (t == Epi::MID_T) E.mid(acc, cur, wr, wc, fr, fq); }
            const bool last = (t == nt - 2);
            const unsigned a1 = cA + (unsigned)(t + 1) * kstep;
            const unsigned a2 = last ? nA : cA + (unsigned)(t + 2) * kstep, b2 = last ? nB : cB + (unsigned)(t + 2) * kstep;
            const unsigned a3 = a2 + kstep, b3 = b2 + kstep;
            PG8_LDB(B0, 0, 0); PG8_SCHED; PG8_LDA(At, 0, 0); PG8_STAGE_A(PG8_SA(1, 1), a1, 1, false);
            PG8_WAIT_L(8); PG8_BAR; PG8_WAIT_L(0); PG8_MMA(0, 0, At, B0); PG8_BAR; PG8_SCHED;
            PG8_LDB(B1, 0, 1); PG8_STAGE(PG8_SB(0, 0), b2, voffB);
            PG8_BAR; PG8_WAIT_L(0); PG8_MMA(0, 1, At, B1); PG8_BAR;
            PG8_LDA(At, 0, 1); PG8_STAGE_A(PG8_SA(0, 0), a2, 0, last);
            PG8_BAR; PG8_WAIT_L(0); PG8_MMA(1, 0, At, B0); PG8_BAR; PG8_SCHED;
            PG8_STAGE(PG8_SB(0, 1), b2 + hstep, voffB);
            PG8_WAIT_V(6); PG8_BAR; PG8_MMA(1, 1, At, B1); PG8_BAR;
            PG8_LDB(B0, 1, 0); PG8_SCHED; PG8_LDA(At, 1, 0); PG8_STAGE_A(PG8_SA(0, 1), a2, 1, last);
            PG8_WAIT_L(8); PG8_BAR; PG8_WAIT_L(0); PG8_MMA(0, 0, At, B0); PG8_BAR; PG8_SCHED;
            PG8_LDB(B1, 1, 1); PG8_STAGE(PG8_SB(1, 0), b3, voffB);
            PG8_BAR; PG8_WAIT_L(0); PG8_MMA(0, 1, At, B1); PG8_BAR;
            PG8_LDA(At, 1, 1); PG8_STAGE_A(PG8_SA(1, 0), a3, 0, last);
            PG8_BAR; PG8_WAIT_L(0); PG8_MMA(1, 0, At, B0); PG8_BAR; PG8_SCHED;
            PG8_STAGE(PG8_SB(1, 1), b3 + hstep, voffB);
            PG8_WAIT_V(6); PG8_BAR; PG8_MMA(1, 1, At, B1); PG8_BAR;
        }
        E(acc, cur, wr, wc, fr, fq);
        if (!has_next) break;
#pragma unroll
        for (int a = 0; a < 2; ++a)
#pragma unroll
            for (int b = 0; b < 2; ++b)
#pragma unroll
                for (int m = 0; m < 4; ++m)
#pragma unroll
                    for (int n = 0; n < 2; ++n) acc[a][b][m][n] = (f32x4){0.f, 0.f, 0.f, 0.f};
        cur = nxt; cA = nA; cB = nB; ++ui;
        if constexpr (GA) { vA[0] = nvA[0]; vA[1] = nvA[1]; }
    }
    PG8_WAIT_V(0);
    if (wr == 0) PG8_BAR;
    PG8_BAR;
#undef PG8_SA
#undef PG8_SB
#undef PG8_STAGE
#undef PG8_STAGE_A
#undef PG8_STAGE_G
#undef PG8_LDA
#undef PG8_LDB
#undef PG8_MMA
#undef PG8_WAIT_V
#undef PG8_WAIT_L
#undef PG8_BAR
#undef PG8_SCHED
}
}

struct TJob { const float* src; bf16_t* dst; int ld, k0, n0, mode, kdst; };
__device__ __forceinline__ void tcvt_load(const TJob& J, float4 (&v)[4], int tid) {
#pragma unroll
    for (int i = 0; i < 4; ++i) {
        const int kk = (tid >> 4) + 16 * i, c4 = (tid & 15) * 4, cd = J.n0 + c4;
        int orig = cd; bool ok = true;
        if (J.mode == 1) {
            if (cd < 896) orig = cd;
            else if (cd < 1024) orig = cd - 896 + 1024;
            else if (cd < 2048) { const int q = cd - 1024, hd = q >> 6, pp = q & 63;
                const int d = (pp & 4) ? 32 + 4 * (pp >> 3) + (pp & 3) : 4 * (pp >> 3) + (pp & 3);
                orig = 1304 + hd * 64 + d; }
            else if (cd < 5120) orig = cd - 2048 + 3352;
            else if (cd < 5144) orig = cd - 5120 + 1280;
            else if (cd < 5376) ok = false;
            else if (cd < 5504) orig = cd - 5376 + 896;
            else if (cd < 5632) orig = cd - 5504 + 1152;
            else orig = cd - 5632 + 2328;
        }
        v[i] = make_float4(0.f, 0.f, 0.f, 0.f);
        if (ok) v[i] = *(const float4*)(J.src + (size_t)(J.k0 + kk) * J.ld + orig);
    }
}
__device__ __forceinline__ void tcvt_finish(const TJob& J, const float4 (&v)[4], unsigned char* lds, int tid) {
    float* tile = (float*)lds;
#pragma unroll
    for (int i = 0; i < 4; ++i) {
        const int kk = (tid >> 4) + 16 * i, c4 = (tid & 15) * 4;
        tile[kk * 65 + c4 + 0] = v[i].x; tile[kk * 65 + c4 + 1] = v[i].y; tile[kk * 65 + c4 + 2] = v[i].z; tile[kk * 65 + c4 + 3] = v[i].w;
    }
    __syncthreads();
#pragma unroll
    for (int i = 0; i < 2; ++i) {
        const int q = tid + 256 * i, n = q >> 3, kc = q & 7;
        float x[8];
#pragma unroll
        for (int j = 0; j < 8; ++j) x[j] = tile[(kc * 8 + j) * 65 + n];
        u32x4 w; w.x = pack2(x[0], x[1]); w.y = pack2(x[2], x[3]); w.z = pack2(x[4], x[5]); w.w = pack2(x[6], x[7]);
        int drow = J.n0 + n; if (J.mode >= 2) drow = 8 * (drow >> 2) + (drow & 3) + (J.mode == 3 ? 4 : 0);
        *(u32x4*)(J.dst + (size_t)drow * J.kdst + J.k0 + kc * 8) = w;
    }
    __syncthreads();
}
__device__ __forceinline__ void tcvt_tile(const float* src, int ld_src, int k0, int n0, int mode, bf16_t* dst, int kdst, unsigned char* lds, int half) {
    TJob J; J.src = src; J.dst = dst; J.ld = ld_src; J.k0 = k0; J.n0 = n0; J.mode = mode; J.kdst = kdst;
    const int tid = (ltid() & 255); float4 v[4];
    tcvt_load(J, v, tid); tcvt_finish(J, v, lds, tid);
}

__device__ __forceinline__ void tcvt_decode(const Params& p, unsigned char* ws, int layer, int t, TJob& J) {
    constexpr int J0 = 16 * 104, J1 = 8 * 16, J2 = 256, J3 = 256, J4 = 2048, J5 = 2048;
    int u = t;
        if (u < J0) { J.src = p.w_in + (size_t)layer * 1024 * DIN; J.ld = DIN; J.k0 = (u % 16) * 64; J.n0 = (u / 16) * 64; J.mode = 1; J.dst = (bf16_t*)(ws + WS_WIN); J.kdst = 1024; return; }
        u -= J0;
        if (u < J1) { J.src = p.w_br_a + (size_t)layer * 512 * 1024; J.ld = 1024; J.k0 = (u % 8) * 64; J.n0 = (u / 8) * 64; J.mode = 0; J.dst = (bf16_t*)(ws + WS_WA); J.kdst = 1536; return; }
        u -= J1;
        if (u < J2) { J.src = p.w_br_b + (size_t)layer * 1024 * 1024; J.ld = 1024; J.k0 = (u % 16) * 64; J.n0 = (u / 16) * 64; J.mode = 0; J.dst = (bf16_t*)(ws + WS_WA) + 512; J.kdst = 1536; return; }
        u -= J2;
        if (u < J3) { J.src = p.w_o + (size_t)layer * 1024 * 1024; J.ld = 1024; J.k0 = (u % 16) * 64; J.n0 = (u / 16) * 64; J.mode = 0; J.dst = (bf16_t*)(ws + WS_WO); J.kdst = 1024; return; }
        u -= J3;
        if (u < J4 + J5) {
            const bool up = u >= J4; if (up) u -= J4;
            const int e = u / 128, v = u % 128;
            J.src = (up ? p.w_up : p.w_gate) + ((size_t)layer * NE + e) * 1024 * 512; J.ld = 512; J.k0 = (v % 16) * 64; J.n0 = (v / 16) * 64; J.mode = up ? 3 : 2;
            J.dst = (bf16_t*)(ws + WS_WG) + (size_t)e * 1024 * 1024; J.kdst = 1024; return;
        }
        u -= J4 + J5;
        { const int e = u / 128, v = u % 128;
          J.src = p.w_down + ((size_t)layer * NE + e) * 512 * 1024; J.ld = 1024; J.k0 = (v % 8) * 64; J.n0 = (v / 8) * 64; J.mode = 0; J.dst = (bf16_t*)(ws + WS_WD) + (size_t)e * 1024 * 512; J.kdst = 512; }
}


__device__ __forceinline__ void phase_pw(const Params& p, int layer, unsigned char* lds, int parts, int half, int skip = 0) {
    const int hq = __builtin_amdgcn_readfirstlane(ltid() >> 8);
    if ((int)(blockIdx.x * 2 + hq) < skip) return;
    const int bid = (blockIdx.x * 2 + hq) - skip, nblk = (gridDim.x * 2) - skip, tid = (ltid() & 255);
    unsigned char* ws = launder(p.ws);
    constexpr int J0 = 16 * 104, J1 = 8 * 16, J2 = 256, J3 = 256, J4 = 2048, J5 = 2048, J6 = 2048, JT = J0 + J1 + J2 + J3 + J4 + J5 + J6;
    const int t_lo = (parts & 1) ? 0 : (parts & 2) ? J0 : J0 + J1 + J2 + J3;
    const int t_hi = (parts & 4) ? JT : (parts & 2) ? J0 + J1 + J2 + J3 : (parts & 1) ? J0 : 0;
    if (t_lo + bid < t_hi) {
        float4 v[4]; { TJob J; tcvt_decode(p, ws, layer, t_lo + bid, J); tcvt_load(J, v, tid); }
        for (int t = t_lo + bid; t < t_hi; t += nblk) {
            float4 vn[4];
            if (t + nblk < t_hi) { TJob J; tcvt_decode(p, ws, layer, t + nblk, J); tcvt_load(J, vn, tid); }
            { TJob J; tcvt_decode(p, ws, layer, t, J); tcvt_finish(J, v, lds, tid); }
#pragma unroll
            for (int i = 0; i < 4; ++i) v[i] = vn[i];
        }
    }
    if (parts & 16) {
    for (int t = bid; t < 64; t += nblk) {
        const int kv = t >> 5, kt = t & 31;
        tcvt_tile(p.cmp_w1 + ((size_t)layer * 2 + kv) * 2048 * 64, 64, kt * 64, 0, 0, (bf16_t*)(ws + WS_W1T) + (size_t)kv * 64 * 2048, 2048, lds, half);
    }
    if (bid >= nblk - 2) {
        const int kv = nblk - 1 - bid, n = tid & 63, part = tid >> 6;
        const float* w1 = p.cmp_w1 + ((size_t)layer * 2 + kv) * 2048 * 64; const float* pos = p.cmp_pos + ((size_t)layer * 2 + kv) * 2048;
        float a = 0.f;
        for (int k = part * 512; k < part * 512 + 512; ++k) a += pos[k] * w1[(size_t)k * 64 + n];
        float* red = (float*)lds;
        __syncthreads(); red[tid] = a; __syncthreads();
        if (tid < 64) ((float*)(ws + WS_B1))[kv * 64 + tid] = red[tid] + red[tid + 64] + red[tid + 128] + red[tid + 192];
        __syncthreads();
    }
    }
    if (parts & 8) {
        const float4* xs = (const float4*)p.x; u32x2* xb = (u32x2*)(ws + WS_XB);
        for (size_t i = (size_t)bid * HT + tid; i < (size_t)T_ * 1024 / 4; i += (size_t)nblk * HT) {
            float4 v = xs[i]; u32x2 w; w.x = pack2(v.x, v.y); w.y = pack2(v.z, v.w); xb[i] = w;
        }
        for (int n = bid * HT + tid; n < 8192; n += nblk * HT) {
            int bk;
            if (n < 16) bk = n;
            else { const int th[15] = {22, 30, 40, 54, 73, 99, 134, 182, 246, 332, 450, 609, 825, 1117, 1513}; bk = 16;
#pragma unroll
                for (int k = 0; k < 15; ++k) bk += (n >= th[k]) ? 1 : 0; }
            (ws + WS_BUCKET)[n] = (unsigned char)bk;
        }
        for (int i = bid * HT + tid; i < 8192 * 32; i += nblk * HT) {
            const int pos = i >> 5, d = i & 31;
            const float inv = powf(10000.f, -(float)d * 2.0f / 64.f);
            const float ang = (float)pos * inv;
            float sn, cs; sincosf(ang, &sn, &cs);
            ((float2*)(ws + WS_ROPE))[i] = make_float2(cs, sn);
        }
        if (bid == 0) for (int i = tid; i < 8192; i += HT) ((unsigned*)(ws + WS_CTL))[i] = 0u;
    }
}

__device__ __forceinline__ float fsig(float x) { return __builtin_amdgcn_rcpf(1.f + __builtin_amdgcn_exp2f(-1.4426950408889634f * x)); }
template <int KIND>
__device__ __forceinline__ void g1_epi(const f32x4 (&acc)[2][2][4][2], unsigned char* ws, int r0, int c0, int wr, int wc, int fr, int fq) {
#pragma unroll
    for (int ai = 0; ai < 2; ++ai)
#pragma unroll
        for (int m = 0; m < 4; ++m) {
            const int row = r0 + 128 * ai + 64 * wr + 16 * m + fr + vzero();
#pragma unroll
            for (int bj = 0; bj < 2; ++bj) {
                const int col = c0 + 128 * bj + 32 * wc + 8 * fq;
                f32x4 v0 = acc[ai][bj][m][0], v1 = acc[ai][bj][m][1];
                if (KIND == 5) {
                    const int b = col >> 13, sq = col & (S_ - 1);
                    bf16_t* dst;
                    if (row < C_VW) { const int c = row - C_VS; dst = (bf16_t*)(ws + WS_VST) + ((size_t)(b * 2 + (c >> 6)) * 64 + (c & 63)) * S_ + sq; }
                    else if (row < C_VR) { const int c = row - C_VW; dst = (bf16_t*)(ws + WS_VWT) + ((size_t)(b * 2 + (c >> 6)) * 64 + (c & 63)) * S_ + sq; }
                    else { const int c = row - C_VR; dst = (bf16_t*)(ws + WS_VRT) + ((size_t)(b * 8 + (c >> 7)) * 128 + (c & 127)) * S_ + sq; }
                    u32x4 w; w.x = pack2(v0[0], v0[1]); w.y = pack2(v0[2], v0[3]); w.z = pack2(v1[0], v1[1]); w.w = pack2(v1[2], v1[3]);
                    *(u32x4*)dst = w;
                    continue;
                }
                if (KIND == 1 || KIND == 2) {
                    const float2* rope = (const float2*)(ws + WS_ROPE);
                    const int pos = row & (S_ - 1), d = 16 * (wc & 1) + 4 * fq;
                    const float4 cs01 = *(const float4*)(rope + pos * 32 + d), cs23 = *(const float4*)(rope + pos * 32 + d + 2);
                    const float c[4] = {cs01.x, cs01.z, cs23.x, cs23.z}, sn[4] = {cs01.y, cs01.w, cs23.y, cs23.w};
                    const float sc = (KIND == 2) ? 0.125f : 1.0f;
                    f32x4 y1, y2;
#pragma unroll
                    for (int r = 0; r < 4; ++r) { y1[r] = (v0[r] * c[r] - v1[r] * sn[r]) * sc; y2[r] = (v0[r] * sn[r] + v1[r] * c[r]) * sc; }
                    v0 = y1; v1 = y2;
                } else if (KIND == 3) {
#pragma unroll
                    for (int r = 0; r < 4; ++r) { v0[r] = v0[r] * fsig(v0[r]); v1[r] = v1[r] * fsig(v1[r]); }
                } else if (KIND == 4) {
#pragma unroll
                    for (int r = 0; r < 4; ++r) { v0[r] = fsig(v0[r]); v1[r] = fsig(v1[r]); }
                }
                u32x4 w; w.x = pack2(v0[0], v0[1]); w.y = pack2(v0[2], v0[3]); w.z = pack2(v1[0], v1[1]); w.w = pack2(v1[2], v1[3]);
                *(u32x4*)((bf16_t*)(ws + WS_P) + (size_t)row * LD + col) = w;
            }
        }
}
struct G1Order {      typedef pg8::Unit U; static constexpr bool GATHER = false;
    int xcd, slot, per;
    __device__ __forceinline__ bool next(int i, pg8::Unit& u) const {
        const int j = slot + i * per; if (j >= 208) return false;
        if (j < 192) { u.pm = j / 3; u.pn = xcd + 8 * (j % 3); } else { const int q = j - 192; u.pm = 8 * xcd + (q >> 1); u.pn = 24 + (q & 1); }
        return true;
    }
    __device__ __forceinline__ void ptrs(const pg8::Unit& u, unsigned& A, unsigned& B) const {
        const unsigned x = (unsigned)WS_XB + (unsigned)u.pm * (256u * 1024u * 2u), w = (unsigned)WS_WIN + (unsigned)u.pn * (256u * 1024u * 2u);
        if (u.pn >= 21) { A = w; B = x; } else { A = x; B = w; }
    }
};
struct G1Epi {
    static constexpr int MID_T = 0;
    unsigned char* ws;
    __device__ __forceinline__ void operator()(const f32x4 (&acc)[2][2][4][2], const pg8::Unit& u, int wr, int wc, int fr, int fq) const {
        const int pn = u.pn, tok0 = u.pm * 256, n0 = pn * 256;
        if (pn >= 21) g1_epi<5>(acc, ws, n0, tok0, wr, wc, fr, fq);
        else if (pn >= 12) g1_epi<4>(acc, ws, tok0, n0, wr, wc, fr, fq);
        else if (pn >= 8) g1_epi<3>(acc, ws, tok0, n0, wr, wc, fr, fq);
        else if (pn >= 6) g1_epi<2>(acc, ws, tok0, n0, wr, wc, fr, fq);
        else if (pn >= 4) g1_epi<1>(acc, ws, tok0, n0, wr, wc, fr, fq);
        else g1_epi<0>(acc, ws, tok0, n0, wr, wc, fr, fq);
    }
};
__device__ __forceinline__ void phase_g1(const Params& p, int layer, unsigned char* lds) {
    unsigned char* ws = launder(p.ws);
    G1Order S; S.xcd = blockIdx.x & 7; S.slot = blockIdx.x >> 3; S.per = gridDim.x >> 3;
    G1Epi E; E.ws = ws;
    pg8::gemm_phase<G1Epi, G1Order>(lds, 1024, S, E, ltid(), ws);
}

__device__ __forceinline__ void load_tile64(const bf16_t* base, size_t rowStride, unsigned char* dst, int wid, int lane) {
    const int c = ((lane & 7) ^ (lane >> 3)) * 8;
#pragma unroll
    for (int i = 0; i < 2; ++i) { const int j = wid + 4 * i, row = 8 * j + (lane >> 3); glds16(base + (size_t)row * rowStride + c, dst + j * 1024); }
}
__device__ __forceinline__ void load_tile128(const bf16_t* base, size_t rowStride, unsigned char* dst, int wid, int lane) {
    const int c = ((lane & 7) ^ (lane >> 3)) * 8;
#pragma unroll
    for (int i = 0; i < 4; ++i) { const int j = wid + 4 * i, row = 8 * j + (lane >> 3); glds16(base + (size_t)row * rowStride + c, dst + j * 1024); }
}
__device__ __forceinline__ void load_tile128w(const bf16_t* base, size_t rowStride, unsigned char* dst, int wid, int lane) {
    const int c = ((lane & 15) ^ ((4 * wid + (lane >> 4)) & 15)) * 8;
#pragma unroll
    for (int i = 0; i < 8; ++i) { const int j = wid + 4 * i, row = 4 * j + (lane >> 4); glds16(base + (size_t)row * rowStride + c, dst + j * 1024); }
}
__device__ __forceinline__ bf16x8 lds_frag128(const unsigned char* tile, int row, int chunk) {
    return *(const bf16x8*)(tile + row * 128 + ((chunk ^ (row & 7)) << 4));
}
__device__ __forceinline__ bf16x8 lds_frag256(const unsigned char* tile, int row, int chunk) {
    return *(const bf16x8*)(tile + row * 256 + ((chunk ^ (row & 15)) << 4));
}
__device__ __forceinline__ bf16x8 lds_vfrag128(const unsigned char* tile, int row, int kbase, int fq) {
    const int ca = (kbase >> 3) + (fq >> 1), hb = (fq & 1) * 8;
    const u32x2 a = *(const u32x2*)(tile + row * 128 + ((ca ^ (row & 7)) << 4) + hb);
    const u32x2 b = *(const u32x2*)(tile + row * 128 + (((ca + 2) ^ (row & 7)) << 4) + hb);
    u32x4 w; w.x = a.x; w.y = a.y; w.z = b.x; w.w = b.y;
    return __builtin_bit_cast(bf16x8, w);
}
__device__ __forceinline__ bf16x8 lds_vfrag256(const unsigned char* tile, int row, int kbase, int fq) {
    const int ca = (kbase >> 3) + (fq >> 1), hb = (fq & 1) * 8;
    const u32x2 a = *(const u32x2*)(tile + row * 256 + ((ca ^ (row & 15)) << 4) + hb);
    const u32x2 b = *(const u32x2*)(tile + row * 256 + (((ca + 2) ^ (row & 15)) << 4) + hb);
    u32x4 w; w.x = a.x; w.y = a.y; w.z = b.x; w.w = b.y;
    return __builtin_bit_cast(bf16x8, w);
}
__device__ __forceinline__ bf16x8 pack8(f32x4 a, f32x4 b) {
    u32x4 w; w.x = pack2(a[0], a[1]); w.y = pack2(a[2], a[3]); w.z = pack2(b[0], b[1]); w.w = pack2(b[2], b[3]);
    return __builtin_bit_cast(bf16x8, w);
}

__device__ __forceinline__ float gelu_tanh(float x) {
    const float u = 0.7978845608028654f * (x + 0.044715f * x * x * x);
    return 0.5f * x * (1.f + tanhf(u));
}
__device__ __forceinline__ void compress_item(const Params& p, int layer, int item, unsigned char* lds, int half) {
    unsigned char* ws = launder(p.ws);
    const int tid = (ltid() & 255), lane = tid & 63, wid = tid >> 6, wr = wid >> 1, wc = wid & 1, fr = lane & 15, fq = lane >> 4;
    const int mtile = item & 3, g = (item >> 2) & 1, b = (item >> 3) & 1, kv = item >> 4;
    const int i0 = mtile * 128;
    const bf16_t* P = (const bf16_t*)(ws + WS_P);
    const bf16_t* W1T = (const bf16_t*)(ws + WS_W1T) + (size_t)kv * 64 * 2048;
    const int col = (kv ? C_VC : C_KC) + g * 64;
    const int ldc = ((lane & 7) ^ (lane >> 3)) * 8;
    const int l0 = 16 * half;
    const bf16_t* ap[4];
#pragma unroll
    for (int i = 0; i < 4; ++i) ap[i] = P + ((size_t)b * S_ + 16 * (i0 + 32 * i + 8 * wid + (lane >> 3)) + l0) * LD + col + ldc;
    const bf16_t* bp[2];
#pragma unroll
    for (int i = 0; i < 2; ++i) bp[i] = W1T + (size_t)(8 * (wid + 4 * i) + (lane >> 3)) * 2048 + l0 * 64 + ldc;
    f32x4 acc[4][2];
#pragma unroll
    for (int i = 0; i < 4; ++i)
#pragma unroll
        for (int j = 0; j < 2; ++j) acc[i][j] = (f32x4){0.f, 0.f, 0.f, 0.f};
    __syncthreads();
#define CSTAGE(buf, l) do { unsigned char* st_ = lds + (buf) * 24576; \
        _Pragma("unroll") for (int i = 0; i < 4; ++i) glds16(ap[i] + (size_t)(l) * LD, st_ + (4 * i + wid) * 1024); \
        _Pragma("unroll") for (int i = 0; i < 2; ++i) glds16(bp[i] + (l) * 64, st_ + 16384 + (wid + 4 * i) * 1024); } while (0)
    CSTAGE(0, 0); CSTAGE(1, 1);
    for (int l = 0; l < 16; ++l) {
        const unsigned char* st = lds + (l % 3) * 24576;
        if (l + 1 < 16) WAIT_V(6); else WAIT_V(0);
        RAW_BARRIER();
        if (l + 2 < 16) CSTAGE((l + 2) % 3, l + 2);
#pragma unroll
        for (int ks = 0; ks < 2; ++ks) {
            bf16x8 a[4], bb[2];
#pragma unroll
            for (int i = 0; i < 4; ++i) a[i] = lds_frag128(st, 64 * wr + 16 * i + fr, 4 * ks + fq);
#pragma unroll
            for (int j = 0; j < 2; ++j) bb[j] = lds_frag128(st + 16384, 32 * wc + 16 * j + fr, 4 * ks + fq);
#pragma unroll
            for (int i = 0; i < 4; ++i)
#pragma unroll
                for (int j = 0; j < 2; ++j) acc[i][j] = mfma16(a[i], bb[j], acc[i][j]);
        }
    }
    __syncthreads();
#undef CSTAGE
    float* xch = (float*)(lds - half * HALF_LDS + HALF_LDS);
    if (half == 1) {
#pragma unroll
        for (int i = 0; i < 4; ++i)
#pragma unroll
            for (int j = 0; j < 2; ++j)
#pragma unroll
                for (int r = 0; r < 4; ++r) xch[((i * 2 + j) * 4 + r) * 256 + tid] = acc[i][j][r];
    }
    __syncthreads();
    if (half == 0) {
        const float* b1 = (const float*)(ws + WS_B1) + kv * 64;
#pragma unroll
        for (int j = 0; j < 2; ++j) {
            const int n = 32 * wc + 16 * j + fr; const float bias = b1[n + vzero()];
#pragma unroll
            for (int i = 0; i < 4; ++i)
#pragma unroll
                for (int r = 0; r < 4; ++r) {
                    const int row = 64 * wr + 16 * i + 4 * fq + r;
                    const float hv = gelu_tanh(acc[i][j][r] + xch[((i * 2 + j) * 4 + r) * 256 + tid] + bias);
                    *(bf16_t*)(lds + row * 128 + (((n >> 3) ^ (row & 7)) << 4) + (n & 7) * 2) = f2bf(hv);
                }
        }
        const float* w2 = p.cmp_w2 + ((size_t)layer * 2 + kv) * 64 * 64;
        const int k = tid >> 2, n0 = (tid & 3) * 16;
#pragma unroll
        for (int q4 = 0; q4 < 4; ++q4) {
            const float4 w = *(const float4*)(w2 + k * 64 + n0 + 4 * q4);
            const float wv[4] = {w.x, w.y, w.z, w.w};
#pragma unroll
            for (int e = 0; e < 4; ++e) { const int n = n0 + 4 * q4 + e; *(bf16_t*)(lds + 16384 + n * 128 + (((k >> 3) ^ (n & 7)) << 4) + (k & 7) * 2) = f2bf(wv[e]); }
        }
    }
    __syncthreads();
    if (half == 0) {
        f32x4 o[4][2];
#pragma unroll
        for (int i = 0; i < 4; ++i)
#pragma unroll
            for (int j = 0; j < 2; ++j) o[i][j] = (f32x4){0.f, 0.f, 0.f, 0.f};
#pragma unroll
        for (int ks = 0; ks < 2; ++ks) {
            bf16x8 a[4], bb[2];
#pragma unroll
            for (int i = 0; i < 4; ++i) a[i] = lds_frag128(lds, 64 * wr + 16 * i + fr, 4 * ks + fq);
#pragma unroll
            for (int j = 0; j < 2; ++j) bb[j] = lds_frag128(lds + 16384, 32 * wc + 16 * j + fr, 4 * ks + fq);
#pragma unroll
            for (int i = 0; i < 4; ++i)
#pragma unroll
                for (int j = 0; j < 2; ++j) o[i][j] = mfma16(a[i], bb[j], o[i][j]);
        }
#pragma unroll
        for (int i = 0; i < 4; ++i)
#pragma unroll
            for (int j = 0; j < 2; ++j) {
                const int n = 32 * wc + 16 * j + fr, ci = i0 + 64 * wr + 16 * i + 4 * fq;
                f32x4 v = o[i][j];
#pragma unroll
                for (int r = 0; r < 4; ++r) if (ci + r >= 511) v[r] = 0.f;
                if (kv == 0) {
                    bf16_t* dst = (bf16_t*)(ws + WS_KCC) + ((size_t)(b * 2 + g) * 512 + ci) * 64 + n;
#pragma unroll
                    for (int r = 0; r < 4; ++r) dst[r * 64] = f2bf(v[r]);
                } else {
                    *(u32x2*)((bf16_t*)(ws + WS_VCCT) + ((size_t)(b * 2 + g) * 64 + n) * 512 + ci) = pack4(v);
                }
            }
    }
    __syncthreads();
}

__device__ __forceinline__ float ret_lg2(int h) { const float gam = 1.f - exp2f(-5.f - (float)h); return log2f(gam); }

__device__ __forceinline__ void retkv_item(const Params& p, int item, unsigned char* lds, int half) {
    unsigned char* ws = launder(p.ws);
    const int tid = (ltid() & 255), lane = tid & 63, wid = tid >> 6, fr = lane & 15, fq = lane >> 4;
    const int n = item & 63, h = (item >> 6) & 7, b = item >> 9;
    const size_t tok0 = (size_t)b * S_ + 128 * n;
    unsigned char* vL = lds; unsigned char* kL = lds + 32768;
    load_tile128w((const bf16_t*)(ws + WS_VRT) + ((size_t)(b * 8 + h) * 128) * S_ + 128 * n, S_, vL, wid, lane);
    load_tile128((const bf16_t*)(ws + WS_P) + tok0 * LD + C_KR + h * 64, LD, kL, wid, lane);
    wait_vm0(); __syncthreads();
    const float lg2 = ret_lg2(h);
    f32x4 acc[2][4];
#pragma unroll
    for (int m = 0; m < 2; ++m)
#pragma unroll
        for (int nt = 0; nt < 4; ++nt) acc[m][nt] = (f32x4){0.f, 0.f, 0.f, 0.f};
#pragma unroll
    for (int ks = 0; ks < 4; ++ks) {
        bf16x8 a[2], bb[4];
#pragma unroll
        for (int m = 0; m < 2; ++m) a[m] = lds_frag256(vL, 32 * wid + 16 * m + fr, 4 * ks + fq);
        float dec[8];
#pragma unroll
        for (int j = 0; j < 8; ++j) dec[j] = exp2f((float)(127 - (32 * ks + 8 * fq + j)) * lg2);
#pragma unroll
        for (int nt = 0; nt < 4; ++nt) {
            const int d = 16 * nt + fr;
            float v[8];
#pragma unroll
            for (int j = 0; j < 8; ++j) {
                const int tk = 32 * ks + 8 * fq + j;
                const bf16_t kvv = *(const bf16_t*)(kL + tk * 128 + (((d >> 3) ^ (tk & 7)) << 4) + (d & 7) * 2);
                v[j] = bf2f(kvv) * dec[j];
            }
            u32x4 w; w.x = pack2(v[0], v[1]); w.y = pack2(v[2], v[3]); w.z = pack2(v[4], v[5]); w.w = pack2(v[6], v[7]);
            bb[nt] = __builtin_bit_cast(bf16x8, w);
        }
#pragma unroll
        for (int m = 0; m < 2; ++m)
#pragma unroll
            for (int nt = 0; nt < 4; ++nt) acc[m][nt] = mfma16(a[m], bb[nt], acc[m][nt]);
    }
    float* KVT = (float*)(ws + WS_KVT) + ((size_t)(b * 8 + h) * 64 + n) * 8192;
#pragma unroll
    for (int m = 0; m < 2; ++m)
#pragma unroll
        for (int nt = 0; nt < 4; ++nt)
#pragma unroll
            for (int r = 0; r < 4; ++r) KVT[(32 * wid + 16 * m + 4 * fq + r) * 64 + 16 * nt + fr] = acc[m][nt][r];
    __syncthreads();
}

__device__ __forceinline__ void phase_p2(const Params& p, int layer, unsigned char* lds, int half) {
    const int vb = blockIdx.x * 2 + half, nvb = gridDim.x * 2;
    if (vb < 64) compress_item(p, layer, vb >> 1, lds, half);
    else for (int it = vb - 64; it < 1024; it += nvb - 64) retkv_item(p, it, lds, half);
}

constexpr int NSA_IMP = 32768, NSA_BUCKET = 65792, NSA_BIAS = 73984;

struct NsaLane { int t; int fr, fq, wid, lane; };

constexpr float LOG2E = 1.4426950408889634f;
__device__ __forceinline__ int t5_first(int bk) {
    const int th[16] = {16, 22, 30, 40, 54, 73, 99, 134, 182, 246, 332, 450, 609, 825, 1117, 1513};
    int r = 16;
#pragma unroll
    for (int k = 0; k < 16; ++k) r = (bk == 16 + k) ? th[k] : r;
    return r;
}
template <int BR, int PASS>
__device__ __forceinline__ void nsa_half(const unsigned char* kL, const unsigned char* vL, const unsigned char* lds, const bf16x8 (&qptr)[4][2],
                                         f32x4 (&O)[4][4], float (&m)[4], float (&l)[4], int tile, int hf, const NsaLane& L, int qrow, const bool FAST, int th, int b0, int b1) {
    const int fr = L.lane & 15, fq = L.lane >> 4;
    constexpr float C2 = 0.125f * LOG2E;
    bf16x8 Kf[2][2];
#pragma unroll
    for (int i = 0; i < 2; ++i)
#pragma unroll
        for (int ks = 0; ks < 2; ++ks) Kf[i][ks] = lds_frag128(kL, 32 * hf + 16 * i + fr, 4 * ks + fq);
    bf16x8 Vf[4];
    if (PASS != 0) {
#pragma unroll
        for (int mt = 0; mt < 4; ++mt) Vf[mt] = lds_vfrag128(vL, 16 * mt + fr, 32 * hf, fq);
    }
    unsigned vmask = 0; unsigned bk[2] = {0u, 0u}; bool hi[2][4];
    if (!FAST) {
        const unsigned char* bucketL = lds + NSA_BUCKET;
#pragma unroll
        for (int i = 0; i < 2; ++i) {
            unsigned pk = 0;
#pragma unroll
            for (int r = 0; r < 4; ++r) {
                const int kk = 32 * hf + 16 * i + 4 * fq + r;
                int rel; bool ok;
                if (BR == 0) { rel = L.t - (16 * (64 * tile + kk) + 31); ok = rel >= 0; }
                else { rel = L.t - (64 * tile + kk); ok = rel >= 0 && rel < 512; }
                int rc = rel < 0 ? 0 : rel; rc = rc > 8191 ? 8191 : rc;
                pk |= (unsigned)bucketL[rc] << (8 * r);
                vmask |= (ok ? 1u : 0u) << (4 * i + r);
                hi[i][r] = false;
            }
            bk[i] = pk;
        }
    } else {
        const int kbase = 64 * tile + 32 * hf + 4 * fq;
        const int lim = BR == 0 ? L.t - th - 31 - 16 * kbase : L.t - th - kbase;
#pragma unroll
        for (int i = 0; i < 2; ++i)
#pragma unroll
            for (int r = 0; r < 4; ++r) hi[i][r] = (BR == 0 ? 16 : 1) * (16 * i + r) <= lim;
    }
    const float* biasL = (const float*)(lds + NSA_BIAS);
    float ia[2] = {0.f, 0.f}, ic[2] = {0.f, 0.f};
#pragma unroll
    for (int nt = 0; nt < 4; ++nt) {
        f32x4 S[2];
        const bf16x8 q0 = qptr[nt][0], q1 = qptr[nt][1];
#pragma unroll
        for (int i = 0; i < 2; ++i) {
            S[i] = (f32x4){0.f, 0.f, 0.f, 0.f};
            S[i] = mfma16(Kf[i][0], q0, S[i]); S[i] = mfma16(Kf[i][1], q1, S[i]);
        }
        float tmax = -1e30f;
        if (!FAST) {
#pragma unroll
            for (int i = 0; i < 2; ++i) {
                float bsv[4];
#pragma unroll
                for (int r = 0; r < 4; ++r) bsv[r] = biasL[nt * 32 + ((bk[i] >> (8 * r)) & 0xffu)];
                asm volatile("" : "+v"(bsv[0]), "+v"(bsv[1]), "+v"(bsv[2]), "+v"(bsv[3]));
#pragma unroll
                for (int r = 0; r < 4; ++r) {
                    const bool ok = (vmask >> (4 * i + r)) & 1u;
                    const float sv = S[i][r] * C2 + bsv[r];
                    S[i][r] = ok ? sv : -1e30f; tmax = fmaxf(tmax, S[i][r]);
                }
            }
        } else {
            const float blo = biasL[nt * 32 + b0], bhi = biasL[nt * 32 + b1];
#pragma unroll
            for (int i = 0; i < 2; ++i)
#pragma unroll
                for (int r = 0; r < 4; ++r) { S[i][r] = S[i][r] * C2 + (hi[i][r] ? bhi : blo); tmax = fmaxf(tmax, S[i][r]); }
        }
        if (PASS != 1) {
            if (__builtin_amdgcn_ballot_w64(tmax > m[nt] + 8.f) != 0ull) {
                const float tm = rows_max(tmax);
                const float mnew = tm > m[nt] + 8.f ? tm : m[nt], alpha = __builtin_amdgcn_exp2f(m[nt] - mnew);
                l[nt] *= alpha; m[nt] = mnew;
                if (PASS == 2) {
#pragma unroll
                    for (int mt = 0; mt < 4; ++mt) O[mt][nt] = O[mt][nt] * alpha;
                }
            }
            float psum = 0.f;
#pragma unroll
            for (int i = 0; i < 2; ++i)
#pragma unroll
                for (int r = 0; r < 4; ++r) S[i][r] = __builtin_amdgcn_exp2f(S[i][r] - m[nt]);
            if (!FAST) {
#pragma unroll
                for (int i = 0; i < 2; ++i)
#pragma unroll
                    for (int r = 0; r < 4; ++r) { const bool ok = (vmask >> (4 * i + r)) & 1u; S[i][r] = ok ? S[i][r] : 0.f; }
            }
#pragma unroll
            for (int i = 0; i < 2; ++i)
#pragma unroll
                for (int r = 0; r < 4; ++r) psum += S[i][r];
            l[nt] += psum;
        } else {
#pragma unroll
            for (int i = 0; i < 2; ++i) {
#pragma unroll
                for (int r = 0; r < 4; ++r) S[i][r] = __builtin_amdgcn_exp2f(S[i][r] - m[nt]) * l[nt];
            }
            if (!FAST) {
#pragma unroll
                for (int i = 0; i < 2; ++i)
#pragma unroll
                    for (int r = 0; r < 4; ++r) { const bool ok = (vmask >> (4 * i + r)) & 1u; S[i][r] = ok ? S[i][r] : 0.f; }
            }
#pragma unroll
            for (int i = 0; i < 2; ++i) {
                ia[i] += S[i][0] + S[i][1] + S[i][2] + 0.5f * S[i][3];
                ic[i] += 0.5f * S[i][3];
            }
        }
        if (PASS != 0) {
            const bf16x8 Pb = pack8(S[0], S[1]);
#pragma unroll
            for (int mt = 0; mt < 4; ++mt) O[mt][nt] = mfma16(Vf[mt], Pb, O[mt][nt]);
        }
        if (nt & 1) __builtin_amdgcn_sched_barrier(0);
    }
    if (PASS == 1) {
        float* imp = (float*)(lds + NSA_IMP) + qrow * 129;
        asm volatile("" ::: "memory"); __builtin_amdgcn_wave_barrier();
#pragma unroll
        for (int i = 0; i < 2; ++i) { const int j = 16 * tile + 8 * hf + 4 * i + fq; imp[j] += ia[i]; }
        asm volatile("s_waitcnt lgkmcnt(0)" ::: "memory"); __builtin_amdgcn_wave_barrier();
#pragma unroll
        for (int i = 0; i < 2; ++i) { const int j = 16 * tile + 8 * hf + 4 * i + fq + 1; if (j < 128) imp[j] += ic[i]; }
        asm volatile("s_waitcnt lgkmcnt(0)" ::: "memory"); __builtin_amdgcn_wave_barrier();
    }
}
template <int BR, int PASS>
__device__ __forceinline__ void nsa_tile(const unsigned char* kL, const unsigned char* vL, const unsigned char* lds, const bf16x8 (&qptr)[4][2],
                                         f32x4 (&O)[4][4], float (&m)[4], float (&l)[4], int tile, const NsaLane& L, int qrow) {
    const int tq0 = __builtin_amdgcn_readfirstlane(L.t - (L.lane & 15));
#pragma unroll 1
    for (int hf = 0; hf < 2; ++hf) {
        const int kfirst = 64 * tile + 32 * hf, pmin = BR == 0 ? 16 * kfirst + 31 : kfirst, pmax = BR == 0 ? 16 * (kfirst + 31) + 31 : kfirst + 31;
        const int rmin = tq0 - pmax, rmax = tq0 + 15 - pmin;
        bool fast = false; int th = 0, b0 = 0, b1 = 0;
        if (rmin >= 16 && (BR != 2 || rmax < 512)) {
            const unsigned char* bucketL = lds + NSA_BUCKET;
            b0 = __builtin_amdgcn_readfirstlane((int)bucketL[rmin]); b1 = __builtin_amdgcn_readfirstlane((int)bucketL[rmax > 8191 ? 8191 : rmax]);
            if (b1 - b0 <= 1) { fast = true; th = b1 == b0 ? 0 : t5_first(b1); }
        }
        nsa_half<BR, PASS>(kL, vL, lds, qptr, O, m, l, tile, hf, L, qrow, fast, th, b0, b1);
    }
}

__device__ __forceinline__ void cmp_item(const Params& p, int item, unsigned char* lds, int half) {
    unsigned char* ws = launder(p.ws);
    const int tid = (ltid() & 255), lane = tid & 63, wid = tid >> 6, fr = lane & 15, fq = lane >> 4;
    const int combo = item & 3, qt = 127 - (item >> 2), b = combo >> 1, g = combo & 1;
    const int q0 = qt * 64, qrow = 16 * wid + fr;
    NsaLane L; L.t = q0 + qrow; L.fr = fr; L.fq = fq; L.wid = wid; L.lane = lane;
    const size_t tok = (size_t)b * S_ + L.t;
    const bf16_t* P = (const bf16_t*)(ws + WS_P);
    __syncthreads();
    if (tid < 128) ((float*)(lds + NSA_BIAS))[tid] = p.rel_bias[(tid & 31) * 8 + 4 * g + (tid >> 5)] * LOG2E;
    for (int i = tid; i < 64 * 129; i += HT) ((float*)(lds + NSA_IMP))[i] = 0.f;
    bf16x8 Qf[4][2];
#pragma unroll
    for (int nt = 0; nt < 4; ++nt)
#pragma unroll
        for (int ks = 0; ks < 2; ++ks) Qf[nt][ks] = *(const bf16x8*)(P + tok * LD + C_QA + (4 * g + nt) * 64 + 32 * ks + 8 * fq);
    __syncthreads();
    f32x4 O[4][4]; float m[4], l[4];
    const bf16_t* gates = P + tok * LD + C_GA + (4 * g) * 3;
    const bf16_t* kc = (const bf16_t*)(ws + WS_KCC) + (size_t)(b * 2 + g) * 512 * 64;
    const bf16_t* vc = (const bf16_t*)(ws + WS_VCCT) + (size_t)(b * 2 + g) * 64 * 512;
    const int ntc = ((q0 + 32) >> 4) / 64 + 1;
#pragma unroll
    for (int nt = 0; nt < 4; ++nt) { m[nt] = -1e30f; l[nt] = 0.f; }
    load_tile64(kc, 64, lds, wid, lane);
    wait_vm0(); __syncthreads();
    for (int it = 0; it < ntc; ++it) {
        unsigned char* cur = lds + (it & 1) * 16384;
        if (it + 1 < ntc) load_tile64(kc + (size_t)(it + 1) * 64 * 64, 64, lds + ((it + 1) & 1) * 16384, wid, lane);
        nsa_tile<0, 0>(cur, cur + 8192, lds, Qf, O, m, l, it, L, qrow);
        wait_vm0(); __syncthreads();
    }
#pragma unroll
    for (int nt = 0; nt < 4; ++nt) { l[nt] = rows_sum(l[nt]); l[nt] = l[nt] > 0.f ? 1.f / l[nt] : 0.f; }
#pragma unroll
    for (int mt = 0; mt < 4; ++mt)
#pragma unroll
        for (int nt = 0; nt < 4; ++nt) O[mt][nt] = (f32x4){0.f, 0.f, 0.f, 0.f};
    load_tile64(kc, 64, lds, wid, lane); load_tile64(vc, 512, lds + 8192, wid, lane);
    wait_vm0(); __syncthreads();
    for (int it = 0; it < ntc; ++it) {
        unsigned char* cur = lds + (it & 1) * 16384;
        if (it + 1 < ntc) { unsigned char* nx = lds + ((it + 1) & 1) * 16384;
            load_tile64(kc + (size_t)(it + 1) * 64 * 64, 64, nx, wid, lane); load_tile64(vc + (it + 1) * 64, 512, nx + 8192, wid, lane); }
        nsa_tile<0, 1>(cur, cur + 8192, lds, Qf, O, m, l, it, L, qrow);
        wait_vm0(); __syncthreads();
    }
    bf16_t* YC = (bf16_t*)(ws + WS_YC) + tok * 512 + (4 * g) * 64;
#pragma unroll
    for (int nt = 0; nt < 4; ++nt) {
        const float gt = bf2f(gates[nt * 3 + 0]);
#pragma unroll
        for (int mt = 0; mt < 4; ++mt) *(u32x2*)(YC + nt * 64 + 16 * mt + 4 * fq) = pack4(O[mt][nt] * gt);
    }
    const int cur = qt;
    {
        float* imp = (float*)(lds + NSA_IMP) + qrow * 129 + 32 * fq;
        asm volatile("s_waitcnt lgkmcnt(0)" ::: "memory"); __builtin_amdgcn_wave_barrier();
#pragma unroll
        for (int i = 0; i < 32; ++i) {
            const int j = 32 * fq + i;
            const float v = imp[i];
            imp[i] = j > cur ? -1.f : v + ((j == 0 || j == cur || j == cur - 1) ? 1.0e4f : 0.f);
        }
        unsigned word = 0;
#pragma unroll 1
        for (int round = 0; round < 16; ++round) {
            float bv = imp[0]; int bi = 0;
#pragma unroll
            for (int i = 1; i < 32; ++i) { const float v = imp[i]; if (v > bv) { bv = v; bi = i; } }
            int gi = 32 * fq + bi;
            {
                u32x2 rv = __builtin_amdgcn_permlane16_swap(__float_as_uint(bv), __float_as_uint(bv), false, false);
                u32x2 ri = __builtin_amdgcn_permlane16_swap((unsigned)gi, (unsigned)gi, false, false);
                float v0 = __uint_as_float(rv.x), v1 = __uint_as_float(rv.y); int i0 = (int)ri.x, i1 = (int)ri.y;
                if (v1 > v0 || (v1 == v0 && i1 < i0)) { v0 = v1; i0 = i1; }
                rv = __builtin_amdgcn_permlane32_swap(__float_as_uint(v0), __float_as_uint(v0), false, false);
                ri = __builtin_amdgcn_permlane32_swap((unsigned)i0, (unsigned)i0, false, false);
                v0 = __uint_as_float(rv.x); v1 = __uint_as_float(rv.y); i0 = (int)ri.x; i1 = (int)ri.y;
                if (v1 > v0 || (v1 == v0 && i1 < i0)) { v0 = v1; i0 = i1; }
                bv = v0; gi = i0;
            }
            if (bv >= 0.f && (gi >> 5) == fq) { word |= 1u << (gi & 31); imp[gi & 31] = -2.f; }
        }
        ((unsigned*)(ws + WS_SELW))[(tok * 2 + g) * 4 + fq] = word;
    }
}

__device__ __forceinline__ void win_item(const Params& p, int item, unsigned char* lds, int half) {
    unsigned char* ws = launder(p.ws);
    const int tid = (ltid() & 255), lane = tid & 63, wid = tid >> 6, fr = lane & 15, fq = lane >> 4;
    const int combo = item & 3, qt = 127 - (item >> 2), b = combo >> 1, g = combo & 1;
    const int q0 = qt * 64, qrow = 16 * wid + fr;
    NsaLane L; L.t = q0 + qrow; L.fr = fr; L.fq = fq; L.wid = wid; L.lane = lane;
    const size_t tok = (size_t)b * S_ + L.t;
    const bf16_t* P = (const bf16_t*)(ws + WS_P);
    __syncthreads();
    if (tid < 128) ((float*)(lds + NSA_BIAS))[tid] = p.rel_bias[(tid & 31) * 8 + 4 * g + (tid >> 5)] * LOG2E;
    bf16x8 Qf[4][2];
#pragma unroll
    for (int nt = 0; nt < 4; ++nt)
#pragma unroll
        for (int ks = 0; ks < 2; ++ks) Qf[nt][ks] = *(const bf16x8*)(P + tok * LD + C_QA + (4 * g + nt) * 64 + 32 * ks + 8 * fq);
    __syncthreads();
    f32x4 O[4][4]; float m[4], l[4];
    const bf16_t* gates = P + tok * LD + C_GA + (4 * g) * 3;
#pragma unroll
    for (int nt = 0; nt < 4; ++nt) { m[nt] = -1e30f; l[nt] = 0.f; }
#pragma unroll
    for (int mt = 0; mt < 4; ++mt)
#pragma unroll
        for (int nt = 0; nt < 4; ++nt) O[mt][nt] = (f32x4){0.f, 0.f, 0.f, 0.f};
    {
        const bf16_t* kb = P + ((size_t)b * S_) * LD + C_KW + g * 64;
        const bf16_t* vb = (const bf16_t*)(ws + WS_VWT) + (size_t)(b * 2 + g) * 64 * S_;
        const int k_lo = qt - 8 > 0 ? qt - 8 : 0, ntw = qt - k_lo + 1;
        load_tile64(kb + (size_t)k_lo * 64 * LD, LD, lds, wid, lane); load_tile64(vb + k_lo * 64, S_, lds + 8192, wid, lane);
        wait_vm0(); __syncthreads();
        for (int it = 0; it < ntw; ++it) {
            unsigned char* cu = lds + (it & 1) * 16384;
            if (it + 1 < ntw) { unsigned char* nx = lds + ((it + 1) & 1) * 16384;
                load_tile64(kb + (size_t)(k_lo + it + 1) * 64 * LD, LD, nx, wid, lane); load_tile64(vb + (k_lo + it + 1) * 64, S_, nx + 8192, wid, lane); }
            nsa_tile<2, 2>(cu, cu + 8192, lds, Qf, O, m, l, k_lo + it, L, qrow);
            wait_vm0(); __syncthreads();
        }
    }
    bf16_t* YW = (bf16_t*)(ws + WS_YW) + tok * 512 + (4 * g) * 64;
#pragma unroll
    for (int nt = 0; nt < 4; ++nt) {
        const float lt = rows_sum(l[nt]), gt = bf2f(gates[nt * 3 + 2]) * (lt > 0.f ? 1.f / lt : 0.f);
#pragma unroll
        for (int mt = 0; mt < 4; ++mt) *(u32x2*)(YW + nt * 64 + 16 * mt + 4 * fq) = pack4(O[mt][nt] * gt);
    }
}

constexpr int SEL_RING = 8, SEL_BUCKET = SEL_RING * 16384, SEL_BIAS2 = SEL_BUCKET + 8192;
template <bool FAST>
__device__ __forceinline__ void sel_ntile(const bf16x8 (&Kf)[4][2], const unsigned char* vL, int fr, int fq, const bf16x8& q0, const bf16x8& q1, f32x4 (&O)[4], float& m, float& l,
                                          bool sb, int relb, int th, float blo, float bhi, const unsigned char* lds, int hl) {
    f32x4 S[4];
#pragma unroll
    for (int i = 0; i < 4; ++i) { S[i] = (f32x4){0.f, 0.f, 0.f, 0.f}; S[i] = mfma16(Kf[i][0], q0, S[i]); S[i] = mfma16(Kf[i][1], q1, S[i]); }
    float tmax = -1e30f;
    const float scl = (!FAST || sb) ? 0.125f * LOG2E : 0.f;
    if (FAST) { blo = (sb ? blo : -1e30f) - m; bhi = (sb ? bhi : -1e30f) - m; }
    if (FAST) {
#pragma unroll
        for (int i = 0; i < 4; ++i)
#pragma unroll
            for (int r = 0; r < 4; ++r) { const int rel = relb - (16 * i + r); S[i][r] = S[i][r] * scl + (rel >= th ? bhi : blo); tmax = fmaxf(tmax, S[i][r]); }
    } else {
        unsigned bkt[4][4]; float bs[4][4];
#pragma unroll
        for (int i = 0; i < 4; ++i)
#pragma unroll
            for (int r = 0; r < 4; ++r) { const int rel = relb - (16 * i + r); int rc = rel < 0 ? 0 : rel; rc = rc > 8191 ? 8191 : rc; bkt[i][r] = (lds + SEL_BUCKET)[rc]; }
#pragma unroll
        for (int i = 0; i < 4; ++i)
#pragma unroll
            for (int r = 0; r < 4; ++r) bs[i][r] = ((const float*)(lds + SEL_BIAS2))[hl * 32 + bkt[i][r]];
        asm volatile("" : "+v"(bs[0][0]), "+v"(bs[0][1]), "+v"(bs[0][2]), "+v"(bs[0][3]), "+v"(bs[1][0]), "+v"(bs[1][1]), "+v"(bs[1][2]), "+v"(bs[1][3]),
                          "+v"(bs[2][0]), "+v"(bs[2][1]), "+v"(bs[2][2]), "+v"(bs[2][3]), "+v"(bs[3][0]), "+v"(bs[3][1]), "+v"(bs[3][2]), "+v"(bs[3][3]));
        const float ninf = -1e30f;
#pragma unroll
        for (int i = 0; i < 4; ++i)
#pragma unroll
            for (int r = 0; r < 4; ++r) {
                const int rel = relb - (16 * i + r);
                const float sv = S[i][r] * (0.125f * LOG2E) + (bs[i][r] - m);
                S[i][r] = (sb && rel >= 0) ? sv : ninf; tmax = fmaxf(tmax, S[i][r]);
            }
    }
    tmax = rows_max(tmax);
    if (__ballot(tmax > 8.f) != 0ull) {
        const float d = fmaxf(tmax, 0.f), alpha = __builtin_amdgcn_exp2f(-d);
        m += d; l *= alpha;
#pragma unroll
        for (int mt = 0; mt < 4; ++mt) O[mt] = O[mt] * alpha;
#pragma unroll
        for (int i = 0; i < 4; ++i)
#pragma unroll
            for (int r = 0; r < 4; ++r) S[i][r] -= d;
    }
    float psum = 0.f;
#pragma unroll
    for (int i = 0; i < 4; ++i)
#pragma unroll
        for (int r = 0; r < 4; ++r) { const float pv = __builtin_amdgcn_exp2f(S[i][r]); S[i][r] = pv; psum += pv; }
    l += rows_sum(psum);
    const bf16x8 Pb0 = pack8(S[0], S[1]), Pb1 = pack8(S[2], S[3]);
#pragma unroll
    for (int mt = 0; mt < 4; ++mt) { O[mt] = mfma16(lds_vfrag128(vL, 16 * mt + fr, 0, fq), Pb0, O[mt]); O[mt] = mfma16(lds_vfrag128(vL, 16 * mt + fr, 32, fq), Pb1, O[mt]); }
}
__device__ __forceinline__ void sel_ntile2_fast(const bf16x8 (&Kf)[4][2], const unsigned char* vL, int fr, int fq, const bf16x8 (&Qf)[2][2], f32x4 (&O)[2][4], float (&m)[2], float (&l)[2],
                                                const bool (&sb)[2], const int (&relb)[2], int th, float blo, float bhi) {
    f32x4 S[2][4]; float tmax[2], bl[2], bh[2], scl[2];
#pragma unroll
    for (int b = 0; b < 2; ++b)
#pragma unroll
        for (int i = 0; i < 4; ++i) { S[b][i] = (f32x4){0.f, 0.f, 0.f, 0.f}; S[b][i] = mfma16(Kf[i][0], Qf[b][0], S[b][i]); S[b][i] = mfma16(Kf[i][1], Qf[b][1], S[b][i]); }
#pragma unroll
    for (int b = 0; b < 2; ++b) { scl[b] = sb[b] ? 0.125f * LOG2E : 0.f; bl[b] = (sb[b] ? blo : -1e30f) - m[b]; bh[b] = (sb[b] ? bhi : -1e30f) - m[b]; tmax[b] = -1e30f; }
#pragma unroll
    for (int b = 0; b < 2; ++b)
#pragma unroll
        for (int i = 0; i < 4; ++i)
#pragma unroll
            for (int r = 0; r < 4; ++r) { const int rel = relb[b] - (16 * i + r); S[b][i][r] = S[b][i][r] * scl[b] + (rel >= th ? bh[b] : bl[b]); tmax[b] = fmaxf(tmax[b], S[b][i][r]); }
#pragma unroll
    for (int b = 0; b < 2; ++b) tmax[b] = rows_max(tmax[b]);
    if (__ballot(tmax[0] > 8.f || tmax[1] > 8.f) != 0ull) {
#pragma unroll
        for (int b = 0; b < 2; ++b) {
            const float d = fmaxf(tmax[b], 0.f), alpha = __builtin_amdgcn_exp2f(-d);
            m[b] += d; l[b] *= alpha;
#pragma unroll
            for (int mt = 0; mt < 4; ++mt) O[b][mt] = O[b][mt] * alpha;
#pragma unroll
            for (int i = 0; i < 4; ++i)
#pragma unroll
                for (int r = 0; r < 4; ++r) S[b][i][r] -= d;
        }
    }
    float psum[2] = {0.f, 0.f};
#pragma unroll
    for (int b = 0; b < 2; ++b)
#pragma unroll
        for (int i = 0; i < 4; ++i)
#pragma unroll
            for (int r = 0; r < 4; ++r) { const float pv = __builtin_amdgcn_exp2f(S[b][i][r]); S[b][i][r] = pv; psum[b] += pv; }
#pragma unroll
    for (int b = 0; b < 2; ++b) l[b] += rows_sum(psum[b]);
    bf16x8 P0[2], P1[2];
#pragma unroll
    for (int b = 0; b < 2; ++b) { P0[b] = pack8(S[b][0], S[b][1]); P1[b] = pack8(S[b][2], S[b][3]); }
#pragma unroll
    for (int mt = 0; mt < 4; ++mt) {
        const bf16x8 v0 = lds_vfrag128(vL, 16 * mt + fr, 0, fq), v1 = lds_vfrag128(vL, 16 * mt + fr, 32, fq);
#pragma unroll
        for (int b = 0; b < 2; ++b) { O[b][mt] = mfma16(v0, P0[b], O[b][mt]); O[b][mt] = mfma16(v1, P1[b], O[b][mt]); }
    }
}
template <bool FAST>
__device__ __forceinline__ void sel_tile(const unsigned char* kL, const unsigned char* vL, const unsigned char* lds, const bf16x8 (&Qf)[2][2], f32x4 (&O)[2][4], float (&m)[2], float (&l)[2],
                                         const bool (&sb)[2], const bool (&need)[2], const int (&relb)[2], int th, float blo, float bhi, int hl, int fr, int fq) {
    bf16x8 Kf[4][2];
#pragma unroll
    for (int i = 0; i < 4; ++i)
#pragma unroll
        for (int ks = 0; ks < 2; ++ks) Kf[i][ks] = lds_frag128(kL, 16 * i + fr, 4 * ks + fq);
    if (FAST && need[0] && need[1]) { sel_ntile2_fast(Kf, vL, fr, fq, Qf, O, m, l, sb, relb, th, blo, bhi); return; }
    if (need[0]) sel_ntile<FAST>(Kf, vL, fr, fq, Qf[0][0], Qf[0][1], O[0], m[0], l[0], sb[0], relb[0], th, blo, bhi, lds, hl);
    if (need[1]) sel_ntile<FAST>(Kf, vL, fr, fq, Qf[1][0], Qf[1][1], O[1], m[1], l[1], sb[1], relb[1], th, blo, bhi, lds, hl);
}
template <int VAR>
__device__ __forceinline__ void sel_item(const Params& p, int v, unsigned char* lds) {
    unsigned char* ws = launder(p.ws);
    const int tid = ltid(), lane = tid & 63, wid = tid >> 6, fr = lane & 15, fq = lane >> 4;
    const int qt = 127 - (v >> 2), sub = v & 3, b = sub >> 1, g = sub & 1;
    const int q0 = qt * 64, cur = qt, hl = fr & 3;
    const bf16_t* P = (const bf16_t*)(ws + WS_P);
    __syncthreads();
    if (tid < 128) ((float*)(lds + SEL_BIAS2))[tid] = p.rel_bias[(tid & 31) * 8 + 4 * g + (tid >> 5)] * LOG2E;
    int t[2]; size_t tok[2]; bf16x8 Qf[2][2]; unsigned selw[2][4];
#pragma unroll
    for (int nt = 0; nt < 2; ++nt) {
        t[nt] = q0 + 8 * wid + 4 * nt + (fr >> 2); tok[nt] = (size_t)b * S_ + t[nt];
#pragma unroll
        for (int ks = 0; ks < 2; ++ks) Qf[nt][ks] = *(const bf16x8*)(P + tok[nt] * LD + C_QA + (4 * g + hl) * 64 + 32 * ks + 8 * fq);
        const u32x4 w = *(const u32x4*)((const unsigned*)(ws + WS_SELW) + (tok[nt] * 2 + g) * 4);
        selw[nt][0] = w.x; selw[nt][1] = w.y; selw[nt][2] = w.z; selw[nt][3] = w.w;
    }
    f32x4 O[2][4]; float m[2], l[2];
#pragma unroll
    for (int nt = 0; nt < 2; ++nt) { m[nt] = -1000.f; l[nt] = 0.f;
#pragma unroll
        for (int mt = 0; mt < 4; ++mt) O[nt][mt] = (f32x4){0.f, 0.f, 0.f, 0.f}; }
    const bf16_t* kb = P + ((size_t)b * S_) * LD + C_KS + g * 64;
    const bf16_t* vb = (const bf16_t*)(ws + WS_VST) + (size_t)(b * 2 + g) * 64 * S_;
    const int nts = cur + 1;
#define SEL_ISSUE(jj) do { unsigned char* st_ = lds + ((jj) & 7) * 16384; const int c_ = ((lane & 7) ^ (lane >> 3)) * 8, r_ = 8 * wid + (lane >> 3); \
        glds16(kb + ((size_t)(jj) * 64 + r_) * LD + c_, st_ + wid * 1024); glds16(vb + (size_t)r_ * S_ + (jj) * 64 + c_, st_ + 8192 + wid * 1024); } while (0)
    asm volatile("s_waitcnt vmcnt(0)" ::: "memory");
#pragma unroll
    for (int q = 0; q < 4; ++q) if (q < nts) SEL_ISSUE(q);
    const unsigned char* bucketL = lds + SEL_BUCKET;
    for (int jp = 0; jp < nts; jp += 4) {
        WAIT_V(0);
        RAW_BARRIER();
#pragma unroll
        for (int q = 4; q < 8; ++q) if (jp + q < nts) SEL_ISSUE(jp + q);
#pragma unroll 1
      for (int j = jp; j < jp + 4 && j < nts; ++j) {
        const unsigned char* cu = lds + (j & 7) * 16384;
        bool sb[2], need[2]; int relb[2];
#pragma unroll
        for (int nt = 0; nt < 2; ++nt) {
            const unsigned w = j < 32 ? selw[nt][0] : j < 64 ? selw[nt][1] : j < 96 ? selw[nt][2] : selw[nt][3];
            sb[nt] = (w >> (j & 31)) & 1u; need[nt] = __ballot(sb[nt]) != 0ull; relb[nt] = t[nt] - 64 * j - 4 * fq;
        }
        if (VAR == 1) { need[0] = false; need[1] = false; }
        if (VAR == 2) { if (!(need[0] || need[1])) { need[0] = false; } else { need[0] = true; need[1] = true; } }
        if (need[0] || need[1]) {
            const int rmin = q0 - 64 * j - 63, rmax = q0 + 31 - 64 * j;
            bool fast = false; int th = 0; float blo = 0.f, bhi = 0.f;
            if (rmin >= 16) {
                const int b0 = bucketL[rmin], b1 = bucketL[rmax > 8191 ? 8191 : rmax];
                if (b1 - b0 <= 1) { fast = true; th = t5_first(b1); if (b1 == b0) th = 0;
                    blo = ((const float*)(lds + SEL_BIAS2))[hl * 32 + b0]; bhi = ((const float*)(lds + SEL_BIAS2))[hl * 32 + b1]; }
            }
            if (fast) sel_tile<true>(cu, cu + 8192, lds, Qf, O, m, l, sb, need, relb, th, blo, bhi, hl, fr, fq);
            else sel_tile<false>(cu, cu + 8192, lds, Qf, O, m, l, sb, need, relb, th, blo, bhi, hl, fr, fq);
        }
      }
    }
#undef SEL_ISSUE
    __syncthreads();
#pragma unroll
    for (int nt = 0; nt < 2; ++nt) {
        const float gt = bf2f(P[tok[nt] * LD + C_GA + (4 * g + hl) * 3 + 1]) * (l[nt] > 0.f ? 1.f / l[nt] : 0.f);
        const size_t o = tok[nt] * 512 + (4 * g + hl) * 64;
#pragma unroll
        for (int mt = 0; mt < 4; ++mt) {
            const f32x4 yc = unpack4(*(const u32x2*)((const bf16_t*)(ws + WS_YC) + o + 16 * mt + 4 * fq));
            const f32x4 yw = unpack4(*(const u32x2*)((const bf16_t*)(ws + WS_YW) + o + 16 * mt + 4 * fq));
            if (VAR == 0 || VAR == 3) *(u32x2*)((bf16_t*)(ws + WS_YA) + tok[nt] * 1536 + (4 * g + hl) * 64 + 16 * mt + 4 * fq) = pack4(yc + yw + O[nt][mt] * gt);
            else asm volatile("" :: "v"(O[nt][mt]));
        }
    }
}

__device__ __forceinline__ void scan_item(const Params& p, int item, int half) {
    unsigned char* ws = launder(p.ws);
    const int idx = item * HT + (ltid() & 255);
    const int bh = idx >> 13, ed = idx & 8191, h = bh & 7;
    const float dec = exp2f(128.f * ret_lg2(h));
    const float* KVT = (const float*)(ws + WS_KVT) + (size_t)bh * 64 * 8192 + ed;
    bf16_t* SPT = (bf16_t*)(ws + WS_SPT) + (size_t)bh * 64 * 8192 + ed;
    float s = 0.f;
    for (int n = 0; n < 64; ++n) { SPT[(size_t)n * 8192] = f2bf(s); s = s * dec + KVT[(size_t)n * 8192]; }
}

__device__ __forceinline__ void phase_p3(const Params& p, unsigned char* lds, int half, int what) {
    for (int i = (ltid() & 255); i < 8192 / 16; i += HT) ((u32x4*)(lds + NSA_BUCKET))[i] = ((const u32x4*)(launder(p.ws) + WS_BUCKET))[i];
    __syncthreads();
    for (int h = (blockIdx.x * 2 + half); h < 512; h += (gridDim.x * 2)) {
        if (what & 1) cmp_item(p, h, lds, half);
        if (what & 2) {
            if (h >= 128 && h < 384) win_item(p, h - 128, lds, half);
            else if (h >= 384) { win_item(p, 256 + 2 * (h - 384) - ((h & 1) ? 1 : 0) , lds, half); win_item(p, 256 + 2 * (h - 384) + ((h & 1) ? 0 : 1) + 1 - ((h & 1) ? 0 : 0), lds, half); }
        }
        if (what & 4) scan_item(p, h, half);
    }
}

__device__ __forceinline__ void retout_item(const Params& p, int item, unsigned char* lds, int half) {
    unsigned char* ws = launder(p.ws);
    const int tid = (ltid() & 255), lane = tid & 63, wid = tid >> 6, fr = lane & 15, fq = lane >> 4;
    const int n = item & 63, h = (item >> 6) & 7, b = item >> 9;
    const size_t tok0 = (size_t)b * S_ + 128 * n;
    const bf16_t* P = (const bf16_t*)(ws + WS_P);
    unsigned char* vL = lds; unsigned char* kL = lds + 32768; unsigned char* sL = lds + 49152;
    __syncthreads();
    load_tile128w((const bf16_t*)(ws + WS_VRT) + ((size_t)(b * 8 + h) * 128) * S_ + 128 * n, S_, vL, wid, lane);
    load_tile128(P + tok0 * LD + C_KR + h * 64, LD, kL, wid, lane);
    load_tile128((const bf16_t*)(ws + WS_SPT) + ((size_t)(b * 8 + h) * 64 + n) * 8192, 64, sL, wid, lane);
    bf16x8 Qf[2][2];
#pragma unroll
    for (int nt = 0; nt < 2; ++nt)
#pragma unroll
        for (int ks = 0; ks < 2; ++ks) Qf[nt][ks] = *(const bf16x8*)(P + (tok0 + 32 * wid + 16 * nt + fr) * LD + C_QR + h * 64 + 32 * ks + 8 * fq);
    wait_vm0(); __syncthreads();
    const float lg2 = ret_lg2(h);
    f32x4 Y[8][2];
#pragma unroll
    for (int m = 0; m < 8; ++m)
#pragma unroll
        for (int nt = 0; nt < 2; ++nt) Y[m][nt] = (f32x4){0.f, 0.f, 0.f, 0.f};
#pragma unroll
    for (int m = 0; m < 8; ++m)
#pragma unroll
        for (int ks = 0; ks < 2; ++ks) {
            const bf16x8 a = lds_frag128(sL, 16 * m + fr, 4 * ks + fq);
#pragma unroll
            for (int nt = 0; nt < 2; ++nt) Y[m][nt] = mfma16(a, Qf[nt][ks], Y[m][nt]);
        }
#pragma unroll
    for (int nt = 0; nt < 2; ++nt) {
        const float sc = exp2f((float)(32 * wid + 16 * nt + fr + 1) * lg2);
#pragma unroll
        for (int m = 0; m < 8; ++m) Y[m][nt] = Y[m][nt] * sc;
    }
#pragma unroll 1
    for (int s = 0; s < 4; ++s) {
        f32x4 St[2][2];
#pragma unroll
        for (int hh = 0; hh < 2; ++hh) {
            const int mt = 2 * s + hh;
#pragma unroll
            for (int nt = 0; nt < 2; ++nt) St[hh][nt] = (f32x4){0.f, 0.f, 0.f, 0.f};
#pragma unroll
            for (int ks = 0; ks < 2; ++ks) {
                const bf16x8 a = lds_frag128(kL, 16 * mt + fr, 4 * ks + fq);
#pragma unroll
                for (int nt = 0; nt < 2; ++nt) St[hh][nt] = mfma16(a, Qf[nt][ks], St[hh][nt]);
            }
#pragma unroll
            for (int nt = 0; nt < 2; ++nt) {
                const int qi = 32 * wid + 16 * nt + fr;
#pragma unroll
                for (int r = 0; r < 4; ++r) {
                    const int kj = 16 * mt + 4 * fq + r;
                    const float dm = qi >= kj ? exp2f((float)(qi - kj) * lg2) : 0.f;
                    St[hh][nt][r] *= dm;
                }
            }
        }
        bf16x8 Pb[2];
#pragma unroll
        for (int nt = 0; nt < 2; ++nt) Pb[nt] = pack8(St[0][nt], St[1][nt]);
#pragma unroll
        for (int m = 0; m < 8; ++m) {
            const bf16x8 a = lds_vfrag256(vL, 16 * m + fr, 32 * s, fq);
#pragma unroll
            for (int nt = 0; nt < 2; ++nt) Y[m][nt] = mfma16(a, Pb[nt], Y[m][nt]);
        }
    }
    bf16_t* YB = (bf16_t*)(ws + WS_YA) + 512;
#pragma unroll
    for (int nt = 0; nt < 2; ++nt) {
        float sum = 0.f;
#pragma unroll
        for (int m = 0; m < 8; ++m) sum += Y[m][nt][0] + Y[m][nt][1] + Y[m][nt][2] + Y[m][nt][3];
        sum = rows_sum(sum);
        const float mu = sum * (1.f / 128.f);
        float vs = 0.f;
#pragma unroll
        for (int m = 0; m < 8; ++m)
#pragma unroll
            for (int r = 0; r < 4; ++r) { const float dlt = Y[m][nt][r] - mu; vs += dlt * dlt; }
        vs = rows_sum(vs);
        const float rstd = rsqrtf(vs * (1.f / 128.f) + 1e-5f);
        const size_t tk = tok0 + 32 * wid + 16 * nt + fr;
#pragma unroll
        for (int m = 0; m < 8; ++m) {
            const f32x4 gt = unpack4(*(const u32x2*)(P + tk * LD + C_GR + h * 128 + 16 * m + 4 * fq));
            f32x4 v;
#pragma unroll
            for (int r = 0; r < 4; ++r) v[r] = (Y[m][nt][r] - mu) * rstd * gt[r];
            *(u32x2*)(YB + tk * 1536 + h * 128 + 16 * m + 4 * fq) = pack4(v);
        }
    }
}
__device__ __forceinline__ void phase_p4_sel(const Params& p, unsigned char* lds) {
    for (int i = ltid(); i < 8192 / 16; i += NTHREADS) ((u32x4*)(lds + SEL_BUCKET))[i] = ((const u32x4*)(launder(p.ws) + WS_BUCKET))[i];
    __syncthreads();
    for (int it = blockIdx.x; it < 512; it += gridDim.x * 2) {
        sel_item<0>(p, it, lds);
        if (511 - it != it) sel_item<0>(p, 511 - it, lds);
    }
    __syncthreads();
}
__device__ __forceinline__ void phase_p4(const Params& p, unsigned char* lds, int half) {
    for (int it = (blockIdx.x * 2 + half); it < 1024; it += (gridDim.x * 2)) retout_item(p, it, lds, half);
}

struct RowOrder {     typedef pg8::Unit U; static constexpr bool GATHER = false;
    unsigned a, b; int K, xcd, slot, per;
    __device__ __forceinline__ bool next(int i, pg8::Unit& u) const { const int t = xcd * 32 + slot + i * per; if (t >= (xcd + 1) * 32) return false; u.pm = t >> 2; u.pn = t & 3; return true; }
    __device__ __forceinline__ void ptrs(const pg8::Unit& u, unsigned& A, unsigned& B) const { A = a + (unsigned)u.pm * 512u * (unsigned)K; B = b + (unsigned)u.pn * 512u * (unsigned)K; }
};
template <int MODE>
struct MixEpi {
    static constexpr int MID_T = MODE == 0 ? 8 : 0;
    unsigned char* ws; const float* X;
    __device__ __forceinline__ void mid(f32x4 (&acc)[2][2][4][2], const pg8::Unit& u, int wr, int wc, int fr, int fq) const {
#pragma unroll
        for (int ai = 0; ai < 2; ++ai) {
            __builtin_amdgcn_sched_barrier(0);
#pragma unroll
            for (int m = 0; m < 4; ++m) {
                const size_t tok = (size_t)(u.pm * 256 + 128 * ai + 64 * wr + 16 * m + fr + vzero());
#pragma unroll
                for (int bj = 0; bj < 2; ++bj) {
                    const int n = u.pn * 256 + 128 * bj + 32 * wc + 8 * fq;
                    const u32x4 ga = *(const u32x4*)((const bf16_t*)(ws + WS_P) + tok * LD + C_MA + n), gb = *(const u32x4*)((const bf16_t*)(ws + WS_P) + tok * LD + C_MB + n);
                    const f32x4 a0 = unpack4((u32x2){ga.x, ga.y}), a1 = unpack4((u32x2){ga.z, ga.w}), b0 = unpack4((u32x2){gb.x, gb.y}), b1 = unpack4((u32x2){gb.z, gb.w});
#pragma unroll
                    for (int r = 0; r < 4; ++r) { acc[ai][bj][m][0][r] *= a0[r] * __builtin_amdgcn_rcpf(fmaxf(b0[r], 1e-30f)); acc[ai][bj][m][1][r] *= a1[r] * __builtin_amdgcn_rcpf(fmaxf(b1[r], 1e-30f)); }
                }
            }
        }
        __builtin_amdgcn_sched_barrier(0);
    }
    __device__ __forceinline__ void operator()(const f32x4 (&acc)[2][2][4][2], const pg8::Unit& u, int wr, int wc, int fr, int fq) const {
#pragma unroll
        for (int ai = 0; ai < 2; ++ai)
#pragma unroll
            for (int m = 0; m < 4; ++m) {
                const size_t tok = (size_t)(u.pm * 256 + 128 * ai + 64 * wr + 16 * m + fr + vzero());
#pragma unroll
                for (int bj = 0; bj < 2; ++bj) {
                    const int n = u.pn * 256 + 128 * bj + 32 * wc + 8 * fq;
                    const f32x4 v0 = acc[ai][bj][m][0], v1 = acc[ai][bj][m][1];
                    if (MODE == 2) {
                        const u32x4 xw = *(const u32x4*)((const bf16_t*)(ws + WS_XB) + tok * 1024 + n);
                        const f32x4 h0 = unpack4((u32x2){xw.x, xw.y}) * DN_ALPHA + v0, h1 = unpack4((u32x2){xw.z, xw.w}) * DN_ALPHA + v1;
                        u32x4 w; w.x = pack2(h0[0], h0[1]); w.y = pack2(h0[2], h0[3]); w.z = pack2(h1[0], h1[1]); w.w = pack2(h1[2], h1[3]);
                        *(u32x4*)((bf16_t*)(ws + WS_H1) + tok * 1024 + n) = w;
                    } else {
                        const u32x4 gw = *(const u32x4*)((const bf16_t*)(ws + WS_P) + tok * LD + C_MB + n);
                        const f32x4 g0 = unpack4((u32x2){gw.x, gw.y}), g1 = unpack4((u32x2){gw.z, gw.w});
                        const f32x4 o0 = g0 * v0, o1 = g1 * v1;
                        u32x4 w; w.x = pack2(o0[0], o0[1]); w.y = pack2(o0[2], o0[3]); w.z = pack2(o1[0], o1[1]); w.w = pack2(o1[2], o1[3]);
                        *(u32x4*)((bf16_t*)(ws + WS_MG) + tok * 1024 + n) = w;
                    }
                }
            }
    }
};
__device__ __forceinline__ void phase_g2(const Params& p, unsigned char* lds) {
    unsigned char* ws = launder(p.ws);
    RowOrder S; S.xcd = blockIdx.x & 7; S.slot = blockIdx.x >> 3; S.per = gridDim.x >> 3;
    S.a = (unsigned)WS_YA; S.b = (unsigned)WS_WA; S.K = 1536; MixEpi<0> E; E.ws = ws; E.X = nullptr;
    pg8::gemm_phase<MixEpi<0>, RowOrder>(lds, 1536, S, E, ltid(), ws);
}
__device__ __forceinline__ void phase_g3(const Params& p, int layer, unsigned char* lds) {
    unsigned char* ws = launder(p.ws);
    RowOrder S; S.xcd = blockIdx.x & 7; S.slot = blockIdx.x >> 3; S.per = gridDim.x >> 3; S.a = (unsigned)WS_MG; S.b = (unsigned)WS_WO; S.K = 1024;
    MixEpi<2> E; E.ws = ws; E.X = nullptr;
    pg8::gemm_phase<MixEpi<2>, RowOrder>(lds, 1024, S, E, ltid(), ws);
}

__device__ __forceinline__ void phase_ln1(const Params& p, int layer, unsigned char* lds, bool dry, int half) {
    unsigned char* ws = launder(p.ws);
    const int tid = (ltid() & 255), lane = tid & 63, wid = tid >> 6;
    float* wrL = (float*)lds;
    float* lgL = (float*)(lds - half * HALF_LDS + 65536);
    {
        float4 wv[16];
#pragma unroll
        for (int k = 0; k < 16; ++k) wv[k] = ((const float4*)p.w_router)[tid + 256 * k];
#pragma unroll
        for (int k = 0; k < 16; ++k) { const int i4 = tid + 256 * k, d = i4 >> 2, e0 = (i4 & 3) * 4;
            wrL[(e0 + 0) * 1024 + d] = wv[k].x; wrL[(e0 + 1) * 1024 + d] = wv[k].y; wrL[(e0 + 2) * 1024 + d] = wv[k].z; wrL[(e0 + 3) * 1024 + d] = wv[k].w; }
    }
    __syncthreads();
    const bf16_t* H1 = (const bf16_t*)(ws + WS_H1);
    bf16_t* X1B = (bf16_t*)(ws + WS_X1B);
    const float* gam = p.ln1_g + layer * 1024; const float* bet = p.ln1_b + layer * 1024;
    unsigned* cnt = (unsigned*)(ws + WS_CTL) + (dry ? 0 : CW_CNT) + layer * 1024;
    int* LIST = (int*)(ws + (dry ? WS_HB : WS_LIST)); float* WTS = (float*)(ws + (dry ? WS_HB + 4194304 : WS_WTS));
    constexpr int U = 4;
    const int nwave = (gridDim.x * 2) * 4, wv = (blockIdx.x * 2 + half) * 4 + wid;
    const int nloc = ((T_ - wv * U + nwave * U - 1) / (nwave * U)) * (4 * U);
    u32x2 vn[U][4];
#pragma unroll
    for (int u = 0; u < U; ++u)
#pragma unroll
        for (int j = 0; j < 4; ++j) vn[u][j] = *(const u32x2*)(H1 + (size_t)(wv * U + u) * 1024 + 256 * j + 4 * lane);
    for (int t0 = wv * U; t0 < T_; t0 += nwave * U) {
        float4 y[U][4]; float s[U], q[U];
#pragma unroll
        for (int u = 0; u < U; ++u) {
            s[u] = 0.f;
#pragma unroll
            for (int j = 0; j < 4; ++j) { const f32x4 t = unpack4(vn[u][j]); y[u][j].x = t[0]; y[u][j].y = t[1]; y[u][j].z = t[2]; y[u][j].w = t[3]; s[u] += (t[0] + t[1]) + (t[2] + t[3]); }
        }
        { const int tn = t0 + nwave * U < T_ ? t0 + nwave * U : t0;
#pragma unroll
          for (int u = 0; u < U; ++u)
#pragma unroll
              for (int j = 0; j < 4; ++j) vn[u][j] = *(const u32x2*)(H1 + (size_t)(tn + u) * 1024 + 256 * j + 4 * lane); }
#pragma unroll
        for (int u = 0; u < U; ++u) s[u] = wave_sum(s[u]) * (1.f / 1024.f);
#pragma unroll
        for (int u = 0; u < U; ++u) {
            q[u] = 0.f;
#pragma unroll
            for (int j = 0; j < 4; ++j) { const float a = y[u][j].x - s[u], b2 = y[u][j].y - s[u], c = y[u][j].z - s[u], d = y[u][j].w - s[u]; q[u] += a * a + b2 * b2 + c * c + d * d; }
        }
#pragma unroll
        for (int u = 0; u < U; ++u) q[u] = rsqrtf(wave_sum(q[u]) * (1.f / 1024.f) + 1e-5f);
#pragma unroll
        for (int j = 0; j < 4; ++j) {
            const int d0 = 256 * j + 4 * lane;
            const float4 gg = *(const float4*)(gam + d0), bb = *(const float4*)(bet + d0);
#pragma unroll
            for (int u = 0; u < U; ++u) {
                y[u][j].x = (y[u][j].x - s[u]) * q[u] * gg.x + bb.x; y[u][j].y = (y[u][j].y - s[u]) * q[u] * gg.y + bb.y;
                y[u][j].z = (y[u][j].z - s[u]) * q[u] * gg.z + bb.z; y[u][j].w = (y[u][j].w - s[u]) * q[u] * gg.w + bb.w;
                u32x2 w; w.x = pack2(y[u][j].x, y[u][j].y); w.y = pack2(y[u][j].z, y[u][j].w);
                *(u32x2*)(X1B + (size_t)(t0 + u) * 1024 + d0) = w;
            }
        }
        float lg[U][16];
#pragma unroll
        for (int e = 0; e < 16; ++e) {
#pragma unroll
            for (int u = 0; u < U; ++u) lg[u][e] = 0.f;
#pragma unroll
            for (int j = 0; j < 4; ++j) { const float4 w4 = *(const float4*)(wrL + e * 1024 + 256 * j + 4 * lane);
#pragma unroll
                for (int u = 0; u < U; ++u) lg[u][e] += y[u][j].x * w4.x + y[u][j].y * w4.y + y[u][j].z * w4.z + y[u][j].w * w4.w; }
        }
        float myl = 0.f;
#pragma unroll
        for (int u = 0; u < U; ++u) {
            float w8[8], z4[4];
#pragma unroll
            for (int e = 0; e < 8; ++e) { const u32x2 r = __builtin_amdgcn_permlane32_swap(__float_as_uint(lg[u][e]), __float_as_uint(lg[u][e + 8]), false, false); w8[e] = __uint_as_float(r.x) + __uint_as_float(r.y); }
#pragma unroll
            for (int e = 0; e < 4; ++e) { const u32x2 r = __builtin_amdgcn_permlane16_swap(__float_as_uint(w8[e]), __float_as_uint(w8[e + 4]), false, false); z4[e] = __uint_as_float(r.x) + __uint_as_float(r.y); }
            const bool h8 = (lane & 8) != 0, h4 = (lane & 4) != 0;
            const float k0 = h8 ? z4[2] : z4[0], s0 = h8 ? z4[0] : z4[2], k1 = h8 ? z4[3] : z4[1], s1 = h8 ? z4[1] : z4[3];
            const float y0 = k0 + __int_as_float(__builtin_amdgcn_mov_dpp(__float_as_int(s0), 0x128, 0xF, 0xF, true));
            const float y1 = k1 + __int_as_float(__builtin_amdgcn_mov_dpp(__float_as_int(s1), 0x128, 0xF, 0xF, true));
            const float k2 = h4 ? y1 : y0, s2 = h4 ? y0 : y1;
            float x = k2 + __int_as_float(__builtin_amdgcn_mov_dpp(__float_as_int(s2), 0x141, 0xF, 0xF, true));
            x += __int_as_float(__builtin_amdgcn_mov_dpp(__float_as_int(x), 0xB1, 0xF, 0xF, true));
            x += __int_as_float(__builtin_amdgcn_mov_dpp(__float_as_int(x), 0x4E, 0xF, 0xF, true));
            if ((lane & 3) == u) myl = x;
        }
        static_assert(U == 4, "lane (l & 3) stores token u = l & 3");
        lgL[(half * nloc + ((t0 - wv * U) / (nwave * U)) * (4 * U) + wid * U + (lane & 3)) * 17 + (lane >> 2)] = myl;
    }
    __syncthreads();
    if (half == 0 && wid == 0)
    for (int l0 = 0; l0 < 2 * nloc; l0 += 64) {
        const int li = l0 + lane; const bool act = li < 2 * nloc;
        const int hq = li >= nloc ? 1 : 0, lh = li - hq * nloc;
        const int it = lh / (4 * U), wq = (lh / U) & 3, uq = lh % U, tok = act ? (((blockIdx.x * 2 + hq) * 4 + wq) * U + uq) + it * (nwave * U) : 0;
        float lgv[16];
#pragma unroll
        for (int e = 0; e < 16; ++e) lgv[e] = lgL[li * 17 + e];
        float mx = lgv[0];
#pragma unroll
        for (int e = 1; e < 16; ++e) mx = fmaxf(mx, lgv[e]);
        float pr[16], ps = 0.f;
#pragma unroll
        for (int e = 0; e < 16; ++e) { pr[e] = expf(lgv[e] - mx); ps += pr[e]; }
        const float ips = 1.f / ps;
        float sel[16];
#pragma unroll
        for (int e = 0; e < 16; ++e) { pr[e] *= ips; sel[e] = pr[e] + p.router_bias[e]; }
        int best = 0; float bestv = -1e30f;
#pragma unroll
        for (int gI = 0; gI < 4; ++gI) {
            float a = -1e30f, b2 = -1e30f;
#pragma unroll
            for (int k = 0; k < 4; ++k) { const float x = sel[4 * gI + k]; if (x > a) { b2 = a; a = x; } else if (x > b2) b2 = x; }
            const float gs = a + b2;
            if (gs > bestv) { bestv = gs; best = gI; }
        }
        float s4[4], p4[4];
#pragma unroll
        for (int k = 0; k < 4; ++k) { s4[k] = 0.f; p4[k] = 0.f; }
#pragma unroll
        for (int gI = 0; gI < 4; ++gI) if (gI == best) {
#pragma unroll
            for (int k = 0; k < 4; ++k) { s4[k] = sel[4 * gI + k]; p4[k] = pr[4 * gI + k]; }
        }
        int i0 = 0; float a0 = s4[0];
#pragma unroll
        for (int k = 1; k < 4; ++k) if (s4[k] > a0) { a0 = s4[k]; i0 = k; }
        int i1 = -1; float a1 = -1e30f;
#pragma unroll
        for (int k = 0; k < 4; ++k) if (k != i0 && s4[k] > a1) { a1 = s4[k]; i1 = k; }
        float w0 = 0.f, w1 = 0.f;
#pragma unroll
        for (int k = 0; k < 4; ++k) { if (k == i0) w0 = p4[k]; if (k == i1) w1 = p4[k]; }
        const float iw = 1.f / (w0 + w1);
        const int e0 = act ? best * 4 + i0 : -1, e1 = act ? best * 4 + i1 : -1;
        unsigned myc = 0, r0 = 0, r1 = 0;
#pragma unroll
        for (int e = 0; e < 16; ++e) {
            const unsigned long long m0 = __builtin_amdgcn_ballot_w64(e0 == e), m1 = __builtin_amdgcn_ballot_w64(e1 == e);
            const unsigned c0 = (unsigned)__builtin_popcountll(m0), c = c0 + (unsigned)__builtin_popcountll(m1);
            if (lane == e) myc = c;
            if (e0 == e) r0 = __builtin_amdgcn_mbcnt_hi((unsigned)(m0 >> 32), __builtin_amdgcn_mbcnt_lo((unsigned)m0, 0u));
            if (e1 == e) r1 = c0 + __builtin_amdgcn_mbcnt_hi((unsigned)(m1 >> 32), __builtin_amdgcn_mbcnt_lo((unsigned)m1, 0u));
        }
        unsigned mybase = 0;
        if (lane < 16 && myc != 0) mybase = atomicAdd(&cnt[lane * 64], myc);
        unsigned b0 = 0, b1 = 0;
#pragma unroll
        for (int e = 0; e < 16; ++e) { const unsigned be = (unsigned)__builtin_amdgcn_readlane((int)mybase, e); if (e0 == e) b0 = be; if (e1 == e) b1 = be; }
        if (act) {
            LIST[(size_t)e0 * T_ + b0 + r0] = tok * 2; LIST[(size_t)e1 * T_ + b1 + r1] = tok * 2 + 1;
            WTS[tok * 2] = w0 * iw; WTS[tok * 2 + 1] = w1 * iw;
        }
    }
}

struct MoeUnit { int e, rt, ct, cnt, off; };
struct MoeOrderBase {
    const unsigned* cntp; int t_lo, t_hi, slot, per;
    __device__ __forceinline__ void init(const unsigned* cnt) {
        cntp = cnt; int ntile = 0;
#pragma unroll
        for (int k = 0; k < NE; ++k) ntile += (__builtin_amdgcn_readfirstlane((int)cnt[k * 64]) >> 8) * 4;
        t_lo = (ntile * (int)(blockIdx.x & 7)) >> 3; t_hi = (ntile * (int)((blockIdx.x & 7) + 1)) >> 3; slot = blockIdx.x >> 3; per = gridDim.x >> 3;
    }
    __device__ __forceinline__ bool next(int i, MoeUnit& u) const {
        const int t = t_lo + slot + i * per; if (t >= t_hi) return false;
        int base = 0, off = 0; bool found = false;
#pragma unroll
        for (int k = 0; k < NE; ++k) {
            const int ck = __builtin_amdgcn_readfirstlane((int)cntp[k * 64]), nt = (ck >> 8) * 4;
            if (!found && t < base + nt) { found = true; u.e = k; u.cnt = ck; u.off = off; u.rt = (t - base) >> 2; u.ct = (t - base) & 3; }
            base += nt; off += ck;
        }
        return found;
    }
};
struct M2Order : MoeOrderBase {
    typedef MoeUnit U; static constexpr bool GATHER = true;
    const int* list;
    __device__ __forceinline__ void ptrs(const MoeUnit& u, unsigned& A, unsigned& B) const { A = (unsigned)WS_X1B; B = (unsigned)WS_WG + ((unsigned)u.e * 1024u + (unsigned)u.ct * 256u) * 2048u; }
    __device__ __forceinline__ void rows(const MoeUnit& u, int tid, unsigned (&v)[2]) const {
        v[0] = 0u; v[1] = 0u;
#pragma unroll
        for (int i = 0; i < 2; ++i) { int R, C; pg8::stage_rc((tid + vzero()) * 16 + i * 8192, R, C);
#pragma unroll
            for (int h = 0; h < 2; ++h) { int idx = u.rt * 256 + 128 * h + R; idx = idx < u.cnt ? idx : u.cnt - 1; const int a = (list + (size_t)u.e * T_)[idx]; v[h] |= (unsigned)(a >> 1) << (16 * i); } }
    }
};
struct M3Order : MoeOrderBase {
    typedef MoeUnit U; static constexpr bool GATHER = false;
    __device__ __forceinline__ void ptrs(const MoeUnit& u, unsigned& A, unsigned& B) const { A = (unsigned)WS_HB + ((unsigned)u.off + (unsigned)u.rt * 256u) * 1024u; B = (unsigned)WS_WD + ((unsigned)u.e * 1024u + (unsigned)u.ct * 256u) * 1024u; }
};
struct M2Epi {
    static constexpr int MID_T = 0;
    unsigned char* ws;
    __device__ __forceinline__ void operator()(const f32x4 (&acc)[2][2][4][2], const MoeUnit& u, int wr, int wc, int fr, int fq) const {
        bf16_t* HB = (bf16_t*)(ws + WS_HB);
#pragma unroll
        for (int ai = 0; ai < 2; ++ai)
#pragma unroll
            for (int m = 0; m < 4; ++m) {
                const int idx = u.rt * 256 + 128 * ai + 64 * wr + 16 * m + fr + vzero();
                if (idx < u.cnt) {
#pragma unroll
                    for (int bj = 0; bj < 2; ++bj) {
                        const int hcol = 4 * (32 * u.ct + 16 * bj + 4 * wc + fq);
                        const f32x4 gv = acc[ai][bj][m][0], uv = acc[ai][bj][m][1]; f32x4 hv;
#pragma unroll
                        for (int r = 0; r < 4; ++r) hv[r] = gv[r] * fsig(gv[r]) * uv[r];
                        *(u32x2*)(HB + (size_t)(u.off + idx) * 512 + hcol) = pack4(hv);
                    }
                }
            }
    }
};
struct M3Epi {
    static constexpr int MID_T = 0;
    unsigned char* ws; const int* list;
    __device__ __forceinline__ void operator()(const f32x4 (&acc)[2][2][4][2], const MoeUnit& u, int wr, int wc, int fr, int fq) const {
        bf16_t* CT = (bf16_t*)(ws + WS_CT);
#pragma unroll
        for (int ai = 0; ai < 2; ++ai)
#pragma unroll
            for (int m = 0; m < 4; ++m) {
                const int idx = u.rt * 256 + 128 * ai + 64 * wr + 16 * m + fr + vzero();
                if (idx < u.cnt) {
                    const int a = list[(size_t)u.e * T_ + idx];
#pragma unroll
                    for (int bj = 0; bj < 2; ++bj) {
                        const int n = u.ct * 256 + 128 * bj + 32 * wc + 8 * fq;
                        const f32x4 v0 = acc[ai][bj][m][0], v1 = acc[ai][bj][m][1];
                        u32x4 w; w.x = pack2(v0[0], v0[1]); w.y = pack2(v0[2], v0[3]); w.z = pack2(v1[0], v1[1]); w.w = pack2(v1[2], v1[3]);
                        *(u32x4*)(CT + (size_t)a * 1024 + n) = w;
                    }
                }
            }
    }
};
template <int MODE>
__device__ __forceinline__ void moe_rem_item(unsigned char* ws, const int* list, int e, int cnt, int off, int rh, int c64, unsigned char* lds) {
    constexpr int K = MODE == 0 ? 1024 : 512, NS = K / 64;
    const int tid = (ltid() & 255), lane = tid & 63, wid = tid >> 6, wr = wid >> 1, wc = wid & 1, fr = lane & 15, fq = lane >> 4;
    const int idx0 = (cnt & ~255) + 128 * rh;
    const int ldc = ((lane & 7) ^ (lane >> 3)) * 8;
    const bf16_t* ap[4];
#pragma unroll
    for (int i = 0; i < 4; ++i) {
        int idx = idx0 + 32 * i + 8 * wid + (lane >> 3); idx = idx < cnt ? idx : cnt - 1;
        if (MODE == 0) { const int a = list[(size_t)e * T_ + idx]; ap[i] = (const bf16_t*)(ws + WS_X1B) + (size_t)(a >> 1) * 1024 + ldc; }
        else ap[i] = (const bf16_t*)(ws + WS_HB) + (size_t)(off + idx) * 512 + ldc;
    }
    const bf16_t* bp[2];
#pragma unroll
    for (int i = 0; i < 2; ++i) {
        const int rho = 8 * (wid + 4 * i) + (lane >> 3), src = (rho & ~31) + pg8::perm32(rho & 31);
        bp[i] = (const bf16_t*)(ws + (MODE == 0 ? WS_WG : WS_WD)) + ((size_t)e * 1024 + 64 * c64 + src) * K + ldc;
    }
    f32x4 acc[4][2];
#pragma unroll
    for (int i = 0; i < 4; ++i)
#pragma unroll
        for (int j = 0; j < 2; ++j) acc[i][j] = (f32x4){0.f, 0.f, 0.f, 0.f};
    __syncthreads();
#define RSTAGE(buf, l) do { unsigned char* st_ = lds + (buf) * 24576; \
        _Pragma("unroll") for (int i = 0; i < 4; ++i) glds16(ap[i] + (l) * 64, st_ + (4 * i + wid) * 1024); \
        _Pragma("unroll") for (int i = 0; i < 2; ++i) glds16(bp[i] + (l) * 64, st_ + 16384 + (wid + 4 * i) * 1024); } while (0)
    RSTAGE(0, 0); RSTAGE(1, 1);
    for (int l = 0; l < NS; ++l) {
        const unsigned char* st = lds + (l % 3) * 24576;
        if (l + 1 < NS) WAIT_V(6); else WAIT_V(0);
        RAW_BARRIER();
        if (l + 2 < NS) RSTAGE((l + 2) % 3, l + 2);
#pragma unroll
        for (int ks = 0; ks < 2; ++ks) {
            bf16x8 a[4], bb[2];
#pragma unroll
            for (int i = 0; i < 4; ++i) a[i] = lds_frag128(st, 64 * wr + 16 * i + fr, 4 * ks + fq);
#pragma unroll
            for (int j = 0; j < 2; ++j) bb[j] = lds_frag128(st + 16384, 32 * wc + 16 * j + fr, 4 * ks + fq);
#pragma unroll
            for (int i = 0; i < 4; ++i)
#pragma unroll
                for (int j = 0; j < 2; ++j) acc[i][j] = mfma16(bb[j], a[i], acc[i][j]);
        }
    }
#undef RSTAGE
#pragma unroll
    for (int i = 0; i < 4; ++i) {
        const int idx = idx0 + 64 * wr + 16 * i + fr + vzero();
        if (idx < cnt) {
            if (MODE == 0) {
                f32x4 hv;
#pragma unroll
                for (int r = 0; r < 4; ++r) hv[r] = acc[i][0][r] * fsig(acc[i][0][r]) * acc[i][1][r];
                *(u32x2*)((bf16_t*)(ws + WS_HB) + (size_t)(off + idx) * 512 + 32 * c64 + 16 * wc + 4 * fq) = pack4(hv);
            } else {
                const int a = list[(size_t)e * T_ + idx];
                const f32x4 v0 = acc[i][0], v1 = acc[i][1];
                u32x4 w; w.x = pack2(v0[0], v0[1]); w.y = pack2(v0[2], v0[3]); w.z = pack2(v1[0], v1[1]); w.w = pack2(v1[2], v1[3]);
                *(u32x4*)((bf16_t*)(ws + WS_CT) + (size_t)a * 1024 + 64 * c64 + 32 * wc + 8 * fq) = w;
            }
        }
    }
    __syncthreads();
}
template <int MODE>
__device__ __forceinline__ void moe_rem(const unsigned* cntp, unsigned char* ws, const int* list, unsigned char* ldsh, int half) {
    for (int t = blockIdx.x * 2 + half; ; t += gridDim.x * 2) {
        int base = 0, off = 0, e = -1, cnt = 0, eoff = 0, loc = 0;
#pragma unroll
        for (int k = 0; k < NE; ++k) {
            const int ck = __builtin_amdgcn_readfirstlane((int)cntp[k * 64]), ni = (((ck & 255) + 127) >> 7) * 16;
            if (e < 0 && t < base + ni) { e = k; cnt = ck; eoff = off; loc = t - base; }
            base += ni; off += ck;
        }
        if (e < 0) break;
        moe_rem_item<MODE>(ws, list, e, cnt, eoff, loc >> 4, loc & 15, ldsh);
    }
}
__device__ __forceinline__ void phase_m2(const Params& p, int layer, unsigned char* lds, unsigned char* ldsh, int half) {
    unsigned char* ws = launder(p.ws);
    M2Order S; S.init((const unsigned*)(ws + WS_CTL) + CW_CNT + layer * 1024 + vzero());
    S.list = (const int*)(ws + WS_LIST);
    M2Epi E; E.ws = ws;
    pg8::gemm_phase<M2Epi, M2Order>(lds, 1024, S, E, ltid(), ws);
    moe_rem<0>(S.cntp, ws, S.list, ldsh, half);
}
__device__ __forceinline__ void phase_m3(const Params& p, int layer, unsigned char* lds, unsigned char* ldsh, int half) {
    unsigned char* ws = launder(p.ws);
    M3Order S; S.init((const unsigned*)(ws + WS_CTL) + CW_CNT + layer * 1024 + vzero());
    M3Epi E; E.ws = ws; E.list = (const int*)(ws + WS_LIST);
    pg8::gemm_phase<M3Epi, M3Order>(lds, 512, S, E, ltid(), ws);
    moe_rem<1>(S.cntp, ws, E.list, ldsh, half);
}

__device__ __forceinline__ void phase_ln2(const Params& p, int layer, int half) {
    unsigned char* ws = launder(p.ws);
    const int tid = (ltid() & 255), lane = tid & 63, wid = tid >> 6;
    const bf16_t* X1 = (const bf16_t*)(ws + WS_X1B); const bf16_t* CT = (const bf16_t*)(ws + WS_CT); const float* WTS = (const float*)(ws + WS_WTS);
    float* XO = p.out; bf16_t* XB = (bf16_t*)(ws + WS_XB); const bool fin = layer == NLAYER - 1;
    const float* gam = p.ln2_g + layer * 1024; const float* bet = p.ln2_b + layer * 1024;
    constexpr int U = 4;
    const int nwave = (gridDim.x * 2) * 4, wv = (blockIdx.x * 2 + half) * 4 + wid;
    for (int t0 = wv * U; t0 < T_; t0 += nwave * U) {
        float4 v[U][4]; float s[U], q[U];
#pragma unroll
        for (int u = 0; u < U; ++u) {
            const int tok = t0 + u;
            const float w0 = WTS[tok * 2 + vzero()], w1 = WTS[tok * 2 + 1 + vzero()];
            s[u] = 0.f; q[u] = 0.f;
#pragma unroll
            for (int j = 0; j < 4; ++j) {
                const int d0 = 256 * j + 4 * lane;
                const f32x4 xt = unpack4(*(const u32x2*)(X1 + (size_t)tok * 1024 + d0)); float4 xv; xv.x = xt[0]; xv.y = xt[1]; xv.z = xt[2]; xv.w = xt[3];
                const f32x4 c0 = unpack4(*(const u32x2*)(CT + (size_t)(tok * 2) * 1024 + d0)), c1 = unpack4(*(const u32x2*)(CT + (size_t)(tok * 2 + 1) * 1024 + d0));
                v[u][j].x = xv.x * DN_ALPHA + w0 * c0[0] + w1 * c1[0]; v[u][j].y = xv.y * DN_ALPHA + w0 * c0[1] + w1 * c1[1];
                v[u][j].z = xv.z * DN_ALPHA + w0 * c0[2] + w1 * c1[2]; v[u][j].w = xv.w * DN_ALPHA + w0 * c0[3] + w1 * c1[3];
                s[u] += v[u][j].x + v[u][j].y + v[u][j].z + v[u][j].w;
                q[u] += v[u][j].x * v[u][j].x + v[u][j].y * v[u][j].y + v[u][j].z * v[u][j].z + v[u][j].w * v[u][j].w;
            }
        }
#pragma unroll
        for (int u = 0; u < U; ++u) { s[u] = wave_sum(s[u]); q[u] = wave_sum(q[u]); }
#pragma unroll
        for (int j = 0; j < 4; ++j) {
            const int d0 = 256 * j + 4 * lane;
            const float4 gg = *(const float4*)(gam + d0), bb = *(const float4*)(bet + d0);
#pragma unroll
            for (int u = 0; u < U; ++u) {
                const int tok = t0 + u;
                const float mu = s[u] * (1.f / 1024.f), var = fmaxf(q[u] * (1.f / 1024.f) - mu * mu, 0.f), rstd = rsqrtf(var + 1e-5f);
                float4 y; y.x = (v[u][j].x - mu) * rstd * gg.x + bb.x; y.y = (v[u][j].y - mu) * rstd * gg.y + bb.y; y.z = (v[u][j].z - mu) * rstd * gg.z + bb.z; y.w = (v[u][j].w - mu) * rstd * gg.w + bb.w;
                if (fin) *(float4*)(XO + (size_t)tok * 1024 + d0) = y;
                else { u32x2 w; w.x = pack2(y.x, y.y); w.y = pack2(y.z, y.w); *(u32x2*)(XB + (size_t)tok * 1024 + d0) = w; }
            }
        }
    }
}

#define XB_TMO      128
#define XB_XCNT(j)  (256  + 64 * (j))
#define XB_XSUB(j)  (1280 + 64 * (j))
#define XB_XGEN(j)  (2304 + 64 * (j))
#define XB_TOP      3328
#define XB_TOPGEN   3392
#define XCD_BAR_WORDS 3456
#define XB_SPIN_CAP (1u << 22)
#define LAS __attribute__((address_space(3)))
__device__ __forceinline__ unsigned xb_ld(unsigned* p)              { return __hip_atomic_load(p, __ATOMIC_RELAXED, __HIP_MEMORY_SCOPE_AGENT); }
__device__ __forceinline__ unsigned xb_add(unsigned* p, unsigned v) { return __hip_atomic_fetch_add(p, v, __ATOMIC_RELAXED, __HIP_MEMORY_SCOPE_AGENT); }
__device__ __forceinline__ unsigned xb_xcc_id() { return (unsigned)__builtin_amdgcn_s_getreg((3 << 11) | 20) & 0xFu; }
#define XB_SPIN(cond, bar) do { unsigned _sp = 0; while (cond) { __builtin_amdgcn_s_sleep(1); \
    if ((++_sp & 255u) == 0u) { if (xb_ld(&(bar)[XB_TMO])) break; if (_sp > XB_SPIN_CAP) { atomicAdd(&(bar)[XB_TMO], 1u); break; } } } } while (0)
struct XcdBarrier { unsigned* bar; unsigned x; volatile LAS unsigned* st; };
__device__ __forceinline__ XcdBarrier xcd_barrier_post(unsigned* bar, volatile LAS unsigned* st) {
    XcdBarrier b; b.bar = bar; b.x = xb_xcc_id(); b.st = st;
    if (threadIdx.x == 0) (void)xb_add(&bar[XB_XCNT(b.x)], 1u);
    return b;
}
__device__ __forceinline__ void xcd_barrier_complete(unsigned* bar, unsigned x, unsigned& nloc, unsigned& nx) {
    const unsigned G = gridDim.x * gridDim.y * gridDim.z;
    unsigned sum, cnt, mine, sp = 0u;
    for (;;) {
        sum = 0u; cnt = 0u; mine = 0u;
#pragma unroll
        for (unsigned j = 0; j < 16; ++j) { const unsigned c = xb_ld(&bar[XB_XCNT(j)]); sum += c; cnt += (c > 0u) ? 1u : 0u; mine = (j == x) ? c : mine; }
        if (sum == G) break;
        __builtin_amdgcn_s_sleep(1);
        if ((++sp & 255u) == 0u) { if (xb_ld(&bar[XB_TMO])) break; if (sp > XB_SPIN_CAP) { atomicAdd(&bar[XB_TMO], 1u); break; } }
    }
    nloc = mine > 0u ? mine : 1u; nx = cnt > 0u ? cnt : 1u;
}
__device__ __forceinline__ void xcd_barrier(const XcdBarrier& b) {
    asm volatile("s_waitcnt vmcnt(0)" ::: "memory");
    __syncthreads();
    if (threadIdx.x == 0) {
        unsigned* bar = b.bar;
        __builtin_amdgcn_s_waitcnt(0);
        unsigned nloc = b.st[0], nx = b.st[1];
        if (nloc == 0u) { xcd_barrier_complete(bar, b.x, nloc, nx); b.st[0] = nloc; b.st[1] = nx; }
        const unsigned old = xb_add(&bar[XB_XSUB(b.x)], 1u);
        const unsigned gen = old / nloc;
        if (old + 1u == (gen + 1u) * nloc) {
            __builtin_amdgcn_fence(__ATOMIC_RELEASE, "agent");
            asm volatile("s_waitcnt vmcnt(0)" ::: "memory");
            const unsigned og = xb_add(&bar[XB_TOP], 1u);
            const unsigned tg = og / nx;
            if (og + 1u == (tg + 1u) * nx) xb_add(&bar[XB_TOPGEN], 1u);
            else XB_SPIN(xb_ld(&bar[XB_TOPGEN]) == tg, bar);
            __builtin_amdgcn_fence(__ATOMIC_ACQUIRE, "agent");
            xb_add(&bar[XB_XGEN(b.x)], 1u);
            asm volatile("s_waitcnt vmcnt(0)" ::: "memory");
        } else {
            XB_SPIN(xb_ld(&bar[XB_XGEN(b.x)]) == gen, bar);
            __builtin_amdgcn_fence(__ATOMIC_ACQUIRE, "agent");
            asm volatile("s_waitcnt vmcnt(0)" ::: "memory");
        }
    }
    __syncthreads();
}

constexpr int PH_PER_LAYER = 11, N_PHASES = PH_PER_LAYER * NLAYER;
__global__ void __launch_bounds__(NTHREADS, 2) mega(Params p) {
    extern __shared__ __attribute__((aligned(16))) unsigned char lds[];
#if SINGLE_LAUNCH
    volatile LAS unsigned* xbw = (volatile LAS unsigned*)(lds + LDS_BYTES - 16);
    if (threadIdx.x < 4) xbw[threadIdx.x] = 0u;
    __syncthreads();
    XcdBarrier xbar = xcd_barrier_post((unsigned*)(p.ws + WS_CTL) + CW_BAR, xbw);
#endif
    const int half = __builtin_amdgcn_readfirstlane((int)(threadIdx.x >> 8));
    unsigned char* ldsh = lds + half * HALF_LDS;
    bool second = false;
    for (int ph = p.ph_lo; ph < p.ph_hi; ++ph) {
        const int layer = ph / PH_PER_LAYER, k = ph % PH_PER_LAYER;
        if (k == 0 && layer > 0) continue;
#ifdef ONLY_PHASE
        if (k != ONLY_PHASE) continue;
#endif
        switch (k) {
            case 0: phase_pw(p, layer, ldsh, 1 | 16 | 8, half); break;
            case 1: phase_g1(p, layer, lds); break;
            case 2: phase_p2(p, layer, ldsh, half); if (!second && layer + 1 < NLAYER) { __syncthreads(); phase_pw(p, layer + 1, ldsh, 1, half, 64); } break;
            case 3: phase_p3(p, ldsh, half, second ? ((p.rep_mask >> 16) & 7) : 7); if (!second && layer + 1 < NLAYER) { __syncthreads(); phase_pw(p, layer + 1, ldsh, 16, half); }
                    if (!second && layer == 0) { __syncthreads(); phase_pw(p, 0, ldsh, 2, half); } break;
            case 4: { const int sub = second ? ((p.rep_mask >> 12) & 7) : 7;
                    if (sub & 1) phase_p4_sel(p, lds);
                    if ((sub & 4) && half == 0) { phase_pw(p, layer, ldsh, 4, half); __syncthreads(); }
                    if (sub & 2) phase_p4(p, ldsh, half);
                    if ((sub & 4) && half == 1) { __syncthreads(); phase_pw(p, layer, ldsh, 4, half); } } break;
            case 5: phase_g2(p, lds); break;
            case 6: phase_g3(p, layer, lds); break;
            case 7: phase_ln1(p, layer, ldsh, ((p.rep_mask >> 7) & 1) && !second, half); if (!second && layer + 1 < NLAYER) { __syncthreads(); phase_pw(p, layer + 1, ldsh, 2, half); } break;
            case 8: phase_m2(p, layer, lds, ldsh, half); break;
            case 9: phase_m3(p, layer, lds, ldsh, half); break;
            case 10: phase_ln2(p, layer, half); break;
        }

        if (ph + 1 < p.ph_hi) { if (ph == p.ph_lo && !second) cg::this_grid().sync(); else xcd_barrier(xbar); }
        if (((p.rep_mask >> k) & 1) && !second) { second = true; --ph; } else second = false;
    }
}

extern "C" void kernel_launch(void* const* d_in, const int* in_sizes, int n_in, void* d_out, int out_size, void* d_ws, size_t ws_size, hipStream_t stream) {
    static int grid = 0;
    if (grid == 0) {
        if (n_in != 18 || ws_size < WS_END) { fprintf(stderr, "kernel_launch: unexpected n_in %d or ws_size %zu < %zu\n", n_in, ws_size, (size_t)WS_END); grid = -1; return; }
        int dev = 0, cus = 0, per_cu = 0;
        hipGetDevice(&dev); hipDeviceGetAttribute(&cus, hipDeviceAttributeMultiprocessorCount, dev);
        hipFuncSetAttribute((const void*)mega, hipFuncAttributeMaxDynamicSharedMemorySize, LDS_BYTES);
        hipOccupancyMaxActiveBlocksPerMultiprocessor(&per_cu, (const void*)mega, NTHREADS, LDS_BYTES);
        if (per_cu < 1) per_cu = 1;
        if (per_cu > 1) per_cu = 1;
        grid = cus * per_cu;
        (void)hipGetLastError();
    }
    if (grid < 0) return;
    Params p{};
    p.x = (const float*)d_in[0]; p.w_in = (const float*)d_in[1]; p.cmp_pos = (const float*)d_in[2]; p.cmp_w1 = (const float*)d_in[3]; p.cmp_w2 = (const float*)d_in[4];
    p.w_br_a = (const float*)d_in[5]; p.w_br_b = (const float*)d_in[6]; p.w_o = (const float*)d_in[7]; p.ln1_g = (const float*)d_in[8]; p.ln1_b = (const float*)d_in[9];
    p.w_router = (const float*)d_in[10]; p.router_bias = (const float*)d_in[11]; p.w_gate = (const float*)d_in[12]; p.w_up = (const float*)d_in[13]; p.w_down = (const float*)d_in[14];
    p.ln2_g = (const float*)d_in[15]; p.ln2_b = (const float*)d_in[16]; p.rel_bias = (const float*)d_in[17];
    p.out = (float*)d_out; p.ws = (unsigned char*)d_ws; p.rep_mask = REPEAT_MASK;
#if SINGLE_LAUNCH
    hipMemsetAsync((unsigned char*)d_ws + WS_CTL + (size_t)CW_BAR * 4, 0, XCD_BAR_WORDS * 4, stream);
    p.ph_lo = 0; p.ph_hi = N_PHASES;
    void* args[] = {&p};
    hipError_t e = hipLaunchCooperativeKernel((const void*)mega, dim3(grid), dim3(NTHREADS), args, LDS_BYTES, stream);
    if (e != hipSuccess) fprintf(stderr, "cooperative launch failed: %s (grid %d)\n", hipGetErrorString(e), grid);
#else
    for (int ph = 0; ph < N_PHASES; ++ph) {
        p.ph_lo = ph; p.ph_hi = ph + 1;
        hipLaunchKernelGGL(mega, dim3(grid), dim3(NTHREADS), LDS_BYTES, stream, p);
    }
#endif
}
```

```cpp
#include <hip/hip_runtime.h>
#include <hip/hip_cooperative_groups.h>
#include <cstdio>
#include <cstdint>
namespace cg = cooperative_groups;

#ifndef REPEAT_MASK
#define REPEAT_MASK 0
#endif
#ifndef SINGLE_LAUNCH
#define SINGLE_LAUNCH 1
#endif

typedef unsigned short bf16_t;
typedef short bf16x8 __attribute__((ext_vector_type(8)));
typedef float f32x4 __attribute__((ext_vector_type(4)));
typedef unsigned u32x2 __attribute__((ext_vector_type(2)));
typedef unsigned u32x4 __attribute__((ext_vector_type(4)));

constexpr int B_ = 2, S_ = 8192, D_ = 1024, T_ = B_ * S_, NLAYER = 4;
constexpr int DIN = 6424;
constexpr int LD = 5376;
constexpr int NW = 6656;
constexpr int C_QA = 0, C_KC = 512, C_VC = 640, C_KS = 768, C_KW = 896, C_QR = 1024, C_KR = 1536, C_GR = 2048, C_MA = 3072, C_MB = 4096, C_GA = 5120,
              C_VS = 5376, C_VW = 5504, C_VR = 5632;
constexpr float DN_ALPHA = 1.681792830507429f;
constexpr int NE = 16;

constexpr size_t al256(size_t x) { return (x + 255) & ~(size_t)255; }
constexpr size_t WS_CTL = 0;
constexpr size_t WS_BUCKET = 65536;
constexpr size_t WS_ROPE = WS_BUCKET + 8192;
constexpr size_t WS_WIN = WS_ROPE + (size_t)8192 * 32 * 8;
constexpr size_t WS_WA = WS_WIN + (size_t)NW * 1024 * 2;
constexpr size_t WS_WB = WS_WA + (size_t)1024 * 512 * 2;
constexpr size_t WS_WO = WS_WB + (size_t)1024 * 1024 * 2;
constexpr size_t WS_WG = WS_WO + (size_t)1024 * 1024 * 2;
constexpr size_t WS_WU = WS_WG + (size_t)16 * 512 * 1024 * 2;
constexpr size_t WS_WD = WS_WU + (size_t)16 * 512 * 1024 * 2;
constexpr size_t WS_XB = WS_WD + (size_t)16 * 512 * 1024 * 2;
constexpr size_t WS_X = WS_XB + (size_t)T_ * 1024 * 2;
constexpr size_t WS_MG = WS_X + (size_t)T_ * 1024 * 4;
constexpr size_t WS_KCC = WS_MG + (size_t)T_ * 1024 * 2;
constexpr size_t WS_VCCT = WS_KCC + (size_t)4 * 512 * 64 * 2;
constexpr size_t WS_W1T = WS_VCCT + (size_t)4 * 512 * 64 * 2;
constexpr size_t WS_B1 = WS_W1T + (size_t)2 * 64 * 2048 * 2;
constexpr size_t WS_R = WS_B1 + 1024;
constexpr size_t WS_P = WS_R;
constexpr size_t WS_VST = WS_P + (size_t)T_ * LD * 2;
constexpr size_t WS_VWT = WS_VST + (size_t)4 * 64 * S_ * 2;
constexpr size_t WS_VRT = WS_VWT + (size_t)4 * 64 * S_ * 2;
constexpr size_t WS_KVT = WS_VRT + (size_t)16 * 128 * S_ * 2;
constexpr size_t WS_SPT = WS_KVT + (size_t)16 * 64 * 8192 * 4;
constexpr size_t WS_YC = WS_SPT + (size_t)16 * 64 * 8192 * 2;
constexpr size_t WS_YW = WS_YC + (size_t)T_ * 512 * 2;
constexpr size_t WS_YA = WS_YW + (size_t)T_ * 512 * 2;
constexpr size_t WS_YB = WS_YA + (size_t)T_ * 512 * 2;
constexpr size_t WS_SELW = WS_YB + (size_t)T_ * 1024 * 2;
constexpr size_t WS_ENDA = WS_SELW + (size_t)T_ * 2 * 4 * 4;
constexpr size_t WS_H1 = WS_R;
constexpr size_t WS_X1 = WS_H1 + (size_t)T_ * 1024 * 4;
constexpr size_t WS_X1B = WS_X1 + (size_t)T_ * 1024 * 4;
constexpr size_t WS_HB = WS_X1B + (size_t)T_ * 1024 * 2;
constexpr size_t WS_CT = WS_HB + (size_t)2 * T_ * 512 * 2;
constexpr size_t WS_LIST = WS_CT + (size_t)2 * T_ * 1024 * 2;
constexpr size_t WS_WTS = WS_LIST + (size_t)16 * T_ * 4;
constexpr size_t WS_ENDB = WS_WTS + (size_t)2 * T_ * 4;
static_assert(WS_HB + (size_t)2 * T_ * 512 * 2 <= WS_CT, "view B overlap");
constexpr size_t WS_END = WS_ENDA > WS_ENDB ? WS_ENDA : WS_ENDB;

constexpr int CW_CNT = 4096;
constexpr int CW_BAR = 8192;
constexpr int CW_B1P = 12288;

constexpr int HALF_LDS = 75776, LDS_BYTES = 2 * HALF_LDS + 16;
constexpr int NTHREADS = 512, HT = 256;

struct Params {
    const float* x; const float* w_in; const float* cmp_pos; const float* cmp_w1; const float* cmp_w2;
    const float* w_br_a; const float* w_br_b; const float* w_o; const float* ln1_g; const float* ln1_b;
    const float* w_router; const float* router_bias; const float* w_gate; const float* w_up; const float* w_down;
    const float* ln2_g; const float* ln2_b; const float* rel_bias;
    float* out; unsigned char* ws;
    int ph_lo, ph_hi, rep_mask, pad_;
};

__device__ __forceinline__ bf16_t f2bf(float f) { unsigned u = __float_as_uint(f); u += 0x7fffu + ((u >> 16) & 1u); return (bf16_t)(u >> 16); }
__device__ __forceinline__ float bf2f(unsigned h) { return __uint_as_float(h << 16); }
typedef __bf16 bf16x2_t __attribute__((ext_vector_type(2)));
typedef float f32x2_t __attribute__((ext_vector_type(2)));
__device__ __forceinline__ unsigned pack2(float lo, float hi) { const f32x2_t f = {lo, hi}; return __builtin_bit_cast(unsigned, __builtin_convertvector(f, bf16x2_t)); }
__device__ __forceinline__ u32x2 pack4(f32x4 v) { u32x2 r; r.x = pack2(v[0], v[1]); r.y = pack2(v[2], v[3]); return r; }
__device__ __forceinline__ f32x4 unpack4(u32x2 u) { f32x4 r; r[0] = bf2f(u.x & 0xffffu); r[1] = bf2f(u.x >> 16); r[2] = bf2f(u.y & 0xffffu); r[3] = bf2f(u.y >> 16); return r; }
__device__ __forceinline__ float rows_max(float v) {
    u32x2 r = __builtin_amdgcn_permlane16_swap(__float_as_uint(v), __float_as_uint(v), false, false);
    v = fmaxf(__uint_as_float(r.x), __uint_as_float(r.y));
    r = __builtin_amdgcn_permlane32_swap(__float_as_uint(v), __float_as_uint(v), false, false);
    return fmaxf(__uint_as_float(r.x), __uint_as_float(r.y));
}
__device__ __forceinline__ float rows_sum(float v) {
    u32x2 r = __builtin_amdgcn_permlane16_swap(__float_as_uint(v), __float_as_uint(v), false, false);
    v = __uint_as_float(r.x) + __uint_as_float(r.y);
    r = __builtin_amdgcn_permlane32_swap(__float_as_uint(v), __float_as_uint(v), false, false);
    return __uint_as_float(r.x) + __uint_as_float(r.y);
}
__device__ __forceinline__ float wave_sum(float v) {
    v += __int_as_float(__builtin_amdgcn_mov_dpp(__float_as_int(v), 0xB1, 0xF, 0xF, true));
    v += __int_as_float(__builtin_amdgcn_mov_dpp(__float_as_int(v), 0x4E, 0xF, 0xF, true));
    v += __int_as_float(__builtin_amdgcn_mov_dpp(__float_as_int(v), 0x141, 0xF, 0xF, true));
    v += __int_as_float(__builtin_amdgcn_mov_dpp(__float_as_int(v), 0x140, 0xF, 0xF, true));
    return rows_sum(v);
}
__device__ __forceinline__ float sigmoidf_(float x) { return 1.f / (1.f + __expf(-x)); }
__device__ __forceinline__ int ltid() { int t = threadIdx.x; asm volatile("" : "+v"(t)); return t; }
__device__ __forceinline__ int vzero() { int z; asm volatile("v_mov_b32 %0, 0" : "=v"(z)); return z; }
__device__ __forceinline__ unsigned char* launder(unsigned char* q) { asm volatile("" : "+s"(q)); return q; }
__device__ __forceinline__ void wait_vm0() { asm volatile("s_waitcnt vmcnt(0)" ::: "memory"); }

__device__ __forceinline__ void glds16(const void* g, void* l) {
    __builtin_amdgcn_global_load_lds((const __attribute__((address_space(1))) unsigned*)g,
                                     (__attribute__((address_space(3))) unsigned*)l, 16, 0, 0);
}
__device__ __forceinline__ f32x4 mfma16(bf16x8 a, bf16x8 b, f32x4 c) { return __builtin_amdgcn_mfma_f32_16x16x32_bf16(a, b, c, 0, 0, 0); }

#define WAIT_V(n) asm volatile("s_waitcnt vmcnt(%0)" ::"n"(n) : "memory")
#define RAW_BARRIER() do { asm volatile("s_waitcnt lgkmcnt(0)" ::: "memory"); __builtin_amdgcn_s_barrier(); } while (0)
__device__ __forceinline__ void bglds16(__amdgpu_buffer_rsrc_t r, unsigned voff, int soff, void* l) {
    __builtin_amdgcn_raw_ptr_buffer_load_lds(r, (__attribute__((address_space(3))) void*)l, 16, (int)voff, soff, 0, 0);
}
template <int NJ, bool GN>
__device__ __forceinline__ void gemm8_stage(__amdgpu_buffer_rsrc_t mr, int mld, unsigned mvo, __amdgpu_buffer_rsrc_t nr, int nld, const unsigned (&nvo)[NJ], int kt, unsigned char* st, int wid) {
#pragma unroll
    for (int i = 0; i < 4; ++i) bglds16(mr, mvo, (64 * i * mld + kt * 64) * 2, st + (8 * i + wid) * 1024);
#pragma unroll
    for (int i = 0; i < NJ; ++i) bglds16(nr, nvo[i], ((GN ? 0 : 64 * i * nld) + kt * 64) * 2, st + 32768 + (8 * i + wid) * 1024);
}
template <int NJ, bool GN>
__device__ __forceinline__ void gemm8_kloop(const bf16_t* mb, int mld, unsigned mvo, const bf16_t* nb, int nld, const unsigned (&nvo)[NJ], int nk, unsigned char* lds, f32x4 (&acc)[8][NJ], int tid) {
    const int lane = tid & 63, wid = tid >> 6, wr = wid >> 2, wc = wid & 3, fr = lane & 15, fq = lane >> 4;
    const __amdgpu_buffer_rsrc_t mr = __builtin_amdgcn_make_buffer_rsrc((void*)mb, 0, 0x7fffffff, 0x00020000);
    const __amdgpu_buffer_rsrc_t nr = __builtin_amdgcn_make_buffer_rsrc((void*)nb, 0, 0x7fffffff, 0x00020000);
    gemm8_stage<NJ, GN>(mr, mld, mvo, nr, nld, nvo, 0, lds, wid);
    gemm8_stage<NJ, GN>(mr, mld, mvo, nr, nld, nvo, 1, lds + 65536, wid);
    for (int kt = 0; kt < nk; ++kt) {
        unsigned char* cur = lds + (kt & 1) * 65536;
        if (kt + 1 < nk) WAIT_V(4 + NJ); else WAIT_V(0);
        RAW_BARRIER();
        bf16x8 a[4], b[NJ];
        const unsigned char* ab = cur + (128 * wr + fr) * 128;
        const unsigned char* bb = cur + 32768 + (16 * NJ * wc + fr) * 128;
        const int sw0 = ((fq) ^ (fr & 7)) << 4, sw1 = ((4 + fq) ^ (fr & 7)) << 4;
#pragma unroll
        for (int j = 0; j < NJ; ++j) b[j] = *(const bf16x8*)(bb + j * 2048 + sw0);
#pragma unroll
        for (int mh = 0; mh < 2; ++mh) {
#pragma unroll
            for (int i = 0; i < 4; ++i) a[i] = *(const bf16x8*)(ab + (4 * mh + i) * 2048 + sw0);
#pragma unroll
            for (int i = 0; i < 4; ++i)
#pragma unroll
                for (int j = 0; j < NJ; ++j) acc[4 * mh + i][j] = mfma16(a[i], b[j], acc[4 * mh + i][j]);
        }
#pragma unroll
        for (int j = 0; j < NJ; ++j) b[j] = *(const bf16x8*)(bb + j * 2048 + sw1);
#pragma unroll
        for (int i = 0; i < 4; ++i) a[i] = *(const bf16x8*)(ab + i * 2048 + sw1);
#pragma unroll
        for (int i = 0; i < 4; ++i)
#pragma unroll
            for (int j = 0; j < NJ; ++j) acc[i][j] = mfma16(a[i], b[j], acc[i][j]);
#pragma unroll
        for (int i = 0; i < 4; ++i) a[i] = *(const bf16x8*)(ab + (4 + i) * 2048 + sw1);
        RAW_BARRIER();
        if (kt + 2 < nk) gemm8_stage<NJ, GN>(mr, mld, mvo, nr, nld, nvo, kt + 2, cur, wid);
#pragma unroll
        for (int i = 0; i < 4; ++i)
#pragma unroll
            for (int j = 0; j < NJ; ++j) acc[4 + i][j] = mfma16(a[i], b[j], acc[4 + i][j]);
    }
    __syncthreads();
    __builtin_amdgcn_sched_barrier(0);
}
template <int NJ>
__device__ __forceinline__ void zero_acc8(f32x4 (&acc)[8][NJ]) {
#pragma unroll
    for (int i = 0; i < 8; ++i)
#pragma unroll
        for (int j = 0; j < NJ; ++j) acc[i][j] = (f32x4){0.f, 0.f, 0.f, 0.f};
}

namespace pg8 {
#define PG8_LAS __attribute__((address_space(3)))
constexpr int BM = 256, BK = 64, HALF = 128, HTB = HALF * BK * 2, STAGE_BYTES = 8 * HTB;
__device__ __forceinline__ int lds_byte(int r, int c) { const int st = (r >> 4) * 2 + (c >> 5), rr = r & 15, cc = c & 31, ob = rr * 64 + cc * 2; return st * 1024 + (ob ^ (((ob >> 9) & 1) << 5)); }
__device__ __forceinline__ void stage_rc(int b, int& R, int& C) { const int st = b / 1024, sb = b % 1024, swz = sb ^ (((sb >> 9) & 1) << 5); R = (st >> 1) * 16 + swz / 64; C = (st & 1) * 32 + (swz % 64) / 2; }
__device__ __forceinline__ int perm32(int rho) { const int n = rho >> 4, i = rho & 15; return 8 * (i >> 2) + 4 * n + (i & 3); }
struct Unit { int pm, pn; };
template <class Epi, class Sched>
__device__ __forceinline__ void gemm_phase(unsigned char* lds_, const int K, const Sched& S, const Epi& E, const int tid, const unsigned char* wsbase) {
    PG8_LAS unsigned char* lds = (PG8_LAS unsigned char*)lds_;
    const int wid = __builtin_amdgcn_readfirstlane(tid >> 6), lane = tid & 63, wr = wid >> 2, wc = wid & 3, fr = lane & 15, fq = lane >> 4;
    const int nt = K / BK;
    unsigned voffA[2], voffB[2];
#pragma unroll
    for (int i = 0; i < 2; ++i) { int R, C; stage_rc(tid * 16 + i * 8192, R, C); const int Rb = (R & ~31) + perm32(R & 31);
        voffA[i] = (unsigned)(R * K + C) * 2u; voffB[i] = (unsigned)(Rb * K + C) * 2u; }
    const unsigned kstep = (unsigned)(BK * 2);
    const unsigned hstep = (unsigned)HALF * K * 2;
    const __amdgpu_buffer_rsrc_t rsrc = __builtin_amdgcn_make_buffer_rsrc((void*)wsbase, 0, 0x7fffffff, 0x00020000);
    const unsigned ldsw = (unsigned)wid * 1024u;
    const int aoff = lds_byte(wr * 64 + fr, fq * 8), boff = lds_byte(wc * 32 + fr, fq * 8);
#define PG8_SA(b, h) (((b) * 2 + (h)) * HTB)
#define PG8_SB(b, h) ((4 + (b) * 2 + (h)) * HTB)
#define PG8_STAGE(bufoff, gbase, voff) do { _Pragma("unroll") for (int _i = 0; _i < 2; ++_i) \
        __builtin_amdgcn_raw_ptr_buffer_load_lds(rsrc, (PG8_LAS void*)(lds + (bufoff) + ldsw + _i * 8192), 16, (int)(voff)[_i], (int)(gbase), 0, 0); } while (0)
#define PG8_LDA(dst, b, h) do { _Pragma("unroll") for (int m = 0; m < 4; ++m) _Pragma("unroll") for (int k = 0; k < 2; ++k) dst[m][k] = *(const PG8_LAS bf16x8*)(lds + PG8_SA(b, h) + aoff + m * 2048 + k * 1024); } while (0)
#define PG8_LDB(dst, b, h) do { _Pragma("unroll") for (int n = 0; n < 2; ++n) _Pragma("unroll") for (int k = 0; k < 2; ++k) dst[n][k] = *(const PG8_LAS bf16x8*)(lds + PG8_SB(b, h) + boff + n * 2048 + k * 1024); } while (0)
#define PG8_MMA(ai, bj, At, Bt) do { __builtin_amdgcn_s_setprio(1); _Pragma("unroll") for (int m = 0; m < 4; ++m) _Pragma("unroll") for (int n = 0; n < 2; ++n) _Pragma("unroll") for (int k = 0; k < 2; ++k) \
        acc[ai][bj][m][n] = __builtin_amdgcn_mfma_f32_16x16x32_bf16(Bt[n][k], At[m][k], acc[ai][bj][m][n], 0, 0, 0); __builtin_amdgcn_s_setprio(0); } while (0)
#define PG8_WAIT_V(n) asm volatile("s_waitcnt vmcnt(" #n ")" ::: "memory")
#define PG8_WAIT_L(n) asm volatile("s_waitcnt lgkmcnt(" #n ")" ::: "memory")
#define PG8_BAR __builtin_amdgcn_s_barrier()
#define PG8_SCHED __builtin_amdgcn_sched_barrier(0)
    typename Sched::U cur, nxt; int ui = 0;
    if (!S.next(0, cur)) return;
    unsigned cA, cB; S.ptrs(cur, cA, cB);
    constexpr bool GA = Sched::GATHER;
    unsigned vA[2], nvA[2];
    if constexpr (GA) { S.rows(cur, tid, vA); nvA[0] = vA[0]; nvA[1] = vA[1]; }
#define PG8_STAGE_G(bufoff, gbase, pk) do { const unsigned _cb = voffB[0] & (unsigned)(2 * K - 1); unsigned _vo[2] = {(((pk) & 0xffffu) * (unsigned)(2 * K)) + _cb, (((pk) >> 16) * (unsigned)(2 * K)) + _cb}; PG8_STAGE(bufoff, gbase, _vo); } while (0)
#define PG8_STAGE_A(bufoff, gbase, h, nextu) do { if constexpr (GA) { if (nextu) PG8_STAGE_G(bufoff, gbase, nvA[h]); else PG8_STAGE_G(bufoff, gbase, vA[h]); } \
        else PG8_STAGE(bufoff, (gbase) + (h) * hstep, voffA); } while (0)
    PG8_STAGE(PG8_SB(0, 0), cB, voffB); PG8_STAGE_A(PG8_SA(0, 0), cA, 0, false); PG8_STAGE(PG8_SB(0, 1), cB + hstep, voffB); PG8_STAGE_A(PG8_SA(0, 1), cA, 1, false);
    if (wr == 1) PG8_BAR;
    PG8_WAIT_V(4); PG8_BAR;
    PG8_STAGE(PG8_SB(1, 0), cB + kstep, voffB); PG8_STAGE_A(PG8_SA(1, 0), cA + kstep, 0, false); PG8_STAGE(PG8_SB(1, 1), cB + hstep + kstep, voffB);
    PG8_WAIT_V(6); PG8_BAR;
    PG8_SCHED;
    f32x4 acc[2][2][4][2];
#pragma unroll
    for (int a = 0; a < 2; ++a)
#pragma unroll
        for (int b = 0; b < 2; ++b)
#pragma unroll
            for (int m = 0; m < 4; ++m)
#pragma unroll
                for (int n = 0; n < 2; ++n) acc[a][b][m][n] = (f32x4){0.f, 0.f, 0.f, 0.f};
    bf16x8 At[4][2], B0[2][2], B1[2][2];
    for (;;) {
        const bool has_next = S.next(ui + 1, nxt);
        unsigned nA = cA, nB = cB; if (has_next) S.ptrs(nxt, nA, nB);
        if constexpr (GA) { if (has_next) S.rows(nxt, tid, nvA); }
        for (int t = 0; t < nt; t += 2) {
            if constexpr (Epi::MID_T > 0) { if (t == Epi::MID_T) E.mid(acc, cur, wr, wc, fr, fq); }
            const bool last = (t == nt - 2);
            const unsigned a1 = cA + (unsigned)(t + 1) * kstep;
            const unsigned a2 = last ? nA : cA + (unsigned)(t + 2) * kstep, b2 = last ? nB : cB + (unsigned)(t + 2) * kstep;
            const unsigned a3 = a2 + kstep, b3 = b2 + kstep;
            PG8_LDB(B0, 0, 0); PG8_SCHED; PG8_LDA(At, 0, 0); PG8_STAGE_A(PG8_SA(1, 1), a1, 1, false);
            PG8_WAIT_L(8); PG8_BAR; PG8_WAIT_L(0); PG8_MMA(0, 0, At, B0); PG8_BAR; PG8_SCHED;
            PG8_LDB(B1, 0, 1); PG8_STAGE(PG8_SB(0, 0), b2, voffB);
            PG8_BAR; PG8_WAIT_L(0); PG8_MMA(0, 1, At, B1); PG8_BAR;
            PG8_LDA(At, 0, 1); PG8_STAGE_A(PG8_SA(0, 0), a2, 0, last);
            PG8_BAR; PG8_WAIT_L(0); PG8_MMA(1, 0, At, B0); PG8_BAR; PG8_SCHED;
            PG8_STAGE(PG8_SB(0, 1), b2 + hstep, voffB);
            PG8_WAIT_V(6); PG8_BAR; PG8_MMA(1, 1, At, B1); PG8_BAR;
            PG8_LDB(B0, 1, 0); PG8_SCHED; PG8_LDA(At, 1, 0); PG8_STAGE_A(PG8_SA(0, 1), a2, 1, last);
            PG8_WAIT_L(8); PG8_BAR; PG8_WAIT_L(0); PG8_MMA(0, 0, At, B0); PG8_BAR; PG8_SCHED;
            PG8_LDB(B1, 1, 1); PG8_STAGE(PG8_SB(1, 0), b3, voffB);
            PG8_BAR; PG8_WAIT_L(0); PG8_MMA(0, 1, At, B1); PG8_BAR;
            PG8_LDA(At, 1, 1); PG8_STAGE_A(PG8_SA(1, 0), a3, 0, last);
            PG8_BAR; PG8_WAIT_L(0); PG8_MMA(1, 0, At, B0); PG8_BAR; PG8_SCHED;
            PG8_STAGE(PG8_SB(1, 1), b3 + hstep, voffB);
            PG8_WAIT_V(6); PG8_BAR; PG8_MMA(1, 1, At, B1); PG8_BAR;
        }
        E(acc, cur, wr, wc, fr, fq);
        if (!has_next) break;
#pragma unroll
        for (int a = 0; a < 2; ++a)
#pragma unroll
            for (int b = 0; b < 2; ++b)
#pragma unroll
                for (int m = 0; m < 4; ++m)
#pragma unroll
                    for (int n = 0; n < 2; ++n) acc[a][b][m][n] = (f32x4){0.f, 0.f, 0.f, 0.f};
        cur = nxt; cA = nA; cB = nB; ++ui;
        if constexpr (GA) { vA[0] = nvA[0]; vA[1] = nvA[1]; }
    }
    PG8_WAIT_V(0);
    if (wr == 0) PG8_BAR;
    PG8_BAR;
#undef PG8_SA
#undef PG8_SB
#undef PG8_STAGE
#undef PG8_STAGE_A
#undef PG8_STAGE_G
#undef PG8_LDA
#undef PG8_LDB
#undef PG8_MMA
#undef PG8_WAIT_V
#undef PG8_WAIT_L
#undef PG8_BAR
#undef PG8_SCHED
}
}

struct TJob { const float* src; bf16_t* dst; int ld, k0, n0, mode, kdst; };
__device__ __forceinline__ void tcvt_load(const TJob& J, float4 (&v)[4], int tid) {
#pragma unroll
    for (int i = 0; i < 4; ++i) {
        const int kk = (tid >> 4) + 16 * i, c4 = (tid & 15) * 4, cd = J.n0 + c4;
        int orig = cd; bool ok = true;
        if (J.mode == 1) {
            if (cd < 896) orig = cd;
            else if (cd < 1024) orig = cd - 896 + 1024;
            else if (cd < 2048) { const int q = cd - 1024, hd = q >> 6, pp = q & 63;
                const int d = (pp & 4) ? 32 + 4 * (pp >> 3) + (pp & 3) : 4 * (pp >> 3) + (pp & 3);
                orig = 1304 + hd * 64 + d; }
            else if (cd < 5120) orig = cd - 2048 + 3352;
            else if (cd < 5144) orig = cd - 5120 + 1280;
            else if (cd < 5376) ok = false;
            else if (cd < 5504) orig = cd - 5376 + 896;
            else if (cd < 5632) orig = cd - 5504 + 1152;
            else orig = cd - 5632 + 2328;
        }
        v[i] = make_float4(0.f, 0.f, 0.f, 0.f);
        if (ok) v[i] = *(const float4*)(J.src + (size_t)(J.k0 + kk) * J.ld + orig);
    }
}
__device__ __forceinline__ void tcvt_finish(const TJob& J, const float4 (&v)[4], unsigned char* lds, int tid) {
    float* tile = (float*)lds;
#pragma unroll
    for (int i = 0; i < 4; ++i) {
        const int kk = (tid >> 4) + 16 * i, c4 = (tid & 15) * 4;
        tile[kk * 65 + c4 + 0] = v[i].x; tile[kk * 65 + c4 + 1] = v[i].y; tile[kk * 65 + c4 + 2] = v[i].z; tile[kk * 65 + c4 + 3] = v[i].w;
    }
    __syncthreads();
#pragma unroll
    for (int i = 0; i < 2; ++i) {
        const int q = tid + 256 * i, n = q >> 3, kc = q & 7;
        float x[8];
#pragma unroll
        for (int j = 0; j < 8; ++j) x[j] = tile[(kc * 8 + j) * 65 + n];
        u32x4 w; w.x = pack2(x[0], x[1]); w.y = pack2(x[2], x[3]); w.z = pack2(x[4], x[5]); w.w = pack2(x[6], x[7]);
        int drow = J.n0 + n; if (J.mode >= 2) drow = 8 * (drow >> 2) + (drow & 3) + (J.mode == 3 ? 4 : 0);
        *(u32x4*)(J.dst + (size_t)drow * J.kdst + J.k0 + kc * 8) = w;
    }
    __syncthreads();
}
__device__ __forceinline__ void tcvt_tile(const float* src, int ld_src, int k0, int n0, int mode, bf16_t* dst, int kdst, unsigned char* lds, int half) {
    TJob J; J.src = src; J.dst = dst; J.ld = ld_src; J.k0 = k0; J.n0 = n0; J.mode = mode; J.kdst = kdst;
    const int tid = (ltid() & 255); float4 v[4];
    tcvt_load(J, v, tid); tcvt_finish(J, v, lds, tid);
}

__device__ __forceinline__ void tcvt_decode(const Params& p, unsigned char* ws, int layer, int t, TJob& J) {
    constexpr int J0 = 16 * 104, J1 = 8 * 16, J2 = 256, J3 = 256, J4 = 2048, J5 = 2048;
    int u = t;
        if (u < J0) { J.src = p.w_in + (size_t)layer * 1024 * DIN; J.ld = DIN; J.k0 = (u % 16) * 64; J.n0 = (u / 16) * 64; J.mode = 1; J.dst = (bf16_t*)(ws + WS_WIN); J.kdst = 1024; return; }
        u -= J0;
        if (u < J1) { J.src = p.w_br_a + (size_t)layer * 512 * 1024; J.ld = 1024; J.k0 = (u % 8) * 64; J.n0 = (u / 8) * 64; J.mode = 0; J.dst = (bf16_t*)(ws + WS_WA); J.kdst = 1536; return; }
        u -= J1;
        if (u < J2) { J.src = p.w_br_b + (size_t)layer * 1024 * 1024; J.ld = 1024; J.k0 = (u % 16) * 64; J.n0 = (u / 16) * 64; J.mode = 0; J.dst = (bf16_t*)(ws + WS_WA) + 512; J.kdst = 1536; return; }
        u -= J2;
        if (u < J3) { J.src = p.w_o + (size_t)layer * 1024 * 1024; J.ld = 1024; J.k0 = (u % 16) * 64; J.n0 = (u / 16) * 64; J.mode = 0; J.dst = (bf16_t*)(ws + WS_WO); J.kdst = 1024; return; }
        u -= J3;
        if (u < J4 + J5) {
            const bool up = u >= J4; if (up) u -= J4;
            const int e = u / 128, v = u % 128;
            J.src = (up ? p.w_up : p.w_gate) + ((size_t)layer * NE + e) * 1024 * 512; J.ld = 512; J.k0 = (v % 16) * 64; J.n0 = (v / 16) * 64; J.mode = up ? 3 : 2;
            J.dst = (bf16_t*)(ws + WS_WG) + (size_t)e * 1024 * 1024; J.kdst = 1024; return;
        }
        u -= J4 + J5;
        { const int e = u / 128, v = u % 128;
          J.src = p.w_down + ((size_t)layer * NE + e) * 512 * 1024; J.ld = 1024; J.k0 = (v % 8) * 64; J.n0 = (v / 8) * 64; J.mode = 0; J.dst = (bf16_t*)(ws + WS_WD) + (size_t)e * 1024 * 512; J.kdst = 512; }
}


__device__ __forceinline__ void phase_pw(const Params& p, int layer, unsigned char* lds, int parts, int half, int skip = 0) {
    const int hq = __builtin_amdgcn_readfirstlane(ltid() >> 8);
    if ((int)(blockIdx.x * 2 + hq) < skip) return;
    const int bid = (blockIdx.x * 2 + hq) - skip, nblk = (gridDim.x * 2) - skip, tid = (ltid() & 255);
    unsigned char* ws = launder(p.ws);
    constexpr int J0 = 16 * 104, J1 = 8 * 16, J2 = 256, J3 = 256, J4 = 2048, J5 = 2048, J6 = 2048, JT = J0 + J1 + J2 + J3 + J4 + J5 + J6;
    const int t_lo = (parts & 1) ? 0 : (parts & 2) ? J0 : J0 + J1 + J2 + J3;
    const int t_hi = (parts & 4) ? JT : (parts & 2) ? J0 + J1 + J2 + J3 : (parts & 1) ? J0 : 0;
    if (t_lo + bid < t_hi) {
        float4 v[4]; { TJob J; tcvt_decode(p, ws, layer, t_lo + bid, J); tcvt_load(J, v, tid); }
        for (int t = t_lo + bid; t < t_hi; t += nblk) {
            float4 vn[4];
            if (t + nblk < t_hi) { TJob J; tcvt_decode(p, ws, layer, t + nblk, J); tcvt_load(J, vn, tid); }
            { TJob J; tcvt_decode(p, ws, layer, t, J); tcvt_finish(J, v, lds, tid); }
#pragma unroll
            for (int i = 0; i < 4; ++i) v[i] = vn[i];
        }
    }
    if (parts & 16) {
    for (int t = bid; t < 64; t += nblk) {
        const int kv = t >> 5, kt = t & 31;
        const float* w1 = p.cmp_w1 + ((size_t)layer * 2 + kv) * 2048 * 64;
        tcvt_tile(w1, 64, kt * 64, 0, 0, (bf16_t*)(ws + WS_W1T) + (size_t)kv * 64 * 2048, 2048, lds, half);
        const int n = tid & 63, part = tid >> 6;
        const float* pos = p.cmp_pos + ((size_t)layer * 2 + kv) * 2048 + kt * 64 + part * 16;
        const float* wp = w1 + (size_t)(kt * 64 + part * 16) * 64 + n;
        float a = 0.f;
#pragma unroll
        for (int k = 0; k < 16; ++k) a += pos[k] * wp[(size_t)k * 64];
        float* red = (float*)lds;
        __syncthreads(); red[tid] = a; __syncthreads();
        if (tid < 64) ((float*)(ws + WS_CTL) + CW_B1P)[(kv * 32 + kt) * 64 + tid] = red[tid] + red[tid + 64] + red[tid + 128] + red[tid + 192];
        __syncthreads();
    }
    }
    if (parts & 8) {
        const float4* xs = (const float4*)p.x; u32x2* xb = (u32x2*)(ws + WS_XB);
        for (size_t i = (size_t)bid * HT + tid; i < (size_t)T_ * 1024 / 4; i += (size_t)nblk * HT) {
            float4 v = xs[i]; u32x2 w; w.x = pack2(v.x, v.y); w.y = pack2(v.z, v.w); xb[i] = w;
        }
        for (int n = bid * HT + tid; n < 8192; n += nblk * HT) {
            int bk;
            if (n < 16) bk = n;
            else { const int th[15] = {22, 30, 40, 54, 73, 99, 134, 182, 246, 332, 450, 609, 825, 1117, 1513}; bk = 16;
#pragma unroll
                for (int k = 0; k < 15; ++k) bk += (n >= th[k]) ? 1 : 0; }
            (ws + WS_BUCKET)[n] = (unsigned char)bk;
        }
        for (int i = bid * HT + tid; i < 8192 * 32; i += nblk * HT) {
            const int pos = i >> 5, d = i & 31;
            const float inv = powf(10000.f, -(float)d * 2.0f / 64.f);
            const float ang = (float)pos * inv;
            float sn, cs; sincosf(ang, &sn, &cs);
            ((float2*)(ws + WS_ROPE))[i] = make_float2(cs, sn);
        }
        if (bid == 0) for (int i = tid; i < 8192; i += HT) ((unsigned*)(ws + WS_CTL))[i] = 0u;
    }
}

__device__ __forceinline__ float fsig(float x) { return __builtin_amdgcn_rcpf(1.f + __builtin_amdgcn_exp2f(-1.4426950408889634f * x)); }
template <int KIND>
__device__ __forceinline__ void g1_epi(const f32x4 (&acc)[2][2][4][2], unsigned char* ws, int r0, int c0, int wr, int wc, int fr, int fq) {
#pragma unroll
    for (int ai = 0; ai < 2; ++ai)
#pragma unroll
        for (int m = 0; m < 4; ++m) {
            const int row = r0 + 128 * ai + 64 * wr + 16 * m + fr + vzero();
#pragma unroll
            for (int bj = 0; bj < 2; ++bj) {
                const int col = c0 + 128 * bj + 32 * wc + 8 * fq;
                f32x4 v0 = acc[ai][bj][m][0], v1 = acc[ai][bj][m][1];
                if (KIND == 5) {
                    const int b = col >> 13, sq = col & (S_ - 1);
                    bf16_t* dst;
                    if (row < C_VW) { const int c = row - C_VS; dst = (bf16_t*)(ws + WS_VST) + ((size_t)(b * 2 + (c >> 6)) * 64 + (c & 63)) * S_ + sq; }
                    else if (row < C_VR) { const int c = row - C_VW; dst = (bf16_t*)(ws + WS_VWT) + ((size_t)(b * 2 + (c >> 6)) * 64 + (c & 63)) * S_ + sq; }
                    else { const int c = row - C_VR; dst = (bf16_t*)(ws + WS_VRT) + ((size_t)(b * 8 + (c >> 7)) * 128 + (c & 127)) * S_ + sq; }
                    u32x4 w; w.x = pack2(v0[0], v0[1]); w.y = pack2(v0[2], v0[3]); w.z = pack2(v1[0], v1[1]); w.w = pack2(v1[2], v1[3]);
                    *(u32x4*)dst = w;
                    continue;
                }
                if (KIND == 1 || KIND == 2) {
                    const float2* rope = (const float2*)(ws + WS_ROPE);
                    const int pos = row & (S_ - 1), d = 16 * (wc & 1) + 4 * fq;
                    const float4 cs01 = *(const float4*)(rope + pos * 32 + d), cs23 = *(const float4*)(rope + pos * 32 + d + 2);
                    const float c[4] = {cs01.x, cs01.z, cs23.x, cs23.z}, sn[4] = {cs01.y, cs01.w, cs23.y, cs23.w};
                    const float sc = (KIND == 2) ? 0.125f : 1.0f;
                    f32x4 y1, y2;
#pragma unroll
                    for (int r = 0; r < 4; ++r) { y1[r] = (v0[r] * c[r] - v1[r] * sn[r]) * sc; y2[r] = (v0[r] * sn[r] + v1[r] * c[r]) * sc; }
                    v0 = y1; v1 = y2;
                } else if (KIND == 3) {
#pragma unroll
                    for (int r = 0; r < 4; ++r) { v0[r] = v0[r] * fsig(v0[r]); v1[r] = v1[r] * fsig(v1[r]); }
                } else if (KIND == 4) {
#pragma unroll
                    for (int r = 0; r < 4; ++r) { v0[r] = fsig(v0[r]); v1[r] = fsig(v1[r]); }
                }
                u32x4 w; w.x = pack2(v0[0], v0[1]); w.y = pack2(v0[2], v0[3]); w.z = pack2(v1[0], v1[1]); w.w = pack2(v1[2], v1[3]);
                *(u32x4*)((bf16_t*)(ws + WS_P) + (size_t)row * LD + col) = w;
            }
        }
}
struct G1Order {      typedef pg8::Unit U; static constexpr bool GATHER = false;
    int xcd, slot, per;
    __device__ __forceinline__ bool next(int i, pg8::Unit& u) const {
        const int j = slot + i * per; if (j >= 208) return false;
        if (j < 192) { u.pm = j / 3; u.pn = xcd + 8 * (j % 3); } else { const int q = j - 192; u.pm = 8 * xcd + (q >> 1); u.pn = 24 + (q & 1); }
        return true;
    }
    __device__ __forceinline__ void ptrs(const pg8::Unit& u, unsigned& A, unsigned& B) const {
        const unsigned x = (unsigned)WS_XB + (unsigned)u.pm * (256u * 1024u * 2u), w = (unsigned)WS_WIN + (unsigned)u.pn * (256u * 1024u * 2u);
        if (u.pn >= 21) { A = w; B = x; } else { A = x; B = w; }
    }
};
struct G1Epi {
    static constexpr int MID_T = 0;
    unsigned char* ws;
    __device__ __forceinline__ void operator()(const f32x4 (&acc)[2][2][4][2], const pg8::Unit& u, int wr, int wc, int fr, int fq) const {
        const int pn = u.pn, tok0 = u.pm * 256, n0 = pn * 256;
        if (pn >= 21) g1_epi<5>(acc, ws, n0, tok0, wr, wc, fr, fq);
        else if (pn >= 12) g1_epi<4>(acc, ws, tok0, n0, wr, wc, fr, fq);
        else if (pn >= 8) g1_epi<3>(acc, ws, tok0, n0, wr, wc, fr, fq);
        else if (pn >= 6) g1_epi<2>(acc, ws, tok0, n0, wr, wc, fr, fq);
        else if (pn >= 4) g1_epi<1>(acc, ws, tok0, n0, wr, wc, fr, fq);
        else g1_epi<0>(acc, ws, tok0, n0, wr, wc, fr, fq);
    }
};
__device__ __forceinline__ void phase_g1(const Params& p, int layer, unsigned char* lds) {
    unsigned char* ws = launder(p.ws);
    G1Order S; S.xcd = blockIdx.x & 7; S.slot = blockIdx.x >> 3; S.per = gridDim.x >> 3;
    G1Epi E; E.ws = ws;
    pg8::gemm_phase<G1Epi, G1Order>(lds, 1024, S, E, ltid(), ws);
}

__device__ __forceinline__ void load_tile64(const bf16_t* base, size_t rowStride, unsigned char* dst, int wid, int lane) {
    const int c = ((lane & 7) ^ (lane >> 3)) * 8;
#pragma unroll
    for (int i = 0; i < 2; ++i) { const int j = wid + 4 * i, row = 8 * j + (lane >> 3); glds16(base + (size_t)row * rowStride + c, dst + j * 1024); }
}
__device__ __forceinline__ void load_tile128(const bf16_t* base, size_t rowStride, unsigned char* dst, int wid, int lane) {
    const int c = ((lane & 7) ^ (lane >> 3)) * 8;
#pragma unroll
    for (int i = 0; i < 4; ++i) { const int j = wid + 4 * i, row = 8 * j + (lane >> 3); glds16(base + (size_t)row * rowStride + c, dst + j * 1024); }
}
__device__ __forceinline__ void load_tile128w(const bf16_t* base, size_t rowStride, unsigned char* dst, int wid, int lane) {
    const int c = ((lane & 15) ^ ((4 * wid + (lane >> 4)) & 15)) * 8;
#pragma unroll
    for (int i = 0; i < 8; ++i) { const int j = wid + 4 * i, row = 4 * j + (lane >> 4); glds16(base + (size_t)row * rowStride + c, dst + j * 1024); }
}
__device__ __forceinline__ bf16x8 lds_frag128(const unsigned char* tile, int row, int chunk) {
    return *(const bf16x8*)(tile + row * 128 + ((chunk ^ (row & 7)) << 4));
}
__device__ __forceinline__ bf16x8 lds_frag256(const unsigned char* tile, int row, int chunk) {
    return *(const bf16x8*)(tile + row * 256 + ((chunk ^ (row & 15)) << 4));
}
__device__ __forceinline__ bf16x8 lds_vfrag128(const unsigned char* tile, int row, int kbase, int fq) {
    const int ca = (kbase >> 3) + (fq >> 1), hb = (fq & 1) * 8;
    const u32x2 a = *(const u32x2*)(tile + row * 128 + ((ca ^ (row & 7)) << 4) + hb);
    const u32x2 b = *(const u32x2*)(tile + row * 128 + (((ca + 2) ^ (row & 7)) << 4) + hb);
    u32x4 w; w.x = a.x; w.y = a.y; w.z = b.x; w.w = b.y;
    return __builtin_bit_cast(bf16x8, w);
}
__device__ __forceinline__ bf16x8 lds_vfrag256(const unsigned char* tile, int row, int kbase, int fq) {
    const int ca = (kbase >> 3) + (fq >> 1), hb = (fq & 1) * 8;
    const u32x2 a = *(const u32x2*)(tile + row * 256 + ((ca ^ (row & 15)) << 4) + hb);
    const u32x2 b = *(const u32x2*)(tile + row * 256 + (((ca + 2) ^ (row & 15)) << 4) + hb);
    u32x4 w; w.x = a.x; w.y = a.y; w.z = b.x; w.w = b.y;
    return __builtin_bit_cast(bf16x8, w);
}
__device__ __forceinline__ bf16x8 pack8(f32x4 a, f32x4 b) {
    u32x4 w; w.x = pack2(a[0], a[1]); w.y = pack2(a[2], a[3]); w.z = pack2(b[0], b[1]); w.w = pack2(b[2], b[3]);
    return __builtin_bit_cast(bf16x8, w);
}

__device__ __forceinline__ float gelu_tanh(float x) {
    const float u = 0.7978845608028654f * (x + 0.044715f * x * x * x);
    return 0.5f * x * (1.f + tanhf(u));
}
__device__ __forceinline__ void compress_item(const Params& p, int layer, int item, unsigned char* lds, int half) {
    unsigned char* ws = launder(p.ws);
    const int tid = (ltid() & 255), lane = tid & 63, wid = tid >> 6, wr = wid >> 1, wc = wid & 1, fr = lane & 15, fq = lane >> 4;
    const int mtile = item & 3, g = (item >> 2) & 1, b = (item >> 3) & 1, kv = item >> 4;
    const int i0 = mtile * 128;
    const bf16_t* P = (const bf16_t*)(ws + WS_P);
    const bf16_t* W1T = (const bf16_t*)(ws + WS_W1T) + (size_t)kv * 64 * 2048;
    const int col = (kv ? C_VC : C_KC) + g * 64;
    const int ldc = ((lane & 7) ^ (lane >> 3)) * 8;
    const int l0 = 16 * half;
    const bf16_t* ap[4];
#pragma unroll
    for (int i = 0; i < 4; ++i) ap[i] = P + ((size_t)b * S_ + 16 * (i0 + 32 * i + 8 * wid + (lane >> 3)) + l0) * LD + col + ldc;
    const bf16_t* bp[2];
#pragma unroll
    for (int i = 0; i < 2; ++i) bp[i] = W1T + (size_t)(8 * (wid + 4 * i) + (lane >> 3)) * 2048 + l0 * 64 + ldc;
    f32x4 acc[4][2];
#pragma unroll
    for (int i = 0; i < 4; ++i)
#pragma unroll
        for (int j = 0; j < 2; ++j) acc[i][j] = (f32x4){0.f, 0.f, 0.f, 0.f};
    __syncthreads();
#define CSTAGE(buf, l) do { unsigned char* st_ = lds + (buf) * 24576; \
        _Pragma("unroll") for (int i = 0; i < 4; ++i) glds16(ap[i] + (size_t)(l) * LD, st_ + (4 * i + wid) * 1024); \
        _Pragma("unroll") for (int i = 0; i < 2; ++i) glds16(bp[i] + (l) * 64, st_ + 16384 + (wid + 4 * i) * 1024); } while (0)
    CSTAGE(0, 0); CSTAGE(1, 1);
    for (int l = 0; l < 16; ++l) {
        const unsigned char* st = lds + (l % 3) * 24576;
        if (l + 1 < 16) WAIT_V(6); else WAIT_V(0);
        RAW_BARRIER();
        if (l + 2 < 16) CSTAGE((l + 2) % 3, l + 2);
#pragma unroll
        for (int ks = 0; ks < 2; ++ks) {
            bf16x8 a[4], bb[2];
#pragma unroll
            for (int i = 0; i < 4; ++i) a[i] = lds_frag128(st, 64 * wr + 16 * i + fr, 4 * ks + fq);
#pragma unroll
            for (int j = 0; j < 2; ++j) bb[j] = lds_frag128(st + 16384, 32 * wc + 16 * j + fr, 4 * ks + fq);
#pragma unroll
            for (int i = 0; i < 4; ++i)
#pragma unroll
                for (int j = 0; j < 2; ++j) acc[i][j] = mfma16(a[i], bb[j], acc[i][j]);
        }
    }
    __syncthreads();
#undef CSTAGE
    float* xch = (float*)(lds - half * HALF_LDS + HALF_LDS);
    if (half == 1) {
#pragma unroll
        for (int i = 0; i < 4; ++i)
#pragma unroll
            for (int j = 0; j < 2; ++j)
#pragma unroll
                for (int r = 0; r < 4; ++r) xch[((i * 2 + j) * 4 + r) * 256 + tid] = acc[i][j][r];
    }
    __syncthreads();
    if (half == 0) {
        const float* b1 = (const float*)(ws + WS_CTL) + CW_B1P + kv * 32 * 64;
#pragma unroll
        for (int j = 0; j < 2; ++j) {
            const int n = 32 * wc + 16 * j + fr; float bias = 0.f;
#pragma unroll
            for (int kt = 0; kt < 32; ++kt) bias += b1[kt * 64 + n + vzero()];
#pragma unroll
            for (int i = 0; i < 4; ++i)
#pragma unroll
                for (int r = 0; r < 4; ++r) {
                    const int row = 64 * wr + 16 * i + 4 * fq + r;
                    const float hv = gelu_tanh(acc[i][j][r] + xch[((i * 2 + j) * 4 + r) * 256 + tid] + bias);
                    *(bf16_t*)(lds + row * 128 + (((n >> 3) ^ (row & 7)) << 4) + (n & 7) * 2) = f2bf(hv);
                }
        }
        const float* w2 = p.cmp_w2 + ((size_t)layer * 2 + kv) * 64 * 64;
        const int k = tid >> 2, n0 = (tid & 3) * 16;
#pragma unroll
        for (int q4 = 0; q4 < 4; ++q4) {
            const float4 w = *(const float4*)(w2 + k * 64 + n0 + 4 * q4);
            const float wv[4] = {w.x, w.y, w.z, w.w};
#pragma unroll
            for (int e = 0; e < 4; ++e) { const int n = n0 + 4 * q4 + e; *(bf16_t*)(lds + 16384 + n * 128 + (((k >> 3) ^ (n & 7)) << 4) + (k & 7) * 2) = f2bf(wv[e]); }
        }
    }
    __syncthreads();
    if (half == 0) {
        f32x4 o[4][2];
#pragma unroll
        for (int i = 0; i < 4; ++i)
#pragma unroll
            for (int j = 0; j < 2; ++j) o[i][j] = (f32x4){0.f, 0.f, 0.f, 0.f};
#pragma unroll
        for (int ks = 0; ks < 2; ++ks) {
            bf16x8 a[4], bb[2];
#pragma unroll
            for (int i = 0; i < 4; ++i) a[i] = lds_frag128(lds, 64 * wr + 16 * i + fr, 4 * ks + fq);
#pragma unroll
            for (int j = 0; j < 2; ++j) bb[j] = lds_frag128(lds + 16384, 32 * wc + 16 * j + fr, 4 * ks + fq);
#pragma unroll
            for (int i = 0; i < 4; ++i)
#pragma unroll
                for (int j = 0; j < 2; ++j) o[i][j] = mfma16(a[i], bb[j], o[i][j]);
        }
#pragma unroll
        for (int i = 0; i < 4; ++i)
#pragma unroll
            for (int j = 0; j < 2; ++j) {
                const int n = 32 * wc + 16 * j + fr, ci = i0 + 64 * wr + 16 * i + 4 * fq;
                f32x4 v = o[i][j];
#pragma unroll
                for (int r = 0; r < 4; ++r) if (ci + r >= 511) v[r] = 0.f;
                if (kv == 0) {
                    bf16_t* dst = (bf16_t*)(ws + WS_KCC) + ((size_t)(b * 2 + g) * 512 + ci) * 64 + n;
#pragma unroll
                    for (int r = 0; r < 4; ++r) dst[r * 64] = f2bf(v[r]);
                } else {
                    *(u32x2*)((bf16_t*)(ws + WS_VCCT) + ((size_t)(b * 2 + g) * 64 + n) * 512 + ci) = pack4(v);
                }
            }
    }
    __syncthreads();
}

__device__ __forceinline__ float ret_lg2(int h) { const float gam = 1.f - exp2f(-5.f - (float)h); return log2f(gam); }

__device__ __forceinline__ void retkv_item(const Params& p, int item, unsigned char* lds, int half) {
    unsigned char* ws = launder(p.ws);
    const int tid = (ltid() & 255), lane = tid & 63, wid = tid >> 6, fr = lane & 15, fq = lane >> 4;
    const int n = item & 63, h = (item >> 6) & 7, b = item >> 9;
    const size_t tok0 = (size_t)b * S_ + 128 * n;
    unsigned char* vL = lds; unsigned char* kL = lds + 32768;
    load_tile128w((const bf16_t*)(ws + WS_VRT) + ((size_t)(b * 8 + h) * 128) * S_ + 128 * n, S_, vL, wid, lane);
    load_tile128((const bf16_t*)(ws + WS_P) + tok0 * LD + C_KR + h * 64, LD, kL, wid, lane);
    wait_vm0(); __syncthreads();
    const float lg2 = ret_lg2(h);
    f32x4 acc[2][4];
#pragma unroll
    for (int m = 0; m < 2; ++m)
#pragma unroll
        for (int nt = 0; nt < 4; ++nt) acc[m][nt] = (f32x4){0.f, 0.f, 0.f, 0.f};
#pragma unroll
    for (int ks = 0; ks < 4; ++ks) {
        bf16x8 a[2], bb[4];
#pragma unroll
        for (int m = 0; m < 2; ++m) a[m] = lds_frag256(vL, 32 * wid + 16 * m + fr, 4 * ks + fq);
        float dec[8];
#pragma unroll
        for (int j = 0; j < 8; ++j) dec[j] = exp2f((float)(127 - (32 * ks + 8 * fq + j)) * lg2);
#pragma unroll
        for (int nt = 0; nt < 4; ++nt) {
            const int d = 16 * nt + fr;
            float v[8];
#pragma unroll
            for (int j = 0; j < 8; ++j) {
                const int tk = 32 * ks + 8 * fq + j;
                const bf16_t kvv = *(const bf16_t*)(kL + tk * 128 + (((d >> 3) ^ (tk & 7)) << 4) + (d & 7) * 2);
                v[j] = bf2f(kvv) * dec[j];
            }
            u32x4 w; w.x = pack2(v[0], v[1]); w.y = pack2(v[2], v[3]); w.z = pack2(v[4], v[5]); w.w = pack2(v[6], v[7]);
            bb[nt] = __builtin_bit_cast(bf16x8, w);
        }
#pragma unroll
        for (int m = 0; m < 2; ++m)
#pragma unroll
            for (int nt = 0; nt < 4; ++nt) acc[m][nt] = mfma16(a[m], bb[nt], acc[m][nt]);
    }
    float* KVT = (float*)(ws + WS_KVT) + ((size_t)(b * 8 + h) * 64 + n) * 8192;
#pragma unroll
    for (int m = 0; m < 2; ++m)
#pragma unroll
        for (int nt = 0; nt < 4; ++nt)
#pragma unroll
            for (int r = 0; r < 4; ++r) KVT[(32 * wid + 16 * m + 4 * fq + r) * 64 + 16 * nt + fr] = acc[m][nt][r];
    __syncthreads();
}

__device__ __forceinline__ void phase_p2(const Params& p, int layer, unsigned char* lds, int half) {
    const int vb = blockIdx.x * 2 + half, nvb = gridDim.x * 2;
    if (vb < 64) compress_item(p, layer, vb >> 1, lds, half);
    else for (int it = vb - 64; it < 1024; it += nvb - 64) retkv_item(p, it, lds, half);
}

constexpr int NSA_IMP = 32768, NSA_BUCKET = 65792, NSA_BIAS = 73984;

struct NsaLane { int t; int fr, fq, wid, lane; };

constexpr float LOG2E = 1.4426950408889634f;
__device__ __forceinline__ int t5_first(int bk) {
    const int th[16] = {16, 22, 30, 40, 54, 73, 99, 134, 182, 246, 332, 450, 609, 825, 1117, 1513};
    int r = 16;
#pragma unroll
    for (int k = 0; k < 16; ++k) r = (bk == 16 + k) ? th[k] : r;
    return r;
}
template <int BR, int PASS>
__device__ __forceinline__ void nsa_half(const unsigned char* kL, const unsigned char* vL, const unsigned char* lds, const bf16x8 (&qptr)[4][2],
                                         f32x4 (&O)[4][4], float (&m)[4], float (&l)[4], int tile, int hf, const NsaLane& L, int qrow, const bool FAST, int th, int b0, int b1) {
    const int fr = L.lane & 15, fq = L.lane >> 4;
    constexpr float C2 = 0.125f * LOG2E;
    bf16x8 Kf[2][2];
#pragma unroll
    for (int i = 0; i < 2; ++i)
#pragma unroll
        for (int ks = 0; ks < 2; ++ks) Kf[i][ks] = lds_frag128(kL, 32 * hf + 16 * i + fr, 4 * ks + fq);
    bf16x8 Vf[4];
    if (PASS != 0) {
#pragma unroll
        for (int mt = 0; mt < 4; ++mt) Vf[mt] = lds_vfrag128(vL, 16 * mt + fr, 32 * hf, fq);
    }
    unsigned vmask = 0; unsigned bk[2] = {0u, 0u}; bool hi[2][4];
    if (!FAST) {
        const unsigned char* bucketL = lds + NSA_BUCKET;
#pragma unroll
        for (int i = 0; i < 2; ++i) {
            unsigned pk = 0;
#pragma unroll
            for (int r = 0; r < 4; ++r) {
                const int kk = 32 * hf + 16 * i + 4 * fq + r;
                int rel; bool ok;
                if (BR == 0) { rel = L.t - (16 * (64 * tile + kk) + 31); ok = rel >= 0; }
                else { rel = L.t - (64 * tile + kk); ok = rel >= 0 && rel < 512; }
                int rc = rel < 0 ? 0 : rel; rc = rc > 8191 ? 8191 : rc;
                pk |= (unsigned)bucketL[rc] << (8 * r);
                vmask |= (ok ? 1u : 0u) << (4 * i + r);
                hi[i][r] = false;
            }
            bk[i] = pk;
        }
    } else {
        const int kbase = 64 * tile + 32 * hf + 4 * fq;
        const int lim = BR == 0 ? L.t - th - 31 - 16 * kbase : L.t - th - kbase;
#pragma unroll
        for (int i = 0; i < 2; ++i)
#pragma unroll
            for (int r = 0; r < 4; ++r) hi[i][r] = (BR == 0 ? 16 : 1) * (16 * i + r) <= lim;
    }
    const float* biasL = (const float*)(lds + NSA_BIAS);
    float ia[2] = {0.f, 0.f}, ic[2] = {0.f, 0.f};
#pragma unroll
    for (int nt = 0; nt < 4; ++nt) {
        f32x4 S[2];
        const bf16x8 q0 = qptr[nt][0], q1 = qptr[nt][1];
#pragma unroll
        for (int i = 0; i < 2; ++i) {
            S[i] = (f32x4){0.f, 0.f, 0.f, 0.f};
            S[i] = mfma16(Kf[i][0], q0, S[i]); S[i] = mfma16(Kf[i][1], q1, S[i]);
        }
        float tmax = -1e30f;
        if (!FAST) {
#pragma unroll
            for (int i = 0; i < 2; ++i) {
                float bsv[4];
#pragma unroll
                for (int r = 0; r < 4; ++r) bsv[r] = biasL[nt * 32 + ((bk[i] >> (8 * r)) & 0xffu)];
                asm volatile("" : "+v"(bsv[0]), "+v"(bsv[1]), "+v"(bsv[2]), "+v"(bsv[3]));
#pragma unroll
                for (int r = 0; r < 4; ++r) {
                    const bool ok = (vmask >> (4 * i + r)) & 1u;
                    const float sv = S[i][r] * C2 + bsv[r];
                    S[i][r] = ok ? sv : -1e30f; tmax = fmaxf(tmax, S[i][r]);
                }
            }
        } else {
            const float blo = biasL[nt * 32 + b0], bhi = biasL[nt * 32 + b1];
#pragma unroll
            for (int i = 0; i < 2; ++i)
#pragma unroll
                for (int r = 0; r < 4; ++r) { S[i][r] = S[i][r] * C2 + (hi[i][r] ? bhi : blo); tmax = fmaxf(tmax, S[i][r]); }
        }
        if (PASS != 1) {
            if (__builtin_amdgcn_ballot_w64(tmax > m[nt] + 8.f) != 0ull) {
                const float tm = rows_max(tmax);
                const float mnew = tm > m[nt] + 8.f ? tm : m[nt], alpha = __builtin_amdgcn_exp2f(m[nt] - mnew);
                l[nt] *= alpha; m[nt] = mnew;
                if (PASS == 2) {
#pragma unroll
                    for (int mt = 0; mt < 4; ++mt) O[mt][nt] = O[mt][nt] * alpha;
                }
            }
            float psum = 0.f;
#pragma unroll
            for (int i = 0; i < 2; ++i)
#pragma unroll
                for (int r = 0; r < 4; ++r) S[i][r] = __builtin_amdgcn_exp2f(S[i][r] - m[nt]);
            if (!FAST) {
#pragma unroll
                for (int i = 0; i < 2; ++i)
#pragma unroll
                    for (int r = 0; r < 4; ++r) { const bool ok = (vmask >> (4 * i + r)) & 1u; S[i][r] = ok ? S[i][r] : 0.f; }
            }
#pragma unroll
            for (int i = 0; i < 2; ++i)
#pragma unroll
                for (int r = 0; r < 4; ++r) psum += S[i][r];
            l[nt] += psum;
        } else {
#pragma unroll
            for (int i = 0; i < 2; ++i) {
#pragma unroll
                for (int r = 0; r < 4; ++r) S[i][r] = __builtin_amdgcn_exp2f(S[i][r] - m[nt]) * l[nt];
            }
            if (!FAST) {
#pragma unroll
                for (int i = 0; i < 2; ++i)
#pragma unroll
                    for (int r = 0; r < 4; ++r) { const bool ok = (vmask >> (4 * i + r)) & 1u; S[i][r] = ok ? S[i][r] : 0.f; }
            }
#pragma unroll
            for (int i = 0; i < 2; ++i) {
                ia[i] += S[i][0] + S[i][1] + S[i][2] + 0.5f * S[i][3];
                ic[i] += 0.5f * S[i][3];
            }
        }
        if (PASS != 0) {
            const bf16x8 Pb = pack8(S[0], S[1]);
#pragma unroll
            for (int mt = 0; mt < 4; ++mt) O[mt][nt] = mfma16(Vf[mt], Pb, O[mt][nt]);
        }
        if (nt & 1) __builtin_amdgcn_sched_barrier(0);
    }
    if (PASS == 1) {
        float* imp = (float*)(lds + NSA_IMP) + qrow * 129;
        asm volatile("" ::: "memory"); __builtin_amdgcn_wave_barrier();
#pragma unroll
        for (int i = 0; i < 2; ++i) { const int j = 16 * tile + 8 * hf + 4 * i + fq; imp[j] += ia[i]; }
        asm volatile("s_waitcnt lgkmcnt(0)" ::: "memory"); __builtin_amdgcn_wave_barrier();
#pragma unroll
        for (int i = 0; i < 2; ++i) { const int j = 16 * tile + 8 * hf + 4 * i + fq + 1; if (j < 128) imp[j] += ic[i]; }
        asm volatile("s_waitcnt lgkmcnt(0)" ::: "memory"); __builtin_amdgcn_wave_barrier();
    }
}
template <int BR, int PASS>
__device__ __forceinline__ void nsa_tile(const unsigned char* kL, const unsigned char* vL, const unsigned char* lds, const bf16x8 (&qptr)[4][2],
                                         f32x4 (&O)[4][4], float (&m)[4], float (&l)[4], int tile, const NsaLane& L, int qrow) {
    const int tq0 = __builtin_amdgcn_readfirstlane(L.t - (L.lane & 15));
#pragma unroll 1
    for (int hf = 0; hf < 2; ++hf) {
        const int kfirst = 64 * tile + 32 * hf, pmin = BR == 0 ? 16 * kfirst + 31 : kfirst, pmax = BR == 0 ? 16 * (kfirst + 31) + 31 : kfirst + 31;
        const int rmin = tq0 - pmax, rmax = tq0 + 15 - pmin;
        bool fast = false; int th = 0, b0 = 0, b1 = 0;
        if (rmin >= 16 && (BR != 2 || rmax < 512)) {
            const unsigned char* bucketL = lds + NSA_BUCKET;
            b0 = __builtin_amdgcn_readfirstlane((int)bucketL[rmin]); b1 = __builtin_amdgcn_readfirstlane((int)bucketL[rmax > 8191 ? 8191 : rmax]);
            if (b1 - b0 <= 1) { fast = true; th = b1 == b0 ? 0 : t5_first(b1); }
        }
        nsa_half<BR, PASS>(kL, vL, lds, qptr, O, m, l, tile, hf, L, qrow, fast, th, b0, b1);
    }
}

__device__ __forceinline__ void cmp_item(const Params& p, int item, unsigned char* lds, int half) {
    unsigned char* ws = launder(p.ws);
    const int tid = (ltid() & 255), lane = tid & 63, wid = tid >> 6, fr = lane & 15, fq = lane >> 4;
    const int combo = item & 3, qt = 127 - (item >> 2), b = combo >> 1, g = combo & 1;
    const int q0 = qt * 64, qrow = 16 * wid + fr;
    NsaLane L; L.t = q0 + qrow; L.fr = fr; L.fq = fq; L.wid = wid; L.lane = lane;
    const size_t tok = (size_t)b * S_ + L.t;
    const bf16_t* P = (const bf16_t*)(ws + WS_P);
    __syncthreads();
    if (tid < 128) ((float*)(lds + NSA_BIAS))[tid] = p.rel_bias[(tid & 31) * 8 + 4 * g + (tid >> 5)] * LOG2E;
    for (int i = tid; i < 64 * 129; i += HT) ((float*)(lds + NSA_IMP))[i] = 0.f;
    bf16x8 Qf[4][2];
#pragma unroll
    for (int nt = 0; nt < 4; ++nt)
#pragma unroll
        for (int ks = 0; ks < 2; ++ks) Qf[nt][ks] = *(const bf16x8*)(P + tok * LD + C_QA + (4 * g + nt) * 64 + 32 * ks + 8 * fq);
    __syncthreads();
    f32x4 O[4][4]; float m[4], l[4];
    const bf16_t* gates = P + tok * LD + C_GA + (4 * g) * 3;
    const bf16_t* kc = (const bf16_t*)(ws + WS_KCC) + (size_t)(b * 2 + g) * 512 * 64;
    const bf16_t* vc = (const bf16_t*)(ws + WS_VCCT) + (size_t)(b * 2 + g) * 64 * 512;
    const int ntc = ((q0 + 32) >> 4) / 64 + 1;
#pragma unroll
    for (int nt = 0; nt < 4; ++nt) { m[nt] = -1e30f; l[nt] = 0.f; }
    load_tile64(kc, 64, lds, wid, lane);
    wait_vm0(); __syncthreads();
    for (int it = 0; it < ntc; ++it) {
        unsigned char* cur = lds + (it & 1) * 16384;
        if (it + 1 < ntc) load_tile64(kc + (size_t)(it + 1) * 64 * 64, 64, lds + ((it + 1) & 1) * 16384, wid, lane);
        nsa_tile<0, 0>(cur, cur + 8192, lds, Qf, O, m, l, it, L, qrow);
        wait_vm0(); __syncthreads();
    }
#pragma unroll
    for (int nt = 0; nt < 4; ++nt) { l[nt] = rows_sum(l[nt]); l[nt] = l[nt] > 0.f ? 1.f / l[nt] : 0.f; }
#pragma unroll
    for (int mt = 0; mt < 4; ++mt)
#pragma unroll
        for (int nt = 0; nt < 4; ++nt) O[mt][nt] = (f32x4){0.f, 0.f, 0.f, 0.f};
    load_tile64(kc, 64, lds, wid, lane); load_tile64(vc, 512, lds + 8192, wid, lane);
    wait_vm0(); __syncthreads();
    for (int it = 0; it < ntc; ++it) {
        unsigned char* cur = lds + (it & 1) * 16384;
        if (it + 1 < ntc) { unsigned char* nx = lds + ((it + 1) & 1) * 16384;
            load_tile64(kc + (size_t)(it + 1) * 64 * 64, 64, nx, wid, lane); load_tile64(vc + (it + 1) * 64, 512, nx + 8192, wid, lane); }
        nsa_tile<0, 1>(cur, cur + 8192, lds, Qf, O, m, l, it, L, qrow);
        wait_vm0(); __syncthreads();
    }
    bf16_t* YC = (bf16_t*)(ws + WS_YC) + tok * 512 + (4 * g) * 64;
#pragma unroll
    for (int nt = 0; nt < 4; ++nt) {
        const float gt = bf2f(gates[nt * 3 + 0]);
#pragma unroll
        for (int mt = 0; mt < 4; ++mt) *(u32x2*)(YC + nt * 64 + 16 * mt + 4 * fq) = pack4(O[mt][nt] * gt);
    }
    const int cur = qt;
    {
        float* imp = (float*)(lds + NSA_IMP) + qrow * 129 + 32 * fq;
        asm volatile("s_waitcnt lgkmcnt(0)" ::: "memory"); __builtin_amdgcn_wave_barrier();
#pragma unroll
        for (int i = 0; i < 32; ++i) {
            const int j = 32 * fq + i;
            const float v = imp[i];
            imp[i] = j > cur ? -1.f : v + ((j == 0 || j == cur || j == cur - 1) ? 1.0e4f : 0.f);
        }
        unsigned word = 0;
#pragma unroll 1
        for (int round = 0; round < 16; ++round) {
            float bv = imp[0]; int bi = 0;
#pragma unroll
            for (int i = 1; i < 32; ++i) { const float v = imp[i]; if (v > bv) { bv = v; bi = i; } }
            int gi = 32 * fq + bi;
            {
                u32x2 rv = __builtin_amdgcn_permlane16_swap(__float_as_uint(bv), __float_as_uint(bv), false, false);
                u32x2 ri = __builtin_amdgcn_permlane16_swap((unsigned)gi, (unsigned)gi, false, false);
                float v0 = __uint_as_float(rv.x), v1 = __uint_as_float(rv.y); int i0 = (int)ri.x, i1 = (int)ri.y;
                if (v1 > v0 || (v1 == v0 && i1 < i0)) { v0 = v1; i0 = i1; }
                rv = __builtin_amdgcn_permlane32_swap(__float_as_uint(v0), __float_as_uint(v0), false, false);
                ri = __builtin_amdgcn_permlane32_swap((unsigned)i0, (unsigned)i0, false, false);
                v0 = __uint_as_float(rv.x); v1 = __uint_as_float(rv.y); i0 = (int)ri.x; i1 = (int)ri.y;
                if (v1 > v0 || (v1 == v0 && i1 < i0)) { v0 = v1; i0 = i1; }
                bv = v0; gi = i0;
            }
            if (bv >= 0.f && (gi >> 5) == fq) { word |= 1u << (gi & 31); imp[gi & 31] = -2.f; }
        }
        ((unsigned*)(ws + WS_SELW))[(tok * 2 + g) * 4 + fq] = word;
    }
}

__device__ __forceinline__ void win_item(const Params& p, int item, unsigned char* lds, int half) {
    unsigned char* ws = launder(p.ws);
    const int tid = (ltid() & 255), lane = tid & 63, wid = tid >> 6, fr = lane & 15, fq = lane >> 4;
    const int combo = item & 3, qt = 127 - (item >> 2), b = combo >> 1, g = combo & 1;
    const int q0 = qt * 64, qrow = 16 * wid + fr;
    NsaLane L; L.t = q0 + qrow; L.fr = fr; L.fq = fq; L.wid = wid; L.lane = lane;
    const size_t tok = (size_t)b * S_ + L.t;
    const bf16_t* P = (const bf16_t*)(ws + WS_P);
    __syncthreads();
    if (tid < 128) ((float*)(lds + NSA_BIAS))[tid] = p.rel_bias[(tid & 31) * 8 + 4 * g + (tid >> 5)] * LOG2E;
    bf16x8 Qf[4][2];
#pragma unroll
    for (int nt = 0; nt < 4; ++nt)
#pragma unroll
        for (int ks = 0; ks < 2; ++ks) Qf[nt][ks] = *(const bf16x8*)(P + tok * LD + C_QA + (4 * g + nt) * 64 + 32 * ks + 8 * fq);
    __syncthreads();
    f32x4 O[4][4]; float m[4], l[4];
    const bf16_t* gates = P + tok * LD + C_GA + (4 * g) * 3;
#pragma unroll
    for (int nt = 0; nt < 4; ++nt) { m[nt] = -1e30f; l[nt] = 0.f; }
#pragma unroll
    for (int mt = 0; mt < 4; ++mt)
#pragma unroll
        for (int nt = 0; nt < 4; ++nt) O[mt][nt] = (f32x4){0.f, 0.f, 0.f, 0.f};
    {
        const bf16_t* kb = P + ((size_t)b * S_) * LD + C_KW + g * 64;
        const bf16_t* vb = (const bf16_t*)(ws + WS_VWT) + (size_t)(b * 2 + g) * 64 * S_;
        const int k_lo = qt - 8 > 0 ? qt - 8 : 0, ntw = qt - k_lo + 1;
        load_tile64(kb + (size_t)k_lo * 64 * LD, LD, lds, wid, lane); load_tile64(vb + k_lo * 64, S_, lds + 8192, wid, lane);
        wait_vm0(); __syncthreads();
        for (int it = 0; it < ntw; ++it) {
            unsigned char* cu = lds + (it & 1) * 16384;
            if (it + 1 < ntw) { unsigned char* nx = lds + ((it + 1) & 1) * 16384;
                load_tile64(kb + (size_t)(k_lo + it + 1) * 64 * LD, LD, nx, wid, lane); load_tile64(vb + (k_lo + it + 1) * 64, S_, nx + 8192, wid, lane); }
            nsa_tile<2, 2>(cu, cu + 8192, lds, Qf, O, m, l, k_lo + it, L, qrow);
            wait_vm0(); __syncthreads();
        }
    }
    bf16_t* YW = (bf16_t*)(ws + WS_YW) + tok * 512 + (4 * g) * 64;
#pragma unroll
    for (int nt = 0; nt < 4; ++nt) {
        const float lt = rows_sum(l[nt]), gt = bf2f(gates[nt * 3 + 2]) * (lt > 0.f ? 1.f / lt : 0.f);
#pragma unroll
        for (int mt = 0; mt < 4; ++mt) *(u32x2*)(YW + nt * 64 + 16 * mt + 4 * fq) = pack4(O[mt][nt] * gt);
    }
}

constexpr int SEL_RING = 8, SEL_BUCKET = SEL_RING * 16384, SEL_BIAS2 = SEL_BUCKET + 8192;
template <bool FAST>
__device__ __forceinline__ void sel_ntile(const bf16x8 (&Kf)[4][2], const unsigned char* vL, int fr, int fq, const bf16x8& q0, const bf16x8& q1, f32x4 (&O)[4], float& m, float& l,
                                          bool sb, int relb, int th, float blo, float bhi, const unsigned char* lds, int hl) {
    f32x4 S[4];
#pragma unroll
    for (int i = 0; i < 4; ++i) { S[i] = (f32x4){0.f, 0.f, 0.f, 0.f}; S[i] = mfma16(Kf[i][0], q0, S[i]); S[i] = mfma16(Kf[i][1], q1, S[i]); }
    float tmax = -1e30f;
    const float scl = (!FAST || sb) ? 0.125f * LOG2E : 0.f;
    if (FAST) { blo = (sb ? blo : -1e30f) - m; bhi = (sb ? bhi : -1e30f) - m; }
    if (FAST) {
#pragma unroll
        for (int i = 0; i < 4; ++i)
#pragma unroll
            for (int r = 0; r < 4; ++r) { const int rel = relb - (16 * i + r); S[i][r] = S[i][r] * scl + (rel >= th ? bhi : blo); tmax = fmaxf(tmax, S[i][r]); }
    } else {
        unsigned bkt[4][4]; float bs[4][4];
#pragma unroll
        for (int i = 0; i < 4; ++i)
#pragma unroll
            for (int r = 0; r < 4; ++r) { const int rel = relb - (16 * i + r); int rc = rel < 0 ? 0 : rel; rc = rc > 8191 ? 8191 : rc; bkt[i][r] = (lds + SEL_BUCKET)[rc]; }
#pragma unroll
        for (int i = 0; i < 4; ++i)
#pragma unroll
            for (int r = 0; r < 4; ++r) bs[i][r] = ((const float*)(lds + SEL_BIAS2))[hl * 32 + bkt[i][r]];
        asm volatile("" : "+v"(bs[0][0]), "+v"(bs[0][1]), "+v"(bs[0][2]), "+v"(bs[0][3]), "+v"(bs[1][0]), "+v"(bs[1][1]), "+v"(bs[1][2]), "+v"(bs[1][3]),
                          "+v"(bs[2][0]), "+v"(bs[2][1]), "+v"(bs[2][2]), "+v"(bs[2][3]), "+v"(bs[3][0]), "+v"(bs[3][1]), "+v"(bs[3][2]), "+v"(bs[3][3]));
        const float ninf = -1e30f;
#pragma unroll
        for (int i = 0; i < 4; ++i)
#pragma unroll
            for (int r = 0; r < 4; ++r) {
                const int rel = relb - (16 * i + r);
                const float sv = S[i][r] * (0.125f * LOG2E) + (bs[i][r] - m);
                S[i][r] = (sb && rel >= 0) ? sv : ninf; tmax = fmaxf(tmax, S[i][r]);
            }
    }
    tmax = rows_max(tmax);
    if (__ballot(tmax > 8.f) != 0ull) {
        const float d = fmaxf(tmax, 0.f), alpha = __builtin_amdgcn_exp2f(-d);
        m += d; l *= alpha;
#pragma unroll
        for (int mt = 0; mt < 4; ++mt) O[mt] = O[mt] * alpha;
#pragma unroll
        for (int i = 0; i < 4; ++i)
#pragma unroll
            for (int r = 0; r < 4; ++r) S[i][r] -= d;
    }
    float psum = 0.f;
#pragma unroll
    for (int i = 0; i < 4; ++i)
#pragma unroll
        for (int r = 0; r < 4; ++r) { const float pv = __builtin_amdgcn_exp2f(S[i][r]); S[i][r] = pv; psum += pv; }
    l += rows_sum(psum);
    const bf16x8 Pb0 = pack8(S[0], S[1]), Pb1 = pack8(S[2], S[3]);
#pragma unroll
    for (int mt = 0; mt < 4; ++mt) { O[mt] = mfma16(lds_vfrag128(vL, 16 * mt + fr, 0, fq), Pb0, O[mt]); O[mt] = mfma16(lds_vfrag128(vL, 16 * mt + fr, 32, fq), Pb1, O[mt]); }
}
__device__ __forceinline__ void sel_ntile2_fast(const bf16x8 (&Kf)[4][2], const unsigned char* vL, int fr, int fq, const bf16x8 (&Qf)[2][2], f32x4 (&O)[2][4], float (&m)[2], float (&l)[2],
                                                const bool (&sb)[2], const int (&relb)[2], int th, float blo, float bhi) {
    f32x4 S[2][4]; float tmax[2], bl[2], bh[2], scl[2];
#pragma unroll
    for (int b = 0; b < 2; ++b)
#pragma unroll
        for (int i = 0; i < 4; ++i) { S[b][i] = (f32x4){0.f, 0.f, 0.f, 0.f}; S[b][i] = mfma16(Kf[i][0], Qf[b][0], S[b][i]); S[b][i] = mfma16(Kf[i][1], Qf[b][1], S[b][i]); }
#pragma unroll
    for (int b = 0; b < 2; ++b) { scl[b] = sb[b] ? 0.125f * LOG2E : 0.f; bl[b] = (sb[b] ? blo : -1e30f) - m[b]; bh[b] = (sb[b] ? bhi : -1e30f) - m[b]; tmax[b] = -1e30f; }
#pragma unroll
    for (int b = 0; b < 2; ++b)
#pragma unroll
        for (int i = 0; i < 4; ++i)
#pragma unroll
            for (int r = 0; r < 4; ++r) { const int rel = relb[b] - (16 * i + r); S[b][i][r] = S[b][i][r] * scl[b] + (rel >= th ? bh[b] : bl[b]); tmax[b] = fmaxf(tmax[b], S[b][i][r]); }
#pragma unroll
    for (int b = 0; b < 2; ++b) tmax[b] = rows_max(tmax[b]);
    if (__ballot(tmax[0] > 8.f || tmax[1] > 8.f) != 0ull) {
#pragma unroll
        for (int b = 0; b < 2; ++b) {
            const float d = fmaxf(tmax[b], 0.f), alpha = __builtin_amdgcn_exp2f(-d);
            m[b] += d; l[b] *= alpha;
#pragma unroll
            for (int mt = 0; mt < 4; ++mt) O[b][mt] = O[b][mt] * alpha;
#pragma unroll
            for (int i = 0; i < 4; ++i)
#pragma unroll
                for (int r = 0; r < 4; ++r) S[b][i][r] -= d;
        }
    }
    float psum[2] = {0.f, 0.f};
#pragma unroll
    for (int b = 0; b < 2; ++b)
#pragma unroll
        for (int i = 0; i < 4; ++i)
#pragma unroll
            for (int r = 0; r < 4; ++r) { const float pv = __builtin_amdgcn_exp2f(S[b][i][r]); S[b][i][r] = pv; psum[b] += pv; }
#pragma unroll
    for (int b = 0; b < 2; ++b) l[b] += rows_sum(psum[b]);
    bf16x8 P0[2], P1[2];
#pragma unroll
    for (int b = 0; b < 2; ++b) { P0[b] = pack8(S[b][0], S[b][1]); P1[b] = pack8(S[b][2], S[b][3]); }
#pragma unroll
    for (int mt = 0; mt < 4; ++mt) {
        const bf16x8 v0 = lds_vfrag128(vL, 16 * mt + fr, 0, fq), v1 = lds_vfrag128(vL, 16 * mt + fr, 32, fq);
#pragma unroll
        for (int b = 0; b < 2; ++b) { O[b][mt] = mfma16(v0, P0[b], O[b][mt]); O[b][mt] = mfma16(v1, P1[b], O[b][mt]); }
    }
}
template <bool FAST>
__device__ __forceinline__ void sel_tile(const unsigned char* kL, const unsigned char* vL, const unsigned char* lds, const bf16x8 (&Qf)[2][2], f32x4 (&O)[2][4], float (&m)[2], float (&l)[2],
                                         const bool (&sb)[2], const bool (&need)[2], const int (&relb)[2], int th, float blo, float bhi, int hl, int fr, int fq) {
    bf16x8 Kf[4][2];
#pragma unroll
    for (int i = 0; i < 4; ++i)
#pragma unroll
        for (int ks = 0; ks < 2; ++ks) Kf[i][ks] = lds_frag128(kL, 16 * i + fr, 4 * ks + fq);
    if (FAST && need[0] && need[1]) { sel_ntile2_fast(Kf, vL, fr, fq, Qf, O, m, l, sb, relb, th, blo, bhi); return; }
    if (need[0]) sel_ntile<FAST>(Kf, vL, fr, fq, Qf[0][0], Qf[0][1], O[0], m[0], l[0], sb[0], relb[0], th, blo, bhi, lds, hl);
    if (need[1]) sel_ntile<FAST>(Kf, vL, fr, fq, Qf[1][0], Qf[1][1], O[1], m[1], l[1], sb[1], relb[1], th, blo, bhi, lds, hl);
}
template <int VAR>
__device__ __forceinline__ void sel_item(const Params& p, int v, unsigned char* lds) {
    unsigned char* ws = launder(p.ws);
    const int tid = ltid(), lane = tid & 63, wid = tid >> 6, fr = lane & 15, fq = lane >> 4;
    const int qt = 127 - (v >> 2), sub = v & 3, b = sub >> 1, g = sub & 1;
    const int q0 = qt * 64, cur = qt, hl = fr & 3;
    const bf16_t* P = (const bf16_t*)(ws + WS_P);
    __syncthreads();
    if (tid < 128) ((float*)(lds + SEL_BIAS2))[tid] = p.rel_bias[(tid & 31) * 8 + 4 * g + (tid >> 5)] * LOG2E;
    int t[2]; size_t tok[2]; bf16x8 Qf[2][2]; unsigned selw[2][4];
#pragma unroll
    for (int nt = 0; nt < 2; ++nt) {
        t[nt] = q0 + 8 * wid + 4 * nt + (fr >> 2); tok[nt] = (size_t)b * S_ + t[nt];
#pragma unroll
        for (int ks = 0; ks < 2; ++ks) Qf[nt][ks] = *(const bf16x8*)(P + tok[nt] * LD + C_QA + (4 * g + hl) * 64 + 32 * ks + 8 * fq);
        const u32x4 w = *(const u32x4*)((const unsigned*)(ws + WS_SELW) + (tok[nt] * 2 + g) * 4);
        selw[nt][0] = w.x; selw[nt][1] = w.y; selw[nt][2] = w.z; selw[nt][3] = w.w;
    }
    f32x4 O[2][4]; float m[2], l[2];
#pragma unroll
    for (int nt = 0; nt < 2; ++nt) { m[nt] = -1000.f; l[nt] = 0.f;
#pragma unroll
        for (int mt = 0; mt < 4; ++mt) O[nt][mt] = (f32x4){0.f, 0.f, 0.f, 0.f}; }
    const bf16_t* kb = P + ((size_t)b * S_) * LD + C_KS + g * 64;
    const bf16_t* vb = (const bf16_t*)(ws + WS_VST) + (size_t)(b * 2 + g) * 64 * S_;
    const int nts = cur + 1;
#define SEL_ISSUE(jj) do { unsigned char* st_ = lds + ((jj) & 7) * 16384; const int c_ = ((lane & 7) ^ (lane >> 3)) * 8, r_ = 8 * wid + (lane >> 3); \
        glds16(kb + ((size_t)(jj) * 64 + r_) * LD + c_, st_ + wid * 1024); glds16(vb + (size_t)r_ * S_ + (jj) * 64 + c_, st_ + 8192 + wid * 1024); } while (0)
    asm volatile("s_waitcnt vmcnt(0)" ::: "memory");
#pragma unroll
    for (int q = 0; q < 4; ++q) if (q < nts) SEL_ISSUE(q);
    const unsigned char* bucketL = lds + SEL_BUCKET;
    for (int jp = 0; jp < nts; jp += 4) {
        WAIT_V(0);
        RAW_BARRIER();
#pragma unroll
        for (int q = 4; q < 8; ++q) if (jp + q < nts) SEL_ISSUE(jp + q);
#pragma unroll 1
      for (int j = jp; j < jp + 4 && j < nts; ++j) {
        const unsigned char* cu = lds + (j & 7) * 16384;
        bool sb[2], need[2]; int relb[2];
#pragma unroll
        for (int nt = 0; nt < 2; ++nt) {
            const unsigned w = j < 32 ? selw[nt][0] : j < 64 ? selw[nt][1] : j < 96 ? selw[nt][2] : selw[nt][3];
            sb[nt] = (w >> (j & 31)) & 1u; need[nt] = __ballot(sb[nt]) != 0ull; relb[nt] = t[nt] - 64 * j - 4 * fq;
        }
        if (VAR == 1) { need[0] = false; need[1] = false; }
        if (VAR == 2) { if (!(need[0] || need[1])) { need[0] = false; } else { need[0] = true; need[1] = true; } }
        if (need[0] || need[1]) {
            const int rmin = q0 - 64 * j - 63, rmax = q0 + 31 - 64 * j;
            bool fast = false; int th = 0; float blo = 0.f, bhi = 0.f;
            if (rmin >= 16) {
                const int b0 = bucketL[rmin], b1 = bucketL[rmax > 8191 ? 8191 : rmax];
                if (b1 - b0 <= 1) { fast = true; th = t5_first(b1); if (b1 == b0) th = 0;
                    blo = ((const float*)(lds + SEL_BIAS2))[hl * 32 + b0]; bhi = ((const float*)(lds + SEL_BIAS2))[hl * 32 + b1]; }
            }
            if (fast) sel_tile<true>(cu, cu + 8192, lds, Qf, O, m, l, sb, need, relb, th, blo, bhi, hl, fr, fq);
            else sel_tile<false>(cu, cu + 8192, lds, Qf, O, m, l, sb, need, relb, th, blo, bhi, hl, fr, fq);
        }
      }
    }
#undef SEL_ISSUE
    __syncthreads();
#pragma unroll
    for (int nt = 0; nt < 2; ++nt) {
        const float gt = bf2f(P[tok[nt] * LD + C_GA + (4 * g + hl) * 3 + 1]) * (l[nt] > 0.f ? 1.f / l[nt] : 0.f);
        const size_t o = tok[nt] * 512 + (4 * g + hl) * 64;
#pragma unroll
        for (int mt = 0; mt < 4; ++mt) {
            const f32x4 yc = unpack4(*(const u32x2*)((const bf16_t*)(ws + WS_YC) + o + 16 * mt + 4 * fq));
            const f32x4 yw = unpack4(*(const u32x2*)((const bf16_t*)(ws + WS_YW) + o + 16 * mt + 4 * fq));
            if (VAR == 0 || VAR == 3) *(u32x2*)((bf16_t*)(ws + WS_YA) + tok[nt] * 1536 + (4 * g + hl) * 64 + 16 * mt + 4 * fq) = pack4(yc + yw + O[nt][mt] * gt);
            else asm volatile("" :: "v"(O[nt][mt]));
        }
    }
}

__device__ __forceinline__ void scan_item(const Params& p, int item, int half) {
    unsigned char* ws = launder(p.ws);
    const int idx = item * HT + (ltid() & 255);
    const int bh = idx >> 13, ed = idx & 8191, h = bh & 7;
    const float dec = exp2f(128.f * ret_lg2(h));
    const float* KVT = (const float*)(ws + WS_KVT) + (size_t)bh * 64 * 8192 + ed;
    bf16_t* SPT = (bf16_t*)(ws + WS_SPT) + (size_t)bh * 64 * 8192 + ed;
    float s = 0.f;
    for (int n = 0; n < 64; ++n) { SPT[(size_t)n * 8192] = f2bf(s); s = s * dec + KVT[(size_t)n * 8192]; }
}

__device__ __forceinline__ void phase_p3(const Params& p, unsigned char* lds, int half, int what) {
    for (int i = (ltid() & 255); i < 8192 / 16; i += HT) ((u32x4*)(lds + NSA_BUCKET))[i] = ((const u32x4*)(launder(p.ws) + WS_BUCKET))[i];
    __syncthreads();
    for (int h = (blockIdx.x * 2 + half); h < 512; h += (gridDim.x * 2)) {
        if (what & 1) cmp_item(p, h, lds, half);
        if (what & 2) {
            if (h >= 128 && h < 384) win_item(p, h - 128, lds, half);
            else if (h >= 384) { win_item(p, 256 + 2 * (h - 384) - ((h & 1) ? 1 : 0) , lds, half); win_item(p, 256 + 2 * (h - 384) + ((h & 1) ? 0 : 1) + 1 - ((h & 1) ? 0 : 0), lds, half); }
        }
        if (what & 4) scan_item(p, h, half);
    }
}

__device__ __forceinline__ void retout_item(const Params& p, int item, unsigned char* lds, int half) {
    unsigned char* ws = launder(p.ws);
    const int tid = (ltid() & 255), lane = tid & 63, wid = tid >> 6, fr = lane & 15, fq = lane >> 4;
    const int n = item & 63, h = (item >> 6) & 7, b = item >> 9;
    const size_t tok0 = (size_t)b * S_ + 128 * n;
    const bf16_t* P = (const bf16_t*)(ws + WS_P);
    unsigned char* vL = lds; unsigned char* kL = lds + 32768; unsigned char* sL = lds + 49152;
    __syncthreads();
    load_tile128w((const bf16_t*)(ws + WS_VRT) + ((size_t)(b * 8 + h) * 128) * S_ + 128 * n, S_, vL, wid, lane);
    load_tile128(P + tok0 * LD + C_KR + h * 64, LD, kL, wid, lane);
    load_tile128((const bf16_t*)(ws + WS_SPT) + ((size_t)(b * 8 + h) * 64 + n) * 8192, 64, sL, wid, lane);
    bf16x8 Qf[2][2];
#pragma unroll
    for (int nt = 0; nt < 2; ++nt)
#pragma unroll
        for (int ks = 0; ks < 2; ++ks) Qf[nt][ks] = *(const bf16x8*)(P + (tok0 + 32 * wid + 16 * nt + fr) * LD + C_QR + h * 64 + 32 * ks + 8 * fq);
    wait_vm0(); __syncthreads();
    const float lg2 = ret_lg2(h);
    f32x4 Y[8][2];
#pragma unroll
    for (int m = 0; m < 8; ++m)
#pragma unroll
        for (int nt = 0; nt < 2; ++nt) Y[m][nt] = (f32x4){0.f, 0.f, 0.f, 0.f};
#pragma unroll
    for (int m = 0; m < 8; ++m)
#pragma unroll
        for (int ks = 0; ks < 2; ++ks) {
            const bf16x8 a = lds_frag128(sL, 16 * m + fr, 4 * ks + fq);
#pragma unroll
            for (int nt = 0; nt < 2; ++nt) Y[m][nt] = mfma16(a, Qf[nt][ks], Y[m][nt]);
        }
#pragma unroll
    for (int nt = 0; nt < 2; ++nt) {
        const float sc = exp2f((float)(32 * wid + 16 * nt + fr + 1) * lg2);
#pragma unroll
        for (int m = 0; m < 8; ++m) Y[m][nt] = Y[m][nt] * sc;
    }
#pragma unroll 1
    for (int s = 0; s < 4; ++s) {
        f32x4 St[2][2];
#pragma unroll
        for (int hh = 0; hh < 2; ++hh) {
            const int mt = 2 * s + hh;
#pragma unroll
            for (int nt = 0; nt < 2; ++nt) St[hh][nt] = (f32x4){0.f, 0.f, 0.f, 0.f};
#pragma unroll
            for (int ks = 0; ks < 2; ++ks) {
                const bf16x8 a = lds_frag128(kL, 16 * mt + fr, 4 * ks + fq);
#pragma unroll
                for (int nt = 0; nt < 2; ++nt) St[hh][nt] = mfma16(a, Qf[nt][ks], St[hh][nt]);
            }
#pragma unroll
            for (int nt = 0; nt < 2; ++nt) {
                const int qi = 32 * wid + 16 * nt + fr;
#pragma unroll
                for (int r = 0; r < 4; ++r) {
                    const int kj = 16 * mt + 4 * fq + r;
                    const float dm = qi >= kj ? exp2f((float)(qi - kj) * lg2) : 0.f;
                    St[hh][nt][r] *= dm;
                }
            }
        }
        bf16x8 Pb[2];
#pragma unroll
        for (int nt = 0; nt < 2; ++nt) Pb[nt] = pack8(St[0][nt], St[1][nt]);
#pragma unroll
        for (int m = 0; m < 8; ++m) {
            const bf16x8 a = lds_vfrag256(vL, 16 * m + fr, 32 * s, fq);
#pragma unroll
            for (int nt = 0; nt < 2; ++nt) Y[m][nt] = mfma16(a, Pb[nt], Y[m][nt]);
        }
    }
    bf16_t* YB = (bf16_t*)(ws + WS_YA) + 512;
#pragma unroll
    for (int nt = 0; nt < 2; ++nt) {
        float sum = 0.f;
#pragma unroll
        for (int m = 0; m < 8; ++m) sum += Y[m][nt][0] + Y[m][nt][1] + Y[m][nt][2] + Y[m][nt][3];
        sum = rows_sum(sum);
        const float mu = sum * (1.f / 128.f);
        float vs = 0.f;
#pragma unroll
        for (int m = 0; m < 8; ++m)
#pragma unroll
            for (int r = 0; r < 4; ++r) { const float dlt = Y[m][nt][r] - mu; vs += dlt * dlt; }
        vs = rows_sum(vs);
        const float rstd = rsqrtf(vs * (1.f / 128.f) + 1e-5f);
        const size_t tk = tok0 + 32 * wid + 16 * nt + fr;
#pragma unroll
        for (int m = 0; m < 8; ++m) {
            const f32x4 gt = unpack4(*(const u32x2*)(P + tk * LD + C_GR + h * 128 + 16 * m + 4 * fq));
            f32x4 v;
#pragma unroll
            for (int r = 0; r < 4; ++r) v[r] = (Y[m][nt][r] - mu) * rstd * gt[r];
            *(u32x2*)(YB + tk * 1536 + h * 128 + 16 * m + 4 * fq) = pack4(v);
        }
    }
}
__device__ __forceinline__ void phase_p4_sel(const Params& p, unsigned char* lds) {
    for (int i = ltid(); i < 8192 / 16; i += NTHREADS) ((u32x4*)(lds + SEL_BUCKET))[i] = ((const u32x4*)(launder(p.ws) + WS_BUCKET))[i];
    __syncthreads();
    for (int it = blockIdx.x; it < 512; it += gridDim.x * 2) {
        sel_item<0>(p, it, lds);
        if (511 - it != it) sel_item<0>(p, 511 - it, lds);
    }
    __syncthreads();
}
__device__ __forceinline__ void phase_p4(const Params& p, unsigned char* lds, int half) {
    for (int it = (blockIdx.x * 2 + half); it < 1024; it += (gridDim.x * 2)) retout_item(p, it, lds, half);
}

struct RowOrder {     typedef pg8::Unit U; static constexpr bool GATHER = false;
    unsigned a, b; int K, xcd, slot, per;
    __device__ __forceinline__ bool next(int i, pg8::Unit& u) const { const int t = xcd * 32 + slot + i * per; if (t >= (xcd + 1) * 32) return false; u.pm = t >> 2; u.pn = t & 3; return true; }
    __device__ __forceinline__ void ptrs(const pg8::Unit& u, unsigned& A, unsigned& B) const { A = a + (unsigned)u.pm * 512u * (unsigned)K; B = b + (unsigned)u.pn * 512u * (unsigned)K; }
};
template <int MODE>
struct MixEpi {
    static constexpr int MID_T = MODE == 0 ? 8 : 0;
    unsigned char* ws; const float* X;
    __device__ __forceinline__ void mid(f32x4 (&acc)[2][2][4][2], const pg8::Unit& u, int wr, int wc, int fr, int fq) const {
#pragma unroll
        for (int ai = 0; ai < 2; ++ai) {
            __builtin_amdgcn_sched_barrier(0);
#pragma unroll
            for (int m = 0; m < 4; ++m) {
                const size_t tok = (size_t)(u.pm * 256 + 128 * ai + 64 * wr + 16 * m + fr + vzero());
#pragma unroll
                for (int bj = 0; bj < 2; ++bj) {
                    const int n = u.pn * 256 + 128 * bj + 32 * wc + 8 * fq;
                    const u32x4 ga = *(const u32x4*)((const bf16_t*)(ws + WS_P) + tok * LD + C_MA + n), gb = *(const u32x4*)((const bf16_t*)(ws + WS_P) + tok * LD + C_MB + n);
                    const f32x4 a0 = unpack4((u32x2){ga.x, ga.y}), a1 = unpack4((u32x2){ga.z, ga.w}), b0 = unpack4((u32x2){gb.x, gb.y}), b1 = unpack4((u32x2){gb.z, gb.w});
#pragma unroll
                    for (int r = 0; r < 4; ++r) { acc[ai][bj][m][0][r] *= a0[r] * __builtin_amdgcn_rcpf(fmaxf(b0[r], 1e-30f)); acc[ai][bj][m][1][r] *= a1[r] * __builtin_amdgcn_rcpf(fmaxf(b1[r], 1e-30f)); }
                }
            }
        }
        __builtin_amdgcn_sched_barrier(0);
    }
    __device__ __forceinline__ void operator()(const f32x4 (&acc)[2][2][4][2], const pg8::Unit& u, int wr, int wc, int fr, int fq) const {
#pragma unroll
        for (int ai = 0; ai < 2; ++ai)
#pragma unroll
            for (int m = 0; m < 4; ++m) {
                const size_t tok = (size_t)(u.pm * 256 + 128 * ai + 64 * wr + 16 * m + fr + vzero());
#pragma unroll
                for (int bj = 0; bj < 2; ++bj) {
                    const int n = u.pn * 256 + 128 * bj + 32 * wc + 8 * fq;
                    const f32x4 v0 = acc[ai][bj][m][0], v1 = acc[ai][bj][m][1];
                    if (MODE == 2) {
                        const u32x4 xw = *(const u32x4*)((const bf16_t*)(ws + WS_XB) + tok * 1024 + n);
                        const f32x4 h0 = unpack4((u32x2){xw.x, xw.y}) * DN_ALPHA + v0, h1 = unpack4((u32x2){xw.z, xw.w}) * DN_ALPHA + v1;
                        u32x4 w; w.x = pack2(h0[0], h0[1]); w.y = pack2(h0[2], h0[3]); w.z = pack2(h1[0], h1[1]); w.w = pack2(h1[2], h1[3]);
                        *(u32x4*)((bf16_t*)(ws + WS_H1) + tok * 1024 + n) = w;
                    } else {
                        const u32x4 gw = *(const u32x4*)((const bf16_t*)(ws + WS_P) + tok * LD + C_MB + n);
                        const f32x4 g0 = unpack4((u32x2){gw.x, gw.y}), g1 = unpack4((u32x2){gw.z, gw.w});
                        const f32x4 o0 = g0 * v0, o1 = g1 * v1;
                        u32x4 w; w.x = pack2(o0[0], o0[1]); w.y = pack2(o0[2], o0[3]); w.z = pack2(o1[0], o1[1]); w.w = pack2(o1[2], o1[3]);
                        *(u32x4*)((bf16_t*)(ws + WS_MG) + tok * 1024 + n) = w;
                    }
                }
            }
    }
};
__device__ __forceinline__ void phase_g2(const Params& p, unsigned char* lds) {
    unsigned char* ws = launder(p.ws);
    RowOrder S; S.xcd = blockIdx.x & 7; S.slot = blockIdx.x >> 3; S.per = gridDim.x >> 3;
    S.a = (unsigned)WS_YA; S.b = (unsigned)WS_WA; S.K = 1536; MixEpi<0> E; E.ws = ws; E.X = nullptr;
    pg8::gemm_phase<MixEpi<0>, RowOrder>(lds, 1536, S, E, ltid(), ws);
}
__device__ __forceinline__ void phase_g3(const Params& p, int layer, unsigned char* lds) {
    unsigned char* ws = launder(p.ws);
    RowOrder S; S.xcd = blockIdx.x & 7; S.slot = blockIdx.x >> 3; S.per = gridDim.x >> 3; S.a = (unsigned)WS_MG; S.b = (unsigned)WS_WO; S.K = 1024;
    MixEpi<2> E; E.ws = ws; E.X = nullptr;
    pg8::gemm_phase<MixEpi<2>, RowOrder>(lds, 1024, S, E, ltid(), ws);
}

__device__ __forceinline__ void phase_ln1(const Params& p, int layer, unsigned char* lds, bool dry, int half) {
    unsigned char* ws = launder(p.ws);
    const int tid = (ltid() & 255), lane = tid & 63, wid = tid >> 6;
    float* wrL = (float*)lds;
    float* lgL = (float*)(lds - half * HALF_LDS + 65536);
    {
        float4 wv[16];
#pragma unroll
        for (int k = 0; k < 16; ++k) wv[k] = ((const float4*)p.w_router)[tid + 256 * k];
#pragma unroll
        for (int k = 0; k < 16; ++k) { const int i4 = tid + 256 * k, d = i4 >> 2, e0 = (i4 & 3) * 4;
            wrL[(e0 + 0) * 1024 + d] = wv[k].x; wrL[(e0 + 1) * 1024 + d] = wv[k].y; wrL[(e0 + 2) * 1024 + d] = wv[k].z; wrL[(e0 + 3) * 1024 + d] = wv[k].w; }
    }
    __syncthreads();
    const bf16_t* H1 = (const bf16_t*)(ws + WS_H1);
    bf16_t* X1B = (bf16_t*)(ws + WS_X1B);
    const float* gam = p.ln1_g + layer * 1024; const float* bet = p.ln1_b + layer * 1024;
    unsigned* cnt = (unsigned*)(ws + WS_CTL) + (dry ? 0 : CW_CNT) + layer * 1024;
    int* LIST = (int*)(ws + (dry ? WS_HB : WS_LIST)); float* WTS = (float*)(ws + (dry ? WS_HB + 4194304 : WS_WTS));
    constexpr int U = 4;
    const int nwave = (gridDim.x * 2) * 4, wv = (blockIdx.x * 2 + half) * 4 + wid;
    const int nloc = ((T_ - wv * U + nwave * U - 1) / (nwave * U)) * (4 * U);
    u32x2 vn[U][4];
#pragma unroll
    for (int u = 0; u < U; ++u)
#pragma unroll
        for (int j = 0; j < 4; ++j) vn[u][j] = *(const u32x2*)(H1 + (size_t)(wv * U + u) * 1024 + 256 * j + 4 * lane);
    for (int t0 = wv * U; t0 < T_; t0 += nwave * U) {
        float4 y[U][4]; float s[U], q[U];
#pragma unroll
        for (int u = 0; u < U; ++u) {
            s[u] = 0.f;
#pragma unroll
            for (int j = 0; j < 4; ++j) { const f32x4 t = unpack4(vn[u][j]); y[u][j].x = t[0]; y[u][j].y = t[1]; y[u][j].z = t[2]; y[u][j].w = t[3]; s[u] += (t[0] + t[1]) + (t[2] + t[3]); }
        }
        { const int tn = t0 + nwave * U < T_ ? t0 + nwave * U : t0;
#pragma unroll
          for (int u = 0; u < U; ++u)
#pragma unroll
              for (int j = 0; j < 4; ++j) vn[u][j] = *(const u32x2*)(H1 + (size_t)(tn + u) * 1024 + 256 * j + 4 * lane); }
#pragma unroll
        for (int u = 0; u < U; ++u) s[u] = wave_sum(s[u]) * (1.f / 1024.f);
#pragma unroll
        for (int u = 0; u < U; ++u) {
            q[u] = 0.f;
#pragma unroll
            for (int j = 0; j < 4; ++j) { const float a = y[u][j].x - s[u], b2 = y[u][j].y - s[u], c = y[u][j].z - s[u], d = y[u][j].w - s[u]; q[u] += a * a + b2 * b2 + c * c + d * d; }
        }
#pragma unroll
        for (int u = 0; u < U; ++u) q[u] = rsqrtf(wave_sum(q[u]) * (1.f / 1024.f) + 1e-5f);
#pragma unroll
        for (int j = 0; j < 4; ++j) {
            const int d0 = 256 * j + 4 * lane;
            const float4 gg = *(const float4*)(gam + d0), bb = *(const float4*)(bet + d0);
#pragma unroll
            for (int u = 0; u < U; ++u) {
                y[u][j].x = (y[u][j].x - s[u]) * q[u] * gg.x + bb.x; y[u][j].y = (y[u][j].y - s[u]) * q[u] * gg.y + bb.y;
                y[u][j].z = (y[u][j].z - s[u]) * q[u] * gg.z + bb.z; y[u][j].w = (y[u][j].w - s[u]) * q[u] * gg.w + bb.w;
                u32x2 w; w.x = pack2(y[u][j].x, y[u][j].y); w.y = pack2(y[u][j].z, y[u][j].w);
                *(u32x2*)(X1B + (size_t)(t0 + u) * 1024 + d0) = w;
            }
        }
        float lg[U][16];
#pragma unroll
        for (int e = 0; e < 16; ++e) {
#pragma unroll
            for (int u = 0; u < U; ++u) lg[u][e] = 0.f;
#pragma unroll
            for (int j = 0; j < 4; ++j) { const float4 w4 = *(const float4*)(wrL + e * 1024 + 256 * j + 4 * lane);
#pragma unroll
                for (int u = 0; u < U; ++u) lg[u][e] += y[u][j].x * w4.x + y[u][j].y * w4.y + y[u][j].z * w4.z + y[u][j].w * w4.w; }
        }
        float myl = 0.f;
#pragma unroll
        for (int u = 0; u < U; ++u) {
            float w8[8], z4[4];
#pragma unroll
            for (int e = 0; e < 8; ++e) { const u32x2 r = __builtin_amdgcn_permlane32_swap(__float_as_uint(lg[u][e]), __float_as_uint(lg[u][e + 8]), false, false); w8[e] = __uint_as_float(r.x) + __uint_as_float(r.y); }
#pragma unroll
            for (int e = 0; e < 4; ++e) { const u32x2 r = __builtin_amdgcn_permlane16_swap(__float_as_uint(w8[e]), __float_as_uint(w8[e + 4]), false, false); z4[e] = __uint_as_float(r.x) + __uint_as_float(r.y); }
            const bool h8 = (lane & 8) != 0, h4 = (lane & 4) != 0;
            const float k0 = h8 ? z4[2] : z4[0], s0 = h8 ? z4[0] : z4[2], k1 = h8 ? z4[3] : z4[1], s1 = h8 ? z4[1] : z4[3];
            const float y0 = k0 + __int_as_float(__builtin_amdgcn_mov_dpp(__float_as_int(s0), 0x128, 0xF, 0xF, true));
            const float y1 = k1 + __int_as_float(__builtin_amdgcn_mov_dpp(__float_as_int(s1), 0x128, 0xF, 0xF, true));
            const float k2 = h4 ? y1 : y0, s2 = h4 ? y0 : y1;
            float x = k2 + __int_as_float(__builtin_amdgcn_mov_dpp(__float_as_int(s2), 0x141, 0xF, 0xF, true));
            x += __int_as_float(__builtin_amdgcn_mov_dpp(__float_as_int(x), 0xB1, 0xF, 0xF, true));
            x += __int_as_float(__builtin_amdgcn_mov_dpp(__float_as_int(x), 0x4E, 0xF, 0xF, true));
            if ((lane & 3) == u) myl = x;
        }
        static_assert(U == 4, "lane (l & 3) stores token u = l & 3");
        lgL[(half * nloc + ((t0 - wv * U) / (nwave * U)) * (4 * U) + wid * U + (lane & 3)) * 17 + (lane >> 2)] = myl;
    }
    __syncthreads();
    if (half == 0 && wid == 0)
    for (int l0 = 0; l0 < 2 * nloc; l0 += 64) {
        const int li = l0 + lane; const bool act = li < 2 * nloc;
        const int hq = li >= nloc ? 1 : 0, lh = li - hq * nloc;
        const int it = lh / (4 * U), wq = (lh / U) & 3, uq = lh % U, tok = act ? (((blockIdx.x * 2 + hq) * 4 + wq) * U + uq) + it * (nwave * U) : 0;
        float lgv[16];
#pragma unroll
        for (int e = 0; e < 16; ++e) lgv[e] = lgL[li * 17 + e];
        float mx = lgv[0];
#pragma unroll
        for (int e = 1; e < 16; ++e) mx = fmaxf(mx, lgv[e]);
        float pr[16], ps = 0.f;
#pragma unroll
        for (int e = 0; e < 16; ++e) { pr[e] = expf(lgv[e] - mx); ps += pr[e]; }
        const float ips = 1.f / ps;
        float sel[16];
#pragma unroll
        for (int e = 0; e < 16; ++e) { pr[e] *= ips; sel[e] = pr[e] + p.router_bias[e]; }
        int best = 0; float bestv = -1e30f;
#pragma unroll
        for (int gI = 0; gI < 4; ++gI) {
            float a = -1e30f, b2 = -1e30f;
#pragma unroll
            for (int k = 0; k < 4; ++k) { const float x = sel[4 * gI + k]; if (x > a) { b2 = a; a = x; } else if (x > b2) b2 = x; }
            const float gs = a + b2;
            if (gs > bestv) { bestv = gs; best = gI; }
        }
        float s4[4], p4[4];
#pragma unroll
        for (int k = 0; k < 4; ++k) { s4[k] = 0.f; p4[k] = 0.f; }
#pragma unroll
        for (int gI = 0; gI < 4; ++gI) if (gI == best) {
#pragma unroll
            for (int k = 0; k < 4; ++k) { s4[k] = sel[4 * gI + k]; p4[k] = pr[4 * gI + k]; }
        }
        int i0 = 0; float a0 = s4[0];
#pragma unroll
        for (int k = 1; k < 4; ++k) if (s4[k] > a0) { a0 = s4[k]; i0 = k; }
        int i1 = -1; float a1 = -1e30f;
#pragma unroll
        for (int k = 0; k < 4; ++k) if (k != i0 && s4[k] > a1) { a1 = s4[k]; i1 = k; }
        float w0 = 0.f, w1 = 0.f;
#pragma unroll
        for (int k = 0; k < 4; ++k) { if (k == i0) w0 = p4[k]; if (k == i1) w1 = p4[k]; }
        const float iw = 1.f / (w0 + w1);
        const int e0 = act ? best * 4 + i0 : -1, e1 = act ? best * 4 + i1 : -1;
        unsigned myc = 0, r0 = 0, r1 = 0;
#pragma unroll
        for (int e = 0; e < 16; ++e) {
            const unsigned long long m0 = __builtin_amdgcn_ballot_w64(e0 == e), m1 = __builtin_amdgcn_ballot_w64(e1 == e);
            const unsigned c0 = (unsigned)__builtin_popcountll(m0), c = c0 + (unsigned)__builtin_popcountll(m1);
            if (lane == e) myc = c;
            if (e0 == e) r0 = __builtin_amdgcn_mbcnt_hi((unsigned)(m0 >> 32), __builtin_amdgcn_mbcnt_lo((unsigned)m0, 0u));
            if (e1 == e) r1 = c0 + __builtin_amdgcn_mbcnt_hi((unsigned)(m1 >> 32), __builtin_amdgcn_mbcnt_lo((unsigned)m1, 0u));
        }
        unsigned mybase = 0;
        if (lane < 16 && myc != 0) mybase = atomicAdd(&cnt[lane * 64], myc);
        unsigned b0 = 0, b1 = 0;
#pragma unroll
        for (int e = 0; e < 16; ++e) { const unsigned be = (unsigned)__builtin_amdgcn_readlane((int)mybase, e); if (e0 == e) b0 = be; if (e1 == e) b1 = be; }
        if (act) {
            LIST[(size_t)e0 * T_ + b0 + r0] = tok * 2; LIST[(size_t)e1 * T_ + b1 + r1] = tok * 2 + 1;
            WTS[tok * 2] = w0 * iw; WTS[tok * 2 + 1] = w1 * iw;
        }
    }
}

struct MoeUnit { int e, rt, ct, cnt, off; };
struct MoeOrderBase {
    const unsigned* cntp; int t_lo, t_hi, slot, per;
    __device__ __forceinline__ void init(const unsigned* cnt) {
        cntp = cnt; int ntile = 0;
#pragma unroll
        for (int k = 0; k < NE; ++k) ntile += (__builtin_amdgcn_readfirstlane((int)cnt[k * 64]) >> 8) * 4;
        t_lo = (ntile * (int)(blockIdx.x & 7)) >> 3; t_hi = (ntile * (int)((blockIdx.x & 7) + 1)) >> 3; slot = blockIdx.x >> 3; per = gridDim.x >> 3;
    }
    __device__ __forceinline__ bool next(int i, MoeUnit& u) const {
        const int t = t_lo + slot + i * per; if (t >= t_hi) return false;
        int base = 0, off = 0; bool found = false;
#pragma unroll
        for (int k = 0; k < NE; ++k) {
            const int ck = __builtin_amdgcn_readfirstlane((int)cntp[k * 64]), nt = (ck >> 8) * 4;
            if (!found && t < base + nt) { found = true; u.e = k; u.cnt = ck; u.off = off; u.rt = (t - base) >> 2; u.ct = (t - base) & 3; }
            base += nt; off += ck;
        }
        return found;
    }
};
struct M2Order : MoeOrderBase {
    typedef MoeUnit U; static constexpr bool GATHER = true;
    const int* list;
    __device__ __forceinline__ void ptrs(const MoeUnit& u, unsigned& A, unsigned& B) const { A = (unsigned)WS_X1B; B = (unsigned)WS_WG + ((unsigned)u.e * 1024u + (unsigned)u.ct * 256u) * 2048u; }
    __device__ __forceinline__ void rows(const MoeUnit& u, int tid, unsigned (&v)[2]) const {
        v[0] = 0u; v[1] = 0u;
#pragma unroll
        for (int i = 0; i < 2; ++i) { int R, C; pg8::stage_rc((tid + vzero()) * 16 + i * 8192, R, C);
#pragma unroll
            for (int h = 0; h < 2; ++h) { int idx = u.rt * 256 + 128 * h + R; idx = idx < u.cnt ? idx : u.cnt - 1; const int a = (list + (size_t)u.e * T_)[idx]; v[h] |= (unsigned)(a >> 1) << (16 * i); } }
    }
};
struct M3Order : MoeOrderBase {
    typedef MoeUnit U; static constexpr bool GATHER = false;
    __device__ __forceinline__ void ptrs(const MoeUnit& u, unsigned& A, unsigned& B) const { A = (unsigned)WS_HB + ((unsigned)u.off + (unsigned)u.rt * 256u) * 1024u; B = (unsigned)WS_WD + ((unsigned)u.e * 1024u + (unsigned)u.ct * 256u) * 1024u; }
};
struct M2Epi {
    static constexpr int MID_T = 0;
    unsigned char* ws;
    __device__ __forceinline__ void operator()(const f32x4 (&acc)[2][2][4][2], const MoeUnit& u, int wr, int wc, int fr, int fq) const {
        bf16_t* HB = (bf16_t*)(ws + WS_HB);
#pragma unroll
        for (int ai = 0; ai < 2; ++ai)
#pragma unroll
            for (int m = 0; m < 4; ++m) {
                const int idx = u.rt * 256 + 128 * ai + 64 * wr + 16 * m + fr + vzero();
                if (idx < u.cnt) {
#pragma unroll
                    for (int bj = 0; bj < 2; ++bj) {
                        const int hcol = 4 * (32 * u.ct + 16 * bj + 4 * wc + fq);
                        const f32x4 gv = acc[ai][bj][m][0], uv = acc[ai][bj][m][1]; f32x4 hv;
#pragma unroll
                        for (int r = 0; r < 4; ++r) hv[r] = gv[r] * fsig(gv[r]) * uv[r];
                        *(u32x2*)(HB + (size_t)(u.off + idx) * 512 + hcol) = pack4(hv);
                    }
                }
            }
    }
};
struct M3Epi {
    static constexpr int MID_T = 0;
    unsigned char* ws; const int* list;
    __device__ __forceinline__ void operator()(const f32x4 (&acc)[2][2][4][2], const MoeUnit& u, int wr, int wc, int fr, int fq) const {
        bf16_t* CT = (bf16_t*)(ws + WS_CT);
#pragma unroll
        for (int ai = 0; ai < 2; ++ai)
#pragma unroll
            for (int m = 0; m < 4; ++m) {
                const int idx = u.rt * 256 + 128 * ai + 64 * wr + 16 * m + fr + vzero();
                if (idx < u.cnt) {
                    const int a = list[(size_t)u.e * T_ + idx];
#pragma unroll
                    for (int bj = 0; bj < 2; ++bj) {
                        const int n = u.ct * 256 + 128 * bj + 32 * wc + 8 * fq;
                        const f32x4 v0 = acc[ai][bj][m][0], v1 = acc[ai][bj][m][1];
                        u32x4 w; w.x = pack2(v0[0], v0[1]); w.y = pack2(v0[2], v0[3]); w.z = pack2(v1[0], v1[1]); w.w = pack2(v1[2], v1[3]);
                        *(u32x4*)(CT + (size_t)a * 1024 + n) = w;
                    }
                }
            }
    }
};
template <int MODE>
__device__ __forceinline__ void moe_rem_item(unsigned char* ws, const int* list, int e, int cnt, int off, int rh, int c64, unsigned char* lds) {
    constexpr int K = MODE == 0 ? 1024 : 512, NS = K / 64;
    const int tid = (ltid() & 255), lane = tid & 63, wid = tid >> 6, wr = wid >> 1, wc = wid & 1, fr = lane & 15, fq = lane >> 4;
    const int idx0 = (cnt & ~255) + 128 * rh;
    const int ldc = ((lane & 7) ^ (lane >> 3)) * 8;
    const bf16_t* ap[4];
#pragma unroll
    for (int i = 0; i < 4; ++i) {
        int idx = idx0 + 32 * i + 8 * wid + (lane >> 3); idx = idx < cnt ? idx : cnt - 1;
        if (MODE == 0) { const int a = list[(size_t)e * T_ + idx]; ap[i] = (const bf16_t*)(ws + WS_X1B) + (size_t)(a >> 1) * 1024 + ldc; }
        else ap[i] = (const bf16_t*)(ws + WS_HB) + (size_t)(off + idx) * 512 + ldc;
    }
    const bf16_t* bp[2];
#pragma unroll
    for (int i = 0; i < 2; ++i) {
        const int rho = 8 * (wid + 4 * i) + (lane >> 3), src = (rho & ~31) + pg8::perm32(rho & 31);
        bp[i] = (const bf16_t*)(ws + (MODE == 0 ? WS_WG : WS_WD)) + ((size_t)e * 1024 + 64 * c64 + src) * K + ldc;
    }
    f32x4 acc[4][2];
#pragma unroll
    for (int i = 0; i < 4; ++i)
#pragma unroll
        for (int j = 0; j < 2; ++j) acc[i][j] = (f32x4){0.f, 0.f, 0.f, 0.f};
    __syncthreads();
#define RSTAGE(buf, l) do { unsigned char* st_ = lds + (buf) * 24576; \
        _Pragma("unroll") for (int i = 0; i < 4; ++i) glds16(ap[i] + (l) * 64, st_ + (4 * i + wid) * 1024); \
        _Pragma("unroll") for (int i = 0; i < 2; ++i) glds16(bp[i] + (l) * 64, st_ + 16384 + (wid + 4 * i) * 1024); } while (0)
    RSTAGE(0, 0); RSTAGE(1, 1);
    for (int l = 0; l < NS; ++l) {
        const unsigned char* st = lds + (l % 3) * 24576;
        if (l + 1 < NS) WAIT_V(6); else WAIT_V(0);
        RAW_BARRIER();
        if (l + 2 < NS) RSTAGE((l + 2) % 3, l + 2);
#pragma unroll
        for (int ks = 0; ks < 2; ++ks) {
            bf16x8 a[4], bb[2];
#pragma unroll
            for (int i = 0; i < 4; ++i) a[i] = lds_frag128(st, 64 * wr + 16 * i + fr, 4 * ks + fq);
#pragma unroll
            for (int j = 0; j < 2; ++j) bb[j] = lds_frag128(st + 16384, 32 * wc + 16 * j + fr, 4 * ks + fq);
#pragma unroll
            for (int i = 0; i < 4; ++i)
#pragma unroll
                for (int j = 0; j < 2; ++j) acc[i][j] = mfma16(bb[j], a[i], acc[i][j]);
        }
    }
#undef RSTAGE
#pragma unroll
    for (int i = 0; i < 4; ++i) {
        const int idx = idx0 + 64 * wr + 16 * i + fr + vzero();
        if (idx < cnt) {
            if (MODE == 0) {
                f32x4 hv;
#pragma unroll
                for (int r = 0; r < 4; ++r) hv[r] = acc[i][0][r] * fsig(acc[i][0][r]) * acc[i][1][r];
                *(u32x2*)((bf16_t*)(ws + WS_HB) + (size_t)(off + idx) * 512 + 32 * c64 + 16 * wc + 4 * fq) = pack4(hv);
            } else {
                const int a = list[(size_t)e * T_ + idx];
                const f32x4 v0 = acc[i][0], v1 = acc[i][1];
                u32x4 w; w.x = pack2(v0[0], v0[1]); w.y = pack2(v0[2], v0[3]); w.z = pack2(v1[0], v1[1]); w.w = pack2(v1[2], v1[3]);
                *(u32x4*)((bf16_t*)(ws + WS_CT) + (size_t)a * 1024 + 64 * c64 + 32 * wc + 8 * fq) = w;
            }
        }
    }
    __syncthreads();
}
template <int MODE>
__device__ __forceinline__ void moe_rem(const unsigned* cntp, unsigned char* ws, const int* list, unsigned char* ldsh, int half) {
    for (int t = blockIdx.x * 2 + half; ; t += gridDim.x * 2) {
        int base = 0, off = 0, e = -1, cnt = 0, eoff = 0, loc = 0;
#pragma unroll
        for (int k = 0; k < NE; ++k) {
            const int ck = __builtin_amdgcn_readfirstlane((int)cntp[k * 64]), ni = (((ck & 255) + 127) >> 7) * 16;
            if (e < 0 && t < base + ni) { e = k; cnt = ck; eoff = off; loc = t - base; }
            base += ni; off += ck;
        }
        if (e < 0) break;
        moe_rem_item<MODE>(ws, list, e, cnt, eoff, loc >> 4, loc & 15, ldsh);
    }
}
__device__ __forceinline__ void phase_m2(const Params& p, int layer, unsigned char* lds, unsigned char* ldsh, int half) {
    unsigned char* ws = launder(p.ws);
    M2Order S; S.init((const unsigned*)(ws + WS_CTL) + CW_CNT + layer * 1024 + vzero());
    S.list = (const int*)(ws + WS_LIST);
    M2Epi E; E.ws = ws;
    pg8::gemm_phase<M2Epi, M2Order>(lds, 1024, S, E, ltid(), ws);
    moe_rem<0>(S.cntp, ws, S.list, ldsh, half);
}
__device__ __forceinline__ void phase_m3(const Params& p, int layer, unsigned char* lds, unsigned char* ldsh, int half) {
    unsigned char* ws = launder(p.ws);
    M3Order S; S.init((const unsigned*)(ws + WS_CTL) + CW_CNT + layer * 1024 + vzero());
    M3Epi E; E.ws = ws; E.list = (const int*)(ws + WS_LIST);
    pg8::gemm_phase<M3Epi, M3Order>(lds, 512, S, E, ltid(), ws);
    moe_rem<1>(S.cntp, ws, E.list, ldsh, half);
}

__device__ __forceinline__ void phase_ln2(const Params& p, int layer, int half) {
    unsigned char* ws = launder(p.ws);
    const int tid = (ltid() & 255), lane = tid & 63, wid = tid >> 6;
    const bf16_t* X1 = (const bf16_t*)(ws + WS_X1B); const bf16_t* CT = (const bf16_t*)(ws + WS_CT); const float* WTS = (const float*)(ws + WS_WTS);
    float* XO = p.out; bf16_t* XB = (bf16_t*)(ws + WS_XB); const bool fin = layer == NLAYER - 1;
    const float* gam = p.ln2_g + layer * 1024; const float* bet = p.ln2_b + layer * 1024;
    constexpr int U = 4;
    const int nwave = (gridDim.x * 2) * 4, wv = (blockIdx.x * 2 + half) * 4 + wid;
    for (int t0 = wv * U; t0 < T_; t0 += nwave * U) {
        float4 v[U][4]; float s[U], q[U];
#pragma unroll
        for (int u = 0; u < U; ++u) {
            const int tok = t0 + u;
            const float w0 = WTS[tok * 2 + vzero()], w1 = WTS[tok * 2 + 1 + vzero()];
            s[u] = 0.f; q[u] = 0.f;
#pragma unroll
            for (int j = 0; j < 4; ++j) {
                const int d0 = 256 * j + 4 * lane;
                const f32x4 xt = unpack4(*(const u32x2*)(X1 + (size_t)tok * 1024 + d0)); float4 xv; xv.x = xt[0]; xv.y = xt[1]; xv.z = xt[2]; xv.w = xt[3];
                const f32x4 c0 = unpack4(*(const u32x2*)(CT + (size_t)(tok * 2) * 1024 + d0)), c1 = unpack4(*(const u32x2*)(CT + (size_t)(tok * 2 + 1) * 1024 + d0));
                v[u][j].x = xv.x * DN_ALPHA + w0 * c0[0] + w1 * c1[0]; v[u][j].y = xv.y * DN_ALPHA + w0 * c0[1] + w1 * c1[1];
                v[u][j].z = xv.z * DN_ALPHA + w0 * c0[2] + w1 * c1[2]; v[u][j].w = xv.w * DN_ALPHA + w0 * c0[3] + w1 * c1[3];
                s[u] += v[u][j].x + v[u][j].y + v[u][j].z + v[u][j].w;
                q[u] += v[u][j].x * v[u][j].x + v[u][j].y * v[u][j].y + v[u][j].z * v[u][j].z + v[u][j].w * v[u][j].w;
            }
        }
#pragma unroll
        for (int u = 0; u < U; ++u) { s[u] = wave_sum(s[u]); q[u] = wave_sum(q[u]); }
#pragma unroll
        for (int j = 0; j < 4; ++j) {
            const int d0 = 256 * j + 4 * lane;
            const float4 gg = *(const float4*)(gam + d0), bb = *(const float4*)(bet + d0);
#pragma unroll
            for (int u = 0; u < U; ++u) {
                const int tok = t0 + u;
                const float mu = s[u] * (1.f / 1024.f), var = fmaxf(q[u] * (1.f / 1024.f) - mu * mu, 0.f), rstd = rsqrtf(var + 1e-5f);
                float4 y; y.x = (v[u][j].x - mu) * rstd * gg.x + bb.x; y.y = (v[u][j].y - mu) * rstd * gg.y + bb.y; y.z = (v[u][j].z - mu) * rstd * gg.z + bb.z; y.w = (v[u][j].w - mu) * rstd * gg.w + bb.w;
                if (fin) *(float4*)(XO + (size_t)tok * 1024 + d0) = y;
                else { u32x2 w; w.x = pack2(y.x, y.y); w.y = pack2(y.z, y.w); *(u32x2*)(XB + (size_t)tok * 1024 + d0) = w; }
            }
        }
    }
}

#define XB_TMO      128
#define XB_XCNT(j)  (256  + 64 * (j))
#define XB_XSUB(j)  (1280 + 64 * (j))
#define XB_XGEN(j)  (2304 + 64 * (j))
#define XB_TOP      3328
#define XB_TOPGEN   3392
#define XCD_BAR_WORDS 3456
#define XB_SPIN_CAP (1u << 22)
#define LAS __attribute__((address_space(3)))
__device__ __forceinline__ unsigned xb_ld(unsigned* p)              { return __hip_atomic_load(p, __ATOMIC_RELAXED, __HIP_MEMORY_SCOPE_AGENT); }
__device__ __forceinline__ unsigned xb_add(unsigned* p, unsigned v) { return __hip_atomic_fetch_add(p, v, __ATOMIC_RELAXED, __HIP_MEMORY_SCOPE_AGENT); }
__device__ __forceinline__ unsigned xb_xcc_id() { return (unsigned)__builtin_amdgcn_s_getreg((3 << 11) | 20) & 0xFu; }
#define XB_SPIN(cond, bar) do { unsigned _sp = 0; while (cond) { __builtin_amdgcn_s_sleep(1); \
    if ((++_sp & 255u) == 0u) { if (xb_ld(&(bar)[XB_TMO])) break; if (_sp > XB_SPIN_CAP) { atomicAdd(&(bar)[XB_TMO], 1u); break; } } } } while (0)
struct XcdBarrier { unsigned* bar; unsigned x; volatile LAS unsigned* st; };
__device__ __forceinline__ XcdBarrier xcd_barrier_post(unsigned* bar, volatile LAS unsigned* st) {
    XcdBarrier b; b.bar = bar; b.x = xb_xcc_id(); b.st = st;
    if (threadIdx.x == 0) (void)xb_add(&bar[XB_XCNT(b.x)], 1u);
    return b;
}
__device__ __forceinline__ void xcd_barrier_complete(unsigned* bar, unsigned x, unsigned& nloc, unsigned& nx) {
    const unsigned G = gridDim.x * gridDim.y * gridDim.z;
    unsigned sum, cnt, mine, sp = 0u;
    for (;;) {
        sum = 0u; cnt = 0u; mine = 0u;
#pragma unroll
        for (unsigned j = 0; j < 16; ++j) { const unsigned c = xb_ld(&bar[XB_XCNT(j)]); sum += c; cnt += (c > 0u) ? 1u : 0u; mine = (j == x) ? c : mine; }
        if (sum == G) break;
        __builtin_amdgcn_s_sleep(1);
        if ((++sp & 255u) == 0u) { if (xb_ld(&bar[XB_TMO])) break; if (sp > XB_SPIN_CAP) { atomicAdd(&bar[XB_TMO], 1u); break; } }
    }
    nloc = mine > 0u ? mine : 1u; nx = cnt > 0u ? cnt : 1u;
}
__device__ __forceinline__ void xcd_barrier(const XcdBarrier& b) {
    asm volatile("s_waitcnt vmcnt(0)" ::: "memory");
    __syncthreads();
    if (threadIdx.x == 0) {
        unsigned* bar = b.bar;
        __builtin_amdgcn_s_waitcnt(0);
        unsigned nloc = b.st[0], nx = b.st[1];
        if (nloc == 0u) { xcd_barrier_complete(bar, b.x, nloc, nx); b.st[0] = nloc; b.st[1] = nx; }
        const unsigned old = xb_add(&bar[XB_XSUB(b.x)], 1u);
        const unsigned gen = old / nloc;
        if (old + 1u == (gen + 1u) * nloc) {
            __builtin_amdgcn_fence(__ATOMIC_RELEASE, "agent");
            asm volatile("s_waitcnt vmcnt(0)" ::: "memory");
            const unsigned og = xb_add(&bar[XB_TOP], 1u);
            const unsigned tg = og / nx;
            if (og + 1u == (tg + 1u) * nx) xb_add(&bar[XB_TOPGEN], 1u);
            else XB_SPIN(xb_ld(&bar[XB_TOPGEN]) == tg, bar);
            __builtin_amdgcn_fence(__ATOMIC_ACQUIRE, "agent");
            xb_add(&bar[XB_XGEN(b.x)], 1u);
            asm volatile("s_waitcnt vmcnt(0)" ::: "memory");
        } else {
            XB_SPIN(xb_ld(&bar[XB_XGEN(b.x)]) == gen, bar);
            __builtin_amdgcn_fence(__ATOMIC_ACQUIRE, "agent");
            asm volatile("s_waitcnt vmcnt(0)" ::: "memory");
        }
    }
    __syncthreads();
}

constexpr int PH_PER_LAYER = 11, N_PHASES = PH_PER_LAYER * NLAYER;
__global__ void __launch_bounds__(NTHREADS, 2) mega(Params p) {
    extern __shared__ __attribute__((aligned(16))) unsigned char lds[];
#if SINGLE_LAUNCH
    volatile LAS unsigned* xbw = (volatile LAS unsigned*)(lds + LDS_BYTES - 16);
    if (threadIdx.x < 4) xbw[threadIdx.x] = 0u;
    __syncthreads();
    XcdBarrier xbar = xcd_barrier_post((unsigned*)(p.ws + WS_CTL) + CW_BAR, xbw);
#endif
    const int half = __builtin_amdgcn_readfirstlane((int)(threadIdx.x >> 8));
    unsigned char* ldsh = lds + half * HALF_LDS;
    bool second = false;
    for (int ph = p.ph_lo; ph < p.ph_hi; ++ph) {
        const int layer = ph / PH_PER_LAYER, k = ph % PH_PER_LAYER;
        if (k == 0 && layer > 0) continue;
#ifdef ONLY_PHASE
        if (k != ONLY_PHASE) continue;
#endif
        switch (k) {
            case 0: phase_pw(p, layer, ldsh, 1 | 16 | 8, half); break;
            case 1: phase_g1(p, layer, lds); break;
            case 2: phase_p2(p, layer, ldsh, half); if (!second && layer + 1 < NLAYER) { __syncthreads(); phase_pw(p, layer + 1, ldsh, 1, half, 64); } break;
            case 3: phase_p3(p, ldsh, half, second ? ((p.rep_mask >> 16) & 7) : 7); if (!second && layer + 1 < NLAYER) { __syncthreads(); phase_pw(p, layer + 1, ldsh, 16, half); }
                    if (!second && layer == 0) { __syncthreads(); phase_pw(p, 0, ldsh, 2, half); } break;
            case 4: { const int sub = second ? ((p.rep_mask >> 12) & 7) : 7;
                    if (sub & 1) phase_p4_sel(p, lds);
                    if ((sub & 4) && half == 0) { phase_pw(p, layer, ldsh, 4, half); __syncthreads(); }
                    if (sub & 2) phase_p4(p, ldsh, half);
                    if ((sub & 4) && half == 1) { __syncthreads(); phase_pw(p, layer, ldsh, 4, half); } } break;
            case 5: phase_g2(p, lds); break;
            case 6: phase_g3(p, layer, lds); break;
            case 7: phase_ln1(p, layer, ldsh, ((p.rep_mask >> 7) & 1) && !second, half); if (!second && layer + 1 < NLAYER) { __syncthreads(); phase_pw(p, layer + 1, ldsh, 2, half); } break;
            case 8: phase_m2(p, layer, lds, ldsh, half); break;
            case 9: phase_m3(p, layer, lds, ldsh, half); break;
            case 10: phase_ln2(p, layer, half); break;
        }

        if (ph + 1 < p.ph_hi) { if (ph == p.ph_lo && !second) cg::this_grid().sync(); else xcd_barrier(xbar); }
        if (((p.rep_mask >> k) & 1) && !second) { second = true; --ph; } else second = false;
    }
}

extern "C" void kernel_launch(void* const* d_in, const int* in_sizes, int n_in, void* d_out, int out_size, void* d_ws, size_t ws_size, hipStream_t stream) {
    static int grid = 0;
    if (grid == 0) {
        if (n_in != 18 || ws_size < WS_END) { fprintf(stderr, "kernel_launch: unexpected n_in %d or ws_size %zu < %zu\n", n_in, ws_size, (size_t)WS_END); grid = -1; return; }
        int dev = 0, cus = 0, per_cu = 0;
        hipGetDevice(&dev); hipDeviceGetAttribute(&cus, hipDeviceAttributeMultiprocessorCount, dev);
        hipFuncSetAttribute((const void*)mega, hipFuncAttributeMaxDynamicSharedMemorySize, LDS_BYTES);
        hipOccupancyMaxActiveBlocksPerMultiprocessor(&per_cu, (const void*)mega, NTHREADS, LDS_BYTES);
        if (per_cu < 1) per_cu = 1;
        if (per_cu > 1) per_cu = 1;
        grid = cus * per_cu;
        (void)hipGetLastError();
    }
    if (grid < 0) return;
    Params p{};
    p.x = (const float*)d_in[0]; p.w_in = (const float*)d_in[1]; p.cmp_pos = (const float*)d_in[2]; p.cmp_w1 = (const float*)d_in[3]; p.cmp_w2 = (const float*)d_in[4];
    p.w_br_a = (const float*)d_in[5]; p.w_br_b = (const float*)d_in[6]; p.w_o = (const float*)d_in[7]; p.ln1_g = (const float*)d_in[8]; p.ln1_b = (const float*)d_in[9];
    p.w_router = (const float*)d_in[10]; p.router_bias = (const float*)d_in[11]; p.w_gate = (const float*)d_in[12]; p.w_up = (const float*)d_in[13]; p.w_down = (const float*)d_in[14];
    p.ln2_g = (const float*)d_in[15]; p.ln2_b = (const float*)d_in[16]; p.rel_bias = (const float*)d_in[17];
    p.out = (float*)d_out; p.ws = (unsigned char*)d_ws; p.rep_mask = REPEAT_MASK;
#if SINGLE_LAUNCH
    hipMemsetAsync((unsigned char*)d_ws + WS_CTL + (size_t)CW_BAR * 4, 0, XCD_BAR_WORDS * 4, stream);
    p.ph_lo = 0; p.ph_hi = N_PHASES;
    void* args[] = {&p};
    hipError_t e = hipLaunchCooperativeKernel((const void*)mega, dim3(grid), dim3(NTHREADS), args, LDS_BYTES, stream);
    if (e != hipSuccess) fprintf(stderr, "cooperative launch failed: %s (grid %d)\n", hipGetErrorString(e), grid);
#else
    for (int ph = 0; ph < N_PHASES; ++ph) {
        p.ph_lo = ph; p.ph_hi = ph + 1;
        hipLaunchKernelGGL(mega, dim3(grid), dim3(NTHREADS), LDS_BYTES, stream, p);
    }
#endif
}
```

```cpp
#include <hip/hip_runtime.h>
#include <hip/hip_cooperative_groups.h>
#include <cstdio>
#include <cstdint>
namespace cg = cooperative_groups;

#ifndef REPEAT_MASK
#define REPEAT_MASK 0
#endif
#ifndef SINGLE_LAUNCH
#define SINGLE_LAUNCH 1
#endif

typedef unsigned short bf16_t;
typedef short bf16x8 __attribute__((ext_vector_type(8)));
typedef float f32x4 __attribute__((ext_vector_type(4)));
typedef unsigned u32x2 __attribute__((ext_vector_type(2)));
typedef unsigned u32x4 __attribute__((ext_vector_type(4)));

constexpr int B_ = 2, S_ = 8192, D_ = 1024, T_ = B_ * S_, NLAYER = 4;
constexpr int DIN = 6424;
constexpr int LD = 5376;
constexpr int NW = 6656;
constexpr int C_QA = 0, C_KC = 512, C_VC = 640, C_KS = 768, C_KW = 896, C_QR = 1024, C_KR = 1536, C_GR = 2048, C_MA = 3072, C_MB = 4096, C_GA = 5120,
              C_VS = 5376, C_VW = 5504, C_VR = 5632;
constexpr float DN_ALPHA = 1.681792830507429f;
constexpr int NE = 16;

constexpr size_t al256(size_t x) { return (x + 255) & ~(size_t)255; }
constexpr size_t WS_CTL = 0;
constexpr size_t WS_BUCKET = 65536;
constexpr size_t WS_ROPE = WS_BUCKET + 8192;
constexpr size_t WS_WIN = WS_ROPE + (size_t)8192 * 32 * 8;
constexpr size_t WS_WA = WS_WIN + (size_t)NW * 1024 * 2;
constexpr size_t WS_WB = WS_WA + (size_t)1024 * 512 * 2;
constexpr size_t WS_WO = WS_WB + (size_t)1024 * 1024 * 2;
constexpr size_t WS_WG = WS_WO + (size_t)1024 * 1024 * 2;
constexpr size_t WS_WU = WS_WG + (size_t)16 * 512 * 1024 * 2;
constexpr size_t WS_WD = WS_WU + (size_t)16 * 512 * 1024 * 2;
constexpr size_t WS_XB = WS_WD + (size_t)16 * 512 * 1024 * 2;
constexpr size_t WS_X = WS_XB + (size_t)T_ * 1024 * 2;
constexpr size_t WS_MG = WS_X + (size_t)T_ * 1024 * 4;
constexpr size_t WS_KCC = WS_MG + (size_t)T_ * 1024 * 2;
constexpr size_t WS_VCCT = WS_KCC + (size_t)4 * 512 * 64 * 2;
constexpr size_t WS_W1T = WS_VCCT + (size_t)4 * 512 * 64 * 2;
constexpr size_t WS_B1 = WS_W1T + (size_t)2 * 64 * 2048 * 2;
constexpr size_t WS_R = WS_B1 + 1024;
constexpr size_t WS_P = WS_R;
constexpr size_t WS_VST = WS_P + (size_t)T_ * LD * 2;
constexpr size_t WS_VWT = WS_VST + (size_t)4 * 64 * S_ * 2;
constexpr size_t WS_VRT = WS_VWT + (size_t)4 * 64 * S_ * 2;
constexpr size_t WS_KVT = WS_VRT + (size_t)16 * 128 * S_ * 2;
constexpr size_t WS_SPT = WS_KVT + (size_t)16 * 64 * 8192 * 4;
constexpr size_t WS_YC = WS_SPT + (size_t)16 * 64 * 8192 * 2;
constexpr size_t WS_YW = WS_YC + (size_t)T_ * 512 * 2;
constexpr size_t WS_YA = WS_YW + (size_t)T_ * 512 * 2;
constexpr size_t WS_YB = WS_YA + (size_t)T_ * 512 * 2;
constexpr size_t WS_SELW = WS_YB + (size_t)T_ * 1024 * 2;
constexpr size_t WS_ENDA = WS_SELW + (size_t)T_ * 2 * 4 * 4;
constexpr size_t WS_H1 = WS_R;
constexpr size_t WS_X1 = WS_H1 + (size_t)T_ * 1024 * 4;
constexpr size_t WS_X1B = WS_X1 + (size_t)T_ * 1024 * 4;
constexpr size_t WS_HB = WS_X1B + (size_t)T_ * 1024 * 2;
constexpr size_t WS_CT = WS_HB + (size_t)2 * T_ * 512 * 2;
constexpr size_t WS_LIST = WS_CT + (size_t)2 * T_ * 1024 * 2;
constexpr size_t WS_WTS = WS_LIST + (size_t)16 * T_ * 4;
constexpr size_t WS_ENDB = WS_WTS + (size_t)2 * T_ * 4;
static_assert(WS_HB + (size_t)2 * T_ * 512 * 2 <= WS_CT, "view B overlap");
constexpr size_t WS_END = WS_ENDA > WS_ENDB ? WS_ENDA : WS_ENDB;

constexpr int CW_CNT = 4096;
constexpr int CW_BAR = 8192;
constexpr int CW_B1P = 12288;

constexpr int HALF_LDS = 75776, LDS_BYTES = 2 * HALF_LDS + 16;
constexpr int NTHREADS = 512, HT = 256;

struct Params {
    const float* x; const float* w_in; const float* cmp_pos; const float* cmp_w1; const float* cmp_w2;
    const float* w_br_a; const float* w_br_b; const float* w_o; const float* ln1_g; const float* ln1_b;
    const float* w_router; const float* router_bias; const float* w_gate; const float* w_up; const float* w_down;
    const float* ln2_g; const float* ln2_b; const float* rel_bias;
    float* out; unsigned char* ws;
    int ph_lo, ph_hi, rep_mask, pad_;
};

__device__ __forceinline__ bf16_t f2bf(float f) { unsigned u = __float_as_uint(f); u += 0x7fffu + ((u >> 16) & 1u); return (bf16_t)(u >> 16); }
__device__ __forceinline__ float bf2f(unsigned h) { return __uint_as_float(h << 16); }
typedef __bf16 bf16x2_t __attribute__((ext_vector_type(2)));
typedef float f32x2_t __attribute__((ext_vector_type(2)));
__device__ __forceinline__ unsigned pack2(float lo, float hi) { const f32x2_t f = {lo, hi}; return __builtin_bit_cast(unsigned, __builtin_convertvector(f, bf16x2_t)); }
__device__ __forceinline__ u32x2 pack4(f32x4 v) { u32x2 r; r.x = pack2(v[0], v[1]); r.y = pack2(v[2], v[3]); return r; }
__device__ __forceinline__ f32x4 unpack4(u32x2 u) { f32x4 r; r[0] = bf2f(u.x & 0xffffu); r[1] = bf2f(u.x >> 16); r[2] = bf2f(u.y & 0xffffu); r[3] = bf2f(u.y >> 16); return r; }
__device__ __forceinline__ float rows_max(float v) {
    u32x2 r = __builtin_amdgcn_permlane16_swap(__float_as_uint(v), __float_as_uint(v), false, false);
    v = fmaxf(__uint_as_float(r.x), __uint_as_float(r.y));
    r = __builtin_amdgcn_permlane32_swap(__float_as_uint(v), __float_as_uint(v), false, false);
    return fmaxf(__uint_as_float(r.x), __uint_as_float(r.y));
}
__device__ __forceinline__ float rows_sum(float v) {
    u32x2 r = __builtin_amdgcn_permlane16_swap(__float_as_uint(v), __float_as_uint(v), false, false);
    v = __uint_as_float(r.x) + __uint_as_float(r.y);
    r = __builtin_amdgcn_permlane32_swap(__float_as_uint(v), __float_as_uint(v), false, false);
    return __uint_as_float(r.x) + __uint_as_float(r.y);
}
__device__ __forceinline__ float wave_sum(float v) {
    v += __int_as_float(__builtin_amdgcn_mov_dpp(__float_as_int(v), 0xB1, 0xF, 0xF, true));
    v += __int_as_float(__builtin_amdgcn_mov_dpp(__float_as_int(v), 0x4E, 0xF, 0xF, true));
    v += __int_as_float(__builtin_amdgcn_mov_dpp(__float_as_int(v), 0x141, 0xF, 0xF, true));
    v += __int_as_float(__builtin_amdgcn_mov_dpp(__float_as_int(v), 0x140, 0xF, 0xF, true));
    return rows_sum(v);
}
__device__ __forceinline__ float sigmoidf_(float x) { return 1.f / (1.f + __expf(-x)); }
__device__ __forceinline__ int ltid() { int t = threadIdx.x; asm volatile("" : "+v"(t)); return t; }
__device__ __forceinline__ int vzero() { int z; asm volatile("v_mov_b32 %0, 0" : "=v"(z)); return z; }
__device__ __forceinline__ unsigned char* launder(unsigned char* q) { asm volatile("" : "+s"(q)); return q; }
__device__ __forceinline__ void wait_vm0() { asm volatile("s_waitcnt vmcnt(0)" ::: "memory"); }

__device__ __forceinline__ void glds16(const void* g, void* l) {
    __builtin_amdgcn_global_load_lds((const __attribute__((address_space(1))) unsigned*)g,
                                     (__attribute__((address_space(3))) unsigned*)l, 16, 0, 0);
}
__device__ __forceinline__ f32x4 mfma16(bf16x8 a, bf16x8 b, f32x4 c) { return __builtin_amdgcn_mfma_f32_16x16x32_bf16(a, b, c, 0, 0, 0); }

#define WAIT_V(n) asm volatile("s_waitcnt vmcnt(%0)" ::"n"(n) : "memory")
#define RAW_BARRIER() do { asm volatile("s_waitcnt lgkmcnt(0)" ::: "memory"); __builtin_amdgcn_s_barrier(); } while (0)
__device__ __forceinline__ void bglds16(__amdgpu_buffer_rsrc_t r, unsigned voff, int soff, void* l) {
    __builtin_amdgcn_raw_ptr_buffer_load_lds(r, (__attribute__((address_space(3))) void*)l, 16, (int)voff, soff, 0, 0);
}
template <int NJ, bool GN>
__device__ __forceinline__ void gemm8_stage(__amdgpu_buffer_rsrc_t mr, int mld, unsigned mvo, __amdgpu_buffer_rsrc_t nr, int nld, const unsigned (&nvo)[NJ], int kt, unsigned char* st, int wid) {
#pragma unroll
    for (int i = 0; i < 4; ++i) bglds16(mr, mvo, (64 * i * mld + kt * 64) * 2, st + (8 * i + wid) * 1024);
#pragma unroll
    for (int i = 0; i < NJ; ++i) bglds16(nr, nvo[i], ((GN ? 0 : 64 * i * nld) + kt * 64) * 2, st + 32768 + (8 * i + wid) * 1024);
}
template <int NJ, bool GN>
__device__ __forceinline__ void gemm8_kloop(const bf16_t* mb, int mld, unsigned mvo, const bf16_t* nb, int nld, const unsigned (&nvo)[NJ], int nk, unsigned char* lds, f32x4 (&acc)[8][NJ], int tid) {
    const int lane = tid & 63, wid = tid >> 6, wr = wid >> 2, wc = wid & 3, fr = lane & 15, fq = lane >> 4;
    const __amdgpu_buffer_rsrc_t mr = __builtin_amdgcn_make_buffer_rsrc((void*)mb, 0, 0x7fffffff, 0x00020000);
    const __amdgpu_buffer_rsrc_t nr = __builtin_amdgcn_make_buffer_rsrc((void*)nb, 0, 0x7fffffff, 0x00020000);
    gemm8_stage<NJ, GN>(mr, mld, mvo, nr, nld, nvo, 0, lds, wid);
    gemm8_stage<NJ, GN>(mr, mld, mvo, nr, nld, nvo, 1, lds + 65536, wid);
    for (int kt = 0; kt < nk; ++kt) {
        unsigned char* cur = lds + (kt & 1) * 65536;
        if (kt + 1 < nk) WAIT_V(4 + NJ); else WAIT_V(0);
        RAW_BARRIER();
        bf16x8 a[4], b[NJ];
        const unsigned char* ab = cur + (128 * wr + fr) * 128;
        const unsigned char* bb = cur + 32768 + (16 * NJ * wc + fr) * 128;
        const int sw0 = ((fq) ^ (fr & 7)) << 4, sw1 = ((4 + fq) ^ (fr & 7)) << 4;
#pragma unroll
        for (int j = 0; j < NJ; ++j) b[j] = *(const bf16x8*)(bb + j * 2048 + sw0);
#pragma unroll
        for (int mh = 0; mh < 2; ++mh) {
#pragma unroll
            for (int i = 0; i < 4; ++i) a[i] = *(const bf16x8*)(ab + (4 * mh + i) * 2048 + sw0);
#pragma unroll
            for (int i = 0; i < 4; ++i)
#pragma unroll
                for (int j = 0; j < NJ; ++j) acc[4 * mh + i][j] = mfma16(a[i], b[j], acc[4 * mh + i][j]);
        }
#pragma unroll
        for (int j = 0; j < NJ; ++j) b[j] = *(const bf16x8*)(bb + j * 2048 + sw1);
#pragma unroll
        for (int i = 0; i < 4; ++i) a[i] = *(const bf16x8*)(ab + i * 2048 + sw1);
#pragma unroll
        for (int i = 0; i < 4; ++i)
#pragma unroll
            for (int j = 0; j < NJ; ++j) acc[i][j] = mfma16(a[i], b[j], acc[i][j]);
#pragma unroll
        for (int i = 0; i < 4; ++i) a[i] = *(const bf16x8*)(ab + (4 + i) * 2048 + sw1);
        RAW_BARRIER();
        if (kt + 2 < nk) gemm8_stage<NJ, GN>(mr, mld, mvo, nr, nld, nvo, kt + 2, cur, wid);
#pragma unroll
        for (int i = 0; i < 4; ++i)
#pragma unroll
            for (int j = 0; j < NJ; ++j) acc[4 + i][j] = mfma16(a[i], b[j], acc[4 + i][j]);
    }
    __syncthreads();
    __builtin_amdgcn_sched_barrier(0);
}
template <int NJ>
__device__ __forceinline__ void zero_acc8(f32x4 (&acc)[8][NJ]) {
#pragma unroll
    for (int i = 0; i < 8; ++i)
#pragma unroll
        for (int j = 0; j < NJ; ++j) acc[i][j] = (f32x4){0.f, 0.f, 0.f, 0.f};
}

namespace pg8 {
#define PG8_LAS __attribute__((address_space(3)))
constexpr int BM = 256, BK = 64, HALF = 128, HTB = HALF * BK * 2, STAGE_BYTES = 8 * HTB;
__device__ __forceinline__ int lds_byte(int r, int c) { const int st = (r >> 4) * 2 + (c >> 5), rr = r & 15, cc = c & 31, ob = rr * 64 + cc * 2; return st * 1024 + (ob ^ (((ob >> 9) & 1) << 5)); }
__device__ __forceinline__ void stage_rc(int b, int& R, int& C) { const int st = b / 1024, sb = b % 1024, swz = sb ^ (((sb >> 9) & 1) << 5); R = (st >> 1) * 16 + swz / 64; C = (st & 1) * 32 + (swz % 64) / 2; }
__device__ __forceinline__ int perm32(int rho) { const int n = rho >> 4, i = rho & 15; return 8 * (i >> 2) + 4 * n + (i & 3); }
struct Unit { int pm, pn; };
template <class Epi, class Sched>
__device__ __forceinline__ void gemm_phase(unsigned char* lds_, const int K, const Sched& S, const Epi& E, const int tid, const unsigned char* wsbase) {
    PG8_LAS unsigned char* lds = (PG8_LAS unsigned char*)lds_;
    const int wid = __builtin_amdgcn_readfirstlane(tid >> 6), lane = tid & 63, wr = wid >> 2, wc = wid & 3, fr = lane & 15, fq = lane >> 4;
    const int nt = K / BK;
    unsigned voffA[2], voffB[2];
#pragma unroll
    for (int i = 0; i < 2; ++i) { int R, C; stage_rc(tid * 16 + i * 8192, R, C); const int Rb = (R & ~31) + perm32(R & 31);
        voffA[i] = (unsigned)(R * K + C) * 2u; voffB[i] = (unsigned)(Rb * K + C) * 2u; }
    const unsigned kstep = (unsigned)(BK * 2);
    const unsigned hstep = (unsigned)HALF * K * 2;
    const __amdgpu_buffer_rsrc_t rsrc = __builtin_amdgcn_make_buffer_rsrc((void*)wsbase, 0, 0x7fffffff, 0x00020000);
    const unsigned ldsw = (unsigned)wid * 1024u;
    const int aoff = lds_byte(wr * 64 + fr, fq * 8), boff = lds_byte(wc * 32 + fr, fq * 8);
#define PG8_SA(b, h) (((b) * 2 + (h)) * HTB)
#define PG8_SB(b, h) ((4 + (b) * 2 + (h)) * HTB)
#define PG8_STAGE(bufoff, gbase, voff) do { _Pragma("unroll") for (int _i = 0; _i < 2; ++_i) \
        __builtin_amdgcn_raw_ptr_buffer_load_lds(rsrc, (PG8_LAS void*)(lds + (bufoff) + ldsw + _i * 8192), 16, (int)(voff)[_i], (int)(gbase), 0, 0); } while (0)
#define PG8_LDA(dst, b, h) do { _Pragma("unroll") for (int m = 0; m < 4; ++m) _Pragma("unroll") for (int k = 0; k < 2; ++k) dst[m][k] = *(const PG8_LAS bf16x8*)(lds + PG8_SA(b, h) + aoff + m * 2048 + k * 1024); } while (0)
#define PG8_LDB(dst, b, h) do { _Pragma("unroll") for (int n = 0; n < 2; ++n) _Pragma("unroll") for (int k = 0; k < 2; ++k) dst[n][k] = *(const PG8_LAS bf16x8*)(lds + PG8_SB(b, h) + boff + n * 2048 + k * 1024); } while (0)
#define PG8_MMA(ai, bj, At, Bt) do { __builtin_amdgcn_s_setprio(1); _Pragma("unroll") for (int m = 0; m < 4; ++m) _Pragma("unroll") for (int n = 0; n < 2; ++n) _Pragma("unroll") for (int k = 0; k < 2; ++k) \
        acc[ai][bj][m][n] = __builtin_amdgcn_mfma_f32_16x16x32_bf16(Bt[n][k], At[m][k], acc[ai][bj][m][n], 0, 0, 0); __builtin_amdgcn_s_setprio(0); } while (0)
#define PG8_WAIT_V(n) asm volatile("s_waitcnt vmcnt(" #n ")" ::: "memory")
#define PG8_WAIT_L(n) asm volatile("s_waitcnt lgkmcnt(" #n ")" ::: "memory")
#define PG8_BAR __builtin_amdgcn_s_barrier()
#define PG8_SCHED __builtin_amdgcn_sched_barrier(0)
    typename Sched::U cur, nxt; int ui = 0;
    if (!S.next(0, cur)) return;
    unsigned cA, cB; S.ptrs(cur, cA, cB);
    constexpr bool GA = Sched::GATHER;
    unsigned vA[2], nvA[2];
    if constexpr (GA) { S.rows(cur, tid, vA); nvA[0] = vA[0]; nvA[1] = vA[1]; }
#define PG8_STAGE_G(bufoff, gbase, pk) do { const unsigned _cb = voffB[0] & (unsigned)(2 * K - 1); unsigned _vo[2] = {(((pk) & 0xffffu) * (unsigned)(2 * K)) + _cb, (((pk) >> 16) * (unsigned)(2 * K)) + _cb}; PG8_STAGE(bufoff, gbase, _vo); } while (0)
#define PG8_STAGE_A(bufoff, gbase, h, nextu) do { if constexpr (GA) { if (nextu) PG8_STAGE_G(bufoff, gbase, nvA[h]); else PG8_STAGE_G(bufoff, gbase, vA[h]); } \
        else PG8_STAGE(bufoff, (gbase) + (h) * hstep, voffA); } while (0)
    PG8_STAGE(PG8_SB(0, 0), cB, voffB); PG8_STAGE_A(PG8_SA(0, 0), cA, 0, false); PG8_STAGE(PG8_SB(0, 1), cB + hstep, voffB); PG8_STAGE_A(PG8_SA(0, 1), cA, 1, false);
    if (wr == 1) PG8_BAR;
    PG8_WAIT_V(4); PG8_BAR;
    PG8_STAGE(PG8_SB(1, 0), cB + kstep, voffB); PG8_STAGE_A(PG8_SA(1, 0), cA + kstep, 0, false); PG8_STAGE(PG8_SB(1, 1), cB + hstep + kstep, voffB);
    PG8_WAIT_V(6); PG8_BAR;
    PG8_SCHED;
    f32x4 acc[2][2][4][2];
#pragma unroll
    for (int a = 0; a < 2; ++a)
#pragma unroll
        for (int b = 0; b < 2; ++b)
#pragma unroll
            for (int m = 0; m < 4; ++m)
#pragma unroll
                for (int n = 0; n < 2; ++n) acc[a][b][m][n] = (f32x4){0.f, 0.f, 0.f, 0.f};
    bf16x8 At[4][2], B0[2][2], B1[2][2];
    for (;;) {
        const bool has_next = S.next(ui + 1, nxt);
        unsigned nA = cA, nB = cB; if (has_next) S.ptrs(nxt, nA, nB);
        if constexpr (GA) { if (has_next) S.rows(nxt, tid, nvA); }
        for (int t = 0; t < nt; t += 2) {
            if constexpr (Epi::MID_T > 0) { if (t == Epi::MID_T) E.mid(acc, cur, wr, wc, fr, fq); }
            const bool last = (t == nt - 2);
            const unsigned a1 = cA + (unsigned)(t + 1) * kstep;
            const unsigned a2 = last ? nA : cA + (unsigned)(t + 2) * kstep, b2 = last ? nB : cB + (unsigned)(t + 2) * kstep;
            const unsigned a3 = a2 + kstep, b3 = b2 + kstep;
            PG8_LDB(B0, 0, 0); PG8_SCHED; PG8_LDA(At, 0, 0); PG8_STAGE_A(PG8_SA(1, 1), a1, 1, false);
            PG8_WAIT_L(8); PG8_BAR; PG8_WAIT_L(0); PG8_MMA(0, 0, At, B0); PG8_BAR; PG8_SCHED;
            PG8_LDB(B1, 0, 1); PG8_STAGE(PG8_SB(0, 0), b2, voffB);
            PG8_BAR; PG8_WAIT_L(0); PG8_MMA(0, 1, At, B1); PG8_BAR;
            PG8_LDA(At, 0, 1); PG8_STAGE_A(PG8_SA(0, 0), a2, 0, last);
            PG8_BAR; PG8_WAIT_L(0); PG8_MMA(1, 0, At, B0); PG8_BAR; PG8_SCHED;
            PG8_STAGE(PG8_SB(0, 1), b2 + hstep, voffB);
            PG8_WAIT_V(6); PG8_BAR; PG8_MMA(1, 1, At, B1); PG8_BAR;
            PG8_LDB(B0, 1, 0); PG8_SCHED; PG8_LDA(At, 1, 0); PG8_STAGE_A(PG8_SA(0, 1), a2, 1, last);
            PG8_WAIT_L(8); PG8_BAR; PG8_WAIT_L(0); PG8_MMA(0, 0, At, B0); PG8_BAR; PG8_SCHED;
            PG8_LDB(B1, 1, 1); PG8_STAGE(PG8_SB(1, 0), b3, voffB);
            PG8_BAR; PG8_WAIT_L(0); PG8_MMA(0, 1, At, B1); PG8_BAR;
            PG8_LDA(At, 1, 1); PG8_STAGE_A(PG8_SA(1, 0), a3, 0, last);
            PG8_BAR; PG8_WAIT_L(0); PG8_MMA(1, 0, At, B0); PG8_BAR; PG8_SCHED;
            PG8_STAGE(PG8_SB(1, 1), b3 + hstep, voffB);
            PG8_WAIT_V(6); PG8_BAR; PG8_MMA(1, 1, At, B1); PG8_BAR;
        }
        E(acc, cur, wr, wc, fr, fq);
        if (!has_next) break;
#pragma unroll
        for (int a = 0; a < 2; ++a)
#pragma unroll
            for (int b = 0; b < 2; ++b)
#pragma unroll
                for (int m = 0; m < 4; ++m)
#pragma unroll
                    for (int n = 0; n < 2; ++n) acc[a][b][m][n] = (f32x4){0.f, 0.f, 0.f, 0.f};
        cur = nxt; cA = nA; cB = nB; ++ui;
        if constexpr (GA) { vA[0] = nvA[0]; vA[1] = nvA[1]; }
    }
    PG8_WAIT_V(0);
    if (wr == 0) PG8_BAR;
    PG8_BAR;
#undef PG8_SA
#undef PG8_SB
#undef PG8_STAGE
#undef PG8_STAGE_A
#undef PG8_STAGE_G
#undef PG8_LDA
#undef PG8_LDB
#undef PG8_MMA
#undef PG8_WAIT_V
#undef PG8_WAIT_L
#undef PG8_BAR
#undef PG8_SCHED
}
}

struct TJob { const float* src; bf16_t* dst; int ld, k0, n0, mode, kdst; };
__device__ __forceinline__ void tcvt_load(const TJob& J, float4 (&v)[4], int tid) {
#pragma unroll
    for (int i = 0; i < 4; ++i) {
        const int kk = (tid >> 4) + 16 * i, c4 = (tid & 15) * 4, cd = J.n0 + c4;
        int orig = cd; bool ok = true;
        if (J.mode == 1) {
            if (cd < 896) orig = cd;
            else if (cd < 1024) orig = cd - 896 + 1024;
            else if (cd < 2048) { const int q = cd - 1024, hd = q >> 6, pp = q & 63;
                const int d = (pp & 4) ? 32 + 4 * (pp >> 3) + (pp & 3) : 4 * (pp >> 3) + (pp & 3);
                orig = 1304 + hd * 64 + d; }
            else if (cd < 5120) orig = cd - 2048 + 3352;
            else if (cd < 5144) orig = cd - 5120 + 1280;
            else if (cd < 5376) ok = false;
            else if (cd < 5504) orig = cd - 5376 + 896;
            else if (cd < 5632) orig = cd - 5504 + 1152;
            else orig = cd - 5632 + 2328;
        }
        v[i] = make_float4(0.f, 0.f, 0.f, 0.f);
        if (ok) v[i] = *(const float4*)(J.src + (size_t)(J.k0 + kk) * J.ld + orig);
    }
}
__device__ __forceinline__ void tcvt_finish(const TJob& J, const float4 (&v)[4], unsigned char* lds, int tid) {
    float* tile = (float*)lds;
#pragma unroll
    for (int i = 0; i < 4; ++i) {
        const int kk = (tid >> 4) + 16 * i, c4 = (tid & 15) * 4;
        tile[kk * 65 + c4 + 0] = v[i].x; tile[kk * 65 + c4 + 1] = v[i].y; tile[kk * 65 + c4 + 2] = v[i].z; tile[kk * 65 + c4 + 3] = v[i].w;
    }
    __syncthreads();
#pragma unroll
    for (int i = 0; i < 2; ++i) {
        const int q = tid + 256 * i, n = q >> 3, kc = q & 7;
        float x[8];
#pragma unroll
        for (int j = 0; j < 8; ++j) x[j] = tile[(kc * 8 + j) * 65 + n];
        u32x4 w; w.x = pack2(x[0], x[1]); w.y = pack2(x[2], x[3]); w.z = pack2(x[4], x[5]); w.w = pack2(x[6], x[7]);
        int drow = J.n0 + n; if (J.mode >= 2) drow = 8 * (drow >> 2) + (drow & 3) + (J.mode == 3 ? 4 : 0);
        *(u32x4*)(J.dst + (size_t)drow * J.kdst + J.k0 + kc * 8) = w;
    }
    __syncthreads();
}
__device__ __forceinline__ void tcvt_tile(const float* src, int ld_src, int k0, int n0, int mode, bf16_t* dst, int kdst, unsigned char* lds, int half) {
    TJob J; J.src = src; J.dst = dst; J.ld = ld_src; J.k0 = k0; J.n0 = n0; J.mode = mode; J.kdst = kdst;
    const int tid = (ltid() & 255); float4 v[4];
    tcvt_load(J, v, tid); tcvt_finish(J, v, lds, tid);
}

__device__ __forceinline__ void tcvt_decode(const Params& p, unsigned char* ws, int layer, int t, TJob& J) {
    constexpr int J0 = 16 * 104, J1 = 8 * 16, J2 = 256, J3 = 256, J4 = 2048, J5 = 2048;
    int u = t;
        if (u < J0) { J.src = p.w_in + (size_t)layer * 1024 * DIN; J.ld = DIN; J.k0 = (u % 16) * 64; J.n0 = (u / 16) * 64; J.mode = 1; J.dst = (bf16_t*)(ws + WS_WIN); J.kdst = 1024; return; }
        u -= J0;
        if (u < J1) { J.src = p.w_br_a + (size_t)layer * 512 * 1024; J.ld = 1024; J.k0 = (u % 8) * 64; J.n0 = (u / 8) * 64; J.mode = 0; J.dst = (bf16_t*)(ws + WS_WA); J.kdst = 1536; return; }
        u -= J1;
        if (u < J2) { J.src = p.w_br_b + (size_t)layer * 1024 * 1024; J.ld = 1024; J.k0 = (u % 16) * 64; J.n0 = (u / 16) * 64; J.mode = 0; J.dst = (bf16_t*)(ws + WS_WA) + 512; J.kdst = 1536; return; }
        u -= J2;
        if (u < J3) { J.src = p.w_o + (size_t)layer * 1024 * 1024; J.ld = 1024; J.k0 = (u % 16) * 64; J.n0 = (u / 16) * 64; J.mode = 0; J.dst = (bf16_t*)(ws + WS_WO); J.kdst = 1024; return; }
        u -= J3;
        if (u < J4 + J5) {
            const bool up = u >= J4; if (up) u -= J4;
            const int e = u / 128, v = u % 128;
            J.src = (up ? p.w_up : p.w_gate) + ((size_t)layer * NE + e) * 1024 * 512; J.ld = 512; J.k0 = (v % 16) * 64; J.n0 = (v / 16) * 64; J.mode = up ? 3 : 2;
            J.dst = (bf16_t*)(ws + WS_WG) + (size_t)e * 1024 * 1024; J.kdst = 1024; return;
        }
        u -= J4 + J5;
        { const int e = u / 128, v = u % 128;
          J.src = p.w_down + ((size_t)layer * NE + e) * 512 * 1024; J.ld = 1024; J.k0 = (v % 8) * 64; J.n0 = (v / 8) * 64; J.mode = 0; J.dst = (bf16_t*)(ws + WS_WD) + (size_t)e * 1024 * 512; J.kdst = 512; }
}


__device__ __forceinline__ void phase_pw(const Params& p, int layer, unsigned char* lds, int parts, int half, int skip = 0) {
    const int hq = __builtin_amdgcn_readfirstlane(ltid() >> 8);
    if ((int)(blockIdx.x * 2 + hq) < skip) return;
    const int bid = (blockIdx.x * 2 + hq) - skip, nblk = (gridDim.x * 2) - skip, tid = (ltid() & 255);
    unsigned char* ws = launder(p.ws);
    constexpr int J0 = 16 * 104, J1 = 8 * 16, J2 = 256, J3 = 256, J4 = 2048, J5 = 2048, J6 = 2048, JT = J0 + J1 + J2 + J3 + J4 + J5 + J6;
    const int t_lo = (parts & 1) ? 0 : (parts & 2) ? J0 : J0 + J1 + J2 + J3;
    const int t_hi = (parts & 4) ? JT : (parts & 2) ? J0 + J1 + J2 + J3 : (parts & 1) ? J0 : 0;
    if (t_lo + bid < t_hi) {
        float4 v[4]; { TJob J; tcvt_decode(p, ws, layer, t_lo + bid, J); tcvt_load(J, v, tid); }
        for (int t = t_lo + bid; t < t_hi; t += nblk) {
            float4 vn[4];
            if (t + nblk < t_hi) { TJob J; tcvt_decode(p, ws, layer, t + nblk, J); tcvt_load(J, vn, tid); }
            { TJob J; tcvt_decode(p, ws, layer, t, J); tcvt_finish(J, v, lds, tid); }
#pragma unroll
            for (int i = 0; i < 4; ++i) v[i] = vn[i];
        }
    }
    if (parts & 16) {
    for (int t = bid; t < 64; t += nblk) {
        const int kv = t >> 5, kt = t & 31;
        const float* w1 = p.cmp_w1 + ((size_t)layer * 2 + kv) * 2048 * 64;
        tcvt_tile(w1, 64, kt * 64, 0, 0, (bf16_t*)(ws + WS_W1T) + (size_t)kv * 64 * 2048, 2048, lds, half);
        const int n = tid & 63, part = tid >> 6;
        const float* pos = p.cmp_pos + ((size_t)layer * 2 + kv) * 2048 + kt * 64 + part * 16;
        const float* wp = w1 + (size_t)(kt * 64 + part * 16) * 64 + n;
        float a = 0.f;
#pragma unroll
        for (int k = 0; k < 16; ++k) a += pos[k] * wp[(size_t)k * 64];
        float* red = (float*)lds;
        __syncthreads(); red[tid] = a; __syncthreads();
        if (tid < 64) ((float*)(ws + WS_CTL) + CW_B1P)[(kv * 32 + kt) * 64 + tid] = red[tid] + red[tid + 64] + red[tid + 128] + red[tid + 192];
        __syncthreads();
    }
    }
    if (parts & 8) {
        const float4* xs = (const float4*)p.x; u32x2* xb = (u32x2*)(ws + WS_XB);
        for (size_t i = (size_t)bid * HT + tid; i < (size_t)T_ * 1024 / 4; i += (size_t)nblk * HT) {
            float4 v = xs[i]; u32x2 w; w.x = pack2(v.x, v.y); w.y = pack2(v.z, v.w); xb[i] = w;
        }
        for (int n = bid * HT + tid; n < 8192; n += nblk * HT) {
            int bk;
            if (n < 16) bk = n;
            else { const int th[15] = {22, 30, 40, 54, 73, 99, 134, 182, 246, 332, 450, 609, 825, 1117, 1513}; bk = 16;
#pragma unroll
                for (int k = 0; k < 15; ++k) bk += (n >= th[k]) ? 1 : 0; }
            (ws + WS_BUCKET)[n] = (unsigned char)bk;
        }
        for (int i = bid * HT + tid; i < 8192 * 32; i += nblk * HT) {
            const int pos = i >> 5, d = i & 31;
            const float inv = powf(10000.f, -(float)d * 2.0f / 64.f);
            const float ang = (float)pos * inv;
            float sn, cs; sincosf(ang, &sn, &cs);
            ((float2*)(ws + WS_ROPE))[i] = make_float2(cs, sn);
        }
        if (bid == 0) for (int i = tid; i < 8192; i += HT) ((unsigned*)(ws + WS_CTL))[i] = 0u;
    }
}

__device__ __forceinline__ float fsig(float x) { return __builtin_amdgcn_rcpf(1.f + __builtin_amdgcn_exp2f(-1.4426950408889634f * x)); }
template <int KIND>
__device__ __forceinline__ void g1_epi(const f32x4 (&acc)[2][2][4][2], unsigned char* ws, int r0, int c0, int wr, int wc, int fr, int fq) {
#pragma unroll
    for (int ai = 0; ai < 2; ++ai)
#pragma unroll
        for (int m = 0; m < 4; ++m) {
            const int row = r0 + 128 * ai + 64 * wr + 16 * m + fr + vzero();
#pragma unroll
            for (int bj = 0; bj < 2; ++bj) {
                const int col = c0 + 128 * bj + 32 * wc + 8 * fq;
                f32x4 v0 = acc[ai][bj][m][0], v1 = acc[ai][bj][m][1];
                if (KIND == 5) {
                    const int b = col >> 13, sq = col & (S_ - 1);
                    bf16_t* dst;
                    if (row < C_VW) { const int c = row - C_VS; dst = (bf16_t*)(ws + WS_VST) + ((size_t)(b * 2 + (c >> 6)) * 64 + (c & 63)) * S_ + sq; }
                    else if (row < C_VR) { const int c = row - C_VW; dst = (bf16_t*)(ws + WS_VWT) + ((size_t)(b * 2 + (c >> 6)) * 64 + (c & 63)) * S_ + sq; }
                    else { const int c = row - C_VR; dst = (bf16_t*)(ws + WS_VRT) + ((size_t)(b * 8 + (c >> 7)) * 128 + (c & 127)) * S_ + sq; }
                    u32x4 w; w.x = pack2(v0[0], v0[1]); w.y = pack2(v0[2], v0[3]); w.z = pack2(v1[0], v1[1]); w.w = pack2(v1[2], v1[3]);
                    *(u32x4*)dst = w;
                    continue;
                }
                if (KIND == 1 || KIND == 2) {
                    const float2* rope = (const float2*)(ws + WS_ROPE);
                    const int pos = row & (S_ - 1), d = 16 * (wc & 1) + 4 * fq;
                    const float4 cs01 = *(const float4*)(rope + pos * 32 + d), cs23 = *(const float4*)(rope + pos * 32 + d + 2);
                    const float c[4] = {cs01.x, cs01.z, cs23.x, cs23.z}, sn[4] = {cs01.y, cs01.w, cs23.y, cs23.w};
                    const float sc = (KIND == 2) ? 0.125f : 1.0f;
                    f32x4 y1, y2;
#pragma unroll
                    for (int r = 0; r < 4; ++r) { y1[r] = (v0[r] * c[r] - v1[r] * sn[r]) * sc; y2[r] = (v0[r] * sn[r] + v1[r] * c[r]) * sc; }
                    v0 = y1; v1 = y2;
                } else if (KIND == 3) {
#pragma unroll
                    for (int r = 0; r < 4; ++r) { v0[r] = v0[r] * fsig(v0[r]); v1[r] = v1[r] * fsig(v1[r]); }
                } else if (KIND == 4) {
#pragma unroll
                    for (int r = 0; r < 4; ++r) { v0[r] = fsig(v0[r]); v1[r] = fsig(v1[r]); }
                }
                u32x4 w; w.x = pack2(v0[0], v0[1]); w.y = pack2(v0[2], v0[3]); w.z = pack2(v1[0], v1[1]); w.w = pack2(v1[2], v1[3]);
                *(u32x4*)((bf16_t*)(ws + WS_P) + (size_t)row * LD + col) = w;
            }
        }
}
struct G1Order {      typedef pg8::Unit U; static constexpr bool GATHER = false;
    int xcd, slot, per;
    __device__ __forceinline__ bool next(int i, pg8::Unit& u) const {
        const int j = slot + i * per; if (j >= 208) return false;
        if (j < 192) { u.pm = j / 3; u.pn = xcd + 8 * (j % 3); } else { const int q = j - 192; u.pm = 8 * xcd + (q >> 1); u.pn = 24 + (q & 1); }
        return true;
    }
    __device__ __forceinline__ void ptrs(const pg8::Unit& u, unsigned& A, unsigned& B) const {
        const unsigned x = (unsigned)WS_XB + (unsigned)u.pm * (256u * 1024u * 2u), w = (unsigned)WS_WIN + (unsigned)u.pn * (256u * 1024u * 2u);
        if (u.pn >= 21) { A = w; B = x; } else { A = x; B = w; }
    }
};
struct G1Epi {
    static constexpr int MID_T = 0;
    unsigned char* ws;
    __device__ __forceinline__ void operator()(const f32x4 (&acc)[2][2][4][2], const pg8::Unit& u, int wr, int wc, int fr, int fq) const {
        const int pn = u.pn, tok0 = u.pm * 256, n0 = pn * 256;
        if (pn >= 21) g1_epi<5>(acc, ws, n0, tok0, wr, wc, fr, fq);
        else if (pn >= 12) g1_epi<4>(acc, ws, tok0, n0, wr, wc, fr, fq);
        else if (pn >= 8) g1_epi<3>(acc, ws, tok0, n0, wr, wc, fr, fq);
        else if (pn >= 6) g1_epi<2>(acc, ws, tok0, n0, wr, wc, fr, fq);
        else if (pn >= 4) g1_epi<1>(acc, ws, tok0, n0, wr, wc, fr, fq);
        else g1_epi<0>(acc, ws, tok0, n0, wr, wc, fr, fq);
    }
};
__device__ __forceinline__ void phase_g1(const Params& p, int layer, unsigned char* lds) {
    unsigned char* ws = launder(p.ws);
    G1Order S; S.xcd = blockIdx.x & 7; S.slot = blockIdx.x >> 3; S.per = gridDim.x >> 3;
    G1Epi E; E.ws = ws;
    pg8::gemm_phase<G1Epi, G1Order>(lds, 1024, S, E, ltid(), ws);
}

__device__ __forceinline__ void load_tile64(const bf16_t* base, size_t rowStride, unsigned char* dst, int wid, int lane) {
    const int c = ((lane & 7) ^ (lane >> 3)) * 8;
#pragma unroll
    for (int i = 0; i < 2; ++i) { const int j = wid + 4 * i, row = 8 * j + (lane >> 3); glds16(base + (size_t)row * rowStride + c, dst + j * 1024); }
}
__device__ __forceinline__ void load_tile128(const bf16_t* base, size_t rowStride, unsigned char* dst, int wid, int lane) {
    const int c = ((lane & 7) ^ (lane >> 3)) * 8;
#pragma unroll
    for (int i = 0; i < 4; ++i) { const int j = wid + 4 * i, row = 8 * j + (lane >> 3); glds16(base + (size_t)row * rowStride + c, dst + j * 1024); }
}
__device__ __forceinline__ void load_tile128w(const bf16_t* base, size_t rowStride, unsigned char* dst, int wid, int lane) {
    const int c = ((lane & 15) ^ ((4 * wid + (lane >> 4)) & 15)) * 8;
#pragma unroll
    for (int i = 0; i < 8; ++i) { const int j = wid + 4 * i, row = 4 * j + (lane >> 4); glds16(base + (size_t)row * rowStride + c, dst + j * 1024); }
}
__device__ __forceinline__ bf16x8 lds_frag128(const unsigned char* tile, int row, int chunk) {
    return *(const bf16x8*)(tile + row * 128 + ((chunk ^ (row & 7)) << 4));
}
__device__ __forceinline__ bf16x8 lds_frag256(const unsigned char* tile, int row, int chunk) {
    return *(const bf16x8*)(tile + row * 256 + ((chunk ^ (row & 15)) << 4));
}
__device__ __forceinline__ bf16x8 lds_vfrag128(const unsigned char* tile, int row, int kbase, int fq) {
    const int ca = (kbase >> 3) + (fq >> 1), hb = (fq & 1) * 8;
    const u32x2 a = *(const u32x2*)(tile + row * 128 + ((ca ^ (row & 7)) << 4) + hb);
    const u32x2 b = *(const u32x2*)(tile + row * 128 + (((ca + 2) ^ (row & 7)) << 4) + hb);
    u32x4 w; w.x = a.x; w.y = a.y; w.z = b.x; w.w = b.y;
    return __builtin_bit_cast(bf16x8, w);
}
__device__ __forceinline__ bf16x8 lds_vfrag256(const unsigned char* tile, int row, int kbase, int fq) {
    const int ca = (kbase >> 3) + (fq >> 1), hb = (fq & 1) * 8;
    const u32x2 a = *(const u32x2*)(tile + row * 256 + ((ca ^ (row & 15)) << 4) + hb);
    const u32x2 b = *(const u32x2*)(tile + row * 256 + (((ca + 2) ^ (row & 15)) << 4) + hb);
    u32x4 w; w.x = a.x; w.y = a.y; w.z = b.x; w.w = b.y;
    return __builtin_bit_cast(bf16x8, w);
}
__device__ __forceinline__ bf16x8 pack8(f32x4 a, f32x4 b) {
    u32x4 w; w.x = pack2(a[0], a[1]); w.y = pack2(a[2], a[3]); w.z = pack2(b[0], b[1]); w.w = pack2(b[2], b[3]);
    return __builtin_bit_cast(bf16x8, w);
}

__device__ __forceinline__ float gelu_tanh(float x) {
    const float u = 0.7978845608028654f * (x + 0.044715f * x * x * x);
    return 0.5f * x * (1.f + tanhf(u));
}
__device__ __forceinline__ void compress_item(const Params& p, int layer, int item, unsigned char* lds, int half) {
    unsigned char* ws = launder(p.ws);
    const int tid = (ltid() & 255), lane = tid & 63, wid = tid >> 6, wr = wid >> 1, wc = wid & 1, fr = lane & 15, fq = lane >> 4;
    const int mtile = item & 3, g = (item >> 2) & 1, b = (item >> 3) & 1, kv = item >> 4;
    const int i0 = mtile * 128;
    const bf16_t* P = (const bf16_t*)(ws + WS_P);
    const bf16_t* W1T = (const bf16_t*)(ws + WS_W1T) + (size_t)kv * 64 * 2048;
    const int col = (kv ? C_VC : C_KC) + g * 64;
    const int ldc = ((lane & 7) ^ (lane >> 3)) * 8;
    const int l0 = 16 * half;
    const bf16_t* ap[4];
#pragma unroll
    for (int i = 0; i < 4; ++i) ap[i] = P + ((size_t)b * S_ + 16 * (i0 + 32 * i + 8 * wid + (lane >> 3)) + l0) * LD + col + ldc;
    const bf16_t* bp[2];
#pragma unroll
    for (int i = 0; i < 2; ++i) bp[i] = W1T + (size_t)(8 * (wid + 4 * i) + (lane >> 3)) * 2048 + l0 * 64 + ldc;
    f32x4 acc[4][2];
#pragma unroll
    for (int i = 0; i < 4; ++i)
#pragma unroll
        for (int j = 0; j < 2; ++j) acc[i][j] = (f32x4){0.f, 0.f, 0.f, 0.f};
    __syncthreads();
#define CSTAGE(buf, l) do { unsigned char* st_ = lds + (buf) * 24576; \
        _Pragma("unroll") for (int i = 0; i < 4; ++i) glds16(ap[i] + (size_t)(l) * LD, st_ + (4 * i + wid) * 1024); \
        _Pragma("unroll") for (int i = 0; i < 2; ++i) glds16(bp[i] + (l) * 64, st_ + 16384 + (wid + 4 * i) * 1024); } while (0)
    CSTAGE(0, 0); CSTAGE(1, 1);
    for (int l = 0; l < 16; ++l) {
        const unsigned char* st = lds + (l % 3) * 24576;
        if (l + 1 < 16) WAIT_V(6); else WAIT_V(0);
        RAW_BARRIER();
        if (l + 2 < 16) CSTAGE((l + 2) % 3, l + 2);
#pragma unroll
        for (int ks = 0; ks < 2; ++ks) {
            bf16x8 a[4], bb[2];
#pragma unroll
            for (int i = 0; i < 4; ++i) a[i] = lds_frag128(st, 64 * wr + 16 * i + fr, 4 * ks + fq);
#pragma unroll
            for (int j = 0; j < 2; ++j) bb[j] = lds_frag128(st + 16384, 32 * wc + 16 * j + fr, 4 * ks + fq);
#pragma unroll
            for (int i = 0; i < 4; ++i)
#pragma unroll
                for (int j = 0; j < 2; ++j) acc[i][j] = mfma16(a[i], bb[j], acc[i][j]);
        }
    }
    __syncthreads();
#undef CSTAGE
    float* xch = (float*)(lds - half * HALF_LDS + HALF_LDS);
    if (half == 1) {
#pragma unroll
        for (int i = 0; i < 4; ++i)
#pragma unroll
            for (int j = 0; j < 2; ++j)
#pragma unroll
                for (int r = 0; r < 4; ++r) xch[((i * 2 + j) * 4 + r) * 256 + tid] = acc[i][j][r];
    }
    __syncthreads();
    if (half == 0) {
        const float* b1 = (const float*)(ws + WS_CTL) + CW_B1P + kv * 32 * 64;
#pragma unroll
        for (int j = 0; j < 2; ++j) {
            const int n = 32 * wc + 16 * j + fr; float bias = 0.f;
#pragma unroll
            for (int kt = 0; kt < 32; ++kt) bias += b1[kt * 64 + n + vzero()];
#pragma unroll
            for (int i = 0; i < 4; ++i)
#pragma unroll
                for (int r = 0; r < 4; ++r) {
                    const int row = 64 * wr + 16 * i + 4 * fq + r;
                    const float hv = gelu_tanh(acc[i][j][r] + xch[((i * 2 + j) * 4 + r) * 256 + tid] + bias);
                    *(bf16_t*)(lds + row * 128 + (((n >> 3) ^ (row & 7)) << 4) + (n & 7) * 2) = f2bf(hv);
                }
        }
        const float* w2 = p.cmp_w2 + ((size_t)layer * 2 + kv) * 64 * 64;
        const int k = tid >> 2, n0 = (tid & 3) * 16;
#pragma unroll
        for (int q4 = 0; q4 < 4; ++q4) {
            const float4 w = *(const float4*)(w2 + k * 64 + n0 + 4 * q4);
            const float wv[4] = {w.x, w.y, w.z, w.w};
#pragma unroll
            for (int e = 0; e < 4; ++e) { const int n = n0 + 4 * q4 + e; *(bf16_t*)(lds + 16384 + n * 128 + (((k >> 3) ^ (n & 7)) << 4) + (k & 7) * 2) = f2bf(wv[e]); }
        }
    }
    __syncthreads();
    if (half == 0) {
        f32x4 o[4][2];
#pragma unroll
        for (int i = 0; i < 4; ++i)
#pragma unroll
            for (int j = 0; j < 2; ++j) o[i][j] = (f32x4){0.f, 0.f, 0.f, 0.f};
#pragma unroll
        for (int ks = 0; ks < 2; ++ks) {
            bf16x8 a[4], bb[2];
#pragma unroll
            for (int i = 0; i < 4; ++i) a[i] = lds_frag128(lds, 64 * wr + 16 * i + fr, 4 * ks + fq);
#pragma unroll
            for (int j = 0; j < 2; ++j) bb[j] = lds_frag128(lds + 16384, 32 * wc + 16 * j + fr, 4 * ks + fq);
#pragma unroll
            for (int i = 0; i < 4; ++i)
#pragma unroll
                for (int j = 0; j < 2; ++j) o[i][j] = mfma16(a[i], bb[j], o[i][j]);
        }
#pragma unroll
        for (int i = 0; i < 4; ++i)
#pragma unroll
            for (int j = 0; j < 2; ++j) {
                const int n = 32 * wc + 16 * j + fr, ci = i0 + 64 * wr + 16 * i + 4 * fq;
                f32x4 v = o[i][j];
#pragma unroll
                for (int r = 0; r < 4; ++r) if (ci + r >= 511) v[r] = 0.f;
                if (kv == 0) {
                    bf16_t* dst = (bf16_t*)(ws + WS_KCC) + ((size_t)(b * 2 + g) * 512 + ci) * 64 + n;
#pragma unroll
                    for (int r = 0; r < 4; ++r) dst[r * 64] = f2bf(v[r]);
                } else {
                    *(u32x2*)((bf16_t*)(ws + WS_VCCT) + ((size_t)(b * 2 + g) * 64 + n) * 512 + ci) = pack4(v);
                }
            }
    }
    __syncthreads();
}

__device__ __forceinline__ float ret_lg2(int h) { const float gam = 1.f - exp2f(-5.f - (float)h); return log2f(gam); }

__device__ __forceinline__ void retkv_item(const Params& p, int item, unsigned char* lds, int half) {
    unsigned char* ws = launder(p.ws);
    const int tid = (ltid() & 255), lane = tid & 63, wid = tid >> 6, fr = lane & 15, fq = lane >> 4;
    const int n = item & 63, h = (item >> 6) & 7, b = item >> 9;
    const size_t tok0 = (size_t)b * S_ + 128 * n;
    unsigned char* vL = lds; unsigned char* kL = lds + 32768;
    load_tile128w((const bf16_t*)(ws + WS_VRT) + ((size_t)(b * 8 + h) * 128) * S_ + 128 * n, S_, vL, wid, lane);
    load_tile128((const bf16_t*)(ws + WS_P) + tok0 * LD + C_KR + h * 64, LD, kL, wid, lane);
    wait_vm0(); __syncthreads();
    const float lg2 = ret_lg2(h);
    f32x4 acc[2][4];
#pragma unroll
    for (int m = 0; m < 2; ++m)
#pragma unroll
        for (int nt = 0; nt < 4; ++nt) acc[m][nt] = (f32x4){0.f, 0.f, 0.f, 0.f};
#pragma unroll
    for (int ks = 0; ks < 4; ++ks) {
        bf16x8 a[2], bb[4];
#pragma unroll
        for (int m = 0; m < 2; ++m) a[m] = lds_frag256(vL, 32 * wid + 16 * m + fr, 4 * ks + fq);
        float dec[8];
#pragma unroll
        for (int j = 0; j < 8; ++j) dec[j] = exp2f((float)(127 - (32 * ks + 8 * fq + j)) * lg2);
#pragma unroll
        for (int nt = 0; nt < 4; ++nt) {
            const int d = 16 * nt + fr;
            float v[8];
#pragma unroll
            for (int j = 0; j < 8; ++j) {
                const int tk = 32 * ks + 8 * fq + j;
                const bf16_t kvv = *(const bf16_t*)(kL + tk * 128 + (((d >> 3) ^ (tk & 7)) << 4) + (d & 7) * 2);
                v[j] = bf2f(kvv) * dec[j];
            }
            u32x4 w; w.x = pack2(v[0], v[1]); w.y = pack2(v[2], v[3]); w.z = pack2(v[4], v[5]); w.w = pack2(v[6], v[7]);
            bb[nt] = __builtin_bit_cast(bf16x8, w);
        }
#pragma unroll
        for (int m = 0; m < 2; ++m)
#pragma unroll
            for (int nt = 0; nt < 4; ++nt) acc[m][nt] = mfma16(a[m], bb[nt], acc[m][nt]);
    }
    float* KVT = (float*)(ws + WS_KVT) + ((size_t)(b * 8 + h) * 64 + n) * 8192;
#pragma unroll
    for (int m = 0; m < 2; ++m)
#pragma unroll
        for (int nt = 0; nt < 4; ++nt)
#pragma unroll
            for (int r = 0; r < 4; ++r) KVT[(32 * wid + 16 * m + 4 * fq + r) * 64 + 16 * nt + fr] = acc[m][nt][r];
    __syncthreads();
}

__device__ __forceinline__ void phase_p2(const Params& p, int layer, unsigned char* lds, int half) {
    const int vb = blockIdx.x * 2 + half, nvb = gridDim.x * 2;
    if (vb < 64) compress_item(p, layer, vb >> 1, lds, half);
    else for (int it = vb - 64; it < 1024; it += nvb - 64) retkv_item(p, it, lds, half);
}

constexpr int NSA_IMP = 32768, NSA_BUCKET = 65792, NSA_BIAS = 73984;

struct NsaLane { int t; int fr, fq, wid, lane; };

constexpr float LOG2E = 1.4426950408889634f;
__device__ __forceinline__ int t5_first(int bk) {
    const int th[16] = {16, 22, 30, 40, 54, 73, 99, 134, 182, 246, 332, 450, 609, 825, 1117, 1513};
    int r = 16;
#pragma unroll
    for (int k = 0; k < 16; ++k) r = (bk == 16 + k) ? th[k] : r;
    return r;
}
template <int BR, int PASS>
__device__ __forceinline__ void nsa_half(const unsigned char* kL, const unsigned char* vL, const unsigned char* lds, const bf16x8 (&qptr)[4][2],
                                         f32x4 (&O)[4][4], float (&m)[4], float (&l)[4], int tile, int hf, const NsaLane& L, int qrow, const bool FAST, int th, int b0, int b1) {
    const int fr = L.lane & 15, fq = L.lane >> 4;
    constexpr float C2 = 0.125f * LOG2E;
    bf16x8 Kf[2][2];
#pragma unroll
    for (int i = 0; i < 2; ++i)
#pragma unroll
        for (int ks = 0; ks < 2; ++ks) Kf[i][ks] = lds_frag128(kL, 32 * hf + 16 * i + fr, 4 * ks + fq);
    bf16x8 Vf[4];
    if (PASS != 0) {
#pragma unroll
        for (int mt = 0; mt < 4; ++mt) Vf[mt] = lds_vfrag128(vL, 16 * mt + fr, 32 * hf, fq);
    }
    unsigned vmask = 0; unsigned bk[2] = {0u, 0u}; bool hi[2][4];
    if (!FAST) {
        const unsigned char* bucketL = lds + NSA_BUCKET;
#pragma unroll
        for (int i = 0; i < 2; ++i) {
            unsigned pk = 0;
#pragma unroll
            for (int r = 0; r < 4; ++r) {
                const int kk = 32 * hf + 16 * i + 4 * fq + r;
                int rel; bool ok;
                if (BR == 0) { rel = L.t - (16 * (64 * tile + kk) + 31); ok = rel >= 0; }
                else { rel = L.t - (64 * tile + kk); ok = rel >= 0 && rel < 512; }
                int rc = rel < 0 ? 0 : rel; rc = rc > 8191 ? 8191 : rc;
                pk |= (unsigned)bucketL[rc] << (8 * r);
                vmask |= (ok ? 1u : 0u) << (4 * i + r);
                hi[i][r] = false;
            }
            bk[i] = pk;
        }
    } else {
        const int kbase = 64 * tile + 32 * hf + 4 * fq;
        const int lim = BR == 0 ? L.t - th - 31 - 16 * kbase : L.t - th - kbase;
#pragma unroll
        for (int i = 0; i < 2; ++i)
#pragma unroll
            for (int r = 0; r < 4; ++r) hi[i][r] = (BR == 0 ? 16 : 1) * (16 * i + r) <= lim;
    }
    const float* biasL = (const float*)(lds + NSA_BIAS);
    float ia[2] = {0.f, 0.f}, ic[2] = {0.f, 0.f};
#pragma unroll
    for (int nt = 0; nt < 4; ++nt) {
        f32x4 S[2];
        const bf16x8 q0 = qptr[nt][0], q1 = qptr[nt][1];
#pragma unroll
        for (int i = 0; i < 2; ++i) {
            S[i] = (f32x4){0.f, 0.f, 0.f, 0.f};
            S[i] = mfma16(Kf[i][0], q0, S[i]); S[i] = mfma16(Kf[i][1], q1, S[i]);
        }
        float tmax = -1e30f;
        if (!FAST) {
#pragma unroll
            for (int i = 0; i < 2; ++i) {
                float bsv[4];
#pragma unroll
                for (int r = 0; r < 4; ++r) bsv[r] = biasL[nt * 32 + ((bk[i] >> (8 * r)) & 0xffu)];
                asm volatile("" : "+v"(bsv[0]), "+v"(bsv[1]), "+v"(bsv[2]), "+v"(bsv[3]));
#pragma unroll
                for (int r = 0; r < 4; ++r) {
                    const bool ok = (vmask >> (4 * i + r)) & 1u;
                    const float sv = S[i][r] * C2 + bsv[r];
                    S[i][r] = ok ? sv : -1e30f; tmax = fmaxf(tmax, S[i][r]);
                }
            }
        } else {
            const float blo = biasL[nt * 32 + b0], bhi = biasL[nt * 32 + b1];
#pragma unroll
            for (int i = 0; i < 2; ++i)
#pragma unroll
                for (int r = 0; r < 4; ++r) { S[i][r] = S[i][r] * C2 + (hi[i][r] ? bhi : blo); tmax = fmaxf(tmax, S[i][r]); }
        }
        if (PASS != 1) {
            if (__builtin_amdgcn_ballot_w64(tmax > m[nt] + 8.f) != 0ull) {
                const float tm = rows_max(tmax);
                const float mnew = tm > m[nt] + 8.f ? tm : m[nt], alpha = __builtin_amdgcn_exp2f(m[nt] - mnew);
                l[nt] *= alpha; m[nt] = mnew;
                if (PASS == 2) {
#pragma unroll
                    for (int mt = 0; mt < 4; ++mt) O[mt][nt] = O[mt][nt] * alpha;
                }
            }
            float psum = 0.f;
#pragma unroll
            for (int i = 0; i < 2; ++i)
#pragma unroll
                for (int r = 0; r < 4; ++r) S[i][r] = __builtin_amdgcn_exp2f(S[i][r] - m[nt]);
            if (!FAST) {
#pragma unroll
                for (int i = 0; i < 2; ++i)
#pragma unroll
                    for (int r = 0; r < 4; ++r) { const bool ok = (vmask >> (4 * i + r)) & 1u; S[i][r] = ok ? S[i][r] : 0.f; }
            }
#pragma unroll
            for (int i = 0; i < 2; ++i)
#pragma unroll
                for (int r = 0; r < 4; ++r) psum += S[i][r];
            l[nt] += psum;
        } else {
#pragma unroll
            for (int i = 0; i < 2; ++i) {
#pragma unroll
                for (int r = 0; r < 4; ++r) S[i][r] = __builtin_amdgcn_exp2f(S[i][r] - m[nt]) * l[nt];
            }
            if (!FAST) {
#pragma unroll
                for (int i = 0; i < 2; ++i)
#pragma unroll
                    for (int r = 0; r < 4; ++r) { const bool ok = (vmask >> (4 * i + r)) & 1u; S[i][r] = ok ? S[i][r] : 0.f; }
            }
#pragma unroll
            for (int i = 0; i < 2; ++i) {
                ia[i] += S[i][0] + S[i][1] + S[i][2] + 0.5f * S[i][3];
                ic[i] += 0.5f * S[i][3];
            }
        }
        if (PASS != 0) {
            const bf16x8 Pb = pack8(S[0], S[1]);
#pragma unroll
            for (int mt = 0; mt < 4; ++mt) O[mt][nt] = mfma16(Vf[mt], Pb, O[mt][nt]);
        }
        if (nt & 1) __builtin_amdgcn_sched_barrier(0);
    }
    if (PASS == 1) {
        float* imp = (float*)(lds + NSA_IMP) + qrow * 129;
        asm volatile("" ::: "memory"); __builtin_amdgcn_wave_barrier();
#pragma unroll
        for (int i = 0; i < 2; ++i) { const int j = 16 * tile + 8 * hf + 4 * i + fq; imp[j] += ia[i]; }
        asm volatile("s_waitcnt lgkmcnt(0)" ::: "memory"); __builtin_amdgcn_wave_barrier();
#pragma unroll
        for (int i = 0; i < 2; ++i) { const int j = 16 * tile + 8 * hf + 4 * i + fq + 1; if (j < 128) imp[j] += ic[i]; }
        asm volatile("s_waitcnt lgkmcnt(0)" ::: "memory"); __builtin_amdgcn_wave_barrier();
    }
}
template <int BR, int PASS>
__device__ __forceinline__ void nsa_tile(const unsigned char* kL, const unsigned char* vL, const unsigned char* lds, const bf16x8 (&qptr)[4][2],
                                         f32x4 (&O)[4][4], float (&m)[4], float (&l)[4], int tile, const NsaLane& L, int qrow) {
    const int tq0 = __builtin_amdgcn_readfirstlane(L.t - (L.lane & 15));
#pragma unroll 1
    for (int hf = 0; hf < 2; ++hf) {
        const int kfirst = 64 * tile + 32 * hf, pmin = BR == 0 ? 16 * kfirst + 31 : kfirst, pmax = BR == 0 ? 16 * (kfirst + 31) + 31 : kfirst + 31;
        const int rmin = tq0 - pmax, rmax = tq0 + 15 - pmin;
        bool fast = false; int th = 0, b0 = 0, b1 = 0;
        if (rmin >= 16 && (BR != 2 || rmax < 512)) {
            const unsigned char* bucketL = lds + NSA_BUCKET;
            b0 = __builtin_amdgcn_readfirstlane((int)bucketL[rmin]); b1 = __builtin_amdgcn_readfirstlane((int)bucketL[rmax > 8191 ? 8191 : rmax]);
            if (b1 - b0 <= 1) { fast = true; th = b1 == b0 ? 0 : t5_first(b1); }
        }
        nsa_half<BR, PASS>(kL, vL, lds, qptr, O, m, l, tile, hf, L, qrow, fast, th, b0, b1);
    }
}

__device__ __forceinline__ void cmp_item(const Params& p, int item, unsigned char* lds, int half) {
    unsigned char* ws = launder(p.ws);
    const int tid = (ltid() & 255), lane = tid & 63, wid = tid >> 6, fr = lane & 15, fq = lane >> 4;
    const int combo = item & 3, qt = 127 - (item >> 2), b = combo >> 1, g = combo & 1;
    const int q0 = qt * 64, qrow = 16 * wid + fr;
    NsaLane L; L.t = q0 + qrow; L.fr = fr; L.fq = fq; L.wid = wid; L.lane = lane;
    const size_t tok = (size_t)b * S_ + L.t;
    const bf16_t* P = (const bf16_t*)(ws + WS_P);
    __syncthreads();
    if (tid < 128) ((float*)(lds + NSA_BIAS))[tid] = p.rel_bias[(tid & 31) * 8 + 4 * g + (tid >> 5)] * LOG2E;
    for (int i = tid; i < 64 * 129; i += HT) ((float*)(lds + NSA_IMP))[i] = 0.f;
    bf16x8 Qf[4][2];
#pragma unroll
    for (int nt = 0; nt < 4; ++nt)
#pragma unroll
        for (int ks = 0; ks < 2; ++ks) Qf[nt][ks] = *(const bf16x8*)(P + tok * LD + C_QA + (4 * g + nt) * 64 + 32 * ks + 8 * fq);
    __syncthreads();
    f32x4 O[4][4]; float m[4], l[4];
    const bf16_t* gates = P + tok * LD + C_GA + (4 * g) * 3;
    const bf16_t* kc = (const bf16_t*)(ws + WS_KCC) + (size_t)(b * 2 + g) * 512 * 64;
    const bf16_t* vc = (const bf16_t*)(ws + WS_VCCT) + (size_t)(b * 2 + g) * 64 * 512;
    const int ntc = ((q0 + 32) >> 4) / 64 + 1;
#pragma unroll
    for (int nt = 0; nt < 4; ++nt) { m[nt] = -1e30f; l[nt] = 0.f; }
    load_tile64(kc, 64, lds, wid, lane);
    wait_vm0(); __syncthreads();
    for (int it = 0; it < ntc; ++it) {
        unsigned char* cur = lds + (it & 1) * 16384;
        if (it + 1 < ntc) load_tile64(kc + (size_t)(it + 1) * 64 * 64, 64, lds + ((it + 1) & 1) * 16384, wid, lane);
        nsa_tile<0, 0>(cur, cur + 8192, lds, Qf, O, m, l, it, L, qrow);
        wait_vm0(); __syncthreads();
    }
#pragma unroll
    for (int nt = 0; nt < 4; ++nt) { l[nt] = rows_sum(l[nt]); l[nt] = l[nt] > 0.f ? 1.f / l[nt] : 0.f; }
#pragma unroll
    for (int mt = 0; mt < 4; ++mt)
#pragma unroll
        for (int nt = 0; nt < 4; ++nt) O[mt][nt] = (f32x4){0.f, 0.f, 0.f, 0.f};
    load_tile64(kc, 64, lds, wid, lane); load_tile64(vc, 512, lds + 8192, wid, lane);
    wait_vm0(); __syncthreads();
    for (int it = 0; it < ntc; ++it) {
        unsigned char* cur = lds + (it & 1) * 16384;
        if (it + 1 < ntc) { unsigned char* nx = lds + ((it + 1) & 1) * 16384;
            load_tile64(kc + (size_t)(it + 1) * 64 * 64, 64, nx, wid, lane); load_tile64(vc + (it + 1) * 64, 512, nx + 8192, wid, lane); }
        nsa_tile<0, 1>(cur, cur + 8192, lds, Qf, O, m, l, it, L, qrow);
        wait_vm0(); __syncthreads();
    }
    bf16_t* YC = (bf16_t*)(ws + WS_YC) + tok * 512 + (4 * g) * 64;
#pragma unroll
    for (int nt = 0; nt < 4; ++nt) {
        const float gt = bf2f(gates[nt * 3 + 0]);
#pragma unroll
        for (int mt = 0; mt < 4; ++mt) *(u32x2*)(YC + nt * 64 + 16 * mt + 4 * fq) = pack4(O[mt][nt] * gt);
    }
    const int cur = qt;
    {
        float* imp = (float*)(lds + NSA_IMP) + qrow * 129 + 32 * fq;
        asm volatile("s_waitcnt lgkmcnt(0)" ::: "memory"); __builtin_amdgcn_wave_barrier();
#pragma unroll
        for (int i = 0; i < 32; ++i) {
            const int j = 32 * fq + i;
            const float v = imp[i];
            imp[i] = j > cur ? -1.f : v + ((j == 0 || j == cur || j == cur - 1) ? 1.0e4f : 0.f);
        }
        unsigned word = 0;
#pragma unroll 1
        for (int round = 0; round < 16; ++round) {
            float bv = imp[0]; int bi = 0;
#pragma unroll
            for (int i = 1; i < 32; ++i) { const float v = imp[i]; if (v > bv) { bv = v; bi = i; } }
            int gi = 32 * fq + bi;
            {
                u32x2 rv = __builtin_amdgcn_permlane16_swap(__float_as_uint(bv), __float_as_uint(bv), false, false);
                u32x2 ri = __builtin_amdgcn_permlane16_swap((unsigned)gi, (unsigned)gi, false, false);
                float v0 = __uint_as_float(rv.x), v1 = __uint_as_float(rv.y); int i0 = (int)ri.x, i1 = (int)ri.y;
                if (v1 > v0 || (v1 == v0 && i1 < i0)) { v0 = v1; i0 = i1; }
                rv = __builtin_amdgcn_permlane32_swap(__float_as_uint(v0), __float_as_uint(v0), false, false);
                ri = __builtin_amdgcn_permlane32_swap((unsigned)i0, (unsigned)i0, false, false);
                v0 = __uint_as_float(rv.x); v1 = __uint_as_float(rv.y); i0 = (int)ri.x; i1 = (int)ri.y;
                if (v1 > v0 || (v1 == v0 && i1 < i0)) { v0 = v1; i0 = i1; }
                bv = v0; gi = i0;
            }
            if (bv >= 0.f && (gi >> 5) == fq) { word |= 1u << (gi & 31); imp[gi & 31] = -2.f; }
        }
        ((unsigned*)(ws + WS_SELW))[(tok * 2 + g) * 4 + fq] = word;
    }
}

__device__ __forceinline__ void win_item(const Params& p, int item, unsigned char* lds, int half) {
    unsigned char* ws = launder(p.ws);
    const int tid = (ltid() & 255), lane = tid & 63, wid = tid >> 6, fr = lane & 15, fq = lane >> 4;
    const int combo = item & 3, qt = 127 - (item >> 2), b = combo >> 1, g = combo & 1;
    const int q0 = qt * 64, qrow = 16 * wid + fr;
    NsaLane L; L.t = q0 + qrow; L.fr = fr; L.fq = fq; L.wid = wid; L.lane = lane;
    const size_t tok = (size_t)b * S_ + L.t;
    const bf16_t* P = (const bf16_t*)(ws + WS_P);
    __syncthreads();
    if (tid < 128) ((float*)(lds + NSA_BIAS))[tid] = p.rel_bias[(tid & 31) * 8 + 4 * g + (tid >> 5)] * LOG2E;
    bf16x8 Qf[4][2];
#pragma unroll
    for (int nt = 0; nt < 4; ++nt)
#pragma unroll
        for (int ks = 0; ks < 2; ++ks) Qf[nt][ks] = *(const bf16x8*)(P + tok * LD + C_QA + (4 * g + nt) * 64 + 32 * ks + 8 * fq);
    __syncthreads();
    f32x4 O[4][4]; float m[4], l[4];
    const bf16_t* gates = P + tok * LD + C_GA + (4 * g) * 3;
#pragma unroll
    for (int nt = 0; nt < 4; ++nt) { m[nt] = -1e30f; l[nt] = 0.f; }
#pragma unroll
    for (int mt = 0; mt < 4; ++mt)
#pragma unroll
        for (int nt = 0; nt < 4; ++nt) O[mt][nt] = (f32x4){0.f, 0.f, 0.f, 0.f};
    {
        const bf16_t* kb = P + ((size_t)b * S_) * LD + C_KW + g * 64;
        const bf16_t* vb = (const bf16_t*)(ws + WS_VWT) + (size_t)(b * 2 + g) * 64 * S_;
        const int k_lo = qt - 8 > 0 ? qt - 8 : 0, ntw = qt - k_lo + 1;
        load_tile64(kb + (size_t)k_lo * 64 * LD, LD, lds, wid, lane); load_tile64(vb + k_lo * 64, S_, lds + 8192, wid, lane);
        wait_vm0(); __syncthreads();
        for (int it = 0; it < ntw; ++it) {
            unsigned char* cu = lds + (it & 1) * 16384;
            if (it + 1 < ntw) { unsigned char* nx = lds + ((it + 1) & 1) * 16384;
                load_tile64(kb + (size_t)(k_lo + it + 1) * 64 * LD, LD, nx, wid, lane); load_tile64(vb + (k_lo + it + 1) * 64, S_, nx + 8192, wid, lane); }
            nsa_tile<2, 2>(cu, cu + 8192, lds, Qf, O, m, l, k_lo + it, L, qrow);
            wait_vm0(); __syncthreads();
        }
    }
    bf16_t* YW = (bf16_t*)(ws + WS_YW) + tok * 512 + (4 * g) * 64;
#pragma unroll
    for (int nt = 0; nt < 4; ++nt) {
        const float lt = rows_sum(l[nt]), gt = bf2f(gates[nt * 3 + 2]) * (lt > 0.f ? 1.f / lt : 0.f);
#pragma unroll
        for (int mt = 0; mt < 4; ++mt) *(u32x2*)(YW + nt * 64 + 16 * mt + 4 * fq) = pack4(O[mt][nt] * gt);
    }
}

constexpr int SEL_RING = 8, SEL_BUCKET = SEL_RING * 16384, SEL_BIAS2 = SEL_BUCKET + 8192;
template <bool FAST>
__device__ __forceinline__ void sel_ntile(const bf16x8 (&Kf)[4][2], const unsigned char* vL, int fr, int fq, const bf16x8& q0, const bf16x8& q1, f32x4 (&O)[4], float& m, float& l,
                                          bool sb, int relb, int th, float blo, float bhi, const unsigned char* lds, int hl) {
    f32x4 S[4];
#pragma unroll
    for (int i = 0; i < 4; ++i) { S[i] = (f32x4){0.f, 0.f, 0.f, 0.f}; S[i] = mfma16(Kf[i][0], q0, S[i]); S[i] = mfma16(Kf[i][1], q1, S[i]); }
    float tmax = -1e30f;
    const float scl = (!FAST || sb) ? 0.125f * LOG2E : 0.f;
    if (FAST) { blo = (sb ? blo : -1e30f) - m; bhi = (sb ? bhi : -1e30f) - m; }
    if (FAST) {
#pragma unroll
        for (int i = 0; i < 4; ++i)
#pragma unroll
            for (int r = 0; r < 4; ++r) { const int rel = relb - (16 * i + r); S[i][r] = S[i][r] * scl + (rel >= th ? bhi : blo); tmax = fmaxf(tmax, S[i][r]); }
    } else {
        unsigned bkt[4][4]; float bs[4][4];
#pragma unroll
        for (int i = 0; i < 4; ++i)
#pragma unroll
            for (int r = 0; r < 4; ++r) { const int rel = relb - (16 * i + r); int rc = rel < 0 ? 0 : rel; rc = rc > 8191 ? 8191 : rc; bkt[i][r] = (lds + SEL_BUCKET)[rc]; }
#pragma unroll
        for (int i = 0; i < 4; ++i)
#pragma unroll
            for (int r = 0; r < 4; ++r) bs[i][r] = ((const float*)(lds + SEL_BIAS2))[hl * 32 + bkt[i][r]];
        asm volatile("" : "+v"(bs[0][0]), "+v"(bs[0][1]), "+v"(bs[0][2]), "+v"(bs[0][3]), "+v"(bs[1][0]), "+v"(bs[1][1]), "+v"(bs[1][2]), "+v"(bs[1][3]),
                          "+v"(bs[2][0]), "+v"(bs[2][1]), "+v"(bs[2][2]), "+v"(bs[2][3]), "+v"(bs[3][0]), "+v"(bs[3][1]), "+v"(bs[3][2]), "+v"(bs[3][3]));
        const float ninf = -1e30f;
#pragma unroll
        for (int i = 0; i < 4; ++i)
#pragma unroll
            for (int r = 0; r < 4; ++r) {
                const int rel = relb - (16 * i + r);
                const float sv = S[i][r] * (0.125f * LOG2E) + (bs[i][r] - m);
                S[i][r] = (sb && rel >= 0) ? sv : ninf; tmax = fmaxf(tmax, S[i][r]);
            }
    }
    tmax = rows_max(tmax);
    if (__ballot(tmax > 8.f) != 0ull) {
        const float d = fmaxf(tmax, 0.f), alpha = __builtin_amdgcn_exp2f(-d);
        m += d; l *= alpha;
#pragma unroll
        for (int mt = 0; mt < 4; ++mt) O[mt] = O[mt] * alpha;
#pragma unroll
        for (int i = 0; i < 4; ++i)
#pragma unroll
            for (int r = 0; r < 4; ++r) S[i][r] -= d;
    }
    float psum = 0.f;
#pragma unroll
    for (int i = 0; i < 4; ++i)
#pragma unroll
        for (int r = 0; r < 4; ++r) { const float pv = __builtin_amdgcn_exp2f(S[i][r]); S[i][r] = pv; psum += pv; }
    l += rows_sum(psum);
    const bf16x8 Pb0 = pack8(S[0], S[1]), Pb1 = pack8(S[2], S[3]);
#pragma unroll
    for (int mt = 0; mt < 4; ++mt) { O[mt] = mfma16(lds_vfrag128(vL, 16 * mt + fr, 0, fq), Pb0, O[mt]); O[mt] = mfma16(lds_vfrag128(vL, 16 * mt + fr, 32, fq), Pb1, O[mt]); }
}
__device__ __forceinline__ void sel_ntile2_fast(const bf16x8 (&Kf)[4][2], const unsigned char* vL, int fr, int fq, const bf16x8 (&Qf)[2][2], f32x4 (&O)[2][4], float (&m)[2], float (&l)[2],
                                                const bool (&sb)[2], const int (&relb)[2], int th, float blo, float bhi) {
    f32x4 S[2][4]; float tmax[2], bl[2], bh[2], scl[2];
#pragma unroll
    for (int b = 0; b < 2; ++b)
#pragma unroll
        for (int i = 0; i < 4; ++i) { S[b][i] = (f32x4){0.f, 0.f, 0.f, 0.f}; S[b][i] = mfma16(Kf[i][0], Qf[b][0], S[b][i]); S[b][i] = mfma16(Kf[i][1], Qf[b][1], S[b][i]); }
#pragma unroll
    for (int b = 0; b < 2; ++b) { scl[b] = sb[b] ? 0.125f * LOG2E : 0.f; bl[b] = (sb[b] ? blo : -1e30f) - m[b]; bh[b] = (sb[b] ? bhi : -1e30f) - m[b]; tmax[b] = -1e30f; }
#pragma unroll
    for (int b = 0; b < 2; ++b)
#pragma unroll
        for (int i = 0; i < 4; ++i)
#pragma unroll
            for (int r = 0; r < 4; ++r) { const int rel = relb[b] - (16 * i + r); S[b][i][r] = S[b][i][r] * scl[b] + (rel >= th ? bh[b] : bl[b]); tmax[b] = fmaxf(tmax[b], S[b][i][r]); }
#pragma unroll
    for (int b = 0; b < 2; ++b) tmax[b] = rows_max(tmax[b]);
    if (__ballot(tmax[0] > 8.f || tmax[1] > 8.f) != 0ull) {
#pragma unroll
        for (int b = 0; b < 2; ++b) {
            const float d = fmaxf(tmax[b], 0.f), alpha = __builtin_amdgcn_exp2f(-d);
            m[b] += d; l[b] *= alpha;
#pragma unroll
            for (int mt = 0; mt < 4; ++mt) O[b][mt] = O[b][mt] * alpha;
#pragma unroll
            for (int i = 0; i < 4; ++i)
#pragma unroll
                for (int r = 0; r < 4; ++r) S[b][i][r] -= d;
        }
    }
    float psum[2] = {0.f, 0.f};
#pragma unroll
    for (int b = 0; b < 2; ++b)
#pragma unroll
        for (int i = 0; i < 4; ++i)
#pragma unroll
            for (int r = 0; r < 4; ++r) { const float pv = __builtin_amdgcn_exp2f(S[b][i][r]); S[b][i][r] = pv; psum[b] += pv; }
#pragma unroll
    for (int b = 0; b < 2; ++b) l[b] += rows_sum(psum[b]);
    bf16x8 P0[2], P1[2];
#pragma unroll
    for (int b = 0; b < 2; ++b) { P0[b] = pack8(S[b][0], S[b][1]); P1[b] = pack8(S[b][2], S[b][3]); }
#pragma unroll
    for (int mt = 0; mt < 4; ++mt) {
        const bf16x8 v0 = lds_vfrag128(vL, 16 * mt + fr, 0, fq), v1 = lds_vfrag128(vL, 16 * mt + fr, 32, fq);
#pragma unroll
        for (int b = 0; b < 2; ++b) { O[b][mt] = mfma16(v0, P0[b], O[b][mt]); O[b][mt] = mfma16(v1, P1[b], O[b][mt]); }
    }
}
template <bool FAST>
__device__ __forceinline__ void sel_tile(const unsigned char* kL, const unsigned char* vL, const unsigned char* lds, const bf16x8 (&Qf)[2][2], f32x4 (&O)[2][4], float (&m)[2], float (&l)[2],
                                         const bool (&sb)[2], const bool (&need)[2], const int (&relb)[2], int th, float blo, float bhi, int hl, int fr, int fq) {
    bf16x8 Kf[4][2];
#pragma unroll
    for (int i = 0; i < 4; ++i)
#pragma unroll
        for (int ks = 0; ks < 2; ++ks) Kf[i][ks] = lds_frag128(kL, 16 * i + fr, 4 * ks + fq);
    if (FAST && need[0] && need[1]) { sel_ntile2_fast(Kf, vL, fr, fq, Qf, O, m, l, sb, relb, th, blo, bhi); return; }
    if (need[0]) sel_ntile<FAST>(Kf, vL, fr, fq, Qf[0][0], Qf[0][1], O[0], m[0], l[0], sb[0], relb[0], th, blo, bhi, lds, hl);
    if (need[1]) sel_ntile<FAST>(Kf, vL, fr, fq, Qf[1][0], Qf[1][1], O[1], m[1], l[1], sb[1], relb[1], th, blo, bhi, lds, hl);
}
template <int VAR>
__device__ __forceinline__ void sel_item(const Params& p, int v, unsigned char* lds) {
    unsigned char* ws = launder(p.ws);
    const int tid = ltid(), lane = tid & 63, wid = tid >> 6, fr = lane & 15, fq = lane >> 4;
    const int qt = 127 - (v >> 2), sub = v & 3, b = sub >> 1, g = sub & 1;
    const int q0 = qt * 64, cur = qt, hl = fr & 3;
    const bf16_t* P = (const bf16_t*)(ws + WS_P);
    __syncthreads();
    if (tid < 128) ((float*)(lds + SEL_BIAS2))[tid] = p.rel_bias[(tid & 31) * 8 + 4 * g + (tid >> 5)] * LOG2E;
    int t[2]; size_t tok[2]; bf16x8 Qf[2][2]; unsigned selw[2][4];
#pragma unroll
    for (int nt = 0; nt < 2; ++nt) {
        t[nt] = q0 + 8 * wid + 4 * nt + (fr >> 2); tok[nt] = (size_t)b * S_ + t[nt];
#pragma unroll
        for (int ks = 0; ks < 2; ++ks) Qf[nt][ks] = *(const bf16x8*)(P + tok[nt] * LD + C_QA + (4 * g + hl) * 64 + 32 * ks + 8 * fq);
        const u32x4 w = *(const u32x4*)((const unsigned*)(ws + WS_SELW) + (tok[nt] * 2 + g) * 4);
        selw[nt][0] = w.x; selw[nt][1] = w.y; selw[nt][2] = w.z; selw[nt][3] = w.w;
    }
    f32x4 O[2][4]; float m[2], l[2];
#pragma unroll
    for (int nt = 0; nt < 2; ++nt) { m[nt] = -1000.f; l[nt] = 0.f;
#pragma unroll
        for (int mt = 0; mt < 4; ++mt) O[nt][mt] = (f32x4){0.f, 0.f, 0.f, 0.f}; }
    const bf16_t* kb = P + ((size_t)b * S_) * LD + C_KS + g * 64;
    const bf16_t* vb = (const bf16_t*)(ws + WS_VST) + (size_t)(b * 2 + g) * 64 * S_;
    const int nts = cur + 1;
#define SEL_ISSUE(jj) do { unsigned char* st_ = lds + ((jj) & 7) * 16384; const int c_ = ((lane & 7) ^ (lane >> 3)) * 8, r_ = 8 * wid + (lane >> 3); \
        glds16(kb + ((size_t)(jj) * 64 + r_) * LD + c_, st_ + wid * 1024); glds16(vb + (size_t)r_ * S_ + (jj) * 64 + c_, st_ + 8192 + wid * 1024); } while (0)
    asm volatile("s_waitcnt vmcnt(0)" ::: "memory");
#pragma unroll
    for (int q = 0; q < 4; ++q) if (q < nts) SEL_ISSUE(q);
    const unsigned char* bucketL = lds + SEL_BUCKET;
    for (int jp = 0; jp < nts; jp += 4) {
        WAIT_V(0);
        RAW_BARRIER();
#pragma unroll
        for (int q = 4; q < 8; ++q) if (jp + q < nts) SEL_ISSUE(jp + q);
#pragma unroll 1
      for (int j = jp; j < jp + 4 && j < nts; ++j) {
        const unsigned char* cu = lds + (j & 7) * 16384;
        bool sb[2], need[2]; int relb[2];
#pragma unroll
        for (int nt = 0; nt < 2; ++nt) {
            const unsigned w = j < 32 ? selw[nt][0] : j < 64 ? selw[nt][1] : j < 96 ? selw[nt][2] : selw[nt][3];
            sb[nt] = (w >> (j & 31)) & 1u; need[nt] = __ballot(sb[nt]) != 0ull; relb[nt] = t[nt] - 64 * j - 4 * fq;
        }
        if (VAR == 1) { need[0] = false; need[1] = false; }
        if (VAR == 2) { if (!(need[0] || need[1])) { need[0] = false; } else { need[0] = true; need[1] = true; } }
        if (need[0] || need[1]) {
            const int rmin = q0 - 64 * j - 63, rmax = q0 + 31 - 64 * j;
            bool fast = false; int th = 0; float blo = 0.f, bhi = 0.f;
            if (rmin >= 16) {
                const int b0 = bucketL[rmin], b1 = bucketL[rmax > 8191 ? 8191 : rmax];
                if (b1 - b0 <= 1) { fast = true; th = t5_first(b1); if (b1 == b0) th = 0;
                    blo = ((const float*)(lds + SEL_BIAS2))[hl * 32 + b0]; bhi = ((const float*)(lds + SEL_BIAS2))[hl * 32 + b1]; }
            }
            if (fast) sel_tile<true>(cu, cu + 8192, lds, Qf, O, m, l, sb, need, relb, th, blo, bhi, hl, fr, fq);
            else sel_tile<false>(cu, cu + 8192, lds, Qf, O, m, l, sb, need, relb, th, blo, bhi, hl, fr, fq);
        }
      }
    }
#undef SEL_ISSUE
    __syncthreads();
#pragma unroll
    for (int nt = 0; nt < 2; ++nt) {
        const float gt = bf2f(P[tok[nt] * LD + C_GA + (4 * g + hl) * 3 + 1]) * (l[nt] > 0.f ? 1.f / l[nt] : 0.f);
        const size_t o = tok[nt] * 512 + (4 * g + hl) * 64;
#pragma unroll
        for (int mt = 0; mt < 4; ++mt) {
            const f32x4 yc = unpack4(*(const u32x2*)((const bf16_t*)(ws + WS_YC) + o + 16 * mt + 4 * fq));
            const f32x4 yw = unpack4(*(const u32x2*)((const bf16_t*)(ws + WS_YW) + o + 16 * mt + 4 * fq));
            if (VAR == 0 || VAR == 3) *(u32x2*)((bf16_t*)(ws + WS_YA) + tok[nt] * 1536 + (4 * g + hl) * 64 + 16 * mt + 4 * fq) = pack4(yc + yw + O[nt][mt] * gt);
            else asm volatile("" :: "v"(O[nt][mt]));
        }
    }
}

__device__ __forceinline__ void scan_item(const Params& p, int item, int half) {
    unsigned char* ws = launder(p.ws);
    const int idx = item * HT + (ltid() & 255);
    const int bh = idx >> 13, ed = idx & 8191, h = bh & 7;
    const float dec = exp2f(128.f * ret_lg2(h));
    const float* KVT = (const float*)(ws + WS_KVT) + (size_t)bh * 64 * 8192 + ed;
    bf16_t* SPT = (bf16_t*)(ws + WS_SPT) + (size_t)bh * 64 * 8192 + ed;
    float s = 0.f;
#pragma unroll
    for (int n0 = 0; n0 < 64; n0 += 32) {
        float kv[32];
#pragma unroll
        for (int n = 0; n < 32; ++n) kv[n] = KVT[(size_t)(n0 + n) * 8192];
#pragma unroll
        for (int n = 0; n < 32; ++n) { SPT[(size_t)(n0 + n) * 8192] = f2bf(s); s = s * dec + kv[n]; }
    }
}

__device__ __forceinline__ void phase_p3(const Params& p, unsigned char* lds, int half, int what) {
    for (int i = (ltid() & 255); i < 8192 / 16; i += HT) ((u32x4*)(lds + NSA_BUCKET))[i] = ((const u32x4*)(launder(p.ws) + WS_BUCKET))[i];
    __syncthreads();
    for (int h = (blockIdx.x * 2 + half); h < 512; h += (gridDim.x * 2)) {
        if (what & 1) cmp_item(p, h, lds, half);
        if (what & 2) {
            if (h >= 128 && h < 384) win_item(p, h - 128, lds, half);
            else if (h >= 384) { win_item(p, 256 + 2 * (h - 384) - ((h & 1) ? 1 : 0) , lds, half); win_item(p, 256 + 2 * (h - 384) + ((h & 1) ? 0 : 1) + 1 - ((h & 1) ? 0 : 0), lds, half); }
        }
        if (what & 4) scan_item(p, h, half);
    }
}

__device__ __forceinline__ void retout_item(const Params& p, int item, unsigned char* lds, int half) {
    unsigned char* ws = launder(p.ws);
    const int tid = (ltid() & 255), lane = tid & 63, wid = tid >> 6, fr = lane & 15, fq = lane >> 4;
    const int n = item & 63, h = (item >> 6) & 7, b = item >> 9;
    const size_t tok0 = (size_t)b * S_ + 128 * n;
    const bf16_t* P = (const bf16_t*)(ws + WS_P);
    unsigned char* vL = lds; unsigned char* kL = lds + 32768; unsigned char* sL = lds + 49152;
    __syncthreads();
    load_tile128w((const bf16_t*)(ws + WS_VRT) + ((size_t)(b * 8 + h) * 128) * S_ + 128 * n, S_, vL, wid, lane);
    load_tile128(P + tok0 * LD + C_KR + h * 64, LD, kL, wid, lane);
    load_tile128((const bf16_t*)(ws + WS_SPT) + ((size_t)(b * 8 + h) * 64 + n) * 8192, 64, sL, wid, lane);
    bf16x8 Qf[2][2];
#pragma unroll
    for (int nt = 0; nt < 2; ++nt)
#pragma unroll
        for (int ks = 0; ks < 2; ++ks) Qf[nt][ks] = *(const bf16x8*)(P + (tok0 + 32 * wid + 16 * nt + fr) * LD + C_QR + h * 64 + 32 * ks + 8 * fq);
    wait_vm0(); __syncthreads();
    const float lg2 = ret_lg2(h);
    f32x4 Y[8][2];
#pragma unroll
    for (int m = 0; m < 8; ++m)
#pragma unroll
        for (int nt = 0; nt < 2; ++nt) Y[m][nt] = (f32x4){0.f, 0.f, 0.f, 0.f};
#pragma unroll
    for (int m = 0; m < 8; ++m)
#pragma unroll
        for (int ks = 0; ks < 2; ++ks) {
            const bf16x8 a = lds_frag128(sL, 16 * m + fr, 4 * ks + fq);
#pragma unroll
            for (int nt = 0; nt < 2; ++nt) Y[m][nt] = mfma16(a, Qf[nt][ks], Y[m][nt]);
        }
#pragma unroll
    for (int nt = 0; nt < 2; ++nt) {
        const float sc = exp2f((float)(32 * wid + 16 * nt + fr + 1) * lg2);
#pragma unroll
        for (int m = 0; m < 8; ++m) Y[m][nt] = Y[m][nt] * sc;
    }
#pragma unroll 1
    for (int s = 0; s < 4; ++s) {
        f32x4 St[2][2];
#pragma unroll
        for (int hh = 0; hh < 2; ++hh) {
            const int mt = 2 * s + hh;
#pragma unroll
            for (int nt = 0; nt < 2; ++nt) St[hh][nt] = (f32x4){0.f, 0.f, 0.f, 0.f};
#pragma unroll
            for (int ks = 0; ks < 2; ++ks) {
                const bf16x8 a = lds_frag128(kL, 16 * mt + fr, 4 * ks + fq);
#pragma unroll
                for (int nt = 0; nt < 2; ++nt) St[hh][nt] = mfma16(a, Qf[nt][ks], St[hh][nt]);
            }
#pragma unroll
            for (int nt = 0; nt < 2; ++nt) {
                const int qi = 32 * wid + 16 * nt + fr;
#pragma unroll
                for (int r = 0; r < 4; ++r) {
                    const int kj = 16 * mt + 4 * fq + r;
                    const float dm = qi >= kj ? exp2f((float)(qi - kj) * lg2) : 0.f;
                    St[hh][nt][r] *= dm;
                }
            }
        }
        bf16x8 Pb[2];
#pragma unroll
        for (int nt = 0; nt < 2; ++nt) Pb[nt] = pack8(St[0][nt], St[1][nt]);
#pragma unroll
        for (int m = 0; m < 8; ++m) {
            const bf16x8 a = lds_vfrag256(vL, 16 * m + fr, 32 * s, fq);
#pragma unroll
            for (int nt = 0; nt < 2; ++nt) Y[m][nt] = mfma16(a, Pb[nt], Y[m][nt]);
        }
    }
    bf16_t* YB = (bf16_t*)(ws + WS_YA) + 512;
#pragma unroll
    for (int nt = 0; nt < 2; ++nt) {
        float sum = 0.f;
#pragma unroll
        for (int m = 0; m < 8; ++m) sum += Y[m][nt][0] + Y[m][nt][1] + Y[m][nt][2] + Y[m][nt][3];
        sum = rows_sum(sum);
        const float mu = sum * (1.f / 128.f);
        float vs = 0.f;
#pragma unroll
        for (int m = 0; m < 8; ++m)
#pragma unroll
            for (int r = 0; r < 4; ++r) { const float dlt = Y[m][nt][r] - mu; vs += dlt * dlt; }
        vs = rows_sum(vs);
        const float rstd = rsqrtf(vs * (1.f / 128.f) + 1e-5f);
        const size_t tk = tok0 + 32 * wid + 16 * nt + fr;
#pragma unroll
        for (int m = 0; m < 8; ++m) {
            const f32x4 gt = unpack4(*(const u32x2*)(P + tk * LD + C_GR + h * 128 + 16 * m + 4 * fq));
            f32x4 v;
#pragma unroll
            for (int r = 0; r < 4; ++r) v[r] = (Y[m][nt][r] - mu) * rstd * gt[r];
            *(u32x2*)(YB + tk * 1536 + h * 128 + 16 * m + 4 * fq) = pack4(v);
        }
    }
}
__device__ __forceinline__ void phase_p4_sel(const Params& p, unsigned char* lds) {
    for (int i = ltid(); i < 8192 / 16; i += NTHREADS) ((u32x4*)(lds + SEL_BUCKET))[i] = ((const u32x4*)(launder(p.ws) + WS_BUCKET))[i];
    __syncthreads();
    for (int it = blockIdx.x; it < 512; it += gridDim.x * 2) {
        sel_item<0>(p, it, lds);
        if (511 - it != it) sel_item<0>(p, 511 - it, lds);
    }
    __syncthreads();
}
__device__ __forceinline__ void phase_p4(const Params& p, unsigned char* lds, int half) {
    for (int it = (blockIdx.x * 2 + half); it < 1024; it += (gridDim.x * 2)) retout_item(p, it, lds, half);
}

struct RowOrder {     typedef pg8::Unit U; static constexpr bool GATHER = false;
    unsigned a, b; int K, xcd, slot, per;
    __device__ __forceinline__ bool next(int i, pg8::Unit& u) const { const int t = xcd * 32 + slot + i * per; if (t >= (xcd + 1) * 32) return false; u.pm = t >> 2; u.pn = t & 3; return true; }
    __device__ __forceinline__ void ptrs(const pg8::Unit& u, unsigned& A, unsigned& B) const { A = a + (unsigned)u.pm * 512u * (unsigned)K; B = b + (unsigned)u.pn * 512u * (unsigned)K; }
};
template <int MODE>
struct MixEpi {
    static constexpr int MID_T = MODE == 0 ? 8 : 0;
    unsigned char* ws; const float* X;
    __device__ __forceinline__ void mid(f32x4 (&acc)[2][2][4][2], const pg8::Unit& u, int wr, int wc, int fr, int fq) const {
#pragma unroll
        for (int ai = 0; ai < 2; ++ai) {
            __builtin_amdgcn_sched_barrier(0);
#pragma unroll
            for (int m = 0; m < 4; ++m) {
                const size_t tok = (size_t)(u.pm * 256 + 128 * ai + 64 * wr + 16 * m + fr + vzero());
#pragma unroll
                for (int bj = 0; bj < 2; ++bj) {
                    const int n = u.pn * 256 + 128 * bj + 32 * wc + 8 * fq;
                    const u32x4 ga = *(const u32x4*)((const bf16_t*)(ws + WS_P) + tok * LD + C_MA + n), gb = *(const u32x4*)((const bf16_t*)(ws + WS_P) + tok * LD + C_MB + n);
                    const f32x4 a0 = unpack4((u32x2){ga.x, ga.y}), a1 = unpack4((u32x2){ga.z, ga.w}), b0 = unpack4((u32x2){gb.x, gb.y}), b1 = unpack4((u32x2){gb.z, gb.w});
#pragma unroll
                    for (int r = 0; r < 4; ++r) { acc[ai][bj][m][0][r] *= a0[r] * __builtin_amdgcn_rcpf(fmaxf(b0[r], 1e-30f)); acc[ai][bj][m][1][r] *= a1[r] * __builtin_amdgcn_rcpf(fmaxf(b1[r], 1e-30f)); }
                }
            }
        }
        __builtin_amdgcn_sched_barrier(0);
    }
    __device__ __forceinline__ void operator()(const f32x4 (&acc)[2][2][4][2], const pg8::Unit& u, int wr, int wc, int fr, int fq) const {
#pragma unroll
        for (int ai = 0; ai < 2; ++ai)
#pragma unroll
            for (int m = 0; m < 4; ++m) {
                const size_t tok = (size_t)(u.pm * 256 + 128 * ai + 64 * wr + 16 * m + fr + vzero());
#pragma unroll
                for (int bj = 0; bj < 2; ++bj) {
                    const int n = u.pn * 256 + 128 * bj + 32 * wc + 8 * fq;
                    const f32x4 v0 = acc[ai][bj][m][0], v1 = acc[ai][bj][m][1];
                    if (MODE == 2) {
                        const u32x4 xw = *(const u32x4*)((const bf16_t*)(ws + WS_XB) + tok * 1024 + n);
                        const f32x4 h0 = unpack4((u32x2){xw.x, xw.y}) * DN_ALPHA + v0, h1 = unpack4((u32x2){xw.z, xw.w}) * DN_ALPHA + v1;
                        u32x4 w; w.x = pack2(h0[0], h0[1]); w.y = pack2(h0[2], h0[3]); w.z = pack2(h1[0], h1[1]); w.w = pack2(h1[2], h1[3]);
                        *(u32x4*)((bf16_t*)(ws + WS_H1) + tok * 1024 + n) = w;
                    } else {
                        const u32x4 gw = *(const u32x4*)((const bf16_t*)(ws + WS_P) + tok * LD + C_MB + n);
                        const f32x4 g0 = unpack4((u32x2){gw.x, gw.y}), g1 = unpack4((u32x2){gw.z, gw.w});
                        const f32x4 o0 = g0 * v0, o1 = g1 * v1;
                        u32x4 w; w.x = pack2(o0[0], o0[1]); w.y = pack2(o0[2], o0[3]); w.z = pack2(o1[0], o1[1]); w.w = pack2(o1[2], o1[3]);
                        *(u32x4*)((bf16_t*)(ws + WS_MG) + tok * 1024 + n) = w;
                    }
                }
            }
    }
};
__device__ __forceinline__ void phase_g2(const Params& p, unsigned char* lds) {
    unsigned char* ws = launder(p.ws);
    RowOrder S; S.xcd = blockIdx.x & 7; S.slot = blockIdx.x >> 3; S.per = gridDim.x >> 3;
    S.a = (unsigned)WS_YA; S.b = (unsigned)WS_WA; S.K = 1536; MixEpi<0> E; E.ws = ws; E.X = nullptr;
    pg8::gemm_phase<MixEpi<0>, RowOrder>(lds, 1536, S, E, ltid(), ws);
}
__device__ __forceinline__ void phase_g3(const Params& p, int layer, unsigned char* lds) {
    unsigned char* ws = launder(p.ws);
    RowOrder S; S.xcd = blockIdx.x & 7; S.slot = blockIdx.x >> 3; S.per = gridDim.x >> 3; S.a = (unsigned)WS_MG; S.b = (unsigned)WS_WO; S.K = 1024;
    MixEpi<2> E; E.ws = ws; E.X = nullptr;
    pg8::gemm_phase<MixEpi<2>, RowOrder>(lds, 1024, S, E, ltid(), ws);
}

__device__ __forceinline__ void phase_ln1(const Params& p, int layer, unsigned char* lds, bool dry, int half) {
    unsigned char* ws = launder(p.ws);
    const int tid = (ltid() & 255), lane = tid & 63, wid = tid >> 6;
    float* wrL = (float*)lds;
    float* lgL = (float*)(lds - half * HALF_LDS + 65536);
    {
        float4 wv[16];
#pragma unroll
        for (int k = 0; k < 16; ++k) wv[k] = ((const float4*)p.w_router)[tid + 256 * k];
#pragma unroll
        for (int k = 0; k < 16; ++k) { const int i4 = tid + 256 * k, d = i4 >> 2, e0 = (i4 & 3) * 4;
            wrL[(e0 + 0) * 1024 + d] = wv[k].x; wrL[(e0 + 1) * 1024 + d] = wv[k].y; wrL[(e0 + 2) * 1024 + d] = wv[k].z; wrL[(e0 + 3) * 1024 + d] = wv[k].w; }
    }
    __syncthreads();
    const bf16_t* H1 = (const bf16_t*)(ws + WS_H1);
    bf16_t* X1B = (bf16_t*)(ws + WS_X1B);
    const float* gam = p.ln1_g + layer * 1024; const float* bet = p.ln1_b + layer * 1024;
    unsigned* cnt = (unsigned*)(ws + WS_CTL) + (dry ? 0 : CW_CNT) + layer * 1024;
    int* LIST = (int*)(ws + (dry ? WS_HB : WS_LIST)); float* WTS = (float*)(ws + (dry ? WS_HB + 4194304 : WS_WTS));
    constexpr int U = 4;
    const int nwave = (gridDim.x * 2) * 4, wv = (blockIdx.x * 2 + half) * 4 + wid;
    const int nloc = ((T_ - wv * U + nwave * U - 1) / (nwave * U)) * (4 * U);
    u32x2 vn[U][4];
#pragma unroll
    for (int u = 0; u < U; ++u)
#pragma unroll
        for (int j = 0; j < 4; ++j) vn[u][j] = *(const u32x2*)(H1 + (size_t)(wv * U + u) * 1024 + 256 * j + 4 * lane);
    for (int t0 = wv * U; t0 < T_; t0 += nwave * U) {
        float4 y[U][4]; float s[U], q[U];
#pragma unroll
        for (int u = 0; u < U; ++u) {
            s[u] = 0.f;
#pragma unroll
            for (int j = 0; j < 4; ++j) { const f32x4 t = unpack4(vn[u][j]); y[u][j].x = t[0]; y[u][j].y = t[1]; y[u][j].z = t[2]; y[u][j].w = t[3]; s[u] += (t[0] + t[1]) + (t[2] + t[3]); }
        }
        { const int tn = t0 + nwave * U < T_ ? t0 + nwave * U : t0;
#pragma unroll
          for (int u = 0; u < U; ++u)
#pragma unroll
              for (int j = 0; j < 4; ++j) vn[u][j] = *(const u32x2*)(H1 + (size_t)(tn + u) * 1024 + 256 * j + 4 * lane); }
#pragma unroll
        for (int u = 0; u < U; ++u) s[u] = wave_sum(s[u]) * (1.f / 1024.f);
#pragma unroll
        for (int u = 0; u < U; ++u) {
            q[u] = 0.f;
#pragma unroll
            for (int j = 0; j < 4; ++j) { const float a = y[u][j].x - s[u], b2 = y[u][j].y - s[u], c = y[u][j].z - s[u], d = y[u][j].w - s[u]; q[u] += a * a + b2 * b2 + c * c + d * d; }
        }
#pragma unroll
        for (int u = 0; u < U; ++u) q[u] = rsqrtf(wave_sum(q[u]) * (1.f / 1024.f) + 1e-5f);
#pragma unroll
        for (int j = 0; j < 4; ++j) {
            const int d0 = 256 * j + 4 * lane;
            const float4 gg = *(const float4*)(gam + d0), bb = *(const float4*)(bet + d0);
#pragma unroll
            for (int u = 0; u < U; ++u) {
                y[u][j].x = (y[u][j].x - s[u]) * q[u] * gg.x + bb.x; y[u][j].y = (y[u][j].y - s[u]) * q[u] * gg.y + bb.y;
                y[u][j].z = (y[u][j].z - s[u]) * q[u] * gg.z + bb.z; y[u][j].w = (y[u][j].w - s[u]) * q[u] * gg.w + bb.w;
                u32x2 w; w.x = pack2(y[u][j].x, y[u][j].y); w.y = pack2(y[u][j].z, y[u][j].w);
                *(u32x2*)(X1B + (size_t)(t0 + u) * 1024 + d0) = w;
            }
        }
        float lg[U][16];
#pragma unroll
        for (int e = 0; e < 16; ++e) {
#pragma unroll
            for (int u = 0; u < U; ++u) lg[u][e] = 0.f;
#pragma unroll
            for (int j = 0; j < 4; ++j) { const float4 w4 = *(const float4*)(wrL + e * 1024 + 256 * j + 4 * lane);
#pragma unroll
                for (int u = 0; u < U; ++u) lg[u][e] += y[u][j].x * w4.x + y[u][j].y * w4.y + y[u][j].z * w4.z + y[u][j].w * w4.w; }
        }
        float myl = 0.f;
#pragma unroll
        for (int u = 0; u < U; ++u) {
            float w8[8], z4[4];
#pragma unroll
            for (int e = 0; e < 8; ++e) { const u32x2 r = __builtin_amdgcn_permlane32_swap(__float_as_uint(lg[u][e]), __float_as_uint(lg[u][e + 8]), false, false); w8[e] = __uint_as_float(r.x) + __uint_as_float(r.y); }
#pragma unroll
            for (int e = 0; e < 4; ++e) { const u32x2 r = __builtin_amdgcn_permlane16_swap(__float_as_uint(w8[e]), __float_as_uint(w8[e + 4]), false, false); z4[e] = __uint_as_float(r.x) + __uint_as_float(r.y); }
            const bool h8 = (lane & 8) != 0, h4 = (lane & 4) != 0;
            const float k0 = h8 ? z4[2] : z4[0], s0 = h8 ? z4[0] : z4[2], k1 = h8 ? z4[3] : z4[1], s1 = h8 ? z4[1] : z4[3];
            const float y0 = k0 + __int_as_float(__builtin_amdgcn_mov_dpp(__float_as_int(s0), 0x128, 0xF, 0xF, true));
            const float y1 = k1 + __int_as_float(__builtin_amdgcn_mov_dpp(__float_as_int(s1), 0x128, 0xF, 0xF, true));
            const float k2 = h4 ? y1 : y0, s2 = h4 ? y0 : y1;
            float x = k2 + __int_as_float(__builtin_amdgcn_mov_dpp(__float_as_int(s2), 0x141, 0xF, 0xF, true));
            x += __int_as_float(__builtin_amdgcn_mov_dpp(__float_as_int(x), 0xB1, 0xF, 0xF, true));
            x += __int_as_float(__builtin_amdgcn_mov_dpp(__float_as_int(x), 0x4E, 0xF, 0xF, true));
            if ((lane & 3) == u) myl = x;
        }
        static_assert(U == 4, "lane (l & 3) stores token u = l & 3");
        lgL[(half * nloc + ((t0 - wv * U) / (nwave * U)) * (4 * U) + wid * U + (lane & 3)) * 17 + (lane >> 2)] = myl;
    }
    __syncthreads();
    if (half == 0 && wid == 0)
    for (int l0 = 0; l0 < 2 * nloc; l0 += 64) {
        const int li = l0 + lane; const bool act = li < 2 * nloc;
        const int hq = li >= nloc ? 1 : 0, lh = li - hq * nloc;
        const int it = lh / (4 * U), wq = (lh / U) & 3, uq = lh % U, tok = act ? (((blockIdx.x * 2 + hq) * 4 + wq) * U + uq) + it * (nwave * U) : 0;
        float lgv[16];
#pragma unroll
        for (int e = 0; e < 16; ++e) lgv[e] = lgL[li * 17 + e];
        float mx = lgv[0];
#pragma unroll
        for (int e = 1; e < 16; ++e) mx = fmaxf(mx, lgv[e]);
        float pr[16], ps = 0.f;
#pragma unroll
        for (int e = 0; e < 16; ++e) { pr[e] = expf(lgv[e] - mx); ps += pr[e]; }
        const float ips = 1.f / ps;
        float sel[16];
#pragma unroll
        for (int e = 0; e < 16; ++e) { pr[e] *= ips; sel[e] = pr[e] + p.router_bias[e]; }
        int best = 0; float bestv = -1e30f;
#pragma unroll
        for (int gI = 0; gI < 4; ++gI) {
            float a = -1e30f, b2 = -1e30f;
#pragma unroll
            for (int k = 0; k < 4; ++k) { const float x = sel[4 * gI + k]; if (x > a) { b2 = a; a = x; } else if (x > b2) b2 = x; }
            const float gs = a + b2;
            if (gs > bestv) { bestv = gs; best = gI; }
        }
        float s4[4], p4[4];
#pragma unroll
        for (int k = 0; k < 4; ++k) { s4[k] = 0.f; p4[k] = 0.f; }
#pragma unroll
        for (int gI = 0; gI < 4; ++gI) if (gI == best) {
#pragma unroll
            for (int k = 0; k < 4; ++k) { s4[k] = sel[4 * gI + k]; p4[k] = pr[4 * gI + k]; }
        }
        int i0 = 0; float a0 = s4[0];
#pragma unroll
        for (int k = 1; k < 4; ++k) if (s4[k] > a0) { a0 = s4[k]; i0 = k; }
        int i1 = -1; float a1 = -1e30f;
#pragma unroll
        for (int k = 0; k < 4; ++k) if (k != i0 && s4[k] > a1) { a1 = s4[k]; i1 = k; }
        float w0 = 0.f, w1 = 0.f;
#pragma unroll
        for (int k = 0; k < 4; ++k) { if (k == i0) w0 = p4[k]; if (k == i1) w1 = p4[k]; }
        const float iw = 1.f / (w0 + w1);
        const int e0 = act ? best * 4 + i0 : -1, e1 = act ? best * 4 + i1 : -1;
        unsigned myc = 0, r0 = 0, r1 = 0;
#pragma unroll
        for (int e = 0; e < 16; ++e) {
            const unsigned long long m0 = __builtin_amdgcn_ballot_w64(e0 == e), m1 = __builtin_amdgcn_ballot_w64(e1 == e);
            const unsigned c0 = (unsigned)__builtin_popcountll(m0), c = c0 + (unsigned)__builtin_popcountll(m1);
            if (lane == e) myc = c;
            if (e0 == e) r0 = __builtin_amdgcn_mbcnt_hi((unsigned)(m0 >> 32), __builtin_amdgcn_mbcnt_lo((unsigned)m0, 0u));
            if (e1 == e) r1 = c0 + __builtin_amdgcn_mbcnt_hi((unsigned)(m1 >> 32), __builtin_amdgcn_mbcnt_lo((unsigned)m1, 0u));
        }
        unsigned mybase = 0;
        if (lane < 16 && myc != 0) mybase = atomicAdd(&cnt[lane * 64], myc);
        unsigned b0 = 0, b1 = 0;
#pragma unroll
        for (int e = 0; e < 16; ++e) { const unsigned be = (unsigned)__builtin_amdgcn_readlane((int)mybase, e); if (e0 == e) b0 = be; if (e1 == e) b1 = be; }
        if (act) {
            LIST[(size_t)e0 * T_ + b0 + r0] = tok * 2; LIST[(size_t)e1 * T_ + b1 + r1] = tok * 2 + 1;
            WTS[tok * 2] = w0 * iw; WTS[tok * 2 + 1] = w1 * iw;
        }
    }
}

struct MoeUnit { int e, rt, ct, cnt, off; };
struct MoeOrderBase {
    const unsigned* cntp; int t_lo, t_hi, slot, per;
    __device__ __forceinline__ void init(const unsigned* cnt) {
        cntp = cnt; int ntile = 0;
#pragma unroll
        for (int k = 0; k < NE; ++k) ntile += (__builtin_amdgcn_readfirstlane((int)cnt[k * 64]) >> 8) * 4;
        t_lo = (ntile * (int)(blockIdx.x & 7)) >> 3; t_hi = (ntile * (int)((blockIdx.x & 7) + 1)) >> 3; slot = blockIdx.x >> 3; per = gridDim.x >> 3;
    }
    __device__ __forceinline__ bool next(int i, MoeUnit& u) const {
        const int t = t_lo + slot + i * per; if (t >= t_hi) return false;
        int base = 0, off = 0; bool found = false;
#pragma unroll
        for (int k = 0; k < NE; ++k) {
            const int ck = __builtin_amdgcn_readfirstlane((int)cntp[k * 64]), nt = (ck >> 8) * 4;
            if (!found && t < base + nt) { found = true; u.e = k; u.cnt = ck; u.off = off; u.rt = (t - base) >> 2; u.ct = (t - base) & 3; }
            base += nt; off += ck;
        }
        return found;
    }
};
struct M2Order : MoeOrderBase {
    typedef MoeUnit U; static constexpr bool GATHER = true;
    const int* list;
    __device__ __forceinline__ void ptrs(const MoeUnit& u, unsigned& A, unsigned& B) const { A = (unsigned)WS_X1B; B = (unsigned)WS_WG + ((unsigned)u.e * 1024u + (unsigned)u.ct * 256u) * 2048u; }
    __device__ __forceinline__ void rows(const MoeUnit& u, int tid, unsigned (&v)[2]) const {
        v[0] = 0u; v[1] = 0u;
#pragma unroll
        for (int i = 0; i < 2; ++i) { int R, C; pg8::stage_rc((tid + vzero()) * 16 + i * 8192, R, C);
#pragma unroll
            for (int h = 0; h < 2; ++h) { int idx = u.rt * 256 + 128 * h + R; idx = idx < u.cnt ? idx : u.cnt - 1; const int a = (list + (size_t)u.e * T_)[idx]; v[h] |= (unsigned)(a >> 1) << (16 * i); } }
    }
};
struct M3Order : MoeOrderBase {
    typedef MoeUnit U; static constexpr bool GATHER = false;
    __device__ __forceinline__ void ptrs(const MoeUnit& u, unsigned& A, unsigned& B) const { A = (unsigned)WS_HB + ((unsigned)u.off + (unsigned)u.rt * 256u) * 1024u; B = (unsigned)WS_WD + ((unsigned)u.e * 1024u + (unsigned)u.ct * 256u) * 1024u; }
};
struct M2Epi {
    static constexpr int MID_T = 0;
    unsigned char* ws;
    __device__ __forceinline__ void operator()(const f32x4 (&acc)[2][2][4][2], const MoeUnit& u, int wr, int wc, int fr, int fq) const {
        bf16_t* HB = (bf16_t*)(ws + WS_HB);
#pragma unroll
        for (int ai = 0; ai < 2; ++ai)
#pragma unroll
            for (int m = 0; m < 4; ++m) {
                const int idx = u.rt * 256 + 128 * ai + 64 * wr + 16 * m + fr + vzero();
                if (idx < u.cnt) {
#pragma unroll
                    for (int bj = 0; bj < 2; ++bj) {
                        const int hcol = 4 * (32 * u.ct + 16 * bj + 4 * wc + fq);
                        const f32x4 gv = acc[ai][bj][m][0], uv = acc[ai][bj][m][1]; f32x4 hv;
#pragma unroll
                        for (int r = 0; r < 4; ++r) hv[r] = gv[r] * fsig(gv[r]) * uv[r];
                        *(u32x2*)(HB + (size_t)(u.off + idx) * 512 + hcol) = pack4(hv);
                    }
                }
            }
    }
};
struct M3Epi {
    static constexpr int MID_T = 0;
    unsigned char* ws; const int* list;
    __device__ __forceinline__ void operator()(const f32x4 (&acc)[2][2][4][2], const MoeUnit& u, int wr, int wc, int fr, int fq) const {
        bf16_t* CT = (bf16_t*)(ws + WS_CT);
#pragma unroll
        for (int ai = 0; ai < 2; ++ai)
#pragma unroll
            for (int m = 0; m < 4; ++m) {
                const int idx = u.rt * 256 + 128 * ai + 64 * wr + 16 * m + fr + vzero();
                if (idx < u.cnt) {
                    const int a = list[(size_t)u.e * T_ + idx];
#pragma unroll
                    for (int bj = 0; bj < 2; ++bj) {
                        const int n = u.ct * 256 + 128 * bj + 32 * wc + 8 * fq;
                        const f32x4 v0 = acc[ai][bj][m][0], v1 = acc[ai][bj][m][1];
                        u32x4 w; w.x = pack2(v0[0], v0[1]); w.y = pack2(v0[2], v0[3]); w.z = pack2(v1[0], v1[1]); w.w = pack2(v1[2], v1[3]);
                        *(u32x4*)(CT + (size_t)a * 1024 + n) = w;
                    }
                }
            }
    }
};
template <int MODE>
__device__ __forceinline__ void moe_rem_item(unsigned char* ws, const int* list, int e, int cnt, int off, int rh, int c64, unsigned char* lds) {
    constexpr int K = MODE == 0 ? 1024 : 512, NS = K / 64;
    const int tid = (ltid() & 255), lane = tid & 63, wid = tid >> 6, wr = wid >> 1, wc = wid & 1, fr = lane & 15, fq = lane >> 4;
    const int idx0 = (cnt & ~255) + 128 * rh;
    const int ldc = ((lane & 7) ^ (lane >> 3)) * 8;
    const bf16_t* ap[4];
#pragma unroll
    for (int i = 0; i < 4; ++i) {
        int idx = idx0 + 32 * i + 8 * wid + (lane >> 3); idx = idx < cnt ? idx : cnt - 1;
        if (MODE == 0) { const int a = list[(size_t)e * T_ + idx]; ap[i] = (const bf16_t*)(ws + WS_X1B) + (size_t)(a >> 1) * 1024 + ldc; }
        else ap[i] = (const bf16_t*)(ws + WS_HB) + (size_t)(off + idx) * 512 + ldc;
    }
    const bf16_t* bp[2];
#pragma unroll
    for (int i = 0; i < 2; ++i) {
        const int rho = 8 * (wid + 4 * i) + (lane >> 3), src = (rho & ~31) + pg8::perm32(rho & 31);
        bp[i] = (const bf16_t*)(ws + (MODE == 0 ? WS_WG : WS_WD)) + ((size_t)e * 1024 + 64 * c64 + src) * K + ldc;
    }
    f32x4 acc[4][2];
#pragma unroll
    for (int i = 0; i < 4; ++i)
#pragma unroll
        for (int j = 0; j < 2; ++j) acc[i][j] = (f32x4){0.f, 0.f, 0.f, 0.f};
    __syncthreads();
#define RSTAGE(buf, l) do { unsigned char* st_ = lds + (buf) * 24576; \
        _Pragma("unroll") for (int i = 0; i < 4; ++i) glds16(ap[i] + (l) * 64, st_ + (4 * i + wid) * 1024); \
        _Pragma("unroll") for (int i = 0; i < 2; ++i) glds16(bp[i] + (l) * 64, st_ + 16384 + (wid + 4 * i) * 1024); } while (0)
    RSTAGE(0, 0); RSTAGE(1, 1);
    for (int l = 0; l < NS; ++l) {
        const unsigned char* st = lds + (l % 3) * 24576;
        if (l + 1 < NS) WAIT_V(6); else WAIT_V(0);
        RAW_BARRIER();
        if (l + 2 < NS) RSTAGE((l + 2) % 3, l + 2);
#pragma unroll
        for (int ks = 0; ks < 2; ++ks) {
            bf16x8 a[4], bb[2];
#pragma unroll
            for (int i = 0; i < 4; ++i) a[i] = lds_frag128(st, 64 * wr + 16 * i + fr, 4 * ks + fq);
#pragma unroll
            for (int j = 0; j < 2; ++j) bb[j] = lds_frag128(st + 16384, 32 * wc + 16 * j + fr, 4 * ks + fq);
#pragma unroll
            for (int i = 0; i < 4; ++i)
#pragma unroll
                for (int j = 0; j < 2; ++j) acc[i][j] = mfma16(bb[j], a[i], acc[i][j]);
        }
    }
#undef RSTAGE
#pragma unroll
    for (int i = 0; i < 4; ++i) {
        const int idx = idx0 + 64 * wr + 16 * i + fr + vzero();
        if (idx < cnt) {
            if (MODE == 0) {
                f32x4 hv;
#pragma unroll
                for (int r = 0; r < 4; ++r) hv[r] = acc[i][0][r] * fsig(acc[i][0][r]) * acc[i][1][r];
                *(u32x2*)((bf16_t*)(ws + WS_HB) + (size_t)(off + idx) * 512 + 32 * c64 + 16 * wc + 4 * fq) = pack4(hv);
            } else {
                const int a = list[(size_t)e * T_ + idx];
                const f32x4 v0 = acc[i][0], v1 = acc[i][1];
                u32x4 w; w.x = pack2(v0[0], v0[1]); w.y = pack2(v0[2], v0[3]); w.z = pack2(v1[0], v1[1]); w.w = pack2(v1[2], v1[3]);
                *(u32x4*)((bf16_t*)(ws + WS_CT) + (size_t)a * 1024 + 64 * c64 + 32 * wc + 8 * fq) = w;
            }
        }
    }
    __syncthreads();
}
template <int MODE>
__device__ __forceinline__ void moe_rem(const unsigned* cntp, unsigned char* ws, const int* list, unsigned char* ldsh, int half) {
    for (int t = blockIdx.x * 2 + half; ; t += gridDim.x * 2) {
        int base = 0, off = 0, e = -1, cnt = 0, eoff = 0, loc = 0;
#pragma unroll
        for (int k = 0; k < NE; ++k) {
            const int ck = __builtin_amdgcn_readfirstlane((int)cntp[k * 64]), ni = (((ck & 255) + 127) >> 7) * 16;
            if (e < 0 && t < base + ni) { e = k; cnt = ck; eoff = off; loc = t - base; }
            base += ni; off += ck;
        }
        if (e < 0) break;
        moe_rem_item<MODE>(ws, list, e, cnt, eoff, loc >> 4, loc & 15, ldsh);
    }
}
__device__ __forceinline__ void phase_m2(const Params& p, int layer, unsigned char* lds, unsigned char* ldsh, int half) {
    unsigned char* ws = launder(p.ws);
    M2Order S; S.init((const unsigned*)(ws + WS_CTL) + CW_CNT + layer * 1024 + vzero());
    S.list = (const int*)(ws + WS_LIST);
    M2Epi E; E.ws = ws;
    pg8::gemm_phase<M2Epi, M2Order>(lds, 1024, S, E, ltid(), ws);
    moe_rem<0>(S.cntp, ws, S.list, ldsh, half);
}
__device__ __forceinline__ void phase_m3(const Params& p, int layer, unsigned char* lds, unsigned char* ldsh, int half) {
    unsigned char* ws = launder(p.ws);
    M3Order S; S.init((const unsigned*)(ws + WS_CTL) + CW_CNT + layer * 1024 + vzero());
    M3Epi E; E.ws = ws; E.list = (const int*)(ws + WS_LIST);
    pg8::gemm_phase<M3Epi, M3Order>(lds, 512, S, E, ltid(), ws);
    moe_rem<1>(S.cntp, ws, E.list, ldsh, half);
}

__device__ __forceinline__ void phase_ln2(const Params& p, int layer, int half) {
    unsigned char* ws = launder(p.ws);
    const int tid = (ltid() & 255), lane = tid & 63, wid = tid >> 6;
    const bf16_t* X1 = (const bf16_t*)(ws + WS_X1B); const bf16_t* CT = (const bf16_t*)(ws + WS_CT); const float* WTS = (const float*)(ws + WS_WTS);
    float* XO = p.out; bf16_t* XB = (bf16_t*)(ws + WS_XB); const bool fin = layer == NLAYER - 1;
    const float* gam = p.ln2_g + layer * 1024; const float* bet = p.ln2_b + layer * 1024;
    constexpr int U = 4;
    const int nwave = (gridDim.x * 2) * 4, wv = (blockIdx.x * 2 + half) * 4 + wid;
    for (int t0 = wv * U; t0 < T_; t0 += nwave * U) {
        float4 v[U][4]; float s[U], q[U];
#pragma unroll
        for (int u = 0; u < U; ++u) {
            const int tok = t0 + u;
            const float w0 = WTS[tok * 2 + vzero()], w1 = WTS[tok * 2 + 1 + vzero()];
            s[u] = 0.f; q[u] = 0.f;
#pragma unroll
            for (int j = 0; j < 4; ++j) {
                const int d0 = 256 * j + 4 * lane;
                const f32x4 xt = unpack4(*(const u32x2*)(X1 + (size_t)tok * 1024 + d0)); float4 xv; xv.x = xt[0]; xv.y = xt[1]; xv.z = xt[2]; xv.w = xt[3];
                const f32x4 c0 = unpack4(*(const u32x2*)(CT + (size_t)(tok * 2) * 1024 + d0)), c1 = unpack4(*(const u32x2*)(CT + (size_t)(tok * 2 + 1) * 1024 + d0));
                v[u][j].x = xv.x * DN_ALPHA + w0 * c0[0] + w1 * c1[0]; v[u][j].y = xv.y * DN_ALPHA + w0 * c0[1] + w1 * c1[1];
                v[u][j].z = xv.z * DN_ALPHA + w0 * c0[2] + w1 * c1[2]; v[u][j].w = xv.w * DN_ALPHA + w0 * c0[3] + w1 * c1[3];
                s[u] += v[u][j].x + v[u][j].y + v[u][j].z + v[u][j].w;
                q[u] += v[u][j].x * v[u][j].x + v[u][j].y * v[u][j].y + v[u][j].z * v[u][j].z + v[u][j].w * v[u][j].w;
            }
        }
#pragma unroll
        for (int u = 0; u < U; ++u) { s[u] = wave_sum(s[u]); q[u] = wave_sum(q[u]); }
#pragma unroll
        for (int j = 0; j < 4; ++j) {
            const int d0 = 256 * j + 4 * lane;
            const float4 gg = *(const float4*)(gam + d0), bb = *(const float4*)(bet + d0);
#pragma unroll
            for (int u = 0; u < U; ++u) {
                const int tok = t0 + u;
                const float mu = s[u] * (1.f / 1024.f), var = fmaxf(q[u] * (1.f / 1024.f) - mu * mu, 0.f), rstd = rsqrtf(var + 1e-5f);
                float4 y; y.x = (v[u][j].x - mu) * rstd * gg.x + bb.x; y.y = (v[u][j].y - mu) * rstd * gg.y + bb.y; y.z = (v[u][j].z - mu) * rstd * gg.z + bb.z; y.w = (v[u][j].w - mu) * rstd * gg.w + bb.w;
                if (fin) *(float4*)(XO + (size_t)tok * 1024 + d0) = y;
                else { u32x2 w; w.x = pack2(y.x, y.y); w.y = pack2(y.z, y.w); *(u32x2*)(XB + (size_t)tok * 1024 + d0) = w; }
            }
        }
    }
}

#define XB_TMO      128
#define XB_XCNT(j)  (256  + 64 * (j))
#define XB_XSUB(j)  (1280 + 64 * (j))
#define XB_XGEN(j)  (2304 + 64 * (j))
#define XB_TOP      3328
#define XB_TOPGEN   3392
#define XCD_BAR_WORDS 3456
#define XB_SPIN_CAP (1u << 22)
#define LAS __attribute__((address_space(3)))
__device__ __forceinline__ unsigned xb_ld(unsigned* p)              { return __hip_atomic_load(p, __ATOMIC_RELAXED, __HIP_MEMORY_SCOPE_AGENT); }
__device__ __forceinline__ unsigned xb_add(unsigned* p, unsigned v) { return __hip_atomic_fetch_add(p, v, __ATOMIC_RELAXED, __HIP_MEMORY_SCOPE_AGENT); }
__device__ __forceinline__ unsigned xb_xcc_id() { return (unsigned)__builtin_amdgcn_s_getreg((3 << 11) | 20) & 0xFu; }
#define XB_SPIN(cond, bar) do { unsigned _sp = 0; while (cond) { __builtin_amdgcn_s_sleep(1); \
    if ((++_sp & 255u) == 0u) { if (xb_ld(&(bar)[XB_TMO])) break; if (_sp > XB_SPIN_CAP) { atomicAdd(&(bar)[XB_TMO], 1u); break; } } } } while (0)
struct XcdBarrier { unsigned* bar; unsigned x; volatile LAS unsigned* st; };
__device__ __forceinline__ XcdBarrier xcd_barrier_post(unsigned* bar, volatile LAS unsigned* st) {
    XcdBarrier b; b.bar = bar; b.x = xb_xcc_id(); b.st = st;
    if (threadIdx.x == 0) (void)xb_add(&bar[XB_XCNT(b.x)], 1u);
    return b;
}
__device__ __forceinline__ void xcd_barrier_complete(unsigned* bar, unsigned x, unsigned& nloc, unsigned& nx) {
    const unsigned G = gridDim.x * gridDim.y * gridDim.z;
    unsigned sum, cnt, mine, sp = 0u;
    for (;;) {
        sum = 0u; cnt = 0u; mine = 0u;
#pragma unroll
        for (unsigned j = 0; j < 16; ++j) { const unsigned c = xb_ld(&bar[XB_XCNT(j)]); sum += c; cnt += (c > 0u) ? 1u : 0u; mine = (j == x) ? c : mine; }
        if (sum == G) break;
        __builtin_amdgcn_s_sleep(1);
        if ((++sp & 255u) == 0u) { if (xb_ld(&bar[XB_TMO])) break; if (sp > XB_SPIN_CAP) { atomicAdd(&bar[XB_TMO], 1u); break; } }
    }
    nloc = mine > 0u ? mine : 1u; nx = cnt > 0u ? cnt : 1u;
}
__device__ __forceinline__ void xcd_barrier(const XcdBarrier& b) {
    asm volatile("s_waitcnt vmcnt(0)" ::: "memory");
    __syncthreads();
    if (threadIdx.x == 0) {
        unsigned* bar = b.bar;
        __builtin_amdgcn_s_waitcnt(0);
        unsigned nloc = b.st[0], nx = b.st[1];
        if (nloc == 0u) { xcd_barrier_complete(bar, b.x, nloc, nx); b.st[0] = nloc; b.st[1] = nx; }
        const unsigned old = xb_add(&bar[XB_XSUB(b.x)], 1u);
        const unsigned gen = old / nloc;
        if (old + 1u == (gen + 1u) * nloc) {
            __builtin_amdgcn_fence(__ATOMIC_RELEASE, "agent");
            asm volatile("s_waitcnt vmcnt(0)" ::: "memory");
            const unsigned og = xb_add(&bar[XB_TOP], 1u);
            const unsigned tg = og / nx;
            if (og + 1u == (tg + 1u) * nx) xb_add(&bar[XB_TOPGEN], 1u);
            else XB_SPIN(xb_ld(&bar[XB_TOPGEN]) == tg, bar);
            __builtin_amdgcn_fence(__ATOMIC_ACQUIRE, "agent");
            xb_add(&bar[XB_XGEN(b.x)], 1u);
            asm volatile("s_waitcnt vmcnt(0)" ::: "memory");
        } else {
            XB_SPIN(xb_ld(&bar[XB_XGEN(b.x)]) == gen, bar);
            __builtin_amdgcn_fence(__ATOMIC_ACQUIRE, "agent");
            asm volatile("s_waitcnt vmcnt(0)" ::: "memory");
        }
    }
    __syncthreads();
}

constexpr int PH_PER_LAYER = 11, N_PHASES = PH_PER_LAYER * NLAYER;
__global__ void __launch_bounds__(NTHREADS, 2) mega(Params p) {
    extern __shared__ __attribute__((aligned(16))) unsigned char lds[];
#if SINGLE_LAUNCH
    volatile LAS unsigned* xbw = (volatile LAS unsigned*)(lds + LDS_BYTES - 16);
    if (threadIdx.x < 4) xbw[threadIdx.x] = 0u;
    __syncthreads();
    XcdBarrier xbar = xcd_barrier_post((unsigned*)(p.ws + WS_CTL) + CW_BAR, xbw);
#endif
    const int half = __builtin_amdgcn_readfirstlane((int)(threadIdx.x >> 8));
    unsigned char* ldsh = lds + half * HALF_LDS;
    bool second = false;
    for (int ph = p.ph_lo; ph < p.ph_hi; ++ph) {
        const int layer = ph / PH_PER_LAYER, k = ph % PH_PER_LAYER;
        if (k == 0 && layer > 0) continue;
#ifdef ONLY_PHASE
        if (k != ONLY_PHASE) continue;
#endif
        switch (k) {
            case 0: phase_pw(p, layer, ldsh, 1 | 16 | 8, half); break;
            case 1: phase_g1(p, layer, lds); break;
            case 2: phase_p2(p, layer, ldsh, half); if (!second && layer + 1 < NLAYER) { __syncthreads(); phase_pw(p, layer + 1, ldsh, 1, half, 64); } break;
            case 3: phase_p3(p, ldsh, half, second ? ((p.rep_mask >> 16) & 7) : 7); if (!second && layer + 1 < NLAYER) { __syncthreads(); phase_pw(p, layer + 1, ldsh, 16, half); }
                    if (!second && layer == 0) { __syncthreads(); phase_pw(p, 0, ldsh, 2, half); } break;
            case 4: { const int sub = second ? ((p.rep_mask >> 12) & 7) : 7;
                    if (sub & 1) phase_p4_sel(p, lds);
                    if ((sub & 4) && half == 0) { phase_pw(p, layer, ldsh, 4, half); __syncthreads(); }
                    if (sub & 2) phase_p4(p, ldsh, half);
                    if ((sub & 4) && half == 1) { __syncthreads(); phase_pw(p, layer, ldsh, 4, half); } } break;
            case 5: phase_g2(p, lds); break;
            case 6: phase_g3(p, layer, lds); break;
            case 7: phase_ln1(p, layer, ldsh, ((p.rep_mask >> 7) & 1) && !second, half); if (!second && layer + 1 < NLAYER) { __syncthreads(); phase_pw(p, layer + 1, ldsh, 2, half); } break;
            case 8: phase_m2(p, layer, lds, ldsh, half); break;
            case 9: phase_m3(p, layer, lds, ldsh, half); break;
            case 10: phase_ln2(p, layer, half); break;
        }

        if (ph + 1 < p.ph_hi) { if (ph == p.ph_lo && !second) cg::this_grid().sync(); else xcd_barrier(xbar); }
        if (((p.rep_mask >> k) & 1) && !second) { second = true; --ph; } else second = false;
    }
}

extern "C" void kernel_launch(void* const* d_in, const int* in_sizes, int n_in, void* d_out, int out_size, void* d_ws, size_t ws_size, hipStream_t stream) {
    static int grid = 0;
    if (grid == 0) {
        if (n_in != 18 || ws_size < WS_END) { fprintf(stderr, "kernel_launch: unexpected n_in %d or ws_size %zu < %zu\n", n_in, ws_size, (size_t)WS_END); grid = -1; return; }
        int dev = 0, cus = 0, per_cu = 0;
        hipGetDevice(&dev); hipDeviceGetAttribute(&cus, hipDeviceAttributeMultiprocessorCount, dev);
        hipFuncSetAttribute((const void*)mega, hipFuncAttributeMaxDynamicSharedMemorySize, LDS_BYTES);
        hipOccupancyMaxActiveBlocksPerMultiprocessor(&per_cu, (const void*)mega, NTHREADS, LDS_BYTES);
        if (per_cu < 1) per_cu = 1;
        if (per_cu > 1) per_cu = 1;
        grid = cus * per_cu;
        (void)hipGetLastError();
    }
    if (grid < 0) return;
    Params p{};
    p.x = (const float*)d_in[0]; p.w_in = (const float*)d_in[1]; p.cmp_pos = (const float*)d_in[2]; p.cmp_w1 = (const float*)d_in[3]; p.cmp_w2 = (const float*)d_in[4];
    p.w_br_a = (const float*)d_in[5]; p.w_br_b = (const float*)d_in[6]; p.w_o = (const float*)d_in[7]; p.ln1_g = (const float*)d_in[8]; p.ln1_b = (const float*)d_in[9];
    p.w_router = (const float*)d_in[10]; p.router_bias = (const float*)d_in[11]; p.w_gate = (const float*)d_in[12]; p.w_up = (const float*)d_in[13]; p.w_down = (const float*)d_in[14];
    p.ln2_g = (const float*)d_in[15]; p.ln2_b = (const float*)d_in[16]; p.rel_bias = (const float*)d_in[17];
    p.out = (float*)d_out; p.ws = (unsigned char*)d_ws; p.rep_mask = REPEAT_MASK;
#if SINGLE_LAUNCH
    hipMemsetAsync((unsigned char*)d_ws + WS_CTL + (size_t)CW_BAR * 4, 0, XCD_BAR_WORDS * 4, stream);
    p.ph_lo = 0; p.ph_hi = N_PHASES;
    void* args[] = {&p};
    hipError_t e = hipLaunchCooperativeKernel((const void*)mega, dim3(grid), dim3(NTHREADS), args, LDS_BYTES, stream);
    if (e != hipSuccess) fprintf(stderr, "cooperative launch failed: %s (grid %d)\n", hipGetErrorString(e), grid);
#else
    for (int ph = 0; ph < N_PHASES; ++ph) {
        p.ph_lo = ph; p.ph_hi = ph + 1;
        hipLaunchKernelGGL(mega, dim3(grid), dim3(NTHREADS), LDS_BYTES, stream, p);
    }
#endif
}
```

```cpp
#include <hip/hip_runtime.h>
#include <hip/hip_cooperative_groups.h>
#include <cstdio>
#include <cstdint>
namespace cg = cooperative_groups;

#ifndef REPEAT_MASK
#define REPEAT_MASK 0
#endif
#ifndef SINGLE_LAUNCH
#define SINGLE_LAUNCH 1
#endif

typedef unsigned short bf16_t;
typedef short bf16x8 __attribute__((ext_vector_type(8)));
typedef float f32x4 __attribute__((ext_vector_type(4)));
typedef unsigned u32x2 __attribute__((ext_vector_type(2)));
typedef unsigned u32x4 __attribute__((ext_vector_type(4)));

constexpr int B_ = 2, S_ = 8192, D_ = 1024, T_ = B_ * S_, NLAYER = 4;
constexpr int DIN = 6424;
constexpr int LD = 5376;
constexpr int NW = 6656;
constexpr int C_QA = 0, C_KC = 512, C_VC = 640, C_KS = 768, C_KW = 896, C_QR = 1024, C_KR = 1536, C_GR = 2048, C_MA = 3072, C_MB = 4096, C_GA = 5120,
              C_VS = 5376, C_VW = 5504, C_VR = 5632;
constexpr float DN_ALPHA = 1.681792830507429f;
constexpr int NE = 16;

constexpr size_t al256(size_t x) { return (x + 255) & ~(size_t)255; }
constexpr size_t WS_CTL = 0;
constexpr size_t WS_BUCKET = 65536;
constexpr size_t WS_ROPE = WS_BUCKET + 8192;
constexpr size_t WS_WIN = WS_ROPE + (size_t)8192 * 32 * 8;
constexpr size_t WS_WA = WS_WIN + (size_t)NW * 1024 * 2;
constexpr size_t WS_WB = WS_WA + (size_t)1024 * 512 * 2;
constexpr size_t WS_WO = WS_WB + (size_t)1024 * 1024 * 2;
constexpr size_t WS_WG = WS_WO + (size_t)1024 * 1024 * 2;
constexpr size_t WS_WU = WS_WG + (size_t)16 * 512 * 1024 * 2;
constexpr size_t WS_WD = WS_WU + (size_t)16 * 512 * 1024 * 2;
constexpr size_t WS_XB = WS_WD + (size_t)16 * 512 * 1024 * 2;
constexpr size_t WS_X = WS_XB + (size_t)T_ * 1024 * 2;
constexpr size_t WS_MG = WS_X + (size_t)T_ * 1024 * 4;
constexpr size_t WS_KCC = WS_MG + (size_t)T_ * 1024 * 2;
constexpr size_t WS_VCCT = WS_KCC + (size_t)4 * 512 * 64 * 2;
constexpr size_t WS_W1T = WS_VCCT + (size_t)4 * 512 * 64 * 2;
constexpr size_t WS_B1 = WS_W1T + (size_t)2 * 64 * 2048 * 2;
constexpr size_t WS_R = WS_B1 + 1024;
constexpr size_t WS_P = WS_R;
constexpr size_t WS_VST = WS_P + (size_t)T_ * LD * 2;
constexpr size_t WS_VWT = WS_VST + (size_t)4 * 64 * S_ * 2;
constexpr size_t WS_VRT = WS_VWT + (size_t)4 * 64 * S_ * 2;
constexpr size_t WS_KVT = WS_VRT + (size_t)16 * 128 * S_ * 2;
constexpr size_t WS_SPT = WS_KVT + (size_t)16 * 64 * 8192 * 4;
constexpr size_t WS_YC = WS_SPT + (size_t)16 * 64 * 8192 * 2;
constexpr size_t WS_YW = WS_YC + (size_t)T_ * 512 * 2;
constexpr size_t WS_YA = WS_YW + (size_t)T_ * 512 * 2;
constexpr size_t WS_YB = WS_YA + (size_t)T_ * 512 * 2;
constexpr size_t WS_SELW = WS_YB + (size_t)T_ * 1024 * 2;
constexpr size_t WS_ENDA = WS_SELW + (size_t)T_ * 2 * 4 * 4;
constexpr size_t WS_H1 = WS_R;
constexpr size_t WS_X1 = WS_H1 + (size_t)T_ * 1024 * 4;
constexpr size_t WS_X1B = WS_X1 + (size_t)T_ * 1024 * 4;
constexpr size_t WS_HB = WS_X1B + (size_t)T_ * 1024 * 2;
constexpr size_t WS_CT = WS_HB + (size_t)2 * T_ * 512 * 2;
constexpr size_t WS_LIST = WS_CT + (size_t)2 * T_ * 1024 * 2;
constexpr size_t WS_WTS = WS_LIST + (size_t)16 * T_ * 4;
constexpr size_t WS_ENDB = WS_WTS + (size_t)2 * T_ * 4;
static_assert(WS_HB + (size_t)2 * T_ * 512 * 2 <= WS_CT, "view B overlap");
constexpr size_t WS_END = WS_ENDA > WS_ENDB ? WS_ENDA : WS_ENDB;

constexpr int CW_CNT = 4096;
constexpr int CW_BAR = 8192;
constexpr int CW_B1P = 12288;

constexpr int HALF_LDS = 75776, LDS_BYTES = 2 * HALF_LDS + 16;
constexpr int NTHREADS = 512, HT = 256;

struct Params {
    const float* x; const float* w_in; const float* cmp_pos; const float* cmp_w1; const float* cmp_w2;
    const float* w_br_a; const float* w_br_b; const float* w_o; const float* ln1_g; const float* ln1_b;
    const float* w_router; const float* router_bias; const float* w_gate; const float* w_up; const float* w_down;
    const float* ln2_g; const float* ln2_b; const float* rel_bias;
    float* out; unsigned char* ws;
    int ph_lo, ph_hi, rep_mask, pad_;
};

__device__ __forceinline__ bf16_t f2bf(float f) { unsigned u = __float_as_uint(f); u += 0x7fffu + ((u >> 16) & 1u); return (bf16_t)(u >> 16); }
__device__ __forceinline__ float bf2f(unsigned h) { return __uint_as_float(h << 16); }
typedef __bf16 bf16x2_t __attribute__((ext_vector_type(2)));
typedef float f32x2_t __attribute__((ext_vector_type(2)));
__device__ __forceinline__ unsigned pack2(float lo, float hi) { const f32x2_t f = {lo, hi}; return __builtin_bit_cast(unsigned, __builtin_convertvector(f, bf16x2_t)); }
__device__ __forceinline__ u32x2 pack4(f32x4 v) { u32x2 r; r.x = pack2(v[0], v[1]); r.y = pack2(v[2], v[3]); return r; }
__device__ __forceinline__ f32x4 unpack4(u32x2 u) { f32x4 r; r[0] = bf2f(u.x & 0xffffu); r[1] = bf2f(u.x >> 16); r[2] = bf2f(u.y & 0xffffu); r[3] = bf2f(u.y >> 16); return r; }
__device__ __forceinline__ float rows_max(float v) {
    u32x2 r = __builtin_amdgcn_permlane16_swap(__float_as_uint(v), __float_as_uint(v), false, false);
    v = fmaxf(__uint_as_float(r.x), __uint_as_float(r.y));
    r = __builtin_amdgcn_permlane32_swap(__float_as_uint(v), __float_as_uint(v), false, false);
    return fmaxf(__uint_as_float(r.x), __uint_as_float(r.y));
}
__device__ __forceinline__ float rows_sum(float v) {
    u32x2 r = __builtin_amdgcn_permlane16_swap(__float_as_uint(v), __float_as_uint(v), false, false);
    v = __uint_as_float(r.x) + __uint_as_float(r.y);
    r = __builtin_amdgcn_permlane32_swap(__float_as_uint(v), __float_as_uint(v), false, false);
    return __uint_as_float(r.x) + __uint_as_float(r.y);
}
__device__ __forceinline__ float wave_sum(float v) {
    v += __int_as_float(__builtin_amdgcn_mov_dpp(__float_as_int(v), 0xB1, 0xF, 0xF, true));
    v += __int_as_float(__builtin_amdgcn_mov_dpp(__float_as_int(v), 0x4E, 0xF, 0xF, true));
    v += __int_as_float(__builtin_amdgcn_mov_dpp(__float_as_int(v), 0x141, 0xF, 0xF, true));
    v += __int_as_float(__builtin_amdgcn_mov_dpp(__float_as_int(v), 0x140, 0xF, 0xF, true));
    return rows_sum(v);
}
__device__ __forceinline__ float sigmoidf_(float x) { return 1.f / (1.f + __expf(-x)); }
__device__ __forceinline__ int ltid() { int t = threadIdx.x; asm volatile("" : "+v"(t)); return t; }
__device__ __forceinline__ int vzero() { int z; asm volatile("v_mov_b32 %0, 0" : "=v"(z)); return z; }
__device__ __forceinline__ unsigned char* launder(unsigned char* q) { asm volatile("" : "+s"(q)); return q; }
__device__ __forceinline__ void wait_vm0() { asm volatile("s_waitcnt vmcnt(0)" ::: "memory"); }

__device__ __forceinline__ void glds16(const void* g, void* l) {
    __builtin_amdgcn_global_load_lds((const __attribute__((address_space(1))) unsigned*)g,
                                     (__attribute__((address_space(3))) unsigned*)l, 16, 0, 0);
}
__device__ __forceinline__ f32x4 mfma16(bf16x8 a, bf16x8 b, f32x4 c) { return __builtin_amdgcn_mfma_f32_16x16x32_bf16(a, b, c, 0, 0, 0); }

#define WAIT_V(n) asm volatile("s_waitcnt vmcnt(%0)" ::"n"(n) : "memory")
#define RAW_BARRIER() do { asm volatile("s_waitcnt lgkmcnt(0)" ::: "memory"); __builtin_amdgcn_s_barrier(); } while (0)
__device__ __forceinline__ void bglds16(__amdgpu_buffer_rsrc_t r, unsigned voff, int soff, void* l) {
    __builtin_amdgcn_raw_ptr_buffer_load_lds(r, (__attribute__((address_space(3))) void*)l, 16, (int)voff, soff, 0, 0);
}
template <int NJ, bool GN>
__device__ __forceinline__ void gemm8_stage(__amdgpu_buffer_rsrc_t mr, int mld, unsigned mvo, __amdgpu_buffer_rsrc_t nr, int nld, const unsigned (&nvo)[NJ], int kt, unsigned char* st, int wid) {
#pragma unroll
    for (int i = 0; i < 4; ++i) bglds16(mr, mvo, (64 * i * mld + kt * 64) * 2, st + (8 * i + wid) * 1024);
#pragma unroll
    for (int i = 0; i < NJ; ++i) bglds16(nr, nvo[i], ((GN ? 0 : 64 * i * nld) + kt * 64) * 2, st + 32768 + (8 * i + wid) * 1024);
}
template <int NJ, bool GN>
__device__ __forceinline__ void gemm8_kloop(const bf16_t* mb, int mld, unsigned mvo, const bf16_t* nb, int nld, const unsigned (&nvo)[NJ], int nk, unsigned char* lds, f32x4 (&acc)[8][NJ], int tid) {
    const int lane = tid & 63, wid = tid >> 6, wr = wid >> 2, wc = wid & 3, fr = lane & 15, fq = lane >> 4;
    const __amdgpu_buffer_rsrc_t mr = __builtin_amdgcn_make_buffer_rsrc((void*)mb, 0, 0x7fffffff, 0x00020000);
    const __amdgpu_buffer_rsrc_t nr = __builtin_amdgcn_make_buffer_rsrc((void*)nb, 0, 0x7fffffff, 0x00020000);
    gemm8_stage<NJ, GN>(mr, mld, mvo, nr, nld, nvo, 0, lds, wid);
    gemm8_stage<NJ, GN>(mr, mld, mvo, nr, nld, nvo, 1, lds + 65536, wid);
    for (int kt = 0; kt < nk; ++kt) {
        unsigned char* cur = lds + (kt & 1) * 65536;
        if (kt + 1 < nk) WAIT_V(4 + NJ); else WAIT_V(0);
        RAW_BARRIER();
        bf16x8 a[4], b[NJ];
        const unsigned char* ab = cur + (128 * wr + fr) * 128;
        const unsigned char* bb = cur + 32768 + (16 * NJ * wc + fr) * 128;
        const int sw0 = ((fq) ^ (fr & 7)) << 4, sw1 = ((4 + fq) ^ (fr & 7)) << 4;
#pragma unroll
        for (int j = 0; j < NJ; ++j) b[j] = *(const bf16x8*)(bb + j * 2048 + sw0);
#pragma unroll
        for (int mh = 0; mh < 2; ++mh) {
#pragma unroll
            for (int i = 0; i < 4; ++i) a[i] = *(const bf16x8*)(ab + (4 * mh + i) * 2048 + sw0);
#pragma unroll
            for (int i = 0; i < 4; ++i)
#pragma unroll
                for (int j = 0; j < NJ; ++j) acc[4 * mh + i][j] = mfma16(a[i], b[j], acc[4 * mh + i][j]);
        }
#pragma unroll
        for (int j = 0; j < NJ; ++j) b[j] = *(const bf16x8*)(bb + j * 2048 + sw1);
#pragma unroll
        for (int i = 0; i < 4; ++i) a[i] = *(const bf16x8*)(ab + i * 2048 + sw1);
#pragma unroll
        for (int i = 0; i < 4; ++i)
#pragma unroll
            for (int j = 0; j < NJ; ++j) acc[i][j] = mfma16(a[i], b[j], acc[i][j]);
#pragma unroll
        for (int i = 0; i < 4; ++i) a[i] = *(const bf16x8*)(ab + (4 + i) * 2048 + sw1);
        RAW_BARRIER();
        if (kt + 2 < nk) gemm8_stage<NJ, GN>(mr, mld, mvo, nr, nld, nvo, kt + 2, cur, wid);
#pragma unroll
        for (int i = 0; i < 4; ++i)
#pragma unroll
            for (int j = 0; j < NJ; ++j) acc[4 + i][j] = mfma16(a[i], b[j], acc[4 + i][j]);
    }
    __syncthreads();
    __builtin_amdgcn_sched_barrier(0);
}
template <int NJ>
__device__ __forceinline__ void zero_acc8(f32x4 (&acc)[8][NJ]) {
#pragma unroll
    for (int i = 0; i < 8; ++i)
#pragma unroll
        for (int j = 0; j < NJ; ++j) acc[i][j] = (f32x4){0.f, 0.f, 0.f, 0.f};
}

namespace pg8 {
#define PG8_LAS __attribute__((address_space(3)))
constexpr int BM = 256, BK = 64, HALF = 128, HTB = HALF * BK * 2, STAGE_BYTES = 8 * HTB;
__device__ __forceinline__ int lds_byte(int r, int c) { const int st = (r >> 4) * 2 + (c >> 5), rr = r & 15, cc = c & 31, ob = rr * 64 + cc * 2; return st * 1024 + (ob ^ (((ob >> 9) & 1) << 5)); }
__device__ __forceinline__ void stage_rc(int b, int& R, int& C) { const int st = b / 1024, sb = b % 1024, swz = sb ^ (((sb >> 9) & 1) << 5); R = (st >> 1) * 16 + swz / 64; C = (st & 1) * 32 + (swz % 64) / 2; }
__device__ __forceinline__ int perm32(int rho) { const int n = rho >> 4, i = rho & 15; return 8 * (i >> 2) + 4 * n + (i & 3); }
struct Unit { int pm, pn; };
template <class Epi, class Sched>
__device__ __forceinline__ void gemm_phase(unsigned char* lds_, const int K, const Sched& S, const Epi& E, const int tid, const unsigned char* wsbase) {
    PG8_LAS unsigned char* lds = (PG8_LAS unsigned char*)lds_;
    const int wid = __builtin_amdgcn_readfirstlane(tid >> 6), lane = tid & 63, wr = wid >> 2, wc = wid & 3, fr = lane & 15, fq = lane >> 4;
    const int nt = K / BK;
    unsigned voffA[2], voffB[2];
#pragma unroll
    for (int i = 0; i < 2; ++i) { int R, C; stage_rc(tid * 16 + i * 8192, R, C); const int Rb = (R & ~31) + perm32(R & 31);
        voffA[i] = (unsigned)(R * K + C) * 2u; voffB[i] = (unsigned)(Rb * K + C) * 2u; }
    const unsigned kstep = (unsigned)(BK * 2);
    const unsigned hstep = (unsigned)HALF * K * 2;
    const __amdgpu_buffer_rsrc_t rsrc = __builtin_amdgcn_make_buffer_rsrc((void*)wsbase, 0, 0x7fffffff, 0x00020000);
    const unsigned ldsw = (unsigned)wid * 1024u;
    const int aoff = lds_byte(wr * 64 + fr, fq * 8), boff = lds_byte(wc * 32 + fr, fq * 8);
#define PG8_SA(b, h) (((b) * 2 + (h)) * HTB)
#define PG8_SB(b, h) ((4 + (b) * 2 + (h)) * HTB)
#define PG8_STAGE(bufoff, gbase, voff) do { _Pragma("unroll") for (int _i = 0; _i < 2; ++_i) \
        __builtin_amdgcn_raw_ptr_buffer_load_lds(rsrc, (PG8_LAS void*)(lds + (bufoff) + ldsw + _i * 8192), 16, (int)(voff)[_i], (int)(gbase), 0, 0); } while (0)
#define PG8_LDA(dst, b, h) do { _Pragma("unroll") for (int m = 0; m < 4; ++m) _Pragma("unroll") for (int k = 0; k < 2; ++k) dst[m][k] = *(const PG8_LAS bf16x8*)(lds + PG8_SA(b, h) + aoff + m * 2048 + k * 1024); } while (0)
#define PG8_LDB(dst, b, h) do { _Pragma("unroll") for (int n = 0; n < 2; ++n) _Pragma("unroll") for (int k = 0; k < 2; ++k) dst[n][k] = *(const PG8_LAS bf16x8*)(lds + PG8_SB(b, h) + boff + n * 2048 + k * 1024); } while (0)
#define PG8_MMA(ai, bj, At, Bt) do { __builtin_amdgcn_s_setprio(1); _Pragma("unroll") for (int m = 0; m < 4; ++m) _Pragma("unroll") for (int n = 0; n < 2; ++n) _Pragma("unroll") for (int k = 0; k < 2; ++k) \
        acc[ai][bj][m][n] = __builtin_amdgcn_mfma_f32_16x16x32_bf16(Bt[n][k], At[m][k], acc[ai][bj][m][n], 0, 0, 0); __builtin_amdgcn_s_setprio(0); } while (0)
#define PG8_WAIT_V(n) asm volatile("s_waitcnt vmcnt(" #n ")" ::: "memory")
#define PG8_WAIT_L(n) asm volatile("s_waitcnt lgkmcnt(" #n ")" ::: "memory")
#define PG8_BAR __builtin_amdgcn_s_barrier()
#define PG8_SCHED __builtin_amdgcn_sched_barrier(0)
    typename Sched::U cur, nxt; int ui = 0;
    if (!S.next(0, cur)) return;
    unsigned cA, cB; S.ptrs(cur, cA, cB);
    constexpr bool GA = Sched::GATHER;
    unsigned vA[2], nvA[2];
    if constexpr (GA) { S.rows(cur, tid, vA); nvA[0] = vA[0]; nvA[1] = vA[1]; }
#define PG8_STAGE_G(bufoff, gbase, pk) do { const unsigned _cb = voffB[0] & (unsigned)(2 * K - 1); unsigned _vo[2] = {(((pk) & 0xffffu) * (unsigned)(2 * K)) + _cb, (((pk) >> 16) * (unsigned)(2 * K)) + _cb}; PG8_STAGE(bufoff, gbase, _vo); } while (0)
#define PG8_STAGE_A(bufoff, gbase, h, nextu) do { if constexpr (GA) { if (nextu) PG8_STAGE_G(bufoff, gbase, nvA[h]); else PG8_STAGE_G(bufoff, gbase, vA[h]); } \
        else PG8_STAGE(bufoff, (gbase) + (h) * hstep, voffA); } while (0)
    PG8_STAGE(PG8_SB(0, 0), cB, voffB); PG8_STAGE_A(PG8_SA(0, 0), cA, 0, false); PG8_STAGE(PG8_SB(0, 1), cB + hstep, voffB); PG8_STAGE_A(PG8_SA(0, 1), cA, 1, false);
    if (wr == 1) PG8_BAR;
    PG8_WAIT_V(4); PG8_BAR;
    PG8_STAGE(PG8_SB(1, 0), cB + kstep, voffB); PG8_STAGE_A(PG8_SA(1, 0), cA + kstep, 0, false); PG8_STAGE(PG8_SB(1, 1), cB + hstep + kstep, voffB);
    PG8_WAIT_V(6); PG8_BAR;
    PG8_SCHED;
    f32x4 acc[2][2][4][2];
#pragma unroll
    for (int a = 0; a < 2; ++a)
#pragma unroll
        for (int b = 0; b < 2; ++b)
#pragma unroll
            for (int m = 0; m < 4; ++m)
#pragma unroll
                for (int n = 0; n < 2; ++n) acc[a][b][m][n] = (f32x4){0.f, 0.f, 0.f, 0.f};
    bf16x8 At[4][2], B0[2][2], B1[2][2];
    for (;;) {
        const bool has_next = S.next(ui + 1, nxt);
        unsigned nA = cA, nB = cB; if (has_next) S.ptrs(nxt, nA, nB);
        if constexpr (GA) { if (has_next) S.rows(nxt, tid, nvA); }
        for (int t = 0; t < nt; t += 2) {
            if constexpr (Epi::MID_T > 0) { if (t == Epi::MID_T) E.mid(acc, cur, wr, wc, fr, fq); }
            const bool last = (t == nt - 2);
            const unsigned a1 = cA + (unsigned)(t + 1) * kstep;
            const unsigned a2 = last ? nA : cA + (unsigned)(t + 2) * kstep, b2 = last ? nB : cB + (unsigned)(t + 2) * kstep;
            const unsigned a3 = a2 + kstep, b3 = b2 + kstep;
            PG8_LDB(B0, 0, 0); PG8_SCHED; PG8_LDA(At, 0, 0); PG8_STAGE_A(PG8_SA(1, 1), a1, 1, false);
            PG8_WAIT_L(8); PG8_BAR; PG8_WAIT_L(0); PG8_MMA(0, 0, At, B0); PG8_BAR; PG8_SCHED;
            PG8_LDB(B1, 0, 1); PG8_STAGE(PG8_SB(0, 0), b2, voffB);
            PG8_BAR; PG8_WAIT_L(0); PG8_MMA(0, 1, At, B1); PG8_BAR;
            PG8_LDA(At, 0, 1); PG8_STAGE_A(PG8_SA(0, 0), a2, 0, last);
            PG8_BAR; PG8_WAIT_L(0); PG8_MMA(1, 0, At, B0); PG8_BAR; PG8_SCHED;
            PG8_STAGE(PG8_SB(0, 1), b2 + hstep, voffB);
            PG8_WAIT_V(6); PG8_BAR; PG8_MMA(1, 1, At, B1); PG8_BAR;
            PG8_LDB(B0, 1, 0); PG8_SCHED; PG8_LDA(At, 1, 0); PG8_STAGE_A(PG8_SA(0, 1), a2, 1, last);
            PG8_WAIT_L(8); PG8_BAR; PG8_WAIT_L(0); PG8_MMA(0, 0, At, B0); PG8_BAR; PG8_SCHED;
            PG8_LDB(B1, 1, 1); PG8_STAGE(PG8_SB(1, 0), b3, voffB);
            PG8_BAR; PG8_WAIT_L(0); PG8_MMA(0, 1, At, B1); PG8_BAR;
            PG8_LDA(At, 1, 1); PG8_STAGE_A(PG8_SA(1, 0), a3, 0, last);
            PG8_BAR; PG8_WAIT_L(0); PG8_MMA(1, 0, At, B0); PG8_BAR; PG8_SCHED;
            PG8_STAGE(PG8_SB(1, 1), b3 + hstep, voffB);
            PG8_WAIT_V(6); PG8_BAR; PG8_MMA(1, 1, At, B1); PG8_BAR;
        }
        E(acc, cur, wr, wc, fr, fq);
        if (!has_next) break;
#pragma unroll
        for (int a = 0; a < 2; ++a)
#pragma unroll
            for (int b = 0; b < 2; ++b)
#pragma unroll
                for (int m = 0; m < 4; ++m)
#pragma unroll
                    for (int n = 0; n < 2; ++n) acc[a][b][m][n] = (f32x4){0.f, 0.f, 0.f, 0.f};
        cur = nxt; cA = nA; cB = nB; ++ui;
        if constexpr (GA) { vA[0] = nvA[0]; vA[1] = nvA[1]; }
    }
    PG8_WAIT_V(0);
    if (wr == 0) PG8_BAR;
    PG8_BAR;
#undef PG8_SA
#undef PG8_SB
#undef PG8_STAGE
#undef PG8_STAGE_A
#undef PG8_STAGE_G
#undef PG8_LDA
#undef PG8_LDB
#undef PG8_MMA
#undef PG8_WAIT_V
#undef PG8_WAIT_L
#undef PG8_BAR
#undef PG8_SCHED
}
}

struct TJob { const float* src; bf16_t* dst; int ld, k0, n0, mode, kdst; };
__device__ __forceinline__ void tcvt_load(const TJob& J, float4 (&v)[4], int tid) {
#pragma unroll
    for (int i = 0; i < 4; ++i) {
        const int kk = (tid >> 4) + 16 * i, c4 = (tid & 15) * 4, cd = J.n0 + c4;
        int orig = cd; bool ok = true;
        if (J.mode == 1) {
            if (cd < 896) orig = cd;
            else if (cd < 1024) orig = cd - 896 + 1024;
            else if (cd < 2048) { const int q = cd - 1024, hd = q >> 6, pp = q & 63;
                const int d = (pp & 4) ? 32 + 4 * (pp >> 3) + (pp & 3) : 4 * (pp >> 3) + (pp & 3);
                orig = 1304 + hd * 64 + d; }
            else if (cd < 5120) orig = cd - 2048 + 3352;
            else if (cd < 5144) orig = cd - 5120 + 1280;
            else if (cd < 5376) ok = false;
            else if (cd < 5504) orig = cd - 5376 + 896;
            else if (cd < 5632) orig = cd - 5504 + 1152;
            else orig = cd - 5632 + 2328;
        }
        v[i] = make_float4(0.f, 0.f, 0.f, 0.f);
        if (ok) v[i] = *(const float4*)(J.src + (size_t)(J.k0 + kk) * J.ld + orig);
    }
}
__device__ __forceinline__ void tcvt_finish(const TJob& J, const float4 (&v)[4], unsigned char* lds, int tid) {
    float* tile = (float*)lds;
#pragma unroll
    for (int i = 0; i < 4; ++i) {
        const int kk = (tid >> 4) + 16 * i, c4 = (tid & 15) * 4;
        tile[kk * 65 + c4 + 0] = v[i].x; tile[kk * 65 + c4 + 1] = v[i].y; tile[kk * 65 + c4 + 2] = v[i].z; tile[kk * 65 + c4 + 3] = v[i].w;
    }
    __syncthreads();
#pragma unroll
    for (int i = 0; i < 2; ++i) {
        const int q = tid + 256 * i, n = q >> 3, kc = q & 7;
        float x[8];
#pragma unroll
        for (int j = 0; j < 8; ++j) x[j] = tile[(kc * 8 + j) * 65 + n];
        u32x4 w; w.x = pack2(x[0], x[1]); w.y = pack2(x[2], x[3]); w.z = pack2(x[4], x[5]); w.w = pack2(x[6], x[7]);
        int drow = J.n0 + n; if (J.mode >= 2) drow = 8 * (drow >> 2) + (drow & 3) + (J.mode == 3 ? 4 : 0);
        *(u32x4*)(J.dst + (size_t)drow * J.kdst + J.k0 + kc * 8) = w;
    }
    __syncthreads();
}
__device__ __forceinline__ void tcvt_tile(const float* src, int ld_src, int k0, int n0, int mode, bf16_t* dst, int kdst, unsigned char* lds, int half) {
    TJob J; J.src = src; J.dst = dst; J.ld = ld_src; J.k0 = k0; J.n0 = n0; J.mode = mode; J.kdst = kdst;
    const int tid = (ltid() & 255); float4 v[4];
    tcvt_load(J, v, tid); tcvt_finish(J, v, lds, tid);
}

__device__ __forceinline__ void tcvt_decode(const Params& p, unsigned char* ws, int layer, int t, TJob& J) {
    constexpr int J0 = 16 * 104, J1 = 8 * 16, J2 = 256, J3 = 256, J4 = 2048, J5 = 2048;
    int u = t;
        if (u < J0) { J.src = p.w_in + (size_t)layer * 1024 * DIN; J.ld = DIN; J.k0 = (u % 16) * 64; J.n0 = (u / 16) * 64; J.mode = 1; J.dst = (bf16_t*)(ws + WS_WIN); J.kdst = 1024; return; }
        u -= J0;
        if (u < J1) { J.src = p.w_br_a + (size_t)layer * 512 * 1024; J.ld = 1024; J.k0 = (u % 8) * 64; J.n0 = (u / 8) * 64; J.mode = 0; J.dst = (bf16_t*)(ws + WS_WA); J.kdst = 1536; return; }
        u -= J1;
        if (u < J2) { J.src = p.w_br_b + (size_t)layer * 1024 * 1024; J.ld = 1024; J.k0 = (u % 16) * 64; J.n0 = (u / 16) * 64; J.mode = 0; J.dst = (bf16_t*)(ws + WS_WA) + 512; J.kdst = 1536; return; }
        u -= J2;
        if (u < J3) { J.src = p.w_o + (size_t)layer * 1024 * 1024; J.ld = 1024; J.k0 = (u % 16) * 64; J.n0 = (u / 16) * 64; J.mode = 0; J.dst = (bf16_t*)(ws + WS_WO); J.kdst = 1024; return; }
        u -= J3;
        if (u < J4 + J5) {
            const bool up = u >= J4; if (up) u -= J4;
            const int e = u / 128, v = u % 128;
            J.src = (up ? p.w_up : p.w_gate) + ((size_t)layer * NE + e) * 1024 * 512; J.ld = 512; J.k0 = (v % 16) * 64; J.n0 = (v / 16) * 64; J.mode = up ? 3 : 2;
            J.dst = (bf16_t*)(ws + WS_WG) + (size_t)e * 1024 * 1024; J.kdst = 1024; return;
        }
        u -= J4 + J5;
        { const int e = u / 128, v = u % 128;
          J.src = p.w_down + ((size_t)layer * NE + e) * 512 * 1024; J.ld = 1024; J.k0 = (v % 8) * 64; J.n0 = (v / 8) * 64; J.mode = 0; J.dst = (bf16_t*)(ws + WS_WD) + (size_t)e * 1024 * 512; J.kdst = 512; }
}


__device__ __forceinline__ void phase_pw(const Params& p, int layer, unsigned char* lds, int parts, int half, int skip = 0, int split = 0) {
    const int hq = __builtin_amdgcn_readfirstlane(ltid() >> 8);
    if ((int)(blockIdx.x * 2 + hq) < skip) return;
    constexpr int MOE_A = 2048;
    const int bid = split == 1 ? ((int)blockIdx.x - (int)(gridDim.x >> 1)) * 2 + hq : (blockIdx.x * 2 + hq) - skip, nblk = split == 1 ? (int)gridDim.x : (gridDim.x * 2) - skip, tid = (ltid() & 255);
    if (bid < 0) return;
    unsigned char* ws = launder(p.ws);
    constexpr int J0 = 16 * 104, J1 = 8 * 16, J2 = 256, J3 = 256, J4 = 2048, J5 = 2048, J6 = 2048, JT = J0 + J1 + J2 + J3 + J4 + J5 + J6;
    const int t_lo = ((parts & 1) ? 0 : (parts & 2) ? J0 : J0 + J1 + J2 + J3) + (split == 2 ? MOE_A : 0);
    const int t_hi = split == 1 ? J0 + J1 + J2 + J3 + MOE_A : (parts & 4) ? JT : (parts & 2) ? J0 + J1 + J2 + J3 : (parts & 1) ? J0 : 0;
    if (t_lo + bid < t_hi) {
        float4 v[4]; { TJob J; tcvt_decode(p, ws, layer, t_lo + bid, J); tcvt_load(J, v, tid); }
        for (int t = t_lo + bid; t < t_hi; t += nblk) {
            float4 vn[4];
            if (t + nblk < t_hi) { TJob J; tcvt_decode(p, ws, layer, t + nblk, J); tcvt_load(J, vn, tid); }
            { TJob J; tcvt_decode(p, ws, layer, t, J); tcvt_finish(J, v, lds, tid); }
#pragma unroll
            for (int i = 0; i < 4; ++i) v[i] = vn[i];
        }
    }
    if (parts & 16) {
    for (int t = bid; t < 64; t += nblk) {
        const int kv = t >> 5, kt = t & 31;
        const float* w1 = p.cmp_w1 + ((size_t)layer * 2 + kv) * 2048 * 64;
        tcvt_tile(w1, 64, kt * 64, 0, 0, (bf16_t*)(ws + WS_W1T) + (size_t)kv * 64 * 2048, 2048, lds, half);
        const int n = tid & 63, part = tid >> 6;
        const float* pos = p.cmp_pos + ((size_t)layer * 2 + kv) * 2048 + kt * 64 + part * 16;
        const float* wp = w1 + (size_t)(kt * 64 + part * 16) * 64 + n;
        float a = 0.f;
#pragma unroll
        for (int k = 0; k < 16; ++k) a += pos[k] * wp[(size_t)k * 64];
        float* red = (float*)lds;
        __syncthreads(); red[tid] = a; __syncthreads();
        if (tid < 64) ((float*)(ws + WS_CTL) + CW_B1P)[(kv * 32 + kt) * 64 + tid] = red[tid] + red[tid + 64] + red[tid + 128] + red[tid + 192];
        __syncthreads();
    }
    }
    if (parts & 8) {
        const float4* xs = (const float4*)p.x; u32x2* xb = (u32x2*)(ws + WS_XB);
        for (size_t i = (size_t)bid * HT + tid; i < (size_t)T_ * 1024 / 4; i += (size_t)nblk * HT) {
            float4 v = xs[i]; u32x2 w; w.x = pack2(v.x, v.y); w.y = pack2(v.z, v.w); xb[i] = w;
        }
        for (int n = bid * HT + tid; n < 8192; n += nblk * HT) {
            int bk;
            if (n < 16) bk = n;
            else { const int th[15] = {22, 30, 40, 54, 73, 99, 134, 182, 246, 332, 450, 609, 825, 1117, 1513}; bk = 16;
#pragma unroll
                for (int k = 0; k < 15; ++k) bk += (n >= th[k]) ? 1 : 0; }
            (ws + WS_BUCKET)[n] = (unsigned char)bk;
        }
        for (int i = bid * HT + tid; i < 8192 * 32; i += nblk * HT) {
            const int pos = i >> 5, d = i & 31;
            const float inv = powf(10000.f, -(float)d * 2.0f / 64.f);
            const float ang = (float)pos * inv;
            float sn, cs; sincosf(ang, &sn, &cs);
            ((float2*)(ws + WS_ROPE))[i] = make_float2(cs, sn);
        }
        if (bid == 0) for (int i = tid; i < 8192; i += HT) ((unsigned*)(ws + WS_CTL))[i] = 0u;
    }
}

__device__ __forceinline__ float fsig(float x) { return __builtin_amdgcn_rcpf(1.f + __builtin_amdgcn_exp2f(-1.4426950408889634f * x)); }
template <int KIND>
__device__ __forceinline__ void g1_epi(const f32x4 (&acc)[2][2][4][2], unsigned char* ws, int r0, int c0, int wr, int wc, int fr, int fq) {
#pragma unroll
    for (int ai = 0; ai < 2; ++ai)
#pragma unroll
        for (int m = 0; m < 4; ++m) {
            const int row = r0 + 128 * ai + 64 * wr + 16 * m + fr + vzero();
#pragma unroll
            for (int bj = 0; bj < 2; ++bj) {
                const int col = c0 + 128 * bj + 32 * wc + 8 * fq;
                f32x4 v0 = acc[ai][bj][m][0], v1 = acc[ai][bj][m][1];
                if (KIND == 5) {
                    const int b = col >> 13, sq = col & (S_ - 1);
                    bf16_t* dst;
                    if (row < C_VW) { const int c = row - C_VS; dst = (bf16_t*)(ws + WS_VST) + ((size_t)(b * 2 + (c >> 6)) * 64 + (c & 63)) * S_ + sq; }
                    else if (row < C_VR) { const int c = row - C_VW; dst = (bf16_t*)(ws + WS_VWT) + ((size_t)(b * 2 + (c >> 6)) * 64 + (c & 63)) * S_ + sq; }
                    else { const int c = row - C_VR; dst = (bf16_t*)(ws + WS_VRT) + ((size_t)(b * 8 + (c >> 7)) * 128 + (c & 127)) * S_ + sq; }
                    u32x4 w; w.x = pack2(v0[0], v0[1]); w.y = pack2(v0[2], v0[3]); w.z = pack2(v1[0], v1[1]); w.w = pack2(v1[2], v1[3]);
                    *(u32x4*)dst = w;
                    continue;
                }
                if (KIND == 1 || KIND == 2) {
                    const float2* rope = (const float2*)(ws + WS_ROPE);
                    const int pos = row & (S_ - 1), d = 16 * (wc & 1) + 4 * fq;
                    const float4 cs01 = *(const float4*)(rope + pos * 32 + d), cs23 = *(const float4*)(rope + pos * 32 + d + 2);
                    const float c[4] = {cs01.x, cs01.z, cs23.x, cs23.z}, sn[4] = {cs01.y, cs01.w, cs23.y, cs23.w};
                    const float sc = (KIND == 2) ? 0.125f : 1.0f;
                    f32x4 y1, y2;
#pragma unroll
                    for (int r = 0; r < 4; ++r) { y1[r] = (v0[r] * c[r] - v1[r] * sn[r]) * sc; y2[r] = (v0[r] * sn[r] + v1[r] * c[r]) * sc; }
                    v0 = y1; v1 = y2;
                } else if (KIND == 3) {
#pragma unroll
                    for (int r = 0; r < 4; ++r) { v0[r] = v0[r] * fsig(v0[r]); v1[r] = v1[r] * fsig(v1[r]); }
                } else if (KIND == 4) {
#pragma unroll
                    for (int r = 0; r < 4; ++r) { v0[r] = fsig(v0[r]); v1[r] = fsig(v1[r]); }
                }
                u32x4 w; w.x = pack2(v0[0], v0[1]); w.y = pack2(v0[2], v0[3]); w.z = pack2(v1[0], v1[1]); w.w = pack2(v1[2], v1[3]);
                *(u32x4*)((bf16_t*)(ws + WS_P) + (size_t)row * LD + col) = w;
            }
        }
}
struct G1Order {      typedef pg8::Unit U; static constexpr bool GATHER = false;
    int xcd, slot, per;
    __device__ __forceinline__ bool next(int i, pg8::Unit& u) const {
        const int j = slot + i * per; if (j >= 208) return false;
        if (j < 192) { u.pm = j / 3; u.pn = xcd + 8 * (j % 3); } else { const int q = j - 192; u.pm = 8 * xcd + (q >> 1); u.pn = 24 + (q & 1); }
        return true;
    }
    __device__ __forceinline__ void ptrs(const pg8::Unit& u, unsigned& A, unsigned& B) const {
        const unsigned x = (unsigned)WS_XB + (unsigned)u.pm * (256u * 1024u * 2u), w = (unsigned)WS_WIN + (unsigned)u.pn * (256u * 1024u * 2u);
        if (u.pn >= 21) { A = w; B = x; } else { A = x; B = w; }
    }
};
struct G1Epi {
    static constexpr int MID_T = 0;
    unsigned char* ws;
    __device__ __forceinline__ void operator()(const f32x4 (&acc)[2][2][4][2], const pg8::Unit& u, int wr, int wc, int fr, int fq) const {
        const int pn = u.pn, tok0 = u.pm * 256, n0 = pn * 256;
        if (pn >= 21) g1_epi<5>(acc, ws, n0, tok0, wr, wc, fr, fq);
        else if (pn >= 12) g1_epi<4>(acc, ws, tok0, n0, wr, wc, fr, fq);
        else if (pn >= 8) g1_epi<3>(acc, ws, tok0, n0, wr, wc, fr, fq);
        else if (pn >= 6) g1_epi<2>(acc, ws, tok0, n0, wr, wc, fr, fq);
        else if (pn >= 4) g1_epi<1>(acc, ws, tok0, n0, wr, wc, fr, fq);
        else g1_epi<0>(acc, ws, tok0, n0, wr, wc, fr, fq);
    }
};
__device__ __forceinline__ void phase_g1(const Params& p, int layer, unsigned char* lds) {
    unsigned char* ws = launder(p.ws);
    G1Order S; S.xcd = blockIdx.x & 7; S.slot = blockIdx.x >> 3; S.per = gridDim.x >> 3;
    G1Epi E; E.ws = ws;
    pg8::gemm_phase<G1Epi, G1Order>(lds, 1024, S, E, ltid(), ws);
}

__device__ __forceinline__ void load_tile64(const bf16_t* base, size_t rowStride, unsigned char* dst, int wid, int lane) {
    const int c = ((lane & 7) ^ (lane >> 3)) * 8;
#pragma unroll
    for (int i = 0; i < 2; ++i) { const int j = wid + 4 * i, row = 8 * j + (lane >> 3); glds16(base + (size_t)row * rowStride + c, dst + j * 1024); }
}
__device__ __forceinline__ void load_tile128(const bf16_t* base, size_t rowStride, unsigned char* dst, int wid, int lane) {
    const int c = ((lane & 7) ^ (lane >> 3)) * 8;
#pragma unroll
    for (int i = 0; i < 4; ++i) { const int j = wid + 4 * i, row = 8 * j + (lane >> 3); glds16(base + (size_t)row * rowStride + c, dst + j * 1024); }
}
__device__ __forceinline__ void load_tile128w(const bf16_t* base, size_t rowStride, unsigned char* dst, int wid, int lane) {
    const int c = ((lane & 15) ^ ((4 * wid + (lane >> 4)) & 15)) * 8;
#pragma unroll
    for (int i = 0; i < 8; ++i) { const int j = wid + 4 * i, row = 4 * j + (lane >> 4); glds16(base + (size_t)row * rowStride + c, dst + j * 1024); }
}
__device__ __forceinline__ bf16x8 lds_frag128(const unsigned char* tile, int row, int chunk) {
    return *(const bf16x8*)(tile + row * 128 + ((chunk ^ (row & 7)) << 4));
}
__device__ __forceinline__ bf16x8 lds_frag256(const unsigned char* tile, int row, int chunk) {
    return *(const bf16x8*)(tile + row * 256 + ((chunk ^ (row & 15)) << 4));
}
__device__ __forceinline__ bf16x8 lds_vfrag128(const unsigned char* tile, int row, int kbase, int fq) {
    const int ca = (kbase >> 3) + (fq >> 1), hb = (fq & 1) * 8;
    const u32x2 a = *(const u32x2*)(tile + row * 128 + ((ca ^ (row & 7)) << 4) + hb);
    const u32x2 b = *(const u32x2*)(tile + row * 128 + (((ca + 2) ^ (row & 7)) << 4) + hb);
    u32x4 w; w.x = a.x; w.y = a.y; w.z = b.x; w.w = b.y;
    return __builtin_bit_cast(bf16x8, w);
}
__device__ __forceinline__ bf16x8 lds_vfrag256(const unsigned char* tile, int row, int kbase, int fq) {
    const int ca = (kbase >> 3) + (fq >> 1), hb = (fq & 1) * 8;
    const u32x2 a = *(const u32x2*)(tile + row * 256 + ((ca ^ (row & 15)) << 4) + hb);
    const u32x2 b = *(const u32x2*)(tile + row * 256 + (((ca + 2) ^ (row & 15)) << 4) + hb);
    u32x4 w; w.x = a.x; w.y = a.y; w.z = b.x; w.w = b.y;
    return __builtin_bit_cast(bf16x8, w);
}
__device__ __forceinline__ bf16x8 pack8(f32x4 a, f32x4 b) {
    u32x4 w; w.x = pack2(a[0], a[1]); w.y = pack2(a[2], a[3]); w.z = pack2(b[0], b[1]); w.w = pack2(b[2], b[3]);
    return __builtin_bit_cast(bf16x8, w);
}

__device__ __forceinline__ float gelu_tanh(float x) {
    const float u = 0.7978845608028654f * (x + 0.044715f * x * x * x);
    return 0.5f * x * (1.f + tanhf(u));
}
__device__ __forceinline__ void compress_item(const Params& p, int layer, int item, unsigned char* lds, int half) {
    unsigned char* ws = launder(p.ws);
    const int tid = (ltid() & 255), lane = tid & 63, wid = tid >> 6, wr = wid >> 1, wc = wid & 1, fr = lane & 15, fq = lane >> 4;
    const int mtile = item & 3, g = (item >> 2) & 1, b = (item >> 3) & 1, kv = item >> 4;
    const int i0 = mtile * 128;
    const bf16_t* P = (const bf16_t*)(ws + WS_P);
    const bf16_t* W1T = (const bf16_t*)(ws + WS_W1T) + (size_t)kv * 64 * 2048;
    const int col = (kv ? C_VC : C_KC) + g * 64;
    const int ldc = ((lane & 7) ^ (lane >> 3)) * 8;
    const int l0 = 16 * half;
    const bf16_t* ap[4];
#pragma unroll
    for (int i = 0; i < 4; ++i) ap[i] = P + ((size_t)b * S_ + 16 * (i0 + 32 * i + 8 * wid + (lane >> 3)) + l0) * LD + col + ldc;
    const bf16_t* bp[2];
#pragma unroll
    for (int i = 0; i < 2; ++i) bp[i] = W1T + (size_t)(8 * (wid + 4 * i) + (lane >> 3)) * 2048 + l0 * 64 + ldc;
    f32x4 acc[4][2];
#pragma unroll
    for (int i = 0; i < 4; ++i)
#pragma unroll
        for (int j = 0; j < 2; ++j) acc[i][j] = (f32x4){0.f, 0.f, 0.f, 0.f};
    __syncthreads();
#define CSTAGE(buf, l) do { unsigned char* st_ = lds + (buf) * 24576; \
        _Pragma("unroll") for (int i = 0; i < 4; ++i) glds16(ap[i] + (size_t)(l) * LD, st_ + (4 * i + wid) * 1024); \
        _Pragma("unroll") for (int i = 0; i < 2; ++i) glds16(bp[i] + (l) * 64, st_ + 16384 + (wid + 4 * i) * 1024); } while (0)
    CSTAGE(0, 0); CSTAGE(1, 1);
    for (int l = 0; l < 16; ++l) {
        const unsigned char* st = lds + (l % 3) * 24576;
        if (l + 1 < 16) WAIT_V(6); else WAIT_V(0);
        RAW_BARRIER();
        if (l + 2 < 16) CSTAGE((l + 2) % 3, l + 2);
#pragma unroll
        for (int ks = 0; ks < 2; ++ks) {
            bf16x8 a[4], bb[2];
#pragma unroll
            for (int i = 0; i < 4; ++i) a[i] = lds_frag128(st, 64 * wr + 16 * i + fr, 4 * ks + fq);
#pragma unroll
            for (int j = 0; j < 2; ++j) bb[j] = lds_frag128(st + 16384, 32 * wc + 16 * j + fr, 4 * ks + fq);
#pragma unroll
            for (int i = 0; i < 4; ++i)
#pragma unroll
                for (int j = 0; j < 2; ++j) acc[i][j] = mfma16(a[i], bb[j], acc[i][j]);
        }
    }
    __syncthreads();
#undef CSTAGE
    float* xch = (float*)(lds - half * HALF_LDS + HALF_LDS);
    if (half == 1) {
#pragma unroll
        for (int i = 0; i < 4; ++i)
#pragma unroll
            for (int j = 0; j < 2; ++j)
#pragma unroll
                for (int r = 0; r < 4; ++r) xch[((i * 2 + j) * 4 + r) * 256 + tid] = acc[i][j][r];
    }
    __syncthreads();
    if (half == 0) {
        const float* b1 = (const float*)(ws + WS_CTL) + CW_B1P + kv * 32 * 64;
#pragma unroll
        for (int j = 0; j < 2; ++j) {
            const int n = 32 * wc + 16 * j + fr; float bias = 0.f;
#pragma unroll
            for (int kt = 0; kt < 32; ++kt) bias += b1[kt * 64 + n + vzero()];
#pragma unroll
            for (int i = 0; i < 4; ++i)
#pragma unroll
                for (int r = 0; r < 4; ++r) {
                    const int row = 64 * wr + 16 * i + 4 * fq + r;
                    const float hv = gelu_tanh(acc[i][j][r] + xch[((i * 2 + j) * 4 + r) * 256 + tid] + bias);
                    *(bf16_t*)(lds + row * 128 + (((n >> 3) ^ (row & 7)) << 4) + (n & 7) * 2) = f2bf(hv);
                }
        }
        const float* w2 = p.cmp_w2 + ((size_t)layer * 2 + kv) * 64 * 64;
        const int k = tid >> 2, n0 = (tid & 3) * 16;
#pragma unroll
        for (int q4 = 0; q4 < 4; ++q4) {
            const float4 w = *(const float4*)(w2 + k * 64 + n0 + 4 * q4);
            const float wv[4] = {w.x, w.y, w.z, w.w};
#pragma unroll
            for (int e = 0; e < 4; ++e) { const int n = n0 + 4 * q4 + e; *(bf16_t*)(lds + 16384 + n * 128 + (((k >> 3) ^ (n & 7)) << 4) + (k & 7) * 2) = f2bf(wv[e]); }
        }
    }
    __syncthreads();
    if (half == 0) {
        f32x4 o[4][2];
#pragma unroll
        for (int i = 0; i < 4; ++i)
#pragma unroll
            for (int j = 0; j < 2; ++j) o[i][j] = (f32x4){0.f, 0.f, 0.f, 0.f};
#pragma unroll
        for (int ks = 0; ks < 2; ++ks) {
            bf16x8 a[4], bb[2];
#pragma unroll
            for (int i = 0; i < 4; ++i) a[i] = lds_frag128(lds, 64 * wr + 16 * i + fr, 4 * ks + fq);
#pragma unroll
            for (int j = 0; j < 2; ++j) bb[j] = lds_frag128(lds + 16384, 32 * wc + 16 * j + fr, 4 * ks + fq);
#pragma unroll
            for (int i = 0; i < 4; ++i)
#pragma unroll
                for (int j = 0; j < 2; ++j) o[i][j] = mfma16(a[i], bb[j], o[i][j]);
        }
#pragma unroll
        for (int i = 0; i < 4; ++i)
#pragma unroll
            for (int j = 0; j < 2; ++j) {
                const int n = 32 * wc + 16 * j + fr, ci = i0 + 64 * wr + 16 * i + 4 * fq;
                f32x4 v = o[i][j];
#pragma unroll
                for (int r = 0; r < 4; ++r) if (ci + r >= 511) v[r] = 0.f;
                if (kv == 0) {
                    bf16_t* dst = (bf16_t*)(ws + WS_KCC) + ((size_t)(b * 2 + g) * 512 + ci) * 64 + n;
#pragma unroll
                    for (int r = 0; r < 4; ++r) dst[r * 64] = f2bf(v[r]);
                } else {
                    *(u32x2*)((bf16_t*)(ws + WS_VCCT) + ((size_t)(b * 2 + g) * 64 + n) * 512 + ci) = pack4(v);
                }
            }
    }
    __syncthreads();
}

__device__ __forceinline__ float ret_lg2(int h) { const float gam = 1.f - exp2f(-5.f - (float)h); return log2f(gam); }

__device__ __forceinline__ void retkv_item(const Params& p, int item, unsigned char* lds, int half) {
    unsigned char* ws = launder(p.ws);
    const int tid = (ltid() & 255), lane = tid & 63, wid = tid >> 6, fr = lane & 15, fq = lane >> 4;
    const int n = item & 63, h = (item >> 6) & 7, b = item >> 9;
    const size_t tok0 = (size_t)b * S_ + 128 * n;
    unsigned char* vL = lds; unsigned char* kL = lds + 32768;
    load_tile128w((const bf16_t*)(ws + WS_VRT) + ((size_t)(b * 8 + h) * 128) * S_ + 128 * n, S_, vL, wid, lane);
    load_tile128((const bf16_t*)(ws + WS_P) + tok0 * LD + C_KR + h * 64, LD, kL, wid, lane);
    wait_vm0(); __syncthreads();
    const float lg2 = ret_lg2(h);
    f32x4 acc[2][4];
#pragma unroll
    for (int m = 0; m < 2; ++m)
#pragma unroll
        for (int nt = 0; nt < 4; ++nt) acc[m][nt] = (f32x4){0.f, 0.f, 0.f, 0.f};
#pragma unroll
    for (int ks = 0; ks < 4; ++ks) {
        bf16x8 a[2], bb[4];
#pragma unroll
        for (int m = 0; m < 2; ++m) a[m] = lds_frag256(vL, 32 * wid + 16 * m + fr, 4 * ks + fq);
        float dec[8];
#pragma unroll
        for (int j = 0; j < 8; ++j) dec[j] = exp2f((float)(127 - (32 * ks + 8 * fq + j)) * lg2);
#pragma unroll
        for (int nt = 0; nt < 4; ++nt) {
            const int d = 16 * nt + fr;
            float v[8];
#pragma unroll
            for (int j = 0; j < 8; ++j) {
                const int tk = 32 * ks + 8 * fq + j;
                const bf16_t kvv = *(const bf16_t*)(kL + tk * 128 + (((d >> 3) ^ (tk & 7)) << 4) + (d & 7) * 2);
                v[j] = bf2f(kvv) * dec[j];
            }
            u32x4 w; w.x = pack2(v[0], v[1]); w.y = pack2(v[2], v[3]); w.z = pack2(v[4], v[5]); w.w = pack2(v[6], v[7]);
            bb[nt] = __builtin_bit_cast(bf16x8, w);
        }
#pragma unroll
        for (int m = 0; m < 2; ++m)
#pragma unroll
            for (int nt = 0; nt < 4; ++nt) acc[m][nt] = mfma16(a[m], bb[nt], acc[m][nt]);
    }
    float* KVT = (float*)(ws + WS_KVT) + ((size_t)(b * 8 + h) * 64 + n) * 8192;
#pragma unroll
    for (int m = 0; m < 2; ++m)
#pragma unroll
        for (int nt = 0; nt < 4; ++nt)
#pragma unroll
            for (int r = 0; r < 4; ++r) KVT[(32 * wid + 16 * m + 4 * fq + r) * 64 + 16 * nt + fr] = acc[m][nt][r];
    __syncthreads();
}

__device__ __forceinline__ void phase_p2(const Params& p, int layer, unsigned char* lds, int half) {
    const int vb = blockIdx.x * 2 + half, nvb = gridDim.x * 2;
    if (vb < 64) compress_item(p, layer, vb >> 1, lds, half);
    else for (int it = vb - 64; it < 1024; it += nvb - 64) retkv_item(p, it, lds, half);
}

constexpr int NSA_IMP = 32768, NSA_BUCKET = 65792, NSA_BIAS = 73984;

struct NsaLane { int t; int fr, fq, wid, lane; };

constexpr float LOG2E = 1.4426950408889634f;
__device__ __forceinline__ int t5_first(int bk) {
    const int th[16] = {16, 22, 30, 40, 54, 73, 99, 134, 182, 246, 332, 450, 609, 825, 1117, 1513};
    int r = 16;
#pragma unroll
    for (int k = 0; k < 16; ++k) r = (bk == 16 + k) ? th[k] : r;
    return r;
}
template <int BR, int PASS>
__device__ __forceinline__ void nsa_half(const unsigned char* kL, const unsigned char* vL, const unsigned char* lds, const bf16x8 (&qptr)[4][2],
                                         f32x4 (&O)[4][4], float (&m)[4], float (&l)[4], int tile, int hf, const NsaLane& L, int qrow, const bool FAST, int th, int b0, int b1) {
    const int fr = L.lane & 15, fq = L.lane >> 4;
    constexpr float C2 = 0.125f * LOG2E;
    bf16x8 Kf[2][2];
#pragma unroll
    for (int i = 0; i < 2; ++i)
#pragma unroll
        for (int ks = 0; ks < 2; ++ks) Kf[i][ks] = lds_frag128(kL, 32 * hf + 16 * i + fr, 4 * ks + fq);
    bf16x8 Vf[4];
    if (PASS != 0) {
#pragma unroll
        for (int mt = 0; mt < 4; ++mt) Vf[mt] = lds_vfrag128(vL, 16 * mt + fr, 32 * hf, fq);
    }
    unsigned vmask = 0; unsigned bk[2] = {0u, 0u}; bool hi[2][4];
    if (!FAST) {
        const unsigned char* bucketL = lds + NSA_BUCKET;
#pragma unroll
        for (int i = 0; i < 2; ++i) {
            unsigned pk = 0;
#pragma unroll
            for (int r = 0; r < 4; ++r) {
                const int kk = 32 * hf + 16 * i + 4 * fq + r;
                int rel; bool ok;
                if (BR == 0) { rel = L.t - (16 * (64 * tile + kk) + 31); ok = rel >= 0; }
                else { rel = L.t - (64 * tile + kk); ok = rel >= 0 && rel < 512; }
                int rc = rel < 0 ? 0 : rel; rc = rc > 8191 ? 8191 : rc;
                pk |= (unsigned)bucketL[rc] << (8 * r);
                vmask |= (ok ? 1u : 0u) << (4 * i + r);
                hi[i][r] = false;
            }
            bk[i] = pk;
        }
    } else {
        const int kbase = 64 * tile + 32 * hf + 4 * fq;
        const int lim = BR == 0 ? L.t - th - 31 - 16 * kbase : L.t - th - kbase;
#pragma unroll
        for (int i = 0; i < 2; ++i)
#pragma unroll
            for (int r = 0; r < 4; ++r) hi[i][r] = (BR == 0 ? 16 : 1) * (16 * i + r) <= lim;
    }
    const float* biasL = (const float*)(lds + NSA_BIAS);
    float ia[2] = {0.f, 0.f}, ic[2] = {0.f, 0.f};
#pragma unroll
    for (int nt = 0; nt < 4; ++nt) {
        f32x4 S[2];
        const bf16x8 q0 = qptr[nt][0], q1 = qptr[nt][1];
#pragma unroll
        for (int i = 0; i < 2; ++i) {
            S[i] = (f32x4){0.f, 0.f, 0.f, 0.f};
            S[i] = mfma16(Kf[i][0], q0, S[i]); S[i] = mfma16(Kf[i][1], q1, S[i]);
        }
        float tmax = -1e30f;
        if (!FAST) {
#pragma unroll
            for (int i = 0; i < 2; ++i) {
                float bsv[4];
#pragma unroll
                for (int r = 0; r < 4; ++r) bsv[r] = biasL[nt * 32 + ((bk[i] >> (8 * r)) & 0xffu)];
                asm volatile("" : "+v"(bsv[0]), "+v"(bsv[1]), "+v"(bsv[2]), "+v"(bsv[3]));
#pragma unroll
                for (int r = 0; r < 4; ++r) {
                    const bool ok = (vmask >> (4 * i + r)) & 1u;
                    const float sv = S[i][r] * C2 + bsv[r];
                    S[i][r] = ok ? sv : -1e30f; tmax = fmaxf(tmax, S[i][r]);
                }
            }
        } else {
            const float blo = biasL[nt * 32 + b0], bhi = biasL[nt * 32 + b1];
#pragma unroll
            for (int i = 0; i < 2; ++i)
#pragma unroll
                for (int r = 0; r < 4; ++r) { S[i][r] = S[i][r] * C2 + (hi[i][r] ? bhi : blo); tmax = fmaxf(tmax, S[i][r]); }
        }
        if (PASS != 1) {
            if (__builtin_amdgcn_ballot_w64(tmax > m[nt] + 8.f) != 0ull) {
                const float tm = rows_max(tmax);
                const float mnew = tm > m[nt] + 8.f ? tm : m[nt], alpha = __builtin_amdgcn_exp2f(m[nt] - mnew);
                l[nt] *= alpha; m[nt] = mnew;
                if (PASS == 2) {
#pragma unroll
                    for (int mt = 0; mt < 4; ++mt) O[mt][nt] = O[mt][nt] * alpha;
                }
            }
            float psum = 0.f;
#pragma unroll
            for (int i = 0; i < 2; ++i)
#pragma unroll
                for (int r = 0; r < 4; ++r) S[i][r] = __builtin_amdgcn_exp2f(S[i][r] - m[nt]);
            if (!FAST) {
#pragma unroll
                for (int i = 0; i < 2; ++i)
#pragma unroll
                    for (int r = 0; r < 4; ++r) { const bool ok = (vmask >> (4 * i + r)) & 1u; S[i][r] = ok ? S[i][r] : 0.f; }
            }
#pragma unroll
            for (int i = 0; i < 2; ++i)
#pragma unroll
                for (int r = 0; r < 4; ++r) psum += S[i][r];
            l[nt] += psum;
        } else {
#pragma unroll
            for (int i = 0; i < 2; ++i) {
#pragma unroll
                for (int r = 0; r < 4; ++r) S[i][r] = __builtin_amdgcn_exp2f(S[i][r] - m[nt]) * l[nt];
            }
            if (!FAST) {
#pragma unroll
                for (int i = 0; i < 2; ++i)
#pragma unroll
                    for (int r = 0; r < 4; ++r) { const bool ok = (vmask >> (4 * i + r)) & 1u; S[i][r] = ok ? S[i][r] : 0.f; }
            }
#pragma unroll
            for (int i = 0; i < 2; ++i) {
                ia[i] += S[i][0] + S[i][1] + S[i][2] + 0.5f * S[i][3];
                ic[i] += 0.5f * S[i][3];
            }
        }
        if (PASS != 0) {
            const bf16x8 Pb = pack8(S[0], S[1]);
#pragma unroll
            for (int mt = 0; mt < 4; ++mt) O[mt][nt] = mfma16(Vf[mt], Pb, O[mt][nt]);
        }
        if (nt & 1) __builtin_amdgcn_sched_barrier(0);
    }
    if (PASS == 1) {
        float* imp = (float*)(lds + NSA_IMP) + qrow * 129;
        asm volatile("" ::: "memory"); __builtin_amdgcn_wave_barrier();
#pragma unroll
        for (int i = 0; i < 2; ++i) { const int j = 16 * tile + 8 * hf + 4 * i + fq; imp[j] += ia[i]; }
        asm volatile("s_waitcnt lgkmcnt(0)" ::: "memory"); __builtin_amdgcn_wave_barrier();
#pragma unroll
        for (int i = 0; i < 2; ++i) { const int j = 16 * tile + 8 * hf + 4 * i + fq + 1; if (j < 128) imp[j] += ic[i]; }
        asm volatile("s_waitcnt lgkmcnt(0)" ::: "memory"); __builtin_amdgcn_wave_barrier();
    }
}
template <int BR, int PASS>
__device__ __forceinline__ void nsa_tile(const unsigned char* kL, const unsigned char* vL, const unsigned char* lds, const bf16x8 (&qptr)[4][2],
                                         f32x4 (&O)[4][4], float (&m)[4], float (&l)[4], int tile, const NsaLane& L, int qrow) {
    const int tq0 = __builtin_amdgcn_readfirstlane(L.t - (L.lane & 15));
#pragma unroll 1
    for (int hf = 0; hf < 2; ++hf) {
        const int kfirst = 64 * tile + 32 * hf, pmin = BR == 0 ? 16 * kfirst + 31 : kfirst, pmax = BR == 0 ? 16 * (kfirst + 31) + 31 : kfirst + 31;
        const int rmin = tq0 - pmax, rmax = tq0 + 15 - pmin;
        bool fast = false; int th = 0, b0 = 0, b1 = 0;
        if (rmin >= 16 && (BR != 2 || rmax < 512)) {
            const unsigned char* bucketL = lds + NSA_BUCKET;
            b0 = __builtin_amdgcn_readfirstlane((int)bucketL[rmin]); b1 = __builtin_amdgcn_readfirstlane((int)bucketL[rmax > 8191 ? 8191 : rmax]);
            if (b1 - b0 <= 1) { fast = true; th = b1 == b0 ? 0 : t5_first(b1); }
        }
        nsa_half<BR, PASS>(kL, vL, lds, qptr, O, m, l, tile, hf, L, qrow, fast, th, b0, b1);
    }
}

__device__ __forceinline__ void cmp_item(const Params& p, int item, unsigned char* lds, int half) {
    unsigned char* ws = launder(p.ws);
    const int tid = (ltid() & 255), lane = tid & 63, wid = tid >> 6, fr = lane & 15, fq = lane >> 4;
    const int combo = item & 3, qt = 127 - (item >> 2), b = combo >> 1, g = combo & 1;
    const int q0 = qt * 64, qrow = 16 * wid + fr;
    NsaLane L; L.t = q0 + qrow; L.fr = fr; L.fq = fq; L.wid = wid; L.lane = lane;
    const size_t tok = (size_t)b * S_ + L.t;
    const bf16_t* P = (const bf16_t*)(ws + WS_P);
    __syncthreads();
    if (tid < 128) ((float*)(lds + NSA_BIAS))[tid] = p.rel_bias[(tid & 31) * 8 + 4 * g + (tid >> 5)] * LOG2E;
    for (int i = tid; i < 64 * 129; i += HT) ((float*)(lds + NSA_IMP))[i] = 0.f;
    bf16x8 Qf[4][2];
#pragma unroll
    for (int nt = 0; nt < 4; ++nt)
#pragma unroll
        for (int ks = 0; ks < 2; ++ks) Qf[nt][ks] = *(const bf16x8*)(P + tok * LD + C_QA + (4 * g + nt) * 64 + 32 * ks + 8 * fq);
    __syncthreads();
    f32x4 O[4][4]; float m[4], l[4];
    const bf16_t* gates = P + tok * LD + C_GA + (4 * g) * 3;
    const bf16_t* kc = (const bf16_t*)(ws + WS_KCC) + (size_t)(b * 2 + g) * 512 * 64;
    const bf16_t* vc = (const bf16_t*)(ws + WS_VCCT) + (size_t)(b * 2 + g) * 64 * 512;
    const int ntc = ((q0 + 32) >> 4) / 64 + 1;
#pragma unroll
    for (int nt = 0; nt < 4; ++nt) { m[nt] = -1e30f; l[nt] = 0.f; }
    load_tile64(kc, 64, lds, wid, lane);
    wait_vm0(); __syncthreads();
    for (int it = 0; it < ntc; ++it) {
        unsigned char* cur = lds + (it & 1) * 16384;
        if (it + 1 < ntc) load_tile64(kc + (size_t)(it + 1) * 64 * 64, 64, lds + ((it + 1) & 1) * 16384, wid, lane);
        nsa_tile<0, 0>(cur, cur + 8192, lds, Qf, O, m, l, it, L, qrow);
        wait_vm0(); __syncthreads();
    }
#pragma unroll
    for (int nt = 0; nt < 4; ++nt) { l[nt] = rows_sum(l[nt]); l[nt] = l[nt] > 0.f ? 1.f / l[nt] : 0.f; }
#pragma unroll
    for (int mt = 0; mt < 4; ++mt)
#pragma unroll
        for (int nt = 0; nt < 4; ++nt) O[mt][nt] = (f32x4){0.f, 0.f, 0.f, 0.f};
    load_tile64(kc, 64, lds, wid, lane); load_tile64(vc, 512, lds + 8192, wid, lane);
    wait_vm0(); __syncthreads();
    for (int it = 0; it < ntc; ++it) {
        unsigned char* cur = lds + (it & 1) * 16384;
        if (it + 1 < ntc) { unsigned char* nx = lds + ((it + 1) & 1) * 16384;
            load_tile64(kc + (size_t)(it + 1) * 64 * 64, 64, nx, wid, lane); load_tile64(vc + (it + 1) * 64, 512, nx + 8192, wid, lane); }
        nsa_tile<0, 1>(cur, cur + 8192, lds, Qf, O, m, l, it, L, qrow);
        wait_vm0(); __syncthreads();
    }
    bf16_t* YC = (bf16_t*)(ws + WS_YC) + tok * 512 + (4 * g) * 64;
#pragma unroll
    for (int nt = 0; nt < 4; ++nt) {
        const float gt = bf2f(gates[nt * 3 + 0]);
#pragma unroll
        for (int mt = 0; mt < 4; ++mt) *(u32x2*)(YC + nt * 64 + 16 * mt + 4 * fq) = pack4(O[mt][nt] * gt);
    }
    const int cur = qt;
    {
        float* imp = (float*)(lds + NSA_IMP) + qrow * 129 + 32 * fq;
        asm volatile("s_waitcnt lgkmcnt(0)" ::: "memory"); __builtin_amdgcn_wave_barrier();
#pragma unroll
        for (int i = 0; i < 32; ++i) {
            const int j = 32 * fq + i;
            const float v = imp[i];
            imp[i] = j > cur ? -1.f : v + ((j == 0 || j == cur || j == cur - 1) ? 1.0e4f : 0.f);
        }
        unsigned word = 0;
#pragma unroll 1
        for (int round = 0; round < 16; ++round) {
            float bv = imp[0]; int bi = 0;
#pragma unroll
            for (int i = 1; i < 32; ++i) { const float v = imp[i]; if (v > bv) { bv = v; bi = i; } }
            int gi = 32 * fq + bi;
            {
                u32x2 rv = __builtin_amdgcn_permlane16_swap(__float_as_uint(bv), __float_as_uint(bv), false, false);
                u32x2 ri = __builtin_amdgcn_permlane16_swap((unsigned)gi, (unsigned)gi, false, false);
                float v0 = __uint_as_float(rv.x), v1 = __uint_as_float(rv.y); int i0 = (int)ri.x, i1 = (int)ri.y;
                if (v1 > v0 || (v1 == v0 && i1 < i0)) { v0 = v1; i0 = i1; }
                rv = __builtin_amdgcn_permlane32_swap(__float_as_uint(v0), __float_as_uint(v0), false, false);
                ri = __builtin_amdgcn_permlane32_swap((unsigned)i0, (unsigned)i0, false, false);
                v0 = __uint_as_float(rv.x); v1 = __uint_as_float(rv.y); i0 = (int)ri.x; i1 = (int)ri.y;
                if (v1 > v0 || (v1 == v0 && i1 < i0)) { v0 = v1; i0 = i1; }
                bv = v0; gi = i0;
            }
            if (bv >= 0.f && (gi >> 5) == fq) { word |= 1u << (gi & 31); imp[gi & 31] = -2.f; }
        }
        ((unsigned*)(ws + WS_SELW))[(tok * 2 + g) * 4 + fq] = word;
    }
}

__device__ __forceinline__ void win_item(const Params& p, int item, unsigned char* lds, int half) {
    unsigned char* ws = launder(p.ws);
    const int tid = (ltid() & 255), lane = tid & 63, wid = tid >> 6, fr = lane & 15, fq = lane >> 4;
    const int combo = item & 3, qt = 127 - (item >> 2), b = combo >> 1, g = combo & 1;
    const int q0 = qt * 64, qrow = 16 * wid + fr;
    NsaLane L; L.t = q0 + qrow; L.fr = fr; L.fq = fq; L.wid = wid; L.lane = lane;
    const size_t tok = (size_t)b * S_ + L.t;
    const bf16_t* P = (const bf16_t*)(ws + WS_P);
    __syncthreads();
    if (tid < 128) ((float*)(lds + NSA_BIAS))[tid] = p.rel_bias[(tid & 31) * 8 + 4 * g + (tid >> 5)] * LOG2E;
    bf16x8 Qf[4][2];
#pragma unroll
    for (int nt = 0; nt < 4; ++nt)
#pragma unroll
        for (int ks = 0; ks < 2; ++ks) Qf[nt][ks] = *(const bf16x8*)(P + tok * LD + C_QA + (4 * g + nt) * 64 + 32 * ks + 8 * fq);
    __syncthreads();
    f32x4 O[4][4]; float m[4], l[4];
    const bf16_t* gates = P + tok * LD + C_GA + (4 * g) * 3;
#pragma unroll
    for (int nt = 0; nt < 4; ++nt) { m[nt] = -1e30f; l[nt] = 0.f; }
#pragma unroll
    for (int mt = 0; mt < 4; ++mt)
#pragma unroll
        for (int nt = 0; nt < 4; ++nt) O[mt][nt] = (f32x4){0.f, 0.f, 0.f, 0.f};
    {
        const bf16_t* kb = P + ((size_t)b * S_) * LD + C_KW + g * 64;
        const bf16_t* vb = (const bf16_t*)(ws + WS_VWT) + (size_t)(b * 2 + g) * 64 * S_;
        const int k_lo = qt - 8 > 0 ? qt - 8 : 0, ntw = qt - k_lo + 1;
        load_tile64(kb + (size_t)k_lo * 64 * LD, LD, lds, wid, lane); load_tile64(vb + k_lo * 64, S_, lds + 8192, wid, lane);
        wait_vm0(); __syncthreads();
        for (int it = 0; it < ntw; ++it) {
            unsigned char* cu = lds + (it & 1) * 16384;
            if (it + 1 < ntw) { unsigned char* nx = lds + ((it + 1) & 1) * 16384;
                load_tile64(kb + (size_t)(k_lo + it + 1) * 64 * LD, LD, nx, wid, lane); load_tile64(vb + (k_lo + it + 1) * 64, S_, nx + 8192, wid, lane); }
            nsa_tile<2, 2>(cu, cu + 8192, lds, Qf, O, m, l, k_lo + it, L, qrow);
            wait_vm0(); __syncthreads();
        }
    }
    bf16_t* YW = (bf16_t*)(ws + WS_YW) + tok * 512 + (4 * g) * 64;
#pragma unroll
    for (int nt = 0; nt < 4; ++nt) {
        const float lt = rows_sum(l[nt]), gt = bf2f(gates[nt * 3 + 2]) * (lt > 0.f ? 1.f / lt : 0.f);
#pragma unroll
        for (int mt = 0; mt < 4; ++mt) *(u32x2*)(YW + nt * 64 + 16 * mt + 4 * fq) = pack4(O[mt][nt] * gt);
    }
}

constexpr int SEL_RING = 8, SEL_BUCKET = SEL_RING * 16384, SEL_BIAS2 = SEL_BUCKET + 8192;
template <bool FAST>
__device__ __forceinline__ void sel_ntile(const bf16x8 (&Kf)[4][2], const unsigned char* vL, int fr, int fq, const bf16x8& q0, const bf16x8& q1, f32x4 (&O)[4], float& m, float& l,
                                          bool sb, int relb, int th, float blo, float bhi, const unsigned char* lds, int hl) {
    f32x4 S[4];
#pragma unroll
    for (int i = 0; i < 4; ++i) { S[i] = (f32x4){0.f, 0.f, 0.f, 0.f}; S[i] = mfma16(Kf[i][0], q0, S[i]); S[i] = mfma16(Kf[i][1], q1, S[i]); }
    float tmax = -1e30f;
    const float scl = (!FAST || sb) ? 0.125f * LOG2E : 0.f;
    if (FAST) { blo = (sb ? blo : -1e30f) - m; bhi = (sb ? bhi : -1e30f) - m; }
    if (FAST) {
#pragma unroll
        for (int i = 0; i < 4; ++i)
#pragma unroll
            for (int r = 0; r < 4; ++r) { const int rel = relb - (16 * i + r); S[i][r] = S[i][r] * scl + (rel >= th ? bhi : blo); tmax = fmaxf(tmax, S[i][r]); }
    } else {
        unsigned bkt[4][4]; float bs[4][4];
#pragma unroll
        for (int i = 0; i < 4; ++i)
#pragma unroll
            for (int r = 0; r < 4; ++r) { const int rel = relb - (16 * i + r); int rc = rel < 0 ? 0 : rel; rc = rc > 8191 ? 8191 : rc; bkt[i][r] = (lds + SEL_BUCKET)[rc]; }
#pragma unroll
        for (int i = 0; i < 4; ++i)
#pragma unroll
            for (int r = 0; r < 4; ++r) bs[i][r] = ((const float*)(lds + SEL_BIAS2))[hl * 32 + bkt[i][r]];
        asm volatile("" : "+v"(bs[0][0]), "+v"(bs[0][1]), "+v"(bs[0][2]), "+v"(bs[0][3]), "+v"(bs[1][0]), "+v"(bs[1][1]), "+v"(bs[1][2]), "+v"(bs[1][3]),
                          "+v"(bs[2][0]), "+v"(bs[2][1]), "+v"(bs[2][2]), "+v"(bs[2][3]), "+v"(bs[3][0]), "+v"(bs[3][1]), "+v"(bs[3][2]), "+v"(bs[3][3]));
        const float ninf = -1e30f;
#pragma unroll
        for (int i = 0; i < 4; ++i)
#pragma unroll
            for (int r = 0; r < 4; ++r) {
                const int rel = relb - (16 * i + r);
                const float sv = S[i][r] * (0.125f * LOG2E) + (bs[i][r] - m);
                S[i][r] = (sb && rel >= 0) ? sv : ninf; tmax = fmaxf(tmax, S[i][r]);
            }
    }
    tmax = rows_max(tmax);
    if (__ballot(tmax > 8.f) != 0ull) {
        const float d = fmaxf(tmax, 0.f), alpha = __builtin_amdgcn_exp2f(-d);
        m += d; l *= alpha;
#pragma unroll
        for (int mt = 0; mt < 4; ++mt) O[mt] = O[mt] * alpha;
#pragma unroll
        for (int i = 0; i < 4; ++i)
#pragma unroll
            for (int r = 0; r < 4; ++r) S[i][r] -= d;
    }
    float psum = 0.f;
#pragma unroll
    for (int i = 0; i < 4; ++i)
#pragma unroll
        for (int r = 0; r < 4; ++r) { const float pv = __builtin_amdgcn_exp2f(S[i][r]); S[i][r] = pv; psum += pv; }
    l += rows_sum(psum);
    const bf16x8 Pb0 = pack8(S[0], S[1]), Pb1 = pack8(S[2], S[3]);
#pragma unroll
    for (int mt = 0; mt < 4; ++mt) { O[mt] = mfma16(lds_vfrag128(vL, 16 * mt + fr, 0, fq), Pb0, O[mt]); O[mt] = mfma16(lds_vfrag128(vL, 16 * mt + fr, 32, fq), Pb1, O[mt]); }
}
__device__ __forceinline__ void sel_ntile2_fast(const bf16x8 (&Kf)[4][2], const unsigned char* vL, int fr, int fq, const bf16x8 (&Qf)[2][2], f32x4 (&O)[2][4], float (&m)[2], float (&l)[2],
                                                const bool (&sb)[2], const int (&relb)[2], int th, float blo, float bhi) {
    f32x4 S[2][4]; float tmax[2], bl[2], bh[2], scl[2];
#pragma unroll
    for (int b = 0; b < 2; ++b)
#pragma unroll
        for (int i = 0; i < 4; ++i) { S[b][i] = (f32x4){0.f, 0.f, 0.f, 0.f}; S[b][i] = mfma16(Kf[i][0], Qf[b][0], S[b][i]); S[b][i] = mfma16(Kf[i][1], Qf[b][1], S[b][i]); }
#pragma unroll
    for (int b = 0; b < 2; ++b) { scl[b] = sb[b] ? 0.125f * LOG2E : 0.f; bl[b] = (sb[b] ? blo : -1e30f) - m[b]; bh[b] = (sb[b] ? bhi : -1e30f) - m[b]; tmax[b] = -1e30f; }
#pragma unroll
    for (int b = 0; b < 2; ++b)
#pragma unroll
        for (int i = 0; i < 4; ++i)
#pragma unroll
            for (int r = 0; r < 4; ++r) { const int rel = relb[b] - (16 * i + r); S[b][i][r] = S[b][i][r] * scl[b] + (rel >= th ? bh[b] : bl[b]); tmax[b] = fmaxf(tmax[b], S[b][i][r]); }
#pragma unroll
    for (int b = 0; b < 2; ++b) tmax[b] = rows_max(tmax[b]);
    if (__ballot(tmax[0] > 8.f || tmax[1] > 8.f) != 0ull) {
#pragma unroll
        for (int b = 0; b < 2; ++b) {
            const float d = fmaxf(tmax[b], 0.f), alpha = __builtin_amdgcn_exp2f(-d);
            m[b] += d; l[b] *= alpha;
#pragma unroll
            for (int mt = 0; mt < 4; ++mt) O[b][mt] = O[b][mt] * alpha;
#pragma unroll
            for (int i = 0; i < 4; ++i)
#pragma unroll
                for (int r = 0; r < 4; ++r) S[b][i][r] -= d;
        }
    }
    float psum[2] = {0.f, 0.f};
#pragma unroll
    for (int b = 0; b < 2; ++b)
#pragma unroll
        for (int i = 0; i < 4; ++i)
#pragma unroll
            for (int r = 0; r < 4; ++r) { const float pv = __builtin_amdgcn_exp2f(S[b][i][r]); S[b][i][r] = pv; psum[b] += pv; }
#pragma unroll
    for (int b = 0; b < 2; ++b) l[b] += rows_sum(psum[b]);
    bf16x8 P0[2], P1[2];
#pragma unroll
    for (int b = 0; b < 2; ++b) { P0[b] = pack8(S[b][0], S[b][1]); P1[b] = pack8(S[b][2], S[b][3]); }
#pragma unroll
    for (int mt = 0; mt < 4; ++mt) {
        const bf16x8 v0 = lds_vfrag128(vL, 16 * mt + fr, 0, fq), v1 = lds_vfrag128(vL, 16 * mt + fr, 32, fq);
#pragma unroll
        for (int b = 0; b < 2; ++b) { O[b][mt] = mfma16(v0, P0[b], O[b][mt]); O[b][mt] = mfma16(v1, P1[b], O[b][mt]); }
    }
}
template <bool FAST>
__device__ __forceinline__ void sel_tile(const unsigned char* kL, const unsigned char* vL, const unsigned char* lds, const bf16x8 (&Qf)[2][2], f32x4 (&O)[2][4], float (&m)[2], float (&l)[2],
                                         const bool (&sb)[2], const bool (&need)[2], const int (&relb)[2], int th, float blo, float bhi, int hl, int fr, int fq) {
    bf16x8 Kf[4][2];
#pragma unroll
    for (int i = 0; i < 4; ++i)
#pragma unroll
        for (int ks = 0; ks < 2; ++ks) Kf[i][ks] = lds_frag128(kL, 16 * i + fr, 4 * ks + fq);
    if (FAST && need[0] && need[1]) { sel_ntile2_fast(Kf, vL, fr, fq, Qf, O, m, l, sb, relb, th, blo, bhi); return; }
    if (need[0]) sel_ntile<FAST>(Kf, vL, fr, fq, Qf[0][0], Qf[0][1], O[0], m[0], l[0], sb[0], relb[0], th, blo, bhi, lds, hl);
    if (need[1]) sel_ntile<FAST>(Kf, vL, fr, fq, Qf[1][0], Qf[1][1], O[1], m[1], l[1], sb[1], relb[1], th, blo, bhi, lds, hl);
}
template <int VAR>
__device__ __forceinline__ void sel_item(const Params& p, int v, unsigned char* lds) {
    unsigned char* ws = launder(p.ws);
    const int tid = ltid(), lane = tid & 63, wid = tid >> 6, fr = lane & 15, fq = lane >> 4;
    const int qt = 127 - (v >> 2), sub = v & 3, b = sub >> 1, g = sub & 1;
    const int q0 = qt * 64, cur = qt, hl = fr & 3;
    const bf16_t* P = (const bf16_t*)(ws + WS_P);
    __syncthreads();
    if (tid < 128) ((float*)(lds + SEL_BIAS2))[tid] = p.rel_bias[(tid & 31) * 8 + 4 * g + (tid >> 5)] * LOG2E;
    int t[2]; size_t tok[2]; bf16x8 Qf[2][2]; unsigned selw[2][4];
#pragma unroll
    for (int nt = 0; nt < 2; ++nt) {
        t[nt] = q0 + 8 * wid + 4 * nt + (fr >> 2); tok[nt] = (size_t)b * S_ + t[nt];
#pragma unroll
        for (int ks = 0; ks < 2; ++ks) Qf[nt][ks] = *(const bf16x8*)(P + tok[nt] * LD + C_QA + (4 * g + hl) * 64 + 32 * ks + 8 * fq);
        const u32x4 w = *(const u32x4*)((const unsigned*)(ws + WS_SELW) + (tok[nt] * 2 + g) * 4);
        selw[nt][0] = w.x; selw[nt][1] = w.y; selw[nt][2] = w.z; selw[nt][3] = w.w;
    }
    f32x4 O[2][4]; float m[2], l[2];
#pragma unroll
    for (int nt = 0; nt < 2; ++nt) { m[nt] = -1000.f; l[nt] = 0.f;
#pragma unroll
        for (int mt = 0; mt < 4; ++mt) O[nt][mt] = (f32x4){0.f, 0.f, 0.f, 0.f}; }
    const bf16_t* kb = P + ((size_t)b * S_) * LD + C_KS + g * 64;
    const bf16_t* vb = (const bf16_t*)(ws + WS_VST) + (size_t)(b * 2 + g) * 64 * S_;
    const int nts = cur + 1;
#define SEL_ISSUE(jj) do { unsigned char* st_ = lds + ((jj) & 7) * 16384; const int c_ = ((lane & 7) ^ (lane >> 3)) * 8, r_ = 8 * wid + (lane >> 3); \
        glds16(kb + ((size_t)(jj) * 64 + r_) * LD + c_, st_ + wid * 1024); glds16(vb + (size_t)r_ * S_ + (jj) * 64 + c_, st_ + 8192 + wid * 1024); } while (0)
    asm volatile("s_waitcnt vmcnt(0)" ::: "memory");
#pragma unroll
    for (int q = 0; q < 4; ++q) if (q < nts) SEL_ISSUE(q);
    const unsigned char* bucketL = lds + SEL_BUCKET;
    for (int jp = 0; jp < nts; jp += 4) {
        WAIT_V(0);
        RAW_BARRIER();
#pragma unroll
        for (int q = 4; q < 8; ++q) if (jp + q < nts) SEL_ISSUE(jp + q);
#pragma unroll 1
      for (int j = jp; j < jp + 4 && j < nts; ++j) {
        const unsigned char* cu = lds + (j & 7) * 16384;
        bool sb[2], need[2]; int relb[2];
#pragma unroll
        for (int nt = 0; nt < 2; ++nt) {
            const unsigned w = j < 32 ? selw[nt][0] : j < 64 ? selw[nt][1] : j < 96 ? selw[nt][2] : selw[nt][3];
            sb[nt] = (w >> (j & 31)) & 1u; need[nt] = __ballot(sb[nt]) != 0ull; relb[nt] = t[nt] - 64 * j - 4 * fq;
        }
        if (VAR == 1) { need[0] = false; need[1] = false; }
        if (VAR == 2) { if (!(need[0] || need[1])) { need[0] = false; } else { need[0] = true; need[1] = true; } }
        if (need[0] || need[1]) {
            const int rmin = q0 - 64 * j - 63, rmax = q0 + 31 - 64 * j;
            bool fast = false; int th = 0; float blo = 0.f, bhi = 0.f;
            if (rmin >= 16) {
                const int b0 = bucketL[rmin], b1 = bucketL[rmax > 8191 ? 8191 : rmax];
                if (b1 - b0 <= 1) { fast = true; th = t5_first(b1); if (b1 == b0) th = 0;
                    blo = ((const float*)(lds + SEL_BIAS2))[hl * 32 + b0]; bhi = ((const float*)(lds + SEL_BIAS2))[hl * 32 + b1]; }
            }
            if (fast) sel_tile<true>(cu, cu + 8192, lds, Qf, O, m, l, sb, need, relb, th, blo, bhi, hl, fr, fq);
            else sel_tile<false>(cu, cu + 8192, lds, Qf, O, m, l, sb, need, relb, th, blo, bhi, hl, fr, fq);
        }
      }
    }
#undef SEL_ISSUE
    __syncthreads();
#pragma unroll
    for (int nt = 0; nt < 2; ++nt) {
        const float gt = bf2f(P[tok[nt] * LD + C_GA + (4 * g + hl) * 3 + 1]) * (l[nt] > 0.f ? 1.f / l[nt] : 0.f);
        const size_t o = tok[nt] * 512 + (4 * g + hl) * 64;
#pragma unroll
        for (int mt = 0; mt < 4; ++mt) {
            const f32x4 yc = unpack4(*(const u32x2*)((const bf16_t*)(ws + WS_YC) + o + 16 * mt + 4 * fq));
            const f32x4 yw = unpack4(*(const u32x2*)((const bf16_t*)(ws + WS_YW) + o + 16 * mt + 4 * fq));
            if (VAR == 0 || VAR == 3) *(u32x2*)((bf16_t*)(ws + WS_YA) + tok[nt] * 1536 + (4 * g + hl) * 64 + 16 * mt + 4 * fq) = pack4(yc + yw + O[nt][mt] * gt);
            else asm volatile("" :: "v"(O[nt][mt]));
        }
    }
}

__device__ __forceinline__ void scan_item(const Params& p, int item, int half) {
    unsigned char* ws = launder(p.ws);
    const int idx = item * HT + (ltid() & 255);
    const int bh = idx >> 13, ed = idx & 8191, h = bh & 7;
    const float dec = exp2f(128.f * ret_lg2(h));
    const float* KVT = (const float*)(ws + WS_KVT) + (size_t)bh * 64 * 8192 + ed;
    bf16_t* SPT = (bf16_t*)(ws + WS_SPT) + (size_t)bh * 64 * 8192 + ed;
    float s = 0.f;
#pragma unroll
    for (int n0 = 0; n0 < 64; n0 += 32) {
        float kv[32];
#pragma unroll
        for (int n = 0; n < 32; ++n) kv[n] = KVT[(size_t)(n0 + n) * 8192];
#pragma unroll
        for (int n = 0; n < 32; ++n) { SPT[(size_t)(n0 + n) * 8192] = f2bf(s); s = s * dec + kv[n]; }
    }
}

__device__ __forceinline__ void phase_p3(const Params& p, unsigned char* lds, int half, int what) {
    for (int i = (ltid() & 255); i < 8192 / 16; i += HT) ((u32x4*)(lds + NSA_BUCKET))[i] = ((const u32x4*)(launder(p.ws) + WS_BUCKET))[i];
    __syncthreads();
    for (int h = (blockIdx.x * 2 + half); h < 512; h += (gridDim.x * 2)) {
        if (what & 1) cmp_item(p, h, lds, half);
        if (what & 2) {
            if (h >= 128 && h < 384) win_item(p, h - 128, lds, half);
            else if (h >= 384) { win_item(p, 256 + 2 * (h - 384) - ((h & 1) ? 1 : 0) , lds, half); win_item(p, 256 + 2 * (h - 384) + ((h & 1) ? 0 : 1) + 1 - ((h & 1) ? 0 : 0), lds, half); }
        }
        if (what & 4) scan_item(p, h, half);
    }
}

__device__ __forceinline__ void retout_item(const Params& p, int item, unsigned char* lds, int half) {
    unsigned char* ws = launder(p.ws);
    const int tid = (ltid() & 255), lane = tid & 63, wid = tid >> 6, fr = lane & 15, fq = lane >> 4;
    const int n = item & 63, h = (item >> 6) & 7, b = item >> 9;
    const size_t tok0 = (size_t)b * S_ + 128 * n;
    const bf16_t* P = (const bf16_t*)(ws + WS_P);
    unsigned char* vL = lds; unsigned char* kL = lds + 32768; unsigned char* sL = lds + 49152;
    __syncthreads();
    load_tile128w((const bf16_t*)(ws + WS_VRT) + ((size_t)(b * 8 + h) * 128) * S_ + 128 * n, S_, vL, wid, lane);
    load_tile128(P + tok0 * LD + C_KR + h * 64, LD, kL, wid, lane);
    load_tile128((const bf16_t*)(ws + WS_SPT) + ((size_t)(b * 8 + h) * 64 + n) * 8192, 64, sL, wid, lane);
    bf16x8 Qf[2][2];
#pragma unroll
    for (int nt = 0; nt < 2; ++nt)
#pragma unroll
        for (int ks = 0; ks < 2; ++ks) Qf[nt][ks] = *(const bf16x8*)(P + (tok0 + 32 * wid + 16 * nt + fr) * LD + C_QR + h * 64 + 32 * ks + 8 * fq);
    wait_vm0(); __syncthreads();
    const float lg2 = ret_lg2(h);
    f32x4 Y[8][2];
#pragma unroll
    for (int m = 0; m < 8; ++m)
#pragma unroll
        for (int nt = 0; nt < 2; ++nt) Y[m][nt] = (f32x4){0.f, 0.f, 0.f, 0.f};
#pragma unroll
    for (int m = 0; m < 8; ++m)
#pragma unroll
        for (int ks = 0; ks < 2; ++ks) {
            const bf16x8 a = lds_frag128(sL, 16 * m + fr, 4 * ks + fq);
#pragma unroll
            for (int nt = 0; nt < 2; ++nt) Y[m][nt] = mfma16(a, Qf[nt][ks], Y[m][nt]);
        }
#pragma unroll
    for (int nt = 0; nt < 2; ++nt) {
        const float sc = exp2f((float)(32 * wid + 16 * nt + fr + 1) * lg2);
#pragma unroll
        for (int m = 0; m < 8; ++m) Y[m][nt] = Y[m][nt] * sc;
    }
#pragma unroll 1
    for (int s = 0; s < 4; ++s) {
        f32x4 St[2][2];
#pragma unroll
        for (int hh = 0; hh < 2; ++hh) {
            const int mt = 2 * s + hh;
#pragma unroll
            for (int nt = 0; nt < 2; ++nt) St[hh][nt] = (f32x4){0.f, 0.f, 0.f, 0.f};
#pragma unroll
            for (int ks = 0; ks < 2; ++ks) {
                const bf16x8 a = lds_frag128(kL, 16 * mt + fr, 4 * ks + fq);
#pragma unroll
                for (int nt = 0; nt < 2; ++nt) St[hh][nt] = mfma16(a, Qf[nt][ks], St[hh][nt]);
            }
#pragma unroll
            for (int nt = 0; nt < 2; ++nt) {
                const int qi = 32 * wid + 16 * nt + fr;
#pragma unroll
                for (int r = 0; r < 4; ++r) {
                    const int kj = 16 * mt + 4 * fq + r;
                    const float dm = qi >= kj ? exp2f((float)(qi - kj) * lg2) : 0.f;
                    St[hh][nt][r] *= dm;
                }
            }
        }
        bf16x8 Pb[2];
#pragma unroll
        for (int nt = 0; nt < 2; ++nt) Pb[nt] = pack8(St[0][nt], St[1][nt]);
#pragma unroll
        for (int m = 0; m < 8; ++m) {
            const bf16x8 a = lds_vfrag256(vL, 16 * m + fr, 32 * s, fq);
#pragma unroll
            for (int nt = 0; nt < 2; ++nt) Y[m][nt] = mfma16(a, Pb[nt], Y[m][nt]);
        }
    }
    bf16_t* YB = (bf16_t*)(ws + WS_YA) + 512;
#pragma unroll
    for (int nt = 0; nt < 2; ++nt) {
        float sum = 0.f;
#pragma unroll
        for (int m = 0; m < 8; ++m) sum += Y[m][nt][0] + Y[m][nt][1] + Y[m][nt][2] + Y[m][nt][3];
        sum = rows_sum(sum);
        const float mu = sum * (1.f / 128.f);
        float vs = 0.f;
#pragma unroll
        for (int m = 0; m < 8; ++m)
#pragma unroll
            for (int r = 0; r < 4; ++r) { const float dlt = Y[m][nt][r] - mu; vs += dlt * dlt; }
        vs = rows_sum(vs);
        const float rstd = rsqrtf(vs * (1.f / 128.f) + 1e-5f);
        const size_t tk = tok0 + 32 * wid + 16 * nt + fr;
#pragma unroll
        for (int m = 0; m < 8; ++m) {
            const f32x4 gt = unpack4(*(const u32x2*)(P + tk * LD + C_GR + h * 128 + 16 * m + 4 * fq));
            f32x4 v;
#pragma unroll
            for (int r = 0; r < 4; ++r) v[r] = (Y[m][nt][r] - mu) * rstd * gt[r];
            *(u32x2*)(YB + tk * 1536 + h * 128 + 16 * m + 4 * fq) = pack4(v);
        }
    }
}
__device__ __forceinline__ void phase_p4_sel(const Params& p, unsigned char* lds) {
    for (int i = ltid(); i < 8192 / 16; i += NTHREADS) ((u32x4*)(lds + SEL_BUCKET))[i] = ((const u32x4*)(launder(p.ws) + WS_BUCKET))[i];
    __syncthreads();
    for (int it = blockIdx.x; it < 512; it += gridDim.x * 2) {
        sel_item<0>(p, it, lds);
        if (511 - it != it) sel_item<0>(p, 511 - it, lds);
    }
    __syncthreads();
}
__device__ __forceinline__ void phase_p4(const Params& p, unsigned char* lds, int half) {
    for (int it = (blockIdx.x * 2 + half); it < 1024; it += (gridDim.x * 2)) retout_item(p, it, lds, half);
}

struct RowOrder {     typedef pg8::Unit U; static constexpr bool GATHER = false;
    unsigned a, b; int K, xcd, slot, per;
    __device__ __forceinline__ bool next(int i, pg8::Unit& u) const { const int t = xcd * 32 + slot + i * per; if (t >= (xcd + 1) * 32) return false; u.pm = t >> 2; u.pn = t & 3; return true; }
    __device__ __forceinline__ void ptrs(const pg8::Unit& u, unsigned& A, unsigned& B) const { A = a + (unsigned)u.pm * 512u * (unsigned)K; B = b + (unsigned)u.pn * 512u * (unsigned)K; }
};
template <int MODE>
struct MixEpi {
    static constexpr int MID_T = MODE == 0 ? 8 : 0;
    unsigned char* ws; const float* X;
    __device__ __forceinline__ void mid(f32x4 (&acc)[2][2][4][2], const pg8::Unit& u, int wr, int wc, int fr, int fq) const {
#pragma unroll
        for (int ai = 0; ai < 2; ++ai) {
            __builtin_amdgcn_sched_barrier(0);
#pragma unroll
            for (int m = 0; m < 4; ++m) {
                const size_t tok = (size_t)(u.pm * 256 + 128 * ai + 64 * wr + 16 * m + fr + vzero());
#pragma unroll
                for (int bj = 0; bj < 2; ++bj) {
                    const int n = u.pn * 256 + 128 * bj + 32 * wc + 8 * fq;
                    const u32x4 ga = *(const u32x4*)((const bf16_t*)(ws + WS_P) + tok * LD + C_MA + n), gb = *(const u32x4*)((const bf16_t*)(ws + WS_P) + tok * LD + C_MB + n);
                    const f32x4 a0 = unpack4((u32x2){ga.x, ga.y}), a1 = unpack4((u32x2){ga.z, ga.w}), b0 = unpack4((u32x2){gb.x, gb.y}), b1 = unpack4((u32x2){gb.z, gb.w});
#pragma unroll
                    for (int r = 0; r < 4; ++r) { acc[ai][bj][m][0][r] *= a0[r] * __builtin_amdgcn_rcpf(fmaxf(b0[r], 1e-30f)); acc[ai][bj][m][1][r] *= a1[r] * __builtin_amdgcn_rcpf(fmaxf(b1[r], 1e-30f)); }
                }
            }
        }
        __builtin_amdgcn_sched_barrier(0);
    }
    __device__ __forceinline__ void operator()(const f32x4 (&acc)[2][2][4][2], const pg8::Unit& u, int wr, int wc, int fr, int fq) const {
#pragma unroll
        for (int ai = 0; ai < 2; ++ai)
#pragma unroll
            for (int m = 0; m < 4; ++m) {
                const size_t tok = (size_t)(u.pm * 256 + 128 * ai + 64 * wr + 16 * m + fr + vzero());
#pragma unroll
                for (int bj = 0; bj < 2; ++bj) {
                    const int n = u.pn * 256 + 128 * bj + 32 * wc + 8 * fq;
                    const f32x4 v0 = acc[ai][bj][m][0], v1 = acc[ai][bj][m][1];
                    if (MODE == 2) {
                        const u32x4 xw = *(const u32x4*)((const bf16_t*)(ws + WS_XB) + tok * 1024 + n);
                        const f32x4 h0 = unpack4((u32x2){xw.x, xw.y}) * DN_ALPHA + v0, h1 = unpack4((u32x2){xw.z, xw.w}) * DN_ALPHA + v1;
                        u32x4 w; w.x = pack2(h0[0], h0[1]); w.y = pack2(h0[2], h0[3]); w.z = pack2(h1[0], h1[1]); w.w = pack2(h1[2], h1[3]);
                        *(u32x4*)((bf16_t*)(ws + WS_H1) + tok * 1024 + n) = w;
                    } else {
                        const u32x4 gw = *(const u32x4*)((const bf16_t*)(ws + WS_P) + tok * LD + C_MB + n);
                        const f32x4 g0 = unpack4((u32x2){gw.x, gw.y}), g1 = unpack4((u32x2){gw.z, gw.w});
                        const f32x4 o0 = g0 * v0, o1 = g1 * v1;
                        u32x4 w; w.x = pack2(o0[0], o0[1]); w.y = pack2(o0[2], o0[3]); w.z = pack2(o1[0], o1[1]); w.w = pack2(o1[2], o1[3]);
                        *(u32x4*)((bf16_t*)(ws + WS_MG) + tok * 1024 + n) = w;
                    }
                }
            }
    }
};
__device__ __forceinline__ void phase_g2(const Params& p, unsigned char* lds) {
    unsigned char* ws = launder(p.ws);
    RowOrder S; S.xcd = blockIdx.x & 7; S.slot = blockIdx.x >> 3; S.per = gridDim.x >> 3;
    S.a = (unsigned)WS_YA; S.b = (unsigned)WS_WA; S.K = 1536; MixEpi<0> E; E.ws = ws; E.X = nullptr;
    pg8::gemm_phase<MixEpi<0>, RowOrder>(lds, 1536, S, E, ltid(), ws);
}
__device__ __forceinline__ void phase_g3(const Params& p, int layer, unsigned char* lds) {
    unsigned char* ws = launder(p.ws);
    RowOrder S; S.xcd = blockIdx.x & 7; S.slot = blockIdx.x >> 3; S.per = gridDim.x >> 3; S.a = (unsigned)WS_MG; S.b = (unsigned)WS_WO; S.K = 1024;
    MixEpi<2> E; E.ws = ws; E.X = nullptr;
    pg8::gemm_phase<MixEpi<2>, RowOrder>(lds, 1024, S, E, ltid(), ws);
}

__device__ __forceinline__ void phase_ln1(const Params& p, int layer, unsigned char* lds, bool dry, int half) {
    unsigned char* ws = launder(p.ws);
    const int tid = (ltid() & 255), lane = tid & 63, wid = tid >> 6;
    float* wrL = (float*)lds;
    float* lgL = (float*)(lds - half * HALF_LDS + 65536);
    {
        float4 wv[16];
#pragma unroll
        for (int k = 0; k < 16; ++k) wv[k] = ((const float4*)p.w_router)[tid + 256 * k];
#pragma unroll
        for (int k = 0; k < 16; ++k) { const int i4 = tid + 256 * k, d = i4 >> 2, e0 = (i4 & 3) * 4;
            wrL[(e0 + 0) * 1024 + d] = wv[k].x; wrL[(e0 + 1) * 1024 + d] = wv[k].y; wrL[(e0 + 2) * 1024 + d] = wv[k].z; wrL[(e0 + 3) * 1024 + d] = wv[k].w; }
    }
    __syncthreads();
    const bf16_t* H1 = (const bf16_t*)(ws + WS_H1);
    bf16_t* X1B = (bf16_t*)(ws + WS_X1B);
    const float* gam = p.ln1_g + layer * 1024; const float* bet = p.ln1_b + layer * 1024;
    unsigned* cnt = (unsigned*)(ws + WS_CTL) + (dry ? 0 : CW_CNT) + layer * 1024;
    int* LIST = (int*)(ws + (dry ? WS_HB : WS_LIST)); float* WTS = (float*)(ws + (dry ? WS_HB + 4194304 : WS_WTS));
    constexpr int U = 4;
    const int nwave = (gridDim.x * 2) * 4, wv = (blockIdx.x * 2 + half) * 4 + wid;
    const int nloc = ((T_ - wv * U + nwave * U - 1) / (nwave * U)) * (4 * U);
    u32x2 vn[U][4];
#pragma unroll
    for (int u = 0; u < U; ++u)
#pragma unroll
        for (int j = 0; j < 4; ++j) vn[u][j] = *(const u32x2*)(H1 + (size_t)(wv * U + u) * 1024 + 256 * j + 4 * lane);
    for (int t0 = wv * U; t0 < T_; t0 += nwave * U) {
        float4 y[U][4]; float s[U], q[U];
#pragma unroll
        for (int u = 0; u < U; ++u) {
            s[u] = 0.f;
#pragma unroll
            for (int j = 0; j < 4; ++j) { const f32x4 t = unpack4(vn[u][j]); y[u][j].x = t[0]; y[u][j].y = t[1]; y[u][j].z = t[2]; y[u][j].w = t[3]; s[u] += (t[0] + t[1]) + (t[2] + t[3]); }
        }
        { const int tn = t0 + nwave * U < T_ ? t0 + nwave * U : t0;
#pragma unroll
          for (int u = 0; u < U; ++u)
#pragma unroll
              for (int j = 0; j < 4; ++j) vn[u][j] = *(const u32x2*)(H1 + (size_t)(tn + u) * 1024 + 256 * j + 4 * lane); }
#pragma unroll
        for (int u = 0; u < U; ++u) s[u] = wave_sum(s[u]) * (1.f / 1024.f);
#pragma unroll
        for (int u = 0; u < U; ++u) {
            q[u] = 0.f;
#pragma unroll
            for (int j = 0; j < 4; ++j) { const float a = y[u][j].x - s[u], b2 = y[u][j].y - s[u], c = y[u][j].z - s[u], d = y[u][j].w - s[u]; q[u] += a * a + b2 * b2 + c * c + d * d; }
        }
#pragma unroll
        for (int u = 0; u < U; ++u) q[u] = rsqrtf(wave_sum(q[u]) * (1.f / 1024.f) + 1e-5f);
#pragma unroll
        for (int j = 0; j < 4; ++j) {
            const int d0 = 256 * j + 4 * lane;
            const float4 gg = *(const float4*)(gam + d0), bb = *(const float4*)(bet + d0);
#pragma unroll
            for (int u = 0; u < U; ++u) {
                y[u][j].x = (y[u][j].x - s[u]) * q[u] * gg.x + bb.x; y[u][j].y = (y[u][j].y - s[u]) * q[u] * gg.y + bb.y;
                y[u][j].z = (y[u][j].z - s[u]) * q[u] * gg.z + bb.z; y[u][j].w = (y[u][j].w - s[u]) * q[u] * gg.w + bb.w;
                u32x2 w; w.x = pack2(y[u][j].x, y[u][j].y); w.y = pack2(y[u][j].z, y[u][j].w);
                *(u32x2*)(X1B + (size_t)(t0 + u) * 1024 + d0) = w;
            }
        }
        float lg[U][16];
#pragma unroll
        for (int e = 0; e < 16; ++e) {
#pragma unroll
            for (int u = 0; u < U; ++u) lg[u][e] = 0.f;
#pragma unroll
            for (int j = 0; j < 4; ++j) { const float4 w4 = *(const float4*)(wrL + e * 1024 + 256 * j + 4 * lane);
#pragma unroll
                for (int u = 0; u < U; ++u) lg[u][e] += y[u][j].x * w4.x + y[u][j].y * w4.y + y[u][j].z * w4.z + y[u][j].w * w4.w; }
        }
        float myl = 0.f;
#pragma unroll
        for (int u = 0; u < U; ++u) {
            float w8[8], z4[4];
#pragma unroll
            for (int e = 0; e < 8; ++e) { const u32x2 r = __builtin_amdgcn_permlane32_swap(__float_as_uint(lg[u][e]), __float_as_uint(lg[u][e + 8]), false, false); w8[e] = __uint_as_float(r.x) + __uint_as_float(r.y); }
#pragma unroll
            for (int e = 0; e < 4; ++e) { const u32x2 r = __builtin_amdgcn_permlane16_swap(__float_as_uint(w8[e]), __float_as_uint(w8[e + 4]), false, false); z4[e] = __uint_as_float(r.x) + __uint_as_float(r.y); }
            const bool h8 = (lane & 8) != 0, h4 = (lane & 4) != 0;
            const float k0 = h8 ? z4[2] : z4[0], s0 = h8 ? z4[0] : z4[2], k1 = h8 ? z4[3] : z4[1], s1 = h8 ? z4[1] : z4[3];
            const float y0 = k0 + __int_as_float(__builtin_amdgcn_mov_dpp(__float_as_int(s0), 0x128, 0xF, 0xF, true));
            const float y1 = k1 + __int_as_float(__builtin_amdgcn_mov_dpp(__float_as_int(s1), 0x128, 0xF, 0xF, true));
            const float k2 = h4 ? y1 : y0, s2 = h4 ? y0 : y1;
            float x = k2 + __int_as_float(__builtin_amdgcn_mov_dpp(__float_as_int(s2), 0x141, 0xF, 0xF, true));
            x += __int_as_float(__builtin_amdgcn_mov_dpp(__float_as_int(x), 0xB1, 0xF, 0xF, true));
            x += __int_as_float(__builtin_amdgcn_mov_dpp(__float_as_int(x), 0x4E, 0xF, 0xF, true));
            if ((lane & 3) == u) myl = x;
        }
        static_assert(U == 4, "lane (l & 3) stores token u = l & 3");
        lgL[(half * nloc + ((t0 - wv * U) / (nwave * U)) * (4 * U) + wid * U + (lane & 3)) * 17 + (lane >> 2)] = myl;
    }
    __syncthreads();
    if (half == 0 && wid == 0)
    for (int l0 = 0; l0 < 2 * nloc; l0 += 64) {
        const int li = l0 + lane; const bool act = li < 2 * nloc;
        const int hq = li >= nloc ? 1 : 0, lh = li - hq * nloc;
        const int it = lh / (4 * U), wq = (lh / U) & 3, uq = lh % U, tok = act ? (((blockIdx.x * 2 + hq) * 4 + wq) * U + uq) + it * (nwave * U) : 0;
        float lgv[16];
#pragma unroll
        for (int e = 0; e < 16; ++e) lgv[e] = lgL[li * 17 + e];
        float mx = lgv[0];
#pragma unroll
        for (int e = 1; e < 16; ++e) mx = fmaxf(mx, lgv[e]);
        float pr[16], ps = 0.f;
#pragma unroll
        for (int e = 0; e < 16; ++e) { pr[e] = expf(lgv[e] - mx); ps += pr[e]; }
        const float ips = 1.f / ps;
        float sel[16];
#pragma unroll
        for (int e = 0; e < 16; ++e) { pr[e] *= ips; sel[e] = pr[e] + p.router_bias[e]; }
        int best = 0; float bestv = -1e30f;
#pragma unroll
        for (int gI = 0; gI < 4; ++gI) {
            float a = -1e30f, b2 = -1e30f;
#pragma unroll
            for (int k = 0; k < 4; ++k) { const float x = sel[4 * gI + k]; if (x > a) { b2 = a; a = x; } else if (x > b2) b2 = x; }
            const float gs = a + b2;
            if (gs > bestv) { bestv = gs; best = gI; }
        }
        float s4[4], p4[4];
#pragma unroll
        for (int k = 0; k < 4; ++k) { s4[k] = 0.f; p4[k] = 0.f; }
#pragma unroll
        for (int gI = 0; gI < 4; ++gI) if (gI == best) {
#pragma unroll
            for (int k = 0; k < 4; ++k) { s4[k] = sel[4 * gI + k]; p4[k] = pr[4 * gI + k]; }
        }
        int i0 = 0; float a0 = s4[0];
#pragma unroll
        for (int k = 1; k < 4; ++k) if (s4[k] > a0) { a0 = s4[k]; i0 = k; }
        int i1 = -1; float a1 = -1e30f;
#pragma unroll
        for (int k = 0; k < 4; ++k) if (k != i0 && s4[k] > a1) { a1 = s4[k]; i1 = k; }
        float w0 = 0.f, w1 = 0.f;
#pragma unroll
        for (int k = 0; k < 4; ++k) { if (k == i0) w0 = p4[k]; if (k == i1) w1 = p4[k]; }
        const float iw = 1.f / (w0 + w1);
        const int e0 = act ? best * 4 + i0 : -1, e1 = act ? best * 4 + i1 : -1;
        unsigned myc = 0, r0 = 0, r1 = 0;
#pragma unroll
        for (int e = 0; e < 16; ++e) {
            const unsigned long long m0 = __builtin_amdgcn_ballot_w64(e0 == e), m1 = __builtin_amdgcn_ballot_w64(e1 == e);
            const unsigned c0 = (unsigned)__builtin_popcountll(m0), c = c0 + (unsigned)__builtin_popcountll(m1);
            if (lane == e) myc = c;
            if (e0 == e) r0 = __builtin_amdgcn_mbcnt_hi((unsigned)(m0 >> 32), __builtin_amdgcn_mbcnt_lo((unsigned)m0, 0u));
            if (e1 == e) r1 = c0 + __builtin_amdgcn_mbcnt_hi((unsigned)(m1 >> 32), __builtin_amdgcn_mbcnt_lo((unsigned)m1, 0u));
        }
        unsigned mybase = 0;
        if (lane < 16 && myc != 0) mybase = atomicAdd(&cnt[lane * 64], myc);
        unsigned b0 = 0, b1 = 0;
#pragma unroll
        for (int e = 0; e < 16; ++e) { const unsigned be = (unsigned)__builtin_amdgcn_readlane((int)mybase, e); if (e0 == e) b0 = be; if (e1 == e) b1 = be; }
        if (act) {
            LIST[(size_t)e0 * T_ + b0 + r0] = tok * 2; LIST[(size_t)e1 * T_ + b1 + r1] = tok * 2 + 1;
            WTS[tok * 2] = w0 * iw; WTS[tok * 2 + 1] = w1 * iw;
        }
    }
}

struct MoeUnit { int e, rt, ct, cnt, off; };
struct MoeOrderBase {
    const unsigned* cntp; int t_lo, t_hi, slot, per;
    __device__ __forceinline__ void init(const unsigned* cnt) {
        cntp = cnt; int ntile = 0;
#pragma unroll
        for (int k = 0; k < NE; ++k) ntile += (__builtin_amdgcn_readfirstlane((int)cnt[k * 64]) >> 8) * 4;
        t_lo = (ntile * (int)(blockIdx.x & 7)) >> 3; t_hi = (ntile * (int)((blockIdx.x & 7) + 1)) >> 3; slot = blockIdx.x >> 3; per = gridDim.x >> 3;
    }
    __device__ __forceinline__ bool next(int i, MoeUnit& u) const {
        const int t = t_lo + slot + i * per; if (t >= t_hi) return false;
        int base = 0, off = 0; bool found = false;
#pragma unroll
        for (int k = 0; k < NE; ++k) {
            const int ck = __builtin_amdgcn_readfirstlane((int)cntp[k * 64]), nt = (ck >> 8) * 4;
            if (!found && t < base + nt) { found = true; u.e = k; u.cnt = ck; u.off = off; u.rt = (t - base) >> 2; u.ct = (t - base) & 3; }
            base += nt; off += ck;
        }
        return found;
    }
};
struct M2Order : MoeOrderBase {
    typedef MoeUnit U; static constexpr bool GATHER = true;
    const int* list;
    __device__ __forceinline__ void ptrs(const MoeUnit& u, unsigned& A, unsigned& B) const { A = (unsigned)WS_X1B; B = (unsigned)WS_WG + ((unsigned)u.e * 1024u + (unsigned)u.ct * 256u) * 2048u; }
    __device__ __forceinline__ void rows(const MoeUnit& u, int tid, unsigned (&v)[2]) const {
        v[0] = 0u; v[1] = 0u;
#pragma unroll
        for (int i = 0; i < 2; ++i) { int R, C; pg8::stage_rc((tid + vzero()) * 16 + i * 8192, R, C);
#pragma unroll
            for (int h = 0; h < 2; ++h) { int idx = u.rt * 256 + 128 * h + R; idx = idx < u.cnt ? idx : u.cnt - 1; const int a = (list + (size_t)u.e * T_)[idx]; v[h] |= (unsigned)(a >> 1) << (16 * i); } }
    }
};
struct M3Order : MoeOrderBase {
    typedef MoeUnit U; static constexpr bool GATHER = false;
    __device__ __forceinline__ void ptrs(const MoeUnit& u, unsigned& A, unsigned& B) const { A = (unsigned)WS_HB + ((unsigned)u.off + (unsigned)u.rt * 256u) * 1024u; B = (unsigned)WS_WD + ((unsigned)u.e * 1024u + (unsigned)u.ct * 256u) * 1024u; }
};
struct M2Epi {
    static constexpr int MID_T = 0;
    unsigned char* ws;
    __device__ __forceinline__ void operator()(const f32x4 (&acc)[2][2][4][2], const MoeUnit& u, int wr, int wc, int fr, int fq) const {
        bf16_t* HB = (bf16_t*)(ws + WS_HB);
#pragma unroll
        for (int ai = 0; ai < 2; ++ai)
#pragma unroll
            for (int m = 0; m < 4; ++m) {
                const int idx = u.rt * 256 + 128 * ai + 64 * wr + 16 * m + fr + vzero();
                if (idx < u.cnt) {
#pragma unroll
                    for (int bj = 0; bj < 2; ++bj) {
                        const int hcol = 4 * (32 * u.ct + 16 * bj + 4 * wc + fq);
                        const f32x4 gv = acc[ai][bj][m][0], uv = acc[ai][bj][m][1]; f32x4 hv;
#pragma unroll
                        for (int r = 0; r < 4; ++r) hv[r] = gv[r] * fsig(gv[r]) * uv[r];
                        *(u32x2*)(HB + (size_t)(u.off + idx) * 512 + hcol) = pack4(hv);
                    }
                }
            }
    }
};
struct M3Epi {
    static constexpr int MID_T = 0;
    unsigned char* ws; const int* list;
    __device__ __forceinline__ void operator()(const f32x4 (&acc)[2][2][4][2], const MoeUnit& u, int wr, int wc, int fr, int fq) const {
        bf16_t* CT = (bf16_t*)(ws + WS_CT);
#pragma unroll
        for (int ai = 0; ai < 2; ++ai)
#pragma unroll
            for (int m = 0; m < 4; ++m) {
                const int idx = u.rt * 256 + 128 * ai + 64 * wr + 16 * m + fr + vzero();
                if (idx < u.cnt) {
                    const int a = list[(size_t)u.e * T_ + idx];
#pragma unroll
                    for (int bj = 0; bj < 2; ++bj) {
                        const int n = u.ct * 256 + 128 * bj + 32 * wc + 8 * fq;
                        const f32x4 v0 = acc[ai][bj][m][0], v1 = acc[ai][bj][m][1];
                        u32x4 w; w.x = pack2(v0[0], v0[1]); w.y = pack2(v0[2], v0[3]); w.z = pack2(v1[0], v1[1]); w.w = pack2(v1[2], v1[3]);
                        *(u32x4*)(CT + (size_t)a * 1024 + n) = w;
                    }
                }
            }
    }
};
template <int MODE>
__device__ __forceinline__ void moe_rem_item(unsigned char* ws, const int* list, int e, int cnt, int off, int rh, int c64, unsigned char* lds) {
    constexpr int K = MODE == 0 ? 1024 : 512, NS = K / 64;
    const int tid = (ltid() & 255), lane = tid & 63, wid = tid >> 6, wr = wid >> 1, wc = wid & 1, fr = lane & 15, fq = lane >> 4;
    const int idx0 = (cnt & ~255) + 128 * rh;
    const int ldc = ((lane & 7) ^ (lane >> 3)) * 8;
    const bf16_t* ap[4];
#pragma unroll
    for (int i = 0; i < 4; ++i) {
        int idx = idx0 + 32 * i + 8 * wid + (lane >> 3); idx = idx < cnt ? idx : cnt - 1;
        if (MODE == 0) { const int a = list[(size_t)e * T_ + idx]; ap[i] = (const bf16_t*)(ws + WS_X1B) + (size_t)(a >> 1) * 1024 + ldc; }
        else ap[i] = (const bf16_t*)(ws + WS_HB) + (size_t)(off + idx) * 512 + ldc;
    }
    const bf16_t* bp[2];
#pragma unroll
    for (int i = 0; i < 2; ++i) {
        const int rho = 8 * (wid + 4 * i) + (lane >> 3), src = (rho & ~31) + pg8::perm32(rho & 31);
        bp[i] = (const bf16_t*)(ws + (MODE == 0 ? WS_WG : WS_WD)) + ((size_t)e * 1024 + 64 * c64 + src) * K + ldc;
    }
    f32x4 acc[4][2];
#pragma unroll
    for (int i = 0; i < 4; ++i)
#pragma unroll
        for (int j = 0; j < 2; ++j) acc[i][j] = (f32x4){0.f, 0.f, 0.f, 0.f};
    __syncthreads();
#define RSTAGE(buf, l) do { unsigned char* st_ = lds + (buf) * 24576; \
        _Pragma("unroll") for (int i = 0; i < 4; ++i) glds16(ap[i] + (l) * 64, st_ + (4 * i + wid) * 1024); \
        _Pragma("unroll") for (int i = 0; i < 2; ++i) glds16(bp[i] + (l) * 64, st_ + 16384 + (wid + 4 * i) * 1024); } while (0)
    RSTAGE(0, 0); RSTAGE(1, 1);
    for (int l = 0; l < NS; ++l) {
        const unsigned char* st = lds + (l % 3) * 24576;
        if (l + 1 < NS) WAIT_V(6); else WAIT_V(0);
        RAW_BARRIER();
        if (l + 2 < NS) RSTAGE((l + 2) % 3, l + 2);
#pragma unroll
        for (int ks = 0; ks < 2; ++ks) {
            bf16x8 a[4], bb[2];
#pragma unroll
            for (int i = 0; i < 4; ++i) a[i] = lds_frag128(st, 64 * wr + 16 * i + fr, 4 * ks + fq);
#pragma unroll
            for (int j = 0; j < 2; ++j) bb[j] = lds_frag128(st + 16384, 32 * wc + 16 * j + fr, 4 * ks + fq);
#pragma unroll
            for (int i = 0; i < 4; ++i)
#pragma unroll
                for (int j = 0; j < 2; ++j) acc[i][j] = mfma16(bb[j], a[i], acc[i][j]);
        }
    }
#undef RSTAGE
#pragma unroll
    for (int i = 0; i < 4; ++i) {
        const int idx = idx0 + 64 * wr + 16 * i + fr + vzero();
        if (idx < cnt) {
            if (MODE == 0) {
                f32x4 hv;
#pragma unroll
                for (int r = 0; r < 4; ++r) hv[r] = acc[i][0][r] * fsig(acc[i][0][r]) * acc[i][1][r];
                *(u32x2*)((bf16_t*)(ws + WS_HB) + (size_t)(off + idx) * 512 + 32 * c64 + 16 * wc + 4 * fq) = pack4(hv);
            } else {
                const int a = list[(size_t)e * T_ + idx];
                const f32x4 v0 = acc[i][0], v1 = acc[i][1];
                u32x4 w; w.x = pack2(v0[0], v0[1]); w.y = pack2(v0[2], v0[3]); w.z = pack2(v1[0], v1[1]); w.w = pack2(v1[2], v1[3]);
                *(u32x4*)((bf16_t*)(ws + WS_CT) + (size_t)a * 1024 + 64 * c64 + 32 * wc + 8 * fq) = w;
            }
        }
    }
    __syncthreads();
}
template <int MODE>
__device__ __forceinline__ void moe_rem(const unsigned* cntp, unsigned char* ws, const int* list, unsigned char* ldsh, int half) {
    for (int t = blockIdx.x * 2 + half; ; t += gridDim.x * 2) {
        int base = 0, off = 0, e = -1, cnt = 0, eoff = 0, loc = 0;
#pragma unroll
        for (int k = 0; k < NE; ++k) {
            const int ck = __builtin_amdgcn_readfirstlane((int)cntp[k * 64]), ni = (((ck & 255) + 127) >> 7) * 16;
            if (e < 0 && t < base + ni) { e = k; cnt = ck; eoff = off; loc = t - base; }
            base += ni; off += ck;
        }
        if (e < 0) break;
        moe_rem_item<MODE>(ws, list, e, cnt, eoff, loc >> 4, loc & 15, ldsh);
    }
}
__device__ __forceinline__ void phase_m2(const Params& p, int layer, unsigned char* lds, unsigned char* ldsh, int half) {
    unsigned char* ws = launder(p.ws);
    M2Order S; S.init((const unsigned*)(ws + WS_CTL) + CW_CNT + layer * 1024 + vzero());
    S.list = (const int*)(ws + WS_LIST);
    M2Epi E; E.ws = ws;
    pg8::gemm_phase<M2Epi, M2Order>(lds, 1024, S, E, ltid(), ws);
    moe_rem<0>(S.cntp, ws, S.list, ldsh, half);
}
__device__ __forceinline__ void phase_m3(const Params& p, int layer, unsigned char* lds, unsigned char* ldsh, int half) {
    unsigned char* ws = launder(p.ws);
    M3Order S; S.init((const unsigned*)(ws + WS_CTL) + CW_CNT + layer * 1024 + vzero());
    M3Epi E; E.ws = ws; E.list = (const int*)(ws + WS_LIST);
    pg8::gemm_phase<M3Epi, M3Order>(lds, 512, S, E, ltid(), ws);
    moe_rem<1>(S.cntp, ws, E.list, ldsh, half);
}

__device__ __forceinline__ void phase_ln2(const Params& p, int layer, int half) {
    unsigned char* ws = launder(p.ws);
    const int tid = (ltid() & 255), lane = tid & 63, wid = tid >> 6;
    const bf16_t* X1 = (const bf16_t*)(ws + WS_X1B); const bf16_t* CT = (const bf16_t*)(ws + WS_CT); const float* WTS = (const float*)(ws + WS_WTS);
    float* XO = p.out; bf16_t* XB = (bf16_t*)(ws + WS_XB); const bool fin = layer == NLAYER - 1;
    const float* gam = p.ln2_g + layer * 1024; const float* bet = p.ln2_b + layer * 1024;
    constexpr int U = 4;
    const int nwave = (gridDim.x * 2) * 4, wv = (blockIdx.x * 2 + half) * 4 + wid;
    for (int t0 = wv * U; t0 < T_; t0 += nwave * U) {
        float4 v[U][4]; float s[U], q[U];
#pragma unroll
        for (int u = 0; u < U; ++u) {
            const int tok = t0 + u;
            const float w0 = WTS[tok * 2 + vzero()], w1 = WTS[tok * 2 + 1 + vzero()];
            s[u] = 0.f; q[u] = 0.f;
#pragma unroll
            for (int j = 0; j < 4; ++j) {
                const int d0 = 256 * j + 4 * lane;
                const f32x4 xt = unpack4(*(const u32x2*)(X1 + (size_t)tok * 1024 + d0)); float4 xv; xv.x = xt[0]; xv.y = xt[1]; xv.z = xt[2]; xv.w = xt[3];
                const f32x4 c0 = unpack4(*(const u32x2*)(CT + (size_t)(tok * 2) * 1024 + d0)), c1 = unpack4(*(const u32x2*)(CT + (size_t)(tok * 2 + 1) * 1024 + d0));
                v[u][j].x = xv.x * DN_ALPHA + w0 * c0[0] + w1 * c1[0]; v[u][j].y = xv.y * DN_ALPHA + w0 * c0[1] + w1 * c1[1];
                v[u][j].z = xv.z * DN_ALPHA + w0 * c0[2] + w1 * c1[2]; v[u][j].w = xv.w * DN_ALPHA + w0 * c0[3] + w1 * c1[3];
                s[u] += v[u][j].x + v[u][j].y + v[u][j].z + v[u][j].w;
                q[u] += v[u][j].x * v[u][j].x + v[u][j].y * v[u][j].y + v[u][j].z * v[u][j].z + v[u][j].w * v[u][j].w;
            }
        }
#pragma unroll
        for (int u = 0; u < U; ++u) { s[u] = wave_sum(s[u]); q[u] = wave_sum(q[u]); }
#pragma unroll
        for (int j = 0; j < 4; ++j) {
            const int d0 = 256 * j + 4 * lane;
            const float4 gg = *(const float4*)(gam + d0), bb = *(const float4*)(bet + d0);
#pragma unroll
            for (int u = 0; u < U; ++u) {
                const int tok = t0 + u;
                const float mu = s[u] * (1.f / 1024.f), var = fmaxf(q[u] * (1.f / 1024.f) - mu * mu, 0.f), rstd = rsqrtf(var + 1e-5f);
                float4 y; y.x = (v[u][j].x - mu) * rstd * gg.x + bb.x; y.y = (v[u][j].y - mu) * rstd * gg.y + bb.y; y.z = (v[u][j].z - mu) * rstd * gg.z + bb.z; y.w = (v[u][j].w - mu) * rstd * gg.w + bb.w;
                if (fin) *(float4*)(XO + (size_t)tok * 1024 + d0) = y;
                else { u32x2 w; w.x = pack2(y.x, y.y); w.y = pack2(y.z, y.w); *(u32x2*)(XB + (size_t)tok * 1024 + d0) = w; }
            }
        }
    }
}

#define XB_TMO      128
#define XB_XCNT(j)  (256  + 64 * (j))
#define XB_XSUB(j)  (1280 + 64 * (j))
#define XB_XGEN(j)  (2304 + 64 * (j))
#define XB_TOP      3328
#define XB_TOPGEN   3392
#define XCD_BAR_WORDS 3456
#define XB_SPIN_CAP (1u << 22)
#define LAS __attribute__((address_space(3)))
__device__ __forceinline__ unsigned xb_ld(unsigned* p)              { return __hip_atomic_load(p, __ATOMIC_RELAXED, __HIP_MEMORY_SCOPE_AGENT); }
__device__ __forceinline__ unsigned xb_add(unsigned* p, unsigned v) { return __hip_atomic_fetch_add(p, v, __ATOMIC_RELAXED, __HIP_MEMORY_SCOPE_AGENT); }
__device__ __forceinline__ unsigned xb_xcc_id() { return (unsigned)__builtin_amdgcn_s_getreg((3 << 11) | 20) & 0xFu; }
#define XB_SPIN(cond, bar) do { unsigned _sp = 0; while (cond) { __builtin_amdgcn_s_sleep(1); \
    if ((++_sp & 255u) == 0u) { if (xb_ld(&(bar)[XB_TMO])) break; if (_sp > XB_SPIN_CAP) { atomicAdd(&(bar)[XB_TMO], 1u); break; } } } } while (0)
struct XcdBarrier { unsigned* bar; unsigned x; volatile LAS unsigned* st; };
__device__ __forceinline__ XcdBarrier xcd_barrier_post(unsigned* bar, volatile LAS unsigned* st) {
    XcdBarrier b; b.bar = bar; b.x = xb_xcc_id(); b.st = st;
    if (threadIdx.x == 0) (void)xb_add(&bar[XB_XCNT(b.x)], 1u);
    return b;
}
__device__ __forceinline__ void xcd_barrier_complete(unsigned* bar, unsigned x, unsigned& nloc, unsigned& nx) {
    const unsigned G = gridDim.x * gridDim.y * gridDim.z;
    unsigned sum, cnt, mine, sp = 0u;
    for (;;) {
        sum = 0u; cnt = 0u; mine = 0u;
#pragma unroll
        for (unsigned j = 0; j < 16; ++j) { const unsigned c = xb_ld(&bar[XB_XCNT(j)]); sum += c; cnt += (c > 0u) ? 1u : 0u; mine = (j == x) ? c : mine; }
        if (sum == G) break;
        __builtin_amdgcn_s_sleep(1);
        if ((++sp & 255u) == 0u) { if (xb_ld(&bar[XB_TMO])) break; if (sp > XB_SPIN_CAP) { atomicAdd(&bar[XB_TMO], 1u); break; } }
    }
    nloc = mine > 0u ? mine : 1u; nx = cnt > 0u ? cnt : 1u;
}
__device__ __forceinline__ void xcd_barrier(const XcdBarrier& b) {
    asm volatile("s_waitcnt vmcnt(0)" ::: "memory");
    __syncthreads();
    if (threadIdx.x == 0) {
        unsigned* bar = b.bar;
        __builtin_amdgcn_s_waitcnt(0);
        unsigned nloc = b.st[0], nx = b.st[1];
        if (nloc == 0u) { xcd_barrier_complete(bar, b.x, nloc, nx); b.st[0] = nloc; b.st[1] = nx; }
        const unsigned old = xb_add(&bar[XB_XSUB(b.x)], 1u);
        const unsigned gen = old / nloc;
        if (old + 1u == (gen + 1u) * nloc) {
            __builtin_amdgcn_fence(__ATOMIC_RELEASE, "agent");
            asm volatile("s_waitcnt vmcnt(0)" ::: "memory");
            const unsigned og = xb_add(&bar[XB_TOP], 1u);
            const unsigned tg = og / nx;
            if (og + 1u == (tg + 1u) * nx) xb_add(&bar[XB_TOPGEN], 1u);
            else XB_SPIN(xb_ld(&bar[XB_TOPGEN]) == tg, bar);
            __builtin_amdgcn_fence(__ATOMIC_ACQUIRE, "agent");
            xb_add(&bar[XB_XGEN(b.x)], 1u);
            asm volatile("s_waitcnt vmcnt(0)" ::: "memory");
        } else {
            XB_SPIN(xb_ld(&bar[XB_XGEN(b.x)]) == gen, bar);
            __builtin_amdgcn_fence(__ATOMIC_ACQUIRE, "agent");
            asm volatile("s_waitcnt vmcnt(0)" ::: "memory");
        }
    }
    __syncthreads();
}

constexpr int PH_PER_LAYER = 11, N_PHASES = PH_PER_LAYER * NLAYER;
__global__ void __launch_bounds__(NTHREADS, 2) mega(Params p) {
    extern __shared__ __attribute__((aligned(16))) unsigned char lds[];
#if SINGLE_LAUNCH
    volatile LAS unsigned* xbw = (volatile LAS unsigned*)(lds + LDS_BYTES - 16);
    if (threadIdx.x < 4) xbw[threadIdx.x] = 0u;
    __syncthreads();
    XcdBarrier xbar = xcd_barrier_post((unsigned*)(p.ws + WS_CTL) + CW_BAR, xbw);
#endif
    const int half = __builtin_amdgcn_readfirstlane((int)(threadIdx.x >> 8));
    unsigned char* ldsh = lds + half * HALF_LDS;
    bool second = false;
    for (int ph = p.ph_lo; ph < p.ph_hi; ++ph) {
        const int layer = ph / PH_PER_LAYER, k = ph % PH_PER_LAYER;
        if (k == 0 && layer > 0) continue;
#ifdef ONLY_PHASE
        if (k != ONLY_PHASE) continue;
#endif
        switch (k) {
            case 0: phase_pw(p, layer, ldsh, 1 | 16 | 8, half); break;
            case 1: phase_g1(p, layer, lds); if (!second) { __syncthreads(); phase_pw(p, layer, ldsh, 4, half, 0, 1); } break;
            case 2: phase_p2(p, layer, ldsh, half); if (!second && layer + 1 < NLAYER) { __syncthreads(); phase_pw(p, layer + 1, ldsh, 1, half, 64); } break;
            case 3: phase_p3(p, ldsh, half, second ? ((p.rep_mask >> 16) & 7) : 7); if (!second && layer + 1 < NLAYER) { __syncthreads(); phase_pw(p, layer + 1, ldsh, 16, half); }
                    if (!second && layer == 0) { __syncthreads(); phase_pw(p, 0, ldsh, 2, half); } break;
            case 4: { const int sub = second ? ((p.rep_mask >> 12) & 7) : 7;
                    if (sub & 1) phase_p4_sel(p, lds);
                    if ((sub & 4) && half == 0) { phase_pw(p, layer, ldsh, 4, half, 0, 2); __syncthreads(); }
                    if (sub & 2) phase_p4(p, ldsh, half);
                    if ((sub & 4) && half == 1) { __syncthreads(); phase_pw(p, layer, ldsh, 4, half, 0, 2); } } break;
            case 5: phase_g2(p, lds); break;
            case 6: phase_g3(p, layer, lds); break;
            case 7: phase_ln1(p, layer, ldsh, ((p.rep_mask >> 7) & 1) && !second, half); if (!second && layer + 1 < NLAYER) { __syncthreads(); phase_pw(p, layer + 1, ldsh, 2, half); } break;
            case 8: phase_m2(p, layer, lds, ldsh, half); break;
            case 9: phase_m3(p, layer, lds, ldsh, half); break;
            case 10: phase_ln2(p, layer, half); break;
        }

        if (ph + 1 < p.ph_hi) { if (ph == p.ph_lo && !second) cg::this_grid().sync(); else xcd_barrier(xbar); }
        if (((p.rep_mask >> k) & 1) && !second) { second = true; --ph; } else second = false;
    }
}

extern "C" void kernel_launch(void* const* d_in, const int* in_sizes, int n_in, void* d_out, int out_size, void* d_ws, size_t ws_size, hipStream_t stream) {
    static int grid = 0;
    if (grid == 0) {
        if (n_in != 18 || ws_size < WS_END) { fprintf(stderr, "kernel_launch: unexpected n_in %d or ws_size %zu < %zu\n", n_in, ws_size, (size_t)WS_END); grid = -1; return; }
        int dev = 0, cus = 0, per_cu = 0;
        hipGetDevice(&dev); hipDeviceGetAttribute(&cus, hipDeviceAttributeMultiprocessorCount, dev);
        hipFuncSetAttribute((const void*)mega, hipFuncAttributeMaxDynamicSharedMemorySize, LDS_BYTES);
        hipOccupancyMaxActiveBlocksPerMultiprocessor(&per_cu, (const void*)mega, NTHREADS, LDS_BYTES);
        if (per_cu < 1) per_cu = 1;
        if (per_cu > 1) per_cu = 1;
        grid = cus * per_cu;
        (void)hipGetLastError();
    }
    if (grid < 0) return;
    Params p{};
    p.x = (const float*)d_in[0]; p.w_in = (const float*)d_in[1]; p.cmp_pos = (const float*)d_in[2]; p.cmp_w1 = (const float*)d_in[3]; p.cmp_w2 = (const float*)d_in[4];
    p.w_br_a = (const float*)d_in[5]; p.w_br_b = (const float*)d_in[6]; p.w_o = (const float*)d_in[7]; p.ln1_g = (const float*)d_in[8]; p.ln1_b = (const float*)d_in[9];
    p.w_router = (const float*)d_in[10]; p.router_bias = (const float*)d_in[11]; p.w_gate = (const float*)d_in[12]; p.w_up = (const float*)d_in[13]; p.w_down = (const float*)d_in[14];
    p.ln2_g = (const float*)d_in[15]; p.ln2_b = (const float*)d_in[16]; p.rel_bias = (const float*)d_in[17];
    p.out = (float*)d_out; p.ws = (unsigned char*)d_ws; p.rep_mask = REPEAT_MASK;
#if SINGLE_LAUNCH
    hipMemsetAsync((unsigned char*)d_ws + WS_CTL + (size_t)CW_BAR * 4, 0, XCD_BAR_WORDS * 4, stream);
    p.ph_lo = 0; p.ph_hi = N_PHASES;
    void* args[] = {&p};
    hipError_t e = hipLaunchCooperativeKernel((const void*)mega, dim3(grid), dim3(NTHREADS), args, LDS_BYTES, stream);
    if (e != hipSuccess) fprintf(stderr, "cooperative launch failed: %s (grid %d)\n", hipGetErrorString(e), grid);
#else
    for (int ph = 0; ph < N_PHASES; ++ph) {
        p.ph_lo = ph; p.ph_hi = ph + 1;
        hipLaunchKernelGGL(mega, dim3(grid), dim3(NTHREADS), LDS_BYTES, stream, p);
    }
#endif
}
```

```cpp
#include <hip/hip_runtime.h>
#include <hip/hip_cooperative_groups.h>
#include <cstdio>
#include <cstdint>
namespace cg = cooperative_groups;

#ifndef REPEAT_MASK
#define REPEAT_MASK 0
#endif
#ifndef SINGLE_LAUNCH
#define SINGLE_LAUNCH 1
#endif

typedef unsigned short bf16_t;
typedef short bf16x8 __attribute__((ext_vector_type(8)));
typedef float f32x4 __attribute__((ext_vector_type(4)));
typedef unsigned u32x2 __attribute__((ext_vector_type(2)));
typedef unsigned u32x4 __attribute__((ext_vector_type(4)));

constexpr int B_ = 2, S_ = 8192, D_ = 1024, T_ = B_ * S_, NLAYER = 4;
constexpr int DIN = 6424;
constexpr int LD = 5376;
constexpr int NW = 6656;
constexpr int C_QA = 0, C_KC = 512, C_VC = 640, C_KS = 768, C_KW = 896, C_QR = 1024, C_KR = 1536, C_GR = 2048, C_MA = 3072, C_MB = 4096, C_GA = 5120,
              C_VS = 5376, C_VW = 5504, C_VR = 5632;
constexpr float DN_ALPHA = 1.681792830507429f;
constexpr int NE = 16;

constexpr size_t al256(size_t x) { return (x + 255) & ~(size_t)255; }
constexpr size_t WS_CTL = 0;
constexpr size_t WS_BUCKET = 65536;
constexpr size_t WS_ROPE = WS_BUCKET + 8192;
constexpr size_t WS_WIN = WS_ROPE + (size_t)8192 * 32 * 8;
constexpr size_t WS_WA = WS_WIN + (size_t)NW * 1024 * 2;
constexpr size_t WS_WB = WS_WA + (size_t)1024 * 512 * 2;
constexpr size_t WS_WO = WS_WB + (size_t)1024 * 1024 * 2;
constexpr size_t WS_WG = WS_WO + (size_t)1024 * 1024 * 2;
constexpr size_t WS_WU = WS_WG + (size_t)16 * 512 * 1024 * 2;
constexpr size_t WS_WD = WS_WU + (size_t)16 * 512 * 1024 * 2;
constexpr size_t WS_XB = WS_WD + (size_t)16 * 512 * 1024 * 2;
constexpr size_t WS_X = WS_XB + (size_t)T_ * 1024 * 2;
constexpr size_t WS_MG = WS_X + (size_t)T_ * 1024 * 4;
constexpr size_t WS_KCC = WS_MG + (size_t)T_ * 1024 * 2;
constexpr size_t WS_VCCT = WS_KCC + (size_t)4 * 512 * 64 * 2;
constexpr size_t WS_W1T = WS_VCCT + (size_t)4 * 512 * 64 * 2;
constexpr size_t WS_B1 = WS_W1T + (size_t)2 * 64 * 2048 * 2;
constexpr size_t WS_R = WS_B1 + 1024;
constexpr size_t WS_P = WS_R;
constexpr size_t WS_VST = WS_P + (size_t)T_ * LD * 2;
constexpr size_t WS_VWT = WS_VST + (size_t)4 * 64 * S_ * 2;
constexpr size_t WS_VRT = WS_VWT + (size_t)4 * 64 * S_ * 2;
constexpr size_t WS_KVT = WS_VRT + (size_t)16 * 128 * S_ * 2;
constexpr size_t WS_SPT = WS_KVT + (size_t)16 * 64 * 8192 * 4;
constexpr size_t WS_YC = WS_SPT + (size_t)16 * 64 * 8192 * 2;
constexpr size_t WS_YW = WS_YC + (size_t)T_ * 512 * 2;
constexpr size_t WS_YA = WS_YW + (size_t)T_ * 512 * 2;
constexpr size_t WS_YB = WS_YA + (size_t)T_ * 512 * 2;
constexpr size_t WS_SELW = WS_YB + (size_t)T_ * 1024 * 2;
constexpr size_t WS_ENDA = WS_SELW + (size_t)T_ * 2 * 4 * 4;
constexpr size_t WS_H1 = WS_R;
constexpr size_t WS_X1 = WS_H1 + (size_t)T_ * 1024 * 4;
constexpr size_t WS_X1B = WS_X1 + (size_t)T_ * 1024 * 4;
constexpr size_t WS_HB = WS_X1B + (size_t)T_ * 1024 * 2;
constexpr size_t WS_CT = WS_HB + (size_t)2 * T_ * 512 * 2;
constexpr size_t WS_LIST = WS_CT + (size_t)2 * T_ * 1024 * 2;
constexpr size_t WS_WTS = WS_LIST + (size_t)16 * T_ * 4;
constexpr size_t WS_ENDB = WS_WTS + (size_t)2 * T_ * 4;
static_assert(WS_HB + (size_t)2 * T_ * 512 * 2 <= WS_CT, "view B overlap");
constexpr size_t WS_END = WS_ENDA > WS_ENDB ? WS_ENDA : WS_ENDB;

constexpr int CW_CNT = 4096;
constexpr int CW_BAR = 8192;
constexpr int CW_B1P = 12288;

constexpr int HALF_LDS = 75776, LDS_BYTES = 2 * HALF_LDS + 16;
constexpr int NTHREADS = 512, HT = 256;

struct Params {
    const float* x; const float* w_in; const float* cmp_pos; const float* cmp_w1; const float* cmp_w2;
    const float* w_br_a; const float* w_br_b; const float* w_o; const float* ln1_g; const float* ln1_b;
    const float* w_router; const float* router_bias; const float* w_gate; const float* w_up; const float* w_down;
    const float* ln2_g; const float* ln2_b; const float* rel_bias;
    float* out; unsigned char* ws;
    int ph_lo, ph_hi, rep_mask, pad_;
};

__device__ __forceinline__ bf16_t f2bf(float f) { unsigned u = __float_as_uint(f); u += 0x7fffu + ((u >> 16) & 1u); return (bf16_t)(u >> 16); }
__device__ __forceinline__ float bf2f(unsigned h) { return __uint_as_float(h << 16); }
typedef __bf16 bf16x2_t __attribute__((ext_vector_type(2)));
typedef float f32x2_t __attribute__((ext_vector_type(2)));
__device__ __forceinline__ unsigned pack2(float lo, float hi) { const f32x2_t f = {lo, hi}; return __builtin_bit_cast(unsigned, __builtin_convertvector(f, bf16x2_t)); }
__device__ __forceinline__ u32x2 pack4(f32x4 v) { u32x2 r; r.x = pack2(v[0], v[1]); r.y = pack2(v[2], v[3]); return r; }
__device__ __forceinline__ f32x4 unpack4(u32x2 u) { f32x4 r; r[0] = bf2f(u.x & 0xffffu); r[1] = bf2f(u.x >> 16); r[2] = bf2f(u.y & 0xffffu); r[3] = bf2f(u.y >> 16); return r; }
__device__ __forceinline__ float rows_max(float v) {
    u32x2 r = __builtin_amdgcn_permlane16_swap(__float_as_uint(v), __float_as_uint(v), false, false);
    v = fmaxf(__uint_as_float(r.x), __uint_as_float(r.y));
    r = __builtin_amdgcn_permlane32_swap(__float_as_uint(v), __float_as_uint(v), false, false);
    return fmaxf(__uint_as_float(r.x), __uint_as_float(r.y));
}
__device__ __forceinline__ float rows_sum(float v) {
    u32x2 r = __builtin_amdgcn_permlane16_swap(__float_as_uint(v), __float_as_uint(v), false, false);
    v = __uint_as_float(r.x) + __uint_as_float(r.y);
    r = __builtin_amdgcn_permlane32_swap(__float_as_uint(v), __float_as_uint(v), false, false);
    return __uint_as_float(r.x) + __uint_as_float(r.y);
}
__device__ __forceinline__ float wave_sum(float v) {
    v += __int_as_float(__builtin_amdgcn_mov_dpp(__float_as_int(v), 0xB1, 0xF, 0xF, true));
    v += __int_as_float(__builtin_amdgcn_mov_dpp(__float_as_int(v), 0x4E, 0xF, 0xF, true));
    v += __int_as_float(__builtin_amdgcn_mov_dpp(__float_as_int(v), 0x141, 0xF, 0xF, true));
    v += __int_as_float(__builtin_amdgcn_mov_dpp(__float_as_int(v), 0x140, 0xF, 0xF, true));
    return rows_sum(v);
}
__device__ __forceinline__ float sigmoidf_(float x) { return 1.f / (1.f + __expf(-x)); }
__device__ __forceinline__ int ltid() { int t = threadIdx.x; asm volatile("" : "+v"(t)); return t; }
__device__ __forceinline__ int vzero() { int z; asm volatile("v_mov_b32 %0, 0" : "=v"(z)); return z; }
__device__ __forceinline__ unsigned char* launder(unsigned char* q) { asm volatile("" : "+s"(q)); return q; }
__device__ __forceinline__ void wait_vm0() { asm volatile("s_waitcnt vmcnt(0)" ::: "memory"); }

__device__ __forceinline__ void glds16(const void* g, void* l) {
    __builtin_amdgcn_global_load_lds((const __attribute__((address_space(1))) unsigned*)g,
                                     (__attribute__((address_space(3))) unsigned*)l, 16, 0, 0);
}
__device__ __forceinline__ f32x4 mfma16(bf16x8 a, bf16x8 b, f32x4 c) { return __builtin_amdgcn_mfma_f32_16x16x32_bf16(a, b, c, 0, 0, 0); }

#define WAIT_V(n) asm volatile("s_waitcnt vmcnt(%0)" ::"n"(n) : "memory")
#define RAW_BARRIER() do { asm volatile("s_waitcnt lgkmcnt(0)" ::: "memory"); __builtin_amdgcn_s_barrier(); } while (0)
__device__ __forceinline__ void bglds16(__amdgpu_buffer_rsrc_t r, unsigned voff, int soff, void* l) {
    __builtin_amdgcn_raw_ptr_buffer_load_lds(r, (__attribute__((address_space(3))) void*)l, 16, (int)voff, soff, 0, 0);
}
template <int NJ, bool GN>
__device__ __forceinline__ void gemm8_stage(__amdgpu_buffer_rsrc_t mr, int mld, unsigned mvo, __amdgpu_buffer_rsrc_t nr, int nld, const unsigned (&nvo)[NJ], int kt, unsigned char* st, int wid) {
#pragma unroll
    for (int i = 0; i < 4; ++i) bglds16(mr, mvo, (64 * i * mld + kt * 64) * 2, st + (8 * i + wid) * 1024);
#pragma unroll
    for (int i = 0; i < NJ; ++i) bglds16(nr, nvo[i], ((GN ? 0 : 64 * i * nld) + kt * 64) * 2, st + 32768 + (8 * i + wid) * 1024);
}
template <int NJ, bool GN>
__device__ __forceinline__ void gemm8_kloop(const bf16_t* mb, int mld, unsigned mvo, const bf16_t* nb, int nld, const unsigned (&nvo)[NJ], int nk, unsigned char* lds, f32x4 (&acc)[8][NJ], int tid) {
    const int lane = tid & 63, wid = tid >> 6, wr = wid >> 2, wc = wid & 3, fr = lane & 15, fq = lane >> 4;
    const __amdgpu_buffer_rsrc_t mr = __builtin_amdgcn_make_buffer_rsrc((void*)mb, 0, 0x7fffffff, 0x00020000);
    const __amdgpu_buffer_rsrc_t nr = __builtin_amdgcn_make_buffer_rsrc((void*)nb, 0, 0x7fffffff, 0x00020000);
    gemm8_stage<NJ, GN>(mr, mld, mvo, nr, nld, nvo, 0, lds, wid);
    gemm8_stage<NJ, GN>(mr, mld, mvo, nr, nld, nvo, 1, lds + 65536, wid);
    for (int kt = 0; kt < nk; ++kt) {
        unsigned char* cur = lds + (kt & 1) * 65536;
        if (kt + 1 < nk) WAIT_V(4 + NJ); else WAIT_V(0);
        RAW_BARRIER();
        bf16x8 a[4], b[NJ];
        const unsigned char* ab = cur + (128 * wr + fr) * 128;
        const unsigned char* bb = cur + 32768 + (16 * NJ * wc + fr) * 128;
        const int sw0 = ((fq) ^ (fr & 7)) << 4, sw1 = ((4 + fq) ^ (fr & 7)) << 4;
#pragma unroll
        for (int j = 0; j < NJ; ++j) b[j] = *(const bf16x8*)(bb + j * 2048 + sw0);
#pragma unroll
        for (int mh = 0; mh < 2; ++mh) {
#pragma unroll
            for (int i = 0; i < 4; ++i) a[i] = *(const bf16x8*)(ab + (4 * mh + i) * 2048 + sw0);
#pragma unroll
            for (int i = 0; i < 4; ++i)
#pragma unroll
                for (int j = 0; j < NJ; ++j) acc[4 * mh + i][j] = mfma16(a[i], b[j], acc[4 * mh + i][j]);
        }
#pragma unroll
        for (int j = 0; j < NJ; ++j) b[j] = *(const bf16x8*)(bb + j * 2048 + sw1);
#pragma unroll
        for (int i = 0; i < 4; ++i) a[i] = *(const bf16x8*)(ab + i * 2048 + sw1);
#pragma unroll
        for (int i = 0; i < 4; ++i)
#pragma unroll
            for (int j = 0; j < NJ; ++j) acc[i][j] = mfma16(a[i], b[j], acc[i][j]);
#pragma unroll
        for (int i = 0; i < 4; ++i) a[i] = *(const bf16x8*)(ab + (4 + i) * 2048 + sw1);
        RAW_BARRIER();
        if (kt + 2 < nk) gemm8_stage<NJ, GN>(mr, mld, mvo, nr, nld, nvo, kt + 2, cur, wid);
#pragma unroll
        for (int i = 0; i < 4; ++i)
#pragma unroll
            for (int j = 0; j < NJ; ++j) acc[4 + i][j] = mfma16(a[i], b[j], acc[4 + i][j]);
    }
    __syncthreads();
    __builtin_amdgcn_sched_barrier(0);
}
template <int NJ>
__device__ __forceinline__ void zero_acc8(f32x4 (&acc)[8][NJ]) {
#pragma unroll
    for (int i = 0; i < 8; ++i)
#pragma unroll
        for (int j = 0; j < NJ; ++j) acc[i][j] = (f32x4){0.f, 0.f, 0.f, 0.f};
}

namespace pg8 {
#define PG8_LAS __attribute__((address_space(3)))
constexpr int BM = 256, BK = 64, HALF = 128, HTB = HALF * BK * 2, STAGE_BYTES = 8 * HTB;
__device__ __forceinline__ int lds_byte(int r, int c) { const int st = (r >> 4) * 2 + (c >> 5), rr = r & 15, cc = c & 31, ob = rr * 64 + cc * 2; return st * 1024 + (ob ^ (((ob >> 9) & 1) << 5)); }
__device__ __forceinline__ void stage_rc(int b, int& R, int& C) { const int st = b / 1024, sb = b % 1024, swz = sb ^ (((sb >> 9) & 1) << 5); R = (st >> 1) * 16 + swz / 64; C = (st & 1) * 32 + (swz % 64) / 2; }
__device__ __forceinline__ int perm32(int rho) { const int n = rho >> 4, i = rho & 15; return 8 * (i >> 2) + 4 * n + (i & 3); }
struct Unit { int pm, pn; };
template <class Epi, class Sched>
__device__ __forceinline__ void gemm_phase(unsigned char* lds_, const int K, const Sched& S, const Epi& E, const int tid, const unsigned char* wsbase) {
    PG8_LAS unsigned char* lds = (PG8_LAS unsigned char*)lds_;
    const int wid = __builtin_amdgcn_readfirstlane(tid >> 6), lane = tid & 63, wr = wid >> 2, wc = wid & 3, fr = lane & 15, fq = lane >> 4;
    const int nt = K / BK;
    unsigned voffA[2], voffB[2];
#pragma unroll
    for (int i = 0; i < 2; ++i) { int R, C; stage_rc(tid * 16 + i * 8192, R, C); const int Rb = (R & ~31) + perm32(R & 31);
        voffA[i] = (unsigned)(R * K + C) * 2u; voffB[i] = (unsigned)(Rb * K + C) * 2u; }
    const unsigned kstep = (unsigned)(BK * 2);
    const unsigned hstep = (unsigned)HALF * K * 2;
    const __amdgpu_buffer_rsrc_t rsrc = __builtin_amdgcn_make_buffer_rsrc((void*)wsbase, 0, 0x7fffffff, 0x00020000);
    const unsigned ldsw = (unsigned)wid * 1024u;
    const int aoff = lds_byte(wr * 64 + fr, fq * 8), boff = lds_byte(wc * 32 + fr, fq * 8);
#define PG8_SA(b, h) (((b) * 2 + (h)) * HTB)
#define PG8_SB(b, h) ((4 + (b) * 2 + (h)) * HTB)
#define PG8_STAGE(bufoff, gbase, voff) do { _Pragma("unroll") for (int _i = 0; _i < 2; ++_i) \
        __builtin_amdgcn_raw_ptr_buffer_load_lds(rsrc, (PG8_LAS void*)(lds + (bufoff) + ldsw + _i * 8192), 16, (int)(voff)[_i], (int)(gbase), 0, 0); } while (0)
#define PG8_LDA(dst, b, h) do { _Pragma("unroll") for (int m = 0; m < 4; ++m) _Pragma("unroll") for (int k = 0; k < 2; ++k) dst[m][k] = *(const PG8_LAS bf16x8*)(lds + PG8_SA(b, h) + aoff + m * 2048 + k * 1024); } while (0)
#define PG8_LDB(dst, b, h) do { _Pragma("unroll") for (int n = 0; n < 2; ++n) _Pragma("unroll") for (int k = 0; k < 2; ++k) dst[n][k] = *(const PG8_LAS bf16x8*)(lds + PG8_SB(b, h) + boff + n * 2048 + k * 1024); } while (0)
#define PG8_MMA(ai, bj, At, Bt) do { __builtin_amdgcn_s_setprio(1); _Pragma("unroll") for (int m = 0; m < 4; ++m) _Pragma("unroll") for (int n = 0; n < 2; ++n) _Pragma("unroll") for (int k = 0; k < 2; ++k) \
        acc[ai][bj][m][n] = __builtin_amdgcn_mfma_f32_16x16x32_bf16(Bt[n][k], At[m][k], acc[ai][bj][m][n], 0, 0, 0); __builtin_amdgcn_s_setprio(0); } while (0)
#define PG8_WAIT_V(n) asm volatile("s_waitcnt vmcnt(" #n ")" ::: "memory")
#define PG8_WAIT_L(n) asm volatile("s_waitcnt lgkmcnt(" #n ")" ::: "memory")
#define PG8_BAR __builtin_amdgcn_s_barrier()
#define PG8_SCHED __builtin_amdgcn_sched_barrier(0)
    typename Sched::U cur, nxt; int ui = 0;
    if (!S.next(0, cur)) return;
    unsigned cA, cB; S.ptrs(cur, cA, cB);
    constexpr bool GA = Sched::GATHER;
    unsigned vA[2], nvA[2];
    if constexpr (GA) { S.rows(cur, tid, vA); nvA[0] = vA[0]; nvA[1] = vA[1]; }
#define PG8_STAGE_G(bufoff, gbase, pk) do { const unsigned _cb = voffB[0] & (unsigned)(2 * K - 1); unsigned _vo[2] = {(((pk) & 0xffffu) * (unsigned)(2 * K)) + _cb, (((pk) >> 16) * (unsigned)(2 * K)) + _cb}; PG8_STAGE(bufoff, gbase, _vo); } while (0)
#define PG8_STAGE_A(bufoff, gbase, h, nextu) do { if constexpr (GA) { if (nextu) PG8_STAGE_G(bufoff, gbase, nvA[h]); else PG8_STAGE_G(bufoff, gbase, vA[h]); } \
        else PG8_STAGE(bufoff, (gbase) + (h) * hstep, voffA); } while (0)
    PG8_STAGE(PG8_SB(0, 0), cB, voffB); PG8_STAGE_A(PG8_SA(0, 0), cA, 0, false); PG8_STAGE(PG8_SB(0, 1), cB + hstep, voffB); PG8_STAGE_A(PG8_SA(0, 1), cA, 1, false);
    if (wr == 1) PG8_BAR;
    PG8_WAIT_V(4); PG8_BAR;
    PG8_STAGE(PG8_SB(1, 0), cB + kstep, voffB); PG8_STAGE_A(PG8_SA(1, 0), cA + kstep, 0, false); PG8_STAGE(PG8_SB(1, 1), cB + hstep + kstep, voffB);
    PG8_WAIT_V(6); PG8_BAR;
    PG8_SCHED;
    f32x4 acc[2][2][4][2];
#pragma unroll
    for (int a = 0; a < 2; ++a)
#pragma unroll
        for (int b = 0; b < 2; ++b)
#pragma unroll
            for (int m = 0; m < 4; ++m)
#pragma unroll
                for (int n = 0; n < 2; ++n) acc[a][b][m][n] = (f32x4){0.f, 0.f, 0.f, 0.f};
    bf16x8 At[4][2], B0[2][2], B1[2][2];
    for (;;) {
        const bool has_next = S.next(ui + 1, nxt);
        unsigned nA = cA, nB = cB; if (has_next) S.ptrs(nxt, nA, nB);
        if constexpr (GA) { if (has_next) S.rows(nxt, tid, nvA); }
        for (int t = 0; t < nt; t += 2) {
            if constexpr (Epi::MID_T > 0) { if (t == Epi::MID_T) E.mid(acc, cur, wr, wc, fr, fq); }
            const bool last = (t == nt - 2);
            const unsigned a1 = cA + (unsigned)(t + 1) * kstep;
            const unsigned a2 = last ? nA : cA + (unsigned)(t + 2) * kstep, b2 = last ? nB : cB + (unsigned)(t + 2) * kstep;
            const unsigned a3 = a2 + kstep, b3 = b2 + kstep;
            PG8_LDB(B0, 0, 0); PG8_SCHED; PG8_LDA(At, 0, 0); PG8_STAGE_A(PG8_SA(1, 1), a1, 1, false);
            PG8_WAIT_L(8); PG8_BAR; PG8_WAIT_L(0); PG8_MMA(0, 0, At, B0); PG8_BAR; PG8_SCHED;
            PG8_LDB(B1, 0, 1); PG8_STAGE(PG8_SB(0, 0), b2, voffB);
            PG8_BAR; PG8_WAIT_L(0); PG8_MMA(0, 1, At, B1); PG8_BAR;
            PG8_LDA(At, 0, 1); PG8_STAGE_A(PG8_SA(0, 0), a2, 0, last);
            PG8_BAR; PG8_WAIT_L(0); PG8_MMA(1, 0, At, B0); PG8_BAR; PG8_SCHED;
            PG8_STAGE(PG8_SB(0, 1), b2 + hstep, voffB);
            PG8_WAIT_V(6); PG8_BAR; PG8_MMA(1, 1, At, B1); PG8_BAR;
            PG8_LDB(B0, 1, 0); PG8_SCHED; PG8_LDA(At, 1, 0); PG8_STAGE_A(PG8_SA(0, 1), a2, 1, last);
            PG8_WAIT_L(8); PG8_BAR; PG8_WAIT_L(0); PG8_MMA(0, 0, At, B0); PG8_BAR; PG8_SCHED;
            PG8_LDB(B1, 1, 1); PG8_STAGE(PG8_SB(1, 0), b3, voffB);
            PG8_BAR; PG8_WAIT_L(0); PG8_MMA(0, 1, At, B1); PG8_BAR;
            PG8_LDA(At, 1, 1); PG8_STAGE_A(PG8_SA(1, 0), a3, 0, last);
            PG8_BAR; PG8_WAIT_L(0); PG8_MMA(1, 0, At, B0); PG8_BAR; PG8_SCHED;
            PG8_STAGE(PG8_SB(1, 1), b3 + hstep, voffB);
            PG8_WAIT_V(6); PG8_BAR; PG8_MMA(1, 1, At, B1); PG8_BAR;
        }
        E(acc, cur, wr, wc, fr, fq);
        if (!has_next) break;
#pragma unroll
        for (int a = 0; a < 2; ++a)
#pragma unroll
            for (int b = 0; b < 2; ++b)
#pragma unroll
                for (int m = 0; m < 4; ++m)
#pragma unroll
                    for (int n = 0; n < 2; ++n) acc[a][b][m][n] = (f32x4){0.f, 0.f, 0.f, 0.f};
        cur = nxt; cA = nA; cB = nB; ++ui;
        if constexpr (GA) { vA[0] = nvA[0]; vA[1] = nvA[1]; }
    }
    PG8_WAIT_V(0);
    if (wr == 0) PG8_BAR;
    PG8_BAR;
#undef PG8_SA
#undef PG8_SB
#undef PG8_STAGE
#undef PG8_STAGE_A
#undef PG8_STAGE_G
#undef PG8_LDA
#undef PG8_LDB
#undef PG8_MMA
#undef PG8_WAIT_V
#undef PG8_WAIT_L
#undef PG8_BAR
#undef PG8_SCHED
}
}

struct TJob { const float* src; bf16_t* dst; int ld, k0, n0, mode, kdst; };
__device__ __forceinline__ void tcvt_load(const TJob& J, float4 (&v)[4], int tid) {
#pragma unroll
    for (int i = 0; i < 4; ++i) {
        const int kk = (tid >> 4) + 16 * i, c4 = (tid & 15) * 4, cd = J.n0 + c4;
        int orig = cd; bool ok = true;
        if (J.mode == 1) {
            if (cd < 896) orig = cd;
            else if (cd < 1024) orig = cd - 896 + 1024;
            else if (cd < 2048) { const int q = cd - 1024, hd = q >> 6, pp = q & 63;
                const int d = (pp & 4) ? 32 + 4 * (pp >> 3) + (pp & 3) : 4 * (pp >> 3) + (pp & 3);
                orig = 1304 + hd * 64 + d; }
            else if (cd < 5120) orig = cd - 2048 + 3352;
            else if (cd < 5144) orig = cd - 5120 + 1280;
            else if (cd < 5376) ok = false;
            else if (cd < 5504) orig = cd - 5376 + 896;
            else if (cd < 5632) orig = cd - 5504 + 1152;
            else orig = cd - 5632 + 2328;
        }
        v[i] = make_float4(0.f, 0.f, 0.f, 0.f);
        if (ok) v[i] = *(const float4*)(J.src + (size_t)(J.k0 + kk) * J.ld + orig);
    }
}
__device__ __forceinline__ void tcvt_finish(const TJob& J, const float4 (&v)[4], unsigned char* lds, int tid) {
    float* tile = (float*)lds;
#pragma unroll
    for (int i = 0; i < 4; ++i) {
        const int kk = (tid >> 4) + 16 * i, c4 = (tid & 15) * 4;
        tile[kk * 65 + c4 + 0] = v[i].x; tile[kk * 65 + c4 + 1] = v[i].y; tile[kk * 65 + c4 + 2] = v[i].z; tile[kk * 65 + c4 + 3] = v[i].w;
    }
    __syncthreads();
#pragma unroll
    for (int i = 0; i < 2; ++i) {
        const int q = tid + 256 * i, n = q >> 3, kc = q & 7;
        float x[8];
#pragma unroll
        for (int j = 0; j < 8; ++j) x[j] = tile[(kc * 8 + j) * 65 + n];
        u32x4 w; w.x = pack2(x[0], x[1]); w.y = pack2(x[2], x[3]); w.z = pack2(x[4], x[5]); w.w = pack2(x[6], x[7]);
        int drow = J.n0 + n; if (J.mode >= 2) drow = 8 * (drow >> 2) + (drow & 3) + (J.mode == 3 ? 4 : 0);
        *(u32x4*)(J.dst + (size_t)drow * J.kdst + J.k0 + kc * 8) = w;
    }
    __syncthreads();
}
__device__ __forceinline__ void tcvt_tile(const float* src, int ld_src, int k0, int n0, int mode, bf16_t* dst, int kdst, unsigned char* lds, int half) {
    TJob J; J.src = src; J.dst = dst; J.ld = ld_src; J.k0 = k0; J.n0 = n0; J.mode = mode; J.kdst = kdst;
    const int tid = (ltid() & 255); float4 v[4];
    tcvt_load(J, v, tid); tcvt_finish(J, v, lds, tid);
}

__device__ __forceinline__ void tcvt_decode(const Params& p, unsigned char* ws, int layer, int t, TJob& J) {
    constexpr int J0 = 16 * 104, J1 = 8 * 16, J2 = 256, J3 = 256, J4 = 2048, J5 = 2048;
    int u = t;
        if (u < J0) { J.src = p.w_in + (size_t)layer * 1024 * DIN; J.ld = DIN; J.k0 = (u % 16) * 64; J.n0 = (u / 16) * 64; J.mode = 1; J.dst = (bf16_t*)(ws + WS_WIN); J.kdst = 1024; return; }
        u -= J0;
        if (u < J1) { J.src = p.w_br_a + (size_t)layer * 512 * 1024; J.ld = 1024; J.k0 = (u % 8) * 64; J.n0 = (u / 8) * 64; J.mode = 0; J.dst = (bf16_t*)(ws + WS_WA); J.kdst = 1536; return; }
        u -= J1;
        if (u < J2) { J.src = p.w_br_b + (size_t)layer * 1024 * 1024; J.ld = 1024; J.k0 = (u % 16) * 64; J.n0 = (u / 16) * 64; J.mode = 0; J.dst = (bf16_t*)(ws + WS_WA) + 512; J.kdst = 1536; return; }
        u -= J2;
        if (u < J3) { J.src = p.w_o + (size_t)layer * 1024 * 1024; J.ld = 1024; J.k0 = (u % 16) * 64; J.n0 = (u / 16) * 64; J.mode = 0; J.dst = (bf16_t*)(ws + WS_WO); J.kdst = 1024; return; }
        u -= J3;
        if (u < J4 + J5) {
            const bool up = u >= J4; if (up) u -= J4;
            const int e = u / 128, v = u % 128;
            J.src = (up ? p.w_up : p.w_gate) + ((size_t)layer * NE + e) * 1024 * 512; J.ld = 512; J.k0 = (v % 16) * 64; J.n0 = (v / 16) * 64; J.mode = up ? 3 : 2;
            J.dst = (bf16_t*)(ws + WS_WG) + (size_t)e * 1024 * 1024; J.kdst = 1024; return;
        }
        u -= J4 + J5;
        { const int e = u / 128, v = u % 128;
          J.src = p.w_down + ((size_t)layer * NE + e) * 512 * 1024; J.ld = 1024; J.k0 = (v % 8) * 64; J.n0 = (v / 8) * 64; J.mode = 0; J.dst = (bf16_t*)(ws + WS_WD) + (size_t)e * 1024 * 512; J.kdst = 512; }
}


__device__ __forceinline__ void phase_pw(const Params& p, int layer, unsigned char* lds, int parts, int half, int skip = 0, int split = 0) {
    const int hq = __builtin_amdgcn_readfirstlane(ltid() >> 8);
    if ((int)(blockIdx.x * 2 + hq) < skip) return;
    constexpr int MOE_A = 2048, MOE_B = 1024;
    const int bid = split == 1 ? ((int)blockIdx.x - (int)(gridDim.x >> 1)) * 2 + hq : (blockIdx.x * 2 + hq) - skip, nblk = split == 1 ? (int)gridDim.x : split == 3 ? (int)(gridDim.x >> 1) : (gridDim.x * 2) - skip, tid = (ltid() & 255);
    if (bid < 0 || (split == 3 && bid >= nblk)) return;
    unsigned char* ws = launder(p.ws);
    constexpr int J0 = 16 * 104, J1 = 8 * 16, J2 = 256, J3 = 256, J4 = 2048, J5 = 2048, J6 = 2048, JT = J0 + J1 + J2 + J3 + J4 + J5 + J6;
    const int t_lo = ((parts & 1) ? 0 : (parts & 2) ? J0 : J0 + J1 + J2 + J3) + (split == 2 ? MOE_A + MOE_B : split == 3 ? MOE_A : 0);
    const int t_hi = split == 1 ? J0 + J1 + J2 + J3 + MOE_A : split == 3 ? J0 + J1 + J2 + J3 + MOE_A + MOE_B : (parts & 4) ? JT : (parts & 2) ? J0 + J1 + J2 + J3 : (parts & 1) ? J0 : 0;
    if (t_lo + bid < t_hi) {
        float4 v[4]; { TJob J; tcvt_decode(p, ws, layer, t_lo + bid, J); tcvt_load(J, v, tid); }
        for (int t = t_lo + bid; t < t_hi; t += nblk) {
            float4 vn[4];
            if (t + nblk < t_hi) { TJob J; tcvt_decode(p, ws, layer, t + nblk, J); tcvt_load(J, vn, tid); }
            { TJob J; tcvt_decode(p, ws, layer, t, J); tcvt_finish(J, v, lds, tid); }
#pragma unroll
            for (int i = 0; i < 4; ++i) v[i] = vn[i];
        }
    }
    if (parts & 16) {
    for (int t = bid; t < 64; t += nblk) {
        const int kv = t >> 5, kt = t & 31;
        const float* w1 = p.cmp_w1 + ((size_t)layer * 2 + kv) * 2048 * 64;
        tcvt_tile(w1, 64, kt * 64, 0, 0, (bf16_t*)(ws + WS_W1T) + (size_t)kv * 64 * 2048, 2048, lds, half);
        const int n = tid & 63, part = tid >> 6;
        const float* pos = p.cmp_pos + ((size_t)layer * 2 + kv) * 2048 + kt * 64 + part * 16;
        const float* wp = w1 + (size_t)(kt * 64 + part * 16) * 64 + n;
        float a = 0.f;
#pragma unroll
        for (int k = 0; k < 16; ++k) a += pos[k] * wp[(size_t)k * 64];
        float* red = (float*)lds;
        __syncthreads(); red[tid] = a; __syncthreads();
        if (tid < 64) ((float*)(ws + WS_CTL) + CW_B1P)[(kv * 32 + kt) * 64 + tid] = red[tid] + red[tid + 64] + red[tid + 128] + red[tid + 192];
        __syncthreads();
    }
    }
    if (parts & 8) {
        const float4* xs = (const float4*)p.x; u32x2* xb = (u32x2*)(ws + WS_XB);
        for (size_t i = (size_t)bid * HT + tid; i < (size_t)T_ * 1024 / 4; i += (size_t)nblk * HT) {
            float4 v = xs[i]; u32x2 w; w.x = pack2(v.x, v.y); w.y = pack2(v.z, v.w); xb[i] = w;
        }
        for (int n = bid * HT + tid; n < 8192; n += nblk * HT) {
            int bk;
            if (n < 16) bk = n;
            else { const int th[15] = {22, 30, 40, 54, 73, 99, 134, 182, 246, 332, 450, 609, 825, 1117, 1513}; bk = 16;
#pragma unroll
                for (int k = 0; k < 15; ++k) bk += (n >= th[k]) ? 1 : 0; }
            (ws + WS_BUCKET)[n] = (unsigned char)bk;
        }
        for (int i = bid * HT + tid; i < 8192 * 32; i += nblk * HT) {
            const int pos = i >> 5, d = i & 31;
            const float inv = powf(10000.f, -(float)d * 2.0f / 64.f);
            const float ang = (float)pos * inv;
            float sn, cs; sincosf(ang, &sn, &cs);
            ((float2*)(ws + WS_ROPE))[i] = make_float2(cs, sn);
        }
        if (bid == 0) for (int i = tid; i < 8192; i += HT) ((unsigned*)(ws + WS_CTL))[i] = 0u;
    }
}

__device__ __forceinline__ float fsig(float x) { return __builtin_amdgcn_rcpf(1.f + __builtin_amdgcn_exp2f(-1.4426950408889634f * x)); }
template <int KIND>
__device__ __forceinline__ void g1_epi(const f32x4 (&acc)[2][2][4][2], unsigned char* ws, int r0, int c0, int wr, int wc, int fr, int fq) {
#pragma unroll
    for (int ai = 0; ai < 2; ++ai)
#pragma unroll
        for (int m = 0; m < 4; ++m) {
            const int row = r0 + 128 * ai + 64 * wr + 16 * m + fr + vzero();
#pragma unroll
            for (int bj = 0; bj < 2; ++bj) {
                const int col = c0 + 128 * bj + 32 * wc + 8 * fq;
                f32x4 v0 = acc[ai][bj][m][0], v1 = acc[ai][bj][m][1];
                if (KIND == 5) {
                    const int b = col >> 13, sq = col & (S_ - 1);
                    bf16_t* dst;
                    if (row < C_VW) { const int c = row - C_VS; dst = (bf16_t*)(ws + WS_VST) + ((size_t)(b * 2 + (c >> 6)) * 64 + (c & 63)) * S_ + sq; }
                    else if (row < C_VR) { const int c = row - C_VW; dst = (bf16_t*)(ws + WS_VWT) + ((size_t)(b * 2 + (c >> 6)) * 64 + (c & 63)) * S_ + sq; }
                    else { const int c = row - C_VR; dst = (bf16_t*)(ws + WS_VRT) + ((size_t)(b * 8 + (c >> 7)) * 128 + (c & 127)) * S_ + sq; }
                    u32x4 w; w.x = pack2(v0[0], v0[1]); w.y = pack2(v0[2], v0[3]); w.z = pack2(v1[0], v1[1]); w.w = pack2(v1[2], v1[3]);
                    *(u32x4*)dst = w;
                    continue;
                }
                if (KIND == 1 || KIND == 2) {
                    const float2* rope = (const float2*)(ws + WS_ROPE);
                    const int pos = row & (S_ - 1), d = 16 * (wc & 1) + 4 * fq;
                    const float4 cs01 = *(const float4*)(rope + pos * 32 + d), cs23 = *(const float4*)(rope + pos * 32 + d + 2);
                    const float c[4] = {cs01.x, cs01.z, cs23.x, cs23.z}, sn[4] = {cs01.y, cs01.w, cs23.y, cs23.w};
                    const float sc = (KIND == 2) ? 0.125f : 1.0f;
                    f32x4 y1, y2;
#pragma unroll
                    for (int r = 0; r < 4; ++r) { y1[r] = (v0[r] * c[r] - v1[r] * sn[r]) * sc; y2[r] = (v0[r] * sn[r] + v1[r] * c[r]) * sc; }
                    v0 = y1; v1 = y2;
                } else if (KIND == 3) {
#pragma unroll
                    for (int r = 0; r < 4; ++r) { v0[r] = v0[r] * fsig(v0[r]); v1[r] = v1[r] * fsig(v1[r]); }
                } else if (KIND == 4) {
#pragma unroll
                    for (int r = 0; r < 4; ++r) { v0[r] = fsig(v0[r]); v1[r] = fsig(v1[r]); }
                }
                u32x4 w; w.x = pack2(v0[0], v0[1]); w.y = pack2(v0[2], v0[3]); w.z = pack2(v1[0], v1[1]); w.w = pack2(v1[2], v1[3]);
                *(u32x4*)((bf16_t*)(ws + WS_P) + (size_t)row * LD + col) = w;
            }
        }
}
struct G1Order {      typedef pg8::Unit U; static constexpr bool GATHER = false;
    int xcd, slot, per;
    __device__ __forceinline__ bool next(int i, pg8::Unit& u) const {
        const int j = slot + i * per; if (j >= 208) return false;
        if (j < 192) { u.pm = j / 3; u.pn = xcd + 8 * (j % 3); } else { const int q = j - 192; u.pm = 8 * xcd + (q >> 1); u.pn = 24 + (q & 1); }
        return true;
    }
    __device__ __forceinline__ void ptrs(const pg8::Unit& u, unsigned& A, unsigned& B) const {
        const unsigned x = (unsigned)WS_XB + (unsigned)u.pm * (256u * 1024u * 2u), w = (unsigned)WS_WIN + (unsigned)u.pn * (256u * 1024u * 2u);
        if (u.pn >= 21) { A = w; B = x; } else { A = x; B = w; }
    }
};
struct G1Epi {
    static constexpr int MID_T = 0;
    unsigned char* ws;
    __device__ __forceinline__ void operator()(const f32x4 (&acc)[2][2][4][2], const pg8::Unit& u, int wr, int wc, int fr, int fq) const {
        const int pn = u.pn, tok0 = u.pm * 256, n0 = pn * 256;
        if (pn >= 21) g1_epi<5>(acc, ws, n0, tok0, wr, wc, fr, fq);
        else if (pn >= 12) g1_epi<4>(acc, ws, tok0, n0, wr, wc, fr, fq);
        else if (pn >= 8) g1_epi<3>(acc, ws, tok0, n0, wr, wc, fr, fq);
        else if (pn >= 6) g1_epi<2>(acc, ws, tok0, n0, wr, wc, fr, fq);
        else if (pn >= 4) g1_epi<1>(acc, ws, tok0, n0, wr, wc, fr, fq);
        else g1_epi<0>(acc, ws, tok0, n0, wr, wc, fr, fq);
    }
};
__device__ __forceinline__ void phase_g1(const Params& p, int layer, unsigned char* lds) {
    unsigned char* ws = launder(p.ws);
    G1Order S; S.xcd = blockIdx.x & 7; S.slot = blockIdx.x >> 3; S.per = gridDim.x >> 3;
    G1Epi E; E.ws = ws;
    pg8::gemm_phase<G1Epi, G1Order>(lds, 1024, S, E, ltid(), ws);
}

__device__ __forceinline__ void load_tile64(const bf16_t* base, size_t rowStride, unsigned char* dst, int wid, int lane) {
    const int c = ((lane & 7) ^ (lane >> 3)) * 8;
#pragma unroll
    for (int i = 0; i < 2; ++i) { const int j = wid + 4 * i, row = 8 * j + (lane >> 3); glds16(base + (size_t)row * rowStride + c, dst + j * 1024); }
}
__device__ __forceinline__ void load_tile128(const bf16_t* base, size_t rowStride, unsigned char* dst, int wid, int lane) {
    const int c = ((lane & 7) ^ (lane >> 3)) * 8;
#pragma unroll
    for (int i = 0; i < 4; ++i) { const int j = wid + 4 * i, row = 8 * j + (lane >> 3); glds16(base + (size_t)row * rowStride + c, dst + j * 1024); }
}
__device__ __forceinline__ void load_tile128w(const bf16_t* base, size_t rowStride, unsigned char* dst, int wid, int lane) {
    const int c = ((lane & 15) ^ ((4 * wid + (lane >> 4)) & 15)) * 8;
#pragma unroll
    for (int i = 0; i < 8; ++i) { const int j = wid + 4 * i, row = 4 * j + (lane >> 4); glds16(base + (size_t)row * rowStride + c, dst + j * 1024); }
}
__device__ __forceinline__ bf16x8 lds_frag128(const unsigned char* tile, int row, int chunk) {
    return *(const bf16x8*)(tile + row * 128 + ((chunk ^ (row & 7)) << 4));
}
__device__ __forceinline__ bf16x8 lds_frag256(const unsigned char* tile, int row, int chunk) {
    return *(const bf16x8*)(tile + row * 256 + ((chunk ^ (row & 15)) << 4));
}
__device__ __forceinline__ bf16x8 lds_vfrag128(const unsigned char* tile, int row, int kbase, int fq) {
    const int ca = (kbase >> 3) + (fq >> 1), hb = (fq & 1) * 8;
    const u32x2 a = *(const u32x2*)(tile + row * 128 + ((ca ^ (row & 7)) << 4) + hb);
    const u32x2 b = *(const u32x2*)(tile + row * 128 + (((ca + 2) ^ (row & 7)) << 4) + hb);
    u32x4 w; w.x = a.x; w.y = a.y; w.z = b.x; w.w = b.y;
    return __builtin_bit_cast(bf16x8, w);
}
__device__ __forceinline__ bf16x8 lds_vfrag256(const unsigned char* tile, int row, int kbase, int fq) {
    const int ca = (kbase >> 3) + (fq >> 1), hb = (fq & 1) * 8;
    const u32x2 a = *(const u32x2*)(tile + row * 256 + ((ca ^ (row & 15)) << 4) + hb);
    const u32x2 b = *(const u32x2*)(tile + row * 256 + (((ca + 2) ^ (row & 15)) << 4) + hb);
    u32x4 w; w.x = a.x; w.y = a.y; w.z = b.x; w.w = b.y;
    return __builtin_bit_cast(bf16x8, w);
}
__device__ __forceinline__ bf16x8 pack8(f32x4 a, f32x4 b) {
    u32x4 w; w.x = pack2(a[0], a[1]); w.y = pack2(a[2], a[3]); w.z = pack2(b[0], b[1]); w.w = pack2(b[2], b[3]);
    return __builtin_bit_cast(bf16x8, w);
}

__device__ __forceinline__ float gelu_tanh(float x) {
    const float u = 0.7978845608028654f * (x + 0.044715f * x * x * x);
    return 0.5f * x * (1.f + tanhf(u));
}
__device__ __forceinline__ void compress_item(const Params& p, int layer, int item, unsigned char* lds, int half) {
    unsigned char* ws = launder(p.ws);
    const int tid = (ltid() & 255), lane = tid & 63, wid = tid >> 6, wr = wid >> 1, wc = wid & 1, fr = lane & 15, fq = lane >> 4;
    const int mtile = item & 3, g = (item >> 2) & 1, b = (item >> 3) & 1, kv = item >> 4;
    const int i0 = mtile * 128;
    const bf16_t* P = (const bf16_t*)(ws + WS_P);
    const bf16_t* W1T = (const bf16_t*)(ws + WS_W1T) + (size_t)kv * 64 * 2048;
    const int col = (kv ? C_VC : C_KC) + g * 64;
    const int ldc = ((lane & 7) ^ (lane >> 3)) * 8;
    const int l0 = 16 * half;
    const bf16_t* ap[4];
#pragma unroll
    for (int i = 0; i < 4; ++i) ap[i] = P + ((size_t)b * S_ + 16 * (i0 + 32 * i + 8 * wid + (lane >> 3)) + l0) * LD + col + ldc;
    const bf16_t* bp[2];
#pragma unroll
    for (int i = 0; i < 2; ++i) bp[i] = W1T + (size_t)(8 * (wid + 4 * i) + (lane >> 3)) * 2048 + l0 * 64 + ldc;
    f32x4 acc[4][2];
#pragma unroll
    for (int i = 0; i < 4; ++i)
#pragma unroll
        for (int j = 0; j < 2; ++j) acc[i][j] = (f32x4){0.f, 0.f, 0.f, 0.f};
    __syncthreads();
#define CSTAGE(buf, l) do { unsigned char* st_ = lds + (buf) * 24576; \
        _Pragma("unroll") for (int i = 0; i < 4; ++i) glds16(ap[i] + (size_t)(l) * LD, st_ + (4 * i + wid) * 1024); \
        _Pragma("unroll") for (int i = 0; i < 2; ++i) glds16(bp[i] + (l) * 64, st_ + 16384 + (wid + 4 * i) * 1024); } while (0)
    CSTAGE(0, 0); CSTAGE(1, 1);
    for (int l = 0; l < 16; ++l) {
        const unsigned char* st = lds + (l % 3) * 24576;
        if (l + 1 < 16) WAIT_V(6); else WAIT_V(0);
        RAW_BARRIER();
        if (l + 2 < 16) CSTAGE((l + 2) % 3, l + 2);
#pragma unroll
        for (int ks = 0; ks < 2; ++ks) {
            bf16x8 a[4], bb[2];
#pragma unroll
            for (int i = 0; i < 4; ++i) a[i] = lds_frag128(st, 64 * wr + 16 * i + fr, 4 * ks + fq);
#pragma unroll
            for (int j = 0; j < 2; ++j) bb[j] = lds_frag128(st + 16384, 32 * wc + 16 * j + fr, 4 * ks + fq);
#pragma unroll
            for (int i = 0; i < 4; ++i)
#pragma unroll
                for (int j = 0; j < 2; ++j) acc[i][j] = mfma16(a[i], bb[j], acc[i][j]);
        }
    }
    __syncthreads();
#undef CSTAGE
    float* xch = (float*)(lds - half * HALF_LDS + HALF_LDS);
    if (half == 1) {
#pragma unroll
        for (int i = 0; i < 4; ++i)
#pragma unroll
            for (int j = 0; j < 2; ++j)
#pragma unroll
                for (int r = 0; r < 4; ++r) xch[((i * 2 + j) * 4 + r) * 256 + tid] = acc[i][j][r];
    }
    __syncthreads();
    if (half == 0) {
        const float* b1 = (const float*)(ws + WS_CTL) + CW_B1P + kv * 32 * 64;
#pragma unroll
        for (int j = 0; j < 2; ++j) {
            const int n = 32 * wc + 16 * j + fr; float bias = 0.f;
#pragma unroll
            for (int kt = 0; kt < 32; ++kt) bias += b1[kt * 64 + n + vzero()];
#pragma unroll
            for (int i = 0; i < 4; ++i)
#pragma unroll
                for (int r = 0; r < 4; ++r) {
                    const int row = 64 * wr + 16 * i + 4 * fq + r;
                    const float hv = gelu_tanh(acc[i][j][r] + xch[((i * 2 + j) * 4 + r) * 256 + tid] + bias);
                    *(bf16_t*)(lds + row * 128 + (((n >> 3) ^ (row & 7)) << 4) + (n & 7) * 2) = f2bf(hv);
                }
        }
        const float* w2 = p.cmp_w2 + ((size_t)layer * 2 + kv) * 64 * 64;
        const int k = tid >> 2, n0 = (tid & 3) * 16;
#pragma unroll
        for (int q4 = 0; q4 < 4; ++q4) {
            const float4 w = *(const float4*)(w2 + k * 64 + n0 + 4 * q4);
            const float wv[4] = {w.x, w.y, w.z, w.w};
#pragma unroll
            for (int e = 0; e < 4; ++e) { const int n = n0 + 4 * q4 + e; *(bf16_t*)(lds + 16384 + n * 128 + (((k >> 3) ^ (n & 7)) << 4) + (k & 7) * 2) = f2bf(wv[e]); }
        }
    }
    __syncthreads();
    if (half == 0) {
        f32x4 o[4][2];
#pragma unroll
        for (int i = 0; i < 4; ++i)
#pragma unroll
            for (int j = 0; j < 2; ++j) o[i][j] = (f32x4){0.f, 0.f, 0.f, 0.f};
#pragma unroll
        for (int ks = 0; ks < 2; ++ks) {
            bf16x8 a[4], bb[2];
#pragma unroll
            for (int i = 0; i < 4; ++i) a[i] = lds_frag128(lds, 64 * wr + 16 * i + fr, 4 * ks + fq);
#pragma unroll
            for (int j = 0; j < 2; ++j) bb[j] = lds_frag128(lds + 16384, 32 * wc + 16 * j + fr, 4 * ks + fq);
#pragma unroll
            for (int i = 0; i < 4; ++i)
#pragma unroll
                for (int j = 0; j < 2; ++j) o[i][j] = mfma16(a[i], bb[j], o[i][j]);
        }
#pragma unroll
        for (int i = 0; i < 4; ++i)
#pragma unroll
            for (int j = 0; j < 2; ++j) {
                const int n = 32 * wc + 16 * j + fr, ci = i0 + 64 * wr + 16 * i + 4 * fq;
                f32x4 v = o[i][j];
#pragma unroll
                for (int r = 0; r < 4; ++r) if (ci + r >= 511) v[r] = 0.f;
                if (kv == 0) {
                    bf16_t* dst = (bf16_t*)(ws + WS_KCC) + ((size_t)(b * 2 + g) * 512 + ci) * 64 + n;
#pragma unroll
                    for (int r = 0; r < 4; ++r) dst[r * 64] = f2bf(v[r]);
                } else {
                    *(u32x2*)((bf16_t*)(ws + WS_VCCT) + ((size_t)(b * 2 + g) * 64 + n) * 512 + ci) = pack4(v);
                }
            }
    }
    __syncthreads();
}

__device__ __forceinline__ float ret_lg2(int h) { const float gam = 1.f - exp2f(-5.f - (float)h); return log2f(gam); }

__device__ __forceinline__ void retkv_item(const Params& p, int item, unsigned char* lds, int half) {
    unsigned char* ws = launder(p.ws);
    const int tid = (ltid() & 255), lane = tid & 63, wid = tid >> 6, fr = lane & 15, fq = lane >> 4;
    const int n = item & 63, h = (item >> 6) & 7, b = item >> 9;
    const size_t tok0 = (size_t)b * S_ + 128 * n;
    unsigned char* vL = lds; unsigned char* kL = lds + 32768;
    load_tile128w((const bf16_t*)(ws + WS_VRT) + ((size_t)(b * 8 + h) * 128) * S_ + 128 * n, S_, vL, wid, lane);
    load_tile128((const bf16_t*)(ws + WS_P) + tok0 * LD + C_KR + h * 64, LD, kL, wid, lane);
    wait_vm0(); __syncthreads();
    const float lg2 = ret_lg2(h);
    f32x4 acc[2][4];
#pragma unroll
    for (int m = 0; m < 2; ++m)
#pragma unroll
        for (int nt = 0; nt < 4; ++nt) acc[m][nt] = (f32x4){0.f, 0.f, 0.f, 0.f};
#pragma unroll
    for (int ks = 0; ks < 4; ++ks) {
        bf16x8 a[2], bb[4];
#pragma unroll
        for (int m = 0; m < 2; ++m) a[m] = lds_frag256(vL, 32 * wid + 16 * m + fr, 4 * ks + fq);
        float dec[8];
#pragma unroll
        for (int j = 0; j < 8; ++j) dec[j] = exp2f((float)(127 - (32 * ks + 8 * fq + j)) * lg2);
#pragma unroll
        for (int nt = 0; nt < 4; ++nt) {
            const int d = 16 * nt + fr;
            float v[8];
#pragma unroll
            for (int j = 0; j < 8; ++j) {
                const int tk = 32 * ks + 8 * fq + j;
                const bf16_t kvv = *(const bf16_t*)(kL + tk * 128 + (((d >> 3) ^ (tk & 7)) << 4) + (d & 7) * 2);
                v[j] = bf2f(kvv) * dec[j];
            }
            u32x4 w; w.x = pack2(v[0], v[1]); w.y = pack2(v[2], v[3]); w.z = pack2(v[4], v[5]); w.w = pack2(v[6], v[7]);
            bb[nt] = __builtin_bit_cast(bf16x8, w);
        }
#pragma unroll
        for (int m = 0; m < 2; ++m)
#pragma unroll
            for (int nt = 0; nt < 4; ++nt) acc[m][nt] = mfma16(a[m], bb[nt], acc[m][nt]);
    }
    float* KVT = (float*)(ws + WS_KVT) + ((size_t)(b * 8 + h) * 64 + n) * 8192;
#pragma unroll
    for (int m = 0; m < 2; ++m)
#pragma unroll
        for (int nt = 0; nt < 4; ++nt)
#pragma unroll
            for (int r = 0; r < 4; ++r) KVT[(32 * wid + 16 * m + 4 * fq + r) * 64 + 16 * nt + fr] = acc[m][nt][r];
    __syncthreads();
}

__device__ __forceinline__ void phase_p2(const Params& p, int layer, unsigned char* lds, int half) {
    const int vb = blockIdx.x * 2 + half, nvb = gridDim.x * 2;
    if (vb < 64) compress_item(p, layer, vb >> 1, lds, half);
    else for (int it = vb - 64; it < 1024; it += nvb - 64) retkv_item(p, it, lds, half);
}

constexpr int NSA_IMP = 32768, NSA_BUCKET = 65792, NSA_BIAS = 73984;

struct NsaLane { int t; int fr, fq, wid, lane; };

constexpr float LOG2E = 1.4426950408889634f;
__device__ __forceinline__ int t5_first(int bk) {
    const int th[16] = {16, 22, 30, 40, 54, 73, 99, 134, 182, 246, 332, 450, 609, 825, 1117, 1513};
    int r = 16;
#pragma unroll
    for (int k = 0; k < 16; ++k) r = (bk == 16 + k) ? th[k] : r;
    return r;
}
template <int BR, int PASS>
__device__ __forceinline__ void nsa_half(const unsigned char* kL, const unsigned char* vL, const unsigned char* lds, const bf16x8 (&qptr)[4][2],
                                         f32x4 (&O)[4][4], float (&m)[4], float (&l)[4], int tile, int hf, const NsaLane& L, int qrow, const bool FAST, int th, int b0, int b1) {
    const int fr = L.lane & 15, fq = L.lane >> 4;
    constexpr float C2 = 0.125f * LOG2E;
    bf16x8 Kf[2][2];
#pragma unroll
    for (int i = 0; i < 2; ++i)
#pragma unroll
        for (int ks = 0; ks < 2; ++ks) Kf[i][ks] = lds_frag128(kL, 32 * hf + 16 * i + fr, 4 * ks + fq);
    bf16x8 Vf[4];
    if (PASS != 0) {
#pragma unroll
        for (int mt = 0; mt < 4; ++mt) Vf[mt] = lds_vfrag128(vL, 16 * mt + fr, 32 * hf, fq);
    }
    unsigned vmask = 0; unsigned bk[2] = {0u, 0u}; bool hi[2][4];
    if (!FAST) {
        const unsigned char* bucketL = lds + NSA_BUCKET;
#pragma unroll
        for (int i = 0; i < 2; ++i) {
            unsigned pk = 0;
#pragma unroll
            for (int r = 0; r < 4; ++r) {
                const int kk = 32 * hf + 16 * i + 4 * fq + r;
                int rel; bool ok;
                if (BR == 0) { rel = L.t - (16 * (64 * tile + kk) + 31); ok = rel >= 0; }
                else { rel = L.t - (64 * tile + kk); ok = rel >= 0 && rel < 512; }
                int rc = rel < 0 ? 0 : rel; rc = rc > 8191 ? 8191 : rc;
                pk |= (unsigned)bucketL[rc] << (8 * r);
                vmask |= (ok ? 1u : 0u) << (4 * i + r);
                hi[i][r] = false;
            }
            bk[i] = pk;
        }
    } else {
        const int kbase = 64 * tile + 32 * hf + 4 * fq;
        const int lim = BR == 0 ? L.t - th - 31 - 16 * kbase : L.t - th - kbase;
#pragma unroll
        for (int i = 0; i < 2; ++i)
#pragma unroll
            for (int r = 0; r < 4; ++r) hi[i][r] = (BR == 0 ? 16 : 1) * (16 * i + r) <= lim;
    }
    const float* biasL = (const float*)(lds + NSA_BIAS);
    float ia[2] = {0.f, 0.f}, ic[2] = {0.f, 0.f};
#pragma unroll
    for (int nt = 0; nt < 4; ++nt) {
        f32x4 S[2];
        const bf16x8 q0 = qptr[nt][0], q1 = qptr[nt][1];
#pragma unroll
        for (int i = 0; i < 2; ++i) {
            S[i] = (f32x4){0.f, 0.f, 0.f, 0.f};
            S[i] = mfma16(Kf[i][0], q0, S[i]); S[i] = mfma16(Kf[i][1], q1, S[i]);
        }
        float tmax = -1e30f;
        if (!FAST) {
#pragma unroll
            for (int i = 0; i < 2; ++i) {
                float bsv[4];
#pragma unroll
                for (int r = 0; r < 4; ++r) bsv[r] = biasL[nt * 32 + ((bk[i] >> (8 * r)) & 0xffu)];
                asm volatile("" : "+v"(bsv[0]), "+v"(bsv[1]), "+v"(bsv[2]), "+v"(bsv[3]));
#pragma unroll
                for (int r = 0; r < 4; ++r) {
                    const bool ok = (vmask >> (4 * i + r)) & 1u;
                    const float sv = S[i][r] * C2 + bsv[r];
                    S[i][r] = ok ? sv : -1e30f; tmax = fmaxf(tmax, S[i][r]);
                }
            }
        } else {
            const float blo = biasL[nt * 32 + b0], bhi = biasL[nt * 32 + b1];
#pragma unroll
            for (int i = 0; i < 2; ++i)
#pragma unroll
                for (int r = 0; r < 4; ++r) { S[i][r] = S[i][r] * C2 + (hi[i][r] ? bhi : blo); tmax = fmaxf(tmax, S[i][r]); }
        }
        if (PASS != 1) {
            if (__builtin_amdgcn_ballot_w64(tmax > m[nt] + 8.f) != 0ull) {
                const float tm = rows_max(tmax);
                const float mnew = tm > m[nt] + 8.f ? tm : m[nt], alpha = __builtin_amdgcn_exp2f(m[nt] - mnew);
                l[nt] *= alpha; m[nt] = mnew;
                if (PASS == 2) {
#pragma unroll
                    for (int mt = 0; mt < 4; ++mt) O[mt][nt] = O[mt][nt] * alpha;
                }
            }
            float psum = 0.f;
#pragma unroll
            for (int i = 0; i < 2; ++i)
#pragma unroll
                for (int r = 0; r < 4; ++r) S[i][r] = __builtin_amdgcn_exp2f(S[i][r] - m[nt]);
            if (!FAST) {
#pragma unroll
                for (int i = 0; i < 2; ++i)
#pragma unroll
                    for (int r = 0; r < 4; ++r) { const bool ok = (vmask >> (4 * i + r)) & 1u; S[i][r] = ok ? S[i][r] : 0.f; }
            }
#pragma unroll
            for (int i = 0; i < 2; ++i)
#pragma unroll
                for (int r = 0; r < 4; ++r) psum += S[i][r];
            l[nt] += psum;
        } else {
#pragma unroll
            for (int i = 0; i < 2; ++i) {
#pragma unroll
                for (int r = 0; r < 4; ++r) S[i][r] = __builtin_amdgcn_exp2f(S[i][r] - m[nt]) * l[nt];
            }
            if (!FAST) {
#pragma unroll
                for (int i = 0; i < 2; ++i)
#pragma unroll
                    for (int r = 0; r < 4; ++r) { const bool ok = (vmask >> (4 * i + r)) & 1u; S[i][r] = ok ? S[i][r] : 0.f; }
            }
#pragma unroll
            for (int i = 0; i < 2; ++i) {
                ia[i] += S[i][0] + S[i][1] + S[i][2] + 0.5f * S[i][3];
                ic[i] += 0.5f * S[i][3];
            }
        }
        if (PASS != 0) {
            const bf16x8 Pb = pack8(S[0], S[1]);
#pragma unroll
            for (int mt = 0; mt < 4; ++mt) O[mt][nt] = mfma16(Vf[mt], Pb, O[mt][nt]);
        }
        if (nt & 1) __builtin_amdgcn_sched_barrier(0);
    }
    if (PASS == 1) {
        float* imp = (float*)(lds + NSA_IMP) + qrow * 129;
        asm volatile("" ::: "memory"); __builtin_amdgcn_wave_barrier();
#pragma unroll
        for (int i = 0; i < 2; ++i) { const int j = 16 * tile + 8 * hf + 4 * i + fq; imp[j] += ia[i]; }
        asm volatile("s_waitcnt lgkmcnt(0)" ::: "memory"); __builtin_amdgcn_wave_barrier();
#pragma unroll
        for (int i = 0; i < 2; ++i) { const int j = 16 * tile + 8 * hf + 4 * i + fq + 1; if (j < 128) imp[j] += ic[i]; }
        asm volatile("s_waitcnt lgkmcnt(0)" ::: "memory"); __builtin_amdgcn_wave_barrier();
    }
}
template <int BR, int PASS>
__device__ __forceinline__ void nsa_tile(const unsigned char* kL, const unsigned char* vL, const unsigned char* lds, const bf16x8 (&qptr)[4][2],
                                         f32x4 (&O)[4][4], float (&m)[4], float (&l)[4], int tile, const NsaLane& L, int qrow) {
    const int tq0 = __builtin_amdgcn_readfirstlane(L.t - (L.lane & 15));
#pragma unroll 1
    for (int hf = 0; hf < 2; ++hf) {
        const int kfirst = 64 * tile + 32 * hf, pmin = BR == 0 ? 16 * kfirst + 31 : kfirst, pmax = BR == 0 ? 16 * (kfirst + 31) + 31 : kfirst + 31;
        const int rmin = tq0 - pmax, rmax = tq0 + 15 - pmin;
        bool fast = false; int th = 0, b0 = 0, b1 = 0;
        if (rmin >= 16 && (BR != 2 || rmax < 512)) {
            const unsigned char* bucketL = lds + NSA_BUCKET;
            b0 = __builtin_amdgcn_readfirstlane((int)bucketL[rmin]); b1 = __builtin_amdgcn_readfirstlane((int)bucketL[rmax > 8191 ? 8191 : rmax]);
            if (b1 - b0 <= 1) { fast = true; th = b1 == b0 ? 0 : t5_first(b1); }
        }
        nsa_half<BR, PASS>(kL, vL, lds, qptr, O, m, l, tile, hf, L, qrow, fast, th, b0, b1);
    }
}

__device__ __forceinline__ void cmp_item(const Params& p, int item, unsigned char* lds, int half) {
    unsigned char* ws = launder(p.ws);
    const int tid = (ltid() & 255), lane = tid & 63, wid = tid >> 6, fr = lane & 15, fq = lane >> 4;
    const int combo = item & 3, qt = 127 - (item >> 2), b = combo >> 1, g = combo & 1;
    const int q0 = qt * 64, qrow = 16 * wid + fr;
    NsaLane L; L.t = q0 + qrow; L.fr = fr; L.fq = fq; L.wid = wid; L.lane = lane;
    const size_t tok = (size_t)b * S_ + L.t;
    const bf16_t* P = (const bf16_t*)(ws + WS_P);
    __syncthreads();
    if (tid < 128) ((float*)(lds + NSA_BIAS))[tid] = p.rel_bias[(tid & 31) * 8 + 4 * g + (tid >> 5)] * LOG2E;
    for (int i = tid; i < 64 * 129; i += HT) ((float*)(lds + NSA_IMP))[i] = 0.f;
    bf16x8 Qf[4][2];
#pragma unroll
    for (int nt = 0; nt < 4; ++nt)
#pragma unroll
        for (int ks = 0; ks < 2; ++ks) Qf[nt][ks] = *(const bf16x8*)(P + tok * LD + C_QA + (4 * g + nt) * 64 + 32 * ks + 8 * fq);
    __syncthreads();
    f32x4 O[4][4]; float m[4], l[4];
    const bf16_t* gates = P + tok * LD + C_GA + (4 * g) * 3;
    const bf16_t* kc = (const bf16_t*)(ws + WS_KCC) + (size_t)(b * 2 + g) * 512 * 64;
    const bf16_t* vc = (const bf16_t*)(ws + WS_VCCT) + (size_t)(b * 2 + g) * 64 * 512;
    const int ntc = ((q0 + 32) >> 4) / 64 + 1;
#pragma unroll
    for (int nt = 0; nt < 4; ++nt) { m[nt] = -1e30f; l[nt] = 0.f; }
    load_tile64(kc, 64, lds, wid, lane);
    wait_vm0(); __syncthreads();
    for (int it = 0; it < ntc; ++it) {
        unsigned char* cur = lds + (it & 1) * 16384;
        if (it + 1 < ntc) load_tile64(kc + (size_t)(it + 1) * 64 * 64, 64, lds + ((it + 1) & 1) * 16384, wid, lane);
        nsa_tile<0, 0>(cur, cur + 8192, lds, Qf, O, m, l, it, L, qrow);
        wait_vm0(); __syncthreads();
    }
#pragma unroll
    for (int nt = 0; nt < 4; ++nt) { l[nt] = rows_sum(l[nt]); l[nt] = l[nt] > 0.f ? 1.f / l[nt] : 0.f; }
#pragma unroll
    for (int mt = 0; mt < 4; ++mt)
#pragma unroll
        for (int nt = 0; nt < 4; ++nt) O[mt][nt] = (f32x4){0.f, 0.f, 0.f, 0.f};
    load_tile64(kc, 64, lds, wid, lane); load_tile64(vc, 512, lds + 8192, wid, lane);
    wait_vm0(); __syncthreads();
    for (int it = 0; it < ntc; ++it) {
        unsigned char* cur = lds + (it & 1) * 16384;
        if (it + 1 < ntc) { unsigned char* nx = lds + ((it + 1) & 1) * 16384;
            load_tile64(kc + (size_t)(it + 1) * 64 * 64, 64, nx, wid, lane); load_tile64(vc + (it + 1) * 64, 512, nx + 8192, wid, lane); }
        nsa_tile<0, 1>(cur, cur + 8192, lds, Qf, O, m, l, it, L, qrow);
        wait_vm0(); __syncthreads();
    }
    bf16_t* YC = (bf16_t*)(ws + WS_YC) + tok * 512 + (4 * g) * 64;
#pragma unroll
    for (int nt = 0; nt < 4; ++nt) {
        const float gt = bf2f(gates[nt * 3 + 0]);
#pragma unroll
        for (int mt = 0; mt < 4; ++mt) *(u32x2*)(YC + nt * 64 + 16 * mt + 4 * fq) = pack4(O[mt][nt] * gt);
    }
    const int cur = qt;
    {
        float* imp = (float*)(lds + NSA_IMP) + qrow * 129 + 32 * fq;
        asm volatile("s_waitcnt lgkmcnt(0)" ::: "memory"); __builtin_amdgcn_wave_barrier();
#pragma unroll
        for (int i = 0; i < 32; ++i) {
            const int j = 32 * fq + i;
            const float v = imp[i];
            imp[i] = j > cur ? -1.f : v + ((j == 0 || j == cur || j == cur - 1) ? 1.0e4f : 0.f);
        }
        unsigned word = 0;
#pragma unroll 1
        for (int round = 0; round < 16; ++round) {
            float bv = imp[0]; int bi = 0;
#pragma unroll
            for (int i = 1; i < 32; ++i) { const float v = imp[i]; if (v > bv) { bv = v; bi = i; } }
            int gi = 32 * fq + bi;
            {
                u32x2 rv = __builtin_amdgcn_permlane16_swap(__float_as_uint(bv), __float_as_uint(bv), false, false);
                u32x2 ri = __builtin_amdgcn_permlane16_swap((unsigned)gi, (unsigned)gi, false, false);
                float v0 = __uint_as_float(rv.x), v1 = __uint_as_float(rv.y); int i0 = (int)ri.x, i1 = (int)ri.y;
                if (v1 > v0 || (v1 == v0 && i1 < i0)) { v0 = v1; i0 = i1; }
                rv = __builtin_amdgcn_permlane32_swap(__float_as_uint(v0), __float_as_uint(v0), false, false);
                ri = __builtin_amdgcn_permlane32_swap((unsigned)i0, (unsigned)i0, false, false);
                v0 = __uint_as_float(rv.x); v1 = __uint_as_float(rv.y); i0 = (int)ri.x; i1 = (int)ri.y;
                if (v1 > v0 || (v1 == v0 && i1 < i0)) { v0 = v1; i0 = i1; }
                bv = v0; gi = i0;
            }
            if (bv >= 0.f && (gi >> 5) == fq) { word |= 1u << (gi & 31); imp[gi & 31] = -2.f; }
        }
        ((unsigned*)(ws + WS_SELW))[(tok * 2 + g) * 4 + fq] = word;
    }
}

__device__ __forceinline__ void win_item(const Params& p, int item, unsigned char* lds, int half) {
    unsigned char* ws = launder(p.ws);
    const int tid = (ltid() & 255), lane = tid & 63, wid = tid >> 6, fr = lane & 15, fq = lane >> 4;
    const int combo = item & 3, qt = 127 - (item >> 2), b = combo >> 1, g = combo & 1;
    const int q0 = qt * 64, qrow = 16 * wid + fr;
    NsaLane L; L.t = q0 + qrow; L.fr = fr; L.fq = fq; L.wid = wid; L.lane = lane;
    const size_t tok = (size_t)b * S_ + L.t;
    const bf16_t* P = (const bf16_t*)(ws + WS_P);
    __syncthreads();
    if (tid < 128) ((float*)(lds + NSA_BIAS))[tid] = p.rel_bias[(tid & 31) * 8 + 4 * g + (tid >> 5)] * LOG2E;
    bf16x8 Qf[4][2];
#pragma unroll
    for (int nt = 0; nt < 4; ++nt)
#pragma unroll
        for (int ks = 0; ks < 2; ++ks) Qf[nt][ks] = *(const bf16x8*)(P + tok * LD + C_QA + (4 * g + nt) * 64 + 32 * ks + 8 * fq);
    __syncthreads();
    f32x4 O[4][4]; float m[4], l[4];
    const bf16_t* gates = P + tok * LD + C_GA + (4 * g) * 3;
#pragma unroll
    for (int nt = 0; nt < 4; ++nt) { m[nt] = -1e30f; l[nt] = 0.f; }
#pragma unroll
    for (int mt = 0; mt < 4; ++mt)
#pragma unroll
        for (int nt = 0; nt < 4; ++nt) O[mt][nt] = (f32x4){0.f, 0.f, 0.f, 0.f};
    {
        const bf16_t* kb = P + ((size_t)b * S_) * LD + C_KW + g * 64;
        const bf16_t* vb = (const bf16_t*)(ws + WS_VWT) + (size_t)(b * 2 + g) * 64 * S_;
        const int k_lo = qt - 8 > 0 ? qt - 8 : 0, ntw = qt - k_lo + 1;
        load_tile64(kb + (size_t)k_lo * 64 * LD, LD, lds, wid, lane); load_tile64(vb + k_lo * 64, S_, lds + 8192, wid, lane);
        wait_vm0(); __syncthreads();
        for (int it = 0; it < ntw; ++it) {
            unsigned char* cu = lds + (it & 1) * 16384;
            if (it + 1 < ntw) { unsigned char* nx = lds + ((it + 1) & 1) * 16384;
                load_tile64(kb + (size_t)(k_lo + it + 1) * 64 * LD, LD, nx, wid, lane); load_tile64(vb + (k_lo + it + 1) * 64, S_, nx + 8192, wid, lane); }
            nsa_tile<2, 2>(cu, cu + 8192, lds, Qf, O, m, l, k_lo + it, L, qrow);
            wait_vm0(); __syncthreads();
        }
    }
    bf16_t* YW = (bf16_t*)(ws + WS_YW) + tok * 512 + (4 * g) * 64;
#pragma unroll
    for (int nt = 0; nt < 4; ++nt) {
        const float lt = rows_sum(l[nt]), gt = bf2f(gates[nt * 3 + 2]) * (lt > 0.f ? 1.f / lt : 0.f);
#pragma unroll
        for (int mt = 0; mt < 4; ++mt) *(u32x2*)(YW + nt * 64 + 16 * mt + 4 * fq) = pack4(O[mt][nt] * gt);
    }
}

constexpr int SEL_RING = 8, SEL_BUCKET = SEL_RING * 16384, SEL_BIAS2 = SEL_BUCKET + 8192;
template <bool FAST>
__device__ __forceinline__ void sel_ntile(const bf16x8 (&Kf)[4][2], const unsigned char* vL, int fr, int fq, const bf16x8& q0, const bf16x8& q1, f32x4 (&O)[4], float& m, float& l,
                                          bool sb, int relb, int th, float blo, float bhi, const unsigned char* lds, int hl) {
    f32x4 S[4];
#pragma unroll
    for (int i = 0; i < 4; ++i) { S[i] = (f32x4){0.f, 0.f, 0.f, 0.f}; S[i] = mfma16(Kf[i][0], q0, S[i]); S[i] = mfma16(Kf[i][1], q1, S[i]); }
    float tmax = -1e30f;
    const float scl = (!FAST || sb) ? 0.125f * LOG2E : 0.f;
    if (FAST) { blo = (sb ? blo : -1e30f) - m; bhi = (sb ? bhi : -1e30f) - m; }
    if (FAST) {
#pragma unroll
        for (int i = 0; i < 4; ++i)
#pragma unroll
            for (int r = 0; r < 4; ++r) { const int rel = relb - (16 * i + r); S[i][r] = S[i][r] * scl + (rel >= th ? bhi : blo); tmax = fmaxf(tmax, S[i][r]); }
    } else {
        unsigned bkt[4][4]; float bs[4][4];
#pragma unroll
        for (int i = 0; i < 4; ++i)
#pragma unroll
            for (int r = 0; r < 4; ++r) { const int rel = relb - (16 * i + r); int rc = rel < 0 ? 0 : rel; rc = rc > 8191 ? 8191 : rc; bkt[i][r] = (lds + SEL_BUCKET)[rc]; }
#pragma unroll
        for (int i = 0; i < 4; ++i)
#pragma unroll
            for (int r = 0; r < 4; ++r) bs[i][r] = ((const float*)(lds + SEL_BIAS2))[hl * 32 + bkt[i][r]];
        asm volatile("" : "+v"(bs[0][0]), "+v"(bs[0][1]), "+v"(bs[0][2]), "+v"(bs[0][3]), "+v"(bs[1][0]), "+v"(bs[1][1]), "+v"(bs[1][2]), "+v"(bs[1][3]),
                          "+v"(bs[2][0]), "+v"(bs[2][1]), "+v"(bs[2][2]), "+v"(bs[2][3]), "+v"(bs[3][0]), "+v"(bs[3][1]), "+v"(bs[3][2]), "+v"(bs[3][3]));
        const float ninf = -1e30f;
#pragma unroll
        for (int i = 0; i < 4; ++i)
#pragma unroll
            for (int r = 0; r < 4; ++r) {
                const int rel = relb - (16 * i + r);
                const float sv = S[i][r] * (0.125f * LOG2E) + (bs[i][r] - m);
                S[i][r] = (sb && rel >= 0) ? sv : ninf; tmax = fmaxf(tmax, S[i][r]);
            }
    }
    tmax = rows_max(tmax);
    if (__ballot(tmax > 8.f) != 0ull) {
        const float d = fmaxf(tmax, 0.f), alpha = __builtin_amdgcn_exp2f(-d);
        m += d; l *= alpha;
#pragma unroll
        for (int mt = 0; mt < 4; ++mt) O[mt] = O[mt] * alpha;
#pragma unroll
        for (int i = 0; i < 4; ++i)
#pragma unroll
            for (int r = 0; r < 4; ++r) S[i][r] -= d;
    }
    float psum = 0.f;
#pragma unroll
    for (int i = 0; i < 4; ++i)
#pragma unroll
        for (int r = 0; r < 4; ++r) { const float pv = __builtin_amdgcn_exp2f(S[i][r]); S[i][r] = pv; psum += pv; }
    l += rows_sum(psum);
    const bf16x8 Pb0 = pack8(S[0], S[1]), Pb1 = pack8(S[2], S[3]);
#pragma unroll
    for (int mt = 0; mt < 4; ++mt) { O[mt] = mfma16(lds_vfrag128(vL, 16 * mt + fr, 0, fq), Pb0, O[mt]); O[mt] = mfma16(lds_vfrag128(vL, 16 * mt + fr, 32, fq), Pb1, O[mt]); }
}
__device__ __forceinline__ void sel_ntile2_fast(const bf16x8 (&Kf)[4][2], const unsigned char* vL, int fr, int fq, const bf16x8 (&Qf)[2][2], f32x4 (&O)[2][4], float (&m)[2], float (&l)[2],
                                                const bool (&sb)[2], const int (&relb)[2], int th, float blo, float bhi) {
    f32x4 S[2][4]; float tmax[2], bl[2], bh[2], scl[2];
#pragma unroll
    for (int b = 0; b < 2; ++b)
#pragma unroll
        for (int i = 0; i < 4; ++i) { S[b][i] = (f32x4){0.f, 0.f, 0.f, 0.f}; S[b][i] = mfma16(Kf[i][0], Qf[b][0], S[b][i]); S[b][i] = mfma16(Kf[i][1], Qf[b][1], S[b][i]); }
#pragma unroll
    for (int b = 0; b < 2; ++b) { scl[b] = sb[b] ? 0.125f * LOG2E : 0.f; bl[b] = (sb[b] ? blo : -1e30f) - m[b]; bh[b] = (sb[b] ? bhi : -1e30f) - m[b]; tmax[b] = -1e30f; }
#pragma unroll
    for (int b = 0; b < 2; ++b)
#pragma unroll
        for (int i = 0; i < 4; ++i)
#pragma unroll
            for (int r = 0; r < 4; ++r) { const int rel = relb[b] - (16 * i + r); S[b][i][r] = S[b][i][r] * scl[b] + (rel >= th ? bh[b] : bl[b]); tmax[b] = fmaxf(tmax[b], S[b][i][r]); }
#pragma unroll
    for (int b = 0; b < 2; ++b) tmax[b] = rows_max(tmax[b]);
    if (__ballot(tmax[0] > 8.f || tmax[1] > 8.f) != 0ull) {
#pragma unroll
        for (int b = 0; b < 2; ++b) {
            const float d = fmaxf(tmax[b], 0.f), alpha = __builtin_amdgcn_exp2f(-d);
            m[b] += d; l[b] *= alpha;
#pragma unroll
            for (int mt = 0; mt < 4; ++mt) O[b][mt] = O[b][mt] * alpha;
#pragma unroll
            for (int i = 0; i < 4; ++i)
#pragma unroll
                for (int r = 0; r < 4; ++r) S[b][i][r] -= d;
        }
    }
    float psum[2] = {0.f, 0.f};
#pragma unroll
    for (int b = 0; b < 2; ++b)
#pragma unroll
        for (int i = 0; i < 4; ++i)
#pragma unroll
            for (int r = 0; r < 4; ++r) { const float pv = __builtin_amdgcn_exp2f(S[b][i][r]); S[b][i][r] = pv; psum[b] += pv; }
#pragma unroll
    for (int b = 0; b < 2; ++b) l[b] += rows_sum(psum[b]);
    bf16x8 P0[2], P1[2];
#pragma unroll
    for (int b = 0; b < 2; ++b) { P0[b] = pack8(S[b][0], S[b][1]); P1[b] = pack8(S[b][2], S[b][3]); }
#pragma unroll
    for (int mt = 0; mt < 4; ++mt) {
        const bf16x8 v0 = lds_vfrag128(vL, 16 * mt + fr, 0, fq), v1 = lds_vfrag128(vL, 16 * mt + fr, 32, fq);
#pragma unroll
        for (int b = 0; b < 2; ++b) { O[b][mt] = mfma16(v0, P0[b], O[b][mt]); O[b][mt] = mfma16(v1, P1[b], O[b][mt]); }
    }
}
template <bool FAST>
__device__ __forceinline__ void sel_tile(const unsigned char* kL, const unsigned char* vL, const unsigned char* lds, const bf16x8 (&Qf)[2][2], f32x4 (&O)[2][4], float (&m)[2], float (&l)[2],
                                         const bool (&sb)[2], const bool (&need)[2], const int (&relb)[2], int th, float blo, float bhi, int hl, int fr, int fq) {
    bf16x8 Kf[4][2];
#pragma unroll
    for (int i = 0; i < 4; ++i)
#pragma unroll
        for (int ks = 0; ks < 2; ++ks) Kf[i][ks] = lds_frag128(kL, 16 * i + fr, 4 * ks + fq);
    if (FAST && need[0] && need[1]) { sel_ntile2_fast(Kf, vL, fr, fq, Qf, O, m, l, sb, relb, th, blo, bhi); return; }
    if (need[0]) sel_ntile<FAST>(Kf, vL, fr, fq, Qf[0][0], Qf[0][1], O[0], m[0], l[0], sb[0], relb[0], th, blo, bhi, lds, hl);
    if (need[1]) sel_ntile<FAST>(Kf, vL, fr, fq, Qf[1][0], Qf[1][1], O[1], m[1], l[1], sb[1], relb[1], th, blo, bhi, lds, hl);
}
template <int VAR>
__device__ __forceinline__ void sel_item(const Params& p, int v, unsigned char* lds) {
    unsigned char* ws = launder(p.ws);
    const int tid = ltid(), lane = tid & 63, wid = tid >> 6, fr = lane & 15, fq = lane >> 4;
    const int qt = 127 - (v >> 2), sub = v & 3, b = sub >> 1, g = sub & 1;
    const int q0 = qt * 64, cur = qt, hl = fr & 3;
    const bf16_t* P = (const bf16_t*)(ws + WS_P);
    __syncthreads();
    if (tid < 128) ((float*)(lds + SEL_BIAS2))[tid] = p.rel_bias[(tid & 31) * 8 + 4 * g + (tid >> 5)] * LOG2E;
    int t[2]; size_t tok[2]; bf16x8 Qf[2][2]; unsigned selw[2][4];
#pragma unroll
    for (int nt = 0; nt < 2; ++nt) {
        t[nt] = q0 + 8 * wid + 4 * nt + (fr >> 2); tok[nt] = (size_t)b * S_ + t[nt];
#pragma unroll
        for (int ks = 0; ks < 2; ++ks) Qf[nt][ks] = *(const bf16x8*)(P + tok[nt] * LD + C_QA + (4 * g + hl) * 64 + 32 * ks + 8 * fq);
        const u32x4 w = *(const u32x4*)((const unsigned*)(ws + WS_SELW) + (tok[nt] * 2 + g) * 4);
        selw[nt][0] = w.x; selw[nt][1] = w.y; selw[nt][2] = w.z; selw[nt][3] = w.w;
    }
    f32x4 O[2][4]; float m[2], l[2];
#pragma unroll
    for (int nt = 0; nt < 2; ++nt) { m[nt] = -1000.f; l[nt] = 0.f;
#pragma unroll
        for (int mt = 0; mt < 4; ++mt) O[nt][mt] = (f32x4){0.f, 0.f, 0.f, 0.f}; }
    const bf16_t* kb = P + ((size_t)b * S_) * LD + C_KS + g * 64;
    const bf16_t* vb = (const bf16_t*)(ws + WS_VST) + (size_t)(b * 2 + g) * 64 * S_;
    const int nts = cur + 1;
#define SEL_ISSUE(jj) do { unsigned char* st_ = lds + ((jj) & 7) * 16384; const int c_ = ((lane & 7) ^ (lane >> 3)) * 8, r_ = 8 * wid + (lane >> 3); \
        glds16(kb + ((size_t)(jj) * 64 + r_) * LD + c_, st_ + wid * 1024); glds16(vb + (size_t)r_ * S_ + (jj) * 64 + c_, st_ + 8192 + wid * 1024); } while (0)
    asm volatile("s_waitcnt vmcnt(0)" ::: "memory");
#pragma unroll
    for (int q = 0; q < 4; ++q) if (q < nts) SEL_ISSUE(q);
    const unsigned char* bucketL = lds + SEL_BUCKET;
    for (int jp = 0; jp < nts; jp += 4) {
        WAIT_V(0);
        RAW_BARRIER();
#pragma unroll
        for (int q = 4; q < 8; ++q) if (jp + q < nts) SEL_ISSUE(jp + q);
#pragma unroll 1
      for (int j = jp; j < jp + 4 && j < nts; ++j) {
        const unsigned char* cu = lds + (j & 7) * 16384;
        bool sb[2], need[2]; int relb[2];
#pragma unroll
        for (int nt = 0; nt < 2; ++nt) {
            const unsigned w = j < 32 ? selw[nt][0] : j < 64 ? selw[nt][1] : j < 96 ? selw[nt][2] : selw[nt][3];
            sb[nt] = (w >> (j & 31)) & 1u; need[nt] = __ballot(sb[nt]) != 0ull; relb[nt] = t[nt] - 64 * j - 4 * fq;
        }
        if (VAR == 1) { need[0] = false; need[1] = false; }
        if (VAR == 2) { if (!(need[0] || need[1])) { need[0] = false; } else { need[0] = true; need[1] = true; } }
        if (need[0] || need[1]) {
            const int rmin = q0 - 64 * j - 63, rmax = q0 + 31 - 64 * j;
            bool fast = false; int th = 0; float blo = 0.f, bhi = 0.f;
            if (rmin >= 16) {
                const int b0 = bucketL[rmin], b1 = bucketL[rmax > 8191 ? 8191 : rmax];
                if (b1 - b0 <= 1) { fast = true; th = t5_first(b1); if (b1 == b0) th = 0;
                    blo = ((const float*)(lds + SEL_BIAS2))[hl * 32 + b0]; bhi = ((const float*)(lds + SEL_BIAS2))[hl * 32 + b1]; }
            }
            if (fast) sel_tile<true>(cu, cu + 8192, lds, Qf, O, m, l, sb, need, relb, th, blo, bhi, hl, fr, fq);
            else sel_tile<false>(cu, cu + 8192, lds, Qf, O, m, l, sb, need, relb, th, blo, bhi, hl, fr, fq);
        }
      }
    }
#undef SEL_ISSUE
    __syncthreads();
#pragma unroll
    for (int nt = 0; nt < 2; ++nt) {
        const float gt = bf2f(P[tok[nt] * LD + C_GA + (4 * g + hl) * 3 + 1]) * (l[nt] > 0.f ? 1.f / l[nt] : 0.f);
        const size_t o = tok[nt] * 512 + (4 * g + hl) * 64;
#pragma unroll
        for (int mt = 0; mt < 4; ++mt) {
            const f32x4 yc = unpack4(*(const u32x2*)((const bf16_t*)(ws + WS_YC) + o + 16 * mt + 4 * fq));
            const f32x4 yw = unpack4(*(const u32x2*)((const bf16_t*)(ws + WS_YW) + o + 16 * mt + 4 * fq));
            if (VAR == 0 || VAR == 3) *(u32x2*)((bf16_t*)(ws + WS_YA) + tok[nt] * 1536 + (4 * g + hl) * 64 + 16 * mt + 4 * fq) = pack4(yc + yw + O[nt][mt] * gt);
            else asm volatile("" :: "v"(O[nt][mt]));
        }
    }
}

__device__ __forceinline__ void scan_item(const Params& p, int item, int half) {
    unsigned char* ws = launder(p.ws);
    const int idx = item * HT + (ltid() & 255);
    const int bh = idx >> 13, ed = idx & 8191, h = bh & 7;
    const float dec = exp2f(128.f * ret_lg2(h));
    const float* KVT = (const float*)(ws + WS_KVT) + (size_t)bh * 64 * 8192 + ed;
    bf16_t* SPT = (bf16_t*)(ws + WS_SPT) + (size_t)bh * 64 * 8192 + ed;
    float s = 0.f;
#pragma unroll
    for (int n0 = 0; n0 < 64; n0 += 32) {
        float kv[32];
#pragma unroll
        for (int n = 0; n < 32; ++n) kv[n] = KVT[(size_t)(n0 + n) * 8192];
#pragma unroll
        for (int n = 0; n < 32; ++n) { SPT[(size_t)(n0 + n) * 8192] = f2bf(s); s = s * dec + kv[n]; }
    }
}

__device__ __forceinline__ void phase_p3(const Params& p, unsigned char* lds, int half, int what) {
    for (int i = (ltid() & 255); i < 8192 / 16; i += HT) ((u32x4*)(lds + NSA_BUCKET))[i] = ((const u32x4*)(launder(p.ws) + WS_BUCKET))[i];
    __syncthreads();
    for (int h = (blockIdx.x * 2 + half); h < 512; h += (gridDim.x * 2)) {
        if (what & 1) cmp_item(p, h, lds, half);
        if (what & 2) {
            if (h >= 128 && h < 384) win_item(p, h - 128, lds, half);
            else if (h >= 384) { win_item(p, 256 + 2 * (h - 384) - ((h & 1) ? 1 : 0) , lds, half); win_item(p, 256 + 2 * (h - 384) + ((h & 1) ? 0 : 1) + 1 - ((h & 1) ? 0 : 0), lds, half); }
        }
        if (what & 4) scan_item(p, h, half);
    }
}

__device__ __forceinline__ void retout_item(const Params& p, int item, unsigned char* lds, int half) {
    unsigned char* ws = launder(p.ws);
    const int tid = (ltid() & 255), lane = tid & 63, wid = tid >> 6, fr = lane & 15, fq = lane >> 4;
    const int n = item & 63, h = (item >> 6) & 7, b = item >> 9;
    const size_t tok0 = (size_t)b * S_ + 128 * n;
    const bf16_t* P = (const bf16_t*)(ws + WS_P);
    unsigned char* vL = lds; unsigned char* kL = lds + 32768; unsigned char* sL = lds + 49152;
    __syncthreads();
    load_tile128w((const bf16_t*)(ws + WS_VRT) + ((size_t)(b * 8 + h) * 128) * S_ + 128 * n, S_, vL, wid, lane);
    load_tile128(P + tok0 * LD + C_KR + h * 64, LD, kL, wid, lane);
    load_tile128((const bf16_t*)(ws + WS_SPT) + ((size_t)(b * 8 + h) * 64 + n) * 8192, 64, sL, wid, lane);
    bf16x8 Qf[2][2];
#pragma unroll
    for (int nt = 0; nt < 2; ++nt)
#pragma unroll
        for (int ks = 0; ks < 2; ++ks) Qf[nt][ks] = *(const bf16x8*)(P + (tok0 + 32 * wid + 16 * nt + fr) * LD + C_QR + h * 64 + 32 * ks + 8 * fq);
    wait_vm0(); __syncthreads();
    const float lg2 = ret_lg2(h);
    f32x4 Y[8][2];
#pragma unroll
    for (int m = 0; m < 8; ++m)
#pragma unroll
        for (int nt = 0; nt < 2; ++nt) Y[m][nt] = (f32x4){0.f, 0.f, 0.f, 0.f};
#pragma unroll
    for (int m = 0; m < 8; ++m)
#pragma unroll
        for (int ks = 0; ks < 2; ++ks) {
            const bf16x8 a = lds_frag128(sL, 16 * m + fr, 4 * ks + fq);
#pragma unroll
            for (int nt = 0; nt < 2; ++nt) Y[m][nt] = mfma16(a, Qf[nt][ks], Y[m][nt]);
        }
#pragma unroll
    for (int nt = 0; nt < 2; ++nt) {
        const float sc = exp2f((float)(32 * wid + 16 * nt + fr + 1) * lg2);
#pragma unroll
        for (int m = 0; m < 8; ++m) Y[m][nt] = Y[m][nt] * sc;
    }
#pragma unroll 1
    for (int s = 0; s < 4; ++s) {
        f32x4 St[2][2];
#pragma unroll
        for (int hh = 0; hh < 2; ++hh) {
            const int mt = 2 * s + hh;
#pragma unroll
            for (int nt = 0; nt < 2; ++nt) St[hh][nt] = (f32x4){0.f, 0.f, 0.f, 0.f};
#pragma unroll
            for (int ks = 0; ks < 2; ++ks) {
                const bf16x8 a = lds_frag128(kL, 16 * mt + fr, 4 * ks + fq);
#pragma unroll
                for (int nt = 0; nt < 2; ++nt) St[hh][nt] = mfma16(a, Qf[nt][ks], St[hh][nt]);
            }
#pragma unroll
            for (int nt = 0; nt < 2; ++nt) {
                const int qi = 32 * wid + 16 * nt + fr;
#pragma unroll
                for (int r = 0; r < 4; ++r) {
                    const int kj = 16 * mt + 4 * fq + r;
                    const float dm = qi >= kj ? exp2f((float)(qi - kj) * lg2) : 0.f;
                    St[hh][nt][r] *= dm;
                }
            }
        }
        bf16x8 Pb[2];
#pragma unroll
        for (int nt = 0; nt < 2; ++nt) Pb[nt] = pack8(St[0][nt], St[1][nt]);
#pragma unroll
        for (int m = 0; m < 8; ++m) {
            const bf16x8 a = lds_vfrag256(vL, 16 * m + fr, 32 * s, fq);
#pragma unroll
            for (int nt = 0; nt < 2; ++nt) Y[m][nt] = mfma16(a, Pb[nt], Y[m][nt]);
        }
    }
    bf16_t* YB = (bf16_t*)(ws + WS_YA) + 512;
#pragma unroll
    for (int nt = 0; nt < 2; ++nt) {
        float sum = 0.f;
#pragma unroll
        for (int m = 0; m < 8; ++m) sum += Y[m][nt][0] + Y[m][nt][1] + Y[m][nt][2] + Y[m][nt][3];
        sum = rows_sum(sum);
        const float mu = sum * (1.f / 128.f);
        float vs = 0.f;
#pragma unroll
        for (int m = 0; m < 8; ++m)
#pragma unroll
            for (int r = 0; r < 4; ++r) { const float dlt = Y[m][nt][r] - mu; vs += dlt * dlt; }
        vs = rows_sum(vs);
        const float rstd = rsqrtf(vs * (1.f / 128.f) + 1e-5f);
        const size_t tk = tok0 + 32 * wid + 16 * nt + fr;
#pragma unroll
        for (int m = 0; m < 8; ++m) {
            const f32x4 gt = unpack4(*(const u32x2*)(P + tk * LD + C_GR + h * 128 + 16 * m + 4 * fq));
            f32x4 v;
#pragma unroll
            for (int r = 0; r < 4; ++r) v[r] = (Y[m][nt][r] - mu) * rstd * gt[r];
            *(u32x2*)(YB + tk * 1536 + h * 128 + 16 * m + 4 * fq) = pack4(v);
        }
    }
}
__device__ __forceinline__ void phase_p4_sel(const Params& p, unsigned char* lds) {
    for (int i = ltid(); i < 8192 / 16; i += NTHREADS) ((u32x4*)(lds + SEL_BUCKET))[i] = ((const u32x4*)(launder(p.ws) + WS_BUCKET))[i];
    __syncthreads();
    for (int it = blockIdx.x; it < 512; it += gridDim.x * 2) {
        sel_item<0>(p, it, lds);
        if (511 - it != it) sel_item<0>(p, 511 - it, lds);
    }
    __syncthreads();
}
__device__ __forceinline__ void phase_p4(const Params& p, unsigned char* lds, int half) {
    for (int it = (blockIdx.x * 2 + half); it < 1024; it += (gridDim.x * 2)) retout_item(p, it, lds, half);
}

struct RowOrder {     typedef pg8::Unit U; static constexpr bool GATHER = false;
    unsigned a, b; int K, xcd, slot, per;
    __device__ __forceinline__ bool next(int i, pg8::Unit& u) const { const int t = xcd * 32 + slot + i * per; if (t >= (xcd + 1) * 32) return false; u.pm = t >> 2; u.pn = t & 3; return true; }
    __device__ __forceinline__ void ptrs(const pg8::Unit& u, unsigned& A, unsigned& B) const { A = a + (unsigned)u.pm * 512u * (unsigned)K; B = b + (unsigned)u.pn * 512u * (unsigned)K; }
};
template <int MODE>
struct MixEpi {
    static constexpr int MID_T = MODE == 0 ? 8 : 0;
    unsigned char* ws; const float* X;
    __device__ __forceinline__ void mid(f32x4 (&acc)[2][2][4][2], const pg8::Unit& u, int wr, int wc, int fr, int fq) const {
#pragma unroll
        for (int ai = 0; ai < 2; ++ai) {
            __builtin_amdgcn_sched_barrier(0);
#pragma unroll
            for (int m = 0; m < 4; ++m) {
                const size_t tok = (size_t)(u.pm * 256 + 128 * ai + 64 * wr + 16 * m + fr + vzero());
#pragma unroll
                for (int bj = 0; bj < 2; ++bj) {
                    const int n = u.pn * 256 + 128 * bj + 32 * wc + 8 * fq;
                    const u32x4 ga = *(const u32x4*)((const bf16_t*)(ws + WS_P) + tok * LD + C_MA + n), gb = *(const u32x4*)((const bf16_t*)(ws + WS_P) + tok * LD + C_MB + n);
                    const f32x4 a0 = unpack4((u32x2){ga.x, ga.y}), a1 = unpack4((u32x2){ga.z, ga.w}), b0 = unpack4((u32x2){gb.x, gb.y}), b1 = unpack4((u32x2){gb.z, gb.w});
#pragma unroll
                    for (int r = 0; r < 4; ++r) { acc[ai][bj][m][0][r] *= a0[r] * __builtin_amdgcn_rcpf(fmaxf(b0[r], 1e-30f)); acc[ai][bj][m][1][r] *= a1[r] * __builtin_amdgcn_rcpf(fmaxf(b1[r], 1e-30f)); }
                }
            }
        }
        __builtin_amdgcn_sched_barrier(0);
    }
    __device__ __forceinline__ void operator()(const f32x4 (&acc)[2][2][4][2], const pg8::Unit& u, int wr, int wc, int fr, int fq) const {
#pragma unroll
        for (int ai = 0; ai < 2; ++ai)
#pragma unroll
            for (int m = 0; m < 4; ++m) {
                const size_t tok = (size_t)(u.pm * 256 + 128 * ai + 64 * wr + 16 * m + fr + vzero());
#pragma unroll
                for (int bj = 0; bj < 2; ++bj) {
                    const int n = u.pn * 256 + 128 * bj + 32 * wc + 8 * fq;
                    const f32x4 v0 = acc[ai][bj][m][0], v1 = acc[ai][bj][m][1];
                    if (MODE == 2) {
                        const u32x4 xw = *(const u32x4*)((const bf16_t*)(ws + WS_XB) + tok * 1024 + n);
                        const f32x4 h0 = unpack4((u32x2){xw.x, xw.y}) * DN_ALPHA + v0, h1 = unpack4((u32x2){xw.z, xw.w}) * DN_ALPHA + v1;
                        u32x4 w; w.x = pack2(h0[0], h0[1]); w.y = pack2(h0[2], h0[3]); w.z = pack2(h1[0], h1[1]); w.w = pack2(h1[2], h1[3]);
                        *(u32x4*)((bf16_t*)(ws + WS_H1) + tok * 1024 + n) = w;
                    } else {
                        const u32x4 gw = *(const u32x4*)((const bf16_t*)(ws + WS_P) + tok * LD + C_MB + n);
                        const f32x4 g0 = unpack4((u32x2){gw.x, gw.y}), g1 = unpack4((u32x2){gw.z, gw.w});
                        const f32x4 o0 = g0 * v0, o1 = g1 * v1;
                        u32x4 w; w.x = pack2(o0[0], o0[1]); w.y = pack2(o0[2], o0[3]); w.z = pack2(o1[0], o1[1]); w.w = pack2(o1[2], o1[3]);
                        *(u32x4*)((bf16_t*)(ws + WS_MG) + tok * 1024 + n) = w;
                    }
                }
            }
    }
};
__device__ __forceinline__ void phase_g2(const Params& p, unsigned char* lds) {
    unsigned char* ws = launder(p.ws);
    RowOrder S; S.xcd = blockIdx.x & 7; S.slot = blockIdx.x >> 3; S.per = gridDim.x >> 3;
    S.a = (unsigned)WS_YA; S.b = (unsigned)WS_WA; S.K = 1536; MixEpi<0> E; E.ws = ws; E.X = nullptr;
    pg8::gemm_phase<MixEpi<0>, RowOrder>(lds, 1536, S, E, ltid(), ws);
}
__device__ __forceinline__ void phase_g3(const Params& p, int layer, unsigned char* lds) {
    unsigned char* ws = launder(p.ws);
    RowOrder S; S.xcd = blockIdx.x & 7; S.slot = blockIdx.x >> 3; S.per = gridDim.x >> 3; S.a = (unsigned)WS_MG; S.b = (unsigned)WS_WO; S.K = 1024;
    MixEpi<2> E; E.ws = ws; E.X = nullptr;
    pg8::gemm_phase<MixEpi<2>, RowOrder>(lds, 1024, S, E, ltid(), ws);
}

__device__ __forceinline__ void phase_ln1(const Params& p, int layer, unsigned char* lds, bool dry, int half) {
    unsigned char* ws = launder(p.ws);
    const int tid = (ltid() & 255), lane = tid & 63, wid = tid >> 6;
    float* wrL = (float*)lds;
    float* lgL = (float*)(lds - half * HALF_LDS + 65536);
    {
        float4 wv[16];
#pragma unroll
        for (int k = 0; k < 16; ++k) wv[k] = ((const float4*)p.w_router)[tid + 256 * k];
#pragma unroll
        for (int k = 0; k < 16; ++k) { const int i4 = tid + 256 * k, d = i4 >> 2, e0 = (i4 & 3) * 4;
            wrL[(e0 + 0) * 1024 + d] = wv[k].x; wrL[(e0 + 1) * 1024 + d] = wv[k].y; wrL[(e0 + 2) * 1024 + d] = wv[k].z; wrL[(e0 + 3) * 1024 + d] = wv[k].w; }
    }
    __syncthreads();
    const bf16_t* H1 = (const bf16_t*)(ws + WS_H1);
    bf16_t* X1B = (bf16_t*)(ws + WS_X1B);
    const float* gam = p.ln1_g + layer * 1024; const float* bet = p.ln1_b + layer * 1024;
    unsigned* cnt = (unsigned*)(ws + WS_CTL) + (dry ? 0 : CW_CNT) + layer * 1024;
    int* LIST = (int*)(ws + (dry ? WS_HB : WS_LIST)); float* WTS = (float*)(ws + (dry ? WS_HB + 4194304 : WS_WTS));
    constexpr int U = 4;
    const int nwave = (gridDim.x * 2) * 4, wv = (blockIdx.x * 2 + half) * 4 + wid;
    const int nloc = ((T_ - wv * U + nwave * U - 1) / (nwave * U)) * (4 * U);
    u32x2 vn[U][4];
#pragma unroll
    for (int u = 0; u < U; ++u)
#pragma unroll
        for (int j = 0; j < 4; ++j) vn[u][j] = *(const u32x2*)(H1 + (size_t)(wv * U + u) * 1024 + 256 * j + 4 * lane);
    for (int t0 = wv * U; t0 < T_; t0 += nwave * U) {
        float4 y[U][4]; float s[U], q[U];
#pragma unroll
        for (int u = 0; u < U; ++u) {
            s[u] = 0.f;
#pragma unroll
            for (int j = 0; j < 4; ++j) { const f32x4 t = unpack4(vn[u][j]); y[u][j].x = t[0]; y[u][j].y = t[1]; y[u][j].z = t[2]; y[u][j].w = t[3]; s[u] += (t[0] + t[1]) + (t[2] + t[3]); }
        }
        { const int tn = t0 + nwave * U < T_ ? t0 + nwave * U : t0;
#pragma unroll
          for (int u = 0; u < U; ++u)
#pragma unroll
              for (int j = 0; j < 4; ++j) vn[u][j] = *(const u32x2*)(H1 + (size_t)(tn + u) * 1024 + 256 * j + 4 * lane); }
#pragma unroll
        for (int u = 0; u < U; ++u) s[u] = wave_sum(s[u]) * (1.f / 1024.f);
#pragma unroll
        for (int u = 0; u < U; ++u) {
            q[u] = 0.f;
#pragma unroll
            for (int j = 0; j < 4; ++j) { const float a = y[u][j].x - s[u], b2 = y[u][j].y - s[u], c = y[u][j].z - s[u], d = y[u][j].w - s[u]; q[u] += a * a + b2 * b2 + c * c + d * d; }
        }
#pragma unroll
        for (int u = 0; u < U; ++u) q[u] = rsqrtf(wave_sum(q[u]) * (1.f / 1024.f) + 1e-5f);
#pragma unroll
        for (int j = 0; j < 4; ++j) {
            const int d0 = 256 * j + 4 * lane;
            const float4 gg = *(const float4*)(gam + d0), bb = *(const float4*)(bet + d0);
#pragma unroll
            for (int u = 0; u < U; ++u) {
                y[u][j].x = (y[u][j].x - s[u]) * q[u] * gg.x + bb.x; y[u][j].y = (y[u][j].y - s[u]) * q[u] * gg.y + bb.y;
                y[u][j].z = (y[u][j].z - s[u]) * q[u] * gg.z + bb.z; y[u][j].w = (y[u][j].w - s[u]) * q[u] * gg.w + bb.w;
                u32x2 w; w.x = pack2(y[u][j].x, y[u][j].y); w.y = pack2(y[u][j].z, y[u][j].w);
                *(u32x2*)(X1B + (size_t)(t0 + u) * 1024 + d0) = w;
            }
        }
        float lg[U][16];
#pragma unroll
        for (int e = 0; e < 16; ++e) {
#pragma unroll
            for (int u = 0; u < U; ++u) lg[u][e] = 0.f;
#pragma unroll
            for (int j = 0; j < 4; ++j) { const float4 w4 = *(const float4*)(wrL + e * 1024 + 256 * j + 4 * lane);
#pragma unroll
                for (int u = 0; u < U; ++u) lg[u][e] += y[u][j].x * w4.x + y[u][j].y * w4.y + y[u][j].z * w4.z + y[u][j].w * w4.w; }
        }
        float myl = 0.f;
#pragma unroll
        for (int u = 0; u < U; ++u) {
            float w8[8], z4[4];
#pragma unroll
            for (int e = 0; e < 8; ++e) { const u32x2 r = __builtin_amdgcn_permlane32_swap(__float_as_uint(lg[u][e]), __float_as_uint(lg[u][e + 8]), false, false); w8[e] = __uint_as_float(r.x) + __uint_as_float(r.y); }
#pragma unroll
            for (int e = 0; e < 4; ++e) { const u32x2 r = __builtin_amdgcn_permlane16_swap(__float_as_uint(w8[e]), __float_as_uint(w8[e + 4]), false, false); z4[e] = __uint_as_float(r.x) + __uint_as_float(r.y); }
            const bool h8 = (lane & 8) != 0, h4 = (lane & 4) != 0;
            const float k0 = h8 ? z4[2] : z4[0], s0 = h8 ? z4[0] : z4[2], k1 = h8 ? z4[3] : z4[1], s1 = h8 ? z4[1] : z4[3];
            const float y0 = k0 + __int_as_float(__builtin_amdgcn_mov_dpp(__float_as_int(s0), 0x128, 0xF, 0xF, true));
            const float y1 = k1 + __int_as_float(__builtin_amdgcn_mov_dpp(__float_as_int(s1), 0x128, 0xF, 0xF, true));
            const float k2 = h4 ? y1 : y0, s2 = h4 ? y0 : y1;
            float x = k2 + __int_as_float(__builtin_amdgcn_mov_dpp(__float_as_int(s2), 0x141, 0xF, 0xF, true));
            x += __int_as_float(__builtin_amdgcn_mov_dpp(__float_as_int(x), 0xB1, 0xF, 0xF, true));
            x += __int_as_float(__builtin_amdgcn_mov_dpp(__float_as_int(x), 0x4E, 0xF, 0xF, true));
            if ((lane & 3) == u) myl = x;
        }
        static_assert(U == 4, "lane (l & 3) stores token u = l & 3");
        lgL[(half * nloc + ((t0 - wv * U) / (nwave * U)) * (4 * U) + wid * U + (lane & 3)) * 17 + (lane >> 2)] = myl;
    }
    __syncthreads();
    if (half == 0 && wid == 0)
    for (int l0 = 0; l0 < 2 * nloc; l0 += 64) {
        const int li = l0 + lane; const bool act = li < 2 * nloc;
        const int hq = li >= nloc ? 1 : 0, lh = li - hq * nloc;
        const int it = lh / (4 * U), wq = (lh / U) & 3, uq = lh % U, tok = act ? (((blockIdx.x * 2 + hq) * 4 + wq) * U + uq) + it * (nwave * U) : 0;
        float lgv[16];
#pragma unroll
        for (int e = 0; e < 16; ++e) lgv[e] = lgL[li * 17 + e];
        float mx = lgv[0];
#pragma unroll
        for (int e = 1; e < 16; ++e) mx = fmaxf(mx, lgv[e]);
        float pr[16], ps = 0.f;
#pragma unroll
        for (int e = 0; e < 16; ++e) { pr[e] = expf(lgv[e] - mx); ps += pr[e]; }
        const float ips = 1.f / ps;
        float sel[16];
#pragma unroll
        for (int e = 0; e < 16; ++e) { pr[e] *= ips; sel[e] = pr[e] + p.router_bias[e]; }
        int best = 0; float bestv = -1e30f;
#pragma unroll
        for (int gI = 0; gI < 4; ++gI) {
            float a = -1e30f, b2 = -1e30f;
#pragma unroll
            for (int k = 0; k < 4; ++k) { const float x = sel[4 * gI + k]; if (x > a) { b2 = a; a = x; } else if (x > b2) b2 = x; }
            const float gs = a + b2;
            if (gs > bestv) { bestv = gs; best = gI; }
        }
        float s4[4], p4[4];
#pragma unroll
        for (int k = 0; k < 4; ++k) { s4[k] = 0.f; p4[k] = 0.f; }
#pragma unroll
        for (int gI = 0; gI < 4; ++gI) if (gI == best) {
#pragma unroll
            for (int k = 0; k < 4; ++k) { s4[k] = sel[4 * gI + k]; p4[k] = pr[4 * gI + k]; }
        }
        int i0 = 0; float a0 = s4[0];
#pragma unroll
        for (int k = 1; k < 4; ++k) if (s4[k] > a0) { a0 = s4[k]; i0 = k; }
        int i1 = -1; float a1 = -1e30f;
#pragma unroll
        for (int k = 0; k < 4; ++k) if (k != i0 && s4[k] > a1) { a1 = s4[k]; i1 = k; }
        float w0 = 0.f, w1 = 0.f;
#pragma unroll
        for (int k = 0; k < 4; ++k) { if (k == i0) w0 = p4[k]; if (k == i1) w1 = p4[k]; }
        const float iw = 1.f / (w0 + w1);
        const int e0 = act ? best * 4 + i0 : -1, e1 = act ? best * 4 + i1 : -1;
        unsigned myc = 0, r0 = 0, r1 = 0;
#pragma unroll
        for (int e = 0; e < 16; ++e) {
            const unsigned long long m0 = __builtin_amdgcn_ballot_w64(e0 == e), m1 = __builtin_amdgcn_ballot_w64(e1 == e);
            const unsigned c0 = (unsigned)__builtin_popcountll(m0), c = c0 + (unsigned)__builtin_popcountll(m1);
            if (lane == e) myc = c;
            if (e0 == e) r0 = __builtin_amdgcn_mbcnt_hi((unsigned)(m0 >> 32), __builtin_amdgcn_mbcnt_lo((unsigned)m0, 0u));
            if (e1 == e) r1 = c0 + __builtin_amdgcn_mbcnt_hi((unsigned)(m1 >> 32), __builtin_amdgcn_mbcnt_lo((unsigned)m1, 0u));
        }
        unsigned mybase = 0;
        if (lane < 16 && myc != 0) mybase = atomicAdd(&cnt[lane * 64], myc);
        unsigned b0 = 0, b1 = 0;
#pragma unroll
        for (int e = 0; e < 16; ++e) { const unsigned be = (unsigned)__builtin_amdgcn_readlane((int)mybase, e); if (e0 == e) b0 = be; if (e1 == e) b1 = be; }
        if (act) {
            LIST[(size_t)e0 * T_ + b0 + r0] = tok * 2; LIST[(size_t)e1 * T_ + b1 + r1] = tok * 2 + 1;
            WTS[tok * 2] = w0 * iw; WTS[tok * 2 + 1] = w1 * iw;
        }
    }
}

struct MoeUnit { int e, rt, ct, cnt, off; };
struct MoeOrderBase {
    const unsigned* cntp; int t_lo, t_hi, slot, per;
    __device__ __forceinline__ void init(const unsigned* cnt) {
        cntp = cnt; int ntile = 0;
#pragma unroll
        for (int k = 0; k < NE; ++k) ntile += (__builtin_amdgcn_readfirstlane((int)cnt[k * 64]) >> 8) * 4;
        t_lo = (ntile * (int)(blockIdx.x & 7)) >> 3; t_hi = (ntile * (int)((blockIdx.x & 7) + 1)) >> 3; slot = blockIdx.x >> 3; per = gridDim.x >> 3;
    }
    __device__ __forceinline__ bool next(int i, MoeUnit& u) const {
        const int t = t_lo + slot + i * per; if (t >= t_hi) return false;
        int base = 0, off = 0; bool found = false;
#pragma unroll
        for (int k = 0; k < NE; ++k) {
            const int ck = __builtin_amdgcn_readfirstlane((int)cntp[k * 64]), nt = (ck >> 8) * 4;
            if (!found && t < base + nt) { found = true; u.e = k; u.cnt = ck; u.off = off; u.rt = (t - base) >> 2; u.ct = (t - base) & 3; }
            base += nt; off += ck;
        }
        return found;
    }
};
struct M2Order : MoeOrderBase {
    typedef MoeUnit U; static constexpr bool GATHER = true;
    const int* list;
    __device__ __forceinline__ void ptrs(const MoeUnit& u, unsigned& A, unsigned& B) const { A = (unsigned)WS_X1B; B = (unsigned)WS_WG + ((unsigned)u.e * 1024u + (unsigned)u.ct * 256u) * 2048u; }
    __device__ __forceinline__ void rows(const MoeUnit& u, int tid, unsigned (&v)[2]) const {
        v[0] = 0u; v[1] = 0u;
#pragma unroll
        for (int i = 0; i < 2; ++i) { int R, C; pg8::stage_rc((tid + vzero()) * 16 + i * 8192, R, C);
#pragma unroll
            for (int h = 0; h < 2; ++h) { int idx = u.rt * 256 + 128 * h + R; idx = idx < u.cnt ? idx : u.cnt - 1; const int a = (list + (size_t)u.e * T_)[idx]; v[h] |= (unsigned)(a >> 1) << (16 * i); } }
    }
};
struct M3Order : MoeOrderBase {
    typedef MoeUnit U; static constexpr bool GATHER = false;
    __device__ __forceinline__ void ptrs(const MoeUnit& u, unsigned& A, unsigned& B) const { A = (unsigned)WS_HB + ((unsigned)u.off + (unsigned)u.rt * 256u) * 1024u; B = (unsigned)WS_WD + ((unsigned)u.e * 1024u + (unsigned)u.ct * 256u) * 1024u; }
};
struct M2Epi {
    static constexpr int MID_T = 0;
    unsigned char* ws;
    __device__ __forceinline__ void operator()(const f32x4 (&acc)[2][2][4][2], const MoeUnit& u, int wr, int wc, int fr, int fq) const {
        bf16_t* HB = (bf16_t*)(ws + WS_HB);
#pragma unroll
        for (int ai = 0; ai < 2; ++ai)
#pragma unroll
            for (int m = 0; m < 4; ++m) {
                const int idx = u.rt * 256 + 128 * ai + 64 * wr + 16 * m + fr + vzero();
                if (idx < u.cnt) {
#pragma unroll
                    for (int bj = 0; bj < 2; ++bj) {
                        const int hcol = 4 * (32 * u.ct + 16 * bj + 4 * wc + fq);
                        const f32x4 gv = acc[ai][bj][m][0], uv = acc[ai][bj][m][1]; f32x4 hv;
#pragma unroll
                        for (int r = 0; r < 4; ++r) hv[r] = gv[r] * fsig(gv[r]) * uv[r];
                        *(u32x2*)(HB + (size_t)(u.off + idx) * 512 + hcol) = pack4(hv);
                    }
                }
            }
    }
};
struct M3Epi {
    static constexpr int MID_T = 0;
    unsigned char* ws; const int* list;
    __device__ __forceinline__ void operator()(const f32x4 (&acc)[2][2][4][2], const MoeUnit& u, int wr, int wc, int fr, int fq) const {
        bf16_t* CT = (bf16_t*)(ws + WS_CT);
#pragma unroll
        for (int ai = 0; ai < 2; ++ai)
#pragma unroll
            for (int m = 0; m < 4; ++m) {
                const int idx = u.rt * 256 + 128 * ai + 64 * wr + 16 * m + fr + vzero();
                if (idx < u.cnt) {
                    const int a = list[(size_t)u.e * T_ + idx];
#pragma unroll
                    for (int bj = 0; bj < 2; ++bj) {
                        const int n = u.ct * 256 + 128 * bj + 32 * wc + 8 * fq;
                        const f32x4 v0 = acc[ai][bj][m][0], v1 = acc[ai][bj][m][1];
                        u32x4 w; w.x = pack2(v0[0], v0[1]); w.y = pack2(v0[2], v0[3]); w.z = pack2(v1[0], v1[1]); w.w = pack2(v1[2], v1[3]);
                        *(u32x4*)(CT + (size_t)a * 1024 + n) = w;
                    }
                }
            }
    }
};
template <int MODE>
__device__ __forceinline__ void moe_rem_item(unsigned char* ws, const int* list, int e, int cnt, int off, int rh, int c64, unsigned char* lds) {
    constexpr int K = MODE == 0 ? 1024 : 512, NS = K / 64;
    const int tid = (ltid() & 255), lane = tid & 63, wid = tid >> 6, wr = wid >> 1, wc = wid & 1, fr = lane & 15, fq = lane >> 4;
    const int idx0 = (cnt & ~255) + 128 * rh;
    const int ldc = ((lane & 7) ^ (lane >> 3)) * 8;
    const bf16_t* ap[4];
#pragma unroll
    for (int i = 0; i < 4; ++i) {
        int idx = idx0 + 32 * i + 8 * wid + (lane >> 3); idx = idx < cnt ? idx : cnt - 1;
        if (MODE == 0) { const int a = list[(size_t)e * T_ + idx]; ap[i] = (const bf16_t*)(ws + WS_X1B) + (size_t)(a >> 1) * 1024 + ldc; }
        else ap[i] = (const bf16_t*)(ws + WS_HB) + (size_t)(off + idx) * 512 + ldc;
    }
    const bf16_t* bp[2];
#pragma unroll
    for (int i = 0; i < 2; ++i) {
        const int rho = 8 * (wid + 4 * i) + (lane >> 3), src = (rho & ~31) + pg8::perm32(rho & 31);
        bp[i] = (const bf16_t*)(ws + (MODE == 0 ? WS_WG : WS_WD)) + ((size_t)e * 1024 + 64 * c64 + src) * K + ldc;
    }
    f32x4 acc[4][2];
#pragma unroll
    for (int i = 0; i < 4; ++i)
#pragma unroll
        for (int j = 0; j < 2; ++j) acc[i][j] = (f32x4){0.f, 0.f, 0.f, 0.f};
    __syncthreads();
#define RSTAGE(buf, l) do { unsigned char* st_ = lds + (buf) * 24576; \
        _Pragma("unroll") for (int i = 0; i < 4; ++i) glds16(ap[i] + (l) * 64, st_ + (4 * i + wid) * 1024); \
        _Pragma("unroll") for (int i = 0; i < 2; ++i) glds16(bp[i] + (l) * 64, st_ + 16384 + (wid + 4 * i) * 1024); } while (0)
    RSTAGE(0, 0); RSTAGE(1, 1);
    for (int l = 0; l < NS; ++l) {
        const unsigned char* st = lds + (l % 3) * 24576;
        if (l + 1 < NS) WAIT_V(6); else WAIT_V(0);
        RAW_BARRIER();
        if (l + 2 < NS) RSTAGE((l + 2) % 3, l + 2);
#pragma unroll
        for (int ks = 0; ks < 2; ++ks) {
            bf16x8 a[4], bb[2];
#pragma unroll
            for (int i = 0; i < 4; ++i) a[i] = lds_frag128(st, 64 * wr + 16 * i + fr, 4 * ks + fq);
#pragma unroll
            for (int j = 0; j < 2; ++j) bb[j] = lds_frag128(st + 16384, 32 * wc + 16 * j + fr, 4 * ks + fq);
#pragma unroll
            for (int i = 0; i < 4; ++i)
#pragma unroll
                for (int j = 0; j < 2; ++j) acc[i][j] = mfma16(bb[j], a[i], acc[i][j]);
        }
    }
#undef RSTAGE
#pragma unroll
    for (int i = 0; i < 4; ++i) {
        const int idx = idx0 + 64 * wr + 16 * i + fr + vzero();
        if (idx < cnt) {
            if (MODE == 0) {
                f32x4 hv;
#pragma unroll
                for (int r = 0; r < 4; ++r) hv[r] = acc[i][0][r] * fsig(acc[i][0][r]) * acc[i][1][r];
                *(u32x2*)((bf16_t*)(ws + WS_HB) + (size_t)(off + idx) * 512 + 32 * c64 + 16 * wc + 4 * fq) = pack4(hv);
            } else {
                const int a = list[(size_t)e * T_ + idx];
                const f32x4 v0 = acc[i][0], v1 = acc[i][1];
                u32x4 w; w.x = pack2(v0[0], v0[1]); w.y = pack2(v0[2], v0[3]); w.z = pack2(v1[0], v1[1]); w.w = pack2(v1[2], v1[3]);
                *(u32x4*)((bf16_t*)(ws + WS_CT) + (size_t)a * 1024 + 64 * c64 + 32 * wc + 8 * fq) = w;
            }
        }
    }
    __syncthreads();
}
template <int MODE>
__device__ __forceinline__ void moe_rem(const unsigned* cntp, unsigned char* ws, const int* list, unsigned char* ldsh, int half) {
    for (int t = blockIdx.x * 2 + half; ; t += gridDim.x * 2) {
        int base = 0, off = 0, e = -1, cnt = 0, eoff = 0, loc = 0;
#pragma unroll
        for (int k = 0; k < NE; ++k) {
            const int ck = __builtin_amdgcn_readfirstlane((int)cntp[k * 64]), ni = (((ck & 255) + 127) >> 7) * 16;
            if (e < 0 && t < base + ni) { e = k; cnt = ck; eoff = off; loc = t - base; }
            base += ni; off += ck;
        }
        if (e < 0) break;
        moe_rem_item<MODE>(ws, list, e, cnt, eoff, loc >> 4, loc & 15, ldsh);
    }
}
__device__ __forceinline__ void phase_m2(const Params& p, int layer, unsigned char* lds, unsigned char* ldsh, int half) {
    unsigned char* ws = launder(p.ws);
    M2Order S; S.init((const unsigned*)(ws + WS_CTL) + CW_CNT + layer * 1024 + vzero());
    S.list = (const int*)(ws + WS_LIST);
    M2Epi E; E.ws = ws;
    pg8::gemm_phase<M2Epi, M2Order>(lds, 1024, S, E, ltid(), ws);
    moe_rem<0>(S.cntp, ws, S.list, ldsh, half);
}
__device__ __forceinline__ void phase_m3(const Params& p, int layer, unsigned char* lds, unsigned char* ldsh, int half) {
    unsigned char* ws = launder(p.ws);
    M3Order S; S.init((const unsigned*)(ws + WS_CTL) + CW_CNT + layer * 1024 + vzero());
    M3Epi E; E.ws = ws; E.list = (const int*)(ws + WS_LIST);
    pg8::gemm_phase<M3Epi, M3Order>(lds, 512, S, E, ltid(), ws);
    moe_rem<1>(S.cntp, ws, E.list, ldsh, half);
}

__device__ __forceinline__ void phase_ln2(const Params& p, int layer, int half) {
    unsigned char* ws = launder(p.ws);
    const int tid = (ltid() & 255), lane = tid & 63, wid = tid >> 6;
    const bf16_t* X1 = (const bf16_t*)(ws + WS_X1B); const bf16_t* CT = (const bf16_t*)(ws + WS_CT); const float* WTS = (const float*)(ws + WS_WTS);
    float* XO = p.out; bf16_t* XB = (bf16_t*)(ws + WS_XB); const bool fin = layer == NLAYER - 1;
    const float* gam = p.ln2_g + layer * 1024; const float* bet = p.ln2_b + layer * 1024;
    constexpr int U = 4;
    const int nwave = (gridDim.x * 2) * 4, wv = (blockIdx.x * 2 + half) * 4 + wid;
    for (int t0 = wv * U; t0 < T_; t0 += nwave * U) {
        float4 v[U][4]; float s[U], q[U];
#pragma unroll
        for (int u = 0; u < U; ++u) {
            const int tok = t0 + u;
            const float w0 = WTS[tok * 2 + vzero()], w1 = WTS[tok * 2 + 1 + vzero()];
            s[u] = 0.f; q[u] = 0.f;
#pragma unroll
            for (int j = 0; j < 4; ++j) {
                const int d0 = 256 * j + 4 * lane;
                const f32x4 xt = unpack4(*(const u32x2*)(X1 + (size_t)tok * 1024 + d0)); float4 xv; xv.x = xt[0]; xv.y = xt[1]; xv.z = xt[2]; xv.w = xt[3];
                const f32x4 c0 = unpack4(*(const u32x2*)(CT + (size_t)(tok * 2) * 1024 + d0)), c1 = unpack4(*(const u32x2*)(CT + (size_t)(tok * 2 + 1) * 1024 + d0));
                v[u][j].x = xv.x * DN_ALPHA + w0 * c0[0] + w1 * c1[0]; v[u][j].y = xv.y * DN_ALPHA + w0 * c0[1] + w1 * c1[1];
                v[u][j].z = xv.z * DN_ALPHA + w0 * c0[2] + w1 * c1[2]; v[u][j].w = xv.w * DN_ALPHA + w0 * c0[3] + w1 * c1[3];
                s[u] += v[u][j].x + v[u][j].y + v[u][j].z + v[u][j].w;
                q[u] += v[u][j].x * v[u][j].x + v[u][j].y * v[u][j].y + v[u][j].z * v[u][j].z + v[u][j].w * v[u][j].w;
            }
        }
#pragma unroll
        for (int u = 0; u < U; ++u) { s[u] = wave_sum(s[u]); q[u] = wave_sum(q[u]); }
#pragma unroll
        for (int j = 0; j < 4; ++j) {
            const int d0 = 256 * j + 4 * lane;
            const float4 gg = *(const float4*)(gam + d0), bb = *(const float4*)(bet + d0);
#pragma unroll
            for (int u = 0; u < U; ++u) {
                const int tok = t0 + u;
                const float mu = s[u] * (1.f / 1024.f), var = fmaxf(q[u] * (1.f / 1024.f) - mu * mu, 0.f), rstd = rsqrtf(var + 1e-5f);
                float4 y; y.x = (v[u][j].x - mu) * rstd * gg.x + bb.x; y.y = (v[u][j].y - mu) * rstd * gg.y + bb.y; y.z = (v[u][j].z - mu) * rstd * gg.z + bb.z; y.w = (v[u][j].w - mu) * rstd * gg.w + bb.w;
                if (fin) *(float4*)(XO + (size_t)tok * 1024 + d0) = y;
                else { u32x2 w; w.x = pack2(y.x, y.y); w.y = pack2(y.z, y.w); *(u32x2*)(XB + (size_t)tok * 1024 + d0) = w; }
            }
        }
    }
}

#define XB_TMO      128
#define XB_XCNT(j)  (256  + 64 * (j))
#define XB_XSUB(j)  (1280 + 64 * (j))
#define XB_XGEN(j)  (2304 + 64 * (j))
#define XB_TOP      3328
#define XB_TOPGEN   3392
#define XCD_BAR_WORDS 3456
#define XB_SPIN_CAP (1u << 22)
#define LAS __attribute__((address_space(3)))
__device__ __forceinline__ unsigned xb_ld(unsigned* p)              { return __hip_atomic_load(p, __ATOMIC_RELAXED, __HIP_MEMORY_SCOPE_AGENT); }
__device__ __forceinline__ unsigned xb_add(unsigned* p, unsigned v) { return __hip_atomic_fetch_add(p, v, __ATOMIC_RELAXED, __HIP_MEMORY_SCOPE_AGENT); }
__device__ __forceinline__ unsigned xb_xcc_id() { return (unsigned)__builtin_amdgcn_s_getreg((3 << 11) | 20) & 0xFu; }
#define XB_SPIN(cond, bar) do { unsigned _sp = 0; while (cond) { __builtin_amdgcn_s_sleep(1); \
    if ((++_sp & 255u) == 0u) { if (xb_ld(&(bar)[XB_TMO])) break; if (_sp > XB_SPIN_CAP) { atomicAdd(&(bar)[XB_TMO], 1u); break; } } } } while (0)
struct XcdBarrier { unsigned* bar; unsigned x; volatile LAS unsigned* st; };
__device__ __forceinline__ XcdBarrier xcd_barrier_post(unsigned* bar, volatile LAS unsigned* st) {
    XcdBarrier b; b.bar = bar; b.x = xb_xcc_id(); b.st = st;
    if (threadIdx.x == 0) (void)xb_add(&bar[XB_XCNT(b.x)], 1u);
    return b;
}
__device__ __forceinline__ void xcd_barrier_complete(unsigned* bar, unsigned x, unsigned& nloc, unsigned& nx) {
    const unsigned G = gridDim.x * gridDim.y * gridDim.z;
    unsigned sum, cnt, mine, sp = 0u;
    for (;;) {
        sum = 0u; cnt = 0u; mine = 0u;
#pragma unroll
        for (unsigned j = 0; j < 16; ++j) { const unsigned c = xb_ld(&bar[XB_XCNT(j)]); sum += c; cnt += (c > 0u) ? 1u : 0u; mine = (j == x) ? c : mine; }
        if (sum == G) break;
        __builtin_amdgcn_s_sleep(1);
        if ((++sp & 255u) == 0u) { if (xb_ld(&bar[XB_TMO])) break; if (sp > XB_SPIN_CAP) { atomicAdd(&bar[XB_TMO], 1u); break; } }
    }
    nloc = mine > 0u ? mine : 1u; nx = cnt > 0u ? cnt : 1u;
}
__device__ __forceinline__ void xcd_barrier(const XcdBarrier& b) {
    asm volatile("s_waitcnt vmcnt(0)" ::: "memory");
    __syncthreads();
    if (threadIdx.x == 0) {
        unsigned* bar = b.bar;
        __builtin_amdgcn_s_waitcnt(0);
        unsigned nloc = b.st[0], nx = b.st[1];
        if (nloc == 0u) { xcd_barrier_complete(bar, b.x, nloc, nx); b.st[0] = nloc; b.st[1] = nx; }
        const unsigned old = xb_add(&bar[XB_XSUB(b.x)], 1u);
        const unsigned gen = old / nloc;
        if (old + 1u == (gen + 1u) * nloc) {
            __builtin_amdgcn_fence(__ATOMIC_RELEASE, "agent");
            asm volatile("s_waitcnt vmcnt(0)" ::: "memory");
            const unsigned og = xb_add(&bar[XB_TOP], 1u);
            const unsigned tg = og / nx;
            if (og + 1u == (tg + 1u) * nx) xb_add(&bar[XB_TOPGEN], 1u);
            else XB_SPIN(xb_ld(&bar[XB_TOPGEN]) == tg, bar);
            __builtin_amdgcn_fence(__ATOMIC_ACQUIRE, "agent");
            xb_add(&bar[XB_XGEN(b.x)], 1u);
            asm volatile("s_waitcnt vmcnt(0)" ::: "memory");
        } else {
            XB_SPIN(xb_ld(&bar[XB_XGEN(b.x)]) == gen, bar);
            __builtin_amdgcn_fence(__ATOMIC_ACQUIRE, "agent");
            asm volatile("s_waitcnt vmcnt(0)" ::: "memory");
        }
    }
    __syncthreads();
}

constexpr int PH_PER_LAYER = 11, N_PHASES = PH_PER_LAYER * NLAYER;
__global__ void __launch_bounds__(NTHREADS, 2) mega(Params p) {
    extern __shared__ __attribute__((aligned(16))) unsigned char lds[];
#if SINGLE_LAUNCH
    volatile LAS unsigned* xbw = (volatile LAS unsigned*)(lds + LDS_BYTES - 16);
    if (threadIdx.x < 4) xbw[threadIdx.x] = 0u;
    __syncthreads();
    XcdBarrier xbar = xcd_barrier_post((unsigned*)(p.ws + WS_CTL) + CW_BAR, xbw);
#endif
    const int half = __builtin_amdgcn_readfirstlane((int)(threadIdx.x >> 8));
    unsigned char* ldsh = lds + half * HALF_LDS;
    bool second = false;
    for (int ph = p.ph_lo; ph < p.ph_hi; ++ph) {
        const int layer = ph / PH_PER_LAYER, k = ph % PH_PER_LAYER;
        if (k == 0 && layer > 0) continue;
#ifdef ONLY_PHASE
        if (k != ONLY_PHASE) continue;
#endif
        switch (k) {
            case 0: phase_pw(p, layer, ldsh, 1 | 16 | 8, half); break;
            case 1: phase_g1(p, layer, lds); if (!second) { __syncthreads(); phase_pw(p, layer, ldsh, 4, half, 0, 1); } break;
            case 2: phase_p2(p, layer, ldsh, half); if (!second && layer + 1 < NLAYER) { __syncthreads(); phase_pw(p, layer + 1, ldsh, 1, half, 64); } break;
            case 3: phase_p3(p, ldsh, half, second ? ((p.rep_mask >> 16) & 7) : 7); if (!second) { __syncthreads(); phase_pw(p, layer, ldsh, 4, half, 0, 3); }
                    if (!second && layer + 1 < NLAYER) { __syncthreads(); phase_pw(p, layer + 1, ldsh, 16, half); }
                    if (!second && layer == 0) { __syncthreads(); phase_pw(p, 0, ldsh, 2, half); } break;
            case 4: { const int sub = second ? ((p.rep_mask >> 12) & 7) : 7;
                    if (sub & 1) phase_p4_sel(p, lds);
                    if ((sub & 4) && half == 0) { phase_pw(p, layer, ldsh, 4, half, 0, 2); __syncthreads(); }
                    if (sub & 2) phase_p4(p, ldsh, half);
                    if ((sub & 4) && half == 1) { __syncthreads(); phase_pw(p, layer, ldsh, 4, half, 0, 2); } } break;
            case 5: phase_g2(p, lds); break;
            case 6: phase_g3(p, layer, lds); break;
            case 7: phase_ln1(p, layer, ldsh, ((p.rep_mask >> 7) & 1) && !second, half); if (!second && layer + 1 < NLAYER) { __syncthreads(); phase_pw(p, layer + 1, ldsh, 2, half); } break;
            case 8: phase_m2(p, layer, lds, ldsh, half); break;
            case 9: phase_m3(p, layer, lds, ldsh, half); break;
            case 10: phase_ln2(p, layer, half); break;
        }

        if (ph + 1 < p.ph_hi) { if (ph == p.ph_lo && !second) cg::this_grid().sync(); else xcd_barrier(xbar); }
        if (((p.rep_mask >> k) & 1) && !second) { second = true; --ph; } else second = false;
    }
}

extern "C" void kernel_launch(void* const* d_in, const int* in_sizes, int n_in, void* d_out, int out_size, void* d_ws, size_t ws_size, hipStream_t stream) {
    static int grid = 0;
    if (grid == 0) {
        if (n_in != 18 || ws_size < WS_END) { fprintf(stderr, "kernel_launch: unexpected n_in %d or ws_size %zu < %zu\n", n_in, ws_size, (size_t)WS_END); grid = -1; return; }
        int dev = 0, cus = 0, per_cu = 0;
        hipGetDevice(&dev); hipDeviceGetAttribute(&cus, hipDeviceAttributeMultiprocessorCount, dev);
        hipFuncSetAttribute((const void*)mega, hipFuncAttributeMaxDynamicSharedMemorySize, LDS_BYTES);
        hipOccupancyMaxActiveBlocksPerMultiprocessor(&per_cu, (const void*)mega, NTHREADS, LDS_BYTES);
        if (per_cu < 1) per_cu = 1;
        if (per_cu > 1) per_cu = 1;
        grid = cus * per_cu;
        (void)hipGetLastError();
    }
    if (grid < 0) return;
    Params p{};
    p.x = (const float*)d_in[0]; p.w_in = (const float*)d_in[1]; p.cmp_pos = (const float*)d_in[2]; p.cmp_w1 = (const float*)d_in[3]; p.cmp_w2 = (const float*)d_in[4];
    p.w_br_a = (const float*)d_in[5]; p.w_br_b = (const float*)d_in[6]; p.w_o = (const float*)d_in[7]; p.ln1_g = (const float*)d_in[8]; p.ln1_b = (const float*)d_in[9];
    p.w_router = (const float*)d_in[10]; p.router_bias = (const float*)d_in[11]; p.w_gate = (const float*)d_in[12]; p.w_up = (const float*)d_in[13]; p.w_down = (const float*)d_in[14];
    p.ln2_g = (const float*)d_in[15]; p.ln2_b = (const float*)d_in[16]; p.rel_bias = (const float*)d_in[17];
    p.out = (float*)d_out; p.ws = (unsigned char*)d_ws; p.rep_mask = REPEAT_MASK;
#if SINGLE_LAUNCH
    hipMemsetAsync((unsigned char*)d_ws + WS_CTL + (size_t)CW_BAR * 4, 0, XCD_BAR_WORDS * 4, stream);
    p.ph_lo = 0; p.ph_hi = N_PHASES;
    void* args[] = {&p};
    hipError_t e = hipLaunchCooperativeKernel((const void*)mega, dim3(grid), dim3(NTHREADS), args, LDS_BYTES, stream);
    if (e != hipSuccess) fprintf(stderr, "cooperative launch failed: %s (grid %d)\n", hipGetErrorString(e), grid);
#else
    for (int ph = 0; ph < N_PHASES; ++ph) {
        p.ph_lo = ph; p.ph_hi = ph + 1;
        hipLaunchKernelGGL(mega, dim3(grid), dim3(NTHREADS), LDS_BYTES, stream, p);
    }
#endif
}
```

```cpp
#include <hip/hip_runtime.h>
#include <hip/hip_cooperative_groups.h>
#include <cstdio>
#include <cstdint>
namespace cg = cooperative_groups;

#ifndef REPEAT_MASK
#define REPEAT_MASK 0
#endif
#ifndef SINGLE_LAUNCH
#define SINGLE_LAUNCH 1
#endif

typedef unsigned short bf16_t;
typedef short bf16x8 __attribute__((ext_vector_type(8)));
typedef float f32x4 __attribute__((ext_vector_type(4)));
typedef unsigned u32x2 __attribute__((ext_vector_type(2)));
typedef unsigned u32x4 __attribute__((ext_vector_type(4)));

constexpr int B_ = 2, S_ = 8192, D_ = 1024, T_ = B_ * S_, NLAYER = 4;
constexpr int DIN = 6424;
constexpr int LD = 5376;
constexpr int NW = 6656;
constexpr int C_QA = 0, C_KC = 512, C_VC = 640, C_KS = 768, C_KW = 896, C_QR = 1024, C_KR = 1536, C_GR = 2048, C_MA = 3072, C_MB = 4096, C_GA = 5120,
              C_VS = 5376, C_VW = 5504, C_VR = 5632;
constexpr float DN_ALPHA = 1.681792830507429f;
constexpr int NE = 16;

constexpr size_t al256(size_t x) { return (x + 255) & ~(size_t)255; }
constexpr size_t WS_CTL = 0;
constexpr size_t WS_BUCKET = 65536;
constexpr size_t WS_ROPE = WS_BUCKET + 8192;
constexpr size_t WS_WIN = WS_ROPE + (size_t)8192 * 32 * 8;
constexpr size_t WS_WA = WS_WIN + (size_t)NW * 1024 * 2;
constexpr size_t WS_WB = WS_WA + (size_t)1024 * 512 * 2;
constexpr size_t WS_WO = WS_WB + (size_t)1024 * 1024 * 2;
constexpr size_t WS_WG = WS_WO + (size_t)1024 * 1024 * 2;
constexpr size_t WS_WU = WS_WG + (size_t)16 * 512 * 1024 * 2;
constexpr size_t WS_WD = WS_WU + (size_t)16 * 512 * 1024 * 2;
constexpr size_t WS_XB = WS_WD + (size_t)16 * 512 * 1024 * 2;
constexpr size_t WS_X = WS_XB + (size_t)T_ * 1024 * 2;
constexpr size_t WS_MG = WS_X + (size_t)T_ * 1024 * 4;
constexpr size_t WS_KCC = WS_MG + (size_t)T_ * 1024 * 2;
constexpr size_t WS_VCCT = WS_KCC + (size_t)4 * 512 * 64 * 2;
constexpr size_t WS_W1T = WS_VCCT + (size_t)4 * 512 * 64 * 2;
constexpr size_t WS_B1 = WS_W1T + (size_t)2 * 64 * 2048 * 2;
constexpr size_t WS_R = WS_B1 + 1024;
constexpr size_t WS_P = WS_R;
constexpr size_t WS_VST = WS_P + (size_t)T_ * LD * 2;
constexpr size_t WS_VWT = WS_VST + (size_t)4 * 64 * S_ * 2;
constexpr size_t WS_VRT = WS_VWT + (size_t)4 * 64 * S_ * 2;
constexpr size_t WS_KVT = WS_VRT + (size_t)16 * 128 * S_ * 2;
constexpr size_t WS_SPT = WS_KVT + (size_t)16 * 64 * 8192 * 4;
constexpr size_t WS_YC = WS_SPT + (size_t)16 * 64 * 8192 * 2;
constexpr size_t WS_YW = WS_YC + (size_t)T_ * 512 * 2;
constexpr size_t WS_YA = WS_YW + (size_t)T_ * 512 * 2;
constexpr size_t WS_YB = WS_YA + (size_t)T_ * 512 * 2;
constexpr size_t WS_SELW = WS_YB + (size_t)T_ * 1024 * 2;
constexpr size_t WS_ENDA = WS_SELW + (size_t)T_ * 2 * 4 * 4;
constexpr size_t WS_H1 = WS_R;
constexpr size_t WS_X1 = WS_H1 + (size_t)T_ * 1024 * 4;
constexpr size_t WS_X1B = WS_X1 + (size_t)T_ * 1024 * 4;
constexpr size_t WS_HB = WS_X1B + (size_t)T_ * 1024 * 2;
constexpr size_t WS_CT = WS_HB + (size_t)2 * T_ * 512 * 2;
constexpr size_t WS_LIST = WS_CT + (size_t)2 * T_ * 1024 * 2;
constexpr size_t WS_WTS = WS_LIST + (size_t)16 * T_ * 4;
constexpr size_t WS_ENDB = WS_WTS + (size_t)2 * T_ * 4;
static_assert(WS_HB + (size_t)2 * T_ * 512 * 2 <= WS_CT, "view B overlap");
constexpr size_t WS_END = WS_ENDA > WS_ENDB ? WS_ENDA : WS_ENDB;

constexpr int CW_CNT = 4096;
constexpr int CW_BAR = 8192;
constexpr int CW_B1P = 12288;

constexpr int HALF_LDS = 75776, LDS_BYTES = 2 * HALF_LDS + 16;
constexpr int NTHREADS = 512, HT = 256;

struct Params {
    const float* x; const float* w_in; const float* cmp_pos; const float* cmp_w1; const float* cmp_w2;
    const float* w_br_a; const float* w_br_b; const float* w_o; const float* ln1_g; const float* ln1_b;
    const float* w_router; const float* router_bias; const float* w_gate; const float* w_up; const float* w_down;
    const float* ln2_g; const float* ln2_b; const float* rel_bias;
    float* out; unsigned char* ws;
    int ph_lo, ph_hi, rep_mask, pad_;
};

__device__ __forceinline__ bf16_t f2bf(float f) { unsigned u = __float_as_uint(f); u += 0x7fffu + ((u >> 16) & 1u); return (bf16_t)(u >> 16); }
__device__ __forceinline__ float bf2f(unsigned h) { return __uint_as_float(h << 16); }
typedef __bf16 bf16x2_t __attribute__((ext_vector_type(2)));
typedef float f32x2_t __attribute__((ext_vector_type(2)));
__device__ __forceinline__ unsigned pack2(float lo, float hi) { const f32x2_t f = {lo, hi}; return __builtin_bit_cast(unsigned, __builtin_convertvector(f, bf16x2_t)); }
__device__ __forceinline__ u32x2 pack4(f32x4 v) { u32x2 r; r.x = pack2(v[0], v[1]); r.y = pack2(v[2], v[3]); return r; }
__device__ __forceinline__ f32x4 unpack4(u32x2 u) { f32x4 r; r[0] = bf2f(u.x & 0xffffu); r[1] = bf2f(u.x >> 16); r[2] = bf2f(u.y & 0xffffu); r[3] = bf2f(u.y >> 16); return r; }
__device__ __forceinline__ float rows_max(float v) {
    u32x2 r = __builtin_amdgcn_permlane16_swap(__float_as_uint(v), __float_as_uint(v), false, false);
    v = fmaxf(__uint_as_float(r.x), __uint_as_float(r.y));
    r = __builtin_amdgcn_permlane32_swap(__float_as_uint(v), __float_as_uint(v), false, false);
    return fmaxf(__uint_as_float(r.x), __uint_as_float(r.y));
}
__device__ __forceinline__ float rows_sum(float v) {
    u32x2 r = __builtin_amdgcn_permlane16_swap(__float_as_uint(v), __float_as_uint(v), false, false);
    v = __uint_as_float(r.x) + __uint_as_float(r.y);
    r = __builtin_amdgcn_permlane32_swap(__float_as_uint(v), __float_as_uint(v), false, false);
    return __uint_as_float(r.x) + __uint_as_float(r.y);
}
__device__ __forceinline__ float wave_sum(float v) {
    v += __int_as_float(__builtin_amdgcn_mov_dpp(__float_as_int(v), 0xB1, 0xF, 0xF, true));
    v += __int_as_float(__builtin_amdgcn_mov_dpp(__float_as_int(v), 0x4E, 0xF, 0xF, true));
    v += __int_as_float(__builtin_amdgcn_mov_dpp(__float_as_int(v), 0x141, 0xF, 0xF, true));
    v += __int_as_float(__builtin_amdgcn_mov_dpp(__float_as_int(v), 0x140, 0xF, 0xF, true));
    return rows_sum(v);
}
__device__ __forceinline__ float sigmoidf_(float x) { return 1.f / (1.f + __expf(-x)); }
__device__ __forceinline__ int ltid() { int t = threadIdx.x; asm volatile("" : "+v"(t)); return t; }
__device__ __forceinline__ int vzero() { int z; asm volatile("v_mov_b32 %0, 0" : "=v"(z)); return z; }
__device__ __forceinline__ unsigned char* launder(unsigned char* q) { asm volatile("" : "+s"(q)); return q; }
__device__ __forceinline__ void wait_vm0() { asm volatile("s_waitcnt vmcnt(0)" ::: "memory"); }

__device__ __forceinline__ void glds16(const void* g, void* l) {
    __builtin_amdgcn_global_load_lds((const __attribute__((address_space(1))) unsigned*)g,
                                     (__attribute__((address_space(3))) unsigned*)l, 16, 0, 0);
}
__device__ __forceinline__ f32x4 mfma16(bf16x8 a, bf16x8 b, f32x4 c) { return __builtin_amdgcn_mfma_f32_16x16x32_bf16(a, b, c, 0, 0, 0); }

#define WAIT_V(n) asm volatile("s_waitcnt vmcnt(%0)" ::"n"(n) : "memory")
#define RAW_BARRIER() do { asm volatile("s_waitcnt lgkmcnt(0)" ::: "memory"); __builtin_amdgcn_s_barrier(); } while (0)
__device__ __forceinline__ void bglds16(__amdgpu_buffer_rsrc_t r, unsigned voff, int soff, void* l) {
    __builtin_amdgcn_raw_ptr_buffer_load_lds(r, (__attribute__((address_space(3))) void*)l, 16, (int)voff, soff, 0, 0);
}
template <int NJ, bool GN>
__device__ __forceinline__ void gemm8_stage(__amdgpu_buffer_rsrc_t mr, int mld, unsigned mvo, __amdgpu_buffer_rsrc_t nr, int nld, const unsigned (&nvo)[NJ], int kt, unsigned char* st, int wid) {
#pragma unroll
    for (int i = 0; i < 4; ++i) bglds16(mr, mvo, (64 * i * mld + kt * 64) * 2, st + (8 * i + wid) * 1024);
#pragma unroll
    for (int i = 0; i < NJ; ++i) bglds16(nr, nvo[i], ((GN ? 0 : 64 * i * nld) + kt * 64) * 2, st + 32768 + (8 * i + wid) * 1024);
}
template <int NJ, bool GN>
__device__ __forceinline__ void gemm8_kloop(const bf16_t* mb, int mld, unsigned mvo, const bf16_t* nb, int nld, const unsigned (&nvo)[NJ], int nk, unsigned char* lds, f32x4 (&acc)[8][NJ], int tid) {
    const int lane = tid & 63, wid = tid >> 6, wr = wid >> 2, wc = wid & 3, fr = lane & 15, fq = lane >> 4;
    const __amdgpu_buffer_rsrc_t mr = __builtin_amdgcn_make_buffer_rsrc((void*)mb, 0, 0x7fffffff, 0x00020000);
    const __amdgpu_buffer_rsrc_t nr = __builtin_amdgcn_make_buffer_rsrc((void*)nb, 0, 0x7fffffff, 0x00020000);
    gemm8_stage<NJ, GN>(mr, mld, mvo, nr, nld, nvo, 0, lds, wid);
    gemm8_stage<NJ, GN>(mr, mld, mvo, nr, nld, nvo, 1, lds + 65536, wid);
    for (int kt = 0; kt < nk; ++kt) {
        unsigned char* cur = lds + (kt & 1) * 65536;
        if (kt + 1 < nk) WAIT_V(4 + NJ); else WAIT_V(0);
        RAW_BARRIER();
        bf16x8 a[4], b[NJ];
        const unsigned char* ab = cur + (128 * wr + fr) * 128;
        const unsigned char* bb = cur + 32768 + (16 * NJ * wc + fr) * 128;
        const int sw0 = ((fq) ^ (fr & 7)) << 4, sw1 = ((4 + fq) ^ (fr & 7)) << 4;
#pragma unroll
        for (int j = 0; j < NJ; ++j) b[j] = *(const bf16x8*)(bb + j * 2048 + sw0);
#pragma unroll
        for (int mh = 0; mh < 2; ++mh) {
#pragma unroll
            for (int i = 0; i < 4; ++i) a[i] = *(const bf16x8*)(ab + (4 * mh + i) * 2048 + sw0);
#pragma unroll
            for (int i = 0; i < 4; ++i)
#pragma unroll
                for (int j = 0; j < NJ; ++j) acc[4 * mh + i][j] = mfma16(a[i], b[j], acc[4 * mh + i][j]);
        }
#pragma unroll
        for (int j = 0; j < NJ; ++j) b[j] = *(const bf16x8*)(bb + j * 2048 + sw1);
#pragma unroll
        for (int i = 0; i < 4; ++i) a[i] = *(const bf16x8*)(ab + i * 2048 + sw1);
#pragma unroll
        for (int i = 0; i < 4; ++i)
#pragma unroll
            for (int j = 0; j < NJ; ++j) acc[i][j] = mfma16(a[i], b[j], acc[i][j]);
#pragma unroll
        for (int i = 0; i < 4; ++i) a[i] = *(const bf16x8*)(ab + (4 + i) * 2048 + sw1);
        RAW_BARRIER();
        if (kt + 2 < nk) gemm8_stage<NJ, GN>(mr, mld, mvo, nr, nld, nvo, kt + 2, cur, wid);
#pragma unroll
        for (int i = 0; i < 4; ++i)
#pragma unroll
            for (int j = 0; j < NJ; ++j) acc[4 + i][j] = mfma16(a[i], b[j], acc[4 + i][j]);
    }
    __syncthreads();
    __builtin_amdgcn_sched_barrier(0);
}
template <int NJ>
__device__ __forceinline__ void zero_acc8(f32x4 (&acc)[8][NJ]) {
#pragma unroll
    for (int i = 0; i < 8; ++i)
#pragma unroll
        for (int j = 0; j < NJ; ++j) acc[i][j] = (f32x4){0.f, 0.f, 0.f, 0.f};
}

namespace pg8 {
#define PG8_LAS __attribute__((address_space(3)))
constexpr int BM = 256, BK = 64, HALF = 128, HTB = HALF * BK * 2, STAGE_BYTES = 8 * HTB;
__device__ __forceinline__ int lds_byte(int r, int c) { const int st = (r >> 4) * 2 + (c >> 5), rr = r & 15, cc = c & 31, ob = rr * 64 + cc * 2; return st * 1024 + (ob ^ (((ob >> 9) & 1) << 5)); }
__device__ __forceinline__ void stage_rc(int b, int& R, int& C) { const int st = b / 1024, sb = b % 1024, swz = sb ^ (((sb >> 9) & 1) << 5); R = (st >> 1) * 16 + swz / 64; C = (st & 1) * 32 + (swz % 64) / 2; }
__device__ __forceinline__ int perm32(int rho) { const int n = rho >> 4, i = rho & 15; return 8 * (i >> 2) + 4 * n + (i & 3); }
struct Unit { int pm, pn; };
template <class Epi, class Sched>
__device__ __forceinline__ void gemm_phase(unsigned char* lds_, const int K, const Sched& S, const Epi& E, const int tid, const unsigned char* wsbase) {
    PG8_LAS unsigned char* lds = (PG8_LAS unsigned char*)lds_;
    const int wid = __builtin_amdgcn_readfirstlane(tid >> 6), lane = tid & 63, wr = wid >> 2, wc = wid & 3, fr = lane & 15, fq = lane >> 4;
    const int nt = K / BK;
    unsigned voffA[2], voffB[2];
#pragma unroll
    for (int i = 0; i < 2; ++i) { int R, C; stage_rc(tid * 16 + i * 8192, R, C); const int Rb = (R & ~31) + perm32(R & 31);
        voffA[i] = (unsigned)(R * K + C) * 2u; voffB[i] = (unsigned)(Rb * K + C) * 2u; }
    const unsigned kstep = (unsigned)(BK * 2);
    const unsigned hstep = (unsigned)HALF * K * 2;
    const __amdgpu_buffer_rsrc_t rsrc = __builtin_amdgcn_make_buffer_rsrc((void*)wsbase, 0, 0x7fffffff, 0x00020000);
    const unsigned ldsw = (unsigned)wid * 1024u;
    const int aoff = lds_byte(wr * 64 + fr, fq * 8), boff = lds_byte(wc * 32 + fr, fq * 8);
#define PG8_SA(b, h) (((b) * 2 + (h)) * HTB)
#define PG8_SB(b, h) ((4 + (b) * 2 + (h)) * HTB)
#define PG8_STAGE(bufoff, gbase, voff) do { _Pragma("unroll") for (int _i = 0; _i < 2; ++_i) \
        __builtin_amdgcn_raw_ptr_buffer_load_lds(rsrc, (PG8_LAS void*)(lds + (bufoff) + ldsw + _i * 8192), 16, (int)(voff)[_i], (int)(gbase), 0, 0); } while (0)
#define PG8_LDA(dst, b, h) do { _Pragma("unroll") for (int m = 0; m < 4; ++m) _Pragma("unroll") for (int k = 0; k < 2; ++k) dst[m][k] = *(const PG8_LAS bf16x8*)(lds + PG8_SA(b, h) + aoff + m * 2048 + k * 1024); } while (0)
#define PG8_LDB(dst, b, h) do { _Pragma("unroll") for (int n = 0; n < 2; ++n) _Pragma("unroll") for (int k = 0; k < 2; ++k) dst[n][k] = *(const PG8_LAS bf16x8*)(lds + PG8_SB(b, h) + boff + n * 2048 + k * 1024); } while (0)
#define PG8_MMA(ai, bj, At, Bt) do { __builtin_amdgcn_s_setprio(1); _Pragma("unroll") for (int m = 0; m < 4; ++m) _Pragma("unroll") for (int n = 0; n < 2; ++n) _Pragma("unroll") for (int k = 0; k < 2; ++k) \
        acc[ai][bj][m][n] = __builtin_amdgcn_mfma_f32_16x16x32_bf16(Bt[n][k], At[m][k], acc[ai][bj][m][n], 0, 0, 0); __builtin_amdgcn_s_setprio(0); } while (0)
#define PG8_WAIT_V(n) asm volatile("s_waitcnt vmcnt(" #n ")" ::: "memory")
#define PG8_WAIT_L(n) asm volatile("s_waitcnt lgkmcnt(" #n ")" ::: "memory")
#define PG8_BAR __builtin_amdgcn_s_barrier()
#define PG8_SCHED __builtin_amdgcn_sched_barrier(0)
    typename Sched::U cur, nxt; int ui = 0;
    if (!S.next(0, cur)) return;
    unsigned cA, cB; S.ptrs(cur, cA, cB);
    constexpr bool GA = Sched::GATHER;
    unsigned vA[2], nvA[2];
    if constexpr (GA) { S.rows(cur, tid, vA); nvA[0] = vA[0]; nvA[1] = vA[1]; }
#define PG8_STAGE_G(bufoff, gbase, pk) do { const unsigned _cb = voffB[0] & (unsigned)(2 * K - 1); unsigned _vo[2] = {(((pk) & 0xffffu) * (unsigned)(2 * K)) + _cb, (((pk) >> 16) * (unsigned)(2 * K)) + _cb}; PG8_STAGE(bufoff, gbase, _vo); } while (0)
#define PG8_STAGE_A(bufoff, gbase, h, nextu) do { if constexpr (GA) { if (nextu) PG8_STAGE_G(bufoff, gbase, nvA[h]); else PG8_STAGE_G(bufoff, gbase, vA[h]); } \
        else PG8_STAGE(bufoff, (gbase) + (h) * hstep, voffA); } while (0)
    PG8_STAGE(PG8_SB(0, 0), cB, voffB); PG8_STAGE_A(PG8_SA(0, 0), cA, 0, false); PG8_STAGE(PG8_SB(0, 1), cB + hstep, voffB); PG8_STAGE_A(PG8_SA(0, 1), cA, 1, false);
    if (wr == 1) PG8_BAR;
    PG8_WAIT_V(4); PG8_BAR;
    PG8_STAGE(PG8_SB(1, 0), cB + kstep, voffB); PG8_STAGE_A(PG8_SA(1, 0), cA + kstep, 0, false); PG8_STAGE(PG8_SB(1, 1), cB + hstep + kstep, voffB);
    PG8_WAIT_V(6); PG8_BAR;
    PG8_SCHED;
    f32x4 acc[2][2][4][2];
#pragma unroll
    for (int a = 0; a < 2; ++a)
#pragma unroll
        for (int b = 0; b < 2; ++b)
#pragma unroll
            for (int m = 0; m < 4; ++m)
#pragma unroll
                for (int n = 0; n < 2; ++n) acc[a][b][m][n] = (f32x4){0.f, 0.f, 0.f, 0.f};
    bf16x8 At[4][2], B0[2][2], B1[2][2];
    for (;;) {
        const bool has_next = S.next(ui + 1, nxt);
        unsigned nA = cA, nB = cB; if (has_next) S.ptrs(nxt, nA, nB);
        if constexpr (GA) { if (has_next) S.rows(nxt, tid, nvA); }
        for (int t = 0; t < nt; t += 2) {
            if constexpr (Epi::MID_T > 0) { if (t == Epi::MID_T) E.mid(acc, cur, wr, wc, fr, fq); }
            const bool last = (t == nt - 2);
            const unsigned a1 = cA + (unsigned)(t + 1) * kstep;
            const unsigned a2 = last ? nA : cA + (unsigned)(t + 2) * kstep, b2 = last ? nB : cB + (unsigned)(t + 2) * kstep;
            const unsigned a3 = a2 + kstep, b3 = b2 + kstep;
            PG8_LDB(B0, 0, 0); PG8_SCHED; PG8_LDA(At, 0, 0); PG8_STAGE_A(PG8_SA(1, 1), a1, 1, false);
            PG8_WAIT_L(8); PG8_BAR; PG8_WAIT_L(0); PG8_MMA(0, 0, At, B0); PG8_BAR; PG8_SCHED;
            PG8_LDB(B1, 0, 1); PG8_STAGE(PG8_SB(0, 0), b2, voffB);
            PG8_BAR; PG8_WAIT_L(0); PG8_MMA(0, 1, At, B1); PG8_BAR;
            PG8_LDA(At, 0, 1); PG8_STAGE_A(PG8_SA(0, 0), a2, 0, last);
            PG8_BAR; PG8_WAIT_L(0); PG8_MMA(1, 0, At, B0); PG8_BAR; PG8_SCHED;
            PG8_STAGE(PG8_SB(0, 1), b2 + hstep, voffB);
            PG8_WAIT_V(6); PG8_BAR; PG8_MMA(1, 1, At, B1); PG8_BAR;
            PG8_LDB(B0, 1, 0); PG8_SCHED; PG8_LDA(At, 1, 0); PG8_STAGE_A(PG8_SA(0, 1), a2, 1, last);
            PG8_WAIT_L(8); PG8_BAR; PG8_WAIT_L(0); PG8_MMA(0, 0, At, B0); PG8_BAR; PG8_SCHED;
            PG8_LDB(B1, 1, 1); PG8_STAGE(PG8_SB(1, 0), b3, voffB);
            PG8_BAR; PG8_WAIT_L(0); PG8_MMA(0, 1, At, B1); PG8_BAR;
            PG8_LDA(At, 1, 1); PG8_STAGE_A(PG8_SA(1, 0), a3, 0, last);
            PG8_BAR; PG8_WAIT_L(0); PG8_MMA(1, 0, At, B0); PG8_BAR; PG8_SCHED;
            PG8_STAGE(PG8_SB(1, 1), b3 + hstep, voffB);
            PG8_WAIT_V(6); PG8_BAR; PG8_MMA(1, 1, At, B1); PG8_BAR;
        }
        E(acc, cur, wr, wc, fr, fq);
        if (!has_next) break;
#pragma unroll
        for (int a = 0; a < 2; ++a)
#pragma unroll
            for (int b = 0; b < 2; ++b)
#pragma unroll
                for (int m = 0; m < 4; ++m)
#pragma unroll
                    for (int n = 0; n < 2; ++n) acc[a][b][m][n] = (f32x4){0.f, 0.f, 0.f, 0.f};
        cur = nxt; cA = nA; cB = nB; ++ui;
        if constexpr (GA) { vA[0] = nvA[0]; vA[1] = nvA[1]; }
    }
    PG8_WAIT_V(0);
    if (wr == 0) PG8_BAR;
    PG8_BAR;
#undef PG8_SA
#undef PG8_SB
#undef PG8_STAGE
#undef PG8_STAGE_A
#undef PG8_STAGE_G
#undef PG8_LDA
#undef PG8_LDB
#undef PG8_MMA
#undef PG8_WAIT_V
#undef PG8_WAIT_L
#undef PG8_BAR
#undef PG8_SCHED
}
}

struct TJob { const float* src; bf16_t* dst; int ld, k0, n0, mode, kdst; };
__device__ __forceinline__ void tcvt_load(const TJob& J, float4 (&v)[4], int tid) {
#pragma unroll
    for (int i = 0; i < 4; ++i) {
        const int kk = (tid >> 4) + 16 * i, c4 = (tid & 15) * 4, cd = J.n0 + c4;
        int orig = cd; bool ok = true;
        if (J.mode == 1) {
            if (cd < 896) orig = cd;
            else if (cd < 1024) orig = cd - 896 + 1024;
            else if (cd < 2048) { const int q = cd - 1024, hd = q >> 6, pp = q & 63;
                const int d = (pp & 4) ? 32 + 4 * (pp >> 3) + (pp & 3) : 4 * (pp >> 3) + (pp & 3);
                orig = 1304 + hd * 64 + d; }
            else if (cd < 5120) orig = cd - 2048 + 3352;
            else if (cd < 5144) orig = cd - 5120 + 1280;
            else if (cd < 5376) ok = false;
            else if (cd < 5504) orig = cd - 5376 + 896;
            else if (cd < 5632) orig = cd - 5504 + 1152;
            else orig = cd - 5632 + 2328;
        }
        v[i] = make_float4(0.f, 0.f, 0.f, 0.f);
        if (ok) v[i] = *(const float4*)(J.src + (size_t)(J.k0 + kk) * J.ld + orig);
    }
}
__device__ __forceinline__ void tcvt_finish(const TJob& J, const float4 (&v)[4], unsigned char* lds, int tid) {
    float* tile = (float*)lds;
#pragma unroll
    for (int i = 0; i < 4; ++i) {
        const int kk = (tid >> 4) + 16 * i, c4 = (tid & 15) * 4;
        tile[kk * 65 + c4 + 0] = v[i].x; tile[kk * 65 + c4 + 1] = v[i].y; tile[kk * 65 + c4 + 2] = v[i].z; tile[kk * 65 + c4 + 3] = v[i].w;
    }
    __syncthreads();
#pragma unroll
    for (int i = 0; i < 2; ++i) {
        const int q = tid + 256 * i, n = q >> 3, kc = q & 7;
        float x[8];
#pragma unroll
        for (int j = 0; j < 8; ++j) x[j] = tile[(kc * 8 + j) * 65 + n];
        u32x4 w; w.x = pack2(x[0], x[1]); w.y = pack2(x[2], x[3]); w.z = pack2(x[4], x[5]); w.w = pack2(x[6], x[7]);
        int drow = J.n0 + n; if (J.mode >= 2) drow = 8 * (drow >> 2) + (drow & 3) + (J.mode == 3 ? 4 : 0);
        *(u32x4*)(J.dst + (size_t)drow * J.kdst + J.k0 + kc * 8) = w;
    }
    __syncthreads();
}
__device__ __forceinline__ void tcvt_tile(const float* src, int ld_src, int k0, int n0, int mode, bf16_t* dst, int kdst, unsigned char* lds, int half) {
    TJob J; J.src = src; J.dst = dst; J.ld = ld_src; J.k0 = k0; J.n0 = n0; J.mode = mode; J.kdst = kdst;
    const int tid = (ltid() & 255); float4 v[4];
    tcvt_load(J, v, tid); tcvt_finish(J, v, lds, tid);
}

__device__ __forceinline__ void tcvt_decode(const Params& p, unsigned char* ws, int layer, int t, TJob& J) {
    constexpr int J0 = 16 * 104, J1 = 8 * 16, J2 = 256, J3 = 256, J4 = 2048, J5 = 2048;
    int u = t;
        if (u < J0) { J.src = p.w_in + (size_t)layer * 1024 * DIN; J.ld = DIN; J.k0 = (u % 16) * 64; J.n0 = (u / 16) * 64; J.mode = 1; J.dst = (bf16_t*)(ws + WS_WIN); J.kdst = 1024; return; }
        u -= J0;
        if (u < J1) { J.src = p.w_br_a + (size_t)layer * 512 * 1024; J.ld = 1024; J.k0 = (u % 8) * 64; J.n0 = (u / 8) * 64; J.mode = 0; J.dst = (bf16_t*)(ws + WS_WA); J.kdst = 1536; return; }
        u -= J1;
        if (u < J2) { J.src = p.w_br_b + (size_t)layer * 1024 * 1024; J.ld = 1024; J.k0 = (u % 16) * 64; J.n0 = (u / 16) * 64; J.mode = 0; J.dst = (bf16_t*)(ws + WS_WA) + 512; J.kdst = 1536; return; }
        u -= J2;
        if (u < J3) { J.src = p.w_o + (size_t)layer * 1024 * 1024; J.ld = 1024; J.k0 = (u % 16) * 64; J.n0 = (u / 16) * 64; J.mode = 0; J.dst = (bf16_t*)(ws + WS_WO); J.kdst = 1024; return; }
        u -= J3;
        if (u < J4 + J5) {
            const bool up = u >= J4; if (up) u -= J4;
            const int e = u / 128, v = u % 128;
            J.src = (up ? p.w_up : p.w_gate) + ((size_t)layer * NE + e) * 1024 * 512; J.ld = 512; J.k0 = (v % 16) * 64; J.n0 = (v / 16) * 64; J.mode = up ? 3 : 2;
            J.dst = (bf16_t*)(ws + WS_WG) + (size_t)e * 1024 * 1024; J.kdst = 1024; return;
        }
        u -= J4 + J5;
        { const int e = u / 128, v = u % 128;
          J.src = p.w_down + ((size_t)layer * NE + e) * 512 * 1024; J.ld = 1024; J.k0 = (v % 8) * 64; J.n0 = (v / 8) * 64; J.mode = 0; J.dst = (bf16_t*)(ws + WS_WD) + (size_t)e * 1024 * 512; J.kdst = 512; }
}


__device__ __forceinline__ void phase_pw(const Params& p, int layer, unsigned char* lds, int parts, int half, int skip = 0, int split = 0) {
    const int hq = __builtin_amdgcn_readfirstlane(ltid() >> 8);
    if ((int)(blockIdx.x * 2 + hq) < skip) return;
    constexpr int MOE_A = 2048, MOE_B = 1024;
    const int bid = split == 1 ? ((int)blockIdx.x - (int)(gridDim.x >> 1)) * 2 + hq : (blockIdx.x * 2 + hq) - skip, nblk = split == 1 ? (int)gridDim.x : split == 3 ? (int)(gridDim.x >> 1) : (gridDim.x * 2) - skip, tid = (ltid() & 255);
    if (bid < 0 || (split == 3 && bid >= nblk)) return;
    unsigned char* ws = launder(p.ws);
    constexpr int J0 = 16 * 104, J1 = 8 * 16, J2 = 256, J3 = 256, J4 = 2048, J5 = 2048, J6 = 2048, JT = J0 + J1 + J2 + J3 + J4 + J5 + J6;
    const int t_lo = ((parts & 1) ? 0 : (parts & 2) ? J0 : J0 + J1 + J2 + J3) + (split == 2 ? MOE_A + MOE_B : split == 3 ? MOE_A : 0);
    const int t_hi = split == 1 ? J0 + J1 + J2 + J3 + MOE_A : split == 3 ? J0 + J1 + J2 + J3 + MOE_A + MOE_B : (parts & 4) ? JT : (parts & 2) ? J0 + J1 + J2 + J3 : (parts & 1) ? J0 : 0;
    if (t_lo + bid < t_hi) {
        float4 v[4]; { TJob J; tcvt_decode(p, ws, layer, t_lo + bid, J); tcvt_load(J, v, tid); }
        for (int t = t_lo + bid; t < t_hi; t += nblk) {
            float4 vn[4];
            if (t + nblk < t_hi) { TJob J; tcvt_decode(p, ws, layer, t + nblk, J); tcvt_load(J, vn, tid); }
            { TJob J; tcvt_decode(p, ws, layer, t, J); tcvt_finish(J, v, lds, tid); }
#pragma unroll
            for (int i = 0; i < 4; ++i) v[i] = vn[i];
        }
    }
    if (parts & 16) {
    for (int t = bid; t < 64; t += nblk) {
        const int kv = t >> 5, kt = t & 31;
        const float* w1 = p.cmp_w1 + ((size_t)layer * 2 + kv) * 2048 * 64;
        tcvt_tile(w1, 64, kt * 64, 0, 0, (bf16_t*)(ws + WS_W1T) + (size_t)kv * 64 * 2048, 2048, lds, half);
        const int n = tid & 63, part = tid >> 6;
        const float* pos = p.cmp_pos + ((size_t)layer * 2 + kv) * 2048 + kt * 64 + part * 16;
        const float* wp = w1 + (size_t)(kt * 64 + part * 16) * 64 + n;
        float a = 0.f;
#pragma unroll
        for (int k = 0; k < 16; ++k) a += pos[k] * wp[(size_t)k * 64];
        float* red = (float*)lds;
        __syncthreads(); red[tid] = a; __syncthreads();
        if (tid < 64) ((float*)(ws + WS_CTL) + CW_B1P)[(kv * 32 + kt) * 64 + tid] = red[tid] + red[tid + 64] + red[tid + 128] + red[tid + 192];
        __syncthreads();
    }
    }
    if (parts & 8) {
        const float4* xs = (const float4*)p.x; u32x2* xb = (u32x2*)(ws + WS_XB);
        for (size_t i = (size_t)bid * HT + tid; i < (size_t)T_ * 1024 / 4; i += (size_t)nblk * HT) {
            float4 v = xs[i]; u32x2 w; w.x = pack2(v.x, v.y); w.y = pack2(v.z, v.w); xb[i] = w;
        }
        for (int n = bid * HT + tid; n < 8192; n += nblk * HT) {
            int bk;
            if (n < 16) bk = n;
            else { const int th[15] = {22, 30, 40, 54, 73, 99, 134, 182, 246, 332, 450, 609, 825, 1117, 1513}; bk = 16;
#pragma unroll
                for (int k = 0; k < 15; ++k) bk += (n >= th[k]) ? 1 : 0; }
            (ws + WS_BUCKET)[n] = (unsigned char)bk;
        }
        for (int i = bid * HT + tid; i < 8192 * 32; i += nblk * HT) {
            const int pos = i >> 5, d = i & 31;
            const float inv = powf(10000.f, -(float)d * 2.0f / 64.f);
            const float ang = (float)pos * inv;
            float sn, cs; sincosf(ang, &sn, &cs);
            ((float2*)(ws + WS_ROPE))[i] = make_float2(cs, sn);
        }
        if (bid == 0) for (int i = tid; i < 8192; i += HT) ((unsigned*)(ws + WS_CTL))[i] = 0u;
    }
}

__device__ __forceinline__ float fsig(float x) { return __builtin_amdgcn_rcpf(1.f + __builtin_amdgcn_exp2f(-1.4426950408889634f * x)); }
template <int KIND>
__device__ __forceinline__ void g1_epi(const f32x4 (&acc)[2][2][4][2], unsigned char* ws, int r0, int c0, int wr, int wc, int fr, int fq) {
#pragma unroll
    for (int ai = 0; ai < 2; ++ai)
#pragma unroll
        for (int m = 0; m < 4; ++m) {
            const int row = r0 + 128 * ai + 64 * wr + 16 * m + fr + vzero();
#pragma unroll
            for (int bj = 0; bj < 2; ++bj) {
                const int col = c0 + 128 * bj + 32 * wc + 8 * fq;
                f32x4 v0 = acc[ai][bj][m][0], v1 = acc[ai][bj][m][1];
                if (KIND == 5) {
                    const int b = col >> 13, sq = col & (S_ - 1);
                    bf16_t* dst;
                    if (row < C_VW) { const int c = row - C_VS; dst = (bf16_t*)(ws + WS_VST) + ((size_t)(b * 2 + (c >> 6)) * 64 + (c & 63)) * S_ + sq; }
                    else if (row < C_VR) { const int c = row - C_VW; dst = (bf16_t*)(ws + WS_VWT) + ((size_t)(b * 2 + (c >> 6)) * 64 + (c & 63)) * S_ + sq; }
                    else { const int c = row - C_VR; dst = (bf16_t*)(ws + WS_VRT) + ((size_t)(b * 8 + (c >> 7)) * 128 + (c & 127)) * S_ + sq; }
                    u32x4 w; w.x = pack2(v0[0], v0[1]); w.y = pack2(v0[2], v0[3]); w.z = pack2(v1[0], v1[1]); w.w = pack2(v1[2], v1[3]);
                    *(u32x4*)dst = w;
                    continue;
                }
                if (KIND == 1 || KIND == 2) {
                    const float2* rope = (const float2*)(ws + WS_ROPE);
                    const int pos = row & (S_ - 1), d = 16 * (wc & 1) + 4 * fq;
                    const float4 cs01 = *(const float4*)(rope + pos * 32 + d), cs23 = *(const float4*)(rope + pos * 32 + d + 2);
                    const float c[4] = {cs01.x, cs01.z, cs23.x, cs23.z}, sn[4] = {cs01.y, cs01.w, cs23.y, cs23.w};
                    const float sc = (KIND == 2) ? 0.125f : 1.0f;
                    f32x4 y1, y2;
#pragma unroll
                    for (int r = 0; r < 4; ++r) { y1[r] = (v0[r] * c[r] - v1[r] * sn[r]) * sc; y2[r] = (v0[r] * sn[r] + v1[r] * c[r]) * sc; }
                    v0 = y1; v1 = y2;
                } else if (KIND == 3) {
#pragma unroll
                    for (int r = 0; r < 4; ++r) { v0[r] = v0[r] * fsig(v0[r]); v1[r] = v1[r] * fsig(v1[r]); }
                } else if (KIND == 4) {
#pragma unroll
                    for (int r = 0; r < 4; ++r) { v0[r] = fsig(v0[r]); v1[r] = fsig(v1[r]); }
                }
                u32x4 w; w.x = pack2(v0[0], v0[1]); w.y = pack2(v0[2], v0[3]); w.z = pack2(v1[0], v1[1]); w.w = pack2(v1[2], v1[3]);
                *(u32x4*)((bf16_t*)(ws + WS_P) + (size_t)row * LD + col) = w;
            }
        }
}
struct G1Order {      typedef pg8::Unit U; static constexpr bool GATHER = false;
    int xcd, slot, per;
    __device__ __forceinline__ bool next(int i, pg8::Unit& u) const {
        const int j = slot + i * per; if (j >= 208) return false;
        if (j < 192) { u.pm = j / 3; u.pn = xcd + 8 * (j % 3); } else { const int q = j - 192; u.pm = 8 * xcd + (q >> 1); u.pn = 24 + (q & 1); }
        return true;
    }
    __device__ __forceinline__ void ptrs(const pg8::Unit& u, unsigned& A, unsigned& B) const {
        const unsigned x = (unsigned)WS_XB + (unsigned)u.pm * (256u * 1024u * 2u), w = (unsigned)WS_WIN + (unsigned)u.pn * (256u * 1024u * 2u);
        if (u.pn >= 21) { A = w; B = x; } else { A = x; B = w; }
    }
};
struct G1Epi {
    static constexpr int MID_T = 0;
    unsigned char* ws;
    __device__ __forceinline__ void operator()(const f32x4 (&acc)[2][2][4][2], const pg8::Unit& u, int wr, int wc, int fr, int fq) const {
        const int pn = u.pn, tok0 = u.pm * 256, n0 = pn * 256;
        if (pn >= 21) g1_epi<5>(acc, ws, n0, tok0, wr, wc, fr, fq);
        else if (pn >= 12) g1_epi<4>(acc, ws, tok0, n0, wr, wc, fr, fq);
        else if (pn >= 8) g1_epi<3>(acc, ws, tok0, n0, wr, wc, fr, fq);
        else if (pn >= 6) g1_epi<2>(acc, ws, tok0, n0, wr, wc, fr, fq);
        else if (pn >= 4) g1_epi<1>(acc, ws, tok0, n0, wr, wc, fr, fq);
        else g1_epi<0>(acc, ws, tok0, n0, wr, wc, fr, fq);
    }
};
__device__ __forceinline__ void phase_g1(const Params& p, int layer, unsigned char* lds) {
    unsigned char* ws = launder(p.ws);
    G1Order S; S.xcd = blockIdx.x & 7; S.slot = blockIdx.x >> 3; S.per = gridDim.x >> 3;
    G1Epi E; E.ws = ws;
    pg8::gemm_phase<G1Epi, G1Order>(lds, 1024, S, E, ltid(), ws);
}

__device__ __forceinline__ void load_tile64(const bf16_t* base, size_t rowStride, unsigned char* dst, int wid, int lane) {
    const int c = ((lane & 7) ^ (lane >> 3)) * 8;
#pragma unroll
    for (int i = 0; i < 2; ++i) { const int j = wid + 4 * i, row = 8 * j + (lane >> 3); glds16(base + (size_t)row * rowStride + c, dst + j * 1024); }
}
__device__ __forceinline__ void load_tile128(const bf16_t* base, size_t rowStride, unsigned char* dst, int wid, int lane) {
    const int c = ((lane & 7) ^ (lane >> 3)) * 8;
#pragma unroll
    for (int i = 0; i < 4; ++i) { const int j = wid + 4 * i, row = 8 * j + (lane >> 3); glds16(base + (size_t)row * rowStride + c, dst + j * 1024); }
}
__device__ __forceinline__ void load_tile128w(const bf16_t* base, size_t rowStride, unsigned char* dst, int wid, int lane) {
    const int c = ((lane & 15) ^ ((4 * wid + (lane >> 4)) & 15)) * 8;
#pragma unroll
    for (int i = 0; i < 8; ++i) { const int j = wid + 4 * i, row = 4 * j + (lane >> 4); glds16(base + (size_t)row * rowStride + c, dst + j * 1024); }
}
__device__ __forceinline__ bf16x8 lds_frag128(const unsigned char* tile, int row, int chunk) {
    return *(const bf16x8*)(tile + row * 128 + ((chunk ^ (row & 7)) << 4));
}
__device__ __forceinline__ bf16x8 lds_frag256(const unsigned char* tile, int row, int chunk) {
    return *(const bf16x8*)(tile + row * 256 + ((chunk ^ (row & 15)) << 4));
}
__device__ __forceinline__ bf16x8 lds_vfrag128(const unsigned char* tile, int row, int kbase, int fq) {
    const int ca = (kbase >> 3) + (fq >> 1), hb = (fq & 1) * 8;
    const u32x2 a = *(const u32x2*)(tile + row * 128 + ((ca ^ (row & 7)) << 4) + hb);
    const u32x2 b = *(const u32x2*)(tile + row * 128 + (((ca + 2) ^ (row & 7)) << 4) + hb);
    u32x4 w; w.x = a.x; w.y = a.y; w.z = b.x; w.w = b.y;
    return __builtin_bit_cast(bf16x8, w);
}
__device__ __forceinline__ bf16x8 lds_vfrag256(const unsigned char* tile, int row, int kbase, int fq) {
    const int ca = (kbase >> 3) + (fq >> 1), hb = (fq & 1) * 8;
    const u32x2 a = *(const u32x2*)(tile + row * 256 + ((ca ^ (row & 15)) << 4) + hb);
    const u32x2 b = *(const u32x2*)(tile + row * 256 + (((ca + 2) ^ (row & 15)) << 4) + hb);
    u32x4 w; w.x = a.x; w.y = a.y; w.z = b.x; w.w = b.y;
    return __builtin_bit_cast(bf16x8, w);
}
__device__ __forceinline__ bf16x8 pack8(f32x4 a, f32x4 b) {
    u32x4 w; w.x = pack2(a[0], a[1]); w.y = pack2(a[2], a[3]); w.z = pack2(b[0], b[1]); w.w = pack2(b[2], b[3]);
    return __builtin_bit_cast(bf16x8, w);
}

__device__ __forceinline__ float gelu_tanh(float x) {
    const float u = 0.7978845608028654f * (x + 0.044715f * x * x * x);
    return 0.5f * x * (1.f + tanhf(u));
}
__device__ __forceinline__ void compress_item(const Params& p, int layer, int item, unsigned char* lds, int half) {
    unsigned char* ws = launder(p.ws);
    const int tid = (ltid() & 255), lane = tid & 63, wid = tid >> 6, wr = wid >> 1, wc = wid & 1, fr = lane & 15, fq = lane >> 4;
    const int mtile = item & 3, g = (item >> 2) & 1, b = (item >> 3) & 1, kv = item >> 4;
    const int i0 = mtile * 128;
    const bf16_t* P = (const bf16_t*)(ws + WS_P);
    const bf16_t* W1T = (const bf16_t*)(ws + WS_W1T) + (size_t)kv * 64 * 2048;
    const int col = (kv ? C_VC : C_KC) + g * 64;
    const int ldc = ((lane & 7) ^ (lane >> 3)) * 8;
    const int l0 = 16 * half;
    const bf16_t* ap[4];
#pragma unroll
    for (int i = 0; i < 4; ++i) ap[i] = P + ((size_t)b * S_ + 16 * (i0 + 32 * i + 8 * wid + (lane >> 3)) + l0) * LD + col + ldc;
    const bf16_t* bp[2];
#pragma unroll
    for (int i = 0; i < 2; ++i) bp[i] = W1T + (size_t)(8 * (wid + 4 * i) + (lane >> 3)) * 2048 + l0 * 64 + ldc;
    f32x4 acc[4][2];
#pragma unroll
    for (int i = 0; i < 4; ++i)
#pragma unroll
        for (int j = 0; j < 2; ++j) acc[i][j] = (f32x4){0.f, 0.f, 0.f, 0.f};
    __syncthreads();
#define CSTAGE(buf, l) do { unsigned char* st_ = lds + (buf) * 24576; \
        _Pragma("unroll") for (int i = 0; i < 4; ++i) glds16(ap[i] + (size_t)(l) * LD, st_ + (4 * i + wid) * 1024); \
        _Pragma("unroll") for (int i = 0; i < 2; ++i) glds16(bp[i] + (l) * 64, st_ + 16384 + (wid + 4 * i) * 1024); } while (0)
    CSTAGE(0, 0); CSTAGE(1, 1);
    for (int l = 0; l < 16; ++l) {
        const unsigned char* st = lds + (l % 3) * 24576;
        if (l + 1 < 16) WAIT_V(6); else WAIT_V(0);
        RAW_BARRIER();
        if (l + 2 < 16) CSTAGE((l + 2) % 3, l + 2);
#pragma unroll
        for (int ks = 0; ks < 2; ++ks) {
            bf16x8 a[4], bb[2];
#pragma unroll
            for (int i = 0; i < 4; ++i) a[i] = lds_frag128(st, 64 * wr + 16 * i + fr, 4 * ks + fq);
#pragma unroll
            for (int j = 0; j < 2; ++j) bb[j] = lds_frag128(st + 16384, 32 * wc + 16 * j + fr, 4 * ks + fq);
#pragma unroll
            for (int i = 0; i < 4; ++i)
#pragma unroll
                for (int j = 0; j < 2; ++j) acc[i][j] = mfma16(a[i], bb[j], acc[i][j]);
        }
    }
    __syncthreads();
#undef CSTAGE
    float* xch = (float*)(lds - half * HALF_LDS + HALF_LDS);
    if (half == 1) {
#pragma unroll
        for (int i = 0; i < 4; ++i)
#pragma unroll
            for (int j = 0; j < 2; ++j)
#pragma unroll
                for (int r = 0; r < 4; ++r) xch[((i * 2 + j) * 4 + r) * 256 + tid] = acc[i][j][r];
    }
    __syncthreads();
    if (half == 0) {
        const float* b1 = (const float*)(ws + WS_CTL) + CW_B1P + kv * 32 * 64;
#pragma unroll
        for (int j = 0; j < 2; ++j) {
            const int n = 32 * wc + 16 * j + fr; float bias = 0.f;
#pragma unroll
            for (int kt = 0; kt < 32; ++kt) bias += b1[kt * 64 + n + vzero()];
#pragma unroll
            for (int i = 0; i < 4; ++i)
#pragma unroll
                for (int r = 0; r < 4; ++r) {
                    const int row = 64 * wr + 16 * i + 4 * fq + r;
                    const float hv = gelu_tanh(acc[i][j][r] + xch[((i * 2 + j) * 4 + r) * 256 + tid] + bias);
                    *(bf16_t*)(lds + row * 128 + (((n >> 3) ^ (row & 7)) << 4) + (n & 7) * 2) = f2bf(hv);
                }
        }
        const float* w2 = p.cmp_w2 + ((size_t)layer * 2 + kv) * 64 * 64;
        const int k = tid >> 2, n0 = (tid & 3) * 16;
#pragma unroll
        for (int q4 = 0; q4 < 4; ++q4) {
            const float4 w = *(const float4*)(w2 + k * 64 + n0 + 4 * q4);
            const float wv[4] = {w.x, w.y, w.z, w.w};
#pragma unroll
            for (int e = 0; e < 4; ++e) { const int n = n0 + 4 * q4 + e; *(bf16_t*)(lds + 16384 + n * 128 + (((k >> 3) ^ (n & 7)) << 4) + (k & 7) * 2) = f2bf(wv[e]); }
        }
    }
    __syncthreads();
    if (half == 0) {
        f32x4 o[4][2];
#pragma unroll
        for (int i = 0; i < 4; ++i)
#pragma unroll
            for (int j = 0; j < 2; ++j) o[i][j] = (f32x4){0.f, 0.f, 0.f, 0.f};
#pragma unroll
        for (int ks = 0; ks < 2; ++ks) {
            bf16x8 a[4], bb[2];
#pragma unroll
            for (int i = 0; i < 4; ++i) a[i] = lds_frag128(lds, 64 * wr + 16 * i + fr, 4 * ks + fq);
#pragma unroll
            for (int j = 0; j < 2; ++j) bb[j] = lds_frag128(lds + 16384, 32 * wc + 16 * j + fr, 4 * ks + fq);
#pragma unroll
            for (int i = 0; i < 4; ++i)
#pragma unroll
                for (int j = 0; j < 2; ++j) o[i][j] = mfma16(a[i], bb[j], o[i][j]);
        }
#pragma unroll
        for (int i = 0; i < 4; ++i)
#pragma unroll
            for (int j = 0; j < 2; ++j) {
                const int n = 32 * wc + 16 * j + fr, ci = i0 + 64 * wr + 16 * i + 4 * fq;
                f32x4 v = o[i][j];
#pragma unroll
                for (int r = 0; r < 4; ++r) if (ci + r >= 511) v[r] = 0.f;
                if (kv == 0) {
                    bf16_t* dst = (bf16_t*)(ws + WS_KCC) + ((size_t)(b * 2 + g) * 512 + ci) * 64 + n;
#pragma unroll
                    for (int r = 0; r < 4; ++r) dst[r * 64] = f2bf(v[r]);
                } else {
                    *(u32x2*)((bf16_t*)(ws + WS_VCCT) + ((size_t)(b * 2 + g) * 64 + n) * 512 + ci) = pack4(v);
                }
            }
    }
    __syncthreads();
}

__device__ __forceinline__ float ret_lg2(int h) { const float gam = 1.f - exp2f(-5.f - (float)h); return log2f(gam); }

__device__ __forceinline__ void retkv_item(const Params& p, int item, unsigned char* lds, int half) {
    unsigned char* ws = launder(p.ws);
    const int tid = (ltid() & 255), lane = tid & 63, wid = tid >> 6, fr = lane & 15, fq = lane >> 4;
    const int n = item & 63, h = (item >> 6) & 7, b = item >> 9;
    const size_t tok0 = (size_t)b * S_ + 128 * n;
    unsigned char* vL = lds; unsigned char* kL = lds + 32768;
    load_tile128w((const bf16_t*)(ws + WS_VRT) + ((size_t)(b * 8 + h) * 128) * S_ + 128 * n, S_, vL, wid, lane);
    load_tile128((const bf16_t*)(ws + WS_P) + tok0 * LD + C_KR + h * 64, LD, kL, wid, lane);
    wait_vm0(); __syncthreads();
    const float lg2 = ret_lg2(h);
    f32x4 acc[2][4];
#pragma unroll
    for (int m = 0; m < 2; ++m)
#pragma unroll
        for (int nt = 0; nt < 4; ++nt) acc[m][nt] = (f32x4){0.f, 0.f, 0.f, 0.f};
#pragma unroll
    for (int ks = 0; ks < 4; ++ks) {
        bf16x8 a[2], bb[4];
#pragma unroll
        for (int m = 0; m < 2; ++m) a[m] = lds_frag256(vL, 32 * wid + 16 * m + fr, 4 * ks + fq);
        float dec[8];
#pragma unroll
        for (int j = 0; j < 8; ++j) dec[j] = exp2f((float)(127 - (32 * ks + 8 * fq + j)) * lg2);
#pragma unroll
        for (int nt = 0; nt < 4; ++nt) {
            const int d = 16 * nt + fr;
            float v[8];
#pragma unroll
            for (int j = 0; j < 8; ++j) {
                const int tk = 32 * ks + 8 * fq + j;
                const bf16_t kvv = *(const bf16_t*)(kL + tk * 128 + (((d >> 3) ^ (tk & 7)) << 4) + (d & 7) * 2);
                v[j] = bf2f(kvv) * dec[j];
            }
            u32x4 w; w.x = pack2(v[0], v[1]); w.y = pack2(v[2], v[3]); w.z = pack2(v[4], v[5]); w.w = pack2(v[6], v[7]);
            bb[nt] = __builtin_bit_cast(bf16x8, w);
        }
#pragma unroll
        for (int m = 0; m < 2; ++m)
#pragma unroll
            for (int nt = 0; nt < 4; ++nt) acc[m][nt] = mfma16(a[m], bb[nt], acc[m][nt]);
    }
    float* KVT = (float*)(ws + WS_KVT) + ((size_t)(b * 8 + h) * 64 + n) * 8192;
#pragma unroll
    for (int m = 0; m < 2; ++m)
#pragma unroll
        for (int nt = 0; nt < 4; ++nt)
#pragma unroll
            for (int r = 0; r < 4; ++r) KVT[(32 * wid + 16 * m + 4 * fq + r) * 64 + 16 * nt + fr] = acc[m][nt][r];
    __syncthreads();
}

__device__ __forceinline__ void phase_p2(const Params& p, int layer, unsigned char* lds, int half) {
    const int vb = blockIdx.x * 2 + half, nvb = gridDim.x * 2;
    if (vb < 64) compress_item(p, layer, vb >> 1, lds, half);
    else for (int it = vb - 64; it < 1024; it += nvb - 64) retkv_item(p, it, lds, half);
}

constexpr int NSA_IMP = 32768, NSA_BUCKET = 65792, NSA_BIAS = 73984;

struct NsaLane { int t; int fr, fq, wid, lane; };

constexpr float LOG2E = 1.4426950408889634f;
__device__ __forceinline__ int t5_first(int bk) {
    const int th[16] = {16, 22, 30, 40, 54, 73, 99, 134, 182, 246, 332, 450, 609, 825, 1117, 1513};
    int r = 16;
#pragma unroll
    for (int k = 0; k < 16; ++k) r = (bk == 16 + k) ? th[k] : r;
    return r;
}
template <int BR, int PASS>
__device__ __forceinline__ void nsa_half(const unsigned char* kL, const unsigned char* vL, const unsigned char* lds, const bf16x8 (&qptr)[4][2],
                                         f32x4 (&O)[4][4], float (&m)[4], float (&l)[4], int tile, int hf, const NsaLane& L, int qrow, const bool FAST, int th, int b0, int b1) {
    const int fr = L.lane & 15, fq = L.lane >> 4;
    constexpr float C2 = 0.125f * LOG2E;
    bf16x8 Kf[2][2];
#pragma unroll
    for (int i = 0; i < 2; ++i)
#pragma unroll
        for (int ks = 0; ks < 2; ++ks) Kf[i][ks] = lds_frag128(kL, 32 * hf + 16 * i + fr, 4 * ks + fq);
    bf16x8 Vf[4];
    if (PASS != 0) {
#pragma unroll
        for (int mt = 0; mt < 4; ++mt) Vf[mt] = lds_vfrag128(vL, 16 * mt + fr, 32 * hf, fq);
    }
    unsigned vmask = 0; unsigned bk[2] = {0u, 0u}; bool hi[2][4];
    if (!FAST) {
        const unsigned char* bucketL = lds + NSA_BUCKET;
#pragma unroll
        for (int i = 0; i < 2; ++i) {
            unsigned pk = 0;
#pragma unroll
            for (int r = 0; r < 4; ++r) {
                const int kk = 32 * hf + 16 * i + 4 * fq + r;
                int rel; bool ok;
                if (BR == 0) { rel = L.t - (16 * (64 * tile + kk) + 31); ok = rel >= 0; }
                else { rel = L.t - (64 * tile + kk); ok = rel >= 0 && rel < 512; }
                int rc = rel < 0 ? 0 : rel; rc = rc > 8191 ? 8191 : rc;
                pk |= (unsigned)bucketL[rc] << (8 * r);
                vmask |= (ok ? 1u : 0u) << (4 * i + r);
                hi[i][r] = false;
            }
            bk[i] = pk;
        }
    } else {
        const int kbase = 64 * tile + 32 * hf + 4 * fq;
        const int lim = BR == 0 ? L.t - th - 31 - 16 * kbase : L.t - th - kbase;
#pragma unroll
        for (int i = 0; i < 2; ++i)
#pragma unroll
            for (int r = 0; r < 4; ++r) hi[i][r] = (BR == 0 ? 16 : 1) * (16 * i + r) <= lim;
    }
    const float* biasL = (const float*)(lds + NSA_BIAS);
    float ia[2] = {0.f, 0.f}, ic[2] = {0.f, 0.f};
#pragma unroll
    for (int nt = 0; nt < 4; ++nt) {
        f32x4 S[2];
        const bf16x8 q0 = qptr[nt][0], q1 = qptr[nt][1];
#pragma unroll
        for (int i = 0; i < 2; ++i) {
            S[i] = (f32x4){0.f, 0.f, 0.f, 0.f};
            S[i] = mfma16(Kf[i][0], q0, S[i]); S[i] = mfma16(Kf[i][1], q1, S[i]);
        }
        float tmax = -1e30f;
        if (!FAST) {
#pragma unroll
            for (int i = 0; i < 2; ++i) {
                float bsv[4];
#pragma unroll
                for (int r = 0; r < 4; ++r) bsv[r] = biasL[nt * 32 + ((bk[i] >> (8 * r)) & 0xffu)];
                asm volatile("" : "+v"(bsv[0]), "+v"(bsv[1]), "+v"(bsv[2]), "+v"(bsv[3]));
#pragma unroll
                for (int r = 0; r < 4; ++r) {
                    const bool ok = (vmask >> (4 * i + r)) & 1u;
                    const float sv = S[i][r] * C2 + bsv[r];
                    S[i][r] = ok ? sv : -1e30f; tmax = fmaxf(tmax, S[i][r]);
                }
            }
        } else {
            const float blo = biasL[nt * 32 + b0], bhi = biasL[nt * 32 + b1];
#pragma unroll
            for (int i = 0; i < 2; ++i)
#pragma unroll
                for (int r = 0; r < 4; ++r) { S[i][r] = S[i][r] * C2 + (hi[i][r] ? bhi : blo); tmax = fmaxf(tmax, S[i][r]); }
        }
        if (PASS != 1) {
            if (__builtin_amdgcn_ballot_w64(tmax > m[nt] + 8.f) != 0ull) {
                const float tm = rows_max(tmax);
                const float mnew = tm > m[nt] + 8.f ? tm : m[nt], alpha = __builtin_amdgcn_exp2f(m[nt] - mnew);
                l[nt] *= alpha; m[nt] = mnew;
                if (PASS == 2) {
#pragma unroll
                    for (int mt = 0; mt < 4; ++mt) O[mt][nt] = O[mt][nt] * alpha;
                }
            }
            float psum = 0.f;
#pragma unroll
            for (int i = 0; i < 2; ++i)
#pragma unroll
                for (int r = 0; r < 4; ++r) S[i][r] = __builtin_amdgcn_exp2f(S[i][r] - m[nt]);
            if (!FAST) {
#pragma unroll
                for (int i = 0; i < 2; ++i)
#pragma unroll
                    for (int r = 0; r < 4; ++r) { const bool ok = (vmask >> (4 * i + r)) & 1u; S[i][r] = ok ? S[i][r] : 0.f; }
            }
#pragma unroll
            for (int i = 0; i < 2; ++i)
#pragma unroll
                for (int r = 0; r < 4; ++r) psum += S[i][r];
            l[nt] += psum;
        } else {
#pragma unroll
            for (int i = 0; i < 2; ++i) {
#pragma unroll
                for (int r = 0; r < 4; ++r) S[i][r] = __builtin_amdgcn_exp2f(S[i][r] - m[nt]) * l[nt];
            }
            if (!FAST) {
#pragma unroll
                for (int i = 0; i < 2; ++i)
#pragma unroll
                    for (int r = 0; r < 4; ++r) { const bool ok = (vmask >> (4 * i + r)) & 1u; S[i][r] = ok ? S[i][r] : 0.f; }
            }
#pragma unroll
            for (int i = 0; i < 2; ++i) {
                ia[i] += S[i][0] + S[i][1] + S[i][2] + 0.5f * S[i][3];
                ic[i] += 0.5f * S[i][3];
            }
        }
        if (PASS != 0) {
            const bf16x8 Pb = pack8(S[0], S[1]);
#pragma unroll
            for (int mt = 0; mt < 4; ++mt) O[mt][nt] = mfma16(Vf[mt], Pb, O[mt][nt]);
        }
        if (nt & 1) __builtin_amdgcn_sched_barrier(0);
    }
    if (PASS == 1) {
        float* imp = (float*)(lds + NSA_IMP) + qrow * 129;
        asm volatile("" ::: "memory"); __builtin_amdgcn_wave_barrier();
#pragma unroll
        for (int i = 0; i < 2; ++i) { const int j = 16 * tile + 8 * hf + 4 * i + fq; imp[j] += ia[i]; }
        asm volatile("s_waitcnt lgkmcnt(0)" ::: "memory"); __builtin_amdgcn_wave_barrier();
#pragma unroll
        for (int i = 0; i < 2; ++i) { const int j = 16 * tile + 8 * hf + 4 * i + fq + 1; if (j < 128) imp[j] += ic[i]; }
        asm volatile("s_waitcnt lgkmcnt(0)" ::: "memory"); __builtin_amdgcn_wave_barrier();
    }
}
template <int BR, int PASS>
__device__ __forceinline__ void nsa_tile(const unsigned char* kL, const unsigned char* vL, const unsigned char* lds, const bf16x8 (&qptr)[4][2],
                                         f32x4 (&O)[4][4], float (&m)[4], float (&l)[4], int tile, const NsaLane& L, int qrow) {
    const int tq0 = __builtin_amdgcn_readfirstlane(L.t - (L.lane & 15));
#pragma unroll 1
    for (int hf = 0; hf < 2; ++hf) {
        const int kfirst = 64 * tile + 32 * hf, pmin = BR == 0 ? 16 * kfirst + 31 : kfirst, pmax = BR == 0 ? 16 * (kfirst + 31) + 31 : kfirst + 31;
        const int rmin = tq0 - pmax, rmax = tq0 + 15 - pmin;
        bool fast = false; int th = 0, b0 = 0, b1 = 0;
        if (rmin >= 16 && (BR != 2 || rmax < 512)) {
            const unsigned char* bucketL = lds + NSA_BUCKET;
            b0 = __builtin_amdgcn_readfirstlane((int)bucketL[rmin]); b1 = __builtin_amdgcn_readfirstlane((int)bucketL[rmax > 8191 ? 8191 : rmax]);
            if (b1 - b0 <= 1) { fast = true; th = b1 == b0 ? 0 : t5_first(b1); }
        }
        nsa_half<BR, PASS>(kL, vL, lds, qptr, O, m, l, tile, hf, L, qrow, fast, th, b0, b1);
    }
}

__device__ __forceinline__ void cmp_item(const Params& p, int item, unsigned char* lds, int half) {
    unsigned char* ws = launder(p.ws);
    const int tid = (ltid() & 255), lane = tid & 63, wid = tid >> 6, fr = lane & 15, fq = lane >> 4;
    const int combo = item & 3, qt = 127 - (item >> 2), b = combo >> 1, g = combo & 1;
    const int q0 = qt * 64, qrow = 16 * wid + fr;
    NsaLane L; L.t = q0 + qrow; L.fr = fr; L.fq = fq; L.wid = wid; L.lane = lane;
    const size_t tok = (size_t)b * S_ + L.t;
    const bf16_t* P = (const bf16_t*)(ws + WS_P);
    __syncthreads();
    if (tid < 128) ((float*)(lds + NSA_BIAS))[tid] = p.rel_bias[(tid & 31) * 8 + 4 * g + (tid >> 5)] * LOG2E;
    for (int i = tid; i < 64 * 129; i += HT) ((float*)(lds + NSA_IMP))[i] = 0.f;
    bf16x8 Qf[4][2];
#pragma unroll
    for (int nt = 0; nt < 4; ++nt)
#pragma unroll
        for (int ks = 0; ks < 2; ++ks) Qf[nt][ks] = *(const bf16x8*)(P + tok * LD + C_QA + (4 * g + nt) * 64 + 32 * ks + 8 * fq);
    __syncthreads();
    f32x4 O[4][4]; float m[4], l[4];
    const bf16_t* gates = P + tok * LD + C_GA + (4 * g) * 3;
    const bf16_t* kc = (const bf16_t*)(ws + WS_KCC) + (size_t)(b * 2 + g) * 512 * 64;
    const bf16_t* vc = (const bf16_t*)(ws + WS_VCCT) + (size_t)(b * 2 + g) * 64 * 512;
    const int ntc = ((q0 + 32) >> 4) / 64 + 1;
#pragma unroll
    for (int nt = 0; nt < 4; ++nt) { m[nt] = -1e30f; l[nt] = 0.f; }
    load_tile64(kc, 64, lds, wid, lane);
    wait_vm0(); __syncthreads();
    for (int it = 0; it < ntc; ++it) {
        unsigned char* cur = lds + (it & 1) * 16384;
        if (it + 1 < ntc) load_tile64(kc + (size_t)(it + 1) * 64 * 64, 64, lds + ((it + 1) & 1) * 16384, wid, lane);
        nsa_tile<0, 0>(cur, cur + 8192, lds, Qf, O, m, l, it, L, qrow);
        wait_vm0(); __syncthreads();
    }
#pragma unroll
    for (int nt = 0; nt < 4; ++nt) { l[nt] = rows_sum(l[nt]); l[nt] = l[nt] > 0.f ? 1.f / l[nt] : 0.f; }
#pragma unroll
    for (int mt = 0; mt < 4; ++mt)
#pragma unroll
        for (int nt = 0; nt < 4; ++nt) O[mt][nt] = (f32x4){0.f, 0.f, 0.f, 0.f};
    load_tile64(kc, 64, lds, wid, lane); load_tile64(vc, 512, lds + 8192, wid, lane);
    wait_vm0(); __syncthreads();
    for (int it = 0; it < ntc; ++it) {
        unsigned char* cur = lds + (it & 1) * 16384;
        if (it + 1 < ntc) { unsigned char* nx = lds + ((it + 1) & 1) * 16384;
            load_tile64(kc + (size_t)(it + 1) * 64 * 64, 64, nx, wid, lane); load_tile64(vc + (it + 1) * 64, 512, nx + 8192, wid, lane); }
        nsa_tile<0, 1>(cur, cur + 8192, lds, Qf, O, m, l, it, L, qrow);
        wait_vm0(); __syncthreads();
    }
    bf16_t* YC = (bf16_t*)(ws + WS_YC) + tok * 512 + (4 * g) * 64;
#pragma unroll
    for (int nt = 0; nt < 4; ++nt) {
        const float gt = bf2f(gates[nt * 3 + 0]);
#pragma unroll
        for (int mt = 0; mt < 4; ++mt) *(u32x2*)(YC + nt * 64 + 16 * mt + 4 * fq) = pack4(O[mt][nt] * gt);
    }
    const int cur = qt;
    {
        float* imp = (float*)(lds + NSA_IMP) + qrow * 129 + 32 * fq;
        asm volatile("s_waitcnt lgkmcnt(0)" ::: "memory"); __builtin_amdgcn_wave_barrier();
#pragma unroll
        for (int i = 0; i < 32; ++i) {
            const int j = 32 * fq + i;
            const float v = imp[i];
            imp[i] = j > cur ? -1.f : v + ((j == 0 || j == cur || j == cur - 1) ? 1.0e4f : 0.f);
        }
        unsigned word = 0;
#pragma unroll 1
        for (int round = 0; round < 16; ++round) {
            float bv = imp[0]; int bi = 0;
#pragma unroll
            for (int i = 1; i < 32; ++i) { const float v = imp[i]; if (v > bv) { bv = v; bi = i; } }
            int gi = 32 * fq + bi;
            {
                u32x2 rv = __builtin_amdgcn_permlane16_swap(__float_as_uint(bv), __float_as_uint(bv), false, false);
                u32x2 ri = __builtin_amdgcn_permlane16_swap((unsigned)gi, (unsigned)gi, false, false);
                float v0 = __uint_as_float(rv.x), v1 = __uint_as_float(rv.y); int i0 = (int)ri.x, i1 = (int)ri.y;
                if (v1 > v0 || (v1 == v0 && i1 < i0)) { v0 = v1; i0 = i1; }
                rv = __builtin_amdgcn_permlane32_swap(__float_as_uint(v0), __float_as_uint(v0), false, false);
                ri = __builtin_amdgcn_permlane32_swap((unsigned)i0, (unsigned)i0, false, false);
                v0 = __uint_as_float(rv.x); v1 = __uint_as_float(rv.y); i0 = (int)ri.x; i1 = (int)ri.y;
                if (v1 > v0 || (v1 == v0 && i1 < i0)) { v0 = v1; i0 = i1; }
                bv = v0; gi = i0;
            }
            if (bv >= 0.f && (gi >> 5) == fq) { word |= 1u << (gi & 31); imp[gi & 31] = -2.f; }
        }
        ((unsigned*)(ws + WS_SELW))[(tok * 2 + g) * 4 + fq] = word;
    }
}

__device__ __forceinline__ void win_item(const Params& p, int item, unsigned char* lds, int half) {
    unsigned char* ws = launder(p.ws);
    const int tid = (ltid() & 255), lane = tid & 63, wid = tid >> 6, fr = lane & 15, fq = lane >> 4;
    const int combo = item & 3, qt = 127 - (item >> 2), b = combo >> 1, g = combo & 1;
    const int q0 = qt * 64, qrow = 16 * wid + fr;
    NsaLane L; L.t = q0 + qrow; L.fr = fr; L.fq = fq; L.wid = wid; L.lane = lane;
    const size_t tok = (size_t)b * S_ + L.t;
    const bf16_t* P = (const bf16_t*)(ws + WS_P);
    __syncthreads();
    if (tid < 128) ((float*)(lds + NSA_BIAS))[tid] = p.rel_bias[(tid & 31) * 8 + 4 * g + (tid >> 5)] * LOG2E;
    bf16x8 Qf[4][2];
#pragma unroll
    for (int nt = 0; nt < 4; ++nt)
#pragma unroll
        for (int ks = 0; ks < 2; ++ks) Qf[nt][ks] = *(const bf16x8*)(P + tok * LD + C_QA + (4 * g + nt) * 64 + 32 * ks + 8 * fq);
    __syncthreads();
    f32x4 O[4][4]; float m[4], l[4];
    const bf16_t* gates = P + tok * LD + C_GA + (4 * g) * 3;
#pragma unroll
    for (int nt = 0; nt < 4; ++nt) { m[nt] = -1e30f; l[nt] = 0.f; }
#pragma unroll
    for (int mt = 0; mt < 4; ++mt)
#pragma unroll
        for (int nt = 0; nt < 4; ++nt) O[mt][nt] = (f32x4){0.f, 0.f, 0.f, 0.f};
    {
        const bf16_t* kb = P + ((size_t)b * S_) * LD + C_KW + g * 64;
        const bf16_t* vb = (const bf16_t*)(ws + WS_VWT) + (size_t)(b * 2 + g) * 64 * S_;
        const int k_lo = qt - 8 > 0 ? qt - 8 : 0, ntw = qt - k_lo + 1;
        load_tile64(kb + (size_t)k_lo * 64 * LD, LD, lds, wid, lane); load_tile64(vb + k_lo * 64, S_, lds + 8192, wid, lane);
        wait_vm0(); __syncthreads();
        for (int it = 0; it < ntw; ++it) {
            unsigned char* cu = lds + (it & 1) * 16384;
            if (it + 1 < ntw) { unsigned char* nx = lds + ((it + 1) & 1) * 16384;
                load_tile64(kb + (size_t)(k_lo + it + 1) * 64 * LD, LD, nx, wid, lane); load_tile64(vb + (k_lo + it + 1) * 64, S_, nx + 8192, wid, lane); }
            nsa_tile<2, 2>(cu, cu + 8192, lds, Qf, O, m, l, k_lo + it, L, qrow);
            wait_vm0(); __syncthreads();
        }
    }
    bf16_t* YW = (bf16_t*)(ws + WS_YW) + tok * 512 + (4 * g) * 64;
#pragma unroll
    for (int nt = 0; nt < 4; ++nt) {
        const float lt = rows_sum(l[nt]), gt = bf2f(gates[nt * 3 + 2]) * (lt > 0.f ? 1.f / lt : 0.f);
#pragma unroll
        for (int mt = 0; mt < 4; ++mt) *(u32x2*)(YW + nt * 64 + 16 * mt + 4 * fq) = pack4(O[mt][nt] * gt);
    }
}

constexpr int SEL_RING = 8, SEL_BUCKET = SEL_RING * 16384, SEL_BIAS2 = SEL_BUCKET + 8192;
template <bool FAST>
__device__ __forceinline__ void sel_ntile(const bf16x8 (&Kf)[4][2], const unsigned char* vL, int fr, int fq, const bf16x8& q0, const bf16x8& q1, f32x4 (&O)[4], float& m, float& l,
                                          bool sb, int relb, int th, float blo, float bhi, const unsigned char* lds, int hl) {
    f32x4 S[4];
#pragma unroll
    for (int i = 0; i < 4; ++i) { S[i] = (f32x4){0.f, 0.f, 0.f, 0.f}; S[i] = mfma16(Kf[i][0], q0, S[i]); S[i] = mfma16(Kf[i][1], q1, S[i]); }
    float tmax = -1e30f;
    const float scl = (!FAST || sb) ? 0.125f * LOG2E : 0.f;
    if (FAST) { blo = (sb ? blo : -1e30f) - m; bhi = (sb ? bhi : -1e30f) - m; }
    if (FAST) {
#pragma unroll
        for (int i = 0; i < 4; ++i)
#pragma unroll
            for (int r = 0; r < 4; ++r) { const int rel = relb - (16 * i + r); S[i][r] = S[i][r] * scl + (rel >= th ? bhi : blo); tmax = fmaxf(tmax, S[i][r]); }
    } else {
        unsigned bkt[4][4]; float bs[4][4];
#pragma unroll
        for (int i = 0; i < 4; ++i)
#pragma unroll
            for (int r = 0; r < 4; ++r) { const int rel = relb - (16 * i + r); int rc = rel < 0 ? 0 : rel; rc = rc > 8191 ? 8191 : rc; bkt[i][r] = (lds + SEL_BUCKET)[rc]; }
#pragma unroll
        for (int i = 0; i < 4; ++i)
#pragma unroll
            for (int r = 0; r < 4; ++r) bs[i][r] = ((const float*)(lds + SEL_BIAS2))[hl * 32 + bkt[i][r]];
        asm volatile("" : "+v"(bs[0][0]), "+v"(bs[0][1]), "+v"(bs[0][2]), "+v"(bs[0][3]), "+v"(bs[1][0]), "+v"(bs[1][1]), "+v"(bs[1][2]), "+v"(bs[1][3]),
                          "+v"(bs[2][0]), "+v"(bs[2][1]), "+v"(bs[2][2]), "+v"(bs[2][3]), "+v"(bs[3][0]), "+v"(bs[3][1]), "+v"(bs[3][2]), "+v"(bs[3][3]));
        const float ninf = -1e30f;
#pragma unroll
        for (int i = 0; i < 4; ++i)
#pragma unroll
            for (int r = 0; r < 4; ++r) {
                const int rel = relb - (16 * i + r);
                const float sv = S[i][r] * (0.125f * LOG2E) + (bs[i][r] - m);
                S[i][r] = (sb && rel >= 0) ? sv : ninf; tmax = fmaxf(tmax, S[i][r]);
            }
    }
    tmax = rows_max(tmax);
    if (__ballot(tmax > 8.f) != 0ull) {
        const float d = fmaxf(tmax, 0.f), alpha = __builtin_amdgcn_exp2f(-d);
        m += d; l *= alpha;
#pragma unroll
        for (int mt = 0; mt < 4; ++mt) O[mt] = O[mt] * alpha;
#pragma unroll
        for (int i = 0; i < 4; ++i)
#pragma unroll
            for (int r = 0; r < 4; ++r) S[i][r] -= d;
    }
    float psum = 0.f;
#pragma unroll
    for (int i = 0; i < 4; ++i)
#pragma unroll
        for (int r = 0; r < 4; ++r) { const float pv = __builtin_amdgcn_exp2f(S[i][r]); S[i][r] = pv; psum += pv; }
    l += rows_sum(psum);
    const bf16x8 Pb0 = pack8(S[0], S[1]), Pb1 = pack8(S[2], S[3]);
#pragma unroll
    for (int mt = 0; mt < 4; ++mt) { O[mt] = mfma16(lds_vfrag128(vL, 16 * mt + fr, 0, fq), Pb0, O[mt]); O[mt] = mfma16(lds_vfrag128(vL, 16 * mt + fr, 32, fq), Pb1, O[mt]); }
}
__device__ __forceinline__ void sel_ntile2_fast(const bf16x8 (&Kf)[4][2], const unsigned char* vL, int fr, int fq, const bf16x8 (&Qf)[2][2], f32x4 (&O)[2][4], float (&m)[2], float (&l)[2],
                                                const bool (&sb)[2], const int (&relb)[2], int th, float blo, float bhi) {
    f32x4 S[2][4]; float tmax[2], bl[2], bh[2], scl[2];
#pragma unroll
    for (int b = 0; b < 2; ++b)
#pragma unroll
        for (int i = 0; i < 4; ++i) { S[b][i] = (f32x4){0.f, 0.f, 0.f, 0.f}; S[b][i] = mfma16(Kf[i][0], Qf[b][0], S[b][i]); S[b][i] = mfma16(Kf[i][1], Qf[b][1], S[b][i]); }
#pragma unroll
    for (int b = 0; b < 2; ++b) { scl[b] = sb[b] ? 0.125f * LOG2E : 0.f; bl[b] = (sb[b] ? blo : -1e30f) - m[b]; bh[b] = (sb[b] ? bhi : -1e30f) - m[b]; tmax[b] = -1e30f; }
#pragma unroll
    for (int b = 0; b < 2; ++b)
#pragma unroll
        for (int i = 0; i < 4; ++i)
#pragma unroll
            for (int r = 0; r < 4; ++r) { const int rel = relb[b] - (16 * i + r); S[b][i][r] = S[b][i][r] * scl[b] + (rel >= th ? bh[b] : bl[b]); tmax[b] = fmaxf(tmax[b], S[b][i][r]); }
#pragma unroll
    for (int b = 0; b < 2; ++b) tmax[b] = rows_max(tmax[b]);
    if (__ballot(tmax[0] > 8.f || tmax[1] > 8.f) != 0ull) {
#pragma unroll
        for (int b = 0; b < 2; ++b) {
            const float d = fmaxf(tmax[b], 0.f), alpha = __builtin_amdgcn_exp2f(-d);
            m[b] += d; l[b] *= alpha;
#pragma unroll
            for (int mt = 0; mt < 4; ++mt) O[b][mt] = O[b][mt] * alpha;
#pragma unroll
            for (int i = 0; i < 4; ++i)
#pragma unroll
                for (int r = 0; r < 4; ++r) S[b][i][r] -= d;
        }
    }
    float psum[2] = {0.f, 0.f};
#pragma unroll
    for (int b = 0; b < 2; ++b)
#pragma unroll
        for (int i = 0; i < 4; ++i)
#pragma unroll
            for (int r = 0; r < 4; ++r) { const float pv = __builtin_amdgcn_exp2f(S[b][i][r]); S[b][i][r] = pv; psum[b] += pv; }
#pragma unroll
    for (int b = 0; b < 2; ++b) l[b] += rows_sum(psum[b]);
    bf16x8 P0[2], P1[2];
#pragma unroll
    for (int b = 0; b < 2; ++b) { P0[b] = pack8(S[b][0], S[b][1]); P1[b] = pack8(S[b][2], S[b][3]); }
#pragma unroll
    for (int mt = 0; mt < 4; ++mt) {
        const bf16x8 v0 = lds_vfrag128(vL, 16 * mt + fr, 0, fq), v1 = lds_vfrag128(vL, 16 * mt + fr, 32, fq);
#pragma unroll
        for (int b = 0; b < 2; ++b) { O[b][mt] = mfma16(v0, P0[b], O[b][mt]); O[b][mt] = mfma16(v1, P1[b], O[b][mt]); }
    }
}
template <bool FAST>
__device__ __forceinline__ void sel_tile(const unsigned char* kL, const unsigned char* vL, const unsigned char* lds, const bf16x8 (&Qf)[2][2], f32x4 (&O)[2][4], float (&m)[2], float (&l)[2],
                                         const bool (&sb)[2], const bool (&need)[2], const int (&relb)[2], int th, float blo, float bhi, int hl, int fr, int fq) {
    bf16x8 Kf[4][2];
#pragma unroll
    for (int i = 0; i < 4; ++i)
#pragma unroll
        for (int ks = 0; ks < 2; ++ks) Kf[i][ks] = lds_frag128(kL, 16 * i + fr, 4 * ks + fq);
    if (FAST && need[0] && need[1]) { sel_ntile2_fast(Kf, vL, fr, fq, Qf, O, m, l, sb, relb, th, blo, bhi); return; }
    if (need[0]) sel_ntile<FAST>(Kf, vL, fr, fq, Qf[0][0], Qf[0][1], O[0], m[0], l[0], sb[0], relb[0], th, blo, bhi, lds, hl);
    if (need[1]) sel_ntile<FAST>(Kf, vL, fr, fq, Qf[1][0], Qf[1][1], O[1], m[1], l[1], sb[1], relb[1], th, blo, bhi, lds, hl);
}
template <int VAR>
__device__ __forceinline__ void sel_item(const Params& p, int v, unsigned char* lds) {
    unsigned char* ws = launder(p.ws);
    const int tid = ltid(), lane = tid & 63, wid = tid >> 6, fr = lane & 15, fq = lane >> 4;
    const int qt = 127 - (v >> 2), sub = v & 3, b = sub >> 1, g = sub & 1;
    const int q0 = qt * 64, cur = qt, hl = fr & 3;
    const bf16_t* P = (const bf16_t*)(ws + WS_P);
    __syncthreads();
    if (tid < 128) ((float*)(lds + SEL_BIAS2))[tid] = p.rel_bias[(tid & 31) * 8 + 4 * g + (tid >> 5)] * LOG2E;
    int t[2]; size_t tok[2]; bf16x8 Qf[2][2]; unsigned selw[2][4];
#pragma unroll
    for (int nt = 0; nt < 2; ++nt) {
        t[nt] = q0 + 8 * wid + 4 * nt + (fr >> 2); tok[nt] = (size_t)b * S_ + t[nt];
#pragma unroll
        for (int ks = 0; ks < 2; ++ks) Qf[nt][ks] = *(const bf16x8*)(P + tok[nt] * LD + C_QA + (4 * g + hl) * 64 + 32 * ks + 8 * fq);
        const u32x4 w = *(const u32x4*)((const unsigned*)(ws + WS_SELW) + (tok[nt] * 2 + g) * 4);
        selw[nt][0] = w.x; selw[nt][1] = w.y; selw[nt][2] = w.z; selw[nt][3] = w.w;
    }
    f32x4 O[2][4]; float m[2], l[2];
#pragma unroll
    for (int nt = 0; nt < 2; ++nt) { m[nt] = -1000.f; l[nt] = 0.f;
#pragma unroll
        for (int mt = 0; mt < 4; ++mt) O[nt][mt] = (f32x4){0.f, 0.f, 0.f, 0.f}; }
    const bf16_t* kb = P + ((size_t)b * S_) * LD + C_KS + g * 64;
    const bf16_t* vb = (const bf16_t*)(ws + WS_VST) + (size_t)(b * 2 + g) * 64 * S_;
    const int nts = cur + 1;
#define SEL_ISSUE(jj) do { unsigned char* st_ = lds + ((jj) & 7) * 16384; const int c_ = ((lane & 7) ^ (lane >> 3)) * 8, r_ = 8 * wid + (lane >> 3); \
        glds16(kb + ((size_t)(jj) * 64 + r_) * LD + c_, st_ + wid * 1024); glds16(vb + (size_t)r_ * S_ + (jj) * 64 + c_, st_ + 8192 + wid * 1024); } while (0)
    asm volatile("s_waitcnt vmcnt(0)" ::: "memory");
#pragma unroll
    for (int q = 0; q < 4; ++q) if (q < nts) SEL_ISSUE(q);
    const unsigned char* bucketL = lds + SEL_BUCKET;
    for (int jp = 0; jp < nts; jp += 4) {
        WAIT_V(0);
        RAW_BARRIER();
#pragma unroll
        for (int q = 4; q < 8; ++q) if (jp + q < nts) SEL_ISSUE(jp + q);
#pragma unroll 1
      for (int j = jp; j < jp + 4 && j < nts; ++j) {
        const unsigned char* cu = lds + (j & 7) * 16384;
        bool sb[2], need[2]; int relb[2];
#pragma unroll
        for (int nt = 0; nt < 2; ++nt) {
            const unsigned w = j < 32 ? selw[nt][0] : j < 64 ? selw[nt][1] : j < 96 ? selw[nt][2] : selw[nt][3];
            sb[nt] = (w >> (j & 31)) & 1u; need[nt] = __ballot(sb[nt]) != 0ull; relb[nt] = t[nt] - 64 * j - 4 * fq;
        }
        if (VAR == 1) { need[0] = false; need[1] = false; }
        if (VAR == 2) { if (!(need[0] || need[1])) { need[0] = false; } else { need[0] = true; need[1] = true; } }
        if (need[0] || need[1]) {
            const int rmin = q0 - 64 * j - 63, rmax = q0 + 31 - 64 * j;
            bool fast = false; int th = 0; float blo = 0.f, bhi = 0.f;
            if (rmin >= 16) {
                const int b0 = bucketL[rmin], b1 = bucketL[rmax > 8191 ? 8191 : rmax];
                if (b1 - b0 <= 1) { fast = true; th = t5_first(b1); if (b1 == b0) th = 0;
                    blo = ((const float*)(lds + SEL_BIAS2))[hl * 32 + b0]; bhi = ((const float*)(lds + SEL_BIAS2))[hl * 32 + b1]; }
            }
            if (fast) sel_tile<true>(cu, cu + 8192, lds, Qf, O, m, l, sb, need, relb, th, blo, bhi, hl, fr, fq);
            else sel_tile<false>(cu, cu + 8192, lds, Qf, O, m, l, sb, need, relb, th, blo, bhi, hl, fr, fq);
        }
      }
    }
#undef SEL_ISSUE
    __syncthreads();
#pragma unroll
    for (int nt = 0; nt < 2; ++nt) {
        const float gt = bf2f(P[tok[nt] * LD + C_GA + (4 * g + hl) * 3 + 1]) * (l[nt] > 0.f ? 1.f / l[nt] : 0.f);
        const size_t o = tok[nt] * 512 + (4 * g + hl) * 64;
#pragma unroll
        for (int mt = 0; mt < 4; ++mt) {
            const f32x4 yc = unpack4(*(const u32x2*)((const bf16_t*)(ws + WS_YC) + o + 16 * mt + 4 * fq));
            const f32x4 yw = unpack4(*(const u32x2*)((const bf16_t*)(ws + WS_YW) + o + 16 * mt + 4 * fq));
            if (VAR == 0 || VAR == 3) *(u32x2*)((bf16_t*)(ws + WS_YA) + tok[nt] * 1536 + (4 * g + hl) * 64 + 16 * mt + 4 * fq) = pack4(yc + yw + O[nt][mt] * gt);
            else asm volatile("" :: "v"(O[nt][mt]));
        }
    }
}

__device__ __forceinline__ void scan_item(const Params& p, int item, int half) {
    unsigned char* ws = launder(p.ws);
    const int idx = item * HT + (ltid() & 255);
    const int bh = idx >> 13, ed = idx & 8191, h = bh & 7;
    const float dec = exp2f(128.f * ret_lg2(h));
    const float* KVT = (const float*)(ws + WS_KVT) + (size_t)bh * 64 * 8192 + ed;
    bf16_t* SPT = (bf16_t*)(ws + WS_SPT) + (size_t)bh * 64 * 8192 + ed;
    float s = 0.f;
#pragma unroll
    for (int n0 = 0; n0 < 64; n0 += 32) {
        float kv[32];
#pragma unroll
        for (int n = 0; n < 32; ++n) kv[n] = KVT[(size_t)(n0 + n) * 8192];
#pragma unroll
        for (int n = 0; n < 32; ++n) { SPT[(size_t)(n0 + n) * 8192] = f2bf(s); s = s * dec + kv[n]; }
    }
}

__device__ __forceinline__ void phase_p3(const Params& p, unsigned char* lds, int half, int what) {
    for (int i = (ltid() & 255); i < 8192 / 16; i += HT) ((u32x4*)(lds + NSA_BUCKET))[i] = ((const u32x4*)(launder(p.ws) + WS_BUCKET))[i];
    __syncthreads();
    for (int h = (blockIdx.x * 2 + half); h < 512; h += (gridDim.x * 2)) {
        if (what & 1) cmp_item(p, h, lds, half);
        if (what & 2) {
            if (h >= 128 && h < 384) win_item(p, h - 128, lds, half);
            else if (h >= 384) { win_item(p, 256 + 2 * (h - 384) - ((h & 1) ? 1 : 0) , lds, half); win_item(p, 256 + 2 * (h - 384) + ((h & 1) ? 0 : 1) + 1 - ((h & 1) ? 0 : 0), lds, half); }
        }
        if (what & 4) scan_item(p, h, half);
    }
}

__device__ __forceinline__ void retout_item(const Params& p, int item, unsigned char* lds, int half) {
    unsigned char* ws = launder(p.ws);
    const int tid = (ltid() & 255), lane = tid & 63, wid = tid >> 6, fr = lane & 15, fq = lane >> 4;
    const int n = item & 63, h = (item >> 6) & 7, b = item >> 9;
    const size_t tok0 = (size_t)b * S_ + 128 * n;
    const bf16_t* P = (const bf16_t*)(ws + WS_P);
    unsigned char* vL = lds; unsigned char* kL = lds + 32768; unsigned char* sL = lds + 49152;
    __syncthreads();
    load_tile128w((const bf16_t*)(ws + WS_VRT) + ((size_t)(b * 8 + h) * 128) * S_ + 128 * n, S_, vL, wid, lane);
    load_tile128(P + tok0 * LD + C_KR + h * 64, LD, kL, wid, lane);
    load_tile128((const bf16_t*)(ws + WS_SPT) + ((size_t)(b * 8 + h) * 64 + n) * 8192, 64, sL, wid, lane);
    bf16x8 Qf[2][2];
#pragma unroll
    for (int nt = 0; nt < 2; ++nt)
#pragma unroll
        for (int ks = 0; ks < 2; ++ks) Qf[nt][ks] = *(const bf16x8*)(P + (tok0 + 32 * wid + 16 * nt + fr) * LD + C_QR + h * 64 + 32 * ks + 8 * fq);
    wait_vm0(); __syncthreads();
    const float lg2 = ret_lg2(h);
    f32x4 Y[8][2];
#pragma unroll
    for (int m = 0; m < 8; ++m)
#pragma unroll
        for (int nt = 0; nt < 2; ++nt) Y[m][nt] = (f32x4){0.f, 0.f, 0.f, 0.f};
#pragma unroll
    for (int m = 0; m < 8; ++m)
#pragma unroll
        for (int ks = 0; ks < 2; ++ks) {
            const bf16x8 a = lds_frag128(sL, 16 * m + fr, 4 * ks + fq);
#pragma unroll
            for (int nt = 0; nt < 2; ++nt) Y[m][nt] = mfma16(a, Qf[nt][ks], Y[m][nt]);
        }
#pragma unroll
    for (int nt = 0; nt < 2; ++nt) {
        const float sc = exp2f((float)(32 * wid + 16 * nt + fr + 1) * lg2);
#pragma unroll
        for (int m = 0; m < 8; ++m) Y[m][nt] = Y[m][nt] * sc;
    }
#pragma unroll 1
    for (int s = 0; s < 4; ++s) {
        f32x4 St[2][2];
#pragma unroll
        for (int hh = 0; hh < 2; ++hh) {
            const int mt = 2 * s + hh;
#pragma unroll
            for (int nt = 0; nt < 2; ++nt) St[hh][nt] = (f32x4){0.f, 0.f, 0.f, 0.f};
#pragma unroll
            for (int ks = 0; ks < 2; ++ks) {
                const bf16x8 a = lds_frag128(kL, 16 * mt + fr, 4 * ks + fq);
#pragma unroll
                for (int nt = 0; nt < 2; ++nt) St[hh][nt] = mfma16(a, Qf[nt][ks], St[hh][nt]);
            }
#pragma unroll
            for (int nt = 0; nt < 2; ++nt) {
                const int qi = 32 * wid + 16 * nt + fr;
#pragma unroll
                for (int r = 0; r < 4; ++r) {
                    const int kj = 16 * mt + 4 * fq + r;
                    const float dm = qi >= kj ? exp2f((float)(qi - kj) * lg2) : 0.f;
                    St[hh][nt][r] *= dm;
                }
            }
        }
        bf16x8 Pb[2];
#pragma unroll
        for (int nt = 0; nt < 2; ++nt) Pb[nt] = pack8(St[0][nt], St[1][nt]);
#pragma unroll
        for (int m = 0; m < 8; ++m) {
            const bf16x8 a = lds_vfrag256(vL, 16 * m + fr, 32 * s, fq);
#pragma unroll
            for (int nt = 0; nt < 2; ++nt) Y[m][nt] = mfma16(a, Pb[nt], Y[m][nt]);
        }
    }
    bf16_t* YB = (bf16_t*)(ws + WS_YA) + 512;
#pragma unroll
    for (int nt = 0; nt < 2; ++nt) {
        float sum = 0.f;
#pragma unroll
        for (int m = 0; m < 8; ++m) sum += Y[m][nt][0] + Y[m][nt][1] + Y[m][nt][2] + Y[m][nt][3];
        sum = rows_sum(sum);
        const float mu = sum * (1.f / 128.f);
        float vs = 0.f;
#pragma unroll
        for (int m = 0; m < 8; ++m)
#pragma unroll
            for (int r = 0; r < 4; ++r) { const float dlt = Y[m][nt][r] - mu; vs += dlt * dlt; }
        vs = rows_sum(vs);
        const float rstd = rsqrtf(vs * (1.f / 128.f) + 1e-5f);
        const size_t tk = tok0 + 32 * wid + 16 * nt + fr;
#pragma unroll
        for (int m = 0; m < 8; ++m) {
            const f32x4 gt = unpack4(*(const u32x2*)(P + tk * LD + C_GR + h * 128 + 16 * m + 4 * fq));
            f32x4 v;
#pragma unroll
            for (int r = 0; r < 4; ++r) v[r] = (Y[m][nt][r] - mu) * rstd * gt[r];
            *(u32x2*)(YB + tk * 1536 + h * 128 + 16 * m + 4 * fq) = pack4(v);
        }
    }
}
__device__ __forceinline__ void phase_p4_sel(const Params& p, unsigned char* lds) {
    for (int i = ltid(); i < 8192 / 16; i += NTHREADS) ((u32x4*)(lds + SEL_BUCKET))[i] = ((const u32x4*)(launder(p.ws) + WS_BUCKET))[i];
    __syncthreads();
    for (int it = blockIdx.x; it < 512; it += gridDim.x * 2) {
        sel_item<0>(p, it, lds);
        if (511 - it != it) sel_item<0>(p, 511 - it, lds);
    }
    __syncthreads();
}
__device__ __forceinline__ void phase_p4(const Params& p, unsigned char* lds, int half) {
    for (int it = (blockIdx.x * 2 + half); it < 1024; it += (gridDim.x * 2)) retout_item(p, it, lds, half);
}

struct RowOrder {     typedef pg8::Unit U; static constexpr bool GATHER = false;
    unsigned a, b; int K, xcd, slot, per;
    __device__ __forceinline__ bool next(int i, pg8::Unit& u) const { const int t = xcd * 32 + slot + i * per; if (t >= (xcd + 1) * 32) return false; u.pm = t >> 2; u.pn = t & 3; return true; }
    __device__ __forceinline__ void ptrs(const pg8::Unit& u, unsigned& A, unsigned& B) const { A = a + (unsigned)u.pm * 512u * (unsigned)K; B = b + (unsigned)u.pn * 512u * (unsigned)K; }
};
template <int MODE>
struct MixEpi {
    static constexpr int MID_T = MODE == 0 ? 8 : 0;
    unsigned char* ws; const float* X;
    __device__ __forceinline__ void mid(f32x4 (&acc)[2][2][4][2], const pg8::Unit& u, int wr, int wc, int fr, int fq) const {
#pragma unroll
        for (int ai = 0; ai < 2; ++ai) {
            __builtin_amdgcn_sched_barrier(0);
#pragma unroll
            for (int m = 0; m < 4; ++m) {
                const size_t tok = (size_t)(u.pm * 256 + 128 * ai + 64 * wr + 16 * m + fr + vzero());
#pragma unroll
                for (int bj = 0; bj < 2; ++bj) {
                    const int n = u.pn * 256 + 128 * bj + 32 * wc + 8 * fq;
                    const u32x4 ga = *(const u32x4*)((const bf16_t*)(ws + WS_P) + tok * LD + C_MA + n), gb = *(const u32x4*)((const bf16_t*)(ws + WS_P) + tok * LD + C_MB + n);
                    const f32x4 a0 = unpack4((u32x2){ga.x, ga.y}), a1 = unpack4((u32x2){ga.z, ga.w}), b0 = unpack4((u32x2){gb.x, gb.y}), b1 = unpack4((u32x2){gb.z, gb.w});
#pragma unroll
                    for (int r = 0; r < 4; ++r) { acc[ai][bj][m][0][r] *= a0[r] * __builtin_amdgcn_rcpf(fmaxf(b0[r], 1e-30f)); acc[ai][bj][m][1][r] *= a1[r] * __builtin_amdgcn_rcpf(fmaxf(b1[r], 1e-30f)); }
                }
            }
        }
        __builtin_amdgcn_sched_barrier(0);
    }
    __device__ __forceinline__ void operator()(const f32x4 (&acc)[2][2][4][2], const pg8::Unit& u, int wr, int wc, int fr, int fq) const {
#pragma unroll
        for (int ai = 0; ai < 2; ++ai)
#pragma unroll
            for (int m = 0; m < 4; ++m) {
                const size_t tok = (size_t)(u.pm * 256 + 128 * ai + 64 * wr + 16 * m + fr + vzero());
#pragma unroll
                for (int bj = 0; bj < 2; ++bj) {
                    const int n = u.pn * 256 + 128 * bj + 32 * wc + 8 * fq;
                    const f32x4 v0 = acc[ai][bj][m][0], v1 = acc[ai][bj][m][1];
                    if (MODE == 2) {
                        const u32x4 xw = *(const u32x4*)((const bf16_t*)(ws + WS_XB) + tok * 1024 + n);
                        const f32x4 h0 = unpack4((u32x2){xw.x, xw.y}) * DN_ALPHA + v0, h1 = unpack4((u32x2){xw.z, xw.w}) * DN_ALPHA + v1;
                        u32x4 w; w.x = pack2(h0[0], h0[1]); w.y = pack2(h0[2], h0[3]); w.z = pack2(h1[0], h1[1]); w.w = pack2(h1[2], h1[3]);
                        *(u32x4*)((bf16_t*)(ws + WS_H1) + tok * 1024 + n) = w;
                    } else {
                        const u32x4 gw = *(const u32x4*)((const bf16_t*)(ws + WS_P) + tok * LD + C_MB + n);
                        const f32x4 g0 = unpack4((u32x2){gw.x, gw.y}), g1 = unpack4((u32x2){gw.z, gw.w});
                        const f32x4 o0 = g0 * v0, o1 = g1 * v1;
                        u32x4 w; w.x = pack2(o0[0], o0[1]); w.y = pack2(o0[2], o0[3]); w.z = pack2(o1[0], o1[1]); w.w = pack2(o1[2], o1[3]);
                        *(u32x4*)((bf16_t*)(ws + WS_MG) + tok * 1024 + n) = w;
                    }
                }
            }
    }
};
__device__ __forceinline__ void phase_g2(const Params& p, unsigned char* lds) {
    unsigned char* ws = launder(p.ws);
    RowOrder S; S.xcd = blockIdx.x & 7; S.slot = blockIdx.x >> 3; S.per = gridDim.x >> 3;
    S.a = (unsigned)WS_YA; S.b = (unsigned)WS_WA; S.K = 1536; MixEpi<0> E; E.ws = ws; E.X = nullptr;
    pg8::gemm_phase<MixEpi<0>, RowOrder>(lds, 1536, S, E, ltid(), ws);
}
__device__ __forceinline__ void phase_g3(const Params& p, int layer, unsigned char* lds) {
    unsigned char* ws = launder(p.ws);
    RowOrder S; S.xcd = blockIdx.x & 7; S.slot = blockIdx.x >> 3; S.per = gridDim.x >> 3; S.a = (unsigned)WS_MG; S.b = (unsigned)WS_WO; S.K = 1024;
    MixEpi<2> E; E.ws = ws; E.X = nullptr;
    pg8::gemm_phase<MixEpi<2>, RowOrder>(lds, 1024, S, E, ltid(), ws);
}

__device__ __forceinline__ void phase_ln1(const Params& p, int layer, unsigned char* lds, bool dry, int half) {
    unsigned char* ws = launder(p.ws);
    const int tid = (ltid() & 255), lane = tid & 63, wid = tid >> 6;
    float* wrL = (float*)lds;
    float* lgL = (float*)(lds - half * HALF_LDS + 65536);
    {
        float4 wv[16];
#pragma unroll
        for (int k = 0; k < 16; ++k) wv[k] = ((const float4*)p.w_router)[tid + 256 * k];
#pragma unroll
        for (int k = 0; k < 16; ++k) { const int i4 = tid + 256 * k, d = i4 >> 2, e0 = (i4 & 3) * 4;
            wrL[(e0 + 0) * 1024 + d] = wv[k].x; wrL[(e0 + 1) * 1024 + d] = wv[k].y; wrL[(e0 + 2) * 1024 + d] = wv[k].z; wrL[(e0 + 3) * 1024 + d] = wv[k].w; }
    }
    __syncthreads();
    const bf16_t* H1 = (const bf16_t*)(ws + WS_H1);
    bf16_t* X1B = (bf16_t*)(ws + WS_X1B);
    const float* gam = p.ln1_g + layer * 1024; const float* bet = p.ln1_b + layer * 1024;
    unsigned* cnt = (unsigned*)(ws + WS_CTL) + (dry ? 0 : CW_CNT) + layer * 1024;
    int* LIST = (int*)(ws + (dry ? WS_HB : WS_LIST)); float* WTS = (float*)(ws + (dry ? WS_HB + 4194304 : WS_WTS));
    constexpr int U = 4;
    const int nwave = (gridDim.x * 2) * 4, wv = (blockIdx.x * 2 + half) * 4 + wid;
    const int nloc = ((T_ - wv * U + nwave * U - 1) / (nwave * U)) * (4 * U);
    u32x2 vn[U][4];
#pragma unroll
    for (int u = 0; u < U; ++u)
#pragma unroll
        for (int j = 0; j < 4; ++j) vn[u][j] = *(const u32x2*)(H1 + (size_t)(wv * U + u) * 1024 + 256 * j + 4 * lane);
    for (int t0 = wv * U; t0 < T_; t0 += nwave * U) {
        float4 y[U][4]; float s[U], q[U];
#pragma unroll
        for (int u = 0; u < U; ++u) {
            s[u] = 0.f;
#pragma unroll
            for (int j = 0; j < 4; ++j) { const f32x4 t = unpack4(vn[u][j]); y[u][j].x = t[0]; y[u][j].y = t[1]; y[u][j].z = t[2]; y[u][j].w = t[3]; s[u] += (t[0] + t[1]) + (t[2] + t[3]); }
        }
        { const int tn = t0 + nwave * U < T_ ? t0 + nwave * U : t0;
#pragma unroll
          for (int u = 0; u < U; ++u)
#pragma unroll
              for (int j = 0; j < 4; ++j) vn[u][j] = *(const u32x2*)(H1 + (size_t)(tn + u) * 1024 + 256 * j + 4 * lane); }
#pragma unroll
        for (int u = 0; u < U; ++u) s[u] = wave_sum(s[u]) * (1.f / 1024.f);
#pragma unroll
        for (int u = 0; u < U; ++u) {
            q[u] = 0.f;
#pragma unroll
            for (int j = 0; j < 4; ++j) { const float a = y[u][j].x - s[u], b2 = y[u][j].y - s[u], c = y[u][j].z - s[u], d = y[u][j].w - s[u]; q[u] += a * a + b2 * b2 + c * c + d * d; }
        }
#pragma unroll
        for (int u = 0; u < U; ++u) q[u] = rsqrtf(wave_sum(q[u]) * (1.f / 1024.f) + 1e-5f);
#pragma unroll
        for (int j = 0; j < 4; ++j) {
            const int d0 = 256 * j + 4 * lane;
            const float4 gg = *(const float4*)(gam + d0), bb = *(const float4*)(bet + d0);
#pragma unroll
            for (int u = 0; u < U; ++u) {
                y[u][j].x = (y[u][j].x - s[u]) * q[u] * gg.x + bb.x; y[u][j].y = (y[u][j].y - s[u]) * q[u] * gg.y + bb.y;
                y[u][j].z = (y[u][j].z - s[u]) * q[u] * gg.z + bb.z; y[u][j].w = (y[u][j].w - s[u]) * q[u] * gg.w + bb.w;
                u32x2 w; w.x = pack2(y[u][j].x, y[u][j].y); w.y = pack2(y[u][j].z, y[u][j].w);
                *(u32x2*)(X1B + (size_t)(t0 + u) * 1024 + d0) = w;
            }
        }
        float lg[U][16];
#pragma unroll
        for (int e = 0; e < 16; ++e) {
#pragma unroll
            for (int u = 0; u < U; ++u) lg[u][e] = 0.f;
#pragma unroll
            for (int j = 0; j < 4; ++j) { const float4 w4 = *(const float4*)(wrL + e * 1024 + 256 * j + 4 * lane);
#pragma unroll
                for (int u = 0; u < U; ++u) lg[u][e] += y[u][j].x * w4.x + y[u][j].y * w4.y + y[u][j].z * w4.z + y[u][j].w * w4.w; }
        }
        float myl = 0.f;
#pragma unroll
        for (int u = 0; u < U; ++u) {
            float w8[8], z4[4];
#pragma unroll
            for (int e = 0; e < 8; ++e) { const u32x2 r = __builtin_amdgcn_permlane32_swap(__float_as_uint(lg[u][e]), __float_as_uint(lg[u][e + 8]), false, false); w8[e] = __uint_as_float(r.x) + __uint_as_float(r.y); }
#pragma unroll
            for (int e = 0; e < 4; ++e) { const u32x2 r = __builtin_amdgcn_permlane16_swap(__float_as_uint(w8[e]), __float_as_uint(w8[e + 4]), false, false); z4[e] = __uint_as_float(r.x) + __uint_as_float(r.y); }
            const bool h8 = (lane & 8) != 0, h4 = (lane & 4) != 0;
            const float k0 = h8 ? z4[2] : z4[0], s0 = h8 ? z4[0] : z4[2], k1 = h8 ? z4[3] : z4[1], s1 = h8 ? z4[1] : z4[3];
            const float y0 = k0 + __int_as_float(__builtin_amdgcn_mov_dpp(__float_as_int(s0), 0x128, 0xF, 0xF, true));
            const float y1 = k1 + __int_as_float(__builtin_amdgcn_mov_dpp(__float_as_int(s1), 0x128, 0xF, 0xF, true));
            const float k2 = h4 ? y1 : y0, s2 = h4 ? y0 : y1;
            float x = k2 + __int_as_float(__builtin_amdgcn_mov_dpp(__float_as_int(s2), 0x141, 0xF, 0xF, true));
            x += __int_as_float(__builtin_amdgcn_mov_dpp(__float_as_int(x), 0xB1, 0xF, 0xF, true));
            x += __int_as_float(__builtin_amdgcn_mov_dpp(__float_as_int(x), 0x4E, 0xF, 0xF, true));
            if ((lane & 3) == u) myl = x;
        }
        static_assert(U == 4, "lane (l & 3) stores token u = l & 3");
        lgL[(half * nloc + ((t0 - wv * U) / (nwave * U)) * (4 * U) + wid * U + (lane & 3)) * 17 + (lane >> 2)] = myl;
    }
    __syncthreads();
    if (half == 0 && wid == 0)
    for (int l0 = 0; l0 < 2 * nloc; l0 += 64) {
        const int li = l0 + lane; const bool act = li < 2 * nloc;
        const int hq = li >= nloc ? 1 : 0, lh = li - hq * nloc;
        const int it = lh / (4 * U), wq = (lh / U) & 3, uq = lh % U, tok = act ? (((blockIdx.x * 2 + hq) * 4 + wq) * U + uq) + it * (nwave * U) : 0;
        float lgv[16];
#pragma unroll
        for (int e = 0; e < 16; ++e) lgv[e] = lgL[li * 17 + e];
        float mx = lgv[0];
#pragma unroll
        for (int e = 1; e < 16; ++e) mx = fmaxf(mx, lgv[e]);
        float pr[16], ps = 0.f;
#pragma unroll
        for (int e = 0; e < 16; ++e) { pr[e] = expf(lgv[e] - mx); ps += pr[e]; }
        const float ips = 1.f / ps;
        float sel[16];
#pragma unroll
        for (int e = 0; e < 16; ++e) { pr[e] *= ips; sel[e] = pr[e] + p.router_bias[e]; }
        int best = 0; float bestv = -1e30f;
#pragma unroll
        for (int gI = 0; gI < 4; ++gI) {
            float a = -1e30f, b2 = -1e30f;
#pragma unroll
            for (int k = 0; k < 4; ++k) { const float x = sel[4 * gI + k]; if (x > a) { b2 = a; a = x; } else if (x > b2) b2 = x; }
            const float gs = a + b2;
            if (gs > bestv) { bestv = gs; best = gI; }
        }
        float s4[4], p4[4];
#pragma unroll
        for (int k = 0; k < 4; ++k) { s4[k] = 0.f; p4[k] = 0.f; }
#pragma unroll
        for (int gI = 0; gI < 4; ++gI) if (gI == best) {
#pragma unroll
            for (int k = 0; k < 4; ++k) { s4[k] = sel[4 * gI + k]; p4[k] = pr[4 * gI + k]; }
        }
        int i0 = 0; float a0 = s4[0];
#pragma unroll
        for (int k = 1; k < 4; ++k) if (s4[k] > a0) { a0 = s4[k]; i0 = k; }
        int i1 = -1; float a1 = -1e30f;
#pragma unroll
        for (int k = 0; k < 4; ++k) if (k != i0 && s4[k] > a1) { a1 = s4[k]; i1 = k; }
        float w0 = 0.f, w1 = 0.f;
#pragma unroll
        for (int k = 0; k < 4; ++k) { if (k == i0) w0 = p4[k]; if (k == i1) w1 = p4[k]; }
        const float iw = 1.f / (w0 + w1);
        const int e0 = act ? best * 4 + i0 : -1, e1 = act ? best * 4 + i1 : -1;
        unsigned myc = 0, r0 = 0, r1 = 0;
#pragma unroll
        for (int e = 0; e < 16; ++e) {
            const unsigned long long m0 = __builtin_amdgcn_ballot_w64(e0 == e), m1 = __builtin_amdgcn_ballot_w64(e1 == e);
            const unsigned c0 = (unsigned)__builtin_popcountll(m0), c = c0 + (unsigned)__builtin_popcountll(m1);
            if (lane == e) myc = c;
            if (e0 == e) r0 = __builtin_amdgcn_mbcnt_hi((unsigned)(m0 >> 32), __builtin_amdgcn_mbcnt_lo((unsigned)m0, 0u));
            if (e1 == e) r1 = c0 + __builtin_amdgcn_mbcnt_hi((unsigned)(m1 >> 32), __builtin_amdgcn_mbcnt_lo((unsigned)m1, 0u));
        }
        unsigned mybase = 0;
        if (lane < 16 && myc != 0) mybase = atomicAdd(&cnt[lane * 64], myc);
        unsigned b0 = 0, b1 = 0;
#pragma unroll
        for (int e = 0; e < 16; ++e) { const unsigned be = (unsigned)__builtin_amdgcn_readlane((int)mybase, e); if (e0 == e) b0 = be; if (e1 == e) b1 = be; }
        if (act) {
            LIST[(size_t)e0 * T_ + b0 + r0] = tok * 2; LIST[(size_t)e1 * T_ + b1 + r1] = tok * 2 + 1;
            WTS[tok * 2] = w0 * iw; WTS[tok * 2 + 1] = w1 * iw;
        }
    }
}

struct MoeUnit { int e, rt, ct, cnt, off; };
__device__ __forceinline__ const unsigned* moe_counts_to_lds(unsigned char* ws, int layer, unsigned char* lds) {
    unsigned* cntL = (unsigned*)(lds + 2 * HALF_LDS - 1024);
    const int tid = ltid();
    if (tid < NE) cntL[tid] = ((const unsigned*)(ws + WS_CTL) + CW_CNT + layer * 1024)[tid * 64];
    __syncthreads();
    return cntL;
}
struct MoeOrderBase {
    const unsigned* cntp; int t_lo, t_hi, slot, per;
    __device__ __forceinline__ void init(const unsigned* cnt) {
        cntp = cnt; int ntile = 0;
#pragma unroll
        for (int k = 0; k < NE; ++k) ntile += (__builtin_amdgcn_readfirstlane((int)cnt[k]) >> 8) * 4;
        t_lo = (ntile * (int)(blockIdx.x & 7)) >> 3; t_hi = (ntile * (int)((blockIdx.x & 7) + 1)) >> 3; slot = blockIdx.x >> 3; per = gridDim.x >> 3;
    }
    __device__ __forceinline__ bool next(int i, MoeUnit& u) const {
        const int t = t_lo + slot + i * per; if (t >= t_hi) return false;
        int base = 0, off = 0; bool found = false;
#pragma unroll
        for (int k = 0; k < NE; ++k) {
            const int ck = __builtin_amdgcn_readfirstlane((int)cntp[k]), nt = (ck >> 8) * 4;
            if (!found && t < base + nt) { found = true; u.e = k; u.cnt = ck; u.off = off; u.rt = (t - base) >> 2; u.ct = (t - base) & 3; }
            base += nt; off += ck;
        }
        return found;
    }
};
struct M2Order : MoeOrderBase {
    typedef MoeUnit U; static constexpr bool GATHER = true;
    const int* list;
    __device__ __forceinline__ void ptrs(const MoeUnit& u, unsigned& A, unsigned& B) const { A = (unsigned)WS_X1B; B = (unsigned)WS_WG + ((unsigned)u.e * 1024u + (unsigned)u.ct * 256u) * 2048u; }
    __device__ __forceinline__ void rows(const MoeUnit& u, int tid, unsigned (&v)[2]) const {
        v[0] = 0u; v[1] = 0u;
#pragma unroll
        for (int i = 0; i < 2; ++i) { int R, C; pg8::stage_rc((tid + vzero()) * 16 + i * 8192, R, C);
#pragma unroll
            for (int h = 0; h < 2; ++h) { int idx = u.rt * 256 + 128 * h + R; idx = idx < u.cnt ? idx : u.cnt - 1; const int a = (list + (size_t)u.e * T_)[idx]; v[h] |= (unsigned)(a >> 1) << (16 * i); } }
    }
};
struct M3Order : MoeOrderBase {
    typedef MoeUnit U; static constexpr bool GATHER = false;
    __device__ __forceinline__ void ptrs(const MoeUnit& u, unsigned& A, unsigned& B) const { A = (unsigned)WS_HB + ((unsigned)u.off + (unsigned)u.rt * 256u) * 1024u; B = (unsigned)WS_WD + ((unsigned)u.e * 1024u + (unsigned)u.ct * 256u) * 1024u; }
};
struct M2Epi {
    static constexpr int MID_T = 0;
    unsigned char* ws;
    __device__ __forceinline__ void operator()(const f32x4 (&acc)[2][2][4][2], const MoeUnit& u, int wr, int wc, int fr, int fq) const {
        bf16_t* HB = (bf16_t*)(ws + WS_HB);
#pragma unroll
        for (int ai = 0; ai < 2; ++ai)
#pragma unroll
            for (int m = 0; m < 4; ++m) {
                const int idx = u.rt * 256 + 128 * ai + 64 * wr + 16 * m + fr + vzero();
                if (idx < u.cnt) {
#pragma unroll
                    for (int bj = 0; bj < 2; ++bj) {
                        const int hcol = 4 * (32 * u.ct + 16 * bj + 4 * wc + fq);
                        const f32x4 gv = acc[ai][bj][m][0], uv = acc[ai][bj][m][1]; f32x4 hv;
#pragma unroll
                        for (int r = 0; r < 4; ++r) hv[r] = gv[r] * fsig(gv[r]) * uv[r];
                        *(u32x2*)(HB + (size_t)(u.off + idx) * 512 + hcol) = pack4(hv);
                    }
                }
            }
    }
};
struct M3Epi {
    static constexpr int MID_T = 0;
    unsigned char* ws; const int* list;
    __device__ __forceinline__ void operator()(const f32x4 (&acc)[2][2][4][2], const MoeUnit& u, int wr, int wc, int fr, int fq) const {
        bf16_t* CT = (bf16_t*)(ws + WS_CT);
#pragma unroll
        for (int ai = 0; ai < 2; ++ai)
#pragma unroll
            for (int m = 0; m < 4; ++m) {
                const int idx = u.rt * 256 + 128 * ai + 64 * wr + 16 * m + fr + vzero();
                if (idx < u.cnt) {
                    const int a = list[(size_t)u.e * T_ + idx];
#pragma unroll
                    for (int bj = 0; bj < 2; ++bj) {
                        const int n = u.ct * 256 + 128 * bj + 32 * wc + 8 * fq;
                        const f32x4 v0 = acc[ai][bj][m][0], v1 = acc[ai][bj][m][1];
                        u32x4 w; w.x = pack2(v0[0], v0[1]); w.y = pack2(v0[2], v0[3]); w.z = pack2(v1[0], v1[1]); w.w = pack2(v1[2], v1[3]);
                        *(u32x4*)(CT + (size_t)a * 1024 + n) = w;
                    }
                }
            }
    }
};
template <int MODE>
__device__ __forceinline__ void moe_rem_item(unsigned char* ws, const int* list, int e, int cnt, int off, int rh, int c64, unsigned char* lds) {
    constexpr int K = MODE == 0 ? 1024 : 512, NS = K / 64;
    const int tid = (ltid() & 255), lane = tid & 63, wid = tid >> 6, wr = wid >> 1, wc = wid & 1, fr = lane & 15, fq = lane >> 4;
    const int idx0 = (cnt & ~255) + 128 * rh;
    const int ldc = ((lane & 7) ^ (lane >> 3)) * 8;
    const bf16_t* ap[4];
#pragma unroll
    for (int i = 0; i < 4; ++i) {
        int idx = idx0 + 32 * i + 8 * wid + (lane >> 3); idx = idx < cnt ? idx : cnt - 1;
        if (MODE == 0) { const int a = list[(size_t)e * T_ + idx]; ap[i] = (const bf16_t*)(ws + WS_X1B) + (size_t)(a >> 1) * 1024 + ldc; }
        else ap[i] = (const bf16_t*)(ws + WS_HB) + (size_t)(off + idx) * 512 + ldc;
    }
    const bf16_t* bp[2];
#pragma unroll
    for (int i = 0; i < 2; ++i) {
        const int rho = 8 * (wid + 4 * i) + (lane >> 3), src = (rho & ~31) + pg8::perm32(rho & 31);
        bp[i] = (const bf16_t*)(ws + (MODE == 0 ? WS_WG : WS_WD)) + ((size_t)e * 1024 + 64 * c64 + src) * K + ldc;
    }
    f32x4 acc[4][2];
#pragma unroll
    for (int i = 0; i < 4; ++i)
#pragma unroll
        for (int j = 0; j < 2; ++j) acc[i][j] = (f32x4){0.f, 0.f, 0.f, 0.f};
    __syncthreads();
#define RSTAGE(buf, l) do { unsigned char* st_ = lds + (buf) * 24576; \
        _Pragma("unroll") for (int i = 0; i < 4; ++i) glds16(ap[i] + (l) * 64, st_ + (4 * i + wid) * 1024); \
        _Pragma("unroll") for (int i = 0; i < 2; ++i) glds16(bp[i] + (l) * 64, st_ + 16384 + (wid + 4 * i) * 1024); } while (0)
    RSTAGE(0, 0); RSTAGE(1, 1);
    for (int l = 0; l < NS; ++l) {
        const unsigned char* st = lds + (l % 3) * 24576;
        if (l + 1 < NS) WAIT_V(6); else WAIT_V(0);
        RAW_BARRIER();
        if (l + 2 < NS) RSTAGE((l + 2) % 3, l + 2);
#pragma unroll
        for (int ks = 0; ks < 2; ++ks) {
            bf16x8 a[4], bb[2];
#pragma unroll
            for (int i = 0; i < 4; ++i) a[i] = lds_frag128(st, 64 * wr + 16 * i + fr, 4 * ks + fq);
#pragma unroll
            for (int j = 0; j < 2; ++j) bb[j] = lds_frag128(st + 16384, 32 * wc + 16 * j + fr, 4 * ks + fq);
#pragma unroll
            for (int i = 0; i < 4; ++i)
#pragma unroll
                for (int j = 0; j < 2; ++j) acc[i][j] = mfma16(bb[j], a[i], acc[i][j]);
        }
    }
#undef RSTAGE
#pragma unroll
    for (int i = 0; i < 4; ++i) {
        const int idx = idx0 + 64 * wr + 16 * i + fr + vzero();
        if (idx < cnt) {
            if (MODE == 0) {
                f32x4 hv;
#pragma unroll
                for (int r = 0; r < 4; ++r) hv[r] = acc[i][0][r] * fsig(acc[i][0][r]) * acc[i][1][r];
                *(u32x2*)((bf16_t*)(ws + WS_HB) + (size_t)(off + idx) * 512 + 32 * c64 + 16 * wc + 4 * fq) = pack4(hv);
            } else {
                const int a = list[(size_t)e * T_ + idx];
                const f32x4 v0 = acc[i][0], v1 = acc[i][1];
                u32x4 w; w.x = pack2(v0[0], v0[1]); w.y = pack2(v0[2], v0[3]); w.z = pack2(v1[0], v1[1]); w.w = pack2(v1[2], v1[3]);
                *(u32x4*)((bf16_t*)(ws + WS_CT) + (size_t)a * 1024 + 64 * c64 + 32 * wc + 8 * fq) = w;
            }
        }
    }
    __syncthreads();
}
template <int MODE>
__device__ __forceinline__ void moe_rem(const unsigned* cntp, unsigned char* ws, const int* list, unsigned char* ldsh, int half) {
    for (int t = blockIdx.x * 2 + half; ; t += gridDim.x * 2) {
        int base = 0, off = 0, e = -1, cnt = 0, eoff = 0, loc = 0;
#pragma unroll
        for (int k = 0; k < NE; ++k) {
            const int ck = __builtin_amdgcn_readfirstlane((int)cntp[k]), ni = (((ck & 255) + 127) >> 7) * 16;
            if (e < 0 && t < base + ni) { e = k; cnt = ck; eoff = off; loc = t - base; }
            base += ni; off += ck;
        }
        if (e < 0) break;
        moe_rem_item<MODE>(ws, list, e, cnt, eoff, loc >> 4, loc & 15, ldsh);
    }
}
__device__ __forceinline__ void phase_m2(const Params& p, int layer, unsigned char* lds, unsigned char* ldsh, int half) {
    unsigned char* ws = launder(p.ws);
    const unsigned* cntL = moe_counts_to_lds(ws, layer, lds);
    M2Order S; S.init(cntL);
    S.list = (const int*)(ws + WS_LIST);
    M2Epi E; E.ws = ws;
    pg8::gemm_phase<M2Epi, M2Order>(lds, 1024, S, E, ltid(), ws);
    moe_rem<0>(S.cntp, ws, S.list, ldsh, half);
}
__device__ __forceinline__ void phase_m3(const Params& p, int layer, unsigned char* lds, unsigned char* ldsh, int half) {
    unsigned char* ws = launder(p.ws);
    const unsigned* cntL = moe_counts_to_lds(ws, layer, lds);
    M3Order S; S.init(cntL);
    M3Epi E; E.ws = ws; E.list = (const int*)(ws + WS_LIST);
    pg8::gemm_phase<M3Epi, M3Order>(lds, 512, S, E, ltid(), ws);
    moe_rem<1>(S.cntp, ws, E.list, ldsh, half);
}

__device__ __forceinline__ void phase_ln2(const Params& p, int layer, int half) {
    unsigned char* ws = launder(p.ws);
    const int tid = (ltid() & 255), lane = tid & 63, wid = tid >> 6;
    const bf16_t* X1 = (const bf16_t*)(ws + WS_X1B); const bf16_t* CT = (const bf16_t*)(ws + WS_CT); const float* WTS = (const float*)(ws + WS_WTS);
    float* XO = p.out; bf16_t* XB = (bf16_t*)(ws + WS_XB); const bool fin = layer == NLAYER - 1;
    const float* gam = p.ln2_g + layer * 1024; const float* bet = p.ln2_b + layer * 1024;
    constexpr int U = 4;
    const int nwave = (gridDim.x * 2) * 4, wv = (blockIdx.x * 2 + half) * 4 + wid;
    for (int t0 = wv * U; t0 < T_; t0 += nwave * U) {
        float4 v[U][4]; float s[U], q[U];
#pragma unroll
        for (int u = 0; u < U; ++u) {
            const int tok = t0 + u;
            const float w0 = WTS[tok * 2 + vzero()], w1 = WTS[tok * 2 + 1 + vzero()];
            s[u] = 0.f; q[u] = 0.f;
#pragma unroll
            for (int j = 0; j < 4; ++j) {
                const int d0 = 256 * j + 4 * lane;
                const f32x4 xt = unpack4(*(const u32x2*)(X1 + (size_t)tok * 1024 + d0)); float4 xv; xv.x = xt[0]; xv.y = xt[1]; xv.z = xt[2]; xv.w = xt[3];
                const f32x4 c0 = unpack4(*(const u32x2*)(CT + (size_t)(tok * 2) * 1024 + d0)), c1 = unpack4(*(const u32x2*)(CT + (size_t)(tok * 2 + 1) * 1024 + d0));
                v[u][j].x = xv.x * DN_ALPHA + w0 * c0[0] + w1 * c1[0]; v[u][j].y = xv.y * DN_ALPHA + w0 * c0[1] + w1 * c1[1];
                v[u][j].z = xv.z * DN_ALPHA + w0 * c0[2] + w1 * c1[2]; v[u][j].w = xv.w * DN_ALPHA + w0 * c0[3] + w1 * c1[3];
                s[u] += v[u][j].x + v[u][j].y + v[u][j].z + v[u][j].w;
                q[u] += v[u][j].x * v[u][j].x + v[u][j].y * v[u][j].y + v[u][j].z * v[u][j].z + v[u][j].w * v[u][j].w;
            }
        }
#pragma unroll
        for (int u = 0; u < U; ++u) { s[u] = wave_sum(s[u]); q[u] = wave_sum(q[u]); }
#pragma unroll
        for (int j = 0; j < 4; ++j) {
            const int d0 = 256 * j + 4 * lane;
            const float4 gg = *(const float4*)(gam + d0), bb = *(const float4*)(bet + d0);
#pragma unroll
            for (int u = 0; u < U; ++u) {
                const int tok = t0 + u;
                const float mu = s[u] * (1.f / 1024.f), var = fmaxf(q[u] * (1.f / 1024.f) - mu * mu, 0.f), rstd = rsqrtf(var + 1e-5f);
                float4 y; y.x = (v[u][j].x - mu) * rstd * gg.x + bb.x; y.y = (v[u][j].y - mu) * rstd * gg.y + bb.y; y.z = (v[u][j].z - mu) * rstd * gg.z + bb.z; y.w = (v[u][j].w - mu) * rstd * gg.w + bb.w;
                if (fin) *(float4*)(XO + (size_t)tok * 1024 + d0) = y;
                else { u32x2 w; w.x = pack2(y.x, y.y); w.y = pack2(y.z, y.w); *(u32x2*)(XB + (size_t)tok * 1024 + d0) = w; }
            }
        }
    }
}

#define XB_TMO      128
#define XB_XCNT(j)  (256  + 64 * (j))
#define XB_XSUB(j)  (1280 + 64 * (j))
#define XB_XGEN(j)  (2304 + 64 * (j))
#define XB_TOP      3328
#define XB_TOPGEN   3392
#define XCD_BAR_WORDS 3456
#define XB_SPIN_CAP (1u << 22)
#define LAS __attribute__((address_space(3)))
__device__ __forceinline__ unsigned xb_ld(unsigned* p)              { return __hip_atomic_load(p, __ATOMIC_RELAXED, __HIP_MEMORY_SCOPE_AGENT); }
__device__ __forceinline__ unsigned xb_add(unsigned* p, unsigned v) { return __hip_atomic_fetch_add(p, v, __ATOMIC_RELAXED, __HIP_MEMORY_SCOPE_AGENT); }
__device__ __forceinline__ unsigned xb_xcc_id() { return (unsigned)__builtin_amdgcn_s_getreg((3 << 11) | 20) & 0xFu; }
#define XB_SPIN(cond, bar) do { unsigned _sp = 0; while (cond) { __builtin_amdgcn_s_sleep(1); \
    if ((++_sp & 255u) == 0u) { if (xb_ld(&(bar)[XB_TMO])) break; if (_sp > XB_SPIN_CAP) { atomicAdd(&(bar)[XB_TMO], 1u); break; } } } } while (0)
struct XcdBarrier { unsigned* bar; unsigned x; volatile LAS unsigned* st; };
__device__ __forceinline__ XcdBarrier xcd_barrier_post(unsigned* bar, volatile LAS unsigned* st) {
    XcdBarrier b; b.bar = bar; b.x = xb_xcc_id(); b.st = st;
    if (threadIdx.x == 0) (void)xb_add(&bar[XB_XCNT(b.x)], 1u);
    return b;
}
__device__ __forceinline__ void xcd_barrier_complete(unsigned* bar, unsigned x, unsigned& nloc, unsigned& nx) {
    const unsigned G = gridDim.x * gridDim.y * gridDim.z;
    unsigned sum, cnt, mine, sp = 0u;
    for (;;) {
        sum = 0u; cnt = 0u; mine = 0u;
#pragma unroll
        for (unsigned j = 0; j < 16; ++j) { const unsigned c = xb_ld(&bar[XB_XCNT(j)]); sum += c; cnt += (c > 0u) ? 1u : 0u; mine = (j == x) ? c : mine; }
        if (sum == G) break;
        __builtin_amdgcn_s_sleep(1);
        if ((++sp & 255u) == 0u) { if (xb_ld(&bar[XB_TMO])) break; if (sp > XB_SPIN_CAP) { atomicAdd(&bar[XB_TMO], 1u); break; } }
    }
    nloc = mine > 0u ? mine : 1u; nx = cnt > 0u ? cnt : 1u;
}
__device__ __forceinline__ void xcd_barrier(const XcdBarrier& b) {
    asm volatile("s_waitcnt vmcnt(0)" ::: "memory");
    __syncthreads();
    if (threadIdx.x == 0) {
        unsigned* bar = b.bar;
        __builtin_amdgcn_s_waitcnt(0);
        unsigned nloc = b.st[0], nx = b.st[1];
        if (nloc == 0u) { xcd_barrier_complete(bar, b.x, nloc, nx); b.st[0] = nloc; b.st[1] = nx; }
        const unsigned old = xb_add(&bar[XB_XSUB(b.x)], 1u);
        const unsigned gen = old / nloc;
        if (old + 1u == (gen + 1u) * nloc) {
            __builtin_amdgcn_fence(__ATOMIC_RELEASE, "agent");
            asm volatile("s_waitcnt vmcnt(0)" ::: "memory");
            const unsigned og = xb_add(&bar[XB_TOP], 1u);
            const unsigned tg = og / nx;
            if (og + 1u == (tg + 1u) * nx) xb_add(&bar[XB_TOPGEN], 1u);
            else XB_SPIN(xb_ld(&bar[XB_TOPGEN]) == tg, bar);
            __builtin_amdgcn_fence(__ATOMIC_ACQUIRE, "agent");
            xb_add(&bar[XB_XGEN(b.x)], 1u);
            asm volatile("s_waitcnt vmcnt(0)" ::: "memory");
        } else {
            XB_SPIN(xb_ld(&bar[XB_XGEN(b.x)]) == gen, bar);
            __builtin_amdgcn_fence(__ATOMIC_ACQUIRE, "agent");
            asm volatile("s_waitcnt vmcnt(0)" ::: "memory");
        }
    }
    __syncthreads();
}

constexpr int PH_PER_LAYER = 11, N_PHASES = PH_PER_LAYER * NLAYER;
__global__ void __launch_bounds__(NTHREADS, 2) mega(Params p) {
    extern __shared__ __attribute__((aligned(16))) unsigned char lds[];
#if SINGLE_LAUNCH
    volatile LAS unsigned* xbw = (volatile LAS unsigned*)(lds + LDS_BYTES - 16);
    if (threadIdx.x < 4) xbw[threadIdx.x] = 0u;
    __syncthreads();
    XcdBarrier xbar = xcd_barrier_post((unsigned*)(p.ws + WS_CTL) + CW_BAR, xbw);
#endif
    const int half = __builtin_amdgcn_readfirstlane((int)(threadIdx.x >> 8));
    unsigned char* ldsh = lds + half * HALF_LDS;
    bool second = false;
    for (int ph = p.ph_lo; ph < p.ph_hi; ++ph) {
        const int layer = ph / PH_PER_LAYER, k = ph % PH_PER_LAYER;
        if (k == 0 && layer > 0) continue;
#ifdef ONLY_PHASE
        if (k != ONLY_PHASE) continue;
#endif
        switch (k) {
            case 0: phase_pw(p, layer, ldsh, 1 | 16 | 8, half); break;
            case 1: phase_g1(p, layer, lds); if (!second) { __syncthreads(); phase_pw(p, layer, ldsh, 4, half, 0, 1); } break;
            case 2: phase_p2(p, layer, ldsh, half); if (!second && layer + 1 < NLAYER) { __syncthreads(); phase_pw(p, layer + 1, ldsh, 1, half, 64); } break;
            case 3: phase_p3(p, ldsh, half, second ? ((p.rep_mask >> 16) & 7) : 7); if (!second) { __syncthreads(); phase_pw(p, layer, ldsh, 4, half, 0, 3); }
                    if (!second && layer + 1 < NLAYER) { __syncthreads(); phase_pw(p, layer + 1, ldsh, 16, half); }
                    if (!second && layer == 0) { __syncthreads(); phase_pw(p, 0, ldsh, 2, half); } break;
            case 4: { const int sub = second ? ((p.rep_mask >> 12) & 7) : 7;
                    if (sub & 1) phase_p4_sel(p, lds);
                    if ((sub & 4) && half == 0) { phase_pw(p, layer, ldsh, 4, half, 0, 2); __syncthreads(); }
                    if (sub & 2) phase_p4(p, ldsh, half);
                    if ((sub & 4) && half == 1) { __syncthreads(); phase_pw(p, layer, ldsh, 4, half, 0, 2); } } break;
            case 5: phase_g2(p, lds); break;
            case 6: phase_g3(p, layer, lds); break;
            case 7: phase_ln1(p, layer, ldsh, ((p.rep_mask >> 7) & 1) && !second, half); if (!second && layer + 1 < NLAYER) { __syncthreads(); phase_pw(p, layer + 1, ldsh, 2, half); } break;
            case 8: phase_m2(p, layer, lds, ldsh, half); break;
            case 9: phase_m3(p, layer, lds, ldsh, half); break;
            case 10: phase_ln2(p, layer, half); break;
        }

        if (ph + 1 < p.ph_hi) { if (ph == p.ph_lo && !second) cg::this_grid().sync(); else xcd_barrier(xbar); }
        if (((p.rep_mask >> k) & 1) && !second) { second = true; --ph; } else second = false;
    }
}

extern "C" void kernel_launch(void* const* d_in, const int* in_sizes, int n_in, void* d_out, int out_size, void* d_ws, size_t ws_size, hipStream_t stream) {
    static int grid = 0;
    if (grid == 0) {
        if (n_in != 18 || ws_size < WS_END) { fprintf(stderr, "kernel_launch: unexpected n_in %d or ws_size %zu < %zu\n", n_in, ws_size, (size_t)WS_END); grid = -1; return; }
        int dev = 0, cus = 0, per_cu = 0;
        hipGetDevice(&dev); hipDeviceGetAttribute(&cus, hipDeviceAttributeMultiprocessorCount, dev);
        hipFuncSetAttribute((const void*)mega, hipFuncAttributeMaxDynamicSharedMemorySize, LDS_BYTES);
        hipOccupancyMaxActiveBlocksPerMultiprocessor(&per_cu, (const void*)mega, NTHREADS, LDS_BYTES);
        if (per_cu < 1) per_cu = 1;
        if (per_cu > 1) per_cu = 1;
        grid = cus * per_cu;
        (void)hipGetLastError();
    }
    if (grid < 0) return;
    Params p{};
    p.x = (const float*)d_in[0]; p.w_in = (const float*)d_in[1]; p.cmp_pos = (const float*)d_in[2]; p.cmp_w1 = (const float*)d_in[3]; p.cmp_w2 = (const float*)d_in[4];
    p.w_br_a = (const float*)d_in[5]; p.w_br_b = (const float*)d_in[6]; p.w_o = (const float*)d_in[7]; p.ln1_g = (const float*)d_in[8]; p.ln1_b = (const float*)d_in[9];
    p.w_router = (const float*)d_in[10]; p.router_bias = (const float*)d_in[11]; p.w_gate = (const float*)d_in[12]; p.w_up = (const float*)d_in[13]; p.w_down = (const float*)d_in[14];
    p.ln2_g = (const float*)d_in[15]; p.ln2_b = (const float*)d_in[16]; p.rel_bias = (const float*)d_in[17];
    p.out = (float*)d_out; p.ws = (unsigned char*)d_ws; p.rep_mask = REPEAT_MASK;
#if SINGLE_LAUNCH
    hipMemsetAsync((unsigned char*)d_ws + WS_CTL + (size_t)CW_BAR * 4, 0, XCD_BAR_WORDS * 4, stream);
    p.ph_lo = 0; p.ph_hi = N_PHASES;
    void* args[] = {&p};
    hipError_t e = hipLaunchCooperativeKernel((const void*)mega, dim3(grid), dim3(NTHREADS), args, LDS_BYTES, stream);
    if (e != hipSuccess) fprintf(stderr, "cooperative launch failed: %s (grid %d)\n", hipGetErrorString(e), grid);
#else
    for (int ph = 0; ph < N_PHASES; ++ph) {
        p.ph_lo = ph; p.ph_hi = ph + 1;
        hipLaunchKernelGGL(mega, dim3(grid), dim3(NTHREADS), LDS_BYTES, stream, p);
    }
#endif
}
```

```cpp
#include <hip/hip_runtime.h>
#include <hip/hip_cooperative_groups.h>
#include <cstdio>
#include <cstdint>
namespace cg = cooperative_groups;

#ifndef REPEAT_MASK
#define REPEAT_MASK 0
#endif
#ifndef SINGLE_LAUNCH
#define SINGLE_LAUNCH 1
#endif

typedef unsigned short bf16_t;
typedef short bf16x8 __attribute__((ext_vector_type(8)));
typedef float f32x4 __attribute__((ext_vector_type(4)));
typedef unsigned u32x2 __attribute__((ext_vector_type(2)));
typedef unsigned u32x4 __attribute__((ext_vector_type(4)));

constexpr int B_ = 2, S_ = 8192, D_ = 1024, T_ = B_ * S_, NLAYER = 4;
constexpr int DIN = 6424;
constexpr int LD = 5376;
constexpr int NW = 6656;
constexpr int C_QA = 0, C_KC = 512, C_VC = 640, C_KS = 768, C_KW = 896, C_QR = 1024, C_KR = 1536, C_GR = 2048, C_MA = 3072, C_MB = 4096, C_GA = 5120,
              C_VS = 5376, C_VW = 5504, C_VR = 5632;
constexpr float DN_ALPHA = 1.681792830507429f;
constexpr int NE = 16;

constexpr size_t al256(size_t x) { return (x + 255) & ~(size_t)255; }
constexpr size_t WS_CTL = 0;
constexpr size_t WS_BUCKET = 65536;
constexpr size_t WS_ROPE = WS_BUCKET + 8192;
constexpr size_t WS_WIN = WS_ROPE + (size_t)8192 * 32 * 8;
constexpr size_t WS_WA = WS_WIN + (size_t)NW * 1024 * 2;
constexpr size_t WS_WB = WS_WA + (size_t)1024 * 512 * 2;
constexpr size_t WS_WO = WS_WB + (size_t)1024 * 1024 * 2;
constexpr size_t WS_WG = WS_WO + (size_t)1024 * 1024 * 2;
constexpr size_t WS_WU = WS_WG + (size_t)16 * 512 * 1024 * 2;
constexpr size_t WS_WD = WS_WU + (size_t)16 * 512 * 1024 * 2;
constexpr size_t WS_XB = WS_WD + (size_t)16 * 512 * 1024 * 2;
constexpr size_t WS_X = WS_XB + (size_t)T_ * 1024 * 2;
constexpr size_t WS_MG = WS_X + (size_t)T_ * 1024 * 4;
constexpr size_t WS_KCC = WS_MG + (size_t)T_ * 1024 * 2;
constexpr size_t WS_VCCT = WS_KCC + (size_t)4 * 512 * 64 * 2;
constexpr size_t WS_W1T = WS_VCCT + (size_t)4 * 512 * 64 * 2;
constexpr size_t WS_B1 = WS_W1T + (size_t)2 * 64 * 2048 * 2;
constexpr size_t WS_R = WS_B1 + 1024;
constexpr size_t WS_P = WS_R;
constexpr size_t WS_VST = WS_P + (size_t)T_ * LD * 2;
constexpr size_t WS_VWT = WS_VST + (size_t)4 * 64 * S_ * 2;
constexpr size_t WS_VRT = WS_VWT + (size_t)4 * 64 * S_ * 2;
constexpr size_t WS_KVT = WS_VRT + (size_t)16 * 128 * S_ * 2;
constexpr size_t WS_SPT = WS_KVT + (size_t)16 * 64 * 8192 * 4;
constexpr size_t WS_YC = WS_SPT + (size_t)16 * 64 * 8192 * 2;
constexpr size_t WS_YW = WS_YC + (size_t)T_ * 512 * 2;
constexpr size_t WS_YA = WS_YW + (size_t)T_ * 512 * 2;
constexpr size_t WS_YB = WS_YA + (size_t)T_ * 512 * 2;
constexpr size_t WS_SELW = WS_YB + (size_t)T_ * 1024 * 2;
constexpr size_t WS_ENDA = WS_SELW + (size_t)T_ * 2 * 4 * 4;
constexpr size_t WS_H1 = WS_R;
constexpr size_t WS_X1 = WS_H1 + (size_t)T_ * 1024 * 4;
constexpr size_t WS_X1B = WS_X1 + (size_t)T_ * 1024 * 4;
constexpr size_t WS_HB = WS_X1B + (size_t)T_ * 1024 * 2;
constexpr size_t WS_CT = WS_HB + (size_t)2 * T_ * 512 * 2;
constexpr size_t WS_LIST = WS_CT + (size_t)2 * T_ * 1024 * 2;
constexpr size_t WS_WTS = WS_LIST + (size_t)16 * T_ * 4;
constexpr size_t WS_ENDB = WS_WTS + (size_t)2 * T_ * 4;
static_assert(WS_HB + (size_t)2 * T_ * 512 * 2 <= WS_CT, "view B overlap");
constexpr size_t WS_END = WS_ENDA > WS_ENDB ? WS_ENDA : WS_ENDB;

constexpr int CW_CNT = 4096;
constexpr int CW_BAR = 8192;
constexpr int CW_B1P = 12288;

constexpr int HALF_LDS = 75776, LDS_BYTES = 2 * HALF_LDS + 16;
constexpr int NTHREADS = 512, HT = 256;

struct Params {
    const float* x; const float* w_in; const float* cmp_pos; const float* cmp_w1; const float* cmp_w2;
    const float* w_br_a; const float* w_br_b; const float* w_o; const float* ln1_g; const float* ln1_b;
    const float* w_router; const float* router_bias; const float* w_gate; const float* w_up; const float* w_down;
    const float* ln2_g; const float* ln2_b; const float* rel_bias;
    float* out; unsigned char* ws;
    int ph_lo, ph_hi, rep_mask, pad_;
};

__device__ __forceinline__ bf16_t f2bf(float f) { unsigned u = __float_as_uint(f); u += 0x7fffu + ((u >> 16) & 1u); return (bf16_t)(u >> 16); }
__device__ __forceinline__ float bf2f(unsigned h) { return __uint_as_float(h << 16); }
typedef __bf16 bf16x2_t __attribute__((ext_vector_type(2)));
typedef float f32x2_t __attribute__((ext_vector_type(2)));
__device__ __forceinline__ unsigned pack2(float lo, float hi) { const f32x2_t f = {lo, hi}; return __builtin_bit_cast(unsigned, __builtin_convertvector(f, bf16x2_t)); }
__device__ __forceinline__ u32x2 pack4(f32x4 v) { u32x2 r; r.x = pack2(v[0], v[1]); r.y = pack2(v[2], v[3]); return r; }
__device__ __forceinline__ f32x4 unpack4(u32x2 u) { f32x4 r; r[0] = bf2f(u.x & 0xffffu); r[1] = bf2f(u.x >> 16); r[2] = bf2f(u.y & 0xffffu); r[3] = bf2f(u.y >> 16); return r; }
__device__ __forceinline__ float rows_max(float v) {
    u32x2 r = __builtin_amdgcn_permlane16_swap(__float_as_uint(v), __float_as_uint(v), false, false);
    v = fmaxf(__uint_as_float(r.x), __uint_as_float(r.y));
    r = __builtin_amdgcn_permlane32_swap(__float_as_uint(v), __float_as_uint(v), false, false);
    return fmaxf(__uint_as_float(r.x), __uint_as_float(r.y));
}
__device__ __forceinline__ float rows_sum(float v) {
    u32x2 r = __builtin_amdgcn_permlane16_swap(__float_as_uint(v), __float_as_uint(v), false, false);
    v = __uint_as_float(r.x) + __uint_as_float(r.y);
    r = __builtin_amdgcn_permlane32_swap(__float_as_uint(v), __float_as_uint(v), false, false);
    return __uint_as_float(r.x) + __uint_as_float(r.y);
}
__device__ __forceinline__ float wave_sum(float v) {
    v += __int_as_float(__builtin_amdgcn_mov_dpp(__float_as_int(v), 0xB1, 0xF, 0xF, true));
    v += __int_as_float(__builtin_amdgcn_mov_dpp(__float_as_int(v), 0x4E, 0xF, 0xF, true));
    v += __int_as_float(__builtin_amdgcn_mov_dpp(__float_as_int(v), 0x141, 0xF, 0xF, true));
    v += __int_as_float(__builtin_amdgcn_mov_dpp(__float_as_int(v), 0x140, 0xF, 0xF, true));
    return rows_sum(v);
}
__device__ __forceinline__ float sigmoidf_(float x) { return 1.f / (1.f + __expf(-x)); }
__device__ __forceinline__ int ltid() { int t = threadIdx.x; asm volatile("" : "+v"(t)); return t; }
__device__ __forceinline__ int vzero() { int z; asm volatile("v_mov_b32 %0, 0" : "=v"(z)); return z; }
__device__ __forceinline__ unsigned char* launder(unsigned char* q) { asm volatile("" : "+s"(q)); return q; }
__device__ __forceinline__ void wait_vm0() { asm volatile("s_waitcnt vmcnt(0)" ::: "memory"); }

__device__ __forceinline__ void glds16(const void* g, void* l) {
    __builtin_amdgcn_global_load_lds((const __attribute__((address_space(1))) unsigned*)g,
                                     (__attribute__((address_space(3))) unsigned*)l, 16, 0, 0);
}
__device__ __forceinline__ f32x4 mfma16(bf16x8 a, bf16x8 b, f32x4 c) { return __builtin_amdgcn_mfma_f32_16x16x32_bf16(a, b, c, 0, 0, 0); }

#define WAIT_V(n) asm volatile("s_waitcnt vmcnt(%0)" ::"n"(n) : "memory")
#define RAW_BARRIER() do { asm volatile("s_waitcnt lgkmcnt(0)" ::: "memory"); __builtin_amdgcn_s_barrier(); } while (0)
__device__ __forceinline__ void bglds16(__amdgpu_buffer_rsrc_t r, unsigned voff, int soff, void* l) {
    __builtin_amdgcn_raw_ptr_buffer_load_lds(r, (__attribute__((address_space(3))) void*)l, 16, (int)voff, soff, 0, 0);
}
template <int NJ, bool GN>
__device__ __forceinline__ void gemm8_stage(__amdgpu_buffer_rsrc_t mr, int mld, unsigned mvo, __amdgpu_buffer_rsrc_t nr, int nld, const unsigned (&nvo)[NJ], int kt, unsigned char* st, int wid) {
#pragma unroll
    for (int i = 0; i < 4; ++i) bglds16(mr, mvo, (64 * i * mld + kt * 64) * 2, st + (8 * i + wid) * 1024);
#pragma unroll
    for (int i = 0; i < NJ; ++i) bglds16(nr, nvo[i], ((GN ? 0 : 64 * i * nld) + kt * 64) * 2, st + 32768 + (8 * i + wid) * 1024);
}
template <int NJ, bool GN>
__device__ __forceinline__ void gemm8_kloop(const bf16_t* mb, int mld, unsigned mvo, const bf16_t* nb, int nld, const unsigned (&nvo)[NJ], int nk, unsigned char* lds, f32x4 (&acc)[8][NJ], int tid) {
    const int lane = tid & 63, wid = tid >> 6, wr = wid >> 2, wc = wid & 3, fr = lane & 15, fq = lane >> 4;
    const __amdgpu_buffer_rsrc_t mr = __builtin_amdgcn_make_buffer_rsrc((void*)mb, 0, 0x7fffffff, 0x00020000);
    const __amdgpu_buffer_rsrc_t nr = __builtin_amdgcn_make_buffer_rsrc((void*)nb, 0, 0x7fffffff, 0x00020000);
    gemm8_stage<NJ, GN>(mr, mld, mvo, nr, nld, nvo, 0, lds, wid);
    gemm8_stage<NJ, GN>(mr, mld, mvo, nr, nld, nvo, 1, lds + 65536, wid);
    for (int kt = 0; kt < nk; ++kt) {
        unsigned char* cur = lds + (kt & 1) * 65536;
        if (kt + 1 < nk) WAIT_V(4 + NJ); else WAIT_V(0);
        RAW_BARRIER();
        bf16x8 a[4], b[NJ];
        const unsigned char* ab = cur + (128 * wr + fr) * 128;
        const unsigned char* bb = cur + 32768 + (16 * NJ * wc + fr) * 128;
        const int sw0 = ((fq) ^ (fr & 7)) << 4, sw1 = ((4 + fq) ^ (fr & 7)) << 4;
#pragma unroll
        for (int j = 0; j < NJ; ++j) b[j] = *(const bf16x8*)(bb + j * 2048 + sw0);
#pragma unroll
        for (int mh = 0; mh < 2; ++mh) {
#pragma unroll
            for (int i = 0; i < 4; ++i) a[i] = *(const bf16x8*)(ab + (4 * mh + i) * 2048 + sw0);
#pragma unroll
            for (int i = 0; i < 4; ++i)
#pragma unroll
                for (int j = 0; j < NJ; ++j) acc[4 * mh + i][j] = mfma16(a[i], b[j], acc[4 * mh + i][j]);
        }
#pragma unroll
        for (int j = 0; j < NJ; ++j) b[j] = *(const bf16x8*)(bb + j * 2048 + sw1);
#pragma unroll
        for (int i = 0; i < 4; ++i) a[i] = *(const bf16x8*)(ab + i * 2048 + sw1);
#pragma unroll
        for (int i = 0; i < 4; ++i)
#pragma unroll
            for (int j = 0; j < NJ; ++j) acc[i][j] = mfma16(a[i], b[j], acc[i][j]);
#pragma unroll
        for (int i = 0; i < 4; ++i) a[i] = *(const bf16x8*)(ab + (4 + i) * 2048 + sw1);
        RAW_BARRIER();
        if (kt + 2 < nk) gemm8_stage<NJ, GN>(mr, mld, mvo, nr, nld, nvo, kt + 2, cur, wid);
#pragma unroll
        for (int i = 0; i < 4; ++i)
#pragma unroll
            for (int j = 0; j < NJ; ++j) acc[4 + i][j] = mfma16(a[i], b[j], acc[4 + i][j]);
    }
    __syncthreads();
    __builtin_amdgcn_sched_barrier(0);
}
template <int NJ>
__device__ __forceinline__ void zero_acc8(f32x4 (&acc)[8][NJ]) {
#pragma unroll
    for (int i = 0; i < 8; ++i)
#pragma unroll
        for (int j = 0; j < NJ; ++j) acc[i][j] = (f32x4){0.f, 0.f, 0.f, 0.f};
}

namespace pg8 {
#define PG8_LAS __attribute__((address_space(3)))
constexpr int BM = 256, BK = 64, HALF = 128, HTB = HALF * BK * 2, STAGE_BYTES = 8 * HTB;
__device__ __forceinline__ int lds_byte(int r, int c) { const int st = (r >> 4) * 2 + (c >> 5), rr = r & 15, cc = c & 31, ob = rr * 64 + cc * 2; return st * 1024 + (ob ^ (((ob >> 9) & 1) << 5)); }
__device__ __forceinline__ void stage_rc(int b, int& R, int& C) { const int st = b / 1024, sb = b % 1024, swz = sb ^ (((sb >> 9) & 1) << 5); R = (st >> 1) * 16 + swz / 64; C = (st & 1) * 32 + (swz % 64) / 2; }
__device__ __forceinline__ int perm32(int rho) { const int n = rho >> 4, i = rho & 15; return 8 * (i >> 2) + 4 * n + (i & 3); }
struct Unit { int pm, pn; };
template <class Epi, class Sched>
__device__ __forceinline__ void gemm_phase(unsigned char* lds_, const int K, const Sched& S, const Epi& E, const int tid, const unsigned char* wsbase) {
    PG8_LAS unsigned char* lds = (PG8_LAS unsigned char*)lds_;
    const int wid = __builtin_amdgcn_readfirstlane(tid >> 6), lane = tid & 63, wr = wid >> 2, wc = wid & 3, fr = lane & 15, fq = lane >> 4;
    const int nt = K / BK;
    unsigned voffA[2], voffB[2];
#pragma unroll
    for (int i = 0; i < 2; ++i) { int R, C; stage_rc(tid * 16 + i * 8192, R, C); const int Rb = (R & ~31) + perm32(R & 31);
        voffA[i] = (unsigned)(R * K + C) * 2u; voffB[i] = (unsigned)(Rb * K + C) * 2u; }
    const unsigned kstep = (unsigned)(BK * 2);
    const unsigned hstep = (unsigned)HALF * K * 2;
    const __amdgpu_buffer_rsrc_t rsrc = __builtin_amdgcn_make_buffer_rsrc((void*)wsbase, 0, 0x7fffffff, 0x00020000);
    const unsigned ldsw = (unsigned)wid * 1024u;
    const int aoff = lds_byte(wr * 64 + fr, fq * 8), boff = lds_byte(wc * 32 + fr, fq * 8);
#define PG8_SA(b, h) (((b) * 2 + (h)) * HTB)
#define PG8_SB(b, h) ((4 + (b) * 2 + (h)) * HTB)
#define PG8_STAGE(bufoff, gbase, voff) do { _Pragma("unroll") for (int _i = 0; _i < 2; ++_i) \
        __builtin_amdgcn_raw_ptr_buffer_load_lds(rsrc, (PG8_LAS void*)(lds + (bufoff) + ldsw + _i * 8192), 16, (int)(voff)[_i], (int)(gbase), 0, 0); } while (0)
#define PG8_LDA(dst, b, h) do { _Pragma("unroll") for (int m = 0; m < 4; ++m) _Pragma("unroll") for (int k = 0; k < 2; ++k) dst[m][k] = *(const PG8_LAS bf16x8*)(lds + PG8_SA(b, h) + aoff + m * 2048 + k * 1024); } while (0)
#define PG8_LDB(dst, b, h) do { _Pragma("unroll") for (int n = 0; n < 2; ++n) _Pragma("unroll") for (int k = 0; k < 2; ++k) dst[n][k] = *(const PG8_LAS bf16x8*)(lds + PG8_SB(b, h) + boff + n * 2048 + k * 1024); } while (0)
#define PG8_MMA(ai, bj, At, Bt) do { __builtin_amdgcn_s_setprio(1); _Pragma("unroll") for (int m = 0; m < 4; ++m) _Pragma("unroll") for (int n = 0; n < 2; ++n) _Pragma("unroll") for (int k = 0; k < 2; ++k) \
        acc[ai][bj][m][n] = __builtin_amdgcn_mfma_f32_16x16x32_bf16(Bt[n][k], At[m][k], acc[ai][bj][m][n], 0, 0, 0); __builtin_amdgcn_s_setprio(0); } while (0)
#define PG8_WAIT_V(n) asm volatile("s_waitcnt vmcnt(" #n ")" ::: "memory")
#define PG8_WAIT_L(n) asm volatile("s_waitcnt lgkmcnt(" #n ")" ::: "memory")
#define PG8_BAR __builtin_amdgcn_s_barrier()
#define PG8_SCHED __builtin_amdgcn_sched_barrier(0)
    typename Sched::U cur, nxt; int ui = 0;
    if (!S.next(0, cur)) return;
    unsigned cA, cB; S.ptrs(cur, cA, cB);
    constexpr bool GA = Sched::GATHER;
    unsigned vA[2], nvA[2];
    if constexpr (GA) { S.rows(cur, tid, vA); nvA[0] = vA[0]; nvA[1] = vA[1]; }
#define PG8_STAGE_G(bufoff, gbase, pk) do { const unsigned _cb = voffB[0] & (unsigned)(2 * K - 1); unsigned _vo[2] = {(((pk) & 0xffffu) * (unsigned)(2 * K)) + _cb, (((pk) >> 16) * (unsigned)(2 * K)) + _cb}; PG8_STAGE(bufoff, gbase, _vo); } while (0)
#define PG8_STAGE_A(bufoff, gbase, h, nextu) do { if constexpr (GA) { if (nextu) PG8_STAGE_G(bufoff, gbase, nvA[h]); else PG8_STAGE_G(bufoff, gbase, vA[h]); } \
        else PG8_STAGE(bufoff, (gbase) + (h) * hstep, voffA); } while (0)
    PG8_STAGE(PG8_SB(0, 0), cB, voffB); PG8_STAGE_A(PG8_SA(0, 0), cA, 0, false); PG8_STAGE(PG8_SB(0, 1), cB + hstep, voffB); PG8_STAGE_A(PG8_SA(0, 1), cA, 1, false);
    if (wr == 1) PG8_BAR;
    PG8_WAIT_V(4); PG8_BAR;
    PG8_STAGE(PG8_SB(1, 0), cB + kstep, voffB); PG8_STAGE_A(PG8_SA(1, 0), cA + kstep, 0, false); PG8_STAGE(PG8_SB(1, 1), cB + hstep + kstep, voffB);
    PG8_WAIT_V(6); PG8_BAR;
    PG8_SCHED;
    f32x4 acc[2][2][4][2];
#pragma unroll
    for (int a = 0; a < 2; ++a)
#pragma unroll
        for (int b = 0; b < 2; ++b)
#pragma unroll
            for (int m = 0; m < 4; ++m)
#pragma unroll
                for (int n = 0; n < 2; ++n) acc[a][b][m][n] = (f32x4){0.f, 0.f, 0.f, 0.f};
    bf16x8 At[4][2], B0[2][2], B1[2][2];
    for (;;) {
        const bool has_next = S.next(ui + 1, nxt);
        unsigned nA = cA, nB = cB; if (has_next) S.ptrs(nxt, nA, nB);
        if constexpr (GA) { if (has_next) S.rows(nxt, tid, nvA); }
        for (int t = 0; t < nt; t += 2) {
            if constexpr (Epi::MID_T > 0) { if (t == Epi::MID_T) E.mid(acc, cur, wr, wc, fr, fq); }
            const bool last = (t == nt - 2);
            const unsigned a1 = cA + (unsigned)(t + 1) * kstep;
            const unsigned a2 = last ? nA : cA + (unsigned)(t + 2) * kstep, b2 = last ? nB : cB + (unsigned)(t + 2) * kstep;
            const unsigned a3 = a2 + kstep, b3 = b2 + kstep;
            PG8_LDB(B0, 0, 0); PG8_SCHED; PG8_LDA(At, 0, 0); PG8_STAGE_A(PG8_SA(1, 1), a1, 1, false);
            PG8_WAIT_L(8); PG8_BAR; PG8_WAIT_L(0); PG8_MMA(0, 0, At, B0); PG8_BAR; PG8_SCHED;
            PG8_LDB(B1, 0, 1); PG8_STAGE(PG8_SB(0, 0), b2, voffB);
            PG8_BAR; PG8_WAIT_L(0); PG8_MMA(0, 1, At, B1); PG8_BAR;
            PG8_LDA(At, 0, 1); PG8_STAGE_A(PG8_SA(0, 0), a2, 0, last);
            PG8_BAR; PG8_WAIT_L(0); PG8_MMA(1, 0, At, B0); PG8_BAR; PG8_SCHED;
            PG8_STAGE(PG8_SB(0, 1), b2 + hstep, voffB);
            PG8_WAIT_V(6); PG8_BAR; PG8_MMA(1, 1, At, B1); PG8_BAR;
            PG8_LDB(B0, 1, 0); PG8_SCHED; PG8_LDA(At, 1, 0); PG8_STAGE_A(PG8_SA(0, 1), a2, 1, last);
            PG8_WAIT_L(8); PG8_BAR; PG8_WAIT_L(0); PG8_MMA(0, 0, At, B0); PG8_BAR; PG8_SCHED;
            PG8_LDB(B1, 1, 1); PG8_STAGE(PG8_SB(1, 0), b3, voffB);
            PG8_BAR; PG8_WAIT_L(0); PG8_MMA(0, 1, At, B1); PG8_BAR;
            PG8_LDA(At, 1, 1); PG8_STAGE_A(PG8_SA(1, 0), a3, 0, last);
            PG8_BAR; PG8_WAIT_L(0); PG8_MMA(1, 0, At, B0); PG8_BAR; PG8_SCHED;
            PG8_STAGE(PG8_SB(1, 1), b3 + hstep, voffB);
            PG8_WAIT_V(6); PG8_BAR; PG8_MMA(1, 1, At, B1); PG8_BAR;
        }
        E(acc, cur, wr, wc, fr, fq);
        if (!has_next) break;
#pragma unroll
        for (int a = 0; a < 2; ++a)
#pragma unroll
            for (int b = 0; b < 2; ++b)
#pragma unroll
                for (int m = 0; m < 4; ++m)
#pragma unroll
                    for (int n = 0; n < 2; ++n) acc[a][b][m][n] = (f32x4){0.f, 0.f, 0.f, 0.f};
        cur = nxt; cA = nA; cB = nB; ++ui;
        if constexpr (GA) { vA[0] = nvA[0]; vA[1] = nvA[1]; }
    }
    PG8_WAIT_V(0);
    if (wr == 0) PG8_BAR;
    PG8_BAR;
#undef PG8_SA
#undef PG8_SB
#undef PG8_STAGE
#undef PG8_STAGE_A
#undef PG8_STAGE_G
#undef PG8_LDA
#undef PG8_LDB
#undef PG8_MMA
#undef PG8_WAIT_V
#undef PG8_WAIT_L
#undef PG8_BAR
#undef PG8_SCHED
}
}

struct TJob { const float* src; bf16_t* dst; int ld, k0, n0, mode, kdst; };
__device__ __forceinline__ void tcvt_load(const TJob& J, float4 (&v)[4], int tid) {
#pragma unroll
    for (int i = 0; i < 4; ++i) {
        const int kk = (tid >> 4) + 16 * i, c4 = (tid & 15) * 4, cd = J.n0 + c4;
        int orig = cd; bool ok = true;
        if (J.mode == 1) {
            if (cd < 896) orig = cd;
            else if (cd < 1024) orig = cd - 896 + 1024;
            else if (cd < 2048) { const int q = cd - 1024, hd = q >> 6, pp = q & 63;
                const int d = (pp & 4) ? 32 + 4 * (pp >> 3) + (pp & 3) : 4 * (pp >> 3) + (pp & 3);
                orig = 1304 + hd * 64 + d; }
            else if (cd < 5120) orig = cd - 2048 + 3352;
            else if (cd < 5144) orig = cd - 5120 + 1280;
            else if (cd < 5376) ok = false;
            else if (cd < 5504) orig = cd - 5376 + 896;
            else if (cd < 5632) orig = cd - 5504 + 1152;
            else orig = cd - 5632 + 2328;
        }
        v[i] = make_float4(0.f, 0.f, 0.f, 0.f);
        if (ok) v[i] = *(const float4*)(J.src + (size_t)(J.k0 + kk) * J.ld + orig);
    }
}
__device__ __forceinline__ void tcvt_finish(const TJob& J, const float4 (&v)[4], unsigned char* lds, int tid) {
    float* tile = (float*)lds;
#pragma unroll
    for (int i = 0; i < 4; ++i) {
        const int kk = (tid >> 4) + 16 * i, c4 = (tid & 15) * 4;
        tile[kk * 65 + c4 + 0] = v[i].x; tile[kk * 65 + c4 + 1] = v[i].y; tile[kk * 65 + c4 + 2] = v[i].z; tile[kk * 65 + c4 + 3] = v[i].w;
    }
    __syncthreads();
#pragma unroll
    for (int i = 0; i < 2; ++i) {
        const int q = tid + 256 * i, n = q >> 3, kc = q & 7;
        float x[8];
#pragma unroll
        for (int j = 0; j < 8; ++j) x[j] = tile[(kc * 8 + j) * 65 + n];
        u32x4 w; w.x = pack2(x[0], x[1]); w.y = pack2(x[2], x[3]); w.z = pack2(x[4], x[5]); w.w = pack2(x[6], x[7]);
        int drow = J.n0 + n; if (J.mode >= 2) drow = 8 * (drow >> 2) + (drow & 3) + (J.mode == 3 ? 4 : 0);
        *(u32x4*)(J.dst + (size_t)drow * J.kdst + J.k0 + kc * 8) = w;
    }
    __syncthreads();
}
__device__ __forceinline__ void tcvt_tile(const float* src, int ld_src, int k0, int n0, int mode, bf16_t* dst, int kdst, unsigned char* lds, int half) {
    TJob J; J.src = src; J.dst = dst; J.ld = ld_src; J.k0 = k0; J.n0 = n0; J.mode = mode; J.kdst = kdst;
    const int tid = (ltid() & 255); float4 v[4];
    tcvt_load(J, v, tid); tcvt_finish(J, v, lds, tid);
}

__device__ __forceinline__ void tcvt_decode(const Params& p, unsigned char* ws, int layer, int t, TJob& J) {
    constexpr int J0 = 16 * 104, J1 = 8 * 16, J2 = 256, J3 = 256, J4 = 2048, J5 = 2048;
    int u = t;
        if (u < J0) { J.src = p.w_in + (size_t)layer * 1024 * DIN; J.ld = DIN; J.k0 = (u % 16) * 64; J.n0 = (u / 16) * 64; J.mode = 1; J.dst = (bf16_t*)(ws + WS_WIN); J.kdst = 1024; return; }
        u -= J0;
        if (u < J1) { J.src = p.w_br_a + (size_t)layer * 512 * 1024; J.ld = 1024; J.k0 = (u % 8) * 64; J.n0 = (u / 8) * 64; J.mode = 0; J.dst = (bf16_t*)(ws + WS_WA); J.kdst = 1536; return; }
        u -= J1;
        if (u < J2) { J.src = p.w_br_b + (size_t)layer * 1024 * 1024; J.ld = 1024; J.k0 = (u % 16) * 64; J.n0 = (u / 16) * 64; J.mode = 0; J.dst = (bf16_t*)(ws + WS_WA) + 512; J.kdst = 1536; return; }
        u -= J2;
        if (u < J3) { J.src = p.w_o + (size_t)layer * 1024 * 1024; J.ld = 1024; J.k0 = (u % 16) * 64; J.n0 = (u / 16) * 64; J.mode = 0; J.dst = (bf16_t*)(ws + WS_WO); J.kdst = 1024; return; }
        u -= J3;
        if (u < J4 + J5) {
            const bool up = u >= J4; if (up) u -= J4;
            const int e = u / 128, v = u % 128;
            J.src = (up ? p.w_up : p.w_gate) + ((size_t)layer * NE + e) * 1024 * 512; J.ld = 512; J.k0 = (v % 16) * 64; J.n0 = (v / 16) * 64; J.mode = up ? 3 : 2;
            J.dst = (bf16_t*)(ws + WS_WG) + (size_t)e * 1024 * 1024; J.kdst = 1024; return;
        }
        u -= J4 + J5;
        { const int e = u / 128, v = u % 128;
          J.src = p.w_down + ((size_t)layer * NE + e) * 512 * 1024; J.ld = 1024; J.k0 = (v % 8) * 64; J.n0 = (v / 8) * 64; J.mode = 0; J.dst = (bf16_t*)(ws + WS_WD) + (size_t)e * 1024 * 512; J.kdst = 512; }
}


__device__ __forceinline__ void phase_pw(const Params& p, int layer, unsigned char* lds, int parts, int half, int skip = 0, int split = 0) {
    const int hq = __builtin_amdgcn_readfirstlane(ltid() >> 8);
    if ((int)(blockIdx.x * 2 + hq) < skip) return;
    constexpr int MOE_A = 2048, MOE_B = 1024;
    const int bid = split == 1 ? ((int)blockIdx.x - (int)(gridDim.x >> 1)) * 2 + hq : (blockIdx.x * 2 + hq) - skip, nblk = split == 1 ? (int)gridDim.x : split == 3 ? (int)(gridDim.x >> 1) : (gridDim.x * 2) - skip, tid = (ltid() & 255);
    if (bid < 0 || (split == 3 && bid >= nblk)) return;
    unsigned char* ws = launder(p.ws);
    constexpr int J0 = 16 * 104, J1 = 8 * 16, J2 = 256, J3 = 256, J4 = 2048, J5 = 2048, J6 = 2048, JT = J0 + J1 + J2 + J3 + J4 + J5 + J6;
    const int t_lo = ((parts & 1) ? 0 : (parts & 2) ? J0 : J0 + J1 + J2 + J3) + (split == 2 ? MOE_A + MOE_B : split == 3 ? MOE_A : 0);
    const int t_hi = split == 1 ? J0 + J1 + J2 + J3 + MOE_A : split == 3 ? J0 + J1 + J2 + J3 + MOE_A + MOE_B : (parts & 4) ? JT : (parts & 2) ? J0 + J1 + J2 + J3 : (parts & 1) ? J0 : 0;
    if (t_lo + bid < t_hi) {
        float4 v[4]; { TJob J; tcvt_decode(p, ws, layer, t_lo + bid, J); tcvt_load(J, v, tid); }
        for (int t = t_lo + bid; t < t_hi; t += nblk) {
            float4 vn[4];
            if (t + nblk < t_hi) { TJob J; tcvt_decode(p, ws, layer, t + nblk, J); tcvt_load(J, vn, tid); }
            { TJob J; tcvt_decode(p, ws, layer, t, J); tcvt_finish(J, v, lds, tid); }
#pragma unroll
            for (int i = 0; i < 4; ++i) v[i] = vn[i];
        }
    }
    if (parts & 16) {
    for (int t = bid; t < 64; t += nblk) {
        const int kv = t >> 5, kt = t & 31;
        const float* w1 = p.cmp_w1 + ((size_t)layer * 2 + kv) * 2048 * 64;
        tcvt_tile(w1, 64, kt * 64, 0, 0, (bf16_t*)(ws + WS_W1T) + (size_t)kv * 64 * 2048, 2048, lds, half);
        const int n = tid & 63, part = tid >> 6;
        const float* pos = p.cmp_pos + ((size_t)layer * 2 + kv) * 2048 + kt * 64 + part * 16;
        const float* wp = w1 + (size_t)(kt * 64 + part * 16) * 64 + n;
        float a = 0.f;
#pragma unroll
        for (int k = 0; k < 16; ++k) a += pos[k] * wp[(size_t)k * 64];
        float* red = (float*)lds;
        __syncthreads(); red[tid] = a; __syncthreads();
        if (tid < 64) ((float*)(ws + WS_CTL) + CW_B1P)[(kv * 32 + kt) * 64 + tid] = red[tid] + red[tid + 64] + red[tid + 128] + red[tid + 192];
        __syncthreads();
    }
    }
    if (parts & 8) {
        const float4* xs = (const float4*)p.x; u32x2* xb = (u32x2*)(ws + WS_XB);
        for (size_t i = (size_t)bid * HT + tid; i < (size_t)T_ * 1024 / 4; i += (size_t)nblk * HT) {
            float4 v = xs[i]; u32x2 w; w.x = pack2(v.x, v.y); w.y = pack2(v.z, v.w); xb[i] = w;
        }
        for (int n = bid * HT + tid; n < 8192; n += nblk * HT) {
            int bk;
            if (n < 16) bk = n;
            else { const int th[15] = {22, 30, 40, 54, 73, 99, 134, 182, 246, 332, 450, 609, 825, 1117, 1513}; bk = 16;
#pragma unroll
                for (int k = 0; k < 15; ++k) bk += (n >= th[k]) ? 1 : 0; }
            (ws + WS_BUCKET)[n] = (unsigned char)bk;
        }
        for (int i = bid * HT + tid; i < 8192 * 32; i += nblk * HT) {
            const int pos = i >> 5, d = i & 31;
            const float inv = powf(10000.f, -(float)d * 2.0f / 64.f);
            const float ang = (float)pos * inv;
            float sn, cs; sincosf(ang, &sn, &cs);
            ((float2*)(ws + WS_ROPE))[i] = make_float2(cs, sn);
        }
        if (bid == 0) for (int i = tid; i < 8192; i += HT) ((unsigned*)(ws + WS_CTL))[i] = 0u;
    }
}

__device__ __forceinline__ float fsig(float x) { return __builtin_amdgcn_rcpf(1.f + __builtin_amdgcn_exp2f(-1.4426950408889634f * x)); }
template <int KIND>
__device__ __forceinline__ void g1_epi(const f32x4 (&acc)[2][2][4][2], unsigned char* ws, int r0, int c0, int wr, int wc, int fr, int fq) {
#pragma unroll
    for (int ai = 0; ai < 2; ++ai)
#pragma unroll
        for (int m = 0; m < 4; ++m) {
            const int row = r0 + 128 * ai + 64 * wr + 16 * m + fr + vzero();
#pragma unroll
            for (int bj = 0; bj < 2; ++bj) {
                const int col = c0 + 128 * bj + 32 * wc + 8 * fq;
                f32x4 v0 = acc[ai][bj][m][0], v1 = acc[ai][bj][m][1];
                if (KIND == 5) {
                    const int b = col >> 13, sq = col & (S_ - 1);
                    bf16_t* dst;
                    if (row < C_VW) { const int c = row - C_VS; dst = (bf16_t*)(ws + WS_VST) + ((size_t)(b * 2 + (c >> 6)) * 64 + (c & 63)) * S_ + sq; }
                    else if (row < C_VR) { const int c = row - C_VW; dst = (bf16_t*)(ws + WS_VWT) + ((size_t)(b * 2 + (c >> 6)) * 64 + (c & 63)) * S_ + sq; }
                    else { const int c = row - C_VR; dst = (bf16_t*)(ws + WS_VRT) + ((size_t)(b * 8 + (c >> 7)) * 128 + (c & 127)) * S_ + sq; }
                    u32x4 w; w.x = pack2(v0[0], v0[1]); w.y = pack2(v0[2], v0[3]); w.z = pack2(v1[0], v1[1]); w.w = pack2(v1[2], v1[3]);
                    *(u32x4*)dst = w;
                    continue;
                }
                if (KIND == 1 || KIND == 2) {
                    const float2* rope = (const float2*)(ws + WS_ROPE);
                    const int pos = row & (S_ - 1), d = 16 * (wc & 1) + 4 * fq;
                    const float4 cs01 = *(const float4*)(rope + pos * 32 + d), cs23 = *(const float4*)(rope + pos * 32 + d + 2);
                    const float c[4] = {cs01.x, cs01.z, cs23.x, cs23.z}, sn[4] = {cs01.y, cs01.w, cs23.y, cs23.w};
                    const float sc = (KIND == 2) ? 0.125f : 1.0f;
                    f32x4 y1, y2;
#pragma unroll
                    for (int r = 0; r < 4; ++r) { y1[r] = (v0[r] * c[r] - v1[r] * sn[r]) * sc; y2[r] = (v0[r] * sn[r] + v1[r] * c[r]) * sc; }
                    v0 = y1; v1 = y2;
                } else if (KIND == 3) {
#pragma unroll
                    for (int r = 0; r < 4; ++r) { v0[r] = v0[r] * fsig(v0[r]); v1[r] = v1[r] * fsig(v1[r]); }
                } else if (KIND == 4) {
#pragma unroll
                    for (int r = 0; r < 4; ++r) { v0[r] = fsig(v0[r]); v1[r] = fsig(v1[r]); }
                }
                u32x4 w; w.x = pack2(v0[0], v0[1]); w.y = pack2(v0[2], v0[3]); w.z = pack2(v1[0], v1[1]); w.w = pack2(v1[2], v1[3]);
                *(u32x4*)((bf16_t*)(ws + WS_P) + (size_t)row * LD + col) = w;
            }
        }
}
struct G1Order {      typedef pg8::Unit U; static constexpr bool GATHER = false;
    int xcd, slot, per;
    __device__ __forceinline__ bool next(int i, pg8::Unit& u) const {
        const int j = slot + i * per; if (j >= 208) return false;
        if (j < 192) { u.pm = j / 3; u.pn = xcd + 8 * (j % 3); } else { const int q = j - 192; u.pm = 8 * xcd + (q >> 1); u.pn = 24 + (q & 1); }
        return true;
    }
    __device__ __forceinline__ void ptrs(const pg8::Unit& u, unsigned& A, unsigned& B) const {
        const unsigned x = (unsigned)WS_XB + (unsigned)u.pm * (256u * 1024u * 2u), w = (unsigned)WS_WIN + (unsigned)u.pn * (256u * 1024u * 2u);
        if (u.pn >= 21) { A = w; B = x; } else { A = x; B = w; }
    }
};
struct G1Epi {
    static constexpr int MID_T = 0;
    unsigned char* ws;
    __device__ __forceinline__ void operator()(const f32x4 (&acc)[2][2][4][2], const pg8::Unit& u, int wr, int wc, int fr, int fq) const {
        const int pn = u.pn, tok0 = u.pm * 256, n0 = pn * 256;
        if (pn >= 21) g1_epi<5>(acc, ws, n0, tok0, wr, wc, fr, fq);
        else if (pn >= 12) g1_epi<4>(acc, ws, tok0, n0, wr, wc, fr, fq);
        else if (pn >= 8) g1_epi<3>(acc, ws, tok0, n0, wr, wc, fr, fq);
        else if (pn >= 6) g1_epi<2>(acc, ws, tok0, n0, wr, wc, fr, fq);
        else if (pn >= 4) g1_epi<1>(acc, ws, tok0, n0, wr, wc, fr, fq);
        else g1_epi<0>(acc, ws, tok0, n0, wr, wc, fr, fq);
    }
};
__device__ __forceinline__ void phase_g1(const Params& p, int layer, unsigned char* lds) {
    unsigned char* ws = launder(p.ws);
    G1Order S; S.xcd = blockIdx.x & 7; S.slot = blockIdx.x >> 3; S.per = gridDim.x >> 3;
    G1Epi E; E.ws = ws;
    pg8::gemm_phase<G1Epi, G1Order>(lds, 1024, S, E, ltid(), ws);
}

__device__ __forceinline__ void load_tile64(const bf16_t* base, size_t rowStride, unsigned char* dst, int wid, int lane) {
    const int c = ((lane & 7) ^ (lane >> 3)) * 8;
#pragma unroll
    for (int i = 0; i < 2; ++i) { const int j = wid + 4 * i, row = 8 * j + (lane >> 3); glds16(base + (size_t)row * rowStride + c, dst + j * 1024); }
}
__device__ __forceinline__ void load_tile128(const bf16_t* base, size_t rowStride, unsigned char* dst, int wid, int lane) {
    const int c = ((lane & 7) ^ (lane >> 3)) * 8;
#pragma unroll
    for (int i = 0; i < 4; ++i) { const int j = wid + 4 * i, row = 8 * j + (lane >> 3); glds16(base + (size_t)row * rowStride + c, dst + j * 1024); }
}
__device__ __forceinline__ void load_tile128w(const bf16_t* base, size_t rowStride, unsigned char* dst, int wid, int lane) {
    const int c = ((lane & 15) ^ ((4 * wid + (lane >> 4)) & 15)) * 8;
#pragma unroll
    for (int i = 0; i < 8; ++i) { const int j = wid + 4 * i, row = 4 * j + (lane >> 4); glds16(base + (size_t)row * rowStride + c, dst + j * 1024); }
}
__device__ __forceinline__ bf16x8 lds_frag128(const unsigned char* tile, int row, int chunk) {
    return *(const bf16x8*)(tile + row * 128 + ((chunk ^ (row & 7)) << 4));
}
__device__ __forceinline__ bf16x8 lds_frag256(const unsigned char* tile, int row, int chunk) {
    return *(const bf16x8*)(tile + row * 256 + ((chunk ^ (row & 15)) << 4));
}
__device__ __forceinline__ bf16x8 lds_vfrag128(const unsigned char* tile, int row, int kbase, int fq) {
    const int ca = (kbase >> 3) + (fq >> 1), hb = (fq & 1) * 8;
    const u32x2 a = *(const u32x2*)(tile + row * 128 + ((ca ^ (row & 7)) << 4) + hb);
    const u32x2 b = *(const u32x2*)(tile + row * 128 + (((ca + 2) ^ (row & 7)) << 4) + hb);
    u32x4 w; w.x = a.x; w.y = a.y; w.z = b.x; w.w = b.y;
    return __builtin_bit_cast(bf16x8, w);
}
__device__ __forceinline__ bf16x8 lds_vfrag256(const unsigned char* tile, int row, int kbase, int fq) {
    const int ca = (kbase >> 3) + (fq >> 1), hb = (fq & 1) * 8;
    const u32x2 a = *(const u32x2*)(tile + row * 256 + ((ca ^ (row & 15)) << 4) + hb);
    const u32x2 b = *(const u32x2*)(tile + row * 256 + (((ca + 2) ^ (row & 15)) << 4) + hb);
    u32x4 w; w.x = a.x; w.y = a.y; w.z = b.x; w.w = b.y;
    return __builtin_bit_cast(bf16x8, w);
}
__device__ __forceinline__ bf16x8 pack8(f32x4 a, f32x4 b) {
    u32x4 w; w.x = pack2(a[0], a[1]); w.y = pack2(a[2], a[3]); w.z = pack2(b[0], b[1]); w.w = pack2(b[2], b[3]);
    return __builtin_bit_cast(bf16x8, w);
}

__device__ __forceinline__ float gelu_tanh(float x) {
    const float u = 0.7978845608028654f * (x + 0.044715f * x * x * x);
    return 0.5f * x * (1.f + tanhf(u));
}
__device__ __forceinline__ void compress_item(const Params& p, int layer, int item, unsigned char* lds, int half) {
    unsigned char* ws = launder(p.ws);
    const int tid = (ltid() & 255), lane = tid & 63, wid = tid >> 6, wr = wid >> 1, wc = wid & 1, fr = lane & 15, fq = lane >> 4;
    const int mtile = item & 3, g = (item >> 2) & 1, b = (item >> 3) & 1, kv = item >> 4;
    const int i0 = mtile * 128;
    const bf16_t* P = (const bf16_t*)(ws + WS_P);
    const bf16_t* W1T = (const bf16_t*)(ws + WS_W1T) + (size_t)kv * 64 * 2048;
    const int col = (kv ? C_VC : C_KC) + g * 64;
    const int ldc = ((lane & 7) ^ (lane >> 3)) * 8;
    const int l0 = 16 * half;
    const bf16_t* ap[4];
#pragma unroll
    for (int i = 0; i < 4; ++i) ap[i] = P + ((size_t)b * S_ + 16 * (i0 + 32 * i + 8 * wid + (lane >> 3)) + l0) * LD + col + ldc;
    const bf16_t* bp[2];
#pragma unroll
    for (int i = 0; i < 2; ++i) bp[i] = W1T + (size_t)(8 * (wid + 4 * i) + (lane >> 3)) * 2048 + l0 * 64 + ldc;
    f32x4 acc[4][2];
#pragma unroll
    for (int i = 0; i < 4; ++i)
#pragma unroll
        for (int j = 0; j < 2; ++j) acc[i][j] = (f32x4){0.f, 0.f, 0.f, 0.f};
    __syncthreads();
#define CSTAGE(buf, l) do { unsigned char* st_ = lds + (buf) * 24576; \
        _Pragma("unroll") for (int i = 0; i < 4; ++i) glds16(ap[i] + (size_t)(l) * LD, st_ + (4 * i + wid) * 1024); \
        _Pragma("unroll") for (int i = 0; i < 2; ++i) glds16(bp[i] + (l) * 64, st_ + 16384 + (wid + 4 * i) * 1024); } while (0)
    CSTAGE(0, 0); CSTAGE(1, 1);
    for (int l = 0; l < 16; ++l) {
        const unsigned char* st = lds + (l % 3) * 24576;
        if (l + 1 < 16) WAIT_V(6); else WAIT_V(0);
        RAW_BARRIER();
        if (l + 2 < 16) CSTAGE((l + 2) % 3, l + 2);
#pragma unroll
        for (int ks = 0; ks < 2; ++ks) {
            bf16x8 a[4], bb[2];
#pragma unroll
            for (int i = 0; i < 4; ++i) a[i] = lds_frag128(st, 64 * wr + 16 * i + fr, 4 * ks + fq);
#pragma unroll
            for (int j = 0; j < 2; ++j) bb[j] = lds_frag128(st + 16384, 32 * wc + 16 * j + fr, 4 * ks + fq);
#pragma unroll
            for (int i = 0; i < 4; ++i)
#pragma unroll
                for (int j = 0; j < 2; ++j) acc[i][j] = mfma16(a[i], bb[j], acc[i][j]);
        }
    }
    __syncthreads();
#undef CSTAGE
    float* xch = (float*)(lds - half * HALF_LDS + HALF_LDS);
    if (half == 1) {
#pragma unroll
        for (int i = 0; i < 4; ++i)
#pragma unroll
            for (int j = 0; j < 2; ++j)
#pragma unroll
                for (int r = 0; r < 4; ++r) xch[((i * 2 + j) * 4 + r) * 256 + tid] = acc[i][j][r];
    }
    __syncthreads();
    if (half == 0) {
        const float* b1 = (const float*)(ws + WS_CTL) + CW_B1P + kv * 32 * 64;
#pragma unroll
        for (int j = 0; j < 2; ++j) {
            const int n = 32 * wc + 16 * j + fr; float bias = 0.f;
#pragma unroll
            for (int kt = 0; kt < 32; ++kt) bias += b1[kt * 64 + n + vzero()];
#pragma unroll
            for (int i = 0; i < 4; ++i)
#pragma unroll
                for (int r = 0; r < 4; ++r) {
                    const int row = 64 * wr + 16 * i + 4 * fq + r;
                    const float hv = gelu_tanh(acc[i][j][r] + xch[((i * 2 + j) * 4 + r) * 256 + tid] + bias);
                    *(bf16_t*)(lds + row * 128 + (((n >> 3) ^ (row & 7)) << 4) + (n & 7) * 2) = f2bf(hv);
                }
        }
        const float* w2 = p.cmp_w2 + ((size_t)layer * 2 + kv) * 64 * 64;
        const int k = tid >> 2, n0 = (tid & 3) * 16;
#pragma unroll
        for (int q4 = 0; q4 < 4; ++q4) {
            const float4 w = *(const float4*)(w2 + k * 64 + n0 + 4 * q4);
            const float wv[4] = {w.x, w.y, w.z, w.w};
#pragma unroll
            for (int e = 0; e < 4; ++e) { const int n = n0 + 4 * q4 + e; *(bf16_t*)(lds + 16384 + n * 128 + (((k >> 3) ^ (n & 7)) << 4) + (k & 7) * 2) = f2bf(wv[e]); }
        }
    }
    __syncthreads();
    if (half == 0) {
        f32x4 o[4][2];
#pragma unroll
        for (int i = 0; i < 4; ++i)
#pragma unroll
            for (int j = 0; j < 2; ++j) o[i][j] = (f32x4){0.f, 0.f, 0.f, 0.f};
#pragma unroll
        for (int ks = 0; ks < 2; ++ks) {
            bf16x8 a[4], bb[2];
#pragma unroll
            for (int i = 0; i < 4; ++i) a[i] = lds_frag128(lds, 64 * wr + 16 * i + fr, 4 * ks + fq);
#pragma unroll
            for (int j = 0; j < 2; ++j) bb[j] = lds_frag128(lds + 16384, 32 * wc + 16 * j + fr, 4 * ks + fq);
#pragma unroll
            for (int i = 0; i < 4; ++i)
#pragma unroll
                for (int j = 0; j < 2; ++j) o[i][j] = mfma16(a[i], bb[j], o[i][j]);
        }
#pragma unroll
        for (int i = 0; i < 4; ++i)
#pragma unroll
            for (int j = 0; j < 2; ++j) {
                const int n = 32 * wc + 16 * j + fr, ci = i0 + 64 * wr + 16 * i + 4 * fq;
                f32x4 v = o[i][j];
#pragma unroll
                for (int r = 0; r < 4; ++r) if (ci + r >= 511) v[r] = 0.f;
                if (kv == 0) {
                    bf16_t* dst = (bf16_t*)(ws + WS_KCC) + ((size_t)(b * 2 + g) * 512 + ci) * 64 + n;
#pragma unroll
                    for (int r = 0; r < 4; ++r) dst[r * 64] = f2bf(v[r]);
                } else {
                    *(u32x2*)((bf16_t*)(ws + WS_VCCT) + ((size_t)(b * 2 + g) * 64 + n) * 512 + ci) = pack4(v);
                }
            }
    }
    __syncthreads();
}

__device__ __forceinline__ float ret_lg2(int h) { const float gam = 1.f - exp2f(-5.f - (float)h); return log2f(gam); }

__device__ __forceinline__ void retkv_item(const Params& p, int item, unsigned char* lds, int half) {
    unsigned char* ws = launder(p.ws);
    const int tid = (ltid() & 255), lane = tid & 63, wid = tid >> 6, fr = lane & 15, fq = lane >> 4;
    const int n = item & 63, h = (item >> 6) & 7, b = item >> 9;
    const size_t tok0 = (size_t)b * S_ + 128 * n;
    unsigned char* vL = lds; unsigned char* kL = lds + 32768;
    load_tile128w((const bf16_t*)(ws + WS_VRT) + ((size_t)(b * 8 + h) * 128) * S_ + 128 * n, S_, vL, wid, lane);
    load_tile128((const bf16_t*)(ws + WS_P) + tok0 * LD + C_KR + h * 64, LD, kL, wid, lane);
    wait_vm0(); __syncthreads();
    const float lg2 = ret_lg2(h);
    f32x4 acc[2][4];
#pragma unroll
    for (int m = 0; m < 2; ++m)
#pragma unroll
        for (int nt = 0; nt < 4; ++nt) acc[m][nt] = (f32x4){0.f, 0.f, 0.f, 0.f};
#pragma unroll
    for (int ks = 0; ks < 4; ++ks) {
        bf16x8 a[2], bb[4];
#pragma unroll
        for (int m = 0; m < 2; ++m) a[m] = lds_frag256(vL, 32 * wid + 16 * m + fr, 4 * ks + fq);
        float dec[8];
#pragma unroll
        for (int j = 0; j < 8; ++j) dec[j] = exp2f((float)(127 - (32 * ks + 8 * fq + j)) * lg2);
#pragma unroll
        for (int nt = 0; nt < 4; ++nt) {
            const int d = 16 * nt + fr;
            float v[8];
#pragma unroll
            for (int j = 0; j < 8; ++j) {
                const int tk = 32 * ks + 8 * fq + j;
                const bf16_t kvv = *(const bf16_t*)(kL + tk * 128 + (((d >> 3) ^ (tk & 7)) << 4) + (d & 7) * 2);
                v[j] = bf2f(kvv) * dec[j];
            }
            u32x4 w; w.x = pack2(v[0], v[1]); w.y = pack2(v[2], v[3]); w.z = pack2(v[4], v[5]); w.w = pack2(v[6], v[7]);
            bb[nt] = __builtin_bit_cast(bf16x8, w);
        }
#pragma unroll
        for (int m = 0; m < 2; ++m)
#pragma unroll
            for (int nt = 0; nt < 4; ++nt) acc[m][nt] = mfma16(a[m], bb[nt], acc[m][nt]);
    }
    float* KVT = (float*)(ws + WS_KVT) + ((size_t)(b * 8 + h) * 64 + n) * 8192;
#pragma unroll
    for (int m = 0; m < 2; ++m)
#pragma unroll
        for (int nt = 0; nt < 4; ++nt)
#pragma unroll
            for (int r = 0; r < 4; ++r) KVT[(32 * wid + 16 * m + 4 * fq + r) * 64 + 16 * nt + fr] = acc[m][nt][r];
    __syncthreads();
}

__device__ __forceinline__ void phase_p2(const Params& p, int layer, unsigned char* lds, int half) {
    const int vb = blockIdx.x * 2 + half, nvb = gridDim.x * 2;
    if (vb < 64) compress_item(p, layer, vb >> 1, lds, half);
    else for (int it = vb - 64; it < 1024; it += nvb - 64) retkv_item(p, it, lds, half);
}

constexpr int NSA_IMP = 32768, NSA_BUCKET = 65792, NSA_BIAS = 73984;

struct NsaLane { int t; int fr, fq, wid, lane; };

constexpr float LOG2E = 1.4426950408889634f;
__device__ __forceinline__ int t5_first(int bk) {
    const int th[16] = {16, 22, 30, 40, 54, 73, 99, 134, 182, 246, 332, 450, 609, 825, 1117, 1513};
    int r = 16;
#pragma unroll
    for (int k = 0; k < 16; ++k) r = (bk == 16 + k) ? th[k] : r;
    return r;
}
template <int BR, int PASS>
__device__ __forceinline__ void nsa_half(const unsigned char* kL, const unsigned char* vL, const unsigned char* lds, const bf16x8 (&qptr)[4][2],
                                         f32x4 (&O)[4][4], float (&m)[4], float (&l)[4], int tile, int hf, const NsaLane& L, int qrow, const bool FAST, int th, int b0, int b1) {
    const int fr = L.lane & 15, fq = L.lane >> 4;
    constexpr float C2 = 0.125f * LOG2E;
    bf16x8 Kf[2][2];
#pragma unroll
    for (int i = 0; i < 2; ++i)
#pragma unroll
        for (int ks = 0; ks < 2; ++ks) Kf[i][ks] = lds_frag128(kL, 32 * hf + 16 * i + fr, 4 * ks + fq);
    bf16x8 Vf[4];
    if (PASS != 0) {
#pragma unroll
        for (int mt = 0; mt < 4; ++mt) Vf[mt] = lds_vfrag128(vL, 16 * mt + fr, 32 * hf, fq);
    }
    unsigned vmask = 0; unsigned bk[2] = {0u, 0u}; bool hi[2][4];
    if (!FAST) {
        const unsigned char* bucketL = lds + NSA_BUCKET;
#pragma unroll
        for (int i = 0; i < 2; ++i) {
            unsigned pk = 0;
#pragma unroll
            for (int r = 0; r < 4; ++r) {
                const int kk = 32 * hf + 16 * i + 4 * fq + r;
                int rel; bool ok;
                if (BR == 0) { rel = L.t - (16 * (64 * tile + kk) + 31); ok = rel >= 0; }
                else { rel = L.t - (64 * tile + kk); ok = rel >= 0 && rel < 512; }
                int rc = rel < 0 ? 0 : rel; rc = rc > 8191 ? 8191 : rc;
                pk |= (unsigned)bucketL[rc] << (8 * r);
                vmask |= (ok ? 1u : 0u) << (4 * i + r);
                hi[i][r] = false;
            }
            bk[i] = pk;
        }
    } else {
        const int kbase = 64 * tile + 32 * hf + 4 * fq;
        const int lim = BR == 0 ? L.t - th - 31 - 16 * kbase : L.t - th - kbase;
#pragma unroll
        for (int i = 0; i < 2; ++i)
#pragma unroll
            for (int r = 0; r < 4; ++r) hi[i][r] = (BR == 0 ? 16 : 1) * (16 * i + r) <= lim;
    }
    const float* biasL = (const float*)(lds + NSA_BIAS);
    float ia[2] = {0.f, 0.f}, ic[2] = {0.f, 0.f};
#pragma unroll
    for (int nt = 0; nt < 4; ++nt) {
        f32x4 S[2];
        const bf16x8 q0 = qptr[nt][0], q1 = qptr[nt][1];
#pragma unroll
        for (int i = 0; i < 2; ++i) {
            S[i] = (f32x4){0.f, 0.f, 0.f, 0.f};
            S[i] = mfma16(Kf[i][0], q0, S[i]); S[i] = mfma16(Kf[i][1], q1, S[i]);
        }
        float tmax = -1e30f;
        if (!FAST) {
#pragma unroll
            for (int i = 0; i < 2; ++i) {
                float bsv[4];
#pragma unroll
                for (int r = 0; r < 4; ++r) bsv[r] = biasL[nt * 32 + ((bk[i] >> (8 * r)) & 0xffu)];
                asm volatile("" : "+v"(bsv[0]), "+v"(bsv[1]), "+v"(bsv[2]), "+v"(bsv[3]));
#pragma unroll
                for (int r = 0; r < 4; ++r) {
                    const bool ok = (vmask >> (4 * i + r)) & 1u;
                    const float sv = S[i][r] * C2 + bsv[r];
                    S[i][r] = ok ? sv : -1e30f; tmax = fmaxf(tmax, S[i][r]);
                }
            }
        } else {
            const float blo = biasL[nt * 32 + b0], bhi = biasL[nt * 32 + b1];
#pragma unroll
            for (int i = 0; i < 2; ++i)
#pragma unroll
                for (int r = 0; r < 4; ++r) { S[i][r] = S[i][r] * C2 + (hi[i][r] ? bhi : blo); tmax = fmaxf(tmax, S[i][r]); }
        }
        if (PASS != 1) {
            if (__builtin_amdgcn_ballot_w64(tmax > m[nt] + 8.f) != 0ull) {
                const float tm = rows_max(tmax);
                const float mnew = tm > m[nt] + 8.f ? tm : m[nt], alpha = __builtin_amdgcn_exp2f(m[nt] - mnew);
                l[nt] *= alpha; m[nt] = mnew;
                if (PASS == 2) {
#pragma unroll
                    for (int mt = 0; mt < 4; ++mt) O[mt][nt] = O[mt][nt] * alpha;
                }
            }
            float psum = 0.f;
#pragma unroll
            for (int i = 0; i < 2; ++i)
#pragma unroll
                for (int r = 0; r < 4; ++r) S[i][r] = __builtin_amdgcn_exp2f(S[i][r] - m[nt]);
            if (!FAST) {
#pragma unroll
                for (int i = 0; i < 2; ++i)
#pragma unroll
                    for (int r = 0; r < 4; ++r) { const bool ok = (vmask >> (4 * i + r)) & 1u; S[i][r] = ok ? S[i][r] : 0.f; }
            }
#pragma unroll
            for (int i = 0; i < 2; ++i)
#pragma unroll
                for (int r = 0; r < 4; ++r) psum += S[i][r];
            l[nt] += psum;
        } else {
#pragma unroll
            for (int i = 0; i < 2; ++i) {
#pragma unroll
                for (int r = 0; r < 4; ++r) S[i][r] = __builtin_amdgcn_exp2f(S[i][r] - m[nt]) * l[nt];
            }
            if (!FAST) {
#pragma unroll
                for (int i = 0; i < 2; ++i)
#pragma unroll
                    for (int r = 0; r < 4; ++r) { const bool ok = (vmask >> (4 * i + r)) & 1u; S[i][r] = ok ? S[i][r] : 0.f; }
            }
#pragma unroll
            for (int i = 0; i < 2; ++i) {
                ia[i] += S[i][0] + S[i][1] + S[i][2] + 0.5f * S[i][3];
                ic[i] += 0.5f * S[i][3];
            }
        }
        if (PASS != 0) {
            const bf16x8 Pb = pack8(S[0], S[1]);
#pragma unroll
            for (int mt = 0; mt < 4; ++mt) O[mt][nt] = mfma16(Vf[mt], Pb, O[mt][nt]);
        }
        if (nt & 1) __builtin_amdgcn_sched_barrier(0);
    }
    if (PASS == 1) {
        float* imp = (float*)(lds + NSA_IMP) + qrow * 129;
        asm volatile("" ::: "memory"); __builtin_amdgcn_wave_barrier();
#pragma unroll
        for (int i = 0; i < 2; ++i) { const int j = 16 * tile + 8 * hf + 4 * i + fq; imp[j] += ia[i]; }
        asm volatile("s_waitcnt lgkmcnt(0)" ::: "memory"); __builtin_amdgcn_wave_barrier();
#pragma unroll
        for (int i = 0; i < 2; ++i) { const int j = 16 * tile + 8 * hf + 4 * i + fq + 1; if (j < 128) imp[j] += ic[i]; }
        asm volatile("s_waitcnt lgkmcnt(0)" ::: "memory"); __builtin_amdgcn_wave_barrier();
    }
}
template <int BR, int PASS>
__device__ __forceinline__ void nsa_tile(const unsigned char* kL, const unsigned char* vL, const unsigned char* lds, const bf16x8 (&qptr)[4][2],
                                         f32x4 (&O)[4][4], float (&m)[4], float (&l)[4], int tile, const NsaLane& L, int qrow) {
    const int tq0 = __builtin_amdgcn_readfirstlane(L.t - (L.lane & 15));
#pragma unroll 1
    for (int hf = 0; hf < 2; ++hf) {
        const int kfirst = 64 * tile + 32 * hf, pmin = BR == 0 ? 16 * kfirst + 31 : kfirst, pmax = BR == 0 ? 16 * (kfirst + 31) + 31 : kfirst + 31;
        const int rmin = tq0 - pmax, rmax = tq0 + 15 - pmin;
        bool fast = false; int th = 0, b0 = 0, b1 = 0;
        if (rmin >= 16 && (BR != 2 || rmax < 512)) {
            const unsigned char* bucketL = lds + NSA_BUCKET;
            b0 = __builtin_amdgcn_readfirstlane((int)bucketL[rmin]); b1 = __builtin_amdgcn_readfirstlane((int)bucketL[rmax > 8191 ? 8191 : rmax]);
            if (b1 - b0 <= 1) { fast = true; th = b1 == b0 ? 0 : t5_first(b1); }
        }
        nsa_half<BR, PASS>(kL, vL, lds, qptr, O, m, l, tile, hf, L, qrow, fast, th, b0, b1);
    }
}

__device__ __forceinline__ void cmp_item(const Params& p, int item, unsigned char* lds, int half) {
    unsigned char* ws = launder(p.ws);
    const int tid = (ltid() & 255), lane = tid & 63, wid = tid >> 6, fr = lane & 15, fq = lane >> 4;
    const int combo = item & 3, qt = 127 - (item >> 2), b = combo >> 1, g = combo & 1;
    const int q0 = qt * 64, qrow = 16 * wid + fr;
    NsaLane L; L.t = q0 + qrow; L.fr = fr; L.fq = fq; L.wid = wid; L.lane = lane;
    const size_t tok = (size_t)b * S_ + L.t;
    const bf16_t* P = (const bf16_t*)(ws + WS_P);
    __syncthreads();
    if (tid < 128) ((float*)(lds + NSA_BIAS))[tid] = p.rel_bias[(tid & 31) * 8 + 4 * g + (tid >> 5)] * LOG2E;
    for (int i = tid; i < 64 * 129; i += HT) ((float*)(lds + NSA_IMP))[i] = 0.f;
    bf16x8 Qf[4][2];
#pragma unroll
    for (int nt = 0; nt < 4; ++nt)
#pragma unroll
        for (int ks = 0; ks < 2; ++ks) Qf[nt][ks] = *(const bf16x8*)(P + tok * LD + C_QA + (4 * g + nt) * 64 + 32 * ks + 8 * fq);
    __syncthreads();
    f32x4 O[4][4]; float m[4], l[4];
    const bf16_t* gates = P + tok * LD + C_GA + (4 * g) * 3;
    const bf16_t* kc = (const bf16_t*)(ws + WS_KCC) + (size_t)(b * 2 + g) * 512 * 64;
    const bf16_t* vc = (const bf16_t*)(ws + WS_VCCT) + (size_t)(b * 2 + g) * 64 * 512;
    const int ntc = ((q0 + 32) >> 4) / 64 + 1;
#pragma unroll
    for (int nt = 0; nt < 4; ++nt) { m[nt] = -1e30f; l[nt] = 0.f; }
    load_tile64(kc, 64, lds, wid, lane);
    wait_vm0(); __syncthreads();
    for (int it = 0; it < ntc; ++it) {
        unsigned char* cur = lds + (it & 1) * 16384;
        if (it + 1 < ntc) load_tile64(kc + (size_t)(it + 1) * 64 * 64, 64, lds + ((it + 1) & 1) * 16384, wid, lane);
        nsa_tile<0, 0>(cur, cur + 8192, lds, Qf, O, m, l, it, L, qrow);
        wait_vm0(); __syncthreads();
    }
#pragma unroll
    for (int nt = 0; nt < 4; ++nt) { l[nt] = rows_sum(l[nt]); l[nt] = l[nt] > 0.f ? 1.f / l[nt] : 0.f; }
#pragma unroll
    for (int mt = 0; mt < 4; ++mt)
#pragma unroll
        for (int nt = 0; nt < 4; ++nt) O[mt][nt] = (f32x4){0.f, 0.f, 0.f, 0.f};
    load_tile64(kc, 64, lds, wid, lane); load_tile64(vc, 512, lds + 8192, wid, lane);
    wait_vm0(); __syncthreads();
    for (int it = 0; it < ntc; ++it) {
        unsigned char* cur = lds + (it & 1) * 16384;
        if (it + 1 < ntc) { unsigned char* nx = lds + ((it + 1) & 1) * 16384;
            load_tile64(kc + (size_t)(it + 1) * 64 * 64, 64, nx, wid, lane); load_tile64(vc + (it + 1) * 64, 512, nx + 8192, wid, lane); }
        nsa_tile<0, 1>(cur, cur + 8192, lds, Qf, O, m, l, it, L, qrow);
        wait_vm0(); __syncthreads();
    }
    bf16_t* YC = (bf16_t*)(ws + WS_YC) + tok * 512 + (4 * g) * 64;
#pragma unroll
    for (int nt = 0; nt < 4; ++nt) {
        const float gt = bf2f(gates[nt * 3 + 0]);
#pragma unroll
        for (int mt = 0; mt < 4; ++mt) *(u32x2*)(YC + nt * 64 + 16 * mt + 4 * fq) = pack4(O[mt][nt] * gt);
    }
    const int cur = qt;
    {
        float* imp = (float*)(lds + NSA_IMP) + qrow * 129 + 32 * fq;
        asm volatile("s_waitcnt lgkmcnt(0)" ::: "memory"); __builtin_amdgcn_wave_barrier();
#pragma unroll
        for (int i = 0; i < 32; ++i) {
            const int j = 32 * fq + i;
            const float v = imp[i];
            imp[i] = j > cur ? -1.f : v + ((j == 0 || j == cur || j == cur - 1) ? 1.0e4f : 0.f);
        }
        unsigned word = 0;
#pragma unroll 1
        for (int round = 0; round < 16; ++round) {
            float bv = imp[0]; int bi = 0;
#pragma unroll
            for (int i = 1; i < 32; ++i) { const float v = imp[i]; if (v > bv) { bv = v; bi = i; } }
            int gi = 32 * fq + bi;
            {
                u32x2 rv = __builtin_amdgcn_permlane16_swap(__float_as_uint(bv), __float_as_uint(bv), false, false);
                u32x2 ri = __builtin_amdgcn_permlane16_swap((unsigned)gi, (unsigned)gi, false, false);
                float v0 = __uint_as_float(rv.x), v1 = __uint_as_float(rv.y); int i0 = (int)ri.x, i1 = (int)ri.y;
                if (v1 > v0 || (v1 == v0 && i1 < i0)) { v0 = v1; i0 = i1; }
                rv = __builtin_amdgcn_permlane32_swap(__float_as_uint(v0), __float_as_uint(v0), false, false);
                ri = __builtin_amdgcn_permlane32_swap((unsigned)i0, (unsigned)i0, false, false);
                v0 = __uint_as_float(rv.x); v1 = __uint_as_float(rv.y); i0 = (int)ri.x; i1 = (int)ri.y;
                if (v1 > v0 || (v1 == v0 && i1 < i0)) { v0 = v1; i0 = i1; }
                bv = v0; gi = i0;
            }
            if (bv >= 0.f && (gi >> 5) == fq) { word |= 1u << (gi & 31); imp[gi & 31] = -2.f; }
        }
        ((unsigned*)(ws + WS_SELW))[(tok * 2 + g) * 4 + fq] = word;
    }
}

__device__ __forceinline__ void win_item(const Params& p, int item, unsigned char* lds, int half) {
    unsigned char* ws = launder(p.ws);
    const int tid = (ltid() & 255), lane = tid & 63, wid = tid >> 6, fr = lane & 15, fq = lane >> 4;
    const int combo = item & 3, qt = 127 - (item >> 2), b = combo >> 1, g = combo & 1;
    const int q0 = qt * 64, qrow = 16 * wid + fr;
    NsaLane L; L.t = q0 + qrow; L.fr = fr; L.fq = fq; L.wid = wid; L.lane = lane;
    const size_t tok = (size_t)b * S_ + L.t;
    const bf16_t* P = (const bf16_t*)(ws + WS_P);
    __syncthreads();
    if (tid < 128) ((float*)(lds + NSA_BIAS))[tid] = p.rel_bias[(tid & 31) * 8 + 4 * g + (tid >> 5)] * LOG2E;
    bf16x8 Qf[4][2];
#pragma unroll
    for (int nt = 0; nt < 4; ++nt)
#pragma unroll
        for (int ks = 0; ks < 2; ++ks) Qf[nt][ks] = *(const bf16x8*)(P + tok * LD + C_QA + (4 * g + nt) * 64 + 32 * ks + 8 * fq);
    __syncthreads();
    f32x4 O[4][4]; float m[4], l[4];
    const bf16_t* gates = P + tok * LD + C_GA + (4 * g) * 3;
#pragma unroll
    for (int nt = 0; nt < 4; ++nt) { m[nt] = -1e30f; l[nt] = 0.f; }
#pragma unroll
    for (int mt = 0; mt < 4; ++mt)
#pragma unroll
        for (int nt = 0; nt < 4; ++nt) O[mt][nt] = (f32x4){0.f, 0.f, 0.f, 0.f};
    {
        const bf16_t* kb = P + ((size_t)b * S_) * LD + C_KW + g * 64;
        const bf16_t* vb = (const bf16_t*)(ws + WS_VWT) + (size_t)(b * 2 + g) * 64 * S_;
        const int k_lo = qt - 8 > 0 ? qt - 8 : 0, ntw = qt - k_lo + 1;
        load_tile64(kb + (size_t)k_lo * 64 * LD, LD, lds, wid, lane); load_tile64(vb + k_lo * 64, S_, lds + 8192, wid, lane);
        wait_vm0(); __syncthreads();
        for (int it = 0; it < ntw; ++it) {
            unsigned char* cu = lds + (it & 1) * 16384;
            if (it + 1 < ntw) { unsigned char* nx = lds + ((it + 1) & 1) * 16384;
                load_tile64(kb + (size_t)(k_lo + it + 1) * 64 * LD, LD, nx, wid, lane); load_tile64(vb + (k_lo + it + 1) * 64, S_, nx + 8192, wid, lane); }
            nsa_tile<2, 2>(cu, cu + 8192, lds, Qf, O, m, l, k_lo + it, L, qrow);
            wait_vm0(); __syncthreads();
        }
    }
    bf16_t* YW = (bf16_t*)(ws + WS_YW) + tok * 512 + (4 * g) * 64;
#pragma unroll
    for (int nt = 0; nt < 4; ++nt) {
        const float lt = rows_sum(l[nt]), gt = bf2f(gates[nt * 3 + 2]) * (lt > 0.f ? 1.f / lt : 0.f);
#pragma unroll
        for (int mt = 0; mt < 4; ++mt) *(u32x2*)(YW + nt * 64 + 16 * mt + 4 * fq) = pack4(O[mt][nt] * gt);
    }
}

constexpr int SEL_RING = 8, SEL_BUCKET = SEL_RING * 16384, SEL_BIAS2 = SEL_BUCKET + 8192;
template <bool FAST>
__device__ __forceinline__ void sel_ntile(const bf16x8 (&Kf)[4][2], const unsigned char* vL, int fr, int fq, const bf16x8& q0, const bf16x8& q1, f32x4 (&O)[4], float& m, float& l,
                                          bool sb, int relb, int th, float blo, float bhi, const unsigned char* lds, int hl) {
    f32x4 S[4];
#pragma unroll
    for (int i = 0; i < 4; ++i) { S[i] = (f32x4){0.f, 0.f, 0.f, 0.f}; S[i] = mfma16(Kf[i][0], q0, S[i]); S[i] = mfma16(Kf[i][1], q1, S[i]); }
    float tmax = -1e30f;
    const float scl = (!FAST || sb) ? 0.125f * LOG2E : 0.f;
    if (FAST) { blo = (sb ? blo : -1e30f) - m; bhi = (sb ? bhi : -1e30f) - m; }
    if (FAST) {
#pragma unroll
        for (int i = 0; i < 4; ++i)
#pragma unroll
            for (int r = 0; r < 4; ++r) { const int rel = relb - (16 * i + r); S[i][r] = S[i][r] * scl + (rel >= th ? bhi : blo); tmax = fmaxf(tmax, S[i][r]); }
    } else {
        unsigned bkt[4][4]; float bs[4][4];
#pragma unroll
        for (int i = 0; i < 4; ++i)
#pragma unroll
            for (int r = 0; r < 4; ++r) { const int rel = relb - (16 * i + r); int rc = rel < 0 ? 0 : rel; rc = rc > 8191 ? 8191 : rc; bkt[i][r] = (lds + SEL_BUCKET)[rc]; }
#pragma unroll
        for (int i = 0; i < 4; ++i)
#pragma unroll
            for (int r = 0; r < 4; ++r) bs[i][r] = ((const float*)(lds + SEL_BIAS2))[hl * 32 + bkt[i][r]];
        asm volatile("" : "+v"(bs[0][0]), "+v"(bs[0][1]), "+v"(bs[0][2]), "+v"(bs[0][3]), "+v"(bs[1][0]), "+v"(bs[1][1]), "+v"(bs[1][2]), "+v"(bs[1][3]),
                          "+v"(bs[2][0]), "+v"(bs[2][1]), "+v"(bs[2][2]), "+v"(bs[2][3]), "+v"(bs[3][0]), "+v"(bs[3][1]), "+v"(bs[3][2]), "+v"(bs[3][3]));
        const float ninf = -1e30f;
#pragma unroll
        for (int i = 0; i < 4; ++i)
#pragma unroll
            for (int r = 0; r < 4; ++r) {
                const int rel = relb - (16 * i + r);
                const float sv = S[i][r] * (0.125f * LOG2E) + (bs[i][r] - m);
                S[i][r] = (sb && rel >= 0) ? sv : ninf; tmax = fmaxf(tmax, S[i][r]);
            }
    }
    tmax = rows_max(tmax);
    if (__ballot(tmax > 8.f) != 0ull) {
        const float d = fmaxf(tmax, 0.f), alpha = __builtin_amdgcn_exp2f(-d);
        m += d; l *= alpha;
#pragma unroll
        for (int mt = 0; mt < 4; ++mt) O[mt] = O[mt] * alpha;
#pragma unroll
        for (int i = 0; i < 4; ++i)
#pragma unroll
            for (int r = 0; r < 4; ++r) S[i][r] -= d;
    }
    float psum = 0.f;
#pragma unroll
    for (int i = 0; i < 4; ++i)
#pragma unroll
        for (int r = 0; r < 4; ++r) { const float pv = __builtin_amdgcn_exp2f(S[i][r]); S[i][r] = pv; psum += pv; }
    l += rows_sum(psum);
    const bf16x8 Pb0 = pack8(S[0], S[1]), Pb1 = pack8(S[2], S[3]);
#pragma unroll
    for (int mt = 0; mt < 4; ++mt) { O[mt] = mfma16(lds_vfrag128(vL, 16 * mt + fr, 0, fq), Pb0, O[mt]); O[mt] = mfma16(lds_vfrag128(vL, 16 * mt + fr, 32, fq), Pb1, O[mt]); }
}
__device__ __forceinline__ void sel_ntile2_fast(const bf16x8 (&Kf)[4][2], const unsigned char* vL, int fr, int fq, const bf16x8 (&Qf)[2][2], f32x4 (&O)[2][4], float (&m)[2], float (&l)[2],
                                                const bool (&sb)[2], const int (&relb)[2], int th, float blo, float bhi) {
    f32x4 S[2][4]; float tmax[2], bl[2], bh[2], scl[2];
#pragma unroll
    for (int b = 0; b < 2; ++b)
#pragma unroll
        for (int i = 0; i < 4; ++i) { S[b][i] = (f32x4){0.f, 0.f, 0.f, 0.f}; S[b][i] = mfma16(Kf[i][0], Qf[b][0], S[b][i]); S[b][i] = mfma16(Kf[i][1], Qf[b][1], S[b][i]); }
#pragma unroll
    for (int b = 0; b < 2; ++b) { scl[b] = sb[b] ? 0.125f * LOG2E : 0.f; bl[b] = (sb[b] ? blo : -1e30f) - m[b]; bh[b] = (sb[b] ? bhi : -1e30f) - m[b]; tmax[b] = -1e30f; }
#pragma unroll
    for (int b = 0; b < 2; ++b)
#pragma unroll
        for (int i = 0; i < 4; ++i)
#pragma unroll
            for (int r = 0; r < 4; ++r) { const int rel = relb[b] - (16 * i + r); S[b][i][r] = S[b][i][r] * scl[b] + (rel >= th ? bh[b] : bl[b]); tmax[b] = fmaxf(tmax[b], S[b][i][r]); }
#pragma unroll
    for (int b = 0; b < 2; ++b) tmax[b] = rows_max(tmax[b]);
    if (__ballot(tmax[0] > 8.f || tmax[1] > 8.f) != 0ull) {
#pragma unroll
        for (int b = 0; b < 2; ++b) {
            const float d = fmaxf(tmax[b], 0.f), alpha = __builtin_amdgcn_exp2f(-d);
            m[b] += d; l[b] *= alpha;
#pragma unroll
            for (int mt = 0; mt < 4; ++mt) O[b][mt] = O[b][mt] * alpha;
#pragma unroll
            for (int i = 0; i < 4; ++i)
#pragma unroll
                for (int r = 0; r < 4; ++r) S[b][i][r] -= d;
        }
    }
    float psum[2] = {0.f, 0.f};
#pragma unroll
    for (int b = 0; b < 2; ++b)
#pragma unroll
        for (int i = 0; i < 4; ++i)
#pragma unroll
            for (int r = 0; r < 4; ++r) { const float pv = __builtin_amdgcn_exp2f(S[b][i][r]); S[b][i][r] = pv; psum[b] += pv; }
#pragma unroll
    for (int b = 0; b < 2; ++b) l[b] += rows_sum(psum[b]);
    bf16x8 P0[2], P1[2];
#pragma unroll
    for (int b = 0; b < 2; ++b) { P0[b] = pack8(S[b][0], S[b][1]); P1[b] = pack8(S[b][2], S[b][3]); }
#pragma unroll
    for (int mt = 0; mt < 4; ++mt) {
        const bf16x8 v0 = lds_vfrag128(vL, 16 * mt + fr, 0, fq), v1 = lds_vfrag128(vL, 16 * mt + fr, 32, fq);
#pragma unroll
        for (int b = 0; b < 2; ++b) { O[b][mt] = mfma16(v0, P0[b], O[b][mt]); O[b][mt] = mfma16(v1, P1[b], O[b][mt]); }
    }
}
template <bool FAST>
__device__ __forceinline__ void sel_tile(const unsigned char* kL, const unsigned char* vL, const unsigned char* lds, const bf16x8 (&Qf)[2][2], f32x4 (&O)[2][4], float (&m)[2], float (&l)[2],
                                         const bool (&sb)[2], const bool (&need)[2], const int (&relb)[2], int th, float blo, float bhi, int hl, int fr, int fq) {
    bf16x8 Kf[4][2];
#pragma unroll
    for (int i = 0; i < 4; ++i)
#pragma unroll
        for (int ks = 0; ks < 2; ++ks) Kf[i][ks] = lds_frag128(kL, 16 * i + fr, 4 * ks + fq);
    if (FAST && need[0] && need[1]) { sel_ntile2_fast(Kf, vL, fr, fq, Qf, O, m, l, sb, relb, th, blo, bhi); return; }
    if (need[0]) sel_ntile<FAST>(Kf, vL, fr, fq, Qf[0][0], Qf[0][1], O[0], m[0], l[0], sb[0], relb[0], th, blo, bhi, lds, hl);
    if (need[1]) sel_ntile<FAST>(Kf, vL, fr, fq, Qf[1][0], Qf[1][1], O[1], m[1], l[1], sb[1], relb[1], th, blo, bhi, lds, hl);
}
template <int VAR>
__device__ __forceinline__ void sel_item(const Params& p, int v, unsigned char* lds) {
    unsigned char* ws = launder(p.ws);
    const int tid = ltid(), lane = tid & 63, wid = tid >> 6, fr = lane & 15, fq = lane >> 4;
    const int qt = 127 - (v >> 2), sub = v & 3, b = sub >> 1, g = sub & 1;
    const int q0 = qt * 64, cur = qt, hl = fr & 3;
    const bf16_t* P = (const bf16_t*)(ws + WS_P);
    __syncthreads();
    if (tid < 128) ((float*)(lds + SEL_BIAS2))[tid] = p.rel_bias[(tid & 31) * 8 + 4 * g + (tid >> 5)] * LOG2E;
    int t[2]; size_t tok[2]; bf16x8 Qf[2][2]; unsigned selw[2][4];
#pragma unroll
    for (int nt = 0; nt < 2; ++nt) {
        t[nt] = q0 + 8 * wid + 4 * nt + (fr >> 2); tok[nt] = (size_t)b * S_ + t[nt];
#pragma unroll
        for (int ks = 0; ks < 2; ++ks) Qf[nt][ks] = *(const bf16x8*)(P + tok[nt] * LD + C_QA + (4 * g + hl) * 64 + 32 * ks + 8 * fq);
        const u32x4 w = *(const u32x4*)((const unsigned*)(ws + WS_SELW) + (tok[nt] * 2 + g) * 4);
        selw[nt][0] = w.x; selw[nt][1] = w.y; selw[nt][2] = w.z; selw[nt][3] = w.w;
    }
    f32x4 O[2][4]; float m[2], l[2];
#pragma unroll
    for (int nt = 0; nt < 2; ++nt) { m[nt] = -1000.f; l[nt] = 0.f;
#pragma unroll
        for (int mt = 0; mt < 4; ++mt) O[nt][mt] = (f32x4){0.f, 0.f, 0.f, 0.f}; }
    const bf16_t* kb = P + ((size_t)b * S_) * LD + C_KS + g * 64;
    const bf16_t* vb = (const bf16_t*)(ws + WS_VST) + (size_t)(b * 2 + g) * 64 * S_;
    const int nts = cur + 1;
#define SEL_ISSUE(jj) do { unsigned char* st_ = lds + ((jj) & 7) * 16384; const int c_ = ((lane & 7) ^ (lane >> 3)) * 8, r_ = 8 * wid + (lane >> 3); \
        glds16(kb + ((size_t)(jj) * 64 + r_) * LD + c_, st_ + wid * 1024); glds16(vb + (size_t)r_ * S_ + (jj) * 64 + c_, st_ + 8192 + wid * 1024); } while (0)
    asm volatile("s_waitcnt vmcnt(0)" ::: "memory");
#pragma unroll
    for (int q = 0; q < 4; ++q) if (q < nts) SEL_ISSUE(q);
    const unsigned char* bucketL = lds + SEL_BUCKET;
    for (int jp = 0; jp < nts; jp += 4) {
        WAIT_V(0);
        RAW_BARRIER();
#pragma unroll
        for (int q = 4; q < 8; ++q) if (jp + q < nts) SEL_ISSUE(jp + q);
#pragma unroll 1
      for (int j = jp; j < jp + 4 && j < nts; ++j) {
        const unsigned char* cu = lds + (j & 7) * 16384;
        bool sb[2], need[2]; int relb[2];
#pragma unroll
        for (int nt = 0; nt < 2; ++nt) {
            const unsigned w = j < 32 ? selw[nt][0] : j < 64 ? selw[nt][1] : j < 96 ? selw[nt][2] : selw[nt][3];
            sb[nt] = (w >> (j & 31)) & 1u; need[nt] = __ballot(sb[nt]) != 0ull; relb[nt] = t[nt] - 64 * j - 4 * fq;
        }
        if (VAR == 1) { need[0] = false; need[1] = false; }
        if (VAR == 2) { if (!(need[0] || need[1])) { need[0] = false; } else { need[0] = true; need[1] = true; } }
        if (need[0] || need[1]) {
            const int rmin = q0 - 64 * j - 63, rmax = q0 + 31 - 64 * j;
            bool fast = false; int th = 0; float blo = 0.f, bhi = 0.f;
            if (rmin >= 16) {
                const int b0 = bucketL[rmin], b1 = bucketL[rmax > 8191 ? 8191 : rmax];
                if (b1 - b0 <= 1) { fast = true; th = t5_first(b1); if (b1 == b0) th = 0;
                    blo = ((const float*)(lds + SEL_BIAS2))[hl * 32 + b0]; bhi = ((const float*)(lds + SEL_BIAS2))[hl * 32 + b1]; }
            }
            if (fast) sel_tile<true>(cu, cu + 8192, lds, Qf, O, m, l, sb, need, relb, th, blo, bhi, hl, fr, fq);
            else sel_tile<false>(cu, cu + 8192, lds, Qf, O, m, l, sb, need, relb, th, blo, bhi, hl, fr, fq);
        }
      }
    }
#undef SEL_ISSUE
    __syncthreads();
#pragma unroll
    for (int nt = 0; nt < 2; ++nt) {
        const float gt = bf2f(P[tok[nt] * LD + C_GA + (4 * g + hl) * 3 + 1]) * (l[nt] > 0.f ? 1.f / l[nt] : 0.f);
        const size_t o = tok[nt] * 512 + (4 * g + hl) * 64;
#pragma unroll
        for (int mt = 0; mt < 4; ++mt) {
            const f32x4 yc = unpack4(*(const u32x2*)((const bf16_t*)(ws + WS_YC) + o + 16 * mt + 4 * fq));
            const f32x4 yw = unpack4(*(const u32x2*)((const bf16_t*)(ws + WS_YW) + o + 16 * mt + 4 * fq));
            if (VAR == 0 || VAR == 3) *(u32x2*)((bf16_t*)(ws + WS_YA) + tok[nt] * 1536 + (4 * g + hl) * 64 + 16 * mt + 4 * fq) = pack4(yc + yw + O[nt][mt] * gt);
            else asm volatile("" :: "v"(O[nt][mt]));
        }
    }
}

__device__ __forceinline__ void scan_item(const Params& p, int item, int half) {
    unsigned char* ws = launder(p.ws);
    const int idx = item * HT + (ltid() & 255);
    const int bh = idx >> 13, ed = idx & 8191, h = bh & 7;
    const float dec = exp2f(128.f * ret_lg2(h));
    const float* KVT = (const float*)(ws + WS_KVT) + (size_t)bh * 64 * 8192 + ed;
    bf16_t* SPT = (bf16_t*)(ws + WS_SPT) + (size_t)bh * 64 * 8192 + ed;
    float s = 0.f;
#pragma unroll
    for (int n0 = 0; n0 < 64; n0 += 32) {
        float kv[32];
#pragma unroll
        for (int n = 0; n < 32; ++n) kv[n] = KVT[(size_t)(n0 + n) * 8192];
#pragma unroll
        for (int n = 0; n < 32; ++n) { SPT[(size_t)(n0 + n) * 8192] = f2bf(s); s = s * dec + kv[n]; }
    }
}

__device__ __forceinline__ void phase_p3(const Params& p, unsigned char* lds, int half, int what) {
    for (int i = (ltid() & 255); i < 8192 / 16; i += HT) ((u32x4*)(lds + NSA_BUCKET))[i] = ((const u32x4*)(launder(p.ws) + WS_BUCKET))[i];
    __syncthreads();
    for (int h = (blockIdx.x * 2 + half); h < 512; h += (gridDim.x * 2)) {
        if (what & 1) cmp_item(p, h, lds, half);
        if (what & 2) {
            if (h >= 128 && h < 384) win_item(p, h - 128, lds, half);
            else if (h >= 384) { win_item(p, 256 + 2 * (h - 384) - ((h & 1) ? 1 : 0) , lds, half); win_item(p, 256 + 2 * (h - 384) + ((h & 1) ? 0 : 1) + 1 - ((h & 1) ? 0 : 0), lds, half); }
        }
        if (what & 4) scan_item(p, h, half);
    }
}

__device__ __forceinline__ void retout_item(const Params& p, int item, unsigned char* lds, int half) {
    unsigned char* ws = launder(p.ws);
    const int tid = (ltid() & 255), lane = tid & 63, wid = tid >> 6, fr = lane & 15, fq = lane >> 4;
    const int n = item & 63, h = (item >> 6) & 7, b = item >> 9;
    const size_t tok0 = (size_t)b * S_ + 128 * n;
    const bf16_t* P = (const bf16_t*)(ws + WS_P);
    unsigned char* vL = lds; unsigned char* kL = lds + 32768; unsigned char* sL = lds + 49152;
    __syncthreads();
    load_tile128w((const bf16_t*)(ws + WS_VRT) + ((size_t)(b * 8 + h) * 128) * S_ + 128 * n, S_, vL, wid, lane);
    load_tile128(P + tok0 * LD + C_KR + h * 64, LD, kL, wid, lane);
    load_tile128((const bf16_t*)(ws + WS_SPT) + ((size_t)(b * 8 + h) * 64 + n) * 8192, 64, sL, wid, lane);
    bf16x8 Qf[2][2];
#pragma unroll
    for (int nt = 0; nt < 2; ++nt)
#pragma unroll
        for (int ks = 0; ks < 2; ++ks) Qf[nt][ks] = *(const bf16x8*)(P + (tok0 + 32 * wid + 16 * nt + fr) * LD + C_QR + h * 64 + 32 * ks + 8 * fq);
    wait_vm0(); __syncthreads();
    const float lg2 = ret_lg2(h);
    f32x4 Y[8][2];
#pragma unroll
    for (int m = 0; m < 8; ++m)
#pragma unroll
        for (int nt = 0; nt < 2; ++nt) Y[m][nt] = (f32x4){0.f, 0.f, 0.f, 0.f};
#pragma unroll
    for (int m = 0; m < 8; ++m)
#pragma unroll
        for (int ks = 0; ks < 2; ++ks) {
            const bf16x8 a = lds_frag128(sL, 16 * m + fr, 4 * ks + fq);
#pragma unroll
            for (int nt = 0; nt < 2; ++nt) Y[m][nt] = mfma16(a, Qf[nt][ks], Y[m][nt]);
        }
#pragma unroll
    for (int nt = 0; nt < 2; ++nt) {
        const float sc = exp2f((float)(32 * wid + 16 * nt + fr + 1) * lg2);
#pragma unroll
        for (int m = 0; m < 8; ++m) Y[m][nt] = Y[m][nt] * sc;
    }
#pragma unroll 1
    for (int s = 0; s < 4; ++s) {
        f32x4 St[2][2];
#pragma unroll
        for (int hh = 0; hh < 2; ++hh) {
            const int mt = 2 * s + hh;
#pragma unroll
            for (int nt = 0; nt < 2; ++nt) St[hh][nt] = (f32x4){0.f, 0.f, 0.f, 0.f};
#pragma unroll
            for (int ks = 0; ks < 2; ++ks) {
                const bf16x8 a = lds_frag128(kL, 16 * mt + fr, 4 * ks + fq);
#pragma unroll
                for (int nt = 0; nt < 2; ++nt) St[hh][nt] = mfma16(a, Qf[nt][ks], St[hh][nt]);
            }
#pragma unroll
            for (int nt = 0; nt < 2; ++nt) {
                const int qi = 32 * wid + 16 * nt + fr;
#pragma unroll
                for (int r = 0; r < 4; ++r) {
                    const int kj = 16 * mt + 4 * fq + r;
                    const float dm = qi >= kj ? exp2f((float)(qi - kj) * lg2) : 0.f;
                    St[hh][nt][r] *= dm;
                }
            }
        }
        bf16x8 Pb[2];
#pragma unroll
        for (int nt = 0; nt < 2; ++nt) Pb[nt] = pack8(St[0][nt], St[1][nt]);
#pragma unroll
        for (int m = 0; m < 8; ++m) {
            const bf16x8 a = lds_vfrag256(vL, 16 * m + fr, 32 * s, fq);
#pragma unroll
            for (int nt = 0; nt < 2; ++nt) Y[m][nt] = mfma16(a, Pb[nt], Y[m][nt]);
        }
    }
    bf16_t* YB = (bf16_t*)(ws + WS_YA) + 512;
#pragma unroll
    for (int nt = 0; nt < 2; ++nt) {
        float sum = 0.f;
#pragma unroll
        for (int m = 0; m < 8; ++m) sum += Y[m][nt][0] + Y[m][nt][1] + Y[m][nt][2] + Y[m][nt][3];
        sum = rows_sum(sum);
        const float mu = sum * (1.f / 128.f);
        float vs = 0.f;
#pragma unroll
        for (int m = 0; m < 8; ++m)
#pragma unroll
            for (int r = 0; r < 4; ++r) { const float dlt = Y[m][nt][r] - mu; vs += dlt * dlt; }
        vs = rows_sum(vs);
        const float rstd = rsqrtf(vs * (1.f / 128.f) + 1e-5f);
        const size_t tk = tok0 + 32 * wid + 16 * nt + fr;
#pragma unroll
        for (int m = 0; m < 8; ++m) {
            const f32x4 gt = unpack4(*(const u32x2*)(P + tk * LD + C_GR + h * 128 + 16 * m + 4 * fq));
            f32x4 v;
#pragma unroll
            for (int r = 0; r < 4; ++r) v[r] = (Y[m][nt][r] - mu) * rstd * gt[r];
            *(u32x2*)(YB + tk * 1536 + h * 128 + 16 * m + 4 * fq) = pack4(v);
        }
    }
}
__device__ __forceinline__ void phase_p4_sel(const Params& p, unsigned char* lds) {
    for (int i = ltid(); i < 8192 / 16; i += NTHREADS) ((u32x4*)(lds + SEL_BUCKET))[i] = ((const u32x4*)(launder(p.ws) + WS_BUCKET))[i];
    __syncthreads();
    for (int it = blockIdx.x; it < 512; it += gridDim.x * 2) {
        sel_item<0>(p, it, lds);
        if (511 - it != it) sel_item<0>(p, 511 - it, lds);
    }
    __syncthreads();
}
__device__ __forceinline__ void phase_p4(const Params& p, unsigned char* lds, int half) {
    for (int it = (blockIdx.x * 2 + half); it < 1024; it += (gridDim.x * 2)) retout_item(p, it, lds, half);
}

struct RowOrder {     typedef pg8::Unit U; static constexpr bool GATHER = false;
    unsigned a, b; int K, xcd, slot, per;
    __device__ __forceinline__ bool next(int i, pg8::Unit& u) const { const int t = xcd * 32 + slot + i * per; if (t >= (xcd + 1) * 32) return false; u.pm = t >> 2; u.pn = t & 3; return true; }
    __device__ __forceinline__ void ptrs(const pg8::Unit& u, unsigned& A, unsigned& B) const { A = a + (unsigned)u.pm * 512u * (unsigned)K; B = b + (unsigned)u.pn * 512u * (unsigned)K; }
};
template <int MODE>
struct MixEpi {
    static constexpr int MID_T = MODE == 0 ? 8 : 0;
    unsigned char* ws; const float* X;
    __device__ __forceinline__ void mid(f32x4 (&acc)[2][2][4][2], const pg8::Unit& u, int wr, int wc, int fr, int fq) const {
#pragma unroll
        for (int ai = 0; ai < 2; ++ai) {
            __builtin_amdgcn_sched_barrier(0);
#pragma unroll
            for (int m = 0; m < 4; ++m) {
                const size_t tok = (size_t)(u.pm * 256 + 128 * ai + 64 * wr + 16 * m + fr + vzero());
#pragma unroll
                for (int bj = 0; bj < 2; ++bj) {
                    const int n = u.pn * 256 + 128 * bj + 32 * wc + 8 * fq;
                    const u32x4 ga = *(const u32x4*)((const bf16_t*)(ws + WS_P) + tok * LD + C_MA + n), gb = *(const u32x4*)((const bf16_t*)(ws + WS_P) + tok * LD + C_MB + n);
                    const f32x4 a0 = unpack4((u32x2){ga.x, ga.y}), a1 = unpack4((u32x2){ga.z, ga.w}), b0 = unpack4((u32x2){gb.x, gb.y}), b1 = unpack4((u32x2){gb.z, gb.w});
#pragma unroll
                    for (int r = 0; r < 4; ++r) { acc[ai][bj][m][0][r] *= a0[r] * __builtin_amdgcn_rcpf(fmaxf(b0[r], 1e-30f)); acc[ai][bj][m][1][r] *= a1[r] * __builtin_amdgcn_rcpf(fmaxf(b1[r], 1e-30f)); }
                }
            }
        }
        __builtin_amdgcn_sched_barrier(0);
    }
    __device__ __forceinline__ void operator()(const f32x4 (&acc)[2][2][4][2], const pg8::Unit& u, int wr, int wc, int fr, int fq) const {
#pragma unroll
        for (int ai = 0; ai < 2; ++ai)
#pragma unroll
            for (int m = 0; m < 4; ++m) {
                const size_t tok = (size_t)(u.pm * 256 + 128 * ai + 64 * wr + 16 * m + fr + vzero());
#pragma unroll
                for (int bj = 0; bj < 2; ++bj) {
                    const int n = u.pn * 256 + 128 * bj + 32 * wc + 8 * fq;
                    const f32x4 v0 = acc[ai][bj][m][0], v1 = acc[ai][bj][m][1];
                    if (MODE == 2) {
                        const u32x4 xw = *(const u32x4*)((const bf16_t*)(ws + WS_XB) + tok * 1024 + n);
                        const f32x4 h0 = unpack4((u32x2){xw.x, xw.y}) * DN_ALPHA + v0, h1 = unpack4((u32x2){xw.z, xw.w}) * DN_ALPHA + v1;
                        u32x4 w; w.x = pack2(h0[0], h0[1]); w.y = pack2(h0[2], h0[3]); w.z = pack2(h1[0], h1[1]); w.w = pack2(h1[2], h1[3]);
                        *(u32x4*)((bf16_t*)(ws + WS_H1) + tok * 1024 + n) = w;
                    } else {
                        const u32x4 gw = *(const u32x4*)((const bf16_t*)(ws + WS_P) + tok * LD + C_MB + n);
                        const f32x4 g0 = unpack4((u32x2){gw.x, gw.y}), g1 = unpack4((u32x2){gw.z, gw.w});
                        const f32x4 o0 = g0 * v0, o1 = g1 * v1;
                        u32x4 w; w.x = pack2(o0[0], o0[1]); w.y = pack2(o0[2], o0[3]); w.z = pack2(o1[0], o1[1]); w.w = pack2(o1[2], o1[3]);
                        *(u32x4*)((bf16_t*)(ws + WS_MG) + tok * 1024 + n) = w;
                    }
                }
            }
    }
};
__device__ __forceinline__ void phase_g2(const Params& p, unsigned char* lds) {
    unsigned char* ws = launder(p.ws);
    RowOrder S; S.xcd = blockIdx.x & 7; S.slot = blockIdx.x >> 3; S.per = gridDim.x >> 3;
    S.a = (unsigned)WS_YA; S.b = (unsigned)WS_WA; S.K = 1536; MixEpi<0> E; E.ws = ws; E.X = nullptr;
    pg8::gemm_phase<MixEpi<0>, RowOrder>(lds, 1536, S, E, ltid(), ws);
}
__device__ __forceinline__ void phase_g3(const Params& p, int layer, unsigned char* lds) {
    unsigned char* ws = launder(p.ws);
    RowOrder S; S.xcd = blockIdx.x & 7; S.slot = blockIdx.x >> 3; S.per = gridDim.x >> 3; S.a = (unsigned)WS_MG; S.b = (unsigned)WS_WO; S.K = 1024;
    MixEpi<2> E; E.ws = ws; E.X = nullptr;
    pg8::gemm_phase<MixEpi<2>, RowOrder>(lds, 1024, S, E, ltid(), ws);
}

__device__ __forceinline__ void phase_ln1(const Params& p, int layer, unsigned char* lds, bool dry, int half) {
    unsigned char* ws = launder(p.ws);
    const int tid = (ltid() & 255), lane = tid & 63, wid = tid >> 6;
    float* wrL = (float*)lds;
    float* lgL = (float*)(lds - half * HALF_LDS + 65536);
    {
        float4 wv[16];
#pragma unroll
        for (int k = 0; k < 16; ++k) wv[k] = ((const float4*)p.w_router)[tid + 256 * k];
#pragma unroll
        for (int k = 0; k < 16; ++k) { const int i4 = tid + 256 * k, d = i4 >> 2, e0 = (i4 & 3) * 4;
            wrL[(e0 + 0) * 1024 + d] = wv[k].x; wrL[(e0 + 1) * 1024 + d] = wv[k].y; wrL[(e0 + 2) * 1024 + d] = wv[k].z; wrL[(e0 + 3) * 1024 + d] = wv[k].w; }
    }
    __syncthreads();
    const bf16_t* H1 = (const bf16_t*)(ws + WS_H1);
    bf16_t* X1B = (bf16_t*)(ws + WS_X1B);
    const float* gam = p.ln1_g + layer * 1024; const float* bet = p.ln1_b + layer * 1024;
    unsigned* cnt = (unsigned*)(ws + WS_CTL) + (dry ? 0 : CW_CNT) + layer * 1024;
    int* LIST = (int*)(ws + (dry ? WS_HB : WS_LIST)); float* WTS = (float*)(ws + (dry ? WS_HB + 4194304 : WS_WTS));
    constexpr int U = 4;
    const int nwave = (gridDim.x * 2) * 4, wv = (blockIdx.x * 2 + half) * 4 + wid;
    const int nloc = ((T_ - wv * U + nwave * U - 1) / (nwave * U)) * (4 * U);
    u32x2 vn[U][4];
#pragma unroll
    for (int u = 0; u < U; ++u)
#pragma unroll
        for (int j = 0; j < 4; ++j) vn[u][j] = *(const u32x2*)(H1 + (size_t)(wv * U + u) * 1024 + 256 * j + 4 * lane);
    for (int t0 = wv * U; t0 < T_; t0 += nwave * U) {
        float4 y[U][4]; float s[U], q[U];
#pragma unroll
        for (int u = 0; u < U; ++u) {
            s[u] = 0.f;
#pragma unroll
            for (int j = 0; j < 4; ++j) { const f32x4 t = unpack4(vn[u][j]); y[u][j].x = t[0]; y[u][j].y = t[1]; y[u][j].z = t[2]; y[u][j].w = t[3]; s[u] += (t[0] + t[1]) + (t[2] + t[3]); }
        }
        { const int tn = t0 + nwave * U < T_ ? t0 + nwave * U : t0;
#pragma unroll
          for (int u = 0; u < U; ++u)
#pragma unroll
              for (int j = 0; j < 4; ++j) vn[u][j] = *(const u32x2*)(H1 + (size_t)(tn + u) * 1024 + 256 * j + 4 * lane); }
#pragma unroll
        for (int u = 0; u < U; ++u) s[u] = wave_sum(s[u]) * (1.f / 1024.f);
#pragma unroll
        for (int u = 0; u < U; ++u) {
            q[u] = 0.f;
#pragma unroll
            for (int j = 0; j < 4; ++j) { const float a = y[u][j].x - s[u], b2 = y[u][j].y - s[u], c = y[u][j].z - s[u], d = y[u][j].w - s[u]; q[u] += a * a + b2 * b2 + c * c + d * d; }
        }
#pragma unroll
        for (int u = 0; u < U; ++u) q[u] = rsqrtf(wave_sum(q[u]) * (1.f / 1024.f) + 1e-5f);
#pragma unroll
        for (int j = 0; j < 4; ++j) {
            const int d0 = 256 * j + 4 * lane;
            const float4 gg = *(const float4*)(gam + d0), bb = *(const float4*)(bet + d0);
#pragma unroll
            for (int u = 0; u < U; ++u) {
                y[u][j].x = (y[u][j].x - s[u]) * q[u] * gg.x + bb.x; y[u][j].y = (y[u][j].y - s[u]) * q[u] * gg.y + bb.y;
                y[u][j].z = (y[u][j].z - s[u]) * q[u] * gg.z + bb.z; y[u][j].w = (y[u][j].w - s[u]) * q[u] * gg.w + bb.w;
                u32x2 w; w.x = pack2(y[u][j].x, y[u][j].y); w.y = pack2(y[u][j].z, y[u][j].w);
                *(u32x2*)(X1B + (size_t)(t0 + u) * 1024 + d0) = w;
            }
        }
        float lg[U][16];
#pragma unroll
        for (int e = 0; e < 16; ++e) {
#pragma unroll
            for (int u = 0; u < U; ++u) lg[u][e] = 0.f;
#pragma unroll
            for (int j = 0; j < 4; ++j) { const float4 w4 = *(const float4*)(wrL + e * 1024 + 256 * j + 4 * lane);
#pragma unroll
                for (int u = 0; u < U; ++u) lg[u][e] += y[u][j].x * w4.x + y[u][j].y * w4.y + y[u][j].z * w4.z + y[u][j].w * w4.w; }
        }
        float myl = 0.f;
#pragma unroll
        for (int u = 0; u < U; ++u) {
            float w8[8], z4[4];
#pragma unroll
            for (int e = 0; e < 8; ++e) { const u32x2 r = __builtin_amdgcn_permlane32_swap(__float_as_uint(lg[u][e]), __float_as_uint(lg[u][e + 8]), false, false); w8[e] = __uint_as_float(r.x) + __uint_as_float(r.y); }
#pragma unroll
            for (int e = 0; e < 4; ++e) { const u32x2 r = __builtin_amdgcn_permlane16_swap(__float_as_uint(w8[e]), __float_as_uint(w8[e + 4]), false, false); z4[e] = __uint_as_float(r.x) + __uint_as_float(r.y); }
            const bool h8 = (lane & 8) != 0, h4 = (lane & 4) != 0;
            const float k0 = h8 ? z4[2] : z4[0], s0 = h8 ? z4[0] : z4[2], k1 = h8 ? z4[3] : z4[1], s1 = h8 ? z4[1] : z4[3];
            const float y0 = k0 + __int_as_float(__builtin_amdgcn_mov_dpp(__float_as_int(s0), 0x128, 0xF, 0xF, true));
            const float y1 = k1 + __int_as_float(__builtin_amdgcn_mov_dpp(__float_as_int(s1), 0x128, 0xF, 0xF, true));
            const float k2 = h4 ? y1 : y0, s2 = h4 ? y0 : y1;
            float x = k2 + __int_as_float(__builtin_amdgcn_mov_dpp(__float_as_int(s2), 0x141, 0xF, 0xF, true));
            x += __int_as_float(__builtin_amdgcn_mov_dpp(__float_as_int(x), 0xB1, 0xF, 0xF, true));
            x += __int_as_float(__builtin_amdgcn_mov_dpp(__float_as_int(x), 0x4E, 0xF, 0xF, true));
            if ((lane & 3) == u) myl = x;
        }
        static_assert(U == 4, "lane (l & 3) stores token u = l & 3");
        lgL[(half * nloc + ((t0 - wv * U) / (nwave * U)) * (4 * U) + wid * U + (lane & 3)) * 17 + (lane >> 2)] = myl;
    }
    __syncthreads();
    if (half == 0 && wid == 0)
    for (int l0 = 0; l0 < 2 * nloc; l0 += 64) {
        const int li = l0 + lane; const bool act = li < 2 * nloc;
        const int hq = li >= nloc ? 1 : 0, lh = li - hq * nloc;
        const int it = lh / (4 * U), wq = (lh / U) & 3, uq = lh % U, tok = act ? (((blockIdx.x * 2 + hq) * 4 + wq) * U + uq) + it * (nwave * U) : 0;
        float lgv[16];
#pragma unroll
        for (int e = 0; e < 16; ++e) lgv[e] = lgL[li * 17 + e];
        float mx = lgv[0];
#pragma unroll
        for (int e = 1; e < 16; ++e) mx = fmaxf(mx, lgv[e]);
        float pr[16], ps = 0.f;
#pragma unroll
        for (int e = 0; e < 16; ++e) { pr[e] = expf(lgv[e] - mx); ps += pr[e]; }
        const float ips = 1.f / ps;
        float sel[16];
#pragma unroll
        for (int e = 0; e < 16; ++e) { pr[e] *= ips; sel[e] = pr[e] + p.router_bias[e]; }
        int best = 0; float bestv = -1e30f;
#pragma unroll
        for (int gI = 0; gI < 4; ++gI) {
            float a = -1e30f, b2 = -1e30f;
#pragma unroll
            for (int k = 0; k < 4; ++k) { const float x = sel[4 * gI + k]; if (x > a) { b2 = a; a = x; } else if (x > b2) b2 = x; }
            const float gs = a + b2;
            if (gs > bestv) { bestv = gs; best = gI; }
        }
        float s4[4], p4[4];
#pragma unroll
        for (int k = 0; k < 4; ++k) { s4[k] = 0.f; p4[k] = 0.f; }
#pragma unroll
        for (int gI = 0; gI < 4; ++gI) if (gI == best) {
#pragma unroll
            for (int k = 0; k < 4; ++k) { s4[k] = sel[4 * gI + k]; p4[k] = pr[4 * gI + k]; }
        }
        int i0 = 0; float a0 = s4[0];
#pragma unroll
        for (int k = 1; k < 4; ++k) if (s4[k] > a0) { a0 = s4[k]; i0 = k; }
        int i1 = -1; float a1 = -1e30f;
#pragma unroll
        for (int k = 0; k < 4; ++k) if (k != i0 && s4[k] > a1) { a1 = s4[k]; i1 = k; }
        float w0 = 0.f, w1 = 0.f;
#pragma unroll
        for (int k = 0; k < 4; ++k) { if (k == i0) w0 = p4[k]; if (k == i1) w1 = p4[k]; }
        const float iw = 1.f / (w0 + w1);
        const int e0 = act ? best * 4 + i0 : -1, e1 = act ? best * 4 + i1 : -1;
        unsigned myc = 0, r0 = 0, r1 = 0;
#pragma unroll
        for (int e = 0; e < 16; ++e) {
            const unsigned long long m0 = __builtin_amdgcn_ballot_w64(e0 == e), m1 = __builtin_amdgcn_ballot_w64(e1 == e);
            const unsigned c0 = (unsigned)__builtin_popcountll(m0), c = c0 + (unsigned)__builtin_popcountll(m1);
            if (lane == e) myc = c;
            if (e0 == e) r0 = __builtin_amdgcn_mbcnt_hi((unsigned)(m0 >> 32), __builtin_amdgcn_mbcnt_lo((unsigned)m0, 0u));
            if (e1 == e) r1 = c0 + __builtin_amdgcn_mbcnt_hi((unsigned)(m1 >> 32), __builtin_amdgcn_mbcnt_lo((unsigned)m1, 0u));
        }
        unsigned mybase = 0;
        if (lane < 16 && myc != 0) mybase = atomicAdd(&cnt[lane * 64], myc);
        unsigned b0 = 0, b1 = 0;
#pragma unroll
        for (int e = 0; e < 16; ++e) { const unsigned be = (unsigned)__builtin_amdgcn_readlane((int)mybase, e); if (e0 == e) b0 = be; if (e1 == e) b1 = be; }
        if (act) {
            LIST[(size_t)e0 * T_ + b0 + r0] = tok * 2; LIST[(size_t)e1 * T_ + b1 + r1] = tok * 2 + 1;
            WTS[tok * 2] = w0 * iw; WTS[tok * 2 + 1] = w1 * iw;
        }
    }
}

struct MoeUnit { int e, rt, ct, cnt, off; };
__device__ __forceinline__ const unsigned* moe_counts_to_lds(unsigned char* ws, int layer, unsigned char* lds) {
    unsigned* cntL = (unsigned*)(lds + 2 * HALF_LDS - 1024);
    const int tid = ltid();
    if (tid < NE) cntL[tid] = ((const unsigned*)(ws + WS_CTL) + CW_CNT + layer * 1024)[tid * 64];
    __syncthreads();
    return cntL;
}
struct MoeOrderBase {
    const unsigned* cntp; int t_lo, t_hi, slot, per;
    __device__ __forceinline__ void init(const unsigned* cnt) {
        cntp = cnt; int ntile = 0;
#pragma unroll
        for (int k = 0; k < NE; ++k) ntile += (__builtin_amdgcn_readfirstlane((int)cnt[k]) >> 8) * 4;
        t_lo = (ntile * (int)(blockIdx.x & 7)) >> 3; t_hi = (ntile * (int)((blockIdx.x & 7) + 1)) >> 3; slot = blockIdx.x >> 3; per = gridDim.x >> 3;
    }
    __device__ __forceinline__ bool next(int i, MoeUnit& u) const {
        const int t = t_lo + slot + i * per; if (t >= t_hi) return false;
        int base = 0, off = 0; bool found = false;
#pragma unroll
        for (int k = 0; k < NE; ++k) {
            const int ck = __builtin_amdgcn_readfirstlane((int)cntp[k]), nt = (ck >> 8) * 4;
            if (!found && t < base + nt) { found = true; u.e = k; u.cnt = ck; u.off = off; u.rt = (t - base) >> 2; u.ct = (t - base) & 3; }
            base += nt; off += ck;
        }
        return found;
    }
};
struct M2Order : MoeOrderBase {
    typedef MoeUnit U; static constexpr bool GATHER = true;
    const int* list;
    __device__ __forceinline__ void ptrs(const MoeUnit& u, unsigned& A, unsigned& B) const { A = (unsigned)WS_X1B; B = (unsigned)WS_WG + ((unsigned)u.e * 1024u + (unsigned)u.ct * 256u) * 2048u; }
    __device__ __forceinline__ void rows(const MoeUnit& u, int tid, unsigned (&v)[2]) const {
        v[0] = 0u; v[1] = 0u;
#pragma unroll
        for (int i = 0; i < 2; ++i) { int R, C; pg8::stage_rc((tid + vzero()) * 16 + i * 8192, R, C);
#pragma unroll
            for (int h = 0; h < 2; ++h) { int idx = u.rt * 256 + 128 * h + R; idx = idx < u.cnt ? idx : u.cnt - 1; const int a = (list + (size_t)u.e * T_)[idx]; v[h] |= (unsigned)(a >> 1) << (16 * i); } }
    }
};
struct M3Order : MoeOrderBase {
    typedef MoeUnit U; static constexpr bool GATHER = false;
    __device__ __forceinline__ void ptrs(const MoeUnit& u, unsigned& A, unsigned& B) const { A = (unsigned)WS_HB + ((unsigned)u.off + (unsigned)u.rt * 256u) * 1024u; B = (unsigned)WS_WD + ((unsigned)u.e * 1024u + (unsigned)u.ct * 256u) * 1024u; }
};
struct M2Epi {
    static constexpr int MID_T = 0;
    unsigned char* ws;
    __device__ __forceinline__ void operator()(const f32x4 (&acc)[2][2][4][2], const MoeUnit& u, int wr, int wc, int fr, int fq) const {
        bf16_t* HB = (bf16_t*)(ws + WS_HB);
#pragma unroll
        for (int ai = 0; ai < 2; ++ai)
#pragma unroll
            for (int m = 0; m < 4; ++m) {
                const int idx = u.rt * 256 + 128 * ai + 64 * wr + 16 * m + fr + vzero();
                if (idx < u.cnt) {
#pragma unroll
                    for (int bj = 0; bj < 2; ++bj) {
                        const int hcol = 4 * (32 * u.ct + 16 * bj + 4 * wc + fq);
                        const f32x4 gv = acc[ai][bj][m][0], uv = acc[ai][bj][m][1]; f32x4 hv;
#pragma unroll
                        for (int r = 0; r < 4; ++r) hv[r] = gv[r] * fsig(gv[r]) * uv[r];
                        *(u32x2*)(HB + (size_t)(u.off + idx) * 512 + hcol) = pack4(hv);
                    }
                }
            }
    }
};
struct M3Epi {
    static constexpr int MID_T = 0;
    unsigned char* ws; const int* list;
    __device__ __forceinline__ void operator()(const f32x4 (&acc)[2][2][4][2], const MoeUnit& u, int wr, int wc, int fr, int fq) const {
        bf16_t* CT = (bf16_t*)(ws + WS_CT);
#pragma unroll
        for (int ai = 0; ai < 2; ++ai)
#pragma unroll
            for (int m = 0; m < 4; ++m) {
                const int idx = u.rt * 256 + 128 * ai + 64 * wr + 16 * m + fr + vzero();
                if (idx < u.cnt) {
                    const int a = list[(size_t)u.e * T_ + idx];
#pragma unroll
                    for (int bj = 0; bj < 2; ++bj) {
                        const int n = u.ct * 256 + 128 * bj + 32 * wc + 8 * fq;
                        const f32x4 v0 = acc[ai][bj][m][0], v1 = acc[ai][bj][m][1];
                        u32x4 w; w.x = pack2(v0[0], v0[1]); w.y = pack2(v0[2], v0[3]); w.z = pack2(v1[0], v1[1]); w.w = pack2(v1[2], v1[3]);
                        *(u32x4*)(CT + (size_t)a * 1024 + n) = w;
                    }
                }
            }
    }
};
template <int MODE>
__device__ __forceinline__ void moe_rem_item(unsigned char* ws, const int* list, int e, int cnt, int off, int rh, int c64, unsigned char* lds) {
    constexpr int K = MODE == 0 ? 1024 : 512, NS = K / 64;
    const int tid = (ltid() & 255), lane = tid & 63, wid = tid >> 6, wr = wid >> 1, wc = wid & 1, fr = lane & 15, fq = lane >> 4;
    const int idx0 = (cnt & ~255) + 128 * rh;
    const int ldc = ((lane & 7) ^ (lane >> 3)) * 8;
    const bf16_t* ap[4];
#pragma unroll
    for (int i = 0; i < 4; ++i) {
        int idx = idx0 + 32 * i + 8 * wid + (lane >> 3); idx = idx < cnt ? idx : cnt - 1;
        if (MODE == 0) { const int a = list[(size_t)e * T_ + idx]; ap[i] = (const bf16_t*)(ws + WS_X1B) + (size_t)(a >> 1) * 1024 + ldc; }
        else ap[i] = (const bf16_t*)(ws + WS_HB) + (size_t)(off + idx) * 512 + ldc;
    }
    const bf16_t* bp[2];
#pragma unroll
    for (int i = 0; i < 2; ++i) {
        const int rho = 8 * (wid + 4 * i) + (lane >> 3), src = (rho & ~31) + pg8::perm32(rho & 31);
        bp[i] = (const bf16_t*)(ws + (MODE == 0 ? WS_WG : WS_WD)) + ((size_t)e * 1024 + 64 * c64 + src) * K + ldc;
    }
    f32x4 acc[4][2];
#pragma unroll
    for (int i = 0; i < 4; ++i)
#pragma unroll
        for (int j = 0; j < 2; ++j) acc[i][j] = (f32x4){0.f, 0.f, 0.f, 0.f};
    __syncthreads();
#define RSTAGE(buf, l) do { unsigned char* st_ = lds + (buf) * 24576; \
        _Pragma("unroll") for (int i = 0; i < 4; ++i) glds16(ap[i] + (l) * 64, st_ + (4 * i + wid) * 1024); \
        _Pragma("unroll") for (int i = 0; i < 2; ++i) glds16(bp[i] + (l) * 64, st_ + 16384 + (wid + 4 * i) * 1024); } while (0)
    RSTAGE(0, 0); RSTAGE(1, 1);
    for (int l = 0; l < NS; ++l) {
        const unsigned char* st = lds + (l % 3) * 24576;
        if (l + 1 < NS) WAIT_V(6); else WAIT_V(0);
        RAW_BARRIER();
        if (l + 2 < NS) RSTAGE((l + 2) % 3, l + 2);
#pragma unroll
        for (int ks = 0; ks < 2; ++ks) {
            bf16x8 a[4], bb[2];
#pragma unroll
            for (int i = 0; i < 4; ++i) a[i] = lds_frag128(st, 64 * wr + 16 * i + fr, 4 * ks + fq);
#pragma unroll
            for (int j = 0; j < 2; ++j) bb[j] = lds_frag128(st + 16384, 32 * wc + 16 * j + fr, 4 * ks + fq);
#pragma unroll
            for (int i = 0; i < 4; ++i)
#pragma unroll
                for (int j = 0; j < 2; ++j) acc[i][j] = mfma16(bb[j], a[i], acc[i][j]);
        }
    }
#undef RSTAGE
#pragma unroll
    for (int i = 0; i < 4; ++i) {
        const int idx = idx0 + 64 * wr + 16 * i + fr + vzero();
        if (idx < cnt) {
            if (MODE == 0) {
                f32x4 hv;
#pragma unroll
                for (int r = 0; r < 4; ++r) hv[r] = acc[i][0][r] * fsig(acc[i][0][r]) * acc[i][1][r];
                *(u32x2*)((bf16_t*)(ws + WS_HB) + (size_t)(off + idx) * 512 + 32 * c64 + 16 * wc + 4 * fq) = pack4(hv);
            } else {
                const int a = list[(size_t)e * T_ + idx];
                const f32x4 v0 = acc[i][0], v1 = acc[i][1];
                u32x4 w; w.x = pack2(v0[0], v0[1]); w.y = pack2(v0[2], v0[3]); w.z = pack2(v1[0], v1[1]); w.w = pack2(v1[2], v1[3]);
                *(u32x4*)((bf16_t*)(ws + WS_CT) + (size_t)a * 1024 + 64 * c64 + 32 * wc + 8 * fq) = w;
            }
        }
    }
    __syncthreads();
}
template <int MODE>
__device__ __forceinline__ void moe_rem(const unsigned* cntp, unsigned char* ws, const int* list, unsigned char* ldsh, int half) {
    for (int t = blockIdx.x * 2 + half; ; t += gridDim.x * 2) {
        int base = 0, off = 0, e = -1, cnt = 0, eoff = 0, loc = 0;
#pragma unroll
        for (int k = 0; k < NE; ++k) {
            const int ck = __builtin_amdgcn_readfirstlane((int)cntp[k]), ni = (((ck & 255) + 127) >> 7) * 16;
            if (e < 0 && t < base + ni) { e = k; cnt = ck; eoff = off; loc = t - base; }
            base += ni; off += ck;
        }
        if (e < 0) break;
        moe_rem_item<MODE>(ws, list, e, cnt, eoff, loc >> 4, loc & 15, ldsh);
    }
}
__device__ __forceinline__ void phase_m2(const Params& p, int layer, unsigned char* lds, unsigned char* ldsh, int half) {
    unsigned char* ws = launder(p.ws);
    const unsigned* cntL = moe_counts_to_lds(ws, layer, lds);
    M2Order S; S.init(cntL);
    S.list = (const int*)(ws + WS_LIST);
    M2Epi E; E.ws = ws;
    pg8::gemm_phase<M2Epi, M2Order>(lds, 1024, S, E, ltid(), ws);
    moe_rem<0>(S.cntp, ws, S.list, ldsh, half);
}
__device__ __forceinline__ void phase_m3(const Params& p, int layer, unsigned char* lds, unsigned char* ldsh, int half) {
    unsigned char* ws = launder(p.ws);
    const unsigned* cntL = moe_counts_to_lds(ws, layer, lds);
    M3Order S; S.init(cntL);
    M3Epi E; E.ws = ws; E.list = (const int*)(ws + WS_LIST);
    pg8::gemm_phase<M3Epi, M3Order>(lds, 512, S, E, ltid(), ws);
    moe_rem<1>(S.cntp, ws, E.list, ldsh, half);
}

__device__ __forceinline__ void phase_ln2(const Params& p, int layer, int half) {
    unsigned char* ws = launder(p.ws);
    const int tid = (ltid() & 255), lane = tid & 63, wid = tid >> 6;
    const bf16_t* X1 = (const bf16_t*)(ws + WS_X1B); const bf16_t* CT = (const bf16_t*)(ws + WS_CT); const float* WTS = (const float*)(ws + WS_WTS);
    float* XO = p.out; bf16_t* XB = (bf16_t*)(ws + WS_XB); const bool fin = layer == NLAYER - 1;
    const float* gam = p.ln2_g + layer * 1024; const float* bet = p.ln2_b + layer * 1024;
    constexpr int U = 4;
    const int nwave = (gridDim.x * 2) * 4, wv = (blockIdx.x * 2 + half) * 4 + wid;
    for (int t0 = wv * U; t0 < T_; t0 += nwave * U) {
        float4 v[U][4]; float s[U], q[U];
#pragma unroll
        for (int u = 0; u < U; ++u) {
            const int tok = t0 + u;
            const float w0 = WTS[tok * 2 + vzero()], w1 = WTS[tok * 2 + 1 + vzero()];
            s[u] = 0.f; q[u] = 0.f;
#pragma unroll
            for (int j = 0; j < 4; ++j) {
                const int d0 = 256 * j + 4 * lane;
                const f32x4 xt = unpack4(*(const u32x2*)(X1 + (size_t)tok * 1024 + d0)); float4 xv; xv.x = xt[0]; xv.y = xt[1]; xv.z = xt[2]; xv.w = xt[3];
                const f32x4 c0 = unpack4(*(const u32x2*)(CT + (size_t)(tok * 2) * 1024 + d0)), c1 = unpack4(*(const u32x2*)(CT + (size_t)(tok * 2 + 1) * 1024 + d0));
                v[u][j].x = xv.x * DN_ALPHA + w0 * c0[0] + w1 * c1[0]; v[u][j].y = xv.y * DN_ALPHA + w0 * c0[1] + w1 * c1[1];
                v[u][j].z = xv.z * DN_ALPHA + w0 * c0[2] + w1 * c1[2]; v[u][j].w = xv.w * DN_ALPHA + w0 * c0[3] + w1 * c1[3];
                s[u] += v[u][j].x + v[u][j].y + v[u][j].z + v[u][j].w;
                q[u] += v[u][j].x * v[u][j].x + v[u][j].y * v[u][j].y + v[u][j].z * v[u][j].z + v[u][j].w * v[u][j].w;
            }
        }
#pragma unroll
        for (int u = 0; u < U; ++u) { s[u] = wave_sum(s[u]); q[u] = wave_sum(q[u]); }
#pragma unroll
        for (int j = 0; j < 4; ++j) {
            const int d0 = 256 * j + 4 * lane;
            const float4 gg = *(const float4*)(gam + d0), bb = *(const float4*)(bet + d0);
#pragma unroll
            for (int u = 0; u < U; ++u) {
                const int tok = t0 + u;
                const float mu = s[u] * (1.f / 1024.f), var = fmaxf(q[u] * (1.f / 1024.f) - mu * mu, 0.f), rstd = rsqrtf(var + 1e-5f);
                float4 y; y.x = (v[u][j].x - mu) * rstd * gg.x + bb.x; y.y = (v[u][j].y - mu) * rstd * gg.y + bb.y; y.z = (v[u][j].z - mu) * rstd * gg.z + bb.z; y.w = (v[u][j].w - mu) * rstd * gg.w + bb.w;
                if (fin) *(float4*)(XO + (size_t)tok * 1024 + d0) = y;
                else { u32x2 w; w.x = pack2(y.x, y.y); w.y = pack2(y.z, y.w); *(u32x2*)(XB + (size_t)tok * 1024 + d0) = w; }
            }
        }
    }
}

#define XB_TMO      128
#define XB_XCNT(j)  (256  + 64 * (j))
#define XB_XSUB(j)  (1280 + 64 * (j))
#define XB_XGEN(j)  (2304 + 64 * (j))
#define XB_TOP      3328
#define XB_TOPGEN   3392
#define XCD_BAR_WORDS 3456
#define XB_SPIN_CAP (1u << 22)
#define LAS __attribute__((address_space(3)))
__device__ __forceinline__ unsigned xb_ld(unsigned* p)              { return __hip_atomic_load(p, __ATOMIC_RELAXED, __HIP_MEMORY_SCOPE_AGENT); }
__device__ __forceinline__ unsigned xb_add(unsigned* p, unsigned v) { return __hip_atomic_fetch_add(p, v, __ATOMIC_RELAXED, __HIP_MEMORY_SCOPE_AGENT); }
__device__ __forceinline__ unsigned xb_xcc_id() { return (unsigned)__builtin_amdgcn_s_getreg((3 << 11) | 20) & 0xFu; }
#define XB_SPIN(cond, bar) do { unsigned _sp = 0; while (cond) { __builtin_amdgcn_s_sleep(1); \
    if ((++_sp & 255u) == 0u) { if (xb_ld(&(bar)[XB_TMO])) break; if (_sp > XB_SPIN_CAP) { atomicAdd(&(bar)[XB_TMO], 1u); break; } } } } while (0)
struct XcdBarrier { unsigned* bar; unsigned x; volatile LAS unsigned* st; };
__device__ __forceinline__ XcdBarrier xcd_barrier_post(unsigned* bar, volatile LAS unsigned* st) {
    XcdBarrier b; b.bar = bar; b.x = xb_xcc_id(); b.st = st;
    if (threadIdx.x == 0) (void)xb_add(&bar[XB_XCNT(b.x)], 1u);
    return b;
}
__device__ __forceinline__ void xcd_barrier_complete(unsigned* bar, unsigned x, unsigned& nloc, unsigned& nx) {
    const unsigned G = gridDim.x * gridDim.y * gridDim.z;
    unsigned sum, cnt, mine, sp = 0u;
    for (;;) {
        sum = 0u; cnt = 0u; mine = 0u;
#pragma unroll
        for (unsigned j = 0; j < 16; ++j) { const unsigned c = xb_ld(&bar[XB_XCNT(j)]); sum += c; cnt += (c > 0u) ? 1u : 0u; mine = (j == x) ? c : mine; }
        if (sum == G) break;
        __builtin_amdgcn_s_sleep(1);
        if ((++sp & 255u) == 0u) { if (xb_ld(&bar[XB_TMO])) break; if (sp > XB_SPIN_CAP) { atomicAdd(&bar[XB_TMO], 1u); break; } }
    }
    nloc = mine > 0u ? mine : 1u; nx = cnt > 0u ? cnt : 1u;
}
__device__ __forceinline__ void xcd_barrier(const XcdBarrier& b) {
    asm volatile("s_waitcnt vmcnt(0)" ::: "memory");
    __syncthreads();
    if (threadIdx.x == 0) {
        unsigned* bar = b.bar;
        __builtin_amdgcn_s_waitcnt(0);
        unsigned nloc = b.st[0], nx = b.st[1];
        if (nloc == 0u) { xcd_barrier_complete(bar, b.x, nloc, nx); b.st[0] = nloc; b.st[1] = nx; }
        const unsigned old = xb_add(&bar[XB_XSUB(b.x)], 1u);
        const unsigned gen = old / nloc;
        if (old + 1u == (gen + 1u) * nloc) {
            __builtin_amdgcn_fence(__ATOMIC_RELEASE, "agent");
            asm volatile("s_waitcnt vmcnt(0)" ::: "memory");
            const unsigned og = xb_add(&bar[XB_TOP], 1u);
            const unsigned tg = og / nx;
            if (og + 1u == (tg + 1u) * nx) xb_add(&bar[XB_TOPGEN], 1u);
            else XB_SPIN(xb_ld(&bar[XB_TOPGEN]) == tg, bar);
            __builtin_amdgcn_fence(__ATOMIC_ACQUIRE, "agent");
            xb_add(&bar[XB_XGEN(b.x)], 1u);
            asm volatile("s_waitcnt vmcnt(0)" ::: "memory");
        } else {
            XB_SPIN(xb_ld(&bar[XB_XGEN(b.x)]) == gen, bar);
            __builtin_amdgcn_fence(__ATOMIC_ACQUIRE, "agent");
            asm volatile("s_waitcnt vmcnt(0)" ::: "memory");
        }
    }
    __syncthreads();
}

constexpr int PH_PER_LAYER = 11, N_PHASES = PH_PER_LAYER * NLAYER;
__global__ void __launch_bounds__(NTHREADS, 2) mega(Params p) {
    extern __shared__ __attribute__((aligned(16))) unsigned char lds[];
#if SINGLE_LAUNCH
    volatile LAS unsigned* xbw = (volatile LAS unsigned*)(lds + LDS_BYTES - 16);
    if (threadIdx.x < 4) xbw[threadIdx.x] = 0u;
    __syncthreads();
    XcdBarrier xbar = xcd_barrier_post((unsigned*)(p.ws + WS_CTL) + CW_BAR, xbw);
#endif
    const int half = __builtin_amdgcn_readfirstlane((int)(threadIdx.x >> 8));
    unsigned char* ldsh = lds + half * HALF_LDS;
#if REPEAT_MASK == 0
    const int REPM = 0;
#else
    const int REPM = p.rep_mask;
#endif
    bool second = false;
    for (int ph = p.ph_lo; ph < p.ph_hi; ++ph) {
        const int layer = ph / PH_PER_LAYER, k = ph % PH_PER_LAYER;
        if (k == 0 && layer > 0) continue;
#ifdef ONLY_PHASE
        if (k != ONLY_PHASE) continue;
#endif
        switch (k) {
            case 0: phase_pw(p, layer, ldsh, 1 | 16 | 8, half); break;
            case 1: phase_g1(p, layer, lds); if (!second) { __syncthreads(); phase_pw(p, layer, ldsh, 4, half, 0, 1); } break;
            case 2: phase_p2(p, layer, ldsh, half); if (!second && layer + 1 < NLAYER) { __syncthreads(); phase_pw(p, layer + 1, ldsh, 1, half, 64); } break;
            case 3: phase_p3(p, ldsh, half, second ? ((REPM >> 16) & 7) : 7); if (!second) { __syncthreads(); phase_pw(p, layer, ldsh, 4, half, 0, 3); }
                    if (!second && layer + 1 < NLAYER) { __syncthreads(); phase_pw(p, layer + 1, ldsh, 16, half); }
                    if (!second && layer == 0) { __syncthreads(); phase_pw(p, 0, ldsh, 2, half); } break;
            case 4: { const int sub = second ? ((REPM >> 12) & 7) : 7;
                    if (sub & 1) phase_p4_sel(p, lds);
                    if ((sub & 4) && half == 0) { phase_pw(p, layer, ldsh, 4, half, 0, 2); __syncthreads(); }
                    if (sub & 2) phase_p4(p, ldsh, half);
                    if ((sub & 4) && half == 1) { __syncthreads(); phase_pw(p, layer, ldsh, 4, half, 0, 2); } } break;
            case 5: phase_g2(p, lds); break;
            case 6: phase_g3(p, layer, lds); break;
            case 7: phase_ln1(p, layer, ldsh, ((REPM >> 7) & 1) && !second, half); if (!second && layer + 1 < NLAYER) { __syncthreads(); phase_pw(p, layer + 1, ldsh, 2, half); } break;
            case 8: phase_m2(p, layer, lds, ldsh, half); break;
            case 9: phase_m3(p, layer, lds, ldsh, half); break;
            case 10: phase_ln2(p, layer, half); break;
        }

        if (ph + 1 < p.ph_hi) { if (ph == p.ph_lo && !second) cg::this_grid().sync(); else xcd_barrier(xbar); }
        if (((REPM >> k) & 1) && !second) { second = true; --ph; } else second = false;
    }
}

extern "C" void kernel_launch(void* const* d_in, const int* in_sizes, int n_in, void* d_out, int out_size, void* d_ws, size_t ws_size, hipStream_t stream) {
    static int grid = 0;
    if (grid == 0) {
        if (n_in != 18 || ws_size < WS_END) { fprintf(stderr, "kernel_launch: unexpected n_in %d or ws_size %zu < %zu\n", n_in, ws_size, (size_t)WS_END); grid = -1; return; }
        int dev = 0, cus = 0, per_cu = 0;
        hipGetDevice(&dev); hipDeviceGetAttribute(&cus, hipDeviceAttributeMultiprocessorCount, dev);
        hipFuncSetAttribute((const void*)mega, hipFuncAttributeMaxDynamicSharedMemorySize, LDS_BYTES);
        hipOccupancyMaxActiveBlocksPerMultiprocessor(&per_cu, (const void*)mega, NTHREADS, LDS_BYTES);
        if (per_cu < 1) per_cu = 1;
        if (per_cu > 1) per_cu = 1;
        grid = cus * per_cu;
        (void)hipGetLastError();
    }
    if (grid < 0) return;
    Params p{};
    p.x = (const float*)d_in[0]; p.w_in = (const float*)d_in[1]; p.cmp_pos = (const float*)d_in[2]; p.cmp_w1 = (const float*)d_in[3]; p.cmp_w2 = (const float*)d_in[4];
    p.w_br_a = (const float*)d_in[5]; p.w_br_b = (const float*)d_in[6]; p.w_o = (const float*)d_in[7]; p.ln1_g = (const float*)d_in[8]; p.ln1_b = (const float*)d_in[9];
    p.w_router = (const float*)d_in[10]; p.router_bias = (const float*)d_in[11]; p.w_gate = (const float*)d_in[12]; p.w_up = (const float*)d_in[13]; p.w_down = (const float*)d_in[14];
    p.ln2_g = (const float*)d_in[15]; p.ln2_b = (const float*)d_in[16]; p.rel_bias = (const float*)d_in[17];
    p.out = (float*)d_out; p.ws = (unsigned char*)d_ws; p.rep_mask = REPEAT_MASK;
#if SINGLE_LAUNCH
    hipMemsetAsync((unsigned char*)d_ws + WS_CTL + (size_t)CW_BAR * 4, 0, XCD_BAR_WORDS * 4, stream);
    p.ph_lo = 0; p.ph_hi = N_PHASES;
    void* args[] = {&p};
    hipError_t e = hipLaunchCooperativeKernel((const void*)mega, dim3(grid), dim3(NTHREADS), args, LDS_BYTES, stream);
    if (e != hipSuccess) fprintf(stderr, "cooperative launch failed: %s (grid %d)\n", hipGetErrorString(e), grid);
#else
    for (int ph = 0; ph < N_PHASES; ++ph) {
        p.ph_lo = ph; p.ph_hi = ph + 1;
        hipLaunchKernelGGL(mega, dim3(grid), dim3(NTHREADS), LDS_BYTES, stream, p);
    }
#endif
}
```

```cpp
#include <hip/hip_runtime.h>
#include <hip/hip_cooperative_groups.h>
#include <cstdio>
#include <cstdint>
namespace cg = cooperative_groups;

#ifndef REPEAT_MASK
#define REPEAT_MASK 0
#endif
#ifndef SINGLE_LAUNCH
#define SINGLE_LAUNCH 1
#endif

typedef unsigned short bf16_t;
typedef short bf16x8 __attribute__((ext_vector_type(8)));
typedef float f32x4 __attribute__((ext_vector_type(4)));
typedef unsigned u32x2 __attribute__((ext_vector_type(2)));
typedef unsigned u32x4 __attribute__((ext_vector_type(4)));

constexpr int B_ = 2, S_ = 8192, D_ = 1024, T_ = B_ * S_, NLAYER = 4;
constexpr int DIN = 6424;
constexpr int LD = 5376;
constexpr int NW = 6656;
constexpr int C_QA = 0, C_KC = 512, C_VC = 640, C_KS = 768, C_KW = 896, C_QR = 1024, C_KR = 1536, C_GR = 2048, C_MA = 3072, C_MB = 4096, C_GA = 5120,
              C_VS = 5376, C_VW = 5504, C_VR = 5632;
constexpr float DN_ALPHA = 1.681792830507429f;
constexpr int NE = 16;

constexpr size_t al256(size_t x) { return (x + 255) & ~(size_t)255; }
constexpr size_t WS_CTL = 0;
constexpr size_t WS_BUCKET = 65536;
constexpr size_t WS_ROPE = WS_BUCKET + 8192;
constexpr size_t WS_WIN = WS_ROPE + (size_t)8192 * 32 * 8;
constexpr size_t WS_WA = WS_WIN + (size_t)NW * 1024 * 2;
constexpr size_t WS_WB = WS_WA + (size_t)1024 * 512 * 2;
constexpr size_t WS_WO = WS_WB + (size_t)1024 * 1024 * 2;
constexpr size_t WS_WG = WS_WO + (size_t)1024 * 1024 * 2;
constexpr size_t WS_WU = WS_WG + (size_t)16 * 512 * 1024 * 2;
constexpr size_t WS_WD = WS_WU + (size_t)16 * 512 * 1024 * 2;
constexpr size_t WS_XB = WS_WD + (size_t)16 * 512 * 1024 * 2;
constexpr size_t WS_X = WS_XB + (size_t)T_ * 1024 * 2;
constexpr size_t WS_MG = WS_X + (size_t)T_ * 1024 * 4;
constexpr size_t WS_KCC = WS_MG + (size_t)T_ * 1024 * 2;
constexpr size_t WS_VCCT = WS_KCC + (size_t)4 * 512 * 64 * 2;
constexpr size_t WS_W1T = WS_VCCT + (size_t)4 * 512 * 64 * 2;
constexpr size_t WS_B1 = WS_W1T + (size_t)2 * 64 * 2048 * 2;
constexpr size_t WS_R = WS_B1 + 1024;
constexpr size_t WS_P = WS_R;
constexpr size_t WS_VST = WS_P + (size_t)T_ * LD * 2;
constexpr size_t WS_VWT = WS_VST + (size_t)4 * 64 * S_ * 2;
constexpr size_t WS_VRT = WS_VWT + (size_t)4 * 64 * S_ * 2;
constexpr size_t WS_KVT = WS_VRT + (size_t)16 * 128 * S_ * 2;
constexpr size_t WS_SPT = WS_KVT + (size_t)16 * 64 * 8192 * 4;
constexpr size_t WS_YC = WS_SPT + (size_t)16 * 64 * 8192 * 2;
constexpr size_t WS_YW = WS_YC + (size_t)T_ * 512 * 2;
constexpr size_t WS_YA = WS_YW + (size_t)T_ * 512 * 2;
constexpr size_t WS_YB = WS_YA + (size_t)T_ * 512 * 2;
constexpr size_t WS_SELW = WS_YB + (size_t)T_ * 1024 * 2;
constexpr size_t WS_ENDA = WS_SELW + (size_t)T_ * 2 * 4 * 4;
constexpr size_t WS_H1 = WS_R;
constexpr size_t WS_X1 = WS_H1 + (size_t)T_ * 1024 * 4;
constexpr size_t WS_X1B = WS_X1 + (size_t)T_ * 1024 * 4;
constexpr size_t WS_HB = WS_X1B + (size_t)T_ * 1024 * 2;
constexpr size_t WS_CT = WS_HB + (size_t)2 * T_ * 512 * 2;
constexpr size_t WS_LIST = WS_CT + (size_t)2 * T_ * 1024 * 2;
constexpr size_t WS_WTS = WS_LIST + (size_t)16 * T_ * 4;
constexpr size_t WS_ENDB = WS_WTS + (size_t)2 * T_ * 4;
static_assert(WS_HB + (size_t)2 * T_ * 512 * 2 <= WS_CT, "view B overlap");
constexpr size_t WS_END = WS_ENDA > WS_ENDB ? WS_ENDA : WS_ENDB;

constexpr int CW_CNT = 4096;
constexpr int CW_BAR = 8192;
constexpr int CW_B1P = 12288;

constexpr int HALF_LDS = 75776, LDS_BYTES = 2 * HALF_LDS + 16;
constexpr int NTHREADS = 512, HT = 256;

struct Params {
    const float* x; const float* w_in; const float* cmp_pos; const float* cmp_w1; const float* cmp_w2;
    const float* w_br_a; const float* w_br_b; const float* w_o; const float* ln1_g; const float* ln1_b;
    const float* w_router; const float* router_bias; const float* w_gate; const float* w_up; const float* w_down;
    const float* ln2_g; const float* ln2_b; const float* rel_bias;
    float* out; unsigned char* ws;
    int ph_lo, ph_hi, rep_mask, pad_;
};

__device__ __forceinline__ bf16_t f2bf(float f) { unsigned u = __float_as_uint(f); u += 0x7fffu + ((u >> 16) & 1u); return (bf16_t)(u >> 16); }
__device__ __forceinline__ float bf2f(unsigned h) { return __uint_as_float(h << 16); }
typedef __bf16 bf16x2_t __attribute__((ext_vector_type(2)));
typedef float f32x2_t __attribute__((ext_vector_type(2)));
__device__ __forceinline__ unsigned pack2(float lo, float hi) { const f32x2_t f = {lo, hi}; return __builtin_bit_cast(unsigned, __builtin_convertvector(f, bf16x2_t)); }
__device__ __forceinline__ u32x2 pack4(f32x4 v) { u32x2 r; r.x = pack2(v[0], v[1]); r.y = pack2(v[2], v[3]); return r; }
__device__ __forceinline__ f32x4 unpack4(u32x2 u) { f32x4 r; r[0] = bf2f(u.x & 0xffffu); r[1] = bf2f(u.x >> 16); r[2] = bf2f(u.y & 0xffffu); r[3] = bf2f(u.y >> 16); return r; }
__device__ __forceinline__ float rows_max(float v) {
    u32x2 r = __builtin_amdgcn_permlane16_swap(__float_as_uint(v), __float_as_uint(v), false, false);
    v = fmaxf(__uint_as_float(r.x), __uint_as_float(r.y));
    r = __builtin_amdgcn_permlane32_swap(__float_as_uint(v), __float_as_uint(v), false, false);
    return fmaxf(__uint_as_float(r.x), __uint_as_float(r.y));
}
__device__ __forceinline__ float rows_sum(float v) {
    u32x2 r = __builtin_amdgcn_permlane16_swap(__float_as_uint(v), __float_as_uint(v), false, false);
    v = __uint_as_float(r.x) + __uint_as_float(r.y);
    r = __builtin_amdgcn_permlane32_swap(__float_as_uint(v), __float_as_uint(v), false, false);
    return __uint_as_float(r.x) + __uint_as_float(r.y);
}
__device__ __forceinline__ float wave_sum(float v) {
    v += __int_as_float(__builtin_amdgcn_mov_dpp(__float_as_int(v), 0xB1, 0xF, 0xF, true));
    v += __int_as_float(__builtin_amdgcn_mov_dpp(__float_as_int(v), 0x4E, 0xF, 0xF, true));
    v += __int_as_float(__builtin_amdgcn_mov_dpp(__float_as_int(v), 0x141, 0xF, 0xF, true));
    v += __int_as_float(__builtin_amdgcn_mov_dpp(__float_as_int(v), 0x140, 0xF, 0xF, true));
    return rows_sum(v);
}
__device__ __forceinline__ float sigmoidf_(float x) { return 1.f / (1.f + __expf(-x)); }
__device__ __forceinline__ int ltid() { int t = threadIdx.x; asm volatile("" : "+v"(t)); return t; }
__device__ __forceinline__ int vzero() { int z; asm volatile("v_mov_b32 %0, 0" : "=v"(z)); return z; }
__device__ __forceinline__ unsigned char* launder(unsigned char* q) { asm volatile("" : "+s"(q)); return q; }
__device__ __forceinline__ void wait_vm0() { asm volatile("s_waitcnt vmcnt(0)" ::: "memory"); }

__device__ __forceinline__ void glds16(const void* g, void* l) {
    __builtin_amdgcn_global_load_lds((const __attribute__((address_space(1))) unsigned*)g,
                                     (__attribute__((address_space(3))) unsigned*)l, 16, 0, 0);
}
__device__ __forceinline__ f32x4 mfma16(bf16x8 a, bf16x8 b, f32x4 c) { return __builtin_amdgcn_mfma_f32_16x16x32_bf16(a, b, c, 0, 0, 0); }

#define WAIT_V(n) asm volatile("s_waitcnt vmcnt(%0)" ::"n"(n) : "memory")
#define RAW_BARRIER() do { asm volatile("s_waitcnt lgkmcnt(0)" ::: "memory"); __builtin_amdgcn_s_barrier(); } while (0)
__device__ __forceinline__ void bglds16(__amdgpu_buffer_rsrc_t r, unsigned voff, int soff, void* l) {
    __builtin_amdgcn_raw_ptr_buffer_load_lds(r, (__attribute__((address_space(3))) void*)l, 16, (int)voff, soff, 0, 0);
}
template <int NJ, bool GN>
__device__ __forceinline__ void gemm8_stage(__amdgpu_buffer_rsrc_t mr, int mld, unsigned mvo, __amdgpu_buffer_rsrc_t nr, int nld, const unsigned (&nvo)[NJ], int kt, unsigned char* st, int wid) {
#pragma unroll
    for (int i = 0; i < 4; ++i) bglds16(mr, mvo, (64 * i * mld + kt * 64) * 2, st + (8 * i + wid) * 1024);
#pragma unroll
    for (int i = 0; i < NJ; ++i) bglds16(nr, nvo[i], ((GN ? 0 : 64 * i * nld) + kt * 64) * 2, st + 32768 + (8 * i + wid) * 1024);
}
template <int NJ, bool GN>
__device__ __forceinline__ void gemm8_kloop(const bf16_t* mb, int mld, unsigned mvo, const bf16_t* nb, int nld, const unsigned (&nvo)[NJ], int nk, unsigned char* lds, f32x4 (&acc)[8][NJ], int tid) {
    const int lane = tid & 63, wid = tid >> 6, wr = wid >> 2, wc = wid & 3, fr = lane & 15, fq = lane >> 4;
    const __amdgpu_buffer_rsrc_t mr = __builtin_amdgcn_make_buffer_rsrc((void*)mb, 0, 0x7fffffff, 0x00020000);
    const __amdgpu_buffer_rsrc_t nr = __builtin_amdgcn_make_buffer_rsrc((void*)nb, 0, 0x7fffffff, 0x00020000);
    gemm8_stage<NJ, GN>(mr, mld, mvo, nr, nld, nvo, 0, lds, wid);
    gemm8_stage<NJ, GN>(mr, mld, mvo, nr, nld, nvo, 1, lds + 65536, wid);
    for (int kt = 0; kt < nk; ++kt) {
        unsigned char* cur = lds + (kt & 1) * 65536;
        if (kt + 1 < nk) WAIT_V(4 + NJ); else WAIT_V(0);
        RAW_BARRIER();
        bf16x8 a[4], b[NJ];
        const unsigned char* ab = cur + (128 * wr + fr) * 128;
        const unsigned char* bb = cur + 32768 + (16 * NJ * wc + fr) * 128;
        const int sw0 = ((fq) ^ (fr & 7)) << 4, sw1 = ((4 + fq) ^ (fr & 7)) << 4;
#pragma unroll
        for (int j = 0; j < NJ; ++j) b[j] = *(const bf16x8*)(bb + j * 2048 + sw0);
#pragma unroll
        for (int mh = 0; mh < 2; ++mh) {
#pragma unroll
            for (int i = 0; i < 4; ++i) a[i] = *(const bf16x8*)(ab + (4 * mh + i) * 2048 + sw0);
#pragma unroll
            for (int i = 0; i < 4; ++i)
#pragma unroll
                for (int j = 0; j < NJ; ++j) acc[4 * mh + i][j] = mfma16(a[i], b[j], acc[4 * mh + i][j]);
        }
#pragma unroll
        for (int j = 0; j < NJ; ++j) b[j] = *(const bf16x8*)(bb + j * 2048 + sw1);
#pragma unroll
        for (int i = 0; i < 4; ++i) a[i] = *(const bf16x8*)(ab + i * 2048 + sw1);
#pragma unroll
        for (int i = 0; i < 4; ++i)
#pragma unroll
            for (int j = 0; j < NJ; ++j) acc[i][j] = mfma16(a[i], b[j], acc[i][j]);
#pragma unroll
        for (int i = 0; i < 4; ++i) a[i] = *(const bf16x8*)(ab + (4 + i) * 2048 + sw1);
        RAW_BARRIER();
        if (kt + 2 < nk) gemm8_stage<NJ, GN>(mr, mld, mvo, nr, nld, nvo, kt + 2, cur, wid);
#pragma unroll
        for (int i = 0; i < 4; ++i)
#pragma unroll
            for (int j = 0; j < NJ; ++j) acc[4 + i][j] = mfma16(a[i], b[j], acc[4 + i][j]);
    }
    __syncthreads();
    __builtin_amdgcn_sched_barrier(0);
}
template <int NJ>
__device__ __forceinline__ void zero_acc8(f32x4 (&acc)[8][NJ]) {
#pragma unroll
    for (int i = 0; i < 8; ++i)
#pragma unroll
        for (int j = 0; j < NJ; ++j) acc[i][j] = (f32x4){0.f, 0.f, 0.f, 0.f};
}

namespace pg8 {
#define PG8_LAS __attribute__((address_space(3)))
constexpr int BM = 256, BK = 64, HALF = 128, HTB = HALF * BK * 2, STAGE_BYTES = 8 * HTB;
__device__ __forceinline__ int lds_byte(int r, int c) { const int st = (r >> 4) * 2 + (c >> 5), rr = r & 15, cc = c & 31, ob = rr * 64 + cc * 2; return st * 1024 + (ob ^ (((ob >> 9) & 1) << 5)); }
__device__ __forceinline__ void stage_rc(int b, int& R, int& C) { const int st = b / 1024, sb = b % 1024, swz = sb ^ (((sb >> 9) & 1) << 5); R = (st >> 1) * 16 + swz / 64; C = (st & 1) * 32 + (swz % 64) / 2; }
__device__ __forceinline__ int perm32(int rho) { const int n = rho >> 4, i = rho & 15; return 8 * (i >> 2) + 4 * n + (i & 3); }
struct Unit { int pm, pn; };
template <class Epi, class Sched>
__device__ __forceinline__ void gemm_phase(unsigned char* lds_, const int K, const Sched& S, const Epi& E, const int tid, const unsigned char* wsbase) {
    PG8_LAS unsigned char* lds = (PG8_LAS unsigned char*)lds_;
    const int wid = __builtin_amdgcn_readfirstlane(tid >> 6), lane = tid & 63, wr = wid >> 2, wc = wid & 3, fr = lane & 15, fq = lane >> 4;
    const int nt = K / BK;
    unsigned voffA[2], voffB[2];
#pragma unroll
    for (int i = 0; i < 2; ++i) { int R, C; stage_rc(tid * 16 + i * 8192, R, C); const int Rb = (R & ~31) + perm32(R & 31);
        voffA[i] = (unsigned)(R * K + C) * 2u; voffB[i] = (unsigned)(Rb * K + C) * 2u; }
    const unsigned kstep = (unsigned)(BK * 2);
    const unsigned hstep = (unsigned)HALF * K * 2;
    const __amdgpu_buffer_rsrc_t rsrc = __builtin_amdgcn_make_buffer_rsrc((void*)wsbase, 0, 0x7fffffff, 0x00020000);
    const unsigned ldsw = (unsigned)wid * 1024u;
    const int aoff = lds_byte(wr * 64 + fr, fq * 8), boff = lds_byte(wc * 32 + fr, fq * 8);
#define PG8_SA(b, h) (((b) * 2 + (h)) * HTB)
#define PG8_SB(b, h) ((4 + (b) * 2 + (h)) * HTB)
#define PG8_STAGE(bufoff, gbase, voff) do { _Pragma("unroll") for (int _i = 0; _i < 2; ++_i) \
        __builtin_amdgcn_raw_ptr_buffer_load_lds(rsrc, (PG8_LAS void*)(lds + (bufoff) + ldsw + _i * 8192), 16, (int)(voff)[_i], (int)(gbase), 0, 0); } while (0)
#define PG8_LDA(dst, b, h) do { _Pragma("unroll") for (int m = 0; m < 4; ++m) _Pragma("unroll") for (int k = 0; k < 2; ++k) dst[m][k] = *(const PG8_LAS bf16x8*)(lds + PG8_SA(b, h) + aoff + m * 2048 + k * 1024); } while (0)
#define PG8_LDB(dst, b, h) do { _Pragma("unroll") for (int n = 0; n < 2; ++n) _Pragma("unroll") for (int k = 0; k < 2; ++k) dst[n][k] = *(const PG8_LAS bf16x8*)(lds + PG8_SB(b, h) + boff + n * 2048 + k * 1024); } while (0)
#define PG8_MMA(ai, bj, At, Bt) do { __builtin_amdgcn_s_setprio(1); _Pragma("unroll") for (int m = 0; m < 4; ++m) _Pragma("unroll") for (int n = 0; n < 2; ++n) _Pragma("unroll") for (int k = 0; k < 2; ++k) \
        acc[ai][bj][m][n] = __builtin_amdgcn_mfma_f32_16x16x32_bf16(Bt[n][k], At[m][k], acc[ai][bj][m][n], 0, 0, 0); __builtin_amdgcn_s_setprio(0); } while (0)
#define PG8_WAIT_V(n) asm volatile("s_waitcnt vmcnt(" #n ")" ::: "memory")
#define PG8_WAIT_L(n) asm volatile("s_waitcnt lgkmcnt(" #n ")" ::: "memory")
#define PG8_BAR __builtin_amdgcn_s_barrier()
#define PG8_SCHED __builtin_amdgcn_sched_barrier(0)
    typename Sched::U cur, nxt; int ui = 0;
    if (!S.next(0, cur)) return;
    unsigned cA, cB; S.ptrs(cur, cA, cB);
    constexpr bool GA = Sched::GATHER;
    unsigned vA[2], nvA[2];
    if constexpr (GA) { S.rows(cur, tid, vA); nvA[0] = vA[0]; nvA[1] = vA[1]; }
#define PG8_STAGE_G(bufoff, gbase, pk) do { const unsigned _cb = voffB[0] & (unsigned)(2 * K - 1); unsigned _vo[2] = {(((pk) & 0xffffu) * (unsigned)(2 * K)) + _cb, (((pk) >> 16) * (unsigned)(2 * K)) + _cb}; PG8_STAGE(bufoff, gbase, _vo); } while (0)
#define PG8_STAGE_A(bufoff, gbase, h, nextu) do { if constexpr (GA) { if (nextu) PG8_STAGE_G(bufoff, gbase, nvA[h]); else PG8_STAGE_G(bufoff, gbase, vA[h]); } \
        else PG8_STAGE(bufoff, (gbase) + (h) * hstep, voffA); } while (0)
    PG8_STAGE(PG8_SB(0, 0), cB, voffB); PG8_STAGE_A(PG8_SA(0, 0), cA, 0, false); PG8_STAGE(PG8_SB(0, 1), cB + hstep, voffB); PG8_STAGE_A(PG8_SA(0, 1), cA, 1, false);
    if (wr == 1) PG8_BAR;
    PG8_WAIT_V(4); PG8_BAR;
    PG8_STAGE(PG8_SB(1, 0), cB + kstep, voffB); PG8_STAGE_A(PG8_SA(1, 0), cA + kstep, 0, false); PG8_STAGE(PG8_SB(1, 1), cB + hstep + kstep, voffB);
    PG8_WAIT_V(6); PG8_BAR;
    PG8_SCHED;
    f32x4 acc[2][2][4][2];
#pragma unroll
    for (int a = 0; a < 2; ++a)
#pragma unroll
        for (int b = 0; b < 2; ++b)
#pragma unroll
            for (int m = 0; m < 4; ++m)
#pragma unroll
                for (int n = 0; n < 2; ++n) acc[a][b][m][n] = (f32x4){0.f, 0.f, 0.f, 0.f};
    bf16x8 At[4][2], B0[2][2], B1[2][2];
    for (;;) {
        const bool has_next = S.next(ui + 1, nxt);
        unsigned nA = cA, nB = cB; if (has_next) S.ptrs(nxt, nA, nB);
        if constexpr (GA) { if (has_next) S.rows(nxt, tid, nvA); }
        for (int t = 0; t < nt; t += 2) {
            if constexpr (Epi::MID_T > 0) { if (t == Epi::MID_T) E.mid(acc, cur, wr, wc, fr, fq); }
            const bool last = (t == nt - 2);
            const unsigned a1 = cA + (unsigned)(t + 1) * kstep;
            const unsigned a2 = last ? nA : cA + (unsigned)(t + 2) * kstep, b2 = last ? nB : cB + (unsigned)(t + 2) * kstep;
            const unsigned a3 = a2 + kstep, b3 = b2 + kstep;
            PG8_LDB(B0, 0, 0); PG8_SCHED; PG8_LDA(At, 0, 0); PG8_STAGE_A(PG8_SA(1, 1), a1, 1, false);
            PG8_WAIT_L(8); PG8_BAR; PG8_WAIT_L(0); PG8_MMA(0, 0, At, B0); PG8_BAR; PG8_SCHED;
            PG8_LDB(B1, 0, 1); PG8_STAGE(PG8_SB(0, 0), b2, voffB);
            PG8_BAR; PG8_WAIT_L(0); PG8_MMA(0, 1, At, B1); PG8_BAR;
            PG8_LDA(At, 0, 1); PG8_STAGE_A(PG8_SA(0, 0), a2, 0, last);
            PG8_BAR; PG8_WAIT_L(0); PG8_MMA(1, 0, At, B0); PG8_BAR; PG8_SCHED;
            PG8_STAGE(PG8_SB(0, 1), b2 + hstep, voffB);
            PG8_WAIT_V(6); PG8_BAR; PG8_MMA(1, 1, At, B1); PG8_BAR;
            PG8_LDB(B0, 1, 0); PG8_SCHED; PG8_LDA(At, 1, 0); PG8_STAGE_A(PG8_SA(0, 1), a2, 1, last);
            PG8_WAIT_L(8); PG8_BAR; PG8_WAIT_L(0); PG8_MMA(0, 0, At, B0); PG8_BAR; PG8_SCHED;
            PG8_LDB(B1, 1, 1); PG8_STAGE(PG8_SB(1, 0), b3, voffB);
            PG8_BAR; PG8_WAIT_L(0); PG8_MMA(0, 1, At, B1); PG8_BAR;
            PG8_LDA(At, 1, 1); PG8_STAGE_A(PG8_SA(1, 0), a3, 0, last);
            PG8_BAR; PG8_WAIT_L(0); PG8_MMA(1, 0, At, B0); PG8_BAR; PG8_SCHED;
            PG8_STAGE(PG8_SB(1, 1), b3 + hstep, voffB);
            PG8_WAIT_V(6); PG8_BAR; PG8_MMA(1, 1, At, B1); PG8_BAR;
        }
        E(acc, cur, wr, wc, fr, fq);
        if (!has_next) break;
#pragma unroll
        for (int a = 0; a < 2; ++a)
#pragma unroll
            for (int b = 0; b < 2; ++b)
#pragma unroll
                for (int m = 0; m < 4; ++m)
#pragma unroll
                    for (int n = 0; n < 2; ++n) acc[a][b][m][n] = (f32x4){0.f, 0.f, 0.f, 0.f};
        cur = nxt; cA = nA; cB = nB; ++ui;
        if constexpr (GA) { vA[0] = nvA[0]; vA[1] = nvA[1]; }
    }
    PG8_WAIT_V(0);
    if (wr == 0) PG8_BAR;
    PG8_BAR;
#undef PG8_SA
#undef PG8_SB
#undef PG8_STAGE
#undef PG8_STAGE_A
#undef PG8_STAGE_G
#undef PG8_LDA
#undef PG8_LDB
#undef PG8_MMA
#undef PG8_WAIT_V
#undef PG8_WAIT_L
#undef PG8_BAR
#undef PG8_SCHED
}
}

struct TJob { const float* src; bf16_t* dst; int ld, k0, n0, mode, kdst; };
__device__ __forceinline__ void tcvt_load(const TJob& J, float4 (&v)[4], int tid) {
#pragma unroll
    for (int i = 0; i < 4; ++i) {
        const int kk = (tid >> 4) + 16 * i, c4 = (tid & 15) * 4, cd = J.n0 + c4;
        int orig = cd; bool ok = true;
        if (J.mode == 1) {
            if (cd < 896) orig = cd;
            else if (cd < 1024) orig = cd - 896 + 1024;
            else if (cd < 2048) { const int q = cd - 1024, hd = q >> 6, pp = q & 63;
                const int d = (pp & 4) ? 32 + 4 * (pp >> 3) + (pp & 3) : 4 * (pp >> 3) + (pp & 3);
                orig = 1304 + hd * 64 + d; }
            else if (cd < 5120) orig = cd - 2048 + 3352;
            else if (cd < 5144) orig = cd - 5120 + 1280;
            else if (cd < 5376) ok = false;
            else if (cd < 5504) orig = cd - 5376 + 896;
            else if (cd < 5632) orig = cd - 5504 + 1152;
            else orig = cd - 5632 + 2328;
        }
        v[i] = make_float4(0.f, 0.f, 0.f, 0.f);
        if (ok) v[i] = *(const float4*)(J.src + (size_t)(J.k0 + kk) * J.ld + orig);
    }
}
__device__ __forceinline__ void tcvt_finish(const TJob& J, const float4 (&v)[4], unsigned char* lds, int tid) {
    float* tile = (float*)lds;
#pragma unroll
    for (int i = 0; i < 4; ++i) {
        const int kk = (tid >> 4) + 16 * i, c4 = (tid & 15) * 4;
        tile[kk * 65 + c4 + 0] = v[i].x; tile[kk * 65 + c4 + 1] = v[i].y; tile[kk * 65 + c4 + 2] = v[i].z; tile[kk * 65 + c4 + 3] = v[i].w;
    }
    __syncthreads();
#pragma unroll
    for (int i = 0; i < 2; ++i) {
        const int q = tid + 256 * i, n = q >> 3, kc = q & 7;
        float x[8];
#pragma unroll
        for (int j = 0; j < 8; ++j) x[j] = tile[(kc * 8 + j) * 65 + n];
        u32x4 w; w.x = pack2(x[0], x[1]); w.y = pack2(x[2], x[3]); w.z = pack2(x[4], x[5]); w.w = pack2(x[6], x[7]);
        int drow = J.n0 + n; if (J.mode == 2 || J.mode == 3) drow = 8 * (drow >> 2) + (drow & 3) + (J.mode == 3 ? 4 : 0);
        if (J.mode == 4) {
            bf16_t* d = J.dst + (size_t)drow * J.kdst + 128 * (J.k0 >> 7) + 32 * (kc >> 1) + 16 * (kc & 1) + 4 * ((J.k0 >> 6) & 1);
            *(u32x2*)d = (u32x2){w.x, w.y}; *(u32x2*)(d + 8) = (u32x2){w.z, w.w};
        } else
        *(u32x4*)(J.dst + (size_t)drow * J.kdst + J.k0 + kc * 8) = w;
    }
    __syncthreads();
}
__device__ __forceinline__ void tcvt_tile(const float* src, int ld_src, int k0, int n0, int mode, bf16_t* dst, int kdst, unsigned char* lds, int half) {
    TJob J; J.src = src; J.dst = dst; J.ld = ld_src; J.k0 = k0; J.n0 = n0; J.mode = mode; J.kdst = kdst;
    const int tid = (ltid() & 255); float4 v[4];
    tcvt_load(J, v, tid); tcvt_finish(J, v, lds, tid);
}

__device__ __forceinline__ void tcvt_decode(const Params& p, unsigned char* ws, int layer, int t, TJob& J) {
    constexpr int J0 = 16 * 104, J1 = 8 * 16, J2 = 256, J3 = 256, J4 = 2048, J5 = 2048;
    int u = t;
        if (u < J0) { J.src = p.w_in + (size_t)layer * 1024 * DIN; J.ld = DIN; J.k0 = (u % 16) * 64; J.n0 = (u / 16) * 64; J.mode = 1; J.dst = (bf16_t*)(ws + WS_WIN); J.kdst = 1024; return; }
        u -= J0;
        if (u < J1) { J.src = p.w_br_a + (size_t)layer * 512 * 1024; J.ld = 1024; J.k0 = (u % 8) * 64; J.n0 = (u / 8) * 64; J.mode = 0; J.dst = (bf16_t*)(ws + WS_WA); J.kdst = 1536; return; }
        u -= J1;
        if (u < J2) { J.src = p.w_br_b + (size_t)layer * 1024 * 1024; J.ld = 1024; J.k0 = (u % 16) * 64; J.n0 = (u / 16) * 64; J.mode = 0; J.dst = (bf16_t*)(ws + WS_WA) + 512; J.kdst = 1536; return; }
        u -= J2;
        if (u < J3) { J.src = p.w_o + (size_t)layer * 1024 * 1024; J.ld = 1024; J.k0 = (u % 16) * 64; J.n0 = (u / 16) * 64; J.mode = 0; J.dst = (bf16_t*)(ws + WS_WO); J.kdst = 1024; return; }
        u -= J3;
        if (u < J4 + J5) {
            const bool up = u >= J4; if (up) u -= J4;
            const int e = u / 128, v = u % 128;
            J.src = (up ? p.w_up : p.w_gate) + ((size_t)layer * NE + e) * 1024 * 512; J.ld = 512; J.k0 = (v % 16) * 64; J.n0 = (v / 16) * 64; J.mode = up ? 3 : 2;
            J.dst = (bf16_t*)(ws + WS_WG) + (size_t)e * 1024 * 1024; J.kdst = 1024; return;
        }
        u -= J4 + J5;
        { const int e = u / 128, v = u % 128;
          J.src = p.w_down + ((size_t)layer * NE + e) * 512 * 1024; J.ld = 1024; J.k0 = (v % 8) * 64; J.n0 = (v / 8) * 64; J.mode = 4; J.dst = (bf16_t*)(ws + WS_WD) + (size_t)e * 1024 * 512; J.kdst = 512; }
}


__device__ __forceinline__ void phase_pw(const Params& p, int layer, unsigned char* lds, int parts, int half, int skip = 0, int split = 0) {
    const int hq = __builtin_amdgcn_readfirstlane(ltid() >> 8);
    if ((int)(blockIdx.x * 2 + hq) < skip) return;
    constexpr int MOE_A = 2048, MOE_B = 1024;
    const int bid = split == 1 ? ((int)blockIdx.x - (int)(gridDim.x >> 1)) * 2 + hq : (blockIdx.x * 2 + hq) - skip, nblk = split == 1 ? (int)gridDim.x : split == 3 ? (int)(gridDim.x >> 1) : (gridDim.x * 2) - skip, tid = (ltid() & 255);
    if (bid < 0 || (split == 3 && bid >= nblk)) return;
    unsigned char* ws = launder(p.ws);
    constexpr int J0 = 16 * 104, J1 = 8 * 16, J2 = 256, J3 = 256, J4 = 2048, J5 = 2048, J6 = 2048, JT = J0 + J1 + J2 + J3 + J4 + J5 + J6;
    const int t_lo = ((parts & 1) ? 0 : (parts & 2) ? J0 : J0 + J1 + J2 + J3) + (split == 2 ? MOE_A + MOE_B : split == 3 ? MOE_A : 0);
    const int t_hi = split == 1 ? J0 + J1 + J2 + J3 + MOE_A : split == 3 ? J0 + J1 + J2 + J3 + MOE_A + MOE_B : (parts & 4) ? JT : (parts & 2) ? J0 + J1 + J2 + J3 : (parts & 1) ? J0 : 0;
    if (t_lo + bid < t_hi) {
        float4 v[4]; { TJob J; tcvt_decode(p, ws, layer, t_lo + bid, J); tcvt_load(J, v, tid); }
        for (int t = t_lo + bid; t < t_hi; t += nblk) {
            float4 vn[4];
            if (t + nblk < t_hi) { TJob J; tcvt_decode(p, ws, layer, t + nblk, J); tcvt_load(J, vn, tid); }
            { TJob J; tcvt_decode(p, ws, layer, t, J); tcvt_finish(J, v, lds, tid); }
#pragma unroll
            for (int i = 0; i < 4; ++i) v[i] = vn[i];
        }
    }
    if (parts & 16) {
    for (int t = bid; t < 64; t += nblk) {
        const int kv = t >> 5, kt = t & 31;
        const float* w1 = p.cmp_w1 + ((size_t)layer * 2 + kv) * 2048 * 64;
        tcvt_tile(w1, 64, kt * 64, 0, 0, (bf16_t*)(ws + WS_W1T) + (size_t)kv * 64 * 2048, 2048, lds, half);
        const int n = tid & 63, part = tid >> 6;
        const float* pos = p.cmp_pos + ((size_t)layer * 2 + kv) * 2048 + kt * 64 + part * 16;
        const float* wp = w1 + (size_t)(kt * 64 + part * 16) * 64 + n;
        float a = 0.f;
#pragma unroll
        for (int k = 0; k < 16; ++k) a += pos[k] * wp[(size_t)k * 64];
        float* red = (float*)lds;
        __syncthreads(); red[tid] = a; __syncthreads();
        if (tid < 64) ((float*)(ws + WS_CTL) + CW_B1P)[(kv * 32 + kt) * 64 + tid] = red[tid] + red[tid + 64] + red[tid + 128] + red[tid + 192];
        __syncthreads();
    }
    }
    if (parts & 8) {
        const float4* xs = (const float4*)p.x; u32x2* xb = (u32x2*)(ws + WS_XB);
        {
            const size_t n4 = (size_t)T_ * 1024 / 4, step = (size_t)nblk * HT;
            for (size_t i0 = (size_t)bid * HT + tid; i0 < n4; i0 += 8 * step) {
                float4 v[8];
#pragma unroll
                for (int u = 0; u < 8; ++u) { const size_t i = i0 + u * step; v[u] = xs[i < n4 ? i : i0]; }
#pragma unroll
                for (int u = 0; u < 8; ++u) { const size_t i = i0 + u * step; if (i < n4) { u32x2 w; w.x = pack2(v[u].x, v[u].y); w.y = pack2(v[u].z, v[u].w); xb[i] = w; } }
            }
        }
        for (int n = bid * HT + tid; n < 8192; n += nblk * HT) {
            int bk;
            if (n < 16) bk = n;
            else { const int th[15] = {22, 30, 40, 54, 73, 99, 134, 182, 246, 332, 450, 609, 825, 1117, 1513}; bk = 16;
#pragma unroll
                for (int k = 0; k < 15; ++k) bk += (n >= th[k]) ? 1 : 0; }
            (ws + WS_BUCKET)[n] = (unsigned char)bk;
        }
        for (int i = bid * HT + tid; i < 8192 * 32; i += nblk * HT) {
            const int pos = i >> 5, d = i & 31;
            const float inv = powf(10000.f, -(float)d * 2.0f / 64.f);
            const float ang = (float)pos * inv;
            float sn, cs; sincosf(ang, &sn, &cs);
            ((float2*)(ws + WS_ROPE))[i] = make_float2(cs, sn);
        }
        if (bid == 0) for (int i = tid; i < CW_BAR + 3456; i += HT) ((unsigned*)(ws + WS_CTL))[i] = 0u;
    }
}

__device__ __forceinline__ float fsig(float x) { return __builtin_amdgcn_rcpf(1.f + __builtin_amdgcn_exp2f(-1.4426950408889634f * x)); }
template <int KIND>
__device__ __forceinline__ void g1_epi(const f32x4 (&acc)[2][2][4][2], unsigned char* ws, int r0, int c0, int wr, int wc, int fr, int fq) {
#pragma unroll
    for (int ai = 0; ai < 2; ++ai)
#pragma unroll
        for (int m = 0; m < 4; ++m) {
            const int row = r0 + 128 * ai + 64 * wr + 16 * m + fr + vzero();
#pragma unroll
            for (int bj = 0; bj < 2; ++bj) {
                const int col = c0 + 128 * bj + 32 * wc + 8 * fq;
                if (KIND == 4 && col >= C_GA + 24) continue;
                f32x4 v0 = acc[ai][bj][m][0], v1 = acc[ai][bj][m][1];
                if (KIND == 5) {
                    const int b = col >> 13, sq = col & (S_ - 1);
                    bf16_t* dst;
                    if (row < C_VW) { const int c = row - C_VS; dst = (bf16_t*)(ws + WS_VST) + ((size_t)(b * 2 + (c >> 6)) * 64 + (c & 63)) * S_ + sq; }
                    else if (row < C_VR) { const int c = row - C_VW; dst = (bf16_t*)(ws + WS_VWT) + ((size_t)(b * 2 + (c >> 6)) * 64 + (c & 63)) * S_ + sq; }
                    else { const int c = row - C_VR; dst = (bf16_t*)(ws + WS_VRT) + ((size_t)(b * 8 + (c >> 7)) * 128 + (c & 127)) * S_ + sq; }
                    u32x4 w; w.x = pack2(v0[0], v0[1]); w.y = pack2(v0[2], v0[3]); w.z = pack2(v1[0], v1[1]); w.w = pack2(v1[2], v1[3]);
                    *(u32x4*)dst = w;
                    continue;
                }
                if (KIND == 1 || KIND == 2) {
                    const float2* rope = (const float2*)(ws + WS_ROPE);
                    const int pos = row & (S_ - 1), d = 16 * (wc & 1) + 4 * fq;
                    const float4 cs01 = *(const float4*)(rope + pos * 32 + d), cs23 = *(const float4*)(rope + pos * 32 + d + 2);
                    const float c[4] = {cs01.x, cs01.z, cs23.x, cs23.z}, sn[4] = {cs01.y, cs01.w, cs23.y, cs23.w};
                    const float sc = (KIND == 2) ? 0.125f : 1.0f;
                    f32x4 y1, y2;
#pragma unroll
                    for (int r = 0; r < 4; ++r) { y1[r] = (v0[r] * c[r] - v1[r] * sn[r]) * sc; y2[r] = (v0[r] * sn[r] + v1[r] * c[r]) * sc; }
                    v0 = y1; v1 = y2;
                } else if (KIND == 3) {
#pragma unroll
                    for (int r = 0; r < 4; ++r) { v0[r] = v0[r] * fsig(v0[r]); v1[r] = v1[r] * fsig(v1[r]); }
                } else if (KIND == 4) {
#pragma unroll
                    for (int r = 0; r < 4; ++r) { v0[r] = fsig(v0[r]); v1[r] = fsig(v1[r]); }
                }
                u32x4 w; w.x = pack2(v0[0], v0[1]); w.y = pack2(v0[2], v0[3]); w.z = pack2(v1[0], v1[1]); w.w = pack2(v1[2], v1[3]);
                *(u32x4*)((bf16_t*)(ws + WS_P) + (size_t)row * LD + col) = w;
            }
        }
}
struct G1Order {      typedef pg8::Unit U; static constexpr bool GATHER = false;
    int xcd, slot, per;
    __device__ __forceinline__ bool next(int i, pg8::Unit& u) const {
        const int j = slot + i * per; if (j >= 208) return false;
        if (j < 192) { u.pm = j / 3; u.pn = xcd + 8 * (j % 3); } else { const int q = j - 192; u.pm = 8 * xcd + (q >> 1); u.pn = 24 + (q & 1); }
        return true;
    }
    __device__ __forceinline__ void ptrs(const pg8::Unit& u, unsigned& A, unsigned& B) const {
        const unsigned x = (unsigned)WS_XB + (unsigned)u.pm * (256u * 1024u * 2u), w = (unsigned)WS_WIN + (unsigned)u.pn * (256u * 1024u * 2u);
        if (u.pn >= 21) { A = w; B = x; } else { A = x; B = w; }
    }
};
struct G1Epi {
    static constexpr int MID_T = 0;
    unsigned char* ws;
    __device__ __forceinline__ void operator()(const f32x4 (&acc)[2][2][4][2], const pg8::Unit& u, int wr, int wc, int fr, int fq) const {
        const int pn = u.pn, tok0 = u.pm * 256, n0 = pn * 256;
        if (pn >= 21) g1_epi<5>(acc, ws, n0, tok0, wr, wc, fr, fq);
        else if (pn >= 12) g1_epi<4>(acc, ws, tok0, n0, wr, wc, fr, fq);
        else if (pn >= 8) g1_epi<3>(acc, ws, tok0, n0, wr, wc, fr, fq);
        else if (pn >= 6) g1_epi<2>(acc, ws, tok0, n0, wr, wc, fr, fq);
        else if (pn >= 4) g1_epi<1>(acc, ws, tok0, n0, wr, wc, fr, fq);
        else g1_epi<0>(acc, ws, tok0, n0, wr, wc, fr, fq);
    }
};
__device__ __forceinline__ void phase_g1(const Params& p, int layer, unsigned char* lds) {
    unsigned char* ws = launder(p.ws);
    G1Order S; S.xcd = blockIdx.x & 7; S.slot = blockIdx.x >> 3; S.per = gridDim.x >> 3;
    G1Epi E; E.ws = ws;
    pg8::gemm_phase<G1Epi, G1Order>(lds, 1024, S, E, ltid(), ws);
}

__device__ __forceinline__ void load_tile64(const bf16_t* base, size_t rowStride, unsigned char* dst, int wid, int lane) {
    const int c = ((lane & 7) ^ (lane >> 3)) * 8;
#pragma unroll
    for (int i = 0; i < 2; ++i) { const int j = wid + 4 * i, row = 8 * j + (lane >> 3); glds16(base + (size_t)row * rowStride + c, dst + j * 1024); }
}
__device__ __forceinline__ void load_tile128(const bf16_t* base, size_t rowStride, unsigned char* dst, int wid, int lane) {
    const int c = ((lane & 7) ^ (lane >> 3)) * 8;
#pragma unroll
    for (int i = 0; i < 4; ++i) { const int j = wid + 4 * i, row = 8 * j + (lane >> 3); glds16(base + (size_t)row * rowStride + c, dst + j * 1024); }
}
__device__ __forceinline__ void load_tile128w(const bf16_t* base, size_t rowStride, unsigned char* dst, int wid, int lane) {
    const int c = ((lane & 15) ^ ((4 * wid + (lane >> 4)) & 15)) * 8;
#pragma unroll
    for (int i = 0; i < 8; ++i) { const int j = wid + 4 * i, row = 4 * j + (lane >> 4); glds16(base + (size_t)row * rowStride + c, dst + j * 1024); }
}
__device__ __forceinline__ bf16x8 lds_frag128(const unsigned char* tile, int row, int chunk) {
    return *(const bf16x8*)(tile + row * 128 + ((chunk ^ (row & 7)) << 4));
}
__device__ __forceinline__ bf16x8 lds_frag256(const unsigned char* tile, int row, int chunk) {
    return *(const bf16x8*)(tile + row * 256 + ((chunk ^ (row & 15)) << 4));
}
__device__ __forceinline__ bf16x8 lds_vfrag128(const unsigned char* tile, int row, int kbase, int fq) {
    const int ca = (kbase >> 3) + (fq >> 1), hb = (fq & 1) * 8;
    const u32x2 a = *(const u32x2*)(tile + row * 128 + ((ca ^ (row & 7)) << 4) + hb);
    const u32x2 b = *(const u32x2*)(tile + row * 128 + (((ca + 2) ^ (row & 7)) << 4) + hb);
    u32x4 w; w.x = a.x; w.y = a.y; w.z = b.x; w.w = b.y;
    return __builtin_bit_cast(bf16x8, w);
}
__device__ __forceinline__ bf16x8 lds_vfrag256(const unsigned char* tile, int row, int kbase, int fq) {
    const int ca = (kbase >> 3) + (fq >> 1), hb = (fq & 1) * 8;
    const u32x2 a = *(const u32x2*)(tile + row * 256 + ((ca ^ (row & 15)) << 4) + hb);
    const u32x2 b = *(const u32x2*)(tile + row * 256 + (((ca + 2) ^ (row & 15)) << 4) + hb);
    u32x4 w; w.x = a.x; w.y = a.y; w.z = b.x; w.w = b.y;
    return __builtin_bit_cast(bf16x8, w);
}
__device__ __forceinline__ bf16x8 pack8(f32x4 a, f32x4 b) {
    u32x4 w; w.x = pack2(a[0], a[1]); w.y = pack2(a[2], a[3]); w.z = pack2(b[0], b[1]); w.w = pack2(b[2], b[3]);
    return __builtin_bit_cast(bf16x8, w);
}

__device__ __forceinline__ float gelu_tanh(float x) {
    const float u = 0.7978845608028654f * (x + 0.044715f * x * x * x);
    return 0.5f * x * (1.f + tanhf(u));
}
__device__ __forceinline__ void compress_item(const Params& p, int layer, int item, unsigned char* lds, int half) {
    unsigned char* ws = launder(p.ws);
    const int tid = (ltid() & 255), lane = tid & 63, wid = tid >> 6, wr = wid >> 1, wc = wid & 1, fr = lane & 15, fq = lane >> 4;
    const int mtile = item & 3, g = (item >> 2) & 1, b = (item >> 3) & 1, kv = item >> 4;
    const int i0 = mtile * 128;
    const bf16_t* P = (const bf16_t*)(ws + WS_P);
    const bf16_t* W1T = (const bf16_t*)(ws + WS_W1T) + (size_t)kv * 64 * 2048;
    const int col = (kv ? C_VC : C_KC) + g * 64;
    const int ldc = ((lane & 7) ^ (lane >> 3)) * 8;
    const int l0 = 16 * half;
    const bf16_t* ap[4];
#pragma unroll
    for (int i = 0; i < 4; ++i) ap[i] = P + ((size_t)b * S_ + 16 * (i0 + 32 * i + 8 * wid + (lane >> 3)) + l0) * LD + col + ldc;
    const bf16_t* bp[2];
#pragma unroll
    for (int i = 0; i < 2; ++i) bp[i] = W1T + (size_t)(8 * (wid + 4 * i) + (lane >> 3)) * 2048 + l0 * 64 + ldc;
    f32x4 acc[4][2];
#pragma unroll
    for (int i = 0; i < 4; ++i)
#pragma unroll
        for (int j = 0; j < 2; ++j) acc[i][j] = (f32x4){0.f, 0.f, 0.f, 0.f};
    __syncthreads();
#define CSTAGE(buf, l) do { unsigned char* st_ = lds + (buf) * 24576; \
        _Pragma("unroll") for (int i = 0; i < 4; ++i) glds16(ap[i] + (size_t)(l) * LD, st_ + (4 * i + wid) * 1024); \
        _Pragma("unroll") for (int i = 0; i < 2; ++i) glds16(bp[i] + (l) * 64, st_ + 16384 + (wid + 4 * i) * 1024); } while (0)
    CSTAGE(0, 0); CSTAGE(1, 1);
    for (int l = 0; l < 16; ++l) {
        const unsigned char* st = lds + (l % 3) * 24576;
        if (l + 1 < 16) WAIT_V(6); else WAIT_V(0);
        RAW_BARRIER();
        if (l + 2 < 16) CSTAGE((l + 2) % 3, l + 2);
#pragma unroll
        for (int ks = 0; ks < 2; ++ks) {
            bf16x8 a[4], bb[2];
#pragma unroll
            for (int i = 0; i < 4; ++i) a[i] = lds_frag128(st, 64 * wr + 16 * i + fr, 4 * ks + fq);
#pragma unroll
            for (int j = 0; j < 2; ++j) bb[j] = lds_frag128(st + 16384, 32 * wc + 16 * j + fr, 4 * ks + fq);
#pragma unroll
            for (int i = 0; i < 4; ++i)
#pragma unroll
                for (int j = 0; j < 2; ++j) acc[i][j] = mfma16(a[i], bb[j], acc[i][j]);
        }
    }
    __syncthreads();
#undef CSTAGE
    float* xch = (float*)(lds - half * HALF_LDS + HALF_LDS);
    if (half == 1) {
#pragma unroll
        for (int i = 0; i < 4; ++i)
#pragma unroll
            for (int j = 0; j < 2; ++j)
#pragma unroll
                for (int r = 0; r < 4; ++r) xch[((i * 2 + j) * 4 + r) * 256 + tid] = acc[i][j][r];
    }
    __syncthreads();
    if (half == 0) {
        const float* b1 = (const float*)(ws + WS_CTL) + CW_B1P + kv * 32 * 64;
#pragma unroll
        for (int j = 0; j < 2; ++j) {
            const int n = 32 * wc + 16 * j + fr; float bias = 0.f;
#pragma unroll
            for (int kt = 0; kt < 32; ++kt) bias += b1[kt * 64 + n + vzero()];
#pragma unroll
            for (int i = 0; i < 4; ++i)
#pragma unroll
                for (int r = 0; r < 4; ++r) {
                    const int row = 64 * wr + 16 * i + 4 * fq + r;
                    const float hv = gelu_tanh(acc[i][j][r] + xch[((i * 2 + j) * 4 + r) * 256 + tid] + bias);
                    *(bf16_t*)(lds + row * 128 + (((n >> 3) ^ (row & 7)) << 4) + (n & 7) * 2) = f2bf(hv);
                }
        }
        const float* w2 = p.cmp_w2 + ((size_t)layer * 2 + kv) * 64 * 64;
        const int k = tid >> 2, n0 = (tid & 3) * 16;
#pragma unroll
        for (int q4 = 0; q4 < 4; ++q4) {
            const float4 w = *(const float4*)(w2 + k * 64 + n0 + 4 * q4);
            const float wv[4] = {w.x, w.y, w.z, w.w};
#pragma unroll
            for (int e = 0; e < 4; ++e) { const int n = n0 + 4 * q4 + e; *(bf16_t*)(lds + 16384 + n * 128 + (((k >> 3) ^ (n & 7)) << 4) + (k & 7) * 2) = f2bf(wv[e]); }
        }
    }
    __syncthreads();
    if (half == 0) {
        f32x4 o[4][2];
#pragma unroll
        for (int i = 0; i < 4; ++i)
#pragma unroll
            for (int j = 0; j < 2; ++j) o[i][j] = (f32x4){0.f, 0.f, 0.f, 0.f};
#pragma unroll
        for (int ks = 0; ks < 2; ++ks) {
            bf16x8 a[4], bb[2];
#pragma unroll
            for (int i = 0; i < 4; ++i) a[i] = lds_frag128(lds, 64 * wr + 16 * i + fr, 4 * ks + fq);
#pragma unroll
            for (int j = 0; j < 2; ++j) bb[j] = lds_frag128(lds + 16384, 32 * wc + 16 * j + fr, 4 * ks + fq);
#pragma unroll
            for (int i = 0; i < 4; ++i)
#pragma unroll
                for (int j = 0; j < 2; ++j) o[i][j] = mfma16(a[i], bb[j], o[i][j]);
        }
#pragma unroll
        for (int i = 0; i < 4; ++i)
#pragma unroll
            for (int j = 0; j < 2; ++j) {
                const int n = 32 * wc + 16 * j + fr, ci = i0 + 64 * wr + 16 * i + 4 * fq;
                f32x4 v = o[i][j];
#pragma unroll
                for (int r = 0; r < 4; ++r) if (ci + r >= 511) v[r] = 0.f;
                if (kv == 0) {
                    bf16_t* dst = (bf16_t*)(ws + WS_KCC) + ((size_t)(b * 2 + g) * 512 + ci) * 64 + n;
#pragma unroll
                    for (int r = 0; r < 4; ++r) dst[r * 64] = f2bf(v[r]);
                } else {
                    *(u32x2*)((bf16_t*)(ws + WS_VCCT) + ((size_t)(b * 2 + g) * 64 + n) * 512 + ci) = pack4(v);
                }
            }
    }
    __syncthreads();
}

__device__ __forceinline__ float ret_lg2(int h) { const float gam = 1.f - exp2f(-5.f - (float)h); return log2f(gam); }

__device__ __forceinline__ void retkv_item(const Params& p, int item, unsigned char* lds, int half) {
    unsigned char* ws = launder(p.ws);
    const int tid = (ltid() & 255), lane = tid & 63, wid = tid >> 6, fr = lane & 15, fq = lane >> 4;
    const int n = item & 63, h = (item >> 6) & 7, b = item >> 9;
    const size_t tok0 = (size_t)b * S_ + 128 * n;
    unsigned char* vL = lds; unsigned char* kL = lds + 32768;
    load_tile128w((const bf16_t*)(ws + WS_VRT) + ((size_t)(b * 8 + h) * 128) * S_ + 128 * n, S_, vL, wid, lane);
    load_tile128((const bf16_t*)(ws + WS_P) + tok0 * LD + C_KR + h * 64, LD, kL, wid, lane);
    wait_vm0(); __syncthreads();
    const float lg2 = ret_lg2(h);
    f32x4 acc[2][4];
#pragma unroll
    for (int m = 0; m < 2; ++m)
#pragma unroll
        for (int nt = 0; nt < 4; ++nt) acc[m][nt] = (f32x4){0.f, 0.f, 0.f, 0.f};
#pragma unroll
    for (int ks = 0; ks < 4; ++ks) {
        bf16x8 a[2], bb[4];
#pragma unroll
        for (int m = 0; m < 2; ++m) a[m] = lds_frag256(vL, 32 * wid + 16 * m + fr, 4 * ks + fq);
        float dec[8];
#pragma unroll
        for (int j = 0; j < 8; ++j) dec[j] = __builtin_amdgcn_exp2f((float)(127 - (32 * ks + 8 * fq + j)) * lg2);
#pragma unroll
        for (int nt = 0; nt < 4; ++nt) {
            const int d = 16 * nt + fr;
            float v[8];
#pragma unroll
            for (int j = 0; j < 8; ++j) {
                const int tk = 32 * ks + 8 * fq + j;
                const bf16_t kvv = *(const bf16_t*)(kL + tk * 128 + (((d >> 3) ^ (tk & 7)) << 4) + (d & 7) * 2);
                v[j] = bf2f(kvv) * dec[j];
            }
            u32x4 w; w.x = pack2(v[0], v[1]); w.y = pack2(v[2], v[3]); w.z = pack2(v[4], v[5]); w.w = pack2(v[6], v[7]);
            bb[nt] = __builtin_bit_cast(bf16x8, w);
        }
#pragma unroll
        for (int m = 0; m < 2; ++m)
#pragma unroll
            for (int nt = 0; nt < 4; ++nt) acc[m][nt] = mfma16(a[m], bb[nt], acc[m][nt]);
    }
    float* KVT = (float*)(ws + WS_KVT) + ((size_t)(b * 8 + h) * 64 + n) * 8192;
#pragma unroll
    for (int m = 0; m < 2; ++m)
#pragma unroll
        for (int nt = 0; nt < 4; ++nt)
#pragma unroll
            for (int r = 0; r < 4; ++r) KVT[(32 * wid + 16 * m + 4 * fq + r) * 64 + 16 * nt + fr] = acc[m][nt][r];
    __syncthreads();
}

__device__ __forceinline__ void phase_p2(const Params& p, int layer, unsigned char* lds, int half) {
    const int vb = blockIdx.x * 2 + half, nvb = gridDim.x * 2;
    if (vb < 64) compress_item(p, layer, vb >> 1, lds, half);
    else for (int it = vb - 64; it < 1024; it += nvb - 64) retkv_item(p, it, lds, half);
}

constexpr int NSA_IMP = 32768, NSA_BUCKET = 65792, NSA_BIAS = 73984;

struct NsaLane { int t; int fr, fq, wid, lane; };

constexpr float LOG2E = 1.4426950408889634f;
__device__ __forceinline__ int t5_first(int bk) {
    const int th[16] = {16, 22, 30, 40, 54, 73, 99, 134, 182, 246, 332, 450, 609, 825, 1117, 1513};
    int r = 16;
#pragma unroll
    for (int k = 0; k < 16; ++k) r = (bk == 16 + k) ? th[k] : r;
    return r;
}
template <int BR, int PASS>
__device__ __forceinline__ void nsa_half(const unsigned char* kL, const unsigned char* vL, const unsigned char* lds, const bf16x8 (&qptr)[4][2],
                                         f32x4 (&O)[4][4], float (&m)[4], float (&l)[4], int tile, int hf, const NsaLane& L, int qrow, const bool FAST, int th, int b0, int b1) {
    const int fr = L.lane & 15, fq = L.lane >> 4;
    constexpr float C2 = 0.125f * LOG2E;
    bf16x8 Kf[2][2];
#pragma unroll
    for (int i = 0; i < 2; ++i)
#pragma unroll
        for (int ks = 0; ks < 2; ++ks) Kf[i][ks] = lds_frag128(kL, 32 * hf + 16 * i + fr, 4 * ks + fq);
    bf16x8 Vf[4];
    if (PASS != 0) {
#pragma unroll
        for (int mt = 0; mt < 4; ++mt) Vf[mt] = lds_vfrag128(vL, 16 * mt + fr, 32 * hf, fq);
    }
    unsigned bk[2] = {0u, 0u}; bool hi[2][4];
    if (!FAST) {
        const unsigned char* bucketL = lds + NSA_BUCKET;
#pragma unroll
        for (int i = 0; i < 2; ++i) {
            unsigned pk = 0;
#pragma unroll
            for (int r = 0; r < 4; ++r) {
                const int kk = 32 * hf + 16 * i + 4 * fq + r;
                int rel; bool ok;
                if (BR == 0) { rel = L.t - (16 * (64 * tile + kk) + 31); ok = rel >= 0; }
                else { rel = L.t - (64 * tile + kk); ok = rel >= 0 && rel < 512; }
                int rc = rel < 0 ? 0 : rel; rc = rc > 8191 ? 8191 : rc;
                pk |= (unsigned)bucketL[rc] << (8 * r);
                hi[i][r] = ok;
            }
            bk[i] = pk;
        }
    } else {
        const int kbase = 64 * tile + 32 * hf + 4 * fq;
        const int lim = BR == 0 ? L.t - th - 31 - 16 * kbase : L.t - th - kbase;
#pragma unroll
        for (int i = 0; i < 2; ++i)
#pragma unroll
            for (int r = 0; r < 4; ++r) hi[i][r] = (BR == 0 ? 16 : 1) * (16 * i + r) <= lim;
    }
    const float* biasL = (const float*)(lds + NSA_BIAS);
    float ia[2] = {0.f, 0.f}, ic[2] = {0.f, 0.f};
#pragma unroll
    for (int nt = 0; nt < 4; ++nt) {
        f32x4 S[2];
        const bf16x8 q0 = qptr[nt][0], q1 = qptr[nt][1];
#pragma unroll
        for (int i = 0; i < 2; ++i) {
            S[i] = (f32x4){0.f, 0.f, 0.f, 0.f};
            S[i] = mfma16(Kf[i][0], q0, S[i]); S[i] = mfma16(Kf[i][1], q1, S[i]);
        }
        float tmax = -1e30f;
        if (!FAST) {
#pragma unroll
            for (int i = 0; i < 2; ++i) {
                float bsv[4];
#pragma unroll
                for (int r = 0; r < 4; ++r) bsv[r] = biasL[nt * 32 + ((bk[i] >> (8 * r)) & 0xffu)];
                asm volatile("" : "+v"(bsv[0]), "+v"(bsv[1]), "+v"(bsv[2]), "+v"(bsv[3]));
#pragma unroll
                for (int r = 0; r < 4; ++r) {
                    const float sv = S[i][r] * C2 + bsv[r];
                    S[i][r] = hi[i][r] ? sv : -1e30f; tmax = fmaxf(tmax, S[i][r]);
                }
            }
        } else {
            const float blo = biasL[nt * 32 + b0], bhi = biasL[nt * 32 + b1];
            if (b0 == b1) {
#pragma unroll
                for (int i = 0; i < 2; ++i)
#pragma unroll
                    for (int r = 0; r < 4; ++r) { S[i][r] = S[i][r] * C2 + bhi; tmax = fmaxf(tmax, S[i][r]); }
            } else {
#pragma unroll
                for (int i = 0; i < 2; ++i)
#pragma unroll
                    for (int r = 0; r < 4; ++r) { S[i][r] = S[i][r] * C2 + (hi[i][r] ? bhi : blo); tmax = fmaxf(tmax, S[i][r]); }
            }
        }
        if (PASS != 1) {
            if (__builtin_amdgcn_ballot_w64(tmax > m[nt] + 8.f) != 0ull) {
                const float tm = rows_max(tmax);
                const float mnew = tm > m[nt] + 8.f ? tm : m[nt], alpha = __builtin_amdgcn_exp2f(m[nt] - mnew);
                l[nt] *= alpha; m[nt] = mnew;
                if (PASS == 2) {
#pragma unroll
                    for (int mt = 0; mt < 4; ++mt) O[mt][nt] = O[mt][nt] * alpha;
                }
            }
            float psum = 0.f;
#pragma unroll
            for (int i = 0; i < 2; ++i)
#pragma unroll
                for (int r = 0; r < 4; ++r) S[i][r] = __builtin_amdgcn_exp2f(S[i][r] - m[nt]);
#pragma unroll
            for (int i = 0; i < 2; ++i)
#pragma unroll
                for (int r = 0; r < 4; ++r) psum += S[i][r];
            l[nt] += psum;
        } else {
#pragma unroll
            for (int i = 0; i < 2; ++i) {
#pragma unroll
                for (int r = 0; r < 4; ++r) S[i][r] = __builtin_amdgcn_exp2f(S[i][r] - m[nt]) * l[nt];
            }
#pragma unroll
            for (int i = 0; i < 2; ++i) {
                ia[i] += S[i][0] + S[i][1] + S[i][2] + 0.5f * S[i][3];
                ic[i] += 0.5f * S[i][3];
            }
        }
        if (PASS != 0) {
            const bf16x8 Pb = pack8(S[0], S[1]);
#pragma unroll
            for (int mt = 0; mt < 4; ++mt) O[mt][nt] = mfma16(Vf[mt], Pb, O[mt][nt]);
        }
        if (nt & 1) __builtin_amdgcn_sched_barrier(0);
    }
    if (PASS == 1) {
        float* imp = (float*)(lds + NSA_IMP) + qrow * 129;
        asm volatile("" ::: "memory"); __builtin_amdgcn_wave_barrier();
#pragma unroll
        for (int i = 0; i < 2; ++i) { const int j = 16 * tile + 8 * hf + 4 * i + fq; imp[j ^ ((j >> 1) & 16)] += ia[i]; }
        asm volatile("s_waitcnt lgkmcnt(0)" ::: "memory"); __builtin_amdgcn_wave_barrier();
#pragma unroll
        for (int i = 0; i < 2; ++i) { const int j = 16 * tile + 8 * hf + 4 * i + fq + 1; if (j < 128) imp[j ^ ((j >> 1) & 16)] += ic[i]; }
        asm volatile("s_waitcnt lgkmcnt(0)" ::: "memory"); __builtin_amdgcn_wave_barrier();
    }
}
template <int BR, int PASS>
__device__ __forceinline__ void nsa_tile(const unsigned char* kL, const unsigned char* vL, const unsigned char* lds, const bf16x8 (&qptr)[4][2],
                                         f32x4 (&O)[4][4], float (&m)[4], float (&l)[4], int tile, const NsaLane& L, int qrow) {
    const int tq0 = __builtin_amdgcn_readfirstlane(L.t - (L.lane & 15));
#pragma unroll 1
    for (int hf = 0; hf < 2; ++hf) {
        const bool fast = false; const int th = 0, b0 = 0, b1 = 0;
        {   const int kfirst = 64 * tile + 32 * hf, pmin = BR == 0 ? 16 * kfirst + 31 : kfirst, pmax = BR == 0 ? 16 * (kfirst + 31) + 31 : kfirst + 31;
            if (tq0 + 15 - pmin < 0 || (BR == 2 && tq0 - pmax >= 512)) continue; }
        nsa_half<BR, PASS>(kL, vL, lds, qptr, O, m, l, tile, hf, L, qrow, fast, th, b0, b1);
    }
}

__device__ __forceinline__ void cmp_item(const Params& p, int item, unsigned char* lds, int half) {
    unsigned char* ws = launder(p.ws);
    const int tid = (ltid() & 255), lane = tid & 63, wid = tid >> 6, fr = lane & 15, fq = lane >> 4;
    const int combo = item & 3, qt = 127 - (item >> 2), b = combo >> 1, g = combo & 1;
    const int q0 = qt * 64, qrow = 16 * wid + fr;
    NsaLane L; L.t = q0 + qrow; L.fr = fr; L.fq = fq; L.wid = wid; L.lane = lane;
    const size_t tok = (size_t)b * S_ + L.t;
    const bf16_t* P = (const bf16_t*)(ws + WS_P);
    const bf16_t* kc = (const bf16_t*)(ws + WS_KCC) + (size_t)(b * 2 + g) * 512 * 64;
    const bf16_t* vc = (const bf16_t*)(ws + WS_VCCT) + (size_t)(b * 2 + g) * 64 * 512;
    __syncthreads();
    load_tile64(kc, 64, lds, wid, lane);
    if (tid < 128) ((float*)(lds + NSA_BIAS))[tid] = p.rel_bias[(tid & 31) * 8 + 4 * g + (tid >> 5)] * LOG2E;
    for (int i = tid; i < 64 * 129; i += HT) ((float*)(lds + NSA_IMP))[i] = 0.f;
    bf16x8 Qf[4][2];
#pragma unroll
    for (int nt = 0; nt < 4; ++nt)
#pragma unroll
        for (int ks = 0; ks < 2; ++ks) Qf[nt][ks] = *(const bf16x8*)(P + tok * LD + C_QA + (4 * g + nt) * 64 + 32 * ks + 8 * fq);
    f32x4 O[4][4]; float m[4], l[4];
    const bf16_t* gates = P + tok * LD + C_GA + (4 * g) * 3;
    const int ntc = ((q0 + 32) >> 4) / 64 + 1;
#pragma unroll
    for (int nt = 0; nt < 4; ++nt) { m[nt] = -1000.f; l[nt] = 0.f; }
    wait_vm0(); __syncthreads();
    for (int it = 0; it < ntc; ++it) {
        unsigned char* cur = lds + (it & 1) * 16384;
        if (it + 1 < ntc) load_tile64(kc + (size_t)(it + 1) * 64 * 64, 64, lds + ((it + 1) & 1) * 16384, wid, lane);
        nsa_tile<0, 0>(cur, cur + 8192, lds, Qf, O, m, l, it, L, qrow);
        wait_vm0(); __syncthreads();
    }
#pragma unroll
    for (int nt = 0; nt < 4; ++nt) { l[nt] = rows_sum(l[nt]); l[nt] = l[nt] > 0.f ? 1.f / l[nt] : 0.f; }
#pragma unroll
    for (int mt = 0; mt < 4; ++mt)
#pragma unroll
        for (int nt = 0; nt < 4; ++nt) O[mt][nt] = (f32x4){0.f, 0.f, 0.f, 0.f};
    load_tile64(kc, 64, lds, wid, lane); load_tile64(vc, 512, lds + 8192, wid, lane);
    wait_vm0(); __syncthreads();
    for (int it = 0; it < ntc; ++it) {
        unsigned char* cur = lds + (it & 1) * 16384;
        if (it + 1 < ntc) { unsigned char* nx = lds + ((it + 1) & 1) * 16384;
            load_tile64(kc + (size_t)(it + 1) * 64 * 64, 64, nx, wid, lane); load_tile64(vc + (it + 1) * 64, 512, nx + 8192, wid, lane); }
        nsa_tile<0, 1>(cur, cur + 8192, lds, Qf, O, m, l, it, L, qrow);
        wait_vm0(); __syncthreads();
    }
    bf16_t* YC = (bf16_t*)(ws + WS_YC) + tok * 512 + (4 * g) * 64;
#pragma unroll
    for (int nt = 0; nt < 4; ++nt) {
        const float gt = bf2f(gates[nt * 3 + 0]);
#pragma unroll
        for (int mt = 0; mt < 4; ++mt) *(u32x2*)(YC + nt * 64 + 16 * mt + 4 * fq) = pack4(O[mt][nt] * gt);
    }
    const int cur = qt;
    {
        float* imp = (float*)(lds + NSA_IMP) + qrow * 129 + 32 * fq;
        asm volatile("s_waitcnt lgkmcnt(0)" ::: "memory"); __builtin_amdgcn_wave_barrier();
        unsigned word = 0;
        const int xs = 16 * (fq & 1);
        float* pa = imp + xs; float* pb = imp - xs;
#define IMP_AT(i) ((i) < 16 ? pa[(i)] : pb[(i)])
#pragma unroll
        for (int i = 0; i < 32; ++i) {
            const int j = 32 * fq + i;
            const float v = IMP_AT(i);
            const bool forced = j <= cur && (cur < 16 || j == 0 || j == cur || j == cur - 1);
            if (forced) word |= 1u << i;
            IMP_AT(i) = j > cur ? -1.f : forced ? -2.f : v;
        }
        const int nforced = cur < 16 ? 16 : 3;
#pragma unroll 1
        for (int round = 0; round < 16 - nforced; ++round) {
            float bv = IMP_AT(0); int bi = 0;
#pragma unroll
            for (int i = 1; i < 32; ++i) { const float v = IMP_AT(i); if (v > bv) { bv = v; bi = i; } }
            int gi = 32 * fq + bi;
            {
                u32x2 rv = __builtin_amdgcn_permlane16_swap(__float_as_uint(bv), __float_as_uint(bv), false, false);
                u32x2 ri = __builtin_amdgcn_permlane16_swap((unsigned)gi, (unsigned)gi, false, false);
                float v0 = __uint_as_float(rv.x), v1 = __uint_as_float(rv.y); int i0 = (int)ri.x, i1 = (int)ri.y;
                if (v1 > v0 || (v1 == v0 && i1 < i0)) { v0 = v1; i0 = i1; }
                rv = __builtin_amdgcn_permlane32_swap(__float_as_uint(v0), __float_as_uint(v0), false, false);
                ri = __builtin_amdgcn_permlane32_swap((unsigned)i0, (unsigned)i0, false, false);
                v0 = __uint_as_float(rv.x); v1 = __uint_as_float(rv.y); i0 = (int)ri.x; i1 = (int)ri.y;
                if (v1 > v0 || (v1 == v0 && i1 < i0)) { v0 = v1; i0 = i1; }
                bv = v0; gi = i0;
            }
            if (bv >= 0.f && (gi >> 5) == fq) { word |= 1u << (gi & 31); imp[(gi & 31) ^ xs] = -2.f; }
        }
#undef IMP_AT
        ((unsigned*)(ws + WS_SELW))[(tok * 2 + g) * 4 + fq] = word;
    }
}

__device__ __forceinline__ void win_item(const Params& p, int item, unsigned char* lds, int half) {
    unsigned char* ws = launder(p.ws);
    const int tid = (ltid() & 255), lane = tid & 63, wid = tid >> 6, fr = lane & 15, fq = lane >> 4;
    const int combo = item & 3, qt = 127 - (item >> 2), b = combo >> 1, g = combo & 1;
    const int q0 = qt * 64, qrow = 16 * wid + fr;
    NsaLane L; L.t = q0 + qrow; L.fr = fr; L.fq = fq; L.wid = wid; L.lane = lane;
    const size_t tok = (size_t)b * S_ + L.t;
    const bf16_t* P = (const bf16_t*)(ws + WS_P);
    const bf16_t* kb = P + ((size_t)b * S_) * LD + C_KW + g * 64;
    const bf16_t* vb = (const bf16_t*)(ws + WS_VWT) + (size_t)(b * 2 + g) * 64 * S_;
    const int k_lo = qt - 8 > 0 ? qt - 8 : 0, ntw = qt - k_lo + 1;
    __syncthreads();
    load_tile64(kb + (size_t)k_lo * 64 * LD, LD, lds, wid, lane); load_tile64(vb + k_lo * 64, S_, lds + 8192, wid, lane);
    if (tid < 128) ((float*)(lds + NSA_BIAS))[tid] = p.rel_bias[(tid & 31) * 8 + 4 * g + (tid >> 5)] * LOG2E;
    bf16x8 Qf[4][2];
#pragma unroll
    for (int nt = 0; nt < 4; ++nt)
#pragma unroll
        for (int ks = 0; ks < 2; ++ks) Qf[nt][ks] = *(const bf16x8*)(P + tok * LD + C_QA + (4 * g + nt) * 64 + 32 * ks + 8 * fq);
    f32x4 O[4][4]; float m[4], l[4];
    const bf16_t* gates = P + tok * LD + C_GA + (4 * g) * 3;
#pragma unroll
    for (int nt = 0; nt < 4; ++nt) { m[nt] = -1000.f; l[nt] = 0.f; }
#pragma unroll
    for (int mt = 0; mt < 4; ++mt)
#pragma unroll
        for (int nt = 0; nt < 4; ++nt) O[mt][nt] = (f32x4){0.f, 0.f, 0.f, 0.f};
    {
        wait_vm0(); __syncthreads();
        for (int it = 0; it < ntw; ++it) {
            unsigned char* cu = lds + (it & 1) * 16384;
            if (it + 1 < ntw) { unsigned char* nx = lds + ((it + 1) & 1) * 16384;
                load_tile64(kb + (size_t)(k_lo + it + 1) * 64 * LD, LD, nx, wid, lane); load_tile64(vb + (k_lo + it + 1) * 64, S_, nx + 8192, wid, lane); }
            nsa_tile<2, 2>(cu, cu + 8192, lds, Qf, O, m, l, k_lo + it, L, qrow);
            wait_vm0(); __syncthreads();
        }
    }
    bf16_t* YW = (bf16_t*)(ws + WS_YW) + tok * 512 + (4 * g) * 64;
#pragma unroll
    for (int nt = 0; nt < 4; ++nt) {
        const float lt = rows_sum(l[nt]), gt = bf2f(gates[nt * 3 + 2]) * (lt > 0.f ? 1.f / lt : 0.f);
#pragma unroll
        for (int mt = 0; mt < 4; ++mt) *(u32x2*)(YW + nt * 64 + 16 * mt + 4 * fq) = pack4(O[mt][nt] * gt);
    }
}

constexpr int SEL_RING = 8, SEL_BUCKET = SEL_RING * 16384, SEL_BIAS2 = SEL_BUCKET + 8192;
template <bool FAST>
__device__ __forceinline__ void sel_ntile(const bf16x8 (&Kf)[4][2], const unsigned char* vL, int fr, int fq, const bf16x8& q0, const bf16x8& q1, f32x4 (&O)[4], float& m, float& l,
                                          bool sb, int relb, int th, float blo, float bhi, const unsigned char* lds, int hl) {
    f32x4 S[4];
#pragma unroll
    for (int i = 0; i < 4; ++i) { S[i] = (f32x4){0.f, 0.f, 0.f, 0.f}; S[i] = mfma16(Kf[i][0], q0, S[i]); S[i] = mfma16(Kf[i][1], q1, S[i]); }
    float tmax = -1e30f;
    const float scl = (!FAST || sb) ? 0.125f * LOG2E : 0.f;
    if (FAST) { blo = (sb ? blo : -1e30f) - m; bhi = (sb ? bhi : -1e30f) - m; }
    if (FAST) {
        if (th == 0) {
#pragma unroll
            for (int i = 0; i < 4; ++i)
#pragma unroll
                for (int r = 0; r < 4; ++r) { S[i][r] = S[i][r] * scl + bhi; tmax = fmaxf(tmax, S[i][r]); }
        } else {
#pragma unroll
            for (int i = 0; i < 4; ++i)
#pragma unroll
                for (int r = 0; r < 4; ++r) { const int rel = relb - (16 * i + r); S[i][r] = S[i][r] * scl + (rel >= th ? bhi : blo); tmax = fmaxf(tmax, S[i][r]); }
        }
    } else {
        unsigned bkt[4][4]; float bs[4][4];
#pragma unroll
        for (int i = 0; i < 4; ++i)
#pragma unroll
            for (int r = 0; r < 4; ++r) { const int rel = relb - (16 * i + r); int rc = rel < 0 ? 0 : rel; rc = rc > 8191 ? 8191 : rc; bkt[i][r] = (lds + SEL_BUCKET)[rc]; }
#pragma unroll
        for (int i = 0; i < 4; ++i)
#pragma unroll
            for (int r = 0; r < 4; ++r) bs[i][r] = ((const float*)(lds + SEL_BIAS2))[hl * 32 + bkt[i][r]];
        asm volatile("" : "+v"(bs[0][0]), "+v"(bs[0][1]), "+v"(bs[0][2]), "+v"(bs[0][3]), "+v"(bs[1][0]), "+v"(bs[1][1]), "+v"(bs[1][2]), "+v"(bs[1][3]),
                          "+v"(bs[2][0]), "+v"(bs[2][1]), "+v"(bs[2][2]), "+v"(bs[2][3]), "+v"(bs[3][0]), "+v"(bs[3][1]), "+v"(bs[3][2]), "+v"(bs[3][3]));
        const float ninf = -1e30f;
#pragma unroll
        for (int i = 0; i < 4; ++i)
#pragma unroll
            for (int r = 0; r < 4; ++r) {
                const int rel = relb - (16 * i + r);
                const float sv = S[i][r] * (0.125f * LOG2E) + (bs[i][r] - m);
                S[i][r] = (sb && rel >= 0) ? sv : ninf; tmax = fmaxf(tmax, S[i][r]);
            }
    }
    if (__ballot(tmax > 8.f) != 0ull) {
        tmax = rows_max(tmax);
        const float d = fmaxf(tmax, 0.f), alpha = __builtin_amdgcn_exp2f(-d);
        m += d; l *= alpha;
#pragma unroll
        for (int mt = 0; mt < 4; ++mt) O[mt] = O[mt] * alpha;
#pragma unroll
        for (int i = 0; i < 4; ++i)
#pragma unroll
            for (int r = 0; r < 4; ++r) S[i][r] -= d;
    }
    float psum = 0.f;
#pragma unroll
    for (int i = 0; i < 4; ++i)
#pragma unroll
        for (int r = 0; r < 4; ++r) { const float pv = __builtin_amdgcn_exp2f(S[i][r]); S[i][r] = pv; psum += pv; }
    l += psum;
    const bf16x8 Pb0 = pack8(S[0], S[1]), Pb1 = pack8(S[2], S[3]);
#pragma unroll
    for (int mt = 0; mt < 4; ++mt) { O[mt] = mfma16(lds_vfrag128(vL, 16 * mt + fr, 0, fq), Pb0, O[mt]); O[mt] = mfma16(lds_vfrag128(vL, 16 * mt + fr, 32, fq), Pb1, O[mt]); }
}
__device__ __forceinline__ void sel_ntile2_fast(const bf16x8 (&Kf)[4][2], const unsigned char* vL, int fr, int fq, const bf16x8 (&Qf)[2][2], f32x4 (&O)[2][4], float (&m)[2], float (&l)[2],
                                                const bool (&sb)[2], const int (&relb)[2], int th, float blo, float bhi) {
    f32x4 S[2][4]; float tmax[2], bl[2], bh[2], scl[2];
#pragma unroll
    for (int b = 0; b < 2; ++b)
#pragma unroll
        for (int i = 0; i < 4; ++i) { S[b][i] = (f32x4){0.f, 0.f, 0.f, 0.f}; S[b][i] = mfma16(Kf[i][0], Qf[b][0], S[b][i]); S[b][i] = mfma16(Kf[i][1], Qf[b][1], S[b][i]); }
#pragma unroll
    for (int b = 0; b < 2; ++b) { scl[b] = sb[b] ? 0.125f * LOG2E : 0.f; bl[b] = (sb[b] ? blo : -1e30f) - m[b]; bh[b] = (sb[b] ? bhi : -1e30f) - m[b]; tmax[b] = -1e30f; }
    if (th == 0) {
#pragma unroll
        for (int b = 0; b < 2; ++b)
#pragma unroll
            for (int i = 0; i < 4; ++i)
#pragma unroll
                for (int r = 0; r < 4; ++r) { S[b][i][r] = S[b][i][r] * scl[b] + bh[b]; tmax[b] = fmaxf(tmax[b], S[b][i][r]); }
    } else {
#pragma unroll
        for (int b = 0; b < 2; ++b)
#pragma unroll
            for (int i = 0; i < 4; ++i)
#pragma unroll
                for (int r = 0; r < 4; ++r) { const int rel = relb[b] - (16 * i + r); S[b][i][r] = S[b][i][r] * scl[b] + (rel >= th ? bh[b] : bl[b]); tmax[b] = fmaxf(tmax[b], S[b][i][r]); }
    }
    if (__ballot(tmax[0] > 8.f || tmax[1] > 8.f) != 0ull) {
#pragma unroll
        for (int b = 0; b < 2; ++b) {
            tmax[b] = rows_max(tmax[b]);
            const float d = fmaxf(tmax[b], 0.f), alpha = __builtin_amdgcn_exp2f(-d);
            m[b] += d; l[b] *= alpha;
#pragma unroll
            for (int mt = 0; mt < 4; ++mt) O[b][mt] = O[b][mt] * alpha;
#pragma unroll
            for (int i = 0; i < 4; ++i)
#pragma unroll
                for (int r = 0; r < 4; ++r) S[b][i][r] -= d;
        }
    }
    float psum[2] = {0.f, 0.f};
#pragma unroll
    for (int b = 0; b < 2; ++b)
#pragma unroll
        for (int i = 0; i < 4; ++i)
#pragma unroll
            for (int r = 0; r < 4; ++r) { const float pv = __builtin_amdgcn_exp2f(S[b][i][r]); S[b][i][r] = pv; psum[b] += pv; }
#pragma unroll
    for (int b = 0; b < 2; ++b) l[b] += psum[b];
    bf16x8 P0[2], P1[2];
#pragma unroll
    for (int b = 0; b < 2; ++b) { P0[b] = pack8(S[b][0], S[b][1]); P1[b] = pack8(S[b][2], S[b][3]); }
#pragma unroll
    for (int mt = 0; mt < 4; ++mt) {
        const bf16x8 v0 = lds_vfrag128(vL, 16 * mt + fr, 0, fq), v1 = lds_vfrag128(vL, 16 * mt + fr, 32, fq);
#pragma unroll
        for (int b = 0; b < 2; ++b) { O[b][mt] = mfma16(v0, P0[b], O[b][mt]); O[b][mt] = mfma16(v1, P1[b], O[b][mt]); }
    }
}
template <bool FAST>
__device__ __forceinline__ void sel_tile(const unsigned char* kL, const unsigned char* vL, const unsigned char* lds, const bf16x8 (&Qf)[2][2], f32x4 (&O)[2][4], float (&m)[2], float (&l)[2],
                                         const bool (&sb)[2], const bool (&need)[2], const int (&relb)[2], int th, float blo, float bhi, int hl, int fr, int fq) {
    bf16x8 Kf[4][2];
#pragma unroll
    for (int i = 0; i < 4; ++i)
#pragma unroll
        for (int ks = 0; ks < 2; ++ks) Kf[i][ks] = lds_frag128(kL, 16 * i + fr, 4 * ks + fq);
    if (FAST && need[0] && need[1]) { sel_ntile2_fast(Kf, vL, fr, fq, Qf, O, m, l, sb, relb, th, blo, bhi); return; }
    if (need[0]) sel_ntile<FAST>(Kf, vL, fr, fq, Qf[0][0], Qf[0][1], O[0], m[0], l[0], sb[0], relb[0], th, blo, bhi, lds, hl);
    if (need[1]) sel_ntile<FAST>(Kf, vL, fr, fq, Qf[1][0], Qf[1][1], O[1], m[1], l[1], sb[1], relb[1], th, blo, bhi, lds, hl);
}
template <int VAR>
__device__ __forceinline__ void sel_item(const Params& p, int v, unsigned char* lds) {
    unsigned char* ws = launder(p.ws);
    const int tid = ltid(), lane = tid & 63, wid = tid >> 6, fr = lane & 15, fq = lane >> 4;
    const int qt = 127 - (v >> 2), sub = v & 3, b = sub >> 1, g = sub & 1;
    const int q0 = qt * 64, cur = qt, hl = fr & 3;
    const bf16_t* P = (const bf16_t*)(ws + WS_P);
    __syncthreads();
    if (tid < 128) ((float*)(lds + SEL_BIAS2))[tid] = p.rel_bias[(tid & 31) * 8 + 4 * g + (tid >> 5)] * LOG2E;
    if (tid >= 128 && tid < 144) ((int*)(lds + SEL_BIAS2 + 512))[tid - 128] = t5_first(tid - 128 + 16);
    int t[2]; size_t tok[2]; bf16x8 Qf[2][2]; unsigned selw[2][4];
#pragma unroll
    for (int nt = 0; nt < 2; ++nt) {
        t[nt] = q0 + 8 * wid + 4 * nt + (fr >> 2); tok[nt] = (size_t)b * S_ + t[nt];
#pragma unroll
        for (int ks = 0; ks < 2; ++ks) Qf[nt][ks] = *(const bf16x8*)(P + tok[nt] * LD + C_QA + (4 * g + hl) * 64 + 32 * ks + 8 * fq);
        const u32x4 w = *(const u32x4*)((const unsigned*)(ws + WS_SELW) + (tok[nt] * 2 + g) * 4);
        selw[nt][0] = w.x; selw[nt][1] = w.y; selw[nt][2] = w.z; selw[nt][3] = w.w;
    }
    f32x4 O[2][4]; float m[2], l[2];
#pragma unroll
    for (int nt = 0; nt < 2; ++nt) { m[nt] = -1000.f; l[nt] = 0.f;
#pragma unroll
        for (int mt = 0; mt < 4; ++mt) O[nt][mt] = (f32x4){0.f, 0.f, 0.f, 0.f}; }
    const bf16_t* kb = P + ((size_t)b * S_) * LD + C_KS + g * 64;
    const bf16_t* vb = (const bf16_t*)(ws + WS_VST) + (size_t)(b * 2 + g) * 64 * S_;
    const int nts = cur + 1;
#define SEL_ISSUE(jj) do { unsigned char* st_ = lds + ((jj) & 7) * 16384; const int c_ = ((lane & 7) ^ (lane >> 3)) * 8, r_ = 8 * wid + (lane >> 3); \
        glds16(kb + ((size_t)(jj) * 64 + r_) * LD + c_, st_ + wid * 1024); glds16(vb + (size_t)r_ * S_ + (jj) * 64 + c_, st_ + 8192 + wid * 1024); } while (0)
#pragma unroll
    for (int q = 0; q < 4; ++q) if (q < nts) SEL_ISSUE(q);
    const unsigned char* bucketL = lds + SEL_BUCKET;
    for (int jp = 0; jp < nts; jp += 4) {
        WAIT_V(0);
        RAW_BARRIER();
#pragma unroll
        for (int q = 4; q < 8; ++q) if (jp + q < nts) SEL_ISSUE(jp + q);
#pragma unroll 1
      for (int j = jp; j < jp + 4 && j < nts; ++j) {
        const unsigned char* cu = lds + (j & 7) * 16384;
        bool sb[2], need[2]; int relb[2];
#pragma unroll
        for (int nt = 0; nt < 2; ++nt) {
            const unsigned w = j < 32 ? selw[nt][0] : j < 64 ? selw[nt][1] : j < 96 ? selw[nt][2] : selw[nt][3];
            sb[nt] = (w >> (j & 31)) & 1u; need[nt] = __ballot(sb[nt]) != 0ull; relb[nt] = t[nt] - 64 * j - 4 * fq;
        }
        if (VAR == 1) { need[0] = false; need[1] = false; }
        if (VAR == 2) { if (!(need[0] || need[1])) { need[0] = false; } else { need[0] = true; need[1] = true; } }
        if (need[0] || need[1]) {
            const int rmin = q0 - 64 * j - 63, rmax = q0 + 31 - 64 * j;
            bool fast = false; int th = 0; float blo = 0.f, bhi = 0.f;
            if (rmin >= 16) {
                const int b0 = bucketL[rmin], b1 = bucketL[rmax > 8191 ? 8191 : rmax];
                if (b1 - b0 <= 1) { fast = true; th = b1 == b0 ? 0 : ((const int*)(lds + SEL_BIAS2 + 512))[b1 - 16];
                    blo = ((const float*)(lds + SEL_BIAS2))[hl * 32 + b0]; bhi = ((const float*)(lds + SEL_BIAS2))[hl * 32 + b1]; }
            }
            if (fast) sel_tile<true>(cu, cu + 8192, lds, Qf, O, m, l, sb, need, relb, th, blo, bhi, hl, fr, fq);
            else sel_tile<false>(cu, cu + 8192, lds, Qf, O, m, l, sb, need, relb, th, blo, bhi, hl, fr, fq);
        }
      }
    }
#undef SEL_ISSUE
    __syncthreads();
#pragma unroll
    for (int nt = 0; nt < 2; ++nt) {
        const float lt = rows_sum(l[nt]), gt = bf2f(P[tok[nt] * LD + C_GA + (4 * g + hl) * 3 + 1]) * (lt > 0.f ? 1.f / lt : 0.f);
        const size_t o = tok[nt] * 512 + (4 * g + hl) * 64;
#pragma unroll
        for (int mt = 0; mt < 4; ++mt) {
            const f32x4 yc = unpack4(*(const u32x2*)((const bf16_t*)(ws + WS_YC) + o + 16 * mt + 4 * fq));
            const f32x4 yw = unpack4(*(const u32x2*)((const bf16_t*)(ws + WS_YW) + o + 16 * mt + 4 * fq));
            if (VAR == 0 || VAR == 3) *(u32x2*)((bf16_t*)(ws + WS_YA) + tok[nt] * 1536 + (4 * g + hl) * 64 + 16 * mt + 4 * fq) = pack4(yc + yw + O[nt][mt] * gt);
            else asm volatile("" :: "v"(O[nt][mt]));
        }
    }
}

__device__ __forceinline__ void scan_item(const Params& p, int item, int half) {
    unsigned char* ws = launder(p.ws);
    const int idx = item * HT + (ltid() & 255);
    const int bh = idx >> 13, ed = idx & 8191, h = bh & 7;
    const float dec = exp2f(128.f * ret_lg2(h));
    const float* KVT = (const float*)(ws + WS_KVT) + (size_t)bh * 64 * 8192 + ed;
    bf16_t* SPT = (bf16_t*)(ws + WS_SPT) + (size_t)bh * 64 * 8192 + ed;
    float s = 0.f;
#pragma unroll
    for (int n0 = 0; n0 < 64; n0 += 32) {
        float kv[32];
#pragma unroll
        for (int n = 0; n < 32; ++n) kv[n] = KVT[(size_t)(n0 + n) * 8192];
#pragma unroll
        for (int n = 0; n < 32; ++n) { SPT[(size_t)(n0 + n) * 8192] = f2bf(s); s = s * dec + kv[n]; }
    }
}

__device__ __forceinline__ void phase_p3(const Params& p, unsigned char* lds, int half, int what) {
    for (int i = (ltid() & 255); i < 8192 / 16; i += HT) ((u32x4*)(lds + NSA_BUCKET))[i] = ((const u32x4*)(launder(p.ws) + WS_BUCKET))[i];
    __syncthreads();
    for (int h = (blockIdx.x * 2 + half); h < 512; h += (gridDim.x * 2)) {
        if (what & 1) cmp_item(p, h, lds, half);
        if (what & 2) {
            if (h >= 128 && h < 384) win_item(p, h - 128, lds, half);
            else if (h >= 384) { win_item(p, 256 + 2 * (h - 384) - ((h & 1) ? 1 : 0) , lds, half); win_item(p, 256 + 2 * (h - 384) + ((h & 1) ? 0 : 1) + 1 - ((h & 1) ? 0 : 0), lds, half); }
        }
        if (what & 4) scan_item(p, h, half);
    }
}

__device__ __forceinline__ void retout_item(const Params& p, int item, unsigned char* lds, int half) {
    unsigned char* ws = launder(p.ws);
    const int tid = (ltid() & 255), lane = tid & 63, wid = tid >> 6, fr = lane & 15, fq = lane >> 4;
    const int n = item & 63, h = (item >> 6) & 7, b = item >> 9;
    const size_t tok0 = (size_t)b * S_ + 128 * n;
    const bf16_t* P = (const bf16_t*)(ws + WS_P);
    unsigned char* vL = lds; unsigned char* kL = lds + 32768; unsigned char* sL = lds + 49152;
    const int wq = half ? 3 - wid : wid;
    __syncthreads();
    load_tile128w((const bf16_t*)(ws + WS_VRT) + ((size_t)(b * 8 + h) * 128) * S_ + 128 * n, S_, vL, wid, lane);
    load_tile128(P + tok0 * LD + C_KR + h * 64, LD, kL, wid, lane);
    load_tile128((const bf16_t*)(ws + WS_SPT) + ((size_t)(b * 8 + h) * 64 + n) * 8192, 64, sL, wid, lane);
    bf16x8 Qf[2][2];
#pragma unroll
    for (int nt = 0; nt < 2; ++nt)
#pragma unroll
        for (int ks = 0; ks < 2; ++ks) Qf[nt][ks] = *(const bf16x8*)(P + (tok0 + 32 * wq + 16 * nt + fr) * LD + C_QR + h * 64 + 32 * ks + 8 * fq);
    wait_vm0(); __syncthreads();
    const float lg2 = ret_lg2(h);
    f32x4 Y[8][2];
#pragma unroll
    for (int m = 0; m < 8; ++m)
#pragma unroll
        for (int nt = 0; nt < 2; ++nt) Y[m][nt] = (f32x4){0.f, 0.f, 0.f, 0.f};
#pragma unroll
    for (int m = 0; m < 8; ++m)
#pragma unroll
        for (int ks = 0; ks < 2; ++ks) {
            const bf16x8 a = lds_frag128(sL, 16 * m + fr, 4 * ks + fq);
#pragma unroll
            for (int nt = 0; nt < 2; ++nt) Y[m][nt] = mfma16(a, Qf[nt][ks], Y[m][nt]);
        }
#pragma unroll
    for (int nt = 0; nt < 2; ++nt) {
        const float sc = __builtin_amdgcn_exp2f((float)(32 * wq + 16 * nt + fr + 1) * lg2);
#pragma unroll
        for (int m = 0; m < 8; ++m) Y[m][nt] = Y[m][nt] * sc;
    }
#pragma unroll 1
    for (int s = 0; s <= wq; ++s) {
        f32x4 St[2][2];
#pragma unroll
        for (int hh = 0; hh < 2; ++hh) {
            const int mt = 2 * s + hh;
#pragma unroll
            for (int nt = 0; nt < 2; ++nt) St[hh][nt] = (f32x4){0.f, 0.f, 0.f, 0.f};
#pragma unroll
            for (int ks = 0; ks < 2; ++ks) {
                const bf16x8 a = lds_frag128(kL, 16 * mt + fr, 4 * ks + fq);
#pragma unroll
                for (int nt = 0; nt < 2; ++nt) St[hh][nt] = mfma16(a, Qf[nt][ks], St[hh][nt]);
            }
#pragma unroll
            for (int nt = 0; nt < 2; ++nt) {
                const int qi = 32 * wq + 16 * nt + fr;
#pragma unroll
                for (int r = 0; r < 4; ++r) {
                    const int kj = 16 * mt + 4 * fq + r;
                    const float dm = qi >= kj ? __builtin_amdgcn_exp2f((float)(qi - kj) * lg2) : 0.f;
                    St[hh][nt][r] *= dm;
                }
            }
        }
        bf16x8 Pb[2];
#pragma unroll
        for (int nt = 0; nt < 2; ++nt) Pb[nt] = pack8(St[0][nt], St[1][nt]);
#pragma unroll
        for (int m = 0; m < 8; ++m) {
            const bf16x8 a = lds_vfrag256(vL, 16 * m + fr, 32 * s, fq);
#pragma unroll
            for (int nt = 0; nt < 2; ++nt) Y[m][nt] = mfma16(a, Pb[nt], Y[m][nt]);
        }
    }
    bf16_t* YB = (bf16_t*)(ws + WS_YA) + 512;
#pragma unroll
    for (int nt = 0; nt < 2; ++nt) {
        float sum = 0.f;
#pragma unroll
        for (int m = 0; m < 8; ++m) sum += Y[m][nt][0] + Y[m][nt][1] + Y[m][nt][2] + Y[m][nt][3];
        sum = rows_sum(sum);
        const float mu = sum * (1.f / 128.f);
        float vs = 0.f;
#pragma unroll
        for (int m = 0; m < 8; ++m)
#pragma unroll
            for (int r = 0; r < 4; ++r) { const float dlt = Y[m][nt][r] - mu; vs += dlt * dlt; }
        vs = rows_sum(vs);
        const float rstd = rsqrtf(vs * (1.f / 128.f) + 1e-5f);
        const size_t tk = tok0 + 32 * wq + 16 * nt + fr;
#pragma unroll
        for (int m = 0; m < 8; ++m) {
            const f32x4 gt = unpack4(*(const u32x2*)(P + tk * LD + C_GR + h * 128 + 16 * m + 4 * fq));
            f32x4 v;
#pragma unroll
            for (int r = 0; r < 4; ++r) v[r] = (Y[m][nt][r] - mu) * rstd * gt[r];
            *(u32x2*)(YB + tk * 1536 + h * 128 + 16 * m + 4 * fq) = pack4(v);
        }
    }
}
__device__ __forceinline__ void phase_p4_sel(const Params& p, unsigned char* lds) {
    for (int i = ltid(); i < 8192 / 16; i += NTHREADS) ((u32x4*)(lds + SEL_BUCKET))[i] = ((const u32x4*)(launder(p.ws) + WS_BUCKET))[i];
    __syncthreads();
    for (int it = blockIdx.x; it < 512; it += gridDim.x * 2) {
        sel_item<0>(p, it, lds);
        if (511 - it != it) sel_item<0>(p, 511 - it, lds);
    }
    __syncthreads();
}
__device__ __forceinline__ void phase_p4(const Params& p, unsigned char* lds, int half) {
    for (int it = (blockIdx.x * 2 + half); it < 1024; it += (gridDim.x * 2)) retout_item(p, it, lds, half);
}

struct RowOrder {     typedef pg8::Unit U; static constexpr bool GATHER = false;
    unsigned a, b; int K, xcd, slot, per;
    __device__ __forceinline__ bool next(int i, pg8::Unit& u) const { const int t = xcd * 32 + slot + i * per; if (t >= (xcd + 1) * 32) return false; u.pm = t >> 2; u.pn = t & 3; return true; }
    __device__ __forceinline__ void ptrs(const pg8::Unit& u, unsigned& A, unsigned& B) const { A = a + (unsigned)u.pm * 512u * (unsigned)K; B = b + (unsigned)u.pn * 512u * (unsigned)K; }
};
template <int MODE>
struct MixEpi {
    static constexpr int MID_T = MODE == 0 ? 8 : 0;
    unsigned char* ws; const float* X;
    __device__ __forceinline__ void mid(f32x4 (&acc)[2][2][4][2], const pg8::Unit& u, int wr, int wc, int fr, int fq) const {
#pragma unroll
        for (int ai = 0; ai < 2; ++ai) {
            __builtin_amdgcn_sched_barrier(0);
#pragma unroll
            for (int m = 0; m < 4; ++m) {
                const size_t tok = (size_t)(u.pm * 256 + 128 * ai + 64 * wr + 16 * m + fr + vzero());
#pragma unroll
                for (int bj = 0; bj < 2; ++bj) {
                    const int n = u.pn * 256 + 128 * bj + 32 * wc + 8 * fq;
                    const u32x4 ga = *(const u32x4*)((const bf16_t*)(ws + WS_P) + tok * LD + C_MA + n), gb = *(const u32x4*)((const bf16_t*)(ws + WS_P) + tok * LD + C_MB + n);
                    const f32x4 a0 = unpack4((u32x2){ga.x, ga.y}), a1 = unpack4((u32x2){ga.z, ga.w}), b0 = unpack4((u32x2){gb.x, gb.y}), b1 = unpack4((u32x2){gb.z, gb.w});
#pragma unroll
                    for (int r = 0; r < 4; ++r) { acc[ai][bj][m][0][r] *= a0[r] * __builtin_amdgcn_rcpf(fmaxf(b0[r], 1e-30f)); acc[ai][bj][m][1][r] *= a1[r] * __builtin_amdgcn_rcpf(fmaxf(b1[r], 1e-30f)); }
                }
            }
        }
        __builtin_amdgcn_sched_barrier(0);
    }
    __device__ __forceinline__ void operator()(const f32x4 (&acc)[2][2][4][2], const pg8::Unit& u, int wr, int wc, int fr, int fq) const {
#pragma unroll
        for (int ai = 0; ai < 2; ++ai)
#pragma unroll
            for (int m = 0; m < 4; ++m) {
                const size_t tok = (size_t)(u.pm * 256 + 128 * ai + 64 * wr + 16 * m + fr + vzero());
#pragma unroll
                for (int bj = 0; bj < 2; ++bj) {
                    const int n = u.pn * 256 + 128 * bj + 32 * wc + 8 * fq;
                    const f32x4 v0 = acc[ai][bj][m][0], v1 = acc[ai][bj][m][1];
                    if (MODE == 2) {
                        const u32x4 xw = *(const u32x4*)((const bf16_t*)(ws + WS_XB) + tok * 1024 + n);
                        const f32x4 h0 = unpack4((u32x2){xw.x, xw.y}) * DN_ALPHA + v0, h1 = unpack4((u32x2){xw.z, xw.w}) * DN_ALPHA + v1;
                        u32x4 w; w.x = pack2(h0[0], h0[1]); w.y = pack2(h0[2], h0[3]); w.z = pack2(h1[0], h1[1]); w.w = pack2(h1[2], h1[3]);
                        *(u32x4*)((bf16_t*)(ws + WS_H1) + tok * 1024 + n) = w;
                    } else {
                        const u32x4 gw = *(const u32x4*)((const bf16_t*)(ws + WS_P) + tok * LD + C_MB + n);
                        const f32x4 g0 = unpack4((u32x2){gw.x, gw.y}), g1 = unpack4((u32x2){gw.z, gw.w});
                        const f32x4 o0 = g0 * v0, o1 = g1 * v1;
                        u32x4 w; w.x = pack2(o0[0], o0[1]); w.y = pack2(o0[2], o0[3]); w.z = pack2(o1[0], o1[1]); w.w = pack2(o1[2], o1[3]);
                        *(u32x4*)((bf16_t*)(ws + WS_MG) + tok * 1024 + n) = w;
                    }
                }
            }
    }
};
__device__ __forceinline__ void phase_g2(const Params& p, unsigned char* lds) {
    unsigned char* ws = launder(p.ws);
    RowOrder S; S.xcd = blockIdx.x & 7; S.slot = blockIdx.x >> 3; S.per = gridDim.x >> 3;
    S.a = (unsigned)WS_YA; S.b = (unsigned)WS_WA; S.K = 1536; MixEpi<0> E; E.ws = ws; E.X = nullptr;
    pg8::gemm_phase<MixEpi<0>, RowOrder>(lds, 1536, S, E, ltid(), ws);
}
__device__ __forceinline__ void phase_g3(const Params& p, int layer, unsigned char* lds) {
    unsigned char* ws = launder(p.ws);
    RowOrder S; S.xcd = blockIdx.x & 7; S.slot = blockIdx.x >> 3; S.per = gridDim.x >> 3; S.a = (unsigned)WS_MG; S.b = (unsigned)WS_WO; S.K = 1024;
    MixEpi<2> E; E.ws = ws; E.X = nullptr;
    pg8::gemm_phase<MixEpi<2>, RowOrder>(lds, 1024, S, E, ltid(), ws);
}

__device__ __forceinline__ void phase_ln1(const Params& p, int layer, unsigned char* lds, bool dry, int half) {
    unsigned char* ws = launder(p.ws);
    const int tid = (ltid() & 255), lane = tid & 63, wid = tid >> 6;
    float* wrL = (float*)lds;
    float* lgL = (float*)(lds - half * HALF_LDS + 65536);
    {
        float4 wv[16];
#pragma unroll
        for (int k = 0; k < 16; ++k) wv[k] = ((const float4*)p.w_router)[tid + 256 * k];
#pragma unroll
        for (int k = 0; k < 16; ++k) { const int i4 = tid + 256 * k, d = i4 >> 2, e0 = (i4 & 3) * 4;
            wrL[(e0 + 0) * 1024 + d] = wv[k].x; wrL[(e0 + 1) * 1024 + d] = wv[k].y; wrL[(e0 + 2) * 1024 + d] = wv[k].z; wrL[(e0 + 3) * 1024 + d] = wv[k].w; }
    }
    __syncthreads();
    const bf16_t* H1 = (const bf16_t*)(ws + WS_H1);
    bf16_t* X1B = (bf16_t*)(ws + WS_X1B);
    const float* gam = p.ln1_g + layer * 1024; const float* bet = p.ln1_b + layer * 1024;
    unsigned* cnt = (unsigned*)(ws + WS_CTL) + (dry ? 0 : CW_CNT) + layer * 1024;
    int* LIST = (int*)(ws + (dry ? WS_HB : WS_LIST)); float* WTS = (float*)(ws + (dry ? WS_HB + 4194304 : WS_WTS));
    constexpr int U = 4;
    const int nwave = (gridDim.x * 2) * 4, wv = (blockIdx.x * 2 + half) * 4 + wid;
    const int nloc = ((T_ - wv * U + nwave * U - 1) / (nwave * U)) * (4 * U);
    u32x2 vn[U][4];
#pragma unroll
    for (int u = 0; u < U; ++u)
#pragma unroll
        for (int j = 0; j < 4; ++j) vn[u][j] = *(const u32x2*)(H1 + (size_t)(wv * U + u) * 1024 + 256 * j + 4 * lane);
    for (int t0 = wv * U; t0 < T_; t0 += nwave * U) {
        float4 y[U][4]; float s[U], q[U];
#pragma unroll
        for (int u = 0; u < U; ++u) {
            s[u] = 0.f;
#pragma unroll
            for (int j = 0; j < 4; ++j) { const f32x4 t = unpack4(vn[u][j]); y[u][j].x = t[0]; y[u][j].y = t[1]; y[u][j].z = t[2]; y[u][j].w = t[3]; s[u] += (t[0] + t[1]) + (t[2] + t[3]); }
        }
        if (t0 + nwave * U < T_) { const int tn = t0 + nwave * U;
#pragma unroll
          for (int u = 0; u < U; ++u)
#pragma unroll
              for (int j = 0; j < 4; ++j) vn[u][j] = *(const u32x2*)(H1 + (size_t)(tn + u) * 1024 + 256 * j + 4 * lane); }
#pragma unroll
        for (int u = 0; u < U; ++u) s[u] = wave_sum(s[u]) * (1.f / 1024.f);
#pragma unroll
        for (int u = 0; u < U; ++u) {
            q[u] = 0.f;
#pragma unroll
            for (int j = 0; j < 4; ++j) { const float a = y[u][j].x - s[u], b2 = y[u][j].y - s[u], c = y[u][j].z - s[u], d = y[u][j].w - s[u]; q[u] += a * a + b2 * b2 + c * c + d * d; }
        }
#pragma unroll
        for (int u = 0; u < U; ++u) q[u] = rsqrtf(wave_sum(q[u]) * (1.f / 1024.f) + 1e-5f);
#pragma unroll
        for (int j = 0; j < 4; ++j) {
            const int d0 = 256 * j + 4 * lane;
            const float4 gg = *(const float4*)(gam + d0), bb = *(const float4*)(bet + d0);
#pragma unroll
            for (int u = 0; u < U; ++u) {
                y[u][j].x = (y[u][j].x - s[u]) * q[u] * gg.x + bb.x; y[u][j].y = (y[u][j].y - s[u]) * q[u] * gg.y + bb.y;
                y[u][j].z = (y[u][j].z - s[u]) * q[u] * gg.z + bb.z; y[u][j].w = (y[u][j].w - s[u]) * q[u] * gg.w + bb.w;
                u32x2 w; w.x = pack2(y[u][j].x, y[u][j].y); w.y = pack2(y[u][j].z, y[u][j].w);
                *(u32x2*)(X1B + (size_t)(t0 + u) * 1024 + d0) = w;
            }
        }
        float lg[U][16];
#pragma unroll
        for (int e = 0; e < 16; ++e) {
#pragma unroll
            for (int u = 0; u < U; ++u) lg[u][e] = 0.f;
#pragma unroll
            for (int j = 0; j < 4; ++j) { const float4 w4 = *(const float4*)(wrL + e * 1024 + 256 * j + 4 * lane);
#pragma unroll
                for (int u = 0; u < U; ++u) lg[u][e] += y[u][j].x * w4.x + y[u][j].y * w4.y + y[u][j].z * w4.z + y[u][j].w * w4.w; }
        }
        float myl = 0.f;
#pragma unroll
        for (int u = 0; u < U; ++u) {
            float w8[8], z4[4];
#pragma unroll
            for (int e = 0; e < 8; ++e) { const u32x2 r = __builtin_amdgcn_permlane32_swap(__float_as_uint(lg[u][e]), __float_as_uint(lg[u][e + 8]), false, false); w8[e] = __uint_as_float(r.x) + __uint_as_float(r.y); }
#pragma unroll
            for (int e = 0; e < 4; ++e) { const u32x2 r = __builtin_amdgcn_permlane16_swap(__float_as_uint(w8[e]), __float_as_uint(w8[e + 4]), false, false); z4[e] = __uint_as_float(r.x) + __uint_as_float(r.y); }
            const bool h8 = (lane & 8) != 0, h4 = (lane & 4) != 0;
            const float k0 = h8 ? z4[2] : z4[0], s0 = h8 ? z4[0] : z4[2], k1 = h8 ? z4[3] : z4[1], s1 = h8 ? z4[1] : z4[3];
            const float y0 = k0 + __int_as_float(__builtin_amdgcn_mov_dpp(__float_as_int(s0), 0x128, 0xF, 0xF, true));
            const float y1 = k1 + __int_as_float(__builtin_amdgcn_mov_dpp(__float_as_int(s1), 0x128, 0xF, 0xF, true));
            const float k2 = h4 ? y1 : y0, s2 = h4 ? y0 : y1;
            float x = k2 + __int_as_float(__builtin_amdgcn_mov_dpp(__float_as_int(s2), 0x141, 0xF, 0xF, true));
            x += __int_as_float(__builtin_amdgcn_mov_dpp(__float_as_int(x), 0xB1, 0xF, 0xF, true));
            x += __int_as_float(__builtin_amdgcn_mov_dpp(__float_as_int(x), 0x4E, 0xF, 0xF, true));
            if ((lane & 3) == u) myl = x;
        }
        static_assert(U == 4, "lane (l & 3) stores token u = l & 3");
        lgL[(half * nloc + ((t0 - wv * U) / (nwave * U)) * (4 * U) + wid * U + (lane & 3)) * 17 + (lane >> 2)] = myl;
    }
    __syncthreads();
    if (half == 0 && wid == 0)
    for (int l0 = 0; l0 < 2 * nloc; l0 += 64) {
        const int li = l0 + lane; const bool act = li < 2 * nloc;
        const int hq = li >= nloc ? 1 : 0, lh = li - hq * nloc;
        const int it = lh / (4 * U), wq = (lh / U) & 3, uq = lh % U, tok = act ? (((blockIdx.x * 2 + hq) * 4 + wq) * U + uq) + it * (nwave * U) : 0;
        float lgv[16];
#pragma unroll
        for (int e = 0; e < 16; ++e) lgv[e] = lgL[li * 17 + e];
        float mx = lgv[0];
#pragma unroll
        for (int e = 1; e < 16; ++e) mx = fmaxf(mx, lgv[e]);
        float pr[16], ps = 0.f;
#pragma unroll
        for (int e = 0; e < 16; ++e) { pr[e] = expf(lgv[e] - mx); ps += pr[e]; }
        const float ips = 1.f / ps;
        float sel[16];
#pragma unroll
        for (int e = 0; e < 16; ++e) { pr[e] *= ips; sel[e] = pr[e] + p.router_bias[e]; }
        int best = 0; float bestv = -1e30f;
#pragma unroll
        for (int gI = 0; gI < 4; ++gI) {
            float a = -1e30f, b2 = -1e30f;
#pragma unroll
            for (int k = 0; k < 4; ++k) { const float x = sel[4 * gI + k]; if (x > a) { b2 = a; a = x; } else if (x > b2) b2 = x; }
            const float gs = a + b2;
            if (gs > bestv) { bestv = gs; best = gI; }
        }
        float s4[4], p4[4];
#pragma unroll
        for (int k = 0; k < 4; ++k) { s4[k] = 0.f; p4[k] = 0.f; }
#pragma unroll
        for (int gI = 0; gI < 4; ++gI) if (gI == best) {
#pragma unroll
            for (int k = 0; k < 4; ++k) { s4[k] = sel[4 * gI + k]; p4[k] = pr[4 * gI + k]; }
        }
        int i0 = 0; float a0 = s4[0];
#pragma unroll
        for (int k = 1; k < 4; ++k) if (s4[k] > a0) { a0 = s4[k]; i0 = k; }
        int i1 = -1; float a1 = -1e30f;
#pragma unroll
        for (int k = 0; k < 4; ++k) if (k != i0 && s4[k] > a1) { a1 = s4[k]; i1 = k; }
        float w0 = 0.f, w1 = 0.f;
#pragma unroll
        for (int k = 0; k < 4; ++k) { if (k == i0) w0 = p4[k]; if (k == i1) w1 = p4[k]; }
        const float iw = 1.f / (w0 + w1);
        const int e0 = act ? best * 4 + i0 : -1, e1 = act ? best * 4 + i1 : -1;
        unsigned myc = 0, r0 = 0, r1 = 0;
#pragma unroll
        for (int e = 0; e < 16; ++e) {
            const unsigned long long m0 = __builtin_amdgcn_ballot_w64(e0 == e), m1 = __builtin_amdgcn_ballot_w64(e1 == e);
            const unsigned c0 = (unsigned)__builtin_popcountll(m0), c = c0 + (unsigned)__builtin_popcountll(m1);
            if (lane == e) myc = c;
            if (e0 == e) r0 = __builtin_amdgcn_mbcnt_hi((unsigned)(m0 >> 32), __builtin_amdgcn_mbcnt_lo((unsigned)m0, 0u));
            if (e1 == e) r1 = c0 + __builtin_amdgcn_mbcnt_hi((unsigned)(m1 >> 32), __builtin_amdgcn_mbcnt_lo((unsigned)m1, 0u));
        }
        unsigned mybase = 0;
        if (lane < 16 && myc != 0) mybase = atomicAdd(&cnt[lane * 64], myc);
        unsigned b0 = 0, b1 = 0;
#pragma unroll
        for (int e = 0; e < 16; ++e) { const unsigned be = (unsigned)__builtin_amdgcn_readlane((int)mybase, e); if (e0 == e) b0 = be; if (e1 == e) b1 = be; }
        if (act) {
            LIST[(size_t)e0 * T_ + b0 + r0] = tok * 2; LIST[(size_t)e1 * T_ + b1 + r1] = tok * 2 + 1;
            WTS[tok * 2] = w0 * iw; WTS[tok * 2 + 1] = w1 * iw;
        }
    }
}

struct MoeUnit { int e, rt, ct, cnt, off; };
__device__ __forceinline__ const unsigned* moe_counts_to_lds(unsigned char* ws, int layer, unsigned char* lds) {
    unsigned* cntL = (unsigned*)(lds + 2 * HALF_LDS - 1024);
    const int tid = ltid();
    if (tid < NE) cntL[tid] = ((const unsigned*)(ws + WS_CTL) + CW_CNT + layer * 1024)[tid * 64];
    __syncthreads();
    return cntL;
}
struct MoeOrderBase {
    const unsigned* cntp; int t_lo, t_hi, slot, per;
    __device__ __forceinline__ void init(const unsigned* cnt) {
        cntp = cnt; int ntile = 0;
#pragma unroll
        for (int k = 0; k < NE; ++k) ntile += (__builtin_amdgcn_readfirstlane((int)cnt[k]) >> 8) * 4;
        t_lo = (ntile * (int)(blockIdx.x & 7)) >> 3; t_hi = (ntile * (int)((blockIdx.x & 7) + 1)) >> 3; slot = blockIdx.x >> 3; per = gridDim.x >> 3;
    }
    __device__ __forceinline__ bool next(int i, MoeUnit& u) const {
        const int t = t_lo + slot + i * per; if (t >= t_hi) return false;
        int base = 0, off = 0; bool found = false;
#pragma unroll
        for (int k = 0; k < NE; ++k) {
            const int ck = __builtin_amdgcn_readfirstlane((int)cntp[k]), nt = (ck >> 8) * 4;
            if (!found && t < base + nt) { found = true; u.e = k; u.cnt = ck; u.off = off; u.rt = (t - base) >> 2; u.ct = (t - base) & 3; }
            base += nt; off += ck;
        }
        return found;
    }
};
struct M2Order : MoeOrderBase {
    typedef MoeUnit U; static constexpr bool GATHER = true;
    const int* list;
    __device__ __forceinline__ void ptrs(const MoeUnit& u, unsigned& A, unsigned& B) const { A = (unsigned)WS_X1B; B = (unsigned)WS_WG + ((unsigned)u.e * 1024u + (unsigned)u.ct * 256u) * 2048u; }
    __device__ __forceinline__ void rows(const MoeUnit& u, int tid, unsigned (&v)[2]) const {
        v[0] = 0u; v[1] = 0u;
#pragma unroll
        for (int i = 0; i < 2; ++i) { int R, C; pg8::stage_rc((tid + vzero()) * 16 + i * 8192, R, C);
#pragma unroll
            for (int h = 0; h < 2; ++h) { int idx = u.rt * 256 + 128 * h + R; idx = idx < u.cnt ? idx : u.cnt - 1; const int a = (list + (size_t)u.e * T_)[idx]; v[h] |= (unsigned)(a >> 1) << (16 * i); } }
    }
};
struct M3Order : MoeOrderBase {
    typedef MoeUnit U; static constexpr bool GATHER = false;
    __device__ __forceinline__ void ptrs(const MoeUnit& u, unsigned& A, unsigned& B) const { A = (unsigned)WS_HB + ((unsigned)u.off + (unsigned)u.rt * 256u) * 1024u; B = (unsigned)WS_WD + ((unsigned)u.e * 1024u + (unsigned)u.ct * 256u) * 1024u; }
};
struct M2Epi {
    static constexpr int MID_T = 0;
    unsigned char* ws;
    __device__ __forceinline__ void operator()(const f32x4 (&acc)[2][2][4][2], const MoeUnit& u, int wr, int wc, int fr, int fq) const {
        bf16_t* HB = (bf16_t*)(ws + WS_HB);
#pragma unroll
        for (int ai = 0; ai < 2; ++ai)
#pragma unroll
            for (int m = 0; m < 4; ++m) {
                const int idx = u.rt * 256 + 128 * ai + 64 * wr + 16 * m + fr + vzero();
                if (idx < u.cnt) {
                    u32x2 hw[2];
#pragma unroll
                    for (int bj = 0; bj < 2; ++bj) {
                        const f32x4 gv = acc[ai][bj][m][0], uv = acc[ai][bj][m][1]; f32x4 hv;
#pragma unroll
                        for (int r = 0; r < 4; ++r) hv[r] = gv[r] * fsig(gv[r]) * uv[r];
                        hw[bj] = pack4(hv);
                    }
                    *(u32x4*)(HB + (size_t)(u.off + idx) * 512 + 128 * u.ct + 32 * wc + 8 * fq) = (u32x4){hw[0].x, hw[0].y, hw[1].x, hw[1].y};
                }
            }
    }
};
struct M3Epi {
    static constexpr int MID_T = 0;
    unsigned char* ws; const int* list;
    __device__ __forceinline__ void operator()(const f32x4 (&acc)[2][2][4][2], const MoeUnit& u, int wr, int wc, int fr, int fq) const {
        bf16_t* CT = (bf16_t*)(ws + WS_CT);
#pragma unroll
        for (int ai = 0; ai < 2; ++ai)
#pragma unroll
            for (int m = 0; m < 4; ++m) {
                const int idx = u.rt * 256 + 128 * ai + 64 * wr + 16 * m + fr + vzero();
                if (idx < u.cnt) {
                    const int a = list[(size_t)u.e * T_ + idx];
#pragma unroll
                    for (int bj = 0; bj < 2; ++bj) {
                        const int n = u.ct * 256 + 128 * bj + 32 * wc + 8 * fq;
                        const f32x4 v0 = acc[ai][bj][m][0], v1 = acc[ai][bj][m][1];
                        u32x4 w; w.x = pack2(v0[0], v0[1]); w.y = pack2(v0[2], v0[3]); w.z = pack2(v1[0], v1[1]); w.w = pack2(v1[2], v1[3]);
                        *(u32x4*)(CT + (size_t)a * 1024 + n) = w;
                    }
                }
            }
    }
};
template <int MODE>
__device__ __forceinline__ void moe_rem_item(unsigned char* ws, const int* list, int e, int cnt, int off, int rh, int c64, unsigned char* lds) {
    constexpr int K = MODE == 0 ? 1024 : 512, NS = K / 64;
    const int tid = (ltid() & 255), lane = tid & 63, wid = tid >> 6, wr = wid >> 1, wc = wid & 1, fr = lane & 15, fq = lane >> 4;
    const int idx0 = (cnt & ~255) + 128 * rh;
    const int ldc = ((lane & 7) ^ (lane >> 3)) * 8;
    const bf16_t* ap[4];
#pragma unroll
    for (int i = 0; i < 4; ++i) {
        int idx = idx0 + 32 * i + 8 * wid + (lane >> 3); idx = idx < cnt ? idx : cnt - 1;
        if (MODE == 0) { const int a = list[(size_t)e * T_ + idx]; ap[i] = (const bf16_t*)(ws + WS_X1B) + (size_t)(a >> 1) * 1024 + ldc; }
        else ap[i] = (const bf16_t*)(ws + WS_HB) + (size_t)(off + idx) * 512 + ldc;
    }
    const bf16_t* bp[2];
#pragma unroll
    for (int i = 0; i < 2; ++i) {
        const int rho = 8 * (wid + 4 * i) + (lane >> 3), src = (rho & ~31) + pg8::perm32(rho & 31);
        bp[i] = (const bf16_t*)(ws + (MODE == 0 ? WS_WG : WS_WD)) + ((size_t)e * 1024 + 64 * c64 + src) * K + ldc;
    }
    f32x4 acc[4][2];
#pragma unroll
    for (int i = 0; i < 4; ++i)
#pragma unroll
        for (int j = 0; j < 2; ++j) acc[i][j] = (f32x4){0.f, 0.f, 0.f, 0.f};
    __syncthreads();
#define RSTAGE(buf, l) do { unsigned char* st_ = lds + (buf) * 24576; \
        _Pragma("unroll") for (int i = 0; i < 4; ++i) glds16(ap[i] + (l) * 64, st_ + (4 * i + wid) * 1024); \
        _Pragma("unroll") for (int i = 0; i < 2; ++i) glds16(bp[i] + (l) * 64, st_ + 16384 + (wid + 4 * i) * 1024); } while (0)
    RSTAGE(0, 0); RSTAGE(1, 1);
    for (int l = 0; l < NS; ++l) {
        const unsigned char* st = lds + (l % 3) * 24576;
        if (l + 1 < NS) WAIT_V(6); else WAIT_V(0);
        RAW_BARRIER();
        if (l + 2 < NS) RSTAGE((l + 2) % 3, l + 2);
#pragma unroll
        for (int ks = 0; ks < 2; ++ks) {
            bf16x8 a[4], bb[2];
#pragma unroll
            for (int i = 0; i < 4; ++i) a[i] = lds_frag128(st, 64 * wr + 16 * i + fr, 4 * ks + fq);
#pragma unroll
            for (int j = 0; j < 2; ++j) bb[j] = lds_frag128(st + 16384, 32 * wc + 16 * j + fr, 4 * ks + fq);
#pragma unroll
            for (int i = 0; i < 4; ++i)
#pragma unroll
                for (int j = 0; j < 2; ++j) acc[i][j] = mfma16(bb[j], a[i], acc[i][j]);
        }
    }
#undef RSTAGE
#pragma unroll
    for (int i = 0; i < 4; ++i) {
        const int idx = idx0 + 64 * wr + 16 * i + fr + vzero();
        if (idx < cnt) {
            if (MODE == 0) {
                f32x4 hv;
#pragma unroll
                for (int r = 0; r < 4; ++r) hv[r] = acc[i][0][r] * fsig(acc[i][0][r]) * acc[i][1][r];
                *(u32x2*)((bf16_t*)(ws + WS_HB) + (size_t)(off + idx) * 512 + 128 * (c64 >> 2) + 32 * (2 * (c64 & 1) + wc) + 8 * fq + 4 * ((c64 >> 1) & 1)) = pack4(hv);
            } else {
                const int a = list[(size_t)e * T_ + idx];
                const f32x4 v0 = acc[i][0], v1 = acc[i][1];
                u32x4 w; w.x = pack2(v0[0], v0[1]); w.y = pack2(v0[2], v0[3]); w.z = pack2(v1[0], v1[1]); w.w = pack2(v1[2], v1[3]);
                *(u32x4*)((bf16_t*)(ws + WS_CT) + (size_t)a * 1024 + 64 * c64 + 32 * wc + 8 * fq) = w;
            }
        }
    }
    __syncthreads();
}
template <int MODE>
__device__ __forceinline__ void moe_rem(const unsigned* cntp, unsigned char* ws, const int* list, unsigned char* ldsh, int half) {
    for (int t = blockIdx.x * 2 + half; ; t += gridDim.x * 2) {
        int base = 0, off = 0, e = -1, cnt = 0, eoff = 0, loc = 0;
#pragma unroll
        for (int k = 0; k < NE; ++k) {
            const int ck = __builtin_amdgcn_readfirstlane((int)cntp[k]), ni = (((ck & 255) + 127) >> 7) * 16;
            if (e < 0 && t < base + ni) { e = k; cnt = ck; eoff = off; loc = t - base; }
            base += ni; off += ck;
        }
        if (e < 0) break;
        moe_rem_item<MODE>(ws, list, e, cnt, eoff, loc >> 4, loc & 15, ldsh);
    }
}
__device__ __forceinline__ void phase_m2(const Params& p, int layer, unsigned char* lds, unsigned char* ldsh, int half) {
    unsigned char* ws = launder(p.ws);
    const unsigned* cntL = moe_counts_to_lds(ws, layer, lds);
    M2Order S; S.init(cntL);
    S.list = (const int*)(ws + WS_LIST);
    M2Epi E; E.ws = ws;
    pg8::gemm_phase<M2Epi, M2Order>(lds, 1024, S, E, ltid(), ws);
    moe_rem<0>(S.cntp, ws, S.list, ldsh, half);
}
__device__ __forceinline__ void phase_m3(const Params& p, int layer, unsigned char* lds, unsigned char* ldsh, int half) {
    unsigned char* ws = launder(p.ws);
    const unsigned* cntL = moe_counts_to_lds(ws, layer, lds);
    M3Order S; S.init(cntL);
    M3Epi E; E.ws = ws; E.list = (const int*)(ws + WS_LIST);
    pg8::gemm_phase<M3Epi, M3Order>(lds, 512, S, E, ltid(), ws);
    moe_rem<1>(S.cntp, ws, E.list, ldsh, half);
}

__device__ __forceinline__ void phase_ln2(const Params& p, int layer, int half) {
    unsigned char* ws = launder(p.ws);
    const int tid = (ltid() & 255), lane = tid & 63, wid = tid >> 6;
    const bf16_t* X1 = (const bf16_t*)(ws + WS_X1B); const bf16_t* CT = (const bf16_t*)(ws + WS_CT); const float* WTS = (const float*)(ws + WS_WTS);
    float* XO = p.out; bf16_t* XB = (bf16_t*)(ws + WS_XB); const bool fin = layer == NLAYER - 1;
    const float* gam = p.ln2_g + layer * 1024; const float* bet = p.ln2_b + layer * 1024;
    constexpr int U = 4;
    const int nwave = (gridDim.x * 2) * 4, wv = (blockIdx.x * 2 + half) * 4 + wid;
    for (int t0 = wv * U; t0 < T_; t0 += nwave * U) {
        float v[U][2][8]; float s[U], q[U];
#pragma unroll
        for (int u = 0; u < U; ++u) {
            const int tok = t0 + u;
            const float w0 = WTS[tok * 2 + vzero()], w1 = WTS[tok * 2 + 1 + vzero()];
            s[u] = 0.f; q[u] = 0.f;
#pragma unroll
            for (int j = 0; j < 2; ++j) {
                const int d0 = 512 * j + 8 * lane;
                const u32x4 xr = *(const u32x4*)(X1 + (size_t)tok * 1024 + d0);
                const u32x4 c0 = *(const u32x4*)(CT + (size_t)(tok * 2) * 1024 + d0), c1 = *(const u32x4*)(CT + (size_t)(tok * 2 + 1) * 1024 + d0);
#pragma unroll
                for (int e = 0; e < 4; ++e) {
                    const float a = bf2f(xr[e] & 0xffffu) * DN_ALPHA + w0 * bf2f(c0[e] & 0xffffu) + w1 * bf2f(c1[e] & 0xffffu);
                    const float b = bf2f(xr[e] >> 16) * DN_ALPHA + w0 * bf2f(c0[e] >> 16) + w1 * bf2f(c1[e] >> 16);
                    v[u][j][2 * e] = a; v[u][j][2 * e + 1] = b;
                    s[u] += a + b; q[u] += a * a + b * b;
                }
            }
        }
#pragma unroll
        for (int u = 0; u < U; ++u) { s[u] = wave_sum(s[u]); q[u] = wave_sum(q[u]); }
#pragma unroll
        for (int j = 0; j < 2; ++j) {
            const int d0 = 512 * j + 8 * lane;
            const float4 g0 = *(const float4*)(gam + d0), g1 = *(const float4*)(gam + d0 + 4), b0 = *(const float4*)(bet + d0), b1 = *(const float4*)(bet + d0 + 4);
#pragma unroll
            for (int u = 0; u < U; ++u) {
                const int tok = t0 + u;
                const float mu = s[u] * (1.f / 1024.f), var = fmaxf(q[u] * (1.f / 1024.f) - mu * mu, 0.f), rstd = rsqrtf(var + 1e-5f);
                float4 y0, y1;
                y0.x = (v[u][j][0] - mu) * rstd * g0.x + b0.x; y0.y = (v[u][j][1] - mu) * rstd * g0.y + b0.y; y0.z = (v[u][j][2] - mu) * rstd * g0.z + b0.z; y0.w = (v[u][j][3] - mu) * rstd * g0.w + b0.w;
                y1.x = (v[u][j][4] - mu) * rstd * g1.x + b1.x; y1.y = (v[u][j][5] - mu) * rstd * g1.y + b1.y; y1.z = (v[u][j][6] - mu) * rstd * g1.z + b1.z; y1.w = (v[u][j][7] - mu) * rstd * g1.w + b1.w;
                if (fin) { *(float4*)(XO + (size_t)tok * 1024 + d0) = y0; *(float4*)(XO + (size_t)tok * 1024 + d0 + 4) = y1; }
                else { u32x4 w; w.x = pack2(y0.x, y0.y); w.y = pack2(y0.z, y0.w); w.z = pack2(y1.x, y1.y); w.w = pack2(y1.z, y1.w); *(u32x4*)(XB + (size_t)tok * 1024 + d0) = w; }
            }
        }
    }
}

#define XB_TMO      128
#define XB_XCNT(j)  (256  + 64 * (j))
#define XB_XSUB(j)  (1280 + 64 * (j))
#define XB_XGEN(j)  (2304 + 64 * (j))
#define XB_TOP      3328
#define XB_TOPGEN   3392
#define XCD_BAR_WORDS 3456
#define XB_SPIN_CAP (1u << 22)
#define LAS __attribute__((address_space(3)))
__device__ __forceinline__ unsigned xb_ld(unsigned* p)              { return __hip_atomic_load(p, __ATOMIC_RELAXED, __HIP_MEMORY_SCOPE_AGENT); }
__device__ __forceinline__ unsigned xb_add(unsigned* p, unsigned v) { return __hip_atomic_fetch_add(p, v, __ATOMIC_RELAXED, __HIP_MEMORY_SCOPE_AGENT); }
__device__ __forceinline__ unsigned xb_xcc_id() { return (unsigned)__builtin_amdgcn_s_getreg((3 << 11) | 20) & 0xFu; }
#define XB_SPIN(cond, bar) do { unsigned _sp = 0; while (cond) { __builtin_amdgcn_s_sleep(1); \
    if ((++_sp & 255u) == 0u) { if (xb_ld(&(bar)[XB_TMO])) break; if (_sp > XB_SPIN_CAP) { atomicAdd(&(bar)[XB_TMO], 1u); break; } } } } while (0)
struct XcdBarrier { unsigned* bar; unsigned x; volatile LAS unsigned* st; };
__device__ __forceinline__ XcdBarrier xcd_barrier_post(unsigned* bar, volatile LAS unsigned* st) {
    XcdBarrier b; b.bar = bar; b.x = xb_xcc_id(); b.st = st;
    if (threadIdx.x == 0) (void)xb_add(&bar[XB_XCNT(b.x)], 1u);
    return b;
}
__device__ __forceinline__ void xcd_barrier_complete(unsigned* bar, unsigned x, unsigned& nloc, unsigned& nx) {
    const unsigned G = gridDim.x * gridDim.y * gridDim.z;
    unsigned sum, cnt, mine, sp = 0u;
    for (;;) {
        sum = 0u; cnt = 0u; mine = 0u;
#pragma unroll
        for (unsigned j = 0; j < 16; ++j) { const unsigned c = xb_ld(&bar[XB_XCNT(j)]); sum += c; cnt += (c > 0u) ? 1u : 0u; mine = (j == x) ? c : mine; }
        if (sum == G) break;
        __builtin_amdgcn_s_sleep(1);
        if ((++sp & 255u) == 0u) { if (xb_ld(&bar[XB_TMO])) break; if (sp > XB_SPIN_CAP) { atomicAdd(&bar[XB_TMO], 1u); break; } }
    }
    nloc = mine > 0u ? mine : 1u; nx = cnt > 0u ? cnt : 1u;
}
__device__ __forceinline__ void xcd_barrier(const XcdBarrier& b) {
    asm volatile("s_waitcnt vmcnt(0)" ::: "memory");
    __syncthreads();
    if (threadIdx.x == 0) {
        unsigned* bar = b.bar;
        __builtin_amdgcn_s_waitcnt(0);
        unsigned nloc = b.st[0], nx = b.st[1];
        if (nloc == 0u) { xcd_barrier_complete(bar, b.x, nloc, nx); b.st[0] = nloc; b.st[1] = nx; }
        const unsigned old = xb_add(&bar[XB_XSUB(b.x)], 1u);
        const unsigned gen = old / nloc;
        if (old + 1u == (gen + 1u) * nloc) {
            __builtin_amdgcn_fence(__ATOMIC_RELEASE, "agent");
            asm volatile("s_waitcnt vmcnt(0)" ::: "memory");
            const unsigned og = xb_add(&bar[XB_TOP], 1u);
            const unsigned tg = og / nx;
            if (og + 1u == (tg + 1u) * nx) xb_add(&bar[XB_TOPGEN], 1u);
            else XB_SPIN(xb_ld(&bar[XB_TOPGEN]) == tg, bar);
            __builtin_amdgcn_fence(__ATOMIC_ACQUIRE, "agent");
            xb_add(&bar[XB_XGEN(b.x)], 1u);
            asm volatile("s_waitcnt vmcnt(0)" ::: "memory");
        } else {
            XB_SPIN(xb_ld(&bar[XB_XGEN(b.x)]) == gen, bar);
            __builtin_amdgcn_fence(__ATOMIC_ACQUIRE, "agent");
            asm volatile("s_waitcnt vmcnt(0)" ::: "memory");
        }
    }
    __syncthreads();
}

constexpr int PH_PER_LAYER = 11, N_PHASES = PH_PER_LAYER * NLAYER;
__global__ void __launch_bounds__(NTHREADS, 2) mega(Params p) {
    extern __shared__ __attribute__((aligned(16))) unsigned char lds[];
#if SINGLE_LAUNCH
    volatile LAS unsigned* xbw = (volatile LAS unsigned*)(lds + LDS_BYTES - 16);
    if (threadIdx.x < 4) xbw[threadIdx.x] = 0u;
    __syncthreads();
    XcdBarrier xbar; xbar.bar = (unsigned*)(p.ws + WS_CTL) + CW_BAR; xbar.x = xb_xcc_id(); xbar.st = xbw;
#endif
    const int half = __builtin_amdgcn_readfirstlane((int)(threadIdx.x >> 8));
    unsigned char* ldsh = lds + half * HALF_LDS;
#if REPEAT_MASK == 0
    const int REPM = 0;
#else
    const int REPM = p.rep_mask;
#endif
    bool second = false;
    for (int ph = p.ph_lo; ph < p.ph_hi; ++ph) {
        const int layer = ph / PH_PER_LAYER, k = ph % PH_PER_LAYER;
        if (k == 0 && layer > 0) continue;
#ifdef ONLY_PHASE
        if (k != ONLY_PHASE) continue;
#endif
        switch (k) {
            case 0: phase_pw(p, layer, ldsh, 1 | 16 | 8, half); break;
            case 1: phase_g1(p, layer, lds); if (!second) { __syncthreads(); phase_pw(p, layer, ldsh, 4, half, 0, 1); } break;
            case 2: phase_p2(p, layer, ldsh, half); if (!second && layer + 1 < NLAYER) { __syncthreads(); phase_pw(p, layer + 1, ldsh, 1, half, 64); } break;
            case 3: phase_p3(p, ldsh, half, second ? ((REPM >> 16) & 7) : 7); if (!second) { __syncthreads(); phase_pw(p, layer, ldsh, 4, half, 0, 3); }
                    if (!second && layer + 1 < NLAYER) { __syncthreads(); phase_pw(p, layer + 1, ldsh, 16, half); }
                    if (!second && layer == 0) { __syncthreads(); phase_pw(p, 0, ldsh, 2, half); } break;
            case 4: { const int sub = second ? ((REPM >> 12) & 7) : 7;
                    if (sub & 1) phase_p4_sel(p, lds);
                    if ((sub & 4) && half == 0) { phase_pw(p, layer, ldsh, 4, half, 0, 2); __syncthreads(); }
                    if (sub & 2) phase_p4(p, ldsh, half);
                    if ((sub & 4) && half == 1) { __syncthreads(); phase_pw(p, layer, ldsh, 4, half, 0, 2); } } break;
            case 5: phase_g2(p, lds); break;
            case 6: phase_g3(p, layer, lds); break;
            case 7: phase_ln1(p, layer, ldsh, ((REPM >> 7) & 1) && !second, half); if (!second && layer + 1 < NLAYER) { __syncthreads(); phase_pw(p, layer + 1, ldsh, 2, half); } break;
            case 8: phase_m2(p, layer, lds, ldsh, half); break;
            case 9: phase_m3(p, layer, lds, ldsh, half); break;
            case 10: phase_ln2(p, layer, half); break;
        }

        if (ph + 1 < p.ph_hi) { if (ph == p.ph_lo && !second) { cg::this_grid().sync(); if (threadIdx.x == 0) (void)xb_add(&xbar.bar[XB_XCNT(xbar.x)], 1u); } else xcd_barrier(xbar); }
        if (((REPM >> k) & 1) && !second) { second = true; --ph; } else second = false;
    }
}

extern "C" void kernel_launch(void* const* d_in, const int* in_sizes, int n_in, void* d_out, int out_size, void* d_ws, size_t ws_size, hipStream_t stream) {
    static int grid = 0;
    if (grid == 0) {
        if (n_in != 18 || ws_size < WS_END) { fprintf(stderr, "kernel_launch: unexpected n_in %d or ws_size %zu < %zu\n", n_in, ws_size, (size_t)WS_END); grid = -1; return; }
        int dev = 0, cus = 0, per_cu = 0;
        hipGetDevice(&dev); hipDeviceGetAttribute(&cus, hipDeviceAttributeMultiprocessorCount, dev);
        hipFuncSetAttribute((const void*)mega, hipFuncAttributeMaxDynamicSharedMemorySize, LDS_BYTES);
        hipOccupancyMaxActiveBlocksPerMultiprocessor(&per_cu, (const void*)mega, NTHREADS, LDS_BYTES);
        if (per_cu < 1) per_cu = 1;
        if (per_cu > 1) per_cu = 1;
        grid = cus * per_cu;
        (void)hipGetLastError();
    }
    if (grid < 0) return;
    Params p{};
    p.x = (const float*)d_in[0]; p.w_in = (const float*)d_in[1]; p.cmp_pos = (const float*)d_in[2]; p.cmp_w1 = (const float*)d_in[3]; p.cmp_w2 = (const float*)d_in[4];
    p.w_br_a = (const float*)d_in[5]; p.w_br_b = (const float*)d_in[6]; p.w_o = (const float*)d_in[7]; p.ln1_g = (const float*)d_in[8]; p.ln1_b = (const float*)d_in[9];
    p.w_router = (const float*)d_in[10]; p.router_bias = (const float*)d_in[11]; p.w_gate = (const float*)d_in[12]; p.w_up = (const float*)d_in[13]; p.w_down = (const float*)d_in[14];
    p.ln2_g = (const float*)d_in[15]; p.ln2_b = (const float*)d_in[16]; p.rel_bias = (const float*)d_in[17];
    p.out = (float*)d_out; p.ws = (unsigned char*)d_ws; p.rep_mask = REPEAT_MASK;
#if SINGLE_LAUNCH
    p.ph_lo = 0; p.ph_hi = N_PHASES;
    void* args[] = {&p};
    hipError_t e = hipLaunchCooperativeKernel((const void*)mega, dim3(grid), dim3(NTHREADS), args, LDS_BYTES, stream);
    if (e != hipSuccess) fprintf(stderr, "cooperative launch failed: %s (grid %d)\n", hipGetErrorString(e), grid);
#else
    for (int ph = 0; ph < N_PHASES; ++ph) {
        p.ph_lo = ph; p.ph_hi = ph + 1;
        hipLaunchKernelGGL(mega, dim3(grid), dim3(NTHREADS), LDS_BYTES, stream, p);
    }
#endif
}
```
